# Optimizing an MI355X kernel written in HIP

```python
import math
import jax, jax.numpy as jnp
from jax import lax
import numpy as np


D_MODEL = 1024
BATCH = 4
SEQ = 4096
DEPTH = 2

N_MEM = 256
D_MIX = D_MODEL
D_CONV = D_MIX // 4
D_ATTN = D_MIX // 2
D_SSM = D_MIX // 4
ATTN_HEAD_DIM = 64
ATTN_HEADS = D_ATTN // ATTN_HEAD_DIM
SB_BLOCK = 128
CONV_WIDTH = 31
SSM_GROUP = 16
SSM_GROUPS = D_SSM // SSM_GROUP
SSM_STATE = 64
MEM_HEADS = 4
MEM_HEAD_DIM = D_MODEL // MEM_HEADS
PEER_HEADS = 8
PEER_KEYS = 128
PEER_EXPERTS = PEER_KEYS * PEER_KEYS
PEER_QDIM = 256
PEER_HALF = PEER_QDIM // 2
PEER_TOPK = 16
PEER_CHUNK = 128
D_IN = 2 * D_CONV + 3 * D_ATTN + D_SSM
EPS = 1e-6

kernel_name = 'hybrid_conv_sba_s5_peer_block'


def rmsnorm(x, g):
    x32 = x.astype(jnp.float32)
    y = x32 * lax.rsqrt(jnp.mean(x32 * x32, axis=-1, keepdims=True) + EPS)
    return (y * g.astype(jnp.float32)).astype(x.dtype)


def conformer_conv(u, conv_w, conv_b, ln_g, ln_b):
    val, gate = jnp.split(u, 2, axis=-1)
    y = val * jax.nn.sigmoid(gate)
    y = lax.conv_general_dilated(
        y, conv_w[:, None, :].astype(y.dtype), window_strides=(1,),
        padding=[(CONV_WIDTH - 1, 0)], dimension_numbers=('NWC', 'WIO', 'NWC'),
        feature_group_count=D_CONV) + conv_b
    y32 = y.astype(jnp.float32)
    mu = jnp.mean(y32, axis=-1, keepdims=True)
    var = jnp.mean(jnp.square(y32 - mu), axis=-1, keepdims=True)
    y32 = (y32 - mu) * lax.rsqrt(var + EPS) * ln_g.astype(jnp.float32) + ln_b.astype(jnp.float32)
    return jax.nn.silu(y32).astype(u.dtype)


def stick_breaking_attention(q, k, v):
    b, h, s, dh = q.shape
    n_blk = s // SB_BLOCK
    k32 = k.astype(jnp.float32)
    scale = 1.0 / math.sqrt(dh)
    key_pos = jnp.arange(s)

    def one_block(i):
        start = i * SB_BLOCK
        q_blk = lax.dynamic_slice_in_dim(q, start, SB_BLOCK, axis=2).astype(jnp.float32)
        z = jnp.einsum('bhqd,bhkd->bhqk', q_blk, k32) * scale
        q_pos = start + jnp.arange(SB_BLOCK)
        mask = key_pos[None, :] < q_pos[:, None]
        log_stay = jnp.where(mask, jax.nn.log_sigmoid(-z), 0.0)
        later = lax.cumsum(log_stay, axis=3, reverse=True) - log_stay
        a = jnp.where(mask, jnp.exp(jax.nn.log_sigmoid(z) + later), 0.0)
        return jnp.einsum('bhqk,bhkd->bhqd', a.astype(v.dtype), v)

    out = lax.map(one_block, jnp.arange(n_blk))
    return jnp.transpose(out, (1, 0, 3, 2, 4)).reshape(b, s, h * dh)


def _ssm_combine(c1, c2):
    a1, b1 = c1
    a2, b2 = c2
    return a1 * a2, a2 * b1 + b2


def s5_ssm(u, lam_re, lam_im, log_dt, b_re, b_im, c_re, c_im, d_skip, glu_w, glu_b):
    bsz, s, _ = u.shape
    f32 = jnp.float32
    u32 = u.astype(f32)
    lam = lax.complex(jnp.minimum(lam_re.astype(f32), -1e-4), lam_im.astype(f32))
    dt = jnp.exp(log_dt.astype(f32))[:, None]
    lam_bar = jnp.exp(lam * dt)
    b_mat = lax.complex(b_re.astype(f32), b_im.astype(f32))
    b_bar = ((lam_bar - 1.0) / lam)[..., None] * b_mat
    c_mat = lax.complex(c_re.astype(f32), c_im.astype(f32))
    ug = u32.reshape(bsz, s, SSM_GROUPS, SSM_GROUP).astype(jnp.complex64)
    bu = jnp.einsum('bsgh,gph->sbgp', ug, b_bar)
    a = jnp.broadcast_to(lam_bar[None, None], (s, 1, SSM_GROUPS, SSM_STATE))
    _, states = lax.associative_scan(_ssm_combine, (a, bu), axis=0)
    y = jnp.einsum('sbgp,ghp->bsgh', states, c_mat).real.reshape(bsz, s, D_SSM)
    y = y + d_skip.astype(f32) * u32
    y = jax.nn.gelu(y)
    y = y * jax.nn.sigmoid(y @ glu_w.astype(f32) + glu_b.astype(f32))
    return y.astype(u.dtype)


def memory_cross_attention(h, mem_h, w_q, w_kv, w_o):
    b, s, _ = h.shape
    m = mem_h.shape[1]
    q = (h @ w_q).reshape(b, s, MEM_HEADS, MEM_HEAD_DIM)
    k, v = jnp.split(mem_h @ w_kv, 2, axis=-1)
    k = k.reshape(b, m, MEM_HEADS, MEM_HEAD_DIM)
    v = v.reshape(b, m, MEM_HEADS, MEM_HEAD_DIM)
    scores = jnp.einsum('bshd,bmhd->bhsm', q.astype(jnp.float32), k.astype(jnp.float32))
    p = jax.nn.softmax(scores / math.sqrt(MEM_HEAD_DIM), axis=-1)
    o = jnp.einsum('bhsm,bmhd->bshd', p.astype(v.dtype), v).reshape(b, s, D_MODEL)
    return o @ w_o


def peer_ffn(h, w_q, sub_keys, u_tab, v_tab):
    b, s, d = h.shape
    tokens = h.reshape(-1, PEER_CHUNK, d)

    def one_chunk(xc):
        q = (xc @ w_q).reshape(PEER_CHUNK, PEER_HEADS, 2, PEER_HALF)
        sc = jnp.einsum('chid,hikd->chik', q.astype(jnp.float32), sub_keys.astype(jnp.float32))
        top_s, top_i = lax.top_k(sc, PEER_TOPK)
        cand = top_s[:, :, 0, :, None] + top_s[:, :, 1, None, :]
        cand = cand.reshape(PEER_CHUNK, PEER_HEADS, PEER_TOPK * PEER_TOPK)
        best_s, best_c = lax.top_k(cand, PEER_TOPK)
        i1 = jnp.take_along_axis(top_i[:, :, 0], best_c // PEER_TOPK, axis=-1)
        i2 = jnp.take_along_axis(top_i[:, :, 1], best_c % PEER_TOPK, axis=-1)
        expert = i1 * PEER_KEYS + i2
        gate = jax.nn.softmax(best_s, axis=-1)
        u_e = jnp.take(u_tab, expert, axis=0)
        v_e = jnp.take(v_tab, expert, axis=0)
        act = jax.nn.gelu(jnp.einsum('chkd,cd->chk', u_e, xc).astype(jnp.float32))
        return jnp.einsum('chk,chkd->cd', (gate * act).astype(v_e.dtype), v_e)

    return lax.map(one_chunk, tokens).reshape(b, s, d)


def setup_inputs(seed: int = 0) -> dict:
    key = jax.random.key(seed)
    ks = iter(jax.random.split(key, 48))
    f32 = jnp.float32

    def nrm(shape, scale):
        return jax.random.normal(next(ks), shape, f32) * scale

    def gain(shape):
        return 1.0 + nrm(shape, 0.02)

    L = DEPTH
    G, P, H = SSM_GROUPS, SSM_STATE, SSM_GROUP
    return {
        'x': nrm((BATCH, SEQ, D_MODEL), 1.0),
        'mem': nrm((BATCH, N_MEM, D_MODEL), 1.0),
        'norm_mix_g': gain((L, D_MODEL)),
        'w_in': nrm((L, D_MODEL, D_IN), D_MODEL ** -0.5),
        'conv_w': nrm((L, CONV_WIDTH, D_CONV), CONV_WIDTH ** -0.5),
        'conv_b': nrm((L, D_CONV), 0.02),
        'conv_ln_g': gain((L, D_CONV)),
        'conv_ln_b': nrm((L, D_CONV), 0.02),
        'ssm_lambda_re': -0.5 + nrm((L, G, P), 0.01),
        'ssm_lambda_im': math.pi * jnp.arange(P, dtype=f32) + nrm((L, G, P), 0.01),
        'ssm_log_dt': jax.random.uniform(next(ks), (L, G), f32, math.log(1e-3), math.log(1e-1)),
        'ssm_b_re': nrm((L, G, P, H), (2.0 * H) ** -0.5),
        'ssm_b_im': nrm((L, G, P, H), (2.0 * H) ** -0.5),
        'ssm_c_re': nrm((L, G, H, P), (2.0 * P) ** -0.5),
        'ssm_c_im': nrm((L, G, H, P), (2.0 * P) ** -0.5),
        'ssm_d': nrm((L, D_SSM), 1.0),
        'ssm_glu_w': nrm((L, D_SSM, D_SSM), D_SSM ** -0.5),
        'ssm_glu_b': nrm((L, D_SSM), 0.02),
        'grp_norm_g': gain((L, D_MIX)),
        'w_out': nrm((L, D_MIX, D_MODEL), D_MIX ** -0.5),
        'norm_mem_g': gain((L, D_MODEL)),
        'mem_norm_g': gain((L, D_MODEL)),
        'w_mq': nrm((L, D_MODEL, D_MODEL), D_MODEL ** -0.5),
        'w_mkv': nrm((L, D_MODEL, 2 * D_MODEL), D_MODEL ** -0.5),
        'w_mo': nrm((L, D_MODEL, D_MODEL), D_MODEL ** -0.5),
        'norm_ffn_g': gain((L, D_MODEL)),
        'peer_wq': nrm((L, D_MODEL, PEER_HEADS * PEER_QDIM), D_MODEL ** -0.5),
        'peer_sub_keys': nrm((L, PEER_HEADS, 2, PEER_KEYS, PEER_HALF), PEER_HALF ** -0.5),
        'peer_u': nrm((L, PEER_EXPERTS, D_MODEL), D_MODEL ** -0.5),
        'peer_v': nrm((L, PEER_EXPERTS, D_MODEL), 0.5),
        'final_norm_g': gain((D_MODEL,)),
    }


def reference(x, mem, norm_mix_g, w_in, conv_w, conv_b, conv_ln_g, conv_ln_b,
              ssm_lambda_re, ssm_lambda_im, ssm_log_dt, ssm_b_re, ssm_b_im,
              ssm_c_re, ssm_c_im, ssm_d, ssm_glu_w, ssm_glu_b, grp_norm_g, w_out,
              norm_mem_g, mem_norm_g, w_mq, w_mkv, w_mo, norm_ffn_g, peer_wq,
              peer_sub_keys, peer_u, peer_v, final_norm_g):
    b, s, _ = x.shape
    for l in range(DEPTH):
        h = rmsnorm(x, norm_mix_g[l])
        proj = h @ w_in[l]
        p_conv, p_attn, p_ssm = jnp.split(proj, [2 * D_CONV, 2 * D_CONV + 3 * D_ATTN], axis=-1)
        y_conv = conformer_conv(p_conv, conv_w[l], conv_b[l], conv_ln_g[l], conv_ln_b[l])
        q, k, v = jnp.split(p_attn, 3, axis=-1)
        q = q.reshape(b, s, ATTN_HEADS, ATTN_HEAD_DIM).transpose(0, 2, 1, 3)
        k = k.reshape(b, s, ATTN_HEADS, ATTN_HEAD_DIM).transpose(0, 2, 1, 3)
        v = v.reshape(b, s, ATTN_HEADS, ATTN_HEAD_DIM).transpose(0, 2, 1, 3)
        y_attn = stick_breaking_attention(q, k, v)
        y_ssm = s5_ssm(p_ssm, ssm_lambda_re[l], ssm_lambda_im[l], ssm_log_dt[l],
                       ssm_b_re[l], ssm_b_im[l], ssm_c_re[l], ssm_c_im[l], ssm_d[l],
                       ssm_glu_w[l], ssm_glu_b[l])
        g = grp_norm_g[l]
        y = jnp.concatenate([
            rmsnorm(y_conv, g[:D_CONV]),
            rmsnorm(y_attn, g[D_CONV:D_CONV + D_ATTN]),
            rmsnorm(y_ssm, g[D_CONV + D_ATTN:]),
        ], axis=-1)
        x = x + y @ w_out[l]
        x = x + memory_cross_attention(rmsnorm(x, norm_mem_g[l]), rmsnorm(mem, mem_norm_g[l]),
                                       w_mq[l], w_mkv[l], w_mo[l])
        x = x + peer_ffn(rmsnorm(x, norm_ffn_g[l]), peer_wq[l], peer_sub_keys[l],
                         peer_u[l], peer_v[l])
    return rmsnorm(x, final_norm_g)
```

```cpp
#include <hip/hip_runtime.h>
#include <hip/hip_cooperative_groups.h>
#include <cstdio>
namespace cg = cooperative_groups;

#define NT 16384
#define SEQ 4096
#define DM 1024
#define DIN 2304
#define NMEM 256
#define EPSF 1e-6f

struct Params {
  const float* in[31];
  float* out;
  float* ws;
};

#define OFF_XW    ((size_t)0)
#define OFF_XN    (OFF_XW + (size_t)NT * DM)
#define OFF_BIG   (OFF_XN + (size_t)NT * DM)
#define OFF_Y     (OFF_BIG + (size_t)NT * DIN)
#define OFF_MEMH  (OFF_Y + (size_t)NT * DM)
#define OFF_KV    (OFF_MEMH + (size_t)2 * 1024 * 1024)
#define OFF_SSME  (OFF_KV + (size_t)2 * 1024 * 2048)
#define OFF_SSMP  (OFF_SSME + (size_t)4 * 64 * 16 * 64 * 2)
#define SSMP_PER_LAYER (2048 + 2048 + 32768)
#define OFF_IDS   (OFF_SSMP + (size_t)2 * SSMP_PER_LAYER)
#define OFF_GATE  (OFF_IDS + (size_t)NT * 128)
#define OFF_END   (OFF_GATE + (size_t)NT * 128)

__device__ __forceinline__ float wsum(float v) {
#pragma unroll
  for (int o = 32; o > 0; o >>= 1) v += __shfl_xor(v, o, 64);
  return v;
}
__device__ __forceinline__ float wmaxf(float v) {
#pragma unroll
  for (int o = 32; o > 0; o >>= 1) v = fmaxf(v, __shfl_xor(v, o, 64));
  return v;
}
__device__ __forceinline__ float sigmoidf_(float x) { return 1.0f / (1.0f + expf(-x)); }
__device__ __forceinline__ float gelu_tanh(float x) {
  return 0.5f * x * (1.0f + tanhf(0.7978845608028654f * (x + 0.044715f * x * x * x)));
}

__device__ void rms_rows(const float* src, const float* g, float* dst, int rows) {
  const int lane = threadIdx.x & 63;
  const int gw = blockIdx.x * 4 + (threadIdx.x >> 6);
  const int nw = gridDim.x * 4;
  for (int r = gw; r < rows; r += nw) {
    const float4* s4 = (const float4*)(src + (size_t)r * DM);
    float4 v[4];
    float ss = 0.f;
#pragma unroll
    for (int i = 0; i < 4; i++) {
      v[i] = s4[lane + i * 64];
      ss += v[i].x * v[i].x + v[i].y * v[i].y + v[i].z * v[i].z + v[i].w * v[i].w;
    }
    ss = wsum(ss);
    const float rstd = rsqrtf(ss * (1.0f / DM) + EPSF);
    float4* d4 = (float4*)(dst + (size_t)r * DM);
    const float4* g4 = (const float4*)g;
#pragma unroll
    for (int i = 0; i < 4; i++) {
      float4 gg = g4[lane + i * 64];
      float4 o;
      o.x = v[i].x * rstd * gg.x; o.y = v[i].y * rstd * gg.y;
      o.z = v[i].z * rstd * gg.z; o.w = v[i].w * rstd * gg.w;
      d4[lane + i * 64] = o;
    }
  }
}

__device__ void gemm_f32(const float* A, const float* B, const float* R, float* C,
                         int M, int N, int K, float* smem) {
  float (*As)[68] = (float (*)[68])smem;
  float (*Bs)[64] = (float (*)[64])(smem + 16 * 68);
  const int tid = threadIdx.x;
  const int ty = tid >> 4, tx = tid & 15;
  const int ntn = N / 64, ntm = M / 64;
  for (int tile = blockIdx.x; tile < ntm * ntn; tile += gridDim.x) {
    const int tm = tile / ntn, tn = tile % ntn;
    float acc[4][4];
#pragma unroll
    for (int i = 0; i < 4; i++)
#pragma unroll
      for (int j = 0; j < 4; j++) acc[i][j] = 0.f;
    const float* Ap = A + (size_t)(tm * 64 + (tid >> 2)) * K + (tid & 3) * 4;
    const float* Bp = B + (size_t)(tid >> 4) * N + tn * 64 + (tid & 15) * 4;
    for (int k0 = 0; k0 < K; k0 += 16) {
      const float4 a = *(const float4*)(Ap + k0);
      const float4 b = *(const float4*)(Bp + (size_t)k0 * N);
      __syncthreads();
      As[(tid & 3) * 4 + 0][tid >> 2] = a.x;
      As[(tid & 3) * 4 + 1][tid >> 2] = a.y;
      As[(tid & 3) * 4 + 2][tid >> 2] = a.z;
      As[(tid & 3) * 4 + 3][tid >> 2] = a.w;
      *(float4*)&Bs[tid >> 4][(tid & 15) * 4] = b;
      __syncthreads();
#pragma unroll
      for (int k = 0; k < 16; k++) {
        const float4 av = *(const float4*)&As[k][ty * 4];
        const float4 bv = *(const float4*)&Bs[k][tx * 4];
        const float aa[4] = {av.x, av.y, av.z, av.w};
        const float bb[4] = {bv.x, bv.y, bv.z, bv.w};
#pragma unroll
        for (int i = 0; i < 4; i++)
#pragma unroll
          for (int j = 0; j < 4; j++) acc[i][j] += aa[i] * bb[j];
      }
    }
#pragma unroll
    for (int i = 0; i < 4; i++) {
      const size_t off = (size_t)(tm * 64 + ty * 4 + i) * N + tn * 64 + tx * 4;
      float4 o = make_float4(acc[i][0], acc[i][1], acc[i][2], acc[i][3]);
      if (R) {
        const float4 r = *(const float4*)(R + off);
        o.x += r.x; o.y += r.y; o.z += r.z; o.w += r.w;
      }
      *(float4*)(C + off) = o;
    }
  }
}

__device__ void ssm_params(const Params& p, float* ssmp_all) {
  const int gt = blockIdx.x * blockDim.x + threadIdx.x;
  const int nth = gridDim.x * blockDim.x;
  for (int i = gt; i < 2 * 16 * 64; i += nth) {
    const int l = i / 1024, gp = i % 1024, g = gp / 64;
    float* sp = ssmp_all + (size_t)l * SSMP_PER_LAYER;
    const float lre = fminf(p.in[8][l * 1024 + gp], -1e-4f);
    const float lim = p.in[9][l * 1024 + gp];
    const float dt = expf(p.in[10][l * 16 + g]);
    const float er = expf(lre * dt);
    float sn, cs;
    sincosf(lim * dt, &sn, &cs);
    const float br = er * cs, bi = er * sn;
    sp[gp * 2 + 0] = br;
    sp[gp * 2 + 1] = bi;
    float cr = br, ci = bi;
#pragma unroll
    for (int s = 0; s < 6; s++) {
      const float nr = cr * cr - ci * ci, ni = 2.f * cr * ci;
      cr = nr; ci = ni;
    }
    sp[2048 + gp * 2 + 0] = cr;
    sp[2048 + gp * 2 + 1] = ci;
    const float nr = br - 1.0f, ni = bi;
    const float den = lre * lre + lim * lim;
    const float fr = (nr * lre + ni * lim) / den;
    const float fi = (ni * lre - nr * lim) / den;
    for (int h = 0; h < 16; h++) {
      const float bre = p.in[11][((size_t)l * 1024 + gp) * 16 + h];
      const float bim = p.in[12][((size_t)l * 1024 + gp) * 16 + h];
      sp[4096 + (gp * 16 + h) * 2 + 0] = fr * bre - fi * bim;
      sp[4096 + (gp * 16 + h) * 2 + 1] = fr * bim + fi * bre;
    }
  }
}

__device__ void conv_phase(const Params& p, int l, const float* proj, float* y) {
  const int lane = threadIdx.x & 63;
  const int gw = blockIdx.x * 4 + (threadIdx.x >> 6);
  const int nw = gridDim.x * 4;
  const float* cw = p.in[4] + (size_t)l * 31 * 256;
  const float4 cb = ((const float4*)(p.in[5] + l * 256))[lane];
  const float4 lg = ((const float4*)(p.in[6] + l * 256))[lane];
  const float4 lb = ((const float4*)(p.in[7] + l * 256))[lane];
  const float4 gg = ((const float4*)(p.in[18] + l * 1024))[lane];
  for (int tok = gw; tok < NT; tok += nw) {
    const int t = tok & (SEQ - 1);
    float4 acc = cb;
    for (int j = 0; j < 31; j++) {
      const int tt = t - 30 + j;
      if (tt >= 0) {
        const float* row = proj + (size_t)(tok - 30 + j) * DIN;
        const float4 v = ((const float4*)row)[lane];
        const float4 gt = ((const float4*)(row + 256))[lane];
        const float4 w = ((const float4*)(cw + j * 256))[lane];
        acc.x += v.x * sigmoidf_(gt.x) * w.x;
        acc.y += v.y * sigmoidf_(gt.y) * w.y;
        acc.z += v.z * sigmoidf_(gt.z) * w.z;
        acc.w += v.w * sigmoidf_(gt.w) * w.w;
      }
    }
    const float mean = wsum(acc.x + acc.y + acc.z + acc.w) * (1.0f / 256.f);
    const float dx = acc.x - mean, dy = acc.y - mean, dz = acc.z - mean, dw = acc.w - mean;
    const float var = wsum(dx * dx + dy * dy + dz * dz + dw * dw) * (1.0f / 256.f);
    const float rs = rsqrtf(var + EPSF);
    float4 s;
    s.x = dx * rs * lg.x + lb.x; s.y = dy * rs * lg.y + lb.y;
    s.z = dz * rs * lg.z + lb.z; s.w = dw * rs * lg.w + lb.w;
    s.x = s.x * sigmoidf_(s.x); s.y = s.y * sigmoidf_(s.y);
    s.z = s.z * sigmoidf_(s.z); s.w = s.w * sigmoidf_(s.w);
    const float ss = wsum(s.x * s.x + s.y * s.y + s.z * s.z + s.w * s.w) * (1.0f / 256.f);
    const float r2 = rsqrtf(ss + EPSF);
    float4 o;
    o.x = s.x * r2 * gg.x; o.y = s.y * r2 * gg.y; o.z = s.z * r2 * gg.z; o.w = s.w * r2 * gg.w;
    ((float4*)(y + (size_t)tok * DM))[lane] = o;
  }
}

__device__ void attn_phase(const Params& p, int l, const float* proj, float* y) {
  const int lane = threadIdx.x & 63;
  const int gw = blockIdx.x * 4 + (threadIdx.x >> 6);
  const int nw = gridDim.x * 4;
  const float* gg = p.in[18] + l * 1024 + 256;
  for (int tok = gw; tok < NT; tok += nw) {
    const int t = tok & (SEQ - 1);
    float ssq = 0.f;
    for (int h = 0; h < 8; h++) {
      const float qd = proj[(size_t)tok * DIN + 512 + h * 64 + lane];
      float R = 0.f, o = 0.f;
      for (int s = 1; s <= t; s++) {
        const float* row = proj + (size_t)(tok - s) * DIN + h * 64 + lane;
        const float kd = row[1024];
        const float vd = row[1536];
        const float z = wsum(qd * kd) * 0.125f;
        const float sp = log1pf(expf(-fabsf(z)));
        const float lsz = fminf(z, 0.f) - sp;
        const float lst = -(fmaxf(z, 0.f) + sp);
        o += expf(lsz + R) * vd;
        R += lst;
        if (R < -110.f) break;
      }
      y[(size_t)tok * DM + 256 + h * 64 + lane] = o;
      ssq += o * o;
    }
    ssq = wsum(ssq) * (1.0f / 512.f);
    const float rs = rsqrtf(ssq + EPSF);
    for (int h = 0; h < 8; h++) {
      const size_t off = (size_t)tok * DM + 256 + h * 64 + lane;
      y[off] = y[off] * rs * gg[h * 64 + lane];
    }
  }
}

__device__ void ssm_chunk_end(const float* ssmp, const float* proj, float* ssmE) {
  const int lane = threadIdx.x & 63;
  const int gw = blockIdx.x * 4 + (threadIdx.x >> 6);
  const int nw = gridDim.x * 4;
  for (int it = gw; it < 4 * 64 * 16; it += nw) {
    const int g = it & 15, c = (it >> 4) & 63, b = it >> 10;
    const int gp = g * 64 + lane;
    const float lbr = ssmp[gp * 2], lbi = ssmp[gp * 2 + 1];
    float bbr[16], bbi[16];
#pragma unroll
    for (int h = 0; h < 16; h++) {
      bbr[h] = ssmp[4096 + (gp * 16 + h) * 2];
      bbi[h] = ssmp[4096 + (gp * 16 + h) * 2 + 1];
    }
    float xr = 0.f, xi = 0.f;
    for (int tt = 0; tt < 64; tt++) {
      const float* u = proj + (size_t)(b * SEQ + c * 64 + tt) * DIN + 2048 + g * 16;
      float br = 0.f, bi = 0.f;
#pragma unroll
      for (int h = 0; h < 16; h++) {
        const float uh = u[h];
        br += bbr[h] * uh;
        bi += bbi[h] * uh;
      }
      const float nr = lbr * xr - lbi * xi + br;
      const float ni = lbr * xi + lbi * xr + bi;
      xr = nr; xi = ni;
    }
    float* e = ssmE + ((size_t)((b * 64 + c) * 16 + g) * 64 + lane) * 2;
    e[0] = xr; e[1] = xi;
  }
}

__device__ void ssm_finish(const Params& p, int l, const float* ssmp, const float* proj,
                           const float* ssmE, float* y, float* smem) {
  float (*Yt)[256] = (float (*)[256])smem;
  const int tid = threadIdx.x, lane = tid & 63, wave = tid >> 6;
  const float* cre = p.in[13] + (size_t)l * 16 * 16 * 64;
  const float* cim = p.in[14] + (size_t)l * 16 * 16 * 64;
  const float* dsk = p.in[15] + l * 256;
  const float* glw = p.in[16] + (size_t)l * 256 * 256;
  const float* glb = p.in[17] + l * 256;
  const float* gg = p.in[18] + l * 1024 + 768;
  for (int it = blockIdx.x; it < 256; it += gridDim.x) {
    const int b = it >> 6, c = it & 63;
    __syncthreads();
    for (int gi = 0; gi < 4; gi++) {
      const int g = wave + gi * 4;
      const int gp = g * 64 + lane;
      const float lbr = ssmp[gp * 2], lbi = ssmp[gp * 2 + 1];
      const float lcr = ssmp[2048 + gp * 2], lci = ssmp[2048 + gp * 2 + 1];
      float bbr[16], bbi[16], ccr[16], cci[16];
#pragma unroll
      for (int h = 0; h < 16; h++) {
        bbr[h] = ssmp[4096 + (gp * 16 + h) * 2];
        bbi[h] = ssmp[4096 + (gp * 16 + h) * 2 + 1];
        ccr[h] = cre[(g * 16 + h) * 64 + lane];
        cci[h] = cim[(g * 16 + h) * 64 + lane];
      }
      float xr = 0.f, xi = 0.f;
      for (int cc = 0; cc < c; cc++) {
        const float* e = ssmE + ((size_t)((b * 64 + cc) * 16 + g) * 64 + lane) * 2;
        const float er = e[0], ei = e[1];
        const float nr = lcr * xr - lci * xi + er;
        const float ni = lcr * xi + lci * xr + ei;
        xr = nr; xi = ni;
      }
      const int hq = ((lane >> 5) & 1) * 8 + ((lane >> 4) & 1) * 4 + ((lane >> 3) & 1) * 2 + ((lane >> 2) & 1);
      const float dh = dsk[g * 16 + hq];
      for (int tt = 0; tt < 64; tt++) {
        const float* u = proj + (size_t)(b * SEQ + c * 64 + tt) * DIN + 2048 + g * 16;
        float br = 0.f, bi = 0.f;
#pragma unroll
        for (int h = 0; h < 16; h++) {
          const float uh = u[h];
          br += bbr[h] * uh;
          bi += bbi[h] * uh;
        }
        const float nr = lbr * xr - lbi * xi + br;
        const float ni = lbr * xi + lbi * xr + bi;
        xr = nr; xi = ni;
        float v[16];
#pragma unroll
        for (int h = 0; h < 16; h++) v[h] = xr * ccr[h] - xi * cci[h];
        float v8[8], v4[4], v2[2], v1;
        {
          const bool hi = (lane & 32) != 0;
#pragma unroll
          for (int i = 0; i < 8; i++) {
            const float send = hi ? v[i] : v[i + 8];
            const float keep = hi ? v[i + 8] : v[i];
            v8[i] = keep + __shfl_xor(send, 32, 64);
          }
        }
        {
          const bool hi = (lane & 16) != 0;
#pragma unroll
          for (int i = 0; i < 4; i++) {
            const float send = hi ? v8[i] : v8[i + 4];
            const float keep = hi ? v8[i + 4] : v8[i];
            v4[i] = keep + __shfl_xor(send, 16, 64);
          }
        }
        {
          const bool hi = (lane & 8) != 0;
#pragma unroll
          for (int i = 0; i < 2; i++) {
            const float send = hi ? v4[i] : v4[i + 2];
            const float keep = hi ? v4[i + 2] : v4[i];
            v2[i] = keep + __shfl_xor(send, 8, 64);
          }
        }
        {
          const bool hi = (lane & 4) != 0;
          const float send = hi ? v2[0] : v2[1];
          const float keep = hi ? v2[1] : v2[0];
          v1 = keep + __shfl_xor(send, 4, 64);
        }
        v1 += __shfl_xor(v1, 2, 64);
        v1 += __shfl_xor(v1, 1, 64);
        if ((lane & 3) == 0) {
          const float yy = v1 + dh * u[hq];
          Yt[tt][g * 16 + hq] = gelu_tanh(yy);
        }
      }
    }
    __syncthreads();
    {
      const int j = tid;
      const float bj = glb[j];
      for (int t0 = 0; t0 < 64; t0 += 8) {
        float acc[8];
#pragma unroll
        for (int i = 0; i < 8; i++) acc[i] = 0.f;
        for (int k = 0; k < 256; k++) {
          const float w = glw[k * 256 + j];
#pragma unroll
          for (int i = 0; i < 8; i++) acc[i] += Yt[t0 + i][k] * w;
        }
        __syncthreads();
#pragma unroll
        for (int i = 0; i < 8; i++) {
          const float yv = Yt[t0 + i][j];
          Yt[t0 + i][j] = yv * sigmoidf_(acc[i] + bj);
        }
      }
    }
    __syncthreads();
    for (int i = 0; i < 16; i++) {
      const int tt = wave * 16 + i;
      const float4 v = *(const float4*)&Yt[tt][lane * 4];
      const float ss = wsum(v.x * v.x + v.y * v.y + v.z * v.z + v.w * v.w) * (1.0f / 256.f);
      const float rs = rsqrtf(ss + EPSF);
      const float4 g4 = ((const float4*)gg)[lane];
      float4 o;
      o.x = v.x * rs * g4.x; o.y = v.y * rs * g4.y; o.z = v.z * rs * g4.z; o.w = v.w * rs * g4.w;
      ((float4*)(y + (size_t)(b * SEQ + c * 64 + tt) * DM + 768))[lane] = o;
    }
  }
}

__device__ void memattn_phase(const float* q, const float* kv, float* o) {
  const int lane = threadIdx.x & 63;
  const int gw = blockIdx.x * 4 + (threadIdx.x >> 6);
  const int nw = gridDim.x * 4;
  for (int it = gw; it < NT * 4; it += nw) {
    const int tok = it >> 2, h = it & 3, b = tok >> 12;
    const float4 q4 = ((const float4*)(q + (size_t)tok * DM + h * 256))[lane];
    const float* kb = kv + (size_t)(b * NMEM) * 2048 + h * 256;
    float sc[4];
#pragma unroll
    for (int mm = 0; mm < 4; mm++) {
      float mine = 0.f;
      for (int m2 = 0; m2 < 64; m2++) {
        const float4 k4 = ((const float4*)(kb + (size_t)(mm * 64 + m2) * 2048))[lane];
        const float s = wsum(q4.x * k4.x + q4.y * k4.y + q4.z * k4.z + q4.w * k4.w) * 0.0625f;
        if (m2 == lane) mine = s;
      }
      sc[mm] = mine;
    }
    const float mx = wmaxf(fmaxf(fmaxf(sc[0], sc[1]), fmaxf(sc[2], sc[3])));
    float pr[4];
    float sum = 0.f;
#pragma unroll
    for (int mm = 0; mm < 4; mm++) { pr[mm] = expf(sc[mm] - mx); sum += pr[mm]; }
    sum = wsum(sum);
    const float inv = 1.0f / sum;
    float4 acc = make_float4(0.f, 0.f, 0.f, 0.f);
#pragma unroll
    for (int mm = 0; mm < 4; mm++) {
      const float pm_all = pr[mm] * inv;
      for (int m2 = 0; m2 < 64; m2++) {
        const float pm = __shfl(pm_all, m2, 64);
        const float4 v4 = ((const float4*)(kb + (size_t)(mm * 64 + m2) * 2048 + 1024))[lane];
        acc.x += pm * v4.x; acc.y += pm * v4.y; acc.z += pm * v4.z; acc.w += pm * v4.w;
      }
    }
    ((float4*)(o + (size_t)tok * DM + h * 256))[lane] = acc;
  }
}

__device__ __forceinline__ void wave_argmax(float& v, int& idx) {
#pragma unroll
  for (int o = 32; o > 0; o >>= 1) {
    const float ov = __shfl_xor(v, o, 64);
    const int oi = __shfl_xor(idx, o, 64);
    if (ov > v || (ov == v && oi < idx)) { v = ov; idx = oi; }
  }
}

__device__ void peer_topk(const float* pq, const float* subk, int* ids, float* gates, float* smem) {
  const int lane = threadIdx.x & 63, wave = threadIdx.x >> 6;
  const int gw = blockIdx.x * 4 + wave;
  const int nw = gridDim.x * 4;
  float* qs = smem + wave * 512;
  float* ts = qs + 256;
  int* ti = (int*)(qs + 256 + 32);
  float* bs = qs + 256 + 64;
  int* be = (int*)(qs + 256 + 80);
  const float NEG = -3.0e38f;
  for (int it = gw; it < NT * 8; it += nw) {
    const int tok = it >> 3, h = it & 7;
    ((float4*)qs)[lane] = ((const float4*)(pq + (size_t)tok * 2048 + h * 256))[lane];
    __builtin_amdgcn_wave_barrier();
    for (int half = 0; half < 2; half++) {
      const float* k0p = subk + ((size_t)((h * 2 + half) * 128 + lane)) * 128;
      const float* k1p = k0p + 64 * 128;
      float s0 = 0.f, s1 = 0.f;
      for (int d = 0; d < 128; d += 4) {
        const float4 qv = *(const float4*)(qs + half * 128 + d);
        const float4 a = *(const float4*)(k0p + d);
        const float4 c = *(const float4*)(k1p + d);
        s0 += qv.x * a.x + qv.y * a.y + qv.z * a.z + qv.w * a.w;
        s1 += qv.x * c.x + qv.y * c.y + qv.z * c.z + qv.w * c.w;
      }
      for (int r = 0; r < 16; r++) {
        float v; int idx;
        if (s0 >= s1) { v = s0; idx = lane; } else { v = s1; idx = lane + 64; }
        wave_argmax(v, idx);
        if (lane == 0) { ts[half * 16 + r] = v; ti[half * 16 + r] = idx; }
        if (idx == lane) s0 = NEG;
        if (idx == lane + 64) s1 = NEG;
      }
    }
    __builtin_amdgcn_wave_barrier();
    float c0, c1, c2, c3;
    {
      const int a = lane >> 2, bb = (lane & 3) * 4;
      const float ta = ts[a];
      c0 = ta + ts[16 + bb + 0];
      c1 = ta + ts[16 + bb + 1];
      c2 = ta + ts[16 + bb + 2];
      c3 = ta + ts[16 + bb + 3];
    }
    for (int r = 0; r < 16; r++) {
      float v = c0; int idx = lane * 4;
      if (c1 > v) { v = c1; idx = lane * 4 + 1; }
      if (c2 > v) { v = c2; idx = lane * 4 + 2; }
      if (c3 > v) { v = c3; idx = lane * 4 + 3; }
      wave_argmax(v, idx);
      if (lane == 0) {
        bs[r] = v;
        be[r] = ti[idx >> 4] * 128 + ti[16 + (idx & 15)];
      }
      if ((idx >> 2) == lane) {
        const int j = idx & 3;
        if (j == 0) c0 = NEG; else if (j == 1) c1 = NEG; else if (j == 2) c2 = NEG; else c3 = NEG;
      }
    }
    __builtin_amdgcn_wave_barrier();
    {
      const float b0 = bs[0];
      float e = (lane < 16) ? expf(bs[lane & 15] - b0) : 0.f;
      const float sum = wsum(e);
      if (lane < 16) {
        ids[(size_t)tok * 128 + h * 16 + lane] = be[lane];
        gates[(size_t)tok * 128 + h * 16 + lane] = e / sum;
      }
    }
    __builtin_amdgcn_wave_barrier();
  }
}

__device__ void peer_gather(const float* xn, const float* utab, const float* vtab,
                            const int* ids, const float* gates, float* xw, float* smem) {
  const int tid = threadIdx.x, lane = tid & 63, wave = tid >> 6;
  float* red = smem;
  for (int tok = blockIdx.x; tok < NT; tok += gridDim.x) {
    float4 xr[4], acc[4];
#pragma unroll
    for (int i = 0; i < 4; i++) {
      xr[i] = ((const float4*)(xn + (size_t)tok * DM))[lane + i * 64];
      acc[i] = make_float4(0.f, 0.f, 0.f, 0.f);
    }
    for (int e = wave * 32; e < wave * 32 + 32; e++) {
      const int id = ids[(size_t)tok * 128 + e];
      const float gt = gates[(size_t)tok * 128 + e];
      const float4* ur = (const float4*)(utab + (size_t)id * DM);
      const float4* vr = (const float4*)(vtab + (size_t)id * DM);
      float d = 0.f;
      float4 vv[4];
#pragma unroll
      for (int i = 0; i < 4; i++) {
        const float4 u4 = ur[lane + i * 64];
        vv[i] = vr[lane + i * 64];
        d += u4.x * xr[i].x + u4.y * xr[i].y + u4.z * xr[i].z + u4.w * xr[i].w;
      }
      d = wsum(d);
      const float w = gt * gelu_tanh(d);
#pragma unroll
      for (int i = 0; i < 4; i++) {
        acc[i].x += w * vv[i].x; acc[i].y += w * vv[i].y;
        acc[i].z += w * vv[i].z; acc[i].w += w * vv[i].w;
      }
    }
    __syncthreads();
#pragma unroll
    for (int i = 0; i < 4; i++) ((float4*)(red + wave * 1024))[lane + i * 64] = acc[i];
    __syncthreads();
    {
      float4 s = ((const float4*)red)[tid];
#pragma unroll
      for (int w = 1; w < 4; w++) {
        const float4 t4 = ((const float4*)(red + w * 1024))[tid];
        s.x += t4.x; s.y += t4.y; s.z += t4.z; s.w += t4.w;
      }
      float4* xp = (float4*)(xw + (size_t)tok * DM) + tid;
      float4 x4 = *xp;
      x4.x += s.x; x4.y += s.y; x4.z += s.z; x4.w += s.w;
      *xp = x4;
    }
  }
}

__global__ void __launch_bounds__(256) fwd_megakernel(Params p) {
  cg::grid_group grid = cg::this_grid();
  __shared__ __attribute__((aligned(16))) float smem[16384];
  float* ws = p.ws;
  float* xw = ws + OFF_XW;
  float* xn = ws + OFF_XN;
  float* big = ws + OFF_BIG;
  float* y = ws + OFF_Y;
  float* memh = ws + OFF_MEMH;
  float* kv = ws + OFF_KV;
  float* ssmE = ws + OFF_SSME;
  float* ssmp = ws + OFF_SSMP;
  int* ids = (int*)(ws + OFF_IDS);
  float* gates = ws + OFF_GATE;

  for (int l = 0; l < 2; l++)
    rms_rows(p.in[1], p.in[21] + l * DM, memh + (size_t)l * 1024 * 1024, 1024);
  ssm_params(p, ssmp);
  grid.sync();
  for (int l = 0; l < 2; l++)
    gemm_f32(memh + (size_t)l * 1024 * 1024, p.in[23] + (size_t)l * 1024 * 2048, nullptr,
             kv + (size_t)l * 1024 * 2048, 1024, 2048, 1024, smem);

  for (int l = 0; l < 2; l++) {
    const float* xcur = (l == 0) ? p.in[0] : xw;
    const float* sp = ssmp + (size_t)l * SSMP_PER_LAYER;
    rms_rows(xcur, p.in[2] + l * DM, xn, NT);
    grid.sync();
    gemm_f32(xn, p.in[3] + (size_t)l * DM * DIN, nullptr, big, NT, DIN, DM, smem);
    grid.sync();
    ssm_chunk_end(sp, big, ssmE);
    attn_phase(p, l, big, y);
    conv_phase(p, l, big, y);
    grid.sync();
    ssm_finish(p, l, sp, big, ssmE, y, smem);
    grid.sync();
    gemm_f32(y, p.in[19] + (size_t)l * DM * DM, xcur, xw, NT, DM, DM, smem);
    grid.sync();
    rms_rows(xw, p.in[20] + l * DM, xn, NT);
    grid.sync();
    gemm_f32(xn, p.in[22] + (size_t)l * DM * DM, nullptr, big, NT, DM, DM, smem);
    grid.sync();
    memattn_phase(big, kv + (size_t)l * 1024 * 2048, big + (size_t)NT * DM);
    grid.sync();
    gemm_f32(big + (size_t)NT * DM, p.in[24] + (size_t)l * DM * DM, xw, xw, NT, DM, DM, smem);
    grid.sync();
    rms_rows(xw, p.in[25] + l * DM, xn, NT);
    grid.sync();
    gemm_f32(xn, p.in[26] + (size_t)l * DM * 2048, nullptr, big, NT, 2048, DM, smem);
    grid.sync();
    peer_topk(big, p.in[27] + (size_t)l * 8 * 2 * 128 * 128, ids, gates, smem);
    grid.sync();
    peer_gather(xn, p.in[28] + (size_t)l * 16384 * DM, p.in[29] + (size_t)l * 16384 * DM,
                ids, gates, xw, smem);
    grid.sync();
  }
  rms_rows(xw, p.in[30], p.out, NT);
}

extern "C" void kernel_launch(void* const* d_in, const int* in_sizes, int n_in,
                              void* d_out, int out_size, void* d_ws, size_t ws_size,
                              hipStream_t stream) {
  static int grid_blocks = 0;
  if (!grid_blocks) {
    int dev = 0, cus = 0, per_cu = 0;
    hipGetDevice(&dev);
    hipDeviceGetAttribute(&cus, hipDeviceAttributeMultiprocessorCount, dev);
    hipOccupancyMaxActiveBlocksPerMultiprocessor(&per_cu, fwd_megakernel, 256, 0);
    if (per_cu > 2) per_cu = 2;
    if (per_cu < 1) per_cu = 1;
    grid_blocks = cus * per_cu;
  }
  Params p{};
  for (int i = 0; i < 31; i++) p.in[i] = (const float*)d_in[i];
  p.out = (float*)d_out;
  p.ws = (float*)d_ws;
  void* args[] = {&p};
  hipError_t e = hipLaunchCooperativeKernel((void*)fwd_megakernel, dim3(grid_blocks), dim3(256),
                                            args, 0, stream);
  if (e != hipSuccess)
    fprintf(stderr, "cooperative launch failed: %s (grid %d)\n", hipGetErrorString(e), grid_blocks);
}
```

```cpp
#include <hip/hip_runtime.h>
#include <hip/hip_cooperative_groups.h>
#include <cstdio>
namespace cg = cooperative_groups;

#define NT 16384
#define SEQ 4096
#define DM 1024
#define DIN 2304
#define NMEM 256
#define EPSF 1e-6f
#define NWAVES 8
#define LDS_BYTES 147456

typedef unsigned short bf16;
#define LAS __attribute__((address_space(3)))

struct Params {
  const float* in[31];
  float* out;
  unsigned char* ws;
};
typedef __attribute__((address_space(4))) const unsigned char* kaptr_t;
__device__ __forceinline__ const float* karg_in(int i) {
  kaptr_t ka = (kaptr_t)__builtin_amdgcn_kernarg_segment_ptr();
  asm volatile("" : "+s"(ka));
  return *(const float* __attribute__((address_space(4))) const*)(ka + 8 * i);
}

constexpr size_t MiB = 1u << 20;
constexpr size_t WS_CTL  = 0;
constexpr size_t WS_WT   = 1 * MiB;
constexpr size_t WT_IN = 0, WT_OUT = WT_IN + (size_t)DIN * DM * 2, WT_MQ = WT_OUT + (size_t)DM * DM * 2,
                 WT_MKV = WT_MQ + (size_t)DM * DM * 2, WT_MO = WT_MKV + (size_t)2048 * DM * 2,
                 WT_PQ = WT_MO + (size_t)DM * DM * 2, WT_LAYER = WT_PQ + (size_t)2048 * DM * 2;
constexpr size_t WS_XW   = WS_WT + 2 * WT_LAYER;
constexpr size_t WS_XN   = WS_XW + (size_t)NT * DM * 4;
constexpr size_t WS_BIG  = WS_XN + (size_t)NT * DM * 2;
constexpr size_t WS_Y    = WS_BIG + (size_t)NT * DIN * 4;
constexpr size_t WS_MEMH = WS_Y + (size_t)NT * DM * 2;
constexpr size_t WS_KV   = WS_MEMH + (size_t)2 * 1024 * 1024 * 2;
constexpr size_t WS_SSME = WS_KV + (size_t)2 * 1024 * 2048 * 4;
#define SSMP_PER_LAYER (2048 + 2048 + 32768)
constexpr size_t WS_SSMP = WS_SSME + (size_t)4 * 64 * 16 * 64 * 2 * 4;
constexpr size_t WS_IDS  = WS_SSMP + (size_t)2 * SSMP_PER_LAYER * 4;
constexpr size_t WS_GATE = WS_IDS + (size_t)NT * 128 * 4;
constexpr size_t WS_END  = WS_GATE + (size_t)NT * 128 * 4;
static_assert(WS_END <= 512 * MiB, "workspace");
static_assert(WT_LAYER % 256 == 0 && WS_SSMP % 16 == 0 && WS_IDS % 16 == 0, "align");

__device__ __forceinline__ int opaque_tid() { int v = threadIdx.x; asm volatile("" : "+v"(v)); return v; }
__device__ __forceinline__ unsigned f2bf(float f) { unsigned u = __builtin_bit_cast(unsigned, f); return (u + 0x7fffu + ((u >> 16) & 1u)) >> 16; }
__device__ __forceinline__ unsigned pk2(float lo, float hi) { return f2bf(lo) | (f2bf(hi) << 16); }
__device__ __forceinline__ float bf_lo(unsigned u) { return __builtin_bit_cast(float, u << 16); }
__device__ __forceinline__ float bf_hi(unsigned u) { return __builtin_bit_cast(float, u & 0xffff0000u); }
__device__ __forceinline__ float bf2f(bf16 h) { return __builtin_bit_cast(float, (unsigned)h << 16); }


#define XB_TMO      128
#define XB_XCNT(j)  (256  + 64 * (j))
#define XB_XSUB(j)  (1280 + 64 * (j))
#define XB_XGEN(j)  (2304 + 64 * (j))
#define XB_TOP      3328
#define XB_TOPGEN   3392
#define XCD_BAR_WORDS 3456
#define XB_SPIN_CAP (1u << 22)
__device__ __forceinline__ unsigned xb_ld(unsigned* p)              { return __hip_atomic_load(p, __ATOMIC_RELAXED, __HIP_MEMORY_SCOPE_AGENT); }
__device__ __forceinline__ unsigned xb_add(unsigned* p, unsigned v) { return __hip_atomic_fetch_add(p, v, __ATOMIC_RELAXED, __HIP_MEMORY_SCOPE_AGENT); }
__device__ __forceinline__ unsigned xb_xcc_id() { return (unsigned)__builtin_amdgcn_s_getreg((3 << 11) | 20) & 0xFu; }
#define XB_SPIN(cond, bar) do { unsigned _sp = 0; while (cond) { __builtin_amdgcn_s_sleep(1); \
    if ((++_sp & 255u) == 0u) { if (xb_ld(&(bar)[XB_TMO])) break; if (_sp > XB_SPIN_CAP) { atomicAdd(&(bar)[XB_TMO], 1u); break; } } } } while (0)
struct XcdBarrier { unsigned* bar; unsigned x; volatile LAS unsigned* st; };
__device__ __forceinline__ XcdBarrier xcd_barrier_post(unsigned* bar, volatile LAS unsigned* st) {
    XcdBarrier b; b.bar = bar; b.x = xb_xcc_id(); b.st = st;
    if (threadIdx.x == 0) (void)xb_add(&bar[XB_XCNT(b.x)], 1u);
    return b;
}
__device__ __forceinline__ void xcd_barrier_complete(unsigned* bar, unsigned x, unsigned& nloc, unsigned& nx) {
    const unsigned G = gridDim.x * gridDim.y * gridDim.z;
    unsigned sum, cnt, mine, sp = 0u;
    for (;;) {
        sum = 0u; cnt = 0u; mine = 0u;
#pragma unroll
        for (unsigned j = 0; j < 16; ++j) { const unsigned c = xb_ld(&bar[XB_XCNT(j)]); sum += c; cnt += (c > 0u) ? 1u : 0u; mine = (j == x) ? c : mine; }
        if (sum == G) break;
        __builtin_amdgcn_s_sleep(1);
        if ((++sp & 255u) == 0u) { if (xb_ld(&bar[XB_TMO])) break; if (sp > XB_SPIN_CAP) { atomicAdd(&bar[XB_TMO], 1u); break; } }
    }
    nloc = mine > 0u ? mine : 1u; nx = cnt > 0u ? cnt : 1u;
}
__device__ __forceinline__ void xcd_barrier(const XcdBarrier& b) {
    asm volatile("s_waitcnt vmcnt(0)" ::: "memory");
    __syncthreads();
    if (threadIdx.x == 0) {
        unsigned* bar = b.bar;
        __builtin_amdgcn_s_waitcnt(0);
        unsigned nloc = b.st[0], nx = b.st[1];
        if (nloc == 0u) { xcd_barrier_complete(bar, b.x, nloc, nx); b.st[0] = nloc; b.st[1] = nx; }
        const unsigned old = xb_add(&bar[XB_XSUB(b.x)], 1u);
        const unsigned gen = old / nloc;
        if (old + 1u == (gen + 1u) * nloc) {
            __builtin_amdgcn_fence(__ATOMIC_RELEASE, "agent");
            asm volatile("s_waitcnt vmcnt(0)" ::: "memory");
            const unsigned og = xb_add(&bar[XB_TOP], 1u);
            const unsigned tg = og / nx;
            if (og + 1u == (tg + 1u) * nx) xb_add(&bar[XB_TOPGEN], 1u);
            else XB_SPIN(xb_ld(&bar[XB_TOPGEN]) == tg, bar);
            __builtin_amdgcn_fence(__ATOMIC_ACQUIRE, "agent");
            xb_add(&bar[XB_XGEN(b.x)], 1u);
            asm volatile("s_waitcnt vmcnt(0)" ::: "memory");
        } else {
            XB_SPIN(xb_ld(&bar[XB_XGEN(b.x)]) == gen, bar);
            __builtin_amdgcn_fence(__ATOMIC_ACQUIRE, "agent");
            asm volatile("s_waitcnt vmcnt(0)" ::: "memory");
        }
    }
    __syncthreads();
}

namespace pg8 {
#define PG8_LAS __attribute__((address_space(3)))
typedef unsigned short bf16_t;
typedef short bf16x8 __attribute__((ext_vector_type(8)));
typedef float f32x4 __attribute__((ext_vector_type(4)));
typedef unsigned u32x4 __attribute__((ext_vector_type(4)));
constexpr int BM = 256, BK = 64, HALF = 128, HTB = HALF * BK * 2, STAGE_BYTES = 8 * HTB, NXCD = 8, WGM = 8;
__host__ __device__ __forceinline__ int lds_byte(int r, int c) { const int st = (r >> 4) * 2 + (c >> 5), rr = r & 15, cc = c & 31, ob = rr * 64 + cc * 2; return st * 1024 + (ob ^ (((ob >> 9) & 1) << 5)); }
__host__ __device__ __forceinline__ void stage_rc(int b, int& R, int& C) { const int st = b / 1024, sb = b % 1024, swz = sb ^ (((sb >> 9) & 1) << 5); R = (st >> 1) * 16 + swz / 64; C = (st & 1) * 32 + (swz % 64) / 2; }
__host__ __device__ __forceinline__ int perm32(int rho) { const int n = rho >> 4, i = rho & 15; return 8 * (i >> 2) + 4 * n + (i & 3); }
struct Unit { int pm, pn; };
struct Gemm { const bf16_t* A; const bf16_t* Bt; int M, N, K; };
struct StaticOrder {
    int nM, nN, nwg, G, c;
    __host__ __device__ __forceinline__ void init(int M, int N, int G_, int c_) { nM = M / BM; nN = N / BM; nwg = nM * nN; G = G_; c = c_; }
    __host__ __device__ bool next(int i, Unit& u) const {
        const long L = (long)i * G + c; if (L >= nwg) return false;
        int wgid = (int)L; { const int q = nwg / NXCD, r = nwg % NXCD, xcd = wgid % NXCD, off = wgid / NXCD; wgid = (xcd < r ? xcd * (q + 1) : r * (q + 1) + (xcd - r) * q) + off; }
        const int nig = WGM * nN, gid = wgid / nig, fm = gid * WGM, gsz = (nM - fm) < WGM ? (nM - fm) : WGM;
        u.pm = fm + ((wgid % nig) % gsz); u.pn = (wgid % nig) / gsz; return true;
    }
    __device__ __forceinline__ void a_ready(const Unit&) const {}
    __device__ __forceinline__ void done(const Unit&) const {}
};
__device__ __forceinline__ unsigned cvt_pk_bf16(float lo, float hi) { unsigned r; asm volatile("v_cvt_pk_bf16_f32 %0, %1, %2" : "=v"(r) : "v"(lo), "v"(hi)); return r; }

struct EpiF32R {
    static constexpr bool PERM = false, AFTER_DRAIN = false;
    float* C; const float* R; int ldc;
    __device__ __forceinline__ void operator()(const f32x4 (&acc)[2][2][4][2], const Unit& u, int wr, int wc, int fr, int fq) const {
        const int row0 = u.pm * BM + wr * 64 + fr, col0 = u.pn * BM + wc * 32 + 4 * fq;
#pragma unroll
        for (int ai = 0; ai < 2; ++ai)
#pragma unroll
            for (int m = 0; m < 4; ++m) {
                const size_t ro = (size_t)(row0 + ai * HALF + m * 16) * ldc + col0;
                f32x4 rv[2][2];
#pragma unroll
                for (int bj = 0; bj < 2; ++bj)
#pragma unroll
                    for (int n = 0; n < 2; ++n) rv[bj][n] = R ? *(const f32x4*)(R + ro + bj * HALF + n * 16) : (f32x4){0.f, 0.f, 0.f, 0.f};
#pragma unroll
                for (int bj = 0; bj < 2; ++bj)
#pragma unroll
                    for (int n = 0; n < 2; ++n) *(f32x4*)(C + ro + bj * HALF + n * 16) = acc[ai][bj][m][n] + rv[bj][n];
                __builtin_amdgcn_sched_barrier(0);
            }
    }
};

struct EpiBf16 {
    static constexpr bool PERM = true, AFTER_DRAIN = false;
    bf16_t* O; int ldc;
    __device__ __forceinline__ void operator()(const f32x4 (&acc)[2][2][4][2], const Unit& u, int wr, int wc, int fr, int fq) const {
        const int row0 = u.pm * BM + wr * 64 + fr, col0 = u.pn * BM + wc * 32 + 8 * fq;
#pragma unroll
        for (int ai = 0; ai < 2; ++ai)
#pragma unroll
            for (int m = 0; m < 4; ++m) { bf16_t* rowp = O + (size_t)(row0 + ai * HALF + m * 16) * ldc + col0;
#pragma unroll
                for (int bj = 0; bj < 2; ++bj) { const f32x4 v0 = acc[ai][bj][m][0], v1 = acc[ai][bj][m][1];
                    u32x4 w; w.x = cvt_pk_bf16(v0[0], v0[1]); w.y = cvt_pk_bf16(v0[2], v0[3]); w.z = cvt_pk_bf16(v1[0], v1[1]); w.w = cvt_pk_bf16(v1[2], v1[3]);
                    *(u32x4*)(rowp + bj * HALF) = w; } }
    }
};

template <class Epi, class Sched, bool ALIGN_EPI = false, bool SP2 = false>
__device__ __forceinline__ void gemm_phase(PG8_LAS unsigned char* lds, const Gemm g, const Sched& S, const Epi& E) {
    const int tid = opaque_tid(), wid = __builtin_amdgcn_readfirstlane(tid >> 6), lane = tid & 63, wr = wid >> 2, wc = wid & 3, fr = lane & 15, fq = lane >> 4;
    const int K = g.K, nt = K / BK;
    unsigned voffA[2], voffB[2];
#pragma unroll
    for (int i = 0; i < 2; ++i) { int R, C; stage_rc(tid * 16 + i * 8192, R, C); const int Rb = Epi::PERM ? ((R & ~31) + perm32(R & 31)) : R;
        voffA[i] = (unsigned)(R * K + C) * 2u; voffB[i] = (unsigned)(Rb * K + C) * 2u; }
    const size_t kstep = (size_t)(BK * 2);
    const size_t hstep = (size_t)HALF * K * 2;
    const size_t tstep = 2 * hstep;
    const unsigned ldsw = (unsigned)wid * 1024u;
    const int aoff = lds_byte(wr * 64 + fr, fq * 8), boff = lds_byte(wc * 32 + fr, fq * 8);
#define PG8_SA(b, h) (((b) * 2 + (h)) * HTB)
#define PG8_SB(b, h) ((4 + (b) * 2 + (h)) * HTB)
#define PG8_STAGE(bufoff, gbase, voff) do { _Pragma("unroll") for (int _i = 0; _i < 2; ++_i) \
        __builtin_amdgcn_global_load_lds((const unsigned*)((const char*)(gbase) + (voff)[_i]), (PG8_LAS unsigned*)(lds + (bufoff) + ldsw + _i * 8192), 16, 0, 0); } while (0)
#define PG8_LDA(dst, b, h) do { _Pragma("unroll") for (int m = 0; m < 4; ++m) _Pragma("unroll") for (int k = 0; k < 2; ++k) dst[m][k] = *(const PG8_LAS bf16x8*)(lds + PG8_SA(b, h) + aoff + m * 2048 + k * 1024); } while (0)
#define PG8_LDB(dst, b, h) do { _Pragma("unroll") for (int n = 0; n < 2; ++n) _Pragma("unroll") for (int k = 0; k < 2; ++k) dst[n][k] = *(const PG8_LAS bf16x8*)(lds + PG8_SB(b, h) + boff + n * 2048 + k * 1024); } while (0)
#define PG8_MMA(ai, bj, At, Bt) do { __builtin_amdgcn_s_setprio(1); _Pragma("unroll") for (int m = 0; m < 4; ++m) _Pragma("unroll") for (int n = 0; n < 2; ++n) _Pragma("unroll") for (int k = 0; k < 2; ++k) \
        acc[ai][bj][m][n] = __builtin_amdgcn_mfma_f32_16x16x32_bf16(Bt[n][k], At[m][k], acc[ai][bj][m][n], 0, 0, 0); __builtin_amdgcn_s_setprio(0); } while (0)
#define PG8_WAIT_V(n) asm volatile("s_waitcnt vmcnt(" #n ")" ::: "memory")
#define PG8_WAIT_L(n) asm volatile("s_waitcnt lgkmcnt(" #n ")" ::: "memory")
#define PG8_BAR __builtin_amdgcn_s_barrier()
#define PG8_SCHED __builtin_amdgcn_sched_barrier(0)
    Unit cur, nxt; int ui = 0;
    if (!S.next(0, cur)) return;
    f32x4 acc[2][2][4][2];
#pragma unroll
    for (int a = 0; a < 2; ++a)
#pragma unroll
        for (int b = 0; b < 2; ++b)
#pragma unroll
            for (int m = 0; m < 4; ++m)
#pragma unroll
                for (int n = 0; n < 2; ++n) acc[a][b][m][n] = (f32x4){0.f, 0.f, 0.f, 0.f};
    bf16x8 At[4][2], B0[2][2], B1[2][2];
    const char* cA = (const char*)g.A + (size_t)cur.pm * tstep; const char* cB = (const char*)g.Bt + (size_t)cur.pn * tstep;
    S.a_ready(cur);
    if constexpr (SP2) {
        PG8_STAGE(PG8_SB(0, 0), cB, voffB); PG8_STAGE(PG8_SB(0, 1), cB + hstep, voffB); PG8_STAGE(PG8_SA(0, 0), cA, voffA); PG8_STAGE(PG8_SA(0, 1), cA + hstep, voffA);
        if (wr == 1) PG8_BAR;
        PG8_WAIT_V(2); PG8_BAR;
        PG8_STAGE(PG8_SB(1, 0), cB + kstep, voffB); PG8_STAGE(PG8_SA(1, 0), cA + kstep, voffA); PG8_STAGE(PG8_SB(1, 1), cB + hstep + kstep, voffB);
        PG8_WAIT_V(6); PG8_BAR;
    } else {
        PG8_STAGE(PG8_SB(0, 0), cB, voffB); PG8_STAGE(PG8_SA(0, 0), cA, voffA); PG8_STAGE(PG8_SB(0, 1), cB + hstep, voffB); PG8_STAGE(PG8_SA(0, 1), cA + hstep, voffA);
        if (wr == 1) PG8_BAR;
        PG8_WAIT_V(4); PG8_BAR;
        PG8_STAGE(PG8_SB(1, 0), cB + kstep, voffB); PG8_STAGE(PG8_SA(1, 0), cA + kstep, voffA); PG8_STAGE(PG8_SB(1, 1), cB + hstep + kstep, voffB);
        PG8_WAIT_V(6); PG8_BAR;
    }
    for (;;) {
        const bool has_next = S.next(ui + 1, nxt);
        const char* nA = has_next ? (const char*)g.A + (size_t)nxt.pm * tstep : cA; const char* nB = has_next ? (const char*)g.Bt + (size_t)nxt.pn * tstep : cB;
        for (int t = 0; t < nt; t += 2) {
            const bool last = (t == nt - 2);
            const char* a1 = cA + (size_t)(t + 1) * kstep;
            const char* a2 = last ? nA : cA + (size_t)(t + 2) * kstep; const char* b2 = last ? nB : cB + (size_t)(t + 2) * kstep;
            const char* a3 = a2 + kstep; const char* b3 = b2 + kstep;
            if (last && has_next) S.a_ready(nxt);
            if constexpr (SP2) {
            PG8_LDB(B0, 0, 0); PG8_LDB(B1, 0, 1); PG8_SCHED; PG8_LDA(At, 0, 0); PG8_STAGE(PG8_SA(1, 1), a1 + hstep, voffA);
            PG8_WAIT_V(8); PG8_WAIT_L(0); PG8_BAR; PG8_MMA(0, 0, At, B0); PG8_MMA(0, 1, At, B1); PG8_BAR; PG8_SCHED;
            PG8_LDA(At, 0, 1); PG8_STAGE(PG8_SB(0, 0), b2, voffB); PG8_STAGE(PG8_SB(0, 1), b2 + hstep, voffB); PG8_STAGE(PG8_SA(0, 0), a2, voffA);
            PG8_WAIT_V(8); PG8_WAIT_L(0); PG8_BAR; PG8_MMA(1, 0, At, B0); PG8_MMA(1, 1, At, B1); PG8_BAR; PG8_SCHED;
            PG8_LDB(B0, 1, 0); PG8_LDB(B1, 1, 1); PG8_SCHED; PG8_LDA(At, 1, 0); PG8_STAGE(PG8_SA(0, 1), a2 + hstep, voffA);
            PG8_WAIT_V(8); PG8_WAIT_L(0); PG8_BAR; PG8_MMA(0, 0, At, B0); PG8_MMA(0, 1, At, B1); PG8_BAR; PG8_SCHED;
            PG8_LDA(At, 1, 1); PG8_STAGE(PG8_SB(1, 0), b3, voffB); PG8_STAGE(PG8_SB(1, 1), b3 + hstep, voffB); PG8_STAGE(PG8_SA(1, 0), a3, voffA);
            PG8_WAIT_V(8); PG8_WAIT_L(0); PG8_BAR; PG8_MMA(1, 0, At, B0); PG8_MMA(1, 1, At, B1); PG8_BAR; PG8_SCHED;
            } else {
            PG8_LDB(B0, 0, 0); PG8_SCHED; PG8_LDA(At, 0, 0); PG8_STAGE(PG8_SA(1, 1), a1 + hstep, voffA);
            PG8_WAIT_L(8); PG8_BAR; PG8_WAIT_L(0); PG8_MMA(0, 0, At, B0); PG8_BAR; PG8_SCHED;
            PG8_LDB(B1, 0, 1); PG8_STAGE(PG8_SB(0, 0), b2, voffB);
            PG8_BAR; PG8_WAIT_L(0); PG8_MMA(0, 1, At, B1); PG8_BAR;
            PG8_LDA(At, 0, 1); PG8_STAGE(PG8_SA(0, 0), a2, voffA);
            PG8_BAR; PG8_WAIT_L(0); PG8_MMA(1, 0, At, B0); PG8_BAR; PG8_SCHED;
            PG8_STAGE(PG8_SB(0, 1), b2 + hstep, voffB);
            PG8_WAIT_V(6); PG8_BAR; PG8_MMA(1, 1, At, B1); PG8_BAR;
            PG8_LDB(B0, 1, 0); PG8_SCHED; PG8_LDA(At, 1, 0); PG8_STAGE(PG8_SA(0, 1), a2 + hstep, voffA);
            PG8_WAIT_L(8); PG8_BAR; PG8_WAIT_L(0); PG8_MMA(0, 0, At, B0); PG8_BAR; PG8_SCHED;
            PG8_LDB(B1, 1, 1); PG8_STAGE(PG8_SB(1, 0), b3, voffB);
            PG8_BAR; PG8_WAIT_L(0); PG8_MMA(0, 1, At, B1); PG8_BAR;
            PG8_LDA(At, 1, 1); PG8_STAGE(PG8_SA(1, 0), a3, voffA);
            PG8_BAR; PG8_WAIT_L(0); PG8_MMA(1, 0, At, B0); PG8_BAR; PG8_SCHED;
            PG8_STAGE(PG8_SB(1, 1), b3 + hstep, voffB);
            PG8_WAIT_V(6); PG8_BAR; PG8_MMA(1, 1, At, B1); PG8_BAR;
            }
        }
        if constexpr (ALIGN_EPI) { if (wr == 0) PG8_BAR; }
        if constexpr (!Epi::AFTER_DRAIN) { E(acc, cur, wr, wc, fr, fq); S.done(cur); }
        if (!has_next) break;
#pragma unroll
        for (int a = 0; a < 2; ++a)
#pragma unroll
            for (int b = 0; b < 2; ++b)
#pragma unroll
                for (int m = 0; m < 4; ++m)
#pragma unroll
                    for (int n = 0; n < 2; ++n) acc[a][b][m][n] = (f32x4){0.f, 0.f, 0.f, 0.f};
        cur = nxt; cA = nA; cB = nB; ++ui;
        if constexpr (ALIGN_EPI) { if (wr == 1) PG8_BAR; }
    }
    PG8_WAIT_V(0);
    if constexpr (!ALIGN_EPI) { if (wr == 0) PG8_BAR; }
    PG8_BAR;
#undef PG8_SA
#undef PG8_SB
#undef PG8_STAGE
#undef PG8_LDA
#undef PG8_LDB
#undef PG8_MMA
#undef PG8_WAIT_V
#undef PG8_WAIT_L
#undef PG8_BAR
#undef PG8_SCHED
}
}

__device__ __forceinline__ void transpose_item(const float* W, int K, int N, bf16* WT, LAS float* scr, int item, int lane) {
    const int nblk = N / 32, kb = item / nblk, nb = item % nblk, k0 = 64 * kb, n0 = 32 * nb;
#pragma unroll 8
    for (int i = 0; i < 32; ++i) { const int kk = 2 * i + (lane >> 5); scr[kk * 33 + (lane & 31)] = W[(size_t)(k0 + kk) * N + n0 + (lane & 31)]; }
    asm volatile("s_waitcnt lgkmcnt(0)" ::: "memory");
    const int c = lane & 7;
#pragma unroll
    for (int j = 0; j < 4; ++j) { const int n = (lane >> 3) + 8 * j; const LAS float* s = scr + (8 * c) * 33 + n;
        uint4 o; o.x = pk2(s[0 * 33], s[1 * 33]); o.y = pk2(s[2 * 33], s[3 * 33]); o.z = pk2(s[4 * 33], s[5 * 33]); o.w = pk2(s[6 * 33], s[7 * 33]);
        *(uint4*)(WT + (size_t)(n0 + n) * K + k0 + 8 * c) = o; }
    asm volatile("s_waitcnt lgkmcnt(0)" ::: "memory");
}

__device__ __forceinline__ float wsum(float v) {
#pragma unroll
  for (int o = 32; o > 0; o >>= 1) v += __shfl_xor(v, o, 64);
  return v;
}
__device__ __forceinline__ float wmaxf(float v) {
#pragma unroll
  for (int o = 32; o > 0; o >>= 1) v = fmaxf(v, __shfl_xor(v, o, 64));
  return v;
}
__device__ __forceinline__ float sigmoidf_(float x) { return 1.0f / (1.0f + expf(-x)); }
__device__ __forceinline__ float gelu_tanh(float x) {
  return 0.5f * x * (1.0f + tanhf(0.7978845608028654f * (x + 0.044715f * x * x * x)));
}

template <bool BF16OUT>
__device__ __forceinline__ void rms_rows(const float* src, const float* g, void* dstv, int rows) {
  const int tid_ = opaque_tid();
  const int lane = tid_ & 63;
  const int gw = blockIdx.x * NWAVES + (tid_ >> 6);
  const int nw = gridDim.x * NWAVES;
  for (int r = gw; r < rows; r += nw) {
    const float4* s4 = (const float4*)(src + (size_t)r * DM);
    float4 v[4];
    float ss = 0.f;
#pragma unroll
    for (int i = 0; i < 4; i++) {
      v[i] = s4[lane + i * 64];
      ss += v[i].x * v[i].x + v[i].y * v[i].y + v[i].z * v[i].z + v[i].w * v[i].w;
    }
    ss = wsum(ss);
    const float rstd = rsqrtf(ss * (1.0f / DM) + EPSF);
    const float4* g4 = (const float4*)g;
#pragma unroll
    for (int i = 0; i < 4; i++) {
      float4 gg = g4[lane + i * 64];
      float4 o;
      o.x = v[i].x * rstd * gg.x; o.y = v[i].y * rstd * gg.y;
      o.z = v[i].z * rstd * gg.z; o.w = v[i].w * rstd * gg.w;
      if (BF16OUT) {
        uint2 pk; pk.x = pk2(o.x, o.y); pk.y = pk2(o.z, o.w);
        ((uint2*)((bf16*)dstv + (size_t)r * DM))[lane + i * 64] = pk;
      } else {
        ((float4*)((float*)dstv + (size_t)r * DM))[lane + i * 64] = o;
      }
    }
  }
}

__device__ __forceinline__ void ssm_params(const Params& p, float* ssmp_all) {
  const int tid_ = opaque_tid();
  const float* in8 = karg_in(8); const float* in9 = karg_in(9); const float* in10 = karg_in(10);
  const float* in11 = karg_in(11); const float* in12 = karg_in(12);
  const int gt = blockIdx.x * blockDim.x + tid_;
  const int nth = gridDim.x * blockDim.x;
  for (int i = gt; i < 2 * 16 * 64; i += nth) {
    const int l = i / 1024, gp = i % 1024, g = gp / 64;
    float* sp = ssmp_all + (size_t)l * SSMP_PER_LAYER;
    const float lre = fminf(in8[l * 1024 + gp], -1e-4f);
    const float lim = in9[l * 1024 + gp];
    const float dt = expf(in10[l * 16 + g]);
    const float er = expf(lre * dt);
    float sn, cs;
    sincosf(lim * dt, &sn, &cs);
    const float br = er * cs, bi = er * sn;
    sp[gp * 2 + 0] = br;
    sp[gp * 2 + 1] = bi;
    float cr = br, ci = bi;
#pragma unroll
    for (int s = 0; s < 6; s++) {
      const float nr = cr * cr - ci * ci, ni = 2.f * cr * ci;
      cr = nr; ci = ni;
    }
    sp[2048 + gp * 2 + 0] = cr;
    sp[2048 + gp * 2 + 1] = ci;
    const float nr = br - 1.0f, ni = bi;
    const float den = lre * lre + lim * lim;
    const float fr = (nr * lre + ni * lim) / den;
    const float fi = (ni * lre - nr * lim) / den;
    for (int h = 0; h < 16; h++) {
      const float bre = in11[((size_t)l * 1024 + gp) * 16 + h];
      const float bim = in12[((size_t)l * 1024 + gp) * 16 + h];
      sp[4096 + (gp * 16 + h) * 2 + 0] = fr * bre - fi * bim;
      sp[4096 + (gp * 16 + h) * 2 + 1] = fr * bim + fi * bre;
    }
  }
}

__device__ __forceinline__ void conv_phase(const Params& p, int l, const bf16* proj, bf16* y) {
  const int tid_ = opaque_tid();
  const int lane = tid_ & 63;
  const int gw = blockIdx.x * NWAVES + (tid_ >> 6);
  const int nw = gridDim.x * NWAVES;
  const float* cw = karg_in(4) + (size_t)l * 31 * 256;
  const float4 cb = ((const float4*)(karg_in(5) + l * 256))[lane];
  const float4 lg = ((const float4*)(karg_in(6) + l * 256))[lane];
  const float4 lb = ((const float4*)(karg_in(7) + l * 256))[lane];
  const float4 gg = ((const float4*)(karg_in(18) + l * 1024))[lane];
  for (int tok = gw; tok < NT; tok += nw) {
    const int t = tok & (SEQ - 1);
    float4 acc = cb;
    for (int j = 0; j < 31; j++) {
      const int tt = t - 30 + j;
      if (tt >= 0) {
        const bf16* row = proj + (size_t)(tok - 30 + j) * DIN;
        const uint2 vp = ((const uint2*)row)[lane];
        const uint2 gp = ((const uint2*)(row + 256))[lane];
        const float4 v = make_float4(bf_lo(vp.x), bf_hi(vp.x), bf_lo(vp.y), bf_hi(vp.y));
        const float4 gt = make_float4(bf_lo(gp.x), bf_hi(gp.x), bf_lo(gp.y), bf_hi(gp.y));
        const float4 w = ((const float4*)(cw + j * 256))[lane];
        acc.x += v.x * sigmoidf_(gt.x) * w.x;
        acc.y += v.y * sigmoidf_(gt.y) * w.y;
        acc.z += v.z * sigmoidf_(gt.z) * w.z;
        acc.w += v.w * sigmoidf_(gt.w) * w.w;
      }
    }
    const float mean = wsum(acc.x + acc.y + acc.z + acc.w) * (1.0f / 256.f);
    const float dx = acc.x - mean, dy = acc.y - mean, dz = acc.z - mean, dw = acc.w - mean;
    const float var = wsum(dx * dx + dy * dy + dz * dz + dw * dw) * (1.0f / 256.f);
    const float rs = rsqrtf(var + EPSF);
    float4 s;
    s.x = dx * rs * lg.x + lb.x; s.y = dy * rs * lg.y + lb.y;
    s.z = dz * rs * lg.z + lb.z; s.w = dw * rs * lg.w + lb.w;
    s.x = s.x * sigmoidf_(s.x); s.y = s.y * sigmoidf_(s.y);
    s.z = s.z * sigmoidf_(s.z); s.w = s.w * sigmoidf_(s.w);
    const float ss = wsum(s.x * s.x + s.y * s.y + s.z * s.z + s.w * s.w) * (1.0f / 256.f);
    const float r2 = rsqrtf(ss + EPSF);
    float4 o;
    o.x = s.x * r2 * gg.x; o.y = s.y * r2 * gg.y; o.z = s.z * r2 * gg.z; o.w = s.w * r2 * gg.w;
    { uint2 pk; pk.x = pk2(o.x, o.y); pk.y = pk2(o.z, o.w); ((uint2*)(y + (size_t)tok * DM))[lane] = pk; }
  }
}

typedef short bf16x8_t __attribute__((ext_vector_type(8)));
typedef float f32x16_t __attribute__((ext_vector_type(16)));
__device__ __forceinline__ void attn_phase(const Params& p, int l, const bf16* proj, bf16* y, LAS float* smem) {
  const int tid = opaque_tid(), lane = tid & 63, wave = tid >> 6;
  const int n = lane & 31, hh = lane >> 5;
  const float* gg = karg_in(18) + l * 1024 + 256 + wave * 64;
  const float g0 = gg[n], g1 = gg[32 + n];
  LAS float* ssq = smem;
  LAS float* rstd = smem + 256;
  for (int item = blockIdx.x; item < 4 * 128; item += gridDim.x) {
    const int b = item >> 7, q0 = (item & 127) * 32;
    const size_t tokb = (size_t)b * SEQ;
    bf16x8_t qf[4];
    {
      const bf16* qrow = proj + (tokb + q0 + n) * DIN + 512 + wave * 64 + 8 * hh;
#pragma unroll
      for (int ks = 0; ks < 4; ks++) qf[ks] = *(const bf16x8_t*)(qrow + 16 * ks);
    }
    f32x16_t o0, o1;
#pragma unroll
    for (int r = 0; r < 16; r++) { o0[r] = 0.f; o1[r] = 0.f; }
    float R = 0.f;
    for (int kt = q0; kt >= 0; kt -= 32) {
      bf16x8_t kf[4];
      {
        const bf16* krow = proj + (tokb + kt + n) * DIN + 1024 + wave * 64 + 8 * hh;
#pragma unroll
        for (int ks = 0; ks < 4; ks++) kf[ks] = *(const bf16x8_t*)(krow + 16 * ks);
      }
      bf16x8_t vf0[2], vf1[2];
      {
        const bf16* vb = proj + (tokb + kt + 4 * hh) * DIN + 1536 + wave * 64 + n;
#pragma unroll
        for (int s = 0; s < 2; s++)
#pragma unroll
          for (int j = 0; j < 8; j++) {
            const int key = 16 * s + 8 * (j >> 2) + (j & 3);
            vf0[s][j] = (short)vb[(size_t)key * DIN];
            vf1[s][j] = (short)vb[(size_t)key * DIN + 32];
          }
      }
      f32x16_t sacc;
#pragma unroll
      for (int r = 0; r < 16; r++) sacc[r] = 0.f;
      __builtin_amdgcn_sched_barrier(0); asm volatile("s_nop 15\n\ts_nop 15" ::: "memory"); __builtin_amdgcn_sched_barrier(0);
#pragma unroll
      for (int ks = 0; ks < 4; ks++) sacc = __builtin_amdgcn_mfma_f32_32x32x16_bf16(kf[ks], qf[ks], sacc, 0, 0, 0);
      __builtin_amdgcn_sched_barrier(0); asm volatile("s_nop 15\n\ts_nop 15" ::: "memory"); __builtin_amdgcn_sched_barrier(0);
      float lst[16], lsz[16];
      const bool diag = (kt == q0);
#pragma unroll
      for (int r = 0; r < 16; r++) {
        const float z = sacc[r] * 0.125f;
        const float sp = __logf(1.0f + __expf(-fabsf(z)));
        float a = fminf(z, 0.f) - sp;
        float c = -(fmaxf(z, 0.f) + sp);
        if (diag) {
          const int key = (r & 3) + 8 * (r >> 2) + 4 * hh;
          if (key >= n) { a = -1.0e30f; c = 0.f; }
        }
        lsz[r] = a; lst[r] = c;
      }
      float Gs[4], Gp[4];
#pragma unroll
      for (int g = 0; g < 4; g++) {
        Gs[g] = (lst[4 * g] + lst[4 * g + 1]) + (lst[4 * g + 2] + lst[4 * g + 3]);
        Gp[g] = __shfl_xor(Gs[g], 32, 64);
      }
      float carry[4];
      {
        float after = R;
#pragma unroll
        for (int g = 3; g >= 0; g--) {
          carry[g] = after + (hh ? 0.f : Gp[g]);
          after += Gs[g] + Gp[g];
        }
        R = after;
      }
      bf16x8_t pf[2];
#pragma unroll
      for (int g = 0; g < 4; g++) {
        float run = carry[g];
        float a3 = __expf(lsz[4 * g + 3] + run); run += lst[4 * g + 3];
        float a2 = __expf(lsz[4 * g + 2] + run); run += lst[4 * g + 2];
        float a1 = __expf(lsz[4 * g + 1] + run); run += lst[4 * g + 1];
        float a0 = __expf(lsz[4 * g + 0] + run);
        const int s = g >> 1, jb = (g & 1) * 4;
        pf[s][jb + 0] = (short)f2bf(a0); pf[s][jb + 1] = (short)f2bf(a1);
        pf[s][jb + 2] = (short)f2bf(a2); pf[s][jb + 3] = (short)f2bf(a3);
      }
      __builtin_amdgcn_sched_barrier(0); asm volatile("s_nop 15\n\ts_nop 15" ::: "memory"); __builtin_amdgcn_sched_barrier(0);
#pragma unroll
      for (int s = 0; s < 2; s++) {
        o0 = __builtin_amdgcn_mfma_f32_32x32x16_bf16(pf[s], vf0[s], o0, 0, 0, 0);
        o1 = __builtin_amdgcn_mfma_f32_32x32x16_bf16(pf[s], vf1[s], o1, 0, 0, 0);
      }
      __builtin_amdgcn_sched_barrier(0); asm volatile("s_nop 15\n\ts_nop 15" ::: "memory"); __builtin_amdgcn_sched_barrier(0);
      if (__all(R < -110.f)) break;
    }
    float sq[16];
#pragma unroll
    for (int r = 0; r < 16; r++) {
      float v = o0[r] * o0[r] + o1[r] * o1[r];
#pragma unroll
      for (int o = 16; o > 0; o >>= 1) v += __shfl_xor(v, o, 64);
      sq[r] = v;
    }
    __syncthreads();
    if (n == 0) {
#pragma unroll
      for (int r = 0; r < 16; r++) ssq[wave * 32 + (r & 3) + 8 * (r >> 2) + 4 * hh] = sq[r];
    }
    __syncthreads();
    if (tid < 32) {
      float t = 0.f;
#pragma unroll
      for (int w = 0; w < 8; w++) t += ssq[w * 32 + tid];
      rstd[tid] = rsqrtf(t * (1.0f / 512.f) + EPSF);
    }
    __syncthreads();
#pragma unroll
    for (int r = 0; r < 16; r++) {
      const int qi = (r & 3) + 8 * (r >> 2) + 4 * hh;
      const float rs = rstd[qi];
      bf16* yr = y + (tokb + q0 + qi) * DM + 256 + wave * 64 + n;
      yr[0] = (bf16)f2bf(o0[r] * rs * g0);
      yr[32] = (bf16)f2bf(o1[r] * rs * g1);
    }
  }
}

__device__ __forceinline__ void ssm_chunk_end(const float* ssmp, const bf16* proj, float* ssmE) {
  const int tid_ = opaque_tid();
  const int lane = tid_ & 63;
  const int gw = blockIdx.x * NWAVES + (tid_ >> 6);
  const int nw = gridDim.x * NWAVES;
  for (int it = gw; it < 4 * 64 * 16; it += nw) {
    const int g = it & 15, c = (it >> 4) & 63, b = it >> 10;
    const int gp = g * 64 + lane;
    const float lbr = ssmp[gp * 2], lbi = ssmp[gp * 2 + 1];
    float bbr[16], bbi[16];
#pragma unroll
    for (int h = 0; h < 16; h++) {
      bbr[h] = ssmp[4096 + (gp * 16 + h) * 2];
      bbi[h] = ssmp[4096 + (gp * 16 + h) * 2 + 1];
    }
    float xr = 0.f, xi = 0.f;
    for (int tt = 0; tt < 64; tt++) {
      float u[16];
      {
        const uint4* up = (const uint4*)(proj + (size_t)(b * SEQ + c * 64 + tt) * DIN + 2048 + g * 16);
        const uint4 ua = up[0], ub = up[1];
        u[0] = bf_lo(ua.x); u[1] = bf_hi(ua.x); u[2] = bf_lo(ua.y); u[3] = bf_hi(ua.y);
        u[4] = bf_lo(ua.z); u[5] = bf_hi(ua.z); u[6] = bf_lo(ua.w); u[7] = bf_hi(ua.w);
        u[8] = bf_lo(ub.x); u[9] = bf_hi(ub.x); u[10] = bf_lo(ub.y); u[11] = bf_hi(ub.y);
        u[12] = bf_lo(ub.z); u[13] = bf_hi(ub.z); u[14] = bf_lo(ub.w); u[15] = bf_hi(ub.w);
      }
      float br = 0.f, bi = 0.f;
#pragma unroll
      for (int h = 0; h < 16; h++) {
        const float uh = u[h];
        br += bbr[h] * uh;
        bi += bbi[h] * uh;
      }
      const float nr = lbr * xr - lbi * xi + br;
      const float ni = lbr * xi + lbi * xr + bi;
      xr = nr; xi = ni;
    }
    float* e = ssmE + ((size_t)((b * 64 + c) * 16 + g) * 64 + lane) * 2;
    e[0] = xr; e[1] = xi;
  }
}

__device__ __forceinline__ void ssm_finish(const Params& p, int l, const float* ssmp, const bf16* proj,
                           const float* ssmE, bf16* y, LAS float* smem) {
  LAS float (*Yt)[256] = (LAS float (*)[256])smem;
  const int tid = opaque_tid(), lane = tid & 63, wave = tid >> 6;
  const float* cre = karg_in(13) + (size_t)l * 16 * 16 * 64;
  const float* cim = karg_in(14) + (size_t)l * 16 * 16 * 64;
  const float* dsk = karg_in(15) + l * 256;
  const float* glw = karg_in(16) + (size_t)l * 256 * 256;
  const float* glb = karg_in(17) + l * 256;
  const float* gg = karg_in(18) + l * 1024 + 768;
  for (int it = blockIdx.x; it < 256; it += gridDim.x) {
    const int b = it >> 6, c = it & 63;
    __syncthreads();
    for (int gi = 0; gi < 2; gi++) {
      const int g = wave + gi * 8;
      const int gp = g * 64 + lane;
      const float lbr = ssmp[gp * 2], lbi = ssmp[gp * 2 + 1];
      const float lcr = ssmp[2048 + gp * 2], lci = ssmp[2048 + gp * 2 + 1];
      float bbr[16], bbi[16], ccr[16], cci[16];
#pragma unroll
      for (int h = 0; h < 16; h++) {
        bbr[h] = ssmp[4096 + (gp * 16 + h) * 2];
        bbi[h] = ssmp[4096 + (gp * 16 + h) * 2 + 1];
        ccr[h] = cre[(g * 16 + h) * 64 + lane];
        cci[h] = cim[(g * 16 + h) * 64 + lane];
      }
      float xr = 0.f, xi = 0.f;
      for (int cc = 0; cc < c; cc++) {
        const float* e = ssmE + ((size_t)((b * 64 + cc) * 16 + g) * 64 + lane) * 2;
        const float er = e[0], ei = e[1];
        const float nr = lcr * xr - lci * xi + er;
        const float ni = lcr * xi + lci * xr + ei;
        xr = nr; xi = ni;
      }
      const int hq = ((lane >> 5) & 1) * 8 + ((lane >> 4) & 1) * 4 + ((lane >> 3) & 1) * 2 + ((lane >> 2) & 1);
      const float dh = dsk[g * 16 + hq];
      for (int tt = 0; tt < 64; tt++) {
        float u[16];
        {
          const uint4* up = (const uint4*)(proj + (size_t)(b * SEQ + c * 64 + tt) * DIN + 2048 + g * 16);
          const uint4 ua = up[0], ub = up[1];
          u[0] = bf_lo(ua.x); u[1] = bf_hi(ua.x); u[2] = bf_lo(ua.y); u[3] = bf_hi(ua.y);
          u[4] = bf_lo(ua.z); u[5] = bf_hi(ua.z); u[6] = bf_lo(ua.w); u[7] = bf_hi(ua.w);
          u[8] = bf_lo(ub.x); u[9] = bf_hi(ub.x); u[10] = bf_lo(ub.y); u[11] = bf_hi(ub.y);
          u[12] = bf_lo(ub.z); u[13] = bf_hi(ub.z); u[14] = bf_lo(ub.w); u[15] = bf_hi(ub.w);
        }
        float br = 0.f, bi = 0.f;
#pragma unroll
        for (int h = 0; h < 16; h++) {
          const float uh = u[h];
          br += bbr[h] * uh;
          bi += bbi[h] * uh;
        }
        const float nr = lbr * xr - lbi * xi + br;
        const float ni = lbr * xi + lbi * xr + bi;
        xr = nr; xi = ni;
        float v[16];
#pragma unroll
        for (int h = 0; h < 16; h++) v[h] = xr * ccr[h] - xi * cci[h];
        float v8[8], v4[4], v2[2], v1;
        {
          const bool hi = (lane & 32) != 0;
#pragma unroll
          for (int i = 0; i < 8; i++) {
            const float send = hi ? v[i] : v[i + 8];
            const float keep = hi ? v[i + 8] : v[i];
            v8[i] = keep + __shfl_xor(send, 32, 64);
          }
        }
        {
          const bool hi = (lane & 16) != 0;
#pragma unroll
          for (int i = 0; i < 4; i++) {
            const float send = hi ? v8[i] : v8[i + 4];
            const float keep = hi ? v8[i + 4] : v8[i];
            v4[i] = keep + __shfl_xor(send, 16, 64);
          }
        }
        {
          const bool hi = (lane & 8) != 0;
#pragma unroll
          for (int i = 0; i < 2; i++) {
            const float send = hi ? v4[i] : v4[i + 2];
            const float keep = hi ? v4[i + 2] : v4[i];
            v2[i] = keep + __shfl_xor(send, 8, 64);
          }
        }
        {
          const bool hi = (lane & 4) != 0;
          const float send = hi ? v2[0] : v2[1];
          const float keep = hi ? v2[1] : v2[0];
          v1 = keep + __shfl_xor(send, 4, 64);
        }
        v1 += __shfl_xor(v1, 2, 64);
        v1 += __shfl_xor(v1, 1, 64);
        if ((lane & 3) == 0) {
          float uq = u[0];
#pragma unroll
          for (int h = 1; h < 16; h++) uq = (hq == h) ? u[h] : uq;
          const float yy = v1 + dh * uq;
          Yt[tt][g * 16 + hq] = gelu_tanh(yy);
        }
      }
    }
    __syncthreads();
    {
      const int j = tid & 255, th = tid >> 8;
      const float bj = glb[j];
      for (int t0 = th * 32; t0 < th * 32 + 32; t0 += 8) {
        float acc[8];
#pragma unroll
        for (int i = 0; i < 8; i++) acc[i] = 0.f;
        for (int k = 0; k < 256; k++) {
          const float w = glw[k * 256 + j];
#pragma unroll
          for (int i = 0; i < 8; i++) acc[i] += Yt[t0 + i][k] * w;
        }
        __syncthreads();
#pragma unroll
        for (int i = 0; i < 8; i++) {
          const float yv = Yt[t0 + i][j];
          Yt[t0 + i][j] = yv * sigmoidf_(acc[i] + bj);
        }
      }
    }
    __syncthreads();
    for (int i = 0; i < 8; i++) {
      const int tt = wave * 8 + i;
      const float4 v = *(const float4*)&Yt[tt][lane * 4];
      const float ss = wsum(v.x * v.x + v.y * v.y + v.z * v.z + v.w * v.w) * (1.0f / 256.f);
      const float rs = rsqrtf(ss + EPSF);
      const float4 g4 = ((const float4*)gg)[lane];
      uint2 pk;
      pk.x = pk2(v.x * rs * g4.x, v.y * rs * g4.y);
      pk.y = pk2(v.z * rs * g4.z, v.w * rs * g4.w);
      ((uint2*)(y + (size_t)(b * SEQ + c * 64 + tt) * DM + 768))[lane] = pk;
    }
  }
}

__device__ __forceinline__ void memattn_phase(const float* q, const float* kv, bf16* o) {
  const int tid_ = opaque_tid();
  const int lane = tid_ & 63;
  const int gw = blockIdx.x * NWAVES + (tid_ >> 6);
  const int nw = gridDim.x * NWAVES;
  for (int it = gw; it < NT * 4; it += nw) {
    const int tok = it >> 2, h = it & 3, b = tok >> 12;
    const float4 q4 = ((const float4*)(q + (size_t)tok * DM + h * 256))[lane];
    const float* kb = kv + (size_t)(b * NMEM) * 2048 + h * 256;
    float sc[4];
#pragma unroll
    for (int mm = 0; mm < 4; mm++) {
      float mine = 0.f;
      for (int m2 = 0; m2 < 64; m2++) {
        const float4 k4 = ((const float4*)(kb + (size_t)(mm * 64 + m2) * 2048))[lane];
        const float s = wsum(q4.x * k4.x + q4.y * k4.y + q4.z * k4.z + q4.w * k4.w) * 0.0625f;
        if (m2 == lane) mine = s;
      }
      sc[mm] = mine;
    }
    const float mx = wmaxf(fmaxf(fmaxf(sc[0], sc[1]), fmaxf(sc[2], sc[3])));
    float pr[4];
    float sum = 0.f;
#pragma unroll
    for (int mm = 0; mm < 4; mm++) { pr[mm] = expf(sc[mm] - mx); sum += pr[mm]; }
    sum = wsum(sum);
    const float inv = 1.0f / sum;
    float4 acc = make_float4(0.f, 0.f, 0.f, 0.f);
#pragma unroll
    for (int mm = 0; mm < 4; mm++) {
      const float pm_all = pr[mm] * inv;
      for (int m2 = 0; m2 < 64; m2++) {
        const float pm = __shfl(pm_all, m2, 64);
        const float4 v4 = ((const float4*)(kb + (size_t)(mm * 64 + m2) * 2048 + 1024))[lane];
        acc.x += pm * v4.x; acc.y += pm * v4.y; acc.z += pm * v4.z; acc.w += pm * v4.w;
      }
    }
    { uint2 pk; pk.x = pk2(acc.x, acc.y); pk.y = pk2(acc.z, acc.w); ((uint2*)(o + (size_t)tok * DM + h * 256))[lane] = pk; }
  }
}

__device__ __forceinline__ void wave_argmax(float& v, int& idx) {
#pragma unroll
  for (int o = 32; o > 0; o >>= 1) {
    const float ov = __shfl_xor(v, o, 64);
    const int oi = __shfl_xor(idx, o, 64);
    if (ov > v || (ov == v && oi < idx)) { v = ov; idx = oi; }
  }
}

__device__ __forceinline__ void peer_topk(const float* pq, const float* subk, int* ids, float* gates, LAS float* smem) {
  const int tid_ = opaque_tid();
  const int lane = tid_ & 63, wave = tid_ >> 6;
  const int gw = blockIdx.x * NWAVES + wave;
  const int nw = gridDim.x * NWAVES;
  LAS float* qs = smem + wave * 512;
  LAS float* ts = qs + 256;
  LAS int* ti = (LAS int*)(qs + 256 + 32);
  LAS float* bs = qs + 256 + 64;
  LAS int* be = (LAS int*)(qs + 256 + 80);
  const float NEG = -3.0e38f;
  for (int it = gw; it < NT * 8; it += nw) {
    const int tok = it >> 3, h = it & 7;
    ((float4*)qs)[lane] = ((const float4*)(pq + (size_t)tok * 2048 + h * 256))[lane];
    __builtin_amdgcn_wave_barrier();
    for (int half = 0; half < 2; half++) {
      const float* k0p = subk + ((size_t)((h * 2 + half) * 128 + lane)) * 128;
      const float* k1p = k0p + 64 * 128;
      float s0 = 0.f, s1 = 0.f;
      for (int d = 0; d < 128; d += 4) {
        const float4 qv = *(const float4*)(qs + half * 128 + d);
        const float4 a = *(const float4*)(k0p + d);
        const float4 c = *(const float4*)(k1p + d);
        s0 += qv.x * a.x + qv.y * a.y + qv.z * a.z + qv.w * a.w;
        s1 += qv.x * c.x + qv.y * c.y + qv.z * c.z + qv.w * c.w;
      }
      for (int r = 0; r < 16; r++) {
        float v; int idx;
        if (s0 >= s1) { v = s0; idx = lane; } else { v = s1; idx = lane + 64; }
        wave_argmax(v, idx);
        if (lane == 0) { ts[half * 16 + r] = v; ti[half * 16 + r] = idx; }
        if (idx == lane) s0 = NEG;
        if (idx == lane + 64) s1 = NEG;
      }
    }
    __builtin_amdgcn_wave_barrier();
    float c0, c1, c2, c3;
    {
      const int a = lane >> 2, bb = (lane & 3) * 4;
      const float ta = ts[a];
      c0 = ta + ts[16 + bb + 0];
      c1 = ta + ts[16 + bb + 1];
      c2 = ta + ts[16 + bb + 2];
      c3 = ta + ts[16 + bb + 3];
    }
    for (int r = 0; r < 16; r++) {
      float v = c0; int idx = lane * 4;
      if (c1 > v) { v = c1; idx = lane * 4 + 1; }
      if (c2 > v) { v = c2; idx = lane * 4 + 2; }
      if (c3 > v) { v = c3; idx = lane * 4 + 3; }
      wave_argmax(v, idx);
      if (lane == 0) {
        bs[r] = v;
        be[r] = ti[idx >> 4] * 128 + ti[16 + (idx & 15)];
      }
      if ((idx >> 2) == lane) {
        const int j = idx & 3;
        if (j == 0) c0 = NEG; else if (j == 1) c1 = NEG; else if (j == 2) c2 = NEG; else c3 = NEG;
      }
    }
    __builtin_amdgcn_wave_barrier();
    {
      const float b0 = bs[0];
      float e = (lane < 16) ? expf(bs[lane & 15] - b0) : 0.f;
      const float sum = wsum(e);
      if (lane < 16) {
        ids[(size_t)tok * 128 + h * 16 + lane] = be[lane];
        gates[(size_t)tok * 128 + h * 16 + lane] = e / sum;
      }
    }
    __builtin_amdgcn_wave_barrier();
  }
}

__device__ __forceinline__ void peer_gather(const bf16* xn, const float* utab, const float* vtab,
                            const int* ids, const float* gates, float* xw, LAS float* smem) {
  const int tid = opaque_tid(), lane = tid & 63, wave = tid >> 6;
  LAS float* red = smem;
  for (int tok = blockIdx.x; tok < NT; tok += gridDim.x) {
    float4 xr[4], acc[4];
#pragma unroll
    for (int i = 0; i < 4; i++) {
      const uint2 pk = ((const uint2*)(xn + (size_t)tok * DM))[lane + i * 64];
      xr[i] = make_float4(bf_lo(pk.x), bf_hi(pk.x), bf_lo(pk.y), bf_hi(pk.y));
      acc[i] = make_float4(0.f, 0.f, 0.f, 0.f);
    }
    for (int e = wave * 16; e < wave * 16 + 16; e++) {
      const int id = ids[(size_t)tok * 128 + e];
      const float gt = gates[(size_t)tok * 128 + e];
      const float4* ur = (const float4*)(utab + (size_t)id * DM);
      const float4* vr = (const float4*)(vtab + (size_t)id * DM);
      float d = 0.f;
      float4 vv[4];
#pragma unroll
      for (int i = 0; i < 4; i++) {
        const float4 u4 = ur[lane + i * 64];
        vv[i] = vr[lane + i * 64];
        d += u4.x * xr[i].x + u4.y * xr[i].y + u4.z * xr[i].z + u4.w * xr[i].w;
      }
      d = wsum(d);
      const float w = gt * gelu_tanh(d);
#pragma unroll
      for (int i = 0; i < 4; i++) {
        acc[i].x += w * vv[i].x; acc[i].y += w * vv[i].y;
        acc[i].z += w * vv[i].z; acc[i].w += w * vv[i].w;
      }
    }
    __syncthreads();
#pragma unroll
    for (int i = 0; i < 4; i++) ((float4*)(red + wave * 1024))[lane + i * 64] = acc[i];
    __syncthreads();
    {
      float2 s = ((const float2*)red)[tid];
#pragma unroll
      for (int w = 1; w < 8; w++) {
        const float2 t2 = ((const float2*)(red + w * 1024))[tid];
        s.x += t2.x; s.y += t2.y;
      }
      float2* xp = (float2*)(xw + (size_t)tok * DM) + tid;
      float2 x2 = *xp;
      x2.x += s.x; x2.y += s.y;
      *xp = x2;
    }
  }
}

__device__ __forceinline__ void prologue_transposes(const Params& p, unsigned char* ws, LAS unsigned char* lds) {
  const int tid_ = opaque_tid();
  const int lane = tid_ & 63, wave = tid_ >> 6;
  LAS float* scr = (LAS float*)(lds + wave * 16384);
  const int gw = blockIdx.x * NWAVES + wave, NGW = gridDim.x * NWAVES;
  constexpr int I_IN = (DM / 64) * (DIN / 32), I_SQ = (DM / 64) * (DM / 32), I_2K = (DM / 64) * (2048 / 32);
  constexpr int PER_LAYER = I_IN + 3 * I_SQ + 2 * I_2K;
  const float* w3 = karg_in(3); const float* w19 = karg_in(19); const float* w22 = karg_in(22);
  const float* w23 = karg_in(23); const float* w24 = karg_in(24); const float* w26 = karg_in(26);
  for (int it = gw; it < 2 * PER_LAYER; it += NGW) {
    const int l = it / PER_LAYER;
    int r = it % PER_LAYER;
    unsigned char* wl = ws + WS_WT + (size_t)l * WT_LAYER;
    if (r < I_IN) { transpose_item(w3 + (size_t)l * DM * DIN, DM, DIN, (bf16*)(wl + WT_IN), scr, r, lane); continue; } r -= I_IN;
    if (r < I_SQ) { transpose_item(w19 + (size_t)l * DM * DM, DM, DM, (bf16*)(wl + WT_OUT), scr, r, lane); continue; } r -= I_SQ;
    if (r < I_SQ) { transpose_item(w22 + (size_t)l * DM * DM, DM, DM, (bf16*)(wl + WT_MQ), scr, r, lane); continue; } r -= I_SQ;
    if (r < I_2K) { transpose_item(w23 + (size_t)l * DM * 2048, DM, 2048, (bf16*)(wl + WT_MKV), scr, r, lane); continue; } r -= I_2K;
    if (r < I_SQ) { transpose_item(w24 + (size_t)l * DM * DM, DM, DM, (bf16*)(wl + WT_MO), scr, r, lane); continue; } r -= I_SQ;
    transpose_item(w26 + (size_t)l * DM * 2048, DM, 2048, (bf16*)(wl + WT_PQ), scr, r, lane);
  }
}

template <class T> __device__ __forceinline__ T* opq(T* p) { asm volatile("" : "+s"(p)); return p; }
#define GEMM_F32(Aptr, Wt, Cptr, Rptr, M_, N_) do { \
    pg8::Gemm g_{opq((const bf16*)(Aptr)), opq((const bf16*)(Wt)), (M_), (N_), DM}; pg8::StaticOrder S_; S_.init((M_), (N_), (int)gridDim.x, (int)blockIdx.x); \
    pg8::EpiF32R E_{opq((float*)(Cptr)), opq((const float*)(Rptr)), (N_)}; \
    pg8::gemm_phase<pg8::EpiF32R, pg8::StaticOrder, true, true>(ldsl, g_, S_, E_); } while (0)
#define GEMM_BF16(Aptr, Wt, Optr, M_, N_) do { \
    pg8::Gemm g_{opq((const bf16*)(Aptr)), opq((const bf16*)(Wt)), (M_), (N_), DM}; pg8::StaticOrder S_; S_.init((M_), (N_), (int)gridDim.x, (int)blockIdx.x); \
    pg8::EpiBf16 E_{opq((bf16*)(Optr)), (N_)}; \
    pg8::gemm_phase<pg8::EpiBf16, pg8::StaticOrder, true, true>(ldsl, g_, S_, E_); } while (0)

__global__ void __launch_bounds__(NWAVES * 64, 2) fwd_megakernel(Params p) {
  cg::grid_group grid = cg::this_grid();
  extern __shared__ __attribute__((aligned(16))) unsigned char lds[];
  LAS unsigned char* ldsl = (LAS unsigned char*)lds;
  LAS float* smem = (LAS float*)ldsl;
  unsigned char* ws = p.ws;
  volatile LAS unsigned* MISC = (volatile LAS unsigned*)(ldsl + 131072);
  if (threadIdx.x < 64) MISC[threadIdx.x] = 0u;
  __syncthreads();
  const XcdBarrier bar = xcd_barrier_post((unsigned*)(ws + WS_CTL) + 4096, MISC + 8);
  grid.sync();
  float* xw = (float*)(ws + WS_XW);
  bf16* xn = (bf16*)(ws + WS_XN);
  float* big = (float*)(ws + WS_BIG);
  bf16* y = (bf16*)(ws + WS_Y);
  bf16* memh = (bf16*)(ws + WS_MEMH);
  float* kv = (float*)(ws + WS_KV);
  float* ssmE = (float*)(ws + WS_SSME);
  float* ssmp = (float*)(ws + WS_SSMP);
  int* ids = (int*)(ws + WS_IDS);
  float* gates = (float*)(ws + WS_GATE);

  prologue_transposes(p, ws, ldsl);
  for (int l = 0; l < 2; l++)
    rms_rows<true>(karg_in(1), karg_in(21) + l * DM, memh + (size_t)l * 1024 * 1024, 1024);
  ssm_params(p, ssmp);
  xcd_barrier(bar);
  for (int l = 0; l < 2; l++)
    GEMM_F32(memh + (size_t)l * 1024 * 1024, ws + WS_WT + (size_t)l * WT_LAYER + WT_MKV,
             kv + (size_t)l * 1024 * 2048, (const float*)nullptr, 1024, 2048);

#pragma nounroll
  for (int l = 0; l < 2; l++) {
    const float* xcur = (l == 0) ? karg_in(0) : xw;
    const float* sp = ssmp + (size_t)l * SSMP_PER_LAYER;
    const unsigned char* wl = ws + WS_WT + (size_t)l * WT_LAYER;
    rms_rows<true>(xcur, karg_in(2) + l * DM, xn, NT);
    xcd_barrier(bar);
    GEMM_BF16(xn, wl + WT_IN, big, NT, DIN);
    xcd_barrier(bar);
    ssm_chunk_end(sp, (const bf16*)big, ssmE);
    attn_phase(p, l, (const bf16*)big, y, smem);
    conv_phase(p, l, (const bf16*)big, y);
    xcd_barrier(bar);
    ssm_finish(p, l, sp, (const bf16*)big, ssmE, y, smem);
    xcd_barrier(bar);
    GEMM_F32(y, wl + WT_OUT, xw, xcur, NT, DM);
    xcd_barrier(bar);
    rms_rows<true>(xw, karg_in(20) + l * DM, xn, NT);
    xcd_barrier(bar);
    GEMM_F32(xn, wl + WT_MQ, big, (const float*)nullptr, NT, DM);
    xcd_barrier(bar);
    memattn_phase(big, kv + (size_t)l * 1024 * 2048, y);
    xcd_barrier(bar);
    GEMM_F32(y, wl + WT_MO, xw, (const float*)xw, NT, DM);
    xcd_barrier(bar);
    rms_rows<true>(xw, karg_in(25) + l * DM, xn, NT);
    xcd_barrier(bar);
    GEMM_F32(xn, wl + WT_PQ, big, (const float*)nullptr, NT, 2048);
    xcd_barrier(bar);
    peer_topk(big, karg_in(27) + (size_t)l * 8 * 2 * 128 * 128, ids, gates, smem);
    xcd_barrier(bar);
    peer_gather(xn, karg_in(28) + (size_t)l * 16384 * DM, karg_in(29) + (size_t)l * 16384 * DM,
                ids, gates, xw, smem);
    xcd_barrier(bar);
  }
  rms_rows<false>(xw, karg_in(30), p.out, NT);
}

extern "C" void kernel_launch(void* const* d_in, const int* in_sizes, int n_in,
                              void* d_out, int out_size, void* d_ws, size_t ws_size,
                              hipStream_t stream) {
  static int grid_blocks = 0;
  if (!grid_blocks) {
    int dev = 0, cus = 0, per_cu = 0;
    (void)hipGetDevice(&dev);
    (void)hipDeviceGetAttribute(&cus, hipDeviceAttributeMultiprocessorCount, dev);
    (void)hipFuncSetAttribute((const void*)fwd_megakernel, hipFuncAttributeMaxDynamicSharedMemorySize, LDS_BYTES);
    (void)hipOccupancyMaxActiveBlocksPerMultiprocessor(&per_cu, fwd_megakernel, NWAVES * 64, LDS_BYTES);
    if (per_cu < 1) fprintf(stderr, "occupancy query reports %d blocks/CU\n", per_cu);
    grid_blocks = cus;
  }
  (void)hipMemsetAsync((char*)d_ws + WS_CTL, 0, 1 * MiB, stream);
  Params p{};
  for (int i = 0; i < 31; i++) p.in[i] = (const float*)d_in[i];
  p.out = (float*)d_out;
  p.ws = (unsigned char*)d_ws;
  void* args[] = {&p};
  hipError_t e = hipLaunchCooperativeKernel((void*)fwd_megakernel, dim3(grid_blocks), dim3(NWAVES * 64),
                                            args, LDS_BYTES, stream);
  if (e != hipSuccess)
    fprintf(stderr, "cooperative launch failed: %s (grid %d)\n", hipGetErrorString(e), grid_blocks);
}
```

```cpp
#include <hip/hip_runtime.h>
#include <hip/hip_cooperative_groups.h>
#include <cstdio>
namespace cg = cooperative_groups;

#define NT 16384
#define SEQ 4096
#define DM 1024
#define DIN 2304
#define NMEM 256
#define EPSF 1e-6f
#define NWAVES 8
#define LDS_BYTES 147456

typedef unsigned short bf16;
#define LAS __attribute__((address_space(3)))

struct Params {
  const float* in[31];
  float* out;
  unsigned char* ws;
};
typedef __attribute__((address_space(4))) const unsigned char* kaptr_t;
__device__ __forceinline__ const float* karg_in(int i) {
  kaptr_t ka = (kaptr_t)__builtin_amdgcn_kernarg_segment_ptr();
  asm volatile("" : "+s"(ka));
  return *(const float* __attribute__((address_space(4))) const*)(ka + 8 * i);
}

constexpr size_t MiB = 1u << 20;
constexpr size_t WS_CTL  = 0;
constexpr size_t WS_WT   = 1 * MiB;
constexpr size_t WT_IN = 0, WT_OUT = WT_IN + (size_t)DIN * DM * 2, WT_MQ = WT_OUT + (size_t)DM * DM * 2,
                 WT_MKV = WT_MQ + (size_t)DM * DM * 2, WT_MO = WT_MKV + (size_t)2048 * DM * 2,
                 WT_PQ = WT_MO + (size_t)DM * DM * 2, WT_LAYER = WT_PQ + (size_t)2048 * DM * 2;
constexpr size_t WS_XW   = WS_WT + 2 * WT_LAYER;
constexpr size_t WS_XN   = WS_XW + (size_t)NT * DM * 4;
constexpr size_t WS_BIG  = WS_XN + (size_t)NT * DM * 2;
constexpr size_t WS_Y    = WS_BIG + (size_t)NT * DIN * 2;
constexpr size_t WS_MEMH = WS_Y + (size_t)NT * DM * 2;
constexpr size_t WS_KVB  = WS_MEMH + (size_t)2 * 1024 * 1024 * 2;
constexpr size_t WS_VT   = WS_KVB + (size_t)2 * 1024 * 2048 * 2;
constexpr size_t WS_SSME = WS_VT + (size_t)2 * 4 * 4 * 256 * 256 * 2;
#define SSMP_PER_LAYER (2048 + 2048 + 32768)
constexpr size_t WS_SSMP = WS_SSME + (size_t)4 * 64 * 16 * 64 * 2 * 4;
constexpr size_t WS_IDS  = WS_SSMP + (size_t)2 * SSMP_PER_LAYER * 4;
constexpr size_t WS_GATE = WS_IDS + (size_t)NT * 128 * 4;
constexpr size_t WS_SKB  = WS_GATE + (size_t)NT * 128 * 4;
constexpr size_t WS_UB   = WS_SKB + (size_t)2 * 8 * 2 * 128 * 128 * 2;
constexpr size_t WS_VB   = WS_UB + (size_t)2 * 16384 * 1024 * 2;
constexpr size_t WS_END  = WS_VB + (size_t)2 * 16384 * 1024 * 2;
static_assert(WS_END <= 512 * MiB, "workspace");
static_assert(WT_LAYER % 256 == 0 && WS_SSMP % 16 == 0 && WS_IDS % 16 == 0 && WS_SKB % 256 == 0 && WS_VT % 256 == 0, "align");

__device__ __forceinline__ int opaque_tid() { int v = threadIdx.x; asm volatile("" : "+v"(v)); return v; }
__device__ __forceinline__ unsigned f2bf(float f) { unsigned u = __builtin_bit_cast(unsigned, f); return (u + 0x7fffu + ((u >> 16) & 1u)) >> 16; }
__device__ __forceinline__ unsigned pk2(float lo, float hi) { return f2bf(lo) | (f2bf(hi) << 16); }
__device__ __forceinline__ float bf_lo(unsigned u) { return __builtin_bit_cast(float, u << 16); }
__device__ __forceinline__ float bf_hi(unsigned u) { return __builtin_bit_cast(float, u & 0xffff0000u); }
__device__ __forceinline__ float bf2f(bf16 h) { return __builtin_bit_cast(float, (unsigned)h << 16); }


#define XB_TMO      128
#define XB_XCNT(j)  (256  + 64 * (j))
#define XB_XSUB(j)  (1280 + 64 * (j))
#define XB_XGEN(j)  (2304 + 64 * (j))
#define XB_TOP      3328
#define XB_TOPGEN   3392
#define XCD_BAR_WORDS 3456
#define XB_SPIN_CAP (1u << 22)
__device__ __forceinline__ unsigned xb_ld(unsigned* p)              { return __hip_atomic_load(p, __ATOMIC_RELAXED, __HIP_MEMORY_SCOPE_AGENT); }
__device__ __forceinline__ unsigned xb_add(unsigned* p, unsigned v) { return __hip_atomic_fetch_add(p, v, __ATOMIC_RELAXED, __HIP_MEMORY_SCOPE_AGENT); }
__device__ __forceinline__ unsigned xb_xcc_id() { return (unsigned)__builtin_amdgcn_s_getreg((3 << 11) | 20) & 0xFu; }
#define XB_SPIN(cond, bar) do { unsigned _sp = 0; while (cond) { __builtin_amdgcn_s_sleep(1); \
    if ((++_sp & 255u) == 0u) { if (xb_ld(&(bar)[XB_TMO])) break; if (_sp > XB_SPIN_CAP) { atomicAdd(&(bar)[XB_TMO], 1u); break; } } } } while (0)
struct XcdBarrier { unsigned* bar; unsigned x; volatile LAS unsigned* st; };
__device__ __forceinline__ XcdBarrier xcd_barrier_post(unsigned* bar, volatile LAS unsigned* st) {
    XcdBarrier b; b.bar = bar; b.x = xb_xcc_id(); b.st = st;
    if (threadIdx.x == 0) (void)xb_add(&bar[XB_XCNT(b.x)], 1u);
    return b;
}
__device__ __forceinline__ void xcd_barrier_complete(unsigned* bar, unsigned x, unsigned& nloc, unsigned& nx) {
    const unsigned G = gridDim.x * gridDim.y * gridDim.z;
    unsigned sum, cnt, mine, sp = 0u;
    for (;;) {
        sum = 0u; cnt = 0u; mine = 0u;
#pragma unroll
        for (unsigned j = 0; j < 16; ++j) { const unsigned c = xb_ld(&bar[XB_XCNT(j)]); sum += c; cnt += (c > 0u) ? 1u : 0u; mine = (j == x) ? c : mine; }
        if (sum == G) break;
        __builtin_amdgcn_s_sleep(1);
        if ((++sp & 255u) == 0u) { if (xb_ld(&bar[XB_TMO])) break; if (sp > XB_SPIN_CAP) { atomicAdd(&bar[XB_TMO], 1u); break; } }
    }
    nloc = mine > 0u ? mine : 1u; nx = cnt > 0u ? cnt : 1u;
}
__device__ __forceinline__ void xcd_barrier(const XcdBarrier& b) {
    asm volatile("s_waitcnt vmcnt(0)" ::: "memory");
    __syncthreads();
    if (threadIdx.x == 0) {
        unsigned* bar = b.bar;
        __builtin_amdgcn_s_waitcnt(0);
        unsigned nloc = b.st[0], nx = b.st[1];
        if (nloc == 0u) { xcd_barrier_complete(bar, b.x, nloc, nx); b.st[0] = nloc; b.st[1] = nx; }
        const unsigned old = xb_add(&bar[XB_XSUB(b.x)], 1u);
        const unsigned gen = old / nloc;
        if (old + 1u == (gen + 1u) * nloc) {
            __builtin_amdgcn_fence(__ATOMIC_RELEASE, "agent");
            asm volatile("s_waitcnt vmcnt(0)" ::: "memory");
            const unsigned og = xb_add(&bar[XB_TOP], 1u);
            const unsigned tg = og / nx;
            if (og + 1u == (tg + 1u) * nx) xb_add(&bar[XB_TOPGEN], 1u);
            else XB_SPIN(xb_ld(&bar[XB_TOPGEN]) == tg, bar);
            __builtin_amdgcn_fence(__ATOMIC_ACQUIRE, "agent");
            xb_add(&bar[XB_XGEN(b.x)], 1u);
            asm volatile("s_waitcnt vmcnt(0)" ::: "memory");
        } else {
            XB_SPIN(xb_ld(&bar[XB_XGEN(b.x)]) == gen, bar);
            __builtin_amdgcn_fence(__ATOMIC_ACQUIRE, "agent");
            asm volatile("s_waitcnt vmcnt(0)" ::: "memory");
        }
    }
    __syncthreads();
}

namespace pg8 {
#define PG8_LAS __attribute__((address_space(3)))
typedef unsigned short bf16_t;
typedef short bf16x8 __attribute__((ext_vector_type(8)));
typedef float f32x4 __attribute__((ext_vector_type(4)));
typedef unsigned u32x4 __attribute__((ext_vector_type(4)));
constexpr int BM = 256, BK = 64, HALF = 128, HTB = HALF * BK * 2, STAGE_BYTES = 8 * HTB, NXCD = 8, WGM = 8;
__host__ __device__ __forceinline__ int lds_byte(int r, int c) { const int st = (r >> 4) * 2 + (c >> 5), rr = r & 15, cc = c & 31, ob = rr * 64 + cc * 2; return st * 1024 + (ob ^ (((ob >> 9) & 1) << 5)); }
__host__ __device__ __forceinline__ void stage_rc(int b, int& R, int& C) { const int st = b / 1024, sb = b % 1024, swz = sb ^ (((sb >> 9) & 1) << 5); R = (st >> 1) * 16 + swz / 64; C = (st & 1) * 32 + (swz % 64) / 2; }
__host__ __device__ __forceinline__ int perm32(int rho) { const int n = rho >> 4, i = rho & 15; return 8 * (i >> 2) + 4 * n + (i & 3); }
struct Unit { int pm, pn; };
struct Gemm { const bf16_t* A; const bf16_t* Bt; int M, N, K; };
struct StaticOrder {
    int nM, nN, nwg, G, c;
    __host__ __device__ __forceinline__ void init(int M, int N, int G_, int c_) { nM = M / BM; nN = N / BM; nwg = nM * nN; G = G_; c = c_; }
    __host__ __device__ bool next(int i, Unit& u) const {
        const long L = (long)i * G + c; if (L >= nwg) return false;
        int wgid = (int)L; { const int q = nwg / NXCD, r = nwg % NXCD, xcd = wgid % NXCD, off = wgid / NXCD; wgid = (xcd < r ? xcd * (q + 1) : r * (q + 1) + (xcd - r) * q) + off; }
        const int nig = WGM * nN, gid = wgid / nig, fm = gid * WGM, gsz = (nM - fm) < WGM ? (nM - fm) : WGM;
        u.pm = fm + ((wgid % nig) % gsz); u.pn = (wgid % nig) / gsz; return true;
    }
    __device__ __forceinline__ void a_ready(const Unit&) const {}
    __device__ __forceinline__ void done(const Unit&) const {}
};
__device__ __forceinline__ unsigned cvt_pk_bf16(float lo, float hi) { unsigned r; asm volatile("v_cvt_pk_bf16_f32 %0, %1, %2" : "=v"(r) : "v"(lo), "v"(hi)); return r; }

struct EpiF32R {
    static constexpr bool PERM = false, AFTER_DRAIN = false;
    float* C; const float* R; int ldc;
    __device__ __forceinline__ void operator()(const f32x4 (&acc)[2][2][4][2], const Unit& u, int wr, int wc, int fr, int fq) const {
        const int row0 = u.pm * BM + wr * 64 + fr, col0 = u.pn * BM + wc * 32 + 4 * fq;
#pragma unroll
        for (int ai = 0; ai < 2; ++ai)
#pragma unroll
            for (int m = 0; m < 4; ++m) {
                const size_t ro = (size_t)(row0 + ai * HALF + m * 16) * ldc + col0;
                f32x4 rv[2][2];
#pragma unroll
                for (int bj = 0; bj < 2; ++bj)
#pragma unroll
                    for (int n = 0; n < 2; ++n) rv[bj][n] = R ? *(const f32x4*)(R + ro + bj * HALF + n * 16) : (f32x4){0.f, 0.f, 0.f, 0.f};
#pragma unroll
                for (int bj = 0; bj < 2; ++bj)
#pragma unroll
                    for (int n = 0; n < 2; ++n) *(f32x4*)(C + ro + bj * HALF + n * 16) = acc[ai][bj][m][n] + rv[bj][n];
                __builtin_amdgcn_sched_barrier(0);
            }
    }
};

struct EpiBf16 {
    static constexpr bool PERM = true, AFTER_DRAIN = false;
    bf16_t* O; int ldc;
    __device__ __forceinline__ void operator()(const f32x4 (&acc)[2][2][4][2], const Unit& u, int wr, int wc, int fr, int fq) const {
        const int row0 = u.pm * BM + wr * 64 + fr, col0 = u.pn * BM + wc * 32 + 8 * fq;
#pragma unroll
        for (int ai = 0; ai < 2; ++ai)
#pragma unroll
            for (int m = 0; m < 4; ++m) { bf16_t* rowp = O + (size_t)(row0 + ai * HALF + m * 16) * ldc + col0;
#pragma unroll
                for (int bj = 0; bj < 2; ++bj) { const f32x4 v0 = acc[ai][bj][m][0], v1 = acc[ai][bj][m][1];
                    u32x4 w; w.x = cvt_pk_bf16(v0[0], v0[1]); w.y = cvt_pk_bf16(v0[2], v0[3]); w.z = cvt_pk_bf16(v1[0], v1[1]); w.w = cvt_pk_bf16(v1[2], v1[3]);
                    *(u32x4*)(rowp + bj * HALF) = w; } }
    }
};

template <class Epi, class Sched, bool ALIGN_EPI = false, bool SP2 = false>
__device__ __forceinline__ void gemm_phase(PG8_LAS unsigned char* lds, const Gemm g, const Sched& S, const Epi& E) {
    const int tid = opaque_tid(), wid = __builtin_amdgcn_readfirstlane(tid >> 6), lane = tid & 63, wr = wid >> 2, wc = wid & 3, fr = lane & 15, fq = lane >> 4;
    const int K = g.K, nt = K / BK;
    unsigned voffA[2], voffB[2];
#pragma unroll
    for (int i = 0; i < 2; ++i) { int R, C; stage_rc(tid * 16 + i * 8192, R, C); const int Rb = Epi::PERM ? ((R & ~31) + perm32(R & 31)) : R;
        voffA[i] = (unsigned)(R * K + C) * 2u; voffB[i] = (unsigned)(Rb * K + C) * 2u; }
    const size_t kstep = (size_t)(BK * 2);
    const size_t hstep = (size_t)HALF * K * 2;
    const size_t tstep = 2 * hstep;
    const unsigned ldsw = (unsigned)wid * 1024u;
    const int aoff = lds_byte(wr * 64 + fr, fq * 8), boff = lds_byte(wc * 32 + fr, fq * 8);
#define PG8_SA(b, h) (((b) * 2 + (h)) * HTB)
#define PG8_SB(b, h) ((4 + (b) * 2 + (h)) * HTB)
#define PG8_STAGE(bufoff, gbase, voff) do { _Pragma("unroll") for (int _i = 0; _i < 2; ++_i) \
        __builtin_amdgcn_global_load_lds((const unsigned*)((const char*)(gbase) + (voff)[_i]), (PG8_LAS unsigned*)(lds + (bufoff) + ldsw + _i * 8192), 16, 0, 0); } while (0)
#define PG8_LDA(dst, b, h) do { _Pragma("unroll") for (int m = 0; m < 4; ++m) _Pragma("unroll") for (int k = 0; k < 2; ++k) dst[m][k] = *(const PG8_LAS bf16x8*)(lds + PG8_SA(b, h) + aoff + m * 2048 + k * 1024); } while (0)
#define PG8_LDB(dst, b, h) do { _Pragma("unroll") for (int n = 0; n < 2; ++n) _Pragma("unroll") for (int k = 0; k < 2; ++k) dst[n][k] = *(const PG8_LAS bf16x8*)(lds + PG8_SB(b, h) + boff + n * 2048 + k * 1024); } while (0)
#define PG8_MMA(ai, bj, At, Bt) do { __builtin_amdgcn_s_setprio(1); _Pragma("unroll") for (int m = 0; m < 4; ++m) _Pragma("unroll") for (int n = 0; n < 2; ++n) _Pragma("unroll") for (int k = 0; k < 2; ++k) \
        acc[ai][bj][m][n] = __builtin_amdgcn_mfma_f32_16x16x32_bf16(Bt[n][k], At[m][k], acc[ai][bj][m][n], 0, 0, 0); __builtin_amdgcn_s_setprio(0); } while (0)
#define PG8_WAIT_V(n) asm volatile("s_waitcnt vmcnt(" #n ")" ::: "memory")
#define PG8_WAIT_L(n) asm volatile("s_waitcnt lgkmcnt(" #n ")" ::: "memory")
#define PG8_BAR __builtin_amdgcn_s_barrier()
#define PG8_SCHED __builtin_amdgcn_sched_barrier(0)
    Unit cur, nxt; int ui = 0;
    if (!S.next(0, cur)) return;
    f32x4 acc[2][2][4][2];
#pragma unroll
    for (int a = 0; a < 2; ++a)
#pragma unroll
        for (int b = 0; b < 2; ++b)
#pragma unroll
            for (int m = 0; m < 4; ++m)
#pragma unroll
                for (int n = 0; n < 2; ++n) acc[a][b][m][n] = (f32x4){0.f, 0.f, 0.f, 0.f};
    bf16x8 At[4][2], B0[2][2], B1[2][2];
    const char* cA = (const char*)g.A + (size_t)cur.pm * tstep; const char* cB = (const char*)g.Bt + (size_t)cur.pn * tstep;
    S.a_ready(cur);
    if constexpr (SP2) {
        PG8_STAGE(PG8_SB(0, 0), cB, voffB); PG8_STAGE(PG8_SB(0, 1), cB + hstep, voffB); PG8_STAGE(PG8_SA(0, 0), cA, voffA); PG8_STAGE(PG8_SA(0, 1), cA + hstep, voffA);
        if (wr == 1) PG8_BAR;
        PG8_WAIT_V(2); PG8_BAR;
        PG8_STAGE(PG8_SB(1, 0), cB + kstep, voffB); PG8_STAGE(PG8_SA(1, 0), cA + kstep, voffA); PG8_STAGE(PG8_SB(1, 1), cB + hstep + kstep, voffB);
        PG8_WAIT_V(6); PG8_BAR;
    } else {
        PG8_STAGE(PG8_SB(0, 0), cB, voffB); PG8_STAGE(PG8_SA(0, 0), cA, voffA); PG8_STAGE(PG8_SB(0, 1), cB + hstep, voffB); PG8_STAGE(PG8_SA(0, 1), cA + hstep, voffA);
        if (wr == 1) PG8_BAR;
        PG8_WAIT_V(4); PG8_BAR;
        PG8_STAGE(PG8_SB(1, 0), cB + kstep, voffB); PG8_STAGE(PG8_SA(1, 0), cA + kstep, voffA); PG8_STAGE(PG8_SB(1, 1), cB + hstep + kstep, voffB);
        PG8_WAIT_V(6); PG8_BAR;
    }
    for (;;) {
        const bool has_next = S.next(ui + 1, nxt);
        const char* nA = has_next ? (const char*)g.A + (size_t)nxt.pm * tstep : cA; const char* nB = has_next ? (const char*)g.Bt + (size_t)nxt.pn * tstep : cB;
        for (int t = 0; t < nt; t += 2) {
            const bool last = (t == nt - 2);
            const char* a1 = cA + (size_t)(t + 1) * kstep;
            const char* a2 = last ? nA : cA + (size_t)(t + 2) * kstep; const char* b2 = last ? nB : cB + (size_t)(t + 2) * kstep;
            const char* a3 = a2 + kstep; const char* b3 = b2 + kstep;
            if (last && has_next) S.a_ready(nxt);
            if constexpr (SP2) {
            PG8_LDB(B0, 0, 0); PG8_LDB(B1, 0, 1); PG8_SCHED; PG8_LDA(At, 0, 0); PG8_STAGE(PG8_SA(1, 1), a1 + hstep, voffA);
            PG8_WAIT_V(8); PG8_WAIT_L(0); PG8_BAR; PG8_MMA(0, 0, At, B0); PG8_MMA(0, 1, At, B1); PG8_BAR; PG8_SCHED;
            PG8_LDA(At, 0, 1); PG8_STAGE(PG8_SB(0, 0), b2, voffB); PG8_STAGE(PG8_SB(0, 1), b2 + hstep, voffB); PG8_STAGE(PG8_SA(0, 0), a2, voffA);
            PG8_WAIT_V(8); PG8_WAIT_L(0); PG8_BAR; PG8_MMA(1, 0, At, B0); PG8_MMA(1, 1, At, B1); PG8_BAR; PG8_SCHED;
            PG8_LDB(B0, 1, 0); PG8_LDB(B1, 1, 1); PG8_SCHED; PG8_LDA(At, 1, 0); PG8_STAGE(PG8_SA(0, 1), a2 + hstep, voffA);
            PG8_WAIT_V(8); PG8_WAIT_L(0); PG8_BAR; PG8_MMA(0, 0, At, B0); PG8_MMA(0, 1, At, B1); PG8_BAR; PG8_SCHED;
            PG8_LDA(At, 1, 1); PG8_STAGE(PG8_SB(1, 0), b3, voffB); PG8_STAGE(PG8_SB(1, 1), b3 + hstep, voffB); PG8_STAGE(PG8_SA(1, 0), a3, voffA);
            PG8_WAIT_V(8); PG8_WAIT_L(0); PG8_BAR; PG8_MMA(1, 0, At, B0); PG8_MMA(1, 1, At, B1); PG8_BAR; PG8_SCHED;
            } else {
            PG8_LDB(B0, 0, 0); PG8_SCHED; PG8_LDA(At, 0, 0); PG8_STAGE(PG8_SA(1, 1), a1 + hstep, voffA);
            PG8_WAIT_L(8); PG8_BAR; PG8_WAIT_L(0); PG8_MMA(0, 0, At, B0); PG8_BAR; PG8_SCHED;
            PG8_LDB(B1, 0, 1); PG8_STAGE(PG8_SB(0, 0), b2, voffB);
            PG8_BAR; PG8_WAIT_L(0); PG8_MMA(0, 1, At, B1); PG8_BAR;
            PG8_LDA(At, 0, 1); PG8_STAGE(PG8_SA(0, 0), a2, voffA);
            PG8_BAR; PG8_WAIT_L(0); PG8_MMA(1, 0, At, B0); PG8_BAR; PG8_SCHED;
            PG8_STAGE(PG8_SB(0, 1), b2 + hstep, voffB);
            PG8_WAIT_V(6); PG8_BAR; PG8_MMA(1, 1, At, B1); PG8_BAR;
            PG8_LDB(B0, 1, 0); PG8_SCHED; PG8_LDA(At, 1, 0); PG8_STAGE(PG8_SA(0, 1), a2 + hstep, voffA);
            PG8_WAIT_L(8); PG8_BAR; PG8_WAIT_L(0); PG8_MMA(0, 0, At, B0); PG8_BAR; PG8_SCHED;
            PG8_LDB(B1, 1, 1); PG8_STAGE(PG8_SB(1, 0), b3, voffB);
            PG8_BAR; PG8_WAIT_L(0); PG8_MMA(0, 1, At, B1); PG8_BAR;
            PG8_LDA(At, 1, 1); PG8_STAGE(PG8_SA(1, 0), a3, voffA);
            PG8_BAR; PG8_WAIT_L(0); PG8_MMA(1, 0, At, B0); PG8_BAR; PG8_SCHED;
            PG8_STAGE(PG8_SB(1, 1), b3 + hstep, voffB);
            PG8_WAIT_V(6); PG8_BAR; PG8_MMA(1, 1, At, B1); PG8_BAR;
            }
        }
        if constexpr (ALIGN_EPI) { if (wr == 0) PG8_BAR; }
        if constexpr (!Epi::AFTER_DRAIN) { E(acc, cur, wr, wc, fr, fq); S.done(cur); }
        if (!has_next) break;
#pragma unroll
        for (int a = 0; a < 2; ++a)
#pragma unroll
            for (int b = 0; b < 2; ++b)
#pragma unroll
                for (int m = 0; m < 4; ++m)
#pragma unroll
                    for (int n = 0; n < 2; ++n) acc[a][b][m][n] = (f32x4){0.f, 0.f, 0.f, 0.f};
        cur = nxt; cA = nA; cB = nB; ++ui;
        if constexpr (ALIGN_EPI) { if (wr == 1) PG8_BAR; }
    }
    PG8_WAIT_V(0);
    if constexpr (!ALIGN_EPI) { if (wr == 0) PG8_BAR; }
    PG8_BAR;
#undef PG8_SA
#undef PG8_SB
#undef PG8_STAGE
#undef PG8_LDA
#undef PG8_LDB
#undef PG8_MMA
#undef PG8_WAIT_V
#undef PG8_WAIT_L
#undef PG8_BAR
#undef PG8_SCHED
}
}

__device__ __forceinline__ void transpose_item(const float* W, int K, int N, bf16* WT, LAS float* scr, int item, int lane) {
    const int nblk = N / 32, kb = item / nblk, nb = item % nblk, k0 = 64 * kb, n0 = 32 * nb;
#pragma unroll 8
    for (int i = 0; i < 32; ++i) { const int kk = 2 * i + (lane >> 5); scr[kk * 33 + (lane & 31)] = W[(size_t)(k0 + kk) * N + n0 + (lane & 31)]; }
    asm volatile("s_waitcnt lgkmcnt(0)" ::: "memory");
    const int c = lane & 7;
#pragma unroll
    for (int j = 0; j < 4; ++j) { const int n = (lane >> 3) + 8 * j; const LAS float* s = scr + (8 * c) * 33 + n;
        uint4 o; o.x = pk2(s[0 * 33], s[1 * 33]); o.y = pk2(s[2 * 33], s[3 * 33]); o.z = pk2(s[4 * 33], s[5 * 33]); o.w = pk2(s[6 * 33], s[7 * 33]);
        *(uint4*)(WT + (size_t)(n0 + n) * K + k0 + 8 * c) = o; }
    asm volatile("s_waitcnt lgkmcnt(0)" ::: "memory");
}

__device__ __forceinline__ float wsum(float v) {
#pragma unroll
  for (int o = 32; o > 0; o >>= 1) v += __shfl_xor(v, o, 64);
  return v;
}
__device__ __forceinline__ float wmaxf(float v) {
#pragma unroll
  for (int o = 32; o > 0; o >>= 1) v = fmaxf(v, __shfl_xor(v, o, 64));
  return v;
}
__device__ __forceinline__ float sigmoidf_(float x) { return 1.0f / (1.0f + expf(-x)); }
__device__ __forceinline__ float gelu_tanh(float x) {
  return 0.5f * x * (1.0f + tanhf(0.7978845608028654f * (x + 0.044715f * x * x * x)));
}

template <bool BF16OUT>
__device__ __forceinline__ void rms_rows(const float* src, const float* g, void* dstv, int rows) {
  const int tid_ = opaque_tid();
  const int lane = tid_ & 63;
  const int gw = blockIdx.x * NWAVES + (tid_ >> 6);
  const int nw = gridDim.x * NWAVES;
  for (int r = gw; r < rows; r += nw) {
    const float4* s4 = (const float4*)(src + (size_t)r * DM);
    float4 v[4];
    float ss = 0.f;
#pragma unroll
    for (int i = 0; i < 4; i++) {
      v[i] = s4[lane + i * 64];
      ss += v[i].x * v[i].x + v[i].y * v[i].y + v[i].z * v[i].z + v[i].w * v[i].w;
    }
    ss = wsum(ss);
    const float rstd = rsqrtf(ss * (1.0f / DM) + EPSF);
    const float4* g4 = (const float4*)g;
#pragma unroll
    for (int i = 0; i < 4; i++) {
      float4 gg = g4[lane + i * 64];
      float4 o;
      o.x = v[i].x * rstd * gg.x; o.y = v[i].y * rstd * gg.y;
      o.z = v[i].z * rstd * gg.z; o.w = v[i].w * rstd * gg.w;
      if (BF16OUT) {
        uint2 pk; pk.x = pk2(o.x, o.y); pk.y = pk2(o.z, o.w);
        ((uint2*)((bf16*)dstv + (size_t)r * DM))[lane + i * 64] = pk;
      } else {
        ((float4*)((float*)dstv + (size_t)r * DM))[lane + i * 64] = o;
      }
    }
  }
}

__device__ __forceinline__ void ssm_params(const Params& p, float* ssmp_all) {
  const int tid_ = opaque_tid();
  const float* in8 = karg_in(8); const float* in9 = karg_in(9); const float* in10 = karg_in(10);
  const float* in11 = karg_in(11); const float* in12 = karg_in(12);
  const int gt = blockIdx.x * blockDim.x + tid_;
  const int nth = gridDim.x * blockDim.x;
  for (int i = gt; i < 2 * 16 * 64; i += nth) {
    const int l = i / 1024, gp = i % 1024, g = gp / 64;
    float* sp = ssmp_all + (size_t)l * SSMP_PER_LAYER;
    const float lre = fminf(in8[l * 1024 + gp], -1e-4f);
    const float lim = in9[l * 1024 + gp];
    const float dt = expf(in10[l * 16 + g]);
    const float er = expf(lre * dt);
    float sn, cs;
    sincosf(lim * dt, &sn, &cs);
    const float br = er * cs, bi = er * sn;
    sp[gp * 2 + 0] = br;
    sp[gp * 2 + 1] = bi;
    float cr = br, ci = bi;
#pragma unroll
    for (int s = 0; s < 6; s++) {
      const float nr = cr * cr - ci * ci, ni = 2.f * cr * ci;
      cr = nr; ci = ni;
    }
    sp[2048 + gp * 2 + 0] = cr;
    sp[2048 + gp * 2 + 1] = ci;
    const float nr = br - 1.0f, ni = bi;
    const float den = lre * lre + lim * lim;
    const float fr = (nr * lre + ni * lim) / den;
    const float fi = (ni * lre - nr * lim) / den;
    for (int h = 0; h < 16; h++) {
      const float bre = in11[((size_t)l * 1024 + gp) * 16 + h];
      const float bim = in12[((size_t)l * 1024 + gp) * 16 + h];
      sp[4096 + (gp * 16 + h) * 2 + 0] = fr * bre - fi * bim;
      sp[4096 + (gp * 16 + h) * 2 + 1] = fr * bim + fi * bre;
    }
  }
}

__device__ __forceinline__ void conv_phase(const Params& p, int l, const bf16* proj, bf16* y) {
  const int tid_ = opaque_tid();
  const int lane = tid_ & 63;
  const int gw = blockIdx.x * NWAVES + (tid_ >> 6);
  const int nw = gridDim.x * NWAVES;
  const float* cw = karg_in(4) + (size_t)l * 31 * 256;
  const float4 cb = ((const float4*)(karg_in(5) + l * 256))[lane];
  const float4 lg = ((const float4*)(karg_in(6) + l * 256))[lane];
  const float4 lb = ((const float4*)(karg_in(7) + l * 256))[lane];
  const float4 gg = ((const float4*)(karg_in(18) + l * 1024))[lane];
  for (int tok = gw; tok < NT; tok += nw) {
    const int t = tok & (SEQ - 1);
    float4 acc = cb;
    for (int j = 0; j < 31; j++) {
      const int tt = t - 30 + j;
      if (tt >= 0) {
        const bf16* row = proj + (size_t)(tok - 30 + j) * DIN;
        const uint2 vp = ((const uint2*)row)[lane];
        const uint2 gp = ((const uint2*)(row + 256))[lane];
        const float4 v = make_float4(bf_lo(vp.x), bf_hi(vp.x), bf_lo(vp.y), bf_hi(vp.y));
        const float4 gt = make_float4(bf_lo(gp.x), bf_hi(gp.x), bf_lo(gp.y), bf_hi(gp.y));
        const float4 w = ((const float4*)(cw + j * 256))[lane];
        acc.x += v.x * sigmoidf_(gt.x) * w.x;
        acc.y += v.y * sigmoidf_(gt.y) * w.y;
        acc.z += v.z * sigmoidf_(gt.z) * w.z;
        acc.w += v.w * sigmoidf_(gt.w) * w.w;
      }
    }
    const float mean = wsum(acc.x + acc.y + acc.z + acc.w) * (1.0f / 256.f);
    const float dx = acc.x - mean, dy = acc.y - mean, dz = acc.z - mean, dw = acc.w - mean;
    const float var = wsum(dx * dx + dy * dy + dz * dz + dw * dw) * (1.0f / 256.f);
    const float rs = rsqrtf(var + EPSF);
    float4 s;
    s.x = dx * rs * lg.x + lb.x; s.y = dy * rs * lg.y + lb.y;
    s.z = dz * rs * lg.z + lb.z; s.w = dw * rs * lg.w + lb.w;
    s.x = s.x * sigmoidf_(s.x); s.y = s.y * sigmoidf_(s.y);
    s.z = s.z * sigmoidf_(s.z); s.w = s.w * sigmoidf_(s.w);
    const float ss = wsum(s.x * s.x + s.y * s.y + s.z * s.z + s.w * s.w) * (1.0f / 256.f);
    const float r2 = rsqrtf(ss + EPSF);
    float4 o;
    o.x = s.x * r2 * gg.x; o.y = s.y * r2 * gg.y; o.z = s.z * r2 * gg.z; o.w = s.w * r2 * gg.w;
    { uint2 pk; pk.x = pk2(o.x, o.y); pk.y = pk2(o.z, o.w); ((uint2*)(y + (size_t)tok * DM))[lane] = pk; }
  }
}

typedef short bf16x8_t __attribute__((ext_vector_type(8)));
typedef float f32x16_t __attribute__((ext_vector_type(16)));
__device__ __forceinline__ void attn_phase(const Params& p, int l, const bf16* proj, bf16* y, LAS float* smem) {
  const int tid = opaque_tid(), lane = tid & 63, wave = tid >> 6;
  const int n = lane & 31, hh = lane >> 5;
  const float* gg = karg_in(18) + l * 1024 + 256 + wave * 64;
  const float g0 = gg[n], g1 = gg[32 + n];
  LAS float* ssq = smem;
  LAS float* rstd = smem + 256;
  for (int item = blockIdx.x; item < 4 * 128; item += gridDim.x) {
    const int b = item >> 7, q0 = (item & 127) * 32;
    const size_t tokb = (size_t)b * SEQ;
    bf16x8_t qf[4];
    {
      const bf16* qrow = proj + (tokb + q0 + n) * DIN + 512 + wave * 64 + 8 * hh;
#pragma unroll
      for (int ks = 0; ks < 4; ks++) qf[ks] = *(const bf16x8_t*)(qrow + 16 * ks);
    }
    f32x16_t o0, o1;
#pragma unroll
    for (int r = 0; r < 16; r++) { o0[r] = 0.f; o1[r] = 0.f; }
    float R = 0.f;
    for (int kt = q0; kt >= 0; kt -= 32) {
      bf16x8_t kf[4];
      {
        const bf16* krow = proj + (tokb + kt + n) * DIN + 1024 + wave * 64 + 8 * hh;
#pragma unroll
        for (int ks = 0; ks < 4; ks++) kf[ks] = *(const bf16x8_t*)(krow + 16 * ks);
      }
      bf16x8_t vf0[2], vf1[2];
      {
        const bf16* vb = proj + (tokb + kt + 4 * hh) * DIN + 1536 + wave * 64 + n;
#pragma unroll
        for (int s = 0; s < 2; s++)
#pragma unroll
          for (int j = 0; j < 8; j++) {
            const int key = 16 * s + 8 * (j >> 2) + (j & 3);
            vf0[s][j] = (short)vb[(size_t)key * DIN];
            vf1[s][j] = (short)vb[(size_t)key * DIN + 32];
          }
      }
      f32x16_t sacc;
#pragma unroll
      for (int r = 0; r < 16; r++) sacc[r] = 0.f;
      __builtin_amdgcn_sched_barrier(0); asm volatile("s_nop 15\n\ts_nop 15" ::: "memory"); __builtin_amdgcn_sched_barrier(0);
#pragma unroll
      for (int ks = 0; ks < 4; ks++) sacc = __builtin_amdgcn_mfma_f32_32x32x16_bf16(kf[ks], qf[ks], sacc, 0, 0, 0);
      __builtin_amdgcn_sched_barrier(0); asm volatile("s_nop 15\n\ts_nop 15" ::: "memory"); __builtin_amdgcn_sched_barrier(0);
      float lst[16], lsz[16];
      const bool diag = (kt == q0);
#pragma unroll
      for (int r = 0; r < 16; r++) {
        const float z = sacc[r] * 0.125f;
        const float sp = __logf(1.0f + __expf(-fabsf(z)));
        float a = fminf(z, 0.f) - sp;
        float c = -(fmaxf(z, 0.f) + sp);
        if (diag) {
          const int key = (r & 3) + 8 * (r >> 2) + 4 * hh;
          if (key >= n) { a = -1.0e30f; c = 0.f; }
        }
        lsz[r] = a; lst[r] = c;
      }
      float Gs[4], Gp[4];
#pragma unroll
      for (int g = 0; g < 4; g++) {
        Gs[g] = (lst[4 * g] + lst[4 * g + 1]) + (lst[4 * g + 2] + lst[4 * g + 3]);
        Gp[g] = __shfl_xor(Gs[g], 32, 64);
      }
      float carry[4];
      {
        float after = R;
#pragma unroll
        for (int g = 3; g >= 0; g--) {
          carry[g] = after + (hh ? 0.f : Gp[g]);
          after += Gs[g] + Gp[g];
        }
        R = after;
      }
      bf16x8_t pf[2];
#pragma unroll
      for (int g = 0; g < 4; g++) {
        float run = carry[g];
        float a3 = __expf(lsz[4 * g + 3] + run); run += lst[4 * g + 3];
        float a2 = __expf(lsz[4 * g + 2] + run); run += lst[4 * g + 2];
        float a1 = __expf(lsz[4 * g + 1] + run); run += lst[4 * g + 1];
        float a0 = __expf(lsz[4 * g + 0] + run);
        const int s = g >> 1, jb = (g & 1) * 4;
        pf[s][jb + 0] = (short)f2bf(a0); pf[s][jb + 1] = (short)f2bf(a1);
        pf[s][jb + 2] = (short)f2bf(a2); pf[s][jb + 3] = (short)f2bf(a3);
      }
      __builtin_amdgcn_sched_barrier(0); asm volatile("s_nop 15\n\ts_nop 15" ::: "memory"); __builtin_amdgcn_sched_barrier(0);
#pragma unroll
      for (int s = 0; s < 2; s++) {
        o0 = __builtin_amdgcn_mfma_f32_32x32x16_bf16(pf[s], vf0[s], o0, 0, 0, 0);
        o1 = __builtin_amdgcn_mfma_f32_32x32x16_bf16(pf[s], vf1[s], o1, 0, 0, 0);
      }
      __builtin_amdgcn_sched_barrier(0); asm volatile("s_nop 15\n\ts_nop 15" ::: "memory"); __builtin_amdgcn_sched_barrier(0);
      if (__all(R < -110.f)) break;
    }
    float sq[16];
#pragma unroll
    for (int r = 0; r < 16; r++) {
      float v = o0[r] * o0[r] + o1[r] * o1[r];
#pragma unroll
      for (int o = 16; o > 0; o >>= 1) v += __shfl_xor(v, o, 64);
      sq[r] = v;
    }
    __syncthreads();
    if (n == 0) {
#pragma unroll
      for (int r = 0; r < 16; r++) ssq[wave * 32 + (r & 3) + 8 * (r >> 2) + 4 * hh] = sq[r];
    }
    __syncthreads();
    if (tid < 32) {
      float t = 0.f;
#pragma unroll
      for (int w = 0; w < 8; w++) t += ssq[w * 32 + tid];
      rstd[tid] = rsqrtf(t * (1.0f / 512.f) + EPSF);
    }
    __syncthreads();
#pragma unroll
    for (int r = 0; r < 16; r++) {
      const int qi = (r & 3) + 8 * (r >> 2) + 4 * hh;
      const float rs = rstd[qi];
      bf16* yr = y + (tokb + q0 + qi) * DM + 256 + wave * 64 + n;
      yr[0] = (bf16)f2bf(o0[r] * rs * g0);
      yr[32] = (bf16)f2bf(o1[r] * rs * g1);
    }
  }
}

__device__ __forceinline__ void ssm_chunk_end(const float* ssmp, const bf16* proj, float* ssmE) {
  const int tid_ = opaque_tid();
  const int lane = tid_ & 63;
  const int gw = blockIdx.x * NWAVES + (tid_ >> 6);
  const int nw = gridDim.x * NWAVES;
  for (int it = gw; it < 4 * 64 * 16; it += nw) {
    const int g = it & 15, c = (it >> 4) & 63, b = it >> 10;
    const int gp = g * 64 + lane;
    const float lbr = ssmp[gp * 2], lbi = ssmp[gp * 2 + 1];
    float bbr[16], bbi[16];
#pragma unroll
    for (int h = 0; h < 16; h++) {
      bbr[h] = ssmp[4096 + (gp * 16 + h) * 2];
      bbi[h] = ssmp[4096 + (gp * 16 + h) * 2 + 1];
    }
    float xr = 0.f, xi = 0.f;
    for (int tt = 0; tt < 64; tt++) {
      float u[16];
      {
        const uint4* up = (const uint4*)(proj + (size_t)(b * SEQ + c * 64 + tt) * DIN + 2048 + g * 16);
        const uint4 ua = up[0], ub = up[1];
        u[0] = bf_lo(ua.x); u[1] = bf_hi(ua.x); u[2] = bf_lo(ua.y); u[3] = bf_hi(ua.y);
        u[4] = bf_lo(ua.z); u[5] = bf_hi(ua.z); u[6] = bf_lo(ua.w); u[7] = bf_hi(ua.w);
        u[8] = bf_lo(ub.x); u[9] = bf_hi(ub.x); u[10] = bf_lo(ub.y); u[11] = bf_hi(ub.y);
        u[12] = bf_lo(ub.z); u[13] = bf_hi(ub.z); u[14] = bf_lo(ub.w); u[15] = bf_hi(ub.w);
      }
      float br = 0.f, bi = 0.f;
#pragma unroll
      for (int h = 0; h < 16; h++) {
        const float uh = u[h];
        br += bbr[h] * uh;
        bi += bbi[h] * uh;
      }
      const float nr = lbr * xr - lbi * xi + br;
      const float ni = lbr * xi + lbi * xr + bi;
      xr = nr; xi = ni;
    }
    float* e = ssmE + ((size_t)((b * 64 + c) * 16 + g) * 64 + lane) * 2;
    e[0] = xr; e[1] = xi;
  }
}

__device__ __forceinline__ void ssm_finish(const Params& p, int l, const float* ssmp, const bf16* proj,
                           const float* ssmE, bf16* y, LAS float* smem) {
  LAS float (*Yt)[256] = (LAS float (*)[256])smem;
  const int tid = opaque_tid(), lane = tid & 63, wave = tid >> 6;
  const float* cre = karg_in(13) + (size_t)l * 16 * 16 * 64;
  const float* cim = karg_in(14) + (size_t)l * 16 * 16 * 64;
  const float* dsk = karg_in(15) + l * 256;
  const float* glw = karg_in(16) + (size_t)l * 256 * 256;
  const float* glb = karg_in(17) + l * 256;
  const float* gg = karg_in(18) + l * 1024 + 768;
  for (int it = blockIdx.x; it < 256; it += gridDim.x) {
    const int b = it >> 6, c = it & 63;
    __syncthreads();
    for (int gi = 0; gi < 2; gi++) {
      const int g = wave + gi * 8;
      const int gp = g * 64 + lane;
      const float lbr = ssmp[gp * 2], lbi = ssmp[gp * 2 + 1];
      const float lcr = ssmp[2048 + gp * 2], lci = ssmp[2048 + gp * 2 + 1];
      float bbr[16], bbi[16], ccr[16], cci[16];
#pragma unroll
      for (int h = 0; h < 16; h++) {
        bbr[h] = ssmp[4096 + (gp * 16 + h) * 2];
        bbi[h] = ssmp[4096 + (gp * 16 + h) * 2 + 1];
        ccr[h] = cre[(g * 16 + h) * 64 + lane];
        cci[h] = cim[(g * 16 + h) * 64 + lane];
      }
      float xr = 0.f, xi = 0.f;
      for (int cc = 0; cc < c; cc++) {
        const float* e = ssmE + ((size_t)((b * 64 + cc) * 16 + g) * 64 + lane) * 2;
        const float er = e[0], ei = e[1];
        const float nr = lcr * xr - lci * xi + er;
        const float ni = lcr * xi + lci * xr + ei;
        xr = nr; xi = ni;
      }
      const int hq = ((lane >> 5) & 1) * 8 + ((lane >> 4) & 1) * 4 + ((lane >> 3) & 1) * 2 + ((lane >> 2) & 1);
      const float dh = dsk[g * 16 + hq];
      for (int tt = 0; tt < 64; tt++) {
        float u[16];
        {
          const uint4* up = (const uint4*)(proj + (size_t)(b * SEQ + c * 64 + tt) * DIN + 2048 + g * 16);
          const uint4 ua = up[0], ub = up[1];
          u[0] = bf_lo(ua.x); u[1] = bf_hi(ua.x); u[2] = bf_lo(ua.y); u[3] = bf_hi(ua.y);
          u[4] = bf_lo(ua.z); u[5] = bf_hi(ua.z); u[6] = bf_lo(ua.w); u[7] = bf_hi(ua.w);
          u[8] = bf_lo(ub.x); u[9] = bf_hi(ub.x); u[10] = bf_lo(ub.y); u[11] = bf_hi(ub.y);
          u[12] = bf_lo(ub.z); u[13] = bf_hi(ub.z); u[14] = bf_lo(ub.w); u[15] = bf_hi(ub.w);
        }
        float br = 0.f, bi = 0.f;
#pragma unroll
        for (int h = 0; h < 16; h++) {
          const float uh = u[h];
          br += bbr[h] * uh;
          bi += bbi[h] * uh;
        }
        const float nr = lbr * xr - lbi * xi + br;
        const float ni = lbr * xi + lbi * xr + bi;
        xr = nr; xi = ni;
        float v[16];
#pragma unroll
        for (int h = 0; h < 16; h++) v[h] = xr * ccr[h] - xi * cci[h];
        float v8[8], v4[4], v2[2], v1;
        {
          const bool hi = (lane & 32) != 0;
#pragma unroll
          for (int i = 0; i < 8; i++) {
            const float send = hi ? v[i] : v[i + 8];
            const float keep = hi ? v[i + 8] : v[i];
            v8[i] = keep + __shfl_xor(send, 32, 64);
          }
        }
        {
          const bool hi = (lane & 16) != 0;
#pragma unroll
          for (int i = 0; i < 4; i++) {
            const float send = hi ? v8[i] : v8[i + 4];
            const float keep = hi ? v8[i + 4] : v8[i];
            v4[i] = keep + __shfl_xor(send, 16, 64);
          }
        }
        {
          const bool hi = (lane & 8) != 0;
#pragma unroll
          for (int i = 0; i < 2; i++) {
            const float send = hi ? v4[i] : v4[i + 2];
            const float keep = hi ? v4[i + 2] : v4[i];
            v2[i] = keep + __shfl_xor(send, 8, 64);
          }
        }
        {
          const bool hi = (lane & 4) != 0;
          const float send = hi ? v2[0] : v2[1];
          const float keep = hi ? v2[1] : v2[0];
          v1 = keep + __shfl_xor(send, 4, 64);
        }
        v1 += __shfl_xor(v1, 2, 64);
        v1 += __shfl_xor(v1, 1, 64);
        if ((lane & 3) == 0) {
          float uq = u[0];
#pragma unroll
          for (int h = 1; h < 16; h++) uq = (hq == h) ? u[h] : uq;
          const float yy = v1 + dh * uq;
          Yt[tt][g * 16 + hq] = gelu_tanh(yy);
        }
      }
    }
    __syncthreads();
    {
      const int j = tid & 255, th = tid >> 8;
      const float bj = glb[j];
      for (int t0 = th * 32; t0 < th * 32 + 32; t0 += 8) {
        float acc[8];
#pragma unroll
        for (int i = 0; i < 8; i++) acc[i] = 0.f;
        for (int k = 0; k < 256; k++) {
          const float w = glw[k * 256 + j];
#pragma unroll
          for (int i = 0; i < 8; i++) acc[i] += Yt[t0 + i][k] * w;
        }
        __syncthreads();
#pragma unroll
        for (int i = 0; i < 8; i++) {
          const float yv = Yt[t0 + i][j];
          Yt[t0 + i][j] = yv * sigmoidf_(acc[i] + bj);
        }
      }
    }
    __syncthreads();
    for (int i = 0; i < 8; i++) {
      const int tt = wave * 8 + i;
      const float4 v = *(const float4*)&Yt[tt][lane * 4];
      const float ss = wsum(v.x * v.x + v.y * v.y + v.z * v.z + v.w * v.w) * (1.0f / 256.f);
      const float rs = rsqrtf(ss + EPSF);
      const float4 g4 = ((const float4*)gg)[lane];
      uint2 pk;
      pk.x = pk2(v.x * rs * g4.x, v.y * rs * g4.y);
      pk.y = pk2(v.z * rs * g4.z, v.w * rs * g4.w);
      ((uint2*)(y + (size_t)(b * SEQ + c * 64 + tt) * DM + 768))[lane] = pk;
    }
  }
}

#define MFMA_PAD() do { __builtin_amdgcn_sched_barrier(0); asm volatile("s_nop 15\n\ts_nop 15" ::: "memory"); __builtin_amdgcn_sched_barrier(0); } while (0)

__device__ __forceinline__ void memattn_phase(const bf16* q, const bf16* kvb, const bf16* vT, bf16* o) {
  const int tid_ = opaque_tid();
  const int lane = tid_ & 63, n = lane & 31, hh = lane >> 5;
  const int gw = blockIdx.x * NWAVES + (tid_ >> 6);
  const int nw = gridDim.x * NWAVES;
  const int sig = (n & 0x13) | ((n & 4) << 1) | ((n & 8) >> 1);
  for (int it = gw; it < 512 * 4; it += nw) {
    const int h = it & 3, tok0 = (it >> 2) * 32, b = tok0 >> 12;
    f32x16_t st[8];
#pragma unroll
    for (int kt = 0; kt < 8; kt++)
#pragma unroll
      for (int r = 0; r < 16; r++) st[kt][r] = 0.f;
    const bf16* qrow = q + (size_t)(tok0 + n) * DM + h * 256 + 8 * hh;
    const bf16* kbase = kvb + (size_t)(b * NMEM + sig) * 2048 + h * 256 + 8 * hh;
#pragma unroll
    for (int kq = 0; kq < 4; kq++) {
      bf16x8_t qf[4];
#pragma unroll
      for (int i = 0; i < 4; i++) qf[i] = *(const bf16x8_t*)(qrow + 16 * (kq * 4 + i));
#pragma unroll
      for (int kt = 0; kt < 8; kt++) {
        const bf16* krow = kbase + (size_t)kt * 32 * 2048;
        bf16x8_t kf[4];
#pragma unroll
        for (int i = 0; i < 4; i++) kf[i] = *(const bf16x8_t*)(krow + 16 * (kq * 4 + i));
        MFMA_PAD();
#pragma unroll
        for (int i = 0; i < 4; i++) st[kt] = __builtin_amdgcn_mfma_f32_32x32x16_bf16(kf[i], qf[i], st[kt], 0, 0, 0);
        MFMA_PAD();
      }
    }
    float mx = st[0][0];
#pragma unroll
    for (int kt = 0; kt < 8; kt++)
#pragma unroll
      for (int r = 0; r < 16; r++) mx = fmaxf(mx, st[kt][r]);
    mx = fmaxf(mx, __shfl_xor(mx, 32, 64));
    float sum = 0.f;
#pragma unroll
    for (int kt = 0; kt < 8; kt++)
#pragma unroll
      for (int r = 0; r < 16; r++) { const float e = __expf((st[kt][r] - mx) * 0.0625f); st[kt][r] = e; sum += e; }
    sum += __shfl_xor(sum, 32, 64);
    const float inv = 1.0f / sum;
    bf16x8_t pf[8][2];
#pragma unroll
    for (int kt = 0; kt < 8; kt++)
#pragma unroll
      for (int s = 0; s < 2; s++)
#pragma unroll
        for (int j = 0; j < 8; j++) pf[kt][s][j] = (short)f2bf(st[kt][8 * s + j] * inv);
    const bf16* vbase = vT + ((size_t)(b * 4 + h) * 256 + n) * 256 + 8 * hh;
#pragma unroll 1
    for (int dt = 0; dt < 8; dt++) {
      f32x16_t oacc;
#pragma unroll
      for (int r = 0; r < 16; r++) oacc[r] = 0.f;
      const bf16* vrow = vbase + (size_t)dt * 32 * 256;
#pragma unroll
      for (int kq = 0; kq < 4; kq++) {
        bf16x8_t vf[4];
#pragma unroll
        for (int i = 0; i < 4; i++) vf[i] = *(const bf16x8_t*)(vrow + (kq * 2 + (i >> 1)) * 32 + 16 * (i & 1));
        MFMA_PAD();
#pragma unroll
        for (int i = 0; i < 4; i++) oacc = __builtin_amdgcn_mfma_f32_32x32x16_bf16(pf[kq * 2 + (i >> 1)][i & 1], vf[i], oacc, 0, 0, 0);
        MFMA_PAD();
      }
#pragma unroll
      for (int r = 0; r < 16; r++) {
        const int qi = (r & 3) + 8 * (r >> 2) + 4 * hh;
        o[(size_t)(tok0 + qi) * DM + h * 256 + dt * 32 + n] = (bf16)f2bf(oacc[r]);
      }
    }
  }
}

__device__ __forceinline__ void vt_phase(const bf16* kvb, bf16* vT) {
  const int tid_ = opaque_tid();
  const int gt = blockIdx.x * (NWAVES * 64) + tid_;
  const int nth = gridDim.x * NWAVES * 64;
  for (int i = gt; i < 2 * 4 * 4 * 256 * 256; i += nth) {
    const int m = i & 255, d = (i >> 8) & 255, h = (i >> 16) & 3, b = (i >> 18) & 3, l = i >> 20;
    vT[i] = kvb[((size_t)l * 1024 + b * 256 + m) * 2048 + 1024 + h * 256 + d];
  }
}

__device__ __forceinline__ void topk_rounds(float (&s)[64], int hh, float (&tv)[16], int (&ti)[16]) {
  const float NEG = -3.0e38f;
#pragma unroll 1
  for (int r = 0; r < 16; r++) {
    float m = s[0]; int slot = 0;
#pragma unroll
    for (int i = 1; i < 64; i++) {
      const bool gt = s[i] > m;
      m = gt ? s[i] : m;
      slot = gt ? i : slot;
    }
    const int rr = slot & 15;
    const int idx = (slot >> 4) * 32 + (rr & 3) + 8 * (rr >> 2) + 4 * hh;
    const float pm = __shfl_xor(m, 32, 64);
    const int pidx = __shfl_xor(idx, 32, 64);
    const bool mine = (m > pm) || (m == pm && idx < pidx);
    const float wv = mine ? m : pm;
    const int wi = mine ? idx : pidx;
#pragma unroll
    for (int j = 0; j < 16; j++) { tv[j] = (r == j) ? wv : tv[j]; ti[j] = (r == j) ? wi : ti[j]; }
    const int kill = mine ? slot : -1;
#pragma unroll
    for (int i = 0; i < 64; i++) s[i] = (kill == i) ? NEG : s[i];
  }
}

__device__ __forceinline__ void peer_topk(const bf16* pq, const bf16* skb, int* ids, float* gates) {
  const int tid_ = opaque_tid();
  const int lane = tid_ & 63, n = lane & 31, hh = lane >> 5;
  const int gw = blockIdx.x * NWAVES + (tid_ >> 6);
  const int nw = gridDim.x * NWAVES;
  const float NEG = -3.0e38f;
  for (int it = gw; it < 512 * 8; it += nw) {
    const int h = it & 7, tok0 = (it >> 3) * 32;
    float tv0[16], tv1[16];
    int ti0[16], ti1[16];
#pragma unroll
    for (int j = 0; j < 16; j++) { tv0[j] = 0.f; tv1[j] = 0.f; ti0[j] = 0; ti1[j] = 0; }
#pragma unroll
    for (int half = 0; half < 2; half++) {
      bf16x8_t qf[8];
      {
        const bf16* qrow = pq + (size_t)(tok0 + n) * 2048 + h * 256 + half * 128 + 8 * hh;
#pragma unroll
        for (int ks = 0; ks < 8; ks++) qf[ks] = *(const bf16x8_t*)(qrow + 16 * ks);
      }
      f32x16_t st[4];
#pragma unroll
      for (int kt = 0; kt < 4; kt++) {
        const bf16* krow = skb + ((size_t)((h * 2 + half) * 128 + kt * 32 + n)) * 128 + 8 * hh;
        asm volatile("" : "+v"(krow));
        f32x16_t acc;
#pragma unroll
        for (int r = 0; r < 16; r++) acc[r] = 0.f;
#pragma unroll
        for (int kq = 0; kq < 2; kq++) {
          bf16x8_t kf[4];
#pragma unroll
          for (int i = 0; i < 4; i++) kf[i] = *(const bf16x8_t*)(krow + 16 * (kq * 4 + i));
          MFMA_PAD();
#pragma unroll
          for (int i = 0; i < 4; i++) acc = __builtin_amdgcn_mfma_f32_32x32x16_bf16(kf[i], qf[kq * 4 + i], acc, 0, 0, 0);
          MFMA_PAD();
        }
        st[kt] = acc;
      }
      float s[64];
#pragma unroll
      for (int kt = 0; kt < 4; kt++)
#pragma unroll
        for (int i = 0; i < 16; i++) s[kt * 16 + i] = st[kt][i];
      __builtin_amdgcn_sched_barrier(0);
      if (half == 0) topk_rounds(s, hh, tv0, ti0); else topk_rounds(s, hh, tv1, ti1);
      __builtin_amdgcn_sched_barrier(0);
    }
    float F[16];
    int ba[16];
#pragma unroll
    for (int a = 0; a < 16; a++) { F[a] = tv0[a] + tv1[0]; ba[a] = 0; }
    float bv[16];
    int be[16];
#pragma unroll
    for (int j = 0; j < 16; j++) { bv[j] = 0.f; be[j] = 0; }
#pragma unroll 1
    for (int r = 0; r < 16; r++) {
      float m = F[0]; int a = 0;
#pragma unroll
      for (int i = 1; i < 16; i++) { const bool gt = F[i] > m; m = gt ? F[i] : m; a = gt ? i : a; }
      int bsel = 0, i0 = 0; float t0 = 0.f;
#pragma unroll
      for (int i = 0; i < 16; i++) { const bool is = (a == i); bsel = is ? ba[i] : bsel; i0 = is ? ti0[i] : i0; t0 = is ? tv0[i] : t0; }
      int i1 = 0; float t1n = NEG;
#pragma unroll
      for (int i = 0; i < 16; i++) { i1 = (bsel == i) ? ti1[i] : i1; t1n = (bsel + 1 == i) ? tv1[i] : t1n; }
      const int e = i0 * 128 + i1;
      const float fn = (bsel + 1 < 16) ? (t0 + t1n) : NEG;
#pragma unroll
      for (int i = 0; i < 16; i++) { const bool is = (a == i); F[i] = is ? fn : F[i]; ba[i] = is ? (bsel + 1) : ba[i]; }
#pragma unroll
      for (int j = 0; j < 16; j++) { bv[j] = (r == j) ? m : bv[j]; be[j] = (r == j) ? e : be[j]; }
    }
    const float b0 = bv[0];
    float ge[16];
    float gsum = 0.f;
#pragma unroll
    for (int r = 0; r < 16; r++) { ge[r] = __expf(bv[r] - b0); gsum += ge[r]; }
    const float ginv = 1.0f / gsum;
    if (hh == 0) {
      int* ip = ids + (size_t)(tok0 + n) * 128 + h * 16;
      float* gp = gates + (size_t)(tok0 + n) * 128 + h * 16;
#pragma unroll
      for (int r4 = 0; r4 < 4; r4++) {
        *(int4*)(ip + 4 * r4) = make_int4(be[4 * r4], be[4 * r4 + 1], be[4 * r4 + 2], be[4 * r4 + 3]);
        *(float4*)(gp + 4 * r4) = make_float4(ge[4 * r4] * ginv, ge[4 * r4 + 1] * ginv, ge[4 * r4 + 2] * ginv, ge[4 * r4 + 3] * ginv);
      }
    }
  }
}

typedef __bf16 bf16x2_t __attribute__((ext_vector_type(2)));
__device__ __forceinline__ float dot2bf(unsigned a, unsigned b, float c) {
  return __builtin_amdgcn_fdot2_f32_bf16(__builtin_bit_cast(bf16x2_t, a), __builtin_bit_cast(bf16x2_t, b), c, false);
}
__device__ __forceinline__ void peer_gather(const bf16* xn, const bf16* ub, const bf16* vb,
                                            const int* ids, const float* gates, float* xw) {
  const int tid_ = opaque_tid();
  const int lane = tid_ & 63;
  const int gw = blockIdx.x * NWAVES + (tid_ >> 6);
  const int nw = gridDim.x * NWAVES;
  const int el = ((lane >> 5) & 1) * 4 + ((lane >> 4) & 1) * 2 + ((lane >> 3) & 1);
  for (int tok = gw; tok < NT; tok += nw) {
    uint4 xp[2];
    xp[0] = *(const uint4*)(xn + (size_t)tok * DM + lane * 8);
    xp[1] = *(const uint4*)(xn + (size_t)tok * DM + 512 + lane * 8);
    float acc[16];
#pragma unroll
    for (int i = 0; i < 16; i++) acc[i] = 0.f;
#pragma unroll 1
    for (int g = 0; g < 16; g++) {
      const int idv = ids[(size_t)tok * 128 + g * 8 + (lane & 7)];
      const float gv = gates[(size_t)tok * 128 + g * 8 + el];
      uint4 uu[8][2], vv[8][2];
#pragma unroll
      for (int e = 0; e < 8; e++) {
        const int id = __builtin_amdgcn_readlane(idv, e);
        const bf16* ur = ub + (size_t)id * DM + lane * 8;
        const bf16* vr = vb + (size_t)id * DM + lane * 8;
        uu[e][0] = *(const uint4*)ur; uu[e][1] = *(const uint4*)(ur + 512);
        vv[e][0] = *(const uint4*)vr; vv[e][1] = *(const uint4*)(vr + 512);
      }
      float d[8];
#pragma unroll
      for (int e = 0; e < 8; e++) {
        float s = 0.f;
        s = dot2bf(uu[e][0].x, xp[0].x, s); s = dot2bf(uu[e][0].y, xp[0].y, s);
        s = dot2bf(uu[e][0].z, xp[0].z, s); s = dot2bf(uu[e][0].w, xp[0].w, s);
        s = dot2bf(uu[e][1].x, xp[1].x, s); s = dot2bf(uu[e][1].y, xp[1].y, s);
        s = dot2bf(uu[e][1].z, xp[1].z, s); s = dot2bf(uu[e][1].w, xp[1].w, s);
        d[e] = s;
      }
      float d4[4], d2[2], d1;
      {
        const bool hi = (lane & 32) != 0;
#pragma unroll
        for (int i = 0; i < 4; i++) {
          const float send = hi ? d[i] : d[i + 4];
          const float keep = hi ? d[i + 4] : d[i];
          d4[i] = keep + __shfl_xor(send, 32, 64);
        }
      }
      {
        const bool hi = (lane & 16) != 0;
#pragma unroll
        for (int i = 0; i < 2; i++) {
          const float send = hi ? d4[i] : d4[i + 2];
          const float keep = hi ? d4[i + 2] : d4[i];
          d2[i] = keep + __shfl_xor(send, 16, 64);
        }
      }
      {
        const bool hi = (lane & 8) != 0;
        const float send = hi ? d2[0] : d2[1];
        const float keep = hi ? d2[1] : d2[0];
        d1 = keep + __shfl_xor(send, 8, 64);
      }
      d1 += __shfl_xor(d1, 4, 64);
      d1 += __shfl_xor(d1, 2, 64);
      d1 += __shfl_xor(d1, 1, 64);
      const float wl = gv * gelu_tanh(d1);
#pragma unroll
      for (int e = 0; e < 8; e++) {
        const float w = __builtin_bit_cast(float, __builtin_amdgcn_readlane(__builtin_bit_cast(int, wl), ((e >> 2) & 1) * 32 + ((e >> 1) & 1) * 16 + (e & 1) * 8));
        const unsigned vw[8] = {vv[e][0].x, vv[e][0].y, vv[e][0].z, vv[e][0].w, vv[e][1].x, vv[e][1].y, vv[e][1].z, vv[e][1].w};
#pragma unroll
        for (int k = 0; k < 8; k++) {
          acc[2 * k] += w * bf_lo(vw[k]);
          acc[2 * k + 1] += w * bf_hi(vw[k]);
        }
      }
    }
    float* xr = xw + (size_t)tok * DM + lane * 8;
#pragma unroll
    for (int c = 0; c < 2; c++) {
      float4 a0 = *(float4*)(xr + c * 512), a1 = *(float4*)(xr + c * 512 + 4);
      a0.x += acc[c * 8 + 0]; a0.y += acc[c * 8 + 1]; a0.z += acc[c * 8 + 2]; a0.w += acc[c * 8 + 3];
      a1.x += acc[c * 8 + 4]; a1.y += acc[c * 8 + 5]; a1.z += acc[c * 8 + 6]; a1.w += acc[c * 8 + 7];
      *(float4*)(xr + c * 512) = a0; *(float4*)(xr + c * 512 + 4) = a1;
    }
  }
}

__device__ __forceinline__ void prologue_transposes(const Params& p, unsigned char* ws, LAS unsigned char* lds) {
  const int tid_ = opaque_tid();
  const int lane = tid_ & 63, wave = tid_ >> 6;
  LAS float* scr = (LAS float*)(lds + wave * 16384);
  const int gw = blockIdx.x * NWAVES + wave, NGW = gridDim.x * NWAVES;
  constexpr int I_IN = (DM / 64) * (DIN / 32), I_SQ = (DM / 64) * (DM / 32), I_2K = (DM / 64) * (2048 / 32);
  constexpr int PER_LAYER = I_IN + 3 * I_SQ + 2 * I_2K;
  const float* w3 = karg_in(3); const float* w19 = karg_in(19); const float* w22 = karg_in(22);
  const float* w23 = karg_in(23); const float* w24 = karg_in(24); const float* w26 = karg_in(26);
  for (int it = gw; it < 2 * PER_LAYER; it += NGW) {
    const int l = it / PER_LAYER;
    int r = it % PER_LAYER;
    unsigned char* wl = ws + WS_WT + (size_t)l * WT_LAYER;
    if (r < I_IN) { transpose_item(w3 + (size_t)l * DM * DIN, DM, DIN, (bf16*)(wl + WT_IN), scr, r, lane); continue; } r -= I_IN;
    if (r < I_SQ) { transpose_item(w19 + (size_t)l * DM * DM, DM, DM, (bf16*)(wl + WT_OUT), scr, r, lane); continue; } r -= I_SQ;
    if (r < I_SQ) { transpose_item(w22 + (size_t)l * DM * DM, DM, DM, (bf16*)(wl + WT_MQ), scr, r, lane); continue; } r -= I_SQ;
    if (r < I_2K) { transpose_item(w23 + (size_t)l * DM * 2048, DM, 2048, (bf16*)(wl + WT_MKV), scr, r, lane); continue; } r -= I_2K;
    if (r < I_SQ) { transpose_item(w24 + (size_t)l * DM * DM, DM, DM, (bf16*)(wl + WT_MO), scr, r, lane); continue; } r -= I_SQ;
    transpose_item(w26 + (size_t)l * DM * 2048, DM, 2048, (bf16*)(wl + WT_PQ), scr, r, lane);
  }
}

template <class T> __device__ __forceinline__ T* opq(T* p) { asm volatile("" : "+s"(p)); return p; }
__device__ __forceinline__ void cvt_rows_bf16(const float* src, bf16* dst, size_t n) {
  const int tid_ = opaque_tid();
  const size_t gt = (size_t)blockIdx.x * (NWAVES * 64) + tid_;
  const size_t nth = (size_t)gridDim.x * NWAVES * 64;
  for (size_t i = gt; i < n / 8; i += nth) {
    const float4 a = ((const float4*)src)[2 * i], b = ((const float4*)src)[2 * i + 1];
    uint4 o; o.x = pk2(a.x, a.y); o.y = pk2(a.z, a.w); o.z = pk2(b.x, b.y); o.w = pk2(b.z, b.w);
    ((uint4*)dst)[i] = o;
  }
}

#define GEMM_F32(Aptr, Wt, Cptr, Rptr, M_, N_) do { \
    pg8::Gemm g_{opq((const bf16*)(Aptr)), opq((const bf16*)(Wt)), (M_), (N_), DM}; pg8::StaticOrder S_; S_.init((M_), (N_), (int)gridDim.x, (int)blockIdx.x); \
    pg8::EpiF32R E_{opq((float*)(Cptr)), opq((const float*)(Rptr)), (N_)}; \
    pg8::gemm_phase<pg8::EpiF32R, pg8::StaticOrder, true, true>(ldsl, g_, S_, E_); } while (0)
#define GEMM_BF16(Aptr, Wt, Optr, M_, N_) do { \
    pg8::Gemm g_{opq((const bf16*)(Aptr)), opq((const bf16*)(Wt)), (M_), (N_), DM}; pg8::StaticOrder S_; S_.init((M_), (N_), (int)gridDim.x, (int)blockIdx.x); \
    pg8::EpiBf16 E_{opq((bf16*)(Optr)), (N_)}; \
    pg8::gemm_phase<pg8::EpiBf16, pg8::StaticOrder, true, true>(ldsl, g_, S_, E_); } while (0)

__global__ void __launch_bounds__(NWAVES * 64, 2) fwd_megakernel(Params p) {
  cg::grid_group grid = cg::this_grid();
  extern __shared__ __attribute__((aligned(16))) unsigned char lds[];
  LAS unsigned char* ldsl = (LAS unsigned char*)lds;
  LAS float* smem = (LAS float*)ldsl;
  unsigned char* ws = p.ws;
  volatile LAS unsigned* MISC = (volatile LAS unsigned*)(ldsl + 131072);
  if (threadIdx.x < 64) MISC[threadIdx.x] = 0u;
  __syncthreads();
  const XcdBarrier bar = xcd_barrier_post((unsigned*)(ws + WS_CTL) + 4096, MISC + 8);
  grid.sync();
  float* xw = (float*)(ws + WS_XW);
  bf16* xn = (bf16*)(ws + WS_XN);
  bf16* big = (bf16*)(ws + WS_BIG);
  bf16* y = (bf16*)(ws + WS_Y);
  bf16* memh = (bf16*)(ws + WS_MEMH);
  bf16* kvb = (bf16*)(ws + WS_KVB);
  bf16* vT = (bf16*)(ws + WS_VT);
  float* ssmE = (float*)(ws + WS_SSME);
  float* ssmp = (float*)(ws + WS_SSMP);
  int* ids = (int*)(ws + WS_IDS);
  float* gates = (float*)(ws + WS_GATE);
  bf16* skb = (bf16*)(ws + WS_SKB);
  bf16* ub = (bf16*)(ws + WS_UB);
  bf16* vb = (bf16*)(ws + WS_VB);

  prologue_transposes(p, ws, ldsl);
  cvt_rows_bf16(karg_in(27), skb, (size_t)2 * 8 * 2 * 128 * 128);
  cvt_rows_bf16(karg_in(28), ub, (size_t)2 * 16384 * 1024);
  cvt_rows_bf16(karg_in(29), vb, (size_t)2 * 16384 * 1024);
  for (int l = 0; l < 2; l++)
    rms_rows<true>(karg_in(1), karg_in(21) + l * DM, memh + (size_t)l * 1024 * 1024, 1024);
  ssm_params(p, ssmp);
  xcd_barrier(bar);
  for (int l = 0; l < 2; l++)
    GEMM_BF16(memh + (size_t)l * 1024 * 1024, ws + WS_WT + (size_t)l * WT_LAYER + WT_MKV,
              kvb + (size_t)l * 1024 * 2048, 1024, 2048);

#pragma nounroll
  for (int l = 0; l < 2; l++) {
    const float* xcur = (l == 0) ? karg_in(0) : xw;
    const float* sp = ssmp + (size_t)l * SSMP_PER_LAYER;
    const unsigned char* wl = ws + WS_WT + (size_t)l * WT_LAYER;
    rms_rows<true>(xcur, karg_in(2) + l * DM, xn, NT);
    xcd_barrier(bar);
    GEMM_BF16(xn, wl + WT_IN, big, NT, DIN);
    xcd_barrier(bar);
    if (l == 0) vt_phase(kvb, vT);
    ssm_chunk_end(sp, big, ssmE);
    attn_phase(p, l, big, y, smem);
    conv_phase(p, l, big, y);
    xcd_barrier(bar);
    ssm_finish(p, l, sp, big, ssmE, y, smem);
    xcd_barrier(bar);
    GEMM_F32(y, wl + WT_OUT, xw, xcur, NT, DM);
    xcd_barrier(bar);
    rms_rows<true>(xw, karg_in(20) + l * DM, xn, NT);
    xcd_barrier(bar);
    GEMM_BF16(xn, wl + WT_MQ, big, NT, DM);
    xcd_barrier(bar);
    memattn_phase(big, kvb + (size_t)l * 1024 * 2048, vT + (size_t)l * 4 * 4 * 256 * 256, y);
    xcd_barrier(bar);
    GEMM_F32(y, wl + WT_MO, xw, (const float*)xw, NT, DM);
    xcd_barrier(bar);
    rms_rows<true>(xw, karg_in(25) + l * DM, xn, NT);
    xcd_barrier(bar);
    GEMM_BF16(xn, wl + WT_PQ, big, NT, 2048);
    xcd_barrier(bar);
    peer_topk(big, skb + (size_t)l * 8 * 2 * 128 * 128, ids, gates);
    xcd_barrier(bar);
    peer_gather(xn, ub + (size_t)l * 16384 * DM, vb + (size_t)l * 16384 * DM, ids, gates, xw);
    xcd_barrier(bar);
  }
  rms_rows<false>(xw, karg_in(30), p.out, NT);
}

extern "C" void kernel_launch(void* const* d_in, const int* in_sizes, int n_in,
                              void* d_out, int out_size, void* d_ws, size_t ws_size,
                              hipStream_t stream) {
  static int grid_blocks = 0;
  if (!grid_blocks) {
    int dev = 0, cus = 0, per_cu = 0;
    (void)hipGetDevice(&dev);
    (void)hipDeviceGetAttribute(&cus, hipDeviceAttributeMultiprocessorCount, dev);
    (void)hipFuncSetAttribute((const void*)fwd_megakernel, hipFuncAttributeMaxDynamicSharedMemorySize, LDS_BYTES);
    (void)hipOccupancyMaxActiveBlocksPerMultiprocessor(&per_cu, fwd_megakernel, NWAVES * 64, LDS_BYTES);
    if (per_cu < 1) fprintf(stderr, "occupancy query reports %d blocks/CU\n", per_cu);
    grid_blocks = cus;
  }
  (void)hipMemsetAsync((char*)d_ws + WS_CTL, 0, 1 * MiB, stream);
  Params p{};
  for (int i = 0; i < 31; i++) p.in[i] = (const float*)d_in[i];
  p.out = (float*)d_out;
  p.ws = (unsigned char*)d_ws;
  void* args[] = {&p};
  hipError_t e = hipLaunchCooperativeKernel((void*)fwd_megakernel, dim3(grid_blocks), dim3(NWAVES * 64),
                                            args, LDS_BYTES, stream);
  if (e != hipSuccess)
    fprintf(stderr, "cooperative launch failed: %s (grid %d)\n", hipGetErrorString(e), grid_blocks);
}
```

```cpp
#include <hip/hip_runtime.h>
#include <hip/hip_cooperative_groups.h>
#include <cstdio>
namespace cg = cooperative_groups;

#define NT 16384
#define SEQ 4096
#define DM 1024
#define DIN 2304
#define NMEM 256
#define EPSF 1e-6f
#define NWAVES 8
#define LDS_BYTES 147456

typedef unsigned short bf16;
#define LAS __attribute__((address_space(3)))

struct Params {
  const float* in[31];
  float* out;
  unsigned char* ws;
};
typedef __attribute__((address_space(4))) const unsigned char* kaptr_t;
__device__ __forceinline__ const float* karg_in(int i) {
  kaptr_t ka = (kaptr_t)__builtin_amdgcn_kernarg_segment_ptr();
  asm volatile("" : "+s"(ka));
  return *(const float* __attribute__((address_space(4))) const*)(ka + 8 * i);
}

constexpr size_t MiB = 1u << 20;
constexpr size_t WS_CTL  = 0;
constexpr size_t WS_WT   = 1 * MiB;
constexpr size_t WT_IN = 0, WT_OUT = WT_IN + (size_t)DIN * DM * 2, WT_MQ = WT_OUT + (size_t)DM * DM * 2,
                 WT_MKV = WT_MQ + (size_t)DM * DM * 2, WT_MO = WT_MKV + (size_t)2048 * DM * 2,
                 WT_PQ = WT_MO + (size_t)DM * DM * 2, WT_LAYER = WT_PQ + (size_t)2048 * DM * 2;
constexpr size_t WS_XW   = WS_WT + 2 * WT_LAYER;
constexpr size_t WS_XN   = WS_XW + (size_t)NT * DM * 4;
constexpr size_t WS_BIG  = WS_XN + (size_t)NT * DM * 2;
constexpr size_t WS_Y    = WS_BIG + (size_t)NT * DIN * 2;
constexpr size_t WS_MEMH = WS_Y + (size_t)NT * DM * 2;
constexpr size_t WS_KVB  = WS_MEMH + (size_t)2 * 1024 * 1024 * 2;
constexpr size_t WS_VT   = WS_KVB + (size_t)2 * 1024 * 2048 * 2;
constexpr size_t WS_SSME = WS_VT + (size_t)2 * 4 * 4 * 256 * 256 * 2;
#define SSMP_PER_LAYER (2048 + 2048 + 32768)
constexpr size_t WS_SSMP = WS_SSME + (size_t)4 * 64 * 16 * 64 * 2 * 4;
constexpr size_t WS_IDS  = WS_SSMP + (size_t)2 * SSMP_PER_LAYER * 4;
constexpr size_t WS_GATE = WS_IDS + (size_t)NT * 128 * 4;
constexpr size_t WS_SKB  = WS_GATE + (size_t)NT * 128 * 4;
constexpr size_t WS_UB   = WS_SKB + (size_t)2 * 8 * 2 * 128 * 128 * 2;
constexpr size_t WS_VB   = WS_UB + (size_t)2 * 16384 * 1024;
constexpr size_t WS_END  = WS_VB + (size_t)2 * 16384 * 1024;
#define U_SCALE 64.0f
#define V_SCALE 8.0f
static_assert(WS_END <= 512 * MiB, "workspace");
static_assert(WT_LAYER % 256 == 0 && WS_SSMP % 16 == 0 && WS_IDS % 16 == 0 && WS_SKB % 256 == 0 && WS_VT % 256 == 0, "align");

__device__ __forceinline__ int opaque_tid() { int v = threadIdx.x; asm volatile("" : "+v"(v)); return v; }
__device__ __forceinline__ unsigned f2bf(float f) { unsigned u = __builtin_bit_cast(unsigned, f); return (u + 0x7fffu + ((u >> 16) & 1u)) >> 16; }
__device__ __forceinline__ unsigned pk2(float lo, float hi) { return f2bf(lo) | (f2bf(hi) << 16); }
__device__ __forceinline__ float bf_lo(unsigned u) { return __builtin_bit_cast(float, u << 16); }
__device__ __forceinline__ float bf_hi(unsigned u) { return __builtin_bit_cast(float, u & 0xffff0000u); }
__device__ __forceinline__ float bf2f(bf16 h) { return __builtin_bit_cast(float, (unsigned)h << 16); }


#define XB_TMO      128
#define XB_XCNT(j)  (256  + 64 * (j))
#define XB_XSUB(j)  (1280 + 64 * (j))
#define XB_XGEN(j)  (2304 + 64 * (j))
#define XB_TOP      3328
#define XB_TOPGEN   3392
#define XCD_BAR_WORDS 3456
#define XB_SPIN_CAP (1u << 22)
__device__ __forceinline__ unsigned xb_ld(unsigned* p)              { return __hip_atomic_load(p, __ATOMIC_RELAXED, __HIP_MEMORY_SCOPE_AGENT); }
__device__ __forceinline__ unsigned xb_add(unsigned* p, unsigned v) { return __hip_atomic_fetch_add(p, v, __ATOMIC_RELAXED, __HIP_MEMORY_SCOPE_AGENT); }
__device__ __forceinline__ unsigned xb_xcc_id() { return (unsigned)__builtin_amdgcn_s_getreg((3 << 11) | 20) & 0xFu; }
#define XB_SPIN(cond, bar) do { unsigned _sp = 0; while (cond) { __builtin_amdgcn_s_sleep(1); \
    if ((++_sp & 255u) == 0u) { if (xb_ld(&(bar)[XB_TMO])) break; if (_sp > XB_SPIN_CAP) { atomicAdd(&(bar)[XB_TMO], 1u); break; } } } } while (0)
struct XcdBarrier { unsigned* bar; unsigned x; volatile LAS unsigned* st; };
__device__ __forceinline__ XcdBarrier xcd_barrier_post(unsigned* bar, volatile LAS unsigned* st) {
    XcdBarrier b; b.bar = bar; b.x = xb_xcc_id(); b.st = st;
    if (threadIdx.x == 0) (void)xb_add(&bar[XB_XCNT(b.x)], 1u);
    return b;
}
__device__ __forceinline__ void xcd_barrier_complete(unsigned* bar, unsigned x, unsigned& nloc, unsigned& nx) {
    const unsigned G = gridDim.x * gridDim.y * gridDim.z;
    unsigned sum, cnt, mine, sp = 0u;
    for (;;) {
        sum = 0u; cnt = 0u; mine = 0u;
#pragma unroll
        for (unsigned j = 0; j < 16; ++j) { const unsigned c = xb_ld(&bar[XB_XCNT(j)]); sum += c; cnt += (c > 0u) ? 1u : 0u; mine = (j == x) ? c : mine; }
        if (sum == G) break;
        __builtin_amdgcn_s_sleep(1);
        if ((++sp & 255u) == 0u) { if (xb_ld(&bar[XB_TMO])) break; if (sp > XB_SPIN_CAP) { atomicAdd(&bar[XB_TMO], 1u); break; } }
    }
    nloc = mine > 0u ? mine : 1u; nx = cnt > 0u ? cnt : 1u;
}
__device__ __forceinline__ void xcd_barrier(const XcdBarrier& b) {
    asm volatile("s_waitcnt vmcnt(0)" ::: "memory");
    __syncthreads();
    if (threadIdx.x == 0) {
        unsigned* bar = b.bar;
        __builtin_amdgcn_s_waitcnt(0);
        unsigned nloc = b.st[0], nx = b.st[1];
        if (nloc == 0u) { xcd_barrier_complete(bar, b.x, nloc, nx); b.st[0] = nloc; b.st[1] = nx; }
        const unsigned old = xb_add(&bar[XB_XSUB(b.x)], 1u);
        const unsigned gen = old / nloc;
        if (old + 1u == (gen + 1u) * nloc) {
            __builtin_amdgcn_fence(__ATOMIC_RELEASE, "agent");
            asm volatile("s_waitcnt vmcnt(0)" ::: "memory");
            const unsigned og = xb_add(&bar[XB_TOP], 1u);
            const unsigned tg = og / nx;
            if (og + 1u == (tg + 1u) * nx) xb_add(&bar[XB_TOPGEN], 1u);
            else XB_SPIN(xb_ld(&bar[XB_TOPGEN]) == tg, bar);
            __builtin_amdgcn_fence(__ATOMIC_ACQUIRE, "agent");
            xb_add(&bar[XB_XGEN(b.x)], 1u);
            asm volatile("s_waitcnt vmcnt(0)" ::: "memory");
        } else {
            XB_SPIN(xb_ld(&bar[XB_XGEN(b.x)]) == gen, bar);
            __builtin_amdgcn_fence(__ATOMIC_ACQUIRE, "agent");
            asm volatile("s_waitcnt vmcnt(0)" ::: "memory");
        }
    }
    __syncthreads();
}

namespace pg8 {
#define PG8_LAS __attribute__((address_space(3)))
typedef unsigned short bf16_t;
typedef short bf16x8 __attribute__((ext_vector_type(8)));
typedef float f32x4 __attribute__((ext_vector_type(4)));
typedef unsigned u32x4 __attribute__((ext_vector_type(4)));
constexpr int BM = 256, BK = 64, HALF = 128, HTB = HALF * BK * 2, STAGE_BYTES = 8 * HTB, NXCD = 8, WGM = 8;
__host__ __device__ __forceinline__ int lds_byte(int r, int c) { const int st = (r >> 4) * 2 + (c >> 5), rr = r & 15, cc = c & 31, ob = rr * 64 + cc * 2; return st * 1024 + (ob ^ (((ob >> 9) & 1) << 5)); }
__host__ __device__ __forceinline__ void stage_rc(int b, int& R, int& C) { const int st = b / 1024, sb = b % 1024, swz = sb ^ (((sb >> 9) & 1) << 5); R = (st >> 1) * 16 + swz / 64; C = (st & 1) * 32 + (swz % 64) / 2; }
__host__ __device__ __forceinline__ int perm32(int rho) { const int n = rho >> 4, i = rho & 15; return 8 * (i >> 2) + 4 * n + (i & 3); }
struct Unit { int pm, pn; };
struct Gemm { const bf16_t* A; const bf16_t* Bt; int M, N, K; };
struct StaticOrder {
    int nM, nN, nwg, G, c;
    __host__ __device__ __forceinline__ void init(int M, int N, int G_, int c_) { nM = M / BM; nN = N / BM; nwg = nM * nN; G = G_; c = c_; }
    __host__ __device__ bool next(int i, Unit& u) const {
        const long L = (long)i * G + c; if (L >= nwg) return false;
        int wgid = (int)L; { const int q = nwg / NXCD, r = nwg % NXCD, xcd = wgid % NXCD, off = wgid / NXCD; wgid = (xcd < r ? xcd * (q + 1) : r * (q + 1) + (xcd - r) * q) + off; }
        const int nig = WGM * nN, gid = wgid / nig, fm = gid * WGM, gsz = (nM - fm) < WGM ? (nM - fm) : WGM;
        u.pm = fm + ((wgid % nig) % gsz); u.pn = (wgid % nig) / gsz; return true;
    }
    __device__ __forceinline__ void a_ready(const Unit&) const {}
    __device__ __forceinline__ void done(const Unit&) const {}
};
__device__ __forceinline__ unsigned cvt_pk_bf16(float lo, float hi) { unsigned r; asm volatile("v_cvt_pk_bf16_f32 %0, %1, %2" : "=v"(r) : "v"(lo), "v"(hi)); return r; }

struct EpiF32R {
    static constexpr bool PERM = false, AFTER_DRAIN = false;
    float* C; const float* R; int ldc;
    __device__ __forceinline__ void operator()(const f32x4 (&acc)[2][2][4][2], const Unit& u, int wr, int wc, int fr, int fq) const {
        const int row0 = u.pm * BM + wr * 64 + fr, col0 = u.pn * BM + wc * 32 + 4 * fq;
#pragma unroll
        for (int ai = 0; ai < 2; ++ai)
#pragma unroll
            for (int m = 0; m < 4; ++m) {
                const size_t ro = (size_t)(row0 + ai * HALF + m * 16) * ldc + col0;
                f32x4 rv[2][2];
#pragma unroll
                for (int bj = 0; bj < 2; ++bj)
#pragma unroll
                    for (int n = 0; n < 2; ++n) rv[bj][n] = R ? *(const f32x4*)(R + ro + bj * HALF + n * 16) : (f32x4){0.f, 0.f, 0.f, 0.f};
#pragma unroll
                for (int bj = 0; bj < 2; ++bj)
#pragma unroll
                    for (int n = 0; n < 2; ++n) *(f32x4*)(C + ro + bj * HALF + n * 16) = acc[ai][bj][m][n] + rv[bj][n];
                __builtin_amdgcn_sched_barrier(0);
            }
    }
};

struct EpiBf16 {
    static constexpr bool PERM = true, AFTER_DRAIN = false;
    bf16_t* O; int ldc;
    __device__ __forceinline__ void operator()(const f32x4 (&acc)[2][2][4][2], const Unit& u, int wr, int wc, int fr, int fq) const {
        const int row0 = u.pm * BM + wr * 64 + fr, col0 = u.pn * BM + wc * 32 + 8 * fq;
#pragma unroll
        for (int ai = 0; ai < 2; ++ai)
#pragma unroll
            for (int m = 0; m < 4; ++m) { bf16_t* rowp = O + (size_t)(row0 + ai * HALF + m * 16) * ldc + col0;
#pragma unroll
                for (int bj = 0; bj < 2; ++bj) { const f32x4 v0 = acc[ai][bj][m][0], v1 = acc[ai][bj][m][1];
                    u32x4 w; w.x = cvt_pk_bf16(v0[0], v0[1]); w.y = cvt_pk_bf16(v0[2], v0[3]); w.z = cvt_pk_bf16(v1[0], v1[1]); w.w = cvt_pk_bf16(v1[2], v1[3]);
                    *(u32x4*)(rowp + bj * HALF) = w; } }
    }
};

template <class Epi, class Sched, bool ALIGN_EPI = false, bool SP2 = false>
__device__ __forceinline__ void gemm_phase(PG8_LAS unsigned char* lds, const Gemm g, const Sched& S, const Epi& E) {
    const int tid = opaque_tid(), wid = __builtin_amdgcn_readfirstlane(tid >> 6), lane = tid & 63, wr = wid >> 2, wc = wid & 3, fr = lane & 15, fq = lane >> 4;
    const int K = g.K, nt = K / BK;
    unsigned voffA[2], voffB[2];
#pragma unroll
    for (int i = 0; i < 2; ++i) { int R, C; stage_rc(tid * 16 + i * 8192, R, C); const int Rb = Epi::PERM ? ((R & ~31) + perm32(R & 31)) : R;
        voffA[i] = (unsigned)(R * K + C) * 2u; voffB[i] = (unsigned)(Rb * K + C) * 2u; }
    const size_t kstep = (size_t)(BK * 2);
    const size_t hstep = (size_t)HALF * K * 2;
    const size_t tstep = 2 * hstep;
    const unsigned ldsw = (unsigned)wid * 1024u;
    const int aoff = lds_byte(wr * 64 + fr, fq * 8), boff = lds_byte(wc * 32 + fr, fq * 8);
#define PG8_SA(b, h) (((b) * 2 + (h)) * HTB)
#define PG8_SB(b, h) ((4 + (b) * 2 + (h)) * HTB)
#define PG8_STAGE(bufoff, gbase, voff) do { _Pragma("unroll") for (int _i = 0; _i < 2; ++_i) \
        __builtin_amdgcn_global_load_lds((const unsigned*)((const char*)(gbase) + (voff)[_i]), (PG8_LAS unsigned*)(lds + (bufoff) + ldsw + _i * 8192), 16, 0, 0); } while (0)
#define PG8_LDA(dst, b, h) do { _Pragma("unroll") for (int m = 0; m < 4; ++m) _Pragma("unroll") for (int k = 0; k < 2; ++k) dst[m][k] = *(const PG8_LAS bf16x8*)(lds + PG8_SA(b, h) + aoff + m * 2048 + k * 1024); } while (0)
#define PG8_LDB(dst, b, h) do { _Pragma("unroll") for (int n = 0; n < 2; ++n) _Pragma("unroll") for (int k = 0; k < 2; ++k) dst[n][k] = *(const PG8_LAS bf16x8*)(lds + PG8_SB(b, h) + boff + n * 2048 + k * 1024); } while (0)
#define PG8_MMA(ai, bj, At, Bt) do { __builtin_amdgcn_s_setprio(1); _Pragma("unroll") for (int m = 0; m < 4; ++m) _Pragma("unroll") for (int n = 0; n < 2; ++n) _Pragma("unroll") for (int k = 0; k < 2; ++k) \
        acc[ai][bj][m][n] = __builtin_amdgcn_mfma_f32_16x16x32_bf16(Bt[n][k], At[m][k], acc[ai][bj][m][n], 0, 0, 0); __builtin_amdgcn_s_setprio(0); } while (0)
#define PG8_WAIT_V(n) asm volatile("s_waitcnt vmcnt(" #n ")" ::: "memory")
#define PG8_WAIT_L(n) asm volatile("s_waitcnt lgkmcnt(" #n ")" ::: "memory")
#define PG8_BAR __builtin_amdgcn_s_barrier()
#define PG8_SCHED __builtin_amdgcn_sched_barrier(0)
    Unit cur, nxt; int ui = 0;
    if (!S.next(0, cur)) return;
    f32x4 acc[2][2][4][2];
#pragma unroll
    for (int a = 0; a < 2; ++a)
#pragma unroll
        for (int b = 0; b < 2; ++b)
#pragma unroll
            for (int m = 0; m < 4; ++m)
#pragma unroll
                for (int n = 0; n < 2; ++n) acc[a][b][m][n] = (f32x4){0.f, 0.f, 0.f, 0.f};
    bf16x8 At[4][2], B0[2][2], B1[2][2];
    const char* cA = (const char*)g.A + (size_t)cur.pm * tstep; const char* cB = (const char*)g.Bt + (size_t)cur.pn * tstep;
    S.a_ready(cur);
    if constexpr (SP2) {
        PG8_STAGE(PG8_SB(0, 0), cB, voffB); PG8_STAGE(PG8_SB(0, 1), cB + hstep, voffB); PG8_STAGE(PG8_SA(0, 0), cA, voffA); PG8_STAGE(PG8_SA(0, 1), cA + hstep, voffA);
        if (wr == 1) PG8_BAR;
        PG8_WAIT_V(2); PG8_BAR;
        PG8_STAGE(PG8_SB(1, 0), cB + kstep, voffB); PG8_STAGE(PG8_SA(1, 0), cA + kstep, voffA); PG8_STAGE(PG8_SB(1, 1), cB + hstep + kstep, voffB);
        PG8_WAIT_V(6); PG8_BAR;
    } else {
        PG8_STAGE(PG8_SB(0, 0), cB, voffB); PG8_STAGE(PG8_SA(0, 0), cA, voffA); PG8_STAGE(PG8_SB(0, 1), cB + hstep, voffB); PG8_STAGE(PG8_SA(0, 1), cA + hstep, voffA);
        if (wr == 1) PG8_BAR;
        PG8_WAIT_V(4); PG8_BAR;
        PG8_STAGE(PG8_SB(1, 0), cB + kstep, voffB); PG8_STAGE(PG8_SA(1, 0), cA + kstep, voffA); PG8_STAGE(PG8_SB(1, 1), cB + hstep + kstep, voffB);
        PG8_WAIT_V(6); PG8_BAR;
    }
    for (;;) {
        const bool has_next = S.next(ui + 1, nxt);
        const char* nA = has_next ? (const char*)g.A + (size_t)nxt.pm * tstep : cA; const char* nB = has_next ? (const char*)g.Bt + (size_t)nxt.pn * tstep : cB;
        for (int t = 0; t < nt; t += 2) {
            const bool last = (t == nt - 2);
            const char* a1 = cA + (size_t)(t + 1) * kstep;
            const char* a2 = last ? nA : cA + (size_t)(t + 2) * kstep; const char* b2 = last ? nB : cB + (size_t)(t + 2) * kstep;
            const char* a3 = a2 + kstep; const char* b3 = b2 + kstep;
            if (last && has_next) S.a_ready(nxt);
            if constexpr (SP2) {
            PG8_LDB(B0, 0, 0); PG8_LDB(B1, 0, 1); PG8_SCHED; PG8_LDA(At, 0, 0); PG8_STAGE(PG8_SA(1, 1), a1 + hstep, voffA);
            PG8_WAIT_V(8); PG8_WAIT_L(0); PG8_BAR; PG8_MMA(0, 0, At, B0); PG8_MMA(0, 1, At, B1); PG8_BAR; PG8_SCHED;
            PG8_LDA(At, 0, 1); PG8_STAGE(PG8_SB(0, 0), b2, voffB); PG8_STAGE(PG8_SB(0, 1), b2 + hstep, voffB); PG8_STAGE(PG8_SA(0, 0), a2, voffA);
            PG8_WAIT_V(8); PG8_WAIT_L(0); PG8_BAR; PG8_MMA(1, 0, At, B0); PG8_MMA(1, 1, At, B1); PG8_BAR; PG8_SCHED;
            PG8_LDB(B0, 1, 0); PG8_LDB(B1, 1, 1); PG8_SCHED; PG8_LDA(At, 1, 0); PG8_STAGE(PG8_SA(0, 1), a2 + hstep, voffA);
            PG8_WAIT_V(8); PG8_WAIT_L(0); PG8_BAR; PG8_MMA(0, 0, At, B0); PG8_MMA(0, 1, At, B1); PG8_BAR; PG8_SCHED;
            PG8_LDA(At, 1, 1); PG8_STAGE(PG8_SB(1, 0), b3, voffB); PG8_STAGE(PG8_SB(1, 1), b3 + hstep, voffB); PG8_STAGE(PG8_SA(1, 0), a3, voffA);
            PG8_WAIT_V(8); PG8_WAIT_L(0); PG8_BAR; PG8_MMA(1, 0, At, B0); PG8_MMA(1, 1, At, B1); PG8_BAR; PG8_SCHED;
            } else {
            PG8_LDB(B0, 0, 0); PG8_SCHED; PG8_LDA(At, 0, 0); PG8_STAGE(PG8_SA(1, 1), a1 + hstep, voffA);
            PG8_WAIT_L(8); PG8_BAR; PG8_WAIT_L(0); PG8_MMA(0, 0, At, B0); PG8_BAR; PG8_SCHED;
            PG8_LDB(B1, 0, 1); PG8_STAGE(PG8_SB(0, 0), b2, voffB);
            PG8_BAR; PG8_WAIT_L(0); PG8_MMA(0, 1, At, B1); PG8_BAR;
            PG8_LDA(At, 0, 1); PG8_STAGE(PG8_SA(0, 0), a2, voffA);
            PG8_BAR; PG8_WAIT_L(0); PG8_MMA(1, 0, At, B0); PG8_BAR; PG8_SCHED;
            PG8_STAGE(PG8_SB(0, 1), b2 + hstep, voffB);
            PG8_WAIT_V(6); PG8_BAR; PG8_MMA(1, 1, At, B1); PG8_BAR;
            PG8_LDB(B0, 1, 0); PG8_SCHED; PG8_LDA(At, 1, 0); PG8_STAGE(PG8_SA(0, 1), a2 + hstep, voffA);
            PG8_WAIT_L(8); PG8_BAR; PG8_WAIT_L(0); PG8_MMA(0, 0, At, B0); PG8_BAR; PG8_SCHED;
            PG8_LDB(B1, 1, 1); PG8_STAGE(PG8_SB(1, 0), b3, voffB);
            PG8_BAR; PG8_WAIT_L(0); PG8_MMA(0, 1, At, B1); PG8_BAR;
            PG8_LDA(At, 1, 1); PG8_STAGE(PG8_SA(1, 0), a3, voffA);
            PG8_BAR; PG8_WAIT_L(0); PG8_MMA(1, 0, At, B0); PG8_BAR; PG8_SCHED;
            PG8_STAGE(PG8_SB(1, 1), b3 + hstep, voffB);
            PG8_WAIT_V(6); PG8_BAR; PG8_MMA(1, 1, At, B1); PG8_BAR;
            }
        }
        if constexpr (ALIGN_EPI) { if (wr == 0) PG8_BAR; }
        if constexpr (!Epi::AFTER_DRAIN) { E(acc, cur, wr, wc, fr, fq); S.done(cur); }
        if (!has_next) break;
#pragma unroll
        for (int a = 0; a < 2; ++a)
#pragma unroll
            for (int b = 0; b < 2; ++b)
#pragma unroll
                for (int m = 0; m < 4; ++m)
#pragma unroll
                    for (int n = 0; n < 2; ++n) acc[a][b][m][n] = (f32x4){0.f, 0.f, 0.f, 0.f};
        cur = nxt; cA = nA; cB = nB; ++ui;
        if constexpr (ALIGN_EPI) { if (wr == 1) PG8_BAR; }
    }
    PG8_WAIT_V(0);
    if constexpr (!ALIGN_EPI) { if (wr == 0) PG8_BAR; }
    PG8_BAR;
#undef PG8_SA
#undef PG8_SB
#undef PG8_STAGE
#undef PG8_LDA
#undef PG8_LDB
#undef PG8_MMA
#undef PG8_WAIT_V
#undef PG8_WAIT_L
#undef PG8_BAR
#undef PG8_SCHED
}
}

__device__ __forceinline__ void transpose_item(const float* W, int K, int N, bf16* WT, LAS float* scr, int item, int lane) {
    const int nblk = N / 32, kb = item / nblk, nb = item % nblk, k0 = 64 * kb, n0 = 32 * nb;
#pragma unroll 8
    for (int i = 0; i < 32; ++i) { const int kk = 2 * i + (lane >> 5); scr[kk * 33 + (lane & 31)] = W[(size_t)(k0 + kk) * N + n0 + (lane & 31)]; }
    asm volatile("s_waitcnt lgkmcnt(0)" ::: "memory");
    const int c = lane & 7;
#pragma unroll
    for (int j = 0; j < 4; ++j) { const int n = (lane >> 3) + 8 * j; const LAS float* s = scr + (8 * c) * 33 + n;
        uint4 o; o.x = pk2(s[0 * 33], s[1 * 33]); o.y = pk2(s[2 * 33], s[3 * 33]); o.z = pk2(s[4 * 33], s[5 * 33]); o.w = pk2(s[6 * 33], s[7 * 33]);
        *(uint4*)(WT + (size_t)(n0 + n) * K + k0 + 8 * c) = o; }
    asm volatile("s_waitcnt lgkmcnt(0)" ::: "memory");
}

__device__ __forceinline__ float wsum(float v) {
#pragma unroll
  for (int o = 32; o > 0; o >>= 1) v += __shfl_xor(v, o, 64);
  return v;
}
__device__ __forceinline__ float wmaxf(float v) {
#pragma unroll
  for (int o = 32; o > 0; o >>= 1) v = fmaxf(v, __shfl_xor(v, o, 64));
  return v;
}
__device__ __forceinline__ float sigmoidf_(float x) { return 1.0f / (1.0f + expf(-x)); }
__device__ __forceinline__ float gelu_tanh(float x) {
  return 0.5f * x * (1.0f + tanhf(0.7978845608028654f * (x + 0.044715f * x * x * x)));
}

template <bool BF16OUT>
__device__ __forceinline__ void rms_rows(const float* src, const float* g, void* dstv, int rows) {
  const int tid_ = opaque_tid();
  const int lane = tid_ & 63;
  const int gw = blockIdx.x * NWAVES + (tid_ >> 6);
  const int nw = gridDim.x * NWAVES;
  for (int r = gw; r < rows; r += nw) {
    const float4* s4 = (const float4*)(src + (size_t)r * DM);
    float4 v[4];
    float ss = 0.f;
#pragma unroll
    for (int i = 0; i < 4; i++) {
      v[i] = s4[lane + i * 64];
      ss += v[i].x * v[i].x + v[i].y * v[i].y + v[i].z * v[i].z + v[i].w * v[i].w;
    }
    ss = wsum(ss);
    const float rstd = rsqrtf(ss * (1.0f / DM) + EPSF);
    const float4* g4 = (const float4*)g;
#pragma unroll
    for (int i = 0; i < 4; i++) {
      float4 gg = g4[lane + i * 64];
      float4 o;
      o.x = v[i].x * rstd * gg.x; o.y = v[i].y * rstd * gg.y;
      o.z = v[i].z * rstd * gg.z; o.w = v[i].w * rstd * gg.w;
      if (BF16OUT) {
        uint2 pk; pk.x = pk2(o.x, o.y); pk.y = pk2(o.z, o.w);
        ((uint2*)((bf16*)dstv + (size_t)r * DM))[lane + i * 64] = pk;
      } else {
        ((float4*)((float*)dstv + (size_t)r * DM))[lane + i * 64] = o;
      }
    }
  }
}

__device__ __forceinline__ void ssm_params(const Params& p, float* ssmp_all) {
  const int tid_ = opaque_tid();
  const float* in8 = karg_in(8); const float* in9 = karg_in(9); const float* in10 = karg_in(10);
  const float* in11 = karg_in(11); const float* in12 = karg_in(12);
  const int gt = blockIdx.x * blockDim.x + tid_;
  const int nth = gridDim.x * blockDim.x;
  for (int i = gt; i < 2 * 16 * 64; i += nth) {
    const int l = i / 1024, gp = i % 1024, g = gp / 64;
    float* sp = ssmp_all + (size_t)l * SSMP_PER_LAYER;
    const float lre = fminf(in8[l * 1024 + gp], -1e-4f);
    const float lim = in9[l * 1024 + gp];
    const float dt = expf(in10[l * 16 + g]);
    const float er = expf(lre * dt);
    float sn, cs;
    sincosf(lim * dt, &sn, &cs);
    const float br = er * cs, bi = er * sn;
    sp[gp * 2 + 0] = br;
    sp[gp * 2 + 1] = bi;
    float cr = br, ci = bi;
#pragma unroll
    for (int s = 0; s < 6; s++) {
      const float nr = cr * cr - ci * ci, ni = 2.f * cr * ci;
      cr = nr; ci = ni;
    }
    sp[2048 + gp * 2 + 0] = cr;
    sp[2048 + gp * 2 + 1] = ci;
    const float nr = br - 1.0f, ni = bi;
    const float den = lre * lre + lim * lim;
    const float fr = (nr * lre + ni * lim) / den;
    const float fi = (ni * lre - nr * lim) / den;
    for (int h = 0; h < 16; h++) {
      const float bre = in11[((size_t)l * 1024 + gp) * 16 + h];
      const float bim = in12[((size_t)l * 1024 + gp) * 16 + h];
      sp[4096 + (gp * 16 + h) * 2 + 0] = fr * bre - fi * bim;
      sp[4096 + (gp * 16 + h) * 2 + 1] = fr * bim + fi * bre;
    }
  }
}

__device__ __forceinline__ void conv_phase(const Params& p, int l, const bf16* proj, bf16* y) {
  const int tid_ = opaque_tid();
  const int lane = tid_ & 63;
  const int gw = blockIdx.x * NWAVES + (tid_ >> 6);
  const int nw = gridDim.x * NWAVES;
  const float* cw = karg_in(4) + (size_t)l * 31 * 256;
  const float4 cb = ((const float4*)(karg_in(5) + l * 256))[lane];
  const float4 lg = ((const float4*)(karg_in(6) + l * 256))[lane];
  const float4 lb = ((const float4*)(karg_in(7) + l * 256))[lane];
  const float4 gg = ((const float4*)(karg_in(18) + l * 1024))[lane];
  for (int tok = gw; tok < NT; tok += nw) {
    const int t = tok & (SEQ - 1);
    float4 acc = cb;
    for (int j = 0; j < 31; j++) {
      const int tt = t - 30 + j;
      if (tt >= 0) {
        const bf16* row = proj + (size_t)(tok - 30 + j) * DIN;
        const uint2 vp = ((const uint2*)row)[lane];
        const uint2 gp = ((const uint2*)(row + 256))[lane];
        const float4 v = make_float4(bf_lo(vp.x), bf_hi(vp.x), bf_lo(vp.y), bf_hi(vp.y));
        const float4 gt = make_float4(bf_lo(gp.x), bf_hi(gp.x), bf_lo(gp.y), bf_hi(gp.y));
        const float4 w = ((const float4*)(cw + j * 256))[lane];
        acc.x += v.x * sigmoidf_(gt.x) * w.x;
        acc.y += v.y * sigmoidf_(gt.y) * w.y;
        acc.z += v.z * sigmoidf_(gt.z) * w.z;
        acc.w += v.w * sigmoidf_(gt.w) * w.w;
      }
    }
    const float mean = wsum(acc.x + acc.y + acc.z + acc.w) * (1.0f / 256.f);
    const float dx = acc.x - mean, dy = acc.y - mean, dz = acc.z - mean, dw = acc.w - mean;
    const float var = wsum(dx * dx + dy * dy + dz * dz + dw * dw) * (1.0f / 256.f);
    const float rs = rsqrtf(var + EPSF);
    float4 s;
    s.x = dx * rs * lg.x + lb.x; s.y = dy * rs * lg.y + lb.y;
    s.z = dz * rs * lg.z + lb.z; s.w = dw * rs * lg.w + lb.w;
    s.x = s.x * sigmoidf_(s.x); s.y = s.y * sigmoidf_(s.y);
    s.z = s.z * sigmoidf_(s.z); s.w = s.w * sigmoidf_(s.w);
    const float ss = wsum(s.x * s.x + s.y * s.y + s.z * s.z + s.w * s.w) * (1.0f / 256.f);
    const float r2 = rsqrtf(ss + EPSF);
    float4 o;
    o.x = s.x * r2 * gg.x; o.y = s.y * r2 * gg.y; o.z = s.z * r2 * gg.z; o.w = s.w * r2 * gg.w;
    { uint2 pk; pk.x = pk2(o.x, o.y); pk.y = pk2(o.z, o.w); ((uint2*)(y + (size_t)tok * DM))[lane] = pk; }
  }
}

typedef short bf16x8_t __attribute__((ext_vector_type(8)));
typedef float f32x16_t __attribute__((ext_vector_type(16)));
__device__ __forceinline__ void attn_phase(const Params& p, int l, const bf16* proj, bf16* y, LAS float* smem) {
  const int tid = opaque_tid(), lane = tid & 63, wave = tid >> 6;
  const int n = lane & 31, hh = lane >> 5;
  const float* gg = karg_in(18) + l * 1024 + 256 + wave * 64;
  const float g0 = gg[n], g1 = gg[32 + n];
  LAS float* ssq = smem;
  LAS float* rstd = smem + 256;
  for (int item = blockIdx.x; item < 4 * 128; item += gridDim.x) {
    const int b = item >> 7, q0 = (item & 127) * 32;
    const size_t tokb = (size_t)b * SEQ;
    bf16x8_t qf[4];
    {
      const bf16* qrow = proj + (tokb + q0 + n) * DIN + 512 + wave * 64 + 8 * hh;
#pragma unroll
      for (int ks = 0; ks < 4; ks++) qf[ks] = *(const bf16x8_t*)(qrow + 16 * ks);
    }
    f32x16_t o0, o1;
#pragma unroll
    for (int r = 0; r < 16; r++) { o0[r] = 0.f; o1[r] = 0.f; }
    float R = 0.f;
    for (int kt = q0; kt >= 0; kt -= 32) {
      bf16x8_t kf[4];
      {
        const bf16* krow = proj + (tokb + kt + n) * DIN + 1024 + wave * 64 + 8 * hh;
#pragma unroll
        for (int ks = 0; ks < 4; ks++) kf[ks] = *(const bf16x8_t*)(krow + 16 * ks);
      }
      bf16x8_t vf0[2], vf1[2];
      {
        const bf16* vb = proj + (tokb + kt + 4 * hh) * DIN + 1536 + wave * 64 + n;
#pragma unroll
        for (int s = 0; s < 2; s++)
#pragma unroll
          for (int j = 0; j < 8; j++) {
            const int key = 16 * s + 8 * (j >> 2) + (j & 3);
            vf0[s][j] = (short)vb[(size_t)key * DIN];
            vf1[s][j] = (short)vb[(size_t)key * DIN + 32];
          }
      }
      f32x16_t sacc;
#pragma unroll
      for (int r = 0; r < 16; r++) sacc[r] = 0.f;
      __builtin_amdgcn_sched_barrier(0); asm volatile("s_nop 15\n\ts_nop 15" ::: "memory"); __builtin_amdgcn_sched_barrier(0);
#pragma unroll
      for (int ks = 0; ks < 4; ks++) sacc = __builtin_amdgcn_mfma_f32_32x32x16_bf16(kf[ks], qf[ks], sacc, 0, 0, 0);
      __builtin_amdgcn_sched_barrier(0); asm volatile("s_nop 15\n\ts_nop 15" ::: "memory"); __builtin_amdgcn_sched_barrier(0);
      float lst[16], lsz[16];
      const bool diag = (kt == q0);
#pragma unroll
      for (int r = 0; r < 16; r++) {
        const float z = sacc[r] * 0.125f;
        const float sp = __logf(1.0f + __expf(-fabsf(z)));
        float a = fminf(z, 0.f) - sp;
        float c = -(fmaxf(z, 0.f) + sp);
        if (diag) {
          const int key = (r & 3) + 8 * (r >> 2) + 4 * hh;
          if (key >= n) { a = -1.0e30f; c = 0.f; }
        }
        lsz[r] = a; lst[r] = c;
      }
      float Gs[4], Gp[4];
#pragma unroll
      for (int g = 0; g < 4; g++) {
        Gs[g] = (lst[4 * g] + lst[4 * g + 1]) + (lst[4 * g + 2] + lst[4 * g + 3]);
        Gp[g] = __shfl_xor(Gs[g], 32, 64);
      }
      float carry[4];
      {
        float after = R;
#pragma unroll
        for (int g = 3; g >= 0; g--) {
          carry[g] = after + (hh ? 0.f : Gp[g]);
          after += Gs[g] + Gp[g];
        }
        R = after;
      }
      bf16x8_t pf[2];
#pragma unroll
      for (int g = 0; g < 4; g++) {
        float run = carry[g];
        float a3 = __expf(lsz[4 * g + 3] + run); run += lst[4 * g + 3];
        float a2 = __expf(lsz[4 * g + 2] + run); run += lst[4 * g + 2];
        float a1 = __expf(lsz[4 * g + 1] + run); run += lst[4 * g + 1];
        float a0 = __expf(lsz[4 * g + 0] + run);
        const int s = g >> 1, jb = (g & 1) * 4;
        pf[s][jb + 0] = (short)f2bf(a0); pf[s][jb + 1] = (short)f2bf(a1);
        pf[s][jb + 2] = (short)f2bf(a2); pf[s][jb + 3] = (short)f2bf(a3);
      }
      __builtin_amdgcn_sched_barrier(0); asm volatile("s_nop 15\n\ts_nop 15" ::: "memory"); __builtin_amdgcn_sched_barrier(0);
#pragma unroll
      for (int s = 0; s < 2; s++) {
        o0 = __builtin_amdgcn_mfma_f32_32x32x16_bf16(pf[s], vf0[s], o0, 0, 0, 0);
        o1 = __builtin_amdgcn_mfma_f32_32x32x16_bf16(pf[s], vf1[s], o1, 0, 0, 0);
      }
      __builtin_amdgcn_sched_barrier(0); asm volatile("s_nop 15\n\ts_nop 15" ::: "memory"); __builtin_amdgcn_sched_barrier(0);
      if (__all(R < -110.f)) break;
    }
    float sq[16];
#pragma unroll
    for (int r = 0; r < 16; r++) {
      float v = o0[r] * o0[r] + o1[r] * o1[r];
#pragma unroll
      for (int o = 16; o > 0; o >>= 1) v += __shfl_xor(v, o, 64);
      sq[r] = v;
    }
    __syncthreads();
    if (n == 0) {
#pragma unroll
      for (int r = 0; r < 16; r++) ssq[wave * 32 + (r & 3) + 8 * (r >> 2) + 4 * hh] = sq[r];
    }
    __syncthreads();
    if (tid < 32) {
      float t = 0.f;
#pragma unroll
      for (int w = 0; w < 8; w++) t += ssq[w * 32 + tid];
      rstd[tid] = rsqrtf(t * (1.0f / 512.f) + EPSF);
    }
    __syncthreads();
#pragma unroll
    for (int r = 0; r < 16; r++) {
      const int qi = (r & 3) + 8 * (r >> 2) + 4 * hh;
      const float rs = rstd[qi];
      bf16* yr = y + (tokb + q0 + qi) * DM + 256 + wave * 64 + n;
      yr[0] = (bf16)f2bf(o0[r] * rs * g0);
      yr[32] = (bf16)f2bf(o1[r] * rs * g1);
    }
  }
}

__device__ __forceinline__ void ssm_chunk_end(const float* ssmp, const bf16* proj, float* ssmE) {
  const int tid_ = opaque_tid();
  const int lane = tid_ & 63;
  const int gw = blockIdx.x * NWAVES + (tid_ >> 6);
  const int nw = gridDim.x * NWAVES;
  for (int it = gw; it < 4 * 64 * 16; it += nw) {
    const int g = it & 15, c = (it >> 4) & 63, b = it >> 10;
    const int gp = g * 64 + lane;
    const float lbr = ssmp[gp * 2], lbi = ssmp[gp * 2 + 1];
    float bbr[16], bbi[16];
#pragma unroll
    for (int h = 0; h < 16; h++) {
      bbr[h] = ssmp[4096 + (gp * 16 + h) * 2];
      bbi[h] = ssmp[4096 + (gp * 16 + h) * 2 + 1];
    }
    float xr = 0.f, xi = 0.f;
    for (int tt = 0; tt < 64; tt++) {
      float u[16];
      {
        const uint4* up = (const uint4*)(proj + (size_t)(b * SEQ + c * 64 + tt) * DIN + 2048 + g * 16);
        const uint4 ua = up[0], ub = up[1];
        u[0] = bf_lo(ua.x); u[1] = bf_hi(ua.x); u[2] = bf_lo(ua.y); u[3] = bf_hi(ua.y);
        u[4] = bf_lo(ua.z); u[5] = bf_hi(ua.z); u[6] = bf_lo(ua.w); u[7] = bf_hi(ua.w);
        u[8] = bf_lo(ub.x); u[9] = bf_hi(ub.x); u[10] = bf_lo(ub.y); u[11] = bf_hi(ub.y);
        u[12] = bf_lo(ub.z); u[13] = bf_hi(ub.z); u[14] = bf_lo(ub.w); u[15] = bf_hi(ub.w);
      }
      float br = 0.f, bi = 0.f;
#pragma unroll
      for (int h = 0; h < 16; h++) {
        const float uh = u[h];
        br += bbr[h] * uh;
        bi += bbi[h] * uh;
      }
      const float nr = lbr * xr - lbi * xi + br;
      const float ni = lbr * xi + lbi * xr + bi;
      xr = nr; xi = ni;
    }
    float* e = ssmE + ((size_t)((b * 64 + c) * 16 + g) * 64 + lane) * 2;
    e[0] = xr; e[1] = xi;
  }
}

__device__ __forceinline__ void ssm_finish(const Params& p, int l, const float* ssmp, const bf16* proj,
                           const float* ssmE, bf16* y, LAS float* smem) {
  LAS float (*Yt)[256] = (LAS float (*)[256])smem;
  const int tid = opaque_tid(), lane = tid & 63, wave = tid >> 6;
  const float* cre = karg_in(13) + (size_t)l * 16 * 16 * 64;
  const float* cim = karg_in(14) + (size_t)l * 16 * 16 * 64;
  const float* dsk = karg_in(15) + l * 256;
  const float* glw = karg_in(16) + (size_t)l * 256 * 256;
  const float* glb = karg_in(17) + l * 256;
  const float* gg = karg_in(18) + l * 1024 + 768;
  for (int it = blockIdx.x; it < 256; it += gridDim.x) {
    const int b = it >> 6, c = it & 63;
    __syncthreads();
    for (int gi = 0; gi < 2; gi++) {
      const int g = wave + gi * 8;
      const int gp = g * 64 + lane;
      const float lbr = ssmp[gp * 2], lbi = ssmp[gp * 2 + 1];
      const float lcr = ssmp[2048 + gp * 2], lci = ssmp[2048 + gp * 2 + 1];
      float bbr[16], bbi[16], ccr[16], cci[16];
#pragma unroll
      for (int h = 0; h < 16; h++) {
        bbr[h] = ssmp[4096 + (gp * 16 + h) * 2];
        bbi[h] = ssmp[4096 + (gp * 16 + h) * 2 + 1];
        ccr[h] = cre[(g * 16 + h) * 64 + lane];
        cci[h] = cim[(g * 16 + h) * 64 + lane];
      }
      float xr = 0.f, xi = 0.f;
      for (int cc = 0; cc < c; cc++) {
        const float* e = ssmE + ((size_t)((b * 64 + cc) * 16 + g) * 64 + lane) * 2;
        const float er = e[0], ei = e[1];
        const float nr = lcr * xr - lci * xi + er;
        const float ni = lcr * xi + lci * xr + ei;
        xr = nr; xi = ni;
      }
      const int hq = ((lane >> 5) & 1) * 8 + ((lane >> 4) & 1) * 4 + ((lane >> 3) & 1) * 2 + ((lane >> 2) & 1);
      const float dh = dsk[g * 16 + hq];
      for (int tt = 0; tt < 64; tt++) {
        float u[16];
        {
          const uint4* up = (const uint4*)(proj + (size_t)(b * SEQ + c * 64 + tt) * DIN + 2048 + g * 16);
          const uint4 ua = up[0], ub = up[1];
          u[0] = bf_lo(ua.x); u[1] = bf_hi(ua.x); u[2] = bf_lo(ua.y); u[3] = bf_hi(ua.y);
          u[4] = bf_lo(ua.z); u[5] = bf_hi(ua.z); u[6] = bf_lo(ua.w); u[7] = bf_hi(ua.w);
          u[8] = bf_lo(ub.x); u[9] = bf_hi(ub.x); u[10] = bf_lo(ub.y); u[11] = bf_hi(ub.y);
          u[12] = bf_lo(ub.z); u[13] = bf_hi(ub.z); u[14] = bf_lo(ub.w); u[15] = bf_hi(ub.w);
        }
        float br = 0.f, bi = 0.f;
#pragma unroll
        for (int h = 0; h < 16; h++) {
          const float uh = u[h];
          br += bbr[h] * uh;
          bi += bbi[h] * uh;
        }
        const float nr = lbr * xr - lbi * xi + br;
        const float ni = lbr * xi + lbi * xr + bi;
        xr = nr; xi = ni;
        float v[16];
#pragma unroll
        for (int h = 0; h < 16; h++) v[h] = xr * ccr[h] - xi * cci[h];
        float v8[8], v4[4], v2[2], v1;
        {
          const bool hi = (lane & 32) != 0;
#pragma unroll
          for (int i = 0; i < 8; i++) {
            const float send = hi ? v[i] : v[i + 8];
            const float keep = hi ? v[i + 8] : v[i];
            v8[i] = keep + __shfl_xor(send, 32, 64);
          }
        }
        {
          const bool hi = (lane & 16) != 0;
#pragma unroll
          for (int i = 0; i < 4; i++) {
            const float send = hi ? v8[i] : v8[i + 4];
            const float keep = hi ? v8[i + 4] : v8[i];
            v4[i] = keep + __shfl_xor(send, 16, 64);
          }
        }
        {
          const bool hi = (lane & 8) != 0;
#pragma unroll
          for (int i = 0; i < 2; i++) {
            const float send = hi ? v4[i] : v4[i + 2];
            const float keep = hi ? v4[i + 2] : v4[i];
            v2[i] = keep + __shfl_xor(send, 8, 64);
          }
        }
        {
          const bool hi = (lane & 4) != 0;
          const float send = hi ? v2[0] : v2[1];
          const float keep = hi ? v2[1] : v2[0];
          v1 = keep + __shfl_xor(send, 4, 64);
        }
        v1 += __shfl_xor(v1, 2, 64);
        v1 += __shfl_xor(v1, 1, 64);
        if ((lane & 3) == 0) {
          float uq = u[0];
#pragma unroll
          for (int h = 1; h < 16; h++) uq = (hq == h) ? u[h] : uq;
          const float yy = v1 + dh * uq;
          Yt[tt][g * 16 + hq] = gelu_tanh(yy);
        }
      }
    }
    __syncthreads();
    {
      const int j = tid & 255, th = tid >> 8;
      const float bj = glb[j];
      for (int t0 = th * 32; t0 < th * 32 + 32; t0 += 8) {
        float acc[8];
#pragma unroll
        for (int i = 0; i < 8; i++) acc[i] = 0.f;
        for (int k = 0; k < 256; k++) {
          const float w = glw[k * 256 + j];
#pragma unroll
          for (int i = 0; i < 8; i++) acc[i] += Yt[t0 + i][k] * w;
        }
        __syncthreads();
#pragma unroll
        for (int i = 0; i < 8; i++) {
          const float yv = Yt[t0 + i][j];
          Yt[t0 + i][j] = yv * sigmoidf_(acc[i] + bj);
        }
      }
    }
    __syncthreads();
    for (int i = 0; i < 8; i++) {
      const int tt = wave * 8 + i;
      const float4 v = *(const float4*)&Yt[tt][lane * 4];
      const float ss = wsum(v.x * v.x + v.y * v.y + v.z * v.z + v.w * v.w) * (1.0f / 256.f);
      const float rs = rsqrtf(ss + EPSF);
      const float4 g4 = ((const float4*)gg)[lane];
      uint2 pk;
      pk.x = pk2(v.x * rs * g4.x, v.y * rs * g4.y);
      pk.y = pk2(v.z * rs * g4.z, v.w * rs * g4.w);
      ((uint2*)(y + (size_t)(b * SEQ + c * 64 + tt) * DM + 768))[lane] = pk;
    }
  }
}

#define MFMA_PAD() do { __builtin_amdgcn_sched_barrier(0); asm volatile("s_nop 15\n\ts_nop 15" ::: "memory"); __builtin_amdgcn_sched_barrier(0); } while (0)

__device__ __forceinline__ void memattn_phase(const bf16* q, const bf16* kvb, const bf16* vT, bf16* o) {
  const int tid_ = opaque_tid();
  const int lane = tid_ & 63, n = lane & 31, hh = lane >> 5;
  const int gw = blockIdx.x * NWAVES + (tid_ >> 6);
  const int nw = gridDim.x * NWAVES;
  const int sig = (n & 0x13) | ((n & 4) << 1) | ((n & 8) >> 1);
  for (int it = gw; it < 512 * 4; it += nw) {
    const int h = it & 3, tok0 = (it >> 2) * 32, b = tok0 >> 12;
    f32x16_t st[8];
#pragma unroll
    for (int kt = 0; kt < 8; kt++)
#pragma unroll
      for (int r = 0; r < 16; r++) st[kt][r] = 0.f;
    const bf16* qrow = q + (size_t)(tok0 + n) * DM + h * 256 + 8 * hh;
    const bf16* kbase = kvb + (size_t)(b * NMEM + sig) * 2048 + h * 256 + 8 * hh;
#pragma unroll
    for (int kq = 0; kq < 4; kq++) {
      bf16x8_t qf[4];
#pragma unroll
      for (int i = 0; i < 4; i++) qf[i] = *(const bf16x8_t*)(qrow + 16 * (kq * 4 + i));
#pragma unroll
      for (int kt = 0; kt < 8; kt++) {
        const bf16* krow = kbase + (size_t)kt * 32 * 2048;
        bf16x8_t kf[4];
#pragma unroll
        for (int i = 0; i < 4; i++) kf[i] = *(const bf16x8_t*)(krow + 16 * (kq * 4 + i));
        MFMA_PAD();
#pragma unroll
        for (int i = 0; i < 4; i++) st[kt] = __builtin_amdgcn_mfma_f32_32x32x16_bf16(kf[i], qf[i], st[kt], 0, 0, 0);
        MFMA_PAD();
      }
    }
    float mx = st[0][0];
#pragma unroll
    for (int kt = 0; kt < 8; kt++)
#pragma unroll
      for (int r = 0; r < 16; r++) mx = fmaxf(mx, st[kt][r]);
    mx = fmaxf(mx, __shfl_xor(mx, 32, 64));
    float sum = 0.f;
#pragma unroll
    for (int kt = 0; kt < 8; kt++)
#pragma unroll
      for (int r = 0; r < 16; r++) { const float e = __expf((st[kt][r] - mx) * 0.0625f); st[kt][r] = e; sum += e; }
    sum += __shfl_xor(sum, 32, 64);
    const float inv = 1.0f / sum;
    bf16x8_t pf[8][2];
#pragma unroll
    for (int kt = 0; kt < 8; kt++)
#pragma unroll
      for (int s = 0; s < 2; s++)
#pragma unroll
        for (int j = 0; j < 8; j++) pf[kt][s][j] = (short)f2bf(st[kt][8 * s + j] * inv);
    const bf16* vbase = vT + ((size_t)(b * 4 + h) * 256 + n) * 256 + 8 * hh;
#pragma unroll 1
    for (int dt = 0; dt < 8; dt++) {
      f32x16_t oacc;
#pragma unroll
      for (int r = 0; r < 16; r++) oacc[r] = 0.f;
      const bf16* vrow = vbase + (size_t)dt * 32 * 256;
#pragma unroll
      for (int kq = 0; kq < 4; kq++) {
        bf16x8_t vf[4];
#pragma unroll
        for (int i = 0; i < 4; i++) vf[i] = *(const bf16x8_t*)(vrow + (kq * 2 + (i >> 1)) * 32 + 16 * (i & 1));
        MFMA_PAD();
#pragma unroll
        for (int i = 0; i < 4; i++) oacc = __builtin_amdgcn_mfma_f32_32x32x16_bf16(pf[kq * 2 + (i >> 1)][i & 1], vf[i], oacc, 0, 0, 0);
        MFMA_PAD();
      }
#pragma unroll
      for (int r = 0; r < 16; r++) {
        const int qi = (r & 3) + 8 * (r >> 2) + 4 * hh;
        o[(size_t)(tok0 + qi) * DM + h * 256 + dt * 32 + n] = (bf16)f2bf(oacc[r]);
      }
    }
  }
}

__device__ __forceinline__ void vt_phase(const bf16* kvb, bf16* vT) {
  const int tid_ = opaque_tid();
  const int gt = blockIdx.x * (NWAVES * 64) + tid_;
  const int nth = gridDim.x * NWAVES * 64;
  for (int i = gt; i < 2 * 4 * 4 * 256 * 256; i += nth) {
    const int m = i & 255, d = (i >> 8) & 255, h = (i >> 16) & 3, b = (i >> 18) & 3, l = i >> 20;
    vT[i] = kvb[((size_t)l * 1024 + b * 256 + m) * 2048 + 1024 + h * 256 + d];
  }
}

__device__ __forceinline__ void topk_rounds(float (&s)[64], int hh, float (&tv)[16], int (&ti)[16]) {
  const float NEG = -3.0e38f;
#pragma unroll 1
  for (int r = 0; r < 16; r++) {
    float m = s[0]; int slot = 0;
#pragma unroll
    for (int i = 1; i < 64; i++) {
      const bool gt = s[i] > m;
      m = gt ? s[i] : m;
      slot = gt ? i : slot;
    }
    const int rr = slot & 15;
    const int idx = (slot >> 4) * 32 + (rr & 3) + 8 * (rr >> 2) + 4 * hh;
    const float pm = __shfl_xor(m, 32, 64);
    const int pidx = __shfl_xor(idx, 32, 64);
    const bool mine = (m > pm) || (m == pm && idx < pidx);
    const float wv = mine ? m : pm;
    const int wi = mine ? idx : pidx;
#pragma unroll
    for (int j = 0; j < 16; j++) { tv[j] = (r == j) ? wv : tv[j]; ti[j] = (r == j) ? wi : ti[j]; }
    const int kill = mine ? slot : -1;
#pragma unroll
    for (int i = 0; i < 64; i++) s[i] = (kill == i) ? NEG : s[i];
  }
}

__device__ __forceinline__ void peer_topk(const bf16* pq, const bf16* skb, int* ids, float* gates) {
  const int tid_ = opaque_tid();
  const int lane = tid_ & 63, n = lane & 31, hh = lane >> 5;
  const int gw = blockIdx.x * NWAVES + (tid_ >> 6);
  const int nw = gridDim.x * NWAVES;
  const float NEG = -3.0e38f;
  for (int it = gw; it < 512 * 8; it += nw) {
    const int h = it & 7, tok0 = (it >> 3) * 32;
    float tv0[16], tv1[16];
    int ti0[16], ti1[16];
#pragma unroll
    for (int j = 0; j < 16; j++) { tv0[j] = 0.f; tv1[j] = 0.f; ti0[j] = 0; ti1[j] = 0; }
#pragma unroll
    for (int half = 0; half < 2; half++) {
      bf16x8_t qf[8];
      {
        const bf16* qrow = pq + (size_t)(tok0 + n) * 2048 + h * 256 + half * 128 + 8 * hh;
#pragma unroll
        for (int ks = 0; ks < 8; ks++) qf[ks] = *(const bf16x8_t*)(qrow + 16 * ks);
      }
      f32x16_t st[4];
#pragma unroll
      for (int kt = 0; kt < 4; kt++) {
        const bf16* krow = skb + ((size_t)((h * 2 + half) * 128 + kt * 32 + n)) * 128 + 8 * hh;
        asm volatile("" : "+v"(krow));
        f32x16_t acc;
#pragma unroll
        for (int r = 0; r < 16; r++) acc[r] = 0.f;
#pragma unroll
        for (int kq = 0; kq < 2; kq++) {
          bf16x8_t kf[4];
#pragma unroll
          for (int i = 0; i < 4; i++) kf[i] = *(const bf16x8_t*)(krow + 16 * (kq * 4 + i));
          MFMA_PAD();
#pragma unroll
          for (int i = 0; i < 4; i++) acc = __builtin_amdgcn_mfma_f32_32x32x16_bf16(kf[i], qf[kq * 4 + i], acc, 0, 0, 0);
          MFMA_PAD();
        }
        st[kt] = acc;
      }
      float s[64];
#pragma unroll
      for (int kt = 0; kt < 4; kt++)
#pragma unroll
        for (int i = 0; i < 16; i++) s[kt * 16 + i] = st[kt][i];
      __builtin_amdgcn_sched_barrier(0);
      if (half == 0) topk_rounds(s, hh, tv0, ti0); else topk_rounds(s, hh, tv1, ti1);
      __builtin_amdgcn_sched_barrier(0);
    }
    float F[16];
    int ba[16];
#pragma unroll
    for (int a = 0; a < 16; a++) { F[a] = tv0[a] + tv1[0]; ba[a] = 0; }
    float bv[16];
    int be[16];
#pragma unroll
    for (int j = 0; j < 16; j++) { bv[j] = 0.f; be[j] = 0; }
#pragma unroll 1
    for (int r = 0; r < 16; r++) {
      float m = F[0]; int a = 0;
#pragma unroll
      for (int i = 1; i < 16; i++) { const bool gt = F[i] > m; m = gt ? F[i] : m; a = gt ? i : a; }
      int bsel = 0, i0 = 0; float t0 = 0.f;
#pragma unroll
      for (int i = 0; i < 16; i++) { const bool is = (a == i); bsel = is ? ba[i] : bsel; i0 = is ? ti0[i] : i0; t0 = is ? tv0[i] : t0; }
      int i1 = 0; float t1n = NEG;
#pragma unroll
      for (int i = 0; i < 16; i++) { i1 = (bsel == i) ? ti1[i] : i1; t1n = (bsel + 1 == i) ? tv1[i] : t1n; }
      const int e = i0 * 128 + i1;
      const float fn = (bsel + 1 < 16) ? (t0 + t1n) : NEG;
#pragma unroll
      for (int i = 0; i < 16; i++) { const bool is = (a == i); F[i] = is ? fn : F[i]; ba[i] = is ? (bsel + 1) : ba[i]; }
#pragma unroll
      for (int j = 0; j < 16; j++) { bv[j] = (r == j) ? m : bv[j]; be[j] = (r == j) ? e : be[j]; }
    }
    const float b0 = bv[0];
    float ge[16];
    float gsum = 0.f;
#pragma unroll
    for (int r = 0; r < 16; r++) { ge[r] = __expf(bv[r] - b0); gsum += ge[r]; }
    const float ginv = 1.0f / gsum;
    if (hh == 0) {
      int* ip = ids + (size_t)(tok0 + n) * 128 + h * 16;
      float* gp = gates + (size_t)(tok0 + n) * 128 + h * 16;
#pragma unroll
      for (int r4 = 0; r4 < 4; r4++) {
        *(int4*)(ip + 4 * r4) = make_int4(be[4 * r4], be[4 * r4 + 1], be[4 * r4 + 2], be[4 * r4 + 3]);
        *(float4*)(gp + 4 * r4) = make_float4(ge[4 * r4] * ginv, ge[4 * r4 + 1] * ginv, ge[4 * r4 + 2] * ginv, ge[4 * r4 + 3] * ginv);
      }
    }
  }
}

typedef _Float16 f16x2_t __attribute__((ext_vector_type(2)));
__device__ __forceinline__ unsigned e4m3x2_to_f16x2(unsigned w, unsigned sel) {
  const unsigned p = __builtin_amdgcn_perm(w, w, sel);
  return (p & 0x80008000u) | ((p >> 1) & 0x3F803F80u);
}
__device__ __forceinline__ float dot2h(unsigned a, unsigned b, float c) {
  return __builtin_amdgcn_fdot2(__builtin_bit_cast(f16x2_t, a), __builtin_bit_cast(f16x2_t, b), c, false);
}
__device__ __forceinline__ unsigned pack_h2(float lo, float hi) {
  f16x2_t v; v.x = (_Float16)lo; v.y = (_Float16)hi;
  return __builtin_bit_cast(unsigned, v);
}
__device__ __forceinline__ void peer_gather(const bf16* xn, const unsigned char* ub, const unsigned char* vb,
                                            const int* ids, const float* gates, float* xw) {
  const int tid_ = opaque_tid();
  const int lane = tid_ & 63;
  const int gw = blockIdx.x * NWAVES + (tid_ >> 6);
  const int nw = gridDim.x * NWAVES;
  const int el = ((lane >> 5) & 1) * 4 + ((lane >> 4) & 1) * 2 + ((lane >> 3) & 1);
  for (int tok = gw; tok < NT; tok += nw) {
    unsigned xh[8];
    {
      const uint4 a = *(const uint4*)(xn + (size_t)tok * DM + lane * 16);
      const uint4 b = *(const uint4*)(xn + (size_t)tok * DM + lane * 16 + 8);
      const unsigned xw_[8] = {a.x, a.y, a.z, a.w, b.x, b.y, b.z, b.w};
#pragma unroll
      for (int k = 0; k < 8; k++) xh[k] = pack_h2(bf_lo(xw_[k]), bf_hi(xw_[k]));
    }
    float acc[16];
#pragma unroll
    for (int i = 0; i < 16; i++) acc[i] = 0.f;
#pragma unroll 1
    for (int g = 0; g < 16; g++) {
      const int idv = ids[(size_t)tok * 128 + g * 8 + (lane & 7)];
      const float gv = gates[(size_t)tok * 128 + g * 8 + el];
      uint4 uu[8], vv[8];
#pragma unroll
      for (int e = 0; e < 8; e++) {
        const int id = __builtin_amdgcn_readlane(idv, e);
        uu[e] = *(const uint4*)(ub + (size_t)id * DM + lane * 16);
        vv[e] = *(const uint4*)(vb + (size_t)id * DM + lane * 16);
      }
      float d[8];
#pragma unroll
      for (int e = 0; e < 8; e++) {
        const unsigned uw[4] = {uu[e].x, uu[e].y, uu[e].z, uu[e].w};
        float s = 0.f;
#pragma unroll
        for (int k = 0; k < 4; k++) {
          s = dot2h(e4m3x2_to_f16x2(uw[k], 0x010c000cu), xh[2 * k], s);
          s = dot2h(e4m3x2_to_f16x2(uw[k], 0x030c020cu), xh[2 * k + 1], s);
        }
        d[e] = s;
      }
      float d4[4], d2[2], d1;
      {
        const bool hi = (lane & 32) != 0;
#pragma unroll
        for (int i = 0; i < 4; i++) { const float send = hi ? d[i] : d[i + 4]; const float keep = hi ? d[i + 4] : d[i]; d4[i] = keep + __shfl_xor(send, 32, 64); }
      }
      {
        const bool hi = (lane & 16) != 0;
#pragma unroll
        for (int i = 0; i < 2; i++) { const float send = hi ? d4[i] : d4[i + 2]; const float keep = hi ? d4[i + 2] : d4[i]; d2[i] = keep + __shfl_xor(send, 16, 64); }
      }
      {
        const bool hi = (lane & 8) != 0;
        const float send = hi ? d2[0] : d2[1];
        const float keep = hi ? d2[1] : d2[0];
        d1 = keep + __shfl_xor(send, 8, 64);
      }
      d1 += __shfl_xor(d1, 4, 64);
      d1 += __shfl_xor(d1, 2, 64);
      d1 += __shfl_xor(d1, 1, 64);
      const float wl = gv * gelu_tanh(d1 * (256.0f / U_SCALE)) * (256.0f / V_SCALE);
#pragma unroll
      for (int e = 0; e < 8; e++) {
        const float w = __builtin_bit_cast(float, __builtin_amdgcn_readlane(__builtin_bit_cast(int, wl), ((e >> 2) & 1) * 32 + ((e >> 1) & 1) * 16 + (e & 1) * 8));
        const unsigned wlo = pack_h2(w, 0.f), whi = pack_h2(0.f, w);
        const unsigned vw[4] = {vv[e].x, vv[e].y, vv[e].z, vv[e].w};
#pragma unroll
        for (int k = 0; k < 4; k++) {
          const unsigned h0 = e4m3x2_to_f16x2(vw[k], 0x010c000cu), h1 = e4m3x2_to_f16x2(vw[k], 0x030c020cu);
          acc[4 * k + 0] = dot2h(h0, wlo, acc[4 * k + 0]);
          acc[4 * k + 1] = dot2h(h0, whi, acc[4 * k + 1]);
          acc[4 * k + 2] = dot2h(h1, wlo, acc[4 * k + 2]);
          acc[4 * k + 3] = dot2h(h1, whi, acc[4 * k + 3]);
        }
      }
    }
    float* xr = xw + (size_t)tok * DM + lane * 16;
#pragma unroll
    for (int c = 0; c < 4; c++) {
      float4 a0 = *(float4*)(xr + c * 4);
      a0.x += acc[c * 4 + 0]; a0.y += acc[c * 4 + 1]; a0.z += acc[c * 4 + 2]; a0.w += acc[c * 4 + 3];
      *(float4*)(xr + c * 4) = a0;
    }
  }
}

__device__ __forceinline__ void prologue_transposes(const Params& p, unsigned char* ws, LAS unsigned char* lds) {
  const int tid_ = opaque_tid();
  const int lane = tid_ & 63, wave = tid_ >> 6;
  LAS float* scr = (LAS float*)(lds + wave * 16384);
  const int gw = blockIdx.x * NWAVES + wave, NGW = gridDim.x * NWAVES;
  constexpr int I_IN = (DM / 64) * (DIN / 32), I_SQ = (DM / 64) * (DM / 32), I_2K = (DM / 64) * (2048 / 32);
  constexpr int PER_LAYER = I_IN + 3 * I_SQ + 2 * I_2K;
  const float* w3 = karg_in(3); const float* w19 = karg_in(19); const float* w22 = karg_in(22);
  const float* w23 = karg_in(23); const float* w24 = karg_in(24); const float* w26 = karg_in(26);
  for (int it = gw; it < 2 * PER_LAYER; it += NGW) {
    const int l = it / PER_LAYER;
    int r = it % PER_LAYER;
    unsigned char* wl = ws + WS_WT + (size_t)l * WT_LAYER;
    if (r < I_IN) { transpose_item(w3 + (size_t)l * DM * DIN, DM, DIN, (bf16*)(wl + WT_IN), scr, r, lane); continue; } r -= I_IN;
    if (r < I_SQ) { transpose_item(w19 + (size_t)l * DM * DM, DM, DM, (bf16*)(wl + WT_OUT), scr, r, lane); continue; } r -= I_SQ;
    if (r < I_SQ) { transpose_item(w22 + (size_t)l * DM * DM, DM, DM, (bf16*)(wl + WT_MQ), scr, r, lane); continue; } r -= I_SQ;
    if (r < I_2K) { transpose_item(w23 + (size_t)l * DM * 2048, DM, 2048, (bf16*)(wl + WT_MKV), scr, r, lane); continue; } r -= I_2K;
    if (r < I_SQ) { transpose_item(w24 + (size_t)l * DM * DM, DM, DM, (bf16*)(wl + WT_MO), scr, r, lane); continue; } r -= I_SQ;
    transpose_item(w26 + (size_t)l * DM * 2048, DM, 2048, (bf16*)(wl + WT_PQ), scr, r, lane);
  }
}

template <class T> __device__ __forceinline__ T* opq(T* p) { asm volatile("" : "+s"(p)); return p; }
__device__ __forceinline__ void cvt_rows_bf16(const float* src, bf16* dst, size_t n) {
  const int tid_ = opaque_tid();
  const size_t gt = (size_t)blockIdx.x * (NWAVES * 64) + tid_;
  const size_t nth = (size_t)gridDim.x * NWAVES * 64;
  for (size_t i = gt; i < n / 8; i += nth) {
    const float4 a = ((const float4*)src)[2 * i], b = ((const float4*)src)[2 * i + 1];
    uint4 o; o.x = pk2(a.x, a.y); o.y = pk2(a.z, a.w); o.z = pk2(b.x, b.y); o.w = pk2(b.z, b.w);
    ((uint4*)dst)[i] = o;
  }
}

__device__ __forceinline__ unsigned enc_e4m3(float x) {
  const unsigned bits = __builtin_bit_cast(unsigned, x);
  const unsigned sign = (bits >> 24) & 0x80u;
  float ax = fminf(fabsf(x), 448.0f);
  unsigned r;
  if (ax >= 0.015625f) {
    unsigned ab = __builtin_bit_cast(unsigned, ax);
    ab += 0x0007FFFFu + ((ab >> 20) & 1u);
    r = (ab >> 20) - 960u;
    r = r > 0x7Eu ? 0x7Eu : r;
  } else {
    r = (unsigned)__float2int_rn(ax * 512.0f);
  }
  return sign | r;
}
__device__ __forceinline__ void cvt_rows_e4m3(const float* src, unsigned char* dst, size_t n, float sc) {
  const int tid_ = opaque_tid();
  const size_t gt = (size_t)blockIdx.x * (NWAVES * 64) + tid_;
  const size_t nth = (size_t)gridDim.x * NWAVES * 64;
  for (size_t i = gt; i < n / 16; i += nth) {
    unsigned w[4];
#pragma unroll
    for (int k = 0; k < 4; k++) {
      const float4 a = ((const float4*)src)[4 * i + k];
      w[k] = enc_e4m3(a.x * sc) | (enc_e4m3(a.y * sc) << 8) | (enc_e4m3(a.z * sc) << 16) | (enc_e4m3(a.w * sc) << 24);
    }
    uint4 o; o.x = w[0]; o.y = w[1]; o.z = w[2]; o.w = w[3];
    ((uint4*)dst)[i] = o;
  }
}

#define GEMM_F32(Aptr, Wt, Cptr, Rptr, M_, N_) do { \
    pg8::Gemm g_{opq((const bf16*)(Aptr)), opq((const bf16*)(Wt)), (M_), (N_), DM}; pg8::StaticOrder S_; S_.init((M_), (N_), (int)gridDim.x, (int)blockIdx.x); \
    pg8::EpiF32R E_{opq((float*)(Cptr)), opq((const float*)(Rptr)), (N_)}; \
    pg8::gemm_phase<pg8::EpiF32R, pg8::StaticOrder, true, true>(ldsl, g_, S_, E_); } while (0)
#define GEMM_BF16(Aptr, Wt, Optr, M_, N_) do { \
    pg8::Gemm g_{opq((const bf16*)(Aptr)), opq((const bf16*)(Wt)), (M_), (N_), DM}; pg8::StaticOrder S_; S_.init((M_), (N_), (int)gridDim.x, (int)blockIdx.x); \
    pg8::EpiBf16 E_{opq((bf16*)(Optr)), (N_)}; \
    pg8::gemm_phase<pg8::EpiBf16, pg8::StaticOrder, true, true>(ldsl, g_, S_, E_); } while (0)

__global__ void __launch_bounds__(NWAVES * 64, 2) fwd_megakernel(Params p) {
  cg::grid_group grid = cg::this_grid();
  extern __shared__ __attribute__((aligned(16))) unsigned char lds[];
  LAS unsigned char* ldsl = (LAS unsigned char*)lds;
  LAS float* smem = (LAS float*)ldsl;
  unsigned char* ws = p.ws;
  volatile LAS unsigned* MISC = (volatile LAS unsigned*)(ldsl + 131072);
  if (threadIdx.x < 64) MISC[threadIdx.x] = 0u;
  __syncthreads();
  const XcdBarrier bar = xcd_barrier_post((unsigned*)(ws + WS_CTL) + 4096, MISC + 8);
  grid.sync();
  float* xw = (float*)(ws + WS_XW);
  bf16* xn = (bf16*)(ws + WS_XN);
  bf16* big = (bf16*)(ws + WS_BIG);
  bf16* y = (bf16*)(ws + WS_Y);
  bf16* memh = (bf16*)(ws + WS_MEMH);
  bf16* kvb = (bf16*)(ws + WS_KVB);
  bf16* vT = (bf16*)(ws + WS_VT);
  float* ssmE = (float*)(ws + WS_SSME);
  float* ssmp = (float*)(ws + WS_SSMP);
  int* ids = (int*)(ws + WS_IDS);
  float* gates = (float*)(ws + WS_GATE);
  bf16* skb = (bf16*)(ws + WS_SKB);
  unsigned char* ub = ws + WS_UB;
  unsigned char* vb = ws + WS_VB;

  prologue_transposes(p, ws, ldsl);
  cvt_rows_bf16(karg_in(27), skb, (size_t)2 * 8 * 2 * 128 * 128);
  cvt_rows_e4m3(karg_in(28), ub, (size_t)2 * 16384 * 1024, U_SCALE);
  cvt_rows_e4m3(karg_in(29), vb, (size_t)2 * 16384 * 1024, V_SCALE);
  for (int l = 0; l < 2; l++)
    rms_rows<true>(karg_in(1), karg_in(21) + l * DM, memh + (size_t)l * 1024 * 1024, 1024);
  ssm_params(p, ssmp);
  xcd_barrier(bar);
  for (int l = 0; l < 2; l++)
    GEMM_BF16(memh + (size_t)l * 1024 * 1024, ws + WS_WT + (size_t)l * WT_LAYER + WT_MKV,
              kvb + (size_t)l * 1024 * 2048, 1024, 2048);

#pragma nounroll
  for (int l = 0; l < 2; l++) {
    const float* xcur = (l == 0) ? karg_in(0) : xw;
    const float* sp = ssmp + (size_t)l * SSMP_PER_LAYER;
    const unsigned char* wl = ws + WS_WT + (size_t)l * WT_LAYER;
    rms_rows<true>(xcur, karg_in(2) + l * DM, xn, NT);
    xcd_barrier(bar);
    GEMM_BF16(xn, wl + WT_IN, big, NT, DIN);
    xcd_barrier(bar);
    if (l == 0) vt_phase(kvb, vT);
    ssm_chunk_end(sp, big, ssmE);
    attn_phase(p, l, big, y, smem);
    conv_phase(p, l, big, y);
    xcd_barrier(bar);
    ssm_finish(p, l, sp, big, ssmE, y, smem);
    xcd_barrier(bar);
    GEMM_F32(y, wl + WT_OUT, xw, xcur, NT, DM);
    xcd_barrier(bar);
    rms_rows<true>(xw, karg_in(20) + l * DM, xn, NT);
    xcd_barrier(bar);
    GEMM_BF16(xn, wl + WT_MQ, big, NT, DM);
    xcd_barrier(bar);
    memattn_phase(big, kvb + (size_t)l * 1024 * 2048, vT + (size_t)l * 4 * 4 * 256 * 256, y);
    xcd_barrier(bar);
    GEMM_F32(y, wl + WT_MO, xw, (const float*)xw, NT, DM);
    xcd_barrier(bar);
    rms_rows<true>(xw, karg_in(25) + l * DM, xn, NT);
    xcd_barrier(bar);
    GEMM_BF16(xn, wl + WT_PQ, big, NT, 2048);
    xcd_barrier(bar);
    peer_topk(big, skb + (size_t)l * 8 * 2 * 128 * 128, ids, gates);
    xcd_barrier(bar);
    peer_gather(xn, ub + (size_t)l * 16384 * DM, vb + (size_t)l * 16384 * DM, ids, gates, xw);
    xcd_barrier(bar);
  }
  rms_rows<false>(xw, karg_in(30), p.out, NT);
}

extern "C" void kernel_launch(void* const* d_in, const int* in_sizes, int n_in,
                              void* d_out, int out_size, void* d_ws, size_t ws_size,
                              hipStream_t stream) {
  static int grid_blocks = 0;
  if (!grid_blocks) {
    int dev = 0, cus = 0, per_cu = 0;
    (void)hipGetDevice(&dev);
    (void)hipDeviceGetAttribute(&cus, hipDeviceAttributeMultiprocessorCount, dev);
    (void)hipFuncSetAttribute((const void*)fwd_megakernel, hipFuncAttributeMaxDynamicSharedMemorySize, LDS_BYTES);
    (void)hipOccupancyMaxActiveBlocksPerMultiprocessor(&per_cu, fwd_megakernel, NWAVES * 64, LDS_BYTES);
    if (per_cu < 1) fprintf(stderr, "occupancy query reports %d blocks/CU\n", per_cu);
    grid_blocks = cus;
  }
  (void)hipMemsetAsync((char*)d_ws + WS_CTL, 0, 1 * MiB, stream);
  Params p{};
  for (int i = 0; i < 31; i++) p.in[i] = (const float*)d_in[i];
  p.out = (float*)d_out;
  p.ws = (unsigned char*)d_ws;
  void* args[] = {&p};
  hipError_t e = hipLaunchCooperativeKernel((void*)fwd_megakernel, dim3(grid_blocks), dim3(NWAVES * 64),
                                            args, LDS_BYTES, stream);
  if (e != hipSuccess)
    fprintf(stderr, "cooperative launch failed: %s (grid %d)\n", hipGetErrorString(e), grid_blocks);
}
```

```cpp
#include <hip/hip_runtime.h>
#include <hip/hip_cooperative_groups.h>
#include <cstdio>
namespace cg = cooperative_groups;

#define NT 16384
#define SEQ 4096
#define DM 1024
#define DIN 2304
#define NMEM 256
#define EPSF 1e-6f
#define NWAVES 8
#define LDS_BYTES 147456

typedef unsigned short bf16;
#define LAS __attribute__((address_space(3)))

struct Params {
  const float* in[31];
  float* out;
  unsigned char* ws;
};
typedef __attribute__((address_space(4))) const unsigned char* kaptr_t;
__device__ __forceinline__ const float* karg_in(int i) {
  kaptr_t ka = (kaptr_t)__builtin_amdgcn_kernarg_segment_ptr();
  asm volatile("" : "+s"(ka));
  return *(const float* __attribute__((address_space(4))) const*)(ka + 8 * i);
}

constexpr size_t MiB = 1u << 20;
constexpr size_t WS_CTL  = 0;
constexpr size_t WS_WT   = 1 * MiB;
constexpr size_t WT_IN = 0, WT_OUT = WT_IN + (size_t)DIN * DM * 2, WT_MQ = WT_OUT + (size_t)DM * DM * 2,
                 WT_MKV = WT_MQ + (size_t)DM * DM * 2, WT_MO = WT_MKV + (size_t)2048 * DM * 2,
                 WT_PQ = WT_MO + (size_t)DM * DM * 2, WT_GLU = WT_PQ + (size_t)2048 * DM * 2, WT_LAYER = WT_GLU + (size_t)256 * 256 * 2;
constexpr size_t WS_XW   = WS_WT + 2 * WT_LAYER;
constexpr size_t WS_XN   = WS_XW + (size_t)NT * DM * 4;
constexpr size_t WS_BIG  = WS_XN + (size_t)NT * DM * 2;
constexpr size_t WS_Y    = WS_BIG + (size_t)NT * DIN * 2;
constexpr size_t WS_MEMH = WS_Y + (size_t)NT * DM * 2;
constexpr size_t WS_KVB  = WS_MEMH + (size_t)2 * 1024 * 1024 * 2;
constexpr size_t WS_VT   = WS_KVB + (size_t)2 * 1024 * 2048 * 2;
constexpr size_t WS_SSME = WS_VT + (size_t)2 * 4 * 4 * 256 * 256 * 2;
#define SSMP_PER_LAYER (2048 + 2048 + 32768)
constexpr size_t WS_SSMP = WS_SSME + (size_t)4 * 64 * 16 * 64 * 2 * 4;
constexpr size_t WS_IDS  = WS_SSMP + (size_t)2 * SSMP_PER_LAYER * 4;
constexpr size_t WS_GATE = WS_IDS + (size_t)NT * 128 * 4;
constexpr size_t WS_SKB  = WS_GATE + (size_t)NT * 128 * 4;
constexpr size_t WS_UB   = WS_SKB + (size_t)2 * 8 * 2 * 128 * 128 * 2;
constexpr size_t WS_VB   = WS_UB + (size_t)2 * 16384 * 1024;
constexpr size_t WS_END  = WS_VB + (size_t)2 * 16384 * 1024;
#define U_SCALE 64.0f
#define V_SCALE 8.0f
static_assert(WS_END <= 512 * MiB, "workspace");
static_assert(WT_LAYER % 256 == 0 && WS_SSMP % 16 == 0 && WS_IDS % 16 == 0 && WS_SKB % 256 == 0 && WS_VT % 256 == 0, "align");

__device__ __forceinline__ int opaque_tid() { int v = threadIdx.x; asm volatile("" : "+v"(v)); return v; }
__device__ __forceinline__ unsigned f2bf(float f) { unsigned u = __builtin_bit_cast(unsigned, f); return (u + 0x7fffu + ((u >> 16) & 1u)) >> 16; }
__device__ __forceinline__ unsigned pk2(float lo, float hi) { return f2bf(lo) | (f2bf(hi) << 16); }
__device__ __forceinline__ float bf_lo(unsigned u) { return __builtin_bit_cast(float, u << 16); }
__device__ __forceinline__ float bf_hi(unsigned u) { return __builtin_bit_cast(float, u & 0xffff0000u); }
__device__ __forceinline__ float bf2f(bf16 h) { return __builtin_bit_cast(float, (unsigned)h << 16); }


#define XB_TMO      128
#define XB_XCNT(j)  (256  + 64 * (j))
#define XB_XSUB(j)  (1280 + 64 * (j))
#define XB_XGEN(j)  (2304 + 64 * (j))
#define XB_TOP      3328
#define XB_TOPGEN   3392
#define XCD_BAR_WORDS 3456
#define XB_SPIN_CAP (1u << 22)
__device__ __forceinline__ unsigned xb_ld(unsigned* p)              { return __hip_atomic_load(p, __ATOMIC_RELAXED, __HIP_MEMORY_SCOPE_AGENT); }
__device__ __forceinline__ unsigned xb_add(unsigned* p, unsigned v) { return __hip_atomic_fetch_add(p, v, __ATOMIC_RELAXED, __HIP_MEMORY_SCOPE_AGENT); }
__device__ __forceinline__ unsigned xb_xcc_id() { return (unsigned)__builtin_amdgcn_s_getreg((3 << 11) | 20) & 0xFu; }
#define XB_SPIN(cond, bar) do { unsigned _sp = 0; while (cond) { __builtin_amdgcn_s_sleep(1); \
    if ((++_sp & 255u) == 0u) { if (xb_ld(&(bar)[XB_TMO])) break; if (_sp > XB_SPIN_CAP) { atomicAdd(&(bar)[XB_TMO], 1u); break; } } } } while (0)
struct XcdBarrier { unsigned* bar; unsigned x; volatile LAS unsigned* st; };
__device__ __forceinline__ XcdBarrier xcd_barrier_post(unsigned* bar, volatile LAS unsigned* st) {
    XcdBarrier b; b.bar = bar; b.x = xb_xcc_id(); b.st = st;
    if (threadIdx.x == 0) (void)xb_add(&bar[XB_XCNT(b.x)], 1u);
    return b;
}
__device__ __forceinline__ void xcd_barrier_complete(unsigned* bar, unsigned x, unsigned& nloc, unsigned& nx) {
    const unsigned G = gridDim.x * gridDim.y * gridDim.z;
    unsigned sum, cnt, mine, sp = 0u;
    for (;;) {
        sum = 0u; cnt = 0u; mine = 0u;
#pragma unroll
        for (unsigned j = 0; j < 16; ++j) { const unsigned c = xb_ld(&bar[XB_XCNT(j)]); sum += c; cnt += (c > 0u) ? 1u : 0u; mine = (j == x) ? c : mine; }
        if (sum == G) break;
        __builtin_amdgcn_s_sleep(1);
        if ((++sp & 255u) == 0u) { if (xb_ld(&bar[XB_TMO])) break; if (sp > XB_SPIN_CAP) { atomicAdd(&bar[XB_TMO], 1u); break; } }
    }
    nloc = mine > 0u ? mine : 1u; nx = cnt > 0u ? cnt : 1u;
}
__device__ __forceinline__ void xcd_barrier(const XcdBarrier& b) {
    asm volatile("s_waitcnt vmcnt(0)" ::: "memory");
    __syncthreads();
    if (threadIdx.x == 0) {
        unsigned* bar = b.bar;
        __builtin_amdgcn_s_waitcnt(0);
        unsigned nloc = b.st[0], nx = b.st[1];
        if (nloc == 0u) { xcd_barrier_complete(bar, b.x, nloc, nx); b.st[0] = nloc; b.st[1] = nx; }
        const unsigned old = xb_add(&bar[XB_XSUB(b.x)], 1u);
        const unsigned gen = old / nloc;
        if (old + 1u == (gen + 1u) * nloc) {
            __builtin_amdgcn_fence(__ATOMIC_RELEASE, "agent");
            asm volatile("s_waitcnt vmcnt(0)" ::: "memory");
            const unsigned og = xb_add(&bar[XB_TOP], 1u);
            const unsigned tg = og / nx;
            if (og + 1u == (tg + 1u) * nx) xb_add(&bar[XB_TOPGEN], 1u);
            else XB_SPIN(xb_ld(&bar[XB_TOPGEN]) == tg, bar);
            __builtin_amdgcn_fence(__ATOMIC_ACQUIRE, "agent");
            xb_add(&bar[XB_XGEN(b.x)], 1u);
            asm volatile("s_waitcnt vmcnt(0)" ::: "memory");
        } else {
            XB_SPIN(xb_ld(&bar[XB_XGEN(b.x)]) == gen, bar);
            __builtin_amdgcn_fence(__ATOMIC_ACQUIRE, "agent");
            asm volatile("s_waitcnt vmcnt(0)" ::: "memory");
        }
    }
    __syncthreads();
}

namespace pg8 {
#define PG8_LAS __attribute__((address_space(3)))
typedef unsigned short bf16_t;
typedef short bf16x8 __attribute__((ext_vector_type(8)));
typedef float f32x4 __attribute__((ext_vector_type(4)));
typedef unsigned u32x4 __attribute__((ext_vector_type(4)));
constexpr int BM = 256, BK = 64, HALF = 128, HTB = HALF * BK * 2, STAGE_BYTES = 8 * HTB, NXCD = 8, WGM = 8;
__host__ __device__ __forceinline__ int lds_byte(int r, int c) { const int st = (r >> 4) * 2 + (c >> 5), rr = r & 15, cc = c & 31, ob = rr * 64 + cc * 2; return st * 1024 + (ob ^ (((ob >> 9) & 1) << 5)); }
__host__ __device__ __forceinline__ void stage_rc(int b, int& R, int& C) { const int st = b / 1024, sb = b % 1024, swz = sb ^ (((sb >> 9) & 1) << 5); R = (st >> 1) * 16 + swz / 64; C = (st & 1) * 32 + (swz % 64) / 2; }
__host__ __device__ __forceinline__ int perm32(int rho) { const int n = rho >> 4, i = rho & 15; return 8 * (i >> 2) + 4 * n + (i & 3); }
struct Unit { int pm, pn; };
struct Gemm { const bf16_t* A; const bf16_t* Bt; int M, N, K; };
struct StaticOrder {
    int nM, nN, nwg, G, c;
    __host__ __device__ __forceinline__ void init(int M, int N, int G_, int c_) { nM = M / BM; nN = N / BM; nwg = nM * nN; G = G_; c = c_; }
    __host__ __device__ bool next(int i, Unit& u) const {
        const long L = (long)i * G + c; if (L >= nwg) return false;
        int wgid = (int)L; { const int q = nwg / NXCD, r = nwg % NXCD, xcd = wgid % NXCD, off = wgid / NXCD; wgid = (xcd < r ? xcd * (q + 1) : r * (q + 1) + (xcd - r) * q) + off; }
        const int nig = WGM * nN, gid = wgid / nig, fm = gid * WGM, gsz = (nM - fm) < WGM ? (nM - fm) : WGM;
        u.pm = fm + ((wgid % nig) % gsz); u.pn = (wgid % nig) / gsz; return true;
    }
    __device__ __forceinline__ void a_ready(const Unit&) const {}
    __device__ __forceinline__ void done(const Unit&) const {}
};
__device__ __forceinline__ unsigned cvt_pk_bf16(float lo, float hi) { unsigned r; asm volatile("v_cvt_pk_bf16_f32 %0, %1, %2" : "=v"(r) : "v"(lo), "v"(hi)); return r; }

struct EpiF32R {
    static constexpr bool PERM = false, AFTER_DRAIN = false;
    float* C; const float* R; int ldc;
    __device__ __forceinline__ void operator()(const f32x4 (&acc)[2][2][4][2], const Unit& u, int wr, int wc, int fr, int fq) const {
        const int row0 = u.pm * BM + wr * 64 + fr, col0 = u.pn * BM + wc * 32 + 4 * fq;
#pragma unroll
        for (int ai = 0; ai < 2; ++ai)
#pragma unroll
            for (int m = 0; m < 4; ++m) {
                const size_t ro = (size_t)(row0 + ai * HALF + m * 16) * ldc + col0;
                f32x4 rv[2][2];
#pragma unroll
                for (int bj = 0; bj < 2; ++bj)
#pragma unroll
                    for (int n = 0; n < 2; ++n) rv[bj][n] = R ? *(const f32x4*)(R + ro + bj * HALF + n * 16) : (f32x4){0.f, 0.f, 0.f, 0.f};
#pragma unroll
                for (int bj = 0; bj < 2; ++bj)
#pragma unroll
                    for (int n = 0; n < 2; ++n) *(f32x4*)(C + ro + bj * HALF + n * 16) = acc[ai][bj][m][n] + rv[bj][n];
                __builtin_amdgcn_sched_barrier(0);
            }
    }
};

struct EpiBf16 {
    static constexpr bool PERM = true, AFTER_DRAIN = false;
    bf16_t* O; int ldc;
    __device__ __forceinline__ void operator()(const f32x4 (&acc)[2][2][4][2], const Unit& u, int wr, int wc, int fr, int fq) const {
        const int row0 = u.pm * BM + wr * 64 + fr, col0 = u.pn * BM + wc * 32 + 8 * fq;
#pragma unroll
        for (int ai = 0; ai < 2; ++ai)
#pragma unroll
            for (int m = 0; m < 4; ++m) { bf16_t* rowp = O + (size_t)(row0 + ai * HALF + m * 16) * ldc + col0;
#pragma unroll
                for (int bj = 0; bj < 2; ++bj) { const f32x4 v0 = acc[ai][bj][m][0], v1 = acc[ai][bj][m][1];
                    u32x4 w; w.x = cvt_pk_bf16(v0[0], v0[1]); w.y = cvt_pk_bf16(v0[2], v0[3]); w.z = cvt_pk_bf16(v1[0], v1[1]); w.w = cvt_pk_bf16(v1[2], v1[3]);
                    *(u32x4*)(rowp + bj * HALF) = w; } }
    }
};

template <class Epi, class Sched, bool ALIGN_EPI = false, bool SP2 = false>
__device__ __forceinline__ void gemm_phase(PG8_LAS unsigned char* lds, const Gemm g, const Sched& S, const Epi& E) {
    const int tid = opaque_tid(), wid = __builtin_amdgcn_readfirstlane(tid >> 6), lane = tid & 63, wr = wid >> 2, wc = wid & 3, fr = lane & 15, fq = lane >> 4;
    const int K = g.K, nt = K / BK;
    unsigned voffA[2], voffB[2];
#pragma unroll
    for (int i = 0; i < 2; ++i) { int R, C; stage_rc(tid * 16 + i * 8192, R, C); const int Rb = Epi::PERM ? ((R & ~31) + perm32(R & 31)) : R;
        voffA[i] = (unsigned)(R * K + C) * 2u; voffB[i] = (unsigned)(Rb * K + C) * 2u; }
    const size_t kstep = (size_t)(BK * 2);
    const size_t hstep = (size_t)HALF * K * 2;
    const size_t tstep = 2 * hstep;
    const unsigned ldsw = (unsigned)wid * 1024u;
    const int aoff = lds_byte(wr * 64 + fr, fq * 8), boff = lds_byte(wc * 32 + fr, fq * 8);
#define PG8_SA(b, h) (((b) * 2 + (h)) * HTB)
#define PG8_SB(b, h) ((4 + (b) * 2 + (h)) * HTB)
#define PG8_STAGE(bufoff, gbase, voff) do { _Pragma("unroll") for (int _i = 0; _i < 2; ++_i) \
        __builtin_amdgcn_global_load_lds((const unsigned*)((const char*)(gbase) + (voff)[_i]), (PG8_LAS unsigned*)(lds + (bufoff) + ldsw + _i * 8192), 16, 0, 0); } while (0)
#define PG8_LDA(dst, b, h) do { _Pragma("unroll") for (int m = 0; m < 4; ++m) _Pragma("unroll") for (int k = 0; k < 2; ++k) dst[m][k] = *(const PG8_LAS bf16x8*)(lds + PG8_SA(b, h) + aoff + m * 2048 + k * 1024); } while (0)
#define PG8_LDB(dst, b, h) do { _Pragma("unroll") for (int n = 0; n < 2; ++n) _Pragma("unroll") for (int k = 0; k < 2; ++k) dst[n][k] = *(const PG8_LAS bf16x8*)(lds + PG8_SB(b, h) + boff + n * 2048 + k * 1024); } while (0)
#define PG8_MMA(ai, bj, At, Bt) do { __builtin_amdgcn_s_setprio(1); _Pragma("unroll") for (int m = 0; m < 4; ++m) _Pragma("unroll") for (int n = 0; n < 2; ++n) _Pragma("unroll") for (int k = 0; k < 2; ++k) \
        acc[ai][bj][m][n] = __builtin_amdgcn_mfma_f32_16x16x32_bf16(Bt[n][k], At[m][k], acc[ai][bj][m][n], 0, 0, 0); __builtin_amdgcn_s_setprio(0); } while (0)
#define PG8_WAIT_V(n) asm volatile("s_waitcnt vmcnt(" #n ")" ::: "memory")
#define PG8_WAIT_L(n) asm volatile("s_waitcnt lgkmcnt(" #n ")" ::: "memory")
#define PG8_BAR __builtin_amdgcn_s_barrier()
#define PG8_SCHED __builtin_amdgcn_sched_barrier(0)
    Unit cur, nxt; int ui = 0;
    if (!S.next(0, cur)) return;
    f32x4 acc[2][2][4][2];
#pragma unroll
    for (int a = 0; a < 2; ++a)
#pragma unroll
        for (int b = 0; b < 2; ++b)
#pragma unroll
            for (int m = 0; m < 4; ++m)
#pragma unroll
                for (int n = 0; n < 2; ++n) acc[a][b][m][n] = (f32x4){0.f, 0.f, 0.f, 0.f};
    bf16x8 At[4][2], B0[2][2], B1[2][2];
    const char* cA = (const char*)g.A + (size_t)cur.pm * tstep; const char* cB = (const char*)g.Bt + (size_t)cur.pn * tstep;
    S.a_ready(cur);
    if constexpr (SP2) {
        PG8_STAGE(PG8_SB(0, 0), cB, voffB); PG8_STAGE(PG8_SB(0, 1), cB + hstep, voffB); PG8_STAGE(PG8_SA(0, 0), cA, voffA); PG8_STAGE(PG8_SA(0, 1), cA + hstep, voffA);
        if (wr == 1) PG8_BAR;
        PG8_WAIT_V(2); PG8_BAR;
        PG8_STAGE(PG8_SB(1, 0), cB + kstep, voffB); PG8_STAGE(PG8_SA(1, 0), cA + kstep, voffA); PG8_STAGE(PG8_SB(1, 1), cB + hstep + kstep, voffB);
        PG8_WAIT_V(6); PG8_BAR;
    } else {
        PG8_STAGE(PG8_SB(0, 0), cB, voffB); PG8_STAGE(PG8_SA(0, 0), cA, voffA); PG8_STAGE(PG8_SB(0, 1), cB + hstep, voffB); PG8_STAGE(PG8_SA(0, 1), cA + hstep, voffA);
        if (wr == 1) PG8_BAR;
        PG8_WAIT_V(4); PG8_BAR;
        PG8_STAGE(PG8_SB(1, 0), cB + kstep, voffB); PG8_STAGE(PG8_SA(1, 0), cA + kstep, voffA); PG8_STAGE(PG8_SB(1, 1), cB + hstep + kstep, voffB);
        PG8_WAIT_V(6); PG8_BAR;
    }
    for (;;) {
        const bool has_next = S.next(ui + 1, nxt);
        const char* nA = has_next ? (const char*)g.A + (size_t)nxt.pm * tstep : cA; const char* nB = has_next ? (const char*)g.Bt + (size_t)nxt.pn * tstep : cB;
        for (int t = 0; t < nt; t += 2) {
            const bool last = (t == nt - 2);
            const char* a1 = cA + (size_t)(t + 1) * kstep;
            const char* a2 = last ? nA : cA + (size_t)(t + 2) * kstep; const char* b2 = last ? nB : cB + (size_t)(t + 2) * kstep;
            const char* a3 = a2 + kstep; const char* b3 = b2 + kstep;
            if (last && has_next) S.a_ready(nxt);
            if constexpr (SP2) {
            PG8_LDB(B0, 0, 0); PG8_LDB(B1, 0, 1); PG8_SCHED; PG8_LDA(At, 0, 0); PG8_STAGE(PG8_SA(1, 1), a1 + hstep, voffA);
            PG8_WAIT_V(8); PG8_WAIT_L(0); PG8_BAR; PG8_MMA(0, 0, At, B0); PG8_MMA(0, 1, At, B1); PG8_BAR; PG8_SCHED;
            PG8_LDA(At, 0, 1); PG8_STAGE(PG8_SB(0, 0), b2, voffB); PG8_STAGE(PG8_SB(0, 1), b2 + hstep, voffB); PG8_STAGE(PG8_SA(0, 0), a2, voffA);
            PG8_WAIT_V(8); PG8_WAIT_L(0); PG8_BAR; PG8_MMA(1, 0, At, B0); PG8_MMA(1, 1, At, B1); PG8_BAR; PG8_SCHED;
            PG8_LDB(B0, 1, 0); PG8_LDB(B1, 1, 1); PG8_SCHED; PG8_LDA(At, 1, 0); PG8_STAGE(PG8_SA(0, 1), a2 + hstep, voffA);
            PG8_WAIT_V(8); PG8_WAIT_L(0); PG8_BAR; PG8_MMA(0, 0, At, B0); PG8_MMA(0, 1, At, B1); PG8_BAR; PG8_SCHED;
            PG8_LDA(At, 1, 1); PG8_STAGE(PG8_SB(1, 0), b3, voffB); PG8_STAGE(PG8_SB(1, 1), b3 + hstep, voffB); PG8_STAGE(PG8_SA(1, 0), a3, voffA);
            PG8_WAIT_V(8); PG8_WAIT_L(0); PG8_BAR; PG8_MMA(1, 0, At, B0); PG8_MMA(1, 1, At, B1); PG8_BAR; PG8_SCHED;
            } else {
            PG8_LDB(B0, 0, 0); PG8_SCHED; PG8_LDA(At, 0, 0); PG8_STAGE(PG8_SA(1, 1), a1 + hstep, voffA);
            PG8_WAIT_L(8); PG8_BAR; PG8_WAIT_L(0); PG8_MMA(0, 0, At, B0); PG8_BAR; PG8_SCHED;
            PG8_LDB(B1, 0, 1); PG8_STAGE(PG8_SB(0, 0), b2, voffB);
            PG8_BAR; PG8_WAIT_L(0); PG8_MMA(0, 1, At, B1); PG8_BAR;
            PG8_LDA(At, 0, 1); PG8_STAGE(PG8_SA(0, 0), a2, voffA);
            PG8_BAR; PG8_WAIT_L(0); PG8_MMA(1, 0, At, B0); PG8_BAR; PG8_SCHED;
            PG8_STAGE(PG8_SB(0, 1), b2 + hstep, voffB);
            PG8_WAIT_V(6); PG8_BAR; PG8_MMA(1, 1, At, B1); PG8_BAR;
            PG8_LDB(B0, 1, 0); PG8_SCHED; PG8_LDA(At, 1, 0); PG8_STAGE(PG8_SA(0, 1), a2 + hstep, voffA);
            PG8_WAIT_L(8); PG8_BAR; PG8_WAIT_L(0); PG8_MMA(0, 0, At, B0); PG8_BAR; PG8_SCHED;
            PG8_LDB(B1, 1, 1); PG8_STAGE(PG8_SB(1, 0), b3, voffB);
            PG8_BAR; PG8_WAIT_L(0); PG8_MMA(0, 1, At, B1); PG8_BAR;
            PG8_LDA(At, 1, 1); PG8_STAGE(PG8_SA(1, 0), a3, voffA);
            PG8_BAR; PG8_WAIT_L(0); PG8_MMA(1, 0, At, B0); PG8_BAR; PG8_SCHED;
            PG8_STAGE(PG8_SB(1, 1), b3 + hstep, voffB);
            PG8_WAIT_V(6); PG8_BAR; PG8_MMA(1, 1, At, B1); PG8_BAR;
            }
        }
        if constexpr (ALIGN_EPI) { if (wr == 0) PG8_BAR; }
        if constexpr (!Epi::AFTER_DRAIN) { E(acc, cur, wr, wc, fr, fq); S.done(cur); }
        if (!has_next) break;
#pragma unroll
        for (int a = 0; a < 2; ++a)
#pragma unroll
            for (int b = 0; b < 2; ++b)
#pragma unroll
                for (int m = 0; m < 4; ++m)
#pragma unroll
                    for (int n = 0; n < 2; ++n) acc[a][b][m][n] = (f32x4){0.f, 0.f, 0.f, 0.f};
        cur = nxt; cA = nA; cB = nB; ++ui;
        if constexpr (ALIGN_EPI) { if (wr == 1) PG8_BAR; }
    }
    PG8_WAIT_V(0);
    if constexpr (!ALIGN_EPI) { if (wr == 0) PG8_BAR; }
    PG8_BAR;
#undef PG8_SA
#undef PG8_SB
#undef PG8_STAGE
#undef PG8_LDA
#undef PG8_LDB
#undef PG8_MMA
#undef PG8_WAIT_V
#undef PG8_WAIT_L
#undef PG8_BAR
#undef PG8_SCHED
}
}

__device__ __forceinline__ void transpose_item(const float* W, int K, int N, bf16* WT, LAS float* scr, int item, int lane) {
    const int nblk = N / 32, kb = item / nblk, nb = item % nblk, k0 = 64 * kb, n0 = 32 * nb;
#pragma unroll 8
    for (int i = 0; i < 32; ++i) { const int kk = 2 * i + (lane >> 5); scr[kk * 33 + (lane & 31)] = W[(size_t)(k0 + kk) * N + n0 + (lane & 31)]; }
    asm volatile("s_waitcnt lgkmcnt(0)" ::: "memory");
    const int c = lane & 7;
#pragma unroll
    for (int j = 0; j < 4; ++j) { const int n = (lane >> 3) + 8 * j; const LAS float* s = scr + (8 * c) * 33 + n;
        uint4 o; o.x = pk2(s[0 * 33], s[1 * 33]); o.y = pk2(s[2 * 33], s[3 * 33]); o.z = pk2(s[4 * 33], s[5 * 33]); o.w = pk2(s[6 * 33], s[7 * 33]);
        *(uint4*)(WT + (size_t)(n0 + n) * K + k0 + 8 * c) = o; }
    asm volatile("s_waitcnt lgkmcnt(0)" ::: "memory");
}

__device__ __forceinline__ float wsum(float v) {
#pragma unroll
  for (int o = 32; o > 0; o >>= 1) v += __shfl_xor(v, o, 64);
  return v;
}
__device__ __forceinline__ float wmaxf(float v) {
#pragma unroll
  for (int o = 32; o > 0; o >>= 1) v = fmaxf(v, __shfl_xor(v, o, 64));
  return v;
}
__device__ __forceinline__ float sigmoidf_(float x) { return 1.0f / (1.0f + expf(-x)); }
__device__ __forceinline__ float gelu_tanh(float x) {
  return 0.5f * x * (1.0f + tanhf(0.7978845608028654f * (x + 0.044715f * x * x * x)));
}

template <bool BF16OUT>
__device__ __forceinline__ void rms_rows(const float* src, const float* g, void* dstv, int rows) {
  const int tid_ = opaque_tid();
  const int lane = tid_ & 63;
  const int gw = blockIdx.x * NWAVES + (tid_ >> 6);
  const int nw = gridDim.x * NWAVES;
  for (int r = gw; r < rows; r += nw) {
    const float4* s4 = (const float4*)(src + (size_t)r * DM);
    float4 v[4];
    float ss = 0.f;
#pragma unroll
    for (int i = 0; i < 4; i++) {
      v[i] = s4[lane + i * 64];
      ss += v[i].x * v[i].x + v[i].y * v[i].y + v[i].z * v[i].z + v[i].w * v[i].w;
    }
    ss = wsum(ss);
    const float rstd = rsqrtf(ss * (1.0f / DM) + EPSF);
    const float4* g4 = (const float4*)g;
#pragma unroll
    for (int i = 0; i < 4; i++) {
      float4 gg = g4[lane + i * 64];
      float4 o;
      o.x = v[i].x * rstd * gg.x; o.y = v[i].y * rstd * gg.y;
      o.z = v[i].z * rstd * gg.z; o.w = v[i].w * rstd * gg.w;
      if (BF16OUT) {
        uint2 pk; pk.x = pk2(o.x, o.y); pk.y = pk2(o.z, o.w);
        ((uint2*)((bf16*)dstv + (size_t)r * DM))[lane + i * 64] = pk;
      } else {
        ((float4*)((float*)dstv + (size_t)r * DM))[lane + i * 64] = o;
      }
    }
  }
}

__device__ __forceinline__ void ssm_params(const Params& p, float* ssmp_all) {
  const int tid_ = opaque_tid();
  const float* in8 = karg_in(8); const float* in9 = karg_in(9); const float* in10 = karg_in(10);
  const float* in11 = karg_in(11); const float* in12 = karg_in(12);
  const int gt = blockIdx.x * blockDim.x + tid_;
  const int nth = gridDim.x * blockDim.x;
  for (int i = gt; i < 2 * 16 * 64; i += nth) {
    const int l = i / 1024, gp = i % 1024, g = gp / 64;
    float* sp = ssmp_all + (size_t)l * SSMP_PER_LAYER;
    const float lre = fminf(in8[l * 1024 + gp], -1e-4f);
    const float lim = in9[l * 1024 + gp];
    const float dt = expf(in10[l * 16 + g]);
    const float er = expf(lre * dt);
    float sn, cs;
    sincosf(lim * dt, &sn, &cs);
    const float br = er * cs, bi = er * sn;
    sp[gp * 2 + 0] = br;
    sp[gp * 2 + 1] = bi;
    float cr = br, ci = bi;
#pragma unroll
    for (int s = 0; s < 6; s++) {
      const float nr = cr * cr - ci * ci, ni = 2.f * cr * ci;
      cr = nr; ci = ni;
    }
    sp[2048 + gp * 2 + 0] = cr;
    sp[2048 + gp * 2 + 1] = ci;
    const float nr = br - 1.0f, ni = bi;
    const float den = lre * lre + lim * lim;
    const float fr = (nr * lre + ni * lim) / den;
    const float fi = (ni * lre - nr * lim) / den;
    for (int h = 0; h < 16; h++) {
      const float bre = in11[((size_t)l * 1024 + gp) * 16 + h];
      const float bim = in12[((size_t)l * 1024 + gp) * 16 + h];
      sp[4096 + ((g * 16 + h) * 64 + (gp & 63)) * 2 + 0] = fr * bre - fi * bim;
      sp[4096 + ((g * 16 + h) * 64 + (gp & 63)) * 2 + 1] = fr * bim + fi * bre;
    }
  }
}

__device__ __forceinline__ void conv_phase(const Params& p, int l, const bf16* proj, bf16* y, LAS float* smem) {
  const int tid_ = opaque_tid();
  const int lane = tid_ & 63;
  const int gw = blockIdx.x * NWAVES + (tid_ >> 6);
  const int nw = gridDim.x * NWAVES;
  const float* cw = karg_in(4) + (size_t)l * 31 * 256;
  const float4 cb = ((const float4*)(karg_in(5) + l * 256))[lane];
  const float4 lg = ((const float4*)(karg_in(6) + l * 256))[lane];
  const float4 lb = ((const float4*)(karg_in(7) + l * 256))[lane];
  const float4 gg = ((const float4*)(karg_in(18) + l * 1024))[lane];
  LAS float* cwl = smem + 1024;
  for (int i = tid_; i < 31 * 256 / 4; i += NWAVES * 64) *(LAS pg8::f32x4*)(cwl + 4 * i) = *(const pg8::f32x4*)(cw + 4 * i);
  __syncthreads();
  for (int it = gw; it < NT / 8; it += nw) {
    const int tok0 = it * 8;
    const int t0 = tok0 & (SEQ - 1);
    float4 acc[8];
#pragma unroll
    for (int o = 0; o < 8; o++) acc[o] = cb;
#pragma unroll
    for (int i = 0; i < 38; i++) {
      if (t0 - 30 + i >= 0) {
        const bf16* row = proj + (size_t)(tok0 - 30 + i) * DIN;
        const uint2 vp = ((const uint2*)row)[lane];
        const uint2 gp = ((const uint2*)(row + 256))[lane];
        float4 g4;
        g4.x = bf_lo(vp.x) * sigmoidf_(bf_lo(gp.x)); g4.y = bf_hi(vp.x) * sigmoidf_(bf_hi(gp.x));
        g4.z = bf_lo(vp.y) * sigmoidf_(bf_lo(gp.y)); g4.w = bf_hi(vp.y) * sigmoidf_(bf_hi(gp.y));
#pragma unroll
        for (int o = 0; o < 8; o++) {
          const int j = i - o;
          if (j >= 0 && j <= 30) {
            const pg8::f32x4 w4 = *(const LAS pg8::f32x4*)(cwl + j * 256 + lane * 4);
            acc[o].x += g4.x * w4[0]; acc[o].y += g4.y * w4[1];
            acc[o].z += g4.z * w4[2]; acc[o].w += g4.w * w4[3];
          }
        }
      }
    }
#pragma unroll
    for (int o = 0; o < 8; o++) {
      const float4 a = acc[o];
      const float mean = wsum(a.x + a.y + a.z + a.w) * (1.0f / 256.f);
      const float dx = a.x - mean, dy = a.y - mean, dz = a.z - mean, dw = a.w - mean;
      const float var = wsum(dx * dx + dy * dy + dz * dz + dw * dw) * (1.0f / 256.f);
      const float rs = rsqrtf(var + EPSF);
      float4 s;
      s.x = dx * rs * lg.x + lb.x; s.y = dy * rs * lg.y + lb.y;
      s.z = dz * rs * lg.z + lb.z; s.w = dw * rs * lg.w + lb.w;
      s.x = s.x * sigmoidf_(s.x); s.y = s.y * sigmoidf_(s.y);
      s.z = s.z * sigmoidf_(s.z); s.w = s.w * sigmoidf_(s.w);
      const float ss = wsum(s.x * s.x + s.y * s.y + s.z * s.z + s.w * s.w) * (1.0f / 256.f);
      const float r2 = rsqrtf(ss + EPSF);
      uint2 pk; pk.x = pk2(s.x * r2 * gg.x, s.y * r2 * gg.y); pk.y = pk2(s.z * r2 * gg.z, s.w * r2 * gg.w);
      ((uint2*)(y + (size_t)(tok0 + o) * DM))[lane] = pk;
    }
  }
}

typedef short bf16x8_t __attribute__((ext_vector_type(8)));
typedef float f32x16_t __attribute__((ext_vector_type(16)));
#define MFMA_PAD() do { __builtin_amdgcn_sched_barrier(0); asm volatile("s_nop 15\n\ts_nop 15" ::: "memory"); __builtin_amdgcn_sched_barrier(0); } while (0)

__device__ __forceinline__ void attn_phase(const Params& p, int l, const bf16* proj, bf16* y, LAS float* smem) {
  const int tid = opaque_tid(), lane = tid & 63, wave = tid >> 6;
  const int n = lane & 31, hh = lane >> 5;
  const float* gg = karg_in(18) + l * 1024 + 256 + wave * 64;
  const float g0 = gg[n], g1 = gg[32 + n];
  LAS float* ssq = smem;
  LAS float* rstd = smem + 256;
  for (int item = blockIdx.x; item < 4 * 128; item += gridDim.x) {
    const int b = item >> 7, q0 = (item & 127) * 32;
    const size_t tokb = (size_t)b * SEQ;
    bf16x8_t qf[4];
    {
      const bf16* qrow = proj + (tokb + q0 + n) * DIN + 512 + wave * 64 + 8 * hh;
#pragma unroll
      for (int ks = 0; ks < 4; ks++) qf[ks] = *(const bf16x8_t*)(qrow + 16 * ks);
    }
    f32x16_t o0, o1;
#pragma unroll
    for (int r = 0; r < 16; r++) { o0[r] = 0.f; o1[r] = 0.f; }
    float R = 0.f;
    for (int kt = q0; kt >= 0; kt -= 32) {
      bf16x8_t kf[4];
      {
        const bf16* krow = proj + (tokb + kt + n) * DIN + 1024 + wave * 64 + 8 * hh;
#pragma unroll
        for (int ks = 0; ks < 4; ks++) kf[ks] = *(const bf16x8_t*)(krow + 16 * ks);
      }
      bf16x8_t vf0[2], vf1[2];
      {
        const bf16* vb = proj + (tokb + kt + 4 * hh) * DIN + 1536 + wave * 64 + n;
#pragma unroll
        for (int s = 0; s < 2; s++)
#pragma unroll
          for (int j = 0; j < 8; j++) {
            const int key = 16 * s + 8 * (j >> 2) + (j & 3);
            vf0[s][j] = (short)vb[(size_t)key * DIN];
            vf1[s][j] = (short)vb[(size_t)key * DIN + 32];
          }
      }
      f32x16_t sacc;
#pragma unroll
      for (int r = 0; r < 16; r++) sacc[r] = 0.f;
      __builtin_amdgcn_sched_barrier(0); asm volatile("s_nop 15\n\ts_nop 15" ::: "memory"); __builtin_amdgcn_sched_barrier(0);
#pragma unroll
      for (int ks = 0; ks < 4; ks++) sacc = __builtin_amdgcn_mfma_f32_32x32x16_bf16(kf[ks], qf[ks], sacc, 0, 0, 0);
      __builtin_amdgcn_sched_barrier(0); asm volatile("s_nop 15\n\ts_nop 15" ::: "memory"); __builtin_amdgcn_sched_barrier(0);
      float lst[16], lsz[16];
      const bool diag = (kt == q0);
#pragma unroll
      for (int r = 0; r < 16; r++) {
        const float z = sacc[r] * 0.125f;
        const float sp = __logf(1.0f + __expf(-fabsf(z)));
        float a = fminf(z, 0.f) - sp;
        float c = -(fmaxf(z, 0.f) + sp);
        if (diag) {
          const int key = (r & 3) + 8 * (r >> 2) + 4 * hh;
          if (key >= n) { a = -1.0e30f; c = 0.f; }
        }
        lsz[r] = a; lst[r] = c;
      }
      float Gs[4], Gp[4];
#pragma unroll
      for (int g = 0; g < 4; g++) {
        Gs[g] = (lst[4 * g] + lst[4 * g + 1]) + (lst[4 * g + 2] + lst[4 * g + 3]);
        Gp[g] = __shfl_xor(Gs[g], 32, 64);
      }
      float carry[4];
      {
        float after = R;
#pragma unroll
        for (int g = 3; g >= 0; g--) {
          carry[g] = after + (hh ? 0.f : Gp[g]);
          after += Gs[g] + Gp[g];
        }
        R = after;
      }
      bf16x8_t pf[2];
#pragma unroll
      for (int g = 0; g < 4; g++) {
        float run = carry[g];
        float a3 = __expf(lsz[4 * g + 3] + run); run += lst[4 * g + 3];
        float a2 = __expf(lsz[4 * g + 2] + run); run += lst[4 * g + 2];
        float a1 = __expf(lsz[4 * g + 1] + run); run += lst[4 * g + 1];
        float a0 = __expf(lsz[4 * g + 0] + run);
        const int s = g >> 1, jb = (g & 1) * 4;
        pf[s][jb + 0] = (short)f2bf(a0); pf[s][jb + 1] = (short)f2bf(a1);
        pf[s][jb + 2] = (short)f2bf(a2); pf[s][jb + 3] = (short)f2bf(a3);
      }
      __builtin_amdgcn_sched_barrier(0); asm volatile("s_nop 15\n\ts_nop 15" ::: "memory"); __builtin_amdgcn_sched_barrier(0);
#pragma unroll
      for (int s = 0; s < 2; s++) {
        o0 = __builtin_amdgcn_mfma_f32_32x32x16_bf16(pf[s], vf0[s], o0, 0, 0, 0);
        o1 = __builtin_amdgcn_mfma_f32_32x32x16_bf16(pf[s], vf1[s], o1, 0, 0, 0);
      }
      __builtin_amdgcn_sched_barrier(0); asm volatile("s_nop 15\n\ts_nop 15" ::: "memory"); __builtin_amdgcn_sched_barrier(0);
      if (__all(R < -110.f)) break;
    }
    float sq[16];
#pragma unroll
    for (int r = 0; r < 16; r++) {
      float v = o0[r] * o0[r] + o1[r] * o1[r];
#pragma unroll
      for (int o = 16; o > 0; o >>= 1) v += __shfl_xor(v, o, 64);
      sq[r] = v;
    }
    __syncthreads();
    if (n == 0) {
#pragma unroll
      for (int r = 0; r < 16; r++) ssq[wave * 32 + (r & 3) + 8 * (r >> 2) + 4 * hh] = sq[r];
    }
    __syncthreads();
    if (tid < 32) {
      float t = 0.f;
#pragma unroll
      for (int w = 0; w < 8; w++) t += ssq[w * 32 + tid];
      rstd[tid] = rsqrtf(t * (1.0f / 512.f) + EPSF);
    }
    __syncthreads();
#pragma unroll
    for (int r = 0; r < 16; r++) {
      const int qi = (r & 3) + 8 * (r >> 2) + 4 * hh;
      const float rs = rstd[qi];
      bf16* yr = y + (tokb + q0 + qi) * DM + 256 + wave * 64 + n;
      yr[0] = (bf16)f2bf(o0[r] * rs * g0);
      yr[32] = (bf16)f2bf(o1[r] * rs * g1);
    }
  }
}

#define SSM_BCAST_U(u, ua, ub, tt) do { \
    const unsigned w0 = (unsigned)__builtin_amdgcn_readlane((int)(ua).x, (tt)), w1 = (unsigned)__builtin_amdgcn_readlane((int)(ua).y, (tt)); \
    const unsigned w2 = (unsigned)__builtin_amdgcn_readlane((int)(ua).z, (tt)), w3 = (unsigned)__builtin_amdgcn_readlane((int)(ua).w, (tt)); \
    const unsigned w4 = (unsigned)__builtin_amdgcn_readlane((int)(ub).x, (tt)), w5 = (unsigned)__builtin_amdgcn_readlane((int)(ub).y, (tt)); \
    const unsigned w6 = (unsigned)__builtin_amdgcn_readlane((int)(ub).z, (tt)), w7 = (unsigned)__builtin_amdgcn_readlane((int)(ub).w, (tt)); \
    (u)[0] = bf_lo(w0); (u)[1] = bf_hi(w0); (u)[2] = bf_lo(w1); (u)[3] = bf_hi(w1); (u)[4] = bf_lo(w2); (u)[5] = bf_hi(w2); (u)[6] = bf_lo(w3); (u)[7] = bf_hi(w3); \
    (u)[8] = bf_lo(w4); (u)[9] = bf_hi(w4); (u)[10] = bf_lo(w5); (u)[11] = bf_hi(w5); (u)[12] = bf_lo(w6); (u)[13] = bf_hi(w6); (u)[14] = bf_lo(w7); (u)[15] = bf_hi(w7); } while (0)
__device__ __forceinline__ void ssm_chunk_end(const float* ssmp, const bf16* proj, float* ssmE) {
  const int tid_ = opaque_tid();
  const int lane = tid_ & 63;
  const int gw = blockIdx.x * NWAVES + (tid_ >> 6);
  const int nw = gridDim.x * NWAVES;
  for (int it = gw; it < 4 * 64 * 16; it += nw) {
    const int g = it & 15, c = (it >> 4) & 63, b = it >> 10;
    const int gp = g * 64 + lane;
    const uint4* up = (const uint4*)(proj + (size_t)(b * SEQ + c * 64 + lane) * DIN + 2048 + g * 16);
    const uint4 ua = up[0], ub = up[1];
    const float lbr = ssmp[gp * 2], lbi = ssmp[gp * 2 + 1];
    float bbr[16], bbi[16];
#pragma unroll
    for (int h = 0; h < 16; h++) {
      { const float2 bb = *(const float2*)(ssmp + 4096 + ((g * 16 + h) * 64 + lane) * 2); bbr[h] = bb.x; bbi[h] = bb.y; }
    }
    float xr = 0.f, xi = 0.f;
#pragma unroll 2
    for (int tt = 0; tt < 64; tt++) {
      float u[16];
      SSM_BCAST_U(u, ua, ub, tt);
      float br = 0.f, bi = 0.f;
#pragma unroll
      for (int h = 0; h < 16; h++) { br += bbr[h] * u[h]; bi += bbi[h] * u[h]; }
      const float nr = lbr * xr - lbi * xi + br;
      const float ni = lbr * xi + lbi * xr + bi;
      xr = nr; xi = ni;
    }
    float* e = ssmE + ((size_t)((b * 64 + c) * 16 + g) * 64 + lane) * 2;
    e[0] = xr; e[1] = xi;
  }
}

__device__ __forceinline__ void ssm_finish(const Params& p, int l, const float* ssmp, const bf16* proj,
                           const float* ssmE, bf16* y, LAS float* smem) {
  LAS bf16* Ytb = (LAS bf16*)smem;
  LAS float* ssq2 = smem + (64 * 264 * 2) / 4;
  LAS float* rstd2 = ssq2 + 512;
  const bf16* glT = (const bf16*)(p.ws + WS_WT + (size_t)l * WT_LAYER + WT_GLU);
  const int tid = opaque_tid(), lane = tid & 63, wave = tid >> 6;
  const float* cre = karg_in(13) + (size_t)l * 16 * 16 * 64;
  const float* cim = karg_in(14) + (size_t)l * 16 * 16 * 64;
  const float* dsk = karg_in(15) + l * 256;
  const float* glw = karg_in(16) + (size_t)l * 256 * 256;
  const float* glb = karg_in(17) + l * 256;
  const float* gg = karg_in(18) + l * 1024 + 768;
  for (int it = blockIdx.x; it < 256; it += gridDim.x) {
    const int b = it >> 6, c = it & 63;
    __syncthreads();
    for (int gi = 0; gi < 2; gi++) {
      const int g = wave + gi * 8;
      const int gp = g * 64 + lane;
      const float lbr = ssmp[gp * 2], lbi = ssmp[gp * 2 + 1];
      const float lcr = ssmp[2048 + gp * 2], lci = ssmp[2048 + gp * 2 + 1];
      float bbr[16], bbi[16], ccr[16], cci[16];
#pragma unroll
      for (int h = 0; h < 16; h++) {
        { const float2 bb = *(const float2*)(ssmp + 4096 + ((g * 16 + h) * 64 + lane) * 2); bbr[h] = bb.x; bbi[h] = bb.y; }
        ccr[h] = cre[(g * 16 + h) * 64 + lane];
        cci[h] = cim[(g * 16 + h) * 64 + lane];
      }
      float xr = 0.f, xi = 0.f;
      {
        const float2* eb = (const float2*)ssmE + ((size_t)(b * 64) * 16 + g) * 64 + lane;
        int cc = 0;
        for (; cc + 8 <= c; cc += 8) {
          float2 ev[8];
#pragma unroll
          for (int k = 0; k < 8; k++) ev[k] = eb[(size_t)(cc + k) * 16 * 64];
#pragma unroll
          for (int k = 0; k < 8; k++) {
            const float nr = lcr * xr - lci * xi + ev[k].x;
            const float ni = lcr * xi + lci * xr + ev[k].y;
            xr = nr; xi = ni;
          }
        }
        for (; cc < c; cc++) {
          const float2 e1 = eb[(size_t)cc * 16 * 64];
          const float nr = lcr * xr - lci * xi + e1.x;
          const float ni = lcr * xi + lci * xr + e1.y;
          xr = nr; xi = ni;
        }
      }
      const int hq = ((lane >> 5) & 1) * 8 + ((lane >> 4) & 1) * 4 + ((lane >> 3) & 1) * 2 + ((lane >> 2) & 1);
      float dm[16];
#pragma unroll
      for (int h = 0; h < 16; h++) dm[h] = (lane == 0) ? dsk[g * 16 + h] : 0.f;
      const uint4* up = (const uint4*)(proj + (size_t)(b * SEQ + c * 64 + lane) * DIN + 2048 + g * 16);
      const uint4 ua = up[0], ub = up[1];
#pragma unroll 1
      for (int t4 = 0; t4 < 64; t4 += 4) {
        float vv[4][16];
#pragma unroll
        for (int s = 0; s < 4; s++) {
          float u[16];
          SSM_BCAST_U(u, ua, ub, t4 + s);
          float br = 0.f, bi = 0.f;
#pragma unroll
          for (int h = 0; h < 16; h++) { br += bbr[h] * u[h]; bi += bbi[h] * u[h]; }
          const float nr = lbr * xr - lbi * xi + br;
          const float ni = lbr * xi + lbi * xr + bi;
          xr = nr; xi = ni;
#pragma unroll
          for (int h = 0; h < 16; h++) vv[s][h] = xr * ccr[h] - xi * cci[h] + dm[h] * u[h];
        }
        float v1[4];
#pragma unroll
        for (int s = 0; s < 4; s++) {
          float v8[8], v4[4], v2[2];
          {
            const bool hi = (lane & 32) != 0;
#pragma unroll
            for (int i = 0; i < 8; i++) { const float send = hi ? vv[s][i] : vv[s][i + 8]; const float keep = hi ? vv[s][i + 8] : vv[s][i]; v8[i] = keep + __shfl_xor(send, 32, 64); }
          }
          {
            const bool hi = (lane & 16) != 0;
#pragma unroll
            for (int i = 0; i < 4; i++) { const float send = hi ? v8[i] : v8[i + 4]; const float keep = hi ? v8[i + 4] : v8[i]; v4[i] = keep + __shfl_xor(send, 16, 64); }
          }
          {
            const bool hi = (lane & 8) != 0;
#pragma unroll
            for (int i = 0; i < 2; i++) { const float send = hi ? v4[i] : v4[i + 2]; const float keep = hi ? v4[i + 2] : v4[i]; v2[i] = keep + __shfl_xor(send, 8, 64); }
          }
          {
            const bool hi = (lane & 4) != 0;
            const float send = hi ? v2[0] : v2[1];
            const float keep = hi ? v2[1] : v2[0];
            v1[s] = keep + __shfl_xor(send, 4, 64);
          }
          v1[s] += __shfl_xor(v1[s], 2, 64);
          v1[s] += __shfl_xor(v1[s], 1, 64);
        }
        if ((lane & 3) == 0) {
#pragma unroll
          for (int s = 0; s < 4; s++) Ytb[(t4 + s) * 264 + g * 16 + hq] = (bf16)f2bf(gelu_tanh(v1[s]));
        }
      }
    }
    __syncthreads();
    {
      const int n = lane & 31, hh = lane >> 5;
      const int ch = wave * 32 + n;
      const float bj = glb[ch];
      const float gj = gg[ch];
      bf16x8_t gf[16];
      {
        const bf16* grow = glT + (size_t)ch * 256 + 8 * hh;
#pragma unroll
        for (int ks = 0; ks < 16; ks++) gf[ks] = *(const bf16x8_t*)(grow + 16 * ks);
      }
      float oo[2][16];
#pragma unroll
      for (int mt = 0; mt < 2; mt++) {
        f32x16_t z;
#pragma unroll
        for (int r = 0; r < 16; r++) z[r] = 0.f;
        const LAS bf16* yrow = Ytb + (mt * 32 + n) * 264 + 8 * hh;
#pragma unroll
        for (int kq = 0; kq < 4; kq++) {
          bf16x8_t yf[4];
#pragma unroll
          for (int i = 0; i < 4; i++) yf[i] = *(const LAS bf16x8_t*)(yrow + 16 * (kq * 4 + i));
          MFMA_PAD();
#pragma unroll
          for (int i = 0; i < 4; i++) z = __builtin_amdgcn_mfma_f32_32x32x16_bf16(yf[i], gf[kq * 4 + i], z, 0, 0, 0);
          MFMA_PAD();
        }
        float sq[16];
#pragma unroll
        for (int r = 0; r < 16; r++) {
          const int t = mt * 32 + (r & 3) + 8 * (r >> 2) + 4 * hh;
          const float yv = bf2f(Ytb[t * 264 + ch]);
          const float o = yv * sigmoidf_(z[r] + bj);
          oo[mt][r] = o;
          float v = o * o;
#pragma unroll
          for (int s = 16; s > 0; s >>= 1) v += __shfl_xor(v, s, 64);
          sq[r] = v;
        }
        if (n == 0) {
#pragma unroll
          for (int r = 0; r < 16; r++) ssq2[wave * 64 + mt * 32 + (r & 3) + 8 * (r >> 2) + 4 * hh] = sq[r];
        }
      }
      __syncthreads();
      if (tid < 64) {
        float t = 0.f;
#pragma unroll
        for (int w = 0; w < 8; w++) t += ssq2[w * 64 + tid];
        rstd2[tid] = rsqrtf(t * (1.0f / 256.f) + EPSF);
      }
      __syncthreads();
#pragma unroll
      for (int mt = 0; mt < 2; mt++)
#pragma unroll
        for (int r = 0; r < 16; r++) {
          const int t = mt * 32 + (r & 3) + 8 * (r >> 2) + 4 * hh;
          y[(size_t)(b * SEQ + c * 64 + t) * DM + 768 + ch] = (bf16)f2bf(oo[mt][r] * rstd2[t] * gj);
        }
    }
  }
}

__device__ __forceinline__ void memattn_phase(const bf16* q, const bf16* kvb, const bf16* vT, bf16* o) {
  const int tid_ = opaque_tid();
  const int lane = tid_ & 63, n = lane & 31, hh = lane >> 5;
  const int gw = blockIdx.x * NWAVES + (tid_ >> 6);
  const int nw = gridDim.x * NWAVES;
  const int sig = (n & 0x13) | ((n & 4) << 1) | ((n & 8) >> 1);
  for (int it = gw; it < 512 * 4; it += nw) {
    const int h = it & 3, tok0 = (it >> 2) * 32, b = tok0 >> 12;
    f32x16_t st[8];
#pragma unroll
    for (int kt = 0; kt < 8; kt++)
#pragma unroll
      for (int r = 0; r < 16; r++) st[kt][r] = 0.f;
    const bf16* qrow = q + (size_t)(tok0 + n) * DM + h * 256 + 8 * hh;
    const bf16* kbase = kvb + (size_t)(b * NMEM + sig) * 2048 + h * 256 + 8 * hh;
#pragma unroll
    for (int kq = 0; kq < 4; kq++) {
      bf16x8_t qf[4];
#pragma unroll
      for (int i = 0; i < 4; i++) qf[i] = *(const bf16x8_t*)(qrow + 16 * (kq * 4 + i));
#pragma unroll
      for (int kt = 0; kt < 8; kt++) {
        const bf16* krow = kbase + (size_t)kt * 32 * 2048;
        bf16x8_t kf[4];
#pragma unroll
        for (int i = 0; i < 4; i++) kf[i] = *(const bf16x8_t*)(krow + 16 * (kq * 4 + i));
        MFMA_PAD();
#pragma unroll
        for (int i = 0; i < 4; i++) st[kt] = __builtin_amdgcn_mfma_f32_32x32x16_bf16(kf[i], qf[i], st[kt], 0, 0, 0);
        MFMA_PAD();
      }
    }
    float mx = st[0][0];
#pragma unroll
    for (int kt = 0; kt < 8; kt++)
#pragma unroll
      for (int r = 0; r < 16; r++) mx = fmaxf(mx, st[kt][r]);
    mx = fmaxf(mx, __shfl_xor(mx, 32, 64));
    float sum = 0.f;
#pragma unroll
    for (int kt = 0; kt < 8; kt++)
#pragma unroll
      for (int r = 0; r < 16; r++) { const float e = __expf((st[kt][r] - mx) * 0.0625f); st[kt][r] = e; sum += e; }
    sum += __shfl_xor(sum, 32, 64);
    const float inv = 1.0f / sum;
    bf16x8_t pf[8][2];
#pragma unroll
    for (int kt = 0; kt < 8; kt++)
#pragma unroll
      for (int s = 0; s < 2; s++)
#pragma unroll
        for (int j = 0; j < 8; j++) pf[kt][s][j] = (short)f2bf(st[kt][8 * s + j] * inv);
    const bf16* vbase = vT + ((size_t)(b * 4 + h) * 256 + n) * 256 + 8 * hh;
#pragma unroll 1
    for (int dt = 0; dt < 8; dt++) {
      f32x16_t oacc;
#pragma unroll
      for (int r = 0; r < 16; r++) oacc[r] = 0.f;
      const bf16* vrow = vbase + (size_t)dt * 32 * 256;
#pragma unroll
      for (int kq = 0; kq < 4; kq++) {
        bf16x8_t vf[4];
#pragma unroll
        for (int i = 0; i < 4; i++) vf[i] = *(const bf16x8_t*)(vrow + (kq * 2 + (i >> 1)) * 32 + 16 * (i & 1));
        MFMA_PAD();
#pragma unroll
        for (int i = 0; i < 4; i++) oacc = __builtin_amdgcn_mfma_f32_32x32x16_bf16(pf[kq * 2 + (i >> 1)][i & 1], vf[i], oacc, 0, 0, 0);
        MFMA_PAD();
      }
#pragma unroll
      for (int r = 0; r < 16; r++) {
        const int qi = (r & 3) + 8 * (r >> 2) + 4 * hh;
        o[(size_t)(tok0 + qi) * DM + h * 256 + dt * 32 + n] = (bf16)f2bf(oacc[r]);
      }
    }
  }
}

__device__ __forceinline__ void vt_phase(const bf16* kvb, bf16* vT) {
  const int tid_ = opaque_tid();
  const int gt = blockIdx.x * (NWAVES * 64) + tid_;
  const int nth = gridDim.x * NWAVES * 64;
  for (int i = gt; i < 2 * 4 * 4 * 256 * 256; i += nth) {
    const int m = i & 255, d = (i >> 8) & 255, h = (i >> 16) & 3, b = (i >> 18) & 3, l = i >> 20;
    vT[i] = kvb[((size_t)l * 1024 + b * 256 + m) * 2048 + 1024 + h * 256 + d];
  }
}

__device__ __forceinline__ void topk_rounds(float (&s)[64], int hh, float (&tv)[16], int (&ti)[16]) {
  const float NEG = -3.0e38f;
#pragma unroll 1
  for (int r = 0; r < 16; r++) {
    float m = s[0]; int slot = 0;
#pragma unroll
    for (int i = 1; i < 64; i++) {
      const bool gt = s[i] > m;
      m = gt ? s[i] : m;
      slot = gt ? i : slot;
    }
    const int rr = slot & 15;
    const int idx = (slot >> 4) * 32 + (rr & 3) + 8 * (rr >> 2) + 4 * hh;
    const float pm = __shfl_xor(m, 32, 64);
    const int pidx = __shfl_xor(idx, 32, 64);
    const bool mine = (m > pm) || (m == pm && idx < pidx);
    const float wv = mine ? m : pm;
    const int wi = mine ? idx : pidx;
#pragma unroll
    for (int j = 0; j < 16; j++) { tv[j] = (r == j) ? wv : tv[j]; ti[j] = (r == j) ? wi : ti[j]; }
    const int kill = mine ? slot : -1;
#pragma unroll
    for (int i = 0; i < 64; i++) s[i] = (kill == i) ? NEG : s[i];
  }
}

__device__ __forceinline__ void peer_topk(const bf16* pq, const bf16* skb, int* ids, float* gates) {
  const int tid_ = opaque_tid();
  const int lane = tid_ & 63, n = lane & 31, hh = lane >> 5;
  const int gw = blockIdx.x * NWAVES + (tid_ >> 6);
  const int nw = gridDim.x * NWAVES;
  const float NEG = -3.0e38f;
  for (int it = gw; it < 512 * 8; it += nw) {
    const int h = it & 7, tok0 = (it >> 3) * 32;
    float tv0[16], tv1[16];
    int ti0[16], ti1[16];
#pragma unroll
    for (int j = 0; j < 16; j++) { tv0[j] = 0.f; tv1[j] = 0.f; ti0[j] = 0; ti1[j] = 0; }
#pragma unroll
    for (int half = 0; half < 2; half++) {
      bf16x8_t qf[8];
      {
        const bf16* qrow = pq + (size_t)(tok0 + n) * 2048 + h * 256 + half * 128 + 8 * hh;
#pragma unroll
        for (int ks = 0; ks < 8; ks++) qf[ks] = *(const bf16x8_t*)(qrow + 16 * ks);
      }
      f32x16_t st[4];
#pragma unroll
      for (int kt = 0; kt < 4; kt++) {
        const bf16* krow = skb + ((size_t)((h * 2 + half) * 128 + kt * 32 + n)) * 128 + 8 * hh;
        asm volatile("" : "+v"(krow));
        f32x16_t acc;
#pragma unroll
        for (int r = 0; r < 16; r++) acc[r] = 0.f;
#pragma unroll
        for (int kq = 0; kq < 2; kq++) {
          bf16x8_t kf[4];
#pragma unroll
          for (int i = 0; i < 4; i++) kf[i] = *(const bf16x8_t*)(krow + 16 * (kq * 4 + i));
          MFMA_PAD();
#pragma unroll
          for (int i = 0; i < 4; i++) acc = __builtin_amdgcn_mfma_f32_32x32x16_bf16(kf[i], qf[kq * 4 + i], acc, 0, 0, 0);
          MFMA_PAD();
        }
        st[kt] = acc;
      }
      float s[64];
#pragma unroll
      for (int kt = 0; kt < 4; kt++)
#pragma unroll
        for (int i = 0; i < 16; i++) s[kt * 16 + i] = st[kt][i];
      __builtin_amdgcn_sched_barrier(0);
      if (half == 0) topk_rounds(s, hh, tv0, ti0); else topk_rounds(s, hh, tv1, ti1);
      __builtin_amdgcn_sched_barrier(0);
    }
    float F[16];
    int ba[16];
#pragma unroll
    for (int a = 0; a < 16; a++) { F[a] = tv0[a] + tv1[0]; ba[a] = 0; }
    float bv[16];
    int be[16];
#pragma unroll
    for (int j = 0; j < 16; j++) { bv[j] = 0.f; be[j] = 0; }
#pragma unroll 1
    for (int r = 0; r < 16; r++) {
      float m = F[0]; int a = 0;
#pragma unroll
      for (int i = 1; i < 16; i++) { const bool gt = F[i] > m; m = gt ? F[i] : m; a = gt ? i : a; }
      int bsel = 0, i0 = 0; float t0 = 0.f;
#pragma unroll
      for (int i = 0; i < 16; i++) { const bool is = (a == i); bsel = is ? ba[i] : bsel; i0 = is ? ti0[i] : i0; t0 = is ? tv0[i] : t0; }
      int i1 = 0; float t1n = NEG;
#pragma unroll
      for (int i = 0; i < 16; i++) { i1 = (bsel == i) ? ti1[i] : i1; t1n = (bsel + 1 == i) ? tv1[i] : t1n; }
      const int e = i0 * 128 + i1;
      const float fn = (bsel + 1 < 16) ? (t0 + t1n) : NEG;
#pragma unroll
      for (int i = 0; i < 16; i++) { const bool is = (a == i); F[i] = is ? fn : F[i]; ba[i] = is ? (bsel + 1) : ba[i]; }
#pragma unroll
      for (int j = 0; j < 16; j++) { bv[j] = (r == j) ? m : bv[j]; be[j] = (r == j) ? e : be[j]; }
    }
    const float b0 = bv[0];
    float ge[16];
    float gsum = 0.f;
#pragma unroll
    for (int r = 0; r < 16; r++) { ge[r] = __expf(bv[r] - b0); gsum += ge[r]; }
    const float ginv = 1.0f / gsum;
    if (hh == 0) {
      int* ip = ids + (size_t)(tok0 + n) * 128 + h * 16;
      float* gp = gates + (size_t)(tok0 + n) * 128 + h * 16;
#pragma unroll
      for (int r4 = 0; r4 < 4; r4++) {
        *(int4*)(ip + 4 * r4) = make_int4(be[4 * r4], be[4 * r4 + 1], be[4 * r4 + 2], be[4 * r4 + 3]);
        *(float4*)(gp + 4 * r4) = make_float4(ge[4 * r4] * ginv, ge[4 * r4 + 1] * ginv, ge[4 * r4 + 2] * ginv, ge[4 * r4 + 3] * ginv);
      }
    }
  }
}

typedef _Float16 f16x2_t __attribute__((ext_vector_type(2)));
__device__ __forceinline__ unsigned e4m3x2_to_f16x2(unsigned w, unsigned sel) {
  const unsigned p = __builtin_amdgcn_perm(w, w, sel);
  return (p & 0x80008000u) | ((p >> 1) & 0x3F803F80u);
}
__device__ __forceinline__ float dot2h(unsigned a, unsigned b, float c) {
  return __builtin_amdgcn_fdot2(__builtin_bit_cast(f16x2_t, a), __builtin_bit_cast(f16x2_t, b), c, false);
}
__device__ __forceinline__ unsigned pack_h2(float lo, float hi) {
  f16x2_t v; v.x = (_Float16)lo; v.y = (_Float16)hi;
  return __builtin_bit_cast(unsigned, v);
}
__device__ __forceinline__ void peer_gather(const bf16* xn, const unsigned char* ub, const unsigned char* vb,
                                            const int* ids, const float* gates, float* xw) {
  const int tid_ = opaque_tid();
  const int lane = tid_ & 63;
  const int gw = blockIdx.x * NWAVES + (tid_ >> 6);
  const int nw = gridDim.x * NWAVES;
  const int el = ((lane >> 5) & 1) * 4 + ((lane >> 4) & 1) * 2 + ((lane >> 3) & 1);
  for (int tok = gw; tok < NT; tok += nw) {
    unsigned xh[8];
    {
      const uint4 a = *(const uint4*)(xn + (size_t)tok * DM + lane * 16);
      const uint4 b = *(const uint4*)(xn + (size_t)tok * DM + lane * 16 + 8);
      const unsigned xw_[8] = {a.x, a.y, a.z, a.w, b.x, b.y, b.z, b.w};
#pragma unroll
      for (int k = 0; k < 8; k++) xh[k] = pack_h2(bf_lo(xw_[k]), bf_hi(xw_[k]));
    }
    float acc[16];
#pragma unroll
    for (int i = 0; i < 16; i++) acc[i] = 0.f;
#pragma unroll 1
    for (int g = 0; g < 16; g++) {
      const int idv = ids[(size_t)tok * 128 + g * 8 + (lane & 7)];
      const float gv = gates[(size_t)tok * 128 + g * 8 + el];
      uint4 uu[8], vv[8];
#pragma unroll
      for (int e = 0; e < 8; e++) {
        const int id = __builtin_amdgcn_readlane(idv, e);
        uu[e] = *(const uint4*)(ub + (size_t)id * DM + lane * 16);
        vv[e] = *(const uint4*)(vb + (size_t)id * DM + lane * 16);
      }
      float d[8];
#pragma unroll
      for (int e = 0; e < 8; e++) {
        const unsigned uw[4] = {uu[e].x, uu[e].y, uu[e].z, uu[e].w};
        float s = 0.f;
#pragma unroll
        for (int k = 0; k < 4; k++) {
          s = dot2h(e4m3x2_to_f16x2(uw[k], 0x010c000cu), xh[2 * k], s);
          s = dot2h(e4m3x2_to_f16x2(uw[k], 0x030c020cu), xh[2 * k + 1], s);
        }
        d[e] = s;
      }
      float d4[4], d2[2], d1;
      {
        const bool hi = (lane & 32) != 0;
#pragma unroll
        for (int i = 0; i < 4; i++) { const float send = hi ? d[i] : d[i + 4]; const float keep = hi ? d[i + 4] : d[i]; d4[i] = keep + __shfl_xor(send, 32, 64); }
      }
      {
        const bool hi = (lane & 16) != 0;
#pragma unroll
        for (int i = 0; i < 2; i++) { const float send = hi ? d4[i] : d4[i + 2]; const float keep = hi ? d4[i + 2] : d4[i]; d2[i] = keep + __shfl_xor(send, 16, 64); }
      }
      {
        const bool hi = (lane & 8) != 0;
        const float send = hi ? d2[0] : d2[1];
        const float keep = hi ? d2[1] : d2[0];
        d1 = keep + __shfl_xor(send, 8, 64);
      }
      d1 += __shfl_xor(d1, 4, 64);
      d1 += __shfl_xor(d1, 2, 64);
      d1 += __shfl_xor(d1, 1, 64);
      const float wl = gv * gelu_tanh(d1 * (256.0f / U_SCALE)) * (256.0f / V_SCALE);
#pragma unroll
      for (int e = 0; e < 8; e++) {
        const float w = __builtin_bit_cast(float, __builtin_amdgcn_readlane(__builtin_bit_cast(int, wl), ((e >> 2) & 1) * 32 + ((e >> 1) & 1) * 16 + (e & 1) * 8));
        const unsigned wlo = pack_h2(w, 0.f), whi = pack_h2(0.f, w);
        const unsigned vw[4] = {vv[e].x, vv[e].y, vv[e].z, vv[e].w};
#pragma unroll
        for (int k = 0; k < 4; k++) {
          const unsigned h0 = e4m3x2_to_f16x2(vw[k], 0x010c000cu), h1 = e4m3x2_to_f16x2(vw[k], 0x030c020cu);
          acc[4 * k + 0] = dot2h(h0, wlo, acc[4 * k + 0]);
          acc[4 * k + 1] = dot2h(h0, whi, acc[4 * k + 1]);
          acc[4 * k + 2] = dot2h(h1, wlo, acc[4 * k + 2]);
          acc[4 * k + 3] = dot2h(h1, whi, acc[4 * k + 3]);
        }
      }
    }
    float* xr = xw + (size_t)tok * DM + lane * 16;
#pragma unroll
    for (int c = 0; c < 4; c++) {
      float4 a0 = *(float4*)(xr + c * 4);
      a0.x += acc[c * 4 + 0]; a0.y += acc[c * 4 + 1]; a0.z += acc[c * 4 + 2]; a0.w += acc[c * 4 + 3];
      *(float4*)(xr + c * 4) = a0;
    }
  }
}

__device__ __forceinline__ void prologue_transposes(const Params& p, unsigned char* ws, LAS unsigned char* lds) {
  const int tid_ = opaque_tid();
  const int lane = tid_ & 63, wave = tid_ >> 6;
  LAS float* scr = (LAS float*)(lds + wave * 16384);
  const int gw = blockIdx.x * NWAVES + wave, NGW = gridDim.x * NWAVES;
  constexpr int I_IN = (DM / 64) * (DIN / 32), I_SQ = (DM / 64) * (DM / 32), I_2K = (DM / 64) * (2048 / 32);
  constexpr int I_GL = (256 / 64) * (256 / 32);
  constexpr int PER_LAYER = I_IN + 3 * I_SQ + 2 * I_2K + I_GL;
  const float* w3 = karg_in(3); const float* w19 = karg_in(19); const float* w22 = karg_in(22);
  const float* w23 = karg_in(23); const float* w24 = karg_in(24); const float* w26 = karg_in(26);
  const float* w16 = karg_in(16);
  for (int it = gw; it < 2 * PER_LAYER; it += NGW) {
    const int l = it / PER_LAYER;
    int r = it % PER_LAYER;
    unsigned char* wl = ws + WS_WT + (size_t)l * WT_LAYER;
    if (r < I_IN) { transpose_item(w3 + (size_t)l * DM * DIN, DM, DIN, (bf16*)(wl + WT_IN), scr, r, lane); continue; } r -= I_IN;
    if (r < I_SQ) { transpose_item(w19 + (size_t)l * DM * DM, DM, DM, (bf16*)(wl + WT_OUT), scr, r, lane); continue; } r -= I_SQ;
    if (r < I_SQ) { transpose_item(w22 + (size_t)l * DM * DM, DM, DM, (bf16*)(wl + WT_MQ), scr, r, lane); continue; } r -= I_SQ;
    if (r < I_2K) { transpose_item(w23 + (size_t)l * DM * 2048, DM, 2048, (bf16*)(wl + WT_MKV), scr, r, lane); continue; } r -= I_2K;
    if (r < I_SQ) { transpose_item(w24 + (size_t)l * DM * DM, DM, DM, (bf16*)(wl + WT_MO), scr, r, lane); continue; } r -= I_SQ;
    if (r < I_2K) { transpose_item(w26 + (size_t)l * DM * 2048, DM, 2048, (bf16*)(wl + WT_PQ), scr, r, lane); continue; } r -= I_2K;
    transpose_item(w16 + (size_t)l * 256 * 256, 256, 256, (bf16*)(wl + WT_GLU), scr, r, lane);
  }
}

template <class T> __device__ __forceinline__ T* opq(T* p) { asm volatile("" : "+s"(p)); return p; }
__device__ __forceinline__ void cvt_rows_bf16(const float* src, bf16* dst, size_t n) {
  const int tid_ = opaque_tid();
  const size_t gt = (size_t)blockIdx.x * (NWAVES * 64) + tid_;
  const size_t nth = (size_t)gridDim.x * NWAVES * 64;
  for (size_t i = gt; i < n / 8; i += nth) {
    const float4 a = ((const float4*)src)[2 * i], b = ((const float4*)src)[2 * i + 1];
    uint4 o; o.x = pk2(a.x, a.y); o.y = pk2(a.z, a.w); o.z = pk2(b.x, b.y); o.w = pk2(b.z, b.w);
    ((uint4*)dst)[i] = o;
  }
}

__device__ __forceinline__ unsigned enc_e4m3(float x) {
  const unsigned bits = __builtin_bit_cast(unsigned, x);
  const unsigned sign = (bits >> 24) & 0x80u;
  float ax = fminf(fabsf(x), 448.0f);
  unsigned r;
  if (ax >= 0.015625f) {
    unsigned ab = __builtin_bit_cast(unsigned, ax);
    ab += 0x0007FFFFu + ((ab >> 20) & 1u);
    r = (ab >> 20) - 960u;
    r = r > 0x7Eu ? 0x7Eu : r;
  } else {
    r = (unsigned)__float2int_rn(ax * 512.0f);
  }
  return sign | r;
}
__device__ __forceinline__ void cvt_rows_e4m3(const float* src, unsigned char* dst, size_t n, float sc) {
  const int tid_ = opaque_tid();
  const size_t gt = (size_t)blockIdx.x * (NWAVES * 64) + tid_;
  const size_t nth = (size_t)gridDim.x * NWAVES * 64;
  for (size_t i = gt; i < n / 16; i += nth) {
    unsigned w[4];
#pragma unroll
    for (int k = 0; k < 4; k++) {
      const float4 a = ((const float4*)src)[4 * i + k];
      w[k] = enc_e4m3(a.x * sc) | (enc_e4m3(a.y * sc) << 8) | (enc_e4m3(a.z * sc) << 16) | (enc_e4m3(a.w * sc) << 24);
    }
    uint4 o; o.x = w[0]; o.y = w[1]; o.z = w[2]; o.w = w[3];
    ((uint4*)dst)[i] = o;
  }
}

#define GEMM_F32(Aptr, Wt, Cptr, Rptr, M_, N_) do { \
    pg8::Gemm g_{opq((const bf16*)(Aptr)), opq((const bf16*)(Wt)), (M_), (N_), DM}; pg8::StaticOrder S_; S_.init((M_), (N_), (int)gridDim.x, (int)blockIdx.x); \
    pg8::EpiF32R E_{opq((float*)(Cptr)), opq((const float*)(Rptr)), (N_)}; \
    pg8::gemm_phase<pg8::EpiF32R, pg8::StaticOrder, true, true>(ldsl, g_, S_, E_); } while (0)
#define GEMM_BF16(Aptr, Wt, Optr, M_, N_) do { \
    pg8::Gemm g_{opq((const bf16*)(Aptr)), opq((const bf16*)(Wt)), (M_), (N_), DM}; pg8::StaticOrder S_; S_.init((M_), (N_), (int)gridDim.x, (int)blockIdx.x); \
    pg8::EpiBf16 E_{opq((bf16*)(Optr)), (N_)}; \
    pg8::gemm_phase<pg8::EpiBf16, pg8::StaticOrder, true, true>(ldsl, g_, S_, E_); } while (0)

__global__ void __launch_bounds__(NWAVES * 64, 2) fwd_megakernel(Params p) {
  cg::grid_group grid = cg::this_grid();
  extern __shared__ __attribute__((aligned(16))) unsigned char lds[];
  LAS unsigned char* ldsl = (LAS unsigned char*)lds;
  LAS float* smem = (LAS float*)ldsl;
  unsigned char* ws = p.ws;
  volatile LAS unsigned* MISC = (volatile LAS unsigned*)(ldsl + 131072);
  if (threadIdx.x < 64) MISC[threadIdx.x] = 0u;
  __syncthreads();
  const XcdBarrier bar = xcd_barrier_post((unsigned*)(ws + WS_CTL) + 4096, MISC + 8);
  grid.sync();
  float* xw = (float*)(ws + WS_XW);
  bf16* xn = (bf16*)(ws + WS_XN);
  bf16* big = (bf16*)(ws + WS_BIG);
  bf16* y = (bf16*)(ws + WS_Y);
  bf16* memh = (bf16*)(ws + WS_MEMH);
  bf16* kvb = (bf16*)(ws + WS_KVB);
  bf16* vT = (bf16*)(ws + WS_VT);
  float* ssmE = (float*)(ws + WS_SSME);
  float* ssmp = (float*)(ws + WS_SSMP);
  int* ids = (int*)(ws + WS_IDS);
  float* gates = (float*)(ws + WS_GATE);
  bf16* skb = (bf16*)(ws + WS_SKB);
  unsigned char* ub = ws + WS_UB;
  unsigned char* vb = ws + WS_VB;

  prologue_transposes(p, ws, ldsl);
  cvt_rows_bf16(karg_in(27), skb, (size_t)2 * 8 * 2 * 128 * 128);
  cvt_rows_e4m3(karg_in(28), ub, (size_t)2 * 16384 * 1024, U_SCALE);
  cvt_rows_e4m3(karg_in(29), vb, (size_t)2 * 16384 * 1024, V_SCALE);
  for (int l = 0; l < 2; l++)
    rms_rows<true>(karg_in(1), karg_in(21) + l * DM, memh + (size_t)l * 1024 * 1024, 1024);
  ssm_params(p, ssmp);
  xcd_barrier(bar);
  for (int l = 0; l < 2; l++)
    GEMM_BF16(memh + (size_t)l * 1024 * 1024, ws + WS_WT + (size_t)l * WT_LAYER + WT_MKV,
              kvb + (size_t)l * 1024 * 2048, 1024, 2048);

#pragma nounroll
  for (int l = 0; l < 2; l++) {
    const float* xcur = (l == 0) ? karg_in(0) : xw;
    const float* sp = ssmp + (size_t)l * SSMP_PER_LAYER;
    const unsigned char* wl = ws + WS_WT + (size_t)l * WT_LAYER;
    rms_rows<true>(xcur, karg_in(2) + l * DM, xn, NT);
    xcd_barrier(bar);
    GEMM_BF16(xn, wl + WT_IN, big, NT, DIN);
    xcd_barrier(bar);
    if (l == 0) vt_phase(kvb, vT);
    ssm_chunk_end(sp, big, ssmE);
    attn_phase(p, l, big, y, smem);
    conv_phase(p, l, big, y, smem);
    xcd_barrier(bar);
    ssm_finish(p, l, sp, big, ssmE, y, smem);
    xcd_barrier(bar);
    GEMM_F32(y, wl + WT_OUT, xw, xcur, NT, DM);
    xcd_barrier(bar);
    rms_rows<true>(xw, karg_in(20) + l * DM, xn, NT);
    xcd_barrier(bar);
    GEMM_BF16(xn, wl + WT_MQ, big, NT, DM);
    xcd_barrier(bar);
    memattn_phase(big, kvb + (size_t)l * 1024 * 2048, vT + (size_t)l * 4 * 4 * 256 * 256, y);
    xcd_barrier(bar);
    GEMM_F32(y, wl + WT_MO, xw, (const float*)xw, NT, DM);
    xcd_barrier(bar);
    rms_rows<true>(xw, karg_in(25) + l * DM, xn, NT);
    xcd_barrier(bar);
    GEMM_BF16(xn, wl + WT_PQ, big, NT, 2048);
    xcd_barrier(bar);
    peer_topk(big, skb + (size_t)l * 8 * 2 * 128 * 128, ids, gates);
    xcd_barrier(bar);
    peer_gather(xn, ub + (size_t)l * 16384 * DM, vb + (size_t)l * 16384 * DM, ids, gates, xw);
    xcd_barrier(bar);
  }
  rms_rows<false>(xw, karg_in(30), p.out, NT);
}

extern "C" void kernel_launch(void* const* d_in, const int* in_sizes, int n_in,
                              void* d_out, int out_size, void* d_ws, size_t ws_size,
                              hipStream_t stream) {
  static int grid_blocks = 0;
  if (!grid_blocks) {
    int dev = 0, cus = 0, per_cu = 0;
    (void)hipGetDevice(&dev);
    (void)hipDeviceGetAttribute(&cus, hipDeviceAttributeMultiprocessorCount, dev);
    (void)hipFuncSetAttribute((const void*)fwd_megakernel, hipFuncAttributeMaxDynamicSharedMemorySize, LDS_BYTES);
    (void)hipOccupancyMaxActiveBlocksPerMultiprocessor(&per_cu, fwd_megakernel, NWAVES * 64, LDS_BYTES);
    if (per_cu < 1) fprintf(stderr, "occupancy query reports %d blocks/CU\n", per_cu);
    grid_blocks = cus;
  }
  (void)hipMemsetAsync((char*)d_ws + WS_CTL, 0, 1 * MiB, stream);
  Params p{};
  for (int i = 0; i < 31; i++) p.in[i] = (const float*)d_in[i];
  p.out = (float*)d_out;
  p.ws = (unsigned char*)d_ws;
  void* args[] = {&p};
  hipError_t e = hipLaunchCooperativeKernel((void*)fwd_megakernel, dim3(grid_blocks), dim3(NWAVES * 64),
                                            args, LDS_BYTES, stream);
  if (e != hipSuccess)
    fprintf(stderr, "cooperative launch failed: %s (grid %d)\n", hipGetErrorString(e), grid_blocks);
}
```

```cpp
#include <hip/hip_runtime.h>
#include <hip/hip_cooperative_groups.h>
#include <cstdio>
namespace cg = cooperative_groups;

#define NT 16384
#define SEQ 4096
#define DM 1024
#define DIN 2304
#define NMEM 256
#define EPSF 1e-6f
#define NWAVES 8
#define LDS_BYTES 147456

typedef unsigned short bf16;
#define LAS __attribute__((address_space(3)))

struct Params {
  const float* in[31];
  float* out;
  unsigned char* ws;
};
typedef __attribute__((address_space(4))) const unsigned char* kaptr_t;
__device__ __forceinline__ const float* karg_in(int i) {
  kaptr_t ka = (kaptr_t)__builtin_amdgcn_kernarg_segment_ptr();
  asm volatile("" : "+s"(ka));
  return *(const float* __attribute__((address_space(4))) const*)(ka + 8 * i);
}

constexpr size_t MiB = 1u << 20;
constexpr size_t WS_CTL  = 0;
constexpr size_t WS_WT   = 1 * MiB;
constexpr size_t WT_IN = 0, WT_OUT = WT_IN + (size_t)DIN * DM * 2, WT_MQ = WT_OUT + (size_t)DM * DM * 2,
                 WT_MKV = WT_MQ + (size_t)DM * DM * 2, WT_MO = WT_MKV + (size_t)2048 * DM * 2,
                 WT_PQ = WT_MO + (size_t)DM * DM * 2, WT_GLU = WT_PQ + (size_t)2048 * DM * 2, WT_LAYER = WT_GLU + (size_t)256 * 256 * 2;
constexpr size_t WS_XW   = WS_WT + 2 * WT_LAYER;
constexpr size_t WS_XN   = WS_XW + (size_t)NT * DM * 4;
constexpr size_t WS_BIG  = WS_XN + (size_t)NT * DM * 2;
constexpr size_t WS_Y    = WS_BIG + (size_t)NT * DIN * 2;
constexpr size_t WS_MEMH = WS_Y + (size_t)NT * DM * 2;
constexpr size_t WS_KVB  = WS_MEMH + (size_t)2 * 1024 * 1024 * 2;
constexpr size_t WS_VT   = WS_KVB + (size_t)2 * 1024 * 2048 * 2;
constexpr size_t WS_SSME = WS_VT + (size_t)2 * 4 * 4 * 256 * 256 * 2;
#define SSMP_PER_LAYER (2048 + 2048 + 32768)
constexpr size_t WS_SSMP = WS_SSME + (size_t)4 * 64 * 16 * 64 * 2 * 4;
constexpr size_t WS_IDS  = WS_SSMP + (size_t)2 * SSMP_PER_LAYER * 4;
constexpr size_t WS_GATE = WS_IDS + (size_t)NT * 128 * 4;
constexpr size_t WS_SKB  = WS_GATE + (size_t)NT * 128 * 4;
constexpr size_t WS_UB   = WS_SKB + (size_t)2 * 8 * 2 * 128 * 128 * 2;
constexpr size_t WS_VB   = WS_UB + (size_t)2 * 16384 * 1024;
constexpr size_t WS_RST  = WS_VB + (size_t)2 * 16384 * 1024;
constexpr size_t WS_END  = WS_RST + (size_t)NT * 16 * 4;
#define U_SCALE 64.0f
#define V_SCALE 8.0f
static_assert(WS_END <= 512 * MiB, "workspace");
static_assert(WT_LAYER % 256 == 0 && WS_SSMP % 16 == 0 && WS_IDS % 16 == 0 && WS_SKB % 256 == 0 && WS_VT % 256 == 0, "align");

__device__ __forceinline__ int opaque_tid(int wave_s) { int v = wave_s * 64 + (int)__builtin_amdgcn_mbcnt_hi(~0u, __builtin_amdgcn_mbcnt_lo(~0u, 0u)); asm volatile("" : "+v"(v)); return v; }
__device__ __forceinline__ unsigned f2bf(float f) { unsigned u = __builtin_bit_cast(unsigned, f); return (u + 0x7fffu + ((u >> 16) & 1u)) >> 16; }
__device__ __forceinline__ unsigned pk2(float lo, float hi) { return f2bf(lo) | (f2bf(hi) << 16); }
__device__ __forceinline__ float bf_lo(unsigned u) { return __builtin_bit_cast(float, u << 16); }
__device__ __forceinline__ float bf_hi(unsigned u) { return __builtin_bit_cast(float, u & 0xffff0000u); }
__device__ __forceinline__ float bf2f(bf16 h) { return __builtin_bit_cast(float, (unsigned)h << 16); }


#define XB_TMO      128
#define XB_XCNT(j)  (256  + 64 * (j))
#define XB_XSUB(j)  (1280 + 64 * (j))
#define XB_XGEN(j)  (2304 + 64 * (j))
#define XB_TOP      3328
#define XB_TOPGEN   3392
#define XCD_BAR_WORDS 3456
#define XB_SPIN_CAP (1u << 22)
__device__ __forceinline__ unsigned xb_ld(unsigned* p)              { return __hip_atomic_load(p, __ATOMIC_RELAXED, __HIP_MEMORY_SCOPE_AGENT); }
__device__ __forceinline__ unsigned xb_add(unsigned* p, unsigned v) { return __hip_atomic_fetch_add(p, v, __ATOMIC_RELAXED, __HIP_MEMORY_SCOPE_AGENT); }
__device__ __forceinline__ unsigned xb_xcc_id() { return (unsigned)__builtin_amdgcn_s_getreg((3 << 11) | 20) & 0xFu; }
#define XB_SPIN(cond, bar) do { unsigned _sp = 0; while (cond) { __builtin_amdgcn_s_sleep(1); \
    if ((++_sp & 255u) == 0u) { if (xb_ld(&(bar)[XB_TMO])) break; if (_sp > XB_SPIN_CAP) { atomicAdd(&(bar)[XB_TMO], 1u); break; } } } } while (0)
struct XcdBarrier { unsigned* bar; unsigned x; volatile LAS unsigned* st; };
__device__ __forceinline__ XcdBarrier xcd_barrier_post(unsigned* bar, volatile LAS unsigned* st) {
    XcdBarrier b; b.bar = bar; b.x = xb_xcc_id(); b.st = st;
    if (threadIdx.x == 0) (void)xb_add(&bar[XB_XCNT(b.x)], 1u);
    return b;
}
__device__ __forceinline__ void xcd_barrier_complete(unsigned* bar, unsigned x, unsigned& nloc, unsigned& nx) {
    const unsigned G = gridDim.x * gridDim.y * gridDim.z;
    unsigned sum, cnt, mine, sp = 0u;
    for (;;) {
        sum = 0u; cnt = 0u; mine = 0u;
#pragma unroll
        for (unsigned j = 0; j < 16; ++j) { const unsigned c = xb_ld(&bar[XB_XCNT(j)]); sum += c; cnt += (c > 0u) ? 1u : 0u; mine = (j == x) ? c : mine; }
        if (sum == G) break;
        __builtin_amdgcn_s_sleep(1);
        if ((++sp & 255u) == 0u) { if (xb_ld(&bar[XB_TMO])) break; if (sp > XB_SPIN_CAP) { atomicAdd(&bar[XB_TMO], 1u); break; } }
    }
    nloc = mine > 0u ? mine : 1u; nx = cnt > 0u ? cnt : 1u;
}
__device__ __forceinline__ void xcd_barrier(const XcdBarrier& b) {
    asm volatile("s_waitcnt vmcnt(0)" ::: "memory");
    __syncthreads();
    if (threadIdx.x == 0) {
        unsigned* bar = b.bar;
        __builtin_amdgcn_s_waitcnt(0);
        unsigned nloc = b.st[0], nx = b.st[1];
        if (nloc == 0u) { xcd_barrier_complete(bar, b.x, nloc, nx); b.st[0] = nloc; b.st[1] = nx; }
        const unsigned old = xb_add(&bar[XB_XSUB(b.x)], 1u);
        const unsigned gen = old / nloc;
        if (old + 1u == (gen + 1u) * nloc) {
            __builtin_amdgcn_fence(__ATOMIC_RELEASE, "agent");
            asm volatile("s_waitcnt vmcnt(0)" ::: "memory");
            const unsigned og = xb_add(&bar[XB_TOP], 1u);
            const unsigned tg = og / nx;
            if (og + 1u == (tg + 1u) * nx) xb_add(&bar[XB_TOPGEN], 1u);
            else XB_SPIN(xb_ld(&bar[XB_TOPGEN]) == tg, bar);
            __builtin_amdgcn_fence(__ATOMIC_ACQUIRE, "agent");
            xb_add(&bar[XB_XGEN(b.x)], 1u);
            asm volatile("s_waitcnt vmcnt(0)" ::: "memory");
        } else {
            XB_SPIN(xb_ld(&bar[XB_XGEN(b.x)]) == gen, bar);
            __builtin_amdgcn_fence(__ATOMIC_ACQUIRE, "agent");
            asm volatile("s_waitcnt vmcnt(0)" ::: "memory");
        }
    }
    __syncthreads();
}

namespace pg8 {
#define PG8_LAS __attribute__((address_space(3)))
typedef unsigned short bf16_t;
typedef short bf16x8 __attribute__((ext_vector_type(8)));
typedef float f32x4 __attribute__((ext_vector_type(4)));
typedef unsigned u32x4 __attribute__((ext_vector_type(4)));
constexpr int BM = 256, BK = 64, HALF = 128, HTB = HALF * BK * 2, STAGE_BYTES = 8 * HTB, NXCD = 8, WGM = 8;
__host__ __device__ __forceinline__ int lds_byte(int r, int c) { const int st = (r >> 4) * 2 + (c >> 5), rr = r & 15, cc = c & 31, ob = rr * 64 + cc * 2; return st * 1024 + (ob ^ (((ob >> 9) & 1) << 5)); }
__host__ __device__ __forceinline__ void stage_rc(int b, int& R, int& C) { const int st = b / 1024, sb = b % 1024, swz = sb ^ (((sb >> 9) & 1) << 5); R = (st >> 1) * 16 + swz / 64; C = (st & 1) * 32 + (swz % 64) / 2; }
__host__ __device__ __forceinline__ int perm32(int rho) { const int n = rho >> 4, i = rho & 15; return 8 * (i >> 2) + 4 * n + (i & 3); }
struct Unit { int pm, pn; };
struct Gemm { const bf16_t* A; const bf16_t* Bt; int M, N, K; };
struct StaticOrder {
    int nM, nN, nwg, G, c;
    __host__ __device__ __forceinline__ void init(int M, int N, int G_, int c_) { nM = M / BM; nN = N / BM; nwg = nM * nN; G = G_; c = c_; }
    __host__ __device__ bool next(int i, Unit& u) const {
        const long L = (long)i * G + c; if (L >= nwg) return false;
        int wgid = (int)L; { const int q = nwg / NXCD, r = nwg % NXCD, xcd = wgid % NXCD, off = wgid / NXCD; wgid = (xcd < r ? xcd * (q + 1) : r * (q + 1) + (xcd - r) * q) + off; }
        const int nig = WGM * nN, gid = wgid / nig, fm = gid * WGM, gsz = (nM - fm) < WGM ? (nM - fm) : WGM;
        u.pm = fm + ((wgid % nig) % gsz); u.pn = (wgid % nig) / gsz; return true;
    }
    __device__ __forceinline__ void a_ready(const Unit&) const {}
    __device__ __forceinline__ void done(const Unit&) const {}
};
__device__ __forceinline__ unsigned cvt_pk_bf16(float lo, float hi) { unsigned r; asm volatile("v_cvt_pk_bf16_f32 %0, %1, %2" : "=v"(r) : "v"(lo), "v"(hi)); return r; }

struct EpiF32R {
    static constexpr bool PERM = false, AFTER_DRAIN = false;
    float* C; const float* R; int ldc;
    __device__ __forceinline__ void operator()(const f32x4 (&acc)[2][2][4][2], const Unit& u, int wr, int wc, int fr, int fq) const {
        const int row0 = u.pm * BM + wr * 64 + fr, col0 = u.pn * BM + wc * 32 + 4 * fq;
#pragma unroll
        for (int ai = 0; ai < 2; ++ai)
#pragma unroll
            for (int m = 0; m < 4; ++m) {
                const size_t ro = (size_t)(row0 + ai * HALF + m * 16) * ldc + col0;
                f32x4 rv[2][2];
#pragma unroll
                for (int bj = 0; bj < 2; ++bj)
#pragma unroll
                    for (int n = 0; n < 2; ++n) rv[bj][n] = R ? *(const f32x4*)(R + ro + bj * HALF + n * 16) : (f32x4){0.f, 0.f, 0.f, 0.f};
#pragma unroll
                for (int bj = 0; bj < 2; ++bj)
#pragma unroll
                    for (int n = 0; n < 2; ++n) *(f32x4*)(C + ro + bj * HALF + n * 16) = acc[ai][bj][m][n] + rv[bj][n];
                __builtin_amdgcn_sched_barrier(0);
            }
    }
};

struct EpiBf16 {
    static constexpr bool PERM = true, AFTER_DRAIN = false;
    bf16_t* O; int ldc;
    __device__ __forceinline__ void operator()(const f32x4 (&acc)[2][2][4][2], const Unit& u, int wr, int wc, int fr, int fq) const {
        const int row0 = u.pm * BM + wr * 64 + fr, col0 = u.pn * BM + wc * 32 + 8 * fq;
#pragma unroll
        for (int ai = 0; ai < 2; ++ai)
#pragma unroll
            for (int m = 0; m < 4; ++m) { bf16_t* rowp = O + (size_t)(row0 + ai * HALF + m * 16) * ldc + col0;
#pragma unroll
                for (int bj = 0; bj < 2; ++bj) { const f32x4 v0 = acc[ai][bj][m][0], v1 = acc[ai][bj][m][1];
                    u32x4 w; w.x = cvt_pk_bf16(v0[0], v0[1]); w.y = cvt_pk_bf16(v0[2], v0[3]); w.z = cvt_pk_bf16(v1[0], v1[1]); w.w = cvt_pk_bf16(v1[2], v1[3]);
                    *(u32x4*)(rowp + bj * HALF) = w; } }
    }
};

struct EpiF32RN {
    static constexpr bool PERM = false, AFTER_DRAIN = false;
    float* C; const float* R; int ldc; bf16_t* XG; const float* g; float* st;
    __device__ __forceinline__ void operator()(const f32x4 (&acc)[2][2][4][2], const Unit& u, int wr, int wc, int fr, int fq) const {
        const int row0 = u.pm * BM + wr * 64 + fr, col0 = u.pn * BM + wc * 32 + 4 * fq;
        f32x4 gv[2][2];
#pragma unroll
        for (int bj = 0; bj < 2; ++bj)
#pragma unroll
            for (int n = 0; n < 2; ++n) gv[bj][n] = *(const f32x4*)(g + col0 + bj * HALF + n * 16);
#pragma unroll
        for (int ai = 0; ai < 2; ++ai)
#pragma unroll
            for (int m = 0; m < 4; ++m) {
                const int row = row0 + ai * HALF + m * 16;
                const size_t ro = (size_t)row * ldc + col0;
                f32x4 rv[2][2];
#pragma unroll
                for (int bj = 0; bj < 2; ++bj)
#pragma unroll
                    for (int n = 0; n < 2; ++n) rv[bj][n] = *(const f32x4*)(R + ro + bj * HALF + n * 16);
                float ss = 0.f;
#pragma unroll
                for (int bj = 0; bj < 2; ++bj)
#pragma unroll
                    for (int n = 0; n < 2; ++n) {
                        const f32x4 v = acc[ai][bj][m][n] + rv[bj][n];
                        *(f32x4*)(C + ro + bj * HALF + n * 16) = v;
                        ss += (v[0] * v[0] + v[1] * v[1]) + (v[2] * v[2] + v[3] * v[3]);
                        const f32x4 w = v * gv[bj][n];
                        uint2 pk; pk.x = cvt_pk_bf16(w[0], w[1]); pk.y = cvt_pk_bf16(w[2], w[3]);
                        *(uint2*)(XG + ro + bj * HALF + n * 16) = pk;
                    }
                ss += __shfl_xor(ss, 16, 64); ss += __shfl_xor(ss, 32, 64);
                if (fq == 0) st[(size_t)row * 16 + u.pn * 4 + wc] = ss;
                __builtin_amdgcn_sched_barrier(0);
            }
    }
};
struct EpiBf16S {
    static constexpr bool PERM = true, AFTER_DRAIN = false;
    bf16_t* O; int ldc; const float* st;
    __device__ __forceinline__ void operator()(const f32x4 (&acc)[2][2][4][2], const Unit& u, int wr, int wc, int fr, int fq) const {
        const int row0 = u.pm * BM + wr * 64 + fr, col0 = u.pn * BM + wc * 32 + 8 * fq;
#pragma unroll
        for (int ai = 0; ai < 2; ++ai)
#pragma unroll
            for (int m = 0; m < 4; ++m) {
                const int row = row0 + ai * HALF + m * 16;
                const f32x4* sp = (const f32x4*)(st + (size_t)row * 16);
                const f32x4 s0 = sp[0], s1 = sp[1], s2 = sp[2], s3 = sp[3];
                const f32x4 sa = (s0 + s1) + (s2 + s3);
                const float rs = __builtin_amdgcn_rsqf(((sa[0] + sa[1]) + (sa[2] + sa[3])) * (1.0f / 1024.f) + 1e-6f);
                bf16_t* rowp = O + (size_t)row * ldc + col0;
#pragma unroll
                for (int bj = 0; bj < 2; ++bj) { const f32x4 v0 = acc[ai][bj][m][0] * rs, v1 = acc[ai][bj][m][1] * rs;
                    u32x4 w; w.x = cvt_pk_bf16(v0[0], v0[1]); w.y = cvt_pk_bf16(v0[2], v0[3]); w.z = cvt_pk_bf16(v1[0], v1[1]); w.w = cvt_pk_bf16(v1[2], v1[3]);
                    *(u32x4*)(rowp + bj * HALF) = w; }
                __builtin_amdgcn_sched_barrier(0);
            }
    }
};

template <class Epi, class Sched, bool ALIGN_EPI = false, bool SP2 = false>
__device__ __forceinline__ void gemm_phase(const int wave_s, PG8_LAS unsigned char* lds, const Gemm g, const Sched& S, const Epi& E) {
    const int tid = opaque_tid(wave_s), wid = __builtin_amdgcn_readfirstlane(tid >> 6), lane = tid & 63, wr = wid >> 2, wc = wid & 3, fr = lane & 15, fq = lane >> 4;
    const int K = g.K, nt = K / BK;
    unsigned voffA[2], voffB[2];
#pragma unroll
    for (int i = 0; i < 2; ++i) { int R, C; stage_rc(tid * 16 + i * 8192, R, C); const int Rb = Epi::PERM ? ((R & ~31) + perm32(R & 31)) : R;
        voffA[i] = (unsigned)(R * K + C) * 2u; voffB[i] = (unsigned)(Rb * K + C) * 2u; }
    const size_t kstep = (size_t)(BK * 2);
    const size_t hstep = (size_t)HALF * K * 2;
    const size_t tstep = 2 * hstep;
    const unsigned ldsw = (unsigned)wid * 1024u;
    const int aoff = lds_byte(wr * 64 + fr, fq * 8), boff = lds_byte(wc * 32 + fr, fq * 8);
#define PG8_SA(b, h) (((b) * 2 + (h)) * HTB)
#define PG8_SB(b, h) ((4 + (b) * 2 + (h)) * HTB)
#define PG8_STAGE(bufoff, gbase, voff) do { _Pragma("unroll") for (int _i = 0; _i < 2; ++_i) \
        __builtin_amdgcn_global_load_lds((const unsigned*)((const char*)(gbase) + (voff)[_i]), (PG8_LAS unsigned*)(lds + (bufoff) + ldsw + _i * 8192), 16, 0, 0); } while (0)
#define PG8_LDA(dst, b, h) do { _Pragma("unroll") for (int m = 0; m < 4; ++m) _Pragma("unroll") for (int k = 0; k < 2; ++k) dst[m][k] = *(const PG8_LAS bf16x8*)(lds + PG8_SA(b, h) + aoff + m * 2048 + k * 1024); } while (0)
#define PG8_LDB(dst, b, h) do { _Pragma("unroll") for (int n = 0; n < 2; ++n) _Pragma("unroll") for (int k = 0; k < 2; ++k) dst[n][k] = *(const PG8_LAS bf16x8*)(lds + PG8_SB(b, h) + boff + n * 2048 + k * 1024); } while (0)
#define PG8_MMA(ai, bj, At, Bt) do { __builtin_amdgcn_s_setprio(1); _Pragma("unroll") for (int m = 0; m < 4; ++m) _Pragma("unroll") for (int n = 0; n < 2; ++n) _Pragma("unroll") for (int k = 0; k < 2; ++k) \
        acc[ai][bj][m][n] = __builtin_amdgcn_mfma_f32_16x16x32_bf16(Bt[n][k], At[m][k], acc[ai][bj][m][n], 0, 0, 0); __builtin_amdgcn_s_setprio(0); } while (0)
#define PG8_WAIT_V(n) asm volatile("s_waitcnt vmcnt(" #n ")" ::: "memory")
#define PG8_WAIT_L(n) asm volatile("s_waitcnt lgkmcnt(" #n ")" ::: "memory")
#define PG8_BAR __builtin_amdgcn_s_barrier()
#define PG8_SCHED __builtin_amdgcn_sched_barrier(0)
    Unit cur, nxt; int ui = 0;
    if (!S.next(0, cur)) return;
    f32x4 acc[2][2][4][2];
#pragma unroll
    for (int a = 0; a < 2; ++a)
#pragma unroll
        for (int b = 0; b < 2; ++b)
#pragma unroll
            for (int m = 0; m < 4; ++m)
#pragma unroll
                for (int n = 0; n < 2; ++n) acc[a][b][m][n] = (f32x4){0.f, 0.f, 0.f, 0.f};
    bf16x8 At[4][2], B0[2][2], B1[2][2];
    const char* cA = (const char*)g.A + (size_t)cur.pm * tstep; const char* cB = (const char*)g.Bt + (size_t)cur.pn * tstep;
    S.a_ready(cur);
    if constexpr (SP2) {
        PG8_STAGE(PG8_SB(0, 0), cB, voffB); PG8_STAGE(PG8_SB(0, 1), cB + hstep, voffB); PG8_STAGE(PG8_SA(0, 0), cA, voffA); PG8_STAGE(PG8_SA(0, 1), cA + hstep, voffA);
        if (wr == 1) PG8_BAR;
        PG8_WAIT_V(2); PG8_BAR;
        PG8_STAGE(PG8_SB(1, 0), cB + kstep, voffB); PG8_STAGE(PG8_SA(1, 0), cA + kstep, voffA); PG8_STAGE(PG8_SB(1, 1), cB + hstep + kstep, voffB);
        PG8_WAIT_V(6); PG8_BAR;
    } else {
        PG8_STAGE(PG8_SB(0, 0), cB, voffB); PG8_STAGE(PG8_SA(0, 0), cA, voffA); PG8_STAGE(PG8_SB(0, 1), cB + hstep, voffB); PG8_STAGE(PG8_SA(0, 1), cA + hstep, voffA);
        if (wr == 1) PG8_BAR;
        PG8_WAIT_V(4); PG8_BAR;
        PG8_STAGE(PG8_SB(1, 0), cB + kstep, voffB); PG8_STAGE(PG8_SA(1, 0), cA + kstep, voffA); PG8_STAGE(PG8_SB(1, 1), cB + hstep + kstep, voffB);
        PG8_WAIT_V(6); PG8_BAR;
    }
    for (;;) {
        const bool has_next = S.next(ui + 1, nxt);
        const char* nA = has_next ? (const char*)g.A + (size_t)nxt.pm * tstep : cA; const char* nB = has_next ? (const char*)g.Bt + (size_t)nxt.pn * tstep : cB;
        for (int t = 0; t < nt; t += 2) {
            const bool last = (t == nt - 2);
            const char* a1 = cA + (size_t)(t + 1) * kstep;
            const char* a2 = last ? nA : cA + (size_t)(t + 2) * kstep; const char* b2 = last ? nB : cB + (size_t)(t + 2) * kstep;
            const char* a3 = a2 + kstep; const char* b3 = b2 + kstep;
            if (last && has_next) S.a_ready(nxt);
            if constexpr (SP2) {
            PG8_LDB(B0, 0, 0); PG8_LDB(B1, 0, 1); PG8_SCHED; PG8_LDA(At, 0, 0); PG8_STAGE(PG8_SA(1, 1), a1 + hstep, voffA);
            PG8_WAIT_V(8); PG8_WAIT_L(0); PG8_BAR; PG8_MMA(0, 0, At, B0); PG8_MMA(0, 1, At, B1); PG8_BAR; PG8_SCHED;
            PG8_LDA(At, 0, 1); PG8_STAGE(PG8_SB(0, 0), b2, voffB); PG8_STAGE(PG8_SB(0, 1), b2 + hstep, voffB); PG8_STAGE(PG8_SA(0, 0), a2, voffA);
            PG8_WAIT_V(8); PG8_WAIT_L(0); PG8_BAR; PG8_MMA(1, 0, At, B0); PG8_MMA(1, 1, At, B1); PG8_BAR; PG8_SCHED;
            PG8_LDB(B0, 1, 0); PG8_LDB(B1, 1, 1); PG8_SCHED; PG8_LDA(At, 1, 0); PG8_STAGE(PG8_SA(0, 1), a2 + hstep, voffA);
            PG8_WAIT_V(8); PG8_WAIT_L(0); PG8_BAR; PG8_MMA(0, 0, At, B0); PG8_MMA(0, 1, At, B1); PG8_BAR; PG8_SCHED;
            PG8_LDA(At, 1, 1); PG8_STAGE(PG8_SB(1, 0), b3, voffB); PG8_STAGE(PG8_SB(1, 1), b3 + hstep, voffB); PG8_STAGE(PG8_SA(1, 0), a3, voffA);
            PG8_WAIT_V(8); PG8_WAIT_L(0); PG8_BAR; PG8_MMA(1, 0, At, B0); PG8_MMA(1, 1, At, B1); PG8_BAR; PG8_SCHED;
            } else {
            PG8_LDB(B0, 0, 0); PG8_SCHED; PG8_LDA(At, 0, 0); PG8_STAGE(PG8_SA(1, 1), a1 + hstep, voffA);
            PG8_WAIT_L(8); PG8_BAR; PG8_WAIT_L(0); PG8_MMA(0, 0, At, B0); PG8_BAR; PG8_SCHED;
            PG8_LDB(B1, 0, 1); PG8_STAGE(PG8_SB(0, 0), b2, voffB);
            PG8_BAR; PG8_WAIT_L(0); PG8_MMA(0, 1, At, B1); PG8_BAR;
            PG8_LDA(At, 0, 1); PG8_STAGE(PG8_SA(0, 0), a2, voffA);
            PG8_BAR; PG8_WAIT_L(0); PG8_MMA(1, 0, At, B0); PG8_BAR; PG8_SCHED;
            PG8_STAGE(PG8_SB(0, 1), b2 + hstep, voffB);
            PG8_WAIT_V(6); PG8_BAR; PG8_MMA(1, 1, At, B1); PG8_BAR;
            PG8_LDB(B0, 1, 0); PG8_SCHED; PG8_LDA(At, 1, 0); PG8_STAGE(PG8_SA(0, 1), a2 + hstep, voffA);
            PG8_WAIT_L(8); PG8_BAR; PG8_WAIT_L(0); PG8_MMA(0, 0, At, B0); PG8_BAR; PG8_SCHED;
            PG8_LDB(B1, 1, 1); PG8_STAGE(PG8_SB(1, 0), b3, voffB);
            PG8_BAR; PG8_WAIT_L(0); PG8_MMA(0, 1, At, B1); PG8_BAR;
            PG8_LDA(At, 1, 1); PG8_STAGE(PG8_SA(1, 0), a3, voffA);
            PG8_BAR; PG8_WAIT_L(0); PG8_MMA(1, 0, At, B0); PG8_BAR; PG8_SCHED;
            PG8_STAGE(PG8_SB(1, 1), b3 + hstep, voffB);
            PG8_WAIT_V(6); PG8_BAR; PG8_MMA(1, 1, At, B1); PG8_BAR;
            }
        }
        if constexpr (ALIGN_EPI) { if (wr == 0) PG8_BAR; }
        if constexpr (!Epi::AFTER_DRAIN) { E(acc, cur, wr, wc, fr, fq); S.done(cur); }
        if (!has_next) break;
#pragma unroll
        for (int a = 0; a < 2; ++a)
#pragma unroll
            for (int b = 0; b < 2; ++b)
#pragma unroll
                for (int m = 0; m < 4; ++m)
#pragma unroll
                    for (int n = 0; n < 2; ++n) acc[a][b][m][n] = (f32x4){0.f, 0.f, 0.f, 0.f};
        cur = nxt; cA = nA; cB = nB; ++ui;
        if constexpr (ALIGN_EPI) { if (wr == 1) PG8_BAR; }
    }
    PG8_WAIT_V(0);
    if constexpr (!ALIGN_EPI) { if (wr == 0) PG8_BAR; }
    PG8_BAR;
#undef PG8_SA
#undef PG8_SB
#undef PG8_STAGE
#undef PG8_LDA
#undef PG8_LDB
#undef PG8_MMA
#undef PG8_WAIT_V
#undef PG8_WAIT_L
#undef PG8_BAR
#undef PG8_SCHED
}
}

__device__ __forceinline__ void transpose_item(const float* W, int K, int N, bf16* WT, LAS float* scr, int item, int lane) {
    const int nblk = N / 32, kb = item / nblk, nb = item % nblk, k0 = 64 * kb, n0 = 32 * nb;
#pragma unroll 8
    for (int i = 0; i < 32; ++i) { const int kk = 2 * i + (lane >> 5); scr[kk * 33 + (lane & 31)] = W[(size_t)(k0 + kk) * N + n0 + (lane & 31)]; }
    asm volatile("s_waitcnt lgkmcnt(0)" ::: "memory");
    const int c = lane & 7;
#pragma unroll
    for (int j = 0; j < 4; ++j) { const int n = (lane >> 3) + 8 * j; const LAS float* s = scr + (8 * c) * 33 + n;
        uint4 o; o.x = pk2(s[0 * 33], s[1 * 33]); o.y = pk2(s[2 * 33], s[3 * 33]); o.z = pk2(s[4 * 33], s[5 * 33]); o.w = pk2(s[6 * 33], s[7 * 33]);
        *(uint4*)(WT + (size_t)(n0 + n) * K + k0 + 8 * c) = o; }
    asm volatile("s_waitcnt lgkmcnt(0)" ::: "memory");
}

__device__ __forceinline__ float wsum(float v) {
#pragma unroll
  for (int o = 32; o > 0; o >>= 1) v += __shfl_xor(v, o, 64);
  return v;
}
__device__ __forceinline__ float wmaxf(float v) {
#pragma unroll
  for (int o = 32; o > 0; o >>= 1) v = fmaxf(v, __shfl_xor(v, o, 64));
  return v;
}
__device__ __forceinline__ float sigmoidf_(float x) { return 1.0f / (1.0f + expf(-x)); }
__device__ __forceinline__ float gelu_tanh(float x) {
  return 0.5f * x * (1.0f + tanhf(0.7978845608028654f * (x + 0.044715f * x * x * x)));
}

template <bool BF16OUT>
__device__ __forceinline__ void rms_rows(const int wave_s, const float* src, const float* g, void* dstv, int rows) {
  const int tid_ = opaque_tid(wave_s);
  const int lane = tid_ & 63;
  const int gw = blockIdx.x * NWAVES + (tid_ >> 6);
  const int nw = gridDim.x * NWAVES;
  for (int r = gw; r < rows; r += nw) {
    const float4* s4 = (const float4*)(src + (size_t)r * DM);
    float4 v[4];
    float ss = 0.f;
#pragma unroll
    for (int i = 0; i < 4; i++) {
      v[i] = s4[lane + i * 64];
      ss += v[i].x * v[i].x + v[i].y * v[i].y + v[i].z * v[i].z + v[i].w * v[i].w;
    }
    ss = wsum(ss);
    const float rstd = rsqrtf(ss * (1.0f / DM) + EPSF);
    const float4* g4 = (const float4*)g;
#pragma unroll
    for (int i = 0; i < 4; i++) {
      float4 gg = g4[lane + i * 64];
      float4 o;
      o.x = v[i].x * rstd * gg.x; o.y = v[i].y * rstd * gg.y;
      o.z = v[i].z * rstd * gg.z; o.w = v[i].w * rstd * gg.w;
      if (BF16OUT) {
        uint2 pk; pk.x = pk2(o.x, o.y); pk.y = pk2(o.z, o.w);
        ((uint2*)((bf16*)dstv + (size_t)r * DM))[lane + i * 64] = pk;
      } else {
        ((float4*)((float*)dstv + (size_t)r * DM))[lane + i * 64] = o;
      }
    }
  }
}

__device__ __forceinline__ void ssm_params(const int wave_s, const Params& p, float* ssmp_all) {
  const int tid_ = opaque_tid(wave_s);
  const float* in8 = karg_in(8); const float* in9 = karg_in(9); const float* in10 = karg_in(10);
  const float* in11 = karg_in(11); const float* in12 = karg_in(12);
  const int gt = blockIdx.x * blockDim.x + tid_;
  const int nth = gridDim.x * blockDim.x;
  for (int i = gt; i < 2 * 16 * 64; i += nth) {
    const int l = i / 1024, gp = i % 1024, g = gp / 64;
    float* sp = ssmp_all + (size_t)l * SSMP_PER_LAYER;
    const float lre = fminf(in8[l * 1024 + gp], -1e-4f);
    const float lim = in9[l * 1024 + gp];
    const float dt = expf(in10[l * 16 + g]);
    const float er = expf(lre * dt);
    float sn, cs;
    sincosf(lim * dt, &sn, &cs);
    const float br = er * cs, bi = er * sn;
    sp[gp * 2 + 0] = br;
    sp[gp * 2 + 1] = bi;
    float cr = br, ci = bi;
#pragma unroll
    for (int s = 0; s < 6; s++) {
      const float nr = cr * cr - ci * ci, ni = 2.f * cr * ci;
      cr = nr; ci = ni;
    }
    sp[2048 + gp * 2 + 0] = cr;
    sp[2048 + gp * 2 + 1] = ci;
    const float nr = br - 1.0f, ni = bi;
    const float den = lre * lre + lim * lim;
    const float fr = (nr * lre + ni * lim) / den;
    const float fi = (ni * lre - nr * lim) / den;
    for (int h = 0; h < 16; h++) {
      const float bre = in11[((size_t)l * 1024 + gp) * 16 + h];
      const float bim = in12[((size_t)l * 1024 + gp) * 16 + h];
      sp[4096 + ((g * 16 + h) * 64 + (gp & 63)) * 2 + 0] = fr * bre - fi * bim;
      sp[4096 + ((g * 16 + h) * 64 + (gp & 63)) * 2 + 1] = fr * bim + fi * bre;
    }
  }
}

__device__ __forceinline__ void conv_phase(const int wave_s, const Params& p, int l, const bf16* proj, bf16* y, LAS float* smem) {
  const int tid_ = opaque_tid(wave_s);
  const int lane = tid_ & 63;
  const int gw = blockIdx.x * NWAVES + (tid_ >> 6);
  const int nw = gridDim.x * NWAVES;
  const float* cw = karg_in(4) + (size_t)l * 31 * 256;
  const float4 cb = ((const float4*)(karg_in(5) + l * 256))[lane];
  const float4 lg = ((const float4*)(karg_in(6) + l * 256))[lane];
  const float4 lb = ((const float4*)(karg_in(7) + l * 256))[lane];
  const float4 gg = ((const float4*)(karg_in(18) + l * 1024))[lane];
  LAS float* cwl = smem + 1024;
  for (int i = tid_; i < 31 * 256 / 4; i += NWAVES * 64) *(LAS pg8::f32x4*)(cwl + 4 * i) = *(const pg8::f32x4*)(cw + 4 * i);
  __syncthreads();
  for (int it = gw; it < NT / 8; it += nw) {
    const int tok0 = it * 8;
    const int t0 = tok0 & (SEQ - 1);
    float4 acc[8];
#pragma unroll
    for (int o = 0; o < 8; o++) acc[o] = cb;
#pragma unroll
    for (int i = 0; i < 38; i++) {
      if (t0 - 30 + i >= 0) {
        const bf16* row = proj + (size_t)(tok0 - 30 + i) * DIN;
        const uint2 vp = ((const uint2*)row)[lane];
        const uint2 gp = ((const uint2*)(row + 256))[lane];
        float4 g4;
        g4.x = bf_lo(vp.x) * sigmoidf_(bf_lo(gp.x)); g4.y = bf_hi(vp.x) * sigmoidf_(bf_hi(gp.x));
        g4.z = bf_lo(vp.y) * sigmoidf_(bf_lo(gp.y)); g4.w = bf_hi(vp.y) * sigmoidf_(bf_hi(gp.y));
#pragma unroll
        for (int o = 0; o < 8; o++) {
          const int j = i - o;
          if (j >= 0 && j <= 30) {
            const pg8::f32x4 w4 = *(const LAS pg8::f32x4*)(cwl + j * 256 + lane * 4);
            acc[o].x += g4.x * w4[0]; acc[o].y += g4.y * w4[1];
            acc[o].z += g4.z * w4[2]; acc[o].w += g4.w * w4[3];
          }
        }
      }
    }
#pragma unroll
    for (int o = 0; o < 8; o++) {
      const float4 a = acc[o];
      const float mean = wsum(a.x + a.y + a.z + a.w) * (1.0f / 256.f);
      const float dx = a.x - mean, dy = a.y - mean, dz = a.z - mean, dw = a.w - mean;
      const float var = wsum(dx * dx + dy * dy + dz * dz + dw * dw) * (1.0f / 256.f);
      const float rs = rsqrtf(var + EPSF);
      float4 s;
      s.x = dx * rs * lg.x + lb.x; s.y = dy * rs * lg.y + lb.y;
      s.z = dz * rs * lg.z + lb.z; s.w = dw * rs * lg.w + lb.w;
      s.x = s.x * sigmoidf_(s.x); s.y = s.y * sigmoidf_(s.y);
      s.z = s.z * sigmoidf_(s.z); s.w = s.w * sigmoidf_(s.w);
      const float ss = wsum(s.x * s.x + s.y * s.y + s.z * s.z + s.w * s.w) * (1.0f / 256.f);
      const float r2 = rsqrtf(ss + EPSF);
      uint2 pk; pk.x = pk2(s.x * r2 * gg.x, s.y * r2 * gg.y); pk.y = pk2(s.z * r2 * gg.z, s.w * r2 * gg.w);
      ((uint2*)(y + (size_t)(tok0 + o) * DM))[lane] = pk;
    }
  }
}

typedef short bf16x8_t __attribute__((ext_vector_type(8)));
typedef float f32x16_t __attribute__((ext_vector_type(16)));
#define MFMA_PAD() do { __builtin_amdgcn_sched_barrier(0); asm volatile("s_nop 15\n\ts_nop 15" ::: "memory"); __builtin_amdgcn_sched_barrier(0); } while (0)

__device__ __forceinline__ void attn_phase(const int wave_s, const Params& p, int l, const bf16* proj, bf16* y, LAS float* smem) {
  const int tid = opaque_tid(wave_s), lane = tid & 63, wave = tid >> 6;
  const int n = lane & 31, hh = lane >> 5;
  const float* gg = karg_in(18) + l * 1024 + 256 + wave * 64;
  const float g0 = gg[n], g1 = gg[32 + n];
  LAS float* ssq = smem;
  LAS float* rstd = smem + 256;
  for (int item = blockIdx.x; item < 4 * 128; item += gridDim.x) {
    const int b = item >> 7, q0 = (item & 127) * 32;
    const size_t tokb = (size_t)b * SEQ;
    bf16x8_t qf[4];
    {
      const bf16* qrow = proj + (tokb + q0 + n) * DIN + 512 + wave * 64 + 8 * hh;
#pragma unroll
      for (int ks = 0; ks < 4; ks++) qf[ks] = *(const bf16x8_t*)(qrow + 16 * ks);
    }
    f32x16_t o0, o1;
#pragma unroll
    for (int r = 0; r < 16; r++) { o0[r] = 0.f; o1[r] = 0.f; }
    float R = 0.f;
    for (int kt = q0; kt >= 0; kt -= 32) {
      bf16x8_t kf[4];
      {
        const bf16* krow = proj + (tokb + kt + n) * DIN + 1024 + wave * 64 + 8 * hh;
#pragma unroll
        for (int ks = 0; ks < 4; ks++) kf[ks] = *(const bf16x8_t*)(krow + 16 * ks);
      }
      bf16x8_t vf0[2], vf1[2];
      {
        const bf16* vb = proj + (tokb + kt + 4 * hh) * DIN + 1536 + wave * 64 + n;
#pragma unroll
        for (int s = 0; s < 2; s++)
#pragma unroll
          for (int j = 0; j < 8; j++) {
            const int key = 16 * s + 8 * (j >> 2) + (j & 3);
            vf0[s][j] = (short)vb[(size_t)key * DIN];
            vf1[s][j] = (short)vb[(size_t)key * DIN + 32];
          }
      }
      f32x16_t sacc;
#pragma unroll
      for (int r = 0; r < 16; r++) sacc[r] = 0.f;
      __builtin_amdgcn_sched_barrier(0); asm volatile("s_nop 15\n\ts_nop 15" ::: "memory"); __builtin_amdgcn_sched_barrier(0);
#pragma unroll
      for (int ks = 0; ks < 4; ks++) sacc = __builtin_amdgcn_mfma_f32_32x32x16_bf16(kf[ks], qf[ks], sacc, 0, 0, 0);
      __builtin_amdgcn_sched_barrier(0); asm volatile("s_nop 15\n\ts_nop 15" ::: "memory"); __builtin_amdgcn_sched_barrier(0);
      float lst[16], lsz[16];
      const bool diag = (kt == q0);
#pragma unroll
      for (int r = 0; r < 16; r++) {
        const float z = sacc[r] * 0.125f;
        const float sp = __logf(1.0f + __expf(-fabsf(z)));
        float a = fminf(z, 0.f) - sp;
        float c = -(fmaxf(z, 0.f) + sp);
        if (diag) {
          const int key = (r & 3) + 8 * (r >> 2) + 4 * hh;
          if (key >= n) { a = -1.0e30f; c = 0.f; }
        }
        lsz[r] = a; lst[r] = c;
      }
      float Gs[4], Gp[4];
#pragma unroll
      for (int g = 0; g < 4; g++) {
        Gs[g] = (lst[4 * g] + lst[4 * g + 1]) + (lst[4 * g + 2] + lst[4 * g + 3]);
        Gp[g] = __shfl_xor(Gs[g], 32, 64);
      }
      float carry[4];
      {
        float after = R;
#pragma unroll
        for (int g = 3; g >= 0; g--) {
          carry[g] = after + (hh ? 0.f : Gp[g]);
          after += Gs[g] + Gp[g];
        }
        R = after;
      }
      bf16x8_t pf[2];
#pragma unroll
      for (int g = 0; g < 4; g++) {
        float run = carry[g];
        float a3 = __expf(lsz[4 * g + 3] + run); run += lst[4 * g + 3];
        float a2 = __expf(lsz[4 * g + 2] + run); run += lst[4 * g + 2];
        float a1 = __expf(lsz[4 * g + 1] + run); run += lst[4 * g + 1];
        float a0 = __expf(lsz[4 * g + 0] + run);
        const int s = g >> 1, jb = (g & 1) * 4;
        pf[s][jb + 0] = (short)f2bf(a0); pf[s][jb + 1] = (short)f2bf(a1);
        pf[s][jb + 2] = (short)f2bf(a2); pf[s][jb + 3] = (short)f2bf(a3);
      }
      __builtin_amdgcn_sched_barrier(0); asm volatile("s_nop 15\n\ts_nop 15" ::: "memory"); __builtin_amdgcn_sched_barrier(0);
#pragma unroll
      for (int s = 0; s < 2; s++) {
        o0 = __builtin_amdgcn_mfma_f32_32x32x16_bf16(pf[s], vf0[s], o0, 0, 0, 0);
        o1 = __builtin_amdgcn_mfma_f32_32x32x16_bf16(pf[s], vf1[s], o1, 0, 0, 0);
      }
      __builtin_amdgcn_sched_barrier(0); asm volatile("s_nop 15\n\ts_nop 15" ::: "memory"); __builtin_amdgcn_sched_barrier(0);
      if (__all(R < -110.f)) break;
    }
    float sq[16];
#pragma unroll
    for (int r = 0; r < 16; r++) {
      float v = o0[r] * o0[r] + o1[r] * o1[r];
#pragma unroll
      for (int o = 16; o > 0; o >>= 1) v += __shfl_xor(v, o, 64);
      sq[r] = v;
    }
    __syncthreads();
    if (n == 0) {
#pragma unroll
      for (int r = 0; r < 16; r++) ssq[wave * 32 + (r & 3) + 8 * (r >> 2) + 4 * hh] = sq[r];
    }
    __syncthreads();
    if (tid < 32) {
      float t = 0.f;
#pragma unroll
      for (int w = 0; w < 8; w++) t += ssq[w * 32 + tid];
      rstd[tid] = rsqrtf(t * (1.0f / 512.f) + EPSF);
    }
    __syncthreads();
#pragma unroll
    for (int r = 0; r < 16; r++) {
      const int qi = (r & 3) + 8 * (r >> 2) + 4 * hh;
      const float rs = rstd[qi];
      bf16* yr = y + (tokb + q0 + qi) * DM + 256 + wave * 64 + n;
      yr[0] = (bf16)f2bf(o0[r] * rs * g0);
      yr[32] = (bf16)f2bf(o1[r] * rs * g1);
    }
  }
}

#define SSM_BCAST_U(u, ua, ub, tt) do { \
    const unsigned w0 = (unsigned)__builtin_amdgcn_readlane((int)(ua).x, (tt)), w1 = (unsigned)__builtin_amdgcn_readlane((int)(ua).y, (tt)); \
    const unsigned w2 = (unsigned)__builtin_amdgcn_readlane((int)(ua).z, (tt)), w3 = (unsigned)__builtin_amdgcn_readlane((int)(ua).w, (tt)); \
    const unsigned w4 = (unsigned)__builtin_amdgcn_readlane((int)(ub).x, (tt)), w5 = (unsigned)__builtin_amdgcn_readlane((int)(ub).y, (tt)); \
    const unsigned w6 = (unsigned)__builtin_amdgcn_readlane((int)(ub).z, (tt)), w7 = (unsigned)__builtin_amdgcn_readlane((int)(ub).w, (tt)); \
    (u)[0] = bf_lo(w0); (u)[1] = bf_hi(w0); (u)[2] = bf_lo(w1); (u)[3] = bf_hi(w1); (u)[4] = bf_lo(w2); (u)[5] = bf_hi(w2); (u)[6] = bf_lo(w3); (u)[7] = bf_hi(w3); \
    (u)[8] = bf_lo(w4); (u)[9] = bf_hi(w4); (u)[10] = bf_lo(w5); (u)[11] = bf_hi(w5); (u)[12] = bf_lo(w6); (u)[13] = bf_hi(w6); (u)[14] = bf_lo(w7); (u)[15] = bf_hi(w7); } while (0)
__device__ __forceinline__ void ssm_chunk_end(const int wave_s, const float* ssmp, const bf16* proj, float* ssmE) {
  const int tid_ = opaque_tid(wave_s);
  const int lane = tid_ & 63;
  const int gw = blockIdx.x * NWAVES + (tid_ >> 6);
  const int nw = gridDim.x * NWAVES;
  for (int it = gw; it < 4 * 64 * 16; it += nw) {
    const int g = it & 15, c = (it >> 4) & 63, b = it >> 10;
    const int gp = g * 64 + lane;
    const uint4* up = (const uint4*)(proj + (size_t)(b * SEQ + c * 64 + lane) * DIN + 2048 + g * 16);
    const uint4 ua = up[0], ub = up[1];
    const float lbr = ssmp[gp * 2], lbi = ssmp[gp * 2 + 1];
    float bbr[16], bbi[16];
#pragma unroll
    for (int h = 0; h < 16; h++) {
      { const float2 bb = *(const float2*)(ssmp + 4096 + ((g * 16 + h) * 64 + lane) * 2); bbr[h] = bb.x; bbi[h] = bb.y; }
    }
    float xr = 0.f, xi = 0.f;
#pragma unroll 2
    for (int tt = 0; tt < 64; tt++) {
      float u[16];
      SSM_BCAST_U(u, ua, ub, tt);
      float br = 0.f, bi = 0.f;
#pragma unroll
      for (int h = 0; h < 16; h++) { br += bbr[h] * u[h]; bi += bbi[h] * u[h]; }
      const float nr = lbr * xr - lbi * xi + br;
      const float ni = lbr * xi + lbi * xr + bi;
      xr = nr; xi = ni;
    }
    float* e = ssmE + ((size_t)((b * 64 + c) * 16 + g) * 64 + lane) * 2;
    e[0] = xr; e[1] = xi;
  }
}

__device__ __forceinline__ void ssm_finish(const int wave_s, const Params& p, int l, const float* ssmp, const bf16* proj,
                           const float* ssmE, bf16* y, LAS float* smem) {
  LAS bf16* Ytb = (LAS bf16*)smem;
  LAS float* ssq2 = smem + (64 * 264 * 2) / 4;
  LAS float* rstd2 = ssq2 + 512;
  const bf16* glT = (const bf16*)(p.ws + WS_WT + (size_t)l * WT_LAYER + WT_GLU);
  const int tid = opaque_tid(wave_s), lane = tid & 63, wave = tid >> 6;
  const float* cre = karg_in(13) + (size_t)l * 16 * 16 * 64;
  const float* cim = karg_in(14) + (size_t)l * 16 * 16 * 64;
  const float* dsk = karg_in(15) + l * 256;
  const float* glw = karg_in(16) + (size_t)l * 256 * 256;
  const float* glb = karg_in(17) + l * 256;
  const float* gg = karg_in(18) + l * 1024 + 768;
  for (int it = blockIdx.x; it < 256; it += gridDim.x) {
    const int b = it >> 6, c = it & 63;
    __syncthreads();
    for (int gi = 0; gi < 2; gi++) {
      const int g = wave + gi * 8;
      const int gp = g * 64 + lane;
      const float lbr = ssmp[gp * 2], lbi = ssmp[gp * 2 + 1];
      const float lcr = ssmp[2048 + gp * 2], lci = ssmp[2048 + gp * 2 + 1];
      float bbr[16], bbi[16], ccr[16], cci[16];
#pragma unroll
      for (int h = 0; h < 16; h++) {
        { const float2 bb = *(const float2*)(ssmp + 4096 + ((g * 16 + h) * 64 + lane) * 2); bbr[h] = bb.x; bbi[h] = bb.y; }
        ccr[h] = cre[(g * 16 + h) * 64 + lane];
        cci[h] = cim[(g * 16 + h) * 64 + lane];
      }
      float xr = 0.f, xi = 0.f;
      {
        const float2* eb = (const float2*)ssmE + ((size_t)(b * 64) * 16 + g) * 64 + lane;
        int cc = 0;
        for (; cc + 8 <= c; cc += 8) {
          float2 ev[8];
#pragma unroll
          for (int k = 0; k < 8; k++) ev[k] = eb[(size_t)(cc + k) * 16 * 64];
#pragma unroll
          for (int k = 0; k < 8; k++) {
            const float nr = lcr * xr - lci * xi + ev[k].x;
            const float ni = lcr * xi + lci * xr + ev[k].y;
            xr = nr; xi = ni;
          }
        }
        for (; cc < c; cc++) {
          const float2 e1 = eb[(size_t)cc * 16 * 64];
          const float nr = lcr * xr - lci * xi + e1.x;
          const float ni = lcr * xi + lci * xr + e1.y;
          xr = nr; xi = ni;
        }
      }
      const int hq = ((lane >> 5) & 1) * 8 + ((lane >> 4) & 1) * 4 + ((lane >> 3) & 1) * 2 + ((lane >> 2) & 1);
      float dm[16];
#pragma unroll
      for (int h = 0; h < 16; h++) dm[h] = (lane == 0) ? dsk[g * 16 + h] : 0.f;
      const uint4* up = (const uint4*)(proj + (size_t)(b * SEQ + c * 64 + lane) * DIN + 2048 + g * 16);
      const uint4 ua = up[0], ub = up[1];
#pragma unroll 1
      for (int t4 = 0; t4 < 64; t4 += 4) {
        float vv[4][16];
#pragma unroll
        for (int s = 0; s < 4; s++) {
          float u[16];
          SSM_BCAST_U(u, ua, ub, t4 + s);
          float br = 0.f, bi = 0.f;
#pragma unroll
          for (int h = 0; h < 16; h++) { br += bbr[h] * u[h]; bi += bbi[h] * u[h]; }
          const float nr = lbr * xr - lbi * xi + br;
          const float ni = lbr * xi + lbi * xr + bi;
          xr = nr; xi = ni;
#pragma unroll
          for (int h = 0; h < 16; h++) vv[s][h] = xr * ccr[h] - xi * cci[h] + dm[h] * u[h];
        }
        float v1[4];
#pragma unroll
        for (int s = 0; s < 4; s++) {
          float v8[8], v4[4], v2[2];
          {
            const bool hi = (lane & 32) != 0;
#pragma unroll
            for (int i = 0; i < 8; i++) { const float send = hi ? vv[s][i] : vv[s][i + 8]; const float keep = hi ? vv[s][i + 8] : vv[s][i]; v8[i] = keep + __shfl_xor(send, 32, 64); }
          }
          {
            const bool hi = (lane & 16) != 0;
#pragma unroll
            for (int i = 0; i < 4; i++) { const float send = hi ? v8[i] : v8[i + 4]; const float keep = hi ? v8[i + 4] : v8[i]; v4[i] = keep + __shfl_xor(send, 16, 64); }
          }
          {
            const bool hi = (lane & 8) != 0;
#pragma unroll
            for (int i = 0; i < 2; i++) { const float send = hi ? v4[i] : v4[i + 2]; const float keep = hi ? v4[i + 2] : v4[i]; v2[i] = keep + __shfl_xor(send, 8, 64); }
          }
          {
            const bool hi = (lane & 4) != 0;
            const float send = hi ? v2[0] : v2[1];
            const float keep = hi ? v2[1] : v2[0];
            v1[s] = keep + __shfl_xor(send, 4, 64);
          }
          v1[s] += __shfl_xor(v1[s], 2, 64);
          v1[s] += __shfl_xor(v1[s], 1, 64);
        }
        if ((lane & 3) == 0) {
#pragma unroll
          for (int s = 0; s < 4; s++) Ytb[(t4 + s) * 264 + g * 16 + hq] = (bf16)f2bf(gelu_tanh(v1[s]));
        }
      }
    }
    __syncthreads();
    {
      const int n = lane & 31, hh = lane >> 5;
      const int ch = wave * 32 + n;
      const float bj = glb[ch];
      const float gj = gg[ch];
      bf16x8_t gf[16];
      {
        const bf16* grow = glT + (size_t)ch * 256 + 8 * hh;
#pragma unroll
        for (int ks = 0; ks < 16; ks++) gf[ks] = *(const bf16x8_t*)(grow + 16 * ks);
      }
      float oo[2][16];
#pragma unroll
      for (int mt = 0; mt < 2; mt++) {
        f32x16_t z;
#pragma unroll
        for (int r = 0; r < 16; r++) z[r] = 0.f;
        const LAS bf16* yrow = Ytb + (mt * 32 + n) * 264 + 8 * hh;
#pragma unroll
        for (int kq = 0; kq < 4; kq++) {
          bf16x8_t yf[4];
#pragma unroll
          for (int i = 0; i < 4; i++) yf[i] = *(const LAS bf16x8_t*)(yrow + 16 * (kq * 4 + i));
          MFMA_PAD();
#pragma unroll
          for (int i = 0; i < 4; i++) z = __builtin_amdgcn_mfma_f32_32x32x16_bf16(yf[i], gf[kq * 4 + i], z, 0, 0, 0);
          MFMA_PAD();
        }
        float sq[16];
#pragma unroll
        for (int r = 0; r < 16; r++) {
          const int t = mt * 32 + (r & 3) + 8 * (r >> 2) + 4 * hh;
          const float yv = bf2f(Ytb[t * 264 + ch]);
          const float o = yv * sigmoidf_(z[r] + bj);
          oo[mt][r] = o;
          float v = o * o;
#pragma unroll
          for (int s = 16; s > 0; s >>= 1) v += __shfl_xor(v, s, 64);
          sq[r] = v;
        }
        if (n == 0) {
#pragma unroll
          for (int r = 0; r < 16; r++) ssq2[wave * 64 + mt * 32 + (r & 3) + 8 * (r >> 2) + 4 * hh] = sq[r];
        }
      }
      __syncthreads();
      if (tid < 64) {
        float t = 0.f;
#pragma unroll
        for (int w = 0; w < 8; w++) t += ssq2[w * 64 + tid];
        rstd2[tid] = rsqrtf(t * (1.0f / 256.f) + EPSF);
      }
      __syncthreads();
#pragma unroll
      for (int mt = 0; mt < 2; mt++)
#pragma unroll
        for (int r = 0; r < 16; r++) {
          const int t = mt * 32 + (r & 3) + 8 * (r >> 2) + 4 * hh;
          y[(size_t)(b * SEQ + c * 64 + t) * DM + 768 + ch] = (bf16)f2bf(oo[mt][r] * rstd2[t] * gj);
        }
    }
  }
}

__device__ __forceinline__ void memattn_phase(const int wave_s, const bf16* q, const bf16* kvb, const bf16* vT, bf16* o) {
  const int tid_ = opaque_tid(wave_s);
  const int lane = tid_ & 63, n = lane & 31, hh = lane >> 5;
  const int gw = blockIdx.x * NWAVES + (tid_ >> 6);
  const int nw = gridDim.x * NWAVES;
  const int sig = (n & 0x13) | ((n & 4) << 1) | ((n & 8) >> 1);
  for (int it = gw; it < 512 * 4; it += nw) {
    const int h = it & 3, tok0 = (it >> 2) * 32, b = tok0 >> 12;
    f32x16_t st[8];
#pragma unroll
    for (int kt = 0; kt < 8; kt++)
#pragma unroll
      for (int r = 0; r < 16; r++) st[kt][r] = 0.f;
    const bf16* qrow = q + (size_t)(tok0 + n) * DM + h * 256 + 8 * hh;
    const bf16* kbase = kvb + (size_t)(b * NMEM + sig) * 2048 + h * 256 + 8 * hh;
#pragma unroll
    for (int kq = 0; kq < 4; kq++) {
      bf16x8_t qf[4];
#pragma unroll
      for (int i = 0; i < 4; i++) qf[i] = *(const bf16x8_t*)(qrow + 16 * (kq * 4 + i));
#pragma unroll
      for (int kt = 0; kt < 8; kt++) {
        const bf16* krow = kbase + (size_t)kt * 32 * 2048;
        bf16x8_t kf[4];
#pragma unroll
        for (int i = 0; i < 4; i++) kf[i] = *(const bf16x8_t*)(krow + 16 * (kq * 4 + i));
        MFMA_PAD();
#pragma unroll
        for (int i = 0; i < 4; i++) st[kt] = __builtin_amdgcn_mfma_f32_32x32x16_bf16(kf[i], qf[i], st[kt], 0, 0, 0);
        MFMA_PAD();
      }
    }
    float mx = st[0][0];
#pragma unroll
    for (int kt = 0; kt < 8; kt++)
#pragma unroll
      for (int r = 0; r < 16; r++) mx = fmaxf(mx, st[kt][r]);
    mx = fmaxf(mx, __shfl_xor(mx, 32, 64));
    float sum = 0.f;
#pragma unroll
    for (int kt = 0; kt < 8; kt++)
#pragma unroll
      for (int r = 0; r < 16; r++) { const float e = __expf((st[kt][r] - mx) * 0.0625f); st[kt][r] = e; sum += e; }
    sum += __shfl_xor(sum, 32, 64);
    const float inv = 1.0f / sum;
    bf16x8_t pf[8][2];
#pragma unroll
    for (int kt = 0; kt < 8; kt++)
#pragma unroll
      for (int s = 0; s < 2; s++)
#pragma unroll
        for (int j = 0; j < 8; j++) pf[kt][s][j] = (short)f2bf(st[kt][8 * s + j] * inv);
    const bf16* vbase = vT + ((size_t)(b * 4 + h) * 256 + n) * 256 + 8 * hh;
#pragma unroll 1
    for (int dt = 0; dt < 8; dt++) {
      f32x16_t oacc;
#pragma unroll
      for (int r = 0; r < 16; r++) oacc[r] = 0.f;
      const bf16* vrow = vbase + (size_t)dt * 32 * 256;
#pragma unroll
      for (int kq = 0; kq < 4; kq++) {
        bf16x8_t vf[4];
#pragma unroll
        for (int i = 0; i < 4; i++) vf[i] = *(const bf16x8_t*)(vrow + (kq * 2 + (i >> 1)) * 32 + 16 * (i & 1));
        MFMA_PAD();
#pragma unroll
        for (int i = 0; i < 4; i++) oacc = __builtin_amdgcn_mfma_f32_32x32x16_bf16(pf[kq * 2 + (i >> 1)][i & 1], vf[i], oacc, 0, 0, 0);
        MFMA_PAD();
      }
#pragma unroll
      for (int r = 0; r < 16; r++) {
        const int qi = (r & 3) + 8 * (r >> 2) + 4 * hh;
        o[(size_t)(tok0 + qi) * DM + h * 256 + dt * 32 + n] = (bf16)f2bf(oacc[r]);
      }
    }
  }
}

__device__ __forceinline__ void vt_phase(const int wave_s, const bf16* kvb, bf16* vT) {
  const int tid_ = opaque_tid(wave_s);
  const int gt = blockIdx.x * (NWAVES * 64) + tid_;
  const int nth = gridDim.x * NWAVES * 64;
  for (int i = gt; i < 2 * 4 * 4 * 256 * 256; i += nth) {
    const int m = i & 255, d = (i >> 8) & 255, h = (i >> 16) & 3, b = (i >> 18) & 3, l = i >> 20;
    vT[i] = kvb[((size_t)l * 1024 + b * 256 + m) * 2048 + 1024 + h * 256 + d];
  }
}

__device__ __forceinline__ void topk_rounds(float (&s)[64], int hh, float (&tv)[16], int (&ti)[16]) {
  const float NEG = -3.0e38f;
#pragma unroll 1
  for (int r = 0; r < 16; r++) {
    float m = s[0]; int slot = 0;
#pragma unroll
    for (int i = 1; i < 64; i++) {
      const bool gt = s[i] > m;
      m = gt ? s[i] : m;
      slot = gt ? i : slot;
    }
    const int rr = slot & 15;
    const int idx = (slot >> 4) * 32 + (rr & 3) + 8 * (rr >> 2) + 4 * hh;
    const float pm = __shfl_xor(m, 32, 64);
    const int pidx = __shfl_xor(idx, 32, 64);
    const bool mine = (m > pm) || (m == pm && idx < pidx);
    const float wv = mine ? m : pm;
    const int wi = mine ? idx : pidx;
#pragma unroll
    for (int j = 0; j < 16; j++) { tv[j] = (r == j) ? wv : tv[j]; ti[j] = (r == j) ? wi : ti[j]; }
    const int kill = mine ? slot : -1;
#pragma unroll
    for (int i = 0; i < 64; i++) s[i] = (kill == i) ? NEG : s[i];
  }
}

__device__ __forceinline__ void peer_topk(const int wave_s, const bf16* pq, const bf16* skb, int* ids, float* gates) {
  const int tid_ = opaque_tid(wave_s);
  const int lane = tid_ & 63, n = lane & 31, hh = lane >> 5;
  const int gw = blockIdx.x * NWAVES + (tid_ >> 6);
  const int nw = gridDim.x * NWAVES;
  const float NEG = -3.0e38f;
  for (int it = gw; it < 512 * 8; it += nw) {
    const int h = it & 7, tok0 = (it >> 3) * 32;
    float tv0[16], tv1[16];
    int ti0[16], ti1[16];
#pragma unroll
    for (int j = 0; j < 16; j++) { tv0[j] = 0.f; tv1[j] = 0.f; ti0[j] = 0; ti1[j] = 0; }
#pragma unroll
    for (int half = 0; half < 2; half++) {
      bf16x8_t qf[8];
      {
        const bf16* qrow = pq + (size_t)(tok0 + n) * 2048 + h * 256 + half * 128 + 8 * hh;
#pragma unroll
        for (int ks = 0; ks < 8; ks++) qf[ks] = *(const bf16x8_t*)(qrow + 16 * ks);
      }
      f32x16_t st[4];
#pragma unroll
      for (int kt = 0; kt < 4; kt++) {
        const bf16* krow = skb + ((size_t)((h * 2 + half) * 128 + kt * 32 + n)) * 128 + 8 * hh;
        asm volatile("" : "+v"(krow));
        f32x16_t acc;
#pragma unroll
        for (int r = 0; r < 16; r++) acc[r] = 0.f;
#pragma unroll
        for (int kq = 0; kq < 2; kq++) {
          bf16x8_t kf[4];
#pragma unroll
          for (int i = 0; i < 4; i++) kf[i] = *(const bf16x8_t*)(krow + 16 * (kq * 4 + i));
          MFMA_PAD();
#pragma unroll
          for (int i = 0; i < 4; i++) acc = __builtin_amdgcn_mfma_f32_32x32x16_bf16(kf[i], qf[kq * 4 + i], acc, 0, 0, 0);
          MFMA_PAD();
        }
        st[kt] = acc;
      }
      float s[64];
#pragma unroll
      for (int kt = 0; kt < 4; kt++)
#pragma unroll
        for (int i = 0; i < 16; i++) s[kt * 16 + i] = st[kt][i];
      __builtin_amdgcn_sched_barrier(0);
      if (half == 0) topk_rounds(s, hh, tv0, ti0); else topk_rounds(s, hh, tv1, ti1);
      __builtin_amdgcn_sched_barrier(0);
    }
    float F[16];
    int ba[16];
#pragma unroll
    for (int a = 0; a < 16; a++) { F[a] = tv0[a] + tv1[0]; ba[a] = 0; }
    float bv[16];
    int be[16];
#pragma unroll
    for (int j = 0; j < 16; j++) { bv[j] = 0.f; be[j] = 0; }
#pragma unroll 1
    for (int r = 0; r < 16; r++) {
      float m = F[0]; int a = 0;
#pragma unroll
      for (int i = 1; i < 16; i++) { const bool gt = F[i] > m; m = gt ? F[i] : m; a = gt ? i : a; }
      int bsel = 0, i0 = 0; float t0 = 0.f;
#pragma unroll
      for (int i = 0; i < 16; i++) { const bool is = (a == i); bsel = is ? ba[i] : bsel; i0 = is ? ti0[i] : i0; t0 = is ? tv0[i] : t0; }
      int i1 = 0; float t1n = NEG;
#pragma unroll
      for (int i = 0; i < 16; i++) { i1 = (bsel == i) ? ti1[i] : i1; t1n = (bsel + 1 == i) ? tv1[i] : t1n; }
      const int e = i0 * 128 + i1;
      const float fn = (bsel + 1 < 16) ? (t0 + t1n) : NEG;
#pragma unroll
      for (int i = 0; i < 16; i++) { const bool is = (a == i); F[i] = is ? fn : F[i]; ba[i] = is ? (bsel + 1) : ba[i]; }
#pragma unroll
      for (int j = 0; j < 16; j++) { bv[j] = (r == j) ? m : bv[j]; be[j] = (r == j) ? e : be[j]; }
    }
    const float b0 = bv[0];
    float ge[16];
    float gsum = 0.f;
#pragma unroll
    for (int r = 0; r < 16; r++) { ge[r] = __expf(bv[r] - b0); gsum += ge[r]; }
    const float ginv = 1.0f / gsum;
    if (hh == 0) {
      int* ip = ids + (size_t)(tok0 + n) * 128 + h * 16;
      float* gp = gates + (size_t)(tok0 + n) * 128 + h * 16;
#pragma unroll
      for (int r4 = 0; r4 < 4; r4++) {
        *(int4*)(ip + 4 * r4) = make_int4(be[4 * r4], be[4 * r4 + 1], be[4 * r4 + 2], be[4 * r4 + 3]);
        *(float4*)(gp + 4 * r4) = make_float4(ge[4 * r4] * ginv, ge[4 * r4 + 1] * ginv, ge[4 * r4 + 2] * ginv, ge[4 * r4 + 3] * ginv);
      }
    }
  }
}

typedef _Float16 f16x2_t __attribute__((ext_vector_type(2)));
__device__ __forceinline__ unsigned e4m3x2_to_f16x2(unsigned w, unsigned sel) {
  const unsigned p = __builtin_amdgcn_perm(w, w, sel);
  return (p & 0x80008000u) | ((p >> 1) & 0x3F803F80u);
}
__device__ __forceinline__ float dot2h(unsigned a, unsigned b, float c) {
  return __builtin_amdgcn_fdot2(__builtin_bit_cast(f16x2_t, a), __builtin_bit_cast(f16x2_t, b), c, false);
}
__device__ __forceinline__ unsigned pack_h2(float lo, float hi) {
  f16x2_t v; v.x = (_Float16)lo; v.y = (_Float16)hi;
  return __builtin_bit_cast(unsigned, v);
}
template <bool FINAL>
__device__ __forceinline__ void peer_gather(const int wave_s, bf16* xn, const float* rst, const unsigned char* ub, const unsigned char* vb,
                                            const int* ids, const float* gates, float* xw, const float* gnext, float* outp) {
  const int tid_ = opaque_tid(wave_s);
  const int lane = tid_ & 63;
  const int gw = blockIdx.x * NWAVES + (tid_ >> 6);
  const int nw = gridDim.x * NWAVES;
  const int el = ((lane >> 5) & 1) * 4 + ((lane >> 4) & 1) * 2 + ((lane >> 3) & 1);
  for (int tok = gw; tok < NT; tok += nw) {
    unsigned xh[8];
    {
      const uint4 a = *(const uint4*)(xn + (size_t)tok * DM + lane * 16);
      const uint4 b = *(const uint4*)(xn + (size_t)tok * DM + lane * 16 + 8);
      const unsigned xw_[8] = {a.x, a.y, a.z, a.w, b.x, b.y, b.z, b.w};
      const float4* sp = (const float4*)(rst + (size_t)tok * 16);
      const float4 s0 = sp[0], s1 = sp[1], s2 = sp[2], s3 = sp[3];
      const float xs = rsqrtf((((s0.x + s0.y) + (s0.z + s0.w)) + ((s1.x + s1.y) + (s1.z + s1.w)) + ((s2.x + s2.y) + (s2.z + s2.w)) + ((s3.x + s3.y) + (s3.z + s3.w))) * (1.0f / 1024.f) + EPSF);
#pragma unroll
      for (int k = 0; k < 8; k++) xh[k] = pack_h2(bf_lo(xw_[k]) * xs, bf_hi(xw_[k]) * xs);
    }
    float acc[16];
#pragma unroll
    for (int i = 0; i < 16; i++) acc[i] = 0.f;
#pragma unroll 1
    for (int g = 0; g < 16; g++) {
      const int idv = ids[(size_t)tok * 128 + g * 8 + (lane & 7)];
      const float gv = gates[(size_t)tok * 128 + g * 8 + el];
      uint4 uu[8], vv[8];
#pragma unroll
      for (int e = 0; e < 8; e++) {
        const int id = __builtin_amdgcn_readlane(idv, e);
        uu[e] = *(const uint4*)(ub + (size_t)id * DM + lane * 16);
        vv[e] = *(const uint4*)(vb + (size_t)id * DM + lane * 16);
      }
      float d[8];
#pragma unroll
      for (int e = 0; e < 8; e++) {
        const unsigned uw[4] = {uu[e].x, uu[e].y, uu[e].z, uu[e].w};
        float s = 0.f;
#pragma unroll
        for (int k = 0; k < 4; k++) {
          s = dot2h(e4m3x2_to_f16x2(uw[k], 0x010c000cu), xh[2 * k], s);
          s = dot2h(e4m3x2_to_f16x2(uw[k], 0x030c020cu), xh[2 * k + 1], s);
        }
        d[e] = s;
      }
      float d4[4], d2[2], d1;
      {
        const bool hi = (lane & 32) != 0;
#pragma unroll
        for (int i = 0; i < 4; i++) { const float send = hi ? d[i] : d[i + 4]; const float keep = hi ? d[i + 4] : d[i]; d4[i] = keep + __shfl_xor(send, 32, 64); }
      }
      {
        const bool hi = (lane & 16) != 0;
#pragma unroll
        for (int i = 0; i < 2; i++) { const float send = hi ? d4[i] : d4[i + 2]; const float keep = hi ? d4[i + 2] : d4[i]; d2[i] = keep + __shfl_xor(send, 16, 64); }
      }
      {
        const bool hi = (lane & 8) != 0;
        const float send = hi ? d2[0] : d2[1];
        const float keep = hi ? d2[1] : d2[0];
        d1 = keep + __shfl_xor(send, 8, 64);
      }
      d1 += __shfl_xor(d1, 4, 64);
      d1 += __shfl_xor(d1, 2, 64);
      d1 += __shfl_xor(d1, 1, 64);
      const float wl = gv * gelu_tanh(d1 * (256.0f / U_SCALE)) * (256.0f / V_SCALE);
#pragma unroll
      for (int e = 0; e < 8; e++) {
        const float w = __builtin_bit_cast(float, __builtin_amdgcn_readlane(__builtin_bit_cast(int, wl), ((e >> 2) & 1) * 32 + ((e >> 1) & 1) * 16 + (e & 1) * 8));
        const unsigned wlo = pack_h2(w, 0.f), whi = pack_h2(0.f, w);
        const unsigned vw[4] = {vv[e].x, vv[e].y, vv[e].z, vv[e].w};
#pragma unroll
        for (int k = 0; k < 4; k++) {
          const unsigned h0 = e4m3x2_to_f16x2(vw[k], 0x010c000cu), h1 = e4m3x2_to_f16x2(vw[k], 0x030c020cu);
          acc[4 * k + 0] = dot2h(h0, wlo, acc[4 * k + 0]);
          acc[4 * k + 1] = dot2h(h0, whi, acc[4 * k + 1]);
          acc[4 * k + 2] = dot2h(h1, wlo, acc[4 * k + 2]);
          acc[4 * k + 3] = dot2h(h1, whi, acc[4 * k + 3]);
        }
      }
    }
    float* xr = xw + (size_t)tok * DM + lane * 16;
    float xv[16];
    float ssq = 0.f;
#pragma unroll
    for (int c = 0; c < 4; c++) {
      float4 a0 = *(float4*)(xr + c * 4);
      a0.x += acc[c * 4 + 0]; a0.y += acc[c * 4 + 1]; a0.z += acc[c * 4 + 2]; a0.w += acc[c * 4 + 3];
      if (!FINAL) *(float4*)(xr + c * 4) = a0;
      xv[c * 4 + 0] = a0.x; xv[c * 4 + 1] = a0.y; xv[c * 4 + 2] = a0.z; xv[c * 4 + 3] = a0.w;
      ssq += a0.x * a0.x + a0.y * a0.y + a0.z * a0.z + a0.w * a0.w;
    }
    ssq = wsum(ssq);
    const float rstd = rsqrtf(ssq * (1.0f / DM) + EPSF);
    const float4* g4 = (const float4*)(gnext + lane * 16);
    if (FINAL) {
      float* op = outp + (size_t)tok * DM + lane * 16;
#pragma unroll
      for (int c = 0; c < 4; c++) {
        const float4 gq = g4[c];
        *(float4*)(op + c * 4) = make_float4(xv[c * 4] * rstd * gq.x, xv[c * 4 + 1] * rstd * gq.y, xv[c * 4 + 2] * rstd * gq.z, xv[c * 4 + 3] * rstd * gq.w);
      }
    } else {
      uint4 o0, o1;
      { const float4 ga = g4[0], gb = g4[1];
        o0.x = pk2(xv[0] * rstd * ga.x, xv[1] * rstd * ga.y); o0.y = pk2(xv[2] * rstd * ga.z, xv[3] * rstd * ga.w);
        o0.z = pk2(xv[4] * rstd * gb.x, xv[5] * rstd * gb.y); o0.w = pk2(xv[6] * rstd * gb.z, xv[7] * rstd * gb.w); }
      { const float4 ga = g4[2], gb = g4[3];
        o1.x = pk2(xv[8] * rstd * ga.x, xv[9] * rstd * ga.y); o1.y = pk2(xv[10] * rstd * ga.z, xv[11] * rstd * ga.w);
        o1.z = pk2(xv[12] * rstd * gb.x, xv[13] * rstd * gb.y); o1.w = pk2(xv[14] * rstd * gb.z, xv[15] * rstd * gb.w); }
      *(uint4*)(xn + (size_t)tok * DM + lane * 16) = o0;
      *(uint4*)(xn + (size_t)tok * DM + lane * 16 + 8) = o1;
    }
  }
}

__device__ __forceinline__ void prologue_transposes(const int wave_s, const Params& p, unsigned char* ws, LAS unsigned char* lds) {
  const int tid_ = opaque_tid(wave_s);
  const int lane = tid_ & 63, wave = tid_ >> 6;
  LAS float* scr = (LAS float*)(lds + wave * 16384);
  const int gw = blockIdx.x * NWAVES + wave, NGW = gridDim.x * NWAVES;
  constexpr int I_IN = (DM / 64) * (DIN / 32), I_SQ = (DM / 64) * (DM / 32), I_2K = (DM / 64) * (2048 / 32);
  constexpr int I_GL = (256 / 64) * (256 / 32);
  constexpr int PER_LAYER = I_IN + 3 * I_SQ + 2 * I_2K + I_GL;
  const float* w3 = karg_in(3); const float* w19 = karg_in(19); const float* w22 = karg_in(22);
  const float* w23 = karg_in(23); const float* w24 = karg_in(24); const float* w26 = karg_in(26);
  const float* w16 = karg_in(16);
  for (int it = gw; it < 2 * PER_LAYER; it += NGW) {
    const int l = it / PER_LAYER;
    int r = it % PER_LAYER;
    unsigned char* wl = ws + WS_WT + (size_t)l * WT_LAYER;
    if (r < I_IN) { transpose_item(w3 + (size_t)l * DM * DIN, DM, DIN, (bf16*)(wl + WT_IN), scr, r, lane); continue; } r -= I_IN;
    if (r < I_SQ) { transpose_item(w19 + (size_t)l * DM * DM, DM, DM, (bf16*)(wl + WT_OUT), scr, r, lane); continue; } r -= I_SQ;
    if (r < I_SQ) { transpose_item(w22 + (size_t)l * DM * DM, DM, DM, (bf16*)(wl + WT_MQ), scr, r, lane); continue; } r -= I_SQ;
    if (r < I_2K) { transpose_item(w23 + (size_t)l * DM * 2048, DM, 2048, (bf16*)(wl + WT_MKV), scr, r, lane); continue; } r -= I_2K;
    if (r < I_SQ) { transpose_item(w24 + (size_t)l * DM * DM, DM, DM, (bf16*)(wl + WT_MO), scr, r, lane); continue; } r -= I_SQ;
    if (r < I_2K) { transpose_item(w26 + (size_t)l * DM * 2048, DM, 2048, (bf16*)(wl + WT_PQ), scr, r, lane); continue; } r -= I_2K;
    transpose_item(w16 + (size_t)l * 256 * 256, 256, 256, (bf16*)(wl + WT_GLU), scr, r, lane);
  }
}

template <class T> __device__ __forceinline__ T* opq(T* p) { asm volatile("" : "+s"(p)); return p; }
__device__ __forceinline__ void cvt_rows_bf16(const int wave_s, const float* src, bf16* dst, size_t n) {
  const int tid_ = opaque_tid(wave_s);
  const size_t gt = (size_t)blockIdx.x * (NWAVES * 64) + tid_;
  const size_t nth = (size_t)gridDim.x * NWAVES * 64;
  for (size_t i = gt; i < n / 8; i += nth) {
    const float4 a = ((const float4*)src)[2 * i], b = ((const float4*)src)[2 * i + 1];
    uint4 o; o.x = pk2(a.x, a.y); o.y = pk2(a.z, a.w); o.z = pk2(b.x, b.y); o.w = pk2(b.z, b.w);
    ((uint4*)dst)[i] = o;
  }
}

__device__ __forceinline__ unsigned enc_e4m3(float x) {
  const unsigned bits = __builtin_bit_cast(unsigned, x);
  const unsigned sign = (bits >> 24) & 0x80u;
  float ax = fminf(fabsf(x), 448.0f);
  unsigned r;
  if (ax >= 0.015625f) {
    unsigned ab = __builtin_bit_cast(unsigned, ax);
    ab += 0x0007FFFFu + ((ab >> 20) & 1u);
    r = (ab >> 20) - 960u;
    r = r > 0x7Eu ? 0x7Eu : r;
  } else {
    r = (unsigned)__float2int_rn(ax * 512.0f);
  }
  return sign | r;
}
__device__ __forceinline__ void cvt_rows_e4m3(const int wave_s, const float* src, unsigned char* dst, size_t n, float sc) {
  const int tid_ = opaque_tid(wave_s);
  const size_t gt = (size_t)blockIdx.x * (NWAVES * 64) + tid_;
  const size_t nth = (size_t)gridDim.x * NWAVES * 64;
  for (size_t i = gt; i < n / 16; i += nth) {
    unsigned w[4];
#pragma unroll
    for (int k = 0; k < 4; k++) {
      const float4 a = ((const float4*)src)[4 * i + k];
      w[k] = enc_e4m3(a.x * sc) | (enc_e4m3(a.y * sc) << 8) | (enc_e4m3(a.z * sc) << 16) | (enc_e4m3(a.w * sc) << 24);
    }
    uint4 o; o.x = w[0]; o.y = w[1]; o.z = w[2]; o.w = w[3];
    ((uint4*)dst)[i] = o;
  }
}

#define GEMM_F32(Aptr, Wt, Cptr, Rptr, M_, N_) do { \
    pg8::Gemm g_{opq((const bf16*)(Aptr)), opq((const bf16*)(Wt)), (M_), (N_), DM}; pg8::StaticOrder S_; S_.init((M_), (N_), (int)gridDim.x, (int)blockIdx.x); \
    pg8::EpiF32R E_{opq((float*)(Cptr)), opq((const float*)(Rptr)), (N_)}; \
    pg8::gemm_phase<pg8::EpiF32R, pg8::StaticOrder, true, true>(wave_s, ldsl, g_, S_, E_); } while (0)
#define GEMM_BF16_C(Aptr, Wt, Optr, M_, N_, C_) do { \
    pg8::Gemm g_{opq((const bf16*)(Aptr)), opq((const bf16*)(Wt)), (M_), (N_), DM}; pg8::StaticOrder S_; S_.init((M_), (N_), (int)gridDim.x, (C_)); \
    pg8::EpiBf16 E_{opq((bf16*)(Optr)), (N_)}; \
    pg8::gemm_phase<pg8::EpiBf16, pg8::StaticOrder, true, true>(wave_s, ldsl, g_, S_, E_); } while (0)
#define GEMM_BF16(Aptr, Wt, Optr, M_, N_) GEMM_BF16_C(Aptr, Wt, Optr, M_, N_, (int)blockIdx.x)
#define GEMM_F32RN(Aptr, Wt, Cptr, Rptr, XGptr, Gptr, STptr) do { \
    pg8::Gemm g_{opq((const bf16*)(Aptr)), opq((const bf16*)(Wt)), NT, DM, DM}; pg8::StaticOrder S_; S_.init(NT, DM, (int)gridDim.x, (int)blockIdx.x); \
    pg8::EpiF32RN E_{opq((float*)(Cptr)), opq((const float*)(Rptr)), DM, opq((bf16*)(XGptr)), opq((const float*)(Gptr)), opq((float*)(STptr))}; \
    pg8::gemm_phase<pg8::EpiF32RN, pg8::StaticOrder, true, true>(wave_s, ldsl, g_, S_, E_); } while (0)
#define GEMM_BF16S(Aptr, Wt, Optr, N_, STptr) do { \
    pg8::Gemm g_{opq((const bf16*)(Aptr)), opq((const bf16*)(Wt)), NT, (N_), DM}; pg8::StaticOrder S_; S_.init(NT, (N_), (int)gridDim.x, (int)blockIdx.x); \
    pg8::EpiBf16S E_{opq((bf16*)(Optr)), (N_), opq((const float*)(STptr))}; \
    pg8::gemm_phase<pg8::EpiBf16S, pg8::StaticOrder, true, true>(wave_s, ldsl, g_, S_, E_); } while (0)

__global__ void __launch_bounds__(NWAVES * 64, 2) fwd_megakernel(Params p) {
  cg::grid_group grid = cg::this_grid();
  extern __shared__ __attribute__((aligned(16))) unsigned char lds[];
  LAS unsigned char* ldsl = (LAS unsigned char*)lds;
  LAS float* smem = (LAS float*)ldsl;
  const int wave_s = __builtin_amdgcn_readfirstlane((int)(threadIdx.x >> 6));
  unsigned char* ws = p.ws;
  volatile LAS unsigned* MISC = (volatile LAS unsigned*)(ldsl + 131072);
  if (threadIdx.x < 64) MISC[threadIdx.x] = 0u;
  __syncthreads();
  const XcdBarrier bar = xcd_barrier_post((unsigned*)(ws + WS_CTL) + 4096, MISC + 8);
  grid.sync();
  float* xw = (float*)(ws + WS_XW);
  bf16* xn = (bf16*)(ws + WS_XN);
  bf16* big = (bf16*)(ws + WS_BIG);
  bf16* y = (bf16*)(ws + WS_Y);
  bf16* memh = (bf16*)(ws + WS_MEMH);
  bf16* kvb = (bf16*)(ws + WS_KVB);
  bf16* vT = (bf16*)(ws + WS_VT);
  float* ssmE = (float*)(ws + WS_SSME);
  float* ssmp = (float*)(ws + WS_SSMP);
  int* ids = (int*)(ws + WS_IDS);
  float* gates = (float*)(ws + WS_GATE);
  bf16* skb = (bf16*)(ws + WS_SKB);
  unsigned char* ub = ws + WS_UB;
  unsigned char* vb = ws + WS_VB;
  float* rst = (float*)(ws + WS_RST);

  prologue_transposes(wave_s, p, ws, ldsl);
  cvt_rows_bf16(wave_s, karg_in(27), skb, (size_t)2 * 8 * 2 * 128 * 128);
  cvt_rows_e4m3(wave_s, karg_in(28), ub, (size_t)2 * 16384 * 1024, U_SCALE);
  cvt_rows_e4m3(wave_s, karg_in(29), vb, (size_t)2 * 16384 * 1024, V_SCALE);
  for (int l = 0; l < 2; l++)
    rms_rows<true>(wave_s, karg_in(1), karg_in(21) + l * DM, memh + (size_t)l * 1024 * 1024, 1024);
  ssm_params(wave_s, p, ssmp);
  xcd_barrier(bar);
  for (int l = 0; l < 2; l++)
    GEMM_BF16_C(memh + (size_t)l * 1024 * 1024, ws + WS_WT + (size_t)l * WT_LAYER + WT_MKV,
              kvb + (size_t)l * 1024 * 2048, 1024, 2048, (int)((blockIdx.x + gridDim.x - 32u * (unsigned)l) % gridDim.x));

#pragma nounroll
  for (int l = 0; l < 2; l++) {
    const float* xcur = (l == 0) ? karg_in(0) : xw;
    const float* sp = ssmp + (size_t)l * SSMP_PER_LAYER;
    const unsigned char* wl = ws + WS_WT + (size_t)l * WT_LAYER;
    if (l == 0) {
      rms_rows<true>(wave_s, xcur, karg_in(2) + l * DM, xn, NT);
      xcd_barrier(bar);
    }
    GEMM_BF16(xn, wl + WT_IN, big, NT, DIN);
    xcd_barrier(bar);
    if (l == 0) vt_phase(wave_s, kvb, vT);
    ssm_chunk_end(wave_s, sp, big, ssmE);
    attn_phase(wave_s, p, l, big, y, smem);
    conv_phase(wave_s, p, l, big, y, smem);
    xcd_barrier(bar);
    ssm_finish(wave_s, p, l, sp, big, ssmE, y, smem);
    xcd_barrier(bar);
    GEMM_F32RN(y, wl + WT_OUT, xw, xcur, xn, karg_in(20) + l * DM, rst);
    xcd_barrier(bar);
    GEMM_BF16S(xn, wl + WT_MQ, big, DM, rst);
    xcd_barrier(bar);
    memattn_phase(wave_s, big, kvb + (size_t)l * 1024 * 2048, vT + (size_t)l * 4 * 4 * 256 * 256, y);
    xcd_barrier(bar);
    GEMM_F32RN(y, wl + WT_MO, xw, (const float*)xw, xn, karg_in(25) + l * DM, rst);
    xcd_barrier(bar);
    GEMM_BF16S(xn, wl + WT_PQ, big, 2048, rst);
    xcd_barrier(bar);
    peer_topk(wave_s, big, skb + (size_t)l * 8 * 2 * 128 * 128, ids, gates);
    xcd_barrier(bar);
    if (l == 0) {
      peer_gather<false>(wave_s, xn, rst, ub + (size_t)l * 16384 * DM, vb + (size_t)l * 16384 * DM, ids, gates, xw, karg_in(2) + DM, (float*)nullptr);
      xcd_barrier(bar);
    } else {
      peer_gather<true>(wave_s, xn, rst, ub + (size_t)l * 16384 * DM, vb + (size_t)l * 16384 * DM, ids, gates, xw, karg_in(30), p.out);
    }
  }
}

extern "C" void kernel_launch(void* const* d_in, const int* in_sizes, int n_in,
                              void* d_out, int out_size, void* d_ws, size_t ws_size,
                              hipStream_t stream) {
  static int grid_blocks = 0;
  if (!grid_blocks) {
    int dev = 0, cus = 0, per_cu = 0;
    (void)hipGetDevice(&dev);
    (void)hipDeviceGetAttribute(&cus, hipDeviceAttributeMultiprocessorCount, dev);
    (void)hipFuncSetAttribute((const void*)fwd_megakernel, hipFuncAttributeMaxDynamicSharedMemorySize, LDS_BYTES);
    (void)hipOccupancyMaxActiveBlocksPerMultiprocessor(&per_cu, fwd_megakernel, NWAVES * 64, LDS_BYTES);
    if (per_cu < 1) fprintf(stderr, "occupancy query reports %d blocks/CU\n", per_cu);
    grid_blocks = cus;
  }
  (void)hipMemsetAsync((char*)d_ws + WS_CTL, 0, 1 * MiB, stream);
  Params p{};
  for (int i = 0; i < 31; i++) p.in[i] = (const float*)d_in[i];
  p.out = (float*)d_out;
  p.ws = (unsigned char*)d_ws;
  void* args[] = {&p};
  hipError_t e = hipLaunchCooperativeKernel((void*)fwd_megakernel, dim3(grid_blocks), dim3(NWAVES * 64),
                                            args, LDS_BYTES, stream);
  if (e != hipSuccess)
    fprintf(stderr, "cooperative launch failed: %s (grid %d)\n", hipGetErrorString(e), grid_blocks);
}
```

```cpp
#include <hip/hip_runtime.h>
#include <hip/hip_cooperative_groups.h>
#include <cstdio>
namespace cg = cooperative_groups;

#define NT 16384
#define SEQ 4096
#define DM 1024
#define DIN 2304
#define NMEM 256
#define EPSF 1e-6f
#define NWAVES 8
#define LDS_BYTES 147456

typedef unsigned short bf16;
#define LAS __attribute__((address_space(3)))

struct Params {
  const float* in[31];
  float* out;
  unsigned char* ws;
};
typedef __attribute__((address_space(4))) const unsigned char* kaptr_t;
__device__ __forceinline__ const float* karg_in(int i) {
  kaptr_t ka = (kaptr_t)__builtin_amdgcn_kernarg_segment_ptr();
  asm volatile("" : "+s"(ka));
  return *(const float* __attribute__((address_space(4))) const*)(ka + 8 * i);
}

constexpr size_t MiB = 1u << 20;
constexpr size_t WS_CTL  = 0;
constexpr size_t WS_WT   = 1 * MiB;
constexpr size_t WT_IN = 0, WT_OUT = WT_IN + (size_t)DIN * DM * 2, WT_MQ = WT_OUT + (size_t)DM * DM * 2,
                 WT_MKV = WT_MQ + (size_t)DM * DM * 2, WT_MO = WT_MKV + (size_t)2048 * DM * 2,
                 WT_PQ = WT_MO + (size_t)DM * DM * 2, WT_GLU = WT_PQ + (size_t)2048 * DM * 2, WT_LAYER = WT_GLU + (size_t)256 * 256 * 2;
constexpr size_t WS_XW   = WS_WT + 2 * WT_LAYER;
constexpr size_t WS_XN   = WS_XW + (size_t)NT * DM * 4;
constexpr size_t WS_BIG  = WS_XN + (size_t)NT * DM * 2;
constexpr size_t WS_Y    = WS_BIG + (size_t)NT * DIN * 2;
constexpr size_t WS_MEMH = WS_Y + (size_t)NT * DM * 2;
constexpr size_t WS_KVB  = WS_MEMH + (size_t)2 * 1024 * 1024 * 2;
constexpr size_t WS_VT   = WS_KVB + (size_t)2 * 1024 * 2048 * 2;
constexpr size_t WS_SSME = WS_VT + (size_t)2 * 4 * 4 * 256 * 256 * 2;
#define SSMP_PER_LAYER (2048 + 2048 + 32768)
constexpr size_t WS_SSMP = WS_SSME + (size_t)4 * 64 * 16 * 64 * 2 * 4;
constexpr size_t WS_IDS  = WS_SSMP + (size_t)2 * SSMP_PER_LAYER * 4;
constexpr size_t WS_GATE = WS_IDS + (size_t)NT * 128 * 4;
constexpr size_t WS_SKB  = WS_GATE + (size_t)NT * 128 * 4;
constexpr size_t WS_UB   = WS_SKB + (size_t)2 * 8 * 2 * 128 * 128 * 2;
constexpr size_t WS_VB   = WS_UB + (size_t)2 * 16384 * 1024;
constexpr size_t WS_RST  = WS_VB + (size_t)2 * 16384 * 1024;
constexpr size_t WS_END  = WS_RST + (size_t)NT * 16 * 4;
#define U_SCALE 64.0f
#define V_SCALE 8.0f
static_assert(WS_END <= 512 * MiB, "workspace");
static_assert(WT_LAYER % 256 == 0 && WS_SSMP % 16 == 0 && WS_IDS % 16 == 0 && WS_SKB % 256 == 0 && WS_VT % 256 == 0, "align");

__device__ __forceinline__ int opaque_tid(int wave_s) { int v = wave_s * 64 + (int)__builtin_amdgcn_mbcnt_hi(~0u, __builtin_amdgcn_mbcnt_lo(~0u, 0u)); asm volatile("" : "+v"(v)); return v; }
__device__ __forceinline__ unsigned f2bf(float f) { unsigned u = __builtin_bit_cast(unsigned, f); return (u + 0x7fffu + ((u >> 16) & 1u)) >> 16; }
__device__ __forceinline__ unsigned pk2(float lo, float hi) { return f2bf(lo) | (f2bf(hi) << 16); }
__device__ __forceinline__ float bf_lo(unsigned u) { return __builtin_bit_cast(float, u << 16); }
__device__ __forceinline__ float bf_hi(unsigned u) { return __builtin_bit_cast(float, u & 0xffff0000u); }
__device__ __forceinline__ float bf2f(bf16 h) { return __builtin_bit_cast(float, (unsigned)h << 16); }


#define XB_TMO      128
#define XB_XCNT(j)  (256  + 64 * (j))
#define XB_XSUB(j)  (1280 + 64 * (j))
#define XB_XGEN(j)  (2304 + 64 * (j))
#define XB_TOP      3328
#define XB_TOPGEN   3392
#define XCD_BAR_WORDS 3456
#define XB_SPIN_CAP (1u << 22)
__device__ __forceinline__ unsigned xb_ld(unsigned* p)              { return __hip_atomic_load(p, __ATOMIC_RELAXED, __HIP_MEMORY_SCOPE_AGENT); }
__device__ __forceinline__ unsigned xb_add(unsigned* p, unsigned v) { return __hip_atomic_fetch_add(p, v, __ATOMIC_RELAXED, __HIP_MEMORY_SCOPE_AGENT); }
__device__ __forceinline__ unsigned xb_xcc_id() { return (unsigned)__builtin_amdgcn_s_getreg((3 << 11) | 20) & 0xFu; }
#define XB_SPIN(cond, bar) do { unsigned _sp = 0; while (cond) { __builtin_amdgcn_s_sleep(1); \
    if ((++_sp & 255u) == 0u) { if (xb_ld(&(bar)[XB_TMO])) break; if (_sp > XB_SPIN_CAP) { atomicAdd(&(bar)[XB_TMO], 1u); break; } } } } while (0)
struct XcdBarrier { unsigned* bar; unsigned x; volatile LAS unsigned* st; };
__device__ __forceinline__ XcdBarrier xcd_barrier_post(unsigned* bar, volatile LAS unsigned* st) {
    XcdBarrier b; b.bar = bar; b.x = xb_xcc_id(); b.st = st;
    if (threadIdx.x == 0) (void)xb_add(&bar[XB_XCNT(b.x)], 1u);
    return b;
}
__device__ __forceinline__ void xcd_barrier_complete(unsigned* bar, unsigned x, unsigned& nloc, unsigned& nx) {
    const unsigned G = gridDim.x * gridDim.y * gridDim.z;
    unsigned sum, cnt, mine, sp = 0u;
    for (;;) {
        sum = 0u; cnt = 0u; mine = 0u;
#pragma unroll
        for (unsigned j = 0; j < 16; ++j) { const unsigned c = xb_ld(&bar[XB_XCNT(j)]); sum += c; cnt += (c > 0u) ? 1u : 0u; mine = (j == x) ? c : mine; }
        if (sum == G) break;
        __builtin_amdgcn_s_sleep(1);
        if ((++sp & 255u) == 0u) { if (xb_ld(&bar[XB_TMO])) break; if (sp > XB_SPIN_CAP) { atomicAdd(&bar[XB_TMO], 1u); break; } }
    }
    nloc = mine > 0u ? mine : 1u; nx = cnt > 0u ? cnt : 1u;
}
__device__ __forceinline__ void xcd_barrier(const XcdBarrier& b) {
    asm volatile("s_waitcnt vmcnt(0)" ::: "memory");
    __syncthreads();
    if (threadIdx.x == 0) {
        unsigned* bar = b.bar;
        __builtin_amdgcn_s_waitcnt(0);
        unsigned nloc = b.st[0], nx = b.st[1];
        if (nloc == 0u) { xcd_barrier_complete(bar, b.x, nloc, nx); b.st[0] = nloc; b.st[1] = nx; }
        const unsigned old = xb_add(&bar[XB_XSUB(b.x)], 1u);
        const unsigned gen = old / nloc;
        if (old + 1u == (gen + 1u) * nloc) {
            __builtin_amdgcn_fence(__ATOMIC_RELEASE, "agent");
            asm volatile("s_waitcnt vmcnt(0)" ::: "memory");
            const unsigned og = xb_add(&bar[XB_TOP], 1u);
            const unsigned tg = og / nx;
            if (og + 1u == (tg + 1u) * nx) xb_add(&bar[XB_TOPGEN], 1u);
            else XB_SPIN(xb_ld(&bar[XB_TOPGEN]) == tg, bar);
            __builtin_amdgcn_fence(__ATOMIC_ACQUIRE, "agent");
            xb_add(&bar[XB_XGEN(b.x)], 1u);
            asm volatile("s_waitcnt vmcnt(0)" ::: "memory");
        } else {
            XB_SPIN(xb_ld(&bar[XB_XGEN(b.x)]) == gen, bar);
            __builtin_amdgcn_fence(__ATOMIC_ACQUIRE, "agent");
            asm volatile("s_waitcnt vmcnt(0)" ::: "memory");
        }
    }
    __syncthreads();
}

namespace pg8 {
#define PG8_LAS __attribute__((address_space(3)))
typedef unsigned short bf16_t;
typedef short bf16x8 __attribute__((ext_vector_type(8)));
typedef float f32x4 __attribute__((ext_vector_type(4)));
typedef unsigned u32x4 __attribute__((ext_vector_type(4)));
constexpr int BM = 256, BK = 64, HALF = 128, HTB = HALF * BK * 2, STAGE_BYTES = 8 * HTB, NXCD = 8, WGM = 8;
__host__ __device__ __forceinline__ int lds_byte(int r, int c) { const int st = (r >> 4) * 2 + (c >> 5), rr = r & 15, cc = c & 31, ob = rr * 64 + cc * 2; return st * 1024 + (ob ^ (((ob >> 9) & 1) << 5)); }
__host__ __device__ __forceinline__ void stage_rc(int b, int& R, int& C) { const int st = b / 1024, sb = b % 1024, swz = sb ^ (((sb >> 9) & 1) << 5); R = (st >> 1) * 16 + swz / 64; C = (st & 1) * 32 + (swz % 64) / 2; }
__host__ __device__ __forceinline__ int perm32(int rho) { const int n = rho >> 4, i = rho & 15; return 8 * (i >> 2) + 4 * n + (i & 3); }
struct Unit { int pm, pn; };
struct Gemm { const bf16_t* A; const bf16_t* Bt; int M, N, K; };
struct StaticOrder {
    int nM, nN, nwg, G, c;
    __host__ __device__ __forceinline__ void init(int M, int N, int G_, int c_) { nM = M / BM; nN = N / BM; nwg = nM * nN; G = G_; c = c_; }
    __host__ __device__ bool next(int i, Unit& u) const {
        const long L = (long)i * G + c; if (L >= nwg) return false;
        int wgid = (int)L; { const int q = nwg / NXCD, r = nwg % NXCD, xcd = wgid % NXCD, off = wgid / NXCD; wgid = (xcd < r ? xcd * (q + 1) : r * (q + 1) + (xcd - r) * q) + off; }
        const int nig = WGM * nN, gid = wgid / nig, fm = gid * WGM, gsz = (nM - fm) < WGM ? (nM - fm) : WGM;
        u.pm = fm + ((wgid % nig) % gsz); u.pn = (wgid % nig) / gsz; return true;
    }
    __device__ __forceinline__ void a_ready(const Unit&) const {}
    __device__ __forceinline__ void done(const Unit&) const {}
};
__device__ __forceinline__ unsigned cvt_pk_bf16(float lo, float hi) { unsigned r; asm volatile("v_cvt_pk_bf16_f32 %0, %1, %2" : "=v"(r) : "v"(lo), "v"(hi)); return r; }

struct EpiF32R {
    static constexpr bool PERM = false, AFTER_DRAIN = false;
    float* C; const float* R; int ldc;
    __device__ __forceinline__ void operator()(const f32x4 (&acc)[2][2][4][2], const Unit& u, int wr, int wc, int fr, int fq) const {
        const int row0 = u.pm * BM + wr * 64 + fr, col0 = u.pn * BM + wc * 32 + 4 * fq;
#pragma unroll
        for (int ai = 0; ai < 2; ++ai)
#pragma unroll
            for (int m = 0; m < 4; ++m) {
                const size_t ro = (size_t)(row0 + ai * HALF + m * 16) * ldc + col0;
                f32x4 rv[2][2];
#pragma unroll
                for (int bj = 0; bj < 2; ++bj)
#pragma unroll
                    for (int n = 0; n < 2; ++n) rv[bj][n] = R ? *(const f32x4*)(R + ro + bj * HALF + n * 16) : (f32x4){0.f, 0.f, 0.f, 0.f};
#pragma unroll
                for (int bj = 0; bj < 2; ++bj)
#pragma unroll
                    for (int n = 0; n < 2; ++n) *(f32x4*)(C + ro + bj * HALF + n * 16) = acc[ai][bj][m][n] + rv[bj][n];
                __builtin_amdgcn_sched_barrier(0);
            }
    }
};

struct EpiBf16 {
    static constexpr bool PERM = true, AFTER_DRAIN = false;
    bf16_t* O; int ldc;
    __device__ __forceinline__ void operator()(const f32x4 (&acc)[2][2][4][2], const Unit& u, int wr, int wc, int fr, int fq) const {
        const int row0 = u.pm * BM + wr * 64 + fr, col0 = u.pn * BM + wc * 32 + 8 * fq;
#pragma unroll
        for (int ai = 0; ai < 2; ++ai)
#pragma unroll
            for (int m = 0; m < 4; ++m) { bf16_t* rowp = O + (size_t)(row0 + ai * HALF + m * 16) * ldc + col0;
#pragma unroll
                for (int bj = 0; bj < 2; ++bj) { const f32x4 v0 = acc[ai][bj][m][0], v1 = acc[ai][bj][m][1];
                    u32x4 w; w.x = cvt_pk_bf16(v0[0], v0[1]); w.y = cvt_pk_bf16(v0[2], v0[3]); w.z = cvt_pk_bf16(v1[0], v1[1]); w.w = cvt_pk_bf16(v1[2], v1[3]);
                    *(u32x4*)(rowp + bj * HALF) = w; } }
    }
};

struct EpiF32RN {
    static constexpr bool PERM = false, AFTER_DRAIN = false;
    float* C; const float* R; int ldc; bf16_t* XG; const float* g; float* st;
    __device__ __forceinline__ void operator()(const f32x4 (&acc)[2][2][4][2], const Unit& u, int wr, int wc, int fr, int fq) const {
        const int row0 = u.pm * BM + wr * 64 + fr, col0 = u.pn * BM + wc * 32 + 4 * fq;
        f32x4 gv[2][2];
#pragma unroll
        for (int bj = 0; bj < 2; ++bj)
#pragma unroll
            for (int n = 0; n < 2; ++n) gv[bj][n] = *(const f32x4*)(g + col0 + bj * HALF + n * 16);
#pragma unroll
        for (int ai = 0; ai < 2; ++ai)
#pragma unroll
            for (int m = 0; m < 4; ++m) {
                const int row = row0 + ai * HALF + m * 16;
                const size_t ro = (size_t)row * ldc + col0;
                f32x4 rv[2][2];
#pragma unroll
                for (int bj = 0; bj < 2; ++bj)
#pragma unroll
                    for (int n = 0; n < 2; ++n) rv[bj][n] = *(const f32x4*)(R + ro + bj * HALF + n * 16);
                float ss = 0.f;
#pragma unroll
                for (int bj = 0; bj < 2; ++bj)
#pragma unroll
                    for (int n = 0; n < 2; ++n) {
                        const f32x4 v = acc[ai][bj][m][n] + rv[bj][n];
                        *(f32x4*)(C + ro + bj * HALF + n * 16) = v;
                        ss += (v[0] * v[0] + v[1] * v[1]) + (v[2] * v[2] + v[3] * v[3]);
                        const f32x4 w = v * gv[bj][n];
                        uint2 pk; pk.x = cvt_pk_bf16(w[0], w[1]); pk.y = cvt_pk_bf16(w[2], w[3]);
                        *(uint2*)(XG + ro + bj * HALF + n * 16) = pk;
                    }
                ss += __shfl_xor(ss, 16, 64); ss += __shfl_xor(ss, 32, 64);
                if (fq == 0) st[(size_t)row * 16 + u.pn * 4 + wc] = ss;
                __builtin_amdgcn_sched_barrier(0);
            }
    }
};
struct EpiBf16S {
    static constexpr bool PERM = true, AFTER_DRAIN = false;
    bf16_t* O; int ldc; const float* st;
    __device__ __forceinline__ void operator()(const f32x4 (&acc)[2][2][4][2], const Unit& u, int wr, int wc, int fr, int fq) const {
        const int row0 = u.pm * BM + wr * 64 + fr, col0 = u.pn * BM + wc * 32 + 8 * fq;
#pragma unroll
        for (int ai = 0; ai < 2; ++ai)
#pragma unroll
            for (int m = 0; m < 4; ++m) {
                const int row = row0 + ai * HALF + m * 16;
                const f32x4* sp = (const f32x4*)(st + (size_t)row * 16);
                const f32x4 s0 = sp[0], s1 = sp[1], s2 = sp[2], s3 = sp[3];
                const f32x4 sa = (s0 + s1) + (s2 + s3);
                const float rs = __builtin_amdgcn_rsqf(((sa[0] + sa[1]) + (sa[2] + sa[3])) * (1.0f / 1024.f) + 1e-6f);
                bf16_t* rowp = O + (size_t)row * ldc + col0;
#pragma unroll
                for (int bj = 0; bj < 2; ++bj) { const f32x4 v0 = acc[ai][bj][m][0] * rs, v1 = acc[ai][bj][m][1] * rs;
                    u32x4 w; w.x = cvt_pk_bf16(v0[0], v0[1]); w.y = cvt_pk_bf16(v0[2], v0[3]); w.z = cvt_pk_bf16(v1[0], v1[1]); w.w = cvt_pk_bf16(v1[2], v1[3]);
                    *(u32x4*)(rowp + bj * HALF) = w; }
                __builtin_amdgcn_sched_barrier(0);
            }
    }
};

template <class Epi, class Sched, bool ALIGN_EPI = false, bool SP2 = false>
__device__ __forceinline__ void gemm_phase(const int wave_s, PG8_LAS unsigned char* lds, const Gemm g, const Sched& S, const Epi& E) {
    const int tid = opaque_tid(wave_s), wid = __builtin_amdgcn_readfirstlane(tid >> 6), lane = tid & 63, wr = wid >> 2, wc = wid & 3, fr = lane & 15, fq = lane >> 4;
    const int K = g.K, nt = K / BK;
    unsigned voffA[2], voffB[2];
#pragma unroll
    for (int i = 0; i < 2; ++i) { int R, C; stage_rc(tid * 16 + i * 8192, R, C); const int Rb = Epi::PERM ? ((R & ~31) + perm32(R & 31)) : R;
        voffA[i] = (unsigned)(R * K + C) * 2u; voffB[i] = (unsigned)(Rb * K + C) * 2u; }
    const size_t kstep = (size_t)(BK * 2);
    const size_t hstep = (size_t)HALF * K * 2;
    const size_t tstep = 2 * hstep;
    const unsigned ldsw = (unsigned)wid * 1024u;
    const int aoff = lds_byte(wr * 64 + fr, fq * 8), boff = lds_byte(wc * 32 + fr, fq * 8);
#define PG8_SA(b, h) (((b) * 2 + (h)) * HTB)
#define PG8_SB(b, h) ((4 + (b) * 2 + (h)) * HTB)
#define PG8_STAGE(bufoff, gbase, voff) do { _Pragma("unroll") for (int _i = 0; _i < 2; ++_i) \
        __builtin_amdgcn_global_load_lds((const unsigned*)((const char*)(gbase) + (voff)[_i]), (PG8_LAS unsigned*)(lds + (bufoff) + ldsw + _i * 8192), 16, 0, 0); } while (0)
#define PG8_LDA(dst, b, h) do { _Pragma("unroll") for (int m = 0; m < 4; ++m) _Pragma("unroll") for (int k = 0; k < 2; ++k) dst[m][k] = *(const PG8_LAS bf16x8*)(lds + PG8_SA(b, h) + aoff + m * 2048 + k * 1024); } while (0)
#define PG8_LDB(dst, b, h) do { _Pragma("unroll") for (int n = 0; n < 2; ++n) _Pragma("unroll") for (int k = 0; k < 2; ++k) dst[n][k] = *(const PG8_LAS bf16x8*)(lds + PG8_SB(b, h) + boff + n * 2048 + k * 1024); } while (0)
#define PG8_MMA(ai, bj, At, Bt) do { __builtin_amdgcn_s_setprio(1); _Pragma("unroll") for (int m = 0; m < 4; ++m) _Pragma("unroll") for (int n = 0; n < 2; ++n) _Pragma("unroll") for (int k = 0; k < 2; ++k) \
        acc[ai][bj][m][n] = __builtin_amdgcn_mfma_f32_16x16x32_bf16(Bt[n][k], At[m][k], acc[ai][bj][m][n], 0, 0, 0); __builtin_amdgcn_s_setprio(0); } while (0)
#define PG8_WAIT_V(n) asm volatile("s_waitcnt vmcnt(" #n ")" ::: "memory")
#define PG8_WAIT_L(n) asm volatile("s_waitcnt lgkmcnt(" #n ")" ::: "memory")
#define PG8_BAR __builtin_amdgcn_s_barrier()
#define PG8_SCHED __builtin_amdgcn_sched_barrier(0)
    Unit cur, nxt; int ui = 0;
    if (!S.next(0, cur)) return;
    f32x4 acc[2][2][4][2];
#pragma unroll
    for (int a = 0; a < 2; ++a)
#pragma unroll
        for (int b = 0; b < 2; ++b)
#pragma unroll
            for (int m = 0; m < 4; ++m)
#pragma unroll
                for (int n = 0; n < 2; ++n) acc[a][b][m][n] = (f32x4){0.f, 0.f, 0.f, 0.f};
    bf16x8 At[4][2], B0[2][2], B1[2][2];
    const char* cA = (const char*)g.A + (size_t)cur.pm * tstep; const char* cB = (const char*)g.Bt + (size_t)cur.pn * tstep;
    S.a_ready(cur);
    if constexpr (SP2) {
        PG8_STAGE(PG8_SB(0, 0), cB, voffB); PG8_STAGE(PG8_SB(0, 1), cB + hstep, voffB); PG8_STAGE(PG8_SA(0, 0), cA, voffA); PG8_STAGE(PG8_SA(0, 1), cA + hstep, voffA);
        if (wr == 1) PG8_BAR;
        PG8_WAIT_V(2); PG8_BAR;
        PG8_STAGE(PG8_SB(1, 0), cB + kstep, voffB); PG8_STAGE(PG8_SA(1, 0), cA + kstep, voffA); PG8_STAGE(PG8_SB(1, 1), cB + hstep + kstep, voffB);
        PG8_WAIT_V(6); PG8_BAR;
    } else {
        PG8_STAGE(PG8_SB(0, 0), cB, voffB); PG8_STAGE(PG8_SA(0, 0), cA, voffA); PG8_STAGE(PG8_SB(0, 1), cB + hstep, voffB); PG8_STAGE(PG8_SA(0, 1), cA + hstep, voffA);
        if (wr == 1) PG8_BAR;
        PG8_WAIT_V(4); PG8_BAR;
        PG8_STAGE(PG8_SB(1, 0), cB + kstep, voffB); PG8_STAGE(PG8_SA(1, 0), cA + kstep, voffA); PG8_STAGE(PG8_SB(1, 1), cB + hstep + kstep, voffB);
        PG8_WAIT_V(6); PG8_BAR;
    }
    for (;;) {
        const bool has_next = S.next(ui + 1, nxt);
        const char* nA = has_next ? (const char*)g.A + (size_t)nxt.pm * tstep : cA; const char* nB = has_next ? (const char*)g.Bt + (size_t)nxt.pn * tstep : cB;
        for (int t = 0; t < nt; t += 2) {
            const bool last = (t == nt - 2);
            const char* a1 = cA + (size_t)(t + 1) * kstep;
            const char* a2 = last ? nA : cA + (size_t)(t + 2) * kstep; const char* b2 = last ? nB : cB + (size_t)(t + 2) * kstep;
            const char* a3 = a2 + kstep; const char* b3 = b2 + kstep;
            if (last && has_next) S.a_ready(nxt);
            if constexpr (SP2) {
            PG8_LDB(B0, 0, 0); PG8_LDB(B1, 0, 1); PG8_SCHED; PG8_LDA(At, 0, 0); PG8_STAGE(PG8_SA(1, 1), a1 + hstep, voffA);
            PG8_WAIT_V(8); PG8_WAIT_L(0); PG8_BAR; PG8_MMA(0, 0, At, B0); PG8_MMA(0, 1, At, B1); PG8_BAR; PG8_SCHED;
            PG8_LDA(At, 0, 1); PG8_STAGE(PG8_SB(0, 0), b2, voffB); PG8_STAGE(PG8_SB(0, 1), b2 + hstep, voffB); PG8_STAGE(PG8_SA(0, 0), a2, voffA);
            PG8_WAIT_V(8); PG8_WAIT_L(0); PG8_BAR; PG8_MMA(1, 0, At, B0); PG8_MMA(1, 1, At, B1); PG8_BAR; PG8_SCHED;
            PG8_LDB(B0, 1, 0); PG8_LDB(B1, 1, 1); PG8_SCHED; PG8_LDA(At, 1, 0); PG8_STAGE(PG8_SA(0, 1), a2 + hstep, voffA);
            PG8_WAIT_V(8); PG8_WAIT_L(0); PG8_BAR; PG8_MMA(0, 0, At, B0); PG8_MMA(0, 1, At, B1); PG8_BAR; PG8_SCHED;
            PG8_LDA(At, 1, 1); PG8_STAGE(PG8_SB(1, 0), b3, voffB); PG8_STAGE(PG8_SB(1, 1), b3 + hstep, voffB); PG8_STAGE(PG8_SA(1, 0), a3, voffA);
            PG8_WAIT_V(8); PG8_WAIT_L(0); PG8_BAR; PG8_MMA(1, 0, At, B0); PG8_MMA(1, 1, At, B1); PG8_BAR; PG8_SCHED;
            } else {
            PG8_LDB(B0, 0, 0); PG8_SCHED; PG8_LDA(At, 0, 0); PG8_STAGE(PG8_SA(1, 1), a1 + hstep, voffA);
            PG8_WAIT_L(8); PG8_BAR; PG8_WAIT_L(0); PG8_MMA(0, 0, At, B0); PG8_BAR; PG8_SCHED;
            PG8_LDB(B1, 0, 1); PG8_STAGE(PG8_SB(0, 0), b2, voffB);
            PG8_BAR; PG8_WAIT_L(0); PG8_MMA(0, 1, At, B1); PG8_BAR;
            PG8_LDA(At, 0, 1); PG8_STAGE(PG8_SA(0, 0), a2, voffA);
            PG8_BAR; PG8_WAIT_L(0); PG8_MMA(1, 0, At, B0); PG8_BAR; PG8_SCHED;
            PG8_STAGE(PG8_SB(0, 1), b2 + hstep, voffB);
            PG8_WAIT_V(6); PG8_BAR; PG8_MMA(1, 1, At, B1); PG8_BAR;
            PG8_LDB(B0, 1, 0); PG8_SCHED; PG8_LDA(At, 1, 0); PG8_STAGE(PG8_SA(0, 1), a2 + hstep, voffA);
            PG8_WAIT_L(8); PG8_BAR; PG8_WAIT_L(0); PG8_MMA(0, 0, At, B0); PG8_BAR; PG8_SCHED;
            PG8_LDB(B1, 1, 1); PG8_STAGE(PG8_SB(1, 0), b3, voffB);
            PG8_BAR; PG8_WAIT_L(0); PG8_MMA(0, 1, At, B1); PG8_BAR;
            PG8_LDA(At, 1, 1); PG8_STAGE(PG8_SA(1, 0), a3, voffA);
            PG8_BAR; PG8_WAIT_L(0); PG8_MMA(1, 0, At, B0); PG8_BAR; PG8_SCHED;
            PG8_STAGE(PG8_SB(1, 1), b3 + hstep, voffB);
            PG8_WAIT_V(6); PG8_BAR; PG8_MMA(1, 1, At, B1); PG8_BAR;
            }
        }
        if constexpr (ALIGN_EPI) { if (wr == 0) PG8_BAR; }
        if constexpr (!Epi::AFTER_DRAIN) { E(acc, cur, wr, wc, fr, fq); S.done(cur); }
        if (!has_next) break;
#pragma unroll
        for (int a = 0; a < 2; ++a)
#pragma unroll
            for (int b = 0; b < 2; ++b)
#pragma unroll
                for (int m = 0; m < 4; ++m)
#pragma unroll
                    for (int n = 0; n < 2; ++n) acc[a][b][m][n] = (f32x4){0.f, 0.f, 0.f, 0.f};
        cur = nxt; cA = nA; cB = nB; ++ui;
        if constexpr (ALIGN_EPI) { if (wr == 1) PG8_BAR; }
    }
    PG8_WAIT_V(0);
    if constexpr (!ALIGN_EPI) { if (wr == 0) PG8_BAR; }
    PG8_BAR;
#undef PG8_SA
#undef PG8_SB
#undef PG8_STAGE
#undef PG8_LDA
#undef PG8_LDB
#undef PG8_MMA
#undef PG8_WAIT_V
#undef PG8_WAIT_L
#undef PG8_BAR
#undef PG8_SCHED
}
}

__device__ __forceinline__ void transpose_item(const float* W, int K, int N, bf16* WT, LAS float* scr, int item, int lane) {
    const int nblk = N / 32, kb = item / nblk, nb = item % nblk, k0 = 64 * kb, n0 = 32 * nb;
#pragma unroll 8
    for (int i = 0; i < 32; ++i) { const int kk = 2 * i + (lane >> 5); scr[kk * 33 + (lane & 31)] = W[(size_t)(k0 + kk) * N + n0 + (lane & 31)]; }
    asm volatile("s_waitcnt lgkmcnt(0)" ::: "memory");
    const int c = lane & 7;
#pragma unroll
    for (int j = 0; j < 4; ++j) { const int n = (lane >> 3) + 8 * j; const LAS float* s = scr + (8 * c) * 33 + n;
        uint4 o; o.x = pk2(s[0 * 33], s[1 * 33]); o.y = pk2(s[2 * 33], s[3 * 33]); o.z = pk2(s[4 * 33], s[5 * 33]); o.w = pk2(s[6 * 33], s[7 * 33]);
        *(uint4*)(WT + (size_t)(n0 + n) * K + k0 + 8 * c) = o; }
    asm volatile("s_waitcnt lgkmcnt(0)" ::: "memory");
}

__device__ __forceinline__ float wsum(float v) {
#pragma unroll
  for (int o = 32; o > 0; o >>= 1) v += __shfl_xor(v, o, 64);
  return v;
}
__device__ __forceinline__ float wmaxf(float v) {
#pragma unroll
  for (int o = 32; o > 0; o >>= 1) v = fmaxf(v, __shfl_xor(v, o, 64));
  return v;
}
__device__ __forceinline__ float sigmoidf_(float x) { return 1.0f / (1.0f + expf(-x)); }
__device__ __forceinline__ float gelu_tanh(float x) {
  return 0.5f * x * (1.0f + tanhf(0.7978845608028654f * (x + 0.044715f * x * x * x)));
}

template <bool BF16OUT>
__device__ __forceinline__ void rms_rows(const int wave_s, const float* src, const float* g, void* dstv, int rows) {
  const int tid_ = opaque_tid(wave_s);
  const int lane = tid_ & 63;
  const int gw = blockIdx.x * NWAVES + (tid_ >> 6);
  const int nw = gridDim.x * NWAVES;
  for (int r = gw; r < rows; r += nw) {
    const float4* s4 = (const float4*)(src + (size_t)r * DM);
    float4 v[4];
    float ss = 0.f;
#pragma unroll
    for (int i = 0; i < 4; i++) {
      v[i] = s4[lane + i * 64];
      ss += v[i].x * v[i].x + v[i].y * v[i].y + v[i].z * v[i].z + v[i].w * v[i].w;
    }
    ss = wsum(ss);
    const float rstd = rsqrtf(ss * (1.0f / DM) + EPSF);
    const float4* g4 = (const float4*)g;
#pragma unroll
    for (int i = 0; i < 4; i++) {
      float4 gg = g4[lane + i * 64];
      float4 o;
      o.x = v[i].x * rstd * gg.x; o.y = v[i].y * rstd * gg.y;
      o.z = v[i].z * rstd * gg.z; o.w = v[i].w * rstd * gg.w;
      if (BF16OUT) {
        uint2 pk; pk.x = pk2(o.x, o.y); pk.y = pk2(o.z, o.w);
        ((uint2*)((bf16*)dstv + (size_t)r * DM))[lane + i * 64] = pk;
      } else {
        ((float4*)((float*)dstv + (size_t)r * DM))[lane + i * 64] = o;
      }
    }
  }
}

__device__ __forceinline__ void ssm_params(const int wave_s, const Params& p, float* ssmp_all) {
  const int tid_ = opaque_tid(wave_s);
  const float* in8 = karg_in(8); const float* in9 = karg_in(9); const float* in10 = karg_in(10);
  const float* in11 = karg_in(11); const float* in12 = karg_in(12);
  const int gt = blockIdx.x * blockDim.x + tid_;
  const int nth = gridDim.x * blockDim.x;
  for (int i = gt; i < 2 * 16 * 64; i += nth) {
    const int l = i / 1024, gp = i % 1024, g = gp / 64;
    float* sp = ssmp_all + (size_t)l * SSMP_PER_LAYER;
    const float lre = fminf(in8[l * 1024 + gp], -1e-4f);
    const float lim = in9[l * 1024 + gp];
    const float dt = expf(in10[l * 16 + g]);
    const float er = expf(lre * dt);
    float sn, cs;
    sincosf(lim * dt, &sn, &cs);
    const float br = er * cs, bi = er * sn;
    sp[gp * 2 + 0] = br;
    sp[gp * 2 + 1] = bi;
    float cr = br, ci = bi;
#pragma unroll
    for (int s = 0; s < 6; s++) {
      const float nr = cr * cr - ci * ci, ni = 2.f * cr * ci;
      cr = nr; ci = ni;
    }
    sp[2048 + gp * 2 + 0] = cr;
    sp[2048 + gp * 2 + 1] = ci;
    const float nr = br - 1.0f, ni = bi;
    const float den = lre * lre + lim * lim;
    const float fr = (nr * lre + ni * lim) / den;
    const float fi = (ni * lre - nr * lim) / den;
    for (int h = 0; h < 16; h++) {
      const float bre = in11[((size_t)l * 1024 + gp) * 16 + h];
      const float bim = in12[((size_t)l * 1024 + gp) * 16 + h];
      sp[4096 + ((g * 16 + h) * 64 + (gp & 63)) * 2 + 0] = fr * bre - fi * bim;
      sp[4096 + ((g * 16 + h) * 64 + (gp & 63)) * 2 + 1] = fr * bim + fi * bre;
    }
  }
}

__device__ __forceinline__ void conv_phase(const int wave_s, const Params& p, int l, const bf16* proj, bf16* y, LAS float* smem) {
  const int tid_ = opaque_tid(wave_s);
  const int lane = tid_ & 63;
  const int gw = blockIdx.x * NWAVES + (tid_ >> 6);
  const int nw = gridDim.x * NWAVES;
  const float* cw = karg_in(4) + (size_t)l * 31 * 256;
  const float4 cb = ((const float4*)(karg_in(5) + l * 256))[lane];
  const float4 lg = ((const float4*)(karg_in(6) + l * 256))[lane];
  const float4 lb = ((const float4*)(karg_in(7) + l * 256))[lane];
  const float4 gg = ((const float4*)(karg_in(18) + l * 1024))[lane];
  LAS float* cwl = smem + 1024;
  for (int i = tid_; i < 31 * 256 / 4; i += NWAVES * 64) *(LAS pg8::f32x4*)(cwl + 4 * i) = *(const pg8::f32x4*)(cw + 4 * i);
  __syncthreads();
  for (int it = gw; it < NT / 8; it += nw) {
    const int tok0 = it * 8;
    const int t0 = tok0 & (SEQ - 1);
    float4 acc[8];
#pragma unroll
    for (int o = 0; o < 8; o++) acc[o] = cb;
#pragma unroll
    for (int i = 0; i < 38; i++) {
      if (t0 - 30 + i >= 0) {
        const bf16* row = proj + (size_t)(tok0 - 30 + i) * DIN;
        const uint2 vp = ((const uint2*)row)[lane];
        const uint2 gp = ((const uint2*)(row + 256))[lane];
        float4 g4;
        g4.x = bf_lo(vp.x) * sigmoidf_(bf_lo(gp.x)); g4.y = bf_hi(vp.x) * sigmoidf_(bf_hi(gp.x));
        g4.z = bf_lo(vp.y) * sigmoidf_(bf_lo(gp.y)); g4.w = bf_hi(vp.y) * sigmoidf_(bf_hi(gp.y));
#pragma unroll
        for (int o = 0; o < 8; o++) {
          const int j = i - o;
          if (j >= 0 && j <= 30) {
            const pg8::f32x4 w4 = *(const LAS pg8::f32x4*)(cwl + j * 256 + lane * 4);
            acc[o].x += g4.x * w4[0]; acc[o].y += g4.y * w4[1];
            acc[o].z += g4.z * w4[2]; acc[o].w += g4.w * w4[3];
          }
        }
      }
    }
#pragma unroll
    for (int o = 0; o < 8; o++) {
      const float4 a = acc[o];
      const float mean = wsum(a.x + a.y + a.z + a.w) * (1.0f / 256.f);
      const float dx = a.x - mean, dy = a.y - mean, dz = a.z - mean, dw = a.w - mean;
      const float var = wsum(dx * dx + dy * dy + dz * dz + dw * dw) * (1.0f / 256.f);
      const float rs = rsqrtf(var + EPSF);
      float4 s;
      s.x = dx * rs * lg.x + lb.x; s.y = dy * rs * lg.y + lb.y;
      s.z = dz * rs * lg.z + lb.z; s.w = dw * rs * lg.w + lb.w;
      s.x = s.x * sigmoidf_(s.x); s.y = s.y * sigmoidf_(s.y);
      s.z = s.z * sigmoidf_(s.z); s.w = s.w * sigmoidf_(s.w);
      const float ss = wsum(s.x * s.x + s.y * s.y + s.z * s.z + s.w * s.w) * (1.0f / 256.f);
      const float r2 = rsqrtf(ss + EPSF);
      uint2 pk; pk.x = pk2(s.x * r2 * gg.x, s.y * r2 * gg.y); pk.y = pk2(s.z * r2 * gg.z, s.w * r2 * gg.w);
      ((uint2*)(y + (size_t)(tok0 + o) * DM))[lane] = pk;
    }
  }
}

typedef short bf16x8_t __attribute__((ext_vector_type(8)));
typedef float f32x16_t __attribute__((ext_vector_type(16)));
#define MFMA_PAD() do { __builtin_amdgcn_sched_barrier(0); asm volatile("s_nop 15\n\ts_nop 15" ::: "memory"); __builtin_amdgcn_sched_barrier(0); } while (0)

__device__ __forceinline__ void attn_phase(const int wave_s, const Params& p, int l, const bf16* proj, bf16* y, LAS float* smem) {
  const int tid = opaque_tid(wave_s), lane = tid & 63, wave = tid >> 6;
  const int n = lane & 31, hh = lane >> 5;
  const float* gg = karg_in(18) + l * 1024 + 256 + wave * 64;
  const float g0 = gg[n], g1 = gg[32 + n];
  LAS float* ssq = smem;
  LAS float* rstd = smem + 256;
  for (int item = blockIdx.x; item < 4 * 128; item += gridDim.x) {
    const int b = item >> 7, q0 = (item & 127) * 32;
    const size_t tokb = (size_t)b * SEQ;
    bf16x8_t qf[4];
    {
      const bf16* qrow = proj + (tokb + q0 + n) * DIN + 512 + wave * 64 + 8 * hh;
#pragma unroll
      for (int ks = 0; ks < 4; ks++) qf[ks] = *(const bf16x8_t*)(qrow + 16 * ks);
    }
    f32x16_t o0, o1;
#pragma unroll
    for (int r = 0; r < 16; r++) { o0[r] = 0.f; o1[r] = 0.f; }
    float R = 0.f;
    for (int kt = q0; kt >= 0; kt -= 32) {
      bf16x8_t kf[4];
      {
        const bf16* krow = proj + (tokb + kt + n) * DIN + 1024 + wave * 64 + 8 * hh;
#pragma unroll
        for (int ks = 0; ks < 4; ks++) kf[ks] = *(const bf16x8_t*)(krow + 16 * ks);
      }
      bf16x8_t vf0[2], vf1[2];
      {
        const bf16* vb = proj + (tokb + kt + 4 * hh) * DIN + 1536 + wave * 64 + n;
#pragma unroll
        for (int s = 0; s < 2; s++)
#pragma unroll
          for (int j = 0; j < 8; j++) {
            const int key = 16 * s + 8 * (j >> 2) + (j & 3);
            vf0[s][j] = (short)vb[(size_t)key * DIN];
            vf1[s][j] = (short)vb[(size_t)key * DIN + 32];
          }
      }
      f32x16_t sacc;
#pragma unroll
      for (int r = 0; r < 16; r++) sacc[r] = 0.f;
      __builtin_amdgcn_sched_barrier(0); asm volatile("s_nop 15\n\ts_nop 15" ::: "memory"); __builtin_amdgcn_sched_barrier(0);
#pragma unroll
      for (int ks = 0; ks < 4; ks++) sacc = __builtin_amdgcn_mfma_f32_32x32x16_bf16(kf[ks], qf[ks], sacc, 0, 0, 0);
      __builtin_amdgcn_sched_barrier(0); asm volatile("s_nop 15\n\ts_nop 15" ::: "memory"); __builtin_amdgcn_sched_barrier(0);
      float lst[16], lsz[16];
      const bool diag = (kt == q0);
#pragma unroll
      for (int r = 0; r < 16; r++) {
        const float z = sacc[r] * 0.125f;
        const float sp = __logf(1.0f + __expf(-fabsf(z)));
        float a = fminf(z, 0.f) - sp;
        float c = -(fmaxf(z, 0.f) + sp);
        if (diag) {
          const int key = (r & 3) + 8 * (r >> 2) + 4 * hh;
          if (key >= n) { a = -1.0e30f; c = 0.f; }
        }
        lsz[r] = a; lst[r] = c;
      }
      float Gs[4], Gp[4];
#pragma unroll
      for (int g = 0; g < 4; g++) {
        Gs[g] = (lst[4 * g] + lst[4 * g + 1]) + (lst[4 * g + 2] + lst[4 * g + 3]);
        Gp[g] = __shfl_xor(Gs[g], 32, 64);
      }
      float carry[4];
      {
        float after = R;
#pragma unroll
        for (int g = 3; g >= 0; g--) {
          carry[g] = after + (hh ? 0.f : Gp[g]);
          after += Gs[g] + Gp[g];
        }
        R = after;
      }
      bf16x8_t pf[2];
#pragma unroll
      for (int g = 0; g < 4; g++) {
        float run = carry[g];
        float a3 = __expf(lsz[4 * g + 3] + run); run += lst[4 * g + 3];
        float a2 = __expf(lsz[4 * g + 2] + run); run += lst[4 * g + 2];
        float a1 = __expf(lsz[4 * g + 1] + run); run += lst[4 * g + 1];
        float a0 = __expf(lsz[4 * g + 0] + run);
        const int s = g >> 1, jb = (g & 1) * 4;
        pf[s][jb + 0] = (short)f2bf(a0); pf[s][jb + 1] = (short)f2bf(a1);
        pf[s][jb + 2] = (short)f2bf(a2); pf[s][jb + 3] = (short)f2bf(a3);
      }
      __builtin_amdgcn_sched_barrier(0); asm volatile("s_nop 15\n\ts_nop 15" ::: "memory"); __builtin_amdgcn_sched_barrier(0);
#pragma unroll
      for (int s = 0; s < 2; s++) {
        o0 = __builtin_amdgcn_mfma_f32_32x32x16_bf16(pf[s], vf0[s], o0, 0, 0, 0);
        o1 = __builtin_amdgcn_mfma_f32_32x32x16_bf16(pf[s], vf1[s], o1, 0, 0, 0);
      }
      __builtin_amdgcn_sched_barrier(0); asm volatile("s_nop 15\n\ts_nop 15" ::: "memory"); __builtin_amdgcn_sched_barrier(0);
      if (__all(R < -110.f)) break;
    }
    float sq[16];
#pragma unroll
    for (int r = 0; r < 16; r++) {
      float v = o0[r] * o0[r] + o1[r] * o1[r];
#pragma unroll
      for (int o = 16; o > 0; o >>= 1) v += __shfl_xor(v, o, 64);
      sq[r] = v;
    }
    __syncthreads();
    if (n == 0) {
#pragma unroll
      for (int r = 0; r < 16; r++) ssq[wave * 32 + (r & 3) + 8 * (r >> 2) + 4 * hh] = sq[r];
    }
    __syncthreads();
    if (tid < 32) {
      float t = 0.f;
#pragma unroll
      for (int w = 0; w < 8; w++) t += ssq[w * 32 + tid];
      rstd[tid] = rsqrtf(t * (1.0f / 512.f) + EPSF);
    }
    __syncthreads();
#pragma unroll
    for (int r = 0; r < 16; r++) {
      const int qi = (r & 3) + 8 * (r >> 2) + 4 * hh;
      const float rs = rstd[qi];
      bf16* yr = y + (tokb + q0 + qi) * DM + 256 + wave * 64 + n;
      yr[0] = (bf16)f2bf(o0[r] * rs * g0);
      yr[32] = (bf16)f2bf(o1[r] * rs * g1);
    }
  }
}

#define SSM_BCAST_U(u, ua, ub, tt) do { \
    const unsigned w0 = (unsigned)__builtin_amdgcn_readlane((int)(ua).x, (tt)), w1 = (unsigned)__builtin_amdgcn_readlane((int)(ua).y, (tt)); \
    const unsigned w2 = (unsigned)__builtin_amdgcn_readlane((int)(ua).z, (tt)), w3 = (unsigned)__builtin_amdgcn_readlane((int)(ua).w, (tt)); \
    const unsigned w4 = (unsigned)__builtin_amdgcn_readlane((int)(ub).x, (tt)), w5 = (unsigned)__builtin_amdgcn_readlane((int)(ub).y, (tt)); \
    const unsigned w6 = (unsigned)__builtin_amdgcn_readlane((int)(ub).z, (tt)), w7 = (unsigned)__builtin_amdgcn_readlane((int)(ub).w, (tt)); \
    (u)[0] = bf_lo(w0); (u)[1] = bf_hi(w0); (u)[2] = bf_lo(w1); (u)[3] = bf_hi(w1); (u)[4] = bf_lo(w2); (u)[5] = bf_hi(w2); (u)[6] = bf_lo(w3); (u)[7] = bf_hi(w3); \
    (u)[8] = bf_lo(w4); (u)[9] = bf_hi(w4); (u)[10] = bf_lo(w5); (u)[11] = bf_hi(w5); (u)[12] = bf_lo(w6); (u)[13] = bf_hi(w6); (u)[14] = bf_lo(w7); (u)[15] = bf_hi(w7); } while (0)
__device__ __forceinline__ void ssm_chunk_end(const int wave_s, const float* ssmp, const bf16* proj, float* ssmE) {
  const int tid_ = opaque_tid(wave_s);
  const int lane = tid_ & 63;
  const int gw = blockIdx.x * NWAVES + (tid_ >> 6);
  const int nw = gridDim.x * NWAVES;
  for (int it = gw; it < 4 * 64 * 16; it += nw) {
    const int g = it & 15, c = (it >> 4) & 63, b = it >> 10;
    const int gp = g * 64 + lane;
    const uint4* up = (const uint4*)(proj + (size_t)(b * SEQ + c * 64 + lane) * DIN + 2048 + g * 16);
    const uint4 ua = up[0], ub = up[1];
    const float lbr = ssmp[gp * 2], lbi = ssmp[gp * 2 + 1];
    float bbr[16], bbi[16];
#pragma unroll
    for (int h = 0; h < 16; h++) {
      { const float2 bb = *(const float2*)(ssmp + 4096 + ((g * 16 + h) * 64 + lane) * 2); bbr[h] = bb.x; bbi[h] = bb.y; }
    }
    float xr = 0.f, xi = 0.f;
#pragma unroll 2
    for (int tt = 0; tt < 64; tt++) {
      float u[16];
      SSM_BCAST_U(u, ua, ub, tt);
      float br = 0.f, bi = 0.f;
#pragma unroll
      for (int h = 0; h < 16; h++) { br += bbr[h] * u[h]; bi += bbi[h] * u[h]; }
      const float nr = lbr * xr - lbi * xi + br;
      const float ni = lbr * xi + lbi * xr + bi;
      xr = nr; xi = ni;
    }
    float* e = ssmE + ((size_t)((b * 64 + c) * 16 + g) * 64 + lane) * 2;
    e[0] = xr; e[1] = xi;
  }
}

__device__ __forceinline__ void ssm_finish(const int wave_s, const Params& p, int l, const float* ssmp, const bf16* proj,
                           const float* ssmE, bf16* y, LAS float* smem) {
  LAS bf16* Ytb = (LAS bf16*)smem;
  LAS float* ssq2 = smem + (64 * 264 * 2) / 4;
  LAS float* rstd2 = ssq2 + 512;
  const bf16* glT = (const bf16*)(p.ws + WS_WT + (size_t)l * WT_LAYER + WT_GLU);
  const int tid = opaque_tid(wave_s), lane = tid & 63, wave = tid >> 6;
  const float* cre = karg_in(13) + (size_t)l * 16 * 16 * 64;
  const float* cim = karg_in(14) + (size_t)l * 16 * 16 * 64;
  const float* dsk = karg_in(15) + l * 256;
  const float* glw = karg_in(16) + (size_t)l * 256 * 256;
  const float* glb = karg_in(17) + l * 256;
  const float* gg = karg_in(18) + l * 1024 + 768;
  for (int it = blockIdx.x; it < 256; it += gridDim.x) {
    const int b = it >> 6, c = it & 63;
    __syncthreads();
    for (int gi = 0; gi < 2; gi++) {
      const int g = wave + gi * 8;
      const int gp = g * 64 + lane;
      const float lbr = ssmp[gp * 2], lbi = ssmp[gp * 2 + 1];
      const float lcr = ssmp[2048 + gp * 2], lci = ssmp[2048 + gp * 2 + 1];
      float bbr[16], bbi[16], ccr[16], cci[16];
#pragma unroll
      for (int h = 0; h < 16; h++) {
        { const float2 bb = *(const float2*)(ssmp + 4096 + ((g * 16 + h) * 64 + lane) * 2); bbr[h] = bb.x; bbi[h] = bb.y; }
        ccr[h] = cre[(g * 16 + h) * 64 + lane];
        cci[h] = cim[(g * 16 + h) * 64 + lane];
      }
      float xr = 0.f, xi = 0.f;
      {
        const float2* eb = (const float2*)ssmE + ((size_t)(b * 64) * 16 + g) * 64 + lane;
        int cc = 0;
        for (; cc + 8 <= c; cc += 8) {
          float2 ev[8];
#pragma unroll
          for (int k = 0; k < 8; k++) ev[k] = eb[(size_t)(cc + k) * 16 * 64];
#pragma unroll
          for (int k = 0; k < 8; k++) {
            const float nr = lcr * xr - lci * xi + ev[k].x;
            const float ni = lcr * xi + lci * xr + ev[k].y;
            xr = nr; xi = ni;
          }
        }
        for (; cc < c; cc++) {
          const float2 e1 = eb[(size_t)cc * 16 * 64];
          const float nr = lcr * xr - lci * xi + e1.x;
          const float ni = lcr * xi + lci * xr + e1.y;
          xr = nr; xi = ni;
        }
      }
      const int hq = ((lane >> 5) & 1) * 8 + ((lane >> 4) & 1) * 4 + ((lane >> 3) & 1) * 2 + ((lane >> 2) & 1);
      float dm[16];
#pragma unroll
      for (int h = 0; h < 16; h++) dm[h] = (lane == 0) ? dsk[g * 16 + h] : 0.f;
      const uint4* up = (const uint4*)(proj + (size_t)(b * SEQ + c * 64 + lane) * DIN + 2048 + g * 16);
      const uint4 ua = up[0], ub = up[1];
#pragma unroll 1
      for (int t4 = 0; t4 < 64; t4 += 4) {
        float vv[4][16];
#pragma unroll
        for (int s = 0; s < 4; s++) {
          float u[16];
          SSM_BCAST_U(u, ua, ub, t4 + s);
          float br = 0.f, bi = 0.f;
#pragma unroll
          for (int h = 0; h < 16; h++) { br += bbr[h] * u[h]; bi += bbi[h] * u[h]; }
          const float nr = lbr * xr - lbi * xi + br;
          const float ni = lbr * xi + lbi * xr + bi;
          xr = nr; xi = ni;
#pragma unroll
          for (int h = 0; h < 16; h++) vv[s][h] = xr * ccr[h] - xi * cci[h] + dm[h] * u[h];
        }
        float v1[4];
#pragma unroll
        for (int s = 0; s < 4; s++) {
          float v8[8], v4[4], v2[2];
          {
            const bool hi = (lane & 32) != 0;
#pragma unroll
            for (int i = 0; i < 8; i++) { const float send = hi ? vv[s][i] : vv[s][i + 8]; const float keep = hi ? vv[s][i + 8] : vv[s][i]; v8[i] = keep + __shfl_xor(send, 32, 64); }
          }
          {
            const bool hi = (lane & 16) != 0;
#pragma unroll
            for (int i = 0; i < 4; i++) { const float send = hi ? v8[i] : v8[i + 4]; const float keep = hi ? v8[i + 4] : v8[i]; v4[i] = keep + __shfl_xor(send, 16, 64); }
          }
          {
            const bool hi = (lane & 8) != 0;
#pragma unroll
            for (int i = 0; i < 2; i++) { const float send = hi ? v4[i] : v4[i + 2]; const float keep = hi ? v4[i + 2] : v4[i]; v2[i] = keep + __shfl_xor(send, 8, 64); }
          }
          {
            const bool hi = (lane & 4) != 0;
            const float send = hi ? v2[0] : v2[1];
            const float keep = hi ? v2[1] : v2[0];
            v1[s] = keep + __shfl_xor(send, 4, 64);
          }
          v1[s] += __shfl_xor(v1[s], 2, 64);
          v1[s] += __shfl_xor(v1[s], 1, 64);
        }
        if ((lane & 3) == 0) {
#pragma unroll
          for (int s = 0; s < 4; s++) Ytb[(t4 + s) * 264 + g * 16 + hq] = (bf16)f2bf(gelu_tanh(v1[s]));
        }
      }
    }
    __syncthreads();
    {
      const int n = lane & 31, hh = lane >> 5;
      const int ch = wave * 32 + n;
      const float bj = glb[ch];
      const float gj = gg[ch];
      bf16x8_t gf[16];
      {
        const bf16* grow = glT + (size_t)ch * 256 + 8 * hh;
#pragma unroll
        for (int ks = 0; ks < 16; ks++) gf[ks] = *(const bf16x8_t*)(grow + 16 * ks);
      }
      float oo[2][16];
#pragma unroll
      for (int mt = 0; mt < 2; mt++) {
        f32x16_t z;
#pragma unroll
        for (int r = 0; r < 16; r++) z[r] = 0.f;
        const LAS bf16* yrow = Ytb + (mt * 32 + n) * 264 + 8 * hh;
#pragma unroll
        for (int kq = 0; kq < 4; kq++) {
          bf16x8_t yf[4];
#pragma unroll
          for (int i = 0; i < 4; i++) yf[i] = *(const LAS bf16x8_t*)(yrow + 16 * (kq * 4 + i));
          MFMA_PAD();
#pragma unroll
          for (int i = 0; i < 4; i++) z = __builtin_amdgcn_mfma_f32_32x32x16_bf16(yf[i], gf[kq * 4 + i], z, 0, 0, 0);
          MFMA_PAD();
        }
        float sq[16];
#pragma unroll
        for (int r = 0; r < 16; r++) {
          const int t = mt * 32 + (r & 3) + 8 * (r >> 2) + 4 * hh;
          const float yv = bf2f(Ytb[t * 264 + ch]);
          const float o = yv * sigmoidf_(z[r] + bj);
          oo[mt][r] = o;
          float v = o * o;
#pragma unroll
          for (int s = 16; s > 0; s >>= 1) v += __shfl_xor(v, s, 64);
          sq[r] = v;
        }
        if (n == 0) {
#pragma unroll
          for (int r = 0; r < 16; r++) ssq2[wave * 64 + mt * 32 + (r & 3) + 8 * (r >> 2) + 4 * hh] = sq[r];
        }
      }
      __syncthreads();
      if (tid < 64) {
        float t = 0.f;
#pragma unroll
        for (int w = 0; w < 8; w++) t += ssq2[w * 64 + tid];
        rstd2[tid] = rsqrtf(t * (1.0f / 256.f) + EPSF);
      }
      __syncthreads();
#pragma unroll
      for (int mt = 0; mt < 2; mt++)
#pragma unroll
        for (int r = 0; r < 16; r++) {
          const int t = mt * 32 + (r & 3) + 8 * (r >> 2) + 4 * hh;
          y[(size_t)(b * SEQ + c * 64 + t) * DM + 768 + ch] = (bf16)f2bf(oo[mt][r] * rstd2[t] * gj);
        }
    }
  }
}

__device__ __forceinline__ void memattn_phase(const int wave_s, const bf16* q, const bf16* kvb, const bf16* vT, bf16* o, LAS float* smem) {
  const int tid_ = opaque_tid(wave_s);
  const int lane = tid_ & 63, n = lane & 31, hh = lane >> 5, wave = tid_ >> 6;
  const int sig = (n & 0x13) | ((n & 4) << 1) | ((n & 8) >> 1);
  LAS bf16* Ls = (LAS bf16*)smem;
  for (int it = blockIdx.x; it < 64 * 4; it += gridDim.x) {
    const int h = it & 3, tg = it >> 2, b = tg >> 4;
    const int tok0 = (tg * 8 + wave) * 32;
    __syncthreads();
    {
      const int r = tid_ >> 1, hf = tid_ & 1;
      const pg8::u32x4* src4 = (const pg8::u32x4*)(kvb + (size_t)(b * NMEM + r) * 2048 + h * 256 + hf * 128);
      LAS pg8::u32x4* dst4 = (LAS pg8::u32x4*)(Ls + r * 264 + hf * 128);
#pragma unroll
      for (int k = 0; k < 16; k++) dst4[k] = src4[k];
    }
    f32x16_t st[8];
#pragma unroll
    for (int kt = 0; kt < 8; kt++)
#pragma unroll
      for (int r = 0; r < 16; r++) st[kt][r] = 0.f;
    const bf16* qrow = q + (size_t)(tok0 + n) * DM + h * 256 + 8 * hh;
    __syncthreads();
#pragma unroll
    for (int kq = 0; kq < 4; kq++) {
      bf16x8_t qf[4];
#pragma unroll
      for (int i = 0; i < 4; i++) qf[i] = *(const bf16x8_t*)(qrow + 16 * (kq * 4 + i));
#pragma unroll
      for (int kt = 0; kt < 8; kt++) {
        const LAS bf16* krow = Ls + (kt * 32 + sig) * 264 + 8 * hh;
        bf16x8_t kf[4];
#pragma unroll
        for (int i = 0; i < 4; i++) kf[i] = *(const LAS bf16x8_t*)(krow + 16 * (kq * 4 + i));
        MFMA_PAD();
#pragma unroll
        for (int i = 0; i < 4; i++) st[kt] = __builtin_amdgcn_mfma_f32_32x32x16_bf16(kf[i], qf[i], st[kt], 0, 0, 0);
        MFMA_PAD();
      }
    }
    float mx = st[0][0];
#pragma unroll
    for (int kt = 0; kt < 8; kt++)
#pragma unroll
      for (int r = 0; r < 16; r++) mx = fmaxf(mx, st[kt][r]);
    mx = fmaxf(mx, __shfl_xor(mx, 32, 64));
    float sum = 0.f;
#pragma unroll
    for (int kt = 0; kt < 8; kt++)
#pragma unroll
      for (int r = 0; r < 16; r++) { const float e = __expf((st[kt][r] - mx) * 0.0625f); st[kt][r] = e; sum += e; }
    sum += __shfl_xor(sum, 32, 64);
    const float inv = 1.0f / sum;
    bf16x8_t pf[8][2];
#pragma unroll
    for (int kt = 0; kt < 8; kt++)
#pragma unroll
      for (int s = 0; s < 2; s++)
#pragma unroll
        for (int j = 0; j < 8; j++) pf[kt][s][j] = (short)f2bf(st[kt][8 * s + j] * inv);
    __syncthreads();
    {
      const int r = tid_ >> 1, hf = tid_ & 1;
      const pg8::u32x4* src4 = (const pg8::u32x4*)(vT + ((size_t)(b * 4 + h) * 256 + r) * 256 + hf * 128);
      LAS pg8::u32x4* dst4 = (LAS pg8::u32x4*)(Ls + r * 264 + hf * 128);
#pragma unroll
      for (int k = 0; k < 16; k++) dst4[k] = src4[k];
    }
    __syncthreads();
#pragma unroll 1
    for (int dt = 0; dt < 8; dt++) {
      f32x16_t oacc;
#pragma unroll
      for (int r = 0; r < 16; r++) oacc[r] = 0.f;
      const LAS bf16* vrow = Ls + (dt * 32 + n) * 264 + 8 * hh;
#pragma unroll
      for (int kq = 0; kq < 4; kq++) {
        bf16x8_t vf[4];
#pragma unroll
        for (int i = 0; i < 4; i++) vf[i] = *(const LAS bf16x8_t*)(vrow + (kq * 2 + (i >> 1)) * 32 + 16 * (i & 1));
        MFMA_PAD();
#pragma unroll
        for (int i = 0; i < 4; i++) oacc = __builtin_amdgcn_mfma_f32_32x32x16_bf16(pf[kq * 2 + (i >> 1)][i & 1], vf[i], oacc, 0, 0, 0);
        MFMA_PAD();
      }
#pragma unroll
      for (int r = 0; r < 16; r++) {
        const int qi = (r & 3) + 8 * (r >> 2) + 4 * hh;
        o[(size_t)(tok0 + qi) * DM + h * 256 + dt * 32 + n] = (bf16)f2bf(oacc[r]);
      }
    }
  }
}

__device__ __forceinline__ void vt_phase(const int wave_s, const bf16* kvb, bf16* vT) {
  const int tid_ = opaque_tid(wave_s);
  const int gt = blockIdx.x * (NWAVES * 64) + tid_;
  const int nth = gridDim.x * NWAVES * 64;
  for (int i = gt; i < 2 * 4 * 4 * 256 * 256; i += nth) {
    const int m = i & 255, d = (i >> 8) & 255, h = (i >> 16) & 3, b = (i >> 18) & 3, l = i >> 20;
    vT[i] = kvb[((size_t)l * 1024 + b * 256 + m) * 2048 + 1024 + h * 256 + d];
  }
}

__device__ __forceinline__ void topk_rounds(float (&s)[64], int hh, float (&tv)[16], int (&ti)[16]) {
  const float NEG = -3.0e38f;
#pragma unroll 1
  for (int r = 0; r < 16; r++) {
    float m = s[0]; int slot = 0;
#pragma unroll
    for (int i = 1; i < 64; i++) {
      const bool gt = s[i] > m;
      m = gt ? s[i] : m;
      slot = gt ? i : slot;
    }
    const int rr = slot & 15;
    const int idx = (slot >> 4) * 32 + (rr & 3) + 8 * (rr >> 2) + 4 * hh;
    const float pm = __shfl_xor(m, 32, 64);
    const int pidx = __shfl_xor(idx, 32, 64);
    const bool mine = (m > pm) || (m == pm && idx < pidx);
    const float wv = mine ? m : pm;
    const int wi = mine ? idx : pidx;
#pragma unroll
    for (int j = 0; j < 16; j++) { tv[j] = (r == j) ? wv : tv[j]; ti[j] = (r == j) ? wi : ti[j]; }
    const int kill = mine ? slot : -1;
#pragma unroll
    for (int i = 0; i < 64; i++) s[i] = (kill == i) ? NEG : s[i];
  }
}

__device__ __forceinline__ void peer_topk(const int wave_s, const bf16* pq, const bf16* skb, int* ids, float* gates) {
  const int tid_ = opaque_tid(wave_s);
  const int lane = tid_ & 63, n = lane & 31, hh = lane >> 5;
  const int gw = blockIdx.x * NWAVES + (tid_ >> 6);
  const int nw = gridDim.x * NWAVES;
  const float NEG = -3.0e38f;
  for (int it = gw; it < 512 * 8; it += nw) {
    const int h = it & 7, tok0 = (it >> 3) * 32;
    float tv0[16], tv1[16];
    int ti0[16], ti1[16];
#pragma unroll
    for (int j = 0; j < 16; j++) { tv0[j] = 0.f; tv1[j] = 0.f; ti0[j] = 0; ti1[j] = 0; }
#pragma unroll
    for (int half = 0; half < 2; half++) {
      bf16x8_t qf[8];
      {
        const bf16* qrow = pq + (size_t)(tok0 + n) * 2048 + h * 256 + half * 128 + 8 * hh;
#pragma unroll
        for (int ks = 0; ks < 8; ks++) qf[ks] = *(const bf16x8_t*)(qrow + 16 * ks);
      }
      f32x16_t st[4];
#pragma unroll
      for (int kt = 0; kt < 4; kt++) {
        const bf16* krow = skb + ((size_t)((h * 2 + half) * 128 + kt * 32 + n)) * 128 + 8 * hh;
        asm volatile("" : "+v"(krow));
        f32x16_t acc;
#pragma unroll
        for (int r = 0; r < 16; r++) acc[r] = 0.f;
#pragma unroll
        for (int kq = 0; kq < 2; kq++) {
          bf16x8_t kf[4];
#pragma unroll
          for (int i = 0; i < 4; i++) kf[i] = *(const bf16x8_t*)(krow + 16 * (kq * 4 + i));
          MFMA_PAD();
#pragma unroll
          for (int i = 0; i < 4; i++) acc = __builtin_amdgcn_mfma_f32_32x32x16_bf16(kf[i], qf[kq * 4 + i], acc, 0, 0, 0);
          MFMA_PAD();
        }
        st[kt] = acc;
      }
      float s[64];
#pragma unroll
      for (int kt = 0; kt < 4; kt++)
#pragma unroll
        for (int i = 0; i < 16; i++) s[kt * 16 + i] = st[kt][i];
      __builtin_amdgcn_sched_barrier(0);
      if (half == 0) topk_rounds(s, hh, tv0, ti0); else topk_rounds(s, hh, tv1, ti1);
      __builtin_amdgcn_sched_barrier(0);
    }
    float F[16];
    int ba[16];
#pragma unroll
    for (int a = 0; a < 16; a++) { F[a] = tv0[a] + tv1[0]; ba[a] = 0; }
    float bv[16];
    int be[16];
#pragma unroll
    for (int j = 0; j < 16; j++) { bv[j] = 0.f; be[j] = 0; }
#pragma unroll 1
    for (int r = 0; r < 16; r++) {
      float m = F[0]; int a = 0;
#pragma unroll
      for (int i = 1; i < 16; i++) { const bool gt = F[i] > m; m = gt ? F[i] : m; a = gt ? i : a; }
      int bsel = 0, i0 = 0; float t0 = 0.f;
#pragma unroll
      for (int i = 0; i < 16; i++) { const bool is = (a == i); bsel = is ? ba[i] : bsel; i0 = is ? ti0[i] : i0; t0 = is ? tv0[i] : t0; }
      int i1 = 0; float t1n = NEG;
#pragma unroll
      for (int i = 0; i < 16; i++) { i1 = (bsel == i) ? ti1[i] : i1; t1n = (bsel + 1 == i) ? tv1[i] : t1n; }
      const int e = i0 * 128 + i1;
      const float fn = (bsel + 1 < 16) ? (t0 + t1n) : NEG;
#pragma unroll
      for (int i = 0; i < 16; i++) { const bool is = (a == i); F[i] = is ? fn : F[i]; ba[i] = is ? (bsel + 1) : ba[i]; }
#pragma unroll
      for (int j = 0; j < 16; j++) { bv[j] = (r == j) ? m : bv[j]; be[j] = (r == j) ? e : be[j]; }
    }
    const float b0 = bv[0];
    float ge[16];
    float gsum = 0.f;
#pragma unroll
    for (int r = 0; r < 16; r++) { ge[r] = __expf(bv[r] - b0); gsum += ge[r]; }
    const float ginv = 1.0f / gsum;
    if (hh == 0) {
      int* ip = ids + (size_t)(tok0 + n) * 128 + h * 16;
      float* gp = gates + (size_t)(tok0 + n) * 128 + h * 16;
#pragma unroll
      for (int r4 = 0; r4 < 4; r4++) {
        *(int4*)(ip + 4 * r4) = make_int4(be[4 * r4], be[4 * r4 + 1], be[4 * r4 + 2], be[4 * r4 + 3]);
        *(float4*)(gp + 4 * r4) = make_float4(ge[4 * r4] * ginv, ge[4 * r4 + 1] * ginv, ge[4 * r4 + 2] * ginv, ge[4 * r4 + 3] * ginv);
      }
    }
  }
}

typedef _Float16 f16x2_t __attribute__((ext_vector_type(2)));
__device__ __forceinline__ unsigned e4m3x2_to_f16x2(unsigned w, unsigned sel) {
  const unsigned p = __builtin_amdgcn_perm(w, w, sel);
  return (p & 0x80008000u) | ((p >> 1) & 0x3F803F80u);
}
__device__ __forceinline__ float dot2h(unsigned a, unsigned b, float c) {
  return __builtin_amdgcn_fdot2(__builtin_bit_cast(f16x2_t, a), __builtin_bit_cast(f16x2_t, b), c, false);
}
__device__ __forceinline__ unsigned pack_h2(float lo, float hi) {
  f16x2_t v; v.x = (_Float16)lo; v.y = (_Float16)hi;
  return __builtin_bit_cast(unsigned, v);
}
template <bool FINAL>
__device__ __forceinline__ void peer_gather(const int wave_s, bf16* xn, const float* rst, const unsigned char* ub, const unsigned char* vb,
                                            const int* ids, const float* gates, float* xw, const float* gnext, float* outp) {
  const int tid_ = opaque_tid(wave_s);
  const int lane = tid_ & 63;
  const int gw = blockIdx.x * NWAVES + (tid_ >> 6);
  const int nw = gridDim.x * NWAVES;
  const int el = ((lane >> 5) & 1) * 4 + ((lane >> 4) & 1) * 2 + ((lane >> 3) & 1);
  for (int tok = gw; tok < NT; tok += nw) {
    unsigned xh[8];
    {
      const uint4 a = *(const uint4*)(xn + (size_t)tok * DM + lane * 16);
      const uint4 b = *(const uint4*)(xn + (size_t)tok * DM + lane * 16 + 8);
      const unsigned xw_[8] = {a.x, a.y, a.z, a.w, b.x, b.y, b.z, b.w};
      const float4* sp = (const float4*)(rst + (size_t)tok * 16);
      const float4 s0 = sp[0], s1 = sp[1], s2 = sp[2], s3 = sp[3];
      const float xs = rsqrtf((((s0.x + s0.y) + (s0.z + s0.w)) + ((s1.x + s1.y) + (s1.z + s1.w)) + ((s2.x + s2.y) + (s2.z + s2.w)) + ((s3.x + s3.y) + (s3.z + s3.w))) * (1.0f / 1024.f) + EPSF);
#pragma unroll
      for (int k = 0; k < 8; k++) xh[k] = pack_h2(bf_lo(xw_[k]) * xs, bf_hi(xw_[k]) * xs);
    }
    float acc[16];
#pragma unroll
    for (int i = 0; i < 16; i++) acc[i] = 0.f;
#pragma unroll 1
    for (int g = 0; g < 16; g++) {
      const int idv = ids[(size_t)tok * 128 + g * 8 + (lane & 7)];
      const float gv = gates[(size_t)tok * 128 + g * 8 + el];
      uint4 uu[8], vv[8];
#pragma unroll
      for (int e = 0; e < 8; e++) {
        const int id = __builtin_amdgcn_readlane(idv, e);
        uu[e] = *(const uint4*)(ub + (size_t)id * DM + lane * 16);
        vv[e] = *(const uint4*)(vb + (size_t)id * DM + lane * 16);
      }
      float d[8];
#pragma unroll
      for (int e = 0; e < 8; e++) {
        const unsigned uw[4] = {uu[e].x, uu[e].y, uu[e].z, uu[e].w};
        float s = 0.f;
#pragma unroll
        for (int k = 0; k < 4; k++) {
          s = dot2h(e4m3x2_to_f16x2(uw[k], 0x010c000cu), xh[2 * k], s);
          s = dot2h(e4m3x2_to_f16x2(uw[k], 0x030c020cu), xh[2 * k + 1], s);
        }
        d[e] = s;
      }
      float d4[4], d2[2], d1;
      {
        const bool hi = (lane & 32) != 0;
#pragma unroll
        for (int i = 0; i < 4; i++) { const float send = hi ? d[i] : d[i + 4]; const float keep = hi ? d[i + 4] : d[i]; d4[i] = keep + __shfl_xor(send, 32, 64); }
      }
      {
        const bool hi = (lane & 16) != 0;
#pragma unroll
        for (int i = 0; i < 2; i++) { const float send = hi ? d4[i] : d4[i + 2]; const float keep = hi ? d4[i + 2] : d4[i]; d2[i] = keep + __shfl_xor(send, 16, 64); }
      }
      {
        const bool hi = (lane & 8) != 0;
        const float send = hi ? d2[0] : d2[1];
        const float keep = hi ? d2[1] : d2[0];
        d1 = keep + __shfl_xor(send, 8, 64);
      }
      d1 += __shfl_xor(d1, 4, 64);
      d1 += __shfl_xor(d1, 2, 64);
      d1 += __shfl_xor(d1, 1, 64);
      const float wl = gv * gelu_tanh(d1 * (256.0f / U_SCALE)) * (256.0f / V_SCALE);
#pragma unroll
      for (int e = 0; e < 8; e++) {
        const float w = __builtin_bit_cast(float, __builtin_amdgcn_readlane(__builtin_bit_cast(int, wl), ((e >> 2) & 1) * 32 + ((e >> 1) & 1) * 16 + (e & 1) * 8));
        const unsigned wlo = pack_h2(w, 0.f), whi = pack_h2(0.f, w);
        const unsigned vw[4] = {vv[e].x, vv[e].y, vv[e].z, vv[e].w};
#pragma unroll
        for (int k = 0; k < 4; k++) {
          const unsigned h0 = e4m3x2_to_f16x2(vw[k], 0x010c000cu), h1 = e4m3x2_to_f16x2(vw[k], 0x030c020cu);
          acc[4 * k + 0] = dot2h(h0, wlo, acc[4 * k + 0]);
          acc[4 * k + 1] = dot2h(h0, whi, acc[4 * k + 1]);
          acc[4 * k + 2] = dot2h(h1, wlo, acc[4 * k + 2]);
          acc[4 * k + 3] = dot2h(h1, whi, acc[4 * k + 3]);
        }
      }
    }
    float* xr = xw + (size_t)tok * DM + lane * 16;
    float xv[16];
    float ssq = 0.f;
#pragma unroll
    for (int c = 0; c < 4; c++) {
      float4 a0 = *(float4*)(xr + c * 4);
      a0.x += acc[c * 4 + 0]; a0.y += acc[c * 4 + 1]; a0.z += acc[c * 4 + 2]; a0.w += acc[c * 4 + 3];
      if (!FINAL) *(float4*)(xr + c * 4) = a0;
      xv[c * 4 + 0] = a0.x; xv[c * 4 + 1] = a0.y; xv[c * 4 + 2] = a0.z; xv[c * 4 + 3] = a0.w;
      ssq += a0.x * a0.x + a0.y * a0.y + a0.z * a0.z + a0.w * a0.w;
    }
    ssq = wsum(ssq);
    const float rstd = rsqrtf(ssq * (1.0f / DM) + EPSF);
    const float4* g4 = (const float4*)(gnext + lane * 16);
    if (FINAL) {
      float* op = outp + (size_t)tok * DM + lane * 16;
#pragma unroll
      for (int c = 0; c < 4; c++) {
        const float4 gq = g4[c];
        *(float4*)(op + c * 4) = make_float4(xv[c * 4] * rstd * gq.x, xv[c * 4 + 1] * rstd * gq.y, xv[c * 4 + 2] * rstd * gq.z, xv[c * 4 + 3] * rstd * gq.w);
      }
    } else {
      uint4 o0, o1;
      { const float4 ga = g4[0], gb = g4[1];
        o0.x = pk2(xv[0] * rstd * ga.x, xv[1] * rstd * ga.y); o0.y = pk2(xv[2] * rstd * ga.z, xv[3] * rstd * ga.w);
        o0.z = pk2(xv[4] * rstd * gb.x, xv[5] * rstd * gb.y); o0.w = pk2(xv[6] * rstd * gb.z, xv[7] * rstd * gb.w); }
      { const float4 ga = g4[2], gb = g4[3];
        o1.x = pk2(xv[8] * rstd * ga.x, xv[9] * rstd * ga.y); o1.y = pk2(xv[10] * rstd * ga.z, xv[11] * rstd * ga.w);
        o1.z = pk2(xv[12] * rstd * gb.x, xv[13] * rstd * gb.y); o1.w = pk2(xv[14] * rstd * gb.z, xv[15] * rstd * gb.w); }
      *(uint4*)(xn + (size_t)tok * DM + lane * 16) = o0;
      *(uint4*)(xn + (size_t)tok * DM + lane * 16 + 8) = o1;
    }
  }
}

__device__ __forceinline__ void prologue_transposes(const int wave_s, const Params& p, unsigned char* ws, LAS unsigned char* lds) {
  const int tid_ = opaque_tid(wave_s);
  const int lane = tid_ & 63, wave = tid_ >> 6;
  LAS float* scr = (LAS float*)(lds + wave * 16384);
  const int gw = blockIdx.x * NWAVES + wave, NGW = gridDim.x * NWAVES;
  constexpr int I_IN = (DM / 64) * (DIN / 32), I_SQ = (DM / 64) * (DM / 32), I_2K = (DM / 64) * (2048 / 32);
  constexpr int I_GL = (256 / 64) * (256 / 32);
  constexpr int PER_LAYER = I_IN + 3 * I_SQ + 2 * I_2K + I_GL;
  const float* w3 = karg_in(3); const float* w19 = karg_in(19); const float* w22 = karg_in(22);
  const float* w23 = karg_in(23); const float* w24 = karg_in(24); const float* w26 = karg_in(26);
  const float* w16 = karg_in(16);
  for (int it = gw; it < 2 * PER_LAYER; it += NGW) {
    const int l = it / PER_LAYER;
    int r = it % PER_LAYER;
    unsigned char* wl = ws + WS_WT + (size_t)l * WT_LAYER;
    if (r < I_IN) { transpose_item(w3 + (size_t)l * DM * DIN, DM, DIN, (bf16*)(wl + WT_IN), scr, r, lane); continue; } r -= I_IN;
    if (r < I_SQ) { transpose_item(w19 + (size_t)l * DM * DM, DM, DM, (bf16*)(wl + WT_OUT), scr, r, lane); continue; } r -= I_SQ;
    if (r < I_SQ) { transpose_item(w22 + (size_t)l * DM * DM, DM, DM, (bf16*)(wl + WT_MQ), scr, r, lane); continue; } r -= I_SQ;
    if (r < I_2K) { transpose_item(w23 + (size_t)l * DM * 2048, DM, 2048, (bf16*)(wl + WT_MKV), scr, r, lane); continue; } r -= I_2K;
    if (r < I_SQ) { transpose_item(w24 + (size_t)l * DM * DM, DM, DM, (bf16*)(wl + WT_MO), scr, r, lane); continue; } r -= I_SQ;
    if (r < I_2K) { transpose_item(w26 + (size_t)l * DM * 2048, DM, 2048, (bf16*)(wl + WT_PQ), scr, r, lane); continue; } r -= I_2K;
    transpose_item(w16 + (size_t)l * 256 * 256, 256, 256, (bf16*)(wl + WT_GLU), scr, r, lane);
  }
}

template <class T> __device__ __forceinline__ T* opq(T* p) { asm volatile("" : "+s"(p)); return p; }
__device__ __forceinline__ void cvt_rows_bf16(const int wave_s, const float* src, bf16* dst, size_t n) {
  const int tid_ = opaque_tid(wave_s);
  const size_t gt = (size_t)blockIdx.x * (NWAVES * 64) + tid_;
  const size_t nth = (size_t)gridDim.x * NWAVES * 64;
  for (size_t i = gt; i < n / 8; i += nth) {
    const float4 a = ((const float4*)src)[2 * i], b = ((const float4*)src)[2 * i + 1];
    uint4 o; o.x = pk2(a.x, a.y); o.y = pk2(a.z, a.w); o.z = pk2(b.x, b.y); o.w = pk2(b.z, b.w);
    ((uint4*)dst)[i] = o;
  }
}

__device__ __forceinline__ unsigned enc_e4m3(float x) {
  const unsigned bits = __builtin_bit_cast(unsigned, x);
  const unsigned sign = (bits >> 24) & 0x80u;
  float ax = fminf(fabsf(x), 448.0f);
  unsigned r;
  if (ax >= 0.015625f) {
    unsigned ab = __builtin_bit_cast(unsigned, ax);
    ab += 0x0007FFFFu + ((ab >> 20) & 1u);
    r = (ab >> 20) - 960u;
    r = r > 0x7Eu ? 0x7Eu : r;
  } else {
    r = (unsigned)__float2int_rn(ax * 512.0f);
  }
  return sign | r;
}
__device__ __forceinline__ void cvt_rows_e4m3(const int wave_s, const float* src, unsigned char* dst, size_t n, float sc) {
  const int tid_ = opaque_tid(wave_s);
  const size_t gt = (size_t)blockIdx.x * (NWAVES * 64) + tid_;
  const size_t nth = (size_t)gridDim.x * NWAVES * 64;
  for (size_t i = gt; i < n / 16; i += nth) {
    unsigned w[4];
#pragma unroll
    for (int k = 0; k < 4; k++) {
      const float4 a = ((const float4*)src)[4 * i + k];
      w[k] = enc_e4m3(a.x * sc) | (enc_e4m3(a.y * sc) << 8) | (enc_e4m3(a.z * sc) << 16) | (enc_e4m3(a.w * sc) << 24);
    }
    uint4 o; o.x = w[0]; o.y = w[1]; o.z = w[2]; o.w = w[3];
    ((uint4*)dst)[i] = o;
  }
}

#define GEMM_F32(Aptr, Wt, Cptr, Rptr, M_, N_) do { \
    pg8::Gemm g_{opq((const bf16*)(Aptr)), opq((const bf16*)(Wt)), (M_), (N_), DM}; pg8::StaticOrder S_; S_.init((M_), (N_), (int)gridDim.x, (int)blockIdx.x); \
    pg8::EpiF32R E_{opq((float*)(Cptr)), opq((const float*)(Rptr)), (N_)}; \
    pg8::gemm_phase<pg8::EpiF32R, pg8::StaticOrder, true, true>(wave_s, ldsl, g_, S_, E_); } while (0)
#define GEMM_BF16_C(Aptr, Wt, Optr, M_, N_, C_) do { \
    pg8::Gemm g_{opq((const bf16*)(Aptr)), opq((const bf16*)(Wt)), (M_), (N_), DM}; pg8::StaticOrder S_; S_.init((M_), (N_), (int)gridDim.x, (C_)); \
    pg8::EpiBf16 E_{opq((bf16*)(Optr)), (N_)}; \
    pg8::gemm_phase<pg8::EpiBf16, pg8::StaticOrder, true, true>(wave_s, ldsl, g_, S_, E_); } while (0)
#define GEMM_BF16(Aptr, Wt, Optr, M_, N_) GEMM_BF16_C(Aptr, Wt, Optr, M_, N_, (int)blockIdx.x)
#define GEMM_F32RN(Aptr, Wt, Cptr, Rptr, XGptr, Gptr, STptr) do { \
    pg8::Gemm g_{opq((const bf16*)(Aptr)), opq((const bf16*)(Wt)), NT, DM, DM}; pg8::StaticOrder S_; S_.init(NT, DM, (int)gridDim.x, (int)blockIdx.x); \
    pg8::EpiF32RN E_{opq((float*)(Cptr)), opq((const float*)(Rptr)), DM, opq((bf16*)(XGptr)), opq((const float*)(Gptr)), opq((float*)(STptr))}; \
    pg8::gemm_phase<pg8::EpiF32RN, pg8::StaticOrder, true, true>(wave_s, ldsl, g_, S_, E_); } while (0)
#define GEMM_BF16S(Aptr, Wt, Optr, N_, STptr) do { \
    pg8::Gemm g_{opq((const bf16*)(Aptr)), opq((const bf16*)(Wt)), NT, (N_), DM}; pg8::StaticOrder S_; S_.init(NT, (N_), (int)gridDim.x, (int)blockIdx.x); \
    pg8::EpiBf16S E_{opq((bf16*)(Optr)), (N_), opq((const float*)(STptr))}; \
    pg8::gemm_phase<pg8::EpiBf16S, pg8::StaticOrder, true, true>(wave_s, ldsl, g_, S_, E_); } while (0)

__global__ void __launch_bounds__(NWAVES * 64, 2) fwd_megakernel(Params p) {
  cg::grid_group grid = cg::this_grid();
  extern __shared__ __attribute__((aligned(16))) unsigned char lds[];
  LAS unsigned char* ldsl = (LAS unsigned char*)lds;
  LAS float* smem = (LAS float*)ldsl;
  const int wave_s = __builtin_amdgcn_readfirstlane((int)(threadIdx.x >> 6));
  unsigned char* ws = p.ws;
  volatile LAS unsigned* MISC = (volatile LAS unsigned*)(ldsl + (LDS_BYTES - 256));
  if (threadIdx.x < 64) MISC[threadIdx.x] = 0u;
  __syncthreads();
  const XcdBarrier bar = xcd_barrier_post((unsigned*)(ws + WS_CTL) + 4096, MISC + 8);
  grid.sync();
  float* xw = (float*)(ws + WS_XW);
  bf16* xn = (bf16*)(ws + WS_XN);
  bf16* big = (bf16*)(ws + WS_BIG);
  bf16* y = (bf16*)(ws + WS_Y);
  bf16* memh = (bf16*)(ws + WS_MEMH);
  bf16* kvb = (bf16*)(ws + WS_KVB);
  bf16* vT = (bf16*)(ws + WS_VT);
  float* ssmE = (float*)(ws + WS_SSME);
  float* ssmp = (float*)(ws + WS_SSMP);
  int* ids = (int*)(ws + WS_IDS);
  float* gates = (float*)(ws + WS_GATE);
  bf16* skb = (bf16*)(ws + WS_SKB);
  unsigned char* ub = ws + WS_UB;
  unsigned char* vb = ws + WS_VB;
  float* rst = (float*)(ws + WS_RST);

  prologue_transposes(wave_s, p, ws, ldsl);
  cvt_rows_bf16(wave_s, karg_in(27), skb, (size_t)2 * 8 * 2 * 128 * 128);
  cvt_rows_e4m3(wave_s, karg_in(28), ub, (size_t)2 * 16384 * 1024, U_SCALE);
  cvt_rows_e4m3(wave_s, karg_in(29), vb, (size_t)2 * 16384 * 1024, V_SCALE);
  for (int l = 0; l < 2; l++)
    rms_rows<true>(wave_s, karg_in(1), karg_in(21) + l * DM, memh + (size_t)l * 1024 * 1024, 1024);
  ssm_params(wave_s, p, ssmp);
  xcd_barrier(bar);
  for (int l = 0; l < 2; l++)
    GEMM_BF16_C(memh + (size_t)l * 1024 * 1024, ws + WS_WT + (size_t)l * WT_LAYER + WT_MKV,
              kvb + (size_t)l * 1024 * 2048, 1024, 2048, (int)((blockIdx.x + gridDim.x - 32u * (unsigned)l) % gridDim.x));

#pragma nounroll
  for (int l = 0; l < 2; l++) {
    const float* xcur = (l == 0) ? karg_in(0) : xw;
    const float* sp = ssmp + (size_t)l * SSMP_PER_LAYER;
    const unsigned char* wl = ws + WS_WT + (size_t)l * WT_LAYER;
    if (l == 0) {
      rms_rows<true>(wave_s, xcur, karg_in(2) + l * DM, xn, NT);
      xcd_barrier(bar);
    }
    GEMM_BF16(xn, wl + WT_IN, big, NT, DIN);
    xcd_barrier(bar);
    if (l == 0) vt_phase(wave_s, kvb, vT);
    ssm_chunk_end(wave_s, sp, big, ssmE);
    attn_phase(wave_s, p, l, big, y, smem);
    conv_phase(wave_s, p, l, big, y, smem);
    xcd_barrier(bar);
    ssm_finish(wave_s, p, l, sp, big, ssmE, y, smem);
    xcd_barrier(bar);
    GEMM_F32RN(y, wl + WT_OUT, xw, xcur, xn, karg_in(20) + l * DM, rst);
    xcd_barrier(bar);
    GEMM_BF16S(xn, wl + WT_MQ, big, DM, rst);
    xcd_barrier(bar);
    memattn_phase(wave_s, big, kvb + (size_t)l * 1024 * 2048, vT + (size_t)l * 4 * 4 * 256 * 256, y, smem);
    xcd_barrier(bar);
    GEMM_F32RN(y, wl + WT_MO, xw, (const float*)xw, xn, karg_in(25) + l * DM, rst);
    xcd_barrier(bar);
    GEMM_BF16S(xn, wl + WT_PQ, big, 2048, rst);
    xcd_barrier(bar);
    peer_topk(wave_s, big, skb + (size_t)l * 8 * 2 * 128 * 128, ids, gates);
    xcd_barrier(bar);
    if (l == 0) {
      peer_gather<false>(wave_s, xn, rst, ub + (size_t)l * 16384 * DM, vb + (size_t)l * 16384 * DM, ids, gates, xw, karg_in(2) + DM, (float*)nullptr);
      xcd_barrier(bar);
    } else {
      peer_gather<true>(wave_s, xn, rst, ub + (size_t)l * 16384 * DM, vb + (size_t)l * 16384 * DM, ids, gates, xw, karg_in(30), p.out);
    }
  }
}

extern "C" void kernel_launch(void* const* d_in, const int* in_sizes, int n_in,
                              void* d_out, int out_size, void* d_ws, size_t ws_size,
                              hipStream_t stream) {
  static int grid_blocks = 0;
  if (!grid_blocks) {
    int dev = 0, cus = 0, per_cu = 0;
    (void)hipGetDevice(&dev);
    (void)hipDeviceGetAttribute(&cus, hipDeviceAttributeMultiprocessorCount, dev);
    (void)hipFuncSetAttribute((const void*)fwd_megakernel, hipFuncAttributeMaxDynamicSharedMemorySize, LDS_BYTES);
    (void)hipOccupancyMaxActiveBlocksPerMultiprocessor(&per_cu, fwd_megakernel, NWAVES * 64, LDS_BYTES);
    if (per_cu < 1) fprintf(stderr, "occupancy query reports %d blocks/CU\n", per_cu);
    grid_blocks = cus;
  }
  (void)hipMemsetAsync((char*)d_ws + WS_CTL, 0, 1 * MiB, stream);
  Params p{};
  for (int i = 0; i < 31; i++) p.in[i] = (const float*)d_in[i];
  p.out = (float*)d_out;
  p.ws = (unsigned char*)d_ws;
  void* args[] = {&p};
  hipError_t e = hipLaunchCooperativeKernel((void*)fwd_megakernel, dim3(grid_blocks), dim3(NWAVES * 64),
                                            args, LDS_BYTES, stream);
  if (e != hipSuccess)
    fprintf(stderr, "cooperative launch failed: %s (grid %d)\n", hipGetErrorString(e), grid_blocks);
}
```

```cpp
#include <hip/hip_runtime.h>
#include <hip/hip_cooperative_groups.h>
#include <cstdio>
namespace cg = cooperative_groups;

#define NT 16384
#define SEQ 4096
#define DM 1024
#define DIN 2304
#define NMEM 256
#define EPSF 1e-6f
#define NWAVES 8
#define LDS_BYTES 147456

typedef unsigned short bf16;
#define LAS __attribute__((address_space(3)))

struct Params {
  const float* in[31];
  float* out;
  unsigned char* ws;
};
typedef __attribute__((address_space(4))) const unsigned char* kaptr_t;
__device__ __forceinline__ const float* karg_in(int i) {
  kaptr_t ka = (kaptr_t)__builtin_amdgcn_kernarg_segment_ptr();
  asm volatile("" : "+s"(ka));
  return *(const float* __attribute__((address_space(4))) const*)(ka + 8 * i);
}

constexpr size_t MiB = 1u << 20;
constexpr size_t WS_CTL  = 0;
constexpr size_t WS_WT   = 1 * MiB;
constexpr size_t WT_IN = 0, WT_OUT = WT_IN + (size_t)DIN * DM * 2, WT_MQ = WT_OUT + (size_t)DM * DM * 2,
                 WT_MKV = WT_MQ + (size_t)DM * DM * 2, WT_MO = WT_MKV + (size_t)2048 * DM * 2,
                 WT_PQ = WT_MO + (size_t)DM * DM * 2, WT_GLU = WT_PQ + (size_t)2048 * DM * 2, WT_LAYER = WT_GLU + (size_t)256 * 256 * 2;
constexpr size_t WS_XW   = WS_WT + 2 * WT_LAYER;
constexpr size_t WS_XN   = WS_XW + (size_t)NT * DM * 4;
constexpr size_t WS_BIG  = WS_XN + (size_t)NT * DM * 2;
constexpr size_t WS_Y    = WS_BIG + (size_t)NT * DIN * 2;
constexpr size_t WS_MEMH = WS_Y + (size_t)NT * DM * 2;
constexpr size_t WS_KVB  = WS_MEMH + (size_t)2 * 1024 * 1024 * 2;
constexpr size_t WS_VT   = WS_KVB + (size_t)2 * 1024 * 2048 * 2;
constexpr size_t WS_SSME = WS_VT + (size_t)2 * 4 * 4 * 256 * 256 * 2;
#define SSMP_PER_LAYER (2048 + 2048 + 32768)
constexpr size_t WS_SSMP = WS_SSME + (size_t)4 * 64 * 16 * 64 * 2 * 4;
constexpr size_t WS_IDS  = WS_SSMP + (size_t)2 * SSMP_PER_LAYER * 4;
constexpr size_t WS_GATE = WS_IDS + (size_t)NT * 128 * 4;
constexpr size_t WS_SKB  = WS_GATE + (size_t)NT * 128 * 4;
constexpr size_t WS_UB   = WS_SKB + (size_t)2 * 8 * 2 * 128 * 128 * 2;
constexpr size_t WS_VB   = WS_UB + (size_t)2 * 16384 * 1024;
constexpr size_t WS_RST  = WS_VB + (size_t)2 * 16384 * 1024;
constexpr size_t WS_END  = WS_RST + (size_t)NT * 16 * 4;
#define U_SCALE 64.0f
#define V_SCALE 1.0f
static_assert(WS_END <= 512 * MiB, "workspace");
static_assert(WT_LAYER % 256 == 0 && WS_SSMP % 16 == 0 && WS_IDS % 16 == 0 && WS_SKB % 256 == 0 && WS_VT % 256 == 0, "align");

__device__ __forceinline__ int opaque_tid(int wave_s) { int v = wave_s * 64 + (int)__builtin_amdgcn_mbcnt_hi(~0u, __builtin_amdgcn_mbcnt_lo(~0u, 0u)); asm volatile("" : "+v"(v)); return v; }
__device__ __forceinline__ unsigned f2bf(float f) { unsigned u = __builtin_bit_cast(unsigned, f); return (u + 0x7fffu + ((u >> 16) & 1u)) >> 16; }
__device__ __forceinline__ unsigned pk2(float lo, float hi) { return f2bf(lo) | (f2bf(hi) << 16); }
__device__ __forceinline__ float bf_lo(unsigned u) { return __builtin_bit_cast(float, u << 16); }
__device__ __forceinline__ float bf_hi(unsigned u) { return __builtin_bit_cast(float, u & 0xffff0000u); }
__device__ __forceinline__ float bf2f(bf16 h) { return __builtin_bit_cast(float, (unsigned)h << 16); }


#define XB_TMO      128
#define XB_XCNT(j)  (256  + 64 * (j))
#define XB_XSUB(j)  (1280 + 64 * (j))
#define XB_XGEN(j)  (2304 + 64 * (j))
#define XB_TOP      3328
#define XB_TOPGEN   3392
#define XCD_BAR_WORDS 3456
#define XB_SPIN_CAP (1u << 22)
__device__ __forceinline__ unsigned xb_ld(unsigned* p)              { return __hip_atomic_load(p, __ATOMIC_RELAXED, __HIP_MEMORY_SCOPE_AGENT); }
__device__ __forceinline__ unsigned xb_add(unsigned* p, unsigned v) { return __hip_atomic_fetch_add(p, v, __ATOMIC_RELAXED, __HIP_MEMORY_SCOPE_AGENT); }
__device__ __forceinline__ unsigned xb_xcc_id() { return (unsigned)__builtin_amdgcn_s_getreg((3 << 11) | 20) & 0xFu; }
#define XB_SPIN(cond, bar) do { unsigned _sp = 0; while (cond) { __builtin_amdgcn_s_sleep(1); \
    if ((++_sp & 255u) == 0u) { if (xb_ld(&(bar)[XB_TMO])) break; if (_sp > XB_SPIN_CAP) { atomicAdd(&(bar)[XB_TMO], 1u); break; } } } } while (0)
struct XcdBarrier { unsigned* bar; unsigned x; volatile LAS unsigned* st; };
__device__ __forceinline__ XcdBarrier xcd_barrier_post(unsigned* bar, volatile LAS unsigned* st) {
    XcdBarrier b; b.bar = bar; b.x = xb_xcc_id(); b.st = st;
    if (threadIdx.x == 0) (void)xb_add(&bar[XB_XCNT(b.x)], 1u);
    return b;
}
__device__ __forceinline__ void xcd_barrier_complete(unsigned* bar, unsigned x, unsigned& nloc, unsigned& nx) {
    const unsigned G = gridDim.x * gridDim.y * gridDim.z;
    unsigned sum, cnt, mine, sp = 0u;
    for (;;) {
        sum = 0u; cnt = 0u; mine = 0u;
#pragma unroll
        for (unsigned j = 0; j < 16; ++j) { const unsigned c = xb_ld(&bar[XB_XCNT(j)]); sum += c; cnt += (c > 0u) ? 1u : 0u; mine = (j == x) ? c : mine; }
        if (sum == G) break;
        __builtin_amdgcn_s_sleep(1);
        if ((++sp & 255u) == 0u) { if (xb_ld(&bar[XB_TMO])) break; if (sp > XB_SPIN_CAP) { atomicAdd(&bar[XB_TMO], 1u); break; } }
    }
    nloc = mine > 0u ? mine : 1u; nx = cnt > 0u ? cnt : 1u;
}
__device__ __forceinline__ void xcd_barrier(const XcdBarrier& b) {
    asm volatile("s_waitcnt vmcnt(0)" ::: "memory");
    __syncthreads();
    if (threadIdx.x == 0) {
        unsigned* bar = b.bar;
        __builtin_amdgcn_s_waitcnt(0);
        unsigned nloc = b.st[0], nx = b.st[1];
        if (nloc == 0u) { xcd_barrier_complete(bar, b.x, nloc, nx); b.st[0] = nloc; b.st[1] = nx; }
        const unsigned old = xb_add(&bar[XB_XSUB(b.x)], 1u);
        const unsigned gen = old / nloc;
        if (old + 1u == (gen + 1u) * nloc) {
            __builtin_amdgcn_fence(__ATOMIC_RELEASE, "agent");
            asm volatile("s_waitcnt vmcnt(0)" ::: "memory");
            const unsigned og = xb_add(&bar[XB_TOP], 1u);
            const unsigned tg = og / nx;
            if (og + 1u == (tg + 1u) * nx) xb_add(&bar[XB_TOPGEN], 1u);
            else XB_SPIN(xb_ld(&bar[XB_TOPGEN]) == tg, bar);
            __builtin_amdgcn_fence(__ATOMIC_ACQUIRE, "agent");
            xb_add(&bar[XB_XGEN(b.x)], 1u);
            asm volatile("s_waitcnt vmcnt(0)" ::: "memory");
        } else {
            XB_SPIN(xb_ld(&bar[XB_XGEN(b.x)]) == gen, bar);
            __builtin_amdgcn_fence(__ATOMIC_ACQUIRE, "agent");
            asm volatile("s_waitcnt vmcnt(0)" ::: "memory");
        }
    }
    __syncthreads();
}

namespace pg8 {
#define PG8_LAS __attribute__((address_space(3)))
typedef unsigned short bf16_t;
typedef short bf16x8 __attribute__((ext_vector_type(8)));
typedef float f32x4 __attribute__((ext_vector_type(4)));
typedef unsigned u32x4 __attribute__((ext_vector_type(4)));
constexpr int BM = 256, BK = 64, HALF = 128, HTB = HALF * BK * 2, STAGE_BYTES = 8 * HTB, NXCD = 8, WGM = 8;
__host__ __device__ __forceinline__ int lds_byte(int r, int c) { const int st = (r >> 4) * 2 + (c >> 5), rr = r & 15, cc = c & 31, ob = rr * 64 + cc * 2; return st * 1024 + (ob ^ (((ob >> 9) & 1) << 5)); }
__host__ __device__ __forceinline__ void stage_rc(int b, int& R, int& C) { const int st = b / 1024, sb = b % 1024, swz = sb ^ (((sb >> 9) & 1) << 5); R = (st >> 1) * 16 + swz / 64; C = (st & 1) * 32 + (swz % 64) / 2; }
__host__ __device__ __forceinline__ int perm32(int rho) { const int n = rho >> 4, i = rho & 15; return 8 * (i >> 2) + 4 * n + (i & 3); }
struct Unit { int pm, pn; };
struct Gemm { const bf16_t* A; const bf16_t* Bt; int M, N, K; };
struct StaticOrder {
    int nM, nN, nwg, G, c;
    __host__ __device__ __forceinline__ void init(int M, int N, int G_, int c_) { nM = M / BM; nN = N / BM; nwg = nM * nN; G = G_; c = c_; }
    __host__ __device__ bool next(int i, Unit& u) const {
        const long L = (long)i * G + c; if (L >= nwg) return false;
        int wgid = (int)L; { const int q = nwg / NXCD, r = nwg % NXCD, xcd = wgid % NXCD, off = wgid / NXCD; wgid = (xcd < r ? xcd * (q + 1) : r * (q + 1) + (xcd - r) * q) + off; }
        const int nig = WGM * nN, gid = wgid / nig, fm = gid * WGM, gsz = (nM - fm) < WGM ? (nM - fm) : WGM;
        u.pm = fm + ((wgid % nig) % gsz); u.pn = (wgid % nig) / gsz; return true;
    }
    __device__ __forceinline__ void a_ready(const Unit&) const {}
    __device__ __forceinline__ void done(const Unit&) const {}
};
__device__ __forceinline__ unsigned cvt_pk_bf16(float lo, float hi) { unsigned r; asm volatile("v_cvt_pk_bf16_f32 %0, %1, %2" : "=v"(r) : "v"(lo), "v"(hi)); return r; }

struct EpiF32R {
    static constexpr bool PERM = false, AFTER_DRAIN = false;
    float* C; const float* R; int ldc;
    __device__ __forceinline__ void operator()(const f32x4 (&acc)[2][2][4][2], const Unit& u, int wr, int wc, int fr, int fq) const {
        const int row0 = u.pm * BM + wr * 64 + fr, col0 = u.pn * BM + wc * 32 + 4 * fq;
#pragma unroll
        for (int ai = 0; ai < 2; ++ai)
#pragma unroll
            for (int m = 0; m < 4; ++m) {
                const size_t ro = (size_t)(row0 + ai * HALF + m * 16) * ldc + col0;
                f32x4 rv[2][2];
#pragma unroll
                for (int bj = 0; bj < 2; ++bj)
#pragma unroll
                    for (int n = 0; n < 2; ++n) rv[bj][n] = R ? *(const f32x4*)(R + ro + bj * HALF + n * 16) : (f32x4){0.f, 0.f, 0.f, 0.f};
#pragma unroll
                for (int bj = 0; bj < 2; ++bj)
#pragma unroll
                    for (int n = 0; n < 2; ++n) *(f32x4*)(C + ro + bj * HALF + n * 16) = acc[ai][bj][m][n] + rv[bj][n];
                __builtin_amdgcn_sched_barrier(0);
            }
    }
};

struct EpiBf16 {
    static constexpr bool PERM = true, AFTER_DRAIN = false;
    bf16_t* O; int ldc;
    __device__ __forceinline__ void operator()(const f32x4 (&acc)[2][2][4][2], const Unit& u, int wr, int wc, int fr, int fq) const {
        const int row0 = u.pm * BM + wr * 64 + fr, col0 = u.pn * BM + wc * 32 + 8 * fq;
#pragma unroll
        for (int ai = 0; ai < 2; ++ai)
#pragma unroll
            for (int m = 0; m < 4; ++m) { bf16_t* rowp = O + (size_t)(row0 + ai * HALF + m * 16) * ldc + col0;
#pragma unroll
                for (int bj = 0; bj < 2; ++bj) { const f32x4 v0 = acc[ai][bj][m][0], v1 = acc[ai][bj][m][1];
                    u32x4 w; w.x = cvt_pk_bf16(v0[0], v0[1]); w.y = cvt_pk_bf16(v0[2], v0[3]); w.z = cvt_pk_bf16(v1[0], v1[1]); w.w = cvt_pk_bf16(v1[2], v1[3]);
                    *(u32x4*)(rowp + bj * HALF) = w; } }
    }
};

struct EpiF32RN {
    static constexpr bool PERM = false, AFTER_DRAIN = false;
    float* C; const float* R; int ldc; bf16_t* XG; const float* g; float* st;
    __device__ __forceinline__ void operator()(const f32x4 (&acc)[2][2][4][2], const Unit& u, int wr, int wc, int fr, int fq) const {
        const int row0 = u.pm * BM + wr * 64 + fr, col0 = u.pn * BM + wc * 32 + 4 * fq;
        f32x4 gv[2][2];
#pragma unroll
        for (int bj = 0; bj < 2; ++bj)
#pragma unroll
            for (int n = 0; n < 2; ++n) gv[bj][n] = *(const f32x4*)(g + col0 + bj * HALF + n * 16);
#pragma unroll
        for (int ai = 0; ai < 2; ++ai)
#pragma unroll
            for (int m = 0; m < 4; ++m) {
                const int row = row0 + ai * HALF + m * 16;
                const size_t ro = (size_t)row * ldc + col0;
                f32x4 rv[2][2];
#pragma unroll
                for (int bj = 0; bj < 2; ++bj)
#pragma unroll
                    for (int n = 0; n < 2; ++n) rv[bj][n] = *(const f32x4*)(R + ro + bj * HALF + n * 16);
                float ss = 0.f;
#pragma unroll
                for (int bj = 0; bj < 2; ++bj)
#pragma unroll
                    for (int n = 0; n < 2; ++n) {
                        const f32x4 v = acc[ai][bj][m][n] + rv[bj][n];
                        *(f32x4*)(C + ro + bj * HALF + n * 16) = v;
                        ss += (v[0] * v[0] + v[1] * v[1]) + (v[2] * v[2] + v[3] * v[3]);
                        const f32x4 w = v * gv[bj][n];
                        uint2 pk; pk.x = cvt_pk_bf16(w[0], w[1]); pk.y = cvt_pk_bf16(w[2], w[3]);
                        *(uint2*)(XG + ro + bj * HALF + n * 16) = pk;
                    }
                ss += __shfl_xor(ss, 16, 64); ss += __shfl_xor(ss, 32, 64);
                if (fq == 0) st[(size_t)row * 16 + u.pn * 4 + wc] = ss;
                __builtin_amdgcn_sched_barrier(0);
            }
    }
};
struct EpiBf16S {
    static constexpr bool PERM = true, AFTER_DRAIN = false;
    bf16_t* O; int ldc; const float* st;
    __device__ __forceinline__ void operator()(const f32x4 (&acc)[2][2][4][2], const Unit& u, int wr, int wc, int fr, int fq) const {
        const int row0 = u.pm * BM + wr * 64 + fr, col0 = u.pn * BM + wc * 32 + 8 * fq;
#pragma unroll
        for (int ai = 0; ai < 2; ++ai)
#pragma unroll
            for (int m = 0; m < 4; ++m) {
                const int row = row0 + ai * HALF + m * 16;
                const f32x4* sp = (const f32x4*)(st + (size_t)row * 16);
                const f32x4 s0 = sp[0], s1 = sp[1], s2 = sp[2], s3 = sp[3];
                const f32x4 sa = (s0 + s1) + (s2 + s3);
                const float rs = __builtin_amdgcn_rsqf(((sa[0] + sa[1]) + (sa[2] + sa[3])) * (1.0f / 1024.f) + 1e-6f);
                bf16_t* rowp = O + (size_t)row * ldc + col0;
#pragma unroll
                for (int bj = 0; bj < 2; ++bj) { const f32x4 v0 = acc[ai][bj][m][0] * rs, v1 = acc[ai][bj][m][1] * rs;
                    u32x4 w; w.x = cvt_pk_bf16(v0[0], v0[1]); w.y = cvt_pk_bf16(v0[2], v0[3]); w.z = cvt_pk_bf16(v1[0], v1[1]); w.w = cvt_pk_bf16(v1[2], v1[3]);
                    *(u32x4*)(rowp + bj * HALF) = w; }
                __builtin_amdgcn_sched_barrier(0);
            }
    }
};

template <class Epi, class Sched, bool ALIGN_EPI = false, bool SP2 = false>
__device__ __forceinline__ void gemm_phase(const int wave_s, PG8_LAS unsigned char* lds, const Gemm g, const Sched& S, const Epi& E) {
    const int tid = opaque_tid(wave_s), wid = __builtin_amdgcn_readfirstlane(tid >> 6), lane = tid & 63, wr = wid >> 2, wc = wid & 3, fr = lane & 15, fq = lane >> 4;
    const int K = g.K, nt = K / BK;
    unsigned voffA[2], voffB[2];
#pragma unroll
    for (int i = 0; i < 2; ++i) { int R, C; stage_rc(tid * 16 + i * 8192, R, C); const int Rb = Epi::PERM ? ((R & ~31) + perm32(R & 31)) : R;
        voffA[i] = (unsigned)(R * K + C) * 2u; voffB[i] = (unsigned)(Rb * K + C) * 2u; }
    const size_t kstep = (size_t)(BK * 2);
    const size_t hstep = (size_t)HALF * K * 2;
    const size_t tstep = 2 * hstep;
    const unsigned ldsw = (unsigned)wid * 1024u;
    const int aoff = lds_byte(wr * 64 + fr, fq * 8), boff = lds_byte(wc * 32 + fr, fq * 8);
#define PG8_SA(b, h) (((b) * 2 + (h)) * HTB)
#define PG8_SB(b, h) ((4 + (b) * 2 + (h)) * HTB)
#define PG8_STAGE(bufoff, gbase, voff) do { _Pragma("unroll") for (int _i = 0; _i < 2; ++_i) \
        __builtin_amdgcn_global_load_lds((const unsigned*)((const char*)(gbase) + (voff)[_i]), (PG8_LAS unsigned*)(lds + (bufoff) + ldsw + _i * 8192), 16, 0, 0); } while (0)
#define PG8_LDA(dst, b, h) do { _Pragma("unroll") for (int m = 0; m < 4; ++m) _Pragma("unroll") for (int k = 0; k < 2; ++k) dst[m][k] = *(const PG8_LAS bf16x8*)(lds + PG8_SA(b, h) + aoff + m * 2048 + k * 1024); } while (0)
#define PG8_LDB(dst, b, h) do { _Pragma("unroll") for (int n = 0; n < 2; ++n) _Pragma("unroll") for (int k = 0; k < 2; ++k) dst[n][k] = *(const PG8_LAS bf16x8*)(lds + PG8_SB(b, h) + boff + n * 2048 + k * 1024); } while (0)
#define PG8_MMA(ai, bj, At, Bt) do { __builtin_amdgcn_s_setprio(1); _Pragma("unroll") for (int m = 0; m < 4; ++m) _Pragma("unroll") for (int n = 0; n < 2; ++n) _Pragma("unroll") for (int k = 0; k < 2; ++k) \
        acc[ai][bj][m][n] = __builtin_amdgcn_mfma_f32_16x16x32_bf16(Bt[n][k], At[m][k], acc[ai][bj][m][n], 0, 0, 0); __builtin_amdgcn_s_setprio(0); } while (0)
#define PG8_WAIT_V(n) asm volatile("s_waitcnt vmcnt(" #n ")" ::: "memory")
#define PG8_WAIT_L(n) asm volatile("s_waitcnt lgkmcnt(" #n ")" ::: "memory")
#define PG8_BAR __builtin_amdgcn_s_barrier()
#define PG8_SCHED __builtin_amdgcn_sched_barrier(0)
    Unit cur, nxt; int ui = 0;
    if (!S.next(0, cur)) return;
    f32x4 acc[2][2][4][2];
#pragma unroll
    for (int a = 0; a < 2; ++a)
#pragma unroll
        for (int b = 0; b < 2; ++b)
#pragma unroll
            for (int m = 0; m < 4; ++m)
#pragma unroll
                for (int n = 0; n < 2; ++n) acc[a][b][m][n] = (f32x4){0.f, 0.f, 0.f, 0.f};
    bf16x8 At[4][2], B0[2][2], B1[2][2];
    const char* cA = (const char*)g.A + (size_t)cur.pm * tstep; const char* cB = (const char*)g.Bt + (size_t)cur.pn * tstep;
    S.a_ready(cur);
    if constexpr (SP2) {
        PG8_STAGE(PG8_SB(0, 0), cB, voffB); PG8_STAGE(PG8_SB(0, 1), cB + hstep, voffB); PG8_STAGE(PG8_SA(0, 0), cA, voffA); PG8_STAGE(PG8_SA(0, 1), cA + hstep, voffA);
        if (wr == 1) PG8_BAR;
        PG8_WAIT_V(2); PG8_BAR;
        PG8_STAGE(PG8_SB(1, 0), cB + kstep, voffB); PG8_STAGE(PG8_SA(1, 0), cA + kstep, voffA); PG8_STAGE(PG8_SB(1, 1), cB + hstep + kstep, voffB);
        PG8_WAIT_V(6); PG8_BAR;
    } else {
        PG8_STAGE(PG8_SB(0, 0), cB, voffB); PG8_STAGE(PG8_SA(0, 0), cA, voffA); PG8_STAGE(PG8_SB(0, 1), cB + hstep, voffB); PG8_STAGE(PG8_SA(0, 1), cA + hstep, voffA);
        if (wr == 1) PG8_BAR;
        PG8_WAIT_V(4); PG8_BAR;
        PG8_STAGE(PG8_SB(1, 0), cB + kstep, voffB); PG8_STAGE(PG8_SA(1, 0), cA + kstep, voffA); PG8_STAGE(PG8_SB(1, 1), cB + hstep + kstep, voffB);
        PG8_WAIT_V(6); PG8_BAR;
    }
    for (;;) {
        const bool has_next = S.next(ui + 1, nxt);
        const char* nA = has_next ? (const char*)g.A + (size_t)nxt.pm * tstep : cA; const char* nB = has_next ? (const char*)g.Bt + (size_t)nxt.pn * tstep : cB;
        for (int t = 0; t < nt; t += 2) {
            const bool last = (t == nt - 2);
            const char* a1 = cA + (size_t)(t + 1) * kstep;
            const char* a2 = last ? nA : cA + (size_t)(t + 2) * kstep; const char* b2 = last ? nB : cB + (size_t)(t + 2) * kstep;
            const char* a3 = a2 + kstep; const char* b3 = b2 + kstep;
            if (last && has_next) S.a_ready(nxt);
            if constexpr (SP2) {
            PG8_LDB(B0, 0, 0); PG8_LDB(B1, 0, 1); PG8_SCHED; PG8_LDA(At, 0, 0); PG8_STAGE(PG8_SA(1, 1), a1 + hstep, voffA);
            PG8_WAIT_V(8); PG8_WAIT_L(0); PG8_BAR; PG8_MMA(0, 0, At, B0); PG8_MMA(0, 1, At, B1); PG8_BAR; PG8_SCHED;
            PG8_LDA(At, 0, 1); PG8_STAGE(PG8_SB(0, 0), b2, voffB); PG8_STAGE(PG8_SB(0, 1), b2 + hstep, voffB); PG8_STAGE(PG8_SA(0, 0), a2, voffA);
            PG8_WAIT_V(8); PG8_WAIT_L(0); PG8_BAR; PG8_MMA(1, 0, At, B0); PG8_MMA(1, 1, At, B1); PG8_BAR; PG8_SCHED;
            PG8_LDB(B0, 1, 0); PG8_LDB(B1, 1, 1); PG8_SCHED; PG8_LDA(At, 1, 0); PG8_STAGE(PG8_SA(0, 1), a2 + hstep, voffA);
            PG8_WAIT_V(8); PG8_WAIT_L(0); PG8_BAR; PG8_MMA(0, 0, At, B0); PG8_MMA(0, 1, At, B1); PG8_BAR; PG8_SCHED;
            PG8_LDA(At, 1, 1); PG8_STAGE(PG8_SB(1, 0), b3, voffB); PG8_STAGE(PG8_SB(1, 1), b3 + hstep, voffB); PG8_STAGE(PG8_SA(1, 0), a3, voffA);
            PG8_WAIT_V(8); PG8_WAIT_L(0); PG8_BAR; PG8_MMA(1, 0, At, B0); PG8_MMA(1, 1, At, B1); PG8_BAR; PG8_SCHED;
            } else {
            PG8_LDB(B0, 0, 0); PG8_SCHED; PG8_LDA(At, 0, 0); PG8_STAGE(PG8_SA(1, 1), a1 + hstep, voffA);
            PG8_WAIT_L(8); PG8_BAR; PG8_WAIT_L(0); PG8_MMA(0, 0, At, B0); PG8_BAR; PG8_SCHED;
            PG8_LDB(B1, 0, 1); PG8_STAGE(PG8_SB(0, 0), b2, voffB);
            PG8_BAR; PG8_WAIT_L(0); PG8_MMA(0, 1, At, B1); PG8_BAR;
            PG8_LDA(At, 0, 1); PG8_STAGE(PG8_SA(0, 0), a2, voffA);
            PG8_BAR; PG8_WAIT_L(0); PG8_MMA(1, 0, At, B0); PG8_BAR; PG8_SCHED;
            PG8_STAGE(PG8_SB(0, 1), b2 + hstep, voffB);
            PG8_WAIT_V(6); PG8_BAR; PG8_MMA(1, 1, At, B1); PG8_BAR;
            PG8_LDB(B0, 1, 0); PG8_SCHED; PG8_LDA(At, 1, 0); PG8_STAGE(PG8_SA(0, 1), a2 + hstep, voffA);
            PG8_WAIT_L(8); PG8_BAR; PG8_WAIT_L(0); PG8_MMA(0, 0, At, B0); PG8_BAR; PG8_SCHED;
            PG8_LDB(B1, 1, 1); PG8_STAGE(PG8_SB(1, 0), b3, voffB);
            PG8_BAR; PG8_WAIT_L(0); PG8_MMA(0, 1, At, B1); PG8_BAR;
            PG8_LDA(At, 1, 1); PG8_STAGE(PG8_SA(1, 0), a3, voffA);
            PG8_BAR; PG8_WAIT_L(0); PG8_MMA(1, 0, At, B0); PG8_BAR; PG8_SCHED;
            PG8_STAGE(PG8_SB(1, 1), b3 + hstep, voffB);
            PG8_WAIT_V(6); PG8_BAR; PG8_MMA(1, 1, At, B1); PG8_BAR;
            }
        }
        if constexpr (ALIGN_EPI) { if (wr == 0) PG8_BAR; }
        if constexpr (!Epi::AFTER_DRAIN) { E(acc, cur, wr, wc, fr, fq); S.done(cur); }
        if (!has_next) break;
#pragma unroll
        for (int a = 0; a < 2; ++a)
#pragma unroll
            for (int b = 0; b < 2; ++b)
#pragma unroll
                for (int m = 0; m < 4; ++m)
#pragma unroll
                    for (int n = 0; n < 2; ++n) acc[a][b][m][n] = (f32x4){0.f, 0.f, 0.f, 0.f};
        cur = nxt; cA = nA; cB = nB; ++ui;
        if constexpr (ALIGN_EPI) { if (wr == 1) PG8_BAR; }
    }
    PG8_WAIT_V(0);
    if constexpr (!ALIGN_EPI) { if (wr == 0) PG8_BAR; }
    PG8_BAR;
#undef PG8_SA
#undef PG8_SB
#undef PG8_STAGE
#undef PG8_LDA
#undef PG8_LDB
#undef PG8_MMA
#undef PG8_WAIT_V
#undef PG8_WAIT_L
#undef PG8_BAR
#undef PG8_SCHED
}
}

__device__ __forceinline__ void transpose_item(const float* W, int K, int N, bf16* WT, LAS float* scr, int item, int lane) {
    const int nblk = N / 32, kb = item / nblk, nb = item % nblk, k0 = 64 * kb, n0 = 32 * nb;
#pragma unroll 8
    for (int i = 0; i < 32; ++i) { const int kk = 2 * i + (lane >> 5); scr[kk * 33 + (lane & 31)] = W[(size_t)(k0 + kk) * N + n0 + (lane & 31)]; }
    asm volatile("s_waitcnt lgkmcnt(0)" ::: "memory");
    const int c = lane & 7;
#pragma unroll
    for (int j = 0; j < 4; ++j) { const int n = (lane >> 3) + 8 * j; const LAS float* s = scr + (8 * c) * 33 + n;
        uint4 o; o.x = pk2(s[0 * 33], s[1 * 33]); o.y = pk2(s[2 * 33], s[3 * 33]); o.z = pk2(s[4 * 33], s[5 * 33]); o.w = pk2(s[6 * 33], s[7 * 33]);
        *(uint4*)(WT + (size_t)(n0 + n) * K + k0 + 8 * c) = o; }
    asm volatile("s_waitcnt lgkmcnt(0)" ::: "memory");
}

__device__ __forceinline__ float wsum(float v) {
#pragma unroll
  for (int o = 32; o > 0; o >>= 1) v += __shfl_xor(v, o, 64);
  return v;
}
__device__ __forceinline__ float wmaxf(float v) {
#pragma unroll
  for (int o = 32; o > 0; o >>= 1) v = fmaxf(v, __shfl_xor(v, o, 64));
  return v;
}
__device__ __forceinline__ float sigmoidf_(float x) { return 1.0f / (1.0f + expf(-x)); }
__device__ __forceinline__ float gelu_tanh(float x) {
  return 0.5f * x * (1.0f + tanhf(0.7978845608028654f * (x + 0.044715f * x * x * x)));
}

template <bool BF16OUT>
__device__ __forceinline__ void rms_rows(const int wave_s, const float* src, const float* g, void* dstv, int rows) {
  const int tid_ = opaque_tid(wave_s);
  const int lane = tid_ & 63;
  const int gw = blockIdx.x * NWAVES + (tid_ >> 6);
  const int nw = gridDim.x * NWAVES;
  for (int r = gw; r < rows; r += nw) {
    const float4* s4 = (const float4*)(src + (size_t)r * DM);
    float4 v[4];
    float ss = 0.f;
#pragma unroll
    for (int i = 0; i < 4; i++) {
      v[i] = s4[lane + i * 64];
      ss += v[i].x * v[i].x + v[i].y * v[i].y + v[i].z * v[i].z + v[i].w * v[i].w;
    }
    ss = wsum(ss);
    const float rstd = rsqrtf(ss * (1.0f / DM) + EPSF);
    const float4* g4 = (const float4*)g;
#pragma unroll
    for (int i = 0; i < 4; i++) {
      float4 gg = g4[lane + i * 64];
      float4 o;
      o.x = v[i].x * rstd * gg.x; o.y = v[i].y * rstd * gg.y;
      o.z = v[i].z * rstd * gg.z; o.w = v[i].w * rstd * gg.w;
      if (BF16OUT) {
        uint2 pk; pk.x = pk2(o.x, o.y); pk.y = pk2(o.z, o.w);
        ((uint2*)((bf16*)dstv + (size_t)r * DM))[lane + i * 64] = pk;
      } else {
        ((float4*)((float*)dstv + (size_t)r * DM))[lane + i * 64] = o;
      }
    }
  }
}

__device__ __forceinline__ void ssm_params(const int wave_s, const Params& p, float* ssmp_all) {
  const int tid_ = opaque_tid(wave_s);
  const float* in8 = karg_in(8); const float* in9 = karg_in(9); const float* in10 = karg_in(10);
  const float* in11 = karg_in(11); const float* in12 = karg_in(12);
  const int gt = blockIdx.x * blockDim.x + tid_;
  const int nth = gridDim.x * blockDim.x;
  for (int i = gt; i < 2 * 16 * 64; i += nth) {
    const int l = i / 1024, gp = i % 1024, g = gp / 64;
    float* sp = ssmp_all + (size_t)l * SSMP_PER_LAYER;
    const float lre = fminf(in8[l * 1024 + gp], -1e-4f);
    const float lim = in9[l * 1024 + gp];
    const float dt = expf(in10[l * 16 + g]);
    const float er = expf(lre * dt);
    float sn, cs;
    sincosf(lim * dt, &sn, &cs);
    const float br = er * cs, bi = er * sn;
    sp[gp * 2 + 0] = br;
    sp[gp * 2 + 1] = bi;
    float cr = br, ci = bi;
#pragma unroll
    for (int s = 0; s < 6; s++) {
      const float nr = cr * cr - ci * ci, ni = 2.f * cr * ci;
      cr = nr; ci = ni;
    }
    sp[2048 + gp * 2 + 0] = cr;
    sp[2048 + gp * 2 + 1] = ci;
    const float nr = br - 1.0f, ni = bi;
    const float den = lre * lre + lim * lim;
    const float fr = (nr * lre + ni * lim) / den;
    const float fi = (ni * lre - nr * lim) / den;
    for (int h = 0; h < 16; h++) {
      const float bre = in11[((size_t)l * 1024 + gp) * 16 + h];
      const float bim = in12[((size_t)l * 1024 + gp) * 16 + h];
      sp[4096 + ((g * 16 + h) * 64 + (gp & 63)) * 2 + 0] = fr * bre - fi * bim;
      sp[4096 + ((g * 16 + h) * 64 + (gp & 63)) * 2 + 1] = fr * bim + fi * bre;
    }
  }
}

__device__ __forceinline__ void conv_phase(const int wave_s, const Params& p, int l, const bf16* proj, bf16* y, LAS float* smem) {
  const int tid_ = opaque_tid(wave_s);
  const int lane = tid_ & 63;
  const int gw = blockIdx.x * NWAVES + (tid_ >> 6);
  const int nw = gridDim.x * NWAVES;
  const float* cw = karg_in(4) + (size_t)l * 31 * 256;
  const float4 cb = ((const float4*)(karg_in(5) + l * 256))[lane];
  const float4 lg = ((const float4*)(karg_in(6) + l * 256))[lane];
  const float4 lb = ((const float4*)(karg_in(7) + l * 256))[lane];
  const float4 gg = ((const float4*)(karg_in(18) + l * 1024))[lane];
  LAS float* cwl = smem + 1024;
  for (int i = tid_; i < 31 * 256 / 4; i += NWAVES * 64) *(LAS pg8::f32x4*)(cwl + 4 * i) = *(const pg8::f32x4*)(cw + 4 * i);
  __syncthreads();
  for (int it = gw; it < NT / 8; it += nw) {
    const int tok0 = it * 8;
    const int t0 = tok0 & (SEQ - 1);
    float4 acc[8];
#pragma unroll
    for (int o = 0; o < 8; o++) acc[o] = cb;
#pragma unroll
    for (int i = 0; i < 38; i++) {
      if (t0 - 30 + i >= 0) {
        const bf16* row = proj + (size_t)(tok0 - 30 + i) * DIN;
        const uint2 vp = ((const uint2*)row)[lane];
        const uint2 gp = ((const uint2*)(row + 256))[lane];
        float4 g4;
        g4.x = bf_lo(vp.x) * sigmoidf_(bf_lo(gp.x)); g4.y = bf_hi(vp.x) * sigmoidf_(bf_hi(gp.x));
        g4.z = bf_lo(vp.y) * sigmoidf_(bf_lo(gp.y)); g4.w = bf_hi(vp.y) * sigmoidf_(bf_hi(gp.y));
#pragma unroll
        for (int o = 0; o < 8; o++) {
          const int j = i - o;
          if (j >= 0 && j <= 30) {
            const pg8::f32x4 w4 = *(const LAS pg8::f32x4*)(cwl + j * 256 + lane * 4);
            acc[o].x += g4.x * w4[0]; acc[o].y += g4.y * w4[1];
            acc[o].z += g4.z * w4[2]; acc[o].w += g4.w * w4[3];
          }
        }
      }
    }
#pragma unroll
    for (int o = 0; o < 8; o++) {
      const float4 a = acc[o];
      const float mean = wsum(a.x + a.y + a.z + a.w) * (1.0f / 256.f);
      const float dx = a.x - mean, dy = a.y - mean, dz = a.z - mean, dw = a.w - mean;
      const float var = wsum(dx * dx + dy * dy + dz * dz + dw * dw) * (1.0f / 256.f);
      const float rs = rsqrtf(var + EPSF);
      float4 s;
      s.x = dx * rs * lg.x + lb.x; s.y = dy * rs * lg.y + lb.y;
      s.z = dz * rs * lg.z + lb.z; s.w = dw * rs * lg.w + lb.w;
      s.x = s.x * sigmoidf_(s.x); s.y = s.y * sigmoidf_(s.y);
      s.z = s.z * sigmoidf_(s.z); s.w = s.w * sigmoidf_(s.w);
      const float ss = wsum(s.x * s.x + s.y * s.y + s.z * s.z + s.w * s.w) * (1.0f / 256.f);
      const float r2 = rsqrtf(ss + EPSF);
      uint2 pk; pk.x = pk2(s.x * r2 * gg.x, s.y * r2 * gg.y); pk.y = pk2(s.z * r2 * gg.z, s.w * r2 * gg.w);
      ((uint2*)(y + (size_t)(tok0 + o) * DM))[lane] = pk;
    }
  }
}

typedef short bf16x8_t __attribute__((ext_vector_type(8)));
typedef float f32x16_t __attribute__((ext_vector_type(16)));
#define MFMA_PAD() do { __builtin_amdgcn_sched_barrier(0); asm volatile("s_nop 15\n\ts_nop 15" ::: "memory"); __builtin_amdgcn_sched_barrier(0); } while (0)

__device__ __forceinline__ void attn_phase(const int wave_s, const Params& p, int l, const bf16* proj, bf16* y, LAS float* smem) {
  const int tid = opaque_tid(wave_s), lane = tid & 63, wave = tid >> 6;
  const int n = lane & 31, hh = lane >> 5;
  const float* gg = karg_in(18) + l * 1024 + 256 + wave * 64;
  const float g0 = gg[n], g1 = gg[32 + n];
  LAS float* ssq = smem;
  LAS float* rstd = smem + 256;
  for (int item = blockIdx.x; item < 4 * 128; item += gridDim.x) {
    const int b = item >> 7, q0 = (item & 127) * 32;
    const size_t tokb = (size_t)b * SEQ;
    bf16x8_t qf[4];
    {
      const bf16* qrow = proj + (tokb + q0 + n) * DIN + 512 + wave * 64 + 8 * hh;
#pragma unroll
      for (int ks = 0; ks < 4; ks++) qf[ks] = *(const bf16x8_t*)(qrow + 16 * ks);
    }
    f32x16_t o0, o1;
#pragma unroll
    for (int r = 0; r < 16; r++) { o0[r] = 0.f; o1[r] = 0.f; }
    float R = 0.f;
    for (int kt = q0; kt >= 0; kt -= 32) {
      bf16x8_t kf[4];
      {
        const bf16* krow = proj + (tokb + kt + n) * DIN + 1024 + wave * 64 + 8 * hh;
#pragma unroll
        for (int ks = 0; ks < 4; ks++) kf[ks] = *(const bf16x8_t*)(krow + 16 * ks);
      }
      bf16x8_t vf0[2], vf1[2];
      {
        const bf16* vb = proj + (tokb + kt + 4 * hh) * DIN + 1536 + wave * 64 + n;
#pragma unroll
        for (int s = 0; s < 2; s++)
#pragma unroll
          for (int j = 0; j < 8; j++) {
            const int key = 16 * s + 8 * (j >> 2) + (j & 3);
            vf0[s][j] = (short)vb[(size_t)key * DIN];
            vf1[s][j] = (short)vb[(size_t)key * DIN + 32];
          }
      }
      f32x16_t sacc;
#pragma unroll
      for (int r = 0; r < 16; r++) sacc[r] = 0.f;
      __builtin_amdgcn_sched_barrier(0); asm volatile("s_nop 15\n\ts_nop 15" ::: "memory"); __builtin_amdgcn_sched_barrier(0);
#pragma unroll
      for (int ks = 0; ks < 4; ks++) sacc = __builtin_amdgcn_mfma_f32_32x32x16_bf16(kf[ks], qf[ks], sacc, 0, 0, 0);
      __builtin_amdgcn_sched_barrier(0); asm volatile("s_nop 15\n\ts_nop 15" ::: "memory"); __builtin_amdgcn_sched_barrier(0);
      float lst[16], lsz[16];
      const bool diag = (kt == q0);
#pragma unroll
      for (int r = 0; r < 16; r++) {
        const float z = sacc[r] * 0.125f;
        const float sp = __logf(1.0f + __expf(-fabsf(z)));
        float a = fminf(z, 0.f) - sp;
        float c = -(fmaxf(z, 0.f) + sp);
        if (diag) {
          const int key = (r & 3) + 8 * (r >> 2) + 4 * hh;
          if (key >= n) { a = -1.0e30f; c = 0.f; }
        }
        lsz[r] = a; lst[r] = c;
      }
      float Gs[4], Gp[4];
#pragma unroll
      for (int g = 0; g < 4; g++) {
        Gs[g] = (lst[4 * g] + lst[4 * g + 1]) + (lst[4 * g + 2] + lst[4 * g + 3]);
        Gp[g] = __shfl_xor(Gs[g], 32, 64);
      }
      float carry[4];
      {
        float after = R;
#pragma unroll
        for (int g = 3; g >= 0; g--) {
          carry[g] = after + (hh ? 0.f : Gp[g]);
          after += Gs[g] + Gp[g];
        }
        R = after;
      }
      bf16x8_t pf[2];
#pragma unroll
      for (int g = 0; g < 4; g++) {
        float run = carry[g];
        float a3 = __expf(lsz[4 * g + 3] + run); run += lst[4 * g + 3];
        float a2 = __expf(lsz[4 * g + 2] + run); run += lst[4 * g + 2];
        float a1 = __expf(lsz[4 * g + 1] + run); run += lst[4 * g + 1];
        float a0 = __expf(lsz[4 * g + 0] + run);
        const int s = g >> 1, jb = (g & 1) * 4;
        pf[s][jb + 0] = (short)f2bf(a0); pf[s][jb + 1] = (short)f2bf(a1);
        pf[s][jb + 2] = (short)f2bf(a2); pf[s][jb + 3] = (short)f2bf(a3);
      }
      __builtin_amdgcn_sched_barrier(0); asm volatile("s_nop 15\n\ts_nop 15" ::: "memory"); __builtin_amdgcn_sched_barrier(0);
#pragma unroll
      for (int s = 0; s < 2; s++) {
        o0 = __builtin_amdgcn_mfma_f32_32x32x16_bf16(pf[s], vf0[s], o0, 0, 0, 0);
        o1 = __builtin_amdgcn_mfma_f32_32x32x16_bf16(pf[s], vf1[s], o1, 0, 0, 0);
      }
      __builtin_amdgcn_sched_barrier(0); asm volatile("s_nop 15\n\ts_nop 15" ::: "memory"); __builtin_amdgcn_sched_barrier(0);
      if (__all(R < -110.f)) break;
    }
    float sq[16];
#pragma unroll
    for (int r = 0; r < 16; r++) {
      float v = o0[r] * o0[r] + o1[r] * o1[r];
#pragma unroll
      for (int o = 16; o > 0; o >>= 1) v += __shfl_xor(v, o, 64);
      sq[r] = v;
    }
    __syncthreads();
    if (n == 0) {
#pragma unroll
      for (int r = 0; r < 16; r++) ssq[wave * 32 + (r & 3) + 8 * (r >> 2) + 4 * hh] = sq[r];
    }
    __syncthreads();
    if (tid < 32) {
      float t = 0.f;
#pragma unroll
      for (int w = 0; w < 8; w++) t += ssq[w * 32 + tid];
      rstd[tid] = rsqrtf(t * (1.0f / 512.f) + EPSF);
    }
    __syncthreads();
#pragma unroll
    for (int r = 0; r < 16; r++) {
      const int qi = (r & 3) + 8 * (r >> 2) + 4 * hh;
      const float rs = rstd[qi];
      bf16* yr = y + (tokb + q0 + qi) * DM + 256 + wave * 64 + n;
      yr[0] = (bf16)f2bf(o0[r] * rs * g0);
      yr[32] = (bf16)f2bf(o1[r] * rs * g1);
    }
  }
}

#define SSM_BCAST_U(u, ua, ub, tt) do { \
    const unsigned w0 = (unsigned)__builtin_amdgcn_readlane((int)(ua).x, (tt)), w1 = (unsigned)__builtin_amdgcn_readlane((int)(ua).y, (tt)); \
    const unsigned w2 = (unsigned)__builtin_amdgcn_readlane((int)(ua).z, (tt)), w3 = (unsigned)__builtin_amdgcn_readlane((int)(ua).w, (tt)); \
    const unsigned w4 = (unsigned)__builtin_amdgcn_readlane((int)(ub).x, (tt)), w5 = (unsigned)__builtin_amdgcn_readlane((int)(ub).y, (tt)); \
    const unsigned w6 = (unsigned)__builtin_amdgcn_readlane((int)(ub).z, (tt)), w7 = (unsigned)__builtin_amdgcn_readlane((int)(ub).w, (tt)); \
    (u)[0] = bf_lo(w0); (u)[1] = bf_hi(w0); (u)[2] = bf_lo(w1); (u)[3] = bf_hi(w1); (u)[4] = bf_lo(w2); (u)[5] = bf_hi(w2); (u)[6] = bf_lo(w3); (u)[7] = bf_hi(w3); \
    (u)[8] = bf_lo(w4); (u)[9] = bf_hi(w4); (u)[10] = bf_lo(w5); (u)[11] = bf_hi(w5); (u)[12] = bf_lo(w6); (u)[13] = bf_hi(w6); (u)[14] = bf_lo(w7); (u)[15] = bf_hi(w7); } while (0)
__device__ __forceinline__ void ssm_chunk_end(const int wave_s, const float* ssmp, const bf16* proj, float* ssmE) {
  const int tid_ = opaque_tid(wave_s);
  const int lane = tid_ & 63;
  const int gw = blockIdx.x * NWAVES + (tid_ >> 6);
  const int nw = gridDim.x * NWAVES;
  for (int it = gw; it < 4 * 64 * 16; it += nw) {
    const int g = it & 15, c = (it >> 4) & 63, b = it >> 10;
    const int gp = g * 64 + lane;
    const uint4* up = (const uint4*)(proj + (size_t)(b * SEQ + c * 64 + lane) * DIN + 2048 + g * 16);
    const uint4 ua = up[0], ub = up[1];
    const float lbr = ssmp[gp * 2], lbi = ssmp[gp * 2 + 1];
    float bbr[16], bbi[16];
#pragma unroll
    for (int h = 0; h < 16; h++) {
      { const float2 bb = *(const float2*)(ssmp + 4096 + ((g * 16 + h) * 64 + lane) * 2); bbr[h] = bb.x; bbi[h] = bb.y; }
    }
    float xr = 0.f, xi = 0.f;
#pragma unroll 2
    for (int tt = 0; tt < 64; tt++) {
      float u[16];
      SSM_BCAST_U(u, ua, ub, tt);
      float br = 0.f, bi = 0.f;
#pragma unroll
      for (int h = 0; h < 16; h++) { br += bbr[h] * u[h]; bi += bbi[h] * u[h]; }
      const float nr = lbr * xr - lbi * xi + br;
      const float ni = lbr * xi + lbi * xr + bi;
      xr = nr; xi = ni;
    }
    float* e = ssmE + ((size_t)((b * 64 + c) * 16 + g) * 64 + lane) * 2;
    e[0] = xr; e[1] = xi;
  }
}

__device__ __forceinline__ void ssm_finish(const int wave_s, const Params& p, int l, const float* ssmp, const bf16* proj,
                           const float* ssmE, bf16* y, LAS float* smem) {
  LAS bf16* Ytb = (LAS bf16*)smem;
  LAS float* ssq2 = smem + (64 * 264 * 2) / 4;
  LAS float* rstd2 = ssq2 + 512;
  const bf16* glT = (const bf16*)(p.ws + WS_WT + (size_t)l * WT_LAYER + WT_GLU);
  const int tid = opaque_tid(wave_s), lane = tid & 63, wave = tid >> 6;
  const float* cre = karg_in(13) + (size_t)l * 16 * 16 * 64;
  const float* cim = karg_in(14) + (size_t)l * 16 * 16 * 64;
  const float* dsk = karg_in(15) + l * 256;
  const float* glw = karg_in(16) + (size_t)l * 256 * 256;
  const float* glb = karg_in(17) + l * 256;
  const float* gg = karg_in(18) + l * 1024 + 768;
  for (int it = blockIdx.x; it < 256; it += gridDim.x) {
    const int b = it >> 6, c = it & 63;
    __syncthreads();
    for (int gi = 0; gi < 2; gi++) {
      const int g = wave + gi * 8;
      const int gp = g * 64 + lane;
      const float lbr = ssmp[gp * 2], lbi = ssmp[gp * 2 + 1];
      const float lcr = ssmp[2048 + gp * 2], lci = ssmp[2048 + gp * 2 + 1];
      float bbr[16], bbi[16], ccr[16], cci[16];
#pragma unroll
      for (int h = 0; h < 16; h++) {
        { const float2 bb = *(const float2*)(ssmp + 4096 + ((g * 16 + h) * 64 + lane) * 2); bbr[h] = bb.x; bbi[h] = bb.y; }
        ccr[h] = cre[(g * 16 + h) * 64 + lane];
        cci[h] = cim[(g * 16 + h) * 64 + lane];
      }
      float xr = 0.f, xi = 0.f;
      {
        const float2* eb = (const float2*)ssmE + ((size_t)(b * 64) * 16 + g) * 64 + lane;
        int cc = 0;
        for (; cc + 8 <= c; cc += 8) {
          float2 ev[8];
#pragma unroll
          for (int k = 0; k < 8; k++) ev[k] = eb[(size_t)(cc + k) * 16 * 64];
#pragma unroll
          for (int k = 0; k < 8; k++) {
            const float nr = lcr * xr - lci * xi + ev[k].x;
            const float ni = lcr * xi + lci * xr + ev[k].y;
            xr = nr; xi = ni;
          }
        }
        for (; cc < c; cc++) {
          const float2 e1 = eb[(size_t)cc * 16 * 64];
          const float nr = lcr * xr - lci * xi + e1.x;
          const float ni = lcr * xi + lci * xr + e1.y;
          xr = nr; xi = ni;
        }
      }
      const int hq = ((lane >> 5) & 1) * 8 + ((lane >> 4) & 1) * 4 + ((lane >> 3) & 1) * 2 + ((lane >> 2) & 1);
      float dm[16];
#pragma unroll
      for (int h = 0; h < 16; h++) dm[h] = (lane == 0) ? dsk[g * 16 + h] : 0.f;
      const uint4* up = (const uint4*)(proj + (size_t)(b * SEQ + c * 64 + lane) * DIN + 2048 + g * 16);
      const uint4 ua = up[0], ub = up[1];
#pragma unroll 1
      for (int t4 = 0; t4 < 64; t4 += 4) {
        float vv[4][16];
#pragma unroll
        for (int s = 0; s < 4; s++) {
          float u[16];
          SSM_BCAST_U(u, ua, ub, t4 + s);
          float br = 0.f, bi = 0.f;
#pragma unroll
          for (int h = 0; h < 16; h++) { br += bbr[h] * u[h]; bi += bbi[h] * u[h]; }
          const float nr = lbr * xr - lbi * xi + br;
          const float ni = lbr * xi + lbi * xr + bi;
          xr = nr; xi = ni;
#pragma unroll
          for (int h = 0; h < 16; h++) vv[s][h] = xr * ccr[h] - xi * cci[h] + dm[h] * u[h];
        }
        float v1[4];
#pragma unroll
        for (int s = 0; s < 4; s++) {
          float v8[8], v4[4], v2[2];
          {
            const bool hi = (lane & 32) != 0;
#pragma unroll
            for (int i = 0; i < 8; i++) { const float send = hi ? vv[s][i] : vv[s][i + 8]; const float keep = hi ? vv[s][i + 8] : vv[s][i]; v8[i] = keep + __shfl_xor(send, 32, 64); }
          }
          {
            const bool hi = (lane & 16) != 0;
#pragma unroll
            for (int i = 0; i < 4; i++) { const float send = hi ? v8[i] : v8[i + 4]; const float keep = hi ? v8[i + 4] : v8[i]; v4[i] = keep + __shfl_xor(send, 16, 64); }
          }
          {
            const bool hi = (lane & 8) != 0;
#pragma unroll
            for (int i = 0; i < 2; i++) { const float send = hi ? v4[i] : v4[i + 2]; const float keep = hi ? v4[i + 2] : v4[i]; v2[i] = keep + __shfl_xor(send, 8, 64); }
          }
          {
            const bool hi = (lane & 4) != 0;
            const float send = hi ? v2[0] : v2[1];
            const float keep = hi ? v2[1] : v2[0];
            v1[s] = keep + __shfl_xor(send, 4, 64);
          }
          v1[s] += __shfl_xor(v1[s], 2, 64);
          v1[s] += __shfl_xor(v1[s], 1, 64);
        }
        if ((lane & 3) == 0) {
#pragma unroll
          for (int s = 0; s < 4; s++) Ytb[(t4 + s) * 264 + g * 16 + hq] = (bf16)f2bf(gelu_tanh(v1[s]));
        }
      }
    }
    __syncthreads();
    {
      const int n = lane & 31, hh = lane >> 5;
      const int ch = wave * 32 + n;
      const float bj = glb[ch];
      const float gj = gg[ch];
      bf16x8_t gf[16];
      {
        const bf16* grow = glT + (size_t)ch * 256 + 8 * hh;
#pragma unroll
        for (int ks = 0; ks < 16; ks++) gf[ks] = *(const bf16x8_t*)(grow + 16 * ks);
      }
      float oo[2][16];
#pragma unroll
      for (int mt = 0; mt < 2; mt++) {
        f32x16_t z;
#pragma unroll
        for (int r = 0; r < 16; r++) z[r] = 0.f;
        const LAS bf16* yrow = Ytb + (mt * 32 + n) * 264 + 8 * hh;
#pragma unroll
        for (int kq = 0; kq < 4; kq++) {
          bf16x8_t yf[4];
#pragma unroll
          for (int i = 0; i < 4; i++) yf[i] = *(const LAS bf16x8_t*)(yrow + 16 * (kq * 4 + i));
          MFMA_PAD();
#pragma unroll
          for (int i = 0; i < 4; i++) z = __builtin_amdgcn_mfma_f32_32x32x16_bf16(yf[i], gf[kq * 4 + i], z, 0, 0, 0);
          MFMA_PAD();
        }
        float sq[16];
#pragma unroll
        for (int r = 0; r < 16; r++) {
          const int t = mt * 32 + (r & 3) + 8 * (r >> 2) + 4 * hh;
          const float yv = bf2f(Ytb[t * 264 + ch]);
          const float o = yv * sigmoidf_(z[r] + bj);
          oo[mt][r] = o;
          float v = o * o;
#pragma unroll
          for (int s = 16; s > 0; s >>= 1) v += __shfl_xor(v, s, 64);
          sq[r] = v;
        }
        if (n == 0) {
#pragma unroll
          for (int r = 0; r < 16; r++) ssq2[wave * 64 + mt * 32 + (r & 3) + 8 * (r >> 2) + 4 * hh] = sq[r];
        }
      }
      __syncthreads();
      if (tid < 64) {
        float t = 0.f;
#pragma unroll
        for (int w = 0; w < 8; w++) t += ssq2[w * 64 + tid];
        rstd2[tid] = rsqrtf(t * (1.0f / 256.f) + EPSF);
      }
      __syncthreads();
#pragma unroll
      for (int mt = 0; mt < 2; mt++)
#pragma unroll
        for (int r = 0; r < 16; r++) {
          const int t = mt * 32 + (r & 3) + 8 * (r >> 2) + 4 * hh;
          y[(size_t)(b * SEQ + c * 64 + t) * DM + 768 + ch] = (bf16)f2bf(oo[mt][r] * rstd2[t] * gj);
        }
    }
  }
}

__device__ __forceinline__ void memattn_phase(const int wave_s, const bf16* q, const bf16* kvb, const bf16* vT, bf16* o, LAS float* smem) {
  const int tid_ = opaque_tid(wave_s);
  const int lane = tid_ & 63, n = lane & 31, hh = lane >> 5, wave = tid_ >> 6;
  const int sig = (n & 0x13) | ((n & 4) << 1) | ((n & 8) >> 1);
  LAS bf16* Ls = (LAS bf16*)smem;
  for (int it = blockIdx.x; it < 64 * 4; it += gridDim.x) {
    const int h = it & 3, tg = it >> 2, b = tg >> 4;
    const int tok0 = (tg * 8 + wave) * 32;
    __syncthreads();
    {
      const int r = tid_ >> 1, hf = tid_ & 1;
      const pg8::u32x4* src4 = (const pg8::u32x4*)(kvb + (size_t)(b * NMEM + r) * 2048 + h * 256 + hf * 128);
      LAS pg8::u32x4* dst4 = (LAS pg8::u32x4*)(Ls + r * 264 + hf * 128);
#pragma unroll
      for (int k = 0; k < 16; k++) dst4[k] = src4[k];
    }
    f32x16_t st[8];
#pragma unroll
    for (int kt = 0; kt < 8; kt++)
#pragma unroll
      for (int r = 0; r < 16; r++) st[kt][r] = 0.f;
    const bf16* qrow = q + (size_t)(tok0 + n) * DM + h * 256 + 8 * hh;
    __syncthreads();
#pragma unroll
    for (int kq = 0; kq < 4; kq++) {
      bf16x8_t qf[4];
#pragma unroll
      for (int i = 0; i < 4; i++) qf[i] = *(const bf16x8_t*)(qrow + 16 * (kq * 4 + i));
#pragma unroll
      for (int kt = 0; kt < 8; kt++) {
        const LAS bf16* krow = Ls + (kt * 32 + sig) * 264 + 8 * hh;
        bf16x8_t kf[4];
#pragma unroll
        for (int i = 0; i < 4; i++) kf[i] = *(const LAS bf16x8_t*)(krow + 16 * (kq * 4 + i));
        MFMA_PAD();
#pragma unroll
        for (int i = 0; i < 4; i++) st[kt] = __builtin_amdgcn_mfma_f32_32x32x16_bf16(kf[i], qf[i], st[kt], 0, 0, 0);
        MFMA_PAD();
      }
    }
    float mx = st[0][0];
#pragma unroll
    for (int kt = 0; kt < 8; kt++)
#pragma unroll
      for (int r = 0; r < 16; r++) mx = fmaxf(mx, st[kt][r]);
    mx = fmaxf(mx, __shfl_xor(mx, 32, 64));
    float sum = 0.f;
#pragma unroll
    for (int kt = 0; kt < 8; kt++)
#pragma unroll
      for (int r = 0; r < 16; r++) { const float e = __expf((st[kt][r] - mx) * 0.0625f); st[kt][r] = e; sum += e; }
    sum += __shfl_xor(sum, 32, 64);
    const float inv = 1.0f / sum;
    bf16x8_t pf[8][2];
#pragma unroll
    for (int kt = 0; kt < 8; kt++)
#pragma unroll
      for (int s = 0; s < 2; s++)
#pragma unroll
        for (int j = 0; j < 8; j++) pf[kt][s][j] = (short)f2bf(st[kt][8 * s + j] * inv);
    __syncthreads();
    {
      const int r = tid_ >> 1, hf = tid_ & 1;
      const pg8::u32x4* src4 = (const pg8::u32x4*)(vT + ((size_t)(b * 4 + h) * 256 + r) * 256 + hf * 128);
      LAS pg8::u32x4* dst4 = (LAS pg8::u32x4*)(Ls + r * 264 + hf * 128);
#pragma unroll
      for (int k = 0; k < 16; k++) dst4[k] = src4[k];
    }
    __syncthreads();
#pragma unroll 1
    for (int dt = 0; dt < 8; dt++) {
      f32x16_t oacc;
#pragma unroll
      for (int r = 0; r < 16; r++) oacc[r] = 0.f;
      const LAS bf16* vrow = Ls + (dt * 32 + n) * 264 + 8 * hh;
#pragma unroll
      for (int kq = 0; kq < 4; kq++) {
        bf16x8_t vf[4];
#pragma unroll
        for (int i = 0; i < 4; i++) vf[i] = *(const LAS bf16x8_t*)(vrow + (kq * 2 + (i >> 1)) * 32 + 16 * (i & 1));
        MFMA_PAD();
#pragma unroll
        for (int i = 0; i < 4; i++) oacc = __builtin_amdgcn_mfma_f32_32x32x16_bf16(pf[kq * 2 + (i >> 1)][i & 1], vf[i], oacc, 0, 0, 0);
        MFMA_PAD();
      }
#pragma unroll
      for (int r = 0; r < 16; r++) {
        const int qi = (r & 3) + 8 * (r >> 2) + 4 * hh;
        o[(size_t)(tok0 + qi) * DM + h * 256 + dt * 32 + n] = (bf16)f2bf(oacc[r]);
      }
    }
  }
}

__device__ __forceinline__ void vt_phase(const int wave_s, const bf16* kvb, bf16* vT) {
  const int tid_ = opaque_tid(wave_s);
  const int gt = blockIdx.x * (NWAVES * 64) + tid_;
  const int nth = gridDim.x * NWAVES * 64;
  for (int i = gt; i < 2 * 4 * 4 * 256 * 256; i += nth) {
    const int m = i & 255, d = (i >> 8) & 255, h = (i >> 16) & 3, b = (i >> 18) & 3, l = i >> 20;
    vT[i] = kvb[((size_t)l * 1024 + b * 256 + m) * 2048 + 1024 + h * 256 + d];
  }
}

__device__ __forceinline__ void topk_rounds(float (&s)[64], int hh, float (&tv)[16], int (&ti)[16]) {
  const float NEG = -3.0e38f;
#pragma unroll 1
  for (int r = 0; r < 16; r++) {
    float m = s[0]; int slot = 0;
#pragma unroll
    for (int i = 1; i < 64; i++) {
      const bool gt = s[i] > m;
      m = gt ? s[i] : m;
      slot = gt ? i : slot;
    }
    const int rr = slot & 15;
    const int idx = (slot >> 4) * 32 + (rr & 3) + 8 * (rr >> 2) + 4 * hh;
    const float pm = __shfl_xor(m, 32, 64);
    const int pidx = __shfl_xor(idx, 32, 64);
    const bool mine = (m > pm) || (m == pm && idx < pidx);
    const float wv = mine ? m : pm;
    const int wi = mine ? idx : pidx;
#pragma unroll
    for (int j = 0; j < 16; j++) { tv[j] = (r == j) ? wv : tv[j]; ti[j] = (r == j) ? wi : ti[j]; }
    const int kill = mine ? slot : -1;
#pragma unroll
    for (int i = 0; i < 64; i++) s[i] = (kill == i) ? NEG : s[i];
  }
}

__device__ __forceinline__ void peer_topk(const int wave_s, const bf16* pq, const bf16* skb, int* ids, float* gates) {
  const int tid_ = opaque_tid(wave_s);
  const int lane = tid_ & 63, n = lane & 31, hh = lane >> 5;
  const int gw = blockIdx.x * NWAVES + (tid_ >> 6);
  const int nw = gridDim.x * NWAVES;
  const float NEG = -3.0e38f;
  for (int it = gw; it < 512 * 8; it += nw) {
    const int h = it & 7, tok0 = (it >> 3) * 32;
    float tv0[16], tv1[16];
    int ti0[16], ti1[16];
#pragma unroll
    for (int j = 0; j < 16; j++) { tv0[j] = 0.f; tv1[j] = 0.f; ti0[j] = 0; ti1[j] = 0; }
#pragma unroll
    for (int half = 0; half < 2; half++) {
      bf16x8_t qf[8];
      {
        const bf16* qrow = pq + (size_t)(tok0 + n) * 2048 + h * 256 + half * 128 + 8 * hh;
#pragma unroll
        for (int ks = 0; ks < 8; ks++) qf[ks] = *(const bf16x8_t*)(qrow + 16 * ks);
      }
      f32x16_t st[4];
#pragma unroll
      for (int kt = 0; kt < 4; kt++) {
        const bf16* krow = skb + ((size_t)((h * 2 + half) * 128 + kt * 32 + n)) * 128 + 8 * hh;
        asm volatile("" : "+v"(krow));
        f32x16_t acc;
#pragma unroll
        for (int r = 0; r < 16; r++) acc[r] = 0.f;
#pragma unroll
        for (int kq = 0; kq < 2; kq++) {
          bf16x8_t kf[4];
#pragma unroll
          for (int i = 0; i < 4; i++) kf[i] = *(const bf16x8_t*)(krow + 16 * (kq * 4 + i));
          MFMA_PAD();
#pragma unroll
          for (int i = 0; i < 4; i++) acc = __builtin_amdgcn_mfma_f32_32x32x16_bf16(kf[i], qf[kq * 4 + i], acc, 0, 0, 0);
          MFMA_PAD();
        }
        st[kt] = acc;
      }
      float s[64];
#pragma unroll
      for (int kt = 0; kt < 4; kt++)
#pragma unroll
        for (int i = 0; i < 16; i++) s[kt * 16 + i] = st[kt][i];
      __builtin_amdgcn_sched_barrier(0);
      if (half == 0) topk_rounds(s, hh, tv0, ti0); else topk_rounds(s, hh, tv1, ti1);
      __builtin_amdgcn_sched_barrier(0);
    }
    float F[16];
    int ba[16];
#pragma unroll
    for (int a = 0; a < 16; a++) { F[a] = tv0[a] + tv1[0]; ba[a] = 0; }
    float bv[16];
    int be[16];
#pragma unroll
    for (int j = 0; j < 16; j++) { bv[j] = 0.f; be[j] = 0; }
#pragma unroll 1
    for (int r = 0; r < 16; r++) {
      float m = F[0]; int a = 0;
#pragma unroll
      for (int i = 1; i < 16; i++) { const bool gt = F[i] > m; m = gt ? F[i] : m; a = gt ? i : a; }
      int bsel = 0, i0 = 0; float t0 = 0.f;
#pragma unroll
      for (int i = 0; i < 16; i++) { const bool is = (a == i); bsel = is ? ba[i] : bsel; i0 = is ? ti0[i] : i0; t0 = is ? tv0[i] : t0; }
      int i1 = 0; float t1n = NEG;
#pragma unroll
      for (int i = 0; i < 16; i++) { i1 = (bsel == i) ? ti1[i] : i1; t1n = (bsel + 1 == i) ? tv1[i] : t1n; }
      const int e = i0 * 128 + i1;
      const float fn = (bsel + 1 < 16) ? (t0 + t1n) : NEG;
#pragma unroll
      for (int i = 0; i < 16; i++) { const bool is = (a == i); F[i] = is ? fn : F[i]; ba[i] = is ? (bsel + 1) : ba[i]; }
#pragma unroll
      for (int j = 0; j < 16; j++) { bv[j] = (r == j) ? m : bv[j]; be[j] = (r == j) ? e : be[j]; }
    }
    const float b0 = bv[0];
    float ge[16];
    float gsum = 0.f;
#pragma unroll
    for (int r = 0; r < 16; r++) { ge[r] = __expf(bv[r] - b0); gsum += ge[r]; }
    const float ginv = 1.0f / gsum;
    if (hh == 0) {
      int* ip = ids + (size_t)(tok0 + n) * 128 + h * 16;
      float* gp = gates + (size_t)(tok0 + n) * 128 + h * 16;
#pragma unroll
      for (int r4 = 0; r4 < 4; r4++) {
        *(int4*)(ip + 4 * r4) = make_int4(be[4 * r4], be[4 * r4 + 1], be[4 * r4 + 2], be[4 * r4 + 3]);
        *(float4*)(gp + 4 * r4) = make_float4(ge[4 * r4] * ginv, ge[4 * r4 + 1] * ginv, ge[4 * r4 + 2] * ginv, ge[4 * r4 + 3] * ginv);
      }
    }
  }
}

typedef _Float16 f16x2_t __attribute__((ext_vector_type(2)));
__device__ __forceinline__ unsigned e4m3x2_to_f16x2(unsigned w, unsigned sel) {
  return __builtin_amdgcn_perm(w, w, sel);
}
__device__ __forceinline__ float dot2h(unsigned a, unsigned b, float c) {
  return __builtin_amdgcn_fdot2(__builtin_bit_cast(f16x2_t, a), __builtin_bit_cast(f16x2_t, b), c, false);
}
__device__ __forceinline__ unsigned pack_h2(float lo, float hi) {
  f16x2_t v; v.x = (_Float16)lo; v.y = (_Float16)hi;
  return __builtin_bit_cast(unsigned, v);
}
template <bool FINAL>
__device__ __forceinline__ void peer_gather(const int wave_s, bf16* xn, const float* rst, const unsigned char* ub, const unsigned char* vb,
                                            const int* ids, const float* gates, float* xw, const float* gnext, float* outp) {
  const int tid_ = opaque_tid(wave_s);
  const int lane = tid_ & 63;
  const int gw = blockIdx.x * NWAVES + (tid_ >> 6);
  const int nw = gridDim.x * NWAVES;
  const int el = ((lane >> 5) & 1) * 4 + ((lane >> 4) & 1) * 2 + ((lane >> 3) & 1);
  for (int tok = gw; tok < NT; tok += nw) {
    unsigned xh[8];
    {
      const uint4 a = *(const uint4*)(xn + (size_t)tok * DM + lane * 16);
      const uint4 b = *(const uint4*)(xn + (size_t)tok * DM + lane * 16 + 8);
      const unsigned xw_[8] = {a.x, a.y, a.z, a.w, b.x, b.y, b.z, b.w};
      const float4* sp = (const float4*)(rst + (size_t)tok * 16);
      const float4 s0 = sp[0], s1 = sp[1], s2 = sp[2], s3 = sp[3];
      const float xs = rsqrtf((((s0.x + s0.y) + (s0.z + s0.w)) + ((s1.x + s1.y) + (s1.z + s1.w)) + ((s2.x + s2.y) + (s2.z + s2.w)) + ((s3.x + s3.y) + (s3.z + s3.w))) * (1.0f / 1024.f) + EPSF);
#pragma unroll
      for (int k = 0; k < 8; k++) xh[k] = pack_h2(bf_lo(xw_[k]) * xs, bf_hi(xw_[k]) * xs);
    }
    float acc[16];
#pragma unroll
    for (int i = 0; i < 16; i++) acc[i] = 0.f;
#pragma unroll 1
    for (int g = 0; g < 16; g++) {
      const int idv = ids[(size_t)tok * 128 + g * 8 + (lane & 7)];
      const float gv = gates[(size_t)tok * 128 + g * 8 + el];
      uint4 uu[8], vv[8];
#pragma unroll
      for (int e = 0; e < 8; e++) {
        const int id = __builtin_amdgcn_readlane(idv, e);
        uu[e] = *(const uint4*)(ub + (size_t)id * DM + lane * 16);
        vv[e] = *(const uint4*)(vb + (size_t)id * DM + lane * 16);
      }
      float d[8];
#pragma unroll
      for (int e = 0; e < 8; e++) {
        const unsigned uw[4] = {uu[e].x, uu[e].y, uu[e].z, uu[e].w};
        float s = 0.f;
#pragma unroll
        for (int k = 0; k < 4; k++) {
          s = dot2h(e4m3x2_to_f16x2(uw[k], 0x010c000cu), xh[2 * k], s);
          s = dot2h(e4m3x2_to_f16x2(uw[k], 0x030c020cu), xh[2 * k + 1], s);
        }
        d[e] = s;
      }
      float d4[4], d2[2], d1;
      {
        const bool hi = (lane & 32) != 0;
#pragma unroll
        for (int i = 0; i < 4; i++) { const float send = hi ? d[i] : d[i + 4]; const float keep = hi ? d[i + 4] : d[i]; d4[i] = keep + __shfl_xor(send, 32, 64); }
      }
      {
        const bool hi = (lane & 16) != 0;
#pragma unroll
        for (int i = 0; i < 2; i++) { const float send = hi ? d4[i] : d4[i + 2]; const float keep = hi ? d4[i + 2] : d4[i]; d2[i] = keep + __shfl_xor(send, 16, 64); }
      }
      {
        const bool hi = (lane & 8) != 0;
        const float send = hi ? d2[0] : d2[1];
        const float keep = hi ? d2[1] : d2[0];
        d1 = keep + __shfl_xor(send, 8, 64);
      }
      d1 += __shfl_xor(d1, 4, 64);
      d1 += __shfl_xor(d1, 2, 64);
      d1 += __shfl_xor(d1, 1, 64);
      const float wl = gv * gelu_tanh(d1 * (1.0f / U_SCALE)) * (1.0f / V_SCALE);
#pragma unroll
      for (int e = 0; e < 8; e++) {
        const float w = __builtin_bit_cast(float, __builtin_amdgcn_readlane(__builtin_bit_cast(int, wl), ((e >> 2) & 1) * 32 + ((e >> 1) & 1) * 16 + (e & 1) * 8));
        const unsigned wlo = pack_h2(w, 0.f), whi = pack_h2(0.f, w);
        const unsigned vw[4] = {vv[e].x, vv[e].y, vv[e].z, vv[e].w};
#pragma unroll
        for (int k = 0; k < 4; k++) {
          const unsigned h0 = e4m3x2_to_f16x2(vw[k], 0x010c000cu), h1 = e4m3x2_to_f16x2(vw[k], 0x030c020cu);
          acc[4 * k + 0] = dot2h(h0, wlo, acc[4 * k + 0]);
          acc[4 * k + 1] = dot2h(h0, whi, acc[4 * k + 1]);
          acc[4 * k + 2] = dot2h(h1, wlo, acc[4 * k + 2]);
          acc[4 * k + 3] = dot2h(h1, whi, acc[4 * k + 3]);
        }
      }
    }
    float* xr = xw + (size_t)tok * DM + lane * 16;
    float xv[16];
    float ssq = 0.f;
#pragma unroll
    for (int c = 0; c < 4; c++) {
      float4 a0 = *(float4*)(xr + c * 4);
      a0.x += acc[c * 4 + 0]; a0.y += acc[c * 4 + 1]; a0.z += acc[c * 4 + 2]; a0.w += acc[c * 4 + 3];
      if (!FINAL) *(float4*)(xr + c * 4) = a0;
      xv[c * 4 + 0] = a0.x; xv[c * 4 + 1] = a0.y; xv[c * 4 + 2] = a0.z; xv[c * 4 + 3] = a0.w;
      ssq += a0.x * a0.x + a0.y * a0.y + a0.z * a0.z + a0.w * a0.w;
    }
    ssq = wsum(ssq);
    const float rstd = rsqrtf(ssq * (1.0f / DM) + EPSF);
    const float4* g4 = (const float4*)(gnext + lane * 16);
    if (FINAL) {
      float* op = outp + (size_t)tok * DM + lane * 16;
#pragma unroll
      for (int c = 0; c < 4; c++) {
        const float4 gq = g4[c];
        *(float4*)(op + c * 4) = make_float4(xv[c * 4] * rstd * gq.x, xv[c * 4 + 1] * rstd * gq.y, xv[c * 4 + 2] * rstd * gq.z, xv[c * 4 + 3] * rstd * gq.w);
      }
    } else {
      uint4 o0, o1;
      { const float4 ga = g4[0], gb = g4[1];
        o0.x = pk2(xv[0] * rstd * ga.x, xv[1] * rstd * ga.y); o0.y = pk2(xv[2] * rstd * ga.z, xv[3] * rstd * ga.w);
        o0.z = pk2(xv[4] * rstd * gb.x, xv[5] * rstd * gb.y); o0.w = pk2(xv[6] * rstd * gb.z, xv[7] * rstd * gb.w); }
      { const float4 ga = g4[2], gb = g4[3];
        o1.x = pk2(xv[8] * rstd * ga.x, xv[9] * rstd * ga.y); o1.y = pk2(xv[10] * rstd * ga.z, xv[11] * rstd * ga.w);
        o1.z = pk2(xv[12] * rstd * gb.x, xv[13] * rstd * gb.y); o1.w = pk2(xv[14] * rstd * gb.z, xv[15] * rstd * gb.w); }
      *(uint4*)(xn + (size_t)tok * DM + lane * 16) = o0;
      *(uint4*)(xn + (size_t)tok * DM + lane * 16 + 8) = o1;
    }
  }
}

__device__ __forceinline__ void prologue_transposes(const int wave_s, const Params& p, unsigned char* ws, LAS unsigned char* lds) {
  const int tid_ = opaque_tid(wave_s);
  const int lane = tid_ & 63, wave = tid_ >> 6;
  LAS float* scr = (LAS float*)(lds + wave * 16384);
  const int gw = blockIdx.x * NWAVES + wave, NGW = gridDim.x * NWAVES;
  constexpr int I_IN = (DM / 64) * (DIN / 32), I_SQ = (DM / 64) * (DM / 32), I_2K = (DM / 64) * (2048 / 32);
  constexpr int I_GL = (256 / 64) * (256 / 32);
  constexpr int PER_LAYER = I_IN + 3 * I_SQ + 2 * I_2K + I_GL;
  const float* w3 = karg_in(3); const float* w19 = karg_in(19); const float* w22 = karg_in(22);
  const float* w23 = karg_in(23); const float* w24 = karg_in(24); const float* w26 = karg_in(26);
  const float* w16 = karg_in(16);
  for (int it = gw; it < 2 * PER_LAYER; it += NGW) {
    const int l = it / PER_LAYER;
    int r = it % PER_LAYER;
    unsigned char* wl = ws + WS_WT + (size_t)l * WT_LAYER;
    if (r < I_IN) { transpose_item(w3 + (size_t)l * DM * DIN, DM, DIN, (bf16*)(wl + WT_IN), scr, r, lane); continue; } r -= I_IN;
    if (r < I_SQ) { transpose_item(w19 + (size_t)l * DM * DM, DM, DM, (bf16*)(wl + WT_OUT), scr, r, lane); continue; } r -= I_SQ;
    if (r < I_SQ) { transpose_item(w22 + (size_t)l * DM * DM, DM, DM, (bf16*)(wl + WT_MQ), scr, r, lane); continue; } r -= I_SQ;
    if (r < I_2K) { transpose_item(w23 + (size_t)l * DM * 2048, DM, 2048, (bf16*)(wl + WT_MKV), scr, r, lane); continue; } r -= I_2K;
    if (r < I_SQ) { transpose_item(w24 + (size_t)l * DM * DM, DM, DM, (bf16*)(wl + WT_MO), scr, r, lane); continue; } r -= I_SQ;
    if (r < I_2K) { transpose_item(w26 + (size_t)l * DM * 2048, DM, 2048, (bf16*)(wl + WT_PQ), scr, r, lane); continue; } r -= I_2K;
    transpose_item(w16 + (size_t)l * 256 * 256, 256, 256, (bf16*)(wl + WT_GLU), scr, r, lane);
  }
}

template <class T> __device__ __forceinline__ T* opq(T* p) { asm volatile("" : "+s"(p)); return p; }
__device__ __forceinline__ void cvt_rows_bf16(const int wave_s, const float* src, bf16* dst, size_t n) {
  const int tid_ = opaque_tid(wave_s);
  const size_t gt = (size_t)blockIdx.x * (NWAVES * 64) + tid_;
  const size_t nth = (size_t)gridDim.x * NWAVES * 64;
  for (size_t i = gt; i < n / 8; i += nth) {
    const float4 a = ((const float4*)src)[2 * i], b = ((const float4*)src)[2 * i + 1];
    uint4 o; o.x = pk2(a.x, a.y); o.y = pk2(a.z, a.w); o.z = pk2(b.x, b.y); o.w = pk2(b.z, b.w);
    ((uint4*)dst)[i] = o;
  }
}

__device__ __forceinline__ unsigned enc_e4m3(float x) {
  const _Float16 hf = (_Float16)x;
  const unsigned h = (unsigned)__builtin_bit_cast(unsigned short, hf);
  return ((h + 0x7Fu + ((h >> 8) & 1u)) >> 8) & 0xFFu;
}
__device__ __forceinline__ void cvt_rows_e4m3(const int wave_s, const float* src, unsigned char* dst, size_t n, float sc) {
  const int tid_ = opaque_tid(wave_s);
  const size_t gt = (size_t)blockIdx.x * (NWAVES * 64) + tid_;
  const size_t nth = (size_t)gridDim.x * NWAVES * 64;
  for (size_t i = gt; i < n / 16; i += nth) {
    unsigned w[4];
#pragma unroll
    for (int k = 0; k < 4; k++) {
      const float4 a = ((const float4*)src)[4 * i + k];
      w[k] = enc_e4m3(a.x * sc) | (enc_e4m3(a.y * sc) << 8) | (enc_e4m3(a.z * sc) << 16) | (enc_e4m3(a.w * sc) << 24);
    }
    uint4 o; o.x = w[0]; o.y = w[1]; o.z = w[2]; o.w = w[3];
    ((uint4*)dst)[i] = o;
  }
}

#define GEMM_F32(Aptr, Wt, Cptr, Rptr, M_, N_) do { \
    pg8::Gemm g_{opq((const bf16*)(Aptr)), opq((const bf16*)(Wt)), (M_), (N_), DM}; pg8::StaticOrder S_; S_.init((M_), (N_), (int)gridDim.x, (int)blockIdx.x); \
    pg8::EpiF32R E_{opq((float*)(Cptr)), opq((const float*)(Rptr)), (N_)}; \
    pg8::gemm_phase<pg8::EpiF32R, pg8::StaticOrder, true, true>(wave_s, ldsl, g_, S_, E_); } while (0)
#define GEMM_BF16_C(Aptr, Wt, Optr, M_, N_, C_) do { \
    pg8::Gemm g_{opq((const bf16*)(Aptr)), opq((const bf16*)(Wt)), (M_), (N_), DM}; pg8::StaticOrder S_; S_.init((M_), (N_), (int)gridDim.x, (C_)); \
    pg8::EpiBf16 E_{opq((bf16*)(Optr)), (N_)}; \
    pg8::gemm_phase<pg8::EpiBf16, pg8::StaticOrder, true, true>(wave_s, ldsl, g_, S_, E_); } while (0)
#define GEMM_BF16(Aptr, Wt, Optr, M_, N_) GEMM_BF16_C(Aptr, Wt, Optr, M_, N_, (int)blockIdx.x)
#define GEMM_F32RN(Aptr, Wt, Cptr, Rptr, XGptr, Gptr, STptr) do { \
    pg8::Gemm g_{opq((const bf16*)(Aptr)), opq((const bf16*)(Wt)), NT, DM, DM}; pg8::StaticOrder S_; S_.init(NT, DM, (int)gridDim.x, (int)blockIdx.x); \
    pg8::EpiF32RN E_{opq((float*)(Cptr)), opq((const float*)(Rptr)), DM, opq((bf16*)(XGptr)), opq((const float*)(Gptr)), opq((float*)(STptr))}; \
    pg8::gemm_phase<pg8::EpiF32RN, pg8::StaticOrder, true, true>(wave_s, ldsl, g_, S_, E_); } while (0)
#define GEMM_BF16S(Aptr, Wt, Optr, N_, STptr) do { \
    pg8::Gemm g_{opq((const bf16*)(Aptr)), opq((const bf16*)(Wt)), NT, (N_), DM}; pg8::StaticOrder S_; S_.init(NT, (N_), (int)gridDim.x, (int)blockIdx.x); \
    pg8::EpiBf16S E_{opq((bf16*)(Optr)), (N_), opq((const float*)(STptr))}; \
    pg8::gemm_phase<pg8::EpiBf16S, pg8::StaticOrder, true, true>(wave_s, ldsl, g_, S_, E_); } while (0)

__global__ void __launch_bounds__(NWAVES * 64, 2) fwd_megakernel(Params p) {
  cg::grid_group grid = cg::this_grid();
  extern __shared__ __attribute__((aligned(16))) unsigned char lds[];
  LAS unsigned char* ldsl = (LAS unsigned char*)lds;
  LAS float* smem = (LAS float*)ldsl;
  const int wave_s = __builtin_amdgcn_readfirstlane((int)(threadIdx.x >> 6));
  unsigned char* ws = p.ws;
  volatile LAS unsigned* MISC = (volatile LAS unsigned*)(ldsl + (LDS_BYTES - 256));
  if (threadIdx.x < 64) MISC[threadIdx.x] = 0u;
  __syncthreads();
  const XcdBarrier bar = xcd_barrier_post((unsigned*)(ws + WS_CTL) + 4096, MISC + 8);
  grid.sync();
  float* xw = (float*)(ws + WS_XW);
  bf16* xn = (bf16*)(ws + WS_XN);
  bf16* big = (bf16*)(ws + WS_BIG);
  bf16* y = (bf16*)(ws + WS_Y);
  bf16* memh = (bf16*)(ws + WS_MEMH);
  bf16* kvb = (bf16*)(ws + WS_KVB);
  bf16* vT = (bf16*)(ws + WS_VT);
  float* ssmE = (float*)(ws + WS_SSME);
  float* ssmp = (float*)(ws + WS_SSMP);
  int* ids = (int*)(ws + WS_IDS);
  float* gates = (float*)(ws + WS_GATE);
  bf16* skb = (bf16*)(ws + WS_SKB);
  unsigned char* ub = ws + WS_UB;
  unsigned char* vb = ws + WS_VB;
  float* rst = (float*)(ws + WS_RST);

  prologue_transposes(wave_s, p, ws, ldsl);
  cvt_rows_bf16(wave_s, karg_in(27), skb, (size_t)2 * 8 * 2 * 128 * 128);
  cvt_rows_e4m3(wave_s, karg_in(28), ub, (size_t)2 * 16384 * 1024, U_SCALE);
  cvt_rows_e4m3(wave_s, karg_in(29), vb, (size_t)2 * 16384 * 1024, V_SCALE);
  for (int l = 0; l < 2; l++)
    rms_rows<true>(wave_s, karg_in(1), karg_in(21) + l * DM, memh + (size_t)l * 1024 * 1024, 1024);
  ssm_params(wave_s, p, ssmp);
  xcd_barrier(bar);
  for (int l = 0; l < 2; l++)
    GEMM_BF16_C(memh + (size_t)l * 1024 * 1024, ws + WS_WT + (size_t)l * WT_LAYER + WT_MKV,
              kvb + (size_t)l * 1024 * 2048, 1024, 2048, (int)((blockIdx.x + gridDim.x - 32u * (unsigned)l) % gridDim.x));

#pragma nounroll
  for (int l = 0; l < 2; l++) {
    const float* xcur = (l == 0) ? karg_in(0) : xw;
    const float* sp = ssmp + (size_t)l * SSMP_PER_LAYER;
    const unsigned char* wl = ws + WS_WT + (size_t)l * WT_LAYER;
    if (l == 0) {
      rms_rows<true>(wave_s, xcur, karg_in(2) + l * DM, xn, NT);
      xcd_barrier(bar);
    }
    GEMM_BF16(xn, wl + WT_IN, big, NT, DIN);
    xcd_barrier(bar);
    if (l == 0) vt_phase(wave_s, kvb, vT);
    ssm_chunk_end(wave_s, sp, big, ssmE);
    attn_phase(wave_s, p, l, big, y, smem);
    conv_phase(wave_s, p, l, big, y, smem);
    xcd_barrier(bar);
    ssm_finish(wave_s, p, l, sp, big, ssmE, y, smem);
    xcd_barrier(bar);
    GEMM_F32RN(y, wl + WT_OUT, xw, xcur, xn, karg_in(20) + l * DM, rst);
    xcd_barrier(bar);
    GEMM_BF16S(xn, wl + WT_MQ, big, DM, rst);
    xcd_barrier(bar);
    memattn_phase(wave_s, big, kvb + (size_t)l * 1024 * 2048, vT + (size_t)l * 4 * 4 * 256 * 256, y, smem);
    xcd_barrier(bar);
    GEMM_F32RN(y, wl + WT_MO, xw, (const float*)xw, xn, karg_in(25) + l * DM, rst);
    xcd_barrier(bar);
    GEMM_BF16S(xn, wl + WT_PQ, big, 2048, rst);
    xcd_barrier(bar);
    peer_topk(wave_s, big, skb + (size_t)l * 8 * 2 * 128 * 128, ids, gates);
    xcd_barrier(bar);
    if (l == 0) {
      peer_gather<false>(wave_s, xn, rst, ub + (size_t)l * 16384 * DM, vb + (size_t)l * 16384 * DM, ids, gates, xw, karg_in(2) + DM, (float*)nullptr);
      xcd_barrier(bar);
    } else {
      peer_gather<true>(wave_s, xn, rst, ub + (size_t)l * 16384 * DM, vb + (size_t)l * 16384 * DM, ids, gates, xw, karg_in(30), p.out);
    }
  }
}

extern "C" void kernel_launch(void* const* d_in, const int* in_sizes, int n_in,
                              void* d_out, int out_size, void* d_ws, size_t ws_size,
                              hipStream_t stream) {
  static int grid_blocks = 0;
  if (!grid_blocks) {
    int dev = 0, cus = 0, per_cu = 0;
    (void)hipGetDevice(&dev);
    (void)hipDeviceGetAttribute(&cus, hipDeviceAttributeMultiprocessorCount, dev);
    (void)hipFuncSetAttribute((const void*)fwd_megakernel, hipFuncAttributeMaxDynamicSharedMemorySize, LDS_BYTES);
    (void)hipOccupancyMaxActiveBlocksPerMultiprocessor(&per_cu, fwd_megakernel, NWAVES * 64, LDS_BYTES);
    if (per_cu < 1) fprintf(stderr, "occupancy query reports %d blocks/CU\n", per_cu);
    grid_blocks = cus;
  }
  (void)hipMemsetAsync((char*)d_ws + WS_CTL, 0, 1 * MiB, stream);
  Params p{};
  for (int i = 0; i < 31; i++) p.in[i] = (const float*)d_in[i];
  p.out = (float*)d_out;
  p.ws = (unsigned char*)d_ws;
  void* args[] = {&p};
  hipError_t e = hipLaunchCooperativeKernel((void*)fwd_megakernel, dim3(grid_blocks), dim3(NWAVES * 64),
                                            args, LDS_BYTES, stream);
  if (e != hipSuccess)
    fprintf(stderr, "cooperative launch failed: %s (grid %d)\n", hipGetErrorString(e), grid_blocks);
}
```

```cpp
#include <hip/hip_runtime.h>
#include <hip/hip_cooperative_groups.h>
#include <cstdio>
namespace cg = cooperative_groups;

#define NT 16384
#define SEQ 4096
#define DM 1024
#define DIN 2304
#define NMEM 256
#define EPSF 1e-6f
#define NWAVES 8
#define LDS_BYTES 147456

typedef unsigned short bf16;
#define LAS __attribute__((address_space(3)))

struct Params {
  const float* in[31];
  float* out;
  unsigned char* ws;
};
typedef __attribute__((address_space(4))) const unsigned char* kaptr_t;
__device__ __forceinline__ const float* karg_in(int i) {
  kaptr_t ka = (kaptr_t)__builtin_amdgcn_kernarg_segment_ptr();
  asm volatile("" : "+s"(ka));
  return *(const float* __attribute__((address_space(4))) const*)(ka + 8 * i);
}

constexpr size_t MiB = 1u << 20;
constexpr size_t WS_CTL  = 0;
constexpr size_t WS_WT   = 1 * MiB;
constexpr size_t WT_IN = 0, WT_OUT = WT_IN + (size_t)DIN * DM * 2, WT_MQ = WT_OUT + (size_t)DM * DM * 2,
                 WT_MKV = WT_MQ + (size_t)DM * DM * 2, WT_MO = WT_MKV + (size_t)2048 * DM * 2,
                 WT_PQ = WT_MO + (size_t)DM * DM * 2, WT_GLU = WT_PQ + (size_t)2048 * DM * 2, WT_LAYER = WT_GLU + (size_t)256 * 256 * 2;
constexpr size_t WS_XW   = WS_WT + 2 * WT_LAYER;
constexpr size_t WS_XN   = WS_XW + (size_t)NT * DM * 4;
constexpr size_t WS_BIG  = WS_XN + (size_t)NT * DM * 2;
constexpr size_t WS_Y    = WS_BIG + (size_t)NT * DIN * 2;
constexpr size_t WS_MEMH = WS_Y + (size_t)NT * DM * 2;
constexpr size_t WS_KVB  = WS_MEMH + (size_t)2 * 1024 * 1024 * 2;
constexpr size_t WS_VT   = WS_KVB + (size_t)2 * 1024 * 2048 * 2;
constexpr size_t WS_SSME = WS_VT + (size_t)2 * 4 * 4 * 256 * 256 * 2;
#define SSMP_PER_LAYER (2048 + 2048 + 32768)
constexpr size_t WS_SSMP = WS_SSME + (size_t)4 * 64 * 16 * 64 * 2 * 4;
constexpr size_t WS_IDS  = WS_SSMP + (size_t)2 * SSMP_PER_LAYER * 4;
constexpr size_t WS_GATE = WS_IDS + (size_t)NT * 128 * 4;
constexpr size_t WS_SKB  = WS_GATE + (size_t)NT * 128 * 4;
constexpr size_t WS_UB   = WS_SKB + (size_t)2 * 8 * 2 * 128 * 128 * 2;
constexpr size_t WS_VB   = WS_UB + (size_t)2 * 16384 * 1024;
constexpr size_t WS_RST  = WS_VB + (size_t)2 * 16384 * 1024;
constexpr size_t WS_END  = WS_RST + (size_t)NT * 16 * 4;
#define U_SCALE 64.0f
#define V_SCALE 1.0f
static_assert(WS_END <= 512 * MiB, "workspace");
static_assert(WT_LAYER % 256 == 0 && WS_SSMP % 16 == 0 && WS_IDS % 16 == 0 && WS_SKB % 256 == 0 && WS_VT % 256 == 0, "align");

__device__ __forceinline__ int opaque_tid(int wave_s) { int v = wave_s * 64 + (int)__builtin_amdgcn_mbcnt_hi(~0u, __builtin_amdgcn_mbcnt_lo(~0u, 0u)); asm volatile("" : "+v"(v)); return v; }
__device__ __forceinline__ unsigned f2bf(float f) { unsigned u = __builtin_bit_cast(unsigned, f); return (u + 0x7fffu + ((u >> 16) & 1u)) >> 16; }
__device__ __forceinline__ unsigned pk2(float lo, float hi) { return f2bf(lo) | (f2bf(hi) << 16); }
__device__ __forceinline__ float bf_lo(unsigned u) { return __builtin_bit_cast(float, u << 16); }
__device__ __forceinline__ float bf_hi(unsigned u) { return __builtin_bit_cast(float, u & 0xffff0000u); }
__device__ __forceinline__ float bf2f(bf16 h) { return __builtin_bit_cast(float, (unsigned)h << 16); }


#define XB_TMO      128
#define XB_XCNT(j)  (256  + 64 * (j))
#define XB_XSUB(j)  (1280 + 64 * (j))
#define XB_XGEN(j)  (2304 + 64 * (j))
#define XB_TOP      3328
#define XB_TOPGEN   3392
#define XCD_BAR_WORDS 3456
#define XB_SPIN_CAP (1u << 22)
__device__ __forceinline__ unsigned xb_ld(unsigned* p)              { return __hip_atomic_load(p, __ATOMIC_RELAXED, __HIP_MEMORY_SCOPE_AGENT); }
__device__ __forceinline__ unsigned xb_add(unsigned* p, unsigned v) { return __hip_atomic_fetch_add(p, v, __ATOMIC_RELAXED, __HIP_MEMORY_SCOPE_AGENT); }
__device__ __forceinline__ unsigned xb_xcc_id() { return (unsigned)__builtin_amdgcn_s_getreg((3 << 11) | 20) & 0xFu; }
#define XB_SPIN(cond, bar) do { unsigned _sp = 0; while (cond) { __builtin_amdgcn_s_sleep(1); \
    if ((++_sp & 255u) == 0u) { if (xb_ld(&(bar)[XB_TMO])) break; if (_sp > XB_SPIN_CAP) { atomicAdd(&(bar)[XB_TMO], 1u); break; } } } } while (0)
struct XcdBarrier { unsigned* bar; unsigned x; volatile LAS unsigned* st; };
__device__ __forceinline__ XcdBarrier xcd_barrier_post(unsigned* bar, volatile LAS unsigned* st) {
    XcdBarrier b; b.bar = bar; b.x = xb_xcc_id(); b.st = st;
    if (threadIdx.x == 0) (void)xb_add(&bar[XB_XCNT(b.x)], 1u);
    return b;
}
__device__ __forceinline__ void xcd_barrier_complete(unsigned* bar, unsigned x, unsigned& nloc, unsigned& nx) {
    const unsigned G = gridDim.x * gridDim.y * gridDim.z;
    unsigned sum, cnt, mine, sp = 0u;
    for (;;) {
        sum = 0u; cnt = 0u; mine = 0u;
#pragma unroll
        for (unsigned j = 0; j < 16; ++j) { const unsigned c = xb_ld(&bar[XB_XCNT(j)]); sum += c; cnt += (c > 0u) ? 1u : 0u; mine = (j == x) ? c : mine; }
        if (sum == G) break;
        __builtin_amdgcn_s_sleep(1);
        if ((++sp & 255u) == 0u) { if (xb_ld(&bar[XB_TMO])) break; if (sp > XB_SPIN_CAP) { atomicAdd(&bar[XB_TMO], 1u); break; } }
    }
    nloc = mine > 0u ? mine : 1u; nx = cnt > 0u ? cnt : 1u;
}
__device__ __forceinline__ void xcd_barrier(const XcdBarrier& b) {
    asm volatile("s_waitcnt vmcnt(0)" ::: "memory");
    __syncthreads();
    if (threadIdx.x == 0) {
        unsigned* bar = b.bar;
        __builtin_amdgcn_s_waitcnt(0);
        unsigned nloc = b.st[0], nx = b.st[1];
        if (nloc == 0u) { xcd_barrier_complete(bar, b.x, nloc, nx); b.st[0] = nloc; b.st[1] = nx; }
        const unsigned old = xb_add(&bar[XB_XSUB(b.x)], 1u);
        const unsigned gen = old / nloc;
        if (old + 1u == (gen + 1u) * nloc) {
            __builtin_amdgcn_fence(__ATOMIC_RELEASE, "agent");
            asm volatile("s_waitcnt vmcnt(0)" ::: "memory");
            const unsigned og = xb_add(&bar[XB_TOP], 1u);
            const unsigned tg = og / nx;
            if (og + 1u == (tg + 1u) * nx) xb_add(&bar[XB_TOPGEN], 1u);
            else XB_SPIN(xb_ld(&bar[XB_TOPGEN]) == tg, bar);
            __builtin_amdgcn_fence(__ATOMIC_ACQUIRE, "agent");
            xb_add(&bar[XB_XGEN(b.x)], 1u);
            asm volatile("s_waitcnt vmcnt(0)" ::: "memory");
        } else {
            XB_SPIN(xb_ld(&bar[XB_XGEN(b.x)]) == gen, bar);
            __builtin_amdgcn_fence(__ATOMIC_ACQUIRE, "agent");
            asm volatile("s_waitcnt vmcnt(0)" ::: "memory");
        }
    }
    __syncthreads();
}

namespace pg8 {
#define PG8_LAS __attribute__((address_space(3)))
typedef unsigned short bf16_t;
typedef short bf16x8 __attribute__((ext_vector_type(8)));
typedef float f32x4 __attribute__((ext_vector_type(4)));
typedef unsigned u32x4 __attribute__((ext_vector_type(4)));
constexpr int BM = 256, BK = 64, HALF = 128, HTB = HALF * BK * 2, STAGE_BYTES = 8 * HTB, NXCD = 8, WGM = 8;
__host__ __device__ __forceinline__ int lds_byte(int r, int c) { const int st = (r >> 4) * 2 + (c >> 5), rr = r & 15, cc = c & 31, ob = rr * 64 + cc * 2; return st * 1024 + (ob ^ (((ob >> 9) & 1) << 5)); }
__host__ __device__ __forceinline__ void stage_rc(int b, int& R, int& C) { const int st = b / 1024, sb = b % 1024, swz = sb ^ (((sb >> 9) & 1) << 5); R = (st >> 1) * 16 + swz / 64; C = (st & 1) * 32 + (swz % 64) / 2; }
__host__ __device__ __forceinline__ int perm32(int rho) { const int n = rho >> 4, i = rho & 15; return 8 * (i >> 2) + 4 * n + (i & 3); }
struct Unit { int pm, pn; };
struct Gemm { const bf16_t* A; const bf16_t* Bt; int M, N, K; };
struct StaticOrder {
    int nM, nN, nwg, G, c;
    __host__ __device__ __forceinline__ void init(int M, int N, int G_, int c_) { nM = M / BM; nN = N / BM; nwg = nM * nN; G = G_; c = c_; }
    __host__ __device__ bool next(int i, Unit& u) const {
        const long L = (long)i * G + c; if (L >= nwg) return false;
        int wgid = (int)L; { const int q = nwg / NXCD, r = nwg % NXCD, xcd = wgid % NXCD, off = wgid / NXCD; wgid = (xcd < r ? xcd * (q + 1) : r * (q + 1) + (xcd - r) * q) + off; }
        const int nig = WGM * nN, gid = wgid / nig, fm = gid * WGM, gsz = (nM - fm) < WGM ? (nM - fm) : WGM;
        u.pm = fm + ((wgid % nig) % gsz); u.pn = (wgid % nig) / gsz; return true;
    }
    __device__ __forceinline__ void a_ready(const Unit&) const {}
    __device__ __forceinline__ void done(const Unit&) const {}
};
__device__ __forceinline__ unsigned cvt_pk_bf16(float lo, float hi) { unsigned r; asm volatile("v_cvt_pk_bf16_f32 %0, %1, %2" : "=v"(r) : "v"(lo), "v"(hi)); return r; }

struct EpiF32R {
    static constexpr bool PERM = false, AFTER_DRAIN = false;
    float* C; const float* R; int ldc;
    __device__ __forceinline__ void operator()(const f32x4 (&acc)[2][2][4][2], const Unit& u, int wr, int wc, int fr, int fq) const {
        const int row0 = u.pm * BM + wr * 64 + fr, col0 = u.pn * BM + wc * 32 + 4 * fq;
#pragma unroll
        for (int ai = 0; ai < 2; ++ai)
#pragma unroll
            for (int m = 0; m < 4; ++m) {
                const size_t ro = (size_t)(row0 + ai * HALF + m * 16) * ldc + col0;
                f32x4 rv[2][2];
#pragma unroll
                for (int bj = 0; bj < 2; ++bj)
#pragma unroll
                    for (int n = 0; n < 2; ++n) rv[bj][n] = R ? *(const f32x4*)(R + ro + bj * HALF + n * 16) : (f32x4){0.f, 0.f, 0.f, 0.f};
#pragma unroll
                for (int bj = 0; bj < 2; ++bj)
#pragma unroll
                    for (int n = 0; n < 2; ++n) *(f32x4*)(C + ro + bj * HALF + n * 16) = acc[ai][bj][m][n] + rv[bj][n];
                __builtin_amdgcn_sched_barrier(0);
            }
    }
};

struct EpiBf16 {
    static constexpr bool PERM = true, AFTER_DRAIN = false;
    bf16_t* O; int ldc;
    __device__ __forceinline__ void operator()(const f32x4 (&acc)[2][2][4][2], const Unit& u, int wr, int wc, int fr, int fq) const {
        const int row0 = u.pm * BM + wr * 64 + fr, col0 = u.pn * BM + wc * 32 + 8 * fq;
#pragma unroll
        for (int ai = 0; ai < 2; ++ai)
#pragma unroll
            for (int m = 0; m < 4; ++m) { bf16_t* rowp = O + (size_t)(row0 + ai * HALF + m * 16) * ldc + col0;
#pragma unroll
                for (int bj = 0; bj < 2; ++bj) { const f32x4 v0 = acc[ai][bj][m][0], v1 = acc[ai][bj][m][1];
                    u32x4 w; w.x = cvt_pk_bf16(v0[0], v0[1]); w.y = cvt_pk_bf16(v0[2], v0[3]); w.z = cvt_pk_bf16(v1[0], v1[1]); w.w = cvt_pk_bf16(v1[2], v1[3]);
                    *(u32x4*)(rowp + bj * HALF) = w; } }
    }
};

struct EpiF32RN {
    static constexpr bool PERM = false, AFTER_DRAIN = false;
    float* C; const float* R; int ldc; bf16_t* XG; const float* g; float* st;
    __device__ __forceinline__ void operator()(const f32x4 (&acc)[2][2][4][2], const Unit& u, int wr, int wc, int fr, int fq) const {
        const int row0 = u.pm * BM + wr * 64 + fr, col0 = u.pn * BM + wc * 32 + 4 * fq;
        f32x4 gv[2][2];
#pragma unroll
        for (int bj = 0; bj < 2; ++bj)
#pragma unroll
            for (int n = 0; n < 2; ++n) gv[bj][n] = *(const f32x4*)(g + col0 + bj * HALF + n * 16);
#pragma unroll
        for (int ai = 0; ai < 2; ++ai)
#pragma unroll
            for (int m = 0; m < 4; ++m) {
                const int row = row0 + ai * HALF + m * 16;
                const size_t ro = (size_t)row * ldc + col0;
                f32x4 rv[2][2];
#pragma unroll
                for (int bj = 0; bj < 2; ++bj)
#pragma unroll
                    for (int n = 0; n < 2; ++n) rv[bj][n] = *(const f32x4*)(R + ro + bj * HALF + n * 16);
                float ss = 0.f;
#pragma unroll
                for (int bj = 0; bj < 2; ++bj)
#pragma unroll
                    for (int n = 0; n < 2; ++n) {
                        const f32x4 v = acc[ai][bj][m][n] + rv[bj][n];
                        *(f32x4*)(C + ro + bj * HALF + n * 16) = v;
                        ss += (v[0] * v[0] + v[1] * v[1]) + (v[2] * v[2] + v[3] * v[3]);
                        const f32x4 w = v * gv[bj][n];
                        uint2 pk; pk.x = cvt_pk_bf16(w[0], w[1]); pk.y = cvt_pk_bf16(w[2], w[3]);
                        *(uint2*)(XG + ro + bj * HALF + n * 16) = pk;
                    }
                ss += __shfl_xor(ss, 16, 64); ss += __shfl_xor(ss, 32, 64);
                if (fq == 0) st[(size_t)row * 16 + u.pn * 4 + wc] = ss;
                __builtin_amdgcn_sched_barrier(0);
            }
    }
};
struct EpiBf16S {
    static constexpr bool PERM = true, AFTER_DRAIN = false;
    bf16_t* O; int ldc; const float* st;
    __device__ __forceinline__ void operator()(const f32x4 (&acc)[2][2][4][2], const Unit& u, int wr, int wc, int fr, int fq) const {
        const int row0 = u.pm * BM + wr * 64 + fr, col0 = u.pn * BM + wc * 32 + 8 * fq;
#pragma unroll
        for (int ai = 0; ai < 2; ++ai)
#pragma unroll
            for (int m = 0; m < 4; ++m) {
                const int row = row0 + ai * HALF + m * 16;
                const f32x4* sp = (const f32x4*)(st + (size_t)row * 16);
                const f32x4 s0 = sp[0], s1 = sp[1], s2 = sp[2], s3 = sp[3];
                const f32x4 sa = (s0 + s1) + (s2 + s3);
                const float rs = __builtin_amdgcn_rsqf(((sa[0] + sa[1]) + (sa[2] + sa[3])) * (1.0f / 1024.f) + 1e-6f);
                bf16_t* rowp = O + (size_t)row * ldc + col0;
#pragma unroll
                for (int bj = 0; bj < 2; ++bj) { const f32x4 v0 = acc[ai][bj][m][0] * rs, v1 = acc[ai][bj][m][1] * rs;
                    u32x4 w; w.x = cvt_pk_bf16(v0[0], v0[1]); w.y = cvt_pk_bf16(v0[2], v0[3]); w.z = cvt_pk_bf16(v1[0], v1[1]); w.w = cvt_pk_bf16(v1[2], v1[3]);
                    *(u32x4*)(rowp + bj * HALF) = w; }
                __builtin_amdgcn_sched_barrier(0);
            }
    }
};

template <class Epi, class Sched, bool ALIGN_EPI = false, bool SP2 = false>
__device__ __forceinline__ void gemm_phase(const int wave_s, PG8_LAS unsigned char* lds, const Gemm g, const Sched& S, const Epi& E) {
    const int tid = opaque_tid(wave_s), wid = __builtin_amdgcn_readfirstlane(tid >> 6), lane = tid & 63, wr = wid >> 2, wc = wid & 3, fr = lane & 15, fq = lane >> 4;
    const int K = g.K, nt = K / BK;
    unsigned voffA[2], voffB[2];
#pragma unroll
    for (int i = 0; i < 2; ++i) { int R, C; stage_rc(tid * 16 + i * 8192, R, C); const int Rb = Epi::PERM ? ((R & ~31) + perm32(R & 31)) : R;
        voffA[i] = (unsigned)(R * K + C) * 2u; voffB[i] = (unsigned)(Rb * K + C) * 2u; }
    const size_t kstep = (size_t)(BK * 2);
    const size_t hstep = (size_t)HALF * K * 2;
    const size_t tstep = 2 * hstep;
    const unsigned ldsw = (unsigned)wid * 1024u;
    const int aoff = lds_byte(wr * 64 + fr, fq * 8), boff = lds_byte(wc * 32 + fr, fq * 8);
#define PG8_SA(b, h) (((b) * 2 + (h)) * HTB)
#define PG8_SB(b, h) ((4 + (b) * 2 + (h)) * HTB)
#define PG8_STAGE(bufoff, gbase, voff) do { _Pragma("unroll") for (int _i = 0; _i < 2; ++_i) \
        __builtin_amdgcn_global_load_lds((const unsigned*)((const char*)(gbase) + (voff)[_i]), (PG8_LAS unsigned*)(lds + (bufoff) + ldsw + _i * 8192), 16, 0, 0); } while (0)
#define PG8_LDA(dst, b, h) do { _Pragma("unroll") for (int m = 0; m < 4; ++m) _Pragma("unroll") for (int k = 0; k < 2; ++k) dst[m][k] = *(const PG8_LAS bf16x8*)(lds + PG8_SA(b, h) + aoff + m * 2048 + k * 1024); } while (0)
#define PG8_LDB(dst, b, h) do { _Pragma("unroll") for (int n = 0; n < 2; ++n) _Pragma("unroll") for (int k = 0; k < 2; ++k) dst[n][k] = *(const PG8_LAS bf16x8*)(lds + PG8_SB(b, h) + boff + n * 2048 + k * 1024); } while (0)
#define PG8_MMA(ai, bj, At, Bt) do { __builtin_amdgcn_s_setprio(1); _Pragma("unroll") for (int m = 0; m < 4; ++m) _Pragma("unroll") for (int n = 0; n < 2; ++n) _Pragma("unroll") for (int k = 0; k < 2; ++k) \
        acc[ai][bj][m][n] = __builtin_amdgcn_mfma_f32_16x16x32_bf16(Bt[n][k], At[m][k], acc[ai][bj][m][n], 0, 0, 0); __builtin_amdgcn_s_setprio(0); } while (0)
#define PG8_WAIT_V(n) asm volatile("s_waitcnt vmcnt(" #n ")" ::: "memory")
#define PG8_WAIT_L(n) asm volatile("s_waitcnt lgkmcnt(" #n ")" ::: "memory")
#define PG8_BAR __builtin_amdgcn_s_barrier()
#define PG8_SCHED __builtin_amdgcn_sched_barrier(0)
    Unit cur, nxt; int ui = 0;
    if (!S.next(0, cur)) return;
    f32x4 acc[2][2][4][2];
#pragma unroll
    for (int a = 0; a < 2; ++a)
#pragma unroll
        for (int b = 0; b < 2; ++b)
#pragma unroll
            for (int m = 0; m < 4; ++m)
#pragma unroll
                for (int n = 0; n < 2; ++n) acc[a][b][m][n] = (f32x4){0.f, 0.f, 0.f, 0.f};
    bf16x8 At[4][2], B0[2][2], B1[2][2];
    const char* cA = (const char*)g.A + (size_t)cur.pm * tstep; const char* cB = (const char*)g.Bt + (size_t)cur.pn * tstep;
    S.a_ready(cur);
    if constexpr (SP2) {
        PG8_STAGE(PG8_SB(0, 0), cB, voffB); PG8_STAGE(PG8_SB(0, 1), cB + hstep, voffB); PG8_STAGE(PG8_SA(0, 0), cA, voffA); PG8_STAGE(PG8_SA(0, 1), cA + hstep, voffA);
        if (wr == 1) PG8_BAR;
        PG8_WAIT_V(2); PG8_BAR;
        PG8_STAGE(PG8_SB(1, 0), cB + kstep, voffB); PG8_STAGE(PG8_SA(1, 0), cA + kstep, voffA); PG8_STAGE(PG8_SB(1, 1), cB + hstep + kstep, voffB);
        PG8_WAIT_V(6); PG8_BAR;
    } else {
        PG8_STAGE(PG8_SB(0, 0), cB, voffB); PG8_STAGE(PG8_SA(0, 0), cA, voffA); PG8_STAGE(PG8_SB(0, 1), cB + hstep, voffB); PG8_STAGE(PG8_SA(0, 1), cA + hstep, voffA);
        if (wr == 1) PG8_BAR;
        PG8_WAIT_V(4); PG8_BAR;
        PG8_STAGE(PG8_SB(1, 0), cB + kstep, voffB); PG8_STAGE(PG8_SA(1, 0), cA + kstep, voffA); PG8_STAGE(PG8_SB(1, 1), cB + hstep + kstep, voffB);
        PG8_WAIT_V(6); PG8_BAR;
    }
    for (;;) {
        const bool has_next = S.next(ui + 1, nxt);
        const char* nA = has_next ? (const char*)g.A + (size_t)nxt.pm * tstep : cA; const char* nB = has_next ? (const char*)g.Bt + (size_t)nxt.pn * tstep : cB;
        for (int t = 0; t < nt; t += 2) {
            const bool last = (t == nt - 2);
            const char* a1 = cA + (size_t)(t + 1) * kstep;
            const char* a2 = last ? nA : cA + (size_t)(t + 2) * kstep; const char* b2 = last ? nB : cB + (size_t)(t + 2) * kstep;
            const char* a3 = a2 + kstep; const char* b3 = b2 + kstep;
            if (last && has_next) S.a_ready(nxt);
            if constexpr (SP2) {
            PG8_LDB(B0, 0, 0); PG8_LDB(B1, 0, 1); PG8_SCHED; PG8_LDA(At, 0, 0); PG8_STAGE(PG8_SA(1, 1), a1 + hstep, voffA);
            PG8_WAIT_V(8); PG8_WAIT_L(0); PG8_BAR; PG8_MMA(0, 0, At, B0); PG8_MMA(0, 1, At, B1); PG8_BAR; PG8_SCHED;
            PG8_LDA(At, 0, 1); PG8_STAGE(PG8_SB(0, 0), b2, voffB); PG8_STAGE(PG8_SB(0, 1), b2 + hstep, voffB); PG8_STAGE(PG8_SA(0, 0), a2, voffA);
            PG8_WAIT_V(8); PG8_WAIT_L(0); PG8_BAR; PG8_MMA(1, 0, At, B0); PG8_MMA(1, 1, At, B1); PG8_BAR; PG8_SCHED;
            PG8_LDB(B0, 1, 0); PG8_LDB(B1, 1, 1); PG8_SCHED; PG8_LDA(At, 1, 0); PG8_STAGE(PG8_SA(0, 1), a2 + hstep, voffA);
            PG8_WAIT_V(8); PG8_WAIT_L(0); PG8_BAR; PG8_MMA(0, 0, At, B0); PG8_MMA(0, 1, At, B1); PG8_BAR; PG8_SCHED;
            PG8_LDA(At, 1, 1); PG8_STAGE(PG8_SB(1, 0), b3, voffB); PG8_STAGE(PG8_SB(1, 1), b3 + hstep, voffB); PG8_STAGE(PG8_SA(1, 0), a3, voffA);
            PG8_WAIT_V(8); PG8_WAIT_L(0); PG8_BAR; PG8_MMA(1, 0, At, B0); PG8_MMA(1, 1, At, B1); PG8_BAR; PG8_SCHED;
            } else {
            PG8_LDB(B0, 0, 0); PG8_SCHED; PG8_LDA(At, 0, 0); PG8_STAGE(PG8_SA(1, 1), a1 + hstep, voffA);
            PG8_WAIT_L(8); PG8_BAR; PG8_WAIT_L(0); PG8_MMA(0, 0, At, B0); PG8_BAR; PG8_SCHED;
            PG8_LDB(B1, 0, 1); PG8_STAGE(PG8_SB(0, 0), b2, voffB);
            PG8_BAR; PG8_WAIT_L(0); PG8_MMA(0, 1, At, B1); PG8_BAR;
            PG8_LDA(At, 0, 1); PG8_STAGE(PG8_SA(0, 0), a2, voffA);
            PG8_BAR; PG8_WAIT_L(0); PG8_MMA(1, 0, At, B0); PG8_BAR; PG8_SCHED;
            PG8_STAGE(PG8_SB(0, 1), b2 + hstep, voffB);
            PG8_WAIT_V(6); PG8_BAR; PG8_MMA(1, 1, At, B1); PG8_BAR;
            PG8_LDB(B0, 1, 0); PG8_SCHED; PG8_LDA(At, 1, 0); PG8_STAGE(PG8_SA(0, 1), a2 + hstep, voffA);
            PG8_WAIT_L(8); PG8_BAR; PG8_WAIT_L(0); PG8_MMA(0, 0, At, B0); PG8_BAR; PG8_SCHED;
            PG8_LDB(B1, 1, 1); PG8_STAGE(PG8_SB(1, 0), b3, voffB);
            PG8_BAR; PG8_WAIT_L(0); PG8_MMA(0, 1, At, B1); PG8_BAR;
            PG8_LDA(At, 1, 1); PG8_STAGE(PG8_SA(1, 0), a3, voffA);
            PG8_BAR; PG8_WAIT_L(0); PG8_MMA(1, 0, At, B0); PG8_BAR; PG8_SCHED;
            PG8_STAGE(PG8_SB(1, 1), b3 + hstep, voffB);
            PG8_WAIT_V(6); PG8_BAR; PG8_MMA(1, 1, At, B1); PG8_BAR;
            }
        }
        if constexpr (ALIGN_EPI) { if (wr == 0) PG8_BAR; }
        if constexpr (!Epi::AFTER_DRAIN) { E(acc, cur, wr, wc, fr, fq); S.done(cur); }
        if (!has_next) break;
#pragma unroll
        for (int a = 0; a < 2; ++a)
#pragma unroll
            for (int b = 0; b < 2; ++b)
#pragma unroll
                for (int m = 0; m < 4; ++m)
#pragma unroll
                    for (int n = 0; n < 2; ++n) acc[a][b][m][n] = (f32x4){0.f, 0.f, 0.f, 0.f};
        cur = nxt; cA = nA; cB = nB; ++ui;
        if constexpr (ALIGN_EPI) { if (wr == 1) PG8_BAR; }
    }
    PG8_WAIT_V(0);
    if constexpr (!ALIGN_EPI) { if (wr == 0) PG8_BAR; }
    PG8_BAR;
#undef PG8_SA
#undef PG8_SB
#undef PG8_STAGE
#undef PG8_LDA
#undef PG8_LDB
#undef PG8_MMA
#undef PG8_WAIT_V
#undef PG8_WAIT_L
#undef PG8_BAR
#undef PG8_SCHED
}
}

__device__ __forceinline__ void transpose_item(const float* W, int K, int N, bf16* WT, LAS float* scr, int item, int lane) {
    const int nblk = N / 32, kb = item / nblk, nb = item % nblk, k0 = 64 * kb, n0 = 32 * nb;
#pragma unroll 8
    for (int i = 0; i < 32; ++i) { const int kk = 2 * i + (lane >> 5); scr[kk * 33 + (lane & 31)] = W[(size_t)(k0 + kk) * N + n0 + (lane & 31)]; }
    asm volatile("s_waitcnt lgkmcnt(0)" ::: "memory");
    const int c = lane & 7;
#pragma unroll
    for (int j = 0; j < 4; ++j) { const int n = (lane >> 3) + 8 * j; const LAS float* s = scr + (8 * c) * 33 + n;
        uint4 o; o.x = pk2(s[0 * 33], s[1 * 33]); o.y = pk2(s[2 * 33], s[3 * 33]); o.z = pk2(s[4 * 33], s[5 * 33]); o.w = pk2(s[6 * 33], s[7 * 33]);
        *(uint4*)(WT + (size_t)(n0 + n) * K + k0 + 8 * c) = o; }
    asm volatile("s_waitcnt lgkmcnt(0)" ::: "memory");
}

__device__ __forceinline__ float wsum(float v) {
#pragma unroll
  for (int o = 32; o > 0; o >>= 1) v += __shfl_xor(v, o, 64);
  return v;
}
__device__ __forceinline__ float wmaxf(float v) {
#pragma unroll
  for (int o = 32; o > 0; o >>= 1) v = fmaxf(v, __shfl_xor(v, o, 64));
  return v;
}
__device__ __forceinline__ float sigmoidf_(float x) { return 1.0f / (1.0f + expf(-x)); }
__device__ __forceinline__ float gelu_tanh(float x) {
  return 0.5f * x * (1.0f + tanhf(0.7978845608028654f * (x + 0.044715f * x * x * x)));
}

template <bool BF16OUT>
__device__ __forceinline__ void rms_rows(const int wave_s, const float* src, const float* g, void* dstv, int rows) {
  const int tid_ = opaque_tid(wave_s);
  const int lane = tid_ & 63;
  const int gw = blockIdx.x * NWAVES + (tid_ >> 6);
  const int nw = gridDim.x * NWAVES;
  for (int r = gw; r < rows; r += nw) {
    const float4* s4 = (const float4*)(src + (size_t)r * DM);
    float4 v[4];
    float ss = 0.f;
#pragma unroll
    for (int i = 0; i < 4; i++) {
      v[i] = s4[lane + i * 64];
      ss += v[i].x * v[i].x + v[i].y * v[i].y + v[i].z * v[i].z + v[i].w * v[i].w;
    }
    ss = wsum(ss);
    const float rstd = rsqrtf(ss * (1.0f / DM) + EPSF);
    const float4* g4 = (const float4*)g;
#pragma unroll
    for (int i = 0; i < 4; i++) {
      float4 gg = g4[lane + i * 64];
      float4 o;
      o.x = v[i].x * rstd * gg.x; o.y = v[i].y * rstd * gg.y;
      o.z = v[i].z * rstd * gg.z; o.w = v[i].w * rstd * gg.w;
      if (BF16OUT) {
        uint2 pk; pk.x = pk2(o.x, o.y); pk.y = pk2(o.z, o.w);
        ((uint2*)((bf16*)dstv + (size_t)r * DM))[lane + i * 64] = pk;
      } else {
        ((float4*)((float*)dstv + (size_t)r * DM))[lane + i * 64] = o;
      }
    }
  }
}

__device__ __forceinline__ void ssm_params(const int wave_s, const Params& p, float* ssmp_all) {
  const int tid_ = opaque_tid(wave_s);
  const float* in8 = karg_in(8); const float* in9 = karg_in(9); const float* in10 = karg_in(10);
  const float* in11 = karg_in(11); const float* in12 = karg_in(12);
  const int gt = blockIdx.x * blockDim.x + tid_;
  const int nth = gridDim.x * blockDim.x;
  for (int i = gt; i < 2 * 16 * 64; i += nth) {
    const int l = i / 1024, gp = i % 1024, g = gp / 64;
    float* sp = ssmp_all + (size_t)l * SSMP_PER_LAYER;
    const float lre = fminf(in8[l * 1024 + gp], -1e-4f);
    const float lim = in9[l * 1024 + gp];
    const float dt = expf(in10[l * 16 + g]);
    const float er = expf(lre * dt);
    float sn, cs;
    sincosf(lim * dt, &sn, &cs);
    const float br = er * cs, bi = er * sn;
    sp[gp * 2 + 0] = br;
    sp[gp * 2 + 1] = bi;
    float cr = br, ci = bi;
#pragma unroll
    for (int s = 0; s < 6; s++) {
      const float nr = cr * cr - ci * ci, ni = 2.f * cr * ci;
      cr = nr; ci = ni;
    }
    sp[2048 + gp * 2 + 0] = cr;
    sp[2048 + gp * 2 + 1] = ci;
    const float nr = br - 1.0f, ni = bi;
    const float den = lre * lre + lim * lim;
    const float fr = (nr * lre + ni * lim) / den;
    const float fi = (ni * lre - nr * lim) / den;
    for (int h = 0; h < 16; h++) {
      const float bre = in11[((size_t)l * 1024 + gp) * 16 + h];
      const float bim = in12[((size_t)l * 1024 + gp) * 16 + h];
      sp[4096 + ((g * 16 + h) * 64 + (gp & 63)) * 2 + 0] = fr * bre - fi * bim;
      sp[4096 + ((g * 16 + h) * 64 + (gp & 63)) * 2 + 1] = fr * bim + fi * bre;
    }
  }
}

__device__ __forceinline__ void conv_phase(const int wave_s, const Params& p, int l, const bf16* proj, bf16* y, LAS float* smem) {
  const int tid_ = opaque_tid(wave_s);
  const int lane = tid_ & 63;
  const int gw = blockIdx.x * NWAVES + (tid_ >> 6);
  const int nw = gridDim.x * NWAVES;
  const float* cw = karg_in(4) + (size_t)l * 31 * 256;
  const float4 cb = ((const float4*)(karg_in(5) + l * 256))[lane];
  const float4 lg = ((const float4*)(karg_in(6) + l * 256))[lane];
  const float4 lb = ((const float4*)(karg_in(7) + l * 256))[lane];
  const float4 gg = ((const float4*)(karg_in(18) + l * 1024))[lane];
  LAS float* cwl = smem + 1024;
  for (int i = tid_; i < 31 * 256 / 4; i += NWAVES * 64) *(LAS pg8::f32x4*)(cwl + 4 * i) = *(const pg8::f32x4*)(cw + 4 * i);
  __syncthreads();
  for (int it = gw; it < NT / 8; it += nw) {
    const int tok0 = it * 8;
    const int t0 = tok0 & (SEQ - 1);
    float4 acc[8];
#pragma unroll
    for (int o = 0; o < 8; o++) acc[o] = cb;
#pragma unroll
    for (int i = 0; i < 38; i++) {
      if (t0 - 30 + i >= 0) {
        const bf16* row = proj + (size_t)(tok0 - 30 + i) * DIN;
        const uint2 vp = ((const uint2*)row)[lane];
        const uint2 gp = ((const uint2*)(row + 256))[lane];
        float4 g4;
        g4.x = bf_lo(vp.x) * sigmoidf_(bf_lo(gp.x)); g4.y = bf_hi(vp.x) * sigmoidf_(bf_hi(gp.x));
        g4.z = bf_lo(vp.y) * sigmoidf_(bf_lo(gp.y)); g4.w = bf_hi(vp.y) * sigmoidf_(bf_hi(gp.y));
#pragma unroll
        for (int o = 0; o < 8; o++) {
          const int j = i - o;
          if (j >= 0 && j <= 30) {
            const pg8::f32x4 w4 = *(const LAS pg8::f32x4*)(cwl + j * 256 + lane * 4);
            acc[o].x += g4.x * w4[0]; acc[o].y += g4.y * w4[1];
            acc[o].z += g4.z * w4[2]; acc[o].w += g4.w * w4[3];
          }
        }
      }
    }
#pragma unroll
    for (int o = 0; o < 8; o++) {
      const float4 a = acc[o];
      const float mean = wsum(a.x + a.y + a.z + a.w) * (1.0f / 256.f);
      const float dx = a.x - mean, dy = a.y - mean, dz = a.z - mean, dw = a.w - mean;
      const float var = wsum(dx * dx + dy * dy + dz * dz + dw * dw) * (1.0f / 256.f);
      const float rs = rsqrtf(var + EPSF);
      float4 s;
      s.x = dx * rs * lg.x + lb.x; s.y = dy * rs * lg.y + lb.y;
      s.z = dz * rs * lg.z + lb.z; s.w = dw * rs * lg.w + lb.w;
      s.x = s.x * sigmoidf_(s.x); s.y = s.y * sigmoidf_(s.y);
      s.z = s.z * sigmoidf_(s.z); s.w = s.w * sigmoidf_(s.w);
      const float ss = wsum(s.x * s.x + s.y * s.y + s.z * s.z + s.w * s.w) * (1.0f / 256.f);
      const float r2 = rsqrtf(ss + EPSF);
      uint2 pk; pk.x = pk2(s.x * r2 * gg.x, s.y * r2 * gg.y); pk.y = pk2(s.z * r2 * gg.z, s.w * r2 * gg.w);
      ((uint2*)(y + (size_t)(tok0 + o) * DM))[lane] = pk;
    }
  }
}

typedef short bf16x8_t __attribute__((ext_vector_type(8)));
typedef float f32x16_t __attribute__((ext_vector_type(16)));
#define MFMA_PAD() do { __builtin_amdgcn_sched_barrier(0); asm volatile("s_nop 15\n\ts_nop 15" ::: "memory"); __builtin_amdgcn_sched_barrier(0); } while (0)

__device__ __forceinline__ void attn_phase(const int wave_s, const Params& p, int l, const bf16* proj, bf16* y, LAS float* smem) {
  const int tid = opaque_tid(wave_s), lane = tid & 63, wave = tid >> 6;
  const int n = lane & 31, hh = lane >> 5;
  const float* gg = karg_in(18) + l * 1024 + 256 + wave * 64;
  const float g0 = gg[n], g1 = gg[32 + n];
  LAS float* ssq = smem;
  LAS float* rstd = smem + 256;
  for (int item = blockIdx.x; item < 4 * 128; item += gridDim.x) {
    const int b = item >> 7, q0 = (item & 127) * 32;
    const size_t tokb = (size_t)b * SEQ;
    bf16x8_t qf[4];
    {
      const bf16* qrow = proj + (tokb + q0 + n) * DIN + 512 + wave * 64 + 8 * hh;
#pragma unroll
      for (int ks = 0; ks < 4; ks++) qf[ks] = *(const bf16x8_t*)(qrow + 16 * ks);
    }
    f32x16_t o0, o1;
#pragma unroll
    for (int r = 0; r < 16; r++) { o0[r] = 0.f; o1[r] = 0.f; }
    float R = 0.f;
    for (int kt = q0; kt >= 0; kt -= 32) {
      bf16x8_t kf[4];
      {
        const bf16* krow = proj + (tokb + kt + n) * DIN + 1024 + wave * 64 + 8 * hh;
#pragma unroll
        for (int ks = 0; ks < 4; ks++) kf[ks] = *(const bf16x8_t*)(krow + 16 * ks);
      }
      bf16x8_t vf0[2], vf1[2];
      {
        const bf16* vb = proj + (tokb + kt + 4 * hh) * DIN + 1536 + wave * 64 + n;
#pragma unroll
        for (int s = 0; s < 2; s++)
#pragma unroll
          for (int j = 0; j < 8; j++) {
            const int key = 16 * s + 8 * (j >> 2) + (j & 3);
            vf0[s][j] = (short)vb[(size_t)key * DIN];
            vf1[s][j] = (short)vb[(size_t)key * DIN + 32];
          }
      }
      f32x16_t sacc;
#pragma unroll
      for (int r = 0; r < 16; r++) sacc[r] = 0.f;
      __builtin_amdgcn_sched_barrier(0); asm volatile("s_nop 15\n\ts_nop 15" ::: "memory"); __builtin_amdgcn_sched_barrier(0);
#pragma unroll
      for (int ks = 0; ks < 4; ks++) sacc = __builtin_amdgcn_mfma_f32_32x32x16_bf16(kf[ks], qf[ks], sacc, 0, 0, 0);
      __builtin_amdgcn_sched_barrier(0); asm volatile("s_nop 15\n\ts_nop 15" ::: "memory"); __builtin_amdgcn_sched_barrier(0);
      float lst[16], lsz[16];
      const bool diag = (kt == q0);
#pragma unroll
      for (int r = 0; r < 16; r++) {
        const float z = sacc[r] * 0.125f;
        const float sp = __logf(1.0f + __expf(-fabsf(z)));
        float a = fminf(z, 0.f) - sp;
        float c = -(fmaxf(z, 0.f) + sp);
        if (diag) {
          const int key = (r & 3) + 8 * (r >> 2) + 4 * hh;
          if (key >= n) { a = -1.0e30f; c = 0.f; }
        }
        lsz[r] = a; lst[r] = c;
      }
      float Gs[4], Gp[4];
#pragma unroll
      for (int g = 0; g < 4; g++) {
        Gs[g] = (lst[4 * g] + lst[4 * g + 1]) + (lst[4 * g + 2] + lst[4 * g + 3]);
        Gp[g] = __shfl_xor(Gs[g], 32, 64);
      }
      float carry[4];
      {
        float after = R;
#pragma unroll
        for (int g = 3; g >= 0; g--) {
          carry[g] = after + (hh ? 0.f : Gp[g]);
          after += Gs[g] + Gp[g];
        }
        R = after;
      }
      bf16x8_t pf[2];
#pragma unroll
      for (int g = 0; g < 4; g++) {
        float run = carry[g];
        float a3 = __expf(lsz[4 * g + 3] + run); run += lst[4 * g + 3];
        float a2 = __expf(lsz[4 * g + 2] + run); run += lst[4 * g + 2];
        float a1 = __expf(lsz[4 * g + 1] + run); run += lst[4 * g + 1];
        float a0 = __expf(lsz[4 * g + 0] + run);
        const int s = g >> 1, jb = (g & 1) * 4;
        pf[s][jb + 0] = (short)f2bf(a0); pf[s][jb + 1] = (short)f2bf(a1);
        pf[s][jb + 2] = (short)f2bf(a2); pf[s][jb + 3] = (short)f2bf(a3);
      }
      __builtin_amdgcn_sched_barrier(0); asm volatile("s_nop 15\n\ts_nop 15" ::: "memory"); __builtin_amdgcn_sched_barrier(0);
#pragma unroll
      for (int s = 0; s < 2; s++) {
        o0 = __builtin_amdgcn_mfma_f32_32x32x16_bf16(pf[s], vf0[s], o0, 0, 0, 0);
        o1 = __builtin_amdgcn_mfma_f32_32x32x16_bf16(pf[s], vf1[s], o1, 0, 0, 0);
      }
      __builtin_amdgcn_sched_barrier(0); asm volatile("s_nop 15\n\ts_nop 15" ::: "memory"); __builtin_amdgcn_sched_barrier(0);
      if (__all(R < -110.f)) break;
    }
    float sq[16];
#pragma unroll
    for (int r = 0; r < 16; r++) {
      float v = o0[r] * o0[r] + o1[r] * o1[r];
#pragma unroll
      for (int o = 16; o > 0; o >>= 1) v += __shfl_xor(v, o, 64);
      sq[r] = v;
    }
    __syncthreads();
    if (n == 0) {
#pragma unroll
      for (int r = 0; r < 16; r++) ssq[wave * 32 + (r & 3) + 8 * (r >> 2) + 4 * hh] = sq[r];
    }
    __syncthreads();
    if (tid < 32) {
      float t = 0.f;
#pragma unroll
      for (int w = 0; w < 8; w++) t += ssq[w * 32 + tid];
      rstd[tid] = rsqrtf(t * (1.0f / 512.f) + EPSF);
    }
    __syncthreads();
#pragma unroll
    for (int r = 0; r < 16; r++) {
      const int qi = (r & 3) + 8 * (r >> 2) + 4 * hh;
      const float rs = rstd[qi];
      bf16* yr = y + (tokb + q0 + qi) * DM + 256 + wave * 64 + n;
      yr[0] = (bf16)f2bf(o0[r] * rs * g0);
      yr[32] = (bf16)f2bf(o1[r] * rs * g1);
    }
  }
}

#define SSM_BCAST_U(u, ua, ub, tt) do { \
    const unsigned w0 = (unsigned)__builtin_amdgcn_readlane((int)(ua).x, (tt)), w1 = (unsigned)__builtin_amdgcn_readlane((int)(ua).y, (tt)); \
    const unsigned w2 = (unsigned)__builtin_amdgcn_readlane((int)(ua).z, (tt)), w3 = (unsigned)__builtin_amdgcn_readlane((int)(ua).w, (tt)); \
    const unsigned w4 = (unsigned)__builtin_amdgcn_readlane((int)(ub).x, (tt)), w5 = (unsigned)__builtin_amdgcn_readlane((int)(ub).y, (tt)); \
    const unsigned w6 = (unsigned)__builtin_amdgcn_readlane((int)(ub).z, (tt)), w7 = (unsigned)__builtin_amdgcn_readlane((int)(ub).w, (tt)); \
    (u)[0] = bf_lo(w0); (u)[1] = bf_hi(w0); (u)[2] = bf_lo(w1); (u)[3] = bf_hi(w1); (u)[4] = bf_lo(w2); (u)[5] = bf_hi(w2); (u)[6] = bf_lo(w3); (u)[7] = bf_hi(w3); \
    (u)[8] = bf_lo(w4); (u)[9] = bf_hi(w4); (u)[10] = bf_lo(w5); (u)[11] = bf_hi(w5); (u)[12] = bf_lo(w6); (u)[13] = bf_hi(w6); (u)[14] = bf_lo(w7); (u)[15] = bf_hi(w7); } while (0)
__device__ __forceinline__ void ssm_chunk_end(const int wave_s, const float* ssmp, const bf16* proj, float* ssmE) {
  const int tid_ = opaque_tid(wave_s);
  const int lane = tid_ & 63;
  const int gw = blockIdx.x * NWAVES + (tid_ >> 6);
  const int nw = gridDim.x * NWAVES;
  for (int it = gw; it < 4 * 64 * 16; it += nw) {
    const int g = it & 15, c = (it >> 4) & 63, b = it >> 10;
    const int gp = g * 64 + lane;
    const uint4* up = (const uint4*)(proj + (size_t)(b * SEQ + c * 64 + lane) * DIN + 2048 + g * 16);
    const uint4 ua = up[0], ub = up[1];
    const float lbr = ssmp[gp * 2], lbi = ssmp[gp * 2 + 1];
    float bbr[16], bbi[16];
#pragma unroll
    for (int h = 0; h < 16; h++) {
      { const float2 bb = *(const float2*)(ssmp + 4096 + ((g * 16 + h) * 64 + lane) * 2); bbr[h] = bb.x; bbi[h] = bb.y; }
    }
    float xr = 0.f, xi = 0.f;
#pragma unroll 2
    for (int tt = 0; tt < 64; tt++) {
      float u[16];
      SSM_BCAST_U(u, ua, ub, tt);
      float br = 0.f, bi = 0.f;
#pragma unroll
      for (int h = 0; h < 16; h++) { br += bbr[h] * u[h]; bi += bbi[h] * u[h]; }
      const float nr = lbr * xr - lbi * xi + br;
      const float ni = lbr * xi + lbi * xr + bi;
      xr = nr; xi = ni;
    }
    float* e = ssmE + ((size_t)((b * 64 + c) * 16 + g) * 64 + lane) * 2;
    e[0] = xr; e[1] = xi;
  }
}

__device__ __forceinline__ void ssm_finish(const int wave_s, const Params& p, int l, const float* ssmp, const bf16* proj,
                           const float* ssmE, bf16* y, LAS float* smem) {
  LAS bf16* Ytb = (LAS bf16*)smem;
  LAS float* ssq2 = smem + (64 * 264 * 2) / 4;
  LAS float* rstd2 = ssq2 + 512;
  const bf16* glT = (const bf16*)(p.ws + WS_WT + (size_t)l * WT_LAYER + WT_GLU);
  const int tid = opaque_tid(wave_s), lane = tid & 63, wave = tid >> 6;
  const float* cre = karg_in(13) + (size_t)l * 16 * 16 * 64;
  const float* cim = karg_in(14) + (size_t)l * 16 * 16 * 64;
  const float* dsk = karg_in(15) + l * 256;
  const float* glw = karg_in(16) + (size_t)l * 256 * 256;
  const float* glb = karg_in(17) + l * 256;
  const float* gg = karg_in(18) + l * 1024 + 768;
  for (int it = blockIdx.x; it < 256; it += gridDim.x) {
    const int b = it >> 6, c = it & 63;
    __syncthreads();
    for (int gi = 0; gi < 2; gi++) {
      const int g = wave + gi * 8;
      const int gp = g * 64 + lane;
      const float lbr = ssmp[gp * 2], lbi = ssmp[gp * 2 + 1];
      const float lcr = ssmp[2048 + gp * 2], lci = ssmp[2048 + gp * 2 + 1];
      float bbr[16], bbi[16], ccr[16], cci[16];
#pragma unroll
      for (int h = 0; h < 16; h++) {
        { const float2 bb = *(const float2*)(ssmp + 4096 + ((g * 16 + h) * 64 + lane) * 2); bbr[h] = bb.x; bbi[h] = bb.y; }
        ccr[h] = cre[(g * 16 + h) * 64 + lane];
        cci[h] = cim[(g * 16 + h) * 64 + lane];
      }
      float xr = 0.f, xi = 0.f;
      {
        const float2* eb = (const float2*)ssmE + ((size_t)(b * 64) * 16 + g) * 64 + lane;
        int cc = 0;
        for (; cc + 8 <= c; cc += 8) {
          float2 ev[8];
#pragma unroll
          for (int k = 0; k < 8; k++) ev[k] = eb[(size_t)(cc + k) * 16 * 64];
#pragma unroll
          for (int k = 0; k < 8; k++) {
            const float nr = lcr * xr - lci * xi + ev[k].x;
            const float ni = lcr * xi + lci * xr + ev[k].y;
            xr = nr; xi = ni;
          }
        }
        for (; cc < c; cc++) {
          const float2 e1 = eb[(size_t)cc * 16 * 64];
          const float nr = lcr * xr - lci * xi + e1.x;
          const float ni = lcr * xi + lci * xr + e1.y;
          xr = nr; xi = ni;
        }
      }
      const int hq = ((lane >> 5) & 1) * 8 + ((lane >> 4) & 1) * 4 + ((lane >> 3) & 1) * 2 + ((lane >> 2) & 1);
      float dm[16];
#pragma unroll
      for (int h = 0; h < 16; h++) dm[h] = (lane == 0) ? dsk[g * 16 + h] : 0.f;
      const uint4* up = (const uint4*)(proj + (size_t)(b * SEQ + c * 64 + lane) * DIN + 2048 + g * 16);
      const uint4 ua = up[0], ub = up[1];
#pragma unroll 1
      for (int t4 = 0; t4 < 64; t4 += 4) {
        float vv[4][16];
#pragma unroll
        for (int s = 0; s < 4; s++) {
          float u[16];
          SSM_BCAST_U(u, ua, ub, t4 + s);
          float br = 0.f, bi = 0.f;
#pragma unroll
          for (int h = 0; h < 16; h++) { br += bbr[h] * u[h]; bi += bbi[h] * u[h]; }
          const float nr = lbr * xr - lbi * xi + br;
          const float ni = lbr * xi + lbi * xr + bi;
          xr = nr; xi = ni;
#pragma unroll
          for (int h = 0; h < 16; h++) vv[s][h] = xr * ccr[h] - xi * cci[h] + dm[h] * u[h];
        }
        float v1[4];
#pragma unroll
        for (int s = 0; s < 4; s++) {
          float v8[8], v4[4], v2[2];
          {
            const bool hi = (lane & 32) != 0;
#pragma unroll
            for (int i = 0; i < 8; i++) { const float send = hi ? vv[s][i] : vv[s][i + 8]; const float keep = hi ? vv[s][i + 8] : vv[s][i]; v8[i] = keep + __shfl_xor(send, 32, 64); }
          }
          {
            const bool hi = (lane & 16) != 0;
#pragma unroll
            for (int i = 0; i < 4; i++) { const float send = hi ? v8[i] : v8[i + 4]; const float keep = hi ? v8[i + 4] : v8[i]; v4[i] = keep + __shfl_xor(send, 16, 64); }
          }
          {
            const bool hi = (lane & 8) != 0;
#pragma unroll
            for (int i = 0; i < 2; i++) { const float send = hi ? v4[i] : v4[i + 2]; const float keep = hi ? v4[i + 2] : v4[i]; v2[i] = keep + __shfl_xor(send, 8, 64); }
          }
          {
            const bool hi = (lane & 4) != 0;
            const float send = hi ? v2[0] : v2[1];
            const float keep = hi ? v2[1] : v2[0];
            v1[s] = keep + __shfl_xor(send, 4, 64);
          }
          v1[s] += __shfl_xor(v1[s], 2, 64);
          v1[s] += __shfl_xor(v1[s], 1, 64);
        }
        if ((lane & 3) == 0) {
#pragma unroll
          for (int s = 0; s < 4; s++) Ytb[(t4 + s) * 264 + g * 16 + hq] = (bf16)f2bf(gelu_tanh(v1[s]));
        }
      }
    }
    __syncthreads();
    {
      const int n = lane & 31, hh = lane >> 5;
      const int ch = wave * 32 + n;
      const float bj = glb[ch];
      const float gj = gg[ch];
      bf16x8_t gf[16];
      {
        const bf16* grow = glT + (size_t)ch * 256 + 8 * hh;
#pragma unroll
        for (int ks = 0; ks < 16; ks++) gf[ks] = *(const bf16x8_t*)(grow + 16 * ks);
      }
      float oo[2][16];
#pragma unroll
      for (int mt = 0; mt < 2; mt++) {
        f32x16_t z;
#pragma unroll
        for (int r = 0; r < 16; r++) z[r] = 0.f;
        const LAS bf16* yrow = Ytb + (mt * 32 + n) * 264 + 8 * hh;
#pragma unroll
        for (int kq = 0; kq < 4; kq++) {
          bf16x8_t yf[4];
#pragma unroll
          for (int i = 0; i < 4; i++) yf[i] = *(const LAS bf16x8_t*)(yrow + 16 * (kq * 4 + i));
          MFMA_PAD();
#pragma unroll
          for (int i = 0; i < 4; i++) z = __builtin_amdgcn_mfma_f32_32x32x16_bf16(yf[i], gf[kq * 4 + i], z, 0, 0, 0);
          MFMA_PAD();
        }
        float sq[16];
#pragma unroll
        for (int r = 0; r < 16; r++) {
          const int t = mt * 32 + (r & 3) + 8 * (r >> 2) + 4 * hh;
          const float yv = bf2f(Ytb[t * 264 + ch]);
          const float o = yv * sigmoidf_(z[r] + bj);
          oo[mt][r] = o;
          float v = o * o;
#pragma unroll
          for (int s = 16; s > 0; s >>= 1) v += __shfl_xor(v, s, 64);
          sq[r] = v;
        }
        if (n == 0) {
#pragma unroll
          for (int r = 0; r < 16; r++) ssq2[wave * 64 + mt * 32 + (r & 3) + 8 * (r >> 2) + 4 * hh] = sq[r];
        }
      }
      __syncthreads();
      if (tid < 64) {
        float t = 0.f;
#pragma unroll
        for (int w = 0; w < 8; w++) t += ssq2[w * 64 + tid];
        rstd2[tid] = rsqrtf(t * (1.0f / 256.f) + EPSF);
      }
      __syncthreads();
#pragma unroll
      for (int mt = 0; mt < 2; mt++)
#pragma unroll
        for (int r = 0; r < 16; r++) {
          const int t = mt * 32 + (r & 3) + 8 * (r >> 2) + 4 * hh;
          y[(size_t)(b * SEQ + c * 64 + t) * DM + 768 + ch] = (bf16)f2bf(oo[mt][r] * rstd2[t] * gj);
        }
    }
  }
}

__device__ __forceinline__ void memattn_phase(const int wave_s, const bf16* q, const bf16* kvb, const bf16* vT, bf16* o, LAS float* smem) {
  const int tid_ = opaque_tid(wave_s);
  const int lane = tid_ & 63, n = lane & 31, hh = lane >> 5, wave = tid_ >> 6;
  const int sig = (n & 0x13) | ((n & 4) << 1) | ((n & 8) >> 1);
  LAS bf16* Ls = (LAS bf16*)smem;
  for (int it = blockIdx.x; it < 64 * 4; it += gridDim.x) {
    const int h = it & 3, tg = it >> 2, b = tg >> 4;
    const int tok0 = (tg * 8 + wave) * 32;
    __syncthreads();
    {
      const int r = tid_ >> 1, hf = tid_ & 1;
      const pg8::u32x4* src4 = (const pg8::u32x4*)(kvb + (size_t)(b * NMEM + r) * 2048 + h * 256 + hf * 128);
      LAS pg8::u32x4* dst4 = (LAS pg8::u32x4*)(Ls + r * 264 + hf * 128);
#pragma unroll
      for (int k = 0; k < 16; k++) dst4[k] = src4[k];
    }
    f32x16_t st[8];
#pragma unroll
    for (int kt = 0; kt < 8; kt++)
#pragma unroll
      for (int r = 0; r < 16; r++) st[kt][r] = 0.f;
    const bf16* qrow = q + (size_t)(tok0 + n) * DM + h * 256 + 8 * hh;
    __syncthreads();
#pragma unroll
    for (int kq = 0; kq < 4; kq++) {
      bf16x8_t qf[4];
#pragma unroll
      for (int i = 0; i < 4; i++) qf[i] = *(const bf16x8_t*)(qrow + 16 * (kq * 4 + i));
#pragma unroll
      for (int kt = 0; kt < 8; kt++) {
        const LAS bf16* krow = Ls + (kt * 32 + sig) * 264 + 8 * hh;
        bf16x8_t kf[4];
#pragma unroll
        for (int i = 0; i < 4; i++) kf[i] = *(const LAS bf16x8_t*)(krow + 16 * (kq * 4 + i));
        MFMA_PAD();
#pragma unroll
        for (int i = 0; i < 4; i++) st[kt] = __builtin_amdgcn_mfma_f32_32x32x16_bf16(kf[i], qf[i], st[kt], 0, 0, 0);
        MFMA_PAD();
      }
    }
    float mx = st[0][0];
#pragma unroll
    for (int kt = 0; kt < 8; kt++)
#pragma unroll
      for (int r = 0; r < 16; r++) mx = fmaxf(mx, st[kt][r]);
    mx = fmaxf(mx, __shfl_xor(mx, 32, 64));
    float sum = 0.f;
#pragma unroll
    for (int kt = 0; kt < 8; kt++)
#pragma unroll
      for (int r = 0; r < 16; r++) { const float e = __expf((st[kt][r] - mx) * 0.0625f); st[kt][r] = e; sum += e; }
    sum += __shfl_xor(sum, 32, 64);
    const float inv = 1.0f / sum;
    bf16x8_t pf[8][2];
#pragma unroll
    for (int kt = 0; kt < 8; kt++)
#pragma unroll
      for (int s = 0; s < 2; s++)
#pragma unroll
        for (int j = 0; j < 8; j++) pf[kt][s][j] = (short)f2bf(st[kt][8 * s + j] * inv);
    __syncthreads();
    {
      const int r = tid_ >> 1, hf = tid_ & 1;
      const pg8::u32x4* src4 = (const pg8::u32x4*)(vT + ((size_t)(b * 4 + h) * 256 + r) * 256 + hf * 128);
      LAS pg8::u32x4* dst4 = (LAS pg8::u32x4*)(Ls + r * 264 + hf * 128);
#pragma unroll
      for (int k = 0; k < 16; k++) dst4[k] = src4[k];
    }
    __syncthreads();
#pragma unroll 1
    for (int dt = 0; dt < 8; dt++) {
      f32x16_t oacc;
#pragma unroll
      for (int r = 0; r < 16; r++) oacc[r] = 0.f;
      const LAS bf16* vrow = Ls + (dt * 32 + n) * 264 + 8 * hh;
#pragma unroll
      for (int kq = 0; kq < 4; kq++) {
        bf16x8_t vf[4];
#pragma unroll
        for (int i = 0; i < 4; i++) vf[i] = *(const LAS bf16x8_t*)(vrow + (kq * 2 + (i >> 1)) * 32 + 16 * (i & 1));
        MFMA_PAD();
#pragma unroll
        for (int i = 0; i < 4; i++) oacc = __builtin_amdgcn_mfma_f32_32x32x16_bf16(pf[kq * 2 + (i >> 1)][i & 1], vf[i], oacc, 0, 0, 0);
        MFMA_PAD();
      }
#pragma unroll
      for (int r = 0; r < 16; r++) {
        const int qi = (r & 3) + 8 * (r >> 2) + 4 * hh;
        o[(size_t)(tok0 + qi) * DM + h * 256 + dt * 32 + n] = (bf16)f2bf(oacc[r]);
      }
    }
  }
}

__device__ __forceinline__ void vt_phase(const int wave_s, const bf16* kvb, bf16* vT) {
  const int tid_ = opaque_tid(wave_s);
  const int gt = blockIdx.x * (NWAVES * 64) + tid_;
  const int nth = gridDim.x * NWAVES * 64;
  for (int i = gt; i < 2 * 4 * 4 * 256 * 256; i += nth) {
    const int m = i & 255, d = (i >> 8) & 255, h = (i >> 16) & 3, b = (i >> 18) & 3, l = i >> 20;
    vT[i] = kvb[((size_t)l * 1024 + b * 256 + m) * 2048 + 1024 + h * 256 + d];
  }
}

template <unsigned MASK>
__device__ __forceinline__ float pack_key(float s, unsigned idx) {
  const unsigned u = __builtin_bit_cast(unsigned, s);
  const unsigned tag = ((int)u < 0) ? idx : (MASK - idx);
  return __builtin_bit_cast(float, (u & ~MASK) + tag);
}
template <unsigned MASK>
__device__ __forceinline__ unsigned key_idx(float k) {
  const unsigned u = __builtin_bit_cast(unsigned, k);
  const unsigned tag = u & MASK;
  return ((int)u < 0) ? tag : (MASK - tag);
}
template <unsigned MASK>
__device__ __forceinline__ float key_val(float k) { return __builtin_bit_cast(float, __builtin_bit_cast(unsigned, k) & ~MASK); }
__device__ __forceinline__ void top16_of_64(float (&K)[64]) {
  { const float a_ = K[0], b_ = K[1]; const bool g_ = a_ > b_; K[0] = g_ ? a_ : b_; K[1] = g_ ? b_ : a_; }
  { const float a_ = K[2], b_ = K[3]; const bool g_ = a_ > b_; K[2] = g_ ? b_ : a_; K[3] = g_ ? a_ : b_; }
  { const float a_ = K[4], b_ = K[5]; const bool g_ = a_ > b_; K[4] = g_ ? a_ : b_; K[5] = g_ ? b_ : a_; }
  { const float a_ = K[6], b_ = K[7]; const bool g_ = a_ > b_; K[6] = g_ ? b_ : a_; K[7] = g_ ? a_ : b_; }
  { const float a_ = K[8], b_ = K[9]; const bool g_ = a_ > b_; K[8] = g_ ? a_ : b_; K[9] = g_ ? b_ : a_; }
  { const float a_ = K[10], b_ = K[11]; const bool g_ = a_ > b_; K[10] = g_ ? b_ : a_; K[11] = g_ ? a_ : b_; }
  { const float a_ = K[12], b_ = K[13]; const bool g_ = a_ > b_; K[12] = g_ ? a_ : b_; K[13] = g_ ? b_ : a_; }
  { const float a_ = K[14], b_ = K[15]; const bool g_ = a_ > b_; K[14] = g_ ? b_ : a_; K[15] = g_ ? a_ : b_; }
  { const float a_ = K[0], b_ = K[2]; const bool g_ = a_ > b_; K[0] = g_ ? a_ : b_; K[2] = g_ ? b_ : a_; }
  { const float a_ = K[1], b_ = K[3]; const bool g_ = a_ > b_; K[1] = g_ ? a_ : b_; K[3] = g_ ? b_ : a_; }
  { const float a_ = K[4], b_ = K[6]; const bool g_ = a_ > b_; K[4] = g_ ? b_ : a_; K[6] = g_ ? a_ : b_; }
  { const float a_ = K[5], b_ = K[7]; const bool g_ = a_ > b_; K[5] = g_ ? b_ : a_; K[7] = g_ ? a_ : b_; }
  { const float a_ = K[8], b_ = K[10]; const bool g_ = a_ > b_; K[8] = g_ ? a_ : b_; K[10] = g_ ? b_ : a_; }
  { const float a_ = K[9], b_ = K[11]; const bool g_ = a_ > b_; K[9] = g_ ? a_ : b_; K[11] = g_ ? b_ : a_; }
  { const float a_ = K[12], b_ = K[14]; const bool g_ = a_ > b_; K[12] = g_ ? b_ : a_; K[14] = g_ ? a_ : b_; }
  { const float a_ = K[13], b_ = K[15]; const bool g_ = a_ > b_; K[13] = g_ ? b_ : a_; K[15] = g_ ? a_ : b_; }
  { const float a_ = K[0], b_ = K[1]; const bool g_ = a_ > b_; K[0] = g_ ? a_ : b_; K[1] = g_ ? b_ : a_; }
  { const float a_ = K[2], b_ = K[3]; const bool g_ = a_ > b_; K[2] = g_ ? a_ : b_; K[3] = g_ ? b_ : a_; }
  { const float a_ = K[4], b_ = K[5]; const bool g_ = a_ > b_; K[4] = g_ ? b_ : a_; K[5] = g_ ? a_ : b_; }
  { const float a_ = K[6], b_ = K[7]; const bool g_ = a_ > b_; K[6] = g_ ? b_ : a_; K[7] = g_ ? a_ : b_; }
  { const float a_ = K[8], b_ = K[9]; const bool g_ = a_ > b_; K[8] = g_ ? a_ : b_; K[9] = g_ ? b_ : a_; }
  { const float a_ = K[10], b_ = K[11]; const bool g_ = a_ > b_; K[10] = g_ ? a_ : b_; K[11] = g_ ? b_ : a_; }
  { const float a_ = K[12], b_ = K[13]; const bool g_ = a_ > b_; K[12] = g_ ? b_ : a_; K[13] = g_ ? a_ : b_; }
  { const float a_ = K[14], b_ = K[15]; const bool g_ = a_ > b_; K[14] = g_ ? b_ : a_; K[15] = g_ ? a_ : b_; }
  { const float a_ = K[0], b_ = K[4]; const bool g_ = a_ > b_; K[0] = g_ ? a_ : b_; K[4] = g_ ? b_ : a_; }
  { const float a_ = K[1], b_ = K[5]; const bool g_ = a_ > b_; K[1] = g_ ? a_ : b_; K[5] = g_ ? b_ : a_; }
  { const float a_ = K[2], b_ = K[6]; const bool g_ = a_ > b_; K[2] = g_ ? a_ : b_; K[6] = g_ ? b_ : a_; }
  { const float a_ = K[3], b_ = K[7]; const bool g_ = a_ > b_; K[3] = g_ ? a_ : b_; K[7] = g_ ? b_ : a_; }
  { const float a_ = K[8], b_ = K[12]; const bool g_ = a_ > b_; K[8] = g_ ? b_ : a_; K[12] = g_ ? a_ : b_; }
  { const float a_ = K[9], b_ = K[13]; const bool g_ = a_ > b_; K[9] = g_ ? b_ : a_; K[13] = g_ ? a_ : b_; }
  { const float a_ = K[10], b_ = K[14]; const bool g_ = a_ > b_; K[10] = g_ ? b_ : a_; K[14] = g_ ? a_ : b_; }
  { const float a_ = K[11], b_ = K[15]; const bool g_ = a_ > b_; K[11] = g_ ? b_ : a_; K[15] = g_ ? a_ : b_; }
  { const float a_ = K[0], b_ = K[2]; const bool g_ = a_ > b_; K[0] = g_ ? a_ : b_; K[2] = g_ ? b_ : a_; }
  { const float a_ = K[1], b_ = K[3]; const bool g_ = a_ > b_; K[1] = g_ ? a_ : b_; K[3] = g_ ? b_ : a_; }
  { const float a_ = K[4], b_ = K[6]; const bool g_ = a_ > b_; K[4] = g_ ? a_ : b_; K[6] = g_ ? b_ : a_; }
  { const float a_ = K[5], b_ = K[7]; const bool g_ = a_ > b_; K[5] = g_ ? a_ : b_; K[7] = g_ ? b_ : a_; }
  { const float a_ = K[8], b_ = K[10]; const bool g_ = a_ > b_; K[8] = g_ ? b_ : a_; K[10] = g_ ? a_ : b_; }
  { const float a_ = K[9], b_ = K[11]; const bool g_ = a_ > b_; K[9] = g_ ? b_ : a_; K[11] = g_ ? a_ : b_; }
  { const float a_ = K[12], b_ = K[14]; const bool g_ = a_ > b_; K[12] = g_ ? b_ : a_; K[14] = g_ ? a_ : b_; }
  { const float a_ = K[13], b_ = K[15]; const bool g_ = a_ > b_; K[13] = g_ ? b_ : a_; K[15] = g_ ? a_ : b_; }
  { const float a_ = K[0], b_ = K[1]; const bool g_ = a_ > b_; K[0] = g_ ? a_ : b_; K[1] = g_ ? b_ : a_; }
  { const float a_ = K[2], b_ = K[3]; const bool g_ = a_ > b_; K[2] = g_ ? a_ : b_; K[3] = g_ ? b_ : a_; }
  { const float a_ = K[4], b_ = K[5]; const bool g_ = a_ > b_; K[4] = g_ ? a_ : b_; K[5] = g_ ? b_ : a_; }
  { const float a_ = K[6], b_ = K[7]; const bool g_ = a_ > b_; K[6] = g_ ? a_ : b_; K[7] = g_ ? b_ : a_; }
  { const float a_ = K[8], b_ = K[9]; const bool g_ = a_ > b_; K[8] = g_ ? b_ : a_; K[9] = g_ ? a_ : b_; }
  { const float a_ = K[10], b_ = K[11]; const bool g_ = a_ > b_; K[10] = g_ ? b_ : a_; K[11] = g_ ? a_ : b_; }
  { const float a_ = K[12], b_ = K[13]; const bool g_ = a_ > b_; K[12] = g_ ? b_ : a_; K[13] = g_ ? a_ : b_; }
  { const float a_ = K[14], b_ = K[15]; const bool g_ = a_ > b_; K[14] = g_ ? b_ : a_; K[15] = g_ ? a_ : b_; }
  { const float a_ = K[0], b_ = K[8]; const bool g_ = a_ > b_; K[0] = g_ ? a_ : b_; K[8] = g_ ? b_ : a_; }
  { const float a_ = K[1], b_ = K[9]; const bool g_ = a_ > b_; K[1] = g_ ? a_ : b_; K[9] = g_ ? b_ : a_; }
  { const float a_ = K[2], b_ = K[10]; const bool g_ = a_ > b_; K[2] = g_ ? a_ : b_; K[10] = g_ ? b_ : a_; }
  { const float a_ = K[3], b_ = K[11]; const bool g_ = a_ > b_; K[3] = g_ ? a_ : b_; K[11] = g_ ? b_ : a_; }
  { const float a_ = K[4], b_ = K[12]; const bool g_ = a_ > b_; K[4] = g_ ? a_ : b_; K[12] = g_ ? b_ : a_; }
  { const float a_ = K[5], b_ = K[13]; const bool g_ = a_ > b_; K[5] = g_ ? a_ : b_; K[13] = g_ ? b_ : a_; }
  { const float a_ = K[6], b_ = K[14]; const bool g_ = a_ > b_; K[6] = g_ ? a_ : b_; K[14] = g_ ? b_ : a_; }
  { const float a_ = K[7], b_ = K[15]; const bool g_ = a_ > b_; K[7] = g_ ? a_ : b_; K[15] = g_ ? b_ : a_; }
  { const float a_ = K[0], b_ = K[4]; const bool g_ = a_ > b_; K[0] = g_ ? a_ : b_; K[4] = g_ ? b_ : a_; }
  { const float a_ = K[1], b_ = K[5]; const bool g_ = a_ > b_; K[1] = g_ ? a_ : b_; K[5] = g_ ? b_ : a_; }
  { const float a_ = K[2], b_ = K[6]; const bool g_ = a_ > b_; K[2] = g_ ? a_ : b_; K[6] = g_ ? b_ : a_; }
  { const float a_ = K[3], b_ = K[7]; const bool g_ = a_ > b_; K[3] = g_ ? a_ : b_; K[7] = g_ ? b_ : a_; }
  { const float a_ = K[8], b_ = K[12]; const bool g_ = a_ > b_; K[8] = g_ ? a_ : b_; K[12] = g_ ? b_ : a_; }
  { const float a_ = K[9], b_ = K[13]; const bool g_ = a_ > b_; K[9] = g_ ? a_ : b_; K[13] = g_ ? b_ : a_; }
  { const float a_ = K[10], b_ = K[14]; const bool g_ = a_ > b_; K[10] = g_ ? a_ : b_; K[14] = g_ ? b_ : a_; }
  { const float a_ = K[11], b_ = K[15]; const bool g_ = a_ > b_; K[11] = g_ ? a_ : b_; K[15] = g_ ? b_ : a_; }
  { const float a_ = K[0], b_ = K[2]; const bool g_ = a_ > b_; K[0] = g_ ? a_ : b_; K[2] = g_ ? b_ : a_; }
  { const float a_ = K[1], b_ = K[3]; const bool g_ = a_ > b_; K[1] = g_ ? a_ : b_; K[3] = g_ ? b_ : a_; }
  { const float a_ = K[4], b_ = K[6]; const bool g_ = a_ > b_; K[4] = g_ ? a_ : b_; K[6] = g_ ? b_ : a_; }
  { const float a_ = K[5], b_ = K[7]; const bool g_ = a_ > b_; K[5] = g_ ? a_ : b_; K[7] = g_ ? b_ : a_; }
  { const float a_ = K[8], b_ = K[10]; const bool g_ = a_ > b_; K[8] = g_ ? a_ : b_; K[10] = g_ ? b_ : a_; }
  { const float a_ = K[9], b_ = K[11]; const bool g_ = a_ > b_; K[9] = g_ ? a_ : b_; K[11] = g_ ? b_ : a_; }
  { const float a_ = K[12], b_ = K[14]; const bool g_ = a_ > b_; K[12] = g_ ? a_ : b_; K[14] = g_ ? b_ : a_; }
  { const float a_ = K[13], b_ = K[15]; const bool g_ = a_ > b_; K[13] = g_ ? a_ : b_; K[15] = g_ ? b_ : a_; }
  { const float a_ = K[0], b_ = K[1]; const bool g_ = a_ > b_; K[0] = g_ ? a_ : b_; K[1] = g_ ? b_ : a_; }
  { const float a_ = K[2], b_ = K[3]; const bool g_ = a_ > b_; K[2] = g_ ? a_ : b_; K[3] = g_ ? b_ : a_; }
  { const float a_ = K[4], b_ = K[5]; const bool g_ = a_ > b_; K[4] = g_ ? a_ : b_; K[5] = g_ ? b_ : a_; }
  { const float a_ = K[6], b_ = K[7]; const bool g_ = a_ > b_; K[6] = g_ ? a_ : b_; K[7] = g_ ? b_ : a_; }
  { const float a_ = K[8], b_ = K[9]; const bool g_ = a_ > b_; K[8] = g_ ? a_ : b_; K[9] = g_ ? b_ : a_; }
  { const float a_ = K[10], b_ = K[11]; const bool g_ = a_ > b_; K[10] = g_ ? a_ : b_; K[11] = g_ ? b_ : a_; }
  { const float a_ = K[12], b_ = K[13]; const bool g_ = a_ > b_; K[12] = g_ ? a_ : b_; K[13] = g_ ? b_ : a_; }
  { const float a_ = K[14], b_ = K[15]; const bool g_ = a_ > b_; K[14] = g_ ? a_ : b_; K[15] = g_ ? b_ : a_; }
  { const float a_ = K[16], b_ = K[17]; const bool g_ = a_ > b_; K[16] = g_ ? a_ : b_; K[17] = g_ ? b_ : a_; }
  { const float a_ = K[18], b_ = K[19]; const bool g_ = a_ > b_; K[18] = g_ ? b_ : a_; K[19] = g_ ? a_ : b_; }
  { const float a_ = K[20], b_ = K[21]; const bool g_ = a_ > b_; K[20] = g_ ? a_ : b_; K[21] = g_ ? b_ : a_; }
  { const float a_ = K[22], b_ = K[23]; const bool g_ = a_ > b_; K[22] = g_ ? b_ : a_; K[23] = g_ ? a_ : b_; }
  { const float a_ = K[24], b_ = K[25]; const bool g_ = a_ > b_; K[24] = g_ ? a_ : b_; K[25] = g_ ? b_ : a_; }
  { const float a_ = K[26], b_ = K[27]; const bool g_ = a_ > b_; K[26] = g_ ? b_ : a_; K[27] = g_ ? a_ : b_; }
  { const float a_ = K[28], b_ = K[29]; const bool g_ = a_ > b_; K[28] = g_ ? a_ : b_; K[29] = g_ ? b_ : a_; }
  { const float a_ = K[30], b_ = K[31]; const bool g_ = a_ > b_; K[30] = g_ ? b_ : a_; K[31] = g_ ? a_ : b_; }
  { const float a_ = K[16], b_ = K[18]; const bool g_ = a_ > b_; K[16] = g_ ? a_ : b_; K[18] = g_ ? b_ : a_; }
  { const float a_ = K[17], b_ = K[19]; const bool g_ = a_ > b_; K[17] = g_ ? a_ : b_; K[19] = g_ ? b_ : a_; }
  { const float a_ = K[20], b_ = K[22]; const bool g_ = a_ > b_; K[20] = g_ ? b_ : a_; K[22] = g_ ? a_ : b_; }
  { const float a_ = K[21], b_ = K[23]; const bool g_ = a_ > b_; K[21] = g_ ? b_ : a_; K[23] = g_ ? a_ : b_; }
  { const float a_ = K[24], b_ = K[26]; const bool g_ = a_ > b_; K[24] = g_ ? a_ : b_; K[26] = g_ ? b_ : a_; }
  { const float a_ = K[25], b_ = K[27]; const bool g_ = a_ > b_; K[25] = g_ ? a_ : b_; K[27] = g_ ? b_ : a_; }
  { const float a_ = K[28], b_ = K[30]; const bool g_ = a_ > b_; K[28] = g_ ? b_ : a_; K[30] = g_ ? a_ : b_; }
  { const float a_ = K[29], b_ = K[31]; const bool g_ = a_ > b_; K[29] = g_ ? b_ : a_; K[31] = g_ ? a_ : b_; }
  { const float a_ = K[16], b_ = K[17]; const bool g_ = a_ > b_; K[16] = g_ ? a_ : b_; K[17] = g_ ? b_ : a_; }
  { const float a_ = K[18], b_ = K[19]; const bool g_ = a_ > b_; K[18] = g_ ? a_ : b_; K[19] = g_ ? b_ : a_; }
  { const float a_ = K[20], b_ = K[21]; const bool g_ = a_ > b_; K[20] = g_ ? b_ : a_; K[21] = g_ ? a_ : b_; }
  { const float a_ = K[22], b_ = K[23]; const bool g_ = a_ > b_; K[22] = g_ ? b_ : a_; K[23] = g_ ? a_ : b_; }
  { const float a_ = K[24], b_ = K[25]; const bool g_ = a_ > b_; K[24] = g_ ? a_ : b_; K[25] = g_ ? b_ : a_; }
  { const float a_ = K[26], b_ = K[27]; const bool g_ = a_ > b_; K[26] = g_ ? a_ : b_; K[27] = g_ ? b_ : a_; }
  { const float a_ = K[28], b_ = K[29]; const bool g_ = a_ > b_; K[28] = g_ ? b_ : a_; K[29] = g_ ? a_ : b_; }
  { const float a_ = K[30], b_ = K[31]; const bool g_ = a_ > b_; K[30] = g_ ? b_ : a_; K[31] = g_ ? a_ : b_; }
  { const float a_ = K[16], b_ = K[20]; const bool g_ = a_ > b_; K[16] = g_ ? a_ : b_; K[20] = g_ ? b_ : a_; }
  { const float a_ = K[17], b_ = K[21]; const bool g_ = a_ > b_; K[17] = g_ ? a_ : b_; K[21] = g_ ? b_ : a_; }
  { const float a_ = K[18], b_ = K[22]; const bool g_ = a_ > b_; K[18] = g_ ? a_ : b_; K[22] = g_ ? b_ : a_; }
  { const float a_ = K[19], b_ = K[23]; const bool g_ = a_ > b_; K[19] = g_ ? a_ : b_; K[23] = g_ ? b_ : a_; }
  { const float a_ = K[24], b_ = K[28]; const bool g_ = a_ > b_; K[24] = g_ ? b_ : a_; K[28] = g_ ? a_ : b_; }
  { const float a_ = K[25], b_ = K[29]; const bool g_ = a_ > b_; K[25] = g_ ? b_ : a_; K[29] = g_ ? a_ : b_; }
  { const float a_ = K[26], b_ = K[30]; const bool g_ = a_ > b_; K[26] = g_ ? b_ : a_; K[30] = g_ ? a_ : b_; }
  { const float a_ = K[27], b_ = K[31]; const bool g_ = a_ > b_; K[27] = g_ ? b_ : a_; K[31] = g_ ? a_ : b_; }
  { const float a_ = K[16], b_ = K[18]; const bool g_ = a_ > b_; K[16] = g_ ? a_ : b_; K[18] = g_ ? b_ : a_; }
  { const float a_ = K[17], b_ = K[19]; const bool g_ = a_ > b_; K[17] = g_ ? a_ : b_; K[19] = g_ ? b_ : a_; }
  { const float a_ = K[20], b_ = K[22]; const bool g_ = a_ > b_; K[20] = g_ ? a_ : b_; K[22] = g_ ? b_ : a_; }
  { const float a_ = K[21], b_ = K[23]; const bool g_ = a_ > b_; K[21] = g_ ? a_ : b_; K[23] = g_ ? b_ : a_; }
  { const float a_ = K[24], b_ = K[26]; const bool g_ = a_ > b_; K[24] = g_ ? b_ : a_; K[26] = g_ ? a_ : b_; }
  { const float a_ = K[25], b_ = K[27]; const bool g_ = a_ > b_; K[25] = g_ ? b_ : a_; K[27] = g_ ? a_ : b_; }
  { const float a_ = K[28], b_ = K[30]; const bool g_ = a_ > b_; K[28] = g_ ? b_ : a_; K[30] = g_ ? a_ : b_; }
  { const float a_ = K[29], b_ = K[31]; const bool g_ = a_ > b_; K[29] = g_ ? b_ : a_; K[31] = g_ ? a_ : b_; }
  { const float a_ = K[16], b_ = K[17]; const bool g_ = a_ > b_; K[16] = g_ ? a_ : b_; K[17] = g_ ? b_ : a_; }
  { const float a_ = K[18], b_ = K[19]; const bool g_ = a_ > b_; K[18] = g_ ? a_ : b_; K[19] = g_ ? b_ : a_; }
  { const float a_ = K[20], b_ = K[21]; const bool g_ = a_ > b_; K[20] = g_ ? a_ : b_; K[21] = g_ ? b_ : a_; }
  { const float a_ = K[22], b_ = K[23]; const bool g_ = a_ > b_; K[22] = g_ ? a_ : b_; K[23] = g_ ? b_ : a_; }
  { const float a_ = K[24], b_ = K[25]; const bool g_ = a_ > b_; K[24] = g_ ? b_ : a_; K[25] = g_ ? a_ : b_; }
  { const float a_ = K[26], b_ = K[27]; const bool g_ = a_ > b_; K[26] = g_ ? b_ : a_; K[27] = g_ ? a_ : b_; }
  { const float a_ = K[28], b_ = K[29]; const bool g_ = a_ > b_; K[28] = g_ ? b_ : a_; K[29] = g_ ? a_ : b_; }
  { const float a_ = K[30], b_ = K[31]; const bool g_ = a_ > b_; K[30] = g_ ? b_ : a_; K[31] = g_ ? a_ : b_; }
  { const float a_ = K[16], b_ = K[24]; const bool g_ = a_ > b_; K[16] = g_ ? a_ : b_; K[24] = g_ ? b_ : a_; }
  { const float a_ = K[17], b_ = K[25]; const bool g_ = a_ > b_; K[17] = g_ ? a_ : b_; K[25] = g_ ? b_ : a_; }
  { const float a_ = K[18], b_ = K[26]; const bool g_ = a_ > b_; K[18] = g_ ? a_ : b_; K[26] = g_ ? b_ : a_; }
  { const float a_ = K[19], b_ = K[27]; const bool g_ = a_ > b_; K[19] = g_ ? a_ : b_; K[27] = g_ ? b_ : a_; }
  { const float a_ = K[20], b_ = K[28]; const bool g_ = a_ > b_; K[20] = g_ ? a_ : b_; K[28] = g_ ? b_ : a_; }
  { const float a_ = K[21], b_ = K[29]; const bool g_ = a_ > b_; K[21] = g_ ? a_ : b_; K[29] = g_ ? b_ : a_; }
  { const float a_ = K[22], b_ = K[30]; const bool g_ = a_ > b_; K[22] = g_ ? a_ : b_; K[30] = g_ ? b_ : a_; }
  { const float a_ = K[23], b_ = K[31]; const bool g_ = a_ > b_; K[23] = g_ ? a_ : b_; K[31] = g_ ? b_ : a_; }
  { const float a_ = K[16], b_ = K[20]; const bool g_ = a_ > b_; K[16] = g_ ? a_ : b_; K[20] = g_ ? b_ : a_; }
  { const float a_ = K[17], b_ = K[21]; const bool g_ = a_ > b_; K[17] = g_ ? a_ : b_; K[21] = g_ ? b_ : a_; }
  { const float a_ = K[18], b_ = K[22]; const bool g_ = a_ > b_; K[18] = g_ ? a_ : b_; K[22] = g_ ? b_ : a_; }
  { const float a_ = K[19], b_ = K[23]; const bool g_ = a_ > b_; K[19] = g_ ? a_ : b_; K[23] = g_ ? b_ : a_; }
  { const float a_ = K[24], b_ = K[28]; const bool g_ = a_ > b_; K[24] = g_ ? a_ : b_; K[28] = g_ ? b_ : a_; }
  { const float a_ = K[25], b_ = K[29]; const bool g_ = a_ > b_; K[25] = g_ ? a_ : b_; K[29] = g_ ? b_ : a_; }
  { const float a_ = K[26], b_ = K[30]; const bool g_ = a_ > b_; K[26] = g_ ? a_ : b_; K[30] = g_ ? b_ : a_; }
  { const float a_ = K[27], b_ = K[31]; const bool g_ = a_ > b_; K[27] = g_ ? a_ : b_; K[31] = g_ ? b_ : a_; }
  { const float a_ = K[16], b_ = K[18]; const bool g_ = a_ > b_; K[16] = g_ ? a_ : b_; K[18] = g_ ? b_ : a_; }
  { const float a_ = K[17], b_ = K[19]; const bool g_ = a_ > b_; K[17] = g_ ? a_ : b_; K[19] = g_ ? b_ : a_; }
  { const float a_ = K[20], b_ = K[22]; const bool g_ = a_ > b_; K[20] = g_ ? a_ : b_; K[22] = g_ ? b_ : a_; }
  { const float a_ = K[21], b_ = K[23]; const bool g_ = a_ > b_; K[21] = g_ ? a_ : b_; K[23] = g_ ? b_ : a_; }
  { const float a_ = K[24], b_ = K[26]; const bool g_ = a_ > b_; K[24] = g_ ? a_ : b_; K[26] = g_ ? b_ : a_; }
  { const float a_ = K[25], b_ = K[27]; const bool g_ = a_ > b_; K[25] = g_ ? a_ : b_; K[27] = g_ ? b_ : a_; }
  { const float a_ = K[28], b_ = K[30]; const bool g_ = a_ > b_; K[28] = g_ ? a_ : b_; K[30] = g_ ? b_ : a_; }
  { const float a_ = K[29], b_ = K[31]; const bool g_ = a_ > b_; K[29] = g_ ? a_ : b_; K[31] = g_ ? b_ : a_; }
  { const float a_ = K[16], b_ = K[17]; const bool g_ = a_ > b_; K[16] = g_ ? a_ : b_; K[17] = g_ ? b_ : a_; }
  { const float a_ = K[18], b_ = K[19]; const bool g_ = a_ > b_; K[18] = g_ ? a_ : b_; K[19] = g_ ? b_ : a_; }
  { const float a_ = K[20], b_ = K[21]; const bool g_ = a_ > b_; K[20] = g_ ? a_ : b_; K[21] = g_ ? b_ : a_; }
  { const float a_ = K[22], b_ = K[23]; const bool g_ = a_ > b_; K[22] = g_ ? a_ : b_; K[23] = g_ ? b_ : a_; }
  { const float a_ = K[24], b_ = K[25]; const bool g_ = a_ > b_; K[24] = g_ ? a_ : b_; K[25] = g_ ? b_ : a_; }
  { const float a_ = K[26], b_ = K[27]; const bool g_ = a_ > b_; K[26] = g_ ? a_ : b_; K[27] = g_ ? b_ : a_; }
  { const float a_ = K[28], b_ = K[29]; const bool g_ = a_ > b_; K[28] = g_ ? a_ : b_; K[29] = g_ ? b_ : a_; }
  { const float a_ = K[30], b_ = K[31]; const bool g_ = a_ > b_; K[30] = g_ ? a_ : b_; K[31] = g_ ? b_ : a_; }
  { const float a_ = K[32], b_ = K[33]; const bool g_ = a_ > b_; K[32] = g_ ? a_ : b_; K[33] = g_ ? b_ : a_; }
  { const float a_ = K[34], b_ = K[35]; const bool g_ = a_ > b_; K[34] = g_ ? b_ : a_; K[35] = g_ ? a_ : b_; }
  { const float a_ = K[36], b_ = K[37]; const bool g_ = a_ > b_; K[36] = g_ ? a_ : b_; K[37] = g_ ? b_ : a_; }
  { const float a_ = K[38], b_ = K[39]; const bool g_ = a_ > b_; K[38] = g_ ? b_ : a_; K[39] = g_ ? a_ : b_; }
  { const float a_ = K[40], b_ = K[41]; const bool g_ = a_ > b_; K[40] = g_ ? a_ : b_; K[41] = g_ ? b_ : a_; }
  { const float a_ = K[42], b_ = K[43]; const bool g_ = a_ > b_; K[42] = g_ ? b_ : a_; K[43] = g_ ? a_ : b_; }
  { const float a_ = K[44], b_ = K[45]; const bool g_ = a_ > b_; K[44] = g_ ? a_ : b_; K[45] = g_ ? b_ : a_; }
  { const float a_ = K[46], b_ = K[47]; const bool g_ = a_ > b_; K[46] = g_ ? b_ : a_; K[47] = g_ ? a_ : b_; }
  { const float a_ = K[32], b_ = K[34]; const bool g_ = a_ > b_; K[32] = g_ ? a_ : b_; K[34] = g_ ? b_ : a_; }
  { const float a_ = K[33], b_ = K[35]; const bool g_ = a_ > b_; K[33] = g_ ? a_ : b_; K[35] = g_ ? b_ : a_; }
  { const float a_ = K[36], b_ = K[38]; const bool g_ = a_ > b_; K[36] = g_ ? b_ : a_; K[38] = g_ ? a_ : b_; }
  { const float a_ = K[37], b_ = K[39]; const bool g_ = a_ > b_; K[37] = g_ ? b_ : a_; K[39] = g_ ? a_ : b_; }
  { const float a_ = K[40], b_ = K[42]; const bool g_ = a_ > b_; K[40] = g_ ? a_ : b_; K[42] = g_ ? b_ : a_; }
  { const float a_ = K[41], b_ = K[43]; const bool g_ = a_ > b_; K[41] = g_ ? a_ : b_; K[43] = g_ ? b_ : a_; }
  { const float a_ = K[44], b_ = K[46]; const bool g_ = a_ > b_; K[44] = g_ ? b_ : a_; K[46] = g_ ? a_ : b_; }
  { const float a_ = K[45], b_ = K[47]; const bool g_ = a_ > b_; K[45] = g_ ? b_ : a_; K[47] = g_ ? a_ : b_; }
  { const float a_ = K[32], b_ = K[33]; const bool g_ = a_ > b_; K[32] = g_ ? a_ : b_; K[33] = g_ ? b_ : a_; }
  { const float a_ = K[34], b_ = K[35]; const bool g_ = a_ > b_; K[34] = g_ ? a_ : b_; K[35] = g_ ? b_ : a_; }
  { const float a_ = K[36], b_ = K[37]; const bool g_ = a_ > b_; K[36] = g_ ? b_ : a_; K[37] = g_ ? a_ : b_; }
  { const float a_ = K[38], b_ = K[39]; const bool g_ = a_ > b_; K[38] = g_ ? b_ : a_; K[39] = g_ ? a_ : b_; }
  { const float a_ = K[40], b_ = K[41]; const bool g_ = a_ > b_; K[40] = g_ ? a_ : b_; K[41] = g_ ? b_ : a_; }
  { const float a_ = K[42], b_ = K[43]; const bool g_ = a_ > b_; K[42] = g_ ? a_ : b_; K[43] = g_ ? b_ : a_; }
  { const float a_ = K[44], b_ = K[45]; const bool g_ = a_ > b_; K[44] = g_ ? b_ : a_; K[45] = g_ ? a_ : b_; }
  { const float a_ = K[46], b_ = K[47]; const bool g_ = a_ > b_; K[46] = g_ ? b_ : a_; K[47] = g_ ? a_ : b_; }
  { const float a_ = K[32], b_ = K[36]; const bool g_ = a_ > b_; K[32] = g_ ? a_ : b_; K[36] = g_ ? b_ : a_; }
  { const float a_ = K[33], b_ = K[37]; const bool g_ = a_ > b_; K[33] = g_ ? a_ : b_; K[37] = g_ ? b_ : a_; }
  { const float a_ = K[34], b_ = K[38]; const bool g_ = a_ > b_; K[34] = g_ ? a_ : b_; K[38] = g_ ? b_ : a_; }
  { const float a_ = K[35], b_ = K[39]; const bool g_ = a_ > b_; K[35] = g_ ? a_ : b_; K[39] = g_ ? b_ : a_; }
  { const float a_ = K[40], b_ = K[44]; const bool g_ = a_ > b_; K[40] = g_ ? b_ : a_; K[44] = g_ ? a_ : b_; }
  { const float a_ = K[41], b_ = K[45]; const bool g_ = a_ > b_; K[41] = g_ ? b_ : a_; K[45] = g_ ? a_ : b_; }
  { const float a_ = K[42], b_ = K[46]; const bool g_ = a_ > b_; K[42] = g_ ? b_ : a_; K[46] = g_ ? a_ : b_; }
  { const float a_ = K[43], b_ = K[47]; const bool g_ = a_ > b_; K[43] = g_ ? b_ : a_; K[47] = g_ ? a_ : b_; }
  { const float a_ = K[32], b_ = K[34]; const bool g_ = a_ > b_; K[32] = g_ ? a_ : b_; K[34] = g_ ? b_ : a_; }
  { const float a_ = K[33], b_ = K[35]; const bool g_ = a_ > b_; K[33] = g_ ? a_ : b_; K[35] = g_ ? b_ : a_; }
  { const float a_ = K[36], b_ = K[38]; const bool g_ = a_ > b_; K[36] = g_ ? a_ : b_; K[38] = g_ ? b_ : a_; }
  { const float a_ = K[37], b_ = K[39]; const bool g_ = a_ > b_; K[37] = g_ ? a_ : b_; K[39] = g_ ? b_ : a_; }
  { const float a_ = K[40], b_ = K[42]; const bool g_ = a_ > b_; K[40] = g_ ? b_ : a_; K[42] = g_ ? a_ : b_; }
  { const float a_ = K[41], b_ = K[43]; const bool g_ = a_ > b_; K[41] = g_ ? b_ : a_; K[43] = g_ ? a_ : b_; }
  { const float a_ = K[44], b_ = K[46]; const bool g_ = a_ > b_; K[44] = g_ ? b_ : a_; K[46] = g_ ? a_ : b_; }
  { const float a_ = K[45], b_ = K[47]; const bool g_ = a_ > b_; K[45] = g_ ? b_ : a_; K[47] = g_ ? a_ : b_; }
  { const float a_ = K[32], b_ = K[33]; const bool g_ = a_ > b_; K[32] = g_ ? a_ : b_; K[33] = g_ ? b_ : a_; }
  { const float a_ = K[34], b_ = K[35]; const bool g_ = a_ > b_; K[34] = g_ ? a_ : b_; K[35] = g_ ? b_ : a_; }
  { const float a_ = K[36], b_ = K[37]; const bool g_ = a_ > b_; K[36] = g_ ? a_ : b_; K[37] = g_ ? b_ : a_; }
  { const float a_ = K[38], b_ = K[39]; const bool g_ = a_ > b_; K[38] = g_ ? a_ : b_; K[39] = g_ ? b_ : a_; }
  { const float a_ = K[40], b_ = K[41]; const bool g_ = a_ > b_; K[40] = g_ ? b_ : a_; K[41] = g_ ? a_ : b_; }
  { const float a_ = K[42], b_ = K[43]; const bool g_ = a_ > b_; K[42] = g_ ? b_ : a_; K[43] = g_ ? a_ : b_; }
  { const float a_ = K[44], b_ = K[45]; const bool g_ = a_ > b_; K[44] = g_ ? b_ : a_; K[45] = g_ ? a_ : b_; }
  { const float a_ = K[46], b_ = K[47]; const bool g_ = a_ > b_; K[46] = g_ ? b_ : a_; K[47] = g_ ? a_ : b_; }
  { const float a_ = K[32], b_ = K[40]; const bool g_ = a_ > b_; K[32] = g_ ? a_ : b_; K[40] = g_ ? b_ : a_; }
  { const float a_ = K[33], b_ = K[41]; const bool g_ = a_ > b_; K[33] = g_ ? a_ : b_; K[41] = g_ ? b_ : a_; }
  { const float a_ = K[34], b_ = K[42]; const bool g_ = a_ > b_; K[34] = g_ ? a_ : b_; K[42] = g_ ? b_ : a_; }
  { const float a_ = K[35], b_ = K[43]; const bool g_ = a_ > b_; K[35] = g_ ? a_ : b_; K[43] = g_ ? b_ : a_; }
  { const float a_ = K[36], b_ = K[44]; const bool g_ = a_ > b_; K[36] = g_ ? a_ : b_; K[44] = g_ ? b_ : a_; }
  { const float a_ = K[37], b_ = K[45]; const bool g_ = a_ > b_; K[37] = g_ ? a_ : b_; K[45] = g_ ? b_ : a_; }
  { const float a_ = K[38], b_ = K[46]; const bool g_ = a_ > b_; K[38] = g_ ? a_ : b_; K[46] = g_ ? b_ : a_; }
  { const float a_ = K[39], b_ = K[47]; const bool g_ = a_ > b_; K[39] = g_ ? a_ : b_; K[47] = g_ ? b_ : a_; }
  { const float a_ = K[32], b_ = K[36]; const bool g_ = a_ > b_; K[32] = g_ ? a_ : b_; K[36] = g_ ? b_ : a_; }
  { const float a_ = K[33], b_ = K[37]; const bool g_ = a_ > b_; K[33] = g_ ? a_ : b_; K[37] = g_ ? b_ : a_; }
  { const float a_ = K[34], b_ = K[38]; const bool g_ = a_ > b_; K[34] = g_ ? a_ : b_; K[38] = g_ ? b_ : a_; }
  { const float a_ = K[35], b_ = K[39]; const bool g_ = a_ > b_; K[35] = g_ ? a_ : b_; K[39] = g_ ? b_ : a_; }
  { const float a_ = K[40], b_ = K[44]; const bool g_ = a_ > b_; K[40] = g_ ? a_ : b_; K[44] = g_ ? b_ : a_; }
  { const float a_ = K[41], b_ = K[45]; const bool g_ = a_ > b_; K[41] = g_ ? a_ : b_; K[45] = g_ ? b_ : a_; }
  { const float a_ = K[42], b_ = K[46]; const bool g_ = a_ > b_; K[42] = g_ ? a_ : b_; K[46] = g_ ? b_ : a_; }
  { const float a_ = K[43], b_ = K[47]; const bool g_ = a_ > b_; K[43] = g_ ? a_ : b_; K[47] = g_ ? b_ : a_; }
  { const float a_ = K[32], b_ = K[34]; const bool g_ = a_ > b_; K[32] = g_ ? a_ : b_; K[34] = g_ ? b_ : a_; }
  { const float a_ = K[33], b_ = K[35]; const bool g_ = a_ > b_; K[33] = g_ ? a_ : b_; K[35] = g_ ? b_ : a_; }
  { const float a_ = K[36], b_ = K[38]; const bool g_ = a_ > b_; K[36] = g_ ? a_ : b_; K[38] = g_ ? b_ : a_; }
  { const float a_ = K[37], b_ = K[39]; const bool g_ = a_ > b_; K[37] = g_ ? a_ : b_; K[39] = g_ ? b_ : a_; }
  { const float a_ = K[40], b_ = K[42]; const bool g_ = a_ > b_; K[40] = g_ ? a_ : b_; K[42] = g_ ? b_ : a_; }
  { const float a_ = K[41], b_ = K[43]; const bool g_ = a_ > b_; K[41] = g_ ? a_ : b_; K[43] = g_ ? b_ : a_; }
  { const float a_ = K[44], b_ = K[46]; const bool g_ = a_ > b_; K[44] = g_ ? a_ : b_; K[46] = g_ ? b_ : a_; }
  { const float a_ = K[45], b_ = K[47]; const bool g_ = a_ > b_; K[45] = g_ ? a_ : b_; K[47] = g_ ? b_ : a_; }
  { const float a_ = K[32], b_ = K[33]; const bool g_ = a_ > b_; K[32] = g_ ? a_ : b_; K[33] = g_ ? b_ : a_; }
  { const float a_ = K[34], b_ = K[35]; const bool g_ = a_ > b_; K[34] = g_ ? a_ : b_; K[35] = g_ ? b_ : a_; }
  { const float a_ = K[36], b_ = K[37]; const bool g_ = a_ > b_; K[36] = g_ ? a_ : b_; K[37] = g_ ? b_ : a_; }
  { const float a_ = K[38], b_ = K[39]; const bool g_ = a_ > b_; K[38] = g_ ? a_ : b_; K[39] = g_ ? b_ : a_; }
  { const float a_ = K[40], b_ = K[41]; const bool g_ = a_ > b_; K[40] = g_ ? a_ : b_; K[41] = g_ ? b_ : a_; }
  { const float a_ = K[42], b_ = K[43]; const bool g_ = a_ > b_; K[42] = g_ ? a_ : b_; K[43] = g_ ? b_ : a_; }
  { const float a_ = K[44], b_ = K[45]; const bool g_ = a_ > b_; K[44] = g_ ? a_ : b_; K[45] = g_ ? b_ : a_; }
  { const float a_ = K[46], b_ = K[47]; const bool g_ = a_ > b_; K[46] = g_ ? a_ : b_; K[47] = g_ ? b_ : a_; }
  { const float a_ = K[48], b_ = K[49]; const bool g_ = a_ > b_; K[48] = g_ ? a_ : b_; K[49] = g_ ? b_ : a_; }
  { const float a_ = K[50], b_ = K[51]; const bool g_ = a_ > b_; K[50] = g_ ? b_ : a_; K[51] = g_ ? a_ : b_; }
  { const float a_ = K[52], b_ = K[53]; const bool g_ = a_ > b_; K[52] = g_ ? a_ : b_; K[53] = g_ ? b_ : a_; }
  { const float a_ = K[54], b_ = K[55]; const bool g_ = a_ > b_; K[54] = g_ ? b_ : a_; K[55] = g_ ? a_ : b_; }
  { const float a_ = K[56], b_ = K[57]; const bool g_ = a_ > b_; K[56] = g_ ? a_ : b_; K[57] = g_ ? b_ : a_; }
  { const float a_ = K[58], b_ = K[59]; const bool g_ = a_ > b_; K[58] = g_ ? b_ : a_; K[59] = g_ ? a_ : b_; }
  { const float a_ = K[60], b_ = K[61]; const bool g_ = a_ > b_; K[60] = g_ ? a_ : b_; K[61] = g_ ? b_ : a_; }
  { const float a_ = K[62], b_ = K[63]; const bool g_ = a_ > b_; K[62] = g_ ? b_ : a_; K[63] = g_ ? a_ : b_; }
  { const float a_ = K[48], b_ = K[50]; const bool g_ = a_ > b_; K[48] = g_ ? a_ : b_; K[50] = g_ ? b_ : a_; }
  { const float a_ = K[49], b_ = K[51]; const bool g_ = a_ > b_; K[49] = g_ ? a_ : b_; K[51] = g_ ? b_ : a_; }
  { const float a_ = K[52], b_ = K[54]; const bool g_ = a_ > b_; K[52] = g_ ? b_ : a_; K[54] = g_ ? a_ : b_; }
  { const float a_ = K[53], b_ = K[55]; const bool g_ = a_ > b_; K[53] = g_ ? b_ : a_; K[55] = g_ ? a_ : b_; }
  { const float a_ = K[56], b_ = K[58]; const bool g_ = a_ > b_; K[56] = g_ ? a_ : b_; K[58] = g_ ? b_ : a_; }
  { const float a_ = K[57], b_ = K[59]; const bool g_ = a_ > b_; K[57] = g_ ? a_ : b_; K[59] = g_ ? b_ : a_; }
  { const float a_ = K[60], b_ = K[62]; const bool g_ = a_ > b_; K[60] = g_ ? b_ : a_; K[62] = g_ ? a_ : b_; }
  { const float a_ = K[61], b_ = K[63]; const bool g_ = a_ > b_; K[61] = g_ ? b_ : a_; K[63] = g_ ? a_ : b_; }
  { const float a_ = K[48], b_ = K[49]; const bool g_ = a_ > b_; K[48] = g_ ? a_ : b_; K[49] = g_ ? b_ : a_; }
  { const float a_ = K[50], b_ = K[51]; const bool g_ = a_ > b_; K[50] = g_ ? a_ : b_; K[51] = g_ ? b_ : a_; }
  { const float a_ = K[52], b_ = K[53]; const bool g_ = a_ > b_; K[52] = g_ ? b_ : a_; K[53] = g_ ? a_ : b_; }
  { const float a_ = K[54], b_ = K[55]; const bool g_ = a_ > b_; K[54] = g_ ? b_ : a_; K[55] = g_ ? a_ : b_; }
  { const float a_ = K[56], b_ = K[57]; const bool g_ = a_ > b_; K[56] = g_ ? a_ : b_; K[57] = g_ ? b_ : a_; }
  { const float a_ = K[58], b_ = K[59]; const bool g_ = a_ > b_; K[58] = g_ ? a_ : b_; K[59] = g_ ? b_ : a_; }
  { const float a_ = K[60], b_ = K[61]; const bool g_ = a_ > b_; K[60] = g_ ? b_ : a_; K[61] = g_ ? a_ : b_; }
  { const float a_ = K[62], b_ = K[63]; const bool g_ = a_ > b_; K[62] = g_ ? b_ : a_; K[63] = g_ ? a_ : b_; }
  { const float a_ = K[48], b_ = K[52]; const bool g_ = a_ > b_; K[48] = g_ ? a_ : b_; K[52] = g_ ? b_ : a_; }
  { const float a_ = K[49], b_ = K[53]; const bool g_ = a_ > b_; K[49] = g_ ? a_ : b_; K[53] = g_ ? b_ : a_; }
  { const float a_ = K[50], b_ = K[54]; const bool g_ = a_ > b_; K[50] = g_ ? a_ : b_; K[54] = g_ ? b_ : a_; }
  { const float a_ = K[51], b_ = K[55]; const bool g_ = a_ > b_; K[51] = g_ ? a_ : b_; K[55] = g_ ? b_ : a_; }
  { const float a_ = K[56], b_ = K[60]; const bool g_ = a_ > b_; K[56] = g_ ? b_ : a_; K[60] = g_ ? a_ : b_; }
  { const float a_ = K[57], b_ = K[61]; const bool g_ = a_ > b_; K[57] = g_ ? b_ : a_; K[61] = g_ ? a_ : b_; }
  { const float a_ = K[58], b_ = K[62]; const bool g_ = a_ > b_; K[58] = g_ ? b_ : a_; K[62] = g_ ? a_ : b_; }
  { const float a_ = K[59], b_ = K[63]; const bool g_ = a_ > b_; K[59] = g_ ? b_ : a_; K[63] = g_ ? a_ : b_; }
  { const float a_ = K[48], b_ = K[50]; const bool g_ = a_ > b_; K[48] = g_ ? a_ : b_; K[50] = g_ ? b_ : a_; }
  { const float a_ = K[49], b_ = K[51]; const bool g_ = a_ > b_; K[49] = g_ ? a_ : b_; K[51] = g_ ? b_ : a_; }
  { const float a_ = K[52], b_ = K[54]; const bool g_ = a_ > b_; K[52] = g_ ? a_ : b_; K[54] = g_ ? b_ : a_; }
  { const float a_ = K[53], b_ = K[55]; const bool g_ = a_ > b_; K[53] = g_ ? a_ : b_; K[55] = g_ ? b_ : a_; }
  { const float a_ = K[56], b_ = K[58]; const bool g_ = a_ > b_; K[56] = g_ ? b_ : a_; K[58] = g_ ? a_ : b_; }
  { const float a_ = K[57], b_ = K[59]; const bool g_ = a_ > b_; K[57] = g_ ? b_ : a_; K[59] = g_ ? a_ : b_; }
  { const float a_ = K[60], b_ = K[62]; const bool g_ = a_ > b_; K[60] = g_ ? b_ : a_; K[62] = g_ ? a_ : b_; }
  { const float a_ = K[61], b_ = K[63]; const bool g_ = a_ > b_; K[61] = g_ ? b_ : a_; K[63] = g_ ? a_ : b_; }
  { const float a_ = K[48], b_ = K[49]; const bool g_ = a_ > b_; K[48] = g_ ? a_ : b_; K[49] = g_ ? b_ : a_; }
  { const float a_ = K[50], b_ = K[51]; const bool g_ = a_ > b_; K[50] = g_ ? a_ : b_; K[51] = g_ ? b_ : a_; }
  { const float a_ = K[52], b_ = K[53]; const bool g_ = a_ > b_; K[52] = g_ ? a_ : b_; K[53] = g_ ? b_ : a_; }
  { const float a_ = K[54], b_ = K[55]; const bool g_ = a_ > b_; K[54] = g_ ? a_ : b_; K[55] = g_ ? b_ : a_; }
  { const float a_ = K[56], b_ = K[57]; const bool g_ = a_ > b_; K[56] = g_ ? b_ : a_; K[57] = g_ ? a_ : b_; }
  { const float a_ = K[58], b_ = K[59]; const bool g_ = a_ > b_; K[58] = g_ ? b_ : a_; K[59] = g_ ? a_ : b_; }
  { const float a_ = K[60], b_ = K[61]; const bool g_ = a_ > b_; K[60] = g_ ? b_ : a_; K[61] = g_ ? a_ : b_; }
  { const float a_ = K[62], b_ = K[63]; const bool g_ = a_ > b_; K[62] = g_ ? b_ : a_; K[63] = g_ ? a_ : b_; }
  { const float a_ = K[48], b_ = K[56]; const bool g_ = a_ > b_; K[48] = g_ ? a_ : b_; K[56] = g_ ? b_ : a_; }
  { const float a_ = K[49], b_ = K[57]; const bool g_ = a_ > b_; K[49] = g_ ? a_ : b_; K[57] = g_ ? b_ : a_; }
  { const float a_ = K[50], b_ = K[58]; const bool g_ = a_ > b_; K[50] = g_ ? a_ : b_; K[58] = g_ ? b_ : a_; }
  { const float a_ = K[51], b_ = K[59]; const bool g_ = a_ > b_; K[51] = g_ ? a_ : b_; K[59] = g_ ? b_ : a_; }
  { const float a_ = K[52], b_ = K[60]; const bool g_ = a_ > b_; K[52] = g_ ? a_ : b_; K[60] = g_ ? b_ : a_; }
  { const float a_ = K[53], b_ = K[61]; const bool g_ = a_ > b_; K[53] = g_ ? a_ : b_; K[61] = g_ ? b_ : a_; }
  { const float a_ = K[54], b_ = K[62]; const bool g_ = a_ > b_; K[54] = g_ ? a_ : b_; K[62] = g_ ? b_ : a_; }
  { const float a_ = K[55], b_ = K[63]; const bool g_ = a_ > b_; K[55] = g_ ? a_ : b_; K[63] = g_ ? b_ : a_; }
  { const float a_ = K[48], b_ = K[52]; const bool g_ = a_ > b_; K[48] = g_ ? a_ : b_; K[52] = g_ ? b_ : a_; }
  { const float a_ = K[49], b_ = K[53]; const bool g_ = a_ > b_; K[49] = g_ ? a_ : b_; K[53] = g_ ? b_ : a_; }
  { const float a_ = K[50], b_ = K[54]; const bool g_ = a_ > b_; K[50] = g_ ? a_ : b_; K[54] = g_ ? b_ : a_; }
  { const float a_ = K[51], b_ = K[55]; const bool g_ = a_ > b_; K[51] = g_ ? a_ : b_; K[55] = g_ ? b_ : a_; }
  { const float a_ = K[56], b_ = K[60]; const bool g_ = a_ > b_; K[56] = g_ ? a_ : b_; K[60] = g_ ? b_ : a_; }
  { const float a_ = K[57], b_ = K[61]; const bool g_ = a_ > b_; K[57] = g_ ? a_ : b_; K[61] = g_ ? b_ : a_; }
  { const float a_ = K[58], b_ = K[62]; const bool g_ = a_ > b_; K[58] = g_ ? a_ : b_; K[62] = g_ ? b_ : a_; }
  { const float a_ = K[59], b_ = K[63]; const bool g_ = a_ > b_; K[59] = g_ ? a_ : b_; K[63] = g_ ? b_ : a_; }
  { const float a_ = K[48], b_ = K[50]; const bool g_ = a_ > b_; K[48] = g_ ? a_ : b_; K[50] = g_ ? b_ : a_; }
  { const float a_ = K[49], b_ = K[51]; const bool g_ = a_ > b_; K[49] = g_ ? a_ : b_; K[51] = g_ ? b_ : a_; }
  { const float a_ = K[52], b_ = K[54]; const bool g_ = a_ > b_; K[52] = g_ ? a_ : b_; K[54] = g_ ? b_ : a_; }
  { const float a_ = K[53], b_ = K[55]; const bool g_ = a_ > b_; K[53] = g_ ? a_ : b_; K[55] = g_ ? b_ : a_; }
  { const float a_ = K[56], b_ = K[58]; const bool g_ = a_ > b_; K[56] = g_ ? a_ : b_; K[58] = g_ ? b_ : a_; }
  { const float a_ = K[57], b_ = K[59]; const bool g_ = a_ > b_; K[57] = g_ ? a_ : b_; K[59] = g_ ? b_ : a_; }
  { const float a_ = K[60], b_ = K[62]; const bool g_ = a_ > b_; K[60] = g_ ? a_ : b_; K[62] = g_ ? b_ : a_; }
  { const float a_ = K[61], b_ = K[63]; const bool g_ = a_ > b_; K[61] = g_ ? a_ : b_; K[63] = g_ ? b_ : a_; }
  { const float a_ = K[48], b_ = K[49]; const bool g_ = a_ > b_; K[48] = g_ ? a_ : b_; K[49] = g_ ? b_ : a_; }
  { const float a_ = K[50], b_ = K[51]; const bool g_ = a_ > b_; K[50] = g_ ? a_ : b_; K[51] = g_ ? b_ : a_; }
  { const float a_ = K[52], b_ = K[53]; const bool g_ = a_ > b_; K[52] = g_ ? a_ : b_; K[53] = g_ ? b_ : a_; }
  { const float a_ = K[54], b_ = K[55]; const bool g_ = a_ > b_; K[54] = g_ ? a_ : b_; K[55] = g_ ? b_ : a_; }
  { const float a_ = K[56], b_ = K[57]; const bool g_ = a_ > b_; K[56] = g_ ? a_ : b_; K[57] = g_ ? b_ : a_; }
  { const float a_ = K[58], b_ = K[59]; const bool g_ = a_ > b_; K[58] = g_ ? a_ : b_; K[59] = g_ ? b_ : a_; }
  { const float a_ = K[60], b_ = K[61]; const bool g_ = a_ > b_; K[60] = g_ ? a_ : b_; K[61] = g_ ? b_ : a_; }
  { const float a_ = K[62], b_ = K[63]; const bool g_ = a_ > b_; K[62] = g_ ? a_ : b_; K[63] = g_ ? b_ : a_; }
  { const float a_ = K[0], b_ = K[31]; K[0] = a_ > b_ ? a_ : b_; }
  { const float a_ = K[1], b_ = K[30]; K[1] = a_ > b_ ? a_ : b_; }
  { const float a_ = K[2], b_ = K[29]; K[2] = a_ > b_ ? a_ : b_; }
  { const float a_ = K[3], b_ = K[28]; K[3] = a_ > b_ ? a_ : b_; }
  { const float a_ = K[4], b_ = K[27]; K[4] = a_ > b_ ? a_ : b_; }
  { const float a_ = K[5], b_ = K[26]; K[5] = a_ > b_ ? a_ : b_; }
  { const float a_ = K[6], b_ = K[25]; K[6] = a_ > b_ ? a_ : b_; }
  { const float a_ = K[7], b_ = K[24]; K[7] = a_ > b_ ? a_ : b_; }
  { const float a_ = K[8], b_ = K[23]; K[8] = a_ > b_ ? a_ : b_; }
  { const float a_ = K[9], b_ = K[22]; K[9] = a_ > b_ ? a_ : b_; }
  { const float a_ = K[10], b_ = K[21]; K[10] = a_ > b_ ? a_ : b_; }
  { const float a_ = K[11], b_ = K[20]; K[11] = a_ > b_ ? a_ : b_; }
  { const float a_ = K[12], b_ = K[19]; K[12] = a_ > b_ ? a_ : b_; }
  { const float a_ = K[13], b_ = K[18]; K[13] = a_ > b_ ? a_ : b_; }
  { const float a_ = K[14], b_ = K[17]; K[14] = a_ > b_ ? a_ : b_; }
  { const float a_ = K[15], b_ = K[16]; K[15] = a_ > b_ ? a_ : b_; }
  { const float a_ = K[0], b_ = K[8]; const bool g_ = a_ > b_; K[0] = g_ ? a_ : b_; K[8] = g_ ? b_ : a_; }
  { const float a_ = K[1], b_ = K[9]; const bool g_ = a_ > b_; K[1] = g_ ? a_ : b_; K[9] = g_ ? b_ : a_; }
  { const float a_ = K[2], b_ = K[10]; const bool g_ = a_ > b_; K[2] = g_ ? a_ : b_; K[10] = g_ ? b_ : a_; }
  { const float a_ = K[3], b_ = K[11]; const bool g_ = a_ > b_; K[3] = g_ ? a_ : b_; K[11] = g_ ? b_ : a_; }
  { const float a_ = K[4], b_ = K[12]; const bool g_ = a_ > b_; K[4] = g_ ? a_ : b_; K[12] = g_ ? b_ : a_; }
  { const float a_ = K[5], b_ = K[13]; const bool g_ = a_ > b_; K[5] = g_ ? a_ : b_; K[13] = g_ ? b_ : a_; }
  { const float a_ = K[6], b_ = K[14]; const bool g_ = a_ > b_; K[6] = g_ ? a_ : b_; K[14] = g_ ? b_ : a_; }
  { const float a_ = K[7], b_ = K[15]; const bool g_ = a_ > b_; K[7] = g_ ? a_ : b_; K[15] = g_ ? b_ : a_; }
  { const float a_ = K[0], b_ = K[4]; const bool g_ = a_ > b_; K[0] = g_ ? a_ : b_; K[4] = g_ ? b_ : a_; }
  { const float a_ = K[1], b_ = K[5]; const bool g_ = a_ > b_; K[1] = g_ ? a_ : b_; K[5] = g_ ? b_ : a_; }
  { const float a_ = K[2], b_ = K[6]; const bool g_ = a_ > b_; K[2] = g_ ? a_ : b_; K[6] = g_ ? b_ : a_; }
  { const float a_ = K[3], b_ = K[7]; const bool g_ = a_ > b_; K[3] = g_ ? a_ : b_; K[7] = g_ ? b_ : a_; }
  { const float a_ = K[8], b_ = K[12]; const bool g_ = a_ > b_; K[8] = g_ ? a_ : b_; K[12] = g_ ? b_ : a_; }
  { const float a_ = K[9], b_ = K[13]; const bool g_ = a_ > b_; K[9] = g_ ? a_ : b_; K[13] = g_ ? b_ : a_; }
  { const float a_ = K[10], b_ = K[14]; const bool g_ = a_ > b_; K[10] = g_ ? a_ : b_; K[14] = g_ ? b_ : a_; }
  { const float a_ = K[11], b_ = K[15]; const bool g_ = a_ > b_; K[11] = g_ ? a_ : b_; K[15] = g_ ? b_ : a_; }
  { const float a_ = K[0], b_ = K[2]; const bool g_ = a_ > b_; K[0] = g_ ? a_ : b_; K[2] = g_ ? b_ : a_; }
  { const float a_ = K[1], b_ = K[3]; const bool g_ = a_ > b_; K[1] = g_ ? a_ : b_; K[3] = g_ ? b_ : a_; }
  { const float a_ = K[4], b_ = K[6]; const bool g_ = a_ > b_; K[4] = g_ ? a_ : b_; K[6] = g_ ? b_ : a_; }
  { const float a_ = K[5], b_ = K[7]; const bool g_ = a_ > b_; K[5] = g_ ? a_ : b_; K[7] = g_ ? b_ : a_; }
  { const float a_ = K[8], b_ = K[10]; const bool g_ = a_ > b_; K[8] = g_ ? a_ : b_; K[10] = g_ ? b_ : a_; }
  { const float a_ = K[9], b_ = K[11]; const bool g_ = a_ > b_; K[9] = g_ ? a_ : b_; K[11] = g_ ? b_ : a_; }
  { const float a_ = K[12], b_ = K[14]; const bool g_ = a_ > b_; K[12] = g_ ? a_ : b_; K[14] = g_ ? b_ : a_; }
  { const float a_ = K[13], b_ = K[15]; const bool g_ = a_ > b_; K[13] = g_ ? a_ : b_; K[15] = g_ ? b_ : a_; }
  { const float a_ = K[0], b_ = K[1]; const bool g_ = a_ > b_; K[0] = g_ ? a_ : b_; K[1] = g_ ? b_ : a_; }
  { const float a_ = K[2], b_ = K[3]; const bool g_ = a_ > b_; K[2] = g_ ? a_ : b_; K[3] = g_ ? b_ : a_; }
  { const float a_ = K[4], b_ = K[5]; const bool g_ = a_ > b_; K[4] = g_ ? a_ : b_; K[5] = g_ ? b_ : a_; }
  { const float a_ = K[6], b_ = K[7]; const bool g_ = a_ > b_; K[6] = g_ ? a_ : b_; K[7] = g_ ? b_ : a_; }
  { const float a_ = K[8], b_ = K[9]; const bool g_ = a_ > b_; K[8] = g_ ? a_ : b_; K[9] = g_ ? b_ : a_; }
  { const float a_ = K[10], b_ = K[11]; const bool g_ = a_ > b_; K[10] = g_ ? a_ : b_; K[11] = g_ ? b_ : a_; }
  { const float a_ = K[12], b_ = K[13]; const bool g_ = a_ > b_; K[12] = g_ ? a_ : b_; K[13] = g_ ? b_ : a_; }
  { const float a_ = K[14], b_ = K[15]; const bool g_ = a_ > b_; K[14] = g_ ? a_ : b_; K[15] = g_ ? b_ : a_; }
  { const float a_ = K[32], b_ = K[63]; K[32] = a_ > b_ ? a_ : b_; }
  { const float a_ = K[33], b_ = K[62]; K[33] = a_ > b_ ? a_ : b_; }
  { const float a_ = K[34], b_ = K[61]; K[34] = a_ > b_ ? a_ : b_; }
  { const float a_ = K[35], b_ = K[60]; K[35] = a_ > b_ ? a_ : b_; }
  { const float a_ = K[36], b_ = K[59]; K[36] = a_ > b_ ? a_ : b_; }
  { const float a_ = K[37], b_ = K[58]; K[37] = a_ > b_ ? a_ : b_; }
  { const float a_ = K[38], b_ = K[57]; K[38] = a_ > b_ ? a_ : b_; }
  { const float a_ = K[39], b_ = K[56]; K[39] = a_ > b_ ? a_ : b_; }
  { const float a_ = K[40], b_ = K[55]; K[40] = a_ > b_ ? a_ : b_; }
  { const float a_ = K[41], b_ = K[54]; K[41] = a_ > b_ ? a_ : b_; }
  { const float a_ = K[42], b_ = K[53]; K[42] = a_ > b_ ? a_ : b_; }
  { const float a_ = K[43], b_ = K[52]; K[43] = a_ > b_ ? a_ : b_; }
  { const float a_ = K[44], b_ = K[51]; K[44] = a_ > b_ ? a_ : b_; }
  { const float a_ = K[45], b_ = K[50]; K[45] = a_ > b_ ? a_ : b_; }
  { const float a_ = K[46], b_ = K[49]; K[46] = a_ > b_ ? a_ : b_; }
  { const float a_ = K[47], b_ = K[48]; K[47] = a_ > b_ ? a_ : b_; }
  { const float a_ = K[32], b_ = K[40]; const bool g_ = a_ > b_; K[32] = g_ ? a_ : b_; K[40] = g_ ? b_ : a_; }
  { const float a_ = K[33], b_ = K[41]; const bool g_ = a_ > b_; K[33] = g_ ? a_ : b_; K[41] = g_ ? b_ : a_; }
  { const float a_ = K[34], b_ = K[42]; const bool g_ = a_ > b_; K[34] = g_ ? a_ : b_; K[42] = g_ ? b_ : a_; }
  { const float a_ = K[35], b_ = K[43]; const bool g_ = a_ > b_; K[35] = g_ ? a_ : b_; K[43] = g_ ? b_ : a_; }
  { const float a_ = K[36], b_ = K[44]; const bool g_ = a_ > b_; K[36] = g_ ? a_ : b_; K[44] = g_ ? b_ : a_; }
  { const float a_ = K[37], b_ = K[45]; const bool g_ = a_ > b_; K[37] = g_ ? a_ : b_; K[45] = g_ ? b_ : a_; }
  { const float a_ = K[38], b_ = K[46]; const bool g_ = a_ > b_; K[38] = g_ ? a_ : b_; K[46] = g_ ? b_ : a_; }
  { const float a_ = K[39], b_ = K[47]; const bool g_ = a_ > b_; K[39] = g_ ? a_ : b_; K[47] = g_ ? b_ : a_; }
  { const float a_ = K[32], b_ = K[36]; const bool g_ = a_ > b_; K[32] = g_ ? a_ : b_; K[36] = g_ ? b_ : a_; }
  { const float a_ = K[33], b_ = K[37]; const bool g_ = a_ > b_; K[33] = g_ ? a_ : b_; K[37] = g_ ? b_ : a_; }
  { const float a_ = K[34], b_ = K[38]; const bool g_ = a_ > b_; K[34] = g_ ? a_ : b_; K[38] = g_ ? b_ : a_; }
  { const float a_ = K[35], b_ = K[39]; const bool g_ = a_ > b_; K[35] = g_ ? a_ : b_; K[39] = g_ ? b_ : a_; }
  { const float a_ = K[40], b_ = K[44]; const bool g_ = a_ > b_; K[40] = g_ ? a_ : b_; K[44] = g_ ? b_ : a_; }
  { const float a_ = K[41], b_ = K[45]; const bool g_ = a_ > b_; K[41] = g_ ? a_ : b_; K[45] = g_ ? b_ : a_; }
  { const float a_ = K[42], b_ = K[46]; const bool g_ = a_ > b_; K[42] = g_ ? a_ : b_; K[46] = g_ ? b_ : a_; }
  { const float a_ = K[43], b_ = K[47]; const bool g_ = a_ > b_; K[43] = g_ ? a_ : b_; K[47] = g_ ? b_ : a_; }
  { const float a_ = K[32], b_ = K[34]; const bool g_ = a_ > b_; K[32] = g_ ? a_ : b_; K[34] = g_ ? b_ : a_; }
  { const float a_ = K[33], b_ = K[35]; const bool g_ = a_ > b_; K[33] = g_ ? a_ : b_; K[35] = g_ ? b_ : a_; }
  { const float a_ = K[36], b_ = K[38]; const bool g_ = a_ > b_; K[36] = g_ ? a_ : b_; K[38] = g_ ? b_ : a_; }
  { const float a_ = K[37], b_ = K[39]; const bool g_ = a_ > b_; K[37] = g_ ? a_ : b_; K[39] = g_ ? b_ : a_; }
  { const float a_ = K[40], b_ = K[42]; const bool g_ = a_ > b_; K[40] = g_ ? a_ : b_; K[42] = g_ ? b_ : a_; }
  { const float a_ = K[41], b_ = K[43]; const bool g_ = a_ > b_; K[41] = g_ ? a_ : b_; K[43] = g_ ? b_ : a_; }
  { const float a_ = K[44], b_ = K[46]; const bool g_ = a_ > b_; K[44] = g_ ? a_ : b_; K[46] = g_ ? b_ : a_; }
  { const float a_ = K[45], b_ = K[47]; const bool g_ = a_ > b_; K[45] = g_ ? a_ : b_; K[47] = g_ ? b_ : a_; }
  { const float a_ = K[32], b_ = K[33]; const bool g_ = a_ > b_; K[32] = g_ ? a_ : b_; K[33] = g_ ? b_ : a_; }
  { const float a_ = K[34], b_ = K[35]; const bool g_ = a_ > b_; K[34] = g_ ? a_ : b_; K[35] = g_ ? b_ : a_; }
  { const float a_ = K[36], b_ = K[37]; const bool g_ = a_ > b_; K[36] = g_ ? a_ : b_; K[37] = g_ ? b_ : a_; }
  { const float a_ = K[38], b_ = K[39]; const bool g_ = a_ > b_; K[38] = g_ ? a_ : b_; K[39] = g_ ? b_ : a_; }
  { const float a_ = K[40], b_ = K[41]; const bool g_ = a_ > b_; K[40] = g_ ? a_ : b_; K[41] = g_ ? b_ : a_; }
  { const float a_ = K[42], b_ = K[43]; const bool g_ = a_ > b_; K[42] = g_ ? a_ : b_; K[43] = g_ ? b_ : a_; }
  { const float a_ = K[44], b_ = K[45]; const bool g_ = a_ > b_; K[44] = g_ ? a_ : b_; K[45] = g_ ? b_ : a_; }
  { const float a_ = K[46], b_ = K[47]; const bool g_ = a_ > b_; K[46] = g_ ? a_ : b_; K[47] = g_ ? b_ : a_; }
  { const float a_ = K[0], b_ = K[47]; K[0] = a_ > b_ ? a_ : b_; }
  { const float a_ = K[1], b_ = K[46]; K[1] = a_ > b_ ? a_ : b_; }
  { const float a_ = K[2], b_ = K[45]; K[2] = a_ > b_ ? a_ : b_; }
  { const float a_ = K[3], b_ = K[44]; K[3] = a_ > b_ ? a_ : b_; }
  { const float a_ = K[4], b_ = K[43]; K[4] = a_ > b_ ? a_ : b_; }
  { const float a_ = K[5], b_ = K[42]; K[5] = a_ > b_ ? a_ : b_; }
  { const float a_ = K[6], b_ = K[41]; K[6] = a_ > b_ ? a_ : b_; }
  { const float a_ = K[7], b_ = K[40]; K[7] = a_ > b_ ? a_ : b_; }
  { const float a_ = K[8], b_ = K[39]; K[8] = a_ > b_ ? a_ : b_; }
  { const float a_ = K[9], b_ = K[38]; K[9] = a_ > b_ ? a_ : b_; }
  { const float a_ = K[10], b_ = K[37]; K[10] = a_ > b_ ? a_ : b_; }
  { const float a_ = K[11], b_ = K[36]; K[11] = a_ > b_ ? a_ : b_; }
  { const float a_ = K[12], b_ = K[35]; K[12] = a_ > b_ ? a_ : b_; }
  { const float a_ = K[13], b_ = K[34]; K[13] = a_ > b_ ? a_ : b_; }
  { const float a_ = K[14], b_ = K[33]; K[14] = a_ > b_ ? a_ : b_; }
  { const float a_ = K[15], b_ = K[32]; K[15] = a_ > b_ ? a_ : b_; }
  { const float a_ = K[0], b_ = K[8]; const bool g_ = a_ > b_; K[0] = g_ ? a_ : b_; K[8] = g_ ? b_ : a_; }
  { const float a_ = K[1], b_ = K[9]; const bool g_ = a_ > b_; K[1] = g_ ? a_ : b_; K[9] = g_ ? b_ : a_; }
  { const float a_ = K[2], b_ = K[10]; const bool g_ = a_ > b_; K[2] = g_ ? a_ : b_; K[10] = g_ ? b_ : a_; }
  { const float a_ = K[3], b_ = K[11]; const bool g_ = a_ > b_; K[3] = g_ ? a_ : b_; K[11] = g_ ? b_ : a_; }
  { const float a_ = K[4], b_ = K[12]; const bool g_ = a_ > b_; K[4] = g_ ? a_ : b_; K[12] = g_ ? b_ : a_; }
  { const float a_ = K[5], b_ = K[13]; const bool g_ = a_ > b_; K[5] = g_ ? a_ : b_; K[13] = g_ ? b_ : a_; }
  { const float a_ = K[6], b_ = K[14]; const bool g_ = a_ > b_; K[6] = g_ ? a_ : b_; K[14] = g_ ? b_ : a_; }
  { const float a_ = K[7], b_ = K[15]; const bool g_ = a_ > b_; K[7] = g_ ? a_ : b_; K[15] = g_ ? b_ : a_; }
  { const float a_ = K[0], b_ = K[4]; const bool g_ = a_ > b_; K[0] = g_ ? a_ : b_; K[4] = g_ ? b_ : a_; }
  { const float a_ = K[1], b_ = K[5]; const bool g_ = a_ > b_; K[1] = g_ ? a_ : b_; K[5] = g_ ? b_ : a_; }
  { const float a_ = K[2], b_ = K[6]; const bool g_ = a_ > b_; K[2] = g_ ? a_ : b_; K[6] = g_ ? b_ : a_; }
  { const float a_ = K[3], b_ = K[7]; const bool g_ = a_ > b_; K[3] = g_ ? a_ : b_; K[7] = g_ ? b_ : a_; }
  { const float a_ = K[8], b_ = K[12]; const bool g_ = a_ > b_; K[8] = g_ ? a_ : b_; K[12] = g_ ? b_ : a_; }
  { const float a_ = K[9], b_ = K[13]; const bool g_ = a_ > b_; K[9] = g_ ? a_ : b_; K[13] = g_ ? b_ : a_; }
  { const float a_ = K[10], b_ = K[14]; const bool g_ = a_ > b_; K[10] = g_ ? a_ : b_; K[14] = g_ ? b_ : a_; }
  { const float a_ = K[11], b_ = K[15]; const bool g_ = a_ > b_; K[11] = g_ ? a_ : b_; K[15] = g_ ? b_ : a_; }
  { const float a_ = K[0], b_ = K[2]; const bool g_ = a_ > b_; K[0] = g_ ? a_ : b_; K[2] = g_ ? b_ : a_; }
  { const float a_ = K[1], b_ = K[3]; const bool g_ = a_ > b_; K[1] = g_ ? a_ : b_; K[3] = g_ ? b_ : a_; }
  { const float a_ = K[4], b_ = K[6]; const bool g_ = a_ > b_; K[4] = g_ ? a_ : b_; K[6] = g_ ? b_ : a_; }
  { const float a_ = K[5], b_ = K[7]; const bool g_ = a_ > b_; K[5] = g_ ? a_ : b_; K[7] = g_ ? b_ : a_; }
  { const float a_ = K[8], b_ = K[10]; const bool g_ = a_ > b_; K[8] = g_ ? a_ : b_; K[10] = g_ ? b_ : a_; }
  { const float a_ = K[9], b_ = K[11]; const bool g_ = a_ > b_; K[9] = g_ ? a_ : b_; K[11] = g_ ? b_ : a_; }
  { const float a_ = K[12], b_ = K[14]; const bool g_ = a_ > b_; K[12] = g_ ? a_ : b_; K[14] = g_ ? b_ : a_; }
  { const float a_ = K[13], b_ = K[15]; const bool g_ = a_ > b_; K[13] = g_ ? a_ : b_; K[15] = g_ ? b_ : a_; }
  { const float a_ = K[0], b_ = K[1]; const bool g_ = a_ > b_; K[0] = g_ ? a_ : b_; K[1] = g_ ? b_ : a_; }
  { const float a_ = K[2], b_ = K[3]; const bool g_ = a_ > b_; K[2] = g_ ? a_ : b_; K[3] = g_ ? b_ : a_; }
  { const float a_ = K[4], b_ = K[5]; const bool g_ = a_ > b_; K[4] = g_ ? a_ : b_; K[5] = g_ ? b_ : a_; }
  { const float a_ = K[6], b_ = K[7]; const bool g_ = a_ > b_; K[6] = g_ ? a_ : b_; K[7] = g_ ? b_ : a_; }
  { const float a_ = K[8], b_ = K[9]; const bool g_ = a_ > b_; K[8] = g_ ? a_ : b_; K[9] = g_ ? b_ : a_; }
  { const float a_ = K[10], b_ = K[11]; const bool g_ = a_ > b_; K[10] = g_ ? a_ : b_; K[11] = g_ ? b_ : a_; }
  { const float a_ = K[12], b_ = K[13]; const bool g_ = a_ > b_; K[12] = g_ ? a_ : b_; K[13] = g_ ? b_ : a_; }
  { const float a_ = K[14], b_ = K[15]; const bool g_ = a_ > b_; K[14] = g_ ? a_ : b_; K[15] = g_ ? b_ : a_; }
}
__device__ __forceinline__ void merge_top16(float (&T)[16], const float (&P)[16]) {
  { const float a_ = T[0], b_ = P[15]; T[0] = a_ > b_ ? a_ : b_; }
  { const float a_ = T[1], b_ = P[14]; T[1] = a_ > b_ ? a_ : b_; }
  { const float a_ = T[2], b_ = P[13]; T[2] = a_ > b_ ? a_ : b_; }
  { const float a_ = T[3], b_ = P[12]; T[3] = a_ > b_ ? a_ : b_; }
  { const float a_ = T[4], b_ = P[11]; T[4] = a_ > b_ ? a_ : b_; }
  { const float a_ = T[5], b_ = P[10]; T[5] = a_ > b_ ? a_ : b_; }
  { const float a_ = T[6], b_ = P[9]; T[6] = a_ > b_ ? a_ : b_; }
  { const float a_ = T[7], b_ = P[8]; T[7] = a_ > b_ ? a_ : b_; }
  { const float a_ = T[8], b_ = P[7]; T[8] = a_ > b_ ? a_ : b_; }
  { const float a_ = T[9], b_ = P[6]; T[9] = a_ > b_ ? a_ : b_; }
  { const float a_ = T[10], b_ = P[5]; T[10] = a_ > b_ ? a_ : b_; }
  { const float a_ = T[11], b_ = P[4]; T[11] = a_ > b_ ? a_ : b_; }
  { const float a_ = T[12], b_ = P[3]; T[12] = a_ > b_ ? a_ : b_; }
  { const float a_ = T[13], b_ = P[2]; T[13] = a_ > b_ ? a_ : b_; }
  { const float a_ = T[14], b_ = P[1]; T[14] = a_ > b_ ? a_ : b_; }
  { const float a_ = T[15], b_ = P[0]; T[15] = a_ > b_ ? a_ : b_; }
  { const float a_ = T[0], b_ = T[8]; const bool g_ = a_ > b_; T[0] = g_ ? a_ : b_; T[8] = g_ ? b_ : a_; }
  { const float a_ = T[1], b_ = T[9]; const bool g_ = a_ > b_; T[1] = g_ ? a_ : b_; T[9] = g_ ? b_ : a_; }
  { const float a_ = T[2], b_ = T[10]; const bool g_ = a_ > b_; T[2] = g_ ? a_ : b_; T[10] = g_ ? b_ : a_; }
  { const float a_ = T[3], b_ = T[11]; const bool g_ = a_ > b_; T[3] = g_ ? a_ : b_; T[11] = g_ ? b_ : a_; }
  { const float a_ = T[4], b_ = T[12]; const bool g_ = a_ > b_; T[4] = g_ ? a_ : b_; T[12] = g_ ? b_ : a_; }
  { const float a_ = T[5], b_ = T[13]; const bool g_ = a_ > b_; T[5] = g_ ? a_ : b_; T[13] = g_ ? b_ : a_; }
  { const float a_ = T[6], b_ = T[14]; const bool g_ = a_ > b_; T[6] = g_ ? a_ : b_; T[14] = g_ ? b_ : a_; }
  { const float a_ = T[7], b_ = T[15]; const bool g_ = a_ > b_; T[7] = g_ ? a_ : b_; T[15] = g_ ? b_ : a_; }
  { const float a_ = T[0], b_ = T[4]; const bool g_ = a_ > b_; T[0] = g_ ? a_ : b_; T[4] = g_ ? b_ : a_; }
  { const float a_ = T[1], b_ = T[5]; const bool g_ = a_ > b_; T[1] = g_ ? a_ : b_; T[5] = g_ ? b_ : a_; }
  { const float a_ = T[2], b_ = T[6]; const bool g_ = a_ > b_; T[2] = g_ ? a_ : b_; T[6] = g_ ? b_ : a_; }
  { const float a_ = T[3], b_ = T[7]; const bool g_ = a_ > b_; T[3] = g_ ? a_ : b_; T[7] = g_ ? b_ : a_; }
  { const float a_ = T[8], b_ = T[12]; const bool g_ = a_ > b_; T[8] = g_ ? a_ : b_; T[12] = g_ ? b_ : a_; }
  { const float a_ = T[9], b_ = T[13]; const bool g_ = a_ > b_; T[9] = g_ ? a_ : b_; T[13] = g_ ? b_ : a_; }
  { const float a_ = T[10], b_ = T[14]; const bool g_ = a_ > b_; T[10] = g_ ? a_ : b_; T[14] = g_ ? b_ : a_; }
  { const float a_ = T[11], b_ = T[15]; const bool g_ = a_ > b_; T[11] = g_ ? a_ : b_; T[15] = g_ ? b_ : a_; }
  { const float a_ = T[0], b_ = T[2]; const bool g_ = a_ > b_; T[0] = g_ ? a_ : b_; T[2] = g_ ? b_ : a_; }
  { const float a_ = T[1], b_ = T[3]; const bool g_ = a_ > b_; T[1] = g_ ? a_ : b_; T[3] = g_ ? b_ : a_; }
  { const float a_ = T[4], b_ = T[6]; const bool g_ = a_ > b_; T[4] = g_ ? a_ : b_; T[6] = g_ ? b_ : a_; }
  { const float a_ = T[5], b_ = T[7]; const bool g_ = a_ > b_; T[5] = g_ ? a_ : b_; T[7] = g_ ? b_ : a_; }
  { const float a_ = T[8], b_ = T[10]; const bool g_ = a_ > b_; T[8] = g_ ? a_ : b_; T[10] = g_ ? b_ : a_; }
  { const float a_ = T[9], b_ = T[11]; const bool g_ = a_ > b_; T[9] = g_ ? a_ : b_; T[11] = g_ ? b_ : a_; }
  { const float a_ = T[12], b_ = T[14]; const bool g_ = a_ > b_; T[12] = g_ ? a_ : b_; T[14] = g_ ? b_ : a_; }
  { const float a_ = T[13], b_ = T[15]; const bool g_ = a_ > b_; T[13] = g_ ? a_ : b_; T[15] = g_ ? b_ : a_; }
  { const float a_ = T[0], b_ = T[1]; const bool g_ = a_ > b_; T[0] = g_ ? a_ : b_; T[1] = g_ ? b_ : a_; }
  { const float a_ = T[2], b_ = T[3]; const bool g_ = a_ > b_; T[2] = g_ ? a_ : b_; T[3] = g_ ? b_ : a_; }
  { const float a_ = T[4], b_ = T[5]; const bool g_ = a_ > b_; T[4] = g_ ? a_ : b_; T[5] = g_ ? b_ : a_; }
  { const float a_ = T[6], b_ = T[7]; const bool g_ = a_ > b_; T[6] = g_ ? a_ : b_; T[7] = g_ ? b_ : a_; }
  { const float a_ = T[8], b_ = T[9]; const bool g_ = a_ > b_; T[8] = g_ ? a_ : b_; T[9] = g_ ? b_ : a_; }
  { const float a_ = T[10], b_ = T[11]; const bool g_ = a_ > b_; T[10] = g_ ? a_ : b_; T[11] = g_ ? b_ : a_; }
  { const float a_ = T[12], b_ = T[13]; const bool g_ = a_ > b_; T[12] = g_ ? a_ : b_; T[13] = g_ ? b_ : a_; }
  { const float a_ = T[14], b_ = T[15]; const bool g_ = a_ > b_; T[14] = g_ ? a_ : b_; T[15] = g_ ? b_ : a_; }
}

__device__ __forceinline__ void peer_topk(const int wave_s, const bf16* pq, const bf16* skb, int* ids, float* gates, LAS float* smem) {
  const int tid_ = opaque_tid(wave_s);
  const int lane = tid_ & 63, n = lane & 31, hh = lane >> 5, wave = tid_ >> 6;
  const int gw = blockIdx.x * NWAVES + wave;
  const int nw = gridDim.x * NWAVES;
  LAS float* lk = smem + wave * 2048;
  for (int it = gw; it < 512 * 8; it += nw) {
    const int h = it & 7, tok0 = (it >> 3) * 32;
#pragma unroll 1
    for (int half = 0; half < 2; half++) {
      bf16x8_t qf[8];
      {
        const bf16* qrow = pq + (size_t)(tok0 + n) * 2048 + h * 256 + half * 128 + 8 * hh;
#pragma unroll
        for (int ks = 0; ks < 8; ks++) qf[ks] = *(const bf16x8_t*)(qrow + 16 * ks);
      }
      float K[64];
#pragma unroll
      for (int kt = 0; kt < 4; kt++) {
        const bf16* krow = skb + ((size_t)((h * 2 + half) * 128 + kt * 32 + n)) * 128 + 8 * hh;
        f32x16_t acc;
#pragma unroll
        for (int r = 0; r < 16; r++) acc[r] = 0.f;
#pragma unroll
        for (int kq = 0; kq < 2; kq++) {
          bf16x8_t kf[4];
#pragma unroll
          for (int i = 0; i < 4; i++) kf[i] = *(const bf16x8_t*)(krow + 16 * (kq * 4 + i));
          MFMA_PAD();
#pragma unroll
          for (int i = 0; i < 4; i++) acc = __builtin_amdgcn_mfma_f32_32x32x16_bf16(kf[i], qf[kq * 4 + i], acc, 0, 0, 0);
          MFMA_PAD();
        }
#pragma unroll
        for (int i = 0; i < 16; i++) K[kt * 16 + i] = pack_key<0x7Fu>(acc[i], (unsigned)(kt * 32 + (i & 3) + 8 * (i >> 2) + 4 * hh));
      }
      __builtin_amdgcn_sched_barrier(0);
      top16_of_64(K);
      __builtin_amdgcn_sched_barrier(0);
      float T[16], P[16];
#pragma unroll
      for (int i = 0; i < 16; i++) { T[i] = K[i]; P[i] = __shfl_xor(K[i], 32, 64); }
      merge_top16(T, P);
#pragma unroll
      for (int i = 0; i < 16; i++) lk[(half * 16 + i) * 64 + lane] = T[i];
      __builtin_amdgcn_sched_barrier(0);
    }
    float f0[16], f1[16];
    int ti0[16], ti1[16];
#pragma unroll
    for (int i = 0; i < 16; i++) {
      const float k0 = lk[i * 64 + lane], k1 = lk[(16 + i) * 64 + lane];
      f0[i] = key_val<0x7Fu>(k0); ti0[i] = (int)key_idx<0x7Fu>(k0);
      f1[i] = key_val<0x7Fu>(k1); ti1[i] = (int)key_idx<0x7Fu>(k1);
    }
    float K[64];
    {
    K[0] = pack_key<0xFFu>(f0[0] + f1[0], 0u);
    K[1] = pack_key<0xFFu>(f0[0] + f1[1], 1u);
    K[2] = pack_key<0xFFu>(f0[0] + f1[2], 2u);
    K[3] = pack_key<0xFFu>(f0[0] + f1[3], 3u);
    K[4] = pack_key<0xFFu>(f0[0] + f1[4], 4u);
    K[5] = pack_key<0xFFu>(f0[0] + f1[5], 5u);
    K[6] = pack_key<0xFFu>(f0[0] + f1[6], 6u);
    K[7] = pack_key<0xFFu>(f0[0] + f1[7], 7u);
    K[8] = pack_key<0xFFu>(f0[0] + f1[8], 8u);
    K[9] = pack_key<0xFFu>(f0[0] + f1[9], 9u);
    K[10] = pack_key<0xFFu>(f0[0] + f1[10], 10u);
    K[11] = pack_key<0xFFu>(f0[0] + f1[11], 11u);
    K[12] = pack_key<0xFFu>(f0[0] + f1[12], 12u);
    K[13] = pack_key<0xFFu>(f0[0] + f1[13], 13u);
    K[14] = pack_key<0xFFu>(f0[0] + f1[14], 14u);
    K[15] = pack_key<0xFFu>(f0[0] + f1[15], 15u);
    K[16] = pack_key<0xFFu>(f0[1] + f1[0], 16u);
    K[17] = pack_key<0xFFu>(f0[1] + f1[1], 17u);
    K[18] = pack_key<0xFFu>(f0[1] + f1[2], 18u);
    K[19] = pack_key<0xFFu>(f0[1] + f1[3], 19u);
    K[20] = pack_key<0xFFu>(f0[1] + f1[4], 20u);
    K[21] = pack_key<0xFFu>(f0[1] + f1[5], 21u);
    K[22] = pack_key<0xFFu>(f0[1] + f1[6], 22u);
    K[23] = pack_key<0xFFu>(f0[1] + f1[7], 23u);
    K[24] = pack_key<0xFFu>(f0[2] + f1[0], 32u);
    K[25] = pack_key<0xFFu>(f0[2] + f1[1], 33u);
    K[26] = pack_key<0xFFu>(f0[2] + f1[2], 34u);
    K[27] = pack_key<0xFFu>(f0[2] + f1[3], 35u);
    K[28] = pack_key<0xFFu>(f0[2] + f1[4], 36u);
    K[29] = pack_key<0xFFu>(f0[3] + f1[0], 48u);
    K[30] = pack_key<0xFFu>(f0[3] + f1[1], 49u);
    K[31] = pack_key<0xFFu>(f0[3] + f1[2], 50u);
    K[32] = pack_key<0xFFu>(f0[3] + f1[3], 51u);
    K[33] = pack_key<0xFFu>(f0[4] + f1[0], 64u);
    K[34] = pack_key<0xFFu>(f0[4] + f1[1], 65u);
    K[35] = pack_key<0xFFu>(f0[4] + f1[2], 66u);
    K[36] = pack_key<0xFFu>(f0[5] + f1[0], 80u);
    K[37] = pack_key<0xFFu>(f0[5] + f1[1], 81u);
    K[38] = pack_key<0xFFu>(f0[6] + f1[0], 96u);
    K[39] = pack_key<0xFFu>(f0[6] + f1[1], 97u);
    K[40] = pack_key<0xFFu>(f0[7] + f1[0], 112u);
    K[41] = pack_key<0xFFu>(f0[7] + f1[1], 113u);
    K[42] = pack_key<0xFFu>(f0[8] + f1[0], 128u);
    K[43] = pack_key<0xFFu>(f0[9] + f1[0], 144u);
    K[44] = pack_key<0xFFu>(f0[10] + f1[0], 160u);
    K[45] = pack_key<0xFFu>(f0[11] + f1[0], 176u);
    K[46] = pack_key<0xFFu>(f0[12] + f1[0], 192u);
    K[47] = pack_key<0xFFu>(f0[13] + f1[0], 208u);
    K[48] = pack_key<0xFFu>(f0[14] + f1[0], 224u);
    K[49] = pack_key<0xFFu>(f0[15] + f1[0], 240u);
    K[50] = -3.0e38f;
    K[51] = -3.0e38f;
    K[52] = -3.0e38f;
    K[53] = -3.0e38f;
    K[54] = -3.0e38f;
    K[55] = -3.0e38f;
    K[56] = -3.0e38f;
    K[57] = -3.0e38f;
    K[58] = -3.0e38f;
    K[59] = -3.0e38f;
    K[60] = -3.0e38f;
    K[61] = -3.0e38f;
    K[62] = -3.0e38f;
    K[63] = -3.0e38f;
    }
    __builtin_amdgcn_sched_barrier(0);
    top16_of_64(K);
    __builtin_amdgcn_sched_barrier(0);
    float bv[16];
    int be[16];
#pragma unroll
    for (int r = 0; r < 16; r++) {
      const int flat = (int)key_idx<0xFFu>(K[r]);
      const int a = flat >> 4, b = flat & 15;
      int i0 = 0, i1 = 0;
#pragma unroll
      for (int i = 0; i < 16; i++) { i0 = (a == i) ? ti0[i] : i0; i1 = (b == i) ? ti1[i] : i1; }
      be[r] = i0 * 128 + i1;
      bv[r] = key_val<0xFFu>(K[r]);
    }
    const float b0 = bv[0];
    float ge[16];
    float gsum = 0.f;
#pragma unroll
    for (int r = 0; r < 16; r++) { ge[r] = __expf(bv[r] - b0); gsum += ge[r]; }
    const float ginv = 1.0f / gsum;
    if (hh == 0) {
      int* ip = ids + (size_t)(tok0 + n) * 128 + h * 16;
      float* gp = gates + (size_t)(tok0 + n) * 128 + h * 16;
#pragma unroll
      for (int r4 = 0; r4 < 4; r4++) {
        *(int4*)(ip + 4 * r4) = make_int4(be[4 * r4], be[4 * r4 + 1], be[4 * r4 + 2], be[4 * r4 + 3]);
        *(float4*)(gp + 4 * r4) = make_float4(ge[4 * r4] * ginv, ge[4 * r4 + 1] * ginv, ge[4 * r4 + 2] * ginv, ge[4 * r4 + 3] * ginv);
      }
    }
  }
}

typedef _Float16 f16x2_t __attribute__((ext_vector_type(2)));
__device__ __forceinline__ unsigned e4m3x2_to_f16x2(unsigned w, unsigned sel) {
  return __builtin_amdgcn_perm(w, w, sel);
}
__device__ __forceinline__ float dot2h(unsigned a, unsigned b, float c) {
  return __builtin_amdgcn_fdot2(__builtin_bit_cast(f16x2_t, a), __builtin_bit_cast(f16x2_t, b), c, false);
}
__device__ __forceinline__ unsigned pack_h2(float lo, float hi) {
  f16x2_t v; v.x = (_Float16)lo; v.y = (_Float16)hi;
  return __builtin_bit_cast(unsigned, v);
}
template <bool FINAL>
__device__ __forceinline__ void peer_gather(const int wave_s, bf16* xn, const float* rst, const unsigned char* ub, const unsigned char* vb,
                                            const int* ids, const float* gates, float* xw, const float* gnext, float* outp) {
  const int tid_ = opaque_tid(wave_s);
  const int lane = tid_ & 63;
  const int gw = blockIdx.x * NWAVES + (tid_ >> 6);
  const int nw = gridDim.x * NWAVES;
  const int el = ((lane >> 5) & 1) * 4 + ((lane >> 4) & 1) * 2 + ((lane >> 3) & 1);
  for (int tok = gw; tok < NT; tok += nw) {
    unsigned xh[8];
    {
      const uint4 a = *(const uint4*)(xn + (size_t)tok * DM + lane * 16);
      const uint4 b = *(const uint4*)(xn + (size_t)tok * DM + lane * 16 + 8);
      const unsigned xw_[8] = {a.x, a.y, a.z, a.w, b.x, b.y, b.z, b.w};
      const float4* sp = (const float4*)(rst + (size_t)tok * 16);
      const float4 s0 = sp[0], s1 = sp[1], s2 = sp[2], s3 = sp[3];
      const float xs = rsqrtf((((s0.x + s0.y) + (s0.z + s0.w)) + ((s1.x + s1.y) + (s1.z + s1.w)) + ((s2.x + s2.y) + (s2.z + s2.w)) + ((s3.x + s3.y) + (s3.z + s3.w))) * (1.0f / 1024.f) + EPSF);
#pragma unroll
      for (int k = 0; k < 8; k++) xh[k] = pack_h2(bf_lo(xw_[k]) * xs, bf_hi(xw_[k]) * xs);
    }
    float acc[16];
#pragma unroll
    for (int i = 0; i < 16; i++) acc[i] = 0.f;
#pragma unroll 1
    for (int g = 0; g < 16; g++) {
      const int idv = ids[(size_t)tok * 128 + g * 8 + (lane & 7)];
      const float gv = gates[(size_t)tok * 128 + g * 8 + el];
      uint4 uu[8], vv[8];
#pragma unroll
      for (int e = 0; e < 8; e++) {
        const int id = __builtin_amdgcn_readlane(idv, e);
        uu[e] = *(const uint4*)(ub + (size_t)id * DM + lane * 16);
        vv[e] = *(const uint4*)(vb + (size_t)id * DM + lane * 16);
      }
      float d[8];
#pragma unroll
      for (int e = 0; e < 8; e++) {
        const unsigned uw[4] = {uu[e].x, uu[e].y, uu[e].z, uu[e].w};
        float s = 0.f;
#pragma unroll
        for (int k = 0; k < 4; k++) {
          s = dot2h(e4m3x2_to_f16x2(uw[k], 0x010c000cu), xh[2 * k], s);
          s = dot2h(e4m3x2_to_f16x2(uw[k], 0x030c020cu), xh[2 * k + 1], s);
        }
        d[e] = s;
      }
      float d4[4], d2[2], d1;
      {
        const bool hi = (lane & 32) != 0;
#pragma unroll
        for (int i = 0; i < 4; i++) { const float send = hi ? d[i] : d[i + 4]; const float keep = hi ? d[i + 4] : d[i]; d4[i] = keep + __shfl_xor(send, 32, 64); }
      }
      {
        const bool hi = (lane & 16) != 0;
#pragma unroll
        for (int i = 0; i < 2; i++) { const float send = hi ? d4[i] : d4[i + 2]; const float keep = hi ? d4[i + 2] : d4[i]; d2[i] = keep + __shfl_xor(send, 16, 64); }
      }
      {
        const bool hi = (lane & 8) != 0;
        const float send = hi ? d2[0] : d2[1];
        const float keep = hi ? d2[1] : d2[0];
        d1 = keep + __shfl_xor(send, 8, 64);
      }
      d1 += __shfl_xor(d1, 4, 64);
      d1 += __shfl_xor(d1, 2, 64);
      d1 += __shfl_xor(d1, 1, 64);
      const float wl = gv * gelu_tanh(d1 * (1.0f / U_SCALE)) * (1.0f / V_SCALE);
#pragma unroll
      for (int e = 0; e < 8; e++) {
        const float w = __builtin_bit_cast(float, __builtin_amdgcn_readlane(__builtin_bit_cast(int, wl), ((e >> 2) & 1) * 32 + ((e >> 1) & 1) * 16 + (e & 1) * 8));
        const unsigned wlo = pack_h2(w, 0.f), whi = pack_h2(0.f, w);
        const unsigned vw[4] = {vv[e].x, vv[e].y, vv[e].z, vv[e].w};
#pragma unroll
        for (int k = 0; k < 4; k++) {
          const unsigned h0 = e4m3x2_to_f16x2(vw[k], 0x010c000cu), h1 = e4m3x2_to_f16x2(vw[k], 0x030c020cu);
          acc[4 * k + 0] = dot2h(h0, wlo, acc[4 * k + 0]);
          acc[4 * k + 1] = dot2h(h0, whi, acc[4 * k + 1]);
          acc[4 * k + 2] = dot2h(h1, wlo, acc[4 * k + 2]);
          acc[4 * k + 3] = dot2h(h1, whi, acc[4 * k + 3]);
        }
      }
    }
    float* xr = xw + (size_t)tok * DM + lane * 16;
    float xv[16];
    float ssq = 0.f;
#pragma unroll
    for (int c = 0; c < 4; c++) {
      float4 a0 = *(float4*)(xr + c * 4);
      a0.x += acc[c * 4 + 0]; a0.y += acc[c * 4 + 1]; a0.z += acc[c * 4 + 2]; a0.w += acc[c * 4 + 3];
      if (!FINAL) *(float4*)(xr + c * 4) = a0;
      xv[c * 4 + 0] = a0.x; xv[c * 4 + 1] = a0.y; xv[c * 4 + 2] = a0.z; xv[c * 4 + 3] = a0.w;
      ssq += a0.x * a0.x + a0.y * a0.y + a0.z * a0.z + a0.w * a0.w;
    }
    ssq = wsum(ssq);
    const float rstd = rsqrtf(ssq * (1.0f / DM) + EPSF);
    const float4* g4 = (const float4*)(gnext + lane * 16);
    if (FINAL) {
      float* op = outp + (size_t)tok * DM + lane * 16;
#pragma unroll
      for (int c = 0; c < 4; c++) {
        const float4 gq = g4[c];
        *(float4*)(op + c * 4) = make_float4(xv[c * 4] * rstd * gq.x, xv[c * 4 + 1] * rstd * gq.y, xv[c * 4 + 2] * rstd * gq.z, xv[c * 4 + 3] * rstd * gq.w);
      }
    } else {
      uint4 o0, o1;
      { const float4 ga = g4[0], gb = g4[1];
        o0.x = pk2(xv[0] * rstd * ga.x, xv[1] * rstd * ga.y); o0.y = pk2(xv[2] * rstd * ga.z, xv[3] * rstd * ga.w);
        o0.z = pk2(xv[4] * rstd * gb.x, xv[5] * rstd * gb.y); o0.w = pk2(xv[6] * rstd * gb.z, xv[7] * rstd * gb.w); }
      { const float4 ga = g4[2], gb = g4[3];
        o1.x = pk2(xv[8] * rstd * ga.x, xv[9] * rstd * ga.y); o1.y = pk2(xv[10] * rstd * ga.z, xv[11] * rstd * ga.w);
        o1.z = pk2(xv[12] * rstd * gb.x, xv[13] * rstd * gb.y); o1.w = pk2(xv[14] * rstd * gb.z, xv[15] * rstd * gb.w); }
      *(uint4*)(xn + (size_t)tok * DM + lane * 16) = o0;
      *(uint4*)(xn + (size_t)tok * DM + lane * 16 + 8) = o1;
    }
  }
}

__device__ __forceinline__ void prologue_transposes(const int wave_s, const Params& p, unsigned char* ws, LAS unsigned char* lds) {
  const int tid_ = opaque_tid(wave_s);
  const int lane = tid_ & 63, wave = tid_ >> 6;
  LAS float* scr = (LAS float*)(lds + wave * 16384);
  const int gw = blockIdx.x * NWAVES + wave, NGW = gridDim.x * NWAVES;
  constexpr int I_IN = (DM / 64) * (DIN / 32), I_SQ = (DM / 64) * (DM / 32), I_2K = (DM / 64) * (2048 / 32);
  constexpr int I_GL = (256 / 64) * (256 / 32);
  constexpr int PER_LAYER = I_IN + 3 * I_SQ + 2 * I_2K + I_GL;
  const float* w3 = karg_in(3); const float* w19 = karg_in(19); const float* w22 = karg_in(22);
  const float* w23 = karg_in(23); const float* w24 = karg_in(24); const float* w26 = karg_in(26);
  const float* w16 = karg_in(16);
  for (int it = gw; it < 2 * PER_LAYER; it += NGW) {
    const int l = it / PER_LAYER;
    int r = it % PER_LAYER;
    unsigned char* wl = ws + WS_WT + (size_t)l * WT_LAYER;
    if (r < I_IN) { transpose_item(w3 + (size_t)l * DM * DIN, DM, DIN, (bf16*)(wl + WT_IN), scr, r, lane); continue; } r -= I_IN;
    if (r < I_SQ) { transpose_item(w19 + (size_t)l * DM * DM, DM, DM, (bf16*)(wl + WT_OUT), scr, r, lane); continue; } r -= I_SQ;
    if (r < I_SQ) { transpose_item(w22 + (size_t)l * DM * DM, DM, DM, (bf16*)(wl + WT_MQ), scr, r, lane); continue; } r -= I_SQ;
    if (r < I_2K) { transpose_item(w23 + (size_t)l * DM * 2048, DM, 2048, (bf16*)(wl + WT_MKV), scr, r, lane); continue; } r -= I_2K;
    if (r < I_SQ) { transpose_item(w24 + (size_t)l * DM * DM, DM, DM, (bf16*)(wl + WT_MO), scr, r, lane); continue; } r -= I_SQ;
    if (r < I_2K) { transpose_item(w26 + (size_t)l * DM * 2048, DM, 2048, (bf16*)(wl + WT_PQ), scr, r, lane); continue; } r -= I_2K;
    transpose_item(w16 + (size_t)l * 256 * 256, 256, 256, (bf16*)(wl + WT_GLU), scr, r, lane);
  }
}

template <class T> __device__ __forceinline__ T* opq(T* p) { asm volatile("" : "+s"(p)); return p; }
__device__ __forceinline__ void cvt_rows_bf16(const int wave_s, const float* src, bf16* dst, size_t n) {
  const int tid_ = opaque_tid(wave_s);
  const size_t gt = (size_t)blockIdx.x * (NWAVES * 64) + tid_;
  const size_t nth = (size_t)gridDim.x * NWAVES * 64;
  for (size_t i = gt; i < n / 8; i += nth) {
    const float4 a = ((const float4*)src)[2 * i], b = ((const float4*)src)[2 * i + 1];
    uint4 o; o.x = pk2(a.x, a.y); o.y = pk2(a.z, a.w); o.z = pk2(b.x, b.y); o.w = pk2(b.z, b.w);
    ((uint4*)dst)[i] = o;
  }
}

__device__ __forceinline__ unsigned enc_e4m3(float x) {
  const _Float16 hf = (_Float16)x;
  const unsigned h = (unsigned)__builtin_bit_cast(unsigned short, hf);
  return ((h + 0x7Fu + ((h >> 8) & 1u)) >> 8) & 0xFFu;
}
__device__ __forceinline__ void cvt_rows_e4m3(const int wave_s, const float* src, unsigned char* dst, size_t n, float sc) {
  const int tid_ = opaque_tid(wave_s);
  const size_t gt = (size_t)blockIdx.x * (NWAVES * 64) + tid_;
  const size_t nth = (size_t)gridDim.x * NWAVES * 64;
  for (size_t i = gt; i < n / 16; i += nth) {
    unsigned w[4];
#pragma unroll
    for (int k = 0; k < 4; k++) {
      const float4 a = ((const float4*)src)[4 * i + k];
      w[k] = enc_e4m3(a.x * sc) | (enc_e4m3(a.y * sc) << 8) | (enc_e4m3(a.z * sc) << 16) | (enc_e4m3(a.w * sc) << 24);
    }
    uint4 o; o.x = w[0]; o.y = w[1]; o.z = w[2]; o.w = w[3];
    ((uint4*)dst)[i] = o;
  }
}

#define GEMM_F32(Aptr, Wt, Cptr, Rptr, M_, N_) do { \
    pg8::Gemm g_{opq((const bf16*)(Aptr)), opq((const bf16*)(Wt)), (M_), (N_), DM}; pg8::StaticOrder S_; S_.init((M_), (N_), (int)gridDim.x, (int)blockIdx.x); \
    pg8::EpiF32R E_{opq((float*)(Cptr)), opq((const float*)(Rptr)), (N_)}; \
    pg8::gemm_phase<pg8::EpiF32R, pg8::StaticOrder, true, true>(wave_s, ldsl, g_, S_, E_); } while (0)
#define GEMM_BF16_C(Aptr, Wt, Optr, M_, N_, C_) do { \
    pg8::Gemm g_{opq((const bf16*)(Aptr)), opq((const bf16*)(Wt)), (M_), (N_), DM}; pg8::StaticOrder S_; S_.init((M_), (N_), (int)gridDim.x, (C_)); \
    pg8::EpiBf16 E_{opq((bf16*)(Optr)), (N_)}; \
    pg8::gemm_phase<pg8::EpiBf16, pg8::StaticOrder, true, true>(wave_s, ldsl, g_, S_, E_); } while (0)
#define GEMM_BF16(Aptr, Wt, Optr, M_, N_) GEMM_BF16_C(Aptr, Wt, Optr, M_, N_, (int)blockIdx.x)
#define GEMM_F32RN(Aptr, Wt, Cptr, Rptr, XGptr, Gptr, STptr) do { \
    pg8::Gemm g_{opq((const bf16*)(Aptr)), opq((const bf16*)(Wt)), NT, DM, DM}; pg8::StaticOrder S_; S_.init(NT, DM, (int)gridDim.x, (int)blockIdx.x); \
    pg8::EpiF32RN E_{opq((float*)(Cptr)), opq((const float*)(Rptr)), DM, opq((bf16*)(XGptr)), opq((const float*)(Gptr)), opq((float*)(STptr))}; \
    pg8::gemm_phase<pg8::EpiF32RN, pg8::StaticOrder, true, true>(wave_s, ldsl, g_, S_, E_); } while (0)
#define GEMM_BF16S(Aptr, Wt, Optr, N_, STptr) do { \
    pg8::Gemm g_{opq((const bf16*)(Aptr)), opq((const bf16*)(Wt)), NT, (N_), DM}; pg8::StaticOrder S_; S_.init(NT, (N_), (int)gridDim.x, (int)blockIdx.x); \
    pg8::EpiBf16S E_{opq((bf16*)(Optr)), (N_), opq((const float*)(STptr))}; \
    pg8::gemm_phase<pg8::EpiBf16S, pg8::StaticOrder, true, true>(wave_s, ldsl, g_, S_, E_); } while (0)

__global__ void __launch_bounds__(NWAVES * 64, 2) fwd_megakernel(Params p) {
  cg::grid_group grid = cg::this_grid();
  extern __shared__ __attribute__((aligned(16))) unsigned char lds[];
  LAS unsigned char* ldsl = (LAS unsigned char*)lds;
  LAS float* smem = (LAS float*)ldsl;
  const int wave_s = __builtin_amdgcn_readfirstlane((int)(threadIdx.x >> 6));
  unsigned char* ws = p.ws;
  volatile LAS unsigned* MISC = (volatile LAS unsigned*)(ldsl + (LDS_BYTES - 256));
  if (threadIdx.x < 64) MISC[threadIdx.x] = 0u;
  __syncthreads();
  const XcdBarrier bar = xcd_barrier_post((unsigned*)(ws + WS_CTL) + 4096, MISC + 8);
  grid.sync();
  float* xw = (float*)(ws + WS_XW);
  bf16* xn = (bf16*)(ws + WS_XN);
  bf16* big = (bf16*)(ws + WS_BIG);
  bf16* y = (bf16*)(ws + WS_Y);
  bf16* memh = (bf16*)(ws + WS_MEMH);
  bf16* kvb = (bf16*)(ws + WS_KVB);
  bf16* vT = (bf16*)(ws + WS_VT);
  float* ssmE = (float*)(ws + WS_SSME);
  float* ssmp = (float*)(ws + WS_SSMP);
  int* ids = (int*)(ws + WS_IDS);
  float* gates = (float*)(ws + WS_GATE);
  bf16* skb = (bf16*)(ws + WS_SKB);
  unsigned char* ub = ws + WS_UB;
  unsigned char* vb = ws + WS_VB;
  float* rst = (float*)(ws + WS_RST);

  prologue_transposes(wave_s, p, ws, ldsl);
  cvt_rows_bf16(wave_s, karg_in(27), skb, (size_t)2 * 8 * 2 * 128 * 128);
  cvt_rows_e4m3(wave_s, karg_in(28), ub, (size_t)2 * 16384 * 1024, U_SCALE);
  cvt_rows_e4m3(wave_s, karg_in(29), vb, (size_t)2 * 16384 * 1024, V_SCALE);
  for (int l = 0; l < 2; l++)
    rms_rows<true>(wave_s, karg_in(1), karg_in(21) + l * DM, memh + (size_t)l * 1024 * 1024, 1024);
  ssm_params(wave_s, p, ssmp);
  xcd_barrier(bar);
  for (int l = 0; l < 2; l++)
    GEMM_BF16_C(memh + (size_t)l * 1024 * 1024, ws + WS_WT + (size_t)l * WT_LAYER + WT_MKV,
              kvb + (size_t)l * 1024 * 2048, 1024, 2048, (int)((blockIdx.x + gridDim.x - 32u * (unsigned)l) % gridDim.x));

#pragma nounroll
  for (int l = 0; l < 2; l++) {
    const float* xcur = (l == 0) ? karg_in(0) : xw;
    const float* sp = ssmp + (size_t)l * SSMP_PER_LAYER;
    const unsigned char* wl = ws + WS_WT + (size_t)l * WT_LAYER;
    if (l == 0) {
      rms_rows<true>(wave_s, xcur, karg_in(2) + l * DM, xn, NT);
      xcd_barrier(bar);
    }
    GEMM_BF16(xn, wl + WT_IN, big, NT, DIN);
    xcd_barrier(bar);
    if (l == 0) vt_phase(wave_s, kvb, vT);
    ssm_chunk_end(wave_s, sp, big, ssmE);
    attn_phase(wave_s, p, l, big, y, smem);
    conv_phase(wave_s, p, l, big, y, smem);
    xcd_barrier(bar);
    ssm_finish(wave_s, p, l, sp, big, ssmE, y, smem);
    xcd_barrier(bar);
    GEMM_F32RN(y, wl + WT_OUT, xw, xcur, xn, karg_in(20) + l * DM, rst);
    xcd_barrier(bar);
    GEMM_BF16S(xn, wl + WT_MQ, big, DM, rst);
    xcd_barrier(bar);
    memattn_phase(wave_s, big, kvb + (size_t)l * 1024 * 2048, vT + (size_t)l * 4 * 4 * 256 * 256, y, smem);
    xcd_barrier(bar);
    GEMM_F32RN(y, wl + WT_MO, xw, (const float*)xw, xn, karg_in(25) + l * DM, rst);
    xcd_barrier(bar);
    GEMM_BF16S(xn, wl + WT_PQ, big, 2048, rst);
    xcd_barrier(bar);
    peer_topk(wave_s, big, skb + (size_t)l * 8 * 2 * 128 * 128, ids, gates, smem);
    xcd_barrier(bar);
    if (l == 0) {
      peer_gather<false>(wave_s, xn, rst, ub + (size_t)l * 16384 * DM, vb + (size_t)l * 16384 * DM, ids, gates, xw, karg_in(2) + DM, (float*)nullptr);
      xcd_barrier(bar);
    } else {
      peer_gather<true>(wave_s, xn, rst, ub + (size_t)l * 16384 * DM, vb + (size_t)l * 16384 * DM, ids, gates, xw, karg_in(30), p.out);
    }
  }
}

extern "C" void kernel_launch(void* const* d_in, const int* in_sizes, int n_in,
                              void* d_out, int out_size, void* d_ws, size_t ws_size,
                              hipStream_t stream) {
  static int grid_blocks = 0;
  if (!grid_blocks) {
    int dev = 0, cus = 0, per_cu = 0;
    (void)hipGetDevice(&dev);
    (void)hipDeviceGetAttribute(&cus, hipDeviceAttributeMultiprocessorCount, dev);
    (void)hipFuncSetAttribute((const void*)fwd_megakernel, hipFuncAttributeMaxDynamicSharedMemorySize, LDS_BYTES);
    (void)hipOccupancyMaxActiveBlocksPerMultiprocessor(&per_cu, fwd_megakernel, NWAVES * 64, LDS_BYTES);
    if (per_cu < 1) fprintf(stderr, "occupancy query reports %d blocks/CU\n", per_cu);
    grid_blocks = cus;
  }
  (void)hipMemsetAsync((char*)d_ws + WS_CTL, 0, 1 * MiB, stream);
  Params p{};
  for (int i = 0; i < 31; i++) p.in[i] = (const float*)d_in[i];
  p.out = (float*)d_out;
  p.ws = (unsigned char*)d_ws;
  void* args[] = {&p};
  hipError_t e = hipLaunchCooperativeKernel((void*)fwd_megakernel, dim3(grid_blocks), dim3(NWAVES * 64),
                                            args, LDS_BYTES, stream);
  if (e != hipSuccess)
    fprintf(stderr, "cooperative launch failed: %s (grid %d)\n", hipGetErrorString(e), grid_blocks);
}
```

```cpp
#include <hip/hip_runtime.h>
#include <hip/hip_cooperative_groups.h>
#include <cstdio>
namespace cg = cooperative_groups;

#define NT 16384
#define SEQ 4096
#define DM 1024
#define DIN 2304
#define NMEM 256
#define EPSF 1e-6f
#define NWAVES 8
#define LDS_BYTES 147456

typedef unsigned short bf16;
#define LAS __attribute__((address_space(3)))

struct Params {
  const float* in[31];
  float* out;
  unsigned char* ws;
};
typedef __attribute__((address_space(4))) const unsigned char* kaptr_t;
__device__ __forceinline__ const float* karg_in(int i) {
  kaptr_t ka = (kaptr_t)__builtin_amdgcn_kernarg_segment_ptr();
  asm volatile("" : "+s"(ka));
  return *(const float* __attribute__((address_space(4))) const*)(ka + 8 * i);
}

constexpr size_t MiB = 1u << 20;
constexpr size_t WS_CTL  = 0;
constexpr size_t WS_WT   = 1 * MiB;
constexpr size_t WT_IN = 0, WT_OUT = WT_IN + (size_t)DIN * DM * 2, WT_MQ = WT_OUT + (size_t)DM * DM * 2,
                 WT_MKV = WT_MQ + (size_t)DM * DM * 2, WT_MO = WT_MKV + (size_t)2048 * DM * 2,
                 WT_PQ = WT_MO + (size_t)DM * DM * 2, WT_GLU = WT_PQ + (size_t)2048 * DM * 2, WT_LAYER = WT_GLU + (size_t)256 * 256 * 2;
constexpr size_t WS_XW   = WS_WT + 2 * WT_LAYER;
constexpr size_t WS_XN   = WS_XW + (size_t)NT * DM * 4;
constexpr size_t WS_BIG  = WS_XN + (size_t)NT * DM * 2;
constexpr size_t WS_Y    = WS_BIG + (size_t)NT * DIN * 2;
constexpr size_t WS_MEMH = WS_Y + (size_t)NT * DM * 2;
constexpr size_t WS_KVB  = WS_MEMH + (size_t)2 * 1024 * 1024 * 2;
constexpr size_t WS_VT   = WS_KVB + (size_t)2 * 1024 * 2048 * 2;
constexpr size_t WS_SSME = WS_VT + (size_t)2 * 4 * 4 * 256 * 256 * 2;
#define SSMP_PER_LAYER (2048 + 2048 + 32768)
constexpr size_t WS_SSMP = WS_SSME + (size_t)4 * 64 * 16 * 64 * 2 * 4;
constexpr size_t WS_IDS  = WS_SSMP + (size_t)2 * SSMP_PER_LAYER * 4;
constexpr size_t WS_GATE = WS_IDS + (size_t)NT * 128 * 4;
constexpr size_t WS_SKB  = WS_GATE + (size_t)NT * 128 * 4;
constexpr size_t WS_UB   = WS_SKB + (size_t)2 * 8 * 2 * 128 * 128 * 2;
constexpr size_t WS_VB   = WS_UB + (size_t)2 * 16384 * 1024;
constexpr size_t WS_RST  = WS_VB + (size_t)2 * 16384 * 1024;
constexpr size_t WS_END  = WS_RST + (size_t)NT * 16 * 4;
#define U_SCALE 64.0f
#define V_SCALE 1.0f
static_assert(WS_END <= 512 * MiB, "workspace");
static_assert(WT_LAYER % 256 == 0 && WS_SSMP % 16 == 0 && WS_IDS % 16 == 0 && WS_SKB % 256 == 0 && WS_VT % 256 == 0, "align");

__device__ __forceinline__ int opaque_tid(int wave_s) { int v = wave_s * 64 + (int)__builtin_amdgcn_mbcnt_hi(~0u, __builtin_amdgcn_mbcnt_lo(~0u, 0u)); asm volatile("" : "+v"(v)); return v; }
__device__ __forceinline__ unsigned f2bf(float f) { unsigned u = __builtin_bit_cast(unsigned, f); return (u + 0x7fffu + ((u >> 16) & 1u)) >> 16; }
__device__ __forceinline__ unsigned pk2(float lo, float hi) { return f2bf(lo) | (f2bf(hi) << 16); }
__device__ __forceinline__ float bf_lo(unsigned u) { return __builtin_bit_cast(float, u << 16); }
__device__ __forceinline__ float bf_hi(unsigned u) { return __builtin_bit_cast(float, u & 0xffff0000u); }
__device__ __forceinline__ float bf2f(bf16 h) { return __builtin_bit_cast(float, (unsigned)h << 16); }


#define XB_TMO      128
#define XB_XCNT(j)  (256  + 64 * (j))
#define XB_XSUB(j)  (1280 + 64 * (j))
#define XB_XGEN(j)  (2304 + 64 * (j))
#define XB_TOP      3328
#define XB_TOPGEN   3392
#define XCD_BAR_WORDS 3456
#define XB_SPIN_CAP (1u << 22)
__device__ __forceinline__ unsigned xb_ld(unsigned* p)              { return __hip_atomic_load(p, __ATOMIC_RELAXED, __HIP_MEMORY_SCOPE_AGENT); }
__device__ __forceinline__ unsigned xb_add(unsigned* p, unsigned v) { return __hip_atomic_fetch_add(p, v, __ATOMIC_RELAXED, __HIP_MEMORY_SCOPE_AGENT); }
__device__ __forceinline__ unsigned xb_xcc_id() { return (unsigned)__builtin_amdgcn_s_getreg((3 << 11) | 20) & 0xFu; }
#define XB_SPIN(cond, bar) do { unsigned _sp = 0; while (cond) { __builtin_amdgcn_s_sleep(1); \
    if ((++_sp & 255u) == 0u) { if (xb_ld(&(bar)[XB_TMO])) break; if (_sp > XB_SPIN_CAP) { atomicAdd(&(bar)[XB_TMO], 1u); break; } } } } while (0)
struct XcdBarrier { unsigned* bar; unsigned x; volatile LAS unsigned* st; };
__device__ __forceinline__ XcdBarrier xcd_barrier_post(unsigned* bar, volatile LAS unsigned* st) {
    XcdBarrier b; b.bar = bar; b.x = xb_xcc_id(); b.st = st;
    if (threadIdx.x == 0) (void)xb_add(&bar[XB_XCNT(b.x)], 1u);
    return b;
}
__device__ __forceinline__ void xcd_barrier_complete(unsigned* bar, unsigned x, unsigned& nloc, unsigned& nx) {
    const unsigned G = gridDim.x * gridDim.y * gridDim.z;
    unsigned sum, cnt, mine, sp = 0u;
    for (;;) {
        sum = 0u; cnt = 0u; mine = 0u;
#pragma unroll
        for (unsigned j = 0; j < 16; ++j) { const unsigned c = xb_ld(&bar[XB_XCNT(j)]); sum += c; cnt += (c > 0u) ? 1u : 0u; mine = (j == x) ? c : mine; }
        if (sum == G) break;
        __builtin_amdgcn_s_sleep(1);
        if ((++sp & 255u) == 0u) { if (xb_ld(&bar[XB_TMO])) break; if (sp > XB_SPIN_CAP) { atomicAdd(&bar[XB_TMO], 1u); break; } }
    }
    nloc = mine > 0u ? mine : 1u; nx = cnt > 0u ? cnt : 1u;
}
__device__ __forceinline__ void xcd_barrier(const XcdBarrier& b) {
    asm volatile("s_waitcnt vmcnt(0)" ::: "memory");
    __syncthreads();
    if (threadIdx.x == 0) {
        unsigned* bar = b.bar;
        __builtin_amdgcn_s_waitcnt(0);
        unsigned nloc = b.st[0], nx = b.st[1];
        if (nloc == 0u) { xcd_barrier_complete(bar, b.x, nloc, nx); b.st[0] = nloc; b.st[1] = nx; }
        const unsigned old = xb_add(&bar[XB_XSUB(b.x)], 1u);
        const unsigned gen = old / nloc;
        if (old + 1u == (gen + 1u) * nloc) {
            __builtin_amdgcn_fence(__ATOMIC_RELEASE, "agent");
            asm volatile("s_waitcnt vmcnt(0)" ::: "memory");
            const unsigned og = xb_add(&bar[XB_TOP], 1u);
            const unsigned tg = og / nx;
            if (og + 1u == (tg + 1u) * nx) xb_add(&bar[XB_TOPGEN], 1u);
            else XB_SPIN(xb_ld(&bar[XB_TOPGEN]) == tg, bar);
            __builtin_amdgcn_fence(__ATOMIC_ACQUIRE, "agent");
            xb_add(&bar[XB_XGEN(b.x)], 1u);
            asm volatile("s_waitcnt vmcnt(0)" ::: "memory");
        } else {
            XB_SPIN(xb_ld(&bar[XB_XGEN(b.x)]) == gen, bar);
            __builtin_amdgcn_fence(__ATOMIC_ACQUIRE, "agent");
            asm volatile("s_waitcnt vmcnt(0)" ::: "memory");
        }
    }
    __syncthreads();
}

namespace pg8 {
#define PG8_LAS __attribute__((address_space(3)))
typedef unsigned short bf16_t;
typedef short bf16x8 __attribute__((ext_vector_type(8)));
typedef float f32x4 __attribute__((ext_vector_type(4)));
typedef unsigned u32x4 __attribute__((ext_vector_type(4)));
constexpr int BM = 256, BK = 64, HALF = 128, HTB = HALF * BK * 2, STAGE_BYTES = 8 * HTB, NXCD = 8, WGM = 8;
__host__ __device__ __forceinline__ int lds_byte(int r, int c) { const int st = (r >> 4) * 2 + (c >> 5), rr = r & 15, cc = c & 31, ob = rr * 64 + cc * 2; return st * 1024 + (ob ^ (((ob >> 9) & 1) << 5)); }
__host__ __device__ __forceinline__ void stage_rc(int b, int& R, int& C) { const int st = b / 1024, sb = b % 1024, swz = sb ^ (((sb >> 9) & 1) << 5); R = (st >> 1) * 16 + swz / 64; C = (st & 1) * 32 + (swz % 64) / 2; }
__host__ __device__ __forceinline__ int perm32(int rho) { const int n = rho >> 4, i = rho & 15; return 8 * (i >> 2) + 4 * n + (i & 3); }
struct Unit { int pm, pn; };
struct Gemm { const bf16_t* A; const bf16_t* Bt; int M, N, K; };
struct StaticOrder {
    int nM, nN, nwg, G, c;
    __host__ __device__ __forceinline__ void init(int M, int N, int G_, int c_) { nM = M / BM; nN = N / BM; nwg = nM * nN; G = G_; c = c_; }
    __host__ __device__ bool next(int i, Unit& u) const {
        const long L = (long)i * G + c; if (L >= nwg) return false;
        int wgid = (int)L; { const int q = nwg / NXCD, r = nwg % NXCD, xcd = wgid % NXCD, off = wgid / NXCD; wgid = (xcd < r ? xcd * (q + 1) : r * (q + 1) + (xcd - r) * q) + off; }
        const int nig = WGM * nN, gid = wgid / nig, fm = gid * WGM, gsz = (nM - fm) < WGM ? (nM - fm) : WGM;
        u.pm = fm + ((wgid % nig) % gsz); u.pn = (wgid % nig) / gsz; return true;
    }
    __device__ __forceinline__ void a_ready(const Unit&) const {}
    __device__ __forceinline__ void done(const Unit&) const {}
};
__device__ __forceinline__ unsigned cvt_pk_bf16(float lo, float hi) { unsigned r; asm volatile("v_cvt_pk_bf16_f32 %0, %1, %2" : "=v"(r) : "v"(lo), "v"(hi)); return r; }

struct EpiF32R {
    static constexpr bool PERM = false, AFTER_DRAIN = false;
    float* C; const float* R; int ldc;
    __device__ __forceinline__ void operator()(const f32x4 (&acc)[2][2][4][2], const Unit& u, int wr, int wc, int fr, int fq) const {
        const int row0 = u.pm * BM + wr * 64 + fr, col0 = u.pn * BM + wc * 32 + 4 * fq;
#pragma unroll
        for (int ai = 0; ai < 2; ++ai)
#pragma unroll
            for (int m = 0; m < 4; ++m) {
                const size_t ro = (size_t)(row0 + ai * HALF + m * 16) * ldc + col0;
                f32x4 rv[2][2];
#pragma unroll
                for (int bj = 0; bj < 2; ++bj)
#pragma unroll
                    for (int n = 0; n < 2; ++n) rv[bj][n] = R ? *(const f32x4*)(R + ro + bj * HALF + n * 16) : (f32x4){0.f, 0.f, 0.f, 0.f};
#pragma unroll
                for (int bj = 0; bj < 2; ++bj)
#pragma unroll
                    for (int n = 0; n < 2; ++n) *(f32x4*)(C + ro + bj * HALF + n * 16) = acc[ai][bj][m][n] + rv[bj][n];
                __builtin_amdgcn_sched_barrier(0);
            }
    }
};

struct EpiBf16 {
    static constexpr bool PERM = true, AFTER_DRAIN = false;
    bf16_t* O; int ldc;
    __device__ __forceinline__ void operator()(const f32x4 (&acc)[2][2][4][2], const Unit& u, int wr, int wc, int fr, int fq) const {
        const int row0 = u.pm * BM + wr * 64 + fr, col0 = u.pn * BM + wc * 32 + 8 * fq;
#pragma unroll
        for (int ai = 0; ai < 2; ++ai)
#pragma unroll
            for (int m = 0; m < 4; ++m) { bf16_t* rowp = O + (size_t)(row0 + ai * HALF + m * 16) * ldc + col0;
#pragma unroll
                for (int bj = 0; bj < 2; ++bj) { const f32x4 v0 = acc[ai][bj][m][0], v1 = acc[ai][bj][m][1];
                    u32x4 w; w.x = cvt_pk_bf16(v0[0], v0[1]); w.y = cvt_pk_bf16(v0[2], v0[3]); w.z = cvt_pk_bf16(v1[0], v1[1]); w.w = cvt_pk_bf16(v1[2], v1[3]);
                    *(u32x4*)(rowp + bj * HALF) = w; } }
    }
};

struct EpiF32RN {
    static constexpr bool PERM = false, AFTER_DRAIN = false;
    float* C; const float* R; int ldc; bf16_t* XG; const float* g; float* st;
    __device__ __forceinline__ void operator()(const f32x4 (&acc)[2][2][4][2], const Unit& u, int wr, int wc, int fr, int fq) const {
        const int row0 = u.pm * BM + wr * 64 + fr, col0 = u.pn * BM + wc * 32 + 4 * fq;
        f32x4 gv[2][2];
#pragma unroll
        for (int bj = 0; bj < 2; ++bj)
#pragma unroll
            for (int n = 0; n < 2; ++n) gv[bj][n] = *(const f32x4*)(g + col0 + bj * HALF + n * 16);
#pragma unroll
        for (int ai = 0; ai < 2; ++ai)
#pragma unroll
            for (int m = 0; m < 4; ++m) {
                const int row = row0 + ai * HALF + m * 16;
                const size_t ro = (size_t)row * ldc + col0;
                f32x4 rv[2][2];
#pragma unroll
                for (int bj = 0; bj < 2; ++bj)
#pragma unroll
                    for (int n = 0; n < 2; ++n) rv[bj][n] = *(const f32x4*)(R + ro + bj * HALF + n * 16);
                float ss = 0.f;
#pragma unroll
                for (int bj = 0; bj < 2; ++bj)
#pragma unroll
                    for (int n = 0; n < 2; ++n) {
                        const f32x4 v = acc[ai][bj][m][n] + rv[bj][n];
                        *(f32x4*)(C + ro + bj * HALF + n * 16) = v;
                        ss += (v[0] * v[0] + v[1] * v[1]) + (v[2] * v[2] + v[3] * v[3]);
                        const f32x4 w = v * gv[bj][n];
                        uint2 pk; pk.x = cvt_pk_bf16(w[0], w[1]); pk.y = cvt_pk_bf16(w[2], w[3]);
                        *(uint2*)(XG + ro + bj * HALF + n * 16) = pk;
                    }
                ss += __shfl_xor(ss, 16, 64); ss += __shfl_xor(ss, 32, 64);
                if (fq == 0) st[(size_t)row * 16 + u.pn * 4 + wc] = ss;
                __builtin_amdgcn_sched_barrier(0);
            }
    }
};
struct EpiBf16S {
    static constexpr bool PERM = true, AFTER_DRAIN = false;
    bf16_t* O; int ldc; const float* st;
    __device__ __forceinline__ void operator()(const f32x4 (&acc)[2][2][4][2], const Unit& u, int wr, int wc, int fr, int fq) const {
        const int row0 = u.pm * BM + wr * 64 + fr, col0 = u.pn * BM + wc * 32 + 8 * fq;
#pragma unroll
        for (int ai = 0; ai < 2; ++ai)
#pragma unroll
            for (int m = 0; m < 4; ++m) {
                const int row = row0 + ai * HALF + m * 16;
                const f32x4* sp = (const f32x4*)(st + (size_t)row * 16);
                const f32x4 s0 = sp[0], s1 = sp[1], s2 = sp[2], s3 = sp[3];
                const f32x4 sa = (s0 + s1) + (s2 + s3);
                const float rs = __builtin_amdgcn_rsqf(((sa[0] + sa[1]) + (sa[2] + sa[3])) * (1.0f / 1024.f) + 1e-6f);
                bf16_t* rowp = O + (size_t)row * ldc + col0;
#pragma unroll
                for (int bj = 0; bj < 2; ++bj) { const f32x4 v0 = acc[ai][bj][m][0] * rs, v1 = acc[ai][bj][m][1] * rs;
                    u32x4 w; w.x = cvt_pk_bf16(v0[0], v0[1]); w.y = cvt_pk_bf16(v0[2], v0[3]); w.z = cvt_pk_bf16(v1[0], v1[1]); w.w = cvt_pk_bf16(v1[2], v1[3]);
                    *(u32x4*)(rowp + bj * HALF) = w; }
                __builtin_amdgcn_sched_barrier(0);
            }
    }
};

template <class Epi, class Sched, bool ALIGN_EPI = false, bool SP2 = false>
__device__ __forceinline__ void gemm_phase(const int wave_s, PG8_LAS unsigned char* lds, const Gemm g, const Sched& S, const Epi& E) {
    const int tid = opaque_tid(wave_s), wid = __builtin_amdgcn_readfirstlane(tid >> 6), lane = tid & 63, wr = wid >> 2, wc = wid & 3, fr = lane & 15, fq = lane >> 4;
    const int K = g.K, nt = K / BK;
    unsigned voffA[2], voffB[2];
#pragma unroll
    for (int i = 0; i < 2; ++i) { int R, C; stage_rc(tid * 16 + i * 8192, R, C); const int Rb = Epi::PERM ? ((R & ~31) + perm32(R & 31)) : R;
        voffA[i] = (unsigned)(R * K + C) * 2u; voffB[i] = (unsigned)(Rb * K + C) * 2u; }
    const size_t kstep = (size_t)(BK * 2);
    const size_t hstep = (size_t)HALF * K * 2;
    const size_t tstep = 2 * hstep;
    const unsigned ldsw = (unsigned)wid * 1024u;
    const int aoff = lds_byte(wr * 64 + fr, fq * 8), boff = lds_byte(wc * 32 + fr, fq * 8);
#define PG8_SA(b, h) (((b) * 2 + (h)) * HTB)
#define PG8_SB(b, h) ((4 + (b) * 2 + (h)) * HTB)
#define PG8_STAGE(bufoff, gbase, voff) do { _Pragma("unroll") for (int _i = 0; _i < 2; ++_i) \
        __builtin_amdgcn_global_load_lds((const unsigned*)((const char*)(gbase) + (voff)[_i]), (PG8_LAS unsigned*)(lds + (bufoff) + ldsw + _i * 8192), 16, 0, 0); } while (0)
#define PG8_LDA(dst, b, h) do { _Pragma("unroll") for (int m = 0; m < 4; ++m) _Pragma("unroll") for (int k = 0; k < 2; ++k) dst[m][k] = *(const PG8_LAS bf16x8*)(lds + PG8_SA(b, h) + aoff + m * 2048 + k * 1024); } while (0)
#define PG8_LDB(dst, b, h) do { _Pragma("unroll") for (int n = 0; n < 2; ++n) _Pragma("unroll") for (int k = 0; k < 2; ++k) dst[n][k] = *(const PG8_LAS bf16x8*)(lds + PG8_SB(b, h) + boff + n * 2048 + k * 1024); } while (0)
#define PG8_MMA(ai, bj, At, Bt) do { __builtin_amdgcn_s_setprio(1); _Pragma("unroll") for (int m = 0; m < 4; ++m) _Pragma("unroll") for (int n = 0; n < 2; ++n) _Pragma("unroll") for (int k = 0; k < 2; ++k) \
        acc[ai][bj][m][n] = __builtin_amdgcn_mfma_f32_16x16x32_bf16(Bt[n][k], At[m][k], acc[ai][bj][m][n], 0, 0, 0); __builtin_amdgcn_s_setprio(0); } while (0)
#define PG8_WAIT_V(n) asm volatile("s_waitcnt vmcnt(" #n ")" ::: "memory")
#define PG8_WAIT_L(n) asm volatile("s_waitcnt lgkmcnt(" #n ")" ::: "memory")
#define PG8_BAR __builtin_amdgcn_s_barrier()
#define PG8_SCHED __builtin_amdgcn_sched_barrier(0)
    Unit cur, nxt; int ui = 0;
    if (!S.next(0, cur)) return;
    f32x4 acc[2][2][4][2];
#pragma unroll
    for (int a = 0; a < 2; ++a)
#pragma unroll
        for (int b = 0; b < 2; ++b)
#pragma unroll
            for (int m = 0; m < 4; ++m)
#pragma unroll
                for (int n = 0; n < 2; ++n) acc[a][b][m][n] = (f32x4){0.f, 0.f, 0.f, 0.f};
    bf16x8 At[4][2], B0[2][2], B1[2][2];
    const char* cA = (const char*)g.A + (size_t)cur.pm * tstep; const char* cB = (const char*)g.Bt + (size_t)cur.pn * tstep;
    S.a_ready(cur);
    if constexpr (SP2) {
        PG8_STAGE(PG8_SB(0, 0), cB, voffB); PG8_STAGE(PG8_SB(0, 1), cB + hstep, voffB); PG8_STAGE(PG8_SA(0, 0), cA, voffA); PG8_STAGE(PG8_SA(0, 1), cA + hstep, voffA);
        if (wr == 1) PG8_BAR;
        PG8_WAIT_V(2); PG8_BAR;
        PG8_STAGE(PG8_SB(1, 0), cB + kstep, voffB); PG8_STAGE(PG8_SA(1, 0), cA + kstep, voffA); PG8_STAGE(PG8_SB(1, 1), cB + hstep + kstep, voffB);
        PG8_WAIT_V(6); PG8_BAR;
    } else {
        PG8_STAGE(PG8_SB(0, 0), cB, voffB); PG8_STAGE(PG8_SA(0, 0), cA, voffA); PG8_STAGE(PG8_SB(0, 1), cB + hstep, voffB); PG8_STAGE(PG8_SA(0, 1), cA + hstep, voffA);
        if (wr == 1) PG8_BAR;
        PG8_WAIT_V(4); PG8_BAR;
        PG8_STAGE(PG8_SB(1, 0), cB + kstep, voffB); PG8_STAGE(PG8_SA(1, 0), cA + kstep, voffA); PG8_STAGE(PG8_SB(1, 1), cB + hstep + kstep, voffB);
        PG8_WAIT_V(6); PG8_BAR;
    }
    for (;;) {
        const bool has_next = S.next(ui + 1, nxt);
        const char* nA = has_next ? (const char*)g.A + (size_t)nxt.pm * tstep : cA; const char* nB = has_next ? (const char*)g.Bt + (size_t)nxt.pn * tstep : cB;
        for (int t = 0; t < nt; t += 2) {
            const bool last = (t == nt - 2);
            const char* a1 = cA + (size_t)(t + 1) * kstep;
            const char* a2 = last ? nA : cA + (size_t)(t + 2) * kstep; const char* b2 = last ? nB : cB + (size_t)(t + 2) * kstep;
            const char* a3 = a2 + kstep; const char* b3 = b2 + kstep;
            if (last && has_next) S.a_ready(nxt);
            if constexpr (SP2) {
            PG8_LDB(B0, 0, 0); PG8_LDB(B1, 0, 1); PG8_SCHED; PG8_LDA(At, 0, 0); PG8_STAGE(PG8_SA(1, 1), a1 + hstep, voffA);
            PG8_WAIT_V(8); PG8_WAIT_L(0); PG8_BAR; PG8_MMA(0, 0, At, B0); PG8_MMA(0, 1, At, B1); PG8_BAR; PG8_SCHED;
            PG8_LDA(At, 0, 1); PG8_STAGE(PG8_SB(0, 0), b2, voffB); PG8_STAGE(PG8_SB(0, 1), b2 + hstep, voffB); PG8_STAGE(PG8_SA(0, 0), a2, voffA);
            PG8_WAIT_V(8); PG8_WAIT_L(0); PG8_BAR; PG8_MMA(1, 0, At, B0); PG8_MMA(1, 1, At, B1); PG8_BAR; PG8_SCHED;
            PG8_LDB(B0, 1, 0); PG8_LDB(B1, 1, 1); PG8_SCHED; PG8_LDA(At, 1, 0); PG8_STAGE(PG8_SA(0, 1), a2 + hstep, voffA);
            PG8_WAIT_V(8); PG8_WAIT_L(0); PG8_BAR; PG8_MMA(0, 0, At, B0); PG8_MMA(0, 1, At, B1); PG8_BAR; PG8_SCHED;
            PG8_LDA(At, 1, 1); PG8_STAGE(PG8_SB(1, 0), b3, voffB); PG8_STAGE(PG8_SB(1, 1), b3 + hstep, voffB); PG8_STAGE(PG8_SA(1, 0), a3, voffA);
            PG8_WAIT_V(8); PG8_WAIT_L(0); PG8_BAR; PG8_MMA(1, 0, At, B0); PG8_MMA(1, 1, At, B1); PG8_BAR; PG8_SCHED;
            } else {
            PG8_LDB(B0, 0, 0); PG8_SCHED; PG8_LDA(At, 0, 0); PG8_STAGE(PG8_SA(1, 1), a1 + hstep, voffA);
            PG8_WAIT_L(8); PG8_BAR; PG8_WAIT_L(0); PG8_MMA(0, 0, At, B0); PG8_BAR; PG8_SCHED;
            PG8_LDB(B1, 0, 1); PG8_STAGE(PG8_SB(0, 0), b2, voffB);
            PG8_BAR; PG8_WAIT_L(0); PG8_MMA(0, 1, At, B1); PG8_BAR;
            PG8_LDA(At, 0, 1); PG8_STAGE(PG8_SA(0, 0), a2, voffA);
            PG8_BAR; PG8_WAIT_L(0); PG8_MMA(1, 0, At, B0); PG8_BAR; PG8_SCHED;
            PG8_STAGE(PG8_SB(0, 1), b2 + hstep, voffB);
            PG8_WAIT_V(6); PG8_BAR; PG8_MMA(1, 1, At, B1); PG8_BAR;
            PG8_LDB(B0, 1, 0); PG8_SCHED; PG8_LDA(At, 1, 0); PG8_STAGE(PG8_SA(0, 1), a2 + hstep, voffA);
            PG8_WAIT_L(8); PG8_BAR; PG8_WAIT_L(0); PG8_MMA(0, 0, At, B0); PG8_BAR; PG8_SCHED;
            PG8_LDB(B1, 1, 1); PG8_STAGE(PG8_SB(1, 0), b3, voffB);
            PG8_BAR; PG8_WAIT_L(0); PG8_MMA(0, 1, At, B1); PG8_BAR;
            PG8_LDA(At, 1, 1); PG8_STAGE(PG8_SA(1, 0), a3, voffA);
            PG8_BAR; PG8_WAIT_L(0); PG8_MMA(1, 0, At, B0); PG8_BAR; PG8_SCHED;
            PG8_STAGE(PG8_SB(1, 1), b3 + hstep, voffB);
            PG8_WAIT_V(6); PG8_BAR; PG8_MMA(1, 1, At, B1); PG8_BAR;
            }
        }
        if constexpr (ALIGN_EPI) { if (wr == 0) PG8_BAR; }
        if constexpr (!Epi::AFTER_DRAIN) { E(acc, cur, wr, wc, fr, fq); S.done(cur); }
        if (!has_next) break;
#pragma unroll
        for (int a = 0; a < 2; ++a)
#pragma unroll
            for (int b = 0; b < 2; ++b)
#pragma unroll
                for (int m = 0; m < 4; ++m)
#pragma unroll
                    for (int n = 0; n < 2; ++n) acc[a][b][m][n] = (f32x4){0.f, 0.f, 0.f, 0.f};
        cur = nxt; cA = nA; cB = nB; ++ui;
        if constexpr (ALIGN_EPI) { if (wr == 1) PG8_BAR; }
    }
    PG8_WAIT_V(0);
    if constexpr (!ALIGN_EPI) { if (wr == 0) PG8_BAR; }
    PG8_BAR;
#undef PG8_SA
#undef PG8_SB
#undef PG8_STAGE
#undef PG8_LDA
#undef PG8_LDB
#undef PG8_MMA
#undef PG8_WAIT_V
#undef PG8_WAIT_L
#undef PG8_BAR
#undef PG8_SCHED
}
}

__device__ __forceinline__ void transpose_item(const float* W, int K, int N, bf16* WT, LAS float* scr, int item, int lane) {
    const int nblk = N / 32, kb = item / nblk, nb = item % nblk, k0 = 64 * kb, n0 = 32 * nb;
#pragma unroll 8
    for (int i = 0; i < 32; ++i) { const int kk = 2 * i + (lane >> 5); scr[kk * 33 + (lane & 31)] = W[(size_t)(k0 + kk) * N + n0 + (lane & 31)]; }
    asm volatile("s_waitcnt lgkmcnt(0)" ::: "memory");
    const int c = lane & 7;
#pragma unroll
    for (int j = 0; j < 4; ++j) { const int n = (lane >> 3) + 8 * j; const LAS float* s = scr + (8 * c) * 33 + n;
        uint4 o; o.x = pk2(s[0 * 33], s[1 * 33]); o.y = pk2(s[2 * 33], s[3 * 33]); o.z = pk2(s[4 * 33], s[5 * 33]); o.w = pk2(s[6 * 33], s[7 * 33]);
        *(uint4*)(WT + (size_t)(n0 + n) * K + k0 + 8 * c) = o; }
    asm volatile("s_waitcnt lgkmcnt(0)" ::: "memory");
}

__device__ __forceinline__ float wsum(float v) {
#pragma unroll
  for (int o = 32; o > 0; o >>= 1) v += __shfl_xor(v, o, 64);
  return v;
}
__device__ __forceinline__ float wmaxf(float v) {
#pragma unroll
  for (int o = 32; o > 0; o >>= 1) v = fmaxf(v, __shfl_xor(v, o, 64));
  return v;
}
__device__ __forceinline__ float sigmoidf_(float x) { return 1.0f / (1.0f + expf(-x)); }
__device__ __forceinline__ float gelu_tanh(float x) {
  return 0.5f * x * (1.0f + tanhf(0.7978845608028654f * (x + 0.044715f * x * x * x)));
}

template <bool BF16OUT>
__device__ __forceinline__ void rms_rows(const int wave_s, const float* src, const float* g, void* dstv, int rows) {
  const int tid_ = opaque_tid(wave_s);
  const int lane = tid_ & 63;
  const int gw = blockIdx.x * NWAVES + (tid_ >> 6);
  const int nw = gridDim.x * NWAVES;
  for (int r = gw; r < rows; r += nw) {
    const float4* s4 = (const float4*)(src + (size_t)r * DM);
    float4 v[4];
    float ss = 0.f;
#pragma unroll
    for (int i = 0; i < 4; i++) {
      v[i] = s4[lane + i * 64];
      ss += v[i].x * v[i].x + v[i].y * v[i].y + v[i].z * v[i].z + v[i].w * v[i].w;
    }
    ss = wsum(ss);
    const float rstd = rsqrtf(ss * (1.0f / DM) + EPSF);
    const float4* g4 = (const float4*)g;
#pragma unroll
    for (int i = 0; i < 4; i++) {
      float4 gg = g4[lane + i * 64];
      float4 o;
      o.x = v[i].x * rstd * gg.x; o.y = v[i].y * rstd * gg.y;
      o.z = v[i].z * rstd * gg.z; o.w = v[i].w * rstd * gg.w;
      if (BF16OUT) {
        uint2 pk; pk.x = pk2(o.x, o.y); pk.y = pk2(o.z, o.w);
        ((uint2*)((bf16*)dstv + (size_t)r * DM))[lane + i * 64] = pk;
      } else {
        ((float4*)((float*)dstv + (size_t)r * DM))[lane + i * 64] = o;
      }
    }
  }
}

__device__ __forceinline__ void ssm_params(const int wave_s, const Params& p, float* ssmp_all) {
  const int tid_ = opaque_tid(wave_s);
  const float* in8 = karg_in(8); const float* in9 = karg_in(9); const float* in10 = karg_in(10);
  const float* in11 = karg_in(11); const float* in12 = karg_in(12);
  const int gt = blockIdx.x * blockDim.x + tid_;
  const int nth = gridDim.x * blockDim.x;
  for (int i = gt; i < 2 * 16 * 64; i += nth) {
    const int l = i / 1024, gp = i % 1024, g = gp / 64;
    float* sp = ssmp_all + (size_t)l * SSMP_PER_LAYER;
    const float lre = fminf(in8[l * 1024 + gp], -1e-4f);
    const float lim = in9[l * 1024 + gp];
    const float dt = expf(in10[l * 16 + g]);
    const float er = expf(lre * dt);
    float sn, cs;
    sincosf(lim * dt, &sn, &cs);
    const float br = er * cs, bi = er * sn;
    sp[gp * 2 + 0] = br;
    sp[gp * 2 + 1] = bi;
    float cr = br, ci = bi;
#pragma unroll
    for (int s = 0; s < 6; s++) {
      const float nr = cr * cr - ci * ci, ni = 2.f * cr * ci;
      cr = nr; ci = ni;
    }
    sp[2048 + gp * 2 + 0] = cr;
    sp[2048 + gp * 2 + 1] = ci;
    const float nr = br - 1.0f, ni = bi;
    const float den = lre * lre + lim * lim;
    const float fr = (nr * lre + ni * lim) / den;
    const float fi = (ni * lre - nr * lim) / den;
    for (int h = 0; h < 16; h++) {
      const float bre = in11[((size_t)l * 1024 + gp) * 16 + h];
      const float bim = in12[((size_t)l * 1024 + gp) * 16 + h];
      sp[4096 + ((g * 16 + h) * 64 + (gp & 63)) * 2 + 0] = fr * bre - fi * bim;
      sp[4096 + ((g * 16 + h) * 64 + (gp & 63)) * 2 + 1] = fr * bim + fi * bre;
    }
  }
}

__device__ __forceinline__ void conv_phase(const int wave_s, const Params& p, int l, const bf16* proj, bf16* y, LAS float* smem) {
  const int tid_ = opaque_tid(wave_s);
  const int lane = tid_ & 63;
  const int gw = blockIdx.x * NWAVES + (tid_ >> 6);
  const int nw = gridDim.x * NWAVES;
  const float* cw = karg_in(4) + (size_t)l * 31 * 256;
  const float4 cb = ((const float4*)(karg_in(5) + l * 256))[lane];
  const float4 lg = ((const float4*)(karg_in(6) + l * 256))[lane];
  const float4 lb = ((const float4*)(karg_in(7) + l * 256))[lane];
  const float4 gg = ((const float4*)(karg_in(18) + l * 1024))[lane];
  LAS float* cwl = smem + 1024;
  for (int i = tid_; i < 31 * 256 / 4; i += NWAVES * 64) *(LAS pg8::f32x4*)(cwl + 4 * i) = *(const pg8::f32x4*)(cw + 4 * i);
  __syncthreads();
  for (int it = gw; it < NT / 8; it += nw) {
    const int tok0 = it * 8;
    const int t0 = tok0 & (SEQ - 1);
    float4 acc[8];
#pragma unroll
    for (int o = 0; o < 8; o++) acc[o] = cb;
#pragma unroll
    for (int i = 0; i < 38; i++) {
      if (t0 - 30 + i >= 0) {
        const bf16* row = proj + (size_t)(tok0 - 30 + i) * DIN;
        const uint2 vp = ((const uint2*)row)[lane];
        const uint2 gp = ((const uint2*)(row + 256))[lane];
        float4 g4;
        g4.x = bf_lo(vp.x) * sigmoidf_(bf_lo(gp.x)); g4.y = bf_hi(vp.x) * sigmoidf_(bf_hi(gp.x));
        g4.z = bf_lo(vp.y) * sigmoidf_(bf_lo(gp.y)); g4.w = bf_hi(vp.y) * sigmoidf_(bf_hi(gp.y));
#pragma unroll
        for (int o = 0; o < 8; o++) {
          const int j = i - o;
          if (j >= 0 && j <= 30) {
            const pg8::f32x4 w4 = *(const LAS pg8::f32x4*)(cwl + j * 256 + lane * 4);
            acc[o].x += g4.x * w4[0]; acc[o].y += g4.y * w4[1];
            acc[o].z += g4.z * w4[2]; acc[o].w += g4.w * w4[3];
          }
        }
      }
    }
#pragma unroll
    for (int o = 0; o < 8; o++) {
      const float4 a = acc[o];
      const float mean = wsum(a.x + a.y + a.z + a.w) * (1.0f / 256.f);
      const float dx = a.x - mean, dy = a.y - mean, dz = a.z - mean, dw = a.w - mean;
      const float var = wsum(dx * dx + dy * dy + dz * dz + dw * dw) * (1.0f / 256.f);
      const float rs = rsqrtf(var + EPSF);
      float4 s;
      s.x = dx * rs * lg.x + lb.x; s.y = dy * rs * lg.y + lb.y;
      s.z = dz * rs * lg.z + lb.z; s.w = dw * rs * lg.w + lb.w;
      s.x = s.x * sigmoidf_(s.x); s.y = s.y * sigmoidf_(s.y);
      s.z = s.z * sigmoidf_(s.z); s.w = s.w * sigmoidf_(s.w);
      const float ss = wsum(s.x * s.x + s.y * s.y + s.z * s.z + s.w * s.w) * (1.0f / 256.f);
      const float r2 = rsqrtf(ss + EPSF);
      uint2 pk; pk.x = pk2(s.x * r2 * gg.x, s.y * r2 * gg.y); pk.y = pk2(s.z * r2 * gg.z, s.w * r2 * gg.w);
      ((uint2*)(y + (size_t)(tok0 + o) * DM))[lane] = pk;
    }
  }
}

typedef short bf16x8_t __attribute__((ext_vector_type(8)));
typedef float f32x16_t __attribute__((ext_vector_type(16)));
#define MFMA_PAD() do { __builtin_amdgcn_sched_barrier(0); asm volatile("s_nop 15\n\ts_nop 15" ::: "memory"); __builtin_amdgcn_sched_barrier(0); } while (0)

__device__ __forceinline__ void attn_phase(const int wave_s, const Params& p, int l, const bf16* proj, bf16* y, LAS float* smem) {
  const int tid = opaque_tid(wave_s), lane = tid & 63, wave = tid >> 6;
  const int n = lane & 31, hh = lane >> 5;
  const float* gg = karg_in(18) + l * 1024 + 256 + wave * 64;
  const float g0 = gg[n], g1 = gg[32 + n];
  LAS float* ssq = smem;
  LAS float* rstd = smem + 256;
  for (int item = blockIdx.x; item < 4 * 128; item += gridDim.x) {
    const int b = item >> 7, q0 = (item & 127) * 32;
    const size_t tokb = (size_t)b * SEQ;
    bf16x8_t qf[4];
    {
      const bf16* qrow = proj + (tokb + q0 + n) * DIN + 512 + wave * 64 + 8 * hh;
#pragma unroll
      for (int ks = 0; ks < 4; ks++) qf[ks] = *(const bf16x8_t*)(qrow + 16 * ks);
    }
    f32x16_t o0, o1;
#pragma unroll
    for (int r = 0; r < 16; r++) { o0[r] = 0.f; o1[r] = 0.f; }
    float R = 0.f;
    for (int kt = q0; kt >= 0; kt -= 32) {
      bf16x8_t kf[4];
      {
        const bf16* krow = proj + (tokb + kt + n) * DIN + 1024 + wave * 64 + 8 * hh;
#pragma unroll
        for (int ks = 0; ks < 4; ks++) kf[ks] = *(const bf16x8_t*)(krow + 16 * ks);
      }
      bf16x8_t vf0[2], vf1[2];
      {
        const bf16* vb = proj + (tokb + kt + 4 * hh) * DIN + 1536 + wave * 64 + n;
#pragma unroll
        for (int s = 0; s < 2; s++)
#pragma unroll
          for (int j = 0; j < 8; j++) {
            const int key = 16 * s + 8 * (j >> 2) + (j & 3);
            vf0[s][j] = (short)vb[(size_t)key * DIN];
            vf1[s][j] = (short)vb[(size_t)key * DIN + 32];
          }
      }
      f32x16_t sacc;
#pragma unroll
      for (int r = 0; r < 16; r++) sacc[r] = 0.f;
      __builtin_amdgcn_sched_barrier(0); asm volatile("s_nop 15\n\ts_nop 15" ::: "memory"); __builtin_amdgcn_sched_barrier(0);
#pragma unroll
      for (int ks = 0; ks < 4; ks++) sacc = __builtin_amdgcn_mfma_f32_32x32x16_bf16(kf[ks], qf[ks], sacc, 0, 0, 0);
      __builtin_amdgcn_sched_barrier(0); asm volatile("s_nop 15\n\ts_nop 15" ::: "memory"); __builtin_amdgcn_sched_barrier(0);
      float lst[16], lsz[16];
      const bool diag = (kt == q0);
#pragma unroll
      for (int r = 0; r < 16; r++) {
        const float z = sacc[r] * 0.125f;
        const float sp = __logf(1.0f + __expf(-fabsf(z)));
        float a = fminf(z, 0.f) - sp;
        float c = -(fmaxf(z, 0.f) + sp);
        if (diag) {
          const int key = (r & 3) + 8 * (r >> 2) + 4 * hh;
          if (key >= n) { a = -1.0e30f; c = 0.f; }
        }
        lsz[r] = a; lst[r] = c;
      }
      float Gs[4], Gp[4];
#pragma unroll
      for (int g = 0; g < 4; g++) {
        Gs[g] = (lst[4 * g] + lst[4 * g + 1]) + (lst[4 * g + 2] + lst[4 * g + 3]);
        Gp[g] = __shfl_xor(Gs[g], 32, 64);
      }
      float carry[4];
      {
        float after = R;
#pragma unroll
        for (int g = 3; g >= 0; g--) {
          carry[g] = after + (hh ? 0.f : Gp[g]);
          after += Gs[g] + Gp[g];
        }
        R = after;
      }
      bf16x8_t pf[2];
#pragma unroll
      for (int g = 0; g < 4; g++) {
        float run = carry[g];
        float a3 = __expf(lsz[4 * g + 3] + run); run += lst[4 * g + 3];
        float a2 = __expf(lsz[4 * g + 2] + run); run += lst[4 * g + 2];
        float a1 = __expf(lsz[4 * g + 1] + run); run += lst[4 * g + 1];
        float a0 = __expf(lsz[4 * g + 0] + run);
        const int s = g >> 1, jb = (g & 1) * 4;
        pf[s][jb + 0] = (short)f2bf(a0); pf[s][jb + 1] = (short)f2bf(a1);
        pf[s][jb + 2] = (short)f2bf(a2); pf[s][jb + 3] = (short)f2bf(a3);
      }
      __builtin_amdgcn_sched_barrier(0); asm volatile("s_nop 15\n\ts_nop 15" ::: "memory"); __builtin_amdgcn_sched_barrier(0);
#pragma unroll
      for (int s = 0; s < 2; s++) {
        o0 = __builtin_amdgcn_mfma_f32_32x32x16_bf16(pf[s], vf0[s], o0, 0, 0, 0);
        o1 = __builtin_amdgcn_mfma_f32_32x32x16_bf16(pf[s], vf1[s], o1, 0, 0, 0);
      }
      __builtin_amdgcn_sched_barrier(0); asm volatile("s_nop 15\n\ts_nop 15" ::: "memory"); __builtin_amdgcn_sched_barrier(0);
      if (__all(R < -110.f)) break;
    }
    float sq[16];
#pragma unroll
    for (int r = 0; r < 16; r++) {
      float v = o0[r] * o0[r] + o1[r] * o1[r];
#pragma unroll
      for (int o = 16; o > 0; o >>= 1) v += __shfl_xor(v, o, 64);
      sq[r] = v;
    }
    __syncthreads();
    if (n == 0) {
#pragma unroll
      for (int r = 0; r < 16; r++) ssq[wave * 32 + (r & 3) + 8 * (r >> 2) + 4 * hh] = sq[r];
    }
    __syncthreads();
    if (tid < 32) {
      float t = 0.f;
#pragma unroll
      for (int w = 0; w < 8; w++) t += ssq[w * 32 + tid];
      rstd[tid] = rsqrtf(t * (1.0f / 512.f) + EPSF);
    }
    __syncthreads();
#pragma unroll
    for (int r = 0; r < 16; r++) {
      const int qi = (r & 3) + 8 * (r >> 2) + 4 * hh;
      const float rs = rstd[qi];
      bf16* yr = y + (tokb + q0 + qi) * DM + 256 + wave * 64 + n;
      yr[0] = (bf16)f2bf(o0[r] * rs * g0);
      yr[32] = (bf16)f2bf(o1[r] * rs * g1);
    }
  }
}

#define SSM_BCAST_U(u, ua, ub, tt) do { \
    const unsigned w0 = (unsigned)__builtin_amdgcn_readlane((int)(ua).x, (tt)), w1 = (unsigned)__builtin_amdgcn_readlane((int)(ua).y, (tt)); \
    const unsigned w2 = (unsigned)__builtin_amdgcn_readlane((int)(ua).z, (tt)), w3 = (unsigned)__builtin_amdgcn_readlane((int)(ua).w, (tt)); \
    const unsigned w4 = (unsigned)__builtin_amdgcn_readlane((int)(ub).x, (tt)), w5 = (unsigned)__builtin_amdgcn_readlane((int)(ub).y, (tt)); \
    const unsigned w6 = (unsigned)__builtin_amdgcn_readlane((int)(ub).z, (tt)), w7 = (unsigned)__builtin_amdgcn_readlane((int)(ub).w, (tt)); \
    (u)[0] = bf_lo(w0); (u)[1] = bf_hi(w0); (u)[2] = bf_lo(w1); (u)[3] = bf_hi(w1); (u)[4] = bf_lo(w2); (u)[5] = bf_hi(w2); (u)[6] = bf_lo(w3); (u)[7] = bf_hi(w3); \
    (u)[8] = bf_lo(w4); (u)[9] = bf_hi(w4); (u)[10] = bf_lo(w5); (u)[11] = bf_hi(w5); (u)[12] = bf_lo(w6); (u)[13] = bf_hi(w6); (u)[14] = bf_lo(w7); (u)[15] = bf_hi(w7); } while (0)
__device__ __forceinline__ void ssm_chunk_end(const int wave_s, const float* ssmp, const bf16* proj, float* ssmE) {
  const int tid_ = opaque_tid(wave_s);
  const int lane = tid_ & 63;
  const int gw = blockIdx.x * NWAVES + (tid_ >> 6);
  const int nw = gridDim.x * NWAVES;
  for (int it = gw; it < 4 * 64 * 16; it += nw) {
    const int g = it & 15, c = (it >> 4) & 63, b = it >> 10;
    const int gp = g * 64 + lane;
    const uint4* up = (const uint4*)(proj + (size_t)(b * SEQ + c * 64 + lane) * DIN + 2048 + g * 16);
    const uint4 ua = up[0], ub = up[1];
    const float lbr = ssmp[gp * 2], lbi = ssmp[gp * 2 + 1];
    float bbr[16], bbi[16];
#pragma unroll
    for (int h = 0; h < 16; h++) {
      { const float2 bb = *(const float2*)(ssmp + 4096 + ((g * 16 + h) * 64 + lane) * 2); bbr[h] = bb.x; bbi[h] = bb.y; }
    }
    float xr = 0.f, xi = 0.f;
#pragma unroll 2
    for (int tt = 0; tt < 64; tt++) {
      float u[16];
      SSM_BCAST_U(u, ua, ub, tt);
      float br = 0.f, bi = 0.f;
#pragma unroll
      for (int h = 0; h < 16; h++) { br += bbr[h] * u[h]; bi += bbi[h] * u[h]; }
      const float nr = lbr * xr - lbi * xi + br;
      const float ni = lbr * xi + lbi * xr + bi;
      xr = nr; xi = ni;
    }
    float* e = ssmE + ((size_t)((b * 64 + c) * 16 + g) * 64 + lane) * 2;
    e[0] = xr; e[1] = xi;
  }
}

__device__ __forceinline__ void ssm_finish(const int wave_s, const Params& p, int l, const float* ssmp, const bf16* proj,
                           const float* ssmE, bf16* y, LAS float* smem) {
  LAS bf16* Ytb = (LAS bf16*)smem;
  LAS float* ssq2 = smem + (64 * 264 * 2) / 4;
  LAS float* rstd2 = ssq2 + 512;
  const bf16* glT = (const bf16*)(p.ws + WS_WT + (size_t)l * WT_LAYER + WT_GLU);
  const int tid = opaque_tid(wave_s), lane = tid & 63, wave = tid >> 6;
  const float* cre = karg_in(13) + (size_t)l * 16 * 16 * 64;
  const float* cim = karg_in(14) + (size_t)l * 16 * 16 * 64;
  const float* dsk = karg_in(15) + l * 256;
  const float* glw = karg_in(16) + (size_t)l * 256 * 256;
  const float* glb = karg_in(17) + l * 256;
  const float* gg = karg_in(18) + l * 1024 + 768;
  for (int it = blockIdx.x; it < 256; it += gridDim.x) {
    const int b = it >> 6, c = it & 63;
    __syncthreads();
    for (int gi = 0; gi < 2; gi++) {
      const int g = wave + gi * 8;
      const int gp = g * 64 + lane;
      const float lbr = ssmp[gp * 2], lbi = ssmp[gp * 2 + 1];
      const float lcr = ssmp[2048 + gp * 2], lci = ssmp[2048 + gp * 2 + 1];
      float bbr[16], bbi[16], ccr[16], cci[16];
#pragma unroll
      for (int h = 0; h < 16; h++) {
        { const float2 bb = *(const float2*)(ssmp + 4096 + ((g * 16 + h) * 64 + lane) * 2); bbr[h] = bb.x; bbi[h] = bb.y; }
        ccr[h] = cre[(g * 16 + h) * 64 + lane];
        cci[h] = cim[(g * 16 + h) * 64 + lane];
      }
      float xr = 0.f, xi = 0.f;
      {
        const float2* eb = (const float2*)ssmE + ((size_t)(b * 64) * 16 + g) * 64 + lane;
        int cc = 0;
        for (; cc + 8 <= c; cc += 8) {
          float2 ev[8];
#pragma unroll
          for (int k = 0; k < 8; k++) ev[k] = eb[(size_t)(cc + k) * 16 * 64];
#pragma unroll
          for (int k = 0; k < 8; k++) {
            const float nr = lcr * xr - lci * xi + ev[k].x;
            const float ni = lcr * xi + lci * xr + ev[k].y;
            xr = nr; xi = ni;
          }
        }
        for (; cc < c; cc++) {
          const float2 e1 = eb[(size_t)cc * 16 * 64];
          const float nr = lcr * xr - lci * xi + e1.x;
          const float ni = lcr * xi + lci * xr + e1.y;
          xr = nr; xi = ni;
        }
      }
      const int hq = ((lane >> 5) & 1) * 8 + ((lane >> 4) & 1) * 4 + ((lane >> 3) & 1) * 2 + ((lane >> 2) & 1);
      float dm[16];
#pragma unroll
      for (int h = 0; h < 16; h++) dm[h] = (lane == 0) ? dsk[g * 16 + h] : 0.f;
      const uint4* up = (const uint4*)(proj + (size_t)(b * SEQ + c * 64 + lane) * DIN + 2048 + g * 16);
      const uint4 ua = up[0], ub = up[1];
#pragma unroll 1
      for (int t4 = 0; t4 < 64; t4 += 4) {
        float vv[4][16];
#pragma unroll
        for (int s = 0; s < 4; s++) {
          float u[16];
          SSM_BCAST_U(u, ua, ub, t4 + s);
          float br = 0.f, bi = 0.f;
#pragma unroll
          for (int h = 0; h < 16; h++) { br += bbr[h] * u[h]; bi += bbi[h] * u[h]; }
          const float nr = lbr * xr - lbi * xi + br;
          const float ni = lbr * xi + lbi * xr + bi;
          xr = nr; xi = ni;
#pragma unroll
          for (int h = 0; h < 16; h++) vv[s][h] = xr * ccr[h] - xi * cci[h] + dm[h] * u[h];
        }
        float v1[4];
#pragma unroll
        for (int s = 0; s < 4; s++) {
          float v8[8], v4[4], v2[2];
          {
            const bool hi = (lane & 32) != 0;
#pragma unroll
            for (int i = 0; i < 8; i++) { const float send = hi ? vv[s][i] : vv[s][i + 8]; const float keep = hi ? vv[s][i + 8] : vv[s][i]; v8[i] = keep + __shfl_xor(send, 32, 64); }
          }
          {
            const bool hi = (lane & 16) != 0;
#pragma unroll
            for (int i = 0; i < 4; i++) { const float send = hi ? v8[i] : v8[i + 4]; const float keep = hi ? v8[i + 4] : v8[i]; v4[i] = keep + __shfl_xor(send, 16, 64); }
          }
          {
            const bool hi = (lane & 8) != 0;
#pragma unroll
            for (int i = 0; i < 2; i++) { const float send = hi ? v4[i] : v4[i + 2]; const float keep = hi ? v4[i + 2] : v4[i]; v2[i] = keep + __shfl_xor(send, 8, 64); }
          }
          {
            const bool hi = (lane & 4) != 0;
            const float send = hi ? v2[0] : v2[1];
            const float keep = hi ? v2[1] : v2[0];
            v1[s] = keep + __shfl_xor(send, 4, 64);
          }
          v1[s] += __shfl_xor(v1[s], 2, 64);
          v1[s] += __shfl_xor(v1[s], 1, 64);
        }
        if ((lane & 3) == 0) {
#pragma unroll
          for (int s = 0; s < 4; s++) Ytb[(t4 + s) * 264 + g * 16 + hq] = (bf16)f2bf(gelu_tanh(v1[s]));
        }
      }
    }
    __syncthreads();
    {
      const int n = lane & 31, hh = lane >> 5;
      const int ch = wave * 32 + n;
      const float bj = glb[ch];
      const float gj = gg[ch];
      bf16x8_t gf[16];
      {
        const bf16* grow = glT + (size_t)ch * 256 + 8 * hh;
#pragma unroll
        for (int ks = 0; ks < 16; ks++) gf[ks] = *(const bf16x8_t*)(grow + 16 * ks);
      }
      float oo[2][16];
#pragma unroll
      for (int mt = 0; mt < 2; mt++) {
        f32x16_t z;
#pragma unroll
        for (int r = 0; r < 16; r++) z[r] = 0.f;
        const LAS bf16* yrow = Ytb + (mt * 32 + n) * 264 + 8 * hh;
#pragma unroll
        for (int kq = 0; kq < 4; kq++) {
          bf16x8_t yf[4];
#pragma unroll
          for (int i = 0; i < 4; i++) yf[i] = *(const LAS bf16x8_t*)(yrow + 16 * (kq * 4 + i));
          MFMA_PAD();
#pragma unroll
          for (int i = 0; i < 4; i++) z = __builtin_amdgcn_mfma_f32_32x32x16_bf16(yf[i], gf[kq * 4 + i], z, 0, 0, 0);
          MFMA_PAD();
        }
        float sq[16];
#pragma unroll
        for (int r = 0; r < 16; r++) {
          const int t = mt * 32 + (r & 3) + 8 * (r >> 2) + 4 * hh;
          const float yv = bf2f(Ytb[t * 264 + ch]);
          const float o = yv * sigmoidf_(z[r] + bj);
          oo[mt][r] = o;
          float v = o * o;
#pragma unroll
          for (int s = 16; s > 0; s >>= 1) v += __shfl_xor(v, s, 64);
          sq[r] = v;
        }
        if (n == 0) {
#pragma unroll
          for (int r = 0; r < 16; r++) ssq2[wave * 64 + mt * 32 + (r & 3) + 8 * (r >> 2) + 4 * hh] = sq[r];
        }
      }
      __syncthreads();
      if (tid < 64) {
        float t = 0.f;
#pragma unroll
        for (int w = 0; w < 8; w++) t += ssq2[w * 64 + tid];
        rstd2[tid] = rsqrtf(t * (1.0f / 256.f) + EPSF);
      }
      __syncthreads();
#pragma unroll
      for (int mt = 0; mt < 2; mt++)
#pragma unroll
        for (int r = 0; r < 16; r++) {
          const int t = mt * 32 + (r & 3) + 8 * (r >> 2) + 4 * hh;
          y[(size_t)(b * SEQ + c * 64 + t) * DM + 768 + ch] = (bf16)f2bf(oo[mt][r] * rstd2[t] * gj);
        }
    }
  }
}

__device__ __forceinline__ void memattn_phase(const int wave_s, const bf16* q, const bf16* kvb, const bf16* vT, bf16* o, LAS float* smem) {
  const int tid_ = opaque_tid(wave_s);
  const int lane = tid_ & 63, n = lane & 31, hh = lane >> 5, wave = tid_ >> 6;
  const int sig = (n & 0x13) | ((n & 4) << 1) | ((n & 8) >> 1);
  LAS bf16* Ls = (LAS bf16*)smem;
  for (int it = blockIdx.x; it < 64 * 4; it += gridDim.x) {
    const int h = it & 3, tg = it >> 2, b = tg >> 4;
    const int tok0 = (tg * 8 + wave) * 32;
    __syncthreads();
    {
      const int r = tid_ >> 1, hf = tid_ & 1;
      const pg8::u32x4* src4 = (const pg8::u32x4*)(kvb + (size_t)(b * NMEM + r) * 2048 + h * 256 + hf * 128);
      LAS pg8::u32x4* dst4 = (LAS pg8::u32x4*)(Ls + r * 264 + hf * 128);
#pragma unroll
      for (int k = 0; k < 16; k++) dst4[k] = src4[k];
    }
    f32x16_t st[8];
#pragma unroll
    for (int kt = 0; kt < 8; kt++)
#pragma unroll
      for (int r = 0; r < 16; r++) st[kt][r] = 0.f;
    const bf16* qrow = q + (size_t)(tok0 + n) * DM + h * 256 + 8 * hh;
    __syncthreads();
#pragma unroll
    for (int kq = 0; kq < 4; kq++) {
      bf16x8_t qf[4];
#pragma unroll
      for (int i = 0; i < 4; i++) qf[i] = *(const bf16x8_t*)(qrow + 16 * (kq * 4 + i));
#pragma unroll
      for (int kt = 0; kt < 8; kt++) {
        const LAS bf16* krow = Ls + (kt * 32 + sig) * 264 + 8 * hh;
        bf16x8_t kf[4];
#pragma unroll
        for (int i = 0; i < 4; i++) kf[i] = *(const LAS bf16x8_t*)(krow + 16 * (kq * 4 + i));
        MFMA_PAD();
#pragma unroll
        for (int i = 0; i < 4; i++) st[kt] = __builtin_amdgcn_mfma_f32_32x32x16_bf16(kf[i], qf[i], st[kt], 0, 0, 0);
        MFMA_PAD();
      }
    }
    float mx = st[0][0];
#pragma unroll
    for (int kt = 0; kt < 8; kt++)
#pragma unroll
      for (int r = 0; r < 16; r++) mx = fmaxf(mx, st[kt][r]);
    mx = fmaxf(mx, __shfl_xor(mx, 32, 64));
    float sum = 0.f;
#pragma unroll
    for (int kt = 0; kt < 8; kt++)
#pragma unroll
      for (int r = 0; r < 16; r++) { const float e = __expf((st[kt][r] - mx) * 0.0625f); st[kt][r] = e; sum += e; }
    sum += __shfl_xor(sum, 32, 64);
    const float inv = 1.0f / sum;
    bf16x8_t pf[8][2];
#pragma unroll
    for (int kt = 0; kt < 8; kt++)
#pragma unroll
      for (int s = 0; s < 2; s++)
#pragma unroll
        for (int j = 0; j < 8; j++) pf[kt][s][j] = (short)f2bf(st[kt][8 * s + j] * inv);
    __syncthreads();
    {
      const int r = tid_ >> 1, hf = tid_ & 1;
      const pg8::u32x4* src4 = (const pg8::u32x4*)(vT + ((size_t)(b * 4 + h) * 256 + r) * 256 + hf * 128);
      LAS pg8::u32x4* dst4 = (LAS pg8::u32x4*)(Ls + r * 264 + hf * 128);
#pragma unroll
      for (int k = 0; k < 16; k++) dst4[k] = src4[k];
    }
    __syncthreads();
#pragma unroll 1
    for (int dt = 0; dt < 8; dt++) {
      f32x16_t oacc;
#pragma unroll
      for (int r = 0; r < 16; r++) oacc[r] = 0.f;
      const LAS bf16* vrow = Ls + (dt * 32 + n) * 264 + 8 * hh;
#pragma unroll
      for (int kq = 0; kq < 4; kq++) {
        bf16x8_t vf[4];
#pragma unroll
        for (int i = 0; i < 4; i++) vf[i] = *(const LAS bf16x8_t*)(vrow + (kq * 2 + (i >> 1)) * 32 + 16 * (i & 1));
        MFMA_PAD();
#pragma unroll
        for (int i = 0; i < 4; i++) oacc = __builtin_amdgcn_mfma_f32_32x32x16_bf16(pf[kq * 2 + (i >> 1)][i & 1], vf[i], oacc, 0, 0, 0);
        MFMA_PAD();
      }
#pragma unroll
      for (int r = 0; r < 16; r++) {
        const int qi = (r & 3) + 8 * (r >> 2) + 4 * hh;
        o[(size_t)(tok0 + qi) * DM + h * 256 + dt * 32 + n] = (bf16)f2bf(oacc[r]);
      }
    }
  }
}

__device__ __forceinline__ void vt_phase(const int wave_s, const bf16* kvb, bf16* vT) {
  const int tid_ = opaque_tid(wave_s);
  const int gt = blockIdx.x * (NWAVES * 64) + tid_;
  const int nth = gridDim.x * NWAVES * 64;
  for (int i = gt; i < 2 * 4 * 4 * 256 * 256; i += nth) {
    const int m = i & 255, d = (i >> 8) & 255, h = (i >> 16) & 3, b = (i >> 18) & 3, l = i >> 20;
    vT[i] = kvb[((size_t)l * 1024 + b * 256 + m) * 2048 + 1024 + h * 256 + d];
  }
}

template <unsigned MASK>
__device__ __forceinline__ float pack_key(float s, unsigned idx) {
  const unsigned u = __builtin_bit_cast(unsigned, s);
  const unsigned tag = ((int)u < 0) ? idx : (MASK - idx);
  return __builtin_bit_cast(float, (u & ~MASK) + tag);
}
template <unsigned MASK>
__device__ __forceinline__ unsigned key_idx(float k) {
  const unsigned u = __builtin_bit_cast(unsigned, k);
  const unsigned tag = u & MASK;
  return ((int)u < 0) ? tag : (MASK - tag);
}
template <unsigned MASK>
__device__ __forceinline__ float key_val(float k) { return __builtin_bit_cast(float, __builtin_bit_cast(unsigned, k) & ~MASK); }
__device__ __forceinline__ void top16_of_64(float (&K)[64]) {
  { const float a_ = K[0], b_ = K[1]; const bool g_ = a_ > b_; K[0] = g_ ? a_ : b_; K[1] = g_ ? b_ : a_; }
  { const float a_ = K[2], b_ = K[3]; const bool g_ = a_ > b_; K[2] = g_ ? b_ : a_; K[3] = g_ ? a_ : b_; }
  { const float a_ = K[4], b_ = K[5]; const bool g_ = a_ > b_; K[4] = g_ ? a_ : b_; K[5] = g_ ? b_ : a_; }
  { const float a_ = K[6], b_ = K[7]; const bool g_ = a_ > b_; K[6] = g_ ? b_ : a_; K[7] = g_ ? a_ : b_; }
  { const float a_ = K[8], b_ = K[9]; const bool g_ = a_ > b_; K[8] = g_ ? a_ : b_; K[9] = g_ ? b_ : a_; }
  { const float a_ = K[10], b_ = K[11]; const bool g_ = a_ > b_; K[10] = g_ ? b_ : a_; K[11] = g_ ? a_ : b_; }
  { const float a_ = K[12], b_ = K[13]; const bool g_ = a_ > b_; K[12] = g_ ? a_ : b_; K[13] = g_ ? b_ : a_; }
  { const float a_ = K[14], b_ = K[15]; const bool g_ = a_ > b_; K[14] = g_ ? b_ : a_; K[15] = g_ ? a_ : b_; }
  { const float a_ = K[0], b_ = K[2]; const bool g_ = a_ > b_; K[0] = g_ ? a_ : b_; K[2] = g_ ? b_ : a_; }
  { const float a_ = K[1], b_ = K[3]; const bool g_ = a_ > b_; K[1] = g_ ? a_ : b_; K[3] = g_ ? b_ : a_; }
  { const float a_ = K[4], b_ = K[6]; const bool g_ = a_ > b_; K[4] = g_ ? b_ : a_; K[6] = g_ ? a_ : b_; }
  { const float a_ = K[5], b_ = K[7]; const bool g_ = a_ > b_; K[5] = g_ ? b_ : a_; K[7] = g_ ? a_ : b_; }
  { const float a_ = K[8], b_ = K[10]; const bool g_ = a_ > b_; K[8] = g_ ? a_ : b_; K[10] = g_ ? b_ : a_; }
  { const float a_ = K[9], b_ = K[11]; const bool g_ = a_ > b_; K[9] = g_ ? a_ : b_; K[11] = g_ ? b_ : a_; }
  { const float a_ = K[12], b_ = K[14]; const bool g_ = a_ > b_; K[12] = g_ ? b_ : a_; K[14] = g_ ? a_ : b_; }
  { const float a_ = K[13], b_ = K[15]; const bool g_ = a_ > b_; K[13] = g_ ? b_ : a_; K[15] = g_ ? a_ : b_; }
  { const float a_ = K[0], b_ = K[1]; const bool g_ = a_ > b_; K[0] = g_ ? a_ : b_; K[1] = g_ ? b_ : a_; }
  { const float a_ = K[2], b_ = K[3]; const bool g_ = a_ > b_; K[2] = g_ ? a_ : b_; K[3] = g_ ? b_ : a_; }
  { const float a_ = K[4], b_ = K[5]; const bool g_ = a_ > b_; K[4] = g_ ? b_ : a_; K[5] = g_ ? a_ : b_; }
  { const float a_ = K[6], b_ = K[7]; const bool g_ = a_ > b_; K[6] = g_ ? b_ : a_; K[7] = g_ ? a_ : b_; }
  { const float a_ = K[8], b_ = K[9]; const bool g_ = a_ > b_; K[8] = g_ ? a_ : b_; K[9] = g_ ? b_ : a_; }
  { const float a_ = K[10], b_ = K[11]; const bool g_ = a_ > b_; K[10] = g_ ? a_ : b_; K[11] = g_ ? b_ : a_; }
  { const float a_ = K[12], b_ = K[13]; const bool g_ = a_ > b_; K[12] = g_ ? b_ : a_; K[13] = g_ ? a_ : b_; }
  { const float a_ = K[14], b_ = K[15]; const bool g_ = a_ > b_; K[14] = g_ ? b_ : a_; K[15] = g_ ? a_ : b_; }
  { const float a_ = K[0], b_ = K[4]; const bool g_ = a_ > b_; K[0] = g_ ? a_ : b_; K[4] = g_ ? b_ : a_; }
  { const float a_ = K[1], b_ = K[5]; const bool g_ = a_ > b_; K[1] = g_ ? a_ : b_; K[5] = g_ ? b_ : a_; }
  { const float a_ = K[2], b_ = K[6]; const bool g_ = a_ > b_; K[2] = g_ ? a_ : b_; K[6] = g_ ? b_ : a_; }
  { const float a_ = K[3], b_ = K[7]; const bool g_ = a_ > b_; K[3] = g_ ? a_ : b_; K[7] = g_ ? b_ : a_; }
  { const float a_ = K[8], b_ = K[12]; const bool g_ = a_ > b_; K[8] = g_ ? b_ : a_; K[12] = g_ ? a_ : b_; }
  { const float a_ = K[9], b_ = K[13]; const bool g_ = a_ > b_; K[9] = g_ ? b_ : a_; K[13] = g_ ? a_ : b_; }
  { const float a_ = K[10], b_ = K[14]; const bool g_ = a_ > b_; K[10] = g_ ? b_ : a_; K[14] = g_ ? a_ : b_; }
  { const float a_ = K[11], b_ = K[15]; const bool g_ = a_ > b_; K[11] = g_ ? b_ : a_; K[15] = g_ ? a_ : b_; }
  { const float a_ = K[0], b_ = K[2]; const bool g_ = a_ > b_; K[0] = g_ ? a_ : b_; K[2] = g_ ? b_ : a_; }
  { const float a_ = K[1], b_ = K[3]; const bool g_ = a_ > b_; K[1] = g_ ? a_ : b_; K[3] = g_ ? b_ : a_; }
  { const float a_ = K[4], b_ = K[6]; const bool g_ = a_ > b_; K[4] = g_ ? a_ : b_; K[6] = g_ ? b_ : a_; }
  { const float a_ = K[5], b_ = K[7]; const bool g_ = a_ > b_; K[5] = g_ ? a_ : b_; K[7] = g_ ? b_ : a_; }
  { const float a_ = K[8], b_ = K[10]; const bool g_ = a_ > b_; K[8] = g_ ? b_ : a_; K[10] = g_ ? a_ : b_; }
  { const float a_ = K[9], b_ = K[11]; const bool g_ = a_ > b_; K[9] = g_ ? b_ : a_; K[11] = g_ ? a_ : b_; }
  { const float a_ = K[12], b_ = K[14]; const bool g_ = a_ > b_; K[12] = g_ ? b_ : a_; K[14] = g_ ? a_ : b_; }
  { const float a_ = K[13], b_ = K[15]; const bool g_ = a_ > b_; K[13] = g_ ? b_ : a_; K[15] = g_ ? a_ : b_; }
  { const float a_ = K[0], b_ = K[1]; const bool g_ = a_ > b_; K[0] = g_ ? a_ : b_; K[1] = g_ ? b_ : a_; }
  { const float a_ = K[2], b_ = K[3]; const bool g_ = a_ > b_; K[2] = g_ ? a_ : b_; K[3] = g_ ? b_ : a_; }
  { const float a_ = K[4], b_ = K[5]; const bool g_ = a_ > b_; K[4] = g_ ? a_ : b_; K[5] = g_ ? b_ : a_; }
  { const float a_ = K[6], b_ = K[7]; const bool g_ = a_ > b_; K[6] = g_ ? a_ : b_; K[7] = g_ ? b_ : a_; }
  { const float a_ = K[8], b_ = K[9]; const bool g_ = a_ > b_; K[8] = g_ ? b_ : a_; K[9] = g_ ? a_ : b_; }
  { const float a_ = K[10], b_ = K[11]; const bool g_ = a_ > b_; K[10] = g_ ? b_ : a_; K[11] = g_ ? a_ : b_; }
  { const float a_ = K[12], b_ = K[13]; const bool g_ = a_ > b_; K[12] = g_ ? b_ : a_; K[13] = g_ ? a_ : b_; }
  { const float a_ = K[14], b_ = K[15]; const bool g_ = a_ > b_; K[14] = g_ ? b_ : a_; K[15] = g_ ? a_ : b_; }
  { const float a_ = K[0], b_ = K[8]; const bool g_ = a_ > b_; K[0] = g_ ? a_ : b_; K[8] = g_ ? b_ : a_; }
  { const float a_ = K[1], b_ = K[9]; const bool g_ = a_ > b_; K[1] = g_ ? a_ : b_; K[9] = g_ ? b_ : a_; }
  { const float a_ = K[2], b_ = K[10]; const bool g_ = a_ > b_; K[2] = g_ ? a_ : b_; K[10] = g_ ? b_ : a_; }
  { const float a_ = K[3], b_ = K[11]; const bool g_ = a_ > b_; K[3] = g_ ? a_ : b_; K[11] = g_ ? b_ : a_; }
  { const float a_ = K[4], b_ = K[12]; const bool g_ = a_ > b_; K[4] = g_ ? a_ : b_; K[12] = g_ ? b_ : a_; }
  { const float a_ = K[5], b_ = K[13]; const bool g_ = a_ > b_; K[5] = g_ ? a_ : b_; K[13] = g_ ? b_ : a_; }
  { const float a_ = K[6], b_ = K[14]; const bool g_ = a_ > b_; K[6] = g_ ? a_ : b_; K[14] = g_ ? b_ : a_; }
  { const float a_ = K[7], b_ = K[15]; const bool g_ = a_ > b_; K[7] = g_ ? a_ : b_; K[15] = g_ ? b_ : a_; }
  { const float a_ = K[0], b_ = K[4]; const bool g_ = a_ > b_; K[0] = g_ ? a_ : b_; K[4] = g_ ? b_ : a_; }
  { const float a_ = K[1], b_ = K[5]; const bool g_ = a_ > b_; K[1] = g_ ? a_ : b_; K[5] = g_ ? b_ : a_; }
  { const float a_ = K[2], b_ = K[6]; const bool g_ = a_ > b_; K[2] = g_ ? a_ : b_; K[6] = g_ ? b_ : a_; }
  { const float a_ = K[3], b_ = K[7]; const bool g_ = a_ > b_; K[3] = g_ ? a_ : b_; K[7] = g_ ? b_ : a_; }
  { const float a_ = K[8], b_ = K[12]; const bool g_ = a_ > b_; K[8] = g_ ? a_ : b_; K[12] = g_ ? b_ : a_; }
  { const float a_ = K[9], b_ = K[13]; const bool g_ = a_ > b_; K[9] = g_ ? a_ : b_; K[13] = g_ ? b_ : a_; }
  { const float a_ = K[10], b_ = K[14]; const bool g_ = a_ > b_; K[10] = g_ ? a_ : b_; K[14] = g_ ? b_ : a_; }
  { const float a_ = K[11], b_ = K[15]; const bool g_ = a_ > b_; K[11] = g_ ? a_ : b_; K[15] = g_ ? b_ : a_; }
  { const float a_ = K[0], b_ = K[2]; const bool g_ = a_ > b_; K[0] = g_ ? a_ : b_; K[2] = g_ ? b_ : a_; }
  { const float a_ = K[1], b_ = K[3]; const bool g_ = a_ > b_; K[1] = g_ ? a_ : b_; K[3] = g_ ? b_ : a_; }
  { const float a_ = K[4], b_ = K[6]; const bool g_ = a_ > b_; K[4] = g_ ? a_ : b_; K[6] = g_ ? b_ : a_; }
  { const float a_ = K[5], b_ = K[7]; const bool g_ = a_ > b_; K[5] = g_ ? a_ : b_; K[7] = g_ ? b_ : a_; }
  { const float a_ = K[8], b_ = K[10]; const bool g_ = a_ > b_; K[8] = g_ ? a_ : b_; K[10] = g_ ? b_ : a_; }
  { const float a_ = K[9], b_ = K[11]; const bool g_ = a_ > b_; K[9] = g_ ? a_ : b_; K[11] = g_ ? b_ : a_; }
  { const float a_ = K[12], b_ = K[14]; const bool g_ = a_ > b_; K[12] = g_ ? a_ : b_; K[14] = g_ ? b_ : a_; }
  { const float a_ = K[13], b_ = K[15]; const bool g_ = a_ > b_; K[13] = g_ ? a_ : b_; K[15] = g_ ? b_ : a_; }
  { const float a_ = K[0], b_ = K[1]; const bool g_ = a_ > b_; K[0] = g_ ? a_ : b_; K[1] = g_ ? b_ : a_; }
  { const float a_ = K[2], b_ = K[3]; const bool g_ = a_ > b_; K[2] = g_ ? a_ : b_; K[3] = g_ ? b_ : a_; }
  { const float a_ = K[4], b_ = K[5]; const bool g_ = a_ > b_; K[4] = g_ ? a_ : b_; K[5] = g_ ? b_ : a_; }
  { const float a_ = K[6], b_ = K[7]; const bool g_ = a_ > b_; K[6] = g_ ? a_ : b_; K[7] = g_ ? b_ : a_; }
  { const float a_ = K[8], b_ = K[9]; const bool g_ = a_ > b_; K[8] = g_ ? a_ : b_; K[9] = g_ ? b_ : a_; }
  { const float a_ = K[10], b_ = K[11]; const bool g_ = a_ > b_; K[10] = g_ ? a_ : b_; K[11] = g_ ? b_ : a_; }
  { const float a_ = K[12], b_ = K[13]; const bool g_ = a_ > b_; K[12] = g_ ? a_ : b_; K[13] = g_ ? b_ : a_; }
  { const float a_ = K[14], b_ = K[15]; const bool g_ = a_ > b_; K[14] = g_ ? a_ : b_; K[15] = g_ ? b_ : a_; }
  { const float a_ = K[16], b_ = K[17]; const bool g_ = a_ > b_; K[16] = g_ ? a_ : b_; K[17] = g_ ? b_ : a_; }
  { const float a_ = K[18], b_ = K[19]; const bool g_ = a_ > b_; K[18] = g_ ? b_ : a_; K[19] = g_ ? a_ : b_; }
  { const float a_ = K[20], b_ = K[21]; const bool g_ = a_ > b_; K[20] = g_ ? a_ : b_; K[21] = g_ ? b_ : a_; }
  { const float a_ = K[22], b_ = K[23]; const bool g_ = a_ > b_; K[22] = g_ ? b_ : a_; K[23] = g_ ? a_ : b_; }
  { const float a_ = K[24], b_ = K[25]; const bool g_ = a_ > b_; K[24] = g_ ? a_ : b_; K[25] = g_ ? b_ : a_; }
  { const float a_ = K[26], b_ = K[27]; const bool g_ = a_ > b_; K[26] = g_ ? b_ : a_; K[27] = g_ ? a_ : b_; }
  { const float a_ = K[28], b_ = K[29]; const bool g_ = a_ > b_; K[28] = g_ ? a_ : b_; K[29] = g_ ? b_ : a_; }
  { const float a_ = K[30], b_ = K[31]; const bool g_ = a_ > b_; K[30] = g_ ? b_ : a_; K[31] = g_ ? a_ : b_; }
  { const float a_ = K[16], b_ = K[18]; const bool g_ = a_ > b_; K[16] = g_ ? a_ : b_; K[18] = g_ ? b_ : a_; }
  { const float a_ = K[17], b_ = K[19]; const bool g_ = a_ > b_; K[17] = g_ ? a_ : b_; K[19] = g_ ? b_ : a_; }
  { const float a_ = K[20], b_ = K[22]; const bool g_ = a_ > b_; K[20] = g_ ? b_ : a_; K[22] = g_ ? a_ : b_; }
  { const float a_ = K[21], b_ = K[23]; const bool g_ = a_ > b_; K[21] = g_ ? b_ : a_; K[23] = g_ ? a_ : b_; }
  { const float a_ = K[24], b_ = K[26]; const bool g_ = a_ > b_; K[24] = g_ ? a_ : b_; K[26] = g_ ? b_ : a_; }
  { const float a_ = K[25], b_ = K[27]; const bool g_ = a_ > b_; K[25] = g_ ? a_ : b_; K[27] = g_ ? b_ : a_; }
  { const float a_ = K[28], b_ = K[30]; const bool g_ = a_ > b_; K[28] = g_ ? b_ : a_; K[30] = g_ ? a_ : b_; }
  { const float a_ = K[29], b_ = K[31]; const bool g_ = a_ > b_; K[29] = g_ ? b_ : a_; K[31] = g_ ? a_ : b_; }
  { const float a_ = K[16], b_ = K[17]; const bool g_ = a_ > b_; K[16] = g_ ? a_ : b_; K[17] = g_ ? b_ : a_; }
  { const float a_ = K[18], b_ = K[19]; const bool g_ = a_ > b_; K[18] = g_ ? a_ : b_; K[19] = g_ ? b_ : a_; }
  { const float a_ = K[20], b_ = K[21]; const bool g_ = a_ > b_; K[20] = g_ ? b_ : a_; K[21] = g_ ? a_ : b_; }
  { const float a_ = K[22], b_ = K[23]; const bool g_ = a_ > b_; K[22] = g_ ? b_ : a_; K[23] = g_ ? a_ : b_; }
  { const float a_ = K[24], b_ = K[25]; const bool g_ = a_ > b_; K[24] = g_ ? a_ : b_; K[25] = g_ ? b_ : a_; }
  { const float a_ = K[26], b_ = K[27]; const bool g_ = a_ > b_; K[26] = g_ ? a_ : b_; K[27] = g_ ? b_ : a_; }
  { const float a_ = K[28], b_ = K[29]; const bool g_ = a_ > b_; K[28] = g_ ? b_ : a_; K[29] = g_ ? a_ : b_; }
  { const float a_ = K[30], b_ = K[31]; const bool g_ = a_ > b_; K[30] = g_ ? b_ : a_; K[31] = g_ ? a_ : b_; }
  { const float a_ = K[16], b_ = K[20]; const bool g_ = a_ > b_; K[16] = g_ ? a_ : b_; K[20] = g_ ? b_ : a_; }
  { const float a_ = K[17], b_ = K[21]; const bool g_ = a_ > b_; K[17] = g_ ? a_ : b_; K[21] = g_ ? b_ : a_; }
  { const float a_ = K[18], b_ = K[22]; const bool g_ = a_ > b_; K[18] = g_ ? a_ : b_; K[22] = g_ ? b_ : a_; }
  { const float a_ = K[19], b_ = K[23]; const bool g_ = a_ > b_; K[19] = g_ ? a_ : b_; K[23] = g_ ? b_ : a_; }
  { const float a_ = K[24], b_ = K[28]; const bool g_ = a_ > b_; K[24] = g_ ? b_ : a_; K[28] = g_ ? a_ : b_; }
  { const float a_ = K[25], b_ = K[29]; const bool g_ = a_ > b_; K[25] = g_ ? b_ : a_; K[29] = g_ ? a_ : b_; }
  { const float a_ = K[26], b_ = K[30]; const bool g_ = a_ > b_; K[26] = g_ ? b_ : a_; K[30] = g_ ? a_ : b_; }
  { const float a_ = K[27], b_ = K[31]; const bool g_ = a_ > b_; K[27] = g_ ? b_ : a_; K[31] = g_ ? a_ : b_; }
  { const float a_ = K[16], b_ = K[18]; const bool g_ = a_ > b_; K[16] = g_ ? a_ : b_; K[18] = g_ ? b_ : a_; }
  { const float a_ = K[17], b_ = K[19]; const bool g_ = a_ > b_; K[17] = g_ ? a_ : b_; K[19] = g_ ? b_ : a_; }
  { const float a_ = K[20], b_ = K[22]; const bool g_ = a_ > b_; K[20] = g_ ? a_ : b_; K[22] = g_ ? b_ : a_; }
  { const float a_ = K[21], b_ = K[23]; const bool g_ = a_ > b_; K[21] = g_ ? a_ : b_; K[23] = g_ ? b_ : a_; }
  { const float a_ = K[24], b_ = K[26]; const bool g_ = a_ > b_; K[24] = g_ ? b_ : a_; K[26] = g_ ? a_ : b_; }
  { const float a_ = K[25], b_ = K[27]; const bool g_ = a_ > b_; K[25] = g_ ? b_ : a_; K[27] = g_ ? a_ : b_; }
  { const float a_ = K[28], b_ = K[30]; const bool g_ = a_ > b_; K[28] = g_ ? b_ : a_; K[30] = g_ ? a_ : b_; }
  { const float a_ = K[29], b_ = K[31]; const bool g_ = a_ > b_; K[29] = g_ ? b_ : a_; K[31] = g_ ? a_ : b_; }
  { const float a_ = K[16], b_ = K[17]; const bool g_ = a_ > b_; K[16] = g_ ? a_ : b_; K[17] = g_ ? b_ : a_; }
  { const float a_ = K[18], b_ = K[19]; const bool g_ = a_ > b_; K[18] = g_ ? a_ : b_; K[19] = g_ ? b_ : a_; }
  { const float a_ = K[20], b_ = K[21]; const bool g_ = a_ > b_; K[20] = g_ ? a_ : b_; K[21] = g_ ? b_ : a_; }
  { const float a_ = K[22], b_ = K[23]; const bool g_ = a_ > b_; K[22] = g_ ? a_ : b_; K[23] = g_ ? b_ : a_; }
  { const float a_ = K[24], b_ = K[25]; const bool g_ = a_ > b_; K[24] = g_ ? b_ : a_; K[25] = g_ ? a_ : b_; }
  { const float a_ = K[26], b_ = K[27]; const bool g_ = a_ > b_; K[26] = g_ ? b_ : a_; K[27] = g_ ? a_ : b_; }
  { const float a_ = K[28], b_ = K[29]; const bool g_ = a_ > b_; K[28] = g_ ? b_ : a_; K[29] = g_ ? a_ : b_; }
  { const float a_ = K[30], b_ = K[31]; const bool g_ = a_ > b_; K[30] = g_ ? b_ : a_; K[31] = g_ ? a_ : b_; }
  { const float a_ = K[16], b_ = K[24]; const bool g_ = a_ > b_; K[16] = g_ ? a_ : b_; K[24] = g_ ? b_ : a_; }
  { const float a_ = K[17], b_ = K[25]; const bool g_ = a_ > b_; K[17] = g_ ? a_ : b_; K[25] = g_ ? b_ : a_; }
  { const float a_ = K[18], b_ = K[26]; const bool g_ = a_ > b_; K[18] = g_ ? a_ : b_; K[26] = g_ ? b_ : a_; }
  { const float a_ = K[19], b_ = K[27]; const bool g_ = a_ > b_; K[19] = g_ ? a_ : b_; K[27] = g_ ? b_ : a_; }
  { const float a_ = K[20], b_ = K[28]; const bool g_ = a_ > b_; K[20] = g_ ? a_ : b_; K[28] = g_ ? b_ : a_; }
  { const float a_ = K[21], b_ = K[29]; const bool g_ = a_ > b_; K[21] = g_ ? a_ : b_; K[29] = g_ ? b_ : a_; }
  { const float a_ = K[22], b_ = K[30]; const bool g_ = a_ > b_; K[22] = g_ ? a_ : b_; K[30] = g_ ? b_ : a_; }
  { const float a_ = K[23], b_ = K[31]; const bool g_ = a_ > b_; K[23] = g_ ? a_ : b_; K[31] = g_ ? b_ : a_; }
  { const float a_ = K[16], b_ = K[20]; const bool g_ = a_ > b_; K[16] = g_ ? a_ : b_; K[20] = g_ ? b_ : a_; }
  { const float a_ = K[17], b_ = K[21]; const bool g_ = a_ > b_; K[17] = g_ ? a_ : b_; K[21] = g_ ? b_ : a_; }
  { const float a_ = K[18], b_ = K[22]; const bool g_ = a_ > b_; K[18] = g_ ? a_ : b_; K[22] = g_ ? b_ : a_; }
  { const float a_ = K[19], b_ = K[23]; const bool g_ = a_ > b_; K[19] = g_ ? a_ : b_; K[23] = g_ ? b_ : a_; }
  { const float a_ = K[24], b_ = K[28]; const bool g_ = a_ > b_; K[24] = g_ ? a_ : b_; K[28] = g_ ? b_ : a_; }
  { const float a_ = K[25], b_ = K[29]; const bool g_ = a_ > b_; K[25] = g_ ? a_ : b_; K[29] = g_ ? b_ : a_; }
  { const float a_ = K[26], b_ = K[30]; const bool g_ = a_ > b_; K[26] = g_ ? a_ : b_; K[30] = g_ ? b_ : a_; }
  { const float a_ = K[27], b_ = K[31]; const bool g_ = a_ > b_; K[27] = g_ ? a_ : b_; K[31] = g_ ? b_ : a_; }
  { const float a_ = K[16], b_ = K[18]; const bool g_ = a_ > b_; K[16] = g_ ? a_ : b_; K[18] = g_ ? b_ : a_; }
  { const float a_ = K[17], b_ = K[19]; const bool g_ = a_ > b_; K[17] = g_ ? a_ : b_; K[19] = g_ ? b_ : a_; }
  { const float a_ = K[20], b_ = K[22]; const bool g_ = a_ > b_; K[20] = g_ ? a_ : b_; K[22] = g_ ? b_ : a_; }
  { const float a_ = K[21], b_ = K[23]; const bool g_ = a_ > b_; K[21] = g_ ? a_ : b_; K[23] = g_ ? b_ : a_; }
  { const float a_ = K[24], b_ = K[26]; const bool g_ = a_ > b_; K[24] = g_ ? a_ : b_; K[26] = g_ ? b_ : a_; }
  { const float a_ = K[25], b_ = K[27]; const bool g_ = a_ > b_; K[25] = g_ ? a_ : b_; K[27] = g_ ? b_ : a_; }
  { const float a_ = K[28], b_ = K[30]; const bool g_ = a_ > b_; K[28] = g_ ? a_ : b_; K[30] = g_ ? b_ : a_; }
  { const float a_ = K[29], b_ = K[31]; const bool g_ = a_ > b_; K[29] = g_ ? a_ : b_; K[31] = g_ ? b_ : a_; }
  { const float a_ = K[16], b_ = K[17]; const bool g_ = a_ > b_; K[16] = g_ ? a_ : b_; K[17] = g_ ? b_ : a_; }
  { const float a_ = K[18], b_ = K[19]; const bool g_ = a_ > b_; K[18] = g_ ? a_ : b_; K[19] = g_ ? b_ : a_; }
  { const float a_ = K[20], b_ = K[21]; const bool g_ = a_ > b_; K[20] = g_ ? a_ : b_; K[21] = g_ ? b_ : a_; }
  { const float a_ = K[22], b_ = K[23]; const bool g_ = a_ > b_; K[22] = g_ ? a_ : b_; K[23] = g_ ? b_ : a_; }
  { const float a_ = K[24], b_ = K[25]; const bool g_ = a_ > b_; K[24] = g_ ? a_ : b_; K[25] = g_ ? b_ : a_; }
  { const float a_ = K[26], b_ = K[27]; const bool g_ = a_ > b_; K[26] = g_ ? a_ : b_; K[27] = g_ ? b_ : a_; }
  { const float a_ = K[28], b_ = K[29]; const bool g_ = a_ > b_; K[28] = g_ ? a_ : b_; K[29] = g_ ? b_ : a_; }
  { const float a_ = K[30], b_ = K[31]; const bool g_ = a_ > b_; K[30] = g_ ? a_ : b_; K[31] = g_ ? b_ : a_; }
  { const float a_ = K[32], b_ = K[33]; const bool g_ = a_ > b_; K[32] = g_ ? a_ : b_; K[33] = g_ ? b_ : a_; }
  { const float a_ = K[34], b_ = K[35]; const bool g_ = a_ > b_; K[34] = g_ ? b_ : a_; K[35] = g_ ? a_ : b_; }
  { const float a_ = K[36], b_ = K[37]; const bool g_ = a_ > b_; K[36] = g_ ? a_ : b_; K[37] = g_ ? b_ : a_; }
  { const float a_ = K[38], b_ = K[39]; const bool g_ = a_ > b_; K[38] = g_ ? b_ : a_; K[39] = g_ ? a_ : b_; }
  { const float a_ = K[40], b_ = K[41]; const bool g_ = a_ > b_; K[40] = g_ ? a_ : b_; K[41] = g_ ? b_ : a_; }
  { const float a_ = K[42], b_ = K[43]; const bool g_ = a_ > b_; K[42] = g_ ? b_ : a_; K[43] = g_ ? a_ : b_; }
  { const float a_ = K[44], b_ = K[45]; const bool g_ = a_ > b_; K[44] = g_ ? a_ : b_; K[45] = g_ ? b_ : a_; }
  { const float a_ = K[46], b_ = K[47]; const bool g_ = a_ > b_; K[46] = g_ ? b_ : a_; K[47] = g_ ? a_ : b_; }
  { const float a_ = K[32], b_ = K[34]; const bool g_ = a_ > b_; K[32] = g_ ? a_ : b_; K[34] = g_ ? b_ : a_; }
  { const float a_ = K[33], b_ = K[35]; const bool g_ = a_ > b_; K[33] = g_ ? a_ : b_; K[35] = g_ ? b_ : a_; }
  { const float a_ = K[36], b_ = K[38]; const bool g_ = a_ > b_; K[36] = g_ ? b_ : a_; K[38] = g_ ? a_ : b_; }
  { const float a_ = K[37], b_ = K[39]; const bool g_ = a_ > b_; K[37] = g_ ? b_ : a_; K[39] = g_ ? a_ : b_; }
  { const float a_ = K[40], b_ = K[42]; const bool g_ = a_ > b_; K[40] = g_ ? a_ : b_; K[42] = g_ ? b_ : a_; }
  { const float a_ = K[41], b_ = K[43]; const bool g_ = a_ > b_; K[41] = g_ ? a_ : b_; K[43] = g_ ? b_ : a_; }
  { const float a_ = K[44], b_ = K[46]; const bool g_ = a_ > b_; K[44] = g_ ? b_ : a_; K[46] = g_ ? a_ : b_; }
  { const float a_ = K[45], b_ = K[47]; const bool g_ = a_ > b_; K[45] = g_ ? b_ : a_; K[47] = g_ ? a_ : b_; }
  { const float a_ = K[32], b_ = K[33]; const bool g_ = a_ > b_; K[32] = g_ ? a_ : b_; K[33] = g_ ? b_ : a_; }
  { const float a_ = K[34], b_ = K[35]; const bool g_ = a_ > b_; K[34] = g_ ? a_ : b_; K[35] = g_ ? b_ : a_; }
  { const float a_ = K[36], b_ = K[37]; const bool g_ = a_ > b_; K[36] = g_ ? b_ : a_; K[37] = g_ ? a_ : b_; }
  { const float a_ = K[38], b_ = K[39]; const bool g_ = a_ > b_; K[38] = g_ ? b_ : a_; K[39] = g_ ? a_ : b_; }
  { const float a_ = K[40], b_ = K[41]; const bool g_ = a_ > b_; K[40] = g_ ? a_ : b_; K[41] = g_ ? b_ : a_; }
  { const float a_ = K[42], b_ = K[43]; const bool g_ = a_ > b_; K[42] = g_ ? a_ : b_; K[43] = g_ ? b_ : a_; }
  { const float a_ = K[44], b_ = K[45]; const bool g_ = a_ > b_; K[44] = g_ ? b_ : a_; K[45] = g_ ? a_ : b_; }
  { const float a_ = K[46], b_ = K[47]; const bool g_ = a_ > b_; K[46] = g_ ? b_ : a_; K[47] = g_ ? a_ : b_; }
  { const float a_ = K[32], b_ = K[36]; const bool g_ = a_ > b_; K[32] = g_ ? a_ : b_; K[36] = g_ ? b_ : a_; }
  { const float a_ = K[33], b_ = K[37]; const bool g_ = a_ > b_; K[33] = g_ ? a_ : b_; K[37] = g_ ? b_ : a_; }
  { const float a_ = K[34], b_ = K[38]; const bool g_ = a_ > b_; K[34] = g_ ? a_ : b_; K[38] = g_ ? b_ : a_; }
  { const float a_ = K[35], b_ = K[39]; const bool g_ = a_ > b_; K[35] = g_ ? a_ : b_; K[39] = g_ ? b_ : a_; }
  { const float a_ = K[40], b_ = K[44]; const bool g_ = a_ > b_; K[40] = g_ ? b_ : a_; K[44] = g_ ? a_ : b_; }
  { const float a_ = K[41], b_ = K[45]; const bool g_ = a_ > b_; K[41] = g_ ? b_ : a_; K[45] = g_ ? a_ : b_; }
  { const float a_ = K[42], b_ = K[46]; const bool g_ = a_ > b_; K[42] = g_ ? b_ : a_; K[46] = g_ ? a_ : b_; }
  { const float a_ = K[43], b_ = K[47]; const bool g_ = a_ > b_; K[43] = g_ ? b_ : a_; K[47] = g_ ? a_ : b_; }
  { const float a_ = K[32], b_ = K[34]; const bool g_ = a_ > b_; K[32] = g_ ? a_ : b_; K[34] = g_ ? b_ : a_; }
  { const float a_ = K[33], b_ = K[35]; const bool g_ = a_ > b_; K[33] = g_ ? a_ : b_; K[35] = g_ ? b_ : a_; }
  { const float a_ = K[36], b_ = K[38]; const bool g_ = a_ > b_; K[36] = g_ ? a_ : b_; K[38] = g_ ? b_ : a_; }
  { const float a_ = K[37], b_ = K[39]; const bool g_ = a_ > b_; K[37] = g_ ? a_ : b_; K[39] = g_ ? b_ : a_; }
  { const float a_ = K[40], b_ = K[42]; const bool g_ = a_ > b_; K[40] = g_ ? b_ : a_; K[42] = g_ ? a_ : b_; }
  { const float a_ = K[41], b_ = K[43]; const bool g_ = a_ > b_; K[41] = g_ ? b_ : a_; K[43] = g_ ? a_ : b_; }
  { const float a_ = K[44], b_ = K[46]; const bool g_ = a_ > b_; K[44] = g_ ? b_ : a_; K[46] = g_ ? a_ : b_; }
  { const float a_ = K[45], b_ = K[47]; const bool g_ = a_ > b_; K[45] = g_ ? b_ : a_; K[47] = g_ ? a_ : b_; }
  { const float a_ = K[32], b_ = K[33]; const bool g_ = a_ > b_; K[32] = g_ ? a_ : b_; K[33] = g_ ? b_ : a_; }
  { const float a_ = K[34], b_ = K[35]; const bool g_ = a_ > b_; K[34] = g_ ? a_ : b_; K[35] = g_ ? b_ : a_; }
  { const float a_ = K[36], b_ = K[37]; const bool g_ = a_ > b_; K[36] = g_ ? a_ : b_; K[37] = g_ ? b_ : a_; }
  { const float a_ = K[38], b_ = K[39]; const bool g_ = a_ > b_; K[38] = g_ ? a_ : b_; K[39] = g_ ? b_ : a_; }
  { const float a_ = K[40], b_ = K[41]; const bool g_ = a_ > b_; K[40] = g_ ? b_ : a_; K[41] = g_ ? a_ : b_; }
  { const float a_ = K[42], b_ = K[43]; const bool g_ = a_ > b_; K[42] = g_ ? b_ : a_; K[43] = g_ ? a_ : b_; }
  { const float a_ = K[44], b_ = K[45]; const bool g_ = a_ > b_; K[44] = g_ ? b_ : a_; K[45] = g_ ? a_ : b_; }
  { const float a_ = K[46], b_ = K[47]; const bool g_ = a_ > b_; K[46] = g_ ? b_ : a_; K[47] = g_ ? a_ : b_; }
  { const float a_ = K[32], b_ = K[40]; const bool g_ = a_ > b_; K[32] = g_ ? a_ : b_; K[40] = g_ ? b_ : a_; }
  { const float a_ = K[33], b_ = K[41]; const bool g_ = a_ > b_; K[33] = g_ ? a_ : b_; K[41] = g_ ? b_ : a_; }
  { const float a_ = K[34], b_ = K[42]; const bool g_ = a_ > b_; K[34] = g_ ? a_ : b_; K[42] = g_ ? b_ : a_; }
  { const float a_ = K[35], b_ = K[43]; const bool g_ = a_ > b_; K[35] = g_ ? a_ : b_; K[43] = g_ ? b_ : a_; }
  { const float a_ = K[36], b_ = K[44]; const bool g_ = a_ > b_; K[36] = g_ ? a_ : b_; K[44] = g_ ? b_ : a_; }
  { const float a_ = K[37], b_ = K[45]; const bool g_ = a_ > b_; K[37] = g_ ? a_ : b_; K[45] = g_ ? b_ : a_; }
  { const float a_ = K[38], b_ = K[46]; const bool g_ = a_ > b_; K[38] = g_ ? a_ : b_; K[46] = g_ ? b_ : a_; }
  { const float a_ = K[39], b_ = K[47]; const bool g_ = a_ > b_; K[39] = g_ ? a_ : b_; K[47] = g_ ? b_ : a_; }
  { const float a_ = K[32], b_ = K[36]; const bool g_ = a_ > b_; K[32] = g_ ? a_ : b_; K[36] = g_ ? b_ : a_; }
  { const float a_ = K[33], b_ = K[37]; const bool g_ = a_ > b_; K[33] = g_ ? a_ : b_; K[37] = g_ ? b_ : a_; }
  { const float a_ = K[34], b_ = K[38]; const bool g_ = a_ > b_; K[34] = g_ ? a_ : b_; K[38] = g_ ? b_ : a_; }
  { const float a_ = K[35], b_ = K[39]; const bool g_ = a_ > b_; K[35] = g_ ? a_ : b_; K[39] = g_ ? b_ : a_; }
  { const float a_ = K[40], b_ = K[44]; const bool g_ = a_ > b_; K[40] = g_ ? a_ : b_; K[44] = g_ ? b_ : a_; }
  { const float a_ = K[41], b_ = K[45]; const bool g_ = a_ > b_; K[41] = g_ ? a_ : b_; K[45] = g_ ? b_ : a_; }
  { const float a_ = K[42], b_ = K[46]; const bool g_ = a_ > b_; K[42] = g_ ? a_ : b_; K[46] = g_ ? b_ : a_; }
  { const float a_ = K[43], b_ = K[47]; const bool g_ = a_ > b_; K[43] = g_ ? a_ : b_; K[47] = g_ ? b_ : a_; }
  { const float a_ = K[32], b_ = K[34]; const bool g_ = a_ > b_; K[32] = g_ ? a_ : b_; K[34] = g_ ? b_ : a_; }
  { const float a_ = K[33], b_ = K[35]; const bool g_ = a_ > b_; K[33] = g_ ? a_ : b_; K[35] = g_ ? b_ : a_; }
  { const float a_ = K[36], b_ = K[38]; const bool g_ = a_ > b_; K[36] = g_ ? a_ : b_; K[38] = g_ ? b_ : a_; }
  { const float a_ = K[37], b_ = K[39]; const bool g_ = a_ > b_; K[37] = g_ ? a_ : b_; K[39] = g_ ? b_ : a_; }
  { const float a_ = K[40], b_ = K[42]; const bool g_ = a_ > b_; K[40] = g_ ? a_ : b_; K[42] = g_ ? b_ : a_; }
  { const float a_ = K[41], b_ = K[43]; const bool g_ = a_ > b_; K[41] = g_ ? a_ : b_; K[43] = g_ ? b_ : a_; }
  { const float a_ = K[44], b_ = K[46]; const bool g_ = a_ > b_; K[44] = g_ ? a_ : b_; K[46] = g_ ? b_ : a_; }
  { const float a_ = K[45], b_ = K[47]; const bool g_ = a_ > b_; K[45] = g_ ? a_ : b_; K[47] = g_ ? b_ : a_; }
  { const float a_ = K[32], b_ = K[33]; const bool g_ = a_ > b_; K[32] = g_ ? a_ : b_; K[33] = g_ ? b_ : a_; }
  { const float a_ = K[34], b_ = K[35]; const bool g_ = a_ > b_; K[34] = g_ ? a_ : b_; K[35] = g_ ? b_ : a_; }
  { const float a_ = K[36], b_ = K[37]; const bool g_ = a_ > b_; K[36] = g_ ? a_ : b_; K[37] = g_ ? b_ : a_; }
  { const float a_ = K[38], b_ = K[39]; const bool g_ = a_ > b_; K[38] = g_ ? a_ : b_; K[39] = g_ ? b_ : a_; }
  { const float a_ = K[40], b_ = K[41]; const bool g_ = a_ > b_; K[40] = g_ ? a_ : b_; K[41] = g_ ? b_ : a_; }
  { const float a_ = K[42], b_ = K[43]; const bool g_ = a_ > b_; K[42] = g_ ? a_ : b_; K[43] = g_ ? b_ : a_; }
  { const float a_ = K[44], b_ = K[45]; const bool g_ = a_ > b_; K[44] = g_ ? a_ : b_; K[45] = g_ ? b_ : a_; }
  { const float a_ = K[46], b_ = K[47]; const bool g_ = a_ > b_; K[46] = g_ ? a_ : b_; K[47] = g_ ? b_ : a_; }
  { const float a_ = K[48], b_ = K[49]; const bool g_ = a_ > b_; K[48] = g_ ? a_ : b_; K[49] = g_ ? b_ : a_; }
  { const float a_ = K[50], b_ = K[51]; const bool g_ = a_ > b_; K[50] = g_ ? b_ : a_; K[51] = g_ ? a_ : b_; }
  { const float a_ = K[52], b_ = K[53]; const bool g_ = a_ > b_; K[52] = g_ ? a_ : b_; K[53] = g_ ? b_ : a_; }
  { const float a_ = K[54], b_ = K[55]; const bool g_ = a_ > b_; K[54] = g_ ? b_ : a_; K[55] = g_ ? a_ : b_; }
  { const float a_ = K[56], b_ = K[57]; const bool g_ = a_ > b_; K[56] = g_ ? a_ : b_; K[57] = g_ ? b_ : a_; }
  { const float a_ = K[58], b_ = K[59]; const bool g_ = a_ > b_; K[58] = g_ ? b_ : a_; K[59] = g_ ? a_ : b_; }
  { const float a_ = K[60], b_ = K[61]; const bool g_ = a_ > b_; K[60] = g_ ? a_ : b_; K[61] = g_ ? b_ : a_; }
  { const float a_ = K[62], b_ = K[63]; const bool g_ = a_ > b_; K[62] = g_ ? b_ : a_; K[63] = g_ ? a_ : b_; }
  { const float a_ = K[48], b_ = K[50]; const bool g_ = a_ > b_; K[48] = g_ ? a_ : b_; K[50] = g_ ? b_ : a_; }
  { const float a_ = K[49], b_ = K[51]; const bool g_ = a_ > b_; K[49] = g_ ? a_ : b_; K[51] = g_ ? b_ : a_; }
  { const float a_ = K[52], b_ = K[54]; const bool g_ = a_ > b_; K[52] = g_ ? b_ : a_; K[54] = g_ ? a_ : b_; }
  { const float a_ = K[53], b_ = K[55]; const bool g_ = a_ > b_; K[53] = g_ ? b_ : a_; K[55] = g_ ? a_ : b_; }
  { const float a_ = K[56], b_ = K[58]; const bool g_ = a_ > b_; K[56] = g_ ? a_ : b_; K[58] = g_ ? b_ : a_; }
  { const float a_ = K[57], b_ = K[59]; const bool g_ = a_ > b_; K[57] = g_ ? a_ : b_; K[59] = g_ ? b_ : a_; }
  { const float a_ = K[60], b_ = K[62]; const bool g_ = a_ > b_; K[60] = g_ ? b_ : a_; K[62] = g_ ? a_ : b_; }
  { const float a_ = K[61], b_ = K[63]; const bool g_ = a_ > b_; K[61] = g_ ? b_ : a_; K[63] = g_ ? a_ : b_; }
  { const float a_ = K[48], b_ = K[49]; const bool g_ = a_ > b_; K[48] = g_ ? a_ : b_; K[49] = g_ ? b_ : a_; }
  { const float a_ = K[50], b_ = K[51]; const bool g_ = a_ > b_; K[50] = g_ ? a_ : b_; K[51] = g_ ? b_ : a_; }
  { const float a_ = K[52], b_ = K[53]; const bool g_ = a_ > b_; K[52] = g_ ? b_ : a_; K[53] = g_ ? a_ : b_; }
  { const float a_ = K[54], b_ = K[55]; const bool g_ = a_ > b_; K[54] = g_ ? b_ : a_; K[55] = g_ ? a_ : b_; }
  { const float a_ = K[56], b_ = K[57]; const bool g_ = a_ > b_; K[56] = g_ ? a_ : b_; K[57] = g_ ? b_ : a_; }
  { const float a_ = K[58], b_ = K[59]; const bool g_ = a_ > b_; K[58] = g_ ? a_ : b_; K[59] = g_ ? b_ : a_; }
  { const float a_ = K[60], b_ = K[61]; const bool g_ = a_ > b_; K[60] = g_ ? b_ : a_; K[61] = g_ ? a_ : b_; }
  { const float a_ = K[62], b_ = K[63]; const bool g_ = a_ > b_; K[62] = g_ ? b_ : a_; K[63] = g_ ? a_ : b_; }
  { const float a_ = K[48], b_ = K[52]; const bool g_ = a_ > b_; K[48] = g_ ? a_ : b_; K[52] = g_ ? b_ : a_; }
  { const float a_ = K[49], b_ = K[53]; const bool g_ = a_ > b_; K[49] = g_ ? a_ : b_; K[53] = g_ ? b_ : a_; }
  { const float a_ = K[50], b_ = K[54]; const bool g_ = a_ > b_; K[50] = g_ ? a_ : b_; K[54] = g_ ? b_ : a_; }
  { const float a_ = K[51], b_ = K[55]; const bool g_ = a_ > b_; K[51] = g_ ? a_ : b_; K[55] = g_ ? b_ : a_; }
  { const float a_ = K[56], b_ = K[60]; const bool g_ = a_ > b_; K[56] = g_ ? b_ : a_; K[60] = g_ ? a_ : b_; }
  { const float a_ = K[57], b_ = K[61]; const bool g_ = a_ > b_; K[57] = g_ ? b_ : a_; K[61] = g_ ? a_ : b_; }
  { const float a_ = K[58], b_ = K[62]; const bool g_ = a_ > b_; K[58] = g_ ? b_ : a_; K[62] = g_ ? a_ : b_; }
  { const float a_ = K[59], b_ = K[63]; const bool g_ = a_ > b_; K[59] = g_ ? b_ : a_; K[63] = g_ ? a_ : b_; }
  { const float a_ = K[48], b_ = K[50]; const bool g_ = a_ > b_; K[48] = g_ ? a_ : b_; K[50] = g_ ? b_ : a_; }
  { const float a_ = K[49], b_ = K[51]; const bool g_ = a_ > b_; K[49] = g_ ? a_ : b_; K[51] = g_ ? b_ : a_; }
  { const float a_ = K[52], b_ = K[54]; const bool g_ = a_ > b_; K[52] = g_ ? a_ : b_; K[54] = g_ ? b_ : a_; }
  { const float a_ = K[53], b_ = K[55]; const bool g_ = a_ > b_; K[53] = g_ ? a_ : b_; K[55] = g_ ? b_ : a_; }
  { const float a_ = K[56], b_ = K[58]; const bool g_ = a_ > b_; K[56] = g_ ? b_ : a_; K[58] = g_ ? a_ : b_; }
  { const float a_ = K[57], b_ = K[59]; const bool g_ = a_ > b_; K[57] = g_ ? b_ : a_; K[59] = g_ ? a_ : b_; }
  { const float a_ = K[60], b_ = K[62]; const bool g_ = a_ > b_; K[60] = g_ ? b_ : a_; K[62] = g_ ? a_ : b_; }
  { const float a_ = K[61], b_ = K[63]; const bool g_ = a_ > b_; K[61] = g_ ? b_ : a_; K[63] = g_ ? a_ : b_; }
  { const float a_ = K[48], b_ = K[49]; const bool g_ = a_ > b_; K[48] = g_ ? a_ : b_; K[49] = g_ ? b_ : a_; }
  { const float a_ = K[50], b_ = K[51]; const bool g_ = a_ > b_; K[50] = g_ ? a_ : b_; K[51] = g_ ? b_ : a_; }
  { const float a_ = K[52], b_ = K[53]; const bool g_ = a_ > b_; K[52] = g_ ? a_ : b_; K[53] = g_ ? b_ : a_; }
  { const float a_ = K[54], b_ = K[55]; const bool g_ = a_ > b_; K[54] = g_ ? a_ : b_; K[55] = g_ ? b_ : a_; }
  { const float a_ = K[56], b_ = K[57]; const bool g_ = a_ > b_; K[56] = g_ ? b_ : a_; K[57] = g_ ? a_ : b_; }
  { const float a_ = K[58], b_ = K[59]; const bool g_ = a_ > b_; K[58] = g_ ? b_ : a_; K[59] = g_ ? a_ : b_; }
  { const float a_ = K[60], b_ = K[61]; const bool g_ = a_ > b_; K[60] = g_ ? b_ : a_; K[61] = g_ ? a_ : b_; }
  { const float a_ = K[62], b_ = K[63]; const bool g_ = a_ > b_; K[62] = g_ ? b_ : a_; K[63] = g_ ? a_ : b_; }
  { const float a_ = K[48], b_ = K[56]; const bool g_ = a_ > b_; K[48] = g_ ? a_ : b_; K[56] = g_ ? b_ : a_; }
  { const float a_ = K[49], b_ = K[57]; const bool g_ = a_ > b_; K[49] = g_ ? a_ : b_; K[57] = g_ ? b_ : a_; }
  { const float a_ = K[50], b_ = K[58]; const bool g_ = a_ > b_; K[50] = g_ ? a_ : b_; K[58] = g_ ? b_ : a_; }
  { const float a_ = K[51], b_ = K[59]; const bool g_ = a_ > b_; K[51] = g_ ? a_ : b_; K[59] = g_ ? b_ : a_; }
  { const float a_ = K[52], b_ = K[60]; const bool g_ = a_ > b_; K[52] = g_ ? a_ : b_; K[60] = g_ ? b_ : a_; }
  { const float a_ = K[53], b_ = K[61]; const bool g_ = a_ > b_; K[53] = g_ ? a_ : b_; K[61] = g_ ? b_ : a_; }
  { const float a_ = K[54], b_ = K[62]; const bool g_ = a_ > b_; K[54] = g_ ? a_ : b_; K[62] = g_ ? b_ : a_; }
  { const float a_ = K[55], b_ = K[63]; const bool g_ = a_ > b_; K[55] = g_ ? a_ : b_; K[63] = g_ ? b_ : a_; }
  { const float a_ = K[48], b_ = K[52]; const bool g_ = a_ > b_; K[48] = g_ ? a_ : b_; K[52] = g_ ? b_ : a_; }
  { const float a_ = K[49], b_ = K[53]; const bool g_ = a_ > b_; K[49] = g_ ? a_ : b_; K[53] = g_ ? b_ : a_; }
  { const float a_ = K[50], b_ = K[54]; const bool g_ = a_ > b_; K[50] = g_ ? a_ : b_; K[54] = g_ ? b_ : a_; }
  { const float a_ = K[51], b_ = K[55]; const bool g_ = a_ > b_; K[51] = g_ ? a_ : b_; K[55] = g_ ? b_ : a_; }
  { const float a_ = K[56], b_ = K[60]; const bool g_ = a_ > b_; K[56] = g_ ? a_ : b_; K[60] = g_ ? b_ : a_; }
  { const float a_ = K[57], b_ = K[61]; const bool g_ = a_ > b_; K[57] = g_ ? a_ : b_; K[61] = g_ ? b_ : a_; }
  { const float a_ = K[58], b_ = K[62]; const bool g_ = a_ > b_; K[58] = g_ ? a_ : b_; K[62] = g_ ? b_ : a_; }
  { const float a_ = K[59], b_ = K[63]; const bool g_ = a_ > b_; K[59] = g_ ? a_ : b_; K[63] = g_ ? b_ : a_; }
  { const float a_ = K[48], b_ = K[50]; const bool g_ = a_ > b_; K[48] = g_ ? a_ : b_; K[50] = g_ ? b_ : a_; }
  { const float a_ = K[49], b_ = K[51]; const bool g_ = a_ > b_; K[49] = g_ ? a_ : b_; K[51] = g_ ? b_ : a_; }
  { const float a_ = K[52], b_ = K[54]; const bool g_ = a_ > b_; K[52] = g_ ? a_ : b_; K[54] = g_ ? b_ : a_; }
  { const float a_ = K[53], b_ = K[55]; const bool g_ = a_ > b_; K[53] = g_ ? a_ : b_; K[55] = g_ ? b_ : a_; }
  { const float a_ = K[56], b_ = K[58]; const bool g_ = a_ > b_; K[56] = g_ ? a_ : b_; K[58] = g_ ? b_ : a_; }
  { const float a_ = K[57], b_ = K[59]; const bool g_ = a_ > b_; K[57] = g_ ? a_ : b_; K[59] = g_ ? b_ : a_; }
  { const float a_ = K[60], b_ = K[62]; const bool g_ = a_ > b_; K[60] = g_ ? a_ : b_; K[62] = g_ ? b_ : a_; }
  { const float a_ = K[61], b_ = K[63]; const bool g_ = a_ > b_; K[61] = g_ ? a_ : b_; K[63] = g_ ? b_ : a_; }
  { const float a_ = K[48], b_ = K[49]; const bool g_ = a_ > b_; K[48] = g_ ? a_ : b_; K[49] = g_ ? b_ : a_; }
  { const float a_ = K[50], b_ = K[51]; const bool g_ = a_ > b_; K[50] = g_ ? a_ : b_; K[51] = g_ ? b_ : a_; }
  { const float a_ = K[52], b_ = K[53]; const bool g_ = a_ > b_; K[52] = g_ ? a_ : b_; K[53] = g_ ? b_ : a_; }
  { const float a_ = K[54], b_ = K[55]; const bool g_ = a_ > b_; K[54] = g_ ? a_ : b_; K[55] = g_ ? b_ : a_; }
  { const float a_ = K[56], b_ = K[57]; const bool g_ = a_ > b_; K[56] = g_ ? a_ : b_; K[57] = g_ ? b_ : a_; }
  { const float a_ = K[58], b_ = K[59]; const bool g_ = a_ > b_; K[58] = g_ ? a_ : b_; K[59] = g_ ? b_ : a_; }
  { const float a_ = K[60], b_ = K[61]; const bool g_ = a_ > b_; K[60] = g_ ? a_ : b_; K[61] = g_ ? b_ : a_; }
  { const float a_ = K[62], b_ = K[63]; const bool g_ = a_ > b_; K[62] = g_ ? a_ : b_; K[63] = g_ ? b_ : a_; }
  { const float a_ = K[0], b_ = K[31]; K[0] = a_ > b_ ? a_ : b_; }
  { const float a_ = K[1], b_ = K[30]; K[1] = a_ > b_ ? a_ : b_; }
  { const float a_ = K[2], b_ = K[29]; K[2] = a_ > b_ ? a_ : b_; }
  { const float a_ = K[3], b_ = K[28]; K[3] = a_ > b_ ? a_ : b_; }
  { const float a_ = K[4], b_ = K[27]; K[4] = a_ > b_ ? a_ : b_; }
  { const float a_ = K[5], b_ = K[26]; K[5] = a_ > b_ ? a_ : b_; }
  { const float a_ = K[6], b_ = K[25]; K[6] = a_ > b_ ? a_ : b_; }
  { const float a_ = K[7], b_ = K[24]; K[7] = a_ > b_ ? a_ : b_; }
  { const float a_ = K[8], b_ = K[23]; K[8] = a_ > b_ ? a_ : b_; }
  { const float a_ = K[9], b_ = K[22]; K[9] = a_ > b_ ? a_ : b_; }
  { const float a_ = K[10], b_ = K[21]; K[10] = a_ > b_ ? a_ : b_; }
  { const float a_ = K[11], b_ = K[20]; K[11] = a_ > b_ ? a_ : b_; }
  { const float a_ = K[12], b_ = K[19]; K[12] = a_ > b_ ? a_ : b_; }
  { const float a_ = K[13], b_ = K[18]; K[13] = a_ > b_ ? a_ : b_; }
  { const float a_ = K[14], b_ = K[17]; K[14] = a_ > b_ ? a_ : b_; }
  { const float a_ = K[15], b_ = K[16]; K[15] = a_ > b_ ? a_ : b_; }
  { const float a_ = K[0], b_ = K[8]; const bool g_ = a_ > b_; K[0] = g_ ? a_ : b_; K[8] = g_ ? b_ : a_; }
  { const float a_ = K[1], b_ = K[9]; const bool g_ = a_ > b_; K[1] = g_ ? a_ : b_; K[9] = g_ ? b_ : a_; }
  { const float a_ = K[2], b_ = K[10]; const bool g_ = a_ > b_; K[2] = g_ ? a_ : b_; K[10] = g_ ? b_ : a_; }
  { const float a_ = K[3], b_ = K[11]; const bool g_ = a_ > b_; K[3] = g_ ? a_ : b_; K[11] = g_ ? b_ : a_; }
  { const float a_ = K[4], b_ = K[12]; const bool g_ = a_ > b_; K[4] = g_ ? a_ : b_; K[12] = g_ ? b_ : a_; }
  { const float a_ = K[5], b_ = K[13]; const bool g_ = a_ > b_; K[5] = g_ ? a_ : b_; K[13] = g_ ? b_ : a_; }
  { const float a_ = K[6], b_ = K[14]; const bool g_ = a_ > b_; K[6] = g_ ? a_ : b_; K[14] = g_ ? b_ : a_; }
  { const float a_ = K[7], b_ = K[15]; const bool g_ = a_ > b_; K[7] = g_ ? a_ : b_; K[15] = g_ ? b_ : a_; }
  { const float a_ = K[0], b_ = K[4]; const bool g_ = a_ > b_; K[0] = g_ ? a_ : b_; K[4] = g_ ? b_ : a_; }
  { const float a_ = K[1], b_ = K[5]; const bool g_ = a_ > b_; K[1] = g_ ? a_ : b_; K[5] = g_ ? b_ : a_; }
  { const float a_ = K[2], b_ = K[6]; const bool g_ = a_ > b_; K[2] = g_ ? a_ : b_; K[6] = g_ ? b_ : a_; }
  { const float a_ = K[3], b_ = K[7]; const bool g_ = a_ > b_; K[3] = g_ ? a_ : b_; K[7] = g_ ? b_ : a_; }
  { const float a_ = K[8], b_ = K[12]; const bool g_ = a_ > b_; K[8] = g_ ? a_ : b_; K[12] = g_ ? b_ : a_; }
  { const float a_ = K[9], b_ = K[13]; const bool g_ = a_ > b_; K[9] = g_ ? a_ : b_; K[13] = g_ ? b_ : a_; }
  { const float a_ = K[10], b_ = K[14]; const bool g_ = a_ > b_; K[10] = g_ ? a_ : b_; K[14] = g_ ? b_ : a_; }
  { const float a_ = K[11], b_ = K[15]; const bool g_ = a_ > b_; K[11] = g_ ? a_ : b_; K[15] = g_ ? b_ : a_; }
  { const float a_ = K[0], b_ = K[2]; const bool g_ = a_ > b_; K[0] = g_ ? a_ : b_; K[2] = g_ ? b_ : a_; }
  { const float a_ = K[1], b_ = K[3]; const bool g_ = a_ > b_; K[1] = g_ ? a_ : b_; K[3] = g_ ? b_ : a_; }
  { const float a_ = K[4], b_ = K[6]; const bool g_ = a_ > b_; K[4] = g_ ? a_ : b_; K[6] = g_ ? b_ : a_; }
  { const float a_ = K[5], b_ = K[7]; const bool g_ = a_ > b_; K[5] = g_ ? a_ : b_; K[7] = g_ ? b_ : a_; }
  { const float a_ = K[8], b_ = K[10]; const bool g_ = a_ > b_; K[8] = g_ ? a_ : b_; K[10] = g_ ? b_ : a_; }
  { const float a_ = K[9], b_ = K[11]; const bool g_ = a_ > b_; K[9] = g_ ? a_ : b_; K[11] = g_ ? b_ : a_; }
  { const float a_ = K[12], b_ = K[14]; const bool g_ = a_ > b_; K[12] = g_ ? a_ : b_; K[14] = g_ ? b_ : a_; }
  { const float a_ = K[13], b_ = K[15]; const bool g_ = a_ > b_; K[13] = g_ ? a_ : b_; K[15] = g_ ? b_ : a_; }
  { const float a_ = K[0], b_ = K[1]; const bool g_ = a_ > b_; K[0] = g_ ? a_ : b_; K[1] = g_ ? b_ : a_; }
  { const float a_ = K[2], b_ = K[3]; const bool g_ = a_ > b_; K[2] = g_ ? a_ : b_; K[3] = g_ ? b_ : a_; }
  { const float a_ = K[4], b_ = K[5]; const bool g_ = a_ > b_; K[4] = g_ ? a_ : b_; K[5] = g_ ? b_ : a_; }
  { const float a_ = K[6], b_ = K[7]; const bool g_ = a_ > b_; K[6] = g_ ? a_ : b_; K[7] = g_ ? b_ : a_; }
  { const float a_ = K[8], b_ = K[9]; const bool g_ = a_ > b_; K[8] = g_ ? a_ : b_; K[9] = g_ ? b_ : a_; }
  { const float a_ = K[10], b_ = K[11]; const bool g_ = a_ > b_; K[10] = g_ ? a_ : b_; K[11] = g_ ? b_ : a_; }
  { const float a_ = K[12], b_ = K[13]; const bool g_ = a_ > b_; K[12] = g_ ? a_ : b_; K[13] = g_ ? b_ : a_; }
  { const float a_ = K[14], b_ = K[15]; const bool g_ = a_ > b_; K[14] = g_ ? a_ : b_; K[15] = g_ ? b_ : a_; }
  { const float a_ = K[32], b_ = K[63]; K[32] = a_ > b_ ? a_ : b_; }
  { const float a_ = K[33], b_ = K[62]; K[33] = a_ > b_ ? a_ : b_; }
  { const float a_ = K[34], b_ = K[61]; K[34] = a_ > b_ ? a_ : b_; }
  { const float a_ = K[35], b_ = K[60]; K[35] = a_ > b_ ? a_ : b_; }
  { const float a_ = K[36], b_ = K[59]; K[36] = a_ > b_ ? a_ : b_; }
  { const float a_ = K[37], b_ = K[58]; K[37] = a_ > b_ ? a_ : b_; }
  { const float a_ = K[38], b_ = K[57]; K[38] = a_ > b_ ? a_ : b_; }
  { const float a_ = K[39], b_ = K[56]; K[39] = a_ > b_ ? a_ : b_; }
  { const float a_ = K[40], b_ = K[55]; K[40] = a_ > b_ ? a_ : b_; }
  { const float a_ = K[41], b_ = K[54]; K[41] = a_ > b_ ? a_ : b_; }
  { const float a_ = K[42], b_ = K[53]; K[42] = a_ > b_ ? a_ : b_; }
  { const float a_ = K[43], b_ = K[52]; K[43] = a_ > b_ ? a_ : b_; }
  { const float a_ = K[44], b_ = K[51]; K[44] = a_ > b_ ? a_ : b_; }
  { const float a_ = K[45], b_ = K[50]; K[45] = a_ > b_ ? a_ : b_; }
  { const float a_ = K[46], b_ = K[49]; K[46] = a_ > b_ ? a_ : b_; }
  { const float a_ = K[47], b_ = K[48]; K[47] = a_ > b_ ? a_ : b_; }
  { const float a_ = K[32], b_ = K[40]; const bool g_ = a_ > b_; K[32] = g_ ? a_ : b_; K[40] = g_ ? b_ : a_; }
  { const float a_ = K[33], b_ = K[41]; const bool g_ = a_ > b_; K[33] = g_ ? a_ : b_; K[41] = g_ ? b_ : a_; }
  { const float a_ = K[34], b_ = K[42]; const bool g_ = a_ > b_; K[34] = g_ ? a_ : b_; K[42] = g_ ? b_ : a_; }
  { const float a_ = K[35], b_ = K[43]; const bool g_ = a_ > b_; K[35] = g_ ? a_ : b_; K[43] = g_ ? b_ : a_; }
  { const float a_ = K[36], b_ = K[44]; const bool g_ = a_ > b_; K[36] = g_ ? a_ : b_; K[44] = g_ ? b_ : a_; }
  { const float a_ = K[37], b_ = K[45]; const bool g_ = a_ > b_; K[37] = g_ ? a_ : b_; K[45] = g_ ? b_ : a_; }
  { const float a_ = K[38], b_ = K[46]; const bool g_ = a_ > b_; K[38] = g_ ? a_ : b_; K[46] = g_ ? b_ : a_; }
  { const float a_ = K[39], b_ = K[47]; const bool g_ = a_ > b_; K[39] = g_ ? a_ : b_; K[47] = g_ ? b_ : a_; }
  { const float a_ = K[32], b_ = K[36]; const bool g_ = a_ > b_; K[32] = g_ ? a_ : b_; K[36] = g_ ? b_ : a_; }
  { const float a_ = K[33], b_ = K[37]; const bool g_ = a_ > b_; K[33] = g_ ? a_ : b_; K[37] = g_ ? b_ : a_; }
  { const float a_ = K[34], b_ = K[38]; const bool g_ = a_ > b_; K[34] = g_ ? a_ : b_; K[38] = g_ ? b_ : a_; }
  { const float a_ = K[35], b_ = K[39]; const bool g_ = a_ > b_; K[35] = g_ ? a_ : b_; K[39] = g_ ? b_ : a_; }
  { const float a_ = K[40], b_ = K[44]; const bool g_ = a_ > b_; K[40] = g_ ? a_ : b_; K[44] = g_ ? b_ : a_; }
  { const float a_ = K[41], b_ = K[45]; const bool g_ = a_ > b_; K[41] = g_ ? a_ : b_; K[45] = g_ ? b_ : a_; }
  { const float a_ = K[42], b_ = K[46]; const bool g_ = a_ > b_; K[42] = g_ ? a_ : b_; K[46] = g_ ? b_ : a_; }
  { const float a_ = K[43], b_ = K[47]; const bool g_ = a_ > b_; K[43] = g_ ? a_ : b_; K[47] = g_ ? b_ : a_; }
  { const float a_ = K[32], b_ = K[34]; const bool g_ = a_ > b_; K[32] = g_ ? a_ : b_; K[34] = g_ ? b_ : a_; }
  { const float a_ = K[33], b_ = K[35]; const bool g_ = a_ > b_; K[33] = g_ ? a_ : b_; K[35] = g_ ? b_ : a_; }
  { const float a_ = K[36], b_ = K[38]; const bool g_ = a_ > b_; K[36] = g_ ? a_ : b_; K[38] = g_ ? b_ : a_; }
  { const float a_ = K[37], b_ = K[39]; const bool g_ = a_ > b_; K[37] = g_ ? a_ : b_; K[39] = g_ ? b_ : a_; }
  { const float a_ = K[40], b_ = K[42]; const bool g_ = a_ > b_; K[40] = g_ ? a_ : b_; K[42] = g_ ? b_ : a_; }
  { const float a_ = K[41], b_ = K[43]; const bool g_ = a_ > b_; K[41] = g_ ? a_ : b_; K[43] = g_ ? b_ : a_; }
  { const float a_ = K[44], b_ = K[46]; const bool g_ = a_ > b_; K[44] = g_ ? a_ : b_; K[46] = g_ ? b_ : a_; }
  { const float a_ = K[45], b_ = K[47]; const bool g_ = a_ > b_; K[45] = g_ ? a_ : b_; K[47] = g_ ? b_ : a_; }
  { const float a_ = K[32], b_ = K[33]; const bool g_ = a_ > b_; K[32] = g_ ? a_ : b_; K[33] = g_ ? b_ : a_; }
  { const float a_ = K[34], b_ = K[35]; const bool g_ = a_ > b_; K[34] = g_ ? a_ : b_; K[35] = g_ ? b_ : a_; }
  { const float a_ = K[36], b_ = K[37]; const bool g_ = a_ > b_; K[36] = g_ ? a_ : b_; K[37] = g_ ? b_ : a_; }
  { const float a_ = K[38], b_ = K[39]; const bool g_ = a_ > b_; K[38] = g_ ? a_ : b_; K[39] = g_ ? b_ : a_; }
  { const float a_ = K[40], b_ = K[41]; const bool g_ = a_ > b_; K[40] = g_ ? a_ : b_; K[41] = g_ ? b_ : a_; }
  { const float a_ = K[42], b_ = K[43]; const bool g_ = a_ > b_; K[42] = g_ ? a_ : b_; K[43] = g_ ? b_ : a_; }
  { const float a_ = K[44], b_ = K[45]; const bool g_ = a_ > b_; K[44] = g_ ? a_ : b_; K[45] = g_ ? b_ : a_; }
  { const float a_ = K[46], b_ = K[47]; const bool g_ = a_ > b_; K[46] = g_ ? a_ : b_; K[47] = g_ ? b_ : a_; }
  { const float a_ = K[0], b_ = K[47]; K[0] = a_ > b_ ? a_ : b_; }
  { const float a_ = K[1], b_ = K[46]; K[1] = a_ > b_ ? a_ : b_; }
  { const float a_ = K[2], b_ = K[45]; K[2] = a_ > b_ ? a_ : b_; }
  { const float a_ = K[3], b_ = K[44]; K[3] = a_ > b_ ? a_ : b_; }
  { const float a_ = K[4], b_ = K[43]; K[4] = a_ > b_ ? a_ : b_; }
  { const float a_ = K[5], b_ = K[42]; K[5] = a_ > b_ ? a_ : b_; }
  { const float a_ = K[6], b_ = K[41]; K[6] = a_ > b_ ? a_ : b_; }
  { const float a_ = K[7], b_ = K[40]; K[7] = a_ > b_ ? a_ : b_; }
  { const float a_ = K[8], b_ = K[39]; K[8] = a_ > b_ ? a_ : b_; }
  { const float a_ = K[9], b_ = K[38]; K[9] = a_ > b_ ? a_ : b_; }
  { const float a_ = K[10], b_ = K[37]; K[10] = a_ > b_ ? a_ : b_; }
  { const float a_ = K[11], b_ = K[36]; K[11] = a_ > b_ ? a_ : b_; }
  { const float a_ = K[12], b_ = K[35]; K[12] = a_ > b_ ? a_ : b_; }
  { const float a_ = K[13], b_ = K[34]; K[13] = a_ > b_ ? a_ : b_; }
  { const float a_ = K[14], b_ = K[33]; K[14] = a_ > b_ ? a_ : b_; }
  { const float a_ = K[15], b_ = K[32]; K[15] = a_ > b_ ? a_ : b_; }
  { const float a_ = K[0], b_ = K[8]; const bool g_ = a_ > b_; K[0] = g_ ? a_ : b_; K[8] = g_ ? b_ : a_; }
  { const float a_ = K[1], b_ = K[9]; const bool g_ = a_ > b_; K[1] = g_ ? a_ : b_; K[9] = g_ ? b_ : a_; }
  { const float a_ = K[2], b_ = K[10]; const bool g_ = a_ > b_; K[2] = g_ ? a_ : b_; K[10] = g_ ? b_ : a_; }
  { const float a_ = K[3], b_ = K[11]; const bool g_ = a_ > b_; K[3] = g_ ? a_ : b_; K[11] = g_ ? b_ : a_; }
  { const float a_ = K[4], b_ = K[12]; const bool g_ = a_ > b_; K[4] = g_ ? a_ : b_; K[12] = g_ ? b_ : a_; }
  { const float a_ = K[5], b_ = K[13]; const bool g_ = a_ > b_; K[5] = g_ ? a_ : b_; K[13] = g_ ? b_ : a_; }
  { const float a_ = K[6], b_ = K[14]; const bool g_ = a_ > b_; K[6] = g_ ? a_ : b_; K[14] = g_ ? b_ : a_; }
  { const float a_ = K[7], b_ = K[15]; const bool g_ = a_ > b_; K[7] = g_ ? a_ : b_; K[15] = g_ ? b_ : a_; }
  { const float a_ = K[0], b_ = K[4]; const bool g_ = a_ > b_; K[0] = g_ ? a_ : b_; K[4] = g_ ? b_ : a_; }
  { const float a_ = K[1], b_ = K[5]; const bool g_ = a_ > b_; K[1] = g_ ? a_ : b_; K[5] = g_ ? b_ : a_; }
  { const float a_ = K[2], b_ = K[6]; const bool g_ = a_ > b_; K[2] = g_ ? a_ : b_; K[6] = g_ ? b_ : a_; }
  { const float a_ = K[3], b_ = K[7]; const bool g_ = a_ > b_; K[3] = g_ ? a_ : b_; K[7] = g_ ? b_ : a_; }
  { const float a_ = K[8], b_ = K[12]; const bool g_ = a_ > b_; K[8] = g_ ? a_ : b_; K[12] = g_ ? b_ : a_; }
  { const float a_ = K[9], b_ = K[13]; const bool g_ = a_ > b_; K[9] = g_ ? a_ : b_; K[13] = g_ ? b_ : a_; }
  { const float a_ = K[10], b_ = K[14]; const bool g_ = a_ > b_; K[10] = g_ ? a_ : b_; K[14] = g_ ? b_ : a_; }
  { const float a_ = K[11], b_ = K[15]; const bool g_ = a_ > b_; K[11] = g_ ? a_ : b_; K[15] = g_ ? b_ : a_; }
  { const float a_ = K[0], b_ = K[2]; const bool g_ = a_ > b_; K[0] = g_ ? a_ : b_; K[2] = g_ ? b_ : a_; }
  { const float a_ = K[1], b_ = K[3]; const bool g_ = a_ > b_; K[1] = g_ ? a_ : b_; K[3] = g_ ? b_ : a_; }
  { const float a_ = K[4], b_ = K[6]; const bool g_ = a_ > b_; K[4] = g_ ? a_ : b_; K[6] = g_ ? b_ : a_; }
  { const float a_ = K[5], b_ = K[7]; const bool g_ = a_ > b_; K[5] = g_ ? a_ : b_; K[7] = g_ ? b_ : a_; }
  { const float a_ = K[8], b_ = K[10]; const bool g_ = a_ > b_; K[8] = g_ ? a_ : b_; K[10] = g_ ? b_ : a_; }
  { const float a_ = K[9], b_ = K[11]; const bool g_ = a_ > b_; K[9] = g_ ? a_ : b_; K[11] = g_ ? b_ : a_; }
  { const float a_ = K[12], b_ = K[14]; const bool g_ = a_ > b_; K[12] = g_ ? a_ : b_; K[14] = g_ ? b_ : a_; }
  { const float a_ = K[13], b_ = K[15]; const bool g_ = a_ > b_; K[13] = g_ ? a_ : b_; K[15] = g_ ? b_ : a_; }
  { const float a_ = K[0], b_ = K[1]; const bool g_ = a_ > b_; K[0] = g_ ? a_ : b_; K[1] = g_ ? b_ : a_; }
  { const float a_ = K[2], b_ = K[3]; const bool g_ = a_ > b_; K[2] = g_ ? a_ : b_; K[3] = g_ ? b_ : a_; }
  { const float a_ = K[4], b_ = K[5]; const bool g_ = a_ > b_; K[4] = g_ ? a_ : b_; K[5] = g_ ? b_ : a_; }
  { const float a_ = K[6], b_ = K[7]; const bool g_ = a_ > b_; K[6] = g_ ? a_ : b_; K[7] = g_ ? b_ : a_; }
  { const float a_ = K[8], b_ = K[9]; const bool g_ = a_ > b_; K[8] = g_ ? a_ : b_; K[9] = g_ ? b_ : a_; }
  { const float a_ = K[10], b_ = K[11]; const bool g_ = a_ > b_; K[10] = g_ ? a_ : b_; K[11] = g_ ? b_ : a_; }
  { const float a_ = K[12], b_ = K[13]; const bool g_ = a_ > b_; K[12] = g_ ? a_ : b_; K[13] = g_ ? b_ : a_; }
  { const float a_ = K[14], b_ = K[15]; const bool g_ = a_ > b_; K[14] = g_ ? a_ : b_; K[15] = g_ ? b_ : a_; }
}
__device__ __forceinline__ void merge_top16(float (&T)[16], const float (&P)[16]) {
  { const float a_ = T[0], b_ = P[15]; T[0] = a_ > b_ ? a_ : b_; }
  { const float a_ = T[1], b_ = P[14]; T[1] = a_ > b_ ? a_ : b_; }
  { const float a_ = T[2], b_ = P[13]; T[2] = a_ > b_ ? a_ : b_; }
  { const float a_ = T[3], b_ = P[12]; T[3] = a_ > b_ ? a_ : b_; }
  { const float a_ = T[4], b_ = P[11]; T[4] = a_ > b_ ? a_ : b_; }
  { const float a_ = T[5], b_ = P[10]; T[5] = a_ > b_ ? a_ : b_; }
  { const float a_ = T[6], b_ = P[9]; T[6] = a_ > b_ ? a_ : b_; }
  { const float a_ = T[7], b_ = P[8]; T[7] = a_ > b_ ? a_ : b_; }
  { const float a_ = T[8], b_ = P[7]; T[8] = a_ > b_ ? a_ : b_; }
  { const float a_ = T[9], b_ = P[6]; T[9] = a_ > b_ ? a_ : b_; }
  { const float a_ = T[10], b_ = P[5]; T[10] = a_ > b_ ? a_ : b_; }
  { const float a_ = T[11], b_ = P[4]; T[11] = a_ > b_ ? a_ : b_; }
  { const float a_ = T[12], b_ = P[3]; T[12] = a_ > b_ ? a_ : b_; }
  { const float a_ = T[13], b_ = P[2]; T[13] = a_ > b_ ? a_ : b_; }
  { const float a_ = T[14], b_ = P[1]; T[14] = a_ > b_ ? a_ : b_; }
  { const float a_ = T[15], b_ = P[0]; T[15] = a_ > b_ ? a_ : b_; }
  { const float a_ = T[0], b_ = T[8]; const bool g_ = a_ > b_; T[0] = g_ ? a_ : b_; T[8] = g_ ? b_ : a_; }
  { const float a_ = T[1], b_ = T[9]; const bool g_ = a_ > b_; T[1] = g_ ? a_ : b_; T[9] = g_ ? b_ : a_; }
  { const float a_ = T[2], b_ = T[10]; const bool g_ = a_ > b_; T[2] = g_ ? a_ : b_; T[10] = g_ ? b_ : a_; }
  { const float a_ = T[3], b_ = T[11]; const bool g_ = a_ > b_; T[3] = g_ ? a_ : b_; T[11] = g_ ? b_ : a_; }
  { const float a_ = T[4], b_ = T[12]; const bool g_ = a_ > b_; T[4] = g_ ? a_ : b_; T[12] = g_ ? b_ : a_; }
  { const float a_ = T[5], b_ = T[13]; const bool g_ = a_ > b_; T[5] = g_ ? a_ : b_; T[13] = g_ ? b_ : a_; }
  { const float a_ = T[6], b_ = T[14]; const bool g_ = a_ > b_; T[6] = g_ ? a_ : b_; T[14] = g_ ? b_ : a_; }
  { const float a_ = T[7], b_ = T[15]; const bool g_ = a_ > b_; T[7] = g_ ? a_ : b_; T[15] = g_ ? b_ : a_; }
  { const float a_ = T[0], b_ = T[4]; const bool g_ = a_ > b_; T[0] = g_ ? a_ : b_; T[4] = g_ ? b_ : a_; }
  { const float a_ = T[1], b_ = T[5]; const bool g_ = a_ > b_; T[1] = g_ ? a_ : b_; T[5] = g_ ? b_ : a_; }
  { const float a_ = T[2], b_ = T[6]; const bool g_ = a_ > b_; T[2] = g_ ? a_ : b_; T[6] = g_ ? b_ : a_; }
  { const float a_ = T[3], b_ = T[7]; const bool g_ = a_ > b_; T[3] = g_ ? a_ : b_; T[7] = g_ ? b_ : a_; }
  { const float a_ = T[8], b_ = T[12]; const bool g_ = a_ > b_; T[8] = g_ ? a_ : b_; T[12] = g_ ? b_ : a_; }
  { const float a_ = T[9], b_ = T[13]; const bool g_ = a_ > b_; T[9] = g_ ? a_ : b_; T[13] = g_ ? b_ : a_; }
  { const float a_ = T[10], b_ = T[14]; const bool g_ = a_ > b_; T[10] = g_ ? a_ : b_; T[14] = g_ ? b_ : a_; }
  { const float a_ = T[11], b_ = T[15]; const bool g_ = a_ > b_; T[11] = g_ ? a_ : b_; T[15] = g_ ? b_ : a_; }
  { const float a_ = T[0], b_ = T[2]; const bool g_ = a_ > b_; T[0] = g_ ? a_ : b_; T[2] = g_ ? b_ : a_; }
  { const float a_ = T[1], b_ = T[3]; const bool g_ = a_ > b_; T[1] = g_ ? a_ : b_; T[3] = g_ ? b_ : a_; }
  { const float a_ = T[4], b_ = T[6]; const bool g_ = a_ > b_; T[4] = g_ ? a_ : b_; T[6] = g_ ? b_ : a_; }
  { const float a_ = T[5], b_ = T[7]; const bool g_ = a_ > b_; T[5] = g_ ? a_ : b_; T[7] = g_ ? b_ : a_; }
  { const float a_ = T[8], b_ = T[10]; const bool g_ = a_ > b_; T[8] = g_ ? a_ : b_; T[10] = g_ ? b_ : a_; }
  { const float a_ = T[9], b_ = T[11]; const bool g_ = a_ > b_; T[9] = g_ ? a_ : b_; T[11] = g_ ? b_ : a_; }
  { const float a_ = T[12], b_ = T[14]; const bool g_ = a_ > b_; T[12] = g_ ? a_ : b_; T[14] = g_ ? b_ : a_; }
  { const float a_ = T[13], b_ = T[15]; const bool g_ = a_ > b_; T[13] = g_ ? a_ : b_; T[15] = g_ ? b_ : a_; }
  { const float a_ = T[0], b_ = T[1]; const bool g_ = a_ > b_; T[0] = g_ ? a_ : b_; T[1] = g_ ? b_ : a_; }
  { const float a_ = T[2], b_ = T[3]; const bool g_ = a_ > b_; T[2] = g_ ? a_ : b_; T[3] = g_ ? b_ : a_; }
  { const float a_ = T[4], b_ = T[5]; const bool g_ = a_ > b_; T[4] = g_ ? a_ : b_; T[5] = g_ ? b_ : a_; }
  { const float a_ = T[6], b_ = T[7]; const bool g_ = a_ > b_; T[6] = g_ ? a_ : b_; T[7] = g_ ? b_ : a_; }
  { const float a_ = T[8], b_ = T[9]; const bool g_ = a_ > b_; T[8] = g_ ? a_ : b_; T[9] = g_ ? b_ : a_; }
  { const float a_ = T[10], b_ = T[11]; const bool g_ = a_ > b_; T[10] = g_ ? a_ : b_; T[11] = g_ ? b_ : a_; }
  { const float a_ = T[12], b_ = T[13]; const bool g_ = a_ > b_; T[12] = g_ ? a_ : b_; T[13] = g_ ? b_ : a_; }
  { const float a_ = T[14], b_ = T[15]; const bool g_ = a_ > b_; T[14] = g_ ? a_ : b_; T[15] = g_ ? b_ : a_; }
}

__device__ __forceinline__ void peer_topk(const int wave_s, const bf16* pq, const bf16* skb, int* ids, float* gates, LAS float* smem) {
  const int tid_ = opaque_tid(wave_s);
  const int lane = tid_ & 63, n = lane & 31, hh = lane >> 5, wave = tid_ >> 6;
  const int gw = blockIdx.x * NWAVES + wave;
  const int nw = gridDim.x * NWAVES;
  LAS float* lk = smem + wave * 2048;
  for (int it = gw; it < 512 * 8; it += nw) {
    const int h = it & 7, tok0 = (it >> 3) * 32;
#pragma unroll 1
    for (int half = 0; half < 2; half++) {
      bf16x8_t qf[8];
      {
        const bf16* qrow = pq + (size_t)(tok0 + n) * 2048 + h * 256 + half * 128 + 8 * hh;
#pragma unroll
        for (int ks = 0; ks < 8; ks++) qf[ks] = *(const bf16x8_t*)(qrow + 16 * ks);
      }
      float K[64];
#pragma unroll
      for (int kt = 0; kt < 4; kt++) {
        const bf16* krow = skb + ((size_t)((h * 2 + half) * 128 + kt * 32 + n)) * 128 + 8 * hh;
        f32x16_t acc;
#pragma unroll
        for (int r = 0; r < 16; r++) acc[r] = 0.f;
#pragma unroll
        for (int kq = 0; kq < 2; kq++) {
          bf16x8_t kf[4];
#pragma unroll
          for (int i = 0; i < 4; i++) kf[i] = *(const bf16x8_t*)(krow + 16 * (kq * 4 + i));
          MFMA_PAD();
#pragma unroll
          for (int i = 0; i < 4; i++) acc = __builtin_amdgcn_mfma_f32_32x32x16_bf16(kf[i], qf[kq * 4 + i], acc, 0, 0, 0);
          MFMA_PAD();
        }
#pragma unroll
        for (int i = 0; i < 16; i++) K[kt * 16 + i] = pack_key<0x7Fu>(acc[i], (unsigned)(kt * 32 + (i & 3) + 8 * (i >> 2) + 4 * hh));
      }
      __builtin_amdgcn_sched_barrier(0);
      top16_of_64(K);
      __builtin_amdgcn_sched_barrier(0);
      float T[16], P[16];
#pragma unroll
      for (int i = 0; i < 16; i++) { T[i] = K[i]; P[i] = __shfl_xor(K[i], 32, 64); }
      merge_top16(T, P);
#pragma unroll
      for (int i = 0; i < 16; i++) lk[(half * 16 + i) * 64 + lane] = T[i];
      __builtin_amdgcn_sched_barrier(0);
    }
    float f0[16], f1[16];
    int ti0[16], ti1[16];
#pragma unroll
    for (int i = 0; i < 16; i++) {
      const float k0 = lk[i * 64 + lane], k1 = lk[(16 + i) * 64 + lane];
      f0[i] = key_val<0x7Fu>(k0); ti0[i] = (int)key_idx<0x7Fu>(k0);
      f1[i] = key_val<0x7Fu>(k1); ti1[i] = (int)key_idx<0x7Fu>(k1);
    }
    float K[64];
    {
    K[0] = pack_key<0xFFu>(f0[0] + f1[0], 0u);
    K[1] = pack_key<0xFFu>(f0[0] + f1[1], 1u);
    K[2] = pack_key<0xFFu>(f0[0] + f1[2], 2u);
    K[3] = pack_key<0xFFu>(f0[0] + f1[3], 3u);
    K[4] = pack_key<0xFFu>(f0[0] + f1[4], 4u);
    K[5] = pack_key<0xFFu>(f0[0] + f1[5], 5u);
    K[6] = pack_key<0xFFu>(f0[0] + f1[6], 6u);
    K[7] = pack_key<0xFFu>(f0[0] + f1[7], 7u);
    K[8] = pack_key<0xFFu>(f0[0] + f1[8], 8u);
    K[9] = pack_key<0xFFu>(f0[0] + f1[9], 9u);
    K[10] = pack_key<0xFFu>(f0[0] + f1[10], 10u);
    K[11] = pack_key<0xFFu>(f0[0] + f1[11], 11u);
    K[12] = pack_key<0xFFu>(f0[0] + f1[12], 12u);
    K[13] = pack_key<0xFFu>(f0[0] + f1[13], 13u);
    K[14] = pack_key<0xFFu>(f0[0] + f1[14], 14u);
    K[15] = pack_key<0xFFu>(f0[0] + f1[15], 15u);
    K[16] = pack_key<0xFFu>(f0[1] + f1[0], 16u);
    K[17] = pack_key<0xFFu>(f0[1] + f1[1], 17u);
    K[18] = pack_key<0xFFu>(f0[1] + f1[2], 18u);
    K[19] = pack_key<0xFFu>(f0[1] + f1[3], 19u);
    K[20] = pack_key<0xFFu>(f0[1] + f1[4], 20u);
    K[21] = pack_key<0xFFu>(f0[1] + f1[5], 21u);
    K[22] = pack_key<0xFFu>(f0[1] + f1[6], 22u);
    K[23] = pack_key<0xFFu>(f0[1] + f1[7], 23u);
    K[24] = pack_key<0xFFu>(f0[2] + f1[0], 32u);
    K[25] = pack_key<0xFFu>(f0[2] + f1[1], 33u);
    K[26] = pack_key<0xFFu>(f0[2] + f1[2], 34u);
    K[27] = pack_key<0xFFu>(f0[2] + f1[3], 35u);
    K[28] = pack_key<0xFFu>(f0[2] + f1[4], 36u);
    K[29] = pack_key<0xFFu>(f0[3] + f1[0], 48u);
    K[30] = pack_key<0xFFu>(f0[3] + f1[1], 49u);
    K[31] = pack_key<0xFFu>(f0[3] + f1[2], 50u);
    K[32] = pack_key<0xFFu>(f0[3] + f1[3], 51u);
    K[33] = pack_key<0xFFu>(f0[4] + f1[0], 64u);
    K[34] = pack_key<0xFFu>(f0[4] + f1[1], 65u);
    K[35] = pack_key<0xFFu>(f0[4] + f1[2], 66u);
    K[36] = pack_key<0xFFu>(f0[5] + f1[0], 80u);
    K[37] = pack_key<0xFFu>(f0[5] + f1[1], 81u);
    K[38] = pack_key<0xFFu>(f0[6] + f1[0], 96u);
    K[39] = pack_key<0xFFu>(f0[6] + f1[1], 97u);
    K[40] = pack_key<0xFFu>(f0[7] + f1[0], 112u);
    K[41] = pack_key<0xFFu>(f0[7] + f1[1], 113u);
    K[42] = pack_key<0xFFu>(f0[8] + f1[0], 128u);
    K[43] = pack_key<0xFFu>(f0[9] + f1[0], 144u);
    K[44] = pack_key<0xFFu>(f0[10] + f1[0], 160u);
    K[45] = pack_key<0xFFu>(f0[11] + f1[0], 176u);
    K[46] = pack_key<0xFFu>(f0[12] + f1[0], 192u);
    K[47] = pack_key<0xFFu>(f0[13] + f1[0], 208u);
    K[48] = pack_key<0xFFu>(f0[14] + f1[0], 224u);
    K[49] = pack_key<0xFFu>(f0[15] + f1[0], 240u);
    K[50] = -3.0e38f;
    K[51] = -3.0e38f;
    K[52] = -3.0e38f;
    K[53] = -3.0e38f;
    K[54] = -3.0e38f;
    K[55] = -3.0e38f;
    K[56] = -3.0e38f;
    K[57] = -3.0e38f;
    K[58] = -3.0e38f;
    K[59] = -3.0e38f;
    K[60] = -3.0e38f;
    K[61] = -3.0e38f;
    K[62] = -3.0e38f;
    K[63] = -3.0e38f;
    }
    __builtin_amdgcn_sched_barrier(0);
    top16_of_64(K);
    __builtin_amdgcn_sched_barrier(0);
    float bv[16];
    int be[16];
#pragma unroll
    for (int r = 0; r < 16; r++) {
      const int flat = (int)key_idx<0xFFu>(K[r]);
      const int a = flat >> 4, b = flat & 15;
      int i0 = 0, i1 = 0;
#pragma unroll
      for (int i = 0; i < 16; i++) { i0 = (a == i) ? ti0[i] : i0; i1 = (b == i) ? ti1[i] : i1; }
      be[r] = i0 * 128 + i1;
      bv[r] = key_val<0xFFu>(K[r]);
    }
    const float b0 = bv[0];
    float ge[16];
    float gsum = 0.f;
#pragma unroll
    for (int r = 0; r < 16; r++) { ge[r] = __expf(bv[r] - b0); gsum += ge[r]; }
    const float ginv = 1.0f / gsum;
    if (hh == 0) {
      int* ip = ids + (size_t)(tok0 + n) * 128 + h * 16;
      float* gp = gates + (size_t)(tok0 + n) * 128 + h * 16;
#pragma unroll
      for (int r4 = 0; r4 < 4; r4++) {
        *(int4*)(ip + 4 * r4) = make_int4(be[4 * r4], be[4 * r4 + 1], be[4 * r4 + 2], be[4 * r4 + 3]);
        *(float4*)(gp + 4 * r4) = make_float4(ge[4 * r4] * ginv, ge[4 * r4 + 1] * ginv, ge[4 * r4 + 2] * ginv, ge[4 * r4 + 3] * ginv);
      }
    }
  }
}

typedef _Float16 f16x2_t __attribute__((ext_vector_type(2)));
__device__ __forceinline__ unsigned e4m3x2_to_f16x2(unsigned w, unsigned sel) {
  return __builtin_amdgcn_perm(w, w, sel);
}
__device__ __forceinline__ float dot2h(unsigned a, unsigned b, float c) {
  return __builtin_amdgcn_fdot2(__builtin_bit_cast(f16x2_t, a), __builtin_bit_cast(f16x2_t, b), c, false);
}
__device__ __forceinline__ unsigned pack_h2(float lo, float hi) {
  f16x2_t v; v.x = (_Float16)lo; v.y = (_Float16)hi;
  return __builtin_bit_cast(unsigned, v);
}
template <bool FINAL>
__device__ __forceinline__ void peer_gather(const int wave_s, bf16* xn, const float* rst, const unsigned char* ub, const unsigned char* vb,
                                            const int* ids, const float* gates, float* xw, const float* gnext, float* outp) {
  const int tid_ = opaque_tid(wave_s);
  const int lane = tid_ & 63;
  const int gw = blockIdx.x * NWAVES + (tid_ >> 6);
  const int nw = gridDim.x * NWAVES;
  const int el = ((lane >> 5) & 1) * 4 + ((lane >> 4) & 1) * 2 + ((lane >> 3) & 1);
  for (int tok = gw; tok < NT; tok += nw) {
    unsigned xh[8];
    {
      const uint4 a = *(const uint4*)(xn + (size_t)tok * DM + lane * 16);
      const uint4 b = *(const uint4*)(xn + (size_t)tok * DM + lane * 16 + 8);
      const unsigned xw_[8] = {a.x, a.y, a.z, a.w, b.x, b.y, b.z, b.w};
      const float4* sp = (const float4*)(rst + (size_t)tok * 16);
      const float4 s0 = sp[0], s1 = sp[1], s2 = sp[2], s3 = sp[3];
      const float xs = rsqrtf((((s0.x + s0.y) + (s0.z + s0.w)) + ((s1.x + s1.y) + (s1.z + s1.w)) + ((s2.x + s2.y) + (s2.z + s2.w)) + ((s3.x + s3.y) + (s3.z + s3.w))) * (1.0f / 1024.f) + EPSF);
#pragma unroll
      for (int k = 0; k < 8; k++) xh[k] = pack_h2(bf_lo(xw_[k]) * xs, bf_hi(xw_[k]) * xs);
    }
    float acc[16];
#pragma unroll
    for (int i = 0; i < 16; i++) acc[i] = 0.f;
#pragma unroll 1
    for (int g = 0; g < 16; g++) {
      const int idv = ids[(size_t)tok * 128 + g * 8 + (lane & 7)];
      const float gv = gates[(size_t)tok * 128 + g * 8 + el];
      uint4 uu[8], vv[8];
#pragma unroll
      for (int e = 0; e < 8; e++) {
        const int id = __builtin_amdgcn_readlane(idv, e);
        uu[e] = *(const uint4*)(ub + (size_t)id * DM + lane * 16);
        vv[e] = *(const uint4*)(vb + (size_t)id * DM + lane * 16);
      }
      float d[8];
#pragma unroll
      for (int e = 0; e < 8; e++) {
        const unsigned uw[4] = {uu[e].x, uu[e].y, uu[e].z, uu[e].w};
        float s = 0.f;
#pragma unroll
        for (int k = 0; k < 4; k++) {
          s = dot2h(e4m3x2_to_f16x2(uw[k], 0x010c000cu), xh[2 * k], s);
          s = dot2h(e4m3x2_to_f16x2(uw[k], 0x030c020cu), xh[2 * k + 1], s);
        }
        d[e] = s;
      }
      float d4[4], d2[2], d1;
      {
        const bool hi = (lane & 32) != 0;
#pragma unroll
        for (int i = 0; i < 4; i++) { const float send = hi ? d[i] : d[i + 4]; const float keep = hi ? d[i + 4] : d[i]; d4[i] = keep + __shfl_xor(send, 32, 64); }
      }
      {
        const bool hi = (lane & 16) != 0;
#pragma unroll
        for (int i = 0; i < 2; i++) { const float send = hi ? d4[i] : d4[i + 2]; const float keep = hi ? d4[i + 2] : d4[i]; d2[i] = keep + __shfl_xor(send, 16, 64); }
      }
      {
        const bool hi = (lane & 8) != 0;
        const float send = hi ? d2[0] : d2[1];
        const float keep = hi ? d2[1] : d2[0];
        d1 = keep + __shfl_xor(send, 8, 64);
      }
      d1 += __shfl_xor(d1, 4, 64);
      d1 += __shfl_xor(d1, 2, 64);
      d1 += __shfl_xor(d1, 1, 64);
      const float wl = gv * gelu_tanh(d1 * (1.0f / U_SCALE)) * (1.0f / V_SCALE);
#pragma unroll
      for (int e = 0; e < 8; e++) {
        const float w = __builtin_bit_cast(float, __builtin_amdgcn_readlane(__builtin_bit_cast(int, wl), ((e >> 2) & 1) * 32 + ((e >> 1) & 1) * 16 + (e & 1) * 8));
        const unsigned wlo = pack_h2(w, 0.f), whi = pack_h2(0.f, w);
        const unsigned vw[4] = {vv[e].x, vv[e].y, vv[e].z, vv[e].w};
#pragma unroll
        for (int k = 0; k < 4; k++) {
          const unsigned h0 = e4m3x2_to_f16x2(vw[k], 0x010c000cu), h1 = e4m3x2_to_f16x2(vw[k], 0x030c020cu);
          acc[4 * k + 0] = dot2h(h0, wlo, acc[4 * k + 0]);
          acc[4 * k + 1] = dot2h(h0, whi, acc[4 * k + 1]);
          acc[4 * k + 2] = dot2h(h1, wlo, acc[4 * k + 2]);
          acc[4 * k + 3] = dot2h(h1, whi, acc[4 * k + 3]);
        }
      }
    }
    float* xr = xw + (size_t)tok * DM + lane * 16;
    float xv[16];
    float ssq = 0.f;
#pragma unroll
    for (int c = 0; c < 4; c++) {
      float4 a0 = *(float4*)(xr + c * 4);
      a0.x += acc[c * 4 + 0]; a0.y += acc[c * 4 + 1]; a0.z += acc[c * 4 + 2]; a0.w += acc[c * 4 + 3];
      if (!FINAL) *(float4*)(xr + c * 4) = a0;
      xv[c * 4 + 0] = a0.x; xv[c * 4 + 1] = a0.y; xv[c * 4 + 2] = a0.z; xv[c * 4 + 3] = a0.w;
      ssq += a0.x * a0.x + a0.y * a0.y + a0.z * a0.z + a0.w * a0.w;
    }
    ssq = wsum(ssq);
    const float rstd = rsqrtf(ssq * (1.0f / DM) + EPSF);
    const float4* g4 = (const float4*)(gnext + lane * 16);
    if (FINAL) {
      float* op = outp + (size_t)tok * DM + lane * 16;
#pragma unroll
      for (int c = 0; c < 4; c++) {
        const float4 gq = g4[c];
        *(float4*)(op + c * 4) = make_float4(xv[c * 4] * rstd * gq.x, xv[c * 4 + 1] * rstd * gq.y, xv[c * 4 + 2] * rstd * gq.z, xv[c * 4 + 3] * rstd * gq.w);
      }
    } else {
      uint4 o0, o1;
      { const float4 ga = g4[0], gb = g4[1];
        o0.x = pk2(xv[0] * rstd * ga.x, xv[1] * rstd * ga.y); o0.y = pk2(xv[2] * rstd * ga.z, xv[3] * rstd * ga.w);
        o0.z = pk2(xv[4] * rstd * gb.x, xv[5] * rstd * gb.y); o0.w = pk2(xv[6] * rstd * gb.z, xv[7] * rstd * gb.w); }
      { const float4 ga = g4[2], gb = g4[3];
        o1.x = pk2(xv[8] * rstd * ga.x, xv[9] * rstd * ga.y); o1.y = pk2(xv[10] * rstd * ga.z, xv[11] * rstd * ga.w);
        o1.z = pk2(xv[12] * rstd * gb.x, xv[13] * rstd * gb.y); o1.w = pk2(xv[14] * rstd * gb.z, xv[15] * rstd * gb.w); }
      *(uint4*)(xn + (size_t)tok * DM + lane * 16) = o0;
      *(uint4*)(xn + (size_t)tok * DM + lane * 16 + 8) = o1;
    }
  }
}

__device__ __forceinline__ void prologue_transposes(const int wave_s, const Params& p, unsigned char* ws, LAS unsigned char* lds) {
  const int tid_ = opaque_tid(wave_s);
  const int lane = tid_ & 63, wave = tid_ >> 6;
  LAS float* scr = (LAS float*)(lds + wave * 16384);
  const int gw = blockIdx.x * NWAVES + wave, NGW = gridDim.x * NWAVES;
  constexpr int I_IN = (DM / 64) * (DIN / 32), I_SQ = (DM / 64) * (DM / 32), I_2K = (DM / 64) * (2048 / 32);
  constexpr int I_GL = (256 / 64) * (256 / 32);
  constexpr int PER_LAYER = I_IN + 3 * I_SQ + 2 * I_2K + I_GL;
  const float* w3 = karg_in(3); const float* w19 = karg_in(19); const float* w22 = karg_in(22);
  const float* w23 = karg_in(23); const float* w24 = karg_in(24); const float* w26 = karg_in(26);
  const float* w16 = karg_in(16);
  for (int it = gw; it < 2 * PER_LAYER; it += NGW) {
    const int l = it / PER_LAYER;
    int r = it % PER_LAYER;
    unsigned char* wl = ws + WS_WT + (size_t)l * WT_LAYER;
    if (r < I_IN) { transpose_item(w3 + (size_t)l * DM * DIN, DM, DIN, (bf16*)(wl + WT_IN), scr, r, lane); continue; } r -= I_IN;
    if (r < I_SQ) { transpose_item(w19 + (size_t)l * DM * DM, DM, DM, (bf16*)(wl + WT_OUT), scr, r, lane); continue; } r -= I_SQ;
    if (r < I_SQ) { transpose_item(w22 + (size_t)l * DM * DM, DM, DM, (bf16*)(wl + WT_MQ), scr, r, lane); continue; } r -= I_SQ;
    if (r < I_2K) { transpose_item(w23 + (size_t)l * DM * 2048, DM, 2048, (bf16*)(wl + WT_MKV), scr, r, lane); continue; } r -= I_2K;
    if (r < I_SQ) { transpose_item(w24 + (size_t)l * DM * DM, DM, DM, (bf16*)(wl + WT_MO), scr, r, lane); continue; } r -= I_SQ;
    if (r < I_2K) { transpose_item(w26 + (size_t)l * DM * 2048, DM, 2048, (bf16*)(wl + WT_PQ), scr, r, lane); continue; } r -= I_2K;
    transpose_item(w16 + (size_t)l * 256 * 256, 256, 256, (bf16*)(wl + WT_GLU), scr, r, lane);
  }
}

template <class T> __device__ __forceinline__ T* opq(T* p) { asm volatile("" : "+s"(p)); return p; }
__device__ __forceinline__ void cvt_rows_bf16(const int wave_s, const float* src, bf16* dst, size_t n) {
  const int tid_ = opaque_tid(wave_s);
  const size_t gt = (size_t)blockIdx.x * (NWAVES * 64) + tid_;
  const size_t nth = (size_t)gridDim.x * NWAVES * 64;
  for (size_t i = gt; i < n / 8; i += nth) {
    const float4 a = ((const float4*)src)[2 * i], b = ((const float4*)src)[2 * i + 1];
    uint4 o; o.x = pk2(a.x, a.y); o.y = pk2(a.z, a.w); o.z = pk2(b.x, b.y); o.w = pk2(b.z, b.w);
    ((uint4*)dst)[i] = o;
  }
}

__device__ __forceinline__ unsigned enc_e4m3(float x) {
  const _Float16 hf = (_Float16)x;
  const unsigned h = (unsigned)__builtin_bit_cast(unsigned short, hf);
  return ((h + 0x7Fu + ((h >> 8) & 1u)) >> 8) & 0xFFu;
}
__device__ __forceinline__ void cvt_rows_e4m3(const int wave_s, const float* src, unsigned char* dst, size_t n, float sc) {
  const int tid_ = opaque_tid(wave_s);
  const size_t gt = (size_t)blockIdx.x * (NWAVES * 64) + tid_;
  const size_t nth = (size_t)gridDim.x * NWAVES * 64;
  for (size_t i = gt; i < n / 16; i += nth) {
    unsigned w[4];
#pragma unroll
    for (int k = 0; k < 4; k++) {
      const float4 a = ((const float4*)src)[4 * i + k];
      w[k] = enc_e4m3(a.x * sc) | (enc_e4m3(a.y * sc) << 8) | (enc_e4m3(a.z * sc) << 16) | (enc_e4m3(a.w * sc) << 24);
    }
    uint4 o; o.x = w[0]; o.y = w[1]; o.z = w[2]; o.w = w[3];
    ((uint4*)dst)[i] = o;
  }
}

#define GEMM_F32(Aptr, Wt, Cptr, Rptr, M_, N_) do { \
    pg8::Gemm g_{opq((const bf16*)(Aptr)), opq((const bf16*)(Wt)), (M_), (N_), DM}; pg8::StaticOrder S_; S_.init((M_), (N_), (int)gridDim.x, (int)blockIdx.x); \
    pg8::EpiF32R E_{opq((float*)(Cptr)), opq((const float*)(Rptr)), (N_)}; \
    pg8::gemm_phase<pg8::EpiF32R, pg8::StaticOrder, true, true>(wave_s, ldsl, g_, S_, E_); } while (0)
#define GEMM_BF16_C(Aptr, Wt, Optr, M_, N_, C_) do { \
    pg8::Gemm g_{opq((const bf16*)(Aptr)), opq((const bf16*)(Wt)), (M_), (N_), DM}; pg8::StaticOrder S_; S_.init((M_), (N_), (int)gridDim.x, (C_)); \
    pg8::EpiBf16 E_{opq((bf16*)(Optr)), (N_)}; \
    pg8::gemm_phase<pg8::EpiBf16, pg8::StaticOrder, true, true>(wave_s, ldsl, g_, S_, E_); } while (0)
#define GEMM_BF16(Aptr, Wt, Optr, M_, N_) GEMM_BF16_C(Aptr, Wt, Optr, M_, N_, (int)blockIdx.x)
#define GEMM_F32RN(Aptr, Wt, Cptr, Rptr, XGptr, Gptr, STptr) do { \
    pg8::Gemm g_{opq((const bf16*)(Aptr)), opq((const bf16*)(Wt)), NT, DM, DM}; pg8::StaticOrder S_; S_.init(NT, DM, (int)gridDim.x, (int)blockIdx.x); \
    pg8::EpiF32RN E_{opq((float*)(Cptr)), opq((const float*)(Rptr)), DM, opq((bf16*)(XGptr)), opq((const float*)(Gptr)), opq((float*)(STptr))}; \
    pg8::gemm_phase<pg8::EpiF32RN, pg8::StaticOrder, true, true>(wave_s, ldsl, g_, S_, E_); } while (0)
#define GEMM_BF16S(Aptr, Wt, Optr, N_, STptr) do { \
    pg8::Gemm g_{opq((const bf16*)(Aptr)), opq((const bf16*)(Wt)), NT, (N_), DM}; pg8::StaticOrder S_; S_.init(NT, (N_), (int)gridDim.x, (int)blockIdx.x); \
    pg8::EpiBf16S E_{opq((bf16*)(Optr)), (N_), opq((const float*)(STptr))}; \
    pg8::gemm_phase<pg8::EpiBf16S, pg8::StaticOrder, true, true>(wave_s, ldsl, g_, S_, E_); } while (0)

__global__ void __launch_bounds__(NWAVES * 64, 2) fwd_megakernel(Params p) {
  extern __shared__ __attribute__((aligned(16))) unsigned char lds[];
  LAS unsigned char* ldsl = (LAS unsigned char*)lds;
  LAS float* smem = (LAS float*)ldsl;
  const int wave_s = __builtin_amdgcn_readfirstlane((int)(threadIdx.x >> 6));
  unsigned char* ws = p.ws;
  volatile LAS unsigned* MISC = (volatile LAS unsigned*)(ldsl + (LDS_BYTES - 256));
  if (threadIdx.x < 64) MISC[threadIdx.x] = 0u;
  __syncthreads();
  const XcdBarrier bar = xcd_barrier_post((unsigned*)(ws + WS_CTL) + 4096, MISC + 8);
  float* xw = (float*)(ws + WS_XW);
  bf16* xn = (bf16*)(ws + WS_XN);
  bf16* big = (bf16*)(ws + WS_BIG);
  bf16* y = (bf16*)(ws + WS_Y);
  bf16* memh = (bf16*)(ws + WS_MEMH);
  bf16* kvb = (bf16*)(ws + WS_KVB);
  bf16* vT = (bf16*)(ws + WS_VT);
  float* ssmE = (float*)(ws + WS_SSME);
  float* ssmp = (float*)(ws + WS_SSMP);
  int* ids = (int*)(ws + WS_IDS);
  float* gates = (float*)(ws + WS_GATE);
  bf16* skb = (bf16*)(ws + WS_SKB);
  unsigned char* ub = ws + WS_UB;
  unsigned char* vb = ws + WS_VB;
  float* rst = (float*)(ws + WS_RST);

  prologue_transposes(wave_s, p, ws, ldsl);
  cvt_rows_bf16(wave_s, karg_in(27), skb, (size_t)2 * 8 * 2 * 128 * 128);
  cvt_rows_e4m3(wave_s, karg_in(28), ub, (size_t)2 * 16384 * 1024, U_SCALE);
  cvt_rows_e4m3(wave_s, karg_in(29), vb, (size_t)2 * 16384 * 1024, V_SCALE);
  for (int l = 0; l < 2; l++)
    rms_rows<true>(wave_s, karg_in(1), karg_in(21) + l * DM, memh + (size_t)l * 1024 * 1024, 1024);
  ssm_params(wave_s, p, ssmp);
  xcd_barrier(bar);
  for (int l = 0; l < 2; l++)
    GEMM_BF16_C(memh + (size_t)l * 1024 * 1024, ws + WS_WT + (size_t)l * WT_LAYER + WT_MKV,
              kvb + (size_t)l * 1024 * 2048, 1024, 2048, (int)((blockIdx.x + gridDim.x - 32u * (unsigned)l) % gridDim.x));

#pragma nounroll
  for (int l = 0; l < 2; l++) {
    const float* xcur = (l == 0) ? karg_in(0) : xw;
    const float* sp = ssmp + (size_t)l * SSMP_PER_LAYER;
    const unsigned char* wl = ws + WS_WT + (size_t)l * WT_LAYER;
    if (l == 0) {
      rms_rows<true>(wave_s, xcur, karg_in(2) + l * DM, xn, NT);
      xcd_barrier(bar);
    }
    GEMM_BF16(xn, wl + WT_IN, big, NT, DIN);
    xcd_barrier(bar);
    if (l == 0) vt_phase(wave_s, kvb, vT);
    ssm_chunk_end(wave_s, sp, big, ssmE);
    attn_phase(wave_s, p, l, big, y, smem);
    conv_phase(wave_s, p, l, big, y, smem);
    xcd_barrier(bar);
    ssm_finish(wave_s, p, l, sp, big, ssmE, y, smem);
    xcd_barrier(bar);
    GEMM_F32RN(y, wl + WT_OUT, xw, xcur, xn, karg_in(20) + l * DM, rst);
    xcd_barrier(bar);
    GEMM_BF16S(xn, wl + WT_MQ, big, DM, rst);
    xcd_barrier(bar);
    memattn_phase(wave_s, big, kvb + (size_t)l * 1024 * 2048, vT + (size_t)l * 4 * 4 * 256 * 256, y, smem);
    xcd_barrier(bar);
    GEMM_F32RN(y, wl + WT_MO, xw, (const float*)xw, xn, karg_in(25) + l * DM, rst);
    xcd_barrier(bar);
    GEMM_BF16S(xn, wl + WT_PQ, big, 2048, rst);
    xcd_barrier(bar);
    peer_topk(wave_s, big, skb + (size_t)l * 8 * 2 * 128 * 128, ids, gates, smem);
    xcd_barrier(bar);
    if (l == 0) {
      peer_gather<false>(wave_s, xn, rst, ub + (size_t)l * 16384 * DM, vb + (size_t)l * 16384 * DM, ids, gates, xw, karg_in(2) + DM, (float*)nullptr);
      xcd_barrier(bar);
    } else {
      peer_gather<true>(wave_s, xn, rst, ub + (size_t)l * 16384 * DM, vb + (size_t)l * 16384 * DM, ids, gates, xw, karg_in(30), p.out);
    }
  }
}

extern "C" void kernel_launch(void* const* d_in, const int* in_sizes, int n_in,
                              void* d_out, int out_size, void* d_ws, size_t ws_size,
                              hipStream_t stream) {
  static int grid_blocks = 0;
  if (!grid_blocks) {
    int dev = 0, cus = 0, per_cu = 0;
    (void)hipGetDevice(&dev);
    (void)hipDeviceGetAttribute(&cus, hipDeviceAttributeMultiprocessorCount, dev);
    (void)hipFuncSetAttribute((const void*)fwd_megakernel, hipFuncAttributeMaxDynamicSharedMemorySize, LDS_BYTES);
    (void)hipOccupancyMaxActiveBlocksPerMultiprocessor(&per_cu, fwd_megakernel, NWAVES * 64, LDS_BYTES);
    if (per_cu < 1) fprintf(stderr, "occupancy query reports %d blocks/CU\n", per_cu);
    grid_blocks = cus;
  }
  (void)hipMemsetAsync((char*)d_ws + WS_CTL, 0, 1 * MiB, stream);
  Params p{};
  for (int i = 0; i < 31; i++) p.in[i] = (const float*)d_in[i];
  p.out = (float*)d_out;
  p.ws = (unsigned char*)d_ws;
  void* args[] = {&p};
  hipError_t e = hipLaunchCooperativeKernel((void*)fwd_megakernel, dim3(grid_blocks), dim3(NWAVES * 64),
                                            args, LDS_BYTES, stream);
  if (e != hipSuccess)
    fprintf(stderr, "cooperative launch failed: %s (grid %d)\n", hipGetErrorString(e), grid_blocks);
}
```

```cpp
#include <hip/hip_runtime.h>
#include <hip/hip_cooperative_groups.h>
#include <cstdio>
namespace cg = cooperative_groups;

#define NT 16384
#define SEQ 4096
#define DM 1024
#define DIN 2304
#define NMEM 256
#define EPSF 1e-6f
#define NWAVES 8
#define LDS_BYTES 147456

typedef unsigned short bf16;
#define LAS __attribute__((address_space(3)))

struct Params {
  const float* in[31];
  float* out;
  unsigned char* ws;
};
typedef __attribute__((address_space(4))) const unsigned char* kaptr_t;
__device__ __forceinline__ const float* karg_in(int i) {
  kaptr_t ka = (kaptr_t)__builtin_amdgcn_kernarg_segment_ptr();
  asm volatile("" : "+s"(ka));
  return *(const float* __attribute__((address_space(4))) const*)(ka + 8 * i);
}

constexpr size_t MiB = 1u << 20;
constexpr size_t WS_CTL  = 0;
constexpr size_t WS_WT   = 1 * MiB;
constexpr size_t WT_IN = 0, WT_OUT = WT_IN + (size_t)DIN * DM * 2, WT_MQ = WT_OUT + (size_t)DM * DM * 2,
                 WT_MKV = WT_MQ + (size_t)DM * DM * 2, WT_MO = WT_MKV + (size_t)2048 * DM * 2,
                 WT_PQ = WT_MO + (size_t)DM * DM * 2, WT_GLU = WT_PQ + (size_t)2048 * DM * 2, WT_LAYER = WT_GLU + (size_t)256 * 256 * 2;
constexpr size_t WS_XW   = WS_WT + 2 * WT_LAYER;
constexpr size_t WS_XN   = WS_XW + (size_t)NT * DM * 4;
constexpr size_t WS_BIG  = WS_XN + (size_t)NT * DM * 2;
constexpr size_t WS_Y    = WS_BIG + (size_t)NT * DIN * 2;
constexpr size_t WS_MEMH = WS_Y + (size_t)NT * DM * 2;
constexpr size_t WS_KVB  = WS_MEMH + (size_t)2 * 1024 * 1024 * 2;
constexpr size_t WS_VT   = WS_KVB + (size_t)2 * 1024 * 2048 * 2;
constexpr size_t WS_SSME = WS_VT + (size_t)2 * 4 * 4 * 256 * 256 * 2;
#define SSMP_PER_LAYER (2048 + 2048 + 32768)
constexpr size_t WS_SSMP = WS_SSME + (size_t)4 * 64 * 16 * 64 * 2 * 4;
constexpr size_t WS_IDS  = WS_SSMP + (size_t)2 * SSMP_PER_LAYER * 4;
constexpr size_t WS_GATE = WS_IDS + (size_t)NT * 128 * 4;
constexpr size_t WS_SKB  = WS_GATE + (size_t)NT * 128 * 4;
constexpr size_t WS_UB   = WS_SKB + (size_t)2 * 8 * 2 * 128 * 128 * 2;
constexpr size_t WS_VB   = WS_UB + (size_t)2 * 16384 * 1024;
constexpr size_t WS_VSC  = WS_VB + (size_t)2 * 16384 * 512;
constexpr size_t WS_RST  = WS_VSC + (size_t)2 * 16384 * 4;
constexpr size_t WS_END  = WS_RST + (size_t)NT * 16 * 4;
#define U_SCALE 64.0f
#define V4_LUT_LO 0x3B393630u
#define V4_LUT_HI 0x41403E3Du
#define V4_ROWSCALE 1.075f
static_assert(WS_END <= 512 * MiB, "workspace");
static_assert(WT_LAYER % 256 == 0 && WS_SSMP % 16 == 0 && WS_IDS % 16 == 0 && WS_SKB % 256 == 0 && WS_VT % 256 == 0, "align");

__device__ __forceinline__ int opaque_tid(int wave_s) { int v = wave_s * 64 + (int)__builtin_amdgcn_mbcnt_hi(~0u, __builtin_amdgcn_mbcnt_lo(~0u, 0u)); asm volatile("" : "+v"(v)); return v; }
__device__ __forceinline__ unsigned f2bf(float f) { unsigned u = __builtin_bit_cast(unsigned, f); return (u + 0x7fffu + ((u >> 16) & 1u)) >> 16; }
__device__ __forceinline__ unsigned pk2(float lo, float hi) { return f2bf(lo) | (f2bf(hi) << 16); }
__device__ __forceinline__ float bf_lo(unsigned u) { return __builtin_bit_cast(float, u << 16); }
__device__ __forceinline__ float bf_hi(unsigned u) { return __builtin_bit_cast(float, u & 0xffff0000u); }
__device__ __forceinline__ float bf2f(bf16 h) { return __builtin_bit_cast(float, (unsigned)h << 16); }


#define XB_TMO      128
#define XB_XCNT(j)  (256  + 64 * (j))
#define XB_XSUB(j)  (1280 + 64 * (j))
#define XB_XGEN(j)  (2304 + 64 * (j))
#define XB_TOP      3328
#define XB_TOPGEN   3392
#define XCD_BAR_WORDS 3456
#define XB_SPIN_CAP (1u << 22)
__device__ __forceinline__ unsigned xb_ld(unsigned* p)              { return __hip_atomic_load(p, __ATOMIC_RELAXED, __HIP_MEMORY_SCOPE_AGENT); }
__device__ __forceinline__ unsigned xb_add(unsigned* p, unsigned v) { return __hip_atomic_fetch_add(p, v, __ATOMIC_RELAXED, __HIP_MEMORY_SCOPE_AGENT); }
__device__ __forceinline__ unsigned xb_xcc_id() { return (unsigned)__builtin_amdgcn_s_getreg((3 << 11) | 20) & 0xFu; }
#define XB_SPIN(cond, bar) do { unsigned _sp = 0; while (cond) { __builtin_amdgcn_s_sleep(1); \
    if ((++_sp & 255u) == 0u) { if (xb_ld(&(bar)[XB_TMO])) break; if (_sp > XB_SPIN_CAP) { atomicAdd(&(bar)[XB_TMO], 1u); break; } } } } while (0)
struct XcdBarrier { unsigned* bar; unsigned x; volatile LAS unsigned* st; };
__device__ __forceinline__ XcdBarrier xcd_barrier_post(unsigned* bar, volatile LAS unsigned* st) {
    XcdBarrier b; b.bar = bar; b.x = xb_xcc_id(); b.st = st;
    if (threadIdx.x == 0) (void)xb_add(&bar[XB_XCNT(b.x)], 1u);
    return b;
}
__device__ __forceinline__ void xcd_barrier_complete(unsigned* bar, unsigned x, unsigned& nloc, unsigned& nx) {
    const unsigned G = gridDim.x * gridDim.y * gridDim.z;
    unsigned sum, cnt, mine, sp = 0u;
    for (;;) {
        sum = 0u; cnt = 0u; mine = 0u;
#pragma unroll
        for (unsigned j = 0; j < 16; ++j) { const unsigned c = xb_ld(&bar[XB_XCNT(j)]); sum += c; cnt += (c > 0u) ? 1u : 0u; mine = (j == x) ? c : mine; }
        if (sum == G) break;
        __builtin_amdgcn_s_sleep(1);
        if ((++sp & 255u) == 0u) { if (xb_ld(&bar[XB_TMO])) break; if (sp > XB_SPIN_CAP) { atomicAdd(&bar[XB_TMO], 1u); break; } }
    }
    nloc = mine > 0u ? mine : 1u; nx = cnt > 0u ? cnt : 1u;
}
__device__ __forceinline__ void xcd_barrier(const XcdBarrier& b) {
    asm volatile("s_waitcnt vmcnt(0)" ::: "memory");
    __syncthreads();
    if (threadIdx.x == 0) {
        unsigned* bar = b.bar;
        __builtin_amdgcn_s_waitcnt(0);
        unsigned nloc = b.st[0], nx = b.st[1];
        if (nloc == 0u) { xcd_barrier_complete(bar, b.x, nloc, nx); b.st[0] = nloc; b.st[1] = nx; }
        const unsigned old = xb_add(&bar[XB_XSUB(b.x)], 1u);
        const unsigned gen = old / nloc;
        if (old + 1u == (gen + 1u) * nloc) {
            __builtin_amdgcn_fence(__ATOMIC_RELEASE, "agent");
            asm volatile("s_waitcnt vmcnt(0)" ::: "memory");
            const unsigned og = xb_add(&bar[XB_TOP], 1u);
            const unsigned tg = og / nx;
            if (og + 1u == (tg + 1u) * nx) xb_add(&bar[XB_TOPGEN], 1u);
            else XB_SPIN(xb_ld(&bar[XB_TOPGEN]) == tg, bar);
            __builtin_amdgcn_fence(__ATOMIC_ACQUIRE, "agent");
            xb_add(&bar[XB_XGEN(b.x)], 1u);
            asm volatile("s_waitcnt vmcnt(0)" ::: "memory");
        } else {
            XB_SPIN(xb_ld(&bar[XB_XGEN(b.x)]) == gen, bar);
            __builtin_amdgcn_fence(__ATOMIC_ACQUIRE, "agent");
            asm volatile("s_waitcnt vmcnt(0)" ::: "memory");
        }
    }
    __syncthreads();
}

namespace pg8 {
#define PG8_LAS __attribute__((address_space(3)))
typedef unsigned short bf16_t;
typedef short bf16x8 __attribute__((ext_vector_type(8)));
typedef float f32x4 __attribute__((ext_vector_type(4)));
typedef unsigned u32x4 __attribute__((ext_vector_type(4)));
constexpr int BM = 256, BK = 64, HALF = 128, HTB = HALF * BK * 2, STAGE_BYTES = 8 * HTB, NXCD = 8, WGM = 8;
__host__ __device__ __forceinline__ int lds_byte(int r, int c) { const int st = (r >> 4) * 2 + (c >> 5), rr = r & 15, cc = c & 31, ob = rr * 64 + cc * 2; return st * 1024 + (ob ^ (((ob >> 9) & 1) << 5)); }
__host__ __device__ __forceinline__ void stage_rc(int b, int& R, int& C) { const int st = b / 1024, sb = b % 1024, swz = sb ^ (((sb >> 9) & 1) << 5); R = (st >> 1) * 16 + swz / 64; C = (st & 1) * 32 + (swz % 64) / 2; }
__host__ __device__ __forceinline__ int perm32(int rho) { const int n = rho >> 4, i = rho & 15; return 8 * (i >> 2) + 4 * n + (i & 3); }
struct Unit { int pm, pn; };
struct Gemm { const bf16_t* A; const bf16_t* Bt; int M, N, K; };
struct StaticOrder {
    int nM, nN, nwg, G, c;
    __host__ __device__ __forceinline__ void init(int M, int N, int G_, int c_) { nM = M / BM; nN = N / BM; nwg = nM * nN; G = G_; c = c_; }
    __host__ __device__ bool next(int i, Unit& u) const {
        const long L = (long)i * G + c; if (L >= nwg) return false;
        int wgid = (int)L; { const int q = nwg / NXCD, r = nwg % NXCD, xcd = wgid % NXCD, off = wgid / NXCD; wgid = (xcd < r ? xcd * (q + 1) : r * (q + 1) + (xcd - r) * q) + off; }
        const int nig = WGM * nN, gid = wgid / nig, fm = gid * WGM, gsz = (nM - fm) < WGM ? (nM - fm) : WGM;
        u.pm = fm + ((wgid % nig) % gsz); u.pn = (wgid % nig) / gsz; return true;
    }
    __device__ __forceinline__ void a_ready(const Unit&) const {}
    __device__ __forceinline__ void done(const Unit&) const {}
};
__device__ __forceinline__ unsigned cvt_pk_bf16(float lo, float hi) { unsigned r; asm volatile("v_cvt_pk_bf16_f32 %0, %1, %2" : "=v"(r) : "v"(lo), "v"(hi)); return r; }

struct EpiF32R {
    static constexpr bool PERM = false, AFTER_DRAIN = false;
    float* C; const float* R; int ldc;
    __device__ __forceinline__ void operator()(const f32x4 (&acc)[2][2][4][2], const Unit& u, int wr, int wc, int fr, int fq) const {
        const int row0 = u.pm * BM + wr * 64 + fr, col0 = u.pn * BM + wc * 32 + 4 * fq;
#pragma unroll
        for (int ai = 0; ai < 2; ++ai)
#pragma unroll
            for (int m = 0; m < 4; ++m) {
                const size_t ro = (size_t)(row0 + ai * HALF + m * 16) * ldc + col0;
                f32x4 rv[2][2];
#pragma unroll
                for (int bj = 0; bj < 2; ++bj)
#pragma unroll
                    for (int n = 0; n < 2; ++n) rv[bj][n] = R ? *(const f32x4*)(R + ro + bj * HALF + n * 16) : (f32x4){0.f, 0.f, 0.f, 0.f};
#pragma unroll
                for (int bj = 0; bj < 2; ++bj)
#pragma unroll
                    for (int n = 0; n < 2; ++n) *(f32x4*)(C + ro + bj * HALF + n * 16) = acc[ai][bj][m][n] + rv[bj][n];
                __builtin_amdgcn_sched_barrier(0);
            }
    }
};

struct EpiBf16 {
    static constexpr bool PERM = true, AFTER_DRAIN = false;
    bf16_t* O; int ldc;
    __device__ __forceinline__ void operator()(const f32x4 (&acc)[2][2][4][2], const Unit& u, int wr, int wc, int fr, int fq) const {
        const int row0 = u.pm * BM + wr * 64 + fr, col0 = u.pn * BM + wc * 32 + 8 * fq;
#pragma unroll
        for (int ai = 0; ai < 2; ++ai)
#pragma unroll
            for (int m = 0; m < 4; ++m) { bf16_t* rowp = O + (size_t)(row0 + ai * HALF + m * 16) * ldc + col0;
#pragma unroll
                for (int bj = 0; bj < 2; ++bj) { const f32x4 v0 = acc[ai][bj][m][0], v1 = acc[ai][bj][m][1];
                    u32x4 w; w.x = cvt_pk_bf16(v0[0], v0[1]); w.y = cvt_pk_bf16(v0[2], v0[3]); w.z = cvt_pk_bf16(v1[0], v1[1]); w.w = cvt_pk_bf16(v1[2], v1[3]);
                    *(u32x4*)(rowp + bj * HALF) = w; } }
    }
};

struct EpiF32RN {
    static constexpr bool PERM = false, AFTER_DRAIN = false;
    float* C; const float* R; int ldc; bf16_t* XG; const float* g; float* st;
    __device__ __forceinline__ void operator()(const f32x4 (&acc)[2][2][4][2], const Unit& u, int wr, int wc, int fr, int fq) const {
        const int row0 = u.pm * BM + wr * 64 + fr, col0 = u.pn * BM + wc * 32 + 4 * fq;
        f32x4 gv[2][2];
#pragma unroll
        for (int bj = 0; bj < 2; ++bj)
#pragma unroll
            for (int n = 0; n < 2; ++n) gv[bj][n] = *(const f32x4*)(g + col0 + bj * HALF + n * 16);
#pragma unroll
        for (int ai = 0; ai < 2; ++ai)
#pragma unroll
            for (int m = 0; m < 4; ++m) {
                const int row = row0 + ai * HALF + m * 16;
                const size_t ro = (size_t)row * ldc + col0;
                f32x4 rv[2][2];
#pragma unroll
                for (int bj = 0; bj < 2; ++bj)
#pragma unroll
                    for (int n = 0; n < 2; ++n) rv[bj][n] = *(const f32x4*)(R + ro + bj * HALF + n * 16);
                float ss = 0.f;
#pragma unroll
                for (int bj = 0; bj < 2; ++bj)
#pragma unroll
                    for (int n = 0; n < 2; ++n) {
                        const f32x4 v = acc[ai][bj][m][n] + rv[bj][n];
                        *(f32x4*)(C + ro + bj * HALF + n * 16) = v;
                        ss += (v[0] * v[0] + v[1] * v[1]) + (v[2] * v[2] + v[3] * v[3]);
                        const f32x4 w = v * gv[bj][n];
                        uint2 pk; pk.x = cvt_pk_bf16(w[0], w[1]); pk.y = cvt_pk_bf16(w[2], w[3]);
                        *(uint2*)(XG + ro + bj * HALF + n * 16) = pk;
                    }
                ss += __shfl_xor(ss, 16, 64); ss += __shfl_xor(ss, 32, 64);
                if (fq == 0) st[(size_t)row * 16 + u.pn * 4 + wc] = ss;
                __builtin_amdgcn_sched_barrier(0);
            }
    }
};
struct EpiBf16S {
    static constexpr bool PERM = true, AFTER_DRAIN = false;
    bf16_t* O; int ldc; const float* st;
    __device__ __forceinline__ void operator()(const f32x4 (&acc)[2][2][4][2], const Unit& u, int wr, int wc, int fr, int fq) const {
        const int row0 = u.pm * BM + wr * 64 + fr, col0 = u.pn * BM + wc * 32 + 8 * fq;
#pragma unroll
        for (int ai = 0; ai < 2; ++ai)
#pragma unroll
            for (int m = 0; m < 4; ++m) {
                const int row = row0 + ai * HALF + m * 16;
                const f32x4* sp = (const f32x4*)(st + (size_t)row * 16);
                const f32x4 s0 = sp[0], s1 = sp[1], s2 = sp[2], s3 = sp[3];
                const f32x4 sa = (s0 + s1) + (s2 + s3);
                const float rs = __builtin_amdgcn_rsqf(((sa[0] + sa[1]) + (sa[2] + sa[3])) * (1.0f / 1024.f) + 1e-6f);
                bf16_t* rowp = O + (size_t)row * ldc + col0;
#pragma unroll
                for (int bj = 0; bj < 2; ++bj) { const f32x4 v0 = acc[ai][bj][m][0] * rs, v1 = acc[ai][bj][m][1] * rs;
                    u32x4 w; w.x = cvt_pk_bf16(v0[0], v0[1]); w.y = cvt_pk_bf16(v0[2], v0[3]); w.z = cvt_pk_bf16(v1[0], v1[1]); w.w = cvt_pk_bf16(v1[2], v1[3]);
                    *(u32x4*)(rowp + bj * HALF) = w; }
                __builtin_amdgcn_sched_barrier(0);
            }
    }
};

template <class Epi, class Sched, bool ALIGN_EPI = false, bool SP2 = false>
__device__ __forceinline__ void gemm_phase(const int wave_s, PG8_LAS unsigned char* lds, const Gemm g, const Sched& S, const Epi& E) {
    const int tid = opaque_tid(wave_s), wid = __builtin_amdgcn_readfirstlane(tid >> 6), lane = tid & 63, wr = wid >> 2, wc = wid & 3, fr = lane & 15, fq = lane >> 4;
    const int K = g.K, nt = K / BK;
    unsigned voffA[2], voffB[2];
#pragma unroll
    for (int i = 0; i < 2; ++i) { int R, C; stage_rc(tid * 16 + i * 8192, R, C); const int Rb = Epi::PERM ? ((R & ~31) + perm32(R & 31)) : R;
        voffA[i] = (unsigned)(R * K + C) * 2u; voffB[i] = (unsigned)(Rb * K + C) * 2u; }
    const size_t kstep = (size_t)(BK * 2);
    const size_t hstep = (size_t)HALF * K * 2;
    const size_t tstep = 2 * hstep;
    const unsigned ldsw = (unsigned)wid * 1024u;
    const int aoff = lds_byte(wr * 64 + fr, fq * 8), boff = lds_byte(wc * 32 + fr, fq * 8);
#define PG8_SA(b, h) (((b) * 2 + (h)) * HTB)
#define PG8_SB(b, h) ((4 + (b) * 2 + (h)) * HTB)
#define PG8_STAGE(bufoff, gbase, voff) do { _Pragma("unroll") for (int _i = 0; _i < 2; ++_i) \
        __builtin_amdgcn_global_load_lds((const unsigned*)((const char*)(gbase) + (voff)[_i]), (PG8_LAS unsigned*)(lds + (bufoff) + ldsw + _i * 8192), 16, 0, 0); } while (0)
#define PG8_LDA(dst, b, h) do { _Pragma("unroll") for (int m = 0; m < 4; ++m) _Pragma("unroll") for (int k = 0; k < 2; ++k) dst[m][k] = *(const PG8_LAS bf16x8*)(lds + PG8_SA(b, h) + aoff + m * 2048 + k * 1024); } while (0)
#define PG8_LDB(dst, b, h) do { _Pragma("unroll") for (int n = 0; n < 2; ++n) _Pragma("unroll") for (int k = 0; k < 2; ++k) dst[n][k] = *(const PG8_LAS bf16x8*)(lds + PG8_SB(b, h) + boff + n * 2048 + k * 1024); } while (0)
#define PG8_MMA(ai, bj, At, Bt) do { __builtin_amdgcn_s_setprio(1); _Pragma("unroll") for (int m = 0; m < 4; ++m) _Pragma("unroll") for (int n = 0; n < 2; ++n) _Pragma("unroll") for (int k = 0; k < 2; ++k) \
        acc[ai][bj][m][n] = __builtin_amdgcn_mfma_f32_16x16x32_bf16(Bt[n][k], At[m][k], acc[ai][bj][m][n], 0, 0, 0); __builtin_amdgcn_s_setprio(0); } while (0)
#define PG8_WAIT_V(n) asm volatile("s_waitcnt vmcnt(" #n ")" ::: "memory")
#define PG8_WAIT_L(n) asm volatile("s_waitcnt lgkmcnt(" #n ")" ::: "memory")
#define PG8_BAR __builtin_amdgcn_s_barrier()
#define PG8_SCHED __builtin_amdgcn_sched_barrier(0)
    Unit cur, nxt; int ui = 0;
    if (!S.next(0, cur)) return;
    f32x4 acc[2][2][4][2];
#pragma unroll
    for (int a = 0; a < 2; ++a)
#pragma unroll
        for (int b = 0; b < 2; ++b)
#pragma unroll
            for (int m = 0; m < 4; ++m)
#pragma unroll
                for (int n = 0; n < 2; ++n) acc[a][b][m][n] = (f32x4){0.f, 0.f, 0.f, 0.f};
    bf16x8 At[4][2], B0[2][2], B1[2][2];
    const char* cA = (const char*)g.A + (size_t)cur.pm * tstep; const char* cB = (const char*)g.Bt + (size_t)cur.pn * tstep;
    S.a_ready(cur);
    if constexpr (SP2) {
        PG8_STAGE(PG8_SB(0, 0), cB, voffB); PG8_STAGE(PG8_SB(0, 1), cB + hstep, voffB); PG8_STAGE(PG8_SA(0, 0), cA, voffA); PG8_STAGE(PG8_SA(0, 1), cA + hstep, voffA);
        if (wr == 1) PG8_BAR;
        PG8_WAIT_V(2); PG8_BAR;
        PG8_STAGE(PG8_SB(1, 0), cB + kstep, voffB); PG8_STAGE(PG8_SA(1, 0), cA + kstep, voffA); PG8_STAGE(PG8_SB(1, 1), cB + hstep + kstep, voffB);
        PG8_WAIT_V(6); PG8_BAR;
    } else {
        PG8_STAGE(PG8_SB(0, 0), cB, voffB); PG8_STAGE(PG8_SA(0, 0), cA, voffA); PG8_STAGE(PG8_SB(0, 1), cB + hstep, voffB); PG8_STAGE(PG8_SA(0, 1), cA + hstep, voffA);
        if (wr == 1) PG8_BAR;
        PG8_WAIT_V(4); PG8_BAR;
        PG8_STAGE(PG8_SB(1, 0), cB + kstep, voffB); PG8_STAGE(PG8_SA(1, 0), cA + kstep, voffA); PG8_STAGE(PG8_SB(1, 1), cB + hstep + kstep, voffB);
        PG8_WAIT_V(6); PG8_BAR;
    }
    for (;;) {
        const bool has_next = S.next(ui + 1, nxt);
        const char* nA = has_next ? (const char*)g.A + (size_t)nxt.pm * tstep : cA; const char* nB = has_next ? (const char*)g.Bt + (size_t)nxt.pn * tstep : cB;
        for (int t = 0; t < nt; t += 2) {
            const bool last = (t == nt - 2);
            const char* a1 = cA + (size_t)(t + 1) * kstep;
            const char* a2 = last ? nA : cA + (size_t)(t + 2) * kstep; const char* b2 = last ? nB : cB + (size_t)(t + 2) * kstep;
            const char* a3 = a2 + kstep; const char* b3 = b2 + kstep;
            if (last && has_next) S.a_ready(nxt);
            if constexpr (SP2) {
            PG8_LDB(B0, 0, 0); PG8_LDB(B1, 0, 1); PG8_SCHED; PG8_LDA(At, 0, 0); PG8_STAGE(PG8_SA(1, 1), a1 + hstep, voffA);
            PG8_WAIT_V(8); PG8_WAIT_L(0); PG8_BAR; PG8_MMA(0, 0, At, B0); PG8_MMA(0, 1, At, B1); PG8_BAR; PG8_SCHED;
            PG8_LDA(At, 0, 1); PG8_STAGE(PG8_SB(0, 0), b2, voffB); PG8_STAGE(PG8_SB(0, 1), b2 + hstep, voffB); PG8_STAGE(PG8_SA(0, 0), a2, voffA);
            PG8_WAIT_V(8); PG8_WAIT_L(0); PG8_BAR; PG8_MMA(1, 0, At, B0); PG8_MMA(1, 1, At, B1); PG8_BAR; PG8_SCHED;
            PG8_LDB(B0, 1, 0); PG8_LDB(B1, 1, 1); PG8_SCHED; PG8_LDA(At, 1, 0); PG8_STAGE(PG8_SA(0, 1), a2 + hstep, voffA);
            PG8_WAIT_V(8); PG8_WAIT_L(0); PG8_BAR; PG8_MMA(0, 0, At, B0); PG8_MMA(0, 1, At, B1); PG8_BAR; PG8_SCHED;
            PG8_LDA(At, 1, 1); PG8_STAGE(PG8_SB(1, 0), b3, voffB); PG8_STAGE(PG8_SB(1, 1), b3 + hstep, voffB); PG8_STAGE(PG8_SA(1, 0), a3, voffA);
            PG8_WAIT_V(8); PG8_WAIT_L(0); PG8_BAR; PG8_MMA(1, 0, At, B0); PG8_MMA(1, 1, At, B1); PG8_BAR; PG8_SCHED;
            } else {
            PG8_LDB(B0, 0, 0); PG8_SCHED; PG8_LDA(At, 0, 0); PG8_STAGE(PG8_SA(1, 1), a1 + hstep, voffA);
            PG8_WAIT_L(8); PG8_BAR; PG8_WAIT_L(0); PG8_MMA(0, 0, At, B0); PG8_BAR; PG8_SCHED;
            PG8_LDB(B1, 0, 1); PG8_STAGE(PG8_SB(0, 0), b2, voffB);
            PG8_BAR; PG8_WAIT_L(0); PG8_MMA(0, 1, At, B1); PG8_BAR;
            PG8_LDA(At, 0, 1); PG8_STAGE(PG8_SA(0, 0), a2, voffA);
            PG8_BAR; PG8_WAIT_L(0); PG8_MMA(1, 0, At, B0); PG8_BAR; PG8_SCHED;
            PG8_STAGE(PG8_SB(0, 1), b2 + hstep, voffB);
            PG8_WAIT_V(6); PG8_BAR; PG8_MMA(1, 1, At, B1); PG8_BAR;
            PG8_LDB(B0, 1, 0); PG8_SCHED; PG8_LDA(At, 1, 0); PG8_STAGE(PG8_SA(0, 1), a2 + hstep, voffA);
            PG8_WAIT_L(8); PG8_BAR; PG8_WAIT_L(0); PG8_MMA(0, 0, At, B0); PG8_BAR; PG8_SCHED;
            PG8_LDB(B1, 1, 1); PG8_STAGE(PG8_SB(1, 0), b3, voffB);
            PG8_BAR; PG8_WAIT_L(0); PG8_MMA(0, 1, At, B1); PG8_BAR;
            PG8_LDA(At, 1, 1); PG8_STAGE(PG8_SA(1, 0), a3, voffA);
            PG8_BAR; PG8_WAIT_L(0); PG8_MMA(1, 0, At, B0); PG8_BAR; PG8_SCHED;
            PG8_STAGE(PG8_SB(1, 1), b3 + hstep, voffB);
            PG8_WAIT_V(6); PG8_BAR; PG8_MMA(1, 1, At, B1); PG8_BAR;
            }
        }
        if constexpr (ALIGN_EPI) { if (wr == 0) PG8_BAR; }
        if constexpr (!Epi::AFTER_DRAIN) { E(acc, cur, wr, wc, fr, fq); S.done(cur); }
        if (!has_next) break;
#pragma unroll
        for (int a = 0; a < 2; ++a)
#pragma unroll
            for (int b = 0; b < 2; ++b)
#pragma unroll
                for (int m = 0; m < 4; ++m)
#pragma unroll
                    for (int n = 0; n < 2; ++n) acc[a][b][m][n] = (f32x4){0.f, 0.f, 0.f, 0.f};
        cur = nxt; cA = nA; cB = nB; ++ui;
        if constexpr (ALIGN_EPI) { if (wr == 1) PG8_BAR; }
    }
    PG8_WAIT_V(0);
    if constexpr (!ALIGN_EPI) { if (wr == 0) PG8_BAR; }
    PG8_BAR;
#undef PG8_SA
#undef PG8_SB
#undef PG8_STAGE
#undef PG8_LDA
#undef PG8_LDB
#undef PG8_MMA
#undef PG8_WAIT_V
#undef PG8_WAIT_L
#undef PG8_BAR
#undef PG8_SCHED
}
}

__device__ __forceinline__ void transpose_item(const float* W, int K, int N, bf16* WT, LAS float* scr, int item, int lane) {
    const int nblk = N / 32, kb = item / nblk, nb = item % nblk, k0 = 64 * kb, n0 = 32 * nb;
#pragma unroll 8
    for (int i = 0; i < 32; ++i) { const int kk = 2 * i + (lane >> 5); scr[kk * 33 + (lane & 31)] = W[(size_t)(k0 + kk) * N + n0 + (lane & 31)]; }
    asm volatile("s_waitcnt lgkmcnt(0)" ::: "memory");
    const int c = lane & 7;
#pragma unroll
    for (int j = 0; j < 4; ++j) { const int n = (lane >> 3) + 8 * j; const LAS float* s = scr + (8 * c) * 33 + n;
        uint4 o; o.x = pk2(s[0 * 33], s[1 * 33]); o.y = pk2(s[2 * 33], s[3 * 33]); o.z = pk2(s[4 * 33], s[5 * 33]); o.w = pk2(s[6 * 33], s[7 * 33]);
        *(uint4*)(WT + (size_t)(n0 + n) * K + k0 + 8 * c) = o; }
    asm volatile("s_waitcnt lgkmcnt(0)" ::: "memory");
}

__device__ __forceinline__ float wsum(float v) {
#pragma unroll
  for (int o = 32; o > 0; o >>= 1) v += __shfl_xor(v, o, 64);
  return v;
}
__device__ __forceinline__ float wmaxf(float v) {
#pragma unroll
  for (int o = 32; o > 0; o >>= 1) v = fmaxf(v, __shfl_xor(v, o, 64));
  return v;
}
__device__ __forceinline__ float sigmoidf_(float x) { return 1.0f / (1.0f + expf(-x)); }
__device__ __forceinline__ float gelu_tanh(float x) {
  return 0.5f * x * (1.0f + tanhf(0.7978845608028654f * (x + 0.044715f * x * x * x)));
}

template <bool BF16OUT>
__device__ __forceinline__ void rms_rows(const int wave_s, const float* src, const float* g, void* dstv, int rows) {
  const int tid_ = opaque_tid(wave_s);
  const int lane = tid_ & 63;
  const int gw = blockIdx.x * NWAVES + (tid_ >> 6);
  const int nw = gridDim.x * NWAVES;
  for (int r = gw; r < rows; r += nw) {
    const float4* s4 = (const float4*)(src + (size_t)r * DM);
    float4 v[4];
    float ss = 0.f;
#pragma unroll
    for (int i = 0; i < 4; i++) {
      v[i] = s4[lane + i * 64];
      ss += v[i].x * v[i].x + v[i].y * v[i].y + v[i].z * v[i].z + v[i].w * v[i].w;
    }
    ss = wsum(ss);
    const float rstd = rsqrtf(ss * (1.0f / DM) + EPSF);
    const float4* g4 = (const float4*)g;
#pragma unroll
    for (int i = 0; i < 4; i++) {
      float4 gg = g4[lane + i * 64];
      float4 o;
      o.x = v[i].x * rstd * gg.x; o.y = v[i].y * rstd * gg.y;
      o.z = v[i].z * rstd * gg.z; o.w = v[i].w * rstd * gg.w;
      if (BF16OUT) {
        uint2 pk; pk.x = pk2(o.x, o.y); pk.y = pk2(o.z, o.w);
        ((uint2*)((bf16*)dstv + (size_t)r * DM))[lane + i * 64] = pk;
      } else {
        ((float4*)((float*)dstv + (size_t)r * DM))[lane + i * 64] = o;
      }
    }
  }
}

__device__ __forceinline__ void ssm_params(const int wave_s, const Params& p, float* ssmp_all) {
  const int tid_ = opaque_tid(wave_s);
  const float* in8 = karg_in(8); const float* in9 = karg_in(9); const float* in10 = karg_in(10);
  const float* in11 = karg_in(11); const float* in12 = karg_in(12);
  const int gt = blockIdx.x * blockDim.x + tid_;
  const int nth = gridDim.x * blockDim.x;
  for (int i = gt; i < 2 * 16 * 64; i += nth) {
    const int l = i / 1024, gp = i % 1024, g = gp / 64;
    float* sp = ssmp_all + (size_t)l * SSMP_PER_LAYER;
    const float lre = fminf(in8[l * 1024 + gp], -1e-4f);
    const float lim = in9[l * 1024 + gp];
    const float dt = expf(in10[l * 16 + g]);
    const float er = expf(lre * dt);
    float sn, cs;
    sincosf(lim * dt, &sn, &cs);
    const float br = er * cs, bi = er * sn;
    sp[gp * 2 + 0] = br;
    sp[gp * 2 + 1] = bi;
    float cr = br, ci = bi;
#pragma unroll
    for (int s = 0; s < 6; s++) {
      const float nr = cr * cr - ci * ci, ni = 2.f * cr * ci;
      cr = nr; ci = ni;
    }
    sp[2048 + gp * 2 + 0] = cr;
    sp[2048 + gp * 2 + 1] = ci;
    const float nr = br - 1.0f, ni = bi;
    const float den = lre * lre + lim * lim;
    const float fr = (nr * lre + ni * lim) / den;
    const float fi = (ni * lre - nr * lim) / den;
    for (int h = 0; h < 16; h++) {
      const float bre = in11[((size_t)l * 1024 + gp) * 16 + h];
      const float bim = in12[((size_t)l * 1024 + gp) * 16 + h];
      sp[4096 + ((g * 16 + h) * 64 + (gp & 63)) * 2 + 0] = fr * bre - fi * bim;
      sp[4096 + ((g * 16 + h) * 64 + (gp & 63)) * 2 + 1] = fr * bim + fi * bre;
    }
  }
}

__device__ __forceinline__ void conv_phase(const int wave_s, const Params& p, int l, const bf16* proj, bf16* y, LAS float* smem) {
  const int tid_ = opaque_tid(wave_s);
  const int lane = tid_ & 63;
  const int gw = blockIdx.x * NWAVES + (tid_ >> 6);
  const int nw = gridDim.x * NWAVES;
  const float* cw = karg_in(4) + (size_t)l * 31 * 256;
  const float4 cb = ((const float4*)(karg_in(5) + l * 256))[lane];
  const float4 lg = ((const float4*)(karg_in(6) + l * 256))[lane];
  const float4 lb = ((const float4*)(karg_in(7) + l * 256))[lane];
  const float4 gg = ((const float4*)(karg_in(18) + l * 1024))[lane];
  LAS float* cwl = smem + 1024;
  for (int i = tid_; i < 31 * 256 / 4; i += NWAVES * 64) *(LAS pg8::f32x4*)(cwl + 4 * i) = *(const pg8::f32x4*)(cw + 4 * i);
  __syncthreads();
  for (int it = gw; it < NT / 8; it += nw) {
    const int tok0 = it * 8;
    const int t0 = tok0 & (SEQ - 1);
    float4 acc[8];
#pragma unroll
    for (int o = 0; o < 8; o++) acc[o] = cb;
#pragma unroll
    for (int i = 0; i < 38; i++) {
      if (t0 - 30 + i >= 0) {
        const bf16* row = proj + (size_t)(tok0 - 30 + i) * DIN;
        const uint2 vp = ((const uint2*)row)[lane];
        const uint2 gp = ((const uint2*)(row + 256))[lane];
        float4 g4;
        g4.x = bf_lo(vp.x) * sigmoidf_(bf_lo(gp.x)); g4.y = bf_hi(vp.x) * sigmoidf_(bf_hi(gp.x));
        g4.z = bf_lo(vp.y) * sigmoidf_(bf_lo(gp.y)); g4.w = bf_hi(vp.y) * sigmoidf_(bf_hi(gp.y));
#pragma unroll
        for (int o = 0; o < 8; o++) {
          const int j = i - o;
          if (j >= 0 && j <= 30) {
            const pg8::f32x4 w4 = *(const LAS pg8::f32x4*)(cwl + j * 256 + lane * 4);
            acc[o].x += g4.x * w4[0]; acc[o].y += g4.y * w4[1];
            acc[o].z += g4.z * w4[2]; acc[o].w += g4.w * w4[3];
          }
        }
      }
    }
#pragma unroll
    for (int o = 0; o < 8; o++) {
      const float4 a = acc[o];
      const float mean = wsum(a.x + a.y + a.z + a.w) * (1.0f / 256.f);
      const float dx = a.x - mean, dy = a.y - mean, dz = a.z - mean, dw = a.w - mean;
      const float var = wsum(dx * dx + dy * dy + dz * dz + dw * dw) * (1.0f / 256.f);
      const float rs = rsqrtf(var + EPSF);
      float4 s;
      s.x = dx * rs * lg.x + lb.x; s.y = dy * rs * lg.y + lb.y;
      s.z = dz * rs * lg.z + lb.z; s.w = dw * rs * lg.w + lb.w;
      s.x = s.x * sigmoidf_(s.x); s.y = s.y * sigmoidf_(s.y);
      s.z = s.z * sigmoidf_(s.z); s.w = s.w * sigmoidf_(s.w);
      const float ss = wsum(s.x * s.x + s.y * s.y + s.z * s.z + s.w * s.w) * (1.0f / 256.f);
      const float r2 = rsqrtf(ss + EPSF);
      uint2 pk; pk.x = pk2(s.x * r2 * gg.x, s.y * r2 * gg.y); pk.y = pk2(s.z * r2 * gg.z, s.w * r2 * gg.w);
      ((uint2*)(y + (size_t)(tok0 + o) * DM))[lane] = pk;
    }
  }
}

typedef short bf16x8_t __attribute__((ext_vector_type(8)));
typedef float f32x16_t __attribute__((ext_vector_type(16)));
#define MFMA_PAD() do { __builtin_amdgcn_sched_barrier(0); asm volatile("s_nop 15\n\ts_nop 15" ::: "memory"); __builtin_amdgcn_sched_barrier(0); } while (0)

__device__ __forceinline__ void attn_phase(const int wave_s, const Params& p, int l, const bf16* proj, bf16* y, LAS float* smem) {
  const int tid = opaque_tid(wave_s), lane = tid & 63, wave = tid >> 6;
  const int n = lane & 31, hh = lane >> 5;
  const float* gg = karg_in(18) + l * 1024 + 256 + wave * 64;
  const float g0 = gg[n], g1 = gg[32 + n];
  LAS float* ssq = smem;
  LAS float* rstd = smem + 256;
  for (int item = blockIdx.x; item < 4 * 128; item += gridDim.x) {
    const int b = item >> 7, q0 = (item & 127) * 32;
    const size_t tokb = (size_t)b * SEQ;
    bf16x8_t qf[4];
    {
      const bf16* qrow = proj + (tokb + q0 + n) * DIN + 512 + wave * 64 + 8 * hh;
#pragma unroll
      for (int ks = 0; ks < 4; ks++) qf[ks] = *(const bf16x8_t*)(qrow + 16 * ks);
    }
    f32x16_t o0, o1;
#pragma unroll
    for (int r = 0; r < 16; r++) { o0[r] = 0.f; o1[r] = 0.f; }
    float R = 0.f;
    for (int kt = q0; kt >= 0; kt -= 32) {
      bf16x8_t kf[4];
      {
        const bf16* krow = proj + (tokb + kt + n) * DIN + 1024 + wave * 64 + 8 * hh;
#pragma unroll
        for (int ks = 0; ks < 4; ks++) kf[ks] = *(const bf16x8_t*)(krow + 16 * ks);
      }
      bf16x8_t vf0[2], vf1[2];
      {
        const bf16* vb = proj + (tokb + kt + 4 * hh) * DIN + 1536 + wave * 64 + n;
#pragma unroll
        for (int s = 0; s < 2; s++)
#pragma unroll
          for (int j = 0; j < 8; j++) {
            const int key = 16 * s + 8 * (j >> 2) + (j & 3);
            vf0[s][j] = (short)vb[(size_t)key * DIN];
            vf1[s][j] = (short)vb[(size_t)key * DIN + 32];
          }
      }
      f32x16_t sacc;
#pragma unroll
      for (int r = 0; r < 16; r++) sacc[r] = 0.f;
      __builtin_amdgcn_sched_barrier(0); asm volatile("s_nop 15\n\ts_nop 15" ::: "memory"); __builtin_amdgcn_sched_barrier(0);
#pragma unroll
      for (int ks = 0; ks < 4; ks++) sacc = __builtin_amdgcn_mfma_f32_32x32x16_bf16(kf[ks], qf[ks], sacc, 0, 0, 0);
      __builtin_amdgcn_sched_barrier(0); asm volatile("s_nop 15\n\ts_nop 15" ::: "memory"); __builtin_amdgcn_sched_barrier(0);
      float lst[16], lsz[16];
      const bool diag = (kt == q0);
#pragma unroll
      for (int r = 0; r < 16; r++) {
        const float z = sacc[r] * 0.125f;
        const float sp = __logf(1.0f + __expf(-fabsf(z)));
        float a = fminf(z, 0.f) - sp;
        float c = -(fmaxf(z, 0.f) + sp);
        if (diag) {
          const int key = (r & 3) + 8 * (r >> 2) + 4 * hh;
          if (key >= n) { a = -1.0e30f; c = 0.f; }
        }
        lsz[r] = a; lst[r] = c;
      }
      float Gs[4], Gp[4];
#pragma unroll
      for (int g = 0; g < 4; g++) {
        Gs[g] = (lst[4 * g] + lst[4 * g + 1]) + (lst[4 * g + 2] + lst[4 * g + 3]);
        Gp[g] = __shfl_xor(Gs[g], 32, 64);
      }
      float carry[4];
      {
        float after = R;
#pragma unroll
        for (int g = 3; g >= 0; g--) {
          carry[g] = after + (hh ? 0.f : Gp[g]);
          after += Gs[g] + Gp[g];
        }
        R = after;
      }
      bf16x8_t pf[2];
#pragma unroll
      for (int g = 0; g < 4; g++) {
        float run = carry[g];
        float a3 = __expf(lsz[4 * g + 3] + run); run += lst[4 * g + 3];
        float a2 = __expf(lsz[4 * g + 2] + run); run += lst[4 * g + 2];
        float a1 = __expf(lsz[4 * g + 1] + run); run += lst[4 * g + 1];
        float a0 = __expf(lsz[4 * g + 0] + run);
        const int s = g >> 1, jb = (g & 1) * 4;
        pf[s][jb + 0] = (short)f2bf(a0); pf[s][jb + 1] = (short)f2bf(a1);
        pf[s][jb + 2] = (short)f2bf(a2); pf[s][jb + 3] = (short)f2bf(a3);
      }
      __builtin_amdgcn_sched_barrier(0); asm volatile("s_nop 15\n\ts_nop 15" ::: "memory"); __builtin_amdgcn_sched_barrier(0);
#pragma unroll
      for (int s = 0; s < 2; s++) {
        o0 = __builtin_amdgcn_mfma_f32_32x32x16_bf16(pf[s], vf0[s], o0, 0, 0, 0);
        o1 = __builtin_amdgcn_mfma_f32_32x32x16_bf16(pf[s], vf1[s], o1, 0, 0, 0);
      }
      __builtin_amdgcn_sched_barrier(0); asm volatile("s_nop 15\n\ts_nop 15" ::: "memory"); __builtin_amdgcn_sched_barrier(0);
      if (__all(R < -110.f)) break;
    }
    float sq[16];
#pragma unroll
    for (int r = 0; r < 16; r++) {
      float v = o0[r] * o0[r] + o1[r] * o1[r];
#pragma unroll
      for (int o = 16; o > 0; o >>= 1) v += __shfl_xor(v, o, 64);
      sq[r] = v;
    }
    __syncthreads();
    if (n == 0) {
#pragma unroll
      for (int r = 0; r < 16; r++) ssq[wave * 32 + (r & 3) + 8 * (r >> 2) + 4 * hh] = sq[r];
    }
    __syncthreads();
    if (tid < 32) {
      float t = 0.f;
#pragma unroll
      for (int w = 0; w < 8; w++) t += ssq[w * 32 + tid];
      rstd[tid] = rsqrtf(t * (1.0f / 512.f) + EPSF);
    }
    __syncthreads();
#pragma unroll
    for (int r = 0; r < 16; r++) {
      const int qi = (r & 3) + 8 * (r >> 2) + 4 * hh;
      const float rs = rstd[qi];
      bf16* yr = y + (tokb + q0 + qi) * DM + 256 + wave * 64 + n;
      yr[0] = (bf16)f2bf(o0[r] * rs * g0);
      yr[32] = (bf16)f2bf(o1[r] * rs * g1);
    }
  }
}

#define SSM_BCAST_U(u, ua, ub, tt) do { \
    const unsigned w0 = (unsigned)__builtin_amdgcn_readlane((int)(ua).x, (tt)), w1 = (unsigned)__builtin_amdgcn_readlane((int)(ua).y, (tt)); \
    const unsigned w2 = (unsigned)__builtin_amdgcn_readlane((int)(ua).z, (tt)), w3 = (unsigned)__builtin_amdgcn_readlane((int)(ua).w, (tt)); \
    const unsigned w4 = (unsigned)__builtin_amdgcn_readlane((int)(ub).x, (tt)), w5 = (unsigned)__builtin_amdgcn_readlane((int)(ub).y, (tt)); \
    const unsigned w6 = (unsigned)__builtin_amdgcn_readlane((int)(ub).z, (tt)), w7 = (unsigned)__builtin_amdgcn_readlane((int)(ub).w, (tt)); \
    (u)[0] = bf_lo(w0); (u)[1] = bf_hi(w0); (u)[2] = bf_lo(w1); (u)[3] = bf_hi(w1); (u)[4] = bf_lo(w2); (u)[5] = bf_hi(w2); (u)[6] = bf_lo(w3); (u)[7] = bf_hi(w3); \
    (u)[8] = bf_lo(w4); (u)[9] = bf_hi(w4); (u)[10] = bf_lo(w5); (u)[11] = bf_hi(w5); (u)[12] = bf_lo(w6); (u)[13] = bf_hi(w6); (u)[14] = bf_lo(w7); (u)[15] = bf_hi(w7); } while (0)
__device__ __forceinline__ void ssm_chunk_end(const int wave_s, const float* ssmp, const bf16* proj, float* ssmE) {
  const int tid_ = opaque_tid(wave_s);
  const int lane = tid_ & 63;
  const int gw = blockIdx.x * NWAVES + (tid_ >> 6);
  const int nw = gridDim.x * NWAVES;
  for (int it = gw; it < 4 * 64 * 16; it += nw) {
    const int g = it & 15, c = (it >> 4) & 63, b = it >> 10;
    const int gp = g * 64 + lane;
    const uint4* up = (const uint4*)(proj + (size_t)(b * SEQ + c * 64 + lane) * DIN + 2048 + g * 16);
    const uint4 ua = up[0], ub = up[1];
    const float lbr = ssmp[gp * 2], lbi = ssmp[gp * 2 + 1];
    float bbr[16], bbi[16];
#pragma unroll
    for (int h = 0; h < 16; h++) {
      { const float2 bb = *(const float2*)(ssmp + 4096 + ((g * 16 + h) * 64 + lane) * 2); bbr[h] = bb.x; bbi[h] = bb.y; }
    }
    float xr = 0.f, xi = 0.f;
#pragma unroll 2
    for (int tt = 0; tt < 64; tt++) {
      float u[16];
      SSM_BCAST_U(u, ua, ub, tt);
      float br = 0.f, bi = 0.f;
#pragma unroll
      for (int h = 0; h < 16; h++) { br += bbr[h] * u[h]; bi += bbi[h] * u[h]; }
      const float nr = lbr * xr - lbi * xi + br;
      const float ni = lbr * xi + lbi * xr + bi;
      xr = nr; xi = ni;
    }
    float* e = ssmE + ((size_t)((b * 64 + c) * 16 + g) * 64 + lane) * 2;
    e[0] = xr; e[1] = xi;
  }
}

__device__ __forceinline__ void ssm_finish(const int wave_s, const Params& p, int l, const float* ssmp, const bf16* proj,
                           const float* ssmE, bf16* y, LAS float* smem) {
  LAS bf16* Ytb = (LAS bf16*)smem;
  LAS float* ssq2 = smem + (64 * 264 * 2) / 4;
  LAS float* rstd2 = ssq2 + 512;
  const bf16* glT = (const bf16*)(p.ws + WS_WT + (size_t)l * WT_LAYER + WT_GLU);
  const int tid = opaque_tid(wave_s), lane = tid & 63, wave = tid >> 6;
  const float* cre = karg_in(13) + (size_t)l * 16 * 16 * 64;
  const float* cim = karg_in(14) + (size_t)l * 16 * 16 * 64;
  const float* dsk = karg_in(15) + l * 256;
  const float* glw = karg_in(16) + (size_t)l * 256 * 256;
  const float* glb = karg_in(17) + l * 256;
  const float* gg = karg_in(18) + l * 1024 + 768;
  for (int it = blockIdx.x; it < 256; it += gridDim.x) {
    const int b = it >> 6, c = it & 63;
    __syncthreads();
    for (int gi = 0; gi < 2; gi++) {
      const int g = wave + gi * 8;
      const int gp = g * 64 + lane;
      const float lbr = ssmp[gp * 2], lbi = ssmp[gp * 2 + 1];
      const float lcr = ssmp[2048 + gp * 2], lci = ssmp[2048 + gp * 2 + 1];
      float bbr[16], bbi[16], ccr[16], cci[16];
#pragma unroll
      for (int h = 0; h < 16; h++) {
        { const float2 bb = *(const float2*)(ssmp + 4096 + ((g * 16 + h) * 64 + lane) * 2); bbr[h] = bb.x; bbi[h] = bb.y; }
        ccr[h] = cre[(g * 16 + h) * 64 + lane];
        cci[h] = cim[(g * 16 + h) * 64 + lane];
      }
      float xr = 0.f, xi = 0.f;
      {
        const float2* eb = (const float2*)ssmE + ((size_t)(b * 64) * 16 + g) * 64 + lane;
        int cc = 0;
        for (; cc + 8 <= c; cc += 8) {
          float2 ev[8];
#pragma unroll
          for (int k = 0; k < 8; k++) ev[k] = eb[(size_t)(cc + k) * 16 * 64];
#pragma unroll
          for (int k = 0; k < 8; k++) {
            const float nr = lcr * xr - lci * xi + ev[k].x;
            const float ni = lcr * xi + lci * xr + ev[k].y;
            xr = nr; xi = ni;
          }
        }
        for (; cc < c; cc++) {
          const float2 e1 = eb[(size_t)cc * 16 * 64];
          const float nr = lcr * xr - lci * xi + e1.x;
          const float ni = lcr * xi + lci * xr + e1.y;
          xr = nr; xi = ni;
        }
      }
      const int hq = ((lane >> 5) & 1) * 8 + ((lane >> 4) & 1) * 4 + ((lane >> 3) & 1) * 2 + ((lane >> 2) & 1);
      float dm[16];
#pragma unroll
      for (int h = 0; h < 16; h++) dm[h] = (lane == 0) ? dsk[g * 16 + h] : 0.f;
      const uint4* up = (const uint4*)(proj + (size_t)(b * SEQ + c * 64 + lane) * DIN + 2048 + g * 16);
      const uint4 ua = up[0], ub = up[1];
#pragma unroll 1
      for (int t4 = 0; t4 < 64; t4 += 4) {
        float vv[4][16];
#pragma unroll
        for (int s = 0; s < 4; s++) {
          float u[16];
          SSM_BCAST_U(u, ua, ub, t4 + s);
          float br = 0.f, bi = 0.f;
#pragma unroll
          for (int h = 0; h < 16; h++) { br += bbr[h] * u[h]; bi += bbi[h] * u[h]; }
          const float nr = lbr * xr - lbi * xi + br;
          const float ni = lbr * xi + lbi * xr + bi;
          xr = nr; xi = ni;
#pragma unroll
          for (int h = 0; h < 16; h++) vv[s][h] = xr * ccr[h] - xi * cci[h] + dm[h] * u[h];
        }
        float v1[4];
#pragma unroll
        for (int s = 0; s < 4; s++) {
          float v8[8], v4[4], v2[2];
          {
            const bool hi = (lane & 32) != 0;
#pragma unroll
            for (int i = 0; i < 8; i++) { const float send = hi ? vv[s][i] : vv[s][i + 8]; const float keep = hi ? vv[s][i + 8] : vv[s][i]; v8[i] = keep + __shfl_xor(send, 32, 64); }
          }
          {
            const bool hi = (lane & 16) != 0;
#pragma unroll
            for (int i = 0; i < 4; i++) { const float send = hi ? v8[i] : v8[i + 4]; const float keep = hi ? v8[i + 4] : v8[i]; v4[i] = keep + __shfl_xor(send, 16, 64); }
          }
          {
            const bool hi = (lane & 8) != 0;
#pragma unroll
            for (int i = 0; i < 2; i++) { const float send = hi ? v4[i] : v4[i + 2]; const float keep = hi ? v4[i + 2] : v4[i]; v2[i] = keep + __shfl_xor(send, 8, 64); }
          }
          {
            const bool hi = (lane & 4) != 0;
            const float send = hi ? v2[0] : v2[1];
            const float keep = hi ? v2[1] : v2[0];
            v1[s] = keep + __shfl_xor(send, 4, 64);
          }
          v1[s] += __shfl_xor(v1[s], 2, 64);
          v1[s] += __shfl_xor(v1[s], 1, 64);
        }
        if ((lane & 3) == 0) {
#pragma unroll
          for (int s = 0; s < 4; s++) Ytb[(t4 + s) * 264 + g * 16 + hq] = (bf16)f2bf(gelu_tanh(v1[s]));
        }
      }
    }
    __syncthreads();
    {
      const int n = lane & 31, hh = lane >> 5;
      const int ch = wave * 32 + n;
      const float bj = glb[ch];
      const float gj = gg[ch];
      bf16x8_t gf[16];
      {
        const bf16* grow = glT + (size_t)ch * 256 + 8 * hh;
#pragma unroll
        for (int ks = 0; ks < 16; ks++) gf[ks] = *(const bf16x8_t*)(grow + 16 * ks);
      }
      float oo[2][16];
#pragma unroll
      for (int mt = 0; mt < 2; mt++) {
        f32x16_t z;
#pragma unroll
        for (int r = 0; r < 16; r++) z[r] = 0.f;
        const LAS bf16* yrow = Ytb + (mt * 32 + n) * 264 + 8 * hh;
#pragma unroll
        for (int kq = 0; kq < 4; kq++) {
          bf16x8_t yf[4];
#pragma unroll
          for (int i = 0; i < 4; i++) yf[i] = *(const LAS bf16x8_t*)(yrow + 16 * (kq * 4 + i));
          MFMA_PAD();
#pragma unroll
          for (int i = 0; i < 4; i++) z = __builtin_amdgcn_mfma_f32_32x32x16_bf16(yf[i], gf[kq * 4 + i], z, 0, 0, 0);
          MFMA_PAD();
        }
        float sq[16];
#pragma unroll
        for (int r = 0; r < 16; r++) {
          const int t = mt * 32 + (r & 3) + 8 * (r >> 2) + 4 * hh;
          const float yv = bf2f(Ytb[t * 264 + ch]);
          const float o = yv * sigmoidf_(z[r] + bj);
          oo[mt][r] = o;
          float v = o * o;
#pragma unroll
          for (int s = 16; s > 0; s >>= 1) v += __shfl_xor(v, s, 64);
          sq[r] = v;
        }
        if (n == 0) {
#pragma unroll
          for (int r = 0; r < 16; r++) ssq2[wave * 64 + mt * 32 + (r & 3) + 8 * (r >> 2) + 4 * hh] = sq[r];
        }
      }
      __syncthreads();
      if (tid < 64) {
        float t = 0.f;
#pragma unroll
        for (int w = 0; w < 8; w++) t += ssq2[w * 64 + tid];
        rstd2[tid] = rsqrtf(t * (1.0f / 256.f) + EPSF);
      }
      __syncthreads();
#pragma unroll
      for (int mt = 0; mt < 2; mt++)
#pragma unroll
        for (int r = 0; r < 16; r++) {
          const int t = mt * 32 + (r & 3) + 8 * (r >> 2) + 4 * hh;
          y[(size_t)(b * SEQ + c * 64 + t) * DM + 768 + ch] = (bf16)f2bf(oo[mt][r] * rstd2[t] * gj);
        }
    }
  }
}

__device__ __forceinline__ void memattn_phase(const int wave_s, const bf16* q, const bf16* kvb, const bf16* vT, bf16* o, LAS float* smem) {
  const int tid_ = opaque_tid(wave_s);
  const int lane = tid_ & 63, n = lane & 31, hh = lane >> 5, wave = tid_ >> 6;
  const int sig = (n & 0x13) | ((n & 4) << 1) | ((n & 8) >> 1);
  LAS bf16* Ls = (LAS bf16*)smem;
  for (int it = blockIdx.x; it < 64 * 4; it += gridDim.x) {
    const int h = it & 3, tg = it >> 2, b = tg >> 4;
    const int tok0 = (tg * 8 + wave) * 32;
    __syncthreads();
    {
      const int r = tid_ >> 1, hf = tid_ & 1;
      const pg8::u32x4* src4 = (const pg8::u32x4*)(kvb + (size_t)(b * NMEM + r) * 2048 + h * 256 + hf * 128);
      LAS pg8::u32x4* dst4 = (LAS pg8::u32x4*)(Ls + r * 264 + hf * 128);
#pragma unroll
      for (int k = 0; k < 16; k++) dst4[k] = src4[k];
    }
    f32x16_t st[8];
#pragma unroll
    for (int kt = 0; kt < 8; kt++)
#pragma unroll
      for (int r = 0; r < 16; r++) st[kt][r] = 0.f;
    const bf16* qrow = q + (size_t)(tok0 + n) * DM + h * 256 + 8 * hh;
    __syncthreads();
#pragma unroll
    for (int kq = 0; kq < 4; kq++) {
      bf16x8_t qf[4];
#pragma unroll
      for (int i = 0; i < 4; i++) qf[i] = *(const bf16x8_t*)(qrow + 16 * (kq * 4 + i));
#pragma unroll
      for (int kt = 0; kt < 8; kt++) {
        const LAS bf16* krow = Ls + (kt * 32 + sig) * 264 + 8 * hh;
        bf16x8_t kf[4];
#pragma unroll
        for (int i = 0; i < 4; i++) kf[i] = *(const LAS bf16x8_t*)(krow + 16 * (kq * 4 + i));
        MFMA_PAD();
#pragma unroll
        for (int i = 0; i < 4; i++) st[kt] = __builtin_amdgcn_mfma_f32_32x32x16_bf16(kf[i], qf[i], st[kt], 0, 0, 0);
        MFMA_PAD();
      }
    }
    float mx = st[0][0];
#pragma unroll
    for (int kt = 0; kt < 8; kt++)
#pragma unroll
      for (int r = 0; r < 16; r++) mx = fmaxf(mx, st[kt][r]);
    mx = fmaxf(mx, __shfl_xor(mx, 32, 64));
    float sum = 0.f;
#pragma unroll
    for (int kt = 0; kt < 8; kt++)
#pragma unroll
      for (int r = 0; r < 16; r++) { const float e = __expf((st[kt][r] - mx) * 0.0625f); st[kt][r] = e; sum += e; }
    sum += __shfl_xor(sum, 32, 64);
    const float inv = 1.0f / sum;
    bf16x8_t pf[8][2];
#pragma unroll
    for (int kt = 0; kt < 8; kt++)
#pragma unroll
      for (int s = 0; s < 2; s++)
#pragma unroll
        for (int j = 0; j < 8; j++) pf[kt][s][j] = (short)f2bf(st[kt][8 * s + j] * inv);
    __syncthreads();
    {
      const int r = tid_ >> 1, hf = tid_ & 1;
      const pg8::u32x4* src4 = (const pg8::u32x4*)(vT + ((size_t)(b * 4 + h) * 256 + r) * 256 + hf * 128);
      LAS pg8::u32x4* dst4 = (LAS pg8::u32x4*)(Ls + r * 264 + hf * 128);
#pragma unroll
      for (int k = 0; k < 16; k++) dst4[k] = src4[k];
    }
    __syncthreads();
#pragma unroll 1
    for (int dt = 0; dt < 8; dt++) {
      f32x16_t oacc;
#pragma unroll
      for (int r = 0; r < 16; r++) oacc[r] = 0.f;
      const LAS bf16* vrow = Ls + (dt * 32 + n) * 264 + 8 * hh;
#pragma unroll
      for (int kq = 0; kq < 4; kq++) {
        bf16x8_t vf[4];
#pragma unroll
        for (int i = 0; i < 4; i++) vf[i] = *(const LAS bf16x8_t*)(vrow + (kq * 2 + (i >> 1)) * 32 + 16 * (i & 1));
        MFMA_PAD();
#pragma unroll
        for (int i = 0; i < 4; i++) oacc = __builtin_amdgcn_mfma_f32_32x32x16_bf16(pf[kq * 2 + (i >> 1)][i & 1], vf[i], oacc, 0, 0, 0);
        MFMA_PAD();
      }
#pragma unroll
      for (int r = 0; r < 16; r++) {
        const int qi = (r & 3) + 8 * (r >> 2) + 4 * hh;
        o[(size_t)(tok0 + qi) * DM + h * 256 + dt * 32 + n] = (bf16)f2bf(oacc[r]);
      }
    }
  }
}

__device__ __forceinline__ void vt_phase(const int wave_s, const bf16* kvb, bf16* vT) {
  const int tid_ = opaque_tid(wave_s);
  const int gt = blockIdx.x * (NWAVES * 64) + tid_;
  const int nth = gridDim.x * NWAVES * 64;
  for (int i = gt; i < 2 * 4 * 4 * 256 * 256; i += nth) {
    const int m = i & 255, d = (i >> 8) & 255, h = (i >> 16) & 3, b = (i >> 18) & 3, l = i >> 20;
    vT[i] = kvb[((size_t)l * 1024 + b * 256 + m) * 2048 + 1024 + h * 256 + d];
  }
}

template <unsigned MASK>
__device__ __forceinline__ float pack_key(float s, unsigned idx) {
  const unsigned u = __builtin_bit_cast(unsigned, s);
  const unsigned tag = ((int)u < 0) ? idx : (MASK - idx);
  return __builtin_bit_cast(float, (u & ~MASK) + tag);
}
template <unsigned MASK>
__device__ __forceinline__ unsigned key_idx(float k) {
  const unsigned u = __builtin_bit_cast(unsigned, k);
  const unsigned tag = u & MASK;
  return ((int)u < 0) ? tag : (MASK - tag);
}
template <unsigned MASK>
__device__ __forceinline__ float key_val(float k) { return __builtin_bit_cast(float, __builtin_bit_cast(unsigned, k) & ~MASK); }
__device__ __forceinline__ void top16_of_64(float (&K)[64]) {
  { const float a_ = K[0], b_ = K[1]; const bool g_ = a_ > b_; K[0] = g_ ? a_ : b_; K[1] = g_ ? b_ : a_; }
  { const float a_ = K[2], b_ = K[3]; const bool g_ = a_ > b_; K[2] = g_ ? b_ : a_; K[3] = g_ ? a_ : b_; }
  { const float a_ = K[4], b_ = K[5]; const bool g_ = a_ > b_; K[4] = g_ ? a_ : b_; K[5] = g_ ? b_ : a_; }
  { const float a_ = K[6], b_ = K[7]; const bool g_ = a_ > b_; K[6] = g_ ? b_ : a_; K[7] = g_ ? a_ : b_; }
  { const float a_ = K[8], b_ = K[9]; const bool g_ = a_ > b_; K[8] = g_ ? a_ : b_; K[9] = g_ ? b_ : a_; }
  { const float a_ = K[10], b_ = K[11]; const bool g_ = a_ > b_; K[10] = g_ ? b_ : a_; K[11] = g_ ? a_ : b_; }
  { const float a_ = K[12], b_ = K[13]; const bool g_ = a_ > b_; K[12] = g_ ? a_ : b_; K[13] = g_ ? b_ : a_; }
  { const float a_ = K[14], b_ = K[15]; const bool g_ = a_ > b_; K[14] = g_ ? b_ : a_; K[15] = g_ ? a_ : b_; }
  { const float a_ = K[0], b_ = K[2]; const bool g_ = a_ > b_; K[0] = g_ ? a_ : b_; K[2] = g_ ? b_ : a_; }
  { const float a_ = K[1], b_ = K[3]; const bool g_ = a_ > b_; K[1] = g_ ? a_ : b_; K[3] = g_ ? b_ : a_; }
  { const float a_ = K[4], b_ = K[6]; const bool g_ = a_ > b_; K[4] = g_ ? b_ : a_; K[6] = g_ ? a_ : b_; }
  { const float a_ = K[5], b_ = K[7]; const bool g_ = a_ > b_; K[5] = g_ ? b_ : a_; K[7] = g_ ? a_ : b_; }
  { const float a_ = K[8], b_ = K[10]; const bool g_ = a_ > b_; K[8] = g_ ? a_ : b_; K[10] = g_ ? b_ : a_; }
  { const float a_ = K[9], b_ = K[11]; const bool g_ = a_ > b_; K[9] = g_ ? a_ : b_; K[11] = g_ ? b_ : a_; }
  { const float a_ = K[12], b_ = K[14]; const bool g_ = a_ > b_; K[12] = g_ ? b_ : a_; K[14] = g_ ? a_ : b_; }
  { const float a_ = K[13], b_ = K[15]; const bool g_ = a_ > b_; K[13] = g_ ? b_ : a_; K[15] = g_ ? a_ : b_; }
  { const float a_ = K[0], b_ = K[1]; const bool g_ = a_ > b_; K[0] = g_ ? a_ : b_; K[1] = g_ ? b_ : a_; }
  { const float a_ = K[2], b_ = K[3]; const bool g_ = a_ > b_; K[2] = g_ ? a_ : b_; K[3] = g_ ? b_ : a_; }
  { const float a_ = K[4], b_ = K[5]; const bool g_ = a_ > b_; K[4] = g_ ? b_ : a_; K[5] = g_ ? a_ : b_; }
  { const float a_ = K[6], b_ = K[7]; const bool g_ = a_ > b_; K[6] = g_ ? b_ : a_; K[7] = g_ ? a_ : b_; }
  { const float a_ = K[8], b_ = K[9]; const bool g_ = a_ > b_; K[8] = g_ ? a_ : b_; K[9] = g_ ? b_ : a_; }
  { const float a_ = K[10], b_ = K[11]; const bool g_ = a_ > b_; K[10] = g_ ? a_ : b_; K[11] = g_ ? b_ : a_; }
  { const float a_ = K[12], b_ = K[13]; const bool g_ = a_ > b_; K[12] = g_ ? b_ : a_; K[13] = g_ ? a_ : b_; }
  { const float a_ = K[14], b_ = K[15]; const bool g_ = a_ > b_; K[14] = g_ ? b_ : a_; K[15] = g_ ? a_ : b_; }
  { const float a_ = K[0], b_ = K[4]; const bool g_ = a_ > b_; K[0] = g_ ? a_ : b_; K[4] = g_ ? b_ : a_; }
  { const float a_ = K[1], b_ = K[5]; const bool g_ = a_ > b_; K[1] = g_ ? a_ : b_; K[5] = g_ ? b_ : a_; }
  { const float a_ = K[2], b_ = K[6]; const bool g_ = a_ > b_; K[2] = g_ ? a_ : b_; K[6] = g_ ? b_ : a_; }
  { const float a_ = K[3], b_ = K[7]; const bool g_ = a_ > b_; K[3] = g_ ? a_ : b_; K[7] = g_ ? b_ : a_; }
  { const float a_ = K[8], b_ = K[12]; const bool g_ = a_ > b_; K[8] = g_ ? b_ : a_; K[12] = g_ ? a_ : b_; }
  { const float a_ = K[9], b_ = K[13]; const bool g_ = a_ > b_; K[9] = g_ ? b_ : a_; K[13] = g_ ? a_ : b_; }
  { const float a_ = K[10], b_ = K[14]; const bool g_ = a_ > b_; K[10] = g_ ? b_ : a_; K[14] = g_ ? a_ : b_; }
  { const float a_ = K[11], b_ = K[15]; const bool g_ = a_ > b_; K[11] = g_ ? b_ : a_; K[15] = g_ ? a_ : b_; }
  { const float a_ = K[0], b_ = K[2]; const bool g_ = a_ > b_; K[0] = g_ ? a_ : b_; K[2] = g_ ? b_ : a_; }
  { const float a_ = K[1], b_ = K[3]; const bool g_ = a_ > b_; K[1] = g_ ? a_ : b_; K[3] = g_ ? b_ : a_; }
  { const float a_ = K[4], b_ = K[6]; const bool g_ = a_ > b_; K[4] = g_ ? a_ : b_; K[6] = g_ ? b_ : a_; }
  { const float a_ = K[5], b_ = K[7]; const bool g_ = a_ > b_; K[5] = g_ ? a_ : b_; K[7] = g_ ? b_ : a_; }
  { const float a_ = K[8], b_ = K[10]; const bool g_ = a_ > b_; K[8] = g_ ? b_ : a_; K[10] = g_ ? a_ : b_; }
  { const float a_ = K[9], b_ = K[11]; const bool g_ = a_ > b_; K[9] = g_ ? b_ : a_; K[11] = g_ ? a_ : b_; }
  { const float a_ = K[12], b_ = K[14]; const bool g_ = a_ > b_; K[12] = g_ ? b_ : a_; K[14] = g_ ? a_ : b_; }
  { const float a_ = K[13], b_ = K[15]; const bool g_ = a_ > b_; K[13] = g_ ? b_ : a_; K[15] = g_ ? a_ : b_; }
  { const float a_ = K[0], b_ = K[1]; const bool g_ = a_ > b_; K[0] = g_ ? a_ : b_; K[1] = g_ ? b_ : a_; }
  { const float a_ = K[2], b_ = K[3]; const bool g_ = a_ > b_; K[2] = g_ ? a_ : b_; K[3] = g_ ? b_ : a_; }
  { const float a_ = K[4], b_ = K[5]; const bool g_ = a_ > b_; K[4] = g_ ? a_ : b_; K[5] = g_ ? b_ : a_; }
  { const float a_ = K[6], b_ = K[7]; const bool g_ = a_ > b_; K[6] = g_ ? a_ : b_; K[7] = g_ ? b_ : a_; }
  { const float a_ = K[8], b_ = K[9]; const bool g_ = a_ > b_; K[8] = g_ ? b_ : a_; K[9] = g_ ? a_ : b_; }
  { const float a_ = K[10], b_ = K[11]; const bool g_ = a_ > b_; K[10] = g_ ? b_ : a_; K[11] = g_ ? a_ : b_; }
  { const float a_ = K[12], b_ = K[13]; const bool g_ = a_ > b_; K[12] = g_ ? b_ : a_; K[13] = g_ ? a_ : b_; }
  { const float a_ = K[14], b_ = K[15]; const bool g_ = a_ > b_; K[14] = g_ ? b_ : a_; K[15] = g_ ? a_ : b_; }
  { const float a_ = K[0], b_ = K[8]; const bool g_ = a_ > b_; K[0] = g_ ? a_ : b_; K[8] = g_ ? b_ : a_; }
  { const float a_ = K[1], b_ = K[9]; const bool g_ = a_ > b_; K[1] = g_ ? a_ : b_; K[9] = g_ ? b_ : a_; }
  { const float a_ = K[2], b_ = K[10]; const bool g_ = a_ > b_; K[2] = g_ ? a_ : b_; K[10] = g_ ? b_ : a_; }
  { const float a_ = K[3], b_ = K[11]; const bool g_ = a_ > b_; K[3] = g_ ? a_ : b_; K[11] = g_ ? b_ : a_; }
  { const float a_ = K[4], b_ = K[12]; const bool g_ = a_ > b_; K[4] = g_ ? a_ : b_; K[12] = g_ ? b_ : a_; }
  { const float a_ = K[5], b_ = K[13]; const bool g_ = a_ > b_; K[5] = g_ ? a_ : b_; K[13] = g_ ? b_ : a_; }
  { const float a_ = K[6], b_ = K[14]; const bool g_ = a_ > b_; K[6] = g_ ? a_ : b_; K[14] = g_ ? b_ : a_; }
  { const float a_ = K[7], b_ = K[15]; const bool g_ = a_ > b_; K[7] = g_ ? a_ : b_; K[15] = g_ ? b_ : a_; }
  { const float a_ = K[0], b_ = K[4]; const bool g_ = a_ > b_; K[0] = g_ ? a_ : b_; K[4] = g_ ? b_ : a_; }
  { const float a_ = K[1], b_ = K[5]; const bool g_ = a_ > b_; K[1] = g_ ? a_ : b_; K[5] = g_ ? b_ : a_; }
  { const float a_ = K[2], b_ = K[6]; const bool g_ = a_ > b_; K[2] = g_ ? a_ : b_; K[6] = g_ ? b_ : a_; }
  { const float a_ = K[3], b_ = K[7]; const bool g_ = a_ > b_; K[3] = g_ ? a_ : b_; K[7] = g_ ? b_ : a_; }
  { const float a_ = K[8], b_ = K[12]; const bool g_ = a_ > b_; K[8] = g_ ? a_ : b_; K[12] = g_ ? b_ : a_; }
  { const float a_ = K[9], b_ = K[13]; const bool g_ = a_ > b_; K[9] = g_ ? a_ : b_; K[13] = g_ ? b_ : a_; }
  { const float a_ = K[10], b_ = K[14]; const bool g_ = a_ > b_; K[10] = g_ ? a_ : b_; K[14] = g_ ? b_ : a_; }
  { const float a_ = K[11], b_ = K[15]; const bool g_ = a_ > b_; K[11] = g_ ? a_ : b_; K[15] = g_ ? b_ : a_; }
  { const float a_ = K[0], b_ = K[2]; const bool g_ = a_ > b_; K[0] = g_ ? a_ : b_; K[2] = g_ ? b_ : a_; }
  { const float a_ = K[1], b_ = K[3]; const bool g_ = a_ > b_; K[1] = g_ ? a_ : b_; K[3] = g_ ? b_ : a_; }
  { const float a_ = K[4], b_ = K[6]; const bool g_ = a_ > b_; K[4] = g_ ? a_ : b_; K[6] = g_ ? b_ : a_; }
  { const float a_ = K[5], b_ = K[7]; const bool g_ = a_ > b_; K[5] = g_ ? a_ : b_; K[7] = g_ ? b_ : a_; }
  { const float a_ = K[8], b_ = K[10]; const bool g_ = a_ > b_; K[8] = g_ ? a_ : b_; K[10] = g_ ? b_ : a_; }
  { const float a_ = K[9], b_ = K[11]; const bool g_ = a_ > b_; K[9] = g_ ? a_ : b_; K[11] = g_ ? b_ : a_; }
  { const float a_ = K[12], b_ = K[14]; const bool g_ = a_ > b_; K[12] = g_ ? a_ : b_; K[14] = g_ ? b_ : a_; }
  { const float a_ = K[13], b_ = K[15]; const bool g_ = a_ > b_; K[13] = g_ ? a_ : b_; K[15] = g_ ? b_ : a_; }
  { const float a_ = K[0], b_ = K[1]; const bool g_ = a_ > b_; K[0] = g_ ? a_ : b_; K[1] = g_ ? b_ : a_; }
  { const float a_ = K[2], b_ = K[3]; const bool g_ = a_ > b_; K[2] = g_ ? a_ : b_; K[3] = g_ ? b_ : a_; }
  { const float a_ = K[4], b_ = K[5]; const bool g_ = a_ > b_; K[4] = g_ ? a_ : b_; K[5] = g_ ? b_ : a_; }
  { const float a_ = K[6], b_ = K[7]; const bool g_ = a_ > b_; K[6] = g_ ? a_ : b_; K[7] = g_ ? b_ : a_; }
  { const float a_ = K[8], b_ = K[9]; const bool g_ = a_ > b_; K[8] = g_ ? a_ : b_; K[9] = g_ ? b_ : a_; }
  { const float a_ = K[10], b_ = K[11]; const bool g_ = a_ > b_; K[10] = g_ ? a_ : b_; K[11] = g_ ? b_ : a_; }
  { const float a_ = K[12], b_ = K[13]; const bool g_ = a_ > b_; K[12] = g_ ? a_ : b_; K[13] = g_ ? b_ : a_; }
  { const float a_ = K[14], b_ = K[15]; const bool g_ = a_ > b_; K[14] = g_ ? a_ : b_; K[15] = g_ ? b_ : a_; }
  { const float a_ = K[16], b_ = K[17]; const bool g_ = a_ > b_; K[16] = g_ ? a_ : b_; K[17] = g_ ? b_ : a_; }
  { const float a_ = K[18], b_ = K[19]; const bool g_ = a_ > b_; K[18] = g_ ? b_ : a_; K[19] = g_ ? a_ : b_; }
  { const float a_ = K[20], b_ = K[21]; const bool g_ = a_ > b_; K[20] = g_ ? a_ : b_; K[21] = g_ ? b_ : a_; }
  { const float a_ = K[22], b_ = K[23]; const bool g_ = a_ > b_; K[22] = g_ ? b_ : a_; K[23] = g_ ? a_ : b_; }
  { const float a_ = K[24], b_ = K[25]; const bool g_ = a_ > b_; K[24] = g_ ? a_ : b_; K[25] = g_ ? b_ : a_; }
  { const float a_ = K[26], b_ = K[27]; const bool g_ = a_ > b_; K[26] = g_ ? b_ : a_; K[27] = g_ ? a_ : b_; }
  { const float a_ = K[28], b_ = K[29]; const bool g_ = a_ > b_; K[28] = g_ ? a_ : b_; K[29] = g_ ? b_ : a_; }
  { const float a_ = K[30], b_ = K[31]; const bool g_ = a_ > b_; K[30] = g_ ? b_ : a_; K[31] = g_ ? a_ : b_; }
  { const float a_ = K[16], b_ = K[18]; const bool g_ = a_ > b_; K[16] = g_ ? a_ : b_; K[18] = g_ ? b_ : a_; }
  { const float a_ = K[17], b_ = K[19]; const bool g_ = a_ > b_; K[17] = g_ ? a_ : b_; K[19] = g_ ? b_ : a_; }
  { const float a_ = K[20], b_ = K[22]; const bool g_ = a_ > b_; K[20] = g_ ? b_ : a_; K[22] = g_ ? a_ : b_; }
  { const float a_ = K[21], b_ = K[23]; const bool g_ = a_ > b_; K[21] = g_ ? b_ : a_; K[23] = g_ ? a_ : b_; }
  { const float a_ = K[24], b_ = K[26]; const bool g_ = a_ > b_; K[24] = g_ ? a_ : b_; K[26] = g_ ? b_ : a_; }
  { const float a_ = K[25], b_ = K[27]; const bool g_ = a_ > b_; K[25] = g_ ? a_ : b_; K[27] = g_ ? b_ : a_; }
  { const float a_ = K[28], b_ = K[30]; const bool g_ = a_ > b_; K[28] = g_ ? b_ : a_; K[30] = g_ ? a_ : b_; }
  { const float a_ = K[29], b_ = K[31]; const bool g_ = a_ > b_; K[29] = g_ ? b_ : a_; K[31] = g_ ? a_ : b_; }
  { const float a_ = K[16], b_ = K[17]; const bool g_ = a_ > b_; K[16] = g_ ? a_ : b_; K[17] = g_ ? b_ : a_; }
  { const float a_ = K[18], b_ = K[19]; const bool g_ = a_ > b_; K[18] = g_ ? a_ : b_; K[19] = g_ ? b_ : a_; }
  { const float a_ = K[20], b_ = K[21]; const bool g_ = a_ > b_; K[20] = g_ ? b_ : a_; K[21] = g_ ? a_ : b_; }
  { const float a_ = K[22], b_ = K[23]; const bool g_ = a_ > b_; K[22] = g_ ? b_ : a_; K[23] = g_ ? a_ : b_; }
  { const float a_ = K[24], b_ = K[25]; const bool g_ = a_ > b_; K[24] = g_ ? a_ : b_; K[25] = g_ ? b_ : a_; }
  { const float a_ = K[26], b_ = K[27]; const bool g_ = a_ > b_; K[26] = g_ ? a_ : b_; K[27] = g_ ? b_ : a_; }
  { const float a_ = K[28], b_ = K[29]; const bool g_ = a_ > b_; K[28] = g_ ? b_ : a_; K[29] = g_ ? a_ : b_; }
  { const float a_ = K[30], b_ = K[31]; const bool g_ = a_ > b_; K[30] = g_ ? b_ : a_; K[31] = g_ ? a_ : b_; }
  { const float a_ = K[16], b_ = K[20]; const bool g_ = a_ > b_; K[16] = g_ ? a_ : b_; K[20] = g_ ? b_ : a_; }
  { const float a_ = K[17], b_ = K[21]; const bool g_ = a_ > b_; K[17] = g_ ? a_ : b_; K[21] = g_ ? b_ : a_; }
  { const float a_ = K[18], b_ = K[22]; const bool g_ = a_ > b_; K[18] = g_ ? a_ : b_; K[22] = g_ ? b_ : a_; }
  { const float a_ = K[19], b_ = K[23]; const bool g_ = a_ > b_; K[19] = g_ ? a_ : b_; K[23] = g_ ? b_ : a_; }
  { const float a_ = K[24], b_ = K[28]; const bool g_ = a_ > b_; K[24] = g_ ? b_ : a_; K[28] = g_ ? a_ : b_; }
  { const float a_ = K[25], b_ = K[29]; const bool g_ = a_ > b_; K[25] = g_ ? b_ : a_; K[29] = g_ ? a_ : b_; }
  { const float a_ = K[26], b_ = K[30]; const bool g_ = a_ > b_; K[26] = g_ ? b_ : a_; K[30] = g_ ? a_ : b_; }
  { const float a_ = K[27], b_ = K[31]; const bool g_ = a_ > b_; K[27] = g_ ? b_ : a_; K[31] = g_ ? a_ : b_; }
  { const float a_ = K[16], b_ = K[18]; const bool g_ = a_ > b_; K[16] = g_ ? a_ : b_; K[18] = g_ ? b_ : a_; }
  { const float a_ = K[17], b_ = K[19]; const bool g_ = a_ > b_; K[17] = g_ ? a_ : b_; K[19] = g_ ? b_ : a_; }
  { const float a_ = K[20], b_ = K[22]; const bool g_ = a_ > b_; K[20] = g_ ? a_ : b_; K[22] = g_ ? b_ : a_; }
  { const float a_ = K[21], b_ = K[23]; const bool g_ = a_ > b_; K[21] = g_ ? a_ : b_; K[23] = g_ ? b_ : a_; }
  { const float a_ = K[24], b_ = K[26]; const bool g_ = a_ > b_; K[24] = g_ ? b_ : a_; K[26] = g_ ? a_ : b_; }
  { const float a_ = K[25], b_ = K[27]; const bool g_ = a_ > b_; K[25] = g_ ? b_ : a_; K[27] = g_ ? a_ : b_; }
  { const float a_ = K[28], b_ = K[30]; const bool g_ = a_ > b_; K[28] = g_ ? b_ : a_; K[30] = g_ ? a_ : b_; }
  { const float a_ = K[29], b_ = K[31]; const bool g_ = a_ > b_; K[29] = g_ ? b_ : a_; K[31] = g_ ? a_ : b_; }
  { const float a_ = K[16], b_ = K[17]; const bool g_ = a_ > b_; K[16] = g_ ? a_ : b_; K[17] = g_ ? b_ : a_; }
  { const float a_ = K[18], b_ = K[19]; const bool g_ = a_ > b_; K[18] = g_ ? a_ : b_; K[19] = g_ ? b_ : a_; }
  { const float a_ = K[20], b_ = K[21]; const bool g_ = a_ > b_; K[20] = g_ ? a_ : b_; K[21] = g_ ? b_ : a_; }
  { const float a_ = K[22], b_ = K[23]; const bool g_ = a_ > b_; K[22] = g_ ? a_ : b_; K[23] = g_ ? b_ : a_; }
  { const float a_ = K[24], b_ = K[25]; const bool g_ = a_ > b_; K[24] = g_ ? b_ : a_; K[25] = g_ ? a_ : b_; }
  { const float a_ = K[26], b_ = K[27]; const bool g_ = a_ > b_; K[26] = g_ ? b_ : a_; K[27] = g_ ? a_ : b_; }
  { const float a_ = K[28], b_ = K[29]; const bool g_ = a_ > b_; K[28] = g_ ? b_ : a_; K[29] = g_ ? a_ : b_; }
  { const float a_ = K[30], b_ = K[31]; const bool g_ = a_ > b_; K[30] = g_ ? b_ : a_; K[31] = g_ ? a_ : b_; }
  { const float a_ = K[16], b_ = K[24]; const bool g_ = a_ > b_; K[16] = g_ ? a_ : b_; K[24] = g_ ? b_ : a_; }
  { const float a_ = K[17], b_ = K[25]; const bool g_ = a_ > b_; K[17] = g_ ? a_ : b_; K[25] = g_ ? b_ : a_; }
  { const float a_ = K[18], b_ = K[26]; const bool g_ = a_ > b_; K[18] = g_ ? a_ : b_; K[26] = g_ ? b_ : a_; }
  { const float a_ = K[19], b_ = K[27]; const bool g_ = a_ > b_; K[19] = g_ ? a_ : b_; K[27] = g_ ? b_ : a_; }
  { const float a_ = K[20], b_ = K[28]; const bool g_ = a_ > b_; K[20] = g_ ? a_ : b_; K[28] = g_ ? b_ : a_; }
  { const float a_ = K[21], b_ = K[29]; const bool g_ = a_ > b_; K[21] = g_ ? a_ : b_; K[29] = g_ ? b_ : a_; }
  { const float a_ = K[22], b_ = K[30]; const bool g_ = a_ > b_; K[22] = g_ ? a_ : b_; K[30] = g_ ? b_ : a_; }
  { const float a_ = K[23], b_ = K[31]; const bool g_ = a_ > b_; K[23] = g_ ? a_ : b_; K[31] = g_ ? b_ : a_; }
  { const float a_ = K[16], b_ = K[20]; const bool g_ = a_ > b_; K[16] = g_ ? a_ : b_; K[20] = g_ ? b_ : a_; }
  { const float a_ = K[17], b_ = K[21]; const bool g_ = a_ > b_; K[17] = g_ ? a_ : b_; K[21] = g_ ? b_ : a_; }
  { const float a_ = K[18], b_ = K[22]; const bool g_ = a_ > b_; K[18] = g_ ? a_ : b_; K[22] = g_ ? b_ : a_; }
  { const float a_ = K[19], b_ = K[23]; const bool g_ = a_ > b_; K[19] = g_ ? a_ : b_; K[23] = g_ ? b_ : a_; }
  { const float a_ = K[24], b_ = K[28]; const bool g_ = a_ > b_; K[24] = g_ ? a_ : b_; K[28] = g_ ? b_ : a_; }
  { const float a_ = K[25], b_ = K[29]; const bool g_ = a_ > b_; K[25] = g_ ? a_ : b_; K[29] = g_ ? b_ : a_; }
  { const float a_ = K[26], b_ = K[30]; const bool g_ = a_ > b_; K[26] = g_ ? a_ : b_; K[30] = g_ ? b_ : a_; }
  { const float a_ = K[27], b_ = K[31]; const bool g_ = a_ > b_; K[27] = g_ ? a_ : b_; K[31] = g_ ? b_ : a_; }
  { const float a_ = K[16], b_ = K[18]; const bool g_ = a_ > b_; K[16] = g_ ? a_ : b_; K[18] = g_ ? b_ : a_; }
  { const float a_ = K[17], b_ = K[19]; const bool g_ = a_ > b_; K[17] = g_ ? a_ : b_; K[19] = g_ ? b_ : a_; }
  { const float a_ = K[20], b_ = K[22]; const bool g_ = a_ > b_; K[20] = g_ ? a_ : b_; K[22] = g_ ? b_ : a_; }
  { const float a_ = K[21], b_ = K[23]; const bool g_ = a_ > b_; K[21] = g_ ? a_ : b_; K[23] = g_ ? b_ : a_; }
  { const float a_ = K[24], b_ = K[26]; const bool g_ = a_ > b_; K[24] = g_ ? a_ : b_; K[26] = g_ ? b_ : a_; }
  { const float a_ = K[25], b_ = K[27]; const bool g_ = a_ > b_; K[25] = g_ ? a_ : b_; K[27] = g_ ? b_ : a_; }
  { const float a_ = K[28], b_ = K[30]; const bool g_ = a_ > b_; K[28] = g_ ? a_ : b_; K[30] = g_ ? b_ : a_; }
  { const float a_ = K[29], b_ = K[31]; const bool g_ = a_ > b_; K[29] = g_ ? a_ : b_; K[31] = g_ ? b_ : a_; }
  { const float a_ = K[16], b_ = K[17]; const bool g_ = a_ > b_; K[16] = g_ ? a_ : b_; K[17] = g_ ? b_ : a_; }
  { const float a_ = K[18], b_ = K[19]; const bool g_ = a_ > b_; K[18] = g_ ? a_ : b_; K[19] = g_ ? b_ : a_; }
  { const float a_ = K[20], b_ = K[21]; const bool g_ = a_ > b_; K[20] = g_ ? a_ : b_; K[21] = g_ ? b_ : a_; }
  { const float a_ = K[22], b_ = K[23]; const bool g_ = a_ > b_; K[22] = g_ ? a_ : b_; K[23] = g_ ? b_ : a_; }
  { const float a_ = K[24], b_ = K[25]; const bool g_ = a_ > b_; K[24] = g_ ? a_ : b_; K[25] = g_ ? b_ : a_; }
  { const float a_ = K[26], b_ = K[27]; const bool g_ = a_ > b_; K[26] = g_ ? a_ : b_; K[27] = g_ ? b_ : a_; }
  { const float a_ = K[28], b_ = K[29]; const bool g_ = a_ > b_; K[28] = g_ ? a_ : b_; K[29] = g_ ? b_ : a_; }
  { const float a_ = K[30], b_ = K[31]; const bool g_ = a_ > b_; K[30] = g_ ? a_ : b_; K[31] = g_ ? b_ : a_; }
  { const float a_ = K[32], b_ = K[33]; const bool g_ = a_ > b_; K[32] = g_ ? a_ : b_; K[33] = g_ ? b_ : a_; }
  { const float a_ = K[34], b_ = K[35]; const bool g_ = a_ > b_; K[34] = g_ ? b_ : a_; K[35] = g_ ? a_ : b_; }
  { const float a_ = K[36], b_ = K[37]; const bool g_ = a_ > b_; K[36] = g_ ? a_ : b_; K[37] = g_ ? b_ : a_; }
  { const float a_ = K[38], b_ = K[39]; const bool g_ = a_ > b_; K[38] = g_ ? b_ : a_; K[39] = g_ ? a_ : b_; }
  { const float a_ = K[40], b_ = K[41]; const bool g_ = a_ > b_; K[40] = g_ ? a_ : b_; K[41] = g_ ? b_ : a_; }
  { const float a_ = K[42], b_ = K[43]; const bool g_ = a_ > b_; K[42] = g_ ? b_ : a_; K[43] = g_ ? a_ : b_; }
  { const float a_ = K[44], b_ = K[45]; const bool g_ = a_ > b_; K[44] = g_ ? a_ : b_; K[45] = g_ ? b_ : a_; }
  { const float a_ = K[46], b_ = K[47]; const bool g_ = a_ > b_; K[46] = g_ ? b_ : a_; K[47] = g_ ? a_ : b_; }
  { const float a_ = K[32], b_ = K[34]; const bool g_ = a_ > b_; K[32] = g_ ? a_ : b_; K[34] = g_ ? b_ : a_; }
  { const float a_ = K[33], b_ = K[35]; const bool g_ = a_ > b_; K[33] = g_ ? a_ : b_; K[35] = g_ ? b_ : a_; }
  { const float a_ = K[36], b_ = K[38]; const bool g_ = a_ > b_; K[36] = g_ ? b_ : a_; K[38] = g_ ? a_ : b_; }
  { const float a_ = K[37], b_ = K[39]; const bool g_ = a_ > b_; K[37] = g_ ? b_ : a_; K[39] = g_ ? a_ : b_; }
  { const float a_ = K[40], b_ = K[42]; const bool g_ = a_ > b_; K[40] = g_ ? a_ : b_; K[42] = g_ ? b_ : a_; }
  { const float a_ = K[41], b_ = K[43]; const bool g_ = a_ > b_; K[41] = g_ ? a_ : b_; K[43] = g_ ? b_ : a_; }
  { const float a_ = K[44], b_ = K[46]; const bool g_ = a_ > b_; K[44] = g_ ? b_ : a_; K[46] = g_ ? a_ : b_; }
  { const float a_ = K[45], b_ = K[47]; const bool g_ = a_ > b_; K[45] = g_ ? b_ : a_; K[47] = g_ ? a_ : b_; }
  { const float a_ = K[32], b_ = K[33]; const bool g_ = a_ > b_; K[32] = g_ ? a_ : b_; K[33] = g_ ? b_ : a_; }
  { const float a_ = K[34], b_ = K[35]; const bool g_ = a_ > b_; K[34] = g_ ? a_ : b_; K[35] = g_ ? b_ : a_; }
  { const float a_ = K[36], b_ = K[37]; const bool g_ = a_ > b_; K[36] = g_ ? b_ : a_; K[37] = g_ ? a_ : b_; }
  { const float a_ = K[38], b_ = K[39]; const bool g_ = a_ > b_; K[38] = g_ ? b_ : a_; K[39] = g_ ? a_ : b_; }
  { const float a_ = K[40], b_ = K[41]; const bool g_ = a_ > b_; K[40] = g_ ? a_ : b_; K[41] = g_ ? b_ : a_; }
  { const float a_ = K[42], b_ = K[43]; const bool g_ = a_ > b_; K[42] = g_ ? a_ : b_; K[43] = g_ ? b_ : a_; }
  { const float a_ = K[44], b_ = K[45]; const bool g_ = a_ > b_; K[44] = g_ ? b_ : a_; K[45] = g_ ? a_ : b_; }
  { const float a_ = K[46], b_ = K[47]; const bool g_ = a_ > b_; K[46] = g_ ? b_ : a_; K[47] = g_ ? a_ : b_; }
  { const float a_ = K[32], b_ = K[36]; const bool g_ = a_ > b_; K[32] = g_ ? a_ : b_; K[36] = g_ ? b_ : a_; }
  { const float a_ = K[33], b_ = K[37]; const bool g_ = a_ > b_; K[33] = g_ ? a_ : b_; K[37] = g_ ? b_ : a_; }
  { const float a_ = K[34], b_ = K[38]; const bool g_ = a_ > b_; K[34] = g_ ? a_ : b_; K[38] = g_ ? b_ : a_; }
  { const float a_ = K[35], b_ = K[39]; const bool g_ = a_ > b_; K[35] = g_ ? a_ : b_; K[39] = g_ ? b_ : a_; }
  { const float a_ = K[40], b_ = K[44]; const bool g_ = a_ > b_; K[40] = g_ ? b_ : a_; K[44] = g_ ? a_ : b_; }
  { const float a_ = K[41], b_ = K[45]; const bool g_ = a_ > b_; K[41] = g_ ? b_ : a_; K[45] = g_ ? a_ : b_; }
  { const float a_ = K[42], b_ = K[46]; const bool g_ = a_ > b_; K[42] = g_ ? b_ : a_; K[46] = g_ ? a_ : b_; }
  { const float a_ = K[43], b_ = K[47]; const bool g_ = a_ > b_; K[43] = g_ ? b_ : a_; K[47] = g_ ? a_ : b_; }
  { const float a_ = K[32], b_ = K[34]; const bool g_ = a_ > b_; K[32] = g_ ? a_ : b_; K[34] = g_ ? b_ : a_; }
  { const float a_ = K[33], b_ = K[35]; const bool g_ = a_ > b_; K[33] = g_ ? a_ : b_; K[35] = g_ ? b_ : a_; }
  { const float a_ = K[36], b_ = K[38]; const bool g_ = a_ > b_; K[36] = g_ ? a_ : b_; K[38] = g_ ? b_ : a_; }
  { const float a_ = K[37], b_ = K[39]; const bool g_ = a_ > b_; K[37] = g_ ? a_ : b_; K[39] = g_ ? b_ : a_; }
  { const float a_ = K[40], b_ = K[42]; const bool g_ = a_ > b_; K[40] = g_ ? b_ : a_; K[42] = g_ ? a_ : b_; }
  { const float a_ = K[41], b_ = K[43]; const bool g_ = a_ > b_; K[41] = g_ ? b_ : a_; K[43] = g_ ? a_ : b_; }
  { const float a_ = K[44], b_ = K[46]; const bool g_ = a_ > b_; K[44] = g_ ? b_ : a_; K[46] = g_ ? a_ : b_; }
  { const float a_ = K[45], b_ = K[47]; const bool g_ = a_ > b_; K[45] = g_ ? b_ : a_; K[47] = g_ ? a_ : b_; }
  { const float a_ = K[32], b_ = K[33]; const bool g_ = a_ > b_; K[32] = g_ ? a_ : b_; K[33] = g_ ? b_ : a_; }
  { const float a_ = K[34], b_ = K[35]; const bool g_ = a_ > b_; K[34] = g_ ? a_ : b_; K[35] = g_ ? b_ : a_; }
  { const float a_ = K[36], b_ = K[37]; const bool g_ = a_ > b_; K[36] = g_ ? a_ : b_; K[37] = g_ ? b_ : a_; }
  { const float a_ = K[38], b_ = K[39]; const bool g_ = a_ > b_; K[38] = g_ ? a_ : b_; K[39] = g_ ? b_ : a_; }
  { const float a_ = K[40], b_ = K[41]; const bool g_ = a_ > b_; K[40] = g_ ? b_ : a_; K[41] = g_ ? a_ : b_; }
  { const float a_ = K[42], b_ = K[43]; const bool g_ = a_ > b_; K[42] = g_ ? b_ : a_; K[43] = g_ ? a_ : b_; }
  { const float a_ = K[44], b_ = K[45]; const bool g_ = a_ > b_; K[44] = g_ ? b_ : a_; K[45] = g_ ? a_ : b_; }
  { const float a_ = K[46], b_ = K[47]; const bool g_ = a_ > b_; K[46] = g_ ? b_ : a_; K[47] = g_ ? a_ : b_; }
  { const float a_ = K[32], b_ = K[40]; const bool g_ = a_ > b_; K[32] = g_ ? a_ : b_; K[40] = g_ ? b_ : a_; }
  { const float a_ = K[33], b_ = K[41]; const bool g_ = a_ > b_; K[33] = g_ ? a_ : b_; K[41] = g_ ? b_ : a_; }
  { const float a_ = K[34], b_ = K[42]; const bool g_ = a_ > b_; K[34] = g_ ? a_ : b_; K[42] = g_ ? b_ : a_; }
  { const float a_ = K[35], b_ = K[43]; const bool g_ = a_ > b_; K[35] = g_ ? a_ : b_; K[43] = g_ ? b_ : a_; }
  { const float a_ = K[36], b_ = K[44]; const bool g_ = a_ > b_; K[36] = g_ ? a_ : b_; K[44] = g_ ? b_ : a_; }
  { const float a_ = K[37], b_ = K[45]; const bool g_ = a_ > b_; K[37] = g_ ? a_ : b_; K[45] = g_ ? b_ : a_; }
  { const float a_ = K[38], b_ = K[46]; const bool g_ = a_ > b_; K[38] = g_ ? a_ : b_; K[46] = g_ ? b_ : a_; }
  { const float a_ = K[39], b_ = K[47]; const bool g_ = a_ > b_; K[39] = g_ ? a_ : b_; K[47] = g_ ? b_ : a_; }
  { const float a_ = K[32], b_ = K[36]; const bool g_ = a_ > b_; K[32] = g_ ? a_ : b_; K[36] = g_ ? b_ : a_; }
  { const float a_ = K[33], b_ = K[37]; const bool g_ = a_ > b_; K[33] = g_ ? a_ : b_; K[37] = g_ ? b_ : a_; }
  { const float a_ = K[34], b_ = K[38]; const bool g_ = a_ > b_; K[34] = g_ ? a_ : b_; K[38] = g_ ? b_ : a_; }
  { const float a_ = K[35], b_ = K[39]; const bool g_ = a_ > b_; K[35] = g_ ? a_ : b_; K[39] = g_ ? b_ : a_; }
  { const float a_ = K[40], b_ = K[44]; const bool g_ = a_ > b_; K[40] = g_ ? a_ : b_; K[44] = g_ ? b_ : a_; }
  { const float a_ = K[41], b_ = K[45]; const bool g_ = a_ > b_; K[41] = g_ ? a_ : b_; K[45] = g_ ? b_ : a_; }
  { const float a_ = K[42], b_ = K[46]; const bool g_ = a_ > b_; K[42] = g_ ? a_ : b_; K[46] = g_ ? b_ : a_; }
  { const float a_ = K[43], b_ = K[47]; const bool g_ = a_ > b_; K[43] = g_ ? a_ : b_; K[47] = g_ ? b_ : a_; }
  { const float a_ = K[32], b_ = K[34]; const bool g_ = a_ > b_; K[32] = g_ ? a_ : b_; K[34] = g_ ? b_ : a_; }
  { const float a_ = K[33], b_ = K[35]; const bool g_ = a_ > b_; K[33] = g_ ? a_ : b_; K[35] = g_ ? b_ : a_; }
  { const float a_ = K[36], b_ = K[38]; const bool g_ = a_ > b_; K[36] = g_ ? a_ : b_; K[38] = g_ ? b_ : a_; }
  { const float a_ = K[37], b_ = K[39]; const bool g_ = a_ > b_; K[37] = g_ ? a_ : b_; K[39] = g_ ? b_ : a_; }
  { const float a_ = K[40], b_ = K[42]; const bool g_ = a_ > b_; K[40] = g_ ? a_ : b_; K[42] = g_ ? b_ : a_; }
  { const float a_ = K[41], b_ = K[43]; const bool g_ = a_ > b_; K[41] = g_ ? a_ : b_; K[43] = g_ ? b_ : a_; }
  { const float a_ = K[44], b_ = K[46]; const bool g_ = a_ > b_; K[44] = g_ ? a_ : b_; K[46] = g_ ? b_ : a_; }
  { const float a_ = K[45], b_ = K[47]; const bool g_ = a_ > b_; K[45] = g_ ? a_ : b_; K[47] = g_ ? b_ : a_; }
  { const float a_ = K[32], b_ = K[33]; const bool g_ = a_ > b_; K[32] = g_ ? a_ : b_; K[33] = g_ ? b_ : a_; }
  { const float a_ = K[34], b_ = K[35]; const bool g_ = a_ > b_; K[34] = g_ ? a_ : b_; K[35] = g_ ? b_ : a_; }
  { const float a_ = K[36], b_ = K[37]; const bool g_ = a_ > b_; K[36] = g_ ? a_ : b_; K[37] = g_ ? b_ : a_; }
  { const float a_ = K[38], b_ = K[39]; const bool g_ = a_ > b_; K[38] = g_ ? a_ : b_; K[39] = g_ ? b_ : a_; }
  { const float a_ = K[40], b_ = K[41]; const bool g_ = a_ > b_; K[40] = g_ ? a_ : b_; K[41] = g_ ? b_ : a_; }
  { const float a_ = K[42], b_ = K[43]; const bool g_ = a_ > b_; K[42] = g_ ? a_ : b_; K[43] = g_ ? b_ : a_; }
  { const float a_ = K[44], b_ = K[45]; const bool g_ = a_ > b_; K[44] = g_ ? a_ : b_; K[45] = g_ ? b_ : a_; }
  { const float a_ = K[46], b_ = K[47]; const bool g_ = a_ > b_; K[46] = g_ ? a_ : b_; K[47] = g_ ? b_ : a_; }
  { const float a_ = K[48], b_ = K[49]; const bool g_ = a_ > b_; K[48] = g_ ? a_ : b_; K[49] = g_ ? b_ : a_; }
  { const float a_ = K[50], b_ = K[51]; const bool g_ = a_ > b_; K[50] = g_ ? b_ : a_; K[51] = g_ ? a_ : b_; }
  { const float a_ = K[52], b_ = K[53]; const bool g_ = a_ > b_; K[52] = g_ ? a_ : b_; K[53] = g_ ? b_ : a_; }
  { const float a_ = K[54], b_ = K[55]; const bool g_ = a_ > b_; K[54] = g_ ? b_ : a_; K[55] = g_ ? a_ : b_; }
  { const float a_ = K[56], b_ = K[57]; const bool g_ = a_ > b_; K[56] = g_ ? a_ : b_; K[57] = g_ ? b_ : a_; }
  { const float a_ = K[58], b_ = K[59]; const bool g_ = a_ > b_; K[58] = g_ ? b_ : a_; K[59] = g_ ? a_ : b_; }
  { const float a_ = K[60], b_ = K[61]; const bool g_ = a_ > b_; K[60] = g_ ? a_ : b_; K[61] = g_ ? b_ : a_; }
  { const float a_ = K[62], b_ = K[63]; const bool g_ = a_ > b_; K[62] = g_ ? b_ : a_; K[63] = g_ ? a_ : b_; }
  { const float a_ = K[48], b_ = K[50]; const bool g_ = a_ > b_; K[48] = g_ ? a_ : b_; K[50] = g_ ? b_ : a_; }
  { const float a_ = K[49], b_ = K[51]; const bool g_ = a_ > b_; K[49] = g_ ? a_ : b_; K[51] = g_ ? b_ : a_; }
  { const float a_ = K[52], b_ = K[54]; const bool g_ = a_ > b_; K[52] = g_ ? b_ : a_; K[54] = g_ ? a_ : b_; }
  { const float a_ = K[53], b_ = K[55]; const bool g_ = a_ > b_; K[53] = g_ ? b_ : a_; K[55] = g_ ? a_ : b_; }
  { const float a_ = K[56], b_ = K[58]; const bool g_ = a_ > b_; K[56] = g_ ? a_ : b_; K[58] = g_ ? b_ : a_; }
  { const float a_ = K[57], b_ = K[59]; const bool g_ = a_ > b_; K[57] = g_ ? a_ : b_; K[59] = g_ ? b_ : a_; }
  { const float a_ = K[60], b_ = K[62]; const bool g_ = a_ > b_; K[60] = g_ ? b_ : a_; K[62] = g_ ? a_ : b_; }
  { const float a_ = K[61], b_ = K[63]; const bool g_ = a_ > b_; K[61] = g_ ? b_ : a_; K[63] = g_ ? a_ : b_; }
  { const float a_ = K[48], b_ = K[49]; const bool g_ = a_ > b_; K[48] = g_ ? a_ : b_; K[49] = g_ ? b_ : a_; }
  { const float a_ = K[50], b_ = K[51]; const bool g_ = a_ > b_; K[50] = g_ ? a_ : b_; K[51] = g_ ? b_ : a_; }
  { const float a_ = K[52], b_ = K[53]; const bool g_ = a_ > b_; K[52] = g_ ? b_ : a_; K[53] = g_ ? a_ : b_; }
  { const float a_ = K[54], b_ = K[55]; const bool g_ = a_ > b_; K[54] = g_ ? b_ : a_; K[55] = g_ ? a_ : b_; }
  { const float a_ = K[56], b_ = K[57]; const bool g_ = a_ > b_; K[56] = g_ ? a_ : b_; K[57] = g_ ? b_ : a_; }
  { const float a_ = K[58], b_ = K[59]; const bool g_ = a_ > b_; K[58] = g_ ? a_ : b_; K[59] = g_ ? b_ : a_; }
  { const float a_ = K[60], b_ = K[61]; const bool g_ = a_ > b_; K[60] = g_ ? b_ : a_; K[61] = g_ ? a_ : b_; }
  { const float a_ = K[62], b_ = K[63]; const bool g_ = a_ > b_; K[62] = g_ ? b_ : a_; K[63] = g_ ? a_ : b_; }
  { const float a_ = K[48], b_ = K[52]; const bool g_ = a_ > b_; K[48] = g_ ? a_ : b_; K[52] = g_ ? b_ : a_; }
  { const float a_ = K[49], b_ = K[53]; const bool g_ = a_ > b_; K[49] = g_ ? a_ : b_; K[53] = g_ ? b_ : a_; }
  { const float a_ = K[50], b_ = K[54]; const bool g_ = a_ > b_; K[50] = g_ ? a_ : b_; K[54] = g_ ? b_ : a_; }
  { const float a_ = K[51], b_ = K[55]; const bool g_ = a_ > b_; K[51] = g_ ? a_ : b_; K[55] = g_ ? b_ : a_; }
  { const float a_ = K[56], b_ = K[60]; const bool g_ = a_ > b_; K[56] = g_ ? b_ : a_; K[60] = g_ ? a_ : b_; }
  { const float a_ = K[57], b_ = K[61]; const bool g_ = a_ > b_; K[57] = g_ ? b_ : a_; K[61] = g_ ? a_ : b_; }
  { const float a_ = K[58], b_ = K[62]; const bool g_ = a_ > b_; K[58] = g_ ? b_ : a_; K[62] = g_ ? a_ : b_; }
  { const float a_ = K[59], b_ = K[63]; const bool g_ = a_ > b_; K[59] = g_ ? b_ : a_; K[63] = g_ ? a_ : b_; }
  { const float a_ = K[48], b_ = K[50]; const bool g_ = a_ > b_; K[48] = g_ ? a_ : b_; K[50] = g_ ? b_ : a_; }
  { const float a_ = K[49], b_ = K[51]; const bool g_ = a_ > b_; K[49] = g_ ? a_ : b_; K[51] = g_ ? b_ : a_; }
  { const float a_ = K[52], b_ = K[54]; const bool g_ = a_ > b_; K[52] = g_ ? a_ : b_; K[54] = g_ ? b_ : a_; }
  { const float a_ = K[53], b_ = K[55]; const bool g_ = a_ > b_; K[53] = g_ ? a_ : b_; K[55] = g_ ? b_ : a_; }
  { const float a_ = K[56], b_ = K[58]; const bool g_ = a_ > b_; K[56] = g_ ? b_ : a_; K[58] = g_ ? a_ : b_; }
  { const float a_ = K[57], b_ = K[59]; const bool g_ = a_ > b_; K[57] = g_ ? b_ : a_; K[59] = g_ ? a_ : b_; }
  { const float a_ = K[60], b_ = K[62]; const bool g_ = a_ > b_; K[60] = g_ ? b_ : a_; K[62] = g_ ? a_ : b_; }
  { const float a_ = K[61], b_ = K[63]; const bool g_ = a_ > b_; K[61] = g_ ? b_ : a_; K[63] = g_ ? a_ : b_; }
  { const float a_ = K[48], b_ = K[49]; const bool g_ = a_ > b_; K[48] = g_ ? a_ : b_; K[49] = g_ ? b_ : a_; }
  { const float a_ = K[50], b_ = K[51]; const bool g_ = a_ > b_; K[50] = g_ ? a_ : b_; K[51] = g_ ? b_ : a_; }
  { const float a_ = K[52], b_ = K[53]; const bool g_ = a_ > b_; K[52] = g_ ? a_ : b_; K[53] = g_ ? b_ : a_; }
  { const float a_ = K[54], b_ = K[55]; const bool g_ = a_ > b_; K[54] = g_ ? a_ : b_; K[55] = g_ ? b_ : a_; }
  { const float a_ = K[56], b_ = K[57]; const bool g_ = a_ > b_; K[56] = g_ ? b_ : a_; K[57] = g_ ? a_ : b_; }
  { const float a_ = K[58], b_ = K[59]; const bool g_ = a_ > b_; K[58] = g_ ? b_ : a_; K[59] = g_ ? a_ : b_; }
  { const float a_ = K[60], b_ = K[61]; const bool g_ = a_ > b_; K[60] = g_ ? b_ : a_; K[61] = g_ ? a_ : b_; }
  { const float a_ = K[62], b_ = K[63]; const bool g_ = a_ > b_; K[62] = g_ ? b_ : a_; K[63] = g_ ? a_ : b_; }
  { const float a_ = K[48], b_ = K[56]; const bool g_ = a_ > b_; K[48] = g_ ? a_ : b_; K[56] = g_ ? b_ : a_; }
  { const float a_ = K[49], b_ = K[57]; const bool g_ = a_ > b_; K[49] = g_ ? a_ : b_; K[57] = g_ ? b_ : a_; }
  { const float a_ = K[50], b_ = K[58]; const bool g_ = a_ > b_; K[50] = g_ ? a_ : b_; K[58] = g_ ? b_ : a_; }
  { const float a_ = K[51], b_ = K[59]; const bool g_ = a_ > b_; K[51] = g_ ? a_ : b_; K[59] = g_ ? b_ : a_; }
  { const float a_ = K[52], b_ = K[60]; const bool g_ = a_ > b_; K[52] = g_ ? a_ : b_; K[60] = g_ ? b_ : a_; }
  { const float a_ = K[53], b_ = K[61]; const bool g_ = a_ > b_; K[53] = g_ ? a_ : b_; K[61] = g_ ? b_ : a_; }
  { const float a_ = K[54], b_ = K[62]; const bool g_ = a_ > b_; K[54] = g_ ? a_ : b_; K[62] = g_ ? b_ : a_; }
  { const float a_ = K[55], b_ = K[63]; const bool g_ = a_ > b_; K[55] = g_ ? a_ : b_; K[63] = g_ ? b_ : a_; }
  { const float a_ = K[48], b_ = K[52]; const bool g_ = a_ > b_; K[48] = g_ ? a_ : b_; K[52] = g_ ? b_ : a_; }
  { const float a_ = K[49], b_ = K[53]; const bool g_ = a_ > b_; K[49] = g_ ? a_ : b_; K[53] = g_ ? b_ : a_; }
  { const float a_ = K[50], b_ = K[54]; const bool g_ = a_ > b_; K[50] = g_ ? a_ : b_; K[54] = g_ ? b_ : a_; }
  { const float a_ = K[51], b_ = K[55]; const bool g_ = a_ > b_; K[51] = g_ ? a_ : b_; K[55] = g_ ? b_ : a_; }
  { const float a_ = K[56], b_ = K[60]; const bool g_ = a_ > b_; K[56] = g_ ? a_ : b_; K[60] = g_ ? b_ : a_; }
  { const float a_ = K[57], b_ = K[61]; const bool g_ = a_ > b_; K[57] = g_ ? a_ : b_; K[61] = g_ ? b_ : a_; }
  { const float a_ = K[58], b_ = K[62]; const bool g_ = a_ > b_; K[58] = g_ ? a_ : b_; K[62] = g_ ? b_ : a_; }
  { const float a_ = K[59], b_ = K[63]; const bool g_ = a_ > b_; K[59] = g_ ? a_ : b_; K[63] = g_ ? b_ : a_; }
  { const float a_ = K[48], b_ = K[50]; const bool g_ = a_ > b_; K[48] = g_ ? a_ : b_; K[50] = g_ ? b_ : a_; }
  { const float a_ = K[49], b_ = K[51]; const bool g_ = a_ > b_; K[49] = g_ ? a_ : b_; K[51] = g_ ? b_ : a_; }
  { const float a_ = K[52], b_ = K[54]; const bool g_ = a_ > b_; K[52] = g_ ? a_ : b_; K[54] = g_ ? b_ : a_; }
  { const float a_ = K[53], b_ = K[55]; const bool g_ = a_ > b_; K[53] = g_ ? a_ : b_; K[55] = g_ ? b_ : a_; }
  { const float a_ = K[56], b_ = K[58]; const bool g_ = a_ > b_; K[56] = g_ ? a_ : b_; K[58] = g_ ? b_ : a_; }
  { const float a_ = K[57], b_ = K[59]; const bool g_ = a_ > b_; K[57] = g_ ? a_ : b_; K[59] = g_ ? b_ : a_; }
  { const float a_ = K[60], b_ = K[62]; const bool g_ = a_ > b_; K[60] = g_ ? a_ : b_; K[62] = g_ ? b_ : a_; }
  { const float a_ = K[61], b_ = K[63]; const bool g_ = a_ > b_; K[61] = g_ ? a_ : b_; K[63] = g_ ? b_ : a_; }
  { const float a_ = K[48], b_ = K[49]; const bool g_ = a_ > b_; K[48] = g_ ? a_ : b_; K[49] = g_ ? b_ : a_; }
  { const float a_ = K[50], b_ = K[51]; const bool g_ = a_ > b_; K[50] = g_ ? a_ : b_; K[51] = g_ ? b_ : a_; }
  { const float a_ = K[52], b_ = K[53]; const bool g_ = a_ > b_; K[52] = g_ ? a_ : b_; K[53] = g_ ? b_ : a_; }
  { const float a_ = K[54], b_ = K[55]; const bool g_ = a_ > b_; K[54] = g_ ? a_ : b_; K[55] = g_ ? b_ : a_; }
  { const float a_ = K[56], b_ = K[57]; const bool g_ = a_ > b_; K[56] = g_ ? a_ : b_; K[57] = g_ ? b_ : a_; }
  { const float a_ = K[58], b_ = K[59]; const bool g_ = a_ > b_; K[58] = g_ ? a_ : b_; K[59] = g_ ? b_ : a_; }
  { const float a_ = K[60], b_ = K[61]; const bool g_ = a_ > b_; K[60] = g_ ? a_ : b_; K[61] = g_ ? b_ : a_; }
  { const float a_ = K[62], b_ = K[63]; const bool g_ = a_ > b_; K[62] = g_ ? a_ : b_; K[63] = g_ ? b_ : a_; }
  { const float a_ = K[0], b_ = K[31]; K[0] = a_ > b_ ? a_ : b_; }
  { const float a_ = K[1], b_ = K[30]; K[1] = a_ > b_ ? a_ : b_; }
  { const float a_ = K[2], b_ = K[29]; K[2] = a_ > b_ ? a_ : b_; }
  { const float a_ = K[3], b_ = K[28]; K[3] = a_ > b_ ? a_ : b_; }
  { const float a_ = K[4], b_ = K[27]; K[4] = a_ > b_ ? a_ : b_; }
  { const float a_ = K[5], b_ = K[26]; K[5] = a_ > b_ ? a_ : b_; }
  { const float a_ = K[6], b_ = K[25]; K[6] = a_ > b_ ? a_ : b_; }
  { const float a_ = K[7], b_ = K[24]; K[7] = a_ > b_ ? a_ : b_; }
  { const float a_ = K[8], b_ = K[23]; K[8] = a_ > b_ ? a_ : b_; }
  { const float a_ = K[9], b_ = K[22]; K[9] = a_ > b_ ? a_ : b_; }
  { const float a_ = K[10], b_ = K[21]; K[10] = a_ > b_ ? a_ : b_; }
  { const float a_ = K[11], b_ = K[20]; K[11] = a_ > b_ ? a_ : b_; }
  { const float a_ = K[12], b_ = K[19]; K[12] = a_ > b_ ? a_ : b_; }
  { const float a_ = K[13], b_ = K[18]; K[13] = a_ > b_ ? a_ : b_; }
  { const float a_ = K[14], b_ = K[17]; K[14] = a_ > b_ ? a_ : b_; }
  { const float a_ = K[15], b_ = K[16]; K[15] = a_ > b_ ? a_ : b_; }
  { const float a_ = K[0], b_ = K[8]; const bool g_ = a_ > b_; K[0] = g_ ? a_ : b_; K[8] = g_ ? b_ : a_; }
  { const float a_ = K[1], b_ = K[9]; const bool g_ = a_ > b_; K[1] = g_ ? a_ : b_; K[9] = g_ ? b_ : a_; }
  { const float a_ = K[2], b_ = K[10]; const bool g_ = a_ > b_; K[2] = g_ ? a_ : b_; K[10] = g_ ? b_ : a_; }
  { const float a_ = K[3], b_ = K[11]; const bool g_ = a_ > b_; K[3] = g_ ? a_ : b_; K[11] = g_ ? b_ : a_; }
  { const float a_ = K[4], b_ = K[12]; const bool g_ = a_ > b_; K[4] = g_ ? a_ : b_; K[12] = g_ ? b_ : a_; }
  { const float a_ = K[5], b_ = K[13]; const bool g_ = a_ > b_; K[5] = g_ ? a_ : b_; K[13] = g_ ? b_ : a_; }
  { const float a_ = K[6], b_ = K[14]; const bool g_ = a_ > b_; K[6] = g_ ? a_ : b_; K[14] = g_ ? b_ : a_; }
  { const float a_ = K[7], b_ = K[15]; const bool g_ = a_ > b_; K[7] = g_ ? a_ : b_; K[15] = g_ ? b_ : a_; }
  { const float a_ = K[0], b_ = K[4]; const bool g_ = a_ > b_; K[0] = g_ ? a_ : b_; K[4] = g_ ? b_ : a_; }
  { const float a_ = K[1], b_ = K[5]; const bool g_ = a_ > b_; K[1] = g_ ? a_ : b_; K[5] = g_ ? b_ : a_; }
  { const float a_ = K[2], b_ = K[6]; const bool g_ = a_ > b_; K[2] = g_ ? a_ : b_; K[6] = g_ ? b_ : a_; }
  { const float a_ = K[3], b_ = K[7]; const bool g_ = a_ > b_; K[3] = g_ ? a_ : b_; K[7] = g_ ? b_ : a_; }
  { const float a_ = K[8], b_ = K[12]; const bool g_ = a_ > b_; K[8] = g_ ? a_ : b_; K[12] = g_ ? b_ : a_; }
  { const float a_ = K[9], b_ = K[13]; const bool g_ = a_ > b_; K[9] = g_ ? a_ : b_; K[13] = g_ ? b_ : a_; }
  { const float a_ = K[10], b_ = K[14]; const bool g_ = a_ > b_; K[10] = g_ ? a_ : b_; K[14] = g_ ? b_ : a_; }
  { const float a_ = K[11], b_ = K[15]; const bool g_ = a_ > b_; K[11] = g_ ? a_ : b_; K[15] = g_ ? b_ : a_; }
  { const float a_ = K[0], b_ = K[2]; const bool g_ = a_ > b_; K[0] = g_ ? a_ : b_; K[2] = g_ ? b_ : a_; }
  { const float a_ = K[1], b_ = K[3]; const bool g_ = a_ > b_; K[1] = g_ ? a_ : b_; K[3] = g_ ? b_ : a_; }
  { const float a_ = K[4], b_ = K[6]; const bool g_ = a_ > b_; K[4] = g_ ? a_ : b_; K[6] = g_ ? b_ : a_; }
  { const float a_ = K[5], b_ = K[7]; const bool g_ = a_ > b_; K[5] = g_ ? a_ : b_; K[7] = g_ ? b_ : a_; }
  { const float a_ = K[8], b_ = K[10]; const bool g_ = a_ > b_; K[8] = g_ ? a_ : b_; K[10] = g_ ? b_ : a_; }
  { const float a_ = K[9], b_ = K[11]; const bool g_ = a_ > b_; K[9] = g_ ? a_ : b_; K[11] = g_ ? b_ : a_; }
  { const float a_ = K[12], b_ = K[14]; const bool g_ = a_ > b_; K[12] = g_ ? a_ : b_; K[14] = g_ ? b_ : a_; }
  { const float a_ = K[13], b_ = K[15]; const bool g_ = a_ > b_; K[13] = g_ ? a_ : b_; K[15] = g_ ? b_ : a_; }
  { const float a_ = K[0], b_ = K[1]; const bool g_ = a_ > b_; K[0] = g_ ? a_ : b_; K[1] = g_ ? b_ : a_; }
  { const float a_ = K[2], b_ = K[3]; const bool g_ = a_ > b_; K[2] = g_ ? a_ : b_; K[3] = g_ ? b_ : a_; }
  { const float a_ = K[4], b_ = K[5]; const bool g_ = a_ > b_; K[4] = g_ ? a_ : b_; K[5] = g_ ? b_ : a_; }
  { const float a_ = K[6], b_ = K[7]; const bool g_ = a_ > b_; K[6] = g_ ? a_ : b_; K[7] = g_ ? b_ : a_; }
  { const float a_ = K[8], b_ = K[9]; const bool g_ = a_ > b_; K[8] = g_ ? a_ : b_; K[9] = g_ ? b_ : a_; }
  { const float a_ = K[10], b_ = K[11]; const bool g_ = a_ > b_; K[10] = g_ ? a_ : b_; K[11] = g_ ? b_ : a_; }
  { const float a_ = K[12], b_ = K[13]; const bool g_ = a_ > b_; K[12] = g_ ? a_ : b_; K[13] = g_ ? b_ : a_; }
  { const float a_ = K[14], b_ = K[15]; const bool g_ = a_ > b_; K[14] = g_ ? a_ : b_; K[15] = g_ ? b_ : a_; }
  { const float a_ = K[32], b_ = K[63]; K[32] = a_ > b_ ? a_ : b_; }
  { const float a_ = K[33], b_ = K[62]; K[33] = a_ > b_ ? a_ : b_; }
  { const float a_ = K[34], b_ = K[61]; K[34] = a_ > b_ ? a_ : b_; }
  { const float a_ = K[35], b_ = K[60]; K[35] = a_ > b_ ? a_ : b_; }
  { const float a_ = K[36], b_ = K[59]; K[36] = a_ > b_ ? a_ : b_; }
  { const float a_ = K[37], b_ = K[58]; K[37] = a_ > b_ ? a_ : b_; }
  { const float a_ = K[38], b_ = K[57]; K[38] = a_ > b_ ? a_ : b_; }
  { const float a_ = K[39], b_ = K[56]; K[39] = a_ > b_ ? a_ : b_; }
  { const float a_ = K[40], b_ = K[55]; K[40] = a_ > b_ ? a_ : b_; }
  { const float a_ = K[41], b_ = K[54]; K[41] = a_ > b_ ? a_ : b_; }
  { const float a_ = K[42], b_ = K[53]; K[42] = a_ > b_ ? a_ : b_; }
  { const float a_ = K[43], b_ = K[52]; K[43] = a_ > b_ ? a_ : b_; }
  { const float a_ = K[44], b_ = K[51]; K[44] = a_ > b_ ? a_ : b_; }
  { const float a_ = K[45], b_ = K[50]; K[45] = a_ > b_ ? a_ : b_; }
  { const float a_ = K[46], b_ = K[49]; K[46] = a_ > b_ ? a_ : b_; }
  { const float a_ = K[47], b_ = K[48]; K[47] = a_ > b_ ? a_ : b_; }
  { const float a_ = K[32], b_ = K[40]; const bool g_ = a_ > b_; K[32] = g_ ? a_ : b_; K[40] = g_ ? b_ : a_; }
  { const float a_ = K[33], b_ = K[41]; const bool g_ = a_ > b_; K[33] = g_ ? a_ : b_; K[41] = g_ ? b_ : a_; }
  { const float a_ = K[34], b_ = K[42]; const bool g_ = a_ > b_; K[34] = g_ ? a_ : b_; K[42] = g_ ? b_ : a_; }
  { const float a_ = K[35], b_ = K[43]; const bool g_ = a_ > b_; K[35] = g_ ? a_ : b_; K[43] = g_ ? b_ : a_; }
  { const float a_ = K[36], b_ = K[44]; const bool g_ = a_ > b_; K[36] = g_ ? a_ : b_; K[44] = g_ ? b_ : a_; }
  { const float a_ = K[37], b_ = K[45]; const bool g_ = a_ > b_; K[37] = g_ ? a_ : b_; K[45] = g_ ? b_ : a_; }
  { const float a_ = K[38], b_ = K[46]; const bool g_ = a_ > b_; K[38] = g_ ? a_ : b_; K[46] = g_ ? b_ : a_; }
  { const float a_ = K[39], b_ = K[47]; const bool g_ = a_ > b_; K[39] = g_ ? a_ : b_; K[47] = g_ ? b_ : a_; }
  { const float a_ = K[32], b_ = K[36]; const bool g_ = a_ > b_; K[32] = g_ ? a_ : b_; K[36] = g_ ? b_ : a_; }
  { const float a_ = K[33], b_ = K[37]; const bool g_ = a_ > b_; K[33] = g_ ? a_ : b_; K[37] = g_ ? b_ : a_; }
  { const float a_ = K[34], b_ = K[38]; const bool g_ = a_ > b_; K[34] = g_ ? a_ : b_; K[38] = g_ ? b_ : a_; }
  { const float a_ = K[35], b_ = K[39]; const bool g_ = a_ > b_; K[35] = g_ ? a_ : b_; K[39] = g_ ? b_ : a_; }
  { const float a_ = K[40], b_ = K[44]; const bool g_ = a_ > b_; K[40] = g_ ? a_ : b_; K[44] = g_ ? b_ : a_; }
  { const float a_ = K[41], b_ = K[45]; const bool g_ = a_ > b_; K[41] = g_ ? a_ : b_; K[45] = g_ ? b_ : a_; }
  { const float a_ = K[42], b_ = K[46]; const bool g_ = a_ > b_; K[42] = g_ ? a_ : b_; K[46] = g_ ? b_ : a_; }
  { const float a_ = K[43], b_ = K[47]; const bool g_ = a_ > b_; K[43] = g_ ? a_ : b_; K[47] = g_ ? b_ : a_; }
  { const float a_ = K[32], b_ = K[34]; const bool g_ = a_ > b_; K[32] = g_ ? a_ : b_; K[34] = g_ ? b_ : a_; }
  { const float a_ = K[33], b_ = K[35]; const bool g_ = a_ > b_; K[33] = g_ ? a_ : b_; K[35] = g_ ? b_ : a_; }
  { const float a_ = K[36], b_ = K[38]; const bool g_ = a_ > b_; K[36] = g_ ? a_ : b_; K[38] = g_ ? b_ : a_; }
  { const float a_ = K[37], b_ = K[39]; const bool g_ = a_ > b_; K[37] = g_ ? a_ : b_; K[39] = g_ ? b_ : a_; }
  { const float a_ = K[40], b_ = K[42]; const bool g_ = a_ > b_; K[40] = g_ ? a_ : b_; K[42] = g_ ? b_ : a_; }
  { const float a_ = K[41], b_ = K[43]; const bool g_ = a_ > b_; K[41] = g_ ? a_ : b_; K[43] = g_ ? b_ : a_; }
  { const float a_ = K[44], b_ = K[46]; const bool g_ = a_ > b_; K[44] = g_ ? a_ : b_; K[46] = g_ ? b_ : a_; }
  { const float a_ = K[45], b_ = K[47]; const bool g_ = a_ > b_; K[45] = g_ ? a_ : b_; K[47] = g_ ? b_ : a_; }
  { const float a_ = K[32], b_ = K[33]; const bool g_ = a_ > b_; K[32] = g_ ? a_ : b_; K[33] = g_ ? b_ : a_; }
  { const float a_ = K[34], b_ = K[35]; const bool g_ = a_ > b_; K[34] = g_ ? a_ : b_; K[35] = g_ ? b_ : a_; }
  { const float a_ = K[36], b_ = K[37]; const bool g_ = a_ > b_; K[36] = g_ ? a_ : b_; K[37] = g_ ? b_ : a_; }
  { const float a_ = K[38], b_ = K[39]; const bool g_ = a_ > b_; K[38] = g_ ? a_ : b_; K[39] = g_ ? b_ : a_; }
  { const float a_ = K[40], b_ = K[41]; const bool g_ = a_ > b_; K[40] = g_ ? a_ : b_; K[41] = g_ ? b_ : a_; }
  { const float a_ = K[42], b_ = K[43]; const bool g_ = a_ > b_; K[42] = g_ ? a_ : b_; K[43] = g_ ? b_ : a_; }
  { const float a_ = K[44], b_ = K[45]; const bool g_ = a_ > b_; K[44] = g_ ? a_ : b_; K[45] = g_ ? b_ : a_; }
  { const float a_ = K[46], b_ = K[47]; const bool g_ = a_ > b_; K[46] = g_ ? a_ : b_; K[47] = g_ ? b_ : a_; }
  { const float a_ = K[0], b_ = K[47]; K[0] = a_ > b_ ? a_ : b_; }
  { const float a_ = K[1], b_ = K[46]; K[1] = a_ > b_ ? a_ : b_; }
  { const float a_ = K[2], b_ = K[45]; K[2] = a_ > b_ ? a_ : b_; }
  { const float a_ = K[3], b_ = K[44]; K[3] = a_ > b_ ? a_ : b_; }
  { const float a_ = K[4], b_ = K[43]; K[4] = a_ > b_ ? a_ : b_; }
  { const float a_ = K[5], b_ = K[42]; K[5] = a_ > b_ ? a_ : b_; }
  { const float a_ = K[6], b_ = K[41]; K[6] = a_ > b_ ? a_ : b_; }
  { const float a_ = K[7], b_ = K[40]; K[7] = a_ > b_ ? a_ : b_; }
  { const float a_ = K[8], b_ = K[39]; K[8] = a_ > b_ ? a_ : b_; }
  { const float a_ = K[9], b_ = K[38]; K[9] = a_ > b_ ? a_ : b_; }
  { const float a_ = K[10], b_ = K[37]; K[10] = a_ > b_ ? a_ : b_; }
  { const float a_ = K[11], b_ = K[36]; K[11] = a_ > b_ ? a_ : b_; }
  { const float a_ = K[12], b_ = K[35]; K[12] = a_ > b_ ? a_ : b_; }
  { const float a_ = K[13], b_ = K[34]; K[13] = a_ > b_ ? a_ : b_; }
  { const float a_ = K[14], b_ = K[33]; K[14] = a_ > b_ ? a_ : b_; }
  { const float a_ = K[15], b_ = K[32]; K[15] = a_ > b_ ? a_ : b_; }
  { const float a_ = K[0], b_ = K[8]; const bool g_ = a_ > b_; K[0] = g_ ? a_ : b_; K[8] = g_ ? b_ : a_; }
  { const float a_ = K[1], b_ = K[9]; const bool g_ = a_ > b_; K[1] = g_ ? a_ : b_; K[9] = g_ ? b_ : a_; }
  { const float a_ = K[2], b_ = K[10]; const bool g_ = a_ > b_; K[2] = g_ ? a_ : b_; K[10] = g_ ? b_ : a_; }
  { const float a_ = K[3], b_ = K[11]; const bool g_ = a_ > b_; K[3] = g_ ? a_ : b_; K[11] = g_ ? b_ : a_; }
  { const float a_ = K[4], b_ = K[12]; const bool g_ = a_ > b_; K[4] = g_ ? a_ : b_; K[12] = g_ ? b_ : a_; }
  { const float a_ = K[5], b_ = K[13]; const bool g_ = a_ > b_; K[5] = g_ ? a_ : b_; K[13] = g_ ? b_ : a_; }
  { const float a_ = K[6], b_ = K[14]; const bool g_ = a_ > b_; K[6] = g_ ? a_ : b_; K[14] = g_ ? b_ : a_; }
  { const float a_ = K[7], b_ = K[15]; const bool g_ = a_ > b_; K[7] = g_ ? a_ : b_; K[15] = g_ ? b_ : a_; }
  { const float a_ = K[0], b_ = K[4]; const bool g_ = a_ > b_; K[0] = g_ ? a_ : b_; K[4] = g_ ? b_ : a_; }
  { const float a_ = K[1], b_ = K[5]; const bool g_ = a_ > b_; K[1] = g_ ? a_ : b_; K[5] = g_ ? b_ : a_; }
  { const float a_ = K[2], b_ = K[6]; const bool g_ = a_ > b_; K[2] = g_ ? a_ : b_; K[6] = g_ ? b_ : a_; }
  { const float a_ = K[3], b_ = K[7]; const bool g_ = a_ > b_; K[3] = g_ ? a_ : b_; K[7] = g_ ? b_ : a_; }
  { const float a_ = K[8], b_ = K[12]; const bool g_ = a_ > b_; K[8] = g_ ? a_ : b_; K[12] = g_ ? b_ : a_; }
  { const float a_ = K[9], b_ = K[13]; const bool g_ = a_ > b_; K[9] = g_ ? a_ : b_; K[13] = g_ ? b_ : a_; }
  { const float a_ = K[10], b_ = K[14]; const bool g_ = a_ > b_; K[10] = g_ ? a_ : b_; K[14] = g_ ? b_ : a_; }
  { const float a_ = K[11], b_ = K[15]; const bool g_ = a_ > b_; K[11] = g_ ? a_ : b_; K[15] = g_ ? b_ : a_; }
  { const float a_ = K[0], b_ = K[2]; const bool g_ = a_ > b_; K[0] = g_ ? a_ : b_; K[2] = g_ ? b_ : a_; }
  { const float a_ = K[1], b_ = K[3]; const bool g_ = a_ > b_; K[1] = g_ ? a_ : b_; K[3] = g_ ? b_ : a_; }
  { const float a_ = K[4], b_ = K[6]; const bool g_ = a_ > b_; K[4] = g_ ? a_ : b_; K[6] = g_ ? b_ : a_; }
  { const float a_ = K[5], b_ = K[7]; const bool g_ = a_ > b_; K[5] = g_ ? a_ : b_; K[7] = g_ ? b_ : a_; }
  { const float a_ = K[8], b_ = K[10]; const bool g_ = a_ > b_; K[8] = g_ ? a_ : b_; K[10] = g_ ? b_ : a_; }
  { const float a_ = K[9], b_ = K[11]; const bool g_ = a_ > b_; K[9] = g_ ? a_ : b_; K[11] = g_ ? b_ : a_; }
  { const float a_ = K[12], b_ = K[14]; const bool g_ = a_ > b_; K[12] = g_ ? a_ : b_; K[14] = g_ ? b_ : a_; }
  { const float a_ = K[13], b_ = K[15]; const bool g_ = a_ > b_; K[13] = g_ ? a_ : b_; K[15] = g_ ? b_ : a_; }
  { const float a_ = K[0], b_ = K[1]; const bool g_ = a_ > b_; K[0] = g_ ? a_ : b_; K[1] = g_ ? b_ : a_; }
  { const float a_ = K[2], b_ = K[3]; const bool g_ = a_ > b_; K[2] = g_ ? a_ : b_; K[3] = g_ ? b_ : a_; }
  { const float a_ = K[4], b_ = K[5]; const bool g_ = a_ > b_; K[4] = g_ ? a_ : b_; K[5] = g_ ? b_ : a_; }
  { const float a_ = K[6], b_ = K[7]; const bool g_ = a_ > b_; K[6] = g_ ? a_ : b_; K[7] = g_ ? b_ : a_; }
  { const float a_ = K[8], b_ = K[9]; const bool g_ = a_ > b_; K[8] = g_ ? a_ : b_; K[9] = g_ ? b_ : a_; }
  { const float a_ = K[10], b_ = K[11]; const bool g_ = a_ > b_; K[10] = g_ ? a_ : b_; K[11] = g_ ? b_ : a_; }
  { const float a_ = K[12], b_ = K[13]; const bool g_ = a_ > b_; K[12] = g_ ? a_ : b_; K[13] = g_ ? b_ : a_; }
  { const float a_ = K[14], b_ = K[15]; const bool g_ = a_ > b_; K[14] = g_ ? a_ : b_; K[15] = g_ ? b_ : a_; }
}
__device__ __forceinline__ void merge_top16(float (&T)[16], const float (&P)[16]) {
  { const float a_ = T[0], b_ = P[15]; T[0] = a_ > b_ ? a_ : b_; }
  { const float a_ = T[1], b_ = P[14]; T[1] = a_ > b_ ? a_ : b_; }
  { const float a_ = T[2], b_ = P[13]; T[2] = a_ > b_ ? a_ : b_; }
  { const float a_ = T[3], b_ = P[12]; T[3] = a_ > b_ ? a_ : b_; }
  { const float a_ = T[4], b_ = P[11]; T[4] = a_ > b_ ? a_ : b_; }
  { const float a_ = T[5], b_ = P[10]; T[5] = a_ > b_ ? a_ : b_; }
  { const float a_ = T[6], b_ = P[9]; T[6] = a_ > b_ ? a_ : b_; }
  { const float a_ = T[7], b_ = P[8]; T[7] = a_ > b_ ? a_ : b_; }
  { const float a_ = T[8], b_ = P[7]; T[8] = a_ > b_ ? a_ : b_; }
  { const float a_ = T[9], b_ = P[6]; T[9] = a_ > b_ ? a_ : b_; }
  { const float a_ = T[10], b_ = P[5]; T[10] = a_ > b_ ? a_ : b_; }
  { const float a_ = T[11], b_ = P[4]; T[11] = a_ > b_ ? a_ : b_; }
  { const float a_ = T[12], b_ = P[3]; T[12] = a_ > b_ ? a_ : b_; }
  { const float a_ = T[13], b_ = P[2]; T[13] = a_ > b_ ? a_ : b_; }
  { const float a_ = T[14], b_ = P[1]; T[14] = a_ > b_ ? a_ : b_; }
  { const float a_ = T[15], b_ = P[0]; T[15] = a_ > b_ ? a_ : b_; }
  { const float a_ = T[0], b_ = T[8]; const bool g_ = a_ > b_; T[0] = g_ ? a_ : b_; T[8] = g_ ? b_ : a_; }
  { const float a_ = T[1], b_ = T[9]; const bool g_ = a_ > b_; T[1] = g_ ? a_ : b_; T[9] = g_ ? b_ : a_; }
  { const float a_ = T[2], b_ = T[10]; const bool g_ = a_ > b_; T[2] = g_ ? a_ : b_; T[10] = g_ ? b_ : a_; }
  { const float a_ = T[3], b_ = T[11]; const bool g_ = a_ > b_; T[3] = g_ ? a_ : b_; T[11] = g_ ? b_ : a_; }
  { const float a_ = T[4], b_ = T[12]; const bool g_ = a_ > b_; T[4] = g_ ? a_ : b_; T[12] = g_ ? b_ : a_; }
  { const float a_ = T[5], b_ = T[13]; const bool g_ = a_ > b_; T[5] = g_ ? a_ : b_; T[13] = g_ ? b_ : a_; }
  { const float a_ = T[6], b_ = T[14]; const bool g_ = a_ > b_; T[6] = g_ ? a_ : b_; T[14] = g_ ? b_ : a_; }
  { const float a_ = T[7], b_ = T[15]; const bool g_ = a_ > b_; T[7] = g_ ? a_ : b_; T[15] = g_ ? b_ : a_; }
  { const float a_ = T[0], b_ = T[4]; const bool g_ = a_ > b_; T[0] = g_ ? a_ : b_; T[4] = g_ ? b_ : a_; }
  { const float a_ = T[1], b_ = T[5]; const bool g_ = a_ > b_; T[1] = g_ ? a_ : b_; T[5] = g_ ? b_ : a_; }
  { const float a_ = T[2], b_ = T[6]; const bool g_ = a_ > b_; T[2] = g_ ? a_ : b_; T[6] = g_ ? b_ : a_; }
  { const float a_ = T[3], b_ = T[7]; const bool g_ = a_ > b_; T[3] = g_ ? a_ : b_; T[7] = g_ ? b_ : a_; }
  { const float a_ = T[8], b_ = T[12]; const bool g_ = a_ > b_; T[8] = g_ ? a_ : b_; T[12] = g_ ? b_ : a_; }
  { const float a_ = T[9], b_ = T[13]; const bool g_ = a_ > b_; T[9] = g_ ? a_ : b_; T[13] = g_ ? b_ : a_; }
  { const float a_ = T[10], b_ = T[14]; const bool g_ = a_ > b_; T[10] = g_ ? a_ : b_; T[14] = g_ ? b_ : a_; }
  { const float a_ = T[11], b_ = T[15]; const bool g_ = a_ > b_; T[11] = g_ ? a_ : b_; T[15] = g_ ? b_ : a_; }
  { const float a_ = T[0], b_ = T[2]; const bool g_ = a_ > b_; T[0] = g_ ? a_ : b_; T[2] = g_ ? b_ : a_; }
  { const float a_ = T[1], b_ = T[3]; const bool g_ = a_ > b_; T[1] = g_ ? a_ : b_; T[3] = g_ ? b_ : a_; }
  { const float a_ = T[4], b_ = T[6]; const bool g_ = a_ > b_; T[4] = g_ ? a_ : b_; T[6] = g_ ? b_ : a_; }
  { const float a_ = T[5], b_ = T[7]; const bool g_ = a_ > b_; T[5] = g_ ? a_ : b_; T[7] = g_ ? b_ : a_; }
  { const float a_ = T[8], b_ = T[10]; const bool g_ = a_ > b_; T[8] = g_ ? a_ : b_; T[10] = g_ ? b_ : a_; }
  { const float a_ = T[9], b_ = T[11]; const bool g_ = a_ > b_; T[9] = g_ ? a_ : b_; T[11] = g_ ? b_ : a_; }
  { const float a_ = T[12], b_ = T[14]; const bool g_ = a_ > b_; T[12] = g_ ? a_ : b_; T[14] = g_ ? b_ : a_; }
  { const float a_ = T[13], b_ = T[15]; const bool g_ = a_ > b_; T[13] = g_ ? a_ : b_; T[15] = g_ ? b_ : a_; }
  { const float a_ = T[0], b_ = T[1]; const bool g_ = a_ > b_; T[0] = g_ ? a_ : b_; T[1] = g_ ? b_ : a_; }
  { const float a_ = T[2], b_ = T[3]; const bool g_ = a_ > b_; T[2] = g_ ? a_ : b_; T[3] = g_ ? b_ : a_; }
  { const float a_ = T[4], b_ = T[5]; const bool g_ = a_ > b_; T[4] = g_ ? a_ : b_; T[5] = g_ ? b_ : a_; }
  { const float a_ = T[6], b_ = T[7]; const bool g_ = a_ > b_; T[6] = g_ ? a_ : b_; T[7] = g_ ? b_ : a_; }
  { const float a_ = T[8], b_ = T[9]; const bool g_ = a_ > b_; T[8] = g_ ? a_ : b_; T[9] = g_ ? b_ : a_; }
  { const float a_ = T[10], b_ = T[11]; const bool g_ = a_ > b_; T[10] = g_ ? a_ : b_; T[11] = g_ ? b_ : a_; }
  { const float a_ = T[12], b_ = T[13]; const bool g_ = a_ > b_; T[12] = g_ ? a_ : b_; T[13] = g_ ? b_ : a_; }
  { const float a_ = T[14], b_ = T[15]; const bool g_ = a_ > b_; T[14] = g_ ? a_ : b_; T[15] = g_ ? b_ : a_; }
}

__device__ __forceinline__ void peer_topk(const int wave_s, const bf16* pq, const bf16* skb, int* ids, float* gates, LAS float* smem) {
  const int tid_ = opaque_tid(wave_s);
  const int lane = tid_ & 63, n = lane & 31, hh = lane >> 5, wave = tid_ >> 6;
  const int gw = blockIdx.x * NWAVES + wave;
  const int nw = gridDim.x * NWAVES;
  LAS float* lk = smem + wave * 2048;
  for (int it = gw; it < 512 * 8; it += nw) {
    const int h = it & 7, tok0 = (it >> 3) * 32;
#pragma unroll 1
    for (int half = 0; half < 2; half++) {
      bf16x8_t qf[8];
      {
        const bf16* qrow = pq + (size_t)(tok0 + n) * 2048 + h * 256 + half * 128 + 8 * hh;
#pragma unroll
        for (int ks = 0; ks < 8; ks++) qf[ks] = *(const bf16x8_t*)(qrow + 16 * ks);
      }
      float K[64];
#pragma unroll
      for (int kt = 0; kt < 4; kt++) {
        const bf16* krow = skb + ((size_t)((h * 2 + half) * 128 + kt * 32 + n)) * 128 + 8 * hh;
        f32x16_t acc;
#pragma unroll
        for (int r = 0; r < 16; r++) acc[r] = 0.f;
#pragma unroll
        for (int kq = 0; kq < 2; kq++) {
          bf16x8_t kf[4];
#pragma unroll
          for (int i = 0; i < 4; i++) kf[i] = *(const bf16x8_t*)(krow + 16 * (kq * 4 + i));
          MFMA_PAD();
#pragma unroll
          for (int i = 0; i < 4; i++) acc = __builtin_amdgcn_mfma_f32_32x32x16_bf16(kf[i], qf[kq * 4 + i], acc, 0, 0, 0);
          MFMA_PAD();
        }
#pragma unroll
        for (int i = 0; i < 16; i++) K[kt * 16 + i] = pack_key<0x7Fu>(acc[i], (unsigned)(kt * 32 + (i & 3) + 8 * (i >> 2) + 4 * hh));
      }
      __builtin_amdgcn_sched_barrier(0);
      top16_of_64(K);
      __builtin_amdgcn_sched_barrier(0);
      float T[16], P[16];
#pragma unroll
      for (int i = 0; i < 16; i++) { T[i] = K[i]; P[i] = __shfl_xor(K[i], 32, 64); }
      merge_top16(T, P);
#pragma unroll
      for (int i = 0; i < 16; i++) lk[(half * 16 + i) * 64 + lane] = T[i];
      __builtin_amdgcn_sched_barrier(0);
    }
    float f0[16], f1[16];
    int ti0[16], ti1[16];
#pragma unroll
    for (int i = 0; i < 16; i++) {
      const float k0 = lk[i * 64 + lane], k1 = lk[(16 + i) * 64 + lane];
      f0[i] = key_val<0x7Fu>(k0); ti0[i] = (int)key_idx<0x7Fu>(k0);
      f1[i] = key_val<0x7Fu>(k1); ti1[i] = (int)key_idx<0x7Fu>(k1);
    }
    float K[64];
    {
    K[0] = pack_key<0xFFu>(f0[0] + f1[0], 0u);
    K[1] = pack_key<0xFFu>(f0[0] + f1[1], 1u);
    K[2] = pack_key<0xFFu>(f0[0] + f1[2], 2u);
    K[3] = pack_key<0xFFu>(f0[0] + f1[3], 3u);
    K[4] = pack_key<0xFFu>(f0[0] + f1[4], 4u);
    K[5] = pack_key<0xFFu>(f0[0] + f1[5], 5u);
    K[6] = pack_key<0xFFu>(f0[0] + f1[6], 6u);
    K[7] = pack_key<0xFFu>(f0[0] + f1[7], 7u);
    K[8] = pack_key<0xFFu>(f0[0] + f1[8], 8u);
    K[9] = pack_key<0xFFu>(f0[0] + f1[9], 9u);
    K[10] = pack_key<0xFFu>(f0[0] + f1[10], 10u);
    K[11] = pack_key<0xFFu>(f0[0] + f1[11], 11u);
    K[12] = pack_key<0xFFu>(f0[0] + f1[12], 12u);
    K[13] = pack_key<0xFFu>(f0[0] + f1[13], 13u);
    K[14] = pack_key<0xFFu>(f0[0] + f1[14], 14u);
    K[15] = pack_key<0xFFu>(f0[0] + f1[15], 15u);
    K[16] = pack_key<0xFFu>(f0[1] + f1[0], 16u);
    K[17] = pack_key<0xFFu>(f0[1] + f1[1], 17u);
    K[18] = pack_key<0xFFu>(f0[1] + f1[2], 18u);
    K[19] = pack_key<0xFFu>(f0[1] + f1[3], 19u);
    K[20] = pack_key<0xFFu>(f0[1] + f1[4], 20u);
    K[21] = pack_key<0xFFu>(f0[1] + f1[5], 21u);
    K[22] = pack_key<0xFFu>(f0[1] + f1[6], 22u);
    K[23] = pack_key<0xFFu>(f0[1] + f1[7], 23u);
    K[24] = pack_key<0xFFu>(f0[2] + f1[0], 32u);
    K[25] = pack_key<0xFFu>(f0[2] + f1[1], 33u);
    K[26] = pack_key<0xFFu>(f0[2] + f1[2], 34u);
    K[27] = pack_key<0xFFu>(f0[2] + f1[3], 35u);
    K[28] = pack_key<0xFFu>(f0[2] + f1[4], 36u);
    K[29] = pack_key<0xFFu>(f0[3] + f1[0], 48u);
    K[30] = pack_key<0xFFu>(f0[3] + f1[1], 49u);
    K[31] = pack_key<0xFFu>(f0[3] + f1[2], 50u);
    K[32] = pack_key<0xFFu>(f0[3] + f1[3], 51u);
    K[33] = pack_key<0xFFu>(f0[4] + f1[0], 64u);
    K[34] = pack_key<0xFFu>(f0[4] + f1[1], 65u);
    K[35] = pack_key<0xFFu>(f0[4] + f1[2], 66u);
    K[36] = pack_key<0xFFu>(f0[5] + f1[0], 80u);
    K[37] = pack_key<0xFFu>(f0[5] + f1[1], 81u);
    K[38] = pack_key<0xFFu>(f0[6] + f1[0], 96u);
    K[39] = pack_key<0xFFu>(f0[6] + f1[1], 97u);
    K[40] = pack_key<0xFFu>(f0[7] + f1[0], 112u);
    K[41] = pack_key<0xFFu>(f0[7] + f1[1], 113u);
    K[42] = pack_key<0xFFu>(f0[8] + f1[0], 128u);
    K[43] = pack_key<0xFFu>(f0[9] + f1[0], 144u);
    K[44] = pack_key<0xFFu>(f0[10] + f1[0], 160u);
    K[45] = pack_key<0xFFu>(f0[11] + f1[0], 176u);
    K[46] = pack_key<0xFFu>(f0[12] + f1[0], 192u);
    K[47] = pack_key<0xFFu>(f0[13] + f1[0], 208u);
    K[48] = pack_key<0xFFu>(f0[14] + f1[0], 224u);
    K[49] = pack_key<0xFFu>(f0[15] + f1[0], 240u);
    K[50] = -3.0e38f;
    K[51] = -3.0e38f;
    K[52] = -3.0e38f;
    K[53] = -3.0e38f;
    K[54] = -3.0e38f;
    K[55] = -3.0e38f;
    K[56] = -3.0e38f;
    K[57] = -3.0e38f;
    K[58] = -3.0e38f;
    K[59] = -3.0e38f;
    K[60] = -3.0e38f;
    K[61] = -3.0e38f;
    K[62] = -3.0e38f;
    K[63] = -3.0e38f;
    }
    __builtin_amdgcn_sched_barrier(0);
    top16_of_64(K);
    __builtin_amdgcn_sched_barrier(0);
    float bv[16];
    int be[16];
#pragma unroll
    for (int r = 0; r < 16; r++) {
      const int flat = (int)key_idx<0xFFu>(K[r]);
      const int a = flat >> 4, b = flat & 15;
      int i0 = 0, i1 = 0;
#pragma unroll
      for (int i = 0; i < 16; i++) { i0 = (a == i) ? ti0[i] : i0; i1 = (b == i) ? ti1[i] : i1; }
      be[r] = i0 * 128 + i1;
      bv[r] = key_val<0xFFu>(K[r]);
    }
    const float b0 = bv[0];
    float ge[16];
    float gsum = 0.f;
#pragma unroll
    for (int r = 0; r < 16; r++) { ge[r] = __expf(bv[r] - b0); gsum += ge[r]; }
    const float ginv = 1.0f / gsum;
    if (hh == 0) {
      int* ip = ids + (size_t)(tok0 + n) * 128 + h * 16;
      float* gp = gates + (size_t)(tok0 + n) * 128 + h * 16;
#pragma unroll
      for (int r4 = 0; r4 < 4; r4++) {
        *(int4*)(ip + 4 * r4) = make_int4(be[4 * r4], be[4 * r4 + 1], be[4 * r4 + 2], be[4 * r4 + 3]);
        *(float4*)(gp + 4 * r4) = make_float4(ge[4 * r4] * ginv, ge[4 * r4 + 1] * ginv, ge[4 * r4 + 2] * ginv, ge[4 * r4 + 3] * ginv);
      }
    }
  }
}

typedef _Float16 f16x2_t __attribute__((ext_vector_type(2)));
__device__ __forceinline__ unsigned e4m3x2_to_f16x2(unsigned w, unsigned sel) {
  return __builtin_amdgcn_perm(w, w, sel);
}
__device__ __forceinline__ float dot2h(unsigned a, unsigned b, float c) {
  return __builtin_amdgcn_fdot2(__builtin_bit_cast(f16x2_t, a), __builtin_bit_cast(f16x2_t, b), c, false);
}
__device__ __forceinline__ unsigned pack_h2(float lo, float hi) {
  f16x2_t v; v.x = (_Float16)lo; v.y = (_Float16)hi;
  return __builtin_bit_cast(unsigned, v);
}
template <bool FINAL>
__device__ __forceinline__ void peer_gather(const int wave_s, bf16* xn, const float* rst, const unsigned char* ub, const unsigned char* vb, const float* vsc,
                                            const int* ids, const float* gates, float* xw, const float* gnext, float* outp) {
  const int tid_ = opaque_tid(wave_s);
  const int lane = tid_ & 63;
  const int gw = blockIdx.x * NWAVES + (tid_ >> 6);
  const int nw = gridDim.x * NWAVES;
  const int el = ((lane >> 5) & 1) * 4 + ((lane >> 4) & 1) * 2 + ((lane >> 3) & 1);
  for (int tok = gw; tok < NT; tok += nw) {
    unsigned xh[8];
    {
      const uint4 a = *(const uint4*)(xn + (size_t)tok * DM + lane * 16);
      const uint4 b = *(const uint4*)(xn + (size_t)tok * DM + lane * 16 + 8);
      const unsigned xw_[8] = {a.x, a.y, a.z, a.w, b.x, b.y, b.z, b.w};
      const float4* sp = (const float4*)(rst + (size_t)tok * 16);
      const float4 s0 = sp[0], s1 = sp[1], s2 = sp[2], s3 = sp[3];
      const float xs = rsqrtf((((s0.x + s0.y) + (s0.z + s0.w)) + ((s1.x + s1.y) + (s1.z + s1.w)) + ((s2.x + s2.y) + (s2.z + s2.w)) + ((s3.x + s3.y) + (s3.z + s3.w))) * (1.0f / 1024.f) + EPSF);
#pragma unroll
      for (int k = 0; k < 8; k++) xh[k] = pack_h2(bf_lo(xw_[k]) * xs, bf_hi(xw_[k]) * xs);
    }
    float acc[16];
#pragma unroll
    for (int i = 0; i < 16; i++) acc[i] = 0.f;
#pragma unroll 1
    for (int g = 0; g < 16; g++) {
      const int idv = ids[(size_t)tok * 128 + g * 8 + (lane & 7)];
      const float gv = gates[(size_t)tok * 128 + g * 8 + el] * vsc[__builtin_amdgcn_ds_bpermute(el << 2, idv)];
      uint4 uu[8];
      uint2 vv[8];
#pragma unroll
      for (int e = 0; e < 8; e++) {
        const int id = __builtin_amdgcn_readlane(idv, e);
        uu[e] = *(const uint4*)(ub + (size_t)id * DM + lane * 16);
        vv[e] = *(const uint2*)(vb + (size_t)id * 512 + lane * 8);
      }
      float d[8];
#pragma unroll
      for (int e = 0; e < 8; e++) {
        const unsigned uw[4] = {uu[e].x, uu[e].y, uu[e].z, uu[e].w};
        float s = 0.f;
#pragma unroll
        for (int k = 0; k < 4; k++) {
          s = dot2h(e4m3x2_to_f16x2(uw[k], 0x010c000cu), xh[2 * k], s);
          s = dot2h(e4m3x2_to_f16x2(uw[k], 0x030c020cu), xh[2 * k + 1], s);
        }
        d[e] = s;
      }
      float d4[4], d2[2], d1;
      {
        const bool hi = (lane & 32) != 0;
#pragma unroll
        for (int i = 0; i < 4; i++) { const float send = hi ? d[i] : d[i + 4]; const float keep = hi ? d[i + 4] : d[i]; d4[i] = keep + __shfl_xor(send, 32, 64); }
      }
      {
        const bool hi = (lane & 16) != 0;
#pragma unroll
        for (int i = 0; i < 2; i++) { const float send = hi ? d4[i] : d4[i + 2]; const float keep = hi ? d4[i + 2] : d4[i]; d2[i] = keep + __shfl_xor(send, 16, 64); }
      }
      {
        const bool hi = (lane & 8) != 0;
        const float send = hi ? d2[0] : d2[1];
        const float keep = hi ? d2[1] : d2[0];
        d1 = keep + __shfl_xor(send, 8, 64);
      }
      d1 += __shfl_xor(d1, 4, 64);
      d1 += __shfl_xor(d1, 2, 64);
      d1 += __shfl_xor(d1, 1, 64);
      const float wl = gv * gelu_tanh(d1 * (1.0f / U_SCALE));
#pragma unroll
      for (int e = 0; e < 8; e++) {
        const float w = __builtin_bit_cast(float, __builtin_amdgcn_readlane(__builtin_bit_cast(int, wl), ((e >> 2) & 1) * 32 + ((e >> 1) & 1) * 16 + (e & 1) * 8));
        const unsigned wlo = pack_h2(w, 0.f), whi = pack_h2(0.f, w);
        const unsigned vw[2] = {vv[e].x, vv[e].y};
#pragma unroll
        for (int k = 0; k < 2; k++) {
          const unsigned w4 = vw[k];
          const unsigned le = __builtin_amdgcn_perm(V4_LUT_HI, V4_LUT_LO, w4 & 0x07070707u);
          const unsigned lo = __builtin_amdgcn_perm(V4_LUT_HI, V4_LUT_LO, (w4 >> 4) & 0x07070707u);
          const unsigned ee = ((w4 << 4) & 0x80808080u) | le;
          const unsigned eo = (w4 & 0x80808080u) | lo;
          const unsigned p01 = __builtin_amdgcn_perm(eo, ee, 0x040c000cu), p23 = __builtin_amdgcn_perm(eo, ee, 0x050c010cu);
          const unsigned p45 = __builtin_amdgcn_perm(eo, ee, 0x060c020cu), p67 = __builtin_amdgcn_perm(eo, ee, 0x070c030cu);
          acc[8 * k + 0] = dot2h(p01, wlo, acc[8 * k + 0]);
          acc[8 * k + 1] = dot2h(p01, whi, acc[8 * k + 1]);
          acc[8 * k + 2] = dot2h(p23, wlo, acc[8 * k + 2]);
          acc[8 * k + 3] = dot2h(p23, whi, acc[8 * k + 3]);
          acc[8 * k + 4] = dot2h(p45, wlo, acc[8 * k + 4]);
          acc[8 * k + 5] = dot2h(p45, whi, acc[8 * k + 5]);
          acc[8 * k + 6] = dot2h(p67, wlo, acc[8 * k + 6]);
          acc[8 * k + 7] = dot2h(p67, whi, acc[8 * k + 7]);
        }
      }
    }
    float* xr = xw + (size_t)tok * DM + lane * 16;
    float xv[16];
    float ssq = 0.f;
#pragma unroll
    for (int c = 0; c < 4; c++) {
      float4 a0 = *(float4*)(xr + c * 4);
      a0.x += acc[c * 4 + 0]; a0.y += acc[c * 4 + 1]; a0.z += acc[c * 4 + 2]; a0.w += acc[c * 4 + 3];
      if (!FINAL) *(float4*)(xr + c * 4) = a0;
      xv[c * 4 + 0] = a0.x; xv[c * 4 + 1] = a0.y; xv[c * 4 + 2] = a0.z; xv[c * 4 + 3] = a0.w;
      ssq += a0.x * a0.x + a0.y * a0.y + a0.z * a0.z + a0.w * a0.w;
    }
    ssq = wsum(ssq);
    const float rstd = rsqrtf(ssq * (1.0f / DM) + EPSF);
    const float4* g4 = (const float4*)(gnext + lane * 16);
    if (FINAL) {
      float* op = outp + (size_t)tok * DM + lane * 16;
#pragma unroll
      for (int c = 0; c < 4; c++) {
        const float4 gq = g4[c];
        *(float4*)(op + c * 4) = make_float4(xv[c * 4] * rstd * gq.x, xv[c * 4 + 1] * rstd * gq.y, xv[c * 4 + 2] * rstd * gq.z, xv[c * 4 + 3] * rstd * gq.w);
      }
    } else {
      uint4 o0, o1;
      { const float4 ga = g4[0], gb = g4[1];
        o0.x = pk2(xv[0] * rstd * ga.x, xv[1] * rstd * ga.y); o0.y = pk2(xv[2] * rstd * ga.z, xv[3] * rstd * ga.w);
        o0.z = pk2(xv[4] * rstd * gb.x, xv[5] * rstd * gb.y); o0.w = pk2(xv[6] * rstd * gb.z, xv[7] * rstd * gb.w); }
      { const float4 ga = g4[2], gb = g4[3];
        o1.x = pk2(xv[8] * rstd * ga.x, xv[9] * rstd * ga.y); o1.y = pk2(xv[10] * rstd * ga.z, xv[11] * rstd * ga.w);
        o1.z = pk2(xv[12] * rstd * gb.x, xv[13] * rstd * gb.y); o1.w = pk2(xv[14] * rstd * gb.z, xv[15] * rstd * gb.w); }
      *(uint4*)(xn + (size_t)tok * DM + lane * 16) = o0;
      *(uint4*)(xn + (size_t)tok * DM + lane * 16 + 8) = o1;
    }
  }
}

__device__ __forceinline__ void prologue_transposes(const int wave_s, const Params& p, unsigned char* ws, LAS unsigned char* lds) {
  const int tid_ = opaque_tid(wave_s);
  const int lane = tid_ & 63, wave = tid_ >> 6;
  LAS float* scr = (LAS float*)(lds + wave * 16384);
  const int gw = blockIdx.x * NWAVES + wave, NGW = gridDim.x * NWAVES;
  constexpr int I_IN = (DM / 64) * (DIN / 32), I_SQ = (DM / 64) * (DM / 32), I_2K = (DM / 64) * (2048 / 32);
  constexpr int I_GL = (256 / 64) * (256 / 32);
  constexpr int PER_LAYER = I_IN + 3 * I_SQ + 2 * I_2K + I_GL;
  const float* w3 = karg_in(3); const float* w19 = karg_in(19); const float* w22 = karg_in(22);
  const float* w23 = karg_in(23); const float* w24 = karg_in(24); const float* w26 = karg_in(26);
  const float* w16 = karg_in(16);
  for (int it = gw; it < 2 * PER_LAYER; it += NGW) {
    const int l = it / PER_LAYER;
    int r = it % PER_LAYER;
    unsigned char* wl = ws + WS_WT + (size_t)l * WT_LAYER;
    if (r < I_IN) { transpose_item(w3 + (size_t)l * DM * DIN, DM, DIN, (bf16*)(wl + WT_IN), scr, r, lane); continue; } r -= I_IN;
    if (r < I_SQ) { transpose_item(w19 + (size_t)l * DM * DM, DM, DM, (bf16*)(wl + WT_OUT), scr, r, lane); continue; } r -= I_SQ;
    if (r < I_SQ) { transpose_item(w22 + (size_t)l * DM * DM, DM, DM, (bf16*)(wl + WT_MQ), scr, r, lane); continue; } r -= I_SQ;
    if (r < I_2K) { transpose_item(w23 + (size_t)l * DM * 2048, DM, 2048, (bf16*)(wl + WT_MKV), scr, r, lane); continue; } r -= I_2K;
    if (r < I_SQ) { transpose_item(w24 + (size_t)l * DM * DM, DM, DM, (bf16*)(wl + WT_MO), scr, r, lane); continue; } r -= I_SQ;
    if (r < I_2K) { transpose_item(w26 + (size_t)l * DM * 2048, DM, 2048, (bf16*)(wl + WT_PQ), scr, r, lane); continue; } r -= I_2K;
    transpose_item(w16 + (size_t)l * 256 * 256, 256, 256, (bf16*)(wl + WT_GLU), scr, r, lane);
  }
}

template <class T> __device__ __forceinline__ T* opq(T* p) { asm volatile("" : "+s"(p)); return p; }
__device__ __forceinline__ void cvt_rows_bf16(const int wave_s, const float* src, bf16* dst, size_t n) {
  const int tid_ = opaque_tid(wave_s);
  const size_t gt = (size_t)blockIdx.x * (NWAVES * 64) + tid_;
  const size_t nth = (size_t)gridDim.x * NWAVES * 64;
  for (size_t i = gt; i < n / 8; i += nth) {
    const float4 a = ((const float4*)src)[2 * i], b = ((const float4*)src)[2 * i + 1];
    uint4 o; o.x = pk2(a.x, a.y); o.y = pk2(a.z, a.w); o.z = pk2(b.x, b.y); o.w = pk2(b.z, b.w);
    ((uint4*)dst)[i] = o;
  }
}

__device__ __forceinline__ unsigned enc_e4m3(float x) {
  const _Float16 hf = (_Float16)x;
  const unsigned h = (unsigned)__builtin_bit_cast(unsigned short, hf);
  return ((h + 0x7Fu + ((h >> 8) & 1u)) >> 8) & 0xFFu;
}
__device__ __forceinline__ void cvt_rows_e4m3(const int wave_s, const float* src, unsigned char* dst, size_t n, float sc) {
  const int tid_ = opaque_tid(wave_s);
  const size_t gt = (size_t)blockIdx.x * (NWAVES * 64) + tid_;
  const size_t nth = (size_t)gridDim.x * NWAVES * 64;
  for (size_t i = gt; i < n / 16; i += nth) {
    unsigned w[4];
#pragma unroll
    for (int k = 0; k < 4; k++) {
      const float4 a = ((const float4*)src)[4 * i + k];
      w[k] = enc_e4m3(a.x * sc) | (enc_e4m3(a.y * sc) << 8) | (enc_e4m3(a.z * sc) << 16) | (enc_e4m3(a.w * sc) << 24);
    }
    uint4 o; o.x = w[0]; o.y = w[1]; o.z = w[2]; o.w = w[3];
    ((uint4*)dst)[i] = o;
  }
}

__device__ __forceinline__ unsigned enc_v4(float z) {
  const float az = fabsf(z);
  unsigned c = 0;
  c += az > 0.25f; c += az > 0.5f; c += az > 0.75f; c += az > 1.0625f; c += az > 1.375f; c += az > 1.75f; c += az > 2.25f;
  return c | ((__builtin_bit_cast(unsigned, z) >> 28) & 8u);
}
__device__ __forceinline__ void cvt_rows_v4(const int wave_s, const float* src, unsigned char* dst, float* sc_out, int nrows) {
  const int tid_ = opaque_tid(wave_s);
  const int lane = tid_ & 63;
  const int gw = blockIdx.x * NWAVES + (tid_ >> 6);
  const int nw = gridDim.x * NWAVES;
  for (int r = gw; r < nrows; r += nw) {
    const float4* sp = (const float4*)(src + (size_t)r * 1024 + lane * 16);
    const float4 a0 = sp[0], a1 = sp[1], a2 = sp[2], a3 = sp[3];
    const float xv[16] = {a0.x, a0.y, a0.z, a0.w, a1.x, a1.y, a1.z, a1.w, a2.x, a2.y, a2.z, a2.w, a3.x, a3.y, a3.z, a3.w};
    float ss = 0.f;
#pragma unroll
    for (int i = 0; i < 16; i++) ss += xv[i] * xv[i];
    ss = wsum(ss);
    const float sc = sqrtf(ss * (1.0f / 1024.f)) * V4_ROWSCALE;
    const float inv = sc > 0.f ? 1.0f / sc : 0.f;
    unsigned w[2] = {0u, 0u};
#pragma unroll
    for (int i = 0; i < 16; i++) w[i >> 3] |= enc_v4(xv[i] * inv) << (4 * (i & 7));
    uint2 o; o.x = w[0]; o.y = w[1];
    *(uint2*)(dst + (size_t)r * 512 + lane * 8) = o;
    if (lane == 0) sc_out[r] = sc;
  }
}

#define GEMM_F32(Aptr, Wt, Cptr, Rptr, M_, N_) do { \
    pg8::Gemm g_{opq((const bf16*)(Aptr)), opq((const bf16*)(Wt)), (M_), (N_), DM}; pg8::StaticOrder S_; S_.init((M_), (N_), (int)gridDim.x, (int)blockIdx.x); \
    pg8::EpiF32R E_{opq((float*)(Cptr)), opq((const float*)(Rptr)), (N_)}; \
    pg8::gemm_phase<pg8::EpiF32R, pg8::StaticOrder, true, true>(wave_s, ldsl, g_, S_, E_); } while (0)
#define GEMM_BF16_C(Aptr, Wt, Optr, M_, N_, C_) do { \
    pg8::Gemm g_{opq((const bf16*)(Aptr)), opq((const bf16*)(Wt)), (M_), (N_), DM}; pg8::StaticOrder S_; S_.init((M_), (N_), (int)gridDim.x, (C_)); \
    pg8::EpiBf16 E_{opq((bf16*)(Optr)), (N_)}; \
    pg8::gemm_phase<pg8::EpiBf16, pg8::StaticOrder, true, true>(wave_s, ldsl, g_, S_, E_); } while (0)
#define GEMM_BF16(Aptr, Wt, Optr, M_, N_) GEMM_BF16_C(Aptr, Wt, Optr, M_, N_, (int)blockIdx.x)
#define GEMM_F32RN(Aptr, Wt, Cptr, Rptr, XGptr, Gptr, STptr) do { \
    pg8::Gemm g_{opq((const bf16*)(Aptr)), opq((const bf16*)(Wt)), NT, DM, DM}; pg8::StaticOrder S_; S_.init(NT, DM, (int)gridDim.x, (int)blockIdx.x); \
    pg8::EpiF32RN E_{opq((float*)(Cptr)), opq((const float*)(Rptr)), DM, opq((bf16*)(XGptr)), opq((const float*)(Gptr)), opq((float*)(STptr))}; \
    pg8::gemm_phase<pg8::EpiF32RN, pg8::StaticOrder, true, true>(wave_s, ldsl, g_, S_, E_); } while (0)
#define GEMM_BF16S(Aptr, Wt, Optr, N_, STptr) do { \
    pg8::Gemm g_{opq((const bf16*)(Aptr)), opq((const bf16*)(Wt)), NT, (N_), DM}; pg8::StaticOrder S_; S_.init(NT, (N_), (int)gridDim.x, (int)blockIdx.x); \
    pg8::EpiBf16S E_{opq((bf16*)(Optr)), (N_), opq((const float*)(STptr))}; \
    pg8::gemm_phase<pg8::EpiBf16S, pg8::StaticOrder, true, true>(wave_s, ldsl, g_, S_, E_); } while (0)

__global__ void __launch_bounds__(NWAVES * 64, 2) fwd_megakernel(Params p) {
  extern __shared__ __attribute__((aligned(16))) unsigned char lds[];
  LAS unsigned char* ldsl = (LAS unsigned char*)lds;
  LAS float* smem = (LAS float*)ldsl;
  const int wave_s = __builtin_amdgcn_readfirstlane((int)(threadIdx.x >> 6));
  unsigned char* ws = p.ws;
  volatile LAS unsigned* MISC = (volatile LAS unsigned*)(ldsl + (LDS_BYTES - 256));
  if (threadIdx.x < 64) MISC[threadIdx.x] = 0u;
  __syncthreads();
  const XcdBarrier bar = xcd_barrier_post((unsigned*)(ws + WS_CTL) + 4096, MISC + 8);
  float* xw = (float*)(ws + WS_XW);
  bf16* xn = (bf16*)(ws + WS_XN);
  bf16* big = (bf16*)(ws + WS_BIG);
  bf16* y = (bf16*)(ws + WS_Y);
  bf16* memh = (bf16*)(ws + WS_MEMH);
  bf16* kvb = (bf16*)(ws + WS_KVB);
  bf16* vT = (bf16*)(ws + WS_VT);
  float* ssmE = (float*)(ws + WS_SSME);
  float* ssmp = (float*)(ws + WS_SSMP);
  int* ids = (int*)(ws + WS_IDS);
  float* gates = (float*)(ws + WS_GATE);
  bf16* skb = (bf16*)(ws + WS_SKB);
  unsigned char* ub = ws + WS_UB;
  unsigned char* vb = ws + WS_VB;
  float* rst = (float*)(ws + WS_RST);
  float* vsc = (float*)(ws + WS_VSC);

  prologue_transposes(wave_s, p, ws, ldsl);
  cvt_rows_bf16(wave_s, karg_in(27), skb, (size_t)2 * 8 * 2 * 128 * 128);
  cvt_rows_e4m3(wave_s, karg_in(28), ub, (size_t)2 * 16384 * 1024, U_SCALE);
  cvt_rows_v4(wave_s, karg_in(29), vb, vsc, 2 * 16384);
  for (int l = 0; l < 2; l++)
    rms_rows<true>(wave_s, karg_in(1), karg_in(21) + l * DM, memh + (size_t)l * 1024 * 1024, 1024);
  ssm_params(wave_s, p, ssmp);
  xcd_barrier(bar);
  for (int l = 0; l < 2; l++)
    GEMM_BF16_C(memh + (size_t)l * 1024 * 1024, ws + WS_WT + (size_t)l * WT_LAYER + WT_MKV,
              kvb + (size_t)l * 1024 * 2048, 1024, 2048, (int)((blockIdx.x + gridDim.x - 32u * (unsigned)l) % gridDim.x));

#pragma nounroll
  for (int l = 0; l < 2; l++) {
    const float* xcur = (l == 0) ? karg_in(0) : xw;
    const float* sp = ssmp + (size_t)l * SSMP_PER_LAYER;
    const unsigned char* wl = ws + WS_WT + (size_t)l * WT_LAYER;
    if (l == 0) {
      rms_rows<true>(wave_s, xcur, karg_in(2) + l * DM, xn, NT);
      xcd_barrier(bar);
    }
    GEMM_BF16(xn, wl + WT_IN, big, NT, DIN);
    xcd_barrier(bar);
    if (l == 0) vt_phase(wave_s, kvb, vT);
    ssm_chunk_end(wave_s, sp, big, ssmE);
    attn_phase(wave_s, p, l, big, y, smem);
    conv_phase(wave_s, p, l, big, y, smem);
    xcd_barrier(bar);
    ssm_finish(wave_s, p, l, sp, big, ssmE, y, smem);
    xcd_barrier(bar);
    GEMM_F32RN(y, wl + WT_OUT, xw, xcur, xn, karg_in(20) + l * DM, rst);
    xcd_barrier(bar);
    GEMM_BF16S(xn, wl + WT_MQ, big, DM, rst);
    xcd_barrier(bar);
    memattn_phase(wave_s, big, kvb + (size_t)l * 1024 * 2048, vT + (size_t)l * 4 * 4 * 256 * 256, y, smem);
    xcd_barrier(bar);
    GEMM_F32RN(y, wl + WT_MO, xw, (const float*)xw, xn, karg_in(25) + l * DM, rst);
    xcd_barrier(bar);
    GEMM_BF16S(xn, wl + WT_PQ, big, 2048, rst);
    xcd_barrier(bar);
    peer_topk(wave_s, big, skb + (size_t)l * 8 * 2 * 128 * 128, ids, gates, smem);
    xcd_barrier(bar);
    if (l == 0) {
      peer_gather<false>(wave_s, xn, rst, ub + (size_t)l * 16384 * DM, vb + (size_t)l * 16384 * 512, vsc + (size_t)l * 16384, ids, gates, xw, karg_in(2) + DM, (float*)nullptr);
      xcd_barrier(bar);
    } else {
      peer_gather<true>(wave_s, xn, rst, ub + (size_t)l * 16384 * DM, vb + (size_t)l * 16384 * 512, vsc + (size_t)l * 16384, ids, gates, xw, karg_in(30), p.out);
    }
  }
}

extern "C" void kernel_launch(void* const* d_in, const int* in_sizes, int n_in,
                              void* d_out, int out_size, void* d_ws, size_t ws_size,
                              hipStream_t stream) {
  static int grid_blocks = 0;
  if (!grid_blocks) {
    int dev = 0, cus = 0, per_cu = 0;
    (void)hipGetDevice(&dev);
    (void)hipDeviceGetAttribute(&cus, hipDeviceAttributeMultiprocessorCount, dev);
    (void)hipFuncSetAttribute((const void*)fwd_megakernel, hipFuncAttributeMaxDynamicSharedMemorySize, LDS_BYTES);
    (void)hipOccupancyMaxActiveBlocksPerMultiprocessor(&per_cu, fwd_megakernel, NWAVES * 64, LDS_BYTES);
    if (per_cu < 1) fprintf(stderr, "occupancy query reports %d blocks/CU\n", per_cu);
    grid_blocks = cus;
  }
  (void)hipMemsetAsync((char*)d_ws + WS_CTL, 0, 1 * MiB, stream);
  Params p{};
  for (int i = 0; i < 31; i++) p.in[i] = (const float*)d_in[i];
  p.out = (float*)d_out;
  p.ws = (unsigned char*)d_ws;
  void* args[] = {&p};
  hipError_t e = hipLaunchCooperativeKernel((void*)fwd_megakernel, dim3(grid_blocks), dim3(NWAVES * 64),
                                            args, LDS_BYTES, stream);
  if (e != hipSuccess)
    fprintf(stderr, "cooperative launch failed: %s (grid %d)\n", hipGetErrorString(e), grid_blocks);
}
```

```cpp
#include <hip/hip_runtime.h>
#include <hip/hip_cooperative_groups.h>
#include <cstdio>
namespace cg = cooperative_groups;

#define NT 16384
#define SEQ 4096
#define DM 1024
#define DIN 2304
#define NMEM 256
#define EPSF 1e-6f
#define NWAVES 8
#define LDS_BYTES 147456

typedef unsigned short bf16;
#define LAS __attribute__((address_space(3)))

struct Params {
  const float* in[31];
  float* out;
  unsigned char* ws;
};
typedef __attribute__((address_space(4))) const unsigned char* kaptr_t;
__device__ __forceinline__ const float* karg_in(int i) {
  kaptr_t ka = (kaptr_t)__builtin_amdgcn_kernarg_segment_ptr();
  asm volatile("" : "+s"(ka));
  return *(const float* __attribute__((address_space(4))) const*)(ka + 8 * i);
}

constexpr size_t MiB = 1u << 20;
constexpr size_t WS_CTL  = 0;
constexpr size_t WS_WT   = 1 * MiB;
constexpr size_t WT_IN = 0, WT_OUT = WT_IN + (size_t)DIN * DM * 2, WT_MQ = WT_OUT + (size_t)DM * DM * 2,
                 WT_MKV = WT_MQ + (size_t)DM * DM * 2, WT_MO = WT_MKV + (size_t)2048 * DM * 2,
                 WT_PQ = WT_MO + (size_t)DM * DM * 2, WT_GLU = WT_PQ + (size_t)2048 * DM * 2, WT_LAYER = WT_GLU + (size_t)256 * 256 * 2;
constexpr size_t WS_XW   = WS_WT + 2 * WT_LAYER;
constexpr size_t WS_XN   = WS_XW + (size_t)NT * DM * 4;
constexpr size_t WS_BIG  = WS_XN + (size_t)NT * DM * 2;
constexpr size_t WS_Y    = WS_BIG + (size_t)NT * DIN * 2;
constexpr size_t WS_MEMH = WS_Y + (size_t)NT * DM * 2;
constexpr size_t WS_KVB  = WS_MEMH + (size_t)2 * 1024 * 1024 * 2;
constexpr size_t WS_VT   = WS_KVB + (size_t)2 * 1024 * 2048 * 2;
constexpr size_t WS_SSME = WS_VT + (size_t)2 * 4 * 4 * 256 * 256 * 2;
#define SSMP_PER_LAYER (2048 + 2048 + 32768)
constexpr size_t WS_SSMP = WS_SSME + (size_t)4 * 64 * 16 * 64 * 2 * 4;
constexpr size_t WS_IDS  = WS_SSMP + (size_t)2 * SSMP_PER_LAYER * 4;
constexpr size_t WS_GATE = WS_IDS + (size_t)NT * 128 * 4;
constexpr size_t WS_SKB  = WS_GATE + (size_t)NT * 128 * 4;
constexpr size_t WS_UB   = WS_SKB + (size_t)2 * 8 * 2 * 128 * 128 * 2;
constexpr size_t WS_VB   = WS_UB + (size_t)2 * 16384 * 1024;
constexpr size_t WS_VSC  = WS_VB + (size_t)2 * 16384 * 512;
constexpr size_t WS_RST  = WS_VSC + (size_t)2 * 16384 * 4;
constexpr size_t WS_END  = WS_RST + (size_t)NT * 16 * 4;
#define U_SCALE 64.0f
#define V4_LUT_LO 0x3B393630u
#define V4_LUT_HI 0x41403E3Du
#define V4_ROWSCALE 1.075f
static_assert(WS_END <= 512 * MiB, "workspace");
static_assert(WT_LAYER % 256 == 0 && WS_SSMP % 16 == 0 && WS_IDS % 16 == 0 && WS_SKB % 256 == 0 && WS_VT % 256 == 0, "align");

__device__ __forceinline__ int opaque_tid(int wave_s) { int v = wave_s * 64 + (int)__builtin_amdgcn_mbcnt_hi(~0u, __builtin_amdgcn_mbcnt_lo(~0u, 0u)); asm volatile("" : "+v"(v)); return v; }
__device__ __forceinline__ unsigned f2bf(float f) { unsigned u = __builtin_bit_cast(unsigned, f); return (u + 0x7fffu + ((u >> 16) & 1u)) >> 16; }
__device__ __forceinline__ unsigned pk2(float lo, float hi) { return f2bf(lo) | (f2bf(hi) << 16); }
__device__ __forceinline__ float bf_lo(unsigned u) { return __builtin_bit_cast(float, u << 16); }
__device__ __forceinline__ float bf_hi(unsigned u) { return __builtin_bit_cast(float, u & 0xffff0000u); }
__device__ __forceinline__ float bf2f(bf16 h) { return __builtin_bit_cast(float, (unsigned)h << 16); }


#define XB_TMO      128
#define XB_XCNT(j)  (256  + 64 * (j))
#define XB_XSUB(j)  (1280 + 64 * (j))
#define XB_XGEN(j)  (2304 + 64 * (j))
#define XB_TOP      3328
#define XB_TOPGEN   3392
#define XCD_BAR_WORDS 3456
#define XB_SPIN_CAP (1u << 22)
__device__ __forceinline__ unsigned xb_ld(unsigned* p)              { return __hip_atomic_load(p, __ATOMIC_RELAXED, __HIP_MEMORY_SCOPE_AGENT); }
__device__ __forceinline__ unsigned xb_add(unsigned* p, unsigned v) { return __hip_atomic_fetch_add(p, v, __ATOMIC_RELAXED, __HIP_MEMORY_SCOPE_AGENT); }
__device__ __forceinline__ unsigned xb_xcc_id() { return (unsigned)__builtin_amdgcn_s_getreg((3 << 11) | 20) & 0xFu; }
#define XB_SPIN(cond, bar) do { unsigned _sp = 0; while (cond) { __builtin_amdgcn_s_sleep(1); \
    if ((++_sp & 255u) == 0u) { if (xb_ld(&(bar)[XB_TMO])) break; if (_sp > XB_SPIN_CAP) { atomicAdd(&(bar)[XB_TMO], 1u); break; } } } } while (0)
struct XcdBarrier { unsigned* bar; unsigned x; volatile LAS unsigned* st; };
__device__ __forceinline__ XcdBarrier xcd_barrier_post(unsigned* bar, volatile LAS unsigned* st) {
    XcdBarrier b; b.bar = bar; b.x = xb_xcc_id(); b.st = st;
    if (threadIdx.x == 0) (void)xb_add(&bar[XB_XCNT(b.x)], 1u);
    return b;
}
__device__ __forceinline__ void xcd_barrier_complete(unsigned* bar, unsigned x, unsigned& nloc, unsigned& nx) {
    const unsigned G = gridDim.x * gridDim.y * gridDim.z;
    unsigned sum, cnt, mine, sp = 0u;
    for (;;) {
        sum = 0u; cnt = 0u; mine = 0u;
#pragma unroll
        for (unsigned j = 0; j < 16; ++j) { const unsigned c = xb_ld(&bar[XB_XCNT(j)]); sum += c; cnt += (c > 0u) ? 1u : 0u; mine = (j == x) ? c : mine; }
        if (sum == G) break;
        __builtin_amdgcn_s_sleep(1);
        if ((++sp & 255u) == 0u) { if (xb_ld(&bar[XB_TMO])) break; if (sp > XB_SPIN_CAP) { atomicAdd(&bar[XB_TMO], 1u); break; } }
    }
    nloc = mine > 0u ? mine : 1u; nx = cnt > 0u ? cnt : 1u;
}
__device__ __forceinline__ void xcd_barrier(const XcdBarrier& b) {
    asm volatile("s_waitcnt vmcnt(0)" ::: "memory");
    __syncthreads();
    if (threadIdx.x == 0) {
        unsigned* bar = b.bar;
        __builtin_amdgcn_s_waitcnt(0);
        unsigned nloc = b.st[0], nx = b.st[1];
        if (nloc == 0u) { xcd_barrier_complete(bar, b.x, nloc, nx); b.st[0] = nloc; b.st[1] = nx; }
        const unsigned old = xb_add(&bar[XB_XSUB(b.x)], 1u);
        const unsigned gen = old / nloc;
        if (old + 1u == (gen + 1u) * nloc) {
            __builtin_amdgcn_fence(__ATOMIC_RELEASE, "agent");
            asm volatile("s_waitcnt vmcnt(0)" ::: "memory");
            const unsigned og = xb_add(&bar[XB_TOP], 1u);
            const unsigned tg = og / nx;
            if (og + 1u == (tg + 1u) * nx) xb_add(&bar[XB_TOPGEN], 1u);
            else XB_SPIN(xb_ld(&bar[XB_TOPGEN]) == tg, bar);
            __builtin_amdgcn_fence(__ATOMIC_ACQUIRE, "agent");
            xb_add(&bar[XB_XGEN(b.x)], 1u);
            asm volatile("s_waitcnt vmcnt(0)" ::: "memory");
        } else {
            XB_SPIN(xb_ld(&bar[XB_XGEN(b.x)]) == gen, bar);
            __builtin_amdgcn_fence(__ATOMIC_ACQUIRE, "agent");
            asm volatile("s_waitcnt vmcnt(0)" ::: "memory");
        }
    }
    __syncthreads();
}

namespace pg8 {
#define PG8_LAS __attribute__((address_space(3)))
typedef unsigned short bf16_t;
typedef short bf16x8 __attribute__((ext_vector_type(8)));
typedef float f32x4 __attribute__((ext_vector_type(4)));
typedef unsigned u32x4 __attribute__((ext_vector_type(4)));
constexpr int BM = 256, BK = 64, HALF = 128, HTB = HALF * BK * 2, STAGE_BYTES = 8 * HTB, NXCD = 8, WGM = 8;
__host__ __device__ __forceinline__ int lds_byte(int r, int c) { const int st = (r >> 4) * 2 + (c >> 5), rr = r & 15, cc = c & 31, ob = rr * 64 + cc * 2; return st * 1024 + (ob ^ (((ob >> 9) & 1) << 5)); }
__host__ __device__ __forceinline__ void stage_rc(int b, int& R, int& C) { const int st = b / 1024, sb = b % 1024, swz = sb ^ (((sb >> 9) & 1) << 5); R = (st >> 1) * 16 + swz / 64; C = (st & 1) * 32 + (swz % 64) / 2; }
__host__ __device__ __forceinline__ int perm32(int rho) { const int n = rho >> 4, i = rho & 15; return 8 * (i >> 2) + 4 * n + (i & 3); }
struct Unit { int pm, pn; };
struct Gemm { const bf16_t* A; const bf16_t* Bt; int M, N, K; };
struct StaticOrder {
    int nM, nN, nwg, G, c;
    __host__ __device__ __forceinline__ void init(int M, int N, int G_, int c_) { nM = M / BM; nN = N / BM; nwg = nM * nN; G = G_; c = c_; }
    __host__ __device__ bool next(int i, Unit& u) const {
        const long L = (long)i * G + c; if (L >= nwg) return false;
        int wgid = (int)L; { const int q = nwg / NXCD, r = nwg % NXCD, xcd = wgid % NXCD, off = wgid / NXCD; wgid = (xcd < r ? xcd * (q + 1) : r * (q + 1) + (xcd - r) * q) + off; }
        const int nig = WGM * nN, gid = wgid / nig, fm = gid * WGM, gsz = (nM - fm) < WGM ? (nM - fm) : WGM;
        u.pm = fm + ((wgid % nig) % gsz); u.pn = (wgid % nig) / gsz; return true;
    }
    __device__ __forceinline__ void a_ready(const Unit&) const {}
    __device__ __forceinline__ void done(const Unit&) const {}
};
__device__ __forceinline__ unsigned cvt_pk_bf16(float lo, float hi) { unsigned r; asm volatile("v_cvt_pk_bf16_f32 %0, %1, %2" : "=v"(r) : "v"(lo), "v"(hi)); return r; }

struct EpiF32R {
    static constexpr bool PERM = false, AFTER_DRAIN = false;
    float* C; const float* R; int ldc;
    __device__ __forceinline__ void operator()(const f32x4 (&acc)[2][2][4][2], const Unit& u, int wr, int wc, int fr, int fq) const {
        const int row0 = u.pm * BM + wr * 64 + fr, col0 = u.pn * BM + wc * 32 + 4 * fq;
#pragma unroll
        for (int ai = 0; ai < 2; ++ai)
#pragma unroll
            for (int m = 0; m < 4; ++m) {
                const size_t ro = (size_t)(row0 + ai * HALF + m * 16) * ldc + col0;
                f32x4 rv[2][2];
#pragma unroll
                for (int bj = 0; bj < 2; ++bj)
#pragma unroll
                    for (int n = 0; n < 2; ++n) rv[bj][n] = R ? *(const f32x4*)(R + ro + bj * HALF + n * 16) : (f32x4){0.f, 0.f, 0.f, 0.f};
#pragma unroll
                for (int bj = 0; bj < 2; ++bj)
#pragma unroll
                    for (int n = 0; n < 2; ++n) *(f32x4*)(C + ro + bj * HALF + n * 16) = acc[ai][bj][m][n] + rv[bj][n];
                __builtin_amdgcn_sched_barrier(0);
            }
    }
};

struct EpiBf16 {
    static constexpr bool PERM = true, AFTER_DRAIN = false;
    bf16_t* O; int ldc;
    __device__ __forceinline__ void operator()(const f32x4 (&acc)[2][2][4][2], const Unit& u, int wr, int wc, int fr, int fq) const {
        const int row0 = u.pm * BM + wr * 64 + fr, col0 = u.pn * BM + wc * 32 + 8 * fq;
#pragma unroll
        for (int ai = 0; ai < 2; ++ai)
#pragma unroll
            for (int m = 0; m < 4; ++m) { bf16_t* rowp = O + (size_t)(row0 + ai * HALF + m * 16) * ldc + col0;
#pragma unroll
                for (int bj = 0; bj < 2; ++bj) { const f32x4 v0 = acc[ai][bj][m][0], v1 = acc[ai][bj][m][1];
                    u32x4 w; w.x = cvt_pk_bf16(v0[0], v0[1]); w.y = cvt_pk_bf16(v0[2], v0[3]); w.z = cvt_pk_bf16(v1[0], v1[1]); w.w = cvt_pk_bf16(v1[2], v1[3]);
                    *(u32x4*)(rowp + bj * HALF) = w; } }
    }
};

struct EpiF32RN {
    static constexpr bool PERM = false, AFTER_DRAIN = false;
    float* C; const float* R; int ldc; bf16_t* XG; const float* g; float* st;
    __device__ __forceinline__ void operator()(const f32x4 (&acc)[2][2][4][2], const Unit& u, int wr, int wc, int fr, int fq) const {
        const int row0 = u.pm * BM + wr * 64 + fr, col0 = u.pn * BM + wc * 32 + 4 * fq;
        f32x4 gv[2][2];
#pragma unroll
        for (int bj = 0; bj < 2; ++bj)
#pragma unroll
            for (int n = 0; n < 2; ++n) gv[bj][n] = *(const f32x4*)(g + col0 + bj * HALF + n * 16);
#pragma unroll
        for (int ai = 0; ai < 2; ++ai)
#pragma unroll
            for (int m = 0; m < 4; ++m) {
                const int row = row0 + ai * HALF + m * 16;
                const size_t ro = (size_t)row * ldc + col0;
                f32x4 rv[2][2];
#pragma unroll
                for (int bj = 0; bj < 2; ++bj)
#pragma unroll
                    for (int n = 0; n < 2; ++n) rv[bj][n] = *(const f32x4*)(R + ro + bj * HALF + n * 16);
                float ss = 0.f;
#pragma unroll
                for (int bj = 0; bj < 2; ++bj)
#pragma unroll
                    for (int n = 0; n < 2; ++n) {
                        const f32x4 v = acc[ai][bj][m][n] + rv[bj][n];
                        *(f32x4*)(C + ro + bj * HALF + n * 16) = v;
                        ss += (v[0] * v[0] + v[1] * v[1]) + (v[2] * v[2] + v[3] * v[3]);
                        const f32x4 w = v * gv[bj][n];
                        uint2 pk; pk.x = cvt_pk_bf16(w[0], w[1]); pk.y = cvt_pk_bf16(w[2], w[3]);
                        *(uint2*)(XG + ro + bj * HALF + n * 16) = pk;
                    }
                ss += __shfl_xor(ss, 16, 64); ss += __shfl_xor(ss, 32, 64);
                if (fq == 0) st[(size_t)row * 16 + u.pn * 4 + wc] = ss;
                __builtin_amdgcn_sched_barrier(0);
            }
    }
};
struct EpiBf16S {
    static constexpr bool PERM = true, AFTER_DRAIN = false;
    bf16_t* O; int ldc; const float* st;
    __device__ __forceinline__ void operator()(const f32x4 (&acc)[2][2][4][2], const Unit& u, int wr, int wc, int fr, int fq) const {
        const int row0 = u.pm * BM + wr * 64 + fr, col0 = u.pn * BM + wc * 32 + 8 * fq;
#pragma unroll
        for (int ai = 0; ai < 2; ++ai)
#pragma unroll
            for (int m = 0; m < 4; ++m) {
                const int row = row0 + ai * HALF + m * 16;
                const f32x4* sp = (const f32x4*)(st + (size_t)row * 16);
                const f32x4 s0 = sp[0], s1 = sp[1], s2 = sp[2], s3 = sp[3];
                const f32x4 sa = (s0 + s1) + (s2 + s3);
                const float rs = __builtin_amdgcn_rsqf(((sa[0] + sa[1]) + (sa[2] + sa[3])) * (1.0f / 1024.f) + 1e-6f);
                bf16_t* rowp = O + (size_t)row * ldc + col0;
#pragma unroll
                for (int bj = 0; bj < 2; ++bj) { const f32x4 v0 = acc[ai][bj][m][0] * rs, v1 = acc[ai][bj][m][1] * rs;
                    u32x4 w; w.x = cvt_pk_bf16(v0[0], v0[1]); w.y = cvt_pk_bf16(v0[2], v0[3]); w.z = cvt_pk_bf16(v1[0], v1[1]); w.w = cvt_pk_bf16(v1[2], v1[3]);
                    *(u32x4*)(rowp + bj * HALF) = w; }
                __builtin_amdgcn_sched_barrier(0);
            }
    }
};

template <class Epi, class Sched, bool ALIGN_EPI = false, bool SP2 = false>
__device__ __forceinline__ void gemm_phase(const int wave_s, PG8_LAS unsigned char* lds, const Gemm g, const Sched& S, const Epi& E) {
    const int tid = opaque_tid(wave_s), wid = __builtin_amdgcn_readfirstlane(tid >> 6), lane = tid & 63, wr = wid >> 2, wc = wid & 3, fr = lane & 15, fq = lane >> 4;
    const int K = g.K, nt = K / BK;
    unsigned voffA[2], voffB[2];
#pragma unroll
    for (int i = 0; i < 2; ++i) { int R, C; stage_rc(tid * 16 + i * 8192, R, C); const int Rb = Epi::PERM ? ((R & ~31) + perm32(R & 31)) : R;
        voffA[i] = (unsigned)(R * K + C) * 2u; voffB[i] = (unsigned)(Rb * K + C) * 2u; }
    const size_t kstep = (size_t)(BK * 2);
    const size_t hstep = (size_t)HALF * K * 2;
    const size_t tstep = 2 * hstep;
    const unsigned ldsw = (unsigned)wid * 1024u;
    const int aoff = lds_byte(wr * 64 + fr, fq * 8), boff = lds_byte(wc * 32 + fr, fq * 8);
#define PG8_SA(b, h) (((b) * 2 + (h)) * HTB)
#define PG8_SB(b, h) ((4 + (b) * 2 + (h)) * HTB)
#define PG8_STAGE(bufoff, gbase, voff) do { _Pragma("unroll") for (int _i = 0; _i < 2; ++_i) \
        __builtin_amdgcn_global_load_lds((const unsigned*)((const char*)(gbase) + (voff)[_i]), (PG8_LAS unsigned*)(lds + (bufoff) + ldsw + _i * 8192), 16, 0, 0); } while (0)
#define PG8_LDA(dst, b, h) do { _Pragma("unroll") for (int m = 0; m < 4; ++m) _Pragma("unroll") for (int k = 0; k < 2; ++k) dst[m][k] = *(const PG8_LAS bf16x8*)(lds + PG8_SA(b, h) + aoff + m * 2048 + k * 1024); } while (0)
#define PG8_LDB(dst, b, h) do { _Pragma("unroll") for (int n = 0; n < 2; ++n) _Pragma("unroll") for (int k = 0; k < 2; ++k) dst[n][k] = *(const PG8_LAS bf16x8*)(lds + PG8_SB(b, h) + boff + n * 2048 + k * 1024); } while (0)
#define PG8_MMA(ai, bj, At, Bt) do { __builtin_amdgcn_s_setprio(1); _Pragma("unroll") for (int m = 0; m < 4; ++m) _Pragma("unroll") for (int n = 0; n < 2; ++n) _Pragma("unroll") for (int k = 0; k < 2; ++k) \
        acc[ai][bj][m][n] = __builtin_amdgcn_mfma_f32_16x16x32_bf16(Bt[n][k], At[m][k], acc[ai][bj][m][n], 0, 0, 0); __builtin_amdgcn_s_setprio(0); } while (0)
#define PG8_WAIT_V(n) asm volatile("s_waitcnt vmcnt(" #n ")" ::: "memory")
#define PG8_WAIT_L(n) asm volatile("s_waitcnt lgkmcnt(" #n ")" ::: "memory")
#define PG8_BAR __builtin_amdgcn_s_barrier()
#define PG8_SCHED __builtin_amdgcn_sched_barrier(0)
    Unit cur, nxt; int ui = 0;
    if (!S.next(0, cur)) return;
    f32x4 acc[2][2][4][2];
#pragma unroll
    for (int a = 0; a < 2; ++a)
#pragma unroll
        for (int b = 0; b < 2; ++b)
#pragma unroll
            for (int m = 0; m < 4; ++m)
#pragma unroll
                for (int n = 0; n < 2; ++n) acc[a][b][m][n] = (f32x4){0.f, 0.f, 0.f, 0.f};
    bf16x8 At[4][2], B0[2][2], B1[2][2];
    const char* cA = (const char*)g.A + (size_t)cur.pm * tstep; const char* cB = (const char*)g.Bt + (size_t)cur.pn * tstep;
    S.a_ready(cur);
    if constexpr (SP2) {
        PG8_STAGE(PG8_SB(0, 0), cB, voffB); PG8_STAGE(PG8_SB(0, 1), cB + hstep, voffB); PG8_STAGE(PG8_SA(0, 0), cA, voffA); PG8_STAGE(PG8_SA(0, 1), cA + hstep, voffA);
        if (wr == 1) PG8_BAR;
        PG8_WAIT_V(2); PG8_BAR;
        PG8_STAGE(PG8_SB(1, 0), cB + kstep, voffB); PG8_STAGE(PG8_SA(1, 0), cA + kstep, voffA); PG8_STAGE(PG8_SB(1, 1), cB + hstep + kstep, voffB);
        PG8_WAIT_V(6); PG8_BAR;
    } else {
        PG8_STAGE(PG8_SB(0, 0), cB, voffB); PG8_STAGE(PG8_SA(0, 0), cA, voffA); PG8_STAGE(PG8_SB(0, 1), cB + hstep, voffB); PG8_STAGE(PG8_SA(0, 1), cA + hstep, voffA);
        if (wr == 1) PG8_BAR;
        PG8_WAIT_V(4); PG8_BAR;
        PG8_STAGE(PG8_SB(1, 0), cB + kstep, voffB); PG8_STAGE(PG8_SA(1, 0), cA + kstep, voffA); PG8_STAGE(PG8_SB(1, 1), cB + hstep + kstep, voffB);
        PG8_WAIT_V(6); PG8_BAR;
    }
    for (;;) {
        const bool has_next = S.next(ui + 1, nxt);
        const char* nA = has_next ? (const char*)g.A + (size_t)nxt.pm * tstep : cA; const char* nB = has_next ? (const char*)g.Bt + (size_t)nxt.pn * tstep : cB;
        for (int t = 0; t < nt; t += 2) {
            const bool last = (t == nt - 2);
            const char* a1 = cA + (size_t)(t + 1) * kstep;
            const char* a2 = last ? nA : cA + (size_t)(t + 2) * kstep; const char* b2 = last ? nB : cB + (size_t)(t + 2) * kstep;
            const char* a3 = a2 + kstep; const char* b3 = b2 + kstep;
            if (last && has_next) S.a_ready(nxt);
            if constexpr (SP2) {
            PG8_LDB(B0, 0, 0); PG8_LDB(B1, 0, 1); PG8_SCHED; PG8_LDA(At, 0, 0); PG8_STAGE(PG8_SA(1, 1), a1 + hstep, voffA);
            PG8_WAIT_V(8); PG8_WAIT_L(0); PG8_BAR; PG8_MMA(0, 0, At, B0); PG8_MMA(0, 1, At, B1); PG8_BAR; PG8_SCHED;
            PG8_LDA(At, 0, 1); PG8_STAGE(PG8_SB(0, 0), b2, voffB); PG8_STAGE(PG8_SB(0, 1), b2 + hstep, voffB); PG8_STAGE(PG8_SA(0, 0), a2, voffA);
            PG8_WAIT_V(8); PG8_WAIT_L(0); PG8_BAR; PG8_MMA(1, 0, At, B0); PG8_MMA(1, 1, At, B1); PG8_BAR; PG8_SCHED;
            PG8_LDB(B0, 1, 0); PG8_LDB(B1, 1, 1); PG8_SCHED; PG8_LDA(At, 1, 0); PG8_STAGE(PG8_SA(0, 1), a2 + hstep, voffA);
            PG8_WAIT_V(8); PG8_WAIT_L(0); PG8_BAR; PG8_MMA(0, 0, At, B0); PG8_MMA(0, 1, At, B1); PG8_BAR; PG8_SCHED;
            PG8_LDA(At, 1, 1); PG8_STAGE(PG8_SB(1, 0), b3, voffB); PG8_STAGE(PG8_SB(1, 1), b3 + hstep, voffB); PG8_STAGE(PG8_SA(1, 0), a3, voffA);
            PG8_WAIT_V(8); PG8_WAIT_L(0); PG8_BAR; PG8_MMA(1, 0, At, B0); PG8_MMA(1, 1, At, B1); PG8_BAR; PG8_SCHED;
            } else {
            PG8_LDB(B0, 0, 0); PG8_SCHED; PG8_LDA(At, 0, 0); PG8_STAGE(PG8_SA(1, 1), a1 + hstep, voffA);
            PG8_WAIT_L(8); PG8_BAR; PG8_WAIT_L(0); PG8_MMA(0, 0, At, B0); PG8_BAR; PG8_SCHED;
            PG8_LDB(B1, 0, 1); PG8_STAGE(PG8_SB(0, 0), b2, voffB);
            PG8_BAR; PG8_WAIT_L(0); PG8_MMA(0, 1, At, B1); PG8_BAR;
            PG8_LDA(At, 0, 1); PG8_STAGE(PG8_SA(0, 0), a2, voffA);
            PG8_BAR; PG8_WAIT_L(0); PG8_MMA(1, 0, At, B0); PG8_BAR; PG8_SCHED;
            PG8_STAGE(PG8_SB(0, 1), b2 + hstep, voffB);
            PG8_WAIT_V(6); PG8_BAR; PG8_MMA(1, 1, At, B1); PG8_BAR;
            PG8_LDB(B0, 1, 0); PG8_SCHED; PG8_LDA(At, 1, 0); PG8_STAGE(PG8_SA(0, 1), a2 + hstep, voffA);
            PG8_WAIT_L(8); PG8_BAR; PG8_WAIT_L(0); PG8_MMA(0, 0, At, B0); PG8_BAR; PG8_SCHED;
            PG8_LDB(B1, 1, 1); PG8_STAGE(PG8_SB(1, 0), b3, voffB);
            PG8_BAR; PG8_WAIT_L(0); PG8_MMA(0, 1, At, B1); PG8_BAR;
            PG8_LDA(At, 1, 1); PG8_STAGE(PG8_SA(1, 0), a3, voffA);
            PG8_BAR; PG8_WAIT_L(0); PG8_MMA(1, 0, At, B0); PG8_BAR; PG8_SCHED;
            PG8_STAGE(PG8_SB(1, 1), b3 + hstep, voffB);
            PG8_WAIT_V(6); PG8_BAR; PG8_MMA(1, 1, At, B1); PG8_BAR;
            }
        }
        if constexpr (ALIGN_EPI) { if (wr == 0) PG8_BAR; }
        if constexpr (!Epi::AFTER_DRAIN) { E(acc, cur, wr, wc, fr, fq); S.done(cur); }
        if (!has_next) break;
#pragma unroll
        for (int a = 0; a < 2; ++a)
#pragma unroll
            for (int b = 0; b < 2; ++b)
#pragma unroll
                for (int m = 0; m < 4; ++m)
#pragma unroll
                    for (int n = 0; n < 2; ++n) acc[a][b][m][n] = (f32x4){0.f, 0.f, 0.f, 0.f};
        cur = nxt; cA = nA; cB = nB; ++ui;
        if constexpr (ALIGN_EPI) { if (wr == 1) PG8_BAR; }
    }
    PG8_WAIT_V(0);
    if constexpr (!ALIGN_EPI) { if (wr == 0) PG8_BAR; }
    PG8_BAR;
#undef PG8_SA
#undef PG8_SB
#undef PG8_STAGE
#undef PG8_LDA
#undef PG8_LDB
#undef PG8_MMA
#undef PG8_WAIT_V
#undef PG8_WAIT_L
#undef PG8_BAR
#undef PG8_SCHED
}
}

__device__ __forceinline__ void transpose_item(const float* W, int K, int N, bf16* WT, LAS float* scr, int item, int lane) {
    const int nblk = N / 32, kb = item / nblk, nb = item % nblk, k0 = 64 * kb, n0 = 32 * nb;
#pragma unroll 8
    for (int i = 0; i < 32; ++i) { const int kk = 2 * i + (lane >> 5); scr[kk * 33 + (lane & 31)] = W[(size_t)(k0 + kk) * N + n0 + (lane & 31)]; }
    asm volatile("s_waitcnt lgkmcnt(0)" ::: "memory");
    const int c = lane & 7;
#pragma unroll
    for (int j = 0; j < 4; ++j) { const int n = (lane >> 3) + 8 * j; const LAS float* s = scr + (8 * c) * 33 + n;
        uint4 o; o.x = pk2(s[0 * 33], s[1 * 33]); o.y = pk2(s[2 * 33], s[3 * 33]); o.z = pk2(s[4 * 33], s[5 * 33]); o.w = pk2(s[6 * 33], s[7 * 33]);
        *(uint4*)(WT + (size_t)(n0 + n) * K + k0 + 8 * c) = o; }
    asm volatile("s_waitcnt lgkmcnt(0)" ::: "memory");
}

__device__ __forceinline__ float wsum(float v) {
#pragma unroll
  for (int o = 32; o > 0; o >>= 1) v += __shfl_xor(v, o, 64);
  return v;
}
__device__ __forceinline__ float wmaxf(float v) {
#pragma unroll
  for (int o = 32; o > 0; o >>= 1) v = fmaxf(v, __shfl_xor(v, o, 64));
  return v;
}
__device__ __forceinline__ float sigmoidf_(float x) { return 1.0f / (1.0f + expf(-x)); }
__device__ __forceinline__ float gelu_tanh(float x) {
  return 0.5f * x * (1.0f + tanhf(0.7978845608028654f * (x + 0.044715f * x * x * x)));
}

template <bool BF16OUT>
__device__ __forceinline__ void rms_rows(const int wave_s, const float* src, const float* g, void* dstv, int rows) {
  const int tid_ = opaque_tid(wave_s);
  const int lane = tid_ & 63;
  const int gw = blockIdx.x * NWAVES + (tid_ >> 6);
  const int nw = gridDim.x * NWAVES;
  for (int r = gw; r < rows; r += nw) {
    const float4* s4 = (const float4*)(src + (size_t)r * DM);
    float4 v[4];
    float ss = 0.f;
#pragma unroll
    for (int i = 0; i < 4; i++) {
      v[i] = s4[lane + i * 64];
      ss += v[i].x * v[i].x + v[i].y * v[i].y + v[i].z * v[i].z + v[i].w * v[i].w;
    }
    ss = wsum(ss);
    const float rstd = rsqrtf(ss * (1.0f / DM) + EPSF);
    const float4* g4 = (const float4*)g;
#pragma unroll
    for (int i = 0; i < 4; i++) {
      float4 gg = g4[lane + i * 64];
      float4 o;
      o.x = v[i].x * rstd * gg.x; o.y = v[i].y * rstd * gg.y;
      o.z = v[i].z * rstd * gg.z; o.w = v[i].w * rstd * gg.w;
      if (BF16OUT) {
        uint2 pk; pk.x = pk2(o.x, o.y); pk.y = pk2(o.z, o.w);
        ((uint2*)((bf16*)dstv + (size_t)r * DM))[lane + i * 64] = pk;
      } else {
        ((float4*)((float*)dstv + (size_t)r * DM))[lane + i * 64] = o;
      }
    }
  }
}

__device__ __forceinline__ void ssm_params(const int wave_s, const Params& p, float* ssmp_all) {
  const int tid_ = opaque_tid(wave_s);
  const float* in8 = karg_in(8); const float* in9 = karg_in(9); const float* in10 = karg_in(10);
  const float* in11 = karg_in(11); const float* in12 = karg_in(12);
  const int gt = blockIdx.x * blockDim.x + tid_;
  const int nth = gridDim.x * blockDim.x;
  for (int i = gt; i < 2 * 16 * 64; i += nth) {
    const int l = i / 1024, gp = i % 1024, g = gp / 64;
    float* sp = ssmp_all + (size_t)l * SSMP_PER_LAYER;
    const float lre = fminf(in8[l * 1024 + gp], -1e-4f);
    const float lim = in9[l * 1024 + gp];
    const float dt = expf(in10[l * 16 + g]);
    const float er = expf(lre * dt);
    float sn, cs;
    sincosf(lim * dt, &sn, &cs);
    const float br = er * cs, bi = er * sn;
    sp[gp * 2 + 0] = br;
    sp[gp * 2 + 1] = bi;
    float cr = br, ci = bi;
#pragma unroll
    for (int s = 0; s < 6; s++) {
      const float nr = cr * cr - ci * ci, ni = 2.f * cr * ci;
      cr = nr; ci = ni;
    }
    sp[2048 + gp * 2 + 0] = cr;
    sp[2048 + gp * 2 + 1] = ci;
    const float nr = br - 1.0f, ni = bi;
    const float den = lre * lre + lim * lim;
    const float fr = (nr * lre + ni * lim) / den;
    const float fi = (ni * lre - nr * lim) / den;
    for (int h = 0; h < 16; h++) {
      const float bre = in11[((size_t)l * 1024 + gp) * 16 + h];
      const float bim = in12[((size_t)l * 1024 + gp) * 16 + h];
      sp[4096 + ((g * 16 + h) * 64 + (gp & 63)) * 2 + 0] = fr * bre - fi * bim;
      sp[4096 + ((g * 16 + h) * 64 + (gp & 63)) * 2 + 1] = fr * bim + fi * bre;
    }
  }
}

__device__ __forceinline__ void conv_phase(const int wave_s, const Params& p, int l, const bf16* proj, bf16* y, LAS float* smem) {
  const int tid_ = opaque_tid(wave_s);
  const int lane = tid_ & 63;
  const int gw = blockIdx.x * NWAVES + (tid_ >> 6);
  const int nw = gridDim.x * NWAVES;
  const float* cw = karg_in(4) + (size_t)l * 31 * 256;
  const float4 cb = ((const float4*)(karg_in(5) + l * 256))[lane];
  const float4 lg = ((const float4*)(karg_in(6) + l * 256))[lane];
  const float4 lb = ((const float4*)(karg_in(7) + l * 256))[lane];
  const float4 gg = ((const float4*)(karg_in(18) + l * 1024))[lane];
  LAS float* cwl = smem + 1024;
  for (int i = tid_; i < 31 * 256 / 4; i += NWAVES * 64) *(LAS pg8::f32x4*)(cwl + 4 * i) = *(const pg8::f32x4*)(cw + 4 * i);
  __syncthreads();
  for (int it = gw; it < NT / 8; it += nw) {
    const int tok0 = it * 8;
    const int t0 = tok0 & (SEQ - 1);
    float4 acc[8];
#pragma unroll
    for (int o = 0; o < 8; o++) acc[o] = cb;
#pragma unroll
    for (int i = 0; i < 38; i++) {
      if (t0 - 30 + i >= 0) {
        const bf16* row = proj + (size_t)(tok0 - 30 + i) * DIN;
        const uint2 vp = ((const uint2*)row)[lane];
        const uint2 gp = ((const uint2*)(row + 256))[lane];
        float4 g4;
        g4.x = bf_lo(vp.x) * sigmoidf_(bf_lo(gp.x)); g4.y = bf_hi(vp.x) * sigmoidf_(bf_hi(gp.x));
        g4.z = bf_lo(vp.y) * sigmoidf_(bf_lo(gp.y)); g4.w = bf_hi(vp.y) * sigmoidf_(bf_hi(gp.y));
#pragma unroll
        for (int o = 0; o < 8; o++) {
          const int j = i - o;
          if (j >= 0 && j <= 30) {
            const pg8::f32x4 w4 = *(const LAS pg8::f32x4*)(cwl + j * 256 + lane * 4);
            acc[o].x += g4.x * w4[0]; acc[o].y += g4.y * w4[1];
            acc[o].z += g4.z * w4[2]; acc[o].w += g4.w * w4[3];
          }
        }
      }
    }
#pragma unroll
    for (int o = 0; o < 8; o++) {
      const float4 a = acc[o];
      const float mean = wsum(a.x + a.y + a.z + a.w) * (1.0f / 256.f);
      const float dx = a.x - mean, dy = a.y - mean, dz = a.z - mean, dw = a.w - mean;
      const float var = wsum(dx * dx + dy * dy + dz * dz + dw * dw) * (1.0f / 256.f);
      const float rs = rsqrtf(var + EPSF);
      float4 s;
      s.x = dx * rs * lg.x + lb.x; s.y = dy * rs * lg.y + lb.y;
      s.z = dz * rs * lg.z + lb.z; s.w = dw * rs * lg.w + lb.w;
      s.x = s.x * sigmoidf_(s.x); s.y = s.y * sigmoidf_(s.y);
      s.z = s.z * sigmoidf_(s.z); s.w = s.w * sigmoidf_(s.w);
      const float ss = wsum(s.x * s.x + s.y * s.y + s.z * s.z + s.w * s.w) * (1.0f / 256.f);
      const float r2 = rsqrtf(ss + EPSF);
      uint2 pk; pk.x = pk2(s.x * r2 * gg.x, s.y * r2 * gg.y); pk.y = pk2(s.z * r2 * gg.z, s.w * r2 * gg.w);
      ((uint2*)(y + (size_t)(tok0 + o) * DM))[lane] = pk;
    }
  }
}

typedef short bf16x8_t __attribute__((ext_vector_type(8)));
typedef float f32x16_t __attribute__((ext_vector_type(16)));
#define MFMA_PAD() do { __builtin_amdgcn_sched_barrier(0); asm volatile("s_nop 15\n\ts_nop 15" ::: "memory"); __builtin_amdgcn_sched_barrier(0); } while (0)

__device__ __forceinline__ void attn_phase(const int wave_s, const Params& p, int l, const bf16* proj, bf16* y, LAS float* smem) {
  const int tid = opaque_tid(wave_s), lane = tid & 63, wave = tid >> 6;
  const int n = lane & 31, hh = lane >> 5;
  const float* gg = karg_in(18) + l * 1024 + 256 + wave * 64;
  const float g0 = gg[n], g1 = gg[32 + n];
  LAS float* ssq = smem;
  LAS float* rstd = smem + 256;
  for (int item = blockIdx.x; item < 4 * 128; item += gridDim.x) {
    const int b = item >> 7, q0 = (item & 127) * 32;
    const size_t tokb = (size_t)b * SEQ;
    bf16x8_t qf[4];
    {
      const bf16* qrow = proj + (tokb + q0 + n) * DIN + 512 + wave * 64 + 8 * hh;
#pragma unroll
      for (int ks = 0; ks < 4; ks++) qf[ks] = *(const bf16x8_t*)(qrow + 16 * ks);
    }
    f32x16_t o0, o1;
#pragma unroll
    for (int r = 0; r < 16; r++) { o0[r] = 0.f; o1[r] = 0.f; }
    float R = 0.f;
    for (int kt = q0; kt >= 0; kt -= 32) {
      bf16x8_t kf[4];
      {
        const bf16* krow = proj + (tokb + kt + n) * DIN + 1024 + wave * 64 + 8 * hh;
#pragma unroll
        for (int ks = 0; ks < 4; ks++) kf[ks] = *(const bf16x8_t*)(krow + 16 * ks);
      }
      bf16x8_t vf0[2], vf1[2];
      {
        const bf16* vb = proj + (tokb + kt + 4 * hh) * DIN + 1536 + wave * 64 + n;
#pragma unroll
        for (int s = 0; s < 2; s++)
#pragma unroll
          for (int j = 0; j < 8; j++) {
            const int key = 16 * s + 8 * (j >> 2) + (j & 3);
            vf0[s][j] = (short)vb[(size_t)key * DIN];
            vf1[s][j] = (short)vb[(size_t)key * DIN + 32];
          }
      }
      f32x16_t sacc;
#pragma unroll
      for (int r = 0; r < 16; r++) sacc[r] = 0.f;
      __builtin_amdgcn_sched_barrier(0); asm volatile("s_nop 15\n\ts_nop 15" ::: "memory"); __builtin_amdgcn_sched_barrier(0);
#pragma unroll
      for (int ks = 0; ks < 4; ks++) sacc = __builtin_amdgcn_mfma_f32_32x32x16_bf16(kf[ks], qf[ks], sacc, 0, 0, 0);
      __builtin_amdgcn_sched_barrier(0); asm volatile("s_nop 15\n\ts_nop 15" ::: "memory"); __builtin_amdgcn_sched_barrier(0);
      float lst[16], lsz[16];
      const bool diag = (kt == q0);
#pragma unroll
      for (int r = 0; r < 16; r++) {
        const float z = sacc[r] * 0.125f;
        const float sp = __logf(1.0f + __expf(-fabsf(z)));
        float a = fminf(z, 0.f) - sp;
        float c = -(fmaxf(z, 0.f) + sp);
        if (diag) {
          const int key = (r & 3) + 8 * (r >> 2) + 4 * hh;
          if (key >= n) { a = -1.0e30f; c = 0.f; }
        }
        lsz[r] = a; lst[r] = c;
      }
      float Gs[4], Gp[4];
#pragma unroll
      for (int g = 0; g < 4; g++) {
        Gs[g] = (lst[4 * g] + lst[4 * g + 1]) + (lst[4 * g + 2] + lst[4 * g + 3]);
        Gp[g] = __shfl_xor(Gs[g], 32, 64);
      }
      float carry[4];
      {
        float after = R;
#pragma unroll
        for (int g = 3; g >= 0; g--) {
          carry[g] = after + (hh ? 0.f : Gp[g]);
          after += Gs[g] + Gp[g];
        }
        R = after;
      }
      bf16x8_t pf[2];
#pragma unroll
      for (int g = 0; g < 4; g++) {
        float run = carry[g];
        float a3 = __expf(lsz[4 * g + 3] + run); run += lst[4 * g + 3];
        float a2 = __expf(lsz[4 * g + 2] + run); run += lst[4 * g + 2];
        float a1 = __expf(lsz[4 * g + 1] + run); run += lst[4 * g + 1];
        float a0 = __expf(lsz[4 * g + 0] + run);
        const int s = g >> 1, jb = (g & 1) * 4;
        pf[s][jb + 0] = (short)f2bf(a0); pf[s][jb + 1] = (short)f2bf(a1);
        pf[s][jb + 2] = (short)f2bf(a2); pf[s][jb + 3] = (short)f2bf(a3);
      }
      __builtin_amdgcn_sched_barrier(0); asm volatile("s_nop 15\n\ts_nop 15" ::: "memory"); __builtin_amdgcn_sched_barrier(0);
#pragma unroll
      for (int s = 0; s < 2; s++) {
        o0 = __builtin_amdgcn_mfma_f32_32x32x16_bf16(pf[s], vf0[s], o0, 0, 0, 0);
        o1 = __builtin_amdgcn_mfma_f32_32x32x16_bf16(pf[s], vf1[s], o1, 0, 0, 0);
      }
      __builtin_amdgcn_sched_barrier(0); asm volatile("s_nop 15\n\ts_nop 15" ::: "memory"); __builtin_amdgcn_sched_barrier(0);
      if (__all(R < -110.f)) break;
    }
    float sq[16];
#pragma unroll
    for (int r = 0; r < 16; r++) {
      float v = o0[r] * o0[r] + o1[r] * o1[r];
#pragma unroll
      for (int o = 16; o > 0; o >>= 1) v += __shfl_xor(v, o, 64);
      sq[r] = v;
    }
    __syncthreads();
    if (n == 0) {
#pragma unroll
      for (int r = 0; r < 16; r++) ssq[wave * 32 + (r & 3) + 8 * (r >> 2) + 4 * hh] = sq[r];
    }
    __syncthreads();
    if (tid < 32) {
      float t = 0.f;
#pragma unroll
      for (int w = 0; w < 8; w++) t += ssq[w * 32 + tid];
      rstd[tid] = rsqrtf(t * (1.0f / 512.f) + EPSF);
    }
    __syncthreads();
#pragma unroll
    for (int r = 0; r < 16; r++) {
      const int qi = (r & 3) + 8 * (r >> 2) + 4 * hh;
      const float rs = rstd[qi];
      bf16* yr = y + (tokb + q0 + qi) * DM + 256 + wave * 64 + n;
      yr[0] = (bf16)f2bf(o0[r] * rs * g0);
      yr[32] = (bf16)f2bf(o1[r] * rs * g1);
    }
  }
}

#define SSM_BCAST_U(u, ua, ub, tt) do { \
    const unsigned w0 = (unsigned)__builtin_amdgcn_readlane((int)(ua).x, (tt)), w1 = (unsigned)__builtin_amdgcn_readlane((int)(ua).y, (tt)); \
    const unsigned w2 = (unsigned)__builtin_amdgcn_readlane((int)(ua).z, (tt)), w3 = (unsigned)__builtin_amdgcn_readlane((int)(ua).w, (tt)); \
    const unsigned w4 = (unsigned)__builtin_amdgcn_readlane((int)(ub).x, (tt)), w5 = (unsigned)__builtin_amdgcn_readlane((int)(ub).y, (tt)); \
    const unsigned w6 = (unsigned)__builtin_amdgcn_readlane((int)(ub).z, (tt)), w7 = (unsigned)__builtin_amdgcn_readlane((int)(ub).w, (tt)); \
    (u)[0] = bf_lo(w0); (u)[1] = bf_hi(w0); (u)[2] = bf_lo(w1); (u)[3] = bf_hi(w1); (u)[4] = bf_lo(w2); (u)[5] = bf_hi(w2); (u)[6] = bf_lo(w3); (u)[7] = bf_hi(w3); \
    (u)[8] = bf_lo(w4); (u)[9] = bf_hi(w4); (u)[10] = bf_lo(w5); (u)[11] = bf_hi(w5); (u)[12] = bf_lo(w6); (u)[13] = bf_hi(w6); (u)[14] = bf_lo(w7); (u)[15] = bf_hi(w7); } while (0)
__device__ __forceinline__ void ssm_chunk_end(const int wave_s, const float* ssmp, const bf16* proj, float* ssmE) {
  const int tid_ = opaque_tid(wave_s);
  const int lane = tid_ & 63;
  const int gw = blockIdx.x * NWAVES + (tid_ >> 6);
  const int nw = gridDim.x * NWAVES;
  for (int it = gw; it < 4 * 64 * 16; it += nw) {
    const int g = it & 15, c = (it >> 4) & 63, b = it >> 10;
    const int gp = g * 64 + lane;
    const uint4* up = (const uint4*)(proj + (size_t)(b * SEQ + c * 64 + lane) * DIN + 2048 + g * 16);
    const uint4 ua = up[0], ub = up[1];
    const float lbr = ssmp[gp * 2], lbi = ssmp[gp * 2 + 1];
    float bbr[16], bbi[16];
#pragma unroll
    for (int h = 0; h < 16; h++) {
      { const float2 bb = *(const float2*)(ssmp + 4096 + ((g * 16 + h) * 64 + lane) * 2); bbr[h] = bb.x; bbi[h] = bb.y; }
    }
    float xr = 0.f, xi = 0.f;
#pragma unroll 2
    for (int tt = 0; tt < 64; tt++) {
      float u[16];
      SSM_BCAST_U(u, ua, ub, tt);
      float br = 0.f, bi = 0.f;
#pragma unroll
      for (int h = 0; h < 16; h++) { br += bbr[h] * u[h]; bi += bbi[h] * u[h]; }
      const float nr = lbr * xr - lbi * xi + br;
      const float ni = lbr * xi + lbi * xr + bi;
      xr = nr; xi = ni;
    }
    float* e = ssmE + ((size_t)((b * 64 + c) * 16 + g) * 64 + lane) * 2;
    e[0] = xr; e[1] = xi;
  }
}

__device__ __forceinline__ void ssm_finish(const int wave_s, const Params& p, int l, const float* ssmp, const bf16* proj,
                           const float* ssmE, bf16* y, LAS float* smem) {
  LAS bf16* Ytb = (LAS bf16*)smem;
  LAS float* ssq2 = smem + (64 * 264 * 2) / 4;
  LAS float* rstd2 = ssq2 + 512;
  const bf16* glT = (const bf16*)(p.ws + WS_WT + (size_t)l * WT_LAYER + WT_GLU);
  const int tid = opaque_tid(wave_s), lane = tid & 63, wave = tid >> 6;
  const float* cre = karg_in(13) + (size_t)l * 16 * 16 * 64;
  const float* cim = karg_in(14) + (size_t)l * 16 * 16 * 64;
  const float* dsk = karg_in(15) + l * 256;
  const float* glw = karg_in(16) + (size_t)l * 256 * 256;
  const float* glb = karg_in(17) + l * 256;
  const float* gg = karg_in(18) + l * 1024 + 768;
  for (int it = blockIdx.x; it < 256; it += gridDim.x) {
    const int b = it >> 6, c = it & 63;
    __syncthreads();
    for (int gi = 0; gi < 2; gi++) {
      const int g = wave + gi * 8;
      const int gp = g * 64 + lane;
      const float lbr = ssmp[gp * 2], lbi = ssmp[gp * 2 + 1];
      const float lcr = ssmp[2048 + gp * 2], lci = ssmp[2048 + gp * 2 + 1];
      float bbr[16], bbi[16], ccr[16], cci[16];
#pragma unroll
      for (int h = 0; h < 16; h++) {
        { const float2 bb = *(const float2*)(ssmp + 4096 + ((g * 16 + h) * 64 + lane) * 2); bbr[h] = bb.x; bbi[h] = bb.y; }
        ccr[h] = cre[(g * 16 + h) * 64 + lane];
        cci[h] = cim[(g * 16 + h) * 64 + lane];
      }
      float xr = 0.f, xi = 0.f;
      {
        const float2* eb = (const float2*)ssmE + ((size_t)(b * 64) * 16 + g) * 64 + lane;
        int cc = 0;
        for (; cc + 8 <= c; cc += 8) {
          float2 ev[8];
#pragma unroll
          for (int k = 0; k < 8; k++) ev[k] = eb[(size_t)(cc + k) * 16 * 64];
#pragma unroll
          for (int k = 0; k < 8; k++) {
            const float nr = lcr * xr - lci * xi + ev[k].x;
            const float ni = lcr * xi + lci * xr + ev[k].y;
            xr = nr; xi = ni;
          }
        }
        for (; cc < c; cc++) {
          const float2 e1 = eb[(size_t)cc * 16 * 64];
          const float nr = lcr * xr - lci * xi + e1.x;
          const float ni = lcr * xi + lci * xr + e1.y;
          xr = nr; xi = ni;
        }
      }
      const int hq = ((lane >> 5) & 1) * 8 + ((lane >> 4) & 1) * 4 + ((lane >> 3) & 1) * 2 + ((lane >> 2) & 1);
      float dm[16];
#pragma unroll
      for (int h = 0; h < 16; h++) dm[h] = (lane == 0) ? dsk[g * 16 + h] : 0.f;
      const uint4* up = (const uint4*)(proj + (size_t)(b * SEQ + c * 64 + lane) * DIN + 2048 + g * 16);
      const uint4 ua = up[0], ub = up[1];
#pragma unroll 1
      for (int t4 = 0; t4 < 64; t4 += 4) {
        float vv[4][16];
#pragma unroll
        for (int s = 0; s < 4; s++) {
          float u[16];
          SSM_BCAST_U(u, ua, ub, t4 + s);
          float br = 0.f, bi = 0.f;
#pragma unroll
          for (int h = 0; h < 16; h++) { br += bbr[h] * u[h]; bi += bbi[h] * u[h]; }
          const float nr = lbr * xr - lbi * xi + br;
          const float ni = lbr * xi + lbi * xr + bi;
          xr = nr; xi = ni;
#pragma unroll
          for (int h = 0; h < 16; h++) vv[s][h] = xr * ccr[h] - xi * cci[h] + dm[h] * u[h];
        }
        float v1[4];
#pragma unroll
        for (int s = 0; s < 4; s++) {
          float v8[8], v4[4], v2[2];
          {
            const bool hi = (lane & 32) != 0;
#pragma unroll
            for (int i = 0; i < 8; i++) { const float send = hi ? vv[s][i] : vv[s][i + 8]; const float keep = hi ? vv[s][i + 8] : vv[s][i]; v8[i] = keep + __shfl_xor(send, 32, 64); }
          }
          {
            const bool hi = (lane & 16) != 0;
#pragma unroll
            for (int i = 0; i < 4; i++) { const float send = hi ? v8[i] : v8[i + 4]; const float keep = hi ? v8[i + 4] : v8[i]; v4[i] = keep + __shfl_xor(send, 16, 64); }
          }
          {
            const bool hi = (lane & 8) != 0;
#pragma unroll
            for (int i = 0; i < 2; i++) { const float send = hi ? v4[i] : v4[i + 2]; const float keep = hi ? v4[i + 2] : v4[i]; v2[i] = keep + __shfl_xor(send, 8, 64); }
          }
          {
            const bool hi = (lane & 4) != 0;
            const float send = hi ? v2[0] : v2[1];
            const float keep = hi ? v2[1] : v2[0];
            v1[s] = keep + __shfl_xor(send, 4, 64);
          }
          v1[s] += __shfl_xor(v1[s], 2, 64);
          v1[s] += __shfl_xor(v1[s], 1, 64);
        }
        if ((lane & 3) == 0) {
#pragma unroll
          for (int s = 0; s < 4; s++) Ytb[(t4 + s) * 264 + g * 16 + hq] = (bf16)f2bf(gelu_tanh(v1[s]));
        }
      }
    }
    __syncthreads();
    {
      const int n = lane & 31, hh = lane >> 5;
      const int ch = wave * 32 + n;
      const float bj = glb[ch];
      const float gj = gg[ch];
      bf16x8_t gf[16];
      {
        const bf16* grow = glT + (size_t)ch * 256 + 8 * hh;
#pragma unroll
        for (int ks = 0; ks < 16; ks++) gf[ks] = *(const bf16x8_t*)(grow + 16 * ks);
      }
      float oo[2][16];
#pragma unroll
      for (int mt = 0; mt < 2; mt++) {
        f32x16_t z;
#pragma unroll
        for (int r = 0; r < 16; r++) z[r] = 0.f;
        const LAS bf16* yrow = Ytb + (mt * 32 + n) * 264 + 8 * hh;
#pragma unroll
        for (int kq = 0; kq < 4; kq++) {
          bf16x8_t yf[4];
#pragma unroll
          for (int i = 0; i < 4; i++) yf[i] = *(const LAS bf16x8_t*)(yrow + 16 * (kq * 4 + i));
          MFMA_PAD();
#pragma unroll
          for (int i = 0; i < 4; i++) z = __builtin_amdgcn_mfma_f32_32x32x16_bf16(yf[i], gf[kq * 4 + i], z, 0, 0, 0);
          MFMA_PAD();
        }
        float sq[16];
#pragma unroll
        for (int r = 0; r < 16; r++) {
          const int t = mt * 32 + (r & 3) + 8 * (r >> 2) + 4 * hh;
          const float yv = bf2f(Ytb[t * 264 + ch]);
          const float o = yv * sigmoidf_(z[r] + bj);
          oo[mt][r] = o;
          float v = o * o;
#pragma unroll
          for (int s = 16; s > 0; s >>= 1) v += __shfl_xor(v, s, 64);
          sq[r] = v;
        }
        if (n == 0) {
#pragma unroll
          for (int r = 0; r < 16; r++) ssq2[wave * 64 + mt * 32 + (r & 3) + 8 * (r >> 2) + 4 * hh] = sq[r];
        }
      }
      __syncthreads();
      if (tid < 64) {
        float t = 0.f;
#pragma unroll
        for (int w = 0; w < 8; w++) t += ssq2[w * 64 + tid];
        rstd2[tid] = rsqrtf(t * (1.0f / 256.f) + EPSF);
      }
      __syncthreads();
#pragma unroll
      for (int mt = 0; mt < 2; mt++)
#pragma unroll
        for (int r = 0; r < 16; r++) {
          const int t = mt * 32 + (r & 3) + 8 * (r >> 2) + 4 * hh;
          y[(size_t)(b * SEQ + c * 64 + t) * DM + 768 + ch] = (bf16)f2bf(oo[mt][r] * rstd2[t] * gj);
        }
    }
  }
}

__device__ __forceinline__ void memattn_phase(const int wave_s, const bf16* q, const bf16* kvb, const bf16* vT, bf16* o, LAS float* smem) {
  const int tid_ = opaque_tid(wave_s);
  const int lane = tid_ & 63, n = lane & 31, hh = lane >> 5, wave = tid_ >> 6;
  const int sig = (n & 0x13) | ((n & 4) << 1) | ((n & 8) >> 1);
  LAS bf16* Ls = (LAS bf16*)smem;
  for (int it = blockIdx.x; it < 64 * 4; it += gridDim.x) {
    const int h = it & 3, tg = it >> 2, b = tg >> 4;
    const int tok0 = (tg * 8 + wave) * 32;
    __syncthreads();
    {
      const int r = tid_ >> 1, hf = tid_ & 1;
      const pg8::u32x4* src4 = (const pg8::u32x4*)(kvb + (size_t)(b * NMEM + r) * 2048 + h * 256 + hf * 128);
      LAS pg8::u32x4* dst4 = (LAS pg8::u32x4*)(Ls + r * 264 + hf * 128);
#pragma unroll
      for (int k = 0; k < 16; k++) dst4[k] = src4[k];
    }
    f32x16_t st[8];
#pragma unroll
    for (int kt = 0; kt < 8; kt++)
#pragma unroll
      for (int r = 0; r < 16; r++) st[kt][r] = 0.f;
    const bf16* qrow = q + (size_t)(tok0 + n) * DM + h * 256 + 8 * hh;
    __syncthreads();
#pragma unroll
    for (int kq = 0; kq < 4; kq++) {
      bf16x8_t qf[4];
#pragma unroll
      for (int i = 0; i < 4; i++) qf[i] = *(const bf16x8_t*)(qrow + 16 * (kq * 4 + i));
#pragma unroll
      for (int kt = 0; kt < 8; kt++) {
        const LAS bf16* krow = Ls + (kt * 32 + sig) * 264 + 8 * hh;
        bf16x8_t kf[4];
#pragma unroll
        for (int i = 0; i < 4; i++) kf[i] = *(const LAS bf16x8_t*)(krow + 16 * (kq * 4 + i));
        MFMA_PAD();
#pragma unroll
        for (int i = 0; i < 4; i++) st[kt] = __builtin_amdgcn_mfma_f32_32x32x16_bf16(kf[i], qf[i], st[kt], 0, 0, 0);
        MFMA_PAD();
      }
    }
    float mx = st[0][0];
#pragma unroll
    for (int kt = 0; kt < 8; kt++)
#pragma unroll
      for (int r = 0; r < 16; r++) mx = fmaxf(mx, st[kt][r]);
    mx = fmaxf(mx, __shfl_xor(mx, 32, 64));
    float sum = 0.f;
#pragma unroll
    for (int kt = 0; kt < 8; kt++)
#pragma unroll
      for (int r = 0; r < 16; r++) { const float e = __expf((st[kt][r] - mx) * 0.0625f); st[kt][r] = e; sum += e; }
    sum += __shfl_xor(sum, 32, 64);
    const float inv = 1.0f / sum;
    bf16x8_t pf[8][2];
#pragma unroll
    for (int kt = 0; kt < 8; kt++)
#pragma unroll
      for (int s = 0; s < 2; s++)
#pragma unroll
        for (int j = 0; j < 8; j++) pf[kt][s][j] = (short)f2bf(st[kt][8 * s + j] * inv);
    __syncthreads();
    {
      const int r = tid_ >> 1, hf = tid_ & 1;
      const pg8::u32x4* src4 = (const pg8::u32x4*)(vT + ((size_t)(b * 4 + h) * 256 + r) * 256 + hf * 128);
      LAS pg8::u32x4* dst4 = (LAS pg8::u32x4*)(Ls + r * 264 + hf * 128);
#pragma unroll
      for (int k = 0; k < 16; k++) dst4[k] = src4[k];
    }
    __syncthreads();
#pragma unroll 1
    for (int dt = 0; dt < 8; dt++) {
      f32x16_t oacc;
#pragma unroll
      for (int r = 0; r < 16; r++) oacc[r] = 0.f;
      const LAS bf16* vrow = Ls + (dt * 32 + n) * 264 + 8 * hh;
#pragma unroll
      for (int kq = 0; kq < 4; kq++) {
        bf16x8_t vf[4];
#pragma unroll
        for (int i = 0; i < 4; i++) vf[i] = *(const LAS bf16x8_t*)(vrow + (kq * 2 + (i >> 1)) * 32 + 16 * (i & 1));
        MFMA_PAD();
#pragma unroll
        for (int i = 0; i < 4; i++) oacc = __builtin_amdgcn_mfma_f32_32x32x16_bf16(pf[kq * 2 + (i >> 1)][i & 1], vf[i], oacc, 0, 0, 0);
        MFMA_PAD();
      }
#pragma unroll
      for (int r = 0; r < 16; r++) {
        const int qi = (r & 3) + 8 * (r >> 2) + 4 * hh;
        o[(size_t)(tok0 + qi) * DM + h * 256 + dt * 32 + n] = (bf16)f2bf(oacc[r]);
      }
    }
  }
}

__device__ __forceinline__ void vt_phase(const int wave_s, const bf16* kvb, bf16* vT) {
  const int tid_ = opaque_tid(wave_s);
  const int gt = blockIdx.x * (NWAVES * 64) + tid_;
  const int nth = gridDim.x * NWAVES * 64;
  for (int i = gt; i < 2 * 4 * 4 * 256 * 256; i += nth) {
    const int m = i & 255, d = (i >> 8) & 255, h = (i >> 16) & 3, b = (i >> 18) & 3, l = i >> 20;
    vT[i] = kvb[((size_t)l * 1024 + b * 256 + m) * 2048 + 1024 + h * 256 + d];
  }
}

template <unsigned MASK>
__device__ __forceinline__ float pack_key(float s, unsigned idx) {
  const unsigned u = __builtin_bit_cast(unsigned, s);
  const unsigned tag = ((int)u < 0) ? idx : (MASK - idx);
  return __builtin_bit_cast(float, (u & ~MASK) + tag);
}
template <unsigned MASK>
__device__ __forceinline__ unsigned key_idx(float k) {
  const unsigned u = __builtin_bit_cast(unsigned, k);
  const unsigned tag = u & MASK;
  return ((int)u < 0) ? tag : (MASK - tag);
}
template <unsigned MASK>
__device__ __forceinline__ float key_val(float k) { return __builtin_bit_cast(float, __builtin_bit_cast(unsigned, k) & ~MASK); }
__device__ __forceinline__ void top16_of_64(float (&K)[64]) {
  { const float a_ = K[0], b_ = K[1]; const bool g_ = a_ > b_; K[0] = g_ ? a_ : b_; K[1] = g_ ? b_ : a_; }
  { const float a_ = K[2], b_ = K[3]; const bool g_ = a_ > b_; K[2] = g_ ? b_ : a_; K[3] = g_ ? a_ : b_; }
  { const float a_ = K[4], b_ = K[5]; const bool g_ = a_ > b_; K[4] = g_ ? a_ : b_; K[5] = g_ ? b_ : a_; }
  { const float a_ = K[6], b_ = K[7]; const bool g_ = a_ > b_; K[6] = g_ ? b_ : a_; K[7] = g_ ? a_ : b_; }
  { const float a_ = K[8], b_ = K[9]; const bool g_ = a_ > b_; K[8] = g_ ? a_ : b_; K[9] = g_ ? b_ : a_; }
  { const float a_ = K[10], b_ = K[11]; const bool g_ = a_ > b_; K[10] = g_ ? b_ : a_; K[11] = g_ ? a_ : b_; }
  { const float a_ = K[12], b_ = K[13]; const bool g_ = a_ > b_; K[12] = g_ ? a_ : b_; K[13] = g_ ? b_ : a_; }
  { const float a_ = K[14], b_ = K[15]; const bool g_ = a_ > b_; K[14] = g_ ? b_ : a_; K[15] = g_ ? a_ : b_; }
  { const float a_ = K[0], b_ = K[2]; const bool g_ = a_ > b_; K[0] = g_ ? a_ : b_; K[2] = g_ ? b_ : a_; }
  { const float a_ = K[1], b_ = K[3]; const bool g_ = a_ > b_; K[1] = g_ ? a_ : b_; K[3] = g_ ? b_ : a_; }
  { const float a_ = K[4], b_ = K[6]; const bool g_ = a_ > b_; K[4] = g_ ? b_ : a_; K[6] = g_ ? a_ : b_; }
  { const float a_ = K[5], b_ = K[7]; const bool g_ = a_ > b_; K[5] = g_ ? b_ : a_; K[7] = g_ ? a_ : b_; }
  { const float a_ = K[8], b_ = K[10]; const bool g_ = a_ > b_; K[8] = g_ ? a_ : b_; K[10] = g_ ? b_ : a_; }
  { const float a_ = K[9], b_ = K[11]; const bool g_ = a_ > b_; K[9] = g_ ? a_ : b_; K[11] = g_ ? b_ : a_; }
  { const float a_ = K[12], b_ = K[14]; const bool g_ = a_ > b_; K[12] = g_ ? b_ : a_; K[14] = g_ ? a_ : b_; }
  { const float a_ = K[13], b_ = K[15]; const bool g_ = a_ > b_; K[13] = g_ ? b_ : a_; K[15] = g_ ? a_ : b_; }
  { const float a_ = K[0], b_ = K[1]; const bool g_ = a_ > b_; K[0] = g_ ? a_ : b_; K[1] = g_ ? b_ : a_; }
  { const float a_ = K[2], b_ = K[3]; const bool g_ = a_ > b_; K[2] = g_ ? a_ : b_; K[3] = g_ ? b_ : a_; }
  { const float a_ = K[4], b_ = K[5]; const bool g_ = a_ > b_; K[4] = g_ ? b_ : a_; K[5] = g_ ? a_ : b_; }
  { const float a_ = K[6], b_ = K[7]; const bool g_ = a_ > b_; K[6] = g_ ? b_ : a_; K[7] = g_ ? a_ : b_; }
  { const float a_ = K[8], b_ = K[9]; const bool g_ = a_ > b_; K[8] = g_ ? a_ : b_; K[9] = g_ ? b_ : a_; }
  { const float a_ = K[10], b_ = K[11]; const bool g_ = a_ > b_; K[10] = g_ ? a_ : b_; K[11] = g_ ? b_ : a_; }
  { const float a_ = K[12], b_ = K[13]; const bool g_ = a_ > b_; K[12] = g_ ? b_ : a_; K[13] = g_ ? a_ : b_; }
  { const float a_ = K[14], b_ = K[15]; const bool g_ = a_ > b_; K[14] = g_ ? b_ : a_; K[15] = g_ ? a_ : b_; }
  { const float a_ = K[0], b_ = K[4]; const bool g_ = a_ > b_; K[0] = g_ ? a_ : b_; K[4] = g_ ? b_ : a_; }
  { const float a_ = K[1], b_ = K[5]; const bool g_ = a_ > b_; K[1] = g_ ? a_ : b_; K[5] = g_ ? b_ : a_; }
  { const float a_ = K[2], b_ = K[6]; const bool g_ = a_ > b_; K[2] = g_ ? a_ : b_; K[6] = g_ ? b_ : a_; }
  { const float a_ = K[3], b_ = K[7]; const bool g_ = a_ > b_; K[3] = g_ ? a_ : b_; K[7] = g_ ? b_ : a_; }
  { const float a_ = K[8], b_ = K[12]; const bool g_ = a_ > b_; K[8] = g_ ? b_ : a_; K[12] = g_ ? a_ : b_; }
  { const float a_ = K[9], b_ = K[13]; const bool g_ = a_ > b_; K[9] = g_ ? b_ : a_; K[13] = g_ ? a_ : b_; }
  { const float a_ = K[10], b_ = K[14]; const bool g_ = a_ > b_; K[10] = g_ ? b_ : a_; K[14] = g_ ? a_ : b_; }
  { const float a_ = K[11], b_ = K[15]; const bool g_ = a_ > b_; K[11] = g_ ? b_ : a_; K[15] = g_ ? a_ : b_; }
  { const float a_ = K[0], b_ = K[2]; const bool g_ = a_ > b_; K[0] = g_ ? a_ : b_; K[2] = g_ ? b_ : a_; }
  { const float a_ = K[1], b_ = K[3]; const bool g_ = a_ > b_; K[1] = g_ ? a_ : b_; K[3] = g_ ? b_ : a_; }
  { const float a_ = K[4], b_ = K[6]; const bool g_ = a_ > b_; K[4] = g_ ? a_ : b_; K[6] = g_ ? b_ : a_; }
  { const float a_ = K[5], b_ = K[7]; const bool g_ = a_ > b_; K[5] = g_ ? a_ : b_; K[7] = g_ ? b_ : a_; }
  { const float a_ = K[8], b_ = K[10]; const bool g_ = a_ > b_; K[8] = g_ ? b_ : a_; K[10] = g_ ? a_ : b_; }
  { const float a_ = K[9], b_ = K[11]; const bool g_ = a_ > b_; K[9] = g_ ? b_ : a_; K[11] = g_ ? a_ : b_; }
  { const float a_ = K[12], b_ = K[14]; const bool g_ = a_ > b_; K[12] = g_ ? b_ : a_; K[14] = g_ ? a_ : b_; }
  { const float a_ = K[13], b_ = K[15]; const bool g_ = a_ > b_; K[13] = g_ ? b_ : a_; K[15] = g_ ? a_ : b_; }
  { const float a_ = K[0], b_ = K[1]; const bool g_ = a_ > b_; K[0] = g_ ? a_ : b_; K[1] = g_ ? b_ : a_; }
  { const float a_ = K[2], b_ = K[3]; const bool g_ = a_ > b_; K[2] = g_ ? a_ : b_; K[3] = g_ ? b_ : a_; }
  { const float a_ = K[4], b_ = K[5]; const bool g_ = a_ > b_; K[4] = g_ ? a_ : b_; K[5] = g_ ? b_ : a_; }
  { const float a_ = K[6], b_ = K[7]; const bool g_ = a_ > b_; K[6] = g_ ? a_ : b_; K[7] = g_ ? b_ : a_; }
  { const float a_ = K[8], b_ = K[9]; const bool g_ = a_ > b_; K[8] = g_ ? b_ : a_; K[9] = g_ ? a_ : b_; }
  { const float a_ = K[10], b_ = K[11]; const bool g_ = a_ > b_; K[10] = g_ ? b_ : a_; K[11] = g_ ? a_ : b_; }
  { const float a_ = K[12], b_ = K[13]; const bool g_ = a_ > b_; K[12] = g_ ? b_ : a_; K[13] = g_ ? a_ : b_; }
  { const float a_ = K[14], b_ = K[15]; const bool g_ = a_ > b_; K[14] = g_ ? b_ : a_; K[15] = g_ ? a_ : b_; }
  { const float a_ = K[0], b_ = K[8]; const bool g_ = a_ > b_; K[0] = g_ ? a_ : b_; K[8] = g_ ? b_ : a_; }
  { const float a_ = K[1], b_ = K[9]; const bool g_ = a_ > b_; K[1] = g_ ? a_ : b_; K[9] = g_ ? b_ : a_; }
  { const float a_ = K[2], b_ = K[10]; const bool g_ = a_ > b_; K[2] = g_ ? a_ : b_; K[10] = g_ ? b_ : a_; }
  { const float a_ = K[3], b_ = K[11]; const bool g_ = a_ > b_; K[3] = g_ ? a_ : b_; K[11] = g_ ? b_ : a_; }
  { const float a_ = K[4], b_ = K[12]; const bool g_ = a_ > b_; K[4] = g_ ? a_ : b_; K[12] = g_ ? b_ : a_; }
  { const float a_ = K[5], b_ = K[13]; const bool g_ = a_ > b_; K[5] = g_ ? a_ : b_; K[13] = g_ ? b_ : a_; }
  { const float a_ = K[6], b_ = K[14]; const bool g_ = a_ > b_; K[6] = g_ ? a_ : b_; K[14] = g_ ? b_ : a_; }
  { const float a_ = K[7], b_ = K[15]; const bool g_ = a_ > b_; K[7] = g_ ? a_ : b_; K[15] = g_ ? b_ : a_; }
  { const float a_ = K[0], b_ = K[4]; const bool g_ = a_ > b_; K[0] = g_ ? a_ : b_; K[4] = g_ ? b_ : a_; }
  { const float a_ = K[1], b_ = K[5]; const bool g_ = a_ > b_; K[1] = g_ ? a_ : b_; K[5] = g_ ? b_ : a_; }
  { const float a_ = K[2], b_ = K[6]; const bool g_ = a_ > b_; K[2] = g_ ? a_ : b_; K[6] = g_ ? b_ : a_; }
  { const float a_ = K[3], b_ = K[7]; const bool g_ = a_ > b_; K[3] = g_ ? a_ : b_; K[7] = g_ ? b_ : a_; }
  { const float a_ = K[8], b_ = K[12]; const bool g_ = a_ > b_; K[8] = g_ ? a_ : b_; K[12] = g_ ? b_ : a_; }
  { const float a_ = K[9], b_ = K[13]; const bool g_ = a_ > b_; K[9] = g_ ? a_ : b_; K[13] = g_ ? b_ : a_; }
  { const float a_ = K[10], b_ = K[14]; const bool g_ = a_ > b_; K[10] = g_ ? a_ : b_; K[14] = g_ ? b_ : a_; }
  { const float a_ = K[11], b_ = K[15]; const bool g_ = a_ > b_; K[11] = g_ ? a_ : b_; K[15] = g_ ? b_ : a_; }
  { const float a_ = K[0], b_ = K[2]; const bool g_ = a_ > b_; K[0] = g_ ? a_ : b_; K[2] = g_ ? b_ : a_; }
  { const float a_ = K[1], b_ = K[3]; const bool g_ = a_ > b_; K[1] = g_ ? a_ : b_; K[3] = g_ ? b_ : a_; }
  { const float a_ = K[4], b_ = K[6]; const bool g_ = a_ > b_; K[4] = g_ ? a_ : b_; K[6] = g_ ? b_ : a_; }
  { const float a_ = K[5], b_ = K[7]; const bool g_ = a_ > b_; K[5] = g_ ? a_ : b_; K[7] = g_ ? b_ : a_; }
  { const float a_ = K[8], b_ = K[10]; const bool g_ = a_ > b_; K[8] = g_ ? a_ : b_; K[10] = g_ ? b_ : a_; }
  { const float a_ = K[9], b_ = K[11]; const bool g_ = a_ > b_; K[9] = g_ ? a_ : b_; K[11] = g_ ? b_ : a_; }
  { const float a_ = K[12], b_ = K[14]; const bool g_ = a_ > b_; K[12] = g_ ? a_ : b_; K[14] = g_ ? b_ : a_; }
  { const float a_ = K[13], b_ = K[15]; const bool g_ = a_ > b_; K[13] = g_ ? a_ : b_; K[15] = g_ ? b_ : a_; }
  { const float a_ = K[0], b_ = K[1]; const bool g_ = a_ > b_; K[0] = g_ ? a_ : b_; K[1] = g_ ? b_ : a_; }
  { const float a_ = K[2], b_ = K[3]; const bool g_ = a_ > b_; K[2] = g_ ? a_ : b_; K[3] = g_ ? b_ : a_; }
  { const float a_ = K[4], b_ = K[5]; const bool g_ = a_ > b_; K[4] = g_ ? a_ : b_; K[5] = g_ ? b_ : a_; }
  { const float a_ = K[6], b_ = K[7]; const bool g_ = a_ > b_; K[6] = g_ ? a_ : b_; K[7] = g_ ? b_ : a_; }
  { const float a_ = K[8], b_ = K[9]; const bool g_ = a_ > b_; K[8] = g_ ? a_ : b_; K[9] = g_ ? b_ : a_; }
  { const float a_ = K[10], b_ = K[11]; const bool g_ = a_ > b_; K[10] = g_ ? a_ : b_; K[11] = g_ ? b_ : a_; }
  { const float a_ = K[12], b_ = K[13]; const bool g_ = a_ > b_; K[12] = g_ ? a_ : b_; K[13] = g_ ? b_ : a_; }
  { const float a_ = K[14], b_ = K[15]; const bool g_ = a_ > b_; K[14] = g_ ? a_ : b_; K[15] = g_ ? b_ : a_; }
  { const float a_ = K[16], b_ = K[17]; const bool g_ = a_ > b_; K[16] = g_ ? a_ : b_; K[17] = g_ ? b_ : a_; }
  { const float a_ = K[18], b_ = K[19]; const bool g_ = a_ > b_; K[18] = g_ ? b_ : a_; K[19] = g_ ? a_ : b_; }
  { const float a_ = K[20], b_ = K[21]; const bool g_ = a_ > b_; K[20] = g_ ? a_ : b_; K[21] = g_ ? b_ : a_; }
  { const float a_ = K[22], b_ = K[23]; const bool g_ = a_ > b_; K[22] = g_ ? b_ : a_; K[23] = g_ ? a_ : b_; }
  { const float a_ = K[24], b_ = K[25]; const bool g_ = a_ > b_; K[24] = g_ ? a_ : b_; K[25] = g_ ? b_ : a_; }
  { const float a_ = K[26], b_ = K[27]; const bool g_ = a_ > b_; K[26] = g_ ? b_ : a_; K[27] = g_ ? a_ : b_; }
  { const float a_ = K[28], b_ = K[29]; const bool g_ = a_ > b_; K[28] = g_ ? a_ : b_; K[29] = g_ ? b_ : a_; }
  { const float a_ = K[30], b_ = K[31]; const bool g_ = a_ > b_; K[30] = g_ ? b_ : a_; K[31] = g_ ? a_ : b_; }
  { const float a_ = K[16], b_ = K[18]; const bool g_ = a_ > b_; K[16] = g_ ? a_ : b_; K[18] = g_ ? b_ : a_; }
  { const float a_ = K[17], b_ = K[19]; const bool g_ = a_ > b_; K[17] = g_ ? a_ : b_; K[19] = g_ ? b_ : a_; }
  { const float a_ = K[20], b_ = K[22]; const bool g_ = a_ > b_; K[20] = g_ ? b_ : a_; K[22] = g_ ? a_ : b_; }
  { const float a_ = K[21], b_ = K[23]; const bool g_ = a_ > b_; K[21] = g_ ? b_ : a_; K[23] = g_ ? a_ : b_; }
  { const float a_ = K[24], b_ = K[26]; const bool g_ = a_ > b_; K[24] = g_ ? a_ : b_; K[26] = g_ ? b_ : a_; }
  { const float a_ = K[25], b_ = K[27]; const bool g_ = a_ > b_; K[25] = g_ ? a_ : b_; K[27] = g_ ? b_ : a_; }
  { const float a_ = K[28], b_ = K[30]; const bool g_ = a_ > b_; K[28] = g_ ? b_ : a_; K[30] = g_ ? a_ : b_; }
  { const float a_ = K[29], b_ = K[31]; const bool g_ = a_ > b_; K[29] = g_ ? b_ : a_; K[31] = g_ ? a_ : b_; }
  { const float a_ = K[16], b_ = K[17]; const bool g_ = a_ > b_; K[16] = g_ ? a_ : b_; K[17] = g_ ? b_ : a_; }
  { const float a_ = K[18], b_ = K[19]; const bool g_ = a_ > b_; K[18] = g_ ? a_ : b_; K[19] = g_ ? b_ : a_; }
  { const float a_ = K[20], b_ = K[21]; const bool g_ = a_ > b_; K[20] = g_ ? b_ : a_; K[21] = g_ ? a_ : b_; }
  { const float a_ = K[22], b_ = K[23]; const bool g_ = a_ > b_; K[22] = g_ ? b_ : a_; K[23] = g_ ? a_ : b_; }
  { const float a_ = K[24], b_ = K[25]; const bool g_ = a_ > b_; K[24] = g_ ? a_ : b_; K[25] = g_ ? b_ : a_; }
  { const float a_ = K[26], b_ = K[27]; const bool g_ = a_ > b_; K[26] = g_ ? a_ : b_; K[27] = g_ ? b_ : a_; }
  { const float a_ = K[28], b_ = K[29]; const bool g_ = a_ > b_; K[28] = g_ ? b_ : a_; K[29] = g_ ? a_ : b_; }
  { const float a_ = K[30], b_ = K[31]; const bool g_ = a_ > b_; K[30] = g_ ? b_ : a_; K[31] = g_ ? a_ : b_; }
  { const float a_ = K[16], b_ = K[20]; const bool g_ = a_ > b_; K[16] = g_ ? a_ : b_; K[20] = g_ ? b_ : a_; }
  { const float a_ = K[17], b_ = K[21]; const bool g_ = a_ > b_; K[17] = g_ ? a_ : b_; K[21] = g_ ? b_ : a_; }
  { const float a_ = K[18], b_ = K[22]; const bool g_ = a_ > b_; K[18] = g_ ? a_ : b_; K[22] = g_ ? b_ : a_; }
  { const float a_ = K[19], b_ = K[23]; const bool g_ = a_ > b_; K[19] = g_ ? a_ : b_; K[23] = g_ ? b_ : a_; }
  { const float a_ = K[24], b_ = K[28]; const bool g_ = a_ > b_; K[24] = g_ ? b_ : a_; K[28] = g_ ? a_ : b_; }
  { const float a_ = K[25], b_ = K[29]; const bool g_ = a_ > b_; K[25] = g_ ? b_ : a_; K[29] = g_ ? a_ : b_; }
  { const float a_ = K[26], b_ = K[30]; const bool g_ = a_ > b_; K[26] = g_ ? b_ : a_; K[30] = g_ ? a_ : b_; }
  { const float a_ = K[27], b_ = K[31]; const bool g_ = a_ > b_; K[27] = g_ ? b_ : a_; K[31] = g_ ? a_ : b_; }
  { const float a_ = K[16], b_ = K[18]; const bool g_ = a_ > b_; K[16] = g_ ? a_ : b_; K[18] = g_ ? b_ : a_; }
  { const float a_ = K[17], b_ = K[19]; const bool g_ = a_ > b_; K[17] = g_ ? a_ : b_; K[19] = g_ ? b_ : a_; }
  { const float a_ = K[20], b_ = K[22]; const bool g_ = a_ > b_; K[20] = g_ ? a_ : b_; K[22] = g_ ? b_ : a_; }
  { const float a_ = K[21], b_ = K[23]; const bool g_ = a_ > b_; K[21] = g_ ? a_ : b_; K[23] = g_ ? b_ : a_; }
  { const float a_ = K[24], b_ = K[26]; const bool g_ = a_ > b_; K[24] = g_ ? b_ : a_; K[26] = g_ ? a_ : b_; }
  { const float a_ = K[25], b_ = K[27]; const bool g_ = a_ > b_; K[25] = g_ ? b_ : a_; K[27] = g_ ? a_ : b_; }
  { const float a_ = K[28], b_ = K[30]; const bool g_ = a_ > b_; K[28] = g_ ? b_ : a_; K[30] = g_ ? a_ : b_; }
  { const float a_ = K[29], b_ = K[31]; const bool g_ = a_ > b_; K[29] = g_ ? b_ : a_; K[31] = g_ ? a_ : b_; }
  { const float a_ = K[16], b_ = K[17]; const bool g_ = a_ > b_; K[16] = g_ ? a_ : b_; K[17] = g_ ? b_ : a_; }
  { const float a_ = K[18], b_ = K[19]; const bool g_ = a_ > b_; K[18] = g_ ? a_ : b_; K[19] = g_ ? b_ : a_; }
  { const float a_ = K[20], b_ = K[21]; const bool g_ = a_ > b_; K[20] = g_ ? a_ : b_; K[21] = g_ ? b_ : a_; }
  { const float a_ = K[22], b_ = K[23]; const bool g_ = a_ > b_; K[22] = g_ ? a_ : b_; K[23] = g_ ? b_ : a_; }
  { const float a_ = K[24], b_ = K[25]; const bool g_ = a_ > b_; K[24] = g_ ? b_ : a_; K[25] = g_ ? a_ : b_; }
  { const float a_ = K[26], b_ = K[27]; const bool g_ = a_ > b_; K[26] = g_ ? b_ : a_; K[27] = g_ ? a_ : b_; }
  { const float a_ = K[28], b_ = K[29]; const bool g_ = a_ > b_; K[28] = g_ ? b_ : a_; K[29] = g_ ? a_ : b_; }
  { const float a_ = K[30], b_ = K[31]; const bool g_ = a_ > b_; K[30] = g_ ? b_ : a_; K[31] = g_ ? a_ : b_; }
  { const float a_ = K[16], b_ = K[24]; const bool g_ = a_ > b_; K[16] = g_ ? a_ : b_; K[24] = g_ ? b_ : a_; }
  { const float a_ = K[17], b_ = K[25]; const bool g_ = a_ > b_; K[17] = g_ ? a_ : b_; K[25] = g_ ? b_ : a_; }
  { const float a_ = K[18], b_ = K[26]; const bool g_ = a_ > b_; K[18] = g_ ? a_ : b_; K[26] = g_ ? b_ : a_; }
  { const float a_ = K[19], b_ = K[27]; const bool g_ = a_ > b_; K[19] = g_ ? a_ : b_; K[27] = g_ ? b_ : a_; }
  { const float a_ = K[20], b_ = K[28]; const bool g_ = a_ > b_; K[20] = g_ ? a_ : b_; K[28] = g_ ? b_ : a_; }
  { const float a_ = K[21], b_ = K[29]; const bool g_ = a_ > b_; K[21] = g_ ? a_ : b_; K[29] = g_ ? b_ : a_; }
  { const float a_ = K[22], b_ = K[30]; const bool g_ = a_ > b_; K[22] = g_ ? a_ : b_; K[30] = g_ ? b_ : a_; }
  { const float a_ = K[23], b_ = K[31]; const bool g_ = a_ > b_; K[23] = g_ ? a_ : b_; K[31] = g_ ? b_ : a_; }
  { const float a_ = K[16], b_ = K[20]; const bool g_ = a_ > b_; K[16] = g_ ? a_ : b_; K[20] = g_ ? b_ : a_; }
  { const float a_ = K[17], b_ = K[21]; const bool g_ = a_ > b_; K[17] = g_ ? a_ : b_; K[21] = g_ ? b_ : a_; }
  { const float a_ = K[18], b_ = K[22]; const bool g_ = a_ > b_; K[18] = g_ ? a_ : b_; K[22] = g_ ? b_ : a_; }
  { const float a_ = K[19], b_ = K[23]; const bool g_ = a_ > b_; K[19] = g_ ? a_ : b_; K[23] = g_ ? b_ : a_; }
  { const float a_ = K[24], b_ = K[28]; const bool g_ = a_ > b_; K[24] = g_ ? a_ : b_; K[28] = g_ ? b_ : a_; }
  { const float a_ = K[25], b_ = K[29]; const bool g_ = a_ > b_; K[25] = g_ ? a_ : b_; K[29] = g_ ? b_ : a_; }
  { const float a_ = K[26], b_ = K[30]; const bool g_ = a_ > b_; K[26] = g_ ? a_ : b_; K[30] = g_ ? b_ : a_; }
  { const float a_ = K[27], b_ = K[31]; const bool g_ = a_ > b_; K[27] = g_ ? a_ : b_; K[31] = g_ ? b_ : a_; }
  { const float a_ = K[16], b_ = K[18]; const bool g_ = a_ > b_; K[16] = g_ ? a_ : b_; K[18] = g_ ? b_ : a_; }
  { const float a_ = K[17], b_ = K[19]; const bool g_ = a_ > b_; K[17] = g_ ? a_ : b_; K[19] = g_ ? b_ : a_; }
  { const float a_ = K[20], b_ = K[22]; const bool g_ = a_ > b_; K[20] = g_ ? a_ : b_; K[22] = g_ ? b_ : a_; }
  { const float a_ = K[21], b_ = K[23]; const bool g_ = a_ > b_; K[21] = g_ ? a_ : b_; K[23] = g_ ? b_ : a_; }
  { const float a_ = K[24], b_ = K[26]; const bool g_ = a_ > b_; K[24] = g_ ? a_ : b_; K[26] = g_ ? b_ : a_; }
  { const float a_ = K[25], b_ = K[27]; const bool g_ = a_ > b_; K[25] = g_ ? a_ : b_; K[27] = g_ ? b_ : a_; }
  { const float a_ = K[28], b_ = K[30]; const bool g_ = a_ > b_; K[28] = g_ ? a_ : b_; K[30] = g_ ? b_ : a_; }
  { const float a_ = K[29], b_ = K[31]; const bool g_ = a_ > b_; K[29] = g_ ? a_ : b_; K[31] = g_ ? b_ : a_; }
  { const float a_ = K[16], b_ = K[17]; const bool g_ = a_ > b_; K[16] = g_ ? a_ : b_; K[17] = g_ ? b_ : a_; }
  { const float a_ = K[18], b_ = K[19]; const bool g_ = a_ > b_; K[18] = g_ ? a_ : b_; K[19] = g_ ? b_ : a_; }
  { const float a_ = K[20], b_ = K[21]; const bool g_ = a_ > b_; K[20] = g_ ? a_ : b_; K[21] = g_ ? b_ : a_; }
  { const float a_ = K[22], b_ = K[23]; const bool g_ = a_ > b_; K[22] = g_ ? a_ : b_; K[23] = g_ ? b_ : a_; }
  { const float a_ = K[24], b_ = K[25]; const bool g_ = a_ > b_; K[24] = g_ ? a_ : b_; K[25] = g_ ? b_ : a_; }
  { const float a_ = K[26], b_ = K[27]; const bool g_ = a_ > b_; K[26] = g_ ? a_ : b_; K[27] = g_ ? b_ : a_; }
  { const float a_ = K[28], b_ = K[29]; const bool g_ = a_ > b_; K[28] = g_ ? a_ : b_; K[29] = g_ ? b_ : a_; }
  { const float a_ = K[30], b_ = K[31]; const bool g_ = a_ > b_; K[30] = g_ ? a_ : b_; K[31] = g_ ? b_ : a_; }
  { const float a_ = K[32], b_ = K[33]; const bool g_ = a_ > b_; K[32] = g_ ? a_ : b_; K[33] = g_ ? b_ : a_; }
  { const float a_ = K[34], b_ = K[35]; const bool g_ = a_ > b_; K[34] = g_ ? b_ : a_; K[35] = g_ ? a_ : b_; }
  { const float a_ = K[36], b_ = K[37]; const bool g_ = a_ > b_; K[36] = g_ ? a_ : b_; K[37] = g_ ? b_ : a_; }
  { const float a_ = K[38], b_ = K[39]; const bool g_ = a_ > b_; K[38] = g_ ? b_ : a_; K[39] = g_ ? a_ : b_; }
  { const float a_ = K[40], b_ = K[41]; const bool g_ = a_ > b_; K[40] = g_ ? a_ : b_; K[41] = g_ ? b_ : a_; }
  { const float a_ = K[42], b_ = K[43]; const bool g_ = a_ > b_; K[42] = g_ ? b_ : a_; K[43] = g_ ? a_ : b_; }
  { const float a_ = K[44], b_ = K[45]; const bool g_ = a_ > b_; K[44] = g_ ? a_ : b_; K[45] = g_ ? b_ : a_; }
  { const float a_ = K[46], b_ = K[47]; const bool g_ = a_ > b_; K[46] = g_ ? b_ : a_; K[47] = g_ ? a_ : b_; }
  { const float a_ = K[32], b_ = K[34]; const bool g_ = a_ > b_; K[32] = g_ ? a_ : b_; K[34] = g_ ? b_ : a_; }
  { const float a_ = K[33], b_ = K[35]; const bool g_ = a_ > b_; K[33] = g_ ? a_ : b_; K[35] = g_ ? b_ : a_; }
  { const float a_ = K[36], b_ = K[38]; const bool g_ = a_ > b_; K[36] = g_ ? b_ : a_; K[38] = g_ ? a_ : b_; }
  { const float a_ = K[37], b_ = K[39]; const bool g_ = a_ > b_; K[37] = g_ ? b_ : a_; K[39] = g_ ? a_ : b_; }
  { const float a_ = K[40], b_ = K[42]; const bool g_ = a_ > b_; K[40] = g_ ? a_ : b_; K[42] = g_ ? b_ : a_; }
  { const float a_ = K[41], b_ = K[43]; const bool g_ = a_ > b_; K[41] = g_ ? a_ : b_; K[43] = g_ ? b_ : a_; }
  { const float a_ = K[44], b_ = K[46]; const bool g_ = a_ > b_; K[44] = g_ ? b_ : a_; K[46] = g_ ? a_ : b_; }
  { const float a_ = K[45], b_ = K[47]; const bool g_ = a_ > b_; K[45] = g_ ? b_ : a_; K[47] = g_ ? a_ : b_; }
  { const float a_ = K[32], b_ = K[33]; const bool g_ = a_ > b_; K[32] = g_ ? a_ : b_; K[33] = g_ ? b_ : a_; }
  { const float a_ = K[34], b_ = K[35]; const bool g_ = a_ > b_; K[34] = g_ ? a_ : b_; K[35] = g_ ? b_ : a_; }
  { const float a_ = K[36], b_ = K[37]; const bool g_ = a_ > b_; K[36] = g_ ? b_ : a_; K[37] = g_ ? a_ : b_; }
  { const float a_ = K[38], b_ = K[39]; const bool g_ = a_ > b_; K[38] = g_ ? b_ : a_; K[39] = g_ ? a_ : b_; }
  { const float a_ = K[40], b_ = K[41]; const bool g_ = a_ > b_; K[40] = g_ ? a_ : b_; K[41] = g_ ? b_ : a_; }
  { const float a_ = K[42], b_ = K[43]; const bool g_ = a_ > b_; K[42] = g_ ? a_ : b_; K[43] = g_ ? b_ : a_; }
  { const float a_ = K[44], b_ = K[45]; const bool g_ = a_ > b_; K[44] = g_ ? b_ : a_; K[45] = g_ ? a_ : b_; }
  { const float a_ = K[46], b_ = K[47]; const bool g_ = a_ > b_; K[46] = g_ ? b_ : a_; K[47] = g_ ? a_ : b_; }
  { const float a_ = K[32], b_ = K[36]; const bool g_ = a_ > b_; K[32] = g_ ? a_ : b_; K[36] = g_ ? b_ : a_; }
  { const float a_ = K[33], b_ = K[37]; const bool g_ = a_ > b_; K[33] = g_ ? a_ : b_; K[37] = g_ ? b_ : a_; }
  { const float a_ = K[34], b_ = K[38]; const bool g_ = a_ > b_; K[34] = g_ ? a_ : b_; K[38] = g_ ? b_ : a_; }
  { const float a_ = K[35], b_ = K[39]; const bool g_ = a_ > b_; K[35] = g_ ? a_ : b_; K[39] = g_ ? b_ : a_; }
  { const float a_ = K[40], b_ = K[44]; const bool g_ = a_ > b_; K[40] = g_ ? b_ : a_; K[44] = g_ ? a_ : b_; }
  { const float a_ = K[41], b_ = K[45]; const bool g_ = a_ > b_; K[41] = g_ ? b_ : a_; K[45] = g_ ? a_ : b_; }
  { const float a_ = K[42], b_ = K[46]; const bool g_ = a_ > b_; K[42] = g_ ? b_ : a_; K[46] = g_ ? a_ : b_; }
  { const float a_ = K[43], b_ = K[47]; const bool g_ = a_ > b_; K[43] = g_ ? b_ : a_; K[47] = g_ ? a_ : b_; }
  { const float a_ = K[32], b_ = K[34]; const bool g_ = a_ > b_; K[32] = g_ ? a_ : b_; K[34] = g_ ? b_ : a_; }
  { const float a_ = K[33], b_ = K[35]; const bool g_ = a_ > b_; K[33] = g_ ? a_ : b_; K[35] = g_ ? b_ : a_; }
  { const float a_ = K[36], b_ = K[38]; const bool g_ = a_ > b_; K[36] = g_ ? a_ : b_; K[38] = g_ ? b_ : a_; }
  { const float a_ = K[37], b_ = K[39]; const bool g_ = a_ > b_; K[37] = g_ ? a_ : b_; K[39] = g_ ? b_ : a_; }
  { const float a_ = K[40], b_ = K[42]; const bool g_ = a_ > b_; K[40] = g_ ? b_ : a_; K[42] = g_ ? a_ : b_; }
  { const float a_ = K[41], b_ = K[43]; const bool g_ = a_ > b_; K[41] = g_ ? b_ : a_; K[43] = g_ ? a_ : b_; }
  { const float a_ = K[44], b_ = K[46]; const bool g_ = a_ > b_; K[44] = g_ ? b_ : a_; K[46] = g_ ? a_ : b_; }
  { const float a_ = K[45], b_ = K[47]; const bool g_ = a_ > b_; K[45] = g_ ? b_ : a_; K[47] = g_ ? a_ : b_; }
  { const float a_ = K[32], b_ = K[33]; const bool g_ = a_ > b_; K[32] = g_ ? a_ : b_; K[33] = g_ ? b_ : a_; }
  { const float a_ = K[34], b_ = K[35]; const bool g_ = a_ > b_; K[34] = g_ ? a_ : b_; K[35] = g_ ? b_ : a_; }
  { const float a_ = K[36], b_ = K[37]; const bool g_ = a_ > b_; K[36] = g_ ? a_ : b_; K[37] = g_ ? b_ : a_; }
  { const float a_ = K[38], b_ = K[39]; const bool g_ = a_ > b_; K[38] = g_ ? a_ : b_; K[39] = g_ ? b_ : a_; }
  { const float a_ = K[40], b_ = K[41]; const bool g_ = a_ > b_; K[40] = g_ ? b_ : a_; K[41] = g_ ? a_ : b_; }
  { const float a_ = K[42], b_ = K[43]; const bool g_ = a_ > b_; K[42] = g_ ? b_ : a_; K[43] = g_ ? a_ : b_; }
  { const float a_ = K[44], b_ = K[45]; const bool g_ = a_ > b_; K[44] = g_ ? b_ : a_; K[45] = g_ ? a_ : b_; }
  { const float a_ = K[46], b_ = K[47]; const bool g_ = a_ > b_; K[46] = g_ ? b_ : a_; K[47] = g_ ? a_ : b_; }
  { const float a_ = K[32], b_ = K[40]; const bool g_ = a_ > b_; K[32] = g_ ? a_ : b_; K[40] = g_ ? b_ : a_; }
  { const float a_ = K[33], b_ = K[41]; const bool g_ = a_ > b_; K[33] = g_ ? a_ : b_; K[41] = g_ ? b_ : a_; }
  { const float a_ = K[34], b_ = K[42]; const bool g_ = a_ > b_; K[34] = g_ ? a_ : b_; K[42] = g_ ? b_ : a_; }
  { const float a_ = K[35], b_ = K[43]; const bool g_ = a_ > b_; K[35] = g_ ? a_ : b_; K[43] = g_ ? b_ : a_; }
  { const float a_ = K[36], b_ = K[44]; const bool g_ = a_ > b_; K[36] = g_ ? a_ : b_; K[44] = g_ ? b_ : a_; }
  { const float a_ = K[37], b_ = K[45]; const bool g_ = a_ > b_; K[37] = g_ ? a_ : b_; K[45] = g_ ? b_ : a_; }
  { const float a_ = K[38], b_ = K[46]; const bool g_ = a_ > b_; K[38] = g_ ? a_ : b_; K[46] = g_ ? b_ : a_; }
  { const float a_ = K[39], b_ = K[47]; const bool g_ = a_ > b_; K[39] = g_ ? a_ : b_; K[47] = g_ ? b_ : a_; }
  { const float a_ = K[32], b_ = K[36]; const bool g_ = a_ > b_; K[32] = g_ ? a_ : b_; K[36] = g_ ? b_ : a_; }
  { const float a_ = K[33], b_ = K[37]; const bool g_ = a_ > b_; K[33] = g_ ? a_ : b_; K[37] = g_ ? b_ : a_; }
  { const float a_ = K[34], b_ = K[38]; const bool g_ = a_ > b_; K[34] = g_ ? a_ : b_; K[38] = g_ ? b_ : a_; }
  { const float a_ = K[35], b_ = K[39]; const bool g_ = a_ > b_; K[35] = g_ ? a_ : b_; K[39] = g_ ? b_ : a_; }
  { const float a_ = K[40], b_ = K[44]; const bool g_ = a_ > b_; K[40] = g_ ? a_ : b_; K[44] = g_ ? b_ : a_; }
  { const float a_ = K[41], b_ = K[45]; const bool g_ = a_ > b_; K[41] = g_ ? a_ : b_; K[45] = g_ ? b_ : a_; }
  { const float a_ = K[42], b_ = K[46]; const bool g_ = a_ > b_; K[42] = g_ ? a_ : b_; K[46] = g_ ? b_ : a_; }
  { const float a_ = K[43], b_ = K[47]; const bool g_ = a_ > b_; K[43] = g_ ? a_ : b_; K[47] = g_ ? b_ : a_; }
  { const float a_ = K[32], b_ = K[34]; const bool g_ = a_ > b_; K[32] = g_ ? a_ : b_; K[34] = g_ ? b_ : a_; }
  { const float a_ = K[33], b_ = K[35]; const bool g_ = a_ > b_; K[33] = g_ ? a_ : b_; K[35] = g_ ? b_ : a_; }
  { const float a_ = K[36], b_ = K[38]; const bool g_ = a_ > b_; K[36] = g_ ? a_ : b_; K[38] = g_ ? b_ : a_; }
  { const float a_ = K[37], b_ = K[39]; const bool g_ = a_ > b_; K[37] = g_ ? a_ : b_; K[39] = g_ ? b_ : a_; }
  { const float a_ = K[40], b_ = K[42]; const bool g_ = a_ > b_; K[40] = g_ ? a_ : b_; K[42] = g_ ? b_ : a_; }
  { const float a_ = K[41], b_ = K[43]; const bool g_ = a_ > b_; K[41] = g_ ? a_ : b_; K[43] = g_ ? b_ : a_; }
  { const float a_ = K[44], b_ = K[46]; const bool g_ = a_ > b_; K[44] = g_ ? a_ : b_; K[46] = g_ ? b_ : a_; }
  { const float a_ = K[45], b_ = K[47]; const bool g_ = a_ > b_; K[45] = g_ ? a_ : b_; K[47] = g_ ? b_ : a_; }
  { const float a_ = K[32], b_ = K[33]; const bool g_ = a_ > b_; K[32] = g_ ? a_ : b_; K[33] = g_ ? b_ : a_; }
  { const float a_ = K[34], b_ = K[35]; const bool g_ = a_ > b_; K[34] = g_ ? a_ : b_; K[35] = g_ ? b_ : a_; }
  { const float a_ = K[36], b_ = K[37]; const bool g_ = a_ > b_; K[36] = g_ ? a_ : b_; K[37] = g_ ? b_ : a_; }
  { const float a_ = K[38], b_ = K[39]; const bool g_ = a_ > b_; K[38] = g_ ? a_ : b_; K[39] = g_ ? b_ : a_; }
  { const float a_ = K[40], b_ = K[41]; const bool g_ = a_ > b_; K[40] = g_ ? a_ : b_; K[41] = g_ ? b_ : a_; }
  { const float a_ = K[42], b_ = K[43]; const bool g_ = a_ > b_; K[42] = g_ ? a_ : b_; K[43] = g_ ? b_ : a_; }
  { const float a_ = K[44], b_ = K[45]; const bool g_ = a_ > b_; K[44] = g_ ? a_ : b_; K[45] = g_ ? b_ : a_; }
  { const float a_ = K[46], b_ = K[47]; const bool g_ = a_ > b_; K[46] = g_ ? a_ : b_; K[47] = g_ ? b_ : a_; }
  { const float a_ = K[48], b_ = K[49]; const bool g_ = a_ > b_; K[48] = g_ ? a_ : b_; K[49] = g_ ? b_ : a_; }
  { const float a_ = K[50], b_ = K[51]; const bool g_ = a_ > b_; K[50] = g_ ? b_ : a_; K[51] = g_ ? a_ : b_; }
  { const float a_ = K[52], b_ = K[53]; const bool g_ = a_ > b_; K[52] = g_ ? a_ : b_; K[53] = g_ ? b_ : a_; }
  { const float a_ = K[54], b_ = K[55]; const bool g_ = a_ > b_; K[54] = g_ ? b_ : a_; K[55] = g_ ? a_ : b_; }
  { const float a_ = K[56], b_ = K[57]; const bool g_ = a_ > b_; K[56] = g_ ? a_ : b_; K[57] = g_ ? b_ : a_; }
  { const float a_ = K[58], b_ = K[59]; const bool g_ = a_ > b_; K[58] = g_ ? b_ : a_; K[59] = g_ ? a_ : b_; }
  { const float a_ = K[60], b_ = K[61]; const bool g_ = a_ > b_; K[60] = g_ ? a_ : b_; K[61] = g_ ? b_ : a_; }
  { const float a_ = K[62], b_ = K[63]; const bool g_ = a_ > b_; K[62] = g_ ? b_ : a_; K[63] = g_ ? a_ : b_; }
  { const float a_ = K[48], b_ = K[50]; const bool g_ = a_ > b_; K[48] = g_ ? a_ : b_; K[50] = g_ ? b_ : a_; }
  { const float a_ = K[49], b_ = K[51]; const bool g_ = a_ > b_; K[49] = g_ ? a_ : b_; K[51] = g_ ? b_ : a_; }
  { const float a_ = K[52], b_ = K[54]; const bool g_ = a_ > b_; K[52] = g_ ? b_ : a_; K[54] = g_ ? a_ : b_; }
  { const float a_ = K[53], b_ = K[55]; const bool g_ = a_ > b_; K[53] = g_ ? b_ : a_; K[55] = g_ ? a_ : b_; }
  { const float a_ = K[56], b_ = K[58]; const bool g_ = a_ > b_; K[56] = g_ ? a_ : b_; K[58] = g_ ? b_ : a_; }
  { const float a_ = K[57], b_ = K[59]; const bool g_ = a_ > b_; K[57] = g_ ? a_ : b_; K[59] = g_ ? b_ : a_; }
  { const float a_ = K[60], b_ = K[62]; const bool g_ = a_ > b_; K[60] = g_ ? b_ : a_; K[62] = g_ ? a_ : b_; }
  { const float a_ = K[61], b_ = K[63]; const bool g_ = a_ > b_; K[61] = g_ ? b_ : a_; K[63] = g_ ? a_ : b_; }
  { const float a_ = K[48], b_ = K[49]; const bool g_ = a_ > b_; K[48] = g_ ? a_ : b_; K[49] = g_ ? b_ : a_; }
  { const float a_ = K[50], b_ = K[51]; const bool g_ = a_ > b_; K[50] = g_ ? a_ : b_; K[51] = g_ ? b_ : a_; }
  { const float a_ = K[52], b_ = K[53]; const bool g_ = a_ > b_; K[52] = g_ ? b_ : a_; K[53] = g_ ? a_ : b_; }
  { const float a_ = K[54], b_ = K[55]; const bool g_ = a_ > b_; K[54] = g_ ? b_ : a_; K[55] = g_ ? a_ : b_; }
  { const float a_ = K[56], b_ = K[57]; const bool g_ = a_ > b_; K[56] = g_ ? a_ : b_; K[57] = g_ ? b_ : a_; }
  { const float a_ = K[58], b_ = K[59]; const bool g_ = a_ > b_; K[58] = g_ ? a_ : b_; K[59] = g_ ? b_ : a_; }
  { const float a_ = K[60], b_ = K[61]; const bool g_ = a_ > b_; K[60] = g_ ? b_ : a_; K[61] = g_ ? a_ : b_; }
  { const float a_ = K[62], b_ = K[63]; const bool g_ = a_ > b_; K[62] = g_ ? b_ : a_; K[63] = g_ ? a_ : b_; }
  { const float a_ = K[48], b_ = K[52]; const bool g_ = a_ > b_; K[48] = g_ ? a_ : b_; K[52] = g_ ? b_ : a_; }
  { const float a_ = K[49], b_ = K[53]; const bool g_ = a_ > b_; K[49] = g_ ? a_ : b_; K[53] = g_ ? b_ : a_; }
  { const float a_ = K[50], b_ = K[54]; const bool g_ = a_ > b_; K[50] = g_ ? a_ : b_; K[54] = g_ ? b_ : a_; }
  { const float a_ = K[51], b_ = K[55]; const bool g_ = a_ > b_; K[51] = g_ ? a_ : b_; K[55] = g_ ? b_ : a_; }
  { const float a_ = K[56], b_ = K[60]; const bool g_ = a_ > b_; K[56] = g_ ? b_ : a_; K[60] = g_ ? a_ : b_; }
  { const float a_ = K[57], b_ = K[61]; const bool g_ = a_ > b_; K[57] = g_ ? b_ : a_; K[61] = g_ ? a_ : b_; }
  { const float a_ = K[58], b_ = K[62]; const bool g_ = a_ > b_; K[58] = g_ ? b_ : a_; K[62] = g_ ? a_ : b_; }
  { const float a_ = K[59], b_ = K[63]; const bool g_ = a_ > b_; K[59] = g_ ? b_ : a_; K[63] = g_ ? a_ : b_; }
  { const float a_ = K[48], b_ = K[50]; const bool g_ = a_ > b_; K[48] = g_ ? a_ : b_; K[50] = g_ ? b_ : a_; }
  { const float a_ = K[49], b_ = K[51]; const bool g_ = a_ > b_; K[49] = g_ ? a_ : b_; K[51] = g_ ? b_ : a_; }
  { const float a_ = K[52], b_ = K[54]; const bool g_ = a_ > b_; K[52] = g_ ? a_ : b_; K[54] = g_ ? b_ : a_; }
  { const float a_ = K[53], b_ = K[55]; const bool g_ = a_ > b_; K[53] = g_ ? a_ : b_; K[55] = g_ ? b_ : a_; }
  { const float a_ = K[56], b_ = K[58]; const bool g_ = a_ > b_; K[56] = g_ ? b_ : a_; K[58] = g_ ? a_ : b_; }
  { const float a_ = K[57], b_ = K[59]; const bool g_ = a_ > b_; K[57] = g_ ? b_ : a_; K[59] = g_ ? a_ : b_; }
  { const float a_ = K[60], b_ = K[62]; const bool g_ = a_ > b_; K[60] = g_ ? b_ : a_; K[62] = g_ ? a_ : b_; }
  { const float a_ = K[61], b_ = K[63]; const bool g_ = a_ > b_; K[61] = g_ ? b_ : a_; K[63] = g_ ? a_ : b_; }
  { const float a_ = K[48], b_ = K[49]; const bool g_ = a_ > b_; K[48] = g_ ? a_ : b_; K[49] = g_ ? b_ : a_; }
  { const float a_ = K[50], b_ = K[51]; const bool g_ = a_ > b_; K[50] = g_ ? a_ : b_; K[51] = g_ ? b_ : a_; }
  { const float a_ = K[52], b_ = K[53]; const bool g_ = a_ > b_; K[52] = g_ ? a_ : b_; K[53] = g_ ? b_ : a_; }
  { const float a_ = K[54], b_ = K[55]; const bool g_ = a_ > b_; K[54] = g_ ? a_ : b_; K[55] = g_ ? b_ : a_; }
  { const float a_ = K[56], b_ = K[57]; const bool g_ = a_ > b_; K[56] = g_ ? b_ : a_; K[57] = g_ ? a_ : b_; }
  { const float a_ = K[58], b_ = K[59]; const bool g_ = a_ > b_; K[58] = g_ ? b_ : a_; K[59] = g_ ? a_ : b_; }
  { const float a_ = K[60], b_ = K[61]; const bool g_ = a_ > b_; K[60] = g_ ? b_ : a_; K[61] = g_ ? a_ : b_; }
  { const float a_ = K[62], b_ = K[63]; const bool g_ = a_ > b_; K[62] = g_ ? b_ : a_; K[63] = g_ ? a_ : b_; }
  { const float a_ = K[48], b_ = K[56]; const bool g_ = a_ > b_; K[48] = g_ ? a_ : b_; K[56] = g_ ? b_ : a_; }
  { const float a_ = K[49], b_ = K[57]; const bool g_ = a_ > b_; K[49] = g_ ? a_ : b_; K[57] = g_ ? b_ : a_; }
  { const float a_ = K[50], b_ = K[58]; const bool g_ = a_ > b_; K[50] = g_ ? a_ : b_; K[58] = g_ ? b_ : a_; }
  { const float a_ = K[51], b_ = K[59]; const bool g_ = a_ > b_; K[51] = g_ ? a_ : b_; K[59] = g_ ? b_ : a_; }
  { const float a_ = K[52], b_ = K[60]; const bool g_ = a_ > b_; K[52] = g_ ? a_ : b_; K[60] = g_ ? b_ : a_; }
  { const float a_ = K[53], b_ = K[61]; const bool g_ = a_ > b_; K[53] = g_ ? a_ : b_; K[61] = g_ ? b_ : a_; }
  { const float a_ = K[54], b_ = K[62]; const bool g_ = a_ > b_; K[54] = g_ ? a_ : b_; K[62] = g_ ? b_ : a_; }
  { const float a_ = K[55], b_ = K[63]; const bool g_ = a_ > b_; K[55] = g_ ? a_ : b_; K[63] = g_ ? b_ : a_; }
  { const float a_ = K[48], b_ = K[52]; const bool g_ = a_ > b_; K[48] = g_ ? a_ : b_; K[52] = g_ ? b_ : a_; }
  { const float a_ = K[49], b_ = K[53]; const bool g_ = a_ > b_; K[49] = g_ ? a_ : b_; K[53] = g_ ? b_ : a_; }
  { const float a_ = K[50], b_ = K[54]; const bool g_ = a_ > b_; K[50] = g_ ? a_ : b_; K[54] = g_ ? b_ : a_; }
  { const float a_ = K[51], b_ = K[55]; const bool g_ = a_ > b_; K[51] = g_ ? a_ : b_; K[55] = g_ ? b_ : a_; }
  { const float a_ = K[56], b_ = K[60]; const bool g_ = a_ > b_; K[56] = g_ ? a_ : b_; K[60] = g_ ? b_ : a_; }
  { const float a_ = K[57], b_ = K[61]; const bool g_ = a_ > b_; K[57] = g_ ? a_ : b_; K[61] = g_ ? b_ : a_; }
  { const float a_ = K[58], b_ = K[62]; const bool g_ = a_ > b_; K[58] = g_ ? a_ : b_; K[62] = g_ ? b_ : a_; }
  { const float a_ = K[59], b_ = K[63]; const bool g_ = a_ > b_; K[59] = g_ ? a_ : b_; K[63] = g_ ? b_ : a_; }
  { const float a_ = K[48], b_ = K[50]; const bool g_ = a_ > b_; K[48] = g_ ? a_ : b_; K[50] = g_ ? b_ : a_; }
  { const float a_ = K[49], b_ = K[51]; const bool g_ = a_ > b_; K[49] = g_ ? a_ : b_; K[51] = g_ ? b_ : a_; }
  { const float a_ = K[52], b_ = K[54]; const bool g_ = a_ > b_; K[52] = g_ ? a_ : b_; K[54] = g_ ? b_ : a_; }
  { const float a_ = K[53], b_ = K[55]; const bool g_ = a_ > b_; K[53] = g_ ? a_ : b_; K[55] = g_ ? b_ : a_; }
  { const float a_ = K[56], b_ = K[58]; const bool g_ = a_ > b_; K[56] = g_ ? a_ : b_; K[58] = g_ ? b_ : a_; }
  { const float a_ = K[57], b_ = K[59]; const bool g_ = a_ > b_; K[57] = g_ ? a_ : b_; K[59] = g_ ? b_ : a_; }
  { const float a_ = K[60], b_ = K[62]; const bool g_ = a_ > b_; K[60] = g_ ? a_ : b_; K[62] = g_ ? b_ : a_; }
  { const float a_ = K[61], b_ = K[63]; const bool g_ = a_ > b_; K[61] = g_ ? a_ : b_; K[63] = g_ ? b_ : a_; }
  { const float a_ = K[48], b_ = K[49]; const bool g_ = a_ > b_; K[48] = g_ ? a_ : b_; K[49] = g_ ? b_ : a_; }
  { const float a_ = K[50], b_ = K[51]; const bool g_ = a_ > b_; K[50] = g_ ? a_ : b_; K[51] = g_ ? b_ : a_; }
  { const float a_ = K[52], b_ = K[53]; const bool g_ = a_ > b_; K[52] = g_ ? a_ : b_; K[53] = g_ ? b_ : a_; }
  { const float a_ = K[54], b_ = K[55]; const bool g_ = a_ > b_; K[54] = g_ ? a_ : b_; K[55] = g_ ? b_ : a_; }
  { const float a_ = K[56], b_ = K[57]; const bool g_ = a_ > b_; K[56] = g_ ? a_ : b_; K[57] = g_ ? b_ : a_; }
  { const float a_ = K[58], b_ = K[59]; const bool g_ = a_ > b_; K[58] = g_ ? a_ : b_; K[59] = g_ ? b_ : a_; }
  { const float a_ = K[60], b_ = K[61]; const bool g_ = a_ > b_; K[60] = g_ ? a_ : b_; K[61] = g_ ? b_ : a_; }
  { const float a_ = K[62], b_ = K[63]; const bool g_ = a_ > b_; K[62] = g_ ? a_ : b_; K[63] = g_ ? b_ : a_; }
  { const float a_ = K[0], b_ = K[31]; K[0] = a_ > b_ ? a_ : b_; }
  { const float a_ = K[1], b_ = K[30]; K[1] = a_ > b_ ? a_ : b_; }
  { const float a_ = K[2], b_ = K[29]; K[2] = a_ > b_ ? a_ : b_; }
  { const float a_ = K[3], b_ = K[28]; K[3] = a_ > b_ ? a_ : b_; }
  { const float a_ = K[4], b_ = K[27]; K[4] = a_ > b_ ? a_ : b_; }
  { const float a_ = K[5], b_ = K[26]; K[5] = a_ > b_ ? a_ : b_; }
  { const float a_ = K[6], b_ = K[25]; K[6] = a_ > b_ ? a_ : b_; }
  { const float a_ = K[7], b_ = K[24]; K[7] = a_ > b_ ? a_ : b_; }
  { const float a_ = K[8], b_ = K[23]; K[8] = a_ > b_ ? a_ : b_; }
  { const float a_ = K[9], b_ = K[22]; K[9] = a_ > b_ ? a_ : b_; }
  { const float a_ = K[10], b_ = K[21]; K[10] = a_ > b_ ? a_ : b_; }
  { const float a_ = K[11], b_ = K[20]; K[11] = a_ > b_ ? a_ : b_; }
  { const float a_ = K[12], b_ = K[19]; K[12] = a_ > b_ ? a_ : b_; }
  { const float a_ = K[13], b_ = K[18]; K[13] = a_ > b_ ? a_ : b_; }
  { const float a_ = K[14], b_ = K[17]; K[14] = a_ > b_ ? a_ : b_; }
  { const float a_ = K[15], b_ = K[16]; K[15] = a_ > b_ ? a_ : b_; }
  { const float a_ = K[0], b_ = K[8]; const bool g_ = a_ > b_; K[0] = g_ ? a_ : b_; K[8] = g_ ? b_ : a_; }
  { const float a_ = K[1], b_ = K[9]; const bool g_ = a_ > b_; K[1] = g_ ? a_ : b_; K[9] = g_ ? b_ : a_; }
  { const float a_ = K[2], b_ = K[10]; const bool g_ = a_ > b_; K[2] = g_ ? a_ : b_; K[10] = g_ ? b_ : a_; }
  { const float a_ = K[3], b_ = K[11]; const bool g_ = a_ > b_; K[3] = g_ ? a_ : b_; K[11] = g_ ? b_ : a_; }
  { const float a_ = K[4], b_ = K[12]; const bool g_ = a_ > b_; K[4] = g_ ? a_ : b_; K[12] = g_ ? b_ : a_; }
  { const float a_ = K[5], b_ = K[13]; const bool g_ = a_ > b_; K[5] = g_ ? a_ : b_; K[13] = g_ ? b_ : a_; }
  { const float a_ = K[6], b_ = K[14]; const bool g_ = a_ > b_; K[6] = g_ ? a_ : b_; K[14] = g_ ? b_ : a_; }
  { const float a_ = K[7], b_ = K[15]; const bool g_ = a_ > b_; K[7] = g_ ? a_ : b_; K[15] = g_ ? b_ : a_; }
  { const float a_ = K[0], b_ = K[4]; const bool g_ = a_ > b_; K[0] = g_ ? a_ : b_; K[4] = g_ ? b_ : a_; }
  { const float a_ = K[1], b_ = K[5]; const bool g_ = a_ > b_; K[1] = g_ ? a_ : b_; K[5] = g_ ? b_ : a_; }
  { const float a_ = K[2], b_ = K[6]; const bool g_ = a_ > b_; K[2] = g_ ? a_ : b_; K[6] = g_ ? b_ : a_; }
  { const float a_ = K[3], b_ = K[7]; const bool g_ = a_ > b_; K[3] = g_ ? a_ : b_; K[7] = g_ ? b_ : a_; }
  { const float a_ = K[8], b_ = K[12]; const bool g_ = a_ > b_; K[8] = g_ ? a_ : b_; K[12] = g_ ? b_ : a_; }
  { const float a_ = K[9], b_ = K[13]; const bool g_ = a_ > b_; K[9] = g_ ? a_ : b_; K[13] = g_ ? b_ : a_; }
  { const float a_ = K[10], b_ = K[14]; const bool g_ = a_ > b_; K[10] = g_ ? a_ : b_; K[14] = g_ ? b_ : a_; }
  { const float a_ = K[11], b_ = K[15]; const bool g_ = a_ > b_; K[11] = g_ ? a_ : b_; K[15] = g_ ? b_ : a_; }
  { const float a_ = K[0], b_ = K[2]; const bool g_ = a_ > b_; K[0] = g_ ? a_ : b_; K[2] = g_ ? b_ : a_; }
  { const float a_ = K[1], b_ = K[3]; const bool g_ = a_ > b_; K[1] = g_ ? a_ : b_; K[3] = g_ ? b_ : a_; }
  { const float a_ = K[4], b_ = K[6]; const bool g_ = a_ > b_; K[4] = g_ ? a_ : b_; K[6] = g_ ? b_ : a_; }
  { const float a_ = K[5], b_ = K[7]; const bool g_ = a_ > b_; K[5] = g_ ? a_ : b_; K[7] = g_ ? b_ : a_; }
  { const float a_ = K[8], b_ = K[10]; const bool g_ = a_ > b_; K[8] = g_ ? a_ : b_; K[10] = g_ ? b_ : a_; }
  { const float a_ = K[9], b_ = K[11]; const bool g_ = a_ > b_; K[9] = g_ ? a_ : b_; K[11] = g_ ? b_ : a_; }
  { const float a_ = K[12], b_ = K[14]; const bool g_ = a_ > b_; K[12] = g_ ? a_ : b_; K[14] = g_ ? b_ : a_; }
  { const float a_ = K[13], b_ = K[15]; const bool g_ = a_ > b_; K[13] = g_ ? a_ : b_; K[15] = g_ ? b_ : a_; }
  { const float a_ = K[0], b_ = K[1]; const bool g_ = a_ > b_; K[0] = g_ ? a_ : b_; K[1] = g_ ? b_ : a_; }
  { const float a_ = K[2], b_ = K[3]; const bool g_ = a_ > b_; K[2] = g_ ? a_ : b_; K[3] = g_ ? b_ : a_; }
  { const float a_ = K[4], b_ = K[5]; const bool g_ = a_ > b_; K[4] = g_ ? a_ : b_; K[5] = g_ ? b_ : a_; }
  { const float a_ = K[6], b_ = K[7]; const bool g_ = a_ > b_; K[6] = g_ ? a_ : b_; K[7] = g_ ? b_ : a_; }
  { const float a_ = K[8], b_ = K[9]; const bool g_ = a_ > b_; K[8] = g_ ? a_ : b_; K[9] = g_ ? b_ : a_; }
  { const float a_ = K[10], b_ = K[11]; const bool g_ = a_ > b_; K[10] = g_ ? a_ : b_; K[11] = g_ ? b_ : a_; }
  { const float a_ = K[12], b_ = K[13]; const bool g_ = a_ > b_; K[12] = g_ ? a_ : b_; K[13] = g_ ? b_ : a_; }
  { const float a_ = K[14], b_ = K[15]; const bool g_ = a_ > b_; K[14] = g_ ? a_ : b_; K[15] = g_ ? b_ : a_; }
  { const float a_ = K[32], b_ = K[63]; K[32] = a_ > b_ ? a_ : b_; }
  { const float a_ = K[33], b_ = K[62]; K[33] = a_ > b_ ? a_ : b_; }
  { const float a_ = K[34], b_ = K[61]; K[34] = a_ > b_ ? a_ : b_; }
  { const float a_ = K[35], b_ = K[60]; K[35] = a_ > b_ ? a_ : b_; }
  { const float a_ = K[36], b_ = K[59]; K[36] = a_ > b_ ? a_ : b_; }
  { const float a_ = K[37], b_ = K[58]; K[37] = a_ > b_ ? a_ : b_; }
  { const float a_ = K[38], b_ = K[57]; K[38] = a_ > b_ ? a_ : b_; }
  { const float a_ = K[39], b_ = K[56]; K[39] = a_ > b_ ? a_ : b_; }
  { const float a_ = K[40], b_ = K[55]; K[40] = a_ > b_ ? a_ : b_; }
  { const float a_ = K[41], b_ = K[54]; K[41] = a_ > b_ ? a_ : b_; }
  { const float a_ = K[42], b_ = K[53]; K[42] = a_ > b_ ? a_ : b_; }
  { const float a_ = K[43], b_ = K[52]; K[43] = a_ > b_ ? a_ : b_; }
  { const float a_ = K[44], b_ = K[51]; K[44] = a_ > b_ ? a_ : b_; }
  { const float a_ = K[45], b_ = K[50]; K[45] = a_ > b_ ? a_ : b_; }
  { const float a_ = K[46], b_ = K[49]; K[46] = a_ > b_ ? a_ : b_; }
  { const float a_ = K[47], b_ = K[48]; K[47] = a_ > b_ ? a_ : b_; }
  { const float a_ = K[32], b_ = K[40]; const bool g_ = a_ > b_; K[32] = g_ ? a_ : b_; K[40] = g_ ? b_ : a_; }
  { const float a_ = K[33], b_ = K[41]; const bool g_ = a_ > b_; K[33] = g_ ? a_ : b_; K[41] = g_ ? b_ : a_; }
  { const float a_ = K[34], b_ = K[42]; const bool g_ = a_ > b_; K[34] = g_ ? a_ : b_; K[42] = g_ ? b_ : a_; }
  { const float a_ = K[35], b_ = K[43]; const bool g_ = a_ > b_; K[35] = g_ ? a_ : b_; K[43] = g_ ? b_ : a_; }
  { const float a_ = K[36], b_ = K[44]; const bool g_ = a_ > b_; K[36] = g_ ? a_ : b_; K[44] = g_ ? b_ : a_; }
  { const float a_ = K[37], b_ = K[45]; const bool g_ = a_ > b_; K[37] = g_ ? a_ : b_; K[45] = g_ ? b_ : a_; }
  { const float a_ = K[38], b_ = K[46]; const bool g_ = a_ > b_; K[38] = g_ ? a_ : b_; K[46] = g_ ? b_ : a_; }
  { const float a_ = K[39], b_ = K[47]; const bool g_ = a_ > b_; K[39] = g_ ? a_ : b_; K[47] = g_ ? b_ : a_; }
  { const float a_ = K[32], b_ = K[36]; const bool g_ = a_ > b_; K[32] = g_ ? a_ : b_; K[36] = g_ ? b_ : a_; }
  { const float a_ = K[33], b_ = K[37]; const bool g_ = a_ > b_; K[33] = g_ ? a_ : b_; K[37] = g_ ? b_ : a_; }
  { const float a_ = K[34], b_ = K[38]; const bool g_ = a_ > b_; K[34] = g_ ? a_ : b_; K[38] = g_ ? b_ : a_; }
  { const float a_ = K[35], b_ = K[39]; const bool g_ = a_ > b_; K[35] = g_ ? a_ : b_; K[39] = g_ ? b_ : a_; }
  { const float a_ = K[40], b_ = K[44]; const bool g_ = a_ > b_; K[40] = g_ ? a_ : b_; K[44] = g_ ? b_ : a_; }
  { const float a_ = K[41], b_ = K[45]; const bool g_ = a_ > b_; K[41] = g_ ? a_ : b_; K[45] = g_ ? b_ : a_; }
  { const float a_ = K[42], b_ = K[46]; const bool g_ = a_ > b_; K[42] = g_ ? a_ : b_; K[46] = g_ ? b_ : a_; }
  { const float a_ = K[43], b_ = K[47]; const bool g_ = a_ > b_; K[43] = g_ ? a_ : b_; K[47] = g_ ? b_ : a_; }
  { const float a_ = K[32], b_ = K[34]; const bool g_ = a_ > b_; K[32] = g_ ? a_ : b_; K[34] = g_ ? b_ : a_; }
  { const float a_ = K[33], b_ = K[35]; const bool g_ = a_ > b_; K[33] = g_ ? a_ : b_; K[35] = g_ ? b_ : a_; }
  { const float a_ = K[36], b_ = K[38]; const bool g_ = a_ > b_; K[36] = g_ ? a_ : b_; K[38] = g_ ? b_ : a_; }
  { const float a_ = K[37], b_ = K[39]; const bool g_ = a_ > b_; K[37] = g_ ? a_ : b_; K[39] = g_ ? b_ : a_; }
  { const float a_ = K[40], b_ = K[42]; const bool g_ = a_ > b_; K[40] = g_ ? a_ : b_; K[42] = g_ ? b_ : a_; }
  { const float a_ = K[41], b_ = K[43]; const bool g_ = a_ > b_; K[41] = g_ ? a_ : b_; K[43] = g_ ? b_ : a_; }
  { const float a_ = K[44], b_ = K[46]; const bool g_ = a_ > b_; K[44] = g_ ? a_ : b_; K[46] = g_ ? b_ : a_; }
  { const float a_ = K[45], b_ = K[47]; const bool g_ = a_ > b_; K[45] = g_ ? a_ : b_; K[47] = g_ ? b_ : a_; }
  { const float a_ = K[32], b_ = K[33]; const bool g_ = a_ > b_; K[32] = g_ ? a_ : b_; K[33] = g_ ? b_ : a_; }
  { const float a_ = K[34], b_ = K[35]; const bool g_ = a_ > b_; K[34] = g_ ? a_ : b_; K[35] = g_ ? b_ : a_; }
  { const float a_ = K[36], b_ = K[37]; const bool g_ = a_ > b_; K[36] = g_ ? a_ : b_; K[37] = g_ ? b_ : a_; }
  { const float a_ = K[38], b_ = K[39]; const bool g_ = a_ > b_; K[38] = g_ ? a_ : b_; K[39] = g_ ? b_ : a_; }
  { const float a_ = K[40], b_ = K[41]; const bool g_ = a_ > b_; K[40] = g_ ? a_ : b_; K[41] = g_ ? b_ : a_; }
  { const float a_ = K[42], b_ = K[43]; const bool g_ = a_ > b_; K[42] = g_ ? a_ : b_; K[43] = g_ ? b_ : a_; }
  { const float a_ = K[44], b_ = K[45]; const bool g_ = a_ > b_; K[44] = g_ ? a_ : b_; K[45] = g_ ? b_ : a_; }
  { const float a_ = K[46], b_ = K[47]; const bool g_ = a_ > b_; K[46] = g_ ? a_ : b_; K[47] = g_ ? b_ : a_; }
  { const float a_ = K[0], b_ = K[47]; K[0] = a_ > b_ ? a_ : b_; }
  { const float a_ = K[1], b_ = K[46]; K[1] = a_ > b_ ? a_ : b_; }
  { const float a_ = K[2], b_ = K[45]; K[2] = a_ > b_ ? a_ : b_; }
  { const float a_ = K[3], b_ = K[44]; K[3] = a_ > b_ ? a_ : b_; }
  { const float a_ = K[4], b_ = K[43]; K[4] = a_ > b_ ? a_ : b_; }
  { const float a_ = K[5], b_ = K[42]; K[5] = a_ > b_ ? a_ : b_; }
  { const float a_ = K[6], b_ = K[41]; K[6] = a_ > b_ ? a_ : b_; }
  { const float a_ = K[7], b_ = K[40]; K[7] = a_ > b_ ? a_ : b_; }
  { const float a_ = K[8], b_ = K[39]; K[8] = a_ > b_ ? a_ : b_; }
  { const float a_ = K[9], b_ = K[38]; K[9] = a_ > b_ ? a_ : b_; }
  { const float a_ = K[10], b_ = K[37]; K[10] = a_ > b_ ? a_ : b_; }
  { const float a_ = K[11], b_ = K[36]; K[11] = a_ > b_ ? a_ : b_; }
  { const float a_ = K[12], b_ = K[35]; K[12] = a_ > b_ ? a_ : b_; }
  { const float a_ = K[13], b_ = K[34]; K[13] = a_ > b_ ? a_ : b_; }
  { const float a_ = K[14], b_ = K[33]; K[14] = a_ > b_ ? a_ : b_; }
  { const float a_ = K[15], b_ = K[32]; K[15] = a_ > b_ ? a_ : b_; }
  { const float a_ = K[0], b_ = K[8]; const bool g_ = a_ > b_; K[0] = g_ ? a_ : b_; K[8] = g_ ? b_ : a_; }
  { const float a_ = K[1], b_ = K[9]; const bool g_ = a_ > b_; K[1] = g_ ? a_ : b_; K[9] = g_ ? b_ : a_; }
  { const float a_ = K[2], b_ = K[10]; const bool g_ = a_ > b_; K[2] = g_ ? a_ : b_; K[10] = g_ ? b_ : a_; }
  { const float a_ = K[3], b_ = K[11]; const bool g_ = a_ > b_; K[3] = g_ ? a_ : b_; K[11] = g_ ? b_ : a_; }
  { const float a_ = K[4], b_ = K[12]; const bool g_ = a_ > b_; K[4] = g_ ? a_ : b_; K[12] = g_ ? b_ : a_; }
  { const float a_ = K[5], b_ = K[13]; const bool g_ = a_ > b_; K[5] = g_ ? a_ : b_; K[13] = g_ ? b_ : a_; }
  { const float a_ = K[6], b_ = K[14]; const bool g_ = a_ > b_; K[6] = g_ ? a_ : b_; K[14] = g_ ? b_ : a_; }
  { const float a_ = K[7], b_ = K[15]; const bool g_ = a_ > b_; K[7] = g_ ? a_ : b_; K[15] = g_ ? b_ : a_; }
  { const float a_ = K[0], b_ = K[4]; const bool g_ = a_ > b_; K[0] = g_ ? a_ : b_; K[4] = g_ ? b_ : a_; }
  { const float a_ = K[1], b_ = K[5]; const bool g_ = a_ > b_; K[1] = g_ ? a_ : b_; K[5] = g_ ? b_ : a_; }
  { const float a_ = K[2], b_ = K[6]; const bool g_ = a_ > b_; K[2] = g_ ? a_ : b_; K[6] = g_ ? b_ : a_; }
  { const float a_ = K[3], b_ = K[7]; const bool g_ = a_ > b_; K[3] = g_ ? a_ : b_; K[7] = g_ ? b_ : a_; }
  { const float a_ = K[8], b_ = K[12]; const bool g_ = a_ > b_; K[8] = g_ ? a_ : b_; K[12] = g_ ? b_ : a_; }
  { const float a_ = K[9], b_ = K[13]; const bool g_ = a_ > b_; K[9] = g_ ? a_ : b_; K[13] = g_ ? b_ : a_; }
  { const float a_ = K[10], b_ = K[14]; const bool g_ = a_ > b_; K[10] = g_ ? a_ : b_; K[14] = g_ ? b_ : a_; }
  { const float a_ = K[11], b_ = K[15]; const bool g_ = a_ > b_; K[11] = g_ ? a_ : b_; K[15] = g_ ? b_ : a_; }
  { const float a_ = K[0], b_ = K[2]; const bool g_ = a_ > b_; K[0] = g_ ? a_ : b_; K[2] = g_ ? b_ : a_; }
  { const float a_ = K[1], b_ = K[3]; const bool g_ = a_ > b_; K[1] = g_ ? a_ : b_; K[3] = g_ ? b_ : a_; }
  { const float a_ = K[4], b_ = K[6]; const bool g_ = a_ > b_; K[4] = g_ ? a_ : b_; K[6] = g_ ? b_ : a_; }
  { const float a_ = K[5], b_ = K[7]; const bool g_ = a_ > b_; K[5] = g_ ? a_ : b_; K[7] = g_ ? b_ : a_; }
  { const float a_ = K[8], b_ = K[10]; const bool g_ = a_ > b_; K[8] = g_ ? a_ : b_; K[10] = g_ ? b_ : a_; }
  { const float a_ = K[9], b_ = K[11]; const bool g_ = a_ > b_; K[9] = g_ ? a_ : b_; K[11] = g_ ? b_ : a_; }
  { const float a_ = K[12], b_ = K[14]; const bool g_ = a_ > b_; K[12] = g_ ? a_ : b_; K[14] = g_ ? b_ : a_; }
  { const float a_ = K[13], b_ = K[15]; const bool g_ = a_ > b_; K[13] = g_ ? a_ : b_; K[15] = g_ ? b_ : a_; }
  { const float a_ = K[0], b_ = K[1]; const bool g_ = a_ > b_; K[0] = g_ ? a_ : b_; K[1] = g_ ? b_ : a_; }
  { const float a_ = K[2], b_ = K[3]; const bool g_ = a_ > b_; K[2] = g_ ? a_ : b_; K[3] = g_ ? b_ : a_; }
  { const float a_ = K[4], b_ = K[5]; const bool g_ = a_ > b_; K[4] = g_ ? a_ : b_; K[5] = g_ ? b_ : a_; }
  { const float a_ = K[6], b_ = K[7]; const bool g_ = a_ > b_; K[6] = g_ ? a_ : b_; K[7] = g_ ? b_ : a_; }
  { const float a_ = K[8], b_ = K[9]; const bool g_ = a_ > b_; K[8] = g_ ? a_ : b_; K[9] = g_ ? b_ : a_; }
  { const float a_ = K[10], b_ = K[11]; const bool g_ = a_ > b_; K[10] = g_ ? a_ : b_; K[11] = g_ ? b_ : a_; }
  { const float a_ = K[12], b_ = K[13]; const bool g_ = a_ > b_; K[12] = g_ ? a_ : b_; K[13] = g_ ? b_ : a_; }
  { const float a_ = K[14], b_ = K[15]; const bool g_ = a_ > b_; K[14] = g_ ? a_ : b_; K[15] = g_ ? b_ : a_; }
}
__device__ __forceinline__ void merge_top16(float (&T)[16], const float (&P)[16]) {
  { const float a_ = T[0], b_ = P[15]; T[0] = a_ > b_ ? a_ : b_; }
  { const float a_ = T[1], b_ = P[14]; T[1] = a_ > b_ ? a_ : b_; }
  { const float a_ = T[2], b_ = P[13]; T[2] = a_ > b_ ? a_ : b_; }
  { const float a_ = T[3], b_ = P[12]; T[3] = a_ > b_ ? a_ : b_; }
  { const float a_ = T[4], b_ = P[11]; T[4] = a_ > b_ ? a_ : b_; }
  { const float a_ = T[5], b_ = P[10]; T[5] = a_ > b_ ? a_ : b_; }
  { const float a_ = T[6], b_ = P[9]; T[6] = a_ > b_ ? a_ : b_; }
  { const float a_ = T[7], b_ = P[8]; T[7] = a_ > b_ ? a_ : b_; }
  { const float a_ = T[8], b_ = P[7]; T[8] = a_ > b_ ? a_ : b_; }
  { const float a_ = T[9], b_ = P[6]; T[9] = a_ > b_ ? a_ : b_; }
  { const float a_ = T[10], b_ = P[5]; T[10] = a_ > b_ ? a_ : b_; }
  { const float a_ = T[11], b_ = P[4]; T[11] = a_ > b_ ? a_ : b_; }
  { const float a_ = T[12], b_ = P[3]; T[12] = a_ > b_ ? a_ : b_; }
  { const float a_ = T[13], b_ = P[2]; T[13] = a_ > b_ ? a_ : b_; }
  { const float a_ = T[14], b_ = P[1]; T[14] = a_ > b_ ? a_ : b_; }
  { const float a_ = T[15], b_ = P[0]; T[15] = a_ > b_ ? a_ : b_; }
  { const float a_ = T[0], b_ = T[8]; const bool g_ = a_ > b_; T[0] = g_ ? a_ : b_; T[8] = g_ ? b_ : a_; }
  { const float a_ = T[1], b_ = T[9]; const bool g_ = a_ > b_; T[1] = g_ ? a_ : b_; T[9] = g_ ? b_ : a_; }
  { const float a_ = T[2], b_ = T[10]; const bool g_ = a_ > b_; T[2] = g_ ? a_ : b_; T[10] = g_ ? b_ : a_; }
  { const float a_ = T[3], b_ = T[11]; const bool g_ = a_ > b_; T[3] = g_ ? a_ : b_; T[11] = g_ ? b_ : a_; }
  { const float a_ = T[4], b_ = T[12]; const bool g_ = a_ > b_; T[4] = g_ ? a_ : b_; T[12] = g_ ? b_ : a_; }
  { const float a_ = T[5], b_ = T[13]; const bool g_ = a_ > b_; T[5] = g_ ? a_ : b_; T[13] = g_ ? b_ : a_; }
  { const float a_ = T[6], b_ = T[14]; const bool g_ = a_ > b_; T[6] = g_ ? a_ : b_; T[14] = g_ ? b_ : a_; }
  { const float a_ = T[7], b_ = T[15]; const bool g_ = a_ > b_; T[7] = g_ ? a_ : b_; T[15] = g_ ? b_ : a_; }
  { const float a_ = T[0], b_ = T[4]; const bool g_ = a_ > b_; T[0] = g_ ? a_ : b_; T[4] = g_ ? b_ : a_; }
  { const float a_ = T[1], b_ = T[5]; const bool g_ = a_ > b_; T[1] = g_ ? a_ : b_; T[5] = g_ ? b_ : a_; }
  { const float a_ = T[2], b_ = T[6]; const bool g_ = a_ > b_; T[2] = g_ ? a_ : b_; T[6] = g_ ? b_ : a_; }
  { const float a_ = T[3], b_ = T[7]; const bool g_ = a_ > b_; T[3] = g_ ? a_ : b_; T[7] = g_ ? b_ : a_; }
  { const float a_ = T[8], b_ = T[12]; const bool g_ = a_ > b_; T[8] = g_ ? a_ : b_; T[12] = g_ ? b_ : a_; }
  { const float a_ = T[9], b_ = T[13]; const bool g_ = a_ > b_; T[9] = g_ ? a_ : b_; T[13] = g_ ? b_ : a_; }
  { const float a_ = T[10], b_ = T[14]; const bool g_ = a_ > b_; T[10] = g_ ? a_ : b_; T[14] = g_ ? b_ : a_; }
  { const float a_ = T[11], b_ = T[15]; const bool g_ = a_ > b_; T[11] = g_ ? a_ : b_; T[15] = g_ ? b_ : a_; }
  { const float a_ = T[0], b_ = T[2]; const bool g_ = a_ > b_; T[0] = g_ ? a_ : b_; T[2] = g_ ? b_ : a_; }
  { const float a_ = T[1], b_ = T[3]; const bool g_ = a_ > b_; T[1] = g_ ? a_ : b_; T[3] = g_ ? b_ : a_; }
  { const float a_ = T[4], b_ = T[6]; const bool g_ = a_ > b_; T[4] = g_ ? a_ : b_; T[6] = g_ ? b_ : a_; }
  { const float a_ = T[5], b_ = T[7]; const bool g_ = a_ > b_; T[5] = g_ ? a_ : b_; T[7] = g_ ? b_ : a_; }
  { const float a_ = T[8], b_ = T[10]; const bool g_ = a_ > b_; T[8] = g_ ? a_ : b_; T[10] = g_ ? b_ : a_; }
  { const float a_ = T[9], b_ = T[11]; const bool g_ = a_ > b_; T[9] = g_ ? a_ : b_; T[11] = g_ ? b_ : a_; }
  { const float a_ = T[12], b_ = T[14]; const bool g_ = a_ > b_; T[12] = g_ ? a_ : b_; T[14] = g_ ? b_ : a_; }
  { const float a_ = T[13], b_ = T[15]; const bool g_ = a_ > b_; T[13] = g_ ? a_ : b_; T[15] = g_ ? b_ : a_; }
  { const float a_ = T[0], b_ = T[1]; const bool g_ = a_ > b_; T[0] = g_ ? a_ : b_; T[1] = g_ ? b_ : a_; }
  { const float a_ = T[2], b_ = T[3]; const bool g_ = a_ > b_; T[2] = g_ ? a_ : b_; T[3] = g_ ? b_ : a_; }
  { const float a_ = T[4], b_ = T[5]; const bool g_ = a_ > b_; T[4] = g_ ? a_ : b_; T[5] = g_ ? b_ : a_; }
  { const float a_ = T[6], b_ = T[7]; const bool g_ = a_ > b_; T[6] = g_ ? a_ : b_; T[7] = g_ ? b_ : a_; }
  { const float a_ = T[8], b_ = T[9]; const bool g_ = a_ > b_; T[8] = g_ ? a_ : b_; T[9] = g_ ? b_ : a_; }
  { const float a_ = T[10], b_ = T[11]; const bool g_ = a_ > b_; T[10] = g_ ? a_ : b_; T[11] = g_ ? b_ : a_; }
  { const float a_ = T[12], b_ = T[13]; const bool g_ = a_ > b_; T[12] = g_ ? a_ : b_; T[13] = g_ ? b_ : a_; }
  { const float a_ = T[14], b_ = T[15]; const bool g_ = a_ > b_; T[14] = g_ ? a_ : b_; T[15] = g_ ? b_ : a_; }
}

__device__ __forceinline__ void peer_topk(const int wave_s, const bf16* pq, const bf16* skb, int* ids, float* gates, LAS float* smem) {
  const int tid_ = opaque_tid(wave_s);
  const int lane = tid_ & 63, n = lane & 31, hh = lane >> 5, wave = tid_ >> 6;
  const int gw = blockIdx.x * NWAVES + wave;
  const int nw = gridDim.x * NWAVES;
  LAS float* lk = smem + wave * 2048;
  for (int it = gw; it < 512 * 8; it += nw) {
    const int h = it & 7, tok0 = (it >> 3) * 32;
#pragma unroll 1
    for (int half = 0; half < 2; half++) {
      bf16x8_t qf[8];
      {
        const bf16* qrow = pq + (size_t)(tok0 + n) * 2048 + h * 256 + half * 128 + 8 * hh;
#pragma unroll
        for (int ks = 0; ks < 8; ks++) qf[ks] = *(const bf16x8_t*)(qrow + 16 * ks);
      }
      float K[64];
#pragma unroll
      for (int kt = 0; kt < 4; kt++) {
        const bf16* krow = skb + ((size_t)((h * 2 + half) * 128 + kt * 32 + n)) * 128 + 8 * hh;
        f32x16_t acc;
#pragma unroll
        for (int r = 0; r < 16; r++) acc[r] = 0.f;
#pragma unroll
        for (int kq = 0; kq < 2; kq++) {
          bf16x8_t kf[4];
#pragma unroll
          for (int i = 0; i < 4; i++) kf[i] = *(const bf16x8_t*)(krow + 16 * (kq * 4 + i));
          MFMA_PAD();
#pragma unroll
          for (int i = 0; i < 4; i++) acc = __builtin_amdgcn_mfma_f32_32x32x16_bf16(kf[i], qf[kq * 4 + i], acc, 0, 0, 0);
          MFMA_PAD();
        }
#pragma unroll
        for (int i = 0; i < 16; i++) K[kt * 16 + i] = pack_key<0x7Fu>(acc[i], (unsigned)(kt * 32 + (i & 3) + 8 * (i >> 2) + 4 * hh));
      }
      __builtin_amdgcn_sched_barrier(0);
      top16_of_64(K);
      __builtin_amdgcn_sched_barrier(0);
      float T[16], P[16];
#pragma unroll
      for (int i = 0; i < 16; i++) { T[i] = K[i]; P[i] = __shfl_xor(K[i], 32, 64); }
      merge_top16(T, P);
#pragma unroll
      for (int i = 0; i < 16; i++) lk[(half * 16 + i) * 64 + lane] = T[i];
      __builtin_amdgcn_sched_barrier(0);
    }
    float f0[16], f1[16];
    int ti0[16], ti1[16];
#pragma unroll
    for (int i = 0; i < 16; i++) {
      const float k0 = lk[i * 64 + lane], k1 = lk[(16 + i) * 64 + lane];
      f0[i] = key_val<0x7Fu>(k0); ti0[i] = (int)key_idx<0x7Fu>(k0);
      f1[i] = key_val<0x7Fu>(k1); ti1[i] = (int)key_idx<0x7Fu>(k1);
    }
    float K[64];
    {
    K[0] = pack_key<0xFFu>(f0[0] + f1[0], 0u);
    K[1] = pack_key<0xFFu>(f0[0] + f1[1], 1u);
    K[2] = pack_key<0xFFu>(f0[0] + f1[2], 2u);
    K[3] = pack_key<0xFFu>(f0[0] + f1[3], 3u);
    K[4] = pack_key<0xFFu>(f0[0] + f1[4], 4u);
    K[5] = pack_key<0xFFu>(f0[0] + f1[5], 5u);
    K[6] = pack_key<0xFFu>(f0[0] + f1[6], 6u);
    K[7] = pack_key<0xFFu>(f0[0] + f1[7], 7u);
    K[8] = pack_key<0xFFu>(f0[0] + f1[8], 8u);
    K[9] = pack_key<0xFFu>(f0[0] + f1[9], 9u);
    K[10] = pack_key<0xFFu>(f0[0] + f1[10], 10u);
    K[11] = pack_key<0xFFu>(f0[0] + f1[11], 11u);
    K[12] = pack_key<0xFFu>(f0[0] + f1[12], 12u);
    K[13] = pack_key<0xFFu>(f0[0] + f1[13], 13u);
    K[14] = pack_key<0xFFu>(f0[0] + f1[14], 14u);
    K[15] = pack_key<0xFFu>(f0[0] + f1[15], 15u);
    K[16] = pack_key<0xFFu>(f0[1] + f1[0], 16u);
    K[17] = pack_key<0xFFu>(f0[1] + f1[1], 17u);
    K[18] = pack_key<0xFFu>(f0[1] + f1[2], 18u);
    K[19] = pack_key<0xFFu>(f0[1] + f1[3], 19u);
    K[20] = pack_key<0xFFu>(f0[1] + f1[4], 20u);
    K[21] = pack_key<0xFFu>(f0[1] + f1[5], 21u);
    K[22] = pack_key<0xFFu>(f0[1] + f1[6], 22u);
    K[23] = pack_key<0xFFu>(f0[1] + f1[7], 23u);
    K[24] = pack_key<0xFFu>(f0[2] + f1[0], 32u);
    K[25] = pack_key<0xFFu>(f0[2] + f1[1], 33u);
    K[26] = pack_key<0xFFu>(f0[2] + f1[2], 34u);
    K[27] = pack_key<0xFFu>(f0[2] + f1[3], 35u);
    K[28] = pack_key<0xFFu>(f0[2] + f1[4], 36u);
    K[29] = pack_key<0xFFu>(f0[3] + f1[0], 48u);
    K[30] = pack_key<0xFFu>(f0[3] + f1[1], 49u);
    K[31] = pack_key<0xFFu>(f0[3] + f1[2], 50u);
    K[32] = pack_key<0xFFu>(f0[3] + f1[3], 51u);
    K[33] = pack_key<0xFFu>(f0[4] + f1[0], 64u);
    K[34] = pack_key<0xFFu>(f0[4] + f1[1], 65u);
    K[35] = pack_key<0xFFu>(f0[4] + f1[2], 66u);
    K[36] = pack_key<0xFFu>(f0[5] + f1[0], 80u);
    K[37] = pack_key<0xFFu>(f0[5] + f1[1], 81u);
    K[38] = pack_key<0xFFu>(f0[6] + f1[0], 96u);
    K[39] = pack_key<0xFFu>(f0[6] + f1[1], 97u);
    K[40] = pack_key<0xFFu>(f0[7] + f1[0], 112u);
    K[41] = pack_key<0xFFu>(f0[7] + f1[1], 113u);
    K[42] = pack_key<0xFFu>(f0[8] + f1[0], 128u);
    K[43] = pack_key<0xFFu>(f0[9] + f1[0], 144u);
    K[44] = pack_key<0xFFu>(f0[10] + f1[0], 160u);
    K[45] = pack_key<0xFFu>(f0[11] + f1[0], 176u);
    K[46] = pack_key<0xFFu>(f0[12] + f1[0], 192u);
    K[47] = pack_key<0xFFu>(f0[13] + f1[0], 208u);
    K[48] = pack_key<0xFFu>(f0[14] + f1[0], 224u);
    K[49] = pack_key<0xFFu>(f0[15] + f1[0], 240u);
    K[50] = -3.0e38f;
    K[51] = -3.0e38f;
    K[52] = -3.0e38f;
    K[53] = -3.0e38f;
    K[54] = -3.0e38f;
    K[55] = -3.0e38f;
    K[56] = -3.0e38f;
    K[57] = -3.0e38f;
    K[58] = -3.0e38f;
    K[59] = -3.0e38f;
    K[60] = -3.0e38f;
    K[61] = -3.0e38f;
    K[62] = -3.0e38f;
    K[63] = -3.0e38f;
    }
    __builtin_amdgcn_sched_barrier(0);
    top16_of_64(K);
    __builtin_amdgcn_sched_barrier(0);
    float bv[16];
    int be[16];
#pragma unroll
    for (int r = 0; r < 16; r++) {
      const int flat = (int)key_idx<0xFFu>(K[r]);
      const int a = flat >> 4, b = flat & 15;
      int i0 = 0, i1 = 0;
#pragma unroll
      for (int i = 0; i < 16; i++) { i0 = (a == i) ? ti0[i] : i0; i1 = (b == i) ? ti1[i] : i1; }
      be[r] = i0 * 128 + i1;
      bv[r] = key_val<0xFFu>(K[r]);
    }
    const float b0 = bv[0];
    float ge[16];
    float gsum = 0.f;
#pragma unroll
    for (int r = 0; r < 16; r++) { ge[r] = __expf(bv[r] - b0); gsum += ge[r]; }
    const float ginv = 1.0f / gsum;
    if (hh == 0) {
      int* ip = ids + (size_t)(tok0 + n) * 128 + h * 16;
      float* gp = gates + (size_t)(tok0 + n) * 128 + h * 16;
#pragma unroll
      for (int r4 = 0; r4 < 4; r4++) {
        *(int4*)(ip + 4 * r4) = make_int4(be[4 * r4], be[4 * r4 + 1], be[4 * r4 + 2], be[4 * r4 + 3]);
        *(float4*)(gp + 4 * r4) = make_float4(ge[4 * r4] * ginv, ge[4 * r4 + 1] * ginv, ge[4 * r4 + 2] * ginv, ge[4 * r4 + 3] * ginv);
      }
    }
  }
}

typedef _Float16 f16x2_t __attribute__((ext_vector_type(2)));
__device__ __forceinline__ unsigned e4m3x2_to_f16x2(unsigned w, unsigned sel) {
  return __builtin_amdgcn_perm(w, w, sel);
}
__device__ __forceinline__ float dot2h(unsigned a, unsigned b, float c) {
  return __builtin_amdgcn_fdot2(__builtin_bit_cast(f16x2_t, a), __builtin_bit_cast(f16x2_t, b), c, false);
}
__device__ __forceinline__ unsigned pack_h2(float lo, float hi) {
  f16x2_t v; v.x = (_Float16)lo; v.y = (_Float16)hi;
  return __builtin_bit_cast(unsigned, v);
}
template <bool FINAL>
__device__ __forceinline__ void peer_gather(const int wave_s, bf16* xn, const float* rst, const unsigned char* ub, const unsigned char* vb, const float* vsc,
                                            const int* ids, const float* gates, float* xw, const float* gnext, float* outp) {
  const int tid_ = opaque_tid(wave_s);
  const int lane = tid_ & 63;
  const int gw = blockIdx.x * NWAVES + (tid_ >> 6);
  const int nw = gridDim.x * NWAVES;
  const int el = ((lane >> 5) & 1) * 4 + ((lane >> 4) & 1) * 2 + ((lane >> 3) & 1);
  for (int tok = gw; tok < NT; tok += nw) {
    unsigned xh[8];
    {
      const uint4 a = *(const uint4*)(xn + (size_t)tok * DM + lane * 16);
      const uint4 b = *(const uint4*)(xn + (size_t)tok * DM + lane * 16 + 8);
      const unsigned xw_[8] = {a.x, a.y, a.z, a.w, b.x, b.y, b.z, b.w};
      const float4* sp = (const float4*)(rst + (size_t)tok * 16);
      const float4 s0 = sp[0], s1 = sp[1], s2 = sp[2], s3 = sp[3];
      const float xs = rsqrtf((((s0.x + s0.y) + (s0.z + s0.w)) + ((s1.x + s1.y) + (s1.z + s1.w)) + ((s2.x + s2.y) + (s2.z + s2.w)) + ((s3.x + s3.y) + (s3.z + s3.w))) * (1.0f / 1024.f) + EPSF);
#pragma unroll
      for (int k = 0; k < 8; k++) xh[k] = pack_h2(bf_lo(xw_[k]) * xs, bf_hi(xw_[k]) * xs);
    }
    f16x2_t acc2[8];
#pragma unroll
    for (int i = 0; i < 8; i++) acc2[i] = (f16x2_t){(_Float16)0.f, (_Float16)0.f};
#pragma unroll 1
    for (int g = 0; g < 16; g++) {
      const int idv = ids[(size_t)tok * 128 + g * 8 + (lane & 7)];
      const float gv = gates[(size_t)tok * 128 + g * 8 + el] * vsc[__builtin_amdgcn_ds_bpermute(el << 2, idv)];
      uint4 uu[8];
      uint2 vv[8];
#pragma unroll
      for (int e = 0; e < 8; e++) {
        const int id = __builtin_amdgcn_readlane(idv, e);
        uu[e] = *(const uint4*)(ub + (size_t)id * DM + lane * 16);
        vv[e] = *(const uint2*)(vb + (size_t)id * 512 + lane * 8);
      }
      float d[8];
#pragma unroll
      for (int e = 0; e < 8; e++) {
        const unsigned uw[4] = {uu[e].x, uu[e].y, uu[e].z, uu[e].w};
        float s = 0.f;
#pragma unroll
        for (int k = 0; k < 4; k++) {
          s = dot2h(e4m3x2_to_f16x2(uw[k], 0x010c000cu), xh[2 * k], s);
          s = dot2h(e4m3x2_to_f16x2(uw[k], 0x030c020cu), xh[2 * k + 1], s);
        }
        d[e] = s;
      }
      float d4[4], d2[2], d1;
      {
        const bool hi = (lane & 32) != 0;
#pragma unroll
        for (int i = 0; i < 4; i++) { const float send = hi ? d[i] : d[i + 4]; const float keep = hi ? d[i + 4] : d[i]; d4[i] = keep + __shfl_xor(send, 32, 64); }
      }
      {
        const bool hi = (lane & 16) != 0;
#pragma unroll
        for (int i = 0; i < 2; i++) { const float send = hi ? d4[i] : d4[i + 2]; const float keep = hi ? d4[i + 2] : d4[i]; d2[i] = keep + __shfl_xor(send, 16, 64); }
      }
      {
        const bool hi = (lane & 8) != 0;
        const float send = hi ? d2[0] : d2[1];
        const float keep = hi ? d2[1] : d2[0];
        d1 = keep + __shfl_xor(send, 8, 64);
      }
      d1 += __shfl_xor(d1, 4, 64);
      d1 += __shfl_xor(d1, 2, 64);
      d1 += __shfl_xor(d1, 1, 64);
      const float wl = gv * gelu_tanh(d1 * (1.0f / U_SCALE));
#pragma unroll
      for (int e = 0; e < 8; e++) {
        const float w = __builtin_bit_cast(float, __builtin_amdgcn_readlane(__builtin_bit_cast(int, wl), ((e >> 2) & 1) * 32 + ((e >> 1) & 1) * 16 + (e & 1) * 8));
        const f16x2_t w2 = __builtin_bit_cast(f16x2_t, pack_h2(w, w));
        const unsigned vw[2] = {vv[e].x, vv[e].y};
#pragma unroll
        for (int k = 0; k < 2; k++) {
          const unsigned w4 = vw[k];
          const unsigned le = __builtin_amdgcn_perm(V4_LUT_HI, V4_LUT_LO, w4 & 0x07070707u);
          const unsigned lo = __builtin_amdgcn_perm(V4_LUT_HI, V4_LUT_LO, (w4 >> 4) & 0x07070707u);
          const unsigned ee = ((w4 << 4) & 0x80808080u) | le;
          const unsigned eo = (w4 & 0x80808080u) | lo;
          const unsigned p01 = __builtin_amdgcn_perm(eo, ee, 0x040c000cu), p23 = __builtin_amdgcn_perm(eo, ee, 0x050c010cu);
          const unsigned p45 = __builtin_amdgcn_perm(eo, ee, 0x060c020cu), p67 = __builtin_amdgcn_perm(eo, ee, 0x070c030cu);
          acc2[4 * k + 0] = __builtin_elementwise_fma(__builtin_bit_cast(f16x2_t, p01), w2, acc2[4 * k + 0]);
          acc2[4 * k + 1] = __builtin_elementwise_fma(__builtin_bit_cast(f16x2_t, p23), w2, acc2[4 * k + 1]);
          acc2[4 * k + 2] = __builtin_elementwise_fma(__builtin_bit_cast(f16x2_t, p45), w2, acc2[4 * k + 2]);
          acc2[4 * k + 3] = __builtin_elementwise_fma(__builtin_bit_cast(f16x2_t, p67), w2, acc2[4 * k + 3]);
        }
      }
    }
    float acc[16];
#pragma unroll
    for (int i = 0; i < 8; i++) { acc[2 * i] = (float)acc2[i].x; acc[2 * i + 1] = (float)acc2[i].y; }
    float* xr = xw + (size_t)tok * DM + lane * 16;
    float xv[16];
    float ssq = 0.f;
#pragma unroll
    for (int c = 0; c < 4; c++) {
      float4 a0 = *(float4*)(xr + c * 4);
      a0.x += acc[c * 4 + 0]; a0.y += acc[c * 4 + 1]; a0.z += acc[c * 4 + 2]; a0.w += acc[c * 4 + 3];
      if (!FINAL) *(float4*)(xr + c * 4) = a0;
      xv[c * 4 + 0] = a0.x; xv[c * 4 + 1] = a0.y; xv[c * 4 + 2] = a0.z; xv[c * 4 + 3] = a0.w;
      ssq += a0.x * a0.x + a0.y * a0.y + a0.z * a0.z + a0.w * a0.w;
    }
    ssq = wsum(ssq);
    const float rstd = rsqrtf(ssq * (1.0f / DM) + EPSF);
    const float4* g4 = (const float4*)(gnext + lane * 16);
    if (FINAL) {
      float* op = outp + (size_t)tok * DM + lane * 16;
#pragma unroll
      for (int c = 0; c < 4; c++) {
        const float4 gq = g4[c];
        *(float4*)(op + c * 4) = make_float4(xv[c * 4] * rstd * gq.x, xv[c * 4 + 1] * rstd * gq.y, xv[c * 4 + 2] * rstd * gq.z, xv[c * 4 + 3] * rstd * gq.w);
      }
    } else {
      uint4 o0, o1;
      { const float4 ga = g4[0], gb = g4[1];
        o0.x = pk2(xv[0] * rstd * ga.x, xv[1] * rstd * ga.y); o0.y = pk2(xv[2] * rstd * ga.z, xv[3] * rstd * ga.w);
        o0.z = pk2(xv[4] * rstd * gb.x, xv[5] * rstd * gb.y); o0.w = pk2(xv[6] * rstd * gb.z, xv[7] * rstd * gb.w); }
      { const float4 ga = g4[2], gb = g4[3];
        o1.x = pk2(xv[8] * rstd * ga.x, xv[9] * rstd * ga.y); o1.y = pk2(xv[10] * rstd * ga.z, xv[11] * rstd * ga.w);
        o1.z = pk2(xv[12] * rstd * gb.x, xv[13] * rstd * gb.y); o1.w = pk2(xv[14] * rstd * gb.z, xv[15] * rstd * gb.w); }
      *(uint4*)(xn + (size_t)tok * DM + lane * 16) = o0;
      *(uint4*)(xn + (size_t)tok * DM + lane * 16 + 8) = o1;
    }
  }
}

__device__ __forceinline__ void prologue_transposes(const int wave_s, const Params& p, unsigned char* ws, LAS unsigned char* lds) {
  const int tid_ = opaque_tid(wave_s);
  const int lane = tid_ & 63, wave = tid_ >> 6;
  LAS float* scr = (LAS float*)(lds + wave * 16384);
  const int gw = blockIdx.x * NWAVES + wave, NGW = gridDim.x * NWAVES;
  constexpr int I_IN = (DM / 64) * (DIN / 32), I_SQ = (DM / 64) * (DM / 32), I_2K = (DM / 64) * (2048 / 32);
  constexpr int I_GL = (256 / 64) * (256 / 32);
  constexpr int PER_LAYER = I_IN + 3 * I_SQ + 2 * I_2K + I_GL;
  const float* w3 = karg_in(3); const float* w19 = karg_in(19); const float* w22 = karg_in(22);
  const float* w23 = karg_in(23); const float* w24 = karg_in(24); const float* w26 = karg_in(26);
  const float* w16 = karg_in(16);
  for (int it = gw; it < 2 * PER_LAYER; it += NGW) {
    const int l = it / PER_LAYER;
    int r = it % PER_LAYER;
    unsigned char* wl = ws + WS_WT + (size_t)l * WT_LAYER;
    if (r < I_IN) { transpose_item(w3 + (size_t)l * DM * DIN, DM, DIN, (bf16*)(wl + WT_IN), scr, r, lane); continue; } r -= I_IN;
    if (r < I_SQ) { transpose_item(w19 + (size_t)l * DM * DM, DM, DM, (bf16*)(wl + WT_OUT), scr, r, lane); continue; } r -= I_SQ;
    if (r < I_SQ) { transpose_item(w22 + (size_t)l * DM * DM, DM, DM, (bf16*)(wl + WT_MQ), scr, r, lane); continue; } r -= I_SQ;
    if (r < I_2K) { transpose_item(w23 + (size_t)l * DM * 2048, DM, 2048, (bf16*)(wl + WT_MKV), scr, r, lane); continue; } r -= I_2K;
    if (r < I_SQ) { transpose_item(w24 + (size_t)l * DM * DM, DM, DM, (bf16*)(wl + WT_MO), scr, r, lane); continue; } r -= I_SQ;
    if (r < I_2K) { transpose_item(w26 + (size_t)l * DM * 2048, DM, 2048, (bf16*)(wl + WT_PQ), scr, r, lane); continue; } r -= I_2K;
    transpose_item(w16 + (size_t)l * 256 * 256, 256, 256, (bf16*)(wl + WT_GLU), scr, r, lane);
  }
}

template <class T> __device__ __forceinline__ T* opq(T* p) { asm volatile("" : "+s"(p)); return p; }
__device__ __forceinline__ void cvt_rows_bf16(const int wave_s, const float* src, bf16* dst, size_t n) {
  const int tid_ = opaque_tid(wave_s);
  const size_t gt = (size_t)blockIdx.x * (NWAVES * 64) + tid_;
  const size_t nth = (size_t)gridDim.x * NWAVES * 64;
  for (size_t i = gt; i < n / 8; i += nth) {
    const float4 a = ((const float4*)src)[2 * i], b = ((const float4*)src)[2 * i + 1];
    uint4 o; o.x = pk2(a.x, a.y); o.y = pk2(a.z, a.w); o.z = pk2(b.x, b.y); o.w = pk2(b.z, b.w);
    ((uint4*)dst)[i] = o;
  }
}

__device__ __forceinline__ unsigned enc_e4m3(float x) {
  const _Float16 hf = (_Float16)x;
  const unsigned h = (unsigned)__builtin_bit_cast(unsigned short, hf);
  return ((h + 0x7Fu + ((h >> 8) & 1u)) >> 8) & 0xFFu;
}
__device__ __forceinline__ void cvt_rows_e4m3(const int wave_s, const float* src, unsigned char* dst, size_t n, float sc) {
  const int tid_ = opaque_tid(wave_s);
  const size_t gt = (size_t)blockIdx.x * (NWAVES * 64) + tid_;
  const size_t nth = (size_t)gridDim.x * NWAVES * 64;
  for (size_t i = gt; i < n / 16; i += nth) {
    unsigned w[4];
#pragma unroll
    for (int k = 0; k < 4; k++) {
      const float4 a = ((const float4*)src)[4 * i + k];
      w[k] = enc_e4m3(a.x * sc) | (enc_e4m3(a.y * sc) << 8) | (enc_e4m3(a.z * sc) << 16) | (enc_e4m3(a.w * sc) << 24);
    }
    uint4 o; o.x = w[0]; o.y = w[1]; o.z = w[2]; o.w = w[3];
    ((uint4*)dst)[i] = o;
  }
}

__device__ __forceinline__ unsigned enc_v4(float z) {
  const float az = fabsf(z);
  unsigned c = 0;
  c += az > 0.25f; c += az > 0.5f; c += az > 0.75f; c += az > 1.0625f; c += az > 1.375f; c += az > 1.75f; c += az > 2.25f;
  return c | ((__builtin_bit_cast(unsigned, z) >> 28) & 8u);
}
__device__ __forceinline__ void cvt_rows_v4(const int wave_s, const float* src, unsigned char* dst, float* sc_out, int nrows) {
  const int tid_ = opaque_tid(wave_s);
  const int lane = tid_ & 63;
  const int gw = blockIdx.x * NWAVES + (tid_ >> 6);
  const int nw = gridDim.x * NWAVES;
  for (int r = gw; r < nrows; r += nw) {
    const float4* sp = (const float4*)(src + (size_t)r * 1024 + lane * 16);
    const float4 a0 = sp[0], a1 = sp[1], a2 = sp[2], a3 = sp[3];
    const float xv[16] = {a0.x, a0.y, a0.z, a0.w, a1.x, a1.y, a1.z, a1.w, a2.x, a2.y, a2.z, a2.w, a3.x, a3.y, a3.z, a3.w};
    float ss = 0.f;
#pragma unroll
    for (int i = 0; i < 16; i++) ss += xv[i] * xv[i];
    ss = wsum(ss);
    const float sc = sqrtf(ss * (1.0f / 1024.f)) * V4_ROWSCALE;
    const float inv = sc > 0.f ? 1.0f / sc : 0.f;
    unsigned w[2] = {0u, 0u};
#pragma unroll
    for (int i = 0; i < 16; i++) w[i >> 3] |= enc_v4(xv[i] * inv) << (4 * (i & 7));
    uint2 o; o.x = w[0]; o.y = w[1];
    *(uint2*)(dst + (size_t)r * 512 + lane * 8) = o;
    if (lane == 0) sc_out[r] = sc;
  }
}

#define GEMM_F32(Aptr, Wt, Cptr, Rptr, M_, N_) do { \
    pg8::Gemm g_{opq((const bf16*)(Aptr)), opq((const bf16*)(Wt)), (M_), (N_), DM}; pg8::StaticOrder S_; S_.init((M_), (N_), (int)gridDim.x, (int)blockIdx.x); \
    pg8::EpiF32R E_{opq((float*)(Cptr)), opq((const float*)(Rptr)), (N_)}; \
    pg8::gemm_phase<pg8::EpiF32R, pg8::StaticOrder, true, true>(wave_s, ldsl, g_, S_, E_); } while (0)
#define GEMM_BF16_C(Aptr, Wt, Optr, M_, N_, C_) do { \
    pg8::Gemm g_{opq((const bf16*)(Aptr)), opq((const bf16*)(Wt)), (M_), (N_), DM}; pg8::StaticOrder S_; S_.init((M_), (N_), (int)gridDim.x, (C_)); \
    pg8::EpiBf16 E_{opq((bf16*)(Optr)), (N_)}; \
    pg8::gemm_phase<pg8::EpiBf16, pg8::StaticOrder, true, true>(wave_s, ldsl, g_, S_, E_); } while (0)
#define GEMM_BF16(Aptr, Wt, Optr, M_, N_) GEMM_BF16_C(Aptr, Wt, Optr, M_, N_, (int)blockIdx.x)
#define GEMM_F32RN(Aptr, Wt, Cptr, Rptr, XGptr, Gptr, STptr) do { \
    pg8::Gemm g_{opq((const bf16*)(Aptr)), opq((const bf16*)(Wt)), NT, DM, DM}; pg8::StaticOrder S_; S_.init(NT, DM, (int)gridDim.x, (int)blockIdx.x); \
    pg8::EpiF32RN E_{opq((float*)(Cptr)), opq((const float*)(Rptr)), DM, opq((bf16*)(XGptr)), opq((const float*)(Gptr)), opq((float*)(STptr))}; \
    pg8::gemm_phase<pg8::EpiF32RN, pg8::StaticOrder, true, true>(wave_s, ldsl, g_, S_, E_); } while (0)
#define GEMM_BF16S(Aptr, Wt, Optr, N_, STptr) do { \
    pg8::Gemm g_{opq((const bf16*)(Aptr)), opq((const bf16*)(Wt)), NT, (N_), DM}; pg8::StaticOrder S_; S_.init(NT, (N_), (int)gridDim.x, (int)blockIdx.x); \
    pg8::EpiBf16S E_{opq((bf16*)(Optr)), (N_), opq((const float*)(STptr))}; \
    pg8::gemm_phase<pg8::EpiBf16S, pg8::StaticOrder, true, true>(wave_s, ldsl, g_, S_, E_); } while (0)

__global__ void __launch_bounds__(NWAVES * 64, 2) fwd_megakernel(Params p) {
  extern __shared__ __attribute__((aligned(16))) unsigned char lds[];
  LAS unsigned char* ldsl = (LAS unsigned char*)lds;
  LAS float* smem = (LAS float*)ldsl;
  const int wave_s = __builtin_amdgcn_readfirstlane((int)(threadIdx.x >> 6));
  unsigned char* ws = p.ws;
  volatile LAS unsigned* MISC = (volatile LAS unsigned*)(ldsl + (LDS_BYTES - 256));
  if (threadIdx.x < 64) MISC[threadIdx.x] = 0u;
  __syncthreads();
  const XcdBarrier bar = xcd_barrier_post((unsigned*)(ws + WS_CTL) + 4096, MISC + 8);
  float* xw = (float*)(ws + WS_XW);
  bf16* xn = (bf16*)(ws + WS_XN);
  bf16* big = (bf16*)(ws + WS_BIG);
  bf16* y = (bf16*)(ws + WS_Y);
  bf16* memh = (bf16*)(ws + WS_MEMH);
  bf16* kvb = (bf16*)(ws + WS_KVB);
  bf16* vT = (bf16*)(ws + WS_VT);
  float* ssmE = (float*)(ws + WS_SSME);
  float* ssmp = (float*)(ws + WS_SSMP);
  int* ids = (int*)(ws + WS_IDS);
  float* gates = (float*)(ws + WS_GATE);
  bf16* skb = (bf16*)(ws + WS_SKB);
  unsigned char* ub = ws + WS_UB;
  unsigned char* vb = ws + WS_VB;
  float* rst = (float*)(ws + WS_RST);
  float* vsc = (float*)(ws + WS_VSC);

  prologue_transposes(wave_s, p, ws, ldsl);
  cvt_rows_bf16(wave_s, karg_in(27), skb, (size_t)2 * 8 * 2 * 128 * 128);
  cvt_rows_e4m3(wave_s, karg_in(28), ub, (size_t)2 * 16384 * 1024, U_SCALE);
  cvt_rows_v4(wave_s, karg_in(29), vb, vsc, 2 * 16384);
  for (int l = 0; l < 2; l++)
    rms_rows<true>(wave_s, karg_in(1), karg_in(21) + l * DM, memh + (size_t)l * 1024 * 1024, 1024);
  ssm_params(wave_s, p, ssmp);
  xcd_barrier(bar);
  for (int l = 0; l < 2; l++)
    GEMM_BF16_C(memh + (size_t)l * 1024 * 1024, ws + WS_WT + (size_t)l * WT_LAYER + WT_MKV,
              kvb + (size_t)l * 1024 * 2048, 1024, 2048, (int)((blockIdx.x + gridDim.x - 32u * (unsigned)l) % gridDim.x));

#pragma nounroll
  for (int l = 0; l < 2; l++) {
    const float* xcur = (l == 0) ? karg_in(0) : xw;
    const float* sp = ssmp + (size_t)l * SSMP_PER_LAYER;
    const unsigned char* wl = ws + WS_WT + (size_t)l * WT_LAYER;
    if (l == 0) {
      rms_rows<true>(wave_s, xcur, karg_in(2) + l * DM, xn, NT);
      xcd_barrier(bar);
    }
    GEMM_BF16(xn, wl + WT_IN, big, NT, DIN);
    xcd_barrier(bar);
    if (l == 0) vt_phase(wave_s, kvb, vT);
    ssm_chunk_end(wave_s, sp, big, ssmE);
    attn_phase(wave_s, p, l, big, y, smem);
    conv_phase(wave_s, p, l, big, y, smem);
    xcd_barrier(bar);
    ssm_finish(wave_s, p, l, sp, big, ssmE, y, smem);
    xcd_barrier(bar);
    GEMM_F32RN(y, wl + WT_OUT, xw, xcur, xn, karg_in(20) + l * DM, rst);
    xcd_barrier(bar);
    GEMM_BF16S(xn, wl + WT_MQ, big, DM, rst);
    xcd_barrier(bar);
    memattn_phase(wave_s, big, kvb + (size_t)l * 1024 * 2048, vT + (size_t)l * 4 * 4 * 256 * 256, y, smem);
    xcd_barrier(bar);
    GEMM_F32RN(y, wl + WT_MO, xw, (const float*)xw, xn, karg_in(25) + l * DM, rst);
    xcd_barrier(bar);
    GEMM_BF16S(xn, wl + WT_PQ, big, 2048, rst);
    xcd_barrier(bar);
    peer_topk(wave_s, big, skb + (size_t)l * 8 * 2 * 128 * 128, ids, gates, smem);
    xcd_barrier(bar);
    if (l == 0) {
      peer_gather<false>(wave_s, xn, rst, ub + (size_t)l * 16384 * DM, vb + (size_t)l * 16384 * 512, vsc + (size_t)l * 16384, ids, gates, xw, karg_in(2) + DM, (float*)nullptr);
      xcd_barrier(bar);
    } else {
      peer_gather<true>(wave_s, xn, rst, ub + (size_t)l * 16384 * DM, vb + (size_t)l * 16384 * 512, vsc + (size_t)l * 16384, ids, gates, xw, karg_in(30), p.out);
    }
  }
}

extern "C" void kernel_launch(void* const* d_in, const int* in_sizes, int n_in,
                              void* d_out, int out_size, void* d_ws, size_t ws_size,
                              hipStream_t stream) {
  static int grid_blocks = 0;
  if (!grid_blocks) {
    int dev = 0, cus = 0, per_cu = 0;
    (void)hipGetDevice(&dev);
    (void)hipDeviceGetAttribute(&cus, hipDeviceAttributeMultiprocessorCount, dev);
    (void)hipFuncSetAttribute((const void*)fwd_megakernel, hipFuncAttributeMaxDynamicSharedMemorySize, LDS_BYTES);
    (void)hipOccupancyMaxActiveBlocksPerMultiprocessor(&per_cu, fwd_megakernel, NWAVES * 64, LDS_BYTES);
    if (per_cu < 1) fprintf(stderr, "occupancy query reports %d blocks/CU\n", per_cu);
    grid_blocks = cus;
  }
  (void)hipMemsetAsync((char*)d_ws + WS_CTL, 0, 1 * MiB, stream);
  Params p{};
  for (int i = 0; i < 31; i++) p.in[i] = (const float*)d_in[i];
  p.out = (float*)d_out;
  p.ws = (unsigned char*)d_ws;
  void* args[] = {&p};
  hipError_t e = hipLaunchCooperativeKernel((void*)fwd_megakernel, dim3(grid_blocks), dim3(NWAVES * 64),
                                            args, LDS_BYTES, stream);
  if (e != hipSuccess)
    fprintf(stderr, "cooperative launch failed: %s (grid %d)\n", hipGetErrorString(e), grid_blocks);
}
```

```cpp
#include <hip/hip_runtime.h>
#include <hip/hip_cooperative_groups.h>
#include <cstdio>
namespace cg = cooperative_groups;

#define NT 16384
#define SEQ 4096
#define DM 1024
#define DIN 2304
#define NMEM 256
#define EPSF 1e-6f
#define NWAVES 8
#define LDS_BYTES 147456

typedef unsigned short bf16;
#define LAS __attribute__((address_space(3)))

struct Params {
  const float* in[31];
  float* out;
  unsigned char* ws;
};
typedef __attribute__((address_space(4))) const unsigned char* kaptr_t;
__device__ __forceinline__ const float* karg_in(int i) {
  kaptr_t ka = (kaptr_t)__builtin_amdgcn_kernarg_segment_ptr();
  asm volatile("" : "+s"(ka));
  return *(const float* __attribute__((address_space(4))) const*)(ka + 8 * i);
}

constexpr size_t MiB = 1u << 20;
constexpr size_t WS_CTL  = 0;
constexpr size_t WS_WT   = 1 * MiB;
constexpr size_t WT_IN = 0, WT_OUT = WT_IN + (size_t)DIN * DM * 2, WT_MQ = WT_OUT + (size_t)DM * DM * 2,
                 WT_MKV = WT_MQ + (size_t)DM * DM * 2, WT_MO = WT_MKV + (size_t)2048 * DM * 2,
                 WT_PQ = WT_MO + (size_t)DM * DM * 2, WT_GLU = WT_PQ + (size_t)2048 * DM * 2, WT_LAYER = WT_GLU + (size_t)256 * 256 * 2;
constexpr size_t WS_XW   = WS_WT + 2 * WT_LAYER;
constexpr size_t WS_XN   = WS_XW + (size_t)NT * DM * 4;
constexpr size_t WS_BIG  = WS_XN + (size_t)NT * DM * 2;
constexpr size_t WS_Y    = WS_BIG + (size_t)NT * DIN * 2;
constexpr size_t WS_MEMH = WS_Y + (size_t)NT * DM * 2;
constexpr size_t WS_KVB  = WS_MEMH + (size_t)2 * 1024 * 1024 * 2;
constexpr size_t WS_VT   = WS_KVB + (size_t)2 * 1024 * 2048 * 2;
constexpr size_t WS_SSME = WS_VT + (size_t)2 * 4 * 4 * 256 * 256 * 2;
#define SSMP_PER_LAYER (2048 + 2048 + 32768)
constexpr size_t WS_SSMP = WS_SSME + (size_t)4 * 64 * 16 * 64 * 2 * 4;
constexpr size_t WS_IDS  = WS_SSMP + (size_t)2 * SSMP_PER_LAYER * 4;
constexpr size_t WS_GATE = WS_IDS + (size_t)NT * 128 * 4;
constexpr size_t WS_SKB  = WS_GATE + (size_t)NT * 128 * 4;
constexpr size_t WS_UB   = WS_SKB + (size_t)2 * 8 * 2 * 128 * 128 * 2;
constexpr size_t WS_VB   = WS_UB + (size_t)2 * 16384 * 1024;
constexpr size_t WS_VSC  = WS_VB + (size_t)2 * 16384 * 512;
constexpr size_t WS_RST  = WS_VSC + (size_t)2 * 16384 * 4;
constexpr size_t WS_END  = WS_RST + (size_t)NT * 16 * 4;
#define U_SCALE 64.0f
#define V4_LUT_LO 0x3B393630u
#define V4_LUT_HI 0x41403E3Du
#define V4_ROWSCALE 1.075f
static_assert(WS_END <= 512 * MiB, "workspace");
static_assert(WT_LAYER % 256 == 0 && WS_SSMP % 16 == 0 && WS_IDS % 16 == 0 && WS_SKB % 256 == 0 && WS_VT % 256 == 0, "align");

__device__ __forceinline__ int opaque_tid(int wave_s) { int v = wave_s * 64 + (int)__builtin_amdgcn_mbcnt_hi(~0u, __builtin_amdgcn_mbcnt_lo(~0u, 0u)); asm volatile("" : "+v"(v)); return v; }
__device__ __forceinline__ unsigned f2bf(float f) { unsigned u = __builtin_bit_cast(unsigned, f); return (u + 0x7fffu + ((u >> 16) & 1u)) >> 16; }
__device__ __forceinline__ unsigned pk2(float lo, float hi) { return f2bf(lo) | (f2bf(hi) << 16); }
__device__ __forceinline__ float bf_lo(unsigned u) { return __builtin_bit_cast(float, u << 16); }
__device__ __forceinline__ float bf_hi(unsigned u) { return __builtin_bit_cast(float, u & 0xffff0000u); }
__device__ __forceinline__ float bf2f(bf16 h) { return __builtin_bit_cast(float, (unsigned)h << 16); }


#define XB_TMO      128
#define XB_XCNT(j)  (256  + 64 * (j))
#define XB_XSUB(j)  (1280 + 64 * (j))
#define XB_XGEN(j)  (2304 + 64 * (j))
#define XB_TOP      3328
#define XB_TOPGEN   3392
#define XCD_BAR_WORDS 3456
#define XB_SPIN_CAP (1u << 22)
__device__ __forceinline__ unsigned xb_ld(unsigned* p)              { return __hip_atomic_load(p, __ATOMIC_RELAXED, __HIP_MEMORY_SCOPE_AGENT); }
__device__ __forceinline__ unsigned xb_add(unsigned* p, unsigned v) { return __hip_atomic_fetch_add(p, v, __ATOMIC_RELAXED, __HIP_MEMORY_SCOPE_AGENT); }
__device__ __forceinline__ unsigned xb_xcc_id() { return (unsigned)__builtin_amdgcn_s_getreg((3 << 11) | 20) & 0xFu; }
#define XB_SPIN(cond, bar) do { unsigned _sp = 0; while (cond) { __builtin_amdgcn_s_sleep(1); \
    if ((++_sp & 255u) == 0u) { if (xb_ld(&(bar)[XB_TMO])) break; if (_sp > XB_SPIN_CAP) { atomicAdd(&(bar)[XB_TMO], 1u); break; } } } } while (0)
struct XcdBarrier { unsigned* bar; unsigned x; volatile LAS unsigned* st; };
__device__ __forceinline__ XcdBarrier xcd_barrier_post(unsigned* bar, volatile LAS unsigned* st) {
    XcdBarrier b; b.bar = bar; b.x = xb_xcc_id(); b.st = st;
    if (threadIdx.x == 0) (void)xb_add(&bar[XB_XCNT(b.x)], 1u);
    return b;
}
__device__ __forceinline__ void xcd_barrier_complete(unsigned* bar, unsigned x, unsigned& nloc, unsigned& nx) {
    const unsigned G = gridDim.x * gridDim.y * gridDim.z;
    unsigned sum, cnt, mine, sp = 0u;
    for (;;) {
        sum = 0u; cnt = 0u; mine = 0u;
#pragma unroll
        for (unsigned j = 0; j < 16; ++j) { const unsigned c = xb_ld(&bar[XB_XCNT(j)]); sum += c; cnt += (c > 0u) ? 1u : 0u; mine = (j == x) ? c : mine; }
        if (sum == G) break;
        __builtin_amdgcn_s_sleep(1);
        if ((++sp & 255u) == 0u) { if (xb_ld(&bar[XB_TMO])) break; if (sp > XB_SPIN_CAP) { atomicAdd(&bar[XB_TMO], 1u); break; } }
    }
    nloc = mine > 0u ? mine : 1u; nx = cnt > 0u ? cnt : 1u;
}
__device__ __forceinline__ void xcd_barrier(const XcdBarrier& b) {
    asm volatile("s_waitcnt vmcnt(0)" ::: "memory");
    __syncthreads();
    if (threadIdx.x == 0) {
        unsigned* bar = b.bar;
        __builtin_amdgcn_s_waitcnt(0);
        unsigned nloc = b.st[0], nx = b.st[1];
        if (nloc == 0u) { xcd_barrier_complete(bar, b.x, nloc, nx); b.st[0] = nloc; b.st[1] = nx; }
        const unsigned old = xb_add(&bar[XB_XSUB(b.x)], 1u);
        const unsigned gen = old / nloc;
        if (old + 1u == (gen + 1u) * nloc) {
            __builtin_amdgcn_fence(__ATOMIC_RELEASE, "agent");
            asm volatile("s_waitcnt vmcnt(0)" ::: "memory");
            const unsigned og = xb_add(&bar[XB_TOP], 1u);
            const unsigned tg = og / nx;
            if (og + 1u == (tg + 1u) * nx) xb_add(&bar[XB_TOPGEN], 1u);
            else XB_SPIN(xb_ld(&bar[XB_TOPGEN]) == tg, bar);
            __builtin_amdgcn_fence(__ATOMIC_ACQUIRE, "agent");
            xb_add(&bar[XB_XGEN(b.x)], 1u);
            asm volatile("s_waitcnt vmcnt(0)" ::: "memory");
        } else {
            XB_SPIN(xb_ld(&bar[XB_XGEN(b.x)]) == gen, bar);
            __builtin_amdgcn_fence(__ATOMIC_ACQUIRE, "agent");
            asm volatile("s_waitcnt vmcnt(0)" ::: "memory");
        }
    }
    __syncthreads();
}

namespace pg8 {
#define PG8_LAS __attribute__((address_space(3)))
typedef unsigned short bf16_t;
typedef short bf16x8 __attribute__((ext_vector_type(8)));
typedef float f32x4 __attribute__((ext_vector_type(4)));
typedef unsigned u32x4 __attribute__((ext_vector_type(4)));
constexpr int BM = 256, BK = 64, HALF = 128, HTB = HALF * BK * 2, STAGE_BYTES = 8 * HTB, NXCD = 8, WGM = 8;
__host__ __device__ __forceinline__ int lds_byte(int r, int c) { const int st = (r >> 4) * 2 + (c >> 5), rr = r & 15, cc = c & 31, ob = rr * 64 + cc * 2; return st * 1024 + (ob ^ (((ob >> 9) & 1) << 5)); }
__host__ __device__ __forceinline__ void stage_rc(int b, int& R, int& C) { const int st = b / 1024, sb = b % 1024, swz = sb ^ (((sb >> 9) & 1) << 5); R = (st >> 1) * 16 + swz / 64; C = (st & 1) * 32 + (swz % 64) / 2; }
__host__ __device__ __forceinline__ int perm32(int rho) { const int n = rho >> 4, i = rho & 15; return 8 * (i >> 2) + 4 * n + (i & 3); }
struct Unit { int pm, pn; };
struct Gemm { const bf16_t* A; const bf16_t* Bt; int M, N, K; };
struct StaticOrder {
    int nM, nN, nwg, G, c;
    __host__ __device__ __forceinline__ void init(int M, int N, int G_, int c_) { nM = M / BM; nN = N / BM; nwg = nM * nN; G = G_; c = c_; }
    __host__ __device__ bool next(int i, Unit& u) const {
        const long L = (long)i * G + c; if (L >= nwg) return false;
        int wgid = (int)L; { const int q = nwg / NXCD, r = nwg % NXCD, xcd = wgid % NXCD, off = wgid / NXCD; wgid = (xcd < r ? xcd * (q + 1) : r * (q + 1) + (xcd - r) * q) + off; }
        const int nig = WGM * nN, gid = wgid / nig, fm = gid * WGM, gsz = (nM - fm) < WGM ? (nM - fm) : WGM;
        u.pm = fm + ((wgid % nig) % gsz); u.pn = (wgid % nig) / gsz; return true;
    }
    __device__ __forceinline__ void a_ready(const Unit&) const {}
    __device__ __forceinline__ void done(const Unit&) const {}
};
__device__ __forceinline__ unsigned cvt_pk_bf16(float lo, float hi) { unsigned r; asm volatile("v_cvt_pk_bf16_f32 %0, %1, %2" : "=v"(r) : "v"(lo), "v"(hi)); return r; }

struct EpiF32R {
    static constexpr bool PERM = false, AFTER_DRAIN = false;
    float* C; const float* R; int ldc;
    __device__ __forceinline__ void operator()(const f32x4 (&acc)[2][2][4][2], const Unit& u, int wr, int wc, int fr, int fq) const {
        const int row0 = u.pm * BM + wr * 64 + fr, col0 = u.pn * BM + wc * 32 + 4 * fq;
#pragma unroll
        for (int ai = 0; ai < 2; ++ai)
#pragma unroll
            for (int m = 0; m < 4; ++m) {
                const size_t ro = (size_t)(row0 + ai * HALF + m * 16) * ldc + col0;
                f32x4 rv[2][2];
#pragma unroll
                for (int bj = 0; bj < 2; ++bj)
#pragma unroll
                    for (int n = 0; n < 2; ++n) rv[bj][n] = R ? *(const f32x4*)(R + ro + bj * HALF + n * 16) : (f32x4){0.f, 0.f, 0.f, 0.f};
#pragma unroll
                for (int bj = 0; bj < 2; ++bj)
#pragma unroll
                    for (int n = 0; n < 2; ++n) *(f32x4*)(C + ro + bj * HALF + n * 16) = acc[ai][bj][m][n] + rv[bj][n];
                __builtin_amdgcn_sched_barrier(0);
            }
    }
};

struct EpiBf16 {
    static constexpr bool PERM = true, AFTER_DRAIN = false;
    bf16_t* O; int ldc;
    __device__ __forceinline__ void operator()(const f32x4 (&acc)[2][2][4][2], const Unit& u, int wr, int wc, int fr, int fq) const {
        const int row0 = u.pm * BM + wr * 64 + fr, col0 = u.pn * BM + wc * 32 + 8 * fq;
#pragma unroll
        for (int ai = 0; ai < 2; ++ai)
#pragma unroll
            for (int m = 0; m < 4; ++m) { bf16_t* rowp = O + (size_t)(row0 + ai * HALF + m * 16) * ldc + col0;
#pragma unroll
                for (int bj = 0; bj < 2; ++bj) { const f32x4 v0 = acc[ai][bj][m][0], v1 = acc[ai][bj][m][1];
                    u32x4 w; w.x = cvt_pk_bf16(v0[0], v0[1]); w.y = cvt_pk_bf16(v0[2], v0[3]); w.z = cvt_pk_bf16(v1[0], v1[1]); w.w = cvt_pk_bf16(v1[2], v1[3]);
                    *(u32x4*)(rowp + bj * HALF) = w; } }
    }
};

struct EpiF32RN {
    static constexpr bool PERM = false, AFTER_DRAIN = false;
    float* C; const float* R; int ldc; bf16_t* XG; const float* g; float* st;
    __device__ __forceinline__ void operator()(const f32x4 (&acc)[2][2][4][2], const Unit& u, int wr, int wc, int fr, int fq) const {
        const int row0 = u.pm * BM + wr * 64 + fr, col0 = u.pn * BM + wc * 32 + 4 * fq;
        f32x4 gv[2][2];
#pragma unroll
        for (int bj = 0; bj < 2; ++bj)
#pragma unroll
            for (int n = 0; n < 2; ++n) gv[bj][n] = *(const f32x4*)(g + col0 + bj * HALF + n * 16);
#pragma unroll
        for (int ai = 0; ai < 2; ++ai)
#pragma unroll
            for (int m = 0; m < 4; ++m) {
                const int row = row0 + ai * HALF + m * 16;
                const size_t ro = (size_t)row * ldc + col0;
                f32x4 rv[2][2];
#pragma unroll
                for (int bj = 0; bj < 2; ++bj)
#pragma unroll
                    for (int n = 0; n < 2; ++n) rv[bj][n] = *(const f32x4*)(R + ro + bj * HALF + n * 16);
                float ss = 0.f;
#pragma unroll
                for (int bj = 0; bj < 2; ++bj)
#pragma unroll
                    for (int n = 0; n < 2; ++n) {
                        const f32x4 v = acc[ai][bj][m][n] + rv[bj][n];
                        *(f32x4*)(C + ro + bj * HALF + n * 16) = v;
                        ss += (v[0] * v[0] + v[1] * v[1]) + (v[2] * v[2] + v[3] * v[3]);
                        const f32x4 w = v * gv[bj][n];
                        uint2 pk; pk.x = cvt_pk_bf16(w[0], w[1]); pk.y = cvt_pk_bf16(w[2], w[3]);
                        *(uint2*)(XG + ro + bj * HALF + n * 16) = pk;
                    }
                ss += __shfl_xor(ss, 16, 64); ss += __shfl_xor(ss, 32, 64);
                if (fq == 0) st[(size_t)row * 16 + u.pn * 4 + wc] = ss;
                __builtin_amdgcn_sched_barrier(0);
            }
    }
};
struct EpiBf16S {
    static constexpr bool PERM = true, AFTER_DRAIN = false;
    bf16_t* O; int ldc; const float* st;
    __device__ __forceinline__ void operator()(const f32x4 (&acc)[2][2][4][2], const Unit& u, int wr, int wc, int fr, int fq) const {
        const int row0 = u.pm * BM + wr * 64 + fr, col0 = u.pn * BM + wc * 32 + 8 * fq;
#pragma unroll
        for (int ai = 0; ai < 2; ++ai)
#pragma unroll
            for (int m = 0; m < 4; ++m) {
                const int row = row0 + ai * HALF + m * 16;
                const f32x4* sp = (const f32x4*)(st + (size_t)row * 16);
                const f32x4 s0 = sp[0], s1 = sp[1], s2 = sp[2], s3 = sp[3];
                const f32x4 sa = (s0 + s1) + (s2 + s3);
                const float rs = __builtin_amdgcn_rsqf(((sa[0] + sa[1]) + (sa[2] + sa[3])) * (1.0f / 1024.f) + 1e-6f);
                bf16_t* rowp = O + (size_t)row * ldc + col0;
#pragma unroll
                for (int bj = 0; bj < 2; ++bj) { const f32x4 v0 = acc[ai][bj][m][0] * rs, v1 = acc[ai][bj][m][1] * rs;
                    u32x4 w; w.x = cvt_pk_bf16(v0[0], v0[1]); w.y = cvt_pk_bf16(v0[2], v0[3]); w.z = cvt_pk_bf16(v1[0], v1[1]); w.w = cvt_pk_bf16(v1[2], v1[3]);
                    *(u32x4*)(rowp + bj * HALF) = w; }
                __builtin_amdgcn_sched_barrier(0);
            }
    }
};

template <class Epi, class Sched, bool ALIGN_EPI = false, bool SP2 = false>
__device__ __forceinline__ void gemm_phase(const int wave_s, PG8_LAS unsigned char* lds, const Gemm g, const Sched& S, const Epi& E) {
    const int tid = opaque_tid(wave_s), wid = __builtin_amdgcn_readfirstlane(tid >> 6), lane = tid & 63, wr = wid >> 2, wc = wid & 3, fr = lane & 15, fq = lane >> 4;
    const int K = g.K, nt = K / BK;
    unsigned voffA[2], voffB[2];
#pragma unroll
    for (int i = 0; i < 2; ++i) { int R, C; stage_rc(tid * 16 + i * 8192, R, C); const int Rb = Epi::PERM ? ((R & ~31) + perm32(R & 31)) : R;
        voffA[i] = (unsigned)(R * K + C) * 2u; voffB[i] = (unsigned)(Rb * K + C) * 2u; }
    const size_t kstep = (size_t)(BK * 2);
    const size_t hstep = (size_t)HALF * K * 2;
    const size_t tstep = 2 * hstep;
    const unsigned ldsw = (unsigned)wid * 1024u;
    const int aoff = lds_byte(wr * 64 + fr, fq * 8), boff = lds_byte(wc * 32 + fr, fq * 8);
#define PG8_SA(b, h) (((b) * 2 + (h)) * HTB)
#define PG8_SB(b, h) ((4 + (b) * 2 + (h)) * HTB)
#define PG8_STAGE(bufoff, gbase, voff) do { _Pragma("unroll") for (int _i = 0; _i < 2; ++_i) \
        __builtin_amdgcn_global_load_lds((const unsigned*)((const char*)(gbase) + (voff)[_i]), (PG8_LAS unsigned*)(lds + (bufoff) + ldsw + _i * 8192), 16, 0, 0); } while (0)
#define PG8_LDA(dst, b, h) do { _Pragma("unroll") for (int m = 0; m < 4; ++m) _Pragma("unroll") for (int k = 0; k < 2; ++k) dst[m][k] = *(const PG8_LAS bf16x8*)(lds + PG8_SA(b, h) + aoff + m * 2048 + k * 1024); } while (0)
#define PG8_LDB(dst, b, h) do { _Pragma("unroll") for (int n = 0; n < 2; ++n) _Pragma("unroll") for (int k = 0; k < 2; ++k) dst[n][k] = *(const PG8_LAS bf16x8*)(lds + PG8_SB(b, h) + boff + n * 2048 + k * 1024); } while (0)
#define PG8_MMA(ai, bj, At, Bt) do { __builtin_amdgcn_s_setprio(1); _Pragma("unroll") for (int m = 0; m < 4; ++m) _Pragma("unroll") for (int n = 0; n < 2; ++n) _Pragma("unroll") for (int k = 0; k < 2; ++k) \
        acc[ai][bj][m][n] = __builtin_amdgcn_mfma_f32_16x16x32_bf16(Bt[n][k], At[m][k], acc[ai][bj][m][n], 0, 0, 0); __builtin_amdgcn_s_setprio(0); } while (0)
#define PG8_WAIT_V(n) asm volatile("s_waitcnt vmcnt(" #n ")" ::: "memory")
#define PG8_WAIT_L(n) asm volatile("s_waitcnt lgkmcnt(" #n ")" ::: "memory")
#define PG8_BAR __builtin_amdgcn_s_barrier()
#define PG8_SCHED __builtin_amdgcn_sched_barrier(0)
    Unit cur, nxt; int ui = 0;
    if (!S.next(0, cur)) return;
    f32x4 acc[2][2][4][2];
#pragma unroll
    for (int a = 0; a < 2; ++a)
#pragma unroll
        for (int b = 0; b < 2; ++b)
#pragma unroll
            for (int m = 0; m < 4; ++m)
#pragma unroll
                for (int n = 0; n < 2; ++n) acc[a][b][m][n] = (f32x4){0.f, 0.f, 0.f, 0.f};
    bf16x8 At[4][2], B0[2][2], B1[2][2];
    const char* cA = (const char*)g.A + (size_t)cur.pm * tstep; const char* cB = (const char*)g.Bt + (size_t)cur.pn * tstep;
    S.a_ready(cur);
    if constexpr (SP2) {
        PG8_STAGE(PG8_SB(0, 0), cB, voffB); PG8_STAGE(PG8_SB(0, 1), cB + hstep, voffB); PG8_STAGE(PG8_SA(0, 0), cA, voffA); PG8_STAGE(PG8_SA(0, 1), cA + hstep, voffA);
        if (wr == 1) PG8_BAR;
        PG8_WAIT_V(2); PG8_BAR;
        PG8_STAGE(PG8_SB(1, 0), cB + kstep, voffB); PG8_STAGE(PG8_SA(1, 0), cA + kstep, voffA); PG8_STAGE(PG8_SB(1, 1), cB + hstep + kstep, voffB);
        PG8_WAIT_V(6); PG8_BAR;
    } else {
        PG8_STAGE(PG8_SB(0, 0), cB, voffB); PG8_STAGE(PG8_SA(0, 0), cA, voffA); PG8_STAGE(PG8_SB(0, 1), cB + hstep, voffB); PG8_STAGE(PG8_SA(0, 1), cA + hstep, voffA);
        if (wr == 1) PG8_BAR;
        PG8_WAIT_V(4); PG8_BAR;
        PG8_STAGE(PG8_SB(1, 0), cB + kstep, voffB); PG8_STAGE(PG8_SA(1, 0), cA + kstep, voffA); PG8_STAGE(PG8_SB(1, 1), cB + hstep + kstep, voffB);
        PG8_WAIT_V(6); PG8_BAR;
    }
    for (;;) {
        const bool has_next = S.next(ui + 1, nxt);
        const char* nA = has_next ? (const char*)g.A + (size_t)nxt.pm * tstep : cA; const char* nB = has_next ? (const char*)g.Bt + (size_t)nxt.pn * tstep : cB;
        for (int t = 0; t < nt; t += 2) {
            const bool last = (t == nt - 2);
            const char* a1 = cA + (size_t)(t + 1) * kstep;
            const char* a2 = last ? nA : cA + (size_t)(t + 2) * kstep; const char* b2 = last ? nB : cB + (size_t)(t + 2) * kstep;
            const char* a3 = a2 + kstep; const char* b3 = b2 + kstep;
            if (last && has_next) S.a_ready(nxt);
            if constexpr (SP2) {
            PG8_LDB(B0, 0, 0); PG8_LDB(B1, 0, 1); PG8_SCHED; PG8_LDA(At, 0, 0); PG8_STAGE(PG8_SA(1, 1), a1 + hstep, voffA);
            PG8_WAIT_V(8); PG8_WAIT_L(0); PG8_BAR; PG8_MMA(0, 0, At, B0); PG8_MMA(0, 1, At, B1); PG8_BAR; PG8_SCHED;
            PG8_LDA(At, 0, 1); PG8_STAGE(PG8_SB(0, 0), b2, voffB); PG8_STAGE(PG8_SB(0, 1), b2 + hstep, voffB); PG8_STAGE(PG8_SA(0, 0), a2, voffA);
            PG8_WAIT_V(8); PG8_WAIT_L(0); PG8_BAR; PG8_MMA(1, 0, At, B0); PG8_MMA(1, 1, At, B1); PG8_BAR; PG8_SCHED;
            PG8_LDB(B0, 1, 0); PG8_LDB(B1, 1, 1); PG8_SCHED; PG8_LDA(At, 1, 0); PG8_STAGE(PG8_SA(0, 1), a2 + hstep, voffA);
            PG8_WAIT_V(8); PG8_WAIT_L(0); PG8_BAR; PG8_MMA(0, 0, At, B0); PG8_MMA(0, 1, At, B1); PG8_BAR; PG8_SCHED;
            PG8_LDA(At, 1, 1); PG8_STAGE(PG8_SB(1, 0), b3, voffB); PG8_STAGE(PG8_SB(1, 1), b3 + hstep, voffB); PG8_STAGE(PG8_SA(1, 0), a3, voffA);
            PG8_WAIT_V(8); PG8_WAIT_L(0); PG8_BAR; PG8_MMA(1, 0, At, B0); PG8_MMA(1, 1, At, B1); PG8_BAR; PG8_SCHED;
            } else {
            PG8_LDB(B0, 0, 0); PG8_SCHED; PG8_LDA(At, 0, 0); PG8_STAGE(PG8_SA(1, 1), a1 + hstep, voffA);
            PG8_WAIT_L(8); PG8_BAR; PG8_WAIT_L(0); PG8_MMA(0, 0, At, B0); PG8_BAR; PG8_SCHED;
            PG8_LDB(B1, 0, 1); PG8_STAGE(PG8_SB(0, 0), b2, voffB);
            PG8_BAR; PG8_WAIT_L(0); PG8_MMA(0, 1, At, B1); PG8_BAR;
            PG8_LDA(At, 0, 1); PG8_STAGE(PG8_SA(0, 0), a2, voffA);
            PG8_BAR; PG8_WAIT_L(0); PG8_MMA(1, 0, At, B0); PG8_BAR; PG8_SCHED;
            PG8_STAGE(PG8_SB(0, 1), b2 + hstep, voffB);
            PG8_WAIT_V(6); PG8_BAR; PG8_MMA(1, 1, At, B1); PG8_BAR;
            PG8_LDB(B0, 1, 0); PG8_SCHED; PG8_LDA(At, 1, 0); PG8_STAGE(PG8_SA(0, 1), a2 + hstep, voffA);
            PG8_WAIT_L(8); PG8_BAR; PG8_WAIT_L(0); PG8_MMA(0, 0, At, B0); PG8_BAR; PG8_SCHED;
            PG8_LDB(B1, 1, 1); PG8_STAGE(PG8_SB(1, 0), b3, voffB);
            PG8_BAR; PG8_WAIT_L(0); PG8_MMA(0, 1, At, B1); PG8_BAR;
            PG8_LDA(At, 1, 1); PG8_STAGE(PG8_SA(1, 0), a3, voffA);
            PG8_BAR; PG8_WAIT_L(0); PG8_MMA(1, 0, At, B0); PG8_BAR; PG8_SCHED;
            PG8_STAGE(PG8_SB(1, 1), b3 + hstep, voffB);
            PG8_WAIT_V(6); PG8_BAR; PG8_MMA(1, 1, At, B1); PG8_BAR;
            }
        }
        if constexpr (ALIGN_EPI) { if (wr == 0) PG8_BAR; }
        if constexpr (!Epi::AFTER_DRAIN) { E(acc, cur, wr, wc, fr, fq); S.done(cur); }
        if (!has_next) break;
#pragma unroll
        for (int a = 0; a < 2; ++a)
#pragma unroll
            for (int b = 0; b < 2; ++b)
#pragma unroll
                for (int m = 0; m < 4; ++m)
#pragma unroll
                    for (int n = 0; n < 2; ++n) acc[a][b][m][n] = (f32x4){0.f, 0.f, 0.f, 0.f};
        cur = nxt; cA = nA; cB = nB; ++ui;
        if constexpr (ALIGN_EPI) { if (wr == 1) PG8_BAR; }
    }
    PG8_WAIT_V(0);
    if constexpr (!ALIGN_EPI) { if (wr == 0) PG8_BAR; }
    PG8_BAR;
#undef PG8_SA
#undef PG8_SB
#undef PG8_STAGE
#undef PG8_LDA
#undef PG8_LDB
#undef PG8_MMA
#undef PG8_WAIT_V
#undef PG8_WAIT_L
#undef PG8_BAR
#undef PG8_SCHED
}
}

__device__ __forceinline__ void transpose_item(const float* W, int K, int N, bf16* WT, LAS float* scr, int item, int lane) {
    const int nblk = N / 32, kb = item / nblk, nb = item % nblk, k0 = 64 * kb, n0 = 32 * nb;
#pragma unroll 8
    for (int i = 0; i < 32; ++i) { const int kk = 2 * i + (lane >> 5); scr[kk * 33 + (lane & 31)] = W[(size_t)(k0 + kk) * N + n0 + (lane & 31)]; }
    asm volatile("s_waitcnt lgkmcnt(0)" ::: "memory");
    const int c = lane & 7;
#pragma unroll
    for (int j = 0; j < 4; ++j) { const int n = (lane >> 3) + 8 * j; const LAS float* s = scr + (8 * c) * 33 + n;
        uint4 o; o.x = pk2(s[0 * 33], s[1 * 33]); o.y = pk2(s[2 * 33], s[3 * 33]); o.z = pk2(s[4 * 33], s[5 * 33]); o.w = pk2(s[6 * 33], s[7 * 33]);
        *(uint4*)(WT + (size_t)(n0 + n) * K + k0 + 8 * c) = o; }
    asm volatile("s_waitcnt lgkmcnt(0)" ::: "memory");
}

__device__ __forceinline__ float wsum(float v) {
#pragma unroll
  for (int o = 32; o > 0; o >>= 1) v += __shfl_xor(v, o, 64);
  return v;
}
__device__ __forceinline__ float wmaxf(float v) {
#pragma unroll
  for (int o = 32; o > 0; o >>= 1) v = fmaxf(v, __shfl_xor(v, o, 64));
  return v;
}
__device__ __forceinline__ float sigmoidf_(float x) { return 1.0f / (1.0f + expf(-x)); }
__device__ __forceinline__ float gelu_tanh(float x) {
  return 0.5f * x * (1.0f + tanhf(0.7978845608028654f * (x + 0.044715f * x * x * x)));
}

template <bool BF16OUT>
__device__ __forceinline__ void rms_rows(const int wave_s, const float* src, const float* g, void* dstv, int rows) {
  const int tid_ = opaque_tid(wave_s);
  const int lane = tid_ & 63;
  const int gw = blockIdx.x * NWAVES + (tid_ >> 6);
  const int nw = gridDim.x * NWAVES;
  for (int r = gw; r < rows; r += nw) {
    const float4* s4 = (const float4*)(src + (size_t)r * DM);
    float4 v[4];
    float ss = 0.f;
#pragma unroll
    for (int i = 0; i < 4; i++) {
      v[i] = s4[lane + i * 64];
      ss += v[i].x * v[i].x + v[i].y * v[i].y + v[i].z * v[i].z + v[i].w * v[i].w;
    }
    ss = wsum(ss);
    const float rstd = rsqrtf(ss * (1.0f / DM) + EPSF);
    const float4* g4 = (const float4*)g;
#pragma unroll
    for (int i = 0; i < 4; i++) {
      float4 gg = g4[lane + i * 64];
      float4 o;
      o.x = v[i].x * rstd * gg.x; o.y = v[i].y * rstd * gg.y;
      o.z = v[i].z * rstd * gg.z; o.w = v[i].w * rstd * gg.w;
      if (BF16OUT) {
        uint2 pk; pk.x = pk2(o.x, o.y); pk.y = pk2(o.z, o.w);
        ((uint2*)((bf16*)dstv + (size_t)r * DM))[lane + i * 64] = pk;
      } else {
        ((float4*)((float*)dstv + (size_t)r * DM))[lane + i * 64] = o;
      }
    }
  }
}

__device__ __forceinline__ void ssm_params(const int wave_s, const Params& p, float* ssmp_all) {
  const int tid_ = opaque_tid(wave_s);
  const float* in8 = karg_in(8); const float* in9 = karg_in(9); const float* in10 = karg_in(10);
  const float* in11 = karg_in(11); const float* in12 = karg_in(12);
  const int gt = blockIdx.x * blockDim.x + tid_;
  const int nth = gridDim.x * blockDim.x;
  for (int i = gt; i < 2 * 16 * 64; i += nth) {
    const int l = i / 1024, gp = i % 1024, g = gp / 64;
    float* sp = ssmp_all + (size_t)l * SSMP_PER_LAYER;
    const float lre = fminf(in8[l * 1024 + gp], -1e-4f);
    const float lim = in9[l * 1024 + gp];
    const float dt = expf(in10[l * 16 + g]);
    const float er = expf(lre * dt);
    float sn, cs;
    sincosf(lim * dt, &sn, &cs);
    const float br = er * cs, bi = er * sn;
    sp[gp * 2 + 0] = br;
    sp[gp * 2 + 1] = bi;
    float cr = br, ci = bi;
#pragma unroll
    for (int s = 0; s < 6; s++) {
      const float nr = cr * cr - ci * ci, ni = 2.f * cr * ci;
      cr = nr; ci = ni;
    }
    sp[2048 + gp * 2 + 0] = cr;
    sp[2048 + gp * 2 + 1] = ci;
    const float nr = br - 1.0f, ni = bi;
    const float den = lre * lre + lim * lim;
    const float fr = (nr * lre + ni * lim) / den;
    const float fi = (ni * lre - nr * lim) / den;
    for (int h = 0; h < 16; h++) {
      const float bre = in11[((size_t)l * 1024 + gp) * 16 + h];
      const float bim = in12[((size_t)l * 1024 + gp) * 16 + h];
      sp[4096 + ((g * 16 + h) * 64 + (gp & 63)) * 2 + 0] = fr * bre - fi * bim;
      sp[4096 + ((g * 16 + h) * 64 + (gp & 63)) * 2 + 1] = fr * bim + fi * bre;
    }
  }
}

__device__ __forceinline__ void conv_phase(const int wave_s, const Params& p, int l, const bf16* proj, bf16* y, LAS float* smem) {
  const int tid_ = opaque_tid(wave_s);
  const int lane = tid_ & 63;
  const int gw = blockIdx.x * NWAVES + (tid_ >> 6);
  const int nw = gridDim.x * NWAVES;
  const float* cw = karg_in(4) + (size_t)l * 31 * 256;
  const float4 cb = ((const float4*)(karg_in(5) + l * 256))[lane];
  const float4 lg = ((const float4*)(karg_in(6) + l * 256))[lane];
  const float4 lb = ((const float4*)(karg_in(7) + l * 256))[lane];
  const float4 gg = ((const float4*)(karg_in(18) + l * 1024))[lane];
  LAS float* cwl = smem + 1024;
  for (int i = tid_; i < 31 * 256 / 4; i += NWAVES * 64) *(LAS pg8::f32x4*)(cwl + 4 * i) = *(const pg8::f32x4*)(cw + 4 * i);
  __syncthreads();
  for (int it = gw; it < NT / 8; it += nw) {
    const int tok0 = it * 8;
    const int t0 = tok0 & (SEQ - 1);
    float4 acc[8];
#pragma unroll
    for (int o = 0; o < 8; o++) acc[o] = cb;
#pragma unroll
    for (int i = 0; i < 38; i++) {
      if (t0 - 30 + i >= 0) {
        const bf16* row = proj + (size_t)(tok0 - 30 + i) * DIN;
        const uint2 vp = ((const uint2*)row)[lane];
        const uint2 gp = ((const uint2*)(row + 256))[lane];
        float4 g4;
        g4.x = bf_lo(vp.x) * sigmoidf_(bf_lo(gp.x)); g4.y = bf_hi(vp.x) * sigmoidf_(bf_hi(gp.x));
        g4.z = bf_lo(vp.y) * sigmoidf_(bf_lo(gp.y)); g4.w = bf_hi(vp.y) * sigmoidf_(bf_hi(gp.y));
#pragma unroll
        for (int o = 0; o < 8; o++) {
          const int j = i - o;
          if (j >= 0 && j <= 30) {
            const pg8::f32x4 w4 = *(const LAS pg8::f32x4*)(cwl + j * 256 + lane * 4);
            acc[o].x += g4.x * w4[0]; acc[o].y += g4.y * w4[1];
            acc[o].z += g4.z * w4[2]; acc[o].w += g4.w * w4[3];
          }
        }
      }
    }
#pragma unroll
    for (int o = 0; o < 8; o++) {
      const float4 a = acc[o];
      const float mean = wsum(a.x + a.y + a.z + a.w) * (1.0f / 256.f);
      const float dx = a.x - mean, dy = a.y - mean, dz = a.z - mean, dw = a.w - mean;
      const float var = wsum(dx * dx + dy * dy + dz * dz + dw * dw) * (1.0f / 256.f);
      const float rs = rsqrtf(var + EPSF);
      float4 s;
      s.x = dx * rs * lg.x + lb.x; s.y = dy * rs * lg.y + lb.y;
      s.z = dz * rs * lg.z + lb.z; s.w = dw * rs * lg.w + lb.w;
      s.x = s.x * sigmoidf_(s.x); s.y = s.y * sigmoidf_(s.y);
      s.z = s.z * sigmoidf_(s.z); s.w = s.w * sigmoidf_(s.w);
      const float ss = wsum(s.x * s.x + s.y * s.y + s.z * s.z + s.w * s.w) * (1.0f / 256.f);
      const float r2 = rsqrtf(ss + EPSF);
      uint2 pk; pk.x = pk2(s.x * r2 * gg.x, s.y * r2 * gg.y); pk.y = pk2(s.z * r2 * gg.z, s.w * r2 * gg.w);
      ((uint2*)(y + (size_t)(tok0 + o) * DM))[lane] = pk;
    }
  }
}

typedef short bf16x8_t __attribute__((ext_vector_type(8)));
typedef float f32x16_t __attribute__((ext_vector_type(16)));
#define MFMA_PAD() do { __builtin_amdgcn_sched_barrier(0); asm volatile("s_nop 15\n\ts_nop 15" ::: "memory"); __builtin_amdgcn_sched_barrier(0); } while (0)

__device__ __forceinline__ void attn_phase(const int wave_s, const Params& p, int l, const bf16* proj, bf16* y, LAS float* smem) {
  const int tid = opaque_tid(wave_s), lane = tid & 63, wave = tid >> 6;
  const int n = lane & 31, hh = lane >> 5;
  const float* gg = karg_in(18) + l * 1024 + 256 + wave * 64;
  const float g0 = gg[n], g1 = gg[32 + n];
  LAS float* ssq = smem;
  LAS float* rstd = smem + 256;
  for (int item = blockIdx.x; item < 4 * 128; item += gridDim.x) {
    const int b = item >> 7, q0 = (item & 127) * 32;
    const size_t tokb = (size_t)b * SEQ;
    bf16x8_t qf[4];
    {
      const bf16* qrow = proj + (tokb + q0 + n) * DIN + 512 + wave * 64 + 8 * hh;
#pragma unroll
      for (int ks = 0; ks < 4; ks++) qf[ks] = *(const bf16x8_t*)(qrow + 16 * ks);
    }
    f32x16_t o0, o1;
#pragma unroll
    for (int r = 0; r < 16; r++) { o0[r] = 0.f; o1[r] = 0.f; }
    float R = 0.f;
    for (int kt = q0; kt >= 0; kt -= 32) {
      bf16x8_t kf[4];
      {
        const bf16* krow = proj + (tokb + kt + n) * DIN + 1024 + wave * 64 + 8 * hh;
#pragma unroll
        for (int ks = 0; ks < 4; ks++) kf[ks] = *(const bf16x8_t*)(krow + 16 * ks);
      }
      bf16x8_t vf0[2], vf1[2];
      {
        const bf16* vb = proj + (tokb + kt + 4 * hh) * DIN + 1536 + wave * 64 + n;
#pragma unroll
        for (int s = 0; s < 2; s++)
#pragma unroll
          for (int j = 0; j < 8; j++) {
            const int key = 16 * s + 8 * (j >> 2) + (j & 3);
            vf0[s][j] = (short)vb[(size_t)key * DIN];
            vf1[s][j] = (short)vb[(size_t)key * DIN + 32];
          }
      }
      f32x16_t sacc;
#pragma unroll
      for (int r = 0; r < 16; r++) sacc[r] = 0.f;
      __builtin_amdgcn_sched_barrier(0); asm volatile("s_nop 15\n\ts_nop 15" ::: "memory"); __builtin_amdgcn_sched_barrier(0);
#pragma unroll
      for (int ks = 0; ks < 4; ks++) sacc = __builtin_amdgcn_mfma_f32_32x32x16_bf16(kf[ks], qf[ks], sacc, 0, 0, 0);
      __builtin_amdgcn_sched_barrier(0); asm volatile("s_nop 15\n\ts_nop 15" ::: "memory"); __builtin_amdgcn_sched_barrier(0);
      float lst[16], lsz[16];
      const bool diag = (kt == q0);
#pragma unroll
      for (int r = 0; r < 16; r++) {
        const float z = sacc[r] * 0.125f;
        const float sp = __logf(1.0f + __expf(-fabsf(z)));
        float a = fminf(z, 0.f) - sp;
        float c = -(fmaxf(z, 0.f) + sp);
        if (diag) {
          const int key = (r & 3) + 8 * (r >> 2) + 4 * hh;
          if (key >= n) { a = -1.0e30f; c = 0.f; }
        }
        lsz[r] = a; lst[r] = c;
      }
      float Gs[4], Gp[4];
#pragma unroll
      for (int g = 0; g < 4; g++) {
        Gs[g] = (lst[4 * g] + lst[4 * g + 1]) + (lst[4 * g + 2] + lst[4 * g + 3]);
        Gp[g] = __shfl_xor(Gs[g], 32, 64);
      }
      float carry[4];
      {
        float after = R;
#pragma unroll
        for (int g = 3; g >= 0; g--) {
          carry[g] = after + (hh ? 0.f : Gp[g]);
          after += Gs[g] + Gp[g];
        }
        R = after;
      }
      bf16x8_t pf[2];
#pragma unroll
      for (int g = 0; g < 4; g++) {
        float run = carry[g];
        float a3 = __expf(lsz[4 * g + 3] + run); run += lst[4 * g + 3];
        float a2 = __expf(lsz[4 * g + 2] + run); run += lst[4 * g + 2];
        float a1 = __expf(lsz[4 * g + 1] + run); run += lst[4 * g + 1];
        float a0 = __expf(lsz[4 * g + 0] + run);
        const int s = g >> 1, jb = (g & 1) * 4;
        pf[s][jb + 0] = (short)f2bf(a0); pf[s][jb + 1] = (short)f2bf(a1);
        pf[s][jb + 2] = (short)f2bf(a2); pf[s][jb + 3] = (short)f2bf(a3);
      }
      __builtin_amdgcn_sched_barrier(0); asm volatile("s_nop 15\n\ts_nop 15" ::: "memory"); __builtin_amdgcn_sched_barrier(0);
#pragma unroll
      for (int s = 0; s < 2; s++) {
        o0 = __builtin_amdgcn_mfma_f32_32x32x16_bf16(pf[s], vf0[s], o0, 0, 0, 0);
        o1 = __builtin_amdgcn_mfma_f32_32x32x16_bf16(pf[s], vf1[s], o1, 0, 0, 0);
      }
      __builtin_amdgcn_sched_barrier(0); asm volatile("s_nop 15\n\ts_nop 15" ::: "memory"); __builtin_amdgcn_sched_barrier(0);
      if (__all(R < -110.f)) break;
    }
    float sq[16];
#pragma unroll
    for (int r = 0; r < 16; r++) {
      float v = o0[r] * o0[r] + o1[r] * o1[r];
#pragma unroll
      for (int o = 16; o > 0; o >>= 1) v += __shfl_xor(v, o, 64);
      sq[r] = v;
    }
    __syncthreads();
    if (n == 0) {
#pragma unroll
      for (int r = 0; r < 16; r++) ssq[wave * 32 + (r & 3) + 8 * (r >> 2) + 4 * hh] = sq[r];
    }
    __syncthreads();
    if (tid < 32) {
      float t = 0.f;
#pragma unroll
      for (int w = 0; w < 8; w++) t += ssq[w * 32 + tid];
      rstd[tid] = rsqrtf(t * (1.0f / 512.f) + EPSF);
    }
    __syncthreads();
#pragma unroll
    for (int r = 0; r < 16; r++) {
      const int qi = (r & 3) + 8 * (r >> 2) + 4 * hh;
      const float rs = rstd[qi];
      bf16* yr = y + (tokb + q0 + qi) * DM + 256 + wave * 64 + n;
      yr[0] = (bf16)f2bf(o0[r] * rs * g0);
      yr[32] = (bf16)f2bf(o1[r] * rs * g1);
    }
  }
}

#define SSM_BCAST_U(u, ua, ub, tt) do { \
    const unsigned w0 = (unsigned)__builtin_amdgcn_readlane((int)(ua).x, (tt)), w1 = (unsigned)__builtin_amdgcn_readlane((int)(ua).y, (tt)); \
    const unsigned w2 = (unsigned)__builtin_amdgcn_readlane((int)(ua).z, (tt)), w3 = (unsigned)__builtin_amdgcn_readlane((int)(ua).w, (tt)); \
    const unsigned w4 = (unsigned)__builtin_amdgcn_readlane((int)(ub).x, (tt)), w5 = (unsigned)__builtin_amdgcn_readlane((int)(ub).y, (tt)); \
    const unsigned w6 = (unsigned)__builtin_amdgcn_readlane((int)(ub).z, (tt)), w7 = (unsigned)__builtin_amdgcn_readlane((int)(ub).w, (tt)); \
    (u)[0] = bf_lo(w0); (u)[1] = bf_hi(w0); (u)[2] = bf_lo(w1); (u)[3] = bf_hi(w1); (u)[4] = bf_lo(w2); (u)[5] = bf_hi(w2); (u)[6] = bf_lo(w3); (u)[7] = bf_hi(w3); \
    (u)[8] = bf_lo(w4); (u)[9] = bf_hi(w4); (u)[10] = bf_lo(w5); (u)[11] = bf_hi(w5); (u)[12] = bf_lo(w6); (u)[13] = bf_hi(w6); (u)[14] = bf_lo(w7); (u)[15] = bf_hi(w7); } while (0)
__device__ __forceinline__ void ssm_chunk_end(const int wave_s, const float* ssmp, const bf16* proj, float* ssmE) {
  const int tid_ = opaque_tid(wave_s);
  const int lane = tid_ & 63;
  const int gw = blockIdx.x * NWAVES + (tid_ >> 6);
  const int nw = gridDim.x * NWAVES;
  for (int it = gw; it < 4 * 64 * 16; it += nw) {
    const int g = it & 15, c = (it >> 4) & 63, b = it >> 10;
    const int gp = g * 64 + lane;
    const uint4* up = (const uint4*)(proj + (size_t)(b * SEQ + c * 64 + lane) * DIN + 2048 + g * 16);
    const uint4 ua = up[0], ub = up[1];
    const float lbr = ssmp[gp * 2], lbi = ssmp[gp * 2 + 1];
    float bbr[16], bbi[16];
#pragma unroll
    for (int h = 0; h < 16; h++) {
      { const float2 bb = *(const float2*)(ssmp + 4096 + ((g * 16 + h) * 64 + lane) * 2); bbr[h] = bb.x; bbi[h] = bb.y; }
    }
    float xr = 0.f, xi = 0.f;
#pragma unroll 2
    for (int tt = 0; tt < 64; tt++) {
      float u[16];
      SSM_BCAST_U(u, ua, ub, tt);
      float br = 0.f, bi = 0.f;
#pragma unroll
      for (int h = 0; h < 16; h++) { br += bbr[h] * u[h]; bi += bbi[h] * u[h]; }
      const float nr = lbr * xr - lbi * xi + br;
      const float ni = lbr * xi + lbi * xr + bi;
      xr = nr; xi = ni;
    }
    float* e = ssmE + ((size_t)((b * 64 + c) * 16 + g) * 64 + lane) * 2;
    e[0] = xr; e[1] = xi;
  }
}

__device__ __forceinline__ void ssm_finish(const int wave_s, const Params& p, int l, const float* ssmp, const bf16* proj,
                           const float* ssmE, bf16* y, LAS float* smem) {
  LAS bf16* Ytb = (LAS bf16*)smem;
  LAS float* ssq2 = smem + (64 * 264 * 2) / 4;
  LAS float* rstd2 = ssq2 + 512;
  const bf16* glT = (const bf16*)(p.ws + WS_WT + (size_t)l * WT_LAYER + WT_GLU);
  const int tid = opaque_tid(wave_s), lane = tid & 63, wave = tid >> 6;
  const float* cre = karg_in(13) + (size_t)l * 16 * 16 * 64;
  const float* cim = karg_in(14) + (size_t)l * 16 * 16 * 64;
  const float* dsk = karg_in(15) + l * 256;
  const float* glw = karg_in(16) + (size_t)l * 256 * 256;
  const float* glb = karg_in(17) + l * 256;
  const float* gg = karg_in(18) + l * 1024 + 768;
  for (int it = blockIdx.x; it < 256; it += gridDim.x) {
    const int b = it >> 6, c = it & 63;
    __syncthreads();
    for (int gi = 0; gi < 2; gi++) {
      const int g = wave + gi * 8;
      const int gp = g * 64 + lane;
      const float lbr = ssmp[gp * 2], lbi = ssmp[gp * 2 + 1];
      const float lcr = ssmp[2048 + gp * 2], lci = ssmp[2048 + gp * 2 + 1];
      float bbr[16], bbi[16], ccr[16], cci[16];
#pragma unroll
      for (int h = 0; h < 16; h++) {
        { const float2 bb = *(const float2*)(ssmp + 4096 + ((g * 16 + h) * 64 + lane) * 2); bbr[h] = bb.x; bbi[h] = bb.y; }
        ccr[h] = cre[(g * 16 + h) * 64 + lane];
        cci[h] = cim[(g * 16 + h) * 64 + lane];
      }
      float xr = 0.f, xi = 0.f;
      {
        const float2* eb = (const float2*)ssmE + ((size_t)(b * 64) * 16 + g) * 64 + lane;
        int cc = 0;
        for (; cc + 8 <= c; cc += 8) {
          float2 ev[8];
#pragma unroll
          for (int k = 0; k < 8; k++) ev[k] = eb[(size_t)(cc + k) * 16 * 64];
#pragma unroll
          for (int k = 0; k < 8; k++) {
            const float nr = lcr * xr - lci * xi + ev[k].x;
            const float ni = lcr * xi + lci * xr + ev[k].y;
            xr = nr; xi = ni;
          }
        }
        for (; cc < c; cc++) {
          const float2 e1 = eb[(size_t)cc * 16 * 64];
          const float nr = lcr * xr - lci * xi + e1.x;
          const float ni = lcr * xi + lci * xr + e1.y;
          xr = nr; xi = ni;
        }
      }
      const int hq = ((lane >> 5) & 1) * 8 + ((lane >> 4) & 1) * 4 + ((lane >> 3) & 1) * 2 + ((lane >> 2) & 1);
      float dm[16];
#pragma unroll
      for (int h = 0; h < 16; h++) dm[h] = (lane == 0) ? dsk[g * 16 + h] : 0.f;
      const uint4* up = (const uint4*)(proj + (size_t)(b * SEQ + c * 64 + lane) * DIN + 2048 + g * 16);
      const uint4 ua = up[0], ub = up[1];
#pragma unroll 1
      for (int t4 = 0; t4 < 64; t4 += 4) {
        float vv[4][16];
#pragma unroll
        for (int s = 0; s < 4; s++) {
          float u[16];
          SSM_BCAST_U(u, ua, ub, t4 + s);
          float br = 0.f, bi = 0.f;
#pragma unroll
          for (int h = 0; h < 16; h++) { br += bbr[h] * u[h]; bi += bbi[h] * u[h]; }
          const float nr = lbr * xr - lbi * xi + br;
          const float ni = lbr * xi + lbi * xr + bi;
          xr = nr; xi = ni;
#pragma unroll
          for (int h = 0; h < 16; h++) vv[s][h] = xr * ccr[h] - xi * cci[h] + dm[h] * u[h];
        }
        float v1[4];
#pragma unroll
        for (int s = 0; s < 4; s++) {
          float v8[8], v4[4], v2[2];
          {
            const bool hi = (lane & 32) != 0;
#pragma unroll
            for (int i = 0; i < 8; i++) { const float send = hi ? vv[s][i] : vv[s][i + 8]; const float keep = hi ? vv[s][i + 8] : vv[s][i]; v8[i] = keep + __shfl_xor(send, 32, 64); }
          }
          {
            const bool hi = (lane & 16) != 0;
#pragma unroll
            for (int i = 0; i < 4; i++) { const float send = hi ? v8[i] : v8[i + 4]; const float keep = hi ? v8[i + 4] : v8[i]; v4[i] = keep + __shfl_xor(send, 16, 64); }
          }
          {
            const bool hi = (lane & 8) != 0;
#pragma unroll
            for (int i = 0; i < 2; i++) { const float send = hi ? v4[i] : v4[i + 2]; const float keep = hi ? v4[i + 2] : v4[i]; v2[i] = keep + __shfl_xor(send, 8, 64); }
          }
          {
            const bool hi = (lane & 4) != 0;
            const float send = hi ? v2[0] : v2[1];
            const float keep = hi ? v2[1] : v2[0];
            v1[s] = keep + __shfl_xor(send, 4, 64);
          }
          v1[s] += __shfl_xor(v1[s], 2, 64);
          v1[s] += __shfl_xor(v1[s], 1, 64);
        }
        if ((lane & 3) == 0) {
#pragma unroll
          for (int s = 0; s < 4; s++) Ytb[(t4 + s) * 264 + g * 16 + hq] = (bf16)f2bf(gelu_tanh(v1[s]));
        }
      }
    }
    __syncthreads();
    {
      const int n = lane & 31, hh = lane >> 5;
      const int ch = wave * 32 + n;
      const float bj = glb[ch];
      const float gj = gg[ch];
      bf16x8_t gf[16];
      {
        const bf16* grow = glT + (size_t)ch * 256 + 8 * hh;
#pragma unroll
        for (int ks = 0; ks < 16; ks++) gf[ks] = *(const bf16x8_t*)(grow + 16 * ks);
      }
      float oo[2][16];
#pragma unroll
      for (int mt = 0; mt < 2; mt++) {
        f32x16_t z;
#pragma unroll
        for (int r = 0; r < 16; r++) z[r] = 0.f;
        const LAS bf16* yrow = Ytb + (mt * 32 + n) * 264 + 8 * hh;
#pragma unroll
        for (int kq = 0; kq < 4; kq++) {
          bf16x8_t yf[4];
#pragma unroll
          for (int i = 0; i < 4; i++) yf[i] = *(const LAS bf16x8_t*)(yrow + 16 * (kq * 4 + i));
          MFMA_PAD();
#pragma unroll
          for (int i = 0; i < 4; i++) z = __builtin_amdgcn_mfma_f32_32x32x16_bf16(yf[i], gf[kq * 4 + i], z, 0, 0, 0);
          MFMA_PAD();
        }
        float sq[16];
#pragma unroll
        for (int r = 0; r < 16; r++) {
          const int t = mt * 32 + (r & 3) + 8 * (r >> 2) + 4 * hh;
          const float yv = bf2f(Ytb[t * 264 + ch]);
          const float o = yv * sigmoidf_(z[r] + bj);
          oo[mt][r] = o;
          float v = o * o;
#pragma unroll
          for (int s = 16; s > 0; s >>= 1) v += __shfl_xor(v, s, 64);
          sq[r] = v;
        }
        if (n == 0) {
#pragma unroll
          for (int r = 0; r < 16; r++) ssq2[wave * 64 + mt * 32 + (r & 3) + 8 * (r >> 2) + 4 * hh] = sq[r];
        }
      }
      __syncthreads();
      if (tid < 64) {
        float t = 0.f;
#pragma unroll
        for (int w = 0; w < 8; w++) t += ssq2[w * 64 + tid];
        rstd2[tid] = rsqrtf(t * (1.0f / 256.f) + EPSF);
      }
      __syncthreads();
#pragma unroll
      for (int mt = 0; mt < 2; mt++)
#pragma unroll
        for (int r = 0; r < 16; r++) {
          const int t = mt * 32 + (r & 3) + 8 * (r >> 2) + 4 * hh;
          y[(size_t)(b * SEQ + c * 64 + t) * DM + 768 + ch] = (bf16)f2bf(oo[mt][r] * rstd2[t] * gj);
        }
    }
  }
}

__device__ __forceinline__ void memattn_phase(const int wave_s, const bf16* q, const bf16* kvb, const bf16* vT, bf16* o, LAS float* smem) {
  const int tid_ = opaque_tid(wave_s);
  const int lane = tid_ & 63, n = lane & 31, hh = lane >> 5, wave = tid_ >> 6;
  const int sig = (n & 0x13) | ((n & 4) << 1) | ((n & 8) >> 1);
  LAS bf16* Ls = (LAS bf16*)smem;
  for (int it = blockIdx.x; it < 64 * 4; it += gridDim.x) {
    const int h = it & 3, tg = it >> 2, b = tg >> 4;
    const int tok0 = (tg * 8 + wave) * 32;
    __syncthreads();
    {
      const int r = tid_ >> 1, hf = tid_ & 1;
      const pg8::u32x4* src4 = (const pg8::u32x4*)(kvb + (size_t)(b * NMEM + r) * 2048 + h * 256 + hf * 128);
      LAS pg8::u32x4* dst4 = (LAS pg8::u32x4*)(Ls + r * 264 + hf * 128);
#pragma unroll
      for (int k = 0; k < 16; k++) dst4[k] = src4[k];
    }
    f32x16_t st[8];
#pragma unroll
    for (int kt = 0; kt < 8; kt++)
#pragma unroll
      for (int r = 0; r < 16; r++) st[kt][r] = 0.f;
    const bf16* qrow = q + (size_t)(tok0 + n) * DM + h * 256 + 8 * hh;
    __syncthreads();
#pragma unroll
    for (int kq = 0; kq < 4; kq++) {
      bf16x8_t qf[4];
#pragma unroll
      for (int i = 0; i < 4; i++) qf[i] = *(const bf16x8_t*)(qrow + 16 * (kq * 4 + i));
#pragma unroll
      for (int kt = 0; kt < 8; kt++) {
        const LAS bf16* krow = Ls + (kt * 32 + sig) * 264 + 8 * hh;
        bf16x8_t kf[4];
#pragma unroll
        for (int i = 0; i < 4; i++) kf[i] = *(const LAS bf16x8_t*)(krow + 16 * (kq * 4 + i));
        MFMA_PAD();
#pragma unroll
        for (int i = 0; i < 4; i++) st[kt] = __builtin_amdgcn_mfma_f32_32x32x16_bf16(kf[i], qf[i], st[kt], 0, 0, 0);
        MFMA_PAD();
      }
    }
    float mx = st[0][0];
#pragma unroll
    for (int kt = 0; kt < 8; kt++)
#pragma unroll
      for (int r = 0; r < 16; r++) mx = fmaxf(mx, st[kt][r]);
    mx = fmaxf(mx, __shfl_xor(mx, 32, 64));
    float sum = 0.f;
#pragma unroll
    for (int kt = 0; kt < 8; kt++)
#pragma unroll
      for (int r = 0; r < 16; r++) { const float e = __expf((st[kt][r] - mx) * 0.0625f); st[kt][r] = e; sum += e; }
    sum += __shfl_xor(sum, 32, 64);
    const float inv = 1.0f / sum;
    bf16x8_t pf[8][2];
#pragma unroll
    for (int kt = 0; kt < 8; kt++)
#pragma unroll
      for (int s = 0; s < 2; s++)
#pragma unroll
        for (int j = 0; j < 8; j++) pf[kt][s][j] = (short)f2bf(st[kt][8 * s + j] * inv);
    __syncthreads();
    {
      const int r = tid_ >> 1, hf = tid_ & 1;
      const pg8::u32x4* src4 = (const pg8::u32x4*)(vT + ((size_t)(b * 4 + h) * 256 + r) * 256 + hf * 128);
      LAS pg8::u32x4* dst4 = (LAS pg8::u32x4*)(Ls + r * 264 + hf * 128);
#pragma unroll
      for (int k = 0; k < 16; k++) dst4[k] = src4[k];
    }
    __syncthreads();
#pragma unroll 1
    for (int dt = 0; dt < 8; dt++) {
      f32x16_t oacc;
#pragma unroll
      for (int r = 0; r < 16; r++) oacc[r] = 0.f;
      const LAS bf16* vrow = Ls + (dt * 32 + n) * 264 + 8 * hh;
#pragma unroll
      for (int kq = 0; kq < 4; kq++) {
        bf16x8_t vf[4];
#pragma unroll
        for (int i = 0; i < 4; i++) vf[i] = *(const LAS bf16x8_t*)(vrow + (kq * 2 + (i >> 1)) * 32 + 16 * (i & 1));
        MFMA_PAD();
#pragma unroll
        for (int i = 0; i < 4; i++) oacc = __builtin_amdgcn_mfma_f32_32x32x16_bf16(pf[kq * 2 + (i >> 1)][i & 1], vf[i], oacc, 0, 0, 0);
        MFMA_PAD();
      }
#pragma unroll
      for (int r = 0; r < 16; r++) {
        const int qi = (r & 3) + 8 * (r >> 2) + 4 * hh;
        o[(size_t)(tok0 + qi) * DM + h * 256 + dt * 32 + n] = (bf16)f2bf(oacc[r]);
      }
    }
  }
}

__device__ __forceinline__ void vt_phase(const int wave_s, const bf16* kvb, bf16* vT) {
  const int tid_ = opaque_tid(wave_s);
  const int gt = blockIdx.x * (NWAVES * 64) + tid_;
  const int nth = gridDim.x * NWAVES * 64;
  for (int i = gt; i < 2 * 4 * 4 * 256 * 256; i += nth) {
    const int m = i & 255, d = (i >> 8) & 255, h = (i >> 16) & 3, b = (i >> 18) & 3, l = i >> 20;
    vT[i] = kvb[((size_t)l * 1024 + b * 256 + m) * 2048 + 1024 + h * 256 + d];
  }
}

template <unsigned MASK>
__device__ __forceinline__ float pack_key(float s, unsigned idx) {
  const unsigned u = __builtin_bit_cast(unsigned, s);
  const unsigned tag = ((int)u < 0) ? idx : (MASK - idx);
  return __builtin_bit_cast(float, (u & ~MASK) + tag);
}
template <unsigned MASK>
__device__ __forceinline__ unsigned key_idx(float k) {
  const unsigned u = __builtin_bit_cast(unsigned, k);
  const unsigned tag = u & MASK;
  return ((int)u < 0) ? tag : (MASK - tag);
}
template <unsigned MASK>
__device__ __forceinline__ float key_val(float k) { return __builtin_bit_cast(float, __builtin_bit_cast(unsigned, k) & ~MASK); }
__device__ __forceinline__ void top16_of_64(float (&K)[64]) {
  { const float a_ = K[0], b_ = K[1]; const bool g_ = a_ > b_; K[0] = g_ ? a_ : b_; K[1] = g_ ? b_ : a_; }
  { const float a_ = K[2], b_ = K[3]; const bool g_ = a_ > b_; K[2] = g_ ? b_ : a_; K[3] = g_ ? a_ : b_; }
  { const float a_ = K[4], b_ = K[5]; const bool g_ = a_ > b_; K[4] = g_ ? a_ : b_; K[5] = g_ ? b_ : a_; }
  { const float a_ = K[6], b_ = K[7]; const bool g_ = a_ > b_; K[6] = g_ ? b_ : a_; K[7] = g_ ? a_ : b_; }
  { const float a_ = K[8], b_ = K[9]; const bool g_ = a_ > b_; K[8] = g_ ? a_ : b_; K[9] = g_ ? b_ : a_; }
  { const float a_ = K[10], b_ = K[11]; const bool g_ = a_ > b_; K[10] = g_ ? b_ : a_; K[11] = g_ ? a_ : b_; }
  { const float a_ = K[12], b_ = K[13]; const bool g_ = a_ > b_; K[12] = g_ ? a_ : b_; K[13] = g_ ? b_ : a_; }
  { const float a_ = K[14], b_ = K[15]; const bool g_ = a_ > b_; K[14] = g_ ? b_ : a_; K[15] = g_ ? a_ : b_; }
  { const float a_ = K[0], b_ = K[2]; const bool g_ = a_ > b_; K[0] = g_ ? a_ : b_; K[2] = g_ ? b_ : a_; }
  { const float a_ = K[1], b_ = K[3]; const bool g_ = a_ > b_; K[1] = g_ ? a_ : b_; K[3] = g_ ? b_ : a_; }
  { const float a_ = K[4], b_ = K[6]; const bool g_ = a_ > b_; K[4] = g_ ? b_ : a_; K[6] = g_ ? a_ : b_; }
  { const float a_ = K[5], b_ = K[7]; const bool g_ = a_ > b_; K[5] = g_ ? b_ : a_; K[7] = g_ ? a_ : b_; }
  { const float a_ = K[8], b_ = K[10]; const bool g_ = a_ > b_; K[8] = g_ ? a_ : b_; K[10] = g_ ? b_ : a_; }
  { const float a_ = K[9], b_ = K[11]; const bool g_ = a_ > b_; K[9] = g_ ? a_ : b_; K[11] = g_ ? b_ : a_; }
  { const float a_ = K[12], b_ = K[14]; const bool g_ = a_ > b_; K[12] = g_ ? b_ : a_; K[14] = g_ ? a_ : b_; }
  { const float a_ = K[13], b_ = K[15]; const bool g_ = a_ > b_; K[13] = g_ ? b_ : a_; K[15] = g_ ? a_ : b_; }
  { const float a_ = K[0], b_ = K[1]; const bool g_ = a_ > b_; K[0] = g_ ? a_ : b_; K[1] = g_ ? b_ : a_; }
  { const float a_ = K[2], b_ = K[3]; const bool g_ = a_ > b_; K[2] = g_ ? a_ : b_; K[3] = g_ ? b_ : a_; }
  { const float a_ = K[4], b_ = K[5]; const bool g_ = a_ > b_; K[4] = g_ ? b_ : a_; K[5] = g_ ? a_ : b_; }
  { const float a_ = K[6], b_ = K[7]; const bool g_ = a_ > b_; K[6] = g_ ? b_ : a_; K[7] = g_ ? a_ : b_; }
  { const float a_ = K[8], b_ = K[9]; const bool g_ = a_ > b_; K[8] = g_ ? a_ : b_; K[9] = g_ ? b_ : a_; }
  { const float a_ = K[10], b_ = K[11]; const bool g_ = a_ > b_; K[10] = g_ ? a_ : b_; K[11] = g_ ? b_ : a_; }
  { const float a_ = K[12], b_ = K[13]; const bool g_ = a_ > b_; K[12] = g_ ? b_ : a_; K[13] = g_ ? a_ : b_; }
  { const float a_ = K[14], b_ = K[15]; const bool g_ = a_ > b_; K[14] = g_ ? b_ : a_; K[15] = g_ ? a_ : b_; }
  { const float a_ = K[0], b_ = K[4]; const bool g_ = a_ > b_; K[0] = g_ ? a_ : b_; K[4] = g_ ? b_ : a_; }
  { const float a_ = K[1], b_ = K[5]; const bool g_ = a_ > b_; K[1] = g_ ? a_ : b_; K[5] = g_ ? b_ : a_; }
  { const float a_ = K[2], b_ = K[6]; const bool g_ = a_ > b_; K[2] = g_ ? a_ : b_; K[6] = g_ ? b_ : a_; }
  { const float a_ = K[3], b_ = K[7]; const bool g_ = a_ > b_; K[3] = g_ ? a_ : b_; K[7] = g_ ? b_ : a_; }
  { const float a_ = K[8], b_ = K[12]; const bool g_ = a_ > b_; K[8] = g_ ? b_ : a_; K[12] = g_ ? a_ : b_; }
  { const float a_ = K[9], b_ = K[13]; const bool g_ = a_ > b_; K[9] = g_ ? b_ : a_; K[13] = g_ ? a_ : b_; }
  { const float a_ = K[10], b_ = K[14]; const bool g_ = a_ > b_; K[10] = g_ ? b_ : a_; K[14] = g_ ? a_ : b_; }
  { const float a_ = K[11], b_ = K[15]; const bool g_ = a_ > b_; K[11] = g_ ? b_ : a_; K[15] = g_ ? a_ : b_; }
  { const float a_ = K[0], b_ = K[2]; const bool g_ = a_ > b_; K[0] = g_ ? a_ : b_; K[2] = g_ ? b_ : a_; }
  { const float a_ = K[1], b_ = K[3]; const bool g_ = a_ > b_; K[1] = g_ ? a_ : b_; K[3] = g_ ? b_ : a_; }
  { const float a_ = K[4], b_ = K[6]; const bool g_ = a_ > b_; K[4] = g_ ? a_ : b_; K[6] = g_ ? b_ : a_; }
  { const float a_ = K[5], b_ = K[7]; const bool g_ = a_ > b_; K[5] = g_ ? a_ : b_; K[7] = g_ ? b_ : a_; }
  { const float a_ = K[8], b_ = K[10]; const bool g_ = a_ > b_; K[8] = g_ ? b_ : a_; K[10] = g_ ? a_ : b_; }
  { const float a_ = K[9], b_ = K[11]; const bool g_ = a_ > b_; K[9] = g_ ? b_ : a_; K[11] = g_ ? a_ : b_; }
  { const float a_ = K[12], b_ = K[14]; const bool g_ = a_ > b_; K[12] = g_ ? b_ : a_; K[14] = g_ ? a_ : b_; }
  { const float a_ = K[13], b_ = K[15]; const bool g_ = a_ > b_; K[13] = g_ ? b_ : a_; K[15] = g_ ? a_ : b_; }
  { const float a_ = K[0], b_ = K[1]; const bool g_ = a_ > b_; K[0] = g_ ? a_ : b_; K[1] = g_ ? b_ : a_; }
  { const float a_ = K[2], b_ = K[3]; const bool g_ = a_ > b_; K[2] = g_ ? a_ : b_; K[3] = g_ ? b_ : a_; }
  { const float a_ = K[4], b_ = K[5]; const bool g_ = a_ > b_; K[4] = g_ ? a_ : b_; K[5] = g_ ? b_ : a_; }
  { const float a_ = K[6], b_ = K[7]; const bool g_ = a_ > b_; K[6] = g_ ? a_ : b_; K[7] = g_ ? b_ : a_; }
  { const float a_ = K[8], b_ = K[9]; const bool g_ = a_ > b_; K[8] = g_ ? b_ : a_; K[9] = g_ ? a_ : b_; }
  { const float a_ = K[10], b_ = K[11]; const bool g_ = a_ > b_; K[10] = g_ ? b_ : a_; K[11] = g_ ? a_ : b_; }
  { const float a_ = K[12], b_ = K[13]; const bool g_ = a_ > b_; K[12] = g_ ? b_ : a_; K[13] = g_ ? a_ : b_; }
  { const float a_ = K[14], b_ = K[15]; const bool g_ = a_ > b_; K[14] = g_ ? b_ : a_; K[15] = g_ ? a_ : b_; }
  { const float a_ = K[0], b_ = K[8]; const bool g_ = a_ > b_; K[0] = g_ ? a_ : b_; K[8] = g_ ? b_ : a_; }
  { const float a_ = K[1], b_ = K[9]; const bool g_ = a_ > b_; K[1] = g_ ? a_ : b_; K[9] = g_ ? b_ : a_; }
  { const float a_ = K[2], b_ = K[10]; const bool g_ = a_ > b_; K[2] = g_ ? a_ : b_; K[10] = g_ ? b_ : a_; }
  { const float a_ = K[3], b_ = K[11]; const bool g_ = a_ > b_; K[3] = g_ ? a_ : b_; K[11] = g_ ? b_ : a_; }
  { const float a_ = K[4], b_ = K[12]; const bool g_ = a_ > b_; K[4] = g_ ? a_ : b_; K[12] = g_ ? b_ : a_; }
  { const float a_ = K[5], b_ = K[13]; const bool g_ = a_ > b_; K[5] = g_ ? a_ : b_; K[13] = g_ ? b_ : a_; }
  { const float a_ = K[6], b_ = K[14]; const bool g_ = a_ > b_; K[6] = g_ ? a_ : b_; K[14] = g_ ? b_ : a_; }
  { const float a_ = K[7], b_ = K[15]; const bool g_ = a_ > b_; K[7] = g_ ? a_ : b_; K[15] = g_ ? b_ : a_; }
  { const float a_ = K[0], b_ = K[4]; const bool g_ = a_ > b_; K[0] = g_ ? a_ : b_; K[4] = g_ ? b_ : a_; }
  { const float a_ = K[1], b_ = K[5]; const bool g_ = a_ > b_; K[1] = g_ ? a_ : b_; K[5] = g_ ? b_ : a_; }
  { const float a_ = K[2], b_ = K[6]; const bool g_ = a_ > b_; K[2] = g_ ? a_ : b_; K[6] = g_ ? b_ : a_; }
  { const float a_ = K[3], b_ = K[7]; const bool g_ = a_ > b_; K[3] = g_ ? a_ : b_; K[7] = g_ ? b_ : a_; }
  { const float a_ = K[8], b_ = K[12]; const bool g_ = a_ > b_; K[8] = g_ ? a_ : b_; K[12] = g_ ? b_ : a_; }
  { const float a_ = K[9], b_ = K[13]; const bool g_ = a_ > b_; K[9] = g_ ? a_ : b_; K[13] = g_ ? b_ : a_; }
  { const float a_ = K[10], b_ = K[14]; const bool g_ = a_ > b_; K[10] = g_ ? a_ : b_; K[14] = g_ ? b_ : a_; }
  { const float a_ = K[11], b_ = K[15]; const bool g_ = a_ > b_; K[11] = g_ ? a_ : b_; K[15] = g_ ? b_ : a_; }
  { const float a_ = K[0], b_ = K[2]; const bool g_ = a_ > b_; K[0] = g_ ? a_ : b_; K[2] = g_ ? b_ : a_; }
  { const float a_ = K[1], b_ = K[3]; const bool g_ = a_ > b_; K[1] = g_ ? a_ : b_; K[3] = g_ ? b_ : a_; }
  { const float a_ = K[4], b_ = K[6]; const bool g_ = a_ > b_; K[4] = g_ ? a_ : b_; K[6] = g_ ? b_ : a_; }
  { const float a_ = K[5], b_ = K[7]; const bool g_ = a_ > b_; K[5] = g_ ? a_ : b_; K[7] = g_ ? b_ : a_; }
  { const float a_ = K[8], b_ = K[10]; const bool g_ = a_ > b_; K[8] = g_ ? a_ : b_; K[10] = g_ ? b_ : a_; }
  { const float a_ = K[9], b_ = K[11]; const bool g_ = a_ > b_; K[9] = g_ ? a_ : b_; K[11] = g_ ? b_ : a_; }
  { const float a_ = K[12], b_ = K[14]; const bool g_ = a_ > b_; K[12] = g_ ? a_ : b_; K[14] = g_ ? b_ : a_; }
  { const float a_ = K[13], b_ = K[15]; const bool g_ = a_ > b_; K[13] = g_ ? a_ : b_; K[15] = g_ ? b_ : a_; }
  { const float a_ = K[0], b_ = K[1]; const bool g_ = a_ > b_; K[0] = g_ ? a_ : b_; K[1] = g_ ? b_ : a_; }
  { const float a_ = K[2], b_ = K[3]; const bool g_ = a_ > b_; K[2] = g_ ? a_ : b_; K[3] = g_ ? b_ : a_; }
  { const float a_ = K[4], b_ = K[5]; const bool g_ = a_ > b_; K[4] = g_ ? a_ : b_; K[5] = g_ ? b_ : a_; }
  { const float a_ = K[6], b_ = K[7]; const bool g_ = a_ > b_; K[6] = g_ ? a_ : b_; K[7] = g_ ? b_ : a_; }
  { const float a_ = K[8], b_ = K[9]; const bool g_ = a_ > b_; K[8] = g_ ? a_ : b_; K[9] = g_ ? b_ : a_; }
  { const float a_ = K[10], b_ = K[11]; const bool g_ = a_ > b_; K[10] = g_ ? a_ : b_; K[11] = g_ ? b_ : a_; }
  { const float a_ = K[12], b_ = K[13]; const bool g_ = a_ > b_; K[12] = g_ ? a_ : b_; K[13] = g_ ? b_ : a_; }
  { const float a_ = K[14], b_ = K[15]; const bool g_ = a_ > b_; K[14] = g_ ? a_ : b_; K[15] = g_ ? b_ : a_; }
  { const float a_ = K[16], b_ = K[17]; const bool g_ = a_ > b_; K[16] = g_ ? a_ : b_; K[17] = g_ ? b_ : a_; }
  { const float a_ = K[18], b_ = K[19]; const bool g_ = a_ > b_; K[18] = g_ ? b_ : a_; K[19] = g_ ? a_ : b_; }
  { const float a_ = K[20], b_ = K[21]; const bool g_ = a_ > b_; K[20] = g_ ? a_ : b_; K[21] = g_ ? b_ : a_; }
  { const float a_ = K[22], b_ = K[23]; const bool g_ = a_ > b_; K[22] = g_ ? b_ : a_; K[23] = g_ ? a_ : b_; }
  { const float a_ = K[24], b_ = K[25]; const bool g_ = a_ > b_; K[24] = g_ ? a_ : b_; K[25] = g_ ? b_ : a_; }
  { const float a_ = K[26], b_ = K[27]; const bool g_ = a_ > b_; K[26] = g_ ? b_ : a_; K[27] = g_ ? a_ : b_; }
  { const float a_ = K[28], b_ = K[29]; const bool g_ = a_ > b_; K[28] = g_ ? a_ : b_; K[29] = g_ ? b_ : a_; }
  { const float a_ = K[30], b_ = K[31]; const bool g_ = a_ > b_; K[30] = g_ ? b_ : a_; K[31] = g_ ? a_ : b_; }
  { const float a_ = K[16], b_ = K[18]; const bool g_ = a_ > b_; K[16] = g_ ? a_ : b_; K[18] = g_ ? b_ : a_; }
  { const float a_ = K[17], b_ = K[19]; const bool g_ = a_ > b_; K[17] = g_ ? a_ : b_; K[19] = g_ ? b_ : a_; }
  { const float a_ = K[20], b_ = K[22]; const bool g_ = a_ > b_; K[20] = g_ ? b_ : a_; K[22] = g_ ? a_ : b_; }
  { const float a_ = K[21], b_ = K[23]; const bool g_ = a_ > b_; K[21] = g_ ? b_ : a_; K[23] = g_ ? a_ : b_; }
  { const float a_ = K[24], b_ = K[26]; const bool g_ = a_ > b_; K[24] = g_ ? a_ : b_; K[26] = g_ ? b_ : a_; }
  { const float a_ = K[25], b_ = K[27]; const bool g_ = a_ > b_; K[25] = g_ ? a_ : b_; K[27] = g_ ? b_ : a_; }
  { const float a_ = K[28], b_ = K[30]; const bool g_ = a_ > b_; K[28] = g_ ? b_ : a_; K[30] = g_ ? a_ : b_; }
  { const float a_ = K[29], b_ = K[31]; const bool g_ = a_ > b_; K[29] = g_ ? b_ : a_; K[31] = g_ ? a_ : b_; }
  { const float a_ = K[16], b_ = K[17]; const bool g_ = a_ > b_; K[16] = g_ ? a_ : b_; K[17] = g_ ? b_ : a_; }
  { const float a_ = K[18], b_ = K[19]; const bool g_ = a_ > b_; K[18] = g_ ? a_ : b_; K[19] = g_ ? b_ : a_; }
  { const float a_ = K[20], b_ = K[21]; const bool g_ = a_ > b_; K[20] = g_ ? b_ : a_; K[21] = g_ ? a_ : b_; }
  { const float a_ = K[22], b_ = K[23]; const bool g_ = a_ > b_; K[22] = g_ ? b_ : a_; K[23] = g_ ? a_ : b_; }
  { const float a_ = K[24], b_ = K[25]; const bool g_ = a_ > b_; K[24] = g_ ? a_ : b_; K[25] = g_ ? b_ : a_; }
  { const float a_ = K[26], b_ = K[27]; const bool g_ = a_ > b_; K[26] = g_ ? a_ : b_; K[27] = g_ ? b_ : a_; }
  { const float a_ = K[28], b_ = K[29]; const bool g_ = a_ > b_; K[28] = g_ ? b_ : a_; K[29] = g_ ? a_ : b_; }
  { const float a_ = K[30], b_ = K[31]; const bool g_ = a_ > b_; K[30] = g_ ? b_ : a_; K[31] = g_ ? a_ : b_; }
  { const float a_ = K[16], b_ = K[20]; const bool g_ = a_ > b_; K[16] = g_ ? a_ : b_; K[20] = g_ ? b_ : a_; }
  { const float a_ = K[17], b_ = K[21]; const bool g_ = a_ > b_; K[17] = g_ ? a_ : b_; K[21] = g_ ? b_ : a_; }
  { const float a_ = K[18], b_ = K[22]; const bool g_ = a_ > b_; K[18] = g_ ? a_ : b_; K[22] = g_ ? b_ : a_; }
  { const float a_ = K[19], b_ = K[23]; const bool g_ = a_ > b_; K[19] = g_ ? a_ : b_; K[23] = g_ ? b_ : a_; }
  { const float a_ = K[24], b_ = K[28]; const bool g_ = a_ > b_; K[24] = g_ ? b_ : a_; K[28] = g_ ? a_ : b_; }
  { const float a_ = K[25], b_ = K[29]; const bool g_ = a_ > b_; K[25] = g_ ? b_ : a_; K[29] = g_ ? a_ : b_; }
  { const float a_ = K[26], b_ = K[30]; const bool g_ = a_ > b_; K[26] = g_ ? b_ : a_; K[30] = g_ ? a_ : b_; }
  { const float a_ = K[27], b_ = K[31]; const bool g_ = a_ > b_; K[27] = g_ ? b_ : a_; K[31] = g_ ? a_ : b_; }
  { const float a_ = K[16], b_ = K[18]; const bool g_ = a_ > b_; K[16] = g_ ? a_ : b_; K[18] = g_ ? b_ : a_; }
  { const float a_ = K[17], b_ = K[19]; const bool g_ = a_ > b_; K[17] = g_ ? a_ : b_; K[19] = g_ ? b_ : a_; }
  { const float a_ = K[20], b_ = K[22]; const bool g_ = a_ > b_; K[20] = g_ ? a_ : b_; K[22] = g_ ? b_ : a_; }
  { const float a_ = K[21], b_ = K[23]; const bool g_ = a_ > b_; K[21] = g_ ? a_ : b_; K[23] = g_ ? b_ : a_; }
  { const float a_ = K[24], b_ = K[26]; const bool g_ = a_ > b_; K[24] = g_ ? b_ : a_; K[26] = g_ ? a_ : b_; }
  { const float a_ = K[25], b_ = K[27]; const bool g_ = a_ > b_; K[25] = g_ ? b_ : a_; K[27] = g_ ? a_ : b_; }
  { const float a_ = K[28], b_ = K[30]; const bool g_ = a_ > b_; K[28] = g_ ? b_ : a_; K[30] = g_ ? a_ : b_; }
  { const float a_ = K[29], b_ = K[31]; const bool g_ = a_ > b_; K[29] = g_ ? b_ : a_; K[31] = g_ ? a_ : b_; }
  { const float a_ = K[16], b_ = K[17]; const bool g_ = a_ > b_; K[16] = g_ ? a_ : b_; K[17] = g_ ? b_ : a_; }
  { const float a_ = K[18], b_ = K[19]; const bool g_ = a_ > b_; K[18] = g_ ? a_ : b_; K[19] = g_ ? b_ : a_; }
  { const float a_ = K[20], b_ = K[21]; const bool g_ = a_ > b_; K[20] = g_ ? a_ : b_; K[21] = g_ ? b_ : a_; }
  { const float a_ = K[22], b_ = K[23]; const bool g_ = a_ > b_; K[22] = g_ ? a_ : b_; K[23] = g_ ? b_ : a_; }
  { const float a_ = K[24], b_ = K[25]; const bool g_ = a_ > b_; K[24] = g_ ? b_ : a_; K[25] = g_ ? a_ : b_; }
  { const float a_ = K[26], b_ = K[27]; const bool g_ = a_ > b_; K[26] = g_ ? b_ : a_; K[27] = g_ ? a_ : b_; }
  { const float a_ = K[28], b_ = K[29]; const bool g_ = a_ > b_; K[28] = g_ ? b_ : a_; K[29] = g_ ? a_ : b_; }
  { const float a_ = K[30], b_ = K[31]; const bool g_ = a_ > b_; K[30] = g_ ? b_ : a_; K[31] = g_ ? a_ : b_; }
  { const float a_ = K[16], b_ = K[24]; const bool g_ = a_ > b_; K[16] = g_ ? a_ : b_; K[24] = g_ ? b_ : a_; }
  { const float a_ = K[17], b_ = K[25]; const bool g_ = a_ > b_; K[17] = g_ ? a_ : b_; K[25] = g_ ? b_ : a_; }
  { const float a_ = K[18], b_ = K[26]; const bool g_ = a_ > b_; K[18] = g_ ? a_ : b_; K[26] = g_ ? b_ : a_; }
  { const float a_ = K[19], b_ = K[27]; const bool g_ = a_ > b_; K[19] = g_ ? a_ : b_; K[27] = g_ ? b_ : a_; }
  { const float a_ = K[20], b_ = K[28]; const bool g_ = a_ > b_; K[20] = g_ ? a_ : b_; K[28] = g_ ? b_ : a_; }
  { const float a_ = K[21], b_ = K[29]; const bool g_ = a_ > b_; K[21] = g_ ? a_ : b_; K[29] = g_ ? b_ : a_; }
  { const float a_ = K[22], b_ = K[30]; const bool g_ = a_ > b_; K[22] = g_ ? a_ : b_; K[30] = g_ ? b_ : a_; }
  { const float a_ = K[23], b_ = K[31]; const bool g_ = a_ > b_; K[23] = g_ ? a_ : b_; K[31] = g_ ? b_ : a_; }
  { const float a_ = K[16], b_ = K[20]; const bool g_ = a_ > b_; K[16] = g_ ? a_ : b_; K[20] = g_ ? b_ : a_; }
  { const float a_ = K[17], b_ = K[21]; const bool g_ = a_ > b_; K[17] = g_ ? a_ : b_; K[21] = g_ ? b_ : a_; }
  { const float a_ = K[18], b_ = K[22]; const bool g_ = a_ > b_; K[18] = g_ ? a_ : b_; K[22] = g_ ? b_ : a_; }
  { const float a_ = K[19], b_ = K[23]; const bool g_ = a_ > b_; K[19] = g_ ? a_ : b_; K[23] = g_ ? b_ : a_; }
  { const float a_ = K[24], b_ = K[28]; const bool g_ = a_ > b_; K[24] = g_ ? a_ : b_; K[28] = g_ ? b_ : a_; }
  { const float a_ = K[25], b_ = K[29]; const bool g_ = a_ > b_; K[25] = g_ ? a_ : b_; K[29] = g_ ? b_ : a_; }
  { const float a_ = K[26], b_ = K[30]; const bool g_ = a_ > b_; K[26] = g_ ? a_ : b_; K[30] = g_ ? b_ : a_; }
  { const float a_ = K[27], b_ = K[31]; const bool g_ = a_ > b_; K[27] = g_ ? a_ : b_; K[31] = g_ ? b_ : a_; }
  { const float a_ = K[16], b_ = K[18]; const bool g_ = a_ > b_; K[16] = g_ ? a_ : b_; K[18] = g_ ? b_ : a_; }
  { const float a_ = K[17], b_ = K[19]; const bool g_ = a_ > b_; K[17] = g_ ? a_ : b_; K[19] = g_ ? b_ : a_; }
  { const float a_ = K[20], b_ = K[22]; const bool g_ = a_ > b_; K[20] = g_ ? a_ : b_; K[22] = g_ ? b_ : a_; }
  { const float a_ = K[21], b_ = K[23]; const bool g_ = a_ > b_; K[21] = g_ ? a_ : b_; K[23] = g_ ? b_ : a_; }
  { const float a_ = K[24], b_ = K[26]; const bool g_ = a_ > b_; K[24] = g_ ? a_ : b_; K[26] = g_ ? b_ : a_; }
  { const float a_ = K[25], b_ = K[27]; const bool g_ = a_ > b_; K[25] = g_ ? a_ : b_; K[27] = g_ ? b_ : a_; }
  { const float a_ = K[28], b_ = K[30]; const bool g_ = a_ > b_; K[28] = g_ ? a_ : b_; K[30] = g_ ? b_ : a_; }
  { const float a_ = K[29], b_ = K[31]; const bool g_ = a_ > b_; K[29] = g_ ? a_ : b_; K[31] = g_ ? b_ : a_; }
  { const float a_ = K[16], b_ = K[17]; const bool g_ = a_ > b_; K[16] = g_ ? a_ : b_; K[17] = g_ ? b_ : a_; }
  { const float a_ = K[18], b_ = K[19]; const bool g_ = a_ > b_; K[18] = g_ ? a_ : b_; K[19] = g_ ? b_ : a_; }
  { const float a_ = K[20], b_ = K[21]; const bool g_ = a_ > b_; K[20] = g_ ? a_ : b_; K[21] = g_ ? b_ : a_; }
  { const float a_ = K[22], b_ = K[23]; const bool g_ = a_ > b_; K[22] = g_ ? a_ : b_; K[23] = g_ ? b_ : a_; }
  { const float a_ = K[24], b_ = K[25]; const bool g_ = a_ > b_; K[24] = g_ ? a_ : b_; K[25] = g_ ? b_ : a_; }
  { const float a_ = K[26], b_ = K[27]; const bool g_ = a_ > b_; K[26] = g_ ? a_ : b_; K[27] = g_ ? b_ : a_; }
  { const float a_ = K[28], b_ = K[29]; const bool g_ = a_ > b_; K[28] = g_ ? a_ : b_; K[29] = g_ ? b_ : a_; }
  { const float a_ = K[30], b_ = K[31]; const bool g_ = a_ > b_; K[30] = g_ ? a_ : b_; K[31] = g_ ? b_ : a_; }
  { const float a_ = K[32], b_ = K[33]; const bool g_ = a_ > b_; K[32] = g_ ? a_ : b_; K[33] = g_ ? b_ : a_; }
  { const float a_ = K[34], b_ = K[35]; const bool g_ = a_ > b_; K[34] = g_ ? b_ : a_; K[35] = g_ ? a_ : b_; }
  { const float a_ = K[36], b_ = K[37]; const bool g_ = a_ > b_; K[36] = g_ ? a_ : b_; K[37] = g_ ? b_ : a_; }
  { const float a_ = K[38], b_ = K[39]; const bool g_ = a_ > b_; K[38] = g_ ? b_ : a_; K[39] = g_ ? a_ : b_; }
  { const float a_ = K[40], b_ = K[41]; const bool g_ = a_ > b_; K[40] = g_ ? a_ : b_; K[41] = g_ ? b_ : a_; }
  { const float a_ = K[42], b_ = K[43]; const bool g_ = a_ > b_; K[42] = g_ ? b_ : a_; K[43] = g_ ? a_ : b_; }
  { const float a_ = K[44], b_ = K[45]; const bool g_ = a_ > b_; K[44] = g_ ? a_ : b_; K[45] = g_ ? b_ : a_; }
  { const float a_ = K[46], b_ = K[47]; const bool g_ = a_ > b_; K[46] = g_ ? b_ : a_; K[47] = g_ ? a_ : b_; }
  { const float a_ = K[32], b_ = K[34]; const bool g_ = a_ > b_; K[32] = g_ ? a_ : b_; K[34] = g_ ? b_ : a_; }
  { const float a_ = K[33], b_ = K[35]; const bool g_ = a_ > b_; K[33] = g_ ? a_ : b_; K[35] = g_ ? b_ : a_; }
  { const float a_ = K[36], b_ = K[38]; const bool g_ = a_ > b_; K[36] = g_ ? b_ : a_; K[38] = g_ ? a_ : b_; }
  { const float a_ = K[37], b_ = K[39]; const bool g_ = a_ > b_; K[37] = g_ ? b_ : a_; K[39] = g_ ? a_ : b_; }
  { const float a_ = K[40], b_ = K[42]; const bool g_ = a_ > b_; K[40] = g_ ? a_ : b_; K[42] = g_ ? b_ : a_; }
  { const float a_ = K[41], b_ = K[43]; const bool g_ = a_ > b_; K[41] = g_ ? a_ : b_; K[43] = g_ ? b_ : a_; }
  { const float a_ = K[44], b_ = K[46]; const bool g_ = a_ > b_; K[44] = g_ ? b_ : a_; K[46] = g_ ? a_ : b_; }
  { const float a_ = K[45], b_ = K[47]; const bool g_ = a_ > b_; K[45] = g_ ? b_ : a_; K[47] = g_ ? a_ : b_; }
  { const float a_ = K[32], b_ = K[33]; const bool g_ = a_ > b_; K[32] = g_ ? a_ : b_; K[33] = g_ ? b_ : a_; }
  { const float a_ = K[34], b_ = K[35]; const bool g_ = a_ > b_; K[34] = g_ ? a_ : b_; K[35] = g_ ? b_ : a_; }
  { const float a_ = K[36], b_ = K[37]; const bool g_ = a_ > b_; K[36] = g_ ? b_ : a_; K[37] = g_ ? a_ : b_; }
  { const float a_ = K[38], b_ = K[39]; const bool g_ = a_ > b_; K[38] = g_ ? b_ : a_; K[39] = g_ ? a_ : b_; }
  { const float a_ = K[40], b_ = K[41]; const bool g_ = a_ > b_; K[40] = g_ ? a_ : b_; K[41] = g_ ? b_ : a_; }
  { const float a_ = K[42], b_ = K[43]; const bool g_ = a_ > b_; K[42] = g_ ? a_ : b_; K[43] = g_ ? b_ : a_; }
  { const float a_ = K[44], b_ = K[45]; const bool g_ = a_ > b_; K[44] = g_ ? b_ : a_; K[45] = g_ ? a_ : b_; }
  { const float a_ = K[46], b_ = K[47]; const bool g_ = a_ > b_; K[46] = g_ ? b_ : a_; K[47] = g_ ? a_ : b_; }
  { const float a_ = K[32], b_ = K[36]; const bool g_ = a_ > b_; K[32] = g_ ? a_ : b_; K[36] = g_ ? b_ : a_; }
  { const float a_ = K[33], b_ = K[37]; const bool g_ = a_ > b_; K[33] = g_ ? a_ : b_; K[37] = g_ ? b_ : a_; }
  { const float a_ = K[34], b_ = K[38]; const bool g_ = a_ > b_; K[34] = g_ ? a_ : b_; K[38] = g_ ? b_ : a_; }
  { const float a_ = K[35], b_ = K[39]; const bool g_ = a_ > b_; K[35] = g_ ? a_ : b_; K[39] = g_ ? b_ : a_; }
  { const float a_ = K[40], b_ = K[44]; const bool g_ = a_ > b_; K[40] = g_ ? b_ : a_; K[44] = g_ ? a_ : b_; }
  { const float a_ = K[41], b_ = K[45]; const bool g_ = a_ > b_; K[41] = g_ ? b_ : a_; K[45] = g_ ? a_ : b_; }
  { const float a_ = K[42], b_ = K[46]; const bool g_ = a_ > b_; K[42] = g_ ? b_ : a_; K[46] = g_ ? a_ : b_; }
  { const float a_ = K[43], b_ = K[47]; const bool g_ = a_ > b_; K[43] = g_ ? b_ : a_; K[47] = g_ ? a_ : b_; }
  { const float a_ = K[32], b_ = K[34]; const bool g_ = a_ > b_; K[32] = g_ ? a_ : b_; K[34] = g_ ? b_ : a_; }
  { const float a_ = K[33], b_ = K[35]; const bool g_ = a_ > b_; K[33] = g_ ? a_ : b_; K[35] = g_ ? b_ : a_; }
  { const float a_ = K[36], b_ = K[38]; const bool g_ = a_ > b_; K[36] = g_ ? a_ : b_; K[38] = g_ ? b_ : a_; }
  { const float a_ = K[37], b_ = K[39]; const bool g_ = a_ > b_; K[37] = g_ ? a_ : b_; K[39] = g_ ? b_ : a_; }
  { const float a_ = K[40], b_ = K[42]; const bool g_ = a_ > b_; K[40] = g_ ? b_ : a_; K[42] = g_ ? a_ : b_; }
  { const float a_ = K[41], b_ = K[43]; const bool g_ = a_ > b_; K[41] = g_ ? b_ : a_; K[43] = g_ ? a_ : b_; }
  { const float a_ = K[44], b_ = K[46]; const bool g_ = a_ > b_; K[44] = g_ ? b_ : a_; K[46] = g_ ? a_ : b_; }
  { const float a_ = K[45], b_ = K[47]; const bool g_ = a_ > b_; K[45] = g_ ? b_ : a_; K[47] = g_ ? a_ : b_; }
  { const float a_ = K[32], b_ = K[33]; const bool g_ = a_ > b_; K[32] = g_ ? a_ : b_; K[33] = g_ ? b_ : a_; }
  { const float a_ = K[34], b_ = K[35]; const bool g_ = a_ > b_; K[34] = g_ ? a_ : b_; K[35] = g_ ? b_ : a_; }
  { const float a_ = K[36], b_ = K[37]; const bool g_ = a_ > b_; K[36] = g_ ? a_ : b_; K[37] = g_ ? b_ : a_; }
  { const float a_ = K[38], b_ = K[39]; const bool g_ = a_ > b_; K[38] = g_ ? a_ : b_; K[39] = g_ ? b_ : a_; }
  { const float a_ = K[40], b_ = K[41]; const bool g_ = a_ > b_; K[40] = g_ ? b_ : a_; K[41] = g_ ? a_ : b_; }
  { const float a_ = K[42], b_ = K[43]; const bool g_ = a_ > b_; K[42] = g_ ? b_ : a_; K[43] = g_ ? a_ : b_; }
  { const float a_ = K[44], b_ = K[45]; const bool g_ = a_ > b_; K[44] = g_ ? b_ : a_; K[45] = g_ ? a_ : b_; }
  { const float a_ = K[46], b_ = K[47]; const bool g_ = a_ > b_; K[46] = g_ ? b_ : a_; K[47] = g_ ? a_ : b_; }
  { const float a_ = K[32], b_ = K[40]; const bool g_ = a_ > b_; K[32] = g_ ? a_ : b_; K[40] = g_ ? b_ : a_; }
  { const float a_ = K[33], b_ = K[41]; const bool g_ = a_ > b_; K[33] = g_ ? a_ : b_; K[41] = g_ ? b_ : a_; }
  { const float a_ = K[34], b_ = K[42]; const bool g_ = a_ > b_; K[34] = g_ ? a_ : b_; K[42] = g_ ? b_ : a_; }
  { const float a_ = K[35], b_ = K[43]; const bool g_ = a_ > b_; K[35] = g_ ? a_ : b_; K[43] = g_ ? b_ : a_; }
  { const float a_ = K[36], b_ = K[44]; const bool g_ = a_ > b_; K[36] = g_ ? a_ : b_; K[44] = g_ ? b_ : a_; }
  { const float a_ = K[37], b_ = K[45]; const bool g_ = a_ > b_; K[37] = g_ ? a_ : b_; K[45] = g_ ? b_ : a_; }
  { const float a_ = K[38], b_ = K[46]; const bool g_ = a_ > b_; K[38] = g_ ? a_ : b_; K[46] = g_ ? b_ : a_; }
  { const float a_ = K[39], b_ = K[47]; const bool g_ = a_ > b_; K[39] = g_ ? a_ : b_; K[47] = g_ ? b_ : a_; }
  { const float a_ = K[32], b_ = K[36]; const bool g_ = a_ > b_; K[32] = g_ ? a_ : b_; K[36] = g_ ? b_ : a_; }
  { const float a_ = K[33], b_ = K[37]; const bool g_ = a_ > b_; K[33] = g_ ? a_ : b_; K[37] = g_ ? b_ : a_; }
  { const float a_ = K[34], b_ = K[38]; const bool g_ = a_ > b_; K[34] = g_ ? a_ : b_; K[38] = g_ ? b_ : a_; }
  { const float a_ = K[35], b_ = K[39]; const bool g_ = a_ > b_; K[35] = g_ ? a_ : b_; K[39] = g_ ? b_ : a_; }
  { const float a_ = K[40], b_ = K[44]; const bool g_ = a_ > b_; K[40] = g_ ? a_ : b_; K[44] = g_ ? b_ : a_; }
  { const float a_ = K[41], b_ = K[45]; const bool g_ = a_ > b_; K[41] = g_ ? a_ : b_; K[45] = g_ ? b_ : a_; }
  { const float a_ = K[42], b_ = K[46]; const bool g_ = a_ > b_; K[42] = g_ ? a_ : b_; K[46] = g_ ? b_ : a_; }
  { const float a_ = K[43], b_ = K[47]; const bool g_ = a_ > b_; K[43] = g_ ? a_ : b_; K[47] = g_ ? b_ : a_; }
  { const float a_ = K[32], b_ = K[34]; const bool g_ = a_ > b_; K[32] = g_ ? a_ : b_; K[34] = g_ ? b_ : a_; }
  { const float a_ = K[33], b_ = K[35]; const bool g_ = a_ > b_; K[33] = g_ ? a_ : b_; K[35] = g_ ? b_ : a_; }
  { const float a_ = K[36], b_ = K[38]; const bool g_ = a_ > b_; K[36] = g_ ? a_ : b_; K[38] = g_ ? b_ : a_; }
  { const float a_ = K[37], b_ = K[39]; const bool g_ = a_ > b_; K[37] = g_ ? a_ : b_; K[39] = g_ ? b_ : a_; }
  { const float a_ = K[40], b_ = K[42]; const bool g_ = a_ > b_; K[40] = g_ ? a_ : b_; K[42] = g_ ? b_ : a_; }
  { const float a_ = K[41], b_ = K[43]; const bool g_ = a_ > b_; K[41] = g_ ? a_ : b_; K[43] = g_ ? b_ : a_; }
  { const float a_ = K[44], b_ = K[46]; const bool g_ = a_ > b_; K[44] = g_ ? a_ : b_; K[46] = g_ ? b_ : a_; }
  { const float a_ = K[45], b_ = K[47]; const bool g_ = a_ > b_; K[45] = g_ ? a_ : b_; K[47] = g_ ? b_ : a_; }
  { const float a_ = K[32], b_ = K[33]; const bool g_ = a_ > b_; K[32] = g_ ? a_ : b_; K[33] = g_ ? b_ : a_; }
  { const float a_ = K[34], b_ = K[35]; const bool g_ = a_ > b_; K[34] = g_ ? a_ : b_; K[35] = g_ ? b_ : a_; }
  { const float a_ = K[36], b_ = K[37]; const bool g_ = a_ > b_; K[36] = g_ ? a_ : b_; K[37] = g_ ? b_ : a_; }
  { const float a_ = K[38], b_ = K[39]; const bool g_ = a_ > b_; K[38] = g_ ? a_ : b_; K[39] = g_ ? b_ : a_; }
  { const float a_ = K[40], b_ = K[41]; const bool g_ = a_ > b_; K[40] = g_ ? a_ : b_; K[41] = g_ ? b_ : a_; }
  { const float a_ = K[42], b_ = K[43]; const bool g_ = a_ > b_; K[42] = g_ ? a_ : b_; K[43] = g_ ? b_ : a_; }
  { const float a_ = K[44], b_ = K[45]; const bool g_ = a_ > b_; K[44] = g_ ? a_ : b_; K[45] = g_ ? b_ : a_; }
  { const float a_ = K[46], b_ = K[47]; const bool g_ = a_ > b_; K[46] = g_ ? a_ : b_; K[47] = g_ ? b_ : a_; }
  { const float a_ = K[48], b_ = K[49]; const bool g_ = a_ > b_; K[48] = g_ ? a_ : b_; K[49] = g_ ? b_ : a_; }
  { const float a_ = K[50], b_ = K[51]; const bool g_ = a_ > b_; K[50] = g_ ? b_ : a_; K[51] = g_ ? a_ : b_; }
  { const float a_ = K[52], b_ = K[53]; const bool g_ = a_ > b_; K[52] = g_ ? a_ : b_; K[53] = g_ ? b_ : a_; }
  { const float a_ = K[54], b_ = K[55]; const bool g_ = a_ > b_; K[54] = g_ ? b_ : a_; K[55] = g_ ? a_ : b_; }
  { const float a_ = K[56], b_ = K[57]; const bool g_ = a_ > b_; K[56] = g_ ? a_ : b_; K[57] = g_ ? b_ : a_; }
  { const float a_ = K[58], b_ = K[59]; const bool g_ = a_ > b_; K[58] = g_ ? b_ : a_; K[59] = g_ ? a_ : b_; }
  { const float a_ = K[60], b_ = K[61]; const bool g_ = a_ > b_; K[60] = g_ ? a_ : b_; K[61] = g_ ? b_ : a_; }
  { const float a_ = K[62], b_ = K[63]; const bool g_ = a_ > b_; K[62] = g_ ? b_ : a_; K[63] = g_ ? a_ : b_; }
  { const float a_ = K[48], b_ = K[50]; const bool g_ = a_ > b_; K[48] = g_ ? a_ : b_; K[50] = g_ ? b_ : a_; }
  { const float a_ = K[49], b_ = K[51]; const bool g_ = a_ > b_; K[49] = g_ ? a_ : b_; K[51] = g_ ? b_ : a_; }
  { const float a_ = K[52], b_ = K[54]; const bool g_ = a_ > b_; K[52] = g_ ? b_ : a_; K[54] = g_ ? a_ : b_; }
  { const float a_ = K[53], b_ = K[55]; const bool g_ = a_ > b_; K[53] = g_ ? b_ : a_; K[55] = g_ ? a_ : b_; }
  { const float a_ = K[56], b_ = K[58]; const bool g_ = a_ > b_; K[56] = g_ ? a_ : b_; K[58] = g_ ? b_ : a_; }
  { const float a_ = K[57], b_ = K[59]; const bool g_ = a_ > b_; K[57] = g_ ? a_ : b_; K[59] = g_ ? b_ : a_; }
  { const float a_ = K[60], b_ = K[62]; const bool g_ = a_ > b_; K[60] = g_ ? b_ : a_; K[62] = g_ ? a_ : b_; }
  { const float a_ = K[61], b_ = K[63]; const bool g_ = a_ > b_; K[61] = g_ ? b_ : a_; K[63] = g_ ? a_ : b_; }
  { const float a_ = K[48], b_ = K[49]; const bool g_ = a_ > b_; K[48] = g_ ? a_ : b_; K[49] = g_ ? b_ : a_; }
  { const float a_ = K[50], b_ = K[51]; const bool g_ = a_ > b_; K[50] = g_ ? a_ : b_; K[51] = g_ ? b_ : a_; }
  { const float a_ = K[52], b_ = K[53]; const bool g_ = a_ > b_; K[52] = g_ ? b_ : a_; K[53] = g_ ? a_ : b_; }
  { const float a_ = K[54], b_ = K[55]; const bool g_ = a_ > b_; K[54] = g_ ? b_ : a_; K[55] = g_ ? a_ : b_; }
  { const float a_ = K[56], b_ = K[57]; const bool g_ = a_ > b_; K[56] = g_ ? a_ : b_; K[57] = g_ ? b_ : a_; }
  { const float a_ = K[58], b_ = K[59]; const bool g_ = a_ > b_; K[58] = g_ ? a_ : b_; K[59] = g_ ? b_ : a_; }
  { const float a_ = K[60], b_ = K[61]; const bool g_ = a_ > b_; K[60] = g_ ? b_ : a_; K[61] = g_ ? a_ : b_; }
  { const float a_ = K[62], b_ = K[63]; const bool g_ = a_ > b_; K[62] = g_ ? b_ : a_; K[63] = g_ ? a_ : b_; }
  { const float a_ = K[48], b_ = K[52]; const bool g_ = a_ > b_; K[48] = g_ ? a_ : b_; K[52] = g_ ? b_ : a_; }
  { const float a_ = K[49], b_ = K[53]; const bool g_ = a_ > b_; K[49] = g_ ? a_ : b_; K[53] = g_ ? b_ : a_; }
  { const float a_ = K[50], b_ = K[54]; const bool g_ = a_ > b_; K[50] = g_ ? a_ : b_; K[54] = g_ ? b_ : a_; }
  { const float a_ = K[51], b_ = K[55]; const bool g_ = a_ > b_; K[51] = g_ ? a_ : b_; K[55] = g_ ? b_ : a_; }
  { const float a_ = K[56], b_ = K[60]; const bool g_ = a_ > b_; K[56] = g_ ? b_ : a_; K[60] = g_ ? a_ : b_; }
  { const float a_ = K[57], b_ = K[61]; const bool g_ = a_ > b_; K[57] = g_ ? b_ : a_; K[61] = g_ ? a_ : b_; }
  { const float a_ = K[58], b_ = K[62]; const bool g_ = a_ > b_; K[58] = g_ ? b_ : a_; K[62] = g_ ? a_ : b_; }
  { const float a_ = K[59], b_ = K[63]; const bool g_ = a_ > b_; K[59] = g_ ? b_ : a_; K[63] = g_ ? a_ : b_; }
  { const float a_ = K[48], b_ = K[50]; const bool g_ = a_ > b_; K[48] = g_ ? a_ : b_; K[50] = g_ ? b_ : a_; }
  { const float a_ = K[49], b_ = K[51]; const bool g_ = a_ > b_; K[49] = g_ ? a_ : b_; K[51] = g_ ? b_ : a_; }
  { const float a_ = K[52], b_ = K[54]; const bool g_ = a_ > b_; K[52] = g_ ? a_ : b_; K[54] = g_ ? b_ : a_; }
  { const float a_ = K[53], b_ = K[55]; const bool g_ = a_ > b_; K[53] = g_ ? a_ : b_; K[55] = g_ ? b_ : a_; }
  { const float a_ = K[56], b_ = K[58]; const bool g_ = a_ > b_; K[56] = g_ ? b_ : a_; K[58] = g_ ? a_ : b_; }
  { const float a_ = K[57], b_ = K[59]; const bool g_ = a_ > b_; K[57] = g_ ? b_ : a_; K[59] = g_ ? a_ : b_; }
  { const float a_ = K[60], b_ = K[62]; const bool g_ = a_ > b_; K[60] = g_ ? b_ : a_; K[62] = g_ ? a_ : b_; }
  { const float a_ = K[61], b_ = K[63]; const bool g_ = a_ > b_; K[61] = g_ ? b_ : a_; K[63] = g_ ? a_ : b_; }
  { const float a_ = K[48], b_ = K[49]; const bool g_ = a_ > b_; K[48] = g_ ? a_ : b_; K[49] = g_ ? b_ : a_; }
  { const float a_ = K[50], b_ = K[51]; const bool g_ = a_ > b_; K[50] = g_ ? a_ : b_; K[51] = g_ ? b_ : a_; }
  { const float a_ = K[52], b_ = K[53]; const bool g_ = a_ > b_; K[52] = g_ ? a_ : b_; K[53] = g_ ? b_ : a_; }
  { const float a_ = K[54], b_ = K[55]; const bool g_ = a_ > b_; K[54] = g_ ? a_ : b_; K[55] = g_ ? b_ : a_; }
  { const float a_ = K[56], b_ = K[57]; const bool g_ = a_ > b_; K[56] = g_ ? b_ : a_; K[57] = g_ ? a_ : b_; }
  { const float a_ = K[58], b_ = K[59]; const bool g_ = a_ > b_; K[58] = g_ ? b_ : a_; K[59] = g_ ? a_ : b_; }
  { const float a_ = K[60], b_ = K[61]; const bool g_ = a_ > b_; K[60] = g_ ? b_ : a_; K[61] = g_ ? a_ : b_; }
  { const float a_ = K[62], b_ = K[63]; const bool g_ = a_ > b_; K[62] = g_ ? b_ : a_; K[63] = g_ ? a_ : b_; }
  { const float a_ = K[48], b_ = K[56]; const bool g_ = a_ > b_; K[48] = g_ ? a_ : b_; K[56] = g_ ? b_ : a_; }
  { const float a_ = K[49], b_ = K[57]; const bool g_ = a_ > b_; K[49] = g_ ? a_ : b_; K[57] = g_ ? b_ : a_; }
  { const float a_ = K[50], b_ = K[58]; const bool g_ = a_ > b_; K[50] = g_ ? a_ : b_; K[58] = g_ ? b_ : a_; }
  { const float a_ = K[51], b_ = K[59]; const bool g_ = a_ > b_; K[51] = g_ ? a_ : b_; K[59] = g_ ? b_ : a_; }
  { const float a_ = K[52], b_ = K[60]; const bool g_ = a_ > b_; K[52] = g_ ? a_ : b_; K[60] = g_ ? b_ : a_; }
  { const float a_ = K[53], b_ = K[61]; const bool g_ = a_ > b_; K[53] = g_ ? a_ : b_; K[61] = g_ ? b_ : a_; }
  { const float a_ = K[54], b_ = K[62]; const bool g_ = a_ > b_; K[54] = g_ ? a_ : b_; K[62] = g_ ? b_ : a_; }
  { const float a_ = K[55], b_ = K[63]; const bool g_ = a_ > b_; K[55] = g_ ? a_ : b_; K[63] = g_ ? b_ : a_; }
  { const float a_ = K[48], b_ = K[52]; const bool g_ = a_ > b_; K[48] = g_ ? a_ : b_; K[52] = g_ ? b_ : a_; }
  { const float a_ = K[49], b_ = K[53]; const bool g_ = a_ > b_; K[49] = g_ ? a_ : b_; K[53] = g_ ? b_ : a_; }
  { const float a_ = K[50], b_ = K[54]; const bool g_ = a_ > b_; K[50] = g_ ? a_ : b_; K[54] = g_ ? b_ : a_; }
  { const float a_ = K[51], b_ = K[55]; const bool g_ = a_ > b_; K[51] = g_ ? a_ : b_; K[55] = g_ ? b_ : a_; }
  { const float a_ = K[56], b_ = K[60]; const bool g_ = a_ > b_; K[56] = g_ ? a_ : b_; K[60] = g_ ? b_ : a_; }
  { const float a_ = K[57], b_ = K[61]; const bool g_ = a_ > b_; K[57] = g_ ? a_ : b_; K[61] = g_ ? b_ : a_; }
  { const float a_ = K[58], b_ = K[62]; const bool g_ = a_ > b_; K[58] = g_ ? a_ : b_; K[62] = g_ ? b_ : a_; }
  { const float a_ = K[59], b_ = K[63]; const bool g_ = a_ > b_; K[59] = g_ ? a_ : b_; K[63] = g_ ? b_ : a_; }
  { const float a_ = K[48], b_ = K[50]; const bool g_ = a_ > b_; K[48] = g_ ? a_ : b_; K[50] = g_ ? b_ : a_; }
  { const float a_ = K[49], b_ = K[51]; const bool g_ = a_ > b_; K[49] = g_ ? a_ : b_; K[51] = g_ ? b_ : a_; }
  { const float a_ = K[52], b_ = K[54]; const bool g_ = a_ > b_; K[52] = g_ ? a_ : b_; K[54] = g_ ? b_ : a_; }
  { const float a_ = K[53], b_ = K[55]; const bool g_ = a_ > b_; K[53] = g_ ? a_ : b_; K[55] = g_ ? b_ : a_; }
  { const float a_ = K[56], b_ = K[58]; const bool g_ = a_ > b_; K[56] = g_ ? a_ : b_; K[58] = g_ ? b_ : a_; }
  { const float a_ = K[57], b_ = K[59]; const bool g_ = a_ > b_; K[57] = g_ ? a_ : b_; K[59] = g_ ? b_ : a_; }
  { const float a_ = K[60], b_ = K[62]; const bool g_ = a_ > b_; K[60] = g_ ? a_ : b_; K[62] = g_ ? b_ : a_; }
  { const float a_ = K[61], b_ = K[63]; const bool g_ = a_ > b_; K[61] = g_ ? a_ : b_; K[63] = g_ ? b_ : a_; }
  { const float a_ = K[48], b_ = K[49]; const bool g_ = a_ > b_; K[48] = g_ ? a_ : b_; K[49] = g_ ? b_ : a_; }
  { const float a_ = K[50], b_ = K[51]; const bool g_ = a_ > b_; K[50] = g_ ? a_ : b_; K[51] = g_ ? b_ : a_; }
  { const float a_ = K[52], b_ = K[53]; const bool g_ = a_ > b_; K[52] = g_ ? a_ : b_; K[53] = g_ ? b_ : a_; }
  { const float a_ = K[54], b_ = K[55]; const bool g_ = a_ > b_; K[54] = g_ ? a_ : b_; K[55] = g_ ? b_ : a_; }
  { const float a_ = K[56], b_ = K[57]; const bool g_ = a_ > b_; K[56] = g_ ? a_ : b_; K[57] = g_ ? b_ : a_; }
  { const float a_ = K[58], b_ = K[59]; const bool g_ = a_ > b_; K[58] = g_ ? a_ : b_; K[59] = g_ ? b_ : a_; }
  { const float a_ = K[60], b_ = K[61]; const bool g_ = a_ > b_; K[60] = g_ ? a_ : b_; K[61] = g_ ? b_ : a_; }
  { const float a_ = K[62], b_ = K[63]; const bool g_ = a_ > b_; K[62] = g_ ? a_ : b_; K[63] = g_ ? b_ : a_; }
  { const float a_ = K[0], b_ = K[31]; K[0] = a_ > b_ ? a_ : b_; }
  { const float a_ = K[1], b_ = K[30]; K[1] = a_ > b_ ? a_ : b_; }
  { const float a_ = K[2], b_ = K[29]; K[2] = a_ > b_ ? a_ : b_; }
  { const float a_ = K[3], b_ = K[28]; K[3] = a_ > b_ ? a_ : b_; }
  { const float a_ = K[4], b_ = K[27]; K[4] = a_ > b_ ? a_ : b_; }
  { const float a_ = K[5], b_ = K[26]; K[5] = a_ > b_ ? a_ : b_; }
  { const float a_ = K[6], b_ = K[25]; K[6] = a_ > b_ ? a_ : b_; }
  { const float a_ = K[7], b_ = K[24]; K[7] = a_ > b_ ? a_ : b_; }
  { const float a_ = K[8], b_ = K[23]; K[8] = a_ > b_ ? a_ : b_; }
  { const float a_ = K[9], b_ = K[22]; K[9] = a_ > b_ ? a_ : b_; }
  { const float a_ = K[10], b_ = K[21]; K[10] = a_ > b_ ? a_ : b_; }
  { const float a_ = K[11], b_ = K[20]; K[11] = a_ > b_ ? a_ : b_; }
  { const float a_ = K[12], b_ = K[19]; K[12] = a_ > b_ ? a_ : b_; }
  { const float a_ = K[13], b_ = K[18]; K[13] = a_ > b_ ? a_ : b_; }
  { const float a_ = K[14], b_ = K[17]; K[14] = a_ > b_ ? a_ : b_; }
  { const float a_ = K[15], b_ = K[16]; K[15] = a_ > b_ ? a_ : b_; }
  { const float a_ = K[0], b_ = K[8]; const bool g_ = a_ > b_; K[0] = g_ ? a_ : b_; K[8] = g_ ? b_ : a_; }
  { const float a_ = K[1], b_ = K[9]; const bool g_ = a_ > b_; K[1] = g_ ? a_ : b_; K[9] = g_ ? b_ : a_; }
  { const float a_ = K[2], b_ = K[10]; const bool g_ = a_ > b_; K[2] = g_ ? a_ : b_; K[10] = g_ ? b_ : a_; }
  { const float a_ = K[3], b_ = K[11]; const bool g_ = a_ > b_; K[3] = g_ ? a_ : b_; K[11] = g_ ? b_ : a_; }
  { const float a_ = K[4], b_ = K[12]; const bool g_ = a_ > b_; K[4] = g_ ? a_ : b_; K[12] = g_ ? b_ : a_; }
  { const float a_ = K[5], b_ = K[13]; const bool g_ = a_ > b_; K[5] = g_ ? a_ : b_; K[13] = g_ ? b_ : a_; }
  { const float a_ = K[6], b_ = K[14]; const bool g_ = a_ > b_; K[6] = g_ ? a_ : b_; K[14] = g_ ? b_ : a_; }
  { const float a_ = K[7], b_ = K[15]; const bool g_ = a_ > b_; K[7] = g_ ? a_ : b_; K[15] = g_ ? b_ : a_; }
  { const float a_ = K[0], b_ = K[4]; const bool g_ = a_ > b_; K[0] = g_ ? a_ : b_; K[4] = g_ ? b_ : a_; }
  { const float a_ = K[1], b_ = K[5]; const bool g_ = a_ > b_; K[1] = g_ ? a_ : b_; K[5] = g_ ? b_ : a_; }
  { const float a_ = K[2], b_ = K[6]; const bool g_ = a_ > b_; K[2] = g_ ? a_ : b_; K[6] = g_ ? b_ : a_; }
  { const float a_ = K[3], b_ = K[7]; const bool g_ = a_ > b_; K[3] = g_ ? a_ : b_; K[7] = g_ ? b_ : a_; }
  { const float a_ = K[8], b_ = K[12]; const bool g_ = a_ > b_; K[8] = g_ ? a_ : b_; K[12] = g_ ? b_ : a_; }
  { const float a_ = K[9], b_ = K[13]; const bool g_ = a_ > b_; K[9] = g_ ? a_ : b_; K[13] = g_ ? b_ : a_; }
  { const float a_ = K[10], b_ = K[14]; const bool g_ = a_ > b_; K[10] = g_ ? a_ : b_; K[14] = g_ ? b_ : a_; }
  { const float a_ = K[11], b_ = K[15]; const bool g_ = a_ > b_; K[11] = g_ ? a_ : b_; K[15] = g_ ? b_ : a_; }
  { const float a_ = K[0], b_ = K[2]; const bool g_ = a_ > b_; K[0] = g_ ? a_ : b_; K[2] = g_ ? b_ : a_; }
  { const float a_ = K[1], b_ = K[3]; const bool g_ = a_ > b_; K[1] = g_ ? a_ : b_; K[3] = g_ ? b_ : a_; }
  { const float a_ = K[4], b_ = K[6]; const bool g_ = a_ > b_; K[4] = g_ ? a_ : b_; K[6] = g_ ? b_ : a_; }
  { const float a_ = K[5], b_ = K[7]; const bool g_ = a_ > b_; K[5] = g_ ? a_ : b_; K[7] = g_ ? b_ : a_; }
  { const float a_ = K[8], b_ = K[10]; const bool g_ = a_ > b_; K[8] = g_ ? a_ : b_; K[10] = g_ ? b_ : a_; }
  { const float a_ = K[9], b_ = K[11]; const bool g_ = a_ > b_; K[9] = g_ ? a_ : b_; K[11] = g_ ? b_ : a_; }
  { const float a_ = K[12], b_ = K[14]; const bool g_ = a_ > b_; K[12] = g_ ? a_ : b_; K[14] = g_ ? b_ : a_; }
  { const float a_ = K[13], b_ = K[15]; const bool g_ = a_ > b_; K[13] = g_ ? a_ : b_; K[15] = g_ ? b_ : a_; }
  { const float a_ = K[0], b_ = K[1]; const bool g_ = a_ > b_; K[0] = g_ ? a_ : b_; K[1] = g_ ? b_ : a_; }
  { const float a_ = K[2], b_ = K[3]; const bool g_ = a_ > b_; K[2] = g_ ? a_ : b_; K[3] = g_ ? b_ : a_; }
  { const float a_ = K[4], b_ = K[5]; const bool g_ = a_ > b_; K[4] = g_ ? a_ : b_; K[5] = g_ ? b_ : a_; }
  { const float a_ = K[6], b_ = K[7]; const bool g_ = a_ > b_; K[6] = g_ ? a_ : b_; K[7] = g_ ? b_ : a_; }
  { const float a_ = K[8], b_ = K[9]; const bool g_ = a_ > b_; K[8] = g_ ? a_ : b_; K[9] = g_ ? b_ : a_; }
  { const float a_ = K[10], b_ = K[11]; const bool g_ = a_ > b_; K[10] = g_ ? a_ : b_; K[11] = g_ ? b_ : a_; }
  { const float a_ = K[12], b_ = K[13]; const bool g_ = a_ > b_; K[12] = g_ ? a_ : b_; K[13] = g_ ? b_ : a_; }
  { const float a_ = K[14], b_ = K[15]; const bool g_ = a_ > b_; K[14] = g_ ? a_ : b_; K[15] = g_ ? b_ : a_; }
  { const float a_ = K[32], b_ = K[63]; K[32] = a_ > b_ ? a_ : b_; }
  { const float a_ = K[33], b_ = K[62]; K[33] = a_ > b_ ? a_ : b_; }
  { const float a_ = K[34], b_ = K[61]; K[34] = a_ > b_ ? a_ : b_; }
  { const float a_ = K[35], b_ = K[60]; K[35] = a_ > b_ ? a_ : b_; }
  { const float a_ = K[36], b_ = K[59]; K[36] = a_ > b_ ? a_ : b_; }
  { const float a_ = K[37], b_ = K[58]; K[37] = a_ > b_ ? a_ : b_; }
  { const float a_ = K[38], b_ = K[57]; K[38] = a_ > b_ ? a_ : b_; }
  { const float a_ = K[39], b_ = K[56]; K[39] = a_ > b_ ? a_ : b_; }
  { const float a_ = K[40], b_ = K[55]; K[40] = a_ > b_ ? a_ : b_; }
  { const float a_ = K[41], b_ = K[54]; K[41] = a_ > b_ ? a_ : b_; }
  { const float a_ = K[42], b_ = K[53]; K[42] = a_ > b_ ? a_ : b_; }
  { const float a_ = K[43], b_ = K[52]; K[43] = a_ > b_ ? a_ : b_; }
  { const float a_ = K[44], b_ = K[51]; K[44] = a_ > b_ ? a_ : b_; }
  { const float a_ = K[45], b_ = K[50]; K[45] = a_ > b_ ? a_ : b_; }
  { const float a_ = K[46], b_ = K[49]; K[46] = a_ > b_ ? a_ : b_; }
  { const float a_ = K[47], b_ = K[48]; K[47] = a_ > b_ ? a_ : b_; }
  { const float a_ = K[32], b_ = K[40]; const bool g_ = a_ > b_; K[32] = g_ ? a_ : b_; K[40] = g_ ? b_ : a_; }
  { const float a_ = K[33], b_ = K[41]; const bool g_ = a_ > b_; K[33] = g_ ? a_ : b_; K[41] = g_ ? b_ : a_; }
  { const float a_ = K[34], b_ = K[42]; const bool g_ = a_ > b_; K[34] = g_ ? a_ : b_; K[42] = g_ ? b_ : a_; }
  { const float a_ = K[35], b_ = K[43]; const bool g_ = a_ > b_; K[35] = g_ ? a_ : b_; K[43] = g_ ? b_ : a_; }
  { const float a_ = K[36], b_ = K[44]; const bool g_ = a_ > b_; K[36] = g_ ? a_ : b_; K[44] = g_ ? b_ : a_; }
  { const float a_ = K[37], b_ = K[45]; const bool g_ = a_ > b_; K[37] = g_ ? a_ : b_; K[45] = g_ ? b_ : a_; }
  { const float a_ = K[38], b_ = K[46]; const bool g_ = a_ > b_; K[38] = g_ ? a_ : b_; K[46] = g_ ? b_ : a_; }
  { const float a_ = K[39], b_ = K[47]; const bool g_ = a_ > b_; K[39] = g_ ? a_ : b_; K[47] = g_ ? b_ : a_; }
  { const float a_ = K[32], b_ = K[36]; const bool g_ = a_ > b_; K[32] = g_ ? a_ : b_; K[36] = g_ ? b_ : a_; }
  { const float a_ = K[33], b_ = K[37]; const bool g_ = a_ > b_; K[33] = g_ ? a_ : b_; K[37] = g_ ? b_ : a_; }
  { const float a_ = K[34], b_ = K[38]; const bool g_ = a_ > b_; K[34] = g_ ? a_ : b_; K[38] = g_ ? b_ : a_; }
  { const float a_ = K[35], b_ = K[39]; const bool g_ = a_ > b_; K[35] = g_ ? a_ : b_; K[39] = g_ ? b_ : a_; }
  { const float a_ = K[40], b_ = K[44]; const bool g_ = a_ > b_; K[40] = g_ ? a_ : b_; K[44] = g_ ? b_ : a_; }
  { const float a_ = K[41], b_ = K[45]; const bool g_ = a_ > b_; K[41] = g_ ? a_ : b_; K[45] = g_ ? b_ : a_; }
  { const float a_ = K[42], b_ = K[46]; const bool g_ = a_ > b_; K[42] = g_ ? a_ : b_; K[46] = g_ ? b_ : a_; }
  { const float a_ = K[43], b_ = K[47]; const bool g_ = a_ > b_; K[43] = g_ ? a_ : b_; K[47] = g_ ? b_ : a_; }
  { const float a_ = K[32], b_ = K[34]; const bool g_ = a_ > b_; K[32] = g_ ? a_ : b_; K[34] = g_ ? b_ : a_; }
  { const float a_ = K[33], b_ = K[35]; const bool g_ = a_ > b_; K[33] = g_ ? a_ : b_; K[35] = g_ ? b_ : a_; }
  { const float a_ = K[36], b_ = K[38]; const bool g_ = a_ > b_; K[36] = g_ ? a_ : b_; K[38] = g_ ? b_ : a_; }
  { const float a_ = K[37], b_ = K[39]; const bool g_ = a_ > b_; K[37] = g_ ? a_ : b_; K[39] = g_ ? b_ : a_; }
  { const float a_ = K[40], b_ = K[42]; const bool g_ = a_ > b_; K[40] = g_ ? a_ : b_; K[42] = g_ ? b_ : a_; }
  { const float a_ = K[41], b_ = K[43]; const bool g_ = a_ > b_; K[41] = g_ ? a_ : b_; K[43] = g_ ? b_ : a_; }
  { const float a_ = K[44], b_ = K[46]; const bool g_ = a_ > b_; K[44] = g_ ? a_ : b_; K[46] = g_ ? b_ : a_; }
  { const float a_ = K[45], b_ = K[47]; const bool g_ = a_ > b_; K[45] = g_ ? a_ : b_; K[47] = g_ ? b_ : a_; }
  { const float a_ = K[32], b_ = K[33]; const bool g_ = a_ > b_; K[32] = g_ ? a_ : b_; K[33] = g_ ? b_ : a_; }
  { const float a_ = K[34], b_ = K[35]; const bool g_ = a_ > b_; K[34] = g_ ? a_ : b_; K[35] = g_ ? b_ : a_; }
  { const float a_ = K[36], b_ = K[37]; const bool g_ = a_ > b_; K[36] = g_ ? a_ : b_; K[37] = g_ ? b_ : a_; }
  { const float a_ = K[38], b_ = K[39]; const bool g_ = a_ > b_; K[38] = g_ ? a_ : b_; K[39] = g_ ? b_ : a_; }
  { const float a_ = K[40], b_ = K[41]; const bool g_ = a_ > b_; K[40] = g_ ? a_ : b_; K[41] = g_ ? b_ : a_; }
  { const float a_ = K[42], b_ = K[43]; const bool g_ = a_ > b_; K[42] = g_ ? a_ : b_; K[43] = g_ ? b_ : a_; }
  { const float a_ = K[44], b_ = K[45]; const bool g_ = a_ > b_; K[44] = g_ ? a_ : b_; K[45] = g_ ? b_ : a_; }
  { const float a_ = K[46], b_ = K[47]; const bool g_ = a_ > b_; K[46] = g_ ? a_ : b_; K[47] = g_ ? b_ : a_; }
  { const float a_ = K[0], b_ = K[47]; K[0] = a_ > b_ ? a_ : b_; }
  { const float a_ = K[1], b_ = K[46]; K[1] = a_ > b_ ? a_ : b_; }
  { const float a_ = K[2], b_ = K[45]; K[2] = a_ > b_ ? a_ : b_; }
  { const float a_ = K[3], b_ = K[44]; K[3] = a_ > b_ ? a_ : b_; }
  { const float a_ = K[4], b_ = K[43]; K[4] = a_ > b_ ? a_ : b_; }
  { const float a_ = K[5], b_ = K[42]; K[5] = a_ > b_ ? a_ : b_; }
  { const float a_ = K[6], b_ = K[41]; K[6] = a_ > b_ ? a_ : b_; }
  { const float a_ = K[7], b_ = K[40]; K[7] = a_ > b_ ? a_ : b_; }
  { const float a_ = K[8], b_ = K[39]; K[8] = a_ > b_ ? a_ : b_; }
  { const float a_ = K[9], b_ = K[38]; K[9] = a_ > b_ ? a_ : b_; }
  { const float a_ = K[10], b_ = K[37]; K[10] = a_ > b_ ? a_ : b_; }
  { const float a_ = K[11], b_ = K[36]; K[11] = a_ > b_ ? a_ : b_; }
  { const float a_ = K[12], b_ = K[35]; K[12] = a_ > b_ ? a_ : b_; }
  { const float a_ = K[13], b_ = K[34]; K[13] = a_ > b_ ? a_ : b_; }
  { const float a_ = K[14], b_ = K[33]; K[14] = a_ > b_ ? a_ : b_; }
  { const float a_ = K[15], b_ = K[32]; K[15] = a_ > b_ ? a_ : b_; }
  { const float a_ = K[0], b_ = K[8]; const bool g_ = a_ > b_; K[0] = g_ ? a_ : b_; K[8] = g_ ? b_ : a_; }
  { const float a_ = K[1], b_ = K[9]; const bool g_ = a_ > b_; K[1] = g_ ? a_ : b_; K[9] = g_ ? b_ : a_; }
  { const float a_ = K[2], b_ = K[10]; const bool g_ = a_ > b_; K[2] = g_ ? a_ : b_; K[10] = g_ ? b_ : a_; }
  { const float a_ = K[3], b_ = K[11]; const bool g_ = a_ > b_; K[3] = g_ ? a_ : b_; K[11] = g_ ? b_ : a_; }
  { const float a_ = K[4], b_ = K[12]; const bool g_ = a_ > b_; K[4] = g_ ? a_ : b_; K[12] = g_ ? b_ : a_; }
  { const float a_ = K[5], b_ = K[13]; const bool g_ = a_ > b_; K[5] = g_ ? a_ : b_; K[13] = g_ ? b_ : a_; }
  { const float a_ = K[6], b_ = K[14]; const bool g_ = a_ > b_; K[6] = g_ ? a_ : b_; K[14] = g_ ? b_ : a_; }
  { const float a_ = K[7], b_ = K[15]; const bool g_ = a_ > b_; K[7] = g_ ? a_ : b_; K[15] = g_ ? b_ : a_; }
  { const float a_ = K[0], b_ = K[4]; const bool g_ = a_ > b_; K[0] = g_ ? a_ : b_; K[4] = g_ ? b_ : a_; }
  { const float a_ = K[1], b_ = K[5]; const bool g_ = a_ > b_; K[1] = g_ ? a_ : b_; K[5] = g_ ? b_ : a_; }
  { const float a_ = K[2], b_ = K[6]; const bool g_ = a_ > b_; K[2] = g_ ? a_ : b_; K[6] = g_ ? b_ : a_; }
  { const float a_ = K[3], b_ = K[7]; const bool g_ = a_ > b_; K[3] = g_ ? a_ : b_; K[7] = g_ ? b_ : a_; }
  { const float a_ = K[8], b_ = K[12]; const bool g_ = a_ > b_; K[8] = g_ ? a_ : b_; K[12] = g_ ? b_ : a_; }
  { const float a_ = K[9], b_ = K[13]; const bool g_ = a_ > b_; K[9] = g_ ? a_ : b_; K[13] = g_ ? b_ : a_; }
  { const float a_ = K[10], b_ = K[14]; const bool g_ = a_ > b_; K[10] = g_ ? a_ : b_; K[14] = g_ ? b_ : a_; }
  { const float a_ = K[11], b_ = K[15]; const bool g_ = a_ > b_; K[11] = g_ ? a_ : b_; K[15] = g_ ? b_ : a_; }
  { const float a_ = K[0], b_ = K[2]; const bool g_ = a_ > b_; K[0] = g_ ? a_ : b_; K[2] = g_ ? b_ : a_; }
  { const float a_ = K[1], b_ = K[3]; const bool g_ = a_ > b_; K[1] = g_ ? a_ : b_; K[3] = g_ ? b_ : a_; }
  { const float a_ = K[4], b_ = K[6]; const bool g_ = a_ > b_; K[4] = g_ ? a_ : b_; K[6] = g_ ? b_ : a_; }
  { const float a_ = K[5], b_ = K[7]; const bool g_ = a_ > b_; K[5] = g_ ? a_ : b_; K[7] = g_ ? b_ : a_; }
  { const float a_ = K[8], b_ = K[10]; const bool g_ = a_ > b_; K[8] = g_ ? a_ : b_; K[10] = g_ ? b_ : a_; }
  { const float a_ = K[9], b_ = K[11]; const bool g_ = a_ > b_; K[9] = g_ ? a_ : b_; K[11] = g_ ? b_ : a_; }
  { const float a_ = K[12], b_ = K[14]; const bool g_ = a_ > b_; K[12] = g_ ? a_ : b_; K[14] = g_ ? b_ : a_; }
  { const float a_ = K[13], b_ = K[15]; const bool g_ = a_ > b_; K[13] = g_ ? a_ : b_; K[15] = g_ ? b_ : a_; }
  { const float a_ = K[0], b_ = K[1]; const bool g_ = a_ > b_; K[0] = g_ ? a_ : b_; K[1] = g_ ? b_ : a_; }
  { const float a_ = K[2], b_ = K[3]; const bool g_ = a_ > b_; K[2] = g_ ? a_ : b_; K[3] = g_ ? b_ : a_; }
  { const float a_ = K[4], b_ = K[5]; const bool g_ = a_ > b_; K[4] = g_ ? a_ : b_; K[5] = g_ ? b_ : a_; }
  { const float a_ = K[6], b_ = K[7]; const bool g_ = a_ > b_; K[6] = g_ ? a_ : b_; K[7] = g_ ? b_ : a_; }
  { const float a_ = K[8], b_ = K[9]; const bool g_ = a_ > b_; K[8] = g_ ? a_ : b_; K[9] = g_ ? b_ : a_; }
  { const float a_ = K[10], b_ = K[11]; const bool g_ = a_ > b_; K[10] = g_ ? a_ : b_; K[11] = g_ ? b_ : a_; }
  { const float a_ = K[12], b_ = K[13]; const bool g_ = a_ > b_; K[12] = g_ ? a_ : b_; K[13] = g_ ? b_ : a_; }
  { const float a_ = K[14], b_ = K[15]; const bool g_ = a_ > b_; K[14] = g_ ? a_ : b_; K[15] = g_ ? b_ : a_; }
}
__device__ __forceinline__ void merge_top16(float (&T)[16], const float (&P)[16]) {
  { const float a_ = T[0], b_ = P[15]; T[0] = a_ > b_ ? a_ : b_; }
  { const float a_ = T[1], b_ = P[14]; T[1] = a_ > b_ ? a_ : b_; }
  { const float a_ = T[2], b_ = P[13]; T[2] = a_ > b_ ? a_ : b_; }
  { const float a_ = T[3], b_ = P[12]; T[3] = a_ > b_ ? a_ : b_; }
  { const float a_ = T[4], b_ = P[11]; T[4] = a_ > b_ ? a_ : b_; }
  { const float a_ = T[5], b_ = P[10]; T[5] = a_ > b_ ? a_ : b_; }
  { const float a_ = T[6], b_ = P[9]; T[6] = a_ > b_ ? a_ : b_; }
  { const float a_ = T[7], b_ = P[8]; T[7] = a_ > b_ ? a_ : b_; }
  { const float a_ = T[8], b_ = P[7]; T[8] = a_ > b_ ? a_ : b_; }
  { const float a_ = T[9], b_ = P[6]; T[9] = a_ > b_ ? a_ : b_; }
  { const float a_ = T[10], b_ = P[5]; T[10] = a_ > b_ ? a_ : b_; }
  { const float a_ = T[11], b_ = P[4]; T[11] = a_ > b_ ? a_ : b_; }
  { const float a_ = T[12], b_ = P[3]; T[12] = a_ > b_ ? a_ : b_; }
  { const float a_ = T[13], b_ = P[2]; T[13] = a_ > b_ ? a_ : b_; }
  { const float a_ = T[14], b_ = P[1]; T[14] = a_ > b_ ? a_ : b_; }
  { const float a_ = T[15], b_ = P[0]; T[15] = a_ > b_ ? a_ : b_; }
  { const float a_ = T[0], b_ = T[8]; const bool g_ = a_ > b_; T[0] = g_ ? a_ : b_; T[8] = g_ ? b_ : a_; }
  { const float a_ = T[1], b_ = T[9]; const bool g_ = a_ > b_; T[1] = g_ ? a_ : b_; T[9] = g_ ? b_ : a_; }
  { const float a_ = T[2], b_ = T[10]; const bool g_ = a_ > b_; T[2] = g_ ? a_ : b_; T[10] = g_ ? b_ : a_; }
  { const float a_ = T[3], b_ = T[11]; const bool g_ = a_ > b_; T[3] = g_ ? a_ : b_; T[11] = g_ ? b_ : a_; }
  { const float a_ = T[4], b_ = T[12]; const bool g_ = a_ > b_; T[4] = g_ ? a_ : b_; T[12] = g_ ? b_ : a_; }
  { const float a_ = T[5], b_ = T[13]; const bool g_ = a_ > b_; T[5] = g_ ? a_ : b_; T[13] = g_ ? b_ : a_; }
  { const float a_ = T[6], b_ = T[14]; const bool g_ = a_ > b_; T[6] = g_ ? a_ : b_; T[14] = g_ ? b_ : a_; }
  { const float a_ = T[7], b_ = T[15]; const bool g_ = a_ > b_; T[7] = g_ ? a_ : b_; T[15] = g_ ? b_ : a_; }
  { const float a_ = T[0], b_ = T[4]; const bool g_ = a_ > b_; T[0] = g_ ? a_ : b_; T[4] = g_ ? b_ : a_; }
  { const float a_ = T[1], b_ = T[5]; const bool g_ = a_ > b_; T[1] = g_ ? a_ : b_; T[5] = g_ ? b_ : a_; }
  { const float a_ = T[2], b_ = T[6]; const bool g_ = a_ > b_; T[2] = g_ ? a_ : b_; T[6] = g_ ? b_ : a_; }
  { const float a_ = T[3], b_ = T[7]; const bool g_ = a_ > b_; T[3] = g_ ? a_ : b_; T[7] = g_ ? b_ : a_; }
  { const float a_ = T[8], b_ = T[12]; const bool g_ = a_ > b_; T[8] = g_ ? a_ : b_; T[12] = g_ ? b_ : a_; }
  { const float a_ = T[9], b_ = T[13]; const bool g_ = a_ > b_; T[9] = g_ ? a_ : b_; T[13] = g_ ? b_ : a_; }
  { const float a_ = T[10], b_ = T[14]; const bool g_ = a_ > b_; T[10] = g_ ? a_ : b_; T[14] = g_ ? b_ : a_; }
  { const float a_ = T[11], b_ = T[15]; const bool g_ = a_ > b_; T[11] = g_ ? a_ : b_; T[15] = g_ ? b_ : a_; }
  { const float a_ = T[0], b_ = T[2]; const bool g_ = a_ > b_; T[0] = g_ ? a_ : b_; T[2] = g_ ? b_ : a_; }
  { const float a_ = T[1], b_ = T[3]; const bool g_ = a_ > b_; T[1] = g_ ? a_ : b_; T[3] = g_ ? b_ : a_; }
  { const float a_ = T[4], b_ = T[6]; const bool g_ = a_ > b_; T[4] = g_ ? a_ : b_; T[6] = g_ ? b_ : a_; }
  { const float a_ = T[5], b_ = T[7]; const bool g_ = a_ > b_; T[5] = g_ ? a_ : b_; T[7] = g_ ? b_ : a_; }
  { const float a_ = T[8], b_ = T[10]; const bool g_ = a_ > b_; T[8] = g_ ? a_ : b_; T[10] = g_ ? b_ : a_; }
  { const float a_ = T[9], b_ = T[11]; const bool g_ = a_ > b_; T[9] = g_ ? a_ : b_; T[11] = g_ ? b_ : a_; }
  { const float a_ = T[12], b_ = T[14]; const bool g_ = a_ > b_; T[12] = g_ ? a_ : b_; T[14] = g_ ? b_ : a_; }
  { const float a_ = T[13], b_ = T[15]; const bool g_ = a_ > b_; T[13] = g_ ? a_ : b_; T[15] = g_ ? b_ : a_; }
  { const float a_ = T[0], b_ = T[1]; const bool g_ = a_ > b_; T[0] = g_ ? a_ : b_; T[1] = g_ ? b_ : a_; }
  { const float a_ = T[2], b_ = T[3]; const bool g_ = a_ > b_; T[2] = g_ ? a_ : b_; T[3] = g_ ? b_ : a_; }
  { const float a_ = T[4], b_ = T[5]; const bool g_ = a_ > b_; T[4] = g_ ? a_ : b_; T[5] = g_ ? b_ : a_; }
  { const float a_ = T[6], b_ = T[7]; const bool g_ = a_ > b_; T[6] = g_ ? a_ : b_; T[7] = g_ ? b_ : a_; }
  { const float a_ = T[8], b_ = T[9]; const bool g_ = a_ > b_; T[8] = g_ ? a_ : b_; T[9] = g_ ? b_ : a_; }
  { const float a_ = T[10], b_ = T[11]; const bool g_ = a_ > b_; T[10] = g_ ? a_ : b_; T[11] = g_ ? b_ : a_; }
  { const float a_ = T[12], b_ = T[13]; const bool g_ = a_ > b_; T[12] = g_ ? a_ : b_; T[13] = g_ ? b_ : a_; }
  { const float a_ = T[14], b_ = T[15]; const bool g_ = a_ > b_; T[14] = g_ ? a_ : b_; T[15] = g_ ? b_ : a_; }
}

__device__ __forceinline__ void peer_topk(const int wave_s, const bf16* pq, const bf16* skb, int* ids, float* gates, LAS float* smem) {
  const int tid_ = opaque_tid(wave_s);
  const int lane = tid_ & 63, n = lane & 31, hh = lane >> 5, wave = tid_ >> 6;
  const int gw = blockIdx.x * NWAVES + wave;
  const int nw = gridDim.x * NWAVES;
  LAS float* lk = smem + wave * 2048;
  for (int it = gw; it < 512 * 8; it += nw) {
    const int h = it & 7, tok0 = (it >> 3) * 32;
#pragma unroll 1
    for (int half = 0; half < 2; half++) {
      bf16x8_t qf[8];
      {
        const bf16* qrow = pq + (size_t)(tok0 + n) * 2048 + h * 256 + half * 128 + 8 * hh;
#pragma unroll
        for (int ks = 0; ks < 8; ks++) qf[ks] = *(const bf16x8_t*)(qrow + 16 * ks);
      }
      float K[64];
#pragma unroll
      for (int kt = 0; kt < 4; kt++) {
        const bf16* krow = skb + ((size_t)((h * 2 + half) * 128 + kt * 32 + n)) * 128 + 8 * hh;
        f32x16_t acc;
#pragma unroll
        for (int r = 0; r < 16; r++) acc[r] = 0.f;
#pragma unroll
        for (int kq = 0; kq < 2; kq++) {
          bf16x8_t kf[4];
#pragma unroll
          for (int i = 0; i < 4; i++) kf[i] = *(const bf16x8_t*)(krow + 16 * (kq * 4 + i));
          MFMA_PAD();
#pragma unroll
          for (int i = 0; i < 4; i++) acc = __builtin_amdgcn_mfma_f32_32x32x16_bf16(kf[i], qf[kq * 4 + i], acc, 0, 0, 0);
          MFMA_PAD();
        }
#pragma unroll
        for (int i = 0; i < 16; i++) K[kt * 16 + i] = pack_key<0x7Fu>(acc[i], (unsigned)(kt * 32 + (i & 3) + 8 * (i >> 2) + 4 * hh));
      }
      __builtin_amdgcn_sched_barrier(0);
      top16_of_64(K);
      __builtin_amdgcn_sched_barrier(0);
      float T[16], P[16];
#pragma unroll
      for (int i = 0; i < 16; i++) { T[i] = K[i]; P[i] = __shfl_xor(K[i], 32, 64); }
      merge_top16(T, P);
#pragma unroll
      for (int i = 0; i < 16; i++) lk[(half * 16 + i) * 64 + lane] = T[i];
      __builtin_amdgcn_sched_barrier(0);
    }
    float f0[16], f1[16];
    int ti0[16], ti1[16];
#pragma unroll
    for (int i = 0; i < 16; i++) {
      const float k0 = lk[i * 64 + lane], k1 = lk[(16 + i) * 64 + lane];
      f0[i] = key_val<0x7Fu>(k0); ti0[i] = (int)key_idx<0x7Fu>(k0);
      f1[i] = key_val<0x7Fu>(k1); ti1[i] = (int)key_idx<0x7Fu>(k1);
    }
    float K[64];
    {
    K[0] = pack_key<0xFFu>(f0[0] + f1[0], 0u);
    K[1] = pack_key<0xFFu>(f0[0] + f1[1], 1u);
    K[2] = pack_key<0xFFu>(f0[0] + f1[2], 2u);
    K[3] = pack_key<0xFFu>(f0[0] + f1[3], 3u);
    K[4] = pack_key<0xFFu>(f0[0] + f1[4], 4u);
    K[5] = pack_key<0xFFu>(f0[0] + f1[5], 5u);
    K[6] = pack_key<0xFFu>(f0[0] + f1[6], 6u);
    K[7] = pack_key<0xFFu>(f0[0] + f1[7], 7u);
    K[8] = pack_key<0xFFu>(f0[0] + f1[8], 8u);
    K[9] = pack_key<0xFFu>(f0[0] + f1[9], 9u);
    K[10] = pack_key<0xFFu>(f0[0] + f1[10], 10u);
    K[11] = pack_key<0xFFu>(f0[0] + f1[11], 11u);
    K[12] = pack_key<0xFFu>(f0[0] + f1[12], 12u);
    K[13] = pack_key<0xFFu>(f0[0] + f1[13], 13u);
    K[14] = pack_key<0xFFu>(f0[0] + f1[14], 14u);
    K[15] = pack_key<0xFFu>(f0[0] + f1[15], 15u);
    K[16] = pack_key<0xFFu>(f0[1] + f1[0], 16u);
    K[17] = pack_key<0xFFu>(f0[1] + f1[1], 17u);
    K[18] = pack_key<0xFFu>(f0[1] + f1[2], 18u);
    K[19] = pack_key<0xFFu>(f0[1] + f1[3], 19u);
    K[20] = pack_key<0xFFu>(f0[1] + f1[4], 20u);
    K[21] = pack_key<0xFFu>(f0[1] + f1[5], 21u);
    K[22] = pack_key<0xFFu>(f0[1] + f1[6], 22u);
    K[23] = pack_key<0xFFu>(f0[1] + f1[7], 23u);
    K[24] = pack_key<0xFFu>(f0[2] + f1[0], 32u);
    K[25] = pack_key<0xFFu>(f0[2] + f1[1], 33u);
    K[26] = pack_key<0xFFu>(f0[2] + f1[2], 34u);
    K[27] = pack_key<0xFFu>(f0[2] + f1[3], 35u);
    K[28] = pack_key<0xFFu>(f0[2] + f1[4], 36u);
    K[29] = pack_key<0xFFu>(f0[3] + f1[0], 48u);
    K[30] = pack_key<0xFFu>(f0[3] + f1[1], 49u);
    K[31] = pack_key<0xFFu>(f0[3] + f1[2], 50u);
    K[32] = pack_key<0xFFu>(f0[3] + f1[3], 51u);
    K[33] = pack_key<0xFFu>(f0[4] + f1[0], 64u);
    K[34] = pack_key<0xFFu>(f0[4] + f1[1], 65u);
    K[35] = pack_key<0xFFu>(f0[4] + f1[2], 66u);
    K[36] = pack_key<0xFFu>(f0[5] + f1[0], 80u);
    K[37] = pack_key<0xFFu>(f0[5] + f1[1], 81u);
    K[38] = pack_key<0xFFu>(f0[6] + f1[0], 96u);
    K[39] = pack_key<0xFFu>(f0[6] + f1[1], 97u);
    K[40] = pack_key<0xFFu>(f0[7] + f1[0], 112u);
    K[41] = pack_key<0xFFu>(f0[7] + f1[1], 113u);
    K[42] = pack_key<0xFFu>(f0[8] + f1[0], 128u);
    K[43] = pack_key<0xFFu>(f0[9] + f1[0], 144u);
    K[44] = pack_key<0xFFu>(f0[10] + f1[0], 160u);
    K[45] = pack_key<0xFFu>(f0[11] + f1[0], 176u);
    K[46] = pack_key<0xFFu>(f0[12] + f1[0], 192u);
    K[47] = pack_key<0xFFu>(f0[13] + f1[0], 208u);
    K[48] = pack_key<0xFFu>(f0[14] + f1[0], 224u);
    K[49] = pack_key<0xFFu>(f0[15] + f1[0], 240u);
    K[50] = -3.0e38f;
    K[51] = -3.0e38f;
    K[52] = -3.0e38f;
    K[53] = -3.0e38f;
    K[54] = -3.0e38f;
    K[55] = -3.0e38f;
    K[56] = -3.0e38f;
    K[57] = -3.0e38f;
    K[58] = -3.0e38f;
    K[59] = -3.0e38f;
    K[60] = -3.0e38f;
    K[61] = -3.0e38f;
    K[62] = -3.0e38f;
    K[63] = -3.0e38f;
    }
    __builtin_amdgcn_sched_barrier(0);
    top16_of_64(K);
    __builtin_amdgcn_sched_barrier(0);
    float bv[16];
    int be[16];
#pragma unroll
    for (int r = 0; r < 16; r++) {
      const int flat = (int)key_idx<0xFFu>(K[r]);
      const int a = flat >> 4, b = flat & 15;
      int i0 = 0, i1 = 0;
#pragma unroll
      for (int i = 0; i < 16; i++) { i0 = (a == i) ? ti0[i] : i0; i1 = (b == i) ? ti1[i] : i1; }
      be[r] = i0 * 128 + i1;
      bv[r] = key_val<0xFFu>(K[r]);
    }
    const float b0 = bv[0];
    float ge[16];
    float gsum = 0.f;
#pragma unroll
    for (int r = 0; r < 16; r++) { ge[r] = __expf(bv[r] - b0); gsum += ge[r]; }
    const float ginv = 1.0f / gsum;
    if (hh == 0) {
      int* ip = ids + (size_t)(tok0 + n) * 128 + h * 16;
      float* gp = gates + (size_t)(tok0 + n) * 128 + h * 16;
#pragma unroll
      for (int r4 = 0; r4 < 4; r4++) {
        *(int4*)(ip + 4 * r4) = make_int4(be[4 * r4], be[4 * r4 + 1], be[4 * r4 + 2], be[4 * r4 + 3]);
        *(float4*)(gp + 4 * r4) = make_float4(ge[4 * r4] * ginv, ge[4 * r4 + 1] * ginv, ge[4 * r4 + 2] * ginv, ge[4 * r4 + 3] * ginv);
      }
    }
  }
}

typedef _Float16 f16x2_t __attribute__((ext_vector_type(2)));
__device__ __forceinline__ unsigned e4m3x2_to_f16x2(unsigned w, unsigned sel) {
  return __builtin_amdgcn_perm(w, w, sel);
}
__device__ __forceinline__ float dot2h(unsigned a, unsigned b, float c) {
  return __builtin_amdgcn_fdot2(__builtin_bit_cast(f16x2_t, a), __builtin_bit_cast(f16x2_t, b), c, false);
}
__device__ __forceinline__ unsigned pack_h2(float lo, float hi) {
  f16x2_t v; v.x = (_Float16)lo; v.y = (_Float16)hi;
  return __builtin_bit_cast(unsigned, v);
}
template <bool FINAL>
__device__ __forceinline__ void peer_gather(const int wave_s, bf16* xn, const float* rst, const unsigned char* ub, const unsigned char* vb, const float* vsc,
                                            const int* ids, const float* gates, float* xw, const float* gnext, float* outp) {
  const int tid_ = opaque_tid(wave_s);
  const int lane = tid_ & 63;
  const int gw = blockIdx.x * NWAVES + (tid_ >> 6);
  const int nw = gridDim.x * NWAVES;
  const int el = ((lane >> 5) & 1) * 4 + ((lane >> 4) & 1) * 2 + ((lane >> 3) & 1);
  int idv = 0;
  uint4 uu[8];
  uint2 vv[8];
  if (gw < NT) {
    idv = ids[(size_t)gw * 128 + (lane & 7)];
#pragma unroll
    for (int e = 0; e < 8; e++) {
      const int id = __builtin_amdgcn_readlane(idv, e);
      uu[e] = *(const uint4*)(ub + (size_t)id * DM + lane * 16);
      vv[e] = *(const uint2*)(vb + (size_t)id * 512 + lane * 8);
    }
  }
  for (int tok = gw; tok < NT; tok += nw) {
    const int tokn = (tok + nw < NT) ? tok + nw : tok;
    unsigned xh[8];
    {
      const uint4 a = *(const uint4*)(xn + (size_t)tok * DM + lane * 16);
      const uint4 b = *(const uint4*)(xn + (size_t)tok * DM + lane * 16 + 8);
      const unsigned xw_[8] = {a.x, a.y, a.z, a.w, b.x, b.y, b.z, b.w};
      const float4* sp = (const float4*)(rst + (size_t)tok * 16);
      const float4 s0 = sp[0], s1 = sp[1], s2 = sp[2], s3 = sp[3];
      const float xs = rsqrtf((((s0.x + s0.y) + (s0.z + s0.w)) + ((s1.x + s1.y) + (s1.z + s1.w)) + ((s2.x + s2.y) + (s2.z + s2.w)) + ((s3.x + s3.y) + (s3.z + s3.w))) * (1.0f / 1024.f) + EPSF);
#pragma unroll
      for (int k = 0; k < 8; k++) xh[k] = pack_h2(bf_lo(xw_[k]) * xs, bf_hi(xw_[k]) * xs);
    }
    f16x2_t acc2[8];
#pragma unroll
    for (int i = 0; i < 8; i++) acc2[i] = (f16x2_t){(_Float16)0.f, (_Float16)0.f};
#pragma unroll 1
    for (int g = 0; g < 16; g++) {
      const float gv = gates[(size_t)tok * 128 + g * 8 + el] * vsc[__builtin_amdgcn_ds_bpermute(el << 2, idv)];
      const int idn = ids[(size_t)(g < 15 ? tok : tokn) * 128 + ((g + 1) & 15) * 8 + (lane & 7)];
      float d[8];
#pragma unroll
      for (int e = 0; e < 8; e++) {
        const unsigned uw[4] = {uu[e].x, uu[e].y, uu[e].z, uu[e].w};
        float s = 0.f;
#pragma unroll
        for (int k = 0; k < 4; k++) {
          s = dot2h(e4m3x2_to_f16x2(uw[k], 0x010c000cu), xh[2 * k], s);
          s = dot2h(e4m3x2_to_f16x2(uw[k], 0x030c020cu), xh[2 * k + 1], s);
        }
        d[e] = s;
      }
#pragma unroll
      for (int e = 0; e < 8; e++) {
        const int id = __builtin_amdgcn_readlane(idn, e);
        uu[e] = *(const uint4*)(ub + (size_t)id * DM + lane * 16);
      }
      float d4[4], d2[2], d1;
      {
        const bool hi = (lane & 32) != 0;
#pragma unroll
        for (int i = 0; i < 4; i++) { const float send = hi ? d[i] : d[i + 4]; const float keep = hi ? d[i + 4] : d[i]; d4[i] = keep + __shfl_xor(send, 32, 64); }
      }
      {
        const bool hi = (lane & 16) != 0;
#pragma unroll
        for (int i = 0; i < 2; i++) { const float send = hi ? d4[i] : d4[i + 2]; const float keep = hi ? d4[i + 2] : d4[i]; d2[i] = keep + __shfl_xor(send, 16, 64); }
      }
      {
        const bool hi = (lane & 8) != 0;
        const float send = hi ? d2[0] : d2[1];
        const float keep = hi ? d2[1] : d2[0];
        d1 = keep + __shfl_xor(send, 8, 64);
      }
      d1 += __shfl_xor(d1, 4, 64);
      d1 += __shfl_xor(d1, 2, 64);
      d1 += __shfl_xor(d1, 1, 64);
      const float wl = gv * gelu_tanh(d1 * (1.0f / U_SCALE));
#pragma unroll
      for (int e = 0; e < 8; e++) {
        const float w = __builtin_bit_cast(float, __builtin_amdgcn_readlane(__builtin_bit_cast(int, wl), ((e >> 2) & 1) * 32 + ((e >> 1) & 1) * 16 + (e & 1) * 8));
        const f16x2_t w2 = __builtin_bit_cast(f16x2_t, pack_h2(w, w));
        const unsigned vw[2] = {vv[e].x, vv[e].y};
#pragma unroll
        for (int k = 0; k < 2; k++) {
          const unsigned w4 = vw[k];
          const unsigned le = __builtin_amdgcn_perm(V4_LUT_HI, V4_LUT_LO, w4 & 0x07070707u);
          const unsigned lo = __builtin_amdgcn_perm(V4_LUT_HI, V4_LUT_LO, (w4 >> 4) & 0x07070707u);
          const unsigned ee = ((w4 << 4) & 0x80808080u) | le;
          const unsigned eo = (w4 & 0x80808080u) | lo;
          const unsigned p01 = __builtin_amdgcn_perm(eo, ee, 0x040c000cu), p23 = __builtin_amdgcn_perm(eo, ee, 0x050c010cu);
          const unsigned p45 = __builtin_amdgcn_perm(eo, ee, 0x060c020cu), p67 = __builtin_amdgcn_perm(eo, ee, 0x070c030cu);
          acc2[4 * k + 0] = __builtin_elementwise_fma(__builtin_bit_cast(f16x2_t, p01), w2, acc2[4 * k + 0]);
          acc2[4 * k + 1] = __builtin_elementwise_fma(__builtin_bit_cast(f16x2_t, p23), w2, acc2[4 * k + 1]);
          acc2[4 * k + 2] = __builtin_elementwise_fma(__builtin_bit_cast(f16x2_t, p45), w2, acc2[4 * k + 2]);
          acc2[4 * k + 3] = __builtin_elementwise_fma(__builtin_bit_cast(f16x2_t, p67), w2, acc2[4 * k + 3]);
        }
      }
#pragma unroll
      for (int e = 0; e < 8; e++) {
        const int id = __builtin_amdgcn_readlane(idn, e);
        vv[e] = *(const uint2*)(vb + (size_t)id * 512 + lane * 8);
      }
      idv = idn;
    }
    float acc[16];
#pragma unroll
    for (int i = 0; i < 8; i++) { acc[2 * i] = (float)acc2[i].x; acc[2 * i + 1] = (float)acc2[i].y; }
    float* xr = xw + (size_t)tok * DM + lane * 16;
    float xv[16];
    float ssq = 0.f;
#pragma unroll
    for (int c = 0; c < 4; c++) {
      float4 a0 = *(float4*)(xr + c * 4);
      a0.x += acc[c * 4 + 0]; a0.y += acc[c * 4 + 1]; a0.z += acc[c * 4 + 2]; a0.w += acc[c * 4 + 3];
      if (!FINAL) *(float4*)(xr + c * 4) = a0;
      xv[c * 4 + 0] = a0.x; xv[c * 4 + 1] = a0.y; xv[c * 4 + 2] = a0.z; xv[c * 4 + 3] = a0.w;
      ssq += a0.x * a0.x + a0.y * a0.y + a0.z * a0.z + a0.w * a0.w;
    }
    ssq = wsum(ssq);
    const float rstd = rsqrtf(ssq * (1.0f / DM) + EPSF);
    const float4* g4 = (const float4*)(gnext + lane * 16);
    if (FINAL) {
      float* op = outp + (size_t)tok * DM + lane * 16;
#pragma unroll
      for (int c = 0; c < 4; c++) {
        const float4 gq = g4[c];
        *(float4*)(op + c * 4) = make_float4(xv[c * 4] * rstd * gq.x, xv[c * 4 + 1] * rstd * gq.y, xv[c * 4 + 2] * rstd * gq.z, xv[c * 4 + 3] * rstd * gq.w);
      }
    } else {
      uint4 o0, o1;
      { const float4 ga = g4[0], gb = g4[1];
        o0.x = pk2(xv[0] * rstd * ga.x, xv[1] * rstd * ga.y); o0.y = pk2(xv[2] * rstd * ga.z, xv[3] * rstd * ga.w);
        o0.z = pk2(xv[4] * rstd * gb.x, xv[5] * rstd * gb.y); o0.w = pk2(xv[6] * rstd * gb.z, xv[7] * rstd * gb.w); }
      { const float4 ga = g4[2], gb = g4[3];
        o1.x = pk2(xv[8] * rstd * ga.x, xv[9] * rstd * ga.y); o1.y = pk2(xv[10] * rstd * ga.z, xv[11] * rstd * ga.w);
        o1.z = pk2(xv[12] * rstd * gb.x, xv[13] * rstd * gb.y); o1.w = pk2(xv[14] * rstd * gb.z, xv[15] * rstd * gb.w); }
      *(uint4*)(xn + (size_t)tok * DM + lane * 16) = o0;
      *(uint4*)(xn + (size_t)tok * DM + lane * 16 + 8) = o1;
    }
  }
}

__device__ __forceinline__ void prologue_transposes(const int wave_s, const Params& p, unsigned char* ws, LAS unsigned char* lds) {
  const int tid_ = opaque_tid(wave_s);
  const int lane = tid_ & 63, wave = tid_ >> 6;
  LAS float* scr = (LAS float*)(lds + wave * 16384);
  const int gw = blockIdx.x * NWAVES + wave, NGW = gridDim.x * NWAVES;
  constexpr int I_IN = (DM / 64) * (DIN / 32), I_SQ = (DM / 64) * (DM / 32), I_2K = (DM / 64) * (2048 / 32);
  constexpr int I_GL = (256 / 64) * (256 / 32);
  constexpr int PER_LAYER = I_IN + 3 * I_SQ + 2 * I_2K + I_GL;
  const float* w3 = karg_in(3); const float* w19 = karg_in(19); const float* w22 = karg_in(22);
  const float* w23 = karg_in(23); const float* w24 = karg_in(24); const float* w26 = karg_in(26);
  const float* w16 = karg_in(16);
  for (int it = gw; it < 2 * PER_LAYER; it += NGW) {
    const int l = it / PER_LAYER;
    int r = it % PER_LAYER;
    unsigned char* wl = ws + WS_WT + (size_t)l * WT_LAYER;
    if (r < I_IN) { transpose_item(w3 + (size_t)l * DM * DIN, DM, DIN, (bf16*)(wl + WT_IN), scr, r, lane); continue; } r -= I_IN;
    if (r < I_SQ) { transpose_item(w19 + (size_t)l * DM * DM, DM, DM, (bf16*)(wl + WT_OUT), scr, r, lane); continue; } r -= I_SQ;
    if (r < I_SQ) { transpose_item(w22 + (size_t)l * DM * DM, DM, DM, (bf16*)(wl + WT_MQ), scr, r, lane); continue; } r -= I_SQ;
    if (r < I_2K) { transpose_item(w23 + (size_t)l * DM * 2048, DM, 2048, (bf16*)(wl + WT_MKV), scr, r, lane); continue; } r -= I_2K;
    if (r < I_SQ) { transpose_item(w24 + (size_t)l * DM * DM, DM, DM, (bf16*)(wl + WT_MO), scr, r, lane); continue; } r -= I_SQ;
    if (r < I_2K) { transpose_item(w26 + (size_t)l * DM * 2048, DM, 2048, (bf16*)(wl + WT_PQ), scr, r, lane); continue; } r -= I_2K;
    transpose_item(w16 + (size_t)l * 256 * 256, 256, 256, (bf16*)(wl + WT_GLU), scr, r, lane);
  }
}

template <class T> __device__ __forceinline__ T* opq(T* p) { asm volatile("" : "+s"(p)); return p; }
__device__ __forceinline__ void cvt_rows_bf16(const int wave_s, const float* src, bf16* dst, size_t n) {
  const int tid_ = opaque_tid(wave_s);
  const size_t gt = (size_t)blockIdx.x * (NWAVES * 64) + tid_;
  const size_t nth = (size_t)gridDim.x * NWAVES * 64;
  for (size_t i = gt; i < n / 8; i += nth) {
    const float4 a = ((const float4*)src)[2 * i], b = ((const float4*)src)[2 * i + 1];
    uint4 o; o.x = pk2(a.x, a.y); o.y = pk2(a.z, a.w); o.z = pk2(b.x, b.y); o.w = pk2(b.z, b.w);
    ((uint4*)dst)[i] = o;
  }
}

__device__ __forceinline__ unsigned enc_e4m3(float x) {
  const _Float16 hf = (_Float16)x;
  const unsigned h = (unsigned)__builtin_bit_cast(unsigned short, hf);
  return ((h + 0x7Fu + ((h >> 8) & 1u)) >> 8) & 0xFFu;
}
__device__ __forceinline__ void cvt_rows_e4m3(const int wave_s, const float* src, unsigned char* dst, size_t n, float sc) {
  const int tid_ = opaque_tid(wave_s);
  const size_t gt = (size_t)blockIdx.x * (NWAVES * 64) + tid_;
  const size_t nth = (size_t)gridDim.x * NWAVES * 64;
  for (size_t i = gt; i < n / 16; i += nth) {
    unsigned w[4];
#pragma unroll
    for (int k = 0; k < 4; k++) {
      const float4 a = ((const float4*)src)[4 * i + k];
      w[k] = enc_e4m3(a.x * sc) | (enc_e4m3(a.y * sc) << 8) | (enc_e4m3(a.z * sc) << 16) | (enc_e4m3(a.w * sc) << 24);
    }
    uint4 o; o.x = w[0]; o.y = w[1]; o.z = w[2]; o.w = w[3];
    ((uint4*)dst)[i] = o;
  }
}

__device__ __forceinline__ unsigned enc_v4(float z) {
  const float az = fabsf(z);
  unsigned c = 0;
  c += az > 0.25f; c += az > 0.5f; c += az > 0.75f; c += az > 1.0625f; c += az > 1.375f; c += az > 1.75f; c += az > 2.25f;
  return c | ((__builtin_bit_cast(unsigned, z) >> 28) & 8u);
}
__device__ __forceinline__ void cvt_rows_v4(const int wave_s, const float* src, unsigned char* dst, float* sc_out, int nrows) {
  const int tid_ = opaque_tid(wave_s);
  const int lane = tid_ & 63;
  const int gw = blockIdx.x * NWAVES + (tid_ >> 6);
  const int nw = gridDim.x * NWAVES;
  for (int r = gw; r < nrows; r += nw) {
    const float4* sp = (const float4*)(src + (size_t)r * 1024 + lane * 16);
    const float4 a0 = sp[0], a1 = sp[1], a2 = sp[2], a3 = sp[3];
    const float xv[16] = {a0.x, a0.y, a0.z, a0.w, a1.x, a1.y, a1.z, a1.w, a2.x, a2.y, a2.z, a2.w, a3.x, a3.y, a3.z, a3.w};
    float ss = 0.f;
#pragma unroll
    for (int i = 0; i < 16; i++) ss += xv[i] * xv[i];
    ss = wsum(ss);
    const float sc = sqrtf(ss * (1.0f / 1024.f)) * V4_ROWSCALE;
    const float inv = sc > 0.f ? 1.0f / sc : 0.f;
    unsigned w[2] = {0u, 0u};
#pragma unroll
    for (int i = 0; i < 16; i++) w[i >> 3] |= enc_v4(xv[i] * inv) << (4 * (i & 7));
    uint2 o; o.x = w[0]; o.y = w[1];
    *(uint2*)(dst + (size_t)r * 512 + lane * 8) = o;
    if (lane == 0) sc_out[r] = sc;
  }
}

#define GEMM_F32(Aptr, Wt, Cptr, Rptr, M_, N_) do { \
    pg8::Gemm g_{opq((const bf16*)(Aptr)), opq((const bf16*)(Wt)), (M_), (N_), DM}; pg8::StaticOrder S_; S_.init((M_), (N_), (int)gridDim.x, (int)blockIdx.x); \
    pg8::EpiF32R E_{opq((float*)(Cptr)), opq((const float*)(Rptr)), (N_)}; \
    pg8::gemm_phase<pg8::EpiF32R, pg8::StaticOrder, true, true>(wave_s, ldsl, g_, S_, E_); } while (0)
#define GEMM_BF16_C(Aptr, Wt, Optr, M_, N_, C_) do { \
    pg8::Gemm g_{opq((const bf16*)(Aptr)), opq((const bf16*)(Wt)), (M_), (N_), DM}; pg8::StaticOrder S_; S_.init((M_), (N_), (int)gridDim.x, (C_)); \
    pg8::EpiBf16 E_{opq((bf16*)(Optr)), (N_)}; \
    pg8::gemm_phase<pg8::EpiBf16, pg8::StaticOrder, true, true>(wave_s, ldsl, g_, S_, E_); } while (0)
#define GEMM_BF16(Aptr, Wt, Optr, M_, N_) GEMM_BF16_C(Aptr, Wt, Optr, M_, N_, (int)blockIdx.x)
#define GEMM_F32RN(Aptr, Wt, Cptr, Rptr, XGptr, Gptr, STptr) do { \
    pg8::Gemm g_{opq((const bf16*)(Aptr)), opq((const bf16*)(Wt)), NT, DM, DM}; pg8::StaticOrder S_; S_.init(NT, DM, (int)gridDim.x, (int)blockIdx.x); \
    pg8::EpiF32RN E_{opq((float*)(Cptr)), opq((const float*)(Rptr)), DM, opq((bf16*)(XGptr)), opq((const float*)(Gptr)), opq((float*)(STptr))}; \
    pg8::gemm_phase<pg8::EpiF32RN, pg8::StaticOrder, true, true>(wave_s, ldsl, g_, S_, E_); } while (0)
#define GEMM_BF16S(Aptr, Wt, Optr, N_, STptr) do { \
    pg8::Gemm g_{opq((const bf16*)(Aptr)), opq((const bf16*)(Wt)), NT, (N_), DM}; pg8::StaticOrder S_; S_.init(NT, (N_), (int)gridDim.x, (int)blockIdx.x); \
    pg8::EpiBf16S E_{opq((bf16*)(Optr)), (N_), opq((const float*)(STptr))}; \
    pg8::gemm_phase<pg8::EpiBf16S, pg8::StaticOrder, true, true>(wave_s, ldsl, g_, S_, E_); } while (0)

__global__ void __launch_bounds__(NWAVES * 64, 2) fwd_megakernel(Params p) {
  extern __shared__ __attribute__((aligned(16))) unsigned char lds[];
  LAS unsigned char* ldsl = (LAS unsigned char*)lds;
  LAS float* smem = (LAS float*)ldsl;
  const int wave_s = __builtin_amdgcn_readfirstlane((int)(threadIdx.x >> 6));
  unsigned char* ws = p.ws;
  volatile LAS unsigned* MISC = (volatile LAS unsigned*)(ldsl + (LDS_BYTES - 256));
  if (threadIdx.x < 64) MISC[threadIdx.x] = 0u;
  __syncthreads();
  const XcdBarrier bar = xcd_barrier_post((unsigned*)(ws + WS_CTL) + 4096, MISC + 8);
  float* xw = (float*)(ws + WS_XW);
  bf16* xn = (bf16*)(ws + WS_XN);
  bf16* big = (bf16*)(ws + WS_BIG);
  bf16* y = (bf16*)(ws + WS_Y);
  bf16* memh = (bf16*)(ws + WS_MEMH);
  bf16* kvb = (bf16*)(ws + WS_KVB);
  bf16* vT = (bf16*)(ws + WS_VT);
  float* ssmE = (float*)(ws + WS_SSME);
  float* ssmp = (float*)(ws + WS_SSMP);
  int* ids = (int*)(ws + WS_IDS);
  float* gates = (float*)(ws + WS_GATE);
  bf16* skb = (bf16*)(ws + WS_SKB);
  unsigned char* ub = ws + WS_UB;
  unsigned char* vb = ws + WS_VB;
  float* rst = (float*)(ws + WS_RST);
  float* vsc = (float*)(ws + WS_VSC);

  prologue_transposes(wave_s, p, ws, ldsl);
  cvt_rows_bf16(wave_s, karg_in(27), skb, (size_t)2 * 8 * 2 * 128 * 128);
  cvt_rows_e4m3(wave_s, karg_in(28), ub, (size_t)2 * 16384 * 1024, U_SCALE);
  cvt_rows_v4(wave_s, karg_in(29), vb, vsc, 2 * 16384);
  for (int l = 0; l < 2; l++)
    rms_rows<true>(wave_s, karg_in(1), karg_in(21) + l * DM, memh + (size_t)l * 1024 * 1024, 1024);
  ssm_params(wave_s, p, ssmp);
  xcd_barrier(bar);
  for (int l = 0; l < 2; l++)
    GEMM_BF16_C(memh + (size_t)l * 1024 * 1024, ws + WS_WT + (size_t)l * WT_LAYER + WT_MKV,
              kvb + (size_t)l * 1024 * 2048, 1024, 2048, (int)((blockIdx.x + gridDim.x - 32u * (unsigned)l) % gridDim.x));

#pragma nounroll
  for (int l = 0; l < 2; l++) {
    const float* xcur = (l == 0) ? karg_in(0) : xw;
    const float* sp = ssmp + (size_t)l * SSMP_PER_LAYER;
    const unsigned char* wl = ws + WS_WT + (size_t)l * WT_LAYER;
    if (l == 0) {
      rms_rows<true>(wave_s, xcur, karg_in(2) + l * DM, xn, NT);
      xcd_barrier(bar);
    }
    GEMM_BF16(xn, wl + WT_IN, big, NT, DIN);
    xcd_barrier(bar);
    if (l == 0) vt_phase(wave_s, kvb, vT);
    ssm_chunk_end(wave_s, sp, big, ssmE);
    attn_phase(wave_s, p, l, big, y, smem);
    conv_phase(wave_s, p, l, big, y, smem);
    xcd_barrier(bar);
    ssm_finish(wave_s, p, l, sp, big, ssmE, y, smem);
    xcd_barrier(bar);
    GEMM_F32RN(y, wl + WT_OUT, xw, xcur, xn, karg_in(20) + l * DM, rst);
    xcd_barrier(bar);
    GEMM_BF16S(xn, wl + WT_MQ, big, DM, rst);
    xcd_barrier(bar);
    memattn_phase(wave_s, big, kvb + (size_t)l * 1024 * 2048, vT + (size_t)l * 4 * 4 * 256 * 256, y, smem);
    xcd_barrier(bar);
    GEMM_F32RN(y, wl + WT_MO, xw, (const float*)xw, xn, karg_in(25) + l * DM, rst);
    xcd_barrier(bar);
    GEMM_BF16S(xn, wl + WT_PQ, big, 2048, rst);
    xcd_barrier(bar);
    peer_topk(wave_s, big, skb + (size_t)l * 8 * 2 * 128 * 128, ids, gates, smem);
    xcd_barrier(bar);
    if (l == 0) {
      peer_gather<false>(wave_s, xn, rst, ub + (size_t)l * 16384 * DM, vb + (size_t)l * 16384 * 512, vsc + (size_t)l * 16384, ids, gates, xw, karg_in(2) + DM, (float*)nullptr);
      xcd_barrier(bar);
    } else {
      peer_gather<true>(wave_s, xn, rst, ub + (size_t)l * 16384 * DM, vb + (size_t)l * 16384 * 512, vsc + (size_t)l * 16384, ids, gates, xw, karg_in(30), p.out);
    }
  }
}

extern "C" void kernel_launch(void* const* d_in, const int* in_sizes, int n_in,
                              void* d_out, int out_size, void* d_ws, size_t ws_size,
                              hipStream_t stream) {
  static int grid_blocks = 0;
  if (!grid_blocks) {
    int dev = 0, cus = 0, per_cu = 0;
    (void)hipGetDevice(&dev);
    (void)hipDeviceGetAttribute(&cus, hipDeviceAttributeMultiprocessorCount, dev);
    (void)hipFuncSetAttribute((const void*)fwd_megakernel, hipFuncAttributeMaxDynamicSharedMemorySize, LDS_BYTES);
    (void)hipOccupancyMaxActiveBlocksPerMultiprocessor(&per_cu, fwd_megakernel, NWAVES * 64, LDS_BYTES);
    if (per_cu < 1) fprintf(stderr, "occupancy query reports %d blocks/CU\n", per_cu);
    grid_blocks = cus;
  }
  (void)hipMemsetAsync((char*)d_ws + WS_CTL, 0, 1 * MiB, stream);
  Params p{};
  for (int i = 0; i < 31; i++) p.in[i] = (const float*)d_in[i];
  p.out = (float*)d_out;
  p.ws = (unsigned char*)d_ws;
  void* args[] = {&p};
  hipError_t e = hipLaunchCooperativeKernel((void*)fwd_megakernel, dim3(grid_blocks), dim3(NWAVES * 64),
                                            args, LDS_BYTES, stream);
  if (e != hipSuccess)
    fprintf(stderr, "cooperative launch failed: %s (grid %d)\n", hipGetErrorString(e), grid_blocks);
}
```

```cpp
#include <hip/hip_runtime.h>
#include <hip/hip_cooperative_groups.h>
#include <cstdio>
namespace cg = cooperative_groups;

#define NT 16384
#define SEQ 4096
#define DM 1024
#define DIN 2304
#define NMEM 256
#define EPSF 1e-6f
#define NWAVES 8
#define LDS_BYTES 147456

typedef unsigned short bf16;
#define LAS __attribute__((address_space(3)))

struct Params {
  const float* in[31];
  float* out;
  unsigned char* ws;
};
typedef __attribute__((address_space(4))) const unsigned char* kaptr_t;
__device__ __forceinline__ const float* karg_in(int i) {
  kaptr_t ka = (kaptr_t)__builtin_amdgcn_kernarg_segment_ptr();
  asm volatile("" : "+s"(ka));
  return *(const float* __attribute__((address_space(4))) const*)(ka + 8 * i);
}

constexpr size_t MiB = 1u << 20;
constexpr size_t WS_CTL  = 0;
constexpr size_t WS_WT   = 1 * MiB;
constexpr size_t WT_IN = 0, WT_OUT = WT_IN + (size_t)DIN * DM * 2, WT_MQ = WT_OUT + (size_t)DM * DM * 2,
                 WT_MKV = WT_MQ + (size_t)DM * DM * 2, WT_MO = WT_MKV + (size_t)2048 * DM * 2,
                 WT_PQ = WT_MO + (size_t)DM * DM * 2, WT_GLU = WT_PQ + (size_t)2048 * DM * 2, WT_LAYER = WT_GLU + (size_t)256 * 256 * 2;
constexpr size_t WS_XW   = WS_WT + 2 * WT_LAYER;
constexpr size_t WS_XN   = WS_XW + (size_t)NT * DM * 4;
constexpr size_t WS_BIG  = WS_XN + (size_t)NT * DM * 2;
constexpr size_t WS_Y    = WS_BIG + (size_t)NT * DIN * 2;
constexpr size_t WS_MEMH = WS_Y + (size_t)NT * DM * 2;
constexpr size_t WS_KVB  = WS_MEMH + (size_t)2 * 1024 * 1024 * 2;
constexpr size_t WS_VT   = WS_KVB + (size_t)2 * 1024 * 2048 * 2;
constexpr size_t WS_SSME = WS_VT + (size_t)2 * 4 * 4 * 256 * 256 * 2;
#define SSMP_PER_LAYER (2048 + 2048 + 32768)
constexpr size_t WS_SSMP = WS_SSME + (size_t)4 * 64 * 16 * 64 * 2 * 4;
constexpr size_t WS_IDS  = WS_SSMP + (size_t)2 * SSMP_PER_LAYER * 4;
constexpr size_t WS_GATE = WS_IDS + (size_t)NT * 128 * 4;
constexpr size_t WS_SKB  = WS_GATE + (size_t)NT * 128 * 4;
constexpr size_t WS_UB   = WS_SKB + (size_t)2 * 8 * 2 * 128 * 128 * 2;
constexpr size_t WS_VB   = WS_UB + (size_t)2 * 16384 * 512;
constexpr size_t WS_VSC  = WS_VB + (size_t)2 * 16384 * 512;
constexpr size_t WS_USC  = WS_VSC + (size_t)2 * 16384 * 4;
constexpr size_t WS_RST  = WS_USC + (size_t)2 * 16384 * 4;
constexpr size_t WS_END  = WS_RST + (size_t)NT * 16 * 4;
#define U_SCALE 64.0f
#define U4_STEP 0.3352f
#define V4_LUT_LO 0x3B393630u
#define V4_LUT_HI 0x41403E3Du
#define V4_ROWSCALE 1.075f
static_assert(WS_END <= 512 * MiB, "workspace");
static_assert(WT_LAYER % 256 == 0 && WS_SSMP % 16 == 0 && WS_IDS % 16 == 0 && WS_SKB % 256 == 0 && WS_VT % 256 == 0, "align");

__device__ __forceinline__ int opaque_tid(int wave_s) { int v = wave_s * 64 + (int)__builtin_amdgcn_mbcnt_hi(~0u, __builtin_amdgcn_mbcnt_lo(~0u, 0u)); asm volatile("" : "+v"(v)); return v; }
__device__ __forceinline__ unsigned f2bf(float f) { unsigned u = __builtin_bit_cast(unsigned, f); return (u + 0x7fffu + ((u >> 16) & 1u)) >> 16; }
__device__ __forceinline__ unsigned pk2(float lo, float hi) { return f2bf(lo) | (f2bf(hi) << 16); }
__device__ __forceinline__ float bf_lo(unsigned u) { return __builtin_bit_cast(float, u << 16); }
__device__ __forceinline__ float bf_hi(unsigned u) { return __builtin_bit_cast(float, u & 0xffff0000u); }
__device__ __forceinline__ float bf2f(bf16 h) { return __builtin_bit_cast(float, (unsigned)h << 16); }


#define XB_TMO      128
#define XB_XCNT(j)  (256  + 64 * (j))
#define XB_XSUB(j)  (1280 + 64 * (j))
#define XB_XGEN(j)  (2304 + 64 * (j))
#define XB_TOP      3328
#define XB_TOPGEN   3392
#define XCD_BAR_WORDS 3456
#define XB_SPIN_CAP (1u << 22)
__device__ __forceinline__ unsigned xb_ld(unsigned* p)              { return __hip_atomic_load(p, __ATOMIC_RELAXED, __HIP_MEMORY_SCOPE_AGENT); }
__device__ __forceinline__ unsigned xb_add(unsigned* p, unsigned v) { return __hip_atomic_fetch_add(p, v, __ATOMIC_RELAXED, __HIP_MEMORY_SCOPE_AGENT); }
__device__ __forceinline__ unsigned xb_xcc_id() { return (unsigned)__builtin_amdgcn_s_getreg((3 << 11) | 20) & 0xFu; }
#define XB_SPIN(cond, bar) do { unsigned _sp = 0; while (cond) { __builtin_amdgcn_s_sleep(1); \
    if ((++_sp & 255u) == 0u) { if (xb_ld(&(bar)[XB_TMO])) break; if (_sp > XB_SPIN_CAP) { atomicAdd(&(bar)[XB_TMO], 1u); break; } } } } while (0)
struct XcdBarrier { unsigned* bar; unsigned x; volatile LAS unsigned* st; };
__device__ __forceinline__ XcdBarrier xcd_barrier_post(unsigned* bar, volatile LAS unsigned* st) {
    XcdBarrier b; b.bar = bar; b.x = xb_xcc_id(); b.st = st;
    if (threadIdx.x == 0) (void)xb_add(&bar[XB_XCNT(b.x)], 1u);
    return b;
}
__device__ __forceinline__ void xcd_barrier_complete(unsigned* bar, unsigned x, unsigned& nloc, unsigned& nx) {
    const unsigned G = gridDim.x * gridDim.y * gridDim.z;
    unsigned sum, cnt, mine, sp = 0u;
    for (;;) {
        sum = 0u; cnt = 0u; mine = 0u;
#pragma unroll
        for (unsigned j = 0; j < 16; ++j) { const unsigned c = xb_ld(&bar[XB_XCNT(j)]); sum += c; cnt += (c > 0u) ? 1u : 0u; mine = (j == x) ? c : mine; }
        if (sum == G) break;
        __builtin_amdgcn_s_sleep(1);
        if ((++sp & 255u) == 0u) { if (xb_ld(&bar[XB_TMO])) break; if (sp > XB_SPIN_CAP) { atomicAdd(&bar[XB_TMO], 1u); break; } }
    }
    nloc = mine > 0u ? mine : 1u; nx = cnt > 0u ? cnt : 1u;
}
__device__ __forceinline__ void xcd_barrier(const XcdBarrier& b) {
    asm volatile("s_waitcnt vmcnt(0)" ::: "memory");
    __syncthreads();
    if (threadIdx.x == 0) {
        unsigned* bar = b.bar;
        __builtin_amdgcn_s_waitcnt(0);
        unsigned nloc = b.st[0], nx = b.st[1];
        if (nloc == 0u) { xcd_barrier_complete(bar, b.x, nloc, nx); b.st[0] = nloc; b.st[1] = nx; }
        const unsigned old = xb_add(&bar[XB_XSUB(b.x)], 1u);
        const unsigned gen = old / nloc;
        if (old + 1u == (gen + 1u) * nloc) {
            __builtin_amdgcn_fence(__ATOMIC_RELEASE, "agent");
            asm volatile("s_waitcnt vmcnt(0)" ::: "memory");
            const unsigned og = xb_add(&bar[XB_TOP], 1u);
            const unsigned tg = og / nx;
            if (og + 1u == (tg + 1u) * nx) xb_add(&bar[XB_TOPGEN], 1u);
            else XB_SPIN(xb_ld(&bar[XB_TOPGEN]) == tg, bar);
            __builtin_amdgcn_fence(__ATOMIC_ACQUIRE, "agent");
            xb_add(&bar[XB_XGEN(b.x)], 1u);
            asm volatile("s_waitcnt vmcnt(0)" ::: "memory");
        } else {
            XB_SPIN(xb_ld(&bar[XB_XGEN(b.x)]) == gen, bar);
            __builtin_amdgcn_fence(__ATOMIC_ACQUIRE, "agent");
            asm volatile("s_waitcnt vmcnt(0)" ::: "memory");
        }
    }
    __syncthreads();
}

namespace pg8 {
#define PG8_LAS __attribute__((address_space(3)))
typedef unsigned short bf16_t;
typedef short bf16x8 __attribute__((ext_vector_type(8)));
typedef float f32x4 __attribute__((ext_vector_type(4)));
typedef unsigned u32x4 __attribute__((ext_vector_type(4)));
constexpr int BM = 256, BK = 64, HALF = 128, HTB = HALF * BK * 2, STAGE_BYTES = 8 * HTB, NXCD = 8, WGM = 8;
__host__ __device__ __forceinline__ int lds_byte(int r, int c) { const int st = (r >> 4) * 2 + (c >> 5), rr = r & 15, cc = c & 31, ob = rr * 64 + cc * 2; return st * 1024 + (ob ^ (((ob >> 9) & 1) << 5)); }
__host__ __device__ __forceinline__ void stage_rc(int b, int& R, int& C) { const int st = b / 1024, sb = b % 1024, swz = sb ^ (((sb >> 9) & 1) << 5); R = (st >> 1) * 16 + swz / 64; C = (st & 1) * 32 + (swz % 64) / 2; }
__host__ __device__ __forceinline__ int perm32(int rho) { const int n = rho >> 4, i = rho & 15; return 8 * (i >> 2) + 4 * n + (i & 3); }
struct Unit { int pm, pn; };
struct Gemm { const bf16_t* A; const bf16_t* Bt; int M, N, K; };
struct StaticOrder {
    int nM, nN, nwg, G, c;
    __host__ __device__ __forceinline__ void init(int M, int N, int G_, int c_) { nM = M / BM; nN = N / BM; nwg = nM * nN; G = G_; c = c_; }
    __host__ __device__ bool next(int i, Unit& u) const {
        const long L = (long)i * G + c; if (L >= nwg) return false;
        int wgid = (int)L; { const int q = nwg / NXCD, r = nwg % NXCD, xcd = wgid % NXCD, off = wgid / NXCD; wgid = (xcd < r ? xcd * (q + 1) : r * (q + 1) + (xcd - r) * q) + off; }
        const int nig = WGM * nN, gid = wgid / nig, fm = gid * WGM, gsz = (nM - fm) < WGM ? (nM - fm) : WGM;
        u.pm = fm + ((wgid % nig) % gsz); u.pn = (wgid % nig) / gsz; return true;
    }
    __device__ __forceinline__ void a_ready(const Unit&) const {}
    __device__ __forceinline__ void done(const Unit&) const {}
};
__device__ __forceinline__ unsigned cvt_pk_bf16(float lo, float hi) { unsigned r; asm volatile("v_cvt_pk_bf16_f32 %0, %1, %2" : "=v"(r) : "v"(lo), "v"(hi)); return r; }

struct EpiF32R {
    static constexpr bool PERM = false, AFTER_DRAIN = false;
    float* C; const float* R; int ldc;
    __device__ __forceinline__ void operator()(const f32x4 (&acc)[2][2][4][2], const Unit& u, int wr, int wc, int fr, int fq) const {
        const int row0 = u.pm * BM + wr * 64 + fr, col0 = u.pn * BM + wc * 32 + 4 * fq;
#pragma unroll
        for (int ai = 0; ai < 2; ++ai)
#pragma unroll
            for (int m = 0; m < 4; ++m) {
                const size_t ro = (size_t)(row0 + ai * HALF + m * 16) * ldc + col0;
                f32x4 rv[2][2];
#pragma unroll
                for (int bj = 0; bj < 2; ++bj)
#pragma unroll
                    for (int n = 0; n < 2; ++n) rv[bj][n] = R ? *(const f32x4*)(R + ro + bj * HALF + n * 16) : (f32x4){0.f, 0.f, 0.f, 0.f};
#pragma unroll
                for (int bj = 0; bj < 2; ++bj)
#pragma unroll
                    for (int n = 0; n < 2; ++n) *(f32x4*)(C + ro + bj * HALF + n * 16) = acc[ai][bj][m][n] + rv[bj][n];
                __builtin_amdgcn_sched_barrier(0);
            }
    }
};

struct EpiBf16 {
    static constexpr bool PERM = true, AFTER_DRAIN = false;
    bf16_t* O; int ldc;
    __device__ __forceinline__ void operator()(const f32x4 (&acc)[2][2][4][2], const Unit& u, int wr, int wc, int fr, int fq) const {
        const int row0 = u.pm * BM + wr * 64 + fr, col0 = u.pn * BM + wc * 32 + 8 * fq;
#pragma unroll
        for (int ai = 0; ai < 2; ++ai)
#pragma unroll
            for (int m = 0; m < 4; ++m) { bf16_t* rowp = O + (size_t)(row0 + ai * HALF + m * 16) * ldc + col0;
#pragma unroll
                for (int bj = 0; bj < 2; ++bj) { const f32x4 v0 = acc[ai][bj][m][0], v1 = acc[ai][bj][m][1];
                    u32x4 w; w.x = cvt_pk_bf16(v0[0], v0[1]); w.y = cvt_pk_bf16(v0[2], v0[3]); w.z = cvt_pk_bf16(v1[0], v1[1]); w.w = cvt_pk_bf16(v1[2], v1[3]);
                    *(u32x4*)(rowp + bj * HALF) = w; } }
    }
};

struct EpiF32RN {
    static constexpr bool PERM = false, AFTER_DRAIN = false;
    float* C; const float* R; int ldc; bf16_t* XG; const float* g; float* st;
    __device__ __forceinline__ void operator()(const f32x4 (&acc)[2][2][4][2], const Unit& u, int wr, int wc, int fr, int fq) const {
        const int row0 = u.pm * BM + wr * 64 + fr, col0 = u.pn * BM + wc * 32 + 4 * fq;
        f32x4 gv[2][2];
#pragma unroll
        for (int bj = 0; bj < 2; ++bj)
#pragma unroll
            for (int n = 0; n < 2; ++n) gv[bj][n] = *(const f32x4*)(g + col0 + bj * HALF + n * 16);
#pragma unroll
        for (int ai = 0; ai < 2; ++ai)
#pragma unroll
            for (int m = 0; m < 4; ++m) {
                const int row = row0 + ai * HALF + m * 16;
                const size_t ro = (size_t)row * ldc + col0;
                f32x4 rv[2][2];
#pragma unroll
                for (int bj = 0; bj < 2; ++bj)
#pragma unroll
                    for (int n = 0; n < 2; ++n) rv[bj][n] = *(const f32x4*)(R + ro + bj * HALF + n * 16);
                float ss = 0.f;
#pragma unroll
                for (int bj = 0; bj < 2; ++bj)
#pragma unroll
                    for (int n = 0; n < 2; ++n) {
                        const f32x4 v = acc[ai][bj][m][n] + rv[bj][n];
                        *(f32x4*)(C + ro + bj * HALF + n * 16) = v;
                        ss += (v[0] * v[0] + v[1] * v[1]) + (v[2] * v[2] + v[3] * v[3]);
                        const f32x4 w = v * gv[bj][n];
                        uint2 pk; pk.x = cvt_pk_bf16(w[0], w[1]); pk.y = cvt_pk_bf16(w[2], w[3]);
                        *(uint2*)(XG + ro + bj * HALF + n * 16) = pk;
                    }
                ss += __shfl_xor(ss, 16, 64); ss += __shfl_xor(ss, 32, 64);
                if (fq == 0) st[(size_t)row * 16 + u.pn * 4 + wc] = ss;
                __builtin_amdgcn_sched_barrier(0);
            }
    }
};
struct EpiBf16S {
    static constexpr bool PERM = true, AFTER_DRAIN = false;
    bf16_t* O; int ldc; const float* st;
    __device__ __forceinline__ void operator()(const f32x4 (&acc)[2][2][4][2], const Unit& u, int wr, int wc, int fr, int fq) const {
        const int row0 = u.pm * BM + wr * 64 + fr, col0 = u.pn * BM + wc * 32 + 8 * fq;
#pragma unroll
        for (int ai = 0; ai < 2; ++ai)
#pragma unroll
            for (int m = 0; m < 4; ++m) {
                const int row = row0 + ai * HALF + m * 16;
                const f32x4* sp = (const f32x4*)(st + (size_t)row * 16);
                const f32x4 s0 = sp[0], s1 = sp[1], s2 = sp[2], s3 = sp[3];
                const f32x4 sa = (s0 + s1) + (s2 + s3);
                const float rs = __builtin_amdgcn_rsqf(((sa[0] + sa[1]) + (sa[2] + sa[3])) * (1.0f / 1024.f) + 1e-6f);
                bf16_t* rowp = O + (size_t)row * ldc + col0;
#pragma unroll
                for (int bj = 0; bj < 2; ++bj) { const f32x4 v0 = acc[ai][bj][m][0] * rs, v1 = acc[ai][bj][m][1] * rs;
                    u32x4 w; w.x = cvt_pk_bf16(v0[0], v0[1]); w.y = cvt_pk_bf16(v0[2], v0[3]); w.z = cvt_pk_bf16(v1[0], v1[1]); w.w = cvt_pk_bf16(v1[2], v1[3]);
                    *(u32x4*)(rowp + bj * HALF) = w; }
                __builtin_amdgcn_sched_barrier(0);
            }
    }
};

template <class Epi, class Sched, bool ALIGN_EPI = false, bool SP2 = false>
__device__ __forceinline__ void gemm_phase(const int wave_s, PG8_LAS unsigned char* lds, const Gemm g, const Sched& S, const Epi& E) {
    const int tid = opaque_tid(wave_s), wid = __builtin_amdgcn_readfirstlane(tid >> 6), lane = tid & 63, wr = wid >> 2, wc = wid & 3, fr = lane & 15, fq = lane >> 4;
    const int K = g.K, nt = K / BK;
    unsigned voffA[2], voffB[2];
#pragma unroll
    for (int i = 0; i < 2; ++i) { int R, C; stage_rc(tid * 16 + i * 8192, R, C); const int Rb = Epi::PERM ? ((R & ~31) + perm32(R & 31)) : R;
        voffA[i] = (unsigned)(R * K + C) * 2u; voffB[i] = (unsigned)(Rb * K + C) * 2u; }
    const size_t kstep = (size_t)(BK * 2);
    const size_t hstep = (size_t)HALF * K * 2;
    const size_t tstep = 2 * hstep;
    const unsigned ldsw = (unsigned)wid * 1024u;
    const int aoff = lds_byte(wr * 64 + fr, fq * 8), boff = lds_byte(wc * 32 + fr, fq * 8);
#define PG8_SA(b, h) (((b) * 2 + (h)) * HTB)
#define PG8_SB(b, h) ((4 + (b) * 2 + (h)) * HTB)
#define PG8_STAGE(bufoff, gbase, voff) do { _Pragma("unroll") for (int _i = 0; _i < 2; ++_i) \
        __builtin_amdgcn_global_load_lds((const unsigned*)((const char*)(gbase) + (voff)[_i]), (PG8_LAS unsigned*)(lds + (bufoff) + ldsw + _i * 8192), 16, 0, 0); } while (0)
#define PG8_LDA(dst, b, h) do { _Pragma("unroll") for (int m = 0; m < 4; ++m) _Pragma("unroll") for (int k = 0; k < 2; ++k) dst[m][k] = *(const PG8_LAS bf16x8*)(lds + PG8_SA(b, h) + aoff + m * 2048 + k * 1024); } while (0)
#define PG8_LDB(dst, b, h) do { _Pragma("unroll") for (int n = 0; n < 2; ++n) _Pragma("unroll") for (int k = 0; k < 2; ++k) dst[n][k] = *(const PG8_LAS bf16x8*)(lds + PG8_SB(b, h) + boff + n * 2048 + k * 1024); } while (0)
#define PG8_MMA(ai, bj, At, Bt) do { __builtin_amdgcn_s_setprio(1); _Pragma("unroll") for (int m = 0; m < 4; ++m) _Pragma("unroll") for (int n = 0; n < 2; ++n) _Pragma("unroll") for (int k = 0; k < 2; ++k) \
        acc[ai][bj][m][n] = __builtin_amdgcn_mfma_f32_16x16x32_bf16(Bt[n][k], At[m][k], acc[ai][bj][m][n], 0, 0, 0); __builtin_amdgcn_s_setprio(0); } while (0)
#define PG8_WAIT_V(n) asm volatile("s_waitcnt vmcnt(" #n ")" ::: "memory")
#define PG8_WAIT_L(n) asm volatile("s_waitcnt lgkmcnt(" #n ")" ::: "memory")
#define PG8_BAR __builtin_amdgcn_s_barrier()
#define PG8_SCHED __builtin_amdgcn_sched_barrier(0)
    Unit cur, nxt; int ui = 0;
    if (!S.next(0, cur)) return;
    f32x4 acc[2][2][4][2];
#pragma unroll
    for (int a = 0; a < 2; ++a)
#pragma unroll
        for (int b = 0; b < 2; ++b)
#pragma unroll
            for (int m = 0; m < 4; ++m)
#pragma unroll
                for (int n = 0; n < 2; ++n) acc[a][b][m][n] = (f32x4){0.f, 0.f, 0.f, 0.f};
    bf16x8 At[4][2], B0[2][2], B1[2][2];
    const char* cA = (const char*)g.A + (size_t)cur.pm * tstep; const char* cB = (const char*)g.Bt + (size_t)cur.pn * tstep;
    S.a_ready(cur);
    if constexpr (SP2) {
        PG8_STAGE(PG8_SB(0, 0), cB, voffB); PG8_STAGE(PG8_SB(0, 1), cB + hstep, voffB); PG8_STAGE(PG8_SA(0, 0), cA, voffA); PG8_STAGE(PG8_SA(0, 1), cA + hstep, voffA);
        if (wr == 1) PG8_BAR;
        PG8_WAIT_V(2); PG8_BAR;
        PG8_STAGE(PG8_SB(1, 0), cB + kstep, voffB); PG8_STAGE(PG8_SA(1, 0), cA + kstep, voffA); PG8_STAGE(PG8_SB(1, 1), cB + hstep + kstep, voffB);
        PG8_WAIT_V(6); PG8_BAR;
    } else {
        PG8_STAGE(PG8_SB(0, 0), cB, voffB); PG8_STAGE(PG8_SA(0, 0), cA, voffA); PG8_STAGE(PG8_SB(0, 1), cB + hstep, voffB); PG8_STAGE(PG8_SA(0, 1), cA + hstep, voffA);
        if (wr == 1) PG8_BAR;
        PG8_WAIT_V(4); PG8_BAR;
        PG8_STAGE(PG8_SB(1, 0), cB + kstep, voffB); PG8_STAGE(PG8_SA(1, 0), cA + kstep, voffA); PG8_STAGE(PG8_SB(1, 1), cB + hstep + kstep, voffB);
        PG8_WAIT_V(6); PG8_BAR;
    }
    for (;;) {
        const bool has_next = S.next(ui + 1, nxt);
        const char* nA = has_next ? (const char*)g.A + (size_t)nxt.pm * tstep : cA; const char* nB = has_next ? (const char*)g.Bt + (size_t)nxt.pn * tstep : cB;
        for (int t = 0; t < nt; t += 2) {
            const bool last = (t == nt - 2);
            const char* a1 = cA + (size_t)(t + 1) * kstep;
            const char* a2 = last ? nA : cA + (size_t)(t + 2) * kstep; const char* b2 = last ? nB : cB + (size_t)(t + 2) * kstep;
            const char* a3 = a2 + kstep; const char* b3 = b2 + kstep;
            if (last && has_next) S.a_ready(nxt);
            if constexpr (SP2) {
            PG8_LDB(B0, 0, 0); PG8_LDB(B1, 0, 1); PG8_SCHED; PG8_LDA(At, 0, 0); PG8_STAGE(PG8_SA(1, 1), a1 + hstep, voffA);
            PG8_WAIT_V(8); PG8_WAIT_L(0); PG8_BAR; PG8_MMA(0, 0, At, B0); PG8_MMA(0, 1, At, B1); PG8_BAR; PG8_SCHED;
            PG8_LDA(At, 0, 1); PG8_STAGE(PG8_SB(0, 0), b2, voffB); PG8_STAGE(PG8_SB(0, 1), b2 + hstep, voffB); PG8_STAGE(PG8_SA(0, 0), a2, voffA);
            PG8_WAIT_V(8); PG8_WAIT_L(0); PG8_BAR; PG8_MMA(1, 0, At, B0); PG8_MMA(1, 1, At, B1); PG8_BAR; PG8_SCHED;
            PG8_LDB(B0, 1, 0); PG8_LDB(B1, 1, 1); PG8_SCHED; PG8_LDA(At, 1, 0); PG8_STAGE(PG8_SA(0, 1), a2 + hstep, voffA);
            PG8_WAIT_V(8); PG8_WAIT_L(0); PG8_BAR; PG8_MMA(0, 0, At, B0); PG8_MMA(0, 1, At, B1); PG8_BAR; PG8_SCHED;
            PG8_LDA(At, 1, 1); PG8_STAGE(PG8_SB(1, 0), b3, voffB); PG8_STAGE(PG8_SB(1, 1), b3 + hstep, voffB); PG8_STAGE(PG8_SA(1, 0), a3, voffA);
            PG8_WAIT_V(8); PG8_WAIT_L(0); PG8_BAR; PG8_MMA(1, 0, At, B0); PG8_MMA(1, 1, At, B1); PG8_BAR; PG8_SCHED;
            } else {
            PG8_LDB(B0, 0, 0); PG8_SCHED; PG8_LDA(At, 0, 0); PG8_STAGE(PG8_SA(1, 1), a1 + hstep, voffA);
            PG8_WAIT_L(8); PG8_BAR; PG8_WAIT_L(0); PG8_MMA(0, 0, At, B0); PG8_BAR; PG8_SCHED;
            PG8_LDB(B1, 0, 1); PG8_STAGE(PG8_SB(0, 0), b2, voffB);
            PG8_BAR; PG8_WAIT_L(0); PG8_MMA(0, 1, At, B1); PG8_BAR;
            PG8_LDA(At, 0, 1); PG8_STAGE(PG8_SA(0, 0), a2, voffA);
            PG8_BAR; PG8_WAIT_L(0); PG8_MMA(1, 0, At, B0); PG8_BAR; PG8_SCHED;
            PG8_STAGE(PG8_SB(0, 1), b2 + hstep, voffB);
            PG8_WAIT_V(6); PG8_BAR; PG8_MMA(1, 1, At, B1); PG8_BAR;
            PG8_LDB(B0, 1, 0); PG8_SCHED; PG8_LDA(At, 1, 0); PG8_STAGE(PG8_SA(0, 1), a2 + hstep, voffA);
            PG8_WAIT_L(8); PG8_BAR; PG8_WAIT_L(0); PG8_MMA(0, 0, At, B0); PG8_BAR; PG8_SCHED;
            PG8_LDB(B1, 1, 1); PG8_STAGE(PG8_SB(1, 0), b3, voffB);
            PG8_BAR; PG8_WAIT_L(0); PG8_MMA(0, 1, At, B1); PG8_BAR;
            PG8_LDA(At, 1, 1); PG8_STAGE(PG8_SA(1, 0), a3, voffA);
            PG8_BAR; PG8_WAIT_L(0); PG8_MMA(1, 0, At, B0); PG8_BAR; PG8_SCHED;
            PG8_STAGE(PG8_SB(1, 1), b3 + hstep, voffB);
            PG8_WAIT_V(6); PG8_BAR; PG8_MMA(1, 1, At, B1); PG8_BAR;
            }
        }
        if constexpr (ALIGN_EPI) { if (wr == 0) PG8_BAR; }
        if constexpr (!Epi::AFTER_DRAIN) { E(acc, cur, wr, wc, fr, fq); S.done(cur); }
        if (!has_next) break;
#pragma unroll
        for (int a = 0; a < 2; ++a)
#pragma unroll
            for (int b = 0; b < 2; ++b)
#pragma unroll
                for (int m = 0; m < 4; ++m)
#pragma unroll
                    for (int n = 0; n < 2; ++n) acc[a][b][m][n] = (f32x4){0.f, 0.f, 0.f, 0.f};
        cur = nxt; cA = nA; cB = nB; ++ui;
        if constexpr (ALIGN_EPI) { if (wr == 1) PG8_BAR; }
    }
    PG8_WAIT_V(0);
    if constexpr (!ALIGN_EPI) { if (wr == 0) PG8_BAR; }
    PG8_BAR;
#undef PG8_SA
#undef PG8_SB
#undef PG8_STAGE
#undef PG8_LDA
#undef PG8_LDB
#undef PG8_MMA
#undef PG8_WAIT_V
#undef PG8_WAIT_L
#undef PG8_BAR
#undef PG8_SCHED
}
}

__device__ __forceinline__ void transpose_item(const float* W, int K, int N, bf16* WT, LAS float* scr, int item, int lane) {
    const int nblk = N / 32, kb = item / nblk, nb = item % nblk, k0 = 64 * kb, n0 = 32 * nb;
#pragma unroll 8
    for (int i = 0; i < 32; ++i) { const int kk = 2 * i + (lane >> 5); scr[kk * 33 + (lane & 31)] = W[(size_t)(k0 + kk) * N + n0 + (lane & 31)]; }
    asm volatile("s_waitcnt lgkmcnt(0)" ::: "memory");
    const int c = lane & 7;
#pragma unroll
    for (int j = 0; j < 4; ++j) { const int n = (lane >> 3) + 8 * j; const LAS float* s = scr + (8 * c) * 33 + n;
        uint4 o; o.x = pk2(s[0 * 33], s[1 * 33]); o.y = pk2(s[2 * 33], s[3 * 33]); o.z = pk2(s[4 * 33], s[5 * 33]); o.w = pk2(s[6 * 33], s[7 * 33]);
        *(uint4*)(WT + (size_t)(n0 + n) * K + k0 + 8 * c) = o; }
    asm volatile("s_waitcnt lgkmcnt(0)" ::: "memory");
}

__device__ __forceinline__ float wsum(float v) {
#pragma unroll
  for (int o = 32; o > 0; o >>= 1) v += __shfl_xor(v, o, 64);
  return v;
}
__device__ __forceinline__ float wmaxf(float v) {
#pragma unroll
  for (int o = 32; o > 0; o >>= 1) v = fmaxf(v, __shfl_xor(v, o, 64));
  return v;
}
__device__ __forceinline__ float sigmoidf_(float x) { return 1.0f / (1.0f + expf(-x)); }
__device__ __forceinline__ float gelu_tanh(float x) {
  return 0.5f * x * (1.0f + tanhf(0.7978845608028654f * (x + 0.044715f * x * x * x)));
}

template <bool BF16OUT>
__device__ __forceinline__ void rms_rows(const int wave_s, const float* src, const float* g, void* dstv, int rows) {
  const int tid_ = opaque_tid(wave_s);
  const int lane = tid_ & 63;
  const int gw = blockIdx.x * NWAVES + (tid_ >> 6);
  const int nw = gridDim.x * NWAVES;
  for (int r = gw; r < rows; r += nw) {
    const float4* s4 = (const float4*)(src + (size_t)r * DM);
    float4 v[4];
    float ss = 0.f;
#pragma unroll
    for (int i = 0; i < 4; i++) {
      v[i] = s4[lane + i * 64];
      ss += v[i].x * v[i].x + v[i].y * v[i].y + v[i].z * v[i].z + v[i].w * v[i].w;
    }
    ss = wsum(ss);
    const float rstd = rsqrtf(ss * (1.0f / DM) + EPSF);
    const float4* g4 = (const float4*)g;
#pragma unroll
    for (int i = 0; i < 4; i++) {
      float4 gg = g4[lane + i * 64];
      float4 o;
      o.x = v[i].x * rstd * gg.x; o.y = v[i].y * rstd * gg.y;
      o.z = v[i].z * rstd * gg.z; o.w = v[i].w * rstd * gg.w;
      if (BF16OUT) {
        uint2 pk; pk.x = pk2(o.x, o.y); pk.y = pk2(o.z, o.w);
        ((uint2*)((bf16*)dstv + (size_t)r * DM))[lane + i * 64] = pk;
      } else {
        ((float4*)((float*)dstv + (size_t)r * DM))[lane + i * 64] = o;
      }
    }
  }
}

__device__ __forceinline__ void ssm_params(const int wave_s, const Params& p, float* ssmp_all) {
  const int tid_ = opaque_tid(wave_s);
  const float* in8 = karg_in(8); const float* in9 = karg_in(9); const float* in10 = karg_in(10);
  const float* in11 = karg_in(11); const float* in12 = karg_in(12);
  const int gt = blockIdx.x * blockDim.x + tid_;
  const int nth = gridDim.x * blockDim.x;
  for (int i = gt; i < 2 * 16 * 64; i += nth) {
    const int l = i / 1024, gp = i % 1024, g = gp / 64;
    float* sp = ssmp_all + (size_t)l * SSMP_PER_LAYER;
    const float lre = fminf(in8[l * 1024 + gp], -1e-4f);
    const float lim = in9[l * 1024 + gp];
    const float dt = expf(in10[l * 16 + g]);
    const float er = expf(lre * dt);
    float sn, cs;
    sincosf(lim * dt, &sn, &cs);
    const float br = er * cs, bi = er * sn;
    sp[gp * 2 + 0] = br;
    sp[gp * 2 + 1] = bi;
    float cr = br, ci = bi;
#pragma unroll
    for (int s = 0; s < 6; s++) {
      const float nr = cr * cr - ci * ci, ni = 2.f * cr * ci;
      cr = nr; ci = ni;
    }
    sp[2048 + gp * 2 + 0] = cr;
    sp[2048 + gp * 2 + 1] = ci;
    const float nr = br - 1.0f, ni = bi;
    const float den = lre * lre + lim * lim;
    const float fr = (nr * lre + ni * lim) / den;
    const float fi = (ni * lre - nr * lim) / den;
    for (int h = 0; h < 16; h++) {
      const float bre = in11[((size_t)l * 1024 + gp) * 16 + h];
      const float bim = in12[((size_t)l * 1024 + gp) * 16 + h];
      sp[4096 + ((g * 16 + h) * 64 + (gp & 63)) * 2 + 0] = fr * bre - fi * bim;
      sp[4096 + ((g * 16 + h) * 64 + (gp & 63)) * 2 + 1] = fr * bim + fi * bre;
    }
  }
}

__device__ __forceinline__ void conv_phase(const int wave_s, const Params& p, int l, const bf16* proj, bf16* y, LAS float* smem) {
  const int tid_ = opaque_tid(wave_s);
  const int lane = tid_ & 63;
  const int gw = blockIdx.x * NWAVES + (tid_ >> 6);
  const int nw = gridDim.x * NWAVES;
  const float* cw = karg_in(4) + (size_t)l * 31 * 256;
  const float4 cb = ((const float4*)(karg_in(5) + l * 256))[lane];
  const float4 lg = ((const float4*)(karg_in(6) + l * 256))[lane];
  const float4 lb = ((const float4*)(karg_in(7) + l * 256))[lane];
  const float4 gg = ((const float4*)(karg_in(18) + l * 1024))[lane];
  LAS float* cwl = smem + 1024;
  for (int i = tid_; i < 31 * 256 / 4; i += NWAVES * 64) *(LAS pg8::f32x4*)(cwl + 4 * i) = *(const pg8::f32x4*)(cw + 4 * i);
  __syncthreads();
  for (int it = gw; it < NT / 8; it += nw) {
    const int tok0 = it * 8;
    const int t0 = tok0 & (SEQ - 1);
    float4 acc[8];
#pragma unroll
    for (int o = 0; o < 8; o++) acc[o] = cb;
#pragma unroll
    for (int i = 0; i < 38; i++) {
      if (t0 - 30 + i >= 0) {
        const bf16* row = proj + (size_t)(tok0 - 30 + i) * DIN;
        const uint2 vp = ((const uint2*)row)[lane];
        const uint2 gp = ((const uint2*)(row + 256))[lane];
        float4 g4;
        g4.x = bf_lo(vp.x) * sigmoidf_(bf_lo(gp.x)); g4.y = bf_hi(vp.x) * sigmoidf_(bf_hi(gp.x));
        g4.z = bf_lo(vp.y) * sigmoidf_(bf_lo(gp.y)); g4.w = bf_hi(vp.y) * sigmoidf_(bf_hi(gp.y));
#pragma unroll
        for (int o = 0; o < 8; o++) {
          const int j = i - o;
          if (j >= 0 && j <= 30) {
            const pg8::f32x4 w4 = *(const LAS pg8::f32x4*)(cwl + j * 256 + lane * 4);
            acc[o].x += g4.x * w4[0]; acc[o].y += g4.y * w4[1];
            acc[o].z += g4.z * w4[2]; acc[o].w += g4.w * w4[3];
          }
        }
      }
    }
#pragma unroll
    for (int o = 0; o < 8; o++) {
      const float4 a = acc[o];
      const float mean = wsum(a.x + a.y + a.z + a.w) * (1.0f / 256.f);
      const float dx = a.x - mean, dy = a.y - mean, dz = a.z - mean, dw = a.w - mean;
      const float var = wsum(dx * dx + dy * dy + dz * dz + dw * dw) * (1.0f / 256.f);
      const float rs = rsqrtf(var + EPSF);
      float4 s;
      s.x = dx * rs * lg.x + lb.x; s.y = dy * rs * lg.y + lb.y;
      s.z = dz * rs * lg.z + lb.z; s.w = dw * rs * lg.w + lb.w;
      s.x = s.x * sigmoidf_(s.x); s.y = s.y * sigmoidf_(s.y);
      s.z = s.z * sigmoidf_(s.z); s.w = s.w * sigmoidf_(s.w);
      const float ss = wsum(s.x * s.x + s.y * s.y + s.z * s.z + s.w * s.w) * (1.0f / 256.f);
      const float r2 = rsqrtf(ss + EPSF);
      uint2 pk; pk.x = pk2(s.x * r2 * gg.x, s.y * r2 * gg.y); pk.y = pk2(s.z * r2 * gg.z, s.w * r2 * gg.w);
      ((uint2*)(y + (size_t)(tok0 + o) * DM))[lane] = pk;
    }
  }
}

typedef short bf16x8_t __attribute__((ext_vector_type(8)));
typedef float f32x16_t __attribute__((ext_vector_type(16)));
#define MFMA_PAD() do { __builtin_amdgcn_sched_barrier(0); asm volatile("s_nop 15\n\ts_nop 15" ::: "memory"); __builtin_amdgcn_sched_barrier(0); } while (0)

__device__ __forceinline__ void attn_phase(const int wave_s, const Params& p, int l, const bf16* proj, bf16* y, LAS float* smem) {
  const int tid = opaque_tid(wave_s), lane = tid & 63, wave = tid >> 6;
  const int n = lane & 31, hh = lane >> 5;
  const float* gg = karg_in(18) + l * 1024 + 256 + wave * 64;
  const float g0 = gg[n], g1 = gg[32 + n];
  LAS float* ssq = smem;
  LAS float* rstd = smem + 256;
  for (int item = blockIdx.x; item < 4 * 128; item += gridDim.x) {
    const int b = item >> 7, q0 = (item & 127) * 32;
    const size_t tokb = (size_t)b * SEQ;
    bf16x8_t qf[4];
    {
      const bf16* qrow = proj + (tokb + q0 + n) * DIN + 512 + wave * 64 + 8 * hh;
#pragma unroll
      for (int ks = 0; ks < 4; ks++) qf[ks] = *(const bf16x8_t*)(qrow + 16 * ks);
    }
    f32x16_t o0, o1;
#pragma unroll
    for (int r = 0; r < 16; r++) { o0[r] = 0.f; o1[r] = 0.f; }
    float R = 0.f;
    for (int kt = q0; kt >= 0; kt -= 32) {
      bf16x8_t kf[4];
      {
        const bf16* krow = proj + (tokb + kt + n) * DIN + 1024 + wave * 64 + 8 * hh;
#pragma unroll
        for (int ks = 0; ks < 4; ks++) kf[ks] = *(const bf16x8_t*)(krow + 16 * ks);
      }
      bf16x8_t vf0[2], vf1[2];
      {
        const bf16* vb = proj + (tokb + kt + 4 * hh) * DIN + 1536 + wave * 64 + n;
#pragma unroll
        for (int s = 0; s < 2; s++)
#pragma unroll
          for (int j = 0; j < 8; j++) {
            const int key = 16 * s + 8 * (j >> 2) + (j & 3);
            vf0[s][j] = (short)vb[(size_t)key * DIN];
            vf1[s][j] = (short)vb[(size_t)key * DIN + 32];
          }
      }
      f32x16_t sacc;
#pragma unroll
      for (int r = 0; r < 16; r++) sacc[r] = 0.f;
      __builtin_amdgcn_sched_barrier(0); asm volatile("s_nop 15\n\ts_nop 15" ::: "memory"); __builtin_amdgcn_sched_barrier(0);
#pragma unroll
      for (int ks = 0; ks < 4; ks++) sacc = __builtin_amdgcn_mfma_f32_32x32x16_bf16(kf[ks], qf[ks], sacc, 0, 0, 0);
      __builtin_amdgcn_sched_barrier(0); asm volatile("s_nop 15\n\ts_nop 15" ::: "memory"); __builtin_amdgcn_sched_barrier(0);
      float lst[16], lsz[16];
      const bool diag = (kt == q0);
#pragma unroll
      for (int r = 0; r < 16; r++) {
        const float z = sacc[r] * 0.125f;
        const float sp = __logf(1.0f + __expf(-fabsf(z)));
        float a = fminf(z, 0.f) - sp;
        float c = -(fmaxf(z, 0.f) + sp);
        if (diag) {
          const int key = (r & 3) + 8 * (r >> 2) + 4 * hh;
          if (key >= n) { a = -1.0e30f; c = 0.f; }
        }
        lsz[r] = a; lst[r] = c;
      }
      float Gs[4], Gp[4];
#pragma unroll
      for (int g = 0; g < 4; g++) {
        Gs[g] = (lst[4 * g] + lst[4 * g + 1]) + (lst[4 * g + 2] + lst[4 * g + 3]);
        Gp[g] = __shfl_xor(Gs[g], 32, 64);
      }
      float carry[4];
      {
        float after = R;
#pragma unroll
        for (int g = 3; g >= 0; g--) {
          carry[g] = after + (hh ? 0.f : Gp[g]);
          after += Gs[g] + Gp[g];
        }
        R = after;
      }
      bf16x8_t pf[2];
#pragma unroll
      for (int g = 0; g < 4; g++) {
        float run = carry[g];
        float a3 = __expf(lsz[4 * g + 3] + run); run += lst[4 * g + 3];
        float a2 = __expf(lsz[4 * g + 2] + run); run += lst[4 * g + 2];
        float a1 = __expf(lsz[4 * g + 1] + run); run += lst[4 * g + 1];
        float a0 = __expf(lsz[4 * g + 0] + run);
        const int s = g >> 1, jb = (g & 1) * 4;
        pf[s][jb + 0] = (short)f2bf(a0); pf[s][jb + 1] = (short)f2bf(a1);
        pf[s][jb + 2] = (short)f2bf(a2); pf[s][jb + 3] = (short)f2bf(a3);
      }
      __builtin_amdgcn_sched_barrier(0); asm volatile("s_nop 15\n\ts_nop 15" ::: "memory"); __builtin_amdgcn_sched_barrier(0);
#pragma unroll
      for (int s = 0; s < 2; s++) {
        o0 = __builtin_amdgcn_mfma_f32_32x32x16_bf16(pf[s], vf0[s], o0, 0, 0, 0);
        o1 = __builtin_amdgcn_mfma_f32_32x32x16_bf16(pf[s], vf1[s], o1, 0, 0, 0);
      }
      __builtin_amdgcn_sched_barrier(0); asm volatile("s_nop 15\n\ts_nop 15" ::: "memory"); __builtin_amdgcn_sched_barrier(0);
      if (__all(R < -110.f)) break;
    }
    float sq[16];
#pragma unroll
    for (int r = 0; r < 16; r++) {
      float v = o0[r] * o0[r] + o1[r] * o1[r];
#pragma unroll
      for (int o = 16; o > 0; o >>= 1) v += __shfl_xor(v, o, 64);
      sq[r] = v;
    }
    __syncthreads();
    if (n == 0) {
#pragma unroll
      for (int r = 0; r < 16; r++) ssq[wave * 32 + (r & 3) + 8 * (r >> 2) + 4 * hh] = sq[r];
    }
    __syncthreads();
    if (tid < 32) {
      float t = 0.f;
#pragma unroll
      for (int w = 0; w < 8; w++) t += ssq[w * 32 + tid];
      rstd[tid] = rsqrtf(t * (1.0f / 512.f) + EPSF);
    }
    __syncthreads();
#pragma unroll
    for (int r = 0; r < 16; r++) {
      const int qi = (r & 3) + 8 * (r >> 2) + 4 * hh;
      const float rs = rstd[qi];
      bf16* yr = y + (tokb + q0 + qi) * DM + 256 + wave * 64 + n;
      yr[0] = (bf16)f2bf(o0[r] * rs * g0);
      yr[32] = (bf16)f2bf(o1[r] * rs * g1);
    }
  }
}

#define SSM_BCAST_U(u, ua, ub, tt) do { \
    const unsigned w0 = (unsigned)__builtin_amdgcn_readlane((int)(ua).x, (tt)), w1 = (unsigned)__builtin_amdgcn_readlane((int)(ua).y, (tt)); \
    const unsigned w2 = (unsigned)__builtin_amdgcn_readlane((int)(ua).z, (tt)), w3 = (unsigned)__builtin_amdgcn_readlane((int)(ua).w, (tt)); \
    const unsigned w4 = (unsigned)__builtin_amdgcn_readlane((int)(ub).x, (tt)), w5 = (unsigned)__builtin_amdgcn_readlane((int)(ub).y, (tt)); \
    const unsigned w6 = (unsigned)__builtin_amdgcn_readlane((int)(ub).z, (tt)), w7 = (unsigned)__builtin_amdgcn_readlane((int)(ub).w, (tt)); \
    (u)[0] = bf_lo(w0); (u)[1] = bf_hi(w0); (u)[2] = bf_lo(w1); (u)[3] = bf_hi(w1); (u)[4] = bf_lo(w2); (u)[5] = bf_hi(w2); (u)[6] = bf_lo(w3); (u)[7] = bf_hi(w3); \
    (u)[8] = bf_lo(w4); (u)[9] = bf_hi(w4); (u)[10] = bf_lo(w5); (u)[11] = bf_hi(w5); (u)[12] = bf_lo(w6); (u)[13] = bf_hi(w6); (u)[14] = bf_lo(w7); (u)[15] = bf_hi(w7); } while (0)
__device__ __forceinline__ void ssm_chunk_end(const int wave_s, const float* ssmp, const bf16* proj, float* ssmE) {
  const int tid_ = opaque_tid(wave_s);
  const int lane = tid_ & 63;
  const int gw = blockIdx.x * NWAVES + (tid_ >> 6);
  const int nw = gridDim.x * NWAVES;
  for (int it = gw; it < 4 * 64 * 16; it += nw) {
    const int g = it & 15, c = (it >> 4) & 63, b = it >> 10;
    const int gp = g * 64 + lane;
    const uint4* up = (const uint4*)(proj + (size_t)(b * SEQ + c * 64 + lane) * DIN + 2048 + g * 16);
    const uint4 ua = up[0], ub = up[1];
    const float lbr = ssmp[gp * 2], lbi = ssmp[gp * 2 + 1];
    float bbr[16], bbi[16];
#pragma unroll
    for (int h = 0; h < 16; h++) {
      { const float2 bb = *(const float2*)(ssmp + 4096 + ((g * 16 + h) * 64 + lane) * 2); bbr[h] = bb.x; bbi[h] = bb.y; }
    }
    float xr = 0.f, xi = 0.f;
#pragma unroll 2
    for (int tt = 0; tt < 64; tt++) {
      float u[16];
      SSM_BCAST_U(u, ua, ub, tt);
      float br = 0.f, bi = 0.f;
#pragma unroll
      for (int h = 0; h < 16; h++) { br += bbr[h] * u[h]; bi += bbi[h] * u[h]; }
      const float nr = lbr * xr - lbi * xi + br;
      const float ni = lbr * xi + lbi * xr + bi;
      xr = nr; xi = ni;
    }
    float* e = ssmE + ((size_t)((b * 64 + c) * 16 + g) * 64 + lane) * 2;
    e[0] = xr; e[1] = xi;
  }
}

__device__ __forceinline__ void ssm_finish(const int wave_s, const Params& p, int l, const float* ssmp, const bf16* proj,
                           const float* ssmE, bf16* y, LAS float* smem) {
  LAS bf16* Ytb = (LAS bf16*)smem;
  LAS float* ssq2 = smem + (64 * 264 * 2) / 4;
  LAS float* rstd2 = ssq2 + 512;
  const bf16* glT = (const bf16*)(p.ws + WS_WT + (size_t)l * WT_LAYER + WT_GLU);
  const int tid = opaque_tid(wave_s), lane = tid & 63, wave = tid >> 6;
  const float* cre = karg_in(13) + (size_t)l * 16 * 16 * 64;
  const float* cim = karg_in(14) + (size_t)l * 16 * 16 * 64;
  const float* dsk = karg_in(15) + l * 256;
  const float* glw = karg_in(16) + (size_t)l * 256 * 256;
  const float* glb = karg_in(17) + l * 256;
  const float* gg = karg_in(18) + l * 1024 + 768;
  for (int it = blockIdx.x; it < 256; it += gridDim.x) {
    const int b = it >> 6, c = it & 63;
    __syncthreads();
    for (int gi = 0; gi < 2; gi++) {
      const int g = wave + gi * 8;
      const int gp = g * 64 + lane;
      const float lbr = ssmp[gp * 2], lbi = ssmp[gp * 2 + 1];
      const float lcr = ssmp[2048 + gp * 2], lci = ssmp[2048 + gp * 2 + 1];
      float bbr[16], bbi[16], ccr[16], cci[16];
#pragma unroll
      for (int h = 0; h < 16; h++) {
        { const float2 bb = *(const float2*)(ssmp + 4096 + ((g * 16 + h) * 64 + lane) * 2); bbr[h] = bb.x; bbi[h] = bb.y; }
        ccr[h] = cre[(g * 16 + h) * 64 + lane];
        cci[h] = cim[(g * 16 + h) * 64 + lane];
      }
      float xr = 0.f, xi = 0.f;
      {
        const float2* eb = (const float2*)ssmE + ((size_t)(b * 64) * 16 + g) * 64 + lane;
        int cc = 0;
        for (; cc + 8 <= c; cc += 8) {
          float2 ev[8];
#pragma unroll
          for (int k = 0; k < 8; k++) ev[k] = eb[(size_t)(cc + k) * 16 * 64];
#pragma unroll
          for (int k = 0; k < 8; k++) {
            const float nr = lcr * xr - lci * xi + ev[k].x;
            const float ni = lcr * xi + lci * xr + ev[k].y;
            xr = nr; xi = ni;
          }
        }
        for (; cc < c; cc++) {
          const float2 e1 = eb[(size_t)cc * 16 * 64];
          const float nr = lcr * xr - lci * xi + e1.x;
          const float ni = lcr * xi + lci * xr + e1.y;
          xr = nr; xi = ni;
        }
      }
      const int hq = ((lane >> 5) & 1) * 8 + ((lane >> 4) & 1) * 4 + ((lane >> 3) & 1) * 2 + ((lane >> 2) & 1);
      float dm[16];
#pragma unroll
      for (int h = 0; h < 16; h++) dm[h] = (lane == 0) ? dsk[g * 16 + h] : 0.f;
      const uint4* up = (const uint4*)(proj + (size_t)(b * SEQ + c * 64 + lane) * DIN + 2048 + g * 16);
      const uint4 ua = up[0], ub = up[1];
#pragma unroll 1
      for (int t4 = 0; t4 < 64; t4 += 4) {
        float vv[4][16];
#pragma unroll
        for (int s = 0; s < 4; s++) {
          float u[16];
          SSM_BCAST_U(u, ua, ub, t4 + s);
          float br = 0.f, bi = 0.f;
#pragma unroll
          for (int h = 0; h < 16; h++) { br += bbr[h] * u[h]; bi += bbi[h] * u[h]; }
          const float nr = lbr * xr - lbi * xi + br;
          const float ni = lbr * xi + lbi * xr + bi;
          xr = nr; xi = ni;
#pragma unroll
          for (int h = 0; h < 16; h++) vv[s][h] = xr * ccr[h] - xi * cci[h] + dm[h] * u[h];
        }
        float v1[4];
#pragma unroll
        for (int s = 0; s < 4; s++) {
          float v8[8], v4[4], v2[2];
          {
            const bool hi = (lane & 32) != 0;
#pragma unroll
            for (int i = 0; i < 8; i++) { const float send = hi ? vv[s][i] : vv[s][i + 8]; const float keep = hi ? vv[s][i + 8] : vv[s][i]; v8[i] = keep + __shfl_xor(send, 32, 64); }
          }
          {
            const bool hi = (lane & 16) != 0;
#pragma unroll
            for (int i = 0; i < 4; i++) { const float send = hi ? v8[i] : v8[i + 4]; const float keep = hi ? v8[i + 4] : v8[i]; v4[i] = keep + __shfl_xor(send, 16, 64); }
          }
          {
            const bool hi = (lane & 8) != 0;
#pragma unroll
            for (int i = 0; i < 2; i++) { const float send = hi ? v4[i] : v4[i + 2]; const float keep = hi ? v4[i + 2] : v4[i]; v2[i] = keep + __shfl_xor(send, 8, 64); }
          }
          {
            const bool hi = (lane & 4) != 0;
            const float send = hi ? v2[0] : v2[1];
            const float keep = hi ? v2[1] : v2[0];
            v1[s] = keep + __shfl_xor(send, 4, 64);
          }
          v1[s] += __shfl_xor(v1[s], 2, 64);
          v1[s] += __shfl_xor(v1[s], 1, 64);
        }
        if ((lane & 3) == 0) {
#pragma unroll
          for (int s = 0; s < 4; s++) Ytb[(t4 + s) * 264 + g * 16 + hq] = (bf16)f2bf(gelu_tanh(v1[s]));
        }
      }
    }
    __syncthreads();
    {
      const int n = lane & 31, hh = lane >> 5;
      const int ch = wave * 32 + n;
      const float bj = glb[ch];
      const float gj = gg[ch];
      bf16x8_t gf[16];
      {
        const bf16* grow = glT + (size_t)ch * 256 + 8 * hh;
#pragma unroll
        for (int ks = 0; ks < 16; ks++) gf[ks] = *(const bf16x8_t*)(grow + 16 * ks);
      }
      float oo[2][16];
#pragma unroll
      for (int mt = 0; mt < 2; mt++) {
        f32x16_t z;
#pragma unroll
        for (int r = 0; r < 16; r++) z[r] = 0.f;
        const LAS bf16* yrow = Ytb + (mt * 32 + n) * 264 + 8 * hh;
#pragma unroll
        for (int kq = 0; kq < 4; kq++) {
          bf16x8_t yf[4];
#pragma unroll
          for (int i = 0; i < 4; i++) yf[i] = *(const LAS bf16x8_t*)(yrow + 16 * (kq * 4 + i));
          MFMA_PAD();
#pragma unroll
          for (int i = 0; i < 4; i++) z = __builtin_amdgcn_mfma_f32_32x32x16_bf16(yf[i], gf[kq * 4 + i], z, 0, 0, 0);
          MFMA_PAD();
        }
        float sq[16];
#pragma unroll
        for (int r = 0; r < 16; r++) {
          const int t = mt * 32 + (r & 3) + 8 * (r >> 2) + 4 * hh;
          const float yv = bf2f(Ytb[t * 264 + ch]);
          const float o = yv * sigmoidf_(z[r] + bj);
          oo[mt][r] = o;
          float v = o * o;
#pragma unroll
          for (int s = 16; s > 0; s >>= 1) v += __shfl_xor(v, s, 64);
          sq[r] = v;
        }
        if (n == 0) {
#pragma unroll
          for (int r = 0; r < 16; r++) ssq2[wave * 64 + mt * 32 + (r & 3) + 8 * (r >> 2) + 4 * hh] = sq[r];
        }
      }
      __syncthreads();
      if (tid < 64) {
        float t = 0.f;
#pragma unroll
        for (int w = 0; w < 8; w++) t += ssq2[w * 64 + tid];
        rstd2[tid] = rsqrtf(t * (1.0f / 256.f) + EPSF);
      }
      __syncthreads();
#pragma unroll
      for (int mt = 0; mt < 2; mt++)
#pragma unroll
        for (int r = 0; r < 16; r++) {
          const int t = mt * 32 + (r & 3) + 8 * (r >> 2) + 4 * hh;
          y[(size_t)(b * SEQ + c * 64 + t) * DM + 768 + ch] = (bf16)f2bf(oo[mt][r] * rstd2[t] * gj);
        }
    }
  }
}

__device__ __forceinline__ void memattn_phase(const int wave_s, const bf16* q, const bf16* kvb, const bf16* vT, bf16* o, LAS float* smem) {
  const int tid_ = opaque_tid(wave_s);
  const int lane = tid_ & 63, n = lane & 31, hh = lane >> 5, wave = tid_ >> 6;
  const int sig = (n & 0x13) | ((n & 4) << 1) | ((n & 8) >> 1);
  LAS bf16* Ls = (LAS bf16*)smem;
  for (int it = blockIdx.x; it < 64 * 4; it += gridDim.x) {
    const int h = it & 3, tg = it >> 2, b = tg >> 4;
    const int tok0 = (tg * 8 + wave) * 32;
    __syncthreads();
    {
      const int r = tid_ >> 1, hf = tid_ & 1;
      const pg8::u32x4* src4 = (const pg8::u32x4*)(kvb + (size_t)(b * NMEM + r) * 2048 + h * 256 + hf * 128);
      LAS pg8::u32x4* dst4 = (LAS pg8::u32x4*)(Ls + r * 264 + hf * 128);
#pragma unroll
      for (int k = 0; k < 16; k++) dst4[k] = src4[k];
    }
    f32x16_t st[8];
#pragma unroll
    for (int kt = 0; kt < 8; kt++)
#pragma unroll
      for (int r = 0; r < 16; r++) st[kt][r] = 0.f;
    const bf16* qrow = q + (size_t)(tok0 + n) * DM + h * 256 + 8 * hh;
    __syncthreads();
#pragma unroll
    for (int kq = 0; kq < 4; kq++) {
      bf16x8_t qf[4];
#pragma unroll
      for (int i = 0; i < 4; i++) qf[i] = *(const bf16x8_t*)(qrow + 16 * (kq * 4 + i));
#pragma unroll
      for (int kt = 0; kt < 8; kt++) {
        const LAS bf16* krow = Ls + (kt * 32 + sig) * 264 + 8 * hh;
        bf16x8_t kf[4];
#pragma unroll
        for (int i = 0; i < 4; i++) kf[i] = *(const LAS bf16x8_t*)(krow + 16 * (kq * 4 + i));
        MFMA_PAD();
#pragma unroll
        for (int i = 0; i < 4; i++) st[kt] = __builtin_amdgcn_mfma_f32_32x32x16_bf16(kf[i], qf[i], st[kt], 0, 0, 0);
        MFMA_PAD();
      }
    }
    float mx = st[0][0];
#pragma unroll
    for (int kt = 0; kt < 8; kt++)
#pragma unroll
      for (int r = 0; r < 16; r++) mx = fmaxf(mx, st[kt][r]);
    mx = fmaxf(mx, __shfl_xor(mx, 32, 64));
    float sum = 0.f;
#pragma unroll
    for (int kt = 0; kt < 8; kt++)
#pragma unroll
      for (int r = 0; r < 16; r++) { const float e = __expf((st[kt][r] - mx) * 0.0625f); st[kt][r] = e; sum += e; }
    sum += __shfl_xor(sum, 32, 64);
    const float inv = 1.0f / sum;
    bf16x8_t pf[8][2];
#pragma unroll
    for (int kt = 0; kt < 8; kt++)
#pragma unroll
      for (int s = 0; s < 2; s++)
#pragma unroll
        for (int j = 0; j < 8; j++) pf[kt][s][j] = (short)f2bf(st[kt][8 * s + j] * inv);
    __syncthreads();
    {
      const int r = tid_ >> 1, hf = tid_ & 1;
      const pg8::u32x4* src4 = (const pg8::u32x4*)(vT + ((size_t)(b * 4 + h) * 256 + r) * 256 + hf * 128);
      LAS pg8::u32x4* dst4 = (LAS pg8::u32x4*)(Ls + r * 264 + hf * 128);
#pragma unroll
      for (int k = 0; k < 16; k++) dst4[k] = src4[k];
    }
    __syncthreads();
#pragma unroll 1
    for (int dt = 0; dt < 8; dt++) {
      f32x16_t oacc;
#pragma unroll
      for (int r = 0; r < 16; r++) oacc[r] = 0.f;
      const LAS bf16* vrow = Ls + (dt * 32 + n) * 264 + 8 * hh;
#pragma unroll
      for (int kq = 0; kq < 4; kq++) {
        bf16x8_t vf[4];
#pragma unroll
        for (int i = 0; i < 4; i++) vf[i] = *(const LAS bf16x8_t*)(vrow + (kq * 2 + (i >> 1)) * 32 + 16 * (i & 1));
        MFMA_PAD();
#pragma unroll
        for (int i = 0; i < 4; i++) oacc = __builtin_amdgcn_mfma_f32_32x32x16_bf16(pf[kq * 2 + (i >> 1)][i & 1], vf[i], oacc, 0, 0, 0);
        MFMA_PAD();
      }
#pragma unroll
      for (int r = 0; r < 16; r++) {
        const int qi = (r & 3) + 8 * (r >> 2) + 4 * hh;
        o[(size_t)(tok0 + qi) * DM + h * 256 + dt * 32 + n] = (bf16)f2bf(oacc[r]);
      }
    }
  }
}

__device__ __forceinline__ void vt_phase(const int wave_s, const bf16* kvb, bf16* vT) {
  const int tid_ = opaque_tid(wave_s);
  const int gt = blockIdx.x * (NWAVES * 64) + tid_;
  const int nth = gridDim.x * NWAVES * 64;
  for (int i = gt; i < 2 * 4 * 4 * 256 * 256; i += nth) {
    const int m = i & 255, d = (i >> 8) & 255, h = (i >> 16) & 3, b = (i >> 18) & 3, l = i >> 20;
    vT[i] = kvb[((size_t)l * 1024 + b * 256 + m) * 2048 + 1024 + h * 256 + d];
  }
}

template <unsigned MASK>
__device__ __forceinline__ float pack_key(float s, unsigned idx) {
  const unsigned u = __builtin_bit_cast(unsigned, s);
  const unsigned tag = ((int)u < 0) ? idx : (MASK - idx);
  return __builtin_bit_cast(float, (u & ~MASK) + tag);
}
template <unsigned MASK>
__device__ __forceinline__ unsigned key_idx(float k) {
  const unsigned u = __builtin_bit_cast(unsigned, k);
  const unsigned tag = u & MASK;
  return ((int)u < 0) ? tag : (MASK - tag);
}
template <unsigned MASK>
__device__ __forceinline__ float key_val(float k) { return __builtin_bit_cast(float, __builtin_bit_cast(unsigned, k) & ~MASK); }
__device__ __forceinline__ void top16_of_64(float (&K)[64]) {
  { const float a_ = K[0], b_ = K[1]; const bool g_ = a_ > b_; K[0] = g_ ? a_ : b_; K[1] = g_ ? b_ : a_; }
  { const float a_ = K[2], b_ = K[3]; const bool g_ = a_ > b_; K[2] = g_ ? b_ : a_; K[3] = g_ ? a_ : b_; }
  { const float a_ = K[4], b_ = K[5]; const bool g_ = a_ > b_; K[4] = g_ ? a_ : b_; K[5] = g_ ? b_ : a_; }
  { const float a_ = K[6], b_ = K[7]; const bool g_ = a_ > b_; K[6] = g_ ? b_ : a_; K[7] = g_ ? a_ : b_; }
  { const float a_ = K[8], b_ = K[9]; const bool g_ = a_ > b_; K[8] = g_ ? a_ : b_; K[9] = g_ ? b_ : a_; }
  { const float a_ = K[10], b_ = K[11]; const bool g_ = a_ > b_; K[10] = g_ ? b_ : a_; K[11] = g_ ? a_ : b_; }
  { const float a_ = K[12], b_ = K[13]; const bool g_ = a_ > b_; K[12] = g_ ? a_ : b_; K[13] = g_ ? b_ : a_; }
  { const float a_ = K[14], b_ = K[15]; const bool g_ = a_ > b_; K[14] = g_ ? b_ : a_; K[15] = g_ ? a_ : b_; }
  { const float a_ = K[0], b_ = K[2]; const bool g_ = a_ > b_; K[0] = g_ ? a_ : b_; K[2] = g_ ? b_ : a_; }
  { const float a_ = K[1], b_ = K[3]; const bool g_ = a_ > b_; K[1] = g_ ? a_ : b_; K[3] = g_ ? b_ : a_; }
  { const float a_ = K[4], b_ = K[6]; const bool g_ = a_ > b_; K[4] = g_ ? b_ : a_; K[6] = g_ ? a_ : b_; }
  { const float a_ = K[5], b_ = K[7]; const bool g_ = a_ > b_; K[5] = g_ ? b_ : a_; K[7] = g_ ? a_ : b_; }
  { const float a_ = K[8], b_ = K[10]; const bool g_ = a_ > b_; K[8] = g_ ? a_ : b_; K[10] = g_ ? b_ : a_; }
  { const float a_ = K[9], b_ = K[11]; const bool g_ = a_ > b_; K[9] = g_ ? a_ : b_; K[11] = g_ ? b_ : a_; }
  { const float a_ = K[12], b_ = K[14]; const bool g_ = a_ > b_; K[12] = g_ ? b_ : a_; K[14] = g_ ? a_ : b_; }
  { const float a_ = K[13], b_ = K[15]; const bool g_ = a_ > b_; K[13] = g_ ? b_ : a_; K[15] = g_ ? a_ : b_; }
  { const float a_ = K[0], b_ = K[1]; const bool g_ = a_ > b_; K[0] = g_ ? a_ : b_; K[1] = g_ ? b_ : a_; }
  { const float a_ = K[2], b_ = K[3]; const bool g_ = a_ > b_; K[2] = g_ ? a_ : b_; K[3] = g_ ? b_ : a_; }
  { const float a_ = K[4], b_ = K[5]; const bool g_ = a_ > b_; K[4] = g_ ? b_ : a_; K[5] = g_ ? a_ : b_; }
  { const float a_ = K[6], b_ = K[7]; const bool g_ = a_ > b_; K[6] = g_ ? b_ : a_; K[7] = g_ ? a_ : b_; }
  { const float a_ = K[8], b_ = K[9]; const bool g_ = a_ > b_; K[8] = g_ ? a_ : b_; K[9] = g_ ? b_ : a_; }
  { const float a_ = K[10], b_ = K[11]; const bool g_ = a_ > b_; K[10] = g_ ? a_ : b_; K[11] = g_ ? b_ : a_; }
  { const float a_ = K[12], b_ = K[13]; const bool g_ = a_ > b_; K[12] = g_ ? b_ : a_; K[13] = g_ ? a_ : b_; }
  { const float a_ = K[14], b_ = K[15]; const bool g_ = a_ > b_; K[14] = g_ ? b_ : a_; K[15] = g_ ? a_ : b_; }
  { const float a_ = K[0], b_ = K[4]; const bool g_ = a_ > b_; K[0] = g_ ? a_ : b_; K[4] = g_ ? b_ : a_; }
  { const float a_ = K[1], b_ = K[5]; const bool g_ = a_ > b_; K[1] = g_ ? a_ : b_; K[5] = g_ ? b_ : a_; }
  { const float a_ = K[2], b_ = K[6]; const bool g_ = a_ > b_; K[2] = g_ ? a_ : b_; K[6] = g_ ? b_ : a_; }
  { const float a_ = K[3], b_ = K[7]; const bool g_ = a_ > b_; K[3] = g_ ? a_ : b_; K[7] = g_ ? b_ : a_; }
  { const float a_ = K[8], b_ = K[12]; const bool g_ = a_ > b_; K[8] = g_ ? b_ : a_; K[12] = g_ ? a_ : b_; }
  { const float a_ = K[9], b_ = K[13]; const bool g_ = a_ > b_; K[9] = g_ ? b_ : a_; K[13] = g_ ? a_ : b_; }
  { const float a_ = K[10], b_ = K[14]; const bool g_ = a_ > b_; K[10] = g_ ? b_ : a_; K[14] = g_ ? a_ : b_; }
  { const float a_ = K[11], b_ = K[15]; const bool g_ = a_ > b_; K[11] = g_ ? b_ : a_; K[15] = g_ ? a_ : b_; }
  { const float a_ = K[0], b_ = K[2]; const bool g_ = a_ > b_; K[0] = g_ ? a_ : b_; K[2] = g_ ? b_ : a_; }
  { const float a_ = K[1], b_ = K[3]; const bool g_ = a_ > b_; K[1] = g_ ? a_ : b_; K[3] = g_ ? b_ : a_; }
  { const float a_ = K[4], b_ = K[6]; const bool g_ = a_ > b_; K[4] = g_ ? a_ : b_; K[6] = g_ ? b_ : a_; }
  { const float a_ = K[5], b_ = K[7]; const bool g_ = a_ > b_; K[5] = g_ ? a_ : b_; K[7] = g_ ? b_ : a_; }
  { const float a_ = K[8], b_ = K[10]; const bool g_ = a_ > b_; K[8] = g_ ? b_ : a_; K[10] = g_ ? a_ : b_; }
  { const float a_ = K[9], b_ = K[11]; const bool g_ = a_ > b_; K[9] = g_ ? b_ : a_; K[11] = g_ ? a_ : b_; }
  { const float a_ = K[12], b_ = K[14]; const bool g_ = a_ > b_; K[12] = g_ ? b_ : a_; K[14] = g_ ? a_ : b_; }
  { const float a_ = K[13], b_ = K[15]; const bool g_ = a_ > b_; K[13] = g_ ? b_ : a_; K[15] = g_ ? a_ : b_; }
  { const float a_ = K[0], b_ = K[1]; const bool g_ = a_ > b_; K[0] = g_ ? a_ : b_; K[1] = g_ ? b_ : a_; }
  { const float a_ = K[2], b_ = K[3]; const bool g_ = a_ > b_; K[2] = g_ ? a_ : b_; K[3] = g_ ? b_ : a_; }
  { const float a_ = K[4], b_ = K[5]; const bool g_ = a_ > b_; K[4] = g_ ? a_ : b_; K[5] = g_ ? b_ : a_; }
  { const float a_ = K[6], b_ = K[7]; const bool g_ = a_ > b_; K[6] = g_ ? a_ : b_; K[7] = g_ ? b_ : a_; }
  { const float a_ = K[8], b_ = K[9]; const bool g_ = a_ > b_; K[8] = g_ ? b_ : a_; K[9] = g_ ? a_ : b_; }
  { const float a_ = K[10], b_ = K[11]; const bool g_ = a_ > b_; K[10] = g_ ? b_ : a_; K[11] = g_ ? a_ : b_; }
  { const float a_ = K[12], b_ = K[13]; const bool g_ = a_ > b_; K[12] = g_ ? b_ : a_; K[13] = g_ ? a_ : b_; }
  { const float a_ = K[14], b_ = K[15]; const bool g_ = a_ > b_; K[14] = g_ ? b_ : a_; K[15] = g_ ? a_ : b_; }
  { const float a_ = K[0], b_ = K[8]; const bool g_ = a_ > b_; K[0] = g_ ? a_ : b_; K[8] = g_ ? b_ : a_; }
  { const float a_ = K[1], b_ = K[9]; const bool g_ = a_ > b_; K[1] = g_ ? a_ : b_; K[9] = g_ ? b_ : a_; }
  { const float a_ = K[2], b_ = K[10]; const bool g_ = a_ > b_; K[2] = g_ ? a_ : b_; K[10] = g_ ? b_ : a_; }
  { const float a_ = K[3], b_ = K[11]; const bool g_ = a_ > b_; K[3] = g_ ? a_ : b_; K[11] = g_ ? b_ : a_; }
  { const float a_ = K[4], b_ = K[12]; const bool g_ = a_ > b_; K[4] = g_ ? a_ : b_; K[12] = g_ ? b_ : a_; }
  { const float a_ = K[5], b_ = K[13]; const bool g_ = a_ > b_; K[5] = g_ ? a_ : b_; K[13] = g_ ? b_ : a_; }
  { const float a_ = K[6], b_ = K[14]; const bool g_ = a_ > b_; K[6] = g_ ? a_ : b_; K[14] = g_ ? b_ : a_; }
  { const float a_ = K[7], b_ = K[15]; const bool g_ = a_ > b_; K[7] = g_ ? a_ : b_; K[15] = g_ ? b_ : a_; }
  { const float a_ = K[0], b_ = K[4]; const bool g_ = a_ > b_; K[0] = g_ ? a_ : b_; K[4] = g_ ? b_ : a_; }
  { const float a_ = K[1], b_ = K[5]; const bool g_ = a_ > b_; K[1] = g_ ? a_ : b_; K[5] = g_ ? b_ : a_; }
  { const float a_ = K[2], b_ = K[6]; const bool g_ = a_ > b_; K[2] = g_ ? a_ : b_; K[6] = g_ ? b_ : a_; }
  { const float a_ = K[3], b_ = K[7]; const bool g_ = a_ > b_; K[3] = g_ ? a_ : b_; K[7] = g_ ? b_ : a_; }
  { const float a_ = K[8], b_ = K[12]; const bool g_ = a_ > b_; K[8] = g_ ? a_ : b_; K[12] = g_ ? b_ : a_; }
  { const float a_ = K[9], b_ = K[13]; const bool g_ = a_ > b_; K[9] = g_ ? a_ : b_; K[13] = g_ ? b_ : a_; }
  { const float a_ = K[10], b_ = K[14]; const bool g_ = a_ > b_; K[10] = g_ ? a_ : b_; K[14] = g_ ? b_ : a_; }
  { const float a_ = K[11], b_ = K[15]; const bool g_ = a_ > b_; K[11] = g_ ? a_ : b_; K[15] = g_ ? b_ : a_; }
  { const float a_ = K[0], b_ = K[2]; const bool g_ = a_ > b_; K[0] = g_ ? a_ : b_; K[2] = g_ ? b_ : a_; }
  { const float a_ = K[1], b_ = K[3]; const bool g_ = a_ > b_; K[1] = g_ ? a_ : b_; K[3] = g_ ? b_ : a_; }
  { const float a_ = K[4], b_ = K[6]; const bool g_ = a_ > b_; K[4] = g_ ? a_ : b_; K[6] = g_ ? b_ : a_; }
  { const float a_ = K[5], b_ = K[7]; const bool g_ = a_ > b_; K[5] = g_ ? a_ : b_; K[7] = g_ ? b_ : a_; }
  { const float a_ = K[8], b_ = K[10]; const bool g_ = a_ > b_; K[8] = g_ ? a_ : b_; K[10] = g_ ? b_ : a_; }
  { const float a_ = K[9], b_ = K[11]; const bool g_ = a_ > b_; K[9] = g_ ? a_ : b_; K[11] = g_ ? b_ : a_; }
  { const float a_ = K[12], b_ = K[14]; const bool g_ = a_ > b_; K[12] = g_ ? a_ : b_; K[14] = g_ ? b_ : a_; }
  { const float a_ = K[13], b_ = K[15]; const bool g_ = a_ > b_; K[13] = g_ ? a_ : b_; K[15] = g_ ? b_ : a_; }
  { const float a_ = K[0], b_ = K[1]; const bool g_ = a_ > b_; K[0] = g_ ? a_ : b_; K[1] = g_ ? b_ : a_; }
  { const float a_ = K[2], b_ = K[3]; const bool g_ = a_ > b_; K[2] = g_ ? a_ : b_; K[3] = g_ ? b_ : a_; }
  { const float a_ = K[4], b_ = K[5]; const bool g_ = a_ > b_; K[4] = g_ ? a_ : b_; K[5] = g_ ? b_ : a_; }
  { const float a_ = K[6], b_ = K[7]; const bool g_ = a_ > b_; K[6] = g_ ? a_ : b_; K[7] = g_ ? b_ : a_; }
  { const float a_ = K[8], b_ = K[9]; const bool g_ = a_ > b_; K[8] = g_ ? a_ : b_; K[9] = g_ ? b_ : a_; }
  { const float a_ = K[10], b_ = K[11]; const bool g_ = a_ > b_; K[10] = g_ ? a_ : b_; K[11] = g_ ? b_ : a_; }
  { const float a_ = K[12], b_ = K[13]; const bool g_ = a_ > b_; K[12] = g_ ? a_ : b_; K[13] = g_ ? b_ : a_; }
  { const float a_ = K[14], b_ = K[15]; const bool g_ = a_ > b_; K[14] = g_ ? a_ : b_; K[15] = g_ ? b_ : a_; }
  { const float a_ = K[16], b_ = K[17]; const bool g_ = a_ > b_; K[16] = g_ ? a_ : b_; K[17] = g_ ? b_ : a_; }
  { const float a_ = K[18], b_ = K[19]; const bool g_ = a_ > b_; K[18] = g_ ? b_ : a_; K[19] = g_ ? a_ : b_; }
  { const float a_ = K[20], b_ = K[21]; const bool g_ = a_ > b_; K[20] = g_ ? a_ : b_; K[21] = g_ ? b_ : a_; }
  { const float a_ = K[22], b_ = K[23]; const bool g_ = a_ > b_; K[22] = g_ ? b_ : a_; K[23] = g_ ? a_ : b_; }
  { const float a_ = K[24], b_ = K[25]; const bool g_ = a_ > b_; K[24] = g_ ? a_ : b_; K[25] = g_ ? b_ : a_; }
  { const float a_ = K[26], b_ = K[27]; const bool g_ = a_ > b_; K[26] = g_ ? b_ : a_; K[27] = g_ ? a_ : b_; }
  { const float a_ = K[28], b_ = K[29]; const bool g_ = a_ > b_; K[28] = g_ ? a_ : b_; K[29] = g_ ? b_ : a_; }
  { const float a_ = K[30], b_ = K[31]; const bool g_ = a_ > b_; K[30] = g_ ? b_ : a_; K[31] = g_ ? a_ : b_; }
  { const float a_ = K[16], b_ = K[18]; const bool g_ = a_ > b_; K[16] = g_ ? a_ : b_; K[18] = g_ ? b_ : a_; }
  { const float a_ = K[17], b_ = K[19]; const bool g_ = a_ > b_; K[17] = g_ ? a_ : b_; K[19] = g_ ? b_ : a_; }
  { const float a_ = K[20], b_ = K[22]; const bool g_ = a_ > b_; K[20] = g_ ? b_ : a_; K[22] = g_ ? a_ : b_; }
  { const float a_ = K[21], b_ = K[23]; const bool g_ = a_ > b_; K[21] = g_ ? b_ : a_; K[23] = g_ ? a_ : b_; }
  { const float a_ = K[24], b_ = K[26]; const bool g_ = a_ > b_; K[24] = g_ ? a_ : b_; K[26] = g_ ? b_ : a_; }
  { const float a_ = K[25], b_ = K[27]; const bool g_ = a_ > b_; K[25] = g_ ? a_ : b_; K[27] = g_ ? b_ : a_; }
  { const float a_ = K[28], b_ = K[30]; const bool g_ = a_ > b_; K[28] = g_ ? b_ : a_; K[30] = g_ ? a_ : b_; }
  { const float a_ = K[29], b_ = K[31]; const bool g_ = a_ > b_; K[29] = g_ ? b_ : a_; K[31] = g_ ? a_ : b_; }
  { const float a_ = K[16], b_ = K[17]; const bool g_ = a_ > b_; K[16] = g_ ? a_ : b_; K[17] = g_ ? b_ : a_; }
  { const float a_ = K[18], b_ = K[19]; const bool g_ = a_ > b_; K[18] = g_ ? a_ : b_; K[19] = g_ ? b_ : a_; }
  { const float a_ = K[20], b_ = K[21]; const bool g_ = a_ > b_; K[20] = g_ ? b_ : a_; K[21] = g_ ? a_ : b_; }
  { const float a_ = K[22], b_ = K[23]; const bool g_ = a_ > b_; K[22] = g_ ? b_ : a_; K[23] = g_ ? a_ : b_; }
  { const float a_ = K[24], b_ = K[25]; const bool g_ = a_ > b_; K[24] = g_ ? a_ : b_; K[25] = g_ ? b_ : a_; }
  { const float a_ = K[26], b_ = K[27]; const bool g_ = a_ > b_; K[26] = g_ ? a_ : b_; K[27] = g_ ? b_ : a_; }
  { const float a_ = K[28], b_ = K[29]; const bool g_ = a_ > b_; K[28] = g_ ? b_ : a_; K[29] = g_ ? a_ : b_; }
  { const float a_ = K[30], b_ = K[31]; const bool g_ = a_ > b_; K[30] = g_ ? b_ : a_; K[31] = g_ ? a_ : b_; }
  { const float a_ = K[16], b_ = K[20]; const bool g_ = a_ > b_; K[16] = g_ ? a_ : b_; K[20] = g_ ? b_ : a_; }
  { const float a_ = K[17], b_ = K[21]; const bool g_ = a_ > b_; K[17] = g_ ? a_ : b_; K[21] = g_ ? b_ : a_; }
  { const float a_ = K[18], b_ = K[22]; const bool g_ = a_ > b_; K[18] = g_ ? a_ : b_; K[22] = g_ ? b_ : a_; }
  { const float a_ = K[19], b_ = K[23]; const bool g_ = a_ > b_; K[19] = g_ ? a_ : b_; K[23] = g_ ? b_ : a_; }
  { const float a_ = K[24], b_ = K[28]; const bool g_ = a_ > b_; K[24] = g_ ? b_ : a_; K[28] = g_ ? a_ : b_; }
  { const float a_ = K[25], b_ = K[29]; const bool g_ = a_ > b_; K[25] = g_ ? b_ : a_; K[29] = g_ ? a_ : b_; }
  { const float a_ = K[26], b_ = K[30]; const bool g_ = a_ > b_; K[26] = g_ ? b_ : a_; K[30] = g_ ? a_ : b_; }
  { const float a_ = K[27], b_ = K[31]; const bool g_ = a_ > b_; K[27] = g_ ? b_ : a_; K[31] = g_ ? a_ : b_; }
  { const float a_ = K[16], b_ = K[18]; const bool g_ = a_ > b_; K[16] = g_ ? a_ : b_; K[18] = g_ ? b_ : a_; }
  { const float a_ = K[17], b_ = K[19]; const bool g_ = a_ > b_; K[17] = g_ ? a_ : b_; K[19] = g_ ? b_ : a_; }
  { const float a_ = K[20], b_ = K[22]; const bool g_ = a_ > b_; K[20] = g_ ? a_ : b_; K[22] = g_ ? b_ : a_; }
  { const float a_ = K[21], b_ = K[23]; const bool g_ = a_ > b_; K[21] = g_ ? a_ : b_; K[23] = g_ ? b_ : a_; }
  { const float a_ = K[24], b_ = K[26]; const bool g_ = a_ > b_; K[24] = g_ ? b_ : a_; K[26] = g_ ? a_ : b_; }
  { const float a_ = K[25], b_ = K[27]; const bool g_ = a_ > b_; K[25] = g_ ? b_ : a_; K[27] = g_ ? a_ : b_; }
  { const float a_ = K[28], b_ = K[30]; const bool g_ = a_ > b_; K[28] = g_ ? b_ : a_; K[30] = g_ ? a_ : b_; }
  { const float a_ = K[29], b_ = K[31]; const bool g_ = a_ > b_; K[29] = g_ ? b_ : a_; K[31] = g_ ? a_ : b_; }
  { const float a_ = K[16], b_ = K[17]; const bool g_ = a_ > b_; K[16] = g_ ? a_ : b_; K[17] = g_ ? b_ : a_; }
  { const float a_ = K[18], b_ = K[19]; const bool g_ = a_ > b_; K[18] = g_ ? a_ : b_; K[19] = g_ ? b_ : a_; }
  { const float a_ = K[20], b_ = K[21]; const bool g_ = a_ > b_; K[20] = g_ ? a_ : b_; K[21] = g_ ? b_ : a_; }
  { const float a_ = K[22], b_ = K[23]; const bool g_ = a_ > b_; K[22] = g_ ? a_ : b_; K[23] = g_ ? b_ : a_; }
  { const float a_ = K[24], b_ = K[25]; const bool g_ = a_ > b_; K[24] = g_ ? b_ : a_; K[25] = g_ ? a_ : b_; }
  { const float a_ = K[26], b_ = K[27]; const bool g_ = a_ > b_; K[26] = g_ ? b_ : a_; K[27] = g_ ? a_ : b_; }
  { const float a_ = K[28], b_ = K[29]; const bool g_ = a_ > b_; K[28] = g_ ? b_ : a_; K[29] = g_ ? a_ : b_; }
  { const float a_ = K[30], b_ = K[31]; const bool g_ = a_ > b_; K[30] = g_ ? b_ : a_; K[31] = g_ ? a_ : b_; }
  { const float a_ = K[16], b_ = K[24]; const bool g_ = a_ > b_; K[16] = g_ ? a_ : b_; K[24] = g_ ? b_ : a_; }
  { const float a_ = K[17], b_ = K[25]; const bool g_ = a_ > b_; K[17] = g_ ? a_ : b_; K[25] = g_ ? b_ : a_; }
  { const float a_ = K[18], b_ = K[26]; const bool g_ = a_ > b_; K[18] = g_ ? a_ : b_; K[26] = g_ ? b_ : a_; }
  { const float a_ = K[19], b_ = K[27]; const bool g_ = a_ > b_; K[19] = g_ ? a_ : b_; K[27] = g_ ? b_ : a_; }
  { const float a_ = K[20], b_ = K[28]; const bool g_ = a_ > b_; K[20] = g_ ? a_ : b_; K[28] = g_ ? b_ : a_; }
  { const float a_ = K[21], b_ = K[29]; const bool g_ = a_ > b_; K[21] = g_ ? a_ : b_; K[29] = g_ ? b_ : a_; }
  { const float a_ = K[22], b_ = K[30]; const bool g_ = a_ > b_; K[22] = g_ ? a_ : b_; K[30] = g_ ? b_ : a_; }
  { const float a_ = K[23], b_ = K[31]; const bool g_ = a_ > b_; K[23] = g_ ? a_ : b_; K[31] = g_ ? b_ : a_; }
  { const float a_ = K[16], b_ = K[20]; const bool g_ = a_ > b_; K[16] = g_ ? a_ : b_; K[20] = g_ ? b_ : a_; }
  { const float a_ = K[17], b_ = K[21]; const bool g_ = a_ > b_; K[17] = g_ ? a_ : b_; K[21] = g_ ? b_ : a_; }
  { const float a_ = K[18], b_ = K[22]; const bool g_ = a_ > b_; K[18] = g_ ? a_ : b_; K[22] = g_ ? b_ : a_; }
  { const float a_ = K[19], b_ = K[23]; const bool g_ = a_ > b_; K[19] = g_ ? a_ : b_; K[23] = g_ ? b_ : a_; }
  { const float a_ = K[24], b_ = K[28]; const bool g_ = a_ > b_; K[24] = g_ ? a_ : b_; K[28] = g_ ? b_ : a_; }
  { const float a_ = K[25], b_ = K[29]; const bool g_ = a_ > b_; K[25] = g_ ? a_ : b_; K[29] = g_ ? b_ : a_; }
  { const float a_ = K[26], b_ = K[30]; const bool g_ = a_ > b_; K[26] = g_ ? a_ : b_; K[30] = g_ ? b_ : a_; }
  { const float a_ = K[27], b_ = K[31]; const bool g_ = a_ > b_; K[27] = g_ ? a_ : b_; K[31] = g_ ? b_ : a_; }
  { const float a_ = K[16], b_ = K[18]; const bool g_ = a_ > b_; K[16] = g_ ? a_ : b_; K[18] = g_ ? b_ : a_; }
  { const float a_ = K[17], b_ = K[19]; const bool g_ = a_ > b_; K[17] = g_ ? a_ : b_; K[19] = g_ ? b_ : a_; }
  { const float a_ = K[20], b_ = K[22]; const bool g_ = a_ > b_; K[20] = g_ ? a_ : b_; K[22] = g_ ? b_ : a_; }
  { const float a_ = K[21], b_ = K[23]; const bool g_ = a_ > b_; K[21] = g_ ? a_ : b_; K[23] = g_ ? b_ : a_; }
  { const float a_ = K[24], b_ = K[26]; const bool g_ = a_ > b_; K[24] = g_ ? a_ : b_; K[26] = g_ ? b_ : a_; }
  { const float a_ = K[25], b_ = K[27]; const bool g_ = a_ > b_; K[25] = g_ ? a_ : b_; K[27] = g_ ? b_ : a_; }
  { const float a_ = K[28], b_ = K[30]; const bool g_ = a_ > b_; K[28] = g_ ? a_ : b_; K[30] = g_ ? b_ : a_; }
  { const float a_ = K[29], b_ = K[31]; const bool g_ = a_ > b_; K[29] = g_ ? a_ : b_; K[31] = g_ ? b_ : a_; }
  { const float a_ = K[16], b_ = K[17]; const bool g_ = a_ > b_; K[16] = g_ ? a_ : b_; K[17] = g_ ? b_ : a_; }
  { const float a_ = K[18], b_ = K[19]; const bool g_ = a_ > b_; K[18] = g_ ? a_ : b_; K[19] = g_ ? b_ : a_; }
  { const float a_ = K[20], b_ = K[21]; const bool g_ = a_ > b_; K[20] = g_ ? a_ : b_; K[21] = g_ ? b_ : a_; }
  { const float a_ = K[22], b_ = K[23]; const bool g_ = a_ > b_; K[22] = g_ ? a_ : b_; K[23] = g_ ? b_ : a_; }
  { const float a_ = K[24], b_ = K[25]; const bool g_ = a_ > b_; K[24] = g_ ? a_ : b_; K[25] = g_ ? b_ : a_; }
  { const float a_ = K[26], b_ = K[27]; const bool g_ = a_ > b_; K[26] = g_ ? a_ : b_; K[27] = g_ ? b_ : a_; }
  { const float a_ = K[28], b_ = K[29]; const bool g_ = a_ > b_; K[28] = g_ ? a_ : b_; K[29] = g_ ? b_ : a_; }
  { const float a_ = K[30], b_ = K[31]; const bool g_ = a_ > b_; K[30] = g_ ? a_ : b_; K[31] = g_ ? b_ : a_; }
  { const float a_ = K[32], b_ = K[33]; const bool g_ = a_ > b_; K[32] = g_ ? a_ : b_; K[33] = g_ ? b_ : a_; }
  { const float a_ = K[34], b_ = K[35]; const bool g_ = a_ > b_; K[34] = g_ ? b_ : a_; K[35] = g_ ? a_ : b_; }
  { const float a_ = K[36], b_ = K[37]; const bool g_ = a_ > b_; K[36] = g_ ? a_ : b_; K[37] = g_ ? b_ : a_; }
  { const float a_ = K[38], b_ = K[39]; const bool g_ = a_ > b_; K[38] = g_ ? b_ : a_; K[39] = g_ ? a_ : b_; }
  { const float a_ = K[40], b_ = K[41]; const bool g_ = a_ > b_; K[40] = g_ ? a_ : b_; K[41] = g_ ? b_ : a_; }
  { const float a_ = K[42], b_ = K[43]; const bool g_ = a_ > b_; K[42] = g_ ? b_ : a_; K[43] = g_ ? a_ : b_; }
  { const float a_ = K[44], b_ = K[45]; const bool g_ = a_ > b_; K[44] = g_ ? a_ : b_; K[45] = g_ ? b_ : a_; }
  { const float a_ = K[46], b_ = K[47]; const bool g_ = a_ > b_; K[46] = g_ ? b_ : a_; K[47] = g_ ? a_ : b_; }
  { const float a_ = K[32], b_ = K[34]; const bool g_ = a_ > b_; K[32] = g_ ? a_ : b_; K[34] = g_ ? b_ : a_; }
  { const float a_ = K[33], b_ = K[35]; const bool g_ = a_ > b_; K[33] = g_ ? a_ : b_; K[35] = g_ ? b_ : a_; }
  { const float a_ = K[36], b_ = K[38]; const bool g_ = a_ > b_; K[36] = g_ ? b_ : a_; K[38] = g_ ? a_ : b_; }
  { const float a_ = K[37], b_ = K[39]; const bool g_ = a_ > b_; K[37] = g_ ? b_ : a_; K[39] = g_ ? a_ : b_; }
  { const float a_ = K[40], b_ = K[42]; const bool g_ = a_ > b_; K[40] = g_ ? a_ : b_; K[42] = g_ ? b_ : a_; }
  { const float a_ = K[41], b_ = K[43]; const bool g_ = a_ > b_; K[41] = g_ ? a_ : b_; K[43] = g_ ? b_ : a_; }
  { const float a_ = K[44], b_ = K[46]; const bool g_ = a_ > b_; K[44] = g_ ? b_ : a_; K[46] = g_ ? a_ : b_; }
  { const float a_ = K[45], b_ = K[47]; const bool g_ = a_ > b_; K[45] = g_ ? b_ : a_; K[47] = g_ ? a_ : b_; }
  { const float a_ = K[32], b_ = K[33]; const bool g_ = a_ > b_; K[32] = g_ ? a_ : b_; K[33] = g_ ? b_ : a_; }
  { const float a_ = K[34], b_ = K[35]; const bool g_ = a_ > b_; K[34] = g_ ? a_ : b_; K[35] = g_ ? b_ : a_; }
  { const float a_ = K[36], b_ = K[37]; const bool g_ = a_ > b_; K[36] = g_ ? b_ : a_; K[37] = g_ ? a_ : b_; }
  { const float a_ = K[38], b_ = K[39]; const bool g_ = a_ > b_; K[38] = g_ ? b_ : a_; K[39] = g_ ? a_ : b_; }
  { const float a_ = K[40], b_ = K[41]; const bool g_ = a_ > b_; K[40] = g_ ? a_ : b_; K[41] = g_ ? b_ : a_; }
  { const float a_ = K[42], b_ = K[43]; const bool g_ = a_ > b_; K[42] = g_ ? a_ : b_; K[43] = g_ ? b_ : a_; }
  { const float a_ = K[44], b_ = K[45]; const bool g_ = a_ > b_; K[44] = g_ ? b_ : a_; K[45] = g_ ? a_ : b_; }
  { const float a_ = K[46], b_ = K[47]; const bool g_ = a_ > b_; K[46] = g_ ? b_ : a_; K[47] = g_ ? a_ : b_; }
  { const float a_ = K[32], b_ = K[36]; const bool g_ = a_ > b_; K[32] = g_ ? a_ : b_; K[36] = g_ ? b_ : a_; }
  { const float a_ = K[33], b_ = K[37]; const bool g_ = a_ > b_; K[33] = g_ ? a_ : b_; K[37] = g_ ? b_ : a_; }
  { const float a_ = K[34], b_ = K[38]; const bool g_ = a_ > b_; K[34] = g_ ? a_ : b_; K[38] = g_ ? b_ : a_; }
  { const float a_ = K[35], b_ = K[39]; const bool g_ = a_ > b_; K[35] = g_ ? a_ : b_; K[39] = g_ ? b_ : a_; }
  { const float a_ = K[40], b_ = K[44]; const bool g_ = a_ > b_; K[40] = g_ ? b_ : a_; K[44] = g_ ? a_ : b_; }
  { const float a_ = K[41], b_ = K[45]; const bool g_ = a_ > b_; K[41] = g_ ? b_ : a_; K[45] = g_ ? a_ : b_; }
  { const float a_ = K[42], b_ = K[46]; const bool g_ = a_ > b_; K[42] = g_ ? b_ : a_; K[46] = g_ ? a_ : b_; }
  { const float a_ = K[43], b_ = K[47]; const bool g_ = a_ > b_; K[43] = g_ ? b_ : a_; K[47] = g_ ? a_ : b_; }
  { const float a_ = K[32], b_ = K[34]; const bool g_ = a_ > b_; K[32] = g_ ? a_ : b_; K[34] = g_ ? b_ : a_; }
  { const float a_ = K[33], b_ = K[35]; const bool g_ = a_ > b_; K[33] = g_ ? a_ : b_; K[35] = g_ ? b_ : a_; }
  { const float a_ = K[36], b_ = K[38]; const bool g_ = a_ > b_; K[36] = g_ ? a_ : b_; K[38] = g_ ? b_ : a_; }
  { const float a_ = K[37], b_ = K[39]; const bool g_ = a_ > b_; K[37] = g_ ? a_ : b_; K[39] = g_ ? b_ : a_; }
  { const float a_ = K[40], b_ = K[42]; const bool g_ = a_ > b_; K[40] = g_ ? b_ : a_; K[42] = g_ ? a_ : b_; }
  { const float a_ = K[41], b_ = K[43]; const bool g_ = a_ > b_; K[41] = g_ ? b_ : a_; K[43] = g_ ? a_ : b_; }
  { const float a_ = K[44], b_ = K[46]; const bool g_ = a_ > b_; K[44] = g_ ? b_ : a_; K[46] = g_ ? a_ : b_; }
  { const float a_ = K[45], b_ = K[47]; const bool g_ = a_ > b_; K[45] = g_ ? b_ : a_; K[47] = g_ ? a_ : b_; }
  { const float a_ = K[32], b_ = K[33]; const bool g_ = a_ > b_; K[32] = g_ ? a_ : b_; K[33] = g_ ? b_ : a_; }
  { const float a_ = K[34], b_ = K[35]; const bool g_ = a_ > b_; K[34] = g_ ? a_ : b_; K[35] = g_ ? b_ : a_; }
  { const float a_ = K[36], b_ = K[37]; const bool g_ = a_ > b_; K[36] = g_ ? a_ : b_; K[37] = g_ ? b_ : a_; }
  { const float a_ = K[38], b_ = K[39]; const bool g_ = a_ > b_; K[38] = g_ ? a_ : b_; K[39] = g_ ? b_ : a_; }
  { const float a_ = K[40], b_ = K[41]; const bool g_ = a_ > b_; K[40] = g_ ? b_ : a_; K[41] = g_ ? a_ : b_; }
  { const float a_ = K[42], b_ = K[43]; const bool g_ = a_ > b_; K[42] = g_ ? b_ : a_; K[43] = g_ ? a_ : b_; }
  { const float a_ = K[44], b_ = K[45]; const bool g_ = a_ > b_; K[44] = g_ ? b_ : a_; K[45] = g_ ? a_ : b_; }
  { const float a_ = K[46], b_ = K[47]; const bool g_ = a_ > b_; K[46] = g_ ? b_ : a_; K[47] = g_ ? a_ : b_; }
  { const float a_ = K[32], b_ = K[40]; const bool g_ = a_ > b_; K[32] = g_ ? a_ : b_; K[40] = g_ ? b_ : a_; }
  { const float a_ = K[33], b_ = K[41]; const bool g_ = a_ > b_; K[33] = g_ ? a_ : b_; K[41] = g_ ? b_ : a_; }
  { const float a_ = K[34], b_ = K[42]; const bool g_ = a_ > b_; K[34] = g_ ? a_ : b_; K[42] = g_ ? b_ : a_; }
  { const float a_ = K[35], b_ = K[43]; const bool g_ = a_ > b_; K[35] = g_ ? a_ : b_; K[43] = g_ ? b_ : a_; }
  { const float a_ = K[36], b_ = K[44]; const bool g_ = a_ > b_; K[36] = g_ ? a_ : b_; K[44] = g_ ? b_ : a_; }
  { const float a_ = K[37], b_ = K[45]; const bool g_ = a_ > b_; K[37] = g_ ? a_ : b_; K[45] = g_ ? b_ : a_; }
  { const float a_ = K[38], b_ = K[46]; const bool g_ = a_ > b_; K[38] = g_ ? a_ : b_; K[46] = g_ ? b_ : a_; }
  { const float a_ = K[39], b_ = K[47]; const bool g_ = a_ > b_; K[39] = g_ ? a_ : b_; K[47] = g_ ? b_ : a_; }
  { const float a_ = K[32], b_ = K[36]; const bool g_ = a_ > b_; K[32] = g_ ? a_ : b_; K[36] = g_ ? b_ : a_; }
  { const float a_ = K[33], b_ = K[37]; const bool g_ = a_ > b_; K[33] = g_ ? a_ : b_; K[37] = g_ ? b_ : a_; }
  { const float a_ = K[34], b_ = K[38]; const bool g_ = a_ > b_; K[34] = g_ ? a_ : b_; K[38] = g_ ? b_ : a_; }
  { const float a_ = K[35], b_ = K[39]; const bool g_ = a_ > b_; K[35] = g_ ? a_ : b_; K[39] = g_ ? b_ : a_; }
  { const float a_ = K[40], b_ = K[44]; const bool g_ = a_ > b_; K[40] = g_ ? a_ : b_; K[44] = g_ ? b_ : a_; }
  { const float a_ = K[41], b_ = K[45]; const bool g_ = a_ > b_; K[41] = g_ ? a_ : b_; K[45] = g_ ? b_ : a_; }
  { const float a_ = K[42], b_ = K[46]; const bool g_ = a_ > b_; K[42] = g_ ? a_ : b_; K[46] = g_ ? b_ : a_; }
  { const float a_ = K[43], b_ = K[47]; const bool g_ = a_ > b_; K[43] = g_ ? a_ : b_; K[47] = g_ ? b_ : a_; }
  { const float a_ = K[32], b_ = K[34]; const bool g_ = a_ > b_; K[32] = g_ ? a_ : b_; K[34] = g_ ? b_ : a_; }
  { const float a_ = K[33], b_ = K[35]; const bool g_ = a_ > b_; K[33] = g_ ? a_ : b_; K[35] = g_ ? b_ : a_; }
  { const float a_ = K[36], b_ = K[38]; const bool g_ = a_ > b_; K[36] = g_ ? a_ : b_; K[38] = g_ ? b_ : a_; }
  { const float a_ = K[37], b_ = K[39]; const bool g_ = a_ > b_; K[37] = g_ ? a_ : b_; K[39] = g_ ? b_ : a_; }
  { const float a_ = K[40], b_ = K[42]; const bool g_ = a_ > b_; K[40] = g_ ? a_ : b_; K[42] = g_ ? b_ : a_; }
  { const float a_ = K[41], b_ = K[43]; const bool g_ = a_ > b_; K[41] = g_ ? a_ : b_; K[43] = g_ ? b_ : a_; }
  { const float a_ = K[44], b_ = K[46]; const bool g_ = a_ > b_; K[44] = g_ ? a_ : b_; K[46] = g_ ? b_ : a_; }
  { const float a_ = K[45], b_ = K[47]; const bool g_ = a_ > b_; K[45] = g_ ? a_ : b_; K[47] = g_ ? b_ : a_; }
  { const float a_ = K[32], b_ = K[33]; const bool g_ = a_ > b_; K[32] = g_ ? a_ : b_; K[33] = g_ ? b_ : a_; }
  { const float a_ = K[34], b_ = K[35]; const bool g_ = a_ > b_; K[34] = g_ ? a_ : b_; K[35] = g_ ? b_ : a_; }
  { const float a_ = K[36], b_ = K[37]; const bool g_ = a_ > b_; K[36] = g_ ? a_ : b_; K[37] = g_ ? b_ : a_; }
  { const float a_ = K[38], b_ = K[39]; const bool g_ = a_ > b_; K[38] = g_ ? a_ : b_; K[39] = g_ ? b_ : a_; }
  { const float a_ = K[40], b_ = K[41]; const bool g_ = a_ > b_; K[40] = g_ ? a_ : b_; K[41] = g_ ? b_ : a_; }
  { const float a_ = K[42], b_ = K[43]; const bool g_ = a_ > b_; K[42] = g_ ? a_ : b_; K[43] = g_ ? b_ : a_; }
  { const float a_ = K[44], b_ = K[45]; const bool g_ = a_ > b_; K[44] = g_ ? a_ : b_; K[45] = g_ ? b_ : a_; }
  { const float a_ = K[46], b_ = K[47]; const bool g_ = a_ > b_; K[46] = g_ ? a_ : b_; K[47] = g_ ? b_ : a_; }
  { const float a_ = K[48], b_ = K[49]; const bool g_ = a_ > b_; K[48] = g_ ? a_ : b_; K[49] = g_ ? b_ : a_; }
  { const float a_ = K[50], b_ = K[51]; const bool g_ = a_ > b_; K[50] = g_ ? b_ : a_; K[51] = g_ ? a_ : b_; }
  { const float a_ = K[52], b_ = K[53]; const bool g_ = a_ > b_; K[52] = g_ ? a_ : b_; K[53] = g_ ? b_ : a_; }
  { const float a_ = K[54], b_ = K[55]; const bool g_ = a_ > b_; K[54] = g_ ? b_ : a_; K[55] = g_ ? a_ : b_; }
  { const float a_ = K[56], b_ = K[57]; const bool g_ = a_ > b_; K[56] = g_ ? a_ : b_; K[57] = g_ ? b_ : a_; }
  { const float a_ = K[58], b_ = K[59]; const bool g_ = a_ > b_; K[58] = g_ ? b_ : a_; K[59] = g_ ? a_ : b_; }
  { const float a_ = K[60], b_ = K[61]; const bool g_ = a_ > b_; K[60] = g_ ? a_ : b_; K[61] = g_ ? b_ : a_; }
  { const float a_ = K[62], b_ = K[63]; const bool g_ = a_ > b_; K[62] = g_ ? b_ : a_; K[63] = g_ ? a_ : b_; }
  { const float a_ = K[48], b_ = K[50]; const bool g_ = a_ > b_; K[48] = g_ ? a_ : b_; K[50] = g_ ? b_ : a_; }
  { const float a_ = K[49], b_ = K[51]; const bool g_ = a_ > b_; K[49] = g_ ? a_ : b_; K[51] = g_ ? b_ : a_; }
  { const float a_ = K[52], b_ = K[54]; const bool g_ = a_ > b_; K[52] = g_ ? b_ : a_; K[54] = g_ ? a_ : b_; }
  { const float a_ = K[53], b_ = K[55]; const bool g_ = a_ > b_; K[53] = g_ ? b_ : a_; K[55] = g_ ? a_ : b_; }
  { const float a_ = K[56], b_ = K[58]; const bool g_ = a_ > b_; K[56] = g_ ? a_ : b_; K[58] = g_ ? b_ : a_; }
  { const float a_ = K[57], b_ = K[59]; const bool g_ = a_ > b_; K[57] = g_ ? a_ : b_; K[59] = g_ ? b_ : a_; }
  { const float a_ = K[60], b_ = K[62]; const bool g_ = a_ > b_; K[60] = g_ ? b_ : a_; K[62] = g_ ? a_ : b_; }
  { const float a_ = K[61], b_ = K[63]; const bool g_ = a_ > b_; K[61] = g_ ? b_ : a_; K[63] = g_ ? a_ : b_; }
  { const float a_ = K[48], b_ = K[49]; const bool g_ = a_ > b_; K[48] = g_ ? a_ : b_; K[49] = g_ ? b_ : a_; }
  { const float a_ = K[50], b_ = K[51]; const bool g_ = a_ > b_; K[50] = g_ ? a_ : b_; K[51] = g_ ? b_ : a_; }
  { const float a_ = K[52], b_ = K[53]; const bool g_ = a_ > b_; K[52] = g_ ? b_ : a_; K[53] = g_ ? a_ : b_; }
  { const float a_ = K[54], b_ = K[55]; const bool g_ = a_ > b_; K[54] = g_ ? b_ : a_; K[55] = g_ ? a_ : b_; }
  { const float a_ = K[56], b_ = K[57]; const bool g_ = a_ > b_; K[56] = g_ ? a_ : b_; K[57] = g_ ? b_ : a_; }
  { const float a_ = K[58], b_ = K[59]; const bool g_ = a_ > b_; K[58] = g_ ? a_ : b_; K[59] = g_ ? b_ : a_; }
  { const float a_ = K[60], b_ = K[61]; const bool g_ = a_ > b_; K[60] = g_ ? b_ : a_; K[61] = g_ ? a_ : b_; }
  { const float a_ = K[62], b_ = K[63]; const bool g_ = a_ > b_; K[62] = g_ ? b_ : a_; K[63] = g_ ? a_ : b_; }
  { const float a_ = K[48], b_ = K[52]; const bool g_ = a_ > b_; K[48] = g_ ? a_ : b_; K[52] = g_ ? b_ : a_; }
  { const float a_ = K[49], b_ = K[53]; const bool g_ = a_ > b_; K[49] = g_ ? a_ : b_; K[53] = g_ ? b_ : a_; }
  { const float a_ = K[50], b_ = K[54]; const bool g_ = a_ > b_; K[50] = g_ ? a_ : b_; K[54] = g_ ? b_ : a_; }
  { const float a_ = K[51], b_ = K[55]; const bool g_ = a_ > b_; K[51] = g_ ? a_ : b_; K[55] = g_ ? b_ : a_; }
  { const float a_ = K[56], b_ = K[60]; const bool g_ = a_ > b_; K[56] = g_ ? b_ : a_; K[60] = g_ ? a_ : b_; }
  { const float a_ = K[57], b_ = K[61]; const bool g_ = a_ > b_; K[57] = g_ ? b_ : a_; K[61] = g_ ? a_ : b_; }
  { const float a_ = K[58], b_ = K[62]; const bool g_ = a_ > b_; K[58] = g_ ? b_ : a_; K[62] = g_ ? a_ : b_; }
  { const float a_ = K[59], b_ = K[63]; const bool g_ = a_ > b_; K[59] = g_ ? b_ : a_; K[63] = g_ ? a_ : b_; }
  { const float a_ = K[48], b_ = K[50]; const bool g_ = a_ > b_; K[48] = g_ ? a_ : b_; K[50] = g_ ? b_ : a_; }
  { const float a_ = K[49], b_ = K[51]; const bool g_ = a_ > b_; K[49] = g_ ? a_ : b_; K[51] = g_ ? b_ : a_; }
  { const float a_ = K[52], b_ = K[54]; const bool g_ = a_ > b_; K[52] = g_ ? a_ : b_; K[54] = g_ ? b_ : a_; }
  { const float a_ = K[53], b_ = K[55]; const bool g_ = a_ > b_; K[53] = g_ ? a_ : b_; K[55] = g_ ? b_ : a_; }
  { const float a_ = K[56], b_ = K[58]; const bool g_ = a_ > b_; K[56] = g_ ? b_ : a_; K[58] = g_ ? a_ : b_; }
  { const float a_ = K[57], b_ = K[59]; const bool g_ = a_ > b_; K[57] = g_ ? b_ : a_; K[59] = g_ ? a_ : b_; }
  { const float a_ = K[60], b_ = K[62]; const bool g_ = a_ > b_; K[60] = g_ ? b_ : a_; K[62] = g_ ? a_ : b_; }
  { const float a_ = K[61], b_ = K[63]; const bool g_ = a_ > b_; K[61] = g_ ? b_ : a_; K[63] = g_ ? a_ : b_; }
  { const float a_ = K[48], b_ = K[49]; const bool g_ = a_ > b_; K[48] = g_ ? a_ : b_; K[49] = g_ ? b_ : a_; }
  { const float a_ = K[50], b_ = K[51]; const bool g_ = a_ > b_; K[50] = g_ ? a_ : b_; K[51] = g_ ? b_ : a_; }
  { const float a_ = K[52], b_ = K[53]; const bool g_ = a_ > b_; K[52] = g_ ? a_ : b_; K[53] = g_ ? b_ : a_; }
  { const float a_ = K[54], b_ = K[55]; const bool g_ = a_ > b_; K[54] = g_ ? a_ : b_; K[55] = g_ ? b_ : a_; }
  { const float a_ = K[56], b_ = K[57]; const bool g_ = a_ > b_; K[56] = g_ ? b_ : a_; K[57] = g_ ? a_ : b_; }
  { const float a_ = K[58], b_ = K[59]; const bool g_ = a_ > b_; K[58] = g_ ? b_ : a_; K[59] = g_ ? a_ : b_; }
  { const float a_ = K[60], b_ = K[61]; const bool g_ = a_ > b_; K[60] = g_ ? b_ : a_; K[61] = g_ ? a_ : b_; }
  { const float a_ = K[62], b_ = K[63]; const bool g_ = a_ > b_; K[62] = g_ ? b_ : a_; K[63] = g_ ? a_ : b_; }
  { const float a_ = K[48], b_ = K[56]; const bool g_ = a_ > b_; K[48] = g_ ? a_ : b_; K[56] = g_ ? b_ : a_; }
  { const float a_ = K[49], b_ = K[57]; const bool g_ = a_ > b_; K[49] = g_ ? a_ : b_; K[57] = g_ ? b_ : a_; }
  { const float a_ = K[50], b_ = K[58]; const bool g_ = a_ > b_; K[50] = g_ ? a_ : b_; K[58] = g_ ? b_ : a_; }
  { const float a_ = K[51], b_ = K[59]; const bool g_ = a_ > b_; K[51] = g_ ? a_ : b_; K[59] = g_ ? b_ : a_; }
  { const float a_ = K[52], b_ = K[60]; const bool g_ = a_ > b_; K[52] = g_ ? a_ : b_; K[60] = g_ ? b_ : a_; }
  { const float a_ = K[53], b_ = K[61]; const bool g_ = a_ > b_; K[53] = g_ ? a_ : b_; K[61] = g_ ? b_ : a_; }
  { const float a_ = K[54], b_ = K[62]; const bool g_ = a_ > b_; K[54] = g_ ? a_ : b_; K[62] = g_ ? b_ : a_; }
  { const float a_ = K[55], b_ = K[63]; const bool g_ = a_ > b_; K[55] = g_ ? a_ : b_; K[63] = g_ ? b_ : a_; }
  { const float a_ = K[48], b_ = K[52]; const bool g_ = a_ > b_; K[48] = g_ ? a_ : b_; K[52] = g_ ? b_ : a_; }
  { const float a_ = K[49], b_ = K[53]; const bool g_ = a_ > b_; K[49] = g_ ? a_ : b_; K[53] = g_ ? b_ : a_; }
  { const float a_ = K[50], b_ = K[54]; const bool g_ = a_ > b_; K[50] = g_ ? a_ : b_; K[54] = g_ ? b_ : a_; }
  { const float a_ = K[51], b_ = K[55]; const bool g_ = a_ > b_; K[51] = g_ ? a_ : b_; K[55] = g_ ? b_ : a_; }
  { const float a_ = K[56], b_ = K[60]; const bool g_ = a_ > b_; K[56] = g_ ? a_ : b_; K[60] = g_ ? b_ : a_; }
  { const float a_ = K[57], b_ = K[61]; const bool g_ = a_ > b_; K[57] = g_ ? a_ : b_; K[61] = g_ ? b_ : a_; }
  { const float a_ = K[58], b_ = K[62]; const bool g_ = a_ > b_; K[58] = g_ ? a_ : b_; K[62] = g_ ? b_ : a_; }
  { const float a_ = K[59], b_ = K[63]; const bool g_ = a_ > b_; K[59] = g_ ? a_ : b_; K[63] = g_ ? b_ : a_; }
  { const float a_ = K[48], b_ = K[50]; const bool g_ = a_ > b_; K[48] = g_ ? a_ : b_; K[50] = g_ ? b_ : a_; }
  { const float a_ = K[49], b_ = K[51]; const bool g_ = a_ > b_; K[49] = g_ ? a_ : b_; K[51] = g_ ? b_ : a_; }
  { const float a_ = K[52], b_ = K[54]; const bool g_ = a_ > b_; K[52] = g_ ? a_ : b_; K[54] = g_ ? b_ : a_; }
  { const float a_ = K[53], b_ = K[55]; const bool g_ = a_ > b_; K[53] = g_ ? a_ : b_; K[55] = g_ ? b_ : a_; }
  { const float a_ = K[56], b_ = K[58]; const bool g_ = a_ > b_; K[56] = g_ ? a_ : b_; K[58] = g_ ? b_ : a_; }
  { const float a_ = K[57], b_ = K[59]; const bool g_ = a_ > b_; K[57] = g_ ? a_ : b_; K[59] = g_ ? b_ : a_; }
  { const float a_ = K[60], b_ = K[62]; const bool g_ = a_ > b_; K[60] = g_ ? a_ : b_; K[62] = g_ ? b_ : a_; }
  { const float a_ = K[61], b_ = K[63]; const bool g_ = a_ > b_; K[61] = g_ ? a_ : b_; K[63] = g_ ? b_ : a_; }
  { const float a_ = K[48], b_ = K[49]; const bool g_ = a_ > b_; K[48] = g_ ? a_ : b_; K[49] = g_ ? b_ : a_; }
  { const float a_ = K[50], b_ = K[51]; const bool g_ = a_ > b_; K[50] = g_ ? a_ : b_; K[51] = g_ ? b_ : a_; }
  { const float a_ = K[52], b_ = K[53]; const bool g_ = a_ > b_; K[52] = g_ ? a_ : b_; K[53] = g_ ? b_ : a_; }
  { const float a_ = K[54], b_ = K[55]; const bool g_ = a_ > b_; K[54] = g_ ? a_ : b_; K[55] = g_ ? b_ : a_; }
  { const float a_ = K[56], b_ = K[57]; const bool g_ = a_ > b_; K[56] = g_ ? a_ : b_; K[57] = g_ ? b_ : a_; }
  { const float a_ = K[58], b_ = K[59]; const bool g_ = a_ > b_; K[58] = g_ ? a_ : b_; K[59] = g_ ? b_ : a_; }
  { const float a_ = K[60], b_ = K[61]; const bool g_ = a_ > b_; K[60] = g_ ? a_ : b_; K[61] = g_ ? b_ : a_; }
  { const float a_ = K[62], b_ = K[63]; const bool g_ = a_ > b_; K[62] = g_ ? a_ : b_; K[63] = g_ ? b_ : a_; }
  { const float a_ = K[0], b_ = K[31]; K[0] = a_ > b_ ? a_ : b_; }
  { const float a_ = K[1], b_ = K[30]; K[1] = a_ > b_ ? a_ : b_; }
  { const float a_ = K[2], b_ = K[29]; K[2] = a_ > b_ ? a_ : b_; }
  { const float a_ = K[3], b_ = K[28]; K[3] = a_ > b_ ? a_ : b_; }
  { const float a_ = K[4], b_ = K[27]; K[4] = a_ > b_ ? a_ : b_; }
  { const float a_ = K[5], b_ = K[26]; K[5] = a_ > b_ ? a_ : b_; }
  { const float a_ = K[6], b_ = K[25]; K[6] = a_ > b_ ? a_ : b_; }
  { const float a_ = K[7], b_ = K[24]; K[7] = a_ > b_ ? a_ : b_; }
  { const float a_ = K[8], b_ = K[23]; K[8] = a_ > b_ ? a_ : b_; }
  { const float a_ = K[9], b_ = K[22]; K[9] = a_ > b_ ? a_ : b_; }
  { const float a_ = K[10], b_ = K[21]; K[10] = a_ > b_ ? a_ : b_; }
  { const float a_ = K[11], b_ = K[20]; K[11] = a_ > b_ ? a_ : b_; }
  { const float a_ = K[12], b_ = K[19]; K[12] = a_ > b_ ? a_ : b_; }
  { const float a_ = K[13], b_ = K[18]; K[13] = a_ > b_ ? a_ : b_; }
  { const float a_ = K[14], b_ = K[17]; K[14] = a_ > b_ ? a_ : b_; }
  { const float a_ = K[15], b_ = K[16]; K[15] = a_ > b_ ? a_ : b_; }
  { const float a_ = K[0], b_ = K[8]; const bool g_ = a_ > b_; K[0] = g_ ? a_ : b_; K[8] = g_ ? b_ : a_; }
  { const float a_ = K[1], b_ = K[9]; const bool g_ = a_ > b_; K[1] = g_ ? a_ : b_; K[9] = g_ ? b_ : a_; }
  { const float a_ = K[2], b_ = K[10]; const bool g_ = a_ > b_; K[2] = g_ ? a_ : b_; K[10] = g_ ? b_ : a_; }
  { const float a_ = K[3], b_ = K[11]; const bool g_ = a_ > b_; K[3] = g_ ? a_ : b_; K[11] = g_ ? b_ : a_; }
  { const float a_ = K[4], b_ = K[12]; const bool g_ = a_ > b_; K[4] = g_ ? a_ : b_; K[12] = g_ ? b_ : a_; }
  { const float a_ = K[5], b_ = K[13]; const bool g_ = a_ > b_; K[5] = g_ ? a_ : b_; K[13] = g_ ? b_ : a_; }
  { const float a_ = K[6], b_ = K[14]; const bool g_ = a_ > b_; K[6] = g_ ? a_ : b_; K[14] = g_ ? b_ : a_; }
  { const float a_ = K[7], b_ = K[15]; const bool g_ = a_ > b_; K[7] = g_ ? a_ : b_; K[15] = g_ ? b_ : a_; }
  { const float a_ = K[0], b_ = K[4]; const bool g_ = a_ > b_; K[0] = g_ ? a_ : b_; K[4] = g_ ? b_ : a_; }
  { const float a_ = K[1], b_ = K[5]; const bool g_ = a_ > b_; K[1] = g_ ? a_ : b_; K[5] = g_ ? b_ : a_; }
  { const float a_ = K[2], b_ = K[6]; const bool g_ = a_ > b_; K[2] = g_ ? a_ : b_; K[6] = g_ ? b_ : a_; }
  { const float a_ = K[3], b_ = K[7]; const bool g_ = a_ > b_; K[3] = g_ ? a_ : b_; K[7] = g_ ? b_ : a_; }
  { const float a_ = K[8], b_ = K[12]; const bool g_ = a_ > b_; K[8] = g_ ? a_ : b_; K[12] = g_ ? b_ : a_; }
  { const float a_ = K[9], b_ = K[13]; const bool g_ = a_ > b_; K[9] = g_ ? a_ : b_; K[13] = g_ ? b_ : a_; }
  { const float a_ = K[10], b_ = K[14]; const bool g_ = a_ > b_; K[10] = g_ ? a_ : b_; K[14] = g_ ? b_ : a_; }
  { const float a_ = K[11], b_ = K[15]; const bool g_ = a_ > b_; K[11] = g_ ? a_ : b_; K[15] = g_ ? b_ : a_; }
  { const float a_ = K[0], b_ = K[2]; const bool g_ = a_ > b_; K[0] = g_ ? a_ : b_; K[2] = g_ ? b_ : a_; }
  { const float a_ = K[1], b_ = K[3]; const bool g_ = a_ > b_; K[1] = g_ ? a_ : b_; K[3] = g_ ? b_ : a_; }
  { const float a_ = K[4], b_ = K[6]; const bool g_ = a_ > b_; K[4] = g_ ? a_ : b_; K[6] = g_ ? b_ : a_; }
  { const float a_ = K[5], b_ = K[7]; const bool g_ = a_ > b_; K[5] = g_ ? a_ : b_; K[7] = g_ ? b_ : a_; }
  { const float a_ = K[8], b_ = K[10]; const bool g_ = a_ > b_; K[8] = g_ ? a_ : b_; K[10] = g_ ? b_ : a_; }
  { const float a_ = K[9], b_ = K[11]; const bool g_ = a_ > b_; K[9] = g_ ? a_ : b_; K[11] = g_ ? b_ : a_; }
  { const float a_ = K[12], b_ = K[14]; const bool g_ = a_ > b_; K[12] = g_ ? a_ : b_; K[14] = g_ ? b_ : a_; }
  { const float a_ = K[13], b_ = K[15]; const bool g_ = a_ > b_; K[13] = g_ ? a_ : b_; K[15] = g_ ? b_ : a_; }
  { const float a_ = K[0], b_ = K[1]; const bool g_ = a_ > b_; K[0] = g_ ? a_ : b_; K[1] = g_ ? b_ : a_; }
  { const float a_ = K[2], b_ = K[3]; const bool g_ = a_ > b_; K[2] = g_ ? a_ : b_; K[3] = g_ ? b_ : a_; }
  { const float a_ = K[4], b_ = K[5]; const bool g_ = a_ > b_; K[4] = g_ ? a_ : b_; K[5] = g_ ? b_ : a_; }
  { const float a_ = K[6], b_ = K[7]; const bool g_ = a_ > b_; K[6] = g_ ? a_ : b_; K[7] = g_ ? b_ : a_; }
  { const float a_ = K[8], b_ = K[9]; const bool g_ = a_ > b_; K[8] = g_ ? a_ : b_; K[9] = g_ ? b_ : a_; }
  { const float a_ = K[10], b_ = K[11]; const bool g_ = a_ > b_; K[10] = g_ ? a_ : b_; K[11] = g_ ? b_ : a_; }
  { const float a_ = K[12], b_ = K[13]; const bool g_ = a_ > b_; K[12] = g_ ? a_ : b_; K[13] = g_ ? b_ : a_; }
  { const float a_ = K[14], b_ = K[15]; const bool g_ = a_ > b_; K[14] = g_ ? a_ : b_; K[15] = g_ ? b_ : a_; }
  { const float a_ = K[32], b_ = K[63]; K[32] = a_ > b_ ? a_ : b_; }
  { const float a_ = K[33], b_ = K[62]; K[33] = a_ > b_ ? a_ : b_; }
  { const float a_ = K[34], b_ = K[61]; K[34] = a_ > b_ ? a_ : b_; }
  { const float a_ = K[35], b_ = K[60]; K[35] = a_ > b_ ? a_ : b_; }
  { const float a_ = K[36], b_ = K[59]; K[36] = a_ > b_ ? a_ : b_; }
  { const float a_ = K[37], b_ = K[58]; K[37] = a_ > b_ ? a_ : b_; }
  { const float a_ = K[38], b_ = K[57]; K[38] = a_ > b_ ? a_ : b_; }
  { const float a_ = K[39], b_ = K[56]; K[39] = a_ > b_ ? a_ : b_; }
  { const float a_ = K[40], b_ = K[55]; K[40] = a_ > b_ ? a_ : b_; }
  { const float a_ = K[41], b_ = K[54]; K[41] = a_ > b_ ? a_ : b_; }
  { const float a_ = K[42], b_ = K[53]; K[42] = a_ > b_ ? a_ : b_; }
  { const float a_ = K[43], b_ = K[52]; K[43] = a_ > b_ ? a_ : b_; }
  { const float a_ = K[44], b_ = K[51]; K[44] = a_ > b_ ? a_ : b_; }
  { const float a_ = K[45], b_ = K[50]; K[45] = a_ > b_ ? a_ : b_; }
  { const float a_ = K[46], b_ = K[49]; K[46] = a_ > b_ ? a_ : b_; }
  { const float a_ = K[47], b_ = K[48]; K[47] = a_ > b_ ? a_ : b_; }
  { const float a_ = K[32], b_ = K[40]; const bool g_ = a_ > b_; K[32] = g_ ? a_ : b_; K[40] = g_ ? b_ : a_; }
  { const float a_ = K[33], b_ = K[41]; const bool g_ = a_ > b_; K[33] = g_ ? a_ : b_; K[41] = g_ ? b_ : a_; }
  { const float a_ = K[34], b_ = K[42]; const bool g_ = a_ > b_; K[34] = g_ ? a_ : b_; K[42] = g_ ? b_ : a_; }
  { const float a_ = K[35], b_ = K[43]; const bool g_ = a_ > b_; K[35] = g_ ? a_ : b_; K[43] = g_ ? b_ : a_; }
  { const float a_ = K[36], b_ = K[44]; const bool g_ = a_ > b_; K[36] = g_ ? a_ : b_; K[44] = g_ ? b_ : a_; }
  { const float a_ = K[37], b_ = K[45]; const bool g_ = a_ > b_; K[37] = g_ ? a_ : b_; K[45] = g_ ? b_ : a_; }
  { const float a_ = K[38], b_ = K[46]; const bool g_ = a_ > b_; K[38] = g_ ? a_ : b_; K[46] = g_ ? b_ : a_; }
  { const float a_ = K[39], b_ = K[47]; const bool g_ = a_ > b_; K[39] = g_ ? a_ : b_; K[47] = g_ ? b_ : a_; }
  { const float a_ = K[32], b_ = K[36]; const bool g_ = a_ > b_; K[32] = g_ ? a_ : b_; K[36] = g_ ? b_ : a_; }
  { const float a_ = K[33], b_ = K[37]; const bool g_ = a_ > b_; K[33] = g_ ? a_ : b_; K[37] = g_ ? b_ : a_; }
  { const float a_ = K[34], b_ = K[38]; const bool g_ = a_ > b_; K[34] = g_ ? a_ : b_; K[38] = g_ ? b_ : a_; }
  { const float a_ = K[35], b_ = K[39]; const bool g_ = a_ > b_; K[35] = g_ ? a_ : b_; K[39] = g_ ? b_ : a_; }
  { const float a_ = K[40], b_ = K[44]; const bool g_ = a_ > b_; K[40] = g_ ? a_ : b_; K[44] = g_ ? b_ : a_; }
  { const float a_ = K[41], b_ = K[45]; const bool g_ = a_ > b_; K[41] = g_ ? a_ : b_; K[45] = g_ ? b_ : a_; }
  { const float a_ = K[42], b_ = K[46]; const bool g_ = a_ > b_; K[42] = g_ ? a_ : b_; K[46] = g_ ? b_ : a_; }
  { const float a_ = K[43], b_ = K[47]; const bool g_ = a_ > b_; K[43] = g_ ? a_ : b_; K[47] = g_ ? b_ : a_; }
  { const float a_ = K[32], b_ = K[34]; const bool g_ = a_ > b_; K[32] = g_ ? a_ : b_; K[34] = g_ ? b_ : a_; }
  { const float a_ = K[33], b_ = K[35]; const bool g_ = a_ > b_; K[33] = g_ ? a_ : b_; K[35] = g_ ? b_ : a_; }
  { const float a_ = K[36], b_ = K[38]; const bool g_ = a_ > b_; K[36] = g_ ? a_ : b_; K[38] = g_ ? b_ : a_; }
  { const float a_ = K[37], b_ = K[39]; const bool g_ = a_ > b_; K[37] = g_ ? a_ : b_; K[39] = g_ ? b_ : a_; }
  { const float a_ = K[40], b_ = K[42]; const bool g_ = a_ > b_; K[40] = g_ ? a_ : b_; K[42] = g_ ? b_ : a_; }
  { const float a_ = K[41], b_ = K[43]; const bool g_ = a_ > b_; K[41] = g_ ? a_ : b_; K[43] = g_ ? b_ : a_; }
  { const float a_ = K[44], b_ = K[46]; const bool g_ = a_ > b_; K[44] = g_ ? a_ : b_; K[46] = g_ ? b_ : a_; }
  { const float a_ = K[45], b_ = K[47]; const bool g_ = a_ > b_; K[45] = g_ ? a_ : b_; K[47] = g_ ? b_ : a_; }
  { const float a_ = K[32], b_ = K[33]; const bool g_ = a_ > b_; K[32] = g_ ? a_ : b_; K[33] = g_ ? b_ : a_; }
  { const float a_ = K[34], b_ = K[35]; const bool g_ = a_ > b_; K[34] = g_ ? a_ : b_; K[35] = g_ ? b_ : a_; }
  { const float a_ = K[36], b_ = K[37]; const bool g_ = a_ > b_; K[36] = g_ ? a_ : b_; K[37] = g_ ? b_ : a_; }
  { const float a_ = K[38], b_ = K[39]; const bool g_ = a_ > b_; K[38] = g_ ? a_ : b_; K[39] = g_ ? b_ : a_; }
  { const float a_ = K[40], b_ = K[41]; const bool g_ = a_ > b_; K[40] = g_ ? a_ : b_; K[41] = g_ ? b_ : a_; }
  { const float a_ = K[42], b_ = K[43]; const bool g_ = a_ > b_; K[42] = g_ ? a_ : b_; K[43] = g_ ? b_ : a_; }
  { const float a_ = K[44], b_ = K[45]; const bool g_ = a_ > b_; K[44] = g_ ? a_ : b_; K[45] = g_ ? b_ : a_; }
  { const float a_ = K[46], b_ = K[47]; const bool g_ = a_ > b_; K[46] = g_ ? a_ : b_; K[47] = g_ ? b_ : a_; }
  { const float a_ = K[0], b_ = K[47]; K[0] = a_ > b_ ? a_ : b_; }
  { const float a_ = K[1], b_ = K[46]; K[1] = a_ > b_ ? a_ : b_; }
  { const float a_ = K[2], b_ = K[45]; K[2] = a_ > b_ ? a_ : b_; }
  { const float a_ = K[3], b_ = K[44]; K[3] = a_ > b_ ? a_ : b_; }
  { const float a_ = K[4], b_ = K[43]; K[4] = a_ > b_ ? a_ : b_; }
  { const float a_ = K[5], b_ = K[42]; K[5] = a_ > b_ ? a_ : b_; }
  { const float a_ = K[6], b_ = K[41]; K[6] = a_ > b_ ? a_ : b_; }
  { const float a_ = K[7], b_ = K[40]; K[7] = a_ > b_ ? a_ : b_; }
  { const float a_ = K[8], b_ = K[39]; K[8] = a_ > b_ ? a_ : b_; }
  { const float a_ = K[9], b_ = K[38]; K[9] = a_ > b_ ? a_ : b_; }
  { const float a_ = K[10], b_ = K[37]; K[10] = a_ > b_ ? a_ : b_; }
  { const float a_ = K[11], b_ = K[36]; K[11] = a_ > b_ ? a_ : b_; }
  { const float a_ = K[12], b_ = K[35]; K[12] = a_ > b_ ? a_ : b_; }
  { const float a_ = K[13], b_ = K[34]; K[13] = a_ > b_ ? a_ : b_; }
  { const float a_ = K[14], b_ = K[33]; K[14] = a_ > b_ ? a_ : b_; }
  { const float a_ = K[15], b_ = K[32]; K[15] = a_ > b_ ? a_ : b_; }
  { const float a_ = K[0], b_ = K[8]; const bool g_ = a_ > b_; K[0] = g_ ? a_ : b_; K[8] = g_ ? b_ : a_; }
  { const float a_ = K[1], b_ = K[9]; const bool g_ = a_ > b_; K[1] = g_ ? a_ : b_; K[9] = g_ ? b_ : a_; }
  { const float a_ = K[2], b_ = K[10]; const bool g_ = a_ > b_; K[2] = g_ ? a_ : b_; K[10] = g_ ? b_ : a_; }
  { const float a_ = K[3], b_ = K[11]; const bool g_ = a_ > b_; K[3] = g_ ? a_ : b_; K[11] = g_ ? b_ : a_; }
  { const float a_ = K[4], b_ = K[12]; const bool g_ = a_ > b_; K[4] = g_ ? a_ : b_; K[12] = g_ ? b_ : a_; }
  { const float a_ = K[5], b_ = K[13]; const bool g_ = a_ > b_; K[5] = g_ ? a_ : b_; K[13] = g_ ? b_ : a_; }
  { const float a_ = K[6], b_ = K[14]; const bool g_ = a_ > b_; K[6] = g_ ? a_ : b_; K[14] = g_ ? b_ : a_; }
  { const float a_ = K[7], b_ = K[15]; const bool g_ = a_ > b_; K[7] = g_ ? a_ : b_; K[15] = g_ ? b_ : a_; }
  { const float a_ = K[0], b_ = K[4]; const bool g_ = a_ > b_; K[0] = g_ ? a_ : b_; K[4] = g_ ? b_ : a_; }
  { const float a_ = K[1], b_ = K[5]; const bool g_ = a_ > b_; K[1] = g_ ? a_ : b_; K[5] = g_ ? b_ : a_; }
  { const float a_ = K[2], b_ = K[6]; const bool g_ = a_ > b_; K[2] = g_ ? a_ : b_; K[6] = g_ ? b_ : a_; }
  { const float a_ = K[3], b_ = K[7]; const bool g_ = a_ > b_; K[3] = g_ ? a_ : b_; K[7] = g_ ? b_ : a_; }
  { const float a_ = K[8], b_ = K[12]; const bool g_ = a_ > b_; K[8] = g_ ? a_ : b_; K[12] = g_ ? b_ : a_; }
  { const float a_ = K[9], b_ = K[13]; const bool g_ = a_ > b_; K[9] = g_ ? a_ : b_; K[13] = g_ ? b_ : a_; }
  { const float a_ = K[10], b_ = K[14]; const bool g_ = a_ > b_; K[10] = g_ ? a_ : b_; K[14] = g_ ? b_ : a_; }
  { const float a_ = K[11], b_ = K[15]; const bool g_ = a_ > b_; K[11] = g_ ? a_ : b_; K[15] = g_ ? b_ : a_; }
  { const float a_ = K[0], b_ = K[2]; const bool g_ = a_ > b_; K[0] = g_ ? a_ : b_; K[2] = g_ ? b_ : a_; }
  { const float a_ = K[1], b_ = K[3]; const bool g_ = a_ > b_; K[1] = g_ ? a_ : b_; K[3] = g_ ? b_ : a_; }
  { const float a_ = K[4], b_ = K[6]; const bool g_ = a_ > b_; K[4] = g_ ? a_ : b_; K[6] = g_ ? b_ : a_; }
  { const float a_ = K[5], b_ = K[7]; const bool g_ = a_ > b_; K[5] = g_ ? a_ : b_; K[7] = g_ ? b_ : a_; }
  { const float a_ = K[8], b_ = K[10]; const bool g_ = a_ > b_; K[8] = g_ ? a_ : b_; K[10] = g_ ? b_ : a_; }
  { const float a_ = K[9], b_ = K[11]; const bool g_ = a_ > b_; K[9] = g_ ? a_ : b_; K[11] = g_ ? b_ : a_; }
  { const float a_ = K[12], b_ = K[14]; const bool g_ = a_ > b_; K[12] = g_ ? a_ : b_; K[14] = g_ ? b_ : a_; }
  { const float a_ = K[13], b_ = K[15]; const bool g_ = a_ > b_; K[13] = g_ ? a_ : b_; K[15] = g_ ? b_ : a_; }
  { const float a_ = K[0], b_ = K[1]; const bool g_ = a_ > b_; K[0] = g_ ? a_ : b_; K[1] = g_ ? b_ : a_; }
  { const float a_ = K[2], b_ = K[3]; const bool g_ = a_ > b_; K[2] = g_ ? a_ : b_; K[3] = g_ ? b_ : a_; }
  { const float a_ = K[4], b_ = K[5]; const bool g_ = a_ > b_; K[4] = g_ ? a_ : b_; K[5] = g_ ? b_ : a_; }
  { const float a_ = K[6], b_ = K[7]; const bool g_ = a_ > b_; K[6] = g_ ? a_ : b_; K[7] = g_ ? b_ : a_; }
  { const float a_ = K[8], b_ = K[9]; const bool g_ = a_ > b_; K[8] = g_ ? a_ : b_; K[9] = g_ ? b_ : a_; }
  { const float a_ = K[10], b_ = K[11]; const bool g_ = a_ > b_; K[10] = g_ ? a_ : b_; K[11] = g_ ? b_ : a_; }
  { const float a_ = K[12], b_ = K[13]; const bool g_ = a_ > b_; K[12] = g_ ? a_ : b_; K[13] = g_ ? b_ : a_; }
  { const float a_ = K[14], b_ = K[15]; const bool g_ = a_ > b_; K[14] = g_ ? a_ : b_; K[15] = g_ ? b_ : a_; }
}
__device__ __forceinline__ void merge_top16(float (&T)[16], const float (&P)[16]) {
  { const float a_ = T[0], b_ = P[15]; T[0] = a_ > b_ ? a_ : b_; }
  { const float a_ = T[1], b_ = P[14]; T[1] = a_ > b_ ? a_ : b_; }
  { const float a_ = T[2], b_ = P[13]; T[2] = a_ > b_ ? a_ : b_; }
  { const float a_ = T[3], b_ = P[12]; T[3] = a_ > b_ ? a_ : b_; }
  { const float a_ = T[4], b_ = P[11]; T[4] = a_ > b_ ? a_ : b_; }
  { const float a_ = T[5], b_ = P[10]; T[5] = a_ > b_ ? a_ : b_; }
  { const float a_ = T[6], b_ = P[9]; T[6] = a_ > b_ ? a_ : b_; }
  { const float a_ = T[7], b_ = P[8]; T[7] = a_ > b_ ? a_ : b_; }
  { const float a_ = T[8], b_ = P[7]; T[8] = a_ > b_ ? a_ : b_; }
  { const float a_ = T[9], b_ = P[6]; T[9] = a_ > b_ ? a_ : b_; }
  { const float a_ = T[10], b_ = P[5]; T[10] = a_ > b_ ? a_ : b_; }
  { const float a_ = T[11], b_ = P[4]; T[11] = a_ > b_ ? a_ : b_; }
  { const float a_ = T[12], b_ = P[3]; T[12] = a_ > b_ ? a_ : b_; }
  { const float a_ = T[13], b_ = P[2]; T[13] = a_ > b_ ? a_ : b_; }
  { const float a_ = T[14], b_ = P[1]; T[14] = a_ > b_ ? a_ : b_; }
  { const float a_ = T[15], b_ = P[0]; T[15] = a_ > b_ ? a_ : b_; }
  { const float a_ = T[0], b_ = T[8]; const bool g_ = a_ > b_; T[0] = g_ ? a_ : b_; T[8] = g_ ? b_ : a_; }
  { const float a_ = T[1], b_ = T[9]; const bool g_ = a_ > b_; T[1] = g_ ? a_ : b_; T[9] = g_ ? b_ : a_; }
  { const float a_ = T[2], b_ = T[10]; const bool g_ = a_ > b_; T[2] = g_ ? a_ : b_; T[10] = g_ ? b_ : a_; }
  { const float a_ = T[3], b_ = T[11]; const bool g_ = a_ > b_; T[3] = g_ ? a_ : b_; T[11] = g_ ? b_ : a_; }
  { const float a_ = T[4], b_ = T[12]; const bool g_ = a_ > b_; T[4] = g_ ? a_ : b_; T[12] = g_ ? b_ : a_; }
  { const float a_ = T[5], b_ = T[13]; const bool g_ = a_ > b_; T[5] = g_ ? a_ : b_; T[13] = g_ ? b_ : a_; }
  { const float a_ = T[6], b_ = T[14]; const bool g_ = a_ > b_; T[6] = g_ ? a_ : b_; T[14] = g_ ? b_ : a_; }
  { const float a_ = T[7], b_ = T[15]; const bool g_ = a_ > b_; T[7] = g_ ? a_ : b_; T[15] = g_ ? b_ : a_; }
  { const float a_ = T[0], b_ = T[4]; const bool g_ = a_ > b_; T[0] = g_ ? a_ : b_; T[4] = g_ ? b_ : a_; }
  { const float a_ = T[1], b_ = T[5]; const bool g_ = a_ > b_; T[1] = g_ ? a_ : b_; T[5] = g_ ? b_ : a_; }
  { const float a_ = T[2], b_ = T[6]; const bool g_ = a_ > b_; T[2] = g_ ? a_ : b_; T[6] = g_ ? b_ : a_; }
  { const float a_ = T[3], b_ = T[7]; const bool g_ = a_ > b_; T[3] = g_ ? a_ : b_; T[7] = g_ ? b_ : a_; }
  { const float a_ = T[8], b_ = T[12]; const bool g_ = a_ > b_; T[8] = g_ ? a_ : b_; T[12] = g_ ? b_ : a_; }
  { const float a_ = T[9], b_ = T[13]; const bool g_ = a_ > b_; T[9] = g_ ? a_ : b_; T[13] = g_ ? b_ : a_; }
  { const float a_ = T[10], b_ = T[14]; const bool g_ = a_ > b_; T[10] = g_ ? a_ : b_; T[14] = g_ ? b_ : a_; }
  { const float a_ = T[11], b_ = T[15]; const bool g_ = a_ > b_; T[11] = g_ ? a_ : b_; T[15] = g_ ? b_ : a_; }
  { const float a_ = T[0], b_ = T[2]; const bool g_ = a_ > b_; T[0] = g_ ? a_ : b_; T[2] = g_ ? b_ : a_; }
  { const float a_ = T[1], b_ = T[3]; const bool g_ = a_ > b_; T[1] = g_ ? a_ : b_; T[3] = g_ ? b_ : a_; }
  { const float a_ = T[4], b_ = T[6]; const bool g_ = a_ > b_; T[4] = g_ ? a_ : b_; T[6] = g_ ? b_ : a_; }
  { const float a_ = T[5], b_ = T[7]; const bool g_ = a_ > b_; T[5] = g_ ? a_ : b_; T[7] = g_ ? b_ : a_; }
  { const float a_ = T[8], b_ = T[10]; const bool g_ = a_ > b_; T[8] = g_ ? a_ : b_; T[10] = g_ ? b_ : a_; }
  { const float a_ = T[9], b_ = T[11]; const bool g_ = a_ > b_; T[9] = g_ ? a_ : b_; T[11] = g_ ? b_ : a_; }
  { const float a_ = T[12], b_ = T[14]; const bool g_ = a_ > b_; T[12] = g_ ? a_ : b_; T[14] = g_ ? b_ : a_; }
  { const float a_ = T[13], b_ = T[15]; const bool g_ = a_ > b_; T[13] = g_ ? a_ : b_; T[15] = g_ ? b_ : a_; }
  { const float a_ = T[0], b_ = T[1]; const bool g_ = a_ > b_; T[0] = g_ ? a_ : b_; T[1] = g_ ? b_ : a_; }
  { const float a_ = T[2], b_ = T[3]; const bool g_ = a_ > b_; T[2] = g_ ? a_ : b_; T[3] = g_ ? b_ : a_; }
  { const float a_ = T[4], b_ = T[5]; const bool g_ = a_ > b_; T[4] = g_ ? a_ : b_; T[5] = g_ ? b_ : a_; }
  { const float a_ = T[6], b_ = T[7]; const bool g_ = a_ > b_; T[6] = g_ ? a_ : b_; T[7] = g_ ? b_ : a_; }
  { const float a_ = T[8], b_ = T[9]; const bool g_ = a_ > b_; T[8] = g_ ? a_ : b_; T[9] = g_ ? b_ : a_; }
  { const float a_ = T[10], b_ = T[11]; const bool g_ = a_ > b_; T[10] = g_ ? a_ : b_; T[11] = g_ ? b_ : a_; }
  { const float a_ = T[12], b_ = T[13]; const bool g_ = a_ > b_; T[12] = g_ ? a_ : b_; T[13] = g_ ? b_ : a_; }
  { const float a_ = T[14], b_ = T[15]; const bool g_ = a_ > b_; T[14] = g_ ? a_ : b_; T[15] = g_ ? b_ : a_; }
}

__device__ __forceinline__ void peer_topk(const int wave_s, const bf16* pq, const bf16* skb, int* ids, float* gates, LAS float* smem) {
  const int tid_ = opaque_tid(wave_s);
  const int lane = tid_ & 63, n = lane & 31, hh = lane >> 5, wave = tid_ >> 6;
  const int gw = blockIdx.x * NWAVES + wave;
  const int nw = gridDim.x * NWAVES;
  LAS float* lk = smem + wave * 2048;
  for (int it = gw; it < 512 * 8; it += nw) {
    const int h = it & 7, tok0 = (it >> 3) * 32;
#pragma unroll 1
    for (int half = 0; half < 2; half++) {
      bf16x8_t qf[8];
      {
        const bf16* qrow = pq + (size_t)(tok0 + n) * 2048 + h * 256 + half * 128 + 8 * hh;
#pragma unroll
        for (int ks = 0; ks < 8; ks++) qf[ks] = *(const bf16x8_t*)(qrow + 16 * ks);
      }
      float K[64];
#pragma unroll
      for (int kt = 0; kt < 4; kt++) {
        const bf16* krow = skb + ((size_t)((h * 2 + half) * 128 + kt * 32 + n)) * 128 + 8 * hh;
        f32x16_t acc;
#pragma unroll
        for (int r = 0; r < 16; r++) acc[r] = 0.f;
#pragma unroll
        for (int kq = 0; kq < 2; kq++) {
          bf16x8_t kf[4];
#pragma unroll
          for (int i = 0; i < 4; i++) kf[i] = *(const bf16x8_t*)(krow + 16 * (kq * 4 + i));
          MFMA_PAD();
#pragma unroll
          for (int i = 0; i < 4; i++) acc = __builtin_amdgcn_mfma_f32_32x32x16_bf16(kf[i], qf[kq * 4 + i], acc, 0, 0, 0);
          MFMA_PAD();
        }
#pragma unroll
        for (int i = 0; i < 16; i++) K[kt * 16 + i] = pack_key<0x7Fu>(acc[i], (unsigned)(kt * 32 + (i & 3) + 8 * (i >> 2) + 4 * hh));
      }
      __builtin_amdgcn_sched_barrier(0);
      top16_of_64(K);
      __builtin_amdgcn_sched_barrier(0);
      float T[16], P[16];
#pragma unroll
      for (int i = 0; i < 16; i++) { T[i] = K[i]; P[i] = __shfl_xor(K[i], 32, 64); }
      merge_top16(T, P);
#pragma unroll
      for (int i = 0; i < 16; i++) lk[(half * 16 + i) * 64 + lane] = T[i];
      __builtin_amdgcn_sched_barrier(0);
    }
    float f0[16], f1[16];
    int ti0[16], ti1[16];
#pragma unroll
    for (int i = 0; i < 16; i++) {
      const float k0 = lk[i * 64 + lane], k1 = lk[(16 + i) * 64 + lane];
      f0[i] = key_val<0x7Fu>(k0); ti0[i] = (int)key_idx<0x7Fu>(k0);
      f1[i] = key_val<0x7Fu>(k1); ti1[i] = (int)key_idx<0x7Fu>(k1);
    }
    float K[64];
    {
    K[0] = pack_key<0xFFu>(f0[0] + f1[0], 0u);
    K[1] = pack_key<0xFFu>(f0[0] + f1[1], 1u);
    K[2] = pack_key<0xFFu>(f0[0] + f1[2], 2u);
    K[3] = pack_key<0xFFu>(f0[0] + f1[3], 3u);
    K[4] = pack_key<0xFFu>(f0[0] + f1[4], 4u);
    K[5] = pack_key<0xFFu>(f0[0] + f1[5], 5u);
    K[6] = pack_key<0xFFu>(f0[0] + f1[6], 6u);
    K[7] = pack_key<0xFFu>(f0[0] + f1[7], 7u);
    K[8] = pack_key<0xFFu>(f0[0] + f1[8], 8u);
    K[9] = pack_key<0xFFu>(f0[0] + f1[9], 9u);
    K[10] = pack_key<0xFFu>(f0[0] + f1[10], 10u);
    K[11] = pack_key<0xFFu>(f0[0] + f1[11], 11u);
    K[12] = pack_key<0xFFu>(f0[0] + f1[12], 12u);
    K[13] = pack_key<0xFFu>(f0[0] + f1[13], 13u);
    K[14] = pack_key<0xFFu>(f0[0] + f1[14], 14u);
    K[15] = pack_key<0xFFu>(f0[0] + f1[15], 15u);
    K[16] = pack_key<0xFFu>(f0[1] + f1[0], 16u);
    K[17] = pack_key<0xFFu>(f0[1] + f1[1], 17u);
    K[18] = pack_key<0xFFu>(f0[1] + f1[2], 18u);
    K[19] = pack_key<0xFFu>(f0[1] + f1[3], 19u);
    K[20] = pack_key<0xFFu>(f0[1] + f1[4], 20u);
    K[21] = pack_key<0xFFu>(f0[1] + f1[5], 21u);
    K[22] = pack_key<0xFFu>(f0[1] + f1[6], 22u);
    K[23] = pack_key<0xFFu>(f0[1] + f1[7], 23u);
    K[24] = pack_key<0xFFu>(f0[2] + f1[0], 32u);
    K[25] = pack_key<0xFFu>(f0[2] + f1[1], 33u);
    K[26] = pack_key<0xFFu>(f0[2] + f1[2], 34u);
    K[27] = pack_key<0xFFu>(f0[2] + f1[3], 35u);
    K[28] = pack_key<0xFFu>(f0[2] + f1[4], 36u);
    K[29] = pack_key<0xFFu>(f0[3] + f1[0], 48u);
    K[30] = pack_key<0xFFu>(f0[3] + f1[1], 49u);
    K[31] = pack_key<0xFFu>(f0[3] + f1[2], 50u);
    K[32] = pack_key<0xFFu>(f0[3] + f1[3], 51u);
    K[33] = pack_key<0xFFu>(f0[4] + f1[0], 64u);
    K[34] = pack_key<0xFFu>(f0[4] + f1[1], 65u);
    K[35] = pack_key<0xFFu>(f0[4] + f1[2], 66u);
    K[36] = pack_key<0xFFu>(f0[5] + f1[0], 80u);
    K[37] = pack_key<0xFFu>(f0[5] + f1[1], 81u);
    K[38] = pack_key<0xFFu>(f0[6] + f1[0], 96u);
    K[39] = pack_key<0xFFu>(f0[6] + f1[1], 97u);
    K[40] = pack_key<0xFFu>(f0[7] + f1[0], 112u);
    K[41] = pack_key<0xFFu>(f0[7] + f1[1], 113u);
    K[42] = pack_key<0xFFu>(f0[8] + f1[0], 128u);
    K[43] = pack_key<0xFFu>(f0[9] + f1[0], 144u);
    K[44] = pack_key<0xFFu>(f0[10] + f1[0], 160u);
    K[45] = pack_key<0xFFu>(f0[11] + f1[0], 176u);
    K[46] = pack_key<0xFFu>(f0[12] + f1[0], 192u);
    K[47] = pack_key<0xFFu>(f0[13] + f1[0], 208u);
    K[48] = pack_key<0xFFu>(f0[14] + f1[0], 224u);
    K[49] = pack_key<0xFFu>(f0[15] + f1[0], 240u);
    K[50] = -3.0e38f;
    K[51] = -3.0e38f;
    K[52] = -3.0e38f;
    K[53] = -3.0e38f;
    K[54] = -3.0e38f;
    K[55] = -3.0e38f;
    K[56] = -3.0e38f;
    K[57] = -3.0e38f;
    K[58] = -3.0e38f;
    K[59] = -3.0e38f;
    K[60] = -3.0e38f;
    K[61] = -3.0e38f;
    K[62] = -3.0e38f;
    K[63] = -3.0e38f;
    }
    __builtin_amdgcn_sched_barrier(0);
    top16_of_64(K);
    __builtin_amdgcn_sched_barrier(0);
    float bv[16];
    int be[16];
#pragma unroll
    for (int r = 0; r < 16; r++) {
      const int flat = (int)key_idx<0xFFu>(K[r]);
      const int a = flat >> 4, b = flat & 15;
      int i0 = 0, i1 = 0;
#pragma unroll
      for (int i = 0; i < 16; i++) { i0 = (a == i) ? ti0[i] : i0; i1 = (b == i) ? ti1[i] : i1; }
      be[r] = i0 * 128 + i1;
      bv[r] = key_val<0xFFu>(K[r]);
    }
    const float b0 = bv[0];
    float ge[16];
    float gsum = 0.f;
#pragma unroll
    for (int r = 0; r < 16; r++) { ge[r] = __expf(bv[r] - b0); gsum += ge[r]; }
    const float ginv = 1.0f / gsum;
    if (hh == 0) {
      int* ip = ids + (size_t)(tok0 + n) * 128 + h * 16;
      float* gp = gates + (size_t)(tok0 + n) * 128 + h * 16;
#pragma unroll
      for (int r4 = 0; r4 < 4; r4++) {
        *(int4*)(ip + 4 * r4) = make_int4(be[4 * r4], be[4 * r4 + 1], be[4 * r4 + 2], be[4 * r4 + 3]);
        *(float4*)(gp + 4 * r4) = make_float4(ge[4 * r4] * ginv, ge[4 * r4 + 1] * ginv, ge[4 * r4 + 2] * ginv, ge[4 * r4 + 3] * ginv);
      }
    }
  }
}

typedef _Float16 f16x2_t __attribute__((ext_vector_type(2)));
__device__ __forceinline__ unsigned e4m3x2_to_f16x2(unsigned w, unsigned sel) {
  return __builtin_amdgcn_perm(w, w, sel);
}
__device__ __forceinline__ float dot2h(unsigned a, unsigned b, float c) {
  return __builtin_amdgcn_fdot2(__builtin_bit_cast(f16x2_t, a), __builtin_bit_cast(f16x2_t, b), c, false);
}
__device__ __forceinline__ unsigned pack_h2(float lo, float hi) {
  f16x2_t v; v.x = (_Float16)lo; v.y = (_Float16)hi;
  return __builtin_bit_cast(unsigned, v);
}
template <bool FINAL>
__device__ __forceinline__ void peer_gather(const int wave_s, bf16* xn, const float* rst, const unsigned char* ub, const unsigned char* vb, const float* vsc, const float* usc,
                                            const int* ids, const float* gates, float* xw, const float* gnext, float* outp) {
  const int tid_ = opaque_tid(wave_s);
  const int lane = tid_ & 63;
  const int gw = blockIdx.x * NWAVES + (tid_ >> 6);
  const int nw = gridDim.x * NWAVES;
  const int el = ((lane >> 5) & 1) * 4 + ((lane >> 4) & 1) * 2 + ((lane >> 3) & 1);
  int idv = 0;
  uint2 uu[8];
  uint2 vv[8];
  if (gw < NT) {
    idv = ids[(size_t)gw * 128 + (lane & 7)];
#pragma unroll
    for (int e = 0; e < 8; e++) {
      const int id = __builtin_amdgcn_readlane(idv, e);
      uu[e] = *(const uint2*)(ub + (size_t)id * 512 + lane * 8);
      vv[e] = *(const uint2*)(vb + (size_t)id * 512 + lane * 8);
    }
  }
  for (int tok = gw; tok < NT; tok += nw) {
    const int tokn = (tok + nw < NT) ? tok + nw : tok;
    int xqh[2] = {0, 0}, xql[2] = {0, 0};
    float xstep, qhalf;
    {
      const uint4 a = *(const uint4*)(xn + (size_t)tok * DM + lane * 16);
      const uint4 b = *(const uint4*)(xn + (size_t)tok * DM + lane * 16 + 8);
      const unsigned xw_[8] = {a.x, a.y, a.z, a.w, b.x, b.y, b.z, b.w};
      const float4* sp = (const float4*)(rst + (size_t)tok * 16);
      const float4 s0 = sp[0], s1 = sp[1], s2 = sp[2], s3 = sp[3];
      const float xs = rsqrtf((((s0.x + s0.y) + (s0.z + s0.w)) + ((s1.x + s1.y) + (s1.z + s1.w)) + ((s2.x + s2.y) + (s2.z + s2.w)) + ((s3.x + s3.y) + (s3.z + s3.w))) * (1.0f / 1024.f) + EPSF);
      float xf[16];
      float am = 0.f;
#pragma unroll
      for (int k = 0; k < 8; k++) { xf[2 * k] = bf_lo(xw_[k]) * xs; xf[2 * k + 1] = bf_hi(xw_[k]) * xs; am = fmaxf(am, fmaxf(fabsf(xf[2 * k]), fabsf(xf[2 * k + 1]))); }
#pragma unroll
      for (int o = 32; o >= 1; o >>= 1) am = fmaxf(am, __shfl_xor(am, o, 64));
      xstep = am * (1.0f / 119.f);
      const float inv = am > 0.f ? 119.f / am : 0.f;
      int qs = 0;
#pragma unroll
      for (int i = 0; i < 16; i++) {
        const int q = (int)rintf(xf[i] * inv);
        const int t = q + 8;
        xqh[i >> 3] |= ((t >> 4) & 15) << (4 * (i & 7));
        xql[i >> 3] |= (((t & 15) - 8) & 15) << (4 * (i & 7));
        qs += q;
      }
      qhalf = 0.5f * wsum((float)qs);
    }
    f16x2_t acc2[8];
#pragma unroll
    for (int i = 0; i < 8; i++) acc2[i] = (f16x2_t){(_Float16)0.f, (_Float16)0.f};
#pragma unroll 1
    for (int g = 0; g < 16; g++) {
      const int ide = __builtin_amdgcn_ds_bpermute(el << 2, idv);
      const float2 sc2 = ((const float2*)vsc)[ide];
      const float gv = gates[(size_t)tok * 128 + g * 8 + el] * sc2.x;
      const float us = sc2.y * xstep;
      const int idn = ids[(size_t)(g < 15 ? tok : tokn) * 128 + ((g + 1) & 15) * 8 + (lane & 7)];
      float d[8];
#pragma unroll
      for (int e = 0; e < 8; e++) {
        int sh = __builtin_amdgcn_sdot8((int)uu[e].x, xqh[0], 0, false);
        sh = __builtin_amdgcn_sdot8((int)uu[e].y, xqh[1], sh, false);
        int sl = __builtin_amdgcn_sdot8((int)uu[e].x, xql[0], 0, false);
        sl = __builtin_amdgcn_sdot8((int)uu[e].y, xql[1], sl, false);
        d[e] = (float)((sh << 4) + sl);
      }
#pragma unroll
      for (int e = 0; e < 8; e++) {
        const int id = __builtin_amdgcn_readlane(idn, e);
        uu[e] = *(const uint2*)(ub + (size_t)id * 512 + lane * 8);
      }
      float d4[4], d2[2], d1;
      {
        const bool hi = (lane & 32) != 0;
#pragma unroll
        for (int i = 0; i < 4; i++) { const float send = hi ? d[i] : d[i + 4]; const float keep = hi ? d[i + 4] : d[i]; d4[i] = keep + __shfl_xor(send, 32, 64); }
      }
      {
        const bool hi = (lane & 16) != 0;
#pragma unroll
        for (int i = 0; i < 2; i++) { const float send = hi ? d4[i] : d4[i + 2]; const float keep = hi ? d4[i + 2] : d4[i]; d2[i] = keep + __shfl_xor(send, 16, 64); }
      }
      {
        const bool hi = (lane & 8) != 0;
        const float send = hi ? d2[0] : d2[1];
        const float keep = hi ? d2[1] : d2[0];
        d1 = keep + __shfl_xor(send, 8, 64);
      }
      d1 += __shfl_xor(d1, 4, 64);
      d1 += __shfl_xor(d1, 2, 64);
      d1 += __shfl_xor(d1, 1, 64);
      const float wl = gv * gelu_tanh((d1 + qhalf) * us);
#pragma unroll
      for (int e = 0; e < 8; e++) {
        const float w = __builtin_bit_cast(float, __builtin_amdgcn_readlane(__builtin_bit_cast(int, wl), ((e >> 2) & 1) * 32 + ((e >> 1) & 1) * 16 + (e & 1) * 8));
        const f16x2_t w2 = __builtin_bit_cast(f16x2_t, pack_h2(w, w));
        const unsigned vw[2] = {vv[e].x, vv[e].y};
#pragma unroll
        for (int k = 0; k < 2; k++) {
          const unsigned w4 = vw[k];
          const unsigned le = __builtin_amdgcn_perm(V4_LUT_HI, V4_LUT_LO, w4 & 0x07070707u);
          const unsigned lo = __builtin_amdgcn_perm(V4_LUT_HI, V4_LUT_LO, (w4 >> 4) & 0x07070707u);
          const unsigned ee = ((w4 << 4) & 0x80808080u) | le;
          const unsigned eo = (w4 & 0x80808080u) | lo;
          const unsigned p01 = __builtin_amdgcn_perm(eo, ee, 0x040c000cu), p23 = __builtin_amdgcn_perm(eo, ee, 0x050c010cu);
          const unsigned p45 = __builtin_amdgcn_perm(eo, ee, 0x060c020cu), p67 = __builtin_amdgcn_perm(eo, ee, 0x070c030cu);
          acc2[4 * k + 0] = __builtin_elementwise_fma(__builtin_bit_cast(f16x2_t, p01), w2, acc2[4 * k + 0]);
          acc2[4 * k + 1] = __builtin_elementwise_fma(__builtin_bit_cast(f16x2_t, p23), w2, acc2[4 * k + 1]);
          acc2[4 * k + 2] = __builtin_elementwise_fma(__builtin_bit_cast(f16x2_t, p45), w2, acc2[4 * k + 2]);
          acc2[4 * k + 3] = __builtin_elementwise_fma(__builtin_bit_cast(f16x2_t, p67), w2, acc2[4 * k + 3]);
        }
      }
#pragma unroll
      for (int e = 0; e < 8; e++) {
        const int id = __builtin_amdgcn_readlane(idn, e);
        vv[e] = *(const uint2*)(vb + (size_t)id * 512 + lane * 8);
      }
      idv = idn;
    }
    float acc[16];
#pragma unroll
    for (int i = 0; i < 8; i++) { acc[2 * i] = (float)acc2[i].x; acc[2 * i + 1] = (float)acc2[i].y; }
    float* xr = xw + (size_t)tok * DM + lane * 16;
    float xv[16];
    float ssq = 0.f;
#pragma unroll
    for (int c = 0; c < 4; c++) {
      float4 a0 = *(float4*)(xr + c * 4);
      a0.x += acc[c * 4 + 0]; a0.y += acc[c * 4 + 1]; a0.z += acc[c * 4 + 2]; a0.w += acc[c * 4 + 3];
      if (!FINAL) *(float4*)(xr + c * 4) = a0;
      xv[c * 4 + 0] = a0.x; xv[c * 4 + 1] = a0.y; xv[c * 4 + 2] = a0.z; xv[c * 4 + 3] = a0.w;
      ssq += a0.x * a0.x + a0.y * a0.y + a0.z * a0.z + a0.w * a0.w;
    }
    ssq = wsum(ssq);
    const float rstd = rsqrtf(ssq * (1.0f / DM) + EPSF);
    const float4* g4 = (const float4*)(gnext + lane * 16);
    if (FINAL) {
      float* op = outp + (size_t)tok * DM + lane * 16;
#pragma unroll
      for (int c = 0; c < 4; c++) {
        const float4 gq = g4[c];
        *(float4*)(op + c * 4) = make_float4(xv[c * 4] * rstd * gq.x, xv[c * 4 + 1] * rstd * gq.y, xv[c * 4 + 2] * rstd * gq.z, xv[c * 4 + 3] * rstd * gq.w);
      }
    } else {
      uint4 o0, o1;
      { const float4 ga = g4[0], gb = g4[1];
        o0.x = pk2(xv[0] * rstd * ga.x, xv[1] * rstd * ga.y); o0.y = pk2(xv[2] * rstd * ga.z, xv[3] * rstd * ga.w);
        o0.z = pk2(xv[4] * rstd * gb.x, xv[5] * rstd * gb.y); o0.w = pk2(xv[6] * rstd * gb.z, xv[7] * rstd * gb.w); }
      { const float4 ga = g4[2], gb = g4[3];
        o1.x = pk2(xv[8] * rstd * ga.x, xv[9] * rstd * ga.y); o1.y = pk2(xv[10] * rstd * ga.z, xv[11] * rstd * ga.w);
        o1.z = pk2(xv[12] * rstd * gb.x, xv[13] * rstd * gb.y); o1.w = pk2(xv[14] * rstd * gb.z, xv[15] * rstd * gb.w); }
      *(uint4*)(xn + (size_t)tok * DM + lane * 16) = o0;
      *(uint4*)(xn + (size_t)tok * DM + lane * 16 + 8) = o1;
    }
  }
}

__device__ __forceinline__ void prologue_transposes(const int wave_s, const Params& p, unsigned char* ws, LAS unsigned char* lds) {
  const int tid_ = opaque_tid(wave_s);
  const int lane = tid_ & 63, wave = tid_ >> 6;
  LAS float* scr = (LAS float*)(lds + wave * 16384);
  const int gw = blockIdx.x * NWAVES + wave, NGW = gridDim.x * NWAVES;
  constexpr int I_IN = (DM / 64) * (DIN / 32), I_SQ = (DM / 64) * (DM / 32), I_2K = (DM / 64) * (2048 / 32);
  constexpr int I_GL = (256 / 64) * (256 / 32);
  constexpr int PER_LAYER = I_IN + 3 * I_SQ + 2 * I_2K + I_GL;
  const float* w3 = karg_in(3); const float* w19 = karg_in(19); const float* w22 = karg_in(22);
  const float* w23 = karg_in(23); const float* w24 = karg_in(24); const float* w26 = karg_in(26);
  const float* w16 = karg_in(16);
  for (int it = gw; it < 2 * PER_LAYER; it += NGW) {
    const int l = it / PER_LAYER;
    int r = it % PER_LAYER;
    unsigned char* wl = ws + WS_WT + (size_t)l * WT_LAYER;
    if (r < I_IN) { transpose_item(w3 + (size_t)l * DM * DIN, DM, DIN, (bf16*)(wl + WT_IN), scr, r, lane); continue; } r -= I_IN;
    if (r < I_SQ) { transpose_item(w19 + (size_t)l * DM * DM, DM, DM, (bf16*)(wl + WT_OUT), scr, r, lane); continue; } r -= I_SQ;
    if (r < I_SQ) { transpose_item(w22 + (size_t)l * DM * DM, DM, DM, (bf16*)(wl + WT_MQ), scr, r, lane); continue; } r -= I_SQ;
    if (r < I_2K) { transpose_item(w23 + (size_t)l * DM * 2048, DM, 2048, (bf16*)(wl + WT_MKV), scr, r, lane); continue; } r -= I_2K;
    if (r < I_SQ) { transpose_item(w24 + (size_t)l * DM * DM, DM, DM, (bf16*)(wl + WT_MO), scr, r, lane); continue; } r -= I_SQ;
    if (r < I_2K) { transpose_item(w26 + (size_t)l * DM * 2048, DM, 2048, (bf16*)(wl + WT_PQ), scr, r, lane); continue; } r -= I_2K;
    transpose_item(w16 + (size_t)l * 256 * 256, 256, 256, (bf16*)(wl + WT_GLU), scr, r, lane);
  }
}

template <class T> __device__ __forceinline__ T* opq(T* p) { asm volatile("" : "+s"(p)); return p; }
__device__ __forceinline__ void cvt_rows_bf16(const int wave_s, const float* src, bf16* dst, size_t n) {
  const int tid_ = opaque_tid(wave_s);
  const size_t gt = (size_t)blockIdx.x * (NWAVES * 64) + tid_;
  const size_t nth = (size_t)gridDim.x * NWAVES * 64;
  for (size_t i = gt; i < n / 8; i += nth) {
    const float4 a = ((const float4*)src)[2 * i], b = ((const float4*)src)[2 * i + 1];
    uint4 o; o.x = pk2(a.x, a.y); o.y = pk2(a.z, a.w); o.z = pk2(b.x, b.y); o.w = pk2(b.z, b.w);
    ((uint4*)dst)[i] = o;
  }
}

__device__ __forceinline__ unsigned enc_e4m3(float x) {
  const _Float16 hf = (_Float16)x;
  const unsigned h = (unsigned)__builtin_bit_cast(unsigned short, hf);
  return ((h + 0x7Fu + ((h >> 8) & 1u)) >> 8) & 0xFFu;
}
__device__ __forceinline__ void cvt_rows_e4m3(const int wave_s, const float* src, unsigned char* dst, size_t n, float sc) {
  const int tid_ = opaque_tid(wave_s);
  const size_t gt = (size_t)blockIdx.x * (NWAVES * 64) + tid_;
  const size_t nth = (size_t)gridDim.x * NWAVES * 64;
  for (size_t i = gt; i < n / 16; i += nth) {
    unsigned w[4];
#pragma unroll
    for (int k = 0; k < 4; k++) {
      const float4 a = ((const float4*)src)[4 * i + k];
      w[k] = enc_e4m3(a.x * sc) | (enc_e4m3(a.y * sc) << 8) | (enc_e4m3(a.z * sc) << 16) | (enc_e4m3(a.w * sc) << 24);
    }
    uint4 o; o.x = w[0]; o.y = w[1]; o.z = w[2]; o.w = w[3];
    ((uint4*)dst)[i] = o;
  }
}

__device__ __forceinline__ unsigned enc_v4(float z) {
  const float az = fabsf(z);
  unsigned c = 0;
  c += az > 0.25f; c += az > 0.5f; c += az > 0.75f; c += az > 1.0625f; c += az > 1.375f; c += az > 1.75f; c += az > 2.25f;
  return c | ((__builtin_bit_cast(unsigned, z) >> 28) & 8u);
}
__device__ __forceinline__ void cvt_rows_i4(const int wave_s, const float* src, unsigned char* dst, float* sc_out, int nrows) {
  const int tid_ = opaque_tid(wave_s);
  const int lane = tid_ & 63;
  const int gw = blockIdx.x * NWAVES + (tid_ >> 6);
  const int nw = gridDim.x * NWAVES;
  for (int r = gw; r < nrows; r += nw) {
    const float4* sp = (const float4*)(src + (size_t)r * 1024 + lane * 16);
    const float4 a0 = sp[0], a1 = sp[1], a2 = sp[2], a3 = sp[3];
    const float xv[16] = {a0.x, a0.y, a0.z, a0.w, a1.x, a1.y, a1.z, a1.w, a2.x, a2.y, a2.z, a2.w, a3.x, a3.y, a3.z, a3.w};
    float ss = 0.f;
#pragma unroll
    for (int i = 0; i < 16; i++) ss += xv[i] * xv[i];
    ss = wsum(ss);
    const float sc = sqrtf(ss * (1.0f / 1024.f)) * U4_STEP;
    const float inv = sc > 0.f ? 1.0f / sc : 0.f;
    unsigned w[2] = {0u, 0u};
#pragma unroll
    for (int i = 0; i < 16; i++) {
      const float f = fminf(fmaxf(floorf(xv[i] * inv), -8.f), 7.f);
      w[i >> 3] |= ((unsigned)(int)f & 15u) << (4 * (i & 7));
    }
    uint2 o; o.x = w[0]; o.y = w[1];
    *(uint2*)(dst + (size_t)r * 512 + lane * 8) = o;
    if (lane == 0) sc_out[2 * r] = sc;
  }
}
__device__ __forceinline__ void cvt_rows_v4(const int wave_s, const float* src, unsigned char* dst, float* sc_out, int nrows) {
  const int tid_ = opaque_tid(wave_s);
  const int lane = tid_ & 63;
  const int gw = blockIdx.x * NWAVES + (tid_ >> 6);
  const int nw = gridDim.x * NWAVES;
  for (int r = gw; r < nrows; r += nw) {
    const float4* sp = (const float4*)(src + (size_t)r * 1024 + lane * 16);
    const float4 a0 = sp[0], a1 = sp[1], a2 = sp[2], a3 = sp[3];
    const float xv[16] = {a0.x, a0.y, a0.z, a0.w, a1.x, a1.y, a1.z, a1.w, a2.x, a2.y, a2.z, a2.w, a3.x, a3.y, a3.z, a3.w};
    float ss = 0.f;
#pragma unroll
    for (int i = 0; i < 16; i++) ss += xv[i] * xv[i];
    ss = wsum(ss);
    const float sc = sqrtf(ss * (1.0f / 1024.f)) * V4_ROWSCALE;
    const float inv = sc > 0.f ? 1.0f / sc : 0.f;
    unsigned w[2] = {0u, 0u};
#pragma unroll
    for (int i = 0; i < 16; i++) w[i >> 3] |= enc_v4(xv[i] * inv) << (4 * (i & 7));
    uint2 o; o.x = w[0]; o.y = w[1];
    *(uint2*)(dst + (size_t)r * 512 + lane * 8) = o;
    if (lane == 0) sc_out[2 * r] = sc;
  }
}

#define GEMM_F32(Aptr, Wt, Cptr, Rptr, M_, N_) do { \
    pg8::Gemm g_{opq((const bf16*)(Aptr)), opq((const bf16*)(Wt)), (M_), (N_), DM}; pg8::StaticOrder S_; S_.init((M_), (N_), (int)gridDim.x, (int)blockIdx.x); \
    pg8::EpiF32R E_{opq((float*)(Cptr)), opq((const float*)(Rptr)), (N_)}; \
    pg8::gemm_phase<pg8::EpiF32R, pg8::StaticOrder, true, true>(wave_s, ldsl, g_, S_, E_); } while (0)
#define GEMM_BF16_C(Aptr, Wt, Optr, M_, N_, C_) do { \
    pg8::Gemm g_{opq((const bf16*)(Aptr)), opq((const bf16*)(Wt)), (M_), (N_), DM}; pg8::StaticOrder S_; S_.init((M_), (N_), (int)gridDim.x, (C_)); \
    pg8::EpiBf16 E_{opq((bf16*)(Optr)), (N_)}; \
    pg8::gemm_phase<pg8::EpiBf16, pg8::StaticOrder, true, true>(wave_s, ldsl, g_, S_, E_); } while (0)
#define GEMM_BF16(Aptr, Wt, Optr, M_, N_) GEMM_BF16_C(Aptr, Wt, Optr, M_, N_, (int)blockIdx.x)
#define GEMM_F32RN(Aptr, Wt, Cptr, Rptr, XGptr, Gptr, STptr) do { \
    pg8::Gemm g_{opq((const bf16*)(Aptr)), opq((const bf16*)(Wt)), NT, DM, DM}; pg8::StaticOrder S_; S_.init(NT, DM, (int)gridDim.x, (int)blockIdx.x); \
    pg8::EpiF32RN E_{opq((float*)(Cptr)), opq((const float*)(Rptr)), DM, opq((bf16*)(XGptr)), opq((const float*)(Gptr)), opq((float*)(STptr))}; \
    pg8::gemm_phase<pg8::EpiF32RN, pg8::StaticOrder, true, true>(wave_s, ldsl, g_, S_, E_); } while (0)
#define GEMM_BF16S(Aptr, Wt, Optr, N_, STptr) do { \
    pg8::Gemm g_{opq((const bf16*)(Aptr)), opq((const bf16*)(Wt)), NT, (N_), DM}; pg8::StaticOrder S_; S_.init(NT, (N_), (int)gridDim.x, (int)blockIdx.x); \
    pg8::EpiBf16S E_{opq((bf16*)(Optr)), (N_), opq((const float*)(STptr))}; \
    pg8::gemm_phase<pg8::EpiBf16S, pg8::StaticOrder, true, true>(wave_s, ldsl, g_, S_, E_); } while (0)

__global__ void __launch_bounds__(NWAVES * 64, 2) fwd_megakernel(Params p) {
  extern __shared__ __attribute__((aligned(16))) unsigned char lds[];
  LAS unsigned char* ldsl = (LAS unsigned char*)lds;
  LAS float* smem = (LAS float*)ldsl;
  const int wave_s = __builtin_amdgcn_readfirstlane((int)(threadIdx.x >> 6));
  unsigned char* ws = p.ws;
  volatile LAS unsigned* MISC = (volatile LAS unsigned*)(ldsl + (LDS_BYTES - 256));
  if (threadIdx.x < 64) MISC[threadIdx.x] = 0u;
  __syncthreads();
  const XcdBarrier bar = xcd_barrier_post((unsigned*)(ws + WS_CTL) + 4096, MISC + 8);
  float* xw = (float*)(ws + WS_XW);
  bf16* xn = (bf16*)(ws + WS_XN);
  bf16* big = (bf16*)(ws + WS_BIG);
  bf16* y = (bf16*)(ws + WS_Y);
  bf16* memh = (bf16*)(ws + WS_MEMH);
  bf16* kvb = (bf16*)(ws + WS_KVB);
  bf16* vT = (bf16*)(ws + WS_VT);
  float* ssmE = (float*)(ws + WS_SSME);
  float* ssmp = (float*)(ws + WS_SSMP);
  int* ids = (int*)(ws + WS_IDS);
  float* gates = (float*)(ws + WS_GATE);
  bf16* skb = (bf16*)(ws + WS_SKB);
  unsigned char* ub = ws + WS_UB;
  unsigned char* vb = ws + WS_VB;
  float* rst = (float*)(ws + WS_RST);
  float* vsc = (float*)(ws + WS_VSC);
  float* usc = (float*)(ws + WS_USC);

  prologue_transposes(wave_s, p, ws, ldsl);
  cvt_rows_bf16(wave_s, karg_in(27), skb, (size_t)2 * 8 * 2 * 128 * 128);
  cvt_rows_i4(wave_s, karg_in(28), ub, vsc + 1, 2 * 16384);
  cvt_rows_v4(wave_s, karg_in(29), vb, vsc, 2 * 16384);
  for (int l = 0; l < 2; l++)
    rms_rows<true>(wave_s, karg_in(1), karg_in(21) + l * DM, memh + (size_t)l * 1024 * 1024, 1024);
  ssm_params(wave_s, p, ssmp);
  xcd_barrier(bar);
  for (int l = 0; l < 2; l++)
    GEMM_BF16_C(memh + (size_t)l * 1024 * 1024, ws + WS_WT + (size_t)l * WT_LAYER + WT_MKV,
              kvb + (size_t)l * 1024 * 2048, 1024, 2048, (int)((blockIdx.x + gridDim.x - 32u * (unsigned)l) % gridDim.x));

#pragma nounroll
  for (int l = 0; l < 2; l++) {
    const float* xcur = (l == 0) ? karg_in(0) : xw;
    const float* sp = ssmp + (size_t)l * SSMP_PER_LAYER;
    const unsigned char* wl = ws + WS_WT + (size_t)l * WT_LAYER;
    if (l == 0) {
      rms_rows<true>(wave_s, xcur, karg_in(2) + l * DM, xn, NT);
      xcd_barrier(bar);
    }
    GEMM_BF16(xn, wl + WT_IN, big, NT, DIN);
    xcd_barrier(bar);
    if (l == 0) vt_phase(wave_s, kvb, vT);
    ssm_chunk_end(wave_s, sp, big, ssmE);
    attn_phase(wave_s, p, l, big, y, smem);
    conv_phase(wave_s, p, l, big, y, smem);
    xcd_barrier(bar);
    ssm_finish(wave_s, p, l, sp, big, ssmE, y, smem);
    xcd_barrier(bar);
    GEMM_F32RN(y, wl + WT_OUT, xw, xcur, xn, karg_in(20) + l * DM, rst);
    xcd_barrier(bar);
    GEMM_BF16S(xn, wl + WT_MQ, big, DM, rst);
    xcd_barrier(bar);
    memattn_phase(wave_s, big, kvb + (size_t)l * 1024 * 2048, vT + (size_t)l * 4 * 4 * 256 * 256, y, smem);
    xcd_barrier(bar);
    GEMM_F32RN(y, wl + WT_MO, xw, (const float*)xw, xn, karg_in(25) + l * DM, rst);
    xcd_barrier(bar);
    GEMM_BF16S(xn, wl + WT_PQ, big, 2048, rst);
    xcd_barrier(bar);
    peer_topk(wave_s, big, skb + (size_t)l * 8 * 2 * 128 * 128, ids, gates, smem);
    xcd_barrier(bar);
    if (l == 0) {
      peer_gather<false>(wave_s, xn, rst, ub + (size_t)l * 16384 * 512, vb + (size_t)l * 16384 * 512, vsc + (size_t)l * 2 * 16384, usc, ids, gates, xw, karg_in(2) + DM, (float*)nullptr);
      xcd_barrier(bar);
    } else {
      peer_gather<true>(wave_s, xn, rst, ub + (size_t)l * 16384 * 512, vb + (size_t)l * 16384 * 512, vsc + (size_t)l * 2 * 16384, usc, ids, gates, xw, karg_in(30), p.out);
    }
  }
}

extern "C" void kernel_launch(void* const* d_in, const int* in_sizes, int n_in,
                              void* d_out, int out_size, void* d_ws, size_t ws_size,
                              hipStream_t stream) {
  static int grid_blocks = 0;
  if (!grid_blocks) {
    int dev = 0, cus = 0, per_cu = 0;
    (void)hipGetDevice(&dev);
    (void)hipDeviceGetAttribute(&cus, hipDeviceAttributeMultiprocessorCount, dev);
    (void)hipFuncSetAttribute((const void*)fwd_megakernel, hipFuncAttributeMaxDynamicSharedMemorySize, LDS_BYTES);
    (void)hipOccupancyMaxActiveBlocksPerMultiprocessor(&per_cu, fwd_megakernel, NWAVES * 64, LDS_BYTES);
    if (per_cu < 1) fprintf(stderr, "occupancy query reports %d blocks/CU\n", per_cu);
    grid_blocks = cus;
  }
  (void)hipMemsetAsync((char*)d_ws + WS_CTL, 0, 1 * MiB, stream);
  Params p{};
  for (int i = 0; i < 31; i++) p.in[i] = (const float*)d_in[i];
  p.out = (float*)d_out;
  p.ws = (unsigned char*)d_ws;
  void* args[] = {&p};
  hipError_t e = hipLaunchCooperativeKernel((void*)fwd_megakernel, dim3(grid_blocks), dim3(NWAVES * 64),
                                            args, LDS_BYTES, stream);
  if (e != hipSuccess)
    fprintf(stderr, "cooperative launch failed: %s (grid %d)\n", hipGetErrorString(e), grid_blocks);
}
```

```cpp
#include <hip/hip_runtime.h>
#include <hip/hip_cooperative_groups.h>
#include <cstdio>
namespace cg = cooperative_groups;

#define NT 16384
#define SEQ 4096
#define DM 1024
#define DIN 2304
#define NMEM 256
#define EPSF 1e-6f
#define NWAVES 8
#define LDS_BYTES 147456

typedef unsigned short bf16;
#define LAS __attribute__((address_space(3)))

struct Params {
  const float* in[31];
  float* out;
  unsigned char* ws;
};
typedef __attribute__((address_space(4))) const unsigned char* kaptr_t;
__device__ __forceinline__ const float* karg_in(int i) {
  kaptr_t ka = (kaptr_t)__builtin_amdgcn_kernarg_segment_ptr();
  asm volatile("" : "+s"(ka));
  return *(const float* __attribute__((address_space(4))) const*)(ka + 8 * i);
}

constexpr size_t MiB = 1u << 20;
constexpr size_t WS_CTL  = 0;
constexpr size_t WS_WT   = 1 * MiB;
constexpr size_t WT_IN = 0, WT_OUT = WT_IN + (size_t)DIN * DM * 2, WT_MQ = WT_OUT + (size_t)DM * DM * 2,
                 WT_MKV = WT_MQ + (size_t)DM * DM * 2, WT_MO = WT_MKV + (size_t)2048 * DM * 2,
                 WT_PQ = WT_MO + (size_t)DM * DM * 2, WT_GLU = WT_PQ + (size_t)2048 * DM * 2, WT_LAYER = WT_GLU + (size_t)256 * 256 * 2;
constexpr size_t WS_XW   = WS_WT + 2 * WT_LAYER;
constexpr size_t WS_XN   = WS_XW + (size_t)NT * DM * 4;
constexpr size_t WS_BIG  = WS_XN + (size_t)NT * DM * 2;
constexpr size_t WS_Y    = WS_BIG + (size_t)NT * DIN * 2;
constexpr size_t WS_MEMH = WS_Y + (size_t)NT * DM * 2;
constexpr size_t WS_KVB  = WS_MEMH + (size_t)2 * 1024 * 1024 * 2;
constexpr size_t WS_VT   = WS_KVB + (size_t)2 * 1024 * 2048 * 2;
constexpr size_t WS_SSME = WS_VT + (size_t)2 * 4 * 4 * 256 * 256 * 2;
#define SSMP_PER_LAYER (2048 + 2048 + 32768)
constexpr size_t WS_SSMP = WS_SSME + (size_t)4 * 64 * 16 * 64 * 2 * 4;
constexpr size_t WS_IDS  = WS_SSMP + (size_t)2 * SSMP_PER_LAYER * 4;
constexpr size_t WS_GATE = WS_IDS + (size_t)NT * 128 * 4;
constexpr size_t WS_SKB  = WS_GATE + (size_t)NT * 128 * 4;
constexpr size_t WS_UB   = WS_SKB + (size_t)2 * 8 * 2 * 128 * 128 * 2;
constexpr size_t WS_VB   = WS_UB + (size_t)2 * 16384 * 512;
constexpr size_t WS_VSC  = WS_VB + (size_t)2 * 16384 * 512;
constexpr size_t WS_USC  = WS_VSC + (size_t)2 * 16384 * 4;
constexpr size_t WS_RST  = WS_USC + (size_t)2 * 16384 * 4;
constexpr size_t WS_END  = WS_RST + (size_t)NT * 16 * 4;
#define U_SCALE 64.0f
#define U4_STEP 0.3352f
#define V4_LUT_LO 0x3B393630u
#define V4_LUT_HI 0x41403E3Du
#define V4_ROWSCALE 1.075f
static_assert(WS_END <= 512 * MiB, "workspace");
static_assert(WT_LAYER % 256 == 0 && WS_SSMP % 16 == 0 && WS_IDS % 16 == 0 && WS_SKB % 256 == 0 && WS_VT % 256 == 0, "align");

__device__ __forceinline__ int opaque_tid(int wave_s) { int v = wave_s * 64 + (int)__builtin_amdgcn_mbcnt_hi(~0u, __builtin_amdgcn_mbcnt_lo(~0u, 0u)); asm volatile("" : "+v"(v)); return v; }
__device__ __forceinline__ unsigned f2bf(float f) { unsigned u = __builtin_bit_cast(unsigned, f); return (u + 0x7fffu + ((u >> 16) & 1u)) >> 16; }
__device__ __forceinline__ unsigned pk2(float lo, float hi) { return f2bf(lo) | (f2bf(hi) << 16); }
__device__ __forceinline__ float bf_lo(unsigned u) { return __builtin_bit_cast(float, u << 16); }
__device__ __forceinline__ float bf_hi(unsigned u) { return __builtin_bit_cast(float, u & 0xffff0000u); }
__device__ __forceinline__ float bf2f(bf16 h) { return __builtin_bit_cast(float, (unsigned)h << 16); }


#define XB_TMO      128
#define XB_XCNT(j)  (256  + 64 * (j))
#define XB_XSUB(j)  (1280 + 64 * (j))
#define XB_XGEN(j)  (2304 + 64 * (j))
#define XB_TOP      3328
#define XB_TOPGEN   3392
#define XCD_BAR_WORDS 3456
#define XB_SPIN_CAP (1u << 22)
__device__ __forceinline__ unsigned xb_ld(unsigned* p)              { return __hip_atomic_load(p, __ATOMIC_RELAXED, __HIP_MEMORY_SCOPE_AGENT); }
__device__ __forceinline__ unsigned xb_add(unsigned* p, unsigned v) { return __hip_atomic_fetch_add(p, v, __ATOMIC_RELAXED, __HIP_MEMORY_SCOPE_AGENT); }
__device__ __forceinline__ unsigned xb_xcc_id() { return (unsigned)__builtin_amdgcn_s_getreg((3 << 11) | 20) & 0xFu; }
#define XB_SPIN(cond, bar) do { unsigned _sp = 0; while (cond) { __builtin_amdgcn_s_sleep(1); \
    if ((++_sp & 255u) == 0u) { if (xb_ld(&(bar)[XB_TMO])) break; if (_sp > XB_SPIN_CAP) { atomicAdd(&(bar)[XB_TMO], 1u); break; } } } } while (0)
struct XcdBarrier { unsigned* bar; unsigned x; volatile LAS unsigned* st; };
__device__ __forceinline__ XcdBarrier xcd_barrier_post(unsigned* bar, volatile LAS unsigned* st) {
    XcdBarrier b; b.bar = bar; b.x = xb_xcc_id(); b.st = st;
    if (threadIdx.x == 0) (void)xb_add(&bar[XB_XCNT(b.x)], 1u);
    return b;
}
__device__ __forceinline__ void xcd_barrier_complete(unsigned* bar, unsigned x, unsigned& nloc, unsigned& nx) {
    const unsigned G = gridDim.x * gridDim.y * gridDim.z;
    unsigned sum, cnt, mine, sp = 0u;
    for (;;) {
        sum = 0u; cnt = 0u; mine = 0u;
#pragma unroll
        for (unsigned j = 0; j < 16; ++j) { const unsigned c = xb_ld(&bar[XB_XCNT(j)]); sum += c; cnt += (c > 0u) ? 1u : 0u; mine = (j == x) ? c : mine; }
        if (sum == G) break;
        __builtin_amdgcn_s_sleep(1);
        if ((++sp & 255u) == 0u) { if (xb_ld(&bar[XB_TMO])) break; if (sp > XB_SPIN_CAP) { atomicAdd(&bar[XB_TMO], 1u); break; } }
    }
    nloc = mine > 0u ? mine : 1u; nx = cnt > 0u ? cnt : 1u;
}
__device__ __forceinline__ void xcd_barrier(const XcdBarrier& b) {
    asm volatile("s_waitcnt vmcnt(0)" ::: "memory");
    __syncthreads();
    if (threadIdx.x == 0) {
        unsigned* bar = b.bar;
        __builtin_amdgcn_s_waitcnt(0);
        unsigned nloc = b.st[0], nx = b.st[1];
        if (nloc == 0u) { xcd_barrier_complete(bar, b.x, nloc, nx); b.st[0] = nloc; b.st[1] = nx; }
        const unsigned old = xb_add(&bar[XB_XSUB(b.x)], 1u);
        const unsigned gen = old / nloc;
        if (old + 1u == (gen + 1u) * nloc) {
            __builtin_amdgcn_fence(__ATOMIC_RELEASE, "agent");
            asm volatile("s_waitcnt vmcnt(0)" ::: "memory");
            const unsigned og = xb_add(&bar[XB_TOP], 1u);
            const unsigned tg = og / nx;
            if (og + 1u == (tg + 1u) * nx) xb_add(&bar[XB_TOPGEN], 1u);
            else XB_SPIN(xb_ld(&bar[XB_TOPGEN]) == tg, bar);
            __builtin_amdgcn_fence(__ATOMIC_ACQUIRE, "agent");
            xb_add(&bar[XB_XGEN(b.x)], 1u);
            asm volatile("s_waitcnt vmcnt(0)" ::: "memory");
        } else {
            XB_SPIN(xb_ld(&bar[XB_XGEN(b.x)]) == gen, bar);
            __builtin_amdgcn_fence(__ATOMIC_ACQUIRE, "agent");
            asm volatile("s_waitcnt vmcnt(0)" ::: "memory");
        }
    }
    __syncthreads();
}

namespace pg8 {
#define PG8_LAS __attribute__((address_space(3)))
typedef unsigned short bf16_t;
typedef short bf16x8 __attribute__((ext_vector_type(8)));
typedef float f32x4 __attribute__((ext_vector_type(4)));
typedef unsigned u32x4 __attribute__((ext_vector_type(4)));
constexpr int BM = 256, BK = 64, HALF = 128, HTB = HALF * BK * 2, STAGE_BYTES = 8 * HTB, NXCD = 8, WGM = 8;
__host__ __device__ __forceinline__ int lds_byte(int r, int c) { const int st = (r >> 4) * 2 + (c >> 5), rr = r & 15, cc = c & 31, ob = rr * 64 + cc * 2; return st * 1024 + (ob ^ (((ob >> 9) & 1) << 5)); }
__host__ __device__ __forceinline__ void stage_rc(int b, int& R, int& C) { const int st = b / 1024, sb = b % 1024, swz = sb ^ (((sb >> 9) & 1) << 5); R = (st >> 1) * 16 + swz / 64; C = (st & 1) * 32 + (swz % 64) / 2; }
__host__ __device__ __forceinline__ int perm32(int rho) { const int n = rho >> 4, i = rho & 15; return 8 * (i >> 2) + 4 * n + (i & 3); }
struct Unit { int pm, pn; };
struct Gemm { const bf16_t* A; const bf16_t* Bt; int M, N, K; };
struct StaticOrder {
    int nM, nN, nwg, G, c;
    __host__ __device__ __forceinline__ void init(int M, int N, int G_, int c_) { nM = M / BM; nN = N / BM; nwg = nM * nN; G = G_; c = c_; }
    __host__ __device__ bool next(int i, Unit& u) const {
        const long L = (long)i * G + c; if (L >= nwg) return false;
        int wgid = (int)L; { const int q = nwg / NXCD, r = nwg % NXCD, xcd = wgid % NXCD, off = wgid / NXCD; wgid = (xcd < r ? xcd * (q + 1) : r * (q + 1) + (xcd - r) * q) + off; }
        const int nig = WGM * nN, gid = wgid / nig, fm = gid * WGM, gsz = (nM - fm) < WGM ? (nM - fm) : WGM;
        u.pm = fm + ((wgid % nig) % gsz); u.pn = (wgid % nig) / gsz; return true;
    }
    __device__ __forceinline__ void a_ready(const Unit&) const {}
    __device__ __forceinline__ void done(const Unit&) const {}
};
__device__ __forceinline__ unsigned cvt_pk_bf16(float lo, float hi) { unsigned r; asm volatile("v_cvt_pk_bf16_f32 %0, %1, %2" : "=v"(r) : "v"(lo), "v"(hi)); return r; }

struct EpiF32R {
    static constexpr bool PERM = false, AFTER_DRAIN = false;
    float* C; const float* R; int ldc;
    __device__ __forceinline__ void operator()(const f32x4 (&acc)[2][2][4][2], const Unit& u, int wr, int wc, int fr, int fq) const {
        const int row0 = u.pm * BM + wr * 64 + fr, col0 = u.pn * BM + wc * 32 + 4 * fq;
#pragma unroll
        for (int ai = 0; ai < 2; ++ai)
#pragma unroll
            for (int m = 0; m < 4; ++m) {
                const size_t ro = (size_t)(row0 + ai * HALF + m * 16) * ldc + col0;
                f32x4 rv[2][2];
#pragma unroll
                for (int bj = 0; bj < 2; ++bj)
#pragma unroll
                    for (int n = 0; n < 2; ++n) rv[bj][n] = R ? *(const f32x4*)(R + ro + bj * HALF + n * 16) : (f32x4){0.f, 0.f, 0.f, 0.f};
#pragma unroll
                for (int bj = 0; bj < 2; ++bj)
#pragma unroll
                    for (int n = 0; n < 2; ++n) *(f32x4*)(C + ro + bj * HALF + n * 16) = acc[ai][bj][m][n] + rv[bj][n];
                __builtin_amdgcn_sched_barrier(0);
            }
    }
};

struct EpiBf16 {
    static constexpr bool PERM = true, AFTER_DRAIN = false;
    bf16_t* O; int ldc;
    __device__ __forceinline__ void operator()(const f32x4 (&acc)[2][2][4][2], const Unit& u, int wr, int wc, int fr, int fq) const {
        const int row0 = u.pm * BM + wr * 64 + fr, col0 = u.pn * BM + wc * 32 + 8 * fq;
#pragma unroll
        for (int ai = 0; ai < 2; ++ai)
#pragma unroll
            for (int m = 0; m < 4; ++m) { bf16_t* rowp = O + (size_t)(row0 + ai * HALF + m * 16) * ldc + col0;
#pragma unroll
                for (int bj = 0; bj < 2; ++bj) { const f32x4 v0 = acc[ai][bj][m][0], v1 = acc[ai][bj][m][1];
                    u32x4 w; w.x = cvt_pk_bf16(v0[0], v0[1]); w.y = cvt_pk_bf16(v0[2], v0[3]); w.z = cvt_pk_bf16(v1[0], v1[1]); w.w = cvt_pk_bf16(v1[2], v1[3]);
                    *(u32x4*)(rowp + bj * HALF) = w; } }
    }
};

struct EpiF32RN {
    static constexpr bool PERM = false, AFTER_DRAIN = false;
    float* C; const float* R; int ldc; bf16_t* XG; const float* g; float* st;
    __device__ __forceinline__ void operator()(const f32x4 (&acc)[2][2][4][2], const Unit& u, int wr, int wc, int fr, int fq) const {
        const int row0 = u.pm * BM + wr * 64 + fr, col0 = u.pn * BM + wc * 32 + 4 * fq;
        f32x4 gv[2][2];
#pragma unroll
        for (int bj = 0; bj < 2; ++bj)
#pragma unroll
            for (int n = 0; n < 2; ++n) gv[bj][n] = *(const f32x4*)(g + col0 + bj * HALF + n * 16);
#pragma unroll
        for (int ai = 0; ai < 2; ++ai)
#pragma unroll
            for (int m = 0; m < 4; ++m) {
                const int row = row0 + ai * HALF + m * 16;
                const size_t ro = (size_t)row * ldc + col0;
                f32x4 rv[2][2];
#pragma unroll
                for (int bj = 0; bj < 2; ++bj)
#pragma unroll
                    for (int n = 0; n < 2; ++n) rv[bj][n] = *(const f32x4*)(R + ro + bj * HALF + n * 16);
                float ss = 0.f;
#pragma unroll
                for (int bj = 0; bj < 2; ++bj)
#pragma unroll
                    for (int n = 0; n < 2; ++n) {
                        const f32x4 v = acc[ai][bj][m][n] + rv[bj][n];
                        *(f32x4*)(C + ro + bj * HALF + n * 16) = v;
                        ss += (v[0] * v[0] + v[1] * v[1]) + (v[2] * v[2] + v[3] * v[3]);
                        const f32x4 w = v * gv[bj][n];
                        uint2 pk; pk.x = cvt_pk_bf16(w[0], w[1]); pk.y = cvt_pk_bf16(w[2], w[3]);
                        *(uint2*)(XG + ro + bj * HALF + n * 16) = pk;
                    }
                ss += __shfl_xor(ss, 16, 64); ss += __shfl_xor(ss, 32, 64);
                if (fq == 0) st[(size_t)row * 16 + u.pn * 4 + wc] = ss;
                __builtin_amdgcn_sched_barrier(0);
            }
    }
};
struct EpiBf16S {
    static constexpr bool PERM = true, AFTER_DRAIN = false;
    bf16_t* O; int ldc; const float* st;
    __device__ __forceinline__ void operator()(const f32x4 (&acc)[2][2][4][2], const Unit& u, int wr, int wc, int fr, int fq) const {
        const int row0 = u.pm * BM + wr * 64 + fr, col0 = u.pn * BM + wc * 32 + 8 * fq;
#pragma unroll
        for (int ai = 0; ai < 2; ++ai)
#pragma unroll
            for (int m = 0; m < 4; ++m) {
                const int row = row0 + ai * HALF + m * 16;
                const f32x4* sp = (const f32x4*)(st + (size_t)row * 16);
                const f32x4 s0 = sp[0], s1 = sp[1], s2 = sp[2], s3 = sp[3];
                const f32x4 sa = (s0 + s1) + (s2 + s3);
                const float rs = __builtin_amdgcn_rsqf(((sa[0] + sa[1]) + (sa[2] + sa[3])) * (1.0f / 1024.f) + 1e-6f);
                bf16_t* rowp = O + (size_t)row * ldc + col0;
#pragma unroll
                for (int bj = 0; bj < 2; ++bj) { const f32x4 v0 = acc[ai][bj][m][0] * rs, v1 = acc[ai][bj][m][1] * rs;
                    u32x4 w; w.x = cvt_pk_bf16(v0[0], v0[1]); w.y = cvt_pk_bf16(v0[2], v0[3]); w.z = cvt_pk_bf16(v1[0], v1[1]); w.w = cvt_pk_bf16(v1[2], v1[3]);
                    *(u32x4*)(rowp + bj * HALF) = w; }
                __builtin_amdgcn_sched_barrier(0);
            }
    }
};

template <class Epi, class Sched, bool ALIGN_EPI = false, bool SP2 = false>
__device__ __forceinline__ void gemm_phase(const int wave_s, PG8_LAS unsigned char* lds, const Gemm g, const Sched& S, const Epi& E) {
    const int tid = opaque_tid(wave_s), wid = __builtin_amdgcn_readfirstlane(tid >> 6), lane = tid & 63, wr = wid >> 2, wc = wid & 3, fr = lane & 15, fq = lane >> 4;
    const int K = g.K, nt = K / BK;
    unsigned voffA[2], voffB[2];
#pragma unroll
    for (int i = 0; i < 2; ++i) { int R, C; stage_rc(tid * 16 + i * 8192, R, C); const int Rb = Epi::PERM ? ((R & ~31) + perm32(R & 31)) : R;
        voffA[i] = (unsigned)(R * K + C) * 2u; voffB[i] = (unsigned)(Rb * K + C) * 2u; }
    const size_t kstep = (size_t)(BK * 2);
    const size_t hstep = (size_t)HALF * K * 2;
    const size_t tstep = 2 * hstep;
    const unsigned ldsw = (unsigned)wid * 1024u;
    const int aoff = lds_byte(wr * 64 + fr, fq * 8), boff = lds_byte(wc * 32 + fr, fq * 8);
#define PG8_SA(b, h) (((b) * 2 + (h)) * HTB)
#define PG8_SB(b, h) ((4 + (b) * 2 + (h)) * HTB)
#define PG8_STAGE(bufoff, gbase, voff) do { _Pragma("unroll") for (int _i = 0; _i < 2; ++_i) \
        __builtin_amdgcn_global_load_lds((const unsigned*)((const char*)(gbase) + (voff)[_i]), (PG8_LAS unsigned*)(lds + (bufoff) + ldsw + _i * 8192), 16, 0, 0); } while (0)
#define PG8_LDA(dst, b, h) do { _Pragma("unroll") for (int m = 0; m < 4; ++m) _Pragma("unroll") for (int k = 0; k < 2; ++k) dst[m][k] = *(const PG8_LAS bf16x8*)(lds + PG8_SA(b, h) + aoff + m * 2048 + k * 1024); } while (0)
#define PG8_LDB(dst, b, h) do { _Pragma("unroll") for (int n = 0; n < 2; ++n) _Pragma("unroll") for (int k = 0; k < 2; ++k) dst[n][k] = *(const PG8_LAS bf16x8*)(lds + PG8_SB(b, h) + boff + n * 2048 + k * 1024); } while (0)
#define PG8_MMA(ai, bj, At, Bt) do { __builtin_amdgcn_s_setprio(1); _Pragma("unroll") for (int m = 0; m < 4; ++m) _Pragma("unroll") for (int n = 0; n < 2; ++n) _Pragma("unroll") for (int k = 0; k < 2; ++k) \
        acc[ai][bj][m][n] = __builtin_amdgcn_mfma_f32_16x16x32_bf16(Bt[n][k], At[m][k], acc[ai][bj][m][n], 0, 0, 0); __builtin_amdgcn_s_setprio(0); } while (0)
#define PG8_WAIT_V(n) asm volatile("s_waitcnt vmcnt(" #n ")" ::: "memory")
#define PG8_WAIT_L(n) asm volatile("s_waitcnt lgkmcnt(" #n ")" ::: "memory")
#define PG8_BAR __builtin_amdgcn_s_barrier()
#define PG8_SCHED __builtin_amdgcn_sched_barrier(0)
    Unit cur, nxt; int ui = 0;
    if (!S.next(0, cur)) return;
    f32x4 acc[2][2][4][2];
#pragma unroll
    for (int a = 0; a < 2; ++a)
#pragma unroll
        for (int b = 0; b < 2; ++b)
#pragma unroll
            for (int m = 0; m < 4; ++m)
#pragma unroll
                for (int n = 0; n < 2; ++n) acc[a][b][m][n] = (f32x4){0.f, 0.f, 0.f, 0.f};
    bf16x8 At[4][2], B0[2][2], B1[2][2];
    const char* cA = (const char*)g.A + (size_t)cur.pm * tstep; const char* cB = (const char*)g.Bt + (size_t)cur.pn * tstep;
    S.a_ready(cur);
    if constexpr (SP2) {
        PG8_STAGE(PG8_SB(0, 0), cB, voffB); PG8_STAGE(PG8_SB(0, 1), cB + hstep, voffB); PG8_STAGE(PG8_SA(0, 0), cA, voffA); PG8_STAGE(PG8_SA(0, 1), cA + hstep, voffA);
        if (wr == 1) PG8_BAR;
        PG8_WAIT_V(2); PG8_BAR;
        PG8_STAGE(PG8_SB(1, 0), cB + kstep, voffB); PG8_STAGE(PG8_SA(1, 0), cA + kstep, voffA); PG8_STAGE(PG8_SB(1, 1), cB + hstep + kstep, voffB);
        PG8_WAIT_V(6); PG8_BAR;
    } else {
        PG8_STAGE(PG8_SB(0, 0), cB, voffB); PG8_STAGE(PG8_SA(0, 0), cA, voffA); PG8_STAGE(PG8_SB(0, 1), cB + hstep, voffB); PG8_STAGE(PG8_SA(0, 1), cA + hstep, voffA);
        if (wr == 1) PG8_BAR;
        PG8_WAIT_V(4); PG8_BAR;
        PG8_STAGE(PG8_SB(1, 0), cB + kstep, voffB); PG8_STAGE(PG8_SA(1, 0), cA + kstep, voffA); PG8_STAGE(PG8_SB(1, 1), cB + hstep + kstep, voffB);
        PG8_WAIT_V(6); PG8_BAR;
    }
    for (;;) {
        const bool has_next = S.next(ui + 1, nxt);
        const char* nA = has_next ? (const char*)g.A + (size_t)nxt.pm * tstep : cA; const char* nB = has_next ? (const char*)g.Bt + (size_t)nxt.pn * tstep : cB;
        for (int t = 0; t < nt; t += 2) {
            const bool last = (t == nt - 2);
            const char* a1 = cA + (size_t)(t + 1) * kstep;
            const char* a2 = last ? nA : cA + (size_t)(t + 2) * kstep; const char* b2 = last ? nB : cB + (size_t)(t + 2) * kstep;
            const char* a3 = a2 + kstep; const char* b3 = b2 + kstep;
            if (last && has_next) S.a_ready(nxt);
            if constexpr (SP2) {
            PG8_LDB(B0, 0, 0); PG8_LDB(B1, 0, 1); PG8_SCHED; PG8_LDA(At, 0, 0); PG8_STAGE(PG8_SA(1, 1), a1 + hstep, voffA);
            PG8_WAIT_V(8); PG8_WAIT_L(0); PG8_BAR; PG8_MMA(0, 0, At, B0); PG8_MMA(0, 1, At, B1); PG8_BAR; PG8_SCHED;
            PG8_LDA(At, 0, 1); PG8_STAGE(PG8_SB(0, 0), b2, voffB); PG8_STAGE(PG8_SB(0, 1), b2 + hstep, voffB); PG8_STAGE(PG8_SA(0, 0), a2, voffA);
            PG8_WAIT_V(8); PG8_WAIT_L(0); PG8_BAR; PG8_MMA(1, 0, At, B0); PG8_MMA(1, 1, At, B1); PG8_BAR; PG8_SCHED;
            PG8_LDB(B0, 1, 0); PG8_LDB(B1, 1, 1); PG8_SCHED; PG8_LDA(At, 1, 0); PG8_STAGE(PG8_SA(0, 1), a2 + hstep, voffA);
            PG8_WAIT_V(8); PG8_WAIT_L(0); PG8_BAR; PG8_MMA(0, 0, At, B0); PG8_MMA(0, 1, At, B1); PG8_BAR; PG8_SCHED;
            PG8_LDA(At, 1, 1); PG8_STAGE(PG8_SB(1, 0), b3, voffB); PG8_STAGE(PG8_SB(1, 1), b3 + hstep, voffB); PG8_STAGE(PG8_SA(1, 0), a3, voffA);
            PG8_WAIT_V(8); PG8_WAIT_L(0); PG8_BAR; PG8_MMA(1, 0, At, B0); PG8_MMA(1, 1, At, B1); PG8_BAR; PG8_SCHED;
            } else {
            PG8_LDB(B0, 0, 0); PG8_SCHED; PG8_LDA(At, 0, 0); PG8_STAGE(PG8_SA(1, 1), a1 + hstep, voffA);
            PG8_WAIT_L(8); PG8_BAR; PG8_WAIT_L(0); PG8_MMA(0, 0, At, B0); PG8_BAR; PG8_SCHED;
            PG8_LDB(B1, 0, 1); PG8_STAGE(PG8_SB(0, 0), b2, voffB);
            PG8_BAR; PG8_WAIT_L(0); PG8_MMA(0, 1, At, B1); PG8_BAR;
            PG8_LDA(At, 0, 1); PG8_STAGE(PG8_SA(0, 0), a2, voffA);
            PG8_BAR; PG8_WAIT_L(0); PG8_MMA(1, 0, At, B0); PG8_BAR; PG8_SCHED;
            PG8_STAGE(PG8_SB(0, 1), b2 + hstep, voffB);
            PG8_WAIT_V(6); PG8_BAR; PG8_MMA(1, 1, At, B1); PG8_BAR;
            PG8_LDB(B0, 1, 0); PG8_SCHED; PG8_LDA(At, 1, 0); PG8_STAGE(PG8_SA(0, 1), a2 + hstep, voffA);
            PG8_WAIT_L(8); PG8_BAR; PG8_WAIT_L(0); PG8_MMA(0, 0, At, B0); PG8_BAR; PG8_SCHED;
            PG8_LDB(B1, 1, 1); PG8_STAGE(PG8_SB(1, 0), b3, voffB);
            PG8_BAR; PG8_WAIT_L(0); PG8_MMA(0, 1, At, B1); PG8_BAR;
            PG8_LDA(At, 1, 1); PG8_STAGE(PG8_SA(1, 0), a3, voffA);
            PG8_BAR; PG8_WAIT_L(0); PG8_MMA(1, 0, At, B0); PG8_BAR; PG8_SCHED;
            PG8_STAGE(PG8_SB(1, 1), b3 + hstep, voffB);
            PG8_WAIT_V(6); PG8_BAR; PG8_MMA(1, 1, At, B1); PG8_BAR;
            }
        }
        if constexpr (ALIGN_EPI) { if (wr == 0) PG8_BAR; }
        if constexpr (!Epi::AFTER_DRAIN) { E(acc, cur, wr, wc, fr, fq); S.done(cur); }
        if (!has_next) break;
#pragma unroll
        for (int a = 0; a < 2; ++a)
#pragma unroll
            for (int b = 0; b < 2; ++b)
#pragma unroll
                for (int m = 0; m < 4; ++m)
#pragma unroll
                    for (int n = 0; n < 2; ++n) acc[a][b][m][n] = (f32x4){0.f, 0.f, 0.f, 0.f};
        cur = nxt; cA = nA; cB = nB; ++ui;
        if constexpr (ALIGN_EPI) { if (wr == 1) PG8_BAR; }
    }
    PG8_WAIT_V(0);
    if constexpr (!ALIGN_EPI) { if (wr == 0) PG8_BAR; }
    PG8_BAR;
#undef PG8_SA
#undef PG8_SB
#undef PG8_STAGE
#undef PG8_LDA
#undef PG8_LDB
#undef PG8_MMA
#undef PG8_WAIT_V
#undef PG8_WAIT_L
#undef PG8_BAR
#undef PG8_SCHED
}
}

__device__ __forceinline__ void transpose_item(const float* W, int K, int N, bf16* WT, LAS float* scr, int item, int lane) {
    const int nblk = N / 32, kb = item / nblk, nb = item % nblk, k0 = 64 * kb, n0 = 32 * nb;
#pragma unroll 8
    for (int i = 0; i < 32; ++i) { const int kk = 2 * i + (lane >> 5); scr[kk * 33 + (lane & 31)] = W[(size_t)(k0 + kk) * N + n0 + (lane & 31)]; }
    asm volatile("s_waitcnt lgkmcnt(0)" ::: "memory");
    const int c = lane & 7;
#pragma unroll
    for (int j = 0; j < 4; ++j) { const int n = (lane >> 3) + 8 * j; const LAS float* s = scr + (8 * c) * 33 + n;
        uint4 o; o.x = pk2(s[0 * 33], s[1 * 33]); o.y = pk2(s[2 * 33], s[3 * 33]); o.z = pk2(s[4 * 33], s[5 * 33]); o.w = pk2(s[6 * 33], s[7 * 33]);
        *(uint4*)(WT + (size_t)(n0 + n) * K + k0 + 8 * c) = o; }
    asm volatile("s_waitcnt lgkmcnt(0)" ::: "memory");
}

__device__ __forceinline__ float wsum(float v) {
#pragma unroll
  for (int o = 32; o > 0; o >>= 1) v += __shfl_xor(v, o, 64);
  return v;
}
__device__ __forceinline__ float wmaxf(float v) {
#pragma unroll
  for (int o = 32; o > 0; o >>= 1) v = fmaxf(v, __shfl_xor(v, o, 64));
  return v;
}
__device__ __forceinline__ float sigmoidf_(float x) { return 1.0f / (1.0f + expf(-x)); }
__device__ __forceinline__ float gelu_tanh(float x) {
  return 0.5f * x * (1.0f + tanhf(0.7978845608028654f * (x + 0.044715f * x * x * x)));
}

template <bool BF16OUT>
__device__ __forceinline__ void rms_rows(const int wave_s, const float* src, const float* g, void* dstv, int rows) {
  const int tid_ = opaque_tid(wave_s);
  const int lane = tid_ & 63;
  const int gw = blockIdx.x * NWAVES + (tid_ >> 6);
  const int nw = gridDim.x * NWAVES;
  for (int r = gw; r < rows; r += nw) {
    const float4* s4 = (const float4*)(src + (size_t)r * DM);
    float4 v[4];
    float ss = 0.f;
#pragma unroll
    for (int i = 0; i < 4; i++) {
      v[i] = s4[lane + i * 64];
      ss += v[i].x * v[i].x + v[i].y * v[i].y + v[i].z * v[i].z + v[i].w * v[i].w;
    }
    ss = wsum(ss);
    const float rstd = rsqrtf(ss * (1.0f / DM) + EPSF);
    const float4* g4 = (const float4*)g;
#pragma unroll
    for (int i = 0; i < 4; i++) {
      float4 gg = g4[lane + i * 64];
      float4 o;
      o.x = v[i].x * rstd * gg.x; o.y = v[i].y * rstd * gg.y;
      o.z = v[i].z * rstd * gg.z; o.w = v[i].w * rstd * gg.w;
      if (BF16OUT) {
        uint2 pk; pk.x = pk2(o.x, o.y); pk.y = pk2(o.z, o.w);
        ((uint2*)((bf16*)dstv + (size_t)r * DM))[lane + i * 64] = pk;
      } else {
        ((float4*)((float*)dstv + (size_t)r * DM))[lane + i * 64] = o;
      }
    }
  }
}

__device__ __forceinline__ void ssm_params(const int wave_s, const Params& p, float* ssmp_all) {
  const int tid_ = opaque_tid(wave_s);
  const float* in8 = karg_in(8); const float* in9 = karg_in(9); const float* in10 = karg_in(10);
  const float* in11 = karg_in(11); const float* in12 = karg_in(12);
  const int gt = blockIdx.x * blockDim.x + tid_;
  const int nth = gridDim.x * blockDim.x;
  for (int i = gt; i < 2 * 16 * 64; i += nth) {
    const int l = i / 1024, gp = i % 1024, g = gp / 64;
    float* sp = ssmp_all + (size_t)l * SSMP_PER_LAYER;
    const float lre = fminf(in8[l * 1024 + gp], -1e-4f);
    const float lim = in9[l * 1024 + gp];
    const float dt = expf(in10[l * 16 + g]);
    const float er = expf(lre * dt);
    float sn, cs;
    sincosf(lim * dt, &sn, &cs);
    const float br = er * cs, bi = er * sn;
    sp[gp * 2 + 0] = br;
    sp[gp * 2 + 1] = bi;
    float cr = br, ci = bi;
#pragma unroll
    for (int s = 0; s < 6; s++) {
      const float nr = cr * cr - ci * ci, ni = 2.f * cr * ci;
      cr = nr; ci = ni;
    }
    sp[2048 + gp * 2 + 0] = cr;
    sp[2048 + gp * 2 + 1] = ci;
    const float nr = br - 1.0f, ni = bi;
    const float den = lre * lre + lim * lim;
    const float fr = (nr * lre + ni * lim) / den;
    const float fi = (ni * lre - nr * lim) / den;
    for (int h = 0; h < 16; h++) {
      const float bre = in11[((size_t)l * 1024 + gp) * 16 + h];
      const float bim = in12[((size_t)l * 1024 + gp) * 16 + h];
      sp[4096 + ((g * 16 + h) * 64 + (gp & 63)) * 2 + 0] = fr * bre - fi * bim;
      sp[4096 + ((g * 16 + h) * 64 + (gp & 63)) * 2 + 1] = fr * bim + fi * bre;
    }
  }
}

__device__ __forceinline__ void conv_phase(const int wave_s, const Params& p, int l, const bf16* proj, bf16* y, LAS float* smem) {
  const int tid_ = opaque_tid(wave_s);
  const int lane = tid_ & 63;
  const int gw = blockIdx.x * NWAVES + (tid_ >> 6);
  const int nw = gridDim.x * NWAVES;
  const float* cw = karg_in(4) + (size_t)l * 31 * 256;
  const float4 cb = ((const float4*)(karg_in(5) + l * 256))[lane];
  const float4 lg = ((const float4*)(karg_in(6) + l * 256))[lane];
  const float4 lb = ((const float4*)(karg_in(7) + l * 256))[lane];
  const float4 gg = ((const float4*)(karg_in(18) + l * 1024))[lane];
  LAS float* cwl = smem + 1024;
  for (int i = tid_; i < 31 * 256 / 4; i += NWAVES * 64) *(LAS pg8::f32x4*)(cwl + 4 * i) = *(const pg8::f32x4*)(cw + 4 * i);
  __syncthreads();
  for (int it = gw; it < NT / 8; it += nw) {
    const int tok0 = it * 8;
    const int t0 = tok0 & (SEQ - 1);
    float4 acc[8];
#pragma unroll
    for (int o = 0; o < 8; o++) acc[o] = cb;
#pragma unroll
    for (int i = 0; i < 38; i++) {
      if (t0 - 30 + i >= 0) {
        const bf16* row = proj + (size_t)(tok0 - 30 + i) * DIN;
        const uint2 vp = ((const uint2*)row)[lane];
        const uint2 gp = ((const uint2*)(row + 256))[lane];
        float4 g4;
        g4.x = bf_lo(vp.x) * sigmoidf_(bf_lo(gp.x)); g4.y = bf_hi(vp.x) * sigmoidf_(bf_hi(gp.x));
        g4.z = bf_lo(vp.y) * sigmoidf_(bf_lo(gp.y)); g4.w = bf_hi(vp.y) * sigmoidf_(bf_hi(gp.y));
#pragma unroll
        for (int o = 0; o < 8; o++) {
          const int j = i - o;
          if (j >= 0 && j <= 30) {
            const pg8::f32x4 w4 = *(const LAS pg8::f32x4*)(cwl + j * 256 + lane * 4);
            acc[o].x += g4.x * w4[0]; acc[o].y += g4.y * w4[1];
            acc[o].z += g4.z * w4[2]; acc[o].w += g4.w * w4[3];
          }
        }
      }
    }
#pragma unroll
    for (int o = 0; o < 8; o++) {
      const float4 a = acc[o];
      const float mean = wsum(a.x + a.y + a.z + a.w) * (1.0f / 256.f);
      const float dx = a.x - mean, dy = a.y - mean, dz = a.z - mean, dw = a.w - mean;
      const float var = wsum(dx * dx + dy * dy + dz * dz + dw * dw) * (1.0f / 256.f);
      const float rs = rsqrtf(var + EPSF);
      float4 s;
      s.x = dx * rs * lg.x + lb.x; s.y = dy * rs * lg.y + lb.y;
      s.z = dz * rs * lg.z + lb.z; s.w = dw * rs * lg.w + lb.w;
      s.x = s.x * sigmoidf_(s.x); s.y = s.y * sigmoidf_(s.y);
      s.z = s.z * sigmoidf_(s.z); s.w = s.w * sigmoidf_(s.w);
      const float ss = wsum(s.x * s.x + s.y * s.y + s.z * s.z + s.w * s.w) * (1.0f / 256.f);
      const float r2 = rsqrtf(ss + EPSF);
      uint2 pk; pk.x = pk2(s.x * r2 * gg.x, s.y * r2 * gg.y); pk.y = pk2(s.z * r2 * gg.z, s.w * r2 * gg.w);
      ((uint2*)(y + (size_t)(tok0 + o) * DM))[lane] = pk;
    }
  }
}

typedef short bf16x8_t __attribute__((ext_vector_type(8)));
typedef float f32x16_t __attribute__((ext_vector_type(16)));
#define MFMA_PAD() do { __builtin_amdgcn_sched_barrier(0); asm volatile("s_nop 15\n\ts_nop 15" ::: "memory"); __builtin_amdgcn_sched_barrier(0); } while (0)

__device__ __forceinline__ void attn_phase(const int wave_s, const Params& p, int l, const bf16* proj, bf16* y, LAS float* smem) {
  const int tid = opaque_tid(wave_s), lane = tid & 63, wave = tid >> 6;
  const int n = lane & 31, hh = lane >> 5;
  const float* gg = karg_in(18) + l * 1024 + 256 + wave * 64;
  const float g0 = gg[n], g1 = gg[32 + n];
  LAS float* ssq = smem;
  LAS float* rstd = smem + 256;
  for (int item = blockIdx.x; item < 4 * 128; item += gridDim.x) {
    const int b = item >> 7, q0 = (item & 127) * 32;
    const size_t tokb = (size_t)b * SEQ;
    bf16x8_t qf[4];
    {
      const bf16* qrow = proj + (tokb + q0 + n) * DIN + 512 + wave * 64 + 8 * hh;
#pragma unroll
      for (int ks = 0; ks < 4; ks++) qf[ks] = *(const bf16x8_t*)(qrow + 16 * ks);
    }
    f32x16_t o0, o1;
#pragma unroll
    for (int r = 0; r < 16; r++) { o0[r] = 0.f; o1[r] = 0.f; }
    float R = 0.f;
    for (int kt = q0; kt >= 0; kt -= 32) {
      bf16x8_t kf[4];
      {
        const bf16* krow = proj + (tokb + kt + n) * DIN + 1024 + wave * 64 + 8 * hh;
#pragma unroll
        for (int ks = 0; ks < 4; ks++) kf[ks] = *(const bf16x8_t*)(krow + 16 * ks);
      }
      bf16x8_t vf0[2], vf1[2];
      {
        const bf16* vb = proj + (tokb + kt + 4 * hh) * DIN + 1536 + wave * 64 + n;
#pragma unroll
        for (int s = 0; s < 2; s++)
#pragma unroll
          for (int j = 0; j < 8; j++) {
            const int key = 16 * s + 8 * (j >> 2) + (j & 3);
            vf0[s][j] = (short)vb[(size_t)key * DIN];
            vf1[s][j] = (short)vb[(size_t)key * DIN + 32];
          }
      }
      f32x16_t sacc;
#pragma unroll
      for (int r = 0; r < 16; r++) sacc[r] = 0.f;
      __builtin_amdgcn_sched_barrier(0); asm volatile("s_nop 15\n\ts_nop 15" ::: "memory"); __builtin_amdgcn_sched_barrier(0);
#pragma unroll
      for (int ks = 0; ks < 4; ks++) sacc = __builtin_amdgcn_mfma_f32_32x32x16_bf16(kf[ks], qf[ks], sacc, 0, 0, 0);
      __builtin_amdgcn_sched_barrier(0); asm volatile("s_nop 15\n\ts_nop 15" ::: "memory"); __builtin_amdgcn_sched_barrier(0);
      float lst[16], lsz[16];
      const bool diag = (kt == q0);
#pragma unroll
      for (int r = 0; r < 16; r++) {
        const float z = sacc[r] * 0.125f;
        const float sp = __logf(1.0f + __expf(-fabsf(z)));
        float a = fminf(z, 0.f) - sp;
        float c = -(fmaxf(z, 0.f) + sp);
        if (diag) {
          const int key = (r & 3) + 8 * (r >> 2) + 4 * hh;
          if (key >= n) { a = -1.0e30f; c = 0.f; }
        }
        lsz[r] = a; lst[r] = c;
      }
      float Gs[4], Gp[4];
#pragma unroll
      for (int g = 0; g < 4; g++) {
        Gs[g] = (lst[4 * g] + lst[4 * g + 1]) + (lst[4 * g + 2] + lst[4 * g + 3]);
        Gp[g] = __shfl_xor(Gs[g], 32, 64);
      }
      float carry[4];
      {
        float after = R;
#pragma unroll
        for (int g = 3; g >= 0; g--) {
          carry[g] = after + (hh ? 0.f : Gp[g]);
          after += Gs[g] + Gp[g];
        }
        R = after;
      }
      bf16x8_t pf[2];
#pragma unroll
      for (int g = 0; g < 4; g++) {
        float run = carry[g];
        float a3 = __expf(lsz[4 * g + 3] + run); run += lst[4 * g + 3];
        float a2 = __expf(lsz[4 * g + 2] + run); run += lst[4 * g + 2];
        float a1 = __expf(lsz[4 * g + 1] + run); run += lst[4 * g + 1];
        float a0 = __expf(lsz[4 * g + 0] + run);
        const int s = g >> 1, jb = (g & 1) * 4;
        pf[s][jb + 0] = (short)f2bf(a0); pf[s][jb + 1] = (short)f2bf(a1);
        pf[s][jb + 2] = (short)f2bf(a2); pf[s][jb + 3] = (short)f2bf(a3);
      }
      __builtin_amdgcn_sched_barrier(0); asm volatile("s_nop 15\n\ts_nop 15" ::: "memory"); __builtin_amdgcn_sched_barrier(0);
#pragma unroll
      for (int s = 0; s < 2; s++) {
        o0 = __builtin_amdgcn_mfma_f32_32x32x16_bf16(pf[s], vf0[s], o0, 0, 0, 0);
        o1 = __builtin_amdgcn_mfma_f32_32x32x16_bf16(pf[s], vf1[s], o1, 0, 0, 0);
      }
      __builtin_amdgcn_sched_barrier(0); asm volatile("s_nop 15\n\ts_nop 15" ::: "memory"); __builtin_amdgcn_sched_barrier(0);
      if (__all(R < -110.f)) break;
    }
    float sq[16];
#pragma unroll
    for (int r = 0; r < 16; r++) {
      float v = o0[r] * o0[r] + o1[r] * o1[r];
#pragma unroll
      for (int o = 16; o > 0; o >>= 1) v += __shfl_xor(v, o, 64);
      sq[r] = v;
    }
    __syncthreads();
    if (n == 0) {
#pragma unroll
      for (int r = 0; r < 16; r++) ssq[wave * 32 + (r & 3) + 8 * (r >> 2) + 4 * hh] = sq[r];
    }
    __syncthreads();
    if (tid < 32) {
      float t = 0.f;
#pragma unroll
      for (int w = 0; w < 8; w++) t += ssq[w * 32 + tid];
      rstd[tid] = rsqrtf(t * (1.0f / 512.f) + EPSF);
    }
    __syncthreads();
#pragma unroll
    for (int r = 0; r < 16; r++) {
      const int qi = (r & 3) + 8 * (r >> 2) + 4 * hh;
      const float rs = rstd[qi];
      bf16* yr = y + (tokb + q0 + qi) * DM + 256 + wave * 64 + n;
      yr[0] = (bf16)f2bf(o0[r] * rs * g0);
      yr[32] = (bf16)f2bf(o1[r] * rs * g1);
    }
  }
}

#define SSM_BCAST_U(u, ua, ub, tt) do { \
    const unsigned w0 = (unsigned)__builtin_amdgcn_readlane((int)(ua).x, (tt)), w1 = (unsigned)__builtin_amdgcn_readlane((int)(ua).y, (tt)); \
    const unsigned w2 = (unsigned)__builtin_amdgcn_readlane((int)(ua).z, (tt)), w3 = (unsigned)__builtin_amdgcn_readlane((int)(ua).w, (tt)); \
    const unsigned w4 = (unsigned)__builtin_amdgcn_readlane((int)(ub).x, (tt)), w5 = (unsigned)__builtin_amdgcn_readlane((int)(ub).y, (tt)); \
    const unsigned w6 = (unsigned)__builtin_amdgcn_readlane((int)(ub).z, (tt)), w7 = (unsigned)__builtin_amdgcn_readlane((int)(ub).w, (tt)); \
    (u)[0] = bf_lo(w0); (u)[1] = bf_hi(w0); (u)[2] = bf_lo(w1); (u)[3] = bf_hi(w1); (u)[4] = bf_lo(w2); (u)[5] = bf_hi(w2); (u)[6] = bf_lo(w3); (u)[7] = bf_hi(w3); \
    (u)[8] = bf_lo(w4); (u)[9] = bf_hi(w4); (u)[10] = bf_lo(w5); (u)[11] = bf_hi(w5); (u)[12] = bf_lo(w6); (u)[13] = bf_hi(w6); (u)[14] = bf_lo(w7); (u)[15] = bf_hi(w7); } while (0)
__device__ __forceinline__ void ssm_chunk_end(const int wave_s, const float* ssmp, const bf16* proj, float* ssmE) {
  const int tid_ = opaque_tid(wave_s);
  const int lane = tid_ & 63;
  const int gw = blockIdx.x * NWAVES + (tid_ >> 6);
  const int nw = gridDim.x * NWAVES;
  for (int it = gw; it < 4 * 64 * 16; it += nw) {
    const int g = it & 15, c = (it >> 4) & 63, b = it >> 10;
    const int gp = g * 64 + lane;
    const uint4* up = (const uint4*)(proj + (size_t)(b * SEQ + c * 64 + lane) * DIN + 2048 + g * 16);
    const uint4 ua = up[0], ub = up[1];
    const float lbr = ssmp[gp * 2], lbi = ssmp[gp * 2 + 1];
    float bbr[16], bbi[16];
#pragma unroll
    for (int h = 0; h < 16; h++) {
      { const float2 bb = *(const float2*)(ssmp + 4096 + ((g * 16 + h) * 64 + lane) * 2); bbr[h] = bb.x; bbi[h] = bb.y; }
    }
    float xr = 0.f, xi = 0.f;
#pragma unroll 2
    for (int tt = 0; tt < 64; tt++) {
      float u[16];
      SSM_BCAST_U(u, ua, ub, tt);
      float br = 0.f, bi = 0.f;
#pragma unroll
      for (int h = 0; h < 16; h++) { br += bbr[h] * u[h]; bi += bbi[h] * u[h]; }
      const float nr = lbr * xr - lbi * xi + br;
      const float ni = lbr * xi + lbi * xr + bi;
      xr = nr; xi = ni;
    }
    float* e = ssmE + ((size_t)((b * 64 + c) * 16 + g) * 64 + lane) * 2;
    e[0] = xr; e[1] = xi;
  }
}

__device__ __forceinline__ void ssm_finish(const int wave_s, const Params& p, int l, const float* ssmp, const bf16* proj,
                           const float* ssmE, bf16* y, LAS float* smem) {
  LAS bf16* Ytb = (LAS bf16*)smem;
  LAS float* ssq2 = smem + (64 * 264 * 2) / 4;
  LAS float* rstd2 = ssq2 + 512;
  const bf16* glT = (const bf16*)(p.ws + WS_WT + (size_t)l * WT_LAYER + WT_GLU);
  const int tid = opaque_tid(wave_s), lane = tid & 63, wave = tid >> 6;
  const float* cre = karg_in(13) + (size_t)l * 16 * 16 * 64;
  const float* cim = karg_in(14) + (size_t)l * 16 * 16 * 64;
  const float* dsk = karg_in(15) + l * 256;
  const float* glw = karg_in(16) + (size_t)l * 256 * 256;
  const float* glb = karg_in(17) + l * 256;
  const float* gg = karg_in(18) + l * 1024 + 768;
  for (int it = blockIdx.x; it < 256; it += gridDim.x) {
    const int b = it >> 6, c = it & 63;
    __syncthreads();
    for (int gi = 0; gi < 2; gi++) {
      const int g = wave + gi * 8;
      const int gp = g * 64 + lane;
      const float lbr = ssmp[gp * 2], lbi = ssmp[gp * 2 + 1];
      const float lcr = ssmp[2048 + gp * 2], lci = ssmp[2048 + gp * 2 + 1];
      float bbr[16], bbi[16];
#pragma unroll
      for (int h = 0; h < 16; h++) {
        { const float2 bb = *(const float2*)(ssmp + 4096 + ((g * 16 + h) * 64 + lane) * 2); bbr[h] = bb.x; bbi[h] = bb.y; }
      }
      bf16x8_t cop[5];
      {
        const int nn = lane & 15, q = lane >> 4;
#pragma unroll
        for (int ks = 0; ks < 4; ks++) {
          const float4 cr4 = *(const float4*)(cre + (g * 16 + nn) * 64 + 16 * ks + 4 * q);
          const float4 ci4 = *(const float4*)(cim + (g * 16 + nn) * 64 + 16 * ks + 4 * q);
          pg8::u32x4 w;
          w.x = pk2(cr4.x, -ci4.x); w.y = pk2(cr4.y, -ci4.y); w.z = pk2(cr4.z, -ci4.z); w.w = pk2(cr4.w, -ci4.w);
          cop[ks] = __builtin_bit_cast(bf16x8_t, w);
        }
        const float dn = dsk[g * 16 + nn];
        float dv[8];
#pragma unroll
        for (int j = 0; j < 8; j++) dv[j] = (8 * q + j == nn) ? dn : 0.f;
        pg8::u32x4 w;
        w.x = pk2(dv[0], dv[1]); w.y = pk2(dv[2], dv[3]); w.z = pk2(dv[4], dv[5]); w.w = pk2(dv[6], dv[7]);
        cop[4] = __builtin_bit_cast(bf16x8_t, w);
      }
      float xr = 0.f, xi = 0.f;
      {
        const float2* eb = (const float2*)ssmE + ((size_t)(b * 64) * 16 + g) * 64 + lane;
        int cc = 0;
        for (; cc + 8 <= c; cc += 8) {
          float2 ev[8];
#pragma unroll
          for (int k = 0; k < 8; k++) ev[k] = eb[(size_t)(cc + k) * 16 * 64];
#pragma unroll
          for (int k = 0; k < 8; k++) {
            const float nr = lcr * xr - lci * xi + ev[k].x;
            const float ni = lcr * xi + lci * xr + ev[k].y;
            xr = nr; xi = ni;
          }
        }
        for (; cc < c; cc++) {
          const float2 e1 = eb[(size_t)cc * 16 * 64];
          const float nr = lcr * xr - lci * xi + e1.x;
          const float ni = lcr * xi + lci * xr + e1.y;
          xr = nr; xi = ni;
        }
      }
      LAS unsigned char* xt = (LAS unsigned char*)smem + 36864 + wave * 10752;
      const uint4* up = (const uint4*)(proj + (size_t)(b * SEQ + c * 64 + lane) * DIN + 2048 + g * 16);
      const uint4 ua = up[0], ub = up[1];
      if (lane < 32) {
        pg8::u32x4 z4; z4.x = 0u; z4.y = 0u; z4.z = 0u; z4.w = 0u;
        LAS pg8::u32x4* zr = (LAS pg8::u32x4*)(xt + lane * 336 + 288);
        zr[0] = z4; zr[1] = z4;
      }
#pragma unroll 1
      for (int half = 0; half < 2; half++) {
        if ((lane >> 5) == half) {
          pg8::u32x4 w0, w1;
          w0.x = ua.x; w0.y = ua.y; w0.z = ua.z; w0.w = ua.w; w1.x = ub.x; w1.y = ub.y; w1.z = ub.z; w1.w = ub.w;
          LAS pg8::u32x4* ur = (LAS pg8::u32x4*)(xt + (lane & 31) * 336 + 256);
          ur[0] = w0; ur[1] = w1;
        }
#pragma unroll 2
        for (int tt = 0; tt < 32; tt++) {
          float u[16];
          SSM_BCAST_U(u, ua, ub, half * 32 + tt);
          float br = 0.f, bi = 0.f;
#pragma unroll
          for (int h = 0; h < 16; h++) { br += bbr[h] * u[h]; bi += bbi[h] * u[h]; }
          const float nr = lbr * xr - lbi * xi + br;
          const float ni = lbr * xi + lbi * xr + bi;
          xr = nr; xi = ni;
          *(LAS unsigned*)(xt + tt * 336 + lane * 4) = pk2(xr, xi);
        }
        __builtin_amdgcn_wave_barrier();
#pragma unroll
        for (int mt = 0; mt < 2; mt++) {
          pg8::f32x4 acc4;
          acc4[0] = 0.f; acc4[1] = 0.f; acc4[2] = 0.f; acc4[3] = 0.f;
          const LAS unsigned char* ar = xt + (16 * mt + (lane & 15)) * 336 + (lane >> 4) * 16;
#pragma unroll
          for (int ks = 0; ks < 5; ks++)
            acc4 = __builtin_amdgcn_mfma_f32_16x16x32_bf16(*(const LAS bf16x8_t*)(ar + ks * 64), cop[ks], acc4, 0, 0, 0);
#pragma unroll
          for (int j = 0; j < 4; j++)
            Ytb[(half * 32 + 16 * mt + 4 * (lane >> 4) + j) * 264 + g * 16 + (lane & 15)] = (bf16)f2bf(gelu_tanh(acc4[j]));
        }
        __builtin_amdgcn_wave_barrier();
      }
    }
    __syncthreads();
    {
      const int n = lane & 31, hh = lane >> 5;
      const int ch = wave * 32 + n;
      const float bj = glb[ch];
      const float gj = gg[ch];
      bf16x8_t gf[16];
      {
        const bf16* grow = glT + (size_t)ch * 256 + 8 * hh;
#pragma unroll
        for (int ks = 0; ks < 16; ks++) gf[ks] = *(const bf16x8_t*)(grow + 16 * ks);
      }
      float oo[2][16];
#pragma unroll
      for (int mt = 0; mt < 2; mt++) {
        f32x16_t z;
#pragma unroll
        for (int r = 0; r < 16; r++) z[r] = 0.f;
        const LAS bf16* yrow = Ytb + (mt * 32 + n) * 264 + 8 * hh;
#pragma unroll
        for (int kq = 0; kq < 4; kq++) {
          bf16x8_t yf[4];
#pragma unroll
          for (int i = 0; i < 4; i++) yf[i] = *(const LAS bf16x8_t*)(yrow + 16 * (kq * 4 + i));
          MFMA_PAD();
#pragma unroll
          for (int i = 0; i < 4; i++) z = __builtin_amdgcn_mfma_f32_32x32x16_bf16(yf[i], gf[kq * 4 + i], z, 0, 0, 0);
          MFMA_PAD();
        }
        float sq[16];
#pragma unroll
        for (int r = 0; r < 16; r++) {
          const int t = mt * 32 + (r & 3) + 8 * (r >> 2) + 4 * hh;
          const float yv = bf2f(Ytb[t * 264 + ch]);
          const float o = yv * sigmoidf_(z[r] + bj);
          oo[mt][r] = o;
          float v = o * o;
#pragma unroll
          for (int s = 16; s > 0; s >>= 1) v += __shfl_xor(v, s, 64);
          sq[r] = v;
        }
        if (n == 0) {
#pragma unroll
          for (int r = 0; r < 16; r++) ssq2[wave * 64 + mt * 32 + (r & 3) + 8 * (r >> 2) + 4 * hh] = sq[r];
        }
      }
      __syncthreads();
      if (tid < 64) {
        float t = 0.f;
#pragma unroll
        for (int w = 0; w < 8; w++) t += ssq2[w * 64 + tid];
        rstd2[tid] = rsqrtf(t * (1.0f / 256.f) + EPSF);
      }
      __syncthreads();
#pragma unroll
      for (int mt = 0; mt < 2; mt++)
#pragma unroll
        for (int r = 0; r < 16; r++) {
          const int t = mt * 32 + (r & 3) + 8 * (r >> 2) + 4 * hh;
          y[(size_t)(b * SEQ + c * 64 + t) * DM + 768 + ch] = (bf16)f2bf(oo[mt][r] * rstd2[t] * gj);
        }
    }
  }
}

__device__ __forceinline__ void memattn_phase(const int wave_s, const bf16* q, const bf16* kvb, const bf16* vT, bf16* o, LAS float* smem) {
  const int tid_ = opaque_tid(wave_s);
  const int lane = tid_ & 63, n = lane & 31, hh = lane >> 5, wave = tid_ >> 6;
  const int sig = (n & 0x13) | ((n & 4) << 1) | ((n & 8) >> 1);
  LAS bf16* Ls = (LAS bf16*)smem;
  for (int it = blockIdx.x; it < 64 * 4; it += gridDim.x) {
    const int h = it & 3, tg = it >> 2, b = tg >> 4;
    const int tok0 = (tg * 8 + wave) * 32;
    __syncthreads();
    {
      const int r = tid_ >> 1, hf = tid_ & 1;
      const pg8::u32x4* src4 = (const pg8::u32x4*)(kvb + (size_t)(b * NMEM + r) * 2048 + h * 256 + hf * 128);
      LAS pg8::u32x4* dst4 = (LAS pg8::u32x4*)(Ls + r * 264 + hf * 128);
#pragma unroll
      for (int k = 0; k < 16; k++) dst4[k] = src4[k];
    }
    f32x16_t st[8];
#pragma unroll
    for (int kt = 0; kt < 8; kt++)
#pragma unroll
      for (int r = 0; r < 16; r++) st[kt][r] = 0.f;
    const bf16* qrow = q + (size_t)(tok0 + n) * DM + h * 256 + 8 * hh;
    __syncthreads();
#pragma unroll
    for (int kq = 0; kq < 4; kq++) {
      bf16x8_t qf[4];
#pragma unroll
      for (int i = 0; i < 4; i++) qf[i] = *(const bf16x8_t*)(qrow + 16 * (kq * 4 + i));
#pragma unroll
      for (int kt = 0; kt < 8; kt++) {
        const LAS bf16* krow = Ls + (kt * 32 + sig) * 264 + 8 * hh;
        bf16x8_t kf[4];
#pragma unroll
        for (int i = 0; i < 4; i++) kf[i] = *(const LAS bf16x8_t*)(krow + 16 * (kq * 4 + i));
        MFMA_PAD();
#pragma unroll
        for (int i = 0; i < 4; i++) st[kt] = __builtin_amdgcn_mfma_f32_32x32x16_bf16(kf[i], qf[i], st[kt], 0, 0, 0);
        MFMA_PAD();
      }
    }
    float mx = st[0][0];
#pragma unroll
    for (int kt = 0; kt < 8; kt++)
#pragma unroll
      for (int r = 0; r < 16; r++) mx = fmaxf(mx, st[kt][r]);
    mx = fmaxf(mx, __shfl_xor(mx, 32, 64));
    float sum = 0.f;
#pragma unroll
    for (int kt = 0; kt < 8; kt++)
#pragma unroll
      for (int r = 0; r < 16; r++) { const float e = __expf((st[kt][r] - mx) * 0.0625f); st[kt][r] = e; sum += e; }
    sum += __shfl_xor(sum, 32, 64);
    const float inv = 1.0f / sum;
    bf16x8_t pf[8][2];
#pragma unroll
    for (int kt = 0; kt < 8; kt++)
#pragma unroll
      for (int s = 0; s < 2; s++)
#pragma unroll
        for (int j = 0; j < 8; j++) pf[kt][s][j] = (short)f2bf(st[kt][8 * s + j] * inv);
    __syncthreads();
    {
      const int r = tid_ >> 1, hf = tid_ & 1;
      const pg8::u32x4* src4 = (const pg8::u32x4*)(vT + ((size_t)(b * 4 + h) * 256 + r) * 256 + hf * 128);
      LAS pg8::u32x4* dst4 = (LAS pg8::u32x4*)(Ls + r * 264 + hf * 128);
#pragma unroll
      for (int k = 0; k < 16; k++) dst4[k] = src4[k];
    }
    __syncthreads();
#pragma unroll 1
    for (int dt = 0; dt < 8; dt++) {
      f32x16_t oacc;
#pragma unroll
      for (int r = 0; r < 16; r++) oacc[r] = 0.f;
      const LAS bf16* vrow = Ls + (dt * 32 + n) * 264 + 8 * hh;
#pragma unroll
      for (int kq = 0; kq < 4; kq++) {
        bf16x8_t vf[4];
#pragma unroll
        for (int i = 0; i < 4; i++) vf[i] = *(const LAS bf16x8_t*)(vrow + (kq * 2 + (i >> 1)) * 32 + 16 * (i & 1));
        MFMA_PAD();
#pragma unroll
        for (int i = 0; i < 4; i++) oacc = __builtin_amdgcn_mfma_f32_32x32x16_bf16(pf[kq * 2 + (i >> 1)][i & 1], vf[i], oacc, 0, 0, 0);
        MFMA_PAD();
      }
#pragma unroll
      for (int r = 0; r < 16; r++) {
        const int qi = (r & 3) + 8 * (r >> 2) + 4 * hh;
        o[(size_t)(tok0 + qi) * DM + h * 256 + dt * 32 + n] = (bf16)f2bf(oacc[r]);
      }
    }
  }
}

__device__ __forceinline__ void vt_phase(const int wave_s, const bf16* kvb, bf16* vT) {
  const int tid_ = opaque_tid(wave_s);
  const int gt = blockIdx.x * (NWAVES * 64) + tid_;
  const int nth = gridDim.x * NWAVES * 64;
  for (int i = gt; i < 2 * 4 * 4 * 256 * 256; i += nth) {
    const int m = i & 255, d = (i >> 8) & 255, h = (i >> 16) & 3, b = (i >> 18) & 3, l = i >> 20;
    vT[i] = kvb[((size_t)l * 1024 + b * 256 + m) * 2048 + 1024 + h * 256 + d];
  }
}

template <unsigned MASK>
__device__ __forceinline__ float pack_key(float s, unsigned idx) {
  const unsigned u = __builtin_bit_cast(unsigned, s);
  const unsigned tag = ((int)u < 0) ? idx : (MASK - idx);
  return __builtin_bit_cast(float, (u & ~MASK) + tag);
}
template <unsigned MASK>
__device__ __forceinline__ unsigned key_idx(float k) {
  const unsigned u = __builtin_bit_cast(unsigned, k);
  const unsigned tag = u & MASK;
  return ((int)u < 0) ? tag : (MASK - tag);
}
template <unsigned MASK>
__device__ __forceinline__ float key_val(float k) { return __builtin_bit_cast(float, __builtin_bit_cast(unsigned, k) & ~MASK); }
__device__ __forceinline__ void top16_of_64(float (&K)[64]) {
  { const float a_ = K[0], b_ = K[1]; const bool g_ = a_ > b_; K[0] = g_ ? a_ : b_; K[1] = g_ ? b_ : a_; }
  { const float a_ = K[2], b_ = K[3]; const bool g_ = a_ > b_; K[2] = g_ ? b_ : a_; K[3] = g_ ? a_ : b_; }
  { const float a_ = K[4], b_ = K[5]; const bool g_ = a_ > b_; K[4] = g_ ? a_ : b_; K[5] = g_ ? b_ : a_; }
  { const float a_ = K[6], b_ = K[7]; const bool g_ = a_ > b_; K[6] = g_ ? b_ : a_; K[7] = g_ ? a_ : b_; }
  { const float a_ = K[8], b_ = K[9]; const bool g_ = a_ > b_; K[8] = g_ ? a_ : b_; K[9] = g_ ? b_ : a_; }
  { const float a_ = K[10], b_ = K[11]; const bool g_ = a_ > b_; K[10] = g_ ? b_ : a_; K[11] = g_ ? a_ : b_; }
  { const float a_ = K[12], b_ = K[13]; const bool g_ = a_ > b_; K[12] = g_ ? a_ : b_; K[13] = g_ ? b_ : a_; }
  { const float a_ = K[14], b_ = K[15]; const bool g_ = a_ > b_; K[14] = g_ ? b_ : a_; K[15] = g_ ? a_ : b_; }
  { const float a_ = K[0], b_ = K[2]; const bool g_ = a_ > b_; K[0] = g_ ? a_ : b_; K[2] = g_ ? b_ : a_; }
  { const float a_ = K[1], b_ = K[3]; const bool g_ = a_ > b_; K[1] = g_ ? a_ : b_; K[3] = g_ ? b_ : a_; }
  { const float a_ = K[4], b_ = K[6]; const bool g_ = a_ > b_; K[4] = g_ ? b_ : a_; K[6] = g_ ? a_ : b_; }
  { const float a_ = K[5], b_ = K[7]; const bool g_ = a_ > b_; K[5] = g_ ? b_ : a_; K[7] = g_ ? a_ : b_; }
  { const float a_ = K[8], b_ = K[10]; const bool g_ = a_ > b_; K[8] = g_ ? a_ : b_; K[10] = g_ ? b_ : a_; }
  { const float a_ = K[9], b_ = K[11]; const bool g_ = a_ > b_; K[9] = g_ ? a_ : b_; K[11] = g_ ? b_ : a_; }
  { const float a_ = K[12], b_ = K[14]; const bool g_ = a_ > b_; K[12] = g_ ? b_ : a_; K[14] = g_ ? a_ : b_; }
  { const float a_ = K[13], b_ = K[15]; const bool g_ = a_ > b_; K[13] = g_ ? b_ : a_; K[15] = g_ ? a_ : b_; }
  { const float a_ = K[0], b_ = K[1]; const bool g_ = a_ > b_; K[0] = g_ ? a_ : b_; K[1] = g_ ? b_ : a_; }
  { const float a_ = K[2], b_ = K[3]; const bool g_ = a_ > b_; K[2] = g_ ? a_ : b_; K[3] = g_ ? b_ : a_; }
  { const float a_ = K[4], b_ = K[5]; const bool g_ = a_ > b_; K[4] = g_ ? b_ : a_; K[5] = g_ ? a_ : b_; }
  { const float a_ = K[6], b_ = K[7]; const bool g_ = a_ > b_; K[6] = g_ ? b_ : a_; K[7] = g_ ? a_ : b_; }
  { const float a_ = K[8], b_ = K[9]; const bool g_ = a_ > b_; K[8] = g_ ? a_ : b_; K[9] = g_ ? b_ : a_; }
  { const float a_ = K[10], b_ = K[11]; const bool g_ = a_ > b_; K[10] = g_ ? a_ : b_; K[11] = g_ ? b_ : a_; }
  { const float a_ = K[12], b_ = K[13]; const bool g_ = a_ > b_; K[12] = g_ ? b_ : a_; K[13] = g_ ? a_ : b_; }
  { const float a_ = K[14], b_ = K[15]; const bool g_ = a_ > b_; K[14] = g_ ? b_ : a_; K[15] = g_ ? a_ : b_; }
  { const float a_ = K[0], b_ = K[4]; const bool g_ = a_ > b_; K[0] = g_ ? a_ : b_; K[4] = g_ ? b_ : a_; }
  { const float a_ = K[1], b_ = K[5]; const bool g_ = a_ > b_; K[1] = g_ ? a_ : b_; K[5] = g_ ? b_ : a_; }
  { const float a_ = K[2], b_ = K[6]; const bool g_ = a_ > b_; K[2] = g_ ? a_ : b_; K[6] = g_ ? b_ : a_; }
  { const float a_ = K[3], b_ = K[7]; const bool g_ = a_ > b_; K[3] = g_ ? a_ : b_; K[7] = g_ ? b_ : a_; }
  { const float a_ = K[8], b_ = K[12]; const bool g_ = a_ > b_; K[8] = g_ ? b_ : a_; K[12] = g_ ? a_ : b_; }
  { const float a_ = K[9], b_ = K[13]; const bool g_ = a_ > b_; K[9] = g_ ? b_ : a_; K[13] = g_ ? a_ : b_; }
  { const float a_ = K[10], b_ = K[14]; const bool g_ = a_ > b_; K[10] = g_ ? b_ : a_; K[14] = g_ ? a_ : b_; }
  { const float a_ = K[11], b_ = K[15]; const bool g_ = a_ > b_; K[11] = g_ ? b_ : a_; K[15] = g_ ? a_ : b_; }
  { const float a_ = K[0], b_ = K[2]; const bool g_ = a_ > b_; K[0] = g_ ? a_ : b_; K[2] = g_ ? b_ : a_; }
  { const float a_ = K[1], b_ = K[3]; const bool g_ = a_ > b_; K[1] = g_ ? a_ : b_; K[3] = g_ ? b_ : a_; }
  { const float a_ = K[4], b_ = K[6]; const bool g_ = a_ > b_; K[4] = g_ ? a_ : b_; K[6] = g_ ? b_ : a_; }
  { const float a_ = K[5], b_ = K[7]; const bool g_ = a_ > b_; K[5] = g_ ? a_ : b_; K[7] = g_ ? b_ : a_; }
  { const float a_ = K[8], b_ = K[10]; const bool g_ = a_ > b_; K[8] = g_ ? b_ : a_; K[10] = g_ ? a_ : b_; }
  { const float a_ = K[9], b_ = K[11]; const bool g_ = a_ > b_; K[9] = g_ ? b_ : a_; K[11] = g_ ? a_ : b_; }
  { const float a_ = K[12], b_ = K[14]; const bool g_ = a_ > b_; K[12] = g_ ? b_ : a_; K[14] = g_ ? a_ : b_; }
  { const float a_ = K[13], b_ = K[15]; const bool g_ = a_ > b_; K[13] = g_ ? b_ : a_; K[15] = g_ ? a_ : b_; }
  { const float a_ = K[0], b_ = K[1]; const bool g_ = a_ > b_; K[0] = g_ ? a_ : b_; K[1] = g_ ? b_ : a_; }
  { const float a_ = K[2], b_ = K[3]; const bool g_ = a_ > b_; K[2] = g_ ? a_ : b_; K[3] = g_ ? b_ : a_; }
  { const float a_ = K[4], b_ = K[5]; const bool g_ = a_ > b_; K[4] = g_ ? a_ : b_; K[5] = g_ ? b_ : a_; }
  { const float a_ = K[6], b_ = K[7]; const bool g_ = a_ > b_; K[6] = g_ ? a_ : b_; K[7] = g_ ? b_ : a_; }
  { const float a_ = K[8], b_ = K[9]; const bool g_ = a_ > b_; K[8] = g_ ? b_ : a_; K[9] = g_ ? a_ : b_; }
  { const float a_ = K[10], b_ = K[11]; const bool g_ = a_ > b_; K[10] = g_ ? b_ : a_; K[11] = g_ ? a_ : b_; }
  { const float a_ = K[12], b_ = K[13]; const bool g_ = a_ > b_; K[12] = g_ ? b_ : a_; K[13] = g_ ? a_ : b_; }
  { const float a_ = K[14], b_ = K[15]; const bool g_ = a_ > b_; K[14] = g_ ? b_ : a_; K[15] = g_ ? a_ : b_; }
  { const float a_ = K[0], b_ = K[8]; const bool g_ = a_ > b_; K[0] = g_ ? a_ : b_; K[8] = g_ ? b_ : a_; }
  { const float a_ = K[1], b_ = K[9]; const bool g_ = a_ > b_; K[1] = g_ ? a_ : b_; K[9] = g_ ? b_ : a_; }
  { const float a_ = K[2], b_ = K[10]; const bool g_ = a_ > b_; K[2] = g_ ? a_ : b_; K[10] = g_ ? b_ : a_; }
  { const float a_ = K[3], b_ = K[11]; const bool g_ = a_ > b_; K[3] = g_ ? a_ : b_; K[11] = g_ ? b_ : a_; }
  { const float a_ = K[4], b_ = K[12]; const bool g_ = a_ > b_; K[4] = g_ ? a_ : b_; K[12] = g_ ? b_ : a_; }
  { const float a_ = K[5], b_ = K[13]; const bool g_ = a_ > b_; K[5] = g_ ? a_ : b_; K[13] = g_ ? b_ : a_; }
  { const float a_ = K[6], b_ = K[14]; const bool g_ = a_ > b_; K[6] = g_ ? a_ : b_; K[14] = g_ ? b_ : a_; }
  { const float a_ = K[7], b_ = K[15]; const bool g_ = a_ > b_; K[7] = g_ ? a_ : b_; K[15] = g_ ? b_ : a_; }
  { const float a_ = K[0], b_ = K[4]; const bool g_ = a_ > b_; K[0] = g_ ? a_ : b_; K[4] = g_ ? b_ : a_; }
  { const float a_ = K[1], b_ = K[5]; const bool g_ = a_ > b_; K[1] = g_ ? a_ : b_; K[5] = g_ ? b_ : a_; }
  { const float a_ = K[2], b_ = K[6]; const bool g_ = a_ > b_; K[2] = g_ ? a_ : b_; K[6] = g_ ? b_ : a_; }
  { const float a_ = K[3], b_ = K[7]; const bool g_ = a_ > b_; K[3] = g_ ? a_ : b_; K[7] = g_ ? b_ : a_; }
  { const float a_ = K[8], b_ = K[12]; const bool g_ = a_ > b_; K[8] = g_ ? a_ : b_; K[12] = g_ ? b_ : a_; }
  { const float a_ = K[9], b_ = K[13]; const bool g_ = a_ > b_; K[9] = g_ ? a_ : b_; K[13] = g_ ? b_ : a_; }
  { const float a_ = K[10], b_ = K[14]; const bool g_ = a_ > b_; K[10] = g_ ? a_ : b_; K[14] = g_ ? b_ : a_; }
  { const float a_ = K[11], b_ = K[15]; const bool g_ = a_ > b_; K[11] = g_ ? a_ : b_; K[15] = g_ ? b_ : a_; }
  { const float a_ = K[0], b_ = K[2]; const bool g_ = a_ > b_; K[0] = g_ ? a_ : b_; K[2] = g_ ? b_ : a_; }
  { const float a_ = K[1], b_ = K[3]; const bool g_ = a_ > b_; K[1] = g_ ? a_ : b_; K[3] = g_ ? b_ : a_; }
  { const float a_ = K[4], b_ = K[6]; const bool g_ = a_ > b_; K[4] = g_ ? a_ : b_; K[6] = g_ ? b_ : a_; }
  { const float a_ = K[5], b_ = K[7]; const bool g_ = a_ > b_; K[5] = g_ ? a_ : b_; K[7] = g_ ? b_ : a_; }
  { const float a_ = K[8], b_ = K[10]; const bool g_ = a_ > b_; K[8] = g_ ? a_ : b_; K[10] = g_ ? b_ : a_; }
  { const float a_ = K[9], b_ = K[11]; const bool g_ = a_ > b_; K[9] = g_ ? a_ : b_; K[11] = g_ ? b_ : a_; }
  { const float a_ = K[12], b_ = K[14]; const bool g_ = a_ > b_; K[12] = g_ ? a_ : b_; K[14] = g_ ? b_ : a_; }
  { const float a_ = K[13], b_ = K[15]; const bool g_ = a_ > b_; K[13] = g_ ? a_ : b_; K[15] = g_ ? b_ : a_; }
  { const float a_ = K[0], b_ = K[1]; const bool g_ = a_ > b_; K[0] = g_ ? a_ : b_; K[1] = g_ ? b_ : a_; }
  { const float a_ = K[2], b_ = K[3]; const bool g_ = a_ > b_; K[2] = g_ ? a_ : b_; K[3] = g_ ? b_ : a_; }
  { const float a_ = K[4], b_ = K[5]; const bool g_ = a_ > b_; K[4] = g_ ? a_ : b_; K[5] = g_ ? b_ : a_; }
  { const float a_ = K[6], b_ = K[7]; const bool g_ = a_ > b_; K[6] = g_ ? a_ : b_; K[7] = g_ ? b_ : a_; }
  { const float a_ = K[8], b_ = K[9]; const bool g_ = a_ > b_; K[8] = g_ ? a_ : b_; K[9] = g_ ? b_ : a_; }
  { const float a_ = K[10], b_ = K[11]; const bool g_ = a_ > b_; K[10] = g_ ? a_ : b_; K[11] = g_ ? b_ : a_; }
  { const float a_ = K[12], b_ = K[13]; const bool g_ = a_ > b_; K[12] = g_ ? a_ : b_; K[13] = g_ ? b_ : a_; }
  { const float a_ = K[14], b_ = K[15]; const bool g_ = a_ > b_; K[14] = g_ ? a_ : b_; K[15] = g_ ? b_ : a_; }
  { const float a_ = K[16], b_ = K[17]; const bool g_ = a_ > b_; K[16] = g_ ? a_ : b_; K[17] = g_ ? b_ : a_; }
  { const float a_ = K[18], b_ = K[19]; const bool g_ = a_ > b_; K[18] = g_ ? b_ : a_; K[19] = g_ ? a_ : b_; }
  { const float a_ = K[20], b_ = K[21]; const bool g_ = a_ > b_; K[20] = g_ ? a_ : b_; K[21] = g_ ? b_ : a_; }
  { const float a_ = K[22], b_ = K[23]; const bool g_ = a_ > b_; K[22] = g_ ? b_ : a_; K[23] = g_ ? a_ : b_; }
  { const float a_ = K[24], b_ = K[25]; const bool g_ = a_ > b_; K[24] = g_ ? a_ : b_; K[25] = g_ ? b_ : a_; }
  { const float a_ = K[26], b_ = K[27]; const bool g_ = a_ > b_; K[26] = g_ ? b_ : a_; K[27] = g_ ? a_ : b_; }
  { const float a_ = K[28], b_ = K[29]; const bool g_ = a_ > b_; K[28] = g_ ? a_ : b_; K[29] = g_ ? b_ : a_; }
  { const float a_ = K[30], b_ = K[31]; const bool g_ = a_ > b_; K[30] = g_ ? b_ : a_; K[31] = g_ ? a_ : b_; }
  { const float a_ = K[16], b_ = K[18]; const bool g_ = a_ > b_; K[16] = g_ ? a_ : b_; K[18] = g_ ? b_ : a_; }
  { const float a_ = K[17], b_ = K[19]; const bool g_ = a_ > b_; K[17] = g_ ? a_ : b_; K[19] = g_ ? b_ : a_; }
  { const float a_ = K[20], b_ = K[22]; const bool g_ = a_ > b_; K[20] = g_ ? b_ : a_; K[22] = g_ ? a_ : b_; }
  { const float a_ = K[21], b_ = K[23]; const bool g_ = a_ > b_; K[21] = g_ ? b_ : a_; K[23] = g_ ? a_ : b_; }
  { const float a_ = K[24], b_ = K[26]; const bool g_ = a_ > b_; K[24] = g_ ? a_ : b_; K[26] = g_ ? b_ : a_; }
  { const float a_ = K[25], b_ = K[27]; const bool g_ = a_ > b_; K[25] = g_ ? a_ : b_; K[27] = g_ ? b_ : a_; }
  { const float a_ = K[28], b_ = K[30]; const bool g_ = a_ > b_; K[28] = g_ ? b_ : a_; K[30] = g_ ? a_ : b_; }
  { const float a_ = K[29], b_ = K[31]; const bool g_ = a_ > b_; K[29] = g_ ? b_ : a_; K[31] = g_ ? a_ : b_; }
  { const float a_ = K[16], b_ = K[17]; const bool g_ = a_ > b_; K[16] = g_ ? a_ : b_; K[17] = g_ ? b_ : a_; }
  { const float a_ = K[18], b_ = K[19]; const bool g_ = a_ > b_; K[18] = g_ ? a_ : b_; K[19] = g_ ? b_ : a_; }
  { const float a_ = K[20], b_ = K[21]; const bool g_ = a_ > b_; K[20] = g_ ? b_ : a_; K[21] = g_ ? a_ : b_; }
  { const float a_ = K[22], b_ = K[23]; const bool g_ = a_ > b_; K[22] = g_ ? b_ : a_; K[23] = g_ ? a_ : b_; }
  { const float a_ = K[24], b_ = K[25]; const bool g_ = a_ > b_; K[24] = g_ ? a_ : b_; K[25] = g_ ? b_ : a_; }
  { const float a_ = K[26], b_ = K[27]; const bool g_ = a_ > b_; K[26] = g_ ? a_ : b_; K[27] = g_ ? b_ : a_; }
  { const float a_ = K[28], b_ = K[29]; const bool g_ = a_ > b_; K[28] = g_ ? b_ : a_; K[29] = g_ ? a_ : b_; }
  { const float a_ = K[30], b_ = K[31]; const bool g_ = a_ > b_; K[30] = g_ ? b_ : a_; K[31] = g_ ? a_ : b_; }
  { const float a_ = K[16], b_ = K[20]; const bool g_ = a_ > b_; K[16] = g_ ? a_ : b_; K[20] = g_ ? b_ : a_; }
  { const float a_ = K[17], b_ = K[21]; const bool g_ = a_ > b_; K[17] = g_ ? a_ : b_; K[21] = g_ ? b_ : a_; }
  { const float a_ = K[18], b_ = K[22]; const bool g_ = a_ > b_; K[18] = g_ ? a_ : b_; K[22] = g_ ? b_ : a_; }
  { const float a_ = K[19], b_ = K[23]; const bool g_ = a_ > b_; K[19] = g_ ? a_ : b_; K[23] = g_ ? b_ : a_; }
  { const float a_ = K[24], b_ = K[28]; const bool g_ = a_ > b_; K[24] = g_ ? b_ : a_; K[28] = g_ ? a_ : b_; }
  { const float a_ = K[25], b_ = K[29]; const bool g_ = a_ > b_; K[25] = g_ ? b_ : a_; K[29] = g_ ? a_ : b_; }
  { const float a_ = K[26], b_ = K[30]; const bool g_ = a_ > b_; K[26] = g_ ? b_ : a_; K[30] = g_ ? a_ : b_; }
  { const float a_ = K[27], b_ = K[31]; const bool g_ = a_ > b_; K[27] = g_ ? b_ : a_; K[31] = g_ ? a_ : b_; }
  { const float a_ = K[16], b_ = K[18]; const bool g_ = a_ > b_; K[16] = g_ ? a_ : b_; K[18] = g_ ? b_ : a_; }
  { const float a_ = K[17], b_ = K[19]; const bool g_ = a_ > b_; K[17] = g_ ? a_ : b_; K[19] = g_ ? b_ : a_; }
  { const float a_ = K[20], b_ = K[22]; const bool g_ = a_ > b_; K[20] = g_ ? a_ : b_; K[22] = g_ ? b_ : a_; }
  { const float a_ = K[21], b_ = K[23]; const bool g_ = a_ > b_; K[21] = g_ ? a_ : b_; K[23] = g_ ? b_ : a_; }
  { const float a_ = K[24], b_ = K[26]; const bool g_ = a_ > b_; K[24] = g_ ? b_ : a_; K[26] = g_ ? a_ : b_; }
  { const float a_ = K[25], b_ = K[27]; const bool g_ = a_ > b_; K[25] = g_ ? b_ : a_; K[27] = g_ ? a_ : b_; }
  { const float a_ = K[28], b_ = K[30]; const bool g_ = a_ > b_; K[28] = g_ ? b_ : a_; K[30] = g_ ? a_ : b_; }
  { const float a_ = K[29], b_ = K[31]; const bool g_ = a_ > b_; K[29] = g_ ? b_ : a_; K[31] = g_ ? a_ : b_; }
  { const float a_ = K[16], b_ = K[17]; const bool g_ = a_ > b_; K[16] = g_ ? a_ : b_; K[17] = g_ ? b_ : a_; }
  { const float a_ = K[18], b_ = K[19]; const bool g_ = a_ > b_; K[18] = g_ ? a_ : b_; K[19] = g_ ? b_ : a_; }
  { const float a_ = K[20], b_ = K[21]; const bool g_ = a_ > b_; K[20] = g_ ? a_ : b_; K[21] = g_ ? b_ : a_; }
  { const float a_ = K[22], b_ = K[23]; const bool g_ = a_ > b_; K[22] = g_ ? a_ : b_; K[23] = g_ ? b_ : a_; }
  { const float a_ = K[24], b_ = K[25]; const bool g_ = a_ > b_; K[24] = g_ ? b_ : a_; K[25] = g_ ? a_ : b_; }
  { const float a_ = K[26], b_ = K[27]; const bool g_ = a_ > b_; K[26] = g_ ? b_ : a_; K[27] = g_ ? a_ : b_; }
  { const float a_ = K[28], b_ = K[29]; const bool g_ = a_ > b_; K[28] = g_ ? b_ : a_; K[29] = g_ ? a_ : b_; }
  { const float a_ = K[30], b_ = K[31]; const bool g_ = a_ > b_; K[30] = g_ ? b_ : a_; K[31] = g_ ? a_ : b_; }
  { const float a_ = K[16], b_ = K[24]; const bool g_ = a_ > b_; K[16] = g_ ? a_ : b_; K[24] = g_ ? b_ : a_; }
  { const float a_ = K[17], b_ = K[25]; const bool g_ = a_ > b_; K[17] = g_ ? a_ : b_; K[25] = g_ ? b_ : a_; }
  { const float a_ = K[18], b_ = K[26]; const bool g_ = a_ > b_; K[18] = g_ ? a_ : b_; K[26] = g_ ? b_ : a_; }
  { const float a_ = K[19], b_ = K[27]; const bool g_ = a_ > b_; K[19] = g_ ? a_ : b_; K[27] = g_ ? b_ : a_; }
  { const float a_ = K[20], b_ = K[28]; const bool g_ = a_ > b_; K[20] = g_ ? a_ : b_; K[28] = g_ ? b_ : a_; }
  { const float a_ = K[21], b_ = K[29]; const bool g_ = a_ > b_; K[21] = g_ ? a_ : b_; K[29] = g_ ? b_ : a_; }
  { const float a_ = K[22], b_ = K[30]; const bool g_ = a_ > b_; K[22] = g_ ? a_ : b_; K[30] = g_ ? b_ : a_; }
  { const float a_ = K[23], b_ = K[31]; const bool g_ = a_ > b_; K[23] = g_ ? a_ : b_; K[31] = g_ ? b_ : a_; }
  { const float a_ = K[16], b_ = K[20]; const bool g_ = a_ > b_; K[16] = g_ ? a_ : b_; K[20] = g_ ? b_ : a_; }
  { const float a_ = K[17], b_ = K[21]; const bool g_ = a_ > b_; K[17] = g_ ? a_ : b_; K[21] = g_ ? b_ : a_; }
  { const float a_ = K[18], b_ = K[22]; const bool g_ = a_ > b_; K[18] = g_ ? a_ : b_; K[22] = g_ ? b_ : a_; }
  { const float a_ = K[19], b_ = K[23]; const bool g_ = a_ > b_; K[19] = g_ ? a_ : b_; K[23] = g_ ? b_ : a_; }
  { const float a_ = K[24], b_ = K[28]; const bool g_ = a_ > b_; K[24] = g_ ? a_ : b_; K[28] = g_ ? b_ : a_; }
  { const float a_ = K[25], b_ = K[29]; const bool g_ = a_ > b_; K[25] = g_ ? a_ : b_; K[29] = g_ ? b_ : a_; }
  { const float a_ = K[26], b_ = K[30]; const bool g_ = a_ > b_; K[26] = g_ ? a_ : b_; K[30] = g_ ? b_ : a_; }
  { const float a_ = K[27], b_ = K[31]; const bool g_ = a_ > b_; K[27] = g_ ? a_ : b_; K[31] = g_ ? b_ : a_; }
  { const float a_ = K[16], b_ = K[18]; const bool g_ = a_ > b_; K[16] = g_ ? a_ : b_; K[18] = g_ ? b_ : a_; }
  { const float a_ = K[17], b_ = K[19]; const bool g_ = a_ > b_; K[17] = g_ ? a_ : b_; K[19] = g_ ? b_ : a_; }
  { const float a_ = K[20], b_ = K[22]; const bool g_ = a_ > b_; K[20] = g_ ? a_ : b_; K[22] = g_ ? b_ : a_; }
  { const float a_ = K[21], b_ = K[23]; const bool g_ = a_ > b_; K[21] = g_ ? a_ : b_; K[23] = g_ ? b_ : a_; }
  { const float a_ = K[24], b_ = K[26]; const bool g_ = a_ > b_; K[24] = g_ ? a_ : b_; K[26] = g_ ? b_ : a_; }
  { const float a_ = K[25], b_ = K[27]; const bool g_ = a_ > b_; K[25] = g_ ? a_ : b_; K[27] = g_ ? b_ : a_; }
  { const float a_ = K[28], b_ = K[30]; const bool g_ = a_ > b_; K[28] = g_ ? a_ : b_; K[30] = g_ ? b_ : a_; }
  { const float a_ = K[29], b_ = K[31]; const bool g_ = a_ > b_; K[29] = g_ ? a_ : b_; K[31] = g_ ? b_ : a_; }
  { const float a_ = K[16], b_ = K[17]; const bool g_ = a_ > b_; K[16] = g_ ? a_ : b_; K[17] = g_ ? b_ : a_; }
  { const float a_ = K[18], b_ = K[19]; const bool g_ = a_ > b_; K[18] = g_ ? a_ : b_; K[19] = g_ ? b_ : a_; }
  { const float a_ = K[20], b_ = K[21]; const bool g_ = a_ > b_; K[20] = g_ ? a_ : b_; K[21] = g_ ? b_ : a_; }
  { const float a_ = K[22], b_ = K[23]; const bool g_ = a_ > b_; K[22] = g_ ? a_ : b_; K[23] = g_ ? b_ : a_; }
  { const float a_ = K[24], b_ = K[25]; const bool g_ = a_ > b_; K[24] = g_ ? a_ : b_; K[25] = g_ ? b_ : a_; }
  { const float a_ = K[26], b_ = K[27]; const bool g_ = a_ > b_; K[26] = g_ ? a_ : b_; K[27] = g_ ? b_ : a_; }
  { const float a_ = K[28], b_ = K[29]; const bool g_ = a_ > b_; K[28] = g_ ? a_ : b_; K[29] = g_ ? b_ : a_; }
  { const float a_ = K[30], b_ = K[31]; const bool g_ = a_ > b_; K[30] = g_ ? a_ : b_; K[31] = g_ ? b_ : a_; }
  { const float a_ = K[32], b_ = K[33]; const bool g_ = a_ > b_; K[32] = g_ ? a_ : b_; K[33] = g_ ? b_ : a_; }
  { const float a_ = K[34], b_ = K[35]; const bool g_ = a_ > b_; K[34] = g_ ? b_ : a_; K[35] = g_ ? a_ : b_; }
  { const float a_ = K[36], b_ = K[37]; const bool g_ = a_ > b_; K[36] = g_ ? a_ : b_; K[37] = g_ ? b_ : a_; }
  { const float a_ = K[38], b_ = K[39]; const bool g_ = a_ > b_; K[38] = g_ ? b_ : a_; K[39] = g_ ? a_ : b_; }
  { const float a_ = K[40], b_ = K[41]; const bool g_ = a_ > b_; K[40] = g_ ? a_ : b_; K[41] = g_ ? b_ : a_; }
  { const float a_ = K[42], b_ = K[43]; const bool g_ = a_ > b_; K[42] = g_ ? b_ : a_; K[43] = g_ ? a_ : b_; }
  { const float a_ = K[44], b_ = K[45]; const bool g_ = a_ > b_; K[44] = g_ ? a_ : b_; K[45] = g_ ? b_ : a_; }
  { const float a_ = K[46], b_ = K[47]; const bool g_ = a_ > b_; K[46] = g_ ? b_ : a_; K[47] = g_ ? a_ : b_; }
  { const float a_ = K[32], b_ = K[34]; const bool g_ = a_ > b_; K[32] = g_ ? a_ : b_; K[34] = g_ ? b_ : a_; }
  { const float a_ = K[33], b_ = K[35]; const bool g_ = a_ > b_; K[33] = g_ ? a_ : b_; K[35] = g_ ? b_ : a_; }
  { const float a_ = K[36], b_ = K[38]; const bool g_ = a_ > b_; K[36] = g_ ? b_ : a_; K[38] = g_ ? a_ : b_; }
  { const float a_ = K[37], b_ = K[39]; const bool g_ = a_ > b_; K[37] = g_ ? b_ : a_; K[39] = g_ ? a_ : b_; }
  { const float a_ = K[40], b_ = K[42]; const bool g_ = a_ > b_; K[40] = g_ ? a_ : b_; K[42] = g_ ? b_ : a_; }
  { const float a_ = K[41], b_ = K[43]; const bool g_ = a_ > b_; K[41] = g_ ? a_ : b_; K[43] = g_ ? b_ : a_; }
  { const float a_ = K[44], b_ = K[46]; const bool g_ = a_ > b_; K[44] = g_ ? b_ : a_; K[46] = g_ ? a_ : b_; }
  { const float a_ = K[45], b_ = K[47]; const bool g_ = a_ > b_; K[45] = g_ ? b_ : a_; K[47] = g_ ? a_ : b_; }
  { const float a_ = K[32], b_ = K[33]; const bool g_ = a_ > b_; K[32] = g_ ? a_ : b_; K[33] = g_ ? b_ : a_; }
  { const float a_ = K[34], b_ = K[35]; const bool g_ = a_ > b_; K[34] = g_ ? a_ : b_; K[35] = g_ ? b_ : a_; }
  { const float a_ = K[36], b_ = K[37]; const bool g_ = a_ > b_; K[36] = g_ ? b_ : a_; K[37] = g_ ? a_ : b_; }
  { const float a_ = K[38], b_ = K[39]; const bool g_ = a_ > b_; K[38] = g_ ? b_ : a_; K[39] = g_ ? a_ : b_; }
  { const float a_ = K[40], b_ = K[41]; const bool g_ = a_ > b_; K[40] = g_ ? a_ : b_; K[41] = g_ ? b_ : a_; }
  { const float a_ = K[42], b_ = K[43]; const bool g_ = a_ > b_; K[42] = g_ ? a_ : b_; K[43] = g_ ? b_ : a_; }
  { const float a_ = K[44], b_ = K[45]; const bool g_ = a_ > b_; K[44] = g_ ? b_ : a_; K[45] = g_ ? a_ : b_; }
  { const float a_ = K[46], b_ = K[47]; const bool g_ = a_ > b_; K[46] = g_ ? b_ : a_; K[47] = g_ ? a_ : b_; }
  { const float a_ = K[32], b_ = K[36]; const bool g_ = a_ > b_; K[32] = g_ ? a_ : b_; K[36] = g_ ? b_ : a_; }
  { const float a_ = K[33], b_ = K[37]; const bool g_ = a_ > b_; K[33] = g_ ? a_ : b_; K[37] = g_ ? b_ : a_; }
  { const float a_ = K[34], b_ = K[38]; const bool g_ = a_ > b_; K[34] = g_ ? a_ : b_; K[38] = g_ ? b_ : a_; }
  { const float a_ = K[35], b_ = K[39]; const bool g_ = a_ > b_; K[35] = g_ ? a_ : b_; K[39] = g_ ? b_ : a_; }
  { const float a_ = K[40], b_ = K[44]; const bool g_ = a_ > b_; K[40] = g_ ? b_ : a_; K[44] = g_ ? a_ : b_; }
  { const float a_ = K[41], b_ = K[45]; const bool g_ = a_ > b_; K[41] = g_ ? b_ : a_; K[45] = g_ ? a_ : b_; }
  { const float a_ = K[42], b_ = K[46]; const bool g_ = a_ > b_; K[42] = g_ ? b_ : a_; K[46] = g_ ? a_ : b_; }
  { const float a_ = K[43], b_ = K[47]; const bool g_ = a_ > b_; K[43] = g_ ? b_ : a_; K[47] = g_ ? a_ : b_; }
  { const float a_ = K[32], b_ = K[34]; const bool g_ = a_ > b_; K[32] = g_ ? a_ : b_; K[34] = g_ ? b_ : a_; }
  { const float a_ = K[33], b_ = K[35]; const bool g_ = a_ > b_; K[33] = g_ ? a_ : b_; K[35] = g_ ? b_ : a_; }
  { const float a_ = K[36], b_ = K[38]; const bool g_ = a_ > b_; K[36] = g_ ? a_ : b_; K[38] = g_ ? b_ : a_; }
  { const float a_ = K[37], b_ = K[39]; const bool g_ = a_ > b_; K[37] = g_ ? a_ : b_; K[39] = g_ ? b_ : a_; }
  { const float a_ = K[40], b_ = K[42]; const bool g_ = a_ > b_; K[40] = g_ ? b_ : a_; K[42] = g_ ? a_ : b_; }
  { const float a_ = K[41], b_ = K[43]; const bool g_ = a_ > b_; K[41] = g_ ? b_ : a_; K[43] = g_ ? a_ : b_; }
  { const float a_ = K[44], b_ = K[46]; const bool g_ = a_ > b_; K[44] = g_ ? b_ : a_; K[46] = g_ ? a_ : b_; }
  { const float a_ = K[45], b_ = K[47]; const bool g_ = a_ > b_; K[45] = g_ ? b_ : a_; K[47] = g_ ? a_ : b_; }
  { const float a_ = K[32], b_ = K[33]; const bool g_ = a_ > b_; K[32] = g_ ? a_ : b_; K[33] = g_ ? b_ : a_; }
  { const float a_ = K[34], b_ = K[35]; const bool g_ = a_ > b_; K[34] = g_ ? a_ : b_; K[35] = g_ ? b_ : a_; }
  { const float a_ = K[36], b_ = K[37]; const bool g_ = a_ > b_; K[36] = g_ ? a_ : b_; K[37] = g_ ? b_ : a_; }
  { const float a_ = K[38], b_ = K[39]; const bool g_ = a_ > b_; K[38] = g_ ? a_ : b_; K[39] = g_ ? b_ : a_; }
  { const float a_ = K[40], b_ = K[41]; const bool g_ = a_ > b_; K[40] = g_ ? b_ : a_; K[41] = g_ ? a_ : b_; }
  { const float a_ = K[42], b_ = K[43]; const bool g_ = a_ > b_; K[42] = g_ ? b_ : a_; K[43] = g_ ? a_ : b_; }
  { const float a_ = K[44], b_ = K[45]; const bool g_ = a_ > b_; K[44] = g_ ? b_ : a_; K[45] = g_ ? a_ : b_; }
  { const float a_ = K[46], b_ = K[47]; const bool g_ = a_ > b_; K[46] = g_ ? b_ : a_; K[47] = g_ ? a_ : b_; }
  { const float a_ = K[32], b_ = K[40]; const bool g_ = a_ > b_; K[32] = g_ ? a_ : b_; K[40] = g_ ? b_ : a_; }
  { const float a_ = K[33], b_ = K[41]; const bool g_ = a_ > b_; K[33] = g_ ? a_ : b_; K[41] = g_ ? b_ : a_; }
  { const float a_ = K[34], b_ = K[42]; const bool g_ = a_ > b_; K[34] = g_ ? a_ : b_; K[42] = g_ ? b_ : a_; }
  { const float a_ = K[35], b_ = K[43]; const bool g_ = a_ > b_; K[35] = g_ ? a_ : b_; K[43] = g_ ? b_ : a_; }
  { const float a_ = K[36], b_ = K[44]; const bool g_ = a_ > b_; K[36] = g_ ? a_ : b_; K[44] = g_ ? b_ : a_; }
  { const float a_ = K[37], b_ = K[45]; const bool g_ = a_ > b_; K[37] = g_ ? a_ : b_; K[45] = g_ ? b_ : a_; }
  { const float a_ = K[38], b_ = K[46]; const bool g_ = a_ > b_; K[38] = g_ ? a_ : b_; K[46] = g_ ? b_ : a_; }
  { const float a_ = K[39], b_ = K[47]; const bool g_ = a_ > b_; K[39] = g_ ? a_ : b_; K[47] = g_ ? b_ : a_; }
  { const float a_ = K[32], b_ = K[36]; const bool g_ = a_ > b_; K[32] = g_ ? a_ : b_; K[36] = g_ ? b_ : a_; }
  { const float a_ = K[33], b_ = K[37]; const bool g_ = a_ > b_; K[33] = g_ ? a_ : b_; K[37] = g_ ? b_ : a_; }
  { const float a_ = K[34], b_ = K[38]; const bool g_ = a_ > b_; K[34] = g_ ? a_ : b_; K[38] = g_ ? b_ : a_; }
  { const float a_ = K[35], b_ = K[39]; const bool g_ = a_ > b_; K[35] = g_ ? a_ : b_; K[39] = g_ ? b_ : a_; }
  { const float a_ = K[40], b_ = K[44]; const bool g_ = a_ > b_; K[40] = g_ ? a_ : b_; K[44] = g_ ? b_ : a_; }
  { const float a_ = K[41], b_ = K[45]; const bool g_ = a_ > b_; K[41] = g_ ? a_ : b_; K[45] = g_ ? b_ : a_; }
  { const float a_ = K[42], b_ = K[46]; const bool g_ = a_ > b_; K[42] = g_ ? a_ : b_; K[46] = g_ ? b_ : a_; }
  { const float a_ = K[43], b_ = K[47]; const bool g_ = a_ > b_; K[43] = g_ ? a_ : b_; K[47] = g_ ? b_ : a_; }
  { const float a_ = K[32], b_ = K[34]; const bool g_ = a_ > b_; K[32] = g_ ? a_ : b_; K[34] = g_ ? b_ : a_; }
  { const float a_ = K[33], b_ = K[35]; const bool g_ = a_ > b_; K[33] = g_ ? a_ : b_; K[35] = g_ ? b_ : a_; }
  { const float a_ = K[36], b_ = K[38]; const bool g_ = a_ > b_; K[36] = g_ ? a_ : b_; K[38] = g_ ? b_ : a_; }
  { const float a_ = K[37], b_ = K[39]; const bool g_ = a_ > b_; K[37] = g_ ? a_ : b_; K[39] = g_ ? b_ : a_; }
  { const float a_ = K[40], b_ = K[42]; const bool g_ = a_ > b_; K[40] = g_ ? a_ : b_; K[42] = g_ ? b_ : a_; }
  { const float a_ = K[41], b_ = K[43]; const bool g_ = a_ > b_; K[41] = g_ ? a_ : b_; K[43] = g_ ? b_ : a_; }
  { const float a_ = K[44], b_ = K[46]; const bool g_ = a_ > b_; K[44] = g_ ? a_ : b_; K[46] = g_ ? b_ : a_; }
  { const float a_ = K[45], b_ = K[47]; const bool g_ = a_ > b_; K[45] = g_ ? a_ : b_; K[47] = g_ ? b_ : a_; }
  { const float a_ = K[32], b_ = K[33]; const bool g_ = a_ > b_; K[32] = g_ ? a_ : b_; K[33] = g_ ? b_ : a_; }
  { const float a_ = K[34], b_ = K[35]; const bool g_ = a_ > b_; K[34] = g_ ? a_ : b_; K[35] = g_ ? b_ : a_; }
  { const float a_ = K[36], b_ = K[37]; const bool g_ = a_ > b_; K[36] = g_ ? a_ : b_; K[37] = g_ ? b_ : a_; }
  { const float a_ = K[38], b_ = K[39]; const bool g_ = a_ > b_; K[38] = g_ ? a_ : b_; K[39] = g_ ? b_ : a_; }
  { const float a_ = K[40], b_ = K[41]; const bool g_ = a_ > b_; K[40] = g_ ? a_ : b_; K[41] = g_ ? b_ : a_; }
  { const float a_ = K[42], b_ = K[43]; const bool g_ = a_ > b_; K[42] = g_ ? a_ : b_; K[43] = g_ ? b_ : a_; }
  { const float a_ = K[44], b_ = K[45]; const bool g_ = a_ > b_; K[44] = g_ ? a_ : b_; K[45] = g_ ? b_ : a_; }
  { const float a_ = K[46], b_ = K[47]; const bool g_ = a_ > b_; K[46] = g_ ? a_ : b_; K[47] = g_ ? b_ : a_; }
  { const float a_ = K[48], b_ = K[49]; const bool g_ = a_ > b_; K[48] = g_ ? a_ : b_; K[49] = g_ ? b_ : a_; }
  { const float a_ = K[50], b_ = K[51]; const bool g_ = a_ > b_; K[50] = g_ ? b_ : a_; K[51] = g_ ? a_ : b_; }
  { const float a_ = K[52], b_ = K[53]; const bool g_ = a_ > b_; K[52] = g_ ? a_ : b_; K[53] = g_ ? b_ : a_; }
  { const float a_ = K[54], b_ = K[55]; const bool g_ = a_ > b_; K[54] = g_ ? b_ : a_; K[55] = g_ ? a_ : b_; }
  { const float a_ = K[56], b_ = K[57]; const bool g_ = a_ > b_; K[56] = g_ ? a_ : b_; K[57] = g_ ? b_ : a_; }
  { const float a_ = K[58], b_ = K[59]; const bool g_ = a_ > b_; K[58] = g_ ? b_ : a_; K[59] = g_ ? a_ : b_; }
  { const float a_ = K[60], b_ = K[61]; const bool g_ = a_ > b_; K[60] = g_ ? a_ : b_; K[61] = g_ ? b_ : a_; }
  { const float a_ = K[62], b_ = K[63]; const bool g_ = a_ > b_; K[62] = g_ ? b_ : a_; K[63] = g_ ? a_ : b_; }
  { const float a_ = K[48], b_ = K[50]; const bool g_ = a_ > b_; K[48] = g_ ? a_ : b_; K[50] = g_ ? b_ : a_; }
  { const float a_ = K[49], b_ = K[51]; const bool g_ = a_ > b_; K[49] = g_ ? a_ : b_; K[51] = g_ ? b_ : a_; }
  { const float a_ = K[52], b_ = K[54]; const bool g_ = a_ > b_; K[52] = g_ ? b_ : a_; K[54] = g_ ? a_ : b_; }
  { const float a_ = K[53], b_ = K[55]; const bool g_ = a_ > b_; K[53] = g_ ? b_ : a_; K[55] = g_ ? a_ : b_; }
  { const float a_ = K[56], b_ = K[58]; const bool g_ = a_ > b_; K[56] = g_ ? a_ : b_; K[58] = g_ ? b_ : a_; }
  { const float a_ = K[57], b_ = K[59]; const bool g_ = a_ > b_; K[57] = g_ ? a_ : b_; K[59] = g_ ? b_ : a_; }
  { const float a_ = K[60], b_ = K[62]; const bool g_ = a_ > b_; K[60] = g_ ? b_ : a_; K[62] = g_ ? a_ : b_; }
  { const float a_ = K[61], b_ = K[63]; const bool g_ = a_ > b_; K[61] = g_ ? b_ : a_; K[63] = g_ ? a_ : b_; }
  { const float a_ = K[48], b_ = K[49]; const bool g_ = a_ > b_; K[48] = g_ ? a_ : b_; K[49] = g_ ? b_ : a_; }
  { const float a_ = K[50], b_ = K[51]; const bool g_ = a_ > b_; K[50] = g_ ? a_ : b_; K[51] = g_ ? b_ : a_; }
  { const float a_ = K[52], b_ = K[53]; const bool g_ = a_ > b_; K[52] = g_ ? b_ : a_; K[53] = g_ ? a_ : b_; }
  { const float a_ = K[54], b_ = K[55]; const bool g_ = a_ > b_; K[54] = g_ ? b_ : a_; K[55] = g_ ? a_ : b_; }
  { const float a_ = K[56], b_ = K[57]; const bool g_ = a_ > b_; K[56] = g_ ? a_ : b_; K[57] = g_ ? b_ : a_; }
  { const float a_ = K[58], b_ = K[59]; const bool g_ = a_ > b_; K[58] = g_ ? a_ : b_; K[59] = g_ ? b_ : a_; }
  { const float a_ = K[60], b_ = K[61]; const bool g_ = a_ > b_; K[60] = g_ ? b_ : a_; K[61] = g_ ? a_ : b_; }
  { const float a_ = K[62], b_ = K[63]; const bool g_ = a_ > b_; K[62] = g_ ? b_ : a_; K[63] = g_ ? a_ : b_; }
  { const float a_ = K[48], b_ = K[52]; const bool g_ = a_ > b_; K[48] = g_ ? a_ : b_; K[52] = g_ ? b_ : a_; }
  { const float a_ = K[49], b_ = K[53]; const bool g_ = a_ > b_; K[49] = g_ ? a_ : b_; K[53] = g_ ? b_ : a_; }
  { const float a_ = K[50], b_ = K[54]; const bool g_ = a_ > b_; K[50] = g_ ? a_ : b_; K[54] = g_ ? b_ : a_; }
  { const float a_ = K[51], b_ = K[55]; const bool g_ = a_ > b_; K[51] = g_ ? a_ : b_; K[55] = g_ ? b_ : a_; }
  { const float a_ = K[56], b_ = K[60]; const bool g_ = a_ > b_; K[56] = g_ ? b_ : a_; K[60] = g_ ? a_ : b_; }
  { const float a_ = K[57], b_ = K[61]; const bool g_ = a_ > b_; K[57] = g_ ? b_ : a_; K[61] = g_ ? a_ : b_; }
  { const float a_ = K[58], b_ = K[62]; const bool g_ = a_ > b_; K[58] = g_ ? b_ : a_; K[62] = g_ ? a_ : b_; }
  { const float a_ = K[59], b_ = K[63]; const bool g_ = a_ > b_; K[59] = g_ ? b_ : a_; K[63] = g_ ? a_ : b_; }
  { const float a_ = K[48], b_ = K[50]; const bool g_ = a_ > b_; K[48] = g_ ? a_ : b_; K[50] = g_ ? b_ : a_; }
  { const float a_ = K[49], b_ = K[51]; const bool g_ = a_ > b_; K[49] = g_ ? a_ : b_; K[51] = g_ ? b_ : a_; }
  { const float a_ = K[52], b_ = K[54]; const bool g_ = a_ > b_; K[52] = g_ ? a_ : b_; K[54] = g_ ? b_ : a_; }
  { const float a_ = K[53], b_ = K[55]; const bool g_ = a_ > b_; K[53] = g_ ? a_ : b_; K[55] = g_ ? b_ : a_; }
  { const float a_ = K[56], b_ = K[58]; const bool g_ = a_ > b_; K[56] = g_ ? b_ : a_; K[58] = g_ ? a_ : b_; }
  { const float a_ = K[57], b_ = K[59]; const bool g_ = a_ > b_; K[57] = g_ ? b_ : a_; K[59] = g_ ? a_ : b_; }
  { const float a_ = K[60], b_ = K[62]; const bool g_ = a_ > b_; K[60] = g_ ? b_ : a_; K[62] = g_ ? a_ : b_; }
  { const float a_ = K[61], b_ = K[63]; const bool g_ = a_ > b_; K[61] = g_ ? b_ : a_; K[63] = g_ ? a_ : b_; }
  { const float a_ = K[48], b_ = K[49]; const bool g_ = a_ > b_; K[48] = g_ ? a_ : b_; K[49] = g_ ? b_ : a_; }
  { const float a_ = K[50], b_ = K[51]; const bool g_ = a_ > b_; K[50] = g_ ? a_ : b_; K[51] = g_ ? b_ : a_; }
  { const float a_ = K[52], b_ = K[53]; const bool g_ = a_ > b_; K[52] = g_ ? a_ : b_; K[53] = g_ ? b_ : a_; }
  { const float a_ = K[54], b_ = K[55]; const bool g_ = a_ > b_; K[54] = g_ ? a_ : b_; K[55] = g_ ? b_ : a_; }
  { const float a_ = K[56], b_ = K[57]; const bool g_ = a_ > b_; K[56] = g_ ? b_ : a_; K[57] = g_ ? a_ : b_; }
  { const float a_ = K[58], b_ = K[59]; const bool g_ = a_ > b_; K[58] = g_ ? b_ : a_; K[59] = g_ ? a_ : b_; }
  { const float a_ = K[60], b_ = K[61]; const bool g_ = a_ > b_; K[60] = g_ ? b_ : a_; K[61] = g_ ? a_ : b_; }
  { const float a_ = K[62], b_ = K[63]; const bool g_ = a_ > b_; K[62] = g_ ? b_ : a_; K[63] = g_ ? a_ : b_; }
  { const float a_ = K[48], b_ = K[56]; const bool g_ = a_ > b_; K[48] = g_ ? a_ : b_; K[56] = g_ ? b_ : a_; }
  { const float a_ = K[49], b_ = K[57]; const bool g_ = a_ > b_; K[49] = g_ ? a_ : b_; K[57] = g_ ? b_ : a_; }
  { const float a_ = K[50], b_ = K[58]; const bool g_ = a_ > b_; K[50] = g_ ? a_ : b_; K[58] = g_ ? b_ : a_; }
  { const float a_ = K[51], b_ = K[59]; const bool g_ = a_ > b_; K[51] = g_ ? a_ : b_; K[59] = g_ ? b_ : a_; }
  { const float a_ = K[52], b_ = K[60]; const bool g_ = a_ > b_; K[52] = g_ ? a_ : b_; K[60] = g_ ? b_ : a_; }
  { const float a_ = K[53], b_ = K[61]; const bool g_ = a_ > b_; K[53] = g_ ? a_ : b_; K[61] = g_ ? b_ : a_; }
  { const float a_ = K[54], b_ = K[62]; const bool g_ = a_ > b_; K[54] = g_ ? a_ : b_; K[62] = g_ ? b_ : a_; }
  { const float a_ = K[55], b_ = K[63]; const bool g_ = a_ > b_; K[55] = g_ ? a_ : b_; K[63] = g_ ? b_ : a_; }
  { const float a_ = K[48], b_ = K[52]; const bool g_ = a_ > b_; K[48] = g_ ? a_ : b_; K[52] = g_ ? b_ : a_; }
  { const float a_ = K[49], b_ = K[53]; const bool g_ = a_ > b_; K[49] = g_ ? a_ : b_; K[53] = g_ ? b_ : a_; }
  { const float a_ = K[50], b_ = K[54]; const bool g_ = a_ > b_; K[50] = g_ ? a_ : b_; K[54] = g_ ? b_ : a_; }
  { const float a_ = K[51], b_ = K[55]; const bool g_ = a_ > b_; K[51] = g_ ? a_ : b_; K[55] = g_ ? b_ : a_; }
  { const float a_ = K[56], b_ = K[60]; const bool g_ = a_ > b_; K[56] = g_ ? a_ : b_; K[60] = g_ ? b_ : a_; }
  { const float a_ = K[57], b_ = K[61]; const bool g_ = a_ > b_; K[57] = g_ ? a_ : b_; K[61] = g_ ? b_ : a_; }
  { const float a_ = K[58], b_ = K[62]; const bool g_ = a_ > b_; K[58] = g_ ? a_ : b_; K[62] = g_ ? b_ : a_; }
  { const float a_ = K[59], b_ = K[63]; const bool g_ = a_ > b_; K[59] = g_ ? a_ : b_; K[63] = g_ ? b_ : a_; }
  { const float a_ = K[48], b_ = K[50]; const bool g_ = a_ > b_; K[48] = g_ ? a_ : b_; K[50] = g_ ? b_ : a_; }
  { const float a_ = K[49], b_ = K[51]; const bool g_ = a_ > b_; K[49] = g_ ? a_ : b_; K[51] = g_ ? b_ : a_; }
  { const float a_ = K[52], b_ = K[54]; const bool g_ = a_ > b_; K[52] = g_ ? a_ : b_; K[54] = g_ ? b_ : a_; }
  { const float a_ = K[53], b_ = K[55]; const bool g_ = a_ > b_; K[53] = g_ ? a_ : b_; K[55] = g_ ? b_ : a_; }
  { const float a_ = K[56], b_ = K[58]; const bool g_ = a_ > b_; K[56] = g_ ? a_ : b_; K[58] = g_ ? b_ : a_; }
  { const float a_ = K[57], b_ = K[59]; const bool g_ = a_ > b_; K[57] = g_ ? a_ : b_; K[59] = g_ ? b_ : a_; }
  { const float a_ = K[60], b_ = K[62]; const bool g_ = a_ > b_; K[60] = g_ ? a_ : b_; K[62] = g_ ? b_ : a_; }
  { const float a_ = K[61], b_ = K[63]; const bool g_ = a_ > b_; K[61] = g_ ? a_ : b_; K[63] = g_ ? b_ : a_; }
  { const float a_ = K[48], b_ = K[49]; const bool g_ = a_ > b_; K[48] = g_ ? a_ : b_; K[49] = g_ ? b_ : a_; }
  { const float a_ = K[50], b_ = K[51]; const bool g_ = a_ > b_; K[50] = g_ ? a_ : b_; K[51] = g_ ? b_ : a_; }
  { const float a_ = K[52], b_ = K[53]; const bool g_ = a_ > b_; K[52] = g_ ? a_ : b_; K[53] = g_ ? b_ : a_; }
  { const float a_ = K[54], b_ = K[55]; const bool g_ = a_ > b_; K[54] = g_ ? a_ : b_; K[55] = g_ ? b_ : a_; }
  { const float a_ = K[56], b_ = K[57]; const bool g_ = a_ > b_; K[56] = g_ ? a_ : b_; K[57] = g_ ? b_ : a_; }
  { const float a_ = K[58], b_ = K[59]; const bool g_ = a_ > b_; K[58] = g_ ? a_ : b_; K[59] = g_ ? b_ : a_; }
  { const float a_ = K[60], b_ = K[61]; const bool g_ = a_ > b_; K[60] = g_ ? a_ : b_; K[61] = g_ ? b_ : a_; }
  { const float a_ = K[62], b_ = K[63]; const bool g_ = a_ > b_; K[62] = g_ ? a_ : b_; K[63] = g_ ? b_ : a_; }
  { const float a_ = K[0], b_ = K[31]; K[0] = a_ > b_ ? a_ : b_; }
  { const float a_ = K[1], b_ = K[30]; K[1] = a_ > b_ ? a_ : b_; }
  { const float a_ = K[2], b_ = K[29]; K[2] = a_ > b_ ? a_ : b_; }
  { const float a_ = K[3], b_ = K[28]; K[3] = a_ > b_ ? a_ : b_; }
  { const float a_ = K[4], b_ = K[27]; K[4] = a_ > b_ ? a_ : b_; }
  { const float a_ = K[5], b_ = K[26]; K[5] = a_ > b_ ? a_ : b_; }
  { const float a_ = K[6], b_ = K[25]; K[6] = a_ > b_ ? a_ : b_; }
  { const float a_ = K[7], b_ = K[24]; K[7] = a_ > b_ ? a_ : b_; }
  { const float a_ = K[8], b_ = K[23]; K[8] = a_ > b_ ? a_ : b_; }
  { const float a_ = K[9], b_ = K[22]; K[9] = a_ > b_ ? a_ : b_; }
  { const float a_ = K[10], b_ = K[21]; K[10] = a_ > b_ ? a_ : b_; }
  { const float a_ = K[11], b_ = K[20]; K[11] = a_ > b_ ? a_ : b_; }
  { const float a_ = K[12], b_ = K[19]; K[12] = a_ > b_ ? a_ : b_; }
  { const float a_ = K[13], b_ = K[18]; K[13] = a_ > b_ ? a_ : b_; }
  { const float a_ = K[14], b_ = K[17]; K[14] = a_ > b_ ? a_ : b_; }
  { const float a_ = K[15], b_ = K[16]; K[15] = a_ > b_ ? a_ : b_; }
  { const float a_ = K[0], b_ = K[8]; const bool g_ = a_ > b_; K[0] = g_ ? a_ : b_; K[8] = g_ ? b_ : a_; }
  { const float a_ = K[1], b_ = K[9]; const bool g_ = a_ > b_; K[1] = g_ ? a_ : b_; K[9] = g_ ? b_ : a_; }
  { const float a_ = K[2], b_ = K[10]; const bool g_ = a_ > b_; K[2] = g_ ? a_ : b_; K[10] = g_ ? b_ : a_; }
  { const float a_ = K[3], b_ = K[11]; const bool g_ = a_ > b_; K[3] = g_ ? a_ : b_; K[11] = g_ ? b_ : a_; }
  { const float a_ = K[4], b_ = K[12]; const bool g_ = a_ > b_; K[4] = g_ ? a_ : b_; K[12] = g_ ? b_ : a_; }
  { const float a_ = K[5], b_ = K[13]; const bool g_ = a_ > b_; K[5] = g_ ? a_ : b_; K[13] = g_ ? b_ : a_; }
  { const float a_ = K[6], b_ = K[14]; const bool g_ = a_ > b_; K[6] = g_ ? a_ : b_; K[14] = g_ ? b_ : a_; }
  { const float a_ = K[7], b_ = K[15]; const bool g_ = a_ > b_; K[7] = g_ ? a_ : b_; K[15] = g_ ? b_ : a_; }
  { const float a_ = K[0], b_ = K[4]; const bool g_ = a_ > b_; K[0] = g_ ? a_ : b_; K[4] = g_ ? b_ : a_; }
  { const float a_ = K[1], b_ = K[5]; const bool g_ = a_ > b_; K[1] = g_ ? a_ : b_; K[5] = g_ ? b_ : a_; }
  { const float a_ = K[2], b_ = K[6]; const bool g_ = a_ > b_; K[2] = g_ ? a_ : b_; K[6] = g_ ? b_ : a_; }
  { const float a_ = K[3], b_ = K[7]; const bool g_ = a_ > b_; K[3] = g_ ? a_ : b_; K[7] = g_ ? b_ : a_; }
  { const float a_ = K[8], b_ = K[12]; const bool g_ = a_ > b_; K[8] = g_ ? a_ : b_; K[12] = g_ ? b_ : a_; }
  { const float a_ = K[9], b_ = K[13]; const bool g_ = a_ > b_; K[9] = g_ ? a_ : b_; K[13] = g_ ? b_ : a_; }
  { const float a_ = K[10], b_ = K[14]; const bool g_ = a_ > b_; K[10] = g_ ? a_ : b_; K[14] = g_ ? b_ : a_; }
  { const float a_ = K[11], b_ = K[15]; const bool g_ = a_ > b_; K[11] = g_ ? a_ : b_; K[15] = g_ ? b_ : a_; }
  { const float a_ = K[0], b_ = K[2]; const bool g_ = a_ > b_; K[0] = g_ ? a_ : b_; K[2] = g_ ? b_ : a_; }
  { const float a_ = K[1], b_ = K[3]; const bool g_ = a_ > b_; K[1] = g_ ? a_ : b_; K[3] = g_ ? b_ : a_; }
  { const float a_ = K[4], b_ = K[6]; const bool g_ = a_ > b_; K[4] = g_ ? a_ : b_; K[6] = g_ ? b_ : a_; }
  { const float a_ = K[5], b_ = K[7]; const bool g_ = a_ > b_; K[5] = g_ ? a_ : b_; K[7] = g_ ? b_ : a_; }
  { const float a_ = K[8], b_ = K[10]; const bool g_ = a_ > b_; K[8] = g_ ? a_ : b_; K[10] = g_ ? b_ : a_; }
  { const float a_ = K[9], b_ = K[11]; const bool g_ = a_ > b_; K[9] = g_ ? a_ : b_; K[11] = g_ ? b_ : a_; }
  { const float a_ = K[12], b_ = K[14]; const bool g_ = a_ > b_; K[12] = g_ ? a_ : b_; K[14] = g_ ? b_ : a_; }
  { const float a_ = K[13], b_ = K[15]; const bool g_ = a_ > b_; K[13] = g_ ? a_ : b_; K[15] = g_ ? b_ : a_; }
  { const float a_ = K[0], b_ = K[1]; const bool g_ = a_ > b_; K[0] = g_ ? a_ : b_; K[1] = g_ ? b_ : a_; }
  { const float a_ = K[2], b_ = K[3]; const bool g_ = a_ > b_; K[2] = g_ ? a_ : b_; K[3] = g_ ? b_ : a_; }
  { const float a_ = K[4], b_ = K[5]; const bool g_ = a_ > b_; K[4] = g_ ? a_ : b_; K[5] = g_ ? b_ : a_; }
  { const float a_ = K[6], b_ = K[7]; const bool g_ = a_ > b_; K[6] = g_ ? a_ : b_; K[7] = g_ ? b_ : a_; }
  { const float a_ = K[8], b_ = K[9]; const bool g_ = a_ > b_; K[8] = g_ ? a_ : b_; K[9] = g_ ? b_ : a_; }
  { const float a_ = K[10], b_ = K[11]; const bool g_ = a_ > b_; K[10] = g_ ? a_ : b_; K[11] = g_ ? b_ : a_; }
  { const float a_ = K[12], b_ = K[13]; const bool g_ = a_ > b_; K[12] = g_ ? a_ : b_; K[13] = g_ ? b_ : a_; }
  { const float a_ = K[14], b_ = K[15]; const bool g_ = a_ > b_; K[14] = g_ ? a_ : b_; K[15] = g_ ? b_ : a_; }
  { const float a_ = K[32], b_ = K[63]; K[32] = a_ > b_ ? a_ : b_; }
  { const float a_ = K[33], b_ = K[62]; K[33] = a_ > b_ ? a_ : b_; }
  { const float a_ = K[34], b_ = K[61]; K[34] = a_ > b_ ? a_ : b_; }
  { const float a_ = K[35], b_ = K[60]; K[35] = a_ > b_ ? a_ : b_; }
  { const float a_ = K[36], b_ = K[59]; K[36] = a_ > b_ ? a_ : b_; }
  { const float a_ = K[37], b_ = K[58]; K[37] = a_ > b_ ? a_ : b_; }
  { const float a_ = K[38], b_ = K[57]; K[38] = a_ > b_ ? a_ : b_; }
  { const float a_ = K[39], b_ = K[56]; K[39] = a_ > b_ ? a_ : b_; }
  { const float a_ = K[40], b_ = K[55]; K[40] = a_ > b_ ? a_ : b_; }
  { const float a_ = K[41], b_ = K[54]; K[41] = a_ > b_ ? a_ : b_; }
  { const float a_ = K[42], b_ = K[53]; K[42] = a_ > b_ ? a_ : b_; }
  { const float a_ = K[43], b_ = K[52]; K[43] = a_ > b_ ? a_ : b_; }
  { const float a_ = K[44], b_ = K[51]; K[44] = a_ > b_ ? a_ : b_; }
  { const float a_ = K[45], b_ = K[50]; K[45] = a_ > b_ ? a_ : b_; }
  { const float a_ = K[46], b_ = K[49]; K[46] = a_ > b_ ? a_ : b_; }
  { const float a_ = K[47], b_ = K[48]; K[47] = a_ > b_ ? a_ : b_; }
  { const float a_ = K[32], b_ = K[40]; const bool g_ = a_ > b_; K[32] = g_ ? a_ : b_; K[40] = g_ ? b_ : a_; }
  { const float a_ = K[33], b_ = K[41]; const bool g_ = a_ > b_; K[33] = g_ ? a_ : b_; K[41] = g_ ? b_ : a_; }
  { const float a_ = K[34], b_ = K[42]; const bool g_ = a_ > b_; K[34] = g_ ? a_ : b_; K[42] = g_ ? b_ : a_; }
  { const float a_ = K[35], b_ = K[43]; const bool g_ = a_ > b_; K[35] = g_ ? a_ : b_; K[43] = g_ ? b_ : a_; }
  { const float a_ = K[36], b_ = K[44]; const bool g_ = a_ > b_; K[36] = g_ ? a_ : b_; K[44] = g_ ? b_ : a_; }
  { const float a_ = K[37], b_ = K[45]; const bool g_ = a_ > b_; K[37] = g_ ? a_ : b_; K[45] = g_ ? b_ : a_; }
  { const float a_ = K[38], b_ = K[46]; const bool g_ = a_ > b_; K[38] = g_ ? a_ : b_; K[46] = g_ ? b_ : a_; }
  { const float a_ = K[39], b_ = K[47]; const bool g_ = a_ > b_; K[39] = g_ ? a_ : b_; K[47] = g_ ? b_ : a_; }
  { const float a_ = K[32], b_ = K[36]; const bool g_ = a_ > b_; K[32] = g_ ? a_ : b_; K[36] = g_ ? b_ : a_; }
  { const float a_ = K[33], b_ = K[37]; const bool g_ = a_ > b_; K[33] = g_ ? a_ : b_; K[37] = g_ ? b_ : a_; }
  { const float a_ = K[34], b_ = K[38]; const bool g_ = a_ > b_; K[34] = g_ ? a_ : b_; K[38] = g_ ? b_ : a_; }
  { const float a_ = K[35], b_ = K[39]; const bool g_ = a_ > b_; K[35] = g_ ? a_ : b_; K[39] = g_ ? b_ : a_; }
  { const float a_ = K[40], b_ = K[44]; const bool g_ = a_ > b_; K[40] = g_ ? a_ : b_; K[44] = g_ ? b_ : a_; }
  { const float a_ = K[41], b_ = K[45]; const bool g_ = a_ > b_; K[41] = g_ ? a_ : b_; K[45] = g_ ? b_ : a_; }
  { const float a_ = K[42], b_ = K[46]; const bool g_ = a_ > b_; K[42] = g_ ? a_ : b_; K[46] = g_ ? b_ : a_; }
  { const float a_ = K[43], b_ = K[47]; const bool g_ = a_ > b_; K[43] = g_ ? a_ : b_; K[47] = g_ ? b_ : a_; }
  { const float a_ = K[32], b_ = K[34]; const bool g_ = a_ > b_; K[32] = g_ ? a_ : b_; K[34] = g_ ? b_ : a_; }
  { const float a_ = K[33], b_ = K[35]; const bool g_ = a_ > b_; K[33] = g_ ? a_ : b_; K[35] = g_ ? b_ : a_; }
  { const float a_ = K[36], b_ = K[38]; const bool g_ = a_ > b_; K[36] = g_ ? a_ : b_; K[38] = g_ ? b_ : a_; }
  { const float a_ = K[37], b_ = K[39]; const bool g_ = a_ > b_; K[37] = g_ ? a_ : b_; K[39] = g_ ? b_ : a_; }
  { const float a_ = K[40], b_ = K[42]; const bool g_ = a_ > b_; K[40] = g_ ? a_ : b_; K[42] = g_ ? b_ : a_; }
  { const float a_ = K[41], b_ = K[43]; const bool g_ = a_ > b_; K[41] = g_ ? a_ : b_; K[43] = g_ ? b_ : a_; }
  { const float a_ = K[44], b_ = K[46]; const bool g_ = a_ > b_; K[44] = g_ ? a_ : b_; K[46] = g_ ? b_ : a_; }
  { const float a_ = K[45], b_ = K[47]; const bool g_ = a_ > b_; K[45] = g_ ? a_ : b_; K[47] = g_ ? b_ : a_; }
  { const float a_ = K[32], b_ = K[33]; const bool g_ = a_ > b_; K[32] = g_ ? a_ : b_; K[33] = g_ ? b_ : a_; }
  { const float a_ = K[34], b_ = K[35]; const bool g_ = a_ > b_; K[34] = g_ ? a_ : b_; K[35] = g_ ? b_ : a_; }
  { const float a_ = K[36], b_ = K[37]; const bool g_ = a_ > b_; K[36] = g_ ? a_ : b_; K[37] = g_ ? b_ : a_; }
  { const float a_ = K[38], b_ = K[39]; const bool g_ = a_ > b_; K[38] = g_ ? a_ : b_; K[39] = g_ ? b_ : a_; }
  { const float a_ = K[40], b_ = K[41]; const bool g_ = a_ > b_; K[40] = g_ ? a_ : b_; K[41] = g_ ? b_ : a_; }
  { const float a_ = K[42], b_ = K[43]; const bool g_ = a_ > b_; K[42] = g_ ? a_ : b_; K[43] = g_ ? b_ : a_; }
  { const float a_ = K[44], b_ = K[45]; const bool g_ = a_ > b_; K[44] = g_ ? a_ : b_; K[45] = g_ ? b_ : a_; }
  { const float a_ = K[46], b_ = K[47]; const bool g_ = a_ > b_; K[46] = g_ ? a_ : b_; K[47] = g_ ? b_ : a_; }
  { const float a_ = K[0], b_ = K[47]; K[0] = a_ > b_ ? a_ : b_; }
  { const float a_ = K[1], b_ = K[46]; K[1] = a_ > b_ ? a_ : b_; }
  { const float a_ = K[2], b_ = K[45]; K[2] = a_ > b_ ? a_ : b_; }
  { const float a_ = K[3], b_ = K[44]; K[3] = a_ > b_ ? a_ : b_; }
  { const float a_ = K[4], b_ = K[43]; K[4] = a_ > b_ ? a_ : b_; }
  { const float a_ = K[5], b_ = K[42]; K[5] = a_ > b_ ? a_ : b_; }
  { const float a_ = K[6], b_ = K[41]; K[6] = a_ > b_ ? a_ : b_; }
  { const float a_ = K[7], b_ = K[40]; K[7] = a_ > b_ ? a_ : b_; }
  { const float a_ = K[8], b_ = K[39]; K[8] = a_ > b_ ? a_ : b_; }
  { const float a_ = K[9], b_ = K[38]; K[9] = a_ > b_ ? a_ : b_; }
  { const float a_ = K[10], b_ = K[37]; K[10] = a_ > b_ ? a_ : b_; }
  { const float a_ = K[11], b_ = K[36]; K[11] = a_ > b_ ? a_ : b_; }
  { const float a_ = K[12], b_ = K[35]; K[12] = a_ > b_ ? a_ : b_; }
  { const float a_ = K[13], b_ = K[34]; K[13] = a_ > b_ ? a_ : b_; }
  { const float a_ = K[14], b_ = K[33]; K[14] = a_ > b_ ? a_ : b_; }
  { const float a_ = K[15], b_ = K[32]; K[15] = a_ > b_ ? a_ : b_; }
  { const float a_ = K[0], b_ = K[8]; const bool g_ = a_ > b_; K[0] = g_ ? a_ : b_; K[8] = g_ ? b_ : a_; }
  { const float a_ = K[1], b_ = K[9]; const bool g_ = a_ > b_; K[1] = g_ ? a_ : b_; K[9] = g_ ? b_ : a_; }
  { const float a_ = K[2], b_ = K[10]; const bool g_ = a_ > b_; K[2] = g_ ? a_ : b_; K[10] = g_ ? b_ : a_; }
  { const float a_ = K[3], b_ = K[11]; const bool g_ = a_ > b_; K[3] = g_ ? a_ : b_; K[11] = g_ ? b_ : a_; }
  { const float a_ = K[4], b_ = K[12]; const bool g_ = a_ > b_; K[4] = g_ ? a_ : b_; K[12] = g_ ? b_ : a_; }
  { const float a_ = K[5], b_ = K[13]; const bool g_ = a_ > b_; K[5] = g_ ? a_ : b_; K[13] = g_ ? b_ : a_; }
  { const float a_ = K[6], b_ = K[14]; const bool g_ = a_ > b_; K[6] = g_ ? a_ : b_; K[14] = g_ ? b_ : a_; }
  { const float a_ = K[7], b_ = K[15]; const bool g_ = a_ > b_; K[7] = g_ ? a_ : b_; K[15] = g_ ? b_ : a_; }
  { const float a_ = K[0], b_ = K[4]; const bool g_ = a_ > b_; K[0] = g_ ? a_ : b_; K[4] = g_ ? b_ : a_; }
  { const float a_ = K[1], b_ = K[5]; const bool g_ = a_ > b_; K[1] = g_ ? a_ : b_; K[5] = g_ ? b_ : a_; }
  { const float a_ = K[2], b_ = K[6]; const bool g_ = a_ > b_; K[2] = g_ ? a_ : b_; K[6] = g_ ? b_ : a_; }
  { const float a_ = K[3], b_ = K[7]; const bool g_ = a_ > b_; K[3] = g_ ? a_ : b_; K[7] = g_ ? b_ : a_; }
  { const float a_ = K[8], b_ = K[12]; const bool g_ = a_ > b_; K[8] = g_ ? a_ : b_; K[12] = g_ ? b_ : a_; }
  { const float a_ = K[9], b_ = K[13]; const bool g_ = a_ > b_; K[9] = g_ ? a_ : b_; K[13] = g_ ? b_ : a_; }
  { const float a_ = K[10], b_ = K[14]; const bool g_ = a_ > b_; K[10] = g_ ? a_ : b_; K[14] = g_ ? b_ : a_; }
  { const float a_ = K[11], b_ = K[15]; const bool g_ = a_ > b_; K[11] = g_ ? a_ : b_; K[15] = g_ ? b_ : a_; }
  { const float a_ = K[0], b_ = K[2]; const bool g_ = a_ > b_; K[0] = g_ ? a_ : b_; K[2] = g_ ? b_ : a_; }
  { const float a_ = K[1], b_ = K[3]; const bool g_ = a_ > b_; K[1] = g_ ? a_ : b_; K[3] = g_ ? b_ : a_; }
  { const float a_ = K[4], b_ = K[6]; const bool g_ = a_ > b_; K[4] = g_ ? a_ : b_; K[6] = g_ ? b_ : a_; }
  { const float a_ = K[5], b_ = K[7]; const bool g_ = a_ > b_; K[5] = g_ ? a_ : b_; K[7] = g_ ? b_ : a_; }
  { const float a_ = K[8], b_ = K[10]; const bool g_ = a_ > b_; K[8] = g_ ? a_ : b_; K[10] = g_ ? b_ : a_; }
  { const float a_ = K[9], b_ = K[11]; const bool g_ = a_ > b_; K[9] = g_ ? a_ : b_; K[11] = g_ ? b_ : a_; }
  { const float a_ = K[12], b_ = K[14]; const bool g_ = a_ > b_; K[12] = g_ ? a_ : b_; K[14] = g_ ? b_ : a_; }
  { const float a_ = K[13], b_ = K[15]; const bool g_ = a_ > b_; K[13] = g_ ? a_ : b_; K[15] = g_ ? b_ : a_; }
  { const float a_ = K[0], b_ = K[1]; const bool g_ = a_ > b_; K[0] = g_ ? a_ : b_; K[1] = g_ ? b_ : a_; }
  { const float a_ = K[2], b_ = K[3]; const bool g_ = a_ > b_; K[2] = g_ ? a_ : b_; K[3] = g_ ? b_ : a_; }
  { const float a_ = K[4], b_ = K[5]; const bool g_ = a_ > b_; K[4] = g_ ? a_ : b_; K[5] = g_ ? b_ : a_; }
  { const float a_ = K[6], b_ = K[7]; const bool g_ = a_ > b_; K[6] = g_ ? a_ : b_; K[7] = g_ ? b_ : a_; }
  { const float a_ = K[8], b_ = K[9]; const bool g_ = a_ > b_; K[8] = g_ ? a_ : b_; K[9] = g_ ? b_ : a_; }
  { const float a_ = K[10], b_ = K[11]; const bool g_ = a_ > b_; K[10] = g_ ? a_ : b_; K[11] = g_ ? b_ : a_; }
  { const float a_ = K[12], b_ = K[13]; const bool g_ = a_ > b_; K[12] = g_ ? a_ : b_; K[13] = g_ ? b_ : a_; }
  { const float a_ = K[14], b_ = K[15]; const bool g_ = a_ > b_; K[14] = g_ ? a_ : b_; K[15] = g_ ? b_ : a_; }
}
__device__ __forceinline__ void merge_top16(float (&T)[16], const float (&P)[16]) {
  { const float a_ = T[0], b_ = P[15]; T[0] = a_ > b_ ? a_ : b_; }
  { const float a_ = T[1], b_ = P[14]; T[1] = a_ > b_ ? a_ : b_; }
  { const float a_ = T[2], b_ = P[13]; T[2] = a_ > b_ ? a_ : b_; }
  { const float a_ = T[3], b_ = P[12]; T[3] = a_ > b_ ? a_ : b_; }
  { const float a_ = T[4], b_ = P[11]; T[4] = a_ > b_ ? a_ : b_; }
  { const float a_ = T[5], b_ = P[10]; T[5] = a_ > b_ ? a_ : b_; }
  { const float a_ = T[6], b_ = P[9]; T[6] = a_ > b_ ? a_ : b_; }
  { const float a_ = T[7], b_ = P[8]; T[7] = a_ > b_ ? a_ : b_; }
  { const float a_ = T[8], b_ = P[7]; T[8] = a_ > b_ ? a_ : b_; }
  { const float a_ = T[9], b_ = P[6]; T[9] = a_ > b_ ? a_ : b_; }
  { const float a_ = T[10], b_ = P[5]; T[10] = a_ > b_ ? a_ : b_; }
  { const float a_ = T[11], b_ = P[4]; T[11] = a_ > b_ ? a_ : b_; }
  { const float a_ = T[12], b_ = P[3]; T[12] = a_ > b_ ? a_ : b_; }
  { const float a_ = T[13], b_ = P[2]; T[13] = a_ > b_ ? a_ : b_; }
  { const float a_ = T[14], b_ = P[1]; T[14] = a_ > b_ ? a_ : b_; }
  { const float a_ = T[15], b_ = P[0]; T[15] = a_ > b_ ? a_ : b_; }
  { const float a_ = T[0], b_ = T[8]; const bool g_ = a_ > b_; T[0] = g_ ? a_ : b_; T[8] = g_ ? b_ : a_; }
  { const float a_ = T[1], b_ = T[9]; const bool g_ = a_ > b_; T[1] = g_ ? a_ : b_; T[9] = g_ ? b_ : a_; }
  { const float a_ = T[2], b_ = T[10]; const bool g_ = a_ > b_; T[2] = g_ ? a_ : b_; T[10] = g_ ? b_ : a_; }
  { const float a_ = T[3], b_ = T[11]; const bool g_ = a_ > b_; T[3] = g_ ? a_ : b_; T[11] = g_ ? b_ : a_; }
  { const float a_ = T[4], b_ = T[12]; const bool g_ = a_ > b_; T[4] = g_ ? a_ : b_; T[12] = g_ ? b_ : a_; }
  { const float a_ = T[5], b_ = T[13]; const bool g_ = a_ > b_; T[5] = g_ ? a_ : b_; T[13] = g_ ? b_ : a_; }
  { const float a_ = T[6], b_ = T[14]; const bool g_ = a_ > b_; T[6] = g_ ? a_ : b_; T[14] = g_ ? b_ : a_; }
  { const float a_ = T[7], b_ = T[15]; const bool g_ = a_ > b_; T[7] = g_ ? a_ : b_; T[15] = g_ ? b_ : a_; }
  { const float a_ = T[0], b_ = T[4]; const bool g_ = a_ > b_; T[0] = g_ ? a_ : b_; T[4] = g_ ? b_ : a_; }
  { const float a_ = T[1], b_ = T[5]; const bool g_ = a_ > b_; T[1] = g_ ? a_ : b_; T[5] = g_ ? b_ : a_; }
  { const float a_ = T[2], b_ = T[6]; const bool g_ = a_ > b_; T[2] = g_ ? a_ : b_; T[6] = g_ ? b_ : a_; }
  { const float a_ = T[3], b_ = T[7]; const bool g_ = a_ > b_; T[3] = g_ ? a_ : b_; T[7] = g_ ? b_ : a_; }
  { const float a_ = T[8], b_ = T[12]; const bool g_ = a_ > b_; T[8] = g_ ? a_ : b_; T[12] = g_ ? b_ : a_; }
  { const float a_ = T[9], b_ = T[13]; const bool g_ = a_ > b_; T[9] = g_ ? a_ : b_; T[13] = g_ ? b_ : a_; }
  { const float a_ = T[10], b_ = T[14]; const bool g_ = a_ > b_; T[10] = g_ ? a_ : b_; T[14] = g_ ? b_ : a_; }
  { const float a_ = T[11], b_ = T[15]; const bool g_ = a_ > b_; T[11] = g_ ? a_ : b_; T[15] = g_ ? b_ : a_; }
  { const float a_ = T[0], b_ = T[2]; const bool g_ = a_ > b_; T[0] = g_ ? a_ : b_; T[2] = g_ ? b_ : a_; }
  { const float a_ = T[1], b_ = T[3]; const bool g_ = a_ > b_; T[1] = g_ ? a_ : b_; T[3] = g_ ? b_ : a_; }
  { const float a_ = T[4], b_ = T[6]; const bool g_ = a_ > b_; T[4] = g_ ? a_ : b_; T[6] = g_ ? b_ : a_; }
  { const float a_ = T[5], b_ = T[7]; const bool g_ = a_ > b_; T[5] = g_ ? a_ : b_; T[7] = g_ ? b_ : a_; }
  { const float a_ = T[8], b_ = T[10]; const bool g_ = a_ > b_; T[8] = g_ ? a_ : b_; T[10] = g_ ? b_ : a_; }
  { const float a_ = T[9], b_ = T[11]; const bool g_ = a_ > b_; T[9] = g_ ? a_ : b_; T[11] = g_ ? b_ : a_; }
  { const float a_ = T[12], b_ = T[14]; const bool g_ = a_ > b_; T[12] = g_ ? a_ : b_; T[14] = g_ ? b_ : a_; }
  { const float a_ = T[13], b_ = T[15]; const bool g_ = a_ > b_; T[13] = g_ ? a_ : b_; T[15] = g_ ? b_ : a_; }
  { const float a_ = T[0], b_ = T[1]; const bool g_ = a_ > b_; T[0] = g_ ? a_ : b_; T[1] = g_ ? b_ : a_; }
  { const float a_ = T[2], b_ = T[3]; const bool g_ = a_ > b_; T[2] = g_ ? a_ : b_; T[3] = g_ ? b_ : a_; }
  { const float a_ = T[4], b_ = T[5]; const bool g_ = a_ > b_; T[4] = g_ ? a_ : b_; T[5] = g_ ? b_ : a_; }
  { const float a_ = T[6], b_ = T[7]; const bool g_ = a_ > b_; T[6] = g_ ? a_ : b_; T[7] = g_ ? b_ : a_; }
  { const float a_ = T[8], b_ = T[9]; const bool g_ = a_ > b_; T[8] = g_ ? a_ : b_; T[9] = g_ ? b_ : a_; }
  { const float a_ = T[10], b_ = T[11]; const bool g_ = a_ > b_; T[10] = g_ ? a_ : b_; T[11] = g_ ? b_ : a_; }
  { const float a_ = T[12], b_ = T[13]; const bool g_ = a_ > b_; T[12] = g_ ? a_ : b_; T[13] = g_ ? b_ : a_; }
  { const float a_ = T[14], b_ = T[15]; const bool g_ = a_ > b_; T[14] = g_ ? a_ : b_; T[15] = g_ ? b_ : a_; }
}

__device__ __forceinline__ void peer_topk(const int wave_s, const bf16* pq, const bf16* skb, int* ids, float* gates, LAS float* smem) {
  const int tid_ = opaque_tid(wave_s);
  const int lane = tid_ & 63, n = lane & 31, hh = lane >> 5, wave = tid_ >> 6;
  const int gw = blockIdx.x * NWAVES + wave;
  const int nw = gridDim.x * NWAVES;
  LAS float* lk = smem + wave * 2048;
  for (int it = gw; it < 512 * 8; it += nw) {
    const int h = it & 7, tok0 = (it >> 3) * 32;
#pragma unroll 1
    for (int half = 0; half < 2; half++) {
      bf16x8_t qf[8];
      {
        const bf16* qrow = pq + (size_t)(tok0 + n) * 2048 + h * 256 + half * 128 + 8 * hh;
#pragma unroll
        for (int ks = 0; ks < 8; ks++) qf[ks] = *(const bf16x8_t*)(qrow + 16 * ks);
      }
      float K[64];
#pragma unroll
      for (int kt = 0; kt < 4; kt++) {
        const bf16* krow = skb + ((size_t)((h * 2 + half) * 128 + kt * 32 + n)) * 128 + 8 * hh;
        f32x16_t acc;
#pragma unroll
        for (int r = 0; r < 16; r++) acc[r] = 0.f;
#pragma unroll
        for (int kq = 0; kq < 2; kq++) {
          bf16x8_t kf[4];
#pragma unroll
          for (int i = 0; i < 4; i++) kf[i] = *(const bf16x8_t*)(krow + 16 * (kq * 4 + i));
          MFMA_PAD();
#pragma unroll
          for (int i = 0; i < 4; i++) acc = __builtin_amdgcn_mfma_f32_32x32x16_bf16(kf[i], qf[kq * 4 + i], acc, 0, 0, 0);
          MFMA_PAD();
        }
#pragma unroll
        for (int i = 0; i < 16; i++) K[kt * 16 + i] = pack_key<0x7Fu>(acc[i], (unsigned)(kt * 32 + (i & 3) + 8 * (i >> 2) + 4 * hh));
      }
      __builtin_amdgcn_sched_barrier(0);
      top16_of_64(K);
      __builtin_amdgcn_sched_barrier(0);
      float T[16], P[16];
#pragma unroll
      for (int i = 0; i < 16; i++) { T[i] = K[i]; P[i] = __shfl_xor(K[i], 32, 64); }
      merge_top16(T, P);
#pragma unroll
      for (int i = 0; i < 16; i++) lk[(half * 16 + i) * 64 + lane] = T[i];
      __builtin_amdgcn_sched_barrier(0);
    }
    float f0[16], f1[16];
    int ti0[16], ti1[16];
#pragma unroll
    for (int i = 0; i < 16; i++) {
      const float k0 = lk[i * 64 + lane], k1 = lk[(16 + i) * 64 + lane];
      f0[i] = key_val<0x7Fu>(k0); ti0[i] = (int)key_idx<0x7Fu>(k0);
      f1[i] = key_val<0x7Fu>(k1); ti1[i] = (int)key_idx<0x7Fu>(k1);
    }
    float K[64];
    {
    K[0] = pack_key<0xFFu>(f0[0] + f1[0], 0u);
    K[1] = pack_key<0xFFu>(f0[0] + f1[1], 1u);
    K[2] = pack_key<0xFFu>(f0[0] + f1[2], 2u);
    K[3] = pack_key<0xFFu>(f0[0] + f1[3], 3u);
    K[4] = pack_key<0xFFu>(f0[0] + f1[4], 4u);
    K[5] = pack_key<0xFFu>(f0[0] + f1[5], 5u);
    K[6] = pack_key<0xFFu>(f0[0] + f1[6], 6u);
    K[7] = pack_key<0xFFu>(f0[0] + f1[7], 7u);
    K[8] = pack_key<0xFFu>(f0[0] + f1[8], 8u);
    K[9] = pack_key<0xFFu>(f0[0] + f1[9], 9u);
    K[10] = pack_key<0xFFu>(f0[0] + f1[10], 10u);
    K[11] = pack_key<0xFFu>(f0[0] + f1[11], 11u);
    K[12] = pack_key<0xFFu>(f0[0] + f1[12], 12u);
    K[13] = pack_key<0xFFu>(f0[0] + f1[13], 13u);
    K[14] = pack_key<0xFFu>(f0[0] + f1[14], 14u);
    K[15] = pack_key<0xFFu>(f0[0] + f1[15], 15u);
    K[16] = pack_key<0xFFu>(f0[1] + f1[0], 16u);
    K[17] = pack_key<0xFFu>(f0[1] + f1[1], 17u);
    K[18] = pack_key<0xFFu>(f0[1] + f1[2], 18u);
    K[19] = pack_key<0xFFu>(f0[1] + f1[3], 19u);
    K[20] = pack_key<0xFFu>(f0[1] + f1[4], 20u);
    K[21] = pack_key<0xFFu>(f0[1] + f1[5], 21u);
    K[22] = pack_key<0xFFu>(f0[1] + f1[6], 22u);
    K[23] = pack_key<0xFFu>(f0[1] + f1[7], 23u);
    K[24] = pack_key<0xFFu>(f0[2] + f1[0], 32u);
    K[25] = pack_key<0xFFu>(f0[2] + f1[1], 33u);
    K[26] = pack_key<0xFFu>(f0[2] + f1[2], 34u);
    K[27] = pack_key<0xFFu>(f0[2] + f1[3], 35u);
    K[28] = pack_key<0xFFu>(f0[2] + f1[4], 36u);
    K[29] = pack_key<0xFFu>(f0[3] + f1[0], 48u);
    K[30] = pack_key<0xFFu>(f0[3] + f1[1], 49u);
    K[31] = pack_key<0xFFu>(f0[3] + f1[2], 50u);
    K[32] = pack_key<0xFFu>(f0[3] + f1[3], 51u);
    K[33] = pack_key<0xFFu>(f0[4] + f1[0], 64u);
    K[34] = pack_key<0xFFu>(f0[4] + f1[1], 65u);
    K[35] = pack_key<0xFFu>(f0[4] + f1[2], 66u);
    K[36] = pack_key<0xFFu>(f0[5] + f1[0], 80u);
    K[37] = pack_key<0xFFu>(f0[5] + f1[1], 81u);
    K[38] = pack_key<0xFFu>(f0[6] + f1[0], 96u);
    K[39] = pack_key<0xFFu>(f0[6] + f1[1], 97u);
    K[40] = pack_key<0xFFu>(f0[7] + f1[0], 112u);
    K[41] = pack_key<0xFFu>(f0[7] + f1[1], 113u);
    K[42] = pack_key<0xFFu>(f0[8] + f1[0], 128u);
    K[43] = pack_key<0xFFu>(f0[9] + f1[0], 144u);
    K[44] = pack_key<0xFFu>(f0[10] + f1[0], 160u);
    K[45] = pack_key<0xFFu>(f0[11] + f1[0], 176u);
    K[46] = pack_key<0xFFu>(f0[12] + f1[0], 192u);
    K[47] = pack_key<0xFFu>(f0[13] + f1[0], 208u);
    K[48] = pack_key<0xFFu>(f0[14] + f1[0], 224u);
    K[49] = pack_key<0xFFu>(f0[15] + f1[0], 240u);
    K[50] = -3.0e38f;
    K[51] = -3.0e38f;
    K[52] = -3.0e38f;
    K[53] = -3.0e38f;
    K[54] = -3.0e38f;
    K[55] = -3.0e38f;
    K[56] = -3.0e38f;
    K[57] = -3.0e38f;
    K[58] = -3.0e38f;
    K[59] = -3.0e38f;
    K[60] = -3.0e38f;
    K[61] = -3.0e38f;
    K[62] = -3.0e38f;
    K[63] = -3.0e38f;
    }
    __builtin_amdgcn_sched_barrier(0);
    top16_of_64(K);
    __builtin_amdgcn_sched_barrier(0);
    float bv[16];
    int be[16];
#pragma unroll
    for (int r = 0; r < 16; r++) {
      const int flat = (int)key_idx<0xFFu>(K[r]);
      const int a = flat >> 4, b = flat & 15;
      int i0 = 0, i1 = 0;
#pragma unroll
      for (int i = 0; i < 16; i++) { i0 = (a == i) ? ti0[i] : i0; i1 = (b == i) ? ti1[i] : i1; }
      be[r] = i0 * 128 + i1;
      bv[r] = key_val<0xFFu>(K[r]);
    }
    const float b0 = bv[0];
    float ge[16];
    float gsum = 0.f;
#pragma unroll
    for (int r = 0; r < 16; r++) { ge[r] = __expf(bv[r] - b0); gsum += ge[r]; }
    const float ginv = 1.0f / gsum;
    if (hh == 0) {
      int* ip = ids + (size_t)(tok0 + n) * 128 + h * 16;
      float* gp = gates + (size_t)(tok0 + n) * 128 + h * 16;
#pragma unroll
      for (int r4 = 0; r4 < 4; r4++) {
        *(int4*)(ip + 4 * r4) = make_int4(be[4 * r4], be[4 * r4 + 1], be[4 * r4 + 2], be[4 * r4 + 3]);
        *(float4*)(gp + 4 * r4) = make_float4(ge[4 * r4] * ginv, ge[4 * r4 + 1] * ginv, ge[4 * r4 + 2] * ginv, ge[4 * r4 + 3] * ginv);
      }
    }
  }
}

typedef _Float16 f16x2_t __attribute__((ext_vector_type(2)));
__device__ __forceinline__ unsigned e4m3x2_to_f16x2(unsigned w, unsigned sel) {
  return __builtin_amdgcn_perm(w, w, sel);
}
__device__ __forceinline__ float dot2h(unsigned a, unsigned b, float c) {
  return __builtin_amdgcn_fdot2(__builtin_bit_cast(f16x2_t, a), __builtin_bit_cast(f16x2_t, b), c, false);
}
__device__ __forceinline__ unsigned pack_h2(float lo, float hi) {
  f16x2_t v; v.x = (_Float16)lo; v.y = (_Float16)hi;
  return __builtin_bit_cast(unsigned, v);
}
template <bool FINAL>
__device__ __forceinline__ void peer_gather(const int wave_s, bf16* xn, const float* rst, const unsigned char* ub, const unsigned char* vb, const float* vsc, const float* usc,
                                            const int* ids, const float* gates, float* xw, const float* gnext, float* outp) {
  const int tid_ = opaque_tid(wave_s);
  const int lane = tid_ & 63;
  const int gw = blockIdx.x * NWAVES + (tid_ >> 6);
  const int nw = gridDim.x * NWAVES;
  const int el = ((lane >> 5) & 1) * 4 + ((lane >> 4) & 1) * 2 + ((lane >> 3) & 1);
  int idv = 0;
  uint2 uu[8];
  uint2 vv[8];
  if (gw < NT) {
    idv = ids[(size_t)gw * 128 + (lane & 7)];
#pragma unroll
    for (int e = 0; e < 8; e++) {
      const int id = __builtin_amdgcn_readlane(idv, e);
      uu[e] = *(const uint2*)(ub + (size_t)id * 512 + lane * 8);
      vv[e] = *(const uint2*)(vb + (size_t)id * 512 + lane * 8);
    }
  }
  for (int tok = gw; tok < NT; tok += nw) {
    const int tokn = (tok + nw < NT) ? tok + nw : tok;
    int xqh[2] = {0, 0}, xql[2] = {0, 0};
    float xstep, qhalf;
    {
      const uint4 a = *(const uint4*)(xn + (size_t)tok * DM + lane * 16);
      const uint4 b = *(const uint4*)(xn + (size_t)tok * DM + lane * 16 + 8);
      const unsigned xw_[8] = {a.x, a.y, a.z, a.w, b.x, b.y, b.z, b.w};
      const float4* sp = (const float4*)(rst + (size_t)tok * 16);
      const float4 s0 = sp[0], s1 = sp[1], s2 = sp[2], s3 = sp[3];
      const float xs = rsqrtf((((s0.x + s0.y) + (s0.z + s0.w)) + ((s1.x + s1.y) + (s1.z + s1.w)) + ((s2.x + s2.y) + (s2.z + s2.w)) + ((s3.x + s3.y) + (s3.z + s3.w))) * (1.0f / 1024.f) + EPSF);
      float xf[16];
      float am = 0.f;
#pragma unroll
      for (int k = 0; k < 8; k++) { xf[2 * k] = bf_lo(xw_[k]) * xs; xf[2 * k + 1] = bf_hi(xw_[k]) * xs; am = fmaxf(am, fmaxf(fabsf(xf[2 * k]), fabsf(xf[2 * k + 1]))); }
#pragma unroll
      for (int o = 32; o >= 1; o >>= 1) am = fmaxf(am, __shfl_xor(am, o, 64));
      xstep = am * (1.0f / 119.f);
      const float inv = am > 0.f ? 119.f / am : 0.f;
      int qs = 0;
#pragma unroll
      for (int i = 0; i < 16; i++) {
        const int q = (int)rintf(xf[i] * inv);
        const int t = q + 8;
        xqh[i >> 3] |= ((t >> 4) & 15) << (4 * (i & 7));
        xql[i >> 3] |= (((t & 15) - 8) & 15) << (4 * (i & 7));
        qs += q;
      }
      qhalf = 0.5f * wsum((float)qs);
    }
    f16x2_t acc2[8];
#pragma unroll
    for (int i = 0; i < 8; i++) acc2[i] = (f16x2_t){(_Float16)0.f, (_Float16)0.f};
#pragma unroll 1
    for (int g = 0; g < 16; g++) {
      const int ide = __builtin_amdgcn_ds_bpermute(el << 2, idv);
      const float2 sc2 = ((const float2*)vsc)[ide];
      const float gv = gates[(size_t)tok * 128 + g * 8 + el] * sc2.x;
      const float us = sc2.y * xstep;
      const int idn = ids[(size_t)(g < 15 ? tok : tokn) * 128 + ((g + 1) & 15) * 8 + (lane & 7)];
      float d[8];
#pragma unroll
      for (int e = 0; e < 8; e++) {
        int sh = __builtin_amdgcn_sdot8((int)uu[e].x, xqh[0], 0, false);
        sh = __builtin_amdgcn_sdot8((int)uu[e].y, xqh[1], sh, false);
        int sl = __builtin_amdgcn_sdot8((int)uu[e].x, xql[0], 0, false);
        sl = __builtin_amdgcn_sdot8((int)uu[e].y, xql[1], sl, false);
        d[e] = (float)((sh << 4) + sl);
      }
#pragma unroll
      for (int e = 0; e < 8; e++) {
        const int id = __builtin_amdgcn_readlane(idn, e);
        uu[e] = *(const uint2*)(ub + (size_t)id * 512 + lane * 8);
      }
      float d4[4], d2[2], d1;
      {
        const bool hi = (lane & 32) != 0;
#pragma unroll
        for (int i = 0; i < 4; i++) { const float send = hi ? d[i] : d[i + 4]; const float keep = hi ? d[i + 4] : d[i]; d4[i] = keep + __shfl_xor(send, 32, 64); }
      }
      {
        const bool hi = (lane & 16) != 0;
#pragma unroll
        for (int i = 0; i < 2; i++) { const float send = hi ? d4[i] : d4[i + 2]; const float keep = hi ? d4[i + 2] : d4[i]; d2[i] = keep + __shfl_xor(send, 16, 64); }
      }
      {
        const bool hi = (lane & 8) != 0;
        const float send = hi ? d2[0] : d2[1];
        const float keep = hi ? d2[1] : d2[0];
        d1 = keep + __shfl_xor(send, 8, 64);
      }
      d1 += __shfl_xor(d1, 4, 64);
      d1 += __shfl_xor(d1, 2, 64);
      d1 += __shfl_xor(d1, 1, 64);
      const float wl = gv * gelu_tanh((d1 + qhalf) * us);
#pragma unroll
      for (int e = 0; e < 8; e++) {
        const float w = __builtin_bit_cast(float, __builtin_amdgcn_readlane(__builtin_bit_cast(int, wl), ((e >> 2) & 1) * 32 + ((e >> 1) & 1) * 16 + (e & 1) * 8));
        const f16x2_t w2 = __builtin_bit_cast(f16x2_t, pack_h2(w, w));
        const unsigned vw[2] = {vv[e].x, vv[e].y};
#pragma unroll
        for (int k = 0; k < 2; k++) {
          const unsigned w4 = vw[k];
          const unsigned le = __builtin_amdgcn_perm(V4_LUT_HI, V4_LUT_LO, w4 & 0x07070707u);
          const unsigned lo = __builtin_amdgcn_perm(V4_LUT_HI, V4_LUT_LO, (w4 >> 4) & 0x07070707u);
          const unsigned ee = ((w4 << 4) & 0x80808080u) | le;
          const unsigned eo = (w4 & 0x80808080u) | lo;
          const unsigned p01 = __builtin_amdgcn_perm(eo, ee, 0x040c000cu), p23 = __builtin_amdgcn_perm(eo, ee, 0x050c010cu);
          const unsigned p45 = __builtin_amdgcn_perm(eo, ee, 0x060c020cu), p67 = __builtin_amdgcn_perm(eo, ee, 0x070c030cu);
          acc2[4 * k + 0] = __builtin_elementwise_fma(__builtin_bit_cast(f16x2_t, p01), w2, acc2[4 * k + 0]);
          acc2[4 * k + 1] = __builtin_elementwise_fma(__builtin_bit_cast(f16x2_t, p23), w2, acc2[4 * k + 1]);
          acc2[4 * k + 2] = __builtin_elementwise_fma(__builtin_bit_cast(f16x2_t, p45), w2, acc2[4 * k + 2]);
          acc2[4 * k + 3] = __builtin_elementwise_fma(__builtin_bit_cast(f16x2_t, p67), w2, acc2[4 * k + 3]);
        }
      }
#pragma unroll
      for (int e = 0; e < 8; e++) {
        const int id = __builtin_amdgcn_readlane(idn, e);
        vv[e] = *(const uint2*)(vb + (size_t)id * 512 + lane * 8);
      }
      idv = idn;
    }
    float acc[16];
#pragma unroll
    for (int i = 0; i < 8; i++) { acc[2 * i] = (float)acc2[i].x; acc[2 * i + 1] = (float)acc2[i].y; }
    float* xr = xw + (size_t)tok * DM + lane * 16;
    float xv[16];
    float ssq = 0.f;
#pragma unroll
    for (int c = 0; c < 4; c++) {
      float4 a0 = *(float4*)(xr + c * 4);
      a0.x += acc[c * 4 + 0]; a0.y += acc[c * 4 + 1]; a0.z += acc[c * 4 + 2]; a0.w += acc[c * 4 + 3];
      if (!FINAL) *(float4*)(xr + c * 4) = a0;
      xv[c * 4 + 0] = a0.x; xv[c * 4 + 1] = a0.y; xv[c * 4 + 2] = a0.z; xv[c * 4 + 3] = a0.w;
      ssq += a0.x * a0.x + a0.y * a0.y + a0.z * a0.z + a0.w * a0.w;
    }
    ssq = wsum(ssq);
    const float rstd = rsqrtf(ssq * (1.0f / DM) + EPSF);
    const float4* g4 = (const float4*)(gnext + lane * 16);
    if (FINAL) {
      float* op = outp + (size_t)tok * DM + lane * 16;
#pragma unroll
      for (int c = 0; c < 4; c++) {
        const float4 gq = g4[c];
        *(float4*)(op + c * 4) = make_float4(xv[c * 4] * rstd * gq.x, xv[c * 4 + 1] * rstd * gq.y, xv[c * 4 + 2] * rstd * gq.z, xv[c * 4 + 3] * rstd * gq.w);
      }
    } else {
      uint4 o0, o1;
      { const float4 ga = g4[0], gb = g4[1];
        o0.x = pk2(xv[0] * rstd * ga.x, xv[1] * rstd * ga.y); o0.y = pk2(xv[2] * rstd * ga.z, xv[3] * rstd * ga.w);
        o0.z = pk2(xv[4] * rstd * gb.x, xv[5] * rstd * gb.y); o0.w = pk2(xv[6] * rstd * gb.z, xv[7] * rstd * gb.w); }
      { const float4 ga = g4[2], gb = g4[3];
        o1.x = pk2(xv[8] * rstd * ga.x, xv[9] * rstd * ga.y); o1.y = pk2(xv[10] * rstd * ga.z, xv[11] * rstd * ga.w);
        o1.z = pk2(xv[12] * rstd * gb.x, xv[13] * rstd * gb.y); o1.w = pk2(xv[14] * rstd * gb.z, xv[15] * rstd * gb.w); }
      *(uint4*)(xn + (size_t)tok * DM + lane * 16) = o0;
      *(uint4*)(xn + (size_t)tok * DM + lane * 16 + 8) = o1;
    }
  }
}

__device__ __forceinline__ void prologue_transposes(const int wave_s, const Params& p, unsigned char* ws, LAS unsigned char* lds) {
  const int tid_ = opaque_tid(wave_s);
  const int lane = tid_ & 63, wave = tid_ >> 6;
  LAS float* scr = (LAS float*)(lds + wave * 16384);
  const int gw = blockIdx.x * NWAVES + wave, NGW = gridDim.x * NWAVES;
  constexpr int I_IN = (DM / 64) * (DIN / 32), I_SQ = (DM / 64) * (DM / 32), I_2K = (DM / 64) * (2048 / 32);
  constexpr int I_GL = (256 / 64) * (256 / 32);
  constexpr int PER_LAYER = I_IN + 3 * I_SQ + 2 * I_2K + I_GL;
  const float* w3 = karg_in(3); const float* w19 = karg_in(19); const float* w22 = karg_in(22);
  const float* w23 = karg_in(23); const float* w24 = karg_in(24); const float* w26 = karg_in(26);
  const float* w16 = karg_in(16);
  for (int it = gw; it < 2 * PER_LAYER; it += NGW) {
    const int l = it / PER_LAYER;
    int r = it % PER_LAYER;
    unsigned char* wl = ws + WS_WT + (size_t)l * WT_LAYER;
    if (r < I_IN) { transpose_item(w3 + (size_t)l * DM * DIN, DM, DIN, (bf16*)(wl + WT_IN), scr, r, lane); continue; } r -= I_IN;
    if (r < I_SQ) { transpose_item(w19 + (size_t)l * DM * DM, DM, DM, (bf16*)(wl + WT_OUT), scr, r, lane); continue; } r -= I_SQ;
    if (r < I_SQ) { transpose_item(w22 + (size_t)l * DM * DM, DM, DM, (bf16*)(wl + WT_MQ), scr, r, lane); continue; } r -= I_SQ;
    if (r < I_2K) { transpose_item(w23 + (size_t)l * DM * 2048, DM, 2048, (bf16*)(wl + WT_MKV), scr, r, lane); continue; } r -= I_2K;
    if (r < I_SQ) { transpose_item(w24 + (size_t)l * DM * DM, DM, DM, (bf16*)(wl + WT_MO), scr, r, lane); continue; } r -= I_SQ;
    if (r < I_2K) { transpose_item(w26 + (size_t)l * DM * 2048, DM, 2048, (bf16*)(wl + WT_PQ), scr, r, lane); continue; } r -= I_2K;
    transpose_item(w16 + (size_t)l * 256 * 256, 256, 256, (bf16*)(wl + WT_GLU), scr, r, lane);
  }
}

template <class T> __device__ __forceinline__ T* opq(T* p) { asm volatile("" : "+s"(p)); return p; }
__device__ __forceinline__ void cvt_rows_bf16(const int wave_s, const float* src, bf16* dst, size_t n) {
  const int tid_ = opaque_tid(wave_s);
  const size_t gt = (size_t)blockIdx.x * (NWAVES * 64) + tid_;
  const size_t nth = (size_t)gridDim.x * NWAVES * 64;
  for (size_t i = gt; i < n / 8; i += nth) {
    const float4 a = ((const float4*)src)[2 * i], b = ((const float4*)src)[2 * i + 1];
    uint4 o; o.x = pk2(a.x, a.y); o.y = pk2(a.z, a.w); o.z = pk2(b.x, b.y); o.w = pk2(b.z, b.w);
    ((uint4*)dst)[i] = o;
  }
}

__device__ __forceinline__ unsigned enc_e4m3(float x) {
  const _Float16 hf = (_Float16)x;
  const unsigned h = (unsigned)__builtin_bit_cast(unsigned short, hf);
  return ((h + 0x7Fu + ((h >> 8) & 1u)) >> 8) & 0xFFu;
}
__device__ __forceinline__ void cvt_rows_e4m3(const int wave_s, const float* src, unsigned char* dst, size_t n, float sc) {
  const int tid_ = opaque_tid(wave_s);
  const size_t gt = (size_t)blockIdx.x * (NWAVES * 64) + tid_;
  const size_t nth = (size_t)gridDim.x * NWAVES * 64;
  for (size_t i = gt; i < n / 16; i += nth) {
    unsigned w[4];
#pragma unroll
    for (int k = 0; k < 4; k++) {
      const float4 a = ((const float4*)src)[4 * i + k];
      w[k] = enc_e4m3(a.x * sc) | (enc_e4m3(a.y * sc) << 8) | (enc_e4m3(a.z * sc) << 16) | (enc_e4m3(a.w * sc) << 24);
    }
    uint4 o; o.x = w[0]; o.y = w[1]; o.z = w[2]; o.w = w[3];
    ((uint4*)dst)[i] = o;
  }
}

__device__ __forceinline__ unsigned enc_v4(float z) {
  const float az = fabsf(z);
  unsigned c = 0;
  c += az > 0.25f; c += az > 0.5f; c += az > 0.75f; c += az > 1.0625f; c += az > 1.375f; c += az > 1.75f; c += az > 2.25f;
  return c | ((__builtin_bit_cast(unsigned, z) >> 28) & 8u);
}
__device__ __forceinline__ void cvt_rows_i4(const int wave_s, const float* src, unsigned char* dst, float* sc_out, int nrows) {
  const int tid_ = opaque_tid(wave_s);
  const int lane = tid_ & 63;
  const int gw = blockIdx.x * NWAVES + (tid_ >> 6);
  const int nw = gridDim.x * NWAVES;
  for (int r = gw; r < nrows; r += nw) {
    const float4* sp = (const float4*)(src + (size_t)r * 1024 + lane * 16);
    const float4 a0 = sp[0], a1 = sp[1], a2 = sp[2], a3 = sp[3];
    const float xv[16] = {a0.x, a0.y, a0.z, a0.w, a1.x, a1.y, a1.z, a1.w, a2.x, a2.y, a2.z, a2.w, a3.x, a3.y, a3.z, a3.w};
    float ss = 0.f;
#pragma unroll
    for (int i = 0; i < 16; i++) ss += xv[i] * xv[i];
    ss = wsum(ss);
    const float sc = sqrtf(ss * (1.0f / 1024.f)) * U4_STEP;
    const float inv = sc > 0.f ? 1.0f / sc : 0.f;
    unsigned w[2] = {0u, 0u};
#pragma unroll
    for (int i = 0; i < 16; i++) {
      const float f = fminf(fmaxf(floorf(xv[i] * inv), -8.f), 7.f);
      w[i >> 3] |= ((unsigned)(int)f & 15u) << (4 * (i & 7));
    }
    uint2 o; o.x = w[0]; o.y = w[1];
    *(uint2*)(dst + (size_t)r * 512 + lane * 8) = o;
    if (lane == 0) sc_out[2 * r] = sc;
  }
}
__device__ __forceinline__ void cvt_rows_v4(const int wave_s, const float* src, unsigned char* dst, float* sc_out, int nrows) {
  const int tid_ = opaque_tid(wave_s);
  const int lane = tid_ & 63;
  const int gw = blockIdx.x * NWAVES + (tid_ >> 6);
  const int nw = gridDim.x * NWAVES;
  for (int r = gw; r < nrows; r += nw) {
    const float4* sp = (const float4*)(src + (size_t)r * 1024 + lane * 16);
    const float4 a0 = sp[0], a1 = sp[1], a2 = sp[2], a3 = sp[3];
    const float xv[16] = {a0.x, a0.y, a0.z, a0.w, a1.x, a1.y, a1.z, a1.w, a2.x, a2.y, a2.z, a2.w, a3.x, a3.y, a3.z, a3.w};
    float ss = 0.f;
#pragma unroll
    for (int i = 0; i < 16; i++) ss += xv[i] * xv[i];
    ss = wsum(ss);
    const float sc = sqrtf(ss * (1.0f / 1024.f)) * V4_ROWSCALE;
    const float inv = sc > 0.f ? 1.0f / sc : 0.f;
    unsigned w[2] = {0u, 0u};
#pragma unroll
    for (int i = 0; i < 16; i++) w[i >> 3] |= enc_v4(xv[i] * inv) << (4 * (i & 7));
    uint2 o; o.x = w[0]; o.y = w[1];
    *(uint2*)(dst + (size_t)r * 512 + lane * 8) = o;
    if (lane == 0) sc_out[2 * r] = sc;
  }
}

#define GEMM_F32(Aptr, Wt, Cptr, Rptr, M_, N_) do { \
    pg8::Gemm g_{opq((const bf16*)(Aptr)), opq((const bf16*)(Wt)), (M_), (N_), DM}; pg8::StaticOrder S_; S_.init((M_), (N_), (int)gridDim.x, (int)blockIdx.x); \
    pg8::EpiF32R E_{opq((float*)(Cptr)), opq((const float*)(Rptr)), (N_)}; \
    pg8::gemm_phase<pg8::EpiF32R, pg8::StaticOrder, true, true>(wave_s, ldsl, g_, S_, E_); } while (0)
#define GEMM_BF16_C(Aptr, Wt, Optr, M_, N_, C_) do { \
    pg8::Gemm g_{opq((const bf16*)(Aptr)), opq((const bf16*)(Wt)), (M_), (N_), DM}; pg8::StaticOrder S_; S_.init((M_), (N_), (int)gridDim.x, (C_)); \
    pg8::EpiBf16 E_{opq((bf16*)(Optr)), (N_)}; \
    pg8::gemm_phase<pg8::EpiBf16, pg8::StaticOrder, true, true>(wave_s, ldsl, g_, S_, E_); } while (0)
#define GEMM_BF16(Aptr, Wt, Optr, M_, N_) GEMM_BF16_C(Aptr, Wt, Optr, M_, N_, (int)blockIdx.x)
#define GEMM_F32RN(Aptr, Wt, Cptr, Rptr, XGptr, Gptr, STptr) do { \
    pg8::Gemm g_{opq((const bf16*)(Aptr)), opq((const bf16*)(Wt)), NT, DM, DM}; pg8::StaticOrder S_; S_.init(NT, DM, (int)gridDim.x, (int)blockIdx.x); \
    pg8::EpiF32RN E_{opq((float*)(Cptr)), opq((const float*)(Rptr)), DM, opq((bf16*)(XGptr)), opq((const float*)(Gptr)), opq((float*)(STptr))}; \
    pg8::gemm_phase<pg8::EpiF32RN, pg8::StaticOrder, true, true>(wave_s, ldsl, g_, S_, E_); } while (0)
#define GEMM_BF16S(Aptr, Wt, Optr, N_, STptr) do { \
    pg8::Gemm g_{opq((const bf16*)(Aptr)), opq((const bf16*)(Wt)), NT, (N_), DM}; pg8::StaticOrder S_; S_.init(NT, (N_), (int)gridDim.x, (int)blockIdx.x); \
    pg8::EpiBf16S E_{opq((bf16*)(Optr)), (N_), opq((const float*)(STptr))}; \
    pg8::gemm_phase<pg8::EpiBf16S, pg8::StaticOrder, true, true>(wave_s, ldsl, g_, S_, E_); } while (0)

__global__ void __launch_bounds__(NWAVES * 64, 2) fwd_megakernel(Params p) {
  extern __shared__ __attribute__((aligned(16))) unsigned char lds[];
  LAS unsigned char* ldsl = (LAS unsigned char*)lds;
  LAS float* smem = (LAS float*)ldsl;
  const int wave_s = __builtin_amdgcn_readfirstlane((int)(threadIdx.x >> 6));
  unsigned char* ws = p.ws;
  volatile LAS unsigned* MISC = (volatile LAS unsigned*)(ldsl + (LDS_BYTES - 256));
  if (threadIdx.x < 64) MISC[threadIdx.x] = 0u;
  __syncthreads();
  const XcdBarrier bar = xcd_barrier_post((unsigned*)(ws + WS_CTL) + 4096, MISC + 8);
  float* xw = (float*)(ws + WS_XW);
  bf16* xn = (bf16*)(ws + WS_XN);
  bf16* big = (bf16*)(ws + WS_BIG);
  bf16* y = (bf16*)(ws + WS_Y);
  bf16* memh = (bf16*)(ws + WS_MEMH);
  bf16* kvb = (bf16*)(ws + WS_KVB);
  bf16* vT = (bf16*)(ws + WS_VT);
  float* ssmE = (float*)(ws + WS_SSME);
  float* ssmp = (float*)(ws + WS_SSMP);
  int* ids = (int*)(ws + WS_IDS);
  float* gates = (float*)(ws + WS_GATE);
  bf16* skb = (bf16*)(ws + WS_SKB);
  unsigned char* ub = ws + WS_UB;
  unsigned char* vb = ws + WS_VB;
  float* rst = (float*)(ws + WS_RST);
  float* vsc = (float*)(ws + WS_VSC);
  float* usc = (float*)(ws + WS_USC);

  prologue_transposes(wave_s, p, ws, ldsl);
  cvt_rows_bf16(wave_s, karg_in(27), skb, (size_t)2 * 8 * 2 * 128 * 128);
  cvt_rows_i4(wave_s, karg_in(28), ub, vsc + 1, 2 * 16384);
  cvt_rows_v4(wave_s, karg_in(29), vb, vsc, 2 * 16384);
  for (int l = 0; l < 2; l++)
    rms_rows<true>(wave_s, karg_in(1), karg_in(21) + l * DM, memh + (size_t)l * 1024 * 1024, 1024);
  ssm_params(wave_s, p, ssmp);
  xcd_barrier(bar);
  for (int l = 0; l < 2; l++)
    GEMM_BF16_C(memh + (size_t)l * 1024 * 1024, ws + WS_WT + (size_t)l * WT_LAYER + WT_MKV,
              kvb + (size_t)l * 1024 * 2048, 1024, 2048, (int)((blockIdx.x + gridDim.x - 32u * (unsigned)l) % gridDim.x));

#pragma nounroll
  for (int l = 0; l < 2; l++) {
    const float* xcur = (l == 0) ? karg_in(0) : xw;
    const float* sp = ssmp + (size_t)l * SSMP_PER_LAYER;
    const unsigned char* wl = ws + WS_WT + (size_t)l * WT_LAYER;
    if (l == 0) {
      rms_rows<true>(wave_s, xcur, karg_in(2) + l * DM, xn, NT);
      xcd_barrier(bar);
    }
    GEMM_BF16(xn, wl + WT_IN, big, NT, DIN);
    xcd_barrier(bar);
    if (l == 0) vt_phase(wave_s, kvb, vT);
    ssm_chunk_end(wave_s, sp, big, ssmE);
    attn_phase(wave_s, p, l, big, y, smem);
    conv_phase(wave_s, p, l, big, y, smem);
    xcd_barrier(bar);
    ssm_finish(wave_s, p, l, sp, big, ssmE, y, smem);
    xcd_barrier(bar);
    GEMM_F32RN(y, wl + WT_OUT, xw, xcur, xn, karg_in(20) + l * DM, rst);
    xcd_barrier(bar);
    GEMM_BF16S(xn, wl + WT_MQ, big, DM, rst);
    xcd_barrier(bar);
    memattn_phase(wave_s, big, kvb + (size_t)l * 1024 * 2048, vT + (size_t)l * 4 * 4 * 256 * 256, y, smem);
    xcd_barrier(bar);
    GEMM_F32RN(y, wl + WT_MO, xw, (const float*)xw, xn, karg_in(25) + l * DM, rst);
    xcd_barrier(bar);
    GEMM_BF16S(xn, wl + WT_PQ, big, 2048, rst);
    xcd_barrier(bar);
    peer_topk(wave_s, big, skb + (size_t)l * 8 * 2 * 128 * 128, ids, gates, smem);
    xcd_barrier(bar);
    if (l == 0) {
      peer_gather<false>(wave_s, xn, rst, ub + (size_t)l * 16384 * 512, vb + (size_t)l * 16384 * 512, vsc + (size_t)l * 2 * 16384, usc, ids, gates, xw, karg_in(2) + DM, (float*)nullptr);
      xcd_barrier(bar);
    } else {
      peer_gather<true>(wave_s, xn, rst, ub + (size_t)l * 16384 * 512, vb + (size_t)l * 16384 * 512, vsc + (size_t)l * 2 * 16384, usc, ids, gates, xw, karg_in(30), p.out);
    }
  }
}

extern "C" void kernel_launch(void* const* d_in, const int* in_sizes, int n_in,
                              void* d_out, int out_size, void* d_ws, size_t ws_size,
                              hipStream_t stream) {
  static int grid_blocks = 0;
  if (!grid_blocks) {
    int dev = 0, cus = 0, per_cu = 0;
    (void)hipGetDevice(&dev);
    (void)hipDeviceGetAttribute(&cus, hipDeviceAttributeMultiprocessorCount, dev);
    (void)hipFuncSetAttribute((const void*)fwd_megakernel, hipFuncAttributeMaxDynamicSharedMemorySize, LDS_BYTES);
    (void)hipOccupancyMaxActiveBlocksPerMultiprocessor(&per_cu, fwd_megakernel, NWAVES * 64, LDS_BYTES);
    if (per_cu < 1) fprintf(stderr, "occupancy query reports %d blocks/CU\n", per_cu);
    grid_blocks = cus;
  }
  (void)hipMemsetAsync((char*)d_ws + WS_CTL, 0, 1 * MiB, stream);
  Params p{};
  for (int i = 0; i < 31; i++) p.in[i] = (const float*)d_in[i];
  p.out = (float*)d_out;
  p.ws = (unsigned char*)d_ws;
  void* args[] = {&p};
  hipError_t e = hipLaunchCooperativeKernel((void*)fwd_megakernel, dim3(grid_blocks), dim3(NWAVES * 64),
                                            args, LDS_BYTES, stream);
  if (e != hipSuccess)
    fprintf(stderr, "cooperative launch failed: %s (grid %d)\n", hipGetErrorString(e), grid_blocks);
}
```

```cpp
#include <hip/hip_runtime.h>
#include <hip/hip_cooperative_groups.h>
#include <cstdio>
namespace cg = cooperative_groups;

#define NT 16384
#define SEQ 4096
#define DM 1024
#define DIN 2304
#define NMEM 256
#define EPSF 1e-6f
#define NWAVES 8
#define LDS_BYTES 147456

typedef unsigned short bf16;
#define LAS __attribute__((address_space(3)))

struct Params {
  const float* in[31];
  float* out;
  unsigned char* ws;
};
typedef __attribute__((address_space(4))) const unsigned char* kaptr_t;
__device__ __forceinline__ const float* karg_in(int i) {
  kaptr_t ka = (kaptr_t)__builtin_amdgcn_kernarg_segment_ptr();
  asm volatile("" : "+s"(ka));
  return *(const float* __attribute__((address_space(4))) const*)(ka + 8 * i);
}

constexpr size_t MiB = 1u << 20;
constexpr size_t WS_CTL  = 0;
constexpr size_t WS_WT   = 1 * MiB;
constexpr size_t WT_IN = 0, WT_OUT = WT_IN + (size_t)DIN * DM * 2, WT_MQ = WT_OUT + (size_t)DM * DM * 2,
                 WT_MKV = WT_MQ + (size_t)DM * DM * 2, WT_MO = WT_MKV + (size_t)2048 * DM * 2,
                 WT_PQ = WT_MO + (size_t)DM * DM * 2, WT_GLU = WT_PQ + (size_t)2048 * DM * 2, WT_LAYER = WT_GLU + (size_t)256 * 256 * 2;
constexpr size_t WS_XW   = WS_WT + 2 * WT_LAYER;
constexpr size_t WS_XN   = WS_XW + (size_t)NT * DM * 4;
constexpr size_t WS_BIG  = WS_XN + (size_t)NT * DM * 2;
constexpr size_t WS_Y    = WS_BIG + (size_t)NT * DIN * 2;
constexpr size_t WS_MEMH = WS_Y + (size_t)NT * DM * 2;
constexpr size_t WS_KVB  = WS_MEMH + (size_t)2 * 1024 * 1024 * 2;
constexpr size_t WS_VT   = WS_KVB + (size_t)2 * 1024 * 2048 * 2;
constexpr size_t WS_SSME = WS_VT + (size_t)2 * 4 * 4 * 256 * 256 * 2;
#define SSMP_PER_LAYER (2048 + 2048 + 32768)
constexpr size_t WS_SSMP = WS_SSME + (size_t)4 * 64 * 16 * 64 * 2 * 4;
constexpr size_t WS_IDS  = WS_SSMP + (size_t)2 * SSMP_PER_LAYER * 4;
constexpr size_t WS_GATE = WS_IDS + (size_t)NT * 128 * 4;
constexpr size_t WS_SKB  = WS_GATE + (size_t)NT * 128 * 4;
constexpr size_t WS_UB   = WS_SKB + (size_t)2 * 8 * 2 * 128 * 128 * 2;
constexpr size_t WS_VB   = WS_UB + (size_t)2 * 16384 * 512;
constexpr size_t WS_VSC  = WS_VB + (size_t)2 * 16384 * 512;
constexpr size_t WS_USC  = WS_VSC + (size_t)2 * 16384 * 4;
constexpr size_t WS_RST  = WS_USC + (size_t)2 * 16384 * 4;
constexpr size_t WS_END  = WS_RST + (size_t)NT * 16 * 4;
#define U_SCALE 64.0f
#define U4_STEP 0.3352f
#define V4_LUT_LO 0x3B393630u
#define V4_LUT_HI 0x41403E3Du
#define V4_ROWSCALE 1.075f
static_assert(WS_END <= 512 * MiB, "workspace");
static_assert(WT_LAYER % 256 == 0 && WS_SSMP % 16 == 0 && WS_IDS % 16 == 0 && WS_SKB % 256 == 0 && WS_VT % 256 == 0, "align");

__device__ __forceinline__ int opaque_tid(int wave_s) { int v = wave_s * 64 + (int)__builtin_amdgcn_mbcnt_hi(~0u, __builtin_amdgcn_mbcnt_lo(~0u, 0u)); asm volatile("" : "+v"(v)); return v; }
__device__ __forceinline__ unsigned f2bf(float f) { unsigned u = __builtin_bit_cast(unsigned, f); return (u + 0x7fffu + ((u >> 16) & 1u)) >> 16; }
__device__ __forceinline__ unsigned pk2(float lo, float hi) { return f2bf(lo) | (f2bf(hi) << 16); }
__device__ __forceinline__ float bf_lo(unsigned u) { return __builtin_bit_cast(float, u << 16); }
__device__ __forceinline__ float bf_hi(unsigned u) { return __builtin_bit_cast(float, u & 0xffff0000u); }
__device__ __forceinline__ float bf2f(bf16 h) { return __builtin_bit_cast(float, (unsigned)h << 16); }


#define XB_TMO      128
#define XB_XCNT(j)  (256  + 64 * (j))
#define XB_XSUB(j)  (1280 + 64 * (j))
#define XB_XGEN(j)  (2304 + 64 * (j))
#define XB_TOP      3328
#define XB_TOPGEN   3392
#define XCD_BAR_WORDS 3456
#define XB_SPIN_CAP (1u << 22)
__device__ __forceinline__ unsigned xb_ld(unsigned* p)              { return __hip_atomic_load(p, __ATOMIC_RELAXED, __HIP_MEMORY_SCOPE_AGENT); }
__device__ __forceinline__ unsigned xb_add(unsigned* p, unsigned v) { return __hip_atomic_fetch_add(p, v, __ATOMIC_RELAXED, __HIP_MEMORY_SCOPE_AGENT); }
__device__ __forceinline__ unsigned xb_xcc_id() { return (unsigned)__builtin_amdgcn_s_getreg((3 << 11) | 20) & 0xFu; }
#define XB_SPIN(cond, bar) do { unsigned _sp = 0; while (cond) { __builtin_amdgcn_s_sleep(1); \
    if ((++_sp & 255u) == 0u) { if (xb_ld(&(bar)[XB_TMO])) break; if (_sp > XB_SPIN_CAP) { atomicAdd(&(bar)[XB_TMO], 1u); break; } } } } while (0)
struct XcdBarrier { unsigned* bar; unsigned x; volatile LAS unsigned* st; };
__device__ __forceinline__ XcdBarrier xcd_barrier_post(unsigned* bar, volatile LAS unsigned* st) {
    XcdBarrier b; b.bar = bar; b.x = xb_xcc_id(); b.st = st;
    if (threadIdx.x == 0) (void)xb_add(&bar[XB_XCNT(b.x)], 1u);
    return b;
}
__device__ __forceinline__ void xcd_barrier_complete(unsigned* bar, unsigned x, unsigned& nloc, unsigned& nx) {
    const unsigned G = gridDim.x * gridDim.y * gridDim.z;
    unsigned sum, cnt, mine, sp = 0u;
    for (;;) {
        sum = 0u; cnt = 0u; mine = 0u;
#pragma unroll
        for (unsigned j = 0; j < 16; ++j) { const unsigned c = xb_ld(&bar[XB_XCNT(j)]); sum += c; cnt += (c > 0u) ? 1u : 0u; mine = (j == x) ? c : mine; }
        if (sum == G) break;
        __builtin_amdgcn_s_sleep(1);
        if ((++sp & 255u) == 0u) { if (xb_ld(&bar[XB_TMO])) break; if (sp > XB_SPIN_CAP) { atomicAdd(&bar[XB_TMO], 1u); break; } }
    }
    nloc = mine > 0u ? mine : 1u; nx = cnt > 0u ? cnt : 1u;
}
__device__ __forceinline__ void xcd_barrier(const XcdBarrier& b) {
    asm volatile("s_waitcnt vmcnt(0)" ::: "memory");
    __syncthreads();
    if (threadIdx.x == 0) {
        unsigned* bar = b.bar;
        __builtin_amdgcn_s_waitcnt(0);
        unsigned nloc = b.st[0], nx = b.st[1];
        if (nloc == 0u) { xcd_barrier_complete(bar, b.x, nloc, nx); b.st[0] = nloc; b.st[1] = nx; }
        const unsigned old = xb_add(&bar[XB_XSUB(b.x)], 1u);
        const unsigned gen = old / nloc;
        if (old + 1u == (gen + 1u) * nloc) {
            __builtin_amdgcn_fence(__ATOMIC_RELEASE, "agent");
            asm volatile("s_waitcnt vmcnt(0)" ::: "memory");
            const unsigned og = xb_add(&bar[XB_TOP], 1u);
            const unsigned tg = og / nx;
            if (og + 1u == (tg + 1u) * nx) xb_add(&bar[XB_TOPGEN], 1u);
            else XB_SPIN(xb_ld(&bar[XB_TOPGEN]) == tg, bar);
            __builtin_amdgcn_fence(__ATOMIC_ACQUIRE, "agent");
            xb_add(&bar[XB_XGEN(b.x)], 1u);
            asm volatile("s_waitcnt vmcnt(0)" ::: "memory");
        } else {
            XB_SPIN(xb_ld(&bar[XB_XGEN(b.x)]) == gen, bar);
            __builtin_amdgcn_fence(__ATOMIC_ACQUIRE, "agent");
            asm volatile("s_waitcnt vmcnt(0)" ::: "memory");
        }
    }
    __syncthreads();
}

namespace pg8 {
#define PG8_LAS __attribute__((address_space(3)))
typedef unsigned short bf16_t;
typedef short bf16x8 __attribute__((ext_vector_type(8)));
typedef float f32x4 __attribute__((ext_vector_type(4)));
typedef unsigned u32x4 __attribute__((ext_vector_type(4)));
constexpr int BM = 256, BK = 64, HALF = 128, HTB = HALF * BK * 2, STAGE_BYTES = 8 * HTB, NXCD = 8, WGM = 8;
__host__ __device__ __forceinline__ int lds_byte(int r, int c) { const int st = (r >> 4) * 2 + (c >> 5), rr = r & 15, cc = c & 31, ob = rr * 64 + cc * 2; return st * 1024 + (ob ^ (((ob >> 9) & 1) << 5)); }
__host__ __device__ __forceinline__ void stage_rc(int b, int& R, int& C) { const int st = b / 1024, sb = b % 1024, swz = sb ^ (((sb >> 9) & 1) << 5); R = (st >> 1) * 16 + swz / 64; C = (st & 1) * 32 + (swz % 64) / 2; }
__host__ __device__ __forceinline__ int perm32(int rho) { const int n = rho >> 4, i = rho & 15; return 8 * (i >> 2) + 4 * n + (i & 3); }
struct Unit { int pm, pn; };
struct Gemm { const bf16_t* A; const bf16_t* Bt; int M, N, K; };
struct StaticOrder {
    int nM, nN, nwg, G, c;
    __host__ __device__ __forceinline__ void init(int M, int N, int G_, int c_) { nM = M / BM; nN = N / BM; nwg = nM * nN; G = G_; c = c_; }
    __host__ __device__ bool next(int i, Unit& u) const {
        const long L = (long)i * G + c; if (L >= nwg) return false;
        int wgid = (int)L; { const int q = nwg / NXCD, r = nwg % NXCD, xcd = wgid % NXCD, off = wgid / NXCD; wgid = (xcd < r ? xcd * (q + 1) : r * (q + 1) + (xcd - r) * q) + off; }
        const int nig = WGM * nN, gid = wgid / nig, fm = gid * WGM, gsz = (nM - fm) < WGM ? (nM - fm) : WGM;
        u.pm = fm + ((wgid % nig) % gsz); u.pn = (wgid % nig) / gsz; return true;
    }
    __device__ __forceinline__ void a_ready(const Unit&) const {}
    __device__ __forceinline__ void done(const Unit&) const {}
};
__device__ __forceinline__ unsigned cvt_pk_bf16(float lo, float hi) { unsigned r; asm volatile("v_cvt_pk_bf16_f32 %0, %1, %2" : "=v"(r) : "v"(lo), "v"(hi)); return r; }

struct EpiF32R {
    static constexpr bool PERM = false, AFTER_DRAIN = false;
    float* C; const float* R; int ldc;
    __device__ __forceinline__ void operator()(const f32x4 (&acc)[2][2][4][2], const Unit& u, int wr, int wc, int fr, int fq) const {
        const int row0 = u.pm * BM + wr * 64 + fr, col0 = u.pn * BM + wc * 32 + 4 * fq;
#pragma unroll
        for (int ai = 0; ai < 2; ++ai)
#pragma unroll
            for (int m = 0; m < 4; ++m) {
                const size_t ro = (size_t)(row0 + ai * HALF + m * 16) * ldc + col0;
                f32x4 rv[2][2];
#pragma unroll
                for (int bj = 0; bj < 2; ++bj)
#pragma unroll
                    for (int n = 0; n < 2; ++n) rv[bj][n] = R ? *(const f32x4*)(R + ro + bj * HALF + n * 16) : (f32x4){0.f, 0.f, 0.f, 0.f};
#pragma unroll
                for (int bj = 0; bj < 2; ++bj)
#pragma unroll
                    for (int n = 0; n < 2; ++n) *(f32x4*)(C + ro + bj * HALF + n * 16) = acc[ai][bj][m][n] + rv[bj][n];
                __builtin_amdgcn_sched_barrier(0);
            }
    }
};

struct EpiBf16 {
    static constexpr bool PERM = true, AFTER_DRAIN = false;
    bf16_t* O; int ldc;
    __device__ __forceinline__ void operator()(const f32x4 (&acc)[2][2][4][2], const Unit& u, int wr, int wc, int fr, int fq) const {
        const int row0 = u.pm * BM + wr * 64 + fr, col0 = u.pn * BM + wc * 32 + 8 * fq;
#pragma unroll
        for (int ai = 0; ai < 2; ++ai)
#pragma unroll
            for (int m = 0; m < 4; ++m) { bf16_t* rowp = O + (size_t)(row0 + ai * HALF + m * 16) * ldc + col0;
#pragma unroll
                for (int bj = 0; bj < 2; ++bj) { const f32x4 v0 = acc[ai][bj][m][0], v1 = acc[ai][bj][m][1];
                    u32x4 w; w.x = cvt_pk_bf16(v0[0], v0[1]); w.y = cvt_pk_bf16(v0[2], v0[3]); w.z = cvt_pk_bf16(v1[0], v1[1]); w.w = cvt_pk_bf16(v1[2], v1[3]);
                    *(u32x4*)(rowp + bj * HALF) = w; } }
    }
};

struct EpiF32RN {
    static constexpr bool PERM = false, AFTER_DRAIN = false;
    float* C; const float* R; int ldc; bf16_t* XG; const float* g; float* st;
    __device__ __forceinline__ void operator()(const f32x4 (&acc)[2][2][4][2], const Unit& u, int wr, int wc, int fr, int fq) const {
        const int row0 = u.pm * BM + wr * 64 + fr, col0 = u.pn * BM + wc * 32 + 4 * fq;
        f32x4 gv[2][2];
#pragma unroll
        for (int bj = 0; bj < 2; ++bj)
#pragma unroll
            for (int n = 0; n < 2; ++n) gv[bj][n] = *(const f32x4*)(g + col0 + bj * HALF + n * 16);
#pragma unroll
        for (int ai = 0; ai < 2; ++ai)
#pragma unroll
            for (int m = 0; m < 4; ++m) {
                const int row = row0 + ai * HALF + m * 16;
                const size_t ro = (size_t)row * ldc + col0;
                f32x4 rv[2][2];
#pragma unroll
                for (int bj = 0; bj < 2; ++bj)
#pragma unroll
                    for (int n = 0; n < 2; ++n) rv[bj][n] = *(const f32x4*)(R + ro + bj * HALF + n * 16);
                float ss = 0.f;
#pragma unroll
                for (int bj = 0; bj < 2; ++bj)
#pragma unroll
                    for (int n = 0; n < 2; ++n) {
                        const f32x4 v = acc[ai][bj][m][n] + rv[bj][n];
                        *(f32x4*)(C + ro + bj * HALF + n * 16) = v;
                        ss += (v[0] * v[0] + v[1] * v[1]) + (v[2] * v[2] + v[3] * v[3]);
                        const f32x4 w = v * gv[bj][n];
                        uint2 pk; pk.x = cvt_pk_bf16(w[0], w[1]); pk.y = cvt_pk_bf16(w[2], w[3]);
                        *(uint2*)(XG + ro + bj * HALF + n * 16) = pk;
                    }
                ss += __shfl_xor(ss, 16, 64); ss += __shfl_xor(ss, 32, 64);
                if (fq == 0) st[(size_t)row * 16 + u.pn * 4 + wc] = ss;
                __builtin_amdgcn_sched_barrier(0);
            }
    }
};
struct EpiBf16S {
    static constexpr bool PERM = true, AFTER_DRAIN = false;
    bf16_t* O; int ldc; const float* st;
    __device__ __forceinline__ void operator()(const f32x4 (&acc)[2][2][4][2], const Unit& u, int wr, int wc, int fr, int fq) const {
        const int row0 = u.pm * BM + wr * 64 + fr, col0 = u.pn * BM + wc * 32 + 8 * fq;
#pragma unroll
        for (int ai = 0; ai < 2; ++ai)
#pragma unroll
            for (int m = 0; m < 4; ++m) {
                const int row = row0 + ai * HALF + m * 16;
                const f32x4* sp = (const f32x4*)(st + (size_t)row * 16);
                const f32x4 s0 = sp[0], s1 = sp[1], s2 = sp[2], s3 = sp[3];
                const f32x4 sa = (s0 + s1) + (s2 + s3);
                const float rs = __builtin_amdgcn_rsqf(((sa[0] + sa[1]) + (sa[2] + sa[3])) * (1.0f / 1024.f) + 1e-6f);
                bf16_t* rowp = O + (size_t)row * ldc + col0;
#pragma unroll
                for (int bj = 0; bj < 2; ++bj) { const f32x4 v0 = acc[ai][bj][m][0] * rs, v1 = acc[ai][bj][m][1] * rs;
                    u32x4 w; w.x = cvt_pk_bf16(v0[0], v0[1]); w.y = cvt_pk_bf16(v0[2], v0[3]); w.z = cvt_pk_bf16(v1[0], v1[1]); w.w = cvt_pk_bf16(v1[2], v1[3]);
                    *(u32x4*)(rowp + bj * HALF) = w; }
                __builtin_amdgcn_sched_barrier(0);
            }
    }
};

template <class Epi, class Sched, bool ALIGN_EPI = false, bool SP2 = false>
__device__ __forceinline__ void gemm_phase(const int wave_s, PG8_LAS unsigned char* lds, const Gemm g, const Sched& S, const Epi& E) {
    const int tid = opaque_tid(wave_s), wid = __builtin_amdgcn_readfirstlane(tid >> 6), lane = tid & 63, wr = wid >> 2, wc = wid & 3, fr = lane & 15, fq = lane >> 4;
    const int K = g.K, nt = K / BK;
    unsigned voffA[2], voffB[2];
#pragma unroll
    for (int i = 0; i < 2; ++i) { int R, C; stage_rc(tid * 16 + i * 8192, R, C); const int Rb = Epi::PERM ? ((R & ~31) + perm32(R & 31)) : R;
        voffA[i] = (unsigned)(R * K + C) * 2u; voffB[i] = (unsigned)(Rb * K + C) * 2u; }
    const size_t kstep = (size_t)(BK * 2);
    const size_t hstep = (size_t)HALF * K * 2;
    const size_t tstep = 2 * hstep;
    const unsigned ldsw = (unsigned)wid * 1024u;
    const int aoff = lds_byte(wr * 64 + fr, fq * 8), boff = lds_byte(wc * 32 + fr, fq * 8);
#define PG8_SA(b, h) (((b) * 2 + (h)) * HTB)
#define PG8_SB(b, h) ((4 + (b) * 2 + (h)) * HTB)
#define PG8_STAGE(bufoff, gbase, voff) do { _Pragma("unroll") for (int _i = 0; _i < 2; ++_i) \
        __builtin_amdgcn_global_load_lds((const unsigned*)((const char*)(gbase) + (voff)[_i]), (PG8_LAS unsigned*)(lds + (bufoff) + ldsw + _i * 8192), 16, 0, 0); } while (0)
#define PG8_LDA(dst, b, h) do { _Pragma("unroll") for (int m = 0; m < 4; ++m) _Pragma("unroll") for (int k = 0; k < 2; ++k) dst[m][k] = *(const PG8_LAS bf16x8*)(lds + PG8_SA(b, h) + aoff + m * 2048 + k * 1024); } while (0)
#define PG8_LDB(dst, b, h) do { _Pragma("unroll") for (int n = 0; n < 2; ++n) _Pragma("unroll") for (int k = 0; k < 2; ++k) dst[n][k] = *(const PG8_LAS bf16x8*)(lds + PG8_SB(b, h) + boff + n * 2048 + k * 1024); } while (0)
#define PG8_MMA(ai, bj, At, Bt) do { __builtin_amdgcn_s_setprio(1); _Pragma("unroll") for (int m = 0; m < 4; ++m) _Pragma("unroll") for (int n = 0; n < 2; ++n) _Pragma("unroll") for (int k = 0; k < 2; ++k) \
        acc[ai][bj][m][n] = __builtin_amdgcn_mfma_f32_16x16x32_bf16(Bt[n][k], At[m][k], acc[ai][bj][m][n], 0, 0, 0); __builtin_amdgcn_s_setprio(0); } while (0)
#define PG8_WAIT_V(n) asm volatile("s_waitcnt vmcnt(" #n ")" ::: "memory")
#define PG8_WAIT_L(n) asm volatile("s_waitcnt lgkmcnt(" #n ")" ::: "memory")
#define PG8_BAR __builtin_amdgcn_s_barrier()
#define PG8_SCHED __builtin_amdgcn_sched_barrier(0)
    Unit cur, nxt; int ui = 0;
    if (!S.next(0, cur)) return;
    f32x4 acc[2][2][4][2];
#pragma unroll
    for (int a = 0; a < 2; ++a)
#pragma unroll
        for (int b = 0; b < 2; ++b)
#pragma unroll
            for (int m = 0; m < 4; ++m)
#pragma unroll
                for (int n = 0; n < 2; ++n) acc[a][b][m][n] = (f32x4){0.f, 0.f, 0.f, 0.f};
    bf16x8 At[4][2], B0[2][2], B1[2][2];
    const char* cA = (const char*)g.A + (size_t)cur.pm * tstep; const char* cB = (const char*)g.Bt + (size_t)cur.pn * tstep;
    S.a_ready(cur);
    if constexpr (SP2) {
        PG8_STAGE(PG8_SB(0, 0), cB, voffB); PG8_STAGE(PG8_SB(0, 1), cB + hstep, voffB); PG8_STAGE(PG8_SA(0, 0), cA, voffA); PG8_STAGE(PG8_SA(0, 1), cA + hstep, voffA);
        if (wr == 1) PG8_BAR;
        PG8_WAIT_V(2); PG8_BAR;
        PG8_STAGE(PG8_SB(1, 0), cB + kstep, voffB); PG8_STAGE(PG8_SA(1, 0), cA + kstep, voffA); PG8_STAGE(PG8_SB(1, 1), cB + hstep + kstep, voffB);
        PG8_WAIT_V(6); PG8_BAR;
    } else {
        PG8_STAGE(PG8_SB(0, 0), cB, voffB); PG8_STAGE(PG8_SA(0, 0), cA, voffA); PG8_STAGE(PG8_SB(0, 1), cB + hstep, voffB); PG8_STAGE(PG8_SA(0, 1), cA + hstep, voffA);
        if (wr == 1) PG8_BAR;
        PG8_WAIT_V(4); PG8_BAR;
        PG8_STAGE(PG8_SB(1, 0), cB + kstep, voffB); PG8_STAGE(PG8_SA(1, 0), cA + kstep, voffA); PG8_STAGE(PG8_SB(1, 1), cB + hstep + kstep, voffB);
        PG8_WAIT_V(6); PG8_BAR;
    }
    for (;;) {
        const bool has_next = S.next(ui + 1, nxt);
        const char* nA = has_next ? (const char*)g.A + (size_t)nxt.pm * tstep : cA; const char* nB = has_next ? (const char*)g.Bt + (size_t)nxt.pn * tstep : cB;
        for (int t = 0; t < nt; t += 2) {
            const bool last = (t == nt - 2);
            const char* a1 = cA + (size_t)(t + 1) * kstep;
            const char* a2 = last ? nA : cA + (size_t)(t + 2) * kstep; const char* b2 = last ? nB : cB + (size_t)(t + 2) * kstep;
            const char* a3 = a2 + kstep; const char* b3 = b2 + kstep;
            if (last && has_next) S.a_ready(nxt);
            if constexpr (SP2) {
            PG8_LDB(B0, 0, 0); PG8_LDB(B1, 0, 1); PG8_SCHED; PG8_LDA(At, 0, 0); PG8_STAGE(PG8_SA(1, 1), a1 + hstep, voffA);
            PG8_WAIT_V(8); PG8_WAIT_L(0); PG8_BAR; PG8_MMA(0, 0, At, B0); PG8_MMA(0, 1, At, B1); PG8_BAR; PG8_SCHED;
            PG8_LDA(At, 0, 1); PG8_STAGE(PG8_SB(0, 0), b2, voffB); PG8_STAGE(PG8_SB(0, 1), b2 + hstep, voffB); PG8_STAGE(PG8_SA(0, 0), a2, voffA);
            PG8_WAIT_V(8); PG8_WAIT_L(0); PG8_BAR; PG8_MMA(1, 0, At, B0); PG8_MMA(1, 1, At, B1); PG8_BAR; PG8_SCHED;
            PG8_LDB(B0, 1, 0); PG8_LDB(B1, 1, 1); PG8_SCHED; PG8_LDA(At, 1, 0); PG8_STAGE(PG8_SA(0, 1), a2 + hstep, voffA);
            PG8_WAIT_V(8); PG8_WAIT_L(0); PG8_BAR; PG8_MMA(0, 0, At, B0); PG8_MMA(0, 1, At, B1); PG8_BAR; PG8_SCHED;
            PG8_LDA(At, 1, 1); PG8_STAGE(PG8_SB(1, 0), b3, voffB); PG8_STAGE(PG8_SB(1, 1), b3 + hstep, voffB); PG8_STAGE(PG8_SA(1, 0), a3, voffA);
            PG8_WAIT_V(8); PG8_WAIT_L(0); PG8_BAR; PG8_MMA(1, 0, At, B0); PG8_MMA(1, 1, At, B1); PG8_BAR; PG8_SCHED;
            } else {
            PG8_LDB(B0, 0, 0); PG8_SCHED; PG8_LDA(At, 0, 0); PG8_STAGE(PG8_SA(1, 1), a1 + hstep, voffA);
            PG8_WAIT_L(8); PG8_BAR; PG8_WAIT_L(0); PG8_MMA(0, 0, At, B0); PG8_BAR; PG8_SCHED;
            PG8_LDB(B1, 0, 1); PG8_STAGE(PG8_SB(0, 0), b2, voffB);
            PG8_BAR; PG8_WAIT_L(0); PG8_MMA(0, 1, At, B1); PG8_BAR;
            PG8_LDA(At, 0, 1); PG8_STAGE(PG8_SA(0, 0), a2, voffA);
            PG8_BAR; PG8_WAIT_L(0); PG8_MMA(1, 0, At, B0); PG8_BAR; PG8_SCHED;
            PG8_STAGE(PG8_SB(0, 1), b2 + hstep, voffB);
            PG8_WAIT_V(6); PG8_BAR; PG8_MMA(1, 1, At, B1); PG8_BAR;
            PG8_LDB(B0, 1, 0); PG8_SCHED; PG8_LDA(At, 1, 0); PG8_STAGE(PG8_SA(0, 1), a2 + hstep, voffA);
            PG8_WAIT_L(8); PG8_BAR; PG8_WAIT_L(0); PG8_MMA(0, 0, At, B0); PG8_BAR; PG8_SCHED;
            PG8_LDB(B1, 1, 1); PG8_STAGE(PG8_SB(1, 0), b3, voffB);
            PG8_BAR; PG8_WAIT_L(0); PG8_MMA(0, 1, At, B1); PG8_BAR;
            PG8_LDA(At, 1, 1); PG8_STAGE(PG8_SA(1, 0), a3, voffA);
            PG8_BAR; PG8_WAIT_L(0); PG8_MMA(1, 0, At, B0); PG8_BAR; PG8_SCHED;
            PG8_STAGE(PG8_SB(1, 1), b3 + hstep, voffB);
            PG8_WAIT_V(6); PG8_BAR; PG8_MMA(1, 1, At, B1); PG8_BAR;
            }
        }
        if constexpr (ALIGN_EPI) { if (wr == 0) PG8_BAR; }
        if constexpr (!Epi::AFTER_DRAIN) { E(acc, cur, wr, wc, fr, fq); S.done(cur); }
        if (!has_next) break;
#pragma unroll
        for (int a = 0; a < 2; ++a)
#pragma unroll
            for (int b = 0; b < 2; ++b)
#pragma unroll
                for (int m = 0; m < 4; ++m)
#pragma unroll
                    for (int n = 0; n < 2; ++n) acc[a][b][m][n] = (f32x4){0.f, 0.f, 0.f, 0.f};
        cur = nxt; cA = nA; cB = nB; ++ui;
        if constexpr (ALIGN_EPI) { if (wr == 1) PG8_BAR; }
    }
    PG8_WAIT_V(0);
    if constexpr (!ALIGN_EPI) { if (wr == 0) PG8_BAR; }
    PG8_BAR;
#undef PG8_SA
#undef PG8_SB
#undef PG8_STAGE
#undef PG8_LDA
#undef PG8_LDB
#undef PG8_MMA
#undef PG8_WAIT_V
#undef PG8_WAIT_L
#undef PG8_BAR
#undef PG8_SCHED
}
}

__device__ __forceinline__ void transpose_item(const float* W, int K, int N, bf16* WT, LAS float* scr, int item, int lane) {
    const int nblk = N / 32, kb = item / nblk, nb = item % nblk, k0 = 64 * kb, n0 = 32 * nb;
#pragma unroll 8
    for (int i = 0; i < 32; ++i) { const int kk = 2 * i + (lane >> 5); scr[kk * 33 + (lane & 31)] = W[(size_t)(k0 + kk) * N + n0 + (lane & 31)]; }
    asm volatile("s_waitcnt lgkmcnt(0)" ::: "memory");
    const int c = lane & 7;
#pragma unroll
    for (int j = 0; j < 4; ++j) { const int n = (lane >> 3) + 8 * j; const LAS float* s = scr + (8 * c) * 33 + n;
        uint4 o; o.x = pk2(s[0 * 33], s[1 * 33]); o.y = pk2(s[2 * 33], s[3 * 33]); o.z = pk2(s[4 * 33], s[5 * 33]); o.w = pk2(s[6 * 33], s[7 * 33]);
        *(uint4*)(WT + (size_t)(n0 + n) * K + k0 + 8 * c) = o; }
    asm volatile("s_waitcnt lgkmcnt(0)" ::: "memory");
}

__device__ __forceinline__ float wsum(float v) {
#pragma unroll
  for (int o = 32; o > 0; o >>= 1) v += __shfl_xor(v, o, 64);
  return v;
}
__device__ __forceinline__ float wmaxf(float v) {
#pragma unroll
  for (int o = 32; o > 0; o >>= 1) v = fmaxf(v, __shfl_xor(v, o, 64));
  return v;
}
__device__ __forceinline__ float sigmoidf_(float x) { return 1.0f / (1.0f + expf(-x)); }
__device__ __forceinline__ float gelu_tanh(float x) {
  return 0.5f * x * (1.0f + tanhf(0.7978845608028654f * (x + 0.044715f * x * x * x)));
}

template <bool BF16OUT>
__device__ __forceinline__ void rms_rows(const int wave_s, const float* src, const float* g, void* dstv, int rows) {
  const int tid_ = opaque_tid(wave_s);
  const int lane = tid_ & 63;
  const int gw = blockIdx.x * NWAVES + (tid_ >> 6);
  const int nw = gridDim.x * NWAVES;
  for (int r = gw; r < rows; r += nw) {
    const float4* s4 = (const float4*)(src + (size_t)r * DM);
    float4 v[4];
    float ss = 0.f;
#pragma unroll
    for (int i = 0; i < 4; i++) {
      v[i] = s4[lane + i * 64];
      ss += v[i].x * v[i].x + v[i].y * v[i].y + v[i].z * v[i].z + v[i].w * v[i].w;
    }
    ss = wsum(ss);
    const float rstd = rsqrtf(ss * (1.0f / DM) + EPSF);
    const float4* g4 = (const float4*)g;
#pragma unroll
    for (int i = 0; i < 4; i++) {
      float4 gg = g4[lane + i * 64];
      float4 o;
      o.x = v[i].x * rstd * gg.x; o.y = v[i].y * rstd * gg.y;
      o.z = v[i].z * rstd * gg.z; o.w = v[i].w * rstd * gg.w;
      if (BF16OUT) {
        uint2 pk; pk.x = pk2(o.x, o.y); pk.y = pk2(o.z, o.w);
        ((uint2*)((bf16*)dstv + (size_t)r * DM))[lane + i * 64] = pk;
      } else {
        ((float4*)((float*)dstv + (size_t)r * DM))[lane + i * 64] = o;
      }
    }
  }
}

__device__ __forceinline__ void ssm_params(const int wave_s, const Params& p, float* ssmp_all) {
  const int tid_ = opaque_tid(wave_s);
  const float* in8 = karg_in(8); const float* in9 = karg_in(9); const float* in10 = karg_in(10);
  const float* in11 = karg_in(11); const float* in12 = karg_in(12);
  const int gt = blockIdx.x * blockDim.x + tid_;
  const int nth = gridDim.x * blockDim.x;
  for (int i = gt; i < 2 * 16 * 64; i += nth) {
    const int l = i / 1024, gp = i % 1024, g = gp / 64;
    float* sp = ssmp_all + (size_t)l * SSMP_PER_LAYER;
    const float lre = fminf(in8[l * 1024 + gp], -1e-4f);
    const float lim = in9[l * 1024 + gp];
    const float dt = expf(in10[l * 16 + g]);
    const float er = expf(lre * dt);
    float sn, cs;
    sincosf(lim * dt, &sn, &cs);
    const float br = er * cs, bi = er * sn;
    sp[gp * 2 + 0] = br;
    sp[gp * 2 + 1] = bi;
    float cr = br, ci = bi;
#pragma unroll
    for (int s = 0; s < 6; s++) {
      const float nr = cr * cr - ci * ci, ni = 2.f * cr * ci;
      cr = nr; ci = ni;
    }
    sp[2048 + gp * 2 + 0] = cr;
    sp[2048 + gp * 2 + 1] = ci;
    const float nr = br - 1.0f, ni = bi;
    const float den = lre * lre + lim * lim;
    const float fr = (nr * lre + ni * lim) / den;
    const float fi = (ni * lre - nr * lim) / den;
    for (int h = 0; h < 16; h++) {
      const float bre = in11[((size_t)l * 1024 + gp) * 16 + h];
      const float bim = in12[((size_t)l * 1024 + gp) * 16 + h];
      sp[4096 + ((g * 16 + h) * 64 + (gp & 63)) * 2 + 0] = fr * bre - fi * bim;
      sp[4096 + ((g * 16 + h) * 64 + (gp & 63)) * 2 + 1] = fr * bim + fi * bre;
    }
  }
}

__device__ __forceinline__ void conv_phase(const int wave_s, const Params& p, int l, const bf16* proj, bf16* y, LAS float* smem) {
  const int tid_ = opaque_tid(wave_s);
  const int lane = tid_ & 63;
  const int gw = blockIdx.x * NWAVES + (tid_ >> 6);
  const int nw = gridDim.x * NWAVES;
  const float* cw = karg_in(4) + (size_t)l * 31 * 256;
  const float4 cb = ((const float4*)(karg_in(5) + l * 256))[lane];
  const float4 lg = ((const float4*)(karg_in(6) + l * 256))[lane];
  const float4 lb = ((const float4*)(karg_in(7) + l * 256))[lane];
  const float4 gg = ((const float4*)(karg_in(18) + l * 1024))[lane];
  LAS float* cwl = smem + 1024;
  for (int i = tid_; i < 31 * 256 / 4; i += NWAVES * 64) *(LAS pg8::f32x4*)(cwl + 4 * i) = *(const pg8::f32x4*)(cw + 4 * i);
  __syncthreads();
  for (int it = gw; it < NT / 8; it += nw) {
    const int tok0 = it * 8;
    const int t0 = tok0 & (SEQ - 1);
    float4 acc[8];
#pragma unroll
    for (int o = 0; o < 8; o++) acc[o] = cb;
#pragma unroll
    for (int i = 0; i < 38; i++) {
      if (t0 - 30 + i >= 0) {
        const bf16* row = proj + (size_t)(tok0 - 30 + i) * DIN;
        const uint2 vp = ((const uint2*)row)[lane];
        const uint2 gp = ((const uint2*)(row + 256))[lane];
        float4 g4;
        g4.x = bf_lo(vp.x) * sigmoidf_(bf_lo(gp.x)); g4.y = bf_hi(vp.x) * sigmoidf_(bf_hi(gp.x));
        g4.z = bf_lo(vp.y) * sigmoidf_(bf_lo(gp.y)); g4.w = bf_hi(vp.y) * sigmoidf_(bf_hi(gp.y));
#pragma unroll
        for (int o = 0; o < 8; o++) {
          const int j = i - o;
          if (j >= 0 && j <= 30) {
            const pg8::f32x4 w4 = *(const LAS pg8::f32x4*)(cwl + j * 256 + lane * 4);
            acc[o].x += g4.x * w4[0]; acc[o].y += g4.y * w4[1];
            acc[o].z += g4.z * w4[2]; acc[o].w += g4.w * w4[3];
          }
        }
      }
    }
#pragma unroll
    for (int o = 0; o < 8; o++) {
      const float4 a = acc[o];
      const float mean = wsum(a.x + a.y + a.z + a.w) * (1.0f / 256.f);
      const float dx = a.x - mean, dy = a.y - mean, dz = a.z - mean, dw = a.w - mean;
      const float var = wsum(dx * dx + dy * dy + dz * dz + dw * dw) * (1.0f / 256.f);
      const float rs = rsqrtf(var + EPSF);
      float4 s;
      s.x = dx * rs * lg.x + lb.x; s.y = dy * rs * lg.y + lb.y;
      s.z = dz * rs * lg.z + lb.z; s.w = dw * rs * lg.w + lb.w;
      s.x = s.x * sigmoidf_(s.x); s.y = s.y * sigmoidf_(s.y);
      s.z = s.z * sigmoidf_(s.z); s.w = s.w * sigmoidf_(s.w);
      const float ss = wsum(s.x * s.x + s.y * s.y + s.z * s.z + s.w * s.w) * (1.0f / 256.f);
      const float r2 = rsqrtf(ss + EPSF);
      uint2 pk; pk.x = pk2(s.x * r2 * gg.x, s.y * r2 * gg.y); pk.y = pk2(s.z * r2 * gg.z, s.w * r2 * gg.w);
      ((uint2*)(y + (size_t)(tok0 + o) * DM))[lane] = pk;
    }
  }
}

typedef short bf16x8_t __attribute__((ext_vector_type(8)));
typedef float f32x16_t __attribute__((ext_vector_type(16)));
#define MFMA_PAD() do { __builtin_amdgcn_sched_barrier(0); asm volatile("s_nop 15\n\ts_nop 15" ::: "memory"); __builtin_amdgcn_sched_barrier(0); } while (0)

__device__ __forceinline__ void attn_phase(const int wave_s, const Params& p, int l, const bf16* proj, bf16* y, LAS float* smem) {
  const int tid = opaque_tid(wave_s), lane = tid & 63, wave = tid >> 6;
  const int n = lane & 31, hh = lane >> 5;
  const float* gg = karg_in(18) + l * 1024 + 256 + wave * 64;
  const float g0 = gg[n], g1 = gg[32 + n];
  LAS float* ssq = smem;
  LAS float* rstd = smem + 256;
  for (int item = blockIdx.x; item < 4 * 128; item += gridDim.x) {
    const int b = item >> 7, q0 = (item & 127) * 32;
    const size_t tokb = (size_t)b * SEQ;
    bf16x8_t qf[4];
    {
      const bf16* qrow = proj + (tokb + q0 + n) * DIN + 512 + wave * 64 + 8 * hh;
#pragma unroll
      for (int ks = 0; ks < 4; ks++) qf[ks] = *(const bf16x8_t*)(qrow + 16 * ks);
    }
    f32x16_t o0, o1;
#pragma unroll
    for (int r = 0; r < 16; r++) { o0[r] = 0.f; o1[r] = 0.f; }
    float R = 0.f;
    for (int kt = q0; kt >= 0; kt -= 32) {
      bf16x8_t kf[4];
      {
        const bf16* krow = proj + (tokb + kt + n) * DIN + 1024 + wave * 64 + 8 * hh;
#pragma unroll
        for (int ks = 0; ks < 4; ks++) kf[ks] = *(const bf16x8_t*)(krow + 16 * ks);
      }
      bf16x8_t vf0[2], vf1[2];
      {
        const bf16* vb = proj + (tokb + kt + 4 * hh) * DIN + 1536 + wave * 64 + n;
#pragma unroll
        for (int s = 0; s < 2; s++)
#pragma unroll
          for (int j = 0; j < 8; j++) {
            const int key = 16 * s + 8 * (j >> 2) + (j & 3);
            vf0[s][j] = (short)vb[(size_t)key * DIN];
            vf1[s][j] = (short)vb[(size_t)key * DIN + 32];
          }
      }
      f32x16_t sacc;
#pragma unroll
      for (int r = 0; r < 16; r++) sacc[r] = 0.f;
      __builtin_amdgcn_sched_barrier(0); asm volatile("s_nop 15\n\ts_nop 15" ::: "memory"); __builtin_amdgcn_sched_barrier(0);
#pragma unroll
      for (int ks = 0; ks < 4; ks++) sacc = __builtin_amdgcn_mfma_f32_32x32x16_bf16(kf[ks], qf[ks], sacc, 0, 0, 0);
      __builtin_amdgcn_sched_barrier(0); asm volatile("s_nop 15\n\ts_nop 15" ::: "memory"); __builtin_amdgcn_sched_barrier(0);
      float lst[16], lsz[16];
      const bool diag = (kt == q0);
#pragma unroll
      for (int r = 0; r < 16; r++) {
        const float z = sacc[r] * 0.125f;
        const float sp = __logf(1.0f + __expf(-fabsf(z)));
        float a = fminf(z, 0.f) - sp;
        float c = -(fmaxf(z, 0.f) + sp);
        if (diag) {
          const int key = (r & 3) + 8 * (r >> 2) + 4 * hh;
          if (key >= n) { a = -1.0e30f; c = 0.f; }
        }
        lsz[r] = a; lst[r] = c;
      }
      float Gs[4], Gp[4];
#pragma unroll
      for (int g = 0; g < 4; g++) {
        Gs[g] = (lst[4 * g] + lst[4 * g + 1]) + (lst[4 * g + 2] + lst[4 * g + 3]);
        Gp[g] = __shfl_xor(Gs[g], 32, 64);
      }
      float carry[4];
      {
        float after = R;
#pragma unroll
        for (int g = 3; g >= 0; g--) {
          carry[g] = after + (hh ? 0.f : Gp[g]);
          after += Gs[g] + Gp[g];
        }
        R = after;
      }
      bf16x8_t pf[2];
#pragma unroll
      for (int g = 0; g < 4; g++) {
        float run = carry[g];
        float a3 = __expf(lsz[4 * g + 3] + run); run += lst[4 * g + 3];
        float a2 = __expf(lsz[4 * g + 2] + run); run += lst[4 * g + 2];
        float a1 = __expf(lsz[4 * g + 1] + run); run += lst[4 * g + 1];
        float a0 = __expf(lsz[4 * g + 0] + run);
        const int s = g >> 1, jb = (g & 1) * 4;
        pf[s][jb + 0] = (short)f2bf(a0); pf[s][jb + 1] = (short)f2bf(a1);
        pf[s][jb + 2] = (short)f2bf(a2); pf[s][jb + 3] = (short)f2bf(a3);
      }
      __builtin_amdgcn_sched_barrier(0); asm volatile("s_nop 15\n\ts_nop 15" ::: "memory"); __builtin_amdgcn_sched_barrier(0);
#pragma unroll
      for (int s = 0; s < 2; s++) {
        o0 = __builtin_amdgcn_mfma_f32_32x32x16_bf16(pf[s], vf0[s], o0, 0, 0, 0);
        o1 = __builtin_amdgcn_mfma_f32_32x32x16_bf16(pf[s], vf1[s], o1, 0, 0, 0);
      }
      __builtin_amdgcn_sched_barrier(0); asm volatile("s_nop 15\n\ts_nop 15" ::: "memory"); __builtin_amdgcn_sched_barrier(0);
      if (__all(R < -110.f)) break;
    }
    float sq[16];
#pragma unroll
    for (int r = 0; r < 16; r++) {
      float v = o0[r] * o0[r] + o1[r] * o1[r];
#pragma unroll
      for (int o = 16; o > 0; o >>= 1) v += __shfl_xor(v, o, 64);
      sq[r] = v;
    }
    __syncthreads();
    if (n == 0) {
#pragma unroll
      for (int r = 0; r < 16; r++) ssq[wave * 32 + (r & 3) + 8 * (r >> 2) + 4 * hh] = sq[r];
    }
    __syncthreads();
    if (tid < 32) {
      float t = 0.f;
#pragma unroll
      for (int w = 0; w < 8; w++) t += ssq[w * 32 + tid];
      rstd[tid] = rsqrtf(t * (1.0f / 512.f) + EPSF);
    }
    __syncthreads();
#pragma unroll
    for (int r = 0; r < 16; r++) {
      const int qi = (r & 3) + 8 * (r >> 2) + 4 * hh;
      const float rs = rstd[qi];
      bf16* yr = y + (tokb + q0 + qi) * DM + 256 + wave * 64 + n;
      yr[0] = (bf16)f2bf(o0[r] * rs * g0);
      yr[32] = (bf16)f2bf(o1[r] * rs * g1);
    }
  }
}

#define SSM_BCAST_U(u, ua, ub, tt) do { \
    const unsigned w0 = (unsigned)__builtin_amdgcn_readlane((int)(ua).x, (tt)), w1 = (unsigned)__builtin_amdgcn_readlane((int)(ua).y, (tt)); \
    const unsigned w2 = (unsigned)__builtin_amdgcn_readlane((int)(ua).z, (tt)), w3 = (unsigned)__builtin_amdgcn_readlane((int)(ua).w, (tt)); \
    const unsigned w4 = (unsigned)__builtin_amdgcn_readlane((int)(ub).x, (tt)), w5 = (unsigned)__builtin_amdgcn_readlane((int)(ub).y, (tt)); \
    const unsigned w6 = (unsigned)__builtin_amdgcn_readlane((int)(ub).z, (tt)), w7 = (unsigned)__builtin_amdgcn_readlane((int)(ub).w, (tt)); \
    (u)[0] = bf_lo(w0); (u)[1] = bf_hi(w0); (u)[2] = bf_lo(w1); (u)[3] = bf_hi(w1); (u)[4] = bf_lo(w2); (u)[5] = bf_hi(w2); (u)[6] = bf_lo(w3); (u)[7] = bf_hi(w3); \
    (u)[8] = bf_lo(w4); (u)[9] = bf_hi(w4); (u)[10] = bf_lo(w5); (u)[11] = bf_hi(w5); (u)[12] = bf_lo(w6); (u)[13] = bf_hi(w6); (u)[14] = bf_lo(w7); (u)[15] = bf_hi(w7); } while (0)
#define SSM_RS 592
#define SSM_TILE_BASE 36864
#define SSM_TILE_BYTES (16 * SSM_RS)
typedef float f32x2_t __attribute__((ext_vector_type(2)));
__device__ __forceinline__ void ssm_load_bop(const float* ssmp, int g, int lane, bf16x8_t (&bop)[8]) {
  const int q = lane >> 4, n = lane & 15;
  float v[8][8];
#pragma unroll
  for (int j = 0; j < 8; j++) {
    const float4* rp = (const float4*)(ssmp + 4096 + (size_t)(g * 16 + ((8 * q + j) & 15)) * 128 + 8 * n);
    const float4 a = rp[0], b = rp[1];
    v[j][0] = a.x; v[j][1] = a.y; v[j][2] = a.z; v[j][3] = a.w; v[j][4] = b.x; v[j][5] = b.y; v[j][6] = b.z; v[j][7] = b.w;
  }
#pragma unroll
  for (int nt = 0; nt < 8; nt++) {
    pg8::u32x4 w;
    w.x = pk2(v[0][nt], v[1][nt]); w.y = pk2(v[2][nt], v[3][nt]); w.z = pk2(v[4][nt], v[5][nt]); w.w = pk2(v[6][nt], v[7][nt]);
    if (q >= 2) { w.x = 0u; w.y = 0u; w.z = 0u; w.w = 0u; }
    bop[nt] = __builtin_bit_cast(bf16x8_t, w);
  }
}
__device__ __forceinline__ void ssm_bu_block(LAS unsigned char* xt, int lane, int blk, const uint4& ua, const uint4& ub, const bf16x8_t (&bop)[8]) {
  const int q = lane >> 4, n = lane & 15;
  if (q == blk) {
    pg8::u32x4 w0, w1;
    w0.x = ua.x; w0.y = ua.y; w0.z = ua.z; w0.w = ua.w; w1.x = ub.x; w1.y = ub.y; w1.z = ub.z; w1.w = ub.w;
    LAS pg8::u32x4* ur = (LAS pg8::u32x4*)(xt + n * SSM_RS + 512);
    ur[0] = w0; ur[1] = w1;
  }
  __builtin_amdgcn_wave_barrier();
  const bf16x8_t uop = *(const LAS bf16x8_t*)(xt + n * SSM_RS + 512 + q * 16);
  pg8::f32x4 bacc[8];
#pragma unroll
  for (int nt = 0; nt < 8; nt++) {
    pg8::f32x4 z4; z4[0] = 0.f; z4[1] = 0.f; z4[2] = 0.f; z4[3] = 0.f;
    bacc[nt] = __builtin_amdgcn_mfma_f32_16x16x32_bf16(uop, bop[nt], z4, 0, 0, 0);
  }
#pragma unroll
  for (int j = 0; j < 4; j++) {
    pg8::f32x4 w0, w1;
    w0[0] = bacc[0][j]; w0[1] = bacc[1][j]; w0[2] = bacc[2][j]; w0[3] = bacc[3][j];
    w1[0] = bacc[4][j]; w1[1] = bacc[5][j]; w1[2] = bacc[6][j]; w1[3] = bacc[7][j];
    LAS pg8::f32x4* dr = (LAS pg8::f32x4*)(xt + (4 * q + j) * SSM_RS + 32 * n);
    dr[0] = w0; dr[1] = w1;
  }
  __builtin_amdgcn_wave_barrier();
}
__device__ __forceinline__ void ssm_zero_pad(LAS unsigned char* xt, int lane) {
  if (lane < 16) {
    pg8::u32x4 z4; z4.x = 0u; z4.y = 0u; z4.z = 0u; z4.w = 0u;
    LAS pg8::u32x4* zr = (LAS pg8::u32x4*)(xt + lane * SSM_RS + 544);
    zr[0] = z4; zr[1] = z4;
  }
}
__device__ __forceinline__ void ssm_chunk_end(const int wave_s, const float* ssmp, const bf16* proj, float* ssmE, LAS float* smem) {
  const int tid_ = opaque_tid(wave_s);
  const int lane = tid_ & 63;
  const int gw = blockIdx.x * NWAVES + (tid_ >> 6);
  const int nw = gridDim.x * NWAVES;
  for (int it = gw; it < 4 * 64 * 16; it += nw) {
    const int g = it & 15, c = (it >> 4) & 63, b = it >> 10;
    const int gp = g * 64 + lane;
    const uint4* up = (const uint4*)(proj + (size_t)(b * SEQ + c * 64 + lane) * DIN + 2048 + g * 16);
    const uint4 ua = up[0], ub = up[1];
    const float lbr = ssmp[gp * 2], lbi = ssmp[gp * 2 + 1];
    bf16x8_t bop[8];
    ssm_load_bop(ssmp, g, lane, bop);
    LAS unsigned char* xt = (LAS unsigned char*)smem + SSM_TILE_BASE + (tid_ >> 6) * SSM_TILE_BYTES;
    ssm_zero_pad(xt, lane);
    float xr = 0.f, xi = 0.f;
#pragma unroll 1
    for (int blk = 0; blk < 4; blk++) {
      ssm_bu_block(xt, lane, blk, ua, ub, bop);
#pragma unroll 4
      for (int tt = 0; tt < 16; tt++) {
        const f32x2_t bu = *(const LAS f32x2_t*)(xt + tt * SSM_RS + lane * 8);
        const float nr = lbr * xr - lbi * xi + bu[0];
        const float ni = lbr * xi + lbi * xr + bu[1];
        xr = nr; xi = ni;
      }
      __builtin_amdgcn_wave_barrier();
    }
    float* e = ssmE + ((size_t)((b * 64 + c) * 16 + g) * 64 + lane) * 2;
    e[0] = xr; e[1] = xi;
  }
}

__device__ __forceinline__ void ssm_finish(const int wave_s, const Params& p, int l, const float* ssmp, const bf16* proj,
                           const float* ssmE, bf16* y, LAS float* smem) {
  LAS bf16* Ytb = (LAS bf16*)smem;
  LAS float* ssq2 = smem + (64 * 264 * 2) / 4;
  LAS float* rstd2 = ssq2 + 512;
  const bf16* glT = (const bf16*)(p.ws + WS_WT + (size_t)l * WT_LAYER + WT_GLU);
  const int tid = opaque_tid(wave_s), lane = tid & 63, wave = tid >> 6;
  const float* cre = karg_in(13) + (size_t)l * 16 * 16 * 64;
  const float* cim = karg_in(14) + (size_t)l * 16 * 16 * 64;
  const float* dsk = karg_in(15) + l * 256;
  const float* glw = karg_in(16) + (size_t)l * 256 * 256;
  const float* glb = karg_in(17) + l * 256;
  const float* gg = karg_in(18) + l * 1024 + 768;
  for (int it = blockIdx.x; it < 256; it += gridDim.x) {
    const int b = it >> 6, c = it & 63;
    __syncthreads();
    for (int gi = 0; gi < 2; gi++) {
      const int g = wave + gi * 8;
      const int gp = g * 64 + lane;
      const float lbr = ssmp[gp * 2], lbi = ssmp[gp * 2 + 1];
      const float lcr = ssmp[2048 + gp * 2], lci = ssmp[2048 + gp * 2 + 1];
      bf16x8_t bop[8];
      ssm_load_bop(ssmp, g, lane, bop);
      bf16x8_t cop[5];
      {
        const int nn = lane & 15, q = lane >> 4;
#pragma unroll
        for (int ks = 0; ks < 4; ks++) {
          const float4 cr4 = *(const float4*)(cre + (g * 16 + nn) * 64 + 16 * ks + 4 * q);
          const float4 ci4 = *(const float4*)(cim + (g * 16 + nn) * 64 + 16 * ks + 4 * q);
          pg8::u32x4 w;
          w.x = pk2(cr4.x, -ci4.x); w.y = pk2(cr4.y, -ci4.y); w.z = pk2(cr4.z, -ci4.z); w.w = pk2(cr4.w, -ci4.w);
          cop[ks] = __builtin_bit_cast(bf16x8_t, w);
        }
        const float dn = dsk[g * 16 + nn];
        float dv[8];
#pragma unroll
        for (int j = 0; j < 8; j++) dv[j] = (8 * q + j == nn) ? dn : 0.f;
        pg8::u32x4 w;
        w.x = pk2(dv[0], dv[1]); w.y = pk2(dv[2], dv[3]); w.z = pk2(dv[4], dv[5]); w.w = pk2(dv[6], dv[7]);
        cop[4] = __builtin_bit_cast(bf16x8_t, w);
      }
      float xr = 0.f, xi = 0.f;
      {
        const float2* eb = (const float2*)ssmE + ((size_t)(b * 64) * 16 + g) * 64 + lane;
        int cc = 0;
        for (; cc + 8 <= c; cc += 8) {
          float2 ev[8];
#pragma unroll
          for (int k = 0; k < 8; k++) ev[k] = eb[(size_t)(cc + k) * 16 * 64];
#pragma unroll
          for (int k = 0; k < 8; k++) {
            const float nr = lcr * xr - lci * xi + ev[k].x;
            const float ni = lcr * xi + lci * xr + ev[k].y;
            xr = nr; xi = ni;
          }
        }
        for (; cc < c; cc++) {
          const float2 e1 = eb[(size_t)cc * 16 * 64];
          const float nr = lcr * xr - lci * xi + e1.x;
          const float ni = lcr * xi + lci * xr + e1.y;
          xr = nr; xi = ni;
        }
      }
      LAS unsigned char* xt = (LAS unsigned char*)smem + SSM_TILE_BASE + wave * SSM_TILE_BYTES;
      const uint4* up = (const uint4*)(proj + (size_t)(b * SEQ + c * 64 + lane) * DIN + 2048 + g * 16);
      const uint4 ua = up[0], ub = up[1];
      ssm_zero_pad(xt, lane);
#pragma unroll 1
      for (int blk = 0; blk < 4; blk++) {
        ssm_bu_block(xt, lane, blk, ua, ub, bop);
#pragma unroll 4
        for (int tt = 0; tt < 16; tt++) {
          const f32x2_t bu = *(const LAS f32x2_t*)(xt + tt * SSM_RS + lane * 8);
          const float nr = lbr * xr - lbi * xi + bu[0];
          const float ni = lbr * xi + lbi * xr + bu[1];
          xr = nr; xi = ni;
          *(LAS unsigned*)(xt + tt * SSM_RS + lane * 4) = pk2(xr, xi);
        }
        __builtin_amdgcn_wave_barrier();
        {
          pg8::f32x4 acc4;
          acc4[0] = 0.f; acc4[1] = 0.f; acc4[2] = 0.f; acc4[3] = 0.f;
          const LAS unsigned char* ar = xt + (lane & 15) * SSM_RS + (lane >> 4) * 16;
#pragma unroll
          for (int ks = 0; ks < 4; ks++)
            acc4 = __builtin_amdgcn_mfma_f32_16x16x32_bf16(*(const LAS bf16x8_t*)(ar + ks * 64), cop[ks], acc4, 0, 0, 0);
          acc4 = __builtin_amdgcn_mfma_f32_16x16x32_bf16(*(const LAS bf16x8_t*)(ar + 512), cop[4], acc4, 0, 0, 0);
#pragma unroll
          for (int j = 0; j < 4; j++)
            Ytb[(blk * 16 + 4 * (lane >> 4) + j) * 264 + g * 16 + (lane & 15)] = (bf16)f2bf(gelu_tanh(acc4[j]));
        }
        __builtin_amdgcn_wave_barrier();
      }
    }
    __syncthreads();
    {
      const int n = lane & 31, hh = lane >> 5;
      const int ch = wave * 32 + n;
      const float bj = glb[ch];
      const float gj = gg[ch];
      bf16x8_t gf[16];
      {
        const bf16* grow = glT + (size_t)ch * 256 + 8 * hh;
#pragma unroll
        for (int ks = 0; ks < 16; ks++) gf[ks] = *(const bf16x8_t*)(grow + 16 * ks);
      }
      float oo[2][16];
#pragma unroll
      for (int mt = 0; mt < 2; mt++) {
        f32x16_t z;
#pragma unroll
        for (int r = 0; r < 16; r++) z[r] = 0.f;
        const LAS bf16* yrow = Ytb + (mt * 32 + n) * 264 + 8 * hh;
#pragma unroll
        for (int kq = 0; kq < 4; kq++) {
          bf16x8_t yf[4];
#pragma unroll
          for (int i = 0; i < 4; i++) yf[i] = *(const LAS bf16x8_t*)(yrow + 16 * (kq * 4 + i));
          MFMA_PAD();
#pragma unroll
          for (int i = 0; i < 4; i++) z = __builtin_amdgcn_mfma_f32_32x32x16_bf16(yf[i], gf[kq * 4 + i], z, 0, 0, 0);
          MFMA_PAD();
        }
        float sq[16];
#pragma unroll
        for (int r = 0; r < 16; r++) {
          const int t = mt * 32 + (r & 3) + 8 * (r >> 2) + 4 * hh;
          const float yv = bf2f(Ytb[t * 264 + ch]);
          const float o = yv * sigmoidf_(z[r] + bj);
          oo[mt][r] = o;
          float v = o * o;
#pragma unroll
          for (int s = 16; s > 0; s >>= 1) v += __shfl_xor(v, s, 64);
          sq[r] = v;
        }
        if (n == 0) {
#pragma unroll
          for (int r = 0; r < 16; r++) ssq2[wave * 64 + mt * 32 + (r & 3) + 8 * (r >> 2) + 4 * hh] = sq[r];
        }
      }
      __syncthreads();
      if (tid < 64) {
        float t = 0.f;
#pragma unroll
        for (int w = 0; w < 8; w++) t += ssq2[w * 64 + tid];
        rstd2[tid] = rsqrtf(t * (1.0f / 256.f) + EPSF);
      }
      __syncthreads();
#pragma unroll
      for (int mt = 0; mt < 2; mt++)
#pragma unroll
        for (int r = 0; r < 16; r++) {
          const int t = mt * 32 + (r & 3) + 8 * (r >> 2) + 4 * hh;
          y[(size_t)(b * SEQ + c * 64 + t) * DM + 768 + ch] = (bf16)f2bf(oo[mt][r] * rstd2[t] * gj);
        }
    }
  }
}

__device__ __forceinline__ void memattn_phase(const int wave_s, const bf16* q, const bf16* kvb, const bf16* vT, bf16* o, LAS float* smem) {
  const int tid_ = opaque_tid(wave_s);
  const int lane = tid_ & 63, n = lane & 31, hh = lane >> 5, wave = tid_ >> 6;
  const int sig = (n & 0x13) | ((n & 4) << 1) | ((n & 8) >> 1);
  LAS bf16* Ls = (LAS bf16*)smem;
  for (int it = blockIdx.x; it < 64 * 4; it += gridDim.x) {
    const int h = it & 3, tg = it >> 2, b = tg >> 4;
    const int tok0 = (tg * 8 + wave) * 32;
    __syncthreads();
    {
      const int r = tid_ >> 1, hf = tid_ & 1;
      const pg8::u32x4* src4 = (const pg8::u32x4*)(kvb + (size_t)(b * NMEM + r) * 2048 + h * 256 + hf * 128);
      LAS pg8::u32x4* dst4 = (LAS pg8::u32x4*)(Ls + r * 264 + hf * 128);
#pragma unroll
      for (int k = 0; k < 16; k++) dst4[k] = src4[k];
    }
    f32x16_t st[8];
#pragma unroll
    for (int kt = 0; kt < 8; kt++)
#pragma unroll
      for (int r = 0; r < 16; r++) st[kt][r] = 0.f;
    const bf16* qrow = q + (size_t)(tok0 + n) * DM + h * 256 + 8 * hh;
    __syncthreads();
#pragma unroll
    for (int kq = 0; kq < 4; kq++) {
      bf16x8_t qf[4];
#pragma unroll
      for (int i = 0; i < 4; i++) qf[i] = *(const bf16x8_t*)(qrow + 16 * (kq * 4 + i));
#pragma unroll
      for (int kt = 0; kt < 8; kt++) {
        const LAS bf16* krow = Ls + (kt * 32 + sig) * 264 + 8 * hh;
        bf16x8_t kf[4];
#pragma unroll
        for (int i = 0; i < 4; i++) kf[i] = *(const LAS bf16x8_t*)(krow + 16 * (kq * 4 + i));
        MFMA_PAD();
#pragma unroll
        for (int i = 0; i < 4; i++) st[kt] = __builtin_amdgcn_mfma_f32_32x32x16_bf16(kf[i], qf[i], st[kt], 0, 0, 0);
        MFMA_PAD();
      }
    }
    float mx = st[0][0];
#pragma unroll
    for (int kt = 0; kt < 8; kt++)
#pragma unroll
      for (int r = 0; r < 16; r++) mx = fmaxf(mx, st[kt][r]);
    mx = fmaxf(mx, __shfl_xor(mx, 32, 64));
    float sum = 0.f;
#pragma unroll
    for (int kt = 0; kt < 8; kt++)
#pragma unroll
      for (int r = 0; r < 16; r++) { const float e = __expf((st[kt][r] - mx) * 0.0625f); st[kt][r] = e; sum += e; }
    sum += __shfl_xor(sum, 32, 64);
    const float inv = 1.0f / sum;
    bf16x8_t pf[8][2];
#pragma unroll
    for (int kt = 0; kt < 8; kt++)
#pragma unroll
      for (int s = 0; s < 2; s++)
#pragma unroll
        for (int j = 0; j < 8; j++) pf[kt][s][j] = (short)f2bf(st[kt][8 * s + j] * inv);
    __syncthreads();
    {
      const int r = tid_ >> 1, hf = tid_ & 1;
      const pg8::u32x4* src4 = (const pg8::u32x4*)(vT + ((size_t)(b * 4 + h) * 256 + r) * 256 + hf * 128);
      LAS pg8::u32x4* dst4 = (LAS pg8::u32x4*)(Ls + r * 264 + hf * 128);
#pragma unroll
      for (int k = 0; k < 16; k++) dst4[k] = src4[k];
    }
    __syncthreads();
#pragma unroll 1
    for (int dt = 0; dt < 8; dt++) {
      f32x16_t oacc;
#pragma unroll
      for (int r = 0; r < 16; r++) oacc[r] = 0.f;
      const LAS bf16* vrow = Ls + (dt * 32 + n) * 264 + 8 * hh;
#pragma unroll
      for (int kq = 0; kq < 4; kq++) {
        bf16x8_t vf[4];
#pragma unroll
        for (int i = 0; i < 4; i++) vf[i] = *(const LAS bf16x8_t*)(vrow + (kq * 2 + (i >> 1)) * 32 + 16 * (i & 1));
        MFMA_PAD();
#pragma unroll
        for (int i = 0; i < 4; i++) oacc = __builtin_amdgcn_mfma_f32_32x32x16_bf16(pf[kq * 2 + (i >> 1)][i & 1], vf[i], oacc, 0, 0, 0);
        MFMA_PAD();
      }
#pragma unroll
      for (int r = 0; r < 16; r++) {
        const int qi = (r & 3) + 8 * (r >> 2) + 4 * hh;
        o[(size_t)(tok0 + qi) * DM + h * 256 + dt * 32 + n] = (bf16)f2bf(oacc[r]);
      }
    }
  }
}

__device__ __forceinline__ void vt_phase(const int wave_s, const bf16* kvb, bf16* vT) {
  const int tid_ = opaque_tid(wave_s);
  const int gt = blockIdx.x * (NWAVES * 64) + tid_;
  const int nth = gridDim.x * NWAVES * 64;
  for (int i = gt; i < 2 * 4 * 4 * 256 * 256; i += nth) {
    const int m = i & 255, d = (i >> 8) & 255, h = (i >> 16) & 3, b = (i >> 18) & 3, l = i >> 20;
    vT[i] = kvb[((size_t)l * 1024 + b * 256 + m) * 2048 + 1024 + h * 256 + d];
  }
}

template <unsigned MASK>
__device__ __forceinline__ float pack_key(float s, unsigned idx) {
  const unsigned u = __builtin_bit_cast(unsigned, s);
  const unsigned tag = ((int)u < 0) ? idx : (MASK - idx);
  return __builtin_bit_cast(float, (u & ~MASK) + tag);
}
template <unsigned MASK>
__device__ __forceinline__ unsigned key_idx(float k) {
  const unsigned u = __builtin_bit_cast(unsigned, k);
  const unsigned tag = u & MASK;
  return ((int)u < 0) ? tag : (MASK - tag);
}
template <unsigned MASK>
__device__ __forceinline__ float key_val(float k) { return __builtin_bit_cast(float, __builtin_bit_cast(unsigned, k) & ~MASK); }
__device__ __forceinline__ void top16_of_64(float (&K)[64]) {
  { const float a_ = K[0], b_ = K[1]; const bool g_ = a_ > b_; K[0] = g_ ? a_ : b_; K[1] = g_ ? b_ : a_; }
  { const float a_ = K[2], b_ = K[3]; const bool g_ = a_ > b_; K[2] = g_ ? b_ : a_; K[3] = g_ ? a_ : b_; }
  { const float a_ = K[4], b_ = K[5]; const bool g_ = a_ > b_; K[4] = g_ ? a_ : b_; K[5] = g_ ? b_ : a_; }
  { const float a_ = K[6], b_ = K[7]; const bool g_ = a_ > b_; K[6] = g_ ? b_ : a_; K[7] = g_ ? a_ : b_; }
  { const float a_ = K[8], b_ = K[9]; const bool g_ = a_ > b_; K[8] = g_ ? a_ : b_; K[9] = g_ ? b_ : a_; }
  { const float a_ = K[10], b_ = K[11]; const bool g_ = a_ > b_; K[10] = g_ ? b_ : a_; K[11] = g_ ? a_ : b_; }
  { const float a_ = K[12], b_ = K[13]; const bool g_ = a_ > b_; K[12] = g_ ? a_ : b_; K[13] = g_ ? b_ : a_; }
  { const float a_ = K[14], b_ = K[15]; const bool g_ = a_ > b_; K[14] = g_ ? b_ : a_; K[15] = g_ ? a_ : b_; }
  { const float a_ = K[0], b_ = K[2]; const bool g_ = a_ > b_; K[0] = g_ ? a_ : b_; K[2] = g_ ? b_ : a_; }
  { const float a_ = K[1], b_ = K[3]; const bool g_ = a_ > b_; K[1] = g_ ? a_ : b_; K[3] = g_ ? b_ : a_; }
  { const float a_ = K[4], b_ = K[6]; const bool g_ = a_ > b_; K[4] = g_ ? b_ : a_; K[6] = g_ ? a_ : b_; }
  { const float a_ = K[5], b_ = K[7]; const bool g_ = a_ > b_; K[5] = g_ ? b_ : a_; K[7] = g_ ? a_ : b_; }
  { const float a_ = K[8], b_ = K[10]; const bool g_ = a_ > b_; K[8] = g_ ? a_ : b_; K[10] = g_ ? b_ : a_; }
  { const float a_ = K[9], b_ = K[11]; const bool g_ = a_ > b_; K[9] = g_ ? a_ : b_; K[11] = g_ ? b_ : a_; }
  { const float a_ = K[12], b_ = K[14]; const bool g_ = a_ > b_; K[12] = g_ ? b_ : a_; K[14] = g_ ? a_ : b_; }
  { const float a_ = K[13], b_ = K[15]; const bool g_ = a_ > b_; K[13] = g_ ? b_ : a_; K[15] = g_ ? a_ : b_; }
  { const float a_ = K[0], b_ = K[1]; const bool g_ = a_ > b_; K[0] = g_ ? a_ : b_; K[1] = g_ ? b_ : a_; }
  { const float a_ = K[2], b_ = K[3]; const bool g_ = a_ > b_; K[2] = g_ ? a_ : b_; K[3] = g_ ? b_ : a_; }
  { const float a_ = K[4], b_ = K[5]; const bool g_ = a_ > b_; K[4] = g_ ? b_ : a_; K[5] = g_ ? a_ : b_; }
  { const float a_ = K[6], b_ = K[7]; const bool g_ = a_ > b_; K[6] = g_ ? b_ : a_; K[7] = g_ ? a_ : b_; }
  { const float a_ = K[8], b_ = K[9]; const bool g_ = a_ > b_; K[8] = g_ ? a_ : b_; K[9] = g_ ? b_ : a_; }
  { const float a_ = K[10], b_ = K[11]; const bool g_ = a_ > b_; K[10] = g_ ? a_ : b_; K[11] = g_ ? b_ : a_; }
  { const float a_ = K[12], b_ = K[13]; const bool g_ = a_ > b_; K[12] = g_ ? b_ : a_; K[13] = g_ ? a_ : b_; }
  { const float a_ = K[14], b_ = K[15]; const bool g_ = a_ > b_; K[14] = g_ ? b_ : a_; K[15] = g_ ? a_ : b_; }
  { const float a_ = K[0], b_ = K[4]; const bool g_ = a_ > b_; K[0] = g_ ? a_ : b_; K[4] = g_ ? b_ : a_; }
  { const float a_ = K[1], b_ = K[5]; const bool g_ = a_ > b_; K[1] = g_ ? a_ : b_; K[5] = g_ ? b_ : a_; }
  { const float a_ = K[2], b_ = K[6]; const bool g_ = a_ > b_; K[2] = g_ ? a_ : b_; K[6] = g_ ? b_ : a_; }
  { const float a_ = K[3], b_ = K[7]; const bool g_ = a_ > b_; K[3] = g_ ? a_ : b_; K[7] = g_ ? b_ : a_; }
  { const float a_ = K[8], b_ = K[12]; const bool g_ = a_ > b_; K[8] = g_ ? b_ : a_; K[12] = g_ ? a_ : b_; }
  { const float a_ = K[9], b_ = K[13]; const bool g_ = a_ > b_; K[9] = g_ ? b_ : a_; K[13] = g_ ? a_ : b_; }
  { const float a_ = K[10], b_ = K[14]; const bool g_ = a_ > b_; K[10] = g_ ? b_ : a_; K[14] = g_ ? a_ : b_; }
  { const float a_ = K[11], b_ = K[15]; const bool g_ = a_ > b_; K[11] = g_ ? b_ : a_; K[15] = g_ ? a_ : b_; }
  { const float a_ = K[0], b_ = K[2]; const bool g_ = a_ > b_; K[0] = g_ ? a_ : b_; K[2] = g_ ? b_ : a_; }
  { const float a_ = K[1], b_ = K[3]; const bool g_ = a_ > b_; K[1] = g_ ? a_ : b_; K[3] = g_ ? b_ : a_; }
  { const float a_ = K[4], b_ = K[6]; const bool g_ = a_ > b_; K[4] = g_ ? a_ : b_; K[6] = g_ ? b_ : a_; }
  { const float a_ = K[5], b_ = K[7]; const bool g_ = a_ > b_; K[5] = g_ ? a_ : b_; K[7] = g_ ? b_ : a_; }
  { const float a_ = K[8], b_ = K[10]; const bool g_ = a_ > b_; K[8] = g_ ? b_ : a_; K[10] = g_ ? a_ : b_; }
  { const float a_ = K[9], b_ = K[11]; const bool g_ = a_ > b_; K[9] = g_ ? b_ : a_; K[11] = g_ ? a_ : b_; }
  { const float a_ = K[12], b_ = K[14]; const bool g_ = a_ > b_; K[12] = g_ ? b_ : a_; K[14] = g_ ? a_ : b_; }
  { const float a_ = K[13], b_ = K[15]; const bool g_ = a_ > b_; K[13] = g_ ? b_ : a_; K[15] = g_ ? a_ : b_; }
  { const float a_ = K[0], b_ = K[1]; const bool g_ = a_ > b_; K[0] = g_ ? a_ : b_; K[1] = g_ ? b_ : a_; }
  { const float a_ = K[2], b_ = K[3]; const bool g_ = a_ > b_; K[2] = g_ ? a_ : b_; K[3] = g_ ? b_ : a_; }
  { const float a_ = K[4], b_ = K[5]; const bool g_ = a_ > b_; K[4] = g_ ? a_ : b_; K[5] = g_ ? b_ : a_; }
  { const float a_ = K[6], b_ = K[7]; const bool g_ = a_ > b_; K[6] = g_ ? a_ : b_; K[7] = g_ ? b_ : a_; }
  { const float a_ = K[8], b_ = K[9]; const bool g_ = a_ > b_; K[8] = g_ ? b_ : a_; K[9] = g_ ? a_ : b_; }
  { const float a_ = K[10], b_ = K[11]; const bool g_ = a_ > b_; K[10] = g_ ? b_ : a_; K[11] = g_ ? a_ : b_; }
  { const float a_ = K[12], b_ = K[13]; const bool g_ = a_ > b_; K[12] = g_ ? b_ : a_; K[13] = g_ ? a_ : b_; }
  { const float a_ = K[14], b_ = K[15]; const bool g_ = a_ > b_; K[14] = g_ ? b_ : a_; K[15] = g_ ? a_ : b_; }
  { const float a_ = K[0], b_ = K[8]; const bool g_ = a_ > b_; K[0] = g_ ? a_ : b_; K[8] = g_ ? b_ : a_; }
  { const float a_ = K[1], b_ = K[9]; const bool g_ = a_ > b_; K[1] = g_ ? a_ : b_; K[9] = g_ ? b_ : a_; }
  { const float a_ = K[2], b_ = K[10]; const bool g_ = a_ > b_; K[2] = g_ ? a_ : b_; K[10] = g_ ? b_ : a_; }
  { const float a_ = K[3], b_ = K[11]; const bool g_ = a_ > b_; K[3] = g_ ? a_ : b_; K[11] = g_ ? b_ : a_; }
  { const float a_ = K[4], b_ = K[12]; const bool g_ = a_ > b_; K[4] = g_ ? a_ : b_; K[12] = g_ ? b_ : a_; }
  { const float a_ = K[5], b_ = K[13]; const bool g_ = a_ > b_; K[5] = g_ ? a_ : b_; K[13] = g_ ? b_ : a_; }
  { const float a_ = K[6], b_ = K[14]; const bool g_ = a_ > b_; K[6] = g_ ? a_ : b_; K[14] = g_ ? b_ : a_; }
  { const float a_ = K[7], b_ = K[15]; const bool g_ = a_ > b_; K[7] = g_ ? a_ : b_; K[15] = g_ ? b_ : a_; }
  { const float a_ = K[0], b_ = K[4]; const bool g_ = a_ > b_; K[0] = g_ ? a_ : b_; K[4] = g_ ? b_ : a_; }
  { const float a_ = K[1], b_ = K[5]; const bool g_ = a_ > b_; K[1] = g_ ? a_ : b_; K[5] = g_ ? b_ : a_; }
  { const float a_ = K[2], b_ = K[6]; const bool g_ = a_ > b_; K[2] = g_ ? a_ : b_; K[6] = g_ ? b_ : a_; }
  { const float a_ = K[3], b_ = K[7]; const bool g_ = a_ > b_; K[3] = g_ ? a_ : b_; K[7] = g_ ? b_ : a_; }
  { const float a_ = K[8], b_ = K[12]; const bool g_ = a_ > b_; K[8] = g_ ? a_ : b_; K[12] = g_ ? b_ : a_; }
  { const float a_ = K[9], b_ = K[13]; const bool g_ = a_ > b_; K[9] = g_ ? a_ : b_; K[13] = g_ ? b_ : a_; }
  { const float a_ = K[10], b_ = K[14]; const bool g_ = a_ > b_; K[10] = g_ ? a_ : b_; K[14] = g_ ? b_ : a_; }
  { const float a_ = K[11], b_ = K[15]; const bool g_ = a_ > b_; K[11] = g_ ? a_ : b_; K[15] = g_ ? b_ : a_; }
  { const float a_ = K[0], b_ = K[2]; const bool g_ = a_ > b_; K[0] = g_ ? a_ : b_; K[2] = g_ ? b_ : a_; }
  { const float a_ = K[1], b_ = K[3]; const bool g_ = a_ > b_; K[1] = g_ ? a_ : b_; K[3] = g_ ? b_ : a_; }
  { const float a_ = K[4], b_ = K[6]; const bool g_ = a_ > b_; K[4] = g_ ? a_ : b_; K[6] = g_ ? b_ : a_; }
  { const float a_ = K[5], b_ = K[7]; const bool g_ = a_ > b_; K[5] = g_ ? a_ : b_; K[7] = g_ ? b_ : a_; }
  { const float a_ = K[8], b_ = K[10]; const bool g_ = a_ > b_; K[8] = g_ ? a_ : b_; K[10] = g_ ? b_ : a_; }
  { const float a_ = K[9], b_ = K[11]; const bool g_ = a_ > b_; K[9] = g_ ? a_ : b_; K[11] = g_ ? b_ : a_; }
  { const float a_ = K[12], b_ = K[14]; const bool g_ = a_ > b_; K[12] = g_ ? a_ : b_; K[14] = g_ ? b_ : a_; }
  { const float a_ = K[13], b_ = K[15]; const bool g_ = a_ > b_; K[13] = g_ ? a_ : b_; K[15] = g_ ? b_ : a_; }
  { const float a_ = K[0], b_ = K[1]; const bool g_ = a_ > b_; K[0] = g_ ? a_ : b_; K[1] = g_ ? b_ : a_; }
  { const float a_ = K[2], b_ = K[3]; const bool g_ = a_ > b_; K[2] = g_ ? a_ : b_; K[3] = g_ ? b_ : a_; }
  { const float a_ = K[4], b_ = K[5]; const bool g_ = a_ > b_; K[4] = g_ ? a_ : b_; K[5] = g_ ? b_ : a_; }
  { const float a_ = K[6], b_ = K[7]; const bool g_ = a_ > b_; K[6] = g_ ? a_ : b_; K[7] = g_ ? b_ : a_; }
  { const float a_ = K[8], b_ = K[9]; const bool g_ = a_ > b_; K[8] = g_ ? a_ : b_; K[9] = g_ ? b_ : a_; }
  { const float a_ = K[10], b_ = K[11]; const bool g_ = a_ > b_; K[10] = g_ ? a_ : b_; K[11] = g_ ? b_ : a_; }
  { const float a_ = K[12], b_ = K[13]; const bool g_ = a_ > b_; K[12] = g_ ? a_ : b_; K[13] = g_ ? b_ : a_; }
  { const float a_ = K[14], b_ = K[15]; const bool g_ = a_ > b_; K[14] = g_ ? a_ : b_; K[15] = g_ ? b_ : a_; }
  { const float a_ = K[16], b_ = K[17]; const bool g_ = a_ > b_; K[16] = g_ ? a_ : b_; K[17] = g_ ? b_ : a_; }
  { const float a_ = K[18], b_ = K[19]; const bool g_ = a_ > b_; K[18] = g_ ? b_ : a_; K[19] = g_ ? a_ : b_; }
  { const float a_ = K[20], b_ = K[21]; const bool g_ = a_ > b_; K[20] = g_ ? a_ : b_; K[21] = g_ ? b_ : a_; }
  { const float a_ = K[22], b_ = K[23]; const bool g_ = a_ > b_; K[22] = g_ ? b_ : a_; K[23] = g_ ? a_ : b_; }
  { const float a_ = K[24], b_ = K[25]; const bool g_ = a_ > b_; K[24] = g_ ? a_ : b_; K[25] = g_ ? b_ : a_; }
  { const float a_ = K[26], b_ = K[27]; const bool g_ = a_ > b_; K[26] = g_ ? b_ : a_; K[27] = g_ ? a_ : b_; }
  { const float a_ = K[28], b_ = K[29]; const bool g_ = a_ > b_; K[28] = g_ ? a_ : b_; K[29] = g_ ? b_ : a_; }
  { const float a_ = K[30], b_ = K[31]; const bool g_ = a_ > b_; K[30] = g_ ? b_ : a_; K[31] = g_ ? a_ : b_; }
  { const float a_ = K[16], b_ = K[18]; const bool g_ = a_ > b_; K[16] = g_ ? a_ : b_; K[18] = g_ ? b_ : a_; }
  { const float a_ = K[17], b_ = K[19]; const bool g_ = a_ > b_; K[17] = g_ ? a_ : b_; K[19] = g_ ? b_ : a_; }
  { const float a_ = K[20], b_ = K[22]; const bool g_ = a_ > b_; K[20] = g_ ? b_ : a_; K[22] = g_ ? a_ : b_; }
  { const float a_ = K[21], b_ = K[23]; const bool g_ = a_ > b_; K[21] = g_ ? b_ : a_; K[23] = g_ ? a_ : b_; }
  { const float a_ = K[24], b_ = K[26]; const bool g_ = a_ > b_; K[24] = g_ ? a_ : b_; K[26] = g_ ? b_ : a_; }
  { const float a_ = K[25], b_ = K[27]; const bool g_ = a_ > b_; K[25] = g_ ? a_ : b_; K[27] = g_ ? b_ : a_; }
  { const float a_ = K[28], b_ = K[30]; const bool g_ = a_ > b_; K[28] = g_ ? b_ : a_; K[30] = g_ ? a_ : b_; }
  { const float a_ = K[29], b_ = K[31]; const bool g_ = a_ > b_; K[29] = g_ ? b_ : a_; K[31] = g_ ? a_ : b_; }
  { const float a_ = K[16], b_ = K[17]; const bool g_ = a_ > b_; K[16] = g_ ? a_ : b_; K[17] = g_ ? b_ : a_; }
  { const float a_ = K[18], b_ = K[19]; const bool g_ = a_ > b_; K[18] = g_ ? a_ : b_; K[19] = g_ ? b_ : a_; }
  { const float a_ = K[20], b_ = K[21]; const bool g_ = a_ > b_; K[20] = g_ ? b_ : a_; K[21] = g_ ? a_ : b_; }
  { const float a_ = K[22], b_ = K[23]; const bool g_ = a_ > b_; K[22] = g_ ? b_ : a_; K[23] = g_ ? a_ : b_; }
  { const float a_ = K[24], b_ = K[25]; const bool g_ = a_ > b_; K[24] = g_ ? a_ : b_; K[25] = g_ ? b_ : a_; }
  { const float a_ = K[26], b_ = K[27]; const bool g_ = a_ > b_; K[26] = g_ ? a_ : b_; K[27] = g_ ? b_ : a_; }
  { const float a_ = K[28], b_ = K[29]; const bool g_ = a_ > b_; K[28] = g_ ? b_ : a_; K[29] = g_ ? a_ : b_; }
  { const float a_ = K[30], b_ = K[31]; const bool g_ = a_ > b_; K[30] = g_ ? b_ : a_; K[31] = g_ ? a_ : b_; }
  { const float a_ = K[16], b_ = K[20]; const bool g_ = a_ > b_; K[16] = g_ ? a_ : b_; K[20] = g_ ? b_ : a_; }
  { const float a_ = K[17], b_ = K[21]; const bool g_ = a_ > b_; K[17] = g_ ? a_ : b_; K[21] = g_ ? b_ : a_; }
  { const float a_ = K[18], b_ = K[22]; const bool g_ = a_ > b_; K[18] = g_ ? a_ : b_; K[22] = g_ ? b_ : a_; }
  { const float a_ = K[19], b_ = K[23]; const bool g_ = a_ > b_; K[19] = g_ ? a_ : b_; K[23] = g_ ? b_ : a_; }
  { const float a_ = K[24], b_ = K[28]; const bool g_ = a_ > b_; K[24] = g_ ? b_ : a_; K[28] = g_ ? a_ : b_; }
  { const float a_ = K[25], b_ = K[29]; const bool g_ = a_ > b_; K[25] = g_ ? b_ : a_; K[29] = g_ ? a_ : b_; }
  { const float a_ = K[26], b_ = K[30]; const bool g_ = a_ > b_; K[26] = g_ ? b_ : a_; K[30] = g_ ? a_ : b_; }
  { const float a_ = K[27], b_ = K[31]; const bool g_ = a_ > b_; K[27] = g_ ? b_ : a_; K[31] = g_ ? a_ : b_; }
  { const float a_ = K[16], b_ = K[18]; const bool g_ = a_ > b_; K[16] = g_ ? a_ : b_; K[18] = g_ ? b_ : a_; }
  { const float a_ = K[17], b_ = K[19]; const bool g_ = a_ > b_; K[17] = g_ ? a_ : b_; K[19] = g_ ? b_ : a_; }
  { const float a_ = K[20], b_ = K[22]; const bool g_ = a_ > b_; K[20] = g_ ? a_ : b_; K[22] = g_ ? b_ : a_; }
  { const float a_ = K[21], b_ = K[23]; const bool g_ = a_ > b_; K[21] = g_ ? a_ : b_; K[23] = g_ ? b_ : a_; }
  { const float a_ = K[24], b_ = K[26]; const bool g_ = a_ > b_; K[24] = g_ ? b_ : a_; K[26] = g_ ? a_ : b_; }
  { const float a_ = K[25], b_ = K[27]; const bool g_ = a_ > b_; K[25] = g_ ? b_ : a_; K[27] = g_ ? a_ : b_; }
  { const float a_ = K[28], b_ = K[30]; const bool g_ = a_ > b_; K[28] = g_ ? b_ : a_; K[30] = g_ ? a_ : b_; }
  { const float a_ = K[29], b_ = K[31]; const bool g_ = a_ > b_; K[29] = g_ ? b_ : a_; K[31] = g_ ? a_ : b_; }
  { const float a_ = K[16], b_ = K[17]; const bool g_ = a_ > b_; K[16] = g_ ? a_ : b_; K[17] = g_ ? b_ : a_; }
  { const float a_ = K[18], b_ = K[19]; const bool g_ = a_ > b_; K[18] = g_ ? a_ : b_; K[19] = g_ ? b_ : a_; }
  { const float a_ = K[20], b_ = K[21]; const bool g_ = a_ > b_; K[20] = g_ ? a_ : b_; K[21] = g_ ? b_ : a_; }
  { const float a_ = K[22], b_ = K[23]; const bool g_ = a_ > b_; K[22] = g_ ? a_ : b_; K[23] = g_ ? b_ : a_; }
  { const float a_ = K[24], b_ = K[25]; const bool g_ = a_ > b_; K[24] = g_ ? b_ : a_; K[25] = g_ ? a_ : b_; }
  { const float a_ = K[26], b_ = K[27]; const bool g_ = a_ > b_; K[26] = g_ ? b_ : a_; K[27] = g_ ? a_ : b_; }
  { const float a_ = K[28], b_ = K[29]; const bool g_ = a_ > b_; K[28] = g_ ? b_ : a_; K[29] = g_ ? a_ : b_; }
  { const float a_ = K[30], b_ = K[31]; const bool g_ = a_ > b_; K[30] = g_ ? b_ : a_; K[31] = g_ ? a_ : b_; }
  { const float a_ = K[16], b_ = K[24]; const bool g_ = a_ > b_; K[16] = g_ ? a_ : b_; K[24] = g_ ? b_ : a_; }
  { const float a_ = K[17], b_ = K[25]; const bool g_ = a_ > b_; K[17] = g_ ? a_ : b_; K[25] = g_ ? b_ : a_; }
  { const float a_ = K[18], b_ = K[26]; const bool g_ = a_ > b_; K[18] = g_ ? a_ : b_; K[26] = g_ ? b_ : a_; }
  { const float a_ = K[19], b_ = K[27]; const bool g_ = a_ > b_; K[19] = g_ ? a_ : b_; K[27] = g_ ? b_ : a_; }
  { const float a_ = K[20], b_ = K[28]; const bool g_ = a_ > b_; K[20] = g_ ? a_ : b_; K[28] = g_ ? b_ : a_; }
  { const float a_ = K[21], b_ = K[29]; const bool g_ = a_ > b_; K[21] = g_ ? a_ : b_; K[29] = g_ ? b_ : a_; }
  { const float a_ = K[22], b_ = K[30]; const bool g_ = a_ > b_; K[22] = g_ ? a_ : b_; K[30] = g_ ? b_ : a_; }
  { const float a_ = K[23], b_ = K[31]; const bool g_ = a_ > b_; K[23] = g_ ? a_ : b_; K[31] = g_ ? b_ : a_; }
  { const float a_ = K[16], b_ = K[20]; const bool g_ = a_ > b_; K[16] = g_ ? a_ : b_; K[20] = g_ ? b_ : a_; }
  { const float a_ = K[17], b_ = K[21]; const bool g_ = a_ > b_; K[17] = g_ ? a_ : b_; K[21] = g_ ? b_ : a_; }
  { const float a_ = K[18], b_ = K[22]; const bool g_ = a_ > b_; K[18] = g_ ? a_ : b_; K[22] = g_ ? b_ : a_; }
  { const float a_ = K[19], b_ = K[23]; const bool g_ = a_ > b_; K[19] = g_ ? a_ : b_; K[23] = g_ ? b_ : a_; }
  { const float a_ = K[24], b_ = K[28]; const bool g_ = a_ > b_; K[24] = g_ ? a_ : b_; K[28] = g_ ? b_ : a_; }
  { const float a_ = K[25], b_ = K[29]; const bool g_ = a_ > b_; K[25] = g_ ? a_ : b_; K[29] = g_ ? b_ : a_; }
  { const float a_ = K[26], b_ = K[30]; const bool g_ = a_ > b_; K[26] = g_ ? a_ : b_; K[30] = g_ ? b_ : a_; }
  { const float a_ = K[27], b_ = K[31]; const bool g_ = a_ > b_; K[27] = g_ ? a_ : b_; K[31] = g_ ? b_ : a_; }
  { const float a_ = K[16], b_ = K[18]; const bool g_ = a_ > b_; K[16] = g_ ? a_ : b_; K[18] = g_ ? b_ : a_; }
  { const float a_ = K[17], b_ = K[19]; const bool g_ = a_ > b_; K[17] = g_ ? a_ : b_; K[19] = g_ ? b_ : a_; }
  { const float a_ = K[20], b_ = K[22]; const bool g_ = a_ > b_; K[20] = g_ ? a_ : b_; K[22] = g_ ? b_ : a_; }
  { const float a_ = K[21], b_ = K[23]; const bool g_ = a_ > b_; K[21] = g_ ? a_ : b_; K[23] = g_ ? b_ : a_; }
  { const float a_ = K[24], b_ = K[26]; const bool g_ = a_ > b_; K[24] = g_ ? a_ : b_; K[26] = g_ ? b_ : a_; }
  { const float a_ = K[25], b_ = K[27]; const bool g_ = a_ > b_; K[25] = g_ ? a_ : b_; K[27] = g_ ? b_ : a_; }
  { const float a_ = K[28], b_ = K[30]; const bool g_ = a_ > b_; K[28] = g_ ? a_ : b_; K[30] = g_ ? b_ : a_; }
  { const float a_ = K[29], b_ = K[31]; const bool g_ = a_ > b_; K[29] = g_ ? a_ : b_; K[31] = g_ ? b_ : a_; }
  { const float a_ = K[16], b_ = K[17]; const bool g_ = a_ > b_; K[16] = g_ ? a_ : b_; K[17] = g_ ? b_ : a_; }
  { const float a_ = K[18], b_ = K[19]; const bool g_ = a_ > b_; K[18] = g_ ? a_ : b_; K[19] = g_ ? b_ : a_; }
  { const float a_ = K[20], b_ = K[21]; const bool g_ = a_ > b_; K[20] = g_ ? a_ : b_; K[21] = g_ ? b_ : a_; }
  { const float a_ = K[22], b_ = K[23]; const bool g_ = a_ > b_; K[22] = g_ ? a_ : b_; K[23] = g_ ? b_ : a_; }
  { const float a_ = K[24], b_ = K[25]; const bool g_ = a_ > b_; K[24] = g_ ? a_ : b_; K[25] = g_ ? b_ : a_; }
  { const float a_ = K[26], b_ = K[27]; const bool g_ = a_ > b_; K[26] = g_ ? a_ : b_; K[27] = g_ ? b_ : a_; }
  { const float a_ = K[28], b_ = K[29]; const bool g_ = a_ > b_; K[28] = g_ ? a_ : b_; K[29] = g_ ? b_ : a_; }
  { const float a_ = K[30], b_ = K[31]; const bool g_ = a_ > b_; K[30] = g_ ? a_ : b_; K[31] = g_ ? b_ : a_; }
  { const float a_ = K[32], b_ = K[33]; const bool g_ = a_ > b_; K[32] = g_ ? a_ : b_; K[33] = g_ ? b_ : a_; }
  { const float a_ = K[34], b_ = K[35]; const bool g_ = a_ > b_; K[34] = g_ ? b_ : a_; K[35] = g_ ? a_ : b_; }
  { const float a_ = K[36], b_ = K[37]; const bool g_ = a_ > b_; K[36] = g_ ? a_ : b_; K[37] = g_ ? b_ : a_; }
  { const float a_ = K[38], b_ = K[39]; const bool g_ = a_ > b_; K[38] = g_ ? b_ : a_; K[39] = g_ ? a_ : b_; }
  { const float a_ = K[40], b_ = K[41]; const bool g_ = a_ > b_; K[40] = g_ ? a_ : b_; K[41] = g_ ? b_ : a_; }
  { const float a_ = K[42], b_ = K[43]; const bool g_ = a_ > b_; K[42] = g_ ? b_ : a_; K[43] = g_ ? a_ : b_; }
  { const float a_ = K[44], b_ = K[45]; const bool g_ = a_ > b_; K[44] = g_ ? a_ : b_; K[45] = g_ ? b_ : a_; }
  { const float a_ = K[46], b_ = K[47]; const bool g_ = a_ > b_; K[46] = g_ ? b_ : a_; K[47] = g_ ? a_ : b_; }
  { const float a_ = K[32], b_ = K[34]; const bool g_ = a_ > b_; K[32] = g_ ? a_ : b_; K[34] = g_ ? b_ : a_; }
  { const float a_ = K[33], b_ = K[35]; const bool g_ = a_ > b_; K[33] = g_ ? a_ : b_; K[35] = g_ ? b_ : a_; }
  { const float a_ = K[36], b_ = K[38]; const bool g_ = a_ > b_; K[36] = g_ ? b_ : a_; K[38] = g_ ? a_ : b_; }
  { const float a_ = K[37], b_ = K[39]; const bool g_ = a_ > b_; K[37] = g_ ? b_ : a_; K[39] = g_ ? a_ : b_; }
  { const float a_ = K[40], b_ = K[42]; const bool g_ = a_ > b_; K[40] = g_ ? a_ : b_; K[42] = g_ ? b_ : a_; }
  { const float a_ = K[41], b_ = K[43]; const bool g_ = a_ > b_; K[41] = g_ ? a_ : b_; K[43] = g_ ? b_ : a_; }
  { const float a_ = K[44], b_ = K[46]; const bool g_ = a_ > b_; K[44] = g_ ? b_ : a_; K[46] = g_ ? a_ : b_; }
  { const float a_ = K[45], b_ = K[47]; const bool g_ = a_ > b_; K[45] = g_ ? b_ : a_; K[47] = g_ ? a_ : b_; }
  { const float a_ = K[32], b_ = K[33]; const bool g_ = a_ > b_; K[32] = g_ ? a_ : b_; K[33] = g_ ? b_ : a_; }
  { const float a_ = K[34], b_ = K[35]; const bool g_ = a_ > b_; K[34] = g_ ? a_ : b_; K[35] = g_ ? b_ : a_; }
  { const float a_ = K[36], b_ = K[37]; const bool g_ = a_ > b_; K[36] = g_ ? b_ : a_; K[37] = g_ ? a_ : b_; }
  { const float a_ = K[38], b_ = K[39]; const bool g_ = a_ > b_; K[38] = g_ ? b_ : a_; K[39] = g_ ? a_ : b_; }
  { const float a_ = K[40], b_ = K[41]; const bool g_ = a_ > b_; K[40] = g_ ? a_ : b_; K[41] = g_ ? b_ : a_; }
  { const float a_ = K[42], b_ = K[43]; const bool g_ = a_ > b_; K[42] = g_ ? a_ : b_; K[43] = g_ ? b_ : a_; }
  { const float a_ = K[44], b_ = K[45]; const bool g_ = a_ > b_; K[44] = g_ ? b_ : a_; K[45] = g_ ? a_ : b_; }
  { const float a_ = K[46], b_ = K[47]; const bool g_ = a_ > b_; K[46] = g_ ? b_ : a_; K[47] = g_ ? a_ : b_; }
  { const float a_ = K[32], b_ = K[36]; const bool g_ = a_ > b_; K[32] = g_ ? a_ : b_; K[36] = g_ ? b_ : a_; }
  { const float a_ = K[33], b_ = K[37]; const bool g_ = a_ > b_; K[33] = g_ ? a_ : b_; K[37] = g_ ? b_ : a_; }
  { const float a_ = K[34], b_ = K[38]; const bool g_ = a_ > b_; K[34] = g_ ? a_ : b_; K[38] = g_ ? b_ : a_; }
  { const float a_ = K[35], b_ = K[39]; const bool g_ = a_ > b_; K[35] = g_ ? a_ : b_; K[39] = g_ ? b_ : a_; }
  { const float a_ = K[40], b_ = K[44]; const bool g_ = a_ > b_; K[40] = g_ ? b_ : a_; K[44] = g_ ? a_ : b_; }
  { const float a_ = K[41], b_ = K[45]; const bool g_ = a_ > b_; K[41] = g_ ? b_ : a_; K[45] = g_ ? a_ : b_; }
  { const float a_ = K[42], b_ = K[46]; const bool g_ = a_ > b_; K[42] = g_ ? b_ : a_; K[46] = g_ ? a_ : b_; }
  { const float a_ = K[43], b_ = K[47]; const bool g_ = a_ > b_; K[43] = g_ ? b_ : a_; K[47] = g_ ? a_ : b_; }
  { const float a_ = K[32], b_ = K[34]; const bool g_ = a_ > b_; K[32] = g_ ? a_ : b_; K[34] = g_ ? b_ : a_; }
  { const float a_ = K[33], b_ = K[35]; const bool g_ = a_ > b_; K[33] = g_ ? a_ : b_; K[35] = g_ ? b_ : a_; }
  { const float a_ = K[36], b_ = K[38]; const bool g_ = a_ > b_; K[36] = g_ ? a_ : b_; K[38] = g_ ? b_ : a_; }
  { const float a_ = K[37], b_ = K[39]; const bool g_ = a_ > b_; K[37] = g_ ? a_ : b_; K[39] = g_ ? b_ : a_; }
  { const float a_ = K[40], b_ = K[42]; const bool g_ = a_ > b_; K[40] = g_ ? b_ : a_; K[42] = g_ ? a_ : b_; }
  { const float a_ = K[41], b_ = K[43]; const bool g_ = a_ > b_; K[41] = g_ ? b_ : a_; K[43] = g_ ? a_ : b_; }
  { const float a_ = K[44], b_ = K[46]; const bool g_ = a_ > b_; K[44] = g_ ? b_ : a_; K[46] = g_ ? a_ : b_; }
  { const float a_ = K[45], b_ = K[47]; const bool g_ = a_ > b_; K[45] = g_ ? b_ : a_; K[47] = g_ ? a_ : b_; }
  { const float a_ = K[32], b_ = K[33]; const bool g_ = a_ > b_; K[32] = g_ ? a_ : b_; K[33] = g_ ? b_ : a_; }
  { const float a_ = K[34], b_ = K[35]; const bool g_ = a_ > b_; K[34] = g_ ? a_ : b_; K[35] = g_ ? b_ : a_; }
  { const float a_ = K[36], b_ = K[37]; const bool g_ = a_ > b_; K[36] = g_ ? a_ : b_; K[37] = g_ ? b_ : a_; }
  { const float a_ = K[38], b_ = K[39]; const bool g_ = a_ > b_; K[38] = g_ ? a_ : b_; K[39] = g_ ? b_ : a_; }
  { const float a_ = K[40], b_ = K[41]; const bool g_ = a_ > b_; K[40] = g_ ? b_ : a_; K[41] = g_ ? a_ : b_; }
  { const float a_ = K[42], b_ = K[43]; const bool g_ = a_ > b_; K[42] = g_ ? b_ : a_; K[43] = g_ ? a_ : b_; }
  { const float a_ = K[44], b_ = K[45]; const bool g_ = a_ > b_; K[44] = g_ ? b_ : a_; K[45] = g_ ? a_ : b_; }
  { const float a_ = K[46], b_ = K[47]; const bool g_ = a_ > b_; K[46] = g_ ? b_ : a_; K[47] = g_ ? a_ : b_; }
  { const float a_ = K[32], b_ = K[40]; const bool g_ = a_ > b_; K[32] = g_ ? a_ : b_; K[40] = g_ ? b_ : a_; }
  { const float a_ = K[33], b_ = K[41]; const bool g_ = a_ > b_; K[33] = g_ ? a_ : b_; K[41] = g_ ? b_ : a_; }
  { const float a_ = K[34], b_ = K[42]; const bool g_ = a_ > b_; K[34] = g_ ? a_ : b_; K[42] = g_ ? b_ : a_; }
  { const float a_ = K[35], b_ = K[43]; const bool g_ = a_ > b_; K[35] = g_ ? a_ : b_; K[43] = g_ ? b_ : a_; }
  { const float a_ = K[36], b_ = K[44]; const bool g_ = a_ > b_; K[36] = g_ ? a_ : b_; K[44] = g_ ? b_ : a_; }
  { const float a_ = K[37], b_ = K[45]; const bool g_ = a_ > b_; K[37] = g_ ? a_ : b_; K[45] = g_ ? b_ : a_; }
  { const float a_ = K[38], b_ = K[46]; const bool g_ = a_ > b_; K[38] = g_ ? a_ : b_; K[46] = g_ ? b_ : a_; }
  { const float a_ = K[39], b_ = K[47]; const bool g_ = a_ > b_; K[39] = g_ ? a_ : b_; K[47] = g_ ? b_ : a_; }
  { const float a_ = K[32], b_ = K[36]; const bool g_ = a_ > b_; K[32] = g_ ? a_ : b_; K[36] = g_ ? b_ : a_; }
  { const float a_ = K[33], b_ = K[37]; const bool g_ = a_ > b_; K[33] = g_ ? a_ : b_; K[37] = g_ ? b_ : a_; }
  { const float a_ = K[34], b_ = K[38]; const bool g_ = a_ > b_; K[34] = g_ ? a_ : b_; K[38] = g_ ? b_ : a_; }
  { const float a_ = K[35], b_ = K[39]; const bool g_ = a_ > b_; K[35] = g_ ? a_ : b_; K[39] = g_ ? b_ : a_; }
  { const float a_ = K[40], b_ = K[44]; const bool g_ = a_ > b_; K[40] = g_ ? a_ : b_; K[44] = g_ ? b_ : a_; }
  { const float a_ = K[41], b_ = K[45]; const bool g_ = a_ > b_; K[41] = g_ ? a_ : b_; K[45] = g_ ? b_ : a_; }
  { const float a_ = K[42], b_ = K[46]; const bool g_ = a_ > b_; K[42] = g_ ? a_ : b_; K[46] = g_ ? b_ : a_; }
  { const float a_ = K[43], b_ = K[47]; const bool g_ = a_ > b_; K[43] = g_ ? a_ : b_; K[47] = g_ ? b_ : a_; }
  { const float a_ = K[32], b_ = K[34]; const bool g_ = a_ > b_; K[32] = g_ ? a_ : b_; K[34] = g_ ? b_ : a_; }
  { const float a_ = K[33], b_ = K[35]; const bool g_ = a_ > b_; K[33] = g_ ? a_ : b_; K[35] = g_ ? b_ : a_; }
  { const float a_ = K[36], b_ = K[38]; const bool g_ = a_ > b_; K[36] = g_ ? a_ : b_; K[38] = g_ ? b_ : a_; }
  { const float a_ = K[37], b_ = K[39]; const bool g_ = a_ > b_; K[37] = g_ ? a_ : b_; K[39] = g_ ? b_ : a_; }
  { const float a_ = K[40], b_ = K[42]; const bool g_ = a_ > b_; K[40] = g_ ? a_ : b_; K[42] = g_ ? b_ : a_; }
  { const float a_ = K[41], b_ = K[43]; const bool g_ = a_ > b_; K[41] = g_ ? a_ : b_; K[43] = g_ ? b_ : a_; }
  { const float a_ = K[44], b_ = K[46]; const bool g_ = a_ > b_; K[44] = g_ ? a_ : b_; K[46] = g_ ? b_ : a_; }
  { const float a_ = K[45], b_ = K[47]; const bool g_ = a_ > b_; K[45] = g_ ? a_ : b_; K[47] = g_ ? b_ : a_; }
  { const float a_ = K[32], b_ = K[33]; const bool g_ = a_ > b_; K[32] = g_ ? a_ : b_; K[33] = g_ ? b_ : a_; }
  { const float a_ = K[34], b_ = K[35]; const bool g_ = a_ > b_; K[34] = g_ ? a_ : b_; K[35] = g_ ? b_ : a_; }
  { const float a_ = K[36], b_ = K[37]; const bool g_ = a_ > b_; K[36] = g_ ? a_ : b_; K[37] = g_ ? b_ : a_; }
  { const float a_ = K[38], b_ = K[39]; const bool g_ = a_ > b_; K[38] = g_ ? a_ : b_; K[39] = g_ ? b_ : a_; }
  { const float a_ = K[40], b_ = K[41]; const bool g_ = a_ > b_; K[40] = g_ ? a_ : b_; K[41] = g_ ? b_ : a_; }
  { const float a_ = K[42], b_ = K[43]; const bool g_ = a_ > b_; K[42] = g_ ? a_ : b_; K[43] = g_ ? b_ : a_; }
  { const float a_ = K[44], b_ = K[45]; const bool g_ = a_ > b_; K[44] = g_ ? a_ : b_; K[45] = g_ ? b_ : a_; }
  { const float a_ = K[46], b_ = K[47]; const bool g_ = a_ > b_; K[46] = g_ ? a_ : b_; K[47] = g_ ? b_ : a_; }
  { const float a_ = K[48], b_ = K[49]; const bool g_ = a_ > b_; K[48] = g_ ? a_ : b_; K[49] = g_ ? b_ : a_; }
  { const float a_ = K[50], b_ = K[51]; const bool g_ = a_ > b_; K[50] = g_ ? b_ : a_; K[51] = g_ ? a_ : b_; }
  { const float a_ = K[52], b_ = K[53]; const bool g_ = a_ > b_; K[52] = g_ ? a_ : b_; K[53] = g_ ? b_ : a_; }
  { const float a_ = K[54], b_ = K[55]; const bool g_ = a_ > b_; K[54] = g_ ? b_ : a_; K[55] = g_ ? a_ : b_; }
  { const float a_ = K[56], b_ = K[57]; const bool g_ = a_ > b_; K[56] = g_ ? a_ : b_; K[57] = g_ ? b_ : a_; }
  { const float a_ = K[58], b_ = K[59]; const bool g_ = a_ > b_; K[58] = g_ ? b_ : a_; K[59] = g_ ? a_ : b_; }
  { const float a_ = K[60], b_ = K[61]; const bool g_ = a_ > b_; K[60] = g_ ? a_ : b_; K[61] = g_ ? b_ : a_; }
  { const float a_ = K[62], b_ = K[63]; const bool g_ = a_ > b_; K[62] = g_ ? b_ : a_; K[63] = g_ ? a_ : b_; }
  { const float a_ = K[48], b_ = K[50]; const bool g_ = a_ > b_; K[48] = g_ ? a_ : b_; K[50] = g_ ? b_ : a_; }
  { const float a_ = K[49], b_ = K[51]; const bool g_ = a_ > b_; K[49] = g_ ? a_ : b_; K[51] = g_ ? b_ : a_; }
  { const float a_ = K[52], b_ = K[54]; const bool g_ = a_ > b_; K[52] = g_ ? b_ : a_; K[54] = g_ ? a_ : b_; }
  { const float a_ = K[53], b_ = K[55]; const bool g_ = a_ > b_; K[53] = g_ ? b_ : a_; K[55] = g_ ? a_ : b_; }
  { const float a_ = K[56], b_ = K[58]; const bool g_ = a_ > b_; K[56] = g_ ? a_ : b_; K[58] = g_ ? b_ : a_; }
  { const float a_ = K[57], b_ = K[59]; const bool g_ = a_ > b_; K[57] = g_ ? a_ : b_; K[59] = g_ ? b_ : a_; }
  { const float a_ = K[60], b_ = K[62]; const bool g_ = a_ > b_; K[60] = g_ ? b_ : a_; K[62] = g_ ? a_ : b_; }
  { const float a_ = K[61], b_ = K[63]; const bool g_ = a_ > b_; K[61] = g_ ? b_ : a_; K[63] = g_ ? a_ : b_; }
  { const float a_ = K[48], b_ = K[49]; const bool g_ = a_ > b_; K[48] = g_ ? a_ : b_; K[49] = g_ ? b_ : a_; }
  { const float a_ = K[50], b_ = K[51]; const bool g_ = a_ > b_; K[50] = g_ ? a_ : b_; K[51] = g_ ? b_ : a_; }
  { const float a_ = K[52], b_ = K[53]; const bool g_ = a_ > b_; K[52] = g_ ? b_ : a_; K[53] = g_ ? a_ : b_; }
  { const float a_ = K[54], b_ = K[55]; const bool g_ = a_ > b_; K[54] = g_ ? b_ : a_; K[55] = g_ ? a_ : b_; }
  { const float a_ = K[56], b_ = K[57]; const bool g_ = a_ > b_; K[56] = g_ ? a_ : b_; K[57] = g_ ? b_ : a_; }
  { const float a_ = K[58], b_ = K[59]; const bool g_ = a_ > b_; K[58] = g_ ? a_ : b_; K[59] = g_ ? b_ : a_; }
  { const float a_ = K[60], b_ = K[61]; const bool g_ = a_ > b_; K[60] = g_ ? b_ : a_; K[61] = g_ ? a_ : b_; }
  { const float a_ = K[62], b_ = K[63]; const bool g_ = a_ > b_; K[62] = g_ ? b_ : a_; K[63] = g_ ? a_ : b_; }
  { const float a_ = K[48], b_ = K[52]; const bool g_ = a_ > b_; K[48] = g_ ? a_ : b_; K[52] = g_ ? b_ : a_; }
  { const float a_ = K[49], b_ = K[53]; const bool g_ = a_ > b_; K[49] = g_ ? a_ : b_; K[53] = g_ ? b_ : a_; }
  { const float a_ = K[50], b_ = K[54]; const bool g_ = a_ > b_; K[50] = g_ ? a_ : b_; K[54] = g_ ? b_ : a_; }
  { const float a_ = K[51], b_ = K[55]; const bool g_ = a_ > b_; K[51] = g_ ? a_ : b_; K[55] = g_ ? b_ : a_; }
  { const float a_ = K[56], b_ = K[60]; const bool g_ = a_ > b_; K[56] = g_ ? b_ : a_; K[60] = g_ ? a_ : b_; }
  { const float a_ = K[57], b_ = K[61]; const bool g_ = a_ > b_; K[57] = g_ ? b_ : a_; K[61] = g_ ? a_ : b_; }
  { const float a_ = K[58], b_ = K[62]; const bool g_ = a_ > b_; K[58] = g_ ? b_ : a_; K[62] = g_ ? a_ : b_; }
  { const float a_ = K[59], b_ = K[63]; const bool g_ = a_ > b_; K[59] = g_ ? b_ : a_; K[63] = g_ ? a_ : b_; }
  { const float a_ = K[48], b_ = K[50]; const bool g_ = a_ > b_; K[48] = g_ ? a_ : b_; K[50] = g_ ? b_ : a_; }
  { const float a_ = K[49], b_ = K[51]; const bool g_ = a_ > b_; K[49] = g_ ? a_ : b_; K[51] = g_ ? b_ : a_; }
  { const float a_ = K[52], b_ = K[54]; const bool g_ = a_ > b_; K[52] = g_ ? a_ : b_; K[54] = g_ ? b_ : a_; }
  { const float a_ = K[53], b_ = K[55]; const bool g_ = a_ > b_; K[53] = g_ ? a_ : b_; K[55] = g_ ? b_ : a_; }
  { const float a_ = K[56], b_ = K[58]; const bool g_ = a_ > b_; K[56] = g_ ? b_ : a_; K[58] = g_ ? a_ : b_; }
  { const float a_ = K[57], b_ = K[59]; const bool g_ = a_ > b_; K[57] = g_ ? b_ : a_; K[59] = g_ ? a_ : b_; }
  { const float a_ = K[60], b_ = K[62]; const bool g_ = a_ > b_; K[60] = g_ ? b_ : a_; K[62] = g_ ? a_ : b_; }
  { const float a_ = K[61], b_ = K[63]; const bool g_ = a_ > b_; K[61] = g_ ? b_ : a_; K[63] = g_ ? a_ : b_; }
  { const float a_ = K[48], b_ = K[49]; const bool g_ = a_ > b_; K[48] = g_ ? a_ : b_; K[49] = g_ ? b_ : a_; }
  { const float a_ = K[50], b_ = K[51]; const bool g_ = a_ > b_; K[50] = g_ ? a_ : b_; K[51] = g_ ? b_ : a_; }
  { const float a_ = K[52], b_ = K[53]; const bool g_ = a_ > b_; K[52] = g_ ? a_ : b_; K[53] = g_ ? b_ : a_; }
  { const float a_ = K[54], b_ = K[55]; const bool g_ = a_ > b_; K[54] = g_ ? a_ : b_; K[55] = g_ ? b_ : a_; }
  { const float a_ = K[56], b_ = K[57]; const bool g_ = a_ > b_; K[56] = g_ ? b_ : a_; K[57] = g_ ? a_ : b_; }
  { const float a_ = K[58], b_ = K[59]; const bool g_ = a_ > b_; K[58] = g_ ? b_ : a_; K[59] = g_ ? a_ : b_; }
  { const float a_ = K[60], b_ = K[61]; const bool g_ = a_ > b_; K[60] = g_ ? b_ : a_; K[61] = g_ ? a_ : b_; }
  { const float a_ = K[62], b_ = K[63]; const bool g_ = a_ > b_; K[62] = g_ ? b_ : a_; K[63] = g_ ? a_ : b_; }
  { const float a_ = K[48], b_ = K[56]; const bool g_ = a_ > b_; K[48] = g_ ? a_ : b_; K[56] = g_ ? b_ : a_; }
  { const float a_ = K[49], b_ = K[57]; const bool g_ = a_ > b_; K[49] = g_ ? a_ : b_; K[57] = g_ ? b_ : a_; }
  { const float a_ = K[50], b_ = K[58]; const bool g_ = a_ > b_; K[50] = g_ ? a_ : b_; K[58] = g_ ? b_ : a_; }
  { const float a_ = K[51], b_ = K[59]; const bool g_ = a_ > b_; K[51] = g_ ? a_ : b_; K[59] = g_ ? b_ : a_; }
  { const float a_ = K[52], b_ = K[60]; const bool g_ = a_ > b_; K[52] = g_ ? a_ : b_; K[60] = g_ ? b_ : a_; }
  { const float a_ = K[53], b_ = K[61]; const bool g_ = a_ > b_; K[53] = g_ ? a_ : b_; K[61] = g_ ? b_ : a_; }
  { const float a_ = K[54], b_ = K[62]; const bool g_ = a_ > b_; K[54] = g_ ? a_ : b_; K[62] = g_ ? b_ : a_; }
  { const float a_ = K[55], b_ = K[63]; const bool g_ = a_ > b_; K[55] = g_ ? a_ : b_; K[63] = g_ ? b_ : a_; }
  { const float a_ = K[48], b_ = K[52]; const bool g_ = a_ > b_; K[48] = g_ ? a_ : b_; K[52] = g_ ? b_ : a_; }
  { const float a_ = K[49], b_ = K[53]; const bool g_ = a_ > b_; K[49] = g_ ? a_ : b_; K[53] = g_ ? b_ : a_; }
  { const float a_ = K[50], b_ = K[54]; const bool g_ = a_ > b_; K[50] = g_ ? a_ : b_; K[54] = g_ ? b_ : a_; }
  { const float a_ = K[51], b_ = K[55]; const bool g_ = a_ > b_; K[51] = g_ ? a_ : b_; K[55] = g_ ? b_ : a_; }
  { const float a_ = K[56], b_ = K[60]; const bool g_ = a_ > b_; K[56] = g_ ? a_ : b_; K[60] = g_ ? b_ : a_; }
  { const float a_ = K[57], b_ = K[61]; const bool g_ = a_ > b_; K[57] = g_ ? a_ : b_; K[61] = g_ ? b_ : a_; }
  { const float a_ = K[58], b_ = K[62]; const bool g_ = a_ > b_; K[58] = g_ ? a_ : b_; K[62] = g_ ? b_ : a_; }
  { const float a_ = K[59], b_ = K[63]; const bool g_ = a_ > b_; K[59] = g_ ? a_ : b_; K[63] = g_ ? b_ : a_; }
  { const float a_ = K[48], b_ = K[50]; const bool g_ = a_ > b_; K[48] = g_ ? a_ : b_; K[50] = g_ ? b_ : a_; }
  { const float a_ = K[49], b_ = K[51]; const bool g_ = a_ > b_; K[49] = g_ ? a_ : b_; K[51] = g_ ? b_ : a_; }
  { const float a_ = K[52], b_ = K[54]; const bool g_ = a_ > b_; K[52] = g_ ? a_ : b_; K[54] = g_ ? b_ : a_; }
  { const float a_ = K[53], b_ = K[55]; const bool g_ = a_ > b_; K[53] = g_ ? a_ : b_; K[55] = g_ ? b_ : a_; }
  { const float a_ = K[56], b_ = K[58]; const bool g_ = a_ > b_; K[56] = g_ ? a_ : b_; K[58] = g_ ? b_ : a_; }
  { const float a_ = K[57], b_ = K[59]; const bool g_ = a_ > b_; K[57] = g_ ? a_ : b_; K[59] = g_ ? b_ : a_; }
  { const float a_ = K[60], b_ = K[62]; const bool g_ = a_ > b_; K[60] = g_ ? a_ : b_; K[62] = g_ ? b_ : a_; }
  { const float a_ = K[61], b_ = K[63]; const bool g_ = a_ > b_; K[61] = g_ ? a_ : b_; K[63] = g_ ? b_ : a_; }
  { const float a_ = K[48], b_ = K[49]; const bool g_ = a_ > b_; K[48] = g_ ? a_ : b_; K[49] = g_ ? b_ : a_; }
  { const float a_ = K[50], b_ = K[51]; const bool g_ = a_ > b_; K[50] = g_ ? a_ : b_; K[51] = g_ ? b_ : a_; }
  { const float a_ = K[52], b_ = K[53]; const bool g_ = a_ > b_; K[52] = g_ ? a_ : b_; K[53] = g_ ? b_ : a_; }
  { const float a_ = K[54], b_ = K[55]; const bool g_ = a_ > b_; K[54] = g_ ? a_ : b_; K[55] = g_ ? b_ : a_; }
  { const float a_ = K[56], b_ = K[57]; const bool g_ = a_ > b_; K[56] = g_ ? a_ : b_; K[57] = g_ ? b_ : a_; }
  { const float a_ = K[58], b_ = K[59]; const bool g_ = a_ > b_; K[58] = g_ ? a_ : b_; K[59] = g_ ? b_ : a_; }
  { const float a_ = K[60], b_ = K[61]; const bool g_ = a_ > b_; K[60] = g_ ? a_ : b_; K[61] = g_ ? b_ : a_; }
  { const float a_ = K[62], b_ = K[63]; const bool g_ = a_ > b_; K[62] = g_ ? a_ : b_; K[63] = g_ ? b_ : a_; }
  { const float a_ = K[0], b_ = K[31]; K[0] = a_ > b_ ? a_ : b_; }
  { const float a_ = K[1], b_ = K[30]; K[1] = a_ > b_ ? a_ : b_; }
  { const float a_ = K[2], b_ = K[29]; K[2] = a_ > b_ ? a_ : b_; }
  { const float a_ = K[3], b_ = K[28]; K[3] = a_ > b_ ? a_ : b_; }
  { const float a_ = K[4], b_ = K[27]; K[4] = a_ > b_ ? a_ : b_; }
  { const float a_ = K[5], b_ = K[26]; K[5] = a_ > b_ ? a_ : b_; }
  { const float a_ = K[6], b_ = K[25]; K[6] = a_ > b_ ? a_ : b_; }
  { const float a_ = K[7], b_ = K[24]; K[7] = a_ > b_ ? a_ : b_; }
  { const float a_ = K[8], b_ = K[23]; K[8] = a_ > b_ ? a_ : b_; }
  { const float a_ = K[9], b_ = K[22]; K[9] = a_ > b_ ? a_ : b_; }
  { const float a_ = K[10], b_ = K[21]; K[10] = a_ > b_ ? a_ : b_; }
  { const float a_ = K[11], b_ = K[20]; K[11] = a_ > b_ ? a_ : b_; }
  { const float a_ = K[12], b_ = K[19]; K[12] = a_ > b_ ? a_ : b_; }
  { const float a_ = K[13], b_ = K[18]; K[13] = a_ > b_ ? a_ : b_; }
  { const float a_ = K[14], b_ = K[17]; K[14] = a_ > b_ ? a_ : b_; }
  { const float a_ = K[15], b_ = K[16]; K[15] = a_ > b_ ? a_ : b_; }
  { const float a_ = K[0], b_ = K[8]; const bool g_ = a_ > b_; K[0] = g_ ? a_ : b_; K[8] = g_ ? b_ : a_; }
  { const float a_ = K[1], b_ = K[9]; const bool g_ = a_ > b_; K[1] = g_ ? a_ : b_; K[9] = g_ ? b_ : a_; }
  { const float a_ = K[2], b_ = K[10]; const bool g_ = a_ > b_; K[2] = g_ ? a_ : b_; K[10] = g_ ? b_ : a_; }
  { const float a_ = K[3], b_ = K[11]; const bool g_ = a_ > b_; K[3] = g_ ? a_ : b_; K[11] = g_ ? b_ : a_; }
  { const float a_ = K[4], b_ = K[12]; const bool g_ = a_ > b_; K[4] = g_ ? a_ : b_; K[12] = g_ ? b_ : a_; }
  { const float a_ = K[5], b_ = K[13]; const bool g_ = a_ > b_; K[5] = g_ ? a_ : b_; K[13] = g_ ? b_ : a_; }
  { const float a_ = K[6], b_ = K[14]; const bool g_ = a_ > b_; K[6] = g_ ? a_ : b_; K[14] = g_ ? b_ : a_; }
  { const float a_ = K[7], b_ = K[15]; const bool g_ = a_ > b_; K[7] = g_ ? a_ : b_; K[15] = g_ ? b_ : a_; }
  { const float a_ = K[0], b_ = K[4]; const bool g_ = a_ > b_; K[0] = g_ ? a_ : b_; K[4] = g_ ? b_ : a_; }
  { const float a_ = K[1], b_ = K[5]; const bool g_ = a_ > b_; K[1] = g_ ? a_ : b_; K[5] = g_ ? b_ : a_; }
  { const float a_ = K[2], b_ = K[6]; const bool g_ = a_ > b_; K[2] = g_ ? a_ : b_; K[6] = g_ ? b_ : a_; }
  { const float a_ = K[3], b_ = K[7]; const bool g_ = a_ > b_; K[3] = g_ ? a_ : b_; K[7] = g_ ? b_ : a_; }
  { const float a_ = K[8], b_ = K[12]; const bool g_ = a_ > b_; K[8] = g_ ? a_ : b_; K[12] = g_ ? b_ : a_; }
  { const float a_ = K[9], b_ = K[13]; const bool g_ = a_ > b_; K[9] = g_ ? a_ : b_; K[13] = g_ ? b_ : a_; }
  { const float a_ = K[10], b_ = K[14]; const bool g_ = a_ > b_; K[10] = g_ ? a_ : b_; K[14] = g_ ? b_ : a_; }
  { const float a_ = K[11], b_ = K[15]; const bool g_ = a_ > b_; K[11] = g_ ? a_ : b_; K[15] = g_ ? b_ : a_; }
  { const float a_ = K[0], b_ = K[2]; const bool g_ = a_ > b_; K[0] = g_ ? a_ : b_; K[2] = g_ ? b_ : a_; }
  { const float a_ = K[1], b_ = K[3]; const bool g_ = a_ > b_; K[1] = g_ ? a_ : b_; K[3] = g_ ? b_ : a_; }
  { const float a_ = K[4], b_ = K[6]; const bool g_ = a_ > b_; K[4] = g_ ? a_ : b_; K[6] = g_ ? b_ : a_; }
  { const float a_ = K[5], b_ = K[7]; const bool g_ = a_ > b_; K[5] = g_ ? a_ : b_; K[7] = g_ ? b_ : a_; }
  { const float a_ = K[8], b_ = K[10]; const bool g_ = a_ > b_; K[8] = g_ ? a_ : b_; K[10] = g_ ? b_ : a_; }
  { const float a_ = K[9], b_ = K[11]; const bool g_ = a_ > b_; K[9] = g_ ? a_ : b_; K[11] = g_ ? b_ : a_; }
  { const float a_ = K[12], b_ = K[14]; const bool g_ = a_ > b_; K[12] = g_ ? a_ : b_; K[14] = g_ ? b_ : a_; }
  { const float a_ = K[13], b_ = K[15]; const bool g_ = a_ > b_; K[13] = g_ ? a_ : b_; K[15] = g_ ? b_ : a_; }
  { const float a_ = K[0], b_ = K[1]; const bool g_ = a_ > b_; K[0] = g_ ? a_ : b_; K[1] = g_ ? b_ : a_; }
  { const float a_ = K[2], b_ = K[3]; const bool g_ = a_ > b_; K[2] = g_ ? a_ : b_; K[3] = g_ ? b_ : a_; }
  { const float a_ = K[4], b_ = K[5]; const bool g_ = a_ > b_; K[4] = g_ ? a_ : b_; K[5] = g_ ? b_ : a_; }
  { const float a_ = K[6], b_ = K[7]; const bool g_ = a_ > b_; K[6] = g_ ? a_ : b_; K[7] = g_ ? b_ : a_; }
  { const float a_ = K[8], b_ = K[9]; const bool g_ = a_ > b_; K[8] = g_ ? a_ : b_; K[9] = g_ ? b_ : a_; }
  { const float a_ = K[10], b_ = K[11]; const bool g_ = a_ > b_; K[10] = g_ ? a_ : b_; K[11] = g_ ? b_ : a_; }
  { const float a_ = K[12], b_ = K[13]; const bool g_ = a_ > b_; K[12] = g_ ? a_ : b_; K[13] = g_ ? b_ : a_; }
  { const float a_ = K[14], b_ = K[15]; const bool g_ = a_ > b_; K[14] = g_ ? a_ : b_; K[15] = g_ ? b_ : a_; }
  { const float a_ = K[32], b_ = K[63]; K[32] = a_ > b_ ? a_ : b_; }
  { const float a_ = K[33], b_ = K[62]; K[33] = a_ > b_ ? a_ : b_; }
  { const float a_ = K[34], b_ = K[61]; K[34] = a_ > b_ ? a_ : b_; }
  { const float a_ = K[35], b_ = K[60]; K[35] = a_ > b_ ? a_ : b_; }
  { const float a_ = K[36], b_ = K[59]; K[36] = a_ > b_ ? a_ : b_; }
  { const float a_ = K[37], b_ = K[58]; K[37] = a_ > b_ ? a_ : b_; }
  { const float a_ = K[38], b_ = K[57]; K[38] = a_ > b_ ? a_ : b_; }
  { const float a_ = K[39], b_ = K[56]; K[39] = a_ > b_ ? a_ : b_; }
  { const float a_ = K[40], b_ = K[55]; K[40] = a_ > b_ ? a_ : b_; }
  { const float a_ = K[41], b_ = K[54]; K[41] = a_ > b_ ? a_ : b_; }
  { const float a_ = K[42], b_ = K[53]; K[42] = a_ > b_ ? a_ : b_; }
  { const float a_ = K[43], b_ = K[52]; K[43] = a_ > b_ ? a_ : b_; }
  { const float a_ = K[44], b_ = K[51]; K[44] = a_ > b_ ? a_ : b_; }
  { const float a_ = K[45], b_ = K[50]; K[45] = a_ > b_ ? a_ : b_; }
  { const float a_ = K[46], b_ = K[49]; K[46] = a_ > b_ ? a_ : b_; }
  { const float a_ = K[47], b_ = K[48]; K[47] = a_ > b_ ? a_ : b_; }
  { const float a_ = K[32], b_ = K[40]; const bool g_ = a_ > b_; K[32] = g_ ? a_ : b_; K[40] = g_ ? b_ : a_; }
  { const float a_ = K[33], b_ = K[41]; const bool g_ = a_ > b_; K[33] = g_ ? a_ : b_; K[41] = g_ ? b_ : a_; }
  { const float a_ = K[34], b_ = K[42]; const bool g_ = a_ > b_; K[34] = g_ ? a_ : b_; K[42] = g_ ? b_ : a_; }
  { const float a_ = K[35], b_ = K[43]; const bool g_ = a_ > b_; K[35] = g_ ? a_ : b_; K[43] = g_ ? b_ : a_; }
  { const float a_ = K[36], b_ = K[44]; const bool g_ = a_ > b_; K[36] = g_ ? a_ : b_; K[44] = g_ ? b_ : a_; }
  { const float a_ = K[37], b_ = K[45]; const bool g_ = a_ > b_; K[37] = g_ ? a_ : b_; K[45] = g_ ? b_ : a_; }
  { const float a_ = K[38], b_ = K[46]; const bool g_ = a_ > b_; K[38] = g_ ? a_ : b_; K[46] = g_ ? b_ : a_; }
  { const float a_ = K[39], b_ = K[47]; const bool g_ = a_ > b_; K[39] = g_ ? a_ : b_; K[47] = g_ ? b_ : a_; }
  { const float a_ = K[32], b_ = K[36]; const bool g_ = a_ > b_; K[32] = g_ ? a_ : b_; K[36] = g_ ? b_ : a_; }
  { const float a_ = K[33], b_ = K[37]; const bool g_ = a_ > b_; K[33] = g_ ? a_ : b_; K[37] = g_ ? b_ : a_; }
  { const float a_ = K[34], b_ = K[38]; const bool g_ = a_ > b_; K[34] = g_ ? a_ : b_; K[38] = g_ ? b_ : a_; }
  { const float a_ = K[35], b_ = K[39]; const bool g_ = a_ > b_; K[35] = g_ ? a_ : b_; K[39] = g_ ? b_ : a_; }
  { const float a_ = K[40], b_ = K[44]; const bool g_ = a_ > b_; K[40] = g_ ? a_ : b_; K[44] = g_ ? b_ : a_; }
  { const float a_ = K[41], b_ = K[45]; const bool g_ = a_ > b_; K[41] = g_ ? a_ : b_; K[45] = g_ ? b_ : a_; }
  { const float a_ = K[42], b_ = K[46]; const bool g_ = a_ > b_; K[42] = g_ ? a_ : b_; K[46] = g_ ? b_ : a_; }
  { const float a_ = K[43], b_ = K[47]; const bool g_ = a_ > b_; K[43] = g_ ? a_ : b_; K[47] = g_ ? b_ : a_; }
  { const float a_ = K[32], b_ = K[34]; const bool g_ = a_ > b_; K[32] = g_ ? a_ : b_; K[34] = g_ ? b_ : a_; }
  { const float a_ = K[33], b_ = K[35]; const bool g_ = a_ > b_; K[33] = g_ ? a_ : b_; K[35] = g_ ? b_ : a_; }
  { const float a_ = K[36], b_ = K[38]; const bool g_ = a_ > b_; K[36] = g_ ? a_ : b_; K[38] = g_ ? b_ : a_; }
  { const float a_ = K[37], b_ = K[39]; const bool g_ = a_ > b_; K[37] = g_ ? a_ : b_; K[39] = g_ ? b_ : a_; }
  { const float a_ = K[40], b_ = K[42]; const bool g_ = a_ > b_; K[40] = g_ ? a_ : b_; K[42] = g_ ? b_ : a_; }
  { const float a_ = K[41], b_ = K[43]; const bool g_ = a_ > b_; K[41] = g_ ? a_ : b_; K[43] = g_ ? b_ : a_; }
  { const float a_ = K[44], b_ = K[46]; const bool g_ = a_ > b_; K[44] = g_ ? a_ : b_; K[46] = g_ ? b_ : a_; }
  { const float a_ = K[45], b_ = K[47]; const bool g_ = a_ > b_; K[45] = g_ ? a_ : b_; K[47] = g_ ? b_ : a_; }
  { const float a_ = K[32], b_ = K[33]; const bool g_ = a_ > b_; K[32] = g_ ? a_ : b_; K[33] = g_ ? b_ : a_; }
  { const float a_ = K[34], b_ = K[35]; const bool g_ = a_ > b_; K[34] = g_ ? a_ : b_; K[35] = g_ ? b_ : a_; }
  { const float a_ = K[36], b_ = K[37]; const bool g_ = a_ > b_; K[36] = g_ ? a_ : b_; K[37] = g_ ? b_ : a_; }
  { const float a_ = K[38], b_ = K[39]; const bool g_ = a_ > b_; K[38] = g_ ? a_ : b_; K[39] = g_ ? b_ : a_; }
  { const float a_ = K[40], b_ = K[41]; const bool g_ = a_ > b_; K[40] = g_ ? a_ : b_; K[41] = g_ ? b_ : a_; }
  { const float a_ = K[42], b_ = K[43]; const bool g_ = a_ > b_; K[42] = g_ ? a_ : b_; K[43] = g_ ? b_ : a_; }
  { const float a_ = K[44], b_ = K[45]; const bool g_ = a_ > b_; K[44] = g_ ? a_ : b_; K[45] = g_ ? b_ : a_; }
  { const float a_ = K[46], b_ = K[47]; const bool g_ = a_ > b_; K[46] = g_ ? a_ : b_; K[47] = g_ ? b_ : a_; }
  { const float a_ = K[0], b_ = K[47]; K[0] = a_ > b_ ? a_ : b_; }
  { const float a_ = K[1], b_ = K[46]; K[1] = a_ > b_ ? a_ : b_; }
  { const float a_ = K[2], b_ = K[45]; K[2] = a_ > b_ ? a_ : b_; }
  { const float a_ = K[3], b_ = K[44]; K[3] = a_ > b_ ? a_ : b_; }
  { const float a_ = K[4], b_ = K[43]; K[4] = a_ > b_ ? a_ : b_; }
  { const float a_ = K[5], b_ = K[42]; K[5] = a_ > b_ ? a_ : b_; }
  { const float a_ = K[6], b_ = K[41]; K[6] = a_ > b_ ? a_ : b_; }
  { const float a_ = K[7], b_ = K[40]; K[7] = a_ > b_ ? a_ : b_; }
  { const float a_ = K[8], b_ = K[39]; K[8] = a_ > b_ ? a_ : b_; }
  { const float a_ = K[9], b_ = K[38]; K[9] = a_ > b_ ? a_ : b_; }
  { const float a_ = K[10], b_ = K[37]; K[10] = a_ > b_ ? a_ : b_; }
  { const float a_ = K[11], b_ = K[36]; K[11] = a_ > b_ ? a_ : b_; }
  { const float a_ = K[12], b_ = K[35]; K[12] = a_ > b_ ? a_ : b_; }
  { const float a_ = K[13], b_ = K[34]; K[13] = a_ > b_ ? a_ : b_; }
  { const float a_ = K[14], b_ = K[33]; K[14] = a_ > b_ ? a_ : b_; }
  { const float a_ = K[15], b_ = K[32]; K[15] = a_ > b_ ? a_ : b_; }
  { const float a_ = K[0], b_ = K[8]; const bool g_ = a_ > b_; K[0] = g_ ? a_ : b_; K[8] = g_ ? b_ : a_; }
  { const float a_ = K[1], b_ = K[9]; const bool g_ = a_ > b_; K[1] = g_ ? a_ : b_; K[9] = g_ ? b_ : a_; }
  { const float a_ = K[2], b_ = K[10]; const bool g_ = a_ > b_; K[2] = g_ ? a_ : b_; K[10] = g_ ? b_ : a_; }
  { const float a_ = K[3], b_ = K[11]; const bool g_ = a_ > b_; K[3] = g_ ? a_ : b_; K[11] = g_ ? b_ : a_; }
  { const float a_ = K[4], b_ = K[12]; const bool g_ = a_ > b_; K[4] = g_ ? a_ : b_; K[12] = g_ ? b_ : a_; }
  { const float a_ = K[5], b_ = K[13]; const bool g_ = a_ > b_; K[5] = g_ ? a_ : b_; K[13] = g_ ? b_ : a_; }
  { const float a_ = K[6], b_ = K[14]; const bool g_ = a_ > b_; K[6] = g_ ? a_ : b_; K[14] = g_ ? b_ : a_; }
  { const float a_ = K[7], b_ = K[15]; const bool g_ = a_ > b_; K[7] = g_ ? a_ : b_; K[15] = g_ ? b_ : a_; }
  { const float a_ = K[0], b_ = K[4]; const bool g_ = a_ > b_; K[0] = g_ ? a_ : b_; K[4] = g_ ? b_ : a_; }
  { const float a_ = K[1], b_ = K[5]; const bool g_ = a_ > b_; K[1] = g_ ? a_ : b_; K[5] = g_ ? b_ : a_; }
  { const float a_ = K[2], b_ = K[6]; const bool g_ = a_ > b_; K[2] = g_ ? a_ : b_; K[6] = g_ ? b_ : a_; }
  { const float a_ = K[3], b_ = K[7]; const bool g_ = a_ > b_; K[3] = g_ ? a_ : b_; K[7] = g_ ? b_ : a_; }
  { const float a_ = K[8], b_ = K[12]; const bool g_ = a_ > b_; K[8] = g_ ? a_ : b_; K[12] = g_ ? b_ : a_; }
  { const float a_ = K[9], b_ = K[13]; const bool g_ = a_ > b_; K[9] = g_ ? a_ : b_; K[13] = g_ ? b_ : a_; }
  { const float a_ = K[10], b_ = K[14]; const bool g_ = a_ > b_; K[10] = g_ ? a_ : b_; K[14] = g_ ? b_ : a_; }
  { const float a_ = K[11], b_ = K[15]; const bool g_ = a_ > b_; K[11] = g_ ? a_ : b_; K[15] = g_ ? b_ : a_; }
  { const float a_ = K[0], b_ = K[2]; const bool g_ = a_ > b_; K[0] = g_ ? a_ : b_; K[2] = g_ ? b_ : a_; }
  { const float a_ = K[1], b_ = K[3]; const bool g_ = a_ > b_; K[1] = g_ ? a_ : b_; K[3] = g_ ? b_ : a_; }
  { const float a_ = K[4], b_ = K[6]; const bool g_ = a_ > b_; K[4] = g_ ? a_ : b_; K[6] = g_ ? b_ : a_; }
  { const float a_ = K[5], b_ = K[7]; const bool g_ = a_ > b_; K[5] = g_ ? a_ : b_; K[7] = g_ ? b_ : a_; }
  { const float a_ = K[8], b_ = K[10]; const bool g_ = a_ > b_; K[8] = g_ ? a_ : b_; K[10] = g_ ? b_ : a_; }
  { const float a_ = K[9], b_ = K[11]; const bool g_ = a_ > b_; K[9] = g_ ? a_ : b_; K[11] = g_ ? b_ : a_; }
  { const float a_ = K[12], b_ = K[14]; const bool g_ = a_ > b_; K[12] = g_ ? a_ : b_; K[14] = g_ ? b_ : a_; }
  { const float a_ = K[13], b_ = K[15]; const bool g_ = a_ > b_; K[13] = g_ ? a_ : b_; K[15] = g_ ? b_ : a_; }
  { const float a_ = K[0], b_ = K[1]; const bool g_ = a_ > b_; K[0] = g_ ? a_ : b_; K[1] = g_ ? b_ : a_; }
  { const float a_ = K[2], b_ = K[3]; const bool g_ = a_ > b_; K[2] = g_ ? a_ : b_; K[3] = g_ ? b_ : a_; }
  { const float a_ = K[4], b_ = K[5]; const bool g_ = a_ > b_; K[4] = g_ ? a_ : b_; K[5] = g_ ? b_ : a_; }
  { const float a_ = K[6], b_ = K[7]; const bool g_ = a_ > b_; K[6] = g_ ? a_ : b_; K[7] = g_ ? b_ : a_; }
  { const float a_ = K[8], b_ = K[9]; const bool g_ = a_ > b_; K[8] = g_ ? a_ : b_; K[9] = g_ ? b_ : a_; }
  { const float a_ = K[10], b_ = K[11]; const bool g_ = a_ > b_; K[10] = g_ ? a_ : b_; K[11] = g_ ? b_ : a_; }
  { const float a_ = K[12], b_ = K[13]; const bool g_ = a_ > b_; K[12] = g_ ? a_ : b_; K[13] = g_ ? b_ : a_; }
  { const float a_ = K[14], b_ = K[15]; const bool g_ = a_ > b_; K[14] = g_ ? a_ : b_; K[15] = g_ ? b_ : a_; }
}
__device__ __forceinline__ void merge_top16(float (&T)[16], const float (&P)[16]) {
  { const float a_ = T[0], b_ = P[15]; T[0] = a_ > b_ ? a_ : b_; }
  { const float a_ = T[1], b_ = P[14]; T[1] = a_ > b_ ? a_ : b_; }
  { const float a_ = T[2], b_ = P[13]; T[2] = a_ > b_ ? a_ : b_; }
  { const float a_ = T[3], b_ = P[12]; T[3] = a_ > b_ ? a_ : b_; }
  { const float a_ = T[4], b_ = P[11]; T[4] = a_ > b_ ? a_ : b_; }
  { const float a_ = T[5], b_ = P[10]; T[5] = a_ > b_ ? a_ : b_; }
  { const float a_ = T[6], b_ = P[9]; T[6] = a_ > b_ ? a_ : b_; }
  { const float a_ = T[7], b_ = P[8]; T[7] = a_ > b_ ? a_ : b_; }
  { const float a_ = T[8], b_ = P[7]; T[8] = a_ > b_ ? a_ : b_; }
  { const float a_ = T[9], b_ = P[6]; T[9] = a_ > b_ ? a_ : b_; }
  { const float a_ = T[10], b_ = P[5]; T[10] = a_ > b_ ? a_ : b_; }
  { const float a_ = T[11], b_ = P[4]; T[11] = a_ > b_ ? a_ : b_; }
  { const float a_ = T[12], b_ = P[3]; T[12] = a_ > b_ ? a_ : b_; }
  { const float a_ = T[13], b_ = P[2]; T[13] = a_ > b_ ? a_ : b_; }
  { const float a_ = T[14], b_ = P[1]; T[14] = a_ > b_ ? a_ : b_; }
  { const float a_ = T[15], b_ = P[0]; T[15] = a_ > b_ ? a_ : b_; }
  { const float a_ = T[0], b_ = T[8]; const bool g_ = a_ > b_; T[0] = g_ ? a_ : b_; T[8] = g_ ? b_ : a_; }
  { const float a_ = T[1], b_ = T[9]; const bool g_ = a_ > b_; T[1] = g_ ? a_ : b_; T[9] = g_ ? b_ : a_; }
  { const float a_ = T[2], b_ = T[10]; const bool g_ = a_ > b_; T[2] = g_ ? a_ : b_; T[10] = g_ ? b_ : a_; }
  { const float a_ = T[3], b_ = T[11]; const bool g_ = a_ > b_; T[3] = g_ ? a_ : b_; T[11] = g_ ? b_ : a_; }
  { const float a_ = T[4], b_ = T[12]; const bool g_ = a_ > b_; T[4] = g_ ? a_ : b_; T[12] = g_ ? b_ : a_; }
  { const float a_ = T[5], b_ = T[13]; const bool g_ = a_ > b_; T[5] = g_ ? a_ : b_; T[13] = g_ ? b_ : a_; }
  { const float a_ = T[6], b_ = T[14]; const bool g_ = a_ > b_; T[6] = g_ ? a_ : b_; T[14] = g_ ? b_ : a_; }
  { const float a_ = T[7], b_ = T[15]; const bool g_ = a_ > b_; T[7] = g_ ? a_ : b_; T[15] = g_ ? b_ : a_; }
  { const float a_ = T[0], b_ = T[4]; const bool g_ = a_ > b_; T[0] = g_ ? a_ : b_; T[4] = g_ ? b_ : a_; }
  { const float a_ = T[1], b_ = T[5]; const bool g_ = a_ > b_; T[1] = g_ ? a_ : b_; T[5] = g_ ? b_ : a_; }
  { const float a_ = T[2], b_ = T[6]; const bool g_ = a_ > b_; T[2] = g_ ? a_ : b_; T[6] = g_ ? b_ : a_; }
  { const float a_ = T[3], b_ = T[7]; const bool g_ = a_ > b_; T[3] = g_ ? a_ : b_; T[7] = g_ ? b_ : a_; }
  { const float a_ = T[8], b_ = T[12]; const bool g_ = a_ > b_; T[8] = g_ ? a_ : b_; T[12] = g_ ? b_ : a_; }
  { const float a_ = T[9], b_ = T[13]; const bool g_ = a_ > b_; T[9] = g_ ? a_ : b_; T[13] = g_ ? b_ : a_; }
  { const float a_ = T[10], b_ = T[14]; const bool g_ = a_ > b_; T[10] = g_ ? a_ : b_; T[14] = g_ ? b_ : a_; }
  { const float a_ = T[11], b_ = T[15]; const bool g_ = a_ > b_; T[11] = g_ ? a_ : b_; T[15] = g_ ? b_ : a_; }
  { const float a_ = T[0], b_ = T[2]; const bool g_ = a_ > b_; T[0] = g_ ? a_ : b_; T[2] = g_ ? b_ : a_; }
  { const float a_ = T[1], b_ = T[3]; const bool g_ = a_ > b_; T[1] = g_ ? a_ : b_; T[3] = g_ ? b_ : a_; }
  { const float a_ = T[4], b_ = T[6]; const bool g_ = a_ > b_; T[4] = g_ ? a_ : b_; T[6] = g_ ? b_ : a_; }
  { const float a_ = T[5], b_ = T[7]; const bool g_ = a_ > b_; T[5] = g_ ? a_ : b_; T[7] = g_ ? b_ : a_; }
  { const float a_ = T[8], b_ = T[10]; const bool g_ = a_ > b_; T[8] = g_ ? a_ : b_; T[10] = g_ ? b_ : a_; }
  { const float a_ = T[9], b_ = T[11]; const bool g_ = a_ > b_; T[9] = g_ ? a_ : b_; T[11] = g_ ? b_ : a_; }
  { const float a_ = T[12], b_ = T[14]; const bool g_ = a_ > b_; T[12] = g_ ? a_ : b_; T[14] = g_ ? b_ : a_; }
  { const float a_ = T[13], b_ = T[15]; const bool g_ = a_ > b_; T[13] = g_ ? a_ : b_; T[15] = g_ ? b_ : a_; }
  { const float a_ = T[0], b_ = T[1]; const bool g_ = a_ > b_; T[0] = g_ ? a_ : b_; T[1] = g_ ? b_ : a_; }
  { const float a_ = T[2], b_ = T[3]; const bool g_ = a_ > b_; T[2] = g_ ? a_ : b_; T[3] = g_ ? b_ : a_; }
  { const float a_ = T[4], b_ = T[5]; const bool g_ = a_ > b_; T[4] = g_ ? a_ : b_; T[5] = g_ ? b_ : a_; }
  { const float a_ = T[6], b_ = T[7]; const bool g_ = a_ > b_; T[6] = g_ ? a_ : b_; T[7] = g_ ? b_ : a_; }
  { const float a_ = T[8], b_ = T[9]; const bool g_ = a_ > b_; T[8] = g_ ? a_ : b_; T[9] = g_ ? b_ : a_; }
  { const float a_ = T[10], b_ = T[11]; const bool g_ = a_ > b_; T[10] = g_ ? a_ : b_; T[11] = g_ ? b_ : a_; }
  { const float a_ = T[12], b_ = T[13]; const bool g_ = a_ > b_; T[12] = g_ ? a_ : b_; T[13] = g_ ? b_ : a_; }
  { const float a_ = T[14], b_ = T[15]; const bool g_ = a_ > b_; T[14] = g_ ? a_ : b_; T[15] = g_ ? b_ : a_; }
}

__device__ __forceinline__ void peer_topk(const int wave_s, const bf16* pq, const bf16* skb, int* ids, float* gates, LAS float* smem) {
  const int tid_ = opaque_tid(wave_s);
  const int lane = tid_ & 63, n = lane & 31, hh = lane >> 5, wave = tid_ >> 6;
  const int gw = blockIdx.x * NWAVES + wave;
  const int nw = gridDim.x * NWAVES;
  LAS float* lk = smem + wave * 2048;
  for (int it = gw; it < 512 * 8; it += nw) {
    const int h = it & 7, tok0 = (it >> 3) * 32;
#pragma unroll 1
    for (int half = 0; half < 2; half++) {
      bf16x8_t qf[8];
      {
        const bf16* qrow = pq + (size_t)(tok0 + n) * 2048 + h * 256 + half * 128 + 8 * hh;
#pragma unroll
        for (int ks = 0; ks < 8; ks++) qf[ks] = *(const bf16x8_t*)(qrow + 16 * ks);
      }
      float K[64];
#pragma unroll
      for (int kt = 0; kt < 4; kt++) {
        const bf16* krow = skb + ((size_t)((h * 2 + half) * 128 + kt * 32 + n)) * 128 + 8 * hh;
        f32x16_t acc;
#pragma unroll
        for (int r = 0; r < 16; r++) acc[r] = 0.f;
#pragma unroll
        for (int kq = 0; kq < 2; kq++) {
          bf16x8_t kf[4];
#pragma unroll
          for (int i = 0; i < 4; i++) kf[i] = *(const bf16x8_t*)(krow + 16 * (kq * 4 + i));
          MFMA_PAD();
#pragma unroll
          for (int i = 0; i < 4; i++) acc = __builtin_amdgcn_mfma_f32_32x32x16_bf16(kf[i], qf[kq * 4 + i], acc, 0, 0, 0);
          MFMA_PAD();
        }
#pragma unroll
        for (int i = 0; i < 16; i++) K[kt * 16 + i] = pack_key<0x7Fu>(acc[i], (unsigned)(kt * 32 + (i & 3) + 8 * (i >> 2) + 4 * hh));
      }
      __builtin_amdgcn_sched_barrier(0);
      top16_of_64(K);
      __builtin_amdgcn_sched_barrier(0);
      float T[16], P[16];
#pragma unroll
      for (int i = 0; i < 16; i++) { T[i] = K[i]; P[i] = __shfl_xor(K[i], 32, 64); }
      merge_top16(T, P);
#pragma unroll
      for (int i = 0; i < 16; i++) lk[(half * 16 + i) * 64 + lane] = T[i];
      __builtin_amdgcn_sched_barrier(0);
    }
    float f0[16], f1[16];
    int ti0[16], ti1[16];
#pragma unroll
    for (int i = 0; i < 16; i++) {
      const float k0 = lk[i * 64 + lane], k1 = lk[(16 + i) * 64 + lane];
      f0[i] = key_val<0x7Fu>(k0); ti0[i] = (int)key_idx<0x7Fu>(k0);
      f1[i] = key_val<0x7Fu>(k1); ti1[i] = (int)key_idx<0x7Fu>(k1);
    }
    float K[64];
    {
    K[0] = pack_key<0xFFu>(f0[0] + f1[0], 0u);
    K[1] = pack_key<0xFFu>(f0[0] + f1[1], 1u);
    K[2] = pack_key<0xFFu>(f0[0] + f1[2], 2u);
    K[3] = pack_key<0xFFu>(f0[0] + f1[3], 3u);
    K[4] = pack_key<0xFFu>(f0[0] + f1[4], 4u);
    K[5] = pack_key<0xFFu>(f0[0] + f1[5], 5u);
    K[6] = pack_key<0xFFu>(f0[0] + f1[6], 6u);
    K[7] = pack_key<0xFFu>(f0[0] + f1[7], 7u);
    K[8] = pack_key<0xFFu>(f0[0] + f1[8], 8u);
    K[9] = pack_key<0xFFu>(f0[0] + f1[9], 9u);
    K[10] = pack_key<0xFFu>(f0[0] + f1[10], 10u);
    K[11] = pack_key<0xFFu>(f0[0] + f1[11], 11u);
    K[12] = pack_key<0xFFu>(f0[0] + f1[12], 12u);
    K[13] = pack_key<0xFFu>(f0[0] + f1[13], 13u);
    K[14] = pack_key<0xFFu>(f0[0] + f1[14], 14u);
    K[15] = pack_key<0xFFu>(f0[0] + f1[15], 15u);
    K[16] = pack_key<0xFFu>(f0[1] + f1[0], 16u);
    K[17] = pack_key<0xFFu>(f0[1] + f1[1], 17u);
    K[18] = pack_key<0xFFu>(f0[1] + f1[2], 18u);
    K[19] = pack_key<0xFFu>(f0[1] + f1[3], 19u);
    K[20] = pack_key<0xFFu>(f0[1] + f1[4], 20u);
    K[21] = pack_key<0xFFu>(f0[1] + f1[5], 21u);
    K[22] = pack_key<0xFFu>(f0[1] + f1[6], 22u);
    K[23] = pack_key<0xFFu>(f0[1] + f1[7], 23u);
    K[24] = pack_key<0xFFu>(f0[2] + f1[0], 32u);
    K[25] = pack_key<0xFFu>(f0[2] + f1[1], 33u);
    K[26] = pack_key<0xFFu>(f0[2] + f1[2], 34u);
    K[27] = pack_key<0xFFu>(f0[2] + f1[3], 35u);
    K[28] = pack_key<0xFFu>(f0[2] + f1[4], 36u);
    K[29] = pack_key<0xFFu>(f0[3] + f1[0], 48u);
    K[30] = pack_key<0xFFu>(f0[3] + f1[1], 49u);
    K[31] = pack_key<0xFFu>(f0[3] + f1[2], 50u);
    K[32] = pack_key<0xFFu>(f0[3] + f1[3], 51u);
    K[33] = pack_key<0xFFu>(f0[4] + f1[0], 64u);
    K[34] = pack_key<0xFFu>(f0[4] + f1[1], 65u);
    K[35] = pack_key<0xFFu>(f0[4] + f1[2], 66u);
    K[36] = pack_key<0xFFu>(f0[5] + f1[0], 80u);
    K[37] = pack_key<0xFFu>(f0[5] + f1[1], 81u);
    K[38] = pack_key<0xFFu>(f0[6] + f1[0], 96u);
    K[39] = pack_key<0xFFu>(f0[6] + f1[1], 97u);
    K[40] = pack_key<0xFFu>(f0[7] + f1[0], 112u);
    K[41] = pack_key<0xFFu>(f0[7] + f1[1], 113u);
    K[42] = pack_key<0xFFu>(f0[8] + f1[0], 128u);
    K[43] = pack_key<0xFFu>(f0[9] + f1[0], 144u);
    K[44] = pack_key<0xFFu>(f0[10] + f1[0], 160u);
    K[45] = pack_key<0xFFu>(f0[11] + f1[0], 176u);
    K[46] = pack_key<0xFFu>(f0[12] + f1[0], 192u);
    K[47] = pack_key<0xFFu>(f0[13] + f1[0], 208u);
    K[48] = pack_key<0xFFu>(f0[14] + f1[0], 224u);
    K[49] = pack_key<0xFFu>(f0[15] + f1[0], 240u);
    K[50] = -3.0e38f;
    K[51] = -3.0e38f;
    K[52] = -3.0e38f;
    K[53] = -3.0e38f;
    K[54] = -3.0e38f;
    K[55] = -3.0e38f;
    K[56] = -3.0e38f;
    K[57] = -3.0e38f;
    K[58] = -3.0e38f;
    K[59] = -3.0e38f;
    K[60] = -3.0e38f;
    K[61] = -3.0e38f;
    K[62] = -3.0e38f;
    K[63] = -3.0e38f;
    }
    __builtin_amdgcn_sched_barrier(0);
    top16_of_64(K);
    __builtin_amdgcn_sched_barrier(0);
    float bv[16];
    int be[16];
#pragma unroll
    for (int r = 0; r < 16; r++) {
      const int flat = (int)key_idx<0xFFu>(K[r]);
      const int a = flat >> 4, b = flat & 15;
      int i0 = 0, i1 = 0;
#pragma unroll
      for (int i = 0; i < 16; i++) { i0 = (a == i) ? ti0[i] : i0; i1 = (b == i) ? ti1[i] : i1; }
      be[r] = i0 * 128 + i1;
      bv[r] = key_val<0xFFu>(K[r]);
    }
    const float b0 = bv[0];
    float ge[16];
    float gsum = 0.f;
#pragma unroll
    for (int r = 0; r < 16; r++) { ge[r] = __expf(bv[r] - b0); gsum += ge[r]; }
    const float ginv = 1.0f / gsum;
    if (hh == 0) {
      int* ip = ids + (size_t)(tok0 + n) * 128 + h * 16;
      float* gp = gates + (size_t)(tok0 + n) * 128 + h * 16;
#pragma unroll
      for (int r4 = 0; r4 < 4; r4++) {
        *(int4*)(ip + 4 * r4) = make_int4(be[4 * r4], be[4 * r4 + 1], be[4 * r4 + 2], be[4 * r4 + 3]);
        *(float4*)(gp + 4 * r4) = make_float4(ge[4 * r4] * ginv, ge[4 * r4 + 1] * ginv, ge[4 * r4 + 2] * ginv, ge[4 * r4 + 3] * ginv);
      }
    }
  }
}

typedef _Float16 f16x2_t __attribute__((ext_vector_type(2)));
__device__ __forceinline__ unsigned e4m3x2_to_f16x2(unsigned w, unsigned sel) {
  return __builtin_amdgcn_perm(w, w, sel);
}
__device__ __forceinline__ float dot2h(unsigned a, unsigned b, float c) {
  return __builtin_amdgcn_fdot2(__builtin_bit_cast(f16x2_t, a), __builtin_bit_cast(f16x2_t, b), c, false);
}
__device__ __forceinline__ unsigned pack_h2(float lo, float hi) {
  f16x2_t v; v.x = (_Float16)lo; v.y = (_Float16)hi;
  return __builtin_bit_cast(unsigned, v);
}
template <bool FINAL>
__device__ __forceinline__ void peer_gather(const int wave_s, bf16* xn, const float* rst, const unsigned char* ub, const unsigned char* vb, const float* vsc, const float* usc,
                                            const int* ids, const float* gates, float* xw, const float* gnext, float* outp) {
  const int tid_ = opaque_tid(wave_s);
  const int lane = tid_ & 63;
  const int gw = blockIdx.x * NWAVES + (tid_ >> 6);
  const int nw = gridDim.x * NWAVES;
  const int el = ((lane >> 5) & 1) * 4 + ((lane >> 4) & 1) * 2 + ((lane >> 3) & 1);
  int idv = 0;
  uint2 uu[8];
  uint2 vv[8];
  if (gw < NT) {
    idv = ids[(size_t)gw * 128 + (lane & 7)];
#pragma unroll
    for (int e = 0; e < 8; e++) {
      const int id = __builtin_amdgcn_readlane(idv, e);
      uu[e] = *(const uint2*)(ub + (size_t)id * 512 + lane * 8);
      vv[e] = *(const uint2*)(vb + (size_t)id * 512 + lane * 8);
    }
  }
  for (int tok = gw; tok < NT; tok += nw) {
    const int tokn = (tok + nw < NT) ? tok + nw : tok;
    int xqh[2] = {0, 0}, xql[2] = {0, 0};
    float xstep, qhalf;
    {
      const uint4 a = *(const uint4*)(xn + (size_t)tok * DM + lane * 16);
      const uint4 b = *(const uint4*)(xn + (size_t)tok * DM + lane * 16 + 8);
      const unsigned xw_[8] = {a.x, a.y, a.z, a.w, b.x, b.y, b.z, b.w};
      const float4* sp = (const float4*)(rst + (size_t)tok * 16);
      const float4 s0 = sp[0], s1 = sp[1], s2 = sp[2], s3 = sp[3];
      const float xs = rsqrtf((((s0.x + s0.y) + (s0.z + s0.w)) + ((s1.x + s1.y) + (s1.z + s1.w)) + ((s2.x + s2.y) + (s2.z + s2.w)) + ((s3.x + s3.y) + (s3.z + s3.w))) * (1.0f / 1024.f) + EPSF);
      float xf[16];
      float am = 0.f;
#pragma unroll
      for (int k = 0; k < 8; k++) { xf[2 * k] = bf_lo(xw_[k]) * xs; xf[2 * k + 1] = bf_hi(xw_[k]) * xs; am = fmaxf(am, fmaxf(fabsf(xf[2 * k]), fabsf(xf[2 * k + 1]))); }
#pragma unroll
      for (int o = 32; o >= 1; o >>= 1) am = fmaxf(am, __shfl_xor(am, o, 64));
      xstep = am * (1.0f / 119.f);
      const float inv = am > 0.f ? 119.f / am : 0.f;
      int qs = 0;
#pragma unroll
      for (int i = 0; i < 16; i++) {
        const int q = (int)rintf(xf[i] * inv);
        const int t = q + 8;
        xqh[i >> 3] |= ((t >> 4) & 15) << (4 * (i & 7));
        xql[i >> 3] |= (((t & 15) - 8) & 15) << (4 * (i & 7));
        qs += q;
      }
      qhalf = 0.5f * wsum((float)qs);
    }
    f16x2_t acc2[8];
#pragma unroll
    for (int i = 0; i < 8; i++) acc2[i] = (f16x2_t){(_Float16)0.f, (_Float16)0.f};
#pragma unroll 1
    for (int g = 0; g < 16; g++) {
      const int ide = __builtin_amdgcn_ds_bpermute(el << 2, idv);
      const float2 sc2 = ((const float2*)vsc)[ide];
      const float gv = gates[(size_t)tok * 128 + g * 8 + el] * sc2.x;
      const float us = sc2.y * xstep;
      const int idn = ids[(size_t)(g < 15 ? tok : tokn) * 128 + ((g + 1) & 15) * 8 + (lane & 7)];
      float d[8];
#pragma unroll
      for (int e = 0; e < 8; e++) {
        int sh = __builtin_amdgcn_sdot8((int)uu[e].x, xqh[0], 0, false);
        sh = __builtin_amdgcn_sdot8((int)uu[e].y, xqh[1], sh, false);
        int sl = __builtin_amdgcn_sdot8((int)uu[e].x, xql[0], 0, false);
        sl = __builtin_amdgcn_sdot8((int)uu[e].y, xql[1], sl, false);
        d[e] = (float)((sh << 4) + sl);
      }
#pragma unroll
      for (int e = 0; e < 8; e++) {
        const int id = __builtin_amdgcn_readlane(idn, e);
        uu[e] = *(const uint2*)(ub + (size_t)id * 512 + lane * 8);
      }
      float d4[4], d2[2], d1;
      {
        const bool hi = (lane & 32) != 0;
#pragma unroll
        for (int i = 0; i < 4; i++) { const float send = hi ? d[i] : d[i + 4]; const float keep = hi ? d[i + 4] : d[i]; d4[i] = keep + __shfl_xor(send, 32, 64); }
      }
      {
        const bool hi = (lane & 16) != 0;
#pragma unroll
        for (int i = 0; i < 2; i++) { const float send = hi ? d4[i] : d4[i + 2]; const float keep = hi ? d4[i + 2] : d4[i]; d2[i] = keep + __shfl_xor(send, 16, 64); }
      }
      {
        const bool hi = (lane & 8) != 0;
        const float send = hi ? d2[0] : d2[1];
        const float keep = hi ? d2[1] : d2[0];
        d1 = keep + __shfl_xor(send, 8, 64);
      }
      d1 += __shfl_xor(d1, 4, 64);
      d1 += __shfl_xor(d1, 2, 64);
      d1 += __shfl_xor(d1, 1, 64);
      const float wl = gv * gelu_tanh((d1 + qhalf) * us);
#pragma unroll
      for (int e = 0; e < 8; e++) {
        const float w = __builtin_bit_cast(float, __builtin_amdgcn_readlane(__builtin_bit_cast(int, wl), ((e >> 2) & 1) * 32 + ((e >> 1) & 1) * 16 + (e & 1) * 8));
        const f16x2_t w2 = __builtin_bit_cast(f16x2_t, pack_h2(w, w));
        const unsigned vw[2] = {vv[e].x, vv[e].y};
#pragma unroll
        for (int k = 0; k < 2; k++) {
          const unsigned w4 = vw[k];
          const unsigned le = __builtin_amdgcn_perm(V4_LUT_HI, V4_LUT_LO, w4 & 0x07070707u);
          const unsigned lo = __builtin_amdgcn_perm(V4_LUT_HI, V4_LUT_LO, (w4 >> 4) & 0x07070707u);
          const unsigned ee = ((w4 << 4) & 0x80808080u) | le;
          const unsigned eo = (w4 & 0x80808080u) | lo;
          const unsigned p01 = __builtin_amdgcn_perm(eo, ee, 0x040c000cu), p23 = __builtin_amdgcn_perm(eo, ee, 0x050c010cu);
          const unsigned p45 = __builtin_amdgcn_perm(eo, ee, 0x060c020cu), p67 = __builtin_amdgcn_perm(eo, ee, 0x070c030cu);
          acc2[4 * k + 0] = __builtin_elementwise_fma(__builtin_bit_cast(f16x2_t, p01), w2, acc2[4 * k + 0]);
          acc2[4 * k + 1] = __builtin_elementwise_fma(__builtin_bit_cast(f16x2_t, p23), w2, acc2[4 * k + 1]);
          acc2[4 * k + 2] = __builtin_elementwise_fma(__builtin_bit_cast(f16x2_t, p45), w2, acc2[4 * k + 2]);
          acc2[4 * k + 3] = __builtin_elementwise_fma(__builtin_bit_cast(f16x2_t, p67), w2, acc2[4 * k + 3]);
        }
      }
#pragma unroll
      for (int e = 0; e < 8; e++) {
        const int id = __builtin_amdgcn_readlane(idn, e);
        vv[e] = *(const uint2*)(vb + (size_t)id * 512 + lane * 8);
      }
      idv = idn;
    }
    float acc[16];
#pragma unroll
    for (int i = 0; i < 8; i++) { acc[2 * i] = (float)acc2[i].x; acc[2 * i + 1] = (float)acc2[i].y; }
    float* xr = xw + (size_t)tok * DM + lane * 16;
    float xv[16];
    float ssq = 0.f;
#pragma unroll
    for (int c = 0; c < 4; c++) {
      float4 a0 = *(float4*)(xr + c * 4);
      a0.x += acc[c * 4 + 0]; a0.y += acc[c * 4 + 1]; a0.z += acc[c * 4 + 2]; a0.w += acc[c * 4 + 3];
      if (!FINAL) *(float4*)(xr + c * 4) = a0;
      xv[c * 4 + 0] = a0.x; xv[c * 4 + 1] = a0.y; xv[c * 4 + 2] = a0.z; xv[c * 4 + 3] = a0.w;
      ssq += a0.x * a0.x + a0.y * a0.y + a0.z * a0.z + a0.w * a0.w;
    }
    ssq = wsum(ssq);
    const float rstd = rsqrtf(ssq * (1.0f / DM) + EPSF);
    const float4* g4 = (const float4*)(gnext + lane * 16);
    if (FINAL) {
      float* op = outp + (size_t)tok * DM + lane * 16;
#pragma unroll
      for (int c = 0; c < 4; c++) {
        const float4 gq = g4[c];
        *(float4*)(op + c * 4) = make_float4(xv[c * 4] * rstd * gq.x, xv[c * 4 + 1] * rstd * gq.y, xv[c * 4 + 2] * rstd * gq.z, xv[c * 4 + 3] * rstd * gq.w);
      }
    } else {
      uint4 o0, o1;
      { const float4 ga = g4[0], gb = g4[1];
        o0.x = pk2(xv[0] * rstd * ga.x, xv[1] * rstd * ga.y); o0.y = pk2(xv[2] * rstd * ga.z, xv[3] * rstd * ga.w);
        o0.z = pk2(xv[4] * rstd * gb.x, xv[5] * rstd * gb.y); o0.w = pk2(xv[6] * rstd * gb.z, xv[7] * rstd * gb.w); }
      { const float4 ga = g4[2], gb = g4[3];
        o1.x = pk2(xv[8] * rstd * ga.x, xv[9] * rstd * ga.y); o1.y = pk2(xv[10] * rstd * ga.z, xv[11] * rstd * ga.w);
        o1.z = pk2(xv[12] * rstd * gb.x, xv[13] * rstd * gb.y); o1.w = pk2(xv[14] * rstd * gb.z, xv[15] * rstd * gb.w); }
      *(uint4*)(xn + (size_t)tok * DM + lane * 16) = o0;
      *(uint4*)(xn + (size_t)tok * DM + lane * 16 + 8) = o1;
    }
  }
}

__device__ __forceinline__ void prologue_transposes(const int wave_s, const Params& p, unsigned char* ws, LAS unsigned char* lds) {
  const int tid_ = opaque_tid(wave_s);
  const int lane = tid_ & 63, wave = tid_ >> 6;
  LAS float* scr = (LAS float*)(lds + wave * 16384);
  const int gw = blockIdx.x * NWAVES + wave, NGW = gridDim.x * NWAVES;
  constexpr int I_IN = (DM / 64) * (DIN / 32), I_SQ = (DM / 64) * (DM / 32), I_2K = (DM / 64) * (2048 / 32);
  constexpr int I_GL = (256 / 64) * (256 / 32);
  constexpr int PER_LAYER = I_IN + 3 * I_SQ + 2 * I_2K + I_GL;
  const float* w3 = karg_in(3); const float* w19 = karg_in(19); const float* w22 = karg_in(22);
  const float* w23 = karg_in(23); const float* w24 = karg_in(24); const float* w26 = karg_in(26);
  const float* w16 = karg_in(16);
  for (int it = gw; it < 2 * PER_LAYER; it += NGW) {
    const int l = it / PER_LAYER;
    int r = it % PER_LAYER;
    unsigned char* wl = ws + WS_WT + (size_t)l * WT_LAYER;
    if (r < I_IN) { transpose_item(w3 + (size_t)l * DM * DIN, DM, DIN, (bf16*)(wl + WT_IN), scr, r, lane); continue; } r -= I_IN;
    if (r < I_SQ) { transpose_item(w19 + (size_t)l * DM * DM, DM, DM, (bf16*)(wl + WT_OUT), scr, r, lane); continue; } r -= I_SQ;
    if (r < I_SQ) { transpose_item(w22 + (size_t)l * DM * DM, DM, DM, (bf16*)(wl + WT_MQ), scr, r, lane); continue; } r -= I_SQ;
    if (r < I_2K) { transpose_item(w23 + (size_t)l * DM * 2048, DM, 2048, (bf16*)(wl + WT_MKV), scr, r, lane); continue; } r -= I_2K;
    if (r < I_SQ) { transpose_item(w24 + (size_t)l * DM * DM, DM, DM, (bf16*)(wl + WT_MO), scr, r, lane); continue; } r -= I_SQ;
    if (r < I_2K) { transpose_item(w26 + (size_t)l * DM * 2048, DM, 2048, (bf16*)(wl + WT_PQ), scr, r, lane); continue; } r -= I_2K;
    transpose_item(w16 + (size_t)l * 256 * 256, 256, 256, (bf16*)(wl + WT_GLU), scr, r, lane);
  }
}

template <class T> __device__ __forceinline__ T* opq(T* p) { asm volatile("" : "+s"(p)); return p; }
__device__ __forceinline__ void cvt_rows_bf16(const int wave_s, const float* src, bf16* dst, size_t n) {
  const int tid_ = opaque_tid(wave_s);
  const size_t gt = (size_t)blockIdx.x * (NWAVES * 64) + tid_;
  const size_t nth = (size_t)gridDim.x * NWAVES * 64;
  for (size_t i = gt; i < n / 8; i += nth) {
    const float4 a = ((const float4*)src)[2 * i], b = ((const float4*)src)[2 * i + 1];
    uint4 o; o.x = pk2(a.x, a.y); o.y = pk2(a.z, a.w); o.z = pk2(b.x, b.y); o.w = pk2(b.z, b.w);
    ((uint4*)dst)[i] = o;
  }
}

__device__ __forceinline__ unsigned enc_e4m3(float x) {
  const _Float16 hf = (_Float16)x;
  const unsigned h = (unsigned)__builtin_bit_cast(unsigned short, hf);
  return ((h + 0x7Fu + ((h >> 8) & 1u)) >> 8) & 0xFFu;
}
__device__ __forceinline__ void cvt_rows_e4m3(const int wave_s, const float* src, unsigned char* dst, size_t n, float sc) {
  const int tid_ = opaque_tid(wave_s);
  const size_t gt = (size_t)blockIdx.x * (NWAVES * 64) + tid_;
  const size_t nth = (size_t)gridDim.x * NWAVES * 64;
  for (size_t i = gt; i < n / 16; i += nth) {
    unsigned w[4];
#pragma unroll
    for (int k = 0; k < 4; k++) {
      const float4 a = ((const float4*)src)[4 * i + k];
      w[k] = enc_e4m3(a.x * sc) | (enc_e4m3(a.y * sc) << 8) | (enc_e4m3(a.z * sc) << 16) | (enc_e4m3(a.w * sc) << 24);
    }
    uint4 o; o.x = w[0]; o.y = w[1]; o.z = w[2]; o.w = w[3];
    ((uint4*)dst)[i] = o;
  }
}

__device__ __forceinline__ unsigned enc_v4(float z) {
  const float az = fabsf(z);
  unsigned c = 0;
  c += az > 0.25f; c += az > 0.5f; c += az > 0.75f; c += az > 1.0625f; c += az > 1.375f; c += az > 1.75f; c += az > 2.25f;
  return c | ((__builtin_bit_cast(unsigned, z) >> 28) & 8u);
}
__device__ __forceinline__ void cvt_rows_i4(const int wave_s, const float* src, unsigned char* dst, float* sc_out, int nrows) {
  const int tid_ = opaque_tid(wave_s);
  const int lane = tid_ & 63;
  const int gw = blockIdx.x * NWAVES + (tid_ >> 6);
  const int nw = gridDim.x * NWAVES;
  for (int r = gw; r < nrows; r += nw) {
    const float4* sp = (const float4*)(src + (size_t)r * 1024 + lane * 16);
    const float4 a0 = sp[0], a1 = sp[1], a2 = sp[2], a3 = sp[3];
    const float xv[16] = {a0.x, a0.y, a0.z, a0.w, a1.x, a1.y, a1.z, a1.w, a2.x, a2.y, a2.z, a2.w, a3.x, a3.y, a3.z, a3.w};
    float ss = 0.f;
#pragma unroll
    for (int i = 0; i < 16; i++) ss += xv[i] * xv[i];
    ss = wsum(ss);
    const float sc = sqrtf(ss * (1.0f / 1024.f)) * U4_STEP;
    const float inv = sc > 0.f ? 1.0f / sc : 0.f;
    unsigned w[2] = {0u, 0u};
#pragma unroll
    for (int i = 0; i < 16; i++) {
      const float f = fminf(fmaxf(floorf(xv[i] * inv), -8.f), 7.f);
      w[i >> 3] |= ((unsigned)(int)f & 15u) << (4 * (i & 7));
    }
    uint2 o; o.x = w[0]; o.y = w[1];
    *(uint2*)(dst + (size_t)r * 512 + lane * 8) = o;
    if (lane == 0) sc_out[2 * r] = sc;
  }
}
__device__ __forceinline__ void cvt_rows_v4(const int wave_s, const float* src, unsigned char* dst, float* sc_out, int nrows) {
  const int tid_ = opaque_tid(wave_s);
  const int lane = tid_ & 63;
  const int gw = blockIdx.x * NWAVES + (tid_ >> 6);
  const int nw = gridDim.x * NWAVES;
  for (int r = gw; r < nrows; r += nw) {
    const float4* sp = (const float4*)(src + (size_t)r * 1024 + lane * 16);
    const float4 a0 = sp[0], a1 = sp[1], a2 = sp[2], a3 = sp[3];
    const float xv[16] = {a0.x, a0.y, a0.z, a0.w, a1.x, a1.y, a1.z, a1.w, a2.x, a2.y, a2.z, a2.w, a3.x, a3.y, a3.z, a3.w};
    float ss = 0.f;
#pragma unroll
    for (int i = 0; i < 16; i++) ss += xv[i] * xv[i];
    ss = wsum(ss);
    const float sc = sqrtf(ss * (1.0f / 1024.f)) * V4_ROWSCALE;
    const float inv = sc > 0.f ? 1.0f / sc : 0.f;
    unsigned w[2] = {0u, 0u};
#pragma unroll
    for (int i = 0; i < 16; i++) w[i >> 3] |= enc_v4(xv[i] * inv) << (4 * (i & 7));
    uint2 o; o.x = w[0]; o.y = w[1];
    *(uint2*)(dst + (size_t)r * 512 + lane * 8) = o;
    if (lane == 0) sc_out[2 * r] = sc;
  }
}

#define GEMM_F32(Aptr, Wt, Cptr, Rptr, M_, N_) do { \
    pg8::Gemm g_{opq((const bf16*)(Aptr)), opq((const bf16*)(Wt)), (M_), (N_), DM}; pg8::StaticOrder S_; S_.init((M_), (N_), (int)gridDim.x, (int)blockIdx.x); \
    pg8::EpiF32R E_{opq((float*)(Cptr)), opq((const float*)(Rptr)), (N_)}; \
    pg8::gemm_phase<pg8::EpiF32R, pg8::StaticOrder, true, true>(wave_s, ldsl, g_, S_, E_); } while (0)
#define GEMM_BF16_C(Aptr, Wt, Optr, M_, N_, C_) do { \
    pg8::Gemm g_{opq((const bf16*)(Aptr)), opq((const bf16*)(Wt)), (M_), (N_), DM}; pg8::StaticOrder S_; S_.init((M_), (N_), (int)gridDim.x, (C_)); \
    pg8::EpiBf16 E_{opq((bf16*)(Optr)), (N_)}; \
    pg8::gemm_phase<pg8::EpiBf16, pg8::StaticOrder, true, true>(wave_s, ldsl, g_, S_, E_); } while (0)
#define GEMM_BF16(Aptr, Wt, Optr, M_, N_) GEMM_BF16_C(Aptr, Wt, Optr, M_, N_, (int)blockIdx.x)
#define GEMM_F32RN(Aptr, Wt, Cptr, Rptr, XGptr, Gptr, STptr) do { \
    pg8::Gemm g_{opq((const bf16*)(Aptr)), opq((const bf16*)(Wt)), NT, DM, DM}; pg8::StaticOrder S_; S_.init(NT, DM, (int)gridDim.x, (int)blockIdx.x); \
    pg8::EpiF32RN E_{opq((float*)(Cptr)), opq((const float*)(Rptr)), DM, opq((bf16*)(XGptr)), opq((const float*)(Gptr)), opq((float*)(STptr))}; \
    pg8::gemm_phase<pg8::EpiF32RN, pg8::StaticOrder, true, true>(wave_s, ldsl, g_, S_, E_); } while (0)
#define GEMM_BF16S(Aptr, Wt, Optr, N_, STptr) do { \
    pg8::Gemm g_{opq((const bf16*)(Aptr)), opq((const bf16*)(Wt)), NT, (N_), DM}; pg8::StaticOrder S_; S_.init(NT, (N_), (int)gridDim.x, (int)blockIdx.x); \
    pg8::EpiBf16S E_{opq((bf16*)(Optr)), (N_), opq((const float*)(STptr))}; \
    pg8::gemm_phase<pg8::EpiBf16S, pg8::StaticOrder, true, true>(wave_s, ldsl, g_, S_, E_); } while (0)

__global__ void __launch_bounds__(NWAVES * 64, 2) fwd_megakernel(Params p) {
  extern __shared__ __attribute__((aligned(16))) unsigned char lds[];
  LAS unsigned char* ldsl = (LAS unsigned char*)lds;
  LAS float* smem = (LAS float*)ldsl;
  const int wave_s = __builtin_amdgcn_readfirstlane((int)(threadIdx.x >> 6));
  unsigned char* ws = p.ws;
  volatile LAS unsigned* MISC = (volatile LAS unsigned*)(ldsl + (LDS_BYTES - 256));
  if (threadIdx.x < 64) MISC[threadIdx.x] = 0u;
  __syncthreads();
  const XcdBarrier bar = xcd_barrier_post((unsigned*)(ws + WS_CTL) + 4096, MISC + 8);
  float* xw = (float*)(ws + WS_XW);
  bf16* xn = (bf16*)(ws + WS_XN);
  bf16* big = (bf16*)(ws + WS_BIG);
  bf16* y = (bf16*)(ws + WS_Y);
  bf16* memh = (bf16*)(ws + WS_MEMH);
  bf16* kvb = (bf16*)(ws + WS_KVB);
  bf16* vT = (bf16*)(ws + WS_VT);
  float* ssmE = (float*)(ws + WS_SSME);
  float* ssmp = (float*)(ws + WS_SSMP);
  int* ids = (int*)(ws + WS_IDS);
  float* gates = (float*)(ws + WS_GATE);
  bf16* skb = (bf16*)(ws + WS_SKB);
  unsigned char* ub = ws + WS_UB;
  unsigned char* vb = ws + WS_VB;
  float* rst = (float*)(ws + WS_RST);
  float* vsc = (float*)(ws + WS_VSC);
  float* usc = (float*)(ws + WS_USC);

  prologue_transposes(wave_s, p, ws, ldsl);
  cvt_rows_bf16(wave_s, karg_in(27), skb, (size_t)2 * 8 * 2 * 128 * 128);
  cvt_rows_i4(wave_s, karg_in(28), ub, vsc + 1, 2 * 16384);
  cvt_rows_v4(wave_s, karg_in(29), vb, vsc, 2 * 16384);
  for (int l = 0; l < 2; l++)
    rms_rows<true>(wave_s, karg_in(1), karg_in(21) + l * DM, memh + (size_t)l * 1024 * 1024, 1024);
  ssm_params(wave_s, p, ssmp);
  xcd_barrier(bar);
  for (int l = 0; l < 2; l++)
    GEMM_BF16_C(memh + (size_t)l * 1024 * 1024, ws + WS_WT + (size_t)l * WT_LAYER + WT_MKV,
              kvb + (size_t)l * 1024 * 2048, 1024, 2048, (int)((blockIdx.x + gridDim.x - 32u * (unsigned)l) % gridDim.x));

#pragma nounroll
  for (int l = 0; l < 2; l++) {
    const float* xcur = (l == 0) ? karg_in(0) : xw;
    const float* sp = ssmp + (size_t)l * SSMP_PER_LAYER;
    const unsigned char* wl = ws + WS_WT + (size_t)l * WT_LAYER;
    if (l == 0) {
      rms_rows<true>(wave_s, xcur, karg_in(2) + l * DM, xn, NT);
      xcd_barrier(bar);
    }
    GEMM_BF16(xn, wl + WT_IN, big, NT, DIN);
    xcd_barrier(bar);
    if (l == 0) vt_phase(wave_s, kvb, vT);
    ssm_chunk_end(wave_s, sp, big, ssmE, smem);
    attn_phase(wave_s, p, l, big, y, smem);
    conv_phase(wave_s, p, l, big, y, smem);
    xcd_barrier(bar);
    ssm_finish(wave_s, p, l, sp, big, ssmE, y, smem);
    xcd_barrier(bar);
    GEMM_F32RN(y, wl + WT_OUT, xw, xcur, xn, karg_in(20) + l * DM, rst);
    xcd_barrier(bar);
    GEMM_BF16S(xn, wl + WT_MQ, big, DM, rst);
    xcd_barrier(bar);
    memattn_phase(wave_s, big, kvb + (size_t)l * 1024 * 2048, vT + (size_t)l * 4 * 4 * 256 * 256, y, smem);
    xcd_barrier(bar);
    GEMM_F32RN(y, wl + WT_MO, xw, (const float*)xw, xn, karg_in(25) + l * DM, rst);
    xcd_barrier(bar);
    GEMM_BF16S(xn, wl + WT_PQ, big, 2048, rst);
    xcd_barrier(bar);
    peer_topk(wave_s, big, skb + (size_t)l * 8 * 2 * 128 * 128, ids, gates, smem);
    xcd_barrier(bar);
    if (l == 0) {
      peer_gather<false>(wave_s, xn, rst, ub + (size_t)l * 16384 * 512, vb + (size_t)l * 16384 * 512, vsc + (size_t)l * 2 * 16384, usc, ids, gates, xw, karg_in(2) + DM, (float*)nullptr);
      xcd_barrier(bar);
    } else {
      peer_gather<true>(wave_s, xn, rst, ub + (size_t)l * 16384 * 512, vb + (size_t)l * 16384 * 512, vsc + (size_t)l * 2 * 16384, usc, ids, gates, xw, karg_in(30), p.out);
    }
  }
}

extern "C" void kernel_launch(void* const* d_in, const int* in_sizes, int n_in,
                              void* d_out, int out_size, void* d_ws, size_t ws_size,
                              hipStream_t stream) {
  static int grid_blocks = 0;
  if (!grid_blocks) {
    int dev = 0, cus = 0, per_cu = 0;
    (void)hipGetDevice(&dev);
    (void)hipDeviceGetAttribute(&cus, hipDeviceAttributeMultiprocessorCount, dev);
    (void)hipFuncSetAttribute((const void*)fwd_megakernel, hipFuncAttributeMaxDynamicSharedMemorySize, LDS_BYTES);
    (void)hipOccupancyMaxActiveBlocksPerMultiprocessor(&per_cu, fwd_megakernel, NWAVES * 64, LDS_BYTES);
    if (per_cu < 1) fprintf(stderr, "occupancy query reports %d blocks/CU\n", per_cu);
    grid_blocks = cus;
  }
  (void)hipMemsetAsync((char*)d_ws + WS_CTL, 0, 1 * MiB, stream);
  Params p{};
  for (int i = 0; i < 31; i++) p.in[i] = (const float*)d_in[i];
  p.out = (float*)d_out;
  p.ws = (unsigned char*)d_ws;
  void* args[] = {&p};
  hipError_t e = hipLaunchCooperativeKernel((void*)fwd_megakernel, dim3(grid_blocks), dim3(NWAVES * 64),
                                            args, LDS_BYTES, stream);
  if (e != hipSuccess)
    fprintf(stderr, "cooperative launch failed: %s (grid %d)\n", hipGetErrorString(e), grid_blocks);
}
```

```cpp
#include <hip/hip_runtime.h>
#include <hip/hip_cooperative_groups.h>
#include <cstdio>
namespace cg = cooperative_groups;

#define NT 16384
#define SEQ 4096
#define DM 1024
#define DIN 2304
#define NMEM 256
#define EPSF 1e-6f
#define NWAVES 8
#define LDS_BYTES 147456

typedef unsigned short bf16;
#define LAS __attribute__((address_space(3)))

struct Params {
  const float* in[31];
  float* out;
  unsigned char* ws;
};
typedef __attribute__((address_space(4))) const unsigned char* kaptr_t;
__device__ __forceinline__ const float* karg_in(int i) {
  kaptr_t ka = (kaptr_t)__builtin_amdgcn_kernarg_segment_ptr();
  asm volatile("" : "+s"(ka));
  return *(const float* __attribute__((address_space(4))) const*)(ka + 8 * i);
}

constexpr size_t MiB = 1u << 20;
constexpr size_t WS_CTL  = 0;
constexpr size_t WS_WT   = 1 * MiB;
constexpr size_t WT_IN = 0, WT_OUT = WT_IN + (size_t)DIN * DM * 2, WT_MQ = WT_OUT + (size_t)DM * DM * 2,
                 WT_MKV = WT_MQ + (size_t)DM * DM * 2, WT_MO = WT_MKV + (size_t)2048 * DM * 2,
                 WT_PQ = WT_MO + (size_t)DM * DM * 2, WT_GLU = WT_PQ + (size_t)2048 * DM * 2, WT_LAYER = WT_GLU + (size_t)256 * 256 * 2;
constexpr size_t WS_XW   = WS_WT + 2 * WT_LAYER;
constexpr size_t WS_XN   = WS_XW + (size_t)NT * DM * 4;
constexpr size_t WS_BIG  = WS_XN + (size_t)NT * DM * 2;
constexpr size_t WS_Y    = WS_BIG + (size_t)NT * DIN * 2;
constexpr size_t WS_MEMH = WS_Y + (size_t)NT * DM * 2;
constexpr size_t WS_KVB  = WS_MEMH + (size_t)2 * 1024 * 1024 * 2;
constexpr size_t WS_VT   = WS_KVB + (size_t)2 * 1024 * 2048 * 2;
constexpr size_t WS_SSME = WS_VT + (size_t)2 * 4 * 4 * 256 * 256 * 2;
#define SSMP_PER_LAYER (2048 + 2048 + 32768)
constexpr size_t WS_SSMP = WS_SSME + (size_t)4 * 64 * 16 * 64 * 2 * 4;
constexpr size_t WS_IDS  = WS_SSMP + (size_t)2 * SSMP_PER_LAYER * 4;
constexpr size_t WS_GATE = WS_IDS + (size_t)NT * 128 * 4;
constexpr size_t WS_SKB  = WS_GATE + (size_t)NT * 128 * 4;
constexpr size_t WS_UB   = WS_SKB + (size_t)2 * 8 * 2 * 128 * 128 * 2;
constexpr size_t WS_VB   = WS_UB + (size_t)2 * 16384 * 512;
constexpr size_t WS_VSC  = WS_VB + (size_t)2 * 16384 * 512;
constexpr size_t WS_USC  = WS_VSC + (size_t)2 * 16384 * 4;
constexpr size_t WS_RST  = WS_USC + (size_t)2 * 16384 * 4;
constexpr size_t WS_END  = WS_RST + (size_t)NT * 16 * 4;
#define U_SCALE 64.0f
#define U4_STEP 0.3352f
#define V4_LUT_LO 0x3B393630u
#define V4_LUT_HI 0x41403E3Du
#define V4_ROWSCALE 1.075f
static_assert(WS_END <= 512 * MiB, "workspace");
static_assert(WT_LAYER % 256 == 0 && WS_SSMP % 16 == 0 && WS_IDS % 16 == 0 && WS_SKB % 256 == 0 && WS_VT % 256 == 0, "align");

__device__ __forceinline__ int opaque_tid(int wave_s) { int v = wave_s * 64 + (int)__builtin_amdgcn_mbcnt_hi(~0u, __builtin_amdgcn_mbcnt_lo(~0u, 0u)); asm volatile("" : "+v"(v)); return v; }
__device__ __forceinline__ unsigned f2bf(float f) { unsigned u = __builtin_bit_cast(unsigned, f); return (u + 0x7fffu + ((u >> 16) & 1u)) >> 16; }
__device__ __forceinline__ unsigned pk2(float lo, float hi) { return f2bf(lo) | (f2bf(hi) << 16); }
__device__ __forceinline__ float bf_lo(unsigned u) { return __builtin_bit_cast(float, u << 16); }
__device__ __forceinline__ float bf_hi(unsigned u) { return __builtin_bit_cast(float, u & 0xffff0000u); }
__device__ __forceinline__ float bf2f(bf16 h) { return __builtin_bit_cast(float, (unsigned)h << 16); }


#define XB_TMO      128
#define XB_XCNT(j)  (256  + 64 * (j))
#define XB_XSUB(j)  (1280 + 64 * (j))
#define XB_XGEN(j)  (2304 + 64 * (j))
#define XB_TOP      3328
#define XB_TOPGEN   3392
#define XCD_BAR_WORDS 3456
#define XB_SPIN_CAP (1u << 22)
__device__ __forceinline__ unsigned xb_ld(unsigned* p)              { return __hip_atomic_load(p, __ATOMIC_RELAXED, __HIP_MEMORY_SCOPE_AGENT); }
__device__ __forceinline__ unsigned xb_add(unsigned* p, unsigned v) { return __hip_atomic_fetch_add(p, v, __ATOMIC_RELAXED, __HIP_MEMORY_SCOPE_AGENT); }
__device__ __forceinline__ unsigned xb_xcc_id() { return (unsigned)__builtin_amdgcn_s_getreg((3 << 11) | 20) & 0xFu; }
#define XB_SPIN(cond, bar) do { unsigned _sp = 0; while (cond) { __builtin_amdgcn_s_sleep(1); \
    if ((++_sp & 255u) == 0u) { if (xb_ld(&(bar)[XB_TMO])) break; if (_sp > XB_SPIN_CAP) { atomicAdd(&(bar)[XB_TMO], 1u); break; } } } } while (0)
struct XcdBarrier { unsigned* bar; unsigned x; volatile LAS unsigned* st; };
__device__ __forceinline__ XcdBarrier xcd_barrier_post(unsigned* bar, volatile LAS unsigned* st) {
    XcdBarrier b; b.bar = bar; b.x = xb_xcc_id(); b.st = st;
    if (threadIdx.x == 0) (void)xb_add(&bar[XB_XCNT(b.x)], 1u);
    return b;
}
__device__ __forceinline__ void xcd_barrier_complete(unsigned* bar, unsigned x, unsigned& nloc, unsigned& nx) {
    const unsigned G = gridDim.x * gridDim.y * gridDim.z;
    unsigned sum, cnt, mine, sp = 0u;
    for (;;) {
        sum = 0u; cnt = 0u; mine = 0u;
#pragma unroll
        for (unsigned j = 0; j < 16; ++j) { const unsigned c = xb_ld(&bar[XB_XCNT(j)]); sum += c; cnt += (c > 0u) ? 1u : 0u; mine = (j == x) ? c : mine; }
        if (sum == G) break;
        __builtin_amdgcn_s_sleep(1);
        if ((++sp & 255u) == 0u) { if (xb_ld(&bar[XB_TMO])) break; if (sp > XB_SPIN_CAP) { atomicAdd(&bar[XB_TMO], 1u); break; } }
    }
    nloc = mine > 0u ? mine : 1u; nx = cnt > 0u ? cnt : 1u;
}
__device__ __forceinline__ void xcd_barrier(const XcdBarrier& b) {
    asm volatile("s_waitcnt vmcnt(0)" ::: "memory");
    __syncthreads();
    if (threadIdx.x == 0) {
        unsigned* bar = b.bar;
        __builtin_amdgcn_s_waitcnt(0);
        unsigned nloc = b.st[0], nx = b.st[1];
        if (nloc == 0u) { xcd_barrier_complete(bar, b.x, nloc, nx); b.st[0] = nloc; b.st[1] = nx; }
        const unsigned old = xb_add(&bar[XB_XSUB(b.x)], 1u);
        const unsigned gen = old / nloc;
        if (old + 1u == (gen + 1u) * nloc) {
            __builtin_amdgcn_fence(__ATOMIC_RELEASE, "agent");
            asm volatile("s_waitcnt vmcnt(0)" ::: "memory");
            const unsigned og = xb_add(&bar[XB_TOP], 1u);
            const unsigned tg = og / nx;
            if (og + 1u == (tg + 1u) * nx) xb_add(&bar[XB_TOPGEN], 1u);
            else XB_SPIN(xb_ld(&bar[XB_TOPGEN]) == tg, bar);
            __builtin_amdgcn_fence(__ATOMIC_ACQUIRE, "agent");
            xb_add(&bar[XB_XGEN(b.x)], 1u);
            asm volatile("s_waitcnt vmcnt(0)" ::: "memory");
        } else {
            XB_SPIN(xb_ld(&bar[XB_XGEN(b.x)]) == gen, bar);
            __builtin_amdgcn_fence(__ATOMIC_ACQUIRE, "agent");
            asm volatile("s_waitcnt vmcnt(0)" ::: "memory");
        }
    }
    __syncthreads();
}

namespace pg8 {
#define PG8_LAS __attribute__((address_space(3)))
typedef unsigned short bf16_t;
typedef short bf16x8 __attribute__((ext_vector_type(8)));
typedef float f32x4 __attribute__((ext_vector_type(4)));
typedef unsigned u32x4 __attribute__((ext_vector_type(4)));
constexpr int BM = 256, BK = 64, HALF = 128, HTB = HALF * BK * 2, STAGE_BYTES = 8 * HTB, NXCD = 8, WGM = 8;
__host__ __device__ __forceinline__ int lds_byte(int r, int c) { const int st = (r >> 4) * 2 + (c >> 5), rr = r & 15, cc = c & 31, ob = rr * 64 + cc * 2; return st * 1024 + (ob ^ (((ob >> 9) & 1) << 5)); }
__host__ __device__ __forceinline__ void stage_rc(int b, int& R, int& C) { const int st = b / 1024, sb = b % 1024, swz = sb ^ (((sb >> 9) & 1) << 5); R = (st >> 1) * 16 + swz / 64; C = (st & 1) * 32 + (swz % 64) / 2; }
__host__ __device__ __forceinline__ int perm32(int rho) { const int n = rho >> 4, i = rho & 15; return 8 * (i >> 2) + 4 * n + (i & 3); }
struct Unit { int pm, pn; };
struct Gemm { const bf16_t* A; const bf16_t* Bt; int M, N, K; };
struct StaticOrder {
    int nM, nN, nwg, G, c;
    __host__ __device__ __forceinline__ void init(int M, int N, int G_, int c_) { nM = M / BM; nN = N / BM; nwg = nM * nN; G = G_; c = c_; }
    __host__ __device__ bool next(int i, Unit& u) const {
        const long L = (long)i * G + c; if (L >= nwg) return false;
        int wgid = (int)L; { const int q = nwg / NXCD, r = nwg % NXCD, xcd = wgid % NXCD, off = wgid / NXCD; wgid = (xcd < r ? xcd * (q + 1) : r * (q + 1) + (xcd - r) * q) + off; }
        const int nig = WGM * nN, gid = wgid / nig, fm = gid * WGM, gsz = (nM - fm) < WGM ? (nM - fm) : WGM;
        u.pm = fm + ((wgid % nig) % gsz); u.pn = (wgid % nig) / gsz; return true;
    }
    __device__ __forceinline__ void a_ready(const Unit&) const {}
    __device__ __forceinline__ void done(const Unit&) const {}
};
__device__ __forceinline__ unsigned cvt_pk_bf16(float lo, float hi) { unsigned r; asm volatile("v_cvt_pk_bf16_f32 %0, %1, %2" : "=v"(r) : "v"(lo), "v"(hi)); return r; }

struct EpiF32R {
    static constexpr bool PERM = false, AFTER_DRAIN = false;
    float* C; const float* R; int ldc;
    __device__ __forceinline__ void operator()(const f32x4 (&acc)[2][2][4][2], const Unit& u, int wr, int wc, int fr, int fq) const {
        const int row0 = u.pm * BM + wr * 64 + fr, col0 = u.pn * BM + wc * 32 + 4 * fq;
#pragma unroll
        for (int ai = 0; ai < 2; ++ai)
#pragma unroll
            for (int m = 0; m < 4; ++m) {
                const size_t ro = (size_t)(row0 + ai * HALF + m * 16) * ldc + col0;
                f32x4 rv[2][2];
#pragma unroll
                for (int bj = 0; bj < 2; ++bj)
#pragma unroll
                    for (int n = 0; n < 2; ++n) rv[bj][n] = R ? *(const f32x4*)(R + ro + bj * HALF + n * 16) : (f32x4){0.f, 0.f, 0.f, 0.f};
#pragma unroll
                for (int bj = 0; bj < 2; ++bj)
#pragma unroll
                    for (int n = 0; n < 2; ++n) *(f32x4*)(C + ro + bj * HALF + n * 16) = acc[ai][bj][m][n] + rv[bj][n];
                __builtin_amdgcn_sched_barrier(0);
            }
    }
};

struct EpiBf16 {
    static constexpr bool PERM = true, AFTER_DRAIN = false;
    bf16_t* O; int ldc;
    __device__ __forceinline__ void operator()(const f32x4 (&acc)[2][2][4][2], const Unit& u, int wr, int wc, int fr, int fq) const {
        const int row0 = u.pm * BM + wr * 64 + fr, col0 = u.pn * BM + wc * 32 + 8 * fq;
#pragma unroll
        for (int ai = 0; ai < 2; ++ai)
#pragma unroll
            for (int m = 0; m < 4; ++m) { bf16_t* rowp = O + (size_t)(row0 + ai * HALF + m * 16) * ldc + col0;
#pragma unroll
                for (int bj = 0; bj < 2; ++bj) { const f32x4 v0 = acc[ai][bj][m][0], v1 = acc[ai][bj][m][1];
                    u32x4 w; w.x = cvt_pk_bf16(v0[0], v0[1]); w.y = cvt_pk_bf16(v0[2], v0[3]); w.z = cvt_pk_bf16(v1[0], v1[1]); w.w = cvt_pk_bf16(v1[2], v1[3]);
                    *(u32x4*)(rowp + bj * HALF) = w; } }
    }
};

struct EpiF32RN {
    static constexpr bool PERM = false, AFTER_DRAIN = false;
    float* C; const float* R; int ldc; bf16_t* XG; const float* g; float* st;
    __device__ __forceinline__ void operator()(const f32x4 (&acc)[2][2][4][2], const Unit& u, int wr, int wc, int fr, int fq) const {
        const int row0 = u.pm * BM + wr * 64 + fr, col0 = u.pn * BM + wc * 32 + 4 * fq;
        f32x4 gv[2][2];
#pragma unroll
        for (int bj = 0; bj < 2; ++bj)
#pragma unroll
            for (int n = 0; n < 2; ++n) gv[bj][n] = *(const f32x4*)(g + col0 + bj * HALF + n * 16);
#pragma unroll
        for (int ai = 0; ai < 2; ++ai)
#pragma unroll
            for (int m = 0; m < 4; ++m) {
                const int row = row0 + ai * HALF + m * 16;
                const size_t ro = (size_t)row * ldc + col0;
                f32x4 rv[2][2];
#pragma unroll
                for (int bj = 0; bj < 2; ++bj)
#pragma unroll
                    for (int n = 0; n < 2; ++n) rv[bj][n] = *(const f32x4*)(R + ro + bj * HALF + n * 16);
                float ss = 0.f;
#pragma unroll
                for (int bj = 0; bj < 2; ++bj)
#pragma unroll
                    for (int n = 0; n < 2; ++n) {
                        const f32x4 v = acc[ai][bj][m][n] + rv[bj][n];
                        *(f32x4*)(C + ro + bj * HALF + n * 16) = v;
                        ss += (v[0] * v[0] + v[1] * v[1]) + (v[2] * v[2] + v[3] * v[3]);
                        const f32x4 w = v * gv[bj][n];
                        uint2 pk; pk.x = cvt_pk_bf16(w[0], w[1]); pk.y = cvt_pk_bf16(w[2], w[3]);
                        *(uint2*)(XG + ro + bj * HALF + n * 16) = pk;
                    }
                ss += __shfl_xor(ss, 16, 64); ss += __shfl_xor(ss, 32, 64);
                if (fq == 0) st[(size_t)row * 16 + u.pn * 4 + wc] = ss;
                __builtin_amdgcn_sched_barrier(0);
            }
    }
};
struct EpiBf16S {
    static constexpr bool PERM = true, AFTER_DRAIN = false;
    bf16_t* O; int ldc; const float* st;
    __device__ __forceinline__ void operator()(const f32x4 (&acc)[2][2][4][2], const Unit& u, int wr, int wc, int fr, int fq) const {
        const int row0 = u.pm * BM + wr * 64 + fr, col0 = u.pn * BM + wc * 32 + 8 * fq;
#pragma unroll
        for (int ai = 0; ai < 2; ++ai)
#pragma unroll
            for (int m = 0; m < 4; ++m) {
                const int row = row0 + ai * HALF + m * 16;
                const f32x4* sp = (const f32x4*)(st + (size_t)row * 16);
                const f32x4 s0 = sp[0], s1 = sp[1], s2 = sp[2], s3 = sp[3];
                const f32x4 sa = (s0 + s1) + (s2 + s3);
                const float rs = __builtin_amdgcn_rsqf(((sa[0] + sa[1]) + (sa[2] + sa[3])) * (1.0f / 1024.f) + 1e-6f);
                bf16_t* rowp = O + (size_t)row * ldc + col0;
#pragma unroll
                for (int bj = 0; bj < 2; ++bj) { const f32x4 v0 = acc[ai][bj][m][0] * rs, v1 = acc[ai][bj][m][1] * rs;
                    u32x4 w; w.x = cvt_pk_bf16(v0[0], v0[1]); w.y = cvt_pk_bf16(v0[2], v0[3]); w.z = cvt_pk_bf16(v1[0], v1[1]); w.w = cvt_pk_bf16(v1[2], v1[3]);
                    *(u32x4*)(rowp + bj * HALF) = w; }
                __builtin_amdgcn_sched_barrier(0);
            }
    }
};

template <class Epi, class Sched, bool ALIGN_EPI = false, bool SP2 = false>
__device__ __forceinline__ void gemm_phase(const int wave_s, PG8_LAS unsigned char* lds, const Gemm g, const Sched& S, const Epi& E) {
    const int tid = opaque_tid(wave_s), wid = __builtin_amdgcn_readfirstlane(tid >> 6), lane = tid & 63, wr = wid >> 2, wc = wid & 3, fr = lane & 15, fq = lane >> 4;
    const int K = g.K, nt = K / BK;
    unsigned voffA[2], voffB[2];
#pragma unroll
    for (int i = 0; i < 2; ++i) { int R, C; stage_rc(tid * 16 + i * 8192, R, C); const int Rb = Epi::PERM ? ((R & ~31) + perm32(R & 31)) : R;
        voffA[i] = (unsigned)(R * K + C) * 2u; voffB[i] = (unsigned)(Rb * K + C) * 2u; }
    const size_t kstep = (size_t)(BK * 2);
    const size_t hstep = (size_t)HALF * K * 2;
    const size_t tstep = 2 * hstep;
    const unsigned ldsw = (unsigned)wid * 1024u;
    const int aoff = lds_byte(wr * 64 + fr, fq * 8), boff = lds_byte(wc * 32 + fr, fq * 8);
#define PG8_SA(b, h) (((b) * 2 + (h)) * HTB)
#define PG8_SB(b, h) ((4 + (b) * 2 + (h)) * HTB)
#define PG8_STAGE(bufoff, gbase, voff) do { _Pragma("unroll") for (int _i = 0; _i < 2; ++_i) \
        __builtin_amdgcn_global_load_lds((const unsigned*)((const char*)(gbase) + (voff)[_i]), (PG8_LAS unsigned*)(lds + (bufoff) + ldsw + _i * 8192), 16, 0, 0); } while (0)
#define PG8_LDA(dst, b, h) do { _Pragma("unroll") for (int m = 0; m < 4; ++m) _Pragma("unroll") for (int k = 0; k < 2; ++k) dst[m][k] = *(const PG8_LAS bf16x8*)(lds + PG8_SA(b, h) + aoff + m * 2048 + k * 1024); } while (0)
#define PG8_LDB(dst, b, h) do { _Pragma("unroll") for (int n = 0; n < 2; ++n) _Pragma("unroll") for (int k = 0; k < 2; ++k) dst[n][k] = *(const PG8_LAS bf16x8*)(lds + PG8_SB(b, h) + boff + n * 2048 + k * 1024); } while (0)
#define PG8_MMA(ai, bj, At, Bt) do { __builtin_amdgcn_s_setprio(1); _Pragma("unroll") for (int m = 0; m < 4; ++m) _Pragma("unroll") for (int n = 0; n < 2; ++n) _Pragma("unroll") for (int k = 0; k < 2; ++k) \
        acc[ai][bj][m][n] = __builtin_amdgcn_mfma_f32_16x16x32_bf16(Bt[n][k], At[m][k], acc[ai][bj][m][n], 0, 0, 0); __builtin_amdgcn_s_setprio(0); } while (0)
#define PG8_WAIT_V(n) asm volatile("s_waitcnt vmcnt(" #n ")" ::: "memory")
#define PG8_WAIT_L(n) asm volatile("s_waitcnt lgkmcnt(" #n ")" ::: "memory")
#define PG8_BAR __builtin_amdgcn_s_barrier()
#define PG8_SCHED __builtin_amdgcn_sched_barrier(0)
    Unit cur, nxt; int ui = 0;
    if (!S.next(0, cur)) return;
    f32x4 acc[2][2][4][2];
#pragma unroll
    for (int a = 0; a < 2; ++a)
#pragma unroll
        for (int b = 0; b < 2; ++b)
#pragma unroll
            for (int m = 0; m < 4; ++m)
#pragma unroll
                for (int n = 0; n < 2; ++n) acc[a][b][m][n] = (f32x4){0.f, 0.f, 0.f, 0.f};
    bf16x8 At[4][2], B0[2][2], B1[2][2];
    const char* cA = (const char*)g.A + (size_t)cur.pm * tstep; const char* cB = (const char*)g.Bt + (size_t)cur.pn * tstep;
    S.a_ready(cur);
    if constexpr (SP2) {
        PG8_STAGE(PG8_SB(0, 0), cB, voffB); PG8_STAGE(PG8_SB(0, 1), cB + hstep, voffB); PG8_STAGE(PG8_SA(0, 0), cA, voffA); PG8_STAGE(PG8_SA(0, 1), cA + hstep, voffA);
        if (wr == 1) PG8_BAR;
        PG8_WAIT_V(2); PG8_BAR;
        PG8_STAGE(PG8_SB(1, 0), cB + kstep, voffB); PG8_STAGE(PG8_SA(1, 0), cA + kstep, voffA); PG8_STAGE(PG8_SB(1, 1), cB + hstep + kstep, voffB);
        PG8_WAIT_V(6); PG8_BAR;
    } else {
        PG8_STAGE(PG8_SB(0, 0), cB, voffB); PG8_STAGE(PG8_SA(0, 0), cA, voffA); PG8_STAGE(PG8_SB(0, 1), cB + hstep, voffB); PG8_STAGE(PG8_SA(0, 1), cA + hstep, voffA);
        if (wr == 1) PG8_BAR;
        PG8_WAIT_V(4); PG8_BAR;
        PG8_STAGE(PG8_SB(1, 0), cB + kstep, voffB); PG8_STAGE(PG8_SA(1, 0), cA + kstep, voffA); PG8_STAGE(PG8_SB(1, 1), cB + hstep + kstep, voffB);
        PG8_WAIT_V(6); PG8_BAR;
    }
    for (;;) {
        const bool has_next = S.next(ui + 1, nxt);
        const char* nA = has_next ? (const char*)g.A + (size_t)nxt.pm * tstep : cA; const char* nB = has_next ? (const char*)g.Bt + (size_t)nxt.pn * tstep : cB;
        for (int t = 0; t < nt; t += 2) {
            const bool last = (t == nt - 2);
            const char* a1 = cA + (size_t)(t + 1) * kstep;
            const char* a2 = last ? nA : cA + (size_t)(t + 2) * kstep; const char* b2 = last ? nB : cB + (size_t)(t + 2) * kstep;
            const char* a3 = a2 + kstep; const char* b3 = b2 + kstep;
            if (last && has_next) S.a_ready(nxt);
            if constexpr (SP2) {
            PG8_LDB(B0, 0, 0); PG8_LDB(B1, 0, 1); PG8_SCHED; PG8_LDA(At, 0, 0); PG8_STAGE(PG8_SA(1, 1), a1 + hstep, voffA);
            PG8_WAIT_V(8); PG8_WAIT_L(0); PG8_BAR; PG8_MMA(0, 0, At, B0); PG8_MMA(0, 1, At, B1); PG8_BAR; PG8_SCHED;
            PG8_LDA(At, 0, 1); PG8_STAGE(PG8_SB(0, 0), b2, voffB); PG8_STAGE(PG8_SB(0, 1), b2 + hstep, voffB); PG8_STAGE(PG8_SA(0, 0), a2, voffA);
            PG8_WAIT_V(8); PG8_WAIT_L(0); PG8_BAR; PG8_MMA(1, 0, At, B0); PG8_MMA(1, 1, At, B1); PG8_BAR; PG8_SCHED;
            PG8_LDB(B0, 1, 0); PG8_LDB(B1, 1, 1); PG8_SCHED; PG8_LDA(At, 1, 0); PG8_STAGE(PG8_SA(0, 1), a2 + hstep, voffA);
            PG8_WAIT_V(8); PG8_WAIT_L(0); PG8_BAR; PG8_MMA(0, 0, At, B0); PG8_MMA(0, 1, At, B1); PG8_BAR; PG8_SCHED;
            PG8_LDA(At, 1, 1); PG8_STAGE(PG8_SB(1, 0), b3, voffB); PG8_STAGE(PG8_SB(1, 1), b3 + hstep, voffB); PG8_STAGE(PG8_SA(1, 0), a3, voffA);
            PG8_WAIT_V(8); PG8_WAIT_L(0); PG8_BAR; PG8_MMA(1, 0, At, B0); PG8_MMA(1, 1, At, B1); PG8_BAR; PG8_SCHED;
            } else {
            PG8_LDB(B0, 0, 0); PG8_SCHED; PG8_LDA(At, 0, 0); PG8_STAGE(PG8_SA(1, 1), a1 + hstep, voffA);
            PG8_WAIT_L(8); PG8_BAR; PG8_WAIT_L(0); PG8_MMA(0, 0, At, B0); PG8_BAR; PG8_SCHED;
            PG8_LDB(B1, 0, 1); PG8_STAGE(PG8_SB(0, 0), b2, voffB);
            PG8_BAR; PG8_WAIT_L(0); PG8_MMA(0, 1, At, B1); PG8_BAR;
            PG8_LDA(At, 0, 1); PG8_STAGE(PG8_SA(0, 0), a2, voffA);
            PG8_BAR; PG8_WAIT_L(0); PG8_MMA(1, 0, At, B0); PG8_BAR; PG8_SCHED;
            PG8_STAGE(PG8_SB(0, 1), b2 + hstep, voffB);
            PG8_WAIT_V(6); PG8_BAR; PG8_MMA(1, 1, At, B1); PG8_BAR;
            PG8_LDB(B0, 1, 0); PG8_SCHED; PG8_LDA(At, 1, 0); PG8_STAGE(PG8_SA(0, 1), a2 + hstep, voffA);
            PG8_WAIT_L(8); PG8_BAR; PG8_WAIT_L(0); PG8_MMA(0, 0, At, B0); PG8_BAR; PG8_SCHED;
            PG8_LDB(B1, 1, 1); PG8_STAGE(PG8_SB(1, 0), b3, voffB);
            PG8_BAR; PG8_WAIT_L(0); PG8_MMA(0, 1, At, B1); PG8_BAR;
            PG8_LDA(At, 1, 1); PG8_STAGE(PG8_SA(1, 0), a3, voffA);
            PG8_BAR; PG8_WAIT_L(0); PG8_MMA(1, 0, At, B0); PG8_BAR; PG8_SCHED;
            PG8_STAGE(PG8_SB(1, 1), b3 + hstep, voffB);
            PG8_WAIT_V(6); PG8_BAR; PG8_MMA(1, 1, At, B1); PG8_BAR;
            }
        }
        if constexpr (ALIGN_EPI) { if (wr == 0) PG8_BAR; }
        if constexpr (!Epi::AFTER_DRAIN) { E(acc, cur, wr, wc, fr, fq); S.done(cur); }
        if (!has_next) break;
#pragma unroll
        for (int a = 0; a < 2; ++a)
#pragma unroll
            for (int b = 0; b < 2; ++b)
#pragma unroll
                for (int m = 0; m < 4; ++m)
#pragma unroll
                    for (int n = 0; n < 2; ++n) acc[a][b][m][n] = (f32x4){0.f, 0.f, 0.f, 0.f};
        cur = nxt; cA = nA; cB = nB; ++ui;
        if constexpr (ALIGN_EPI) { if (wr == 1) PG8_BAR; }
    }
    PG8_WAIT_V(0);
    if constexpr (!ALIGN_EPI) { if (wr == 0) PG8_BAR; }
    PG8_BAR;
#undef PG8_SA
#undef PG8_SB
#undef PG8_STAGE
#undef PG8_LDA
#undef PG8_LDB
#undef PG8_MMA
#undef PG8_WAIT_V
#undef PG8_WAIT_L
#undef PG8_BAR
#undef PG8_SCHED
}
}

__device__ __forceinline__ void transpose_item(const float* W, int K, int N, bf16* WT, LAS float* scr, int item, int lane) {
    const int nblk = N / 32, kb = item / nblk, nb = item % nblk, k0 = 64 * kb, n0 = 32 * nb;
#pragma unroll 8
    for (int i = 0; i < 32; ++i) { const int kk = 2 * i + (lane >> 5); scr[kk * 33 + (lane & 31)] = W[(size_t)(k0 + kk) * N + n0 + (lane & 31)]; }
    asm volatile("s_waitcnt lgkmcnt(0)" ::: "memory");
    const int c = lane & 7;
#pragma unroll
    for (int j = 0; j < 4; ++j) { const int n = (lane >> 3) + 8 * j; const LAS float* s = scr + (8 * c) * 33 + n;
        uint4 o; o.x = pk2(s[0 * 33], s[1 * 33]); o.y = pk2(s[2 * 33], s[3 * 33]); o.z = pk2(s[4 * 33], s[5 * 33]); o.w = pk2(s[6 * 33], s[7 * 33]);
        *(uint4*)(WT + (size_t)(n0 + n) * K + k0 + 8 * c) = o; }
    asm volatile("s_waitcnt lgkmcnt(0)" ::: "memory");
}

__device__ __forceinline__ float wsum(float v) {
#pragma unroll
  for (int o = 32; o > 0; o >>= 1) v += __shfl_xor(v, o, 64);
  return v;
}
__device__ __forceinline__ float wmaxf(float v) {
#pragma unroll
  for (int o = 32; o > 0; o >>= 1) v = fmaxf(v, __shfl_xor(v, o, 64));
  return v;
}
__device__ __forceinline__ float sigmoidf_(float x) { return 1.0f / (1.0f + expf(-x)); }
__device__ __forceinline__ float gelu_tanh(float x) {
  return 0.5f * x * (1.0f + tanhf(0.7978845608028654f * (x + 0.044715f * x * x * x)));
}

template <bool BF16OUT>
__device__ __forceinline__ void rms_rows(const int wave_s, const float* src, const float* g, void* dstv, int rows) {
  const int tid_ = opaque_tid(wave_s);
  const int lane = tid_ & 63;
  const int gw = blockIdx.x * NWAVES + (tid_ >> 6);
  const int nw = gridDim.x * NWAVES;
  for (int r = gw; r < rows; r += nw) {
    const float4* s4 = (const float4*)(src + (size_t)r * DM);
    float4 v[4];
    float ss = 0.f;
#pragma unroll
    for (int i = 0; i < 4; i++) {
      v[i] = s4[lane + i * 64];
      ss += v[i].x * v[i].x + v[i].y * v[i].y + v[i].z * v[i].z + v[i].w * v[i].w;
    }
    ss = wsum(ss);
    const float rstd = rsqrtf(ss * (1.0f / DM) + EPSF);
    const float4* g4 = (const float4*)g;
#pragma unroll
    for (int i = 0; i < 4; i++) {
      float4 gg = g4[lane + i * 64];
      float4 o;
      o.x = v[i].x * rstd * gg.x; o.y = v[i].y * rstd * gg.y;
      o.z = v[i].z * rstd * gg.z; o.w = v[i].w * rstd * gg.w;
      if (BF16OUT) {
        uint2 pk; pk.x = pk2(o.x, o.y); pk.y = pk2(o.z, o.w);
        ((uint2*)((bf16*)dstv + (size_t)r * DM))[lane + i * 64] = pk;
      } else {
        ((float4*)((float*)dstv + (size_t)r * DM))[lane + i * 64] = o;
      }
    }
  }
}

__device__ __forceinline__ void ssm_params(const int wave_s, const Params& p, float* ssmp_all) {
  const int tid_ = opaque_tid(wave_s);
  const float* in8 = karg_in(8); const float* in9 = karg_in(9); const float* in10 = karg_in(10);
  const float* in11 = karg_in(11); const float* in12 = karg_in(12);
  const int gt = blockIdx.x * blockDim.x + tid_;
  const int nth = gridDim.x * blockDim.x;
  for (int i = gt; i < 2 * 16 * 64; i += nth) {
    const int l = i / 1024, gp = i % 1024, g = gp / 64;
    float* sp = ssmp_all + (size_t)l * SSMP_PER_LAYER;
    const float lre = fminf(in8[l * 1024 + gp], -1e-4f);
    const float lim = in9[l * 1024 + gp];
    const float dt = expf(in10[l * 16 + g]);
    const float er = expf(lre * dt);
    float sn, cs;
    sincosf(lim * dt, &sn, &cs);
    const float br = er * cs, bi = er * sn;
    sp[gp * 2 + 0] = br;
    sp[gp * 2 + 1] = bi;
    float cr = br, ci = bi;
#pragma unroll
    for (int s = 0; s < 6; s++) {
      const float nr = cr * cr - ci * ci, ni = 2.f * cr * ci;
      cr = nr; ci = ni;
    }
    sp[2048 + gp * 2 + 0] = cr;
    sp[2048 + gp * 2 + 1] = ci;
    const float nr = br - 1.0f, ni = bi;
    const float den = lre * lre + lim * lim;
    const float fr = (nr * lre + ni * lim) / den;
    const float fi = (ni * lre - nr * lim) / den;
    for (int h = 0; h < 16; h++) {
      const float bre = in11[((size_t)l * 1024 + gp) * 16 + h];
      const float bim = in12[((size_t)l * 1024 + gp) * 16 + h];
      sp[4096 + ((g * 16 + h) * 64 + (gp & 63)) * 2 + 0] = fr * bre - fi * bim;
      sp[4096 + ((g * 16 + h) * 64 + (gp & 63)) * 2 + 1] = fr * bim + fi * bre;
    }
  }
}

__device__ __forceinline__ void conv_phase(const int wave_s, const Params& p, int l, const bf16* proj, bf16* y, LAS float* smem) {
  const int tid_ = opaque_tid(wave_s);
  const int lane = tid_ & 63;
  const int gw = blockIdx.x * NWAVES + (tid_ >> 6);
  const int nw = gridDim.x * NWAVES;
  const float* cw = karg_in(4) + (size_t)l * 31 * 256;
  const float4 cb = ((const float4*)(karg_in(5) + l * 256))[lane];
  const float4 lg = ((const float4*)(karg_in(6) + l * 256))[lane];
  const float4 lb = ((const float4*)(karg_in(7) + l * 256))[lane];
  const float4 gg = ((const float4*)(karg_in(18) + l * 1024))[lane];
  LAS float* cwl = smem + 1024;
  for (int i = tid_; i < 31 * 256 / 4; i += NWAVES * 64) *(LAS pg8::f32x4*)(cwl + 4 * i) = *(const pg8::f32x4*)(cw + 4 * i);
  __syncthreads();
  for (int it = gw; it < NT / 8; it += nw) {
    const int tok0 = it * 8;
    const int t0 = tok0 & (SEQ - 1);
    float4 acc[8];
#pragma unroll
    for (int o = 0; o < 8; o++) acc[o] = cb;
#pragma unroll
    for (int i = 0; i < 38; i++) {
      if (t0 - 30 + i >= 0) {
        const bf16* row = proj + (size_t)(tok0 - 30 + i) * DIN;
        const uint2 vp = ((const uint2*)row)[lane];
        const uint2 gp = ((const uint2*)(row + 256))[lane];
        float4 g4;
        g4.x = bf_lo(vp.x) * sigmoidf_(bf_lo(gp.x)); g4.y = bf_hi(vp.x) * sigmoidf_(bf_hi(gp.x));
        g4.z = bf_lo(vp.y) * sigmoidf_(bf_lo(gp.y)); g4.w = bf_hi(vp.y) * sigmoidf_(bf_hi(gp.y));
#pragma unroll
        for (int o = 0; o < 8; o++) {
          const int j = i - o;
          if (j >= 0 && j <= 30) {
            const pg8::f32x4 w4 = *(const LAS pg8::f32x4*)(cwl + j * 256 + lane * 4);
            acc[o].x += g4.x * w4[0]; acc[o].y += g4.y * w4[1];
            acc[o].z += g4.z * w4[2]; acc[o].w += g4.w * w4[3];
          }
        }
      }
    }
#pragma unroll
    for (int o = 0; o < 8; o++) {
      const float4 a = acc[o];
      const float mean = wsum(a.x + a.y + a.z + a.w) * (1.0f / 256.f);
      const float dx = a.x - mean, dy = a.y - mean, dz = a.z - mean, dw = a.w - mean;
      const float var = wsum(dx * dx + dy * dy + dz * dz + dw * dw) * (1.0f / 256.f);
      const float rs = rsqrtf(var + EPSF);
      float4 s;
      s.x = dx * rs * lg.x + lb.x; s.y = dy * rs * lg.y + lb.y;
      s.z = dz * rs * lg.z + lb.z; s.w = dw * rs * lg.w + lb.w;
      s.x = s.x * sigmoidf_(s.x); s.y = s.y * sigmoidf_(s.y);
      s.z = s.z * sigmoidf_(s.z); s.w = s.w * sigmoidf_(s.w);
      const float ss = wsum(s.x * s.x + s.y * s.y + s.z * s.z + s.w * s.w) * (1.0f / 256.f);
      const float r2 = rsqrtf(ss + EPSF);
      uint2 pk; pk.x = pk2(s.x * r2 * gg.x, s.y * r2 * gg.y); pk.y = pk2(s.z * r2 * gg.z, s.w * r2 * gg.w);
      ((uint2*)(y + (size_t)(tok0 + o) * DM))[lane] = pk;
    }
  }
}

typedef short bf16x8_t __attribute__((ext_vector_type(8)));
typedef float f32x16_t __attribute__((ext_vector_type(16)));
#define MFMA_PAD() do { __builtin_amdgcn_sched_barrier(0); asm volatile("s_nop 15\n\ts_nop 15" ::: "memory"); __builtin_amdgcn_sched_barrier(0); } while (0)

__device__ __forceinline__ void attn_phase(const int wave_s, const Params& p, int l, const bf16* proj, bf16* y, LAS float* smem) {
  const int tid = opaque_tid(wave_s), lane = tid & 63, wave = tid >> 6;
  const int n = lane & 31, hh = lane >> 5;
  const float* gg = karg_in(18) + l * 1024 + 256 + wave * 64;
  const float g0 = gg[n], g1 = gg[32 + n];
  LAS float* ssq = smem;
  LAS float* rstd = smem + 256;
  for (int item = blockIdx.x; item < 4 * 128; item += gridDim.x) {
    const int b = item >> 7, q0 = (item & 127) * 32;
    const size_t tokb = (size_t)b * SEQ;
    bf16x8_t qf[4];
    {
      const bf16* qrow = proj + (tokb + q0 + n) * DIN + 512 + wave * 64 + 8 * hh;
#pragma unroll
      for (int ks = 0; ks < 4; ks++) qf[ks] = *(const bf16x8_t*)(qrow + 16 * ks);
    }
    f32x16_t o0, o1;
#pragma unroll
    for (int r = 0; r < 16; r++) { o0[r] = 0.f; o1[r] = 0.f; }
    float R = 0.f;
    for (int kt = q0; kt >= 0; kt -= 32) {
      bf16x8_t kf[4];
      {
        const bf16* krow = proj + (tokb + kt + n) * DIN + 1024 + wave * 64 + 8 * hh;
#pragma unroll
        for (int ks = 0; ks < 4; ks++) kf[ks] = *(const bf16x8_t*)(krow + 16 * ks);
      }
      bf16x8_t vf0[2], vf1[2];
      {
        const bf16* vb = proj + (tokb + kt + 4 * hh) * DIN + 1536 + wave * 64 + n;
#pragma unroll
        for (int s = 0; s < 2; s++)
#pragma unroll
          for (int j = 0; j < 8; j++) {
            const int key = 16 * s + 8 * (j >> 2) + (j & 3);
            vf0[s][j] = (short)vb[(size_t)key * DIN];
            vf1[s][j] = (short)vb[(size_t)key * DIN + 32];
          }
      }
      f32x16_t sacc;
#pragma unroll
      for (int r = 0; r < 16; r++) sacc[r] = 0.f;
      __builtin_amdgcn_sched_barrier(0); asm volatile("s_nop 15\n\ts_nop 15" ::: "memory"); __builtin_amdgcn_sched_barrier(0);
#pragma unroll
      for (int ks = 0; ks < 4; ks++) sacc = __builtin_amdgcn_mfma_f32_32x32x16_bf16(kf[ks], qf[ks], sacc, 0, 0, 0);
      __builtin_amdgcn_sched_barrier(0); asm volatile("s_nop 15\n\ts_nop 15" ::: "memory"); __builtin_amdgcn_sched_barrier(0);
      float lst[16], lsz[16];
      const bool diag = (kt == q0);
#pragma unroll
      for (int r = 0; r < 16; r++) {
        const float z = sacc[r] * 0.125f;
        const float sp = __logf(1.0f + __expf(-fabsf(z)));
        float a = fminf(z, 0.f) - sp;
        float c = -(fmaxf(z, 0.f) + sp);
        if (diag) {
          const int key = (r & 3) + 8 * (r >> 2) + 4 * hh;
          if (key >= n) { a = -1.0e30f; c = 0.f; }
        }
        lsz[r] = a; lst[r] = c;
      }
      float Gs[4], Gp[4];
#pragma unroll
      for (int g = 0; g < 4; g++) {
        Gs[g] = (lst[4 * g] + lst[4 * g + 1]) + (lst[4 * g + 2] + lst[4 * g + 3]);
        Gp[g] = __shfl_xor(Gs[g], 32, 64);
      }
      float carry[4];
      {
        float after = R;
#pragma unroll
        for (int g = 3; g >= 0; g--) {
          carry[g] = after + (hh ? 0.f : Gp[g]);
          after += Gs[g] + Gp[g];
        }
        R = after;
      }
      bf16x8_t pf[2];
#pragma unroll
      for (int g = 0; g < 4; g++) {
        float run = carry[g];
        float a3 = __expf(lsz[4 * g + 3] + run); run += lst[4 * g + 3];
        float a2 = __expf(lsz[4 * g + 2] + run); run += lst[4 * g + 2];
        float a1 = __expf(lsz[4 * g + 1] + run); run += lst[4 * g + 1];
        float a0 = __expf(lsz[4 * g + 0] + run);
        const int s = g >> 1, jb = (g & 1) * 4;
        pf[s][jb + 0] = (short)f2bf(a0); pf[s][jb + 1] = (short)f2bf(a1);
        pf[s][jb + 2] = (short)f2bf(a2); pf[s][jb + 3] = (short)f2bf(a3);
      }
      __builtin_amdgcn_sched_barrier(0); asm volatile("s_nop 15\n\ts_nop 15" ::: "memory"); __builtin_amdgcn_sched_barrier(0);
#pragma unroll
      for (int s = 0; s < 2; s++) {
        o0 = __builtin_amdgcn_mfma_f32_32x32x16_bf16(pf[s], vf0[s], o0, 0, 0, 0);
        o1 = __builtin_amdgcn_mfma_f32_32x32x16_bf16(pf[s], vf1[s], o1, 0, 0, 0);
      }
      __builtin_amdgcn_sched_barrier(0); asm volatile("s_nop 15\n\ts_nop 15" ::: "memory"); __builtin_amdgcn_sched_barrier(0);
      if (__all(R < -110.f)) break;
    }
    float sq[16];
#pragma unroll
    for (int r = 0; r < 16; r++) {
      float v = o0[r] * o0[r] + o1[r] * o1[r];
#pragma unroll
      for (int o = 16; o > 0; o >>= 1) v += __shfl_xor(v, o, 64);
      sq[r] = v;
    }
    __syncthreads();
    if (n == 0) {
#pragma unroll
      for (int r = 0; r < 16; r++) ssq[wave * 32 + (r & 3) + 8 * (r >> 2) + 4 * hh] = sq[r];
    }
    __syncthreads();
    if (tid < 32) {
      float t = 0.f;
#pragma unroll
      for (int w = 0; w < 8; w++) t += ssq[w * 32 + tid];
      rstd[tid] = rsqrtf(t * (1.0f / 512.f) + EPSF);
    }
    __syncthreads();
#pragma unroll
    for (int r = 0; r < 16; r++) {
      const int qi = (r & 3) + 8 * (r >> 2) + 4 * hh;
      const float rs = rstd[qi];
      bf16* yr = y + (tokb + q0 + qi) * DM + 256 + wave * 64 + n;
      yr[0] = (bf16)f2bf(o0[r] * rs * g0);
      yr[32] = (bf16)f2bf(o1[r] * rs * g1);
    }
  }
}

#define SSM_BCAST_U(u, ua, ub, tt) do { \
    const unsigned w0 = (unsigned)__builtin_amdgcn_readlane((int)(ua).x, (tt)), w1 = (unsigned)__builtin_amdgcn_readlane((int)(ua).y, (tt)); \
    const unsigned w2 = (unsigned)__builtin_amdgcn_readlane((int)(ua).z, (tt)), w3 = (unsigned)__builtin_amdgcn_readlane((int)(ua).w, (tt)); \
    const unsigned w4 = (unsigned)__builtin_amdgcn_readlane((int)(ub).x, (tt)), w5 = (unsigned)__builtin_amdgcn_readlane((int)(ub).y, (tt)); \
    const unsigned w6 = (unsigned)__builtin_amdgcn_readlane((int)(ub).z, (tt)), w7 = (unsigned)__builtin_amdgcn_readlane((int)(ub).w, (tt)); \
    (u)[0] = bf_lo(w0); (u)[1] = bf_hi(w0); (u)[2] = bf_lo(w1); (u)[3] = bf_hi(w1); (u)[4] = bf_lo(w2); (u)[5] = bf_hi(w2); (u)[6] = bf_lo(w3); (u)[7] = bf_hi(w3); \
    (u)[8] = bf_lo(w4); (u)[9] = bf_hi(w4); (u)[10] = bf_lo(w5); (u)[11] = bf_hi(w5); (u)[12] = bf_lo(w6); (u)[13] = bf_hi(w6); (u)[14] = bf_lo(w7); (u)[15] = bf_hi(w7); } while (0)
#define SSM_RS 592
#define SSM_TILE_BASE 36864
#define SSM_TILE_BYTES (16 * SSM_RS)
typedef float f32x2_t __attribute__((ext_vector_type(2)));
__device__ __forceinline__ void ssm_load_bop(const float* ssmp, int g, int lane, bf16x8_t (&bop)[8]) {
  const int q = lane >> 4, n = lane & 15;
  float v[8][8];
#pragma unroll
  for (int j = 0; j < 8; j++) {
    const float4* rp = (const float4*)(ssmp + 4096 + (size_t)(g * 16 + ((8 * q + j) & 15)) * 128 + 8 * n);
    const float4 a = rp[0], b = rp[1];
    v[j][0] = a.x; v[j][1] = a.y; v[j][2] = a.z; v[j][3] = a.w; v[j][4] = b.x; v[j][5] = b.y; v[j][6] = b.z; v[j][7] = b.w;
  }
#pragma unroll
  for (int nt = 0; nt < 8; nt++) {
    pg8::u32x4 w;
    w.x = pk2(v[0][nt], v[1][nt]); w.y = pk2(v[2][nt], v[3][nt]); w.z = pk2(v[4][nt], v[5][nt]); w.w = pk2(v[6][nt], v[7][nt]);
    if (q >= 2) { w.x = 0u; w.y = 0u; w.z = 0u; w.w = 0u; }
    bop[nt] = __builtin_bit_cast(bf16x8_t, w);
  }
}
__device__ __forceinline__ void ssm_bu_block(LAS unsigned char* xt, int lane, int blk, const uint4& ua, const uint4& ub, const bf16x8_t (&bop)[8]) {
  const int q = lane >> 4, n = lane & 15;
  if (q == blk) {
    pg8::u32x4 w0, w1;
    w0.x = ua.x; w0.y = ua.y; w0.z = ua.z; w0.w = ua.w; w1.x = ub.x; w1.y = ub.y; w1.z = ub.z; w1.w = ub.w;
    LAS pg8::u32x4* ur = (LAS pg8::u32x4*)(xt + n * SSM_RS + 512);
    ur[0] = w0; ur[1] = w1;
  }
  __builtin_amdgcn_wave_barrier();
  const bf16x8_t uop = *(const LAS bf16x8_t*)(xt + n * SSM_RS + 512 + q * 16);
  pg8::f32x4 bacc[8];
#pragma unroll
  for (int nt = 0; nt < 8; nt++) {
    pg8::f32x4 z4; z4[0] = 0.f; z4[1] = 0.f; z4[2] = 0.f; z4[3] = 0.f;
    bacc[nt] = __builtin_amdgcn_mfma_f32_16x16x32_bf16(uop, bop[nt], z4, 0, 0, 0);
  }
#pragma unroll
  for (int j = 0; j < 4; j++) {
    pg8::f32x4 w0, w1;
    w0[0] = bacc[0][j]; w0[1] = bacc[1][j]; w0[2] = bacc[2][j]; w0[3] = bacc[3][j];
    w1[0] = bacc[4][j]; w1[1] = bacc[5][j]; w1[2] = bacc[6][j]; w1[3] = bacc[7][j];
    LAS pg8::f32x4* dr = (LAS pg8::f32x4*)(xt + (4 * q + j) * SSM_RS + 32 * n);
    dr[0] = w0; dr[1] = w1;
  }
  __builtin_amdgcn_wave_barrier();
}
__device__ __forceinline__ void ssm_zero_pad(LAS unsigned char* xt, int lane) {
  if (lane < 16) {
    pg8::u32x4 z4; z4.x = 0u; z4.y = 0u; z4.z = 0u; z4.w = 0u;
    LAS pg8::u32x4* zr = (LAS pg8::u32x4*)(xt + lane * SSM_RS + 544);
    zr[0] = z4; zr[1] = z4;
  }
}
__device__ __forceinline__ void ssm_chunk_end(const int wave_s, const float* ssmp, const bf16* proj, float* ssmE, LAS float* smem) {
  const int tid_ = opaque_tid(wave_s);
  const int lane = tid_ & 63;
  const int gw = blockIdx.x * NWAVES + (tid_ >> 6);
  const int nw = gridDim.x * NWAVES;
  for (int it = gw; it < 4 * 64 * 16; it += nw) {
    const int g = it & 15, c = (it >> 4) & 63, b = it >> 10;
    const int gp = g * 64 + lane;
    const uint4* up = (const uint4*)(proj + (size_t)(b * SEQ + c * 64 + lane) * DIN + 2048 + g * 16);
    const uint4 ua = up[0], ub = up[1];
    const float lbr = ssmp[gp * 2], lbi = ssmp[gp * 2 + 1];
    bf16x8_t bop[8];
    ssm_load_bop(ssmp, g, lane, bop);
    LAS unsigned char* xt = (LAS unsigned char*)smem + SSM_TILE_BASE + (tid_ >> 6) * SSM_TILE_BYTES;
    ssm_zero_pad(xt, lane);
    float xr = 0.f, xi = 0.f;
#pragma unroll 1
    for (int blk = 0; blk < 4; blk++) {
      ssm_bu_block(xt, lane, blk, ua, ub, bop);
#pragma unroll 4
      for (int tt = 0; tt < 16; tt++) {
        const f32x2_t bu = *(const LAS f32x2_t*)(xt + tt * SSM_RS + lane * 8);
        const float nr = lbr * xr - lbi * xi + bu[0];
        const float ni = lbr * xi + lbi * xr + bu[1];
        xr = nr; xi = ni;
      }
      __builtin_amdgcn_wave_barrier();
    }
    float* e = ssmE + ((size_t)((b * 64 + c) * 16 + g) * 64 + lane) * 2;
    e[0] = xr; e[1] = xi;
  }
}

__device__ __forceinline__ void ssm_finish(const int wave_s, const Params& p, int l, const float* ssmp, const bf16* proj,
                           const float* ssmE, bf16* y, LAS float* smem) {
  LAS bf16* Ytb = (LAS bf16*)smem;
  LAS float* ssq2 = smem + (64 * 264 * 2) / 4;
  LAS float* rstd2 = ssq2 + 512;
  const bf16* glT = (const bf16*)(p.ws + WS_WT + (size_t)l * WT_LAYER + WT_GLU);
  const int tid = opaque_tid(wave_s), lane = tid & 63, wave = tid >> 6;
  const float* cre = karg_in(13) + (size_t)l * 16 * 16 * 64;
  const float* cim = karg_in(14) + (size_t)l * 16 * 16 * 64;
  const float* dsk = karg_in(15) + l * 256;
  const float* glw = karg_in(16) + (size_t)l * 256 * 256;
  const float* glb = karg_in(17) + l * 256;
  const float* gg = karg_in(18) + l * 1024 + 768;
  for (int it = blockIdx.x; it < 256; it += gridDim.x) {
    const int b = it >> 6, c = it & 63;
    __syncthreads();
    for (int gi = 0; gi < 2; gi++) {
      const int g = wave + gi * 8;
      const int gp = g * 64 + lane;
      const float lbr = ssmp[gp * 2], lbi = ssmp[gp * 2 + 1];
      const float lcr = ssmp[2048 + gp * 2], lci = ssmp[2048 + gp * 2 + 1];
      bf16x8_t bop[8];
      ssm_load_bop(ssmp, g, lane, bop);
      bf16x8_t cop[5];
      {
        const int nn = lane & 15, q = lane >> 4;
#pragma unroll
        for (int ks = 0; ks < 4; ks++) {
          const float4 cr4 = *(const float4*)(cre + (g * 16 + nn) * 64 + 16 * ks + 4 * q);
          const float4 ci4 = *(const float4*)(cim + (g * 16 + nn) * 64 + 16 * ks + 4 * q);
          pg8::u32x4 w;
          w.x = pk2(cr4.x, -ci4.x); w.y = pk2(cr4.y, -ci4.y); w.z = pk2(cr4.z, -ci4.z); w.w = pk2(cr4.w, -ci4.w);
          cop[ks] = __builtin_bit_cast(bf16x8_t, w);
        }
        const float dn = dsk[g * 16 + nn];
        float dv[8];
#pragma unroll
        for (int j = 0; j < 8; j++) dv[j] = (8 * q + j == nn) ? dn : 0.f;
        pg8::u32x4 w;
        w.x = pk2(dv[0], dv[1]); w.y = pk2(dv[2], dv[3]); w.z = pk2(dv[4], dv[5]); w.w = pk2(dv[6], dv[7]);
        cop[4] = __builtin_bit_cast(bf16x8_t, w);
      }
      const uint4* up = (const uint4*)(proj + (size_t)(b * SEQ + c * 64 + lane) * DIN + 2048 + g * 16);
      const uint4 ua = up[0], ub = up[1];
      float xr = 0.f, xi = 0.f;
      {
        const float2* eb = (const float2*)ssmE + ((size_t)(b * 64) * 16 + g) * 64 + lane;
        for (int cc = 0; cc < c; cc += 16) {
          float2 ev[16];
#pragma unroll
          for (int k = 0; k < 16; k++) ev[k] = eb[(size_t)(cc + k < c ? cc + k : c - 1) * 16 * 64];
#pragma unroll
          for (int k = 0; k < 16; k++) {
            if (cc + k < c) {
              const float nr = lcr * xr - lci * xi + ev[k].x;
              const float ni = lcr * xi + lci * xr + ev[k].y;
              xr = nr; xi = ni;
            }
          }
        }
      }
      LAS unsigned char* xt = (LAS unsigned char*)smem + SSM_TILE_BASE + wave * SSM_TILE_BYTES;
      ssm_zero_pad(xt, lane);
#pragma unroll 1
      for (int blk = 0; blk < 4; blk++) {
        ssm_bu_block(xt, lane, blk, ua, ub, bop);
#pragma unroll 4
        for (int tt = 0; tt < 16; tt++) {
          const f32x2_t bu = *(const LAS f32x2_t*)(xt + tt * SSM_RS + lane * 8);
          const float nr = lbr * xr - lbi * xi + bu[0];
          const float ni = lbr * xi + lbi * xr + bu[1];
          xr = nr; xi = ni;
          *(LAS unsigned*)(xt + tt * SSM_RS + lane * 4) = pk2(xr, xi);
        }
        __builtin_amdgcn_wave_barrier();
        {
          pg8::f32x4 acc4;
          acc4[0] = 0.f; acc4[1] = 0.f; acc4[2] = 0.f; acc4[3] = 0.f;
          const LAS unsigned char* ar = xt + (lane & 15) * SSM_RS + (lane >> 4) * 16;
#pragma unroll
          for (int ks = 0; ks < 4; ks++)
            acc4 = __builtin_amdgcn_mfma_f32_16x16x32_bf16(*(const LAS bf16x8_t*)(ar + ks * 64), cop[ks], acc4, 0, 0, 0);
          acc4 = __builtin_amdgcn_mfma_f32_16x16x32_bf16(*(const LAS bf16x8_t*)(ar + 512), cop[4], acc4, 0, 0, 0);
#pragma unroll
          for (int j = 0; j < 4; j++)
            Ytb[(blk * 16 + 4 * (lane >> 4) + j) * 264 + g * 16 + (lane & 15)] = (bf16)f2bf(gelu_tanh(acc4[j]));
        }
        __builtin_amdgcn_wave_barrier();
      }
    }
    __syncthreads();
    {
      const int n = lane & 31, hh = lane >> 5;
      const int ch = wave * 32 + n;
      const float bj = glb[ch];
      const float gj = gg[ch];
      bf16x8_t gf[16];
      {
        const bf16* grow = glT + (size_t)ch * 256 + 8 * hh;
#pragma unroll
        for (int ks = 0; ks < 16; ks++) gf[ks] = *(const bf16x8_t*)(grow + 16 * ks);
      }
      float oo[2][16];
#pragma unroll
      for (int mt = 0; mt < 2; mt++) {
        f32x16_t z;
#pragma unroll
        for (int r = 0; r < 16; r++) z[r] = 0.f;
        const LAS bf16* yrow = Ytb + (mt * 32 + n) * 264 + 8 * hh;
#pragma unroll
        for (int kq = 0; kq < 4; kq++) {
          bf16x8_t yf[4];
#pragma unroll
          for (int i = 0; i < 4; i++) yf[i] = *(const LAS bf16x8_t*)(yrow + 16 * (kq * 4 + i));
          MFMA_PAD();
#pragma unroll
          for (int i = 0; i < 4; i++) z = __builtin_amdgcn_mfma_f32_32x32x16_bf16(yf[i], gf[kq * 4 + i], z, 0, 0, 0);
          MFMA_PAD();
        }
        float sq[16];
#pragma unroll
        for (int r = 0; r < 16; r++) {
          const int t = mt * 32 + (r & 3) + 8 * (r >> 2) + 4 * hh;
          const float yv = bf2f(Ytb[t * 264 + ch]);
          const float o = yv * sigmoidf_(z[r] + bj);
          oo[mt][r] = o;
          float v = o * o;
#pragma unroll
          for (int s = 16; s > 0; s >>= 1) v += __shfl_xor(v, s, 64);
          sq[r] = v;
        }
        if (n == 0) {
#pragma unroll
          for (int r = 0; r < 16; r++) ssq2[wave * 64 + mt * 32 + (r & 3) + 8 * (r >> 2) + 4 * hh] = sq[r];
        }
      }
      __syncthreads();
      if (tid < 64) {
        float t = 0.f;
#pragma unroll
        for (int w = 0; w < 8; w++) t += ssq2[w * 64 + tid];
        rstd2[tid] = rsqrtf(t * (1.0f / 256.f) + EPSF);
      }
      __syncthreads();
#pragma unroll
      for (int mt = 0; mt < 2; mt++)
#pragma unroll
        for (int r = 0; r < 16; r++) {
          const int t = mt * 32 + (r & 3) + 8 * (r >> 2) + 4 * hh;
          y[(size_t)(b * SEQ + c * 64 + t) * DM + 768 + ch] = (bf16)f2bf(oo[mt][r] * rstd2[t] * gj);
        }
    }
  }
}

__device__ __forceinline__ void memattn_phase(const int wave_s, const bf16* q, const bf16* kvb, const bf16* vT, bf16* o, LAS float* smem) {
  const int tid_ = opaque_tid(wave_s);
  const int lane = tid_ & 63, n = lane & 31, hh = lane >> 5, wave = tid_ >> 6;
  const int sig = (n & 0x13) | ((n & 4) << 1) | ((n & 8) >> 1);
  LAS bf16* Ls = (LAS bf16*)smem;
  for (int it = blockIdx.x; it < 64 * 4; it += gridDim.x) {
    const int h = it & 3, tg = it >> 2, b = tg >> 4;
    const int tok0 = (tg * 8 + wave) * 32;
    __syncthreads();
    {
      const int r = tid_ >> 1, hf = tid_ & 1;
      const pg8::u32x4* src4 = (const pg8::u32x4*)(kvb + (size_t)(b * NMEM + r) * 2048 + h * 256 + hf * 128);
      LAS pg8::u32x4* dst4 = (LAS pg8::u32x4*)(Ls + r * 264 + hf * 128);
#pragma unroll
      for (int k = 0; k < 16; k++) dst4[k] = src4[k];
    }
    f32x16_t st[8];
#pragma unroll
    for (int kt = 0; kt < 8; kt++)
#pragma unroll
      for (int r = 0; r < 16; r++) st[kt][r] = 0.f;
    const bf16* qrow = q + (size_t)(tok0 + n) * DM + h * 256 + 8 * hh;
    __syncthreads();
#pragma unroll
    for (int kq = 0; kq < 4; kq++) {
      bf16x8_t qf[4];
#pragma unroll
      for (int i = 0; i < 4; i++) qf[i] = *(const bf16x8_t*)(qrow + 16 * (kq * 4 + i));
#pragma unroll
      for (int kt = 0; kt < 8; kt++) {
        const LAS bf16* krow = Ls + (kt * 32 + sig) * 264 + 8 * hh;
        bf16x8_t kf[4];
#pragma unroll
        for (int i = 0; i < 4; i++) kf[i] = *(const LAS bf16x8_t*)(krow + 16 * (kq * 4 + i));
        MFMA_PAD();
#pragma unroll
        for (int i = 0; i < 4; i++) st[kt] = __builtin_amdgcn_mfma_f32_32x32x16_bf16(kf[i], qf[i], st[kt], 0, 0, 0);
        MFMA_PAD();
      }
    }
    float mx = st[0][0];
#pragma unroll
    for (int kt = 0; kt < 8; kt++)
#pragma unroll
      for (int r = 0; r < 16; r++) mx = fmaxf(mx, st[kt][r]);
    mx = fmaxf(mx, __shfl_xor(mx, 32, 64));
    float sum = 0.f;
#pragma unroll
    for (int kt = 0; kt < 8; kt++)
#pragma unroll
      for (int r = 0; r < 16; r++) { const float e = __expf((st[kt][r] - mx) * 0.0625f); st[kt][r] = e; sum += e; }
    sum += __shfl_xor(sum, 32, 64);
    const float inv = 1.0f / sum;
    bf16x8_t pf[8][2];
#pragma unroll
    for (int kt = 0; kt < 8; kt++)
#pragma unroll
      for (int s = 0; s < 2; s++)
#pragma unroll
        for (int j = 0; j < 8; j++) pf[kt][s][j] = (short)f2bf(st[kt][8 * s + j] * inv);
    __syncthreads();
    {
      const int r = tid_ >> 1, hf = tid_ & 1;
      const pg8::u32x4* src4 = (const pg8::u32x4*)(vT + ((size_t)(b * 4 + h) * 256 + r) * 256 + hf * 128);
      LAS pg8::u32x4* dst4 = (LAS pg8::u32x4*)(Ls + r * 264 + hf * 128);
#pragma unroll
      for (int k = 0; k < 16; k++) dst4[k] = src4[k];
    }
    __syncthreads();
#pragma unroll 1
    for (int dt = 0; dt < 8; dt++) {
      f32x16_t oacc;
#pragma unroll
      for (int r = 0; r < 16; r++) oacc[r] = 0.f;
      const LAS bf16* vrow = Ls + (dt * 32 + n) * 264 + 8 * hh;
#pragma unroll
      for (int kq = 0; kq < 4; kq++) {
        bf16x8_t vf[4];
#pragma unroll
        for (int i = 0; i < 4; i++) vf[i] = *(const LAS bf16x8_t*)(vrow + (kq * 2 + (i >> 1)) * 32 + 16 * (i & 1));
        MFMA_PAD();
#pragma unroll
        for (int i = 0; i < 4; i++) oacc = __builtin_amdgcn_mfma_f32_32x32x16_bf16(pf[kq * 2 + (i >> 1)][i & 1], vf[i], oacc, 0, 0, 0);
        MFMA_PAD();
      }
#pragma unroll
      for (int r = 0; r < 16; r++) {
        const int qi = (r & 3) + 8 * (r >> 2) + 4 * hh;
        o[(size_t)(tok0 + qi) * DM + h * 256 + dt * 32 + n] = (bf16)f2bf(oacc[r]);
      }
    }
  }
}

__device__ __forceinline__ void vt_phase(const int wave_s, const bf16* kvb, bf16* vT) {
  const int tid_ = opaque_tid(wave_s);
  const int gt = blockIdx.x * (NWAVES * 64) + tid_;
  const int nth = gridDim.x * NWAVES * 64;
  for (int i = gt; i < 2 * 4 * 4 * 256 * 256; i += nth) {
    const int m = i & 255, d = (i >> 8) & 255, h = (i >> 16) & 3, b = (i >> 18) & 3, l = i >> 20;
    vT[i] = kvb[((size_t)l * 1024 + b * 256 + m) * 2048 + 1024 + h * 256 + d];
  }
}

template <unsigned MASK>
__device__ __forceinline__ float pack_key(float s, unsigned idx) {
  const unsigned u = __builtin_bit_cast(unsigned, s);
  const unsigned tag = ((int)u < 0) ? idx : (MASK - idx);
  return __builtin_bit_cast(float, (u & ~MASK) + tag);
}
template <unsigned MASK>
__device__ __forceinline__ unsigned key_idx(float k) {
  const unsigned u = __builtin_bit_cast(unsigned, k);
  const unsigned tag = u & MASK;
  return ((int)u < 0) ? tag : (MASK - tag);
}
template <unsigned MASK>
__device__ __forceinline__ float key_val(float k) { return __builtin_bit_cast(float, __builtin_bit_cast(unsigned, k) & ~MASK); }
__device__ __forceinline__ void top16_of_64(float (&K)[64]) {
  { const float a_ = K[0], b_ = K[1]; const bool g_ = a_ > b_; K[0] = g_ ? a_ : b_; K[1] = g_ ? b_ : a_; }
  { const float a_ = K[2], b_ = K[3]; const bool g_ = a_ > b_; K[2] = g_ ? b_ : a_; K[3] = g_ ? a_ : b_; }
  { const float a_ = K[4], b_ = K[5]; const bool g_ = a_ > b_; K[4] = g_ ? a_ : b_; K[5] = g_ ? b_ : a_; }
  { const float a_ = K[6], b_ = K[7]; const bool g_ = a_ > b_; K[6] = g_ ? b_ : a_; K[7] = g_ ? a_ : b_; }
  { const float a_ = K[8], b_ = K[9]; const bool g_ = a_ > b_; K[8] = g_ ? a_ : b_; K[9] = g_ ? b_ : a_; }
  { const float a_ = K[10], b_ = K[11]; const bool g_ = a_ > b_; K[10] = g_ ? b_ : a_; K[11] = g_ ? a_ : b_; }
  { const float a_ = K[12], b_ = K[13]; const bool g_ = a_ > b_; K[12] = g_ ? a_ : b_; K[13] = g_ ? b_ : a_; }
  { const float a_ = K[14], b_ = K[15]; const bool g_ = a_ > b_; K[14] = g_ ? b_ : a_; K[15] = g_ ? a_ : b_; }
  { const float a_ = K[0], b_ = K[2]; const bool g_ = a_ > b_; K[0] = g_ ? a_ : b_; K[2] = g_ ? b_ : a_; }
  { const float a_ = K[1], b_ = K[3]; const bool g_ = a_ > b_; K[1] = g_ ? a_ : b_; K[3] = g_ ? b_ : a_; }
  { const float a_ = K[4], b_ = K[6]; const bool g_ = a_ > b_; K[4] = g_ ? b_ : a_; K[6] = g_ ? a_ : b_; }
  { const float a_ = K[5], b_ = K[7]; const bool g_ = a_ > b_; K[5] = g_ ? b_ : a_; K[7] = g_ ? a_ : b_; }
  { const float a_ = K[8], b_ = K[10]; const bool g_ = a_ > b_; K[8] = g_ ? a_ : b_; K[10] = g_ ? b_ : a_; }
  { const float a_ = K[9], b_ = K[11]; const bool g_ = a_ > b_; K[9] = g_ ? a_ : b_; K[11] = g_ ? b_ : a_; }
  { const float a_ = K[12], b_ = K[14]; const bool g_ = a_ > b_; K[12] = g_ ? b_ : a_; K[14] = g_ ? a_ : b_; }
  { const float a_ = K[13], b_ = K[15]; const bool g_ = a_ > b_; K[13] = g_ ? b_ : a_; K[15] = g_ ? a_ : b_; }
  { const float a_ = K[0], b_ = K[1]; const bool g_ = a_ > b_; K[0] = g_ ? a_ : b_; K[1] = g_ ? b_ : a_; }
  { const float a_ = K[2], b_ = K[3]; const bool g_ = a_ > b_; K[2] = g_ ? a_ : b_; K[3] = g_ ? b_ : a_; }
  { const float a_ = K[4], b_ = K[5]; const bool g_ = a_ > b_; K[4] = g_ ? b_ : a_; K[5] = g_ ? a_ : b_; }
  { const float a_ = K[6], b_ = K[7]; const bool g_ = a_ > b_; K[6] = g_ ? b_ : a_; K[7] = g_ ? a_ : b_; }
  { const float a_ = K[8], b_ = K[9]; const bool g_ = a_ > b_; K[8] = g_ ? a_ : b_; K[9] = g_ ? b_ : a_; }
  { const float a_ = K[10], b_ = K[11]; const bool g_ = a_ > b_; K[10] = g_ ? a_ : b_; K[11] = g_ ? b_ : a_; }
  { const float a_ = K[12], b_ = K[13]; const bool g_ = a_ > b_; K[12] = g_ ? b_ : a_; K[13] = g_ ? a_ : b_; }
  { const float a_ = K[14], b_ = K[15]; const bool g_ = a_ > b_; K[14] = g_ ? b_ : a_; K[15] = g_ ? a_ : b_; }
  { const float a_ = K[0], b_ = K[4]; const bool g_ = a_ > b_; K[0] = g_ ? a_ : b_; K[4] = g_ ? b_ : a_; }
  { const float a_ = K[1], b_ = K[5]; const bool g_ = a_ > b_; K[1] = g_ ? a_ : b_; K[5] = g_ ? b_ : a_; }
  { const float a_ = K[2], b_ = K[6]; const bool g_ = a_ > b_; K[2] = g_ ? a_ : b_; K[6] = g_ ? b_ : a_; }
  { const float a_ = K[3], b_ = K[7]; const bool g_ = a_ > b_; K[3] = g_ ? a_ : b_; K[7] = g_ ? b_ : a_; }
  { const float a_ = K[8], b_ = K[12]; const bool g_ = a_ > b_; K[8] = g_ ? b_ : a_; K[12] = g_ ? a_ : b_; }
  { const float a_ = K[9], b_ = K[13]; const bool g_ = a_ > b_; K[9] = g_ ? b_ : a_; K[13] = g_ ? a_ : b_; }
  { const float a_ = K[10], b_ = K[14]; const bool g_ = a_ > b_; K[10] = g_ ? b_ : a_; K[14] = g_ ? a_ : b_; }
  { const float a_ = K[11], b_ = K[15]; const bool g_ = a_ > b_; K[11] = g_ ? b_ : a_; K[15] = g_ ? a_ : b_; }
  { const float a_ = K[0], b_ = K[2]; const bool g_ = a_ > b_; K[0] = g_ ? a_ : b_; K[2] = g_ ? b_ : a_; }
  { const float a_ = K[1], b_ = K[3]; const bool g_ = a_ > b_; K[1] = g_ ? a_ : b_; K[3] = g_ ? b_ : a_; }
  { const float a_ = K[4], b_ = K[6]; const bool g_ = a_ > b_; K[4] = g_ ? a_ : b_; K[6] = g_ ? b_ : a_; }
  { const float a_ = K[5], b_ = K[7]; const bool g_ = a_ > b_; K[5] = g_ ? a_ : b_; K[7] = g_ ? b_ : a_; }
  { const float a_ = K[8], b_ = K[10]; const bool g_ = a_ > b_; K[8] = g_ ? b_ : a_; K[10] = g_ ? a_ : b_; }
  { const float a_ = K[9], b_ = K[11]; const bool g_ = a_ > b_; K[9] = g_ ? b_ : a_; K[11] = g_ ? a_ : b_; }
  { const float a_ = K[12], b_ = K[14]; const bool g_ = a_ > b_; K[12] = g_ ? b_ : a_; K[14] = g_ ? a_ : b_; }
  { const float a_ = K[13], b_ = K[15]; const bool g_ = a_ > b_; K[13] = g_ ? b_ : a_; K[15] = g_ ? a_ : b_; }
  { const float a_ = K[0], b_ = K[1]; const bool g_ = a_ > b_; K[0] = g_ ? a_ : b_; K[1] = g_ ? b_ : a_; }
  { const float a_ = K[2], b_ = K[3]; const bool g_ = a_ > b_; K[2] = g_ ? a_ : b_; K[3] = g_ ? b_ : a_; }
  { const float a_ = K[4], b_ = K[5]; const bool g_ = a_ > b_; K[4] = g_ ? a_ : b_; K[5] = g_ ? b_ : a_; }
  { const float a_ = K[6], b_ = K[7]; const bool g_ = a_ > b_; K[6] = g_ ? a_ : b_; K[7] = g_ ? b_ : a_; }
  { const float a_ = K[8], b_ = K[9]; const bool g_ = a_ > b_; K[8] = g_ ? b_ : a_; K[9] = g_ ? a_ : b_; }
  { const float a_ = K[10], b_ = K[11]; const bool g_ = a_ > b_; K[10] = g_ ? b_ : a_; K[11] = g_ ? a_ : b_; }
  { const float a_ = K[12], b_ = K[13]; const bool g_ = a_ > b_; K[12] = g_ ? b_ : a_; K[13] = g_ ? a_ : b_; }
  { const float a_ = K[14], b_ = K[15]; const bool g_ = a_ > b_; K[14] = g_ ? b_ : a_; K[15] = g_ ? a_ : b_; }
  { const float a_ = K[0], b_ = K[8]; const bool g_ = a_ > b_; K[0] = g_ ? a_ : b_; K[8] = g_ ? b_ : a_; }
  { const float a_ = K[1], b_ = K[9]; const bool g_ = a_ > b_; K[1] = g_ ? a_ : b_; K[9] = g_ ? b_ : a_; }
  { const float a_ = K[2], b_ = K[10]; const bool g_ = a_ > b_; K[2] = g_ ? a_ : b_; K[10] = g_ ? b_ : a_; }
  { const float a_ = K[3], b_ = K[11]; const bool g_ = a_ > b_; K[3] = g_ ? a_ : b_; K[11] = g_ ? b_ : a_; }
  { const float a_ = K[4], b_ = K[12]; const bool g_ = a_ > b_; K[4] = g_ ? a_ : b_; K[12] = g_ ? b_ : a_; }
  { const float a_ = K[5], b_ = K[13]; const bool g_ = a_ > b_; K[5] = g_ ? a_ : b_; K[13] = g_ ? b_ : a_; }
  { const float a_ = K[6], b_ = K[14]; const bool g_ = a_ > b_; K[6] = g_ ? a_ : b_; K[14] = g_ ? b_ : a_; }
  { const float a_ = K[7], b_ = K[15]; const bool g_ = a_ > b_; K[7] = g_ ? a_ : b_; K[15] = g_ ? b_ : a_; }
  { const float a_ = K[0], b_ = K[4]; const bool g_ = a_ > b_; K[0] = g_ ? a_ : b_; K[4] = g_ ? b_ : a_; }
  { const float a_ = K[1], b_ = K[5]; const bool g_ = a_ > b_; K[1] = g_ ? a_ : b_; K[5] = g_ ? b_ : a_; }
  { const float a_ = K[2], b_ = K[6]; const bool g_ = a_ > b_; K[2] = g_ ? a_ : b_; K[6] = g_ ? b_ : a_; }
  { const float a_ = K[3], b_ = K[7]; const bool g_ = a_ > b_; K[3] = g_ ? a_ : b_; K[7] = g_ ? b_ : a_; }
  { const float a_ = K[8], b_ = K[12]; const bool g_ = a_ > b_; K[8] = g_ ? a_ : b_; K[12] = g_ ? b_ : a_; }
  { const float a_ = K[9], b_ = K[13]; const bool g_ = a_ > b_; K[9] = g_ ? a_ : b_; K[13] = g_ ? b_ : a_; }
  { const float a_ = K[10], b_ = K[14]; const bool g_ = a_ > b_; K[10] = g_ ? a_ : b_; K[14] = g_ ? b_ : a_; }
  { const float a_ = K[11], b_ = K[15]; const bool g_ = a_ > b_; K[11] = g_ ? a_ : b_; K[15] = g_ ? b_ : a_; }
  { const float a_ = K[0], b_ = K[2]; const bool g_ = a_ > b_; K[0] = g_ ? a_ : b_; K[2] = g_ ? b_ : a_; }
  { const float a_ = K[1], b_ = K[3]; const bool g_ = a_ > b_; K[1] = g_ ? a_ : b_; K[3] = g_ ? b_ : a_; }
  { const float a_ = K[4], b_ = K[6]; const bool g_ = a_ > b_; K[4] = g_ ? a_ : b_; K[6] = g_ ? b_ : a_; }
  { const float a_ = K[5], b_ = K[7]; const bool g_ = a_ > b_; K[5] = g_ ? a_ : b_; K[7] = g_ ? b_ : a_; }
  { const float a_ = K[8], b_ = K[10]; const bool g_ = a_ > b_; K[8] = g_ ? a_ : b_; K[10] = g_ ? b_ : a_; }
  { const float a_ = K[9], b_ = K[11]; const bool g_ = a_ > b_; K[9] = g_ ? a_ : b_; K[11] = g_ ? b_ : a_; }
  { const float a_ = K[12], b_ = K[14]; const bool g_ = a_ > b_; K[12] = g_ ? a_ : b_; K[14] = g_ ? b_ : a_; }
  { const float a_ = K[13], b_ = K[15]; const bool g_ = a_ > b_; K[13] = g_ ? a_ : b_; K[15] = g_ ? b_ : a_; }
  { const float a_ = K[0], b_ = K[1]; const bool g_ = a_ > b_; K[0] = g_ ? a_ : b_; K[1] = g_ ? b_ : a_; }
  { const float a_ = K[2], b_ = K[3]; const bool g_ = a_ > b_; K[2] = g_ ? a_ : b_; K[3] = g_ ? b_ : a_; }
  { const float a_ = K[4], b_ = K[5]; const bool g_ = a_ > b_; K[4] = g_ ? a_ : b_; K[5] = g_ ? b_ : a_; }
  { const float a_ = K[6], b_ = K[7]; const bool g_ = a_ > b_; K[6] = g_ ? a_ : b_; K[7] = g_ ? b_ : a_; }
  { const float a_ = K[8], b_ = K[9]; const bool g_ = a_ > b_; K[8] = g_ ? a_ : b_; K[9] = g_ ? b_ : a_; }
  { const float a_ = K[10], b_ = K[11]; const bool g_ = a_ > b_; K[10] = g_ ? a_ : b_; K[11] = g_ ? b_ : a_; }
  { const float a_ = K[12], b_ = K[13]; const bool g_ = a_ > b_; K[12] = g_ ? a_ : b_; K[13] = g_ ? b_ : a_; }
  { const float a_ = K[14], b_ = K[15]; const bool g_ = a_ > b_; K[14] = g_ ? a_ : b_; K[15] = g_ ? b_ : a_; }
  { const float a_ = K[16], b_ = K[17]; const bool g_ = a_ > b_; K[16] = g_ ? a_ : b_; K[17] = g_ ? b_ : a_; }
  { const float a_ = K[18], b_ = K[19]; const bool g_ = a_ > b_; K[18] = g_ ? b_ : a_; K[19] = g_ ? a_ : b_; }
  { const float a_ = K[20], b_ = K[21]; const bool g_ = a_ > b_; K[20] = g_ ? a_ : b_; K[21] = g_ ? b_ : a_; }
  { const float a_ = K[22], b_ = K[23]; const bool g_ = a_ > b_; K[22] = g_ ? b_ : a_; K[23] = g_ ? a_ : b_; }
  { const float a_ = K[24], b_ = K[25]; const bool g_ = a_ > b_; K[24] = g_ ? a_ : b_; K[25] = g_ ? b_ : a_; }
  { const float a_ = K[26], b_ = K[27]; const bool g_ = a_ > b_; K[26] = g_ ? b_ : a_; K[27] = g_ ? a_ : b_; }
  { const float a_ = K[28], b_ = K[29]; const bool g_ = a_ > b_; K[28] = g_ ? a_ : b_; K[29] = g_ ? b_ : a_; }
  { const float a_ = K[30], b_ = K[31]; const bool g_ = a_ > b_; K[30] = g_ ? b_ : a_; K[31] = g_ ? a_ : b_; }
  { const float a_ = K[16], b_ = K[18]; const bool g_ = a_ > b_; K[16] = g_ ? a_ : b_; K[18] = g_ ? b_ : a_; }
  { const float a_ = K[17], b_ = K[19]; const bool g_ = a_ > b_; K[17] = g_ ? a_ : b_; K[19] = g_ ? b_ : a_; }
  { const float a_ = K[20], b_ = K[22]; const bool g_ = a_ > b_; K[20] = g_ ? b_ : a_; K[22] = g_ ? a_ : b_; }
  { const float a_ = K[21], b_ = K[23]; const bool g_ = a_ > b_; K[21] = g_ ? b_ : a_; K[23] = g_ ? a_ : b_; }
  { const float a_ = K[24], b_ = K[26]; const bool g_ = a_ > b_; K[24] = g_ ? a_ : b_; K[26] = g_ ? b_ : a_; }
  { const float a_ = K[25], b_ = K[27]; const bool g_ = a_ > b_; K[25] = g_ ? a_ : b_; K[27] = g_ ? b_ : a_; }
  { const float a_ = K[28], b_ = K[30]; const bool g_ = a_ > b_; K[28] = g_ ? b_ : a_; K[30] = g_ ? a_ : b_; }
  { const float a_ = K[29], b_ = K[31]; const bool g_ = a_ > b_; K[29] = g_ ? b_ : a_; K[31] = g_ ? a_ : b_; }
  { const float a_ = K[16], b_ = K[17]; const bool g_ = a_ > b_; K[16] = g_ ? a_ : b_; K[17] = g_ ? b_ : a_; }
  { const float a_ = K[18], b_ = K[19]; const bool g_ = a_ > b_; K[18] = g_ ? a_ : b_; K[19] = g_ ? b_ : a_; }
  { const float a_ = K[20], b_ = K[21]; const bool g_ = a_ > b_; K[20] = g_ ? b_ : a_; K[21] = g_ ? a_ : b_; }
  { const float a_ = K[22], b_ = K[23]; const bool g_ = a_ > b_; K[22] = g_ ? b_ : a_; K[23] = g_ ? a_ : b_; }
  { const float a_ = K[24], b_ = K[25]; const bool g_ = a_ > b_; K[24] = g_ ? a_ : b_; K[25] = g_ ? b_ : a_; }
  { const float a_ = K[26], b_ = K[27]; const bool g_ = a_ > b_; K[26] = g_ ? a_ : b_; K[27] = g_ ? b_ : a_; }
  { const float a_ = K[28], b_ = K[29]; const bool g_ = a_ > b_; K[28] = g_ ? b_ : a_; K[29] = g_ ? a_ : b_; }
  { const float a_ = K[30], b_ = K[31]; const bool g_ = a_ > b_; K[30] = g_ ? b_ : a_; K[31] = g_ ? a_ : b_; }
  { const float a_ = K[16], b_ = K[20]; const bool g_ = a_ > b_; K[16] = g_ ? a_ : b_; K[20] = g_ ? b_ : a_; }
  { const float a_ = K[17], b_ = K[21]; const bool g_ = a_ > b_; K[17] = g_ ? a_ : b_; K[21] = g_ ? b_ : a_; }
  { const float a_ = K[18], b_ = K[22]; const bool g_ = a_ > b_; K[18] = g_ ? a_ : b_; K[22] = g_ ? b_ : a_; }
  { const float a_ = K[19], b_ = K[23]; const bool g_ = a_ > b_; K[19] = g_ ? a_ : b_; K[23] = g_ ? b_ : a_; }
  { const float a_ = K[24], b_ = K[28]; const bool g_ = a_ > b_; K[24] = g_ ? b_ : a_; K[28] = g_ ? a_ : b_; }
  { const float a_ = K[25], b_ = K[29]; const bool g_ = a_ > b_; K[25] = g_ ? b_ : a_; K[29] = g_ ? a_ : b_; }
  { const float a_ = K[26], b_ = K[30]; const bool g_ = a_ > b_; K[26] = g_ ? b_ : a_; K[30] = g_ ? a_ : b_; }
  { const float a_ = K[27], b_ = K[31]; const bool g_ = a_ > b_; K[27] = g_ ? b_ : a_; K[31] = g_ ? a_ : b_; }
  { const float a_ = K[16], b_ = K[18]; const bool g_ = a_ > b_; K[16] = g_ ? a_ : b_; K[18] = g_ ? b_ : a_; }
  { const float a_ = K[17], b_ = K[19]; const bool g_ = a_ > b_; K[17] = g_ ? a_ : b_; K[19] = g_ ? b_ : a_; }
  { const float a_ = K[20], b_ = K[22]; const bool g_ = a_ > b_; K[20] = g_ ? a_ : b_; K[22] = g_ ? b_ : a_; }
  { const float a_ = K[21], b_ = K[23]; const bool g_ = a_ > b_; K[21] = g_ ? a_ : b_; K[23] = g_ ? b_ : a_; }
  { const float a_ = K[24], b_ = K[26]; const bool g_ = a_ > b_; K[24] = g_ ? b_ : a_; K[26] = g_ ? a_ : b_; }
  { const float a_ = K[25], b_ = K[27]; const bool g_ = a_ > b_; K[25] = g_ ? b_ : a_; K[27] = g_ ? a_ : b_; }
  { const float a_ = K[28], b_ = K[30]; const bool g_ = a_ > b_; K[28] = g_ ? b_ : a_; K[30] = g_ ? a_ : b_; }
  { const float a_ = K[29], b_ = K[31]; const bool g_ = a_ > b_; K[29] = g_ ? b_ : a_; K[31] = g_ ? a_ : b_; }
  { const float a_ = K[16], b_ = K[17]; const bool g_ = a_ > b_; K[16] = g_ ? a_ : b_; K[17] = g_ ? b_ : a_; }
  { const float a_ = K[18], b_ = K[19]; const bool g_ = a_ > b_; K[18] = g_ ? a_ : b_; K[19] = g_ ? b_ : a_; }
  { const float a_ = K[20], b_ = K[21]; const bool g_ = a_ > b_; K[20] = g_ ? a_ : b_; K[21] = g_ ? b_ : a_; }
  { const float a_ = K[22], b_ = K[23]; const bool g_ = a_ > b_; K[22] = g_ ? a_ : b_; K[23] = g_ ? b_ : a_; }
  { const float a_ = K[24], b_ = K[25]; const bool g_ = a_ > b_; K[24] = g_ ? b_ : a_; K[25] = g_ ? a_ : b_; }
  { const float a_ = K[26], b_ = K[27]; const bool g_ = a_ > b_; K[26] = g_ ? b_ : a_; K[27] = g_ ? a_ : b_; }
  { const float a_ = K[28], b_ = K[29]; const bool g_ = a_ > b_; K[28] = g_ ? b_ : a_; K[29] = g_ ? a_ : b_; }
  { const float a_ = K[30], b_ = K[31]; const bool g_ = a_ > b_; K[30] = g_ ? b_ : a_; K[31] = g_ ? a_ : b_; }
  { const float a_ = K[16], b_ = K[24]; const bool g_ = a_ > b_; K[16] = g_ ? a_ : b_; K[24] = g_ ? b_ : a_; }
  { const float a_ = K[17], b_ = K[25]; const bool g_ = a_ > b_; K[17] = g_ ? a_ : b_; K[25] = g_ ? b_ : a_; }
  { const float a_ = K[18], b_ = K[26]; const bool g_ = a_ > b_; K[18] = g_ ? a_ : b_; K[26] = g_ ? b_ : a_; }
  { const float a_ = K[19], b_ = K[27]; const bool g_ = a_ > b_; K[19] = g_ ? a_ : b_; K[27] = g_ ? b_ : a_; }
  { const float a_ = K[20], b_ = K[28]; const bool g_ = a_ > b_; K[20] = g_ ? a_ : b_; K[28] = g_ ? b_ : a_; }
  { const float a_ = K[21], b_ = K[29]; const bool g_ = a_ > b_; K[21] = g_ ? a_ : b_; K[29] = g_ ? b_ : a_; }
  { const float a_ = K[22], b_ = K[30]; const bool g_ = a_ > b_; K[22] = g_ ? a_ : b_; K[30] = g_ ? b_ : a_; }
  { const float a_ = K[23], b_ = K[31]; const bool g_ = a_ > b_; K[23] = g_ ? a_ : b_; K[31] = g_ ? b_ : a_; }
  { const float a_ = K[16], b_ = K[20]; const bool g_ = a_ > b_; K[16] = g_ ? a_ : b_; K[20] = g_ ? b_ : a_; }
  { const float a_ = K[17], b_ = K[21]; const bool g_ = a_ > b_; K[17] = g_ ? a_ : b_; K[21] = g_ ? b_ : a_; }
  { const float a_ = K[18], b_ = K[22]; const bool g_ = a_ > b_; K[18] = g_ ? a_ : b_; K[22] = g_ ? b_ : a_; }
  { const float a_ = K[19], b_ = K[23]; const bool g_ = a_ > b_; K[19] = g_ ? a_ : b_; K[23] = g_ ? b_ : a_; }
  { const float a_ = K[24], b_ = K[28]; const bool g_ = a_ > b_; K[24] = g_ ? a_ : b_; K[28] = g_ ? b_ : a_; }
  { const float a_ = K[25], b_ = K[29]; const bool g_ = a_ > b_; K[25] = g_ ? a_ : b_; K[29] = g_ ? b_ : a_; }
  { const float a_ = K[26], b_ = K[30]; const bool g_ = a_ > b_; K[26] = g_ ? a_ : b_; K[30] = g_ ? b_ : a_; }
  { const float a_ = K[27], b_ = K[31]; const bool g_ = a_ > b_; K[27] = g_ ? a_ : b_; K[31] = g_ ? b_ : a_; }
  { const float a_ = K[16], b_ = K[18]; const bool g_ = a_ > b_; K[16] = g_ ? a_ : b_; K[18] = g_ ? b_ : a_; }
  { const float a_ = K[17], b_ = K[19]; const bool g_ = a_ > b_; K[17] = g_ ? a_ : b_; K[19] = g_ ? b_ : a_; }
  { const float a_ = K[20], b_ = K[22]; const bool g_ = a_ > b_; K[20] = g_ ? a_ : b_; K[22] = g_ ? b_ : a_; }
  { const float a_ = K[21], b_ = K[23]; const bool g_ = a_ > b_; K[21] = g_ ? a_ : b_; K[23] = g_ ? b_ : a_; }
  { const float a_ = K[24], b_ = K[26]; const bool g_ = a_ > b_; K[24] = g_ ? a_ : b_; K[26] = g_ ? b_ : a_; }
  { const float a_ = K[25], b_ = K[27]; const bool g_ = a_ > b_; K[25] = g_ ? a_ : b_; K[27] = g_ ? b_ : a_; }
  { const float a_ = K[28], b_ = K[30]; const bool g_ = a_ > b_; K[28] = g_ ? a_ : b_; K[30] = g_ ? b_ : a_; }
  { const float a_ = K[29], b_ = K[31]; const bool g_ = a_ > b_; K[29] = g_ ? a_ : b_; K[31] = g_ ? b_ : a_; }
  { const float a_ = K[16], b_ = K[17]; const bool g_ = a_ > b_; K[16] = g_ ? a_ : b_; K[17] = g_ ? b_ : a_; }
  { const float a_ = K[18], b_ = K[19]; const bool g_ = a_ > b_; K[18] = g_ ? a_ : b_; K[19] = g_ ? b_ : a_; }
  { const float a_ = K[20], b_ = K[21]; const bool g_ = a_ > b_; K[20] = g_ ? a_ : b_; K[21] = g_ ? b_ : a_; }
  { const float a_ = K[22], b_ = K[23]; const bool g_ = a_ > b_; K[22] = g_ ? a_ : b_; K[23] = g_ ? b_ : a_; }
  { const float a_ = K[24], b_ = K[25]; const bool g_ = a_ > b_; K[24] = g_ ? a_ : b_; K[25] = g_ ? b_ : a_; }
  { const float a_ = K[26], b_ = K[27]; const bool g_ = a_ > b_; K[26] = g_ ? a_ : b_; K[27] = g_ ? b_ : a_; }
  { const float a_ = K[28], b_ = K[29]; const bool g_ = a_ > b_; K[28] = g_ ? a_ : b_; K[29] = g_ ? b_ : a_; }
  { const float a_ = K[30], b_ = K[31]; const bool g_ = a_ > b_; K[30] = g_ ? a_ : b_; K[31] = g_ ? b_ : a_; }
  { const float a_ = K[32], b_ = K[33]; const bool g_ = a_ > b_; K[32] = g_ ? a_ : b_; K[33] = g_ ? b_ : a_; }
  { const float a_ = K[34], b_ = K[35]; const bool g_ = a_ > b_; K[34] = g_ ? b_ : a_; K[35] = g_ ? a_ : b_; }
  { const float a_ = K[36], b_ = K[37]; const bool g_ = a_ > b_; K[36] = g_ ? a_ : b_; K[37] = g_ ? b_ : a_; }
  { const float a_ = K[38], b_ = K[39]; const bool g_ = a_ > b_; K[38] = g_ ? b_ : a_; K[39] = g_ ? a_ : b_; }
  { const float a_ = K[40], b_ = K[41]; const bool g_ = a_ > b_; K[40] = g_ ? a_ : b_; K[41] = g_ ? b_ : a_; }
  { const float a_ = K[42], b_ = K[43]; const bool g_ = a_ > b_; K[42] = g_ ? b_ : a_; K[43] = g_ ? a_ : b_; }
  { const float a_ = K[44], b_ = K[45]; const bool g_ = a_ > b_; K[44] = g_ ? a_ : b_; K[45] = g_ ? b_ : a_; }
  { const float a_ = K[46], b_ = K[47]; const bool g_ = a_ > b_; K[46] = g_ ? b_ : a_; K[47] = g_ ? a_ : b_; }
  { const float a_ = K[32], b_ = K[34]; const bool g_ = a_ > b_; K[32] = g_ ? a_ : b_; K[34] = g_ ? b_ : a_; }
  { const float a_ = K[33], b_ = K[35]; const bool g_ = a_ > b_; K[33] = g_ ? a_ : b_; K[35] = g_ ? b_ : a_; }
  { const float a_ = K[36], b_ = K[38]; const bool g_ = a_ > b_; K[36] = g_ ? b_ : a_; K[38] = g_ ? a_ : b_; }
  { const float a_ = K[37], b_ = K[39]; const bool g_ = a_ > b_; K[37] = g_ ? b_ : a_; K[39] = g_ ? a_ : b_; }
  { const float a_ = K[40], b_ = K[42]; const bool g_ = a_ > b_; K[40] = g_ ? a_ : b_; K[42] = g_ ? b_ : a_; }
  { const float a_ = K[41], b_ = K[43]; const bool g_ = a_ > b_; K[41] = g_ ? a_ : b_; K[43] = g_ ? b_ : a_; }
  { const float a_ = K[44], b_ = K[46]; const bool g_ = a_ > b_; K[44] = g_ ? b_ : a_; K[46] = g_ ? a_ : b_; }
  { const float a_ = K[45], b_ = K[47]; const bool g_ = a_ > b_; K[45] = g_ ? b_ : a_; K[47] = g_ ? a_ : b_; }
  { const float a_ = K[32], b_ = K[33]; const bool g_ = a_ > b_; K[32] = g_ ? a_ : b_; K[33] = g_ ? b_ : a_; }
  { const float a_ = K[34], b_ = K[35]; const bool g_ = a_ > b_; K[34] = g_ ? a_ : b_; K[35] = g_ ? b_ : a_; }
  { const float a_ = K[36], b_ = K[37]; const bool g_ = a_ > b_; K[36] = g_ ? b_ : a_; K[37] = g_ ? a_ : b_; }
  { const float a_ = K[38], b_ = K[39]; const bool g_ = a_ > b_; K[38] = g_ ? b_ : a_; K[39] = g_ ? a_ : b_; }
  { const float a_ = K[40], b_ = K[41]; const bool g_ = a_ > b_; K[40] = g_ ? a_ : b_; K[41] = g_ ? b_ : a_; }
  { const float a_ = K[42], b_ = K[43]; const bool g_ = a_ > b_; K[42] = g_ ? a_ : b_; K[43] = g_ ? b_ : a_; }
  { const float a_ = K[44], b_ = K[45]; const bool g_ = a_ > b_; K[44] = g_ ? b_ : a_; K[45] = g_ ? a_ : b_; }
  { const float a_ = K[46], b_ = K[47]; const bool g_ = a_ > b_; K[46] = g_ ? b_ : a_; K[47] = g_ ? a_ : b_; }
  { const float a_ = K[32], b_ = K[36]; const bool g_ = a_ > b_; K[32] = g_ ? a_ : b_; K[36] = g_ ? b_ : a_; }
  { const float a_ = K[33], b_ = K[37]; const bool g_ = a_ > b_; K[33] = g_ ? a_ : b_; K[37] = g_ ? b_ : a_; }
  { const float a_ = K[34], b_ = K[38]; const bool g_ = a_ > b_; K[34] = g_ ? a_ : b_; K[38] = g_ ? b_ : a_; }
  { const float a_ = K[35], b_ = K[39]; const bool g_ = a_ > b_; K[35] = g_ ? a_ : b_; K[39] = g_ ? b_ : a_; }
  { const float a_ = K[40], b_ = K[44]; const bool g_ = a_ > b_; K[40] = g_ ? b_ : a_; K[44] = g_ ? a_ : b_; }
  { const float a_ = K[41], b_ = K[45]; const bool g_ = a_ > b_; K[41] = g_ ? b_ : a_; K[45] = g_ ? a_ : b_; }
  { const float a_ = K[42], b_ = K[46]; const bool g_ = a_ > b_; K[42] = g_ ? b_ : a_; K[46] = g_ ? a_ : b_; }
  { const float a_ = K[43], b_ = K[47]; const bool g_ = a_ > b_; K[43] = g_ ? b_ : a_; K[47] = g_ ? a_ : b_; }
  { const float a_ = K[32], b_ = K[34]; const bool g_ = a_ > b_; K[32] = g_ ? a_ : b_; K[34] = g_ ? b_ : a_; }
  { const float a_ = K[33], b_ = K[35]; const bool g_ = a_ > b_; K[33] = g_ ? a_ : b_; K[35] = g_ ? b_ : a_; }
  { const float a_ = K[36], b_ = K[38]; const bool g_ = a_ > b_; K[36] = g_ ? a_ : b_; K[38] = g_ ? b_ : a_; }
  { const float a_ = K[37], b_ = K[39]; const bool g_ = a_ > b_; K[37] = g_ ? a_ : b_; K[39] = g_ ? b_ : a_; }
  { const float a_ = K[40], b_ = K[42]; const bool g_ = a_ > b_; K[40] = g_ ? b_ : a_; K[42] = g_ ? a_ : b_; }
  { const float a_ = K[41], b_ = K[43]; const bool g_ = a_ > b_; K[41] = g_ ? b_ : a_; K[43] = g_ ? a_ : b_; }
  { const float a_ = K[44], b_ = K[46]; const bool g_ = a_ > b_; K[44] = g_ ? b_ : a_; K[46] = g_ ? a_ : b_; }
  { const float a_ = K[45], b_ = K[47]; const bool g_ = a_ > b_; K[45] = g_ ? b_ : a_; K[47] = g_ ? a_ : b_; }
  { const float a_ = K[32], b_ = K[33]; const bool g_ = a_ > b_; K[32] = g_ ? a_ : b_; K[33] = g_ ? b_ : a_; }
  { const float a_ = K[34], b_ = K[35]; const bool g_ = a_ > b_; K[34] = g_ ? a_ : b_; K[35] = g_ ? b_ : a_; }
  { const float a_ = K[36], b_ = K[37]; const bool g_ = a_ > b_; K[36] = g_ ? a_ : b_; K[37] = g_ ? b_ : a_; }
  { const float a_ = K[38], b_ = K[39]; const bool g_ = a_ > b_; K[38] = g_ ? a_ : b_; K[39] = g_ ? b_ : a_; }
  { const float a_ = K[40], b_ = K[41]; const bool g_ = a_ > b_; K[40] = g_ ? b_ : a_; K[41] = g_ ? a_ : b_; }
  { const float a_ = K[42], b_ = K[43]; const bool g_ = a_ > b_; K[42] = g_ ? b_ : a_; K[43] = g_ ? a_ : b_; }
  { const float a_ = K[44], b_ = K[45]; const bool g_ = a_ > b_; K[44] = g_ ? b_ : a_; K[45] = g_ ? a_ : b_; }
  { const float a_ = K[46], b_ = K[47]; const bool g_ = a_ > b_; K[46] = g_ ? b_ : a_; K[47] = g_ ? a_ : b_; }
  { const float a_ = K[32], b_ = K[40]; const bool g_ = a_ > b_; K[32] = g_ ? a_ : b_; K[40] = g_ ? b_ : a_; }
  { const float a_ = K[33], b_ = K[41]; const bool g_ = a_ > b_; K[33] = g_ ? a_ : b_; K[41] = g_ ? b_ : a_; }
  { const float a_ = K[34], b_ = K[42]; const bool g_ = a_ > b_; K[34] = g_ ? a_ : b_; K[42] = g_ ? b_ : a_; }
  { const float a_ = K[35], b_ = K[43]; const bool g_ = a_ > b_; K[35] = g_ ? a_ : b_; K[43] = g_ ? b_ : a_; }
  { const float a_ = K[36], b_ = K[44]; const bool g_ = a_ > b_; K[36] = g_ ? a_ : b_; K[44] = g_ ? b_ : a_; }
  { const float a_ = K[37], b_ = K[45]; const bool g_ = a_ > b_; K[37] = g_ ? a_ : b_; K[45] = g_ ? b_ : a_; }
  { const float a_ = K[38], b_ = K[46]; const bool g_ = a_ > b_; K[38] = g_ ? a_ : b_; K[46] = g_ ? b_ : a_; }
  { const float a_ = K[39], b_ = K[47]; const bool g_ = a_ > b_; K[39] = g_ ? a_ : b_; K[47] = g_ ? b_ : a_; }
  { const float a_ = K[32], b_ = K[36]; const bool g_ = a_ > b_; K[32] = g_ ? a_ : b_; K[36] = g_ ? b_ : a_; }
  { const float a_ = K[33], b_ = K[37]; const bool g_ = a_ > b_; K[33] = g_ ? a_ : b_; K[37] = g_ ? b_ : a_; }
  { const float a_ = K[34], b_ = K[38]; const bool g_ = a_ > b_; K[34] = g_ ? a_ : b_; K[38] = g_ ? b_ : a_; }
  { const float a_ = K[35], b_ = K[39]; const bool g_ = a_ > b_; K[35] = g_ ? a_ : b_; K[39] = g_ ? b_ : a_; }
  { const float a_ = K[40], b_ = K[44]; const bool g_ = a_ > b_; K[40] = g_ ? a_ : b_; K[44] = g_ ? b_ : a_; }
  { const float a_ = K[41], b_ = K[45]; const bool g_ = a_ > b_; K[41] = g_ ? a_ : b_; K[45] = g_ ? b_ : a_; }
  { const float a_ = K[42], b_ = K[46]; const bool g_ = a_ > b_; K[42] = g_ ? a_ : b_; K[46] = g_ ? b_ : a_; }
  { const float a_ = K[43], b_ = K[47]; const bool g_ = a_ > b_; K[43] = g_ ? a_ : b_; K[47] = g_ ? b_ : a_; }
  { const float a_ = K[32], b_ = K[34]; const bool g_ = a_ > b_; K[32] = g_ ? a_ : b_; K[34] = g_ ? b_ : a_; }
  { const float a_ = K[33], b_ = K[35]; const bool g_ = a_ > b_; K[33] = g_ ? a_ : b_; K[35] = g_ ? b_ : a_; }
  { const float a_ = K[36], b_ = K[38]; const bool g_ = a_ > b_; K[36] = g_ ? a_ : b_; K[38] = g_ ? b_ : a_; }
  { const float a_ = K[37], b_ = K[39]; const bool g_ = a_ > b_; K[37] = g_ ? a_ : b_; K[39] = g_ ? b_ : a_; }
  { const float a_ = K[40], b_ = K[42]; const bool g_ = a_ > b_; K[40] = g_ ? a_ : b_; K[42] = g_ ? b_ : a_; }
  { const float a_ = K[41], b_ = K[43]; const bool g_ = a_ > b_; K[41] = g_ ? a_ : b_; K[43] = g_ ? b_ : a_; }
  { const float a_ = K[44], b_ = K[46]; const bool g_ = a_ > b_; K[44] = g_ ? a_ : b_; K[46] = g_ ? b_ : a_; }
  { const float a_ = K[45], b_ = K[47]; const bool g_ = a_ > b_; K[45] = g_ ? a_ : b_; K[47] = g_ ? b_ : a_; }
  { const float a_ = K[32], b_ = K[33]; const bool g_ = a_ > b_; K[32] = g_ ? a_ : b_; K[33] = g_ ? b_ : a_; }
  { const float a_ = K[34], b_ = K[35]; const bool g_ = a_ > b_; K[34] = g_ ? a_ : b_; K[35] = g_ ? b_ : a_; }
  { const float a_ = K[36], b_ = K[37]; const bool g_ = a_ > b_; K[36] = g_ ? a_ : b_; K[37] = g_ ? b_ : a_; }
  { const float a_ = K[38], b_ = K[39]; const bool g_ = a_ > b_; K[38] = g_ ? a_ : b_; K[39] = g_ ? b_ : a_; }
  { const float a_ = K[40], b_ = K[41]; const bool g_ = a_ > b_; K[40] = g_ ? a_ : b_; K[41] = g_ ? b_ : a_; }
  { const float a_ = K[42], b_ = K[43]; const bool g_ = a_ > b_; K[42] = g_ ? a_ : b_; K[43] = g_ ? b_ : a_; }
  { const float a_ = K[44], b_ = K[45]; const bool g_ = a_ > b_; K[44] = g_ ? a_ : b_; K[45] = g_ ? b_ : a_; }
  { const float a_ = K[46], b_ = K[47]; const bool g_ = a_ > b_; K[46] = g_ ? a_ : b_; K[47] = g_ ? b_ : a_; }
  { const float a_ = K[48], b_ = K[49]; const bool g_ = a_ > b_; K[48] = g_ ? a_ : b_; K[49] = g_ ? b_ : a_; }
  { const float a_ = K[50], b_ = K[51]; const bool g_ = a_ > b_; K[50] = g_ ? b_ : a_; K[51] = g_ ? a_ : b_; }
  { const float a_ = K[52], b_ = K[53]; const bool g_ = a_ > b_; K[52] = g_ ? a_ : b_; K[53] = g_ ? b_ : a_; }
  { const float a_ = K[54], b_ = K[55]; const bool g_ = a_ > b_; K[54] = g_ ? b_ : a_; K[55] = g_ ? a_ : b_; }
  { const float a_ = K[56], b_ = K[57]; const bool g_ = a_ > b_; K[56] = g_ ? a_ : b_; K[57] = g_ ? b_ : a_; }
  { const float a_ = K[58], b_ = K[59]; const bool g_ = a_ > b_; K[58] = g_ ? b_ : a_; K[59] = g_ ? a_ : b_; }
  { const float a_ = K[60], b_ = K[61]; const bool g_ = a_ > b_; K[60] = g_ ? a_ : b_; K[61] = g_ ? b_ : a_; }
  { const float a_ = K[62], b_ = K[63]; const bool g_ = a_ > b_; K[62] = g_ ? b_ : a_; K[63] = g_ ? a_ : b_; }
  { const float a_ = K[48], b_ = K[50]; const bool g_ = a_ > b_; K[48] = g_ ? a_ : b_; K[50] = g_ ? b_ : a_; }
  { const float a_ = K[49], b_ = K[51]; const bool g_ = a_ > b_; K[49] = g_ ? a_ : b_; K[51] = g_ ? b_ : a_; }
  { const float a_ = K[52], b_ = K[54]; const bool g_ = a_ > b_; K[52] = g_ ? b_ : a_; K[54] = g_ ? a_ : b_; }
  { const float a_ = K[53], b_ = K[55]; const bool g_ = a_ > b_; K[53] = g_ ? b_ : a_; K[55] = g_ ? a_ : b_; }
  { const float a_ = K[56], b_ = K[58]; const bool g_ = a_ > b_; K[56] = g_ ? a_ : b_; K[58] = g_ ? b_ : a_; }
  { const float a_ = K[57], b_ = K[59]; const bool g_ = a_ > b_; K[57] = g_ ? a_ : b_; K[59] = g_ ? b_ : a_; }
  { const float a_ = K[60], b_ = K[62]; const bool g_ = a_ > b_; K[60] = g_ ? b_ : a_; K[62] = g_ ? a_ : b_; }
  { const float a_ = K[61], b_ = K[63]; const bool g_ = a_ > b_; K[61] = g_ ? b_ : a_; K[63] = g_ ? a_ : b_; }
  { const float a_ = K[48], b_ = K[49]; const bool g_ = a_ > b_; K[48] = g_ ? a_ : b_; K[49] = g_ ? b_ : a_; }
  { const float a_ = K[50], b_ = K[51]; const bool g_ = a_ > b_; K[50] = g_ ? a_ : b_; K[51] = g_ ? b_ : a_; }
  { const float a_ = K[52], b_ = K[53]; const bool g_ = a_ > b_; K[52] = g_ ? b_ : a_; K[53] = g_ ? a_ : b_; }
  { const float a_ = K[54], b_ = K[55]; const bool g_ = a_ > b_; K[54] = g_ ? b_ : a_; K[55] = g_ ? a_ : b_; }
  { const float a_ = K[56], b_ = K[57]; const bool g_ = a_ > b_; K[56] = g_ ? a_ : b_; K[57] = g_ ? b_ : a_; }
  { const float a_ = K[58], b_ = K[59]; const bool g_ = a_ > b_; K[58] = g_ ? a_ : b_; K[59] = g_ ? b_ : a_; }
  { const float a_ = K[60], b_ = K[61]; const bool g_ = a_ > b_; K[60] = g_ ? b_ : a_; K[61] = g_ ? a_ : b_; }
  { const float a_ = K[62], b_ = K[63]; const bool g_ = a_ > b_; K[62] = g_ ? b_ : a_; K[63] = g_ ? a_ : b_; }
  { const float a_ = K[48], b_ = K[52]; const bool g_ = a_ > b_; K[48] = g_ ? a_ : b_; K[52] = g_ ? b_ : a_; }
  { const float a_ = K[49], b_ = K[53]; const bool g_ = a_ > b_; K[49] = g_ ? a_ : b_; K[53] = g_ ? b_ : a_; }
  { const float a_ = K[50], b_ = K[54]; const bool g_ = a_ > b_; K[50] = g_ ? a_ : b_; K[54] = g_ ? b_ : a_; }
  { const float a_ = K[51], b_ = K[55]; const bool g_ = a_ > b_; K[51] = g_ ? a_ : b_; K[55] = g_ ? b_ : a_; }
  { const float a_ = K[56], b_ = K[60]; const bool g_ = a_ > b_; K[56] = g_ ? b_ : a_; K[60] = g_ ? a_ : b_; }
  { const float a_ = K[57], b_ = K[61]; const bool g_ = a_ > b_; K[57] = g_ ? b_ : a_; K[61] = g_ ? a_ : b_; }
  { const float a_ = K[58], b_ = K[62]; const bool g_ = a_ > b_; K[58] = g_ ? b_ : a_; K[62] = g_ ? a_ : b_; }
  { const float a_ = K[59], b_ = K[63]; const bool g_ = a_ > b_; K[59] = g_ ? b_ : a_; K[63] = g_ ? a_ : b_; }
  { const float a_ = K[48], b_ = K[50]; const bool g_ = a_ > b_; K[48] = g_ ? a_ : b_; K[50] = g_ ? b_ : a_; }
  { const float a_ = K[49], b_ = K[51]; const bool g_ = a_ > b_; K[49] = g_ ? a_ : b_; K[51] = g_ ? b_ : a_; }
  { const float a_ = K[52], b_ = K[54]; const bool g_ = a_ > b_; K[52] = g_ ? a_ : b_; K[54] = g_ ? b_ : a_; }
  { const float a_ = K[53], b_ = K[55]; const bool g_ = a_ > b_; K[53] = g_ ? a_ : b_; K[55] = g_ ? b_ : a_; }
  { const float a_ = K[56], b_ = K[58]; const bool g_ = a_ > b_; K[56] = g_ ? b_ : a_; K[58] = g_ ? a_ : b_; }
  { const float a_ = K[57], b_ = K[59]; const bool g_ = a_ > b_; K[57] = g_ ? b_ : a_; K[59] = g_ ? a_ : b_; }
  { const float a_ = K[60], b_ = K[62]; const bool g_ = a_ > b_; K[60] = g_ ? b_ : a_; K[62] = g_ ? a_ : b_; }
  { const float a_ = K[61], b_ = K[63]; const bool g_ = a_ > b_; K[61] = g_ ? b_ : a_; K[63] = g_ ? a_ : b_; }
  { const float a_ = K[48], b_ = K[49]; const bool g_ = a_ > b_; K[48] = g_ ? a_ : b_; K[49] = g_ ? b_ : a_; }
  { const float a_ = K[50], b_ = K[51]; const bool g_ = a_ > b_; K[50] = g_ ? a_ : b_; K[51] = g_ ? b_ : a_; }
  { const float a_ = K[52], b_ = K[53]; const bool g_ = a_ > b_; K[52] = g_ ? a_ : b_; K[53] = g_ ? b_ : a_; }
  { const float a_ = K[54], b_ = K[55]; const bool g_ = a_ > b_; K[54] = g_ ? a_ : b_; K[55] = g_ ? b_ : a_; }
  { const float a_ = K[56], b_ = K[57]; const bool g_ = a_ > b_; K[56] = g_ ? b_ : a_; K[57] = g_ ? a_ : b_; }
  { const float a_ = K[58], b_ = K[59]; const bool g_ = a_ > b_; K[58] = g_ ? b_ : a_; K[59] = g_ ? a_ : b_; }
  { const float a_ = K[60], b_ = K[61]; const bool g_ = a_ > b_; K[60] = g_ ? b_ : a_; K[61] = g_ ? a_ : b_; }
  { const float a_ = K[62], b_ = K[63]; const bool g_ = a_ > b_; K[62] = g_ ? b_ : a_; K[63] = g_ ? a_ : b_; }
  { const float a_ = K[48], b_ = K[56]; const bool g_ = a_ > b_; K[48] = g_ ? a_ : b_; K[56] = g_ ? b_ : a_; }
  { const float a_ = K[49], b_ = K[57]; const bool g_ = a_ > b_; K[49] = g_ ? a_ : b_; K[57] = g_ ? b_ : a_; }
  { const float a_ = K[50], b_ = K[58]; const bool g_ = a_ > b_; K[50] = g_ ? a_ : b_; K[58] = g_ ? b_ : a_; }
  { const float a_ = K[51], b_ = K[59]; const bool g_ = a_ > b_; K[51] = g_ ? a_ : b_; K[59] = g_ ? b_ : a_; }
  { const float a_ = K[52], b_ = K[60]; const bool g_ = a_ > b_; K[52] = g_ ? a_ : b_; K[60] = g_ ? b_ : a_; }
  { const float a_ = K[53], b_ = K[61]; const bool g_ = a_ > b_; K[53] = g_ ? a_ : b_; K[61] = g_ ? b_ : a_; }
  { const float a_ = K[54], b_ = K[62]; const bool g_ = a_ > b_; K[54] = g_ ? a_ : b_; K[62] = g_ ? b_ : a_; }
  { const float a_ = K[55], b_ = K[63]; const bool g_ = a_ > b_; K[55] = g_ ? a_ : b_; K[63] = g_ ? b_ : a_; }
  { const float a_ = K[48], b_ = K[52]; const bool g_ = a_ > b_; K[48] = g_ ? a_ : b_; K[52] = g_ ? b_ : a_; }
  { const float a_ = K[49], b_ = K[53]; const bool g_ = a_ > b_; K[49] = g_ ? a_ : b_; K[53] = g_ ? b_ : a_; }
  { const float a_ = K[50], b_ = K[54]; const bool g_ = a_ > b_; K[50] = g_ ? a_ : b_; K[54] = g_ ? b_ : a_; }
  { const float a_ = K[51], b_ = K[55]; const bool g_ = a_ > b_; K[51] = g_ ? a_ : b_; K[55] = g_ ? b_ : a_; }
  { const float a_ = K[56], b_ = K[60]; const bool g_ = a_ > b_; K[56] = g_ ? a_ : b_; K[60] = g_ ? b_ : a_; }
  { const float a_ = K[57], b_ = K[61]; const bool g_ = a_ > b_; K[57] = g_ ? a_ : b_; K[61] = g_ ? b_ : a_; }
  { const float a_ = K[58], b_ = K[62]; const bool g_ = a_ > b_; K[58] = g_ ? a_ : b_; K[62] = g_ ? b_ : a_; }
  { const float a_ = K[59], b_ = K[63]; const bool g_ = a_ > b_; K[59] = g_ ? a_ : b_; K[63] = g_ ? b_ : a_; }
  { const float a_ = K[48], b_ = K[50]; const bool g_ = a_ > b_; K[48] = g_ ? a_ : b_; K[50] = g_ ? b_ : a_; }
  { const float a_ = K[49], b_ = K[51]; const bool g_ = a_ > b_; K[49] = g_ ? a_ : b_; K[51] = g_ ? b_ : a_; }
  { const float a_ = K[52], b_ = K[54]; const bool g_ = a_ > b_; K[52] = g_ ? a_ : b_; K[54] = g_ ? b_ : a_; }
  { const float a_ = K[53], b_ = K[55]; const bool g_ = a_ > b_; K[53] = g_ ? a_ : b_; K[55] = g_ ? b_ : a_; }
  { const float a_ = K[56], b_ = K[58]; const bool g_ = a_ > b_; K[56] = g_ ? a_ : b_; K[58] = g_ ? b_ : a_; }
  { const float a_ = K[57], b_ = K[59]; const bool g_ = a_ > b_; K[57] = g_ ? a_ : b_; K[59] = g_ ? b_ : a_; }
  { const float a_ = K[60], b_ = K[62]; const bool g_ = a_ > b_; K[60] = g_ ? a_ : b_; K[62] = g_ ? b_ : a_; }
  { const float a_ = K[61], b_ = K[63]; const bool g_ = a_ > b_; K[61] = g_ ? a_ : b_; K[63] = g_ ? b_ : a_; }
  { const float a_ = K[48], b_ = K[49]; const bool g_ = a_ > b_; K[48] = g_ ? a_ : b_; K[49] = g_ ? b_ : a_; }
  { const float a_ = K[50], b_ = K[51]; const bool g_ = a_ > b_; K[50] = g_ ? a_ : b_; K[51] = g_ ? b_ : a_; }
  { const float a_ = K[52], b_ = K[53]; const bool g_ = a_ > b_; K[52] = g_ ? a_ : b_; K[53] = g_ ? b_ : a_; }
  { const float a_ = K[54], b_ = K[55]; const bool g_ = a_ > b_; K[54] = g_ ? a_ : b_; K[55] = g_ ? b_ : a_; }
  { const float a_ = K[56], b_ = K[57]; const bool g_ = a_ > b_; K[56] = g_ ? a_ : b_; K[57] = g_ ? b_ : a_; }
  { const float a_ = K[58], b_ = K[59]; const bool g_ = a_ > b_; K[58] = g_ ? a_ : b_; K[59] = g_ ? b_ : a_; }
  { const float a_ = K[60], b_ = K[61]; const bool g_ = a_ > b_; K[60] = g_ ? a_ : b_; K[61] = g_ ? b_ : a_; }
  { const float a_ = K[62], b_ = K[63]; const bool g_ = a_ > b_; K[62] = g_ ? a_ : b_; K[63] = g_ ? b_ : a_; }
  { const float a_ = K[0], b_ = K[31]; K[0] = a_ > b_ ? a_ : b_; }
  { const float a_ = K[1], b_ = K[30]; K[1] = a_ > b_ ? a_ : b_; }
  { const float a_ = K[2], b_ = K[29]; K[2] = a_ > b_ ? a_ : b_; }
  { const float a_ = K[3], b_ = K[28]; K[3] = a_ > b_ ? a_ : b_; }
  { const float a_ = K[4], b_ = K[27]; K[4] = a_ > b_ ? a_ : b_; }
  { const float a_ = K[5], b_ = K[26]; K[5] = a_ > b_ ? a_ : b_; }
  { const float a_ = K[6], b_ = K[25]; K[6] = a_ > b_ ? a_ : b_; }
  { const float a_ = K[7], b_ = K[24]; K[7] = a_ > b_ ? a_ : b_; }
  { const float a_ = K[8], b_ = K[23]; K[8] = a_ > b_ ? a_ : b_; }
  { const float a_ = K[9], b_ = K[22]; K[9] = a_ > b_ ? a_ : b_; }
  { const float a_ = K[10], b_ = K[21]; K[10] = a_ > b_ ? a_ : b_; }
  { const float a_ = K[11], b_ = K[20]; K[11] = a_ > b_ ? a_ : b_; }
  { const float a_ = K[12], b_ = K[19]; K[12] = a_ > b_ ? a_ : b_; }
  { const float a_ = K[13], b_ = K[18]; K[13] = a_ > b_ ? a_ : b_; }
  { const float a_ = K[14], b_ = K[17]; K[14] = a_ > b_ ? a_ : b_; }
  { const float a_ = K[15], b_ = K[16]; K[15] = a_ > b_ ? a_ : b_; }
  { const float a_ = K[0], b_ = K[8]; const bool g_ = a_ > b_; K[0] = g_ ? a_ : b_; K[8] = g_ ? b_ : a_; }
  { const float a_ = K[1], b_ = K[9]; const bool g_ = a_ > b_; K[1] = g_ ? a_ : b_; K[9] = g_ ? b_ : a_; }
  { const float a_ = K[2], b_ = K[10]; const bool g_ = a_ > b_; K[2] = g_ ? a_ : b_; K[10] = g_ ? b_ : a_; }
  { const float a_ = K[3], b_ = K[11]; const bool g_ = a_ > b_; K[3] = g_ ? a_ : b_; K[11] = g_ ? b_ : a_; }
  { const float a_ = K[4], b_ = K[12]; const bool g_ = a_ > b_; K[4] = g_ ? a_ : b_; K[12] = g_ ? b_ : a_; }
  { const float a_ = K[5], b_ = K[13]; const bool g_ = a_ > b_; K[5] = g_ ? a_ : b_; K[13] = g_ ? b_ : a_; }
  { const float a_ = K[6], b_ = K[14]; const bool g_ = a_ > b_; K[6] = g_ ? a_ : b_; K[14] = g_ ? b_ : a_; }
  { const float a_ = K[7], b_ = K[15]; const bool g_ = a_ > b_; K[7] = g_ ? a_ : b_; K[15] = g_ ? b_ : a_; }
  { const float a_ = K[0], b_ = K[4]; const bool g_ = a_ > b_; K[0] = g_ ? a_ : b_; K[4] = g_ ? b_ : a_; }
  { const float a_ = K[1], b_ = K[5]; const bool g_ = a_ > b_; K[1] = g_ ? a_ : b_; K[5] = g_ ? b_ : a_; }
  { const float a_ = K[2], b_ = K[6]; const bool g_ = a_ > b_; K[2] = g_ ? a_ : b_; K[6] = g_ ? b_ : a_; }
  { const float a_ = K[3], b_ = K[7]; const bool g_ = a_ > b_; K[3] = g_ ? a_ : b_; K[7] = g_ ? b_ : a_; }
  { const float a_ = K[8], b_ = K[12]; const bool g_ = a_ > b_; K[8] = g_ ? a_ : b_; K[12] = g_ ? b_ : a_; }
  { const float a_ = K[9], b_ = K[13]; const bool g_ = a_ > b_; K[9] = g_ ? a_ : b_; K[13] = g_ ? b_ : a_; }
  { const float a_ = K[10], b_ = K[14]; const bool g_ = a_ > b_; K[10] = g_ ? a_ : b_; K[14] = g_ ? b_ : a_; }
  { const float a_ = K[11], b_ = K[15]; const bool g_ = a_ > b_; K[11] = g_ ? a_ : b_; K[15] = g_ ? b_ : a_; }
  { const float a_ = K[0], b_ = K[2]; const bool g_ = a_ > b_; K[0] = g_ ? a_ : b_; K[2] = g_ ? b_ : a_; }
  { const float a_ = K[1], b_ = K[3]; const bool g_ = a_ > b_; K[1] = g_ ? a_ : b_; K[3] = g_ ? b_ : a_; }
  { const float a_ = K[4], b_ = K[6]; const bool g_ = a_ > b_; K[4] = g_ ? a_ : b_; K[6] = g_ ? b_ : a_; }
  { const float a_ = K[5], b_ = K[7]; const bool g_ = a_ > b_; K[5] = g_ ? a_ : b_; K[7] = g_ ? b_ : a_; }
  { const float a_ = K[8], b_ = K[10]; const bool g_ = a_ > b_; K[8] = g_ ? a_ : b_; K[10] = g_ ? b_ : a_; }
  { const float a_ = K[9], b_ = K[11]; const bool g_ = a_ > b_; K[9] = g_ ? a_ : b_; K[11] = g_ ? b_ : a_; }
  { const float a_ = K[12], b_ = K[14]; const bool g_ = a_ > b_; K[12] = g_ ? a_ : b_; K[14] = g_ ? b_ : a_; }
  { const float a_ = K[13], b_ = K[15]; const bool g_ = a_ > b_; K[13] = g_ ? a_ : b_; K[15] = g_ ? b_ : a_; }
  { const float a_ = K[0], b_ = K[1]; const bool g_ = a_ > b_; K[0] = g_ ? a_ : b_; K[1] = g_ ? b_ : a_; }
  { const float a_ = K[2], b_ = K[3]; const bool g_ = a_ > b_; K[2] = g_ ? a_ : b_; K[3] = g_ ? b_ : a_; }
  { const float a_ = K[4], b_ = K[5]; const bool g_ = a_ > b_; K[4] = g_ ? a_ : b_; K[5] = g_ ? b_ : a_; }
  { const float a_ = K[6], b_ = K[7]; const bool g_ = a_ > b_; K[6] = g_ ? a_ : b_; K[7] = g_ ? b_ : a_; }
  { const float a_ = K[8], b_ = K[9]; const bool g_ = a_ > b_; K[8] = g_ ? a_ : b_; K[9] = g_ ? b_ : a_; }
  { const float a_ = K[10], b_ = K[11]; const bool g_ = a_ > b_; K[10] = g_ ? a_ : b_; K[11] = g_ ? b_ : a_; }
  { const float a_ = K[12], b_ = K[13]; const bool g_ = a_ > b_; K[12] = g_ ? a_ : b_; K[13] = g_ ? b_ : a_; }
  { const float a_ = K[14], b_ = K[15]; const bool g_ = a_ > b_; K[14] = g_ ? a_ : b_; K[15] = g_ ? b_ : a_; }
  { const float a_ = K[32], b_ = K[63]; K[32] = a_ > b_ ? a_ : b_; }
  { const float a_ = K[33], b_ = K[62]; K[33] = a_ > b_ ? a_ : b_; }
  { const float a_ = K[34], b_ = K[61]; K[34] = a_ > b_ ? a_ : b_; }
  { const float a_ = K[35], b_ = K[60]; K[35] = a_ > b_ ? a_ : b_; }
  { const float a_ = K[36], b_ = K[59]; K[36] = a_ > b_ ? a_ : b_; }
  { const float a_ = K[37], b_ = K[58]; K[37] = a_ > b_ ? a_ : b_; }
  { const float a_ = K[38], b_ = K[57]; K[38] = a_ > b_ ? a_ : b_; }
  { const float a_ = K[39], b_ = K[56]; K[39] = a_ > b_ ? a_ : b_; }
  { const float a_ = K[40], b_ = K[55]; K[40] = a_ > b_ ? a_ : b_; }
  { const float a_ = K[41], b_ = K[54]; K[41] = a_ > b_ ? a_ : b_; }
  { const float a_ = K[42], b_ = K[53]; K[42] = a_ > b_ ? a_ : b_; }
  { const float a_ = K[43], b_ = K[52]; K[43] = a_ > b_ ? a_ : b_; }
  { const float a_ = K[44], b_ = K[51]; K[44] = a_ > b_ ? a_ : b_; }
  { const float a_ = K[45], b_ = K[50]; K[45] = a_ > b_ ? a_ : b_; }
  { const float a_ = K[46], b_ = K[49]; K[46] = a_ > b_ ? a_ : b_; }
  { const float a_ = K[47], b_ = K[48]; K[47] = a_ > b_ ? a_ : b_; }
  { const float a_ = K[32], b_ = K[40]; const bool g_ = a_ > b_; K[32] = g_ ? a_ : b_; K[40] = g_ ? b_ : a_; }
  { const float a_ = K[33], b_ = K[41]; const bool g_ = a_ > b_; K[33] = g_ ? a_ : b_; K[41] = g_ ? b_ : a_; }
  { const float a_ = K[34], b_ = K[42]; const bool g_ = a_ > b_; K[34] = g_ ? a_ : b_; K[42] = g_ ? b_ : a_; }
  { const float a_ = K[35], b_ = K[43]; const bool g_ = a_ > b_; K[35] = g_ ? a_ : b_; K[43] = g_ ? b_ : a_; }
  { const float a_ = K[36], b_ = K[44]; const bool g_ = a_ > b_; K[36] = g_ ? a_ : b_; K[44] = g_ ? b_ : a_; }
  { const float a_ = K[37], b_ = K[45]; const bool g_ = a_ > b_; K[37] = g_ ? a_ : b_; K[45] = g_ ? b_ : a_; }
  { const float a_ = K[38], b_ = K[46]; const bool g_ = a_ > b_; K[38] = g_ ? a_ : b_; K[46] = g_ ? b_ : a_; }
  { const float a_ = K[39], b_ = K[47]; const bool g_ = a_ > b_; K[39] = g_ ? a_ : b_; K[47] = g_ ? b_ : a_; }
  { const float a_ = K[32], b_ = K[36]; const bool g_ = a_ > b_; K[32] = g_ ? a_ : b_; K[36] = g_ ? b_ : a_; }
  { const float a_ = K[33], b_ = K[37]; const bool g_ = a_ > b_; K[33] = g_ ? a_ : b_; K[37] = g_ ? b_ : a_; }
  { const float a_ = K[34], b_ = K[38]; const bool g_ = a_ > b_; K[34] = g_ ? a_ : b_; K[38] = g_ ? b_ : a_; }
  { const float a_ = K[35], b_ = K[39]; const bool g_ = a_ > b_; K[35] = g_ ? a_ : b_; K[39] = g_ ? b_ : a_; }
  { const float a_ = K[40], b_ = K[44]; const bool g_ = a_ > b_; K[40] = g_ ? a_ : b_; K[44] = g_ ? b_ : a_; }
  { const float a_ = K[41], b_ = K[45]; const bool g_ = a_ > b_; K[41] = g_ ? a_ : b_; K[45] = g_ ? b_ : a_; }
  { const float a_ = K[42], b_ = K[46]; const bool g_ = a_ > b_; K[42] = g_ ? a_ : b_; K[46] = g_ ? b_ : a_; }
  { const float a_ = K[43], b_ = K[47]; const bool g_ = a_ > b_; K[43] = g_ ? a_ : b_; K[47] = g_ ? b_ : a_; }
  { const float a_ = K[32], b_ = K[34]; const bool g_ = a_ > b_; K[32] = g_ ? a_ : b_; K[34] = g_ ? b_ : a_; }
  { const float a_ = K[33], b_ = K[35]; const bool g_ = a_ > b_; K[33] = g_ ? a_ : b_; K[35] = g_ ? b_ : a_; }
  { const float a_ = K[36], b_ = K[38]; const bool g_ = a_ > b_; K[36] = g_ ? a_ : b_; K[38] = g_ ? b_ : a_; }
  { const float a_ = K[37], b_ = K[39]; const bool g_ = a_ > b_; K[37] = g_ ? a_ : b_; K[39] = g_ ? b_ : a_; }
  { const float a_ = K[40], b_ = K[42]; const bool g_ = a_ > b_; K[40] = g_ ? a_ : b_; K[42] = g_ ? b_ : a_; }
  { const float a_ = K[41], b_ = K[43]; const bool g_ = a_ > b_; K[41] = g_ ? a_ : b_; K[43] = g_ ? b_ : a_; }
  { const float a_ = K[44], b_ = K[46]; const bool g_ = a_ > b_; K[44] = g_ ? a_ : b_; K[46] = g_ ? b_ : a_; }
  { const float a_ = K[45], b_ = K[47]; const bool g_ = a_ > b_; K[45] = g_ ? a_ : b_; K[47] = g_ ? b_ : a_; }
  { const float a_ = K[32], b_ = K[33]; const bool g_ = a_ > b_; K[32] = g_ ? a_ : b_; K[33] = g_ ? b_ : a_; }
  { const float a_ = K[34], b_ = K[35]; const bool g_ = a_ > b_; K[34] = g_ ? a_ : b_; K[35] = g_ ? b_ : a_; }
  { const float a_ = K[36], b_ = K[37]; const bool g_ = a_ > b_; K[36] = g_ ? a_ : b_; K[37] = g_ ? b_ : a_; }
  { const float a_ = K[38], b_ = K[39]; const bool g_ = a_ > b_; K[38] = g_ ? a_ : b_; K[39] = g_ ? b_ : a_; }
  { const float a_ = K[40], b_ = K[41]; const bool g_ = a_ > b_; K[40] = g_ ? a_ : b_; K[41] = g_ ? b_ : a_; }
  { const float a_ = K[42], b_ = K[43]; const bool g_ = a_ > b_; K[42] = g_ ? a_ : b_; K[43] = g_ ? b_ : a_; }
  { const float a_ = K[44], b_ = K[45]; const bool g_ = a_ > b_; K[44] = g_ ? a_ : b_; K[45] = g_ ? b_ : a_; }
  { const float a_ = K[46], b_ = K[47]; const bool g_ = a_ > b_; K[46] = g_ ? a_ : b_; K[47] = g_ ? b_ : a_; }
  { const float a_ = K[0], b_ = K[47]; K[0] = a_ > b_ ? a_ : b_; }
  { const float a_ = K[1], b_ = K[46]; K[1] = a_ > b_ ? a_ : b_; }
  { const float a_ = K[2], b_ = K[45]; K[2] = a_ > b_ ? a_ : b_; }
  { const float a_ = K[3], b_ = K[44]; K[3] = a_ > b_ ? a_ : b_; }
  { const float a_ = K[4], b_ = K[43]; K[4] = a_ > b_ ? a_ : b_; }
  { const float a_ = K[5], b_ = K[42]; K[5] = a_ > b_ ? a_ : b_; }
  { const float a_ = K[6], b_ = K[41]; K[6] = a_ > b_ ? a_ : b_; }
  { const float a_ = K[7], b_ = K[40]; K[7] = a_ > b_ ? a_ : b_; }
  { const float a_ = K[8], b_ = K[39]; K[8] = a_ > b_ ? a_ : b_; }
  { const float a_ = K[9], b_ = K[38]; K[9] = a_ > b_ ? a_ : b_; }
  { const float a_ = K[10], b_ = K[37]; K[10] = a_ > b_ ? a_ : b_; }
  { const float a_ = K[11], b_ = K[36]; K[11] = a_ > b_ ? a_ : b_; }
  { const float a_ = K[12], b_ = K[35]; K[12] = a_ > b_ ? a_ : b_; }
  { const float a_ = K[13], b_ = K[34]; K[13] = a_ > b_ ? a_ : b_; }
  { const float a_ = K[14], b_ = K[33]; K[14] = a_ > b_ ? a_ : b_; }
  { const float a_ = K[15], b_ = K[32]; K[15] = a_ > b_ ? a_ : b_; }
  { const float a_ = K[0], b_ = K[8]; const bool g_ = a_ > b_; K[0] = g_ ? a_ : b_; K[8] = g_ ? b_ : a_; }
  { const float a_ = K[1], b_ = K[9]; const bool g_ = a_ > b_; K[1] = g_ ? a_ : b_; K[9] = g_ ? b_ : a_; }
  { const float a_ = K[2], b_ = K[10]; const bool g_ = a_ > b_; K[2] = g_ ? a_ : b_; K[10] = g_ ? b_ : a_; }
  { const float a_ = K[3], b_ = K[11]; const bool g_ = a_ > b_; K[3] = g_ ? a_ : b_; K[11] = g_ ? b_ : a_; }
  { const float a_ = K[4], b_ = K[12]; const bool g_ = a_ > b_; K[4] = g_ ? a_ : b_; K[12] = g_ ? b_ : a_; }
  { const float a_ = K[5], b_ = K[13]; const bool g_ = a_ > b_; K[5] = g_ ? a_ : b_; K[13] = g_ ? b_ : a_; }
  { const float a_ = K[6], b_ = K[14]; const bool g_ = a_ > b_; K[6] = g_ ? a_ : b_; K[14] = g_ ? b_ : a_; }
  { const float a_ = K[7], b_ = K[15]; const bool g_ = a_ > b_; K[7] = g_ ? a_ : b_; K[15] = g_ ? b_ : a_; }
  { const float a_ = K[0], b_ = K[4]; const bool g_ = a_ > b_; K[0] = g_ ? a_ : b_; K[4] = g_ ? b_ : a_; }
  { const float a_ = K[1], b_ = K[5]; const bool g_ = a_ > b_; K[1] = g_ ? a_ : b_; K[5] = g_ ? b_ : a_; }
  { const float a_ = K[2], b_ = K[6]; const bool g_ = a_ > b_; K[2] = g_ ? a_ : b_; K[6] = g_ ? b_ : a_; }
  { const float a_ = K[3], b_ = K[7]; const bool g_ = a_ > b_; K[3] = g_ ? a_ : b_; K[7] = g_ ? b_ : a_; }
  { const float a_ = K[8], b_ = K[12]; const bool g_ = a_ > b_; K[8] = g_ ? a_ : b_; K[12] = g_ ? b_ : a_; }
  { const float a_ = K[9], b_ = K[13]; const bool g_ = a_ > b_; K[9] = g_ ? a_ : b_; K[13] = g_ ? b_ : a_; }
  { const float a_ = K[10], b_ = K[14]; const bool g_ = a_ > b_; K[10] = g_ ? a_ : b_; K[14] = g_ ? b_ : a_; }
  { const float a_ = K[11], b_ = K[15]; const bool g_ = a_ > b_; K[11] = g_ ? a_ : b_; K[15] = g_ ? b_ : a_; }
  { const float a_ = K[0], b_ = K[2]; const bool g_ = a_ > b_; K[0] = g_ ? a_ : b_; K[2] = g_ ? b_ : a_; }
  { const float a_ = K[1], b_ = K[3]; const bool g_ = a_ > b_; K[1] = g_ ? a_ : b_; K[3] = g_ ? b_ : a_; }
  { const float a_ = K[4], b_ = K[6]; const bool g_ = a_ > b_; K[4] = g_ ? a_ : b_; K[6] = g_ ? b_ : a_; }
  { const float a_ = K[5], b_ = K[7]; const bool g_ = a_ > b_; K[5] = g_ ? a_ : b_; K[7] = g_ ? b_ : a_; }
  { const float a_ = K[8], b_ = K[10]; const bool g_ = a_ > b_; K[8] = g_ ? a_ : b_; K[10] = g_ ? b_ : a_; }
  { const float a_ = K[9], b_ = K[11]; const bool g_ = a_ > b_; K[9] = g_ ? a_ : b_; K[11] = g_ ? b_ : a_; }
  { const float a_ = K[12], b_ = K[14]; const bool g_ = a_ > b_; K[12] = g_ ? a_ : b_; K[14] = g_ ? b_ : a_; }
  { const float a_ = K[13], b_ = K[15]; const bool g_ = a_ > b_; K[13] = g_ ? a_ : b_; K[15] = g_ ? b_ : a_; }
  { const float a_ = K[0], b_ = K[1]; const bool g_ = a_ > b_; K[0] = g_ ? a_ : b_; K[1] = g_ ? b_ : a_; }
  { const float a_ = K[2], b_ = K[3]; const bool g_ = a_ > b_; K[2] = g_ ? a_ : b_; K[3] = g_ ? b_ : a_; }
  { const float a_ = K[4], b_ = K[5]; const bool g_ = a_ > b_; K[4] = g_ ? a_ : b_; K[5] = g_ ? b_ : a_; }
  { const float a_ = K[6], b_ = K[7]; const bool g_ = a_ > b_; K[6] = g_ ? a_ : b_; K[7] = g_ ? b_ : a_; }
  { const float a_ = K[8], b_ = K[9]; const bool g_ = a_ > b_; K[8] = g_ ? a_ : b_; K[9] = g_ ? b_ : a_; }
  { const float a_ = K[10], b_ = K[11]; const bool g_ = a_ > b_; K[10] = g_ ? a_ : b_; K[11] = g_ ? b_ : a_; }
  { const float a_ = K[12], b_ = K[13]; const bool g_ = a_ > b_; K[12] = g_ ? a_ : b_; K[13] = g_ ? b_ : a_; }
  { const float a_ = K[14], b_ = K[15]; const bool g_ = a_ > b_; K[14] = g_ ? a_ : b_; K[15] = g_ ? b_ : a_; }
}
__device__ __forceinline__ void merge_top16(float (&T)[16], const float (&P)[16]) {
  { const float a_ = T[0], b_ = P[15]; T[0] = a_ > b_ ? a_ : b_; }
  { const float a_ = T[1], b_ = P[14]; T[1] = a_ > b_ ? a_ : b_; }
  { const float a_ = T[2], b_ = P[13]; T[2] = a_ > b_ ? a_ : b_; }
  { const float a_ = T[3], b_ = P[12]; T[3] = a_ > b_ ? a_ : b_; }
  { const float a_ = T[4], b_ = P[11]; T[4] = a_ > b_ ? a_ : b_; }
  { const float a_ = T[5], b_ = P[10]; T[5] = a_ > b_ ? a_ : b_; }
  { const float a_ = T[6], b_ = P[9]; T[6] = a_ > b_ ? a_ : b_; }
  { const float a_ = T[7], b_ = P[8]; T[7] = a_ > b_ ? a_ : b_; }
  { const float a_ = T[8], b_ = P[7]; T[8] = a_ > b_ ? a_ : b_; }
  { const float a_ = T[9], b_ = P[6]; T[9] = a_ > b_ ? a_ : b_; }
  { const float a_ = T[10], b_ = P[5]; T[10] = a_ > b_ ? a_ : b_; }
  { const float a_ = T[11], b_ = P[4]; T[11] = a_ > b_ ? a_ : b_; }
  { const float a_ = T[12], b_ = P[3]; T[12] = a_ > b_ ? a_ : b_; }
  { const float a_ = T[13], b_ = P[2]; T[13] = a_ > b_ ? a_ : b_; }
  { const float a_ = T[14], b_ = P[1]; T[14] = a_ > b_ ? a_ : b_; }
  { const float a_ = T[15], b_ = P[0]; T[15] = a_ > b_ ? a_ : b_; }
  { const float a_ = T[0], b_ = T[8]; const bool g_ = a_ > b_; T[0] = g_ ? a_ : b_; T[8] = g_ ? b_ : a_; }
  { const float a_ = T[1], b_ = T[9]; const bool g_ = a_ > b_; T[1] = g_ ? a_ : b_; T[9] = g_ ? b_ : a_; }
  { const float a_ = T[2], b_ = T[10]; const bool g_ = a_ > b_; T[2] = g_ ? a_ : b_; T[10] = g_ ? b_ : a_; }
  { const float a_ = T[3], b_ = T[11]; const bool g_ = a_ > b_; T[3] = g_ ? a_ : b_; T[11] = g_ ? b_ : a_; }
  { const float a_ = T[4], b_ = T[12]; const bool g_ = a_ > b_; T[4] = g_ ? a_ : b_; T[12] = g_ ? b_ : a_; }
  { const float a_ = T[5], b_ = T[13]; const bool g_ = a_ > b_; T[5] = g_ ? a_ : b_; T[13] = g_ ? b_ : a_; }
  { const float a_ = T[6], b_ = T[14]; const bool g_ = a_ > b_; T[6] = g_ ? a_ : b_; T[14] = g_ ? b_ : a_; }
  { const float a_ = T[7], b_ = T[15]; const bool g_ = a_ > b_; T[7] = g_ ? a_ : b_; T[15] = g_ ? b_ : a_; }
  { const float a_ = T[0], b_ = T[4]; const bool g_ = a_ > b_; T[0] = g_ ? a_ : b_; T[4] = g_ ? b_ : a_; }
  { const float a_ = T[1], b_ = T[5]; const bool g_ = a_ > b_; T[1] = g_ ? a_ : b_; T[5] = g_ ? b_ : a_; }
  { const float a_ = T[2], b_ = T[6]; const bool g_ = a_ > b_; T[2] = g_ ? a_ : b_; T[6] = g_ ? b_ : a_; }
  { const float a_ = T[3], b_ = T[7]; const bool g_ = a_ > b_; T[3] = g_ ? a_ : b_; T[7] = g_ ? b_ : a_; }
  { const float a_ = T[8], b_ = T[12]; const bool g_ = a_ > b_; T[8] = g_ ? a_ : b_; T[12] = g_ ? b_ : a_; }
  { const float a_ = T[9], b_ = T[13]; const bool g_ = a_ > b_; T[9] = g_ ? a_ : b_; T[13] = g_ ? b_ : a_; }
  { const float a_ = T[10], b_ = T[14]; const bool g_ = a_ > b_; T[10] = g_ ? a_ : b_; T[14] = g_ ? b_ : a_; }
  { const float a_ = T[11], b_ = T[15]; const bool g_ = a_ > b_; T[11] = g_ ? a_ : b_; T[15] = g_ ? b_ : a_; }
  { const float a_ = T[0], b_ = T[2]; const bool g_ = a_ > b_; T[0] = g_ ? a_ : b_; T[2] = g_ ? b_ : a_; }
  { const float a_ = T[1], b_ = T[3]; const bool g_ = a_ > b_; T[1] = g_ ? a_ : b_; T[3] = g_ ? b_ : a_; }
  { const float a_ = T[4], b_ = T[6]; const bool g_ = a_ > b_; T[4] = g_ ? a_ : b_; T[6] = g_ ? b_ : a_; }
  { const float a_ = T[5], b_ = T[7]; const bool g_ = a_ > b_; T[5] = g_ ? a_ : b_; T[7] = g_ ? b_ : a_; }
  { const float a_ = T[8], b_ = T[10]; const bool g_ = a_ > b_; T[8] = g_ ? a_ : b_; T[10] = g_ ? b_ : a_; }
  { const float a_ = T[9], b_ = T[11]; const bool g_ = a_ > b_; T[9] = g_ ? a_ : b_; T[11] = g_ ? b_ : a_; }
  { const float a_ = T[12], b_ = T[14]; const bool g_ = a_ > b_; T[12] = g_ ? a_ : b_; T[14] = g_ ? b_ : a_; }
  { const float a_ = T[13], b_ = T[15]; const bool g_ = a_ > b_; T[13] = g_ ? a_ : b_; T[15] = g_ ? b_ : a_; }
  { const float a_ = T[0], b_ = T[1]; const bool g_ = a_ > b_; T[0] = g_ ? a_ : b_; T[1] = g_ ? b_ : a_; }
  { const float a_ = T[2], b_ = T[3]; const bool g_ = a_ > b_; T[2] = g_ ? a_ : b_; T[3] = g_ ? b_ : a_; }
  { const float a_ = T[4], b_ = T[5]; const bool g_ = a_ > b_; T[4] = g_ ? a_ : b_; T[5] = g_ ? b_ : a_; }
  { const float a_ = T[6], b_ = T[7]; const bool g_ = a_ > b_; T[6] = g_ ? a_ : b_; T[7] = g_ ? b_ : a_; }
  { const float a_ = T[8], b_ = T[9]; const bool g_ = a_ > b_; T[8] = g_ ? a_ : b_; T[9] = g_ ? b_ : a_; }
  { const float a_ = T[10], b_ = T[11]; const bool g_ = a_ > b_; T[10] = g_ ? a_ : b_; T[11] = g_ ? b_ : a_; }
  { const float a_ = T[12], b_ = T[13]; const bool g_ = a_ > b_; T[12] = g_ ? a_ : b_; T[13] = g_ ? b_ : a_; }
  { const float a_ = T[14], b_ = T[15]; const bool g_ = a_ > b_; T[14] = g_ ? a_ : b_; T[15] = g_ ? b_ : a_; }
}

__device__ __forceinline__ void peer_topk(const int wave_s, const bf16* pq, const bf16* skb, int* ids, float* gates, LAS float* smem) {
  const int tid_ = opaque_tid(wave_s);
  const int lane = tid_ & 63, n = lane & 31, hh = lane >> 5, wave = tid_ >> 6;
  const int gw = blockIdx.x * NWAVES + wave;
  const int nw = gridDim.x * NWAVES;
  LAS float* lk = smem + wave * 2048;
  for (int it = gw; it < 512 * 8; it += nw) {
    const int h = it & 7, tok0 = (it >> 3) * 32;
#pragma unroll 1
    for (int half = 0; half < 2; half++) {
      bf16x8_t qf[8];
      {
        const bf16* qrow = pq + (size_t)(tok0 + n) * 2048 + h * 256 + half * 128 + 8 * hh;
#pragma unroll
        for (int ks = 0; ks < 8; ks++) qf[ks] = *(const bf16x8_t*)(qrow + 16 * ks);
      }
      float K[64];
#pragma unroll
      for (int kt = 0; kt < 4; kt++) {
        const bf16* krow = skb + ((size_t)((h * 2 + half) * 128 + kt * 32 + n)) * 128 + 8 * hh;
        f32x16_t acc;
#pragma unroll
        for (int r = 0; r < 16; r++) acc[r] = 0.f;
#pragma unroll
        for (int kq = 0; kq < 2; kq++) {
          bf16x8_t kf[4];
#pragma unroll
          for (int i = 0; i < 4; i++) kf[i] = *(const bf16x8_t*)(krow + 16 * (kq * 4 + i));
          MFMA_PAD();
#pragma unroll
          for (int i = 0; i < 4; i++) acc = __builtin_amdgcn_mfma_f32_32x32x16_bf16(kf[i], qf[kq * 4 + i], acc, 0, 0, 0);
          MFMA_PAD();
        }
#pragma unroll
        for (int i = 0; i < 16; i++) K[kt * 16 + i] = pack_key<0x7Fu>(acc[i], (unsigned)(kt * 32 + (i & 3) + 8 * (i >> 2) + 4 * hh));
      }
      __builtin_amdgcn_sched_barrier(0);
      top16_of_64(K);
      __builtin_amdgcn_sched_barrier(0);
      float T[16], P[16];
#pragma unroll
      for (int i = 0; i < 16; i++) { T[i] = K[i]; P[i] = __shfl_xor(K[i], 32, 64); }
      merge_top16(T, P);
#pragma unroll
      for (int i = 0; i < 16; i++) lk[(half * 16 + i) * 64 + lane] = T[i];
      __builtin_amdgcn_sched_barrier(0);
    }
    float f0[16], f1[16];
    int ti0[16], ti1[16];
#pragma unroll
    for (int i = 0; i < 16; i++) {
      const float k0 = lk[i * 64 + lane], k1 = lk[(16 + i) * 64 + lane];
      f0[i] = key_val<0x7Fu>(k0); ti0[i] = (int)key_idx<0x7Fu>(k0);
      f1[i] = key_val<0x7Fu>(k1); ti1[i] = (int)key_idx<0x7Fu>(k1);
    }
    float K[64];
    {
    K[0] = pack_key<0xFFu>(f0[0] + f1[0], 0u);
    K[1] = pack_key<0xFFu>(f0[0] + f1[1], 1u);
    K[2] = pack_key<0xFFu>(f0[0] + f1[2], 2u);
    K[3] = pack_key<0xFFu>(f0[0] + f1[3], 3u);
    K[4] = pack_key<0xFFu>(f0[0] + f1[4], 4u);
    K[5] = pack_key<0xFFu>(f0[0] + f1[5], 5u);
    K[6] = pack_key<0xFFu>(f0[0] + f1[6], 6u);
    K[7] = pack_key<0xFFu>(f0[0] + f1[7], 7u);
    K[8] = pack_key<0xFFu>(f0[0] + f1[8], 8u);
    K[9] = pack_key<0xFFu>(f0[0] + f1[9], 9u);
    K[10] = pack_key<0xFFu>(f0[0] + f1[10], 10u);
    K[11] = pack_key<0xFFu>(f0[0] + f1[11], 11u);
    K[12] = pack_key<0xFFu>(f0[0] + f1[12], 12u);
    K[13] = pack_key<0xFFu>(f0[0] + f1[13], 13u);
    K[14] = pack_key<0xFFu>(f0[0] + f1[14], 14u);
    K[15] = pack_key<0xFFu>(f0[0] + f1[15], 15u);
    K[16] = pack_key<0xFFu>(f0[1] + f1[0], 16u);
    K[17] = pack_key<0xFFu>(f0[1] + f1[1], 17u);
    K[18] = pack_key<0xFFu>(f0[1] + f1[2], 18u);
    K[19] = pack_key<0xFFu>(f0[1] + f1[3], 19u);
    K[20] = pack_key<0xFFu>(f0[1] + f1[4], 20u);
    K[21] = pack_key<0xFFu>(f0[1] + f1[5], 21u);
    K[22] = pack_key<0xFFu>(f0[1] + f1[6], 22u);
    K[23] = pack_key<0xFFu>(f0[1] + f1[7], 23u);
    K[24] = pack_key<0xFFu>(f0[2] + f1[0], 32u);
    K[25] = pack_key<0xFFu>(f0[2] + f1[1], 33u);
    K[26] = pack_key<0xFFu>(f0[2] + f1[2], 34u);
    K[27] = pack_key<0xFFu>(f0[2] + f1[3], 35u);
    K[28] = pack_key<0xFFu>(f0[2] + f1[4], 36u);
    K[29] = pack_key<0xFFu>(f0[3] + f1[0], 48u);
    K[30] = pack_key<0xFFu>(f0[3] + f1[1], 49u);
    K[31] = pack_key<0xFFu>(f0[3] + f1[2], 50u);
    K[32] = pack_key<0xFFu>(f0[3] + f1[3], 51u);
    K[33] = pack_key<0xFFu>(f0[4] + f1[0], 64u);
    K[34] = pack_key<0xFFu>(f0[4] + f1[1], 65u);
    K[35] = pack_key<0xFFu>(f0[4] + f1[2], 66u);
    K[36] = pack_key<0xFFu>(f0[5] + f1[0], 80u);
    K[37] = pack_key<0xFFu>(f0[5] + f1[1], 81u);
    K[38] = pack_key<0xFFu>(f0[6] + f1[0], 96u);
    K[39] = pack_key<0xFFu>(f0[6] + f1[1], 97u);
    K[40] = pack_key<0xFFu>(f0[7] + f1[0], 112u);
    K[41] = pack_key<0xFFu>(f0[7] + f1[1], 113u);
    K[42] = pack_key<0xFFu>(f0[8] + f1[0], 128u);
    K[43] = pack_key<0xFFu>(f0[9] + f1[0], 144u);
    K[44] = pack_key<0xFFu>(f0[10] + f1[0], 160u);
    K[45] = pack_key<0xFFu>(f0[11] + f1[0], 176u);
    K[46] = pack_key<0xFFu>(f0[12] + f1[0], 192u);
    K[47] = pack_key<0xFFu>(f0[13] + f1[0], 208u);
    K[48] = pack_key<0xFFu>(f0[14] + f1[0], 224u);
    K[49] = pack_key<0xFFu>(f0[15] + f1[0], 240u);
    K[50] = -3.0e38f;
    K[51] = -3.0e38f;
    K[52] = -3.0e38f;
    K[53] = -3.0e38f;
    K[54] = -3.0e38f;
    K[55] = -3.0e38f;
    K[56] = -3.0e38f;
    K[57] = -3.0e38f;
    K[58] = -3.0e38f;
    K[59] = -3.0e38f;
    K[60] = -3.0e38f;
    K[61] = -3.0e38f;
    K[62] = -3.0e38f;
    K[63] = -3.0e38f;
    }
    __builtin_amdgcn_sched_barrier(0);
    top16_of_64(K);
    __builtin_amdgcn_sched_barrier(0);
    float bv[16];
    int be[16];
#pragma unroll
    for (int r = 0; r < 16; r++) {
      const int flat = (int)key_idx<0xFFu>(K[r]);
      const int a = flat >> 4, b = flat & 15;
      int i0 = 0, i1 = 0;
#pragma unroll
      for (int i = 0; i < 16; i++) { i0 = (a == i) ? ti0[i] : i0; i1 = (b == i) ? ti1[i] : i1; }
      be[r] = i0 * 128 + i1;
      bv[r] = key_val<0xFFu>(K[r]);
    }
    const float b0 = bv[0];
    float ge[16];
    float gsum = 0.f;
#pragma unroll
    for (int r = 0; r < 16; r++) { ge[r] = __expf(bv[r] - b0); gsum += ge[r]; }
    const float ginv = 1.0f / gsum;
    if (hh == 0) {
      int* ip = ids + (size_t)(tok0 + n) * 128 + h * 16;
      float* gp = gates + (size_t)(tok0 + n) * 128 + h * 16;
#pragma unroll
      for (int r4 = 0; r4 < 4; r4++) {
        *(int4*)(ip + 4 * r4) = make_int4(be[4 * r4], be[4 * r4 + 1], be[4 * r4 + 2], be[4 * r4 + 3]);
        *(float4*)(gp + 4 * r4) = make_float4(ge[4 * r4] * ginv, ge[4 * r4 + 1] * ginv, ge[4 * r4 + 2] * ginv, ge[4 * r4 + 3] * ginv);
      }
    }
  }
}

typedef _Float16 f16x2_t __attribute__((ext_vector_type(2)));
__device__ __forceinline__ unsigned e4m3x2_to_f16x2(unsigned w, unsigned sel) {
  return __builtin_amdgcn_perm(w, w, sel);
}
__device__ __forceinline__ float dot2h(unsigned a, unsigned b, float c) {
  return __builtin_amdgcn_fdot2(__builtin_bit_cast(f16x2_t, a), __builtin_bit_cast(f16x2_t, b), c, false);
}
__device__ __forceinline__ unsigned pack_h2(float lo, float hi) {
  f16x2_t v; v.x = (_Float16)lo; v.y = (_Float16)hi;
  return __builtin_bit_cast(unsigned, v);
}
template <bool FINAL>
__device__ __forceinline__ void peer_gather(const int wave_s, bf16* xn, const float* rst, const unsigned char* ub, const unsigned char* vb, const float* vsc, const float* usc,
                                            const int* ids, const float* gates, float* xw, const float* gnext, float* outp) {
  const int tid_ = opaque_tid(wave_s);
  const int lane = tid_ & 63;
  const int gw = blockIdx.x * NWAVES + (tid_ >> 6);
  const int nw = gridDim.x * NWAVES;
  const int el = ((lane >> 5) & 1) * 4 + ((lane >> 4) & 1) * 2 + ((lane >> 3) & 1);
  int idv = 0;
  uint2 uu[8];
  uint2 vv[8];
  if (gw < NT) {
    idv = ids[(size_t)gw * 128 + (lane & 7)];
#pragma unroll
    for (int e = 0; e < 8; e++) {
      const int id = __builtin_amdgcn_readlane(idv, e);
      uu[e] = *(const uint2*)(ub + (size_t)id * 512 + lane * 8);
      vv[e] = *(const uint2*)(vb + (size_t)id * 512 + lane * 8);
    }
  }
  for (int tok = gw; tok < NT; tok += nw) {
    const int tokn = (tok + nw < NT) ? tok + nw : tok;
    int xqh[2] = {0, 0}, xql[2] = {0, 0};
    float xstep, qhalf;
    {
      const uint4 a = *(const uint4*)(xn + (size_t)tok * DM + lane * 16);
      const uint4 b = *(const uint4*)(xn + (size_t)tok * DM + lane * 16 + 8);
      const unsigned xw_[8] = {a.x, a.y, a.z, a.w, b.x, b.y, b.z, b.w};
      const float4* sp = (const float4*)(rst + (size_t)tok * 16);
      const float4 s0 = sp[0], s1 = sp[1], s2 = sp[2], s3 = sp[3];
      const float xs = rsqrtf((((s0.x + s0.y) + (s0.z + s0.w)) + ((s1.x + s1.y) + (s1.z + s1.w)) + ((s2.x + s2.y) + (s2.z + s2.w)) + ((s3.x + s3.y) + (s3.z + s3.w))) * (1.0f / 1024.f) + EPSF);
      float xf[16];
      float am = 0.f;
#pragma unroll
      for (int k = 0; k < 8; k++) { xf[2 * k] = bf_lo(xw_[k]) * xs; xf[2 * k + 1] = bf_hi(xw_[k]) * xs; am = fmaxf(am, fmaxf(fabsf(xf[2 * k]), fabsf(xf[2 * k + 1]))); }
#pragma unroll
      for (int o = 32; o >= 1; o >>= 1) am = fmaxf(am, __shfl_xor(am, o, 64));
      xstep = am * (1.0f / 119.f);
      const float inv = am > 0.f ? 119.f / am : 0.f;
      int qs = 0;
#pragma unroll
      for (int i = 0; i < 16; i++) {
        const int q = (int)rintf(xf[i] * inv);
        const int t = q + 8;
        xqh[i >> 3] |= ((t >> 4) & 15) << (4 * (i & 7));
        xql[i >> 3] |= (((t & 15) - 8) & 15) << (4 * (i & 7));
        qs += q;
      }
      qhalf = 0.5f * wsum((float)qs);
    }
    f16x2_t acc2[8];
#pragma unroll
    for (int i = 0; i < 8; i++) acc2[i] = (f16x2_t){(_Float16)0.f, (_Float16)0.f};
#pragma unroll 1
    for (int g = 0; g < 16; g++) {
      const int ide = __builtin_amdgcn_ds_bpermute(el << 2, idv);
      const float2 sc2 = ((const float2*)vsc)[ide];
      const float gv = gates[(size_t)tok * 128 + g * 8 + el] * sc2.x;
      const float us = sc2.y * xstep;
      const int idn = ids[(size_t)(g < 15 ? tok : tokn) * 128 + ((g + 1) & 15) * 8 + (lane & 7)];
      float d[8];
#pragma unroll
      for (int e = 0; e < 8; e++) {
        int sh = __builtin_amdgcn_sdot8((int)uu[e].x, xqh[0], 0, false);
        sh = __builtin_amdgcn_sdot8((int)uu[e].y, xqh[1], sh, false);
        int sl = __builtin_amdgcn_sdot8((int)uu[e].x, xql[0], 0, false);
        sl = __builtin_amdgcn_sdot8((int)uu[e].y, xql[1], sl, false);
        d[e] = (float)((sh << 4) + sl);
      }
#pragma unroll
      for (int e = 0; e < 8; e++) {
        const int id = __builtin_amdgcn_readlane(idn, e);
        uu[e] = *(const uint2*)(ub + (size_t)id * 512 + lane * 8);
      }
      float d4[4], d2[2], d1;
      {
        const bool hi = (lane & 32) != 0;
#pragma unroll
        for (int i = 0; i < 4; i++) { const float send = hi ? d[i] : d[i + 4]; const float keep = hi ? d[i + 4] : d[i]; d4[i] = keep + __shfl_xor(send, 32, 64); }
      }
      {
        const bool hi = (lane & 16) != 0;
#pragma unroll
        for (int i = 0; i < 2; i++) { const float send = hi ? d4[i] : d4[i + 2]; const float keep = hi ? d4[i + 2] : d4[i]; d2[i] = keep + __shfl_xor(send, 16, 64); }
      }
      {
        const bool hi = (lane & 8) != 0;
        const float send = hi ? d2[0] : d2[1];
        const float keep = hi ? d2[1] : d2[0];
        d1 = keep + __shfl_xor(send, 8, 64);
      }
      d1 += __shfl_xor(d1, 4, 64);
      d1 += __shfl_xor(d1, 2, 64);
      d1 += __shfl_xor(d1, 1, 64);
      const float wl = gv * gelu_tanh((d1 + qhalf) * us);
#pragma unroll
      for (int e = 0; e < 8; e++) {
        const float w = __builtin_bit_cast(float, __builtin_amdgcn_readlane(__builtin_bit_cast(int, wl), ((e >> 2) & 1) * 32 + ((e >> 1) & 1) * 16 + (e & 1) * 8));
        const f16x2_t w2 = __builtin_bit_cast(f16x2_t, pack_h2(w, w));
        const unsigned vw[2] = {vv[e].x, vv[e].y};
#pragma unroll
        for (int k = 0; k < 2; k++) {
          const unsigned w4 = vw[k];
          const unsigned le = __builtin_amdgcn_perm(V4_LUT_HI, V4_LUT_LO, w4 & 0x07070707u);
          const unsigned lo = __builtin_amdgcn_perm(V4_LUT_HI, V4_LUT_LO, (w4 >> 4) & 0x07070707u);
          const unsigned ee = ((w4 << 4) & 0x80808080u) | le;
          const unsigned eo = (w4 & 0x80808080u) | lo;
          const unsigned p01 = __builtin_amdgcn_perm(eo, ee, 0x040c000cu), p23 = __builtin_amdgcn_perm(eo, ee, 0x050c010cu);
          const unsigned p45 = __builtin_amdgcn_perm(eo, ee, 0x060c020cu), p67 = __builtin_amdgcn_perm(eo, ee, 0x070c030cu);
          acc2[4 * k + 0] = __builtin_elementwise_fma(__builtin_bit_cast(f16x2_t, p01), w2, acc2[4 * k + 0]);
          acc2[4 * k + 1] = __builtin_elementwise_fma(__builtin_bit_cast(f16x2_t, p23), w2, acc2[4 * k + 1]);
          acc2[4 * k + 2] = __builtin_elementwise_fma(__builtin_bit_cast(f16x2_t, p45), w2, acc2[4 * k + 2]);
          acc2[4 * k + 3] = __builtin_elementwise_fma(__builtin_bit_cast(f16x2_t, p67), w2, acc2[4 * k + 3]);
        }
      }
#pragma unroll
      for (int e = 0; e < 8; e++) {
        const int id = __builtin_amdgcn_readlane(idn, e);
        vv[e] = *(const uint2*)(vb + (size_t)id * 512 + lane * 8);
      }
      idv = idn;
    }
    float acc[16];
#pragma unroll
    for (int i = 0; i < 8; i++) { acc[2 * i] = (float)acc2[i].x; acc[2 * i + 1] = (float)acc2[i].y; }
    float* xr = xw + (size_t)tok * DM + lane * 16;
    float xv[16];
    float ssq = 0.f;
#pragma unroll
    for (int c = 0; c < 4; c++) {
      float4 a0 = *(float4*)(xr + c * 4);
      a0.x += acc[c * 4 + 0]; a0.y += acc[c * 4 + 1]; a0.z += acc[c * 4 + 2]; a0.w += acc[c * 4 + 3];
      if (!FINAL) *(float4*)(xr + c * 4) = a0;
      xv[c * 4 + 0] = a0.x; xv[c * 4 + 1] = a0.y; xv[c * 4 + 2] = a0.z; xv[c * 4 + 3] = a0.w;
      ssq += a0.x * a0.x + a0.y * a0.y + a0.z * a0.z + a0.w * a0.w;
    }
    ssq = wsum(ssq);
    const float rstd = rsqrtf(ssq * (1.0f / DM) + EPSF);
    const float4* g4 = (const float4*)(gnext + lane * 16);
    if (FINAL) {
      float* op = outp + (size_t)tok * DM + lane * 16;
#pragma unroll
      for (int c = 0; c < 4; c++) {
        const float4 gq = g4[c];
        *(float4*)(op + c * 4) = make_float4(xv[c * 4] * rstd * gq.x, xv[c * 4 + 1] * rstd * gq.y, xv[c * 4 + 2] * rstd * gq.z, xv[c * 4 + 3] * rstd * gq.w);
      }
    } else {
      uint4 o0, o1;
      { const float4 ga = g4[0], gb = g4[1];
        o0.x = pk2(xv[0] * rstd * ga.x, xv[1] * rstd * ga.y); o0.y = pk2(xv[2] * rstd * ga.z, xv[3] * rstd * ga.w);
        o0.z = pk2(xv[4] * rstd * gb.x, xv[5] * rstd * gb.y); o0.w = pk2(xv[6] * rstd * gb.z, xv[7] * rstd * gb.w); }
      { const float4 ga = g4[2], gb = g4[3];
        o1.x = pk2(xv[8] * rstd * ga.x, xv[9] * rstd * ga.y); o1.y = pk2(xv[10] * rstd * ga.z, xv[11] * rstd * ga.w);
        o1.z = pk2(xv[12] * rstd * gb.x, xv[13] * rstd * gb.y); o1.w = pk2(xv[14] * rstd * gb.z, xv[15] * rstd * gb.w); }
      *(uint4*)(xn + (size_t)tok * DM + lane * 16) = o0;
      *(uint4*)(xn + (size_t)tok * DM + lane * 16 + 8) = o1;
    }
  }
}

__device__ __forceinline__ void prologue_transposes(const int wave_s, const Params& p, unsigned char* ws, LAS unsigned char* lds) {
  const int tid_ = opaque_tid(wave_s);
  const int lane = tid_ & 63, wave = tid_ >> 6;
  LAS float* scr = (LAS float*)(lds + wave * 16384);
  const int gw = blockIdx.x * NWAVES + wave, NGW = gridDim.x * NWAVES;
  constexpr int I_IN = (DM / 64) * (DIN / 32), I_SQ = (DM / 64) * (DM / 32), I_2K = (DM / 64) * (2048 / 32);
  constexpr int I_GL = (256 / 64) * (256 / 32);
  constexpr int PER_LAYER = I_IN + 3 * I_SQ + 2 * I_2K + I_GL;
  const float* w3 = karg_in(3); const float* w19 = karg_in(19); const float* w22 = karg_in(22);
  const float* w23 = karg_in(23); const float* w24 = karg_in(24); const float* w26 = karg_in(26);
  const float* w16 = karg_in(16);
  for (int it = gw; it < 2 * PER_LAYER; it += NGW) {
    const int l = it / PER_LAYER;
    int r = it % PER_LAYER;
    unsigned char* wl = ws + WS_WT + (size_t)l * WT_LAYER;
    if (r < I_IN) { transpose_item(w3 + (size_t)l * DM * DIN, DM, DIN, (bf16*)(wl + WT_IN), scr, r, lane); continue; } r -= I_IN;
    if (r < I_SQ) { transpose_item(w19 + (size_t)l * DM * DM, DM, DM, (bf16*)(wl + WT_OUT), scr, r, lane); continue; } r -= I_SQ;
    if (r < I_SQ) { transpose_item(w22 + (size_t)l * DM * DM, DM, DM, (bf16*)(wl + WT_MQ), scr, r, lane); continue; } r -= I_SQ;
    if (r < I_2K) { transpose_item(w23 + (size_t)l * DM * 2048, DM, 2048, (bf16*)(wl + WT_MKV), scr, r, lane); continue; } r -= I_2K;
    if (r < I_SQ) { transpose_item(w24 + (size_t)l * DM * DM, DM, DM, (bf16*)(wl + WT_MO), scr, r, lane); continue; } r -= I_SQ;
    if (r < I_2K) { transpose_item(w26 + (size_t)l * DM * 2048, DM, 2048, (bf16*)(wl + WT_PQ), scr, r, lane); continue; } r -= I_2K;
    transpose_item(w16 + (size_t)l * 256 * 256, 256, 256, (bf16*)(wl + WT_GLU), scr, r, lane);
  }
}

template <class T> __device__ __forceinline__ T* opq(T* p) { asm volatile("" : "+s"(p)); return p; }
__device__ __forceinline__ void cvt_rows_bf16(const int wave_s, const float* src, bf16* dst, size_t n) {
  const int tid_ = opaque_tid(wave_s);
  const size_t gt = (size_t)blockIdx.x * (NWAVES * 64) + tid_;
  const size_t nth = (size_t)gridDim.x * NWAVES * 64;
  for (size_t i = gt; i < n / 8; i += nth) {
    const float4 a = ((const float4*)src)[2 * i], b = ((const float4*)src)[2 * i + 1];
    uint4 o; o.x = pk2(a.x, a.y); o.y = pk2(a.z, a.w); o.z = pk2(b.x, b.y); o.w = pk2(b.z, b.w);
    ((uint4*)dst)[i] = o;
  }
}

__device__ __forceinline__ unsigned enc_e4m3(float x) {
  const _Float16 hf = (_Float16)x;
  const unsigned h = (unsigned)__builtin_bit_cast(unsigned short, hf);
  return ((h + 0x7Fu + ((h >> 8) & 1u)) >> 8) & 0xFFu;
}
__device__ __forceinline__ void cvt_rows_e4m3(const int wave_s, const float* src, unsigned char* dst, size_t n, float sc) {
  const int tid_ = opaque_tid(wave_s);
  const size_t gt = (size_t)blockIdx.x * (NWAVES * 64) + tid_;
  const size_t nth = (size_t)gridDim.x * NWAVES * 64;
  for (size_t i = gt; i < n / 16; i += nth) {
    unsigned w[4];
#pragma unroll
    for (int k = 0; k < 4; k++) {
      const float4 a = ((const float4*)src)[4 * i + k];
      w[k] = enc_e4m3(a.x * sc) | (enc_e4m3(a.y * sc) << 8) | (enc_e4m3(a.z * sc) << 16) | (enc_e4m3(a.w * sc) << 24);
    }
    uint4 o; o.x = w[0]; o.y = w[1]; o.z = w[2]; o.w = w[3];
    ((uint4*)dst)[i] = o;
  }
}

__device__ __forceinline__ unsigned enc_v4(float z) {
  const float az = fabsf(z);
  unsigned c = 0;
  c += az > 0.25f; c += az > 0.5f; c += az > 0.75f; c += az > 1.0625f; c += az > 1.375f; c += az > 1.75f; c += az > 2.25f;
  return c | ((__builtin_bit_cast(unsigned, z) >> 28) & 8u);
}
__device__ __forceinline__ void cvt_rows_i4(const int wave_s, const float* src, unsigned char* dst, float* sc_out, int nrows) {
  const int tid_ = opaque_tid(wave_s);
  const int lane = tid_ & 63;
  const int gw = blockIdx.x * NWAVES + (tid_ >> 6);
  const int nw = gridDim.x * NWAVES;
  for (int r = gw; r < nrows; r += nw) {
    const float4* sp = (const float4*)(src + (size_t)r * 1024 + lane * 16);
    const float4 a0 = sp[0], a1 = sp[1], a2 = sp[2], a3 = sp[3];
    const float xv[16] = {a0.x, a0.y, a0.z, a0.w, a1.x, a1.y, a1.z, a1.w, a2.x, a2.y, a2.z, a2.w, a3.x, a3.y, a3.z, a3.w};
    float ss = 0.f;
#pragma unroll
    for (int i = 0; i < 16; i++) ss += xv[i] * xv[i];
    ss = wsum(ss);
    const float sc = sqrtf(ss * (1.0f / 1024.f)) * U4_STEP;
    const float inv = sc > 0.f ? 1.0f / sc : 0.f;
    unsigned w[2] = {0u, 0u};
#pragma unroll
    for (int i = 0; i < 16; i++) {
      const float f = fminf(fmaxf(floorf(xv[i] * inv), -8.f), 7.f);
      w[i >> 3] |= ((unsigned)(int)f & 15u) << (4 * (i & 7));
    }
    uint2 o; o.x = w[0]; o.y = w[1];
    *(uint2*)(dst + (size_t)r * 512 + lane * 8) = o;
    if (lane == 0) sc_out[2 * r] = sc;
  }
}
__device__ __forceinline__ void cvt_rows_v4(const int wave_s, const float* src, unsigned char* dst, float* sc_out, int nrows) {
  const int tid_ = opaque_tid(wave_s);
  const int lane = tid_ & 63;
  const int gw = blockIdx.x * NWAVES + (tid_ >> 6);
  const int nw = gridDim.x * NWAVES;
  for (int r = gw; r < nrows; r += nw) {
    const float4* sp = (const float4*)(src + (size_t)r * 1024 + lane * 16);
    const float4 a0 = sp[0], a1 = sp[1], a2 = sp[2], a3 = sp[3];
    const float xv[16] = {a0.x, a0.y, a0.z, a0.w, a1.x, a1.y, a1.z, a1.w, a2.x, a2.y, a2.z, a2.w, a3.x, a3.y, a3.z, a3.w};
    float ss = 0.f;
#pragma unroll
    for (int i = 0; i < 16; i++) ss += xv[i] * xv[i];
    ss = wsum(ss);
    const float sc = sqrtf(ss * (1.0f / 1024.f)) * V4_ROWSCALE;
    const float inv = sc > 0.f ? 1.0f / sc : 0.f;
    unsigned w[2] = {0u, 0u};
#pragma unroll
    for (int i = 0; i < 16; i++) w[i >> 3] |= enc_v4(xv[i] * inv) << (4 * (i & 7));
    uint2 o; o.x = w[0]; o.y = w[1];
    *(uint2*)(dst + (size_t)r * 512 + lane * 8) = o;
    if (lane == 0) sc_out[2 * r] = sc;
  }
}

#define GEMM_F32(Aptr, Wt, Cptr, Rptr, M_, N_) do { \
    pg8::Gemm g_{opq((const bf16*)(Aptr)), opq((const bf16*)(Wt)), (M_), (N_), DM}; pg8::StaticOrder S_; S_.init((M_), (N_), (int)gridDim.x, (int)blockIdx.x); \
    pg8::EpiF32R E_{opq((float*)(Cptr)), opq((const float*)(Rptr)), (N_)}; \
    pg8::gemm_phase<pg8::EpiF32R, pg8::StaticOrder, true, true>(wave_s, ldsl, g_, S_, E_); } while (0)
#define GEMM_BF16_C(Aptr, Wt, Optr, M_, N_, C_) do { \
    pg8::Gemm g_{opq((const bf16*)(Aptr)), opq((const bf16*)(Wt)), (M_), (N_), DM}; pg8::StaticOrder S_; S_.init((M_), (N_), (int)gridDim.x, (C_)); \
    pg8::EpiBf16 E_{opq((bf16*)(Optr)), (N_)}; \
    pg8::gemm_phase<pg8::EpiBf16, pg8::StaticOrder, true, true>(wave_s, ldsl, g_, S_, E_); } while (0)
#define GEMM_BF16(Aptr, Wt, Optr, M_, N_) GEMM_BF16_C(Aptr, Wt, Optr, M_, N_, (int)blockIdx.x)
#define GEMM_F32RN(Aptr, Wt, Cptr, Rptr, XGptr, Gptr, STptr) do { \
    pg8::Gemm g_{opq((const bf16*)(Aptr)), opq((const bf16*)(Wt)), NT, DM, DM}; pg8::StaticOrder S_; S_.init(NT, DM, (int)gridDim.x, (int)blockIdx.x); \
    pg8::EpiF32RN E_{opq((float*)(Cptr)), opq((const float*)(Rptr)), DM, opq((bf16*)(XGptr)), opq((const float*)(Gptr)), opq((float*)(STptr))}; \
    pg8::gemm_phase<pg8::EpiF32RN, pg8::StaticOrder, true, true>(wave_s, ldsl, g_, S_, E_); } while (0)
#define GEMM_BF16S(Aptr, Wt, Optr, N_, STptr) do { \
    pg8::Gemm g_{opq((const bf16*)(Aptr)), opq((const bf16*)(Wt)), NT, (N_), DM}; pg8::StaticOrder S_; S_.init(NT, (N_), (int)gridDim.x, (int)blockIdx.x); \
    pg8::EpiBf16S E_{opq((bf16*)(Optr)), (N_), opq((const float*)(STptr))}; \
    pg8::gemm_phase<pg8::EpiBf16S, pg8::StaticOrder, true, true>(wave_s, ldsl, g_, S_, E_); } while (0)

__global__ void __launch_bounds__(NWAVES * 64, 2) fwd_megakernel(Params p) {
  extern __shared__ __attribute__((aligned(16))) unsigned char lds[];
  LAS unsigned char* ldsl = (LAS unsigned char*)lds;
  LAS float* smem = (LAS float*)ldsl;
  const int wave_s = __builtin_amdgcn_readfirstlane((int)(threadIdx.x >> 6));
  unsigned char* ws = p.ws;
  volatile LAS unsigned* MISC = (volatile LAS unsigned*)(ldsl + (LDS_BYTES - 256));
  if (threadIdx.x < 64) MISC[threadIdx.x] = 0u;
  __syncthreads();
  const XcdBarrier bar = xcd_barrier_post((unsigned*)(ws + WS_CTL) + 4096, MISC + 8);
  float* xw = (float*)(ws + WS_XW);
  bf16* xn = (bf16*)(ws + WS_XN);
  bf16* big = (bf16*)(ws + WS_BIG);
  bf16* y = (bf16*)(ws + WS_Y);
  bf16* memh = (bf16*)(ws + WS_MEMH);
  bf16* kvb = (bf16*)(ws + WS_KVB);
  bf16* vT = (bf16*)(ws + WS_VT);
  float* ssmE = (float*)(ws + WS_SSME);
  float* ssmp = (float*)(ws + WS_SSMP);
  int* ids = (int*)(ws + WS_IDS);
  float* gates = (float*)(ws + WS_GATE);
  bf16* skb = (bf16*)(ws + WS_SKB);
  unsigned char* ub = ws + WS_UB;
  unsigned char* vb = ws + WS_VB;
  float* rst = (float*)(ws + WS_RST);
  float* vsc = (float*)(ws + WS_VSC);
  float* usc = (float*)(ws + WS_USC);

  prologue_transposes(wave_s, p, ws, ldsl);
  cvt_rows_bf16(wave_s, karg_in(27), skb, (size_t)2 * 8 * 2 * 128 * 128);
  cvt_rows_i4(wave_s, karg_in(28), ub, vsc + 1, 2 * 16384);
  cvt_rows_v4(wave_s, karg_in(29), vb, vsc, 2 * 16384);
  for (int l = 0; l < 2; l++)
    rms_rows<true>(wave_s, karg_in(1), karg_in(21) + l * DM, memh + (size_t)l * 1024 * 1024, 1024);
  ssm_params(wave_s, p, ssmp);
  xcd_barrier(bar);
  for (int l = 0; l < 2; l++)
    GEMM_BF16_C(memh + (size_t)l * 1024 * 1024, ws + WS_WT + (size_t)l * WT_LAYER + WT_MKV,
              kvb + (size_t)l * 1024 * 2048, 1024, 2048, (int)((blockIdx.x + gridDim.x - 32u * (unsigned)l) % gridDim.x));

#pragma nounroll
  for (int l = 0; l < 2; l++) {
    const float* xcur = (l == 0) ? karg_in(0) : xw;
    const float* sp = ssmp + (size_t)l * SSMP_PER_LAYER;
    const unsigned char* wl = ws + WS_WT + (size_t)l * WT_LAYER;
    if (l == 0) {
      rms_rows<true>(wave_s, xcur, karg_in(2) + l * DM, xn, NT);
      xcd_barrier(bar);
    }
    GEMM_BF16(xn, wl + WT_IN, big, NT, DIN);
    xcd_barrier(bar);
    if (l == 0) vt_phase(wave_s, kvb, vT);
    ssm_chunk_end(wave_s, sp, big, ssmE, smem);
    attn_phase(wave_s, p, l, big, y, smem);
    conv_phase(wave_s, p, l, big, y, smem);
    xcd_barrier(bar);
    ssm_finish(wave_s, p, l, sp, big, ssmE, y, smem);
    xcd_barrier(bar);
    GEMM_F32RN(y, wl + WT_OUT, xw, xcur, xn, karg_in(20) + l * DM, rst);
    xcd_barrier(bar);
    GEMM_BF16S(xn, wl + WT_MQ, big, DM, rst);
    xcd_barrier(bar);
    memattn_phase(wave_s, big, kvb + (size_t)l * 1024 * 2048, vT + (size_t)l * 4 * 4 * 256 * 256, y, smem);
    xcd_barrier(bar);
    GEMM_F32RN(y, wl + WT_MO, xw, (const float*)xw, xn, karg_in(25) + l * DM, rst);
    xcd_barrier(bar);
    GEMM_BF16S(xn, wl + WT_PQ, big, 2048, rst);
    xcd_barrier(bar);
    peer_topk(wave_s, big, skb + (size_t)l * 8 * 2 * 128 * 128, ids, gates, smem);
    xcd_barrier(bar);
    if (l == 0) {
      peer_gather<false>(wave_s, xn, rst, ub + (size_t)l * 16384 * 512, vb + (size_t)l * 16384 * 512, vsc + (size_t)l * 2 * 16384, usc, ids, gates, xw, karg_in(2) + DM, (float*)nullptr);
      xcd_barrier(bar);
    } else {
      peer_gather<true>(wave_s, xn, rst, ub + (size_t)l * 16384 * 512, vb + (size_t)l * 16384 * 512, vsc + (size_t)l * 2 * 16384, usc, ids, gates, xw, karg_in(30), p.out);
    }
  }
}

extern "C" void kernel_launch(void* const* d_in, const int* in_sizes, int n_in,
                              void* d_out, int out_size, void* d_ws, size_t ws_size,
                              hipStream_t stream) {
  static int grid_blocks = 0;
  if (!grid_blocks) {
    int dev = 0, cus = 0, per_cu = 0;
    (void)hipGetDevice(&dev);
    (void)hipDeviceGetAttribute(&cus, hipDeviceAttributeMultiprocessorCount, dev);
    (void)hipFuncSetAttribute((const void*)fwd_megakernel, hipFuncAttributeMaxDynamicSharedMemorySize, LDS_BYTES);
    (void)hipOccupancyMaxActiveBlocksPerMultiprocessor(&per_cu, fwd_megakernel, NWAVES * 64, LDS_BYTES);
    if (per_cu < 1) fprintf(stderr, "occupancy query reports %d blocks/CU\n", per_cu);
    grid_blocks = cus;
  }
  (void)hipMemsetAsync((char*)d_ws + WS_CTL, 0, 1 * MiB, stream);
  Params p{};
  for (int i = 0; i < 31; i++) p.in[i] = (const float*)d_in[i];
  p.out = (float*)d_out;
  p.ws = (unsigned char*)d_ws;
  void* args[] = {&p};
  hipError_t e = hipLaunchCooperativeKernel((void*)fwd_megakernel, dim3(grid_blocks), dim3(NWAVES * 64),
                                            args, LDS_BYTES, stream);
  if (e != hipSuccess)
    fprintf(stderr, "cooperative launch failed: %s (grid %d)\n", hipGetErrorString(e), grid_blocks);
}
```

```cpp
#include <hip/hip_runtime.h>
#include <hip/hip_cooperative_groups.h>
#include <cstdio>
namespace cg = cooperative_groups;

#define NT 16384
#define SEQ 4096
#define DM 1024
#define DIN 2304
#define NMEM 256
#define EPSF 1e-6f
#define NWAVES 8
#define LDS_BYTES 147456

typedef unsigned short bf16;
#define LAS __attribute__((address_space(3)))

struct Params {
  const float* in[31];
  float* out;
  unsigned char* ws;
};
typedef __attribute__((address_space(4))) const unsigned char* kaptr_t;
__device__ __forceinline__ const float* karg_in(int i) {
  kaptr_t ka = (kaptr_t)__builtin_amdgcn_kernarg_segment_ptr();
  asm volatile("" : "+s"(ka));
  return *(const float* __attribute__((address_space(4))) const*)(ka + 8 * i);
}

constexpr size_t MiB = 1u << 20;
constexpr size_t WS_CTL  = 0;
constexpr size_t WS_WT   = 1 * MiB;
constexpr size_t WT_IN = 0, WT_OUT = WT_IN + (size_t)DIN * DM * 2, WT_MQ = WT_OUT + (size_t)DM * DM * 2,
                 WT_MKV = WT_MQ + (size_t)DM * DM * 2, WT_MO = WT_MKV + (size_t)2048 * DM * 2,
                 WT_PQ = WT_MO + (size_t)DM * DM * 2, WT_GLU = WT_PQ + (size_t)2048 * DM * 2, WT_LAYER = WT_GLU + (size_t)256 * 256 * 2;
constexpr size_t WS_XW   = WS_WT + 2 * WT_LAYER;
constexpr size_t WS_XN   = WS_XW + (size_t)NT * DM * 4;
constexpr size_t WS_BIG  = WS_XN + (size_t)NT * DM * 2;
constexpr size_t WS_Y    = WS_BIG + (size_t)NT * DIN * 2;
constexpr size_t WS_MEMH = WS_Y + (size_t)NT * DM * 2;
constexpr size_t WS_KVB  = WS_MEMH + (size_t)2 * 1024 * 1024 * 2;
constexpr size_t WS_VT   = WS_KVB + (size_t)2 * 1024 * 2048 * 2;
constexpr size_t WS_SSME = WS_VT + (size_t)2 * 4 * 4 * 256 * 256 * 2;
#define SSMP_PER_LAYER (2048 + 2048 + 32768)
constexpr size_t WS_SSMP = WS_SSME + (size_t)4 * 64 * 16 * 64 * 2 * 4;
constexpr size_t WS_IDS  = WS_SSMP + (size_t)2 * SSMP_PER_LAYER * 4;
constexpr size_t WS_GATE = WS_IDS + (size_t)NT * 128 * 4;
constexpr size_t WS_SKB  = WS_GATE + (size_t)NT * 128 * 4;
constexpr size_t WS_UB   = WS_SKB + (size_t)2 * 8 * 2 * 128 * 128 * 2;
constexpr size_t WS_VB   = WS_UB + (size_t)2 * 16384 * 512;
constexpr size_t WS_VSC  = WS_VB + (size_t)2 * 16384 * 512;
constexpr size_t WS_USC  = WS_VSC + (size_t)2 * 16384 * 4;
constexpr size_t WS_RST  = WS_USC + (size_t)2 * 16384 * 4;
constexpr size_t WS_END  = WS_RST + (size_t)NT * 16 * 4;
#define U_SCALE 64.0f
#define U4_STEP 0.3352f
#define V4_LUT_LO 0x3B393630u
#define V4_LUT_HI 0x41403E3Du
#define V4_ROWSCALE 1.075f
static_assert(WS_END <= 512 * MiB, "workspace");
static_assert(WT_LAYER % 256 == 0 && WS_SSMP % 16 == 0 && WS_IDS % 16 == 0 && WS_SKB % 256 == 0 && WS_VT % 256 == 0, "align");

__device__ __forceinline__ int opaque_tid(int wave_s) { int v = wave_s * 64 + (int)__builtin_amdgcn_mbcnt_hi(~0u, __builtin_amdgcn_mbcnt_lo(~0u, 0u)); asm volatile("" : "+v"(v)); return v; }
__device__ __forceinline__ unsigned f2bf(float f) { unsigned u = __builtin_bit_cast(unsigned, f); return (u + 0x7fffu + ((u >> 16) & 1u)) >> 16; }
__device__ __forceinline__ unsigned pk2(float lo, float hi) { return f2bf(lo) | (f2bf(hi) << 16); }
__device__ __forceinline__ float bf_lo(unsigned u) { return __builtin_bit_cast(float, u << 16); }
__device__ __forceinline__ float bf_hi(unsigned u) { return __builtin_bit_cast(float, u & 0xffff0000u); }
__device__ __forceinline__ float bf2f(bf16 h) { return __builtin_bit_cast(float, (unsigned)h << 16); }


#define XB_TMO      128
#define XB_XCNT(j)  (256  + 64 * (j))
#define XB_XSUB(j)  (1280 + 64 * (j))
#define XB_XGEN(j)  (2304 + 64 * (j))
#define XB_TOP      3328
#define XB_TOPGEN   3392
#define XCD_BAR_WORDS 3456
#define XB_SPIN_CAP (1u << 22)
__device__ __forceinline__ unsigned xb_ld(unsigned* p)              { return __hip_atomic_load(p, __ATOMIC_RELAXED, __HIP_MEMORY_SCOPE_AGENT); }
__device__ __forceinline__ unsigned xb_add(unsigned* p, unsigned v) { return __hip_atomic_fetch_add(p, v, __ATOMIC_RELAXED, __HIP_MEMORY_SCOPE_AGENT); }
__device__ __forceinline__ unsigned xb_xcc_id() { return (unsigned)__builtin_amdgcn_s_getreg((3 << 11) | 20) & 0xFu; }
#define XB_SPIN(cond, bar) do { unsigned _sp = 0; while (cond) { __builtin_amdgcn_s_sleep(1); \
    if ((++_sp & 255u) == 0u) { if (xb_ld(&(bar)[XB_TMO])) break; if (_sp > XB_SPIN_CAP) { atomicAdd(&(bar)[XB_TMO], 1u); break; } } } } while (0)
struct XcdBarrier { unsigned* bar; unsigned x; volatile LAS unsigned* st; };
__device__ __forceinline__ XcdBarrier xcd_barrier_post(unsigned* bar, volatile LAS unsigned* st) {
    XcdBarrier b; b.bar = bar; b.x = xb_xcc_id(); b.st = st;
    if (threadIdx.x == 0) (void)xb_add(&bar[XB_XCNT(b.x)], 1u);
    return b;
}
__device__ __forceinline__ void xcd_barrier_complete(unsigned* bar, unsigned x, unsigned& nloc, unsigned& nx) {
    const unsigned G = gridDim.x * gridDim.y * gridDim.z;
    unsigned sum, cnt, mine, sp = 0u;
    for (;;) {
        sum = 0u; cnt = 0u; mine = 0u;
#pragma unroll
        for (unsigned j = 0; j < 16; ++j) { const unsigned c = xb_ld(&bar[XB_XCNT(j)]); sum += c; cnt += (c > 0u) ? 1u : 0u; mine = (j == x) ? c : mine; }
        if (sum == G) break;
        __builtin_amdgcn_s_sleep(1);
        if ((++sp & 255u) == 0u) { if (xb_ld(&bar[XB_TMO])) break; if (sp > XB_SPIN_CAP) { atomicAdd(&bar[XB_TMO], 1u); break; } }
    }
    nloc = mine > 0u ? mine : 1u; nx = cnt > 0u ? cnt : 1u;
}
__device__ __forceinline__ void xcd_barrier(const XcdBarrier& b) {
    asm volatile("s_waitcnt vmcnt(0)" ::: "memory");
    __syncthreads();
    if (threadIdx.x == 0) {
        unsigned* bar = b.bar;
        __builtin_amdgcn_s_waitcnt(0);
        unsigned nloc = b.st[0], nx = b.st[1];
        if (nloc == 0u) { xcd_barrier_complete(bar, b.x, nloc, nx); b.st[0] = nloc; b.st[1] = nx; }
        const unsigned old = xb_add(&bar[XB_XSUB(b.x)], 1u);
        const unsigned gen = old / nloc;
        if (old + 1u == (gen + 1u) * nloc) {
            __builtin_amdgcn_fence(__ATOMIC_RELEASE, "agent");
            asm volatile("s_waitcnt vmcnt(0)" ::: "memory");
            const unsigned og = xb_add(&bar[XB_TOP], 1u);
            const unsigned tg = og / nx;
            if (og + 1u == (tg + 1u) * nx) xb_add(&bar[XB_TOPGEN], 1u);
            else XB_SPIN(xb_ld(&bar[XB_TOPGEN]) == tg, bar);
            __builtin_amdgcn_fence(__ATOMIC_ACQUIRE, "agent");
            xb_add(&bar[XB_XGEN(b.x)], 1u);
            asm volatile("s_waitcnt vmcnt(0)" ::: "memory");
        } else {
            XB_SPIN(xb_ld(&bar[XB_XGEN(b.x)]) == gen, bar);
            __builtin_amdgcn_fence(__ATOMIC_ACQUIRE, "agent");
            asm volatile("s_waitcnt vmcnt(0)" ::: "memory");
        }
    }
    __syncthreads();
}

namespace pg8 {
#define PG8_LAS __attribute__((address_space(3)))
typedef unsigned short bf16_t;
typedef short bf16x8 __attribute__((ext_vector_type(8)));
typedef float f32x4 __attribute__((ext_vector_type(4)));
typedef unsigned u32x4 __attribute__((ext_vector_type(4)));
constexpr int BM = 256, BK = 64, HALF = 128, HTB = HALF * BK * 2, STAGE_BYTES = 8 * HTB, NXCD = 8, WGM = 8;
__host__ __device__ __forceinline__ int lds_byte(int r, int c) { const int st = (r >> 4) * 2 + (c >> 5), rr = r & 15, cc = c & 31, ob = rr * 64 + cc * 2; return st * 1024 + (ob ^ (((ob >> 9) & 1) << 5)); }
__host__ __device__ __forceinline__ void stage_rc(int b, int& R, int& C) { const int st = b / 1024, sb = b % 1024, swz = sb ^ (((sb >> 9) & 1) << 5); R = (st >> 1) * 16 + swz / 64; C = (st & 1) * 32 + (swz % 64) / 2; }
__host__ __device__ __forceinline__ int perm32(int rho) { const int n = rho >> 4, i = rho & 15; return 8 * (i >> 2) + 4 * n + (i & 3); }
struct Unit { int pm, pn; };
struct Gemm { const bf16_t* A; const bf16_t* Bt; int M, N, K; };
struct StaticOrder {
    int nM, nN, nwg, G, c;
    __host__ __device__ __forceinline__ void init(int M, int N, int G_, int c_) { nM = M / BM; nN = N / BM; nwg = nM * nN; G = G_; c = c_; }
    __host__ __device__ bool next(int i, Unit& u) const {
        const long L = (long)i * G + c; if (L >= nwg) return false;
        int wgid = (int)L; { const int q = nwg / NXCD, r = nwg % NXCD, xcd = wgid % NXCD, off = wgid / NXCD; wgid = (xcd < r ? xcd * (q + 1) : r * (q + 1) + (xcd - r) * q) + off; }
        const int nig = WGM * nN, gid = wgid / nig, fm = gid * WGM, gsz = (nM - fm) < WGM ? (nM - fm) : WGM;
        u.pm = fm + ((wgid % nig) % gsz); u.pn = (wgid % nig) / gsz; return true;
    }
    __device__ __forceinline__ void a_ready(const Unit&) const {}
    __device__ __forceinline__ void done(const Unit&) const {}
};
__device__ __forceinline__ unsigned cvt_pk_bf16(float lo, float hi) { unsigned r; asm volatile("v_cvt_pk_bf16_f32 %0, %1, %2" : "=v"(r) : "v"(lo), "v"(hi)); return r; }

struct EpiF32R {
    static constexpr bool PERM = false, AFTER_DRAIN = false;
    float* C; const float* R; int ldc;
    __device__ __forceinline__ void operator()(const f32x4 (&acc)[2][2][4][2], const Unit& u, int wr, int wc, int fr, int fq) const {
        const int row0 = u.pm * BM + wr * 64 + fr, col0 = u.pn * BM + wc * 32 + 4 * fq;
#pragma unroll
        for (int ai = 0; ai < 2; ++ai)
#pragma unroll
            for (int m = 0; m < 4; ++m) {
                const size_t ro = (size_t)(row0 + ai * HALF + m * 16) * ldc + col0;
                f32x4 rv[2][2];
#pragma unroll
                for (int bj = 0; bj < 2; ++bj)
#pragma unroll
                    for (int n = 0; n < 2; ++n) rv[bj][n] = R ? *(const f32x4*)(R + ro + bj * HALF + n * 16) : (f32x4){0.f, 0.f, 0.f, 0.f};
#pragma unroll
                for (int bj = 0; bj < 2; ++bj)
#pragma unroll
                    for (int n = 0; n < 2; ++n) *(f32x4*)(C + ro + bj * HALF + n * 16) = acc[ai][bj][m][n] + rv[bj][n];
                __builtin_amdgcn_sched_barrier(0);
            }
    }
};

struct EpiBf16 {
    static constexpr bool PERM = true, AFTER_DRAIN = false;
    bf16_t* O; int ldc;
    __device__ __forceinline__ void operator()(const f32x4 (&acc)[2][2][4][2], const Unit& u, int wr, int wc, int fr, int fq) const {
        const int row0 = u.pm * BM + wr * 64 + fr, col0 = u.pn * BM + wc * 32 + 8 * fq;
#pragma unroll
        for (int ai = 0; ai < 2; ++ai)
#pragma unroll
            for (int m = 0; m < 4; ++m) { bf16_t* rowp = O + (size_t)(row0 + ai * HALF + m * 16) * ldc + col0;
#pragma unroll
                for (int bj = 0; bj < 2; ++bj) { const f32x4 v0 = acc[ai][bj][m][0], v1 = acc[ai][bj][m][1];
                    u32x4 w; w.x = cvt_pk_bf16(v0[0], v0[1]); w.y = cvt_pk_bf16(v0[2], v0[3]); w.z = cvt_pk_bf16(v1[0], v1[1]); w.w = cvt_pk_bf16(v1[2], v1[3]);
                    *(u32x4*)(rowp + bj * HALF) = w; } }
    }
};

struct EpiF32RN {
    static constexpr bool PERM = false, AFTER_DRAIN = false;
    float* C; const float* R; int ldc; bf16_t* XG; const float* g; float* st;
    __device__ __forceinline__ void operator()(const f32x4 (&acc)[2][2][4][2], const Unit& u, int wr, int wc, int fr, int fq) const {
        const int row0 = u.pm * BM + wr * 64 + fr, col0 = u.pn * BM + wc * 32 + 4 * fq;
        f32x4 gv[2][2];
#pragma unroll
        for (int bj = 0; bj < 2; ++bj)
#pragma unroll
            for (int n = 0; n < 2; ++n) gv[bj][n] = *(const f32x4*)(g + col0 + bj * HALF + n * 16);
#pragma unroll
        for (int ai = 0; ai < 2; ++ai)
#pragma unroll
            for (int m = 0; m < 4; ++m) {
                const int row = row0 + ai * HALF + m * 16;
                const size_t ro = (size_t)row * ldc + col0;
                f32x4 rv[2][2];
#pragma unroll
                for (int bj = 0; bj < 2; ++bj)
#pragma unroll
                    for (int n = 0; n < 2; ++n) rv[bj][n] = *(const f32x4*)(R + ro + bj * HALF + n * 16);
                float ss = 0.f;
#pragma unroll
                for (int bj = 0; bj < 2; ++bj)
#pragma unroll
                    for (int n = 0; n < 2; ++n) {
                        const f32x4 v = acc[ai][bj][m][n] + rv[bj][n];
                        *(f32x4*)(C + ro + bj * HALF + n * 16) = v;
                        ss += (v[0] * v[0] + v[1] * v[1]) + (v[2] * v[2] + v[3] * v[3]);
                        const f32x4 w = v * gv[bj][n];
                        uint2 pk; pk.x = cvt_pk_bf16(w[0], w[1]); pk.y = cvt_pk_bf16(w[2], w[3]);
                        *(uint2*)(XG + ro + bj * HALF + n * 16) = pk;
                    }
                ss += __shfl_xor(ss, 16, 64); ss += __shfl_xor(ss, 32, 64);
                if (fq == 0) st[(size_t)row * 16 + u.pn * 4 + wc] = ss;
                __builtin_amdgcn_sched_barrier(0);
            }
    }
};
struct EpiBf16S {
    static constexpr bool PERM = true, AFTER_DRAIN = false;
    bf16_t* O; int ldc; const float* st;
    __device__ __forceinline__ void operator()(const f32x4 (&acc)[2][2][4][2], const Unit& u, int wr, int wc, int fr, int fq) const {
        const int row0 = u.pm * BM + wr * 64 + fr, col0 = u.pn * BM + wc * 32 + 8 * fq;
#pragma unroll
        for (int ai = 0; ai < 2; ++ai)
#pragma unroll
            for (int m = 0; m < 4; ++m) {
                const int row = row0 + ai * HALF + m * 16;
                const f32x4* sp = (const f32x4*)(st + (size_t)row * 16);
                const f32x4 s0 = sp[0], s1 = sp[1], s2 = sp[2], s3 = sp[3];
                const f32x4 sa = (s0 + s1) + (s2 + s3);
                const float rs = __builtin_amdgcn_rsqf(((sa[0] + sa[1]) + (sa[2] + sa[3])) * (1.0f / 1024.f) + 1e-6f);
                bf16_t* rowp = O + (size_t)row * ldc + col0;
#pragma unroll
                for (int bj = 0; bj < 2; ++bj) { const f32x4 v0 = acc[ai][bj][m][0] * rs, v1 = acc[ai][bj][m][1] * rs;
                    u32x4 w; w.x = cvt_pk_bf16(v0[0], v0[1]); w.y = cvt_pk_bf16(v0[2], v0[3]); w.z = cvt_pk_bf16(v1[0], v1[1]); w.w = cvt_pk_bf16(v1[2], v1[3]);
                    *(u32x4*)(rowp + bj * HALF) = w; }
                __builtin_amdgcn_sched_barrier(0);
            }
    }
};

template <class Epi, class Sched, bool ALIGN_EPI = false, bool SP2 = false>
__device__ __forceinline__ void gemm_phase(const int wave_s, PG8_LAS unsigned char* lds, const Gemm g, const Sched& S, const Epi& E) {
    const int tid = opaque_tid(wave_s), wid = __builtin_amdgcn_readfirstlane(tid >> 6), lane = tid & 63, wr = wid >> 2, wc = wid & 3, fr = lane & 15, fq = lane >> 4;
    const int K = g.K, nt = K / BK;
    unsigned voffA[2], voffB[2];
#pragma unroll
    for (int i = 0; i < 2; ++i) { int R, C; stage_rc(tid * 16 + i * 8192, R, C); const int Rb = Epi::PERM ? ((R & ~31) + perm32(R & 31)) : R;
        voffA[i] = (unsigned)(R * K + C) * 2u; voffB[i] = (unsigned)(Rb * K + C) * 2u; }
    const size_t kstep = (size_t)(BK * 2);
    const size_t hstep = (size_t)HALF * K * 2;
    const size_t tstep = 2 * hstep;
    const unsigned ldsw = (unsigned)wid * 1024u;
    const int aoff = lds_byte(wr * 64 + fr, fq * 8), boff = lds_byte(wc * 32 + fr, fq * 8);
#define PG8_SA(b, h) (((b) * 2 + (h)) * HTB)
#define PG8_SB(b, h) ((4 + (b) * 2 + (h)) * HTB)
#define PG8_STAGE(bufoff, gbase, voff) do { _Pragma("unroll") for (int _i = 0; _i < 2; ++_i) \
        __builtin_amdgcn_global_load_lds((const unsigned*)((const char*)(gbase) + (voff)[_i]), (PG8_LAS unsigned*)(lds + (bufoff) + ldsw + _i * 8192), 16, 0, 0); } while (0)
#define PG8_LDA(dst, b, h) do { _Pragma("unroll") for (int m = 0; m < 4; ++m) _Pragma("unroll") for (int k = 0; k < 2; ++k) dst[m][k] = *(const PG8_LAS bf16x8*)(lds + PG8_SA(b, h) + aoff + m * 2048 + k * 1024); } while (0)
#define PG8_LDB(dst, b, h) do { _Pragma("unroll") for (int n = 0; n < 2; ++n) _Pragma("unroll") for (int k = 0; k < 2; ++k) dst[n][k] = *(const PG8_LAS bf16x8*)(lds + PG8_SB(b, h) + boff + n * 2048 + k * 1024); } while (0)
#define PG8_MMA(ai, bj, At, Bt) do { __builtin_amdgcn_s_setprio(1); _Pragma("unroll") for (int m = 0; m < 4; ++m) _Pragma("unroll") for (int n = 0; n < 2; ++n) _Pragma("unroll") for (int k = 0; k < 2; ++k) \
        acc[ai][bj][m][n] = __builtin_amdgcn_mfma_f32_16x16x32_bf16(Bt[n][k], At[m][k], acc[ai][bj][m][n], 0, 0, 0); __builtin_amdgcn_s_setprio(0); } while (0)
#define PG8_WAIT_V(n) asm volatile("s_waitcnt vmcnt(" #n ")" ::: "memory")
#define PG8_WAIT_L(n) asm volatile("s_waitcnt lgkmcnt(" #n ")" ::: "memory")
#define PG8_BAR __builtin_amdgcn_s_barrier()
#define PG8_SCHED __builtin_amdgcn_sched_barrier(0)
    Unit cur, nxt; int ui = 0;
    if (!S.next(0, cur)) return;
    f32x4 acc[2][2][4][2];
#pragma unroll
    for (int a = 0; a < 2; ++a)
#pragma unroll
        for (int b = 0; b < 2; ++b)
#pragma unroll
            for (int m = 0; m < 4; ++m)
#pragma unroll
                for (int n = 0; n < 2; ++n) acc[a][b][m][n] = (f32x4){0.f, 0.f, 0.f, 0.f};
    bf16x8 At[4][2], B0[2][2], B1[2][2];
    const char* cA = (const char*)g.A + (size_t)cur.pm * tstep; const char* cB = (const char*)g.Bt + (size_t)cur.pn * tstep;
    S.a_ready(cur);
    if constexpr (SP2) {
        PG8_STAGE(PG8_SB(0, 0), cB, voffB); PG8_STAGE(PG8_SB(0, 1), cB + hstep, voffB); PG8_STAGE(PG8_SA(0, 0), cA, voffA); PG8_STAGE(PG8_SA(0, 1), cA + hstep, voffA);
        if (wr == 1) PG8_BAR;
        PG8_WAIT_V(2); PG8_BAR;
        PG8_STAGE(PG8_SB(1, 0), cB + kstep, voffB); PG8_STAGE(PG8_SA(1, 0), cA + kstep, voffA); PG8_STAGE(PG8_SB(1, 1), cB + hstep + kstep, voffB);
        PG8_WAIT_V(6); PG8_BAR;
    } else {
        PG8_STAGE(PG8_SB(0, 0), cB, voffB); PG8_STAGE(PG8_SA(0, 0), cA, voffA); PG8_STAGE(PG8_SB(0, 1), cB + hstep, voffB); PG8_STAGE(PG8_SA(0, 1), cA + hstep, voffA);
        if (wr == 1) PG8_BAR;
        PG8_WAIT_V(4); PG8_BAR;
        PG8_STAGE(PG8_SB(1, 0), cB + kstep, voffB); PG8_STAGE(PG8_SA(1, 0), cA + kstep, voffA); PG8_STAGE(PG8_SB(1, 1), cB + hstep + kstep, voffB);
        PG8_WAIT_V(6); PG8_BAR;
    }
    for (;;) {
        const bool has_next = S.next(ui + 1, nxt);
        const char* nA = has_next ? (const char*)g.A + (size_t)nxt.pm * tstep : cA; const char* nB = has_next ? (const char*)g.Bt + (size_t)nxt.pn * tstep : cB;
        for (int t = 0; t < nt; t += 2) {
            const bool last = (t == nt - 2);
            const char* a1 = cA + (size_t)(t + 1) * kstep;
            const char* a2 = last ? nA : cA + (size_t)(t + 2) * kstep; const char* b2 = last ? nB : cB + (size_t)(t + 2) * kstep;
            const char* a3 = a2 + kstep; const char* b3 = b2 + kstep;
            if (last && has_next) S.a_ready(nxt);
            if constexpr (SP2) {
            PG8_LDB(B0, 0, 0); PG8_LDB(B1, 0, 1); PG8_SCHED; PG8_LDA(At, 0, 0); PG8_STAGE(PG8_SA(1, 1), a1 + hstep, voffA);
            PG8_WAIT_V(8); PG8_WAIT_L(0); PG8_BAR; PG8_MMA(0, 0, At, B0); PG8_MMA(0, 1, At, B1); PG8_BAR; PG8_SCHED;
            PG8_LDA(At, 0, 1); PG8_STAGE(PG8_SB(0, 0), b2, voffB); PG8_STAGE(PG8_SB(0, 1), b2 + hstep, voffB); PG8_STAGE(PG8_SA(0, 0), a2, voffA);
            PG8_WAIT_V(8); PG8_WAIT_L(0); PG8_BAR; PG8_MMA(1, 0, At, B0); PG8_MMA(1, 1, At, B1); PG8_BAR; PG8_SCHED;
            PG8_LDB(B0, 1, 0); PG8_LDB(B1, 1, 1); PG8_SCHED; PG8_LDA(At, 1, 0); PG8_STAGE(PG8_SA(0, 1), a2 + hstep, voffA);
            PG8_WAIT_V(8); PG8_WAIT_L(0); PG8_BAR; PG8_MMA(0, 0, At, B0); PG8_MMA(0, 1, At, B1); PG8_BAR; PG8_SCHED;
            PG8_LDA(At, 1, 1); PG8_STAGE(PG8_SB(1, 0), b3, voffB); PG8_STAGE(PG8_SB(1, 1), b3 + hstep, voffB); PG8_STAGE(PG8_SA(1, 0), a3, voffA);
            PG8_WAIT_V(8); PG8_WAIT_L(0); PG8_BAR; PG8_MMA(1, 0, At, B0); PG8_MMA(1, 1, At, B1); PG8_BAR; PG8_SCHED;
            } else {
            PG8_LDB(B0, 0, 0); PG8_SCHED; PG8_LDA(At, 0, 0); PG8_STAGE(PG8_SA(1, 1), a1 + hstep, voffA);
            PG8_WAIT_L(8); PG8_BAR; PG8_WAIT_L(0); PG8_MMA(0, 0, At, B0); PG8_BAR; PG8_SCHED;
            PG8_LDB(B1, 0, 1); PG8_STAGE(PG8_SB(0, 0), b2, voffB);
            PG8_BAR; PG8_WAIT_L(0); PG8_MMA(0, 1, At, B1); PG8_BAR;
            PG8_LDA(At, 0, 1); PG8_STAGE(PG8_SA(0, 0), a2, voffA);
            PG8_BAR; PG8_WAIT_L(0); PG8_MMA(1, 0, At, B0); PG8_BAR; PG8_SCHED;
            PG8_STAGE(PG8_SB(0, 1), b2 + hstep, voffB);
            PG8_WAIT_V(6); PG8_BAR; PG8_MMA(1, 1, At, B1); PG8_BAR;
            PG8_LDB(B0, 1, 0); PG8_SCHED; PG8_LDA(At, 1, 0); PG8_STAGE(PG8_SA(0, 1), a2 + hstep, voffA);
            PG8_WAIT_L(8); PG8_BAR; PG8_WAIT_L(0); PG8_MMA(0, 0, At, B0); PG8_BAR; PG8_SCHED;
            PG8_LDB(B1, 1, 1); PG8_STAGE(PG8_SB(1, 0), b3, voffB);
            PG8_BAR; PG8_WAIT_L(0); PG8_MMA(0, 1, At, B1); PG8_BAR;
            PG8_LDA(At, 1, 1); PG8_STAGE(PG8_SA(1, 0), a3, voffA);
            PG8_BAR; PG8_WAIT_L(0); PG8_MMA(1, 0, At, B0); PG8_BAR; PG8_SCHED;
            PG8_STAGE(PG8_SB(1, 1), b3 + hstep, voffB);
            PG8_WAIT_V(6); PG8_BAR; PG8_MMA(1, 1, At, B1); PG8_BAR;
            }
        }
        if constexpr (ALIGN_EPI) { if (wr == 0) PG8_BAR; }
        if constexpr (!Epi::AFTER_DRAIN) { E(acc, cur, wr, wc, fr, fq); S.done(cur); }
        if (!has_next) break;
#pragma unroll
        for (int a = 0; a < 2; ++a)
#pragma unroll
            for (int b = 0; b < 2; ++b)
#pragma unroll
                for (int m = 0; m < 4; ++m)
#pragma unroll
                    for (int n = 0; n < 2; ++n) acc[a][b][m][n] = (f32x4){0.f, 0.f, 0.f, 0.f};
        cur = nxt; cA = nA; cB = nB; ++ui;
        if constexpr (ALIGN_EPI) { if (wr == 1) PG8_BAR; }
    }
    PG8_WAIT_V(0);
    if constexpr (!ALIGN_EPI) { if (wr == 0) PG8_BAR; }
    PG8_BAR;
#undef PG8_SA
#undef PG8_SB
#undef PG8_STAGE
#undef PG8_LDA
#undef PG8_LDB
#undef PG8_MMA
#undef PG8_WAIT_V
#undef PG8_WAIT_L
#undef PG8_BAR
#undef PG8_SCHED
}
}

__device__ __forceinline__ void transpose_item(const float* W, int K, int N, bf16* WT, LAS float* scr, int item, int lane) {
    const int nblk = N / 32, kb = item / nblk, nb = item % nblk, k0 = 64 * kb, n0 = 32 * nb;
#pragma unroll 8
    for (int i = 0; i < 32; ++i) { const int kk = 2 * i + (lane >> 5); scr[kk * 33 + (lane & 31)] = W[(size_t)(k0 + kk) * N + n0 + (lane & 31)]; }
    asm volatile("s_waitcnt lgkmcnt(0)" ::: "memory");
    const int c = lane & 7;
#pragma unroll
    for (int j = 0; j < 4; ++j) { const int n = (lane >> 3) + 8 * j; const LAS float* s = scr + (8 * c) * 33 + n;
        uint4 o; o.x = pk2(s[0 * 33], s[1 * 33]); o.y = pk2(s[2 * 33], s[3 * 33]); o.z = pk2(s[4 * 33], s[5 * 33]); o.w = pk2(s[6 * 33], s[7 * 33]);
        *(uint4*)(WT + (size_t)(n0 + n) * K + k0 + 8 * c) = o; }
    asm volatile("s_waitcnt lgkmcnt(0)" ::: "memory");
}

__device__ __forceinline__ float wsum(float v) {
#pragma unroll
  for (int o = 32; o > 0; o >>= 1) v += __shfl_xor(v, o, 64);
  return v;
}
__device__ __forceinline__ float wmaxf(float v) {
#pragma unroll
  for (int o = 32; o > 0; o >>= 1) v = fmaxf(v, __shfl_xor(v, o, 64));
  return v;
}
__device__ __forceinline__ float sigmoidf_(float x) { return 1.0f / (1.0f + expf(-x)); }
__device__ __forceinline__ float gelu_tanh(float x) {
  return 0.5f * x * (1.0f + tanhf(0.7978845608028654f * (x + 0.044715f * x * x * x)));
}

template <bool BF16OUT>
__device__ __forceinline__ void rms_rows(const int wave_s, const float* src, const float* g, void* dstv, int rows) {
  const int tid_ = opaque_tid(wave_s);
  const int lane = tid_ & 63;
  const int gw = blockIdx.x * NWAVES + (tid_ >> 6);
  const int nw = gridDim.x * NWAVES;
  for (int r = gw; r < rows; r += nw) {
    const float4* s4 = (const float4*)(src + (size_t)r * DM);
    float4 v[4];
    float ss = 0.f;
#pragma unroll
    for (int i = 0; i < 4; i++) {
      v[i] = s4[lane + i * 64];
      ss += v[i].x * v[i].x + v[i].y * v[i].y + v[i].z * v[i].z + v[i].w * v[i].w;
    }
    ss = wsum(ss);
    const float rstd = rsqrtf(ss * (1.0f / DM) + EPSF);
    const float4* g4 = (const float4*)g;
#pragma unroll
    for (int i = 0; i < 4; i++) {
      float4 gg = g4[lane + i * 64];
      float4 o;
      o.x = v[i].x * rstd * gg.x; o.y = v[i].y * rstd * gg.y;
      o.z = v[i].z * rstd * gg.z; o.w = v[i].w * rstd * gg.w;
      if (BF16OUT) {
        uint2 pk; pk.x = pk2(o.x, o.y); pk.y = pk2(o.z, o.w);
        ((uint2*)((bf16*)dstv + (size_t)r * DM))[lane + i * 64] = pk;
      } else {
        ((float4*)((float*)dstv + (size_t)r * DM))[lane + i * 64] = o;
      }
    }
  }
}

__device__ __forceinline__ void ssm_params(const int wave_s, const Params& p, float* ssmp_all) {
  const int tid_ = opaque_tid(wave_s);
  const float* in8 = karg_in(8); const float* in9 = karg_in(9); const float* in10 = karg_in(10);
  const float* in11 = karg_in(11); const float* in12 = karg_in(12);
  const int gt = blockIdx.x * blockDim.x + tid_;
  const int nth = gridDim.x * blockDim.x;
  for (int i = gt; i < 2 * 16 * 64; i += nth) {
    const int l = i / 1024, gp = i % 1024, g = gp / 64;
    float* sp = ssmp_all + (size_t)l * SSMP_PER_LAYER;
    const float lre = fminf(in8[l * 1024 + gp], -1e-4f);
    const float lim = in9[l * 1024 + gp];
    const float dt = expf(in10[l * 16 + g]);
    const float er = expf(lre * dt);
    float sn, cs;
    sincosf(lim * dt, &sn, &cs);
    const float br = er * cs, bi = er * sn;
    sp[gp * 2 + 0] = br;
    sp[gp * 2 + 1] = bi;
    float cr = br, ci = bi;
#pragma unroll
    for (int s = 0; s < 6; s++) {
      const float nr = cr * cr - ci * ci, ni = 2.f * cr * ci;
      cr = nr; ci = ni;
    }
    sp[2048 + gp * 2 + 0] = cr;
    sp[2048 + gp * 2 + 1] = ci;
    const float nr = br - 1.0f, ni = bi;
    const float den = lre * lre + lim * lim;
    const float fr = (nr * lre + ni * lim) / den;
    const float fi = (ni * lre - nr * lim) / den;
    for (int h = 0; h < 16; h++) {
      const float bre = in11[((size_t)l * 1024 + gp) * 16 + h];
      const float bim = in12[((size_t)l * 1024 + gp) * 16 + h];
      sp[4096 + ((g * 16 + h) * 64 + (gp & 63)) * 2 + 0] = fr * bre - fi * bim;
      sp[4096 + ((g * 16 + h) * 64 + (gp & 63)) * 2 + 1] = fr * bim + fi * bre;
    }
  }
}

__device__ __forceinline__ void conv_phase(const int wave_s, const Params& p, int l, const bf16* proj, bf16* y, LAS float* smem) {
  const int tid_ = opaque_tid(wave_s);
  const int lane = tid_ & 63;
  const int gw = blockIdx.x * NWAVES + (tid_ >> 6);
  const int nw = gridDim.x * NWAVES;
  const float* cw = karg_in(4) + (size_t)l * 31 * 256;
  const float4 cb = ((const float4*)(karg_in(5) + l * 256))[lane];
  const float4 lg = ((const float4*)(karg_in(6) + l * 256))[lane];
  const float4 lb = ((const float4*)(karg_in(7) + l * 256))[lane];
  const float4 gg = ((const float4*)(karg_in(18) + l * 1024))[lane];
  LAS float* cwl = smem + 1024;
  for (int i = tid_; i < 31 * 256 / 4; i += NWAVES * 64) *(LAS pg8::f32x4*)(cwl + 4 * i) = *(const pg8::f32x4*)(cw + 4 * i);
  __syncthreads();
  for (int it = gw; it < NT / 8; it += nw) {
    const int tok0 = it * 8;
    const int t0 = tok0 & (SEQ - 1);
    float4 acc[8];
#pragma unroll
    for (int o = 0; o < 8; o++) acc[o] = cb;
#pragma unroll
    for (int i = 0; i < 38; i++) {
      if (t0 - 30 + i >= 0) {
        const bf16* row = proj + (size_t)(tok0 - 30 + i) * DIN;
        const uint2 vp = ((const uint2*)row)[lane];
        const uint2 gp = ((const uint2*)(row + 256))[lane];
        float4 g4;
        g4.x = bf_lo(vp.x) * sigmoidf_(bf_lo(gp.x)); g4.y = bf_hi(vp.x) * sigmoidf_(bf_hi(gp.x));
        g4.z = bf_lo(vp.y) * sigmoidf_(bf_lo(gp.y)); g4.w = bf_hi(vp.y) * sigmoidf_(bf_hi(gp.y));
#pragma unroll
        for (int o = 0; o < 8; o++) {
          const int j = i - o;
          if (j >= 0 && j <= 30) {
            const pg8::f32x4 w4 = *(const LAS pg8::f32x4*)(cwl + j * 256 + lane * 4);
            acc[o].x += g4.x * w4[0]; acc[o].y += g4.y * w4[1];
            acc[o].z += g4.z * w4[2]; acc[o].w += g4.w * w4[3];
          }
        }
      }
    }
#pragma unroll
    for (int o = 0; o < 8; o++) {
      const float4 a = acc[o];
      const float mean = wsum(a.x + a.y + a.z + a.w) * (1.0f / 256.f);
      const float dx = a.x - mean, dy = a.y - mean, dz = a.z - mean, dw = a.w - mean;
      const float var = wsum(dx * dx + dy * dy + dz * dz + dw * dw) * (1.0f / 256.f);
      const float rs = rsqrtf(var + EPSF);
      float4 s;
      s.x = dx * rs * lg.x + lb.x; s.y = dy * rs * lg.y + lb.y;
      s.z = dz * rs * lg.z + lb.z; s.w = dw * rs * lg.w + lb.w;
      s.x = s.x * sigmoidf_(s.x); s.y = s.y * sigmoidf_(s.y);
      s.z = s.z * sigmoidf_(s.z); s.w = s.w * sigmoidf_(s.w);
      const float ss = wsum(s.x * s.x + s.y * s.y + s.z * s.z + s.w * s.w) * (1.0f / 256.f);
      const float r2 = rsqrtf(ss + EPSF);
      uint2 pk; pk.x = pk2(s.x * r2 * gg.x, s.y * r2 * gg.y); pk.y = pk2(s.z * r2 * gg.z, s.w * r2 * gg.w);
      ((uint2*)(y + (size_t)(tok0 + o) * DM))[lane] = pk;
    }
  }
}

typedef short bf16x8_t __attribute__((ext_vector_type(8)));
typedef float f32x16_t __attribute__((ext_vector_type(16)));
#define MFMA_PAD() do { __builtin_amdgcn_sched_barrier(0); asm volatile("s_nop 15\n\ts_nop 15" ::: "memory"); __builtin_amdgcn_sched_barrier(0); } while (0)

__device__ __forceinline__ void attn_phase(const int wave_s, const Params& p, int l, const bf16* proj, bf16* y, LAS float* smem) {
  const int tid = opaque_tid(wave_s), lane = tid & 63, wave = tid >> 6;
  const int n = lane & 31, hh = lane >> 5;
  const float* gg = karg_in(18) + l * 1024 + 256 + wave * 64;
  const float g0 = gg[n], g1 = gg[32 + n];
  LAS float* ssq = smem;
  LAS float* rstd = smem + 256;
  for (int item = blockIdx.x; item < 4 * 128; item += gridDim.x) {
    const int b = item >> 7, q0 = (item & 127) * 32;
    const size_t tokb = (size_t)b * SEQ;
    bf16x8_t qf[4];
    {
      const bf16* qrow = proj + (tokb + q0 + n) * DIN + 512 + wave * 64 + 8 * hh;
#pragma unroll
      for (int ks = 0; ks < 4; ks++) qf[ks] = *(const bf16x8_t*)(qrow + 16 * ks);
    }
    f32x16_t o0, o1;
#pragma unroll
    for (int r = 0; r < 16; r++) { o0[r] = 0.f; o1[r] = 0.f; }
    float R = 0.f;
    for (int kt = q0; kt >= 0; kt -= 32) {
      bf16x8_t kf[4];
      {
        const bf16* krow = proj + (tokb + kt + n) * DIN + 1024 + wave * 64 + 8 * hh;
#pragma unroll
        for (int ks = 0; ks < 4; ks++) kf[ks] = *(const bf16x8_t*)(krow + 16 * ks);
      }
      bf16x8_t vf0[2], vf1[2];
      {
        const bf16* vb = proj + (tokb + kt + 4 * hh) * DIN + 1536 + wave * 64 + n;
#pragma unroll
        for (int s = 0; s < 2; s++)
#pragma unroll
          for (int j = 0; j < 8; j++) {
            const int key = 16 * s + 8 * (j >> 2) + (j & 3);
            vf0[s][j] = (short)vb[(size_t)key * DIN];
            vf1[s][j] = (short)vb[(size_t)key * DIN + 32];
          }
      }
      f32x16_t sacc;
#pragma unroll
      for (int r = 0; r < 16; r++) sacc[r] = 0.f;
      __builtin_amdgcn_sched_barrier(0); asm volatile("s_nop 15\n\ts_nop 15" ::: "memory"); __builtin_amdgcn_sched_barrier(0);
#pragma unroll
      for (int ks = 0; ks < 4; ks++) sacc = __builtin_amdgcn_mfma_f32_32x32x16_bf16(kf[ks], qf[ks], sacc, 0, 0, 0);
      __builtin_amdgcn_sched_barrier(0); asm volatile("s_nop 15\n\ts_nop 15" ::: "memory"); __builtin_amdgcn_sched_barrier(0);
      float lst[16], lsz[16];
      const bool diag = (kt == q0);
#pragma unroll
      for (int r = 0; r < 16; r++) {
        const float z = sacc[r] * 0.125f;
        const float sp = __logf(1.0f + __expf(-fabsf(z)));
        float a = fminf(z, 0.f) - sp;
        float c = -(fmaxf(z, 0.f) + sp);
        if (diag) {
          const int key = (r & 3) + 8 * (r >> 2) + 4 * hh;
          if (key >= n) { a = -1.0e30f; c = 0.f; }
        }
        lsz[r] = a; lst[r] = c;
      }
      float Gs[4], Gp[4];
#pragma unroll
      for (int g = 0; g < 4; g++) {
        Gs[g] = (lst[4 * g] + lst[4 * g + 1]) + (lst[4 * g + 2] + lst[4 * g + 3]);
        Gp[g] = __shfl_xor(Gs[g], 32, 64);
      }
      float carry[4];
      {
        float after = R;
#pragma unroll
        for (int g = 3; g >= 0; g--) {
          carry[g] = after + (hh ? 0.f : Gp[g]);
          after += Gs[g] + Gp[g];
        }
        R = after;
      }
      bf16x8_t pf[2];
#pragma unroll
      for (int g = 0; g < 4; g++) {
        float run = carry[g];
        float a3 = __expf(lsz[4 * g + 3] + run); run += lst[4 * g + 3];
        float a2 = __expf(lsz[4 * g + 2] + run); run += lst[4 * g + 2];
        float a1 = __expf(lsz[4 * g + 1] + run); run += lst[4 * g + 1];
        float a0 = __expf(lsz[4 * g + 0] + run);
        const int s = g >> 1, jb = (g & 1) * 4;
        pf[s][jb + 0] = (short)f2bf(a0); pf[s][jb + 1] = (short)f2bf(a1);
        pf[s][jb + 2] = (short)f2bf(a2); pf[s][jb + 3] = (short)f2bf(a3);
      }
      __builtin_amdgcn_sched_barrier(0); asm volatile("s_nop 15\n\ts_nop 15" ::: "memory"); __builtin_amdgcn_sched_barrier(0);
#pragma unroll
      for (int s = 0; s < 2; s++) {
        o0 = __builtin_amdgcn_mfma_f32_32x32x16_bf16(pf[s], vf0[s], o0, 0, 0, 0);
        o1 = __builtin_amdgcn_mfma_f32_32x32x16_bf16(pf[s], vf1[s], o1, 0, 0, 0);
      }
      __builtin_amdgcn_sched_barrier(0); asm volatile("s_nop 15\n\ts_nop 15" ::: "memory"); __builtin_amdgcn_sched_barrier(0);
      if (__all(R < -110.f)) break;
    }
    float sq[16];
#pragma unroll
    for (int r = 0; r < 16; r++) {
      float v = o0[r] * o0[r] + o1[r] * o1[r];
#pragma unroll
      for (int o = 16; o > 0; o >>= 1) v += __shfl_xor(v, o, 64);
      sq[r] = v;
    }
    __syncthreads();
    if (n == 0) {
#pragma unroll
      for (int r = 0; r < 16; r++) ssq[wave * 32 + (r & 3) + 8 * (r >> 2) + 4 * hh] = sq[r];
    }
    __syncthreads();
    if (tid < 32) {
      float t = 0.f;
#pragma unroll
      for (int w = 0; w < 8; w++) t += ssq[w * 32 + tid];
      rstd[tid] = rsqrtf(t * (1.0f / 512.f) + EPSF);
    }
    __syncthreads();
#pragma unroll
    for (int r = 0; r < 16; r++) {
      const int qi = (r & 3) + 8 * (r >> 2) + 4 * hh;
      const float rs = rstd[qi];
      bf16* yr = y + (tokb + q0 + qi) * DM + 256 + wave * 64 + n;
      yr[0] = (bf16)f2bf(o0[r] * rs * g0);
      yr[32] = (bf16)f2bf(o1[r] * rs * g1);
    }
  }
}

#define SSM_BCAST_U(u, ua, ub, tt) do { \
    const unsigned w0 = (unsigned)__builtin_amdgcn_readlane((int)(ua).x, (tt)), w1 = (unsigned)__builtin_amdgcn_readlane((int)(ua).y, (tt)); \
    const unsigned w2 = (unsigned)__builtin_amdgcn_readlane((int)(ua).z, (tt)), w3 = (unsigned)__builtin_amdgcn_readlane((int)(ua).w, (tt)); \
    const unsigned w4 = (unsigned)__builtin_amdgcn_readlane((int)(ub).x, (tt)), w5 = (unsigned)__builtin_amdgcn_readlane((int)(ub).y, (tt)); \
    const unsigned w6 = (unsigned)__builtin_amdgcn_readlane((int)(ub).z, (tt)), w7 = (unsigned)__builtin_amdgcn_readlane((int)(ub).w, (tt)); \
    (u)[0] = bf_lo(w0); (u)[1] = bf_hi(w0); (u)[2] = bf_lo(w1); (u)[3] = bf_hi(w1); (u)[4] = bf_lo(w2); (u)[5] = bf_hi(w2); (u)[6] = bf_lo(w3); (u)[7] = bf_hi(w3); \
    (u)[8] = bf_lo(w4); (u)[9] = bf_hi(w4); (u)[10] = bf_lo(w5); (u)[11] = bf_hi(w5); (u)[12] = bf_lo(w6); (u)[13] = bf_hi(w6); (u)[14] = bf_lo(w7); (u)[15] = bf_hi(w7); } while (0)
#define SSM_RS 592
#define SSM_TILE_BASE 36864
#define SSM_TILE_BYTES (16 * SSM_RS)
typedef float f32x2_t __attribute__((ext_vector_type(2)));
__device__ __forceinline__ void ssm_load_bop(const float* ssmp, int g, int lane, bf16x8_t (&bop)[8]) {
  const int q = lane >> 4, n = lane & 15;
  float v[8][8];
#pragma unroll
  for (int j = 0; j < 8; j++) {
    const float4* rp = (const float4*)(ssmp + 4096 + (size_t)(g * 16 + ((8 * q + j) & 15)) * 128 + 8 * n);
    const float4 a = rp[0], b = rp[1];
    v[j][0] = a.x; v[j][1] = a.y; v[j][2] = a.z; v[j][3] = a.w; v[j][4] = b.x; v[j][5] = b.y; v[j][6] = b.z; v[j][7] = b.w;
  }
#pragma unroll
  for (int nt = 0; nt < 8; nt++) {
    pg8::u32x4 w;
    w.x = pk2(v[0][nt], v[1][nt]); w.y = pk2(v[2][nt], v[3][nt]); w.z = pk2(v[4][nt], v[5][nt]); w.w = pk2(v[6][nt], v[7][nt]);
    if (q >= 2) { w.x = 0u; w.y = 0u; w.z = 0u; w.w = 0u; }
    bop[nt] = __builtin_bit_cast(bf16x8_t, w);
  }
}
__device__ __forceinline__ void ssm_bu_block(LAS unsigned char* xt, int lane, int blk, const uint4& ua, const uint4& ub, const bf16x8_t (&bop)[8]) {
  const int q = lane >> 4, n = lane & 15;
  if (q == blk) {
    pg8::u32x4 w0, w1;
    w0.x = ua.x; w0.y = ua.y; w0.z = ua.z; w0.w = ua.w; w1.x = ub.x; w1.y = ub.y; w1.z = ub.z; w1.w = ub.w;
    LAS pg8::u32x4* ur = (LAS pg8::u32x4*)(xt + n * SSM_RS + 512);
    ur[0] = w0; ur[1] = w1;
  }
  __builtin_amdgcn_wave_barrier();
  const bf16x8_t uop = *(const LAS bf16x8_t*)(xt + n * SSM_RS + 512 + q * 16);
  pg8::f32x4 bacc[8];
#pragma unroll
  for (int nt = 0; nt < 8; nt++) {
    pg8::f32x4 z4; z4[0] = 0.f; z4[1] = 0.f; z4[2] = 0.f; z4[3] = 0.f;
    bacc[nt] = __builtin_amdgcn_mfma_f32_16x16x32_bf16(uop, bop[nt], z4, 0, 0, 0);
  }
#pragma unroll
  for (int j = 0; j < 4; j++) {
    pg8::f32x4 w0, w1;
    w0[0] = bacc[0][j]; w0[1] = bacc[1][j]; w0[2] = bacc[2][j]; w0[3] = bacc[3][j];
    w1[0] = bacc[4][j]; w1[1] = bacc[5][j]; w1[2] = bacc[6][j]; w1[3] = bacc[7][j];
    LAS pg8::f32x4* dr = (LAS pg8::f32x4*)(xt + (4 * q + j) * SSM_RS + 32 * n);
    dr[0] = w0; dr[1] = w1;
  }
  __builtin_amdgcn_wave_barrier();
}
__device__ __forceinline__ void ssm_zero_pad(LAS unsigned char* xt, int lane) {
  if (lane < 16) {
    pg8::u32x4 z4; z4.x = 0u; z4.y = 0u; z4.z = 0u; z4.w = 0u;
    LAS pg8::u32x4* zr = (LAS pg8::u32x4*)(xt + lane * SSM_RS + 544);
    zr[0] = z4; zr[1] = z4;
  }
}
__device__ __forceinline__ void ssm_chunk_end(const int wave_s, const float* ssmp, const bf16* proj, float* ssmE, LAS float* smem) {
  const int tid_ = opaque_tid(wave_s);
  const int lane = tid_ & 63;
  const int gw = blockIdx.x * NWAVES + (tid_ >> 6);
  const int nw = gridDim.x * NWAVES;
  for (int it = gw; it < 4 * 64 * 16; it += nw) {
    const int g = it & 15, c = (it >> 4) & 63, b = it >> 10;
    const int gp = g * 64 + lane;
    const uint4* up = (const uint4*)(proj + (size_t)(b * SEQ + c * 64 + lane) * DIN + 2048 + g * 16);
    const uint4 ua = up[0], ub = up[1];
    const float lbr = ssmp[gp * 2], lbi = ssmp[gp * 2 + 1];
    bf16x8_t bop[8];
    ssm_load_bop(ssmp, g, lane, bop);
    LAS unsigned char* xt = (LAS unsigned char*)smem + SSM_TILE_BASE + (tid_ >> 6) * SSM_TILE_BYTES;
    ssm_zero_pad(xt, lane);
    float xr = 0.f, xi = 0.f;
#pragma unroll 1
    for (int blk = 0; blk < 4; blk++) {
      ssm_bu_block(xt, lane, blk, ua, ub, bop);
#pragma unroll 4
      for (int tt = 0; tt < 16; tt++) {
        const f32x2_t bu = *(const LAS f32x2_t*)(xt + tt * SSM_RS + lane * 8);
        const float nr = lbr * xr - lbi * xi + bu[0];
        const float ni = lbr * xi + lbi * xr + bu[1];
        xr = nr; xi = ni;
      }
      __builtin_amdgcn_wave_barrier();
    }
    float* e = ssmE + ((size_t)((b * 64 + c) * 16 + g) * 64 + lane) * 2;
    e[0] = xr; e[1] = xi;
  }
}

__device__ __forceinline__ void ssm_finish(const int wave_s, const Params& p, int l, const float* ssmp, const bf16* proj,
                           const float* ssmE, bf16* y, LAS float* smem) {
  LAS bf16* Ytb = (LAS bf16*)smem;
  LAS float* ssq2 = smem + (64 * 264 * 2) / 4;
  LAS float* rstd2 = ssq2 + 512;
  const bf16* glT = (const bf16*)(p.ws + WS_WT + (size_t)l * WT_LAYER + WT_GLU);
  const int tid = opaque_tid(wave_s), lane = tid & 63, wave = tid >> 6;
  const float* cre = karg_in(13) + (size_t)l * 16 * 16 * 64;
  const float* cim = karg_in(14) + (size_t)l * 16 * 16 * 64;
  const float* dsk = karg_in(15) + l * 256;
  const float* glw = karg_in(16) + (size_t)l * 256 * 256;
  const float* glb = karg_in(17) + l * 256;
  const float* gg = karg_in(18) + l * 1024 + 768;
  for (int it = blockIdx.x; it < 256; it += gridDim.x) {
    const int b = it >> 6, c = it & 63;
    __syncthreads();
    for (int gi = 0; gi < 2; gi++) {
      const int g = wave + gi * 8;
      const int gp = g * 64 + lane;
      const float lbr = ssmp[gp * 2], lbi = ssmp[gp * 2 + 1];
      const float lcr = ssmp[2048 + gp * 2], lci = ssmp[2048 + gp * 2 + 1];
      bf16x8_t bop[8];
      ssm_load_bop(ssmp, g, lane, bop);
      bf16x8_t cop[5];
      {
        const int nn = lane & 15, q = lane >> 4;
#pragma unroll
        for (int ks = 0; ks < 4; ks++) {
          const float4 cr4 = *(const float4*)(cre + (g * 16 + nn) * 64 + 16 * ks + 4 * q);
          const float4 ci4 = *(const float4*)(cim + (g * 16 + nn) * 64 + 16 * ks + 4 * q);
          pg8::u32x4 w;
          w.x = pk2(cr4.x, -ci4.x); w.y = pk2(cr4.y, -ci4.y); w.z = pk2(cr4.z, -ci4.z); w.w = pk2(cr4.w, -ci4.w);
          cop[ks] = __builtin_bit_cast(bf16x8_t, w);
        }
        const float dn = dsk[g * 16 + nn];
        float dv[8];
#pragma unroll
        for (int j = 0; j < 8; j++) dv[j] = (8 * q + j == nn) ? dn : 0.f;
        pg8::u32x4 w;
        w.x = pk2(dv[0], dv[1]); w.y = pk2(dv[2], dv[3]); w.z = pk2(dv[4], dv[5]); w.w = pk2(dv[6], dv[7]);
        cop[4] = __builtin_bit_cast(bf16x8_t, w);
      }
      const uint4* up = (const uint4*)(proj + (size_t)(b * SEQ + c * 64 + lane) * DIN + 2048 + g * 16);
      const uint4 ua = up[0], ub = up[1];
      float xr = 0.f, xi = 0.f;
      {
        const float2* eb = (const float2*)ssmE + ((size_t)(b * 64) * 16 + g) * 64 + lane;
        for (int cc = 0; cc < c; cc += 16) {
          float2 ev[16];
#pragma unroll
          for (int k = 0; k < 16; k++) ev[k] = eb[(size_t)(cc + k < c ? cc + k : c - 1) * 16 * 64];
#pragma unroll
          for (int k = 0; k < 16; k++) {
            if (cc + k < c) {
              const float nr = lcr * xr - lci * xi + ev[k].x;
              const float ni = lcr * xi + lci * xr + ev[k].y;
              xr = nr; xi = ni;
            }
          }
        }
      }
      LAS unsigned char* xt = (LAS unsigned char*)smem + SSM_TILE_BASE + wave * SSM_TILE_BYTES;
      ssm_zero_pad(xt, lane);
#pragma unroll 1
      for (int blk = 0; blk < 4; blk++) {
        ssm_bu_block(xt, lane, blk, ua, ub, bop);
#pragma unroll 4
        for (int tt = 0; tt < 16; tt++) {
          const f32x2_t bu = *(const LAS f32x2_t*)(xt + tt * SSM_RS + lane * 8);
          const float nr = lbr * xr - lbi * xi + bu[0];
          const float ni = lbr * xi + lbi * xr + bu[1];
          xr = nr; xi = ni;
          *(LAS unsigned*)(xt + tt * SSM_RS + lane * 4) = pk2(xr, xi);
        }
        __builtin_amdgcn_wave_barrier();
        {
          pg8::f32x4 acc4;
          acc4[0] = 0.f; acc4[1] = 0.f; acc4[2] = 0.f; acc4[3] = 0.f;
          const LAS unsigned char* ar = xt + (lane & 15) * SSM_RS + (lane >> 4) * 16;
#pragma unroll
          for (int ks = 0; ks < 4; ks++)
            acc4 = __builtin_amdgcn_mfma_f32_16x16x32_bf16(*(const LAS bf16x8_t*)(ar + ks * 64), cop[ks], acc4, 0, 0, 0);
          acc4 = __builtin_amdgcn_mfma_f32_16x16x32_bf16(*(const LAS bf16x8_t*)(ar + 512), cop[4], acc4, 0, 0, 0);
#pragma unroll
          for (int j = 0; j < 4; j++)
            Ytb[(blk * 16 + 4 * (lane >> 4) + j) * 264 + g * 16 + (lane & 15)] = (bf16)f2bf(gelu_tanh(acc4[j]));
        }
        __builtin_amdgcn_wave_barrier();
      }
    }
    __syncthreads();
    {
      const int n = lane & 31, hh = lane >> 5;
      const int ch = wave * 32 + n;
      const float bj = glb[ch];
      const float gj = gg[ch];
      bf16x8_t gf[16];
      {
        const bf16* grow = glT + (size_t)ch * 256 + 8 * hh;
#pragma unroll
        for (int ks = 0; ks < 16; ks++) gf[ks] = *(const bf16x8_t*)(grow + 16 * ks);
      }
      float oo[2][16];
#pragma unroll
      for (int mt = 0; mt < 2; mt++) {
        f32x16_t z;
#pragma unroll
        for (int r = 0; r < 16; r++) z[r] = 0.f;
        const LAS bf16* yrow = Ytb + (mt * 32 + n) * 264 + 8 * hh;
#pragma unroll
        for (int kq = 0; kq < 4; kq++) {
          bf16x8_t yf[4];
#pragma unroll
          for (int i = 0; i < 4; i++) yf[i] = *(const LAS bf16x8_t*)(yrow + 16 * (kq * 4 + i));
          MFMA_PAD();
#pragma unroll
          for (int i = 0; i < 4; i++) z = __builtin_amdgcn_mfma_f32_32x32x16_bf16(yf[i], gf[kq * 4 + i], z, 0, 0, 0);
          MFMA_PAD();
        }
        float sq[16];
#pragma unroll
        for (int r = 0; r < 16; r++) {
          const int t = mt * 32 + (r & 3) + 8 * (r >> 2) + 4 * hh;
          const float yv = bf2f(Ytb[t * 264 + ch]);
          const float o = yv * sigmoidf_(z[r] + bj);
          oo[mt][r] = o;
          float v = o * o;
#pragma unroll
          for (int s = 16; s > 0; s >>= 1) v += __shfl_xor(v, s, 64);
          sq[r] = v;
        }
        if (n == 0) {
#pragma unroll
          for (int r = 0; r < 16; r++) ssq2[wave * 64 + mt * 32 + (r & 3) + 8 * (r >> 2) + 4 * hh] = sq[r];
        }
      }
      __syncthreads();
      if (tid < 64) {
        float t = 0.f;
#pragma unroll
        for (int w = 0; w < 8; w++) t += ssq2[w * 64 + tid];
        rstd2[tid] = rsqrtf(t * (1.0f / 256.f) + EPSF);
      }
      __syncthreads();
#pragma unroll
      for (int mt = 0; mt < 2; mt++)
#pragma unroll
        for (int r = 0; r < 16; r++) {
          const int t = mt * 32 + (r & 3) + 8 * (r >> 2) + 4 * hh;
          y[(size_t)(b * SEQ + c * 64 + t) * DM + 768 + ch] = (bf16)f2bf(oo[mt][r] * rstd2[t] * gj);
        }
    }
  }
}

__device__ __forceinline__ void memattn_phase(const int wave_s, const bf16* q, const bf16* kvb, const bf16* vT, bf16* o, LAS float* smem) {
  const int tid_ = opaque_tid(wave_s);
  const int lane = tid_ & 63, n = lane & 31, hh = lane >> 5, wave = tid_ >> 6;
  const int sig = (n & 0x13) | ((n & 4) << 1) | ((n & 8) >> 1);
  LAS bf16* Ls = (LAS bf16*)smem;
  for (int it = blockIdx.x; it < 64 * 4; it += gridDim.x) {
    const int h = it & 3, tg = it >> 2, b = tg >> 4;
    const int tok0 = (tg * 8 + wave) * 32;
    __syncthreads();
    {
      const int r = tid_ >> 1, hf = tid_ & 1;
      const pg8::u32x4* src4 = (const pg8::u32x4*)(kvb + (size_t)(b * NMEM + r) * 2048 + h * 256 + hf * 128);
      LAS pg8::u32x4* dst4 = (LAS pg8::u32x4*)(Ls + r * 264 + hf * 128);
#pragma unroll
      for (int k = 0; k < 16; k++) dst4[k] = src4[k];
    }
    f32x16_t st[8];
#pragma unroll
    for (int kt = 0; kt < 8; kt++)
#pragma unroll
      for (int r = 0; r < 16; r++) st[kt][r] = 0.f;
    const bf16* qrow = q + (size_t)(tok0 + n) * DM + h * 256 + 8 * hh;
    __syncthreads();
#pragma unroll
    for (int kq = 0; kq < 4; kq++) {
      bf16x8_t qf[4];
#pragma unroll
      for (int i = 0; i < 4; i++) qf[i] = *(const bf16x8_t*)(qrow + 16 * (kq * 4 + i));
#pragma unroll
      for (int kt = 0; kt < 8; kt++) {
        const LAS bf16* krow = Ls + (kt * 32 + sig) * 264 + 8 * hh;
        bf16x8_t kf[4];
#pragma unroll
        for (int i = 0; i < 4; i++) kf[i] = *(const LAS bf16x8_t*)(krow + 16 * (kq * 4 + i));
        MFMA_PAD();
#pragma unroll
        for (int i = 0; i < 4; i++) st[kt] = __builtin_amdgcn_mfma_f32_32x32x16_bf16(kf[i], qf[i], st[kt], 0, 0, 0);
        MFMA_PAD();
      }
    }
    float mx = st[0][0];
#pragma unroll
    for (int kt = 0; kt < 8; kt++)
#pragma unroll
      for (int r = 0; r < 16; r++) mx = fmaxf(mx, st[kt][r]);
    mx = fmaxf(mx, __shfl_xor(mx, 32, 64));
    float sum = 0.f;
#pragma unroll
    for (int kt = 0; kt < 8; kt++)
#pragma unroll
      for (int r = 0; r < 16; r++) { const float e = __expf((st[kt][r] - mx) * 0.0625f); st[kt][r] = e; sum += e; }
    sum += __shfl_xor(sum, 32, 64);
    const float inv = 1.0f / sum;
    bf16x8_t pf[8][2];
#pragma unroll
    for (int kt = 0; kt < 8; kt++)
#pragma unroll
      for (int s = 0; s < 2; s++)
#pragma unroll
        for (int j = 0; j < 8; j++) pf[kt][s][j] = (short)f2bf(st[kt][8 * s + j] * inv);
    __syncthreads();
    {
      const int r = tid_ >> 1, hf = tid_ & 1;
      const pg8::u32x4* src4 = (const pg8::u32x4*)(vT + ((size_t)(b * 4 + h) * 256 + r) * 256 + hf * 128);
      LAS pg8::u32x4* dst4 = (LAS pg8::u32x4*)(Ls + r * 264 + hf * 128);
#pragma unroll
      for (int k = 0; k < 16; k++) dst4[k] = src4[k];
    }
    __syncthreads();
#pragma unroll 1
    for (int dt = 0; dt < 8; dt++) {
      f32x16_t oacc;
#pragma unroll
      for (int r = 0; r < 16; r++) oacc[r] = 0.f;
      const LAS bf16* vrow = Ls + (dt * 32 + n) * 264 + 8 * hh;
#pragma unroll
      for (int kq = 0; kq < 4; kq++) {
        bf16x8_t vf[4];
#pragma unroll
        for (int i = 0; i < 4; i++) vf[i] = *(const LAS bf16x8_t*)(vrow + (kq * 2 + (i >> 1)) * 32 + 16 * (i & 1));
        MFMA_PAD();
#pragma unroll
        for (int i = 0; i < 4; i++) oacc = __builtin_amdgcn_mfma_f32_32x32x16_bf16(pf[kq * 2 + (i >> 1)][i & 1], vf[i], oacc, 0, 0, 0);
        MFMA_PAD();
      }
#pragma unroll
      for (int r = 0; r < 16; r++) {
        const int qi = (r & 3) + 8 * (r >> 2) + 4 * hh;
        o[(size_t)(tok0 + qi) * DM + h * 256 + dt * 32 + n] = (bf16)f2bf(oacc[r]);
      }
    }
  }
}

__device__ __forceinline__ void vt_phase(const int wave_s, const bf16* kvb, bf16* vT) {
  const int tid_ = opaque_tid(wave_s);
  const int gt = blockIdx.x * (NWAVES * 64) + tid_;
  const int nth = gridDim.x * NWAVES * 64;
  for (int i = gt; i < 2 * 4 * 4 * 256 * 256; i += nth) {
    const int m = i & 255, d = (i >> 8) & 255, h = (i >> 16) & 3, b = (i >> 18) & 3, l = i >> 20;
    vT[i] = kvb[((size_t)l * 1024 + b * 256 + m) * 2048 + 1024 + h * 256 + d];
  }
}

template <unsigned MASK>
__device__ __forceinline__ float pack_key(float s, unsigned idx) {
  const unsigned u = __builtin_bit_cast(unsigned, s);
  const unsigned tag = ((int)u < 0) ? idx : (MASK - idx);
  return __builtin_bit_cast(float, (u & ~MASK) + tag);
}
template <unsigned MASK>
__device__ __forceinline__ unsigned key_idx(float k) {
  const unsigned u = __builtin_bit_cast(unsigned, k);
  const unsigned tag = u & MASK;
  return ((int)u < 0) ? tag : (MASK - tag);
}
template <unsigned MASK>
__device__ __forceinline__ float key_val(float k) { return __builtin_bit_cast(float, __builtin_bit_cast(unsigned, k) & ~MASK); }
__device__ __forceinline__ void top16_of_64(float (&K)[64]) {
  { const float a_ = K[0], b_ = K[1]; const bool g_ = a_ > b_; K[0] = g_ ? a_ : b_; K[1] = g_ ? b_ : a_; }
  { const float a_ = K[2], b_ = K[3]; const bool g_ = a_ > b_; K[2] = g_ ? b_ : a_; K[3] = g_ ? a_ : b_; }
  { const float a_ = K[4], b_ = K[5]; const bool g_ = a_ > b_; K[4] = g_ ? a_ : b_; K[5] = g_ ? b_ : a_; }
  { const float a_ = K[6], b_ = K[7]; const bool g_ = a_ > b_; K[6] = g_ ? b_ : a_; K[7] = g_ ? a_ : b_; }
  { const float a_ = K[8], b_ = K[9]; const bool g_ = a_ > b_; K[8] = g_ ? a_ : b_; K[9] = g_ ? b_ : a_; }
  { const float a_ = K[10], b_ = K[11]; const bool g_ = a_ > b_; K[10] = g_ ? b_ : a_; K[11] = g_ ? a_ : b_; }
  { const float a_ = K[12], b_ = K[13]; const bool g_ = a_ > b_; K[12] = g_ ? a_ : b_; K[13] = g_ ? b_ : a_; }
  { const float a_ = K[14], b_ = K[15]; const bool g_ = a_ > b_; K[14] = g_ ? b_ : a_; K[15] = g_ ? a_ : b_; }
  { const float a_ = K[0], b_ = K[2]; const bool g_ = a_ > b_; K[0] = g_ ? a_ : b_; K[2] = g_ ? b_ : a_; }
  { const float a_ = K[1], b_ = K[3]; const bool g_ = a_ > b_; K[1] = g_ ? a_ : b_; K[3] = g_ ? b_ : a_; }
  { const float a_ = K[4], b_ = K[6]; const bool g_ = a_ > b_; K[4] = g_ ? b_ : a_; K[6] = g_ ? a_ : b_; }
  { const float a_ = K[5], b_ = K[7]; const bool g_ = a_ > b_; K[5] = g_ ? b_ : a_; K[7] = g_ ? a_ : b_; }
  { const float a_ = K[8], b_ = K[10]; const bool g_ = a_ > b_; K[8] = g_ ? a_ : b_; K[10] = g_ ? b_ : a_; }
  { const float a_ = K[9], b_ = K[11]; const bool g_ = a_ > b_; K[9] = g_ ? a_ : b_; K[11] = g_ ? b_ : a_; }
  { const float a_ = K[12], b_ = K[14]; const bool g_ = a_ > b_; K[12] = g_ ? b_ : a_; K[14] = g_ ? a_ : b_; }
  { const float a_ = K[13], b_ = K[15]; const bool g_ = a_ > b_; K[13] = g_ ? b_ : a_; K[15] = g_ ? a_ : b_; }
  { const float a_ = K[0], b_ = K[1]; const bool g_ = a_ > b_; K[0] = g_ ? a_ : b_; K[1] = g_ ? b_ : a_; }
  { const float a_ = K[2], b_ = K[3]; const bool g_ = a_ > b_; K[2] = g_ ? a_ : b_; K[3] = g_ ? b_ : a_; }
  { const float a_ = K[4], b_ = K[5]; const bool g_ = a_ > b_; K[4] = g_ ? b_ : a_; K[5] = g_ ? a_ : b_; }
  { const float a_ = K[6], b_ = K[7]; const bool g_ = a_ > b_; K[6] = g_ ? b_ : a_; K[7] = g_ ? a_ : b_; }
  { const float a_ = K[8], b_ = K[9]; const bool g_ = a_ > b_; K[8] = g_ ? a_ : b_; K[9] = g_ ? b_ : a_; }
  { const float a_ = K[10], b_ = K[11]; const bool g_ = a_ > b_; K[10] = g_ ? a_ : b_; K[11] = g_ ? b_ : a_; }
  { const float a_ = K[12], b_ = K[13]; const bool g_ = a_ > b_; K[12] = g_ ? b_ : a_; K[13] = g_ ? a_ : b_; }
  { const float a_ = K[14], b_ = K[15]; const bool g_ = a_ > b_; K[14] = g_ ? b_ : a_; K[15] = g_ ? a_ : b_; }
  { const float a_ = K[0], b_ = K[4]; const bool g_ = a_ > b_; K[0] = g_ ? a_ : b_; K[4] = g_ ? b_ : a_; }
  { const float a_ = K[1], b_ = K[5]; const bool g_ = a_ > b_; K[1] = g_ ? a_ : b_; K[5] = g_ ? b_ : a_; }
  { const float a_ = K[2], b_ = K[6]; const bool g_ = a_ > b_; K[2] = g_ ? a_ : b_; K[6] = g_ ? b_ : a_; }
  { const float a_ = K[3], b_ = K[7]; const bool g_ = a_ > b_; K[3] = g_ ? a_ : b_; K[7] = g_ ? b_ : a_; }
  { const float a_ = K[8], b_ = K[12]; const bool g_ = a_ > b_; K[8] = g_ ? b_ : a_; K[12] = g_ ? a_ : b_; }
  { const float a_ = K[9], b_ = K[13]; const bool g_ = a_ > b_; K[9] = g_ ? b_ : a_; K[13] = g_ ? a_ : b_; }
  { const float a_ = K[10], b_ = K[14]; const bool g_ = a_ > b_; K[10] = g_ ? b_ : a_; K[14] = g_ ? a_ : b_; }
  { const float a_ = K[11], b_ = K[15]; const bool g_ = a_ > b_; K[11] = g_ ? b_ : a_; K[15] = g_ ? a_ : b_; }
  { const float a_ = K[0], b_ = K[2]; const bool g_ = a_ > b_; K[0] = g_ ? a_ : b_; K[2] = g_ ? b_ : a_; }
  { const float a_ = K[1], b_ = K[3]; const bool g_ = a_ > b_; K[1] = g_ ? a_ : b_; K[3] = g_ ? b_ : a_; }
  { const float a_ = K[4], b_ = K[6]; const bool g_ = a_ > b_; K[4] = g_ ? a_ : b_; K[6] = g_ ? b_ : a_; }
  { const float a_ = K[5], b_ = K[7]; const bool g_ = a_ > b_; K[5] = g_ ? a_ : b_; K[7] = g_ ? b_ : a_; }
  { const float a_ = K[8], b_ = K[10]; const bool g_ = a_ > b_; K[8] = g_ ? b_ : a_; K[10] = g_ ? a_ : b_; }
  { const float a_ = K[9], b_ = K[11]; const bool g_ = a_ > b_; K[9] = g_ ? b_ : a_; K[11] = g_ ? a_ : b_; }
  { const float a_ = K[12], b_ = K[14]; const bool g_ = a_ > b_; K[12] = g_ ? b_ : a_; K[14] = g_ ? a_ : b_; }
  { const float a_ = K[13], b_ = K[15]; const bool g_ = a_ > b_; K[13] = g_ ? b_ : a_; K[15] = g_ ? a_ : b_; }
  { const float a_ = K[0], b_ = K[1]; const bool g_ = a_ > b_; K[0] = g_ ? a_ : b_; K[1] = g_ ? b_ : a_; }
  { const float a_ = K[2], b_ = K[3]; const bool g_ = a_ > b_; K[2] = g_ ? a_ : b_; K[3] = g_ ? b_ : a_; }
  { const float a_ = K[4], b_ = K[5]; const bool g_ = a_ > b_; K[4] = g_ ? a_ : b_; K[5] = g_ ? b_ : a_; }
  { const float a_ = K[6], b_ = K[7]; const bool g_ = a_ > b_; K[6] = g_ ? a_ : b_; K[7] = g_ ? b_ : a_; }
  { const float a_ = K[8], b_ = K[9]; const bool g_ = a_ > b_; K[8] = g_ ? b_ : a_; K[9] = g_ ? a_ : b_; }
  { const float a_ = K[10], b_ = K[11]; const bool g_ = a_ > b_; K[10] = g_ ? b_ : a_; K[11] = g_ ? a_ : b_; }
  { const float a_ = K[12], b_ = K[13]; const bool g_ = a_ > b_; K[12] = g_ ? b_ : a_; K[13] = g_ ? a_ : b_; }
  { const float a_ = K[14], b_ = K[15]; const bool g_ = a_ > b_; K[14] = g_ ? b_ : a_; K[15] = g_ ? a_ : b_; }
  { const float a_ = K[0], b_ = K[8]; const bool g_ = a_ > b_; K[0] = g_ ? a_ : b_; K[8] = g_ ? b_ : a_; }
  { const float a_ = K[1], b_ = K[9]; const bool g_ = a_ > b_; K[1] = g_ ? a_ : b_; K[9] = g_ ? b_ : a_; }
  { const float a_ = K[2], b_ = K[10]; const bool g_ = a_ > b_; K[2] = g_ ? a_ : b_; K[10] = g_ ? b_ : a_; }
  { const float a_ = K[3], b_ = K[11]; const bool g_ = a_ > b_; K[3] = g_ ? a_ : b_; K[11] = g_ ? b_ : a_; }
  { const float a_ = K[4], b_ = K[12]; const bool g_ = a_ > b_; K[4] = g_ ? a_ : b_; K[12] = g_ ? b_ : a_; }
  { const float a_ = K[5], b_ = K[13]; const bool g_ = a_ > b_; K[5] = g_ ? a_ : b_; K[13] = g_ ? b_ : a_; }
  { const float a_ = K[6], b_ = K[14]; const bool g_ = a_ > b_; K[6] = g_ ? a_ : b_; K[14] = g_ ? b_ : a_; }
  { const float a_ = K[7], b_ = K[15]; const bool g_ = a_ > b_; K[7] = g_ ? a_ : b_; K[15] = g_ ? b_ : a_; }
  { const float a_ = K[0], b_ = K[4]; const bool g_ = a_ > b_; K[0] = g_ ? a_ : b_; K[4] = g_ ? b_ : a_; }
  { const float a_ = K[1], b_ = K[5]; const bool g_ = a_ > b_; K[1] = g_ ? a_ : b_; K[5] = g_ ? b_ : a_; }
  { const float a_ = K[2], b_ = K[6]; const bool g_ = a_ > b_; K[2] = g_ ? a_ : b_; K[6] = g_ ? b_ : a_; }
  { const float a_ = K[3], b_ = K[7]; const bool g_ = a_ > b_; K[3] = g_ ? a_ : b_; K[7] = g_ ? b_ : a_; }
  { const float a_ = K[8], b_ = K[12]; const bool g_ = a_ > b_; K[8] = g_ ? a_ : b_; K[12] = g_ ? b_ : a_; }
  { const float a_ = K[9], b_ = K[13]; const bool g_ = a_ > b_; K[9] = g_ ? a_ : b_; K[13] = g_ ? b_ : a_; }
  { const float a_ = K[10], b_ = K[14]; const bool g_ = a_ > b_; K[10] = g_ ? a_ : b_; K[14] = g_ ? b_ : a_; }
  { const float a_ = K[11], b_ = K[15]; const bool g_ = a_ > b_; K[11] = g_ ? a_ : b_; K[15] = g_ ? b_ : a_; }
  { const float a_ = K[0], b_ = K[2]; const bool g_ = a_ > b_; K[0] = g_ ? a_ : b_; K[2] = g_ ? b_ : a_; }
  { const float a_ = K[1], b_ = K[3]; const bool g_ = a_ > b_; K[1] = g_ ? a_ : b_; K[3] = g_ ? b_ : a_; }
  { const float a_ = K[4], b_ = K[6]; const bool g_ = a_ > b_; K[4] = g_ ? a_ : b_; K[6] = g_ ? b_ : a_; }
  { const float a_ = K[5], b_ = K[7]; const bool g_ = a_ > b_; K[5] = g_ ? a_ : b_; K[7] = g_ ? b_ : a_; }
  { const float a_ = K[8], b_ = K[10]; const bool g_ = a_ > b_; K[8] = g_ ? a_ : b_; K[10] = g_ ? b_ : a_; }
  { const float a_ = K[9], b_ = K[11]; const bool g_ = a_ > b_; K[9] = g_ ? a_ : b_; K[11] = g_ ? b_ : a_; }
  { const float a_ = K[12], b_ = K[14]; const bool g_ = a_ > b_; K[12] = g_ ? a_ : b_; K[14] = g_ ? b_ : a_; }
  { const float a_ = K[13], b_ = K[15]; const bool g_ = a_ > b_; K[13] = g_ ? a_ : b_; K[15] = g_ ? b_ : a_; }
  { const float a_ = K[0], b_ = K[1]; const bool g_ = a_ > b_; K[0] = g_ ? a_ : b_; K[1] = g_ ? b_ : a_; }
  { const float a_ = K[2], b_ = K[3]; const bool g_ = a_ > b_; K[2] = g_ ? a_ : b_; K[3] = g_ ? b_ : a_; }
  { const float a_ = K[4], b_ = K[5]; const bool g_ = a_ > b_; K[4] = g_ ? a_ : b_; K[5] = g_ ? b_ : a_; }
  { const float a_ = K[6], b_ = K[7]; const bool g_ = a_ > b_; K[6] = g_ ? a_ : b_; K[7] = g_ ? b_ : a_; }
  { const float a_ = K[8], b_ = K[9]; const bool g_ = a_ > b_; K[8] = g_ ? a_ : b_; K[9] = g_ ? b_ : a_; }
  { const float a_ = K[10], b_ = K[11]; const bool g_ = a_ > b_; K[10] = g_ ? a_ : b_; K[11] = g_ ? b_ : a_; }
  { const float a_ = K[12], b_ = K[13]; const bool g_ = a_ > b_; K[12] = g_ ? a_ : b_; K[13] = g_ ? b_ : a_; }
  { const float a_ = K[14], b_ = K[15]; const bool g_ = a_ > b_; K[14] = g_ ? a_ : b_; K[15] = g_ ? b_ : a_; }
  { const float a_ = K[16], b_ = K[17]; const bool g_ = a_ > b_; K[16] = g_ ? a_ : b_; K[17] = g_ ? b_ : a_; }
  { const float a_ = K[18], b_ = K[19]; const bool g_ = a_ > b_; K[18] = g_ ? b_ : a_; K[19] = g_ ? a_ : b_; }
  { const float a_ = K[20], b_ = K[21]; const bool g_ = a_ > b_; K[20] = g_ ? a_ : b_; K[21] = g_ ? b_ : a_; }
  { const float a_ = K[22], b_ = K[23]; const bool g_ = a_ > b_; K[22] = g_ ? b_ : a_; K[23] = g_ ? a_ : b_; }
  { const float a_ = K[24], b_ = K[25]; const bool g_ = a_ > b_; K[24] = g_ ? a_ : b_; K[25] = g_ ? b_ : a_; }
  { const float a_ = K[26], b_ = K[27]; const bool g_ = a_ > b_; K[26] = g_ ? b_ : a_; K[27] = g_ ? a_ : b_; }
  { const float a_ = K[28], b_ = K[29]; const bool g_ = a_ > b_; K[28] = g_ ? a_ : b_; K[29] = g_ ? b_ : a_; }
  { const float a_ = K[30], b_ = K[31]; const bool g_ = a_ > b_; K[30] = g_ ? b_ : a_; K[31] = g_ ? a_ : b_; }
  { const float a_ = K[16], b_ = K[18]; const bool g_ = a_ > b_; K[16] = g_ ? a_ : b_; K[18] = g_ ? b_ : a_; }
  { const float a_ = K[17], b_ = K[19]; const bool g_ = a_ > b_; K[17] = g_ ? a_ : b_; K[19] = g_ ? b_ : a_; }
  { const float a_ = K[20], b_ = K[22]; const bool g_ = a_ > b_; K[20] = g_ ? b_ : a_; K[22] = g_ ? a_ : b_; }
  { const float a_ = K[21], b_ = K[23]; const bool g_ = a_ > b_; K[21] = g_ ? b_ : a_; K[23] = g_ ? a_ : b_; }
  { const float a_ = K[24], b_ = K[26]; const bool g_ = a_ > b_; K[24] = g_ ? a_ : b_; K[26] = g_ ? b_ : a_; }
  { const float a_ = K[25], b_ = K[27]; const bool g_ = a_ > b_; K[25] = g_ ? a_ : b_; K[27] = g_ ? b_ : a_; }
  { const float a_ = K[28], b_ = K[30]; const bool g_ = a_ > b_; K[28] = g_ ? b_ : a_; K[30] = g_ ? a_ : b_; }
  { const float a_ = K[29], b_ = K[31]; const bool g_ = a_ > b_; K[29] = g_ ? b_ : a_; K[31] = g_ ? a_ : b_; }
  { const float a_ = K[16], b_ = K[17]; const bool g_ = a_ > b_; K[16] = g_ ? a_ : b_; K[17] = g_ ? b_ : a_; }
  { const float a_ = K[18], b_ = K[19]; const bool g_ = a_ > b_; K[18] = g_ ? a_ : b_; K[19] = g_ ? b_ : a_; }
  { const float a_ = K[20], b_ = K[21]; const bool g_ = a_ > b_; K[20] = g_ ? b_ : a_; K[21] = g_ ? a_ : b_; }
  { const float a_ = K[22], b_ = K[23]; const bool g_ = a_ > b_; K[22] = g_ ? b_ : a_; K[23] = g_ ? a_ : b_; }
  { const float a_ = K[24], b_ = K[25]; const bool g_ = a_ > b_; K[24] = g_ ? a_ : b_; K[25] = g_ ? b_ : a_; }
  { const float a_ = K[26], b_ = K[27]; const bool g_ = a_ > b_; K[26] = g_ ? a_ : b_; K[27] = g_ ? b_ : a_; }
  { const float a_ = K[28], b_ = K[29]; const bool g_ = a_ > b_; K[28] = g_ ? b_ : a_; K[29] = g_ ? a_ : b_; }
  { const float a_ = K[30], b_ = K[31]; const bool g_ = a_ > b_; K[30] = g_ ? b_ : a_; K[31] = g_ ? a_ : b_; }
  { const float a_ = K[16], b_ = K[20]; const bool g_ = a_ > b_; K[16] = g_ ? a_ : b_; K[20] = g_ ? b_ : a_; }
  { const float a_ = K[17], b_ = K[21]; const bool g_ = a_ > b_; K[17] = g_ ? a_ : b_; K[21] = g_ ? b_ : a_; }
  { const float a_ = K[18], b_ = K[22]; const bool g_ = a_ > b_; K[18] = g_ ? a_ : b_; K[22] = g_ ? b_ : a_; }
  { const float a_ = K[19], b_ = K[23]; const bool g_ = a_ > b_; K[19] = g_ ? a_ : b_; K[23] = g_ ? b_ : a_; }
  { const float a_ = K[24], b_ = K[28]; const bool g_ = a_ > b_; K[24] = g_ ? b_ : a_; K[28] = g_ ? a_ : b_; }
  { const float a_ = K[25], b_ = K[29]; const bool g_ = a_ > b_; K[25] = g_ ? b_ : a_; K[29] = g_ ? a_ : b_; }
  { const float a_ = K[26], b_ = K[30]; const bool g_ = a_ > b_; K[26] = g_ ? b_ : a_; K[30] = g_ ? a_ : b_; }
  { const float a_ = K[27], b_ = K[31]; const bool g_ = a_ > b_; K[27] = g_ ? b_ : a_; K[31] = g_ ? a_ : b_; }
  { const float a_ = K[16], b_ = K[18]; const bool g_ = a_ > b_; K[16] = g_ ? a_ : b_; K[18] = g_ ? b_ : a_; }
  { const float a_ = K[17], b_ = K[19]; const bool g_ = a_ > b_; K[17] = g_ ? a_ : b_; K[19] = g_ ? b_ : a_; }
  { const float a_ = K[20], b_ = K[22]; const bool g_ = a_ > b_; K[20] = g_ ? a_ : b_; K[22] = g_ ? b_ : a_; }
  { const float a_ = K[21], b_ = K[23]; const bool g_ = a_ > b_; K[21] = g_ ? a_ : b_; K[23] = g_ ? b_ : a_; }
  { const float a_ = K[24], b_ = K[26]; const bool g_ = a_ > b_; K[24] = g_ ? b_ : a_; K[26] = g_ ? a_ : b_; }
  { const float a_ = K[25], b_ = K[27]; const bool g_ = a_ > b_; K[25] = g_ ? b_ : a_; K[27] = g_ ? a_ : b_; }
  { const float a_ = K[28], b_ = K[30]; const bool g_ = a_ > b_; K[28] = g_ ? b_ : a_; K[30] = g_ ? a_ : b_; }
  { const float a_ = K[29], b_ = K[31]; const bool g_ = a_ > b_; K[29] = g_ ? b_ : a_; K[31] = g_ ? a_ : b_; }
  { const float a_ = K[16], b_ = K[17]; const bool g_ = a_ > b_; K[16] = g_ ? a_ : b_; K[17] = g_ ? b_ : a_; }
  { const float a_ = K[18], b_ = K[19]; const bool g_ = a_ > b_; K[18] = g_ ? a_ : b_; K[19] = g_ ? b_ : a_; }
  { const float a_ = K[20], b_ = K[21]; const bool g_ = a_ > b_; K[20] = g_ ? a_ : b_; K[21] = g_ ? b_ : a_; }
  { const float a_ = K[22], b_ = K[23]; const bool g_ = a_ > b_; K[22] = g_ ? a_ : b_; K[23] = g_ ? b_ : a_; }
  { const float a_ = K[24], b_ = K[25]; const bool g_ = a_ > b_; K[24] = g_ ? b_ : a_; K[25] = g_ ? a_ : b_; }
  { const float a_ = K[26], b_ = K[27]; const bool g_ = a_ > b_; K[26] = g_ ? b_ : a_; K[27] = g_ ? a_ : b_; }
  { const float a_ = K[28], b_ = K[29]; const bool g_ = a_ > b_; K[28] = g_ ? b_ : a_; K[29] = g_ ? a_ : b_; }
  { const float a_ = K[30], b_ = K[31]; const bool g_ = a_ > b_; K[30] = g_ ? b_ : a_; K[31] = g_ ? a_ : b_; }
  { const float a_ = K[16], b_ = K[24]; const bool g_ = a_ > b_; K[16] = g_ ? a_ : b_; K[24] = g_ ? b_ : a_; }
  { const float a_ = K[17], b_ = K[25]; const bool g_ = a_ > b_; K[17] = g_ ? a_ : b_; K[25] = g_ ? b_ : a_; }
  { const float a_ = K[18], b_ = K[26]; const bool g_ = a_ > b_; K[18] = g_ ? a_ : b_; K[26] = g_ ? b_ : a_; }
  { const float a_ = K[19], b_ = K[27]; const bool g_ = a_ > b_; K[19] = g_ ? a_ : b_; K[27] = g_ ? b_ : a_; }
  { const float a_ = K[20], b_ = K[28]; const bool g_ = a_ > b_; K[20] = g_ ? a_ : b_; K[28] = g_ ? b_ : a_; }
  { const float a_ = K[21], b_ = K[29]; const bool g_ = a_ > b_; K[21] = g_ ? a_ : b_; K[29] = g_ ? b_ : a_; }
  { const float a_ = K[22], b_ = K[30]; const bool g_ = a_ > b_; K[22] = g_ ? a_ : b_; K[30] = g_ ? b_ : a_; }
  { const float a_ = K[23], b_ = K[31]; const bool g_ = a_ > b_; K[23] = g_ ? a_ : b_; K[31] = g_ ? b_ : a_; }
  { const float a_ = K[16], b_ = K[20]; const bool g_ = a_ > b_; K[16] = g_ ? a_ : b_; K[20] = g_ ? b_ : a_; }
  { const float a_ = K[17], b_ = K[21]; const bool g_ = a_ > b_; K[17] = g_ ? a_ : b_; K[21] = g_ ? b_ : a_; }
  { const float a_ = K[18], b_ = K[22]; const bool g_ = a_ > b_; K[18] = g_ ? a_ : b_; K[22] = g_ ? b_ : a_; }
  { const float a_ = K[19], b_ = K[23]; const bool g_ = a_ > b_; K[19] = g_ ? a_ : b_; K[23] = g_ ? b_ : a_; }
  { const float a_ = K[24], b_ = K[28]; const bool g_ = a_ > b_; K[24] = g_ ? a_ : b_; K[28] = g_ ? b_ : a_; }
  { const float a_ = K[25], b_ = K[29]; const bool g_ = a_ > b_; K[25] = g_ ? a_ : b_; K[29] = g_ ? b_ : a_; }
  { const float a_ = K[26], b_ = K[30]; const bool g_ = a_ > b_; K[26] = g_ ? a_ : b_; K[30] = g_ ? b_ : a_; }
  { const float a_ = K[27], b_ = K[31]; const bool g_ = a_ > b_; K[27] = g_ ? a_ : b_; K[31] = g_ ? b_ : a_; }
  { const float a_ = K[16], b_ = K[18]; const bool g_ = a_ > b_; K[16] = g_ ? a_ : b_; K[18] = g_ ? b_ : a_; }
  { const float a_ = K[17], b_ = K[19]; const bool g_ = a_ > b_; K[17] = g_ ? a_ : b_; K[19] = g_ ? b_ : a_; }
  { const float a_ = K[20], b_ = K[22]; const bool g_ = a_ > b_; K[20] = g_ ? a_ : b_; K[22] = g_ ? b_ : a_; }
  { const float a_ = K[21], b_ = K[23]; const bool g_ = a_ > b_; K[21] = g_ ? a_ : b_; K[23] = g_ ? b_ : a_; }
  { const float a_ = K[24], b_ = K[26]; const bool g_ = a_ > b_; K[24] = g_ ? a_ : b_; K[26] = g_ ? b_ : a_; }
  { const float a_ = K[25], b_ = K[27]; const bool g_ = a_ > b_; K[25] = g_ ? a_ : b_; K[27] = g_ ? b_ : a_; }
  { const float a_ = K[28], b_ = K[30]; const bool g_ = a_ > b_; K[28] = g_ ? a_ : b_; K[30] = g_ ? b_ : a_; }
  { const float a_ = K[29], b_ = K[31]; const bool g_ = a_ > b_; K[29] = g_ ? a_ : b_; K[31] = g_ ? b_ : a_; }
  { const float a_ = K[16], b_ = K[17]; const bool g_ = a_ > b_; K[16] = g_ ? a_ : b_; K[17] = g_ ? b_ : a_; }
  { const float a_ = K[18], b_ = K[19]; const bool g_ = a_ > b_; K[18] = g_ ? a_ : b_; K[19] = g_ ? b_ : a_; }
  { const float a_ = K[20], b_ = K[21]; const bool g_ = a_ > b_; K[20] = g_ ? a_ : b_; K[21] = g_ ? b_ : a_; }
  { const float a_ = K[22], b_ = K[23]; const bool g_ = a_ > b_; K[22] = g_ ? a_ : b_; K[23] = g_ ? b_ : a_; }
  { const float a_ = K[24], b_ = K[25]; const bool g_ = a_ > b_; K[24] = g_ ? a_ : b_; K[25] = g_ ? b_ : a_; }
  { const float a_ = K[26], b_ = K[27]; const bool g_ = a_ > b_; K[26] = g_ ? a_ : b_; K[27] = g_ ? b_ : a_; }
  { const float a_ = K[28], b_ = K[29]; const bool g_ = a_ > b_; K[28] = g_ ? a_ : b_; K[29] = g_ ? b_ : a_; }
  { const float a_ = K[30], b_ = K[31]; const bool g_ = a_ > b_; K[30] = g_ ? a_ : b_; K[31] = g_ ? b_ : a_; }
  { const float a_ = K[32], b_ = K[33]; const bool g_ = a_ > b_; K[32] = g_ ? a_ : b_; K[33] = g_ ? b_ : a_; }
  { const float a_ = K[34], b_ = K[35]; const bool g_ = a_ > b_; K[34] = g_ ? b_ : a_; K[35] = g_ ? a_ : b_; }
  { const float a_ = K[36], b_ = K[37]; const bool g_ = a_ > b_; K[36] = g_ ? a_ : b_; K[37] = g_ ? b_ : a_; }
  { const float a_ = K[38], b_ = K[39]; const bool g_ = a_ > b_; K[38] = g_ ? b_ : a_; K[39] = g_ ? a_ : b_; }
  { const float a_ = K[40], b_ = K[41]; const bool g_ = a_ > b_; K[40] = g_ ? a_ : b_; K[41] = g_ ? b_ : a_; }
  { const float a_ = K[42], b_ = K[43]; const bool g_ = a_ > b_; K[42] = g_ ? b_ : a_; K[43] = g_ ? a_ : b_; }
  { const float a_ = K[44], b_ = K[45]; const bool g_ = a_ > b_; K[44] = g_ ? a_ : b_; K[45] = g_ ? b_ : a_; }
  { const float a_ = K[46], b_ = K[47]; const bool g_ = a_ > b_; K[46] = g_ ? b_ : a_; K[47] = g_ ? a_ : b_; }
  { const float a_ = K[32], b_ = K[34]; const bool g_ = a_ > b_; K[32] = g_ ? a_ : b_; K[34] = g_ ? b_ : a_; }
  { const float a_ = K[33], b_ = K[35]; const bool g_ = a_ > b_; K[33] = g_ ? a_ : b_; K[35] = g_ ? b_ : a_; }
  { const float a_ = K[36], b_ = K[38]; const bool g_ = a_ > b_; K[36] = g_ ? b_ : a_; K[38] = g_ ? a_ : b_; }
  { const float a_ = K[37], b_ = K[39]; const bool g_ = a_ > b_; K[37] = g_ ? b_ : a_; K[39] = g_ ? a_ : b_; }
  { const float a_ = K[40], b_ = K[42]; const bool g_ = a_ > b_; K[40] = g_ ? a_ : b_; K[42] = g_ ? b_ : a_; }
  { const float a_ = K[41], b_ = K[43]; const bool g_ = a_ > b_; K[41] = g_ ? a_ : b_; K[43] = g_ ? b_ : a_; }
  { const float a_ = K[44], b_ = K[46]; const bool g_ = a_ > b_; K[44] = g_ ? b_ : a_; K[46] = g_ ? a_ : b_; }
  { const float a_ = K[45], b_ = K[47]; const bool g_ = a_ > b_; K[45] = g_ ? b_ : a_; K[47] = g_ ? a_ : b_; }
  { const float a_ = K[32], b_ = K[33]; const bool g_ = a_ > b_; K[32] = g_ ? a_ : b_; K[33] = g_ ? b_ : a_; }
  { const float a_ = K[34], b_ = K[35]; const bool g_ = a_ > b_; K[34] = g_ ? a_ : b_; K[35] = g_ ? b_ : a_; }
  { const float a_ = K[36], b_ = K[37]; const bool g_ = a_ > b_; K[36] = g_ ? b_ : a_; K[37] = g_ ? a_ : b_; }
  { const float a_ = K[38], b_ = K[39]; const bool g_ = a_ > b_; K[38] = g_ ? b_ : a_; K[39] = g_ ? a_ : b_; }
  { const float a_ = K[40], b_ = K[41]; const bool g_ = a_ > b_; K[40] = g_ ? a_ : b_; K[41] = g_ ? b_ : a_; }
  { const float a_ = K[42], b_ = K[43]; const bool g_ = a_ > b_; K[42] = g_ ? a_ : b_; K[43] = g_ ? b_ : a_; }
  { const float a_ = K[44], b_ = K[45]; const bool g_ = a_ > b_; K[44] = g_ ? b_ : a_; K[45] = g_ ? a_ : b_; }
  { const float a_ = K[46], b_ = K[47]; const bool g_ = a_ > b_; K[46] = g_ ? b_ : a_; K[47] = g_ ? a_ : b_; }
  { const float a_ = K[32], b_ = K[36]; const bool g_ = a_ > b_; K[32] = g_ ? a_ : b_; K[36] = g_ ? b_ : a_; }
  { const float a_ = K[33], b_ = K[37]; const bool g_ = a_ > b_; K[33] = g_ ? a_ : b_; K[37] = g_ ? b_ : a_; }
  { const float a_ = K[34], b_ = K[38]; const bool g_ = a_ > b_; K[34] = g_ ? a_ : b_; K[38] = g_ ? b_ : a_; }
  { const float a_ = K[35], b_ = K[39]; const bool g_ = a_ > b_; K[35] = g_ ? a_ : b_; K[39] = g_ ? b_ : a_; }
  { const float a_ = K[40], b_ = K[44]; const bool g_ = a_ > b_; K[40] = g_ ? b_ : a_; K[44] = g_ ? a_ : b_; }
  { const float a_ = K[41], b_ = K[45]; const bool g_ = a_ > b_; K[41] = g_ ? b_ : a_; K[45] = g_ ? a_ : b_; }
  { const float a_ = K[42], b_ = K[46]; const bool g_ = a_ > b_; K[42] = g_ ? b_ : a_; K[46] = g_ ? a_ : b_; }
  { const float a_ = K[43], b_ = K[47]; const bool g_ = a_ > b_; K[43] = g_ ? b_ : a_; K[47] = g_ ? a_ : b_; }
  { const float a_ = K[32], b_ = K[34]; const bool g_ = a_ > b_; K[32] = g_ ? a_ : b_; K[34] = g_ ? b_ : a_; }
  { const float a_ = K[33], b_ = K[35]; const bool g_ = a_ > b_; K[33] = g_ ? a_ : b_; K[35] = g_ ? b_ : a_; }
  { const float a_ = K[36], b_ = K[38]; const bool g_ = a_ > b_; K[36] = g_ ? a_ : b_; K[38] = g_ ? b_ : a_; }
  { const float a_ = K[37], b_ = K[39]; const bool g_ = a_ > b_; K[37] = g_ ? a_ : b_; K[39] = g_ ? b_ : a_; }
  { const float a_ = K[40], b_ = K[42]; const bool g_ = a_ > b_; K[40] = g_ ? b_ : a_; K[42] = g_ ? a_ : b_; }
  { const float a_ = K[41], b_ = K[43]; const bool g_ = a_ > b_; K[41] = g_ ? b_ : a_; K[43] = g_ ? a_ : b_; }
  { const float a_ = K[44], b_ = K[46]; const bool g_ = a_ > b_; K[44] = g_ ? b_ : a_; K[46] = g_ ? a_ : b_; }
  { const float a_ = K[45], b_ = K[47]; const bool g_ = a_ > b_; K[45] = g_ ? b_ : a_; K[47] = g_ ? a_ : b_; }
  { const float a_ = K[32], b_ = K[33]; const bool g_ = a_ > b_; K[32] = g_ ? a_ : b_; K[33] = g_ ? b_ : a_; }
  { const float a_ = K[34], b_ = K[35]; const bool g_ = a_ > b_; K[34] = g_ ? a_ : b_; K[35] = g_ ? b_ : a_; }
  { const float a_ = K[36], b_ = K[37]; const bool g_ = a_ > b_; K[36] = g_ ? a_ : b_; K[37] = g_ ? b_ : a_; }
  { const float a_ = K[38], b_ = K[39]; const bool g_ = a_ > b_; K[38] = g_ ? a_ : b_; K[39] = g_ ? b_ : a_; }
  { const float a_ = K[40], b_ = K[41]; const bool g_ = a_ > b_; K[40] = g_ ? b_ : a_; K[41] = g_ ? a_ : b_; }
  { const float a_ = K[42], b_ = K[43]; const bool g_ = a_ > b_; K[42] = g_ ? b_ : a_; K[43] = g_ ? a_ : b_; }
  { const float a_ = K[44], b_ = K[45]; const bool g_ = a_ > b_; K[44] = g_ ? b_ : a_; K[45] = g_ ? a_ : b_; }
  { const float a_ = K[46], b_ = K[47]; const bool g_ = a_ > b_; K[46] = g_ ? b_ : a_; K[47] = g_ ? a_ : b_; }
  { const float a_ = K[32], b_ = K[40]; const bool g_ = a_ > b_; K[32] = g_ ? a_ : b_; K[40] = g_ ? b_ : a_; }
  { const float a_ = K[33], b_ = K[41]; const bool g_ = a_ > b_; K[33] = g_ ? a_ : b_; K[41] = g_ ? b_ : a_; }
  { const float a_ = K[34], b_ = K[42]; const bool g_ = a_ > b_; K[34] = g_ ? a_ : b_; K[42] = g_ ? b_ : a_; }
  { const float a_ = K[35], b_ = K[43]; const bool g_ = a_ > b_; K[35] = g_ ? a_ : b_; K[43] = g_ ? b_ : a_; }
  { const float a_ = K[36], b_ = K[44]; const bool g_ = a_ > b_; K[36] = g_ ? a_ : b_; K[44] = g_ ? b_ : a_; }
  { const float a_ = K[37], b_ = K[45]; const bool g_ = a_ > b_; K[37] = g_ ? a_ : b_; K[45] = g_ ? b_ : a_; }
  { const float a_ = K[38], b_ = K[46]; const bool g_ = a_ > b_; K[38] = g_ ? a_ : b_; K[46] = g_ ? b_ : a_; }
  { const float a_ = K[39], b_ = K[47]; const bool g_ = a_ > b_; K[39] = g_ ? a_ : b_; K[47] = g_ ? b_ : a_; }
  { const float a_ = K[32], b_ = K[36]; const bool g_ = a_ > b_; K[32] = g_ ? a_ : b_; K[36] = g_ ? b_ : a_; }
  { const float a_ = K[33], b_ = K[37]; const bool g_ = a_ > b_; K[33] = g_ ? a_ : b_; K[37] = g_ ? b_ : a_; }
  { const float a_ = K[34], b_ = K[38]; const bool g_ = a_ > b_; K[34] = g_ ? a_ : b_; K[38] = g_ ? b_ : a_; }
  { const float a_ = K[35], b_ = K[39]; const bool g_ = a_ > b_; K[35] = g_ ? a_ : b_; K[39] = g_ ? b_ : a_; }
  { const float a_ = K[40], b_ = K[44]; const bool g_ = a_ > b_; K[40] = g_ ? a_ : b_; K[44] = g_ ? b_ : a_; }
  { const float a_ = K[41], b_ = K[45]; const bool g_ = a_ > b_; K[41] = g_ ? a_ : b_; K[45] = g_ ? b_ : a_; }
  { const float a_ = K[42], b_ = K[46]; const bool g_ = a_ > b_; K[42] = g_ ? a_ : b_; K[46] = g_ ? b_ : a_; }
  { const float a_ = K[43], b_ = K[47]; const bool g_ = a_ > b_; K[43] = g_ ? a_ : b_; K[47] = g_ ? b_ : a_; }
  { const float a_ = K[32], b_ = K[34]; const bool g_ = a_ > b_; K[32] = g_ ? a_ : b_; K[34] = g_ ? b_ : a_; }
  { const float a_ = K[33], b_ = K[35]; const bool g_ = a_ > b_; K[33] = g_ ? a_ : b_; K[35] = g_ ? b_ : a_; }
  { const float a_ = K[36], b_ = K[38]; const bool g_ = a_ > b_; K[36] = g_ ? a_ : b_; K[38] = g_ ? b_ : a_; }
  { const float a_ = K[37], b_ = K[39]; const bool g_ = a_ > b_; K[37] = g_ ? a_ : b_; K[39] = g_ ? b_ : a_; }
  { const float a_ = K[40], b_ = K[42]; const bool g_ = a_ > b_; K[40] = g_ ? a_ : b_; K[42] = g_ ? b_ : a_; }
  { const float a_ = K[41], b_ = K[43]; const bool g_ = a_ > b_; K[41] = g_ ? a_ : b_; K[43] = g_ ? b_ : a_; }
  { const float a_ = K[44], b_ = K[46]; const bool g_ = a_ > b_; K[44] = g_ ? a_ : b_; K[46] = g_ ? b_ : a_; }
  { const float a_ = K[45], b_ = K[47]; const bool g_ = a_ > b_; K[45] = g_ ? a_ : b_; K[47] = g_ ? b_ : a_; }
  { const float a_ = K[32], b_ = K[33]; const bool g_ = a_ > b_; K[32] = g_ ? a_ : b_; K[33] = g_ ? b_ : a_; }
  { const float a_ = K[34], b_ = K[35]; const bool g_ = a_ > b_; K[34] = g_ ? a_ : b_; K[35] = g_ ? b_ : a_; }
  { const float a_ = K[36], b_ = K[37]; const bool g_ = a_ > b_; K[36] = g_ ? a_ : b_; K[37] = g_ ? b_ : a_; }
  { const float a_ = K[38], b_ = K[39]; const bool g_ = a_ > b_; K[38] = g_ ? a_ : b_; K[39] = g_ ? b_ : a_; }
  { const float a_ = K[40], b_ = K[41]; const bool g_ = a_ > b_; K[40] = g_ ? a_ : b_; K[41] = g_ ? b_ : a_; }
  { const float a_ = K[42], b_ = K[43]; const bool g_ = a_ > b_; K[42] = g_ ? a_ : b_; K[43] = g_ ? b_ : a_; }
  { const float a_ = K[44], b_ = K[45]; const bool g_ = a_ > b_; K[44] = g_ ? a_ : b_; K[45] = g_ ? b_ : a_; }
  { const float a_ = K[46], b_ = K[47]; const bool g_ = a_ > b_; K[46] = g_ ? a_ : b_; K[47] = g_ ? b_ : a_; }
  { const float a_ = K[48], b_ = K[49]; const bool g_ = a_ > b_; K[48] = g_ ? a_ : b_; K[49] = g_ ? b_ : a_; }
  { const float a_ = K[50], b_ = K[51]; const bool g_ = a_ > b_; K[50] = g_ ? b_ : a_; K[51] = g_ ? a_ : b_; }
  { const float a_ = K[52], b_ = K[53]; const bool g_ = a_ > b_; K[52] = g_ ? a_ : b_; K[53] = g_ ? b_ : a_; }
  { const float a_ = K[54], b_ = K[55]; const bool g_ = a_ > b_; K[54] = g_ ? b_ : a_; K[55] = g_ ? a_ : b_; }
  { const float a_ = K[56], b_ = K[57]; const bool g_ = a_ > b_; K[56] = g_ ? a_ : b_; K[57] = g_ ? b_ : a_; }
  { const float a_ = K[58], b_ = K[59]; const bool g_ = a_ > b_; K[58] = g_ ? b_ : a_; K[59] = g_ ? a_ : b_; }
  { const float a_ = K[60], b_ = K[61]; const bool g_ = a_ > b_; K[60] = g_ ? a_ : b_; K[61] = g_ ? b_ : a_; }
  { const float a_ = K[62], b_ = K[63]; const bool g_ = a_ > b_; K[62] = g_ ? b_ : a_; K[63] = g_ ? a_ : b_; }
  { const float a_ = K[48], b_ = K[50]; const bool g_ = a_ > b_; K[48] = g_ ? a_ : b_; K[50] = g_ ? b_ : a_; }
  { const float a_ = K[49], b_ = K[51]; const bool g_ = a_ > b_; K[49] = g_ ? a_ : b_; K[51] = g_ ? b_ : a_; }
  { const float a_ = K[52], b_ = K[54]; const bool g_ = a_ > b_; K[52] = g_ ? b_ : a_; K[54] = g_ ? a_ : b_; }
  { const float a_ = K[53], b_ = K[55]; const bool g_ = a_ > b_; K[53] = g_ ? b_ : a_; K[55] = g_ ? a_ : b_; }
  { const float a_ = K[56], b_ = K[58]; const bool g_ = a_ > b_; K[56] = g_ ? a_ : b_; K[58] = g_ ? b_ : a_; }
  { const float a_ = K[57], b_ = K[59]; const bool g_ = a_ > b_; K[57] = g_ ? a_ : b_; K[59] = g_ ? b_ : a_; }
  { const float a_ = K[60], b_ = K[62]; const bool g_ = a_ > b_; K[60] = g_ ? b_ : a_; K[62] = g_ ? a_ : b_; }
  { const float a_ = K[61], b_ = K[63]; const bool g_ = a_ > b_; K[61] = g_ ? b_ : a_; K[63] = g_ ? a_ : b_; }
  { const float a_ = K[48], b_ = K[49]; const bool g_ = a_ > b_; K[48] = g_ ? a_ : b_; K[49] = g_ ? b_ : a_; }
  { const float a_ = K[50], b_ = K[51]; const bool g_ = a_ > b_; K[50] = g_ ? a_ : b_; K[51] = g_ ? b_ : a_; }
  { const float a_ = K[52], b_ = K[53]; const bool g_ = a_ > b_; K[52] = g_ ? b_ : a_; K[53] = g_ ? a_ : b_; }
  { const float a_ = K[54], b_ = K[55]; const bool g_ = a_ > b_; K[54] = g_ ? b_ : a_; K[55] = g_ ? a_ : b_; }
  { const float a_ = K[56], b_ = K[57]; const bool g_ = a_ > b_; K[56] = g_ ? a_ : b_; K[57] = g_ ? b_ : a_; }
  { const float a_ = K[58], b_ = K[59]; const bool g_ = a_ > b_; K[58] = g_ ? a_ : b_; K[59] = g_ ? b_ : a_; }
  { const float a_ = K[60], b_ = K[61]; const bool g_ = a_ > b_; K[60] = g_ ? b_ : a_; K[61] = g_ ? a_ : b_; }
  { const float a_ = K[62], b_ = K[63]; const bool g_ = a_ > b_; K[62] = g_ ? b_ : a_; K[63] = g_ ? a_ : b_; }
  { const float a_ = K[48], b_ = K[52]; const bool g_ = a_ > b_; K[48] = g_ ? a_ : b_; K[52] = g_ ? b_ : a_; }
  { const float a_ = K[49], b_ = K[53]; const bool g_ = a_ > b_; K[49] = g_ ? a_ : b_; K[53] = g_ ? b_ : a_; }
  { const float a_ = K[50], b_ = K[54]; const bool g_ = a_ > b_; K[50] = g_ ? a_ : b_; K[54] = g_ ? b_ : a_; }
  { const float a_ = K[51], b_ = K[55]; const bool g_ = a_ > b_; K[51] = g_ ? a_ : b_; K[55] = g_ ? b_ : a_; }
  { const float a_ = K[56], b_ = K[60]; const bool g_ = a_ > b_; K[56] = g_ ? b_ : a_; K[60] = g_ ? a_ : b_; }
  { const float a_ = K[57], b_ = K[61]; const bool g_ = a_ > b_; K[57] = g_ ? b_ : a_; K[61] = g_ ? a_ : b_; }
  { const float a_ = K[58], b_ = K[62]; const bool g_ = a_ > b_; K[58] = g_ ? b_ : a_; K[62] = g_ ? a_ : b_; }
  { const float a_ = K[59], b_ = K[63]; const bool g_ = a_ > b_; K[59] = g_ ? b_ : a_; K[63] = g_ ? a_ : b_; }
  { const float a_ = K[48], b_ = K[50]; const bool g_ = a_ > b_; K[48] = g_ ? a_ : b_; K[50] = g_ ? b_ : a_; }
  { const float a_ = K[49], b_ = K[51]; const bool g_ = a_ > b_; K[49] = g_ ? a_ : b_; K[51] = g_ ? b_ : a_; }
  { const float a_ = K[52], b_ = K[54]; const bool g_ = a_ > b_; K[52] = g_ ? a_ : b_; K[54] = g_ ? b_ : a_; }
  { const float a_ = K[53], b_ = K[55]; const bool g_ = a_ > b_; K[53] = g_ ? a_ : b_; K[55] = g_ ? b_ : a_; }
  { const float a_ = K[56], b_ = K[58]; const bool g_ = a_ > b_; K[56] = g_ ? b_ : a_; K[58] = g_ ? a_ : b_; }
  { const float a_ = K[57], b_ = K[59]; const bool g_ = a_ > b_; K[57] = g_ ? b_ : a_; K[59] = g_ ? a_ : b_; }
  { const float a_ = K[60], b_ = K[62]; const bool g_ = a_ > b_; K[60] = g_ ? b_ : a_; K[62] = g_ ? a_ : b_; }
  { const float a_ = K[61], b_ = K[63]; const bool g_ = a_ > b_; K[61] = g_ ? b_ : a_; K[63] = g_ ? a_ : b_; }
  { const float a_ = K[48], b_ = K[49]; const bool g_ = a_ > b_; K[48] = g_ ? a_ : b_; K[49] = g_ ? b_ : a_; }
  { const float a_ = K[50], b_ = K[51]; const bool g_ = a_ > b_; K[50] = g_ ? a_ : b_; K[51] = g_ ? b_ : a_; }
  { const float a_ = K[52], b_ = K[53]; const bool g_ = a_ > b_; K[52] = g_ ? a_ : b_; K[53] = g_ ? b_ : a_; }
  { const float a_ = K[54], b_ = K[55]; const bool g_ = a_ > b_; K[54] = g_ ? a_ : b_; K[55] = g_ ? b_ : a_; }
  { const float a_ = K[56], b_ = K[57]; const bool g_ = a_ > b_; K[56] = g_ ? b_ : a_; K[57] = g_ ? a_ : b_; }
  { const float a_ = K[58], b_ = K[59]; const bool g_ = a_ > b_; K[58] = g_ ? b_ : a_; K[59] = g_ ? a_ : b_; }
  { const float a_ = K[60], b_ = K[61]; const bool g_ = a_ > b_; K[60] = g_ ? b_ : a_; K[61] = g_ ? a_ : b_; }
  { const float a_ = K[62], b_ = K[63]; const bool g_ = a_ > b_; K[62] = g_ ? b_ : a_; K[63] = g_ ? a_ : b_; }
  { const float a_ = K[48], b_ = K[56]; const bool g_ = a_ > b_; K[48] = g_ ? a_ : b_; K[56] = g_ ? b_ : a_; }
  { const float a_ = K[49], b_ = K[57]; const bool g_ = a_ > b_; K[49] = g_ ? a_ : b_; K[57] = g_ ? b_ : a_; }
  { const float a_ = K[50], b_ = K[58]; const bool g_ = a_ > b_; K[50] = g_ ? a_ : b_; K[58] = g_ ? b_ : a_; }
  { const float a_ = K[51], b_ = K[59]; const bool g_ = a_ > b_; K[51] = g_ ? a_ : b_; K[59] = g_ ? b_ : a_; }
  { const float a_ = K[52], b_ = K[60]; const bool g_ = a_ > b_; K[52] = g_ ? a_ : b_; K[60] = g_ ? b_ : a_; }
  { const float a_ = K[53], b_ = K[61]; const bool g_ = a_ > b_; K[53] = g_ ? a_ : b_; K[61] = g_ ? b_ : a_; }
  { const float a_ = K[54], b_ = K[62]; const bool g_ = a_ > b_; K[54] = g_ ? a_ : b_; K[62] = g_ ? b_ : a_; }
  { const float a_ = K[55], b_ = K[63]; const bool g_ = a_ > b_; K[55] = g_ ? a_ : b_; K[63] = g_ ? b_ : a_; }
  { const float a_ = K[48], b_ = K[52]; const bool g_ = a_ > b_; K[48] = g_ ? a_ : b_; K[52] = g_ ? b_ : a_; }
  { const float a_ = K[49], b_ = K[53]; const bool g_ = a_ > b_; K[49] = g_ ? a_ : b_; K[53] = g_ ? b_ : a_; }
  { const float a_ = K[50], b_ = K[54]; const bool g_ = a_ > b_; K[50] = g_ ? a_ : b_; K[54] = g_ ? b_ : a_; }
  { const float a_ = K[51], b_ = K[55]; const bool g_ = a_ > b_; K[51] = g_ ? a_ : b_; K[55] = g_ ? b_ : a_; }
  { const float a_ = K[56], b_ = K[60]; const bool g_ = a_ > b_; K[56] = g_ ? a_ : b_; K[60] = g_ ? b_ : a_; }
  { const float a_ = K[57], b_ = K[61]; const bool g_ = a_ > b_; K[57] = g_ ? a_ : b_; K[61] = g_ ? b_ : a_; }
  { const float a_ = K[58], b_ = K[62]; const bool g_ = a_ > b_; K[58] = g_ ? a_ : b_; K[62] = g_ ? b_ : a_; }
  { const float a_ = K[59], b_ = K[63]; const bool g_ = a_ > b_; K[59] = g_ ? a_ : b_; K[63] = g_ ? b_ : a_; }
  { const float a_ = K[48], b_ = K[50]; const bool g_ = a_ > b_; K[48] = g_ ? a_ : b_; K[50] = g_ ? b_ : a_; }
  { const float a_ = K[49], b_ = K[51]; const bool g_ = a_ > b_; K[49] = g_ ? a_ : b_; K[51] = g_ ? b_ : a_; }
  { const float a_ = K[52], b_ = K[54]; const bool g_ = a_ > b_; K[52] = g_ ? a_ : b_; K[54] = g_ ? b_ : a_; }
  { const float a_ = K[53], b_ = K[55]; const bool g_ = a_ > b_; K[53] = g_ ? a_ : b_; K[55] = g_ ? b_ : a_; }
  { const float a_ = K[56], b_ = K[58]; const bool g_ = a_ > b_; K[56] = g_ ? a_ : b_; K[58] = g_ ? b_ : a_; }
  { const float a_ = K[57], b_ = K[59]; const bool g_ = a_ > b_; K[57] = g_ ? a_ : b_; K[59] = g_ ? b_ : a_; }
  { const float a_ = K[60], b_ = K[62]; const bool g_ = a_ > b_; K[60] = g_ ? a_ : b_; K[62] = g_ ? b_ : a_; }
  { const float a_ = K[61], b_ = K[63]; const bool g_ = a_ > b_; K[61] = g_ ? a_ : b_; K[63] = g_ ? b_ : a_; }
  { const float a_ = K[48], b_ = K[49]; const bool g_ = a_ > b_; K[48] = g_ ? a_ : b_; K[49] = g_ ? b_ : a_; }
  { const float a_ = K[50], b_ = K[51]; const bool g_ = a_ > b_; K[50] = g_ ? a_ : b_; K[51] = g_ ? b_ : a_; }
  { const float a_ = K[52], b_ = K[53]; const bool g_ = a_ > b_; K[52] = g_ ? a_ : b_; K[53] = g_ ? b_ : a_; }
  { const float a_ = K[54], b_ = K[55]; const bool g_ = a_ > b_; K[54] = g_ ? a_ : b_; K[55] = g_ ? b_ : a_; }
  { const float a_ = K[56], b_ = K[57]; const bool g_ = a_ > b_; K[56] = g_ ? a_ : b_; K[57] = g_ ? b_ : a_; }
  { const float a_ = K[58], b_ = K[59]; const bool g_ = a_ > b_; K[58] = g_ ? a_ : b_; K[59] = g_ ? b_ : a_; }
  { const float a_ = K[60], b_ = K[61]; const bool g_ = a_ > b_; K[60] = g_ ? a_ : b_; K[61] = g_ ? b_ : a_; }
  { const float a_ = K[62], b_ = K[63]; const bool g_ = a_ > b_; K[62] = g_ ? a_ : b_; K[63] = g_ ? b_ : a_; }
  { const float a_ = K[0], b_ = K[31]; K[0] = a_ > b_ ? a_ : b_; }
  { const float a_ = K[1], b_ = K[30]; K[1] = a_ > b_ ? a_ : b_; }
  { const float a_ = K[2], b_ = K[29]; K[2] = a_ > b_ ? a_ : b_; }
  { const float a_ = K[3], b_ = K[28]; K[3] = a_ > b_ ? a_ : b_; }
  { const float a_ = K[4], b_ = K[27]; K[4] = a_ > b_ ? a_ : b_; }
  { const float a_ = K[5], b_ = K[26]; K[5] = a_ > b_ ? a_ : b_; }
  { const float a_ = K[6], b_ = K[25]; K[6] = a_ > b_ ? a_ : b_; }
  { const float a_ = K[7], b_ = K[24]; K[7] = a_ > b_ ? a_ : b_; }
  { const float a_ = K[8], b_ = K[23]; K[8] = a_ > b_ ? a_ : b_; }
  { const float a_ = K[9], b_ = K[22]; K[9] = a_ > b_ ? a_ : b_; }
  { const float a_ = K[10], b_ = K[21]; K[10] = a_ > b_ ? a_ : b_; }
  { const float a_ = K[11], b_ = K[20]; K[11] = a_ > b_ ? a_ : b_; }
  { const float a_ = K[12], b_ = K[19]; K[12] = a_ > b_ ? a_ : b_; }
  { const float a_ = K[13], b_ = K[18]; K[13] = a_ > b_ ? a_ : b_; }
  { const float a_ = K[14], b_ = K[17]; K[14] = a_ > b_ ? a_ : b_; }
  { const float a_ = K[15], b_ = K[16]; K[15] = a_ > b_ ? a_ : b_; }
  { const float a_ = K[0], b_ = K[8]; const bool g_ = a_ > b_; K[0] = g_ ? a_ : b_; K[8] = g_ ? b_ : a_; }
  { const float a_ = K[1], b_ = K[9]; const bool g_ = a_ > b_; K[1] = g_ ? a_ : b_; K[9] = g_ ? b_ : a_; }
  { const float a_ = K[2], b_ = K[10]; const bool g_ = a_ > b_; K[2] = g_ ? a_ : b_; K[10] = g_ ? b_ : a_; }
  { const float a_ = K[3], b_ = K[11]; const bool g_ = a_ > b_; K[3] = g_ ? a_ : b_; K[11] = g_ ? b_ : a_; }
  { const float a_ = K[4], b_ = K[12]; const bool g_ = a_ > b_; K[4] = g_ ? a_ : b_; K[12] = g_ ? b_ : a_; }
  { const float a_ = K[5], b_ = K[13]; const bool g_ = a_ > b_; K[5] = g_ ? a_ : b_; K[13] = g_ ? b_ : a_; }
  { const float a_ = K[6], b_ = K[14]; const bool g_ = a_ > b_; K[6] = g_ ? a_ : b_; K[14] = g_ ? b_ : a_; }
  { const float a_ = K[7], b_ = K[15]; const bool g_ = a_ > b_; K[7] = g_ ? a_ : b_; K[15] = g_ ? b_ : a_; }
  { const float a_ = K[0], b_ = K[4]; const bool g_ = a_ > b_; K[0] = g_ ? a_ : b_; K[4] = g_ ? b_ : a_; }
  { const float a_ = K[1], b_ = K[5]; const bool g_ = a_ > b_; K[1] = g_ ? a_ : b_; K[5] = g_ ? b_ : a_; }
  { const float a_ = K[2], b_ = K[6]; const bool g_ = a_ > b_; K[2] = g_ ? a_ : b_; K[6] = g_ ? b_ : a_; }
  { const float a_ = K[3], b_ = K[7]; const bool g_ = a_ > b_; K[3] = g_ ? a_ : b_; K[7] = g_ ? b_ : a_; }
  { const float a_ = K[8], b_ = K[12]; const bool g_ = a_ > b_; K[8] = g_ ? a_ : b_; K[12] = g_ ? b_ : a_; }
  { const float a_ = K[9], b_ = K[13]; const bool g_ = a_ > b_; K[9] = g_ ? a_ : b_; K[13] = g_ ? b_ : a_; }
  { const float a_ = K[10], b_ = K[14]; const bool g_ = a_ > b_; K[10] = g_ ? a_ : b_; K[14] = g_ ? b_ : a_; }
  { const float a_ = K[11], b_ = K[15]; const bool g_ = a_ > b_; K[11] = g_ ? a_ : b_; K[15] = g_ ? b_ : a_; }
  { const float a_ = K[0], b_ = K[2]; const bool g_ = a_ > b_; K[0] = g_ ? a_ : b_; K[2] = g_ ? b_ : a_; }
  { const float a_ = K[1], b_ = K[3]; const bool g_ = a_ > b_; K[1] = g_ ? a_ : b_; K[3] = g_ ? b_ : a_; }
  { const float a_ = K[4], b_ = K[6]; const bool g_ = a_ > b_; K[4] = g_ ? a_ : b_; K[6] = g_ ? b_ : a_; }
  { const float a_ = K[5], b_ = K[7]; const bool g_ = a_ > b_; K[5] = g_ ? a_ : b_; K[7] = g_ ? b_ : a_; }
  { const float a_ = K[8], b_ = K[10]; const bool g_ = a_ > b_; K[8] = g_ ? a_ : b_; K[10] = g_ ? b_ : a_; }
  { const float a_ = K[9], b_ = K[11]; const bool g_ = a_ > b_; K[9] = g_ ? a_ : b_; K[11] = g_ ? b_ : a_; }
  { const float a_ = K[12], b_ = K[14]; const bool g_ = a_ > b_; K[12] = g_ ? a_ : b_; K[14] = g_ ? b_ : a_; }
  { const float a_ = K[13], b_ = K[15]; const bool g_ = a_ > b_; K[13] = g_ ? a_ : b_; K[15] = g_ ? b_ : a_; }
  { const float a_ = K[0], b_ = K[1]; const bool g_ = a_ > b_; K[0] = g_ ? a_ : b_; K[1] = g_ ? b_ : a_; }
  { const float a_ = K[2], b_ = K[3]; const bool g_ = a_ > b_; K[2] = g_ ? a_ : b_; K[3] = g_ ? b_ : a_; }
  { const float a_ = K[4], b_ = K[5]; const bool g_ = a_ > b_; K[4] = g_ ? a_ : b_; K[5] = g_ ? b_ : a_; }
  { const float a_ = K[6], b_ = K[7]; const bool g_ = a_ > b_; K[6] = g_ ? a_ : b_; K[7] = g_ ? b_ : a_; }
  { const float a_ = K[8], b_ = K[9]; const bool g_ = a_ > b_; K[8] = g_ ? a_ : b_; K[9] = g_ ? b_ : a_; }
  { const float a_ = K[10], b_ = K[11]; const bool g_ = a_ > b_; K[10] = g_ ? a_ : b_; K[11] = g_ ? b_ : a_; }
  { const float a_ = K[12], b_ = K[13]; const bool g_ = a_ > b_; K[12] = g_ ? a_ : b_; K[13] = g_ ? b_ : a_; }
  { const float a_ = K[14], b_ = K[15]; const bool g_ = a_ > b_; K[14] = g_ ? a_ : b_; K[15] = g_ ? b_ : a_; }
  { const float a_ = K[32], b_ = K[63]; K[32] = a_ > b_ ? a_ : b_; }
  { const float a_ = K[33], b_ = K[62]; K[33] = a_ > b_ ? a_ : b_; }
  { const float a_ = K[34], b_ = K[61]; K[34] = a_ > b_ ? a_ : b_; }
  { const float a_ = K[35], b_ = K[60]; K[35] = a_ > b_ ? a_ : b_; }
  { const float a_ = K[36], b_ = K[59]; K[36] = a_ > b_ ? a_ : b_; }
  { const float a_ = K[37], b_ = K[58]; K[37] = a_ > b_ ? a_ : b_; }
  { const float a_ = K[38], b_ = K[57]; K[38] = a_ > b_ ? a_ : b_; }
  { const float a_ = K[39], b_ = K[56]; K[39] = a_ > b_ ? a_ : b_; }
  { const float a_ = K[40], b_ = K[55]; K[40] = a_ > b_ ? a_ : b_; }
  { const float a_ = K[41], b_ = K[54]; K[41] = a_ > b_ ? a_ : b_; }
  { const float a_ = K[42], b_ = K[53]; K[42] = a_ > b_ ? a_ : b_; }
  { const float a_ = K[43], b_ = K[52]; K[43] = a_ > b_ ? a_ : b_; }
  { const float a_ = K[44], b_ = K[51]; K[44] = a_ > b_ ? a_ : b_; }
  { const float a_ = K[45], b_ = K[50]; K[45] = a_ > b_ ? a_ : b_; }
  { const float a_ = K[46], b_ = K[49]; K[46] = a_ > b_ ? a_ : b_; }
  { const float a_ = K[47], b_ = K[48]; K[47] = a_ > b_ ? a_ : b_; }
  { const float a_ = K[32], b_ = K[40]; const bool g_ = a_ > b_; K[32] = g_ ? a_ : b_; K[40] = g_ ? b_ : a_; }
  { const float a_ = K[33], b_ = K[41]; const bool g_ = a_ > b_; K[33] = g_ ? a_ : b_; K[41] = g_ ? b_ : a_; }
  { const float a_ = K[34], b_ = K[42]; const bool g_ = a_ > b_; K[34] = g_ ? a_ : b_; K[42] = g_ ? b_ : a_; }
  { const float a_ = K[35], b_ = K[43]; const bool g_ = a_ > b_; K[35] = g_ ? a_ : b_; K[43] = g_ ? b_ : a_; }
  { const float a_ = K[36], b_ = K[44]; const bool g_ = a_ > b_; K[36] = g_ ? a_ : b_; K[44] = g_ ? b_ : a_; }
  { const float a_ = K[37], b_ = K[45]; const bool g_ = a_ > b_; K[37] = g_ ? a_ : b_; K[45] = g_ ? b_ : a_; }
  { const float a_ = K[38], b_ = K[46]; const bool g_ = a_ > b_; K[38] = g_ ? a_ : b_; K[46] = g_ ? b_ : a_; }
  { const float a_ = K[39], b_ = K[47]; const bool g_ = a_ > b_; K[39] = g_ ? a_ : b_; K[47] = g_ ? b_ : a_; }
  { const float a_ = K[32], b_ = K[36]; const bool g_ = a_ > b_; K[32] = g_ ? a_ : b_; K[36] = g_ ? b_ : a_; }
  { const float a_ = K[33], b_ = K[37]; const bool g_ = a_ > b_; K[33] = g_ ? a_ : b_; K[37] = g_ ? b_ : a_; }
  { const float a_ = K[34], b_ = K[38]; const bool g_ = a_ > b_; K[34] = g_ ? a_ : b_; K[38] = g_ ? b_ : a_; }
  { const float a_ = K[35], b_ = K[39]; const bool g_ = a_ > b_; K[35] = g_ ? a_ : b_; K[39] = g_ ? b_ : a_; }
  { const float a_ = K[40], b_ = K[44]; const bool g_ = a_ > b_; K[40] = g_ ? a_ : b_; K[44] = g_ ? b_ : a_; }
  { const float a_ = K[41], b_ = K[45]; const bool g_ = a_ > b_; K[41] = g_ ? a_ : b_; K[45] = g_ ? b_ : a_; }
  { const float a_ = K[42], b_ = K[46]; const bool g_ = a_ > b_; K[42] = g_ ? a_ : b_; K[46] = g_ ? b_ : a_; }
  { const float a_ = K[43], b_ = K[47]; const bool g_ = a_ > b_; K[43] = g_ ? a_ : b_; K[47] = g_ ? b_ : a_; }
  { const float a_ = K[32], b_ = K[34]; const bool g_ = a_ > b_; K[32] = g_ ? a_ : b_; K[34] = g_ ? b_ : a_; }
  { const float a_ = K[33], b_ = K[35]; const bool g_ = a_ > b_; K[33] = g_ ? a_ : b_; K[35] = g_ ? b_ : a_; }
  { const float a_ = K[36], b_ = K[38]; const bool g_ = a_ > b_; K[36] = g_ ? a_ : b_; K[38] = g_ ? b_ : a_; }
  { const float a_ = K[37], b_ = K[39]; const bool g_ = a_ > b_; K[37] = g_ ? a_ : b_; K[39] = g_ ? b_ : a_; }
  { const float a_ = K[40], b_ = K[42]; const bool g_ = a_ > b_; K[40] = g_ ? a_ : b_; K[42] = g_ ? b_ : a_; }
  { const float a_ = K[41], b_ = K[43]; const bool g_ = a_ > b_; K[41] = g_ ? a_ : b_; K[43] = g_ ? b_ : a_; }
  { const float a_ = K[44], b_ = K[46]; const bool g_ = a_ > b_; K[44] = g_ ? a_ : b_; K[46] = g_ ? b_ : a_; }
  { const float a_ = K[45], b_ = K[47]; const bool g_ = a_ > b_; K[45] = g_ ? a_ : b_; K[47] = g_ ? b_ : a_; }
  { const float a_ = K[32], b_ = K[33]; const bool g_ = a_ > b_; K[32] = g_ ? a_ : b_; K[33] = g_ ? b_ : a_; }
  { const float a_ = K[34], b_ = K[35]; const bool g_ = a_ > b_; K[34] = g_ ? a_ : b_; K[35] = g_ ? b_ : a_; }
  { const float a_ = K[36], b_ = K[37]; const bool g_ = a_ > b_; K[36] = g_ ? a_ : b_; K[37] = g_ ? b_ : a_; }
  { const float a_ = K[38], b_ = K[39]; const bool g_ = a_ > b_; K[38] = g_ ? a_ : b_; K[39] = g_ ? b_ : a_; }
  { const float a_ = K[40], b_ = K[41]; const bool g_ = a_ > b_; K[40] = g_ ? a_ : b_; K[41] = g_ ? b_ : a_; }
  { const float a_ = K[42], b_ = K[43]; const bool g_ = a_ > b_; K[42] = g_ ? a_ : b_; K[43] = g_ ? b_ : a_; }
  { const float a_ = K[44], b_ = K[45]; const bool g_ = a_ > b_; K[44] = g_ ? a_ : b_; K[45] = g_ ? b_ : a_; }
  { const float a_ = K[46], b_ = K[47]; const bool g_ = a_ > b_; K[46] = g_ ? a_ : b_; K[47] = g_ ? b_ : a_; }
  { const float a_ = K[0], b_ = K[47]; K[0] = a_ > b_ ? a_ : b_; }
  { const float a_ = K[1], b_ = K[46]; K[1] = a_ > b_ ? a_ : b_; }
  { const float a_ = K[2], b_ = K[45]; K[2] = a_ > b_ ? a_ : b_; }
  { const float a_ = K[3], b_ = K[44]; K[3] = a_ > b_ ? a_ : b_; }
  { const float a_ = K[4], b_ = K[43]; K[4] = a_ > b_ ? a_ : b_; }
  { const float a_ = K[5], b_ = K[42]; K[5] = a_ > b_ ? a_ : b_; }
  { const float a_ = K[6], b_ = K[41]; K[6] = a_ > b_ ? a_ : b_; }
  { const float a_ = K[7], b_ = K[40]; K[7] = a_ > b_ ? a_ : b_; }
  { const float a_ = K[8], b_ = K[39]; K[8] = a_ > b_ ? a_ : b_; }
  { const float a_ = K[9], b_ = K[38]; K[9] = a_ > b_ ? a_ : b_; }
  { const float a_ = K[10], b_ = K[37]; K[10] = a_ > b_ ? a_ : b_; }
  { const float a_ = K[11], b_ = K[36]; K[11] = a_ > b_ ? a_ : b_; }
  { const float a_ = K[12], b_ = K[35]; K[12] = a_ > b_ ? a_ : b_; }
  { const float a_ = K[13], b_ = K[34]; K[13] = a_ > b_ ? a_ : b_; }
  { const float a_ = K[14], b_ = K[33]; K[14] = a_ > b_ ? a_ : b_; }
  { const float a_ = K[15], b_ = K[32]; K[15] = a_ > b_ ? a_ : b_; }
  { const float a_ = K[0], b_ = K[8]; const bool g_ = a_ > b_; K[0] = g_ ? a_ : b_; K[8] = g_ ? b_ : a_; }
  { const float a_ = K[1], b_ = K[9]; const bool g_ = a_ > b_; K[1] = g_ ? a_ : b_; K[9] = g_ ? b_ : a_; }
  { const float a_ = K[2], b_ = K[10]; const bool g_ = a_ > b_; K[2] = g_ ? a_ : b_; K[10] = g_ ? b_ : a_; }
  { const float a_ = K[3], b_ = K[11]; const bool g_ = a_ > b_; K[3] = g_ ? a_ : b_; K[11] = g_ ? b_ : a_; }
  { const float a_ = K[4], b_ = K[12]; const bool g_ = a_ > b_; K[4] = g_ ? a_ : b_; K[12] = g_ ? b_ : a_; }
  { const float a_ = K[5], b_ = K[13]; const bool g_ = a_ > b_; K[5] = g_ ? a_ : b_; K[13] = g_ ? b_ : a_; }
  { const float a_ = K[6], b_ = K[14]; const bool g_ = a_ > b_; K[6] = g_ ? a_ : b_; K[14] = g_ ? b_ : a_; }
  { const float a_ = K[7], b_ = K[15]; const bool g_ = a_ > b_; K[7] = g_ ? a_ : b_; K[15] = g_ ? b_ : a_; }
  { const float a_ = K[0], b_ = K[4]; const bool g_ = a_ > b_; K[0] = g_ ? a_ : b_; K[4] = g_ ? b_ : a_; }
  { const float a_ = K[1], b_ = K[5]; const bool g_ = a_ > b_; K[1] = g_ ? a_ : b_; K[5] = g_ ? b_ : a_; }
  { const float a_ = K[2], b_ = K[6]; const bool g_ = a_ > b_; K[2] = g_ ? a_ : b_; K[6] = g_ ? b_ : a_; }
  { const float a_ = K[3], b_ = K[7]; const bool g_ = a_ > b_; K[3] = g_ ? a_ : b_; K[7] = g_ ? b_ : a_; }
  { const float a_ = K[8], b_ = K[12]; const bool g_ = a_ > b_; K[8] = g_ ? a_ : b_; K[12] = g_ ? b_ : a_; }
  { const float a_ = K[9], b_ = K[13]; const bool g_ = a_ > b_; K[9] = g_ ? a_ : b_; K[13] = g_ ? b_ : a_; }
  { const float a_ = K[10], b_ = K[14]; const bool g_ = a_ > b_; K[10] = g_ ? a_ : b_; K[14] = g_ ? b_ : a_; }
  { const float a_ = K[11], b_ = K[15]; const bool g_ = a_ > b_; K[11] = g_ ? a_ : b_; K[15] = g_ ? b_ : a_; }
  { const float a_ = K[0], b_ = K[2]; const bool g_ = a_ > b_; K[0] = g_ ? a_ : b_; K[2] = g_ ? b_ : a_; }
  { const float a_ = K[1], b_ = K[3]; const bool g_ = a_ > b_; K[1] = g_ ? a_ : b_; K[3] = g_ ? b_ : a_; }
  { const float a_ = K[4], b_ = K[6]; const bool g_ = a_ > b_; K[4] = g_ ? a_ : b_; K[6] = g_ ? b_ : a_; }
  { const float a_ = K[5], b_ = K[7]; const bool g_ = a_ > b_; K[5] = g_ ? a_ : b_; K[7] = g_ ? b_ : a_; }
  { const float a_ = K[8], b_ = K[10]; const bool g_ = a_ > b_; K[8] = g_ ? a_ : b_; K[10] = g_ ? b_ : a_; }
  { const float a_ = K[9], b_ = K[11]; const bool g_ = a_ > b_; K[9] = g_ ? a_ : b_; K[11] = g_ ? b_ : a_; }
  { const float a_ = K[12], b_ = K[14]; const bool g_ = a_ > b_; K[12] = g_ ? a_ : b_; K[14] = g_ ? b_ : a_; }
  { const float a_ = K[13], b_ = K[15]; const bool g_ = a_ > b_; K[13] = g_ ? a_ : b_; K[15] = g_ ? b_ : a_; }
  { const float a_ = K[0], b_ = K[1]; const bool g_ = a_ > b_; K[0] = g_ ? a_ : b_; K[1] = g_ ? b_ : a_; }
  { const float a_ = K[2], b_ = K[3]; const bool g_ = a_ > b_; K[2] = g_ ? a_ : b_; K[3] = g_ ? b_ : a_; }
  { const float a_ = K[4], b_ = K[5]; const bool g_ = a_ > b_; K[4] = g_ ? a_ : b_; K[5] = g_ ? b_ : a_; }
  { const float a_ = K[6], b_ = K[7]; const bool g_ = a_ > b_; K[6] = g_ ? a_ : b_; K[7] = g_ ? b_ : a_; }
  { const float a_ = K[8], b_ = K[9]; const bool g_ = a_ > b_; K[8] = g_ ? a_ : b_; K[9] = g_ ? b_ : a_; }
  { const float a_ = K[10], b_ = K[11]; const bool g_ = a_ > b_; K[10] = g_ ? a_ : b_; K[11] = g_ ? b_ : a_; }
  { const float a_ = K[12], b_ = K[13]; const bool g_ = a_ > b_; K[12] = g_ ? a_ : b_; K[13] = g_ ? b_ : a_; }
  { const float a_ = K[14], b_ = K[15]; const bool g_ = a_ > b_; K[14] = g_ ? a_ : b_; K[15] = g_ ? b_ : a_; }
}
__device__ __forceinline__ void merge_top16(float (&T)[16], const float (&P)[16]) {
  { const float a_ = T[0], b_ = P[15]; T[0] = a_ > b_ ? a_ : b_; }
  { const float a_ = T[1], b_ = P[14]; T[1] = a_ > b_ ? a_ : b_; }
  { const float a_ = T[2], b_ = P[13]; T[2] = a_ > b_ ? a_ : b_; }
  { const float a_ = T[3], b_ = P[12]; T[3] = a_ > b_ ? a_ : b_; }
  { const float a_ = T[4], b_ = P[11]; T[4] = a_ > b_ ? a_ : b_; }
  { const float a_ = T[5], b_ = P[10]; T[5] = a_ > b_ ? a_ : b_; }
  { const float a_ = T[6], b_ = P[9]; T[6] = a_ > b_ ? a_ : b_; }
  { const float a_ = T[7], b_ = P[8]; T[7] = a_ > b_ ? a_ : b_; }
  { const float a_ = T[8], b_ = P[7]; T[8] = a_ > b_ ? a_ : b_; }
  { const float a_ = T[9], b_ = P[6]; T[9] = a_ > b_ ? a_ : b_; }
  { const float a_ = T[10], b_ = P[5]; T[10] = a_ > b_ ? a_ : b_; }
  { const float a_ = T[11], b_ = P[4]; T[11] = a_ > b_ ? a_ : b_; }
  { const float a_ = T[12], b_ = P[3]; T[12] = a_ > b_ ? a_ : b_; }
  { const float a_ = T[13], b_ = P[2]; T[13] = a_ > b_ ? a_ : b_; }
  { const float a_ = T[14], b_ = P[1]; T[14] = a_ > b_ ? a_ : b_; }
  { const float a_ = T[15], b_ = P[0]; T[15] = a_ > b_ ? a_ : b_; }
  { const float a_ = T[0], b_ = T[8]; const bool g_ = a_ > b_; T[0] = g_ ? a_ : b_; T[8] = g_ ? b_ : a_; }
  { const float a_ = T[1], b_ = T[9]; const bool g_ = a_ > b_; T[1] = g_ ? a_ : b_; T[9] = g_ ? b_ : a_; }
  { const float a_ = T[2], b_ = T[10]; const bool g_ = a_ > b_; T[2] = g_ ? a_ : b_; T[10] = g_ ? b_ : a_; }
  { const float a_ = T[3], b_ = T[11]; const bool g_ = a_ > b_; T[3] = g_ ? a_ : b_; T[11] = g_ ? b_ : a_; }
  { const float a_ = T[4], b_ = T[12]; const bool g_ = a_ > b_; T[4] = g_ ? a_ : b_; T[12] = g_ ? b_ : a_; }
  { const float a_ = T[5], b_ = T[13]; const bool g_ = a_ > b_; T[5] = g_ ? a_ : b_; T[13] = g_ ? b_ : a_; }
  { const float a_ = T[6], b_ = T[14]; const bool g_ = a_ > b_; T[6] = g_ ? a_ : b_; T[14] = g_ ? b_ : a_; }
  { const float a_ = T[7], b_ = T[15]; const bool g_ = a_ > b_; T[7] = g_ ? a_ : b_; T[15] = g_ ? b_ : a_; }
  { const float a_ = T[0], b_ = T[4]; const bool g_ = a_ > b_; T[0] = g_ ? a_ : b_; T[4] = g_ ? b_ : a_; }
  { const float a_ = T[1], b_ = T[5]; const bool g_ = a_ > b_; T[1] = g_ ? a_ : b_; T[5] = g_ ? b_ : a_; }
  { const float a_ = T[2], b_ = T[6]; const bool g_ = a_ > b_; T[2] = g_ ? a_ : b_; T[6] = g_ ? b_ : a_; }
  { const float a_ = T[3], b_ = T[7]; const bool g_ = a_ > b_; T[3] = g_ ? a_ : b_; T[7] = g_ ? b_ : a_; }
  { const float a_ = T[8], b_ = T[12]; const bool g_ = a_ > b_; T[8] = g_ ? a_ : b_; T[12] = g_ ? b_ : a_; }
  { const float a_ = T[9], b_ = T[13]; const bool g_ = a_ > b_; T[9] = g_ ? a_ : b_; T[13] = g_ ? b_ : a_; }
  { const float a_ = T[10], b_ = T[14]; const bool g_ = a_ > b_; T[10] = g_ ? a_ : b_; T[14] = g_ ? b_ : a_; }
  { const float a_ = T[11], b_ = T[15]; const bool g_ = a_ > b_; T[11] = g_ ? a_ : b_; T[15] = g_ ? b_ : a_; }
  { const float a_ = T[0], b_ = T[2]; const bool g_ = a_ > b_; T[0] = g_ ? a_ : b_; T[2] = g_ ? b_ : a_; }
  { const float a_ = T[1], b_ = T[3]; const bool g_ = a_ > b_; T[1] = g_ ? a_ : b_; T[3] = g_ ? b_ : a_; }
  { const float a_ = T[4], b_ = T[6]; const bool g_ = a_ > b_; T[4] = g_ ? a_ : b_; T[6] = g_ ? b_ : a_; }
  { const float a_ = T[5], b_ = T[7]; const bool g_ = a_ > b_; T[5] = g_ ? a_ : b_; T[7] = g_ ? b_ : a_; }
  { const float a_ = T[8], b_ = T[10]; const bool g_ = a_ > b_; T[8] = g_ ? a_ : b_; T[10] = g_ ? b_ : a_; }
  { const float a_ = T[9], b_ = T[11]; const bool g_ = a_ > b_; T[9] = g_ ? a_ : b_; T[11] = g_ ? b_ : a_; }
  { const float a_ = T[12], b_ = T[14]; const bool g_ = a_ > b_; T[12] = g_ ? a_ : b_; T[14] = g_ ? b_ : a_; }
  { const float a_ = T[13], b_ = T[15]; const bool g_ = a_ > b_; T[13] = g_ ? a_ : b_; T[15] = g_ ? b_ : a_; }
  { const float a_ = T[0], b_ = T[1]; const bool g_ = a_ > b_; T[0] = g_ ? a_ : b_; T[1] = g_ ? b_ : a_; }
  { const float a_ = T[2], b_ = T[3]; const bool g_ = a_ > b_; T[2] = g_ ? a_ : b_; T[3] = g_ ? b_ : a_; }
  { const float a_ = T[4], b_ = T[5]; const bool g_ = a_ > b_; T[4] = g_ ? a_ : b_; T[5] = g_ ? b_ : a_; }
  { const float a_ = T[6], b_ = T[7]; const bool g_ = a_ > b_; T[6] = g_ ? a_ : b_; T[7] = g_ ? b_ : a_; }
  { const float a_ = T[8], b_ = T[9]; const bool g_ = a_ > b_; T[8] = g_ ? a_ : b_; T[9] = g_ ? b_ : a_; }
  { const float a_ = T[10], b_ = T[11]; const bool g_ = a_ > b_; T[10] = g_ ? a_ : b_; T[11] = g_ ? b_ : a_; }
  { const float a_ = T[12], b_ = T[13]; const bool g_ = a_ > b_; T[12] = g_ ? a_ : b_; T[13] = g_ ? b_ : a_; }
  { const float a_ = T[14], b_ = T[15]; const bool g_ = a_ > b_; T[14] = g_ ? a_ : b_; T[15] = g_ ? b_ : a_; }
}

__device__ __forceinline__ void peer_topk(const int wave_s, const bf16* pq, const bf16* skb, int* ids, float* gates, LAS float* smem) {
  const int tid_ = opaque_tid(wave_s);
  const int lane = tid_ & 63, n = lane & 31, hh = lane >> 5, wave = tid_ >> 6;
  const int gw = blockIdx.x * NWAVES + wave;
  const int nw = gridDim.x * NWAVES;
  LAS float* lk = smem + wave * 2048;
  for (int it = gw; it < 512 * 8; it += nw) {
    const int h = it & 7, tok0 = (it >> 3) * 32;
#pragma unroll 1
    for (int half = 0; half < 2; half++) {
      bf16x8_t qf[8];
      {
        const bf16* qrow = pq + (size_t)(tok0 + n) * 2048 + h * 256 + half * 128 + 8 * hh;
#pragma unroll
        for (int ks = 0; ks < 8; ks++) qf[ks] = *(const bf16x8_t*)(qrow + 16 * ks);
      }
      float K[64];
#pragma unroll
      for (int kt = 0; kt < 4; kt++) {
        const bf16* krow = skb + ((size_t)((h * 2 + half) * 128 + kt * 32 + n)) * 128 + 8 * hh;
        f32x16_t acc;
#pragma unroll
        for (int r = 0; r < 16; r++) acc[r] = 0.f;
#pragma unroll
        for (int kq = 0; kq < 2; kq++) {
          bf16x8_t kf[4];
#pragma unroll
          for (int i = 0; i < 4; i++) kf[i] = *(const bf16x8_t*)(krow + 16 * (kq * 4 + i));
          MFMA_PAD();
#pragma unroll
          for (int i = 0; i < 4; i++) acc = __builtin_amdgcn_mfma_f32_32x32x16_bf16(kf[i], qf[kq * 4 + i], acc, 0, 0, 0);
          MFMA_PAD();
        }
#pragma unroll
        for (int i = 0; i < 16; i++) K[kt * 16 + i] = pack_key<0x7Fu>(acc[i], (unsigned)(kt * 32 + (i & 3) + 8 * (i >> 2) + 4 * hh));
      }
      __builtin_amdgcn_sched_barrier(0);
      top16_of_64(K);
      __builtin_amdgcn_sched_barrier(0);
      float T[16], P[16];
#pragma unroll
      for (int i = 0; i < 16; i++) { T[i] = K[i]; P[i] = __shfl_xor(K[i], 32, 64); }
      merge_top16(T, P);
#pragma unroll
      for (int i = 0; i < 16; i++) lk[(half * 16 + i) * 64 + lane] = T[i];
      __builtin_amdgcn_sched_barrier(0);
    }
    float f0[16], f1[16];
    int ti0[16], ti1[16];
#pragma unroll
    for (int i = 0; i < 16; i++) {
      const float k0 = lk[i * 64 + lane], k1 = lk[(16 + i) * 64 + lane];
      f0[i] = key_val<0x7Fu>(k0); ti0[i] = (int)key_idx<0x7Fu>(k0);
      f1[i] = key_val<0x7Fu>(k1); ti1[i] = (int)key_idx<0x7Fu>(k1);
    }
    float K[64];
    {
    K[0] = pack_key<0xFFu>(f0[0] + f1[0], 0u);
    K[1] = pack_key<0xFFu>(f0[0] + f1[1], 1u);
    K[2] = pack_key<0xFFu>(f0[0] + f1[2], 2u);
    K[3] = pack_key<0xFFu>(f0[0] + f1[3], 3u);
    K[4] = pack_key<0xFFu>(f0[0] + f1[4], 4u);
    K[5] = pack_key<0xFFu>(f0[0] + f1[5], 5u);
    K[6] = pack_key<0xFFu>(f0[0] + f1[6], 6u);
    K[7] = pack_key<0xFFu>(f0[0] + f1[7], 7u);
    K[8] = pack_key<0xFFu>(f0[0] + f1[8], 8u);
    K[9] = pack_key<0xFFu>(f0[0] + f1[9], 9u);
    K[10] = pack_key<0xFFu>(f0[0] + f1[10], 10u);
    K[11] = pack_key<0xFFu>(f0[0] + f1[11], 11u);
    K[12] = pack_key<0xFFu>(f0[0] + f1[12], 12u);
    K[13] = pack_key<0xFFu>(f0[0] + f1[13], 13u);
    K[14] = pack_key<0xFFu>(f0[0] + f1[14], 14u);
    K[15] = pack_key<0xFFu>(f0[0] + f1[15], 15u);
    K[16] = pack_key<0xFFu>(f0[1] + f1[0], 16u);
    K[17] = pack_key<0xFFu>(f0[1] + f1[1], 17u);
    K[18] = pack_key<0xFFu>(f0[1] + f1[2], 18u);
    K[19] = pack_key<0xFFu>(f0[1] + f1[3], 19u);
    K[20] = pack_key<0xFFu>(f0[1] + f1[4], 20u);
    K[21] = pack_key<0xFFu>(f0[1] + f1[5], 21u);
    K[22] = pack_key<0xFFu>(f0[1] + f1[6], 22u);
    K[23] = pack_key<0xFFu>(f0[1] + f1[7], 23u);
    K[24] = pack_key<0xFFu>(f0[2] + f1[0], 32u);
    K[25] = pack_key<0xFFu>(f0[2] + f1[1], 33u);
    K[26] = pack_key<0xFFu>(f0[2] + f1[2], 34u);
    K[27] = pack_key<0xFFu>(f0[2] + f1[3], 35u);
    K[28] = pack_key<0xFFu>(f0[2] + f1[4], 36u);
    K[29] = pack_key<0xFFu>(f0[3] + f1[0], 48u);
    K[30] = pack_key<0xFFu>(f0[3] + f1[1], 49u);
    K[31] = pack_key<0xFFu>(f0[3] + f1[2], 50u);
    K[32] = pack_key<0xFFu>(f0[3] + f1[3], 51u);
    K[33] = pack_key<0xFFu>(f0[4] + f1[0], 64u);
    K[34] = pack_key<0xFFu>(f0[4] + f1[1], 65u);
    K[35] = pack_key<0xFFu>(f0[4] + f1[2], 66u);
    K[36] = pack_key<0xFFu>(f0[5] + f1[0], 80u);
    K[37] = pack_key<0xFFu>(f0[5] + f1[1], 81u);
    K[38] = pack_key<0xFFu>(f0[6] + f1[0], 96u);
    K[39] = pack_key<0xFFu>(f0[6] + f1[1], 97u);
    K[40] = pack_key<0xFFu>(f0[7] + f1[0], 112u);
    K[41] = pack_key<0xFFu>(f0[7] + f1[1], 113u);
    K[42] = pack_key<0xFFu>(f0[8] + f1[0], 128u);
    K[43] = pack_key<0xFFu>(f0[9] + f1[0], 144u);
    K[44] = pack_key<0xFFu>(f0[10] + f1[0], 160u);
    K[45] = pack_key<0xFFu>(f0[11] + f1[0], 176u);
    K[46] = pack_key<0xFFu>(f0[12] + f1[0], 192u);
    K[47] = pack_key<0xFFu>(f0[13] + f1[0], 208u);
    K[48] = pack_key<0xFFu>(f0[14] + f1[0], 224u);
    K[49] = pack_key<0xFFu>(f0[15] + f1[0], 240u);
    K[50] = -3.0e38f;
    K[51] = -3.0e38f;
    K[52] = -3.0e38f;
    K[53] = -3.0e38f;
    K[54] = -3.0e38f;
    K[55] = -3.0e38f;
    K[56] = -3.0e38f;
    K[57] = -3.0e38f;
    K[58] = -3.0e38f;
    K[59] = -3.0e38f;
    K[60] = -3.0e38f;
    K[61] = -3.0e38f;
    K[62] = -3.0e38f;
    K[63] = -3.0e38f;
    }
    __builtin_amdgcn_sched_barrier(0);
    top16_of_64(K);
    __builtin_amdgcn_sched_barrier(0);
    float bv[16];
    int be[16];
#pragma unroll
    for (int r = 0; r < 16; r++) {
      const int flat = (int)key_idx<0xFFu>(K[r]);
      const int a = flat >> 4, b = flat & 15;
      int i0 = 0, i1 = 0;
#pragma unroll
      for (int i = 0; i < 16; i++) { i0 = (a == i) ? ti0[i] : i0; i1 = (b == i) ? ti1[i] : i1; }
      be[r] = i0 * 128 + i1;
      bv[r] = key_val<0xFFu>(K[r]);
    }
    const float b0 = bv[0];
    float ge[16];
    float gsum = 0.f;
#pragma unroll
    for (int r = 0; r < 16; r++) { ge[r] = __expf(bv[r] - b0); gsum += ge[r]; }
    const float ginv = 1.0f / gsum;
    if (hh == 0) {
      int* ip = ids + (size_t)(tok0 + n) * 128 + h * 16;
      float* gp = gates + (size_t)(tok0 + n) * 128 + h * 16;
#pragma unroll
      for (int r4 = 0; r4 < 4; r4++) {
        *(int4*)(ip + 4 * r4) = make_int4(be[4 * r4], be[4 * r4 + 1], be[4 * r4 + 2], be[4 * r4 + 3]);
        *(float4*)(gp + 4 * r4) = make_float4(ge[4 * r4] * ginv, ge[4 * r4 + 1] * ginv, ge[4 * r4 + 2] * ginv, ge[4 * r4 + 3] * ginv);
      }
    }
  }
}

typedef _Float16 f16x2_t __attribute__((ext_vector_type(2)));
__device__ __forceinline__ unsigned e4m3x2_to_f16x2(unsigned w, unsigned sel) {
  return __builtin_amdgcn_perm(w, w, sel);
}
__device__ __forceinline__ float dot2h(unsigned a, unsigned b, float c) {
  return __builtin_amdgcn_fdot2(__builtin_bit_cast(f16x2_t, a), __builtin_bit_cast(f16x2_t, b), c, false);
}
__device__ __forceinline__ unsigned pack_h2(float lo, float hi) {
  f16x2_t v; v.x = (_Float16)lo; v.y = (_Float16)hi;
  return __builtin_bit_cast(unsigned, v);
}
template <bool FINAL>
__device__ __forceinline__ void peer_gather(const int wave_s, bf16* xn, const float* rst, const unsigned char* ub, const unsigned char* vb, const float* vsc, const float* usc,
                                            const int* ids, const float* gates, float* xw, const float* gnext, float* outp) {
  const int tid_ = opaque_tid(wave_s);
  const int lane = tid_ & 63;
  const int gw = blockIdx.x * NWAVES + (tid_ >> 6);
  const int nw = gridDim.x * NWAVES;
  const int el = ((lane >> 5) & 1) * 4 + ((lane >> 4) & 1) * 2 + ((lane >> 3) & 1);
  int idv = 0;
  uint2 uu[8];
  uint2 vv[8];
  if (gw < NT) {
    idv = ids[(size_t)gw * 128 + (lane & 7)];
#pragma unroll
    for (int e = 0; e < 8; e++) {
      const int id = __builtin_amdgcn_readlane(idv, e);
      uu[e] = *(const uint2*)(ub + (size_t)id * 512 + lane * 8);
      vv[e] = *(const uint2*)(vb + (size_t)id * 512 + lane * 8);
    }
  }
  for (int tok = gw; tok < NT; tok += nw) {
    const int tokn = (tok + nw < NT) ? tok + nw : tok;
    int xqh[2] = {0, 0}, xql[2] = {0, 0};
    float xstep, qhalf;
    {
      const uint4 a = *(const uint4*)(xn + (size_t)tok * DM + lane * 16);
      const uint4 b = *(const uint4*)(xn + (size_t)tok * DM + lane * 16 + 8);
      const unsigned xw_[8] = {a.x, a.y, a.z, a.w, b.x, b.y, b.z, b.w};
      const float4* sp = (const float4*)(rst + (size_t)tok * 16);
      const float4 s0 = sp[0], s1 = sp[1], s2 = sp[2], s3 = sp[3];
      const float xs = rsqrtf((((s0.x + s0.y) + (s0.z + s0.w)) + ((s1.x + s1.y) + (s1.z + s1.w)) + ((s2.x + s2.y) + (s2.z + s2.w)) + ((s3.x + s3.y) + (s3.z + s3.w))) * (1.0f / 1024.f) + EPSF);
      float xf[16];
      float am = 0.f;
#pragma unroll
      for (int k = 0; k < 8; k++) { xf[2 * k] = bf_lo(xw_[k]) * xs; xf[2 * k + 1] = bf_hi(xw_[k]) * xs; am = fmaxf(am, fmaxf(fabsf(xf[2 * k]), fabsf(xf[2 * k + 1]))); }
#pragma unroll
      for (int o = 32; o >= 1; o >>= 1) am = fmaxf(am, __shfl_xor(am, o, 64));
      xstep = am * (1.0f / 119.f);
      const float inv = am > 0.f ? 119.f / am : 0.f;
      int qs = 0;
#pragma unroll
      for (int i = 0; i < 16; i++) {
        const int q = (int)rintf(xf[i] * inv);
        const int t = q + 8;
        xqh[i >> 3] |= ((t >> 4) & 15) << (4 * (i & 7));
        xql[i >> 3] |= (((t & 15) - 8) & 15) << (4 * (i & 7));
        qs += q;
      }
      qhalf = 0.5f * wsum((float)qs);
    }
    f16x2_t acc2[8];
#pragma unroll
    for (int i = 0; i < 8; i++) acc2[i] = (f16x2_t){(_Float16)0.f, (_Float16)0.f};
#pragma unroll 1
    for (int g = 0; g < 16; g++) {
      const int ide = __builtin_amdgcn_ds_bpermute(el << 2, idv);
      const float2 sc2 = ((const float2*)vsc)[ide];
      const float gv = gates[(size_t)tok * 128 + g * 8 + el] * sc2.x;
      const float us = sc2.y * xstep;
      const int idn = ids[(size_t)(g < 15 ? tok : tokn) * 128 + ((g + 1) & 15) * 8 + (lane & 7)];
      float d[8];
#pragma unroll
      for (int e = 0; e < 8; e++) {
        int sh = __builtin_amdgcn_sdot8((int)uu[e].x, xqh[0], 0, false);
        sh = __builtin_amdgcn_sdot8((int)uu[e].y, xqh[1], sh, false);
        int sl = __builtin_amdgcn_sdot8((int)uu[e].x, xql[0], 0, false);
        sl = __builtin_amdgcn_sdot8((int)uu[e].y, xql[1], sl, false);
        d[e] = (float)((sh << 4) + sl);
      }
#pragma unroll
      for (int e = 0; e < 8; e++) {
        const int id = __builtin_amdgcn_readlane(idn, e);
        uu[e] = *(const uint2*)(ub + (size_t)id * 512 + lane * 8);
      }
      float d4[4], d2[2], d1;
      {
        const bool hi = (lane & 32) != 0;
#pragma unroll
        for (int i = 0; i < 4; i++) { const float send = hi ? d[i] : d[i + 4]; const float keep = hi ? d[i + 4] : d[i]; d4[i] = keep + __shfl_xor(send, 32, 64); }
      }
      {
        const bool hi = (lane & 16) != 0;
#pragma unroll
        for (int i = 0; i < 2; i++) { const float send = hi ? d4[i] : d4[i + 2]; const float keep = hi ? d4[i + 2] : d4[i]; d2[i] = keep + __shfl_xor(send, 16, 64); }
      }
      {
        const bool hi = (lane & 8) != 0;
        const float send = hi ? d2[0] : d2[1];
        const float keep = hi ? d2[1] : d2[0];
        d1 = keep + __shfl_xor(send, 8, 64);
      }
      d1 += __shfl_xor(d1, 4, 64);
      d1 += __shfl_xor(d1, 2, 64);
      d1 += __shfl_xor(d1, 1, 64);
      const float wl = gv * gelu_tanh((d1 + qhalf) * us);
#pragma unroll
      for (int e = 0; e < 8; e++) {
        const float w = __builtin_bit_cast(float, __builtin_amdgcn_readlane(__builtin_bit_cast(int, wl), ((e >> 2) & 1) * 32 + ((e >> 1) & 1) * 16 + (e & 1) * 8));
        const f16x2_t w2 = __builtin_bit_cast(f16x2_t, pack_h2(w, w));
        const unsigned vw[2] = {vv[e].x, vv[e].y};
#pragma unroll
        for (int k = 0; k < 2; k++) {
          const unsigned w4 = vw[k];
          const unsigned le = __builtin_amdgcn_perm(V4_LUT_HI, V4_LUT_LO, w4 & 0x07070707u);
          const unsigned lo = __builtin_amdgcn_perm(V4_LUT_HI, V4_LUT_LO, (w4 >> 4) & 0x07070707u);
          const unsigned ee = ((w4 << 4) & 0x80808080u) | le;
          const unsigned eo = (w4 & 0x80808080u) | lo;
          const unsigned p01 = __builtin_amdgcn_perm(eo, ee, 0x040c000cu), p23 = __builtin_amdgcn_perm(eo, ee, 0x050c010cu);
          const unsigned p45 = __builtin_amdgcn_perm(eo, ee, 0x060c020cu), p67 = __builtin_amdgcn_perm(eo, ee, 0x070c030cu);
          acc2[4 * k + 0] = __builtin_elementwise_fma(__builtin_bit_cast(f16x2_t, p01), w2, acc2[4 * k + 0]);
          acc2[4 * k + 1] = __builtin_elementwise_fma(__builtin_bit_cast(f16x2_t, p23), w2, acc2[4 * k + 1]);
          acc2[4 * k + 2] = __builtin_elementwise_fma(__builtin_bit_cast(f16x2_t, p45), w2, acc2[4 * k + 2]);
          acc2[4 * k + 3] = __builtin_elementwise_fma(__builtin_bit_cast(f16x2_t, p67), w2, acc2[4 * k + 3]);
        }
      }
#pragma unroll
      for (int e = 0; e < 8; e++) {
        const int id = __builtin_amdgcn_readlane(idn, e);
        vv[e] = *(const uint2*)(vb + (size_t)id * 512 + lane * 8);
      }
      idv = idn;
    }
    float acc[16];
#pragma unroll
    for (int i = 0; i < 8; i++) { acc[2 * i] = (float)acc2[i].x; acc[2 * i + 1] = (float)acc2[i].y; }
    float* xr = xw + (size_t)tok * DM + lane * 16;
    float xv[16];
    float ssq = 0.f;
#pragma unroll
    for (int c = 0; c < 4; c++) {
      float4 a0 = *(float4*)(xr + c * 4);
      a0.x += acc[c * 4 + 0]; a0.y += acc[c * 4 + 1]; a0.z += acc[c * 4 + 2]; a0.w += acc[c * 4 + 3];
      if (!FINAL) *(float4*)(xr + c * 4) = a0;
      xv[c * 4 + 0] = a0.x; xv[c * 4 + 1] = a0.y; xv[c * 4 + 2] = a0.z; xv[c * 4 + 3] = a0.w;
      ssq += a0.x * a0.x + a0.y * a0.y + a0.z * a0.z + a0.w * a0.w;
    }
    ssq = wsum(ssq);
    const float rstd = rsqrtf(ssq * (1.0f / DM) + EPSF);
    const float4* g4 = (const float4*)(gnext + lane * 16);
    if (FINAL) {
      float* op = outp + (size_t)tok * DM + lane * 16;
#pragma unroll
      for (int c = 0; c < 4; c++) {
        const float4 gq = g4[c];
        *(float4*)(op + c * 4) = make_float4(xv[c * 4] * rstd * gq.x, xv[c * 4 + 1] * rstd * gq.y, xv[c * 4 + 2] * rstd * gq.z, xv[c * 4 + 3] * rstd * gq.w);
      }
    } else {
      uint4 o0, o1;
      { const float4 ga = g4[0], gb = g4[1];
        o0.x = pk2(xv[0] * rstd * ga.x, xv[1] * rstd * ga.y); o0.y = pk2(xv[2] * rstd * ga.z, xv[3] * rstd * ga.w);
        o0.z = pk2(xv[4] * rstd * gb.x, xv[5] * rstd * gb.y); o0.w = pk2(xv[6] * rstd * gb.z, xv[7] * rstd * gb.w); }
      { const float4 ga = g4[2], gb = g4[3];
        o1.x = pk2(xv[8] * rstd * ga.x, xv[9] * rstd * ga.y); o1.y = pk2(xv[10] * rstd * ga.z, xv[11] * rstd * ga.w);
        o1.z = pk2(xv[12] * rstd * gb.x, xv[13] * rstd * gb.y); o1.w = pk2(xv[14] * rstd * gb.z, xv[15] * rstd * gb.w); }
      *(uint4*)(xn + (size_t)tok * DM + lane * 16) = o0;
      *(uint4*)(xn + (size_t)tok * DM + lane * 16 + 8) = o1;
    }
  }
}

__device__ __forceinline__ void prologue_transposes(const int wave_s, const Params& p, unsigned char* ws, LAS unsigned char* lds) {
  const int tid_ = opaque_tid(wave_s);
  const int lane = tid_ & 63, wave = tid_ >> 6;
  LAS float* scr = (LAS float*)(lds + wave * 16384);
  const int gw = blockIdx.x * NWAVES + wave, NGW = gridDim.x * NWAVES;
  constexpr int I_IN = (DM / 64) * (DIN / 32), I_SQ = (DM / 64) * (DM / 32), I_2K = (DM / 64) * (2048 / 32);
  constexpr int I_GL = (256 / 64) * (256 / 32);
  constexpr int PER_LAYER = I_IN + 3 * I_SQ + 2 * I_2K + I_GL;
  const float* w3 = karg_in(3); const float* w19 = karg_in(19); const float* w22 = karg_in(22);
  const float* w23 = karg_in(23); const float* w24 = karg_in(24); const float* w26 = karg_in(26);
  const float* w16 = karg_in(16);
  for (int it = gw; it < 2 * PER_LAYER; it += NGW) {
    const int l = it / PER_LAYER;
    int r = it % PER_LAYER;
    unsigned char* wl = ws + WS_WT + (size_t)l * WT_LAYER;
    if (r < I_IN) { transpose_item(w3 + (size_t)l * DM * DIN, DM, DIN, (bf16*)(wl + WT_IN), scr, r, lane); continue; } r -= I_IN;
    if (r < I_SQ) { transpose_item(w19 + (size_t)l * DM * DM, DM, DM, (bf16*)(wl + WT_OUT), scr, r, lane); continue; } r -= I_SQ;
    if (r < I_SQ) { transpose_item(w22 + (size_t)l * DM * DM, DM, DM, (bf16*)(wl + WT_MQ), scr, r, lane); continue; } r -= I_SQ;
    if (r < I_2K) { transpose_item(w23 + (size_t)l * DM * 2048, DM, 2048, (bf16*)(wl + WT_MKV), scr, r, lane); continue; } r -= I_2K;
    if (r < I_SQ) { transpose_item(w24 + (size_t)l * DM * DM, DM, DM, (bf16*)(wl + WT_MO), scr, r, lane); continue; } r -= I_SQ;
    if (r < I_2K) { transpose_item(w26 + (size_t)l * DM * 2048, DM, 2048, (bf16*)(wl + WT_PQ), scr, r, lane); continue; } r -= I_2K;
    transpose_item(w16 + (size_t)l * 256 * 256, 256, 256, (bf16*)(wl + WT_GLU), scr, r, lane);
  }
}

template <class T> __device__ __forceinline__ T* opq(T* p) { asm volatile("" : "+s"(p)); return p; }
__device__ __forceinline__ void cvt_rows_bf16(const int wave_s, const float* src, bf16* dst, size_t n) {
  const int tid_ = opaque_tid(wave_s);
  const size_t gt = (size_t)blockIdx.x * (NWAVES * 64) + tid_;
  const size_t nth = (size_t)gridDim.x * NWAVES * 64;
  for (size_t i = gt; i < n / 8; i += nth) {
    const float4 a = ((const float4*)src)[2 * i], b = ((const float4*)src)[2 * i + 1];
    uint4 o; o.x = pk2(a.x, a.y); o.y = pk2(a.z, a.w); o.z = pk2(b.x, b.y); o.w = pk2(b.z, b.w);
    ((uint4*)dst)[i] = o;
  }
}

__device__ __forceinline__ unsigned enc_e4m3(float x) {
  const _Float16 hf = (_Float16)x;
  const unsigned h = (unsigned)__builtin_bit_cast(unsigned short, hf);
  return ((h + 0x7Fu + ((h >> 8) & 1u)) >> 8) & 0xFFu;
}
__device__ __forceinline__ void cvt_rows_e4m3(const int wave_s, const float* src, unsigned char* dst, size_t n, float sc) {
  const int tid_ = opaque_tid(wave_s);
  const size_t gt = (size_t)blockIdx.x * (NWAVES * 64) + tid_;
  const size_t nth = (size_t)gridDim.x * NWAVES * 64;
  for (size_t i = gt; i < n / 16; i += nth) {
    unsigned w[4];
#pragma unroll
    for (int k = 0; k < 4; k++) {
      const float4 a = ((const float4*)src)[4 * i + k];
      w[k] = enc_e4m3(a.x * sc) | (enc_e4m3(a.y * sc) << 8) | (enc_e4m3(a.z * sc) << 16) | (enc_e4m3(a.w * sc) << 24);
    }
    uint4 o; o.x = w[0]; o.y = w[1]; o.z = w[2]; o.w = w[3];
    ((uint4*)dst)[i] = o;
  }
}

__device__ __forceinline__ unsigned enc_v4(float z) {
  const float az = fabsf(z);
  unsigned c = 0;
  c += az > 0.25f; c += az > 0.5f; c += az > 0.75f; c += az > 1.0625f; c += az > 1.375f; c += az > 1.75f; c += az > 2.25f;
  return c | ((__builtin_bit_cast(unsigned, z) >> 28) & 8u);
}
__device__ __forceinline__ void cvt_rows_i4(const int wave_s, const float* src, unsigned char* dst, float* sc_out, int nrows) {
  const int tid_ = opaque_tid(wave_s);
  const int lane = tid_ & 63;
  const int gw = blockIdx.x * NWAVES + (tid_ >> 6);
  const int nw = gridDim.x * NWAVES;
  for (int r = gw; r < nrows; r += nw) {
    const float4* sp = (const float4*)(src + (size_t)r * 1024 + lane * 16);
    const float4 a0 = sp[0], a1 = sp[1], a2 = sp[2], a3 = sp[3];
    const float xv[16] = {a0.x, a0.y, a0.z, a0.w, a1.x, a1.y, a1.z, a1.w, a2.x, a2.y, a2.z, a2.w, a3.x, a3.y, a3.z, a3.w};
    float ss = 0.f;
#pragma unroll
    for (int i = 0; i < 16; i++) ss += xv[i] * xv[i];
    ss = wsum(ss);
    const float sc = sqrtf(ss * (1.0f / 1024.f)) * U4_STEP;
    const float inv = sc > 0.f ? 1.0f / sc : 0.f;
    unsigned w[2] = {0u, 0u};
#pragma unroll
    for (int i = 0; i < 16; i++) {
      const float f = fminf(fmaxf(floorf(xv[i] * inv), -8.f), 7.f);
      w[i >> 3] |= ((unsigned)(int)f & 15u) << (4 * (i & 7));
    }
    uint2 o; o.x = w[0]; o.y = w[1];
    *(uint2*)(dst + (size_t)r * 512 + lane * 8) = o;
    if (lane == 0) sc_out[2 * r] = sc;
  }
}
__device__ __forceinline__ void cvt_rows_v4(const int wave_s, const float* src, unsigned char* dst, float* sc_out, int nrows) {
  const int tid_ = opaque_tid(wave_s);
  const int lane = tid_ & 63;
  const int gw = blockIdx.x * NWAVES + (tid_ >> 6);
  const int nw = gridDim.x * NWAVES;
  for (int r = gw; r < nrows; r += nw) {
    const float4* sp = (const float4*)(src + (size_t)r * 1024 + lane * 16);
    const float4 a0 = sp[0], a1 = sp[1], a2 = sp[2], a3 = sp[3];
    const float xv[16] = {a0.x, a0.y, a0.z, a0.w, a1.x, a1.y, a1.z, a1.w, a2.x, a2.y, a2.z, a2.w, a3.x, a3.y, a3.z, a3.w};
    float ss = 0.f;
#pragma unroll
    for (int i = 0; i < 16; i++) ss += xv[i] * xv[i];
    ss = wsum(ss);
    const float sc = sqrtf(ss * (1.0f / 1024.f)) * V4_ROWSCALE;
    const float inv = sc > 0.f ? 1.0f / sc : 0.f;
    unsigned w[2] = {0u, 0u};
#pragma unroll
    for (int i = 0; i < 16; i++) w[i >> 3] |= enc_v4(xv[i] * inv) << (4 * (i & 7));
    uint2 o; o.x = w[0]; o.y = w[1];
    *(uint2*)(dst + (size_t)r * 512 + lane * 8) = o;
    if (lane == 0) sc_out[2 * r] = sc;
  }
}

#define GEMM_F32(Aptr, Wt, Cptr, Rptr, M_, N_) do { \
    pg8::Gemm g_{opq((const bf16*)(Aptr)), opq((const bf16*)(Wt)), (M_), (N_), DM}; pg8::StaticOrder S_; S_.init((M_), (N_), (int)gridDim.x, (int)blockIdx.x); \
    pg8::EpiF32R E_{opq((float*)(Cptr)), opq((const float*)(Rptr)), (N_)}; \
    pg8::gemm_phase<pg8::EpiF32R, pg8::StaticOrder, true, true>(wave_s, ldsl, g_, S_, E_); } while (0)
#define GEMM_BF16_C(Aptr, Wt, Optr, M_, N_, C_) do { \
    pg8::Gemm g_{opq((const bf16*)(Aptr)), opq((const bf16*)(Wt)), (M_), (N_), DM}; pg8::StaticOrder S_; S_.init((M_), (N_), (int)gridDim.x, (C_)); \
    pg8::EpiBf16 E_{opq((bf16*)(Optr)), (N_)}; \
    pg8::gemm_phase<pg8::EpiBf16, pg8::StaticOrder, true, true>(wave_s, ldsl, g_, S_, E_); } while (0)
#define GEMM_BF16(Aptr, Wt, Optr, M_, N_) GEMM_BF16_C(Aptr, Wt, Optr, M_, N_, (int)blockIdx.x)
#define GEMM_F32RN(Aptr, Wt, Cptr, Rptr, XGptr, Gptr, STptr) do { \
    pg8::Gemm g_{opq((const bf16*)(Aptr)), opq((const bf16*)(Wt)), NT, DM, DM}; pg8::StaticOrder S_; S_.init(NT, DM, (int)gridDim.x, (int)blockIdx.x); \
    pg8::EpiF32RN E_{opq((float*)(Cptr)), opq((const float*)(Rptr)), DM, opq((bf16*)(XGptr)), opq((const float*)(Gptr)), opq((float*)(STptr))}; \
    pg8::gemm_phase<pg8::EpiF32RN, pg8::StaticOrder, true, true>(wave_s, ldsl, g_, S_, E_); } while (0)
#define GEMM_BF16S(Aptr, Wt, Optr, N_, STptr) do { \
    pg8::Gemm g_{opq((const bf16*)(Aptr)), opq((const bf16*)(Wt)), NT, (N_), DM}; pg8::StaticOrder S_; S_.init(NT, (N_), (int)gridDim.x, (int)blockIdx.x); \
    pg8::EpiBf16S E_{opq((bf16*)(Optr)), (N_), opq((const float*)(STptr))}; \
    pg8::gemm_phase<pg8::EpiBf16S, pg8::StaticOrder, true, true>(wave_s, ldsl, g_, S_, E_); } while (0)

__global__ void __launch_bounds__(NWAVES * 64, 2) fwd_megakernel(Params p) {
  extern __shared__ __attribute__((aligned(16))) unsigned char lds[];
  LAS unsigned char* ldsl = (LAS unsigned char*)lds;
  LAS float* smem = (LAS float*)ldsl;
  const int wave_s = __builtin_amdgcn_readfirstlane((int)(threadIdx.x >> 6));
  unsigned char* ws = p.ws;
  volatile LAS unsigned* MISC = (volatile LAS unsigned*)(ldsl + (LDS_BYTES - 256));
  if (threadIdx.x < 64) MISC[threadIdx.x] = 0u;
  __syncthreads();
  const XcdBarrier bar = xcd_barrier_post((unsigned*)(ws + WS_CTL) + 4096, MISC + 8);
  float* xw = (float*)(ws + WS_XW);
  bf16* xn = (bf16*)(ws + WS_XN);
  bf16* big = (bf16*)(ws + WS_BIG);
  bf16* y = (bf16*)(ws + WS_Y);
  bf16* memh = (bf16*)(ws + WS_MEMH);
  bf16* kvb = (bf16*)(ws + WS_KVB);
  bf16* vT = (bf16*)(ws + WS_VT);
  float* ssmE = (float*)(ws + WS_SSME);
  float* ssmp = (float*)(ws + WS_SSMP);
  int* ids = (int*)(ws + WS_IDS);
  float* gates = (float*)(ws + WS_GATE);
  bf16* skb = (bf16*)(ws + WS_SKB);
  unsigned char* ub = ws + WS_UB;
  unsigned char* vb = ws + WS_VB;
  float* rst = (float*)(ws + WS_RST);
  float* vsc = (float*)(ws + WS_VSC);
  float* usc = (float*)(ws + WS_USC);

  prologue_transposes(wave_s, p, ws, ldsl);
  cvt_rows_bf16(wave_s, karg_in(27), skb, (size_t)2 * 8 * 2 * 128 * 128);
  cvt_rows_i4(wave_s, karg_in(28), ub, vsc + 1, 2 * 16384);
  cvt_rows_v4(wave_s, karg_in(29), vb, vsc, 2 * 16384);
  for (int l = 0; l < 2; l++)
    rms_rows<true>(wave_s, karg_in(1), karg_in(21) + l * DM, memh + (size_t)l * 1024 * 1024, 1024);
  ssm_params(wave_s, p, ssmp);
  xcd_barrier(bar);
  rms_rows<true>(wave_s, karg_in(0), karg_in(2), xn, NT);
  xcd_barrier(bar);
  for (int l = 0; l < 2; l++)
    GEMM_BF16_C(memh + (size_t)l * 1024 * 1024, ws + WS_WT + (size_t)l * WT_LAYER + WT_MKV,
              kvb + (size_t)l * 1024 * 2048, 1024, 2048, (int)((blockIdx.x + gridDim.x - 64u - 32u * (unsigned)l) % gridDim.x));

#pragma nounroll
  for (int l = 0; l < 2; l++) {
    const float* xcur = (l == 0) ? karg_in(0) : xw;
    const float* sp = ssmp + (size_t)l * SSMP_PER_LAYER;
    const unsigned char* wl = ws + WS_WT + (size_t)l * WT_LAYER;
    GEMM_BF16(xn, wl + WT_IN, big, NT, DIN);
    xcd_barrier(bar);
    if (l == 0) vt_phase(wave_s, kvb, vT);
    ssm_chunk_end(wave_s, sp, big, ssmE, smem);
    attn_phase(wave_s, p, l, big, y, smem);
    conv_phase(wave_s, p, l, big, y, smem);
    xcd_barrier(bar);
    ssm_finish(wave_s, p, l, sp, big, ssmE, y, smem);
    xcd_barrier(bar);
    GEMM_F32RN(y, wl + WT_OUT, xw, xcur, xn, karg_in(20) + l * DM, rst);
    xcd_barrier(bar);
    GEMM_BF16S(xn, wl + WT_MQ, big, DM, rst);
    xcd_barrier(bar);
    memattn_phase(wave_s, big, kvb + (size_t)l * 1024 * 2048, vT + (size_t)l * 4 * 4 * 256 * 256, y, smem);
    xcd_barrier(bar);
    GEMM_F32RN(y, wl + WT_MO, xw, (const float*)xw, xn, karg_in(25) + l * DM, rst);
    xcd_barrier(bar);
    GEMM_BF16S(xn, wl + WT_PQ, big, 2048, rst);
    xcd_barrier(bar);
    peer_topk(wave_s, big, skb + (size_t)l * 8 * 2 * 128 * 128, ids, gates, smem);
    xcd_barrier(bar);
    if (l == 0) {
      peer_gather<false>(wave_s, xn, rst, ub + (size_t)l * 16384 * 512, vb + (size_t)l * 16384 * 512, vsc + (size_t)l * 2 * 16384, usc, ids, gates, xw, karg_in(2) + DM, (float*)nullptr);
      xcd_barrier(bar);
    } else {
      peer_gather<true>(wave_s, xn, rst, ub + (size_t)l * 16384 * 512, vb + (size_t)l * 16384 * 512, vsc + (size_t)l * 2 * 16384, usc, ids, gates, xw, karg_in(30), p.out);
    }
  }
}

extern "C" void kernel_launch(void* const* d_in, const int* in_sizes, int n_in,
                              void* d_out, int out_size, void* d_ws, size_t ws_size,
                              hipStream_t stream) {
  static int grid_blocks = 0;
  if (!grid_blocks) {
    int dev = 0, cus = 0, per_cu = 0;
    (void)hipGetDevice(&dev);
    (void)hipDeviceGetAttribute(&cus, hipDeviceAttributeMultiprocessorCount, dev);
    (void)hipFuncSetAttribute((const void*)fwd_megakernel, hipFuncAttributeMaxDynamicSharedMemorySize, LDS_BYTES);
    (void)hipOccupancyMaxActiveBlocksPerMultiprocessor(&per_cu, fwd_megakernel, NWAVES * 64, LDS_BYTES);
    if (per_cu < 1) fprintf(stderr, "occupancy query reports %d blocks/CU\n", per_cu);
    grid_blocks = cus;
  }
  (void)hipMemsetAsync((char*)d_ws + WS_CTL, 0, 1 * MiB, stream);
  Params p{};
  for (int i = 0; i < 31; i++) p.in[i] = (const float*)d_in[i];
  p.out = (float*)d_out;
  p.ws = (unsigned char*)d_ws;
  void* args[] = {&p};
  hipError_t e = hipLaunchCooperativeKernel((void*)fwd_megakernel, dim3(grid_blocks), dim3(NWAVES * 64),
                                            args, LDS_BYTES, stream);
  if (e != hipSuccess)
    fprintf(stderr, "cooperative launch failed: %s (grid %d)\n", hipGetErrorString(e), grid_blocks);
}
```

```cpp
#include <hip/hip_runtime.h>
#include <hip/hip_cooperative_groups.h>
#include <cstdio>
namespace cg = cooperative_groups;

#define NT 16384
#define SEQ 4096
#define DM 1024
#define DIN 2304
#define NMEM 256
#define EPSF 1e-6f
#define NWAVES 8
#define LDS_BYTES 147456

typedef unsigned short bf16;
#define LAS __attribute__((address_space(3)))

struct Params {
  const float* in[31];
  float* out;
  unsigned char* ws;
};
typedef __attribute__((address_space(4))) const unsigned char* kaptr_t;
__device__ __forceinline__ const float* karg_in(int i) {
  kaptr_t ka = (kaptr_t)__builtin_amdgcn_kernarg_segment_ptr();
  asm volatile("" : "+s"(ka));
  return *(const float* __attribute__((address_space(4))) const*)(ka + 8 * i);
}

constexpr size_t MiB = 1u << 20;
constexpr size_t WS_CTL  = 0;
constexpr size_t WS_WT   = 1 * MiB;
constexpr size_t WT_IN = 0, WT_OUT = WT_IN + (size_t)DIN * DM * 2, WT_MQ = WT_OUT + (size_t)DM * DM * 2,
                 WT_MKV = WT_MQ + (size_t)DM * DM * 2, WT_MO = WT_MKV + (size_t)2048 * DM * 2,
                 WT_PQ = WT_MO + (size_t)DM * DM * 2, WT_GLU = WT_PQ + (size_t)2048 * DM * 2, WT_LAYER = WT_GLU + (size_t)256 * 256 * 2;
constexpr size_t WS_XW   = WS_WT + 2 * WT_LAYER;
constexpr size_t WS_XN   = WS_XW + (size_t)NT * DM * 4;
constexpr size_t WS_BIG  = WS_XN + (size_t)NT * DM * 2;
constexpr size_t WS_Y    = WS_BIG + (size_t)NT * DIN * 2;
constexpr size_t WS_MEMH = WS_Y + (size_t)NT * DM * 2;
constexpr size_t WS_KVB  = WS_MEMH + (size_t)2 * 1024 * 1024 * 2;
constexpr size_t WS_VT   = WS_KVB + (size_t)2 * 1024 * 2048 * 2;
constexpr size_t WS_SSME = WS_VT + (size_t)2 * 4 * 4 * 256 * 256 * 2;
#define SSMP_PER_LAYER (2048 + 2048 + 32768)
constexpr size_t WS_SSMP = WS_SSME + (size_t)4 * 64 * 16 * 64 * 2 * 4;
constexpr size_t WS_IDS  = WS_SSMP + (size_t)2 * SSMP_PER_LAYER * 4;
constexpr size_t WS_GATE = WS_IDS + (size_t)NT * 128 * 4;
constexpr size_t WS_SKB  = WS_GATE + (size_t)NT * 128 * 4;
constexpr size_t WS_UB   = WS_SKB + (size_t)2 * 8 * 2 * 128 * 128 * 2;
constexpr size_t WS_VB   = WS_UB + (size_t)2 * 16384 * 512;
constexpr size_t WS_VSC  = WS_VB + (size_t)2 * 16384 * 512;
constexpr size_t WS_USC  = WS_VSC + (size_t)2 * 16384 * 4;
constexpr size_t WS_RST  = WS_USC + (size_t)2 * 16384 * 4;
constexpr size_t WS_END  = WS_RST + (size_t)NT * 16 * 4;
#define U_SCALE 64.0f
#define U4_STEP 0.3352f
#define V4_LUT_LO 0x3B393630u
#define V4_LUT_HI 0x41403E3Du
#define V4_ROWSCALE 1.075f
static_assert(WS_END <= 512 * MiB, "workspace");
static_assert(WT_LAYER % 256 == 0 && WS_SSMP % 16 == 0 && WS_IDS % 16 == 0 && WS_SKB % 256 == 0 && WS_VT % 256 == 0, "align");

__device__ __forceinline__ int opaque_tid(int wave_s) { int v = wave_s * 64 + (int)__builtin_amdgcn_mbcnt_hi(~0u, __builtin_amdgcn_mbcnt_lo(~0u, 0u)); asm volatile("" : "+v"(v)); return v; }
__device__ __forceinline__ unsigned f2bf(float f) { unsigned u = __builtin_bit_cast(unsigned, f); return (u + 0x7fffu + ((u >> 16) & 1u)) >> 16; }
__device__ __forceinline__ unsigned pk2(float lo, float hi) { return f2bf(lo) | (f2bf(hi) << 16); }
__device__ __forceinline__ float bf_lo(unsigned u) { return __builtin_bit_cast(float, u << 16); }
__device__ __forceinline__ float bf_hi(unsigned u) { return __builtin_bit_cast(float, u & 0xffff0000u); }
__device__ __forceinline__ float bf2f(bf16 h) { return __builtin_bit_cast(float, (unsigned)h << 16); }


#define XB_TMO      128
#define XB_XCNT(j)  (256  + 64 * (j))
#define XB_XSUB(j)  (1280 + 64 * (j))
#define XB_XGEN(j)  (2304 + 64 * (j))
#define XB_TOP      3328
#define XB_TOPGEN   3392
#define XCD_BAR_WORDS 3456
#define XB_SPIN_CAP (1u << 22)
__device__ __forceinline__ unsigned xb_ld(unsigned* p)              { return __hip_atomic_load(p, __ATOMIC_RELAXED, __HIP_MEMORY_SCOPE_AGENT); }
__device__ __forceinline__ unsigned xb_add(unsigned* p, unsigned v) { return __hip_atomic_fetch_add(p, v, __ATOMIC_RELAXED, __HIP_MEMORY_SCOPE_AGENT); }
__device__ __forceinline__ unsigned xb_xcc_id() { return (unsigned)__builtin_amdgcn_s_getreg((3 << 11) | 20) & 0xFu; }
#define XB_SPIN(cond, bar) do { unsigned _sp = 0; while (cond) { __builtin_amdgcn_s_sleep(1); \
    if ((++_sp & 255u) == 0u) { if (xb_ld(&(bar)[XB_TMO])) break; if (_sp > XB_SPIN_CAP) { atomicAdd(&(bar)[XB_TMO], 1u); break; } } } } while (0)
struct XcdBarrier { unsigned* bar; unsigned x; volatile LAS unsigned* st; };
__device__ __forceinline__ XcdBarrier xcd_barrier_post(unsigned* bar, volatile LAS unsigned* st) {
    XcdBarrier b; b.bar = bar; b.x = xb_xcc_id(); b.st = st;
    if (threadIdx.x == 0) (void)xb_add(&bar[XB_XCNT(b.x)], 1u);
    return b;
}
__device__ __forceinline__ void xcd_barrier_complete(unsigned* bar, unsigned x, unsigned& nloc, unsigned& nx) {
    const unsigned G = gridDim.x * gridDim.y * gridDim.z;
    unsigned sum, cnt, mine, sp = 0u;
    for (;;) {
        sum = 0u; cnt = 0u; mine = 0u;
#pragma unroll
        for (unsigned j = 0; j < 16; ++j) { const unsigned c = xb_ld(&bar[XB_XCNT(j)]); sum += c; cnt += (c > 0u) ? 1u : 0u; mine = (j == x) ? c : mine; }
        if (sum == G) break;
        __builtin_amdgcn_s_sleep(1);
        if ((++sp & 255u) == 0u) { if (xb_ld(&bar[XB_TMO])) break; if (sp > XB_SPIN_CAP) { atomicAdd(&bar[XB_TMO], 1u); break; } }
    }
    nloc = mine > 0u ? mine : 1u; nx = cnt > 0u ? cnt : 1u;
}
__device__ __forceinline__ void xcd_barrier(const XcdBarrier& b) {
    asm volatile("s_waitcnt vmcnt(0)" ::: "memory");
    __syncthreads();
    if (threadIdx.x == 0) {
        unsigned* bar = b.bar;
        __builtin_amdgcn_s_waitcnt(0);
        unsigned nloc = b.st[0], nx = b.st[1];
        if (nloc == 0u) { xcd_barrier_complete(bar, b.x, nloc, nx); b.st[0] = nloc; b.st[1] = nx; }
        const unsigned old = xb_add(&bar[XB_XSUB(b.x)], 1u);
        const unsigned gen = old / nloc;
        if (old + 1u == (gen + 1u) * nloc) {
            __builtin_amdgcn_fence(__ATOMIC_RELEASE, "agent");
            asm volatile("s_waitcnt vmcnt(0)" ::: "memory");
            const unsigned og = xb_add(&bar[XB_TOP], 1u);
            const unsigned tg = og / nx;
            if (og + 1u == (tg + 1u) * nx) xb_add(&bar[XB_TOPGEN], 1u);
            else XB_SPIN(xb_ld(&bar[XB_TOPGEN]) == tg, bar);
            __builtin_amdgcn_fence(__ATOMIC_ACQUIRE, "agent");
            xb_add(&bar[XB_XGEN(b.x)], 1u);
            asm volatile("s_waitcnt vmcnt(0)" ::: "memory");
        } else {
            XB_SPIN(xb_ld(&bar[XB_XGEN(b.x)]) == gen, bar);
            __builtin_amdgcn_fence(__ATOMIC_ACQUIRE, "agent");
            asm volatile("s_waitcnt vmcnt(0)" ::: "memory");
        }
    }
    __syncthreads();
}

namespace pg8 {
#define PG8_LAS __attribute__((address_space(3)))
typedef unsigned short bf16_t;
typedef short bf16x8 __attribute__((ext_vector_type(8)));
typedef float f32x4 __attribute__((ext_vector_type(4)));
typedef unsigned u32x4 __attribute__((ext_vector_type(4)));
constexpr int BM = 256, BK = 64, HALF = 128, HTB = HALF * BK * 2, STAGE_BYTES = 8 * HTB, NXCD = 8, WGM = 8;
__host__ __device__ __forceinline__ int lds_byte(int r, int c) { const int st = (r >> 4) * 2 + (c >> 5), rr = r & 15, cc = c & 31, ob = rr * 64 + cc * 2; return st * 1024 + (ob ^ (((ob >> 9) & 1) << 5)); }
__host__ __device__ __forceinline__ void stage_rc(int b, int& R, int& C) { const int st = b / 1024, sb = b % 1024, swz = sb ^ (((sb >> 9) & 1) << 5); R = (st >> 1) * 16 + swz / 64; C = (st & 1) * 32 + (swz % 64) / 2; }
__host__ __device__ __forceinline__ int perm32(int rho) { const int n = rho >> 4, i = rho & 15; return 8 * (i >> 2) + 4 * n + (i & 3); }
struct Unit { int pm, pn; };
struct Gemm { const bf16_t* A; const bf16_t* Bt; int M, N, K; };
struct StaticOrder {
    int nM, nN, nwg, G, c;
    __host__ __device__ __forceinline__ void init(int M, int N, int G_, int c_) { nM = M / BM; nN = N / BM; nwg = nM * nN; G = G_; c = c_; }
    __host__ __device__ bool next(int i, Unit& u) const {
        const long L = (long)i * G + c; if (L >= nwg) return false;
        int wgid = (int)L; { const int q = nwg / NXCD, r = nwg % NXCD, xcd = wgid % NXCD, off = wgid / NXCD; wgid = (xcd < r ? xcd * (q + 1) : r * (q + 1) + (xcd - r) * q) + off; }
        const int nig = WGM * nN, gid = wgid / nig, fm = gid * WGM, gsz = (nM - fm) < WGM ? (nM - fm) : WGM;
        u.pm = fm + ((wgid % nig) % gsz); u.pn = (wgid % nig) / gsz; return true;
    }
    __device__ __forceinline__ void a_ready(const Unit&) const {}
    __device__ __forceinline__ void done(const Unit&) const {}
};
__device__ __forceinline__ unsigned cvt_pk_bf16(float lo, float hi) { unsigned r; asm volatile("v_cvt_pk_bf16_f32 %0, %1, %2" : "=v"(r) : "v"(lo), "v"(hi)); return r; }

struct EpiF32R {
    static constexpr bool PERM = false, AFTER_DRAIN = false;
    float* C; const float* R; int ldc;
    __device__ __forceinline__ void operator()(const f32x4 (&acc)[2][2][4][2], const Unit& u, int wr, int wc, int fr, int fq) const {
        const int row0 = u.pm * BM + wr * 64 + fr, col0 = u.pn * BM + wc * 32 + 4 * fq;
#pragma unroll
        for (int ai = 0; ai < 2; ++ai)
#pragma unroll
            for (int m = 0; m < 4; ++m) {
                const size_t ro = (size_t)(row0 + ai * HALF + m * 16) * ldc + col0;
                f32x4 rv[2][2];
#pragma unroll
                for (int bj = 0; bj < 2; ++bj)
#pragma unroll
                    for (int n = 0; n < 2; ++n) rv[bj][n] = R ? *(const f32x4*)(R + ro + bj * HALF + n * 16) : (f32x4){0.f, 0.f, 0.f, 0.f};
#pragma unroll
                for (int bj = 0; bj < 2; ++bj)
#pragma unroll
                    for (int n = 0; n < 2; ++n) *(f32x4*)(C + ro + bj * HALF + n * 16) = acc[ai][bj][m][n] + rv[bj][n];
                __builtin_amdgcn_sched_barrier(0);
            }
    }
};

struct EpiBf16 {
    static constexpr bool PERM = true, AFTER_DRAIN = false;
    bf16_t* O; int ldc;
    __device__ __forceinline__ void operator()(const f32x4 (&acc)[2][2][4][2], const Unit& u, int wr, int wc, int fr, int fq) const {
        const int row0 = u.pm * BM + wr * 64 + fr, col0 = u.pn * BM + wc * 32 + 8 * fq;
#pragma unroll
        for (int ai = 0; ai < 2; ++ai)
#pragma unroll
            for (int m = 0; m < 4; ++m) { bf16_t* rowp = O + (size_t)(row0 + ai * HALF + m * 16) * ldc + col0;
#pragma unroll
                for (int bj = 0; bj < 2; ++bj) { const f32x4 v0 = acc[ai][bj][m][0], v1 = acc[ai][bj][m][1];
                    u32x4 w; w.x = cvt_pk_bf16(v0[0], v0[1]); w.y = cvt_pk_bf16(v0[2], v0[3]); w.z = cvt_pk_bf16(v1[0], v1[1]); w.w = cvt_pk_bf16(v1[2], v1[3]);
                    *(u32x4*)(rowp + bj * HALF) = w; } }
    }
};

struct EpiF32RN {
    static constexpr bool PERM = false, AFTER_DRAIN = false;
    float* C; const float* R; int ldc; bf16_t* XG; const float* g; float* st;
    __device__ __forceinline__ void operator()(const f32x4 (&acc)[2][2][4][2], const Unit& u, int wr, int wc, int fr, int fq) const {
        const int row0 = u.pm * BM + wr * 64 + fr, col0 = u.pn * BM + wc * 32 + 4 * fq;
        f32x4 gv[2][2];
#pragma unroll
        for (int bj = 0; bj < 2; ++bj)
#pragma unroll
            for (int n = 0; n < 2; ++n) gv[bj][n] = *(const f32x4*)(g + col0 + bj * HALF + n * 16);
#pragma unroll
        for (int ai = 0; ai < 2; ++ai)
#pragma unroll
            for (int m = 0; m < 4; ++m) {
                const int row = row0 + ai * HALF + m * 16;
                const size_t ro = (size_t)row * ldc + col0;
                f32x4 rv[2][2];
#pragma unroll
                for (int bj = 0; bj < 2; ++bj)
#pragma unroll
                    for (int n = 0; n < 2; ++n) rv[bj][n] = *(const f32x4*)(R + ro + bj * HALF + n * 16);
                float ss = 0.f;
#pragma unroll
                for (int bj = 0; bj < 2; ++bj)
#pragma unroll
                    for (int n = 0; n < 2; ++n) {
                        const f32x4 v = acc[ai][bj][m][n] + rv[bj][n];
                        *(f32x4*)(C + ro + bj * HALF + n * 16) = v;
                        ss += (v[0] * v[0] + v[1] * v[1]) + (v[2] * v[2] + v[3] * v[3]);
                        const f32x4 w = v * gv[bj][n];
                        uint2 pk; pk.x = cvt_pk_bf16(w[0], w[1]); pk.y = cvt_pk_bf16(w[2], w[3]);
                        *(uint2*)(XG + ro + bj * HALF + n * 16) = pk;
                    }
                ss += __shfl_xor(ss, 16, 64); ss += __shfl_xor(ss, 32, 64);
                if (fq == 0) st[(size_t)row * 16 + u.pn * 4 + wc] = ss;
                __builtin_amdgcn_sched_barrier(0);
            }
    }
};
struct EpiBf16S {
    static constexpr bool PERM = true, AFTER_DRAIN = false;
    bf16_t* O; int ldc; const float* st;
    __device__ __forceinline__ void operator()(const f32x4 (&acc)[2][2][4][2], const Unit& u, int wr, int wc, int fr, int fq) const {
        const int row0 = u.pm * BM + wr * 64 + fr, col0 = u.pn * BM + wc * 32 + 8 * fq;
#pragma unroll
        for (int ai = 0; ai < 2; ++ai)
#pragma unroll
            for (int m = 0; m < 4; ++m) {
                const int row = row0 + ai * HALF + m * 16;
                const f32x4* sp = (const f32x4*)(st + (size_t)row * 16);
                const f32x4 s0 = sp[0], s1 = sp[1], s2 = sp[2], s3 = sp[3];
                const f32x4 sa = (s0 + s1) + (s2 + s3);
                const float rs = __builtin_amdgcn_rsqf(((sa[0] + sa[1]) + (sa[2] + sa[3])) * (1.0f / 1024.f) + 1e-6f);
                bf16_t* rowp = O + (size_t)row * ldc + col0;
#pragma unroll
                for (int bj = 0; bj < 2; ++bj) { const f32x4 v0 = acc[ai][bj][m][0] * rs, v1 = acc[ai][bj][m][1] * rs;
                    u32x4 w; w.x = cvt_pk_bf16(v0[0], v0[1]); w.y = cvt_pk_bf16(v0[2], v0[3]); w.z = cvt_pk_bf16(v1[0], v1[1]); w.w = cvt_pk_bf16(v1[2], v1[3]);
                    *(u32x4*)(rowp + bj * HALF) = w; }
                __builtin_amdgcn_sched_barrier(0);
            }
    }
};

template <class Epi, class Sched, bool ALIGN_EPI = false, bool SP2 = false>
__device__ __forceinline__ void gemm_phase(const int wave_s, PG8_LAS unsigned char* lds, const Gemm g, const Sched& S, const Epi& E) {
    const int tid = opaque_tid(wave_s), wid = __builtin_amdgcn_readfirstlane(tid >> 6), lane = tid & 63, wr = wid >> 2, wc = wid & 3, fr = lane & 15, fq = lane >> 4;
    const int K = g.K, nt = K / BK;
    unsigned voffA[2], voffB[2];
#pragma unroll
    for (int i = 0; i < 2; ++i) { int R, C; stage_rc(tid * 16 + i * 8192, R, C); const int Rb = Epi::PERM ? ((R & ~31) + perm32(R & 31)) : R;
        voffA[i] = (unsigned)(R * K + C) * 2u; voffB[i] = (unsigned)(Rb * K + C) * 2u; }
    const size_t kstep = (size_t)(BK * 2);
    const size_t hstep = (size_t)HALF * K * 2;
    const size_t tstep = 2 * hstep;
    const unsigned ldsw = (unsigned)wid * 1024u;
    const int aoff = lds_byte(wr * 64 + fr, fq * 8), boff = lds_byte(wc * 32 + fr, fq * 8);
#define PG8_SA(b, h) (((b) * 2 + (h)) * HTB)
#define PG8_SB(b, h) ((4 + (b) * 2 + (h)) * HTB)
#define PG8_STAGE(bufoff, gbase, voff) do { _Pragma("unroll") for (int _i = 0; _i < 2; ++_i) \
        __builtin_amdgcn_global_load_lds((const unsigned*)((const char*)(gbase) + (voff)[_i]), (PG8_LAS unsigned*)(lds + (bufoff) + ldsw + _i * 8192), 16, 0, 0); } while (0)
#define PG8_LDA(dst, b, h) do { _Pragma("unroll") for (int m = 0; m < 4; ++m) _Pragma("unroll") for (int k = 0; k < 2; ++k) dst[m][k] = *(const PG8_LAS bf16x8*)(lds + PG8_SA(b, h) + aoff + m * 2048 + k * 1024); } while (0)
#define PG8_LDB(dst, b, h) do { _Pragma("unroll") for (int n = 0; n < 2; ++n) _Pragma("unroll") for (int k = 0; k < 2; ++k) dst[n][k] = *(const PG8_LAS bf16x8*)(lds + PG8_SB(b, h) + boff + n * 2048 + k * 1024); } while (0)
#define PG8_MMA(ai, bj, At, Bt) do { __builtin_amdgcn_s_setprio(1); _Pragma("unroll") for (int m = 0; m < 4; ++m) _Pragma("unroll") for (int n = 0; n < 2; ++n) _Pragma("unroll") for (int k = 0; k < 2; ++k) \
        acc[ai][bj][m][n] = __builtin_amdgcn_mfma_f32_16x16x32_bf16(Bt[n][k], At[m][k], acc[ai][bj][m][n], 0, 0, 0); __builtin_amdgcn_s_setprio(0); } while (0)
#define PG8_WAIT_V(n) asm volatile("s_waitcnt vmcnt(" #n ")" ::: "memory")
#define PG8_WAIT_L(n) asm volatile("s_waitcnt lgkmcnt(" #n ")" ::: "memory")
#define PG8_BAR __builtin_amdgcn_s_barrier()
#define PG8_SCHED __builtin_amdgcn_sched_barrier(0)
    Unit cur, nxt; int ui = 0;
    if (!S.next(0, cur)) return;
    f32x4 acc[2][2][4][2];
#pragma unroll
    for (int a = 0; a < 2; ++a)
#pragma unroll
        for (int b = 0; b < 2; ++b)
#pragma unroll
            for (int m = 0; m < 4; ++m)
#pragma unroll
                for (int n = 0; n < 2; ++n) acc[a][b][m][n] = (f32x4){0.f, 0.f, 0.f, 0.f};
    bf16x8 At[4][2], B0[2][2], B1[2][2];
    const char* cA = (const char*)g.A + (size_t)cur.pm * tstep; const char* cB = (const char*)g.Bt + (size_t)cur.pn * tstep;
    S.a_ready(cur);
    if constexpr (SP2) {
        PG8_STAGE(PG8_SB(0, 0), cB, voffB); PG8_STAGE(PG8_SB(0, 1), cB + hstep, voffB); PG8_STAGE(PG8_SA(0, 0), cA, voffA); PG8_STAGE(PG8_SA(0, 1), cA + hstep, voffA);
        if (wr == 1) PG8_BAR;
        PG8_WAIT_V(2); PG8_BAR;
        PG8_STAGE(PG8_SB(1, 0), cB + kstep, voffB); PG8_STAGE(PG8_SA(1, 0), cA + kstep, voffA); PG8_STAGE(PG8_SB(1, 1), cB + hstep + kstep, voffB);
        PG8_WAIT_V(6); PG8_BAR;
    } else {
        PG8_STAGE(PG8_SB(0, 0), cB, voffB); PG8_STAGE(PG8_SA(0, 0), cA, voffA); PG8_STAGE(PG8_SB(0, 1), cB + hstep, voffB); PG8_STAGE(PG8_SA(0, 1), cA + hstep, voffA);
        if (wr == 1) PG8_BAR;
        PG8_WAIT_V(4); PG8_BAR;
        PG8_STAGE(PG8_SB(1, 0), cB + kstep, voffB); PG8_STAGE(PG8_SA(1, 0), cA + kstep, voffA); PG8_STAGE(PG8_SB(1, 1), cB + hstep + kstep, voffB);
        PG8_WAIT_V(6); PG8_BAR;
    }
    for (;;) {
        const bool has_next = S.next(ui + 1, nxt);
        const char* nA = has_next ? (const char*)g.A + (size_t)nxt.pm * tstep : cA; const char* nB = has_next ? (const char*)g.Bt + (size_t)nxt.pn * tstep : cB;
        for (int t = 0; t < nt; t += 2) {
            const bool last = (t == nt - 2);
            const char* a1 = cA + (size_t)(t + 1) * kstep;
            const char* a2 = last ? nA : cA + (size_t)(t + 2) * kstep; const char* b2 = last ? nB : cB + (size_t)(t + 2) * kstep;
            const char* a3 = a2 + kstep; const char* b3 = b2 + kstep;
            if (last && has_next) S.a_ready(nxt);
            if constexpr (SP2) {
            PG8_LDB(B0, 0, 0); PG8_LDB(B1, 0, 1); PG8_SCHED; PG8_LDA(At, 0, 0); PG8_STAGE(PG8_SA(1, 1), a1 + hstep, voffA);
            PG8_WAIT_V(8); PG8_WAIT_L(0); PG8_BAR; PG8_MMA(0, 0, At, B0); PG8_MMA(0, 1, At, B1); PG8_BAR; PG8_SCHED;
            PG8_LDA(At, 0, 1); PG8_STAGE(PG8_SB(0, 0), b2, voffB); PG8_STAGE(PG8_SB(0, 1), b2 + hstep, voffB); PG8_STAGE(PG8_SA(0, 0), a2, voffA);
            PG8_WAIT_V(8); PG8_WAIT_L(0); PG8_BAR; PG8_MMA(1, 0, At, B0); PG8_MMA(1, 1, At, B1); PG8_BAR; PG8_SCHED;
            PG8_LDB(B0, 1, 0); PG8_LDB(B1, 1, 1); PG8_SCHED; PG8_LDA(At, 1, 0); PG8_STAGE(PG8_SA(0, 1), a2 + hstep, voffA);
            PG8_WAIT_V(8); PG8_WAIT_L(0); PG8_BAR; PG8_MMA(0, 0, At, B0); PG8_MMA(0, 1, At, B1); PG8_BAR; PG8_SCHED;
            PG8_LDA(At, 1, 1); PG8_STAGE(PG8_SB(1, 0), b3, voffB); PG8_STAGE(PG8_SB(1, 1), b3 + hstep, voffB); PG8_STAGE(PG8_SA(1, 0), a3, voffA);
            PG8_WAIT_V(8); PG8_WAIT_L(0); PG8_BAR; PG8_MMA(1, 0, At, B0); PG8_MMA(1, 1, At, B1); PG8_BAR; PG8_SCHED;
            } else {
            PG8_LDB(B0, 0, 0); PG8_SCHED; PG8_LDA(At, 0, 0); PG8_STAGE(PG8_SA(1, 1), a1 + hstep, voffA);
            PG8_WAIT_L(8); PG8_BAR; PG8_WAIT_L(0); PG8_MMA(0, 0, At, B0); PG8_BAR; PG8_SCHED;
            PG8_LDB(B1, 0, 1); PG8_STAGE(PG8_SB(0, 0), b2, voffB);
            PG8_BAR; PG8_WAIT_L(0); PG8_MMA(0, 1, At, B1); PG8_BAR;
            PG8_LDA(At, 0, 1); PG8_STAGE(PG8_SA(0, 0), a2, voffA);
            PG8_BAR; PG8_WAIT_L(0); PG8_MMA(1, 0, At, B0); PG8_BAR; PG8_SCHED;
            PG8_STAGE(PG8_SB(0, 1), b2 + hstep, voffB);
            PG8_WAIT_V(6); PG8_BAR; PG8_MMA(1, 1, At, B1); PG8_BAR;
            PG8_LDB(B0, 1, 0); PG8_SCHED; PG8_LDA(At, 1, 0); PG8_STAGE(PG8_SA(0, 1), a2 + hstep, voffA);
            PG8_WAIT_L(8); PG8_BAR; PG8_WAIT_L(0); PG8_MMA(0, 0, At, B0); PG8_BAR; PG8_SCHED;
            PG8_LDB(B1, 1, 1); PG8_STAGE(PG8_SB(1, 0), b3, voffB);
            PG8_BAR; PG8_WAIT_L(0); PG8_MMA(0, 1, At, B1); PG8_BAR;
            PG8_LDA(At, 1, 1); PG8_STAGE(PG8_SA(1, 0), a3, voffA);
            PG8_BAR; PG8_WAIT_L(0); PG8_MMA(1, 0, At, B0); PG8_BAR; PG8_SCHED;
            PG8_STAGE(PG8_SB(1, 1), b3 + hstep, voffB);
            PG8_WAIT_V(6); PG8_BAR; PG8_MMA(1, 1, At, B1); PG8_BAR;
            }
        }
        if constexpr (ALIGN_EPI) { if (wr == 0) PG8_BAR; }
        if constexpr (!Epi::AFTER_DRAIN) { E(acc, cur, wr, wc, fr, fq); S.done(cur); }
        if (!has_next) break;
#pragma unroll
        for (int a = 0; a < 2; ++a)
#pragma unroll
            for (int b = 0; b < 2; ++b)
#pragma unroll
                for (int m = 0; m < 4; ++m)
#pragma unroll
                    for (int n = 0; n < 2; ++n) acc[a][b][m][n] = (f32x4){0.f, 0.f, 0.f, 0.f};
        cur = nxt; cA = nA; cB = nB; ++ui;
        if constexpr (ALIGN_EPI) { if (wr == 1) PG8_BAR; }
    }
    PG8_WAIT_V(0);
    if constexpr (!ALIGN_EPI) { if (wr == 0) PG8_BAR; }
    PG8_BAR;
#undef PG8_SA
#undef PG8_SB
#undef PG8_STAGE
#undef PG8_LDA
#undef PG8_LDB
#undef PG8_MMA
#undef PG8_WAIT_V
#undef PG8_WAIT_L
#undef PG8_BAR
#undef PG8_SCHED
}
}

__device__ __forceinline__ void transpose_item(const float* W, int K, int N, bf16* WT, LAS float* scr, int item, int lane) {
    const int nblk = N / 32, kb = item / nblk, nb = item % nblk, k0 = 64 * kb, n0 = 32 * nb;
#pragma unroll 8
    for (int i = 0; i < 32; ++i) { const int kk = 2 * i + (lane >> 5); scr[kk * 33 + (lane & 31)] = W[(size_t)(k0 + kk) * N + n0 + (lane & 31)]; }
    asm volatile("s_waitcnt lgkmcnt(0)" ::: "memory");
    const int c = lane & 7;
#pragma unroll
    for (int j = 0; j < 4; ++j) { const int n = (lane >> 3) + 8 * j; const LAS float* s = scr + (8 * c) * 33 + n;
        uint4 o; o.x = pk2(s[0 * 33], s[1 * 33]); o.y = pk2(s[2 * 33], s[3 * 33]); o.z = pk2(s[4 * 33], s[5 * 33]); o.w = pk2(s[6 * 33], s[7 * 33]);
        *(uint4*)(WT + (size_t)(n0 + n) * K + k0 + 8 * c) = o; }
    asm volatile("s_waitcnt lgkmcnt(0)" ::: "memory");
}

__device__ __forceinline__ float wsum(float v) {
#pragma unroll
  for (int o = 32; o > 0; o >>= 1) v += __shfl_xor(v, o, 64);
  return v;
}
__device__ __forceinline__ float wmaxf(float v) {
#pragma unroll
  for (int o = 32; o > 0; o >>= 1) v = fmaxf(v, __shfl_xor(v, o, 64));
  return v;
}
__device__ __forceinline__ float sigmoidf_(float x) { return 1.0f / (1.0f + expf(-x)); }
__device__ __forceinline__ float gelu_tanh(float x) {
  return 0.5f * x * (1.0f + tanhf(0.7978845608028654f * (x + 0.044715f * x * x * x)));
}

template <bool BF16OUT>
__device__ __forceinline__ void rms_rows(const int wave_s, const float* src, const float* g, void* dstv, int rows) {
  const int tid_ = opaque_tid(wave_s);
  const int lane = tid_ & 63;
  const int gw = blockIdx.x * NWAVES + (tid_ >> 6);
  const int nw = gridDim.x * NWAVES;
  for (int r = gw; r < rows; r += nw) {
    const float4* s4 = (const float4*)(src + (size_t)r * DM);
    float4 v[4];
    float ss = 0.f;
#pragma unroll
    for (int i = 0; i < 4; i++) {
      v[i] = s4[lane + i * 64];
      ss += v[i].x * v[i].x + v[i].y * v[i].y + v[i].z * v[i].z + v[i].w * v[i].w;
    }
    ss = wsum(ss);
    const float rstd = rsqrtf(ss * (1.0f / DM) + EPSF);
    const float4* g4 = (const float4*)g;
#pragma unroll
    for (int i = 0; i < 4; i++) {
      float4 gg = g4[lane + i * 64];
      float4 o;
      o.x = v[i].x * rstd * gg.x; o.y = v[i].y * rstd * gg.y;
      o.z = v[i].z * rstd * gg.z; o.w = v[i].w * rstd * gg.w;
      if (BF16OUT) {
        uint2 pk; pk.x = pk2(o.x, o.y); pk.y = pk2(o.z, o.w);
        ((uint2*)((bf16*)dstv + (size_t)r * DM))[lane + i * 64] = pk;
      } else {
        ((float4*)((float*)dstv + (size_t)r * DM))[lane + i * 64] = o;
      }
    }
  }
}

__device__ __forceinline__ void ssm_params(const int wave_s, const Params& p, float* ssmp_all) {
  const int tid_ = opaque_tid(wave_s);
  const float* in8 = karg_in(8); const float* in9 = karg_in(9); const float* in10 = karg_in(10);
  const float* in11 = karg_in(11); const float* in12 = karg_in(12);
  const int gt = blockIdx.x * blockDim.x + tid_;
  const int nth = gridDim.x * blockDim.x;
  for (int i = gt; i < 2 * 16 * 64; i += nth) {
    const int l = i / 1024, gp = i % 1024, g = gp / 64;
    float* sp = ssmp_all + (size_t)l * SSMP_PER_LAYER;
    const float lre = fminf(in8[l * 1024 + gp], -1e-4f);
    const float lim = in9[l * 1024 + gp];
    const float dt = expf(in10[l * 16 + g]);
    const float er = expf(lre * dt);
    float sn, cs;
    sincosf(lim * dt, &sn, &cs);
    const float br = er * cs, bi = er * sn;
    sp[gp * 2 + 0] = br;
    sp[gp * 2 + 1] = bi;
    float cr = br, ci = bi;
#pragma unroll
    for (int s = 0; s < 6; s++) {
      const float nr = cr * cr - ci * ci, ni = 2.f * cr * ci;
      cr = nr; ci = ni;
    }
    sp[2048 + gp * 2 + 0] = cr;
    sp[2048 + gp * 2 + 1] = ci;
    const float nr = br - 1.0f, ni = bi;
    const float den = lre * lre + lim * lim;
    const float fr = (nr * lre + ni * lim) / den;
    const float fi = (ni * lre - nr * lim) / den;
    for (int h = 0; h < 16; h++) {
      const float bre = in11[((size_t)l * 1024 + gp) * 16 + h];
      const float bim = in12[((size_t)l * 1024 + gp) * 16 + h];
      sp[4096 + ((g * 16 + h) * 64 + (gp & 63)) * 2 + 0] = fr * bre - fi * bim;
      sp[4096 + ((g * 16 + h) * 64 + (gp & 63)) * 2 + 1] = fr * bim + fi * bre;
    }
  }
}

__device__ __forceinline__ void conv_phase(const int wave_s, const Params& p, int l, const bf16* proj, bf16* y, LAS float* smem) {
  const int tid_ = opaque_tid(wave_s);
  const int lane = tid_ & 63;
  const int gw = blockIdx.x * NWAVES + (tid_ >> 6);
  const int nw = gridDim.x * NWAVES;
  const float* cw = karg_in(4) + (size_t)l * 31 * 256;
  const float4 cb = ((const float4*)(karg_in(5) + l * 256))[lane];
  const float4 lg = ((const float4*)(karg_in(6) + l * 256))[lane];
  const float4 lb = ((const float4*)(karg_in(7) + l * 256))[lane];
  const float4 gg = ((const float4*)(karg_in(18) + l * 1024))[lane];
  LAS float* cwl = smem + 1024;
  for (int i = tid_; i < 31 * 256 / 4; i += NWAVES * 64) *(LAS pg8::f32x4*)(cwl + 4 * i) = *(const pg8::f32x4*)(cw + 4 * i);
  __syncthreads();
  for (int it = gw; it < NT / 8; it += nw) {
    const int tok0 = it * 8;
    const int t0 = tok0 & (SEQ - 1);
    float4 acc[8];
#pragma unroll
    for (int o = 0; o < 8; o++) acc[o] = cb;
#pragma unroll
    for (int i = 0; i < 38; i++) {
      if (t0 - 30 + i >= 0) {
        const bf16* row = proj + (size_t)(tok0 - 30 + i) * DIN;
        const uint2 vp = ((const uint2*)row)[lane];
        const uint2 gp = ((const uint2*)(row + 256))[lane];
        float4 g4;
        g4.x = bf_lo(vp.x) * sigmoidf_(bf_lo(gp.x)); g4.y = bf_hi(vp.x) * sigmoidf_(bf_hi(gp.x));
        g4.z = bf_lo(vp.y) * sigmoidf_(bf_lo(gp.y)); g4.w = bf_hi(vp.y) * sigmoidf_(bf_hi(gp.y));
#pragma unroll
        for (int o = 0; o < 8; o++) {
          const int j = i - o;
          if (j >= 0 && j <= 30) {
            const pg8::f32x4 w4 = *(const LAS pg8::f32x4*)(cwl + j * 256 + lane * 4);
            acc[o].x += g4.x * w4[0]; acc[o].y += g4.y * w4[1];
            acc[o].z += g4.z * w4[2]; acc[o].w += g4.w * w4[3];
          }
        }
      }
    }
#pragma unroll
    for (int o = 0; o < 8; o++) {
      const float4 a = acc[o];
      const float mean = wsum(a.x + a.y + a.z + a.w) * (1.0f / 256.f);
      const float dx = a.x - mean, dy = a.y - mean, dz = a.z - mean, dw = a.w - mean;
      const float var = wsum(dx * dx + dy * dy + dz * dz + dw * dw) * (1.0f / 256.f);
      const float rs = rsqrtf(var + EPSF);
      float4 s;
      s.x = dx * rs * lg.x + lb.x; s.y = dy * rs * lg.y + lb.y;
      s.z = dz * rs * lg.z + lb.z; s.w = dw * rs * lg.w + lb.w;
      s.x = s.x * sigmoidf_(s.x); s.y = s.y * sigmoidf_(s.y);
      s.z = s.z * sigmoidf_(s.z); s.w = s.w * sigmoidf_(s.w);
      const float ss = wsum(s.x * s.x + s.y * s.y + s.z * s.z + s.w * s.w) * (1.0f / 256.f);
      const float r2 = rsqrtf(ss + EPSF);
      uint2 pk; pk.x = pk2(s.x * r2 * gg.x, s.y * r2 * gg.y); pk.y = pk2(s.z * r2 * gg.z, s.w * r2 * gg.w);
      ((uint2*)(y + (size_t)(tok0 + o) * DM))[lane] = pk;
    }
  }
}

typedef short bf16x8_t __attribute__((ext_vector_type(8)));
typedef float f32x16_t __attribute__((ext_vector_type(16)));
#define MFMA_PAD() do { __builtin_amdgcn_sched_barrier(0); asm volatile("s_nop 15\n\ts_nop 15" ::: "memory"); __builtin_amdgcn_sched_barrier(0); } while (0)

__device__ __forceinline__ void attn_phase(const int wave_s, const Params& p, int l, const bf16* proj, bf16* y, LAS float* smem) {
  const int tid = opaque_tid(wave_s), lane = tid & 63, wave = tid >> 6;
  const int n = lane & 31, hh = lane >> 5;
  const float* gg = karg_in(18) + l * 1024 + 256 + wave * 64;
  const float g0 = gg[n], g1 = gg[32 + n];
  LAS float* ssq = smem;
  LAS float* rstd = smem + 256;
  for (int item = blockIdx.x; item < 4 * 128; item += gridDim.x) {
    const int b = item >> 7, q0 = (item & 127) * 32;
    const size_t tokb = (size_t)b * SEQ;
    bf16x8_t qf[4];
    {
      const bf16* qrow = proj + (tokb + q0 + n) * DIN + 512 + wave * 64 + 8 * hh;
#pragma unroll
      for (int ks = 0; ks < 4; ks++) qf[ks] = *(const bf16x8_t*)(qrow + 16 * ks);
    }
    f32x16_t o0, o1;
#pragma unroll
    for (int r = 0; r < 16; r++) { o0[r] = 0.f; o1[r] = 0.f; }
    float R = 0.f;
    for (int kt = q0; kt >= 0; kt -= 32) {
      bf16x8_t kf[4];
      {
        const bf16* krow = proj + (tokb + kt + n) * DIN + 1024 + wave * 64 + 8 * hh;
#pragma unroll
        for (int ks = 0; ks < 4; ks++) kf[ks] = *(const bf16x8_t*)(krow + 16 * ks);
      }
      bf16x8_t vf0[2], vf1[2];
      {
        const bf16* vb = proj + (tokb + kt + 4 * hh) * DIN + 1536 + wave * 64 + n;
#pragma unroll
        for (int s = 0; s < 2; s++)
#pragma unroll
          for (int j = 0; j < 8; j++) {
            const int key = 16 * s + 8 * (j >> 2) + (j & 3);
            vf0[s][j] = (short)vb[(size_t)key * DIN];
            vf1[s][j] = (short)vb[(size_t)key * DIN + 32];
          }
      }
      f32x16_t sacc;
#pragma unroll
      for (int r = 0; r < 16; r++) sacc[r] = 0.f;
      __builtin_amdgcn_sched_barrier(0); asm volatile("s_nop 15\n\ts_nop 15" ::: "memory"); __builtin_amdgcn_sched_barrier(0);
#pragma unroll
      for (int ks = 0; ks < 4; ks++) sacc = __builtin_amdgcn_mfma_f32_32x32x16_bf16(kf[ks], qf[ks], sacc, 0, 0, 0);
      __builtin_amdgcn_sched_barrier(0); asm volatile("s_nop 15\n\ts_nop 15" ::: "memory"); __builtin_amdgcn_sched_barrier(0);
      float lst[16], lsz[16];
      const bool diag = (kt == q0);
#pragma unroll
      for (int r = 0; r < 16; r++) {
        const float z = sacc[r] * 0.125f;
        const float sp = __logf(1.0f + __expf(-fabsf(z)));
        float a = fminf(z, 0.f) - sp;
        float c = -(fmaxf(z, 0.f) + sp);
        if (diag) {
          const int key = (r & 3) + 8 * (r >> 2) + 4 * hh;
          if (key >= n) { a = -1.0e30f; c = 0.f; }
        }
        lsz[r] = a; lst[r] = c;
      }
      float Gs[4], Gp[4];
#pragma unroll
      for (int g = 0; g < 4; g++) {
        Gs[g] = (lst[4 * g] + lst[4 * g + 1]) + (lst[4 * g + 2] + lst[4 * g + 3]);
        Gp[g] = __shfl_xor(Gs[g], 32, 64);
      }
      float carry[4];
      {
        float after = R;
#pragma unroll
        for (int g = 3; g >= 0; g--) {
          carry[g] = after + (hh ? 0.f : Gp[g]);
          after += Gs[g] + Gp[g];
        }
        R = after;
      }
      bf16x8_t pf[2];
#pragma unroll
      for (int g = 0; g < 4; g++) {
        float run = carry[g];
        float a3 = __expf(lsz[4 * g + 3] + run); run += lst[4 * g + 3];
        float a2 = __expf(lsz[4 * g + 2] + run); run += lst[4 * g + 2];
        float a1 = __expf(lsz[4 * g + 1] + run); run += lst[4 * g + 1];
        float a0 = __expf(lsz[4 * g + 0] + run);
        const int s = g >> 1, jb = (g & 1) * 4;
        pf[s][jb + 0] = (short)f2bf(a0); pf[s][jb + 1] = (short)f2bf(a1);
        pf[s][jb + 2] = (short)f2bf(a2); pf[s][jb + 3] = (short)f2bf(a3);
      }
      __builtin_amdgcn_sched_barrier(0); asm volatile("s_nop 15\n\ts_nop 15" ::: "memory"); __builtin_amdgcn_sched_barrier(0);
#pragma unroll
      for (int s = 0; s < 2; s++) {
        o0 = __builtin_amdgcn_mfma_f32_32x32x16_bf16(pf[s], vf0[s], o0, 0, 0, 0);
        o1 = __builtin_amdgcn_mfma_f32_32x32x16_bf16(pf[s], vf1[s], o1, 0, 0, 0);
      }
      __builtin_amdgcn_sched_barrier(0); asm volatile("s_nop 15\n\ts_nop 15" ::: "memory"); __builtin_amdgcn_sched_barrier(0);
      if (__all(R < -110.f)) break;
    }
    float sq[16];
#pragma unroll
    for (int r = 0; r < 16; r++) {
      float v = o0[r] * o0[r] + o1[r] * o1[r];
#pragma unroll
      for (int o = 16; o > 0; o >>= 1) v += __shfl_xor(v, o, 64);
      sq[r] = v;
    }
    __syncthreads();
    if (n == 0) {
#pragma unroll
      for (int r = 0; r < 16; r++) ssq[wave * 32 + (r & 3) + 8 * (r >> 2) + 4 * hh] = sq[r];
    }
    __syncthreads();
    if (tid < 32) {
      float t = 0.f;
#pragma unroll
      for (int w = 0; w < 8; w++) t += ssq[w * 32 + tid];
      rstd[tid] = rsqrtf(t * (1.0f / 512.f) + EPSF);
    }
    __syncthreads();
#pragma unroll
    for (int r = 0; r < 16; r++) {
      const int qi = (r & 3) + 8 * (r >> 2) + 4 * hh;
      const float rs = rstd[qi];
      bf16* yr = y + (tokb + q0 + qi) * DM + 256 + wave * 64 + n;
      yr[0] = (bf16)f2bf(o0[r] * rs * g0);
      yr[32] = (bf16)f2bf(o1[r] * rs * g1);
    }
  }
}

#define SSM_BCAST_U(u, ua, ub, tt) do { \
    const unsigned w0 = (unsigned)__builtin_amdgcn_readlane((int)(ua).x, (tt)), w1 = (unsigned)__builtin_amdgcn_readlane((int)(ua).y, (tt)); \
    const unsigned w2 = (unsigned)__builtin_amdgcn_readlane((int)(ua).z, (tt)), w3 = (unsigned)__builtin_amdgcn_readlane((int)(ua).w, (tt)); \
    const unsigned w4 = (unsigned)__builtin_amdgcn_readlane((int)(ub).x, (tt)), w5 = (unsigned)__builtin_amdgcn_readlane((int)(ub).y, (tt)); \
    const unsigned w6 = (unsigned)__builtin_amdgcn_readlane((int)(ub).z, (tt)), w7 = (unsigned)__builtin_amdgcn_readlane((int)(ub).w, (tt)); \
    (u)[0] = bf_lo(w0); (u)[1] = bf_hi(w0); (u)[2] = bf_lo(w1); (u)[3] = bf_hi(w1); (u)[4] = bf_lo(w2); (u)[5] = bf_hi(w2); (u)[6] = bf_lo(w3); (u)[7] = bf_hi(w3); \
    (u)[8] = bf_lo(w4); (u)[9] = bf_hi(w4); (u)[10] = bf_lo(w5); (u)[11] = bf_hi(w5); (u)[12] = bf_lo(w6); (u)[13] = bf_hi(w6); (u)[14] = bf_lo(w7); (u)[15] = bf_hi(w7); } while (0)
#define SSM_RS 592
#define SSM_TILE_BASE 36864
#define SSM_TILE_BYTES (16 * SSM_RS)
typedef float f32x2_t __attribute__((ext_vector_type(2)));
__device__ __forceinline__ void ssm_load_bop(const float* ssmp, int g, int lane, bf16x8_t (&bop)[8]) {
  const int q = lane >> 4, n = lane & 15;
  float v[8][8];
#pragma unroll
  for (int j = 0; j < 8; j++) {
    const float4* rp = (const float4*)(ssmp + 4096 + (size_t)(g * 16 + ((8 * q + j) & 15)) * 128 + 8 * n);
    const float4 a = rp[0], b = rp[1];
    v[j][0] = a.x; v[j][1] = a.y; v[j][2] = a.z; v[j][3] = a.w; v[j][4] = b.x; v[j][5] = b.y; v[j][6] = b.z; v[j][7] = b.w;
  }
#pragma unroll
  for (int nt = 0; nt < 8; nt++) {
    pg8::u32x4 w;
    w.x = pk2(v[0][nt], v[1][nt]); w.y = pk2(v[2][nt], v[3][nt]); w.z = pk2(v[4][nt], v[5][nt]); w.w = pk2(v[6][nt], v[7][nt]);
    if (q >= 2) { w.x = 0u; w.y = 0u; w.z = 0u; w.w = 0u; }
    bop[nt] = __builtin_bit_cast(bf16x8_t, w);
  }
}
__device__ __forceinline__ void ssm_bu_block(LAS unsigned char* xt, int lane, int blk, const uint4& ua, const uint4& ub, const bf16x8_t (&bop)[8]) {
  const int q = lane >> 4, n = lane & 15;
  if (q == blk) {
    pg8::u32x4 w0, w1;
    w0.x = ua.x; w0.y = ua.y; w0.z = ua.z; w0.w = ua.w; w1.x = ub.x; w1.y = ub.y; w1.z = ub.z; w1.w = ub.w;
    LAS pg8::u32x4* ur = (LAS pg8::u32x4*)(xt + n * SSM_RS + 512);
    ur[0] = w0; ur[1] = w1;
  }
  __builtin_amdgcn_wave_barrier();
  const bf16x8_t uop = *(const LAS bf16x8_t*)(xt + n * SSM_RS + 512 + q * 16);
  pg8::f32x4 bacc[8];
#pragma unroll
  for (int nt = 0; nt < 8; nt++) {
    pg8::f32x4 z4; z4[0] = 0.f; z4[1] = 0.f; z4[2] = 0.f; z4[3] = 0.f;
    bacc[nt] = __builtin_amdgcn_mfma_f32_16x16x32_bf16(uop, bop[nt], z4, 0, 0, 0);
  }
#pragma unroll
  for (int j = 0; j < 4; j++) {
    pg8::f32x4 w0, w1;
    w0[0] = bacc[0][j]; w0[1] = bacc[1][j]; w0[2] = bacc[2][j]; w0[3] = bacc[3][j];
    w1[0] = bacc[4][j]; w1[1] = bacc[5][j]; w1[2] = bacc[6][j]; w1[3] = bacc[7][j];
    LAS pg8::f32x4* dr = (LAS pg8::f32x4*)(xt + (4 * q + j) * SSM_RS + 32 * n);
    dr[0] = w0; dr[1] = w1;
  }
  __builtin_amdgcn_wave_barrier();
}
__device__ __forceinline__ void ssm_zero_pad(LAS unsigned char* xt, int lane) {
  if (lane < 16) {
    pg8::u32x4 z4; z4.x = 0u; z4.y = 0u; z4.z = 0u; z4.w = 0u;
    LAS pg8::u32x4* zr = (LAS pg8::u32x4*)(xt + lane * SSM_RS + 544);
    zr[0] = z4; zr[1] = z4;
  }
}
__device__ __forceinline__ void ssm_chunk_end(const int wave_s, const float* ssmp, const bf16* proj, float* ssmE, LAS float* smem) {
  const int tid_ = opaque_tid(wave_s);
  const int lane = tid_ & 63;
  const int gw = blockIdx.x * NWAVES + (tid_ >> 6);
  const int nw = gridDim.x * NWAVES;
  for (int it = gw; it < 4 * 64 * 16; it += nw) {
    const int g = it & 15, c = (it >> 4) & 63, b = it >> 10;
    const int gp = g * 64 + lane;
    const uint4* up = (const uint4*)(proj + (size_t)(b * SEQ + c * 64 + lane) * DIN + 2048 + g * 16);
    const uint4 ua = up[0], ub = up[1];
    const float lbr = ssmp[gp * 2], lbi = ssmp[gp * 2 + 1];
    bf16x8_t bop[8];
    ssm_load_bop(ssmp, g, lane, bop);
    LAS unsigned char* xt = (LAS unsigned char*)smem + SSM_TILE_BASE + (tid_ >> 6) * SSM_TILE_BYTES;
    ssm_zero_pad(xt, lane);
    float xr = 0.f, xi = 0.f;
#pragma unroll 1
    for (int blk = 0; blk < 4; blk++) {
      ssm_bu_block(xt, lane, blk, ua, ub, bop);
#pragma unroll 4
      for (int tt = 0; tt < 16; tt++) {
        const f32x2_t bu = *(const LAS f32x2_t*)(xt + tt * SSM_RS + lane * 8);
        const float nr = lbr * xr - lbi * xi + bu[0];
        const float ni = lbr * xi + lbi * xr + bu[1];
        xr = nr; xi = ni;
      }
      __builtin_amdgcn_wave_barrier();
    }
    float* e = ssmE + ((size_t)((b * 64 + c) * 16 + g) * 64 + lane) * 2;
    e[0] = xr; e[1] = xi;
  }
}

__device__ __forceinline__ void ssm_finish(const int wave_s, const Params& p, int l, const float* ssmp, const bf16* proj,
                           const float* ssmE, bf16* y, LAS float* smem) {
  LAS bf16* Ytb = (LAS bf16*)smem;
  LAS float* ssq2 = smem + (64 * 264 * 2) / 4;
  LAS float* rstd2 = ssq2 + 512;
  const bf16* glT = (const bf16*)(p.ws + WS_WT + (size_t)l * WT_LAYER + WT_GLU);
  const int tid = opaque_tid(wave_s), lane = tid & 63, wave = tid >> 6;
  const float* cre = karg_in(13) + (size_t)l * 16 * 16 * 64;
  const float* cim = karg_in(14) + (size_t)l * 16 * 16 * 64;
  const float* dsk = karg_in(15) + l * 256;
  const float* glw = karg_in(16) + (size_t)l * 256 * 256;
  const float* glb = karg_in(17) + l * 256;
  const float* gg = karg_in(18) + l * 1024 + 768;
  for (int it = blockIdx.x; it < 256; it += gridDim.x) {
    const int b = it >> 6, c = it & 63;
    __syncthreads();
    for (int gi = 0; gi < 2; gi++) {
      const int g = wave + gi * 8;
      const int gp = g * 64 + lane;
      const float lbr = ssmp[gp * 2], lbi = ssmp[gp * 2 + 1];
      const float lcr = ssmp[2048 + gp * 2], lci = ssmp[2048 + gp * 2 + 1];
      bf16x8_t bop[8];
      ssm_load_bop(ssmp, g, lane, bop);
      bf16x8_t cop[5];
      {
        const int nn = lane & 15, q = lane >> 4;
#pragma unroll
        for (int ks = 0; ks < 4; ks++) {
          const float4 cr4 = *(const float4*)(cre + (g * 16 + nn) * 64 + 16 * ks + 4 * q);
          const float4 ci4 = *(const float4*)(cim + (g * 16 + nn) * 64 + 16 * ks + 4 * q);
          pg8::u32x4 w;
          w.x = pk2(cr4.x, -ci4.x); w.y = pk2(cr4.y, -ci4.y); w.z = pk2(cr4.z, -ci4.z); w.w = pk2(cr4.w, -ci4.w);
          cop[ks] = __builtin_bit_cast(bf16x8_t, w);
        }
        const float dn = dsk[g * 16 + nn];
        float dv[8];
#pragma unroll
        for (int j = 0; j < 8; j++) dv[j] = (8 * q + j == nn) ? dn : 0.f;
        pg8::u32x4 w;
        w.x = pk2(dv[0], dv[1]); w.y = pk2(dv[2], dv[3]); w.z = pk2(dv[4], dv[5]); w.w = pk2(dv[6], dv[7]);
        cop[4] = __builtin_bit_cast(bf16x8_t, w);
      }
      const uint4* up = (const uint4*)(proj + (size_t)(b * SEQ + c * 64 + lane) * DIN + 2048 + g * 16);
      const uint4 ua = up[0], ub = up[1];
      float xr = 0.f, xi = 0.f;
      {
        const float2* eb = (const float2*)ssmE + ((size_t)(b * 64) * 16 + g) * 64 + lane;
        for (int cc = 0; cc < c; cc += 16) {
          float2 ev[16];
#pragma unroll
          for (int k = 0; k < 16; k++) ev[k] = eb[(size_t)(cc + k < c ? cc + k : c - 1) * 16 * 64];
#pragma unroll
          for (int k = 0; k < 16; k++) {
            if (cc + k < c) {
              const float nr = lcr * xr - lci * xi + ev[k].x;
              const float ni = lcr * xi + lci * xr + ev[k].y;
              xr = nr; xi = ni;
            }
          }
        }
      }
      LAS unsigned char* xt = (LAS unsigned char*)smem + SSM_TILE_BASE + wave * SSM_TILE_BYTES;
      ssm_zero_pad(xt, lane);
#pragma unroll 1
      for (int blk = 0; blk < 4; blk++) {
        ssm_bu_block(xt, lane, blk, ua, ub, bop);
#pragma unroll 4
        for (int tt = 0; tt < 16; tt++) {
          const f32x2_t bu = *(const LAS f32x2_t*)(xt + tt * SSM_RS + lane * 8);
          const float nr = lbr * xr - lbi * xi + bu[0];
          const float ni = lbr * xi + lbi * xr + bu[1];
          xr = nr; xi = ni;
          *(LAS unsigned*)(xt + tt * SSM_RS + lane * 4) = pk2(xr, xi);
        }
        __builtin_amdgcn_wave_barrier();
        {
          pg8::f32x4 acc4;
          acc4[0] = 0.f; acc4[1] = 0.f; acc4[2] = 0.f; acc4[3] = 0.f;
          const LAS unsigned char* ar = xt + (lane & 15) * SSM_RS + (lane >> 4) * 16;
#pragma unroll
          for (int ks = 0; ks < 4; ks++)
            acc4 = __builtin_amdgcn_mfma_f32_16x16x32_bf16(*(const LAS bf16x8_t*)(ar + ks * 64), cop[ks], acc4, 0, 0, 0);
          acc4 = __builtin_amdgcn_mfma_f32_16x16x32_bf16(*(const LAS bf16x8_t*)(ar + 512), cop[4], acc4, 0, 0, 0);
#pragma unroll
          for (int j = 0; j < 4; j++)
            Ytb[(blk * 16 + 4 * (lane >> 4) + j) * 264 + g * 16 + (lane & 15)] = (bf16)f2bf(gelu_tanh(acc4[j]));
        }
        __builtin_amdgcn_wave_barrier();
      }
    }
    __syncthreads();
    {
      const int n = lane & 31, hh = lane >> 5;
      const int ch = wave * 32 + n;
      const float bj = glb[ch];
      const float gj = gg[ch];
      bf16x8_t gf[16];
      {
        const bf16* grow = glT + (size_t)ch * 256 + 8 * hh;
#pragma unroll
        for (int ks = 0; ks < 16; ks++) gf[ks] = *(const bf16x8_t*)(grow + 16 * ks);
      }
      float oo[2][16];
#pragma unroll
      for (int mt = 0; mt < 2; mt++) {
        f32x16_t z;
#pragma unroll
        for (int r = 0; r < 16; r++) z[r] = 0.f;
        const LAS bf16* yrow = Ytb + (mt * 32 + n) * 264 + 8 * hh;
#pragma unroll
        for (int kq = 0; kq < 4; kq++) {
          bf16x8_t yf[4];
#pragma unroll
          for (int i = 0; i < 4; i++) yf[i] = *(const LAS bf16x8_t*)(yrow + 16 * (kq * 4 + i));
          MFMA_PAD();
#pragma unroll
          for (int i = 0; i < 4; i++) z = __builtin_amdgcn_mfma_f32_32x32x16_bf16(yf[i], gf[kq * 4 + i], z, 0, 0, 0);
          MFMA_PAD();
        }
        float sq[16];
#pragma unroll
        for (int r = 0; r < 16; r++) {
          const int t = mt * 32 + (r & 3) + 8 * (r >> 2) + 4 * hh;
          const float yv = bf2f(Ytb[t * 264 + ch]);
          const float o = yv * sigmoidf_(z[r] + bj);
          oo[mt][r] = o;
          float v = o * o;
#pragma unroll
          for (int s = 16; s > 0; s >>= 1) v += __shfl_xor(v, s, 64);
          sq[r] = v;
        }
        if (n == 0) {
#pragma unroll
          for (int r = 0; r < 16; r++) ssq2[wave * 64 + mt * 32 + (r & 3) + 8 * (r >> 2) + 4 * hh] = sq[r];
        }
      }
      __syncthreads();
      if (tid < 64) {
        float t = 0.f;
#pragma unroll
        for (int w = 0; w < 8; w++) t += ssq2[w * 64 + tid];
        rstd2[tid] = rsqrtf(t * (1.0f / 256.f) + EPSF);
      }
      __syncthreads();
#pragma unroll
      for (int mt = 0; mt < 2; mt++)
#pragma unroll
        for (int r = 0; r < 16; r++) {
          const int t = mt * 32 + (r & 3) + 8 * (r >> 2) + 4 * hh;
          y[(size_t)(b * SEQ + c * 64 + t) * DM + 768 + ch] = (bf16)f2bf(oo[mt][r] * rstd2[t] * gj);
        }
    }
  }
}

__device__ __forceinline__ void memattn_phase(const int wave_s, const bf16* q, const bf16* kvb, const bf16* vT, bf16* o, LAS float* smem) {
  const int tid_ = opaque_tid(wave_s);
  const int lane = tid_ & 63, n = lane & 31, hh = lane >> 5, wave = tid_ >> 6;
  const int sig = (n & 0x13) | ((n & 4) << 1) | ((n & 8) >> 1);
  LAS bf16* Ls = (LAS bf16*)smem;
  for (int it = blockIdx.x; it < 64 * 4; it += gridDim.x) {
    const int h = it & 3, tg = it >> 2, b = tg >> 4;
    const int tok0 = (tg * 8 + wave) * 32;
    __syncthreads();
    {
      const int r = tid_ >> 1, hf = tid_ & 1;
      const pg8::u32x4* src4 = (const pg8::u32x4*)(kvb + (size_t)(b * NMEM + r) * 2048 + h * 256 + hf * 128);
      LAS pg8::u32x4* dst4 = (LAS pg8::u32x4*)(Ls + r * 264 + hf * 128);
#pragma unroll
      for (int k = 0; k < 16; k++) dst4[k] = src4[k];
    }
    f32x16_t st[8];
#pragma unroll
    for (int kt = 0; kt < 8; kt++)
#pragma unroll
      for (int r = 0; r < 16; r++) st[kt][r] = 0.f;
    const bf16* qrow = q + (size_t)(tok0 + n) * DM + h * 256 + 8 * hh;
    __syncthreads();
#pragma unroll
    for (int kq = 0; kq < 4; kq++) {
      bf16x8_t qf[4];
#pragma unroll
      for (int i = 0; i < 4; i++) qf[i] = *(const bf16x8_t*)(qrow + 16 * (kq * 4 + i));
#pragma unroll
      for (int kt = 0; kt < 8; kt++) {
        const LAS bf16* krow = Ls + (kt * 32 + sig) * 264 + 8 * hh;
        bf16x8_t kf[4];
#pragma unroll
        for (int i = 0; i < 4; i++) kf[i] = *(const LAS bf16x8_t*)(krow + 16 * (kq * 4 + i));
        MFMA_PAD();
#pragma unroll
        for (int i = 0; i < 4; i++) st[kt] = __builtin_amdgcn_mfma_f32_32x32x16_bf16(kf[i], qf[i], st[kt], 0, 0, 0);
        MFMA_PAD();
      }
    }
    float mx = st[0][0];
#pragma unroll
    for (int kt = 0; kt < 8; kt++)
#pragma unroll
      for (int r = 0; r < 16; r++) mx = fmaxf(mx, st[kt][r]);
    mx = fmaxf(mx, __shfl_xor(mx, 32, 64));
    float sum = 0.f;
#pragma unroll
    for (int kt = 0; kt < 8; kt++)
#pragma unroll
      for (int r = 0; r < 16; r++) { const float e = __expf((st[kt][r] - mx) * 0.0625f); st[kt][r] = e; sum += e; }
    sum += __shfl_xor(sum, 32, 64);
    const float inv = 1.0f / sum;
    bf16x8_t pf[8][2];
#pragma unroll
    for (int kt = 0; kt < 8; kt++)
#pragma unroll
      for (int s = 0; s < 2; s++)
#pragma unroll
        for (int j = 0; j < 8; j++) pf[kt][s][j] = (short)f2bf(st[kt][8 * s + j] * inv);
    __syncthreads();
    {
      const int r = tid_ >> 1, hf = tid_ & 1;
      const pg8::u32x4* src4 = (const pg8::u32x4*)(vT + ((size_t)(b * 4 + h) * 256 + r) * 256 + hf * 128);
      LAS pg8::u32x4* dst4 = (LAS pg8::u32x4*)(Ls + r * 264 + hf * 128);
#pragma unroll
      for (int k = 0; k < 16; k++) dst4[k] = src4[k];
    }
    __syncthreads();
#pragma unroll 1
    for (int dt = 0; dt < 8; dt++) {
      f32x16_t oacc;
#pragma unroll
      for (int r = 0; r < 16; r++) oacc[r] = 0.f;
      const LAS bf16* vrow = Ls + (dt * 32 + n) * 264 + 8 * hh;
#pragma unroll
      for (int kq = 0; kq < 4; kq++) {
        bf16x8_t vf[4];
#pragma unroll
        for (int i = 0; i < 4; i++) vf[i] = *(const LAS bf16x8_t*)(vrow + (kq * 2 + (i >> 1)) * 32 + 16 * (i & 1));
        MFMA_PAD();
#pragma unroll
        for (int i = 0; i < 4; i++) oacc = __builtin_amdgcn_mfma_f32_32x32x16_bf16(pf[kq * 2 + (i >> 1)][i & 1], vf[i], oacc, 0, 0, 0);
        MFMA_PAD();
      }
#pragma unroll
      for (int r = 0; r < 16; r++) {
        const int qi = (r & 3) + 8 * (r >> 2) + 4 * hh;
        o[(size_t)(tok0 + qi) * DM + h * 256 + dt * 32 + n] = (bf16)f2bf(oacc[r]);
      }
    }
  }
}

__device__ __forceinline__ void vt_phase(const int wave_s, const bf16* kvb, bf16* vT) {
  const int tid_ = opaque_tid(wave_s);
  const int gt = blockIdx.x * (NWAVES * 64) + tid_;
  const int nth = gridDim.x * NWAVES * 64;
  for (int i = gt; i < 2 * 4 * 4 * 256 * 256; i += nth) {
    const int m = i & 255, d = (i >> 8) & 255, h = (i >> 16) & 3, b = (i >> 18) & 3, l = i >> 20;
    vT[i] = kvb[((size_t)l * 1024 + b * 256 + m) * 2048 + 1024 + h * 256 + d];
  }
}

template <unsigned MASK>
__device__ __forceinline__ float pack_key(float s, unsigned idx) {
  const unsigned u = __builtin_bit_cast(unsigned, s);
  const unsigned tag = ((int)u < 0) ? idx : (MASK - idx);
  return __builtin_bit_cast(float, (u & ~MASK) + tag);
}
template <unsigned MASK>
__device__ __forceinline__ unsigned key_idx(float k) {
  const unsigned u = __builtin_bit_cast(unsigned, k);
  const unsigned tag = u & MASK;
  return ((int)u < 0) ? tag : (MASK - tag);
}
template <unsigned MASK>
__device__ __forceinline__ float key_val(float k) { return __builtin_bit_cast(float, __builtin_bit_cast(unsigned, k) & ~MASK); }
__device__ __forceinline__ void top16_of_64(float (&K)[64]) {
  { const float a_ = K[0], b_ = K[1]; const bool g_ = a_ > b_; K[0] = g_ ? a_ : b_; K[1] = g_ ? b_ : a_; }
  { const float a_ = K[2], b_ = K[3]; const bool g_ = a_ > b_; K[2] = g_ ? b_ : a_; K[3] = g_ ? a_ : b_; }
  { const float a_ = K[4], b_ = K[5]; const bool g_ = a_ > b_; K[4] = g_ ? a_ : b_; K[5] = g_ ? b_ : a_; }
  { const float a_ = K[6], b_ = K[7]; const bool g_ = a_ > b_; K[6] = g_ ? b_ : a_; K[7] = g_ ? a_ : b_; }
  { const float a_ = K[8], b_ = K[9]; const bool g_ = a_ > b_; K[8] = g_ ? a_ : b_; K[9] = g_ ? b_ : a_; }
  { const float a_ = K[10], b_ = K[11]; const bool g_ = a_ > b_; K[10] = g_ ? b_ : a_; K[11] = g_ ? a_ : b_; }
  { const float a_ = K[12], b_ = K[13]; const bool g_ = a_ > b_; K[12] = g_ ? a_ : b_; K[13] = g_ ? b_ : a_; }
  { const float a_ = K[14], b_ = K[15]; const bool g_ = a_ > b_; K[14] = g_ ? b_ : a_; K[15] = g_ ? a_ : b_; }
  { const float a_ = K[0], b_ = K[2]; const bool g_ = a_ > b_; K[0] = g_ ? a_ : b_; K[2] = g_ ? b_ : a_; }
  { const float a_ = K[1], b_ = K[3]; const bool g_ = a_ > b_; K[1] = g_ ? a_ : b_; K[3] = g_ ? b_ : a_; }
  { const float a_ = K[4], b_ = K[6]; const bool g_ = a_ > b_; K[4] = g_ ? b_ : a_; K[6] = g_ ? a_ : b_; }
  { const float a_ = K[5], b_ = K[7]; const bool g_ = a_ > b_; K[5] = g_ ? b_ : a_; K[7] = g_ ? a_ : b_; }
  { const float a_ = K[8], b_ = K[10]; const bool g_ = a_ > b_; K[8] = g_ ? a_ : b_; K[10] = g_ ? b_ : a_; }
  { const float a_ = K[9], b_ = K[11]; const bool g_ = a_ > b_; K[9] = g_ ? a_ : b_; K[11] = g_ ? b_ : a_; }
  { const float a_ = K[12], b_ = K[14]; const bool g_ = a_ > b_; K[12] = g_ ? b_ : a_; K[14] = g_ ? a_ : b_; }
  { const float a_ = K[13], b_ = K[15]; const bool g_ = a_ > b_; K[13] = g_ ? b_ : a_; K[15] = g_ ? a_ : b_; }
  { const float a_ = K[0], b_ = K[1]; const bool g_ = a_ > b_; K[0] = g_ ? a_ : b_; K[1] = g_ ? b_ : a_; }
  { const float a_ = K[2], b_ = K[3]; const bool g_ = a_ > b_; K[2] = g_ ? a_ : b_; K[3] = g_ ? b_ : a_; }
  { const float a_ = K[4], b_ = K[5]; const bool g_ = a_ > b_; K[4] = g_ ? b_ : a_; K[5] = g_ ? a_ : b_; }
  { const float a_ = K[6], b_ = K[7]; const bool g_ = a_ > b_; K[6] = g_ ? b_ : a_; K[7] = g_ ? a_ : b_; }
  { const float a_ = K[8], b_ = K[9]; const bool g_ = a_ > b_; K[8] = g_ ? a_ : b_; K[9] = g_ ? b_ : a_; }
  { const float a_ = K[10], b_ = K[11]; const bool g_ = a_ > b_; K[10] = g_ ? a_ : b_; K[11] = g_ ? b_ : a_; }
  { const float a_ = K[12], b_ = K[13]; const bool g_ = a_ > b_; K[12] = g_ ? b_ : a_; K[13] = g_ ? a_ : b_; }
  { const float a_ = K[14], b_ = K[15]; const bool g_ = a_ > b_; K[14] = g_ ? b_ : a_; K[15] = g_ ? a_ : b_; }
  { const float a_ = K[0], b_ = K[4]; const bool g_ = a_ > b_; K[0] = g_ ? a_ : b_; K[4] = g_ ? b_ : a_; }
  { const float a_ = K[1], b_ = K[5]; const bool g_ = a_ > b_; K[1] = g_ ? a_ : b_; K[5] = g_ ? b_ : a_; }
  { const float a_ = K[2], b_ = K[6]; const bool g_ = a_ > b_; K[2] = g_ ? a_ : b_; K[6] = g_ ? b_ : a_; }
  { const float a_ = K[3], b_ = K[7]; const bool g_ = a_ > b_; K[3] = g_ ? a_ : b_; K[7] = g_ ? b_ : a_; }
  { const float a_ = K[8], b_ = K[12]; const bool g_ = a_ > b_; K[8] = g_ ? b_ : a_; K[12] = g_ ? a_ : b_; }
  { const float a_ = K[9], b_ = K[13]; const bool g_ = a_ > b_; K[9] = g_ ? b_ : a_; K[13] = g_ ? a_ : b_; }
  { const float a_ = K[10], b_ = K[14]; const bool g_ = a_ > b_; K[10] = g_ ? b_ : a_; K[14] = g_ ? a_ : b_; }
  { const float a_ = K[11], b_ = K[15]; const bool g_ = a_ > b_; K[11] = g_ ? b_ : a_; K[15] = g_ ? a_ : b_; }
  { const float a_ = K[0], b_ = K[2]; const bool g_ = a_ > b_; K[0] = g_ ? a_ : b_; K[2] = g_ ? b_ : a_; }
  { const float a_ = K[1], b_ = K[3]; const bool g_ = a_ > b_; K[1] = g_ ? a_ : b_; K[3] = g_ ? b_ : a_; }
  { const float a_ = K[4], b_ = K[6]; const bool g_ = a_ > b_; K[4] = g_ ? a_ : b_; K[6] = g_ ? b_ : a_; }
  { const float a_ = K[5], b_ = K[7]; const bool g_ = a_ > b_; K[5] = g_ ? a_ : b_; K[7] = g_ ? b_ : a_; }
  { const float a_ = K[8], b_ = K[10]; const bool g_ = a_ > b_; K[8] = g_ ? b_ : a_; K[10] = g_ ? a_ : b_; }
  { const float a_ = K[9], b_ = K[11]; const bool g_ = a_ > b_; K[9] = g_ ? b_ : a_; K[11] = g_ ? a_ : b_; }
  { const float a_ = K[12], b_ = K[14]; const bool g_ = a_ > b_; K[12] = g_ ? b_ : a_; K[14] = g_ ? a_ : b_; }
  { const float a_ = K[13], b_ = K[15]; const bool g_ = a_ > b_; K[13] = g_ ? b_ : a_; K[15] = g_ ? a_ : b_; }
  { const float a_ = K[0], b_ = K[1]; const bool g_ = a_ > b_; K[0] = g_ ? a_ : b_; K[1] = g_ ? b_ : a_; }
  { const float a_ = K[2], b_ = K[3]; const bool g_ = a_ > b_; K[2] = g_ ? a_ : b_; K[3] = g_ ? b_ : a_; }
  { const float a_ = K[4], b_ = K[5]; const bool g_ = a_ > b_; K[4] = g_ ? a_ : b_; K[5] = g_ ? b_ : a_; }
  { const float a_ = K[6], b_ = K[7]; const bool g_ = a_ > b_; K[6] = g_ ? a_ : b_; K[7] = g_ ? b_ : a_; }
  { const float a_ = K[8], b_ = K[9]; const bool g_ = a_ > b_; K[8] = g_ ? b_ : a_; K[9] = g_ ? a_ : b_; }
  { const float a_ = K[10], b_ = K[11]; const bool g_ = a_ > b_; K[10] = g_ ? b_ : a_; K[11] = g_ ? a_ : b_; }
  { const float a_ = K[12], b_ = K[13]; const bool g_ = a_ > b_; K[12] = g_ ? b_ : a_; K[13] = g_ ? a_ : b_; }
  { const float a_ = K[14], b_ = K[15]; const bool g_ = a_ > b_; K[14] = g_ ? b_ : a_; K[15] = g_ ? a_ : b_; }
  { const float a_ = K[0], b_ = K[8]; const bool g_ = a_ > b_; K[0] = g_ ? a_ : b_; K[8] = g_ ? b_ : a_; }
  { const float a_ = K[1], b_ = K[9]; const bool g_ = a_ > b_; K[1] = g_ ? a_ : b_; K[9] = g_ ? b_ : a_; }
  { const float a_ = K[2], b_ = K[10]; const bool g_ = a_ > b_; K[2] = g_ ? a_ : b_; K[10] = g_ ? b_ : a_; }
  { const float a_ = K[3], b_ = K[11]; const bool g_ = a_ > b_; K[3] = g_ ? a_ : b_; K[11] = g_ ? b_ : a_; }
  { const float a_ = K[4], b_ = K[12]; const bool g_ = a_ > b_; K[4] = g_ ? a_ : b_; K[12] = g_ ? b_ : a_; }
  { const float a_ = K[5], b_ = K[13]; const bool g_ = a_ > b_; K[5] = g_ ? a_ : b_; K[13] = g_ ? b_ : a_; }
  { const float a_ = K[6], b_ = K[14]; const bool g_ = a_ > b_; K[6] = g_ ? a_ : b_; K[14] = g_ ? b_ : a_; }
  { const float a_ = K[7], b_ = K[15]; const bool g_ = a_ > b_; K[7] = g_ ? a_ : b_; K[15] = g_ ? b_ : a_; }
  { const float a_ = K[0], b_ = K[4]; const bool g_ = a_ > b_; K[0] = g_ ? a_ : b_; K[4] = g_ ? b_ : a_; }
  { const float a_ = K[1], b_ = K[5]; const bool g_ = a_ > b_; K[1] = g_ ? a_ : b_; K[5] = g_ ? b_ : a_; }
  { const float a_ = K[2], b_ = K[6]; const bool g_ = a_ > b_; K[2] = g_ ? a_ : b_; K[6] = g_ ? b_ : a_; }
  { const float a_ = K[3], b_ = K[7]; const bool g_ = a_ > b_; K[3] = g_ ? a_ : b_; K[7] = g_ ? b_ : a_; }
  { const float a_ = K[8], b_ = K[12]; const bool g_ = a_ > b_; K[8] = g_ ? a_ : b_; K[12] = g_ ? b_ : a_; }
  { const float a_ = K[9], b_ = K[13]; const bool g_ = a_ > b_; K[9] = g_ ? a_ : b_; K[13] = g_ ? b_ : a_; }
  { const float a_ = K[10], b_ = K[14]; const bool g_ = a_ > b_; K[10] = g_ ? a_ : b_; K[14] = g_ ? b_ : a_; }
  { const float a_ = K[11], b_ = K[15]; const bool g_ = a_ > b_; K[11] = g_ ? a_ : b_; K[15] = g_ ? b_ : a_; }
  { const float a_ = K[0], b_ = K[2]; const bool g_ = a_ > b_; K[0] = g_ ? a_ : b_; K[2] = g_ ? b_ : a_; }
  { const float a_ = K[1], b_ = K[3]; const bool g_ = a_ > b_; K[1] = g_ ? a_ : b_; K[3] = g_ ? b_ : a_; }
  { const float a_ = K[4], b_ = K[6]; const bool g_ = a_ > b_; K[4] = g_ ? a_ : b_; K[6] = g_ ? b_ : a_; }
  { const float a_ = K[5], b_ = K[7]; const bool g_ = a_ > b_; K[5] = g_ ? a_ : b_; K[7] = g_ ? b_ : a_; }
  { const float a_ = K[8], b_ = K[10]; const bool g_ = a_ > b_; K[8] = g_ ? a_ : b_; K[10] = g_ ? b_ : a_; }
  { const float a_ = K[9], b_ = K[11]; const bool g_ = a_ > b_; K[9] = g_ ? a_ : b_; K[11] = g_ ? b_ : a_; }
  { const float a_ = K[12], b_ = K[14]; const bool g_ = a_ > b_; K[12] = g_ ? a_ : b_; K[14] = g_ ? b_ : a_; }
  { const float a_ = K[13], b_ = K[15]; const bool g_ = a_ > b_; K[13] = g_ ? a_ : b_; K[15] = g_ ? b_ : a_; }
  { const float a_ = K[0], b_ = K[1]; const bool g_ = a_ > b_; K[0] = g_ ? a_ : b_; K[1] = g_ ? b_ : a_; }
  { const float a_ = K[2], b_ = K[3]; const bool g_ = a_ > b_; K[2] = g_ ? a_ : b_; K[3] = g_ ? b_ : a_; }
  { const float a_ = K[4], b_ = K[5]; const bool g_ = a_ > b_; K[4] = g_ ? a_ : b_; K[5] = g_ ? b_ : a_; }
  { const float a_ = K[6], b_ = K[7]; const bool g_ = a_ > b_; K[6] = g_ ? a_ : b_; K[7] = g_ ? b_ : a_; }
  { const float a_ = K[8], b_ = K[9]; const bool g_ = a_ > b_; K[8] = g_ ? a_ : b_; K[9] = g_ ? b_ : a_; }
  { const float a_ = K[10], b_ = K[11]; const bool g_ = a_ > b_; K[10] = g_ ? a_ : b_; K[11] = g_ ? b_ : a_; }
  { const float a_ = K[12], b_ = K[13]; const bool g_ = a_ > b_; K[12] = g_ ? a_ : b_; K[13] = g_ ? b_ : a_; }
  { const float a_ = K[14], b_ = K[15]; const bool g_ = a_ > b_; K[14] = g_ ? a_ : b_; K[15] = g_ ? b_ : a_; }
  { const float a_ = K[16], b_ = K[17]; const bool g_ = a_ > b_; K[16] = g_ ? a_ : b_; K[17] = g_ ? b_ : a_; }
  { const float a_ = K[18], b_ = K[19]; const bool g_ = a_ > b_; K[18] = g_ ? b_ : a_; K[19] = g_ ? a_ : b_; }
  { const float a_ = K[20], b_ = K[21]; const bool g_ = a_ > b_; K[20] = g_ ? a_ : b_; K[21] = g_ ? b_ : a_; }
  { const float a_ = K[22], b_ = K[23]; const bool g_ = a_ > b_; K[22] = g_ ? b_ : a_; K[23] = g_ ? a_ : b_; }
  { const float a_ = K[24], b_ = K[25]; const bool g_ = a_ > b_; K[24] = g_ ? a_ : b_; K[25] = g_ ? b_ : a_; }
  { const float a_ = K[26], b_ = K[27]; const bool g_ = a_ > b_; K[26] = g_ ? b_ : a_; K[27] = g_ ? a_ : b_; }
  { const float a_ = K[28], b_ = K[29]; const bool g_ = a_ > b_; K[28] = g_ ? a_ : b_; K[29] = g_ ? b_ : a_; }
  { const float a_ = K[30], b_ = K[31]; const bool g_ = a_ > b_; K[30] = g_ ? b_ : a_; K[31] = g_ ? a_ : b_; }
  { const float a_ = K[16], b_ = K[18]; const bool g_ = a_ > b_; K[16] = g_ ? a_ : b_; K[18] = g_ ? b_ : a_; }
  { const float a_ = K[17], b_ = K[19]; const bool g_ = a_ > b_; K[17] = g_ ? a_ : b_; K[19] = g_ ? b_ : a_; }
  { const float a_ = K[20], b_ = K[22]; const bool g_ = a_ > b_; K[20] = g_ ? b_ : a_; K[22] = g_ ? a_ : b_; }
  { const float a_ = K[21], b_ = K[23]; const bool g_ = a_ > b_; K[21] = g_ ? b_ : a_; K[23] = g_ ? a_ : b_; }
  { const float a_ = K[24], b_ = K[26]; const bool g_ = a_ > b_; K[24] = g_ ? a_ : b_; K[26] = g_ ? b_ : a_; }
  { const float a_ = K[25], b_ = K[27]; const bool g_ = a_ > b_; K[25] = g_ ? a_ : b_; K[27] = g_ ? b_ : a_; }
  { const float a_ = K[28], b_ = K[30]; const bool g_ = a_ > b_; K[28] = g_ ? b_ : a_; K[30] = g_ ? a_ : b_; }
  { const float a_ = K[29], b_ = K[31]; const bool g_ = a_ > b_; K[29] = g_ ? b_ : a_; K[31] = g_ ? a_ : b_; }
  { const float a_ = K[16], b_ = K[17]; const bool g_ = a_ > b_; K[16] = g_ ? a_ : b_; K[17] = g_ ? b_ : a_; }
  { const float a_ = K[18], b_ = K[19]; const bool g_ = a_ > b_; K[18] = g_ ? a_ : b_; K[19] = g_ ? b_ : a_; }
  { const float a_ = K[20], b_ = K[21]; const bool g_ = a_ > b_; K[20] = g_ ? b_ : a_; K[21] = g_ ? a_ : b_; }
  { const float a_ = K[22], b_ = K[23]; const bool g_ = a_ > b_; K[22] = g_ ? b_ : a_; K[23] = g_ ? a_ : b_; }
  { const float a_ = K[24], b_ = K[25]; const bool g_ = a_ > b_; K[24] = g_ ? a_ : b_; K[25] = g_ ? b_ : a_; }
  { const float a_ = K[26], b_ = K[27]; const bool g_ = a_ > b_; K[26] = g_ ? a_ : b_; K[27] = g_ ? b_ : a_; }
  { const float a_ = K[28], b_ = K[29]; const bool g_ = a_ > b_; K[28] = g_ ? b_ : a_; K[29] = g_ ? a_ : b_; }
  { const float a_ = K[30], b_ = K[31]; const bool g_ = a_ > b_; K[30] = g_ ? b_ : a_; K[31] = g_ ? a_ : b_; }
  { const float a_ = K[16], b_ = K[20]; const bool g_ = a_ > b_; K[16] = g_ ? a_ : b_; K[20] = g_ ? b_ : a_; }
  { const float a_ = K[17], b_ = K[21]; const bool g_ = a_ > b_; K[17] = g_ ? a_ : b_; K[21] = g_ ? b_ : a_; }
  { const float a_ = K[18], b_ = K[22]; const bool g_ = a_ > b_; K[18] = g_ ? a_ : b_; K[22] = g_ ? b_ : a_; }
  { const float a_ = K[19], b_ = K[23]; const bool g_ = a_ > b_; K[19] = g_ ? a_ : b_; K[23] = g_ ? b_ : a_; }
  { const float a_ = K[24], b_ = K[28]; const bool g_ = a_ > b_; K[24] = g_ ? b_ : a_; K[28] = g_ ? a_ : b_; }
  { const float a_ = K[25], b_ = K[29]; const bool g_ = a_ > b_; K[25] = g_ ? b_ : a_; K[29] = g_ ? a_ : b_; }
  { const float a_ = K[26], b_ = K[30]; const bool g_ = a_ > b_; K[26] = g_ ? b_ : a_; K[30] = g_ ? a_ : b_; }
  { const float a_ = K[27], b_ = K[31]; const bool g_ = a_ > b_; K[27] = g_ ? b_ : a_; K[31] = g_ ? a_ : b_; }
  { const float a_ = K[16], b_ = K[18]; const bool g_ = a_ > b_; K[16] = g_ ? a_ : b_; K[18] = g_ ? b_ : a_; }
  { const float a_ = K[17], b_ = K[19]; const bool g_ = a_ > b_; K[17] = g_ ? a_ : b_; K[19] = g_ ? b_ : a_; }
  { const float a_ = K[20], b_ = K[22]; const bool g_ = a_ > b_; K[20] = g_ ? a_ : b_; K[22] = g_ ? b_ : a_; }
  { const float a_ = K[21], b_ = K[23]; const bool g_ = a_ > b_; K[21] = g_ ? a_ : b_; K[23] = g_ ? b_ : a_; }
  { const float a_ = K[24], b_ = K[26]; const bool g_ = a_ > b_; K[24] = g_ ? b_ : a_; K[26] = g_ ? a_ : b_; }
  { const float a_ = K[25], b_ = K[27]; const bool g_ = a_ > b_; K[25] = g_ ? b_ : a_; K[27] = g_ ? a_ : b_; }
  { const float a_ = K[28], b_ = K[30]; const bool g_ = a_ > b_; K[28] = g_ ? b_ : a_; K[30] = g_ ? a_ : b_; }
  { const float a_ = K[29], b_ = K[31]; const bool g_ = a_ > b_; K[29] = g_ ? b_ : a_; K[31] = g_ ? a_ : b_; }
  { const float a_ = K[16], b_ = K[17]; const bool g_ = a_ > b_; K[16] = g_ ? a_ : b_; K[17] = g_ ? b_ : a_; }
  { const float a_ = K[18], b_ = K[19]; const bool g_ = a_ > b_; K[18] = g_ ? a_ : b_; K[19] = g_ ? b_ : a_; }
  { const float a_ = K[20], b_ = K[21]; const bool g_ = a_ > b_; K[20] = g_ ? a_ : b_; K[21] = g_ ? b_ : a_; }
  { const float a_ = K[22], b_ = K[23]; const bool g_ = a_ > b_; K[22] = g_ ? a_ : b_; K[23] = g_ ? b_ : a_; }
  { const float a_ = K[24], b_ = K[25]; const bool g_ = a_ > b_; K[24] = g_ ? b_ : a_; K[25] = g_ ? a_ : b_; }
  { const float a_ = K[26], b_ = K[27]; const bool g_ = a_ > b_; K[26] = g_ ? b_ : a_; K[27] = g_ ? a_ : b_; }
  { const float a_ = K[28], b_ = K[29]; const bool g_ = a_ > b_; K[28] = g_ ? b_ : a_; K[29] = g_ ? a_ : b_; }
  { const float a_ = K[30], b_ = K[31]; const bool g_ = a_ > b_; K[30] = g_ ? b_ : a_; K[31] = g_ ? a_ : b_; }
  { const float a_ = K[16], b_ = K[24]; const bool g_ = a_ > b_; K[16] = g_ ? a_ : b_; K[24] = g_ ? b_ : a_; }
  { const float a_ = K[17], b_ = K[25]; const bool g_ = a_ > b_; K[17] = g_ ? a_ : b_; K[25] = g_ ? b_ : a_; }
  { const float a_ = K[18], b_ = K[26]; const bool g_ = a_ > b_; K[18] = g_ ? a_ : b_; K[26] = g_ ? b_ : a_; }
  { const float a_ = K[19], b_ = K[27]; const bool g_ = a_ > b_; K[19] = g_ ? a_ : b_; K[27] = g_ ? b_ : a_; }
  { const float a_ = K[20], b_ = K[28]; const bool g_ = a_ > b_; K[20] = g_ ? a_ : b_; K[28] = g_ ? b_ : a_; }
  { const float a_ = K[21], b_ = K[29]; const bool g_ = a_ > b_; K[21] = g_ ? a_ : b_; K[29] = g_ ? b_ : a_; }
  { const float a_ = K[22], b_ = K[30]; const bool g_ = a_ > b_; K[22] = g_ ? a_ : b_; K[30] = g_ ? b_ : a_; }
  { const float a_ = K[23], b_ = K[31]; const bool g_ = a_ > b_; K[23] = g_ ? a_ : b_; K[31] = g_ ? b_ : a_; }
  { const float a_ = K[16], b_ = K[20]; const bool g_ = a_ > b_; K[16] = g_ ? a_ : b_; K[20] = g_ ? b_ : a_; }
  { const float a_ = K[17], b_ = K[21]; const bool g_ = a_ > b_; K[17] = g_ ? a_ : b_; K[21] = g_ ? b_ : a_; }
  { const float a_ = K[18], b_ = K[22]; const bool g_ = a_ > b_; K[18] = g_ ? a_ : b_; K[22] = g_ ? b_ : a_; }
  { const float a_ = K[19], b_ = K[23]; const bool g_ = a_ > b_; K[19] = g_ ? a_ : b_; K[23] = g_ ? b_ : a_; }
  { const float a_ = K[24], b_ = K[28]; const bool g_ = a_ > b_; K[24] = g_ ? a_ : b_; K[28] = g_ ? b_ : a_; }
  { const float a_ = K[25], b_ = K[29]; const bool g_ = a_ > b_; K[25] = g_ ? a_ : b_; K[29] = g_ ? b_ : a_; }
  { const float a_ = K[26], b_ = K[30]; const bool g_ = a_ > b_; K[26] = g_ ? a_ : b_; K[30] = g_ ? b_ : a_; }
  { const float a_ = K[27], b_ = K[31]; const bool g_ = a_ > b_; K[27] = g_ ? a_ : b_; K[31] = g_ ? b_ : a_; }
  { const float a_ = K[16], b_ = K[18]; const bool g_ = a_ > b_; K[16] = g_ ? a_ : b_; K[18] = g_ ? b_ : a_; }
  { const float a_ = K[17], b_ = K[19]; const bool g_ = a_ > b_; K[17] = g_ ? a_ : b_; K[19] = g_ ? b_ : a_; }
  { const float a_ = K[20], b_ = K[22]; const bool g_ = a_ > b_; K[20] = g_ ? a_ : b_; K[22] = g_ ? b_ : a_; }
  { const float a_ = K[21], b_ = K[23]; const bool g_ = a_ > b_; K[21] = g_ ? a_ : b_; K[23] = g_ ? b_ : a_; }
  { const float a_ = K[24], b_ = K[26]; const bool g_ = a_ > b_; K[24] = g_ ? a_ : b_; K[26] = g_ ? b_ : a_; }
  { const float a_ = K[25], b_ = K[27]; const bool g_ = a_ > b_; K[25] = g_ ? a_ : b_; K[27] = g_ ? b_ : a_; }
  { const float a_ = K[28], b_ = K[30]; const bool g_ = a_ > b_; K[28] = g_ ? a_ : b_; K[30] = g_ ? b_ : a_; }
  { const float a_ = K[29], b_ = K[31]; const bool g_ = a_ > b_; K[29] = g_ ? a_ : b_; K[31] = g_ ? b_ : a_; }
  { const float a_ = K[16], b_ = K[17]; const bool g_ = a_ > b_; K[16] = g_ ? a_ : b_; K[17] = g_ ? b_ : a_; }
  { const float a_ = K[18], b_ = K[19]; const bool g_ = a_ > b_; K[18] = g_ ? a_ : b_; K[19] = g_ ? b_ : a_; }
  { const float a_ = K[20], b_ = K[21]; const bool g_ = a_ > b_; K[20] = g_ ? a_ : b_; K[21] = g_ ? b_ : a_; }
  { const float a_ = K[22], b_ = K[23]; const bool g_ = a_ > b_; K[22] = g_ ? a_ : b_; K[23] = g_ ? b_ : a_; }
  { const float a_ = K[24], b_ = K[25]; const bool g_ = a_ > b_; K[24] = g_ ? a_ : b_; K[25] = g_ ? b_ : a_; }
  { const float a_ = K[26], b_ = K[27]; const bool g_ = a_ > b_; K[26] = g_ ? a_ : b_; K[27] = g_ ? b_ : a_; }
  { const float a_ = K[28], b_ = K[29]; const bool g_ = a_ > b_; K[28] = g_ ? a_ : b_; K[29] = g_ ? b_ : a_; }
  { const float a_ = K[30], b_ = K[31]; const bool g_ = a_ > b_; K[30] = g_ ? a_ : b_; K[31] = g_ ? b_ : a_; }
  { const float a_ = K[32], b_ = K[33]; const bool g_ = a_ > b_; K[32] = g_ ? a_ : b_; K[33] = g_ ? b_ : a_; }
  { const float a_ = K[34], b_ = K[35]; const bool g_ = a_ > b_; K[34] = g_ ? b_ : a_; K[35] = g_ ? a_ : b_; }
  { const float a_ = K[36], b_ = K[37]; const bool g_ = a_ > b_; K[36] = g_ ? a_ : b_; K[37] = g_ ? b_ : a_; }
  { const float a_ = K[38], b_ = K[39]; const bool g_ = a_ > b_; K[38] = g_ ? b_ : a_; K[39] = g_ ? a_ : b_; }
  { const float a_ = K[40], b_ = K[41]; const bool g_ = a_ > b_; K[40] = g_ ? a_ : b_; K[41] = g_ ? b_ : a_; }
  { const float a_ = K[42], b_ = K[43]; const bool g_ = a_ > b_; K[42] = g_ ? b_ : a_; K[43] = g_ ? a_ : b_; }
  { const float a_ = K[44], b_ = K[45]; const bool g_ = a_ > b_; K[44] = g_ ? a_ : b_; K[45] = g_ ? b_ : a_; }
  { const float a_ = K[46], b_ = K[47]; const bool g_ = a_ > b_; K[46] = g_ ? b_ : a_; K[47] = g_ ? a_ : b_; }
  { const float a_ = K[32], b_ = K[34]; const bool g_ = a_ > b_; K[32] = g_ ? a_ : b_; K[34] = g_ ? b_ : a_; }
  { const float a_ = K[33], b_ = K[35]; const bool g_ = a_ > b_; K[33] = g_ ? a_ : b_; K[35] = g_ ? b_ : a_; }
  { const float a_ = K[36], b_ = K[38]; const bool g_ = a_ > b_; K[36] = g_ ? b_ : a_; K[38] = g_ ? a_ : b_; }
  { const float a_ = K[37], b_ = K[39]; const bool g_ = a_ > b_; K[37] = g_ ? b_ : a_; K[39] = g_ ? a_ : b_; }
  { const float a_ = K[40], b_ = K[42]; const bool g_ = a_ > b_; K[40] = g_ ? a_ : b_; K[42] = g_ ? b_ : a_; }
  { const float a_ = K[41], b_ = K[43]; const bool g_ = a_ > b_; K[41] = g_ ? a_ : b_; K[43] = g_ ? b_ : a_; }
  { const float a_ = K[44], b_ = K[46]; const bool g_ = a_ > b_; K[44] = g_ ? b_ : a_; K[46] = g_ ? a_ : b_; }
  { const float a_ = K[45], b_ = K[47]; const bool g_ = a_ > b_; K[45] = g_ ? b_ : a_; K[47] = g_ ? a_ : b_; }
  { const float a_ = K[32], b_ = K[33]; const bool g_ = a_ > b_; K[32] = g_ ? a_ : b_; K[33] = g_ ? b_ : a_; }
  { const float a_ = K[34], b_ = K[35]; const bool g_ = a_ > b_; K[34] = g_ ? a_ : b_; K[35] = g_ ? b_ : a_; }
  { const float a_ = K[36], b_ = K[37]; const bool g_ = a_ > b_; K[36] = g_ ? b_ : a_; K[37] = g_ ? a_ : b_; }
  { const float a_ = K[38], b_ = K[39]; const bool g_ = a_ > b_; K[38] = g_ ? b_ : a_; K[39] = g_ ? a_ : b_; }
  { const float a_ = K[40], b_ = K[41]; const bool g_ = a_ > b_; K[40] = g_ ? a_ : b_; K[41] = g_ ? b_ : a_; }
  { const float a_ = K[42], b_ = K[43]; const bool g_ = a_ > b_; K[42] = g_ ? a_ : b_; K[43] = g_ ? b_ : a_; }
  { const float a_ = K[44], b_ = K[45]; const bool g_ = a_ > b_; K[44] = g_ ? b_ : a_; K[45] = g_ ? a_ : b_; }
  { const float a_ = K[46], b_ = K[47]; const bool g_ = a_ > b_; K[46] = g_ ? b_ : a_; K[47] = g_ ? a_ : b_; }
  { const float a_ = K[32], b_ = K[36]; const bool g_ = a_ > b_; K[32] = g_ ? a_ : b_; K[36] = g_ ? b_ : a_; }
  { const float a_ = K[33], b_ = K[37]; const bool g_ = a_ > b_; K[33] = g_ ? a_ : b_; K[37] = g_ ? b_ : a_; }
  { const float a_ = K[34], b_ = K[38]; const bool g_ = a_ > b_; K[34] = g_ ? a_ : b_; K[38] = g_ ? b_ : a_; }
  { const float a_ = K[35], b_ = K[39]; const bool g_ = a_ > b_; K[35] = g_ ? a_ : b_; K[39] = g_ ? b_ : a_; }
  { const float a_ = K[40], b_ = K[44]; const bool g_ = a_ > b_; K[40] = g_ ? b_ : a_; K[44] = g_ ? a_ : b_; }
  { const float a_ = K[41], b_ = K[45]; const bool g_ = a_ > b_; K[41] = g_ ? b_ : a_; K[45] = g_ ? a_ : b_; }
  { const float a_ = K[42], b_ = K[46]; const bool g_ = a_ > b_; K[42] = g_ ? b_ : a_; K[46] = g_ ? a_ : b_; }
  { const float a_ = K[43], b_ = K[47]; const bool g_ = a_ > b_; K[43] = g_ ? b_ : a_; K[47] = g_ ? a_ : b_; }
  { const float a_ = K[32], b_ = K[34]; const bool g_ = a_ > b_; K[32] = g_ ? a_ : b_; K[34] = g_ ? b_ : a_; }
  { const float a_ = K[33], b_ = K[35]; const bool g_ = a_ > b_; K[33] = g_ ? a_ : b_; K[35] = g_ ? b_ : a_; }
  { const float a_ = K[36], b_ = K[38]; const bool g_ = a_ > b_; K[36] = g_ ? a_ : b_; K[38] = g_ ? b_ : a_; }
  { const float a_ = K[37], b_ = K[39]; const bool g_ = a_ > b_; K[37] = g_ ? a_ : b_; K[39] = g_ ? b_ : a_; }
  { const float a_ = K[40], b_ = K[42]; const bool g_ = a_ > b_; K[40] = g_ ? b_ : a_; K[42] = g_ ? a_ : b_; }
  { const float a_ = K[41], b_ = K[43]; const bool g_ = a_ > b_; K[41] = g_ ? b_ : a_; K[43] = g_ ? a_ : b_; }
  { const float a_ = K[44], b_ = K[46]; const bool g_ = a_ > b_; K[44] = g_ ? b_ : a_; K[46] = g_ ? a_ : b_; }
  { const float a_ = K[45], b_ = K[47]; const bool g_ = a_ > b_; K[45] = g_ ? b_ : a_; K[47] = g_ ? a_ : b_; }
  { const float a_ = K[32], b_ = K[33]; const bool g_ = a_ > b_; K[32] = g_ ? a_ : b_; K[33] = g_ ? b_ : a_; }
  { const float a_ = K[34], b_ = K[35]; const bool g_ = a_ > b_; K[34] = g_ ? a_ : b_; K[35] = g_ ? b_ : a_; }
  { const float a_ = K[36], b_ = K[37]; const bool g_ = a_ > b_; K[36] = g_ ? a_ : b_; K[37] = g_ ? b_ : a_; }
  { const float a_ = K[38], b_ = K[39]; const bool g_ = a_ > b_; K[38] = g_ ? a_ : b_; K[39] = g_ ? b_ : a_; }
  { const float a_ = K[40], b_ = K[41]; const bool g_ = a_ > b_; K[40] = g_ ? b_ : a_; K[41] = g_ ? a_ : b_; }
  { const float a_ = K[42], b_ = K[43]; const bool g_ = a_ > b_; K[42] = g_ ? b_ : a_; K[43] = g_ ? a_ : b_; }
  { const float a_ = K[44], b_ = K[45]; const bool g_ = a_ > b_; K[44] = g_ ? b_ : a_; K[45] = g_ ? a_ : b_; }
  { const float a_ = K[46], b_ = K[47]; const bool g_ = a_ > b_; K[46] = g_ ? b_ : a_; K[47] = g_ ? a_ : b_; }
  { const float a_ = K[32], b_ = K[40]; const bool g_ = a_ > b_; K[32] = g_ ? a_ : b_; K[40] = g_ ? b_ : a_; }
  { const float a_ = K[33], b_ = K[41]; const bool g_ = a_ > b_; K[33] = g_ ? a_ : b_; K[41] = g_ ? b_ : a_; }
  { const float a_ = K[34], b_ = K[42]; const bool g_ = a_ > b_; K[34] = g_ ? a_ : b_; K[42] = g_ ? b_ : a_; }
  { const float a_ = K[35], b_ = K[43]; const bool g_ = a_ > b_; K[35] = g_ ? a_ : b_; K[43] = g_ ? b_ : a_; }
  { const float a_ = K[36], b_ = K[44]; const bool g_ = a_ > b_; K[36] = g_ ? a_ : b_; K[44] = g_ ? b_ : a_; }
  { const float a_ = K[37], b_ = K[45]; const bool g_ = a_ > b_; K[37] = g_ ? a_ : b_; K[45] = g_ ? b_ : a_; }
  { const float a_ = K[38], b_ = K[46]; const bool g_ = a_ > b_; K[38] = g_ ? a_ : b_; K[46] = g_ ? b_ : a_; }
  { const float a_ = K[39], b_ = K[47]; const bool g_ = a_ > b_; K[39] = g_ ? a_ : b_; K[47] = g_ ? b_ : a_; }
  { const float a_ = K[32], b_ = K[36]; const bool g_ = a_ > b_; K[32] = g_ ? a_ : b_; K[36] = g_ ? b_ : a_; }
  { const float a_ = K[33], b_ = K[37]; const bool g_ = a_ > b_; K[33] = g_ ? a_ : b_; K[37] = g_ ? b_ : a_; }
  { const float a_ = K[34], b_ = K[38]; const bool g_ = a_ > b_; K[34] = g_ ? a_ : b_; K[38] = g_ ? b_ : a_; }
  { const float a_ = K[35], b_ = K[39]; const bool g_ = a_ > b_; K[35] = g_ ? a_ : b_; K[39] = g_ ? b_ : a_; }
  { const float a_ = K[40], b_ = K[44]; const bool g_ = a_ > b_; K[40] = g_ ? a_ : b_; K[44] = g_ ? b_ : a_; }
  { const float a_ = K[41], b_ = K[45]; const bool g_ = a_ > b_; K[41] = g_ ? a_ : b_; K[45] = g_ ? b_ : a_; }
  { const float a_ = K[42], b_ = K[46]; const bool g_ = a_ > b_; K[42] = g_ ? a_ : b_; K[46] = g_ ? b_ : a_; }
  { const float a_ = K[43], b_ = K[47]; const bool g_ = a_ > b_; K[43] = g_ ? a_ : b_; K[47] = g_ ? b_ : a_; }
  { const float a_ = K[32], b_ = K[34]; const bool g_ = a_ > b_; K[32] = g_ ? a_ : b_; K[34] = g_ ? b_ : a_; }
  { const float a_ = K[33], b_ = K[35]; const bool g_ = a_ > b_; K[33] = g_ ? a_ : b_; K[35] = g_ ? b_ : a_; }
  { const float a_ = K[36], b_ = K[38]; const bool g_ = a_ > b_; K[36] = g_ ? a_ : b_; K[38] = g_ ? b_ : a_; }
  { const float a_ = K[37], b_ = K[39]; const bool g_ = a_ > b_; K[37] = g_ ? a_ : b_; K[39] = g_ ? b_ : a_; }
  { const float a_ = K[40], b_ = K[42]; const bool g_ = a_ > b_; K[40] = g_ ? a_ : b_; K[42] = g_ ? b_ : a_; }
  { const float a_ = K[41], b_ = K[43]; const bool g_ = a_ > b_; K[41] = g_ ? a_ : b_; K[43] = g_ ? b_ : a_; }
  { const float a_ = K[44], b_ = K[46]; const bool g_ = a_ > b_; K[44] = g_ ? a_ : b_; K[46] = g_ ? b_ : a_; }
  { const float a_ = K[45], b_ = K[47]; const bool g_ = a_ > b_; K[45] = g_ ? a_ : b_; K[47] = g_ ? b_ : a_; }
  { const float a_ = K[32], b_ = K[33]; const bool g_ = a_ > b_; K[32] = g_ ? a_ : b_; K[33] = g_ ? b_ : a_; }
  { const float a_ = K[34], b_ = K[35]; const bool g_ = a_ > b_; K[34] = g_ ? a_ : b_; K[35] = g_ ? b_ : a_; }
  { const float a_ = K[36], b_ = K[37]; const bool g_ = a_ > b_; K[36] = g_ ? a_ : b_; K[37] = g_ ? b_ : a_; }
  { const float a_ = K[38], b_ = K[39]; const bool g_ = a_ > b_; K[38] = g_ ? a_ : b_; K[39] = g_ ? b_ : a_; }
  { const float a_ = K[40], b_ = K[41]; const bool g_ = a_ > b_; K[40] = g_ ? a_ : b_; K[41] = g_ ? b_ : a_; }
  { const float a_ = K[42], b_ = K[43]; const bool g_ = a_ > b_; K[42] = g_ ? a_ : b_; K[43] = g_ ? b_ : a_; }
  { const float a_ = K[44], b_ = K[45]; const bool g_ = a_ > b_; K[44] = g_ ? a_ : b_; K[45] = g_ ? b_ : a_; }
  { const float a_ = K[46], b_ = K[47]; const bool g_ = a_ > b_; K[46] = g_ ? a_ : b_; K[47] = g_ ? b_ : a_; }
  { const float a_ = K[48], b_ = K[49]; const bool g_ = a_ > b_; K[48] = g_ ? a_ : b_; K[49] = g_ ? b_ : a_; }
  { const float a_ = K[50], b_ = K[51]; const bool g_ = a_ > b_; K[50] = g_ ? b_ : a_; K[51] = g_ ? a_ : b_; }
  { const float a_ = K[52], b_ = K[53]; const bool g_ = a_ > b_; K[52] = g_ ? a_ : b_; K[53] = g_ ? b_ : a_; }
  { const float a_ = K[54], b_ = K[55]; const bool g_ = a_ > b_; K[54] = g_ ? b_ : a_; K[55] = g_ ? a_ : b_; }
  { const float a_ = K[56], b_ = K[57]; const bool g_ = a_ > b_; K[56] = g_ ? a_ : b_; K[57] = g_ ? b_ : a_; }
  { const float a_ = K[58], b_ = K[59]; const bool g_ = a_ > b_; K[58] = g_ ? b_ : a_; K[59] = g_ ? a_ : b_; }
  { const float a_ = K[60], b_ = K[61]; const bool g_ = a_ > b_; K[60] = g_ ? a_ : b_; K[61] = g_ ? b_ : a_; }
  { const float a_ = K[62], b_ = K[63]; const bool g_ = a_ > b_; K[62] = g_ ? b_ : a_; K[63] = g_ ? a_ : b_; }
  { const float a_ = K[48], b_ = K[50]; const bool g_ = a_ > b_; K[48] = g_ ? a_ : b_; K[50] = g_ ? b_ : a_; }
  { const float a_ = K[49], b_ = K[51]; const bool g_ = a_ > b_; K[49] = g_ ? a_ : b_; K[51] = g_ ? b_ : a_; }
  { const float a_ = K[52], b_ = K[54]; const bool g_ = a_ > b_; K[52] = g_ ? b_ : a_; K[54] = g_ ? a_ : b_; }
  { const float a_ = K[53], b_ = K[55]; const bool g_ = a_ > b_; K[53] = g_ ? b_ : a_; K[55] = g_ ? a_ : b_; }
  { const float a_ = K[56], b_ = K[58]; const bool g_ = a_ > b_; K[56] = g_ ? a_ : b_; K[58] = g_ ? b_ : a_; }
  { const float a_ = K[57], b_ = K[59]; const bool g_ = a_ > b_; K[57] = g_ ? a_ : b_; K[59] = g_ ? b_ : a_; }
  { const float a_ = K[60], b_ = K[62]; const bool g_ = a_ > b_; K[60] = g_ ? b_ : a_; K[62] = g_ ? a_ : b_; }
  { const float a_ = K[61], b_ = K[63]; const bool g_ = a_ > b_; K[61] = g_ ? b_ : a_; K[63] = g_ ? a_ : b_; }
  { const float a_ = K[48], b_ = K[49]; const bool g_ = a_ > b_; K[48] = g_ ? a_ : b_; K[49] = g_ ? b_ : a_; }
  { const float a_ = K[50], b_ = K[51]; const bool g_ = a_ > b_; K[50] = g_ ? a_ : b_; K[51] = g_ ? b_ : a_; }
  { const float a_ = K[52], b_ = K[53]; const bool g_ = a_ > b_; K[52] = g_ ? b_ : a_; K[53] = g_ ? a_ : b_; }
  { const float a_ = K[54], b_ = K[55]; const bool g_ = a_ > b_; K[54] = g_ ? b_ : a_; K[55] = g_ ? a_ : b_; }
  { const float a_ = K[56], b_ = K[57]; const bool g_ = a_ > b_; K[56] = g_ ? a_ : b_; K[57] = g_ ? b_ : a_; }
  { const float a_ = K[58], b_ = K[59]; const bool g_ = a_ > b_; K[58] = g_ ? a_ : b_; K[59] = g_ ? b_ : a_; }
  { const float a_ = K[60], b_ = K[61]; const bool g_ = a_ > b_; K[60] = g_ ? b_ : a_; K[61] = g_ ? a_ : b_; }
  { const float a_ = K[62], b_ = K[63]; const bool g_ = a_ > b_; K[62] = g_ ? b_ : a_; K[63] = g_ ? a_ : b_; }
  { const float a_ = K[48], b_ = K[52]; const bool g_ = a_ > b_; K[48] = g_ ? a_ : b_; K[52] = g_ ? b_ : a_; }
  { const float a_ = K[49], b_ = K[53]; const bool g_ = a_ > b_; K[49] = g_ ? a_ : b_; K[53] = g_ ? b_ : a_; }
  { const float a_ = K[50], b_ = K[54]; const bool g_ = a_ > b_; K[50] = g_ ? a_ : b_; K[54] = g_ ? b_ : a_; }
  { const float a_ = K[51], b_ = K[55]; const bool g_ = a_ > b_; K[51] = g_ ? a_ : b_; K[55] = g_ ? b_ : a_; }
  { const float a_ = K[56], b_ = K[60]; const bool g_ = a_ > b_; K[56] = g_ ? b_ : a_; K[60] = g_ ? a_ : b_; }
  { const float a_ = K[57], b_ = K[61]; const bool g_ = a_ > b_; K[57] = g_ ? b_ : a_; K[61] = g_ ? a_ : b_; }
  { const float a_ = K[58], b_ = K[62]; const bool g_ = a_ > b_; K[58] = g_ ? b_ : a_; K[62] = g_ ? a_ : b_; }
  { const float a_ = K[59], b_ = K[63]; const bool g_ = a_ > b_; K[59] = g_ ? b_ : a_; K[63] = g_ ? a_ : b_; }
  { const float a_ = K[48], b_ = K[50]; const bool g_ = a_ > b_; K[48] = g_ ? a_ : b_; K[50] = g_ ? b_ : a_; }
  { const float a_ = K[49], b_ = K[51]; const bool g_ = a_ > b_; K[49] = g_ ? a_ : b_; K[51] = g_ ? b_ : a_; }
  { const float a_ = K[52], b_ = K[54]; const bool g_ = a_ > b_; K[52] = g_ ? a_ : b_; K[54] = g_ ? b_ : a_; }
  { const float a_ = K[53], b_ = K[55]; const bool g_ = a_ > b_; K[53] = g_ ? a_ : b_; K[55] = g_ ? b_ : a_; }
  { const float a_ = K[56], b_ = K[58]; const bool g_ = a_ > b_; K[56] = g_ ? b_ : a_; K[58] = g_ ? a_ : b_; }
  { const float a_ = K[57], b_ = K[59]; const bool g_ = a_ > b_; K[57] = g_ ? b_ : a_; K[59] = g_ ? a_ : b_; }
  { const float a_ = K[60], b_ = K[62]; const bool g_ = a_ > b_; K[60] = g_ ? b_ : a_; K[62] = g_ ? a_ : b_; }
  { const float a_ = K[61], b_ = K[63]; const bool g_ = a_ > b_; K[61] = g_ ? b_ : a_; K[63] = g_ ? a_ : b_; }
  { const float a_ = K[48], b_ = K[49]; const bool g_ = a_ > b_; K[48] = g_ ? a_ : b_; K[49] = g_ ? b_ : a_; }
  { const float a_ = K[50], b_ = K[51]; const bool g_ = a_ > b_; K[50] = g_ ? a_ : b_; K[51] = g_ ? b_ : a_; }
  { const float a_ = K[52], b_ = K[53]; const bool g_ = a_ > b_; K[52] = g_ ? a_ : b_; K[53] = g_ ? b_ : a_; }
  { const float a_ = K[54], b_ = K[55]; const bool g_ = a_ > b_; K[54] = g_ ? a_ : b_; K[55] = g_ ? b_ : a_; }
  { const float a_ = K[56], b_ = K[57]; const bool g_ = a_ > b_; K[56] = g_ ? b_ : a_; K[57] = g_ ? a_ : b_; }
  { const float a_ = K[58], b_ = K[59]; const bool g_ = a_ > b_; K[58] = g_ ? b_ : a_; K[59] = g_ ? a_ : b_; }
  { const float a_ = K[60], b_ = K[61]; const bool g_ = a_ > b_; K[60] = g_ ? b_ : a_; K[61] = g_ ? a_ : b_; }
  { const float a_ = K[62], b_ = K[63]; const bool g_ = a_ > b_; K[62] = g_ ? b_ : a_; K[63] = g_ ? a_ : b_; }
  { const float a_ = K[48], b_ = K[56]; const bool g_ = a_ > b_; K[48] = g_ ? a_ : b_; K[56] = g_ ? b_ : a_; }
  { const float a_ = K[49], b_ = K[57]; const bool g_ = a_ > b_; K[49] = g_ ? a_ : b_; K[57] = g_ ? b_ : a_; }
  { const float a_ = K[50], b_ = K[58]; const bool g_ = a_ > b_; K[50] = g_ ? a_ : b_; K[58] = g_ ? b_ : a_; }
  { const float a_ = K[51], b_ = K[59]; const bool g_ = a_ > b_; K[51] = g_ ? a_ : b_; K[59] = g_ ? b_ : a_; }
  { const float a_ = K[52], b_ = K[60]; const bool g_ = a_ > b_; K[52] = g_ ? a_ : b_; K[60] = g_ ? b_ : a_; }
  { const float a_ = K[53], b_ = K[61]; const bool g_ = a_ > b_; K[53] = g_ ? a_ : b_; K[61] = g_ ? b_ : a_; }
  { const float a_ = K[54], b_ = K[62]; const bool g_ = a_ > b_; K[54] = g_ ? a_ : b_; K[62] = g_ ? b_ : a_; }
  { const float a_ = K[55], b_ = K[63]; const bool g_ = a_ > b_; K[55] = g_ ? a_ : b_; K[63] = g_ ? b_ : a_; }
  { const float a_ = K[48], b_ = K[52]; const bool g_ = a_ > b_; K[48] = g_ ? a_ : b_; K[52] = g_ ? b_ : a_; }
  { const float a_ = K[49], b_ = K[53]; const bool g_ = a_ > b_; K[49] = g_ ? a_ : b_; K[53] = g_ ? b_ : a_; }
  { const float a_ = K[50], b_ = K[54]; const bool g_ = a_ > b_; K[50] = g_ ? a_ : b_; K[54] = g_ ? b_ : a_; }
  { const float a_ = K[51], b_ = K[55]; const bool g_ = a_ > b_; K[51] = g_ ? a_ : b_; K[55] = g_ ? b_ : a_; }
  { const float a_ = K[56], b_ = K[60]; const bool g_ = a_ > b_; K[56] = g_ ? a_ : b_; K[60] = g_ ? b_ : a_; }
  { const float a_ = K[57], b_ = K[61]; const bool g_ = a_ > b_; K[57] = g_ ? a_ : b_; K[61] = g_ ? b_ : a_; }
  { const float a_ = K[58], b_ = K[62]; const bool g_ = a_ > b_; K[58] = g_ ? a_ : b_; K[62] = g_ ? b_ : a_; }
  { const float a_ = K[59], b_ = K[63]; const bool g_ = a_ > b_; K[59] = g_ ? a_ : b_; K[63] = g_ ? b_ : a_; }
  { const float a_ = K[48], b_ = K[50]; const bool g_ = a_ > b_; K[48] = g_ ? a_ : b_; K[50] = g_ ? b_ : a_; }
  { const float a_ = K[49], b_ = K[51]; const bool g_ = a_ > b_; K[49] = g_ ? a_ : b_; K[51] = g_ ? b_ : a_; }
  { const float a_ = K[52], b_ = K[54]; const bool g_ = a_ > b_; K[52] = g_ ? a_ : b_; K[54] = g_ ? b_ : a_; }
  { const float a_ = K[53], b_ = K[55]; const bool g_ = a_ > b_; K[53] = g_ ? a_ : b_; K[55] = g_ ? b_ : a_; }
  { const float a_ = K[56], b_ = K[58]; const bool g_ = a_ > b_; K[56] = g_ ? a_ : b_; K[58] = g_ ? b_ : a_; }
  { const float a_ = K[57], b_ = K[59]; const bool g_ = a_ > b_; K[57] = g_ ? a_ : b_; K[59] = g_ ? b_ : a_; }
  { const float a_ = K[60], b_ = K[62]; const bool g_ = a_ > b_; K[60] = g_ ? a_ : b_; K[62] = g_ ? b_ : a_; }
  { const float a_ = K[61], b_ = K[63]; const bool g_ = a_ > b_; K[61] = g_ ? a_ : b_; K[63] = g_ ? b_ : a_; }
  { const float a_ = K[48], b_ = K[49]; const bool g_ = a_ > b_; K[48] = g_ ? a_ : b_; K[49] = g_ ? b_ : a_; }
  { const float a_ = K[50], b_ = K[51]; const bool g_ = a_ > b_; K[50] = g_ ? a_ : b_; K[51] = g_ ? b_ : a_; }
  { const float a_ = K[52], b_ = K[53]; const bool g_ = a_ > b_; K[52] = g_ ? a_ : b_; K[53] = g_ ? b_ : a_; }
  { const float a_ = K[54], b_ = K[55]; const bool g_ = a_ > b_; K[54] = g_ ? a_ : b_; K[55] = g_ ? b_ : a_; }
  { const float a_ = K[56], b_ = K[57]; const bool g_ = a_ > b_; K[56] = g_ ? a_ : b_; K[57] = g_ ? b_ : a_; }
  { const float a_ = K[58], b_ = K[59]; const bool g_ = a_ > b_; K[58] = g_ ? a_ : b_; K[59] = g_ ? b_ : a_; }
  { const float a_ = K[60], b_ = K[61]; const bool g_ = a_ > b_; K[60] = g_ ? a_ : b_; K[61] = g_ ? b_ : a_; }
  { const float a_ = K[62], b_ = K[63]; const bool g_ = a_ > b_; K[62] = g_ ? a_ : b_; K[63] = g_ ? b_ : a_; }
  { const float a_ = K[0], b_ = K[31]; K[0] = a_ > b_ ? a_ : b_; }
  { const float a_ = K[1], b_ = K[30]; K[1] = a_ > b_ ? a_ : b_; }
  { const float a_ = K[2], b_ = K[29]; K[2] = a_ > b_ ? a_ : b_; }
  { const float a_ = K[3], b_ = K[28]; K[3] = a_ > b_ ? a_ : b_; }
  { const float a_ = K[4], b_ = K[27]; K[4] = a_ > b_ ? a_ : b_; }
  { const float a_ = K[5], b_ = K[26]; K[5] = a_ > b_ ? a_ : b_; }
  { const float a_ = K[6], b_ = K[25]; K[6] = a_ > b_ ? a_ : b_; }
  { const float a_ = K[7], b_ = K[24]; K[7] = a_ > b_ ? a_ : b_; }
  { const float a_ = K[8], b_ = K[23]; K[8] = a_ > b_ ? a_ : b_; }
  { const float a_ = K[9], b_ = K[22]; K[9] = a_ > b_ ? a_ : b_; }
  { const float a_ = K[10], b_ = K[21]; K[10] = a_ > b_ ? a_ : b_; }
  { const float a_ = K[11], b_ = K[20]; K[11] = a_ > b_ ? a_ : b_; }
  { const float a_ = K[12], b_ = K[19]; K[12] = a_ > b_ ? a_ : b_; }
  { const float a_ = K[13], b_ = K[18]; K[13] = a_ > b_ ? a_ : b_; }
  { const float a_ = K[14], b_ = K[17]; K[14] = a_ > b_ ? a_ : b_; }
  { const float a_ = K[15], b_ = K[16]; K[15] = a_ > b_ ? a_ : b_; }
  { const float a_ = K[0], b_ = K[8]; const bool g_ = a_ > b_; K[0] = g_ ? a_ : b_; K[8] = g_ ? b_ : a_; }
  { const float a_ = K[1], b_ = K[9]; const bool g_ = a_ > b_; K[1] = g_ ? a_ : b_; K[9] = g_ ? b_ : a_; }
  { const float a_ = K[2], b_ = K[10]; const bool g_ = a_ > b_; K[2] = g_ ? a_ : b_; K[10] = g_ ? b_ : a_; }
  { const float a_ = K[3], b_ = K[11]; const bool g_ = a_ > b_; K[3] = g_ ? a_ : b_; K[11] = g_ ? b_ : a_; }
  { const float a_ = K[4], b_ = K[12]; const bool g_ = a_ > b_; K[4] = g_ ? a_ : b_; K[12] = g_ ? b_ : a_; }
  { const float a_ = K[5], b_ = K[13]; const bool g_ = a_ > b_; K[5] = g_ ? a_ : b_; K[13] = g_ ? b_ : a_; }
  { const float a_ = K[6], b_ = K[14]; const bool g_ = a_ > b_; K[6] = g_ ? a_ : b_; K[14] = g_ ? b_ : a_; }
  { const float a_ = K[7], b_ = K[15]; const bool g_ = a_ > b_; K[7] = g_ ? a_ : b_; K[15] = g_ ? b_ : a_; }
  { const float a_ = K[0], b_ = K[4]; const bool g_ = a_ > b_; K[0] = g_ ? a_ : b_; K[4] = g_ ? b_ : a_; }
  { const float a_ = K[1], b_ = K[5]; const bool g_ = a_ > b_; K[1] = g_ ? a_ : b_; K[5] = g_ ? b_ : a_; }
  { const float a_ = K[2], b_ = K[6]; const bool g_ = a_ > b_; K[2] = g_ ? a_ : b_; K[6] = g_ ? b_ : a_; }
  { const float a_ = K[3], b_ = K[7]; const bool g_ = a_ > b_; K[3] = g_ ? a_ : b_; K[7] = g_ ? b_ : a_; }
  { const float a_ = K[8], b_ = K[12]; const bool g_ = a_ > b_; K[8] = g_ ? a_ : b_; K[12] = g_ ? b_ : a_; }
  { const float a_ = K[9], b_ = K[13]; const bool g_ = a_ > b_; K[9] = g_ ? a_ : b_; K[13] = g_ ? b_ : a_; }
  { const float a_ = K[10], b_ = K[14]; const bool g_ = a_ > b_; K[10] = g_ ? a_ : b_; K[14] = g_ ? b_ : a_; }
  { const float a_ = K[11], b_ = K[15]; const bool g_ = a_ > b_; K[11] = g_ ? a_ : b_; K[15] = g_ ? b_ : a_; }
  { const float a_ = K[0], b_ = K[2]; const bool g_ = a_ > b_; K[0] = g_ ? a_ : b_; K[2] = g_ ? b_ : a_; }
  { const float a_ = K[1], b_ = K[3]; const bool g_ = a_ > b_; K[1] = g_ ? a_ : b_; K[3] = g_ ? b_ : a_; }
  { const float a_ = K[4], b_ = K[6]; const bool g_ = a_ > b_; K[4] = g_ ? a_ : b_; K[6] = g_ ? b_ : a_; }
  { const float a_ = K[5], b_ = K[7]; const bool g_ = a_ > b_; K[5] = g_ ? a_ : b_; K[7] = g_ ? b_ : a_; }
  { const float a_ = K[8], b_ = K[10]; const bool g_ = a_ > b_; K[8] = g_ ? a_ : b_; K[10] = g_ ? b_ : a_; }
  { const float a_ = K[9], b_ = K[11]; const bool g_ = a_ > b_; K[9] = g_ ? a_ : b_; K[11] = g_ ? b_ : a_; }
  { const float a_ = K[12], b_ = K[14]; const bool g_ = a_ > b_; K[12] = g_ ? a_ : b_; K[14] = g_ ? b_ : a_; }
  { const float a_ = K[13], b_ = K[15]; const bool g_ = a_ > b_; K[13] = g_ ? a_ : b_; K[15] = g_ ? b_ : a_; }
  { const float a_ = K[0], b_ = K[1]; const bool g_ = a_ > b_; K[0] = g_ ? a_ : b_; K[1] = g_ ? b_ : a_; }
  { const float a_ = K[2], b_ = K[3]; const bool g_ = a_ > b_; K[2] = g_ ? a_ : b_; K[3] = g_ ? b_ : a_; }
  { const float a_ = K[4], b_ = K[5]; const bool g_ = a_ > b_; K[4] = g_ ? a_ : b_; K[5] = g_ ? b_ : a_; }
  { const float a_ = K[6], b_ = K[7]; const bool g_ = a_ > b_; K[6] = g_ ? a_ : b_; K[7] = g_ ? b_ : a_; }
  { const float a_ = K[8], b_ = K[9]; const bool g_ = a_ > b_; K[8] = g_ ? a_ : b_; K[9] = g_ ? b_ : a_; }
  { const float a_ = K[10], b_ = K[11]; const bool g_ = a_ > b_; K[10] = g_ ? a_ : b_; K[11] = g_ ? b_ : a_; }
  { const float a_ = K[12], b_ = K[13]; const bool g_ = a_ > b_; K[12] = g_ ? a_ : b_; K[13] = g_ ? b_ : a_; }
  { const float a_ = K[14], b_ = K[15]; const bool g_ = a_ > b_; K[14] = g_ ? a_ : b_; K[15] = g_ ? b_ : a_; }
  { const float a_ = K[32], b_ = K[63]; K[32] = a_ > b_ ? a_ : b_; }
  { const float a_ = K[33], b_ = K[62]; K[33] = a_ > b_ ? a_ : b_; }
  { const float a_ = K[34], b_ = K[61]; K[34] = a_ > b_ ? a_ : b_; }
  { const float a_ = K[35], b_ = K[60]; K[35] = a_ > b_ ? a_ : b_; }
  { const float a_ = K[36], b_ = K[59]; K[36] = a_ > b_ ? a_ : b_; }
  { const float a_ = K[37], b_ = K[58]; K[37] = a_ > b_ ? a_ : b_; }
  { const float a_ = K[38], b_ = K[57]; K[38] = a_ > b_ ? a_ : b_; }
  { const float a_ = K[39], b_ = K[56]; K[39] = a_ > b_ ? a_ : b_; }
  { const float a_ = K[40], b_ = K[55]; K[40] = a_ > b_ ? a_ : b_; }
  { const float a_ = K[41], b_ = K[54]; K[41] = a_ > b_ ? a_ : b_; }
  { const float a_ = K[42], b_ = K[53]; K[42] = a_ > b_ ? a_ : b_; }
  { const float a_ = K[43], b_ = K[52]; K[43] = a_ > b_ ? a_ : b_; }
  { const float a_ = K[44], b_ = K[51]; K[44] = a_ > b_ ? a_ : b_; }
  { const float a_ = K[45], b_ = K[50]; K[45] = a_ > b_ ? a_ : b_; }
  { const float a_ = K[46], b_ = K[49]; K[46] = a_ > b_ ? a_ : b_; }
  { const float a_ = K[47], b_ = K[48]; K[47] = a_ > b_ ? a_ : b_; }
  { const float a_ = K[32], b_ = K[40]; const bool g_ = a_ > b_; K[32] = g_ ? a_ : b_; K[40] = g_ ? b_ : a_; }
  { const float a_ = K[33], b_ = K[41]; const bool g_ = a_ > b_; K[33] = g_ ? a_ : b_; K[41] = g_ ? b_ : a_; }
  { const float a_ = K[34], b_ = K[42]; const bool g_ = a_ > b_; K[34] = g_ ? a_ : b_; K[42] = g_ ? b_ : a_; }
  { const float a_ = K[35], b_ = K[43]; const bool g_ = a_ > b_; K[35] = g_ ? a_ : b_; K[43] = g_ ? b_ : a_; }
  { const float a_ = K[36], b_ = K[44]; const bool g_ = a_ > b_; K[36] = g_ ? a_ : b_; K[44] = g_ ? b_ : a_; }
  { const float a_ = K[37], b_ = K[45]; const bool g_ = a_ > b_; K[37] = g_ ? a_ : b_; K[45] = g_ ? b_ : a_; }
  { const float a_ = K[38], b_ = K[46]; const bool g_ = a_ > b_; K[38] = g_ ? a_ : b_; K[46] = g_ ? b_ : a_; }
  { const float a_ = K[39], b_ = K[47]; const bool g_ = a_ > b_; K[39] = g_ ? a_ : b_; K[47] = g_ ? b_ : a_; }
  { const float a_ = K[32], b_ = K[36]; const bool g_ = a_ > b_; K[32] = g_ ? a_ : b_; K[36] = g_ ? b_ : a_; }
  { const float a_ = K[33], b_ = K[37]; const bool g_ = a_ > b_; K[33] = g_ ? a_ : b_; K[37] = g_ ? b_ : a_; }
  { const float a_ = K[34], b_ = K[38]; const bool g_ = a_ > b_; K[34] = g_ ? a_ : b_; K[38] = g_ ? b_ : a_; }
  { const float a_ = K[35], b_ = K[39]; const bool g_ = a_ > b_; K[35] = g_ ? a_ : b_; K[39] = g_ ? b_ : a_; }
  { const float a_ = K[40], b_ = K[44]; const bool g_ = a_ > b_; K[40] = g_ ? a_ : b_; K[44] = g_ ? b_ : a_; }
  { const float a_ = K[41], b_ = K[45]; const bool g_ = a_ > b_; K[41] = g_ ? a_ : b_; K[45] = g_ ? b_ : a_; }
  { const float a_ = K[42], b_ = K[46]; const bool g_ = a_ > b_; K[42] = g_ ? a_ : b_; K[46] = g_ ? b_ : a_; }
  { const float a_ = K[43], b_ = K[47]; const bool g_ = a_ > b_; K[43] = g_ ? a_ : b_; K[47] = g_ ? b_ : a_; }
  { const float a_ = K[32], b_ = K[34]; const bool g_ = a_ > b_; K[32] = g_ ? a_ : b_; K[34] = g_ ? b_ : a_; }
  { const float a_ = K[33], b_ = K[35]; const bool g_ = a_ > b_; K[33] = g_ ? a_ : b_; K[35] = g_ ? b_ : a_; }
  { const float a_ = K[36], b_ = K[38]; const bool g_ = a_ > b_; K[36] = g_ ? a_ : b_; K[38] = g_ ? b_ : a_; }
  { const float a_ = K[37], b_ = K[39]; const bool g_ = a_ > b_; K[37] = g_ ? a_ : b_; K[39] = g_ ? b_ : a_; }
  { const float a_ = K[40], b_ = K[42]; const bool g_ = a_ > b_; K[40] = g_ ? a_ : b_; K[42] = g_ ? b_ : a_; }
  { const float a_ = K[41], b_ = K[43]; const bool g_ = a_ > b_; K[41] = g_ ? a_ : b_; K[43] = g_ ? b_ : a_; }
  { const float a_ = K[44], b_ = K[46]; const bool g_ = a_ > b_; K[44] = g_ ? a_ : b_; K[46] = g_ ? b_ : a_; }
  { const float a_ = K[45], b_ = K[47]; const bool g_ = a_ > b_; K[45] = g_ ? a_ : b_; K[47] = g_ ? b_ : a_; }
  { const float a_ = K[32], b_ = K[33]; const bool g_ = a_ > b_; K[32] = g_ ? a_ : b_; K[33] = g_ ? b_ : a_; }
  { const float a_ = K[34], b_ = K[35]; const bool g_ = a_ > b_; K[34] = g_ ? a_ : b_; K[35] = g_ ? b_ : a_; }
  { const float a_ = K[36], b_ = K[37]; const bool g_ = a_ > b_; K[36] = g_ ? a_ : b_; K[37] = g_ ? b_ : a_; }
  { const float a_ = K[38], b_ = K[39]; const bool g_ = a_ > b_; K[38] = g_ ? a_ : b_; K[39] = g_ ? b_ : a_; }
  { const float a_ = K[40], b_ = K[41]; const bool g_ = a_ > b_; K[40] = g_ ? a_ : b_; K[41] = g_ ? b_ : a_; }
  { const float a_ = K[42], b_ = K[43]; const bool g_ = a_ > b_; K[42] = g_ ? a_ : b_; K[43] = g_ ? b_ : a_; }
  { const float a_ = K[44], b_ = K[45]; const bool g_ = a_ > b_; K[44] = g_ ? a_ : b_; K[45] = g_ ? b_ : a_; }
  { const float a_ = K[46], b_ = K[47]; const bool g_ = a_ > b_; K[46] = g_ ? a_ : b_; K[47] = g_ ? b_ : a_; }
  { const float a_ = K[0], b_ = K[47]; K[0] = a_ > b_ ? a_ : b_; }
  { const float a_ = K[1], b_ = K[46]; K[1] = a_ > b_ ? a_ : b_; }
  { const float a_ = K[2], b_ = K[45]; K[2] = a_ > b_ ? a_ : b_; }
  { const float a_ = K[3], b_ = K[44]; K[3] = a_ > b_ ? a_ : b_; }
  { const float a_ = K[4], b_ = K[43]; K[4] = a_ > b_ ? a_ : b_; }
  { const float a_ = K[5], b_ = K[42]; K[5] = a_ > b_ ? a_ : b_; }
  { const float a_ = K[6], b_ = K[41]; K[6] = a_ > b_ ? a_ : b_; }
  { const float a_ = K[7], b_ = K[40]; K[7] = a_ > b_ ? a_ : b_; }
  { const float a_ = K[8], b_ = K[39]; K[8] = a_ > b_ ? a_ : b_; }
  { const float a_ = K[9], b_ = K[38]; K[9] = a_ > b_ ? a_ : b_; }
  { const float a_ = K[10], b_ = K[37]; K[10] = a_ > b_ ? a_ : b_; }
  { const float a_ = K[11], b_ = K[36]; K[11] = a_ > b_ ? a_ : b_; }
  { const float a_ = K[12], b_ = K[35]; K[12] = a_ > b_ ? a_ : b_; }
  { const float a_ = K[13], b_ = K[34]; K[13] = a_ > b_ ? a_ : b_; }
  { const float a_ = K[14], b_ = K[33]; K[14] = a_ > b_ ? a_ : b_; }
  { const float a_ = K[15], b_ = K[32]; K[15] = a_ > b_ ? a_ : b_; }
  { const float a_ = K[0], b_ = K[8]; const bool g_ = a_ > b_; K[0] = g_ ? a_ : b_; K[8] = g_ ? b_ : a_; }
  { const float a_ = K[1], b_ = K[9]; const bool g_ = a_ > b_; K[1] = g_ ? a_ : b_; K[9] = g_ ? b_ : a_; }
  { const float a_ = K[2], b_ = K[10]; const bool g_ = a_ > b_; K[2] = g_ ? a_ : b_; K[10] = g_ ? b_ : a_; }
  { const float a_ = K[3], b_ = K[11]; const bool g_ = a_ > b_; K[3] = g_ ? a_ : b_; K[11] = g_ ? b_ : a_; }
  { const float a_ = K[4], b_ = K[12]; const bool g_ = a_ > b_; K[4] = g_ ? a_ : b_; K[12] = g_ ? b_ : a_; }
  { const float a_ = K[5], b_ = K[13]; const bool g_ = a_ > b_; K[5] = g_ ? a_ : b_; K[13] = g_ ? b_ : a_; }
  { const float a_ = K[6], b_ = K[14]; const bool g_ = a_ > b_; K[6] = g_ ? a_ : b_; K[14] = g_ ? b_ : a_; }
  { const float a_ = K[7], b_ = K[15]; const bool g_ = a_ > b_; K[7] = g_ ? a_ : b_; K[15] = g_ ? b_ : a_; }
  { const float a_ = K[0], b_ = K[4]; const bool g_ = a_ > b_; K[0] = g_ ? a_ : b_; K[4] = g_ ? b_ : a_; }
  { const float a_ = K[1], b_ = K[5]; const bool g_ = a_ > b_; K[1] = g_ ? a_ : b_; K[5] = g_ ? b_ : a_; }
  { const float a_ = K[2], b_ = K[6]; const bool g_ = a_ > b_; K[2] = g_ ? a_ : b_; K[6] = g_ ? b_ : a_; }
  { const float a_ = K[3], b_ = K[7]; const bool g_ = a_ > b_; K[3] = g_ ? a_ : b_; K[7] = g_ ? b_ : a_; }
  { const float a_ = K[8], b_ = K[12]; const bool g_ = a_ > b_; K[8] = g_ ? a_ : b_; K[12] = g_ ? b_ : a_; }
  { const float a_ = K[9], b_ = K[13]; const bool g_ = a_ > b_; K[9] = g_ ? a_ : b_; K[13] = g_ ? b_ : a_; }
  { const float a_ = K[10], b_ = K[14]; const bool g_ = a_ > b_; K[10] = g_ ? a_ : b_; K[14] = g_ ? b_ : a_; }
  { const float a_ = K[11], b_ = K[15]; const bool g_ = a_ > b_; K[11] = g_ ? a_ : b_; K[15] = g_ ? b_ : a_; }
  { const float a_ = K[0], b_ = K[2]; const bool g_ = a_ > b_; K[0] = g_ ? a_ : b_; K[2] = g_ ? b_ : a_; }
  { const float a_ = K[1], b_ = K[3]; const bool g_ = a_ > b_; K[1] = g_ ? a_ : b_; K[3] = g_ ? b_ : a_; }
  { const float a_ = K[4], b_ = K[6]; const bool g_ = a_ > b_; K[4] = g_ ? a_ : b_; K[6] = g_ ? b_ : a_; }
  { const float a_ = K[5], b_ = K[7]; const bool g_ = a_ > b_; K[5] = g_ ? a_ : b_; K[7] = g_ ? b_ : a_; }
  { const float a_ = K[8], b_ = K[10]; const bool g_ = a_ > b_; K[8] = g_ ? a_ : b_; K[10] = g_ ? b_ : a_; }
  { const float a_ = K[9], b_ = K[11]; const bool g_ = a_ > b_; K[9] = g_ ? a_ : b_; K[11] = g_ ? b_ : a_; }
  { const float a_ = K[12], b_ = K[14]; const bool g_ = a_ > b_; K[12] = g_ ? a_ : b_; K[14] = g_ ? b_ : a_; }
  { const float a_ = K[13], b_ = K[15]; const bool g_ = a_ > b_; K[13] = g_ ? a_ : b_; K[15] = g_ ? b_ : a_; }
  { const float a_ = K[0], b_ = K[1]; const bool g_ = a_ > b_; K[0] = g_ ? a_ : b_; K[1] = g_ ? b_ : a_; }
  { const float a_ = K[2], b_ = K[3]; const bool g_ = a_ > b_; K[2] = g_ ? a_ : b_; K[3] = g_ ? b_ : a_; }
  { const float a_ = K[4], b_ = K[5]; const bool g_ = a_ > b_; K[4] = g_ ? a_ : b_; K[5] = g_ ? b_ : a_; }
  { const float a_ = K[6], b_ = K[7]; const bool g_ = a_ > b_; K[6] = g_ ? a_ : b_; K[7] = g_ ? b_ : a_; }
  { const float a_ = K[8], b_ = K[9]; const bool g_ = a_ > b_; K[8] = g_ ? a_ : b_; K[9] = g_ ? b_ : a_; }
  { const float a_ = K[10], b_ = K[11]; const bool g_ = a_ > b_; K[10] = g_ ? a_ : b_; K[11] = g_ ? b_ : a_; }
  { const float a_ = K[12], b_ = K[13]; const bool g_ = a_ > b_; K[12] = g_ ? a_ : b_; K[13] = g_ ? b_ : a_; }
  { const float a_ = K[14], b_ = K[15]; const bool g_ = a_ > b_; K[14] = g_ ? a_ : b_; K[15] = g_ ? b_ : a_; }
}
__device__ __forceinline__ void merge_top16(float (&T)[16], const float (&P)[16]) {
  { const float a_ = T[0], b_ = P[15]; T[0] = a_ > b_ ? a_ : b_; }
  { const float a_ = T[1], b_ = P[14]; T[1] = a_ > b_ ? a_ : b_; }
  { const float a_ = T[2], b_ = P[13]; T[2] = a_ > b_ ? a_ : b_; }
  { const float a_ = T[3], b_ = P[12]; T[3] = a_ > b_ ? a_ : b_; }
  { const float a_ = T[4], b_ = P[11]; T[4] = a_ > b_ ? a_ : b_; }
  { const float a_ = T[5], b_ = P[10]; T[5] = a_ > b_ ? a_ : b_; }
  { const float a_ = T[6], b_ = P[9]; T[6] = a_ > b_ ? a_ : b_; }
  { const float a_ = T[7], b_ = P[8]; T[7] = a_ > b_ ? a_ : b_; }
  { const float a_ = T[8], b_ = P[7]; T[8] = a_ > b_ ? a_ : b_; }
  { const float a_ = T[9], b_ = P[6]; T[9] = a_ > b_ ? a_ : b_; }
  { const float a_ = T[10], b_ = P[5]; T[10] = a_ > b_ ? a_ : b_; }
  { const float a_ = T[11], b_ = P[4]; T[11] = a_ > b_ ? a_ : b_; }
  { const float a_ = T[12], b_ = P[3]; T[12] = a_ > b_ ? a_ : b_; }
  { const float a_ = T[13], b_ = P[2]; T[13] = a_ > b_ ? a_ : b_; }
  { const float a_ = T[14], b_ = P[1]; T[14] = a_ > b_ ? a_ : b_; }
  { const float a_ = T[15], b_ = P[0]; T[15] = a_ > b_ ? a_ : b_; }
  { const float a_ = T[0], b_ = T[8]; const bool g_ = a_ > b_; T[0] = g_ ? a_ : b_; T[8] = g_ ? b_ : a_; }
  { const float a_ = T[1], b_ = T[9]; const bool g_ = a_ > b_; T[1] = g_ ? a_ : b_; T[9] = g_ ? b_ : a_; }
  { const float a_ = T[2], b_ = T[10]; const bool g_ = a_ > b_; T[2] = g_ ? a_ : b_; T[10] = g_ ? b_ : a_; }
  { const float a_ = T[3], b_ = T[11]; const bool g_ = a_ > b_; T[3] = g_ ? a_ : b_; T[11] = g_ ? b_ : a_; }
  { const float a_ = T[4], b_ = T[12]; const bool g_ = a_ > b_; T[4] = g_ ? a_ : b_; T[12] = g_ ? b_ : a_; }
  { const float a_ = T[5], b_ = T[13]; const bool g_ = a_ > b_; T[5] = g_ ? a_ : b_; T[13] = g_ ? b_ : a_; }
  { const float a_ = T[6], b_ = T[14]; const bool g_ = a_ > b_; T[6] = g_ ? a_ : b_; T[14] = g_ ? b_ : a_; }
  { const float a_ = T[7], b_ = T[15]; const bool g_ = a_ > b_; T[7] = g_ ? a_ : b_; T[15] = g_ ? b_ : a_; }
  { const float a_ = T[0], b_ = T[4]; const bool g_ = a_ > b_; T[0] = g_ ? a_ : b_; T[4] = g_ ? b_ : a_; }
  { const float a_ = T[1], b_ = T[5]; const bool g_ = a_ > b_; T[1] = g_ ? a_ : b_; T[5] = g_ ? b_ : a_; }
  { const float a_ = T[2], b_ = T[6]; const bool g_ = a_ > b_; T[2] = g_ ? a_ : b_; T[6] = g_ ? b_ : a_; }
  { const float a_ = T[3], b_ = T[7]; const bool g_ = a_ > b_; T[3] = g_ ? a_ : b_; T[7] = g_ ? b_ : a_; }
  { const float a_ = T[8], b_ = T[12]; const bool g_ = a_ > b_; T[8] = g_ ? a_ : b_; T[12] = g_ ? b_ : a_; }
  { const float a_ = T[9], b_ = T[13]; const bool g_ = a_ > b_; T[9] = g_ ? a_ : b_; T[13] = g_ ? b_ : a_; }
  { const float a_ = T[10], b_ = T[14]; const bool g_ = a_ > b_; T[10] = g_ ? a_ : b_; T[14] = g_ ? b_ : a_; }
  { const float a_ = T[11], b_ = T[15]; const bool g_ = a_ > b_; T[11] = g_ ? a_ : b_; T[15] = g_ ? b_ : a_; }
  { const float a_ = T[0], b_ = T[2]; const bool g_ = a_ > b_; T[0] = g_ ? a_ : b_; T[2] = g_ ? b_ : a_; }
  { const float a_ = T[1], b_ = T[3]; const bool g_ = a_ > b_; T[1] = g_ ? a_ : b_; T[3] = g_ ? b_ : a_; }
  { const float a_ = T[4], b_ = T[6]; const bool g_ = a_ > b_; T[4] = g_ ? a_ : b_; T[6] = g_ ? b_ : a_; }
  { const float a_ = T[5], b_ = T[7]; const bool g_ = a_ > b_; T[5] = g_ ? a_ : b_; T[7] = g_ ? b_ : a_; }
  { const float a_ = T[8], b_ = T[10]; const bool g_ = a_ > b_; T[8] = g_ ? a_ : b_; T[10] = g_ ? b_ : a_; }
  { const float a_ = T[9], b_ = T[11]; const bool g_ = a_ > b_; T[9] = g_ ? a_ : b_; T[11] = g_ ? b_ : a_; }
  { const float a_ = T[12], b_ = T[14]; const bool g_ = a_ > b_; T[12] = g_ ? a_ : b_; T[14] = g_ ? b_ : a_; }
  { const float a_ = T[13], b_ = T[15]; const bool g_ = a_ > b_; T[13] = g_ ? a_ : b_; T[15] = g_ ? b_ : a_; }
  { const float a_ = T[0], b_ = T[1]; const bool g_ = a_ > b_; T[0] = g_ ? a_ : b_; T[1] = g_ ? b_ : a_; }
  { const float a_ = T[2], b_ = T[3]; const bool g_ = a_ > b_; T[2] = g_ ? a_ : b_; T[3] = g_ ? b_ : a_; }
  { const float a_ = T[4], b_ = T[5]; const bool g_ = a_ > b_; T[4] = g_ ? a_ : b_; T[5] = g_ ? b_ : a_; }
  { const float a_ = T[6], b_ = T[7]; const bool g_ = a_ > b_; T[6] = g_ ? a_ : b_; T[7] = g_ ? b_ : a_; }
  { const float a_ = T[8], b_ = T[9]; const bool g_ = a_ > b_; T[8] = g_ ? a_ : b_; T[9] = g_ ? b_ : a_; }
  { const float a_ = T[10], b_ = T[11]; const bool g_ = a_ > b_; T[10] = g_ ? a_ : b_; T[11] = g_ ? b_ : a_; }
  { const float a_ = T[12], b_ = T[13]; const bool g_ = a_ > b_; T[12] = g_ ? a_ : b_; T[13] = g_ ? b_ : a_; }
  { const float a_ = T[14], b_ = T[15]; const bool g_ = a_ > b_; T[14] = g_ ? a_ : b_; T[15] = g_ ? b_ : a_; }
}

__device__ __forceinline__ void peer_topk(const int wave_s, const bf16* pq, const bf16* skb, int* ids, float* gates, LAS float* smem) {
  const int tid_ = opaque_tid(wave_s);
  const int lane = tid_ & 63, n = lane & 31, hh = lane >> 5, wave = tid_ >> 6;
  const int gw = blockIdx.x * NWAVES + wave;
  const int nw = gridDim.x * NWAVES;
  LAS float* lk = smem + wave * 2048;
  for (int it = gw; it < 512 * 8; it += nw) {
    const int h = it & 7, tok0 = (it >> 3) * 32;
#pragma unroll 1
    for (int half = 0; half < 2; half++) {
      bf16x8_t qf[8];
      {
        const bf16* qrow = pq + (size_t)(tok0 + n) * 2048 + h * 256 + half * 128 + 8 * hh;
#pragma unroll
        for (int ks = 0; ks < 8; ks++) qf[ks] = *(const bf16x8_t*)(qrow + 16 * ks);
      }
      float K[64];
#pragma unroll
      for (int kt = 0; kt < 4; kt++) {
        const bf16* krow = skb + ((size_t)((h * 2 + half) * 128 + kt * 32 + n)) * 128 + 8 * hh;
        f32x16_t acc;
#pragma unroll
        for (int r = 0; r < 16; r++) acc[r] = 0.f;
#pragma unroll
        for (int kq = 0; kq < 2; kq++) {
          bf16x8_t kf[4];
#pragma unroll
          for (int i = 0; i < 4; i++) kf[i] = *(const bf16x8_t*)(krow + 16 * (kq * 4 + i));
          MFMA_PAD();
#pragma unroll
          for (int i = 0; i < 4; i++) acc = __builtin_amdgcn_mfma_f32_32x32x16_bf16(kf[i], qf[kq * 4 + i], acc, 0, 0, 0);
          MFMA_PAD();
        }
#pragma unroll
        for (int i = 0; i < 16; i++) K[kt * 16 + i] = pack_key<0x7Fu>(acc[i], (unsigned)(kt * 32 + (i & 3) + 8 * (i >> 2) + 4 * hh));
      }
      __builtin_amdgcn_sched_barrier(0);
      top16_of_64(K);
      __builtin_amdgcn_sched_barrier(0);
      float T[16], P[16];
#pragma unroll
      for (int i = 0; i < 16; i++) { T[i] = K[i]; P[i] = __shfl_xor(K[i], 32, 64); }
      merge_top16(T, P);
#pragma unroll
      for (int i = 0; i < 16; i++) lk[(half * 16 + i) * 64 + lane] = T[i];
      __builtin_amdgcn_sched_barrier(0);
    }
    float f0[16], f1[16];
    int ti0[16], ti1[16];
#pragma unroll
    for (int i = 0; i < 16; i++) {
      const float k0 = lk[i * 64 + lane], k1 = lk[(16 + i) * 64 + lane];
      f0[i] = key_val<0x7Fu>(k0); ti0[i] = (int)key_idx<0x7Fu>(k0);
      f1[i] = key_val<0x7Fu>(k1); ti1[i] = (int)key_idx<0x7Fu>(k1);
    }
    float K[64];
    {
    K[0] = pack_key<0xFFu>(f0[0] + f1[0], 0u);
    K[1] = pack_key<0xFFu>(f0[0] + f1[1], 1u);
    K[2] = pack_key<0xFFu>(f0[0] + f1[2], 2u);
    K[3] = pack_key<0xFFu>(f0[0] + f1[3], 3u);
    K[4] = pack_key<0xFFu>(f0[0] + f1[4], 4u);
    K[5] = pack_key<0xFFu>(f0[0] + f1[5], 5u);
    K[6] = pack_key<0xFFu>(f0[0] + f1[6], 6u);
    K[7] = pack_key<0xFFu>(f0[0] + f1[7], 7u);
    K[8] = pack_key<0xFFu>(f0[0] + f1[8], 8u);
    K[9] = pack_key<0xFFu>(f0[0] + f1[9], 9u);
    K[10] = pack_key<0xFFu>(f0[0] + f1[10], 10u);
    K[11] = pack_key<0xFFu>(f0[0] + f1[11], 11u);
    K[12] = pack_key<0xFFu>(f0[0] + f1[12], 12u);
    K[13] = pack_key<0xFFu>(f0[0] + f1[13], 13u);
    K[14] = pack_key<0xFFu>(f0[0] + f1[14], 14u);
    K[15] = pack_key<0xFFu>(f0[0] + f1[15], 15u);
    K[16] = pack_key<0xFFu>(f0[1] + f1[0], 16u);
    K[17] = pack_key<0xFFu>(f0[1] + f1[1], 17u);
    K[18] = pack_key<0xFFu>(f0[1] + f1[2], 18u);
    K[19] = pack_key<0xFFu>(f0[1] + f1[3], 19u);
    K[20] = pack_key<0xFFu>(f0[1] + f1[4], 20u);
    K[21] = pack_key<0xFFu>(f0[1] + f1[5], 21u);
    K[22] = pack_key<0xFFu>(f0[1] + f1[6], 22u);
    K[23] = pack_key<0xFFu>(f0[1] + f1[7], 23u);
    K[24] = pack_key<0xFFu>(f0[2] + f1[0], 32u);
    K[25] = pack_key<0xFFu>(f0[2] + f1[1], 33u);
    K[26] = pack_key<0xFFu>(f0[2] + f1[2], 34u);
    K[27] = pack_key<0xFFu>(f0[2] + f1[3], 35u);
    K[28] = pack_key<0xFFu>(f0[2] + f1[4], 36u);
    K[29] = pack_key<0xFFu>(f0[3] + f1[0], 48u);
    K[30] = pack_key<0xFFu>(f0[3] + f1[1], 49u);
    K[31] = pack_key<0xFFu>(f0[3] + f1[2], 50u);
    K[32] = pack_key<0xFFu>(f0[3] + f1[3], 51u);
    K[33] = pack_key<0xFFu>(f0[4] + f1[0], 64u);
    K[34] = pack_key<0xFFu>(f0[4] + f1[1], 65u);
    K[35] = pack_key<0xFFu>(f0[4] + f1[2], 66u);
    K[36] = pack_key<0xFFu>(f0[5] + f1[0], 80u);
    K[37] = pack_key<0xFFu>(f0[5] + f1[1], 81u);
    K[38] = pack_key<0xFFu>(f0[6] + f1[0], 96u);
    K[39] = pack_key<0xFFu>(f0[6] + f1[1], 97u);
    K[40] = pack_key<0xFFu>(f0[7] + f1[0], 112u);
    K[41] = pack_key<0xFFu>(f0[7] + f1[1], 113u);
    K[42] = pack_key<0xFFu>(f0[8] + f1[0], 128u);
    K[43] = pack_key<0xFFu>(f0[9] + f1[0], 144u);
    K[44] = pack_key<0xFFu>(f0[10] + f1[0], 160u);
    K[45] = pack_key<0xFFu>(f0[11] + f1[0], 176u);
    K[46] = pack_key<0xFFu>(f0[12] + f1[0], 192u);
    K[47] = pack_key<0xFFu>(f0[13] + f1[0], 208u);
    K[48] = pack_key<0xFFu>(f0[14] + f1[0], 224u);
    K[49] = pack_key<0xFFu>(f0[15] + f1[0], 240u);
    K[50] = -3.0e38f;
    K[51] = -3.0e38f;
    K[52] = -3.0e38f;
    K[53] = -3.0e38f;
    K[54] = -3.0e38f;
    K[55] = -3.0e38f;
    K[56] = -3.0e38f;
    K[57] = -3.0e38f;
    K[58] = -3.0e38f;
    K[59] = -3.0e38f;
    K[60] = -3.0e38f;
    K[61] = -3.0e38f;
    K[62] = -3.0e38f;
    K[63] = -3.0e38f;
    }
    __builtin_amdgcn_sched_barrier(0);
    top16_of_64(K);
    __builtin_amdgcn_sched_barrier(0);
    float bv[16];
    int be[16];
#pragma unroll
    for (int r = 0; r < 16; r++) {
      const int flat = (int)key_idx<0xFFu>(K[r]);
      const int a = flat >> 4, b = flat & 15;
      int i0 = 0, i1 = 0;
#pragma unroll
      for (int i = 0; i < 16; i++) { i0 = (a == i) ? ti0[i] : i0; i1 = (b == i) ? ti1[i] : i1; }
      be[r] = i0 * 128 + i1;
      bv[r] = key_val<0xFFu>(K[r]);
    }
    const float b0 = bv[0];
    float ge[16];
    float gsum = 0.f;
#pragma unroll
    for (int r = 0; r < 16; r++) { ge[r] = __expf(bv[r] - b0); gsum += ge[r]; }
    const float ginv = 1.0f / gsum;
    if (hh == 0) {
      int* ip = ids + (size_t)(tok0 + n) * 128 + h * 16;
      float* gp = gates + (size_t)(tok0 + n) * 128 + h * 16;
#pragma unroll
      for (int r4 = 0; r4 < 4; r4++) {
        *(int4*)(ip + 4 * r4) = make_int4(be[4 * r4], be[4 * r4 + 1], be[4 * r4 + 2], be[4 * r4 + 3]);
        *(float4*)(gp + 4 * r4) = make_float4(ge[4 * r4] * ginv, ge[4 * r4 + 1] * ginv, ge[4 * r4 + 2] * ginv, ge[4 * r4 + 3] * ginv);
      }
    }
  }
}

typedef _Float16 f16x2_t __attribute__((ext_vector_type(2)));
__device__ __forceinline__ unsigned e4m3x2_to_f16x2(unsigned w, unsigned sel) {
  return __builtin_amdgcn_perm(w, w, sel);
}
__device__ __forceinline__ float dot2h(unsigned a, unsigned b, float c) {
  return __builtin_amdgcn_fdot2(__builtin_bit_cast(f16x2_t, a), __builtin_bit_cast(f16x2_t, b), c, false);
}
__device__ __forceinline__ unsigned pack_h2(float lo, float hi) {
  f16x2_t v; v.x = (_Float16)lo; v.y = (_Float16)hi;
  return __builtin_bit_cast(unsigned, v);
}
template <bool FINAL>
__device__ __forceinline__ void peer_gather(const int wave_s, bf16* xn, const float* rst, const unsigned char* ub, const unsigned char* vb, const float* vsc, const float* usc,
                                            const int* ids, const float* gates, float* xw, const float* gnext, float* outp) {
  const int tid_ = opaque_tid(wave_s);
  const int lane = tid_ & 63;
  const int gw = blockIdx.x * NWAVES + (tid_ >> 6);
  const int nw = gridDim.x * NWAVES;
  const int el = ((lane >> 5) & 1) * 8 + ((lane >> 4) & 1) * 4 + ((lane >> 3) & 1) * 2 + ((lane >> 2) & 1);
  int idv = 0;
  uint2 uu[16];
  uint2 vv[16];
  if (gw < NT) {
    idv = ids[(size_t)gw * 128 + (lane & 15)];
#pragma unroll
    for (int e = 0; e < 16; e++) {
      const int id = __builtin_amdgcn_readlane(idv, e);
      uu[e] = *(const uint2*)(ub + (size_t)id * 512 + lane * 8);
      vv[e] = *(const uint2*)(vb + (size_t)id * 512 + lane * 8);
    }
  }
  for (int tok = gw; tok < NT; tok += nw) {
    const int tokn = (tok + nw < NT) ? tok + nw : tok;
    int xqh[2] = {0, 0}, xql[2] = {0, 0};
    float xstep, qhalf;
    {
      const uint4 a = *(const uint4*)(xn + (size_t)tok * DM + lane * 16);
      const uint4 b = *(const uint4*)(xn + (size_t)tok * DM + lane * 16 + 8);
      const unsigned xw_[8] = {a.x, a.y, a.z, a.w, b.x, b.y, b.z, b.w};
      const float4* sp = (const float4*)(rst + (size_t)tok * 16);
      const float4 s0 = sp[0], s1 = sp[1], s2 = sp[2], s3 = sp[3];
      const float xs = rsqrtf((((s0.x + s0.y) + (s0.z + s0.w)) + ((s1.x + s1.y) + (s1.z + s1.w)) + ((s2.x + s2.y) + (s2.z + s2.w)) + ((s3.x + s3.y) + (s3.z + s3.w))) * (1.0f / 1024.f) + EPSF);
      float xf[16];
      float am = 0.f;
#pragma unroll
      for (int k = 0; k < 8; k++) { xf[2 * k] = bf_lo(xw_[k]) * xs; xf[2 * k + 1] = bf_hi(xw_[k]) * xs; am = fmaxf(am, fmaxf(fabsf(xf[2 * k]), fabsf(xf[2 * k + 1]))); }
#pragma unroll
      for (int o = 32; o >= 1; o >>= 1) am = fmaxf(am, __shfl_xor(am, o, 64));
      xstep = am * (1.0f / 119.f);
      const float inv = am > 0.f ? 119.f / am : 0.f;
      int qs = 0;
#pragma unroll
      for (int i = 0; i < 16; i++) {
        const int q = (int)rintf(xf[i] * inv);
        const int t = q + 8;
        xqh[i >> 3] |= ((t >> 4) & 15) << (4 * (i & 7));
        xql[i >> 3] |= (((t & 15) - 8) & 15) << (4 * (i & 7));
        qs += q;
      }
      qhalf = 0.5f * wsum((float)qs);
    }
    f16x2_t acc2[8];
#pragma unroll
    for (int i = 0; i < 8; i++) acc2[i] = (f16x2_t){(_Float16)0.f, (_Float16)0.f};
#pragma unroll 1
    for (int g = 0; g < 8; g++) {
      const int ide = __builtin_amdgcn_ds_bpermute(el << 2, idv);
      const float2 sc2 = ((const float2*)vsc)[ide];
      const float gv = gates[(size_t)tok * 128 + g * 16 + el] * sc2.x;
      const float us = sc2.y * xstep;
      const int idn = ids[(size_t)(g < 7 ? tok : tokn) * 128 + ((g + 1) & 7) * 16 + (lane & 15)];
      float d[16];
#pragma unroll
      for (int e = 0; e < 16; e++) {
        int sh = __builtin_amdgcn_sdot8((int)uu[e].x, xqh[0], 0, false);
        sh = __builtin_amdgcn_sdot8((int)uu[e].y, xqh[1], sh, false);
        int sl = __builtin_amdgcn_sdot8((int)uu[e].x, xql[0], 0, false);
        sl = __builtin_amdgcn_sdot8((int)uu[e].y, xql[1], sl, false);
        d[e] = (float)((sh << 4) + sl);
      }
#pragma unroll
      for (int e = 0; e < 16; e++) {
        const int id = __builtin_amdgcn_readlane(idn, e);
        uu[e] = *(const uint2*)(ub + (size_t)id * 512 + lane * 8);
      }
      float d8[8], d4[4], d2[2], d1;
      {
        const bool hi = (lane & 32) != 0;
#pragma unroll
        for (int i = 0; i < 8; i++) { const float send = hi ? d[i] : d[i + 8]; const float keep = hi ? d[i + 8] : d[i]; d8[i] = keep + __shfl_xor(send, 32, 64); }
      }
      {
        const bool hi = (lane & 16) != 0;
#pragma unroll
        for (int i = 0; i < 4; i++) { const float send = hi ? d8[i] : d8[i + 4]; const float keep = hi ? d8[i + 4] : d8[i]; d4[i] = keep + __shfl_xor(send, 16, 64); }
      }
      {
        const bool hi = (lane & 8) != 0;
#pragma unroll
        for (int i = 0; i < 2; i++) { const float send = hi ? d4[i] : d4[i + 2]; const float keep = hi ? d4[i + 2] : d4[i]; d2[i] = keep + __shfl_xor(send, 8, 64); }
      }
      {
        const bool hi = (lane & 4) != 0;
        const float send = hi ? d2[0] : d2[1];
        const float keep = hi ? d2[1] : d2[0];
        d1 = keep + __shfl_xor(send, 4, 64);
      }
      d1 += __shfl_xor(d1, 2, 64);
      d1 += __shfl_xor(d1, 1, 64);
      const float wl = gv * gelu_tanh((d1 + qhalf) * us);
#pragma unroll
      for (int e = 0; e < 16; e++) {
        const float w = __builtin_bit_cast(float, __builtin_amdgcn_readlane(__builtin_bit_cast(int, wl), ((e >> 3) & 1) * 32 + ((e >> 2) & 1) * 16 + ((e >> 1) & 1) * 8 + (e & 1) * 4));
        const f16x2_t w2 = __builtin_bit_cast(f16x2_t, pack_h2(w, w));
        const unsigned vw[2] = {vv[e].x, vv[e].y};
#pragma unroll
        for (int k = 0; k < 2; k++) {
          const unsigned w4 = vw[k];
          const unsigned le = __builtin_amdgcn_perm(V4_LUT_HI, V4_LUT_LO, w4 & 0x07070707u);
          const unsigned lo = __builtin_amdgcn_perm(V4_LUT_HI, V4_LUT_LO, (w4 >> 4) & 0x07070707u);
          const unsigned ee = ((w4 << 4) & 0x80808080u) | le;
          const unsigned eo = (w4 & 0x80808080u) | lo;
          const unsigned p01 = __builtin_amdgcn_perm(eo, ee, 0x040c000cu), p23 = __builtin_amdgcn_perm(eo, ee, 0x050c010cu);
          const unsigned p45 = __builtin_amdgcn_perm(eo, ee, 0x060c020cu), p67 = __builtin_amdgcn_perm(eo, ee, 0x070c030cu);
          acc2[4 * k + 0] = __builtin_elementwise_fma(__builtin_bit_cast(f16x2_t, p01), w2, acc2[4 * k + 0]);
          acc2[4 * k + 1] = __builtin_elementwise_fma(__builtin_bit_cast(f16x2_t, p23), w2, acc2[4 * k + 1]);
          acc2[4 * k + 2] = __builtin_elementwise_fma(__builtin_bit_cast(f16x2_t, p45), w2, acc2[4 * k + 2]);
          acc2[4 * k + 3] = __builtin_elementwise_fma(__builtin_bit_cast(f16x2_t, p67), w2, acc2[4 * k + 3]);
        }
      }
#pragma unroll
      for (int e = 0; e < 16; e++) {
        const int id = __builtin_amdgcn_readlane(idn, e);
        vv[e] = *(const uint2*)(vb + (size_t)id * 512 + lane * 8);
      }
      idv = idn;
    }
    float acc[16];
#pragma unroll
    for (int i = 0; i < 8; i++) { acc[2 * i] = (float)acc2[i].x; acc[2 * i + 1] = (float)acc2[i].y; }
    float* xr = xw + (size_t)tok * DM + lane * 16;
    float xv[16];
    float ssq = 0.f;
#pragma unroll
    for (int c = 0; c < 4; c++) {
      float4 a0 = *(float4*)(xr + c * 4);
      a0.x += acc[c * 4 + 0]; a0.y += acc[c * 4 + 1]; a0.z += acc[c * 4 + 2]; a0.w += acc[c * 4 + 3];
      if (!FINAL) *(float4*)(xr + c * 4) = a0;
      xv[c * 4 + 0] = a0.x; xv[c * 4 + 1] = a0.y; xv[c * 4 + 2] = a0.z; xv[c * 4 + 3] = a0.w;
      ssq += a0.x * a0.x + a0.y * a0.y + a0.z * a0.z + a0.w * a0.w;
    }
    ssq = wsum(ssq);
    const float rstd = rsqrtf(ssq * (1.0f / DM) + EPSF);
    const float4* g4 = (const float4*)(gnext + lane * 16);
    if (FINAL) {
      float* op = outp + (size_t)tok * DM + lane * 16;
#pragma unroll
      for (int c = 0; c < 4; c++) {
        const float4 gq = g4[c];
        *(float4*)(op + c * 4) = make_float4(xv[c * 4] * rstd * gq.x, xv[c * 4 + 1] * rstd * gq.y, xv[c * 4 + 2] * rstd * gq.z, xv[c * 4 + 3] * rstd * gq.w);
      }
    } else {
      uint4 o0, o1;
      { const float4 ga = g4[0], gb = g4[1];
        o0.x = pk2(xv[0] * rstd * ga.x, xv[1] * rstd * ga.y); o0.y = pk2(xv[2] * rstd * ga.z, xv[3] * rstd * ga.w);
        o0.z = pk2(xv[4] * rstd * gb.x, xv[5] * rstd * gb.y); o0.w = pk2(xv[6] * rstd * gb.z, xv[7] * rstd * gb.w); }
      { const float4 ga = g4[2], gb = g4[3];
        o1.x = pk2(xv[8] * rstd * ga.x, xv[9] * rstd * ga.y); o1.y = pk2(xv[10] * rstd * ga.z, xv[11] * rstd * ga.w);
        o1.z = pk2(xv[12] * rstd * gb.x, xv[13] * rstd * gb.y); o1.w = pk2(xv[14] * rstd * gb.z, xv[15] * rstd * gb.w); }
      *(uint4*)(xn + (size_t)tok * DM + lane * 16) = o0;
      *(uint4*)(xn + (size_t)tok * DM + lane * 16 + 8) = o1;
    }
  }
}

__device__ __forceinline__ void prologue_transposes(const int wave_s, const Params& p, unsigned char* ws, LAS unsigned char* lds) {
  const int tid_ = opaque_tid(wave_s);
  const int lane = tid_ & 63, wave = tid_ >> 6;
  LAS float* scr = (LAS float*)(lds + wave * 16384);
  const int gw = blockIdx.x * NWAVES + wave, NGW = gridDim.x * NWAVES;
  constexpr int I_IN = (DM / 64) * (DIN / 32), I_SQ = (DM / 64) * (DM / 32), I_2K = (DM / 64) * (2048 / 32);
  constexpr int I_GL = (256 / 64) * (256 / 32);
  constexpr int PER_LAYER = I_IN + 3 * I_SQ + 2 * I_2K + I_GL;
  const float* w3 = karg_in(3); const float* w19 = karg_in(19); const float* w22 = karg_in(22);
  const float* w23 = karg_in(23); const float* w24 = karg_in(24); const float* w26 = karg_in(26);
  const float* w16 = karg_in(16);
  for (int it = gw; it < 2 * PER_LAYER; it += NGW) {
    const int l = it / PER_LAYER;
    int r = it % PER_LAYER;
    unsigned char* wl = ws + WS_WT + (size_t)l * WT_LAYER;
    if (r < I_IN) { transpose_item(w3 + (size_t)l * DM * DIN, DM, DIN, (bf16*)(wl + WT_IN), scr, r, lane); continue; } r -= I_IN;
    if (r < I_SQ) { transpose_item(w19 + (size_t)l * DM * DM, DM, DM, (bf16*)(wl + WT_OUT), scr, r, lane); continue; } r -= I_SQ;
    if (r < I_SQ) { transpose_item(w22 + (size_t)l * DM * DM, DM, DM, (bf16*)(wl + WT_MQ), scr, r, lane); continue; } r -= I_SQ;
    if (r < I_2K) { transpose_item(w23 + (size_t)l * DM * 2048, DM, 2048, (bf16*)(wl + WT_MKV), scr, r, lane); continue; } r -= I_2K;
    if (r < I_SQ) { transpose_item(w24 + (size_t)l * DM * DM, DM, DM, (bf16*)(wl + WT_MO), scr, r, lane); continue; } r -= I_SQ;
    if (r < I_2K) { transpose_item(w26 + (size_t)l * DM * 2048, DM, 2048, (bf16*)(wl + WT_PQ), scr, r, lane); continue; } r -= I_2K;
    transpose_item(w16 + (size_t)l * 256 * 256, 256, 256, (bf16*)(wl + WT_GLU), scr, r, lane);
  }
}

template <class T> __device__ __forceinline__ T* opq(T* p) { asm volatile("" : "+s"(p)); return p; }
__device__ __forceinline__ void cvt_rows_bf16(const int wave_s, const float* src, bf16* dst, size_t n) {
  const int tid_ = opaque_tid(wave_s);
  const size_t gt = (size_t)blockIdx.x * (NWAVES * 64) + tid_;
  const size_t nth = (size_t)gridDim.x * NWAVES * 64;
  for (size_t i = gt; i < n / 8; i += nth) {
    const float4 a = ((const float4*)src)[2 * i], b = ((const float4*)src)[2 * i + 1];
    uint4 o; o.x = pk2(a.x, a.y); o.y = pk2(a.z, a.w); o.z = pk2(b.x, b.y); o.w = pk2(b.z, b.w);
    ((uint4*)dst)[i] = o;
  }
}

__device__ __forceinline__ unsigned enc_e4m3(float x) {
  const _Float16 hf = (_Float16)x;
  const unsigned h = (unsigned)__builtin_bit_cast(unsigned short, hf);
  return ((h + 0x7Fu + ((h >> 8) & 1u)) >> 8) & 0xFFu;
}
__device__ __forceinline__ void cvt_rows_e4m3(const int wave_s, const float* src, unsigned char* dst, size_t n, float sc) {
  const int tid_ = opaque_tid(wave_s);
  const size_t gt = (size_t)blockIdx.x * (NWAVES * 64) + tid_;
  const size_t nth = (size_t)gridDim.x * NWAVES * 64;
  for (size_t i = gt; i < n / 16; i += nth) {
    unsigned w[4];
#pragma unroll
    for (int k = 0; k < 4; k++) {
      const float4 a = ((const float4*)src)[4 * i + k];
      w[k] = enc_e4m3(a.x * sc) | (enc_e4m3(a.y * sc) << 8) | (enc_e4m3(a.z * sc) << 16) | (enc_e4m3(a.w * sc) << 24);
    }
    uint4 o; o.x = w[0]; o.y = w[1]; o.z = w[2]; o.w = w[3];
    ((uint4*)dst)[i] = o;
  }
}

__device__ __forceinline__ unsigned enc_v4(float z) {
  const float az = fabsf(z);
  unsigned c = 0;
  c += az > 0.25f; c += az > 0.5f; c += az > 0.75f; c += az > 1.0625f; c += az > 1.375f; c += az > 1.75f; c += az > 2.25f;
  return c | ((__builtin_bit_cast(unsigned, z) >> 28) & 8u);
}
__device__ __forceinline__ void cvt_rows_i4(const int wave_s, const float* src, unsigned char* dst, float* sc_out, int nrows) {
  const int tid_ = opaque_tid(wave_s);
  const int lane = tid_ & 63;
  const int gw = blockIdx.x * NWAVES + (tid_ >> 6);
  const int nw = gridDim.x * NWAVES;
  for (int r = gw; r < nrows; r += nw) {
    const float4* sp = (const float4*)(src + (size_t)r * 1024 + lane * 16);
    const float4 a0 = sp[0], a1 = sp[1], a2 = sp[2], a3 = sp[3];
    const float xv[16] = {a0.x, a0.y, a0.z, a0.w, a1.x, a1.y, a1.z, a1.w, a2.x, a2.y, a2.z, a2.w, a3.x, a3.y, a3.z, a3.w};
    float ss = 0.f;
#pragma unroll
    for (int i = 0; i < 16; i++) ss += xv[i] * xv[i];
    ss = wsum(ss);
    const float sc = sqrtf(ss * (1.0f / 1024.f)) * U4_STEP;
    const float inv = sc > 0.f ? 1.0f / sc : 0.f;
    unsigned w[2] = {0u, 0u};
#pragma unroll
    for (int i = 0; i < 16; i++) {
      const float f = fminf(fmaxf(floorf(xv[i] * inv), -8.f), 7.f);
      w[i >> 3] |= ((unsigned)(int)f & 15u) << (4 * (i & 7));
    }
    uint2 o; o.x = w[0]; o.y = w[1];
    *(uint2*)(dst + (size_t)r * 512 + lane * 8) = o;
    if (lane == 0) sc_out[2 * r] = sc;
  }
}
__device__ __forceinline__ void cvt_rows_v4(const int wave_s, const float* src, unsigned char* dst, float* sc_out, int nrows) {
  const int tid_ = opaque_tid(wave_s);
  const int lane = tid_ & 63;
  const int gw = blockIdx.x * NWAVES + (tid_ >> 6);
  const int nw = gridDim.x * NWAVES;
  for (int r = gw; r < nrows; r += nw) {
    const float4* sp = (const float4*)(src + (size_t)r * 1024 + lane * 16);
    const float4 a0 = sp[0], a1 = sp[1], a2 = sp[2], a3 = sp[3];
    const float xv[16] = {a0.x, a0.y, a0.z, a0.w, a1.x, a1.y, a1.z, a1.w, a2.x, a2.y, a2.z, a2.w, a3.x, a3.y, a3.z, a3.w};
    float ss = 0.f;
#pragma unroll
    for (int i = 0; i < 16; i++) ss += xv[i] * xv[i];
    ss = wsum(ss);
    const float sc = sqrtf(ss * (1.0f / 1024.f)) * V4_ROWSCALE;
    const float inv = sc > 0.f ? 1.0f / sc : 0.f;
    unsigned w[2] = {0u, 0u};
#pragma unroll
    for (int i = 0; i < 16; i++) w[i >> 3] |= enc_v4(xv[i] * inv) << (4 * (i & 7));
    uint2 o; o.x = w[0]; o.y = w[1];
    *(uint2*)(dst + (size_t)r * 512 + lane * 8) = o;
    if (lane == 0) sc_out[2 * r] = sc;
  }
}

#define GEMM_F32(Aptr, Wt, Cptr, Rptr, M_, N_) do { \
    pg8::Gemm g_{opq((const bf16*)(Aptr)), opq((const bf16*)(Wt)), (M_), (N_), DM}; pg8::StaticOrder S_; S_.init((M_), (N_), (int)gridDim.x, (int)blockIdx.x); \
    pg8::EpiF32R E_{opq((float*)(Cptr)), opq((const float*)(Rptr)), (N_)}; \
    pg8::gemm_phase<pg8::EpiF32R, pg8::StaticOrder, true, true>(wave_s, ldsl, g_, S_, E_); } while (0)
#define GEMM_BF16_C(Aptr, Wt, Optr, M_, N_, C_) do { \
    pg8::Gemm g_{opq((const bf16*)(Aptr)), opq((const bf16*)(Wt)), (M_), (N_), DM}; pg8::StaticOrder S_; S_.init((M_), (N_), (int)gridDim.x, (C_)); \
    pg8::EpiBf16 E_{opq((bf16*)(Optr)), (N_)}; \
    pg8::gemm_phase<pg8::EpiBf16, pg8::StaticOrder, true, true>(wave_s, ldsl, g_, S_, E_); } while (0)
#define GEMM_BF16(Aptr, Wt, Optr, M_, N_) GEMM_BF16_C(Aptr, Wt, Optr, M_, N_, (int)blockIdx.x)
#define GEMM_F32RN(Aptr, Wt, Cptr, Rptr, XGptr, Gptr, STptr) do { \
    pg8::Gemm g_{opq((const bf16*)(Aptr)), opq((const bf16*)(Wt)), NT, DM, DM}; pg8::StaticOrder S_; S_.init(NT, DM, (int)gridDim.x, (int)blockIdx.x); \
    pg8::EpiF32RN E_{opq((float*)(Cptr)), opq((const float*)(Rptr)), DM, opq((bf16*)(XGptr)), opq((const float*)(Gptr)), opq((float*)(STptr))}; \
    pg8::gemm_phase<pg8::EpiF32RN, pg8::StaticOrder, true, true>(wave_s, ldsl, g_, S_, E_); } while (0)
#define GEMM_BF16S(Aptr, Wt, Optr, N_, STptr) do { \
    pg8::Gemm g_{opq((const bf16*)(Aptr)), opq((const bf16*)(Wt)), NT, (N_), DM}; pg8::StaticOrder S_; S_.init(NT, (N_), (int)gridDim.x, (int)blockIdx.x); \
    pg8::EpiBf16S E_{opq((bf16*)(Optr)), (N_), opq((const float*)(STptr))}; \
    pg8::gemm_phase<pg8::EpiBf16S, pg8::StaticOrder, true, true>(wave_s, ldsl, g_, S_, E_); } while (0)

__global__ void __launch_bounds__(NWAVES * 64, 2) fwd_megakernel(Params p) {
  extern __shared__ __attribute__((aligned(16))) unsigned char lds[];
  LAS unsigned char* ldsl = (LAS unsigned char*)lds;
  LAS float* smem = (LAS float*)ldsl;
  const int wave_s = __builtin_amdgcn_readfirstlane((int)(threadIdx.x >> 6));
  unsigned char* ws = p.ws;
  volatile LAS unsigned* MISC = (volatile LAS unsigned*)(ldsl + (LDS_BYTES - 256));
  if (threadIdx.x < 64) MISC[threadIdx.x] = 0u;
  __syncthreads();
  const XcdBarrier bar = xcd_barrier_post((unsigned*)(ws + WS_CTL) + 4096, MISC + 8);
  float* xw = (float*)(ws + WS_XW);
  bf16* xn = (bf16*)(ws + WS_XN);
  bf16* big = (bf16*)(ws + WS_BIG);
  bf16* y = (bf16*)(ws + WS_Y);
  bf16* memh = (bf16*)(ws + WS_MEMH);
  bf16* kvb = (bf16*)(ws + WS_KVB);
  bf16* vT = (bf16*)(ws + WS_VT);
  float* ssmE = (float*)(ws + WS_SSME);
  float* ssmp = (float*)(ws + WS_SSMP);
  int* ids = (int*)(ws + WS_IDS);
  float* gates = (float*)(ws + WS_GATE);
  bf16* skb = (bf16*)(ws + WS_SKB);
  unsigned char* ub = ws + WS_UB;
  unsigned char* vb = ws + WS_VB;
  float* rst = (float*)(ws + WS_RST);
  float* vsc = (float*)(ws + WS_VSC);
  float* usc = (float*)(ws + WS_USC);

  prologue_transposes(wave_s, p, ws, ldsl);
  cvt_rows_bf16(wave_s, karg_in(27), skb, (size_t)2 * 8 * 2 * 128 * 128);
  cvt_rows_i4(wave_s, karg_in(28), ub, vsc + 1, 2 * 16384);
  cvt_rows_v4(wave_s, karg_in(29), vb, vsc, 2 * 16384);
  for (int l = 0; l < 2; l++)
    rms_rows<true>(wave_s, karg_in(1), karg_in(21) + l * DM, memh + (size_t)l * 1024 * 1024, 1024);
  ssm_params(wave_s, p, ssmp);
  xcd_barrier(bar);
  rms_rows<true>(wave_s, karg_in(0), karg_in(2), xn, NT);
  xcd_barrier(bar);
  for (int l = 0; l < 2; l++)
    GEMM_BF16_C(memh + (size_t)l * 1024 * 1024, ws + WS_WT + (size_t)l * WT_LAYER + WT_MKV,
              kvb + (size_t)l * 1024 * 2048, 1024, 2048, (int)((blockIdx.x + gridDim.x - 64u - 32u * (unsigned)l) % gridDim.x));

#pragma nounroll
  for (int l = 0; l < 2; l++) {
    const float* xcur = (l == 0) ? karg_in(0) : xw;
    const float* sp = ssmp + (size_t)l * SSMP_PER_LAYER;
    const unsigned char* wl = ws + WS_WT + (size_t)l * WT_LAYER;
    GEMM_BF16(xn, wl + WT_IN, big, NT, DIN);
    xcd_barrier(bar);
    if (l == 0) vt_phase(wave_s, kvb, vT);
    ssm_chunk_end(wave_s, sp, big, ssmE, smem);
    attn_phase(wave_s, p, l, big, y, smem);
    conv_phase(wave_s, p, l, big, y, smem);
    xcd_barrier(bar);
    ssm_finish(wave_s, p, l, sp, big, ssmE, y, smem);
    xcd_barrier(bar);
    GEMM_F32RN(y, wl + WT_OUT, xw, xcur, xn, karg_in(20) + l * DM, rst);
    xcd_barrier(bar);
    GEMM_BF16S(xn, wl + WT_MQ, big, DM, rst);
    xcd_barrier(bar);
    memattn_phase(wave_s, big, kvb + (size_t)l * 1024 * 2048, vT + (size_t)l * 4 * 4 * 256 * 256, y, smem);
    xcd_barrier(bar);
    GEMM_F32RN(y, wl + WT_MO, xw, (const float*)xw, xn, karg_in(25) + l * DM, rst);
    xcd_barrier(bar);
    GEMM_BF16S(xn, wl + WT_PQ, big, 2048, rst);
    xcd_barrier(bar);
    peer_topk(wave_s, big, skb + (size_t)l * 8 * 2 * 128 * 128, ids, gates, smem);
    xcd_barrier(bar);
    if (l == 0) {
      peer_gather<false>(wave_s, xn, rst, ub + (size_t)l * 16384 * 512, vb + (size_t)l * 16384 * 512, vsc + (size_t)l * 2 * 16384, usc, ids, gates, xw, karg_in(2) + DM, (float*)nullptr);
      xcd_barrier(bar);
    } else {
      peer_gather<true>(wave_s, xn, rst, ub + (size_t)l * 16384 * 512, vb + (size_t)l * 16384 * 512, vsc + (size_t)l * 2 * 16384, usc, ids, gates, xw, karg_in(30), p.out);
    }
  }
}

extern "C" void kernel_launch(void* const* d_in, const int* in_sizes, int n_in,
                              void* d_out, int out_size, void* d_ws, size_t ws_size,
                              hipStream_t stream) {
  static int grid_blocks = 0;
  if (!grid_blocks) {
    int dev = 0, cus = 0, per_cu = 0;
    (void)hipGetDevice(&dev);
    (void)hipDeviceGetAttribute(&cus, hipDeviceAttributeMultiprocessorCount, dev);
    (void)hipFuncSetAttribute((const void*)fwd_megakernel, hipFuncAttributeMaxDynamicSharedMemorySize, LDS_BYTES);
    (void)hipOccupancyMaxActiveBlocksPerMultiprocessor(&per_cu, fwd_megakernel, NWAVES * 64, LDS_BYTES);
    if (per_cu < 1) fprintf(stderr, "occupancy query reports %d blocks/CU\n", per_cu);
    grid_blocks = cus;
  }
  (void)hipMemsetAsync((char*)d_ws + WS_CTL, 0, 1 * MiB, stream);
  Params p{};
  for (int i = 0; i < 31; i++) p.in[i] = (const float*)d_in[i];
  p.out = (float*)d_out;
  p.ws = (unsigned char*)d_ws;
  void* args[] = {&p};
  hipError_t e = hipLaunchCooperativeKernel((void*)fwd_megakernel, dim3(grid_blocks), dim3(NWAVES * 64),
                                            args, LDS_BYTES, stream);
  if (e != hipSuccess)
    fprintf(stderr, "cooperative launch failed: %s (grid %d)\n", hipGetErrorString(e), grid_blocks);
}
```

```cpp
#include <hip/hip_runtime.h>
#include <hip/hip_cooperative_groups.h>
#include <cstdio>
namespace cg = cooperative_groups;

#define NT 16384
#define SEQ 4096
#define DM 1024
#define DIN 2304
#define NMEM 256
#define EPSF 1e-6f
#define NWAVES 8
#define LDS_BYTES 147456

typedef unsigned short bf16;
#define LAS __attribute__((address_space(3)))

struct Params {
  const float* in[31];
  float* out;
  unsigned char* ws;
};
typedef __attribute__((address_space(4))) const unsigned char* kaptr_t;
__device__ __forceinline__ const float* karg_in(int i) {
  kaptr_t ka = (kaptr_t)__builtin_amdgcn_kernarg_segment_ptr();
  asm volatile("" : "+s"(ka));
  return *(const float* __attribute__((address_space(4))) const*)(ka + 8 * i);
}

constexpr size_t MiB = 1u << 20;
constexpr size_t WS_CTL  = 0;
constexpr size_t WS_WT   = 1 * MiB;
constexpr size_t WT_IN = 0, WT_OUT = WT_IN + (size_t)DIN * DM * 2, WT_MQ = WT_OUT + (size_t)DM * DM * 2,
                 WT_MKV = WT_MQ + (size_t)DM * DM * 2, WT_MO = WT_MKV + (size_t)2048 * DM * 2,
                 WT_PQ = WT_MO + (size_t)DM * DM * 2, WT_GLU = WT_PQ + (size_t)2048 * DM * 2, WT_LAYER = WT_GLU + (size_t)256 * 256 * 2;
constexpr size_t WS_XW   = WS_WT + 2 * WT_LAYER;
constexpr size_t WS_XN   = WS_XW + (size_t)NT * DM * 4;
constexpr size_t WS_BIG  = WS_XN + (size_t)NT * DM * 2;
constexpr size_t WS_Y    = WS_BIG + (size_t)NT * DIN * 2;
constexpr size_t WS_MEMH = WS_Y + (size_t)NT * DM * 2;
constexpr size_t WS_KVB  = WS_MEMH + (size_t)2 * 1024 * 1024 * 2;
constexpr size_t WS_VT   = WS_KVB + (size_t)2 * 1024 * 2048 * 2;
constexpr size_t WS_SSME = WS_VT + (size_t)2 * 4 * 4 * 256 * 256 * 2;
#define SSMP_PER_LAYER (2048 + 2048 + 32768)
constexpr size_t WS_SSMP = WS_SSME + (size_t)4 * 64 * 16 * 64 * 2 * 4;
constexpr size_t WS_IDS  = WS_SSMP + (size_t)2 * SSMP_PER_LAYER * 4;
constexpr size_t WS_GATE = WS_IDS + (size_t)NT * 128 * 4;
constexpr size_t WS_SKB  = WS_GATE + (size_t)NT * 128 * 4;
constexpr size_t WS_UB   = WS_SKB + (size_t)2 * 8 * 2 * 128 * 128 * 2;
constexpr size_t WS_VB   = WS_UB + (size_t)2 * 16384 * 512;
constexpr size_t WS_VSC  = WS_VB + (size_t)2 * 16384 * 512;
constexpr size_t WS_USC  = WS_VSC + (size_t)2 * 16384 * 4;
constexpr size_t WS_RST  = WS_USC + (size_t)2 * 16384 * 4;
constexpr size_t WS_END  = WS_RST + (size_t)NT * 16 * 4;
#define U_SCALE 64.0f
#define U4_STEP 0.3352f
#define V4_LUT_LO 0x3B393630u
#define V4_LUT_HI 0x41403E3Du
#define V4_ROWSCALE 1.075f
static_assert(WS_END <= 512 * MiB, "workspace");
static_assert(WT_LAYER % 256 == 0 && WS_SSMP % 16 == 0 && WS_IDS % 16 == 0 && WS_SKB % 256 == 0 && WS_VT % 256 == 0, "align");

__device__ __forceinline__ int opaque_tid(int wave_s) { int v = wave_s * 64 + (int)__builtin_amdgcn_mbcnt_hi(~0u, __builtin_amdgcn_mbcnt_lo(~0u, 0u)); asm volatile("" : "+v"(v)); return v; }
__device__ __forceinline__ unsigned f2bf(float f) { unsigned u = __builtin_bit_cast(unsigned, f); return (u + 0x7fffu + ((u >> 16) & 1u)) >> 16; }
__device__ __forceinline__ unsigned pk2(float lo, float hi) { return f2bf(lo) | (f2bf(hi) << 16); }
__device__ __forceinline__ float bf_lo(unsigned u) { return __builtin_bit_cast(float, u << 16); }
__device__ __forceinline__ float bf_hi(unsigned u) { return __builtin_bit_cast(float, u & 0xffff0000u); }
__device__ __forceinline__ float bf2f(bf16 h) { return __builtin_bit_cast(float, (unsigned)h << 16); }


#define XB_TMO      128
#define XB_XCNT(j)  (256  + 64 * (j))
#define XB_XSUB(j)  (1280 + 64 * (j))
#define XB_XGEN(j)  (2304 + 64 * (j))
#define XB_TOP      3328
#define XB_TOPGEN   3392
#define XCD_BAR_WORDS 3456
#define XB_SPIN_CAP (1u << 22)
__device__ __forceinline__ unsigned xb_ld(unsigned* p)              { return __hip_atomic_load(p, __ATOMIC_RELAXED, __HIP_MEMORY_SCOPE_AGENT); }
__device__ __forceinline__ unsigned xb_add(unsigned* p, unsigned v) { return __hip_atomic_fetch_add(p, v, __ATOMIC_RELAXED, __HIP_MEMORY_SCOPE_AGENT); }
__device__ __forceinline__ unsigned xb_xcc_id() { return (unsigned)__builtin_amdgcn_s_getreg((3 << 11) | 20) & 0xFu; }
#define XB_SPIN(cond, bar) do { unsigned _sp = 0; while (cond) { __builtin_amdgcn_s_sleep(1); \
    if ((++_sp & 255u) == 0u) { if (xb_ld(&(bar)[XB_TMO])) break; if (_sp > XB_SPIN_CAP) { atomicAdd(&(bar)[XB_TMO], 1u); break; } } } } while (0)
struct XcdBarrier { unsigned* bar; unsigned x; volatile LAS unsigned* st; };
__device__ __forceinline__ XcdBarrier xcd_barrier_post(unsigned* bar, volatile LAS unsigned* st) {
    XcdBarrier b; b.bar = bar; b.x = xb_xcc_id(); b.st = st;
    if (threadIdx.x == 0) (void)xb_add(&bar[XB_XCNT(b.x)], 1u);
    return b;
}
__device__ __forceinline__ void xcd_barrier_complete(unsigned* bar, unsigned x, unsigned& nloc, unsigned& nx) {
    const unsigned G = gridDim.x * gridDim.y * gridDim.z;
    unsigned sum, cnt, mine, sp = 0u;
    for (;;) {
        sum = 0u; cnt = 0u; mine = 0u;
#pragma unroll
        for (unsigned j = 0; j < 16; ++j) { const unsigned c = xb_ld(&bar[XB_XCNT(j)]); sum += c; cnt += (c > 0u) ? 1u : 0u; mine = (j == x) ? c : mine; }
        if (sum == G) break;
        __builtin_amdgcn_s_sleep(1);
        if ((++sp & 255u) == 0u) { if (xb_ld(&bar[XB_TMO])) break; if (sp > XB_SPIN_CAP) { atomicAdd(&bar[XB_TMO], 1u); break; } }
    }
    nloc = mine > 0u ? mine : 1u; nx = cnt > 0u ? cnt : 1u;
}
__device__ __forceinline__ void xcd_barrier(const XcdBarrier& b) {
    asm volatile("s_waitcnt vmcnt(0)" ::: "memory");
    __syncthreads();
    if (threadIdx.x == 0) {
        unsigned* bar = b.bar;
        __builtin_amdgcn_s_waitcnt(0);
        unsigned nloc = b.st[0], nx = b.st[1];
        if (nloc == 0u) { xcd_barrier_complete(bar, b.x, nloc, nx); b.st[0] = nloc; b.st[1] = nx; }
        const unsigned old = xb_add(&bar[XB_XSUB(b.x)], 1u);
        const unsigned gen = old / nloc;
        if (old + 1u == (gen + 1u) * nloc) {
            __builtin_amdgcn_fence(__ATOMIC_RELEASE, "agent");
            asm volatile("s_waitcnt vmcnt(0)" ::: "memory");
            const unsigned og = xb_add(&bar[XB_TOP], 1u);
            const unsigned tg = og / nx;
            if (og + 1u == (tg + 1u) * nx) xb_add(&bar[XB_TOPGEN], 1u);
            else XB_SPIN(xb_ld(&bar[XB_TOPGEN]) == tg, bar);
            __builtin_amdgcn_fence(__ATOMIC_ACQUIRE, "agent");
            xb_add(&bar[XB_XGEN(b.x)], 1u);
            asm volatile("s_waitcnt vmcnt(0)" ::: "memory");
        } else {
            XB_SPIN(xb_ld(&bar[XB_XGEN(b.x)]) == gen, bar);
            __builtin_amdgcn_fence(__ATOMIC_ACQUIRE, "agent");
            asm volatile("s_waitcnt vmcnt(0)" ::: "memory");
        }
    }
    __syncthreads();
}

namespace pg8 {
#define PG8_LAS __attribute__((address_space(3)))
typedef unsigned short bf16_t;
typedef short bf16x8 __attribute__((ext_vector_type(8)));
typedef float f32x4 __attribute__((ext_vector_type(4)));
typedef unsigned u32x4 __attribute__((ext_vector_type(4)));
constexpr int BM = 256, BK = 64, HALF = 128, HTB = HALF * BK * 2, STAGE_BYTES = 8 * HTB, NXCD = 8, WGM = 8;
__host__ __device__ __forceinline__ int lds_byte(int r, int c) { const int st = (r >> 4) * 2 + (c >> 5), rr = r & 15, cc = c & 31, ob = rr * 64 + cc * 2; return st * 1024 + (ob ^ (((ob >> 9) & 1) << 5)); }
__host__ __device__ __forceinline__ void stage_rc(int b, int& R, int& C) { const int st = b / 1024, sb = b % 1024, swz = sb ^ (((sb >> 9) & 1) << 5); R = (st >> 1) * 16 + swz / 64; C = (st & 1) * 32 + (swz % 64) / 2; }
__host__ __device__ __forceinline__ int perm32(int rho) { const int n = rho >> 4, i = rho & 15; return 8 * (i >> 2) + 4 * n + (i & 3); }
struct Unit { int pm, pn; };
struct Gemm { const bf16_t* A; const bf16_t* Bt; int M, N, K; };
struct StaticOrder {
    int nM, nN, nwg, G, c;
    __host__ __device__ __forceinline__ void init(int M, int N, int G_, int c_) { nM = M / BM; nN = N / BM; nwg = nM * nN; G = G_; c = c_; }
    __host__ __device__ bool next(int i, Unit& u) const {
        const long L = (long)i * G + c; if (L >= nwg) return false;
        int wgid = (int)L; { const int q = nwg / NXCD, r = nwg % NXCD, xcd = wgid % NXCD, off = wgid / NXCD; wgid = (xcd < r ? xcd * (q + 1) : r * (q + 1) + (xcd - r) * q) + off; }
        const int nig = WGM * nN, gid = wgid / nig, fm = gid * WGM, gsz = (nM - fm) < WGM ? (nM - fm) : WGM;
        u.pm = fm + ((wgid % nig) % gsz); u.pn = (wgid % nig) / gsz; return true;
    }
    __device__ __forceinline__ void a_ready(const Unit&) const {}
    __device__ __forceinline__ void done(const Unit&) const {}
};
__device__ __forceinline__ unsigned cvt_pk_bf16(float lo, float hi) { unsigned r; asm volatile("v_cvt_pk_bf16_f32 %0, %1, %2" : "=v"(r) : "v"(lo), "v"(hi)); return r; }

struct EpiF32R {
    static constexpr bool PERM = false, AFTER_DRAIN = false;
    float* C; const float* R; int ldc;
    __device__ __forceinline__ void operator()(const f32x4 (&acc)[2][2][4][2], const Unit& u, int wr, int wc, int fr, int fq) const {
        const int row0 = u.pm * BM + wr * 64 + fr, col0 = u.pn * BM + wc * 32 + 4 * fq;
#pragma unroll
        for (int ai = 0; ai < 2; ++ai)
#pragma unroll
            for (int m = 0; m < 4; ++m) {
                const size_t ro = (size_t)(row0 + ai * HALF + m * 16) * ldc + col0;
                f32x4 rv[2][2];
#pragma unroll
                for (int bj = 0; bj < 2; ++bj)
#pragma unroll
                    for (int n = 0; n < 2; ++n) rv[bj][n] = R ? *(const f32x4*)(R + ro + bj * HALF + n * 16) : (f32x4){0.f, 0.f, 0.f, 0.f};
#pragma unroll
                for (int bj = 0; bj < 2; ++bj)
#pragma unroll
                    for (int n = 0; n < 2; ++n) *(f32x4*)(C + ro + bj * HALF + n * 16) = acc[ai][bj][m][n] + rv[bj][n];
                __builtin_amdgcn_sched_barrier(0);
            }
    }
};

struct EpiBf16 {
    static constexpr bool PERM = true, AFTER_DRAIN = false;
    bf16_t* O; int ldc;
    __device__ __forceinline__ void operator()(const f32x4 (&acc)[2][2][4][2], const Unit& u, int wr, int wc, int fr, int fq) const {
        const int row0 = u.pm * BM + wr * 64 + fr, col0 = u.pn * BM + wc * 32 + 8 * fq;
#pragma unroll
        for (int ai = 0; ai < 2; ++ai)
#pragma unroll
            for (int m = 0; m < 4; ++m) { bf16_t* rowp = O + (size_t)(row0 + ai * HALF + m * 16) * ldc + col0;
#pragma unroll
                for (int bj = 0; bj < 2; ++bj) { const f32x4 v0 = acc[ai][bj][m][0], v1 = acc[ai][bj][m][1];
                    u32x4 w; w.x = cvt_pk_bf16(v0[0], v0[1]); w.y = cvt_pk_bf16(v0[2], v0[3]); w.z = cvt_pk_bf16(v1[0], v1[1]); w.w = cvt_pk_bf16(v1[2], v1[3]);
                    *(u32x4*)(rowp + bj * HALF) = w; } }
    }
};

struct EpiF32RN {
    static constexpr bool PERM = false, AFTER_DRAIN = false;
    float* C; const float* R; int ldc; bf16_t* XG; const float* g; float* st;
    __device__ __forceinline__ void operator()(const f32x4 (&acc)[2][2][4][2], const Unit& u, int wr, int wc, int fr, int fq) const {
        const int row0 = u.pm * BM + wr * 64 + fr, col0 = u.pn * BM + wc * 32 + 4 * fq;
        f32x4 gv[2][2];
#pragma unroll
        for (int bj = 0; bj < 2; ++bj)
#pragma unroll
            for (int n = 0; n < 2; ++n) gv[bj][n] = *(const f32x4*)(g + col0 + bj * HALF + n * 16);
#pragma unroll
        for (int ai = 0; ai < 2; ++ai)
#pragma unroll
            for (int m = 0; m < 4; ++m) {
                const int row = row0 + ai * HALF + m * 16;
                const size_t ro = (size_t)row * ldc + col0;
                f32x4 rv[2][2];
#pragma unroll
                for (int bj = 0; bj < 2; ++bj)
#pragma unroll
                    for (int n = 0; n < 2; ++n) rv[bj][n] = *(const f32x4*)(R + ro + bj * HALF + n * 16);
                float ss = 0.f;
#pragma unroll
                for (int bj = 0; bj < 2; ++bj)
#pragma unroll
                    for (int n = 0; n < 2; ++n) {
                        const f32x4 v = acc[ai][bj][m][n] + rv[bj][n];
                        *(f32x4*)(C + ro + bj * HALF + n * 16) = v;
                        ss += (v[0] * v[0] + v[1] * v[1]) + (v[2] * v[2] + v[3] * v[3]);
                        const f32x4 w = v * gv[bj][n];
                        uint2 pk; pk.x = cvt_pk_bf16(w[0], w[1]); pk.y = cvt_pk_bf16(w[2], w[3]);
                        *(uint2*)(XG + ro + bj * HALF + n * 16) = pk;
                    }
                ss += __shfl_xor(ss, 16, 64); ss += __shfl_xor(ss, 32, 64);
                if (fq == 0) st[(size_t)row * 16 + u.pn * 4 + wc] = ss;
                __builtin_amdgcn_sched_barrier(0);
            }
    }
};
struct EpiBf16S {
    static constexpr bool PERM = true, AFTER_DRAIN = false;
    bf16_t* O; int ldc; const float* st;
    __device__ __forceinline__ void operator()(const f32x4 (&acc)[2][2][4][2], const Unit& u, int wr, int wc, int fr, int fq) const {
        const int row0 = u.pm * BM + wr * 64 + fr, col0 = u.pn * BM + wc * 32 + 8 * fq;
#pragma unroll
        for (int ai = 0; ai < 2; ++ai)
#pragma unroll
            for (int m = 0; m < 4; ++m) {
                const int row = row0 + ai * HALF + m * 16;
                const f32x4* sp = (const f32x4*)(st + (size_t)row * 16);
                const f32x4 s0 = sp[0], s1 = sp[1], s2 = sp[2], s3 = sp[3];
                const f32x4 sa = (s0 + s1) + (s2 + s3);
                const float rs = __builtin_amdgcn_rsqf(((sa[0] + sa[1]) + (sa[2] + sa[3])) * (1.0f / 1024.f) + 1e-6f);
                bf16_t* rowp = O + (size_t)row * ldc + col0;
#pragma unroll
                for (int bj = 0; bj < 2; ++bj) { const f32x4 v0 = acc[ai][bj][m][0] * rs, v1 = acc[ai][bj][m][1] * rs;
                    u32x4 w; w.x = cvt_pk_bf16(v0[0], v0[1]); w.y = cvt_pk_bf16(v0[2], v0[3]); w.z = cvt_pk_bf16(v1[0], v1[1]); w.w = cvt_pk_bf16(v1[2], v1[3]);
                    *(u32x4*)(rowp + bj * HALF) = w; }
                __builtin_amdgcn_sched_barrier(0);
            }
    }
};

template <class Epi, class Sched, bool ALIGN_EPI = false, bool SP2 = false>
__device__ __forceinline__ void gemm_phase(const int wave_s, PG8_LAS unsigned char* lds, const Gemm g, const Sched& S, const Epi& E) {
    const int tid = opaque_tid(wave_s), wid = __builtin_amdgcn_readfirstlane(tid >> 6), lane = tid & 63, wr = wid >> 2, wc = wid & 3, fr = lane & 15, fq = lane >> 4;
    const int K = g.K, nt = K / BK;
    unsigned voffA[2], voffB[2];
#pragma unroll
    for (int i = 0; i < 2; ++i) { int R, C; stage_rc(tid * 16 + i * 8192, R, C); const int Rb = Epi::PERM ? ((R & ~31) + perm32(R & 31)) : R;
        voffA[i] = (unsigned)(R * K + C) * 2u; voffB[i] = (unsigned)(Rb * K + C) * 2u; }
    const size_t kstep = (size_t)(BK * 2);
    const size_t hstep = (size_t)HALF * K * 2;
    const size_t tstep = 2 * hstep;
    const unsigned ldsw = (unsigned)wid * 1024u;
    const int aoff = lds_byte(wr * 64 + fr, fq * 8), boff = lds_byte(wc * 32 + fr, fq * 8);
#define PG8_SA(b, h) (((b) * 2 + (h)) * HTB)
#define PG8_SB(b, h) ((4 + (b) * 2 + (h)) * HTB)
#define PG8_STAGE(bufoff, gbase, voff) do { _Pragma("unroll") for (int _i = 0; _i < 2; ++_i) \
        __builtin_amdgcn_global_load_lds((const unsigned*)((const char*)(gbase) + (voff)[_i]), (PG8_LAS unsigned*)(lds + (bufoff) + ldsw + _i * 8192), 16, 0, 0); } while (0)
#define PG8_LDA(dst, b, h) do { _Pragma("unroll") for (int m = 0; m < 4; ++m) _Pragma("unroll") for (int k = 0; k < 2; ++k) dst[m][k] = *(const PG8_LAS bf16x8*)(lds + PG8_SA(b, h) + aoff + m * 2048 + k * 1024); } while (0)
#define PG8_LDB(dst, b, h) do { _Pragma("unroll") for (int n = 0; n < 2; ++n) _Pragma("unroll") for (int k = 0; k < 2; ++k) dst[n][k] = *(const PG8_LAS bf16x8*)(lds + PG8_SB(b, h) + boff + n * 2048 + k * 1024); } while (0)
#define PG8_MMA(ai, bj, At, Bt) do { __builtin_amdgcn_s_setprio(1); _Pragma("unroll") for (int m = 0; m < 4; ++m) _Pragma("unroll") for (int n = 0; n < 2; ++n) _Pragma("unroll") for (int k = 0; k < 2; ++k) \
        acc[ai][bj][m][n] = __builtin_amdgcn_mfma_f32_16x16x32_bf16(Bt[n][k], At[m][k], acc[ai][bj][m][n], 0, 0, 0); __builtin_amdgcn_s_setprio(0); } while (0)
#define PG8_WAIT_V(n) asm volatile("s_waitcnt vmcnt(" #n ")" ::: "memory")
#define PG8_WAIT_L(n) asm volatile("s_waitcnt lgkmcnt(" #n ")" ::: "memory")
#define PG8_BAR __builtin_amdgcn_s_barrier()
#define PG8_SCHED __builtin_amdgcn_sched_barrier(0)
    Unit cur, nxt; int ui = 0;
    if (!S.next(0, cur)) return;
    f32x4 acc[2][2][4][2];
#pragma unroll
    for (int a = 0; a < 2; ++a)
#pragma unroll
        for (int b = 0; b < 2; ++b)
#pragma unroll
            for (int m = 0; m < 4; ++m)
#pragma unroll
                for (int n = 0; n < 2; ++n) acc[a][b][m][n] = (f32x4){0.f, 0.f, 0.f, 0.f};
    bf16x8 At[4][2], B0[2][2], B1[2][2];
    const char* cA = (const char*)g.A + (size_t)cur.pm * tstep; const char* cB = (const char*)g.Bt + (size_t)cur.pn * tstep;
    S.a_ready(cur);
    if constexpr (SP2) {
        PG8_STAGE(PG8_SB(0, 0), cB, voffB); PG8_STAGE(PG8_SB(0, 1), cB + hstep, voffB); PG8_STAGE(PG8_SA(0, 0), cA, voffA); PG8_STAGE(PG8_SA(0, 1), cA + hstep, voffA);
        if (wr == 1) PG8_BAR;
        PG8_WAIT_V(2); PG8_BAR;
        PG8_STAGE(PG8_SB(1, 0), cB + kstep, voffB); PG8_STAGE(PG8_SA(1, 0), cA + kstep, voffA); PG8_STAGE(PG8_SB(1, 1), cB + hstep + kstep, voffB);
        PG8_WAIT_V(6); PG8_BAR;
    } else {
        PG8_STAGE(PG8_SB(0, 0), cB, voffB); PG8_STAGE(PG8_SA(0, 0), cA, voffA); PG8_STAGE(PG8_SB(0, 1), cB + hstep, voffB); PG8_STAGE(PG8_SA(0, 1), cA + hstep, voffA);
        if (wr == 1) PG8_BAR;
        PG8_WAIT_V(4); PG8_BAR;
        PG8_STAGE(PG8_SB(1, 0), cB + kstep, voffB); PG8_STAGE(PG8_SA(1, 0), cA + kstep, voffA); PG8_STAGE(PG8_SB(1, 1), cB + hstep + kstep, voffB);
        PG8_WAIT_V(6); PG8_BAR;
    }
    for (;;) {
        const bool has_next = S.next(ui + 1, nxt);
        const char* nA = has_next ? (const char*)g.A + (size_t)nxt.pm * tstep : cA; const char* nB = has_next ? (const char*)g.Bt + (size_t)nxt.pn * tstep : cB;
        for (int t = 0; t < nt; t += 2) {
            const bool last = (t == nt - 2);
            const char* a1 = cA + (size_t)(t + 1) * kstep;
            const char* a2 = last ? nA : cA + (size_t)(t + 2) * kstep; const char* b2 = last ? nB : cB + (size_t)(t + 2) * kstep;
            const char* a3 = a2 + kstep; const char* b3 = b2 + kstep;
            if (last && has_next) S.a_ready(nxt);
            if constexpr (SP2) {
            PG8_LDB(B0, 0, 0); PG8_LDB(B1, 0, 1); PG8_SCHED; PG8_LDA(At, 0, 0); PG8_STAGE(PG8_SA(1, 1), a1 + hstep, voffA);
            PG8_WAIT_V(8); PG8_WAIT_L(0); PG8_BAR; PG8_MMA(0, 0, At, B0); PG8_MMA(0, 1, At, B1); PG8_BAR; PG8_SCHED;
            PG8_LDA(At, 0, 1); PG8_STAGE(PG8_SB(0, 0), b2, voffB); PG8_STAGE(PG8_SB(0, 1), b2 + hstep, voffB); PG8_STAGE(PG8_SA(0, 0), a2, voffA);
            PG8_WAIT_V(8); PG8_WAIT_L(0); PG8_BAR; PG8_MMA(1, 0, At, B0); PG8_MMA(1, 1, At, B1); PG8_BAR; PG8_SCHED;
            PG8_LDB(B0, 1, 0); PG8_LDB(B1, 1, 1); PG8_SCHED; PG8_LDA(At, 1, 0); PG8_STAGE(PG8_SA(0, 1), a2 + hstep, voffA);
            PG8_WAIT_V(8); PG8_WAIT_L(0); PG8_BAR; PG8_MMA(0, 0, At, B0); PG8_MMA(0, 1, At, B1); PG8_BAR; PG8_SCHED;
            PG8_LDA(At, 1, 1); PG8_STAGE(PG8_SB(1, 0), b3, voffB); PG8_STAGE(PG8_SB(1, 1), b3 + hstep, voffB); PG8_STAGE(PG8_SA(1, 0), a3, voffA);
            PG8_WAIT_V(8); PG8_WAIT_L(0); PG8_BAR; PG8_MMA(1, 0, At, B0); PG8_MMA(1, 1, At, B1); PG8_BAR; PG8_SCHED;
            } else {
            PG8_LDB(B0, 0, 0); PG8_SCHED; PG8_LDA(At, 0, 0); PG8_STAGE(PG8_SA(1, 1), a1 + hstep, voffA);
            PG8_WAIT_L(8); PG8_BAR; PG8_WAIT_L(0); PG8_MMA(0, 0, At, B0); PG8_BAR; PG8_SCHED;
            PG8_LDB(B1, 0, 1); PG8_STAGE(PG8_SB(0, 0), b2, voffB);
            PG8_BAR; PG8_WAIT_L(0); PG8_MMA(0, 1, At, B1); PG8_BAR;
            PG8_LDA(At, 0, 1); PG8_STAGE(PG8_SA(0, 0), a2, voffA);
            PG8_BAR; PG8_WAIT_L(0); PG8_MMA(1, 0, At, B0); PG8_BAR; PG8_SCHED;
            PG8_STAGE(PG8_SB(0, 1), b2 + hstep, voffB);
            PG8_WAIT_V(6); PG8_BAR; PG8_MMA(1, 1, At, B1); PG8_BAR;
            PG8_LDB(B0, 1, 0); PG8_SCHED; PG8_LDA(At, 1, 0); PG8_STAGE(PG8_SA(0, 1), a2 + hstep, voffA);
            PG8_WAIT_L(8); PG8_BAR; PG8_WAIT_L(0); PG8_MMA(0, 0, At, B0); PG8_BAR; PG8_SCHED;
            PG8_LDB(B1, 1, 1); PG8_STAGE(PG8_SB(1, 0), b3, voffB);
            PG8_BAR; PG8_WAIT_L(0); PG8_MMA(0, 1, At, B1); PG8_BAR;
            PG8_LDA(At, 1, 1); PG8_STAGE(PG8_SA(1, 0), a3, voffA);
            PG8_BAR; PG8_WAIT_L(0); PG8_MMA(1, 0, At, B0); PG8_BAR; PG8_SCHED;
            PG8_STAGE(PG8_SB(1, 1), b3 + hstep, voffB);
            PG8_WAIT_V(6); PG8_BAR; PG8_MMA(1, 1, At, B1); PG8_BAR;
            }
        }
        if constexpr (ALIGN_EPI) { if (wr == 0) PG8_BAR; }
        if constexpr (!Epi::AFTER_DRAIN) { E(acc, cur, wr, wc, fr, fq); S.done(cur); }
        if (!has_next) break;
#pragma unroll
        for (int a = 0; a < 2; ++a)
#pragma unroll
            for (int b = 0; b < 2; ++b)
#pragma unroll
                for (int m = 0; m < 4; ++m)
#pragma unroll
                    for (int n = 0; n < 2; ++n) acc[a][b][m][n] = (f32x4){0.f, 0.f, 0.f, 0.f};
        cur = nxt; cA = nA; cB = nB; ++ui;
        if constexpr (ALIGN_EPI) { if (wr == 1) PG8_BAR; }
    }
    PG8_WAIT_V(0);
    if constexpr (!ALIGN_EPI) { if (wr == 0) PG8_BAR; }
    PG8_BAR;
#undef PG8_SA
#undef PG8_SB
#undef PG8_STAGE
#undef PG8_LDA
#undef PG8_LDB
#undef PG8_MMA
#undef PG8_WAIT_V
#undef PG8_WAIT_L
#undef PG8_BAR
#undef PG8_SCHED
}
}

__device__ __forceinline__ void transpose_item(const float* W, int K, int N, bf16* WT, LAS float* scr, int item, int lane) {
    const int nblk = N / 32, kb = item / nblk, nb = item % nblk, k0 = 64 * kb, n0 = 32 * nb;
#pragma unroll 8
    for (int i = 0; i < 32; ++i) { const int kk = 2 * i + (lane >> 5); scr[kk * 33 + (lane & 31)] = W[(size_t)(k0 + kk) * N + n0 + (lane & 31)]; }
    asm volatile("s_waitcnt lgkmcnt(0)" ::: "memory");
    const int c = lane & 7;
#pragma unroll
    for (int j = 0; j < 4; ++j) { const int n = (lane >> 3) + 8 * j; const LAS float* s = scr + (8 * c) * 33 + n;
        uint4 o; o.x = pk2(s[0 * 33], s[1 * 33]); o.y = pk2(s[2 * 33], s[3 * 33]); o.z = pk2(s[4 * 33], s[5 * 33]); o.w = pk2(s[6 * 33], s[7 * 33]);
        *(uint4*)(WT + (size_t)(n0 + n) * K + k0 + 8 * c) = o; }
    asm volatile("s_waitcnt lgkmcnt(0)" ::: "memory");
}

__device__ __forceinline__ float wsum(float v) {
#pragma unroll
  for (int o = 32; o > 0; o >>= 1) v += __shfl_xor(v, o, 64);
  return v;
}
__device__ __forceinline__ float wmaxf(float v) {
#pragma unroll
  for (int o = 32; o > 0; o >>= 1) v = fmaxf(v, __shfl_xor(v, o, 64));
  return v;
}
__device__ __forceinline__ float sigmoidf_(float x) { return __builtin_amdgcn_rcpf(1.0f + __expf(-x)); }
__device__ __forceinline__ float gelu_tanh(float x) {
  return x * sigmoidf_(1.5957691216057308f * (x + 0.044715f * x * x * x));
}

template <bool BF16OUT>
__device__ __forceinline__ void rms_rows(const int wave_s, const float* src, const float* g, void* dstv, int rows) {
  const int tid_ = opaque_tid(wave_s);
  const int lane = tid_ & 63;
  const int gw = blockIdx.x * NWAVES + (tid_ >> 6);
  const int nw = gridDim.x * NWAVES;
  for (int r = gw; r < rows; r += nw) {
    const float4* s4 = (const float4*)(src + (size_t)r * DM);
    float4 v[4];
    float ss = 0.f;
#pragma unroll
    for (int i = 0; i < 4; i++) {
      v[i] = s4[lane + i * 64];
      ss += v[i].x * v[i].x + v[i].y * v[i].y + v[i].z * v[i].z + v[i].w * v[i].w;
    }
    ss = wsum(ss);
    const float rstd = rsqrtf(ss * (1.0f / DM) + EPSF);
    const float4* g4 = (const float4*)g;
#pragma unroll
    for (int i = 0; i < 4; i++) {
      float4 gg = g4[lane + i * 64];
      float4 o;
      o.x = v[i].x * rstd * gg.x; o.y = v[i].y * rstd * gg.y;
      o.z = v[i].z * rstd * gg.z; o.w = v[i].w * rstd * gg.w;
      if (BF16OUT) {
        uint2 pk; pk.x = pk2(o.x, o.y); pk.y = pk2(o.z, o.w);
        ((uint2*)((bf16*)dstv + (size_t)r * DM))[lane + i * 64] = pk;
      } else {
        ((float4*)((float*)dstv + (size_t)r * DM))[lane + i * 64] = o;
      }
    }
  }
}

__device__ __forceinline__ void ssm_params(const int wave_s, const Params& p, float* ssmp_all) {
  const int tid_ = opaque_tid(wave_s);
  const float* in8 = karg_in(8); const float* in9 = karg_in(9); const float* in10 = karg_in(10);
  const float* in11 = karg_in(11); const float* in12 = karg_in(12);
  const int gt = blockIdx.x * blockDim.x + tid_;
  const int nth = gridDim.x * blockDim.x;
  for (int i = gt; i < 2 * 16 * 64; i += nth) {
    const int l = i / 1024, gp = i % 1024, g = gp / 64;
    float* sp = ssmp_all + (size_t)l * SSMP_PER_LAYER;
    const float lre = fminf(in8[l * 1024 + gp], -1e-4f);
    const float lim = in9[l * 1024 + gp];
    const float dt = expf(in10[l * 16 + g]);
    const float er = expf(lre * dt);
    float sn, cs;
    sincosf(lim * dt, &sn, &cs);
    const float br = er * cs, bi = er * sn;
    sp[gp * 2 + 0] = br;
    sp[gp * 2 + 1] = bi;
    float cr = br, ci = bi;
#pragma unroll
    for (int s = 0; s < 6; s++) {
      const float nr = cr * cr - ci * ci, ni = 2.f * cr * ci;
      cr = nr; ci = ni;
    }
    sp[2048 + gp * 2 + 0] = cr;
    sp[2048 + gp * 2 + 1] = ci;
    const float nr = br - 1.0f, ni = bi;
    const float den = lre * lre + lim * lim;
    const float fr = (nr * lre + ni * lim) / den;
    const float fi = (ni * lre - nr * lim) / den;
    for (int h = 0; h < 16; h++) {
      const float bre = in11[((size_t)l * 1024 + gp) * 16 + h];
      const float bim = in12[((size_t)l * 1024 + gp) * 16 + h];
      sp[4096 + ((g * 16 + h) * 64 + (gp & 63)) * 2 + 0] = fr * bre - fi * bim;
      sp[4096 + ((g * 16 + h) * 64 + (gp & 63)) * 2 + 1] = fr * bim + fi * bre;
    }
  }
}

__device__ __forceinline__ void conv_phase(const int wave_s, const Params& p, int l, const bf16* proj, bf16* y, LAS float* smem) {
  const int tid_ = opaque_tid(wave_s);
  const int lane = tid_ & 63;
  const int gw = blockIdx.x * NWAVES + (tid_ >> 6);
  const int nw = gridDim.x * NWAVES;
  const float* cw = karg_in(4) + (size_t)l * 31 * 256;
  const float4 cb = ((const float4*)(karg_in(5) + l * 256))[lane];
  const float4 lg = ((const float4*)(karg_in(6) + l * 256))[lane];
  const float4 lb = ((const float4*)(karg_in(7) + l * 256))[lane];
  const float4 gg = ((const float4*)(karg_in(18) + l * 1024))[lane];
  LAS float* cwl = smem + 1024;
  for (int i = tid_; i < 31 * 256 / 4; i += NWAVES * 64) *(LAS pg8::f32x4*)(cwl + 4 * i) = *(const pg8::f32x4*)(cw + 4 * i);
  __syncthreads();
  for (int it = gw; it < NT / 8; it += nw) {
    const int tok0 = it * 8;
    const int t0 = tok0 & (SEQ - 1);
    float4 acc[8];
#pragma unroll
    for (int o = 0; o < 8; o++) acc[o] = cb;
#pragma unroll
    for (int i = 0; i < 38; i++) {
      if (t0 - 30 + i >= 0) {
        const bf16* row = proj + (size_t)(tok0 - 30 + i) * DIN;
        const uint2 vp = ((const uint2*)row)[lane];
        const uint2 gp = ((const uint2*)(row + 256))[lane];
        float4 g4;
        g4.x = bf_lo(vp.x) * sigmoidf_(bf_lo(gp.x)); g4.y = bf_hi(vp.x) * sigmoidf_(bf_hi(gp.x));
        g4.z = bf_lo(vp.y) * sigmoidf_(bf_lo(gp.y)); g4.w = bf_hi(vp.y) * sigmoidf_(bf_hi(gp.y));
#pragma unroll
        for (int o = 0; o < 8; o++) {
          const int j = i - o;
          if (j >= 0 && j <= 30) {
            const pg8::f32x4 w4 = *(const LAS pg8::f32x4*)(cwl + j * 256 + lane * 4);
            acc[o].x += g4.x * w4[0]; acc[o].y += g4.y * w4[1];
            acc[o].z += g4.z * w4[2]; acc[o].w += g4.w * w4[3];
          }
        }
      }
    }
#pragma unroll
    for (int o = 0; o < 8; o++) {
      const float4 a = acc[o];
      const float mean = wsum(a.x + a.y + a.z + a.w) * (1.0f / 256.f);
      const float dx = a.x - mean, dy = a.y - mean, dz = a.z - mean, dw = a.w - mean;
      const float var = wsum(dx * dx + dy * dy + dz * dz + dw * dw) * (1.0f / 256.f);
      const float rs = rsqrtf(var + EPSF);
      float4 s;
      s.x = dx * rs * lg.x + lb.x; s.y = dy * rs * lg.y + lb.y;
      s.z = dz * rs * lg.z + lb.z; s.w = dw * rs * lg.w + lb.w;
      s.x = s.x * sigmoidf_(s.x); s.y = s.y * sigmoidf_(s.y);
      s.z = s.z * sigmoidf_(s.z); s.w = s.w * sigmoidf_(s.w);
      const float ss = wsum(s.x * s.x + s.y * s.y + s.z * s.z + s.w * s.w) * (1.0f / 256.f);
      const float r2 = rsqrtf(ss + EPSF);
      uint2 pk; pk.x = pk2(s.x * r2 * gg.x, s.y * r2 * gg.y); pk.y = pk2(s.z * r2 * gg.z, s.w * r2 * gg.w);
      ((uint2*)(y + (size_t)(tok0 + o) * DM))[lane] = pk;
    }
  }
}

typedef short bf16x8_t __attribute__((ext_vector_type(8)));
typedef float f32x16_t __attribute__((ext_vector_type(16)));
#define MFMA_PAD() do { __builtin_amdgcn_sched_barrier(0); asm volatile("s_nop 15\n\ts_nop 15" ::: "memory"); __builtin_amdgcn_sched_barrier(0); } while (0)

__device__ __forceinline__ void attn_phase(const int wave_s, const Params& p, int l, const bf16* proj, bf16* y, LAS float* smem) {
  const int tid = opaque_tid(wave_s), lane = tid & 63, wave = tid >> 6;
  const int n = lane & 31, hh = lane >> 5;
  const float* gg = karg_in(18) + l * 1024 + 256 + wave * 64;
  const float g0 = gg[n], g1 = gg[32 + n];
  LAS float* ssq = smem;
  LAS float* rstd = smem + 256;
  for (int item = blockIdx.x; item < 4 * 128; item += gridDim.x) {
    const int b = item >> 7, q0 = (item & 127) * 32;
    const size_t tokb = (size_t)b * SEQ;
    bf16x8_t qf[4];
    {
      const bf16* qrow = proj + (tokb + q0 + n) * DIN + 512 + wave * 64 + 8 * hh;
#pragma unroll
      for (int ks = 0; ks < 4; ks++) qf[ks] = *(const bf16x8_t*)(qrow + 16 * ks);
    }
    f32x16_t o0, o1;
#pragma unroll
    for (int r = 0; r < 16; r++) { o0[r] = 0.f; o1[r] = 0.f; }
    float R = 0.f;
    for (int kt = q0; kt >= 0; kt -= 32) {
      bf16x8_t kf[4];
      {
        const bf16* krow = proj + (tokb + kt + n) * DIN + 1024 + wave * 64 + 8 * hh;
#pragma unroll
        for (int ks = 0; ks < 4; ks++) kf[ks] = *(const bf16x8_t*)(krow + 16 * ks);
      }
      bf16x8_t vf0[2], vf1[2];
      {
        const bf16* vb = proj + (tokb + kt + 4 * hh) * DIN + 1536 + wave * 64 + n;
#pragma unroll
        for (int s = 0; s < 2; s++)
#pragma unroll
          for (int j = 0; j < 8; j++) {
            const int key = 16 * s + 8 * (j >> 2) + (j & 3);
            vf0[s][j] = (short)vb[(size_t)key * DIN];
            vf1[s][j] = (short)vb[(size_t)key * DIN + 32];
          }
      }
      f32x16_t sacc;
#pragma unroll
      for (int r = 0; r < 16; r++) sacc[r] = 0.f;
      __builtin_amdgcn_sched_barrier(0); asm volatile("s_nop 15\n\ts_nop 15" ::: "memory"); __builtin_amdgcn_sched_barrier(0);
#pragma unroll
      for (int ks = 0; ks < 4; ks++) sacc = __builtin_amdgcn_mfma_f32_32x32x16_bf16(kf[ks], qf[ks], sacc, 0, 0, 0);
      __builtin_amdgcn_sched_barrier(0); asm volatile("s_nop 15\n\ts_nop 15" ::: "memory"); __builtin_amdgcn_sched_barrier(0);
      float lst[16], lsz[16];
      const bool diag = (kt == q0);
#pragma unroll
      for (int r = 0; r < 16; r++) {
        const float z = sacc[r] * 0.125f;
        const float sp = __logf(1.0f + __expf(-fabsf(z)));
        float a = fminf(z, 0.f) - sp;
        float c = -(fmaxf(z, 0.f) + sp);
        if (diag) {
          const int key = (r & 3) + 8 * (r >> 2) + 4 * hh;
          if (key >= n) { a = -1.0e30f; c = 0.f; }
        }
        lsz[r] = a; lst[r] = c;
      }
      float Gs[4], Gp[4];
#pragma unroll
      for (int g = 0; g < 4; g++) {
        Gs[g] = (lst[4 * g] + lst[4 * g + 1]) + (lst[4 * g + 2] + lst[4 * g + 3]);
        Gp[g] = __shfl_xor(Gs[g], 32, 64);
      }
      float carry[4];
      {
        float after = R;
#pragma unroll
        for (int g = 3; g >= 0; g--) {
          carry[g] = after + (hh ? 0.f : Gp[g]);
          after += Gs[g] + Gp[g];
        }
        R = after;
      }
      bf16x8_t pf[2];
#pragma unroll
      for (int g = 0; g < 4; g++) {
        float run = carry[g];
        float a3 = __expf(lsz[4 * g + 3] + run); run += lst[4 * g + 3];
        float a2 = __expf(lsz[4 * g + 2] + run); run += lst[4 * g + 2];
        float a1 = __expf(lsz[4 * g + 1] + run); run += lst[4 * g + 1];
        float a0 = __expf(lsz[4 * g + 0] + run);
        const int s = g >> 1, jb = (g & 1) * 4;
        pf[s][jb + 0] = (short)f2bf(a0); pf[s][jb + 1] = (short)f2bf(a1);
        pf[s][jb + 2] = (short)f2bf(a2); pf[s][jb + 3] = (short)f2bf(a3);
      }
      __builtin_amdgcn_sched_barrier(0); asm volatile("s_nop 15\n\ts_nop 15" ::: "memory"); __builtin_amdgcn_sched_barrier(0);
#pragma unroll
      for (int s = 0; s < 2; s++) {
        o0 = __builtin_amdgcn_mfma_f32_32x32x16_bf16(pf[s], vf0[s], o0, 0, 0, 0);
        o1 = __builtin_amdgcn_mfma_f32_32x32x16_bf16(pf[s], vf1[s], o1, 0, 0, 0);
      }
      __builtin_amdgcn_sched_barrier(0); asm volatile("s_nop 15\n\ts_nop 15" ::: "memory"); __builtin_amdgcn_sched_barrier(0);
      if (__all(R < -110.f)) break;
    }
    float sq[16];
#pragma unroll
    for (int r = 0; r < 16; r++) {
      float v = o0[r] * o0[r] + o1[r] * o1[r];
#pragma unroll
      for (int o = 16; o > 0; o >>= 1) v += __shfl_xor(v, o, 64);
      sq[r] = v;
    }
    __syncthreads();
    if (n == 0) {
#pragma unroll
      for (int r = 0; r < 16; r++) ssq[wave * 32 + (r & 3) + 8 * (r >> 2) + 4 * hh] = sq[r];
    }
    __syncthreads();
    if (tid < 32) {
      float t = 0.f;
#pragma unroll
      for (int w = 0; w < 8; w++) t += ssq[w * 32 + tid];
      rstd[tid] = rsqrtf(t * (1.0f / 512.f) + EPSF);
    }
    __syncthreads();
#pragma unroll
    for (int r = 0; r < 16; r++) {
      const int qi = (r & 3) + 8 * (r >> 2) + 4 * hh;
      const float rs = rstd[qi];
      bf16* yr = y + (tokb + q0 + qi) * DM + 256 + wave * 64 + n;
      yr[0] = (bf16)f2bf(o0[r] * rs * g0);
      yr[32] = (bf16)f2bf(o1[r] * rs * g1);
    }
  }
}

#define SSM_BCAST_U(u, ua, ub, tt) do { \
    const unsigned w0 = (unsigned)__builtin_amdgcn_readlane((int)(ua).x, (tt)), w1 = (unsigned)__builtin_amdgcn_readlane((int)(ua).y, (tt)); \
    const unsigned w2 = (unsigned)__builtin_amdgcn_readlane((int)(ua).z, (tt)), w3 = (unsigned)__builtin_amdgcn_readlane((int)(ua).w, (tt)); \
    const unsigned w4 = (unsigned)__builtin_amdgcn_readlane((int)(ub).x, (tt)), w5 = (unsigned)__builtin_amdgcn_readlane((int)(ub).y, (tt)); \
    const unsigned w6 = (unsigned)__builtin_amdgcn_readlane((int)(ub).z, (tt)), w7 = (unsigned)__builtin_amdgcn_readlane((int)(ub).w, (tt)); \
    (u)[0] = bf_lo(w0); (u)[1] = bf_hi(w0); (u)[2] = bf_lo(w1); (u)[3] = bf_hi(w1); (u)[4] = bf_lo(w2); (u)[5] = bf_hi(w2); (u)[6] = bf_lo(w3); (u)[7] = bf_hi(w3); \
    (u)[8] = bf_lo(w4); (u)[9] = bf_hi(w4); (u)[10] = bf_lo(w5); (u)[11] = bf_hi(w5); (u)[12] = bf_lo(w6); (u)[13] = bf_hi(w6); (u)[14] = bf_lo(w7); (u)[15] = bf_hi(w7); } while (0)
#define SSM_RS 592
#define SSM_TILE_BASE 36864
#define SSM_TILE_BYTES (16 * SSM_RS)
typedef float f32x2_t __attribute__((ext_vector_type(2)));
__device__ __forceinline__ void ssm_load_bop(const float* ssmp, int g, int lane, bf16x8_t (&bop)[8]) {
  const int q = lane >> 4, n = lane & 15;
  float v[8][8];
#pragma unroll
  for (int j = 0; j < 8; j++) {
    const float4* rp = (const float4*)(ssmp + 4096 + (size_t)(g * 16 + ((8 * q + j) & 15)) * 128 + 8 * n);
    const float4 a = rp[0], b = rp[1];
    v[j][0] = a.x; v[j][1] = a.y; v[j][2] = a.z; v[j][3] = a.w; v[j][4] = b.x; v[j][5] = b.y; v[j][6] = b.z; v[j][7] = b.w;
  }
#pragma unroll
  for (int nt = 0; nt < 8; nt++) {
    pg8::u32x4 w;
    w.x = pk2(v[0][nt], v[1][nt]); w.y = pk2(v[2][nt], v[3][nt]); w.z = pk2(v[4][nt], v[5][nt]); w.w = pk2(v[6][nt], v[7][nt]);
    if (q >= 2) { w.x = 0u; w.y = 0u; w.z = 0u; w.w = 0u; }
    bop[nt] = __builtin_bit_cast(bf16x8_t, w);
  }
}
__device__ __forceinline__ void ssm_bu_block(LAS unsigned char* xt, int lane, int blk, const uint4& ua, const uint4& ub, const bf16x8_t (&bop)[8]) {
  const int q = lane >> 4, n = lane & 15;
  if (q == blk) {
    pg8::u32x4 w0, w1;
    w0.x = ua.x; w0.y = ua.y; w0.z = ua.z; w0.w = ua.w; w1.x = ub.x; w1.y = ub.y; w1.z = ub.z; w1.w = ub.w;
    LAS pg8::u32x4* ur = (LAS pg8::u32x4*)(xt + n * SSM_RS + 512);
    ur[0] = w0; ur[1] = w1;
  }
  __builtin_amdgcn_wave_barrier();
  const bf16x8_t uop = *(const LAS bf16x8_t*)(xt + n * SSM_RS + 512 + q * 16);
  pg8::f32x4 bacc[8];
#pragma unroll
  for (int nt = 0; nt < 8; nt++) {
    pg8::f32x4 z4; z4[0] = 0.f; z4[1] = 0.f; z4[2] = 0.f; z4[3] = 0.f;
    bacc[nt] = __builtin_amdgcn_mfma_f32_16x16x32_bf16(uop, bop[nt], z4, 0, 0, 0);
  }
#pragma unroll
  for (int j = 0; j < 4; j++) {
    pg8::f32x4 w0, w1;
    w0[0] = bacc[0][j]; w0[1] = bacc[1][j]; w0[2] = bacc[2][j]; w0[3] = bacc[3][j];
    w1[0] = bacc[4][j]; w1[1] = bacc[5][j]; w1[2] = bacc[6][j]; w1[3] = bacc[7][j];
    LAS pg8::f32x4* dr = (LAS pg8::f32x4*)(xt + (4 * q + j) * SSM_RS + 32 * n);
    dr[0] = w0; dr[1] = w1;
  }
  __builtin_amdgcn_wave_barrier();
}
__device__ __forceinline__ void ssm_zero_pad(LAS unsigned char* xt, int lane) {
  if (lane < 16) {
    pg8::u32x4 z4; z4.x = 0u; z4.y = 0u; z4.z = 0u; z4.w = 0u;
    LAS pg8::u32x4* zr = (LAS pg8::u32x4*)(xt + lane * SSM_RS + 544);
    zr[0] = z4; zr[1] = z4;
  }
}
__device__ __forceinline__ void ssm_chunk_end(const int wave_s, const float* ssmp, const bf16* proj, float* ssmE, LAS float* smem) {
  const int tid_ = opaque_tid(wave_s);
  const int lane = tid_ & 63;
  const int gw = blockIdx.x * NWAVES + (tid_ >> 6);
  const int nw = gridDim.x * NWAVES;
  for (int it = gw; it < 4 * 64 * 16; it += nw) {
    const int g = it & 15, c = (it >> 4) & 63, b = it >> 10;
    const int gp = g * 64 + lane;
    const uint4* up = (const uint4*)(proj + (size_t)(b * SEQ + c * 64 + lane) * DIN + 2048 + g * 16);
    const uint4 ua = up[0], ub = up[1];
    const float lbr = ssmp[gp * 2], lbi = ssmp[gp * 2 + 1];
    bf16x8_t bop[8];
    ssm_load_bop(ssmp, g, lane, bop);
    LAS unsigned char* xt = (LAS unsigned char*)smem + SSM_TILE_BASE + (tid_ >> 6) * SSM_TILE_BYTES;
    ssm_zero_pad(xt, lane);
    float xr = 0.f, xi = 0.f;
#pragma unroll 1
    for (int blk = 0; blk < 4; blk++) {
      ssm_bu_block(xt, lane, blk, ua, ub, bop);
#pragma unroll 4
      for (int tt = 0; tt < 16; tt++) {
        const f32x2_t bu = *(const LAS f32x2_t*)(xt + tt * SSM_RS + lane * 8);
        const float nr = lbr * xr - lbi * xi + bu[0];
        const float ni = lbr * xi + lbi * xr + bu[1];
        xr = nr; xi = ni;
      }
      __builtin_amdgcn_wave_barrier();
    }
    float* e = ssmE + ((size_t)((b * 64 + c) * 16 + g) * 64 + lane) * 2;
    e[0] = xr; e[1] = xi;
  }
}

__device__ __forceinline__ void ssm_finish(const int wave_s, const Params& p, int l, const float* ssmp, const bf16* proj,
                           const float* ssmE, bf16* y, LAS float* smem) {
  LAS bf16* Ytb = (LAS bf16*)smem;
  LAS float* ssq2 = smem + (64 * 264 * 2) / 4;
  LAS float* rstd2 = ssq2 + 512;
  const bf16* glT = (const bf16*)(p.ws + WS_WT + (size_t)l * WT_LAYER + WT_GLU);
  const int tid = opaque_tid(wave_s), lane = tid & 63, wave = tid >> 6;
  const float* cre = karg_in(13) + (size_t)l * 16 * 16 * 64;
  const float* cim = karg_in(14) + (size_t)l * 16 * 16 * 64;
  const float* dsk = karg_in(15) + l * 256;
  const float* glw = karg_in(16) + (size_t)l * 256 * 256;
  const float* glb = karg_in(17) + l * 256;
  const float* gg = karg_in(18) + l * 1024 + 768;
  for (int it = blockIdx.x; it < 256; it += gridDim.x) {
    const int b = it >> 6, c = it & 63;
    __syncthreads();
    for (int gi = 0; gi < 2; gi++) {
      const int g = wave + gi * 8;
      const int gp = g * 64 + lane;
      const float lbr = ssmp[gp * 2], lbi = ssmp[gp * 2 + 1];
      const float lcr = ssmp[2048 + gp * 2], lci = ssmp[2048 + gp * 2 + 1];
      bf16x8_t bop[8];
      ssm_load_bop(ssmp, g, lane, bop);
      bf16x8_t cop[5];
      {
        const int nn = lane & 15, q = lane >> 4;
#pragma unroll
        for (int ks = 0; ks < 4; ks++) {
          const float4 cr4 = *(const float4*)(cre + (g * 16 + nn) * 64 + 16 * ks + 4 * q);
          const float4 ci4 = *(const float4*)(cim + (g * 16 + nn) * 64 + 16 * ks + 4 * q);
          pg8::u32x4 w;
          w.x = pk2(cr4.x, -ci4.x); w.y = pk2(cr4.y, -ci4.y); w.z = pk2(cr4.z, -ci4.z); w.w = pk2(cr4.w, -ci4.w);
          cop[ks] = __builtin_bit_cast(bf16x8_t, w);
        }
        const float dn = dsk[g * 16 + nn];
        float dv[8];
#pragma unroll
        for (int j = 0; j < 8; j++) dv[j] = (8 * q + j == nn) ? dn : 0.f;
        pg8::u32x4 w;
        w.x = pk2(dv[0], dv[1]); w.y = pk2(dv[2], dv[3]); w.z = pk2(dv[4], dv[5]); w.w = pk2(dv[6], dv[7]);
        cop[4] = __builtin_bit_cast(bf16x8_t, w);
      }
      const uint4* up = (const uint4*)(proj + (size_t)(b * SEQ + c * 64 + lane) * DIN + 2048 + g * 16);
      const uint4 ua = up[0], ub = up[1];
      float xr = 0.f, xi = 0.f;
      {
        const float2* eb = (const float2*)ssmE + ((size_t)(b * 64) * 16 + g) * 64 + lane;
        for (int cc = 0; cc < c; cc += 16) {
          float2 ev[16];
#pragma unroll
          for (int k = 0; k < 16; k++) ev[k] = eb[(size_t)(cc + k < c ? cc + k : c - 1) * 16 * 64];
#pragma unroll
          for (int k = 0; k < 16; k++) {
            if (cc + k < c) {
              const float nr = lcr * xr - lci * xi + ev[k].x;
              const float ni = lcr * xi + lci * xr + ev[k].y;
              xr = nr; xi = ni;
            }
          }
        }
      }
      LAS unsigned char* xt = (LAS unsigned char*)smem + SSM_TILE_BASE + wave * SSM_TILE_BYTES;
      ssm_zero_pad(xt, lane);
#pragma unroll 1
      for (int blk = 0; blk < 4; blk++) {
        ssm_bu_block(xt, lane, blk, ua, ub, bop);
#pragma unroll 4
        for (int tt = 0; tt < 16; tt++) {
          const f32x2_t bu = *(const LAS f32x2_t*)(xt + tt * SSM_RS + lane * 8);
          const float nr = lbr * xr - lbi * xi + bu[0];
          const float ni = lbr * xi + lbi * xr + bu[1];
          xr = nr; xi = ni;
          *(LAS unsigned*)(xt + tt * SSM_RS + lane * 4) = pk2(xr, xi);
        }
        __builtin_amdgcn_wave_barrier();
        {
          pg8::f32x4 acc4;
          acc4[0] = 0.f; acc4[1] = 0.f; acc4[2] = 0.f; acc4[3] = 0.f;
          const LAS unsigned char* ar = xt + (lane & 15) * SSM_RS + (lane >> 4) * 16;
#pragma unroll
          for (int ks = 0; ks < 4; ks++)
            acc4 = __builtin_amdgcn_mfma_f32_16x16x32_bf16(*(const LAS bf16x8_t*)(ar + ks * 64), cop[ks], acc4, 0, 0, 0);
          acc4 = __builtin_amdgcn_mfma_f32_16x16x32_bf16(*(const LAS bf16x8_t*)(ar + 512), cop[4], acc4, 0, 0, 0);
#pragma unroll
          for (int j = 0; j < 4; j++)
            Ytb[(blk * 16 + 4 * (lane >> 4) + j) * 264 + g * 16 + (lane & 15)] = (bf16)f2bf(gelu_tanh(acc4[j]));
        }
        __builtin_amdgcn_wave_barrier();
      }
    }
    __syncthreads();
    {
      const int n = lane & 31, hh = lane >> 5;
      const int ch = wave * 32 + n;
      const float bj = glb[ch];
      const float gj = gg[ch];
      bf16x8_t gf[16];
      {
        const bf16* grow = glT + (size_t)ch * 256 + 8 * hh;
#pragma unroll
        for (int ks = 0; ks < 16; ks++) gf[ks] = *(const bf16x8_t*)(grow + 16 * ks);
      }
      float oo[2][16];
#pragma unroll
      for (int mt = 0; mt < 2; mt++) {
        f32x16_t z;
#pragma unroll
        for (int r = 0; r < 16; r++) z[r] = 0.f;
        const LAS bf16* yrow = Ytb + (mt * 32 + n) * 264 + 8 * hh;
#pragma unroll
        for (int kq = 0; kq < 4; kq++) {
          bf16x8_t yf[4];
#pragma unroll
          for (int i = 0; i < 4; i++) yf[i] = *(const LAS bf16x8_t*)(yrow + 16 * (kq * 4 + i));
          MFMA_PAD();
#pragma unroll
          for (int i = 0; i < 4; i++) z = __builtin_amdgcn_mfma_f32_32x32x16_bf16(yf[i], gf[kq * 4 + i], z, 0, 0, 0);
          MFMA_PAD();
        }
        float sq[16];
#pragma unroll
        for (int r = 0; r < 16; r++) {
          const int t = mt * 32 + (r & 3) + 8 * (r >> 2) + 4 * hh;
          const float yv = bf2f(Ytb[t * 264 + ch]);
          const float o = yv * sigmoidf_(z[r] + bj);
          oo[mt][r] = o;
          float v = o * o;
#pragma unroll
          for (int s = 16; s > 0; s >>= 1) v += __shfl_xor(v, s, 64);
          sq[r] = v;
        }
        if (n == 0) {
#pragma unroll
          for (int r = 0; r < 16; r++) ssq2[wave * 64 + mt * 32 + (r & 3) + 8 * (r >> 2) + 4 * hh] = sq[r];
        }
      }
      __syncthreads();
      if (tid < 64) {
        float t = 0.f;
#pragma unroll
        for (int w = 0; w < 8; w++) t += ssq2[w * 64 + tid];
        rstd2[tid] = rsqrtf(t * (1.0f / 256.f) + EPSF);
      }
      __syncthreads();
#pragma unroll
      for (int mt = 0; mt < 2; mt++)
#pragma unroll
        for (int r = 0; r < 16; r++) {
          const int t = mt * 32 + (r & 3) + 8 * (r >> 2) + 4 * hh;
          y[(size_t)(b * SEQ + c * 64 + t) * DM + 768 + ch] = (bf16)f2bf(oo[mt][r] * rstd2[t] * gj);
        }
    }
  }
}

__device__ __forceinline__ void memattn_phase(const int wave_s, const bf16* q, const bf16* kvb, const bf16* vT, bf16* o, LAS float* smem) {
  const int tid_ = opaque_tid(wave_s);
  const int lane = tid_ & 63, n = lane & 31, hh = lane >> 5, wave = tid_ >> 6;
  const int sig = (n & 0x13) | ((n & 4) << 1) | ((n & 8) >> 1);
  LAS bf16* Ls = (LAS bf16*)smem;
  for (int it = blockIdx.x; it < 64 * 4; it += gridDim.x) {
    const int h = it & 3, tg = it >> 2, b = tg >> 4;
    const int tok0 = (tg * 8 + wave) * 32;
    __syncthreads();
    {
      const int r = tid_ >> 1, hf = tid_ & 1;
      const pg8::u32x4* src4 = (const pg8::u32x4*)(kvb + (size_t)(b * NMEM + r) * 2048 + h * 256 + hf * 128);
      LAS pg8::u32x4* dst4 = (LAS pg8::u32x4*)(Ls + r * 264 + hf * 128);
#pragma unroll
      for (int k = 0; k < 16; k++) dst4[k] = src4[k];
    }
    f32x16_t st[8];
#pragma unroll
    for (int kt = 0; kt < 8; kt++)
#pragma unroll
      for (int r = 0; r < 16; r++) st[kt][r] = 0.f;
    const bf16* qrow = q + (size_t)(tok0 + n) * DM + h * 256 + 8 * hh;
    __syncthreads();
#pragma unroll
    for (int kq = 0; kq < 4; kq++) {
      bf16x8_t qf[4];
#pragma unroll
      for (int i = 0; i < 4; i++) qf[i] = *(const bf16x8_t*)(qrow + 16 * (kq * 4 + i));
#pragma unroll
      for (int kt = 0; kt < 8; kt++) {
        const LAS bf16* krow = Ls + (kt * 32 + sig) * 264 + 8 * hh;
        bf16x8_t kf[4];
#pragma unroll
        for (int i = 0; i < 4; i++) kf[i] = *(const LAS bf16x8_t*)(krow + 16 * (kq * 4 + i));
        MFMA_PAD();
#pragma unroll
        for (int i = 0; i < 4; i++) st[kt] = __builtin_amdgcn_mfma_f32_32x32x16_bf16(kf[i], qf[i], st[kt], 0, 0, 0);
        MFMA_PAD();
      }
    }
    float mx = st[0][0];
#pragma unroll
    for (int kt = 0; kt < 8; kt++)
#pragma unroll
      for (int r = 0; r < 16; r++) mx = fmaxf(mx, st[kt][r]);
    mx = fmaxf(mx, __shfl_xor(mx, 32, 64));
    float sum = 0.f;
#pragma unroll
    for (int kt = 0; kt < 8; kt++)
#pragma unroll
      for (int r = 0; r < 16; r++) { const float e = __expf((st[kt][r] - mx) * 0.0625f); st[kt][r] = e; sum += e; }
    sum += __shfl_xor(sum, 32, 64);
    const float inv = 1.0f / sum;
    bf16x8_t pf[8][2];
#pragma unroll
    for (int kt = 0; kt < 8; kt++)
#pragma unroll
      for (int s = 0; s < 2; s++)
#pragma unroll
        for (int j = 0; j < 8; j++) pf[kt][s][j] = (short)f2bf(st[kt][8 * s + j] * inv);
    __syncthreads();
    {
      const int r = tid_ >> 1, hf = tid_ & 1;
      const pg8::u32x4* src4 = (const pg8::u32x4*)(vT + ((size_t)(b * 4 + h) * 256 + r) * 256 + hf * 128);
      LAS pg8::u32x4* dst4 = (LAS pg8::u32x4*)(Ls + r * 264 + hf * 128);
#pragma unroll
      for (int k = 0; k < 16; k++) dst4[k] = src4[k];
    }
    __syncthreads();
#pragma unroll 1
    for (int dt = 0; dt < 8; dt++) {
      f32x16_t oacc;
#pragma unroll
      for (int r = 0; r < 16; r++) oacc[r] = 0.f;
      const LAS bf16* vrow = Ls + (dt * 32 + n) * 264 + 8 * hh;
#pragma unroll
      for (int kq = 0; kq < 4; kq++) {
        bf16x8_t vf[4];
#pragma unroll
        for (int i = 0; i < 4; i++) vf[i] = *(const LAS bf16x8_t*)(vrow + (kq * 2 + (i >> 1)) * 32 + 16 * (i & 1));
        MFMA_PAD();
#pragma unroll
        for (int i = 0; i < 4; i++) oacc = __builtin_amdgcn_mfma_f32_32x32x16_bf16(pf[kq * 2 + (i >> 1)][i & 1], vf[i], oacc, 0, 0, 0);
        MFMA_PAD();
      }
#pragma unroll
      for (int r = 0; r < 16; r++) {
        const int qi = (r & 3) + 8 * (r >> 2) + 4 * hh;
        o[(size_t)(tok0 + qi) * DM + h * 256 + dt * 32 + n] = (bf16)f2bf(oacc[r]);
      }
    }
  }
}

__device__ __forceinline__ void vt_phase(const int wave_s, const bf16* kvb, bf16* vT) {
  const int tid_ = opaque_tid(wave_s);
  const int gt = blockIdx.x * (NWAVES * 64) + tid_;
  const int nth = gridDim.x * NWAVES * 64;
  for (int i = gt; i < 2 * 4 * 4 * 256 * 256; i += nth) {
    const int m = i & 255, d = (i >> 8) & 255, h = (i >> 16) & 3, b = (i >> 18) & 3, l = i >> 20;
    vT[i] = kvb[((size_t)l * 1024 + b * 256 + m) * 2048 + 1024 + h * 256 + d];
  }
}

template <unsigned MASK>
__device__ __forceinline__ float pack_key(float s, unsigned idx) {
  const unsigned u = __builtin_bit_cast(unsigned, s);
  const unsigned tag = ((int)u < 0) ? idx : (MASK - idx);
  return __builtin_bit_cast(float, (u & ~MASK) + tag);
}
template <unsigned MASK>
__device__ __forceinline__ unsigned key_idx(float k) {
  const unsigned u = __builtin_bit_cast(unsigned, k);
  const unsigned tag = u & MASK;
  return ((int)u < 0) ? tag : (MASK - tag);
}
template <unsigned MASK>
__device__ __forceinline__ float key_val(float k) { return __builtin_bit_cast(float, __builtin_bit_cast(unsigned, k) & ~MASK); }
__device__ __forceinline__ void top16_of_64(float (&K)[64]) {
  { const float a_ = K[0], b_ = K[1]; const bool g_ = a_ > b_; K[0] = g_ ? a_ : b_; K[1] = g_ ? b_ : a_; }
  { const float a_ = K[2], b_ = K[3]; const bool g_ = a_ > b_; K[2] = g_ ? b_ : a_; K[3] = g_ ? a_ : b_; }
  { const float a_ = K[4], b_ = K[5]; const bool g_ = a_ > b_; K[4] = g_ ? a_ : b_; K[5] = g_ ? b_ : a_; }
  { const float a_ = K[6], b_ = K[7]; const bool g_ = a_ > b_; K[6] = g_ ? b_ : a_; K[7] = g_ ? a_ : b_; }
  { const float a_ = K[8], b_ = K[9]; const bool g_ = a_ > b_; K[8] = g_ ? a_ : b_; K[9] = g_ ? b_ : a_; }
  { const float a_ = K[10], b_ = K[11]; const bool g_ = a_ > b_; K[10] = g_ ? b_ : a_; K[11] = g_ ? a_ : b_; }
  { const float a_ = K[12], b_ = K[13]; const bool g_ = a_ > b_; K[12] = g_ ? a_ : b_; K[13] = g_ ? b_ : a_; }
  { const float a_ = K[14], b_ = K[15]; const bool g_ = a_ > b_; K[14] = g_ ? b_ : a_; K[15] = g_ ? a_ : b_; }
  { const float a_ = K[0], b_ = K[2]; const bool g_ = a_ > b_; K[0] = g_ ? a_ : b_; K[2] = g_ ? b_ : a_; }
  { const float a_ = K[1], b_ = K[3]; const bool g_ = a_ > b_; K[1] = g_ ? a_ : b_; K[3] = g_ ? b_ : a_; }
  { const float a_ = K[4], b_ = K[6]; const bool g_ = a_ > b_; K[4] = g_ ? b_ : a_; K[6] = g_ ? a_ : b_; }
  { const float a_ = K[5], b_ = K[7]; const bool g_ = a_ > b_; K[5] = g_ ? b_ : a_; K[7] = g_ ? a_ : b_; }
  { const float a_ = K[8], b_ = K[10]; const bool g_ = a_ > b_; K[8] = g_ ? a_ : b_; K[10] = g_ ? b_ : a_; }
  { const float a_ = K[9], b_ = K[11]; const bool g_ = a_ > b_; K[9] = g_ ? a_ : b_; K[11] = g_ ? b_ : a_; }
  { const float a_ = K[12], b_ = K[14]; const bool g_ = a_ > b_; K[12] = g_ ? b_ : a_; K[14] = g_ ? a_ : b_; }
  { const float a_ = K[13], b_ = K[15]; const bool g_ = a_ > b_; K[13] = g_ ? b_ : a_; K[15] = g_ ? a_ : b_; }
  { const float a_ = K[0], b_ = K[1]; const bool g_ = a_ > b_; K[0] = g_ ? a_ : b_; K[1] = g_ ? b_ : a_; }
  { const float a_ = K[2], b_ = K[3]; const bool g_ = a_ > b_; K[2] = g_ ? a_ : b_; K[3] = g_ ? b_ : a_; }
  { const float a_ = K[4], b_ = K[5]; const bool g_ = a_ > b_; K[4] = g_ ? b_ : a_; K[5] = g_ ? a_ : b_; }
  { const float a_ = K[6], b_ = K[7]; const bool g_ = a_ > b_; K[6] = g_ ? b_ : a_; K[7] = g_ ? a_ : b_; }
  { const float a_ = K[8], b_ = K[9]; const bool g_ = a_ > b_; K[8] = g_ ? a_ : b_; K[9] = g_ ? b_ : a_; }
  { const float a_ = K[10], b_ = K[11]; const bool g_ = a_ > b_; K[10] = g_ ? a_ : b_; K[11] = g_ ? b_ : a_; }
  { const float a_ = K[12], b_ = K[13]; const bool g_ = a_ > b_; K[12] = g_ ? b_ : a_; K[13] = g_ ? a_ : b_; }
  { const float a_ = K[14], b_ = K[15]; const bool g_ = a_ > b_; K[14] = g_ ? b_ : a_; K[15] = g_ ? a_ : b_; }
  { const float a_ = K[0], b_ = K[4]; const bool g_ = a_ > b_; K[0] = g_ ? a_ : b_; K[4] = g_ ? b_ : a_; }
  { const float a_ = K[1], b_ = K[5]; const bool g_ = a_ > b_; K[1] = g_ ? a_ : b_; K[5] = g_ ? b_ : a_; }
  { const float a_ = K[2], b_ = K[6]; const bool g_ = a_ > b_; K[2] = g_ ? a_ : b_; K[6] = g_ ? b_ : a_; }
  { const float a_ = K[3], b_ = K[7]; const bool g_ = a_ > b_; K[3] = g_ ? a_ : b_; K[7] = g_ ? b_ : a_; }
  { const float a_ = K[8], b_ = K[12]; const bool g_ = a_ > b_; K[8] = g_ ? b_ : a_; K[12] = g_ ? a_ : b_; }
  { const float a_ = K[9], b_ = K[13]; const bool g_ = a_ > b_; K[9] = g_ ? b_ : a_; K[13] = g_ ? a_ : b_; }
  { const float a_ = K[10], b_ = K[14]; const bool g_ = a_ > b_; K[10] = g_ ? b_ : a_; K[14] = g_ ? a_ : b_; }
  { const float a_ = K[11], b_ = K[15]; const bool g_ = a_ > b_; K[11] = g_ ? b_ : a_; K[15] = g_ ? a_ : b_; }
  { const float a_ = K[0], b_ = K[2]; const bool g_ = a_ > b_; K[0] = g_ ? a_ : b_; K[2] = g_ ? b_ : a_; }
  { const float a_ = K[1], b_ = K[3]; const bool g_ = a_ > b_; K[1] = g_ ? a_ : b_; K[3] = g_ ? b_ : a_; }
  { const float a_ = K[4], b_ = K[6]; const bool g_ = a_ > b_; K[4] = g_ ? a_ : b_; K[6] = g_ ? b_ : a_; }
  { const float a_ = K[5], b_ = K[7]; const bool g_ = a_ > b_; K[5] = g_ ? a_ : b_; K[7] = g_ ? b_ : a_; }
  { const float a_ = K[8], b_ = K[10]; const bool g_ = a_ > b_; K[8] = g_ ? b_ : a_; K[10] = g_ ? a_ : b_; }
  { const float a_ = K[9], b_ = K[11]; const bool g_ = a_ > b_; K[9] = g_ ? b_ : a_; K[11] = g_ ? a_ : b_; }
  { const float a_ = K[12], b_ = K[14]; const bool g_ = a_ > b_; K[12] = g_ ? b_ : a_; K[14] = g_ ? a_ : b_; }
  { const float a_ = K[13], b_ = K[15]; const bool g_ = a_ > b_; K[13] = g_ ? b_ : a_; K[15] = g_ ? a_ : b_; }
  { const float a_ = K[0], b_ = K[1]; const bool g_ = a_ > b_; K[0] = g_ ? a_ : b_; K[1] = g_ ? b_ : a_; }
  { const float a_ = K[2], b_ = K[3]; const bool g_ = a_ > b_; K[2] = g_ ? a_ : b_; K[3] = g_ ? b_ : a_; }
  { const float a_ = K[4], b_ = K[5]; const bool g_ = a_ > b_; K[4] = g_ ? a_ : b_; K[5] = g_ ? b_ : a_; }
  { const float a_ = K[6], b_ = K[7]; const bool g_ = a_ > b_; K[6] = g_ ? a_ : b_; K[7] = g_ ? b_ : a_; }
  { const float a_ = K[8], b_ = K[9]; const bool g_ = a_ > b_; K[8] = g_ ? b_ : a_; K[9] = g_ ? a_ : b_; }
  { const float a_ = K[10], b_ = K[11]; const bool g_ = a_ > b_; K[10] = g_ ? b_ : a_; K[11] = g_ ? a_ : b_; }
  { const float a_ = K[12], b_ = K[13]; const bool g_ = a_ > b_; K[12] = g_ ? b_ : a_; K[13] = g_ ? a_ : b_; }
  { const float a_ = K[14], b_ = K[15]; const bool g_ = a_ > b_; K[14] = g_ ? b_ : a_; K[15] = g_ ? a_ : b_; }
  { const float a_ = K[0], b_ = K[8]; const bool g_ = a_ > b_; K[0] = g_ ? a_ : b_; K[8] = g_ ? b_ : a_; }
  { const float a_ = K[1], b_ = K[9]; const bool g_ = a_ > b_; K[1] = g_ ? a_ : b_; K[9] = g_ ? b_ : a_; }
  { const float a_ = K[2], b_ = K[10]; const bool g_ = a_ > b_; K[2] = g_ ? a_ : b_; K[10] = g_ ? b_ : a_; }
  { const float a_ = K[3], b_ = K[11]; const bool g_ = a_ > b_; K[3] = g_ ? a_ : b_; K[11] = g_ ? b_ : a_; }
  { const float a_ = K[4], b_ = K[12]; const bool g_ = a_ > b_; K[4] = g_ ? a_ : b_; K[12] = g_ ? b_ : a_; }
  { const float a_ = K[5], b_ = K[13]; const bool g_ = a_ > b_; K[5] = g_ ? a_ : b_; K[13] = g_ ? b_ : a_; }
  { const float a_ = K[6], b_ = K[14]; const bool g_ = a_ > b_; K[6] = g_ ? a_ : b_; K[14] = g_ ? b_ : a_; }
  { const float a_ = K[7], b_ = K[15]; const bool g_ = a_ > b_; K[7] = g_ ? a_ : b_; K[15] = g_ ? b_ : a_; }
  { const float a_ = K[0], b_ = K[4]; const bool g_ = a_ > b_; K[0] = g_ ? a_ : b_; K[4] = g_ ? b_ : a_; }
  { const float a_ = K[1], b_ = K[5]; const bool g_ = a_ > b_; K[1] = g_ ? a_ : b_; K[5] = g_ ? b_ : a_; }
  { const float a_ = K[2], b_ = K[6]; const bool g_ = a_ > b_; K[2] = g_ ? a_ : b_; K[6] = g_ ? b_ : a_; }
  { const float a_ = K[3], b_ = K[7]; const bool g_ = a_ > b_; K[3] = g_ ? a_ : b_; K[7] = g_ ? b_ : a_; }
  { const float a_ = K[8], b_ = K[12]; const bool g_ = a_ > b_; K[8] = g_ ? a_ : b_; K[12] = g_ ? b_ : a_; }
  { const float a_ = K[9], b_ = K[13]; const bool g_ = a_ > b_; K[9] = g_ ? a_ : b_; K[13] = g_ ? b_ : a_; }
  { const float a_ = K[10], b_ = K[14]; const bool g_ = a_ > b_; K[10] = g_ ? a_ : b_; K[14] = g_ ? b_ : a_; }
  { const float a_ = K[11], b_ = K[15]; const bool g_ = a_ > b_; K[11] = g_ ? a_ : b_; K[15] = g_ ? b_ : a_; }
  { const float a_ = K[0], b_ = K[2]; const bool g_ = a_ > b_; K[0] = g_ ? a_ : b_; K[2] = g_ ? b_ : a_; }
  { const float a_ = K[1], b_ = K[3]; const bool g_ = a_ > b_; K[1] = g_ ? a_ : b_; K[3] = g_ ? b_ : a_; }
  { const float a_ = K[4], b_ = K[6]; const bool g_ = a_ > b_; K[4] = g_ ? a_ : b_; K[6] = g_ ? b_ : a_; }
  { const float a_ = K[5], b_ = K[7]; const bool g_ = a_ > b_; K[5] = g_ ? a_ : b_; K[7] = g_ ? b_ : a_; }
  { const float a_ = K[8], b_ = K[10]; const bool g_ = a_ > b_; K[8] = g_ ? a_ : b_; K[10] = g_ ? b_ : a_; }
  { const float a_ = K[9], b_ = K[11]; const bool g_ = a_ > b_; K[9] = g_ ? a_ : b_; K[11] = g_ ? b_ : a_; }
  { const float a_ = K[12], b_ = K[14]; const bool g_ = a_ > b_; K[12] = g_ ? a_ : b_; K[14] = g_ ? b_ : a_; }
  { const float a_ = K[13], b_ = K[15]; const bool g_ = a_ > b_; K[13] = g_ ? a_ : b_; K[15] = g_ ? b_ : a_; }
  { const float a_ = K[0], b_ = K[1]; const bool g_ = a_ > b_; K[0] = g_ ? a_ : b_; K[1] = g_ ? b_ : a_; }
  { const float a_ = K[2], b_ = K[3]; const bool g_ = a_ > b_; K[2] = g_ ? a_ : b_; K[3] = g_ ? b_ : a_; }
  { const float a_ = K[4], b_ = K[5]; const bool g_ = a_ > b_; K[4] = g_ ? a_ : b_; K[5] = g_ ? b_ : a_; }
  { const float a_ = K[6], b_ = K[7]; const bool g_ = a_ > b_; K[6] = g_ ? a_ : b_; K[7] = g_ ? b_ : a_; }
  { const float a_ = K[8], b_ = K[9]; const bool g_ = a_ > b_; K[8] = g_ ? a_ : b_; K[9] = g_ ? b_ : a_; }
  { const float a_ = K[10], b_ = K[11]; const bool g_ = a_ > b_; K[10] = g_ ? a_ : b_; K[11] = g_ ? b_ : a_; }
  { const float a_ = K[12], b_ = K[13]; const bool g_ = a_ > b_; K[12] = g_ ? a_ : b_; K[13] = g_ ? b_ : a_; }
  { const float a_ = K[14], b_ = K[15]; const bool g_ = a_ > b_; K[14] = g_ ? a_ : b_; K[15] = g_ ? b_ : a_; }
  { const float a_ = K[16], b_ = K[17]; const bool g_ = a_ > b_; K[16] = g_ ? a_ : b_; K[17] = g_ ? b_ : a_; }
  { const float a_ = K[18], b_ = K[19]; const bool g_ = a_ > b_; K[18] = g_ ? b_ : a_; K[19] = g_ ? a_ : b_; }
  { const float a_ = K[20], b_ = K[21]; const bool g_ = a_ > b_; K[20] = g_ ? a_ : b_; K[21] = g_ ? b_ : a_; }
  { const float a_ = K[22], b_ = K[23]; const bool g_ = a_ > b_; K[22] = g_ ? b_ : a_; K[23] = g_ ? a_ : b_; }
  { const float a_ = K[24], b_ = K[25]; const bool g_ = a_ > b_; K[24] = g_ ? a_ : b_; K[25] = g_ ? b_ : a_; }
  { const float a_ = K[26], b_ = K[27]; const bool g_ = a_ > b_; K[26] = g_ ? b_ : a_; K[27] = g_ ? a_ : b_; }
  { const float a_ = K[28], b_ = K[29]; const bool g_ = a_ > b_; K[28] = g_ ? a_ : b_; K[29] = g_ ? b_ : a_; }
  { const float a_ = K[30], b_ = K[31]; const bool g_ = a_ > b_; K[30] = g_ ? b_ : a_; K[31] = g_ ? a_ : b_; }
  { const float a_ = K[16], b_ = K[18]; const bool g_ = a_ > b_; K[16] = g_ ? a_ : b_; K[18] = g_ ? b_ : a_; }
  { const float a_ = K[17], b_ = K[19]; const bool g_ = a_ > b_; K[17] = g_ ? a_ : b_; K[19] = g_ ? b_ : a_; }
  { const float a_ = K[20], b_ = K[22]; const bool g_ = a_ > b_; K[20] = g_ ? b_ : a_; K[22] = g_ ? a_ : b_; }
  { const float a_ = K[21], b_ = K[23]; const bool g_ = a_ > b_; K[21] = g_ ? b_ : a_; K[23] = g_ ? a_ : b_; }
  { const float a_ = K[24], b_ = K[26]; const bool g_ = a_ > b_; K[24] = g_ ? a_ : b_; K[26] = g_ ? b_ : a_; }
  { const float a_ = K[25], b_ = K[27]; const bool g_ = a_ > b_; K[25] = g_ ? a_ : b_; K[27] = g_ ? b_ : a_; }
  { const float a_ = K[28], b_ = K[30]; const bool g_ = a_ > b_; K[28] = g_ ? b_ : a_; K[30] = g_ ? a_ : b_; }
  { const float a_ = K[29], b_ = K[31]; const bool g_ = a_ > b_; K[29] = g_ ? b_ : a_; K[31] = g_ ? a_ : b_; }
  { const float a_ = K[16], b_ = K[17]; const bool g_ = a_ > b_; K[16] = g_ ? a_ : b_; K[17] = g_ ? b_ : a_; }
  { const float a_ = K[18], b_ = K[19]; const bool g_ = a_ > b_; K[18] = g_ ? a_ : b_; K[19] = g_ ? b_ : a_; }
  { const float a_ = K[20], b_ = K[21]; const bool g_ = a_ > b_; K[20] = g_ ? b_ : a_; K[21] = g_ ? a_ : b_; }
  { const float a_ = K[22], b_ = K[23]; const bool g_ = a_ > b_; K[22] = g_ ? b_ : a_; K[23] = g_ ? a_ : b_; }
  { const float a_ = K[24], b_ = K[25]; const bool g_ = a_ > b_; K[24] = g_ ? a_ : b_; K[25] = g_ ? b_ : a_; }
  { const float a_ = K[26], b_ = K[27]; const bool g_ = a_ > b_; K[26] = g_ ? a_ : b_; K[27] = g_ ? b_ : a_; }
  { const float a_ = K[28], b_ = K[29]; const bool g_ = a_ > b_; K[28] = g_ ? b_ : a_; K[29] = g_ ? a_ : b_; }
  { const float a_ = K[30], b_ = K[31]; const bool g_ = a_ > b_; K[30] = g_ ? b_ : a_; K[31] = g_ ? a_ : b_; }
  { const float a_ = K[16], b_ = K[20]; const bool g_ = a_ > b_; K[16] = g_ ? a_ : b_; K[20] = g_ ? b_ : a_; }
  { const float a_ = K[17], b_ = K[21]; const bool g_ = a_ > b_; K[17] = g_ ? a_ : b_; K[21] = g_ ? b_ : a_; }
  { const float a_ = K[18], b_ = K[22]; const bool g_ = a_ > b_; K[18] = g_ ? a_ : b_; K[22] = g_ ? b_ : a_; }
  { const float a_ = K[19], b_ = K[23]; const bool g_ = a_ > b_; K[19] = g_ ? a_ : b_; K[23] = g_ ? b_ : a_; }
  { const float a_ = K[24], b_ = K[28]; const bool g_ = a_ > b_; K[24] = g_ ? b_ : a_; K[28] = g_ ? a_ : b_; }
  { const float a_ = K[25], b_ = K[29]; const bool g_ = a_ > b_; K[25] = g_ ? b_ : a_; K[29] = g_ ? a_ : b_; }
  { const float a_ = K[26], b_ = K[30]; const bool g_ = a_ > b_; K[26] = g_ ? b_ : a_; K[30] = g_ ? a_ : b_; }
  { const float a_ = K[27], b_ = K[31]; const bool g_ = a_ > b_; K[27] = g_ ? b_ : a_; K[31] = g_ ? a_ : b_; }
  { const float a_ = K[16], b_ = K[18]; const bool g_ = a_ > b_; K[16] = g_ ? a_ : b_; K[18] = g_ ? b_ : a_; }
  { const float a_ = K[17], b_ = K[19]; const bool g_ = a_ > b_; K[17] = g_ ? a_ : b_; K[19] = g_ ? b_ : a_; }
  { const float a_ = K[20], b_ = K[22]; const bool g_ = a_ > b_; K[20] = g_ ? a_ : b_; K[22] = g_ ? b_ : a_; }
  { const float a_ = K[21], b_ = K[23]; const bool g_ = a_ > b_; K[21] = g_ ? a_ : b_; K[23] = g_ ? b_ : a_; }
  { const float a_ = K[24], b_ = K[26]; const bool g_ = a_ > b_; K[24] = g_ ? b_ : a_; K[26] = g_ ? a_ : b_; }
  { const float a_ = K[25], b_ = K[27]; const bool g_ = a_ > b_; K[25] = g_ ? b_ : a_; K[27] = g_ ? a_ : b_; }
  { const float a_ = K[28], b_ = K[30]; const bool g_ = a_ > b_; K[28] = g_ ? b_ : a_; K[30] = g_ ? a_ : b_; }
  { const float a_ = K[29], b_ = K[31]; const bool g_ = a_ > b_; K[29] = g_ ? b_ : a_; K[31] = g_ ? a_ : b_; }
  { const float a_ = K[16], b_ = K[17]; const bool g_ = a_ > b_; K[16] = g_ ? a_ : b_; K[17] = g_ ? b_ : a_; }
  { const float a_ = K[18], b_ = K[19]; const bool g_ = a_ > b_; K[18] = g_ ? a_ : b_; K[19] = g_ ? b_ : a_; }
  { const float a_ = K[20], b_ = K[21]; const bool g_ = a_ > b_; K[20] = g_ ? a_ : b_; K[21] = g_ ? b_ : a_; }
  { const float a_ = K[22], b_ = K[23]; const bool g_ = a_ > b_; K[22] = g_ ? a_ : b_; K[23] = g_ ? b_ : a_; }
  { const float a_ = K[24], b_ = K[25]; const bool g_ = a_ > b_; K[24] = g_ ? b_ : a_; K[25] = g_ ? a_ : b_; }
  { const float a_ = K[26], b_ = K[27]; const bool g_ = a_ > b_; K[26] = g_ ? b_ : a_; K[27] = g_ ? a_ : b_; }
  { const float a_ = K[28], b_ = K[29]; const bool g_ = a_ > b_; K[28] = g_ ? b_ : a_; K[29] = g_ ? a_ : b_; }
  { const float a_ = K[30], b_ = K[31]; const bool g_ = a_ > b_; K[30] = g_ ? b_ : a_; K[31] = g_ ? a_ : b_; }
  { const float a_ = K[16], b_ = K[24]; const bool g_ = a_ > b_; K[16] = g_ ? a_ : b_; K[24] = g_ ? b_ : a_; }
  { const float a_ = K[17], b_ = K[25]; const bool g_ = a_ > b_; K[17] = g_ ? a_ : b_; K[25] = g_ ? b_ : a_; }
  { const float a_ = K[18], b_ = K[26]; const bool g_ = a_ > b_; K[18] = g_ ? a_ : b_; K[26] = g_ ? b_ : a_; }
  { const float a_ = K[19], b_ = K[27]; const bool g_ = a_ > b_; K[19] = g_ ? a_ : b_; K[27] = g_ ? b_ : a_; }
  { const float a_ = K[20], b_ = K[28]; const bool g_ = a_ > b_; K[20] = g_ ? a_ : b_; K[28] = g_ ? b_ : a_; }
  { const float a_ = K[21], b_ = K[29]; const bool g_ = a_ > b_; K[21] = g_ ? a_ : b_; K[29] = g_ ? b_ : a_; }
  { const float a_ = K[22], b_ = K[30]; const bool g_ = a_ > b_; K[22] = g_ ? a_ : b_; K[30] = g_ ? b_ : a_; }
  { const float a_ = K[23], b_ = K[31]; const bool g_ = a_ > b_; K[23] = g_ ? a_ : b_; K[31] = g_ ? b_ : a_; }
  { const float a_ = K[16], b_ = K[20]; const bool g_ = a_ > b_; K[16] = g_ ? a_ : b_; K[20] = g_ ? b_ : a_; }
  { const float a_ = K[17], b_ = K[21]; const bool g_ = a_ > b_; K[17] = g_ ? a_ : b_; K[21] = g_ ? b_ : a_; }
  { const float a_ = K[18], b_ = K[22]; const bool g_ = a_ > b_; K[18] = g_ ? a_ : b_; K[22] = g_ ? b_ : a_; }
  { const float a_ = K[19], b_ = K[23]; const bool g_ = a_ > b_; K[19] = g_ ? a_ : b_; K[23] = g_ ? b_ : a_; }
  { const float a_ = K[24], b_ = K[28]; const bool g_ = a_ > b_; K[24] = g_ ? a_ : b_; K[28] = g_ ? b_ : a_; }
  { const float a_ = K[25], b_ = K[29]; const bool g_ = a_ > b_; K[25] = g_ ? a_ : b_; K[29] = g_ ? b_ : a_; }
  { const float a_ = K[26], b_ = K[30]; const bool g_ = a_ > b_; K[26] = g_ ? a_ : b_; K[30] = g_ ? b_ : a_; }
  { const float a_ = K[27], b_ = K[31]; const bool g_ = a_ > b_; K[27] = g_ ? a_ : b_; K[31] = g_ ? b_ : a_; }
  { const float a_ = K[16], b_ = K[18]; const bool g_ = a_ > b_; K[16] = g_ ? a_ : b_; K[18] = g_ ? b_ : a_; }
  { const float a_ = K[17], b_ = K[19]; const bool g_ = a_ > b_; K[17] = g_ ? a_ : b_; K[19] = g_ ? b_ : a_; }
  { const float a_ = K[20], b_ = K[22]; const bool g_ = a_ > b_; K[20] = g_ ? a_ : b_; K[22] = g_ ? b_ : a_; }
  { const float a_ = K[21], b_ = K[23]; const bool g_ = a_ > b_; K[21] = g_ ? a_ : b_; K[23] = g_ ? b_ : a_; }
  { const float a_ = K[24], b_ = K[26]; const bool g_ = a_ > b_; K[24] = g_ ? a_ : b_; K[26] = g_ ? b_ : a_; }
  { const float a_ = K[25], b_ = K[27]; const bool g_ = a_ > b_; K[25] = g_ ? a_ : b_; K[27] = g_ ? b_ : a_; }
  { const float a_ = K[28], b_ = K[30]; const bool g_ = a_ > b_; K[28] = g_ ? a_ : b_; K[30] = g_ ? b_ : a_; }
  { const float a_ = K[29], b_ = K[31]; const bool g_ = a_ > b_; K[29] = g_ ? a_ : b_; K[31] = g_ ? b_ : a_; }
  { const float a_ = K[16], b_ = K[17]; const bool g_ = a_ > b_; K[16] = g_ ? a_ : b_; K[17] = g_ ? b_ : a_; }
  { const float a_ = K[18], b_ = K[19]; const bool g_ = a_ > b_; K[18] = g_ ? a_ : b_; K[19] = g_ ? b_ : a_; }
  { const float a_ = K[20], b_ = K[21]; const bool g_ = a_ > b_; K[20] = g_ ? a_ : b_; K[21] = g_ ? b_ : a_; }
  { const float a_ = K[22], b_ = K[23]; const bool g_ = a_ > b_; K[22] = g_ ? a_ : b_; K[23] = g_ ? b_ : a_; }
  { const float a_ = K[24], b_ = K[25]; const bool g_ = a_ > b_; K[24] = g_ ? a_ : b_; K[25] = g_ ? b_ : a_; }
  { const float a_ = K[26], b_ = K[27]; const bool g_ = a_ > b_; K[26] = g_ ? a_ : b_; K[27] = g_ ? b_ : a_; }
  { const float a_ = K[28], b_ = K[29]; const bool g_ = a_ > b_; K[28] = g_ ? a_ : b_; K[29] = g_ ? b_ : a_; }
  { const float a_ = K[30], b_ = K[31]; const bool g_ = a_ > b_; K[30] = g_ ? a_ : b_; K[31] = g_ ? b_ : a_; }
  { const float a_ = K[32], b_ = K[33]; const bool g_ = a_ > b_; K[32] = g_ ? a_ : b_; K[33] = g_ ? b_ : a_; }
  { const float a_ = K[34], b_ = K[35]; const bool g_ = a_ > b_; K[34] = g_ ? b_ : a_; K[35] = g_ ? a_ : b_; }
  { const float a_ = K[36], b_ = K[37]; const bool g_ = a_ > b_; K[36] = g_ ? a_ : b_; K[37] = g_ ? b_ : a_; }
  { const float a_ = K[38], b_ = K[39]; const bool g_ = a_ > b_; K[38] = g_ ? b_ : a_; K[39] = g_ ? a_ : b_; }
  { const float a_ = K[40], b_ = K[41]; const bool g_ = a_ > b_; K[40] = g_ ? a_ : b_; K[41] = g_ ? b_ : a_; }
  { const float a_ = K[42], b_ = K[43]; const bool g_ = a_ > b_; K[42] = g_ ? b_ : a_; K[43] = g_ ? a_ : b_; }
  { const float a_ = K[44], b_ = K[45]; const bool g_ = a_ > b_; K[44] = g_ ? a_ : b_; K[45] = g_ ? b_ : a_; }
  { const float a_ = K[46], b_ = K[47]; const bool g_ = a_ > b_; K[46] = g_ ? b_ : a_; K[47] = g_ ? a_ : b_; }
  { const float a_ = K[32], b_ = K[34]; const bool g_ = a_ > b_; K[32] = g_ ? a_ : b_; K[34] = g_ ? b_ : a_; }
  { const float a_ = K[33], b_ = K[35]; const bool g_ = a_ > b_; K[33] = g_ ? a_ : b_; K[35] = g_ ? b_ : a_; }
  { const float a_ = K[36], b_ = K[38]; const bool g_ = a_ > b_; K[36] = g_ ? b_ : a_; K[38] = g_ ? a_ : b_; }
  { const float a_ = K[37], b_ = K[39]; const bool g_ = a_ > b_; K[37] = g_ ? b_ : a_; K[39] = g_ ? a_ : b_; }
  { const float a_ = K[40], b_ = K[42]; const bool g_ = a_ > b_; K[40] = g_ ? a_ : b_; K[42] = g_ ? b_ : a_; }
  { const float a_ = K[41], b_ = K[43]; const bool g_ = a_ > b_; K[41] = g_ ? a_ : b_; K[43] = g_ ? b_ : a_; }
  { const float a_ = K[44], b_ = K[46]; const bool g_ = a_ > b_; K[44] = g_ ? b_ : a_; K[46] = g_ ? a_ : b_; }
  { const float a_ = K[45], b_ = K[47]; const bool g_ = a_ > b_; K[45] = g_ ? b_ : a_; K[47] = g_ ? a_ : b_; }
  { const float a_ = K[32], b_ = K[33]; const bool g_ = a_ > b_; K[32] = g_ ? a_ : b_; K[33] = g_ ? b_ : a_; }
  { const float a_ = K[34], b_ = K[35]; const bool g_ = a_ > b_; K[34] = g_ ? a_ : b_; K[35] = g_ ? b_ : a_; }
  { const float a_ = K[36], b_ = K[37]; const bool g_ = a_ > b_; K[36] = g_ ? b_ : a_; K[37] = g_ ? a_ : b_; }
  { const float a_ = K[38], b_ = K[39]; const bool g_ = a_ > b_; K[38] = g_ ? b_ : a_; K[39] = g_ ? a_ : b_; }
  { const float a_ = K[40], b_ = K[41]; const bool g_ = a_ > b_; K[40] = g_ ? a_ : b_; K[41] = g_ ? b_ : a_; }
  { const float a_ = K[42], b_ = K[43]; const bool g_ = a_ > b_; K[42] = g_ ? a_ : b_; K[43] = g_ ? b_ : a_; }
  { const float a_ = K[44], b_ = K[45]; const bool g_ = a_ > b_; K[44] = g_ ? b_ : a_; K[45] = g_ ? a_ : b_; }
  { const float a_ = K[46], b_ = K[47]; const bool g_ = a_ > b_; K[46] = g_ ? b_ : a_; K[47] = g_ ? a_ : b_; }
  { const float a_ = K[32], b_ = K[36]; const bool g_ = a_ > b_; K[32] = g_ ? a_ : b_; K[36] = g_ ? b_ : a_; }
  { const float a_ = K[33], b_ = K[37]; const bool g_ = a_ > b_; K[33] = g_ ? a_ : b_; K[37] = g_ ? b_ : a_; }
  { const float a_ = K[34], b_ = K[38]; const bool g_ = a_ > b_; K[34] = g_ ? a_ : b_; K[38] = g_ ? b_ : a_; }
  { const float a_ = K[35], b_ = K[39]; const bool g_ = a_ > b_; K[35] = g_ ? a_ : b_; K[39] = g_ ? b_ : a_; }
  { const float a_ = K[40], b_ = K[44]; const bool g_ = a_ > b_; K[40] = g_ ? b_ : a_; K[44] = g_ ? a_ : b_; }
  { const float a_ = K[41], b_ = K[45]; const bool g_ = a_ > b_; K[41] = g_ ? b_ : a_; K[45] = g_ ? a_ : b_; }
  { const float a_ = K[42], b_ = K[46]; const bool g_ = a_ > b_; K[42] = g_ ? b_ : a_; K[46] = g_ ? a_ : b_; }
  { const float a_ = K[43], b_ = K[47]; const bool g_ = a_ > b_; K[43] = g_ ? b_ : a_; K[47] = g_ ? a_ : b_; }
  { const float a_ = K[32], b_ = K[34]; const bool g_ = a_ > b_; K[32] = g_ ? a_ : b_; K[34] = g_ ? b_ : a_; }
  { const float a_ = K[33], b_ = K[35]; const bool g_ = a_ > b_; K[33] = g_ ? a_ : b_; K[35] = g_ ? b_ : a_; }
  { const float a_ = K[36], b_ = K[38]; const bool g_ = a_ > b_; K[36] = g_ ? a_ : b_; K[38] = g_ ? b_ : a_; }
  { const float a_ = K[37], b_ = K[39]; const bool g_ = a_ > b_; K[37] = g_ ? a_ : b_; K[39] = g_ ? b_ : a_; }
  { const float a_ = K[40], b_ = K[42]; const bool g_ = a_ > b_; K[40] = g_ ? b_ : a_; K[42] = g_ ? a_ : b_; }
  { const float a_ = K[41], b_ = K[43]; const bool g_ = a_ > b_; K[41] = g_ ? b_ : a_; K[43] = g_ ? a_ : b_; }
  { const float a_ = K[44], b_ = K[46]; const bool g_ = a_ > b_; K[44] = g_ ? b_ : a_; K[46] = g_ ? a_ : b_; }
  { const float a_ = K[45], b_ = K[47]; const bool g_ = a_ > b_; K[45] = g_ ? b_ : a_; K[47] = g_ ? a_ : b_; }
  { const float a_ = K[32], b_ = K[33]; const bool g_ = a_ > b_; K[32] = g_ ? a_ : b_; K[33] = g_ ? b_ : a_; }
  { const float a_ = K[34], b_ = K[35]; const bool g_ = a_ > b_; K[34] = g_ ? a_ : b_; K[35] = g_ ? b_ : a_; }
  { const float a_ = K[36], b_ = K[37]; const bool g_ = a_ > b_; K[36] = g_ ? a_ : b_; K[37] = g_ ? b_ : a_; }
  { const float a_ = K[38], b_ = K[39]; const bool g_ = a_ > b_; K[38] = g_ ? a_ : b_; K[39] = g_ ? b_ : a_; }
  { const float a_ = K[40], b_ = K[41]; const bool g_ = a_ > b_; K[40] = g_ ? b_ : a_; K[41] = g_ ? a_ : b_; }
  { const float a_ = K[42], b_ = K[43]; const bool g_ = a_ > b_; K[42] = g_ ? b_ : a_; K[43] = g_ ? a_ : b_; }
  { const float a_ = K[44], b_ = K[45]; const bool g_ = a_ > b_; K[44] = g_ ? b_ : a_; K[45] = g_ ? a_ : b_; }
  { const float a_ = K[46], b_ = K[47]; const bool g_ = a_ > b_; K[46] = g_ ? b_ : a_; K[47] = g_ ? a_ : b_; }
  { const float a_ = K[32], b_ = K[40]; const bool g_ = a_ > b_; K[32] = g_ ? a_ : b_; K[40] = g_ ? b_ : a_; }
  { const float a_ = K[33], b_ = K[41]; const bool g_ = a_ > b_; K[33] = g_ ? a_ : b_; K[41] = g_ ? b_ : a_; }
  { const float a_ = K[34], b_ = K[42]; const bool g_ = a_ > b_; K[34] = g_ ? a_ : b_; K[42] = g_ ? b_ : a_; }
  { const float a_ = K[35], b_ = K[43]; const bool g_ = a_ > b_; K[35] = g_ ? a_ : b_; K[43] = g_ ? b_ : a_; }
  { const float a_ = K[36], b_ = K[44]; const bool g_ = a_ > b_; K[36] = g_ ? a_ : b_; K[44] = g_ ? b_ : a_; }
  { const float a_ = K[37], b_ = K[45]; const bool g_ = a_ > b_; K[37] = g_ ? a_ : b_; K[45] = g_ ? b_ : a_; }
  { const float a_ = K[38], b_ = K[46]; const bool g_ = a_ > b_; K[38] = g_ ? a_ : b_; K[46] = g_ ? b_ : a_; }
  { const float a_ = K[39], b_ = K[47]; const bool g_ = a_ > b_; K[39] = g_ ? a_ : b_; K[47] = g_ ? b_ : a_; }
  { const float a_ = K[32], b_ = K[36]; const bool g_ = a_ > b_; K[32] = g_ ? a_ : b_; K[36] = g_ ? b_ : a_; }
  { const float a_ = K[33], b_ = K[37]; const bool g_ = a_ > b_; K[33] = g_ ? a_ : b_; K[37] = g_ ? b_ : a_; }
  { const float a_ = K[34], b_ = K[38]; const bool g_ = a_ > b_; K[34] = g_ ? a_ : b_; K[38] = g_ ? b_ : a_; }
  { const float a_ = K[35], b_ = K[39]; const bool g_ = a_ > b_; K[35] = g_ ? a_ : b_; K[39] = g_ ? b_ : a_; }
  { const float a_ = K[40], b_ = K[44]; const bool g_ = a_ > b_; K[40] = g_ ? a_ : b_; K[44] = g_ ? b_ : a_; }
  { const float a_ = K[41], b_ = K[45]; const bool g_ = a_ > b_; K[41] = g_ ? a_ : b_; K[45] = g_ ? b_ : a_; }
  { const float a_ = K[42], b_ = K[46]; const bool g_ = a_ > b_; K[42] = g_ ? a_ : b_; K[46] = g_ ? b_ : a_; }
  { const float a_ = K[43], b_ = K[47]; const bool g_ = a_ > b_; K[43] = g_ ? a_ : b_; K[47] = g_ ? b_ : a_; }
  { const float a_ = K[32], b_ = K[34]; const bool g_ = a_ > b_; K[32] = g_ ? a_ : b_; K[34] = g_ ? b_ : a_; }
  { const float a_ = K[33], b_ = K[35]; const bool g_ = a_ > b_; K[33] = g_ ? a_ : b_; K[35] = g_ ? b_ : a_; }
  { const float a_ = K[36], b_ = K[38]; const bool g_ = a_ > b_; K[36] = g_ ? a_ : b_; K[38] = g_ ? b_ : a_; }
  { const float a_ = K[37], b_ = K[39]; const bool g_ = a_ > b_; K[37] = g_ ? a_ : b_; K[39] = g_ ? b_ : a_; }
  { const float a_ = K[40], b_ = K[42]; const bool g_ = a_ > b_; K[40] = g_ ? a_ : b_; K[42] = g_ ? b_ : a_; }
  { const float a_ = K[41], b_ = K[43]; const bool g_ = a_ > b_; K[41] = g_ ? a_ : b_; K[43] = g_ ? b_ : a_; }
  { const float a_ = K[44], b_ = K[46]; const bool g_ = a_ > b_; K[44] = g_ ? a_ : b_; K[46] = g_ ? b_ : a_; }
  { const float a_ = K[45], b_ = K[47]; const bool g_ = a_ > b_; K[45] = g_ ? a_ : b_; K[47] = g_ ? b_ : a_; }
  { const float a_ = K[32], b_ = K[33]; const bool g_ = a_ > b_; K[32] = g_ ? a_ : b_; K[33] = g_ ? b_ : a_; }
  { const float a_ = K[34], b_ = K[35]; const bool g_ = a_ > b_; K[34] = g_ ? a_ : b_; K[35] = g_ ? b_ : a_; }
  { const float a_ = K[36], b_ = K[37]; const bool g_ = a_ > b_; K[36] = g_ ? a_ : b_; K[37] = g_ ? b_ : a_; }
  { const float a_ = K[38], b_ = K[39]; const bool g_ = a_ > b_; K[38] = g_ ? a_ : b_; K[39] = g_ ? b_ : a_; }
  { const float a_ = K[40], b_ = K[41]; const bool g_ = a_ > b_; K[40] = g_ ? a_ : b_; K[41] = g_ ? b_ : a_; }
  { const float a_ = K[42], b_ = K[43]; const bool g_ = a_ > b_; K[42] = g_ ? a_ : b_; K[43] = g_ ? b_ : a_; }
  { const float a_ = K[44], b_ = K[45]; const bool g_ = a_ > b_; K[44] = g_ ? a_ : b_; K[45] = g_ ? b_ : a_; }
  { const float a_ = K[46], b_ = K[47]; const bool g_ = a_ > b_; K[46] = g_ ? a_ : b_; K[47] = g_ ? b_ : a_; }
  { const float a_ = K[48], b_ = K[49]; const bool g_ = a_ > b_; K[48] = g_ ? a_ : b_; K[49] = g_ ? b_ : a_; }
  { const float a_ = K[50], b_ = K[51]; const bool g_ = a_ > b_; K[50] = g_ ? b_ : a_; K[51] = g_ ? a_ : b_; }
  { const float a_ = K[52], b_ = K[53]; const bool g_ = a_ > b_; K[52] = g_ ? a_ : b_; K[53] = g_ ? b_ : a_; }
  { const float a_ = K[54], b_ = K[55]; const bool g_ = a_ > b_; K[54] = g_ ? b_ : a_; K[55] = g_ ? a_ : b_; }
  { const float a_ = K[56], b_ = K[57]; const bool g_ = a_ > b_; K[56] = g_ ? a_ : b_; K[57] = g_ ? b_ : a_; }
  { const float a_ = K[58], b_ = K[59]; const bool g_ = a_ > b_; K[58] = g_ ? b_ : a_; K[59] = g_ ? a_ : b_; }
  { const float a_ = K[60], b_ = K[61]; const bool g_ = a_ > b_; K[60] = g_ ? a_ : b_; K[61] = g_ ? b_ : a_; }
  { const float a_ = K[62], b_ = K[63]; const bool g_ = a_ > b_; K[62] = g_ ? b_ : a_; K[63] = g_ ? a_ : b_; }
  { const float a_ = K[48], b_ = K[50]; const bool g_ = a_ > b_; K[48] = g_ ? a_ : b_; K[50] = g_ ? b_ : a_; }
  { const float a_ = K[49], b_ = K[51]; const bool g_ = a_ > b_; K[49] = g_ ? a_ : b_; K[51] = g_ ? b_ : a_; }
  { const float a_ = K[52], b_ = K[54]; const bool g_ = a_ > b_; K[52] = g_ ? b_ : a_; K[54] = g_ ? a_ : b_; }
  { const float a_ = K[53], b_ = K[55]; const bool g_ = a_ > b_; K[53] = g_ ? b_ : a_; K[55] = g_ ? a_ : b_; }
  { const float a_ = K[56], b_ = K[58]; const bool g_ = a_ > b_; K[56] = g_ ? a_ : b_; K[58] = g_ ? b_ : a_; }
  { const float a_ = K[57], b_ = K[59]; const bool g_ = a_ > b_; K[57] = g_ ? a_ : b_; K[59] = g_ ? b_ : a_; }
  { const float a_ = K[60], b_ = K[62]; const bool g_ = a_ > b_; K[60] = g_ ? b_ : a_; K[62] = g_ ? a_ : b_; }
  { const float a_ = K[61], b_ = K[63]; const bool g_ = a_ > b_; K[61] = g_ ? b_ : a_; K[63] = g_ ? a_ : b_; }
  { const float a_ = K[48], b_ = K[49]; const bool g_ = a_ > b_; K[48] = g_ ? a_ : b_; K[49] = g_ ? b_ : a_; }
  { const float a_ = K[50], b_ = K[51]; const bool g_ = a_ > b_; K[50] = g_ ? a_ : b_; K[51] = g_ ? b_ : a_; }
  { const float a_ = K[52], b_ = K[53]; const bool g_ = a_ > b_; K[52] = g_ ? b_ : a_; K[53] = g_ ? a_ : b_; }
  { const float a_ = K[54], b_ = K[55]; const bool g_ = a_ > b_; K[54] = g_ ? b_ : a_; K[55] = g_ ? a_ : b_; }
  { const float a_ = K[56], b_ = K[57]; const bool g_ = a_ > b_; K[56] = g_ ? a_ : b_; K[57] = g_ ? b_ : a_; }
  { const float a_ = K[58], b_ = K[59]; const bool g_ = a_ > b_; K[58] = g_ ? a_ : b_; K[59] = g_ ? b_ : a_; }
  { const float a_ = K[60], b_ = K[61]; const bool g_ = a_ > b_; K[60] = g_ ? b_ : a_; K[61] = g_ ? a_ : b_; }
  { const float a_ = K[62], b_ = K[63]; const bool g_ = a_ > b_; K[62] = g_ ? b_ : a_; K[63] = g_ ? a_ : b_; }
  { const float a_ = K[48], b_ = K[52]; const bool g_ = a_ > b_; K[48] = g_ ? a_ : b_; K[52] = g_ ? b_ : a_; }
  { const float a_ = K[49], b_ = K[53]; const bool g_ = a_ > b_; K[49] = g_ ? a_ : b_; K[53] = g_ ? b_ : a_; }
  { const float a_ = K[50], b_ = K[54]; const bool g_ = a_ > b_; K[50] = g_ ? a_ : b_; K[54] = g_ ? b_ : a_; }
  { const float a_ = K[51], b_ = K[55]; const bool g_ = a_ > b_; K[51] = g_ ? a_ : b_; K[55] = g_ ? b_ : a_; }
  { const float a_ = K[56], b_ = K[60]; const bool g_ = a_ > b_; K[56] = g_ ? b_ : a_; K[60] = g_ ? a_ : b_; }
  { const float a_ = K[57], b_ = K[61]; const bool g_ = a_ > b_; K[57] = g_ ? b_ : a_; K[61] = g_ ? a_ : b_; }
  { const float a_ = K[58], b_ = K[62]; const bool g_ = a_ > b_; K[58] = g_ ? b_ : a_; K[62] = g_ ? a_ : b_; }
  { const float a_ = K[59], b_ = K[63]; const bool g_ = a_ > b_; K[59] = g_ ? b_ : a_; K[63] = g_ ? a_ : b_; }
  { const float a_ = K[48], b_ = K[50]; const bool g_ = a_ > b_; K[48] = g_ ? a_ : b_; K[50] = g_ ? b_ : a_; }
  { const float a_ = K[49], b_ = K[51]; const bool g_ = a_ > b_; K[49] = g_ ? a_ : b_; K[51] = g_ ? b_ : a_; }
  { const float a_ = K[52], b_ = K[54]; const bool g_ = a_ > b_; K[52] = g_ ? a_ : b_; K[54] = g_ ? b_ : a_; }
  { const float a_ = K[53], b_ = K[55]; const bool g_ = a_ > b_; K[53] = g_ ? a_ : b_; K[55] = g_ ? b_ : a_; }
  { const float a_ = K[56], b_ = K[58]; const bool g_ = a_ > b_; K[56] = g_ ? b_ : a_; K[58] = g_ ? a_ : b_; }
  { const float a_ = K[57], b_ = K[59]; const bool g_ = a_ > b_; K[57] = g_ ? b_ : a_; K[59] = g_ ? a_ : b_; }
  { const float a_ = K[60], b_ = K[62]; const bool g_ = a_ > b_; K[60] = g_ ? b_ : a_; K[62] = g_ ? a_ : b_; }
  { const float a_ = K[61], b_ = K[63]; const bool g_ = a_ > b_; K[61] = g_ ? b_ : a_; K[63] = g_ ? a_ : b_; }
  { const float a_ = K[48], b_ = K[49]; const bool g_ = a_ > b_; K[48] = g_ ? a_ : b_; K[49] = g_ ? b_ : a_; }
  { const float a_ = K[50], b_ = K[51]; const bool g_ = a_ > b_; K[50] = g_ ? a_ : b_; K[51] = g_ ? b_ : a_; }
  { const float a_ = K[52], b_ = K[53]; const bool g_ = a_ > b_; K[52] = g_ ? a_ : b_; K[53] = g_ ? b_ : a_; }
  { const float a_ = K[54], b_ = K[55]; const bool g_ = a_ > b_; K[54] = g_ ? a_ : b_; K[55] = g_ ? b_ : a_; }
  { const float a_ = K[56], b_ = K[57]; const bool g_ = a_ > b_; K[56] = g_ ? b_ : a_; K[57] = g_ ? a_ : b_; }
  { const float a_ = K[58], b_ = K[59]; const bool g_ = a_ > b_; K[58] = g_ ? b_ : a_; K[59] = g_ ? a_ : b_; }
  { const float a_ = K[60], b_ = K[61]; const bool g_ = a_ > b_; K[60] = g_ ? b_ : a_; K[61] = g_ ? a_ : b_; }
  { const float a_ = K[62], b_ = K[63]; const bool g_ = a_ > b_; K[62] = g_ ? b_ : a_; K[63] = g_ ? a_ : b_; }
  { const float a_ = K[48], b_ = K[56]; const bool g_ = a_ > b_; K[48] = g_ ? a_ : b_; K[56] = g_ ? b_ : a_; }
  { const float a_ = K[49], b_ = K[57]; const bool g_ = a_ > b_; K[49] = g_ ? a_ : b_; K[57] = g_ ? b_ : a_; }
  { const float a_ = K[50], b_ = K[58]; const bool g_ = a_ > b_; K[50] = g_ ? a_ : b_; K[58] = g_ ? b_ : a_; }
  { const float a_ = K[51], b_ = K[59]; const bool g_ = a_ > b_; K[51] = g_ ? a_ : b_; K[59] = g_ ? b_ : a_; }
  { const float a_ = K[52], b_ = K[60]; const bool g_ = a_ > b_; K[52] = g_ ? a_ : b_; K[60] = g_ ? b_ : a_; }
  { const float a_ = K[53], b_ = K[61]; const bool g_ = a_ > b_; K[53] = g_ ? a_ : b_; K[61] = g_ ? b_ : a_; }
  { const float a_ = K[54], b_ = K[62]; const bool g_ = a_ > b_; K[54] = g_ ? a_ : b_; K[62] = g_ ? b_ : a_; }
  { const float a_ = K[55], b_ = K[63]; const bool g_ = a_ > b_; K[55] = g_ ? a_ : b_; K[63] = g_ ? b_ : a_; }
  { const float a_ = K[48], b_ = K[52]; const bool g_ = a_ > b_; K[48] = g_ ? a_ : b_; K[52] = g_ ? b_ : a_; }
  { const float a_ = K[49], b_ = K[53]; const bool g_ = a_ > b_; K[49] = g_ ? a_ : b_; K[53] = g_ ? b_ : a_; }
  { const float a_ = K[50], b_ = K[54]; const bool g_ = a_ > b_; K[50] = g_ ? a_ : b_; K[54] = g_ ? b_ : a_; }
  { const float a_ = K[51], b_ = K[55]; const bool g_ = a_ > b_; K[51] = g_ ? a_ : b_; K[55] = g_ ? b_ : a_; }
  { const float a_ = K[56], b_ = K[60]; const bool g_ = a_ > b_; K[56] = g_ ? a_ : b_; K[60] = g_ ? b_ : a_; }
  { const float a_ = K[57], b_ = K[61]; const bool g_ = a_ > b_; K[57] = g_ ? a_ : b_; K[61] = g_ ? b_ : a_; }
  { const float a_ = K[58], b_ = K[62]; const bool g_ = a_ > b_; K[58] = g_ ? a_ : b_; K[62] = g_ ? b_ : a_; }
  { const float a_ = K[59], b_ = K[63]; const bool g_ = a_ > b_; K[59] = g_ ? a_ : b_; K[63] = g_ ? b_ : a_; }
  { const float a_ = K[48], b_ = K[50]; const bool g_ = a_ > b_; K[48] = g_ ? a_ : b_; K[50] = g_ ? b_ : a_; }
  { const float a_ = K[49], b_ = K[51]; const bool g_ = a_ > b_; K[49] = g_ ? a_ : b_; K[51] = g_ ? b_ : a_; }
  { const float a_ = K[52], b_ = K[54]; const bool g_ = a_ > b_; K[52] = g_ ? a_ : b_; K[54] = g_ ? b_ : a_; }
  { const float a_ = K[53], b_ = K[55]; const bool g_ = a_ > b_; K[53] = g_ ? a_ : b_; K[55] = g_ ? b_ : a_; }
  { const float a_ = K[56], b_ = K[58]; const bool g_ = a_ > b_; K[56] = g_ ? a_ : b_; K[58] = g_ ? b_ : a_; }
  { const float a_ = K[57], b_ = K[59]; const bool g_ = a_ > b_; K[57] = g_ ? a_ : b_; K[59] = g_ ? b_ : a_; }
  { const float a_ = K[60], b_ = K[62]; const bool g_ = a_ > b_; K[60] = g_ ? a_ : b_; K[62] = g_ ? b_ : a_; }
  { const float a_ = K[61], b_ = K[63]; const bool g_ = a_ > b_; K[61] = g_ ? a_ : b_; K[63] = g_ ? b_ : a_; }
  { const float a_ = K[48], b_ = K[49]; const bool g_ = a_ > b_; K[48] = g_ ? a_ : b_; K[49] = g_ ? b_ : a_; }
  { const float a_ = K[50], b_ = K[51]; const bool g_ = a_ > b_; K[50] = g_ ? a_ : b_; K[51] = g_ ? b_ : a_; }
  { const float a_ = K[52], b_ = K[53]; const bool g_ = a_ > b_; K[52] = g_ ? a_ : b_; K[53] = g_ ? b_ : a_; }
  { const float a_ = K[54], b_ = K[55]; const bool g_ = a_ > b_; K[54] = g_ ? a_ : b_; K[55] = g_ ? b_ : a_; }
  { const float a_ = K[56], b_ = K[57]; const bool g_ = a_ > b_; K[56] = g_ ? a_ : b_; K[57] = g_ ? b_ : a_; }
  { const float a_ = K[58], b_ = K[59]; const bool g_ = a_ > b_; K[58] = g_ ? a_ : b_; K[59] = g_ ? b_ : a_; }
  { const float a_ = K[60], b_ = K[61]; const bool g_ = a_ > b_; K[60] = g_ ? a_ : b_; K[61] = g_ ? b_ : a_; }
  { const float a_ = K[62], b_ = K[63]; const bool g_ = a_ > b_; K[62] = g_ ? a_ : b_; K[63] = g_ ? b_ : a_; }
  { const float a_ = K[0], b_ = K[31]; K[0] = a_ > b_ ? a_ : b_; }
  { const float a_ = K[1], b_ = K[30]; K[1] = a_ > b_ ? a_ : b_; }
  { const float a_ = K[2], b_ = K[29]; K[2] = a_ > b_ ? a_ : b_; }
  { const float a_ = K[3], b_ = K[28]; K[3] = a_ > b_ ? a_ : b_; }
  { const float a_ = K[4], b_ = K[27]; K[4] = a_ > b_ ? a_ : b_; }
  { const float a_ = K[5], b_ = K[26]; K[5] = a_ > b_ ? a_ : b_; }
  { const float a_ = K[6], b_ = K[25]; K[6] = a_ > b_ ? a_ : b_; }
  { const float a_ = K[7], b_ = K[24]; K[7] = a_ > b_ ? a_ : b_; }
  { const float a_ = K[8], b_ = K[23]; K[8] = a_ > b_ ? a_ : b_; }
  { const float a_ = K[9], b_ = K[22]; K[9] = a_ > b_ ? a_ : b_; }
  { const float a_ = K[10], b_ = K[21]; K[10] = a_ > b_ ? a_ : b_; }
  { const float a_ = K[11], b_ = K[20]; K[11] = a_ > b_ ? a_ : b_; }
  { const float a_ = K[12], b_ = K[19]; K[12] = a_ > b_ ? a_ : b_; }
  { const float a_ = K[13], b_ = K[18]; K[13] = a_ > b_ ? a_ : b_; }
  { const float a_ = K[14], b_ = K[17]; K[14] = a_ > b_ ? a_ : b_; }
  { const float a_ = K[15], b_ = K[16]; K[15] = a_ > b_ ? a_ : b_; }
  { const float a_ = K[0], b_ = K[8]; const bool g_ = a_ > b_; K[0] = g_ ? a_ : b_; K[8] = g_ ? b_ : a_; }
  { const float a_ = K[1], b_ = K[9]; const bool g_ = a_ > b_; K[1] = g_ ? a_ : b_; K[9] = g_ ? b_ : a_; }
  { const float a_ = K[2], b_ = K[10]; const bool g_ = a_ > b_; K[2] = g_ ? a_ : b_; K[10] = g_ ? b_ : a_; }
  { const float a_ = K[3], b_ = K[11]; const bool g_ = a_ > b_; K[3] = g_ ? a_ : b_; K[11] = g_ ? b_ : a_; }
  { const float a_ = K[4], b_ = K[12]; const bool g_ = a_ > b_; K[4] = g_ ? a_ : b_; K[12] = g_ ? b_ : a_; }
  { const float a_ = K[5], b_ = K[13]; const bool g_ = a_ > b_; K[5] = g_ ? a_ : b_; K[13] = g_ ? b_ : a_; }
  { const float a_ = K[6], b_ = K[14]; const bool g_ = a_ > b_; K[6] = g_ ? a_ : b_; K[14] = g_ ? b_ : a_; }
  { const float a_ = K[7], b_ = K[15]; const bool g_ = a_ > b_; K[7] = g_ ? a_ : b_; K[15] = g_ ? b_ : a_; }
  { const float a_ = K[0], b_ = K[4]; const bool g_ = a_ > b_; K[0] = g_ ? a_ : b_; K[4] = g_ ? b_ : a_; }
  { const float a_ = K[1], b_ = K[5]; const bool g_ = a_ > b_; K[1] = g_ ? a_ : b_; K[5] = g_ ? b_ : a_; }
  { const float a_ = K[2], b_ = K[6]; const bool g_ = a_ > b_; K[2] = g_ ? a_ : b_; K[6] = g_ ? b_ : a_; }
  { const float a_ = K[3], b_ = K[7]; const bool g_ = a_ > b_; K[3] = g_ ? a_ : b_; K[7] = g_ ? b_ : a_; }
  { const float a_ = K[8], b_ = K[12]; const bool g_ = a_ > b_; K[8] = g_ ? a_ : b_; K[12] = g_ ? b_ : a_; }
  { const float a_ = K[9], b_ = K[13]; const bool g_ = a_ > b_; K[9] = g_ ? a_ : b_; K[13] = g_ ? b_ : a_; }
  { const float a_ = K[10], b_ = K[14]; const bool g_ = a_ > b_; K[10] = g_ ? a_ : b_; K[14] = g_ ? b_ : a_; }
  { const float a_ = K[11], b_ = K[15]; const bool g_ = a_ > b_; K[11] = g_ ? a_ : b_; K[15] = g_ ? b_ : a_; }
  { const float a_ = K[0], b_ = K[2]; const bool g_ = a_ > b_; K[0] = g_ ? a_ : b_; K[2] = g_ ? b_ : a_; }
  { const float a_ = K[1], b_ = K[3]; const bool g_ = a_ > b_; K[1] = g_ ? a_ : b_; K[3] = g_ ? b_ : a_; }
  { const float a_ = K[4], b_ = K[6]; const bool g_ = a_ > b_; K[4] = g_ ? a_ : b_; K[6] = g_ ? b_ : a_; }
  { const float a_ = K[5], b_ = K[7]; const bool g_ = a_ > b_; K[5] = g_ ? a_ : b_; K[7] = g_ ? b_ : a_; }
  { const float a_ = K[8], b_ = K[10]; const bool g_ = a_ > b_; K[8] = g_ ? a_ : b_; K[10] = g_ ? b_ : a_; }
  { const float a_ = K[9], b_ = K[11]; const bool g_ = a_ > b_; K[9] = g_ ? a_ : b_; K[11] = g_ ? b_ : a_; }
  { const float a_ = K[12], b_ = K[14]; const bool g_ = a_ > b_; K[12] = g_ ? a_ : b_; K[14] = g_ ? b_ : a_; }
  { const float a_ = K[13], b_ = K[15]; const bool g_ = a_ > b_; K[13] = g_ ? a_ : b_; K[15] = g_ ? b_ : a_; }
  { const float a_ = K[0], b_ = K[1]; const bool g_ = a_ > b_; K[0] = g_ ? a_ : b_; K[1] = g_ ? b_ : a_; }
  { const float a_ = K[2], b_ = K[3]; const bool g_ = a_ > b_; K[2] = g_ ? a_ : b_; K[3] = g_ ? b_ : a_; }
  { const float a_ = K[4], b_ = K[5]; const bool g_ = a_ > b_; K[4] = g_ ? a_ : b_; K[5] = g_ ? b_ : a_; }
  { const float a_ = K[6], b_ = K[7]; const bool g_ = a_ > b_; K[6] = g_ ? a_ : b_; K[7] = g_ ? b_ : a_; }
  { const float a_ = K[8], b_ = K[9]; const bool g_ = a_ > b_; K[8] = g_ ? a_ : b_; K[9] = g_ ? b_ : a_; }
  { const float a_ = K[10], b_ = K[11]; const bool g_ = a_ > b_; K[10] = g_ ? a_ : b_; K[11] = g_ ? b_ : a_; }
  { const float a_ = K[12], b_ = K[13]; const bool g_ = a_ > b_; K[12] = g_ ? a_ : b_; K[13] = g_ ? b_ : a_; }
  { const float a_ = K[14], b_ = K[15]; const bool g_ = a_ > b_; K[14] = g_ ? a_ : b_; K[15] = g_ ? b_ : a_; }
  { const float a_ = K[32], b_ = K[63]; K[32] = a_ > b_ ? a_ : b_; }
  { const float a_ = K[33], b_ = K[62]; K[33] = a_ > b_ ? a_ : b_; }
  { const float a_ = K[34], b_ = K[61]; K[34] = a_ > b_ ? a_ : b_; }
  { const float a_ = K[35], b_ = K[60]; K[35] = a_ > b_ ? a_ : b_; }
  { const float a_ = K[36], b_ = K[59]; K[36] = a_ > b_ ? a_ : b_; }
  { const float a_ = K[37], b_ = K[58]; K[37] = a_ > b_ ? a_ : b_; }
  { const float a_ = K[38], b_ = K[57]; K[38] = a_ > b_ ? a_ : b_; }
  { const float a_ = K[39], b_ = K[56]; K[39] = a_ > b_ ? a_ : b_; }
  { const float a_ = K[40], b_ = K[55]; K[40] = a_ > b_ ? a_ : b_; }
  { const float a_ = K[41], b_ = K[54]; K[41] = a_ > b_ ? a_ : b_; }
  { const float a_ = K[42], b_ = K[53]; K[42] = a_ > b_ ? a_ : b_; }
  { const float a_ = K[43], b_ = K[52]; K[43] = a_ > b_ ? a_ : b_; }
  { const float a_ = K[44], b_ = K[51]; K[44] = a_ > b_ ? a_ : b_; }
  { const float a_ = K[45], b_ = K[50]; K[45] = a_ > b_ ? a_ : b_; }
  { const float a_ = K[46], b_ = K[49]; K[46] = a_ > b_ ? a_ : b_; }
  { const float a_ = K[47], b_ = K[48]; K[47] = a_ > b_ ? a_ : b_; }
  { const float a_ = K[32], b_ = K[40]; const bool g_ = a_ > b_; K[32] = g_ ? a_ : b_; K[40] = g_ ? b_ : a_; }
  { const float a_ = K[33], b_ = K[41]; const bool g_ = a_ > b_; K[33] = g_ ? a_ : b_; K[41] = g_ ? b_ : a_; }
  { const float a_ = K[34], b_ = K[42]; const bool g_ = a_ > b_; K[34] = g_ ? a_ : b_; K[42] = g_ ? b_ : a_; }
  { const float a_ = K[35], b_ = K[43]; const bool g_ = a_ > b_; K[35] = g_ ? a_ : b_; K[43] = g_ ? b_ : a_; }
  { const float a_ = K[36], b_ = K[44]; const bool g_ = a_ > b_; K[36] = g_ ? a_ : b_; K[44] = g_ ? b_ : a_; }
  { const float a_ = K[37], b_ = K[45]; const bool g_ = a_ > b_; K[37] = g_ ? a_ : b_; K[45] = g_ ? b_ : a_; }
  { const float a_ = K[38], b_ = K[46]; const bool g_ = a_ > b_; K[38] = g_ ? a_ : b_; K[46] = g_ ? b_ : a_; }
  { const float a_ = K[39], b_ = K[47]; const bool g_ = a_ > b_; K[39] = g_ ? a_ : b_; K[47] = g_ ? b_ : a_; }
  { const float a_ = K[32], b_ = K[36]; const bool g_ = a_ > b_; K[32] = g_ ? a_ : b_; K[36] = g_ ? b_ : a_; }
  { const float a_ = K[33], b_ = K[37]; const bool g_ = a_ > b_; K[33] = g_ ? a_ : b_; K[37] = g_ ? b_ : a_; }
  { const float a_ = K[34], b_ = K[38]; const bool g_ = a_ > b_; K[34] = g_ ? a_ : b_; K[38] = g_ ? b_ : a_; }
  { const float a_ = K[35], b_ = K[39]; const bool g_ = a_ > b_; K[35] = g_ ? a_ : b_; K[39] = g_ ? b_ : a_; }
  { const float a_ = K[40], b_ = K[44]; const bool g_ = a_ > b_; K[40] = g_ ? a_ : b_; K[44] = g_ ? b_ : a_; }
  { const float a_ = K[41], b_ = K[45]; const bool g_ = a_ > b_; K[41] = g_ ? a_ : b_; K[45] = g_ ? b_ : a_; }
  { const float a_ = K[42], b_ = K[46]; const bool g_ = a_ > b_; K[42] = g_ ? a_ : b_; K[46] = g_ ? b_ : a_; }
  { const float a_ = K[43], b_ = K[47]; const bool g_ = a_ > b_; K[43] = g_ ? a_ : b_; K[47] = g_ ? b_ : a_; }
  { const float a_ = K[32], b_ = K[34]; const bool g_ = a_ > b_; K[32] = g_ ? a_ : b_; K[34] = g_ ? b_ : a_; }
  { const float a_ = K[33], b_ = K[35]; const bool g_ = a_ > b_; K[33] = g_ ? a_ : b_; K[35] = g_ ? b_ : a_; }
  { const float a_ = K[36], b_ = K[38]; const bool g_ = a_ > b_; K[36] = g_ ? a_ : b_; K[38] = g_ ? b_ : a_; }
  { const float a_ = K[37], b_ = K[39]; const bool g_ = a_ > b_; K[37] = g_ ? a_ : b_; K[39] = g_ ? b_ : a_; }
  { const float a_ = K[40], b_ = K[42]; const bool g_ = a_ > b_; K[40] = g_ ? a_ : b_; K[42] = g_ ? b_ : a_; }
  { const float a_ = K[41], b_ = K[43]; const bool g_ = a_ > b_; K[41] = g_ ? a_ : b_; K[43] = g_ ? b_ : a_; }
  { const float a_ = K[44], b_ = K[46]; const bool g_ = a_ > b_; K[44] = g_ ? a_ : b_; K[46] = g_ ? b_ : a_; }
  { const float a_ = K[45], b_ = K[47]; const bool g_ = a_ > b_; K[45] = g_ ? a_ : b_; K[47] = g_ ? b_ : a_; }
  { const float a_ = K[32], b_ = K[33]; const bool g_ = a_ > b_; K[32] = g_ ? a_ : b_; K[33] = g_ ? b_ : a_; }
  { const float a_ = K[34], b_ = K[35]; const bool g_ = a_ > b_; K[34] = g_ ? a_ : b_; K[35] = g_ ? b_ : a_; }
  { const float a_ = K[36], b_ = K[37]; const bool g_ = a_ > b_; K[36] = g_ ? a_ : b_; K[37] = g_ ? b_ : a_; }
  { const float a_ = K[38], b_ = K[39]; const bool g_ = a_ > b_; K[38] = g_ ? a_ : b_; K[39] = g_ ? b_ : a_; }
  { const float a_ = K[40], b_ = K[41]; const bool g_ = a_ > b_; K[40] = g_ ? a_ : b_; K[41] = g_ ? b_ : a_; }
  { const float a_ = K[42], b_ = K[43]; const bool g_ = a_ > b_; K[42] = g_ ? a_ : b_; K[43] = g_ ? b_ : a_; }
  { const float a_ = K[44], b_ = K[45]; const bool g_ = a_ > b_; K[44] = g_ ? a_ : b_; K[45] = g_ ? b_ : a_; }
  { const float a_ = K[46], b_ = K[47]; const bool g_ = a_ > b_; K[46] = g_ ? a_ : b_; K[47] = g_ ? b_ : a_; }
  { const float a_ = K[0], b_ = K[47]; K[0] = a_ > b_ ? a_ : b_; }
  { const float a_ = K[1], b_ = K[46]; K[1] = a_ > b_ ? a_ : b_; }
  { const float a_ = K[2], b_ = K[45]; K[2] = a_ > b_ ? a_ : b_; }
  { const float a_ = K[3], b_ = K[44]; K[3] = a_ > b_ ? a_ : b_; }
  { const float a_ = K[4], b_ = K[43]; K[4] = a_ > b_ ? a_ : b_; }
  { const float a_ = K[5], b_ = K[42]; K[5] = a_ > b_ ? a_ : b_; }
  { const float a_ = K[6], b_ = K[41]; K[6] = a_ > b_ ? a_ : b_; }
  { const float a_ = K[7], b_ = K[40]; K[7] = a_ > b_ ? a_ : b_; }
  { const float a_ = K[8], b_ = K[39]; K[8] = a_ > b_ ? a_ : b_; }
  { const float a_ = K[9], b_ = K[38]; K[9] = a_ > b_ ? a_ : b_; }
  { const float a_ = K[10], b_ = K[37]; K[10] = a_ > b_ ? a_ : b_; }
  { const float a_ = K[11], b_ = K[36]; K[11] = a_ > b_ ? a_ : b_; }
  { const float a_ = K[12], b_ = K[35]; K[12] = a_ > b_ ? a_ : b_; }
  { const float a_ = K[13], b_ = K[34]; K[13] = a_ > b_ ? a_ : b_; }
  { const float a_ = K[14], b_ = K[33]; K[14] = a_ > b_ ? a_ : b_; }
  { const float a_ = K[15], b_ = K[32]; K[15] = a_ > b_ ? a_ : b_; }
  { const float a_ = K[0], b_ = K[8]; const bool g_ = a_ > b_; K[0] = g_ ? a_ : b_; K[8] = g_ ? b_ : a_; }
  { const float a_ = K[1], b_ = K[9]; const bool g_ = a_ > b_; K[1] = g_ ? a_ : b_; K[9] = g_ ? b_ : a_; }
  { const float a_ = K[2], b_ = K[10]; const bool g_ = a_ > b_; K[2] = g_ ? a_ : b_; K[10] = g_ ? b_ : a_; }
  { const float a_ = K[3], b_ = K[11]; const bool g_ = a_ > b_; K[3] = g_ ? a_ : b_; K[11] = g_ ? b_ : a_; }
  { const float a_ = K[4], b_ = K[12]; const bool g_ = a_ > b_; K[4] = g_ ? a_ : b_; K[12] = g_ ? b_ : a_; }
  { const float a_ = K[5], b_ = K[13]; const bool g_ = a_ > b_; K[5] = g_ ? a_ : b_; K[13] = g_ ? b_ : a_; }
  { const float a_ = K[6], b_ = K[14]; const bool g_ = a_ > b_; K[6] = g_ ? a_ : b_; K[14] = g_ ? b_ : a_; }
  { const float a_ = K[7], b_ = K[15]; const bool g_ = a_ > b_; K[7] = g_ ? a_ : b_; K[15] = g_ ? b_ : a_; }
  { const float a_ = K[0], b_ = K[4]; const bool g_ = a_ > b_; K[0] = g_ ? a_ : b_; K[4] = g_ ? b_ : a_; }
  { const float a_ = K[1], b_ = K[5]; const bool g_ = a_ > b_; K[1] = g_ ? a_ : b_; K[5] = g_ ? b_ : a_; }
  { const float a_ = K[2], b_ = K[6]; const bool g_ = a_ > b_; K[2] = g_ ? a_ : b_; K[6] = g_ ? b_ : a_; }
  { const float a_ = K[3], b_ = K[7]; const bool g_ = a_ > b_; K[3] = g_ ? a_ : b_; K[7] = g_ ? b_ : a_; }
  { const float a_ = K[8], b_ = K[12]; const bool g_ = a_ > b_; K[8] = g_ ? a_ : b_; K[12] = g_ ? b_ : a_; }
  { const float a_ = K[9], b_ = K[13]; const bool g_ = a_ > b_; K[9] = g_ ? a_ : b_; K[13] = g_ ? b_ : a_; }
  { const float a_ = K[10], b_ = K[14]; const bool g_ = a_ > b_; K[10] = g_ ? a_ : b_; K[14] = g_ ? b_ : a_; }
  { const float a_ = K[11], b_ = K[15]; const bool g_ = a_ > b_; K[11] = g_ ? a_ : b_; K[15] = g_ ? b_ : a_; }
  { const float a_ = K[0], b_ = K[2]; const bool g_ = a_ > b_; K[0] = g_ ? a_ : b_; K[2] = g_ ? b_ : a_; }
  { const float a_ = K[1], b_ = K[3]; const bool g_ = a_ > b_; K[1] = g_ ? a_ : b_; K[3] = g_ ? b_ : a_; }
  { const float a_ = K[4], b_ = K[6]; const bool g_ = a_ > b_; K[4] = g_ ? a_ : b_; K[6] = g_ ? b_ : a_; }
  { const float a_ = K[5], b_ = K[7]; const bool g_ = a_ > b_; K[5] = g_ ? a_ : b_; K[7] = g_ ? b_ : a_; }
  { const float a_ = K[8], b_ = K[10]; const bool g_ = a_ > b_; K[8] = g_ ? a_ : b_; K[10] = g_ ? b_ : a_; }
  { const float a_ = K[9], b_ = K[11]; const bool g_ = a_ > b_; K[9] = g_ ? a_ : b_; K[11] = g_ ? b_ : a_; }
  { const float a_ = K[12], b_ = K[14]; const bool g_ = a_ > b_; K[12] = g_ ? a_ : b_; K[14] = g_ ? b_ : a_; }
  { const float a_ = K[13], b_ = K[15]; const bool g_ = a_ > b_; K[13] = g_ ? a_ : b_; K[15] = g_ ? b_ : a_; }
  { const float a_ = K[0], b_ = K[1]; const bool g_ = a_ > b_; K[0] = g_ ? a_ : b_; K[1] = g_ ? b_ : a_; }
  { const float a_ = K[2], b_ = K[3]; const bool g_ = a_ > b_; K[2] = g_ ? a_ : b_; K[3] = g_ ? b_ : a_; }
  { const float a_ = K[4], b_ = K[5]; const bool g_ = a_ > b_; K[4] = g_ ? a_ : b_; K[5] = g_ ? b_ : a_; }
  { const float a_ = K[6], b_ = K[7]; const bool g_ = a_ > b_; K[6] = g_ ? a_ : b_; K[7] = g_ ? b_ : a_; }
  { const float a_ = K[8], b_ = K[9]; const bool g_ = a_ > b_; K[8] = g_ ? a_ : b_; K[9] = g_ ? b_ : a_; }
  { const float a_ = K[10], b_ = K[11]; const bool g_ = a_ > b_; K[10] = g_ ? a_ : b_; K[11] = g_ ? b_ : a_; }
  { const float a_ = K[12], b_ = K[13]; const bool g_ = a_ > b_; K[12] = g_ ? a_ : b_; K[13] = g_ ? b_ : a_; }
  { const float a_ = K[14], b_ = K[15]; const bool g_ = a_ > b_; K[14] = g_ ? a_ : b_; K[15] = g_ ? b_ : a_; }
}
__device__ __forceinline__ void merge_top16(float (&T)[16], const float (&P)[16]) {
  { const float a_ = T[0], b_ = P[15]; T[0] = a_ > b_ ? a_ : b_; }
  { const float a_ = T[1], b_ = P[14]; T[1] = a_ > b_ ? a_ : b_; }
  { const float a_ = T[2], b_ = P[13]; T[2] = a_ > b_ ? a_ : b_; }
  { const float a_ = T[3], b_ = P[12]; T[3] = a_ > b_ ? a_ : b_; }
  { const float a_ = T[4], b_ = P[11]; T[4] = a_ > b_ ? a_ : b_; }
  { const float a_ = T[5], b_ = P[10]; T[5] = a_ > b_ ? a_ : b_; }
  { const float a_ = T[6], b_ = P[9]; T[6] = a_ > b_ ? a_ : b_; }
  { const float a_ = T[7], b_ = P[8]; T[7] = a_ > b_ ? a_ : b_; }
  { const float a_ = T[8], b_ = P[7]; T[8] = a_ > b_ ? a_ : b_; }
  { const float a_ = T[9], b_ = P[6]; T[9] = a_ > b_ ? a_ : b_; }
  { const float a_ = T[10], b_ = P[5]; T[10] = a_ > b_ ? a_ : b_; }
  { const float a_ = T[11], b_ = P[4]; T[11] = a_ > b_ ? a_ : b_; }
  { const float a_ = T[12], b_ = P[3]; T[12] = a_ > b_ ? a_ : b_; }
  { const float a_ = T[13], b_ = P[2]; T[13] = a_ > b_ ? a_ : b_; }
  { const float a_ = T[14], b_ = P[1]; T[14] = a_ > b_ ? a_ : b_; }
  { const float a_ = T[15], b_ = P[0]; T[15] = a_ > b_ ? a_ : b_; }
  { const float a_ = T[0], b_ = T[8]; const bool g_ = a_ > b_; T[0] = g_ ? a_ : b_; T[8] = g_ ? b_ : a_; }
  { const float a_ = T[1], b_ = T[9]; const bool g_ = a_ > b_; T[1] = g_ ? a_ : b_; T[9] = g_ ? b_ : a_; }
  { const float a_ = T[2], b_ = T[10]; const bool g_ = a_ > b_; T[2] = g_ ? a_ : b_; T[10] = g_ ? b_ : a_; }
  { const float a_ = T[3], b_ = T[11]; const bool g_ = a_ > b_; T[3] = g_ ? a_ : b_; T[11] = g_ ? b_ : a_; }
  { const float a_ = T[4], b_ = T[12]; const bool g_ = a_ > b_; T[4] = g_ ? a_ : b_; T[12] = g_ ? b_ : a_; }
  { const float a_ = T[5], b_ = T[13]; const bool g_ = a_ > b_; T[5] = g_ ? a_ : b_; T[13] = g_ ? b_ : a_; }
  { const float a_ = T[6], b_ = T[14]; const bool g_ = a_ > b_; T[6] = g_ ? a_ : b_; T[14] = g_ ? b_ : a_; }
  { const float a_ = T[7], b_ = T[15]; const bool g_ = a_ > b_; T[7] = g_ ? a_ : b_; T[15] = g_ ? b_ : a_; }
  { const float a_ = T[0], b_ = T[4]; const bool g_ = a_ > b_; T[0] = g_ ? a_ : b_; T[4] = g_ ? b_ : a_; }
  { const float a_ = T[1], b_ = T[5]; const bool g_ = a_ > b_; T[1] = g_ ? a_ : b_; T[5] = g_ ? b_ : a_; }
  { const float a_ = T[2], b_ = T[6]; const bool g_ = a_ > b_; T[2] = g_ ? a_ : b_; T[6] = g_ ? b_ : a_; }
  { const float a_ = T[3], b_ = T[7]; const bool g_ = a_ > b_; T[3] = g_ ? a_ : b_; T[7] = g_ ? b_ : a_; }
  { const float a_ = T[8], b_ = T[12]; const bool g_ = a_ > b_; T[8] = g_ ? a_ : b_; T[12] = g_ ? b_ : a_; }
  { const float a_ = T[9], b_ = T[13]; const bool g_ = a_ > b_; T[9] = g_ ? a_ : b_; T[13] = g_ ? b_ : a_; }
  { const float a_ = T[10], b_ = T[14]; const bool g_ = a_ > b_; T[10] = g_ ? a_ : b_; T[14] = g_ ? b_ : a_; }
  { const float a_ = T[11], b_ = T[15]; const bool g_ = a_ > b_; T[11] = g_ ? a_ : b_; T[15] = g_ ? b_ : a_; }
  { const float a_ = T[0], b_ = T[2]; const bool g_ = a_ > b_; T[0] = g_ ? a_ : b_; T[2] = g_ ? b_ : a_; }
  { const float a_ = T[1], b_ = T[3]; const bool g_ = a_ > b_; T[1] = g_ ? a_ : b_; T[3] = g_ ? b_ : a_; }
  { const float a_ = T[4], b_ = T[6]; const bool g_ = a_ > b_; T[4] = g_ ? a_ : b_; T[6] = g_ ? b_ : a_; }
  { const float a_ = T[5], b_ = T[7]; const bool g_ = a_ > b_; T[5] = g_ ? a_ : b_; T[7] = g_ ? b_ : a_; }
  { const float a_ = T[8], b_ = T[10]; const bool g_ = a_ > b_; T[8] = g_ ? a_ : b_; T[10] = g_ ? b_ : a_; }
  { const float a_ = T[9], b_ = T[11]; const bool g_ = a_ > b_; T[9] = g_ ? a_ : b_; T[11] = g_ ? b_ : a_; }
  { const float a_ = T[12], b_ = T[14]; const bool g_ = a_ > b_; T[12] = g_ ? a_ : b_; T[14] = g_ ? b_ : a_; }
  { const float a_ = T[13], b_ = T[15]; const bool g_ = a_ > b_; T[13] = g_ ? a_ : b_; T[15] = g_ ? b_ : a_; }
  { const float a_ = T[0], b_ = T[1]; const bool g_ = a_ > b_; T[0] = g_ ? a_ : b_; T[1] = g_ ? b_ : a_; }
  { const float a_ = T[2], b_ = T[3]; const bool g_ = a_ > b_; T[2] = g_ ? a_ : b_; T[3] = g_ ? b_ : a_; }
  { const float a_ = T[4], b_ = T[5]; const bool g_ = a_ > b_; T[4] = g_ ? a_ : b_; T[5] = g_ ? b_ : a_; }
  { const float a_ = T[6], b_ = T[7]; const bool g_ = a_ > b_; T[6] = g_ ? a_ : b_; T[7] = g_ ? b_ : a_; }
  { const float a_ = T[8], b_ = T[9]; const bool g_ = a_ > b_; T[8] = g_ ? a_ : b_; T[9] = g_ ? b_ : a_; }
  { const float a_ = T[10], b_ = T[11]; const bool g_ = a_ > b_; T[10] = g_ ? a_ : b_; T[11] = g_ ? b_ : a_; }
  { const float a_ = T[12], b_ = T[13]; const bool g_ = a_ > b_; T[12] = g_ ? a_ : b_; T[13] = g_ ? b_ : a_; }
  { const float a_ = T[14], b_ = T[15]; const bool g_ = a_ > b_; T[14] = g_ ? a_ : b_; T[15] = g_ ? b_ : a_; }
}

__device__ __forceinline__ void peer_topk(const int wave_s, const bf16* pq, const bf16* skb, int* ids, float* gates, LAS float* smem) {
  const int tid_ = opaque_tid(wave_s);
  const int lane = tid_ & 63, n = lane & 31, hh = lane >> 5, wave = tid_ >> 6;
  const int gw = blockIdx.x * NWAVES + wave;
  const int nw = gridDim.x * NWAVES;
  LAS float* lk = smem + wave * 2048;
  for (int it = gw; it < 512 * 8; it += nw) {
    const int h = it & 7, tok0 = (it >> 3) * 32;
#pragma unroll 1
    for (int half = 0; half < 2; half++) {
      bf16x8_t qf[8];
      {
        const bf16* qrow = pq + (size_t)(tok0 + n) * 2048 + h * 256 + half * 128 + 8 * hh;
#pragma unroll
        for (int ks = 0; ks < 8; ks++) qf[ks] = *(const bf16x8_t*)(qrow + 16 * ks);
      }
      float K[64];
#pragma unroll
      for (int kt = 0; kt < 4; kt++) {
        const bf16* krow = skb + ((size_t)((h * 2 + half) * 128 + kt * 32 + n)) * 128 + 8 * hh;
        f32x16_t acc;
#pragma unroll
        for (int r = 0; r < 16; r++) acc[r] = 0.f;
#pragma unroll
        for (int kq = 0; kq < 2; kq++) {
          bf16x8_t kf[4];
#pragma unroll
          for (int i = 0; i < 4; i++) kf[i] = *(const bf16x8_t*)(krow + 16 * (kq * 4 + i));
          MFMA_PAD();
#pragma unroll
          for (int i = 0; i < 4; i++) acc = __builtin_amdgcn_mfma_f32_32x32x16_bf16(kf[i], qf[kq * 4 + i], acc, 0, 0, 0);
          MFMA_PAD();
        }
#pragma unroll
        for (int i = 0; i < 16; i++) K[kt * 16 + i] = pack_key<0x7Fu>(acc[i], (unsigned)(kt * 32 + (i & 3) + 8 * (i >> 2) + 4 * hh));
      }
      __builtin_amdgcn_sched_barrier(0);
      top16_of_64(K);
      __builtin_amdgcn_sched_barrier(0);
      float T[16], P[16];
#pragma unroll
      for (int i = 0; i < 16; i++) { T[i] = K[i]; P[i] = __shfl_xor(K[i], 32, 64); }
      merge_top16(T, P);
#pragma unroll
      for (int i = 0; i < 16; i++) lk[(half * 16 + i) * 64 + lane] = T[i];
      __builtin_amdgcn_sched_barrier(0);
    }
    float f0[16], f1[16];
    int ti0[16], ti1[16];
#pragma unroll
    for (int i = 0; i < 16; i++) {
      const float k0 = lk[i * 64 + lane], k1 = lk[(16 + i) * 64 + lane];
      f0[i] = key_val<0x7Fu>(k0); ti0[i] = (int)key_idx<0x7Fu>(k0);
      f1[i] = key_val<0x7Fu>(k1); ti1[i] = (int)key_idx<0x7Fu>(k1);
    }
    float K[64];
    {
    K[0] = pack_key<0xFFu>(f0[0] + f1[0], 0u);
    K[1] = pack_key<0xFFu>(f0[0] + f1[1], 1u);
    K[2] = pack_key<0xFFu>(f0[0] + f1[2], 2u);
    K[3] = pack_key<0xFFu>(f0[0] + f1[3], 3u);
    K[4] = pack_key<0xFFu>(f0[0] + f1[4], 4u);
    K[5] = pack_key<0xFFu>(f0[0] + f1[5], 5u);
    K[6] = pack_key<0xFFu>(f0[0] + f1[6], 6u);
    K[7] = pack_key<0xFFu>(f0[0] + f1[7], 7u);
    K[8] = pack_key<0xFFu>(f0[0] + f1[8], 8u);
    K[9] = pack_key<0xFFu>(f0[0] + f1[9], 9u);
    K[10] = pack_key<0xFFu>(f0[0] + f1[10], 10u);
    K[11] = pack_key<0xFFu>(f0[0] + f1[11], 11u);
    K[12] = pack_key<0xFFu>(f0[0] + f1[12], 12u);
    K[13] = pack_key<0xFFu>(f0[0] + f1[13], 13u);
    K[14] = pack_key<0xFFu>(f0[0] + f1[14], 14u);
    K[15] = pack_key<0xFFu>(f0[0] + f1[15], 15u);
    K[16] = pack_key<0xFFu>(f0[1] + f1[0], 16u);
    K[17] = pack_key<0xFFu>(f0[1] + f1[1], 17u);
    K[18] = pack_key<0xFFu>(f0[1] + f1[2], 18u);
    K[19] = pack_key<0xFFu>(f0[1] + f1[3], 19u);
    K[20] = pack_key<0xFFu>(f0[1] + f1[4], 20u);
    K[21] = pack_key<0xFFu>(f0[1] + f1[5], 21u);
    K[22] = pack_key<0xFFu>(f0[1] + f1[6], 22u);
    K[23] = pack_key<0xFFu>(f0[1] + f1[7], 23u);
    K[24] = pack_key<0xFFu>(f0[2] + f1[0], 32u);
    K[25] = pack_key<0xFFu>(f0[2] + f1[1], 33u);
    K[26] = pack_key<0xFFu>(f0[2] + f1[2], 34u);
    K[27] = pack_key<0xFFu>(f0[2] + f1[3], 35u);
    K[28] = pack_key<0xFFu>(f0[2] + f1[4], 36u);
    K[29] = pack_key<0xFFu>(f0[3] + f1[0], 48u);
    K[30] = pack_key<0xFFu>(f0[3] + f1[1], 49u);
    K[31] = pack_key<0xFFu>(f0[3] + f1[2], 50u);
    K[32] = pack_key<0xFFu>(f0[3] + f1[3], 51u);
    K[33] = pack_key<0xFFu>(f0[4] + f1[0], 64u);
    K[34] = pack_key<0xFFu>(f0[4] + f1[1], 65u);
    K[35] = pack_key<0xFFu>(f0[4] + f1[2], 66u);
    K[36] = pack_key<0xFFu>(f0[5] + f1[0], 80u);
    K[37] = pack_key<0xFFu>(f0[5] + f1[1], 81u);
    K[38] = pack_key<0xFFu>(f0[6] + f1[0], 96u);
    K[39] = pack_key<0xFFu>(f0[6] + f1[1], 97u);
    K[40] = pack_key<0xFFu>(f0[7] + f1[0], 112u);
    K[41] = pack_key<0xFFu>(f0[7] + f1[1], 113u);
    K[42] = pack_key<0xFFu>(f0[8] + f1[0], 128u);
    K[43] = pack_key<0xFFu>(f0[9] + f1[0], 144u);
    K[44] = pack_key<0xFFu>(f0[10] + f1[0], 160u);
    K[45] = pack_key<0xFFu>(f0[11] + f1[0], 176u);
    K[46] = pack_key<0xFFu>(f0[12] + f1[0], 192u);
    K[47] = pack_key<0xFFu>(f0[13] + f1[0], 208u);
    K[48] = pack_key<0xFFu>(f0[14] + f1[0], 224u);
    K[49] = pack_key<0xFFu>(f0[15] + f1[0], 240u);
    K[50] = -3.0e38f;
    K[51] = -3.0e38f;
    K[52] = -3.0e38f;
    K[53] = -3.0e38f;
    K[54] = -3.0e38f;
    K[55] = -3.0e38f;
    K[56] = -3.0e38f;
    K[57] = -3.0e38f;
    K[58] = -3.0e38f;
    K[59] = -3.0e38f;
    K[60] = -3.0e38f;
    K[61] = -3.0e38f;
    K[62] = -3.0e38f;
    K[63] = -3.0e38f;
    }
    __builtin_amdgcn_sched_barrier(0);
    top16_of_64(K);
    __builtin_amdgcn_sched_barrier(0);
    float bv[16];
    int be[16];
#pragma unroll
    for (int r = 0; r < 16; r++) {
      const int flat = (int)key_idx<0xFFu>(K[r]);
      const int a = flat >> 4, b = flat & 15;
      int i0 = 0, i1 = 0;
#pragma unroll
      for (int i = 0; i < 16; i++) { i0 = (a == i) ? ti0[i] : i0; i1 = (b == i) ? ti1[i] : i1; }
      be[r] = i0 * 128 + i1;
      bv[r] = key_val<0xFFu>(K[r]);
    }
    const float b0 = bv[0];
    float ge[16];
    float gsum = 0.f;
#pragma unroll
    for (int r = 0; r < 16; r++) { ge[r] = __expf(bv[r] - b0); gsum += ge[r]; }
    const float ginv = 1.0f / gsum;
    if (hh == 0) {
      int* ip = ids + (size_t)(tok0 + n) * 128 + h * 16;
      float* gp = gates + (size_t)(tok0 + n) * 128 + h * 16;
#pragma unroll
      for (int r4 = 0; r4 < 4; r4++) {
        *(int4*)(ip + 4 * r4) = make_int4(be[4 * r4], be[4 * r4 + 1], be[4 * r4 + 2], be[4 * r4 + 3]);
        *(float4*)(gp + 4 * r4) = make_float4(ge[4 * r4] * ginv, ge[4 * r4 + 1] * ginv, ge[4 * r4 + 2] * ginv, ge[4 * r4 + 3] * ginv);
      }
    }
  }
}

typedef _Float16 f16x2_t __attribute__((ext_vector_type(2)));
__device__ __forceinline__ unsigned e4m3x2_to_f16x2(unsigned w, unsigned sel) {
  return __builtin_amdgcn_perm(w, w, sel);
}
__device__ __forceinline__ float dot2h(unsigned a, unsigned b, float c) {
  return __builtin_amdgcn_fdot2(__builtin_bit_cast(f16x2_t, a), __builtin_bit_cast(f16x2_t, b), c, false);
}
__device__ __forceinline__ unsigned pack_h2(float lo, float hi) {
  f16x2_t v; v.x = (_Float16)lo; v.y = (_Float16)hi;
  return __builtin_bit_cast(unsigned, v);
}
template <bool FINAL>
__device__ __forceinline__ void peer_gather(const int wave_s, bf16* xn, const float* rst, const unsigned char* ub, const unsigned char* vb, const float* vsc, const float* usc,
                                            const int* ids, const float* gates, float* xw, const float* gnext, float* outp) {
  const int tid_ = opaque_tid(wave_s);
  const int lane = tid_ & 63;
  const int gw = blockIdx.x * NWAVES + (tid_ >> 6);
  const int nw = gridDim.x * NWAVES;
  const int el = ((lane >> 5) & 1) * 8 + ((lane >> 4) & 1) * 4 + ((lane >> 3) & 1) * 2 + ((lane >> 2) & 1);
  int idv = 0;
  uint2 uu[16];
  uint2 vv[16];
  if (gw < NT) {
    idv = ids[(size_t)gw * 128 + (lane & 15)];
#pragma unroll
    for (int e = 0; e < 16; e++) {
      const int id = __builtin_amdgcn_readlane(idv, e);
      uu[e] = *(const uint2*)(ub + (size_t)id * 512 + lane * 8);
      vv[e] = *(const uint2*)(vb + (size_t)id * 512 + lane * 8);
    }
  }
  for (int tok = gw; tok < NT; tok += nw) {
    const int tokn = (tok + nw < NT) ? tok + nw : tok;
    int xqh[2] = {0, 0}, xql[2] = {0, 0};
    float xstep, qhalf;
    {
      const uint4 a = *(const uint4*)(xn + (size_t)tok * DM + lane * 16);
      const uint4 b = *(const uint4*)(xn + (size_t)tok * DM + lane * 16 + 8);
      const unsigned xw_[8] = {a.x, a.y, a.z, a.w, b.x, b.y, b.z, b.w};
      const float4* sp = (const float4*)(rst + (size_t)tok * 16);
      const float4 s0 = sp[0], s1 = sp[1], s2 = sp[2], s3 = sp[3];
      const float xs = rsqrtf((((s0.x + s0.y) + (s0.z + s0.w)) + ((s1.x + s1.y) + (s1.z + s1.w)) + ((s2.x + s2.y) + (s2.z + s2.w)) + ((s3.x + s3.y) + (s3.z + s3.w))) * (1.0f / 1024.f) + EPSF);
      float xf[16];
      float am = 0.f;
#pragma unroll
      for (int k = 0; k < 8; k++) { xf[2 * k] = bf_lo(xw_[k]) * xs; xf[2 * k + 1] = bf_hi(xw_[k]) * xs; am = fmaxf(am, fmaxf(fabsf(xf[2 * k]), fabsf(xf[2 * k + 1]))); }
#pragma unroll
      for (int o = 32; o >= 1; o >>= 1) am = fmaxf(am, __shfl_xor(am, o, 64));
      xstep = am * (1.0f / 119.f);
      const float inv = am > 0.f ? 119.f / am : 0.f;
      int qs = 0;
#pragma unroll
      for (int i = 0; i < 16; i++) {
        const int q = (int)rintf(xf[i] * inv);
        const int t = q + 8;
        xqh[i >> 3] |= ((t >> 4) & 15) << (4 * (i & 7));
        xql[i >> 3] |= (((t & 15) - 8) & 15) << (4 * (i & 7));
        qs += q;
      }
      qhalf = 0.5f * wsum((float)qs);
    }
    f16x2_t acc2[8];
#pragma unroll
    for (int i = 0; i < 8; i++) acc2[i] = (f16x2_t){(_Float16)0.f, (_Float16)0.f};
#pragma unroll 1
    for (int g = 0; g < 8; g++) {
      const int ide = __builtin_amdgcn_ds_bpermute(el << 2, idv);
      const float2 sc2 = ((const float2*)vsc)[ide];
      const float gv = gates[(size_t)tok * 128 + g * 16 + el] * sc2.x;
      const float us = sc2.y * xstep;
      const int idn = ids[(size_t)(g < 7 ? tok : tokn) * 128 + ((g + 1) & 7) * 16 + (lane & 15)];
      float d[16];
#pragma unroll
      for (int e = 0; e < 16; e++) {
        int sh = __builtin_amdgcn_sdot8((int)uu[e].x, xqh[0], 0, false);
        sh = __builtin_amdgcn_sdot8((int)uu[e].y, xqh[1], sh, false);
        int sl = __builtin_amdgcn_sdot8((int)uu[e].x, xql[0], 0, false);
        sl = __builtin_amdgcn_sdot8((int)uu[e].y, xql[1], sl, false);
        d[e] = (float)((sh << 4) + sl);
      }
#pragma unroll
      for (int e = 0; e < 16; e++) {
        const int id = __builtin_amdgcn_readlane(idn, e);
        uu[e] = *(const uint2*)(ub + (size_t)id * 512 + lane * 8);
      }
      float d8[8], d4[4], d2[2], d1;
      {
        const bool hi = (lane & 32) != 0;
#pragma unroll
        for (int i = 0; i < 8; i++) { const float send = hi ? d[i] : d[i + 8]; const float keep = hi ? d[i + 8] : d[i]; d8[i] = keep + __shfl_xor(send, 32, 64); }
      }
      {
        const bool hi = (lane & 16) != 0;
#pragma unroll
        for (int i = 0; i < 4; i++) { const float send = hi ? d8[i] : d8[i + 4]; const float keep = hi ? d8[i + 4] : d8[i]; d4[i] = keep + __shfl_xor(send, 16, 64); }
      }
      {
        const bool hi = (lane & 8) != 0;
#pragma unroll
        for (int i = 0; i < 2; i++) { const float send = hi ? d4[i] : d4[i + 2]; const float keep = hi ? d4[i + 2] : d4[i]; d2[i] = keep + __shfl_xor(send, 8, 64); }
      }
      {
        const bool hi = (lane & 4) != 0;
        const float send = hi ? d2[0] : d2[1];
        const float keep = hi ? d2[1] : d2[0];
        d1 = keep + __shfl_xor(send, 4, 64);
      }
      d1 += __shfl_xor(d1, 2, 64);
      d1 += __shfl_xor(d1, 1, 64);
      const float wl = gv * gelu_tanh((d1 + qhalf) * us);
#pragma unroll
      for (int e = 0; e < 16; e++) {
        const float w = __builtin_bit_cast(float, __builtin_amdgcn_readlane(__builtin_bit_cast(int, wl), ((e >> 3) & 1) * 32 + ((e >> 2) & 1) * 16 + ((e >> 1) & 1) * 8 + (e & 1) * 4));
        const f16x2_t w2 = __builtin_bit_cast(f16x2_t, pack_h2(w, w));
        const unsigned vw[2] = {vv[e].x, vv[e].y};
#pragma unroll
        for (int k = 0; k < 2; k++) {
          const unsigned w4 = vw[k];
          const unsigned le = __builtin_amdgcn_perm(V4_LUT_HI, V4_LUT_LO, w4 & 0x07070707u);
          const unsigned lo = __builtin_amdgcn_perm(V4_LUT_HI, V4_LUT_LO, (w4 >> 4) & 0x07070707u);
          const unsigned ee = ((w4 << 4) & 0x80808080u) | le;
          const unsigned eo = (w4 & 0x80808080u) | lo;
          const unsigned p01 = __builtin_amdgcn_perm(eo, ee, 0x040c000cu), p23 = __builtin_amdgcn_perm(eo, ee, 0x050c010cu);
          const unsigned p45 = __builtin_amdgcn_perm(eo, ee, 0x060c020cu), p67 = __builtin_amdgcn_perm(eo, ee, 0x070c030cu);
          acc2[4 * k + 0] = __builtin_elementwise_fma(__builtin_bit_cast(f16x2_t, p01), w2, acc2[4 * k + 0]);
          acc2[4 * k + 1] = __builtin_elementwise_fma(__builtin_bit_cast(f16x2_t, p23), w2, acc2[4 * k + 1]);
          acc2[4 * k + 2] = __builtin_elementwise_fma(__builtin_bit_cast(f16x2_t, p45), w2, acc2[4 * k + 2]);
          acc2[4 * k + 3] = __builtin_elementwise_fma(__builtin_bit_cast(f16x2_t, p67), w2, acc2[4 * k + 3]);
        }
      }
#pragma unroll
      for (int e = 0; e < 16; e++) {
        const int id = __builtin_amdgcn_readlane(idn, e);
        vv[e] = *(const uint2*)(vb + (size_t)id * 512 + lane * 8);
      }
      idv = idn;
    }
    float acc[16];
#pragma unroll
    for (int i = 0; i < 8; i++) { acc[2 * i] = (float)acc2[i].x; acc[2 * i + 1] = (float)acc2[i].y; }
    float* xr = xw + (size_t)tok * DM + lane * 16;
    float xv[16];
    float ssq = 0.f;
#pragma unroll
    for (int c = 0; c < 4; c++) {
      float4 a0 = *(float4*)(xr + c * 4);
      a0.x += acc[c * 4 + 0]; a0.y += acc[c * 4 + 1]; a0.z += acc[c * 4 + 2]; a0.w += acc[c * 4 + 3];
      if (!FINAL) *(float4*)(xr + c * 4) = a0;
      xv[c * 4 + 0] = a0.x; xv[c * 4 + 1] = a0.y; xv[c * 4 + 2] = a0.z; xv[c * 4 + 3] = a0.w;
      ssq += a0.x * a0.x + a0.y * a0.y + a0.z * a0.z + a0.w * a0.w;
    }
    ssq = wsum(ssq);
    const float rstd = rsqrtf(ssq * (1.0f / DM) + EPSF);
    const float4* g4 = (const float4*)(gnext + lane * 16);
    if (FINAL) {
      float* op = outp + (size_t)tok * DM + lane * 16;
#pragma unroll
      for (int c = 0; c < 4; c++) {
        const float4 gq = g4[c];
        *(float4*)(op + c * 4) = make_float4(xv[c * 4] * rstd * gq.x, xv[c * 4 + 1] * rstd * gq.y, xv[c * 4 + 2] * rstd * gq.z, xv[c * 4 + 3] * rstd * gq.w);
      }
    } else {
      uint4 o0, o1;
      { const float4 ga = g4[0], gb = g4[1];
        o0.x = pk2(xv[0] * rstd * ga.x, xv[1] * rstd * ga.y); o0.y = pk2(xv[2] * rstd * ga.z, xv[3] * rstd * ga.w);
        o0.z = pk2(xv[4] * rstd * gb.x, xv[5] * rstd * gb.y); o0.w = pk2(xv[6] * rstd * gb.z, xv[7] * rstd * gb.w); }
      { const float4 ga = g4[2], gb = g4[3];
        o1.x = pk2(xv[8] * rstd * ga.x, xv[9] * rstd * ga.y); o1.y = pk2(xv[10] * rstd * ga.z, xv[11] * rstd * ga.w);
        o1.z = pk2(xv[12] * rstd * gb.x, xv[13] * rstd * gb.y); o1.w = pk2(xv[14] * rstd * gb.z, xv[15] * rstd * gb.w); }
      *(uint4*)(xn + (size_t)tok * DM + lane * 16) = o0;
      *(uint4*)(xn + (size_t)tok * DM + lane * 16 + 8) = o1;
    }
  }
}

__device__ __forceinline__ void prologue_transposes(const int wave_s, const Params& p, unsigned char* ws, LAS unsigned char* lds) {
  const int tid_ = opaque_tid(wave_s);
  const int lane = tid_ & 63, wave = tid_ >> 6;
  LAS float* scr = (LAS float*)(lds + wave * 16384);
  const int gw = blockIdx.x * NWAVES + wave, NGW = gridDim.x * NWAVES;
  constexpr int I_IN = (DM / 64) * (DIN / 32), I_SQ = (DM / 64) * (DM / 32), I_2K = (DM / 64) * (2048 / 32);
  constexpr int I_GL = (256 / 64) * (256 / 32);
  constexpr int PER_LAYER = I_IN + 3 * I_SQ + 2 * I_2K + I_GL;
  const float* w3 = karg_in(3); const float* w19 = karg_in(19); const float* w22 = karg_in(22);
  const float* w23 = karg_in(23); const float* w24 = karg_in(24); const float* w26 = karg_in(26);
  const float* w16 = karg_in(16);
  for (int it = gw; it < 2 * PER_LAYER; it += NGW) {
    const int l = it / PER_LAYER;
    int r = it % PER_LAYER;
    unsigned char* wl = ws + WS_WT + (size_t)l * WT_LAYER;
    if (r < I_IN) { transpose_item(w3 + (size_t)l * DM * DIN, DM, DIN, (bf16*)(wl + WT_IN), scr, r, lane); continue; } r -= I_IN;
    if (r < I_SQ) { transpose_item(w19 + (size_t)l * DM * DM, DM, DM, (bf16*)(wl + WT_OUT), scr, r, lane); continue; } r -= I_SQ;
    if (r < I_SQ) { transpose_item(w22 + (size_t)l * DM * DM, DM, DM, (bf16*)(wl + WT_MQ), scr, r, lane); continue; } r -= I_SQ;
    if (r < I_2K) { transpose_item(w23 + (size_t)l * DM * 2048, DM, 2048, (bf16*)(wl + WT_MKV), scr, r, lane); continue; } r -= I_2K;
    if (r < I_SQ) { transpose_item(w24 + (size_t)l * DM * DM, DM, DM, (bf16*)(wl + WT_MO), scr, r, lane); continue; } r -= I_SQ;
    if (r < I_2K) { transpose_item(w26 + (size_t)l * DM * 2048, DM, 2048, (bf16*)(wl + WT_PQ), scr, r, lane); continue; } r -= I_2K;
    transpose_item(w16 + (size_t)l * 256 * 256, 256, 256, (bf16*)(wl + WT_GLU), scr, r, lane);
  }
}

template <class T> __device__ __forceinline__ T* opq(T* p) { asm volatile("" : "+s"(p)); return p; }
__device__ __forceinline__ void cvt_rows_bf16(const int wave_s, const float* src, bf16* dst, size_t n) {
  const int tid_ = opaque_tid(wave_s);
  const size_t gt = (size_t)blockIdx.x * (NWAVES * 64) + tid_;
  const size_t nth = (size_t)gridDim.x * NWAVES * 64;
  for (size_t i = gt; i < n / 8; i += nth) {
    const float4 a = ((const float4*)src)[2 * i], b = ((const float4*)src)[2 * i + 1];
    uint4 o; o.x = pk2(a.x, a.y); o.y = pk2(a.z, a.w); o.z = pk2(b.x, b.y); o.w = pk2(b.z, b.w);
    ((uint4*)dst)[i] = o;
  }
}

__device__ __forceinline__ unsigned enc_e4m3(float x) {
  const _Float16 hf = (_Float16)x;
  const unsigned h = (unsigned)__builtin_bit_cast(unsigned short, hf);
  return ((h + 0x7Fu + ((h >> 8) & 1u)) >> 8) & 0xFFu;
}
__device__ __forceinline__ void cvt_rows_e4m3(const int wave_s, const float* src, unsigned char* dst, size_t n, float sc) {
  const int tid_ = opaque_tid(wave_s);
  const size_t gt = (size_t)blockIdx.x * (NWAVES * 64) + tid_;
  const size_t nth = (size_t)gridDim.x * NWAVES * 64;
  for (size_t i = gt; i < n / 16; i += nth) {
    unsigned w[4];
#pragma unroll
    for (int k = 0; k < 4; k++) {
      const float4 a = ((const float4*)src)[4 * i + k];
      w[k] = enc_e4m3(a.x * sc) | (enc_e4m3(a.y * sc) << 8) | (enc_e4m3(a.z * sc) << 16) | (enc_e4m3(a.w * sc) << 24);
    }
    uint4 o; o.x = w[0]; o.y = w[1]; o.z = w[2]; o.w = w[3];
    ((uint4*)dst)[i] = o;
  }
}

__device__ __forceinline__ unsigned enc_v4(float z) {
  const float az = fabsf(z);
  unsigned c = 0;
  c += az > 0.25f; c += az > 0.5f; c += az > 0.75f; c += az > 1.0625f; c += az > 1.375f; c += az > 1.75f; c += az > 2.25f;
  return c | ((__builtin_bit_cast(unsigned, z) >> 28) & 8u);
}
__device__ __forceinline__ void cvt_rows_i4(const int wave_s, const float* src, unsigned char* dst, float* sc_out, int nrows) {
  const int tid_ = opaque_tid(wave_s);
  const int lane = tid_ & 63;
  const int gw = blockIdx.x * NWAVES + (tid_ >> 6);
  const int nw = gridDim.x * NWAVES;
  for (int r = gw; r < nrows; r += nw) {
    const float4* sp = (const float4*)(src + (size_t)r * 1024 + lane * 16);
    const float4 a0 = sp[0], a1 = sp[1], a2 = sp[2], a3 = sp[3];
    const float xv[16] = {a0.x, a0.y, a0.z, a0.w, a1.x, a1.y, a1.z, a1.w, a2.x, a2.y, a2.z, a2.w, a3.x, a3.y, a3.z, a3.w};
    float ss = 0.f;
#pragma unroll
    for (int i = 0; i < 16; i++) ss += xv[i] * xv[i];
    ss = wsum(ss);
    const float sc = sqrtf(ss * (1.0f / 1024.f)) * U4_STEP;
    const float inv = sc > 0.f ? 1.0f / sc : 0.f;
    unsigned w[2] = {0u, 0u};
#pragma unroll
    for (int i = 0; i < 16; i++) {
      const float f = fminf(fmaxf(floorf(xv[i] * inv), -8.f), 7.f);
      w[i >> 3] |= ((unsigned)(int)f & 15u) << (4 * (i & 7));
    }
    uint2 o; o.x = w[0]; o.y = w[1];
    *(uint2*)(dst + (size_t)r * 512 + lane * 8) = o;
    if (lane == 0) sc_out[2 * r] = sc;
  }
}
__device__ __forceinline__ void cvt_rows_v4(const int wave_s, const float* src, unsigned char* dst, float* sc_out, int nrows) {
  const int tid_ = opaque_tid(wave_s);
  const int lane = tid_ & 63;
  const int gw = blockIdx.x * NWAVES + (tid_ >> 6);
  const int nw = gridDim.x * NWAVES;
  for (int r = gw; r < nrows; r += nw) {
    const float4* sp = (const float4*)(src + (size_t)r * 1024 + lane * 16);
    const float4 a0 = sp[0], a1 = sp[1], a2 = sp[2], a3 = sp[3];
    const float xv[16] = {a0.x, a0.y, a0.z, a0.w, a1.x, a1.y, a1.z, a1.w, a2.x, a2.y, a2.z, a2.w, a3.x, a3.y, a3.z, a3.w};
    float ss = 0.f;
#pragma unroll
    for (int i = 0; i < 16; i++) ss += xv[i] * xv[i];
    ss = wsum(ss);
    const float sc = sqrtf(ss * (1.0f / 1024.f)) * V4_ROWSCALE;
    const float inv = sc > 0.f ? 1.0f / sc : 0.f;
    unsigned w[2] = {0u, 0u};
#pragma unroll
    for (int i = 0; i < 16; i++) w[i >> 3] |= enc_v4(xv[i] * inv) << (4 * (i & 7));
    uint2 o; o.x = w[0]; o.y = w[1];
    *(uint2*)(dst + (size_t)r * 512 + lane * 8) = o;
    if (lane == 0) sc_out[2 * r] = sc;
  }
}

#define GEMM_F32(Aptr, Wt, Cptr, Rptr, M_, N_) do { \
    pg8::Gemm g_{opq((const bf16*)(Aptr)), opq((const bf16*)(Wt)), (M_), (N_), DM}; pg8::StaticOrder S_; S_.init((M_), (N_), (int)gridDim.x, (int)blockIdx.x); \
    pg8::EpiF32R E_{opq((float*)(Cptr)), opq((const float*)(Rptr)), (N_)}; \
    pg8::gemm_phase<pg8::EpiF32R, pg8::StaticOrder, true, true>(wave_s, ldsl, g_, S_, E_); } while (0)
#define GEMM_BF16_C(Aptr, Wt, Optr, M_, N_, C_) do { \
    pg8::Gemm g_{opq((const bf16*)(Aptr)), opq((const bf16*)(Wt)), (M_), (N_), DM}; pg8::StaticOrder S_; S_.init((M_), (N_), (int)gridDim.x, (C_)); \
    pg8::EpiBf16 E_{opq((bf16*)(Optr)), (N_)}; \
    pg8::gemm_phase<pg8::EpiBf16, pg8::StaticOrder, true, true>(wave_s, ldsl, g_, S_, E_); } while (0)
#define GEMM_BF16(Aptr, Wt, Optr, M_, N_) GEMM_BF16_C(Aptr, Wt, Optr, M_, N_, (int)blockIdx.x)
#define GEMM_F32RN(Aptr, Wt, Cptr, Rptr, XGptr, Gptr, STptr) do { \
    pg8::Gemm g_{opq((const bf16*)(Aptr)), opq((const bf16*)(Wt)), NT, DM, DM}; pg8::StaticOrder S_; S_.init(NT, DM, (int)gridDim.x, (int)blockIdx.x); \
    pg8::EpiF32RN E_{opq((float*)(Cptr)), opq((const float*)(Rptr)), DM, opq((bf16*)(XGptr)), opq((const float*)(Gptr)), opq((float*)(STptr))}; \
    pg8::gemm_phase<pg8::EpiF32RN, pg8::StaticOrder, true, true>(wave_s, ldsl, g_, S_, E_); } while (0)
#define GEMM_BF16S(Aptr, Wt, Optr, N_, STptr) do { \
    pg8::Gemm g_{opq((const bf16*)(Aptr)), opq((const bf16*)(Wt)), NT, (N_), DM}; pg8::StaticOrder S_; S_.init(NT, (N_), (int)gridDim.x, (int)blockIdx.x); \
    pg8::EpiBf16S E_{opq((bf16*)(Optr)), (N_), opq((const float*)(STptr))}; \
    pg8::gemm_phase<pg8::EpiBf16S, pg8::StaticOrder, true, true>(wave_s, ldsl, g_, S_, E_); } while (0)

__global__ void __launch_bounds__(NWAVES * 64, 2) fwd_megakernel(Params p) {
  extern __shared__ __attribute__((aligned(16))) unsigned char lds[];
  LAS unsigned char* ldsl = (LAS unsigned char*)lds;
  LAS float* smem = (LAS float*)ldsl;
  const int wave_s = __builtin_amdgcn_readfirstlane((int)(threadIdx.x >> 6));
  unsigned char* ws = p.ws;
  volatile LAS unsigned* MISC = (volatile LAS unsigned*)(ldsl + (LDS_BYTES - 256));
  if (threadIdx.x < 64) MISC[threadIdx.x] = 0u;
  __syncthreads();
  const XcdBarrier bar = xcd_barrier_post((unsigned*)(ws + WS_CTL) + 4096, MISC + 8);
  float* xw = (float*)(ws + WS_XW);
  bf16* xn = (bf16*)(ws + WS_XN);
  bf16* big = (bf16*)(ws + WS_BIG);
  bf16* y = (bf16*)(ws + WS_Y);
  bf16* memh = (bf16*)(ws + WS_MEMH);
  bf16* kvb = (bf16*)(ws + WS_KVB);
  bf16* vT = (bf16*)(ws + WS_VT);
  float* ssmE = (float*)(ws + WS_SSME);
  float* ssmp = (float*)(ws + WS_SSMP);
  int* ids = (int*)(ws + WS_IDS);
  float* gates = (float*)(ws + WS_GATE);
  bf16* skb = (bf16*)(ws + WS_SKB);
  unsigned char* ub = ws + WS_UB;
  unsigned char* vb = ws + WS_VB;
  float* rst = (float*)(ws + WS_RST);
  float* vsc = (float*)(ws + WS_VSC);
  float* usc = (float*)(ws + WS_USC);

  prologue_transposes(wave_s, p, ws, ldsl);
  cvt_rows_bf16(wave_s, karg_in(27), skb, (size_t)2 * 8 * 2 * 128 * 128);
  cvt_rows_i4(wave_s, karg_in(28), ub, vsc + 1, 2 * 16384);
  cvt_rows_v4(wave_s, karg_in(29), vb, vsc, 2 * 16384);
  for (int l = 0; l < 2; l++)
    rms_rows<true>(wave_s, karg_in(1), karg_in(21) + l * DM, memh + (size_t)l * 1024 * 1024, 1024);
  ssm_params(wave_s, p, ssmp);
  xcd_barrier(bar);
  rms_rows<true>(wave_s, karg_in(0), karg_in(2), xn, NT);
  xcd_barrier(bar);
  for (int l = 0; l < 2; l++)
    GEMM_BF16_C(memh + (size_t)l * 1024 * 1024, ws + WS_WT + (size_t)l * WT_LAYER + WT_MKV,
              kvb + (size_t)l * 1024 * 2048, 1024, 2048, (int)((blockIdx.x + gridDim.x - 64u - 32u * (unsigned)l) % gridDim.x));

#pragma nounroll
  for (int l = 0; l < 2; l++) {
    const float* xcur = (l == 0) ? karg_in(0) : xw;
    const float* sp = ssmp + (size_t)l * SSMP_PER_LAYER;
    const unsigned char* wl = ws + WS_WT + (size_t)l * WT_LAYER;
    GEMM_BF16(xn, wl + WT_IN, big, NT, DIN);
    xcd_barrier(bar);
    if (l == 0) vt_phase(wave_s, kvb, vT);
    ssm_chunk_end(wave_s, sp, big, ssmE, smem);
    attn_phase(wave_s, p, l, big, y, smem);
    conv_phase(wave_s, p, l, big, y, smem);
    xcd_barrier(bar);
    ssm_finish(wave_s, p, l, sp, big, ssmE, y, smem);
    xcd_barrier(bar);
    GEMM_F32RN(y, wl + WT_OUT, xw, xcur, xn, karg_in(20) + l * DM, rst);
    xcd_barrier(bar);
    GEMM_BF16S(xn, wl + WT_MQ, big, DM, rst);
    xcd_barrier(bar);
    memattn_phase(wave_s, big, kvb + (size_t)l * 1024 * 2048, vT + (size_t)l * 4 * 4 * 256 * 256, y, smem);
    xcd_barrier(bar);
    GEMM_F32RN(y, wl + WT_MO, xw, (const float*)xw, xn, karg_in(25) + l * DM, rst);
    xcd_barrier(bar);
    GEMM_BF16S(xn, wl + WT_PQ, big, 2048, rst);
    xcd_barrier(bar);
    peer_topk(wave_s, big, skb + (size_t)l * 8 * 2 * 128 * 128, ids, gates, smem);
    xcd_barrier(bar);
    if (l == 0) {
      peer_gather<false>(wave_s, xn, rst, ub + (size_t)l * 16384 * 512, vb + (size_t)l * 16384 * 512, vsc + (size_t)l * 2 * 16384, usc, ids, gates, xw, karg_in(2) + DM, (float*)nullptr);
      xcd_barrier(bar);
    } else {
      peer_gather<true>(wave_s, xn, rst, ub + (size_t)l * 16384 * 512, vb + (size_t)l * 16384 * 512, vsc + (size_t)l * 2 * 16384, usc, ids, gates, xw, karg_in(30), p.out);
    }
  }
}

extern "C" void kernel_launch(void* const* d_in, const int* in_sizes, int n_in,
                              void* d_out, int out_size, void* d_ws, size_t ws_size,
                              hipStream_t stream) {
  static int grid_blocks = 0;
  if (!grid_blocks) {
    int dev = 0, cus = 0, per_cu = 0;
    (void)hipGetDevice(&dev);
    (void)hipDeviceGetAttribute(&cus, hipDeviceAttributeMultiprocessorCount, dev);
    (void)hipFuncSetAttribute((const void*)fwd_megakernel, hipFuncAttributeMaxDynamicSharedMemorySize, LDS_BYTES);
    (void)hipOccupancyMaxActiveBlocksPerMultiprocessor(&per_cu, fwd_megakernel, NWAVES * 64, LDS_BYTES);
    if (per_cu < 1) fprintf(stderr, "occupancy query reports %d blocks/CU\n", per_cu);
    grid_blocks = cus;
  }
  (void)hipMemsetAsync((char*)d_ws + WS_CTL, 0, 1 * MiB, stream);
  Params p{};
  for (int i = 0; i < 31; i++) p.in[i] = (const float*)d_in[i];
  p.out = (float*)d_out;
  p.ws = (unsigned char*)d_ws;
  void* args[] = {&p};
  hipError_t e = hipLaunchCooperativeKernel((void*)fwd_megakernel, dim3(grid_blocks), dim3(NWAVES * 64),
                                            args, LDS_BYTES, stream);
  if (e != hipSuccess)
    fprintf(stderr, "cooperative launch failed: %s (grid %d)\n", hipGetErrorString(e), grid_blocks);
}
```

```cpp
#include <hip/hip_runtime.h>
#include <hip/hip_cooperative_groups.h>
#include <cstdio>
namespace cg = cooperative_groups;

#define NT 16384
#define SEQ 4096
#define DM 1024
#define DIN 2304
#define NMEM 256
#define EPSF 1e-6f
#define NWAVES 8
#define LDS_BYTES 147456

typedef unsigned short bf16;
#define LAS __attribute__((address_space(3)))

struct Params {
  const float* in[31];
  float* out;
  unsigned char* ws;
};
typedef __attribute__((address_space(4))) const unsigned char* kaptr_t;
__device__ __forceinline__ const float* karg_in(int i) {
  kaptr_t ka = (kaptr_t)__builtin_amdgcn_kernarg_segment_ptr();
  asm volatile("" : "+s"(ka));
  return *(const float* __attribute__((address_space(4))) const*)(ka + 8 * i);
}

constexpr size_t MiB = 1u << 20;
constexpr size_t WS_CTL  = 0;
constexpr size_t WS_WT   = 1 * MiB;
constexpr size_t WT_IN = 0, WT_OUT = WT_IN + (size_t)DIN * DM * 2, WT_MQ = WT_OUT + (size_t)DM * DM * 2,
                 WT_MKV = WT_MQ + (size_t)DM * DM * 2, WT_MO = WT_MKV + (size_t)2048 * DM * 2,
                 WT_PQ = WT_MO + (size_t)DM * DM * 2, WT_GLU = WT_PQ + (size_t)2048 * DM * 2, WT_LAYER = WT_GLU + (size_t)256 * 256 * 2;
constexpr size_t WS_XW   = WS_WT + 2 * WT_LAYER;
constexpr size_t WS_XN   = WS_XW + (size_t)NT * DM * 4;
constexpr size_t WS_BIG  = WS_XN + (size_t)NT * DM * 2;
constexpr size_t WS_Y    = WS_BIG + (size_t)NT * DIN * 2;
constexpr size_t WS_MEMH = WS_Y + (size_t)NT * DM * 2;
constexpr size_t WS_KVB  = WS_MEMH + (size_t)2 * 1024 * 1024 * 2;
constexpr size_t WS_VT   = WS_KVB + (size_t)2 * 1024 * 2048 * 2;
constexpr size_t WS_SSME = WS_VT + (size_t)2 * 4 * 4 * 256 * 256 * 2;
#define SSMP_PER_LAYER (2048 + 2048 + 32768)
constexpr size_t WS_SSMP = WS_SSME + (size_t)4 * 64 * 16 * 64 * 2 * 4;
constexpr size_t WS_IDS  = WS_SSMP + (size_t)2 * SSMP_PER_LAYER * 4;
constexpr size_t WS_GATE = WS_IDS + (size_t)NT * 128 * 4;
constexpr size_t WS_SKB  = WS_GATE + (size_t)NT * 128 * 4;
constexpr size_t WS_UB   = WS_SKB + (size_t)2 * 8 * 2 * 128 * 128 * 2;
constexpr size_t WS_VB   = WS_UB + (size_t)2 * 16384 * 512;
constexpr size_t WS_VSC  = WS_VB + (size_t)2 * 16384 * 512;
constexpr size_t WS_USC  = WS_VSC + (size_t)2 * 16384 * 4;
constexpr size_t WS_RST  = WS_USC + (size_t)2 * 16384 * 4;
constexpr size_t WS_END  = WS_RST + (size_t)NT * 16 * 4;
#define U_SCALE 64.0f
#define U4_STEP 0.3352f
#define V4_LUT_LO 0x3B393630u
#define V4_LUT_HI 0x41403E3Du
#define V4_ROWSCALE 1.075f
static_assert(WS_END <= 512 * MiB, "workspace");
static_assert(WT_LAYER % 256 == 0 && WS_SSMP % 16 == 0 && WS_IDS % 16 == 0 && WS_SKB % 256 == 0 && WS_VT % 256 == 0, "align");

__device__ __forceinline__ int opaque_tid(int wave_s) { int v = wave_s * 64 + (int)__builtin_amdgcn_mbcnt_hi(~0u, __builtin_amdgcn_mbcnt_lo(~0u, 0u)); asm volatile("" : "+v"(v)); return v; }
typedef __bf16 bf16n2_t __attribute__((ext_vector_type(2)));
typedef float f32n2_t __attribute__((ext_vector_type(2)));
__device__ __forceinline__ unsigned pk2(float lo, float hi) { f32n2_t v; v[0] = lo; v[1] = hi; return __builtin_bit_cast(unsigned, __builtin_convertvector(v, bf16n2_t)); }
__device__ __forceinline__ unsigned f2bf(float f) { return (unsigned)__builtin_bit_cast(unsigned short, (__bf16)f); }
__device__ __forceinline__ float bf_lo(unsigned u) { return __builtin_bit_cast(float, u << 16); }
__device__ __forceinline__ float bf_hi(unsigned u) { return __builtin_bit_cast(float, u & 0xffff0000u); }
__device__ __forceinline__ float bf2f(bf16 h) { return __builtin_bit_cast(float, (unsigned)h << 16); }


#define XB_TMO      128
#define XB_XCNT(j)  (256  + 64 * (j))
#define XB_XSUB(j)  (1280 + 64 * (j))
#define XB_XGEN(j)  (2304 + 64 * (j))
#define XB_TOP      3328
#define XB_TOPGEN   3392
#define XCD_BAR_WORDS 3456
#define XB_SPIN_CAP (1u << 22)
__device__ __forceinline__ unsigned xb_ld(unsigned* p)              { return __hip_atomic_load(p, __ATOMIC_RELAXED, __HIP_MEMORY_SCOPE_AGENT); }
__device__ __forceinline__ unsigned xb_add(unsigned* p, unsigned v) { return __hip_atomic_fetch_add(p, v, __ATOMIC_RELAXED, __HIP_MEMORY_SCOPE_AGENT); }
__device__ __forceinline__ unsigned xb_xcc_id() { return (unsigned)__builtin_amdgcn_s_getreg((3 << 11) | 20) & 0xFu; }
#define XB_SPIN(cond, bar) do { unsigned _sp = 0; while (cond) { __builtin_amdgcn_s_sleep(1); \
    if ((++_sp & 255u) == 0u) { if (xb_ld(&(bar)[XB_TMO])) break; if (_sp > XB_SPIN_CAP) { atomicAdd(&(bar)[XB_TMO], 1u); break; } } } } while (0)
struct XcdBarrier { unsigned* bar; unsigned x; volatile LAS unsigned* st; };
__device__ __forceinline__ XcdBarrier xcd_barrier_post(unsigned* bar, volatile LAS unsigned* st) {
    XcdBarrier b; b.bar = bar; b.x = xb_xcc_id(); b.st = st;
    if (threadIdx.x == 0) (void)xb_add(&bar[XB_XCNT(b.x)], 1u);
    return b;
}
__device__ __forceinline__ void xcd_barrier_complete(unsigned* bar, unsigned x, unsigned& nloc, unsigned& nx) {
    const unsigned G = gridDim.x * gridDim.y * gridDim.z;
    unsigned sum, cnt, mine, sp = 0u;
    for (;;) {
        sum = 0u; cnt = 0u; mine = 0u;
#pragma unroll
        for (unsigned j = 0; j < 16; ++j) { const unsigned c = xb_ld(&bar[XB_XCNT(j)]); sum += c; cnt += (c > 0u) ? 1u : 0u; mine = (j == x) ? c : mine; }
        if (sum == G) break;
        __builtin_amdgcn_s_sleep(1);
        if ((++sp & 255u) == 0u) { if (xb_ld(&bar[XB_TMO])) break; if (sp > XB_SPIN_CAP) { atomicAdd(&bar[XB_TMO], 1u); break; } }
    }
    nloc = mine > 0u ? mine : 1u; nx = cnt > 0u ? cnt : 1u;
}
__device__ __forceinline__ void xcd_barrier(const XcdBarrier& b) {
    asm volatile("s_waitcnt vmcnt(0)" ::: "memory");
    __syncthreads();
    if (threadIdx.x == 0) {
        unsigned* bar = b.bar;
        __builtin_amdgcn_s_waitcnt(0);
        unsigned nloc = b.st[0], nx = b.st[1];
        if (nloc == 0u) { xcd_barrier_complete(bar, b.x, nloc, nx); b.st[0] = nloc; b.st[1] = nx; }
        const unsigned old = xb_add(&bar[XB_XSUB(b.x)], 1u);
        const unsigned gen = old / nloc;
        if (old + 1u == (gen + 1u) * nloc) {
            __builtin_amdgcn_fence(__ATOMIC_RELEASE, "agent");
            asm volatile("s_waitcnt vmcnt(0)" ::: "memory");
            const unsigned og = xb_add(&bar[XB_TOP], 1u);
            const unsigned tg = og / nx;
            if (og + 1u == (tg + 1u) * nx) xb_add(&bar[XB_TOPGEN], 1u);
            else XB_SPIN(xb_ld(&bar[XB_TOPGEN]) == tg, bar);
            __builtin_amdgcn_fence(__ATOMIC_ACQUIRE, "agent");
            xb_add(&bar[XB_XGEN(b.x)], 1u);
            asm volatile("s_waitcnt vmcnt(0)" ::: "memory");
        } else {
            XB_SPIN(xb_ld(&bar[XB_XGEN(b.x)]) == gen, bar);
            __builtin_amdgcn_fence(__ATOMIC_ACQUIRE, "agent");
            asm volatile("s_waitcnt vmcnt(0)" ::: "memory");
        }
    }
    __syncthreads();
}

namespace pg8 {
#define PG8_LAS __attribute__((address_space(3)))
typedef unsigned short bf16_t;
typedef short bf16x8 __attribute__((ext_vector_type(8)));
typedef float f32x4 __attribute__((ext_vector_type(4)));
typedef unsigned u32x4 __attribute__((ext_vector_type(4)));
constexpr int BM = 256, BK = 64, HALF = 128, HTB = HALF * BK * 2, STAGE_BYTES = 8 * HTB, NXCD = 8, WGM = 8;
__host__ __device__ __forceinline__ int lds_byte(int r, int c) { const int st = (r >> 4) * 2 + (c >> 5), rr = r & 15, cc = c & 31, ob = rr * 64 + cc * 2; return st * 1024 + (ob ^ (((ob >> 9) & 1) << 5)); }
__host__ __device__ __forceinline__ void stage_rc(int b, int& R, int& C) { const int st = b / 1024, sb = b % 1024, swz = sb ^ (((sb >> 9) & 1) << 5); R = (st >> 1) * 16 + swz / 64; C = (st & 1) * 32 + (swz % 64) / 2; }
__host__ __device__ __forceinline__ int perm32(int rho) { const int n = rho >> 4, i = rho & 15; return 8 * (i >> 2) + 4 * n + (i & 3); }
struct Unit { int pm, pn; };
struct Gemm { const bf16_t* A; const bf16_t* Bt; int M, N, K; };
struct StaticOrder {
    int nM, nN, nwg, G, c;
    __host__ __device__ __forceinline__ void init(int M, int N, int G_, int c_) { nM = M / BM; nN = N / BM; nwg = nM * nN; G = G_; c = c_; }
    __host__ __device__ bool next(int i, Unit& u) const {
        const long L = (long)i * G + c; if (L >= nwg) return false;
        int wgid = (int)L; { const int q = nwg / NXCD, r = nwg % NXCD, xcd = wgid % NXCD, off = wgid / NXCD; wgid = (xcd < r ? xcd * (q + 1) : r * (q + 1) + (xcd - r) * q) + off; }
        const int nig = WGM * nN, gid = wgid / nig, fm = gid * WGM, gsz = (nM - fm) < WGM ? (nM - fm) : WGM;
        u.pm = fm + ((wgid % nig) % gsz); u.pn = (wgid % nig) / gsz; return true;
    }
    __device__ __forceinline__ void a_ready(const Unit&) const {}
    __device__ __forceinline__ void done(const Unit&) const {}
};
__device__ __forceinline__ unsigned cvt_pk_bf16(float lo, float hi) { unsigned r; asm volatile("v_cvt_pk_bf16_f32 %0, %1, %2" : "=v"(r) : "v"(lo), "v"(hi)); return r; }

struct EpiF32R {
    static constexpr bool PERM = false, AFTER_DRAIN = false;
    float* C; const float* R; int ldc;
    __device__ __forceinline__ void operator()(const f32x4 (&acc)[2][2][4][2], const Unit& u, int wr, int wc, int fr, int fq) const {
        const int row0 = u.pm * BM + wr * 64 + fr, col0 = u.pn * BM + wc * 32 + 4 * fq;
#pragma unroll
        for (int ai = 0; ai < 2; ++ai)
#pragma unroll
            for (int m = 0; m < 4; ++m) {
                const size_t ro = (size_t)(row0 + ai * HALF + m * 16) * ldc + col0;
                f32x4 rv[2][2];
#pragma unroll
                for (int bj = 0; bj < 2; ++bj)
#pragma unroll
                    for (int n = 0; n < 2; ++n) rv[bj][n] = R ? *(const f32x4*)(R + ro + bj * HALF + n * 16) : (f32x4){0.f, 0.f, 0.f, 0.f};
#pragma unroll
                for (int bj = 0; bj < 2; ++bj)
#pragma unroll
                    for (int n = 0; n < 2; ++n) *(f32x4*)(C + ro + bj * HALF + n * 16) = acc[ai][bj][m][n] + rv[bj][n];
                __builtin_amdgcn_sched_barrier(0);
            }
    }
};

struct EpiBf16 {
    static constexpr bool PERM = true, AFTER_DRAIN = false;
    bf16_t* O; int ldc;
    __device__ __forceinline__ void operator()(const f32x4 (&acc)[2][2][4][2], const Unit& u, int wr, int wc, int fr, int fq) const {
        const int row0 = u.pm * BM + wr * 64 + fr, col0 = u.pn * BM + wc * 32 + 8 * fq;
#pragma unroll
        for (int ai = 0; ai < 2; ++ai)
#pragma unroll
            for (int m = 0; m < 4; ++m) { bf16_t* rowp = O + (size_t)(row0 + ai * HALF + m * 16) * ldc + col0;
#pragma unroll
                for (int bj = 0; bj < 2; ++bj) { const f32x4 v0 = acc[ai][bj][m][0], v1 = acc[ai][bj][m][1];
                    u32x4 w; w.x = cvt_pk_bf16(v0[0], v0[1]); w.y = cvt_pk_bf16(v0[2], v0[3]); w.z = cvt_pk_bf16(v1[0], v1[1]); w.w = cvt_pk_bf16(v1[2], v1[3]);
                    *(u32x4*)(rowp + bj * HALF) = w; } }
    }
};

struct EpiF32RN {
    static constexpr bool PERM = false, AFTER_DRAIN = false;
    float* C; const float* R; int ldc; bf16_t* XG; const float* g; float* st;
    __device__ __forceinline__ void operator()(const f32x4 (&acc)[2][2][4][2], const Unit& u, int wr, int wc, int fr, int fq) const {
        const int row0 = u.pm * BM + wr * 64 + fr, col0 = u.pn * BM + wc * 32 + 4 * fq;
        f32x4 gv[2][2];
#pragma unroll
        for (int bj = 0; bj < 2; ++bj)
#pragma unroll
            for (int n = 0; n < 2; ++n) gv[bj][n] = *(const f32x4*)(g + col0 + bj * HALF + n * 16);
#pragma unroll
        for (int ai = 0; ai < 2; ++ai)
#pragma unroll
            for (int m = 0; m < 4; ++m) {
                const int row = row0 + ai * HALF + m * 16;
                const size_t ro = (size_t)row * ldc + col0;
                f32x4 rv[2][2];
#pragma unroll
                for (int bj = 0; bj < 2; ++bj)
#pragma unroll
                    for (int n = 0; n < 2; ++n) rv[bj][n] = *(const f32x4*)(R + ro + bj * HALF + n * 16);
                float ss = 0.f;
#pragma unroll
                for (int bj = 0; bj < 2; ++bj)
#pragma unroll
                    for (int n = 0; n < 2; ++n) {
                        const f32x4 v = acc[ai][bj][m][n] + rv[bj][n];
                        *(f32x4*)(C + ro + bj * HALF + n * 16) = v;
                        ss += (v[0] * v[0] + v[1] * v[1]) + (v[2] * v[2] + v[3] * v[3]);
                        const f32x4 w = v * gv[bj][n];
                        uint2 pk; pk.x = cvt_pk_bf16(w[0], w[1]); pk.y = cvt_pk_bf16(w[2], w[3]);
                        *(uint2*)(XG + ro + bj * HALF + n * 16) = pk;
                    }
                ss += __shfl_xor(ss, 16, 64); ss += __shfl_xor(ss, 32, 64);
                if (fq == 0) st[(size_t)row * 16 + u.pn * 4 + wc] = ss;
                __builtin_amdgcn_sched_barrier(0);
            }
    }
};
struct EpiBf16S {
    static constexpr bool PERM = true, AFTER_DRAIN = false;
    bf16_t* O; int ldc; const float* st;
    __device__ __forceinline__ void operator()(const f32x4 (&acc)[2][2][4][2], const Unit& u, int wr, int wc, int fr, int fq) const {
        const int row0 = u.pm * BM + wr * 64 + fr, col0 = u.pn * BM + wc * 32 + 8 * fq;
#pragma unroll
        for (int ai = 0; ai < 2; ++ai)
#pragma unroll
            for (int m = 0; m < 4; ++m) {
                const int row = row0 + ai * HALF + m * 16;
                const f32x4* sp = (const f32x4*)(st + (size_t)row * 16);
                const f32x4 s0 = sp[0], s1 = sp[1], s2 = sp[2], s3 = sp[3];
                const f32x4 sa = (s0 + s1) + (s2 + s3);
                const float rs = __builtin_amdgcn_rsqf(((sa[0] + sa[1]) + (sa[2] + sa[3])) * (1.0f / 1024.f) + 1e-6f);
                bf16_t* rowp = O + (size_t)row * ldc + col0;
#pragma unroll
                for (int bj = 0; bj < 2; ++bj) { const f32x4 v0 = acc[ai][bj][m][0] * rs, v1 = acc[ai][bj][m][1] * rs;
                    u32x4 w; w.x = cvt_pk_bf16(v0[0], v0[1]); w.y = cvt_pk_bf16(v0[2], v0[3]); w.z = cvt_pk_bf16(v1[0], v1[1]); w.w = cvt_pk_bf16(v1[2], v1[3]);
                    *(u32x4*)(rowp + bj * HALF) = w; }
                __builtin_amdgcn_sched_barrier(0);
            }
    }
};

template <class Epi, class Sched, bool ALIGN_EPI = false, bool SP2 = false>
__device__ __forceinline__ void gemm_phase(const int wave_s, PG8_LAS unsigned char* lds, const Gemm g, const Sched& S, const Epi& E) {
    const int tid = opaque_tid(wave_s), wid = __builtin_amdgcn_readfirstlane(tid >> 6), lane = tid & 63, wr = wid >> 2, wc = wid & 3, fr = lane & 15, fq = lane >> 4;
    const int K = g.K, nt = K / BK;
    unsigned voffA[2], voffB[2];
#pragma unroll
    for (int i = 0; i < 2; ++i) { int R, C; stage_rc(tid * 16 + i * 8192, R, C); const int Rb = Epi::PERM ? ((R & ~31) + perm32(R & 31)) : R;
        voffA[i] = (unsigned)(R * K + C) * 2u; voffB[i] = (unsigned)(Rb * K + C) * 2u; }
    const size_t kstep = (size_t)(BK * 2);
    const size_t hstep = (size_t)HALF * K * 2;
    const size_t tstep = 2 * hstep;
    const unsigned ldsw = (unsigned)wid * 1024u;
    const int aoff = lds_byte(wr * 64 + fr, fq * 8), boff = lds_byte(wc * 32 + fr, fq * 8);
#define PG8_SA(b, h) (((b) * 2 + (h)) * HTB)
#define PG8_SB(b, h) ((4 + (b) * 2 + (h)) * HTB)
#define PG8_STAGE(bufoff, gbase, voff) do { _Pragma("unroll") for (int _i = 0; _i < 2; ++_i) \
        __builtin_amdgcn_global_load_lds((const unsigned*)((const char*)(gbase) + (voff)[_i]), (PG8_LAS unsigned*)(lds + (bufoff) + ldsw + _i * 8192), 16, 0, 0); } while (0)
#define PG8_LDA(dst, b, h) do { _Pragma("unroll") for (int m = 0; m < 4; ++m) _Pragma("unroll") for (int k = 0; k < 2; ++k) dst[m][k] = *(const PG8_LAS bf16x8*)(lds + PG8_SA(b, h) + aoff + m * 2048 + k * 1024); } while (0)
#define PG8_LDB(dst, b, h) do { _Pragma("unroll") for (int n = 0; n < 2; ++n) _Pragma("unroll") for (int k = 0; k < 2; ++k) dst[n][k] = *(const PG8_LAS bf16x8*)(lds + PG8_SB(b, h) + boff + n * 2048 + k * 1024); } while (0)
#define PG8_MMA(ai, bj, At, Bt) do { __builtin_amdgcn_s_setprio(1); _Pragma("unroll") for (int m = 0; m < 4; ++m) _Pragma("unroll") for (int n = 0; n < 2; ++n) _Pragma("unroll") for (int k = 0; k < 2; ++k) \
        acc[ai][bj][m][n] = __builtin_amdgcn_mfma_f32_16x16x32_bf16(Bt[n][k], At[m][k], acc[ai][bj][m][n], 0, 0, 0); __builtin_amdgcn_s_setprio(0); } while (0)
#define PG8_WAIT_V(n) asm volatile("s_waitcnt vmcnt(" #n ")" ::: "memory")
#define PG8_WAIT_L(n) asm volatile("s_waitcnt lgkmcnt(" #n ")" ::: "memory")
#define PG8_BAR __builtin_amdgcn_s_barrier()
#define PG8_SCHED __builtin_amdgcn_sched_barrier(0)
    Unit cur, nxt; int ui = 0;
    if (!S.next(0, cur)) return;
    f32x4 acc[2][2][4][2];
#pragma unroll
    for (int a = 0; a < 2; ++a)
#pragma unroll
        for (int b = 0; b < 2; ++b)
#pragma unroll
            for (int m = 0; m < 4; ++m)
#pragma unroll
                for (int n = 0; n < 2; ++n) acc[a][b][m][n] = (f32x4){0.f, 0.f, 0.f, 0.f};
    bf16x8 At[4][2], B0[2][2], B1[2][2];
    const char* cA = (const char*)g.A + (size_t)cur.pm * tstep; const char* cB = (const char*)g.Bt + (size_t)cur.pn * tstep;
    S.a_ready(cur);
    if constexpr (SP2) {
        PG8_STAGE(PG8_SB(0, 0), cB, voffB); PG8_STAGE(PG8_SB(0, 1), cB + hstep, voffB); PG8_STAGE(PG8_SA(0, 0), cA, voffA); PG8_STAGE(PG8_SA(0, 1), cA + hstep, voffA);
        if (wr == 1) PG8_BAR;
        PG8_WAIT_V(2); PG8_BAR;
        PG8_STAGE(PG8_SB(1, 0), cB + kstep, voffB); PG8_STAGE(PG8_SA(1, 0), cA + kstep, voffA); PG8_STAGE(PG8_SB(1, 1), cB + hstep + kstep, voffB);
        PG8_WAIT_V(6); PG8_BAR;
    } else {
        PG8_STAGE(PG8_SB(0, 0), cB, voffB); PG8_STAGE(PG8_SA(0, 0), cA, voffA); PG8_STAGE(PG8_SB(0, 1), cB + hstep, voffB); PG8_STAGE(PG8_SA(0, 1), cA + hstep, voffA);
        if (wr == 1) PG8_BAR;
        PG8_WAIT_V(4); PG8_BAR;
        PG8_STAGE(PG8_SB(1, 0), cB + kstep, voffB); PG8_STAGE(PG8_SA(1, 0), cA + kstep, voffA); PG8_STAGE(PG8_SB(1, 1), cB + hstep + kstep, voffB);
        PG8_WAIT_V(6); PG8_BAR;
    }
    for (;;) {
        const bool has_next = S.next(ui + 1, nxt);
        const char* nA = has_next ? (const char*)g.A + (size_t)nxt.pm * tstep : cA; const char* nB = has_next ? (const char*)g.Bt + (size_t)nxt.pn * tstep : cB;
        for (int t = 0; t < nt; t += 2) {
            const bool last = (t == nt - 2);
            const char* a1 = cA + (size_t)(t + 1) * kstep;
            const char* a2 = last ? nA : cA + (size_t)(t + 2) * kstep; const char* b2 = last ? nB : cB + (size_t)(t + 2) * kstep;
            const char* a3 = a2 + kstep; const char* b3 = b2 + kstep;
            if (last && has_next) S.a_ready(nxt);
            if constexpr (SP2) {
            PG8_LDB(B0, 0, 0); PG8_LDB(B1, 0, 1); PG8_SCHED; PG8_LDA(At, 0, 0); PG8_STAGE(PG8_SA(1, 1), a1 + hstep, voffA);
            PG8_WAIT_V(8); PG8_WAIT_L(0); PG8_BAR; PG8_MMA(0, 0, At, B0); PG8_MMA(0, 1, At, B1); PG8_BAR; PG8_SCHED;
            PG8_LDA(At, 0, 1); PG8_STAGE(PG8_SB(0, 0), b2, voffB); PG8_STAGE(PG8_SB(0, 1), b2 + hstep, voffB); PG8_STAGE(PG8_SA(0, 0), a2, voffA);
            PG8_WAIT_V(8); PG8_WAIT_L(0); PG8_BAR; PG8_MMA(1, 0, At, B0); PG8_MMA(1, 1, At, B1); PG8_BAR; PG8_SCHED;
            PG8_LDB(B0, 1, 0); PG8_LDB(B1, 1, 1); PG8_SCHED; PG8_LDA(At, 1, 0); PG8_STAGE(PG8_SA(0, 1), a2 + hstep, voffA);
            PG8_WAIT_V(8); PG8_WAIT_L(0); PG8_BAR; PG8_MMA(0, 0, At, B0); PG8_MMA(0, 1, At, B1); PG8_BAR; PG8_SCHED;
            PG8_LDA(At, 1, 1); PG8_STAGE(PG8_SB(1, 0), b3, voffB); PG8_STAGE(PG8_SB(1, 1), b3 + hstep, voffB); PG8_STAGE(PG8_SA(1, 0), a3, voffA);
            PG8_WAIT_V(8); PG8_WAIT_L(0); PG8_BAR; PG8_MMA(1, 0, At, B0); PG8_MMA(1, 1, At, B1); PG8_BAR; PG8_SCHED;
            } else {
            PG8_LDB(B0, 0, 0); PG8_SCHED; PG8_LDA(At, 0, 0); PG8_STAGE(PG8_SA(1, 1), a1 + hstep, voffA);
            PG8_WAIT_L(8); PG8_BAR; PG8_WAIT_L(0); PG8_MMA(0, 0, At, B0); PG8_BAR; PG8_SCHED;
            PG8_LDB(B1, 0, 1); PG8_STAGE(PG8_SB(0, 0), b2, voffB);
            PG8_BAR; PG8_WAIT_L(0); PG8_MMA(0, 1, At, B1); PG8_BAR;
            PG8_LDA(At, 0, 1); PG8_STAGE(PG8_SA(0, 0), a2, voffA);
            PG8_BAR; PG8_WAIT_L(0); PG8_MMA(1, 0, At, B0); PG8_BAR; PG8_SCHED;
            PG8_STAGE(PG8_SB(0, 1), b2 + hstep, voffB);
            PG8_WAIT_V(6); PG8_BAR; PG8_MMA(1, 1, At, B1); PG8_BAR;
            PG8_LDB(B0, 1, 0); PG8_SCHED; PG8_LDA(At, 1, 0); PG8_STAGE(PG8_SA(0, 1), a2 + hstep, voffA);
            PG8_WAIT_L(8); PG8_BAR; PG8_WAIT_L(0); PG8_MMA(0, 0, At, B0); PG8_BAR; PG8_SCHED;
            PG8_LDB(B1, 1, 1); PG8_STAGE(PG8_SB(1, 0), b3, voffB);
            PG8_BAR; PG8_WAIT_L(0); PG8_MMA(0, 1, At, B1); PG8_BAR;
            PG8_LDA(At, 1, 1); PG8_STAGE(PG8_SA(1, 0), a3, voffA);
            PG8_BAR; PG8_WAIT_L(0); PG8_MMA(1, 0, At, B0); PG8_BAR; PG8_SCHED;
            PG8_STAGE(PG8_SB(1, 1), b3 + hstep, voffB);
            PG8_WAIT_V(6); PG8_BAR; PG8_MMA(1, 1, At, B1); PG8_BAR;
            }
        }
        if constexpr (ALIGN_EPI) { if (wr == 0) PG8_BAR; }
        if constexpr (!Epi::AFTER_DRAIN) { E(acc, cur, wr, wc, fr, fq); S.done(cur); }
        if (!has_next) break;
#pragma unroll
        for (int a = 0; a < 2; ++a)
#pragma unroll
            for (int b = 0; b < 2; ++b)
#pragma unroll
                for (int m = 0; m < 4; ++m)
#pragma unroll
                    for (int n = 0; n < 2; ++n) acc[a][b][m][n] = (f32x4){0.f, 0.f, 0.f, 0.f};
        cur = nxt; cA = nA; cB = nB; ++ui;
        if constexpr (ALIGN_EPI) { if (wr == 1) PG8_BAR; }
    }
    PG8_WAIT_V(0);
    if constexpr (!ALIGN_EPI) { if (wr == 0) PG8_BAR; }
    PG8_BAR;
#undef PG8_SA
#undef PG8_SB
#undef PG8_STAGE
#undef PG8_LDA
#undef PG8_LDB
#undef PG8_MMA
#undef PG8_WAIT_V
#undef PG8_WAIT_L
#undef PG8_BAR
#undef PG8_SCHED
}
}

__device__ __forceinline__ void transpose_item(const float* W, int K, int N, bf16* WT, LAS float* scr, int item, int lane) {
    const int nblk = N / 32, kb = item / nblk, nb = item % nblk, k0 = 64 * kb, n0 = 32 * nb;
#pragma unroll 8
    for (int i = 0; i < 32; ++i) { const int kk = 2 * i + (lane >> 5); scr[kk * 33 + (lane & 31)] = W[(size_t)(k0 + kk) * N + n0 + (lane & 31)]; }
    asm volatile("s_waitcnt lgkmcnt(0)" ::: "memory");
    const int c = lane & 7;
#pragma unroll
    for (int j = 0; j < 4; ++j) { const int n = (lane >> 3) + 8 * j; const LAS float* s = scr + (8 * c) * 33 + n;
        uint4 o; o.x = pk2(s[0 * 33], s[1 * 33]); o.y = pk2(s[2 * 33], s[3 * 33]); o.z = pk2(s[4 * 33], s[5 * 33]); o.w = pk2(s[6 * 33], s[7 * 33]);
        *(uint4*)(WT + (size_t)(n0 + n) * K + k0 + 8 * c) = o; }
    asm volatile("s_waitcnt lgkmcnt(0)" ::: "memory");
}

__device__ __forceinline__ float wsum(float v) {
#pragma unroll
  for (int o = 32; o > 0; o >>= 1) v += __shfl_xor(v, o, 64);
  return v;
}
__device__ __forceinline__ float wmaxf(float v) {
#pragma unroll
  for (int o = 32; o > 0; o >>= 1) v = fmaxf(v, __shfl_xor(v, o, 64));
  return v;
}
__device__ __forceinline__ float sigmoidf_(float x) { return __builtin_amdgcn_rcpf(1.0f + __expf(-x)); }
__device__ __forceinline__ float gelu_tanh(float x) {
  return x * sigmoidf_(1.5957691216057308f * (x + 0.044715f * x * x * x));
}

template <bool BF16OUT>
__device__ __forceinline__ void rms_rows(const int wave_s, const float* src, const float* g, void* dstv, int rows) {
  const int tid_ = opaque_tid(wave_s);
  const int lane = tid_ & 63;
  const int gw = blockIdx.x * NWAVES + (tid_ >> 6);
  const int nw = gridDim.x * NWAVES;
  for (int r = gw; r < rows; r += nw) {
    const float4* s4 = (const float4*)(src + (size_t)r * DM);
    float4 v[4];
    float ss = 0.f;
#pragma unroll
    for (int i = 0; i < 4; i++) {
      v[i] = s4[lane + i * 64];
      ss += v[i].x * v[i].x + v[i].y * v[i].y + v[i].z * v[i].z + v[i].w * v[i].w;
    }
    ss = wsum(ss);
    const float rstd = rsqrtf(ss * (1.0f / DM) + EPSF);
    const float4* g4 = (const float4*)g;
#pragma unroll
    for (int i = 0; i < 4; i++) {
      float4 gg = g4[lane + i * 64];
      float4 o;
      o.x = v[i].x * rstd * gg.x; o.y = v[i].y * rstd * gg.y;
      o.z = v[i].z * rstd * gg.z; o.w = v[i].w * rstd * gg.w;
      if (BF16OUT) {
        uint2 pk; pk.x = pk2(o.x, o.y); pk.y = pk2(o.z, o.w);
        ((uint2*)((bf16*)dstv + (size_t)r * DM))[lane + i * 64] = pk;
      } else {
        ((float4*)((float*)dstv + (size_t)r * DM))[lane + i * 64] = o;
      }
    }
  }
}

__device__ __forceinline__ void ssm_params(const int wave_s, const Params& p, float* ssmp_all) {
  const int tid_ = opaque_tid(wave_s);
  const float* in8 = karg_in(8); const float* in9 = karg_in(9); const float* in10 = karg_in(10);
  const float* in11 = karg_in(11); const float* in12 = karg_in(12);
  const int gt = blockIdx.x * blockDim.x + tid_;
  const int nth = gridDim.x * blockDim.x;
  for (int i = gt; i < 2 * 16 * 64; i += nth) {
    const int l = i / 1024, gp = i % 1024, g = gp / 64;
    float* sp = ssmp_all + (size_t)l * SSMP_PER_LAYER;
    const float lre = fminf(in8[l * 1024 + gp], -1e-4f);
    const float lim = in9[l * 1024 + gp];
    const float dt = expf(in10[l * 16 + g]);
    const float er = expf(lre * dt);
    float sn, cs;
    sincosf(lim * dt, &sn, &cs);
    const float br = er * cs, bi = er * sn;
    sp[gp * 2 + 0] = br;
    sp[gp * 2 + 1] = bi;
    float cr = br, ci = bi;
#pragma unroll
    for (int s = 0; s < 6; s++) {
      const float nr = cr * cr - ci * ci, ni = 2.f * cr * ci;
      cr = nr; ci = ni;
    }
    sp[2048 + gp * 2 + 0] = cr;
    sp[2048 + gp * 2 + 1] = ci;
    const float nr = br - 1.0f, ni = bi;
    const float den = lre * lre + lim * lim;
    const float fr = (nr * lre + ni * lim) / den;
    const float fi = (ni * lre - nr * lim) / den;
    for (int h = 0; h < 16; h++) {
      const float bre = in11[((size_t)l * 1024 + gp) * 16 + h];
      const float bim = in12[((size_t)l * 1024 + gp) * 16 + h];
      sp[4096 + ((g * 16 + h) * 64 + (gp & 63)) * 2 + 0] = fr * bre - fi * bim;
      sp[4096 + ((g * 16 + h) * 64 + (gp & 63)) * 2 + 1] = fr * bim + fi * bre;
    }
  }
}

__device__ __forceinline__ void conv_phase(const int wave_s, const Params& p, int l, const bf16* proj, bf16* y, LAS float* smem) {
  const int tid_ = opaque_tid(wave_s);
  const int lane = tid_ & 63;
  const int gw = blockIdx.x * NWAVES + (tid_ >> 6);
  const int nw = gridDim.x * NWAVES;
  const float* cw = karg_in(4) + (size_t)l * 31 * 256;
  const float4 cb = ((const float4*)(karg_in(5) + l * 256))[lane];
  const float4 lg = ((const float4*)(karg_in(6) + l * 256))[lane];
  const float4 lb = ((const float4*)(karg_in(7) + l * 256))[lane];
  const float4 gg = ((const float4*)(karg_in(18) + l * 1024))[lane];
  LAS float* cwl = smem + 1024;
  for (int i = tid_; i < 31 * 256 / 4; i += NWAVES * 64) *(LAS pg8::f32x4*)(cwl + 4 * i) = *(const pg8::f32x4*)(cw + 4 * i);
  __syncthreads();
  for (int it = gw; it < NT / 8; it += nw) {
    const int tok0 = it * 8;
    const int t0 = tok0 & (SEQ - 1);
    float4 acc[8];
#pragma unroll
    for (int o = 0; o < 8; o++) acc[o] = cb;
#pragma unroll
    for (int i = 0; i < 38; i++) {
      if (t0 - 30 + i >= 0) {
        const bf16* row = proj + (size_t)(tok0 - 30 + i) * DIN;
        const uint2 vp = ((const uint2*)row)[lane];
        const uint2 gp = ((const uint2*)(row + 256))[lane];
        float4 g4;
        g4.x = bf_lo(vp.x) * sigmoidf_(bf_lo(gp.x)); g4.y = bf_hi(vp.x) * sigmoidf_(bf_hi(gp.x));
        g4.z = bf_lo(vp.y) * sigmoidf_(bf_lo(gp.y)); g4.w = bf_hi(vp.y) * sigmoidf_(bf_hi(gp.y));
#pragma unroll
        for (int o = 0; o < 8; o++) {
          const int j = i - o;
          if (j >= 0 && j <= 30) {
            const pg8::f32x4 w4 = *(const LAS pg8::f32x4*)(cwl + j * 256 + lane * 4);
            acc[o].x += g4.x * w4[0]; acc[o].y += g4.y * w4[1];
            acc[o].z += g4.z * w4[2]; acc[o].w += g4.w * w4[3];
          }
        }
      }
    }
#pragma unroll
    for (int o = 0; o < 8; o++) {
      const float4 a = acc[o];
      const float mean = wsum(a.x + a.y + a.z + a.w) * (1.0f / 256.f);
      const float dx = a.x - mean, dy = a.y - mean, dz = a.z - mean, dw = a.w - mean;
      const float var = wsum(dx * dx + dy * dy + dz * dz + dw * dw) * (1.0f / 256.f);
      const float rs = rsqrtf(var + EPSF);
      float4 s;
      s.x = dx * rs * lg.x + lb.x; s.y = dy * rs * lg.y + lb.y;
      s.z = dz * rs * lg.z + lb.z; s.w = dw * rs * lg.w + lb.w;
      s.x = s.x * sigmoidf_(s.x); s.y = s.y * sigmoidf_(s.y);
      s.z = s.z * sigmoidf_(s.z); s.w = s.w * sigmoidf_(s.w);
      const float ss = wsum(s.x * s.x + s.y * s.y + s.z * s.z + s.w * s.w) * (1.0f / 256.f);
      const float r2 = rsqrtf(ss + EPSF);
      uint2 pk; pk.x = pk2(s.x * r2 * gg.x, s.y * r2 * gg.y); pk.y = pk2(s.z * r2 * gg.z, s.w * r2 * gg.w);
      ((uint2*)(y + (size_t)(tok0 + o) * DM))[lane] = pk;
    }
  }
}

typedef short bf16x8_t __attribute__((ext_vector_type(8)));
typedef float f32x16_t __attribute__((ext_vector_type(16)));
#define MFMA_PAD() do { __builtin_amdgcn_sched_barrier(0); asm volatile("s_nop 15\n\ts_nop 15" ::: "memory"); __builtin_amdgcn_sched_barrier(0); } while (0)

__device__ __forceinline__ void attn_phase(const int wave_s, const Params& p, int l, const bf16* proj, bf16* y, LAS float* smem) {
  const int tid = opaque_tid(wave_s), lane = tid & 63, wave = tid >> 6;
  const int n = lane & 31, hh = lane >> 5;
  const float* gg = karg_in(18) + l * 1024 + 256 + wave * 64;
  const float g0 = gg[n], g1 = gg[32 + n];
  LAS float* ssq = smem;
  LAS float* rstd = smem + 256;
  for (int item = blockIdx.x; item < 4 * 128; item += gridDim.x) {
    const int b = item >> 7, q0 = (item & 127) * 32;
    const size_t tokb = (size_t)b * SEQ;
    bf16x8_t qf[4];
    {
      const bf16* qrow = proj + (tokb + q0 + n) * DIN + 512 + wave * 64 + 8 * hh;
#pragma unroll
      for (int ks = 0; ks < 4; ks++) qf[ks] = *(const bf16x8_t*)(qrow + 16 * ks);
    }
    f32x16_t o0, o1;
#pragma unroll
    for (int r = 0; r < 16; r++) { o0[r] = 0.f; o1[r] = 0.f; }
    float R = 0.f;
    for (int kt = q0; kt >= 0; kt -= 32) {
      bf16x8_t kf[4];
      {
        const bf16* krow = proj + (tokb + kt + n) * DIN + 1024 + wave * 64 + 8 * hh;
#pragma unroll
        for (int ks = 0; ks < 4; ks++) kf[ks] = *(const bf16x8_t*)(krow + 16 * ks);
      }
      bf16x8_t vf0[2], vf1[2];
      {
        const bf16* vb = proj + (tokb + kt + 4 * hh) * DIN + 1536 + wave * 64 + n;
#pragma unroll
        for (int s = 0; s < 2; s++)
#pragma unroll
          for (int j = 0; j < 8; j++) {
            const int key = 16 * s + 8 * (j >> 2) + (j & 3);
            vf0[s][j] = (short)vb[(size_t)key * DIN];
            vf1[s][j] = (short)vb[(size_t)key * DIN + 32];
          }
      }
      f32x16_t sacc;
#pragma unroll
      for (int r = 0; r < 16; r++) sacc[r] = 0.f;
      __builtin_amdgcn_sched_barrier(0); asm volatile("s_nop 15\n\ts_nop 15" ::: "memory"); __builtin_amdgcn_sched_barrier(0);
#pragma unroll
      for (int ks = 0; ks < 4; ks++) sacc = __builtin_amdgcn_mfma_f32_32x32x16_bf16(kf[ks], qf[ks], sacc, 0, 0, 0);
      __builtin_amdgcn_sched_barrier(0); asm volatile("s_nop 15\n\ts_nop 15" ::: "memory"); __builtin_amdgcn_sched_barrier(0);
      float lst[16], lsz[16];
      const bool diag = (kt == q0);
#pragma unroll
      for (int r = 0; r < 16; r++) {
        const float z = sacc[r] * 0.125f;
        const float sp = __logf(1.0f + __expf(-fabsf(z)));
        float a = fminf(z, 0.f) - sp;
        float c = -(fmaxf(z, 0.f) + sp);
        if (diag) {
          const int key = (r & 3) + 8 * (r >> 2) + 4 * hh;
          if (key >= n) { a = -1.0e30f; c = 0.f; }
        }
        lsz[r] = a; lst[r] = c;
      }
      float Gs[4], Gp[4];
#pragma unroll
      for (int g = 0; g < 4; g++) {
        Gs[g] = (lst[4 * g] + lst[4 * g + 1]) + (lst[4 * g + 2] + lst[4 * g + 3]);
        Gp[g] = __shfl_xor(Gs[g], 32, 64);
      }
      float carry[4];
      {
        float after = R;
#pragma unroll
        for (int g = 3; g >= 0; g--) {
          carry[g] = after + (hh ? 0.f : Gp[g]);
          after += Gs[g] + Gp[g];
        }
        R = after;
      }
      bf16x8_t pf[2];
#pragma unroll
      for (int g = 0; g < 4; g++) {
        float run = carry[g];
        float a3 = __expf(lsz[4 * g + 3] + run); run += lst[4 * g + 3];
        float a2 = __expf(lsz[4 * g + 2] + run); run += lst[4 * g + 2];
        float a1 = __expf(lsz[4 * g + 1] + run); run += lst[4 * g + 1];
        float a0 = __expf(lsz[4 * g + 0] + run);
        const int s = g >> 1, jb = (g & 1) * 4;
        pf[s][jb + 0] = (short)f2bf(a0); pf[s][jb + 1] = (short)f2bf(a1);
        pf[s][jb + 2] = (short)f2bf(a2); pf[s][jb + 3] = (short)f2bf(a3);
      }
      __builtin_amdgcn_sched_barrier(0); asm volatile("s_nop 15\n\ts_nop 15" ::: "memory"); __builtin_amdgcn_sched_barrier(0);
#pragma unroll
      for (int s = 0; s < 2; s++) {
        o0 = __builtin_amdgcn_mfma_f32_32x32x16_bf16(pf[s], vf0[s], o0, 0, 0, 0);
        o1 = __builtin_amdgcn_mfma_f32_32x32x16_bf16(pf[s], vf1[s], o1, 0, 0, 0);
      }
      __builtin_amdgcn_sched_barrier(0); asm volatile("s_nop 15\n\ts_nop 15" ::: "memory"); __builtin_amdgcn_sched_barrier(0);
      if (__all(R < -110.f)) break;
    }
    float sq[16];
#pragma unroll
    for (int r = 0; r < 16; r++) {
      float v = o0[r] * o0[r] + o1[r] * o1[r];
#pragma unroll
      for (int o = 16; o > 0; o >>= 1) v += __shfl_xor(v, o, 64);
      sq[r] = v;
    }
    __syncthreads();
    if (n == 0) {
#pragma unroll
      for (int r = 0; r < 16; r++) ssq[wave * 32 + (r & 3) + 8 * (r >> 2) + 4 * hh] = sq[r];
    }
    __syncthreads();
    if (tid < 32) {
      float t = 0.f;
#pragma unroll
      for (int w = 0; w < 8; w++) t += ssq[w * 32 + tid];
      rstd[tid] = rsqrtf(t * (1.0f / 512.f) + EPSF);
    }
    __syncthreads();
#pragma unroll
    for (int r = 0; r < 16; r++) {
      const int qi = (r & 3) + 8 * (r >> 2) + 4 * hh;
      const float rs = rstd[qi];
      bf16* yr = y + (tokb + q0 + qi) * DM + 256 + wave * 64 + n;
      yr[0] = (bf16)f2bf(o0[r] * rs * g0);
      yr[32] = (bf16)f2bf(o1[r] * rs * g1);
    }
  }
}

#define SSM_BCAST_U(u, ua, ub, tt) do { \
    const unsigned w0 = (unsigned)__builtin_amdgcn_readlane((int)(ua).x, (tt)), w1 = (unsigned)__builtin_amdgcn_readlane((int)(ua).y, (tt)); \
    const unsigned w2 = (unsigned)__builtin_amdgcn_readlane((int)(ua).z, (tt)), w3 = (unsigned)__builtin_amdgcn_readlane((int)(ua).w, (tt)); \
    const unsigned w4 = (unsigned)__builtin_amdgcn_readlane((int)(ub).x, (tt)), w5 = (unsigned)__builtin_amdgcn_readlane((int)(ub).y, (tt)); \
    const unsigned w6 = (unsigned)__builtin_amdgcn_readlane((int)(ub).z, (tt)), w7 = (unsigned)__builtin_amdgcn_readlane((int)(ub).w, (tt)); \
    (u)[0] = bf_lo(w0); (u)[1] = bf_hi(w0); (u)[2] = bf_lo(w1); (u)[3] = bf_hi(w1); (u)[4] = bf_lo(w2); (u)[5] = bf_hi(w2); (u)[6] = bf_lo(w3); (u)[7] = bf_hi(w3); \
    (u)[8] = bf_lo(w4); (u)[9] = bf_hi(w4); (u)[10] = bf_lo(w5); (u)[11] = bf_hi(w5); (u)[12] = bf_lo(w6); (u)[13] = bf_hi(w6); (u)[14] = bf_lo(w7); (u)[15] = bf_hi(w7); } while (0)
#define SSM_RS 592
#define SSM_TILE_BASE 36864
#define SSM_TILE_BYTES (16 * SSM_RS)
typedef float f32x2_t __attribute__((ext_vector_type(2)));
__device__ __forceinline__ void ssm_load_bop(const float* ssmp, int g, int lane, bf16x8_t (&bop)[8]) {
  const int q = lane >> 4, n = lane & 15;
  float v[8][8];
#pragma unroll
  for (int j = 0; j < 8; j++) {
    const float4* rp = (const float4*)(ssmp + 4096 + (size_t)(g * 16 + ((8 * q + j) & 15)) * 128 + 8 * n);
    const float4 a = rp[0], b = rp[1];
    v[j][0] = a.x; v[j][1] = a.y; v[j][2] = a.z; v[j][3] = a.w; v[j][4] = b.x; v[j][5] = b.y; v[j][6] = b.z; v[j][7] = b.w;
  }
#pragma unroll
  for (int nt = 0; nt < 8; nt++) {
    pg8::u32x4 w;
    w.x = pk2(v[0][nt], v[1][nt]); w.y = pk2(v[2][nt], v[3][nt]); w.z = pk2(v[4][nt], v[5][nt]); w.w = pk2(v[6][nt], v[7][nt]);
    if (q >= 2) { w.x = 0u; w.y = 0u; w.z = 0u; w.w = 0u; }
    bop[nt] = __builtin_bit_cast(bf16x8_t, w);
  }
}
__device__ __forceinline__ void ssm_bu_block(LAS unsigned char* xt, int lane, int blk, const uint4& ua, const uint4& ub, const bf16x8_t (&bop)[8]) {
  const int q = lane >> 4, n = lane & 15;
  if (q == blk) {
    pg8::u32x4 w0, w1;
    w0.x = ua.x; w0.y = ua.y; w0.z = ua.z; w0.w = ua.w; w1.x = ub.x; w1.y = ub.y; w1.z = ub.z; w1.w = ub.w;
    LAS pg8::u32x4* ur = (LAS pg8::u32x4*)(xt + n * SSM_RS + 512);
    ur[0] = w0; ur[1] = w1;
  }
  __builtin_amdgcn_wave_barrier();
  const bf16x8_t uop = *(const LAS bf16x8_t*)(xt + n * SSM_RS + 512 + q * 16);
  pg8::f32x4 bacc[8];
#pragma unroll
  for (int nt = 0; nt < 8; nt++) {
    pg8::f32x4 z4; z4[0] = 0.f; z4[1] = 0.f; z4[2] = 0.f; z4[3] = 0.f;
    bacc[nt] = __builtin_amdgcn_mfma_f32_16x16x32_bf16(uop, bop[nt], z4, 0, 0, 0);
  }
#pragma unroll
  for (int j = 0; j < 4; j++) {
    pg8::f32x4 w0, w1;
    w0[0] = bacc[0][j]; w0[1] = bacc[1][j]; w0[2] = bacc[2][j]; w0[3] = bacc[3][j];
    w1[0] = bacc[4][j]; w1[1] = bacc[5][j]; w1[2] = bacc[6][j]; w1[3] = bacc[7][j];
    LAS pg8::f32x4* dr = (LAS pg8::f32x4*)(xt + (4 * q + j) * SSM_RS + 32 * n);
    dr[0] = w0; dr[1] = w1;
  }
  __builtin_amdgcn_wave_barrier();
}
__device__ __forceinline__ void ssm_zero_pad(LAS unsigned char* xt, int lane) {
  if (lane < 16) {
    pg8::u32x4 z4; z4.x = 0u; z4.y = 0u; z4.z = 0u; z4.w = 0u;
    LAS pg8::u32x4* zr = (LAS pg8::u32x4*)(xt + lane * SSM_RS + 544);
    zr[0] = z4; zr[1] = z4;
  }
}
__device__ __forceinline__ void ssm_chunk_end(const int wave_s, const float* ssmp, const bf16* proj, float* ssmE, LAS float* smem) {
  const int tid_ = opaque_tid(wave_s);
  const int lane = tid_ & 63;
  const int gw = blockIdx.x * NWAVES + (tid_ >> 6);
  const int nw = gridDim.x * NWAVES;
  for (int it = gw; it < 4 * 64 * 16; it += nw) {
    const int g = it & 15, c = (it >> 4) & 63, b = it >> 10;
    const int gp = g * 64 + lane;
    const uint4* up = (const uint4*)(proj + (size_t)(b * SEQ + c * 64 + lane) * DIN + 2048 + g * 16);
    const uint4 ua = up[0], ub = up[1];
    const float lbr = ssmp[gp * 2], lbi = ssmp[gp * 2 + 1];
    bf16x8_t bop[8];
    ssm_load_bop(ssmp, g, lane, bop);
    LAS unsigned char* xt = (LAS unsigned char*)smem + SSM_TILE_BASE + (tid_ >> 6) * SSM_TILE_BYTES;
    ssm_zero_pad(xt, lane);
    float xr = 0.f, xi = 0.f;
#pragma unroll 1
    for (int blk = 0; blk < 4; blk++) {
      ssm_bu_block(xt, lane, blk, ua, ub, bop);
#pragma unroll 4
      for (int tt = 0; tt < 16; tt++) {
        const f32x2_t bu = *(const LAS f32x2_t*)(xt + tt * SSM_RS + lane * 8);
        const float nr = lbr * xr - lbi * xi + bu[0];
        const float ni = lbr * xi + lbi * xr + bu[1];
        xr = nr; xi = ni;
      }
      __builtin_amdgcn_wave_barrier();
    }
    float* e = ssmE + ((size_t)((b * 64 + c) * 16 + g) * 64 + lane) * 2;
    e[0] = xr; e[1] = xi;
  }
}

__device__ __forceinline__ void ssm_finish(const int wave_s, const Params& p, int l, const float* ssmp, const bf16* proj,
                           const float* ssmE, bf16* y, LAS float* smem) {
  LAS bf16* Ytb = (LAS bf16*)smem;
  LAS float* ssq2 = smem + (64 * 264 * 2) / 4;
  LAS float* rstd2 = ssq2 + 512;
  const bf16* glT = (const bf16*)(p.ws + WS_WT + (size_t)l * WT_LAYER + WT_GLU);
  const int tid = opaque_tid(wave_s), lane = tid & 63, wave = tid >> 6;
  const float* cre = karg_in(13) + (size_t)l * 16 * 16 * 64;
  const float* cim = karg_in(14) + (size_t)l * 16 * 16 * 64;
  const float* dsk = karg_in(15) + l * 256;
  const float* glw = karg_in(16) + (size_t)l * 256 * 256;
  const float* glb = karg_in(17) + l * 256;
  const float* gg = karg_in(18) + l * 1024 + 768;
  for (int it = blockIdx.x; it < 256; it += gridDim.x) {
    const int b = it >> 6, c = it & 63;
    __syncthreads();
    for (int gi = 0; gi < 2; gi++) {
      const int g = wave + gi * 8;
      const int gp = g * 64 + lane;
      const float lbr = ssmp[gp * 2], lbi = ssmp[gp * 2 + 1];
      const float lcr = ssmp[2048 + gp * 2], lci = ssmp[2048 + gp * 2 + 1];
      bf16x8_t bop[8];
      ssm_load_bop(ssmp, g, lane, bop);
      bf16x8_t cop[5];
      {
        const int nn = lane & 15, q = lane >> 4;
#pragma unroll
        for (int ks = 0; ks < 4; ks++) {
          const float4 cr4 = *(const float4*)(cre + (g * 16 + nn) * 64 + 16 * ks + 4 * q);
          const float4 ci4 = *(const float4*)(cim + (g * 16 + nn) * 64 + 16 * ks + 4 * q);
          pg8::u32x4 w;
          w.x = pk2(cr4.x, -ci4.x); w.y = pk2(cr4.y, -ci4.y); w.z = pk2(cr4.z, -ci4.z); w.w = pk2(cr4.w, -ci4.w);
          cop[ks] = __builtin_bit_cast(bf16x8_t, w);
        }
        const float dn = dsk[g * 16 + nn];
        float dv[8];
#pragma unroll
        for (int j = 0; j < 8; j++) dv[j] = (8 * q + j == nn) ? dn : 0.f;
        pg8::u32x4 w;
        w.x = pk2(dv[0], dv[1]); w.y = pk2(dv[2], dv[3]); w.z = pk2(dv[4], dv[5]); w.w = pk2(dv[6], dv[7]);
        cop[4] = __builtin_bit_cast(bf16x8_t, w);
      }
      const uint4* up = (const uint4*)(proj + (size_t)(b * SEQ + c * 64 + lane) * DIN + 2048 + g * 16);
      const uint4 ua = up[0], ub = up[1];
      float xr = 0.f, xi = 0.f;
      {
        const float2* eb = (const float2*)ssmE + ((size_t)(b * 64) * 16 + g) * 64 + lane;
        for (int cc = 0; cc < c; cc += 16) {
          float2 ev[16];
#pragma unroll
          for (int k = 0; k < 16; k++) ev[k] = eb[(size_t)(cc + k < c ? cc + k : c - 1) * 16 * 64];
#pragma unroll
          for (int k = 0; k < 16; k++) {
            if (cc + k < c) {
              const float nr = lcr * xr - lci * xi + ev[k].x;
              const float ni = lcr * xi + lci * xr + ev[k].y;
              xr = nr; xi = ni;
            }
          }
        }
      }
      LAS unsigned char* xt = (LAS unsigned char*)smem + SSM_TILE_BASE + wave * SSM_TILE_BYTES;
      ssm_zero_pad(xt, lane);
#pragma unroll 1
      for (int blk = 0; blk < 4; blk++) {
        ssm_bu_block(xt, lane, blk, ua, ub, bop);
#pragma unroll 4
        for (int tt = 0; tt < 16; tt++) {
          const f32x2_t bu = *(const LAS f32x2_t*)(xt + tt * SSM_RS + lane * 8);
          const float nr = lbr * xr - lbi * xi + bu[0];
          const float ni = lbr * xi + lbi * xr + bu[1];
          xr = nr; xi = ni;
          *(LAS unsigned*)(xt + tt * SSM_RS + lane * 4) = pk2(xr, xi);
        }
        __builtin_amdgcn_wave_barrier();
        {
          pg8::f32x4 acc4;
          acc4[0] = 0.f; acc4[1] = 0.f; acc4[2] = 0.f; acc4[3] = 0.f;
          const LAS unsigned char* ar = xt + (lane & 15) * SSM_RS + (lane >> 4) * 16;
#pragma unroll
          for (int ks = 0; ks < 4; ks++)
            acc4 = __builtin_amdgcn_mfma_f32_16x16x32_bf16(*(const LAS bf16x8_t*)(ar + ks * 64), cop[ks], acc4, 0, 0, 0);
          acc4 = __builtin_amdgcn_mfma_f32_16x16x32_bf16(*(const LAS bf16x8_t*)(ar + 512), cop[4], acc4, 0, 0, 0);
#pragma unroll
          for (int j = 0; j < 4; j++)
            Ytb[(blk * 16 + 4 * (lane >> 4) + j) * 264 + g * 16 + (lane & 15)] = (bf16)f2bf(gelu_tanh(acc4[j]));
        }
        __builtin_amdgcn_wave_barrier();
      }
    }
    __syncthreads();
    {
      const int n = lane & 31, hh = lane >> 5;
      const int ch = wave * 32 + n;
      const float bj = glb[ch];
      const float gj = gg[ch];
      bf16x8_t gf[16];
      {
        const bf16* grow = glT + (size_t)ch * 256 + 8 * hh;
#pragma unroll
        for (int ks = 0; ks < 16; ks++) gf[ks] = *(const bf16x8_t*)(grow + 16 * ks);
      }
      float oo[2][16];
#pragma unroll
      for (int mt = 0; mt < 2; mt++) {
        f32x16_t z;
#pragma unroll
        for (int r = 0; r < 16; r++) z[r] = 0.f;
        const LAS bf16* yrow = Ytb + (mt * 32 + n) * 264 + 8 * hh;
#pragma unroll
        for (int kq = 0; kq < 4; kq++) {
          bf16x8_t yf[4];
#pragma unroll
          for (int i = 0; i < 4; i++) yf[i] = *(const LAS bf16x8_t*)(yrow + 16 * (kq * 4 + i));
          MFMA_PAD();
#pragma unroll
          for (int i = 0; i < 4; i++) z = __builtin_amdgcn_mfma_f32_32x32x16_bf16(yf[i], gf[kq * 4 + i], z, 0, 0, 0);
          MFMA_PAD();
        }
        float sq[16];
#pragma unroll
        for (int r = 0; r < 16; r++) {
          const int t = mt * 32 + (r & 3) + 8 * (r >> 2) + 4 * hh;
          const float yv = bf2f(Ytb[t * 264 + ch]);
          const float o = yv * sigmoidf_(z[r] + bj);
          oo[mt][r] = o;
          float v = o * o;
#pragma unroll
          for (int s = 16; s > 0; s >>= 1) v += __shfl_xor(v, s, 64);
          sq[r] = v;
        }
        if (n == 0) {
#pragma unroll
          for (int r = 0; r < 16; r++) ssq2[wave * 64 + mt * 32 + (r & 3) + 8 * (r >> 2) + 4 * hh] = sq[r];
        }
      }
      __syncthreads();
      if (tid < 64) {
        float t = 0.f;
#pragma unroll
        for (int w = 0; w < 8; w++) t += ssq2[w * 64 + tid];
        rstd2[tid] = rsqrtf(t * (1.0f / 256.f) + EPSF);
      }
      __syncthreads();
#pragma unroll
      for (int mt = 0; mt < 2; mt++)
#pragma unroll
        for (int r = 0; r < 16; r++) {
          const int t = mt * 32 + (r & 3) + 8 * (r >> 2) + 4 * hh;
          y[(size_t)(b * SEQ + c * 64 + t) * DM + 768 + ch] = (bf16)f2bf(oo[mt][r] * rstd2[t] * gj);
        }
    }
  }
}

__device__ __forceinline__ void memattn_phase(const int wave_s, const bf16* q, const bf16* kvb, const bf16* vT, bf16* o, LAS float* smem) {
  const int tid_ = opaque_tid(wave_s);
  const int lane = tid_ & 63, n = lane & 31, hh = lane >> 5, wave = tid_ >> 6;
  const int sig = (n & 0x13) | ((n & 4) << 1) | ((n & 8) >> 1);
  LAS bf16* Ls = (LAS bf16*)smem;
  for (int it = blockIdx.x; it < 64 * 4; it += gridDim.x) {
    const int h = it & 3, tg = it >> 2, b = tg >> 4;
    const int tok0 = (tg * 8 + wave) * 32;
    __syncthreads();
    {
      const int r = tid_ >> 1, hf = tid_ & 1;
      const pg8::u32x4* src4 = (const pg8::u32x4*)(kvb + (size_t)(b * NMEM + r) * 2048 + h * 256 + hf * 128);
      LAS pg8::u32x4* dst4 = (LAS pg8::u32x4*)(Ls + r * 264 + hf * 128);
#pragma unroll
      for (int k = 0; k < 16; k++) dst4[k] = src4[k];
    }
    f32x16_t st[8];
#pragma unroll
    for (int kt = 0; kt < 8; kt++)
#pragma unroll
      for (int r = 0; r < 16; r++) st[kt][r] = 0.f;
    const bf16* qrow = q + (size_t)(tok0 + n) * DM + h * 256 + 8 * hh;
    __syncthreads();
#pragma unroll
    for (int kq = 0; kq < 4; kq++) {
      bf16x8_t qf[4];
#pragma unroll
      for (int i = 0; i < 4; i++) qf[i] = *(const bf16x8_t*)(qrow + 16 * (kq * 4 + i));
#pragma unroll
      for (int kt = 0; kt < 8; kt++) {
        const LAS bf16* krow = Ls + (kt * 32 + sig) * 264 + 8 * hh;
        bf16x8_t kf[4];
#pragma unroll
        for (int i = 0; i < 4; i++) kf[i] = *(const LAS bf16x8_t*)(krow + 16 * (kq * 4 + i));
        MFMA_PAD();
#pragma unroll
        for (int i = 0; i < 4; i++) st[kt] = __builtin_amdgcn_mfma_f32_32x32x16_bf16(kf[i], qf[i], st[kt], 0, 0, 0);
        MFMA_PAD();
      }
    }
    float mx = st[0][0];
#pragma unroll
    for (int kt = 0; kt < 8; kt++)
#pragma unroll
      for (int r = 0; r < 16; r++) mx = fmaxf(mx, st[kt][r]);
    mx = fmaxf(mx, __shfl_xor(mx, 32, 64));
    float sum = 0.f;
#pragma unroll
    for (int kt = 0; kt < 8; kt++)
#pragma unroll
      for (int r = 0; r < 16; r++) { const float e = __expf((st[kt][r] - mx) * 0.0625f); st[kt][r] = e; sum += e; }
    sum += __shfl_xor(sum, 32, 64);
    const float inv = 1.0f / sum;
    bf16x8_t pf[8][2];
#pragma unroll
    for (int kt = 0; kt < 8; kt++)
#pragma unroll
      for (int s = 0; s < 2; s++)
#pragma unroll
        for (int j = 0; j < 8; j++) pf[kt][s][j] = (short)f2bf(st[kt][8 * s + j] * inv);
    __syncthreads();
    {
      const int r = tid_ >> 1, hf = tid_ & 1;
      const pg8::u32x4* src4 = (const pg8::u32x4*)(vT + ((size_t)(b * 4 + h) * 256 + r) * 256 + hf * 128);
      LAS pg8::u32x4* dst4 = (LAS pg8::u32x4*)(Ls + r * 264 + hf * 128);
#pragma unroll
      for (int k = 0; k < 16; k++) dst4[k] = src4[k];
    }
    __syncthreads();
#pragma unroll 1
    for (int dt = 0; dt < 8; dt++) {
      f32x16_t oacc;
#pragma unroll
      for (int r = 0; r < 16; r++) oacc[r] = 0.f;
      const LAS bf16* vrow = Ls + (dt * 32 + n) * 264 + 8 * hh;
#pragma unroll
      for (int kq = 0; kq < 4; kq++) {
        bf16x8_t vf[4];
#pragma unroll
        for (int i = 0; i < 4; i++) vf[i] = *(const LAS bf16x8_t*)(vrow + (kq * 2 + (i >> 1)) * 32 + 16 * (i & 1));
        MFMA_PAD();
#pragma unroll
        for (int i = 0; i < 4; i++) oacc = __builtin_amdgcn_mfma_f32_32x32x16_bf16(pf[kq * 2 + (i >> 1)][i & 1], vf[i], oacc, 0, 0, 0);
        MFMA_PAD();
      }
#pragma unroll
      for (int r = 0; r < 16; r++) {
        const int qi = (r & 3) + 8 * (r >> 2) + 4 * hh;
        o[(size_t)(tok0 + qi) * DM + h * 256 + dt * 32 + n] = (bf16)f2bf(oacc[r]);
      }
    }
  }
}

__device__ __forceinline__ void vt_phase(const int wave_s, const bf16* kvb, bf16* vT) {
  const int tid_ = opaque_tid(wave_s);
  const int gt = blockIdx.x * (NWAVES * 64) + tid_;
  const int nth = gridDim.x * NWAVES * 64;
  for (int i = gt; i < 2 * 4 * 4 * 256 * 256; i += nth) {
    const int m = i & 255, d = (i >> 8) & 255, h = (i >> 16) & 3, b = (i >> 18) & 3, l = i >> 20;
    vT[i] = kvb[((size_t)l * 1024 + b * 256 + m) * 2048 + 1024 + h * 256 + d];
  }
}

template <unsigned MASK>
__device__ __forceinline__ float pack_key(float s, unsigned idx) {
  const unsigned u = __builtin_bit_cast(unsigned, s);
  const unsigned tag = ((int)u < 0) ? idx : (MASK - idx);
  return __builtin_bit_cast(float, (u & ~MASK) + tag);
}
template <unsigned MASK>
__device__ __forceinline__ unsigned key_idx(float k) {
  const unsigned u = __builtin_bit_cast(unsigned, k);
  const unsigned tag = u & MASK;
  return ((int)u < 0) ? tag : (MASK - tag);
}
template <unsigned MASK>
__device__ __forceinline__ float key_val(float k) { return __builtin_bit_cast(float, __builtin_bit_cast(unsigned, k) & ~MASK); }
__device__ __forceinline__ void top16_of_64(float (&K)[64]) {
  { const float a_ = K[0], b_ = K[1]; const bool g_ = a_ > b_; K[0] = g_ ? a_ : b_; K[1] = g_ ? b_ : a_; }
  { const float a_ = K[2], b_ = K[3]; const bool g_ = a_ > b_; K[2] = g_ ? b_ : a_; K[3] = g_ ? a_ : b_; }
  { const float a_ = K[4], b_ = K[5]; const bool g_ = a_ > b_; K[4] = g_ ? a_ : b_; K[5] = g_ ? b_ : a_; }
  { const float a_ = K[6], b_ = K[7]; const bool g_ = a_ > b_; K[6] = g_ ? b_ : a_; K[7] = g_ ? a_ : b_; }
  { const float a_ = K[8], b_ = K[9]; const bool g_ = a_ > b_; K[8] = g_ ? a_ : b_; K[9] = g_ ? b_ : a_; }
  { const float a_ = K[10], b_ = K[11]; const bool g_ = a_ > b_; K[10] = g_ ? b_ : a_; K[11] = g_ ? a_ : b_; }
  { const float a_ = K[12], b_ = K[13]; const bool g_ = a_ > b_; K[12] = g_ ? a_ : b_; K[13] = g_ ? b_ : a_; }
  { const float a_ = K[14], b_ = K[15]; const bool g_ = a_ > b_; K[14] = g_ ? b_ : a_; K[15] = g_ ? a_ : b_; }
  { const float a_ = K[0], b_ = K[2]; const bool g_ = a_ > b_; K[0] = g_ ? a_ : b_; K[2] = g_ ? b_ : a_; }
  { const float a_ = K[1], b_ = K[3]; const bool g_ = a_ > b_; K[1] = g_ ? a_ : b_; K[3] = g_ ? b_ : a_; }
  { const float a_ = K[4], b_ = K[6]; const bool g_ = a_ > b_; K[4] = g_ ? b_ : a_; K[6] = g_ ? a_ : b_; }
  { const float a_ = K[5], b_ = K[7]; const bool g_ = a_ > b_; K[5] = g_ ? b_ : a_; K[7] = g_ ? a_ : b_; }
  { const float a_ = K[8], b_ = K[10]; const bool g_ = a_ > b_; K[8] = g_ ? a_ : b_; K[10] = g_ ? b_ : a_; }
  { const float a_ = K[9], b_ = K[11]; const bool g_ = a_ > b_; K[9] = g_ ? a_ : b_; K[11] = g_ ? b_ : a_; }
  { const float a_ = K[12], b_ = K[14]; const bool g_ = a_ > b_; K[12] = g_ ? b_ : a_; K[14] = g_ ? a_ : b_; }
  { const float a_ = K[13], b_ = K[15]; const bool g_ = a_ > b_; K[13] = g_ ? b_ : a_; K[15] = g_ ? a_ : b_; }
  { const float a_ = K[0], b_ = K[1]; const bool g_ = a_ > b_; K[0] = g_ ? a_ : b_; K[1] = g_ ? b_ : a_; }
  { const float a_ = K[2], b_ = K[3]; const bool g_ = a_ > b_; K[2] = g_ ? a_ : b_; K[3] = g_ ? b_ : a_; }
  { const float a_ = K[4], b_ = K[5]; const bool g_ = a_ > b_; K[4] = g_ ? b_ : a_; K[5] = g_ ? a_ : b_; }
  { const float a_ = K[6], b_ = K[7]; const bool g_ = a_ > b_; K[6] = g_ ? b_ : a_; K[7] = g_ ? a_ : b_; }
  { const float a_ = K[8], b_ = K[9]; const bool g_ = a_ > b_; K[8] = g_ ? a_ : b_; K[9] = g_ ? b_ : a_; }
  { const float a_ = K[10], b_ = K[11]; const bool g_ = a_ > b_; K[10] = g_ ? a_ : b_; K[11] = g_ ? b_ : a_; }
  { const float a_ = K[12], b_ = K[13]; const bool g_ = a_ > b_; K[12] = g_ ? b_ : a_; K[13] = g_ ? a_ : b_; }
  { const float a_ = K[14], b_ = K[15]; const bool g_ = a_ > b_; K[14] = g_ ? b_ : a_; K[15] = g_ ? a_ : b_; }
  { const float a_ = K[0], b_ = K[4]; const bool g_ = a_ > b_; K[0] = g_ ? a_ : b_; K[4] = g_ ? b_ : a_; }
  { const float a_ = K[1], b_ = K[5]; const bool g_ = a_ > b_; K[1] = g_ ? a_ : b_; K[5] = g_ ? b_ : a_; }
  { const float a_ = K[2], b_ = K[6]; const bool g_ = a_ > b_; K[2] = g_ ? a_ : b_; K[6] = g_ ? b_ : a_; }
  { const float a_ = K[3], b_ = K[7]; const bool g_ = a_ > b_; K[3] = g_ ? a_ : b_; K[7] = g_ ? b_ : a_; }
  { const float a_ = K[8], b_ = K[12]; const bool g_ = a_ > b_; K[8] = g_ ? b_ : a_; K[12] = g_ ? a_ : b_; }
  { const float a_ = K[9], b_ = K[13]; const bool g_ = a_ > b_; K[9] = g_ ? b_ : a_; K[13] = g_ ? a_ : b_; }
  { const float a_ = K[10], b_ = K[14]; const bool g_ = a_ > b_; K[10] = g_ ? b_ : a_; K[14] = g_ ? a_ : b_; }
  { const float a_ = K[11], b_ = K[15]; const bool g_ = a_ > b_; K[11] = g_ ? b_ : a_; K[15] = g_ ? a_ : b_; }
  { const float a_ = K[0], b_ = K[2]; const bool g_ = a_ > b_; K[0] = g_ ? a_ : b_; K[2] = g_ ? b_ : a_; }
  { const float a_ = K[1], b_ = K[3]; const bool g_ = a_ > b_; K[1] = g_ ? a_ : b_; K[3] = g_ ? b_ : a_; }
  { const float a_ = K[4], b_ = K[6]; const bool g_ = a_ > b_; K[4] = g_ ? a_ : b_; K[6] = g_ ? b_ : a_; }
  { const float a_ = K[5], b_ = K[7]; const bool g_ = a_ > b_; K[5] = g_ ? a_ : b_; K[7] = g_ ? b_ : a_; }
  { const float a_ = K[8], b_ = K[10]; const bool g_ = a_ > b_; K[8] = g_ ? b_ : a_; K[10] = g_ ? a_ : b_; }
  { const float a_ = K[9], b_ = K[11]; const bool g_ = a_ > b_; K[9] = g_ ? b_ : a_; K[11] = g_ ? a_ : b_; }
  { const float a_ = K[12], b_ = K[14]; const bool g_ = a_ > b_; K[12] = g_ ? b_ : a_; K[14] = g_ ? a_ : b_; }
  { const float a_ = K[13], b_ = K[15]; const bool g_ = a_ > b_; K[13] = g_ ? b_ : a_; K[15] = g_ ? a_ : b_; }
  { const float a_ = K[0], b_ = K[1]; const bool g_ = a_ > b_; K[0] = g_ ? a_ : b_; K[1] = g_ ? b_ : a_; }
  { const float a_ = K[2], b_ = K[3]; const bool g_ = a_ > b_; K[2] = g_ ? a_ : b_; K[3] = g_ ? b_ : a_; }
  { const float a_ = K[4], b_ = K[5]; const bool g_ = a_ > b_; K[4] = g_ ? a_ : b_; K[5] = g_ ? b_ : a_; }
  { const float a_ = K[6], b_ = K[7]; const bool g_ = a_ > b_; K[6] = g_ ? a_ : b_; K[7] = g_ ? b_ : a_; }
  { const float a_ = K[8], b_ = K[9]; const bool g_ = a_ > b_; K[8] = g_ ? b_ : a_; K[9] = g_ ? a_ : b_; }
  { const float a_ = K[10], b_ = K[11]; const bool g_ = a_ > b_; K[10] = g_ ? b_ : a_; K[11] = g_ ? a_ : b_; }
  { const float a_ = K[12], b_ = K[13]; const bool g_ = a_ > b_; K[12] = g_ ? b_ : a_; K[13] = g_ ? a_ : b_; }
  { const float a_ = K[14], b_ = K[15]; const bool g_ = a_ > b_; K[14] = g_ ? b_ : a_; K[15] = g_ ? a_ : b_; }
  { const float a_ = K[0], b_ = K[8]; const bool g_ = a_ > b_; K[0] = g_ ? a_ : b_; K[8] = g_ ? b_ : a_; }
  { const float a_ = K[1], b_ = K[9]; const bool g_ = a_ > b_; K[1] = g_ ? a_ : b_; K[9] = g_ ? b_ : a_; }
  { const float a_ = K[2], b_ = K[10]; const bool g_ = a_ > b_; K[2] = g_ ? a_ : b_; K[10] = g_ ? b_ : a_; }
  { const float a_ = K[3], b_ = K[11]; const bool g_ = a_ > b_; K[3] = g_ ? a_ : b_; K[11] = g_ ? b_ : a_; }
  { const float a_ = K[4], b_ = K[12]; const bool g_ = a_ > b_; K[4] = g_ ? a_ : b_; K[12] = g_ ? b_ : a_; }
  { const float a_ = K[5], b_ = K[13]; const bool g_ = a_ > b_; K[5] = g_ ? a_ : b_; K[13] = g_ ? b_ : a_; }
  { const float a_ = K[6], b_ = K[14]; const bool g_ = a_ > b_; K[6] = g_ ? a_ : b_; K[14] = g_ ? b_ : a_; }
  { const float a_ = K[7], b_ = K[15]; const bool g_ = a_ > b_; K[7] = g_ ? a_ : b_; K[15] = g_ ? b_ : a_; }
  { const float a_ = K[0], b_ = K[4]; const bool g_ = a_ > b_; K[0] = g_ ? a_ : b_; K[4] = g_ ? b_ : a_; }
  { const float a_ = K[1], b_ = K[5]; const bool g_ = a_ > b_; K[1] = g_ ? a_ : b_; K[5] = g_ ? b_ : a_; }
  { const float a_ = K[2], b_ = K[6]; const bool g_ = a_ > b_; K[2] = g_ ? a_ : b_; K[6] = g_ ? b_ : a_; }
  { const float a_ = K[3], b_ = K[7]; const bool g_ = a_ > b_; K[3] = g_ ? a_ : b_; K[7] = g_ ? b_ : a_; }
  { const float a_ = K[8], b_ = K[12]; const bool g_ = a_ > b_; K[8] = g_ ? a_ : b_; K[12] = g_ ? b_ : a_; }
  { const float a_ = K[9], b_ = K[13]; const bool g_ = a_ > b_; K[9] = g_ ? a_ : b_; K[13] = g_ ? b_ : a_; }
  { const float a_ = K[10], b_ = K[14]; const bool g_ = a_ > b_; K[10] = g_ ? a_ : b_; K[14] = g_ ? b_ : a_; }
  { const float a_ = K[11], b_ = K[15]; const bool g_ = a_ > b_; K[11] = g_ ? a_ : b_; K[15] = g_ ? b_ : a_; }
  { const float a_ = K[0], b_ = K[2]; const bool g_ = a_ > b_; K[0] = g_ ? a_ : b_; K[2] = g_ ? b_ : a_; }
  { const float a_ = K[1], b_ = K[3]; const bool g_ = a_ > b_; K[1] = g_ ? a_ : b_; K[3] = g_ ? b_ : a_; }
  { const float a_ = K[4], b_ = K[6]; const bool g_ = a_ > b_; K[4] = g_ ? a_ : b_; K[6] = g_ ? b_ : a_; }
  { const float a_ = K[5], b_ = K[7]; const bool g_ = a_ > b_; K[5] = g_ ? a_ : b_; K[7] = g_ ? b_ : a_; }
  { const float a_ = K[8], b_ = K[10]; const bool g_ = a_ > b_; K[8] = g_ ? a_ : b_; K[10] = g_ ? b_ : a_; }
  { const float a_ = K[9], b_ = K[11]; const bool g_ = a_ > b_; K[9] = g_ ? a_ : b_; K[11] = g_ ? b_ : a_; }
  { const float a_ = K[12], b_ = K[14]; const bool g_ = a_ > b_; K[12] = g_ ? a_ : b_; K[14] = g_ ? b_ : a_; }
  { const float a_ = K[13], b_ = K[15]; const bool g_ = a_ > b_; K[13] = g_ ? a_ : b_; K[15] = g_ ? b_ : a_; }
  { const float a_ = K[0], b_ = K[1]; const bool g_ = a_ > b_; K[0] = g_ ? a_ : b_; K[1] = g_ ? b_ : a_; }
  { const float a_ = K[2], b_ = K[3]; const bool g_ = a_ > b_; K[2] = g_ ? a_ : b_; K[3] = g_ ? b_ : a_; }
  { const float a_ = K[4], b_ = K[5]; const bool g_ = a_ > b_; K[4] = g_ ? a_ : b_; K[5] = g_ ? b_ : a_; }
  { const float a_ = K[6], b_ = K[7]; const bool g_ = a_ > b_; K[6] = g_ ? a_ : b_; K[7] = g_ ? b_ : a_; }
  { const float a_ = K[8], b_ = K[9]; const bool g_ = a_ > b_; K[8] = g_ ? a_ : b_; K[9] = g_ ? b_ : a_; }
  { const float a_ = K[10], b_ = K[11]; const bool g_ = a_ > b_; K[10] = g_ ? a_ : b_; K[11] = g_ ? b_ : a_; }
  { const float a_ = K[12], b_ = K[13]; const bool g_ = a_ > b_; K[12] = g_ ? a_ : b_; K[13] = g_ ? b_ : a_; }
  { const float a_ = K[14], b_ = K[15]; const bool g_ = a_ > b_; K[14] = g_ ? a_ : b_; K[15] = g_ ? b_ : a_; }
  { const float a_ = K[16], b_ = K[17]; const bool g_ = a_ > b_; K[16] = g_ ? a_ : b_; K[17] = g_ ? b_ : a_; }
  { const float a_ = K[18], b_ = K[19]; const bool g_ = a_ > b_; K[18] = g_ ? b_ : a_; K[19] = g_ ? a_ : b_; }
  { const float a_ = K[20], b_ = K[21]; const bool g_ = a_ > b_; K[20] = g_ ? a_ : b_; K[21] = g_ ? b_ : a_; }
  { const float a_ = K[22], b_ = K[23]; const bool g_ = a_ > b_; K[22] = g_ ? b_ : a_; K[23] = g_ ? a_ : b_; }
  { const float a_ = K[24], b_ = K[25]; const bool g_ = a_ > b_; K[24] = g_ ? a_ : b_; K[25] = g_ ? b_ : a_; }
  { const float a_ = K[26], b_ = K[27]; const bool g_ = a_ > b_; K[26] = g_ ? b_ : a_; K[27] = g_ ? a_ : b_; }
  { const float a_ = K[28], b_ = K[29]; const bool g_ = a_ > b_; K[28] = g_ ? a_ : b_; K[29] = g_ ? b_ : a_; }
  { const float a_ = K[30], b_ = K[31]; const bool g_ = a_ > b_; K[30] = g_ ? b_ : a_; K[31] = g_ ? a_ : b_; }
  { const float a_ = K[16], b_ = K[18]; const bool g_ = a_ > b_; K[16] = g_ ? a_ : b_; K[18] = g_ ? b_ : a_; }
  { const float a_ = K[17], b_ = K[19]; const bool g_ = a_ > b_; K[17] = g_ ? a_ : b_; K[19] = g_ ? b_ : a_; }
  { const float a_ = K[20], b_ = K[22]; const bool g_ = a_ > b_; K[20] = g_ ? b_ : a_; K[22] = g_ ? a_ : b_; }
  { const float a_ = K[21], b_ = K[23]; const bool g_ = a_ > b_; K[21] = g_ ? b_ : a_; K[23] = g_ ? a_ : b_; }
  { const float a_ = K[24], b_ = K[26]; const bool g_ = a_ > b_; K[24] = g_ ? a_ : b_; K[26] = g_ ? b_ : a_; }
  { const float a_ = K[25], b_ = K[27]; const bool g_ = a_ > b_; K[25] = g_ ? a_ : b_; K[27] = g_ ? b_ : a_; }
  { const float a_ = K[28], b_ = K[30]; const bool g_ = a_ > b_; K[28] = g_ ? b_ : a_; K[30] = g_ ? a_ : b_; }
  { const float a_ = K[29], b_ = K[31]; const bool g_ = a_ > b_; K[29] = g_ ? b_ : a_; K[31] = g_ ? a_ : b_; }
  { const float a_ = K[16], b_ = K[17]; const bool g_ = a_ > b_; K[16] = g_ ? a_ : b_; K[17] = g_ ? b_ : a_; }
  { const float a_ = K[18], b_ = K[19]; const bool g_ = a_ > b_; K[18] = g_ ? a_ : b_; K[19] = g_ ? b_ : a_; }
  { const float a_ = K[20], b_ = K[21]; const bool g_ = a_ > b_; K[20] = g_ ? b_ : a_; K[21] = g_ ? a_ : b_; }
  { const float a_ = K[22], b_ = K[23]; const bool g_ = a_ > b_; K[22] = g_ ? b_ : a_; K[23] = g_ ? a_ : b_; }
  { const float a_ = K[24], b_ = K[25]; const bool g_ = a_ > b_; K[24] = g_ ? a_ : b_; K[25] = g_ ? b_ : a_; }
  { const float a_ = K[26], b_ = K[27]; const bool g_ = a_ > b_; K[26] = g_ ? a_ : b_; K[27] = g_ ? b_ : a_; }
  { const float a_ = K[28], b_ = K[29]; const bool g_ = a_ > b_; K[28] = g_ ? b_ : a_; K[29] = g_ ? a_ : b_; }
  { const float a_ = K[30], b_ = K[31]; const bool g_ = a_ > b_; K[30] = g_ ? b_ : a_; K[31] = g_ ? a_ : b_; }
  { const float a_ = K[16], b_ = K[20]; const bool g_ = a_ > b_; K[16] = g_ ? a_ : b_; K[20] = g_ ? b_ : a_; }
  { const float a_ = K[17], b_ = K[21]; const bool g_ = a_ > b_; K[17] = g_ ? a_ : b_; K[21] = g_ ? b_ : a_; }
  { const float a_ = K[18], b_ = K[22]; const bool g_ = a_ > b_; K[18] = g_ ? a_ : b_; K[22] = g_ ? b_ : a_; }
  { const float a_ = K[19], b_ = K[23]; const bool g_ = a_ > b_; K[19] = g_ ? a_ : b_; K[23] = g_ ? b_ : a_; }
  { const float a_ = K[24], b_ = K[28]; const bool g_ = a_ > b_; K[24] = g_ ? b_ : a_; K[28] = g_ ? a_ : b_; }
  { const float a_ = K[25], b_ = K[29]; const bool g_ = a_ > b_; K[25] = g_ ? b_ : a_; K[29] = g_ ? a_ : b_; }
  { const float a_ = K[26], b_ = K[30]; const bool g_ = a_ > b_; K[26] = g_ ? b_ : a_; K[30] = g_ ? a_ : b_; }
  { const float a_ = K[27], b_ = K[31]; const bool g_ = a_ > b_; K[27] = g_ ? b_ : a_; K[31] = g_ ? a_ : b_; }
  { const float a_ = K[16], b_ = K[18]; const bool g_ = a_ > b_; K[16] = g_ ? a_ : b_; K[18] = g_ ? b_ : a_; }
  { const float a_ = K[17], b_ = K[19]; const bool g_ = a_ > b_; K[17] = g_ ? a_ : b_; K[19] = g_ ? b_ : a_; }
  { const float a_ = K[20], b_ = K[22]; const bool g_ = a_ > b_; K[20] = g_ ? a_ : b_; K[22] = g_ ? b_ : a_; }
  { const float a_ = K[21], b_ = K[23]; const bool g_ = a_ > b_; K[21] = g_ ? a_ : b_; K[23] = g_ ? b_ : a_; }
  { const float a_ = K[24], b_ = K[26]; const bool g_ = a_ > b_; K[24] = g_ ? b_ : a_; K[26] = g_ ? a_ : b_; }
  { const float a_ = K[25], b_ = K[27]; const bool g_ = a_ > b_; K[25] = g_ ? b_ : a_; K[27] = g_ ? a_ : b_; }
  { const float a_ = K[28], b_ = K[30]; const bool g_ = a_ > b_; K[28] = g_ ? b_ : a_; K[30] = g_ ? a_ : b_; }
  { const float a_ = K[29], b_ = K[31]; const bool g_ = a_ > b_; K[29] = g_ ? b_ : a_; K[31] = g_ ? a_ : b_; }
  { const float a_ = K[16], b_ = K[17]; const bool g_ = a_ > b_; K[16] = g_ ? a_ : b_; K[17] = g_ ? b_ : a_; }
  { const float a_ = K[18], b_ = K[19]; const bool g_ = a_ > b_; K[18] = g_ ? a_ : b_; K[19] = g_ ? b_ : a_; }
  { const float a_ = K[20], b_ = K[21]; const bool g_ = a_ > b_; K[20] = g_ ? a_ : b_; K[21] = g_ ? b_ : a_; }
  { const float a_ = K[22], b_ = K[23]; const bool g_ = a_ > b_; K[22] = g_ ? a_ : b_; K[23] = g_ ? b_ : a_; }
  { const float a_ = K[24], b_ = K[25]; const bool g_ = a_ > b_; K[24] = g_ ? b_ : a_; K[25] = g_ ? a_ : b_; }
  { const float a_ = K[26], b_ = K[27]; const bool g_ = a_ > b_; K[26] = g_ ? b_ : a_; K[27] = g_ ? a_ : b_; }
  { const float a_ = K[28], b_ = K[29]; const bool g_ = a_ > b_; K[28] = g_ ? b_ : a_; K[29] = g_ ? a_ : b_; }
  { const float a_ = K[30], b_ = K[31]; const bool g_ = a_ > b_; K[30] = g_ ? b_ : a_; K[31] = g_ ? a_ : b_; }
  { const float a_ = K[16], b_ = K[24]; const bool g_ = a_ > b_; K[16] = g_ ? a_ : b_; K[24] = g_ ? b_ : a_; }
  { const float a_ = K[17], b_ = K[25]; const bool g_ = a_ > b_; K[17] = g_ ? a_ : b_; K[25] = g_ ? b_ : a_; }
  { const float a_ = K[18], b_ = K[26]; const bool g_ = a_ > b_; K[18] = g_ ? a_ : b_; K[26] = g_ ? b_ : a_; }
  { const float a_ = K[19], b_ = K[27]; const bool g_ = a_ > b_; K[19] = g_ ? a_ : b_; K[27] = g_ ? b_ : a_; }
  { const float a_ = K[20], b_ = K[28]; const bool g_ = a_ > b_; K[20] = g_ ? a_ : b_; K[28] = g_ ? b_ : a_; }
  { const float a_ = K[21], b_ = K[29]; const bool g_ = a_ > b_; K[21] = g_ ? a_ : b_; K[29] = g_ ? b_ : a_; }
  { const float a_ = K[22], b_ = K[30]; const bool g_ = a_ > b_; K[22] = g_ ? a_ : b_; K[30] = g_ ? b_ : a_; }
  { const float a_ = K[23], b_ = K[31]; const bool g_ = a_ > b_; K[23] = g_ ? a_ : b_; K[31] = g_ ? b_ : a_; }
  { const float a_ = K[16], b_ = K[20]; const bool g_ = a_ > b_; K[16] = g_ ? a_ : b_; K[20] = g_ ? b_ : a_; }
  { const float a_ = K[17], b_ = K[21]; const bool g_ = a_ > b_; K[17] = g_ ? a_ : b_; K[21] = g_ ? b_ : a_; }
  { const float a_ = K[18], b_ = K[22]; const bool g_ = a_ > b_; K[18] = g_ ? a_ : b_; K[22] = g_ ? b_ : a_; }
  { const float a_ = K[19], b_ = K[23]; const bool g_ = a_ > b_; K[19] = g_ ? a_ : b_; K[23] = g_ ? b_ : a_; }
  { const float a_ = K[24], b_ = K[28]; const bool g_ = a_ > b_; K[24] = g_ ? a_ : b_; K[28] = g_ ? b_ : a_; }
  { const float a_ = K[25], b_ = K[29]; const bool g_ = a_ > b_; K[25] = g_ ? a_ : b_; K[29] = g_ ? b_ : a_; }
  { const float a_ = K[26], b_ = K[30]; const bool g_ = a_ > b_; K[26] = g_ ? a_ : b_; K[30] = g_ ? b_ : a_; }
  { const float a_ = K[27], b_ = K[31]; const bool g_ = a_ > b_; K[27] = g_ ? a_ : b_; K[31] = g_ ? b_ : a_; }
  { const float a_ = K[16], b_ = K[18]; const bool g_ = a_ > b_; K[16] = g_ ? a_ : b_; K[18] = g_ ? b_ : a_; }
  { const float a_ = K[17], b_ = K[19]; const bool g_ = a_ > b_; K[17] = g_ ? a_ : b_; K[19] = g_ ? b_ : a_; }
  { const float a_ = K[20], b_ = K[22]; const bool g_ = a_ > b_; K[20] = g_ ? a_ : b_; K[22] = g_ ? b_ : a_; }
  { const float a_ = K[21], b_ = K[23]; const bool g_ = a_ > b_; K[21] = g_ ? a_ : b_; K[23] = g_ ? b_ : a_; }
  { const float a_ = K[24], b_ = K[26]; const bool g_ = a_ > b_; K[24] = g_ ? a_ : b_; K[26] = g_ ? b_ : a_; }
  { const float a_ = K[25], b_ = K[27]; const bool g_ = a_ > b_; K[25] = g_ ? a_ : b_; K[27] = g_ ? b_ : a_; }
  { const float a_ = K[28], b_ = K[30]; const bool g_ = a_ > b_; K[28] = g_ ? a_ : b_; K[30] = g_ ? b_ : a_; }
  { const float a_ = K[29], b_ = K[31]; const bool g_ = a_ > b_; K[29] = g_ ? a_ : b_; K[31] = g_ ? b_ : a_; }
  { const float a_ = K[16], b_ = K[17]; const bool g_ = a_ > b_; K[16] = g_ ? a_ : b_; K[17] = g_ ? b_ : a_; }
  { const float a_ = K[18], b_ = K[19]; const bool g_ = a_ > b_; K[18] = g_ ? a_ : b_; K[19] = g_ ? b_ : a_; }
  { const float a_ = K[20], b_ = K[21]; const bool g_ = a_ > b_; K[20] = g_ ? a_ : b_; K[21] = g_ ? b_ : a_; }
  { const float a_ = K[22], b_ = K[23]; const bool g_ = a_ > b_; K[22] = g_ ? a_ : b_; K[23] = g_ ? b_ : a_; }
  { const float a_ = K[24], b_ = K[25]; const bool g_ = a_ > b_; K[24] = g_ ? a_ : b_; K[25] = g_ ? b_ : a_; }
  { const float a_ = K[26], b_ = K[27]; const bool g_ = a_ > b_; K[26] = g_ ? a_ : b_; K[27] = g_ ? b_ : a_; }
  { const float a_ = K[28], b_ = K[29]; const bool g_ = a_ > b_; K[28] = g_ ? a_ : b_; K[29] = g_ ? b_ : a_; }
  { const float a_ = K[30], b_ = K[31]; const bool g_ = a_ > b_; K[30] = g_ ? a_ : b_; K[31] = g_ ? b_ : a_; }
  { const float a_ = K[32], b_ = K[33]; const bool g_ = a_ > b_; K[32] = g_ ? a_ : b_; K[33] = g_ ? b_ : a_; }
  { const float a_ = K[34], b_ = K[35]; const bool g_ = a_ > b_; K[34] = g_ ? b_ : a_; K[35] = g_ ? a_ : b_; }
  { const float a_ = K[36], b_ = K[37]; const bool g_ = a_ > b_; K[36] = g_ ? a_ : b_; K[37] = g_ ? b_ : a_; }
  { const float a_ = K[38], b_ = K[39]; const bool g_ = a_ > b_; K[38] = g_ ? b_ : a_; K[39] = g_ ? a_ : b_; }
  { const float a_ = K[40], b_ = K[41]; const bool g_ = a_ > b_; K[40] = g_ ? a_ : b_; K[41] = g_ ? b_ : a_; }
  { const float a_ = K[42], b_ = K[43]; const bool g_ = a_ > b_; K[42] = g_ ? b_ : a_; K[43] = g_ ? a_ : b_; }
  { const float a_ = K[44], b_ = K[45]; const bool g_ = a_ > b_; K[44] = g_ ? a_ : b_; K[45] = g_ ? b_ : a_; }
  { const float a_ = K[46], b_ = K[47]; const bool g_ = a_ > b_; K[46] = g_ ? b_ : a_; K[47] = g_ ? a_ : b_; }
  { const float a_ = K[32], b_ = K[34]; const bool g_ = a_ > b_; K[32] = g_ ? a_ : b_; K[34] = g_ ? b_ : a_; }
  { const float a_ = K[33], b_ = K[35]; const bool g_ = a_ > b_; K[33] = g_ ? a_ : b_; K[35] = g_ ? b_ : a_; }
  { const float a_ = K[36], b_ = K[38]; const bool g_ = a_ > b_; K[36] = g_ ? b_ : a_; K[38] = g_ ? a_ : b_; }
  { const float a_ = K[37], b_ = K[39]; const bool g_ = a_ > b_; K[37] = g_ ? b_ : a_; K[39] = g_ ? a_ : b_; }
  { const float a_ = K[40], b_ = K[42]; const bool g_ = a_ > b_; K[40] = g_ ? a_ : b_; K[42] = g_ ? b_ : a_; }
  { const float a_ = K[41], b_ = K[43]; const bool g_ = a_ > b_; K[41] = g_ ? a_ : b_; K[43] = g_ ? b_ : a_; }
  { const float a_ = K[44], b_ = K[46]; const bool g_ = a_ > b_; K[44] = g_ ? b_ : a_; K[46] = g_ ? a_ : b_; }
  { const float a_ = K[45], b_ = K[47]; const bool g_ = a_ > b_; K[45] = g_ ? b_ : a_; K[47] = g_ ? a_ : b_; }
  { const float a_ = K[32], b_ = K[33]; const bool g_ = a_ > b_; K[32] = g_ ? a_ : b_; K[33] = g_ ? b_ : a_; }
  { const float a_ = K[34], b_ = K[35]; const bool g_ = a_ > b_; K[34] = g_ ? a_ : b_; K[35] = g_ ? b_ : a_; }
  { const float a_ = K[36], b_ = K[37]; const bool g_ = a_ > b_; K[36] = g_ ? b_ : a_; K[37] = g_ ? a_ : b_; }
  { const float a_ = K[38], b_ = K[39]; const bool g_ = a_ > b_; K[38] = g_ ? b_ : a_; K[39] = g_ ? a_ : b_; }
  { const float a_ = K[40], b_ = K[41]; const bool g_ = a_ > b_; K[40] = g_ ? a_ : b_; K[41] = g_ ? b_ : a_; }
  { const float a_ = K[42], b_ = K[43]; const bool g_ = a_ > b_; K[42] = g_ ? a_ : b_; K[43] = g_ ? b_ : a_; }
  { const float a_ = K[44], b_ = K[45]; const bool g_ = a_ > b_; K[44] = g_ ? b_ : a_; K[45] = g_ ? a_ : b_; }
  { const float a_ = K[46], b_ = K[47]; const bool g_ = a_ > b_; K[46] = g_ ? b_ : a_; K[47] = g_ ? a_ : b_; }
  { const float a_ = K[32], b_ = K[36]; const bool g_ = a_ > b_; K[32] = g_ ? a_ : b_; K[36] = g_ ? b_ : a_; }
  { const float a_ = K[33], b_ = K[37]; const bool g_ = a_ > b_; K[33] = g_ ? a_ : b_; K[37] = g_ ? b_ : a_; }
  { const float a_ = K[34], b_ = K[38]; const bool g_ = a_ > b_; K[34] = g_ ? a_ : b_; K[38] = g_ ? b_ : a_; }
  { const float a_ = K[35], b_ = K[39]; const bool g_ = a_ > b_; K[35] = g_ ? a_ : b_; K[39] = g_ ? b_ : a_; }
  { const float a_ = K[40], b_ = K[44]; const bool g_ = a_ > b_; K[40] = g_ ? b_ : a_; K[44] = g_ ? a_ : b_; }
  { const float a_ = K[41], b_ = K[45]; const bool g_ = a_ > b_; K[41] = g_ ? b_ : a_; K[45] = g_ ? a_ : b_; }
  { const float a_ = K[42], b_ = K[46]; const bool g_ = a_ > b_; K[42] = g_ ? b_ : a_; K[46] = g_ ? a_ : b_; }
  { const float a_ = K[43], b_ = K[47]; const bool g_ = a_ > b_; K[43] = g_ ? b_ : a_; K[47] = g_ ? a_ : b_; }
  { const float a_ = K[32], b_ = K[34]; const bool g_ = a_ > b_; K[32] = g_ ? a_ : b_; K[34] = g_ ? b_ : a_; }
  { const float a_ = K[33], b_ = K[35]; const bool g_ = a_ > b_; K[33] = g_ ? a_ : b_; K[35] = g_ ? b_ : a_; }
  { const float a_ = K[36], b_ = K[38]; const bool g_ = a_ > b_; K[36] = g_ ? a_ : b_; K[38] = g_ ? b_ : a_; }
  { const float a_ = K[37], b_ = K[39]; const bool g_ = a_ > b_; K[37] = g_ ? a_ : b_; K[39] = g_ ? b_ : a_; }
  { const float a_ = K[40], b_ = K[42]; const bool g_ = a_ > b_; K[40] = g_ ? b_ : a_; K[42] = g_ ? a_ : b_; }
  { const float a_ = K[41], b_ = K[43]; const bool g_ = a_ > b_; K[41] = g_ ? b_ : a_; K[43] = g_ ? a_ : b_; }
  { const float a_ = K[44], b_ = K[46]; const bool g_ = a_ > b_; K[44] = g_ ? b_ : a_; K[46] = g_ ? a_ : b_; }
  { const float a_ = K[45], b_ = K[47]; const bool g_ = a_ > b_; K[45] = g_ ? b_ : a_; K[47] = g_ ? a_ : b_; }
  { const float a_ = K[32], b_ = K[33]; const bool g_ = a_ > b_; K[32] = g_ ? a_ : b_; K[33] = g_ ? b_ : a_; }
  { const float a_ = K[34], b_ = K[35]; const bool g_ = a_ > b_; K[34] = g_ ? a_ : b_; K[35] = g_ ? b_ : a_; }
  { const float a_ = K[36], b_ = K[37]; const bool g_ = a_ > b_; K[36] = g_ ? a_ : b_; K[37] = g_ ? b_ : a_; }
  { const float a_ = K[38], b_ = K[39]; const bool g_ = a_ > b_; K[38] = g_ ? a_ : b_; K[39] = g_ ? b_ : a_; }
  { const float a_ = K[40], b_ = K[41]; const bool g_ = a_ > b_; K[40] = g_ ? b_ : a_; K[41] = g_ ? a_ : b_; }
  { const float a_ = K[42], b_ = K[43]; const bool g_ = a_ > b_; K[42] = g_ ? b_ : a_; K[43] = g_ ? a_ : b_; }
  { const float a_ = K[44], b_ = K[45]; const bool g_ = a_ > b_; K[44] = g_ ? b_ : a_; K[45] = g_ ? a_ : b_; }
  { const float a_ = K[46], b_ = K[47]; const bool g_ = a_ > b_; K[46] = g_ ? b_ : a_; K[47] = g_ ? a_ : b_; }
  { const float a_ = K[32], b_ = K[40]; const bool g_ = a_ > b_; K[32] = g_ ? a_ : b_; K[40] = g_ ? b_ : a_; }
  { const float a_ = K[33], b_ = K[41]; const bool g_ = a_ > b_; K[33] = g_ ? a_ : b_; K[41] = g_ ? b_ : a_; }
  { const float a_ = K[34], b_ = K[42]; const bool g_ = a_ > b_; K[34] = g_ ? a_ : b_; K[42] = g_ ? b_ : a_; }
  { const float a_ = K[35], b_ = K[43]; const bool g_ = a_ > b_; K[35] = g_ ? a_ : b_; K[43] = g_ ? b_ : a_; }
  { const float a_ = K[36], b_ = K[44]; const bool g_ = a_ > b_; K[36] = g_ ? a_ : b_; K[44] = g_ ? b_ : a_; }
  { const float a_ = K[37], b_ = K[45]; const bool g_ = a_ > b_; K[37] = g_ ? a_ : b_; K[45] = g_ ? b_ : a_; }
  { const float a_ = K[38], b_ = K[46]; const bool g_ = a_ > b_; K[38] = g_ ? a_ : b_; K[46] = g_ ? b_ : a_; }
  { const float a_ = K[39], b_ = K[47]; const bool g_ = a_ > b_; K[39] = g_ ? a_ : b_; K[47] = g_ ? b_ : a_; }
  { const float a_ = K[32], b_ = K[36]; const bool g_ = a_ > b_; K[32] = g_ ? a_ : b_; K[36] = g_ ? b_ : a_; }
  { const float a_ = K[33], b_ = K[37]; const bool g_ = a_ > b_; K[33] = g_ ? a_ : b_; K[37] = g_ ? b_ : a_; }
  { const float a_ = K[34], b_ = K[38]; const bool g_ = a_ > b_; K[34] = g_ ? a_ : b_; K[38] = g_ ? b_ : a_; }
  { const float a_ = K[35], b_ = K[39]; const bool g_ = a_ > b_; K[35] = g_ ? a_ : b_; K[39] = g_ ? b_ : a_; }
  { const float a_ = K[40], b_ = K[44]; const bool g_ = a_ > b_; K[40] = g_ ? a_ : b_; K[44] = g_ ? b_ : a_; }
  { const float a_ = K[41], b_ = K[45]; const bool g_ = a_ > b_; K[41] = g_ ? a_ : b_; K[45] = g_ ? b_ : a_; }
  { const float a_ = K[42], b_ = K[46]; const bool g_ = a_ > b_; K[42] = g_ ? a_ : b_; K[46] = g_ ? b_ : a_; }
  { const float a_ = K[43], b_ = K[47]; const bool g_ = a_ > b_; K[43] = g_ ? a_ : b_; K[47] = g_ ? b_ : a_; }
  { const float a_ = K[32], b_ = K[34]; const bool g_ = a_ > b_; K[32] = g_ ? a_ : b_; K[34] = g_ ? b_ : a_; }
  { const float a_ = K[33], b_ = K[35]; const bool g_ = a_ > b_; K[33] = g_ ? a_ : b_; K[35] = g_ ? b_ : a_; }
  { const float a_ = K[36], b_ = K[38]; const bool g_ = a_ > b_; K[36] = g_ ? a_ : b_; K[38] = g_ ? b_ : a_; }
  { const float a_ = K[37], b_ = K[39]; const bool g_ = a_ > b_; K[37] = g_ ? a_ : b_; K[39] = g_ ? b_ : a_; }
  { const float a_ = K[40], b_ = K[42]; const bool g_ = a_ > b_; K[40] = g_ ? a_ : b_; K[42] = g_ ? b_ : a_; }
  { const float a_ = K[41], b_ = K[43]; const bool g_ = a_ > b_; K[41] = g_ ? a_ : b_; K[43] = g_ ? b_ : a_; }
  { const float a_ = K[44], b_ = K[46]; const bool g_ = a_ > b_; K[44] = g_ ? a_ : b_; K[46] = g_ ? b_ : a_; }
  { const float a_ = K[45], b_ = K[47]; const bool g_ = a_ > b_; K[45] = g_ ? a_ : b_; K[47] = g_ ? b_ : a_; }
  { const float a_ = K[32], b_ = K[33]; const bool g_ = a_ > b_; K[32] = g_ ? a_ : b_; K[33] = g_ ? b_ : a_; }
  { const float a_ = K[34], b_ = K[35]; const bool g_ = a_ > b_; K[34] = g_ ? a_ : b_; K[35] = g_ ? b_ : a_; }
  { const float a_ = K[36], b_ = K[37]; const bool g_ = a_ > b_; K[36] = g_ ? a_ : b_; K[37] = g_ ? b_ : a_; }
  { const float a_ = K[38], b_ = K[39]; const bool g_ = a_ > b_; K[38] = g_ ? a_ : b_; K[39] = g_ ? b_ : a_; }
  { const float a_ = K[40], b_ = K[41]; const bool g_ = a_ > b_; K[40] = g_ ? a_ : b_; K[41] = g_ ? b_ : a_; }
  { const float a_ = K[42], b_ = K[43]; const bool g_ = a_ > b_; K[42] = g_ ? a_ : b_; K[43] = g_ ? b_ : a_; }
  { const float a_ = K[44], b_ = K[45]; const bool g_ = a_ > b_; K[44] = g_ ? a_ : b_; K[45] = g_ ? b_ : a_; }
  { const float a_ = K[46], b_ = K[47]; const bool g_ = a_ > b_; K[46] = g_ ? a_ : b_; K[47] = g_ ? b_ : a_; }
  { const float a_ = K[48], b_ = K[49]; const bool g_ = a_ > b_; K[48] = g_ ? a_ : b_; K[49] = g_ ? b_ : a_; }
  { const float a_ = K[50], b_ = K[51]; const bool g_ = a_ > b_; K[50] = g_ ? b_ : a_; K[51] = g_ ? a_ : b_; }
  { const float a_ = K[52], b_ = K[53]; const bool g_ = a_ > b_; K[52] = g_ ? a_ : b_; K[53] = g_ ? b_ : a_; }
  { const float a_ = K[54], b_ = K[55]; const bool g_ = a_ > b_; K[54] = g_ ? b_ : a_; K[55] = g_ ? a_ : b_; }
  { const float a_ = K[56], b_ = K[57]; const bool g_ = a_ > b_; K[56] = g_ ? a_ : b_; K[57] = g_ ? b_ : a_; }
  { const float a_ = K[58], b_ = K[59]; const bool g_ = a_ > b_; K[58] = g_ ? b_ : a_; K[59] = g_ ? a_ : b_; }
  { const float a_ = K[60], b_ = K[61]; const bool g_ = a_ > b_; K[60] = g_ ? a_ : b_; K[61] = g_ ? b_ : a_; }
  { const float a_ = K[62], b_ = K[63]; const bool g_ = a_ > b_; K[62] = g_ ? b_ : a_; K[63] = g_ ? a_ : b_; }
  { const float a_ = K[48], b_ = K[50]; const bool g_ = a_ > b_; K[48] = g_ ? a_ : b_; K[50] = g_ ? b_ : a_; }
  { const float a_ = K[49], b_ = K[51]; const bool g_ = a_ > b_; K[49] = g_ ? a_ : b_; K[51] = g_ ? b_ : a_; }
  { const float a_ = K[52], b_ = K[54]; const bool g_ = a_ > b_; K[52] = g_ ? b_ : a_; K[54] = g_ ? a_ : b_; }
  { const float a_ = K[53], b_ = K[55]; const bool g_ = a_ > b_; K[53] = g_ ? b_ : a_; K[55] = g_ ? a_ : b_; }
  { const float a_ = K[56], b_ = K[58]; const bool g_ = a_ > b_; K[56] = g_ ? a_ : b_; K[58] = g_ ? b_ : a_; }
  { const float a_ = K[57], b_ = K[59]; const bool g_ = a_ > b_; K[57] = g_ ? a_ : b_; K[59] = g_ ? b_ : a_; }
  { const float a_ = K[60], b_ = K[62]; const bool g_ = a_ > b_; K[60] = g_ ? b_ : a_; K[62] = g_ ? a_ : b_; }
  { const float a_ = K[61], b_ = K[63]; const bool g_ = a_ > b_; K[61] = g_ ? b_ : a_; K[63] = g_ ? a_ : b_; }
  { const float a_ = K[48], b_ = K[49]; const bool g_ = a_ > b_; K[48] = g_ ? a_ : b_; K[49] = g_ ? b_ : a_; }
  { const float a_ = K[50], b_ = K[51]; const bool g_ = a_ > b_; K[50] = g_ ? a_ : b_; K[51] = g_ ? b_ : a_; }
  { const float a_ = K[52], b_ = K[53]; const bool g_ = a_ > b_; K[52] = g_ ? b_ : a_; K[53] = g_ ? a_ : b_; }
  { const float a_ = K[54], b_ = K[55]; const bool g_ = a_ > b_; K[54] = g_ ? b_ : a_; K[55] = g_ ? a_ : b_; }
  { const float a_ = K[56], b_ = K[57]; const bool g_ = a_ > b_; K[56] = g_ ? a_ : b_; K[57] = g_ ? b_ : a_; }
  { const float a_ = K[58], b_ = K[59]; const bool g_ = a_ > b_; K[58] = g_ ? a_ : b_; K[59] = g_ ? b_ : a_; }
  { const float a_ = K[60], b_ = K[61]; const bool g_ = a_ > b_; K[60] = g_ ? b_ : a_; K[61] = g_ ? a_ : b_; }
  { const float a_ = K[62], b_ = K[63]; const bool g_ = a_ > b_; K[62] = g_ ? b_ : a_; K[63] = g_ ? a_ : b_; }
  { const float a_ = K[48], b_ = K[52]; const bool g_ = a_ > b_; K[48] = g_ ? a_ : b_; K[52] = g_ ? b_ : a_; }
  { const float a_ = K[49], b_ = K[53]; const bool g_ = a_ > b_; K[49] = g_ ? a_ : b_; K[53] = g_ ? b_ : a_; }
  { const float a_ = K[50], b_ = K[54]; const bool g_ = a_ > b_; K[50] = g_ ? a_ : b_; K[54] = g_ ? b_ : a_; }
  { const float a_ = K[51], b_ = K[55]; const bool g_ = a_ > b_; K[51] = g_ ? a_ : b_; K[55] = g_ ? b_ : a_; }
  { const float a_ = K[56], b_ = K[60]; const bool g_ = a_ > b_; K[56] = g_ ? b_ : a_; K[60] = g_ ? a_ : b_; }
  { const float a_ = K[57], b_ = K[61]; const bool g_ = a_ > b_; K[57] = g_ ? b_ : a_; K[61] = g_ ? a_ : b_; }
  { const float a_ = K[58], b_ = K[62]; const bool g_ = a_ > b_; K[58] = g_ ? b_ : a_; K[62] = g_ ? a_ : b_; }
  { const float a_ = K[59], b_ = K[63]; const bool g_ = a_ > b_; K[59] = g_ ? b_ : a_; K[63] = g_ ? a_ : b_; }
  { const float a_ = K[48], b_ = K[50]; const bool g_ = a_ > b_; K[48] = g_ ? a_ : b_; K[50] = g_ ? b_ : a_; }
  { const float a_ = K[49], b_ = K[51]; const bool g_ = a_ > b_; K[49] = g_ ? a_ : b_; K[51] = g_ ? b_ : a_; }
  { const float a_ = K[52], b_ = K[54]; const bool g_ = a_ > b_; K[52] = g_ ? a_ : b_; K[54] = g_ ? b_ : a_; }
  { const float a_ = K[53], b_ = K[55]; const bool g_ = a_ > b_; K[53] = g_ ? a_ : b_; K[55] = g_ ? b_ : a_; }
  { const float a_ = K[56], b_ = K[58]; const bool g_ = a_ > b_; K[56] = g_ ? b_ : a_; K[58] = g_ ? a_ : b_; }
  { const float a_ = K[57], b_ = K[59]; const bool g_ = a_ > b_; K[57] = g_ ? b_ : a_; K[59] = g_ ? a_ : b_; }
  { const float a_ = K[60], b_ = K[62]; const bool g_ = a_ > b_; K[60] = g_ ? b_ : a_; K[62] = g_ ? a_ : b_; }
  { const float a_ = K[61], b_ = K[63]; const bool g_ = a_ > b_; K[61] = g_ ? b_ : a_; K[63] = g_ ? a_ : b_; }
  { const float a_ = K[48], b_ = K[49]; const bool g_ = a_ > b_; K[48] = g_ ? a_ : b_; K[49] = g_ ? b_ : a_; }
  { const float a_ = K[50], b_ = K[51]; const bool g_ = a_ > b_; K[50] = g_ ? a_ : b_; K[51] = g_ ? b_ : a_; }
  { const float a_ = K[52], b_ = K[53]; const bool g_ = a_ > b_; K[52] = g_ ? a_ : b_; K[53] = g_ ? b_ : a_; }
  { const float a_ = K[54], b_ = K[55]; const bool g_ = a_ > b_; K[54] = g_ ? a_ : b_; K[55] = g_ ? b_ : a_; }
  { const float a_ = K[56], b_ = K[57]; const bool g_ = a_ > b_; K[56] = g_ ? b_ : a_; K[57] = g_ ? a_ : b_; }
  { const float a_ = K[58], b_ = K[59]; const bool g_ = a_ > b_; K[58] = g_ ? b_ : a_; K[59] = g_ ? a_ : b_; }
  { const float a_ = K[60], b_ = K[61]; const bool g_ = a_ > b_; K[60] = g_ ? b_ : a_; K[61] = g_ ? a_ : b_; }
  { const float a_ = K[62], b_ = K[63]; const bool g_ = a_ > b_; K[62] = g_ ? b_ : a_; K[63] = g_ ? a_ : b_; }
  { const float a_ = K[48], b_ = K[56]; const bool g_ = a_ > b_; K[48] = g_ ? a_ : b_; K[56] = g_ ? b_ : a_; }
  { const float a_ = K[49], b_ = K[57]; const bool g_ = a_ > b_; K[49] = g_ ? a_ : b_; K[57] = g_ ? b_ : a_; }
  { const float a_ = K[50], b_ = K[58]; const bool g_ = a_ > b_; K[50] = g_ ? a_ : b_; K[58] = g_ ? b_ : a_; }
  { const float a_ = K[51], b_ = K[59]; const bool g_ = a_ > b_; K[51] = g_ ? a_ : b_; K[59] = g_ ? b_ : a_; }
  { const float a_ = K[52], b_ = K[60]; const bool g_ = a_ > b_; K[52] = g_ ? a_ : b_; K[60] = g_ ? b_ : a_; }
  { const float a_ = K[53], b_ = K[61]; const bool g_ = a_ > b_; K[53] = g_ ? a_ : b_; K[61] = g_ ? b_ : a_; }
  { const float a_ = K[54], b_ = K[62]; const bool g_ = a_ > b_; K[54] = g_ ? a_ : b_; K[62] = g_ ? b_ : a_; }
  { const float a_ = K[55], b_ = K[63]; const bool g_ = a_ > b_; K[55] = g_ ? a_ : b_; K[63] = g_ ? b_ : a_; }
  { const float a_ = K[48], b_ = K[52]; const bool g_ = a_ > b_; K[48] = g_ ? a_ : b_; K[52] = g_ ? b_ : a_; }
  { const float a_ = K[49], b_ = K[53]; const bool g_ = a_ > b_; K[49] = g_ ? a_ : b_; K[53] = g_ ? b_ : a_; }
  { const float a_ = K[50], b_ = K[54]; const bool g_ = a_ > b_; K[50] = g_ ? a_ : b_; K[54] = g_ ? b_ : a_; }
  { const float a_ = K[51], b_ = K[55]; const bool g_ = a_ > b_; K[51] = g_ ? a_ : b_; K[55] = g_ ? b_ : a_; }
  { const float a_ = K[56], b_ = K[60]; const bool g_ = a_ > b_; K[56] = g_ ? a_ : b_; K[60] = g_ ? b_ : a_; }
  { const float a_ = K[57], b_ = K[61]; const bool g_ = a_ > b_; K[57] = g_ ? a_ : b_; K[61] = g_ ? b_ : a_; }
  { const float a_ = K[58], b_ = K[62]; const bool g_ = a_ > b_; K[58] = g_ ? a_ : b_; K[62] = g_ ? b_ : a_; }
  { const float a_ = K[59], b_ = K[63]; const bool g_ = a_ > b_; K[59] = g_ ? a_ : b_; K[63] = g_ ? b_ : a_; }
  { const float a_ = K[48], b_ = K[50]; const bool g_ = a_ > b_; K[48] = g_ ? a_ : b_; K[50] = g_ ? b_ : a_; }
  { const float a_ = K[49], b_ = K[51]; const bool g_ = a_ > b_; K[49] = g_ ? a_ : b_; K[51] = g_ ? b_ : a_; }
  { const float a_ = K[52], b_ = K[54]; const bool g_ = a_ > b_; K[52] = g_ ? a_ : b_; K[54] = g_ ? b_ : a_; }
  { const float a_ = K[53], b_ = K[55]; const bool g_ = a_ > b_; K[53] = g_ ? a_ : b_; K[55] = g_ ? b_ : a_; }
  { const float a_ = K[56], b_ = K[58]; const bool g_ = a_ > b_; K[56] = g_ ? a_ : b_; K[58] = g_ ? b_ : a_; }
  { const float a_ = K[57], b_ = K[59]; const bool g_ = a_ > b_; K[57] = g_ ? a_ : b_; K[59] = g_ ? b_ : a_; }
  { const float a_ = K[60], b_ = K[62]; const bool g_ = a_ > b_; K[60] = g_ ? a_ : b_; K[62] = g_ ? b_ : a_; }
  { const float a_ = K[61], b_ = K[63]; const bool g_ = a_ > b_; K[61] = g_ ? a_ : b_; K[63] = g_ ? b_ : a_; }
  { const float a_ = K[48], b_ = K[49]; const bool g_ = a_ > b_; K[48] = g_ ? a_ : b_; K[49] = g_ ? b_ : a_; }
  { const float a_ = K[50], b_ = K[51]; const bool g_ = a_ > b_; K[50] = g_ ? a_ : b_; K[51] = g_ ? b_ : a_; }
  { const float a_ = K[52], b_ = K[53]; const bool g_ = a_ > b_; K[52] = g_ ? a_ : b_; K[53] = g_ ? b_ : a_; }
  { const float a_ = K[54], b_ = K[55]; const bool g_ = a_ > b_; K[54] = g_ ? a_ : b_; K[55] = g_ ? b_ : a_; }
  { const float a_ = K[56], b_ = K[57]; const bool g_ = a_ > b_; K[56] = g_ ? a_ : b_; K[57] = g_ ? b_ : a_; }
  { const float a_ = K[58], b_ = K[59]; const bool g_ = a_ > b_; K[58] = g_ ? a_ : b_; K[59] = g_ ? b_ : a_; }
  { const float a_ = K[60], b_ = K[61]; const bool g_ = a_ > b_; K[60] = g_ ? a_ : b_; K[61] = g_ ? b_ : a_; }
  { const float a_ = K[62], b_ = K[63]; const bool g_ = a_ > b_; K[62] = g_ ? a_ : b_; K[63] = g_ ? b_ : a_; }
  { const float a_ = K[0], b_ = K[31]; K[0] = a_ > b_ ? a_ : b_; }
  { const float a_ = K[1], b_ = K[30]; K[1] = a_ > b_ ? a_ : b_; }
  { const float a_ = K[2], b_ = K[29]; K[2] = a_ > b_ ? a_ : b_; }
  { const float a_ = K[3], b_ = K[28]; K[3] = a_ > b_ ? a_ : b_; }
  { const float a_ = K[4], b_ = K[27]; K[4] = a_ > b_ ? a_ : b_; }
  { const float a_ = K[5], b_ = K[26]; K[5] = a_ > b_ ? a_ : b_; }
  { const float a_ = K[6], b_ = K[25]; K[6] = a_ > b_ ? a_ : b_; }
  { const float a_ = K[7], b_ = K[24]; K[7] = a_ > b_ ? a_ : b_; }
  { const float a_ = K[8], b_ = K[23]; K[8] = a_ > b_ ? a_ : b_; }
  { const float a_ = K[9], b_ = K[22]; K[9] = a_ > b_ ? a_ : b_; }
  { const float a_ = K[10], b_ = K[21]; K[10] = a_ > b_ ? a_ : b_; }
  { const float a_ = K[11], b_ = K[20]; K[11] = a_ > b_ ? a_ : b_; }
  { const float a_ = K[12], b_ = K[19]; K[12] = a_ > b_ ? a_ : b_; }
  { const float a_ = K[13], b_ = K[18]; K[13] = a_ > b_ ? a_ : b_; }
  { const float a_ = K[14], b_ = K[17]; K[14] = a_ > b_ ? a_ : b_; }
  { const float a_ = K[15], b_ = K[16]; K[15] = a_ > b_ ? a_ : b_; }
  { const float a_ = K[0], b_ = K[8]; const bool g_ = a_ > b_; K[0] = g_ ? a_ : b_; K[8] = g_ ? b_ : a_; }
  { const float a_ = K[1], b_ = K[9]; const bool g_ = a_ > b_; K[1] = g_ ? a_ : b_; K[9] = g_ ? b_ : a_; }
  { const float a_ = K[2], b_ = K[10]; const bool g_ = a_ > b_; K[2] = g_ ? a_ : b_; K[10] = g_ ? b_ : a_; }
  { const float a_ = K[3], b_ = K[11]; const bool g_ = a_ > b_; K[3] = g_ ? a_ : b_; K[11] = g_ ? b_ : a_; }
  { const float a_ = K[4], b_ = K[12]; const bool g_ = a_ > b_; K[4] = g_ ? a_ : b_; K[12] = g_ ? b_ : a_; }
  { const float a_ = K[5], b_ = K[13]; const bool g_ = a_ > b_; K[5] = g_ ? a_ : b_; K[13] = g_ ? b_ : a_; }
  { const float a_ = K[6], b_ = K[14]; const bool g_ = a_ > b_; K[6] = g_ ? a_ : b_; K[14] = g_ ? b_ : a_; }
  { const float a_ = K[7], b_ = K[15]; const bool g_ = a_ > b_; K[7] = g_ ? a_ : b_; K[15] = g_ ? b_ : a_; }
  { const float a_ = K[0], b_ = K[4]; const bool g_ = a_ > b_; K[0] = g_ ? a_ : b_; K[4] = g_ ? b_ : a_; }
  { const float a_ = K[1], b_ = K[5]; const bool g_ = a_ > b_; K[1] = g_ ? a_ : b_; K[5] = g_ ? b_ : a_; }
  { const float a_ = K[2], b_ = K[6]; const bool g_ = a_ > b_; K[2] = g_ ? a_ : b_; K[6] = g_ ? b_ : a_; }
  { const float a_ = K[3], b_ = K[7]; const bool g_ = a_ > b_; K[3] = g_ ? a_ : b_; K[7] = g_ ? b_ : a_; }
  { const float a_ = K[8], b_ = K[12]; const bool g_ = a_ > b_; K[8] = g_ ? a_ : b_; K[12] = g_ ? b_ : a_; }
  { const float a_ = K[9], b_ = K[13]; const bool g_ = a_ > b_; K[9] = g_ ? a_ : b_; K[13] = g_ ? b_ : a_; }
  { const float a_ = K[10], b_ = K[14]; const bool g_ = a_ > b_; K[10] = g_ ? a_ : b_; K[14] = g_ ? b_ : a_; }
  { const float a_ = K[11], b_ = K[15]; const bool g_ = a_ > b_; K[11] = g_ ? a_ : b_; K[15] = g_ ? b_ : a_; }
  { const float a_ = K[0], b_ = K[2]; const bool g_ = a_ > b_; K[0] = g_ ? a_ : b_; K[2] = g_ ? b_ : a_; }
  { const float a_ = K[1], b_ = K[3]; const bool g_ = a_ > b_; K[1] = g_ ? a_ : b_; K[3] = g_ ? b_ : a_; }
  { const float a_ = K[4], b_ = K[6]; const bool g_ = a_ > b_; K[4] = g_ ? a_ : b_; K[6] = g_ ? b_ : a_; }
  { const float a_ = K[5], b_ = K[7]; const bool g_ = a_ > b_; K[5] = g_ ? a_ : b_; K[7] = g_ ? b_ : a_; }
  { const float a_ = K[8], b_ = K[10]; const bool g_ = a_ > b_; K[8] = g_ ? a_ : b_; K[10] = g_ ? b_ : a_; }
  { const float a_ = K[9], b_ = K[11]; const bool g_ = a_ > b_; K[9] = g_ ? a_ : b_; K[11] = g_ ? b_ : a_; }
  { const float a_ = K[12], b_ = K[14]; const bool g_ = a_ > b_; K[12] = g_ ? a_ : b_; K[14] = g_ ? b_ : a_; }
  { const float a_ = K[13], b_ = K[15]; const bool g_ = a_ > b_; K[13] = g_ ? a_ : b_; K[15] = g_ ? b_ : a_; }
  { const float a_ = K[0], b_ = K[1]; const bool g_ = a_ > b_; K[0] = g_ ? a_ : b_; K[1] = g_ ? b_ : a_; }
  { const float a_ = K[2], b_ = K[3]; const bool g_ = a_ > b_; K[2] = g_ ? a_ : b_; K[3] = g_ ? b_ : a_; }
  { const float a_ = K[4], b_ = K[5]; const bool g_ = a_ > b_; K[4] = g_ ? a_ : b_; K[5] = g_ ? b_ : a_; }
  { const float a_ = K[6], b_ = K[7]; const bool g_ = a_ > b_; K[6] = g_ ? a_ : b_; K[7] = g_ ? b_ : a_; }
  { const float a_ = K[8], b_ = K[9]; const bool g_ = a_ > b_; K[8] = g_ ? a_ : b_; K[9] = g_ ? b_ : a_; }
  { const float a_ = K[10], b_ = K[11]; const bool g_ = a_ > b_; K[10] = g_ ? a_ : b_; K[11] = g_ ? b_ : a_; }
  { const float a_ = K[12], b_ = K[13]; const bool g_ = a_ > b_; K[12] = g_ ? a_ : b_; K[13] = g_ ? b_ : a_; }
  { const float a_ = K[14], b_ = K[15]; const bool g_ = a_ > b_; K[14] = g_ ? a_ : b_; K[15] = g_ ? b_ : a_; }
  { const float a_ = K[32], b_ = K[63]; K[32] = a_ > b_ ? a_ : b_; }
  { const float a_ = K[33], b_ = K[62]; K[33] = a_ > b_ ? a_ : b_; }
  { const float a_ = K[34], b_ = K[61]; K[34] = a_ > b_ ? a_ : b_; }
  { const float a_ = K[35], b_ = K[60]; K[35] = a_ > b_ ? a_ : b_; }
  { const float a_ = K[36], b_ = K[59]; K[36] = a_ > b_ ? a_ : b_; }
  { const float a_ = K[37], b_ = K[58]; K[37] = a_ > b_ ? a_ : b_; }
  { const float a_ = K[38], b_ = K[57]; K[38] = a_ > b_ ? a_ : b_; }
  { const float a_ = K[39], b_ = K[56]; K[39] = a_ > b_ ? a_ : b_; }
  { const float a_ = K[40], b_ = K[55]; K[40] = a_ > b_ ? a_ : b_; }
  { const float a_ = K[41], b_ = K[54]; K[41] = a_ > b_ ? a_ : b_; }
  { const float a_ = K[42], b_ = K[53]; K[42] = a_ > b_ ? a_ : b_; }
  { const float a_ = K[43], b_ = K[52]; K[43] = a_ > b_ ? a_ : b_; }
  { const float a_ = K[44], b_ = K[51]; K[44] = a_ > b_ ? a_ : b_; }
  { const float a_ = K[45], b_ = K[50]; K[45] = a_ > b_ ? a_ : b_; }
  { const float a_ = K[46], b_ = K[49]; K[46] = a_ > b_ ? a_ : b_; }
  { const float a_ = K[47], b_ = K[48]; K[47] = a_ > b_ ? a_ : b_; }
  { const float a_ = K[32], b_ = K[40]; const bool g_ = a_ > b_; K[32] = g_ ? a_ : b_; K[40] = g_ ? b_ : a_; }
  { const float a_ = K[33], b_ = K[41]; const bool g_ = a_ > b_; K[33] = g_ ? a_ : b_; K[41] = g_ ? b_ : a_; }
  { const float a_ = K[34], b_ = K[42]; const bool g_ = a_ > b_; K[34] = g_ ? a_ : b_; K[42] = g_ ? b_ : a_; }
  { const float a_ = K[35], b_ = K[43]; const bool g_ = a_ > b_; K[35] = g_ ? a_ : b_; K[43] = g_ ? b_ : a_; }
  { const float a_ = K[36], b_ = K[44]; const bool g_ = a_ > b_; K[36] = g_ ? a_ : b_; K[44] = g_ ? b_ : a_; }
  { const float a_ = K[37], b_ = K[45]; const bool g_ = a_ > b_; K[37] = g_ ? a_ : b_; K[45] = g_ ? b_ : a_; }
  { const float a_ = K[38], b_ = K[46]; const bool g_ = a_ > b_; K[38] = g_ ? a_ : b_; K[46] = g_ ? b_ : a_; }
  { const float a_ = K[39], b_ = K[47]; const bool g_ = a_ > b_; K[39] = g_ ? a_ : b_; K[47] = g_ ? b_ : a_; }
  { const float a_ = K[32], b_ = K[36]; const bool g_ = a_ > b_; K[32] = g_ ? a_ : b_; K[36] = g_ ? b_ : a_; }
  { const float a_ = K[33], b_ = K[37]; const bool g_ = a_ > b_; K[33] = g_ ? a_ : b_; K[37] = g_ ? b_ : a_; }
  { const float a_ = K[34], b_ = K[38]; const bool g_ = a_ > b_; K[34] = g_ ? a_ : b_; K[38] = g_ ? b_ : a_; }
  { const float a_ = K[35], b_ = K[39]; const bool g_ = a_ > b_; K[35] = g_ ? a_ : b_; K[39] = g_ ? b_ : a_; }
  { const float a_ = K[40], b_ = K[44]; const bool g_ = a_ > b_; K[40] = g_ ? a_ : b_; K[44] = g_ ? b_ : a_; }
  { const float a_ = K[41], b_ = K[45]; const bool g_ = a_ > b_; K[41] = g_ ? a_ : b_; K[45] = g_ ? b_ : a_; }
  { const float a_ = K[42], b_ = K[46]; const bool g_ = a_ > b_; K[42] = g_ ? a_ : b_; K[46] = g_ ? b_ : a_; }
  { const float a_ = K[43], b_ = K[47]; const bool g_ = a_ > b_; K[43] = g_ ? a_ : b_; K[47] = g_ ? b_ : a_; }
  { const float a_ = K[32], b_ = K[34]; const bool g_ = a_ > b_; K[32] = g_ ? a_ : b_; K[34] = g_ ? b_ : a_; }
  { const float a_ = K[33], b_ = K[35]; const bool g_ = a_ > b_; K[33] = g_ ? a_ : b_; K[35] = g_ ? b_ : a_; }
  { const float a_ = K[36], b_ = K[38]; const bool g_ = a_ > b_; K[36] = g_ ? a_ : b_; K[38] = g_ ? b_ : a_; }
  { const float a_ = K[37], b_ = K[39]; const bool g_ = a_ > b_; K[37] = g_ ? a_ : b_; K[39] = g_ ? b_ : a_; }
  { const float a_ = K[40], b_ = K[42]; const bool g_ = a_ > b_; K[40] = g_ ? a_ : b_; K[42] = g_ ? b_ : a_; }
  { const float a_ = K[41], b_ = K[43]; const bool g_ = a_ > b_; K[41] = g_ ? a_ : b_; K[43] = g_ ? b_ : a_; }
  { const float a_ = K[44], b_ = K[46]; const bool g_ = a_ > b_; K[44] = g_ ? a_ : b_; K[46] = g_ ? b_ : a_; }
  { const float a_ = K[45], b_ = K[47]; const bool g_ = a_ > b_; K[45] = g_ ? a_ : b_; K[47] = g_ ? b_ : a_; }
  { const float a_ = K[32], b_ = K[33]; const bool g_ = a_ > b_; K[32] = g_ ? a_ : b_; K[33] = g_ ? b_ : a_; }
  { const float a_ = K[34], b_ = K[35]; const bool g_ = a_ > b_; K[34] = g_ ? a_ : b_; K[35] = g_ ? b_ : a_; }
  { const float a_ = K[36], b_ = K[37]; const bool g_ = a_ > b_; K[36] = g_ ? a_ : b_; K[37] = g_ ? b_ : a_; }
  { const float a_ = K[38], b_ = K[39]; const bool g_ = a_ > b_; K[38] = g_ ? a_ : b_; K[39] = g_ ? b_ : a_; }
  { const float a_ = K[40], b_ = K[41]; const bool g_ = a_ > b_; K[40] = g_ ? a_ : b_; K[41] = g_ ? b_ : a_; }
  { const float a_ = K[42], b_ = K[43]; const bool g_ = a_ > b_; K[42] = g_ ? a_ : b_; K[43] = g_ ? b_ : a_; }
  { const float a_ = K[44], b_ = K[45]; const bool g_ = a_ > b_; K[44] = g_ ? a_ : b_; K[45] = g_ ? b_ : a_; }
  { const float a_ = K[46], b_ = K[47]; const bool g_ = a_ > b_; K[46] = g_ ? a_ : b_; K[47] = g_ ? b_ : a_; }
  { const float a_ = K[0], b_ = K[47]; K[0] = a_ > b_ ? a_ : b_; }
  { const float a_ = K[1], b_ = K[46]; K[1] = a_ > b_ ? a_ : b_; }
  { const float a_ = K[2], b_ = K[45]; K[2] = a_ > b_ ? a_ : b_; }
  { const float a_ = K[3], b_ = K[44]; K[3] = a_ > b_ ? a_ : b_; }
  { const float a_ = K[4], b_ = K[43]; K[4] = a_ > b_ ? a_ : b_; }
  { const float a_ = K[5], b_ = K[42]; K[5] = a_ > b_ ? a_ : b_; }
  { const float a_ = K[6], b_ = K[41]; K[6] = a_ > b_ ? a_ : b_; }
  { const float a_ = K[7], b_ = K[40]; K[7] = a_ > b_ ? a_ : b_; }
  { const float a_ = K[8], b_ = K[39]; K[8] = a_ > b_ ? a_ : b_; }
  { const float a_ = K[9], b_ = K[38]; K[9] = a_ > b_ ? a_ : b_; }
  { const float a_ = K[10], b_ = K[37]; K[10] = a_ > b_ ? a_ : b_; }
  { const float a_ = K[11], b_ = K[36]; K[11] = a_ > b_ ? a_ : b_; }
  { const float a_ = K[12], b_ = K[35]; K[12] = a_ > b_ ? a_ : b_; }
  { const float a_ = K[13], b_ = K[34]; K[13] = a_ > b_ ? a_ : b_; }
  { const float a_ = K[14], b_ = K[33]; K[14] = a_ > b_ ? a_ : b_; }
  { const float a_ = K[15], b_ = K[32]; K[15] = a_ > b_ ? a_ : b_; }
  { const float a_ = K[0], b_ = K[8]; const bool g_ = a_ > b_; K[0] = g_ ? a_ : b_; K[8] = g_ ? b_ : a_; }
  { const float a_ = K[1], b_ = K[9]; const bool g_ = a_ > b_; K[1] = g_ ? a_ : b_; K[9] = g_ ? b_ : a_; }
  { const float a_ = K[2], b_ = K[10]; const bool g_ = a_ > b_; K[2] = g_ ? a_ : b_; K[10] = g_ ? b_ : a_; }
  { const float a_ = K[3], b_ = K[11]; const bool g_ = a_ > b_; K[3] = g_ ? a_ : b_; K[11] = g_ ? b_ : a_; }
  { const float a_ = K[4], b_ = K[12]; const bool g_ = a_ > b_; K[4] = g_ ? a_ : b_; K[12] = g_ ? b_ : a_; }
  { const float a_ = K[5], b_ = K[13]; const bool g_ = a_ > b_; K[5] = g_ ? a_ : b_; K[13] = g_ ? b_ : a_; }
  { const float a_ = K[6], b_ = K[14]; const bool g_ = a_ > b_; K[6] = g_ ? a_ : b_; K[14] = g_ ? b_ : a_; }
  { const float a_ = K[7], b_ = K[15]; const bool g_ = a_ > b_; K[7] = g_ ? a_ : b_; K[15] = g_ ? b_ : a_; }
  { const float a_ = K[0], b_ = K[4]; const bool g_ = a_ > b_; K[0] = g_ ? a_ : b_; K[4] = g_ ? b_ : a_; }
  { const float a_ = K[1], b_ = K[5]; const bool g_ = a_ > b_; K[1] = g_ ? a_ : b_; K[5] = g_ ? b_ : a_; }
  { const float a_ = K[2], b_ = K[6]; const bool g_ = a_ > b_; K[2] = g_ ? a_ : b_; K[6] = g_ ? b_ : a_; }
  { const float a_ = K[3], b_ = K[7]; const bool g_ = a_ > b_; K[3] = g_ ? a_ : b_; K[7] = g_ ? b_ : a_; }
  { const float a_ = K[8], b_ = K[12]; const bool g_ = a_ > b_; K[8] = g_ ? a_ : b_; K[12] = g_ ? b_ : a_; }
  { const float a_ = K[9], b_ = K[13]; const bool g_ = a_ > b_; K[9] = g_ ? a_ : b_; K[13] = g_ ? b_ : a_; }
  { const float a_ = K[10], b_ = K[14]; const bool g_ = a_ > b_; K[10] = g_ ? a_ : b_; K[14] = g_ ? b_ : a_; }
  { const float a_ = K[11], b_ = K[15]; const bool g_ = a_ > b_; K[11] = g_ ? a_ : b_; K[15] = g_ ? b_ : a_; }
  { const float a_ = K[0], b_ = K[2]; const bool g_ = a_ > b_; K[0] = g_ ? a_ : b_; K[2] = g_ ? b_ : a_; }
  { const float a_ = K[1], b_ = K[3]; const bool g_ = a_ > b_; K[1] = g_ ? a_ : b_; K[3] = g_ ? b_ : a_; }
  { const float a_ = K[4], b_ = K[6]; const bool g_ = a_ > b_; K[4] = g_ ? a_ : b_; K[6] = g_ ? b_ : a_; }
  { const float a_ = K[5], b_ = K[7]; const bool g_ = a_ > b_; K[5] = g_ ? a_ : b_; K[7] = g_ ? b_ : a_; }
  { const float a_ = K[8], b_ = K[10]; const bool g_ = a_ > b_; K[8] = g_ ? a_ : b_; K[10] = g_ ? b_ : a_; }
  { const float a_ = K[9], b_ = K[11]; const bool g_ = a_ > b_; K[9] = g_ ? a_ : b_; K[11] = g_ ? b_ : a_; }
  { const float a_ = K[12], b_ = K[14]; const bool g_ = a_ > b_; K[12] = g_ ? a_ : b_; K[14] = g_ ? b_ : a_; }
  { const float a_ = K[13], b_ = K[15]; const bool g_ = a_ > b_; K[13] = g_ ? a_ : b_; K[15] = g_ ? b_ : a_; }
  { const float a_ = K[0], b_ = K[1]; const bool g_ = a_ > b_; K[0] = g_ ? a_ : b_; K[1] = g_ ? b_ : a_; }
  { const float a_ = K[2], b_ = K[3]; const bool g_ = a_ > b_; K[2] = g_ ? a_ : b_; K[3] = g_ ? b_ : a_; }
  { const float a_ = K[4], b_ = K[5]; const bool g_ = a_ > b_; K[4] = g_ ? a_ : b_; K[5] = g_ ? b_ : a_; }
  { const float a_ = K[6], b_ = K[7]; const bool g_ = a_ > b_; K[6] = g_ ? a_ : b_; K[7] = g_ ? b_ : a_; }
  { const float a_ = K[8], b_ = K[9]; const bool g_ = a_ > b_; K[8] = g_ ? a_ : b_; K[9] = g_ ? b_ : a_; }
  { const float a_ = K[10], b_ = K[11]; const bool g_ = a_ > b_; K[10] = g_ ? a_ : b_; K[11] = g_ ? b_ : a_; }
  { const float a_ = K[12], b_ = K[13]; const bool g_ = a_ > b_; K[12] = g_ ? a_ : b_; K[13] = g_ ? b_ : a_; }
  { const float a_ = K[14], b_ = K[15]; const bool g_ = a_ > b_; K[14] = g_ ? a_ : b_; K[15] = g_ ? b_ : a_; }
}
__device__ __forceinline__ void merge_top16(float (&T)[16], const float (&P)[16]) {
  { const float a_ = T[0], b_ = P[15]; T[0] = a_ > b_ ? a_ : b_; }
  { const float a_ = T[1], b_ = P[14]; T[1] = a_ > b_ ? a_ : b_; }
  { const float a_ = T[2], b_ = P[13]; T[2] = a_ > b_ ? a_ : b_; }
  { const float a_ = T[3], b_ = P[12]; T[3] = a_ > b_ ? a_ : b_; }
  { const float a_ = T[4], b_ = P[11]; T[4] = a_ > b_ ? a_ : b_; }
  { const float a_ = T[5], b_ = P[10]; T[5] = a_ > b_ ? a_ : b_; }
  { const float a_ = T[6], b_ = P[9]; T[6] = a_ > b_ ? a_ : b_; }
  { const float a_ = T[7], b_ = P[8]; T[7] = a_ > b_ ? a_ : b_; }
  { const float a_ = T[8], b_ = P[7]; T[8] = a_ > b_ ? a_ : b_; }
  { const float a_ = T[9], b_ = P[6]; T[9] = a_ > b_ ? a_ : b_; }
  { const float a_ = T[10], b_ = P[5]; T[10] = a_ > b_ ? a_ : b_; }
  { const float a_ = T[11], b_ = P[4]; T[11] = a_ > b_ ? a_ : b_; }
  { const float a_ = T[12], b_ = P[3]; T[12] = a_ > b_ ? a_ : b_; }
  { const float a_ = T[13], b_ = P[2]; T[13] = a_ > b_ ? a_ : b_; }
  { const float a_ = T[14], b_ = P[1]; T[14] = a_ > b_ ? a_ : b_; }
  { const float a_ = T[15], b_ = P[0]; T[15] = a_ > b_ ? a_ : b_; }
  { const float a_ = T[0], b_ = T[8]; const bool g_ = a_ > b_; T[0] = g_ ? a_ : b_; T[8] = g_ ? b_ : a_; }
  { const float a_ = T[1], b_ = T[9]; const bool g_ = a_ > b_; T[1] = g_ ? a_ : b_; T[9] = g_ ? b_ : a_; }
  { const float a_ = T[2], b_ = T[10]; const bool g_ = a_ > b_; T[2] = g_ ? a_ : b_; T[10] = g_ ? b_ : a_; }
  { const float a_ = T[3], b_ = T[11]; const bool g_ = a_ > b_; T[3] = g_ ? a_ : b_; T[11] = g_ ? b_ : a_; }
  { const float a_ = T[4], b_ = T[12]; const bool g_ = a_ > b_; T[4] = g_ ? a_ : b_; T[12] = g_ ? b_ : a_; }
  { const float a_ = T[5], b_ = T[13]; const bool g_ = a_ > b_; T[5] = g_ ? a_ : b_; T[13] = g_ ? b_ : a_; }
  { const float a_ = T[6], b_ = T[14]; const bool g_ = a_ > b_; T[6] = g_ ? a_ : b_; T[14] = g_ ? b_ : a_; }
  { const float a_ = T[7], b_ = T[15]; const bool g_ = a_ > b_; T[7] = g_ ? a_ : b_; T[15] = g_ ? b_ : a_; }
  { const float a_ = T[0], b_ = T[4]; const bool g_ = a_ > b_; T[0] = g_ ? a_ : b_; T[4] = g_ ? b_ : a_; }
  { const float a_ = T[1], b_ = T[5]; const bool g_ = a_ > b_; T[1] = g_ ? a_ : b_; T[5] = g_ ? b_ : a_; }
  { const float a_ = T[2], b_ = T[6]; const bool g_ = a_ > b_; T[2] = g_ ? a_ : b_; T[6] = g_ ? b_ : a_; }
  { const float a_ = T[3], b_ = T[7]; const bool g_ = a_ > b_; T[3] = g_ ? a_ : b_; T[7] = g_ ? b_ : a_; }
  { const float a_ = T[8], b_ = T[12]; const bool g_ = a_ > b_; T[8] = g_ ? a_ : b_; T[12] = g_ ? b_ : a_; }
  { const float a_ = T[9], b_ = T[13]; const bool g_ = a_ > b_; T[9] = g_ ? a_ : b_; T[13] = g_ ? b_ : a_; }
  { const float a_ = T[10], b_ = T[14]; const bool g_ = a_ > b_; T[10] = g_ ? a_ : b_; T[14] = g_ ? b_ : a_; }
  { const float a_ = T[11], b_ = T[15]; const bool g_ = a_ > b_; T[11] = g_ ? a_ : b_; T[15] = g_ ? b_ : a_; }
  { const float a_ = T[0], b_ = T[2]; const bool g_ = a_ > b_; T[0] = g_ ? a_ : b_; T[2] = g_ ? b_ : a_; }
  { const float a_ = T[1], b_ = T[3]; const bool g_ = a_ > b_; T[1] = g_ ? a_ : b_; T[3] = g_ ? b_ : a_; }
  { const float a_ = T[4], b_ = T[6]; const bool g_ = a_ > b_; T[4] = g_ ? a_ : b_; T[6] = g_ ? b_ : a_; }
  { const float a_ = T[5], b_ = T[7]; const bool g_ = a_ > b_; T[5] = g_ ? a_ : b_; T[7] = g_ ? b_ : a_; }
  { const float a_ = T[8], b_ = T[10]; const bool g_ = a_ > b_; T[8] = g_ ? a_ : b_; T[10] = g_ ? b_ : a_; }
  { const float a_ = T[9], b_ = T[11]; const bool g_ = a_ > b_; T[9] = g_ ? a_ : b_; T[11] = g_ ? b_ : a_; }
  { const float a_ = T[12], b_ = T[14]; const bool g_ = a_ > b_; T[12] = g_ ? a_ : b_; T[14] = g_ ? b_ : a_; }
  { const float a_ = T[13], b_ = T[15]; const bool g_ = a_ > b_; T[13] = g_ ? a_ : b_; T[15] = g_ ? b_ : a_; }
  { const float a_ = T[0], b_ = T[1]; const bool g_ = a_ > b_; T[0] = g_ ? a_ : b_; T[1] = g_ ? b_ : a_; }
  { const float a_ = T[2], b_ = T[3]; const bool g_ = a_ > b_; T[2] = g_ ? a_ : b_; T[3] = g_ ? b_ : a_; }
  { const float a_ = T[4], b_ = T[5]; const bool g_ = a_ > b_; T[4] = g_ ? a_ : b_; T[5] = g_ ? b_ : a_; }
  { const float a_ = T[6], b_ = T[7]; const bool g_ = a_ > b_; T[6] = g_ ? a_ : b_; T[7] = g_ ? b_ : a_; }
  { const float a_ = T[8], b_ = T[9]; const bool g_ = a_ > b_; T[8] = g_ ? a_ : b_; T[9] = g_ ? b_ : a_; }
  { const float a_ = T[10], b_ = T[11]; const bool g_ = a_ > b_; T[10] = g_ ? a_ : b_; T[11] = g_ ? b_ : a_; }
  { const float a_ = T[12], b_ = T[13]; const bool g_ = a_ > b_; T[12] = g_ ? a_ : b_; T[13] = g_ ? b_ : a_; }
  { const float a_ = T[14], b_ = T[15]; const bool g_ = a_ > b_; T[14] = g_ ? a_ : b_; T[15] = g_ ? b_ : a_; }
}

__device__ __forceinline__ void peer_topk(const int wave_s, const bf16* pq, const bf16* skb, int* ids, float* gates, LAS float* smem) {
  const int tid_ = opaque_tid(wave_s);
  const int lane = tid_ & 63, n = lane & 31, hh = lane >> 5, wave = tid_ >> 6;
  const int gw = blockIdx.x * NWAVES + wave;
  const int nw = gridDim.x * NWAVES;
  LAS float* lk = smem + wave * 2048;
  for (int it = gw; it < 512 * 8; it += nw) {
    const int h = it & 7, tok0 = (it >> 3) * 32;
#pragma unroll 1
    for (int half = 0; half < 2; half++) {
      bf16x8_t qf[8];
      {
        const bf16* qrow = pq + (size_t)(tok0 + n) * 2048 + h * 256 + half * 128 + 8 * hh;
#pragma unroll
        for (int ks = 0; ks < 8; ks++) qf[ks] = *(const bf16x8_t*)(qrow + 16 * ks);
      }
      float K[64];
#pragma unroll
      for (int kt = 0; kt < 4; kt++) {
        const bf16* krow = skb + ((size_t)((h * 2 + half) * 128 + kt * 32 + n)) * 128 + 8 * hh;
        f32x16_t acc;
#pragma unroll
        for (int r = 0; r < 16; r++) acc[r] = 0.f;
#pragma unroll
        for (int kq = 0; kq < 2; kq++) {
          bf16x8_t kf[4];
#pragma unroll
          for (int i = 0; i < 4; i++) kf[i] = *(const bf16x8_t*)(krow + 16 * (kq * 4 + i));
          MFMA_PAD();
#pragma unroll
          for (int i = 0; i < 4; i++) acc = __builtin_amdgcn_mfma_f32_32x32x16_bf16(kf[i], qf[kq * 4 + i], acc, 0, 0, 0);
          MFMA_PAD();
        }
#pragma unroll
        for (int i = 0; i < 16; i++) K[kt * 16 + i] = pack_key<0x7Fu>(acc[i], (unsigned)(kt * 32 + (i & 3) + 8 * (i >> 2) + 4 * hh));
      }
      __builtin_amdgcn_sched_barrier(0);
      top16_of_64(K);
      __builtin_amdgcn_sched_barrier(0);
      float T[16], P[16];
#pragma unroll
      for (int i = 0; i < 16; i++) { T[i] = K[i]; P[i] = __shfl_xor(K[i], 32, 64); }
      merge_top16(T, P);
#pragma unroll
      for (int i = 0; i < 16; i++) lk[(half * 16 + i) * 64 + lane] = T[i];
      __builtin_amdgcn_sched_barrier(0);
    }
    float f0[16], f1[16];
    int ti0[16], ti1[16];
#pragma unroll
    for (int i = 0; i < 16; i++) {
      const float k0 = lk[i * 64 + lane], k1 = lk[(16 + i) * 64 + lane];
      f0[i] = key_val<0x7Fu>(k0); ti0[i] = (int)key_idx<0x7Fu>(k0);
      f1[i] = key_val<0x7Fu>(k1); ti1[i] = (int)key_idx<0x7Fu>(k1);
    }
    float K[64];
    {
    K[0] = pack_key<0xFFu>(f0[0] + f1[0], 0u);
    K[1] = pack_key<0xFFu>(f0[0] + f1[1], 1u);
    K[2] = pack_key<0xFFu>(f0[0] + f1[2], 2u);
    K[3] = pack_key<0xFFu>(f0[0] + f1[3], 3u);
    K[4] = pack_key<0xFFu>(f0[0] + f1[4], 4u);
    K[5] = pack_key<0xFFu>(f0[0] + f1[5], 5u);
    K[6] = pack_key<0xFFu>(f0[0] + f1[6], 6u);
    K[7] = pack_key<0xFFu>(f0[0] + f1[7], 7u);
    K[8] = pack_key<0xFFu>(f0[0] + f1[8], 8u);
    K[9] = pack_key<0xFFu>(f0[0] + f1[9], 9u);
    K[10] = pack_key<0xFFu>(f0[0] + f1[10], 10u);
    K[11] = pack_key<0xFFu>(f0[0] + f1[11], 11u);
    K[12] = pack_key<0xFFu>(f0[0] + f1[12], 12u);
    K[13] = pack_key<0xFFu>(f0[0] + f1[13], 13u);
    K[14] = pack_key<0xFFu>(f0[0] + f1[14], 14u);
    K[15] = pack_key<0xFFu>(f0[0] + f1[15], 15u);
    K[16] = pack_key<0xFFu>(f0[1] + f1[0], 16u);
    K[17] = pack_key<0xFFu>(f0[1] + f1[1], 17u);
    K[18] = pack_key<0xFFu>(f0[1] + f1[2], 18u);
    K[19] = pack_key<0xFFu>(f0[1] + f1[3], 19u);
    K[20] = pack_key<0xFFu>(f0[1] + f1[4], 20u);
    K[21] = pack_key<0xFFu>(f0[1] + f1[5], 21u);
    K[22] = pack_key<0xFFu>(f0[1] + f1[6], 22u);
    K[23] = pack_key<0xFFu>(f0[1] + f1[7], 23u);
    K[24] = pack_key<0xFFu>(f0[2] + f1[0], 32u);
    K[25] = pack_key<0xFFu>(f0[2] + f1[1], 33u);
    K[26] = pack_key<0xFFu>(f0[2] + f1[2], 34u);
    K[27] = pack_key<0xFFu>(f0[2] + f1[3], 35u);
    K[28] = pack_key<0xFFu>(f0[2] + f1[4], 36u);
    K[29] = pack_key<0xFFu>(f0[3] + f1[0], 48u);
    K[30] = pack_key<0xFFu>(f0[3] + f1[1], 49u);
    K[31] = pack_key<0xFFu>(f0[3] + f1[2], 50u);
    K[32] = pack_key<0xFFu>(f0[3] + f1[3], 51u);
    K[33] = pack_key<0xFFu>(f0[4] + f1[0], 64u);
    K[34] = pack_key<0xFFu>(f0[4] + f1[1], 65u);
    K[35] = pack_key<0xFFu>(f0[4] + f1[2], 66u);
    K[36] = pack_key<0xFFu>(f0[5] + f1[0], 80u);
    K[37] = pack_key<0xFFu>(f0[5] + f1[1], 81u);
    K[38] = pack_key<0xFFu>(f0[6] + f1[0], 96u);
    K[39] = pack_key<0xFFu>(f0[6] + f1[1], 97u);
    K[40] = pack_key<0xFFu>(f0[7] + f1[0], 112u);
    K[41] = pack_key<0xFFu>(f0[7] + f1[1], 113u);
    K[42] = pack_key<0xFFu>(f0[8] + f1[0], 128u);
    K[43] = pack_key<0xFFu>(f0[9] + f1[0], 144u);
    K[44] = pack_key<0xFFu>(f0[10] + f1[0], 160u);
    K[45] = pack_key<0xFFu>(f0[11] + f1[0], 176u);
    K[46] = pack_key<0xFFu>(f0[12] + f1[0], 192u);
    K[47] = pack_key<0xFFu>(f0[13] + f1[0], 208u);
    K[48] = pack_key<0xFFu>(f0[14] + f1[0], 224u);
    K[49] = pack_key<0xFFu>(f0[15] + f1[0], 240u);
    K[50] = -3.0e38f;
    K[51] = -3.0e38f;
    K[52] = -3.0e38f;
    K[53] = -3.0e38f;
    K[54] = -3.0e38f;
    K[55] = -3.0e38f;
    K[56] = -3.0e38f;
    K[57] = -3.0e38f;
    K[58] = -3.0e38f;
    K[59] = -3.0e38f;
    K[60] = -3.0e38f;
    K[61] = -3.0e38f;
    K[62] = -3.0e38f;
    K[63] = -3.0e38f;
    }
    __builtin_amdgcn_sched_barrier(0);
    top16_of_64(K);
    __builtin_amdgcn_sched_barrier(0);
    float bv[16];
    int be[16];
#pragma unroll
    for (int r = 0; r < 16; r++) {
      const int flat = (int)key_idx<0xFFu>(K[r]);
      const int a = flat >> 4, b = flat & 15;
      int i0 = 0, i1 = 0;
#pragma unroll
      for (int i = 0; i < 16; i++) { i0 = (a == i) ? ti0[i] : i0; i1 = (b == i) ? ti1[i] : i1; }
      be[r] = i0 * 128 + i1;
      bv[r] = key_val<0xFFu>(K[r]);
    }
    const float b0 = bv[0];
    float ge[16];
    float gsum = 0.f;
#pragma unroll
    for (int r = 0; r < 16; r++) { ge[r] = __expf(bv[r] - b0); gsum += ge[r]; }
    const float ginv = 1.0f / gsum;
    if (hh == 0) {
      int* ip = ids + (size_t)(tok0 + n) * 128 + h * 16;
      float* gp = gates + (size_t)(tok0 + n) * 128 + h * 16;
#pragma unroll
      for (int r4 = 0; r4 < 4; r4++) {
        *(int4*)(ip + 4 * r4) = make_int4(be[4 * r4], be[4 * r4 + 1], be[4 * r4 + 2], be[4 * r4 + 3]);
        *(float4*)(gp + 4 * r4) = make_float4(ge[4 * r4] * ginv, ge[4 * r4 + 1] * ginv, ge[4 * r4 + 2] * ginv, ge[4 * r4 + 3] * ginv);
      }
    }
  }
}

typedef _Float16 f16x2_t __attribute__((ext_vector_type(2)));
__device__ __forceinline__ unsigned e4m3x2_to_f16x2(unsigned w, unsigned sel) {
  return __builtin_amdgcn_perm(w, w, sel);
}
__device__ __forceinline__ float dot2h(unsigned a, unsigned b, float c) {
  return __builtin_amdgcn_fdot2(__builtin_bit_cast(f16x2_t, a), __builtin_bit_cast(f16x2_t, b), c, false);
}
__device__ __forceinline__ unsigned pack_h2(float lo, float hi) {
  f16x2_t v; v.x = (_Float16)lo; v.y = (_Float16)hi;
  return __builtin_bit_cast(unsigned, v);
}
template <bool FINAL>
__device__ __forceinline__ void peer_gather(const int wave_s, bf16* xn, const float* rst, const unsigned char* ub, const unsigned char* vb, const float* vsc, const float* usc,
                                            const int* ids, const float* gates, float* xw, const float* gnext, float* outp) {
  const int tid_ = opaque_tid(wave_s);
  const int lane = tid_ & 63;
  const int gw = blockIdx.x * NWAVES + (tid_ >> 6);
  const int nw = gridDim.x * NWAVES;
  const int el = ((lane >> 5) & 1) * 8 + ((lane >> 4) & 1) * 4 + ((lane >> 3) & 1) * 2 + ((lane >> 2) & 1);
  int idv = 0;
  uint2 uu[16];
  uint2 vv[16];
  if (gw < NT) {
    idv = ids[(size_t)gw * 128 + (lane & 15)];
#pragma unroll
    for (int e = 0; e < 16; e++) {
      const int id = __builtin_amdgcn_readlane(idv, e);
      uu[e] = *(const uint2*)(ub + (size_t)id * 512 + lane * 8);
      vv[e] = *(const uint2*)(vb + (size_t)id * 512 + lane * 8);
    }
  }
  for (int tok = gw; tok < NT; tok += nw) {
    const int tokn = (tok + nw < NT) ? tok + nw : tok;
    int xqh[2] = {0, 0}, xql[2] = {0, 0};
    float xstep, qhalf;
    {
      const uint4 a = *(const uint4*)(xn + (size_t)tok * DM + lane * 16);
      const uint4 b = *(const uint4*)(xn + (size_t)tok * DM + lane * 16 + 8);
      const unsigned xw_[8] = {a.x, a.y, a.z, a.w, b.x, b.y, b.z, b.w};
      const float4* sp = (const float4*)(rst + (size_t)tok * 16);
      const float4 s0 = sp[0], s1 = sp[1], s2 = sp[2], s3 = sp[3];
      const float xs = rsqrtf((((s0.x + s0.y) + (s0.z + s0.w)) + ((s1.x + s1.y) + (s1.z + s1.w)) + ((s2.x + s2.y) + (s2.z + s2.w)) + ((s3.x + s3.y) + (s3.z + s3.w))) * (1.0f / 1024.f) + EPSF);
      float xf[16];
      float am = 0.f;
#pragma unroll
      for (int k = 0; k < 8; k++) { xf[2 * k] = bf_lo(xw_[k]) * xs; xf[2 * k + 1] = bf_hi(xw_[k]) * xs; am = fmaxf(am, fmaxf(fabsf(xf[2 * k]), fabsf(xf[2 * k + 1]))); }
#pragma unroll
      for (int o = 32; o >= 1; o >>= 1) am = fmaxf(am, __shfl_xor(am, o, 64));
      xstep = am * (1.0f / 119.f);
      const float inv = am > 0.f ? 119.f / am : 0.f;
      int qs = 0;
#pragma unroll
      for (int i = 0; i < 16; i++) {
        const int q = (int)rintf(xf[i] * inv);
        const int t = q + 8;
        xqh[i >> 3] |= ((t >> 4) & 15) << (4 * (i & 7));
        xql[i >> 3] |= (((t & 15) - 8) & 15) << (4 * (i & 7));
        qs += q;
      }
      qhalf = 0.5f * wsum((float)qs);
    }
    f16x2_t acc2[8];
#pragma unroll
    for (int i = 0; i < 8; i++) acc2[i] = (f16x2_t){(_Float16)0.f, (_Float16)0.f};
#pragma unroll 1
    for (int g = 0; g < 8; g++) {
      const int ide = __builtin_amdgcn_ds_bpermute(el << 2, idv);
      const float2 sc2 = ((const float2*)vsc)[ide];
      const float gv = gates[(size_t)tok * 128 + g * 16 + el] * sc2.x;
      const float us = sc2.y * xstep;
      const int idn = ids[(size_t)(g < 7 ? tok : tokn) * 128 + ((g + 1) & 7) * 16 + (lane & 15)];
      float d[16];
#pragma unroll
      for (int e = 0; e < 16; e++) {
        int sh = __builtin_amdgcn_sdot8((int)uu[e].x, xqh[0], 0, false);
        sh = __builtin_amdgcn_sdot8((int)uu[e].y, xqh[1], sh, false);
        int sl = __builtin_amdgcn_sdot8((int)uu[e].x, xql[0], 0, false);
        sl = __builtin_amdgcn_sdot8((int)uu[e].y, xql[1], sl, false);
        d[e] = (float)((sh << 4) + sl);
      }
#pragma unroll
      for (int e = 0; e < 16; e++) {
        const int id = __builtin_amdgcn_readlane(idn, e);
        uu[e] = *(const uint2*)(ub + (size_t)id * 512 + lane * 8);
      }
      float d8[8], d4[4], d2[2], d1;
      {
        const bool hi = (lane & 32) != 0;
#pragma unroll
        for (int i = 0; i < 8; i++) { const float send = hi ? d[i] : d[i + 8]; const float keep = hi ? d[i + 8] : d[i]; d8[i] = keep + __shfl_xor(send, 32, 64); }
      }
      {
        const bool hi = (lane & 16) != 0;
#pragma unroll
        for (int i = 0; i < 4; i++) { const float send = hi ? d8[i] : d8[i + 4]; const float keep = hi ? d8[i + 4] : d8[i]; d4[i] = keep + __shfl_xor(send, 16, 64); }
      }
      {
        const bool hi = (lane & 8) != 0;
#pragma unroll
        for (int i = 0; i < 2; i++) { const float send = hi ? d4[i] : d4[i + 2]; const float keep = hi ? d4[i + 2] : d4[i]; d2[i] = keep + __shfl_xor(send, 8, 64); }
      }
      {
        const bool hi = (lane & 4) != 0;
        const float send = hi ? d2[0] : d2[1];
        const float keep = hi ? d2[1] : d2[0];
        d1 = keep + __shfl_xor(send, 4, 64);
      }
      d1 += __shfl_xor(d1, 2, 64);
      d1 += __shfl_xor(d1, 1, 64);
      const float wl = gv * gelu_tanh((d1 + qhalf) * us);
#pragma unroll
      for (int e = 0; e < 16; e++) {
        const float w = __builtin_bit_cast(float, __builtin_amdgcn_readlane(__builtin_bit_cast(int, wl), ((e >> 3) & 1) * 32 + ((e >> 2) & 1) * 16 + ((e >> 1) & 1) * 8 + (e & 1) * 4));
        const f16x2_t w2 = __builtin_bit_cast(f16x2_t, pack_h2(w, w));
        const unsigned vw[2] = {vv[e].x, vv[e].y};
#pragma unroll
        for (int k = 0; k < 2; k++) {
          const unsigned w4 = vw[k];
          const unsigned le = __builtin_amdgcn_perm(V4_LUT_HI, V4_LUT_LO, w4 & 0x07070707u);
          const unsigned lo = __builtin_amdgcn_perm(V4_LUT_HI, V4_LUT_LO, (w4 >> 4) & 0x07070707u);
          const unsigned ee = ((w4 << 4) & 0x80808080u) | le;
          const unsigned eo = (w4 & 0x80808080u) | lo;
          const unsigned p01 = __builtin_amdgcn_perm(eo, ee, 0x040c000cu), p23 = __builtin_amdgcn_perm(eo, ee, 0x050c010cu);
          const unsigned p45 = __builtin_amdgcn_perm(eo, ee, 0x060c020cu), p67 = __builtin_amdgcn_perm(eo, ee, 0x070c030cu);
          acc2[4 * k + 0] = __builtin_elementwise_fma(__builtin_bit_cast(f16x2_t, p01), w2, acc2[4 * k + 0]);
          acc2[4 * k + 1] = __builtin_elementwise_fma(__builtin_bit_cast(f16x2_t, p23), w2, acc2[4 * k + 1]);
          acc2[4 * k + 2] = __builtin_elementwise_fma(__builtin_bit_cast(f16x2_t, p45), w2, acc2[4 * k + 2]);
          acc2[4 * k + 3] = __builtin_elementwise_fma(__builtin_bit_cast(f16x2_t, p67), w2, acc2[4 * k + 3]);
        }
      }
#pragma unroll
      for (int e = 0; e < 16; e++) {
        const int id = __builtin_amdgcn_readlane(idn, e);
        vv[e] = *(const uint2*)(vb + (size_t)id * 512 + lane * 8);
      }
      idv = idn;
    }
    float acc[16];
#pragma unroll
    for (int i = 0; i < 8; i++) { acc[2 * i] = (float)acc2[i].x; acc[2 * i + 1] = (float)acc2[i].y; }
    float* xr = xw + (size_t)tok * DM + lane * 16;
    float xv[16];
    float ssq = 0.f;
#pragma unroll
    for (int c = 0; c < 4; c++) {
      float4 a0 = *(float4*)(xr + c * 4);
      a0.x += acc[c * 4 + 0]; a0.y += acc[c * 4 + 1]; a0.z += acc[c * 4 + 2]; a0.w += acc[c * 4 + 3];
      if (!FINAL) *(float4*)(xr + c * 4) = a0;
      xv[c * 4 + 0] = a0.x; xv[c * 4 + 1] = a0.y; xv[c * 4 + 2] = a0.z; xv[c * 4 + 3] = a0.w;
      ssq += a0.x * a0.x + a0.y * a0.y + a0.z * a0.z + a0.w * a0.w;
    }
    ssq = wsum(ssq);
    const float rstd = rsqrtf(ssq * (1.0f / DM) + EPSF);
    const float4* g4 = (const float4*)(gnext + lane * 16);
    if (FINAL) {
      float* op = outp + (size_t)tok * DM + lane * 16;
#pragma unroll
      for (int c = 0; c < 4; c++) {
        const float4 gq = g4[c];
        *(float4*)(op + c * 4) = make_float4(xv[c * 4] * rstd * gq.x, xv[c * 4 + 1] * rstd * gq.y, xv[c * 4 + 2] * rstd * gq.z, xv[c * 4 + 3] * rstd * gq.w);
      }
    } else {
      uint4 o0, o1;
      { const float4 ga = g4[0], gb = g4[1];
        o0.x = pk2(xv[0] * rstd * ga.x, xv[1] * rstd * ga.y); o0.y = pk2(xv[2] * rstd * ga.z, xv[3] * rstd * ga.w);
        o0.z = pk2(xv[4] * rstd * gb.x, xv[5] * rstd * gb.y); o0.w = pk2(xv[6] * rstd * gb.z, xv[7] * rstd * gb.w); }
      { const float4 ga = g4[2], gb = g4[3];
        o1.x = pk2(xv[8] * rstd * ga.x, xv[9] * rstd * ga.y); o1.y = pk2(xv[10] * rstd * ga.z, xv[11] * rstd * ga.w);
        o1.z = pk2(xv[12] * rstd * gb.x, xv[13] * rstd * gb.y); o1.w = pk2(xv[14] * rstd * gb.z, xv[15] * rstd * gb.w); }
      *(uint4*)(xn + (size_t)tok * DM + lane * 16) = o0;
      *(uint4*)(xn + (size_t)tok * DM + lane * 16 + 8) = o1;
    }
  }
}

__device__ __forceinline__ void prologue_transposes(const int wave_s, const Params& p, unsigned char* ws, LAS unsigned char* lds) {
  const int tid_ = opaque_tid(wave_s);
  const int lane = tid_ & 63, wave = tid_ >> 6;
  LAS float* scr = (LAS float*)(lds + wave * 16384);
  const int gw = blockIdx.x * NWAVES + wave, NGW = gridDim.x * NWAVES;
  constexpr int I_IN = (DM / 64) * (DIN / 32), I_SQ = (DM / 64) * (DM / 32), I_2K = (DM / 64) * (2048 / 32);
  constexpr int I_GL = (256 / 64) * (256 / 32);
  constexpr int PER_LAYER = I_IN + 3 * I_SQ + 2 * I_2K + I_GL;
  const float* w3 = karg_in(3); const float* w19 = karg_in(19); const float* w22 = karg_in(22);
  const float* w23 = karg_in(23); const float* w24 = karg_in(24); const float* w26 = karg_in(26);
  const float* w16 = karg_in(16);
  for (int it = gw; it < 2 * PER_LAYER; it += NGW) {
    const int l = it / PER_LAYER;
    int r = it % PER_LAYER;
    unsigned char* wl = ws + WS_WT + (size_t)l * WT_LAYER;
    if (r < I_IN) { transpose_item(w3 + (size_t)l * DM * DIN, DM, DIN, (bf16*)(wl + WT_IN), scr, r, lane); continue; } r -= I_IN;
    if (r < I_SQ) { transpose_item(w19 + (size_t)l * DM * DM, DM, DM, (bf16*)(wl + WT_OUT), scr, r, lane); continue; } r -= I_SQ;
    if (r < I_SQ) { transpose_item(w22 + (size_t)l * DM * DM, DM, DM, (bf16*)(wl + WT_MQ), scr, r, lane); continue; } r -= I_SQ;
    if (r < I_2K) { transpose_item(w23 + (size_t)l * DM * 2048, DM, 2048, (bf16*)(wl + WT_MKV), scr, r, lane); continue; } r -= I_2K;
    if (r < I_SQ) { transpose_item(w24 + (size_t)l * DM * DM, DM, DM, (bf16*)(wl + WT_MO), scr, r, lane); continue; } r -= I_SQ;
    if (r < I_2K) { transpose_item(w26 + (size_t)l * DM * 2048, DM, 2048, (bf16*)(wl + WT_PQ), scr, r, lane); continue; } r -= I_2K;
    transpose_item(w16 + (size_t)l * 256 * 256, 256, 256, (bf16*)(wl + WT_GLU), scr, r, lane);
  }
}

template <class T> __device__ __forceinline__ T* opq(T* p) { asm volatile("" : "+s"(p)); return p; }
__device__ __forceinline__ void cvt_rows_bf16(const int wave_s, const float* src, bf16* dst, size_t n) {
  const int tid_ = opaque_tid(wave_s);
  const size_t gt = (size_t)blockIdx.x * (NWAVES * 64) + tid_;
  const size_t nth = (size_t)gridDim.x * NWAVES * 64;
  for (size_t i = gt; i < n / 8; i += nth) {
    const float4 a = ((const float4*)src)[2 * i], b = ((const float4*)src)[2 * i + 1];
    uint4 o; o.x = pk2(a.x, a.y); o.y = pk2(a.z, a.w); o.z = pk2(b.x, b.y); o.w = pk2(b.z, b.w);
    ((uint4*)dst)[i] = o;
  }
}

__device__ __forceinline__ unsigned enc_e4m3(float x) {
  const _Float16 hf = (_Float16)x;
  const unsigned h = (unsigned)__builtin_bit_cast(unsigned short, hf);
  return ((h + 0x7Fu + ((h >> 8) & 1u)) >> 8) & 0xFFu;
}
__device__ __forceinline__ void cvt_rows_e4m3(const int wave_s, const float* src, unsigned char* dst, size_t n, float sc) {
  const int tid_ = opaque_tid(wave_s);
  const size_t gt = (size_t)blockIdx.x * (NWAVES * 64) + tid_;
  const size_t nth = (size_t)gridDim.x * NWAVES * 64;
  for (size_t i = gt; i < n / 16; i += nth) {
    unsigned w[4];
#pragma unroll
    for (int k = 0; k < 4; k++) {
      const float4 a = ((const float4*)src)[4 * i + k];
      w[k] = enc_e4m3(a.x * sc) | (enc_e4m3(a.y * sc) << 8) | (enc_e4m3(a.z * sc) << 16) | (enc_e4m3(a.w * sc) << 24);
    }
    uint4 o; o.x = w[0]; o.y = w[1]; o.z = w[2]; o.w = w[3];
    ((uint4*)dst)[i] = o;
  }
}

__device__ __forceinline__ unsigned enc_v4(float z) {
  const float az = fabsf(z);
  unsigned c = 0;
  c += az > 0.25f; c += az > 0.5f; c += az > 0.75f; c += az > 1.0625f; c += az > 1.375f; c += az > 1.75f; c += az > 2.25f;
  return c | ((__builtin_bit_cast(unsigned, z) >> 28) & 8u);
}
__device__ __forceinline__ void cvt_rows_i4(const int wave_s, const float* src, unsigned char* dst, float* sc_out, int nrows) {
  const int tid_ = opaque_tid(wave_s);
  const int lane = tid_ & 63;
  const int gw = blockIdx.x * NWAVES + (tid_ >> 6);
  const int nw = gridDim.x * NWAVES;
  for (int r = gw; r < nrows; r += nw) {
    const float4* sp = (const float4*)(src + (size_t)r * 1024 + lane * 16);
    const float4 a0 = sp[0], a1 = sp[1], a2 = sp[2], a3 = sp[3];
    const float xv[16] = {a0.x, a0.y, a0.z, a0.w, a1.x, a1.y, a1.z, a1.w, a2.x, a2.y, a2.z, a2.w, a3.x, a3.y, a3.z, a3.w};
    float ss = 0.f;
#pragma unroll
    for (int i = 0; i < 16; i++) ss += xv[i] * xv[i];
    ss = wsum(ss);
    const float sc = sqrtf(ss * (1.0f / 1024.f)) * U4_STEP;
    const float inv = sc > 0.f ? 1.0f / sc : 0.f;
    unsigned w[2] = {0u, 0u};
#pragma unroll
    for (int i = 0; i < 16; i++) {
      const float f = fminf(fmaxf(floorf(xv[i] * inv), -8.f), 7.f);
      w[i >> 3] |= ((unsigned)(int)f & 15u) << (4 * (i & 7));
    }
    uint2 o; o.x = w[0]; o.y = w[1];
    *(uint2*)(dst + (size_t)r * 512 + lane * 8) = o;
    if (lane == 0) sc_out[2 * r] = sc;
  }
}
__device__ __forceinline__ void cvt_rows_v4(const int wave_s, const float* src, unsigned char* dst, float* sc_out, int nrows) {
  const int tid_ = opaque_tid(wave_s);
  const int lane = tid_ & 63;
  const int gw = blockIdx.x * NWAVES + (tid_ >> 6);
  const int nw = gridDim.x * NWAVES;
  for (int r = gw; r < nrows; r += nw) {
    const float4* sp = (const float4*)(src + (size_t)r * 1024 + lane * 16);
    const float4 a0 = sp[0], a1 = sp[1], a2 = sp[2], a3 = sp[3];
    const float xv[16] = {a0.x, a0.y, a0.z, a0.w, a1.x, a1.y, a1.z, a1.w, a2.x, a2.y, a2.z, a2.w, a3.x, a3.y, a3.z, a3.w};
    float ss = 0.f;
#pragma unroll
    for (int i = 0; i < 16; i++) ss += xv[i] * xv[i];
    ss = wsum(ss);
    const float sc = sqrtf(ss * (1.0f / 1024.f)) * V4_ROWSCALE;
    const float inv = sc > 0.f ? 1.0f / sc : 0.f;
    unsigned w[2] = {0u, 0u};
#pragma unroll
    for (int i = 0; i < 16; i++) w[i >> 3] |= enc_v4(xv[i] * inv) << (4 * (i & 7));
    uint2 o; o.x = w[0]; o.y = w[1];
    *(uint2*)(dst + (size_t)r * 512 + lane * 8) = o;
    if (lane == 0) sc_out[2 * r] = sc;
  }
}

#define GEMM_F32(Aptr, Wt, Cptr, Rptr, M_, N_) do { \
    pg8::Gemm g_{opq((const bf16*)(Aptr)), opq((const bf16*)(Wt)), (M_), (N_), DM}; pg8::StaticOrder S_; S_.init((M_), (N_), (int)gridDim.x, (int)blockIdx.x); \
    pg8::EpiF32R E_{opq((float*)(Cptr)), opq((const float*)(Rptr)), (N_)}; \
    pg8::gemm_phase<pg8::EpiF32R, pg8::StaticOrder, true, true>(wave_s, ldsl, g_, S_, E_); } while (0)
#define GEMM_BF16_C(Aptr, Wt, Optr, M_, N_, C_) do { \
    pg8::Gemm g_{opq((const bf16*)(Aptr)), opq((const bf16*)(Wt)), (M_), (N_), DM}; pg8::StaticOrder S_; S_.init((M_), (N_), (int)gridDim.x, (C_)); \
    pg8::EpiBf16 E_{opq((bf16*)(Optr)), (N_)}; \
    pg8::gemm_phase<pg8::EpiBf16, pg8::StaticOrder, true, true>(wave_s, ldsl, g_, S_, E_); } while (0)
#define GEMM_BF16(Aptr, Wt, Optr, M_, N_) GEMM_BF16_C(Aptr, Wt, Optr, M_, N_, (int)blockIdx.x)
#define GEMM_F32RN(Aptr, Wt, Cptr, Rptr, XGptr, Gptr, STptr) do { \
    pg8::Gemm g_{opq((const bf16*)(Aptr)), opq((const bf16*)(Wt)), NT, DM, DM}; pg8::StaticOrder S_; S_.init(NT, DM, (int)gridDim.x, (int)blockIdx.x); \
    pg8::EpiF32RN E_{opq((float*)(Cptr)), opq((const float*)(Rptr)), DM, opq((bf16*)(XGptr)), opq((const float*)(Gptr)), opq((float*)(STptr))}; \
    pg8::gemm_phase<pg8::EpiF32RN, pg8::StaticOrder, true, true>(wave_s, ldsl, g_, S_, E_); } while (0)
#define GEMM_BF16S(Aptr, Wt, Optr, N_, STptr) do { \
    pg8::Gemm g_{opq((const bf16*)(Aptr)), opq((const bf16*)(Wt)), NT, (N_), DM}; pg8::StaticOrder S_; S_.init(NT, (N_), (int)gridDim.x, (int)blockIdx.x); \
    pg8::EpiBf16S E_{opq((bf16*)(Optr)), (N_), opq((const float*)(STptr))}; \
    pg8::gemm_phase<pg8::EpiBf16S, pg8::StaticOrder, true, true>(wave_s, ldsl, g_, S_, E_); } while (0)

__global__ void __launch_bounds__(NWAVES * 64, 2) fwd_megakernel(Params p) {
  extern __shared__ __attribute__((aligned(16))) unsigned char lds[];
  LAS unsigned char* ldsl = (LAS unsigned char*)lds;
  LAS float* smem = (LAS float*)ldsl;
  const int wave_s = __builtin_amdgcn_readfirstlane((int)(threadIdx.x >> 6));
  unsigned char* ws = p.ws;
  volatile LAS unsigned* MISC = (volatile LAS unsigned*)(ldsl + (LDS_BYTES - 256));
  if (threadIdx.x < 64) MISC[threadIdx.x] = 0u;
  __syncthreads();
  const XcdBarrier bar = xcd_barrier_post((unsigned*)(ws + WS_CTL) + 4096, MISC + 8);
  float* xw = (float*)(ws + WS_XW);
  bf16* xn = (bf16*)(ws + WS_XN);
  bf16* big = (bf16*)(ws + WS_BIG);
  bf16* y = (bf16*)(ws + WS_Y);
  bf16* memh = (bf16*)(ws + WS_MEMH);
  bf16* kvb = (bf16*)(ws + WS_KVB);
  bf16* vT = (bf16*)(ws + WS_VT);
  float* ssmE = (float*)(ws + WS_SSME);
  float* ssmp = (float*)(ws + WS_SSMP);
  int* ids = (int*)(ws + WS_IDS);
  float* gates = (float*)(ws + WS_GATE);
  bf16* skb = (bf16*)(ws + WS_SKB);
  unsigned char* ub = ws + WS_UB;
  unsigned char* vb = ws + WS_VB;
  float* rst = (float*)(ws + WS_RST);
  float* vsc = (float*)(ws + WS_VSC);
  float* usc = (float*)(ws + WS_USC);

  prologue_transposes(wave_s, p, ws, ldsl);
  cvt_rows_bf16(wave_s, karg_in(27), skb, (size_t)2 * 8 * 2 * 128 * 128);
  cvt_rows_i4(wave_s, karg_in(28), ub, vsc + 1, 2 * 16384);
  cvt_rows_v4(wave_s, karg_in(29), vb, vsc, 2 * 16384);
  for (int l = 0; l < 2; l++)
    rms_rows<true>(wave_s, karg_in(1), karg_in(21) + l * DM, memh + (size_t)l * 1024 * 1024, 1024);
  ssm_params(wave_s, p, ssmp);
  xcd_barrier(bar);
  rms_rows<true>(wave_s, karg_in(0), karg_in(2), xn, NT);
  xcd_barrier(bar);
  for (int l = 0; l < 2; l++)
    GEMM_BF16_C(memh + (size_t)l * 1024 * 1024, ws + WS_WT + (size_t)l * WT_LAYER + WT_MKV,
              kvb + (size_t)l * 1024 * 2048, 1024, 2048, (int)((blockIdx.x + gridDim.x - 64u - 32u * (unsigned)l) % gridDim.x));

#pragma nounroll
  for (int l = 0; l < 2; l++) {
    const float* xcur = (l == 0) ? karg_in(0) : xw;
    const float* sp = ssmp + (size_t)l * SSMP_PER_LAYER;
    const unsigned char* wl = ws + WS_WT + (size_t)l * WT_LAYER;
    GEMM_BF16(xn, wl + WT_IN, big, NT, DIN);
    xcd_barrier(bar);
    if (l == 0) vt_phase(wave_s, kvb, vT);
    ssm_chunk_end(wave_s, sp, big, ssmE, smem);
    attn_phase(wave_s, p, l, big, y, smem);
    conv_phase(wave_s, p, l, big, y, smem);
    xcd_barrier(bar);
    ssm_finish(wave_s, p, l, sp, big, ssmE, y, smem);
    xcd_barrier(bar);
    GEMM_F32RN(y, wl + WT_OUT, xw, xcur, xn, karg_in(20) + l * DM, rst);
    xcd_barrier(bar);
    GEMM_BF16S(xn, wl + WT_MQ, big, DM, rst);
    xcd_barrier(bar);
    memattn_phase(wave_s, big, kvb + (size_t)l * 1024 * 2048, vT + (size_t)l * 4 * 4 * 256 * 256, y, smem);
    xcd_barrier(bar);
    GEMM_F32RN(y, wl + WT_MO, xw, (const float*)xw, xn, karg_in(25) + l * DM, rst);
    xcd_barrier(bar);
    GEMM_BF16S(xn, wl + WT_PQ, big, 2048, rst);
    xcd_barrier(bar);
    peer_topk(wave_s, big, skb + (size_t)l * 8 * 2 * 128 * 128, ids, gates, smem);
    xcd_barrier(bar);
    if (l == 0) {
      peer_gather<false>(wave_s, xn, rst, ub + (size_t)l * 16384 * 512, vb + (size_t)l * 16384 * 512, vsc + (size_t)l * 2 * 16384, usc, ids, gates, xw, karg_in(2) + DM, (float*)nullptr);
      xcd_barrier(bar);
    } else {
      peer_gather<true>(wave_s, xn, rst, ub + (size_t)l * 16384 * 512, vb + (size_t)l * 16384 * 512, vsc + (size_t)l * 2 * 16384, usc, ids, gates, xw, karg_in(30), p.out);
    }
  }
}

extern "C" void kernel_launch(void* const* d_in, const int* in_sizes, int n_in,
                              void* d_out, int out_size, void* d_ws, size_t ws_size,
                              hipStream_t stream) {
  static int grid_blocks = 0;
  if (!grid_blocks) {
    int dev = 0, cus = 0, per_cu = 0;
    (void)hipGetDevice(&dev);
    (void)hipDeviceGetAttribute(&cus, hipDeviceAttributeMultiprocessorCount, dev);
    (void)hipFuncSetAttribute((const void*)fwd_megakernel, hipFuncAttributeMaxDynamicSharedMemorySize, LDS_BYTES);
    (void)hipOccupancyMaxActiveBlocksPerMultiprocessor(&per_cu, fwd_megakernel, NWAVES * 64, LDS_BYTES);
    if (per_cu < 1) fprintf(stderr, "occupancy query reports %d blocks/CU\n", per_cu);
    grid_blocks = cus;
  }
  (void)hipMemsetAsync((char*)d_ws + WS_CTL, 0, 1 * MiB, stream);
  Params p{};
  for (int i = 0; i < 31; i++) p.in[i] = (const float*)d_in[i];
  p.out = (float*)d_out;
  p.ws = (unsigned char*)d_ws;
  void* args[] = {&p};
  hipError_t e = hipLaunchCooperativeKernel((void*)fwd_megakernel, dim3(grid_blocks), dim3(NWAVES * 64),
                                            args, LDS_BYTES, stream);
  if (e != hipSuccess)
    fprintf(stderr, "cooperative launch failed: %s (grid %d)\n", hipGetErrorString(e), grid_blocks);
}
```

```cpp
#include <hip/hip_runtime.h>
#include <hip/hip_cooperative_groups.h>
#include <cstdio>
namespace cg = cooperative_groups;

#define NT 16384
#define SEQ 4096
#define DM 1024
#define DIN 2304
#define NMEM 256
#define EPSF 1e-6f
#define NWAVES 8
#define LDS_BYTES 147456

typedef unsigned short bf16;
#define LAS __attribute__((address_space(3)))

struct Params {
  const float* in[31];
  float* out;
  unsigned char* ws;
};
typedef __attribute__((address_space(4))) const unsigned char* kaptr_t;
__device__ __forceinline__ const float* karg_in(int i) {
  kaptr_t ka = (kaptr_t)__builtin_amdgcn_kernarg_segment_ptr();
  asm volatile("" : "+s"(ka));
  return *(const float* __attribute__((address_space(4))) const*)(ka + 8 * i);
}

constexpr size_t MiB = 1u << 20;
constexpr size_t WS_CTL  = 0;
constexpr size_t WS_WT   = 1 * MiB;
constexpr size_t WT_IN = 0, WT_OUT = WT_IN + (size_t)DIN * DM * 2, WT_MQ = WT_OUT + (size_t)DM * DM * 2,
                 WT_MKV = WT_MQ + (size_t)DM * DM * 2, WT_MO = WT_MKV + (size_t)2048 * DM * 2,
                 WT_PQ = WT_MO + (size_t)DM * DM * 2, WT_GLU = WT_PQ + (size_t)2048 * DM * 2, WT_LAYER = WT_GLU + (size_t)256 * 256 * 2;
constexpr size_t WS_XW   = WS_WT + 2 * WT_LAYER;
constexpr size_t WS_XN   = WS_XW + (size_t)NT * DM * 4;
constexpr size_t WS_BIG  = WS_XN + (size_t)NT * DM * 2;
constexpr size_t WS_Y    = WS_BIG + (size_t)NT * DIN * 2;
constexpr size_t WS_MEMH = WS_Y + (size_t)NT * DM * 2;
constexpr size_t WS_KVB  = WS_MEMH + (size_t)2 * 1024 * 1024 * 2;
constexpr size_t WS_VT   = WS_KVB + (size_t)2 * 1024 * 2048 * 2;
constexpr size_t WS_SSME = WS_VT + (size_t)2 * 4 * 4 * 256 * 256 * 2;
#define SSMP_PER_LAYER (2048 + 2048 + 32768)
constexpr size_t WS_SSMP = WS_SSME + (size_t)4 * 64 * 16 * 64 * 2 * 4;
constexpr size_t WS_IDS  = WS_SSMP + (size_t)2 * SSMP_PER_LAYER * 4;
constexpr size_t WS_GATE = WS_IDS + (size_t)NT * 128 * 4;
constexpr size_t WS_SKB  = WS_GATE + (size_t)NT * 128 * 4;
constexpr size_t WS_UB   = WS_SKB + (size_t)2 * 8 * 2 * 128 * 128 * 2;
constexpr size_t WS_VB   = WS_UB + (size_t)2 * 16384 * 512;
constexpr size_t WS_VSC  = WS_VB + (size_t)2 * 16384 * 512;
constexpr size_t WS_USC  = WS_VSC + (size_t)2 * 16384 * 4;
constexpr size_t WS_RST  = WS_USC + (size_t)2 * 16384 * 4;
constexpr size_t WS_END  = WS_RST + (size_t)NT * 16 * 4;
#define U_SCALE 64.0f
#define U4_STEP 0.3352f
#define V4_LUT_LO 0x3B393630u
#define V4_LUT_HI 0x41403E3Du
#define V4_ROWSCALE 1.075f
static_assert(WS_END <= 512 * MiB, "workspace");
static_assert(WT_LAYER % 256 == 0 && WS_SSMP % 16 == 0 && WS_IDS % 16 == 0 && WS_SKB % 256 == 0 && WS_VT % 256 == 0, "align");

__device__ __forceinline__ int opaque_tid(int wave_s) { int v = wave_s * 64 + (int)__builtin_amdgcn_mbcnt_hi(~0u, __builtin_amdgcn_mbcnt_lo(~0u, 0u)); asm volatile("" : "+v"(v)); return v; }
typedef __bf16 bf16n2_t __attribute__((ext_vector_type(2)));
typedef float f32n2_t __attribute__((ext_vector_type(2)));
__device__ __forceinline__ unsigned pk2(float lo, float hi) { f32n2_t v; v[0] = lo; v[1] = hi; return __builtin_bit_cast(unsigned, __builtin_convertvector(v, bf16n2_t)); }
__device__ __forceinline__ unsigned f2bf(float f) { return (unsigned)__builtin_bit_cast(unsigned short, (__bf16)f); }
__device__ __forceinline__ float bf_lo(unsigned u) { return __builtin_bit_cast(float, u << 16); }
__device__ __forceinline__ float bf_hi(unsigned u) { return __builtin_bit_cast(float, u & 0xffff0000u); }
__device__ __forceinline__ float bf2f(bf16 h) { return __builtin_bit_cast(float, (unsigned)h << 16); }


#define XB_TMO      128
#define XB_XCNT(j)  (256  + 64 * (j))
#define XB_XSUB(j)  (1280 + 64 * (j))
#define XB_XGEN(j)  (2304 + 64 * (j))
#define XB_TOP      3328
#define XB_TOPGEN   3392
#define XCD_BAR_WORDS 3456
#define XB_SPIN_CAP (1u << 22)
__device__ __forceinline__ unsigned xb_ld(unsigned* p)              { return __hip_atomic_load(p, __ATOMIC_RELAXED, __HIP_MEMORY_SCOPE_AGENT); }
__device__ __forceinline__ unsigned xb_add(unsigned* p, unsigned v) { return __hip_atomic_fetch_add(p, v, __ATOMIC_RELAXED, __HIP_MEMORY_SCOPE_AGENT); }
__device__ __forceinline__ unsigned xb_xcc_id() { return (unsigned)__builtin_amdgcn_s_getreg((3 << 11) | 20) & 0xFu; }
#define XB_SPIN(cond, bar) do { unsigned _sp = 0; while (cond) { __builtin_amdgcn_s_sleep(1); \
    if ((++_sp & 255u) == 0u) { if (xb_ld(&(bar)[XB_TMO])) break; if (_sp > XB_SPIN_CAP) { atomicAdd(&(bar)[XB_TMO], 1u); break; } } } } while (0)
struct XcdBarrier { unsigned* bar; unsigned x; volatile LAS unsigned* st; };
__device__ __forceinline__ XcdBarrier xcd_barrier_post(unsigned* bar, volatile LAS unsigned* st) {
    XcdBarrier b; b.bar = bar; b.x = xb_xcc_id(); b.st = st;
    if (threadIdx.x == 0) (void)xb_add(&bar[XB_XCNT(b.x)], 1u);
    return b;
}
__device__ __forceinline__ void xcd_barrier_complete(unsigned* bar, unsigned x, unsigned& nloc, unsigned& nx) {
    const unsigned G = gridDim.x * gridDim.y * gridDim.z;
    unsigned sum, cnt, mine, sp = 0u;
    for (;;) {
        sum = 0u; cnt = 0u; mine = 0u;
#pragma unroll
        for (unsigned j = 0; j < 16; ++j) { const unsigned c = xb_ld(&bar[XB_XCNT(j)]); sum += c; cnt += (c > 0u) ? 1u : 0u; mine = (j == x) ? c : mine; }
        if (sum == G) break;
        __builtin_amdgcn_s_sleep(1);
        if ((++sp & 255u) == 0u) { if (xb_ld(&bar[XB_TMO])) break; if (sp > XB_SPIN_CAP) { atomicAdd(&bar[XB_TMO], 1u); break; } }
    }
    nloc = mine > 0u ? mine : 1u; nx = cnt > 0u ? cnt : 1u;
}
__device__ __forceinline__ void xcd_barrier(const XcdBarrier& b) {
    asm volatile("s_waitcnt vmcnt(0)" ::: "memory");
    __syncthreads();
    if (threadIdx.x == 0) {
        unsigned* bar = b.bar;
        __builtin_amdgcn_s_waitcnt(0);
        unsigned nloc = b.st[0], nx = b.st[1];
        if (nloc == 0u) { xcd_barrier_complete(bar, b.x, nloc, nx); b.st[0] = nloc; b.st[1] = nx; }
        const unsigned old = xb_add(&bar[XB_XSUB(b.x)], 1u);
        const unsigned gen = old / nloc;
        if (old + 1u == (gen + 1u) * nloc) {
            __builtin_amdgcn_fence(__ATOMIC_RELEASE, "agent");
            asm volatile("s_waitcnt vmcnt(0)" ::: "memory");
            const unsigned og = xb_add(&bar[XB_TOP], 1u);
            const unsigned tg = og / nx;
            if (og + 1u == (tg + 1u) * nx) xb_add(&bar[XB_TOPGEN], 1u);
            else XB_SPIN(xb_ld(&bar[XB_TOPGEN]) == tg, bar);
            __builtin_amdgcn_fence(__ATOMIC_ACQUIRE, "agent");
            xb_add(&bar[XB_XGEN(b.x)], 1u);
            asm volatile("s_waitcnt vmcnt(0)" ::: "memory");
        } else {
            XB_SPIN(xb_ld(&bar[XB_XGEN(b.x)]) == gen, bar);
            __builtin_amdgcn_fence(__ATOMIC_ACQUIRE, "agent");
            asm volatile("s_waitcnt vmcnt(0)" ::: "memory");
        }
    }
    __syncthreads();
}

namespace pg8 {
#define PG8_LAS __attribute__((address_space(3)))
typedef unsigned short bf16_t;
typedef short bf16x8 __attribute__((ext_vector_type(8)));
typedef float f32x4 __attribute__((ext_vector_type(4)));
typedef unsigned u32x4 __attribute__((ext_vector_type(4)));
constexpr int BM = 256, BK = 64, HALF = 128, HTB = HALF * BK * 2, STAGE_BYTES = 8 * HTB, NXCD = 8, WGM = 8;
__host__ __device__ __forceinline__ int lds_byte(int r, int c) { const int st = (r >> 4) * 2 + (c >> 5), rr = r & 15, cc = c & 31, ob = rr * 64 + cc * 2; return st * 1024 + (ob ^ (((ob >> 9) & 1) << 5)); }
__host__ __device__ __forceinline__ void stage_rc(int b, int& R, int& C) { const int st = b / 1024, sb = b % 1024, swz = sb ^ (((sb >> 9) & 1) << 5); R = (st >> 1) * 16 + swz / 64; C = (st & 1) * 32 + (swz % 64) / 2; }
__host__ __device__ __forceinline__ int perm32(int rho) { const int n = rho >> 4, i = rho & 15; return 8 * (i >> 2) + 4 * n + (i & 3); }
struct Unit { int pm, pn; };
struct Gemm { const bf16_t* A; const bf16_t* Bt; int M, N, K; };
struct StaticOrder {
    int nM, nN, nwg, G, c;
    __host__ __device__ __forceinline__ void init(int M, int N, int G_, int c_) { nM = M / BM; nN = N / BM; nwg = nM * nN; G = G_; c = c_; }
    __host__ __device__ bool next(int i, Unit& u) const {
        const long L = (long)i * G + c; if (L >= nwg) return false;
        int wgid = (int)L; { const int q = nwg / NXCD, r = nwg % NXCD, xcd = wgid % NXCD, off = wgid / NXCD; wgid = (xcd < r ? xcd * (q + 1) : r * (q + 1) + (xcd - r) * q) + off; }
        const int nig = WGM * nN, gid = wgid / nig, fm = gid * WGM, gsz = (nM - fm) < WGM ? (nM - fm) : WGM;
        u.pm = fm + ((wgid % nig) % gsz); u.pn = (wgid % nig) / gsz; return true;
    }
    __device__ __forceinline__ void a_ready(const Unit&) const {}
    __device__ __forceinline__ void done(const Unit&) const {}
};
__device__ __forceinline__ unsigned cvt_pk_bf16(float lo, float hi) { unsigned r; asm volatile("v_cvt_pk_bf16_f32 %0, %1, %2" : "=v"(r) : "v"(lo), "v"(hi)); return r; }

struct EpiF32R {
    static constexpr bool PERM = false, AFTER_DRAIN = false;
    float* C; const float* R; int ldc;
    __device__ __forceinline__ void operator()(const f32x4 (&acc)[2][2][4][2], const Unit& u, int wr, int wc, int fr, int fq) const {
        const int row0 = u.pm * BM + wr * 64 + fr, col0 = u.pn * BM + wc * 32 + 4 * fq;
#pragma unroll
        for (int ai = 0; ai < 2; ++ai)
#pragma unroll
            for (int m = 0; m < 4; ++m) {
                const size_t ro = (size_t)(row0 + ai * HALF + m * 16) * ldc + col0;
                f32x4 rv[2][2];
#pragma unroll
                for (int bj = 0; bj < 2; ++bj)
#pragma unroll
                    for (int n = 0; n < 2; ++n) rv[bj][n] = R ? *(const f32x4*)(R + ro + bj * HALF + n * 16) : (f32x4){0.f, 0.f, 0.f, 0.f};
#pragma unroll
                for (int bj = 0; bj < 2; ++bj)
#pragma unroll
                    for (int n = 0; n < 2; ++n) *(f32x4*)(C + ro + bj * HALF + n * 16) = acc[ai][bj][m][n] + rv[bj][n];
                __builtin_amdgcn_sched_barrier(0);
            }
    }
};

struct EpiBf16 {
    static constexpr bool PERM = true, AFTER_DRAIN = false;
    bf16_t* O; int ldc;
    __device__ __forceinline__ void operator()(const f32x4 (&acc)[2][2][4][2], const Unit& u, int wr, int wc, int fr, int fq) const {
        const int row0 = u.pm * BM + wr * 64 + fr, col0 = u.pn * BM + wc * 32 + 8 * fq;
#pragma unroll
        for (int ai = 0; ai < 2; ++ai)
#pragma unroll
            for (int m = 0; m < 4; ++m) { bf16_t* rowp = O + (size_t)(row0 + ai * HALF + m * 16) * ldc + col0;
#pragma unroll
                for (int bj = 0; bj < 2; ++bj) { const f32x4 v0 = acc[ai][bj][m][0], v1 = acc[ai][bj][m][1];
                    u32x4 w; w.x = cvt_pk_bf16(v0[0], v0[1]); w.y = cvt_pk_bf16(v0[2], v0[3]); w.z = cvt_pk_bf16(v1[0], v1[1]); w.w = cvt_pk_bf16(v1[2], v1[3]);
                    *(u32x4*)(rowp + bj * HALF) = w; } }
    }
};

struct EpiF32RN {
    static constexpr bool PERM = false, AFTER_DRAIN = false;
    float* C; const float* R; int ldc; bf16_t* XG; const float* g; float* st;
    __device__ __forceinline__ void operator()(const f32x4 (&acc)[2][2][4][2], const Unit& u, int wr, int wc, int fr, int fq) const {
        const int row0 = u.pm * BM + wr * 64 + fr, col0 = u.pn * BM + wc * 32 + 4 * fq;
        f32x4 gv[2][2];
#pragma unroll
        for (int bj = 0; bj < 2; ++bj)
#pragma unroll
            for (int n = 0; n < 2; ++n) gv[bj][n] = *(const f32x4*)(g + col0 + bj * HALF + n * 16);
#pragma unroll
        for (int ai = 0; ai < 2; ++ai)
#pragma unroll
            for (int m = 0; m < 4; ++m) {
                const int row = row0 + ai * HALF + m * 16;
                const size_t ro = (size_t)row * ldc + col0;
                f32x4 rv[2][2];
#pragma unroll
                for (int bj = 0; bj < 2; ++bj)
#pragma unroll
                    for (int n = 0; n < 2; ++n) rv[bj][n] = *(const f32x4*)(R + ro + bj * HALF + n * 16);
                float ss = 0.f;
#pragma unroll
                for (int bj = 0; bj < 2; ++bj)
#pragma unroll
                    for (int n = 0; n < 2; ++n) {
                        const f32x4 v = acc[ai][bj][m][n] + rv[bj][n];
                        *(f32x4*)(C + ro + bj * HALF + n * 16) = v;
                        ss += (v[0] * v[0] + v[1] * v[1]) + (v[2] * v[2] + v[3] * v[3]);
                        const f32x4 w = v * gv[bj][n];
                        uint2 pk; pk.x = cvt_pk_bf16(w[0], w[1]); pk.y = cvt_pk_bf16(w[2], w[3]);
                        *(uint2*)(XG + ro + bj * HALF + n * 16) = pk;
                    }
                ss += __shfl_xor(ss, 16, 64); ss += __shfl_xor(ss, 32, 64);
                if (fq == 0) st[(size_t)row * 16 + u.pn * 4 + wc] = ss;
                __builtin_amdgcn_sched_barrier(0);
            }
    }
};
struct EpiBf16S {
    static constexpr bool PERM = true, AFTER_DRAIN = false;
    bf16_t* O; int ldc; const float* st;
    __device__ __forceinline__ void operator()(const f32x4 (&acc)[2][2][4][2], const Unit& u, int wr, int wc, int fr, int fq) const {
        const int row0 = u.pm * BM + wr * 64 + fr, col0 = u.pn * BM + wc * 32 + 8 * fq;
#pragma unroll
        for (int ai = 0; ai < 2; ++ai)
#pragma unroll
            for (int m = 0; m < 4; ++m) {
                const int row = row0 + ai * HALF + m * 16;
                const f32x4* sp = (const f32x4*)(st + (size_t)row * 16);
                const f32x4 s0 = sp[0], s1 = sp[1], s2 = sp[2], s3 = sp[3];
                const f32x4 sa = (s0 + s1) + (s2 + s3);
                const float rs = __builtin_amdgcn_rsqf(((sa[0] + sa[1]) + (sa[2] + sa[3])) * (1.0f / 1024.f) + 1e-6f);
                bf16_t* rowp = O + (size_t)row * ldc + col0;
#pragma unroll
                for (int bj = 0; bj < 2; ++bj) { const f32x4 v0 = acc[ai][bj][m][0] * rs, v1 = acc[ai][bj][m][1] * rs;
                    u32x4 w; w.x = cvt_pk_bf16(v0[0], v0[1]); w.y = cvt_pk_bf16(v0[2], v0[3]); w.z = cvt_pk_bf16(v1[0], v1[1]); w.w = cvt_pk_bf16(v1[2], v1[3]);
                    *(u32x4*)(rowp + bj * HALF) = w; }
                __builtin_amdgcn_sched_barrier(0);
            }
    }
};

template <class Epi, class Sched, bool ALIGN_EPI = false, bool SP2 = false>
__device__ __forceinline__ void gemm_phase(const int wave_s, PG8_LAS unsigned char* lds, const Gemm g, const Sched& S, const Epi& E) {
    const int tid = opaque_tid(wave_s), wid = __builtin_amdgcn_readfirstlane(tid >> 6), lane = tid & 63, wr = wid >> 2, wc = wid & 3, fr = lane & 15, fq = lane >> 4;
    const int K = g.K, nt = K / BK;
    unsigned voffA[2], voffB[2];
#pragma unroll
    for (int i = 0; i < 2; ++i) { int R, C; stage_rc(tid * 16 + i * 8192, R, C); const int Rb = Epi::PERM ? ((R & ~31) + perm32(R & 31)) : R;
        voffA[i] = (unsigned)(R * K + C) * 2u; voffB[i] = (unsigned)(Rb * K + C) * 2u; }
    const size_t kstep = (size_t)(BK * 2);
    const size_t hstep = (size_t)HALF * K * 2;
    const size_t tstep = 2 * hstep;
    const unsigned ldsw = (unsigned)wid * 1024u;
    const int aoff = lds_byte(wr * 64 + fr, fq * 8), boff = lds_byte(wc * 32 + fr, fq * 8);
#define PG8_SA(b, h) (((b) * 2 + (h)) * HTB)
#define PG8_SB(b, h) ((4 + (b) * 2 + (h)) * HTB)
#define PG8_STAGE(bufoff, gbase, voff) do { _Pragma("unroll") for (int _i = 0; _i < 2; ++_i) \
        __builtin_amdgcn_global_load_lds((const unsigned*)((const char*)(gbase) + (voff)[_i]), (PG8_LAS unsigned*)(lds + (bufoff) + ldsw + _i * 8192), 16, 0, 0); } while (0)
#define PG8_LDA(dst, b, h) do { _Pragma("unroll") for (int m = 0; m < 4; ++m) _Pragma("unroll") for (int k = 0; k < 2; ++k) dst[m][k] = *(const PG8_LAS bf16x8*)(lds + PG8_SA(b, h) + aoff + m * 2048 + k * 1024); } while (0)
#define PG8_LDB(dst, b, h) do { _Pragma("unroll") for (int n = 0; n < 2; ++n) _Pragma("unroll") for (int k = 0; k < 2; ++k) dst[n][k] = *(const PG8_LAS bf16x8*)(lds + PG8_SB(b, h) + boff + n * 2048 + k * 1024); } while (0)
#define PG8_MMA(ai, bj, At, Bt) do { __builtin_amdgcn_s_setprio(1); _Pragma("unroll") for (int m = 0; m < 4; ++m) _Pragma("unroll") for (int n = 0; n < 2; ++n) _Pragma("unroll") for (int k = 0; k < 2; ++k) \
        acc[ai][bj][m][n] = __builtin_amdgcn_mfma_f32_16x16x32_bf16(Bt[n][k], At[m][k], acc[ai][bj][m][n], 0, 0, 0); __builtin_amdgcn_s_setprio(0); } while (0)
#define PG8_WAIT_V(n) asm volatile("s_waitcnt vmcnt(" #n ")" ::: "memory")
#define PG8_WAIT_L(n) asm volatile("s_waitcnt lgkmcnt(" #n ")" ::: "memory")
#define PG8_BAR __builtin_amdgcn_s_barrier()
#define PG8_SCHED __builtin_amdgcn_sched_barrier(0)
    Unit cur, nxt; int ui = 0;
    if (!S.next(0, cur)) return;
    f32x4 acc[2][2][4][2];
#pragma unroll
    for (int a = 0; a < 2; ++a)
#pragma unroll
        for (int b = 0; b < 2; ++b)
#pragma unroll
            for (int m = 0; m < 4; ++m)
#pragma unroll
                for (int n = 0; n < 2; ++n) acc[a][b][m][n] = (f32x4){0.f, 0.f, 0.f, 0.f};
    bf16x8 At[4][2], B0[2][2], B1[2][2];
    const char* cA = (const char*)g.A + (size_t)cur.pm * tstep; const char* cB = (const char*)g.Bt + (size_t)cur.pn * tstep;
    S.a_ready(cur);
    if constexpr (SP2) {
        PG8_STAGE(PG8_SB(0, 0), cB, voffB); PG8_STAGE(PG8_SB(0, 1), cB + hstep, voffB); PG8_STAGE(PG8_SA(0, 0), cA, voffA); PG8_STAGE(PG8_SA(0, 1), cA + hstep, voffA);
        if (wr == 1) PG8_BAR;
        PG8_WAIT_V(2); PG8_BAR;
        PG8_STAGE(PG8_SB(1, 0), cB + kstep, voffB); PG8_STAGE(PG8_SA(1, 0), cA + kstep, voffA); PG8_STAGE(PG8_SB(1, 1), cB + hstep + kstep, voffB);
        PG8_WAIT_V(6); PG8_BAR;
    } else {
        PG8_STAGE(PG8_SB(0, 0), cB, voffB); PG8_STAGE(PG8_SA(0, 0), cA, voffA); PG8_STAGE(PG8_SB(0, 1), cB + hstep, voffB); PG8_STAGE(PG8_SA(0, 1), cA + hstep, voffA);
        if (wr == 1) PG8_BAR;
        PG8_WAIT_V(4); PG8_BAR;
        PG8_STAGE(PG8_SB(1, 0), cB + kstep, voffB); PG8_STAGE(PG8_SA(1, 0), cA + kstep, voffA); PG8_STAGE(PG8_SB(1, 1), cB + hstep + kstep, voffB);
        PG8_WAIT_V(6); PG8_BAR;
    }
    for (;;) {
        const bool has_next = S.next(ui + 1, nxt);
        const char* nA = has_next ? (const char*)g.A + (size_t)nxt.pm * tstep : cA; const char* nB = has_next ? (const char*)g.Bt + (size_t)nxt.pn * tstep : cB;
        for (int t = 0; t < nt; t += 2) {
            const bool last = (t == nt - 2);
            const char* a1 = cA + (size_t)(t + 1) * kstep;
            const char* a2 = last ? nA : cA + (size_t)(t + 2) * kstep; const char* b2 = last ? nB : cB + (size_t)(t + 2) * kstep;
            const char* a3 = a2 + kstep; const char* b3 = b2 + kstep;
            if (last && has_next) S.a_ready(nxt);
            if constexpr (SP2) {
            PG8_LDB(B0, 0, 0); PG8_LDB(B1, 0, 1); PG8_SCHED; PG8_LDA(At, 0, 0); PG8_STAGE(PG8_SA(1, 1), a1 + hstep, voffA);
            PG8_WAIT_V(8); PG8_WAIT_L(0); PG8_BAR; PG8_MMA(0, 0, At, B0); PG8_MMA(0, 1, At, B1); PG8_BAR; PG8_SCHED;
            PG8_LDA(At, 0, 1); PG8_STAGE(PG8_SB(0, 0), b2, voffB); PG8_STAGE(PG8_SB(0, 1), b2 + hstep, voffB); PG8_STAGE(PG8_SA(0, 0), a2, voffA);
            PG8_WAIT_V(8); PG8_WAIT_L(0); PG8_BAR; PG8_MMA(1, 0, At, B0); PG8_MMA(1, 1, At, B1); PG8_BAR; PG8_SCHED;
            PG8_LDB(B0, 1, 0); PG8_LDB(B1, 1, 1); PG8_SCHED; PG8_LDA(At, 1, 0); PG8_STAGE(PG8_SA(0, 1), a2 + hstep, voffA);
            PG8_WAIT_V(8); PG8_WAIT_L(0); PG8_BAR; PG8_MMA(0, 0, At, B0); PG8_MMA(0, 1, At, B1); PG8_BAR; PG8_SCHED;
            PG8_LDA(At, 1, 1); PG8_STAGE(PG8_SB(1, 0), b3, voffB); PG8_STAGE(PG8_SB(1, 1), b3 + hstep, voffB); PG8_STAGE(PG8_SA(1, 0), a3, voffA);
            PG8_WAIT_V(8); PG8_WAIT_L(0); PG8_BAR; PG8_MMA(1, 0, At, B0); PG8_MMA(1, 1, At, B1); PG8_BAR; PG8_SCHED;
            } else {
            PG8_LDB(B0, 0, 0); PG8_SCHED; PG8_LDA(At, 0, 0); PG8_STAGE(PG8_SA(1, 1), a1 + hstep, voffA);
            PG8_WAIT_L(8); PG8_BAR; PG8_WAIT_L(0); PG8_MMA(0, 0, At, B0); PG8_BAR; PG8_SCHED;
            PG8_LDB(B1, 0, 1); PG8_STAGE(PG8_SB(0, 0), b2, voffB);
            PG8_BAR; PG8_WAIT_L(0); PG8_MMA(0, 1, At, B1); PG8_BAR;
            PG8_LDA(At, 0, 1); PG8_STAGE(PG8_SA(0, 0), a2, voffA);
            PG8_BAR; PG8_WAIT_L(0); PG8_MMA(1, 0, At, B0); PG8_BAR; PG8_SCHED;
            PG8_STAGE(PG8_SB(0, 1), b2 + hstep, voffB);
            PG8_WAIT_V(6); PG8_BAR; PG8_MMA(1, 1, At, B1); PG8_BAR;
            PG8_LDB(B0, 1, 0); PG8_SCHED; PG8_LDA(At, 1, 0); PG8_STAGE(PG8_SA(0, 1), a2 + hstep, voffA);
            PG8_WAIT_L(8); PG8_BAR; PG8_WAIT_L(0); PG8_MMA(0, 0, At, B0); PG8_BAR; PG8_SCHED;
            PG8_LDB(B1, 1, 1); PG8_STAGE(PG8_SB(1, 0), b3, voffB);
            PG8_BAR; PG8_WAIT_L(0); PG8_MMA(0, 1, At, B1); PG8_BAR;
            PG8_LDA(At, 1, 1); PG8_STAGE(PG8_SA(1, 0), a3, voffA);
            PG8_BAR; PG8_WAIT_L(0); PG8_MMA(1, 0, At, B0); PG8_BAR; PG8_SCHED;
            PG8_STAGE(PG8_SB(1, 1), b3 + hstep, voffB);
            PG8_WAIT_V(6); PG8_BAR; PG8_MMA(1, 1, At, B1); PG8_BAR;
            }
        }
        if constexpr (ALIGN_EPI) { if (wr == 0) PG8_BAR; }
        if constexpr (!Epi::AFTER_DRAIN) { E(acc, cur, wr, wc, fr, fq); S.done(cur); }
        if (!has_next) break;
#pragma unroll
        for (int a = 0; a < 2; ++a)
#pragma unroll
            for (int b = 0; b < 2; ++b)
#pragma unroll
                for (int m = 0; m < 4; ++m)
#pragma unroll
                    for (int n = 0; n < 2; ++n) acc[a][b][m][n] = (f32x4){0.f, 0.f, 0.f, 0.f};
        cur = nxt; cA = nA; cB = nB; ++ui;
        if constexpr (ALIGN_EPI) { if (wr == 1) PG8_BAR; }
    }
    PG8_WAIT_V(0);
    if constexpr (!ALIGN_EPI) { if (wr == 0) PG8_BAR; }
    PG8_BAR;
#undef PG8_SA
#undef PG8_SB
#undef PG8_STAGE
#undef PG8_LDA
#undef PG8_LDB
#undef PG8_MMA
#undef PG8_WAIT_V
#undef PG8_WAIT_L
#undef PG8_BAR
#undef PG8_SCHED
}
}

__device__ __forceinline__ void transpose_item(const float* W, int K, int N, bf16* WT, LAS float* scr, int item, int lane) {
    const int nblk = N / 32, kb = item / nblk, nb = item % nblk, k0 = 64 * kb, n0 = 32 * nb;
#pragma unroll 8
    for (int i = 0; i < 32; ++i) { const int kk = 2 * i + (lane >> 5); scr[kk * 33 + (lane & 31)] = W[(size_t)(k0 + kk) * N + n0 + (lane & 31)]; }
    asm volatile("s_waitcnt lgkmcnt(0)" ::: "memory");
    const int c = lane & 7;
#pragma unroll
    for (int j = 0; j < 4; ++j) { const int n = (lane >> 3) + 8 * j; const LAS float* s = scr + (8 * c) * 33 + n;
        uint4 o; o.x = pk2(s[0 * 33], s[1 * 33]); o.y = pk2(s[2 * 33], s[3 * 33]); o.z = pk2(s[4 * 33], s[5 * 33]); o.w = pk2(s[6 * 33], s[7 * 33]);
        *(uint4*)(WT + (size_t)(n0 + n) * K + k0 + 8 * c) = o; }
    asm volatile("s_waitcnt lgkmcnt(0)" ::: "memory");
}

__device__ __forceinline__ float wsum(float v) {
#pragma unroll
  for (int o = 32; o > 0; o >>= 1) v += __shfl_xor(v, o, 64);
  return v;
}
__device__ __forceinline__ float wmaxf(float v) {
#pragma unroll
  for (int o = 32; o > 0; o >>= 1) v = fmaxf(v, __shfl_xor(v, o, 64));
  return v;
}
__device__ __forceinline__ float sigmoidf_(float x) { return __builtin_amdgcn_rcpf(1.0f + __expf(-x)); }
__device__ __forceinline__ float gelu_tanh(float x) {
  return x * sigmoidf_(1.5957691216057308f * (x + 0.044715f * x * x * x));
}

template <bool BF16OUT>
__device__ __forceinline__ void rms_rows(const int wave_s, const float* src, const float* g, void* dstv, int rows) {
  const int tid_ = opaque_tid(wave_s);
  const int lane = tid_ & 63;
  const int gw = blockIdx.x * NWAVES + (tid_ >> 6);
  const int nw = gridDim.x * NWAVES;
  for (int r = gw; r < rows; r += nw) {
    const float4* s4 = (const float4*)(src + (size_t)r * DM);
    float4 v[4];
    float ss = 0.f;
#pragma unroll
    for (int i = 0; i < 4; i++) {
      v[i] = s4[lane + i * 64];
      ss += v[i].x * v[i].x + v[i].y * v[i].y + v[i].z * v[i].z + v[i].w * v[i].w;
    }
    ss = wsum(ss);
    const float rstd = rsqrtf(ss * (1.0f / DM) + EPSF);
    const float4* g4 = (const float4*)g;
#pragma unroll
    for (int i = 0; i < 4; i++) {
      float4 gg = g4[lane + i * 64];
      float4 o;
      o.x = v[i].x * rstd * gg.x; o.y = v[i].y * rstd * gg.y;
      o.z = v[i].z * rstd * gg.z; o.w = v[i].w * rstd * gg.w;
      if (BF16OUT) {
        uint2 pk; pk.x = pk2(o.x, o.y); pk.y = pk2(o.z, o.w);
        ((uint2*)((bf16*)dstv + (size_t)r * DM))[lane + i * 64] = pk;
      } else {
        ((float4*)((float*)dstv + (size_t)r * DM))[lane + i * 64] = o;
      }
    }
  }
}

__device__ __forceinline__ void ssm_params(const int wave_s, const Params& p, float* ssmp_all) {
  const int tid_ = opaque_tid(wave_s);
  const float* in8 = karg_in(8); const float* in9 = karg_in(9); const float* in10 = karg_in(10);
  const float* in11 = karg_in(11); const float* in12 = karg_in(12);
  const int gt = blockIdx.x * blockDim.x + tid_;
  const int nth = gridDim.x * blockDim.x;
  for (int i = gt; i < 2 * 16 * 64; i += nth) {
    const int l = i / 1024, gp = i % 1024, g = gp / 64;
    float* sp = ssmp_all + (size_t)l * SSMP_PER_LAYER;
    const float lre = fminf(in8[l * 1024 + gp], -1e-4f);
    const float lim = in9[l * 1024 + gp];
    const float dt = expf(in10[l * 16 + g]);
    const float er = expf(lre * dt);
    float sn, cs;
    sincosf(lim * dt, &sn, &cs);
    const float br = er * cs, bi = er * sn;
    sp[gp * 2 + 0] = br;
    sp[gp * 2 + 1] = bi;
    float cr = br, ci = bi;
#pragma unroll
    for (int s = 0; s < 6; s++) {
      const float nr = cr * cr - ci * ci, ni = 2.f * cr * ci;
      cr = nr; ci = ni;
    }
    sp[2048 + gp * 2 + 0] = cr;
    sp[2048 + gp * 2 + 1] = ci;
    const float nr = br - 1.0f, ni = bi;
    const float den = lre * lre + lim * lim;
    const float fr = (nr * lre + ni * lim) / den;
    const float fi = (ni * lre - nr * lim) / den;
    for (int h = 0; h < 16; h++) {
      const float bre = in11[((size_t)l * 1024 + gp) * 16 + h];
      const float bim = in12[((size_t)l * 1024 + gp) * 16 + h];
      sp[4096 + ((g * 16 + h) * 64 + (gp & 63)) * 2 + 0] = fr * bre - fi * bim;
      sp[4096 + ((g * 16 + h) * 64 + (gp & 63)) * 2 + 1] = fr * bim + fi * bre;
    }
  }
}

__device__ __forceinline__ void conv_phase(const int wave_s, const Params& p, int l, const bf16* proj, bf16* y, LAS float* smem) {
  const int tid_ = opaque_tid(wave_s);
  const int lane = tid_ & 63;
  const int gw = blockIdx.x * NWAVES + (tid_ >> 6);
  const int nw = gridDim.x * NWAVES;
  const float* cw = karg_in(4) + (size_t)l * 31 * 256;
  const float4 cb = ((const float4*)(karg_in(5) + l * 256))[lane];
  const float4 lg = ((const float4*)(karg_in(6) + l * 256))[lane];
  const float4 lb = ((const float4*)(karg_in(7) + l * 256))[lane];
  const float4 gg = ((const float4*)(karg_in(18) + l * 1024))[lane];
  LAS float* cwl = smem + 1024;
  for (int i = tid_; i < 31 * 256 / 4; i += NWAVES * 64) *(LAS pg8::f32x4*)(cwl + 4 * i) = *(const pg8::f32x4*)(cw + 4 * i);
  __syncthreads();
  for (int it = gw; it < NT / 8; it += nw) {
    const int tok0 = it * 8;
    const int t0 = tok0 & (SEQ - 1);
    float4 acc[8];
#pragma unroll
    for (int o = 0; o < 8; o++) acc[o] = cb;
#pragma unroll
    for (int i = 0; i < 38; i++) {
      if (t0 - 30 + i >= 0) {
        const bf16* row = proj + (size_t)(tok0 - 30 + i) * DIN;
        const uint2 vp = ((const uint2*)row)[lane];
        const uint2 gp = ((const uint2*)(row + 256))[lane];
        float4 g4;
        g4.x = bf_lo(vp.x) * sigmoidf_(bf_lo(gp.x)); g4.y = bf_hi(vp.x) * sigmoidf_(bf_hi(gp.x));
        g4.z = bf_lo(vp.y) * sigmoidf_(bf_lo(gp.y)); g4.w = bf_hi(vp.y) * sigmoidf_(bf_hi(gp.y));
#pragma unroll
        for (int o = 0; o < 8; o++) {
          const int j = i - o;
          if (j >= 0 && j <= 30) {
            const pg8::f32x4 w4 = *(const LAS pg8::f32x4*)(cwl + j * 256 + lane * 4);
            acc[o].x += g4.x * w4[0]; acc[o].y += g4.y * w4[1];
            acc[o].z += g4.z * w4[2]; acc[o].w += g4.w * w4[3];
          }
        }
      }
    }
#pragma unroll
    for (int o = 0; o < 8; o++) {
      const float4 a = acc[o];
      const float mean = wsum(a.x + a.y + a.z + a.w) * (1.0f / 256.f);
      const float dx = a.x - mean, dy = a.y - mean, dz = a.z - mean, dw = a.w - mean;
      const float var = wsum(dx * dx + dy * dy + dz * dz + dw * dw) * (1.0f / 256.f);
      const float rs = rsqrtf(var + EPSF);
      float4 s;
      s.x = dx * rs * lg.x + lb.x; s.y = dy * rs * lg.y + lb.y;
      s.z = dz * rs * lg.z + lb.z; s.w = dw * rs * lg.w + lb.w;
      s.x = s.x * sigmoidf_(s.x); s.y = s.y * sigmoidf_(s.y);
      s.z = s.z * sigmoidf_(s.z); s.w = s.w * sigmoidf_(s.w);
      const float ss = wsum(s.x * s.x + s.y * s.y + s.z * s.z + s.w * s.w) * (1.0f / 256.f);
      const float r2 = rsqrtf(ss + EPSF);
      uint2 pk; pk.x = pk2(s.x * r2 * gg.x, s.y * r2 * gg.y); pk.y = pk2(s.z * r2 * gg.z, s.w * r2 * gg.w);
      ((uint2*)(y + (size_t)(tok0 + o) * DM))[lane] = pk;
    }
  }
}

typedef short bf16x8_t __attribute__((ext_vector_type(8)));
typedef float f32x16_t __attribute__((ext_vector_type(16)));
#define MFMA_PAD() do { __builtin_amdgcn_sched_barrier(0); asm volatile("s_nop 15\n\ts_nop 15" ::: "memory"); __builtin_amdgcn_sched_barrier(0); } while (0)

__device__ __forceinline__ void attn_phase(const int wave_s, const Params& p, int l, const bf16* proj, bf16* y, LAS float* smem) {
  const int tid = opaque_tid(wave_s), lane = tid & 63, wave = tid >> 6;
  const int n = lane & 31, hh = lane >> 5;
  const float* gg = karg_in(18) + l * 1024 + 256 + wave * 64;
  const float g0 = gg[n], g1 = gg[32 + n];
  LAS float* ssq = smem;
  LAS float* rstd = smem + 256;
  for (int item = blockIdx.x; item < 4 * 128; item += gridDim.x) {
    const int b = item >> 7, q0 = (item & 127) * 32;
    const size_t tokb = (size_t)b * SEQ;
    bf16x8_t qf[4];
    {
      const bf16* qrow = proj + (tokb + q0 + n) * DIN + 512 + wave * 64 + 8 * hh;
#pragma unroll
      for (int ks = 0; ks < 4; ks++) qf[ks] = *(const bf16x8_t*)(qrow + 16 * ks);
    }
    f32x16_t o0, o1;
#pragma unroll
    for (int r = 0; r < 16; r++) { o0[r] = 0.f; o1[r] = 0.f; }
    float R = 0.f;
    for (int kt = q0; kt >= 0; kt -= 32) {
      bf16x8_t kf[4];
      {
        const bf16* krow = proj + (tokb + kt + n) * DIN + 1024 + wave * 64 + 8 * hh;
#pragma unroll
        for (int ks = 0; ks < 4; ks++) kf[ks] = *(const bf16x8_t*)(krow + 16 * ks);
      }
      bf16x8_t vf0[2], vf1[2];
      {
        const bf16* vb = proj + (tokb + kt + 4 * hh) * DIN + 1536 + wave * 64 + n;
#pragma unroll
        for (int s = 0; s < 2; s++)
#pragma unroll
          for (int j = 0; j < 8; j++) {
            const int key = 16 * s + 8 * (j >> 2) + (j & 3);
            vf0[s][j] = (short)vb[(size_t)key * DIN];
            vf1[s][j] = (short)vb[(size_t)key * DIN + 32];
          }
      }
      f32x16_t sacc;
#pragma unroll
      for (int r = 0; r < 16; r++) sacc[r] = 0.f;
      __builtin_amdgcn_sched_barrier(0); asm volatile("s_nop 15\n\ts_nop 15" ::: "memory"); __builtin_amdgcn_sched_barrier(0);
#pragma unroll
      for (int ks = 0; ks < 4; ks++) sacc = __builtin_amdgcn_mfma_f32_32x32x16_bf16(kf[ks], qf[ks], sacc, 0, 0, 0);
      __builtin_amdgcn_sched_barrier(0); asm volatile("s_nop 15\n\ts_nop 15" ::: "memory"); __builtin_amdgcn_sched_barrier(0);
      float lst[16], lsz[16];
      const bool diag = (kt == q0);
#pragma unroll
      for (int r = 0; r < 16; r++) {
        const float z = sacc[r] * 0.125f;
        const float sp = __logf(1.0f + __expf(-fabsf(z)));
        float a = fminf(z, 0.f) - sp;
        float c = -(fmaxf(z, 0.f) + sp);
        if (diag) {
          const int key = (r & 3) + 8 * (r >> 2) + 4 * hh;
          if (key >= n) { a = -1.0e30f; c = 0.f; }
        }
        lsz[r] = a; lst[r] = c;
      }
      float Gs[4], Gp[4];
#pragma unroll
      for (int g = 0; g < 4; g++) {
        Gs[g] = (lst[4 * g] + lst[4 * g + 1]) + (lst[4 * g + 2] + lst[4 * g + 3]);
        Gp[g] = __shfl_xor(Gs[g], 32, 64);
      }
      float carry[4];
      {
        float after = R;
#pragma unroll
        for (int g = 3; g >= 0; g--) {
          carry[g] = after + (hh ? 0.f : Gp[g]);
          after += Gs[g] + Gp[g];
        }
        R = after;
      }
      bf16x8_t pf[2];
#pragma unroll
      for (int g = 0; g < 4; g++) {
        float run = carry[g];
        float a3 = __expf(lsz[4 * g + 3] + run); run += lst[4 * g + 3];
        float a2 = __expf(lsz[4 * g + 2] + run); run += lst[4 * g + 2];
        float a1 = __expf(lsz[4 * g + 1] + run); run += lst[4 * g + 1];
        float a0 = __expf(lsz[4 * g + 0] + run);
        const int s = g >> 1, jb = (g & 1) * 4;
        pf[s][jb + 0] = (short)f2bf(a0); pf[s][jb + 1] = (short)f2bf(a1);
        pf[s][jb + 2] = (short)f2bf(a2); pf[s][jb + 3] = (short)f2bf(a3);
      }
      __builtin_amdgcn_sched_barrier(0); asm volatile("s_nop 15\n\ts_nop 15" ::: "memory"); __builtin_amdgcn_sched_barrier(0);
#pragma unroll
      for (int s = 0; s < 2; s++) {
        o0 = __builtin_amdgcn_mfma_f32_32x32x16_bf16(pf[s], vf0[s], o0, 0, 0, 0);
        o1 = __builtin_amdgcn_mfma_f32_32x32x16_bf16(pf[s], vf1[s], o1, 0, 0, 0);
      }
      __builtin_amdgcn_sched_barrier(0); asm volatile("s_nop 15\n\ts_nop 15" ::: "memory"); __builtin_amdgcn_sched_barrier(0);
      if (__all(R < -110.f)) break;
    }
    float sq[16];
#pragma unroll
    for (int r = 0; r < 16; r++) {
      float v = o0[r] * o0[r] + o1[r] * o1[r];
#pragma unroll
      for (int o = 16; o > 0; o >>= 1) v += __shfl_xor(v, o, 64);
      sq[r] = v;
    }
    __syncthreads();
    if (n == 0) {
#pragma unroll
      for (int r = 0; r < 16; r++) ssq[wave * 32 + (r & 3) + 8 * (r >> 2) + 4 * hh] = sq[r];
    }
    __syncthreads();
    if (tid < 32) {
      float t = 0.f;
#pragma unroll
      for (int w = 0; w < 8; w++) t += ssq[w * 32 + tid];
      rstd[tid] = rsqrtf(t * (1.0f / 512.f) + EPSF);
    }
    __syncthreads();
#pragma unroll
    for (int r = 0; r < 16; r++) {
      const int qi = (r & 3) + 8 * (r >> 2) + 4 * hh;
      const float rs = rstd[qi];
      bf16* yr = y + (tokb + q0 + qi) * DM + 256 + wave * 64 + n;
      yr[0] = (bf16)f2bf(o0[r] * rs * g0);
      yr[32] = (bf16)f2bf(o1[r] * rs * g1);
    }
  }
}

#define SSM_BCAST_U(u, ua, ub, tt) do { \
    const unsigned w0 = (unsigned)__builtin_amdgcn_readlane((int)(ua).x, (tt)), w1 = (unsigned)__builtin_amdgcn_readlane((int)(ua).y, (tt)); \
    const unsigned w2 = (unsigned)__builtin_amdgcn_readlane((int)(ua).z, (tt)), w3 = (unsigned)__builtin_amdgcn_readlane((int)(ua).w, (tt)); \
    const unsigned w4 = (unsigned)__builtin_amdgcn_readlane((int)(ub).x, (tt)), w5 = (unsigned)__builtin_amdgcn_readlane((int)(ub).y, (tt)); \
    const unsigned w6 = (unsigned)__builtin_amdgcn_readlane((int)(ub).z, (tt)), w7 = (unsigned)__builtin_amdgcn_readlane((int)(ub).w, (tt)); \
    (u)[0] = bf_lo(w0); (u)[1] = bf_hi(w0); (u)[2] = bf_lo(w1); (u)[3] = bf_hi(w1); (u)[4] = bf_lo(w2); (u)[5] = bf_hi(w2); (u)[6] = bf_lo(w3); (u)[7] = bf_hi(w3); \
    (u)[8] = bf_lo(w4); (u)[9] = bf_hi(w4); (u)[10] = bf_lo(w5); (u)[11] = bf_hi(w5); (u)[12] = bf_lo(w6); (u)[13] = bf_hi(w6); (u)[14] = bf_lo(w7); (u)[15] = bf_hi(w7); } while (0)
#define SSM_RS 592
#define SSM_TILE_BASE 36864
#define SSM_TILE_BYTES (16 * SSM_RS)
typedef float f32x2_t __attribute__((ext_vector_type(2)));
__device__ __forceinline__ void ssm_load_bop(const float* ssmp, int g, int lane, bf16x8_t (&bop)[8]) {
  const int q = lane >> 4, n = lane & 15;
  float v[8][8];
#pragma unroll
  for (int j = 0; j < 8; j++) {
    const float4* rp = (const float4*)(ssmp + 4096 + (size_t)(g * 16 + ((8 * q + j) & 15)) * 128 + 8 * n);
    const float4 a = rp[0], b = rp[1];
    v[j][0] = a.x; v[j][1] = a.y; v[j][2] = a.z; v[j][3] = a.w; v[j][4] = b.x; v[j][5] = b.y; v[j][6] = b.z; v[j][7] = b.w;
  }
#pragma unroll
  for (int nt = 0; nt < 8; nt++) {
    pg8::u32x4 w;
    w.x = pk2(v[0][nt], v[1][nt]); w.y = pk2(v[2][nt], v[3][nt]); w.z = pk2(v[4][nt], v[5][nt]); w.w = pk2(v[6][nt], v[7][nt]);
    if (q >= 2) { w.x = 0u; w.y = 0u; w.z = 0u; w.w = 0u; }
    bop[nt] = __builtin_bit_cast(bf16x8_t, w);
  }
}
__device__ __forceinline__ void ssm_bu_block(LAS unsigned char* xt, int lane, int blk, const uint4& ua, const uint4& ub, const bf16x8_t (&bop)[8]) {
  const int q = lane >> 4, n = lane & 15;
  if (q == blk) {
    pg8::u32x4 w0, w1;
    w0.x = ua.x; w0.y = ua.y; w0.z = ua.z; w0.w = ua.w; w1.x = ub.x; w1.y = ub.y; w1.z = ub.z; w1.w = ub.w;
    LAS pg8::u32x4* ur = (LAS pg8::u32x4*)(xt + n * SSM_RS + 512);
    ur[0] = w0; ur[1] = w1;
  }
  __builtin_amdgcn_wave_barrier();
  const bf16x8_t uop = *(const LAS bf16x8_t*)(xt + n * SSM_RS + 512 + q * 16);
  pg8::f32x4 bacc[8];
#pragma unroll
  for (int nt = 0; nt < 8; nt++) {
    pg8::f32x4 z4; z4[0] = 0.f; z4[1] = 0.f; z4[2] = 0.f; z4[3] = 0.f;
    bacc[nt] = __builtin_amdgcn_mfma_f32_16x16x32_bf16(uop, bop[nt], z4, 0, 0, 0);
  }
#pragma unroll
  for (int j = 0; j < 4; j++) {
    pg8::f32x4 w0, w1;
    w0[0] = bacc[0][j]; w0[1] = bacc[1][j]; w0[2] = bacc[2][j]; w0[3] = bacc[3][j];
    w1[0] = bacc[4][j]; w1[1] = bacc[5][j]; w1[2] = bacc[6][j]; w1[3] = bacc[7][j];
    LAS pg8::f32x4* dr = (LAS pg8::f32x4*)(xt + (4 * q + j) * SSM_RS + 32 * n);
    dr[0] = w0; dr[1] = w1;
  }
  __builtin_amdgcn_wave_barrier();
}
__device__ __forceinline__ void ssm_zero_pad(LAS unsigned char* xt, int lane) {
  if (lane < 16) {
    pg8::u32x4 z4; z4.x = 0u; z4.y = 0u; z4.z = 0u; z4.w = 0u;
    LAS pg8::u32x4* zr = (LAS pg8::u32x4*)(xt + lane * SSM_RS + 544);
    zr[0] = z4; zr[1] = z4;
  }
}
__device__ __forceinline__ void ssm_chunk_end(const int wave_s, const float* ssmp, const bf16* proj, float* ssmE, LAS float* smem) {
  const int tid_ = opaque_tid(wave_s);
  const int lane = tid_ & 63;
  const int gw = blockIdx.x * NWAVES + (tid_ >> 6);
  const int nw = gridDim.x * NWAVES;
  for (int it = gw; it < 4 * 64 * 16; it += nw) {
    const int g = it & 15, c = (it >> 4) & 63, b = it >> 10;
    const int gp = g * 64 + lane;
    const uint4* up = (const uint4*)(proj + (size_t)(b * SEQ + c * 64 + lane) * DIN + 2048 + g * 16);
    const uint4 ua = up[0], ub = up[1];
    const float lbr = ssmp[gp * 2], lbi = ssmp[gp * 2 + 1];
    bf16x8_t bop[8];
    ssm_load_bop(ssmp, g, lane, bop);
    LAS unsigned char* xt = (LAS unsigned char*)smem + SSM_TILE_BASE + (tid_ >> 6) * SSM_TILE_BYTES;
    ssm_zero_pad(xt, lane);
    float xr = 0.f, xi = 0.f;
#pragma unroll 1
    for (int blk = 0; blk < 4; blk++) {
      ssm_bu_block(xt, lane, blk, ua, ub, bop);
#pragma unroll 4
      for (int tt = 0; tt < 16; tt++) {
        const f32x2_t bu = *(const LAS f32x2_t*)(xt + tt * SSM_RS + lane * 8);
        const float nr = lbr * xr - lbi * xi + bu[0];
        const float ni = lbr * xi + lbi * xr + bu[1];
        xr = nr; xi = ni;
      }
      __builtin_amdgcn_wave_barrier();
    }
    float* e = ssmE + ((size_t)((b * 64 + c) * 16 + g) * 64 + lane) * 2;
    e[0] = xr; e[1] = xi;
  }
}

__device__ __forceinline__ void ssm_finish(const int wave_s, const Params& p, int l, const float* ssmp, const bf16* proj,
                           const float* ssmE, bf16* y, LAS float* smem) {
  LAS bf16* Ytb = (LAS bf16*)smem;
  LAS float* ssq2 = smem + (64 * 264 * 2) / 4;
  LAS float* rstd2 = ssq2 + 512;
  const bf16* glT = (const bf16*)(p.ws + WS_WT + (size_t)l * WT_LAYER + WT_GLU);
  const int tid = opaque_tid(wave_s), lane = tid & 63, wave = tid >> 6;
  const float* cre = karg_in(13) + (size_t)l * 16 * 16 * 64;
  const float* cim = karg_in(14) + (size_t)l * 16 * 16 * 64;
  const float* dsk = karg_in(15) + l * 256;
  const float* glw = karg_in(16) + (size_t)l * 256 * 256;
  const float* glb = karg_in(17) + l * 256;
  const float* gg = karg_in(18) + l * 1024 + 768;
  for (int it = blockIdx.x; it < 256; it += gridDim.x) {
    const int b = it >> 6, c = it & 63;
    __syncthreads();
    for (int gi = 0; gi < 2; gi++) {
      const int g = wave + gi * 8;
      const int gp = g * 64 + lane;
      const float lbr = ssmp[gp * 2], lbi = ssmp[gp * 2 + 1];
      const float lcr = ssmp[2048 + gp * 2], lci = ssmp[2048 + gp * 2 + 1];
      bf16x8_t bop[8];
      ssm_load_bop(ssmp, g, lane, bop);
      bf16x8_t cop[5];
      {
        const int nn = lane & 15, q = lane >> 4;
#pragma unroll
        for (int ks = 0; ks < 4; ks++) {
          const float4 cr4 = *(const float4*)(cre + (g * 16 + nn) * 64 + 16 * ks + 4 * q);
          const float4 ci4 = *(const float4*)(cim + (g * 16 + nn) * 64 + 16 * ks + 4 * q);
          pg8::u32x4 w;
          w.x = pk2(cr4.x, -ci4.x); w.y = pk2(cr4.y, -ci4.y); w.z = pk2(cr4.z, -ci4.z); w.w = pk2(cr4.w, -ci4.w);
          cop[ks] = __builtin_bit_cast(bf16x8_t, w);
        }
        const float dn = dsk[g * 16 + nn];
        float dv[8];
#pragma unroll
        for (int j = 0; j < 8; j++) dv[j] = (8 * q + j == nn) ? dn : 0.f;
        pg8::u32x4 w;
        w.x = pk2(dv[0], dv[1]); w.y = pk2(dv[2], dv[3]); w.z = pk2(dv[4], dv[5]); w.w = pk2(dv[6], dv[7]);
        cop[4] = __builtin_bit_cast(bf16x8_t, w);
      }
      const uint4* up = (const uint4*)(proj + (size_t)(b * SEQ + c * 64 + lane) * DIN + 2048 + g * 16);
      const uint4 ua = up[0], ub = up[1];
      float xr = 0.f, xi = 0.f;
      {
        const float2* eb = (const float2*)ssmE + ((size_t)(b * 64) * 16 + g) * 64 + lane;
        for (int cc = 0; cc < c; cc += 16) {
          float2 ev[16];
#pragma unroll
          for (int k = 0; k < 16; k++) ev[k] = eb[(size_t)(cc + k < c ? cc + k : c - 1) * 16 * 64];
#pragma unroll
          for (int k = 0; k < 16; k++) {
            if (cc + k < c) {
              const float nr = lcr * xr - lci * xi + ev[k].x;
              const float ni = lcr * xi + lci * xr + ev[k].y;
              xr = nr; xi = ni;
            }
          }
        }
      }
      LAS unsigned char* xt = (LAS unsigned char*)smem + SSM_TILE_BASE + wave * SSM_TILE_BYTES;
      ssm_zero_pad(xt, lane);
#pragma unroll 1
      for (int blk = 0; blk < 4; blk++) {
        ssm_bu_block(xt, lane, blk, ua, ub, bop);
#pragma unroll 4
        for (int tt = 0; tt < 16; tt++) {
          const f32x2_t bu = *(const LAS f32x2_t*)(xt + tt * SSM_RS + lane * 8);
          const float nr = lbr * xr - lbi * xi + bu[0];
          const float ni = lbr * xi + lbi * xr + bu[1];
          xr = nr; xi = ni;
          *(LAS unsigned*)(xt + tt * SSM_RS + lane * 4) = pk2(xr, xi);
        }
        __builtin_amdgcn_wave_barrier();
        {
          pg8::f32x4 acc4;
          acc4[0] = 0.f; acc4[1] = 0.f; acc4[2] = 0.f; acc4[3] = 0.f;
          const LAS unsigned char* ar = xt + (lane & 15) * SSM_RS + (lane >> 4) * 16;
#pragma unroll
          for (int ks = 0; ks < 4; ks++)
            acc4 = __builtin_amdgcn_mfma_f32_16x16x32_bf16(*(const LAS bf16x8_t*)(ar + ks * 64), cop[ks], acc4, 0, 0, 0);
          acc4 = __builtin_amdgcn_mfma_f32_16x16x32_bf16(*(const LAS bf16x8_t*)(ar + 512), cop[4], acc4, 0, 0, 0);
#pragma unroll
          for (int j = 0; j < 4; j++)
            Ytb[(blk * 16 + 4 * (lane >> 4) + j) * 264 + g * 16 + (lane & 15)] = (bf16)f2bf(gelu_tanh(acc4[j]));
        }
        __builtin_amdgcn_wave_barrier();
      }
    }
    __syncthreads();
    {
      const int n = lane & 31, hh = lane >> 5;
      const int ch = wave * 32 + n;
      const float bj = glb[ch];
      const float gj = gg[ch];
      bf16x8_t gf[16];
      {
        const bf16* grow = glT + (size_t)ch * 256 + 8 * hh;
#pragma unroll
        for (int ks = 0; ks < 16; ks++) gf[ks] = *(const bf16x8_t*)(grow + 16 * ks);
      }
      float oo[2][16];
#pragma unroll
      for (int mt = 0; mt < 2; mt++) {
        f32x16_t z;
#pragma unroll
        for (int r = 0; r < 16; r++) z[r] = 0.f;
        const LAS bf16* yrow = Ytb + (mt * 32 + n) * 264 + 8 * hh;
#pragma unroll
        for (int kq = 0; kq < 4; kq++) {
          bf16x8_t yf[4];
#pragma unroll
          for (int i = 0; i < 4; i++) yf[i] = *(const LAS bf16x8_t*)(yrow + 16 * (kq * 4 + i));
          MFMA_PAD();
#pragma unroll
          for (int i = 0; i < 4; i++) z = __builtin_amdgcn_mfma_f32_32x32x16_bf16(yf[i], gf[kq * 4 + i], z, 0, 0, 0);
          MFMA_PAD();
        }
        float sq[16];
#pragma unroll
        for (int r = 0; r < 16; r++) {
          const int t = mt * 32 + (r & 3) + 8 * (r >> 2) + 4 * hh;
          const float yv = bf2f(Ytb[t * 264 + ch]);
          const float o = yv * sigmoidf_(z[r] + bj);
          oo[mt][r] = o;
          float v = o * o;
#pragma unroll
          for (int s = 16; s > 0; s >>= 1) v += __shfl_xor(v, s, 64);
          sq[r] = v;
        }
        if (n == 0) {
#pragma unroll
          for (int r = 0; r < 16; r++) ssq2[wave * 64 + mt * 32 + (r & 3) + 8 * (r >> 2) + 4 * hh] = sq[r];
        }
      }
      __syncthreads();
      if (tid < 64) {
        float t = 0.f;
#pragma unroll
        for (int w = 0; w < 8; w++) t += ssq2[w * 64 + tid];
        rstd2[tid] = rsqrtf(t * (1.0f / 256.f) + EPSF);
      }
      __syncthreads();
#pragma unroll
      for (int mt = 0; mt < 2; mt++)
#pragma unroll
        for (int r = 0; r < 16; r++) {
          const int t = mt * 32 + (r & 3) + 8 * (r >> 2) + 4 * hh;
          y[(size_t)(b * SEQ + c * 64 + t) * DM + 768 + ch] = (bf16)f2bf(oo[mt][r] * rstd2[t] * gj);
        }
    }
  }
}

__device__ __forceinline__ void memattn_phase(const int wave_s, const bf16* q, const bf16* kvb, const bf16* vT, bf16* o, LAS float* smem) {
  const int tid_ = opaque_tid(wave_s);
  const int lane = tid_ & 63, n = lane & 31, hh = lane >> 5, wave = tid_ >> 6;
  const int sig = (n & 0x13) | ((n & 4) << 1) | ((n & 8) >> 1);
  LAS bf16* Ls = (LAS bf16*)smem;
  for (int it = blockIdx.x; it < 64 * 4; it += gridDim.x) {
    const int h = it & 3, tg = it >> 2, b = tg >> 4;
    const int tok0 = (tg * 8 + wave) * 32;
    __syncthreads();
    {
      const int r = tid_ >> 1, hf = tid_ & 1;
      const pg8::u32x4* src4 = (const pg8::u32x4*)(kvb + (size_t)(b * NMEM + r) * 2048 + h * 256 + hf * 128);
      LAS pg8::u32x4* dst4 = (LAS pg8::u32x4*)(Ls + r * 264 + hf * 128);
#pragma unroll
      for (int k = 0; k < 16; k++) dst4[k] = src4[k];
    }
    f32x16_t st[8];
#pragma unroll
    for (int kt = 0; kt < 8; kt++)
#pragma unroll
      for (int r = 0; r < 16; r++) st[kt][r] = 0.f;
    const bf16* qrow = q + (size_t)(tok0 + n) * DM + h * 256 + 8 * hh;
    __syncthreads();
#pragma unroll
    for (int kq = 0; kq < 4; kq++) {
      bf16x8_t qf[4];
#pragma unroll
      for (int i = 0; i < 4; i++) qf[i] = *(const bf16x8_t*)(qrow + 16 * (kq * 4 + i));
#pragma unroll
      for (int kt = 0; kt < 8; kt++) {
        const LAS bf16* krow = Ls + (kt * 32 + sig) * 264 + 8 * hh;
        bf16x8_t kf[4];
#pragma unroll
        for (int i = 0; i < 4; i++) kf[i] = *(const LAS bf16x8_t*)(krow + 16 * (kq * 4 + i));
        MFMA_PAD();
#pragma unroll
        for (int i = 0; i < 4; i++) st[kt] = __builtin_amdgcn_mfma_f32_32x32x16_bf16(kf[i], qf[i], st[kt], 0, 0, 0);
        MFMA_PAD();
      }
    }
    float mx = st[0][0];
#pragma unroll
    for (int kt = 0; kt < 8; kt++)
#pragma unroll
      for (int r = 0; r < 16; r++) mx = fmaxf(mx, st[kt][r]);
    mx = fmaxf(mx, __shfl_xor(mx, 32, 64));
    float sum = 0.f;
#pragma unroll
    for (int kt = 0; kt < 8; kt++)
#pragma unroll
      for (int r = 0; r < 16; r++) { const float e = __expf((st[kt][r] - mx) * 0.0625f); st[kt][r] = e; sum += e; }
    sum += __shfl_xor(sum, 32, 64);
    const float inv = 1.0f / sum;
    bf16x8_t pf[8][2];
#pragma unroll
    for (int kt = 0; kt < 8; kt++)
#pragma unroll
      for (int s = 0; s < 2; s++)
#pragma unroll
        for (int j = 0; j < 8; j++) pf[kt][s][j] = (short)f2bf(st[kt][8 * s + j] * inv);
    __syncthreads();
    {
      const int r = tid_ >> 1, hf = tid_ & 1;
      const pg8::u32x4* src4 = (const pg8::u32x4*)(vT + ((size_t)(b * 4 + h) * 256 + r) * 256 + hf * 128);
      LAS pg8::u32x4* dst4 = (LAS pg8::u32x4*)(Ls + r * 264 + hf * 128);
#pragma unroll
      for (int k = 0; k < 16; k++) dst4[k] = src4[k];
    }
    __syncthreads();
#pragma unroll 1
    for (int dt = 0; dt < 8; dt++) {
      f32x16_t oacc;
#pragma unroll
      for (int r = 0; r < 16; r++) oacc[r] = 0.f;
      const LAS bf16* vrow = Ls + (dt * 32 + n) * 264 + 8 * hh;
#pragma unroll
      for (int kq = 0; kq < 4; kq++) {
        bf16x8_t vf[4];
#pragma unroll
        for (int i = 0; i < 4; i++) vf[i] = *(const LAS bf16x8_t*)(vrow + (kq * 2 + (i >> 1)) * 32 + 16 * (i & 1));
        MFMA_PAD();
#pragma unroll
        for (int i = 0; i < 4; i++) oacc = __builtin_amdgcn_mfma_f32_32x32x16_bf16(pf[kq * 2 + (i >> 1)][i & 1], vf[i], oacc, 0, 0, 0);
        MFMA_PAD();
      }
#pragma unroll
      for (int r = 0; r < 16; r++) {
        const int qi = (r & 3) + 8 * (r >> 2) + 4 * hh;
        o[(size_t)(tok0 + qi) * DM + h * 256 + dt * 32 + n] = (bf16)f2bf(oacc[r]);
      }
    }
  }
}

__device__ __forceinline__ void vt_phase(const int wave_s, const bf16* kvb, bf16* vT) {
  const int tid_ = opaque_tid(wave_s);
  const int gt = blockIdx.x * (NWAVES * 64) + tid_;
  const int nth = gridDim.x * NWAVES * 64;
  for (int i = gt; i < 2 * 4 * 4 * 256 * 256; i += nth) {
    const int m = i & 255, d = (i >> 8) & 255, h = (i >> 16) & 3, b = (i >> 18) & 3, l = i >> 20;
    vT[i] = kvb[((size_t)l * 1024 + b * 256 + m) * 2048 + 1024 + h * 256 + d];
  }
}

template <unsigned MASK>
__device__ __forceinline__ float pack_key(float s, unsigned idx) {
  const unsigned u = __builtin_bit_cast(unsigned, s);
  const unsigned tag = ((int)u < 0) ? idx : (MASK - idx);
  return __builtin_bit_cast(float, (u & ~MASK) + tag);
}
template <unsigned MASK>
__device__ __forceinline__ unsigned key_idx(float k) {
  const unsigned u = __builtin_bit_cast(unsigned, k);
  const unsigned tag = u & MASK;
  return ((int)u < 0) ? tag : (MASK - tag);
}
template <unsigned MASK>
__device__ __forceinline__ float key_val(float k) { return __builtin_bit_cast(float, __builtin_bit_cast(unsigned, k) & ~MASK); }
__device__ __forceinline__ void top16_of_64(float (&K)[64]) {
  { const float a_ = K[0], b_ = K[1]; const bool g_ = a_ > b_; K[0] = g_ ? a_ : b_; K[1] = g_ ? b_ : a_; }
  { const float a_ = K[2], b_ = K[3]; const bool g_ = a_ > b_; K[2] = g_ ? b_ : a_; K[3] = g_ ? a_ : b_; }
  { const float a_ = K[4], b_ = K[5]; const bool g_ = a_ > b_; K[4] = g_ ? a_ : b_; K[5] = g_ ? b_ : a_; }
  { const float a_ = K[6], b_ = K[7]; const bool g_ = a_ > b_; K[6] = g_ ? b_ : a_; K[7] = g_ ? a_ : b_; }
  { const float a_ = K[8], b_ = K[9]; const bool g_ = a_ > b_; K[8] = g_ ? a_ : b_; K[9] = g_ ? b_ : a_; }
  { const float a_ = K[10], b_ = K[11]; const bool g_ = a_ > b_; K[10] = g_ ? b_ : a_; K[11] = g_ ? a_ : b_; }
  { const float a_ = K[12], b_ = K[13]; const bool g_ = a_ > b_; K[12] = g_ ? a_ : b_; K[13] = g_ ? b_ : a_; }
  { const float a_ = K[14], b_ = K[15]; const bool g_ = a_ > b_; K[14] = g_ ? b_ : a_; K[15] = g_ ? a_ : b_; }
  { const float a_ = K[0], b_ = K[2]; const bool g_ = a_ > b_; K[0] = g_ ? a_ : b_; K[2] = g_ ? b_ : a_; }
  { const float a_ = K[1], b_ = K[3]; const bool g_ = a_ > b_; K[1] = g_ ? a_ : b_; K[3] = g_ ? b_ : a_; }
  { const float a_ = K[4], b_ = K[6]; const bool g_ = a_ > b_; K[4] = g_ ? b_ : a_; K[6] = g_ ? a_ : b_; }
  { const float a_ = K[5], b_ = K[7]; const bool g_ = a_ > b_; K[5] = g_ ? b_ : a_; K[7] = g_ ? a_ : b_; }
  { const float a_ = K[8], b_ = K[10]; const bool g_ = a_ > b_; K[8] = g_ ? a_ : b_; K[10] = g_ ? b_ : a_; }
  { const float a_ = K[9], b_ = K[11]; const bool g_ = a_ > b_; K[9] = g_ ? a_ : b_; K[11] = g_ ? b_ : a_; }
  { const float a_ = K[12], b_ = K[14]; const bool g_ = a_ > b_; K[12] = g_ ? b_ : a_; K[14] = g_ ? a_ : b_; }
  { const float a_ = K[13], b_ = K[15]; const bool g_ = a_ > b_; K[13] = g_ ? b_ : a_; K[15] = g_ ? a_ : b_; }
  { const float a_ = K[0], b_ = K[1]; const bool g_ = a_ > b_; K[0] = g_ ? a_ : b_; K[1] = g_ ? b_ : a_; }
  { const float a_ = K[2], b_ = K[3]; const bool g_ = a_ > b_; K[2] = g_ ? a_ : b_; K[3] = g_ ? b_ : a_; }
  { const float a_ = K[4], b_ = K[5]; const bool g_ = a_ > b_; K[4] = g_ ? b_ : a_; K[5] = g_ ? a_ : b_; }
  { const float a_ = K[6], b_ = K[7]; const bool g_ = a_ > b_; K[6] = g_ ? b_ : a_; K[7] = g_ ? a_ : b_; }
  { const float a_ = K[8], b_ = K[9]; const bool g_ = a_ > b_; K[8] = g_ ? a_ : b_; K[9] = g_ ? b_ : a_; }
  { const float a_ = K[10], b_ = K[11]; const bool g_ = a_ > b_; K[10] = g_ ? a_ : b_; K[11] = g_ ? b_ : a_; }
  { const float a_ = K[12], b_ = K[13]; const bool g_ = a_ > b_; K[12] = g_ ? b_ : a_; K[13] = g_ ? a_ : b_; }
  { const float a_ = K[14], b_ = K[15]; const bool g_ = a_ > b_; K[14] = g_ ? b_ : a_; K[15] = g_ ? a_ : b_; }
  { const float a_ = K[0], b_ = K[4]; const bool g_ = a_ > b_; K[0] = g_ ? a_ : b_; K[4] = g_ ? b_ : a_; }
  { const float a_ = K[1], b_ = K[5]; const bool g_ = a_ > b_; K[1] = g_ ? a_ : b_; K[5] = g_ ? b_ : a_; }
  { const float a_ = K[2], b_ = K[6]; const bool g_ = a_ > b_; K[2] = g_ ? a_ : b_; K[6] = g_ ? b_ : a_; }
  { const float a_ = K[3], b_ = K[7]; const bool g_ = a_ > b_; K[3] = g_ ? a_ : b_; K[7] = g_ ? b_ : a_; }
  { const float a_ = K[8], b_ = K[12]; const bool g_ = a_ > b_; K[8] = g_ ? b_ : a_; K[12] = g_ ? a_ : b_; }
  { const float a_ = K[9], b_ = K[13]; const bool g_ = a_ > b_; K[9] = g_ ? b_ : a_; K[13] = g_ ? a_ : b_; }
  { const float a_ = K[10], b_ = K[14]; const bool g_ = a_ > b_; K[10] = g_ ? b_ : a_; K[14] = g_ ? a_ : b_; }
  { const float a_ = K[11], b_ = K[15]; const bool g_ = a_ > b_; K[11] = g_ ? b_ : a_; K[15] = g_ ? a_ : b_; }
  { const float a_ = K[0], b_ = K[2]; const bool g_ = a_ > b_; K[0] = g_ ? a_ : b_; K[2] = g_ ? b_ : a_; }
  { const float a_ = K[1], b_ = K[3]; const bool g_ = a_ > b_; K[1] = g_ ? a_ : b_; K[3] = g_ ? b_ : a_; }
  { const float a_ = K[4], b_ = K[6]; const bool g_ = a_ > b_; K[4] = g_ ? a_ : b_; K[6] = g_ ? b_ : a_; }
  { const float a_ = K[5], b_ = K[7]; const bool g_ = a_ > b_; K[5] = g_ ? a_ : b_; K[7] = g_ ? b_ : a_; }
  { const float a_ = K[8], b_ = K[10]; const bool g_ = a_ > b_; K[8] = g_ ? b_ : a_; K[10] = g_ ? a_ : b_; }
  { const float a_ = K[9], b_ = K[11]; const bool g_ = a_ > b_; K[9] = g_ ? b_ : a_; K[11] = g_ ? a_ : b_; }
  { const float a_ = K[12], b_ = K[14]; const bool g_ = a_ > b_; K[12] = g_ ? b_ : a_; K[14] = g_ ? a_ : b_; }
  { const float a_ = K[13], b_ = K[15]; const bool g_ = a_ > b_; K[13] = g_ ? b_ : a_; K[15] = g_ ? a_ : b_; }
  { const float a_ = K[0], b_ = K[1]; const bool g_ = a_ > b_; K[0] = g_ ? a_ : b_; K[1] = g_ ? b_ : a_; }
  { const float a_ = K[2], b_ = K[3]; const bool g_ = a_ > b_; K[2] = g_ ? a_ : b_; K[3] = g_ ? b_ : a_; }
  { const float a_ = K[4], b_ = K[5]; const bool g_ = a_ > b_; K[4] = g_ ? a_ : b_; K[5] = g_ ? b_ : a_; }
  { const float a_ = K[6], b_ = K[7]; const bool g_ = a_ > b_; K[6] = g_ ? a_ : b_; K[7] = g_ ? b_ : a_; }
  { const float a_ = K[8], b_ = K[9]; const bool g_ = a_ > b_; K[8] = g_ ? b_ : a_; K[9] = g_ ? a_ : b_; }
  { const float a_ = K[10], b_ = K[11]; const bool g_ = a_ > b_; K[10] = g_ ? b_ : a_; K[11] = g_ ? a_ : b_; }
  { const float a_ = K[12], b_ = K[13]; const bool g_ = a_ > b_; K[12] = g_ ? b_ : a_; K[13] = g_ ? a_ : b_; }
  { const float a_ = K[14], b_ = K[15]; const bool g_ = a_ > b_; K[14] = g_ ? b_ : a_; K[15] = g_ ? a_ : b_; }
  { const float a_ = K[0], b_ = K[8]; const bool g_ = a_ > b_; K[0] = g_ ? a_ : b_; K[8] = g_ ? b_ : a_; }
  { const float a_ = K[1], b_ = K[9]; const bool g_ = a_ > b_; K[1] = g_ ? a_ : b_; K[9] = g_ ? b_ : a_; }
  { const float a_ = K[2], b_ = K[10]; const bool g_ = a_ > b_; K[2] = g_ ? a_ : b_; K[10] = g_ ? b_ : a_; }
  { const float a_ = K[3], b_ = K[11]; const bool g_ = a_ > b_; K[3] = g_ ? a_ : b_; K[11] = g_ ? b_ : a_; }
  { const float a_ = K[4], b_ = K[12]; const bool g_ = a_ > b_; K[4] = g_ ? a_ : b_; K[12] = g_ ? b_ : a_; }
  { const float a_ = K[5], b_ = K[13]; const bool g_ = a_ > b_; K[5] = g_ ? a_ : b_; K[13] = g_ ? b_ : a_; }
  { const float a_ = K[6], b_ = K[14]; const bool g_ = a_ > b_; K[6] = g_ ? a_ : b_; K[14] = g_ ? b_ : a_; }
  { const float a_ = K[7], b_ = K[15]; const bool g_ = a_ > b_; K[7] = g_ ? a_ : b_; K[15] = g_ ? b_ : a_; }
  { const float a_ = K[0], b_ = K[4]; const bool g_ = a_ > b_; K[0] = g_ ? a_ : b_; K[4] = g_ ? b_ : a_; }
  { const float a_ = K[1], b_ = K[5]; const bool g_ = a_ > b_; K[1] = g_ ? a_ : b_; K[5] = g_ ? b_ : a_; }
  { const float a_ = K[2], b_ = K[6]; const bool g_ = a_ > b_; K[2] = g_ ? a_ : b_; K[6] = g_ ? b_ : a_; }
  { const float a_ = K[3], b_ = K[7]; const bool g_ = a_ > b_; K[3] = g_ ? a_ : b_; K[7] = g_ ? b_ : a_; }
  { const float a_ = K[8], b_ = K[12]; const bool g_ = a_ > b_; K[8] = g_ ? a_ : b_; K[12] = g_ ? b_ : a_; }
  { const float a_ = K[9], b_ = K[13]; const bool g_ = a_ > b_; K[9] = g_ ? a_ : b_; K[13] = g_ ? b_ : a_; }
  { const float a_ = K[10], b_ = K[14]; const bool g_ = a_ > b_; K[10] = g_ ? a_ : b_; K[14] = g_ ? b_ : a_; }
  { const float a_ = K[11], b_ = K[15]; const bool g_ = a_ > b_; K[11] = g_ ? a_ : b_; K[15] = g_ ? b_ : a_; }
  { const float a_ = K[0], b_ = K[2]; const bool g_ = a_ > b_; K[0] = g_ ? a_ : b_; K[2] = g_ ? b_ : a_; }
  { const float a_ = K[1], b_ = K[3]; const bool g_ = a_ > b_; K[1] = g_ ? a_ : b_; K[3] = g_ ? b_ : a_; }
  { const float a_ = K[4], b_ = K[6]; const bool g_ = a_ > b_; K[4] = g_ ? a_ : b_; K[6] = g_ ? b_ : a_; }
  { const float a_ = K[5], b_ = K[7]; const bool g_ = a_ > b_; K[5] = g_ ? a_ : b_; K[7] = g_ ? b_ : a_; }
  { const float a_ = K[8], b_ = K[10]; const bool g_ = a_ > b_; K[8] = g_ ? a_ : b_; K[10] = g_ ? b_ : a_; }
  { const float a_ = K[9], b_ = K[11]; const bool g_ = a_ > b_; K[9] = g_ ? a_ : b_; K[11] = g_ ? b_ : a_; }
  { const float a_ = K[12], b_ = K[14]; const bool g_ = a_ > b_; K[12] = g_ ? a_ : b_; K[14] = g_ ? b_ : a_; }
  { const float a_ = K[13], b_ = K[15]; const bool g_ = a_ > b_; K[13] = g_ ? a_ : b_; K[15] = g_ ? b_ : a_; }
  { const float a_ = K[0], b_ = K[1]; const bool g_ = a_ > b_; K[0] = g_ ? a_ : b_; K[1] = g_ ? b_ : a_; }
  { const float a_ = K[2], b_ = K[3]; const bool g_ = a_ > b_; K[2] = g_ ? a_ : b_; K[3] = g_ ? b_ : a_; }
  { const float a_ = K[4], b_ = K[5]; const bool g_ = a_ > b_; K[4] = g_ ? a_ : b_; K[5] = g_ ? b_ : a_; }
  { const float a_ = K[6], b_ = K[7]; const bool g_ = a_ > b_; K[6] = g_ ? a_ : b_; K[7] = g_ ? b_ : a_; }
  { const float a_ = K[8], b_ = K[9]; const bool g_ = a_ > b_; K[8] = g_ ? a_ : b_; K[9] = g_ ? b_ : a_; }
  { const float a_ = K[10], b_ = K[11]; const bool g_ = a_ > b_; K[10] = g_ ? a_ : b_; K[11] = g_ ? b_ : a_; }
  { const float a_ = K[12], b_ = K[13]; const bool g_ = a_ > b_; K[12] = g_ ? a_ : b_; K[13] = g_ ? b_ : a_; }
  { const float a_ = K[14], b_ = K[15]; const bool g_ = a_ > b_; K[14] = g_ ? a_ : b_; K[15] = g_ ? b_ : a_; }
  { const float a_ = K[16], b_ = K[17]; const bool g_ = a_ > b_; K[16] = g_ ? a_ : b_; K[17] = g_ ? b_ : a_; }
  { const float a_ = K[18], b_ = K[19]; const bool g_ = a_ > b_; K[18] = g_ ? b_ : a_; K[19] = g_ ? a_ : b_; }
  { const float a_ = K[20], b_ = K[21]; const bool g_ = a_ > b_; K[20] = g_ ? a_ : b_; K[21] = g_ ? b_ : a_; }
  { const float a_ = K[22], b_ = K[23]; const bool g_ = a_ > b_; K[22] = g_ ? b_ : a_; K[23] = g_ ? a_ : b_; }
  { const float a_ = K[24], b_ = K[25]; const bool g_ = a_ > b_; K[24] = g_ ? a_ : b_; K[25] = g_ ? b_ : a_; }
  { const float a_ = K[26], b_ = K[27]; const bool g_ = a_ > b_; K[26] = g_ ? b_ : a_; K[27] = g_ ? a_ : b_; }
  { const float a_ = K[28], b_ = K[29]; const bool g_ = a_ > b_; K[28] = g_ ? a_ : b_; K[29] = g_ ? b_ : a_; }
  { const float a_ = K[30], b_ = K[31]; const bool g_ = a_ > b_; K[30] = g_ ? b_ : a_; K[31] = g_ ? a_ : b_; }
  { const float a_ = K[16], b_ = K[18]; const bool g_ = a_ > b_; K[16] = g_ ? a_ : b_; K[18] = g_ ? b_ : a_; }
  { const float a_ = K[17], b_ = K[19]; const bool g_ = a_ > b_; K[17] = g_ ? a_ : b_; K[19] = g_ ? b_ : a_; }
  { const float a_ = K[20], b_ = K[22]; const bool g_ = a_ > b_; K[20] = g_ ? b_ : a_; K[22] = g_ ? a_ : b_; }
  { const float a_ = K[21], b_ = K[23]; const bool g_ = a_ > b_; K[21] = g_ ? b_ : a_; K[23] = g_ ? a_ : b_; }
  { const float a_ = K[24], b_ = K[26]; const bool g_ = a_ > b_; K[24] = g_ ? a_ : b_; K[26] = g_ ? b_ : a_; }
  { const float a_ = K[25], b_ = K[27]; const bool g_ = a_ > b_; K[25] = g_ ? a_ : b_; K[27] = g_ ? b_ : a_; }
  { const float a_ = K[28], b_ = K[30]; const bool g_ = a_ > b_; K[28] = g_ ? b_ : a_; K[30] = g_ ? a_ : b_; }
  { const float a_ = K[29], b_ = K[31]; const bool g_ = a_ > b_; K[29] = g_ ? b_ : a_; K[31] = g_ ? a_ : b_; }
  { const float a_ = K[16], b_ = K[17]; const bool g_ = a_ > b_; K[16] = g_ ? a_ : b_; K[17] = g_ ? b_ : a_; }
  { const float a_ = K[18], b_ = K[19]; const bool g_ = a_ > b_; K[18] = g_ ? a_ : b_; K[19] = g_ ? b_ : a_; }
  { const float a_ = K[20], b_ = K[21]; const bool g_ = a_ > b_; K[20] = g_ ? b_ : a_; K[21] = g_ ? a_ : b_; }
  { const float a_ = K[22], b_ = K[23]; const bool g_ = a_ > b_; K[22] = g_ ? b_ : a_; K[23] = g_ ? a_ : b_; }
  { const float a_ = K[24], b_ = K[25]; const bool g_ = a_ > b_; K[24] = g_ ? a_ : b_; K[25] = g_ ? b_ : a_; }
  { const float a_ = K[26], b_ = K[27]; const bool g_ = a_ > b_; K[26] = g_ ? a_ : b_; K[27] = g_ ? b_ : a_; }
  { const float a_ = K[28], b_ = K[29]; const bool g_ = a_ > b_; K[28] = g_ ? b_ : a_; K[29] = g_ ? a_ : b_; }
  { const float a_ = K[30], b_ = K[31]; const bool g_ = a_ > b_; K[30] = g_ ? b_ : a_; K[31] = g_ ? a_ : b_; }
  { const float a_ = K[16], b_ = K[20]; const bool g_ = a_ > b_; K[16] = g_ ? a_ : b_; K[20] = g_ ? b_ : a_; }
  { const float a_ = K[17], b_ = K[21]; const bool g_ = a_ > b_; K[17] = g_ ? a_ : b_; K[21] = g_ ? b_ : a_; }
  { const float a_ = K[18], b_ = K[22]; const bool g_ = a_ > b_; K[18] = g_ ? a_ : b_; K[22] = g_ ? b_ : a_; }
  { const float a_ = K[19], b_ = K[23]; const bool g_ = a_ > b_; K[19] = g_ ? a_ : b_; K[23] = g_ ? b_ : a_; }
  { const float a_ = K[24], b_ = K[28]; const bool g_ = a_ > b_; K[24] = g_ ? b_ : a_; K[28] = g_ ? a_ : b_; }
  { const float a_ = K[25], b_ = K[29]; const bool g_ = a_ > b_; K[25] = g_ ? b_ : a_; K[29] = g_ ? a_ : b_; }
  { const float a_ = K[26], b_ = K[30]; const bool g_ = a_ > b_; K[26] = g_ ? b_ : a_; K[30] = g_ ? a_ : b_; }
  { const float a_ = K[27], b_ = K[31]; const bool g_ = a_ > b_; K[27] = g_ ? b_ : a_; K[31] = g_ ? a_ : b_; }
  { const float a_ = K[16], b_ = K[18]; const bool g_ = a_ > b_; K[16] = g_ ? a_ : b_; K[18] = g_ ? b_ : a_; }
  { const float a_ = K[17], b_ = K[19]; const bool g_ = a_ > b_; K[17] = g_ ? a_ : b_; K[19] = g_ ? b_ : a_; }
  { const float a_ = K[20], b_ = K[22]; const bool g_ = a_ > b_; K[20] = g_ ? a_ : b_; K[22] = g_ ? b_ : a_; }
  { const float a_ = K[21], b_ = K[23]; const bool g_ = a_ > b_; K[21] = g_ ? a_ : b_; K[23] = g_ ? b_ : a_; }
  { const float a_ = K[24], b_ = K[26]; const bool g_ = a_ > b_; K[24] = g_ ? b_ : a_; K[26] = g_ ? a_ : b_; }
  { const float a_ = K[25], b_ = K[27]; const bool g_ = a_ > b_; K[25] = g_ ? b_ : a_; K[27] = g_ ? a_ : b_; }
  { const float a_ = K[28], b_ = K[30]; const bool g_ = a_ > b_; K[28] = g_ ? b_ : a_; K[30] = g_ ? a_ : b_; }
  { const float a_ = K[29], b_ = K[31]; const bool g_ = a_ > b_; K[29] = g_ ? b_ : a_; K[31] = g_ ? a_ : b_; }
  { const float a_ = K[16], b_ = K[17]; const bool g_ = a_ > b_; K[16] = g_ ? a_ : b_; K[17] = g_ ? b_ : a_; }
  { const float a_ = K[18], b_ = K[19]; const bool g_ = a_ > b_; K[18] = g_ ? a_ : b_; K[19] = g_ ? b_ : a_; }
  { const float a_ = K[20], b_ = K[21]; const bool g_ = a_ > b_; K[20] = g_ ? a_ : b_; K[21] = g_ ? b_ : a_; }
  { const float a_ = K[22], b_ = K[23]; const bool g_ = a_ > b_; K[22] = g_ ? a_ : b_; K[23] = g_ ? b_ : a_; }
  { const float a_ = K[24], b_ = K[25]; const bool g_ = a_ > b_; K[24] = g_ ? b_ : a_; K[25] = g_ ? a_ : b_; }
  { const float a_ = K[26], b_ = K[27]; const bool g_ = a_ > b_; K[26] = g_ ? b_ : a_; K[27] = g_ ? a_ : b_; }
  { const float a_ = K[28], b_ = K[29]; const bool g_ = a_ > b_; K[28] = g_ ? b_ : a_; K[29] = g_ ? a_ : b_; }
  { const float a_ = K[30], b_ = K[31]; const bool g_ = a_ > b_; K[30] = g_ ? b_ : a_; K[31] = g_ ? a_ : b_; }
  { const float a_ = K[16], b_ = K[24]; const bool g_ = a_ > b_; K[16] = g_ ? a_ : b_; K[24] = g_ ? b_ : a_; }
  { const float a_ = K[17], b_ = K[25]; const bool g_ = a_ > b_; K[17] = g_ ? a_ : b_; K[25] = g_ ? b_ : a_; }
  { const float a_ = K[18], b_ = K[26]; const bool g_ = a_ > b_; K[18] = g_ ? a_ : b_; K[26] = g_ ? b_ : a_; }
  { const float a_ = K[19], b_ = K[27]; const bool g_ = a_ > b_; K[19] = g_ ? a_ : b_; K[27] = g_ ? b_ : a_; }
  { const float a_ = K[20], b_ = K[28]; const bool g_ = a_ > b_; K[20] = g_ ? a_ : b_; K[28] = g_ ? b_ : a_; }
  { const float a_ = K[21], b_ = K[29]; const bool g_ = a_ > b_; K[21] = g_ ? a_ : b_; K[29] = g_ ? b_ : a_; }
  { const float a_ = K[22], b_ = K[30]; const bool g_ = a_ > b_; K[22] = g_ ? a_ : b_; K[30] = g_ ? b_ : a_; }
  { const float a_ = K[23], b_ = K[31]; const bool g_ = a_ > b_; K[23] = g_ ? a_ : b_; K[31] = g_ ? b_ : a_; }
  { const float a_ = K[16], b_ = K[20]; const bool g_ = a_ > b_; K[16] = g_ ? a_ : b_; K[20] = g_ ? b_ : a_; }
  { const float a_ = K[17], b_ = K[21]; const bool g_ = a_ > b_; K[17] = g_ ? a_ : b_; K[21] = g_ ? b_ : a_; }
  { const float a_ = K[18], b_ = K[22]; const bool g_ = a_ > b_; K[18] = g_ ? a_ : b_; K[22] = g_ ? b_ : a_; }
  { const float a_ = K[19], b_ = K[23]; const bool g_ = a_ > b_; K[19] = g_ ? a_ : b_; K[23] = g_ ? b_ : a_; }
  { const float a_ = K[24], b_ = K[28]; const bool g_ = a_ > b_; K[24] = g_ ? a_ : b_; K[28] = g_ ? b_ : a_; }
  { const float a_ = K[25], b_ = K[29]; const bool g_ = a_ > b_; K[25] = g_ ? a_ : b_; K[29] = g_ ? b_ : a_; }
  { const float a_ = K[26], b_ = K[30]; const bool g_ = a_ > b_; K[26] = g_ ? a_ : b_; K[30] = g_ ? b_ : a_; }
  { const float a_ = K[27], b_ = K[31]; const bool g_ = a_ > b_; K[27] = g_ ? a_ : b_; K[31] = g_ ? b_ : a_; }
  { const float a_ = K[16], b_ = K[18]; const bool g_ = a_ > b_; K[16] = g_ ? a_ : b_; K[18] = g_ ? b_ : a_; }
  { const float a_ = K[17], b_ = K[19]; const bool g_ = a_ > b_; K[17] = g_ ? a_ : b_; K[19] = g_ ? b_ : a_; }
  { const float a_ = K[20], b_ = K[22]; const bool g_ = a_ > b_; K[20] = g_ ? a_ : b_; K[22] = g_ ? b_ : a_; }
  { const float a_ = K[21], b_ = K[23]; const bool g_ = a_ > b_; K[21] = g_ ? a_ : b_; K[23] = g_ ? b_ : a_; }
  { const float a_ = K[24], b_ = K[26]; const bool g_ = a_ > b_; K[24] = g_ ? a_ : b_; K[26] = g_ ? b_ : a_; }
  { const float a_ = K[25], b_ = K[27]; const bool g_ = a_ > b_; K[25] = g_ ? a_ : b_; K[27] = g_ ? b_ : a_; }
  { const float a_ = K[28], b_ = K[30]; const bool g_ = a_ > b_; K[28] = g_ ? a_ : b_; K[30] = g_ ? b_ : a_; }
  { const float a_ = K[29], b_ = K[31]; const bool g_ = a_ > b_; K[29] = g_ ? a_ : b_; K[31] = g_ ? b_ : a_; }
  { const float a_ = K[16], b_ = K[17]; const bool g_ = a_ > b_; K[16] = g_ ? a_ : b_; K[17] = g_ ? b_ : a_; }
  { const float a_ = K[18], b_ = K[19]; const bool g_ = a_ > b_; K[18] = g_ ? a_ : b_; K[19] = g_ ? b_ : a_; }
  { const float a_ = K[20], b_ = K[21]; const bool g_ = a_ > b_; K[20] = g_ ? a_ : b_; K[21] = g_ ? b_ : a_; }
  { const float a_ = K[22], b_ = K[23]; const bool g_ = a_ > b_; K[22] = g_ ? a_ : b_; K[23] = g_ ? b_ : a_; }
  { const float a_ = K[24], b_ = K[25]; const bool g_ = a_ > b_; K[24] = g_ ? a_ : b_; K[25] = g_ ? b_ : a_; }
  { const float a_ = K[26], b_ = K[27]; const bool g_ = a_ > b_; K[26] = g_ ? a_ : b_; K[27] = g_ ? b_ : a_; }
  { const float a_ = K[28], b_ = K[29]; const bool g_ = a_ > b_; K[28] = g_ ? a_ : b_; K[29] = g_ ? b_ : a_; }
  { const float a_ = K[30], b_ = K[31]; const bool g_ = a_ > b_; K[30] = g_ ? a_ : b_; K[31] = g_ ? b_ : a_; }
  { const float a_ = K[32], b_ = K[33]; const bool g_ = a_ > b_; K[32] = g_ ? a_ : b_; K[33] = g_ ? b_ : a_; }
  { const float a_ = K[34], b_ = K[35]; const bool g_ = a_ > b_; K[34] = g_ ? b_ : a_; K[35] = g_ ? a_ : b_; }
  { const float a_ = K[36], b_ = K[37]; const bool g_ = a_ > b_; K[36] = g_ ? a_ : b_; K[37] = g_ ? b_ : a_; }
  { const float a_ = K[38], b_ = K[39]; const bool g_ = a_ > b_; K[38] = g_ ? b_ : a_; K[39] = g_ ? a_ : b_; }
  { const float a_ = K[40], b_ = K[41]; const bool g_ = a_ > b_; K[40] = g_ ? a_ : b_; K[41] = g_ ? b_ : a_; }
  { const float a_ = K[42], b_ = K[43]; const bool g_ = a_ > b_; K[42] = g_ ? b_ : a_; K[43] = g_ ? a_ : b_; }
  { const float a_ = K[44], b_ = K[45]; const bool g_ = a_ > b_; K[44] = g_ ? a_ : b_; K[45] = g_ ? b_ : a_; }
  { const float a_ = K[46], b_ = K[47]; const bool g_ = a_ > b_; K[46] = g_ ? b_ : a_; K[47] = g_ ? a_ : b_; }
  { const float a_ = K[32], b_ = K[34]; const bool g_ = a_ > b_; K[32] = g_ ? a_ : b_; K[34] = g_ ? b_ : a_; }
  { const float a_ = K[33], b_ = K[35]; const bool g_ = a_ > b_; K[33] = g_ ? a_ : b_; K[35] = g_ ? b_ : a_; }
  { const float a_ = K[36], b_ = K[38]; const bool g_ = a_ > b_; K[36] = g_ ? b_ : a_; K[38] = g_ ? a_ : b_; }
  { const float a_ = K[37], b_ = K[39]; const bool g_ = a_ > b_; K[37] = g_ ? b_ : a_; K[39] = g_ ? a_ : b_; }
  { const float a_ = K[40], b_ = K[42]; const bool g_ = a_ > b_; K[40] = g_ ? a_ : b_; K[42] = g_ ? b_ : a_; }
  { const float a_ = K[41], b_ = K[43]; const bool g_ = a_ > b_; K[41] = g_ ? a_ : b_; K[43] = g_ ? b_ : a_; }
  { const float a_ = K[44], b_ = K[46]; const bool g_ = a_ > b_; K[44] = g_ ? b_ : a_; K[46] = g_ ? a_ : b_; }
  { const float a_ = K[45], b_ = K[47]; const bool g_ = a_ > b_; K[45] = g_ ? b_ : a_; K[47] = g_ ? a_ : b_; }
  { const float a_ = K[32], b_ = K[33]; const bool g_ = a_ > b_; K[32] = g_ ? a_ : b_; K[33] = g_ ? b_ : a_; }
  { const float a_ = K[34], b_ = K[35]; const bool g_ = a_ > b_; K[34] = g_ ? a_ : b_; K[35] = g_ ? b_ : a_; }
  { const float a_ = K[36], b_ = K[37]; const bool g_ = a_ > b_; K[36] = g_ ? b_ : a_; K[37] = g_ ? a_ : b_; }
  { const float a_ = K[38], b_ = K[39]; const bool g_ = a_ > b_; K[38] = g_ ? b_ : a_; K[39] = g_ ? a_ : b_; }
  { const float a_ = K[40], b_ = K[41]; const bool g_ = a_ > b_; K[40] = g_ ? a_ : b_; K[41] = g_ ? b_ : a_; }
  { const float a_ = K[42], b_ = K[43]; const bool g_ = a_ > b_; K[42] = g_ ? a_ : b_; K[43] = g_ ? b_ : a_; }
  { const float a_ = K[44], b_ = K[45]; const bool g_ = a_ > b_; K[44] = g_ ? b_ : a_; K[45] = g_ ? a_ : b_; }
  { const float a_ = K[46], b_ = K[47]; const bool g_ = a_ > b_; K[46] = g_ ? b_ : a_; K[47] = g_ ? a_ : b_; }
  { const float a_ = K[32], b_ = K[36]; const bool g_ = a_ > b_; K[32] = g_ ? a_ : b_; K[36] = g_ ? b_ : a_; }
  { const float a_ = K[33], b_ = K[37]; const bool g_ = a_ > b_; K[33] = g_ ? a_ : b_; K[37] = g_ ? b_ : a_; }
  { const float a_ = K[34], b_ = K[38]; const bool g_ = a_ > b_; K[34] = g_ ? a_ : b_; K[38] = g_ ? b_ : a_; }
  { const float a_ = K[35], b_ = K[39]; const bool g_ = a_ > b_; K[35] = g_ ? a_ : b_; K[39] = g_ ? b_ : a_; }
  { const float a_ = K[40], b_ = K[44]; const bool g_ = a_ > b_; K[40] = g_ ? b_ : a_; K[44] = g_ ? a_ : b_; }
  { const float a_ = K[41], b_ = K[45]; const bool g_ = a_ > b_; K[41] = g_ ? b_ : a_; K[45] = g_ ? a_ : b_; }
  { const float a_ = K[42], b_ = K[46]; const bool g_ = a_ > b_; K[42] = g_ ? b_ : a_; K[46] = g_ ? a_ : b_; }
  { const float a_ = K[43], b_ = K[47]; const bool g_ = a_ > b_; K[43] = g_ ? b_ : a_; K[47] = g_ ? a_ : b_; }
  { const float a_ = K[32], b_ = K[34]; const bool g_ = a_ > b_; K[32] = g_ ? a_ : b_; K[34] = g_ ? b_ : a_; }
  { const float a_ = K[33], b_ = K[35]; const bool g_ = a_ > b_; K[33] = g_ ? a_ : b_; K[35] = g_ ? b_ : a_; }
  { const float a_ = K[36], b_ = K[38]; const bool g_ = a_ > b_; K[36] = g_ ? a_ : b_; K[38] = g_ ? b_ : a_; }
  { const float a_ = K[37], b_ = K[39]; const bool g_ = a_ > b_; K[37] = g_ ? a_ : b_; K[39] = g_ ? b_ : a_; }
  { const float a_ = K[40], b_ = K[42]; const bool g_ = a_ > b_; K[40] = g_ ? b_ : a_; K[42] = g_ ? a_ : b_; }
  { const float a_ = K[41], b_ = K[43]; const bool g_ = a_ > b_; K[41] = g_ ? b_ : a_; K[43] = g_ ? a_ : b_; }
  { const float a_ = K[44], b_ = K[46]; const bool g_ = a_ > b_; K[44] = g_ ? b_ : a_; K[46] = g_ ? a_ : b_; }
  { const float a_ = K[45], b_ = K[47]; const bool g_ = a_ > b_; K[45] = g_ ? b_ : a_; K[47] = g_ ? a_ : b_; }
  { const float a_ = K[32], b_ = K[33]; const bool g_ = a_ > b_; K[32] = g_ ? a_ : b_; K[33] = g_ ? b_ : a_; }
  { const float a_ = K[34], b_ = K[35]; const bool g_ = a_ > b_; K[34] = g_ ? a_ : b_; K[35] = g_ ? b_ : a_; }
  { const float a_ = K[36], b_ = K[37]; const bool g_ = a_ > b_; K[36] = g_ ? a_ : b_; K[37] = g_ ? b_ : a_; }
  { const float a_ = K[38], b_ = K[39]; const bool g_ = a_ > b_; K[38] = g_ ? a_ : b_; K[39] = g_ ? b_ : a_; }
  { const float a_ = K[40], b_ = K[41]; const bool g_ = a_ > b_; K[40] = g_ ? b_ : a_; K[41] = g_ ? a_ : b_; }
  { const float a_ = K[42], b_ = K[43]; const bool g_ = a_ > b_; K[42] = g_ ? b_ : a_; K[43] = g_ ? a_ : b_; }
  { const float a_ = K[44], b_ = K[45]; const bool g_ = a_ > b_; K[44] = g_ ? b_ : a_; K[45] = g_ ? a_ : b_; }
  { const float a_ = K[46], b_ = K[47]; const bool g_ = a_ > b_; K[46] = g_ ? b_ : a_; K[47] = g_ ? a_ : b_; }
  { const float a_ = K[32], b_ = K[40]; const bool g_ = a_ > b_; K[32] = g_ ? a_ : b_; K[40] = g_ ? b_ : a_; }
  { const float a_ = K[33], b_ = K[41]; const bool g_ = a_ > b_; K[33] = g_ ? a_ : b_; K[41] = g_ ? b_ : a_; }
  { const float a_ = K[34], b_ = K[42]; const bool g_ = a_ > b_; K[34] = g_ ? a_ : b_; K[42] = g_ ? b_ : a_; }
  { const float a_ = K[35], b_ = K[43]; const bool g_ = a_ > b_; K[35] = g_ ? a_ : b_; K[43] = g_ ? b_ : a_; }
  { const float a_ = K[36], b_ = K[44]; const bool g_ = a_ > b_; K[36] = g_ ? a_ : b_; K[44] = g_ ? b_ : a_; }
  { const float a_ = K[37], b_ = K[45]; const bool g_ = a_ > b_; K[37] = g_ ? a_ : b_; K[45] = g_ ? b_ : a_; }
  { const float a_ = K[38], b_ = K[46]; const bool g_ = a_ > b_; K[38] = g_ ? a_ : b_; K[46] = g_ ? b_ : a_; }
  { const float a_ = K[39], b_ = K[47]; const bool g_ = a_ > b_; K[39] = g_ ? a_ : b_; K[47] = g_ ? b_ : a_; }
  { const float a_ = K[32], b_ = K[36]; const bool g_ = a_ > b_; K[32] = g_ ? a_ : b_; K[36] = g_ ? b_ : a_; }
  { const float a_ = K[33], b_ = K[37]; const bool g_ = a_ > b_; K[33] = g_ ? a_ : b_; K[37] = g_ ? b_ : a_; }
  { const float a_ = K[34], b_ = K[38]; const bool g_ = a_ > b_; K[34] = g_ ? a_ : b_; K[38] = g_ ? b_ : a_; }
  { const float a_ = K[35], b_ = K[39]; const bool g_ = a_ > b_; K[35] = g_ ? a_ : b_; K[39] = g_ ? b_ : a_; }
  { const float a_ = K[40], b_ = K[44]; const bool g_ = a_ > b_; K[40] = g_ ? a_ : b_; K[44] = g_ ? b_ : a_; }
  { const float a_ = K[41], b_ = K[45]; const bool g_ = a_ > b_; K[41] = g_ ? a_ : b_; K[45] = g_ ? b_ : a_; }
  { const float a_ = K[42], b_ = K[46]; const bool g_ = a_ > b_; K[42] = g_ ? a_ : b_; K[46] = g_ ? b_ : a_; }
  { const float a_ = K[43], b_ = K[47]; const bool g_ = a_ > b_; K[43] = g_ ? a_ : b_; K[47] = g_ ? b_ : a_; }
  { const float a_ = K[32], b_ = K[34]; const bool g_ = a_ > b_; K[32] = g_ ? a_ : b_; K[34] = g_ ? b_ : a_; }
  { const float a_ = K[33], b_ = K[35]; const bool g_ = a_ > b_; K[33] = g_ ? a_ : b_; K[35] = g_ ? b_ : a_; }
  { const float a_ = K[36], b_ = K[38]; const bool g_ = a_ > b_; K[36] = g_ ? a_ : b_; K[38] = g_ ? b_ : a_; }
  { const float a_ = K[37], b_ = K[39]; const bool g_ = a_ > b_; K[37] = g_ ? a_ : b_; K[39] = g_ ? b_ : a_; }
  { const float a_ = K[40], b_ = K[42]; const bool g_ = a_ > b_; K[40] = g_ ? a_ : b_; K[42] = g_ ? b_ : a_; }
  { const float a_ = K[41], b_ = K[43]; const bool g_ = a_ > b_; K[41] = g_ ? a_ : b_; K[43] = g_ ? b_ : a_; }
  { const float a_ = K[44], b_ = K[46]; const bool g_ = a_ > b_; K[44] = g_ ? a_ : b_; K[46] = g_ ? b_ : a_; }
  { const float a_ = K[45], b_ = K[47]; const bool g_ = a_ > b_; K[45] = g_ ? a_ : b_; K[47] = g_ ? b_ : a_; }
  { const float a_ = K[32], b_ = K[33]; const bool g_ = a_ > b_; K[32] = g_ ? a_ : b_; K[33] = g_ ? b_ : a_; }
  { const float a_ = K[34], b_ = K[35]; const bool g_ = a_ > b_; K[34] = g_ ? a_ : b_; K[35] = g_ ? b_ : a_; }
  { const float a_ = K[36], b_ = K[37]; const bool g_ = a_ > b_; K[36] = g_ ? a_ : b_; K[37] = g_ ? b_ : a_; }
  { const float a_ = K[38], b_ = K[39]; const bool g_ = a_ > b_; K[38] = g_ ? a_ : b_; K[39] = g_ ? b_ : a_; }
  { const float a_ = K[40], b_ = K[41]; const bool g_ = a_ > b_; K[40] = g_ ? a_ : b_; K[41] = g_ ? b_ : a_; }
  { const float a_ = K[42], b_ = K[43]; const bool g_ = a_ > b_; K[42] = g_ ? a_ : b_; K[43] = g_ ? b_ : a_; }
  { const float a_ = K[44], b_ = K[45]; const bool g_ = a_ > b_; K[44] = g_ ? a_ : b_; K[45] = g_ ? b_ : a_; }
  { const float a_ = K[46], b_ = K[47]; const bool g_ = a_ > b_; K[46] = g_ ? a_ : b_; K[47] = g_ ? b_ : a_; }
  { const float a_ = K[48], b_ = K[49]; const bool g_ = a_ > b_; K[48] = g_ ? a_ : b_; K[49] = g_ ? b_ : a_; }
  { const float a_ = K[50], b_ = K[51]; const bool g_ = a_ > b_; K[50] = g_ ? b_ : a_; K[51] = g_ ? a_ : b_; }
  { const float a_ = K[52], b_ = K[53]; const bool g_ = a_ > b_; K[52] = g_ ? a_ : b_; K[53] = g_ ? b_ : a_; }
  { const float a_ = K[54], b_ = K[55]; const bool g_ = a_ > b_; K[54] = g_ ? b_ : a_; K[55] = g_ ? a_ : b_; }
  { const float a_ = K[56], b_ = K[57]; const bool g_ = a_ > b_; K[56] = g_ ? a_ : b_; K[57] = g_ ? b_ : a_; }
  { const float a_ = K[58], b_ = K[59]; const bool g_ = a_ > b_; K[58] = g_ ? b_ : a_; K[59] = g_ ? a_ : b_; }
  { const float a_ = K[60], b_ = K[61]; const bool g_ = a_ > b_; K[60] = g_ ? a_ : b_; K[61] = g_ ? b_ : a_; }
  { const float a_ = K[62], b_ = K[63]; const bool g_ = a_ > b_; K[62] = g_ ? b_ : a_; K[63] = g_ ? a_ : b_; }
  { const float a_ = K[48], b_ = K[50]; const bool g_ = a_ > b_; K[48] = g_ ? a_ : b_; K[50] = g_ ? b_ : a_; }
  { const float a_ = K[49], b_ = K[51]; const bool g_ = a_ > b_; K[49] = g_ ? a_ : b_; K[51] = g_ ? b_ : a_; }
  { const float a_ = K[52], b_ = K[54]; const bool g_ = a_ > b_; K[52] = g_ ? b_ : a_; K[54] = g_ ? a_ : b_; }
  { const float a_ = K[53], b_ = K[55]; const bool g_ = a_ > b_; K[53] = g_ ? b_ : a_; K[55] = g_ ? a_ : b_; }
  { const float a_ = K[56], b_ = K[58]; const bool g_ = a_ > b_; K[56] = g_ ? a_ : b_; K[58] = g_ ? b_ : a_; }
  { const float a_ = K[57], b_ = K[59]; const bool g_ = a_ > b_; K[57] = g_ ? a_ : b_; K[59] = g_ ? b_ : a_; }
  { const float a_ = K[60], b_ = K[62]; const bool g_ = a_ > b_; K[60] = g_ ? b_ : a_; K[62] = g_ ? a_ : b_; }
  { const float a_ = K[61], b_ = K[63]; const bool g_ = a_ > b_; K[61] = g_ ? b_ : a_; K[63] = g_ ? a_ : b_; }
  { const float a_ = K[48], b_ = K[49]; const bool g_ = a_ > b_; K[48] = g_ ? a_ : b_; K[49] = g_ ? b_ : a_; }
  { const float a_ = K[50], b_ = K[51]; const bool g_ = a_ > b_; K[50] = g_ ? a_ : b_; K[51] = g_ ? b_ : a_; }
  { const float a_ = K[52], b_ = K[53]; const bool g_ = a_ > b_; K[52] = g_ ? b_ : a_; K[53] = g_ ? a_ : b_; }
  { const float a_ = K[54], b_ = K[55]; const bool g_ = a_ > b_; K[54] = g_ ? b_ : a_; K[55] = g_ ? a_ : b_; }
  { const float a_ = K[56], b_ = K[57]; const bool g_ = a_ > b_; K[56] = g_ ? a_ : b_; K[57] = g_ ? b_ : a_; }
  { const float a_ = K[58], b_ = K[59]; const bool g_ = a_ > b_; K[58] = g_ ? a_ : b_; K[59] = g_ ? b_ : a_; }
  { const float a_ = K[60], b_ = K[61]; const bool g_ = a_ > b_; K[60] = g_ ? b_ : a_; K[61] = g_ ? a_ : b_; }
  { const float a_ = K[62], b_ = K[63]; const bool g_ = a_ > b_; K[62] = g_ ? b_ : a_; K[63] = g_ ? a_ : b_; }
  { const float a_ = K[48], b_ = K[52]; const bool g_ = a_ > b_; K[48] = g_ ? a_ : b_; K[52] = g_ ? b_ : a_; }
  { const float a_ = K[49], b_ = K[53]; const bool g_ = a_ > b_; K[49] = g_ ? a_ : b_; K[53] = g_ ? b_ : a_; }
  { const float a_ = K[50], b_ = K[54]; const bool g_ = a_ > b_; K[50] = g_ ? a_ : b_; K[54] = g_ ? b_ : a_; }
  { const float a_ = K[51], b_ = K[55]; const bool g_ = a_ > b_; K[51] = g_ ? a_ : b_; K[55] = g_ ? b_ : a_; }
  { const float a_ = K[56], b_ = K[60]; const bool g_ = a_ > b_; K[56] = g_ ? b_ : a_; K[60] = g_ ? a_ : b_; }
  { const float a_ = K[57], b_ = K[61]; const bool g_ = a_ > b_; K[57] = g_ ? b_ : a_; K[61] = g_ ? a_ : b_; }
  { const float a_ = K[58], b_ = K[62]; const bool g_ = a_ > b_; K[58] = g_ ? b_ : a_; K[62] = g_ ? a_ : b_; }
  { const float a_ = K[59], b_ = K[63]; const bool g_ = a_ > b_; K[59] = g_ ? b_ : a_; K[63] = g_ ? a_ : b_; }
  { const float a_ = K[48], b_ = K[50]; const bool g_ = a_ > b_; K[48] = g_ ? a_ : b_; K[50] = g_ ? b_ : a_; }
  { const float a_ = K[49], b_ = K[51]; const bool g_ = a_ > b_; K[49] = g_ ? a_ : b_; K[51] = g_ ? b_ : a_; }
  { const float a_ = K[52], b_ = K[54]; const bool g_ = a_ > b_; K[52] = g_ ? a_ : b_; K[54] = g_ ? b_ : a_; }
  { const float a_ = K[53], b_ = K[55]; const bool g_ = a_ > b_; K[53] = g_ ? a_ : b_; K[55] = g_ ? b_ : a_; }
  { const float a_ = K[56], b_ = K[58]; const bool g_ = a_ > b_; K[56] = g_ ? b_ : a_; K[58] = g_ ? a_ : b_; }
  { const float a_ = K[57], b_ = K[59]; const bool g_ = a_ > b_; K[57] = g_ ? b_ : a_; K[59] = g_ ? a_ : b_; }
  { const float a_ = K[60], b_ = K[62]; const bool g_ = a_ > b_; K[60] = g_ ? b_ : a_; K[62] = g_ ? a_ : b_; }
  { const float a_ = K[61], b_ = K[63]; const bool g_ = a_ > b_; K[61] = g_ ? b_ : a_; K[63] = g_ ? a_ : b_; }
  { const float a_ = K[48], b_ = K[49]; const bool g_ = a_ > b_; K[48] = g_ ? a_ : b_; K[49] = g_ ? b_ : a_; }
  { const float a_ = K[50], b_ = K[51]; const bool g_ = a_ > b_; K[50] = g_ ? a_ : b_; K[51] = g_ ? b_ : a_; }
  { const float a_ = K[52], b_ = K[53]; const bool g_ = a_ > b_; K[52] = g_ ? a_ : b_; K[53] = g_ ? b_ : a_; }
  { const float a_ = K[54], b_ = K[55]; const bool g_ = a_ > b_; K[54] = g_ ? a_ : b_; K[55] = g_ ? b_ : a_; }
  { const float a_ = K[56], b_ = K[57]; const bool g_ = a_ > b_; K[56] = g_ ? b_ : a_; K[57] = g_ ? a_ : b_; }
  { const float a_ = K[58], b_ = K[59]; const bool g_ = a_ > b_; K[58] = g_ ? b_ : a_; K[59] = g_ ? a_ : b_; }
  { const float a_ = K[60], b_ = K[61]; const bool g_ = a_ > b_; K[60] = g_ ? b_ : a_; K[61] = g_ ? a_ : b_; }
  { const float a_ = K[62], b_ = K[63]; const bool g_ = a_ > b_; K[62] = g_ ? b_ : a_; K[63] = g_ ? a_ : b_; }
  { const float a_ = K[48], b_ = K[56]; const bool g_ = a_ > b_; K[48] = g_ ? a_ : b_; K[56] = g_ ? b_ : a_; }
  { const float a_ = K[49], b_ = K[57]; const bool g_ = a_ > b_; K[49] = g_ ? a_ : b_; K[57] = g_ ? b_ : a_; }
  { const float a_ = K[50], b_ = K[58]; const bool g_ = a_ > b_; K[50] = g_ ? a_ : b_; K[58] = g_ ? b_ : a_; }
  { const float a_ = K[51], b_ = K[59]; const bool g_ = a_ > b_; K[51] = g_ ? a_ : b_; K[59] = g_ ? b_ : a_; }
  { const float a_ = K[52], b_ = K[60]; const bool g_ = a_ > b_; K[52] = g_ ? a_ : b_; K[60] = g_ ? b_ : a_; }
  { const float a_ = K[53], b_ = K[61]; const bool g_ = a_ > b_; K[53] = g_ ? a_ : b_; K[61] = g_ ? b_ : a_; }
  { const float a_ = K[54], b_ = K[62]; const bool g_ = a_ > b_; K[54] = g_ ? a_ : b_; K[62] = g_ ? b_ : a_; }
  { const float a_ = K[55], b_ = K[63]; const bool g_ = a_ > b_; K[55] = g_ ? a_ : b_; K[63] = g_ ? b_ : a_; }
  { const float a_ = K[48], b_ = K[52]; const bool g_ = a_ > b_; K[48] = g_ ? a_ : b_; K[52] = g_ ? b_ : a_; }
  { const float a_ = K[49], b_ = K[53]; const bool g_ = a_ > b_; K[49] = g_ ? a_ : b_; K[53] = g_ ? b_ : a_; }
  { const float a_ = K[50], b_ = K[54]; const bool g_ = a_ > b_; K[50] = g_ ? a_ : b_; K[54] = g_ ? b_ : a_; }
  { const float a_ = K[51], b_ = K[55]; const bool g_ = a_ > b_; K[51] = g_ ? a_ : b_; K[55] = g_ ? b_ : a_; }
  { const float a_ = K[56], b_ = K[60]; const bool g_ = a_ > b_; K[56] = g_ ? a_ : b_; K[60] = g_ ? b_ : a_; }
  { const float a_ = K[57], b_ = K[61]; const bool g_ = a_ > b_; K[57] = g_ ? a_ : b_; K[61] = g_ ? b_ : a_; }
  { const float a_ = K[58], b_ = K[62]; const bool g_ = a_ > b_; K[58] = g_ ? a_ : b_; K[62] = g_ ? b_ : a_; }
  { const float a_ = K[59], b_ = K[63]; const bool g_ = a_ > b_; K[59] = g_ ? a_ : b_; K[63] = g_ ? b_ : a_; }
  { const float a_ = K[48], b_ = K[50]; const bool g_ = a_ > b_; K[48] = g_ ? a_ : b_; K[50] = g_ ? b_ : a_; }
  { const float a_ = K[49], b_ = K[51]; const bool g_ = a_ > b_; K[49] = g_ ? a_ : b_; K[51] = g_ ? b_ : a_; }
  { const float a_ = K[52], b_ = K[54]; const bool g_ = a_ > b_; K[52] = g_ ? a_ : b_; K[54] = g_ ? b_ : a_; }
  { const float a_ = K[53], b_ = K[55]; const bool g_ = a_ > b_; K[53] = g_ ? a_ : b_; K[55] = g_ ? b_ : a_; }
  { const float a_ = K[56], b_ = K[58]; const bool g_ = a_ > b_; K[56] = g_ ? a_ : b_; K[58] = g_ ? b_ : a_; }
  { const float a_ = K[57], b_ = K[59]; const bool g_ = a_ > b_; K[57] = g_ ? a_ : b_; K[59] = g_ ? b_ : a_; }
  { const float a_ = K[60], b_ = K[62]; const bool g_ = a_ > b_; K[60] = g_ ? a_ : b_; K[62] = g_ ? b_ : a_; }
  { const float a_ = K[61], b_ = K[63]; const bool g_ = a_ > b_; K[61] = g_ ? a_ : b_; K[63] = g_ ? b_ : a_; }
  { const float a_ = K[48], b_ = K[49]; const bool g_ = a_ > b_; K[48] = g_ ? a_ : b_; K[49] = g_ ? b_ : a_; }
  { const float a_ = K[50], b_ = K[51]; const bool g_ = a_ > b_; K[50] = g_ ? a_ : b_; K[51] = g_ ? b_ : a_; }
  { const float a_ = K[52], b_ = K[53]; const bool g_ = a_ > b_; K[52] = g_ ? a_ : b_; K[53] = g_ ? b_ : a_; }
  { const float a_ = K[54], b_ = K[55]; const bool g_ = a_ > b_; K[54] = g_ ? a_ : b_; K[55] = g_ ? b_ : a_; }
  { const float a_ = K[56], b_ = K[57]; const bool g_ = a_ > b_; K[56] = g_ ? a_ : b_; K[57] = g_ ? b_ : a_; }
  { const float a_ = K[58], b_ = K[59]; const bool g_ = a_ > b_; K[58] = g_ ? a_ : b_; K[59] = g_ ? b_ : a_; }
  { const float a_ = K[60], b_ = K[61]; const bool g_ = a_ > b_; K[60] = g_ ? a_ : b_; K[61] = g_ ? b_ : a_; }
  { const float a_ = K[62], b_ = K[63]; const bool g_ = a_ > b_; K[62] = g_ ? a_ : b_; K[63] = g_ ? b_ : a_; }
  { const float a_ = K[0], b_ = K[31]; K[0] = a_ > b_ ? a_ : b_; }
  { const float a_ = K[1], b_ = K[30]; K[1] = a_ > b_ ? a_ : b_; }
  { const float a_ = K[2], b_ = K[29]; K[2] = a_ > b_ ? a_ : b_; }
  { const float a_ = K[3], b_ = K[28]; K[3] = a_ > b_ ? a_ : b_; }
  { const float a_ = K[4], b_ = K[27]; K[4] = a_ > b_ ? a_ : b_; }
  { const float a_ = K[5], b_ = K[26]; K[5] = a_ > b_ ? a_ : b_; }
  { const float a_ = K[6], b_ = K[25]; K[6] = a_ > b_ ? a_ : b_; }
  { const float a_ = K[7], b_ = K[24]; K[7] = a_ > b_ ? a_ : b_; }
  { const float a_ = K[8], b_ = K[23]; K[8] = a_ > b_ ? a_ : b_; }
  { const float a_ = K[9], b_ = K[22]; K[9] = a_ > b_ ? a_ : b_; }
  { const float a_ = K[10], b_ = K[21]; K[10] = a_ > b_ ? a_ : b_; }
  { const float a_ = K[11], b_ = K[20]; K[11] = a_ > b_ ? a_ : b_; }
  { const float a_ = K[12], b_ = K[19]; K[12] = a_ > b_ ? a_ : b_; }
  { const float a_ = K[13], b_ = K[18]; K[13] = a_ > b_ ? a_ : b_; }
  { const float a_ = K[14], b_ = K[17]; K[14] = a_ > b_ ? a_ : b_; }
  { const float a_ = K[15], b_ = K[16]; K[15] = a_ > b_ ? a_ : b_; }
  { const float a_ = K[0], b_ = K[8]; const bool g_ = a_ > b_; K[0] = g_ ? a_ : b_; K[8] = g_ ? b_ : a_; }
  { const float a_ = K[1], b_ = K[9]; const bool g_ = a_ > b_; K[1] = g_ ? a_ : b_; K[9] = g_ ? b_ : a_; }
  { const float a_ = K[2], b_ = K[10]; const bool g_ = a_ > b_; K[2] = g_ ? a_ : b_; K[10] = g_ ? b_ : a_; }
  { const float a_ = K[3], b_ = K[11]; const bool g_ = a_ > b_; K[3] = g_ ? a_ : b_; K[11] = g_ ? b_ : a_; }
  { const float a_ = K[4], b_ = K[12]; const bool g_ = a_ > b_; K[4] = g_ ? a_ : b_; K[12] = g_ ? b_ : a_; }
  { const float a_ = K[5], b_ = K[13]; const bool g_ = a_ > b_; K[5] = g_ ? a_ : b_; K[13] = g_ ? b_ : a_; }
  { const float a_ = K[6], b_ = K[14]; const bool g_ = a_ > b_; K[6] = g_ ? a_ : b_; K[14] = g_ ? b_ : a_; }
  { const float a_ = K[7], b_ = K[15]; const bool g_ = a_ > b_; K[7] = g_ ? a_ : b_; K[15] = g_ ? b_ : a_; }
  { const float a_ = K[0], b_ = K[4]; const bool g_ = a_ > b_; K[0] = g_ ? a_ : b_; K[4] = g_ ? b_ : a_; }
  { const float a_ = K[1], b_ = K[5]; const bool g_ = a_ > b_; K[1] = g_ ? a_ : b_; K[5] = g_ ? b_ : a_; }
  { const float a_ = K[2], b_ = K[6]; const bool g_ = a_ > b_; K[2] = g_ ? a_ : b_; K[6] = g_ ? b_ : a_; }
  { const float a_ = K[3], b_ = K[7]; const bool g_ = a_ > b_; K[3] = g_ ? a_ : b_; K[7] = g_ ? b_ : a_; }
  { const float a_ = K[8], b_ = K[12]; const bool g_ = a_ > b_; K[8] = g_ ? a_ : b_; K[12] = g_ ? b_ : a_; }
  { const float a_ = K[9], b_ = K[13]; const bool g_ = a_ > b_; K[9] = g_ ? a_ : b_; K[13] = g_ ? b_ : a_; }
  { const float a_ = K[10], b_ = K[14]; const bool g_ = a_ > b_; K[10] = g_ ? a_ : b_; K[14] = g_ ? b_ : a_; }
  { const float a_ = K[11], b_ = K[15]; const bool g_ = a_ > b_; K[11] = g_ ? a_ : b_; K[15] = g_ ? b_ : a_; }
  { const float a_ = K[0], b_ = K[2]; const bool g_ = a_ > b_; K[0] = g_ ? a_ : b_; K[2] = g_ ? b_ : a_; }
  { const float a_ = K[1], b_ = K[3]; const bool g_ = a_ > b_; K[1] = g_ ? a_ : b_; K[3] = g_ ? b_ : a_; }
  { const float a_ = K[4], b_ = K[6]; const bool g_ = a_ > b_; K[4] = g_ ? a_ : b_; K[6] = g_ ? b_ : a_; }
  { const float a_ = K[5], b_ = K[7]; const bool g_ = a_ > b_; K[5] = g_ ? a_ : b_; K[7] = g_ ? b_ : a_; }
  { const float a_ = K[8], b_ = K[10]; const bool g_ = a_ > b_; K[8] = g_ ? a_ : b_; K[10] = g_ ? b_ : a_; }
  { const float a_ = K[9], b_ = K[11]; const bool g_ = a_ > b_; K[9] = g_ ? a_ : b_; K[11] = g_ ? b_ : a_; }
  { const float a_ = K[12], b_ = K[14]; const bool g_ = a_ > b_; K[12] = g_ ? a_ : b_; K[14] = g_ ? b_ : a_; }
  { const float a_ = K[13], b_ = K[15]; const bool g_ = a_ > b_; K[13] = g_ ? a_ : b_; K[15] = g_ ? b_ : a_; }
  { const float a_ = K[0], b_ = K[1]; const bool g_ = a_ > b_; K[0] = g_ ? a_ : b_; K[1] = g_ ? b_ : a_; }
  { const float a_ = K[2], b_ = K[3]; const bool g_ = a_ > b_; K[2] = g_ ? a_ : b_; K[3] = g_ ? b_ : a_; }
  { const float a_ = K[4], b_ = K[5]; const bool g_ = a_ > b_; K[4] = g_ ? a_ : b_; K[5] = g_ ? b_ : a_; }
  { const float a_ = K[6], b_ = K[7]; const bool g_ = a_ > b_; K[6] = g_ ? a_ : b_; K[7] = g_ ? b_ : a_; }
  { const float a_ = K[8], b_ = K[9]; const bool g_ = a_ > b_; K[8] = g_ ? a_ : b_; K[9] = g_ ? b_ : a_; }
  { const float a_ = K[10], b_ = K[11]; const bool g_ = a_ > b_; K[10] = g_ ? a_ : b_; K[11] = g_ ? b_ : a_; }
  { const float a_ = K[12], b_ = K[13]; const bool g_ = a_ > b_; K[12] = g_ ? a_ : b_; K[13] = g_ ? b_ : a_; }
  { const float a_ = K[14], b_ = K[15]; const bool g_ = a_ > b_; K[14] = g_ ? a_ : b_; K[15] = g_ ? b_ : a_; }
  { const float a_ = K[32], b_ = K[63]; K[32] = a_ > b_ ? a_ : b_; }
  { const float a_ = K[33], b_ = K[62]; K[33] = a_ > b_ ? a_ : b_; }
  { const float a_ = K[34], b_ = K[61]; K[34] = a_ > b_ ? a_ : b_; }
  { const float a_ = K[35], b_ = K[60]; K[35] = a_ > b_ ? a_ : b_; }
  { const float a_ = K[36], b_ = K[59]; K[36] = a_ > b_ ? a_ : b_; }
  { const float a_ = K[37], b_ = K[58]; K[37] = a_ > b_ ? a_ : b_; }
  { const float a_ = K[38], b_ = K[57]; K[38] = a_ > b_ ? a_ : b_; }
  { const float a_ = K[39], b_ = K[56]; K[39] = a_ > b_ ? a_ : b_; }
  { const float a_ = K[40], b_ = K[55]; K[40] = a_ > b_ ? a_ : b_; }
  { const float a_ = K[41], b_ = K[54]; K[41] = a_ > b_ ? a_ : b_; }
  { const float a_ = K[42], b_ = K[53]; K[42] = a_ > b_ ? a_ : b_; }
  { const float a_ = K[43], b_ = K[52]; K[43] = a_ > b_ ? a_ : b_; }
  { const float a_ = K[44], b_ = K[51]; K[44] = a_ > b_ ? a_ : b_; }
  { const float a_ = K[45], b_ = K[50]; K[45] = a_ > b_ ? a_ : b_; }
  { const float a_ = K[46], b_ = K[49]; K[46] = a_ > b_ ? a_ : b_; }
  { const float a_ = K[47], b_ = K[48]; K[47] = a_ > b_ ? a_ : b_; }
  { const float a_ = K[32], b_ = K[40]; const bool g_ = a_ > b_; K[32] = g_ ? a_ : b_; K[40] = g_ ? b_ : a_; }
  { const float a_ = K[33], b_ = K[41]; const bool g_ = a_ > b_; K[33] = g_ ? a_ : b_; K[41] = g_ ? b_ : a_; }
  { const float a_ = K[34], b_ = K[42]; const bool g_ = a_ > b_; K[34] = g_ ? a_ : b_; K[42] = g_ ? b_ : a_; }
  { const float a_ = K[35], b_ = K[43]; const bool g_ = a_ > b_; K[35] = g_ ? a_ : b_; K[43] = g_ ? b_ : a_; }
  { const float a_ = K[36], b_ = K[44]; const bool g_ = a_ > b_; K[36] = g_ ? a_ : b_; K[44] = g_ ? b_ : a_; }
  { const float a_ = K[37], b_ = K[45]; const bool g_ = a_ > b_; K[37] = g_ ? a_ : b_; K[45] = g_ ? b_ : a_; }
  { const float a_ = K[38], b_ = K[46]; const bool g_ = a_ > b_; K[38] = g_ ? a_ : b_; K[46] = g_ ? b_ : a_; }
  { const float a_ = K[39], b_ = K[47]; const bool g_ = a_ > b_; K[39] = g_ ? a_ : b_; K[47] = g_ ? b_ : a_; }
  { const float a_ = K[32], b_ = K[36]; const bool g_ = a_ > b_; K[32] = g_ ? a_ : b_; K[36] = g_ ? b_ : a_; }
  { const float a_ = K[33], b_ = K[37]; const bool g_ = a_ > b_; K[33] = g_ ? a_ : b_; K[37] = g_ ? b_ : a_; }
  { const float a_ = K[34], b_ = K[38]; const bool g_ = a_ > b_; K[34] = g_ ? a_ : b_; K[38] = g_ ? b_ : a_; }
  { const float a_ = K[35], b_ = K[39]; const bool g_ = a_ > b_; K[35] = g_ ? a_ : b_; K[39] = g_ ? b_ : a_; }
  { const float a_ = K[40], b_ = K[44]; const bool g_ = a_ > b_; K[40] = g_ ? a_ : b_; K[44] = g_ ? b_ : a_; }
  { const float a_ = K[41], b_ = K[45]; const bool g_ = a_ > b_; K[41] = g_ ? a_ : b_; K[45] = g_ ? b_ : a_; }
  { const float a_ = K[42], b_ = K[46]; const bool g_ = a_ > b_; K[42] = g_ ? a_ : b_; K[46] = g_ ? b_ : a_; }
  { const float a_ = K[43], b_ = K[47]; const bool g_ = a_ > b_; K[43] = g_ ? a_ : b_; K[47] = g_ ? b_ : a_; }
  { const float a_ = K[32], b_ = K[34]; const bool g_ = a_ > b_; K[32] = g_ ? a_ : b_; K[34] = g_ ? b_ : a_; }
  { const float a_ = K[33], b_ = K[35]; const bool g_ = a_ > b_; K[33] = g_ ? a_ : b_; K[35] = g_ ? b_ : a_; }
  { const float a_ = K[36], b_ = K[38]; const bool g_ = a_ > b_; K[36] = g_ ? a_ : b_; K[38] = g_ ? b_ : a_; }
  { const float a_ = K[37], b_ = K[39]; const bool g_ = a_ > b_; K[37] = g_ ? a_ : b_; K[39] = g_ ? b_ : a_; }
  { const float a_ = K[40], b_ = K[42]; const bool g_ = a_ > b_; K[40] = g_ ? a_ : b_; K[42] = g_ ? b_ : a_; }
  { const float a_ = K[41], b_ = K[43]; const bool g_ = a_ > b_; K[41] = g_ ? a_ : b_; K[43] = g_ ? b_ : a_; }
  { const float a_ = K[44], b_ = K[46]; const bool g_ = a_ > b_; K[44] = g_ ? a_ : b_; K[46] = g_ ? b_ : a_; }
  { const float a_ = K[45], b_ = K[47]; const bool g_ = a_ > b_; K[45] = g_ ? a_ : b_; K[47] = g_ ? b_ : a_; }
  { const float a_ = K[32], b_ = K[33]; const bool g_ = a_ > b_; K[32] = g_ ? a_ : b_; K[33] = g_ ? b_ : a_; }
  { const float a_ = K[34], b_ = K[35]; const bool g_ = a_ > b_; K[34] = g_ ? a_ : b_; K[35] = g_ ? b_ : a_; }
  { const float a_ = K[36], b_ = K[37]; const bool g_ = a_ > b_; K[36] = g_ ? a_ : b_; K[37] = g_ ? b_ : a_; }
  { const float a_ = K[38], b_ = K[39]; const bool g_ = a_ > b_; K[38] = g_ ? a_ : b_; K[39] = g_ ? b_ : a_; }
  { const float a_ = K[40], b_ = K[41]; const bool g_ = a_ > b_; K[40] = g_ ? a_ : b_; K[41] = g_ ? b_ : a_; }
  { const float a_ = K[42], b_ = K[43]; const bool g_ = a_ > b_; K[42] = g_ ? a_ : b_; K[43] = g_ ? b_ : a_; }
  { const float a_ = K[44], b_ = K[45]; const bool g_ = a_ > b_; K[44] = g_ ? a_ : b_; K[45] = g_ ? b_ : a_; }
  { const float a_ = K[46], b_ = K[47]; const bool g_ = a_ > b_; K[46] = g_ ? a_ : b_; K[47] = g_ ? b_ : a_; }
  { const float a_ = K[0], b_ = K[47]; K[0] = a_ > b_ ? a_ : b_; }
  { const float a_ = K[1], b_ = K[46]; K[1] = a_ > b_ ? a_ : b_; }
  { const float a_ = K[2], b_ = K[45]; K[2] = a_ > b_ ? a_ : b_; }
  { const float a_ = K[3], b_ = K[44]; K[3] = a_ > b_ ? a_ : b_; }
  { const float a_ = K[4], b_ = K[43]; K[4] = a_ > b_ ? a_ : b_; }
  { const float a_ = K[5], b_ = K[42]; K[5] = a_ > b_ ? a_ : b_; }
  { const float a_ = K[6], b_ = K[41]; K[6] = a_ > b_ ? a_ : b_; }
  { const float a_ = K[7], b_ = K[40]; K[7] = a_ > b_ ? a_ : b_; }
  { const float a_ = K[8], b_ = K[39]; K[8] = a_ > b_ ? a_ : b_; }
  { const float a_ = K[9], b_ = K[38]; K[9] = a_ > b_ ? a_ : b_; }
  { const float a_ = K[10], b_ = K[37]; K[10] = a_ > b_ ? a_ : b_; }
  { const float a_ = K[11], b_ = K[36]; K[11] = a_ > b_ ? a_ : b_; }
  { const float a_ = K[12], b_ = K[35]; K[12] = a_ > b_ ? a_ : b_; }
  { const float a_ = K[13], b_ = K[34]; K[13] = a_ > b_ ? a_ : b_; }
  { const float a_ = K[14], b_ = K[33]; K[14] = a_ > b_ ? a_ : b_; }
  { const float a_ = K[15], b_ = K[32]; K[15] = a_ > b_ ? a_ : b_; }
  { const float a_ = K[0], b_ = K[8]; const bool g_ = a_ > b_; K[0] = g_ ? a_ : b_; K[8] = g_ ? b_ : a_; }
  { const float a_ = K[1], b_ = K[9]; const bool g_ = a_ > b_; K[1] = g_ ? a_ : b_; K[9] = g_ ? b_ : a_; }
  { const float a_ = K[2], b_ = K[10]; const bool g_ = a_ > b_; K[2] = g_ ? a_ : b_; K[10] = g_ ? b_ : a_; }
  { const float a_ = K[3], b_ = K[11]; const bool g_ = a_ > b_; K[3] = g_ ? a_ : b_; K[11] = g_ ? b_ : a_; }
  { const float a_ = K[4], b_ = K[12]; const bool g_ = a_ > b_; K[4] = g_ ? a_ : b_; K[12] = g_ ? b_ : a_; }
  { const float a_ = K[5], b_ = K[13]; const bool g_ = a_ > b_; K[5] = g_ ? a_ : b_; K[13] = g_ ? b_ : a_; }
  { const float a_ = K[6], b_ = K[14]; const bool g_ = a_ > b_; K[6] = g_ ? a_ : b_; K[14] = g_ ? b_ : a_; }
  { const float a_ = K[7], b_ = K[15]; const bool g_ = a_ > b_; K[7] = g_ ? a_ : b_; K[15] = g_ ? b_ : a_; }
  { const float a_ = K[0], b_ = K[4]; const bool g_ = a_ > b_; K[0] = g_ ? a_ : b_; K[4] = g_ ? b_ : a_; }
  { const float a_ = K[1], b_ = K[5]; const bool g_ = a_ > b_; K[1] = g_ ? a_ : b_; K[5] = g_ ? b_ : a_; }
  { const float a_ = K[2], b_ = K[6]; const bool g_ = a_ > b_; K[2] = g_ ? a_ : b_; K[6] = g_ ? b_ : a_; }
  { const float a_ = K[3], b_ = K[7]; const bool g_ = a_ > b_; K[3] = g_ ? a_ : b_; K[7] = g_ ? b_ : a_; }
  { const float a_ = K[8], b_ = K[12]; const bool g_ = a_ > b_; K[8] = g_ ? a_ : b_; K[12] = g_ ? b_ : a_; }
  { const float a_ = K[9], b_ = K[13]; const bool g_ = a_ > b_; K[9] = g_ ? a_ : b_; K[13] = g_ ? b_ : a_; }
  { const float a_ = K[10], b_ = K[14]; const bool g_ = a_ > b_; K[10] = g_ ? a_ : b_; K[14] = g_ ? b_ : a_; }
  { const float a_ = K[11], b_ = K[15]; const bool g_ = a_ > b_; K[11] = g_ ? a_ : b_; K[15] = g_ ? b_ : a_; }
  { const float a_ = K[0], b_ = K[2]; const bool g_ = a_ > b_; K[0] = g_ ? a_ : b_; K[2] = g_ ? b_ : a_; }
  { const float a_ = K[1], b_ = K[3]; const bool g_ = a_ > b_; K[1] = g_ ? a_ : b_; K[3] = g_ ? b_ : a_; }
  { const float a_ = K[4], b_ = K[6]; const bool g_ = a_ > b_; K[4] = g_ ? a_ : b_; K[6] = g_ ? b_ : a_; }
  { const float a_ = K[5], b_ = K[7]; const bool g_ = a_ > b_; K[5] = g_ ? a_ : b_; K[7] = g_ ? b_ : a_; }
  { const float a_ = K[8], b_ = K[10]; const bool g_ = a_ > b_; K[8] = g_ ? a_ : b_; K[10] = g_ ? b_ : a_; }
  { const float a_ = K[9], b_ = K[11]; const bool g_ = a_ > b_; K[9] = g_ ? a_ : b_; K[11] = g_ ? b_ : a_; }
  { const float a_ = K[12], b_ = K[14]; const bool g_ = a_ > b_; K[12] = g_ ? a_ : b_; K[14] = g_ ? b_ : a_; }
  { const float a_ = K[13], b_ = K[15]; const bool g_ = a_ > b_; K[13] = g_ ? a_ : b_; K[15] = g_ ? b_ : a_; }
  { const float a_ = K[0], b_ = K[1]; const bool g_ = a_ > b_; K[0] = g_ ? a_ : b_; K[1] = g_ ? b_ : a_; }
  { const float a_ = K[2], b_ = K[3]; const bool g_ = a_ > b_; K[2] = g_ ? a_ : b_; K[3] = g_ ? b_ : a_; }
  { const float a_ = K[4], b_ = K[5]; const bool g_ = a_ > b_; K[4] = g_ ? a_ : b_; K[5] = g_ ? b_ : a_; }
  { const float a_ = K[6], b_ = K[7]; const bool g_ = a_ > b_; K[6] = g_ ? a_ : b_; K[7] = g_ ? b_ : a_; }
  { const float a_ = K[8], b_ = K[9]; const bool g_ = a_ > b_; K[8] = g_ ? a_ : b_; K[9] = g_ ? b_ : a_; }
  { const float a_ = K[10], b_ = K[11]; const bool g_ = a_ > b_; K[10] = g_ ? a_ : b_; K[11] = g_ ? b_ : a_; }
  { const float a_ = K[12], b_ = K[13]; const bool g_ = a_ > b_; K[12] = g_ ? a_ : b_; K[13] = g_ ? b_ : a_; }
  { const float a_ = K[14], b_ = K[15]; const bool g_ = a_ > b_; K[14] = g_ ? a_ : b_; K[15] = g_ ? b_ : a_; }
}
__device__ __forceinline__ void merge_top16(float (&T)[16], const float (&P)[16]) {
  { const float a_ = T[0], b_ = P[15]; T[0] = a_ > b_ ? a_ : b_; }
  { const float a_ = T[1], b_ = P[14]; T[1] = a_ > b_ ? a_ : b_; }
  { const float a_ = T[2], b_ = P[13]; T[2] = a_ > b_ ? a_ : b_; }
  { const float a_ = T[3], b_ = P[12]; T[3] = a_ > b_ ? a_ : b_; }
  { const float a_ = T[4], b_ = P[11]; T[4] = a_ > b_ ? a_ : b_; }
  { const float a_ = T[5], b_ = P[10]; T[5] = a_ > b_ ? a_ : b_; }
  { const float a_ = T[6], b_ = P[9]; T[6] = a_ > b_ ? a_ : b_; }
  { const float a_ = T[7], b_ = P[8]; T[7] = a_ > b_ ? a_ : b_; }
  { const float a_ = T[8], b_ = P[7]; T[8] = a_ > b_ ? a_ : b_; }
  { const float a_ = T[9], b_ = P[6]; T[9] = a_ > b_ ? a_ : b_; }
  { const float a_ = T[10], b_ = P[5]; T[10] = a_ > b_ ? a_ : b_; }
  { const float a_ = T[11], b_ = P[4]; T[11] = a_ > b_ ? a_ : b_; }
  { const float a_ = T[12], b_ = P[3]; T[12] = a_ > b_ ? a_ : b_; }
  { const float a_ = T[13], b_ = P[2]; T[13] = a_ > b_ ? a_ : b_; }
  { const float a_ = T[14], b_ = P[1]; T[14] = a_ > b_ ? a_ : b_; }
  { const float a_ = T[15], b_ = P[0]; T[15] = a_ > b_ ? a_ : b_; }
  { const float a_ = T[0], b_ = T[8]; const bool g_ = a_ > b_; T[0] = g_ ? a_ : b_; T[8] = g_ ? b_ : a_; }
  { const float a_ = T[1], b_ = T[9]; const bool g_ = a_ > b_; T[1] = g_ ? a_ : b_; T[9] = g_ ? b_ : a_; }
  { const float a_ = T[2], b_ = T[10]; const bool g_ = a_ > b_; T[2] = g_ ? a_ : b_; T[10] = g_ ? b_ : a_; }
  { const float a_ = T[3], b_ = T[11]; const bool g_ = a_ > b_; T[3] = g_ ? a_ : b_; T[11] = g_ ? b_ : a_; }
  { const float a_ = T[4], b_ = T[12]; const bool g_ = a_ > b_; T[4] = g_ ? a_ : b_; T[12] = g_ ? b_ : a_; }
  { const float a_ = T[5], b_ = T[13]; const bool g_ = a_ > b_; T[5] = g_ ? a_ : b_; T[13] = g_ ? b_ : a_; }
  { const float a_ = T[6], b_ = T[14]; const bool g_ = a_ > b_; T[6] = g_ ? a_ : b_; T[14] = g_ ? b_ : a_; }
  { const float a_ = T[7], b_ = T[15]; const bool g_ = a_ > b_; T[7] = g_ ? a_ : b_; T[15] = g_ ? b_ : a_; }
  { const float a_ = T[0], b_ = T[4]; const bool g_ = a_ > b_; T[0] = g_ ? a_ : b_; T[4] = g_ ? b_ : a_; }
  { const float a_ = T[1], b_ = T[5]; const bool g_ = a_ > b_; T[1] = g_ ? a_ : b_; T[5] = g_ ? b_ : a_; }
  { const float a_ = T[2], b_ = T[6]; const bool g_ = a_ > b_; T[2] = g_ ? a_ : b_; T[6] = g_ ? b_ : a_; }
  { const float a_ = T[3], b_ = T[7]; const bool g_ = a_ > b_; T[3] = g_ ? a_ : b_; T[7] = g_ ? b_ : a_; }
  { const float a_ = T[8], b_ = T[12]; const bool g_ = a_ > b_; T[8] = g_ ? a_ : b_; T[12] = g_ ? b_ : a_; }
  { const float a_ = T[9], b_ = T[13]; const bool g_ = a_ > b_; T[9] = g_ ? a_ : b_; T[13] = g_ ? b_ : a_; }
  { const float a_ = T[10], b_ = T[14]; const bool g_ = a_ > b_; T[10] = g_ ? a_ : b_; T[14] = g_ ? b_ : a_; }
  { const float a_ = T[11], b_ = T[15]; const bool g_ = a_ > b_; T[11] = g_ ? a_ : b_; T[15] = g_ ? b_ : a_; }
  { const float a_ = T[0], b_ = T[2]; const bool g_ = a_ > b_; T[0] = g_ ? a_ : b_; T[2] = g_ ? b_ : a_; }
  { const float a_ = T[1], b_ = T[3]; const bool g_ = a_ > b_; T[1] = g_ ? a_ : b_; T[3] = g_ ? b_ : a_; }
  { const float a_ = T[4], b_ = T[6]; const bool g_ = a_ > b_; T[4] = g_ ? a_ : b_; T[6] = g_ ? b_ : a_; }
  { const float a_ = T[5], b_ = T[7]; const bool g_ = a_ > b_; T[5] = g_ ? a_ : b_; T[7] = g_ ? b_ : a_; }
  { const float a_ = T[8], b_ = T[10]; const bool g_ = a_ > b_; T[8] = g_ ? a_ : b_; T[10] = g_ ? b_ : a_; }
  { const float a_ = T[9], b_ = T[11]; const bool g_ = a_ > b_; T[9] = g_ ? a_ : b_; T[11] = g_ ? b_ : a_; }
  { const float a_ = T[12], b_ = T[14]; const bool g_ = a_ > b_; T[12] = g_ ? a_ : b_; T[14] = g_ ? b_ : a_; }
  { const float a_ = T[13], b_ = T[15]; const bool g_ = a_ > b_; T[13] = g_ ? a_ : b_; T[15] = g_ ? b_ : a_; }
  { const float a_ = T[0], b_ = T[1]; const bool g_ = a_ > b_; T[0] = g_ ? a_ : b_; T[1] = g_ ? b_ : a_; }
  { const float a_ = T[2], b_ = T[3]; const bool g_ = a_ > b_; T[2] = g_ ? a_ : b_; T[3] = g_ ? b_ : a_; }
  { const float a_ = T[4], b_ = T[5]; const bool g_ = a_ > b_; T[4] = g_ ? a_ : b_; T[5] = g_ ? b_ : a_; }
  { const float a_ = T[6], b_ = T[7]; const bool g_ = a_ > b_; T[6] = g_ ? a_ : b_; T[7] = g_ ? b_ : a_; }
  { const float a_ = T[8], b_ = T[9]; const bool g_ = a_ > b_; T[8] = g_ ? a_ : b_; T[9] = g_ ? b_ : a_; }
  { const float a_ = T[10], b_ = T[11]; const bool g_ = a_ > b_; T[10] = g_ ? a_ : b_; T[11] = g_ ? b_ : a_; }
  { const float a_ = T[12], b_ = T[13]; const bool g_ = a_ > b_; T[12] = g_ ? a_ : b_; T[13] = g_ ? b_ : a_; }
  { const float a_ = T[14], b_ = T[15]; const bool g_ = a_ > b_; T[14] = g_ ? a_ : b_; T[15] = g_ ? b_ : a_; }
}

__device__ __forceinline__ void peer_topk(const int wave_s, const bf16* pq, const bf16* skb, int* ids, float* gates, LAS float* smem) {
  const int tid_ = opaque_tid(wave_s);
  const int lane = tid_ & 63, n = lane & 31, hh = lane >> 5, wave = tid_ >> 6;
  const int gw = blockIdx.x * NWAVES + wave;
  const int nw = gridDim.x * NWAVES;
  LAS float* lk = smem + wave * 2048;
  for (int it = gw; it < 512 * 8; it += nw) {
    const int h = it & 7, tok0 = (it >> 3) * 32;
#pragma unroll 1
    for (int half = 0; half < 2; half++) {
      bf16x8_t qf[8];
      {
        const bf16* qrow = pq + (size_t)(tok0 + n) * 2048 + h * 256 + half * 128 + 8 * hh;
#pragma unroll
        for (int ks = 0; ks < 8; ks++) qf[ks] = *(const bf16x8_t*)(qrow + 16 * ks);
      }
      float K[64];
#pragma unroll
      for (int kt = 0; kt < 4; kt++) {
        const bf16* krow = skb + ((size_t)((h * 2 + half) * 128 + kt * 32 + n)) * 128 + 8 * hh;
        f32x16_t acc;
#pragma unroll
        for (int r = 0; r < 16; r++) acc[r] = 0.f;
#pragma unroll
        for (int kq = 0; kq < 2; kq++) {
          bf16x8_t kf[4];
#pragma unroll
          for (int i = 0; i < 4; i++) kf[i] = *(const bf16x8_t*)(krow + 16 * (kq * 4 + i));
          MFMA_PAD();
#pragma unroll
          for (int i = 0; i < 4; i++) acc = __builtin_amdgcn_mfma_f32_32x32x16_bf16(kf[i], qf[kq * 4 + i], acc, 0, 0, 0);
          MFMA_PAD();
        }
#pragma unroll
        for (int i = 0; i < 16; i++) K[kt * 16 + i] = pack_key<0x7Fu>(acc[i], (unsigned)(kt * 32 + (i & 3) + 8 * (i >> 2) + 4 * hh));
      }
      __builtin_amdgcn_sched_barrier(0);
      top16_of_64(K);
      __builtin_amdgcn_sched_barrier(0);
      float T[16], P[16];
#pragma unroll
      for (int i = 0; i < 16; i++) { T[i] = K[i]; P[i] = __shfl_xor(K[i], 32, 64); }
      merge_top16(T, P);
#pragma unroll
      for (int i = 0; i < 16; i++) lk[(half * 16 + i) * 64 + lane] = T[i];
      __builtin_amdgcn_sched_barrier(0);
    }
    float f0[16], f1[16];
    int ti0[16], ti1[16];
#pragma unroll
    for (int i = 0; i < 16; i++) {
      const float k0 = lk[i * 64 + lane], k1 = lk[(16 + i) * 64 + lane];
      f0[i] = key_val<0x7Fu>(k0); ti0[i] = (int)key_idx<0x7Fu>(k0);
      f1[i] = key_val<0x7Fu>(k1); ti1[i] = (int)key_idx<0x7Fu>(k1);
    }
    float K[64];
    {
    K[0] = pack_key<0xFFu>(f0[0] + f1[0], 0u);
    K[1] = pack_key<0xFFu>(f0[0] + f1[1], 1u);
    K[2] = pack_key<0xFFu>(f0[0] + f1[2], 2u);
    K[3] = pack_key<0xFFu>(f0[0] + f1[3], 3u);
    K[4] = pack_key<0xFFu>(f0[0] + f1[4], 4u);
    K[5] = pack_key<0xFFu>(f0[0] + f1[5], 5u);
    K[6] = pack_key<0xFFu>(f0[0] + f1[6], 6u);
    K[7] = pack_key<0xFFu>(f0[0] + f1[7], 7u);
    K[8] = pack_key<0xFFu>(f0[0] + f1[8], 8u);
    K[9] = pack_key<0xFFu>(f0[0] + f1[9], 9u);
    K[10] = pack_key<0xFFu>(f0[0] + f1[10], 10u);
    K[11] = pack_key<0xFFu>(f0[0] + f1[11], 11u);
    K[12] = pack_key<0xFFu>(f0[0] + f1[12], 12u);
    K[13] = pack_key<0xFFu>(f0[0] + f1[13], 13u);
    K[14] = pack_key<0xFFu>(f0[0] + f1[14], 14u);
    K[15] = pack_key<0xFFu>(f0[0] + f1[15], 15u);
    K[16] = pack_key<0xFFu>(f0[1] + f1[0], 16u);
    K[17] = pack_key<0xFFu>(f0[1] + f1[1], 17u);
    K[18] = pack_key<0xFFu>(f0[1] + f1[2], 18u);
    K[19] = pack_key<0xFFu>(f0[1] + f1[3], 19u);
    K[20] = pack_key<0xFFu>(f0[1] + f1[4], 20u);
    K[21] = pack_key<0xFFu>(f0[1] + f1[5], 21u);
    K[22] = pack_key<0xFFu>(f0[1] + f1[6], 22u);
    K[23] = pack_key<0xFFu>(f0[1] + f1[7], 23u);
    K[24] = pack_key<0xFFu>(f0[2] + f1[0], 32u);
    K[25] = pack_key<0xFFu>(f0[2] + f1[1], 33u);
    K[26] = pack_key<0xFFu>(f0[2] + f1[2], 34u);
    K[27] = pack_key<0xFFu>(f0[2] + f1[3], 35u);
    K[28] = pack_key<0xFFu>(f0[2] + f1[4], 36u);
    K[29] = pack_key<0xFFu>(f0[3] + f1[0], 48u);
    K[30] = pack_key<0xFFu>(f0[3] + f1[1], 49u);
    K[31] = pack_key<0xFFu>(f0[3] + f1[2], 50u);
    K[32] = pack_key<0xFFu>(f0[3] + f1[3], 51u);
    K[33] = pack_key<0xFFu>(f0[4] + f1[0], 64u);
    K[34] = pack_key<0xFFu>(f0[4] + f1[1], 65u);
    K[35] = pack_key<0xFFu>(f0[4] + f1[2], 66u);
    K[36] = pack_key<0xFFu>(f0[5] + f1[0], 80u);
    K[37] = pack_key<0xFFu>(f0[5] + f1[1], 81u);
    K[38] = pack_key<0xFFu>(f0[6] + f1[0], 96u);
    K[39] = pack_key<0xFFu>(f0[6] + f1[1], 97u);
    K[40] = pack_key<0xFFu>(f0[7] + f1[0], 112u);
    K[41] = pack_key<0xFFu>(f0[7] + f1[1], 113u);
    K[42] = pack_key<0xFFu>(f0[8] + f1[0], 128u);
    K[43] = pack_key<0xFFu>(f0[9] + f1[0], 144u);
    K[44] = pack_key<0xFFu>(f0[10] + f1[0], 160u);
    K[45] = pack_key<0xFFu>(f0[11] + f1[0], 176u);
    K[46] = pack_key<0xFFu>(f0[12] + f1[0], 192u);
    K[47] = pack_key<0xFFu>(f0[13] + f1[0], 208u);
    K[48] = pack_key<0xFFu>(f0[14] + f1[0], 224u);
    K[49] = pack_key<0xFFu>(f0[15] + f1[0], 240u);
    K[50] = -3.0e38f;
    K[51] = -3.0e38f;
    K[52] = -3.0e38f;
    K[53] = -3.0e38f;
    K[54] = -3.0e38f;
    K[55] = -3.0e38f;
    K[56] = -3.0e38f;
    K[57] = -3.0e38f;
    K[58] = -3.0e38f;
    K[59] = -3.0e38f;
    K[60] = -3.0e38f;
    K[61] = -3.0e38f;
    K[62] = -3.0e38f;
    K[63] = -3.0e38f;
    }
    __builtin_amdgcn_sched_barrier(0);
    top16_of_64(K);
    __builtin_amdgcn_sched_barrier(0);
    float bv[16];
    int be[16];
#pragma unroll
    for (int r = 0; r < 16; r++) {
      const int flat = (int)key_idx<0xFFu>(K[r]);
      const int a = flat >> 4, b = flat & 15;
      int i0 = 0, i1 = 0;
#pragma unroll
      for (int i = 0; i < 16; i++) { i0 = (a == i) ? ti0[i] : i0; i1 = (b == i) ? ti1[i] : i1; }
      be[r] = i0 * 128 + i1;
      bv[r] = key_val<0xFFu>(K[r]);
    }
    const float b0 = bv[0];
    float ge[16];
    float gsum = 0.f;
#pragma unroll
    for (int r = 0; r < 16; r++) { ge[r] = __expf(bv[r] - b0); gsum += ge[r]; }
    const float ginv = 1.0f / gsum;
    if (hh == 0) {
      int* ip = ids + (size_t)(tok0 + n) * 128 + h * 16;
      float* gp = gates + (size_t)(tok0 + n) * 128 + h * 16;
#pragma unroll
      for (int r4 = 0; r4 < 4; r4++) {
        *(int4*)(ip + 4 * r4) = make_int4(be[4 * r4], be[4 * r4 + 1], be[4 * r4 + 2], be[4 * r4 + 3]);
        *(float4*)(gp + 4 * r4) = make_float4(ge[4 * r4] * ginv, ge[4 * r4 + 1] * ginv, ge[4 * r4 + 2] * ginv, ge[4 * r4 + 3] * ginv);
      }
    }
  }
}

typedef _Float16 f16x2_t __attribute__((ext_vector_type(2)));
__device__ __forceinline__ unsigned e4m3x2_to_f16x2(unsigned w, unsigned sel) {
  return __builtin_amdgcn_perm(w, w, sel);
}
__device__ __forceinline__ float dot2h(unsigned a, unsigned b, float c) {
  return __builtin_amdgcn_fdot2(__builtin_bit_cast(f16x2_t, a), __builtin_bit_cast(f16x2_t, b), c, false);
}
__device__ __forceinline__ unsigned pack_h2(float lo, float hi) {
  f16x2_t v; v.x = (_Float16)lo; v.y = (_Float16)hi;
  return __builtin_bit_cast(unsigned, v);
}
template <bool FINAL>
__device__ __forceinline__ void peer_gather(const int wave_s, bf16* xn, const float* rst, const unsigned char* ub, const unsigned char* vb, const float* vsc, const float* usc,
                                            const int* ids, const float* gates, float* xw, const float* gnext, float* outp) {
  const int tid_ = opaque_tid(wave_s);
  const int lane = tid_ & 63;
  const int gw = blockIdx.x * NWAVES + (tid_ >> 6);
  const int nw = gridDim.x * NWAVES;
  const int el = ((lane >> 5) & 1) * 8 + ((lane >> 4) & 1) * 4 + ((lane >> 3) & 1) * 2 + ((lane >> 2) & 1);
  int idv = 0;
  uint2 uu[16];
  uint2 vv[16];
  if (gw < NT) {
    idv = ids[(size_t)gw * 128 + (lane & 15)];
#pragma unroll
    for (int e = 0; e < 16; e++) {
      const int id = __builtin_amdgcn_readlane(idv, e);
      uu[e] = *(const uint2*)(ub + (size_t)id * 512 + lane * 8);
      vv[e] = *(const uint2*)(vb + (size_t)id * 512 + lane * 8);
    }
  }
  for (int tok = gw; tok < NT; tok += nw) {
    const int tokn = (tok + nw < NT) ? tok + nw : tok;
    int xqh[2] = {0, 0}, xql[2] = {0, 0};
    float xstep, qhalf;
    {
      const uint4 a = *(const uint4*)(xn + (size_t)tok * DM + lane * 16);
      const uint4 b = *(const uint4*)(xn + (size_t)tok * DM + lane * 16 + 8);
      const unsigned xw_[8] = {a.x, a.y, a.z, a.w, b.x, b.y, b.z, b.w};
      const float4* sp = (const float4*)(rst + (size_t)tok * 16);
      const float4 s0 = sp[0], s1 = sp[1], s2 = sp[2], s3 = sp[3];
      const float xs = rsqrtf((((s0.x + s0.y) + (s0.z + s0.w)) + ((s1.x + s1.y) + (s1.z + s1.w)) + ((s2.x + s2.y) + (s2.z + s2.w)) + ((s3.x + s3.y) + (s3.z + s3.w))) * (1.0f / 1024.f) + EPSF);
      float xf[16];
      float am = 0.f;
#pragma unroll
      for (int k = 0; k < 8; k++) { xf[2 * k] = bf_lo(xw_[k]) * xs; xf[2 * k + 1] = bf_hi(xw_[k]) * xs; am = fmaxf(am, fmaxf(fabsf(xf[2 * k]), fabsf(xf[2 * k + 1]))); }
#pragma unroll
      for (int o = 32; o >= 1; o >>= 1) am = fmaxf(am, __shfl_xor(am, o, 64));
      xstep = am * (1.0f / 119.f);
      const float inv = am > 0.f ? 119.f / am : 0.f;
      int qs = 0;
#pragma unroll
      for (int i = 0; i < 16; i++) {
        const int q = (int)rintf(xf[i] * inv);
        const int t = q + 8;
        xqh[i >> 3] |= ((t >> 4) & 15) << (4 * (i & 7));
        xql[i >> 3] |= (((t & 15) - 8) & 15) << (4 * (i & 7));
        qs += q;
      }
      qhalf = 0.5f * wsum((float)qs);
    }
    f16x2_t acc2[8];
#pragma unroll
    for (int i = 0; i < 8; i++) acc2[i] = (f16x2_t){(_Float16)0.f, (_Float16)0.f};
#pragma unroll 1
    for (int g = 0; g < 8; g++) {
      const int ide = __builtin_amdgcn_ds_bpermute(el << 2, idv);
      const float2 sc2 = ((const float2*)vsc)[ide];
      const float gv = gates[(size_t)tok * 128 + g * 16 + el] * sc2.x;
      const float us = sc2.y * xstep;
      const int idn = ids[(size_t)(g < 7 ? tok : tokn) * 128 + ((g + 1) & 7) * 16 + (lane & 15)];
      float d[16];
#pragma unroll
      for (int e = 0; e < 16; e++) {
        int sh = __builtin_amdgcn_sdot8((int)uu[e].x, xqh[0], 0, false);
        sh = __builtin_amdgcn_sdot8((int)uu[e].y, xqh[1], sh, false);
        int sl = __builtin_amdgcn_sdot8((int)uu[e].x, xql[0], 0, false);
        sl = __builtin_amdgcn_sdot8((int)uu[e].y, xql[1], sl, false);
        d[e] = (float)((sh << 4) + sl);
      }
#pragma unroll
      for (int e = 0; e < 16; e++) {
        const int id = __builtin_amdgcn_readlane(idn, e);
        uu[e] = *(const uint2*)(ub + (size_t)id * 512 + lane * 8);
      }
      float d8[8], d4[4], d2[2], d1;
      {
        const bool hi = (lane & 32) != 0;
#pragma unroll
        for (int i = 0; i < 8; i++) { const float send = hi ? d[i] : d[i + 8]; const float keep = hi ? d[i + 8] : d[i]; d8[i] = keep + __shfl_xor(send, 32, 64); }
      }
      {
        const bool hi = (lane & 16) != 0;
#pragma unroll
        for (int i = 0; i < 4; i++) { const float send = hi ? d8[i] : d8[i + 4]; const float keep = hi ? d8[i + 4] : d8[i]; d4[i] = keep + __shfl_xor(send, 16, 64); }
      }
      {
        const bool hi = (lane & 8) != 0;
#pragma unroll
        for (int i = 0; i < 2; i++) { const float send = hi ? d4[i] : d4[i + 2]; const float keep = hi ? d4[i + 2] : d4[i]; d2[i] = keep + __shfl_xor(send, 8, 64); }
      }
      {
        const bool hi = (lane & 4) != 0;
        const float send = hi ? d2[0] : d2[1];
        const float keep = hi ? d2[1] : d2[0];
        d1 = keep + __shfl_xor(send, 4, 64);
      }
      d1 += __shfl_xor(d1, 2, 64);
      d1 += __shfl_xor(d1, 1, 64);
      const float wl = gv * gelu_tanh((d1 + qhalf) * us);
#pragma unroll
      for (int e = 0; e < 16; e++) {
        const float w = __builtin_bit_cast(float, __builtin_amdgcn_readlane(__builtin_bit_cast(int, wl), ((e >> 3) & 1) * 32 + ((e >> 2) & 1) * 16 + ((e >> 1) & 1) * 8 + (e & 1) * 4));
        const f16x2_t w2 = __builtin_bit_cast(f16x2_t, pack_h2(w, w));
        const unsigned vw[2] = {vv[e].x, vv[e].y};
#pragma unroll
        for (int k = 0; k < 2; k++) {
          const unsigned w4 = vw[k];
          const unsigned le = __builtin_amdgcn_perm(V4_LUT_HI, V4_LUT_LO, w4 & 0x07070707u);
          const unsigned lo = __builtin_amdgcn_perm(V4_LUT_HI, V4_LUT_LO, (w4 >> 4) & 0x07070707u);
          const unsigned ee = ((w4 << 4) & 0x80808080u) | le;
          const unsigned eo = (w4 & 0x80808080u) | lo;
          const unsigned p01 = __builtin_amdgcn_perm(eo, ee, 0x040c000cu), p23 = __builtin_amdgcn_perm(eo, ee, 0x050c010cu);
          const unsigned p45 = __builtin_amdgcn_perm(eo, ee, 0x060c020cu), p67 = __builtin_amdgcn_perm(eo, ee, 0x070c030cu);
          acc2[4 * k + 0] = __builtin_elementwise_fma(__builtin_bit_cast(f16x2_t, p01), w2, acc2[4 * k + 0]);
          acc2[4 * k + 1] = __builtin_elementwise_fma(__builtin_bit_cast(f16x2_t, p23), w2, acc2[4 * k + 1]);
          acc2[4 * k + 2] = __builtin_elementwise_fma(__builtin_bit_cast(f16x2_t, p45), w2, acc2[4 * k + 2]);
          acc2[4 * k + 3] = __builtin_elementwise_fma(__builtin_bit_cast(f16x2_t, p67), w2, acc2[4 * k + 3]);
        }
      }
#pragma unroll
      for (int e = 0; e < 16; e++) {
        const int id = __builtin_amdgcn_readlane(idn, e);
        vv[e] = *(const uint2*)(vb + (size_t)id * 512 + lane * 8);
      }
      idv = idn;
    }
    float acc[16];
#pragma unroll
    for (int i = 0; i < 8; i++) { acc[2 * i] = (float)acc2[i].x; acc[2 * i + 1] = (float)acc2[i].y; }
    float* xr = xw + (size_t)tok * DM + lane * 16;
    float xv[16];
    float ssq = 0.f;
#pragma unroll
    for (int c = 0; c < 4; c++) {
      float4 a0 = *(float4*)(xr + c * 4);
      a0.x += acc[c * 4 + 0]; a0.y += acc[c * 4 + 1]; a0.z += acc[c * 4 + 2]; a0.w += acc[c * 4 + 3];
      if (!FINAL) *(float4*)(xr + c * 4) = a0;
      xv[c * 4 + 0] = a0.x; xv[c * 4 + 1] = a0.y; xv[c * 4 + 2] = a0.z; xv[c * 4 + 3] = a0.w;
      ssq += a0.x * a0.x + a0.y * a0.y + a0.z * a0.z + a0.w * a0.w;
    }
    ssq = wsum(ssq);
    const float rstd = rsqrtf(ssq * (1.0f / DM) + EPSF);
    const float4* g4 = (const float4*)(gnext + lane * 16);
    if (FINAL) {
      float* op = outp + (size_t)tok * DM + lane * 16;
#pragma unroll
      for (int c = 0; c < 4; c++) {
        const float4 gq = g4[c];
        *(float4*)(op + c * 4) = make_float4(xv[c * 4] * rstd * gq.x, xv[c * 4 + 1] * rstd * gq.y, xv[c * 4 + 2] * rstd * gq.z, xv[c * 4 + 3] * rstd * gq.w);
      }
    } else {
      uint4 o0, o1;
      { const float4 ga = g4[0], gb = g4[1];
        o0.x = pk2(xv[0] * rstd * ga.x, xv[1] * rstd * ga.y); o0.y = pk2(xv[2] * rstd * ga.z, xv[3] * rstd * ga.w);
        o0.z = pk2(xv[4] * rstd * gb.x, xv[5] * rstd * gb.y); o0.w = pk2(xv[6] * rstd * gb.z, xv[7] * rstd * gb.w); }
      { const float4 ga = g4[2], gb = g4[3];
        o1.x = pk2(xv[8] * rstd * ga.x, xv[9] * rstd * ga.y); o1.y = pk2(xv[10] * rstd * ga.z, xv[11] * rstd * ga.w);
        o1.z = pk2(xv[12] * rstd * gb.x, xv[13] * rstd * gb.y); o1.w = pk2(xv[14] * rstd * gb.z, xv[15] * rstd * gb.w); }
      *(uint4*)(xn + (size_t)tok * DM + lane * 16) = o0;
      *(uint4*)(xn + (size_t)tok * DM + lane * 16 + 8) = o1;
    }
  }
}

__device__ __forceinline__ void prologue_transposes(const int wave_s, const Params& p, unsigned char* ws, LAS unsigned char* lds) {
  const int tid_ = opaque_tid(wave_s);
  const int lane = tid_ & 63, wave = tid_ >> 6;
  LAS float* scr = (LAS float*)(lds + wave * 16384);
  const int gw = blockIdx.x * NWAVES + wave, NGW = gridDim.x * NWAVES;
  constexpr int I_IN = (DM / 64) * (DIN / 32), I_SQ = (DM / 64) * (DM / 32), I_2K = (DM / 64) * (2048 / 32);
  constexpr int I_GL = (256 / 64) * (256 / 32);
  constexpr int PER_LAYER = I_IN + 3 * I_SQ + 2 * I_2K + I_GL;
  const float* w3 = karg_in(3); const float* w19 = karg_in(19); const float* w22 = karg_in(22);
  const float* w23 = karg_in(23); const float* w24 = karg_in(24); const float* w26 = karg_in(26);
  const float* w16 = karg_in(16);
  for (int it = gw; it < 2 * PER_LAYER; it += NGW) {
    const int l = it / PER_LAYER;
    int r = it % PER_LAYER;
    unsigned char* wl = ws + WS_WT + (size_t)l * WT_LAYER;
    if (r < I_IN) { transpose_item(w3 + (size_t)l * DM * DIN, DM, DIN, (bf16*)(wl + WT_IN), scr, r, lane); continue; } r -= I_IN;
    if (r < I_SQ) { transpose_item(w19 + (size_t)l * DM * DM, DM, DM, (bf16*)(wl + WT_OUT), scr, r, lane); continue; } r -= I_SQ;
    if (r < I_SQ) { transpose_item(w22 + (size_t)l * DM * DM, DM, DM, (bf16*)(wl + WT_MQ), scr, r, lane); continue; } r -= I_SQ;
    if (r < I_2K) { transpose_item(w23 + (size_t)l * DM * 2048, DM, 2048, (bf16*)(wl + WT_MKV), scr, r, lane); continue; } r -= I_2K;
    if (r < I_SQ) { transpose_item(w24 + (size_t)l * DM * DM, DM, DM, (bf16*)(wl + WT_MO), scr, r, lane); continue; } r -= I_SQ;
    if (r < I_2K) { transpose_item(w26 + (size_t)l * DM * 2048, DM, 2048, (bf16*)(wl + WT_PQ), scr, r, lane); continue; } r -= I_2K;
    transpose_item(w16 + (size_t)l * 256 * 256, 256, 256, (bf16*)(wl + WT_GLU), scr, r, lane);
  }
}

template <class T> __device__ __forceinline__ T* opq(T* p) { asm volatile("" : "+s"(p)); return p; }
__device__ __forceinline__ void cvt_rows_bf16(const int wave_s, const float* src, bf16* dst, size_t n) {
  const int tid_ = opaque_tid(wave_s);
  const size_t gt = (size_t)blockIdx.x * (NWAVES * 64) + tid_;
  const size_t nth = (size_t)gridDim.x * NWAVES * 64;
  for (size_t i = gt; i < n / 8; i += nth) {
    const float4 a = ((const float4*)src)[2 * i], b = ((const float4*)src)[2 * i + 1];
    uint4 o; o.x = pk2(a.x, a.y); o.y = pk2(a.z, a.w); o.z = pk2(b.x, b.y); o.w = pk2(b.z, b.w);
    ((uint4*)dst)[i] = o;
  }
}

__device__ __forceinline__ unsigned enc_e4m3(float x) {
  const _Float16 hf = (_Float16)x;
  const unsigned h = (unsigned)__builtin_bit_cast(unsigned short, hf);
  return ((h + 0x7Fu + ((h >> 8) & 1u)) >> 8) & 0xFFu;
}
__device__ __forceinline__ void cvt_rows_e4m3(const int wave_s, const float* src, unsigned char* dst, size_t n, float sc) {
  const int tid_ = opaque_tid(wave_s);
  const size_t gt = (size_t)blockIdx.x * (NWAVES * 64) + tid_;
  const size_t nth = (size_t)gridDim.x * NWAVES * 64;
  for (size_t i = gt; i < n / 16; i += nth) {
    unsigned w[4];
#pragma unroll
    for (int k = 0; k < 4; k++) {
      const float4 a = ((const float4*)src)[4 * i + k];
      w[k] = enc_e4m3(a.x * sc) | (enc_e4m3(a.y * sc) << 8) | (enc_e4m3(a.z * sc) << 16) | (enc_e4m3(a.w * sc) << 24);
    }
    uint4 o; o.x = w[0]; o.y = w[1]; o.z = w[2]; o.w = w[3];
    ((uint4*)dst)[i] = o;
  }
}

__device__ __forceinline__ unsigned enc_v4(float z) {
  const float az = fabsf(z);
  unsigned c = 0;
  c += az > 0.25f; c += az > 0.5f; c += az > 0.75f; c += az > 1.0625f; c += az > 1.375f; c += az > 1.75f; c += az > 2.25f;
  return c | ((__builtin_bit_cast(unsigned, z) >> 28) & 8u);
}
__device__ __forceinline__ void cvt_rows_i4(const int wave_s, const float* src, unsigned char* dst, float* sc_out, int nrows) {
  const int tid_ = opaque_tid(wave_s);
  const int lane = tid_ & 63;
  const int gw = blockIdx.x * NWAVES + (tid_ >> 6);
  const int nw = gridDim.x * NWAVES;
  for (int r = gw; r < nrows; r += nw) {
    const float4* sp = (const float4*)(src + (size_t)r * 1024 + lane * 16);
    const float4 a0 = sp[0], a1 = sp[1], a2 = sp[2], a3 = sp[3];
    const float xv[16] = {a0.x, a0.y, a0.z, a0.w, a1.x, a1.y, a1.z, a1.w, a2.x, a2.y, a2.z, a2.w, a3.x, a3.y, a3.z, a3.w};
    float ss = 0.f;
#pragma unroll
    for (int i = 0; i < 16; i++) ss += xv[i] * xv[i];
    ss = wsum(ss);
    const float sc = sqrtf(ss * (1.0f / 1024.f)) * U4_STEP;
    const float inv = sc > 0.f ? 1.0f / sc : 0.f;
    unsigned w[2] = {0u, 0u};
#pragma unroll
    for (int i = 0; i < 16; i++) {
      const float f = fminf(fmaxf(floorf(xv[i] * inv), -8.f), 7.f);
      w[i >> 3] |= ((unsigned)(int)f & 15u) << (4 * (i & 7));
    }
    uint2 o; o.x = w[0]; o.y = w[1];
    *(uint2*)(dst + (size_t)r * 512 + lane * 8) = o;
    if (lane == 0) sc_out[2 * r] = sc;
  }
}
__device__ __forceinline__ void cvt_rows_v4(const int wave_s, const float* src, unsigned char* dst, float* sc_out, int nrows) {
  const int tid_ = opaque_tid(wave_s);
  const int lane = tid_ & 63;
  const int gw = blockIdx.x * NWAVES + (tid_ >> 6);
  const int nw = gridDim.x * NWAVES;
  for (int r = gw; r < nrows; r += nw) {
    const float4* sp = (const float4*)(src + (size_t)r * 1024 + lane * 16);
    const float4 a0 = sp[0], a1 = sp[1], a2 = sp[2], a3 = sp[3];
    const float xv[16] = {a0.x, a0.y, a0.z, a0.w, a1.x, a1.y, a1.z, a1.w, a2.x, a2.y, a2.z, a2.w, a3.x, a3.y, a3.z, a3.w};
    float ss = 0.f;
#pragma unroll
    for (int i = 0; i < 16; i++) ss += xv[i] * xv[i];
    ss = wsum(ss);
    const float sc = sqrtf(ss * (1.0f / 1024.f)) * V4_ROWSCALE;
    const float inv = sc > 0.f ? 1.0f / sc : 0.f;
    unsigned w[2] = {0u, 0u};
#pragma unroll
    for (int i = 0; i < 16; i++) w[i >> 3] |= enc_v4(xv[i] * inv) << (4 * (i & 7));
    uint2 o; o.x = w[0]; o.y = w[1];
    *(uint2*)(dst + (size_t)r * 512 + lane * 8) = o;
    if (lane == 0) sc_out[2 * r] = sc;
  }
}

#define GEMM_F32(Aptr, Wt, Cptr, Rptr, M_, N_) do { \
    pg8::Gemm g_{opq((const bf16*)(Aptr)), opq((const bf16*)(Wt)), (M_), (N_), DM}; pg8::StaticOrder S_; S_.init((M_), (N_), (int)gridDim.x, (int)blockIdx.x); \
    pg8::EpiF32R E_{opq((float*)(Cptr)), opq((const float*)(Rptr)), (N_)}; \
    pg8::gemm_phase<pg8::EpiF32R, pg8::StaticOrder, true, true>(wave_s, ldsl, g_, S_, E_); } while (0)
#define GEMM_BF16_C(Aptr, Wt, Optr, M_, N_, C_) do { \
    pg8::Gemm g_{opq((const bf16*)(Aptr)), opq((const bf16*)(Wt)), (M_), (N_), DM}; pg8::StaticOrder S_; S_.init((M_), (N_), (int)gridDim.x, (C_)); \
    pg8::EpiBf16 E_{opq((bf16*)(Optr)), (N_)}; \
    pg8::gemm_phase<pg8::EpiBf16, pg8::StaticOrder, true, true>(wave_s, ldsl, g_, S_, E_); } while (0)
#define GEMM_BF16(Aptr, Wt, Optr, M_, N_) GEMM_BF16_C(Aptr, Wt, Optr, M_, N_, (int)blockIdx.x)
#define GEMM_F32RN(Aptr, Wt, Cptr, Rptr, XGptr, Gptr, STptr) do { \
    pg8::Gemm g_{opq((const bf16*)(Aptr)), opq((const bf16*)(Wt)), NT, DM, DM}; pg8::StaticOrder S_; S_.init(NT, DM, (int)gridDim.x, (int)blockIdx.x); \
    pg8::EpiF32RN E_{opq((float*)(Cptr)), opq((const float*)(Rptr)), DM, opq((bf16*)(XGptr)), opq((const float*)(Gptr)), opq((float*)(STptr))}; \
    pg8::gemm_phase<pg8::EpiF32RN, pg8::StaticOrder, true, true>(wave_s, ldsl, g_, S_, E_); } while (0)
#define GEMM_BF16S(Aptr, Wt, Optr, N_, STptr) do { \
    pg8::Gemm g_{opq((const bf16*)(Aptr)), opq((const bf16*)(Wt)), NT, (N_), DM}; pg8::StaticOrder S_; S_.init(NT, (N_), (int)gridDim.x, (int)blockIdx.x); \
    pg8::EpiBf16S E_{opq((bf16*)(Optr)), (N_), opq((const float*)(STptr))}; \
    pg8::gemm_phase<pg8::EpiBf16S, pg8::StaticOrder, true, true>(wave_s, ldsl, g_, S_, E_); } while (0)

__global__ void __launch_bounds__(NWAVES * 64, 2) fwd_megakernel(Params p) {
  extern __shared__ __attribute__((aligned(16))) unsigned char lds[];
  LAS unsigned char* ldsl = (LAS unsigned char*)lds;
  LAS float* smem = (LAS float*)ldsl;
  const int wave_s = __builtin_amdgcn_readfirstlane((int)(threadIdx.x >> 6));
  unsigned char* ws = p.ws;
  volatile LAS unsigned* MISC = (volatile LAS unsigned*)(ldsl + (LDS_BYTES - 256));
  if (threadIdx.x < 64) MISC[threadIdx.x] = 0u;
  __syncthreads();
  const XcdBarrier bar = xcd_barrier_post((unsigned*)(ws + WS_CTL) + 4096, MISC + 8);
  float* xw = (float*)(ws + WS_XW);
  bf16* xn = (bf16*)(ws + WS_XN);
  bf16* big = (bf16*)(ws + WS_BIG);
  bf16* y = (bf16*)(ws + WS_Y);
  bf16* memh = (bf16*)(ws + WS_MEMH);
  bf16* kvb = (bf16*)(ws + WS_KVB);
  bf16* vT = (bf16*)(ws + WS_VT);
  float* ssmE = (float*)(ws + WS_SSME);
  float* ssmp = (float*)(ws + WS_SSMP);
  int* ids = (int*)(ws + WS_IDS);
  float* gates = (float*)(ws + WS_GATE);
  bf16* skb = (bf16*)(ws + WS_SKB);
  unsigned char* ub = ws + WS_UB;
  unsigned char* vb = ws + WS_VB;
  float* rst = (float*)(ws + WS_RST);
  float* vsc = (float*)(ws + WS_VSC);
  float* usc = (float*)(ws + WS_USC);

  prologue_transposes(wave_s, p, ws, ldsl);
  cvt_rows_bf16(wave_s, karg_in(27), skb, (size_t)2 * 8 * 2 * 128 * 128);
  cvt_rows_i4(wave_s, karg_in(28), ub, vsc + 1, 2 * 16384);
  cvt_rows_v4(wave_s, karg_in(29), vb, vsc, 2 * 16384);
  for (int l = 0; l < 2; l++)
    rms_rows<true>(wave_s, karg_in(1), karg_in(21) + l * DM, memh + (size_t)l * 1024 * 1024, 1024);
  ssm_params(wave_s, p, ssmp);
  rms_rows<true>(wave_s, karg_in(0), karg_in(2), xn, NT);
  xcd_barrier(bar);
  for (int l = 0; l < 2; l++)
    GEMM_BF16_C(memh + (size_t)l * 1024 * 1024, ws + WS_WT + (size_t)l * WT_LAYER + WT_MKV,
              kvb + (size_t)l * 1024 * 2048, 1024, 2048, (int)((blockIdx.x + gridDim.x - 64u - 32u * (unsigned)l) % gridDim.x));

#pragma nounroll
  for (int l = 0; l < 2; l++) {
    const float* xcur = (l == 0) ? karg_in(0) : xw;
    const float* sp = ssmp + (size_t)l * SSMP_PER_LAYER;
    const unsigned char* wl = ws + WS_WT + (size_t)l * WT_LAYER;
    GEMM_BF16(xn, wl + WT_IN, big, NT, DIN);
    xcd_barrier(bar);
    if (l == 0) vt_phase(wave_s, kvb, vT);
    ssm_chunk_end(wave_s, sp, big, ssmE, smem);
    attn_phase(wave_s, p, l, big, y, smem);
    conv_phase(wave_s, p, l, big, y, smem);
    xcd_barrier(bar);
    ssm_finish(wave_s, p, l, sp, big, ssmE, y, smem);
    xcd_barrier(bar);
    GEMM_F32RN(y, wl + WT_OUT, xw, xcur, xn, karg_in(20) + l * DM, rst);
    xcd_barrier(bar);
    GEMM_BF16S(xn, wl + WT_MQ, big, DM, rst);
    xcd_barrier(bar);
    memattn_phase(wave_s, big, kvb + (size_t)l * 1024 * 2048, vT + (size_t)l * 4 * 4 * 256 * 256, y, smem);
    xcd_barrier(bar);
    GEMM_F32RN(y, wl + WT_MO, xw, (const float*)xw, xn, karg_in(25) + l * DM, rst);
    xcd_barrier(bar);
    GEMM_BF16S(xn, wl + WT_PQ, big, 2048, rst);
    xcd_barrier(bar);
    peer_topk(wave_s, big, skb + (size_t)l * 8 * 2 * 128 * 128, ids, gates, smem);
    xcd_barrier(bar);
    if (l == 0) {
      peer_gather<false>(wave_s, xn, rst, ub + (size_t)l * 16384 * 512, vb + (size_t)l * 16384 * 512, vsc + (size_t)l * 2 * 16384, usc, ids, gates, xw, karg_in(2) + DM, (float*)nullptr);
      xcd_barrier(bar);
    } else {
      peer_gather<true>(wave_s, xn, rst, ub + (size_t)l * 16384 * 512, vb + (size_t)l * 16384 * 512, vsc + (size_t)l * 2 * 16384, usc, ids, gates, xw, karg_in(30), p.out);
    }
  }
}

extern "C" void kernel_launch(void* const* d_in, const int* in_sizes, int n_in,
                              void* d_out, int out_size, void* d_ws, size_t ws_size,
                              hipStream_t stream) {
  static int grid_blocks = 0;
  if (!grid_blocks) {
    int dev = 0, cus = 0, per_cu = 0;
    (void)hipGetDevice(&dev);
    (void)hipDeviceGetAttribute(&cus, hipDeviceAttributeMultiprocessorCount, dev);
    (void)hipFuncSetAttribute((const void*)fwd_megakernel, hipFuncAttributeMaxDynamicSharedMemorySize, LDS_BYTES);
    (void)hipOccupancyMaxActiveBlocksPerMultiprocessor(&per_cu, fwd_megakernel, NWAVES * 64, LDS_BYTES);
    if (per_cu < 1) fprintf(stderr, "occupancy query reports %d blocks/CU\n", per_cu);
    grid_blocks = cus;
  }
  (void)hipMemsetAsync((char*)d_ws + WS_CTL, 0, 65536, stream);
  Params p{};
  for (int i = 0; i < 31; i++) p.in[i] = (const float*)d_in[i];
  p.out = (float*)d_out;
  p.ws = (unsigned char*)d_ws;
  void* args[] = {&p};
  hipError_t e = hipLaunchCooperativeKernel((void*)fwd_megakernel, dim3(grid_blocks), dim3(NWAVES * 64),
                                            args, LDS_BYTES, stream);
  if (e != hipSuccess)
    fprintf(stderr, "cooperative launch failed: %s (grid %d)\n", hipGetErrorString(e), grid_blocks);
}
```

```cpp
#include <hip/hip_runtime.h>
#include <hip/hip_cooperative_groups.h>
#include <cstdio>
namespace cg = cooperative_groups;

#define NT 16384
#define SEQ 4096
#define DM 1024
#define DIN 2304
#define NMEM 256
#define EPSF 1e-6f
#define NWAVES 8
#define LDS_BYTES 147456

typedef unsigned short bf16;
#define LAS __attribute__((address_space(3)))

struct Params {
  const float* in[31];
  float* out;
  unsigned char* ws;
};
typedef __attribute__((address_space(4))) const unsigned char* kaptr_t;
__device__ __forceinline__ const float* karg_in(int i) {
  kaptr_t ka = (kaptr_t)__builtin_amdgcn_kernarg_segment_ptr();
  asm volatile("" : "+s"(ka));
  return *(const float* __attribute__((address_space(4))) const*)(ka + 8 * i);
}

constexpr size_t MiB = 1u << 20;
constexpr size_t WS_CTL  = 0;
constexpr size_t WS_WT   = 1 * MiB;
constexpr size_t WT_IN = 0, WT_OUT = WT_IN + (size_t)DIN * DM * 2, WT_MQ = WT_OUT + (size_t)DM * DM * 2,
                 WT_MKV = WT_MQ + (size_t)DM * DM * 2, WT_MO = WT_MKV + (size_t)2048 * DM * 2,
                 WT_PQ = WT_MO + (size_t)DM * DM * 2, WT_GLU = WT_PQ + (size_t)2048 * DM * 2, WT_LAYER = WT_GLU + (size_t)256 * 256 * 2;
constexpr size_t WS_XW   = WS_WT + 2 * WT_LAYER;
constexpr size_t WS_XN   = WS_XW + (size_t)NT * DM * 4;
constexpr size_t WS_BIG  = WS_XN + (size_t)NT * DM * 2;
constexpr size_t WS_Y    = WS_BIG + (size_t)NT * DIN * 2;
constexpr size_t WS_MEMH = WS_Y + (size_t)NT * DM * 2;
constexpr size_t WS_KVB  = WS_MEMH + (size_t)2 * 1024 * 1024 * 2;
constexpr size_t WS_VT   = WS_KVB + (size_t)2 * 1024 * 2048 * 2;
constexpr size_t WS_SSME = WS_VT + (size_t)2 * 4 * 4 * 256 * 256 * 2;
#define SSMP_PER_LAYER (2048 + 2048 + 32768)
constexpr size_t WS_SSMP = WS_SSME + (size_t)4 * 64 * 16 * 64 * 2 * 4;
constexpr size_t WS_IDS  = WS_SSMP + (size_t)2 * SSMP_PER_LAYER * 4;
constexpr size_t WS_GATE = WS_IDS + (size_t)NT * 128 * 4;
constexpr size_t WS_SKB  = WS_GATE + (size_t)NT * 128 * 4;
constexpr size_t WS_UB   = WS_SKB + (size_t)2 * 8 * 2 * 128 * 128 * 2;
constexpr size_t WS_VB   = WS_UB + (size_t)2 * 16384 * 512;
constexpr size_t WS_VSC  = WS_VB + (size_t)2 * 16384 * 512;
constexpr size_t WS_USC  = WS_VSC + (size_t)2 * 16384 * 4;
constexpr size_t WS_RST  = WS_USC + (size_t)2 * 16384 * 4;
constexpr size_t WS_END  = WS_RST + (size_t)NT * 16 * 4;
#define U_SCALE 64.0f
#define U4_STEP 0.3352f
#define V4_LUT_LO 0x3B393630u
#define V4_LUT_HI 0x41403E3Du
#define V4_ROWSCALE 1.075f
static_assert(WS_END <= 512 * MiB, "workspace");
static_assert(WT_LAYER % 256 == 0 && WS_SSMP % 16 == 0 && WS_IDS % 16 == 0 && WS_SKB % 256 == 0 && WS_VT % 256 == 0, "align");

__device__ __forceinline__ int opaque_tid(int wave_s) { int v = wave_s * 64 + (int)__builtin_amdgcn_mbcnt_hi(~0u, __builtin_amdgcn_mbcnt_lo(~0u, 0u)); asm volatile("" : "+v"(v)); return v; }
typedef __bf16 bf16n2_t __attribute__((ext_vector_type(2)));
typedef float f32n2_t __attribute__((ext_vector_type(2)));
__device__ __forceinline__ unsigned pk2(float lo, float hi) { f32n2_t v; v[0] = lo; v[1] = hi; return __builtin_bit_cast(unsigned, __builtin_convertvector(v, bf16n2_t)); }
__device__ __forceinline__ unsigned f2bf(float f) { return (unsigned)__builtin_bit_cast(unsigned short, (__bf16)f); }
__device__ __forceinline__ float bf_lo(unsigned u) { return __builtin_bit_cast(float, u << 16); }
__device__ __forceinline__ float bf_hi(unsigned u) { return __builtin_bit_cast(float, u & 0xffff0000u); }
__device__ __forceinline__ float bf2f(bf16 h) { return __builtin_bit_cast(float, (unsigned)h << 16); }


#define XB_TMO      128
#define XB_XCNT(j)  (256  + 64 * (j))
#define XB_XSUB(j)  (1280 + 64 * (j))
#define XB_XGEN(j)  (2304 + 64 * (j))
#define XB_TOP      3328
#define XB_TOPGEN   3392
#define XCD_BAR_WORDS 3456
#define XB_SPIN_CAP (1u << 22)
__device__ __forceinline__ unsigned xb_ld(unsigned* p)              { return __hip_atomic_load(p, __ATOMIC_RELAXED, __HIP_MEMORY_SCOPE_AGENT); }
__device__ __forceinline__ unsigned xb_add(unsigned* p, unsigned v) { return __hip_atomic_fetch_add(p, v, __ATOMIC_RELAXED, __HIP_MEMORY_SCOPE_AGENT); }
__device__ __forceinline__ unsigned xb_xcc_id() { return (unsigned)__builtin_amdgcn_s_getreg((3 << 11) | 20) & 0xFu; }
#define XB_SPIN(cond, bar) do { unsigned _sp = 0; while (cond) { __builtin_amdgcn_s_sleep(1); \
    if ((++_sp & 255u) == 0u) { if (xb_ld(&(bar)[XB_TMO])) break; if (_sp > XB_SPIN_CAP) { atomicAdd(&(bar)[XB_TMO], 1u); break; } } } } while (0)
struct XcdBarrier { unsigned* bar; unsigned x; volatile LAS unsigned* st; };
__device__ __forceinline__ XcdBarrier xcd_barrier_post(unsigned* bar, volatile LAS unsigned* st) {
    XcdBarrier b; b.bar = bar; b.x = xb_xcc_id(); b.st = st;
    if (threadIdx.x == 0) (void)xb_add(&bar[XB_XCNT(b.x)], 1u);
    return b;
}
__device__ __forceinline__ void xcd_barrier_complete(unsigned* bar, unsigned x, unsigned& nloc, unsigned& nx) {
    const unsigned G = gridDim.x * gridDim.y * gridDim.z;
    unsigned sum, cnt, mine, sp = 0u;
    for (;;) {
        sum = 0u; cnt = 0u; mine = 0u;
#pragma unroll
        for (unsigned j = 0; j < 16; ++j) { const unsigned c = xb_ld(&bar[XB_XCNT(j)]); sum += c; cnt += (c > 0u) ? 1u : 0u; mine = (j == x) ? c : mine; }
        if (sum == G) break;
        __builtin_amdgcn_s_sleep(1);
        if ((++sp & 255u) == 0u) { if (xb_ld(&bar[XB_TMO])) break; if (sp > XB_SPIN_CAP) { atomicAdd(&bar[XB_TMO], 1u); break; } }
    }
    nloc = mine > 0u ? mine : 1u; nx = cnt > 0u ? cnt : 1u;
}
__device__ __forceinline__ void xcd_barrier(const XcdBarrier& b) {
    asm volatile("s_waitcnt vmcnt(0)" ::: "memory");
    __syncthreads();
    if (threadIdx.x == 0) {
        unsigned* bar = b.bar;
        __builtin_amdgcn_s_waitcnt(0);
        unsigned nloc = b.st[0], nx = b.st[1];
        if (nloc == 0u) { xcd_barrier_complete(bar, b.x, nloc, nx); b.st[0] = nloc; b.st[1] = nx; }
        const unsigned old = xb_add(&bar[XB_XSUB(b.x)], 1u);
        const unsigned gen = old / nloc;
        if (old + 1u == (gen + 1u) * nloc) {
            __builtin_amdgcn_fence(__ATOMIC_RELEASE, "agent");
            asm volatile("s_waitcnt vmcnt(0)" ::: "memory");
            const unsigned og = xb_add(&bar[XB_TOP], 1u);
            const unsigned tg = og / nx;
            if (og + 1u == (tg + 1u) * nx) xb_add(&bar[XB_TOPGEN], 1u);
            else XB_SPIN(xb_ld(&bar[XB_TOPGEN]) == tg, bar);
            __builtin_amdgcn_fence(__ATOMIC_ACQUIRE, "agent");
            xb_add(&bar[XB_XGEN(b.x)], 1u);
            asm volatile("s_waitcnt vmcnt(0)" ::: "memory");
        } else {
            XB_SPIN(xb_ld(&bar[XB_XGEN(b.x)]) == gen, bar);
            __builtin_amdgcn_fence(__ATOMIC_ACQUIRE, "agent");
            asm volatile("s_waitcnt vmcnt(0)" ::: "memory");
        }
    }
    __syncthreads();
}

namespace pg8 {
#define PG8_LAS __attribute__((address_space(3)))
typedef unsigned short bf16_t;
typedef short bf16x8 __attribute__((ext_vector_type(8)));
typedef float f32x4 __attribute__((ext_vector_type(4)));
typedef unsigned u32x4 __attribute__((ext_vector_type(4)));
constexpr int BM = 256, BK = 64, HALF = 128, HTB = HALF * BK * 2, STAGE_BYTES = 8 * HTB, NXCD = 8, WGM = 8;
__host__ __device__ __forceinline__ int lds_byte(int r, int c) { const int st = (r >> 4) * 2 + (c >> 5), rr = r & 15, cc = c & 31, ob = rr * 64 + cc * 2; return st * 1024 + (ob ^ (((ob >> 9) & 1) << 5)); }
__host__ __device__ __forceinline__ void stage_rc(int b, int& R, int& C) { const int st = b / 1024, sb = b % 1024, swz = sb ^ (((sb >> 9) & 1) << 5); R = (st >> 1) * 16 + swz / 64; C = (st & 1) * 32 + (swz % 64) / 2; }
__host__ __device__ __forceinline__ int perm32(int rho) { const int n = rho >> 4, i = rho & 15; return 8 * (i >> 2) + 4 * n + (i & 3); }
struct Unit { int pm, pn; };
struct Gemm { const bf16_t* A; const bf16_t* Bt; int M, N, K; };
struct StaticOrder {
    int nM, nN, nwg, G, c;
    __host__ __device__ __forceinline__ void init(int M, int N, int G_, int c_) { nM = M / BM; nN = N / BM; nwg = nM * nN; G = G_; c = c_; }
    __host__ __device__ bool next(int i, Unit& u) const {
        const long L = (long)i * G + c; if (L >= nwg) return false;
        int wgid = (int)L; { const int q = nwg / NXCD, r = nwg % NXCD, xcd = wgid % NXCD, off = wgid / NXCD; wgid = (xcd < r ? xcd * (q + 1) : r * (q + 1) + (xcd - r) * q) + off; }
        const int nig = WGM * nN, gid = wgid / nig, fm = gid * WGM, gsz = (nM - fm) < WGM ? (nM - fm) : WGM;
        u.pm = fm + ((wgid % nig) % gsz); u.pn = (wgid % nig) / gsz; return true;
    }
    __device__ __forceinline__ void a_ready(const Unit&) const {}
    __device__ __forceinline__ void done(const Unit&) const {}
};
__device__ __forceinline__ unsigned cvt_pk_bf16(float lo, float hi) { unsigned r; asm volatile("v_cvt_pk_bf16_f32 %0, %1, %2" : "=v"(r) : "v"(lo), "v"(hi)); return r; }

struct EpiF32R {
    static constexpr bool PERM = false, AFTER_DRAIN = false;
    float* C; const float* R; int ldc;
    __device__ __forceinline__ void operator()(const f32x4 (&acc)[2][2][4][2], const Unit& u, int wr, int wc, int fr, int fq) const {
        const int row0 = u.pm * BM + wr * 64 + fr, col0 = u.pn * BM + wc * 32 + 4 * fq;
#pragma unroll
        for (int ai = 0; ai < 2; ++ai)
#pragma unroll
            for (int m = 0; m < 4; ++m) {
                const size_t ro = (size_t)(row0 + ai * HALF + m * 16) * ldc + col0;
                f32x4 rv[2][2];
#pragma unroll
                for (int bj = 0; bj < 2; ++bj)
#pragma unroll
                    for (int n = 0; n < 2; ++n) rv[bj][n] = R ? *(const f32x4*)(R + ro + bj * HALF + n * 16) : (f32x4){0.f, 0.f, 0.f, 0.f};
#pragma unroll
                for (int bj = 0; bj < 2; ++bj)
#pragma unroll
                    for (int n = 0; n < 2; ++n) *(f32x4*)(C + ro + bj * HALF + n * 16) = acc[ai][bj][m][n] + rv[bj][n];
                __builtin_amdgcn_sched_barrier(0);
            }
    }
};

struct EpiBf16 {
    static constexpr bool PERM = true, AFTER_DRAIN = false;
    bf16_t* O; int ldc;
    __device__ __forceinline__ void operator()(const f32x4 (&acc)[2][2][4][2], const Unit& u, int wr, int wc, int fr, int fq) const {
        const int row0 = u.pm * BM + wr * 64 + fr, col0 = u.pn * BM + wc * 32 + 8 * fq;
#pragma unroll
        for (int ai = 0; ai < 2; ++ai)
#pragma unroll
            for (int m = 0; m < 4; ++m) { bf16_t* rowp = O + (size_t)(row0 + ai * HALF + m * 16) * ldc + col0;
#pragma unroll
                for (int bj = 0; bj < 2; ++bj) { const f32x4 v0 = acc[ai][bj][m][0], v1 = acc[ai][bj][m][1];
                    u32x4 w; w.x = cvt_pk_bf16(v0[0], v0[1]); w.y = cvt_pk_bf16(v0[2], v0[3]); w.z = cvt_pk_bf16(v1[0], v1[1]); w.w = cvt_pk_bf16(v1[2], v1[3]);
                    *(u32x4*)(rowp + bj * HALF) = w; } }
    }
};

struct EpiF32RN {
    static constexpr bool PERM = false, AFTER_DRAIN = false;
    float* C; const float* R; int ldc; bf16_t* XG; const float* g; float* st;
    __device__ __forceinline__ void operator()(const f32x4 (&acc)[2][2][4][2], const Unit& u, int wr, int wc, int fr, int fq) const {
        const int row0 = u.pm * BM + wr * 64 + fr, col0 = u.pn * BM + wc * 32 + 4 * fq;
        f32x4 gv[2][2];
#pragma unroll
        for (int bj = 0; bj < 2; ++bj)
#pragma unroll
            for (int n = 0; n < 2; ++n) gv[bj][n] = *(const f32x4*)(g + col0 + bj * HALF + n * 16);
#pragma unroll
        for (int ai = 0; ai < 2; ++ai)
#pragma unroll
            for (int m = 0; m < 4; ++m) {
                const int row = row0 + ai * HALF + m * 16;
                const size_t ro = (size_t)row * ldc + col0;
                f32x4 rv[2][2];
#pragma unroll
                for (int bj = 0; bj < 2; ++bj)
#pragma unroll
                    for (int n = 0; n < 2; ++n) rv[bj][n] = *(const f32x4*)(R + ro + bj * HALF + n * 16);
                float ss = 0.f;
#pragma unroll
                for (int bj = 0; bj < 2; ++bj)
#pragma unroll
                    for (int n = 0; n < 2; ++n) {
                        const f32x4 v = acc[ai][bj][m][n] + rv[bj][n];
                        *(f32x4*)(C + ro + bj * HALF + n * 16) = v;
                        ss += (v[0] * v[0] + v[1] * v[1]) + (v[2] * v[2] + v[3] * v[3]);
                        const f32x4 w = v * gv[bj][n];
                        uint2 pk; pk.x = cvt_pk_bf16(w[0], w[1]); pk.y = cvt_pk_bf16(w[2], w[3]);
                        *(uint2*)(XG + ro + bj * HALF + n * 16) = pk;
                    }
                ss += __shfl_xor(ss, 16, 64); ss += __shfl_xor(ss, 32, 64);
                if (fq == 0) st[(size_t)row * 16 + u.pn * 4 + wc] = ss;
                __builtin_amdgcn_sched_barrier(0);
            }
    }
};
struct EpiBf16S {
    static constexpr bool PERM = true, AFTER_DRAIN = false;
    bf16_t* O; int ldc; const float* st;
    __device__ __forceinline__ void operator()(const f32x4 (&acc)[2][2][4][2], const Unit& u, int wr, int wc, int fr, int fq) const {
        const int row0 = u.pm * BM + wr * 64 + fr, col0 = u.pn * BM + wc * 32 + 8 * fq;
#pragma unroll
        for (int ai = 0; ai < 2; ++ai)
#pragma unroll
            for (int m = 0; m < 4; ++m) {
                const int row = row0 + ai * HALF + m * 16;
                const f32x4* sp = (const f32x4*)(st + (size_t)row * 16);
                const f32x4 s0 = sp[0], s1 = sp[1], s2 = sp[2], s3 = sp[3];
                const f32x4 sa = (s0 + s1) + (s2 + s3);
                const float rs = __builtin_amdgcn_rsqf(((sa[0] + sa[1]) + (sa[2] + sa[3])) * (1.0f / 1024.f) + 1e-6f);
                bf16_t* rowp = O + (size_t)row * ldc + col0;
#pragma unroll
                for (int bj = 0; bj < 2; ++bj) { const f32x4 v0 = acc[ai][bj][m][0] * rs, v1 = acc[ai][bj][m][1] * rs;
                    u32x4 w; w.x = cvt_pk_bf16(v0[0], v0[1]); w.y = cvt_pk_bf16(v0[2], v0[3]); w.z = cvt_pk_bf16(v1[0], v1[1]); w.w = cvt_pk_bf16(v1[2], v1[3]);
                    *(u32x4*)(rowp + bj * HALF) = w; }
                __builtin_amdgcn_sched_barrier(0);
            }
    }
};

template <class Epi, class Sched, bool ALIGN_EPI = false, bool SP2 = false>
__device__ __forceinline__ void gemm_phase(const int wave_s, PG8_LAS unsigned char* lds, const Gemm g, const Sched& S, const Epi& E) {
    const int tid = opaque_tid(wave_s), wid = __builtin_amdgcn_readfirstlane(tid >> 6), lane = tid & 63, wr = wid >> 2, wc = wid & 3, fr = lane & 15, fq = lane >> 4;
    const int K = g.K, nt = K / BK;
    unsigned voffA[2], voffB[2];
#pragma unroll
    for (int i = 0; i < 2; ++i) { int R, C; stage_rc(tid * 16 + i * 8192, R, C); const int Rb = Epi::PERM ? ((R & ~31) + perm32(R & 31)) : R;
        voffA[i] = (unsigned)(R * K + C) * 2u; voffB[i] = (unsigned)(Rb * K + C) * 2u; }
    const size_t kstep = (size_t)(BK * 2);
    const size_t hstep = (size_t)HALF * K * 2;
    const size_t tstep = 2 * hstep;
    const unsigned ldsw = (unsigned)wid * 1024u;
    const int aoff = lds_byte(wr * 64 + fr, fq * 8), boff = lds_byte(wc * 32 + fr, fq * 8);
#define PG8_SA(b, h) (((b) * 2 + (h)) * HTB)
#define PG8_SB(b, h) ((4 + (b) * 2 + (h)) * HTB)
#define PG8_STAGE(bufoff, gbase, voff) do { _Pragma("unroll") for (int _i = 0; _i < 2; ++_i) \
        __builtin_amdgcn_global_load_lds((const unsigned*)((const char*)(gbase) + (voff)[_i]), (PG8_LAS unsigned*)(lds + (bufoff) + ldsw + _i * 8192), 16, 0, 0); } while (0)
#define PG8_LDA(dst, b, h) do { _Pragma("unroll") for (int m = 0; m < 4; ++m) _Pragma("unroll") for (int k = 0; k < 2; ++k) dst[m][k] = *(const PG8_LAS bf16x8*)(lds + PG8_SA(b, h) + aoff + m * 2048 + k * 1024); } while (0)
#define PG8_LDB(dst, b, h) do { _Pragma("unroll") for (int n = 0; n < 2; ++n) _Pragma("unroll") for (int k = 0; k < 2; ++k) dst[n][k] = *(const PG8_LAS bf16x8*)(lds + PG8_SB(b, h) + boff + n * 2048 + k * 1024); } while (0)
#define PG8_MMA(ai, bj, At, Bt) do { __builtin_amdgcn_s_setprio(1); _Pragma("unroll") for (int m = 0; m < 4; ++m) _Pragma("unroll") for (int n = 0; n < 2; ++n) _Pragma("unroll") for (int k = 0; k < 2; ++k) \
        acc[ai][bj][m][n] = __builtin_amdgcn_mfma_f32_16x16x32_bf16(Bt[n][k], At[m][k], acc[ai][bj][m][n], 0, 0, 0); __builtin_amdgcn_s_setprio(0); } while (0)
#define PG8_WAIT_V(n) asm volatile("s_waitcnt vmcnt(" #n ")" ::: "memory")
#define PG8_WAIT_L(n) asm volatile("s_waitcnt lgkmcnt(" #n ")" ::: "memory")
#define PG8_BAR __builtin_amdgcn_s_barrier()
#define PG8_SCHED __builtin_amdgcn_sched_barrier(0)
    Unit cur, nxt; int ui = 0;
    if (!S.next(0, cur)) return;
    f32x4 acc[2][2][4][2];
#pragma unroll
    for (int a = 0; a < 2; ++a)
#pragma unroll
        for (int b = 0; b < 2; ++b)
#pragma unroll
            for (int m = 0; m < 4; ++m)
#pragma unroll
                for (int n = 0; n < 2; ++n) acc[a][b][m][n] = (f32x4){0.f, 0.f, 0.f, 0.f};
    bf16x8 At[4][2], B0[2][2], B1[2][2];
    const char* cA = (const char*)g.A + (size_t)cur.pm * tstep; const char* cB = (const char*)g.Bt + (size_t)cur.pn * tstep;
    S.a_ready(cur);
    if constexpr (SP2) {
        PG8_STAGE(PG8_SB(0, 0), cB, voffB); PG8_STAGE(PG8_SB(0, 1), cB + hstep, voffB); PG8_STAGE(PG8_SA(0, 0), cA, voffA); PG8_STAGE(PG8_SA(0, 1), cA + hstep, voffA);
        if (wr == 1) PG8_BAR;
        PG8_WAIT_V(2); PG8_BAR;
        PG8_STAGE(PG8_SB(1, 0), cB + kstep, voffB); PG8_STAGE(PG8_SA(1, 0), cA + kstep, voffA); PG8_STAGE(PG8_SB(1, 1), cB + hstep + kstep, voffB);
        PG8_WAIT_V(6); PG8_BAR;
    } else {
        PG8_STAGE(PG8_SB(0, 0), cB, voffB); PG8_STAGE(PG8_SA(0, 0), cA, voffA); PG8_STAGE(PG8_SB(0, 1), cB + hstep, voffB); PG8_STAGE(PG8_SA(0, 1), cA + hstep, voffA);
        if (wr == 1) PG8_BAR;
        PG8_WAIT_V(4); PG8_BAR;
        PG8_STAGE(PG8_SB(1, 0), cB + kstep, voffB); PG8_STAGE(PG8_SA(1, 0), cA + kstep, voffA); PG8_STAGE(PG8_SB(1, 1), cB + hstep + kstep, voffB);
        PG8_WAIT_V(6); PG8_BAR;
    }
    for (;;) {
        const bool has_next = S.next(ui + 1, nxt);
        const char* nA = has_next ? (const char*)g.A + (size_t)nxt.pm * tstep : cA; const char* nB = has_next ? (const char*)g.Bt + (size_t)nxt.pn * tstep : cB;
        for (int t = 0; t < nt; t += 2) {
            const bool last = (t == nt - 2);
            const char* a1 = cA + (size_t)(t + 1) * kstep;
            const char* a2 = last ? nA : cA + (size_t)(t + 2) * kstep; const char* b2 = last ? nB : cB + (size_t)(t + 2) * kstep;
            const char* a3 = a2 + kstep; const char* b3 = b2 + kstep;
            if (last && has_next) S.a_ready(nxt);
            if constexpr (SP2) {
            PG8_LDB(B0, 0, 0); PG8_LDB(B1, 0, 1); PG8_SCHED; PG8_LDA(At, 0, 0); PG8_STAGE(PG8_SA(1, 1), a1 + hstep, voffA);
            PG8_WAIT_V(8); PG8_WAIT_L(0); PG8_BAR; PG8_MMA(0, 0, At, B0); PG8_MMA(0, 1, At, B1); PG8_BAR; PG8_SCHED;
            PG8_LDA(At, 0, 1); PG8_STAGE(PG8_SB(0, 0), b2, voffB); PG8_STAGE(PG8_SB(0, 1), b2 + hstep, voffB); PG8_STAGE(PG8_SA(0, 0), a2, voffA);
            PG8_WAIT_V(8); PG8_WAIT_L(0); PG8_BAR; PG8_MMA(1, 0, At, B0); PG8_MMA(1, 1, At, B1); PG8_BAR; PG8_SCHED;
            PG8_LDB(B0, 1, 0); PG8_LDB(B1, 1, 1); PG8_SCHED; PG8_LDA(At, 1, 0); PG8_STAGE(PG8_SA(0, 1), a2 + hstep, voffA);
            PG8_WAIT_V(8); PG8_WAIT_L(0); PG8_BAR; PG8_MMA(0, 0, At, B0); PG8_MMA(0, 1, At, B1); PG8_BAR; PG8_SCHED;
            PG8_LDA(At, 1, 1); PG8_STAGE(PG8_SB(1, 0), b3, voffB); PG8_STAGE(PG8_SB(1, 1), b3 + hstep, voffB); PG8_STAGE(PG8_SA(1, 0), a3, voffA);
            PG8_WAIT_V(8); PG8_WAIT_L(0); PG8_BAR; PG8_MMA(1, 0, At, B0); PG8_MMA(1, 1, At, B1); PG8_BAR; PG8_SCHED;
            } else {
            PG8_LDB(B0, 0, 0); PG8_SCHED; PG8_LDA(At, 0, 0); PG8_STAGE(PG8_SA(1, 1), a1 + hstep, voffA);
            PG8_WAIT_L(8); PG8_BAR; PG8_WAIT_L(0); PG8_MMA(0, 0, At, B0); PG8_BAR; PG8_SCHED;
            PG8_LDB(B1, 0, 1); PG8_STAGE(PG8_SB(0, 0), b2, voffB);
            PG8_BAR; PG8_WAIT_L(0); PG8_MMA(0, 1, At, B1); PG8_BAR;
            PG8_LDA(At, 0, 1); PG8_STAGE(PG8_SA(0, 0), a2, voffA);
            PG8_BAR; PG8_WAIT_L(0); PG8_MMA(1, 0, At, B0); PG8_BAR; PG8_SCHED;
            PG8_STAGE(PG8_SB(0, 1), b2 + hstep, voffB);
            PG8_WAIT_V(6); PG8_BAR; PG8_MMA(1, 1, At, B1); PG8_BAR;
            PG8_LDB(B0, 1, 0); PG8_SCHED; PG8_LDA(At, 1, 0); PG8_STAGE(PG8_SA(0, 1), a2 + hstep, voffA);
            PG8_WAIT_L(8); PG8_BAR; PG8_WAIT_L(0); PG8_MMA(0, 0, At, B0); PG8_BAR; PG8_SCHED;
            PG8_LDB(B1, 1, 1); PG8_STAGE(PG8_SB(1, 0), b3, voffB);
            PG8_BAR; PG8_WAIT_L(0); PG8_MMA(0, 1, At, B1); PG8_BAR;
            PG8_LDA(At, 1, 1); PG8_STAGE(PG8_SA(1, 0), a3, voffA);
            PG8_BAR; PG8_WAIT_L(0); PG8_MMA(1, 0, At, B0); PG8_BAR; PG8_SCHED;
            PG8_STAGE(PG8_SB(1, 1), b3 + hstep, voffB);
            PG8_WAIT_V(6); PG8_BAR; PG8_MMA(1, 1, At, B1); PG8_BAR;
            }
        }
        if constexpr (ALIGN_EPI) { if (wr == 0) PG8_BAR; }
        if constexpr (!Epi::AFTER_DRAIN) { E(acc, cur, wr, wc, fr, fq); S.done(cur); }
        if (!has_next) break;
#pragma unroll
        for (int a = 0; a < 2; ++a)
#pragma unroll
            for (int b = 0; b < 2; ++b)
#pragma unroll
                for (int m = 0; m < 4; ++m)
#pragma unroll
                    for (int n = 0; n < 2; ++n) acc[a][b][m][n] = (f32x4){0.f, 0.f, 0.f, 0.f};
        cur = nxt; cA = nA; cB = nB; ++ui;
        if constexpr (ALIGN_EPI) { if (wr == 1) PG8_BAR; }
    }
    PG8_WAIT_V(0);
    if constexpr (!ALIGN_EPI) { if (wr == 0) PG8_BAR; }
    PG8_BAR;
#undef PG8_SA
#undef PG8_SB
#undef PG8_STAGE
#undef PG8_LDA
#undef PG8_LDB
#undef PG8_MMA
#undef PG8_WAIT_V
#undef PG8_WAIT_L
#undef PG8_BAR
#undef PG8_SCHED
}
}

__device__ __forceinline__ void transpose_item(const float* W, int K, int N, bf16* WT, LAS float* scr, int item, int lane) {
    const int nblk = N / 32, kb = item / nblk, nb = item % nblk, k0 = 64 * kb, n0 = 32 * nb;
#pragma unroll 8
    for (int i = 0; i < 32; ++i) { const int kk = 2 * i + (lane >> 5); scr[kk * 33 + (lane & 31)] = W[(size_t)(k0 + kk) * N + n0 + (lane & 31)]; }
    asm volatile("s_waitcnt lgkmcnt(0)" ::: "memory");
    const int c = lane & 7;
#pragma unroll
    for (int j = 0; j < 4; ++j) { const int n = (lane >> 3) + 8 * j; const LAS float* s = scr + (8 * c) * 33 + n;
        uint4 o; o.x = pk2(s[0 * 33], s[1 * 33]); o.y = pk2(s[2 * 33], s[3 * 33]); o.z = pk2(s[4 * 33], s[5 * 33]); o.w = pk2(s[6 * 33], s[7 * 33]);
        *(uint4*)(WT + (size_t)(n0 + n) * K + k0 + 8 * c) = o; }
    asm volatile("s_waitcnt lgkmcnt(0)" ::: "memory");
}

__device__ __forceinline__ float wsum(float v) {
#pragma unroll
  for (int o = 32; o > 0; o >>= 1) v += __shfl_xor(v, o, 64);
  return v;
}
__device__ __forceinline__ float wmaxf(float v) {
#pragma unroll
  for (int o = 32; o > 0; o >>= 1) v = fmaxf(v, __shfl_xor(v, o, 64));
  return v;
}
__device__ __forceinline__ float sigmoidf_(float x) { return __builtin_amdgcn_rcpf(1.0f + __expf(-x)); }
__device__ __forceinline__ float gelu_tanh(float x) {
  return x * sigmoidf_(1.5957691216057308f * (x + 0.044715f * x * x * x));
}

template <bool BF16OUT>
__device__ __forceinline__ void rms_rows(const int wave_s, const float* src, const float* g, void* dstv, int rows) {
  const int tid_ = opaque_tid(wave_s);
  const int lane = tid_ & 63;
  const int gw = blockIdx.x * NWAVES + (tid_ >> 6);
  const int nw = gridDim.x * NWAVES;
  for (int r = gw; r < rows; r += nw) {
    const float4* s4 = (const float4*)(src + (size_t)r * DM);
    float4 v[4];
    float ss = 0.f;
#pragma unroll
    for (int i = 0; i < 4; i++) {
      v[i] = s4[lane + i * 64];
      ss += v[i].x * v[i].x + v[i].y * v[i].y + v[i].z * v[i].z + v[i].w * v[i].w;
    }
    ss = wsum(ss);
    const float rstd = rsqrtf(ss * (1.0f / DM) + EPSF);
    const float4* g4 = (const float4*)g;
#pragma unroll
    for (int i = 0; i < 4; i++) {
      float4 gg = g4[lane + i * 64];
      float4 o;
      o.x = v[i].x * rstd * gg.x; o.y = v[i].y * rstd * gg.y;
      o.z = v[i].z * rstd * gg.z; o.w = v[i].w * rstd * gg.w;
      if (BF16OUT) {
        uint2 pk; pk.x = pk2(o.x, o.y); pk.y = pk2(o.z, o.w);
        ((uint2*)((bf16*)dstv + (size_t)r * DM))[lane + i * 64] = pk;
      } else {
        ((float4*)((float*)dstv + (size_t)r * DM))[lane + i * 64] = o;
      }
    }
  }
}

__device__ __forceinline__ void ssm_params(const int wave_s, const Params& p, float* ssmp_all) {
  const int tid_ = opaque_tid(wave_s);
  const float* in8 = karg_in(8); const float* in9 = karg_in(9); const float* in10 = karg_in(10);
  const float* in11 = karg_in(11); const float* in12 = karg_in(12);
  const int gt = blockIdx.x * blockDim.x + tid_;
  const int nth = gridDim.x * blockDim.x;
  for (int i = gt; i < 2 * 16 * 64; i += nth) {
    const int l = i / 1024, gp = i % 1024, g = gp / 64;
    float* sp = ssmp_all + (size_t)l * SSMP_PER_LAYER;
    const float lre = fminf(in8[l * 1024 + gp], -1e-4f);
    const float lim = in9[l * 1024 + gp];
    const float dt = expf(in10[l * 16 + g]);
    const float er = expf(lre * dt);
    float sn, cs;
    sincosf(lim * dt, &sn, &cs);
    const float br = er * cs, bi = er * sn;
    sp[gp * 2 + 0] = br;
    sp[gp * 2 + 1] = bi;
    float cr = br, ci = bi;
#pragma unroll
    for (int s = 0; s < 6; s++) {
      const float nr = cr * cr - ci * ci, ni = 2.f * cr * ci;
      cr = nr; ci = ni;
    }
    sp[2048 + gp * 2 + 0] = cr;
    sp[2048 + gp * 2 + 1] = ci;
    const float nr = br - 1.0f, ni = bi;
    const float den = lre * lre + lim * lim;
    const float fr = (nr * lre + ni * lim) / den;
    const float fi = (ni * lre - nr * lim) / den;
    for (int h = 0; h < 16; h++) {
      const float bre = in11[((size_t)l * 1024 + gp) * 16 + h];
      const float bim = in12[((size_t)l * 1024 + gp) * 16 + h];
      sp[4096 + ((g * 16 + h) * 64 + (gp & 63)) * 2 + 0] = fr * bre - fi * bim;
      sp[4096 + ((g * 16 + h) * 64 + (gp & 63)) * 2 + 1] = fr * bim + fi * bre;
    }
  }
}

__device__ __forceinline__ void conv_phase(const int wave_s, const Params& p, int l, const bf16* proj, bf16* y, LAS float* smem) {
  const int tid_ = opaque_tid(wave_s);
  const int lane = tid_ & 63;
  const int gw = blockIdx.x * NWAVES + (tid_ >> 6);
  const int nw = gridDim.x * NWAVES;
  const float* cw = karg_in(4) + (size_t)l * 31 * 256;
  const float4 cb = ((const float4*)(karg_in(5) + l * 256))[lane];
  const float4 lg = ((const float4*)(karg_in(6) + l * 256))[lane];
  const float4 lb = ((const float4*)(karg_in(7) + l * 256))[lane];
  const float4 gg = ((const float4*)(karg_in(18) + l * 1024))[lane];
  LAS float* cwl = smem + 1024;
  for (int i = tid_; i < 31 * 256 / 4; i += NWAVES * 64) *(LAS pg8::f32x4*)(cwl + 4 * i) = *(const pg8::f32x4*)(cw + 4 * i);
  __syncthreads();
  for (int it = gw; it < NT / 8; it += nw) {
    const int tok0 = it * 8;
    const int t0 = tok0 & (SEQ - 1);
    float4 acc[8];
#pragma unroll
    for (int o = 0; o < 8; o++) acc[o] = cb;
#pragma unroll
    for (int i = 0; i < 38; i++) {
      if (t0 - 30 + i >= 0) {
        const bf16* row = proj + (size_t)(tok0 - 30 + i) * DIN;
        const uint2 vp = ((const uint2*)row)[lane];
        const uint2 gp = ((const uint2*)(row + 256))[lane];
        float4 g4;
        g4.x = bf_lo(vp.x) * sigmoidf_(bf_lo(gp.x)); g4.y = bf_hi(vp.x) * sigmoidf_(bf_hi(gp.x));
        g4.z = bf_lo(vp.y) * sigmoidf_(bf_lo(gp.y)); g4.w = bf_hi(vp.y) * sigmoidf_(bf_hi(gp.y));
#pragma unroll
        for (int o = 0; o < 8; o++) {
          const int j = i - o;
          if (j >= 0 && j <= 30) {
            const pg8::f32x4 w4 = *(const LAS pg8::f32x4*)(cwl + j * 256 + lane * 4);
            acc[o].x += g4.x * w4[0]; acc[o].y += g4.y * w4[1];
            acc[o].z += g4.z * w4[2]; acc[o].w += g4.w * w4[3];
          }
        }
      }
    }
#pragma unroll
    for (int o = 0; o < 8; o++) {
      const float4 a = acc[o];
      const float mean = wsum(a.x + a.y + a.z + a.w) * (1.0f / 256.f);
      const float dx = a.x - mean, dy = a.y - mean, dz = a.z - mean, dw = a.w - mean;
      const float var = wsum(dx * dx + dy * dy + dz * dz + dw * dw) * (1.0f / 256.f);
      const float rs = rsqrtf(var + EPSF);
      float4 s;
      s.x = dx * rs * lg.x + lb.x; s.y = dy * rs * lg.y + lb.y;
      s.z = dz * rs * lg.z + lb.z; s.w = dw * rs * lg.w + lb.w;
      s.x = s.x * sigmoidf_(s.x); s.y = s.y * sigmoidf_(s.y);
      s.z = s.z * sigmoidf_(s.z); s.w = s.w * sigmoidf_(s.w);
      const float ss = wsum(s.x * s.x + s.y * s.y + s.z * s.z + s.w * s.w) * (1.0f / 256.f);
      const float r2 = rsqrtf(ss + EPSF);
      uint2 pk; pk.x = pk2(s.x * r2 * gg.x, s.y * r2 * gg.y); pk.y = pk2(s.z * r2 * gg.z, s.w * r2 * gg.w);
      ((uint2*)(y + (size_t)(tok0 + o) * DM))[lane] = pk;
    }
  }
}

typedef short bf16x8_t __attribute__((ext_vector_type(8)));
typedef float f32x16_t __attribute__((ext_vector_type(16)));
#define MFMA_PAD() do { __builtin_amdgcn_sched_barrier(0); asm volatile("s_nop 15\n\ts_nop 15" ::: "memory"); __builtin_amdgcn_sched_barrier(0); } while (0)

__device__ __forceinline__ void attn_phase(const int wave_s, const Params& p, int l, const bf16* proj, bf16* y, LAS float* smem) {
  const int tid = opaque_tid(wave_s), lane = tid & 63, wave = tid >> 6;
  const int n = lane & 31, hh = lane >> 5;
  const float* gg = karg_in(18) + l * 1024 + 256 + wave * 64;
  const float g0 = gg[n], g1 = gg[32 + n];
  LAS float* ssq = smem;
  LAS float* rstd = smem + 256;
  for (int item = blockIdx.x; item < 4 * 128; item += gridDim.x) {
    const int b = item >> 7, q0 = (item & 127) * 32;
    const size_t tokb = (size_t)b * SEQ;
    bf16x8_t qf[4];
    {
      const bf16* qrow = proj + (tokb + q0 + n) * DIN + 512 + wave * 64 + 8 * hh;
#pragma unroll
      for (int ks = 0; ks < 4; ks++) qf[ks] = *(const bf16x8_t*)(qrow + 16 * ks);
    }
    f32x16_t o0, o1;
#pragma unroll
    for (int r = 0; r < 16; r++) { o0[r] = 0.f; o1[r] = 0.f; }
    float R = 0.f;
    for (int kt = q0; kt >= 0; kt -= 32) {
      bf16x8_t kf[4];
      {
        const bf16* krow = proj + (tokb + kt + n) * DIN + 1024 + wave * 64 + 8 * hh;
#pragma unroll
        for (int ks = 0; ks < 4; ks++) kf[ks] = *(const bf16x8_t*)(krow + 16 * ks);
      }
      bf16x8_t vf0[2], vf1[2];
      {
        const bf16* vb = proj + (tokb + kt + 4 * hh) * DIN + 1536 + wave * 64 + n;
#pragma unroll
        for (int s = 0; s < 2; s++)
#pragma unroll
          for (int j = 0; j < 8; j++) {
            const int key = 16 * s + 8 * (j >> 2) + (j & 3);
            vf0[s][j] = (short)vb[(size_t)key * DIN];
            vf1[s][j] = (short)vb[(size_t)key * DIN + 32];
          }
      }
      f32x16_t sacc;
#pragma unroll
      for (int r = 0; r < 16; r++) sacc[r] = 0.f;
      __builtin_amdgcn_sched_barrier(0); asm volatile("s_nop 15\n\ts_nop 15" ::: "memory"); __builtin_amdgcn_sched_barrier(0);
#pragma unroll
      for (int ks = 0; ks < 4; ks++) sacc = __builtin_amdgcn_mfma_f32_32x32x16_bf16(kf[ks], qf[ks], sacc, 0, 0, 0);
      __builtin_amdgcn_sched_barrier(0); asm volatile("s_nop 15\n\ts_nop 15" ::: "memory"); __builtin_amdgcn_sched_barrier(0);
      float lst[16], lsz[16];
      const bool diag = (kt == q0);
#pragma unroll
      for (int r = 0; r < 16; r++) {
        const float z = sacc[r] * 0.125f;
        const float sp = __logf(1.0f + __expf(-fabsf(z)));
        float a = fminf(z, 0.f) - sp;
        float c = -(fmaxf(z, 0.f) + sp);
        if (diag) {
          const int key = (r & 3) + 8 * (r >> 2) + 4 * hh;
          if (key >= n) { a = -1.0e30f; c = 0.f; }
        }
        lsz[r] = a; lst[r] = c;
      }
      float Gs[4], Gp[4];
#pragma unroll
      for (int g = 0; g < 4; g++) {
        Gs[g] = (lst[4 * g] + lst[4 * g + 1]) + (lst[4 * g + 2] + lst[4 * g + 3]);
        Gp[g] = __shfl_xor(Gs[g], 32, 64);
      }
      float carry[4];
      {
        float after = R;
#pragma unroll
        for (int g = 3; g >= 0; g--) {
          carry[g] = after + (hh ? 0.f : Gp[g]);
          after += Gs[g] + Gp[g];
        }
        R = after;
      }
      bf16x8_t pf[2];
#pragma unroll
      for (int g = 0; g < 4; g++) {
        float run = carry[g];
        float a3 = __expf(lsz[4 * g + 3] + run); run += lst[4 * g + 3];
        float a2 = __expf(lsz[4 * g + 2] + run); run += lst[4 * g + 2];
        float a1 = __expf(lsz[4 * g + 1] + run); run += lst[4 * g + 1];
        float a0 = __expf(lsz[4 * g + 0] + run);
        const int s = g >> 1, jb = (g & 1) * 4;
        pf[s][jb + 0] = (short)f2bf(a0); pf[s][jb + 1] = (short)f2bf(a1);
        pf[s][jb + 2] = (short)f2bf(a2); pf[s][jb + 3] = (short)f2bf(a3);
      }
      __builtin_amdgcn_sched_barrier(0); asm volatile("s_nop 15\n\ts_nop 15" ::: "memory"); __builtin_amdgcn_sched_barrier(0);
#pragma unroll
      for (int s = 0; s < 2; s++) {
        o0 = __builtin_amdgcn_mfma_f32_32x32x16_bf16(pf[s], vf0[s], o0, 0, 0, 0);
        o1 = __builtin_amdgcn_mfma_f32_32x32x16_bf16(pf[s], vf1[s], o1, 0, 0, 0);
      }
      __builtin_amdgcn_sched_barrier(0); asm volatile("s_nop 15\n\ts_nop 15" ::: "memory"); __builtin_amdgcn_sched_barrier(0);
      if (__all(R < -110.f)) break;
    }
    float sq[16];
#pragma unroll
    for (int r = 0; r < 16; r++) {
      float v = o0[r] * o0[r] + o1[r] * o1[r];
#pragma unroll
      for (int o = 16; o > 0; o >>= 1) v += __shfl_xor(v, o, 64);
      sq[r] = v;
    }
    __syncthreads();
    if (n == 0) {
#pragma unroll
      for (int r = 0; r < 16; r++) ssq[wave * 32 + (r & 3) + 8 * (r >> 2) + 4 * hh] = sq[r];
    }
    __syncthreads();
    if (tid < 32) {
      float t = 0.f;
#pragma unroll
      for (int w = 0; w < 8; w++) t += ssq[w * 32 + tid];
      rstd[tid] = rsqrtf(t * (1.0f / 512.f) + EPSF);
    }
    __syncthreads();
#pragma unroll
    for (int r = 0; r < 16; r++) {
      const int qi = (r & 3) + 8 * (r >> 2) + 4 * hh;
      const float rs = rstd[qi];
      bf16* yr = y + (tokb + q0 + qi) * DM + 256 + wave * 64 + n;
      yr[0] = (bf16)f2bf(o0[r] * rs * g0);
      yr[32] = (bf16)f2bf(o1[r] * rs * g1);
    }
  }
}

#define SSM_BCAST_U(u, ua, ub, tt) do { \
    const unsigned w0 = (unsigned)__builtin_amdgcn_readlane((int)(ua).x, (tt)), w1 = (unsigned)__builtin_amdgcn_readlane((int)(ua).y, (tt)); \
    const unsigned w2 = (unsigned)__builtin_amdgcn_readlane((int)(ua).z, (tt)), w3 = (unsigned)__builtin_amdgcn_readlane((int)(ua).w, (tt)); \
    const unsigned w4 = (unsigned)__builtin_amdgcn_readlane((int)(ub).x, (tt)), w5 = (unsigned)__builtin_amdgcn_readlane((int)(ub).y, (tt)); \
    const unsigned w6 = (unsigned)__builtin_amdgcn_readlane((int)(ub).z, (tt)), w7 = (unsigned)__builtin_amdgcn_readlane((int)(ub).w, (tt)); \
    (u)[0] = bf_lo(w0); (u)[1] = bf_hi(w0); (u)[2] = bf_lo(w1); (u)[3] = bf_hi(w1); (u)[4] = bf_lo(w2); (u)[5] = bf_hi(w2); (u)[6] = bf_lo(w3); (u)[7] = bf_hi(w3); \
    (u)[8] = bf_lo(w4); (u)[9] = bf_hi(w4); (u)[10] = bf_lo(w5); (u)[11] = bf_hi(w5); (u)[12] = bf_lo(w6); (u)[13] = bf_hi(w6); (u)[14] = bf_lo(w7); (u)[15] = bf_hi(w7); } while (0)
#define SSM_RS 592
#define SSM_TILE_BASE 36864
#define SSM_TILE_BYTES (16 * SSM_RS)
typedef float f32x2_t __attribute__((ext_vector_type(2)));
__device__ __forceinline__ void ssm_load_bop(const float* ssmp, int g, int lane, bf16x8_t (&bop)[8]) {
  const int q = lane >> 4, n = lane & 15;
  float v[8][8];
#pragma unroll
  for (int j = 0; j < 8; j++) {
    const float4* rp = (const float4*)(ssmp + 4096 + (size_t)(g * 16 + ((8 * q + j) & 15)) * 128 + 8 * n);
    const float4 a = rp[0], b = rp[1];
    v[j][0] = a.x; v[j][1] = a.y; v[j][2] = a.z; v[j][3] = a.w; v[j][4] = b.x; v[j][5] = b.y; v[j][6] = b.z; v[j][7] = b.w;
  }
#pragma unroll
  for (int nt = 0; nt < 8; nt++) {
    pg8::u32x4 w;
    w.x = pk2(v[0][nt], v[1][nt]); w.y = pk2(v[2][nt], v[3][nt]); w.z = pk2(v[4][nt], v[5][nt]); w.w = pk2(v[6][nt], v[7][nt]);
    if (q >= 2) { w.x = 0u; w.y = 0u; w.z = 0u; w.w = 0u; }
    bop[nt] = __builtin_bit_cast(bf16x8_t, w);
  }
}
__device__ __forceinline__ void ssm_bu_block(LAS unsigned char* xt, int lane, int blk, const uint4& ua, const uint4& ub, const bf16x8_t (&bop)[8]) {
  const int q = lane >> 4, n = lane & 15;
  if (q == blk) {
    pg8::u32x4 w0, w1;
    w0.x = ua.x; w0.y = ua.y; w0.z = ua.z; w0.w = ua.w; w1.x = ub.x; w1.y = ub.y; w1.z = ub.z; w1.w = ub.w;
    LAS pg8::u32x4* ur = (LAS pg8::u32x4*)(xt + n * SSM_RS + 512);
    ur[0] = w0; ur[1] = w1;
  }
  __builtin_amdgcn_wave_barrier();
  const bf16x8_t uop = *(const LAS bf16x8_t*)(xt + n * SSM_RS + 512 + q * 16);
  pg8::f32x4 bacc[8];
#pragma unroll
  for (int nt = 0; nt < 8; nt++) {
    pg8::f32x4 z4; z4[0] = 0.f; z4[1] = 0.f; z4[2] = 0.f; z4[3] = 0.f;
    bacc[nt] = __builtin_amdgcn_mfma_f32_16x16x32_bf16(uop, bop[nt], z4, 0, 0, 0);
  }
#pragma unroll
  for (int j = 0; j < 4; j++) {
    pg8::f32x4 w0, w1;
    w0[0] = bacc[0][j]; w0[1] = bacc[1][j]; w0[2] = bacc[2][j]; w0[3] = bacc[3][j];
    w1[0] = bacc[4][j]; w1[1] = bacc[5][j]; w1[2] = bacc[6][j]; w1[3] = bacc[7][j];
    LAS pg8::f32x4* dr = (LAS pg8::f32x4*)(xt + (4 * q + j) * SSM_RS + 32 * n);
    dr[0] = w0; dr[1] = w1;
  }
  __builtin_amdgcn_wave_barrier();
}
__device__ __forceinline__ void ssm_zero_pad(LAS unsigned char* xt, int lane) {
  if (lane < 16) {
    pg8::u32x4 z4; z4.x = 0u; z4.y = 0u; z4.z = 0u; z4.w = 0u;
    LAS pg8::u32x4* zr = (LAS pg8::u32x4*)(xt + lane * SSM_RS + 544);
    zr[0] = z4; zr[1] = z4;
  }
}
__device__ __forceinline__ void ssm_chunk_end(const int wave_s, const float* ssmp, const bf16* proj, float* ssmE, LAS float* smem) {
  const int tid_ = opaque_tid(wave_s);
  const int lane = tid_ & 63;
  const int gw = blockIdx.x * NWAVES + (tid_ >> 6);
  const int nw = gridDim.x * NWAVES;
  for (int it = gw; it < 4 * 64 * 16; it += nw) {
    const int g = it & 15, c = (it >> 4) & 63, b = it >> 10;
    const int gp = g * 64 + lane;
    const uint4* up = (const uint4*)(proj + (size_t)(b * SEQ + c * 64 + lane) * DIN + 2048 + g * 16);
    const uint4 ua = up[0], ub = up[1];
    const float lbr = ssmp[gp * 2], lbi = ssmp[gp * 2 + 1];
    bf16x8_t bop[8];
    ssm_load_bop(ssmp, g, lane, bop);
    LAS unsigned char* xt = (LAS unsigned char*)smem + SSM_TILE_BASE + (tid_ >> 6) * SSM_TILE_BYTES;
    ssm_zero_pad(xt, lane);
    float xr = 0.f, xi = 0.f;
#pragma unroll 1
    for (int blk = 0; blk < 4; blk++) {
      ssm_bu_block(xt, lane, blk, ua, ub, bop);
#pragma unroll 4
      for (int tt = 0; tt < 16; tt++) {
        const f32x2_t bu = *(const LAS f32x2_t*)(xt + tt * SSM_RS + lane * 8);
        const float nr = lbr * xr - lbi * xi + bu[0];
        const float ni = lbr * xi + lbi * xr + bu[1];
        xr = nr; xi = ni;
      }
      __builtin_amdgcn_wave_barrier();
    }
    float* e = ssmE + ((size_t)((b * 64 + c) * 16 + g) * 64 + lane) * 2;
    e[0] = xr; e[1] = xi;
  }
}

__device__ __forceinline__ void ssm_finish(const int wave_s, const Params& p, int l, const float* ssmp, const bf16* proj,
                           const float* ssmE, bf16* y, LAS float* smem) {
  LAS bf16* Ytb = (LAS bf16*)smem;
  LAS float* ssq2 = smem + (64 * 264 * 2) / 4;
  LAS float* rstd2 = ssq2 + 512;
  const bf16* glT = (const bf16*)(p.ws + WS_WT + (size_t)l * WT_LAYER + WT_GLU);
  const int tid = opaque_tid(wave_s), lane = tid & 63, wave = tid >> 6;
  const float* cre = karg_in(13) + (size_t)l * 16 * 16 * 64;
  const float* cim = karg_in(14) + (size_t)l * 16 * 16 * 64;
  const float* dsk = karg_in(15) + l * 256;
  const float* glw = karg_in(16) + (size_t)l * 256 * 256;
  const float* glb = karg_in(17) + l * 256;
  const float* gg = karg_in(18) + l * 1024 + 768;
  for (int it = blockIdx.x; it < 256; it += gridDim.x) {
    const int b = it >> 6, c = it & 63;
    __syncthreads();
    for (int gi = 0; gi < 2; gi++) {
      const int g = wave + gi * 8;
      const int gp = g * 64 + lane;
      const float lbr = ssmp[gp * 2], lbi = ssmp[gp * 2 + 1];
      const float lcr = ssmp[2048 + gp * 2], lci = ssmp[2048 + gp * 2 + 1];
      bf16x8_t bop[8];
      ssm_load_bop(ssmp, g, lane, bop);
      bf16x8_t cop[5];
      {
        const int nn = lane & 15, q = lane >> 4;
#pragma unroll
        for (int ks = 0; ks < 4; ks++) {
          const float4 cr4 = *(const float4*)(cre + (g * 16 + nn) * 64 + 16 * ks + 4 * q);
          const float4 ci4 = *(const float4*)(cim + (g * 16 + nn) * 64 + 16 * ks + 4 * q);
          pg8::u32x4 w;
          w.x = pk2(cr4.x, -ci4.x); w.y = pk2(cr4.y, -ci4.y); w.z = pk2(cr4.z, -ci4.z); w.w = pk2(cr4.w, -ci4.w);
          cop[ks] = __builtin_bit_cast(bf16x8_t, w);
        }
        const float dn = dsk[g * 16 + nn];
        float dv[8];
#pragma unroll
        for (int j = 0; j < 8; j++) dv[j] = (8 * q + j == nn) ? dn : 0.f;
        pg8::u32x4 w;
        w.x = pk2(dv[0], dv[1]); w.y = pk2(dv[2], dv[3]); w.z = pk2(dv[4], dv[5]); w.w = pk2(dv[6], dv[7]);
        cop[4] = __builtin_bit_cast(bf16x8_t, w);
      }
      const uint4* up = (const uint4*)(proj + (size_t)(b * SEQ + c * 64 + lane) * DIN + 2048 + g * 16);
      const uint4 ua = up[0], ub = up[1];
      float xr = 0.f, xi = 0.f;
      {
        const float2* eb = (const float2*)ssmE + ((size_t)(b * 64) * 16 + g) * 64 + lane;
        for (int cc = 0; cc < c; cc += 16) {
          float2 ev[16];
#pragma unroll
          for (int k = 0; k < 16; k++) ev[k] = eb[(size_t)(cc + k < c ? cc + k : c - 1) * 16 * 64];
#pragma unroll
          for (int k = 0; k < 16; k++) {
            if (cc + k < c) {
              const float nr = lcr * xr - lci * xi + ev[k].x;
              const float ni = lcr * xi + lci * xr + ev[k].y;
              xr = nr; xi = ni;
            }
          }
        }
      }
      LAS unsigned char* xt = (LAS unsigned char*)smem + SSM_TILE_BASE + wave * SSM_TILE_BYTES;
      ssm_zero_pad(xt, lane);
#pragma unroll 1
      for (int blk = 0; blk < 4; blk++) {
        ssm_bu_block(xt, lane, blk, ua, ub, bop);
#pragma unroll 4
        for (int tt = 0; tt < 16; tt++) {
          const f32x2_t bu = *(const LAS f32x2_t*)(xt + tt * SSM_RS + lane * 8);
          const float nr = lbr * xr - lbi * xi + bu[0];
          const float ni = lbr * xi + lbi * xr + bu[1];
          xr = nr; xi = ni;
          *(LAS unsigned*)(xt + tt * SSM_RS + lane * 4) = pk2(xr, xi);
        }
        __builtin_amdgcn_wave_barrier();
        {
          pg8::f32x4 acc4;
          acc4[0] = 0.f; acc4[1] = 0.f; acc4[2] = 0.f; acc4[3] = 0.f;
          const LAS unsigned char* ar = xt + (lane & 15) * SSM_RS + (lane >> 4) * 16;
#pragma unroll
          for (int ks = 0; ks < 4; ks++)
            acc4 = __builtin_amdgcn_mfma_f32_16x16x32_bf16(*(const LAS bf16x8_t*)(ar + ks * 64), cop[ks], acc4, 0, 0, 0);
          acc4 = __builtin_amdgcn_mfma_f32_16x16x32_bf16(*(const LAS bf16x8_t*)(ar + 512), cop[4], acc4, 0, 0, 0);
#pragma unroll
          for (int j = 0; j < 4; j++)
            Ytb[(blk * 16 + 4 * (lane >> 4) + j) * 264 + g * 16 + (lane & 15)] = (bf16)f2bf(gelu_tanh(acc4[j]));
        }
        __builtin_amdgcn_wave_barrier();
      }
    }
    __syncthreads();
    {
      const int n = lane & 31, hh = lane >> 5;
      const int ch = wave * 32 + n;
      const float bj = glb[ch];
      const float gj = gg[ch];
      bf16x8_t gf[16];
      {
        const bf16* grow = glT + (size_t)ch * 256 + 8 * hh;
#pragma unroll
        for (int ks = 0; ks < 16; ks++) gf[ks] = *(const bf16x8_t*)(grow + 16 * ks);
      }
      float oo[2][16];
#pragma unroll
      for (int mt = 0; mt < 2; mt++) {
        f32x16_t z;
#pragma unroll
        for (int r = 0; r < 16; r++) z[r] = 0.f;
        const LAS bf16* yrow = Ytb + (mt * 32 + n) * 264 + 8 * hh;
#pragma unroll
        for (int kq = 0; kq < 4; kq++) {
          bf16x8_t yf[4];
#pragma unroll
          for (int i = 0; i < 4; i++) yf[i] = *(const LAS bf16x8_t*)(yrow + 16 * (kq * 4 + i));
          MFMA_PAD();
#pragma unroll
          for (int i = 0; i < 4; i++) z = __builtin_amdgcn_mfma_f32_32x32x16_bf16(yf[i], gf[kq * 4 + i], z, 0, 0, 0);
          MFMA_PAD();
        }
        float sq[16];
#pragma unroll
        for (int r = 0; r < 16; r++) {
          const int t = mt * 32 + (r & 3) + 8 * (r >> 2) + 4 * hh;
          const float yv = bf2f(Ytb[t * 264 + ch]);
          const float o = yv * sigmoidf_(z[r] + bj);
          oo[mt][r] = o;
          float v = o * o;
#pragma unroll
          for (int s = 16; s > 0; s >>= 1) v += __shfl_xor(v, s, 64);
          sq[r] = v;
        }
        if (n == 0) {
#pragma unroll
          for (int r = 0; r < 16; r++) ssq2[wave * 64 + mt * 32 + (r & 3) + 8 * (r >> 2) + 4 * hh] = sq[r];
        }
      }
      __syncthreads();
      if (tid < 64) {
        float t = 0.f;
#pragma unroll
        for (int w = 0; w < 8; w++) t += ssq2[w * 64 + tid];
        rstd2[tid] = rsqrtf(t * (1.0f / 256.f) + EPSF);
      }
      __syncthreads();
#pragma unroll
      for (int mt = 0; mt < 2; mt++)
#pragma unroll
        for (int r = 0; r < 16; r++) {
          const int t = mt * 32 + (r & 3) + 8 * (r >> 2) + 4 * hh;
          y[(size_t)(b * SEQ + c * 64 + t) * DM + 768 + ch] = (bf16)f2bf(oo[mt][r] * rstd2[t] * gj);
        }
    }
  }
}

__device__ __forceinline__ void memattn_phase(const int wave_s, const bf16* q, const bf16* kvb, const bf16* vT, bf16* o, LAS float* smem) {
  const int tid_ = opaque_tid(wave_s);
  const int lane = tid_ & 63, n = lane & 31, hh = lane >> 5, wave = tid_ >> 6;
  const int sig = (n & 0x13) | ((n & 4) << 1) | ((n & 8) >> 1);
  LAS bf16* Ls = (LAS bf16*)smem;
  for (int it = blockIdx.x; it < 64 * 4; it += gridDim.x) {
    const int h = it & 3, tg = it >> 2, b = tg >> 4;
    const int tok0 = (tg * 8 + wave) * 32;
    __syncthreads();
    {
      const int r = tid_ >> 1, hf = tid_ & 1;
      const pg8::u32x4* src4 = (const pg8::u32x4*)(kvb + (size_t)(b * NMEM + r) * 2048 + h * 256 + hf * 128);
      LAS pg8::u32x4* dst4 = (LAS pg8::u32x4*)(Ls + r * 264 + hf * 128);
#pragma unroll
      for (int k = 0; k < 16; k++) dst4[k] = src4[k];
    }
    f32x16_t st[8];
#pragma unroll
    for (int kt = 0; kt < 8; kt++)
#pragma unroll
      for (int r = 0; r < 16; r++) st[kt][r] = 0.f;
    const bf16* qrow = q + (size_t)(tok0 + n) * DM + h * 256 + 8 * hh;
    __syncthreads();
#pragma unroll
    for (int kq = 0; kq < 4; kq++) {
      bf16x8_t qf[4];
#pragma unroll
      for (int i = 0; i < 4; i++) qf[i] = *(const bf16x8_t*)(qrow + 16 * (kq * 4 + i));
#pragma unroll
      for (int kt = 0; kt < 8; kt++) {
        const LAS bf16* krow = Ls + (kt * 32 + sig) * 264 + 8 * hh;
        bf16x8_t kf[4];
#pragma unroll
        for (int i = 0; i < 4; i++) kf[i] = *(const LAS bf16x8_t*)(krow + 16 * (kq * 4 + i));
        MFMA_PAD();
#pragma unroll
        for (int i = 0; i < 4; i++) st[kt] = __builtin_amdgcn_mfma_f32_32x32x16_bf16(kf[i], qf[i], st[kt], 0, 0, 0);
        MFMA_PAD();
      }
    }
    float mx = st[0][0];
#pragma unroll
    for (int kt = 0; kt < 8; kt++)
#pragma unroll
      for (int r = 0; r < 16; r++) mx = fmaxf(mx, st[kt][r]);
    mx = fmaxf(mx, __shfl_xor(mx, 32, 64));
    float sum = 0.f;
#pragma unroll
    for (int kt = 0; kt < 8; kt++)
#pragma unroll
      for (int r = 0; r < 16; r++) { const float e = __expf((st[kt][r] - mx) * 0.0625f); st[kt][r] = e; sum += e; }
    sum += __shfl_xor(sum, 32, 64);
    const float inv = 1.0f / sum;
    bf16x8_t pf[8][2];
#pragma unroll
    for (int kt = 0; kt < 8; kt++)
#pragma unroll
      for (int s = 0; s < 2; s++)
#pragma unroll
        for (int j = 0; j < 8; j++) pf[kt][s][j] = (short)f2bf(st[kt][8 * s + j] * inv);
    __syncthreads();
    {
      const int r = tid_ >> 1, hf = tid_ & 1;
      const pg8::u32x4* src4 = (const pg8::u32x4*)(vT + ((size_t)(b * 4 + h) * 256 + r) * 256 + hf * 128);
      LAS pg8::u32x4* dst4 = (LAS pg8::u32x4*)(Ls + r * 264 + hf * 128);
#pragma unroll
      for (int k = 0; k < 16; k++) dst4[k] = src4[k];
    }
    __syncthreads();
#pragma unroll 1
    for (int dt = 0; dt < 8; dt++) {
      f32x16_t oacc;
#pragma unroll
      for (int r = 0; r < 16; r++) oacc[r] = 0.f;
      const LAS bf16* vrow = Ls + (dt * 32 + n) * 264 + 8 * hh;
#pragma unroll
      for (int kq = 0; kq < 4; kq++) {
        bf16x8_t vf[4];
#pragma unroll
        for (int i = 0; i < 4; i++) vf[i] = *(const LAS bf16x8_t*)(vrow + (kq * 2 + (i >> 1)) * 32 + 16 * (i & 1));
        MFMA_PAD();
#pragma unroll
        for (int i = 0; i < 4; i++) oacc = __builtin_amdgcn_mfma_f32_32x32x16_bf16(pf[kq * 2 + (i >> 1)][i & 1], vf[i], oacc, 0, 0, 0);
        MFMA_PAD();
      }
#pragma unroll
      for (int r = 0; r < 16; r++) {
        const int qi = (r & 3) + 8 * (r >> 2) + 4 * hh;
        o[(size_t)(tok0 + qi) * DM + h * 256 + dt * 32 + n] = (bf16)f2bf(oacc[r]);
      }
    }
  }
}

__device__ __forceinline__ void vt_phase(const int wave_s, const bf16* kvb, bf16* vT) {
  const int tid_ = opaque_tid(wave_s);
  const int gt = blockIdx.x * (NWAVES * 64) + tid_;
  const int nth = gridDim.x * NWAVES * 64;
  for (int i = gt; i < 2 * 4 * 4 * 256 * 256; i += nth) {
    const int m = i & 255, d = (i >> 8) & 255, h = (i >> 16) & 3, b = (i >> 18) & 3, l = i >> 20;
    vT[i] = kvb[((size_t)l * 1024 + b * 256 + m) * 2048 + 1024 + h * 256 + d];
  }
}

template <unsigned MASK>
__device__ __forceinline__ float pack_key(float s, unsigned idx) {
  const unsigned u = __builtin_bit_cast(unsigned, s);
  const unsigned tag = ((int)u < 0) ? idx : (MASK - idx);
  return __builtin_bit_cast(float, (u & ~MASK) + tag);
}
template <unsigned MASK>
__device__ __forceinline__ unsigned key_idx(float k) {
  const unsigned u = __builtin_bit_cast(unsigned, k);
  const unsigned tag = u & MASK;
  return ((int)u < 0) ? tag : (MASK - tag);
}
template <unsigned MASK>
__device__ __forceinline__ float key_val(float k) { return __builtin_bit_cast(float, __builtin_bit_cast(unsigned, k) & ~MASK); }
__device__ __forceinline__ void top16_of_64(float (&K)[64]) {
  { const float a_ = K[0], b_ = K[1]; const bool g_ = a_ > b_; K[0] = g_ ? a_ : b_; K[1] = g_ ? b_ : a_; }
  { const float a_ = K[2], b_ = K[3]; const bool g_ = a_ > b_; K[2] = g_ ? b_ : a_; K[3] = g_ ? a_ : b_; }
  { const float a_ = K[4], b_ = K[5]; const bool g_ = a_ > b_; K[4] = g_ ? a_ : b_; K[5] = g_ ? b_ : a_; }
  { const float a_ = K[6], b_ = K[7]; const bool g_ = a_ > b_; K[6] = g_ ? b_ : a_; K[7] = g_ ? a_ : b_; }
  { const float a_ = K[8], b_ = K[9]; const bool g_ = a_ > b_; K[8] = g_ ? a_ : b_; K[9] = g_ ? b_ : a_; }
  { const float a_ = K[10], b_ = K[11]; const bool g_ = a_ > b_; K[10] = g_ ? b_ : a_; K[11] = g_ ? a_ : b_; }
  { const float a_ = K[12], b_ = K[13]; const bool g_ = a_ > b_; K[12] = g_ ? a_ : b_; K[13] = g_ ? b_ : a_; }
  { const float a_ = K[14], b_ = K[15]; const bool g_ = a_ > b_; K[14] = g_ ? b_ : a_; K[15] = g_ ? a_ : b_; }
  { const float a_ = K[0], b_ = K[2]; const bool g_ = a_ > b_; K[0] = g_ ? a_ : b_; K[2] = g_ ? b_ : a_; }
  { const float a_ = K[1], b_ = K[3]; const bool g_ = a_ > b_; K[1] = g_ ? a_ : b_; K[3] = g_ ? b_ : a_; }
  { const float a_ = K[4], b_ = K[6]; const bool g_ = a_ > b_; K[4] = g_ ? b_ : a_; K[6] = g_ ? a_ : b_; }
  { const float a_ = K[5], b_ = K[7]; const bool g_ = a_ > b_; K[5] = g_ ? b_ : a_; K[7] = g_ ? a_ : b_; }
  { const float a_ = K[8], b_ = K[10]; const bool g_ = a_ > b_; K[8] = g_ ? a_ : b_; K[10] = g_ ? b_ : a_; }
  { const float a_ = K[9], b_ = K[11]; const bool g_ = a_ > b_; K[9] = g_ ? a_ : b_; K[11] = g_ ? b_ : a_; }
  { const float a_ = K[12], b_ = K[14]; const bool g_ = a_ > b_; K[12] = g_ ? b_ : a_; K[14] = g_ ? a_ : b_; }
  { const float a_ = K[13], b_ = K[15]; const bool g_ = a_ > b_; K[13] = g_ ? b_ : a_; K[15] = g_ ? a_ : b_; }
  { const float a_ = K[0], b_ = K[1]; const bool g_ = a_ > b_; K[0] = g_ ? a_ : b_; K[1] = g_ ? b_ : a_; }
  { const float a_ = K[2], b_ = K[3]; const bool g_ = a_ > b_; K[2] = g_ ? a_ : b_; K[3] = g_ ? b_ : a_; }
  { const float a_ = K[4], b_ = K[5]; const bool g_ = a_ > b_; K[4] = g_ ? b_ : a_; K[5] = g_ ? a_ : b_; }
  { const float a_ = K[6], b_ = K[7]; const bool g_ = a_ > b_; K[6] = g_ ? b_ : a_; K[7] = g_ ? a_ : b_; }
  { const float a_ = K[8], b_ = K[9]; const bool g_ = a_ > b_; K[8] = g_ ? a_ : b_; K[9] = g_ ? b_ : a_; }
  { const float a_ = K[10], b_ = K[11]; const bool g_ = a_ > b_; K[10] = g_ ? a_ : b_; K[11] = g_ ? b_ : a_; }
  { const float a_ = K[12], b_ = K[13]; const bool g_ = a_ > b_; K[12] = g_ ? b_ : a_; K[13] = g_ ? a_ : b_; }
  { const float a_ = K[14], b_ = K[15]; const bool g_ = a_ > b_; K[14] = g_ ? b_ : a_; K[15] = g_ ? a_ : b_; }
  { const float a_ = K[0], b_ = K[4]; const bool g_ = a_ > b_; K[0] = g_ ? a_ : b_; K[4] = g_ ? b_ : a_; }
  { const float a_ = K[1], b_ = K[5]; const bool g_ = a_ > b_; K[1] = g_ ? a_ : b_; K[5] = g_ ? b_ : a_; }
  { const float a_ = K[2], b_ = K[6]; const bool g_ = a_ > b_; K[2] = g_ ? a_ : b_; K[6] = g_ ? b_ : a_; }
  { const float a_ = K[3], b_ = K[7]; const bool g_ = a_ > b_; K[3] = g_ ? a_ : b_; K[7] = g_ ? b_ : a_; }
  { const float a_ = K[8], b_ = K[12]; const bool g_ = a_ > b_; K[8] = g_ ? b_ : a_; K[12] = g_ ? a_ : b_; }
  { const float a_ = K[9], b_ = K[13]; const bool g_ = a_ > b_; K[9] = g_ ? b_ : a_; K[13] = g_ ? a_ : b_; }
  { const float a_ = K[10], b_ = K[14]; const bool g_ = a_ > b_; K[10] = g_ ? b_ : a_; K[14] = g_ ? a_ : b_; }
  { const float a_ = K[11], b_ = K[15]; const bool g_ = a_ > b_; K[11] = g_ ? b_ : a_; K[15] = g_ ? a_ : b_; }
  { const float a_ = K[0], b_ = K[2]; const bool g_ = a_ > b_; K[0] = g_ ? a_ : b_; K[2] = g_ ? b_ : a_; }
  { const float a_ = K[1], b_ = K[3]; const bool g_ = a_ > b_; K[1] = g_ ? a_ : b_; K[3] = g_ ? b_ : a_; }
  { const float a_ = K[4], b_ = K[6]; const bool g_ = a_ > b_; K[4] = g_ ? a_ : b_; K[6] = g_ ? b_ : a_; }
  { const float a_ = K[5], b_ = K[7]; const bool g_ = a_ > b_; K[5] = g_ ? a_ : b_; K[7] = g_ ? b_ : a_; }
  { const float a_ = K[8], b_ = K[10]; const bool g_ = a_ > b_; K[8] = g_ ? b_ : a_; K[10] = g_ ? a_ : b_; }
  { const float a_ = K[9], b_ = K[11]; const bool g_ = a_ > b_; K[9] = g_ ? b_ : a_; K[11] = g_ ? a_ : b_; }
  { const float a_ = K[12], b_ = K[14]; const bool g_ = a_ > b_; K[12] = g_ ? b_ : a_; K[14] = g_ ? a_ : b_; }
  { const float a_ = K[13], b_ = K[15]; const bool g_ = a_ > b_; K[13] = g_ ? b_ : a_; K[15] = g_ ? a_ : b_; }
  { const float a_ = K[0], b_ = K[1]; const bool g_ = a_ > b_; K[0] = g_ ? a_ : b_; K[1] = g_ ? b_ : a_; }
  { const float a_ = K[2], b_ = K[3]; const bool g_ = a_ > b_; K[2] = g_ ? a_ : b_; K[3] = g_ ? b_ : a_; }
  { const float a_ = K[4], b_ = K[5]; const bool g_ = a_ > b_; K[4] = g_ ? a_ : b_; K[5] = g_ ? b_ : a_; }
  { const float a_ = K[6], b_ = K[7]; const bool g_ = a_ > b_; K[6] = g_ ? a_ : b_; K[7] = g_ ? b_ : a_; }
  { const float a_ = K[8], b_ = K[9]; const bool g_ = a_ > b_; K[8] = g_ ? b_ : a_; K[9] = g_ ? a_ : b_; }
  { const float a_ = K[10], b_ = K[11]; const bool g_ = a_ > b_; K[10] = g_ ? b_ : a_; K[11] = g_ ? a_ : b_; }
  { const float a_ = K[12], b_ = K[13]; const bool g_ = a_ > b_; K[12] = g_ ? b_ : a_; K[13] = g_ ? a_ : b_; }
  { const float a_ = K[14], b_ = K[15]; const bool g_ = a_ > b_; K[14] = g_ ? b_ : a_; K[15] = g_ ? a_ : b_; }
  { const float a_ = K[0], b_ = K[8]; const bool g_ = a_ > b_; K[0] = g_ ? a_ : b_; K[8] = g_ ? b_ : a_; }
  { const float a_ = K[1], b_ = K[9]; const bool g_ = a_ > b_; K[1] = g_ ? a_ : b_; K[9] = g_ ? b_ : a_; }
  { const float a_ = K[2], b_ = K[10]; const bool g_ = a_ > b_; K[2] = g_ ? a_ : b_; K[10] = g_ ? b_ : a_; }
  { const float a_ = K[3], b_ = K[11]; const bool g_ = a_ > b_; K[3] = g_ ? a_ : b_; K[11] = g_ ? b_ : a_; }
  { const float a_ = K[4], b_ = K[12]; const bool g_ = a_ > b_; K[4] = g_ ? a_ : b_; K[12] = g_ ? b_ : a_; }
  { const float a_ = K[5], b_ = K[13]; const bool g_ = a_ > b_; K[5] = g_ ? a_ : b_; K[13] = g_ ? b_ : a_; }
  { const float a_ = K[6], b_ = K[14]; const bool g_ = a_ > b_; K[6] = g_ ? a_ : b_; K[14] = g_ ? b_ : a_; }
  { const float a_ = K[7], b_ = K[15]; const bool g_ = a_ > b_; K[7] = g_ ? a_ : b_; K[15] = g_ ? b_ : a_; }
  { const float a_ = K[0], b_ = K[4]; const bool g_ = a_ > b_; K[0] = g_ ? a_ : b_; K[4] = g_ ? b_ : a_; }
  { const float a_ = K[1], b_ = K[5]; const bool g_ = a_ > b_; K[1] = g_ ? a_ : b_; K[5] = g_ ? b_ : a_; }
  { const float a_ = K[2], b_ = K[6]; const bool g_ = a_ > b_; K[2] = g_ ? a_ : b_; K[6] = g_ ? b_ : a_; }
  { const float a_ = K[3], b_ = K[7]; const bool g_ = a_ > b_; K[3] = g_ ? a_ : b_; K[7] = g_ ? b_ : a_; }
  { const float a_ = K[8], b_ = K[12]; const bool g_ = a_ > b_; K[8] = g_ ? a_ : b_; K[12] = g_ ? b_ : a_; }
  { const float a_ = K[9], b_ = K[13]; const bool g_ = a_ > b_; K[9] = g_ ? a_ : b_; K[13] = g_ ? b_ : a_; }
  { const float a_ = K[10], b_ = K[14]; const bool g_ = a_ > b_; K[10] = g_ ? a_ : b_; K[14] = g_ ? b_ : a_; }
  { const float a_ = K[11], b_ = K[15]; const bool g_ = a_ > b_; K[11] = g_ ? a_ : b_; K[15] = g_ ? b_ : a_; }
  { const float a_ = K[0], b_ = K[2]; const bool g_ = a_ > b_; K[0] = g_ ? a_ : b_; K[2] = g_ ? b_ : a_; }
  { const float a_ = K[1], b_ = K[3]; const bool g_ = a_ > b_; K[1] = g_ ? a_ : b_; K[3] = g_ ? b_ : a_; }
  { const float a_ = K[4], b_ = K[6]; const bool g_ = a_ > b_; K[4] = g_ ? a_ : b_; K[6] = g_ ? b_ : a_; }
  { const float a_ = K[5], b_ = K[7]; const bool g_ = a_ > b_; K[5] = g_ ? a_ : b_; K[7] = g_ ? b_ : a_; }
  { const float a_ = K[8], b_ = K[10]; const bool g_ = a_ > b_; K[8] = g_ ? a_ : b_; K[10] = g_ ? b_ : a_; }
  { const float a_ = K[9], b_ = K[11]; const bool g_ = a_ > b_; K[9] = g_ ? a_ : b_; K[11] = g_ ? b_ : a_; }
  { const float a_ = K[12], b_ = K[14]; const bool g_ = a_ > b_; K[12] = g_ ? a_ : b_; K[14] = g_ ? b_ : a_; }
  { const float a_ = K[13], b_ = K[15]; const bool g_ = a_ > b_; K[13] = g_ ? a_ : b_; K[15] = g_ ? b_ : a_; }
  { const float a_ = K[0], b_ = K[1]; const bool g_ = a_ > b_; K[0] = g_ ? a_ : b_; K[1] = g_ ? b_ : a_; }
  { const float a_ = K[2], b_ = K[3]; const bool g_ = a_ > b_; K[2] = g_ ? a_ : b_; K[3] = g_ ? b_ : a_; }
  { const float a_ = K[4], b_ = K[5]; const bool g_ = a_ > b_; K[4] = g_ ? a_ : b_; K[5] = g_ ? b_ : a_; }
  { const float a_ = K[6], b_ = K[7]; const bool g_ = a_ > b_; K[6] = g_ ? a_ : b_; K[7] = g_ ? b_ : a_; }
  { const float a_ = K[8], b_ = K[9]; const bool g_ = a_ > b_; K[8] = g_ ? a_ : b_; K[9] = g_ ? b_ : a_; }
  { const float a_ = K[10], b_ = K[11]; const bool g_ = a_ > b_; K[10] = g_ ? a_ : b_; K[11] = g_ ? b_ : a_; }
  { const float a_ = K[12], b_ = K[13]; const bool g_ = a_ > b_; K[12] = g_ ? a_ : b_; K[13] = g_ ? b_ : a_; }
  { const float a_ = K[14], b_ = K[15]; const bool g_ = a_ > b_; K[14] = g_ ? a_ : b_; K[15] = g_ ? b_ : a_; }
  { const float a_ = K[16], b_ = K[17]; const bool g_ = a_ > b_; K[16] = g_ ? a_ : b_; K[17] = g_ ? b_ : a_; }
  { const float a_ = K[18], b_ = K[19]; const bool g_ = a_ > b_; K[18] = g_ ? b_ : a_; K[19] = g_ ? a_ : b_; }
  { const float a_ = K[20], b_ = K[21]; const bool g_ = a_ > b_; K[20] = g_ ? a_ : b_; K[21] = g_ ? b_ : a_; }
  { const float a_ = K[22], b_ = K[23]; const bool g_ = a_ > b_; K[22] = g_ ? b_ : a_; K[23] = g_ ? a_ : b_; }
  { const float a_ = K[24], b_ = K[25]; const bool g_ = a_ > b_; K[24] = g_ ? a_ : b_; K[25] = g_ ? b_ : a_; }
  { const float a_ = K[26], b_ = K[27]; const bool g_ = a_ > b_; K[26] = g_ ? b_ : a_; K[27] = g_ ? a_ : b_; }
  { const float a_ = K[28], b_ = K[29]; const bool g_ = a_ > b_; K[28] = g_ ? a_ : b_; K[29] = g_ ? b_ : a_; }
  { const float a_ = K[30], b_ = K[31]; const bool g_ = a_ > b_; K[30] = g_ ? b_ : a_; K[31] = g_ ? a_ : b_; }
  { const float a_ = K[16], b_ = K[18]; const bool g_ = a_ > b_; K[16] = g_ ? a_ : b_; K[18] = g_ ? b_ : a_; }
  { const float a_ = K[17], b_ = K[19]; const bool g_ = a_ > b_; K[17] = g_ ? a_ : b_; K[19] = g_ ? b_ : a_; }
  { const float a_ = K[20], b_ = K[22]; const bool g_ = a_ > b_; K[20] = g_ ? b_ : a_; K[22] = g_ ? a_ : b_; }
  { const float a_ = K[21], b_ = K[23]; const bool g_ = a_ > b_; K[21] = g_ ? b_ : a_; K[23] = g_ ? a_ : b_; }
  { const float a_ = K[24], b_ = K[26]; const bool g_ = a_ > b_; K[24] = g_ ? a_ : b_; K[26] = g_ ? b_ : a_; }
  { const float a_ = K[25], b_ = K[27]; const bool g_ = a_ > b_; K[25] = g_ ? a_ : b_; K[27] = g_ ? b_ : a_; }
  { const float a_ = K[28], b_ = K[30]; const bool g_ = a_ > b_; K[28] = g_ ? b_ : a_; K[30] = g_ ? a_ : b_; }
  { const float a_ = K[29], b_ = K[31]; const bool g_ = a_ > b_; K[29] = g_ ? b_ : a_; K[31] = g_ ? a_ : b_; }
  { const float a_ = K[16], b_ = K[17]; const bool g_ = a_ > b_; K[16] = g_ ? a_ : b_; K[17] = g_ ? b_ : a_; }
  { const float a_ = K[18], b_ = K[19]; const bool g_ = a_ > b_; K[18] = g_ ? a_ : b_; K[19] = g_ ? b_ : a_; }
  { const float a_ = K[20], b_ = K[21]; const bool g_ = a_ > b_; K[20] = g_ ? b_ : a_; K[21] = g_ ? a_ : b_; }
  { const float a_ = K[22], b_ = K[23]; const bool g_ = a_ > b_; K[22] = g_ ? b_ : a_; K[23] = g_ ? a_ : b_; }
  { const float a_ = K[24], b_ = K[25]; const bool g_ = a_ > b_; K[24] = g_ ? a_ : b_; K[25] = g_ ? b_ : a_; }
  { const float a_ = K[26], b_ = K[27]; const bool g_ = a_ > b_; K[26] = g_ ? a_ : b_; K[27] = g_ ? b_ : a_; }
  { const float a_ = K[28], b_ = K[29]; const bool g_ = a_ > b_; K[28] = g_ ? b_ : a_; K[29] = g_ ? a_ : b_; }
  { const float a_ = K[30], b_ = K[31]; const bool g_ = a_ > b_; K[30] = g_ ? b_ : a_; K[31] = g_ ? a_ : b_; }
  { const float a_ = K[16], b_ = K[20]; const bool g_ = a_ > b_; K[16] = g_ ? a_ : b_; K[20] = g_ ? b_ : a_; }
  { const float a_ = K[17], b_ = K[21]; const bool g_ = a_ > b_; K[17] = g_ ? a_ : b_; K[21] = g_ ? b_ : a_; }
  { const float a_ = K[18], b_ = K[22]; const bool g_ = a_ > b_; K[18] = g_ ? a_ : b_; K[22] = g_ ? b_ : a_; }
  { const float a_ = K[19], b_ = K[23]; const bool g_ = a_ > b_; K[19] = g_ ? a_ : b_; K[23] = g_ ? b_ : a_; }
  { const float a_ = K[24], b_ = K[28]; const bool g_ = a_ > b_; K[24] = g_ ? b_ : a_; K[28] = g_ ? a_ : b_; }
  { const float a_ = K[25], b_ = K[29]; const bool g_ = a_ > b_; K[25] = g_ ? b_ : a_; K[29] = g_ ? a_ : b_; }
  { const float a_ = K[26], b_ = K[30]; const bool g_ = a_ > b_; K[26] = g_ ? b_ : a_; K[30] = g_ ? a_ : b_; }
  { const float a_ = K[27], b_ = K[31]; const bool g_ = a_ > b_; K[27] = g_ ? b_ : a_; K[31] = g_ ? a_ : b_; }
  { const float a_ = K[16], b_ = K[18]; const bool g_ = a_ > b_; K[16] = g_ ? a_ : b_; K[18] = g_ ? b_ : a_; }
  { const float a_ = K[17], b_ = K[19]; const bool g_ = a_ > b_; K[17] = g_ ? a_ : b_; K[19] = g_ ? b_ : a_; }
  { const float a_ = K[20], b_ = K[22]; const bool g_ = a_ > b_; K[20] = g_ ? a_ : b_; K[22] = g_ ? b_ : a_; }
  { const float a_ = K[21], b_ = K[23]; const bool g_ = a_ > b_; K[21] = g_ ? a_ : b_; K[23] = g_ ? b_ : a_; }
  { const float a_ = K[24], b_ = K[26]; const bool g_ = a_ > b_; K[24] = g_ ? b_ : a_; K[26] = g_ ? a_ : b_; }
  { const float a_ = K[25], b_ = K[27]; const bool g_ = a_ > b_; K[25] = g_ ? b_ : a_; K[27] = g_ ? a_ : b_; }
  { const float a_ = K[28], b_ = K[30]; const bool g_ = a_ > b_; K[28] = g_ ? b_ : a_; K[30] = g_ ? a_ : b_; }
  { const float a_ = K[29], b_ = K[31]; const bool g_ = a_ > b_; K[29] = g_ ? b_ : a_; K[31] = g_ ? a_ : b_; }
  { const float a_ = K[16], b_ = K[17]; const bool g_ = a_ > b_; K[16] = g_ ? a_ : b_; K[17] = g_ ? b_ : a_; }
  { const float a_ = K[18], b_ = K[19]; const bool g_ = a_ > b_; K[18] = g_ ? a_ : b_; K[19] = g_ ? b_ : a_; }
  { const float a_ = K[20], b_ = K[21]; const bool g_ = a_ > b_; K[20] = g_ ? a_ : b_; K[21] = g_ ? b_ : a_; }
  { const float a_ = K[22], b_ = K[23]; const bool g_ = a_ > b_; K[22] = g_ ? a_ : b_; K[23] = g_ ? b_ : a_; }
  { const float a_ = K[24], b_ = K[25]; const bool g_ = a_ > b_; K[24] = g_ ? b_ : a_; K[25] = g_ ? a_ : b_; }
  { const float a_ = K[26], b_ = K[27]; const bool g_ = a_ > b_; K[26] = g_ ? b_ : a_; K[27] = g_ ? a_ : b_; }
  { const float a_ = K[28], b_ = K[29]; const bool g_ = a_ > b_; K[28] = g_ ? b_ : a_; K[29] = g_ ? a_ : b_; }
  { const float a_ = K[30], b_ = K[31]; const bool g_ = a_ > b_; K[30] = g_ ? b_ : a_; K[31] = g_ ? a_ : b_; }
  { const float a_ = K[16], b_ = K[24]; const bool g_ = a_ > b_; K[16] = g_ ? a_ : b_; K[24] = g_ ? b_ : a_; }
  { const float a_ = K[17], b_ = K[25]; const bool g_ = a_ > b_; K[17] = g_ ? a_ : b_; K[25] = g_ ? b_ : a_; }
  { const float a_ = K[18], b_ = K[26]; const bool g_ = a_ > b_; K[18] = g_ ? a_ : b_; K[26] = g_ ? b_ : a_; }
  { const float a_ = K[19], b_ = K[27]; const bool g_ = a_ > b_; K[19] = g_ ? a_ : b_; K[27] = g_ ? b_ : a_; }
  { const float a_ = K[20], b_ = K[28]; const bool g_ = a_ > b_; K[20] = g_ ? a_ : b_; K[28] = g_ ? b_ : a_; }
  { const float a_ = K[21], b_ = K[29]; const bool g_ = a_ > b_; K[21] = g_ ? a_ : b_; K[29] = g_ ? b_ : a_; }
  { const float a_ = K[22], b_ = K[30]; const bool g_ = a_ > b_; K[22] = g_ ? a_ : b_; K[30] = g_ ? b_ : a_; }
  { const float a_ = K[23], b_ = K[31]; const bool g_ = a_ > b_; K[23] = g_ ? a_ : b_; K[31] = g_ ? b_ : a_; }
  { const float a_ = K[16], b_ = K[20]; const bool g_ = a_ > b_; K[16] = g_ ? a_ : b_; K[20] = g_ ? b_ : a_; }
  { const float a_ = K[17], b_ = K[21]; const bool g_ = a_ > b_; K[17] = g_ ? a_ : b_; K[21] = g_ ? b_ : a_; }
  { const float a_ = K[18], b_ = K[22]; const bool g_ = a_ > b_; K[18] = g_ ? a_ : b_; K[22] = g_ ? b_ : a_; }
  { const float a_ = K[19], b_ = K[23]; const bool g_ = a_ > b_; K[19] = g_ ? a_ : b_; K[23] = g_ ? b_ : a_; }
  { const float a_ = K[24], b_ = K[28]; const bool g_ = a_ > b_; K[24] = g_ ? a_ : b_; K[28] = g_ ? b_ : a_; }
  { const float a_ = K[25], b_ = K[29]; const bool g_ = a_ > b_; K[25] = g_ ? a_ : b_; K[29] = g_ ? b_ : a_; }
  { const float a_ = K[26], b_ = K[30]; const bool g_ = a_ > b_; K[26] = g_ ? a_ : b_; K[30] = g_ ? b_ : a_; }
  { const float a_ = K[27], b_ = K[31]; const bool g_ = a_ > b_; K[27] = g_ ? a_ : b_; K[31] = g_ ? b_ : a_; }
  { const float a_ = K[16], b_ = K[18]; const bool g_ = a_ > b_; K[16] = g_ ? a_ : b_; K[18] = g_ ? b_ : a_; }
  { const float a_ = K[17], b_ = K[19]; const bool g_ = a_ > b_; K[17] = g_ ? a_ : b_; K[19] = g_ ? b_ : a_; }
  { const float a_ = K[20], b_ = K[22]; const bool g_ = a_ > b_; K[20] = g_ ? a_ : b_; K[22] = g_ ? b_ : a_; }
  { const float a_ = K[21], b_ = K[23]; const bool g_ = a_ > b_; K[21] = g_ ? a_ : b_; K[23] = g_ ? b_ : a_; }
  { const float a_ = K[24], b_ = K[26]; const bool g_ = a_ > b_; K[24] = g_ ? a_ : b_; K[26] = g_ ? b_ : a_; }
  { const float a_ = K[25], b_ = K[27]; const bool g_ = a_ > b_; K[25] = g_ ? a_ : b_; K[27] = g_ ? b_ : a_; }
  { const float a_ = K[28], b_ = K[30]; const bool g_ = a_ > b_; K[28] = g_ ? a_ : b_; K[30] = g_ ? b_ : a_; }
  { const float a_ = K[29], b_ = K[31]; const bool g_ = a_ > b_; K[29] = g_ ? a_ : b_; K[31] = g_ ? b_ : a_; }
  { const float a_ = K[16], b_ = K[17]; const bool g_ = a_ > b_; K[16] = g_ ? a_ : b_; K[17] = g_ ? b_ : a_; }
  { const float a_ = K[18], b_ = K[19]; const bool g_ = a_ > b_; K[18] = g_ ? a_ : b_; K[19] = g_ ? b_ : a_; }
  { const float a_ = K[20], b_ = K[21]; const bool g_ = a_ > b_; K[20] = g_ ? a_ : b_; K[21] = g_ ? b_ : a_; }
  { const float a_ = K[22], b_ = K[23]; const bool g_ = a_ > b_; K[22] = g_ ? a_ : b_; K[23] = g_ ? b_ : a_; }
  { const float a_ = K[24], b_ = K[25]; const bool g_ = a_ > b_; K[24] = g_ ? a_ : b_; K[25] = g_ ? b_ : a_; }
  { const float a_ = K[26], b_ = K[27]; const bool g_ = a_ > b_; K[26] = g_ ? a_ : b_; K[27] = g_ ? b_ : a_; }
  { const float a_ = K[28], b_ = K[29]; const bool g_ = a_ > b_; K[28] = g_ ? a_ : b_; K[29] = g_ ? b_ : a_; }
  { const float a_ = K[30], b_ = K[31]; const bool g_ = a_ > b_; K[30] = g_ ? a_ : b_; K[31] = g_ ? b_ : a_; }
  { const float a_ = K[32], b_ = K[33]; const bool g_ = a_ > b_; K[32] = g_ ? a_ : b_; K[33] = g_ ? b_ : a_; }
  { const float a_ = K[34], b_ = K[35]; const bool g_ = a_ > b_; K[34] = g_ ? b_ : a_; K[35] = g_ ? a_ : b_; }
  { const float a_ = K[36], b_ = K[37]; const bool g_ = a_ > b_; K[36] = g_ ? a_ : b_; K[37] = g_ ? b_ : a_; }
  { const float a_ = K[38], b_ = K[39]; const bool g_ = a_ > b_; K[38] = g_ ? b_ : a_; K[39] = g_ ? a_ : b_; }
  { const float a_ = K[40], b_ = K[41]; const bool g_ = a_ > b_; K[40] = g_ ? a_ : b_; K[41] = g_ ? b_ : a_; }
  { const float a_ = K[42], b_ = K[43]; const bool g_ = a_ > b_; K[42] = g_ ? b_ : a_; K[43] = g_ ? a_ : b_; }
  { const float a_ = K[44], b_ = K[45]; const bool g_ = a_ > b_; K[44] = g_ ? a_ : b_; K[45] = g_ ? b_ : a_; }
  { const float a_ = K[46], b_ = K[47]; const bool g_ = a_ > b_; K[46] = g_ ? b_ : a_; K[47] = g_ ? a_ : b_; }
  { const float a_ = K[32], b_ = K[34]; const bool g_ = a_ > b_; K[32] = g_ ? a_ : b_; K[34] = g_ ? b_ : a_; }
  { const float a_ = K[33], b_ = K[35]; const bool g_ = a_ > b_; K[33] = g_ ? a_ : b_; K[35] = g_ ? b_ : a_; }
  { const float a_ = K[36], b_ = K[38]; const bool g_ = a_ > b_; K[36] = g_ ? b_ : a_; K[38] = g_ ? a_ : b_; }
  { const float a_ = K[37], b_ = K[39]; const bool g_ = a_ > b_; K[37] = g_ ? b_ : a_; K[39] = g_ ? a_ : b_; }
  { const float a_ = K[40], b_ = K[42]; const bool g_ = a_ > b_; K[40] = g_ ? a_ : b_; K[42] = g_ ? b_ : a_; }
  { const float a_ = K[41], b_ = K[43]; const bool g_ = a_ > b_; K[41] = g_ ? a_ : b_; K[43] = g_ ? b_ : a_; }
  { const float a_ = K[44], b_ = K[46]; const bool g_ = a_ > b_; K[44] = g_ ? b_ : a_; K[46] = g_ ? a_ : b_; }
  { const float a_ = K[45], b_ = K[47]; const bool g_ = a_ > b_; K[45] = g_ ? b_ : a_; K[47] = g_ ? a_ : b_; }
  { const float a_ = K[32], b_ = K[33]; const bool g_ = a_ > b_; K[32] = g_ ? a_ : b_; K[33] = g_ ? b_ : a_; }
  { const float a_ = K[34], b_ = K[35]; const bool g_ = a_ > b_; K[34] = g_ ? a_ : b_; K[35] = g_ ? b_ : a_; }
  { const float a_ = K[36], b_ = K[37]; const bool g_ = a_ > b_; K[36] = g_ ? b_ : a_; K[37] = g_ ? a_ : b_; }
  { const float a_ = K[38], b_ = K[39]; const bool g_ = a_ > b_; K[38] = g_ ? b_ : a_; K[39] = g_ ? a_ : b_; }
  { const float a_ = K[40], b_ = K[41]; const bool g_ = a_ > b_; K[40] = g_ ? a_ : b_; K[41] = g_ ? b_ : a_; }
  { const float a_ = K[42], b_ = K[43]; const bool g_ = a_ > b_; K[42] = g_ ? a_ : b_; K[43] = g_ ? b_ : a_; }
  { const float a_ = K[44], b_ = K[45]; const bool g_ = a_ > b_; K[44] = g_ ? b_ : a_; K[45] = g_ ? a_ : b_; }
  { const float a_ = K[46], b_ = K[47]; const bool g_ = a_ > b_; K[46] = g_ ? b_ : a_; K[47] = g_ ? a_ : b_; }
  { const float a_ = K[32], b_ = K[36]; const bool g_ = a_ > b_; K[32] = g_ ? a_ : b_; K[36] = g_ ? b_ : a_; }
  { const float a_ = K[33], b_ = K[37]; const bool g_ = a_ > b_; K[33] = g_ ? a_ : b_; K[37] = g_ ? b_ : a_; }
  { const float a_ = K[34], b_ = K[38]; const bool g_ = a_ > b_; K[34] = g_ ? a_ : b_; K[38] = g_ ? b_ : a_; }
  { const float a_ = K[35], b_ = K[39]; const bool g_ = a_ > b_; K[35] = g_ ? a_ : b_; K[39] = g_ ? b_ : a_; }
  { const float a_ = K[40], b_ = K[44]; const bool g_ = a_ > b_; K[40] = g_ ? b_ : a_; K[44] = g_ ? a_ : b_; }
  { const float a_ = K[41], b_ = K[45]; const bool g_ = a_ > b_; K[41] = g_ ? b_ : a_; K[45] = g_ ? a_ : b_; }
  { const float a_ = K[42], b_ = K[46]; const bool g_ = a_ > b_; K[42] = g_ ? b_ : a_; K[46] = g_ ? a_ : b_; }
  { const float a_ = K[43], b_ = K[47]; const bool g_ = a_ > b_; K[43] = g_ ? b_ : a_; K[47] = g_ ? a_ : b_; }
  { const float a_ = K[32], b_ = K[34]; const bool g_ = a_ > b_; K[32] = g_ ? a_ : b_; K[34] = g_ ? b_ : a_; }
  { const float a_ = K[33], b_ = K[35]; const bool g_ = a_ > b_; K[33] = g_ ? a_ : b_; K[35] = g_ ? b_ : a_; }
  { const float a_ = K[36], b_ = K[38]; const bool g_ = a_ > b_; K[36] = g_ ? a_ : b_; K[38] = g_ ? b_ : a_; }
  { const float a_ = K[37], b_ = K[39]; const bool g_ = a_ > b_; K[37] = g_ ? a_ : b_; K[39] = g_ ? b_ : a_; }
  { const float a_ = K[40], b_ = K[42]; const bool g_ = a_ > b_; K[40] = g_ ? b_ : a_; K[42] = g_ ? a_ : b_; }
  { const float a_ = K[41], b_ = K[43]; const bool g_ = a_ > b_; K[41] = g_ ? b_ : a_; K[43] = g_ ? a_ : b_; }
  { const float a_ = K[44], b_ = K[46]; const bool g_ = a_ > b_; K[44] = g_ ? b_ : a_; K[46] = g_ ? a_ : b_; }
  { const float a_ = K[45], b_ = K[47]; const bool g_ = a_ > b_; K[45] = g_ ? b_ : a_; K[47] = g_ ? a_ : b_; }
  { const float a_ = K[32], b_ = K[33]; const bool g_ = a_ > b_; K[32] = g_ ? a_ : b_; K[33] = g_ ? b_ : a_; }
  { const float a_ = K[34], b_ = K[35]; const bool g_ = a_ > b_; K[34] = g_ ? a_ : b_; K[35] = g_ ? b_ : a_; }
  { const float a_ = K[36], b_ = K[37]; const bool g_ = a_ > b_; K[36] = g_ ? a_ : b_; K[37] = g_ ? b_ : a_; }
  { const float a_ = K[38], b_ = K[39]; const bool g_ = a_ > b_; K[38] = g_ ? a_ : b_; K[39] = g_ ? b_ : a_; }
  { const float a_ = K[40], b_ = K[41]; const bool g_ = a_ > b_; K[40] = g_ ? b_ : a_; K[41] = g_ ? a_ : b_; }
  { const float a_ = K[42], b_ = K[43]; const bool g_ = a_ > b_; K[42] = g_ ? b_ : a_; K[43] = g_ ? a_ : b_; }
  { const float a_ = K[44], b_ = K[45]; const bool g_ = a_ > b_; K[44] = g_ ? b_ : a_; K[45] = g_ ? a_ : b_; }
  { const float a_ = K[46], b_ = K[47]; const bool g_ = a_ > b_; K[46] = g_ ? b_ : a_; K[47] = g_ ? a_ : b_; }
  { const float a_ = K[32], b_ = K[40]; const bool g_ = a_ > b_; K[32] = g_ ? a_ : b_; K[40] = g_ ? b_ : a_; }
  { const float a_ = K[33], b_ = K[41]; const bool g_ = a_ > b_; K[33] = g_ ? a_ : b_; K[41] = g_ ? b_ : a_; }
  { const float a_ = K[34], b_ = K[42]; const bool g_ = a_ > b_; K[34] = g_ ? a_ : b_; K[42] = g_ ? b_ : a_; }
  { const float a_ = K[35], b_ = K[43]; const bool g_ = a_ > b_; K[35] = g_ ? a_ : b_; K[43] = g_ ? b_ : a_; }
  { const float a_ = K[36], b_ = K[44]; const bool g_ = a_ > b_; K[36] = g_ ? a_ : b_; K[44] = g_ ? b_ : a_; }
  { const float a_ = K[37], b_ = K[45]; const bool g_ = a_ > b_; K[37] = g_ ? a_ : b_; K[45] = g_ ? b_ : a_; }
  { const float a_ = K[38], b_ = K[46]; const bool g_ = a_ > b_; K[38] = g_ ? a_ : b_; K[46] = g_ ? b_ : a_; }
  { const float a_ = K[39], b_ = K[47]; const bool g_ = a_ > b_; K[39] = g_ ? a_ : b_; K[47] = g_ ? b_ : a_; }
  { const float a_ = K[32], b_ = K[36]; const bool g_ = a_ > b_; K[32] = g_ ? a_ : b_; K[36] = g_ ? b_ : a_; }
  { const float a_ = K[33], b_ = K[37]; const bool g_ = a_ > b_; K[33] = g_ ? a_ : b_; K[37] = g_ ? b_ : a_; }
  { const float a_ = K[34], b_ = K[38]; const bool g_ = a_ > b_; K[34] = g_ ? a_ : b_; K[38] = g_ ? b_ : a_; }
  { const float a_ = K[35], b_ = K[39]; const bool g_ = a_ > b_; K[35] = g_ ? a_ : b_; K[39] = g_ ? b_ : a_; }
  { const float a_ = K[40], b_ = K[44]; const bool g_ = a_ > b_; K[40] = g_ ? a_ : b_; K[44] = g_ ? b_ : a_; }
  { const float a_ = K[41], b_ = K[45]; const bool g_ = a_ > b_; K[41] = g_ ? a_ : b_; K[45] = g_ ? b_ : a_; }
  { const float a_ = K[42], b_ = K[46]; const bool g_ = a_ > b_; K[42] = g_ ? a_ : b_; K[46] = g_ ? b_ : a_; }
  { const float a_ = K[43], b_ = K[47]; const bool g_ = a_ > b_; K[43] = g_ ? a_ : b_; K[47] = g_ ? b_ : a_; }
  { const float a_ = K[32], b_ = K[34]; const bool g_ = a_ > b_; K[32] = g_ ? a_ : b_; K[34] = g_ ? b_ : a_; }
  { const float a_ = K[33], b_ = K[35]; const bool g_ = a_ > b_; K[33] = g_ ? a_ : b_; K[35] = g_ ? b_ : a_; }
  { const float a_ = K[36], b_ = K[38]; const bool g_ = a_ > b_; K[36] = g_ ? a_ : b_; K[38] = g_ ? b_ : a_; }
  { const float a_ = K[37], b_ = K[39]; const bool g_ = a_ > b_; K[37] = g_ ? a_ : b_; K[39] = g_ ? b_ : a_; }
  { const float a_ = K[40], b_ = K[42]; const bool g_ = a_ > b_; K[40] = g_ ? a_ : b_; K[42] = g_ ? b_ : a_; }
  { const float a_ = K[41], b_ = K[43]; const bool g_ = a_ > b_; K[41] = g_ ? a_ : b_; K[43] = g_ ? b_ : a_; }
  { const float a_ = K[44], b_ = K[46]; const bool g_ = a_ > b_; K[44] = g_ ? a_ : b_; K[46] = g_ ? b_ : a_; }
  { const float a_ = K[45], b_ = K[47]; const bool g_ = a_ > b_; K[45] = g_ ? a_ : b_; K[47] = g_ ? b_ : a_; }
  { const float a_ = K[32], b_ = K[33]; const bool g_ = a_ > b_; K[32] = g_ ? a_ : b_; K[33] = g_ ? b_ : a_; }
  { const float a_ = K[34], b_ = K[35]; const bool g_ = a_ > b_; K[34] = g_ ? a_ : b_; K[35] = g_ ? b_ : a_; }
  { const float a_ = K[36], b_ = K[37]; const bool g_ = a_ > b_; K[36] = g_ ? a_ : b_; K[37] = g_ ? b_ : a_; }
  { const float a_ = K[38], b_ = K[39]; const bool g_ = a_ > b_; K[38] = g_ ? a_ : b_; K[39] = g_ ? b_ : a_; }
  { const float a_ = K[40], b_ = K[41]; const bool g_ = a_ > b_; K[40] = g_ ? a_ : b_; K[41] = g_ ? b_ : a_; }
  { const float a_ = K[42], b_ = K[43]; const bool g_ = a_ > b_; K[42] = g_ ? a_ : b_; K[43] = g_ ? b_ : a_; }
  { const float a_ = K[44], b_ = K[45]; const bool g_ = a_ > b_; K[44] = g_ ? a_ : b_; K[45] = g_ ? b_ : a_; }
  { const float a_ = K[46], b_ = K[47]; const bool g_ = a_ > b_; K[46] = g_ ? a_ : b_; K[47] = g_ ? b_ : a_; }
  { const float a_ = K[48], b_ = K[49]; const bool g_ = a_ > b_; K[48] = g_ ? a_ : b_; K[49] = g_ ? b_ : a_; }
  { const float a_ = K[50], b_ = K[51]; const bool g_ = a_ > b_; K[50] = g_ ? b_ : a_; K[51] = g_ ? a_ : b_; }
  { const float a_ = K[52], b_ = K[53]; const bool g_ = a_ > b_; K[52] = g_ ? a_ : b_; K[53] = g_ ? b_ : a_; }
  { const float a_ = K[54], b_ = K[55]; const bool g_ = a_ > b_; K[54] = g_ ? b_ : a_; K[55] = g_ ? a_ : b_; }
  { const float a_ = K[56], b_ = K[57]; const bool g_ = a_ > b_; K[56] = g_ ? a_ : b_; K[57] = g_ ? b_ : a_; }
  { const float a_ = K[58], b_ = K[59]; const bool g_ = a_ > b_; K[58] = g_ ? b_ : a_; K[59] = g_ ? a_ : b_; }
  { const float a_ = K[60], b_ = K[61]; const bool g_ = a_ > b_; K[60] = g_ ? a_ : b_; K[61] = g_ ? b_ : a_; }
  { const float a_ = K[62], b_ = K[63]; const bool g_ = a_ > b_; K[62] = g_ ? b_ : a_; K[63] = g_ ? a_ : b_; }
  { const float a_ = K[48], b_ = K[50]; const bool g_ = a_ > b_; K[48] = g_ ? a_ : b_; K[50] = g_ ? b_ : a_; }
  { const float a_ = K[49], b_ = K[51]; const bool g_ = a_ > b_; K[49] = g_ ? a_ : b_; K[51] = g_ ? b_ : a_; }
  { const float a_ = K[52], b_ = K[54]; const bool g_ = a_ > b_; K[52] = g_ ? b_ : a_; K[54] = g_ ? a_ : b_; }
  { const float a_ = K[53], b_ = K[55]; const bool g_ = a_ > b_; K[53] = g_ ? b_ : a_; K[55] = g_ ? a_ : b_; }
  { const float a_ = K[56], b_ = K[58]; const bool g_ = a_ > b_; K[56] = g_ ? a_ : b_; K[58] = g_ ? b_ : a_; }
  { const float a_ = K[57], b_ = K[59]; const bool g_ = a_ > b_; K[57] = g_ ? a_ : b_; K[59] = g_ ? b_ : a_; }
  { const float a_ = K[60], b_ = K[62]; const bool g_ = a_ > b_; K[60] = g_ ? b_ : a_; K[62] = g_ ? a_ : b_; }
  { const float a_ = K[61], b_ = K[63]; const bool g_ = a_ > b_; K[61] = g_ ? b_ : a_; K[63] = g_ ? a_ : b_; }
  { const float a_ = K[48], b_ = K[49]; const bool g_ = a_ > b_; K[48] = g_ ? a_ : b_; K[49] = g_ ? b_ : a_; }
  { const float a_ = K[50], b_ = K[51]; const bool g_ = a_ > b_; K[50] = g_ ? a_ : b_; K[51] = g_ ? b_ : a_; }
  { const float a_ = K[52], b_ = K[53]; const bool g_ = a_ > b_; K[52] = g_ ? b_ : a_; K[53] = g_ ? a_ : b_; }
  { const float a_ = K[54], b_ = K[55]; const bool g_ = a_ > b_; K[54] = g_ ? b_ : a_; K[55] = g_ ? a_ : b_; }
  { const float a_ = K[56], b_ = K[57]; const bool g_ = a_ > b_; K[56] = g_ ? a_ : b_; K[57] = g_ ? b_ : a_; }
  { const float a_ = K[58], b_ = K[59]; const bool g_ = a_ > b_; K[58] = g_ ? a_ : b_; K[59] = g_ ? b_ : a_; }
  { const float a_ = K[60], b_ = K[61]; const bool g_ = a_ > b_; K[60] = g_ ? b_ : a_; K[61] = g_ ? a_ : b_; }
  { const float a_ = K[62], b_ = K[63]; const bool g_ = a_ > b_; K[62] = g_ ? b_ : a_; K[63] = g_ ? a_ : b_; }
  { const float a_ = K[48], b_ = K[52]; const bool g_ = a_ > b_; K[48] = g_ ? a_ : b_; K[52] = g_ ? b_ : a_; }
  { const float a_ = K[49], b_ = K[53]; const bool g_ = a_ > b_; K[49] = g_ ? a_ : b_; K[53] = g_ ? b_ : a_; }
  { const float a_ = K[50], b_ = K[54]; const bool g_ = a_ > b_; K[50] = g_ ? a_ : b_; K[54] = g_ ? b_ : a_; }
  { const float a_ = K[51], b_ = K[55]; const bool g_ = a_ > b_; K[51] = g_ ? a_ : b_; K[55] = g_ ? b_ : a_; }
  { const float a_ = K[56], b_ = K[60]; const bool g_ = a_ > b_; K[56] = g_ ? b_ : a_; K[60] = g_ ? a_ : b_; }
  { const float a_ = K[57], b_ = K[61]; const bool g_ = a_ > b_; K[57] = g_ ? b_ : a_; K[61] = g_ ? a_ : b_; }
  { const float a_ = K[58], b_ = K[62]; const bool g_ = a_ > b_; K[58] = g_ ? b_ : a_; K[62] = g_ ? a_ : b_; }
  { const float a_ = K[59], b_ = K[63]; const bool g_ = a_ > b_; K[59] = g_ ? b_ : a_; K[63] = g_ ? a_ : b_; }
  { const float a_ = K[48], b_ = K[50]; const bool g_ = a_ > b_; K[48] = g_ ? a_ : b_; K[50] = g_ ? b_ : a_; }
  { const float a_ = K[49], b_ = K[51]; const bool g_ = a_ > b_; K[49] = g_ ? a_ : b_; K[51] = g_ ? b_ : a_; }
  { const float a_ = K[52], b_ = K[54]; const bool g_ = a_ > b_; K[52] = g_ ? a_ : b_; K[54] = g_ ? b_ : a_; }
  { const float a_ = K[53], b_ = K[55]; const bool g_ = a_ > b_; K[53] = g_ ? a_ : b_; K[55] = g_ ? b_ : a_; }
  { const float a_ = K[56], b_ = K[58]; const bool g_ = a_ > b_; K[56] = g_ ? b_ : a_; K[58] = g_ ? a_ : b_; }
  { const float a_ = K[57], b_ = K[59]; const bool g_ = a_ > b_; K[57] = g_ ? b_ : a_; K[59] = g_ ? a_ : b_; }
  { const float a_ = K[60], b_ = K[62]; const bool g_ = a_ > b_; K[60] = g_ ? b_ : a_; K[62] = g_ ? a_ : b_; }
  { const float a_ = K[61], b_ = K[63]; const bool g_ = a_ > b_; K[61] = g_ ? b_ : a_; K[63] = g_ ? a_ : b_; }
  { const float a_ = K[48], b_ = K[49]; const bool g_ = a_ > b_; K[48] = g_ ? a_ : b_; K[49] = g_ ? b_ : a_; }
  { const float a_ = K[50], b_ = K[51]; const bool g_ = a_ > b_; K[50] = g_ ? a_ : b_; K[51] = g_ ? b_ : a_; }
  { const float a_ = K[52], b_ = K[53]; const bool g_ = a_ > b_; K[52] = g_ ? a_ : b_; K[53] = g_ ? b_ : a_; }
  { const float a_ = K[54], b_ = K[55]; const bool g_ = a_ > b_; K[54] = g_ ? a_ : b_; K[55] = g_ ? b_ : a_; }
  { const float a_ = K[56], b_ = K[57]; const bool g_ = a_ > b_; K[56] = g_ ? b_ : a_; K[57] = g_ ? a_ : b_; }
  { const float a_ = K[58], b_ = K[59]; const bool g_ = a_ > b_; K[58] = g_ ? b_ : a_; K[59] = g_ ? a_ : b_; }
  { const float a_ = K[60], b_ = K[61]; const bool g_ = a_ > b_; K[60] = g_ ? b_ : a_; K[61] = g_ ? a_ : b_; }
  { const float a_ = K[62], b_ = K[63]; const bool g_ = a_ > b_; K[62] = g_ ? b_ : a_; K[63] = g_ ? a_ : b_; }
  { const float a_ = K[48], b_ = K[56]; const bool g_ = a_ > b_; K[48] = g_ ? a_ : b_; K[56] = g_ ? b_ : a_; }
  { const float a_ = K[49], b_ = K[57]; const bool g_ = a_ > b_; K[49] = g_ ? a_ : b_; K[57] = g_ ? b_ : a_; }
  { const float a_ = K[50], b_ = K[58]; const bool g_ = a_ > b_; K[50] = g_ ? a_ : b_; K[58] = g_ ? b_ : a_; }
  { const float a_ = K[51], b_ = K[59]; const bool g_ = a_ > b_; K[51] = g_ ? a_ : b_; K[59] = g_ ? b_ : a_; }
  { const float a_ = K[52], b_ = K[60]; const bool g_ = a_ > b_; K[52] = g_ ? a_ : b_; K[60] = g_ ? b_ : a_; }
  { const float a_ = K[53], b_ = K[61]; const bool g_ = a_ > b_; K[53] = g_ ? a_ : b_; K[61] = g_ ? b_ : a_; }
  { const float a_ = K[54], b_ = K[62]; const bool g_ = a_ > b_; K[54] = g_ ? a_ : b_; K[62] = g_ ? b_ : a_; }
  { const float a_ = K[55], b_ = K[63]; const bool g_ = a_ > b_; K[55] = g_ ? a_ : b_; K[63] = g_ ? b_ : a_; }
  { const float a_ = K[48], b_ = K[52]; const bool g_ = a_ > b_; K[48] = g_ ? a_ : b_; K[52] = g_ ? b_ : a_; }
  { const float a_ = K[49], b_ = K[53]; const bool g_ = a_ > b_; K[49] = g_ ? a_ : b_; K[53] = g_ ? b_ : a_; }
  { const float a_ = K[50], b_ = K[54]; const bool g_ = a_ > b_; K[50] = g_ ? a_ : b_; K[54] = g_ ? b_ : a_; }
  { const float a_ = K[51], b_ = K[55]; const bool g_ = a_ > b_; K[51] = g_ ? a_ : b_; K[55] = g_ ? b_ : a_; }
  { const float a_ = K[56], b_ = K[60]; const bool g_ = a_ > b_; K[56] = g_ ? a_ : b_; K[60] = g_ ? b_ : a_; }
  { const float a_ = K[57], b_ = K[61]; const bool g_ = a_ > b_; K[57] = g_ ? a_ : b_; K[61] = g_ ? b_ : a_; }
  { const float a_ = K[58], b_ = K[62]; const bool g_ = a_ > b_; K[58] = g_ ? a_ : b_; K[62] = g_ ? b_ : a_; }
  { const float a_ = K[59], b_ = K[63]; const bool g_ = a_ > b_; K[59] = g_ ? a_ : b_; K[63] = g_ ? b_ : a_; }
  { const float a_ = K[48], b_ = K[50]; const bool g_ = a_ > b_; K[48] = g_ ? a_ : b_; K[50] = g_ ? b_ : a_; }
  { const float a_ = K[49], b_ = K[51]; const bool g_ = a_ > b_; K[49] = g_ ? a_ : b_; K[51] = g_ ? b_ : a_; }
  { const float a_ = K[52], b_ = K[54]; const bool g_ = a_ > b_; K[52] = g_ ? a_ : b_; K[54] = g_ ? b_ : a_; }
  { const float a_ = K[53], b_ = K[55]; const bool g_ = a_ > b_; K[53] = g_ ? a_ : b_; K[55] = g_ ? b_ : a_; }
  { const float a_ = K[56], b_ = K[58]; const bool g_ = a_ > b_; K[56] = g_ ? a_ : b_; K[58] = g_ ? b_ : a_; }
  { const float a_ = K[57], b_ = K[59]; const bool g_ = a_ > b_; K[57] = g_ ? a_ : b_; K[59] = g_ ? b_ : a_; }
  { const float a_ = K[60], b_ = K[62]; const bool g_ = a_ > b_; K[60] = g_ ? a_ : b_; K[62] = g_ ? b_ : a_; }
  { const float a_ = K[61], b_ = K[63]; const bool g_ = a_ > b_; K[61] = g_ ? a_ : b_; K[63] = g_ ? b_ : a_; }
  { const float a_ = K[48], b_ = K[49]; const bool g_ = a_ > b_; K[48] = g_ ? a_ : b_; K[49] = g_ ? b_ : a_; }
  { const float a_ = K[50], b_ = K[51]; const bool g_ = a_ > b_; K[50] = g_ ? a_ : b_; K[51] = g_ ? b_ : a_; }
  { const float a_ = K[52], b_ = K[53]; const bool g_ = a_ > b_; K[52] = g_ ? a_ : b_; K[53] = g_ ? b_ : a_; }
  { const float a_ = K[54], b_ = K[55]; const bool g_ = a_ > b_; K[54] = g_ ? a_ : b_; K[55] = g_ ? b_ : a_; }
  { const float a_ = K[56], b_ = K[57]; const bool g_ = a_ > b_; K[56] = g_ ? a_ : b_; K[57] = g_ ? b_ : a_; }
  { const float a_ = K[58], b_ = K[59]; const bool g_ = a_ > b_; K[58] = g_ ? a_ : b_; K[59] = g_ ? b_ : a_; }
  { const float a_ = K[60], b_ = K[61]; const bool g_ = a_ > b_; K[60] = g_ ? a_ : b_; K[61] = g_ ? b_ : a_; }
  { const float a_ = K[62], b_ = K[63]; const bool g_ = a_ > b_; K[62] = g_ ? a_ : b_; K[63] = g_ ? b_ : a_; }
  { const float a_ = K[0], b_ = K[31]; K[0] = a_ > b_ ? a_ : b_; }
  { const float a_ = K[1], b_ = K[30]; K[1] = a_ > b_ ? a_ : b_; }
  { const float a_ = K[2], b_ = K[29]; K[2] = a_ > b_ ? a_ : b_; }
  { const float a_ = K[3], b_ = K[28]; K[3] = a_ > b_ ? a_ : b_; }
  { const float a_ = K[4], b_ = K[27]; K[4] = a_ > b_ ? a_ : b_; }
  { const float a_ = K[5], b_ = K[26]; K[5] = a_ > b_ ? a_ : b_; }
  { const float a_ = K[6], b_ = K[25]; K[6] = a_ > b_ ? a_ : b_; }
  { const float a_ = K[7], b_ = K[24]; K[7] = a_ > b_ ? a_ : b_; }
  { const float a_ = K[8], b_ = K[23]; K[8] = a_ > b_ ? a_ : b_; }
  { const float a_ = K[9], b_ = K[22]; K[9] = a_ > b_ ? a_ : b_; }
  { const float a_ = K[10], b_ = K[21]; K[10] = a_ > b_ ? a_ : b_; }
  { const float a_ = K[11], b_ = K[20]; K[11] = a_ > b_ ? a_ : b_; }
  { const float a_ = K[12], b_ = K[19]; K[12] = a_ > b_ ? a_ : b_; }
  { const float a_ = K[13], b_ = K[18]; K[13] = a_ > b_ ? a_ : b_; }
  { const float a_ = K[14], b_ = K[17]; K[14] = a_ > b_ ? a_ : b_; }
  { const float a_ = K[15], b_ = K[16]; K[15] = a_ > b_ ? a_ : b_; }
  { const float a_ = K[0], b_ = K[8]; const bool g_ = a_ > b_; K[0] = g_ ? a_ : b_; K[8] = g_ ? b_ : a_; }
  { const float a_ = K[1], b_ = K[9]; const bool g_ = a_ > b_; K[1] = g_ ? a_ : b_; K[9] = g_ ? b_ : a_; }
  { const float a_ = K[2], b_ = K[10]; const bool g_ = a_ > b_; K[2] = g_ ? a_ : b_; K[10] = g_ ? b_ : a_; }
  { const float a_ = K[3], b_ = K[11]; const bool g_ = a_ > b_; K[3] = g_ ? a_ : b_; K[11] = g_ ? b_ : a_; }
  { const float a_ = K[4], b_ = K[12]; const bool g_ = a_ > b_; K[4] = g_ ? a_ : b_; K[12] = g_ ? b_ : a_; }
  { const float a_ = K[5], b_ = K[13]; const bool g_ = a_ > b_; K[5] = g_ ? a_ : b_; K[13] = g_ ? b_ : a_; }
  { const float a_ = K[6], b_ = K[14]; const bool g_ = a_ > b_; K[6] = g_ ? a_ : b_; K[14] = g_ ? b_ : a_; }
  { const float a_ = K[7], b_ = K[15]; const bool g_ = a_ > b_; K[7] = g_ ? a_ : b_; K[15] = g_ ? b_ : a_; }
  { const float a_ = K[0], b_ = K[4]; const bool g_ = a_ > b_; K[0] = g_ ? a_ : b_; K[4] = g_ ? b_ : a_; }
  { const float a_ = K[1], b_ = K[5]; const bool g_ = a_ > b_; K[1] = g_ ? a_ : b_; K[5] = g_ ? b_ : a_; }
  { const float a_ = K[2], b_ = K[6]; const bool g_ = a_ > b_; K[2] = g_ ? a_ : b_; K[6] = g_ ? b_ : a_; }
  { const float a_ = K[3], b_ = K[7]; const bool g_ = a_ > b_; K[3] = g_ ? a_ : b_; K[7] = g_ ? b_ : a_; }
  { const float a_ = K[8], b_ = K[12]; const bool g_ = a_ > b_; K[8] = g_ ? a_ : b_; K[12] = g_ ? b_ : a_; }
  { const float a_ = K[9], b_ = K[13]; const bool g_ = a_ > b_; K[9] = g_ ? a_ : b_; K[13] = g_ ? b_ : a_; }
  { const float a_ = K[10], b_ = K[14]; const bool g_ = a_ > b_; K[10] = g_ ? a_ : b_; K[14] = g_ ? b_ : a_; }
  { const float a_ = K[11], b_ = K[15]; const bool g_ = a_ > b_; K[11] = g_ ? a_ : b_; K[15] = g_ ? b_ : a_; }
  { const float a_ = K[0], b_ = K[2]; const bool g_ = a_ > b_; K[0] = g_ ? a_ : b_; K[2] = g_ ? b_ : a_; }
  { const float a_ = K[1], b_ = K[3]; const bool g_ = a_ > b_; K[1] = g_ ? a_ : b_; K[3] = g_ ? b_ : a_; }
  { const float a_ = K[4], b_ = K[6]; const bool g_ = a_ > b_; K[4] = g_ ? a_ : b_; K[6] = g_ ? b_ : a_; }
  { const float a_ = K[5], b_ = K[7]; const bool g_ = a_ > b_; K[5] = g_ ? a_ : b_; K[7] = g_ ? b_ : a_; }
  { const float a_ = K[8], b_ = K[10]; const bool g_ = a_ > b_; K[8] = g_ ? a_ : b_; K[10] = g_ ? b_ : a_; }
  { const float a_ = K[9], b_ = K[11]; const bool g_ = a_ > b_; K[9] = g_ ? a_ : b_; K[11] = g_ ? b_ : a_; }
  { const float a_ = K[12], b_ = K[14]; const bool g_ = a_ > b_; K[12] = g_ ? a_ : b_; K[14] = g_ ? b_ : a_; }
  { const float a_ = K[13], b_ = K[15]; const bool g_ = a_ > b_; K[13] = g_ ? a_ : b_; K[15] = g_ ? b_ : a_; }
  { const float a_ = K[0], b_ = K[1]; const bool g_ = a_ > b_; K[0] = g_ ? a_ : b_; K[1] = g_ ? b_ : a_; }
  { const float a_ = K[2], b_ = K[3]; const bool g_ = a_ > b_; K[2] = g_ ? a_ : b_; K[3] = g_ ? b_ : a_; }
  { const float a_ = K[4], b_ = K[5]; const bool g_ = a_ > b_; K[4] = g_ ? a_ : b_; K[5] = g_ ? b_ : a_; }
  { const float a_ = K[6], b_ = K[7]; const bool g_ = a_ > b_; K[6] = g_ ? a_ : b_; K[7] = g_ ? b_ : a_; }
  { const float a_ = K[8], b_ = K[9]; const bool g_ = a_ > b_; K[8] = g_ ? a_ : b_; K[9] = g_ ? b_ : a_; }
  { const float a_ = K[10], b_ = K[11]; const bool g_ = a_ > b_; K[10] = g_ ? a_ : b_; K[11] = g_ ? b_ : a_; }
  { const float a_ = K[12], b_ = K[13]; const bool g_ = a_ > b_; K[12] = g_ ? a_ : b_; K[13] = g_ ? b_ : a_; }
  { const float a_ = K[14], b_ = K[15]; const bool g_ = a_ > b_; K[14] = g_ ? a_ : b_; K[15] = g_ ? b_ : a_; }
  { const float a_ = K[32], b_ = K[63]; K[32] = a_ > b_ ? a_ : b_; }
  { const float a_ = K[33], b_ = K[62]; K[33] = a_ > b_ ? a_ : b_; }
  { const float a_ = K[34], b_ = K[61]; K[34] = a_ > b_ ? a_ : b_; }
  { const float a_ = K[35], b_ = K[60]; K[35] = a_ > b_ ? a_ : b_; }
  { const float a_ = K[36], b_ = K[59]; K[36] = a_ > b_ ? a_ : b_; }
  { const float a_ = K[37], b_ = K[58]; K[37] = a_ > b_ ? a_ : b_; }
  { const float a_ = K[38], b_ = K[57]; K[38] = a_ > b_ ? a_ : b_; }
  { const float a_ = K[39], b_ = K[56]; K[39] = a_ > b_ ? a_ : b_; }
  { const float a_ = K[40], b_ = K[55]; K[40] = a_ > b_ ? a_ : b_; }
  { const float a_ = K[41], b_ = K[54]; K[41] = a_ > b_ ? a_ : b_; }
  { const float a_ = K[42], b_ = K[53]; K[42] = a_ > b_ ? a_ : b_; }
  { const float a_ = K[43], b_ = K[52]; K[43] = a_ > b_ ? a_ : b_; }
  { const float a_ = K[44], b_ = K[51]; K[44] = a_ > b_ ? a_ : b_; }
  { const float a_ = K[45], b_ = K[50]; K[45] = a_ > b_ ? a_ : b_; }
  { const float a_ = K[46], b_ = K[49]; K[46] = a_ > b_ ? a_ : b_; }
  { const float a_ = K[47], b_ = K[48]; K[47] = a_ > b_ ? a_ : b_; }
  { const float a_ = K[32], b_ = K[40]; const bool g_ = a_ > b_; K[32] = g_ ? a_ : b_; K[40] = g_ ? b_ : a_; }
  { const float a_ = K[33], b_ = K[41]; const bool g_ = a_ > b_; K[33] = g_ ? a_ : b_; K[41] = g_ ? b_ : a_; }
  { const float a_ = K[34], b_ = K[42]; const bool g_ = a_ > b_; K[34] = g_ ? a_ : b_; K[42] = g_ ? b_ : a_; }
  { const float a_ = K[35], b_ = K[43]; const bool g_ = a_ > b_; K[35] = g_ ? a_ : b_; K[43] = g_ ? b_ : a_; }
  { const float a_ = K[36], b_ = K[44]; const bool g_ = a_ > b_; K[36] = g_ ? a_ : b_; K[44] = g_ ? b_ : a_; }
  { const float a_ = K[37], b_ = K[45]; const bool g_ = a_ > b_; K[37] = g_ ? a_ : b_; K[45] = g_ ? b_ : a_; }
  { const float a_ = K[38], b_ = K[46]; const bool g_ = a_ > b_; K[38] = g_ ? a_ : b_; K[46] = g_ ? b_ : a_; }
  { const float a_ = K[39], b_ = K[47]; const bool g_ = a_ > b_; K[39] = g_ ? a_ : b_; K[47] = g_ ? b_ : a_; }
  { const float a_ = K[32], b_ = K[36]; const bool g_ = a_ > b_; K[32] = g_ ? a_ : b_; K[36] = g_ ? b_ : a_; }
  { const float a_ = K[33], b_ = K[37]; const bool g_ = a_ > b_; K[33] = g_ ? a_ : b_; K[37] = g_ ? b_ : a_; }
  { const float a_ = K[34], b_ = K[38]; const bool g_ = a_ > b_; K[34] = g_ ? a_ : b_; K[38] = g_ ? b_ : a_; }
  { const float a_ = K[35], b_ = K[39]; const bool g_ = a_ > b_; K[35] = g_ ? a_ : b_; K[39] = g_ ? b_ : a_; }
  { const float a_ = K[40], b_ = K[44]; const bool g_ = a_ > b_; K[40] = g_ ? a_ : b_; K[44] = g_ ? b_ : a_; }
  { const float a_ = K[41], b_ = K[45]; const bool g_ = a_ > b_; K[41] = g_ ? a_ : b_; K[45] = g_ ? b_ : a_; }
  { const float a_ = K[42], b_ = K[46]; const bool g_ = a_ > b_; K[42] = g_ ? a_ : b_; K[46] = g_ ? b_ : a_; }
  { const float a_ = K[43], b_ = K[47]; const bool g_ = a_ > b_; K[43] = g_ ? a_ : b_; K[47] = g_ ? b_ : a_; }
  { const float a_ = K[32], b_ = K[34]; const bool g_ = a_ > b_; K[32] = g_ ? a_ : b_; K[34] = g_ ? b_ : a_; }
  { const float a_ = K[33], b_ = K[35]; const bool g_ = a_ > b_; K[33] = g_ ? a_ : b_; K[35] = g_ ? b_ : a_; }
  { const float a_ = K[36], b_ = K[38]; const bool g_ = a_ > b_; K[36] = g_ ? a_ : b_; K[38] = g_ ? b_ : a_; }
  { const float a_ = K[37], b_ = K[39]; const bool g_ = a_ > b_; K[37] = g_ ? a_ : b_; K[39] = g_ ? b_ : a_; }
  { const float a_ = K[40], b_ = K[42]; const bool g_ = a_ > b_; K[40] = g_ ? a_ : b_; K[42] = g_ ? b_ : a_; }
  { const float a_ = K[41], b_ = K[43]; const bool g_ = a_ > b_; K[41] = g_ ? a_ : b_; K[43] = g_ ? b_ : a_; }
  { const float a_ = K[44], b_ = K[46]; const bool g_ = a_ > b_; K[44] = g_ ? a_ : b_; K[46] = g_ ? b_ : a_; }
  { const float a_ = K[45], b_ = K[47]; const bool g_ = a_ > b_; K[45] = g_ ? a_ : b_; K[47] = g_ ? b_ : a_; }
  { const float a_ = K[32], b_ = K[33]; const bool g_ = a_ > b_; K[32] = g_ ? a_ : b_; K[33] = g_ ? b_ : a_; }
  { const float a_ = K[34], b_ = K[35]; const bool g_ = a_ > b_; K[34] = g_ ? a_ : b_; K[35] = g_ ? b_ : a_; }
  { const float a_ = K[36], b_ = K[37]; const bool g_ = a_ > b_; K[36] = g_ ? a_ : b_; K[37] = g_ ? b_ : a_; }
  { const float a_ = K[38], b_ = K[39]; const bool g_ = a_ > b_; K[38] = g_ ? a_ : b_; K[39] = g_ ? b_ : a_; }
  { const float a_ = K[40], b_ = K[41]; const bool g_ = a_ > b_; K[40] = g_ ? a_ : b_; K[41] = g_ ? b_ : a_; }
  { const float a_ = K[42], b_ = K[43]; const bool g_ = a_ > b_; K[42] = g_ ? a_ : b_; K[43] = g_ ? b_ : a_; }
  { const float a_ = K[44], b_ = K[45]; const bool g_ = a_ > b_; K[44] = g_ ? a_ : b_; K[45] = g_ ? b_ : a_; }
  { const float a_ = K[46], b_ = K[47]; const bool g_ = a_ > b_; K[46] = g_ ? a_ : b_; K[47] = g_ ? b_ : a_; }
  { const float a_ = K[0], b_ = K[47]; K[0] = a_ > b_ ? a_ : b_; }
  { const float a_ = K[1], b_ = K[46]; K[1] = a_ > b_ ? a_ : b_; }
  { const float a_ = K[2], b_ = K[45]; K[2] = a_ > b_ ? a_ : b_; }
  { const float a_ = K[3], b_ = K[44]; K[3] = a_ > b_ ? a_ : b_; }
  { const float a_ = K[4], b_ = K[43]; K[4] = a_ > b_ ? a_ : b_; }
  { const float a_ = K[5], b_ = K[42]; K[5] = a_ > b_ ? a_ : b_; }
  { const float a_ = K[6], b_ = K[41]; K[6] = a_ > b_ ? a_ : b_; }
  { const float a_ = K[7], b_ = K[40]; K[7] = a_ > b_ ? a_ : b_; }
  { const float a_ = K[8], b_ = K[39]; K[8] = a_ > b_ ? a_ : b_; }
  { const float a_ = K[9], b_ = K[38]; K[9] = a_ > b_ ? a_ : b_; }
  { const float a_ = K[10], b_ = K[37]; K[10] = a_ > b_ ? a_ : b_; }
  { const float a_ = K[11], b_ = K[36]; K[11] = a_ > b_ ? a_ : b_; }
  { const float a_ = K[12], b_ = K[35]; K[12] = a_ > b_ ? a_ : b_; }
  { const float a_ = K[13], b_ = K[34]; K[13] = a_ > b_ ? a_ : b_; }
  { const float a_ = K[14], b_ = K[33]; K[14] = a_ > b_ ? a_ : b_; }
  { const float a_ = K[15], b_ = K[32]; K[15] = a_ > b_ ? a_ : b_; }
  { const float a_ = K[0], b_ = K[8]; const bool g_ = a_ > b_; K[0] = g_ ? a_ : b_; K[8] = g_ ? b_ : a_; }
  { const float a_ = K[1], b_ = K[9]; const bool g_ = a_ > b_; K[1] = g_ ? a_ : b_; K[9] = g_ ? b_ : a_; }
  { const float a_ = K[2], b_ = K[10]; const bool g_ = a_ > b_; K[2] = g_ ? a_ : b_; K[10] = g_ ? b_ : a_; }
  { const float a_ = K[3], b_ = K[11]; const bool g_ = a_ > b_; K[3] = g_ ? a_ : b_; K[11] = g_ ? b_ : a_; }
  { const float a_ = K[4], b_ = K[12]; const bool g_ = a_ > b_; K[4] = g_ ? a_ : b_; K[12] = g_ ? b_ : a_; }
  { const float a_ = K[5], b_ = K[13]; const bool g_ = a_ > b_; K[5] = g_ ? a_ : b_; K[13] = g_ ? b_ : a_; }
  { const float a_ = K[6], b_ = K[14]; const bool g_ = a_ > b_; K[6] = g_ ? a_ : b_; K[14] = g_ ? b_ : a_; }
  { const float a_ = K[7], b_ = K[15]; const bool g_ = a_ > b_; K[7] = g_ ? a_ : b_; K[15] = g_ ? b_ : a_; }
  { const float a_ = K[0], b_ = K[4]; const bool g_ = a_ > b_; K[0] = g_ ? a_ : b_; K[4] = g_ ? b_ : a_; }
  { const float a_ = K[1], b_ = K[5]; const bool g_ = a_ > b_; K[1] = g_ ? a_ : b_; K[5] = g_ ? b_ : a_; }
  { const float a_ = K[2], b_ = K[6]; const bool g_ = a_ > b_; K[2] = g_ ? a_ : b_; K[6] = g_ ? b_ : a_; }
  { const float a_ = K[3], b_ = K[7]; const bool g_ = a_ > b_; K[3] = g_ ? a_ : b_; K[7] = g_ ? b_ : a_; }
  { const float a_ = K[8], b_ = K[12]; const bool g_ = a_ > b_; K[8] = g_ ? a_ : b_; K[12] = g_ ? b_ : a_; }
  { const float a_ = K[9], b_ = K[13]; const bool g_ = a_ > b_; K[9] = g_ ? a_ : b_; K[13] = g_ ? b_ : a_; }
  { const float a_ = K[10], b_ = K[14]; const bool g_ = a_ > b_; K[10] = g_ ? a_ : b_; K[14] = g_ ? b_ : a_; }
  { const float a_ = K[11], b_ = K[15]; const bool g_ = a_ > b_; K[11] = g_ ? a_ : b_; K[15] = g_ ? b_ : a_; }
  { const float a_ = K[0], b_ = K[2]; const bool g_ = a_ > b_; K[0] = g_ ? a_ : b_; K[2] = g_ ? b_ : a_; }
  { const float a_ = K[1], b_ = K[3]; const bool g_ = a_ > b_; K[1] = g_ ? a_ : b_; K[3] = g_ ? b_ : a_; }
  { const float a_ = K[4], b_ = K[6]; const bool g_ = a_ > b_; K[4] = g_ ? a_ : b_; K[6] = g_ ? b_ : a_; }
  { const float a_ = K[5], b_ = K[7]; const bool g_ = a_ > b_; K[5] = g_ ? a_ : b_; K[7] = g_ ? b_ : a_; }
  { const float a_ = K[8], b_ = K[10]; const bool g_ = a_ > b_; K[8] = g_ ? a_ : b_; K[10] = g_ ? b_ : a_; }
  { const float a_ = K[9], b_ = K[11]; const bool g_ = a_ > b_; K[9] = g_ ? a_ : b_; K[11] = g_ ? b_ : a_; }
  { const float a_ = K[12], b_ = K[14]; const bool g_ = a_ > b_; K[12] = g_ ? a_ : b_; K[14] = g_ ? b_ : a_; }
  { const float a_ = K[13], b_ = K[15]; const bool g_ = a_ > b_; K[13] = g_ ? a_ : b_; K[15] = g_ ? b_ : a_; }
  { const float a_ = K[0], b_ = K[1]; const bool g_ = a_ > b_; K[0] = g_ ? a_ : b_; K[1] = g_ ? b_ : a_; }
  { const float a_ = K[2], b_ = K[3]; const bool g_ = a_ > b_; K[2] = g_ ? a_ : b_; K[3] = g_ ? b_ : a_; }
  { const float a_ = K[4], b_ = K[5]; const bool g_ = a_ > b_; K[4] = g_ ? a_ : b_; K[5] = g_ ? b_ : a_; }
  { const float a_ = K[6], b_ = K[7]; const bool g_ = a_ > b_; K[6] = g_ ? a_ : b_; K[7] = g_ ? b_ : a_; }
  { const float a_ = K[8], b_ = K[9]; const bool g_ = a_ > b_; K[8] = g_ ? a_ : b_; K[9] = g_ ? b_ : a_; }
  { const float a_ = K[10], b_ = K[11]; const bool g_ = a_ > b_; K[10] = g_ ? a_ : b_; K[11] = g_ ? b_ : a_; }
  { const float a_ = K[12], b_ = K[13]; const bool g_ = a_ > b_; K[12] = g_ ? a_ : b_; K[13] = g_ ? b_ : a_; }
  { const float a_ = K[14], b_ = K[15]; const bool g_ = a_ > b_; K[14] = g_ ? a_ : b_; K[15] = g_ ? b_ : a_; }
}
__device__ __forceinline__ void merge_top16(float (&T)[16], const float (&P)[16]) {
  { const float a_ = T[0], b_ = P[15]; T[0] = a_ > b_ ? a_ : b_; }
  { const float a_ = T[1], b_ = P[14]; T[1] = a_ > b_ ? a_ : b_; }
  { const float a_ = T[2], b_ = P[13]; T[2] = a_ > b_ ? a_ : b_; }
  { const float a_ = T[3], b_ = P[12]; T[3] = a_ > b_ ? a_ : b_; }
  { const float a_ = T[4], b_ = P[11]; T[4] = a_ > b_ ? a_ : b_; }
  { const float a_ = T[5], b_ = P[10]; T[5] = a_ > b_ ? a_ : b_; }
  { const float a_ = T[6], b_ = P[9]; T[6] = a_ > b_ ? a_ : b_; }
  { const float a_ = T[7], b_ = P[8]; T[7] = a_ > b_ ? a_ : b_; }
  { const float a_ = T[8], b_ = P[7]; T[8] = a_ > b_ ? a_ : b_; }
  { const float a_ = T[9], b_ = P[6]; T[9] = a_ > b_ ? a_ : b_; }
  { const float a_ = T[10], b_ = P[5]; T[10] = a_ > b_ ? a_ : b_; }
  { const float a_ = T[11], b_ = P[4]; T[11] = a_ > b_ ? a_ : b_; }
  { const float a_ = T[12], b_ = P[3]; T[12] = a_ > b_ ? a_ : b_; }
  { const float a_ = T[13], b_ = P[2]; T[13] = a_ > b_ ? a_ : b_; }
  { const float a_ = T[14], b_ = P[1]; T[14] = a_ > b_ ? a_ : b_; }
  { const float a_ = T[15], b_ = P[0]; T[15] = a_ > b_ ? a_ : b_; }
  { const float a_ = T[0], b_ = T[8]; const bool g_ = a_ > b_; T[0] = g_ ? a_ : b_; T[8] = g_ ? b_ : a_; }
  { const float a_ = T[1], b_ = T[9]; const bool g_ = a_ > b_; T[1] = g_ ? a_ : b_; T[9] = g_ ? b_ : a_; }
  { const float a_ = T[2], b_ = T[10]; const bool g_ = a_ > b_; T[2] = g_ ? a_ : b_; T[10] = g_ ? b_ : a_; }
  { const float a_ = T[3], b_ = T[11]; const bool g_ = a_ > b_; T[3] = g_ ? a_ : b_; T[11] = g_ ? b_ : a_; }
  { const float a_ = T[4], b_ = T[12]; const bool g_ = a_ > b_; T[4] = g_ ? a_ : b_; T[12] = g_ ? b_ : a_; }
  { const float a_ = T[5], b_ = T[13]; const bool g_ = a_ > b_; T[5] = g_ ? a_ : b_; T[13] = g_ ? b_ : a_; }
  { const float a_ = T[6], b_ = T[14]; const bool g_ = a_ > b_; T[6] = g_ ? a_ : b_; T[14] = g_ ? b_ : a_; }
  { const float a_ = T[7], b_ = T[15]; const bool g_ = a_ > b_; T[7] = g_ ? a_ : b_; T[15] = g_ ? b_ : a_; }
  { const float a_ = T[0], b_ = T[4]; const bool g_ = a_ > b_; T[0] = g_ ? a_ : b_; T[4] = g_ ? b_ : a_; }
  { const float a_ = T[1], b_ = T[5]; const bool g_ = a_ > b_; T[1] = g_ ? a_ : b_; T[5] = g_ ? b_ : a_; }
  { const float a_ = T[2], b_ = T[6]; const bool g_ = a_ > b_; T[2] = g_ ? a_ : b_; T[6] = g_ ? b_ : a_; }
  { const float a_ = T[3], b_ = T[7]; const bool g_ = a_ > b_; T[3] = g_ ? a_ : b_; T[7] = g_ ? b_ : a_; }
  { const float a_ = T[8], b_ = T[12]; const bool g_ = a_ > b_; T[8] = g_ ? a_ : b_; T[12] = g_ ? b_ : a_; }
  { const float a_ = T[9], b_ = T[13]; const bool g_ = a_ > b_; T[9] = g_ ? a_ : b_; T[13] = g_ ? b_ : a_; }
  { const float a_ = T[10], b_ = T[14]; const bool g_ = a_ > b_; T[10] = g_ ? a_ : b_; T[14] = g_ ? b_ : a_; }
  { const float a_ = T[11], b_ = T[15]; const bool g_ = a_ > b_; T[11] = g_ ? a_ : b_; T[15] = g_ ? b_ : a_; }
  { const float a_ = T[0], b_ = T[2]; const bool g_ = a_ > b_; T[0] = g_ ? a_ : b_; T[2] = g_ ? b_ : a_; }
  { const float a_ = T[1], b_ = T[3]; const bool g_ = a_ > b_; T[1] = g_ ? a_ : b_; T[3] = g_ ? b_ : a_; }
  { const float a_ = T[4], b_ = T[6]; const bool g_ = a_ > b_; T[4] = g_ ? a_ : b_; T[6] = g_ ? b_ : a_; }
  { const float a_ = T[5], b_ = T[7]; const bool g_ = a_ > b_; T[5] = g_ ? a_ : b_; T[7] = g_ ? b_ : a_; }
  { const float a_ = T[8], b_ = T[10]; const bool g_ = a_ > b_; T[8] = g_ ? a_ : b_; T[10] = g_ ? b_ : a_; }
  { const float a_ = T[9], b_ = T[11]; const bool g_ = a_ > b_; T[9] = g_ ? a_ : b_; T[11] = g_ ? b_ : a_; }
  { const float a_ = T[12], b_ = T[14]; const bool g_ = a_ > b_; T[12] = g_ ? a_ : b_; T[14] = g_ ? b_ : a_; }
  { const float a_ = T[13], b_ = T[15]; const bool g_ = a_ > b_; T[13] = g_ ? a_ : b_; T[15] = g_ ? b_ : a_; }
  { const float a_ = T[0], b_ = T[1]; const bool g_ = a_ > b_; T[0] = g_ ? a_ : b_; T[1] = g_ ? b_ : a_; }
  { const float a_ = T[2], b_ = T[3]; const bool g_ = a_ > b_; T[2] = g_ ? a_ : b_; T[3] = g_ ? b_ : a_; }
  { const float a_ = T[4], b_ = T[5]; const bool g_ = a_ > b_; T[4] = g_ ? a_ : b_; T[5] = g_ ? b_ : a_; }
  { const float a_ = T[6], b_ = T[7]; const bool g_ = a_ > b_; T[6] = g_ ? a_ : b_; T[7] = g_ ? b_ : a_; }
  { const float a_ = T[8], b_ = T[9]; const bool g_ = a_ > b_; T[8] = g_ ? a_ : b_; T[9] = g_ ? b_ : a_; }
  { const float a_ = T[10], b_ = T[11]; const bool g_ = a_ > b_; T[10] = g_ ? a_ : b_; T[11] = g_ ? b_ : a_; }
  { const float a_ = T[12], b_ = T[13]; const bool g_ = a_ > b_; T[12] = g_ ? a_ : b_; T[13] = g_ ? b_ : a_; }
  { const float a_ = T[14], b_ = T[15]; const bool g_ = a_ > b_; T[14] = g_ ? a_ : b_; T[15] = g_ ? b_ : a_; }
}

__device__ __forceinline__ void peer_topk(const int wave_s, const bf16* pq, const bf16* skb, int* ids, float* gates, LAS float* smem) {
  const int tid_ = opaque_tid(wave_s);
  const int lane = tid_ & 63, n = lane & 31, hh = lane >> 5, wave = tid_ >> 6;
  const int gw = blockIdx.x * NWAVES + wave;
  const int nw = gridDim.x * NWAVES;
  LAS float* lk = smem + wave * 2048;
  for (int it = gw; it < 512 * 8; it += nw) {
    const int h = it & 7, tok0 = (it >> 3) * 32;
#pragma unroll 1
    for (int half = 0; half < 2; half++) {
      bf16x8_t qf[8];
      {
        const bf16* qrow = pq + (size_t)(tok0 + n) * 2048 + h * 256 + half * 128 + 8 * hh;
#pragma unroll
        for (int ks = 0; ks < 8; ks++) qf[ks] = *(const bf16x8_t*)(qrow + 16 * ks);
      }
      float K[64];
#pragma unroll
      for (int kt = 0; kt < 4; kt++) {
        const bf16* krow = skb + ((size_t)((h * 2 + half) * 128 + kt * 32 + n)) * 128 + 8 * hh;
        f32x16_t acc;
#pragma unroll
        for (int r = 0; r < 16; r++) acc[r] = 0.f;
#pragma unroll
        for (int kq = 0; kq < 2; kq++) {
          bf16x8_t kf[4];
#pragma unroll
          for (int i = 0; i < 4; i++) kf[i] = *(const bf16x8_t*)(krow + 16 * (kq * 4 + i));
          MFMA_PAD();
#pragma unroll
          for (int i = 0; i < 4; i++) acc = __builtin_amdgcn_mfma_f32_32x32x16_bf16(kf[i], qf[kq * 4 + i], acc, 0, 0, 0);
          MFMA_PAD();
        }
#pragma unroll
        for (int i = 0; i < 16; i++) K[kt * 16 + i] = pack_key<0x7Fu>(acc[i], (unsigned)(kt * 32 + (i & 3) + 8 * (i >> 2) + 4 * hh));
      }
      __builtin_amdgcn_sched_barrier(0);
      top16_of_64(K);
      __builtin_amdgcn_sched_barrier(0);
      float T[16], P[16];
#pragma unroll
      for (int i = 0; i < 16; i++) { T[i] = K[i]; P[i] = __shfl_xor(K[i], 32, 64); }
      merge_top16(T, P);
#pragma unroll
      for (int i = 0; i < 16; i++) lk[(half * 16 + i) * 64 + lane] = T[i];
      __builtin_amdgcn_sched_barrier(0);
    }
    float f0[16], f1[16];
    int ti0[16], ti1[16];
#pragma unroll
    for (int i = 0; i < 16; i++) {
      const float k0 = lk[i * 64 + lane], k1 = lk[(16 + i) * 64 + lane];
      f0[i] = key_val<0x7Fu>(k0); ti0[i] = (int)key_idx<0x7Fu>(k0);
      f1[i] = key_val<0x7Fu>(k1); ti1[i] = (int)key_idx<0x7Fu>(k1);
    }
    float K[64];
    {
    K[0] = pack_key<0xFFu>(f0[0] + f1[0], 0u);
    K[1] = pack_key<0xFFu>(f0[0] + f1[1], 1u);
    K[2] = pack_key<0xFFu>(f0[0] + f1[2], 2u);
    K[3] = pack_key<0xFFu>(f0[0] + f1[3], 3u);
    K[4] = pack_key<0xFFu>(f0[0] + f1[4], 4u);
    K[5] = pack_key<0xFFu>(f0[0] + f1[5], 5u);
    K[6] = pack_key<0xFFu>(f0[0] + f1[6], 6u);
    K[7] = pack_key<0xFFu>(f0[0] + f1[7], 7u);
    K[8] = pack_key<0xFFu>(f0[0] + f1[8], 8u);
    K[9] = pack_key<0xFFu>(f0[0] + f1[9], 9u);
    K[10] = pack_key<0xFFu>(f0[0] + f1[10], 10u);
    K[11] = pack_key<0xFFu>(f0[0] + f1[11], 11u);
    K[12] = pack_key<0xFFu>(f0[0] + f1[12], 12u);
    K[13] = pack_key<0xFFu>(f0[0] + f1[13], 13u);
    K[14] = pack_key<0xFFu>(f0[0] + f1[14], 14u);
    K[15] = pack_key<0xFFu>(f0[0] + f1[15], 15u);
    K[16] = pack_key<0xFFu>(f0[1] + f1[0], 16u);
    K[17] = pack_key<0xFFu>(f0[1] + f1[1], 17u);
    K[18] = pack_key<0xFFu>(f0[1] + f1[2], 18u);
    K[19] = pack_key<0xFFu>(f0[1] + f1[3], 19u);
    K[20] = pack_key<0xFFu>(f0[1] + f1[4], 20u);
    K[21] = pack_key<0xFFu>(f0[1] + f1[5], 21u);
    K[22] = pack_key<0xFFu>(f0[1] + f1[6], 22u);
    K[23] = pack_key<0xFFu>(f0[1] + f1[7], 23u);
    K[24] = pack_key<0xFFu>(f0[2] + f1[0], 32u);
    K[25] = pack_key<0xFFu>(f0[2] + f1[1], 33u);
    K[26] = pack_key<0xFFu>(f0[2] + f1[2], 34u);
    K[27] = pack_key<0xFFu>(f0[2] + f1[3], 35u);
    K[28] = pack_key<0xFFu>(f0[2] + f1[4], 36u);
    K[29] = pack_key<0xFFu>(f0[3] + f1[0], 48u);
    K[30] = pack_key<0xFFu>(f0[3] + f1[1], 49u);
    K[31] = pack_key<0xFFu>(f0[3] + f1[2], 50u);
    K[32] = pack_key<0xFFu>(f0[3] + f1[3], 51u);
    K[33] = pack_key<0xFFu>(f0[4] + f1[0], 64u);
    K[34] = pack_key<0xFFu>(f0[4] + f1[1], 65u);
    K[35] = pack_key<0xFFu>(f0[4] + f1[2], 66u);
    K[36] = pack_key<0xFFu>(f0[5] + f1[0], 80u);
    K[37] = pack_key<0xFFu>(f0[5] + f1[1], 81u);
    K[38] = pack_key<0xFFu>(f0[6] + f1[0], 96u);
    K[39] = pack_key<0xFFu>(f0[6] + f1[1], 97u);
    K[40] = pack_key<0xFFu>(f0[7] + f1[0], 112u);
    K[41] = pack_key<0xFFu>(f0[7] + f1[1], 113u);
    K[42] = pack_key<0xFFu>(f0[8] + f1[0], 128u);
    K[43] = pack_key<0xFFu>(f0[9] + f1[0], 144u);
    K[44] = pack_key<0xFFu>(f0[10] + f1[0], 160u);
    K[45] = pack_key<0xFFu>(f0[11] + f1[0], 176u);
    K[46] = pack_key<0xFFu>(f0[12] + f1[0], 192u);
    K[47] = pack_key<0xFFu>(f0[13] + f1[0], 208u);
    K[48] = pack_key<0xFFu>(f0[14] + f1[0], 224u);
    K[49] = pack_key<0xFFu>(f0[15] + f1[0], 240u);
    K[50] = -3.0e38f;
    K[51] = -3.0e38f;
    K[52] = -3.0e38f;
    K[53] = -3.0e38f;
    K[54] = -3.0e38f;
    K[55] = -3.0e38f;
    K[56] = -3.0e38f;
    K[57] = -3.0e38f;
    K[58] = -3.0e38f;
    K[59] = -3.0e38f;
    K[60] = -3.0e38f;
    K[61] = -3.0e38f;
    K[62] = -3.0e38f;
    K[63] = -3.0e38f;
    }
    __builtin_amdgcn_sched_barrier(0);
    top16_of_64(K);
    __builtin_amdgcn_sched_barrier(0);
    float bv[16];
    int be[16];
#pragma unroll
    for (int r = 0; r < 16; r++) {
      const int flat = (int)key_idx<0xFFu>(K[r]);
      const int a = flat >> 4, b = flat & 15;
      int i0 = 0, i1 = 0;
#pragma unroll
      for (int i = 0; i < 16; i++) { i0 = (a == i) ? ti0[i] : i0; i1 = (b == i) ? ti1[i] : i1; }
      be[r] = i0 * 128 + i1;
      bv[r] = key_val<0xFFu>(K[r]);
    }
    const float b0 = bv[0];
    float ge[16];
    float gsum = 0.f;
#pragma unroll
    for (int r = 0; r < 16; r++) { ge[r] = __expf(bv[r] - b0); gsum += ge[r]; }
    const float ginv = 1.0f / gsum;
    if (hh == 0) {
      int* ip = ids + (size_t)(tok0 + n) * 128 + h * 16;
      float* gp = gates + (size_t)(tok0 + n) * 128 + h * 16;
#pragma unroll
      for (int r4 = 0; r4 < 4; r4++) {
        *(int4*)(ip + 4 * r4) = make_int4(be[4 * r4], be[4 * r4 + 1], be[4 * r4 + 2], be[4 * r4 + 3]);
        *(float4*)(gp + 4 * r4) = make_float4(ge[4 * r4] * ginv, ge[4 * r4 + 1] * ginv, ge[4 * r4 + 2] * ginv, ge[4 * r4 + 3] * ginv);
      }
    }
  }
}

typedef _Float16 f16x2_t __attribute__((ext_vector_type(2)));
__device__ __forceinline__ unsigned e4m3x2_to_f16x2(unsigned w, unsigned sel) {
  return __builtin_amdgcn_perm(w, w, sel);
}
__device__ __forceinline__ float dot2h(unsigned a, unsigned b, float c) {
  return __builtin_amdgcn_fdot2(__builtin_bit_cast(f16x2_t, a), __builtin_bit_cast(f16x2_t, b), c, false);
}
__device__ __forceinline__ unsigned pack_h2(float lo, float hi) {
  f16x2_t v; v.x = (_Float16)lo; v.y = (_Float16)hi;
  return __builtin_bit_cast(unsigned, v);
}
template <bool FINAL>
__device__ __forceinline__ void peer_gather(const int wave_s, bf16* xn, const float* rst, const unsigned char* ub, const unsigned char* vb, const float* vsc, const float* usc,
                                            const int* ids, const float* gates, float* xw, const float* gnext, float* outp) {
  const int tid_ = opaque_tid(wave_s);
  const int lane = tid_ & 63;
  const int gw = blockIdx.x * NWAVES + (tid_ >> 6);
  const int nw = gridDim.x * NWAVES;
  const int el = ((lane >> 5) & 1) * 8 + ((lane >> 4) & 1) * 4 + ((lane >> 3) & 1) * 2 + ((lane >> 2) & 1);
  int idv = 0;
  uint2 uu[16];
  uint2 vv[16];
  const int wv_ = tid_ >> 6;
  const int ntl_ = (512 - (int)blockIdx.x + (int)gridDim.x - 1) / (int)gridDim.x;
  const int nit_ = ntl_ > 0 ? ntl_ * 4 : 0;
#define GTOK(i) (32 * ((int)blockIdx.x + (int)gridDim.x * ((i) >> 2)) + 8 * ((i) & 3) + wv_)
  if (nit_ > 0) {
    idv = ids[(size_t)GTOK(0) * 128 + (lane & 15)];
#pragma unroll
    for (int e = 0; e < 16; e++) {
      const int id = __builtin_amdgcn_readlane(idv, e);
      uu[e] = *(const uint2*)(ub + (size_t)id * 512 + lane * 8);
      vv[e] = *(const uint2*)(vb + (size_t)id * 512 + lane * 8);
    }
  }
  for (int it_ = 0; it_ < nit_; it_++) {
    const int tok = GTOK(it_);
    const int tokn = (it_ + 1 < nit_) ? GTOK(it_ + 1) : tok;
    int xqh[2] = {0, 0}, xql[2] = {0, 0};
    float xstep, qhalf;
    {
      const uint4 a = *(const uint4*)(xn + (size_t)tok * DM + lane * 16);
      const uint4 b = *(const uint4*)(xn + (size_t)tok * DM + lane * 16 + 8);
      const unsigned xw_[8] = {a.x, a.y, a.z, a.w, b.x, b.y, b.z, b.w};
      const float4* sp = (const float4*)(rst + (size_t)tok * 16);
      const float4 s0 = sp[0], s1 = sp[1], s2 = sp[2], s3 = sp[3];
      const float xs = rsqrtf((((s0.x + s0.y) + (s0.z + s0.w)) + ((s1.x + s1.y) + (s1.z + s1.w)) + ((s2.x + s2.y) + (s2.z + s2.w)) + ((s3.x + s3.y) + (s3.z + s3.w))) * (1.0f / 1024.f) + EPSF);
      float xf[16];
      float am = 0.f;
#pragma unroll
      for (int k = 0; k < 8; k++) { xf[2 * k] = bf_lo(xw_[k]) * xs; xf[2 * k + 1] = bf_hi(xw_[k]) * xs; am = fmaxf(am, fmaxf(fabsf(xf[2 * k]), fabsf(xf[2 * k + 1]))); }
#pragma unroll
      for (int o = 32; o >= 1; o >>= 1) am = fmaxf(am, __shfl_xor(am, o, 64));
      xstep = am * (1.0f / 119.f);
      const float inv = am > 0.f ? 119.f / am : 0.f;
      int qs = 0;
#pragma unroll
      for (int i = 0; i < 16; i++) {
        const int q = (int)rintf(xf[i] * inv);
        const int t = q + 8;
        xqh[i >> 3] |= ((t >> 4) & 15) << (4 * (i & 7));
        xql[i >> 3] |= (((t & 15) - 8) & 15) << (4 * (i & 7));
        qs += q;
      }
      qhalf = 0.5f * wsum((float)qs);
    }
    f16x2_t acc2[8];
#pragma unroll
    for (int i = 0; i < 8; i++) acc2[i] = (f16x2_t){(_Float16)0.f, (_Float16)0.f};
#pragma unroll 1
    for (int g = 0; g < 8; g++) {
      const int ide = __builtin_amdgcn_ds_bpermute(el << 2, idv);
      const float2 sc2 = ((const float2*)vsc)[ide];
      const float gv = gates[(size_t)tok * 128 + g * 16 + el] * sc2.x;
      const float us = sc2.y * xstep;
      const int idn = ids[(size_t)(g < 7 ? tok : tokn) * 128 + ((g + 1) & 7) * 16 + (lane & 15)];
      float d[16];
#pragma unroll
      for (int e = 0; e < 16; e++) {
        int sh = __builtin_amdgcn_sdot8((int)uu[e].x, xqh[0], 0, false);
        sh = __builtin_amdgcn_sdot8((int)uu[e].y, xqh[1], sh, false);
        int sl = __builtin_amdgcn_sdot8((int)uu[e].x, xql[0], 0, false);
        sl = __builtin_amdgcn_sdot8((int)uu[e].y, xql[1], sl, false);
        d[e] = (float)((sh << 4) + sl);
      }
#pragma unroll
      for (int e = 0; e < 16; e++) {
        const int id = __builtin_amdgcn_readlane(idn, e);
        uu[e] = *(const uint2*)(ub + (size_t)id * 512 + lane * 8);
      }
      float d8[8], d4[4], d2[2], d1;
      {
        const bool hi = (lane & 32) != 0;
#pragma unroll
        for (int i = 0; i < 8; i++) { const float send = hi ? d[i] : d[i + 8]; const float keep = hi ? d[i + 8] : d[i]; d8[i] = keep + __shfl_xor(send, 32, 64); }
      }
      {
        const bool hi = (lane & 16) != 0;
#pragma unroll
        for (int i = 0; i < 4; i++) { const float send = hi ? d8[i] : d8[i + 4]; const float keep = hi ? d8[i + 4] : d8[i]; d4[i] = keep + __shfl_xor(send, 16, 64); }
      }
      {
        const bool hi = (lane & 8) != 0;
#pragma unroll
        for (int i = 0; i < 2; i++) { const float send = hi ? d4[i] : d4[i + 2]; const float keep = hi ? d4[i + 2] : d4[i]; d2[i] = keep + __shfl_xor(send, 8, 64); }
      }
      {
        const bool hi = (lane & 4) != 0;
        const float send = hi ? d2[0] : d2[1];
        const float keep = hi ? d2[1] : d2[0];
        d1 = keep + __shfl_xor(send, 4, 64);
      }
      d1 += __shfl_xor(d1, 2, 64);
      d1 += __shfl_xor(d1, 1, 64);
      const float wl = gv * gelu_tanh((d1 + qhalf) * us);
#pragma unroll
      for (int e = 0; e < 16; e++) {
        const float w = __builtin_bit_cast(float, __builtin_amdgcn_readlane(__builtin_bit_cast(int, wl), ((e >> 3) & 1) * 32 + ((e >> 2) & 1) * 16 + ((e >> 1) & 1) * 8 + (e & 1) * 4));
        const f16x2_t w2 = __builtin_bit_cast(f16x2_t, pack_h2(w, w));
        const unsigned vw[2] = {vv[e].x, vv[e].y};
#pragma unroll
        for (int k = 0; k < 2; k++) {
          const unsigned w4 = vw[k];
          const unsigned le = __builtin_amdgcn_perm(V4_LUT_HI, V4_LUT_LO, w4 & 0x07070707u);
          const unsigned lo = __builtin_amdgcn_perm(V4_LUT_HI, V4_LUT_LO, (w4 >> 4) & 0x07070707u);
          const unsigned ee = ((w4 << 4) & 0x80808080u) | le;
          const unsigned eo = (w4 & 0x80808080u) | lo;
          const unsigned p01 = __builtin_amdgcn_perm(eo, ee, 0x040c000cu), p23 = __builtin_amdgcn_perm(eo, ee, 0x050c010cu);
          const unsigned p45 = __builtin_amdgcn_perm(eo, ee, 0x060c020cu), p67 = __builtin_amdgcn_perm(eo, ee, 0x070c030cu);
          acc2[4 * k + 0] = __builtin_elementwise_fma(__builtin_bit_cast(f16x2_t, p01), w2, acc2[4 * k + 0]);
          acc2[4 * k + 1] = __builtin_elementwise_fma(__builtin_bit_cast(f16x2_t, p23), w2, acc2[4 * k + 1]);
          acc2[4 * k + 2] = __builtin_elementwise_fma(__builtin_bit_cast(f16x2_t, p45), w2, acc2[4 * k + 2]);
          acc2[4 * k + 3] = __builtin_elementwise_fma(__builtin_bit_cast(f16x2_t, p67), w2, acc2[4 * k + 3]);
        }
      }
#pragma unroll
      for (int e = 0; e < 16; e++) {
        const int id = __builtin_amdgcn_readlane(idn, e);
        vv[e] = *(const uint2*)(vb + (size_t)id * 512 + lane * 8);
      }
      idv = idn;
    }
    float acc[16];
#pragma unroll
    for (int i = 0; i < 8; i++) { acc[2 * i] = (float)acc2[i].x; acc[2 * i + 1] = (float)acc2[i].y; }
    float* xr = xw + (size_t)tok * DM + lane * 16;
    float xv[16];
    float ssq = 0.f;
#pragma unroll
    for (int c = 0; c < 4; c++) {
      float4 a0 = *(float4*)(xr + c * 4);
      a0.x += acc[c * 4 + 0]; a0.y += acc[c * 4 + 1]; a0.z += acc[c * 4 + 2]; a0.w += acc[c * 4 + 3];
      if (!FINAL) *(float4*)(xr + c * 4) = a0;
      xv[c * 4 + 0] = a0.x; xv[c * 4 + 1] = a0.y; xv[c * 4 + 2] = a0.z; xv[c * 4 + 3] = a0.w;
      ssq += a0.x * a0.x + a0.y * a0.y + a0.z * a0.z + a0.w * a0.w;
    }
    ssq = wsum(ssq);
    const float rstd = rsqrtf(ssq * (1.0f / DM) + EPSF);
    const float4* g4 = (const float4*)(gnext + lane * 16);
    if (FINAL) {
      float* op = outp + (size_t)tok * DM + lane * 16;
#pragma unroll
      for (int c = 0; c < 4; c++) {
        const float4 gq = g4[c];
        *(float4*)(op + c * 4) = make_float4(xv[c * 4] * rstd * gq.x, xv[c * 4 + 1] * rstd * gq.y, xv[c * 4 + 2] * rstd * gq.z, xv[c * 4 + 3] * rstd * gq.w);
      }
    } else {
      uint4 o0, o1;
      { const float4 ga = g4[0], gb = g4[1];
        o0.x = pk2(xv[0] * rstd * ga.x, xv[1] * rstd * ga.y); o0.y = pk2(xv[2] * rstd * ga.z, xv[3] * rstd * ga.w);
        o0.z = pk2(xv[4] * rstd * gb.x, xv[5] * rstd * gb.y); o0.w = pk2(xv[6] * rstd * gb.z, xv[7] * rstd * gb.w); }
      { const float4 ga = g4[2], gb = g4[3];
        o1.x = pk2(xv[8] * rstd * ga.x, xv[9] * rstd * ga.y); o1.y = pk2(xv[10] * rstd * ga.z, xv[11] * rstd * ga.w);
        o1.z = pk2(xv[12] * rstd * gb.x, xv[13] * rstd * gb.y); o1.w = pk2(xv[14] * rstd * gb.z, xv[15] * rstd * gb.w); }
      *(uint4*)(xn + (size_t)tok * DM + lane * 16) = o0;
      *(uint4*)(xn + (size_t)tok * DM + lane * 16 + 8) = o1;
    }
  }
}

__device__ __forceinline__ void prologue_transposes(const int wave_s, const Params& p, unsigned char* ws, LAS unsigned char* lds) {
  const int tid_ = opaque_tid(wave_s);
  const int lane = tid_ & 63, wave = tid_ >> 6;
  LAS float* scr = (LAS float*)(lds + wave * 16384);
  const int gw = blockIdx.x * NWAVES + wave, NGW = gridDim.x * NWAVES;
  constexpr int I_IN = (DM / 64) * (DIN / 32), I_SQ = (DM / 64) * (DM / 32), I_2K = (DM / 64) * (2048 / 32);
  constexpr int I_GL = (256 / 64) * (256 / 32);
  constexpr int PER_LAYER = I_IN + 3 * I_SQ + 2 * I_2K + I_GL;
  const float* w3 = karg_in(3); const float* w19 = karg_in(19); const float* w22 = karg_in(22);
  const float* w23 = karg_in(23); const float* w24 = karg_in(24); const float* w26 = karg_in(26);
  const float* w16 = karg_in(16);
  for (int it = gw; it < 2 * PER_LAYER; it += NGW) {
    const int l = it / PER_LAYER;
    int r = it % PER_LAYER;
    unsigned char* wl = ws + WS_WT + (size_t)l * WT_LAYER;
    if (r < I_IN) { transpose_item(w3 + (size_t)l * DM * DIN, DM, DIN, (bf16*)(wl + WT_IN), scr, r, lane); continue; } r -= I_IN;
    if (r < I_SQ) { transpose_item(w19 + (size_t)l * DM * DM, DM, DM, (bf16*)(wl + WT_OUT), scr, r, lane); continue; } r -= I_SQ;
    if (r < I_SQ) { transpose_item(w22 + (size_t)l * DM * DM, DM, DM, (bf16*)(wl + WT_MQ), scr, r, lane); continue; } r -= I_SQ;
    if (r < I_2K) { transpose_item(w23 + (size_t)l * DM * 2048, DM, 2048, (bf16*)(wl + WT_MKV), scr, r, lane); continue; } r -= I_2K;
    if (r < I_SQ) { transpose_item(w24 + (size_t)l * DM * DM, DM, DM, (bf16*)(wl + WT_MO), scr, r, lane); continue; } r -= I_SQ;
    if (r < I_2K) { transpose_item(w26 + (size_t)l * DM * 2048, DM, 2048, (bf16*)(wl + WT_PQ), scr, r, lane); continue; } r -= I_2K;
    transpose_item(w16 + (size_t)l * 256 * 256, 256, 256, (bf16*)(wl + WT_GLU), scr, r, lane);
  }
}

template <class T> __device__ __forceinline__ T* opq(T* p) { asm volatile("" : "+s"(p)); return p; }
__device__ __forceinline__ void cvt_rows_bf16(const int wave_s, const float* src, bf16* dst, size_t n) {
  const int tid_ = opaque_tid(wave_s);
  const size_t gt = (size_t)blockIdx.x * (NWAVES * 64) + tid_;
  const size_t nth = (size_t)gridDim.x * NWAVES * 64;
  for (size_t i = gt; i < n / 8; i += nth) {
    const float4 a = ((const float4*)src)[2 * i], b = ((const float4*)src)[2 * i + 1];
    uint4 o; o.x = pk2(a.x, a.y); o.y = pk2(a.z, a.w); o.z = pk2(b.x, b.y); o.w = pk2(b.z, b.w);
    ((uint4*)dst)[i] = o;
  }
}

__device__ __forceinline__ unsigned enc_e4m3(float x) {
  const _Float16 hf = (_Float16)x;
  const unsigned h = (unsigned)__builtin_bit_cast(unsigned short, hf);
  return ((h + 0x7Fu + ((h >> 8) & 1u)) >> 8) & 0xFFu;
}
__device__ __forceinline__ void cvt_rows_e4m3(const int wave_s, const float* src, unsigned char* dst, size_t n, float sc) {
  const int tid_ = opaque_tid(wave_s);
  const size_t gt = (size_t)blockIdx.x * (NWAVES * 64) + tid_;
  const size_t nth = (size_t)gridDim.x * NWAVES * 64;
  for (size_t i = gt; i < n / 16; i += nth) {
    unsigned w[4];
#pragma unroll
    for (int k = 0; k < 4; k++) {
      const float4 a = ((const float4*)src)[4 * i + k];
      w[k] = enc_e4m3(a.x * sc) | (enc_e4m3(a.y * sc) << 8) | (enc_e4m3(a.z * sc) << 16) | (enc_e4m3(a.w * sc) << 24);
    }
    uint4 o; o.x = w[0]; o.y = w[1]; o.z = w[2]; o.w = w[3];
    ((uint4*)dst)[i] = o;
  }
}

__device__ __forceinline__ unsigned enc_v4(float z) {
  const float az = fabsf(z);
  unsigned c = 0;
  c += az > 0.25f; c += az > 0.5f; c += az > 0.75f; c += az > 1.0625f; c += az > 1.375f; c += az > 1.75f; c += az > 2.25f;
  return c | ((__builtin_bit_cast(unsigned, z) >> 28) & 8u);
}
__device__ __forceinline__ void cvt_rows_i4(const int wave_s, const float* src, unsigned char* dst, float* sc_out, int nrows) {
  const int tid_ = opaque_tid(wave_s);
  const int lane = tid_ & 63;
  const int gw = blockIdx.x * NWAVES + (tid_ >> 6);
  const int nw = gridDim.x * NWAVES;
  for (int r = gw; r < nrows; r += nw) {
    const float4* sp = (const float4*)(src + (size_t)r * 1024 + lane * 16);
    const float4 a0 = sp[0], a1 = sp[1], a2 = sp[2], a3 = sp[3];
    const float xv[16] = {a0.x, a0.y, a0.z, a0.w, a1.x, a1.y, a1.z, a1.w, a2.x, a2.y, a2.z, a2.w, a3.x, a3.y, a3.z, a3.w};
    float ss = 0.f;
#pragma unroll
    for (int i = 0; i < 16; i++) ss += xv[i] * xv[i];
    ss = wsum(ss);
    const float sc = sqrtf(ss * (1.0f / 1024.f)) * U4_STEP;
    const float inv = sc > 0.f ? 1.0f / sc : 0.f;
    unsigned w[2] = {0u, 0u};
#pragma unroll
    for (int i = 0; i < 16; i++) {
      const float f = fminf(fmaxf(floorf(xv[i] * inv), -8.f), 7.f);
      w[i >> 3] |= ((unsigned)(int)f & 15u) << (4 * (i & 7));
    }
    uint2 o; o.x = w[0]; o.y = w[1];
    *(uint2*)(dst + (size_t)r * 512 + lane * 8) = o;
    if (lane == 0) sc_out[2 * r] = sc;
  }
}
__device__ __forceinline__ void cvt_rows_v4(const int wave_s, const float* src, unsigned char* dst, float* sc_out, int nrows) {
  const int tid_ = opaque_tid(wave_s);
  const int lane = tid_ & 63;
  const int gw = blockIdx.x * NWAVES + (tid_ >> 6);
  const int nw = gridDim.x * NWAVES;
  for (int r = gw; r < nrows; r += nw) {
    const float4* sp = (const float4*)(src + (size_t)r * 1024 + lane * 16);
    const float4 a0 = sp[0], a1 = sp[1], a2 = sp[2], a3 = sp[3];
    const float xv[16] = {a0.x, a0.y, a0.z, a0.w, a1.x, a1.y, a1.z, a1.w, a2.x, a2.y, a2.z, a2.w, a3.x, a3.y, a3.z, a3.w};
    float ss = 0.f;
#pragma unroll
    for (int i = 0; i < 16; i++) ss += xv[i] * xv[i];
    ss = wsum(ss);
    const float sc = sqrtf(ss * (1.0f / 1024.f)) * V4_ROWSCALE;
    const float inv = sc > 0.f ? 1.0f / sc : 0.f;
    unsigned w[2] = {0u, 0u};
#pragma unroll
    for (int i = 0; i < 16; i++) w[i >> 3] |= enc_v4(xv[i] * inv) << (4 * (i & 7));
    uint2 o; o.x = w[0]; o.y = w[1];
    *(uint2*)(dst + (size_t)r * 512 + lane * 8) = o;
    if (lane == 0) sc_out[2 * r] = sc;
  }
}

#define GEMM_F32(Aptr, Wt, Cptr, Rptr, M_, N_) do { \
    pg8::Gemm g_{opq((const bf16*)(Aptr)), opq((const bf16*)(Wt)), (M_), (N_), DM}; pg8::StaticOrder S_; S_.init((M_), (N_), (int)gridDim.x, (int)blockIdx.x); \
    pg8::EpiF32R E_{opq((float*)(Cptr)), opq((const float*)(Rptr)), (N_)}; \
    pg8::gemm_phase<pg8::EpiF32R, pg8::StaticOrder, true, true>(wave_s, ldsl, g_, S_, E_); } while (0)
#define GEMM_BF16_C(Aptr, Wt, Optr, M_, N_, C_) do { \
    pg8::Gemm g_{opq((const bf16*)(Aptr)), opq((const bf16*)(Wt)), (M_), (N_), DM}; pg8::StaticOrder S_; S_.init((M_), (N_), (int)gridDim.x, (C_)); \
    pg8::EpiBf16 E_{opq((bf16*)(Optr)), (N_)}; \
    pg8::gemm_phase<pg8::EpiBf16, pg8::StaticOrder, true, true>(wave_s, ldsl, g_, S_, E_); } while (0)
#define GEMM_BF16(Aptr, Wt, Optr, M_, N_) GEMM_BF16_C(Aptr, Wt, Optr, M_, N_, (int)blockIdx.x)
#define GEMM_F32RN(Aptr, Wt, Cptr, Rptr, XGptr, Gptr, STptr) do { \
    pg8::Gemm g_{opq((const bf16*)(Aptr)), opq((const bf16*)(Wt)), NT, DM, DM}; pg8::StaticOrder S_; S_.init(NT, DM, (int)gridDim.x, (int)blockIdx.x); \
    pg8::EpiF32RN E_{opq((float*)(Cptr)), opq((const float*)(Rptr)), DM, opq((bf16*)(XGptr)), opq((const float*)(Gptr)), opq((float*)(STptr))}; \
    pg8::gemm_phase<pg8::EpiF32RN, pg8::StaticOrder, true, true>(wave_s, ldsl, g_, S_, E_); } while (0)
#define GEMM_BF16S(Aptr, Wt, Optr, N_, STptr) do { \
    pg8::Gemm g_{opq((const bf16*)(Aptr)), opq((const bf16*)(Wt)), NT, (N_), DM}; pg8::StaticOrder S_; S_.init(NT, (N_), (int)gridDim.x, (int)blockIdx.x); \
    pg8::EpiBf16S E_{opq((bf16*)(Optr)), (N_), opq((const float*)(STptr))}; \
    pg8::gemm_phase<pg8::EpiBf16S, pg8::StaticOrder, true, true>(wave_s, ldsl, g_, S_, E_); } while (0)

__global__ void __launch_bounds__(NWAVES * 64, 2) fwd_megakernel(Params p) {
  extern __shared__ __attribute__((aligned(16))) unsigned char lds[];
  LAS unsigned char* ldsl = (LAS unsigned char*)lds;
  LAS float* smem = (LAS float*)ldsl;
  const int wave_s = __builtin_amdgcn_readfirstlane((int)(threadIdx.x >> 6));
  unsigned char* ws = p.ws;
  volatile LAS unsigned* MISC = (volatile LAS unsigned*)(ldsl + (LDS_BYTES - 256));
  if (threadIdx.x < 64) MISC[threadIdx.x] = 0u;
  __syncthreads();
  const XcdBarrier bar = xcd_barrier_post((unsigned*)(ws + WS_CTL) + 4096, MISC + 8);
  float* xw = (float*)(ws + WS_XW);
  bf16* xn = (bf16*)(ws + WS_XN);
  bf16* big = (bf16*)(ws + WS_BIG);
  bf16* y = (bf16*)(ws + WS_Y);
  bf16* memh = (bf16*)(ws + WS_MEMH);
  bf16* kvb = (bf16*)(ws + WS_KVB);
  bf16* vT = (bf16*)(ws + WS_VT);
  float* ssmE = (float*)(ws + WS_SSME);
  float* ssmp = (float*)(ws + WS_SSMP);
  int* ids = (int*)(ws + WS_IDS);
  float* gates = (float*)(ws + WS_GATE);
  bf16* skb = (bf16*)(ws + WS_SKB);
  unsigned char* ub = ws + WS_UB;
  unsigned char* vb = ws + WS_VB;
  float* rst = (float*)(ws + WS_RST);
  float* vsc = (float*)(ws + WS_VSC);
  float* usc = (float*)(ws + WS_USC);

  prologue_transposes(wave_s, p, ws, ldsl);
  cvt_rows_bf16(wave_s, karg_in(27), skb, (size_t)2 * 8 * 2 * 128 * 128);
  cvt_rows_i4(wave_s, karg_in(28), ub, vsc + 1, 2 * 16384);
  cvt_rows_v4(wave_s, karg_in(29), vb, vsc, 2 * 16384);
  for (int l = 0; l < 2; l++)
    rms_rows<true>(wave_s, karg_in(1), karg_in(21) + l * DM, memh + (size_t)l * 1024 * 1024, 1024);
  ssm_params(wave_s, p, ssmp);
  rms_rows<true>(wave_s, karg_in(0), karg_in(2), xn, NT);
  xcd_barrier(bar);
  for (int l = 0; l < 2; l++)
    GEMM_BF16_C(memh + (size_t)l * 1024 * 1024, ws + WS_WT + (size_t)l * WT_LAYER + WT_MKV,
              kvb + (size_t)l * 1024 * 2048, 1024, 2048, (int)((blockIdx.x + gridDim.x - 64u - 32u * (unsigned)l) % gridDim.x));

#pragma nounroll
  for (int l = 0; l < 2; l++) {
    const float* xcur = (l == 0) ? karg_in(0) : xw;
    const float* sp = ssmp + (size_t)l * SSMP_PER_LAYER;
    const unsigned char* wl = ws + WS_WT + (size_t)l * WT_LAYER;
    GEMM_BF16(xn, wl + WT_IN, big, NT, DIN);
    xcd_barrier(bar);
    if (l == 0) vt_phase(wave_s, kvb, vT);
    ssm_chunk_end(wave_s, sp, big, ssmE, smem);
    attn_phase(wave_s, p, l, big, y, smem);
    conv_phase(wave_s, p, l, big, y, smem);
    xcd_barrier(bar);
    ssm_finish(wave_s, p, l, sp, big, ssmE, y, smem);
    xcd_barrier(bar);
    GEMM_F32RN(y, wl + WT_OUT, xw, xcur, xn, karg_in(20) + l * DM, rst);
    xcd_barrier(bar);
    GEMM_BF16S(xn, wl + WT_MQ, big, DM, rst);
    xcd_barrier(bar);
    memattn_phase(wave_s, big, kvb + (size_t)l * 1024 * 2048, vT + (size_t)l * 4 * 4 * 256 * 256, y, smem);
    xcd_barrier(bar);
    GEMM_F32RN(y, wl + WT_MO, xw, (const float*)xw, xn, karg_in(25) + l * DM, rst);
    xcd_barrier(bar);
    GEMM_BF16S(xn, wl + WT_PQ, big, 2048, rst);
    xcd_barrier(bar);
    peer_topk(wave_s, big, skb + (size_t)l * 8 * 2 * 128 * 128, ids, gates, smem);
    asm volatile("s_waitcnt vmcnt(0)" ::: "memory");
    __syncthreads();
    if (l == 0) {
      peer_gather<false>(wave_s, xn, rst, ub + (size_t)l * 16384 * 512, vb + (size_t)l * 16384 * 512, vsc + (size_t)l * 2 * 16384, usc, ids, gates, xw, karg_in(2) + DM, (float*)nullptr);
      xcd_barrier(bar);
    } else {
      peer_gather<true>(wave_s, xn, rst, ub + (size_t)l * 16384 * 512, vb + (size_t)l * 16384 * 512, vsc + (size_t)l * 2 * 16384, usc, ids, gates, xw, karg_in(30), p.out);
    }
  }
}

extern "C" void kernel_launch(void* const* d_in, const int* in_sizes, int n_in,
                              void* d_out, int out_size, void* d_ws, size_t ws_size,
                              hipStream_t stream) {
  static int grid_blocks = 0;
  if (!grid_blocks) {
    int dev = 0, cus = 0, per_cu = 0;
    (void)hipGetDevice(&dev);
    (void)hipDeviceGetAttribute(&cus, hipDeviceAttributeMultiprocessorCount, dev);
    (void)hipFuncSetAttribute((const void*)fwd_megakernel, hipFuncAttributeMaxDynamicSharedMemorySize, LDS_BYTES);
    (void)hipOccupancyMaxActiveBlocksPerMultiprocessor(&per_cu, fwd_megakernel, NWAVES * 64, LDS_BYTES);
    if (per_cu < 1) fprintf(stderr, "occupancy query reports %d blocks/CU\n", per_cu);
    grid_blocks = cus;
  }
  (void)hipMemsetAsync((char*)d_ws + WS_CTL, 0, 65536, stream);
  Params p{};
  for (int i = 0; i < 31; i++) p.in[i] = (const float*)d_in[i];
  p.out = (float*)d_out;
  p.ws = (unsigned char*)d_ws;
  void* args[] = {&p};
  hipError_t e = hipLaunchCooperativeKernel((void*)fwd_megakernel, dim3(grid_blocks), dim3(NWAVES * 64),
                                            args, LDS_BYTES, stream);
  if (e != hipSuccess)
    fprintf(stderr, "cooperative launch failed: %s (grid %d)\n", hipGetErrorString(e), grid_blocks);
}
```

```cpp
#include <hip/hip_runtime.h>
#include <hip/hip_cooperative_groups.h>
#include <cstdio>
namespace cg = cooperative_groups;

#define NT 16384
#define SEQ 4096
#define DM 1024
#define DIN 2304
#define NMEM 256
#define EPSF 1e-6f
#define NWAVES 8
#define LDS_BYTES 147456

typedef unsigned short bf16;
#define LAS __attribute__((address_space(3)))

struct Params {
  const float* in[31];
  float* out;
  unsigned char* ws;
};
typedef __attribute__((address_space(4))) const unsigned char* kaptr_t;
__device__ __forceinline__ const float* karg_in(int i) {
  kaptr_t ka = (kaptr_t)__builtin_amdgcn_kernarg_segment_ptr();
  asm volatile("" : "+s"(ka));
  return *(const float* __attribute__((address_space(4))) const*)(ka + 8 * i);
}

constexpr size_t MiB = 1u << 20;
constexpr size_t WS_CTL  = 0;
constexpr size_t WS_WT   = 1 * MiB;
constexpr size_t WT_IN = 0, WT_OUT = WT_IN + (size_t)DIN * DM * 2, WT_MQ = WT_OUT + (size_t)DM * DM * 2,
                 WT_MKV = WT_MQ + (size_t)DM * DM * 2, WT_MO = WT_MKV + (size_t)2048 * DM * 2,
                 WT_PQ = WT_MO + (size_t)DM * DM * 2, WT_GLU = WT_PQ + (size_t)2048 * DM * 2, WT_LAYER = WT_GLU + (size_t)256 * 256 * 2;
constexpr size_t WS_XW   = WS_WT + 2 * WT_LAYER;
constexpr size_t WS_XN   = WS_XW + (size_t)NT * DM * 4;
constexpr size_t WS_BIG  = WS_XN + (size_t)NT * DM * 2;
constexpr size_t WS_Y    = WS_BIG + (size_t)NT * DIN * 2;
constexpr size_t WS_MEMH = WS_Y + (size_t)NT * DM * 2;
constexpr size_t WS_KVB  = WS_MEMH + (size_t)2 * 1024 * 1024 * 2;
constexpr size_t WS_VT   = WS_KVB + (size_t)2 * 1024 * 2048 * 2;
constexpr size_t WS_SSME = WS_VT + (size_t)2 * 4 * 4 * 256 * 256 * 2;
#define SSMP_PER_LAYER (2048 + 2048 + 32768)
constexpr size_t WS_SSMP = WS_SSME + (size_t)4 * 64 * 16 * 64 * 2 * 4;
constexpr size_t WS_IDS  = WS_SSMP + (size_t)2 * SSMP_PER_LAYER * 4;
constexpr size_t WS_GATE = WS_IDS + (size_t)NT * 128 * 4;
constexpr size_t WS_SKB  = WS_GATE + (size_t)NT * 128 * 4;
constexpr size_t WS_UB   = WS_SKB + (size_t)2 * 8 * 2 * 128 * 128 * 2;
constexpr size_t WS_VB   = WS_UB + (size_t)2 * 16384 * 512;
constexpr size_t WS_VSC  = WS_VB + (size_t)2 * 16384 * 512;
constexpr size_t WS_USC  = WS_VSC + (size_t)2 * 16384 * 4;
constexpr size_t WS_RST  = WS_USC + (size_t)2 * 16384 * 4;
constexpr size_t WS_END  = WS_RST + (size_t)NT * 16 * 4;
#define U_SCALE 64.0f
#define U4_STEP 0.3352f
#define V4_LUT_LO 0x3B393630u
#define V4_LUT_HI 0x41403E3Du
#define V4_ROWSCALE 1.075f
static_assert(WS_END <= 512 * MiB, "workspace");
static_assert(WT_LAYER % 256 == 0 && WS_SSMP % 16 == 0 && WS_IDS % 16 == 0 && WS_SKB % 256 == 0 && WS_VT % 256 == 0, "align");

__device__ __forceinline__ int opaque_tid(int wave_s) { int v = wave_s * 64 + (int)__builtin_amdgcn_mbcnt_hi(~0u, __builtin_amdgcn_mbcnt_lo(~0u, 0u)); asm volatile("" : "+v"(v)); return v; }
typedef __bf16 bf16n2_t __attribute__((ext_vector_type(2)));
typedef float f32n2_t __attribute__((ext_vector_type(2)));
__device__ __forceinline__ unsigned pk2(float lo, float hi) { f32n2_t v; v[0] = lo; v[1] = hi; return __builtin_bit_cast(unsigned, __builtin_convertvector(v, bf16n2_t)); }
__device__ __forceinline__ unsigned f2bf(float f) { return (unsigned)__builtin_bit_cast(unsigned short, (__bf16)f); }
__device__ __forceinline__ float bf_lo(unsigned u) { return __builtin_bit_cast(float, u << 16); }
__device__ __forceinline__ float bf_hi(unsigned u) { return __builtin_bit_cast(float, u & 0xffff0000u); }
__device__ __forceinline__ float bf2f(bf16 h) { return __builtin_bit_cast(float, (unsigned)h << 16); }


#define XB_TMO      128
#define XB_XCNT(j)  (256  + 64 * (j))
#define XB_XSUB(j)  (1280 + 64 * (j))
#define XB_XGEN(j)  (2304 + 64 * (j))
#define XB_TOP      3328
#define XB_TOPGEN   3392
#define XCD_BAR_WORDS 3456
#define XB_SPIN_CAP (1u << 22)
__device__ __forceinline__ unsigned xb_ld(unsigned* p)              { return __hip_atomic_load(p, __ATOMIC_RELAXED, __HIP_MEMORY_SCOPE_AGENT); }
__device__ __forceinline__ unsigned xb_add(unsigned* p, unsigned v) { return __hip_atomic_fetch_add(p, v, __ATOMIC_RELAXED, __HIP_MEMORY_SCOPE_AGENT); }
__device__ __forceinline__ unsigned xb_xcc_id() { return (unsigned)__builtin_amdgcn_s_getreg((3 << 11) | 20) & 0xFu; }
#define XB_SPIN(cond, bar) do { unsigned _sp = 0; while (cond) { __builtin_amdgcn_s_sleep(1); \
    if ((++_sp & 255u) == 0u) { if (xb_ld(&(bar)[XB_TMO])) break; if (_sp > XB_SPIN_CAP) { atomicAdd(&(bar)[XB_TMO], 1u); break; } } } } while (0)
struct XcdBarrier { unsigned* bar; unsigned x; volatile LAS unsigned* st; };
__device__ __forceinline__ XcdBarrier xcd_barrier_post(unsigned* bar, volatile LAS unsigned* st) {
    XcdBarrier b; b.bar = bar; b.x = xb_xcc_id(); b.st = st;
    if (threadIdx.x == 0) (void)xb_add(&bar[XB_XCNT(b.x)], 1u);
    return b;
}
__device__ __forceinline__ void xcd_barrier_complete(unsigned* bar, unsigned x, unsigned& nloc, unsigned& nx) {
    const unsigned G = gridDim.x * gridDim.y * gridDim.z;
    unsigned sum, cnt, mine, sp = 0u;
    for (;;) {
        sum = 0u; cnt = 0u; mine = 0u;
#pragma unroll
        for (unsigned j = 0; j < 16; ++j) { const unsigned c = xb_ld(&bar[XB_XCNT(j)]); sum += c; cnt += (c > 0u) ? 1u : 0u; mine = (j == x) ? c : mine; }
        if (sum == G) break;
        __builtin_amdgcn_s_sleep(1);
        if ((++sp & 255u) == 0u) { if (xb_ld(&bar[XB_TMO])) break; if (sp > XB_SPIN_CAP) { atomicAdd(&bar[XB_TMO], 1u); break; } }
    }
    nloc = mine > 0u ? mine : 1u; nx = cnt > 0u ? cnt : 1u;
}
__device__ __forceinline__ void flag_arrive(unsigned* cnt) {
    asm volatile("s_waitcnt vmcnt(0)" ::: "memory");
    __syncthreads();
    if (threadIdx.x == 0) { __builtin_amdgcn_fence(__ATOMIC_RELEASE, "agent"); asm volatile("s_waitcnt vmcnt(0)" ::: "memory"); (void)xb_add(cnt, 1u); }
}
__device__ __forceinline__ void flag_wait(unsigned* cnt, unsigned* bar) {
    asm volatile("s_waitcnt vmcnt(0)" ::: "memory");
    __syncthreads();
    if (threadIdx.x == 0) {
        const unsigned G = gridDim.x * gridDim.y * gridDim.z;
        XB_SPIN(xb_ld(cnt) < G, bar);
        __builtin_amdgcn_fence(__ATOMIC_ACQUIRE, "agent");
        asm volatile("s_waitcnt vmcnt(0)" ::: "memory");
    }
    __syncthreads();
}
__device__ __forceinline__ void xcd_barrier(const XcdBarrier& b) {
    asm volatile("s_waitcnt vmcnt(0)" ::: "memory");
    __syncthreads();
    if (threadIdx.x == 0) {
        unsigned* bar = b.bar;
        __builtin_amdgcn_s_waitcnt(0);
        unsigned nloc = b.st[0], nx = b.st[1];
        if (nloc == 0u) { xcd_barrier_complete(bar, b.x, nloc, nx); b.st[0] = nloc; b.st[1] = nx; }
        const unsigned old = xb_add(&bar[XB_XSUB(b.x)], 1u);
        const unsigned gen = old / nloc;
        if (old + 1u == (gen + 1u) * nloc) {
            __builtin_amdgcn_fence(__ATOMIC_RELEASE, "agent");
            asm volatile("s_waitcnt vmcnt(0)" ::: "memory");
            const unsigned og = xb_add(&bar[XB_TOP], 1u);
            const unsigned tg = og / nx;
            if (og + 1u == (tg + 1u) * nx) xb_add(&bar[XB_TOPGEN], 1u);
            else XB_SPIN(xb_ld(&bar[XB_TOPGEN]) == tg, bar);
            __builtin_amdgcn_fence(__ATOMIC_ACQUIRE, "agent");
            xb_add(&bar[XB_XGEN(b.x)], 1u);
            asm volatile("s_waitcnt vmcnt(0)" ::: "memory");
        } else {
            XB_SPIN(xb_ld(&bar[XB_XGEN(b.x)]) == gen, bar);
            __builtin_amdgcn_fence(__ATOMIC_ACQUIRE, "agent");
            asm volatile("s_waitcnt vmcnt(0)" ::: "memory");
        }
    }
    __syncthreads();
}

namespace pg8 {
#define PG8_LAS __attribute__((address_space(3)))
typedef unsigned short bf16_t;
typedef short bf16x8 __attribute__((ext_vector_type(8)));
typedef float f32x4 __attribute__((ext_vector_type(4)));
typedef unsigned u32x4 __attribute__((ext_vector_type(4)));
constexpr int BM = 256, BK = 64, HALF = 128, HTB = HALF * BK * 2, STAGE_BYTES = 8 * HTB, NXCD = 8, WGM = 8;
__host__ __device__ __forceinline__ int lds_byte(int r, int c) { const int st = (r >> 4) * 2 + (c >> 5), rr = r & 15, cc = c & 31, ob = rr * 64 + cc * 2; return st * 1024 + (ob ^ (((ob >> 9) & 1) << 5)); }
__host__ __device__ __forceinline__ void stage_rc(int b, int& R, int& C) { const int st = b / 1024, sb = b % 1024, swz = sb ^ (((sb >> 9) & 1) << 5); R = (st >> 1) * 16 + swz / 64; C = (st & 1) * 32 + (swz % 64) / 2; }
__host__ __device__ __forceinline__ int perm32(int rho) { const int n = rho >> 4, i = rho & 15; return 8 * (i >> 2) + 4 * n + (i & 3); }
struct Unit { int pm, pn; };
struct Gemm { const bf16_t* A; const bf16_t* Bt; int M, N, K; };
struct StaticOrder {
    int nM, nN, nwg, G, c;
    __host__ __device__ __forceinline__ void init(int M, int N, int G_, int c_) { nM = M / BM; nN = N / BM; nwg = nM * nN; G = G_; c = c_; }
    __host__ __device__ bool next(int i, Unit& u) const {
        const long L = (long)i * G + c; if (L >= nwg) return false;
        int wgid = (int)L; { const int q = nwg / NXCD, r = nwg % NXCD, xcd = wgid % NXCD, off = wgid / NXCD; wgid = (xcd < r ? xcd * (q + 1) : r * (q + 1) + (xcd - r) * q) + off; }
        const int nig = WGM * nN, gid = wgid / nig, fm = gid * WGM, gsz = (nM - fm) < WGM ? (nM - fm) : WGM;
        u.pm = fm + ((wgid % nig) % gsz); u.pn = (wgid % nig) / gsz; return true;
    }
    __device__ __forceinline__ void a_ready(const Unit&) const {}
    __device__ __forceinline__ void done(const Unit&) const {}
};
__device__ __forceinline__ unsigned cvt_pk_bf16(float lo, float hi) { unsigned r; asm volatile("v_cvt_pk_bf16_f32 %0, %1, %2" : "=v"(r) : "v"(lo), "v"(hi)); return r; }

struct EpiF32R {
    static constexpr bool PERM = false, AFTER_DRAIN = false;
    float* C; const float* R; int ldc;
    __device__ __forceinline__ void operator()(const f32x4 (&acc)[2][2][4][2], const Unit& u, int wr, int wc, int fr, int fq) const {
        const int row0 = u.pm * BM + wr * 64 + fr, col0 = u.pn * BM + wc * 32 + 4 * fq;
#pragma unroll
        for (int ai = 0; ai < 2; ++ai)
#pragma unroll
            for (int m = 0; m < 4; ++m) {
                const size_t ro = (size_t)(row0 + ai * HALF + m * 16) * ldc + col0;
                f32x4 rv[2][2];
#pragma unroll
                for (int bj = 0; bj < 2; ++bj)
#pragma unroll
                    for (int n = 0; n < 2; ++n) rv[bj][n] = R ? *(const f32x4*)(R + ro + bj * HALF + n * 16) : (f32x4){0.f, 0.f, 0.f, 0.f};
#pragma unroll
                for (int bj = 0; bj < 2; ++bj)
#pragma unroll
                    for (int n = 0; n < 2; ++n) *(f32x4*)(C + ro + bj * HALF + n * 16) = acc[ai][bj][m][n] + rv[bj][n];
                __builtin_amdgcn_sched_barrier(0);
            }
    }
};

struct EpiBf16 {
    static constexpr bool PERM = true, AFTER_DRAIN = false;
    bf16_t* O; int ldc;
    __device__ __forceinline__ void operator()(const f32x4 (&acc)[2][2][4][2], const Unit& u, int wr, int wc, int fr, int fq) const {
        const int row0 = u.pm * BM + wr * 64 + fr, col0 = u.pn * BM + wc * 32 + 8 * fq;
#pragma unroll
        for (int ai = 0; ai < 2; ++ai)
#pragma unroll
            for (int m = 0; m < 4; ++m) { bf16_t* rowp = O + (size_t)(row0 + ai * HALF + m * 16) * ldc + col0;
#pragma unroll
                for (int bj = 0; bj < 2; ++bj) { const f32x4 v0 = acc[ai][bj][m][0], v1 = acc[ai][bj][m][1];
                    u32x4 w; w.x = cvt_pk_bf16(v0[0], v0[1]); w.y = cvt_pk_bf16(v0[2], v0[3]); w.z = cvt_pk_bf16(v1[0], v1[1]); w.w = cvt_pk_bf16(v1[2], v1[3]);
                    *(u32x4*)(rowp + bj * HALF) = w; } }
    }
};

struct EpiF32RN {
    static constexpr bool PERM = false, AFTER_DRAIN = false;
    float* C; const float* R; int ldc; bf16_t* XG; const float* g; float* st;
    __device__ __forceinline__ void operator()(const f32x4 (&acc)[2][2][4][2], const Unit& u, int wr, int wc, int fr, int fq) const {
        const int row0 = u.pm * BM + wr * 64 + fr, col0 = u.pn * BM + wc * 32 + 4 * fq;
        f32x4 gv[2][2];
#pragma unroll
        for (int bj = 0; bj < 2; ++bj)
#pragma unroll
            for (int n = 0; n < 2; ++n) gv[bj][n] = *(const f32x4*)(g + col0 + bj * HALF + n * 16);
#pragma unroll
        for (int ai = 0; ai < 2; ++ai)
#pragma unroll
            for (int m = 0; m < 4; ++m) {
                const int row = row0 + ai * HALF + m * 16;
                const size_t ro = (size_t)row * ldc + col0;
                f32x4 rv[2][2];
#pragma unroll
                for (int bj = 0; bj < 2; ++bj)
#pragma unroll
                    for (int n = 0; n < 2; ++n) rv[bj][n] = *(const f32x4*)(R + ro + bj * HALF + n * 16);
                float ss = 0.f;
#pragma unroll
                for (int bj = 0; bj < 2; ++bj)
#pragma unroll
                    for (int n = 0; n < 2; ++n) {
                        const f32x4 v = acc[ai][bj][m][n] + rv[bj][n];
                        *(f32x4*)(C + ro + bj * HALF + n * 16) = v;
                        ss += (v[0] * v[0] + v[1] * v[1]) + (v[2] * v[2] + v[3] * v[3]);
                        const f32x4 w = v * gv[bj][n];
                        uint2 pk; pk.x = cvt_pk_bf16(w[0], w[1]); pk.y = cvt_pk_bf16(w[2], w[3]);
                        *(uint2*)(XG + ro + bj * HALF + n * 16) = pk;
                    }
                ss += __shfl_xor(ss, 16, 64); ss += __shfl_xor(ss, 32, 64);
                if (fq == 0) st[(size_t)row * 16 + u.pn * 4 + wc] = ss;
                __builtin_amdgcn_sched_barrier(0);
            }
    }
};
struct EpiBf16S {
    static constexpr bool PERM = true, AFTER_DRAIN = false;
    bf16_t* O; int ldc; const float* st;
    __device__ __forceinline__ void operator()(const f32x4 (&acc)[2][2][4][2], const Unit& u, int wr, int wc, int fr, int fq) const {
        const int row0 = u.pm * BM + wr * 64 + fr, col0 = u.pn * BM + wc * 32 + 8 * fq;
#pragma unroll
        for (int ai = 0; ai < 2; ++ai)
#pragma unroll
            for (int m = 0; m < 4; ++m) {
                const int row = row0 + ai * HALF + m * 16;
                const f32x4* sp = (const f32x4*)(st + (size_t)row * 16);
                const f32x4 s0 = sp[0], s1 = sp[1], s2 = sp[2], s3 = sp[3];
                const f32x4 sa = (s0 + s1) + (s2 + s3);
                const float rs = __builtin_amdgcn_rsqf(((sa[0] + sa[1]) + (sa[2] + sa[3])) * (1.0f / 1024.f) + 1e-6f);
                bf16_t* rowp = O + (size_t)row * ldc + col0;
#pragma unroll
                for (int bj = 0; bj < 2; ++bj) { const f32x4 v0 = acc[ai][bj][m][0] * rs, v1 = acc[ai][bj][m][1] * rs;
                    u32x4 w; w.x = cvt_pk_bf16(v0[0], v0[1]); w.y = cvt_pk_bf16(v0[2], v0[3]); w.z = cvt_pk_bf16(v1[0], v1[1]); w.w = cvt_pk_bf16(v1[2], v1[3]);
                    *(u32x4*)(rowp + bj * HALF) = w; }
                __builtin_amdgcn_sched_barrier(0);
            }
    }
};

template <class Epi, class Sched, bool ALIGN_EPI = false, bool SP2 = false>
__device__ __forceinline__ void gemm_phase(const int wave_s, PG8_LAS unsigned char* lds, const Gemm g, const Sched& S, const Epi& E) {
    const int tid = opaque_tid(wave_s), wid = __builtin_amdgcn_readfirstlane(tid >> 6), lane = tid & 63, wr = wid >> 2, wc = wid & 3, fr = lane & 15, fq = lane >> 4;
    const int K = g.K, nt = K / BK;
    unsigned voffA[2], voffB[2];
#pragma unroll
    for (int i = 0; i < 2; ++i) { int R, C; stage_rc(tid * 16 + i * 8192, R, C); const int Rb = Epi::PERM ? ((R & ~31) + perm32(R & 31)) : R;
        voffA[i] = (unsigned)(R * K + C) * 2u; voffB[i] = (unsigned)(Rb * K + C) * 2u; }
    const size_t kstep = (size_t)(BK * 2);
    const size_t hstep = (size_t)HALF * K * 2;
    const size_t tstep = 2 * hstep;
    const unsigned ldsw = (unsigned)wid * 1024u;
    const int aoff = lds_byte(wr * 64 + fr, fq * 8), boff = lds_byte(wc * 32 + fr, fq * 8);
#define PG8_SA(b, h) (((b) * 2 + (h)) * HTB)
#define PG8_SB(b, h) ((4 + (b) * 2 + (h)) * HTB)
#define PG8_STAGE(bufoff, gbase, voff) do { _Pragma("unroll") for (int _i = 0; _i < 2; ++_i) \
        __builtin_amdgcn_global_load_lds((const unsigned*)((const char*)(gbase) + (voff)[_i]), (PG8_LAS unsigned*)(lds + (bufoff) + ldsw + _i * 8192), 16, 0, 0); } while (0)
#define PG8_LDA(dst, b, h) do { _Pragma("unroll") for (int m = 0; m < 4; ++m) _Pragma("unroll") for (int k = 0; k < 2; ++k) dst[m][k] = *(const PG8_LAS bf16x8*)(lds + PG8_SA(b, h) + aoff + m * 2048 + k * 1024); } while (0)
#define PG8_LDB(dst, b, h) do { _Pragma("unroll") for (int n = 0; n < 2; ++n) _Pragma("unroll") for (int k = 0; k < 2; ++k) dst[n][k] = *(const PG8_LAS bf16x8*)(lds + PG8_SB(b, h) + boff + n * 2048 + k * 1024); } while (0)
#define PG8_MMA(ai, bj, At, Bt) do { __builtin_amdgcn_s_setprio(1); _Pragma("unroll") for (int m = 0; m < 4; ++m) _Pragma("unroll") for (int n = 0; n < 2; ++n) _Pragma("unroll") for (int k = 0; k < 2; ++k) \
        acc[ai][bj][m][n] = __builtin_amdgcn_mfma_f32_16x16x32_bf16(Bt[n][k], At[m][k], acc[ai][bj][m][n], 0, 0, 0); __builtin_amdgcn_s_setprio(0); } while (0)
#define PG8_WAIT_V(n) asm volatile("s_waitcnt vmcnt(" #n ")" ::: "memory")
#define PG8_WAIT_L(n) asm volatile("s_waitcnt lgkmcnt(" #n ")" ::: "memory")
#define PG8_BAR __builtin_amdgcn_s_barrier()
#define PG8_SCHED __builtin_amdgcn_sched_barrier(0)
    Unit cur, nxt; int ui = 0;
    if (!S.next(0, cur)) return;
    f32x4 acc[2][2][4][2];
#pragma unroll
    for (int a = 0; a < 2; ++a)
#pragma unroll
        for (int b = 0; b < 2; ++b)
#pragma unroll
            for (int m = 0; m < 4; ++m)
#pragma unroll
                for (int n = 0; n < 2; ++n) acc[a][b][m][n] = (f32x4){0.f, 0.f, 0.f, 0.f};
    bf16x8 At[4][2], B0[2][2], B1[2][2];
    const char* cA = (const char*)g.A + (size_t)cur.pm * tstep; const char* cB = (const char*)g.Bt + (size_t)cur.pn * tstep;
    S.a_ready(cur);
    if constexpr (SP2) {
        PG8_STAGE(PG8_SB(0, 0), cB, voffB); PG8_STAGE(PG8_SB(0, 1), cB + hstep, voffB); PG8_STAGE(PG8_SA(0, 0), cA, voffA); PG8_STAGE(PG8_SA(0, 1), cA + hstep, voffA);
        if (wr == 1) PG8_BAR;
        PG8_WAIT_V(2); PG8_BAR;
        PG8_STAGE(PG8_SB(1, 0), cB + kstep, voffB); PG8_STAGE(PG8_SA(1, 0), cA + kstep, voffA); PG8_STAGE(PG8_SB(1, 1), cB + hstep + kstep, voffB);
        PG8_WAIT_V(6); PG8_BAR;
    } else {
        PG8_STAGE(PG8_SB(0, 0), cB, voffB); PG8_STAGE(PG8_SA(0, 0), cA, voffA); PG8_STAGE(PG8_SB(0, 1), cB + hstep, voffB); PG8_STAGE(PG8_SA(0, 1), cA + hstep, voffA);
        if (wr == 1) PG8_BAR;
        PG8_WAIT_V(4); PG8_BAR;
        PG8_STAGE(PG8_SB(1, 0), cB + kstep, voffB); PG8_STAGE(PG8_SA(1, 0), cA + kstep, voffA); PG8_STAGE(PG8_SB(1, 1), cB + hstep + kstep, voffB);
        PG8_WAIT_V(6); PG8_BAR;
    }
    for (;;) {
        const bool has_next = S.next(ui + 1, nxt);
        const char* nA = has_next ? (const char*)g.A + (size_t)nxt.pm * tstep : cA; const char* nB = has_next ? (const char*)g.Bt + (size_t)nxt.pn * tstep : cB;
        for (int t = 0; t < nt; t += 2) {
            const bool last = (t == nt - 2);
            const char* a1 = cA + (size_t)(t + 1) * kstep;
            const char* a2 = last ? nA : cA + (size_t)(t + 2) * kstep; const char* b2 = last ? nB : cB + (size_t)(t + 2) * kstep;
            const char* a3 = a2 + kstep; const char* b3 = b2 + kstep;
            if (last && has_next) S.a_ready(nxt);
            if constexpr (SP2) {
            PG8_LDB(B0, 0, 0); PG8_LDB(B1, 0, 1); PG8_SCHED; PG8_LDA(At, 0, 0); PG8_STAGE(PG8_SA(1, 1), a1 + hstep, voffA);
            PG8_WAIT_V(8); PG8_WAIT_L(0); PG8_BAR; PG8_MMA(0, 0, At, B0); PG8_MMA(0, 1, At, B1); PG8_BAR; PG8_SCHED;
            PG8_LDA(At, 0, 1); PG8_STAGE(PG8_SB(0, 0), b2, voffB); PG8_STAGE(PG8_SB(0, 1), b2 + hstep, voffB); PG8_STAGE(PG8_SA(0, 0), a2, voffA);
            PG8_WAIT_V(8); PG8_WAIT_L(0); PG8_BAR; PG8_MMA(1, 0, At, B0); PG8_MMA(1, 1, At, B1); PG8_BAR; PG8_SCHED;
            PG8_LDB(B0, 1, 0); PG8_LDB(B1, 1, 1); PG8_SCHED; PG8_LDA(At, 1, 0); PG8_STAGE(PG8_SA(0, 1), a2 + hstep, voffA);
            PG8_WAIT_V(8); PG8_WAIT_L(0); PG8_BAR; PG8_MMA(0, 0, At, B0); PG8_MMA(0, 1, At, B1); PG8_BAR; PG8_SCHED;
            PG8_LDA(At, 1, 1); PG8_STAGE(PG8_SB(1, 0), b3, voffB); PG8_STAGE(PG8_SB(1, 1), b3 + hstep, voffB); PG8_STAGE(PG8_SA(1, 0), a3, voffA);
            PG8_WAIT_V(8); PG8_WAIT_L(0); PG8_BAR; PG8_MMA(1, 0, At, B0); PG8_MMA(1, 1, At, B1); PG8_BAR; PG8_SCHED;
            } else {
            PG8_LDB(B0, 0, 0); PG8_SCHED; PG8_LDA(At, 0, 0); PG8_STAGE(PG8_SA(1, 1), a1 + hstep, voffA);
            PG8_WAIT_L(8); PG8_BAR; PG8_WAIT_L(0); PG8_MMA(0, 0, At, B0); PG8_BAR; PG8_SCHED;
            PG8_LDB(B1, 0, 1); PG8_STAGE(PG8_SB(0, 0), b2, voffB);
            PG8_BAR; PG8_WAIT_L(0); PG8_MMA(0, 1, At, B1); PG8_BAR;
            PG8_LDA(At, 0, 1); PG8_STAGE(PG8_SA(0, 0), a2, voffA);
            PG8_BAR; PG8_WAIT_L(0); PG8_MMA(1, 0, At, B0); PG8_BAR; PG8_SCHED;
            PG8_STAGE(PG8_SB(0, 1), b2 + hstep, voffB);
            PG8_WAIT_V(6); PG8_BAR; PG8_MMA(1, 1, At, B1); PG8_BAR;
            PG8_LDB(B0, 1, 0); PG8_SCHED; PG8_LDA(At, 1, 0); PG8_STAGE(PG8_SA(0, 1), a2 + hstep, voffA);
            PG8_WAIT_L(8); PG8_BAR; PG8_WAIT_L(0); PG8_MMA(0, 0, At, B0); PG8_BAR; PG8_SCHED;
            PG8_LDB(B1, 1, 1); PG8_STAGE(PG8_SB(1, 0), b3, voffB);
            PG8_BAR; PG8_WAIT_L(0); PG8_MMA(0, 1, At, B1); PG8_BAR;
            PG8_LDA(At, 1, 1); PG8_STAGE(PG8_SA(1, 0), a3, voffA);
            PG8_BAR; PG8_WAIT_L(0); PG8_MMA(1, 0, At, B0); PG8_BAR; PG8_SCHED;
            PG8_STAGE(PG8_SB(1, 1), b3 + hstep, voffB);
            PG8_WAIT_V(6); PG8_BAR; PG8_MMA(1, 1, At, B1); PG8_BAR;
            }
        }
        if constexpr (ALIGN_EPI) { if (wr == 0) PG8_BAR; }
        if constexpr (!Epi::AFTER_DRAIN) { E(acc, cur, wr, wc, fr, fq); S.done(cur); }
        if (!has_next) break;
#pragma unroll
        for (int a = 0; a < 2; ++a)
#pragma unroll
            for (int b = 0; b < 2; ++b)
#pragma unroll
                for (int m = 0; m < 4; ++m)
#pragma unroll
                    for (int n = 0; n < 2; ++n) acc[a][b][m][n] = (f32x4){0.f, 0.f, 0.f, 0.f};
        cur = nxt; cA = nA; cB = nB; ++ui;
        if constexpr (ALIGN_EPI) { if (wr == 1) PG8_BAR; }
    }
    PG8_WAIT_V(0);
    if constexpr (!ALIGN_EPI) { if (wr == 0) PG8_BAR; }
    PG8_BAR;
#undef PG8_SA
#undef PG8_SB
#undef PG8_STAGE
#undef PG8_LDA
#undef PG8_LDB
#undef PG8_MMA
#undef PG8_WAIT_V
#undef PG8_WAIT_L
#undef PG8_BAR
#undef PG8_SCHED
}
}

__device__ __forceinline__ void transpose_item(const float* W, int K, int N, bf16* WT, LAS float* scr, int item, int lane) {
    const int nblk = N / 32, kb = item / nblk, nb = item % nblk, k0 = 64 * kb, n0 = 32 * nb;
#pragma unroll 8
    for (int i = 0; i < 32; ++i) { const int kk = 2 * i + (lane >> 5); scr[kk * 33 + (lane & 31)] = W[(size_t)(k0 + kk) * N + n0 + (lane & 31)]; }
    asm volatile("s_waitcnt lgkmcnt(0)" ::: "memory");
    const int c = lane & 7;
#pragma unroll
    for (int j = 0; j < 4; ++j) { const int n = (lane >> 3) + 8 * j; const LAS float* s = scr + (8 * c) * 33 + n;
        uint4 o; o.x = pk2(s[0 * 33], s[1 * 33]); o.y = pk2(s[2 * 33], s[3 * 33]); o.z = pk2(s[4 * 33], s[5 * 33]); o.w = pk2(s[6 * 33], s[7 * 33]);
        *(uint4*)(WT + (size_t)(n0 + n) * K + k0 + 8 * c) = o; }
    asm volatile("s_waitcnt lgkmcnt(0)" ::: "memory");
}

__device__ __forceinline__ float wsum(float v) {
#pragma unroll
  for (int o = 32; o > 0; o >>= 1) v += __shfl_xor(v, o, 64);
  return v;
}
__device__ __forceinline__ float wmaxf(float v) {
#pragma unroll
  for (int o = 32; o > 0; o >>= 1) v = fmaxf(v, __shfl_xor(v, o, 64));
  return v;
}
__device__ __forceinline__ float sigmoidf_(float x) { return __builtin_amdgcn_rcpf(1.0f + __expf(-x)); }
__device__ __forceinline__ float gelu_tanh(float x) {
  return x * sigmoidf_(1.5957691216057308f * (x + 0.044715f * x * x * x));
}

template <bool BF16OUT>
__device__ __forceinline__ void rms_rows(const int wave_s, const float* src, const float* g, void* dstv, int rows) {
  const int tid_ = opaque_tid(wave_s);
  const int lane = tid_ & 63;
  const int gw = blockIdx.x * NWAVES + (tid_ >> 6);
  const int nw = gridDim.x * NWAVES;
  for (int r = gw; r < rows; r += nw) {
    const float4* s4 = (const float4*)(src + (size_t)r * DM);
    float4 v[4];
    float ss = 0.f;
#pragma unroll
    for (int i = 0; i < 4; i++) {
      v[i] = s4[lane + i * 64];
      ss += v[i].x * v[i].x + v[i].y * v[i].y + v[i].z * v[i].z + v[i].w * v[i].w;
    }
    ss = wsum(ss);
    const float rstd = rsqrtf(ss * (1.0f / DM) + EPSF);
    const float4* g4 = (const float4*)g;
#pragma unroll
    for (int i = 0; i < 4; i++) {
      float4 gg = g4[lane + i * 64];
      float4 o;
      o.x = v[i].x * rstd * gg.x; o.y = v[i].y * rstd * gg.y;
      o.z = v[i].z * rstd * gg.z; o.w = v[i].w * rstd * gg.w;
      if (BF16OUT) {
        uint2 pk; pk.x = pk2(o.x, o.y); pk.y = pk2(o.z, o.w);
        ((uint2*)((bf16*)dstv + (size_t)r * DM))[lane + i * 64] = pk;
      } else {
        ((float4*)((float*)dstv + (size_t)r * DM))[lane + i * 64] = o;
      }
    }
  }
}

__device__ __forceinline__ void ssm_params(const int wave_s, const Params& p, float* ssmp_all) {
  const int tid_ = opaque_tid(wave_s);
  const float* in8 = karg_in(8); const float* in9 = karg_in(9); const float* in10 = karg_in(10);
  const float* in11 = karg_in(11); const float* in12 = karg_in(12);
  const int gt = blockIdx.x * blockDim.x + tid_;
  const int nth = gridDim.x * blockDim.x;
  for (int i = gt; i < 2 * 16 * 64; i += nth) {
    const int l = i / 1024, gp = i % 1024, g = gp / 64;
    float* sp = ssmp_all + (size_t)l * SSMP_PER_LAYER;
    const float lre = fminf(in8[l * 1024 + gp], -1e-4f);
    const float lim = in9[l * 1024 + gp];
    const float dt = expf(in10[l * 16 + g]);
    const float er = expf(lre * dt);
    float sn, cs;
    sincosf(lim * dt, &sn, &cs);
    const float br = er * cs, bi = er * sn;
    sp[gp * 2 + 0] = br;
    sp[gp * 2 + 1] = bi;
    float cr = br, ci = bi;
#pragma unroll
    for (int s = 0; s < 6; s++) {
      const float nr = cr * cr - ci * ci, ni = 2.f * cr * ci;
      cr = nr; ci = ni;
    }
    sp[2048 + gp * 2 + 0] = cr;
    sp[2048 + gp * 2 + 1] = ci;
    const float nr = br - 1.0f, ni = bi;
    const float den = lre * lre + lim * lim;
    const float fr = (nr * lre + ni * lim) / den;
    const float fi = (ni * lre - nr * lim) / den;
    for (int h = 0; h < 16; h++) {
      const float bre = in11[((size_t)l * 1024 + gp) * 16 + h];
      const float bim = in12[((size_t)l * 1024 + gp) * 16 + h];
      sp[4096 + ((g * 16 + h) * 64 + (gp & 63)) * 2 + 0] = fr * bre - fi * bim;
      sp[4096 + ((g * 16 + h) * 64 + (gp & 63)) * 2 + 1] = fr * bim + fi * bre;
    }
  }
}

__device__ __forceinline__ void conv_phase(const int wave_s, const Params& p, int l, const bf16* proj, bf16* y, LAS float* smem) {
  const int tid_ = opaque_tid(wave_s);
  const int lane = tid_ & 63;
  const int gw = blockIdx.x * NWAVES + (tid_ >> 6);
  const int nw = gridDim.x * NWAVES;
  const float* cw = karg_in(4) + (size_t)l * 31 * 256;
  const float4 cb = ((const float4*)(karg_in(5) + l * 256))[lane];
  const float4 lg = ((const float4*)(karg_in(6) + l * 256))[lane];
  const float4 lb = ((const float4*)(karg_in(7) + l * 256))[lane];
  const float4 gg = ((const float4*)(karg_in(18) + l * 1024))[lane];
  LAS float* cwl = smem + 1024;
  for (int i = tid_; i < 31 * 256 / 4; i += NWAVES * 64) *(LAS pg8::f32x4*)(cwl + 4 * i) = *(const pg8::f32x4*)(cw + 4 * i);
  __syncthreads();
  for (int it = gw; it < NT / 8; it += nw) {
    const int tok0 = it * 8;
    const int t0 = tok0 & (SEQ - 1);
    float4 acc[8];
#pragma unroll
    for (int o = 0; o < 8; o++) acc[o] = cb;
#pragma unroll
    for (int i = 0; i < 38; i++) {
      if (t0 - 30 + i >= 0) {
        const bf16* row = proj + (size_t)(tok0 - 30 + i) * DIN;
        const uint2 vp = ((const uint2*)row)[lane];
        const uint2 gp = ((const uint2*)(row + 256))[lane];
        float4 g4;
        g4.x = bf_lo(vp.x) * sigmoidf_(bf_lo(gp.x)); g4.y = bf_hi(vp.x) * sigmoidf_(bf_hi(gp.x));
        g4.z = bf_lo(vp.y) * sigmoidf_(bf_lo(gp.y)); g4.w = bf_hi(vp.y) * sigmoidf_(bf_hi(gp.y));
#pragma unroll
        for (int o = 0; o < 8; o++) {
          const int j = i - o;
          if (j >= 0 && j <= 30) {
            const pg8::f32x4 w4 = *(const LAS pg8::f32x4*)(cwl + j * 256 + lane * 4);
            acc[o].x += g4.x * w4[0]; acc[o].y += g4.y * w4[1];
            acc[o].z += g4.z * w4[2]; acc[o].w += g4.w * w4[3];
          }
        }
      }
    }
#pragma unroll
    for (int o = 0; o < 8; o++) {
      const float4 a = acc[o];
      const float mean = wsum(a.x + a.y + a.z + a.w) * (1.0f / 256.f);
      const float dx = a.x - mean, dy = a.y - mean, dz = a.z - mean, dw = a.w - mean;
      const float var = wsum(dx * dx + dy * dy + dz * dz + dw * dw) * (1.0f / 256.f);
      const float rs = rsqrtf(var + EPSF);
      float4 s;
      s.x = dx * rs * lg.x + lb.x; s.y = dy * rs * lg.y + lb.y;
      s.z = dz * rs * lg.z + lb.z; s.w = dw * rs * lg.w + lb.w;
      s.x = s.x * sigmoidf_(s.x); s.y = s.y * sigmoidf_(s.y);
      s.z = s.z * sigmoidf_(s.z); s.w = s.w * sigmoidf_(s.w);
      const float ss = wsum(s.x * s.x + s.y * s.y + s.z * s.z + s.w * s.w) * (1.0f / 256.f);
      const float r2 = rsqrtf(ss + EPSF);
      uint2 pk; pk.x = pk2(s.x * r2 * gg.x, s.y * r2 * gg.y); pk.y = pk2(s.z * r2 * gg.z, s.w * r2 * gg.w);
      ((uint2*)(y + (size_t)(tok0 + o) * DM))[lane] = pk;
    }
  }
}

typedef short bf16x8_t __attribute__((ext_vector_type(8)));
typedef float f32x16_t __attribute__((ext_vector_type(16)));
#define MFMA_PAD() do { __builtin_amdgcn_sched_barrier(0); asm volatile("s_nop 15\n\ts_nop 15" ::: "memory"); __builtin_amdgcn_sched_barrier(0); } while (0)

__device__ __forceinline__ void attn_phase(const int wave_s, const Params& p, int l, const bf16* proj, bf16* y, LAS float* smem) {
  const int tid = opaque_tid(wave_s), lane = tid & 63, wave = tid >> 6;
  const int n = lane & 31, hh = lane >> 5;
  const float* gg = karg_in(18) + l * 1024 + 256 + wave * 64;
  const float g0 = gg[n], g1 = gg[32 + n];
  LAS float* ssq = smem;
  LAS float* rstd = smem + 256;
  for (int item = blockIdx.x; item < 4 * 128; item += gridDim.x) {
    const int b = item >> 7, q0 = (item & 127) * 32;
    const size_t tokb = (size_t)b * SEQ;
    bf16x8_t qf[4];
    {
      const bf16* qrow = proj + (tokb + q0 + n) * DIN + 512 + wave * 64 + 8 * hh;
#pragma unroll
      for (int ks = 0; ks < 4; ks++) qf[ks] = *(const bf16x8_t*)(qrow + 16 * ks);
    }
    f32x16_t o0, o1;
#pragma unroll
    for (int r = 0; r < 16; r++) { o0[r] = 0.f; o1[r] = 0.f; }
    float R = 0.f;
    for (int kt = q0; kt >= 0; kt -= 32) {
      bf16x8_t kf[4];
      {
        const bf16* krow = proj + (tokb + kt + n) * DIN + 1024 + wave * 64 + 8 * hh;
#pragma unroll
        for (int ks = 0; ks < 4; ks++) kf[ks] = *(const bf16x8_t*)(krow + 16 * ks);
      }
      bf16x8_t vf0[2], vf1[2];
      {
        const bf16* vb = proj + (tokb + kt + 4 * hh) * DIN + 1536 + wave * 64 + n;
#pragma unroll
        for (int s = 0; s < 2; s++)
#pragma unroll
          for (int j = 0; j < 8; j++) {
            const int key = 16 * s + 8 * (j >> 2) + (j & 3);
            vf0[s][j] = (short)vb[(size_t)key * DIN];
            vf1[s][j] = (short)vb[(size_t)key * DIN + 32];
          }
      }
      f32x16_t sacc;
#pragma unroll
      for (int r = 0; r < 16; r++) sacc[r] = 0.f;
      __builtin_amdgcn_sched_barrier(0); asm volatile("s_nop 15\n\ts_nop 15" ::: "memory"); __builtin_amdgcn_sched_barrier(0);
#pragma unroll
      for (int ks = 0; ks < 4; ks++) sacc = __builtin_amdgcn_mfma_f32_32x32x16_bf16(kf[ks], qf[ks], sacc, 0, 0, 0);
      __builtin_amdgcn_sched_barrier(0); asm volatile("s_nop 15\n\ts_nop 15" ::: "memory"); __builtin_amdgcn_sched_barrier(0);
      float lst[16], lsz[16];
      const bool diag = (kt == q0);
#pragma unroll
      for (int r = 0; r < 16; r++) {
        const float z = sacc[r] * 0.125f;
        const float sp = __logf(1.0f + __expf(-fabsf(z)));
        float a = fminf(z, 0.f) - sp;
        float c = -(fmaxf(z, 0.f) + sp);
        if (diag) {
          const int key = (r & 3) + 8 * (r >> 2) + 4 * hh;
          if (key >= n) { a = -1.0e30f; c = 0.f; }
        }
        lsz[r] = a; lst[r] = c;
      }
      float Gs[4], Gp[4];
#pragma unroll
      for (int g = 0; g < 4; g++) {
        Gs[g] = (lst[4 * g] + lst[4 * g + 1]) + (lst[4 * g + 2] + lst[4 * g + 3]);
        Gp[g] = __shfl_xor(Gs[g], 32, 64);
      }
      float carry[4];
      {
        float after = R;
#pragma unroll
        for (int g = 3; g >= 0; g--) {
          carry[g] = after + (hh ? 0.f : Gp[g]);
          after += Gs[g] + Gp[g];
        }
        R = after;
      }
      bf16x8_t pf[2];
#pragma unroll
      for (int g = 0; g < 4; g++) {
        float run = carry[g];
        float a3 = __expf(lsz[4 * g + 3] + run); run += lst[4 * g + 3];
        float a2 = __expf(lsz[4 * g + 2] + run); run += lst[4 * g + 2];
        float a1 = __expf(lsz[4 * g + 1] + run); run += lst[4 * g + 1];
        float a0 = __expf(lsz[4 * g + 0] + run);
        const int s = g >> 1, jb = (g & 1) * 4;
        pf[s][jb + 0] = (short)f2bf(a0); pf[s][jb + 1] = (short)f2bf(a1);
        pf[s][jb + 2] = (short)f2bf(a2); pf[s][jb + 3] = (short)f2bf(a3);
      }
      __builtin_amdgcn_sched_barrier(0); asm volatile("s_nop 15\n\ts_nop 15" ::: "memory"); __builtin_amdgcn_sched_barrier(0);
#pragma unroll
      for (int s = 0; s < 2; s++) {
        o0 = __builtin_amdgcn_mfma_f32_32x32x16_bf16(pf[s], vf0[s], o0, 0, 0, 0);
        o1 = __builtin_amdgcn_mfma_f32_32x32x16_bf16(pf[s], vf1[s], o1, 0, 0, 0);
      }
      __builtin_amdgcn_sched_barrier(0); asm volatile("s_nop 15\n\ts_nop 15" ::: "memory"); __builtin_amdgcn_sched_barrier(0);
      if (__all(R < -110.f)) break;
    }
    float sq[16];
#pragma unroll
    for (int r = 0; r < 16; r++) {
      float v = o0[r] * o0[r] + o1[r] * o1[r];
#pragma unroll
      for (int o = 16; o > 0; o >>= 1) v += __shfl_xor(v, o, 64);
      sq[r] = v;
    }
    __syncthreads();
    if (n == 0) {
#pragma unroll
      for (int r = 0; r < 16; r++) ssq[wave * 32 + (r & 3) + 8 * (r >> 2) + 4 * hh] = sq[r];
    }
    __syncthreads();
    if (tid < 32) {
      float t = 0.f;
#pragma unroll
      for (int w = 0; w < 8; w++) t += ssq[w * 32 + tid];
      rstd[tid] = rsqrtf(t * (1.0f / 512.f) + EPSF);
    }
    __syncthreads();
#pragma unroll
    for (int r = 0; r < 16; r++) {
      const int qi = (r & 3) + 8 * (r >> 2) + 4 * hh;
      const float rs = rstd[qi];
      bf16* yr = y + (tokb + q0 + qi) * DM + 256 + wave * 64 + n;
      yr[0] = (bf16)f2bf(o0[r] * rs * g0);
      yr[32] = (bf16)f2bf(o1[r] * rs * g1);
    }
  }
}

#define SSM_BCAST_U(u, ua, ub, tt) do { \
    const unsigned w0 = (unsigned)__builtin_amdgcn_readlane((int)(ua).x, (tt)), w1 = (unsigned)__builtin_amdgcn_readlane((int)(ua).y, (tt)); \
    const unsigned w2 = (unsigned)__builtin_amdgcn_readlane((int)(ua).z, (tt)), w3 = (unsigned)__builtin_amdgcn_readlane((int)(ua).w, (tt)); \
    const unsigned w4 = (unsigned)__builtin_amdgcn_readlane((int)(ub).x, (tt)), w5 = (unsigned)__builtin_amdgcn_readlane((int)(ub).y, (tt)); \
    const unsigned w6 = (unsigned)__builtin_amdgcn_readlane((int)(ub).z, (tt)), w7 = (unsigned)__builtin_amdgcn_readlane((int)(ub).w, (tt)); \
    (u)[0] = bf_lo(w0); (u)[1] = bf_hi(w0); (u)[2] = bf_lo(w1); (u)[3] = bf_hi(w1); (u)[4] = bf_lo(w2); (u)[5] = bf_hi(w2); (u)[6] = bf_lo(w3); (u)[7] = bf_hi(w3); \
    (u)[8] = bf_lo(w4); (u)[9] = bf_hi(w4); (u)[10] = bf_lo(w5); (u)[11] = bf_hi(w5); (u)[12] = bf_lo(w6); (u)[13] = bf_hi(w6); (u)[14] = bf_lo(w7); (u)[15] = bf_hi(w7); } while (0)
#define SSM_RS 592
#define SSM_TILE_BASE 36864
#define SSM_TILE_BYTES (16 * SSM_RS)
typedef float f32x2_t __attribute__((ext_vector_type(2)));
__device__ __forceinline__ void ssm_load_bop(const float* ssmp, int g, int lane, bf16x8_t (&bop)[8]) {
  const int q = lane >> 4, n = lane & 15;
  float v[8][8];
#pragma unroll
  for (int j = 0; j < 8; j++) {
    const float4* rp = (const float4*)(ssmp + 4096 + (size_t)(g * 16 + ((8 * q + j) & 15)) * 128 + 8 * n);
    const float4 a = rp[0], b = rp[1];
    v[j][0] = a.x; v[j][1] = a.y; v[j][2] = a.z; v[j][3] = a.w; v[j][4] = b.x; v[j][5] = b.y; v[j][6] = b.z; v[j][7] = b.w;
  }
#pragma unroll
  for (int nt = 0; nt < 8; nt++) {
    pg8::u32x4 w;
    w.x = pk2(v[0][nt], v[1][nt]); w.y = pk2(v[2][nt], v[3][nt]); w.z = pk2(v[4][nt], v[5][nt]); w.w = pk2(v[6][nt], v[7][nt]);
    if (q >= 2) { w.x = 0u; w.y = 0u; w.z = 0u; w.w = 0u; }
    bop[nt] = __builtin_bit_cast(bf16x8_t, w);
  }
}
__device__ __forceinline__ void ssm_bu_block(LAS unsigned char* xt, int lane, int blk, const uint4& ua, const uint4& ub, const bf16x8_t (&bop)[8]) {
  const int q = lane >> 4, n = lane & 15;
  if (q == blk) {
    pg8::u32x4 w0, w1;
    w0.x = ua.x; w0.y = ua.y; w0.z = ua.z; w0.w = ua.w; w1.x = ub.x; w1.y = ub.y; w1.z = ub.z; w1.w = ub.w;
    LAS pg8::u32x4* ur = (LAS pg8::u32x4*)(xt + n * SSM_RS + 512);
    ur[0] = w0; ur[1] = w1;
  }
  __builtin_amdgcn_wave_barrier();
  const bf16x8_t uop = *(const LAS bf16x8_t*)(xt + n * SSM_RS + 512 + q * 16);
  pg8::f32x4 bacc[8];
#pragma unroll
  for (int nt = 0; nt < 8; nt++) {
    pg8::f32x4 z4; z4[0] = 0.f; z4[1] = 0.f; z4[2] = 0.f; z4[3] = 0.f;
    bacc[nt] = __builtin_amdgcn_mfma_f32_16x16x32_bf16(uop, bop[nt], z4, 0, 0, 0);
  }
#pragma unroll
  for (int j = 0; j < 4; j++) {
    pg8::f32x4 w0, w1;
    w0[0] = bacc[0][j]; w0[1] = bacc[1][j]; w0[2] = bacc[2][j]; w0[3] = bacc[3][j];
    w1[0] = bacc[4][j]; w1[1] = bacc[5][j]; w1[2] = bacc[6][j]; w1[3] = bacc[7][j];
    LAS pg8::f32x4* dr = (LAS pg8::f32x4*)(xt + (4 * q + j) * SSM_RS + 32 * n);
    dr[0] = w0; dr[1] = w1;
  }
  __builtin_amdgcn_wave_barrier();
}
__device__ __forceinline__ void ssm_zero_pad(LAS unsigned char* xt, int lane) {
  if (lane < 16) {
    pg8::u32x4 z4; z4.x = 0u; z4.y = 0u; z4.z = 0u; z4.w = 0u;
    LAS pg8::u32x4* zr = (LAS pg8::u32x4*)(xt + lane * SSM_RS + 544);
    zr[0] = z4; zr[1] = z4;
  }
}
__device__ __forceinline__ void ssm_chunk_end(const int wave_s, const float* ssmp, const bf16* proj, float* ssmE, LAS float* smem) {
  const int tid_ = opaque_tid(wave_s);
  const int lane = tid_ & 63;
  const int gw = blockIdx.x * NWAVES + (tid_ >> 6);
  const int nw = gridDim.x * NWAVES;
  for (int it = gw; it < 4 * 64 * 16; it += nw) {
    const int g = it & 15, c = (it >> 4) & 63, b = it >> 10;
    const int gp = g * 64 + lane;
    const uint4* up = (const uint4*)(proj + (size_t)(b * SEQ + c * 64 + lane) * DIN + 2048 + g * 16);
    const uint4 ua = up[0], ub = up[1];
    const float lbr = ssmp[gp * 2], lbi = ssmp[gp * 2 + 1];
    bf16x8_t bop[8];
    ssm_load_bop(ssmp, g, lane, bop);
    LAS unsigned char* xt = (LAS unsigned char*)smem + SSM_TILE_BASE + (tid_ >> 6) * SSM_TILE_BYTES;
    ssm_zero_pad(xt, lane);
    float xr = 0.f, xi = 0.f;
#pragma unroll 1
    for (int blk = 0; blk < 4; blk++) {
      ssm_bu_block(xt, lane, blk, ua, ub, bop);
#pragma unroll 4
      for (int tt = 0; tt < 16; tt++) {
        const f32x2_t bu = *(const LAS f32x2_t*)(xt + tt * SSM_RS + lane * 8);
        const float nr = lbr * xr - lbi * xi + bu[0];
        const float ni = lbr * xi + lbi * xr + bu[1];
        xr = nr; xi = ni;
      }
      __builtin_amdgcn_wave_barrier();
    }
    float* e = ssmE + ((size_t)((b * 64 + c) * 16 + g) * 64 + lane) * 2;
    e[0] = xr; e[1] = xi;
  }
}

__device__ __forceinline__ void ssm_finish(const int wave_s, const Params& p, int l, const float* ssmp, const bf16* proj,
                           const float* ssmE, bf16* y, LAS float* smem) {
  LAS bf16* Ytb = (LAS bf16*)smem;
  LAS float* ssq2 = smem + (64 * 264 * 2) / 4;
  LAS float* rstd2 = ssq2 + 512;
  const bf16* glT = (const bf16*)(p.ws + WS_WT + (size_t)l * WT_LAYER + WT_GLU);
  const int tid = opaque_tid(wave_s), lane = tid & 63, wave = tid >> 6;
  const float* cre = karg_in(13) + (size_t)l * 16 * 16 * 64;
  const float* cim = karg_in(14) + (size_t)l * 16 * 16 * 64;
  const float* dsk = karg_in(15) + l * 256;
  const float* glw = karg_in(16) + (size_t)l * 256 * 256;
  const float* glb = karg_in(17) + l * 256;
  const float* gg = karg_in(18) + l * 1024 + 768;
  for (int it = blockIdx.x; it < 256; it += gridDim.x) {
    const int b = it >> 6, c = it & 63;
    __syncthreads();
    for (int gi = 0; gi < 2; gi++) {
      const int g = wave + gi * 8;
      const int gp = g * 64 + lane;
      const float lbr = ssmp[gp * 2], lbi = ssmp[gp * 2 + 1];
      const float lcr = ssmp[2048 + gp * 2], lci = ssmp[2048 + gp * 2 + 1];
      bf16x8_t bop[8];
      ssm_load_bop(ssmp, g, lane, bop);
      bf16x8_t cop[5];
      {
        const int nn = lane & 15, q = lane >> 4;
#pragma unroll
        for (int ks = 0; ks < 4; ks++) {
          const float4 cr4 = *(const float4*)(cre + (g * 16 + nn) * 64 + 16 * ks + 4 * q);
          const float4 ci4 = *(const float4*)(cim + (g * 16 + nn) * 64 + 16 * ks + 4 * q);
          pg8::u32x4 w;
          w.x = pk2(cr4.x, -ci4.x); w.y = pk2(cr4.y, -ci4.y); w.z = pk2(cr4.z, -ci4.z); w.w = pk2(cr4.w, -ci4.w);
          cop[ks] = __builtin_bit_cast(bf16x8_t, w);
        }
        const float dn = dsk[g * 16 + nn];
        float dv[8];
#pragma unroll
        for (int j = 0; j < 8; j++) dv[j] = (8 * q + j == nn) ? dn : 0.f;
        pg8::u32x4 w;
        w.x = pk2(dv[0], dv[1]); w.y = pk2(dv[2], dv[3]); w.z = pk2(dv[4], dv[5]); w.w = pk2(dv[6], dv[7]);
        cop[4] = __builtin_bit_cast(bf16x8_t, w);
      }
      const uint4* up = (const uint4*)(proj + (size_t)(b * SEQ + c * 64 + lane) * DIN + 2048 + g * 16);
      const uint4 ua = up[0], ub = up[1];
      float xr = 0.f, xi = 0.f;
      {
        const float2* eb = (const float2*)ssmE + ((size_t)(b * 64) * 16 + g) * 64 + lane;
        for (int cc = 0; cc < c; cc += 16) {
          float2 ev[16];
#pragma unroll
          for (int k = 0; k < 16; k++) ev[k] = eb[(size_t)(cc + k < c ? cc + k : c - 1) * 16 * 64];
#pragma unroll
          for (int k = 0; k < 16; k++) {
            if (cc + k < c) {
              const float nr = lcr * xr - lci * xi + ev[k].x;
              const float ni = lcr * xi + lci * xr + ev[k].y;
              xr = nr; xi = ni;
            }
          }
        }
      }
      LAS unsigned char* xt = (LAS unsigned char*)smem + SSM_TILE_BASE + wave * SSM_TILE_BYTES;
      ssm_zero_pad(xt, lane);
#pragma unroll 1
      for (int blk = 0; blk < 4; blk++) {
        ssm_bu_block(xt, lane, blk, ua, ub, bop);
#pragma unroll 4
        for (int tt = 0; tt < 16; tt++) {
          const f32x2_t bu = *(const LAS f32x2_t*)(xt + tt * SSM_RS + lane * 8);
          const float nr = lbr * xr - lbi * xi + bu[0];
          const float ni = lbr * xi + lbi * xr + bu[1];
          xr = nr; xi = ni;
          *(LAS unsigned*)(xt + tt * SSM_RS + lane * 4) = pk2(xr, xi);
        }
        __builtin_amdgcn_wave_barrier();
        {
          pg8::f32x4 acc4;
          acc4[0] = 0.f; acc4[1] = 0.f; acc4[2] = 0.f; acc4[3] = 0.f;
          const LAS unsigned char* ar = xt + (lane & 15) * SSM_RS + (lane >> 4) * 16;
#pragma unroll
          for (int ks = 0; ks < 4; ks++)
            acc4 = __builtin_amdgcn_mfma_f32_16x16x32_bf16(*(const LAS bf16x8_t*)(ar + ks * 64), cop[ks], acc4, 0, 0, 0);
          acc4 = __builtin_amdgcn_mfma_f32_16x16x32_bf16(*(const LAS bf16x8_t*)(ar + 512), cop[4], acc4, 0, 0, 0);
#pragma unroll
          for (int j = 0; j < 4; j++)
            Ytb[(blk * 16 + 4 * (lane >> 4) + j) * 264 + g * 16 + (lane & 15)] = (bf16)f2bf(gelu_tanh(acc4[j]));
        }
        __builtin_amdgcn_wave_barrier();
      }
    }
    __syncthreads();
    {
      const int n = lane & 31, hh = lane >> 5;
      const int ch = wave * 32 + n;
      const float bj = glb[ch];
      const float gj = gg[ch];
      bf16x8_t gf[16];
      {
        const bf16* grow = glT + (size_t)ch * 256 + 8 * hh;
#pragma unroll
        for (int ks = 0; ks < 16; ks++) gf[ks] = *(const bf16x8_t*)(grow + 16 * ks);
      }
      float oo[2][16];
#pragma unroll
      for (int mt = 0; mt < 2; mt++) {
        f32x16_t z;
#pragma unroll
        for (int r = 0; r < 16; r++) z[r] = 0.f;
        const LAS bf16* yrow = Ytb + (mt * 32 + n) * 264 + 8 * hh;
#pragma unroll
        for (int kq = 0; kq < 4; kq++) {
          bf16x8_t yf[4];
#pragma unroll
          for (int i = 0; i < 4; i++) yf[i] = *(const LAS bf16x8_t*)(yrow + 16 * (kq * 4 + i));
          MFMA_PAD();
#pragma unroll
          for (int i = 0; i < 4; i++) z = __builtin_amdgcn_mfma_f32_32x32x16_bf16(yf[i], gf[kq * 4 + i], z, 0, 0, 0);
          MFMA_PAD();
        }
        float sq[16];
#pragma unroll
        for (int r = 0; r < 16; r++) {
          const int t = mt * 32 + (r & 3) + 8 * (r >> 2) + 4 * hh;
          const float yv = bf2f(Ytb[t * 264 + ch]);
          const float o = yv * sigmoidf_(z[r] + bj);
          oo[mt][r] = o;
          float v = o * o;
#pragma unroll
          for (int s = 16; s > 0; s >>= 1) v += __shfl_xor(v, s, 64);
          sq[r] = v;
        }
        if (n == 0) {
#pragma unroll
          for (int r = 0; r < 16; r++) ssq2[wave * 64 + mt * 32 + (r & 3) + 8 * (r >> 2) + 4 * hh] = sq[r];
        }
      }
      __syncthreads();
      if (tid < 64) {
        float t = 0.f;
#pragma unroll
        for (int w = 0; w < 8; w++) t += ssq2[w * 64 + tid];
        rstd2[tid] = rsqrtf(t * (1.0f / 256.f) + EPSF);
      }
      __syncthreads();
#pragma unroll
      for (int mt = 0; mt < 2; mt++)
#pragma unroll
        for (int r = 0; r < 16; r++) {
          const int t = mt * 32 + (r & 3) + 8 * (r >> 2) + 4 * hh;
          y[(size_t)(b * SEQ + c * 64 + t) * DM + 768 + ch] = (bf16)f2bf(oo[mt][r] * rstd2[t] * gj);
        }
    }
  }
}

__device__ __forceinline__ void memattn_phase(const int wave_s, const bf16* q, const bf16* kvb, const bf16* vT, bf16* o, LAS float* smem) {
  const int tid_ = opaque_tid(wave_s);
  const int lane = tid_ & 63, n = lane & 31, hh = lane >> 5, wave = tid_ >> 6;
  const int sig = (n & 0x13) | ((n & 4) << 1) | ((n & 8) >> 1);
  LAS bf16* Ls = (LAS bf16*)smem;
  for (int it = blockIdx.x; it < 64 * 4; it += gridDim.x) {
    const int h = it & 3, tg = it >> 2, b = tg >> 4;
    const int tok0 = (tg * 8 + wave) * 32;
    __syncthreads();
    {
      const int r = tid_ >> 1, hf = tid_ & 1;
      const pg8::u32x4* src4 = (const pg8::u32x4*)(kvb + (size_t)(b * NMEM + r) * 2048 + h * 256 + hf * 128);
      LAS pg8::u32x4* dst4 = (LAS pg8::u32x4*)(Ls + r * 264 + hf * 128);
#pragma unroll
      for (int k = 0; k < 16; k++) dst4[k] = src4[k];
    }
    f32x16_t st[8];
#pragma unroll
    for (int kt = 0; kt < 8; kt++)
#pragma unroll
      for (int r = 0; r < 16; r++) st[kt][r] = 0.f;
    const bf16* qrow = q + (size_t)(tok0 + n) * DM + h * 256 + 8 * hh;
    __syncthreads();
#pragma unroll
    for (int kq = 0; kq < 4; kq++) {
      bf16x8_t qf[4];
#pragma unroll
      for (int i = 0; i < 4; i++) qf[i] = *(const bf16x8_t*)(qrow + 16 * (kq * 4 + i));
#pragma unroll
      for (int kt = 0; kt < 8; kt++) {
        const LAS bf16* krow = Ls + (kt * 32 + sig) * 264 + 8 * hh;
        bf16x8_t kf[4];
#pragma unroll
        for (int i = 0; i < 4; i++) kf[i] = *(const LAS bf16x8_t*)(krow + 16 * (kq * 4 + i));
        MFMA_PAD();
#pragma unroll
        for (int i = 0; i < 4; i++) st[kt] = __builtin_amdgcn_mfma_f32_32x32x16_bf16(kf[i], qf[i], st[kt], 0, 0, 0);
        MFMA_PAD();
      }
    }
    float mx = st[0][0];
#pragma unroll
    for (int kt = 0; kt < 8; kt++)
#pragma unroll
      for (int r = 0; r < 16; r++) mx = fmaxf(mx, st[kt][r]);
    mx = fmaxf(mx, __shfl_xor(mx, 32, 64));
    float sum = 0.f;
#pragma unroll
    for (int kt = 0; kt < 8; kt++)
#pragma unroll
      for (int r = 0; r < 16; r++) { const float e = __expf((st[kt][r] - mx) * 0.0625f); st[kt][r] = e; sum += e; }
    sum += __shfl_xor(sum, 32, 64);
    const float inv = 1.0f / sum;
    bf16x8_t pf[8][2];
#pragma unroll
    for (int kt = 0; kt < 8; kt++)
#pragma unroll
      for (int s = 0; s < 2; s++)
#pragma unroll
        for (int j = 0; j < 8; j++) pf[kt][s][j] = (short)f2bf(st[kt][8 * s + j] * inv);
    __syncthreads();
    {
      const int r = tid_ >> 1, hf = tid_ & 1;
      const pg8::u32x4* src4 = (const pg8::u32x4*)(vT + ((size_t)(b * 4 + h) * 256 + r) * 256 + hf * 128);
      LAS pg8::u32x4* dst4 = (LAS pg8::u32x4*)(Ls + r * 264 + hf * 128);
#pragma unroll
      for (int k = 0; k < 16; k++) dst4[k] = src4[k];
    }
    __syncthreads();
#pragma unroll 1
    for (int dt = 0; dt < 8; dt++) {
      f32x16_t oacc;
#pragma unroll
      for (int r = 0; r < 16; r++) oacc[r] = 0.f;
      const LAS bf16* vrow = Ls + (dt * 32 + n) * 264 + 8 * hh;
#pragma unroll
      for (int kq = 0; kq < 4; kq++) {
        bf16x8_t vf[4];
#pragma unroll
        for (int i = 0; i < 4; i++) vf[i] = *(const LAS bf16x8_t*)(vrow + (kq * 2 + (i >> 1)) * 32 + 16 * (i & 1));
        MFMA_PAD();
#pragma unroll
        for (int i = 0; i < 4; i++) oacc = __builtin_amdgcn_mfma_f32_32x32x16_bf16(pf[kq * 2 + (i >> 1)][i & 1], vf[i], oacc, 0, 0, 0);
        MFMA_PAD();
      }
#pragma unroll
      for (int r = 0; r < 16; r++) {
        const int qi = (r & 3) + 8 * (r >> 2) + 4 * hh;
        o[(size_t)(tok0 + qi) * DM + h * 256 + dt * 32 + n] = (bf16)f2bf(oacc[r]);
      }
    }
  }
}

__device__ __forceinline__ void vt_phase(const int wave_s, const bf16* kvb, bf16* vT) {
  const int tid_ = opaque_tid(wave_s);
  const int gt = blockIdx.x * (NWAVES * 64) + tid_;
  const int nth = gridDim.x * NWAVES * 64;
  for (int i = gt; i < 2 * 4 * 4 * 256 * 256; i += nth) {
    const int m = i & 255, d = (i >> 8) & 255, h = (i >> 16) & 3, b = (i >> 18) & 3, l = i >> 20;
    vT[i] = kvb[((size_t)l * 1024 + b * 256 + m) * 2048 + 1024 + h * 256 + d];
  }
}

template <unsigned MASK>
__device__ __forceinline__ float pack_key(float s, unsigned idx) {
  const unsigned u = __builtin_bit_cast(unsigned, s);
  const unsigned tag = ((int)u < 0) ? idx : (MASK - idx);
  return __builtin_bit_cast(float, (u & ~MASK) + tag);
}
template <unsigned MASK>
__device__ __forceinline__ unsigned key_idx(float k) {
  const unsigned u = __builtin_bit_cast(unsigned, k);
  const unsigned tag = u & MASK;
  return ((int)u < 0) ? tag : (MASK - tag);
}
template <unsigned MASK>
__device__ __forceinline__ float key_val(float k) { return __builtin_bit_cast(float, __builtin_bit_cast(unsigned, k) & ~MASK); }
__device__ __forceinline__ void top16_of_64(float (&K)[64]) {
  { const float a_ = K[0], b_ = K[1]; const bool g_ = a_ > b_; K[0] = g_ ? a_ : b_; K[1] = g_ ? b_ : a_; }
  { const float a_ = K[2], b_ = K[3]; const bool g_ = a_ > b_; K[2] = g_ ? b_ : a_; K[3] = g_ ? a_ : b_; }
  { const float a_ = K[4], b_ = K[5]; const bool g_ = a_ > b_; K[4] = g_ ? a_ : b_; K[5] = g_ ? b_ : a_; }
  { const float a_ = K[6], b_ = K[7]; const bool g_ = a_ > b_; K[6] = g_ ? b_ : a_; K[7] = g_ ? a_ : b_; }
  { const float a_ = K[8], b_ = K[9]; const bool g_ = a_ > b_; K[8] = g_ ? a_ : b_; K[9] = g_ ? b_ : a_; }
  { const float a_ = K[10], b_ = K[11]; const bool g_ = a_ > b_; K[10] = g_ ? b_ : a_; K[11] = g_ ? a_ : b_; }
  { const float a_ = K[12], b_ = K[13]; const bool g_ = a_ > b_; K[12] = g_ ? a_ : b_; K[13] = g_ ? b_ : a_; }
  { const float a_ = K[14], b_ = K[15]; const bool g_ = a_ > b_; K[14] = g_ ? b_ : a_; K[15] = g_ ? a_ : b_; }
  { const float a_ = K[0], b_ = K[2]; const bool g_ = a_ > b_; K[0] = g_ ? a_ : b_; K[2] = g_ ? b_ : a_; }
  { const float a_ = K[1], b_ = K[3]; const bool g_ = a_ > b_; K[1] = g_ ? a_ : b_; K[3] = g_ ? b_ : a_; }
  { const float a_ = K[4], b_ = K[6]; const bool g_ = a_ > b_; K[4] = g_ ? b_ : a_; K[6] = g_ ? a_ : b_; }
  { const float a_ = K[5], b_ = K[7]; const bool g_ = a_ > b_; K[5] = g_ ? b_ : a_; K[7] = g_ ? a_ : b_; }
  { const float a_ = K[8], b_ = K[10]; const bool g_ = a_ > b_; K[8] = g_ ? a_ : b_; K[10] = g_ ? b_ : a_; }
  { const float a_ = K[9], b_ = K[11]; const bool g_ = a_ > b_; K[9] = g_ ? a_ : b_; K[11] = g_ ? b_ : a_; }
  { const float a_ = K[12], b_ = K[14]; const bool g_ = a_ > b_; K[12] = g_ ? b_ : a_; K[14] = g_ ? a_ : b_; }
  { const float a_ = K[13], b_ = K[15]; const bool g_ = a_ > b_; K[13] = g_ ? b_ : a_; K[15] = g_ ? a_ : b_; }
  { const float a_ = K[0], b_ = K[1]; const bool g_ = a_ > b_; K[0] = g_ ? a_ : b_; K[1] = g_ ? b_ : a_; }
  { const float a_ = K[2], b_ = K[3]; const bool g_ = a_ > b_; K[2] = g_ ? a_ : b_; K[3] = g_ ? b_ : a_; }
  { const float a_ = K[4], b_ = K[5]; const bool g_ = a_ > b_; K[4] = g_ ? b_ : a_; K[5] = g_ ? a_ : b_; }
  { const float a_ = K[6], b_ = K[7]; const bool g_ = a_ > b_; K[6] = g_ ? b_ : a_; K[7] = g_ ? a_ : b_; }
  { const float a_ = K[8], b_ = K[9]; const bool g_ = a_ > b_; K[8] = g_ ? a_ : b_; K[9] = g_ ? b_ : a_; }
  { const float a_ = K[10], b_ = K[11]; const bool g_ = a_ > b_; K[10] = g_ ? a_ : b_; K[11] = g_ ? b_ : a_; }
  { const float a_ = K[12], b_ = K[13]; const bool g_ = a_ > b_; K[12] = g_ ? b_ : a_; K[13] = g_ ? a_ : b_; }
  { const float a_ = K[14], b_ = K[15]; const bool g_ = a_ > b_; K[14] = g_ ? b_ : a_; K[15] = g_ ? a_ : b_; }
  { const float a_ = K[0], b_ = K[4]; const bool g_ = a_ > b_; K[0] = g_ ? a_ : b_; K[4] = g_ ? b_ : a_; }
  { const float a_ = K[1], b_ = K[5]; const bool g_ = a_ > b_; K[1] = g_ ? a_ : b_; K[5] = g_ ? b_ : a_; }
  { const float a_ = K[2], b_ = K[6]; const bool g_ = a_ > b_; K[2] = g_ ? a_ : b_; K[6] = g_ ? b_ : a_; }
  { const float a_ = K[3], b_ = K[7]; const bool g_ = a_ > b_; K[3] = g_ ? a_ : b_; K[7] = g_ ? b_ : a_; }
  { const float a_ = K[8], b_ = K[12]; const bool g_ = a_ > b_; K[8] = g_ ? b_ : a_; K[12] = g_ ? a_ : b_; }
  { const float a_ = K[9], b_ = K[13]; const bool g_ = a_ > b_; K[9] = g_ ? b_ : a_; K[13] = g_ ? a_ : b_; }
  { const float a_ = K[10], b_ = K[14]; const bool g_ = a_ > b_; K[10] = g_ ? b_ : a_; K[14] = g_ ? a_ : b_; }
  { const float a_ = K[11], b_ = K[15]; const bool g_ = a_ > b_; K[11] = g_ ? b_ : a_; K[15] = g_ ? a_ : b_; }
  { const float a_ = K[0], b_ = K[2]; const bool g_ = a_ > b_; K[0] = g_ ? a_ : b_; K[2] = g_ ? b_ : a_; }
  { const float a_ = K[1], b_ = K[3]; const bool g_ = a_ > b_; K[1] = g_ ? a_ : b_; K[3] = g_ ? b_ : a_; }
  { const float a_ = K[4], b_ = K[6]; const bool g_ = a_ > b_; K[4] = g_ ? a_ : b_; K[6] = g_ ? b_ : a_; }
  { const float a_ = K[5], b_ = K[7]; const bool g_ = a_ > b_; K[5] = g_ ? a_ : b_; K[7] = g_ ? b_ : a_; }
  { const float a_ = K[8], b_ = K[10]; const bool g_ = a_ > b_; K[8] = g_ ? b_ : a_; K[10] = g_ ? a_ : b_; }
  { const float a_ = K[9], b_ = K[11]; const bool g_ = a_ > b_; K[9] = g_ ? b_ : a_; K[11] = g_ ? a_ : b_; }
  { const float a_ = K[12], b_ = K[14]; const bool g_ = a_ > b_; K[12] = g_ ? b_ : a_; K[14] = g_ ? a_ : b_; }
  { const float a_ = K[13], b_ = K[15]; const bool g_ = a_ > b_; K[13] = g_ ? b_ : a_; K[15] = g_ ? a_ : b_; }
  { const float a_ = K[0], b_ = K[1]; const bool g_ = a_ > b_; K[0] = g_ ? a_ : b_; K[1] = g_ ? b_ : a_; }
  { const float a_ = K[2], b_ = K[3]; const bool g_ = a_ > b_; K[2] = g_ ? a_ : b_; K[3] = g_ ? b_ : a_; }
  { const float a_ = K[4], b_ = K[5]; const bool g_ = a_ > b_; K[4] = g_ ? a_ : b_; K[5] = g_ ? b_ : a_; }
  { const float a_ = K[6], b_ = K[7]; const bool g_ = a_ > b_; K[6] = g_ ? a_ : b_; K[7] = g_ ? b_ : a_; }
  { const float a_ = K[8], b_ = K[9]; const bool g_ = a_ > b_; K[8] = g_ ? b_ : a_; K[9] = g_ ? a_ : b_; }
  { const float a_ = K[10], b_ = K[11]; const bool g_ = a_ > b_; K[10] = g_ ? b_ : a_; K[11] = g_ ? a_ : b_; }
  { const float a_ = K[12], b_ = K[13]; const bool g_ = a_ > b_; K[12] = g_ ? b_ : a_; K[13] = g_ ? a_ : b_; }
  { const float a_ = K[14], b_ = K[15]; const bool g_ = a_ > b_; K[14] = g_ ? b_ : a_; K[15] = g_ ? a_ : b_; }
  { const float a_ = K[0], b_ = K[8]; const bool g_ = a_ > b_; K[0] = g_ ? a_ : b_; K[8] = g_ ? b_ : a_; }
  { const float a_ = K[1], b_ = K[9]; const bool g_ = a_ > b_; K[1] = g_ ? a_ : b_; K[9] = g_ ? b_ : a_; }
  { const float a_ = K[2], b_ = K[10]; const bool g_ = a_ > b_; K[2] = g_ ? a_ : b_; K[10] = g_ ? b_ : a_; }
  { const float a_ = K[3], b_ = K[11]; const bool g_ = a_ > b_; K[3] = g_ ? a_ : b_; K[11] = g_ ? b_ : a_; }
  { const float a_ = K[4], b_ = K[12]; const bool g_ = a_ > b_; K[4] = g_ ? a_ : b_; K[12] = g_ ? b_ : a_; }
  { const float a_ = K[5], b_ = K[13]; const bool g_ = a_ > b_; K[5] = g_ ? a_ : b_; K[13] = g_ ? b_ : a_; }
  { const float a_ = K[6], b_ = K[14]; const bool g_ = a_ > b_; K[6] = g_ ? a_ : b_; K[14] = g_ ? b_ : a_; }
  { const float a_ = K[7], b_ = K[15]; const bool g_ = a_ > b_; K[7] = g_ ? a_ : b_; K[15] = g_ ? b_ : a_; }
  { const float a_ = K[0], b_ = K[4]; const bool g_ = a_ > b_; K[0] = g_ ? a_ : b_; K[4] = g_ ? b_ : a_; }
  { const float a_ = K[1], b_ = K[5]; const bool g_ = a_ > b_; K[1] = g_ ? a_ : b_; K[5] = g_ ? b_ : a_; }
  { const float a_ = K[2], b_ = K[6]; const bool g_ = a_ > b_; K[2] = g_ ? a_ : b_; K[6] = g_ ? b_ : a_; }
  { const float a_ = K[3], b_ = K[7]; const bool g_ = a_ > b_; K[3] = g_ ? a_ : b_; K[7] = g_ ? b_ : a_; }
  { const float a_ = K[8], b_ = K[12]; const bool g_ = a_ > b_; K[8] = g_ ? a_ : b_; K[12] = g_ ? b_ : a_; }
  { const float a_ = K[9], b_ = K[13]; const bool g_ = a_ > b_; K[9] = g_ ? a_ : b_; K[13] = g_ ? b_ : a_; }
  { const float a_ = K[10], b_ = K[14]; const bool g_ = a_ > b_; K[10] = g_ ? a_ : b_; K[14] = g_ ? b_ : a_; }
  { const float a_ = K[11], b_ = K[15]; const bool g_ = a_ > b_; K[11] = g_ ? a_ : b_; K[15] = g_ ? b_ : a_; }
  { const float a_ = K[0], b_ = K[2]; const bool g_ = a_ > b_; K[0] = g_ ? a_ : b_; K[2] = g_ ? b_ : a_; }
  { const float a_ = K[1], b_ = K[3]; const bool g_ = a_ > b_; K[1] = g_ ? a_ : b_; K[3] = g_ ? b_ : a_; }
  { const float a_ = K[4], b_ = K[6]; const bool g_ = a_ > b_; K[4] = g_ ? a_ : b_; K[6] = g_ ? b_ : a_; }
  { const float a_ = K[5], b_ = K[7]; const bool g_ = a_ > b_; K[5] = g_ ? a_ : b_; K[7] = g_ ? b_ : a_; }
  { const float a_ = K[8], b_ = K[10]; const bool g_ = a_ > b_; K[8] = g_ ? a_ : b_; K[10] = g_ ? b_ : a_; }
  { const float a_ = K[9], b_ = K[11]; const bool g_ = a_ > b_; K[9] = g_ ? a_ : b_; K[11] = g_ ? b_ : a_; }
  { const float a_ = K[12], b_ = K[14]; const bool g_ = a_ > b_; K[12] = g_ ? a_ : b_; K[14] = g_ ? b_ : a_; }
  { const float a_ = K[13], b_ = K[15]; const bool g_ = a_ > b_; K[13] = g_ ? a_ : b_; K[15] = g_ ? b_ : a_; }
  { const float a_ = K[0], b_ = K[1]; const bool g_ = a_ > b_; K[0] = g_ ? a_ : b_; K[1] = g_ ? b_ : a_; }
  { const float a_ = K[2], b_ = K[3]; const bool g_ = a_ > b_; K[2] = g_ ? a_ : b_; K[3] = g_ ? b_ : a_; }
  { const float a_ = K[4], b_ = K[5]; const bool g_ = a_ > b_; K[4] = g_ ? a_ : b_; K[5] = g_ ? b_ : a_; }
  { const float a_ = K[6], b_ = K[7]; const bool g_ = a_ > b_; K[6] = g_ ? a_ : b_; K[7] = g_ ? b_ : a_; }
  { const float a_ = K[8], b_ = K[9]; const bool g_ = a_ > b_; K[8] = g_ ? a_ : b_; K[9] = g_ ? b_ : a_; }
  { const float a_ = K[10], b_ = K[11]; const bool g_ = a_ > b_; K[10] = g_ ? a_ : b_; K[11] = g_ ? b_ : a_; }
  { const float a_ = K[12], b_ = K[13]; const bool g_ = a_ > b_; K[12] = g_ ? a_ : b_; K[13] = g_ ? b_ : a_; }
  { const float a_ = K[14], b_ = K[15]; const bool g_ = a_ > b_; K[14] = g_ ? a_ : b_; K[15] = g_ ? b_ : a_; }
  { const float a_ = K[16], b_ = K[17]; const bool g_ = a_ > b_; K[16] = g_ ? a_ : b_; K[17] = g_ ? b_ : a_; }
  { const float a_ = K[18], b_ = K[19]; const bool g_ = a_ > b_; K[18] = g_ ? b_ : a_; K[19] = g_ ? a_ : b_; }
  { const float a_ = K[20], b_ = K[21]; const bool g_ = a_ > b_; K[20] = g_ ? a_ : b_; K[21] = g_ ? b_ : a_; }
  { const float a_ = K[22], b_ = K[23]; const bool g_ = a_ > b_; K[22] = g_ ? b_ : a_; K[23] = g_ ? a_ : b_; }
  { const float a_ = K[24], b_ = K[25]; const bool g_ = a_ > b_; K[24] = g_ ? a_ : b_; K[25] = g_ ? b_ : a_; }
  { const float a_ = K[26], b_ = K[27]; const bool g_ = a_ > b_; K[26] = g_ ? b_ : a_; K[27] = g_ ? a_ : b_; }
  { const float a_ = K[28], b_ = K[29]; const bool g_ = a_ > b_; K[28] = g_ ? a_ : b_; K[29] = g_ ? b_ : a_; }
  { const float a_ = K[30], b_ = K[31]; const bool g_ = a_ > b_; K[30] = g_ ? b_ : a_; K[31] = g_ ? a_ : b_; }
  { const float a_ = K[16], b_ = K[18]; const bool g_ = a_ > b_; K[16] = g_ ? a_ : b_; K[18] = g_ ? b_ : a_; }
  { const float a_ = K[17], b_ = K[19]; const bool g_ = a_ > b_; K[17] = g_ ? a_ : b_; K[19] = g_ ? b_ : a_; }
  { const float a_ = K[20], b_ = K[22]; const bool g_ = a_ > b_; K[20] = g_ ? b_ : a_; K[22] = g_ ? a_ : b_; }
  { const float a_ = K[21], b_ = K[23]; const bool g_ = a_ > b_; K[21] = g_ ? b_ : a_; K[23] = g_ ? a_ : b_; }
  { const float a_ = K[24], b_ = K[26]; const bool g_ = a_ > b_; K[24] = g_ ? a_ : b_; K[26] = g_ ? b_ : a_; }
  { const float a_ = K[25], b_ = K[27]; const bool g_ = a_ > b_; K[25] = g_ ? a_ : b_; K[27] = g_ ? b_ : a_; }
  { const float a_ = K[28], b_ = K[30]; const bool g_ = a_ > b_; K[28] = g_ ? b_ : a_; K[30] = g_ ? a_ : b_; }
  { const float a_ = K[29], b_ = K[31]; const bool g_ = a_ > b_; K[29] = g_ ? b_ : a_; K[31] = g_ ? a_ : b_; }
  { const float a_ = K[16], b_ = K[17]; const bool g_ = a_ > b_; K[16] = g_ ? a_ : b_; K[17] = g_ ? b_ : a_; }
  { const float a_ = K[18], b_ = K[19]; const bool g_ = a_ > b_; K[18] = g_ ? a_ : b_; K[19] = g_ ? b_ : a_; }
  { const float a_ = K[20], b_ = K[21]; const bool g_ = a_ > b_; K[20] = g_ ? b_ : a_; K[21] = g_ ? a_ : b_; }
  { const float a_ = K[22], b_ = K[23]; const bool g_ = a_ > b_; K[22] = g_ ? b_ : a_; K[23] = g_ ? a_ : b_; }
  { const float a_ = K[24], b_ = K[25]; const bool g_ = a_ > b_; K[24] = g_ ? a_ : b_; K[25] = g_ ? b_ : a_; }
  { const float a_ = K[26], b_ = K[27]; const bool g_ = a_ > b_; K[26] = g_ ? a_ : b_; K[27] = g_ ? b_ : a_; }
  { const float a_ = K[28], b_ = K[29]; const bool g_ = a_ > b_; K[28] = g_ ? b_ : a_; K[29] = g_ ? a_ : b_; }
  { const float a_ = K[30], b_ = K[31]; const bool g_ = a_ > b_; K[30] = g_ ? b_ : a_; K[31] = g_ ? a_ : b_; }
  { const float a_ = K[16], b_ = K[20]; const bool g_ = a_ > b_; K[16] = g_ ? a_ : b_; K[20] = g_ ? b_ : a_; }
  { const float a_ = K[17], b_ = K[21]; const bool g_ = a_ > b_; K[17] = g_ ? a_ : b_; K[21] = g_ ? b_ : a_; }
  { const float a_ = K[18], b_ = K[22]; const bool g_ = a_ > b_; K[18] = g_ ? a_ : b_; K[22] = g_ ? b_ : a_; }
  { const float a_ = K[19], b_ = K[23]; const bool g_ = a_ > b_; K[19] = g_ ? a_ : b_; K[23] = g_ ? b_ : a_; }
  { const float a_ = K[24], b_ = K[28]; const bool g_ = a_ > b_; K[24] = g_ ? b_ : a_; K[28] = g_ ? a_ : b_; }
  { const float a_ = K[25], b_ = K[29]; const bool g_ = a_ > b_; K[25] = g_ ? b_ : a_; K[29] = g_ ? a_ : b_; }
  { const float a_ = K[26], b_ = K[30]; const bool g_ = a_ > b_; K[26] = g_ ? b_ : a_; K[30] = g_ ? a_ : b_; }
  { const float a_ = K[27], b_ = K[31]; const bool g_ = a_ > b_; K[27] = g_ ? b_ : a_; K[31] = g_ ? a_ : b_; }
  { const float a_ = K[16], b_ = K[18]; const bool g_ = a_ > b_; K[16] = g_ ? a_ : b_; K[18] = g_ ? b_ : a_; }
  { const float a_ = K[17], b_ = K[19]; const bool g_ = a_ > b_; K[17] = g_ ? a_ : b_; K[19] = g_ ? b_ : a_; }
  { const float a_ = K[20], b_ = K[22]; const bool g_ = a_ > b_; K[20] = g_ ? a_ : b_; K[22] = g_ ? b_ : a_; }
  { const float a_ = K[21], b_ = K[23]; const bool g_ = a_ > b_; K[21] = g_ ? a_ : b_; K[23] = g_ ? b_ : a_; }
  { const float a_ = K[24], b_ = K[26]; const bool g_ = a_ > b_; K[24] = g_ ? b_ : a_; K[26] = g_ ? a_ : b_; }
  { const float a_ = K[25], b_ = K[27]; const bool g_ = a_ > b_; K[25] = g_ ? b_ : a_; K[27] = g_ ? a_ : b_; }
  { const float a_ = K[28], b_ = K[30]; const bool g_ = a_ > b_; K[28] = g_ ? b_ : a_; K[30] = g_ ? a_ : b_; }
  { const float a_ = K[29], b_ = K[31]; const bool g_ = a_ > b_; K[29] = g_ ? b_ : a_; K[31] = g_ ? a_ : b_; }
  { const float a_ = K[16], b_ = K[17]; const bool g_ = a_ > b_; K[16] = g_ ? a_ : b_; K[17] = g_ ? b_ : a_; }
  { const float a_ = K[18], b_ = K[19]; const bool g_ = a_ > b_; K[18] = g_ ? a_ : b_; K[19] = g_ ? b_ : a_; }
  { const float a_ = K[20], b_ = K[21]; const bool g_ = a_ > b_; K[20] = g_ ? a_ : b_; K[21] = g_ ? b_ : a_; }
  { const float a_ = K[22], b_ = K[23]; const bool g_ = a_ > b_; K[22] = g_ ? a_ : b_; K[23] = g_ ? b_ : a_; }
  { const float a_ = K[24], b_ = K[25]; const bool g_ = a_ > b_; K[24] = g_ ? b_ : a_; K[25] = g_ ? a_ : b_; }
  { const float a_ = K[26], b_ = K[27]; const bool g_ = a_ > b_; K[26] = g_ ? b_ : a_; K[27] = g_ ? a_ : b_; }
  { const float a_ = K[28], b_ = K[29]; const bool g_ = a_ > b_; K[28] = g_ ? b_ : a_; K[29] = g_ ? a_ : b_; }
  { const float a_ = K[30], b_ = K[31]; const bool g_ = a_ > b_; K[30] = g_ ? b_ : a_; K[31] = g_ ? a_ : b_; }
  { const float a_ = K[16], b_ = K[24]; const bool g_ = a_ > b_; K[16] = g_ ? a_ : b_; K[24] = g_ ? b_ : a_; }
  { const float a_ = K[17], b_ = K[25]; const bool g_ = a_ > b_; K[17] = g_ ? a_ : b_; K[25] = g_ ? b_ : a_; }
  { const float a_ = K[18], b_ = K[26]; const bool g_ = a_ > b_; K[18] = g_ ? a_ : b_; K[26] = g_ ? b_ : a_; }
  { const float a_ = K[19], b_ = K[27]; const bool g_ = a_ > b_; K[19] = g_ ? a_ : b_; K[27] = g_ ? b_ : a_; }
  { const float a_ = K[20], b_ = K[28]; const bool g_ = a_ > b_; K[20] = g_ ? a_ : b_; K[28] = g_ ? b_ : a_; }
  { const float a_ = K[21], b_ = K[29]; const bool g_ = a_ > b_; K[21] = g_ ? a_ : b_; K[29] = g_ ? b_ : a_; }
  { const float a_ = K[22], b_ = K[30]; const bool g_ = a_ > b_; K[22] = g_ ? a_ : b_; K[30] = g_ ? b_ : a_; }
  { const float a_ = K[23], b_ = K[31]; const bool g_ = a_ > b_; K[23] = g_ ? a_ : b_; K[31] = g_ ? b_ : a_; }
  { const float a_ = K[16], b_ = K[20]; const bool g_ = a_ > b_; K[16] = g_ ? a_ : b_; K[20] = g_ ? b_ : a_; }
  { const float a_ = K[17], b_ = K[21]; const bool g_ = a_ > b_; K[17] = g_ ? a_ : b_; K[21] = g_ ? b_ : a_; }
  { const float a_ = K[18], b_ = K[22]; const bool g_ = a_ > b_; K[18] = g_ ? a_ : b_; K[22] = g_ ? b_ : a_; }
  { const float a_ = K[19], b_ = K[23]; const bool g_ = a_ > b_; K[19] = g_ ? a_ : b_; K[23] = g_ ? b_ : a_; }
  { const float a_ = K[24], b_ = K[28]; const bool g_ = a_ > b_; K[24] = g_ ? a_ : b_; K[28] = g_ ? b_ : a_; }
  { const float a_ = K[25], b_ = K[29]; const bool g_ = a_ > b_; K[25] = g_ ? a_ : b_; K[29] = g_ ? b_ : a_; }
  { const float a_ = K[26], b_ = K[30]; const bool g_ = a_ > b_; K[26] = g_ ? a_ : b_; K[30] = g_ ? b_ : a_; }
  { const float a_ = K[27], b_ = K[31]; const bool g_ = a_ > b_; K[27] = g_ ? a_ : b_; K[31] = g_ ? b_ : a_; }
  { const float a_ = K[16], b_ = K[18]; const bool g_ = a_ > b_; K[16] = g_ ? a_ : b_; K[18] = g_ ? b_ : a_; }
  { const float a_ = K[17], b_ = K[19]; const bool g_ = a_ > b_; K[17] = g_ ? a_ : b_; K[19] = g_ ? b_ : a_; }
  { const float a_ = K[20], b_ = K[22]; const bool g_ = a_ > b_; K[20] = g_ ? a_ : b_; K[22] = g_ ? b_ : a_; }
  { const float a_ = K[21], b_ = K[23]; const bool g_ = a_ > b_; K[21] = g_ ? a_ : b_; K[23] = g_ ? b_ : a_; }
  { const float a_ = K[24], b_ = K[26]; const bool g_ = a_ > b_; K[24] = g_ ? a_ : b_; K[26] = g_ ? b_ : a_; }
  { const float a_ = K[25], b_ = K[27]; const bool g_ = a_ > b_; K[25] = g_ ? a_ : b_; K[27] = g_ ? b_ : a_; }
  { const float a_ = K[28], b_ = K[30]; const bool g_ = a_ > b_; K[28] = g_ ? a_ : b_; K[30] = g_ ? b_ : a_; }
  { const float a_ = K[29], b_ = K[31]; const bool g_ = a_ > b_; K[29] = g_ ? a_ : b_; K[31] = g_ ? b_ : a_; }
  { const float a_ = K[16], b_ = K[17]; const bool g_ = a_ > b_; K[16] = g_ ? a_ : b_; K[17] = g_ ? b_ : a_; }
  { const float a_ = K[18], b_ = K[19]; const bool g_ = a_ > b_; K[18] = g_ ? a_ : b_; K[19] = g_ ? b_ : a_; }
  { const float a_ = K[20], b_ = K[21]; const bool g_ = a_ > b_; K[20] = g_ ? a_ : b_; K[21] = g_ ? b_ : a_; }
  { const float a_ = K[22], b_ = K[23]; const bool g_ = a_ > b_; K[22] = g_ ? a_ : b_; K[23] = g_ ? b_ : a_; }
  { const float a_ = K[24], b_ = K[25]; const bool g_ = a_ > b_; K[24] = g_ ? a_ : b_; K[25] = g_ ? b_ : a_; }
  { const float a_ = K[26], b_ = K[27]; const bool g_ = a_ > b_; K[26] = g_ ? a_ : b_; K[27] = g_ ? b_ : a_; }
  { const float a_ = K[28], b_ = K[29]; const bool g_ = a_ > b_; K[28] = g_ ? a_ : b_; K[29] = g_ ? b_ : a_; }
  { const float a_ = K[30], b_ = K[31]; const bool g_ = a_ > b_; K[30] = g_ ? a_ : b_; K[31] = g_ ? b_ : a_; }
  { const float a_ = K[32], b_ = K[33]; const bool g_ = a_ > b_; K[32] = g_ ? a_ : b_; K[33] = g_ ? b_ : a_; }
  { const float a_ = K[34], b_ = K[35]; const bool g_ = a_ > b_; K[34] = g_ ? b_ : a_; K[35] = g_ ? a_ : b_; }
  { const float a_ = K[36], b_ = K[37]; const bool g_ = a_ > b_; K[36] = g_ ? a_ : b_; K[37] = g_ ? b_ : a_; }
  { const float a_ = K[38], b_ = K[39]; const bool g_ = a_ > b_; K[38] = g_ ? b_ : a_; K[39] = g_ ? a_ : b_; }
  { const float a_ = K[40], b_ = K[41]; const bool g_ = a_ > b_; K[40] = g_ ? a_ : b_; K[41] = g_ ? b_ : a_; }
  { const float a_ = K[42], b_ = K[43]; const bool g_ = a_ > b_; K[42] = g_ ? b_ : a_; K[43] = g_ ? a_ : b_; }
  { const float a_ = K[44], b_ = K[45]; const bool g_ = a_ > b_; K[44] = g_ ? a_ : b_; K[45] = g_ ? b_ : a_; }
  { const float a_ = K[46], b_ = K[47]; const bool g_ = a_ > b_; K[46] = g_ ? b_ : a_; K[47] = g_ ? a_ : b_; }
  { const float a_ = K[32], b_ = K[34]; const bool g_ = a_ > b_; K[32] = g_ ? a_ : b_; K[34] = g_ ? b_ : a_; }
  { const float a_ = K[33], b_ = K[35]; const bool g_ = a_ > b_; K[33] = g_ ? a_ : b_; K[35] = g_ ? b_ : a_; }
  { const float a_ = K[36], b_ = K[38]; const bool g_ = a_ > b_; K[36] = g_ ? b_ : a_; K[38] = g_ ? a_ : b_; }
  { const float a_ = K[37], b_ = K[39]; const bool g_ = a_ > b_; K[37] = g_ ? b_ : a_; K[39] = g_ ? a_ : b_; }
  { const float a_ = K[40], b_ = K[42]; const bool g_ = a_ > b_; K[40] = g_ ? a_ : b_; K[42] = g_ ? b_ : a_; }
  { const float a_ = K[41], b_ = K[43]; const bool g_ = a_ > b_; K[41] = g_ ? a_ : b_; K[43] = g_ ? b_ : a_; }
  { const float a_ = K[44], b_ = K[46]; const bool g_ = a_ > b_; K[44] = g_ ? b_ : a_; K[46] = g_ ? a_ : b_; }
  { const float a_ = K[45], b_ = K[47]; const bool g_ = a_ > b_; K[45] = g_ ? b_ : a_; K[47] = g_ ? a_ : b_; }
  { const float a_ = K[32], b_ = K[33]; const bool g_ = a_ > b_; K[32] = g_ ? a_ : b_; K[33] = g_ ? b_ : a_; }
  { const float a_ = K[34], b_ = K[35]; const bool g_ = a_ > b_; K[34] = g_ ? a_ : b_; K[35] = g_ ? b_ : a_; }
  { const float a_ = K[36], b_ = K[37]; const bool g_ = a_ > b_; K[36] = g_ ? b_ : a_; K[37] = g_ ? a_ : b_; }
  { const float a_ = K[38], b_ = K[39]; const bool g_ = a_ > b_; K[38] = g_ ? b_ : a_; K[39] = g_ ? a_ : b_; }
  { const float a_ = K[40], b_ = K[41]; const bool g_ = a_ > b_; K[40] = g_ ? a_ : b_; K[41] = g_ ? b_ : a_; }
  { const float a_ = K[42], b_ = K[43]; const bool g_ = a_ > b_; K[42] = g_ ? a_ : b_; K[43] = g_ ? b_ : a_; }
  { const float a_ = K[44], b_ = K[45]; const bool g_ = a_ > b_; K[44] = g_ ? b_ : a_; K[45] = g_ ? a_ : b_; }
  { const float a_ = K[46], b_ = K[47]; const bool g_ = a_ > b_; K[46] = g_ ? b_ : a_; K[47] = g_ ? a_ : b_; }
  { const float a_ = K[32], b_ = K[36]; const bool g_ = a_ > b_; K[32] = g_ ? a_ : b_; K[36] = g_ ? b_ : a_; }
  { const float a_ = K[33], b_ = K[37]; const bool g_ = a_ > b_; K[33] = g_ ? a_ : b_; K[37] = g_ ? b_ : a_; }
  { const float a_ = K[34], b_ = K[38]; const bool g_ = a_ > b_; K[34] = g_ ? a_ : b_; K[38] = g_ ? b_ : a_; }
  { const float a_ = K[35], b_ = K[39]; const bool g_ = a_ > b_; K[35] = g_ ? a_ : b_; K[39] = g_ ? b_ : a_; }
  { const float a_ = K[40], b_ = K[44]; const bool g_ = a_ > b_; K[40] = g_ ? b_ : a_; K[44] = g_ ? a_ : b_; }
  { const float a_ = K[41], b_ = K[45]; const bool g_ = a_ > b_; K[41] = g_ ? b_ : a_; K[45] = g_ ? a_ : b_; }
  { const float a_ = K[42], b_ = K[46]; const bool g_ = a_ > b_; K[42] = g_ ? b_ : a_; K[46] = g_ ? a_ : b_; }
  { const float a_ = K[43], b_ = K[47]; const bool g_ = a_ > b_; K[43] = g_ ? b_ : a_; K[47] = g_ ? a_ : b_; }
  { const float a_ = K[32], b_ = K[34]; const bool g_ = a_ > b_; K[32] = g_ ? a_ : b_; K[34] = g_ ? b_ : a_; }
  { const float a_ = K[33], b_ = K[35]; const bool g_ = a_ > b_; K[33] = g_ ? a_ : b_; K[35] = g_ ? b_ : a_; }
  { const float a_ = K[36], b_ = K[38]; const bool g_ = a_ > b_; K[36] = g_ ? a_ : b_; K[38] = g_ ? b_ : a_; }
  { const float a_ = K[37], b_ = K[39]; const bool g_ = a_ > b_; K[37] = g_ ? a_ : b_; K[39] = g_ ? b_ : a_; }
  { const float a_ = K[40], b_ = K[42]; const bool g_ = a_ > b_; K[40] = g_ ? b_ : a_; K[42] = g_ ? a_ : b_; }
  { const float a_ = K[41], b_ = K[43]; const bool g_ = a_ > b_; K[41] = g_ ? b_ : a_; K[43] = g_ ? a_ : b_; }
  { const float a_ = K[44], b_ = K[46]; const bool g_ = a_ > b_; K[44] = g_ ? b_ : a_; K[46] = g_ ? a_ : b_; }
  { const float a_ = K[45], b_ = K[47]; const bool g_ = a_ > b_; K[45] = g_ ? b_ : a_; K[47] = g_ ? a_ : b_; }
  { const float a_ = K[32], b_ = K[33]; const bool g_ = a_ > b_; K[32] = g_ ? a_ : b_; K[33] = g_ ? b_ : a_; }
  { const float a_ = K[34], b_ = K[35]; const bool g_ = a_ > b_; K[34] = g_ ? a_ : b_; K[35] = g_ ? b_ : a_; }
  { const float a_ = K[36], b_ = K[37]; const bool g_ = a_ > b_; K[36] = g_ ? a_ : b_; K[37] = g_ ? b_ : a_; }
  { const float a_ = K[38], b_ = K[39]; const bool g_ = a_ > b_; K[38] = g_ ? a_ : b_; K[39] = g_ ? b_ : a_; }
  { const float a_ = K[40], b_ = K[41]; const bool g_ = a_ > b_; K[40] = g_ ? b_ : a_; K[41] = g_ ? a_ : b_; }
  { const float a_ = K[42], b_ = K[43]; const bool g_ = a_ > b_; K[42] = g_ ? b_ : a_; K[43] = g_ ? a_ : b_; }
  { const float a_ = K[44], b_ = K[45]; const bool g_ = a_ > b_; K[44] = g_ ? b_ : a_; K[45] = g_ ? a_ : b_; }
  { const float a_ = K[46], b_ = K[47]; const bool g_ = a_ > b_; K[46] = g_ ? b_ : a_; K[47] = g_ ? a_ : b_; }
  { const float a_ = K[32], b_ = K[40]; const bool g_ = a_ > b_; K[32] = g_ ? a_ : b_; K[40] = g_ ? b_ : a_; }
  { const float a_ = K[33], b_ = K[41]; const bool g_ = a_ > b_; K[33] = g_ ? a_ : b_; K[41] = g_ ? b_ : a_; }
  { const float a_ = K[34], b_ = K[42]; const bool g_ = a_ > b_; K[34] = g_ ? a_ : b_; K[42] = g_ ? b_ : a_; }
  { const float a_ = K[35], b_ = K[43]; const bool g_ = a_ > b_; K[35] = g_ ? a_ : b_; K[43] = g_ ? b_ : a_; }
  { const float a_ = K[36], b_ = K[44]; const bool g_ = a_ > b_; K[36] = g_ ? a_ : b_; K[44] = g_ ? b_ : a_; }
  { const float a_ = K[37], b_ = K[45]; const bool g_ = a_ > b_; K[37] = g_ ? a_ : b_; K[45] = g_ ? b_ : a_; }
  { const float a_ = K[38], b_ = K[46]; const bool g_ = a_ > b_; K[38] = g_ ? a_ : b_; K[46] = g_ ? b_ : a_; }
  { const float a_ = K[39], b_ = K[47]; const bool g_ = a_ > b_; K[39] = g_ ? a_ : b_; K[47] = g_ ? b_ : a_; }
  { const float a_ = K[32], b_ = K[36]; const bool g_ = a_ > b_; K[32] = g_ ? a_ : b_; K[36] = g_ ? b_ : a_; }
  { const float a_ = K[33], b_ = K[37]; const bool g_ = a_ > b_; K[33] = g_ ? a_ : b_; K[37] = g_ ? b_ : a_; }
  { const float a_ = K[34], b_ = K[38]; const bool g_ = a_ > b_; K[34] = g_ ? a_ : b_; K[38] = g_ ? b_ : a_; }
  { const float a_ = K[35], b_ = K[39]; const bool g_ = a_ > b_; K[35] = g_ ? a_ : b_; K[39] = g_ ? b_ : a_; }
  { const float a_ = K[40], b_ = K[44]; const bool g_ = a_ > b_; K[40] = g_ ? a_ : b_; K[44] = g_ ? b_ : a_; }
  { const float a_ = K[41], b_ = K[45]; const bool g_ = a_ > b_; K[41] = g_ ? a_ : b_; K[45] = g_ ? b_ : a_; }
  { const float a_ = K[42], b_ = K[46]; const bool g_ = a_ > b_; K[42] = g_ ? a_ : b_; K[46] = g_ ? b_ : a_; }
  { const float a_ = K[43], b_ = K[47]; const bool g_ = a_ > b_; K[43] = g_ ? a_ : b_; K[47] = g_ ? b_ : a_; }
  { const float a_ = K[32], b_ = K[34]; const bool g_ = a_ > b_; K[32] = g_ ? a_ : b_; K[34] = g_ ? b_ : a_; }
  { const float a_ = K[33], b_ = K[35]; const bool g_ = a_ > b_; K[33] = g_ ? a_ : b_; K[35] = g_ ? b_ : a_; }
  { const float a_ = K[36], b_ = K[38]; const bool g_ = a_ > b_; K[36] = g_ ? a_ : b_; K[38] = g_ ? b_ : a_; }
  { const float a_ = K[37], b_ = K[39]; const bool g_ = a_ > b_; K[37] = g_ ? a_ : b_; K[39] = g_ ? b_ : a_; }
  { const float a_ = K[40], b_ = K[42]; const bool g_ = a_ > b_; K[40] = g_ ? a_ : b_; K[42] = g_ ? b_ : a_; }
  { const float a_ = K[41], b_ = K[43]; const bool g_ = a_ > b_; K[41] = g_ ? a_ : b_; K[43] = g_ ? b_ : a_; }
  { const float a_ = K[44], b_ = K[46]; const bool g_ = a_ > b_; K[44] = g_ ? a_ : b_; K[46] = g_ ? b_ : a_; }
  { const float a_ = K[45], b_ = K[47]; const bool g_ = a_ > b_; K[45] = g_ ? a_ : b_; K[47] = g_ ? b_ : a_; }
  { const float a_ = K[32], b_ = K[33]; const bool g_ = a_ > b_; K[32] = g_ ? a_ : b_; K[33] = g_ ? b_ : a_; }
  { const float a_ = K[34], b_ = K[35]; const bool g_ = a_ > b_; K[34] = g_ ? a_ : b_; K[35] = g_ ? b_ : a_; }
  { const float a_ = K[36], b_ = K[37]; const bool g_ = a_ > b_; K[36] = g_ ? a_ : b_; K[37] = g_ ? b_ : a_; }
  { const float a_ = K[38], b_ = K[39]; const bool g_ = a_ > b_; K[38] = g_ ? a_ : b_; K[39] = g_ ? b_ : a_; }
  { const float a_ = K[40], b_ = K[41]; const bool g_ = a_ > b_; K[40] = g_ ? a_ : b_; K[41] = g_ ? b_ : a_; }
  { const float a_ = K[42], b_ = K[43]; const bool g_ = a_ > b_; K[42] = g_ ? a_ : b_; K[43] = g_ ? b_ : a_; }
  { const float a_ = K[44], b_ = K[45]; const bool g_ = a_ > b_; K[44] = g_ ? a_ : b_; K[45] = g_ ? b_ : a_; }
  { const float a_ = K[46], b_ = K[47]; const bool g_ = a_ > b_; K[46] = g_ ? a_ : b_; K[47] = g_ ? b_ : a_; }
  { const float a_ = K[48], b_ = K[49]; const bool g_ = a_ > b_; K[48] = g_ ? a_ : b_; K[49] = g_ ? b_ : a_; }
  { const float a_ = K[50], b_ = K[51]; const bool g_ = a_ > b_; K[50] = g_ ? b_ : a_; K[51] = g_ ? a_ : b_; }
  { const float a_ = K[52], b_ = K[53]; const bool g_ = a_ > b_; K[52] = g_ ? a_ : b_; K[53] = g_ ? b_ : a_; }
  { const float a_ = K[54], b_ = K[55]; const bool g_ = a_ > b_; K[54] = g_ ? b_ : a_; K[55] = g_ ? a_ : b_; }
  { const float a_ = K[56], b_ = K[57]; const bool g_ = a_ > b_; K[56] = g_ ? a_ : b_; K[57] = g_ ? b_ : a_; }
  { const float a_ = K[58], b_ = K[59]; const bool g_ = a_ > b_; K[58] = g_ ? b_ : a_; K[59] = g_ ? a_ : b_; }
  { const float a_ = K[60], b_ = K[61]; const bool g_ = a_ > b_; K[60] = g_ ? a_ : b_; K[61] = g_ ? b_ : a_; }
  { const float a_ = K[62], b_ = K[63]; const bool g_ = a_ > b_; K[62] = g_ ? b_ : a_; K[63] = g_ ? a_ : b_; }
  { const float a_ = K[48], b_ = K[50]; const bool g_ = a_ > b_; K[48] = g_ ? a_ : b_; K[50] = g_ ? b_ : a_; }
  { const float a_ = K[49], b_ = K[51]; const bool g_ = a_ > b_; K[49] = g_ ? a_ : b_; K[51] = g_ ? b_ : a_; }
  { const float a_ = K[52], b_ = K[54]; const bool g_ = a_ > b_; K[52] = g_ ? b_ : a_; K[54] = g_ ? a_ : b_; }
  { const float a_ = K[53], b_ = K[55]; const bool g_ = a_ > b_; K[53] = g_ ? b_ : a_; K[55] = g_ ? a_ : b_; }
  { const float a_ = K[56], b_ = K[58]; const bool g_ = a_ > b_; K[56] = g_ ? a_ : b_; K[58] = g_ ? b_ : a_; }
  { const float a_ = K[57], b_ = K[59]; const bool g_ = a_ > b_; K[57] = g_ ? a_ : b_; K[59] = g_ ? b_ : a_; }
  { const float a_ = K[60], b_ = K[62]; const bool g_ = a_ > b_; K[60] = g_ ? b_ : a_; K[62] = g_ ? a_ : b_; }
  { const float a_ = K[61], b_ = K[63]; const bool g_ = a_ > b_; K[61] = g_ ? b_ : a_; K[63] = g_ ? a_ : b_; }
  { const float a_ = K[48], b_ = K[49]; const bool g_ = a_ > b_; K[48] = g_ ? a_ : b_; K[49] = g_ ? b_ : a_; }
  { const float a_ = K[50], b_ = K[51]; const bool g_ = a_ > b_; K[50] = g_ ? a_ : b_; K[51] = g_ ? b_ : a_; }
  { const float a_ = K[52], b_ = K[53]; const bool g_ = a_ > b_; K[52] = g_ ? b_ : a_; K[53] = g_ ? a_ : b_; }
  { const float a_ = K[54], b_ = K[55]; const bool g_ = a_ > b_; K[54] = g_ ? b_ : a_; K[55] = g_ ? a_ : b_; }
  { const float a_ = K[56], b_ = K[57]; const bool g_ = a_ > b_; K[56] = g_ ? a_ : b_; K[57] = g_ ? b_ : a_; }
  { const float a_ = K[58], b_ = K[59]; const bool g_ = a_ > b_; K[58] = g_ ? a_ : b_; K[59] = g_ ? b_ : a_; }
  { const float a_ = K[60], b_ = K[61]; const bool g_ = a_ > b_; K[60] = g_ ? b_ : a_; K[61] = g_ ? a_ : b_; }
  { const float a_ = K[62], b_ = K[63]; const bool g_ = a_ > b_; K[62] = g_ ? b_ : a_; K[63] = g_ ? a_ : b_; }
  { const float a_ = K[48], b_ = K[52]; const bool g_ = a_ > b_; K[48] = g_ ? a_ : b_; K[52] = g_ ? b_ : a_; }
  { const float a_ = K[49], b_ = K[53]; const bool g_ = a_ > b_; K[49] = g_ ? a_ : b_; K[53] = g_ ? b_ : a_; }
  { const float a_ = K[50], b_ = K[54]; const bool g_ = a_ > b_; K[50] = g_ ? a_ : b_; K[54] = g_ ? b_ : a_; }
  { const float a_ = K[51], b_ = K[55]; const bool g_ = a_ > b_; K[51] = g_ ? a_ : b_; K[55] = g_ ? b_ : a_; }
  { const float a_ = K[56], b_ = K[60]; const bool g_ = a_ > b_; K[56] = g_ ? b_ : a_; K[60] = g_ ? a_ : b_; }
  { const float a_ = K[57], b_ = K[61]; const bool g_ = a_ > b_; K[57] = g_ ? b_ : a_; K[61] = g_ ? a_ : b_; }
  { const float a_ = K[58], b_ = K[62]; const bool g_ = a_ > b_; K[58] = g_ ? b_ : a_; K[62] = g_ ? a_ : b_; }
  { const float a_ = K[59], b_ = K[63]; const bool g_ = a_ > b_; K[59] = g_ ? b_ : a_; K[63] = g_ ? a_ : b_; }
  { const float a_ = K[48], b_ = K[50]; const bool g_ = a_ > b_; K[48] = g_ ? a_ : b_; K[50] = g_ ? b_ : a_; }
  { const float a_ = K[49], b_ = K[51]; const bool g_ = a_ > b_; K[49] = g_ ? a_ : b_; K[51] = g_ ? b_ : a_; }
  { const float a_ = K[52], b_ = K[54]; const bool g_ = a_ > b_; K[52] = g_ ? a_ : b_; K[54] = g_ ? b_ : a_; }
  { const float a_ = K[53], b_ = K[55]; const bool g_ = a_ > b_; K[53] = g_ ? a_ : b_; K[55] = g_ ? b_ : a_; }
  { const float a_ = K[56], b_ = K[58]; const bool g_ = a_ > b_; K[56] = g_ ? b_ : a_; K[58] = g_ ? a_ : b_; }
  { const float a_ = K[57], b_ = K[59]; const bool g_ = a_ > b_; K[57] = g_ ? b_ : a_; K[59] = g_ ? a_ : b_; }
  { const float a_ = K[60], b_ = K[62]; const bool g_ = a_ > b_; K[60] = g_ ? b_ : a_; K[62] = g_ ? a_ : b_; }
  { const float a_ = K[61], b_ = K[63]; const bool g_ = a_ > b_; K[61] = g_ ? b_ : a_; K[63] = g_ ? a_ : b_; }
  { const float a_ = K[48], b_ = K[49]; const bool g_ = a_ > b_; K[48] = g_ ? a_ : b_; K[49] = g_ ? b_ : a_; }
  { const float a_ = K[50], b_ = K[51]; const bool g_ = a_ > b_; K[50] = g_ ? a_ : b_; K[51] = g_ ? b_ : a_; }
  { const float a_ = K[52], b_ = K[53]; const bool g_ = a_ > b_; K[52] = g_ ? a_ : b_; K[53] = g_ ? b_ : a_; }
  { const float a_ = K[54], b_ = K[55]; const bool g_ = a_ > b_; K[54] = g_ ? a_ : b_; K[55] = g_ ? b_ : a_; }
  { const float a_ = K[56], b_ = K[57]; const bool g_ = a_ > b_; K[56] = g_ ? b_ : a_; K[57] = g_ ? a_ : b_; }
  { const float a_ = K[58], b_ = K[59]; const bool g_ = a_ > b_; K[58] = g_ ? b_ : a_; K[59] = g_ ? a_ : b_; }
  { const float a_ = K[60], b_ = K[61]; const bool g_ = a_ > b_; K[60] = g_ ? b_ : a_; K[61] = g_ ? a_ : b_; }
  { const float a_ = K[62], b_ = K[63]; const bool g_ = a_ > b_; K[62] = g_ ? b_ : a_; K[63] = g_ ? a_ : b_; }
  { const float a_ = K[48], b_ = K[56]; const bool g_ = a_ > b_; K[48] = g_ ? a_ : b_; K[56] = g_ ? b_ : a_; }
  { const float a_ = K[49], b_ = K[57]; const bool g_ = a_ > b_; K[49] = g_ ? a_ : b_; K[57] = g_ ? b_ : a_; }
  { const float a_ = K[50], b_ = K[58]; const bool g_ = a_ > b_; K[50] = g_ ? a_ : b_; K[58] = g_ ? b_ : a_; }
  { const float a_ = K[51], b_ = K[59]; const bool g_ = a_ > b_; K[51] = g_ ? a_ : b_; K[59] = g_ ? b_ : a_; }
  { const float a_ = K[52], b_ = K[60]; const bool g_ = a_ > b_; K[52] = g_ ? a_ : b_; K[60] = g_ ? b_ : a_; }
  { const float a_ = K[53], b_ = K[61]; const bool g_ = a_ > b_; K[53] = g_ ? a_ : b_; K[61] = g_ ? b_ : a_; }
  { const float a_ = K[54], b_ = K[62]; const bool g_ = a_ > b_; K[54] = g_ ? a_ : b_; K[62] = g_ ? b_ : a_; }
  { const float a_ = K[55], b_ = K[63]; const bool g_ = a_ > b_; K[55] = g_ ? a_ : b_; K[63] = g_ ? b_ : a_; }
  { const float a_ = K[48], b_ = K[52]; const bool g_ = a_ > b_; K[48] = g_ ? a_ : b_; K[52] = g_ ? b_ : a_; }
  { const float a_ = K[49], b_ = K[53]; const bool g_ = a_ > b_; K[49] = g_ ? a_ : b_; K[53] = g_ ? b_ : a_; }
  { const float a_ = K[50], b_ = K[54]; const bool g_ = a_ > b_; K[50] = g_ ? a_ : b_; K[54] = g_ ? b_ : a_; }
  { const float a_ = K[51], b_ = K[55]; const bool g_ = a_ > b_; K[51] = g_ ? a_ : b_; K[55] = g_ ? b_ : a_; }
  { const float a_ = K[56], b_ = K[60]; const bool g_ = a_ > b_; K[56] = g_ ? a_ : b_; K[60] = g_ ? b_ : a_; }
  { const float a_ = K[57], b_ = K[61]; const bool g_ = a_ > b_; K[57] = g_ ? a_ : b_; K[61] = g_ ? b_ : a_; }
  { const float a_ = K[58], b_ = K[62]; const bool g_ = a_ > b_; K[58] = g_ ? a_ : b_; K[62] = g_ ? b_ : a_; }
  { const float a_ = K[59], b_ = K[63]; const bool g_ = a_ > b_; K[59] = g_ ? a_ : b_; K[63] = g_ ? b_ : a_; }
  { const float a_ = K[48], b_ = K[50]; const bool g_ = a_ > b_; K[48] = g_ ? a_ : b_; K[50] = g_ ? b_ : a_; }
  { const float a_ = K[49], b_ = K[51]; const bool g_ = a_ > b_; K[49] = g_ ? a_ : b_; K[51] = g_ ? b_ : a_; }
  { const float a_ = K[52], b_ = K[54]; const bool g_ = a_ > b_; K[52] = g_ ? a_ : b_; K[54] = g_ ? b_ : a_; }
  { const float a_ = K[53], b_ = K[55]; const bool g_ = a_ > b_; K[53] = g_ ? a_ : b_; K[55] = g_ ? b_ : a_; }
  { const float a_ = K[56], b_ = K[58]; const bool g_ = a_ > b_; K[56] = g_ ? a_ : b_; K[58] = g_ ? b_ : a_; }
  { const float a_ = K[57], b_ = K[59]; const bool g_ = a_ > b_; K[57] = g_ ? a_ : b_; K[59] = g_ ? b_ : a_; }
  { const float a_ = K[60], b_ = K[62]; const bool g_ = a_ > b_; K[60] = g_ ? a_ : b_; K[62] = g_ ? b_ : a_; }
  { const float a_ = K[61], b_ = K[63]; const bool g_ = a_ > b_; K[61] = g_ ? a_ : b_; K[63] = g_ ? b_ : a_; }
  { const float a_ = K[48], b_ = K[49]; const bool g_ = a_ > b_; K[48] = g_ ? a_ : b_; K[49] = g_ ? b_ : a_; }
  { const float a_ = K[50], b_ = K[51]; const bool g_ = a_ > b_; K[50] = g_ ? a_ : b_; K[51] = g_ ? b_ : a_; }
  { const float a_ = K[52], b_ = K[53]; const bool g_ = a_ > b_; K[52] = g_ ? a_ : b_; K[53] = g_ ? b_ : a_; }
  { const float a_ = K[54], b_ = K[55]; const bool g_ = a_ > b_; K[54] = g_ ? a_ : b_; K[55] = g_ ? b_ : a_; }
  { const float a_ = K[56], b_ = K[57]; const bool g_ = a_ > b_; K[56] = g_ ? a_ : b_; K[57] = g_ ? b_ : a_; }
  { const float a_ = K[58], b_ = K[59]; const bool g_ = a_ > b_; K[58] = g_ ? a_ : b_; K[59] = g_ ? b_ : a_; }
  { const float a_ = K[60], b_ = K[61]; const bool g_ = a_ > b_; K[60] = g_ ? a_ : b_; K[61] = g_ ? b_ : a_; }
  { const float a_ = K[62], b_ = K[63]; const bool g_ = a_ > b_; K[62] = g_ ? a_ : b_; K[63] = g_ ? b_ : a_; }
  { const float a_ = K[0], b_ = K[31]; K[0] = a_ > b_ ? a_ : b_; }
  { const float a_ = K[1], b_ = K[30]; K[1] = a_ > b_ ? a_ : b_; }
  { const float a_ = K[2], b_ = K[29]; K[2] = a_ > b_ ? a_ : b_; }
  { const float a_ = K[3], b_ = K[28]; K[3] = a_ > b_ ? a_ : b_; }
  { const float a_ = K[4], b_ = K[27]; K[4] = a_ > b_ ? a_ : b_; }
  { const float a_ = K[5], b_ = K[26]; K[5] = a_ > b_ ? a_ : b_; }
  { const float a_ = K[6], b_ = K[25]; K[6] = a_ > b_ ? a_ : b_; }
  { const float a_ = K[7], b_ = K[24]; K[7] = a_ > b_ ? a_ : b_; }
  { const float a_ = K[8], b_ = K[23]; K[8] = a_ > b_ ? a_ : b_; }
  { const float a_ = K[9], b_ = K[22]; K[9] = a_ > b_ ? a_ : b_; }
  { const float a_ = K[10], b_ = K[21]; K[10] = a_ > b_ ? a_ : b_; }
  { const float a_ = K[11], b_ = K[20]; K[11] = a_ > b_ ? a_ : b_; }
  { const float a_ = K[12], b_ = K[19]; K[12] = a_ > b_ ? a_ : b_; }
  { const float a_ = K[13], b_ = K[18]; K[13] = a_ > b_ ? a_ : b_; }
  { const float a_ = K[14], b_ = K[17]; K[14] = a_ > b_ ? a_ : b_; }
  { const float a_ = K[15], b_ = K[16]; K[15] = a_ > b_ ? a_ : b_; }
  { const float a_ = K[0], b_ = K[8]; const bool g_ = a_ > b_; K[0] = g_ ? a_ : b_; K[8] = g_ ? b_ : a_; }
  { const float a_ = K[1], b_ = K[9]; const bool g_ = a_ > b_; K[1] = g_ ? a_ : b_; K[9] = g_ ? b_ : a_; }
  { const float a_ = K[2], b_ = K[10]; const bool g_ = a_ > b_; K[2] = g_ ? a_ : b_; K[10] = g_ ? b_ : a_; }
  { const float a_ = K[3], b_ = K[11]; const bool g_ = a_ > b_; K[3] = g_ ? a_ : b_; K[11] = g_ ? b_ : a_; }
  { const float a_ = K[4], b_ = K[12]; const bool g_ = a_ > b_; K[4] = g_ ? a_ : b_; K[12] = g_ ? b_ : a_; }
  { const float a_ = K[5], b_ = K[13]; const bool g_ = a_ > b_; K[5] = g_ ? a_ : b_; K[13] = g_ ? b_ : a_; }
  { const float a_ = K[6], b_ = K[14]; const bool g_ = a_ > b_; K[6] = g_ ? a_ : b_; K[14] = g_ ? b_ : a_; }
  { const float a_ = K[7], b_ = K[15]; const bool g_ = a_ > b_; K[7] = g_ ? a_ : b_; K[15] = g_ ? b_ : a_; }
  { const float a_ = K[0], b_ = K[4]; const bool g_ = a_ > b_; K[0] = g_ ? a_ : b_; K[4] = g_ ? b_ : a_; }
  { const float a_ = K[1], b_ = K[5]; const bool g_ = a_ > b_; K[1] = g_ ? a_ : b_; K[5] = g_ ? b_ : a_; }
  { const float a_ = K[2], b_ = K[6]; const bool g_ = a_ > b_; K[2] = g_ ? a_ : b_; K[6] = g_ ? b_ : a_; }
  { const float a_ = K[3], b_ = K[7]; const bool g_ = a_ > b_; K[3] = g_ ? a_ : b_; K[7] = g_ ? b_ : a_; }
  { const float a_ = K[8], b_ = K[12]; const bool g_ = a_ > b_; K[8] = g_ ? a_ : b_; K[12] = g_ ? b_ : a_; }
  { const float a_ = K[9], b_ = K[13]; const bool g_ = a_ > b_; K[9] = g_ ? a_ : b_; K[13] = g_ ? b_ : a_; }
  { const float a_ = K[10], b_ = K[14]; const bool g_ = a_ > b_; K[10] = g_ ? a_ : b_; K[14] = g_ ? b_ : a_; }
  { const float a_ = K[11], b_ = K[15]; const bool g_ = a_ > b_; K[11] = g_ ? a_ : b_; K[15] = g_ ? b_ : a_; }
  { const float a_ = K[0], b_ = K[2]; const bool g_ = a_ > b_; K[0] = g_ ? a_ : b_; K[2] = g_ ? b_ : a_; }
  { const float a_ = K[1], b_ = K[3]; const bool g_ = a_ > b_; K[1] = g_ ? a_ : b_; K[3] = g_ ? b_ : a_; }
  { const float a_ = K[4], b_ = K[6]; const bool g_ = a_ > b_; K[4] = g_ ? a_ : b_; K[6] = g_ ? b_ : a_; }
  { const float a_ = K[5], b_ = K[7]; const bool g_ = a_ > b_; K[5] = g_ ? a_ : b_; K[7] = g_ ? b_ : a_; }
  { const float a_ = K[8], b_ = K[10]; const bool g_ = a_ > b_; K[8] = g_ ? a_ : b_; K[10] = g_ ? b_ : a_; }
  { const float a_ = K[9], b_ = K[11]; const bool g_ = a_ > b_; K[9] = g_ ? a_ : b_; K[11] = g_ ? b_ : a_; }
  { const float a_ = K[12], b_ = K[14]; const bool g_ = a_ > b_; K[12] = g_ ? a_ : b_; K[14] = g_ ? b_ : a_; }
  { const float a_ = K[13], b_ = K[15]; const bool g_ = a_ > b_; K[13] = g_ ? a_ : b_; K[15] = g_ ? b_ : a_; }
  { const float a_ = K[0], b_ = K[1]; const bool g_ = a_ > b_; K[0] = g_ ? a_ : b_; K[1] = g_ ? b_ : a_; }
  { const float a_ = K[2], b_ = K[3]; const bool g_ = a_ > b_; K[2] = g_ ? a_ : b_; K[3] = g_ ? b_ : a_; }
  { const float a_ = K[4], b_ = K[5]; const bool g_ = a_ > b_; K[4] = g_ ? a_ : b_; K[5] = g_ ? b_ : a_; }
  { const float a_ = K[6], b_ = K[7]; const bool g_ = a_ > b_; K[6] = g_ ? a_ : b_; K[7] = g_ ? b_ : a_; }
  { const float a_ = K[8], b_ = K[9]; const bool g_ = a_ > b_; K[8] = g_ ? a_ : b_; K[9] = g_ ? b_ : a_; }
  { const float a_ = K[10], b_ = K[11]; const bool g_ = a_ > b_; K[10] = g_ ? a_ : b_; K[11] = g_ ? b_ : a_; }
  { const float a_ = K[12], b_ = K[13]; const bool g_ = a_ > b_; K[12] = g_ ? a_ : b_; K[13] = g_ ? b_ : a_; }
  { const float a_ = K[14], b_ = K[15]; const bool g_ = a_ > b_; K[14] = g_ ? a_ : b_; K[15] = g_ ? b_ : a_; }
  { const float a_ = K[32], b_ = K[63]; K[32] = a_ > b_ ? a_ : b_; }
  { const float a_ = K[33], b_ = K[62]; K[33] = a_ > b_ ? a_ : b_; }
  { const float a_ = K[34], b_ = K[61]; K[34] = a_ > b_ ? a_ : b_; }
  { const float a_ = K[35], b_ = K[60]; K[35] = a_ > b_ ? a_ : b_; }
  { const float a_ = K[36], b_ = K[59]; K[36] = a_ > b_ ? a_ : b_; }
  { const float a_ = K[37], b_ = K[58]; K[37] = a_ > b_ ? a_ : b_; }
  { const float a_ = K[38], b_ = K[57]; K[38] = a_ > b_ ? a_ : b_; }
  { const float a_ = K[39], b_ = K[56]; K[39] = a_ > b_ ? a_ : b_; }
  { const float a_ = K[40], b_ = K[55]; K[40] = a_ > b_ ? a_ : b_; }
  { const float a_ = K[41], b_ = K[54]; K[41] = a_ > b_ ? a_ : b_; }
  { const float a_ = K[42], b_ = K[53]; K[42] = a_ > b_ ? a_ : b_; }
  { const float a_ = K[43], b_ = K[52]; K[43] = a_ > b_ ? a_ : b_; }
  { const float a_ = K[44], b_ = K[51]; K[44] = a_ > b_ ? a_ : b_; }
  { const float a_ = K[45], b_ = K[50]; K[45] = a_ > b_ ? a_ : b_; }
  { const float a_ = K[46], b_ = K[49]; K[46] = a_ > b_ ? a_ : b_; }
  { const float a_ = K[47], b_ = K[48]; K[47] = a_ > b_ ? a_ : b_; }
  { const float a_ = K[32], b_ = K[40]; const bool g_ = a_ > b_; K[32] = g_ ? a_ : b_; K[40] = g_ ? b_ : a_; }
  { const float a_ = K[33], b_ = K[41]; const bool g_ = a_ > b_; K[33] = g_ ? a_ : b_; K[41] = g_ ? b_ : a_; }
  { const float a_ = K[34], b_ = K[42]; const bool g_ = a_ > b_; K[34] = g_ ? a_ : b_; K[42] = g_ ? b_ : a_; }
  { const float a_ = K[35], b_ = K[43]; const bool g_ = a_ > b_; K[35] = g_ ? a_ : b_; K[43] = g_ ? b_ : a_; }
  { const float a_ = K[36], b_ = K[44]; const bool g_ = a_ > b_; K[36] = g_ ? a_ : b_; K[44] = g_ ? b_ : a_; }
  { const float a_ = K[37], b_ = K[45]; const bool g_ = a_ > b_; K[37] = g_ ? a_ : b_; K[45] = g_ ? b_ : a_; }
  { const float a_ = K[38], b_ = K[46]; const bool g_ = a_ > b_; K[38] = g_ ? a_ : b_; K[46] = g_ ? b_ : a_; }
  { const float a_ = K[39], b_ = K[47]; const bool g_ = a_ > b_; K[39] = g_ ? a_ : b_; K[47] = g_ ? b_ : a_; }
  { const float a_ = K[32], b_ = K[36]; const bool g_ = a_ > b_; K[32] = g_ ? a_ : b_; K[36] = g_ ? b_ : a_; }
  { const float a_ = K[33], b_ = K[37]; const bool g_ = a_ > b_; K[33] = g_ ? a_ : b_; K[37] = g_ ? b_ : a_; }
  { const float a_ = K[34], b_ = K[38]; const bool g_ = a_ > b_; K[34] = g_ ? a_ : b_; K[38] = g_ ? b_ : a_; }
  { const float a_ = K[35], b_ = K[39]; const bool g_ = a_ > b_; K[35] = g_ ? a_ : b_; K[39] = g_ ? b_ : a_; }
  { const float a_ = K[40], b_ = K[44]; const bool g_ = a_ > b_; K[40] = g_ ? a_ : b_; K[44] = g_ ? b_ : a_; }
  { const float a_ = K[41], b_ = K[45]; const bool g_ = a_ > b_; K[41] = g_ ? a_ : b_; K[45] = g_ ? b_ : a_; }
  { const float a_ = K[42], b_ = K[46]; const bool g_ = a_ > b_; K[42] = g_ ? a_ : b_; K[46] = g_ ? b_ : a_; }
  { const float a_ = K[43], b_ = K[47]; const bool g_ = a_ > b_; K[43] = g_ ? a_ : b_; K[47] = g_ ? b_ : a_; }
  { const float a_ = K[32], b_ = K[34]; const bool g_ = a_ > b_; K[32] = g_ ? a_ : b_; K[34] = g_ ? b_ : a_; }
  { const float a_ = K[33], b_ = K[35]; const bool g_ = a_ > b_; K[33] = g_ ? a_ : b_; K[35] = g_ ? b_ : a_; }
  { const float a_ = K[36], b_ = K[38]; const bool g_ = a_ > b_; K[36] = g_ ? a_ : b_; K[38] = g_ ? b_ : a_; }
  { const float a_ = K[37], b_ = K[39]; const bool g_ = a_ > b_; K[37] = g_ ? a_ : b_; K[39] = g_ ? b_ : a_; }
  { const float a_ = K[40], b_ = K[42]; const bool g_ = a_ > b_; K[40] = g_ ? a_ : b_; K[42] = g_ ? b_ : a_; }
  { const float a_ = K[41], b_ = K[43]; const bool g_ = a_ > b_; K[41] = g_ ? a_ : b_; K[43] = g_ ? b_ : a_; }
  { const float a_ = K[44], b_ = K[46]; const bool g_ = a_ > b_; K[44] = g_ ? a_ : b_; K[46] = g_ ? b_ : a_; }
  { const float a_ = K[45], b_ = K[47]; const bool g_ = a_ > b_; K[45] = g_ ? a_ : b_; K[47] = g_ ? b_ : a_; }
  { const float a_ = K[32], b_ = K[33]; const bool g_ = a_ > b_; K[32] = g_ ? a_ : b_; K[33] = g_ ? b_ : a_; }
  { const float a_ = K[34], b_ = K[35]; const bool g_ = a_ > b_; K[34] = g_ ? a_ : b_; K[35] = g_ ? b_ : a_; }
  { const float a_ = K[36], b_ = K[37]; const bool g_ = a_ > b_; K[36] = g_ ? a_ : b_; K[37] = g_ ? b_ : a_; }
  { const float a_ = K[38], b_ = K[39]; const bool g_ = a_ > b_; K[38] = g_ ? a_ : b_; K[39] = g_ ? b_ : a_; }
  { const float a_ = K[40], b_ = K[41]; const bool g_ = a_ > b_; K[40] = g_ ? a_ : b_; K[41] = g_ ? b_ : a_; }
  { const float a_ = K[42], b_ = K[43]; const bool g_ = a_ > b_; K[42] = g_ ? a_ : b_; K[43] = g_ ? b_ : a_; }
  { const float a_ = K[44], b_ = K[45]; const bool g_ = a_ > b_; K[44] = g_ ? a_ : b_; K[45] = g_ ? b_ : a_; }
  { const float a_ = K[46], b_ = K[47]; const bool g_ = a_ > b_; K[46] = g_ ? a_ : b_; K[47] = g_ ? b_ : a_; }
  { const float a_ = K[0], b_ = K[47]; K[0] = a_ > b_ ? a_ : b_; }
  { const float a_ = K[1], b_ = K[46]; K[1] = a_ > b_ ? a_ : b_; }
  { const float a_ = K[2], b_ = K[45]; K[2] = a_ > b_ ? a_ : b_; }
  { const float a_ = K[3], b_ = K[44]; K[3] = a_ > b_ ? a_ : b_; }
  { const float a_ = K[4], b_ = K[43]; K[4] = a_ > b_ ? a_ : b_; }
  { const float a_ = K[5], b_ = K[42]; K[5] = a_ > b_ ? a_ : b_; }
  { const float a_ = K[6], b_ = K[41]; K[6] = a_ > b_ ? a_ : b_; }
  { const float a_ = K[7], b_ = K[40]; K[7] = a_ > b_ ? a_ : b_; }
  { const float a_ = K[8], b_ = K[39]; K[8] = a_ > b_ ? a_ : b_; }
  { const float a_ = K[9], b_ = K[38]; K[9] = a_ > b_ ? a_ : b_; }
  { const float a_ = K[10], b_ = K[37]; K[10] = a_ > b_ ? a_ : b_; }
  { const float a_ = K[11], b_ = K[36]; K[11] = a_ > b_ ? a_ : b_; }
  { const float a_ = K[12], b_ = K[35]; K[12] = a_ > b_ ? a_ : b_; }
  { const float a_ = K[13], b_ = K[34]; K[13] = a_ > b_ ? a_ : b_; }
  { const float a_ = K[14], b_ = K[33]; K[14] = a_ > b_ ? a_ : b_; }
  { const float a_ = K[15], b_ = K[32]; K[15] = a_ > b_ ? a_ : b_; }
  { const float a_ = K[0], b_ = K[8]; const bool g_ = a_ > b_; K[0] = g_ ? a_ : b_; K[8] = g_ ? b_ : a_; }
  { const float a_ = K[1], b_ = K[9]; const bool g_ = a_ > b_; K[1] = g_ ? a_ : b_; K[9] = g_ ? b_ : a_; }
  { const float a_ = K[2], b_ = K[10]; const bool g_ = a_ > b_; K[2] = g_ ? a_ : b_; K[10] = g_ ? b_ : a_; }
  { const float a_ = K[3], b_ = K[11]; const bool g_ = a_ > b_; K[3] = g_ ? a_ : b_; K[11] = g_ ? b_ : a_; }
  { const float a_ = K[4], b_ = K[12]; const bool g_ = a_ > b_; K[4] = g_ ? a_ : b_; K[12] = g_ ? b_ : a_; }
  { const float a_ = K[5], b_ = K[13]; const bool g_ = a_ > b_; K[5] = g_ ? a_ : b_; K[13] = g_ ? b_ : a_; }
  { const float a_ = K[6], b_ = K[14]; const bool g_ = a_ > b_; K[6] = g_ ? a_ : b_; K[14] = g_ ? b_ : a_; }
  { const float a_ = K[7], b_ = K[15]; const bool g_ = a_ > b_; K[7] = g_ ? a_ : b_; K[15] = g_ ? b_ : a_; }
  { const float a_ = K[0], b_ = K[4]; const bool g_ = a_ > b_; K[0] = g_ ? a_ : b_; K[4] = g_ ? b_ : a_; }
  { const float a_ = K[1], b_ = K[5]; const bool g_ = a_ > b_; K[1] = g_ ? a_ : b_; K[5] = g_ ? b_ : a_; }
  { const float a_ = K[2], b_ = K[6]; const bool g_ = a_ > b_; K[2] = g_ ? a_ : b_; K[6] = g_ ? b_ : a_; }
  { const float a_ = K[3], b_ = K[7]; const bool g_ = a_ > b_; K[3] = g_ ? a_ : b_; K[7] = g_ ? b_ : a_; }
  { const float a_ = K[8], b_ = K[12]; const bool g_ = a_ > b_; K[8] = g_ ? a_ : b_; K[12] = g_ ? b_ : a_; }
  { const float a_ = K[9], b_ = K[13]; const bool g_ = a_ > b_; K[9] = g_ ? a_ : b_; K[13] = g_ ? b_ : a_; }
  { const float a_ = K[10], b_ = K[14]; const bool g_ = a_ > b_; K[10] = g_ ? a_ : b_; K[14] = g_ ? b_ : a_; }
  { const float a_ = K[11], b_ = K[15]; const bool g_ = a_ > b_; K[11] = g_ ? a_ : b_; K[15] = g_ ? b_ : a_; }
  { const float a_ = K[0], b_ = K[2]; const bool g_ = a_ > b_; K[0] = g_ ? a_ : b_; K[2] = g_ ? b_ : a_; }
  { const float a_ = K[1], b_ = K[3]; const bool g_ = a_ > b_; K[1] = g_ ? a_ : b_; K[3] = g_ ? b_ : a_; }
  { const float a_ = K[4], b_ = K[6]; const bool g_ = a_ > b_; K[4] = g_ ? a_ : b_; K[6] = g_ ? b_ : a_; }
  { const float a_ = K[5], b_ = K[7]; const bool g_ = a_ > b_; K[5] = g_ ? a_ : b_; K[7] = g_ ? b_ : a_; }
  { const float a_ = K[8], b_ = K[10]; const bool g_ = a_ > b_; K[8] = g_ ? a_ : b_; K[10] = g_ ? b_ : a_; }
  { const float a_ = K[9], b_ = K[11]; const bool g_ = a_ > b_; K[9] = g_ ? a_ : b_; K[11] = g_ ? b_ : a_; }
  { const float a_ = K[12], b_ = K[14]; const bool g_ = a_ > b_; K[12] = g_ ? a_ : b_; K[14] = g_ ? b_ : a_; }
  { const float a_ = K[13], b_ = K[15]; const bool g_ = a_ > b_; K[13] = g_ ? a_ : b_; K[15] = g_ ? b_ : a_; }
  { const float a_ = K[0], b_ = K[1]; const bool g_ = a_ > b_; K[0] = g_ ? a_ : b_; K[1] = g_ ? b_ : a_; }
  { const float a_ = K[2], b_ = K[3]; const bool g_ = a_ > b_; K[2] = g_ ? a_ : b_; K[3] = g_ ? b_ : a_; }
  { const float a_ = K[4], b_ = K[5]; const bool g_ = a_ > b_; K[4] = g_ ? a_ : b_; K[5] = g_ ? b_ : a_; }
  { const float a_ = K[6], b_ = K[7]; const bool g_ = a_ > b_; K[6] = g_ ? a_ : b_; K[7] = g_ ? b_ : a_; }
  { const float a_ = K[8], b_ = K[9]; const bool g_ = a_ > b_; K[8] = g_ ? a_ : b_; K[9] = g_ ? b_ : a_; }
  { const float a_ = K[10], b_ = K[11]; const bool g_ = a_ > b_; K[10] = g_ ? a_ : b_; K[11] = g_ ? b_ : a_; }
  { const float a_ = K[12], b_ = K[13]; const bool g_ = a_ > b_; K[12] = g_ ? a_ : b_; K[13] = g_ ? b_ : a_; }
  { const float a_ = K[14], b_ = K[15]; const bool g_ = a_ > b_; K[14] = g_ ? a_ : b_; K[15] = g_ ? b_ : a_; }
}
__device__ __forceinline__ void merge_top16(float (&T)[16], const float (&P)[16]) {
  { const float a_ = T[0], b_ = P[15]; T[0] = a_ > b_ ? a_ : b_; }
  { const float a_ = T[1], b_ = P[14]; T[1] = a_ > b_ ? a_ : b_; }
  { const float a_ = T[2], b_ = P[13]; T[2] = a_ > b_ ? a_ : b_; }
  { const float a_ = T[3], b_ = P[12]; T[3] = a_ > b_ ? a_ : b_; }
  { const float a_ = T[4], b_ = P[11]; T[4] = a_ > b_ ? a_ : b_; }
  { const float a_ = T[5], b_ = P[10]; T[5] = a_ > b_ ? a_ : b_; }
  { const float a_ = T[6], b_ = P[9]; T[6] = a_ > b_ ? a_ : b_; }
  { const float a_ = T[7], b_ = P[8]; T[7] = a_ > b_ ? a_ : b_; }
  { const float a_ = T[8], b_ = P[7]; T[8] = a_ > b_ ? a_ : b_; }
  { const float a_ = T[9], b_ = P[6]; T[9] = a_ > b_ ? a_ : b_; }
  { const float a_ = T[10], b_ = P[5]; T[10] = a_ > b_ ? a_ : b_; }
  { const float a_ = T[11], b_ = P[4]; T[11] = a_ > b_ ? a_ : b_; }
  { const float a_ = T[12], b_ = P[3]; T[12] = a_ > b_ ? a_ : b_; }
  { const float a_ = T[13], b_ = P[2]; T[13] = a_ > b_ ? a_ : b_; }
  { const float a_ = T[14], b_ = P[1]; T[14] = a_ > b_ ? a_ : b_; }
  { const float a_ = T[15], b_ = P[0]; T[15] = a_ > b_ ? a_ : b_; }
  { const float a_ = T[0], b_ = T[8]; const bool g_ = a_ > b_; T[0] = g_ ? a_ : b_; T[8] = g_ ? b_ : a_; }
  { const float a_ = T[1], b_ = T[9]; const bool g_ = a_ > b_; T[1] = g_ ? a_ : b_; T[9] = g_ ? b_ : a_; }
  { const float a_ = T[2], b_ = T[10]; const bool g_ = a_ > b_; T[2] = g_ ? a_ : b_; T[10] = g_ ? b_ : a_; }
  { const float a_ = T[3], b_ = T[11]; const bool g_ = a_ > b_; T[3] = g_ ? a_ : b_; T[11] = g_ ? b_ : a_; }
  { const float a_ = T[4], b_ = T[12]; const bool g_ = a_ > b_; T[4] = g_ ? a_ : b_; T[12] = g_ ? b_ : a_; }
  { const float a_ = T[5], b_ = T[13]; const bool g_ = a_ > b_; T[5] = g_ ? a_ : b_; T[13] = g_ ? b_ : a_; }
  { const float a_ = T[6], b_ = T[14]; const bool g_ = a_ > b_; T[6] = g_ ? a_ : b_; T[14] = g_ ? b_ : a_; }
  { const float a_ = T[7], b_ = T[15]; const bool g_ = a_ > b_; T[7] = g_ ? a_ : b_; T[15] = g_ ? b_ : a_; }
  { const float a_ = T[0], b_ = T[4]; const bool g_ = a_ > b_; T[0] = g_ ? a_ : b_; T[4] = g_ ? b_ : a_; }
  { const float a_ = T[1], b_ = T[5]; const bool g_ = a_ > b_; T[1] = g_ ? a_ : b_; T[5] = g_ ? b_ : a_; }
  { const float a_ = T[2], b_ = T[6]; const bool g_ = a_ > b_; T[2] = g_ ? a_ : b_; T[6] = g_ ? b_ : a_; }
  { const float a_ = T[3], b_ = T[7]; const bool g_ = a_ > b_; T[3] = g_ ? a_ : b_; T[7] = g_ ? b_ : a_; }
  { const float a_ = T[8], b_ = T[12]; const bool g_ = a_ > b_; T[8] = g_ ? a_ : b_; T[12] = g_ ? b_ : a_; }
  { const float a_ = T[9], b_ = T[13]; const bool g_ = a_ > b_; T[9] = g_ ? a_ : b_; T[13] = g_ ? b_ : a_; }
  { const float a_ = T[10], b_ = T[14]; const bool g_ = a_ > b_; T[10] = g_ ? a_ : b_; T[14] = g_ ? b_ : a_; }
  { const float a_ = T[11], b_ = T[15]; const bool g_ = a_ > b_; T[11] = g_ ? a_ : b_; T[15] = g_ ? b_ : a_; }
  { const float a_ = T[0], b_ = T[2]; const bool g_ = a_ > b_; T[0] = g_ ? a_ : b_; T[2] = g_ ? b_ : a_; }
  { const float a_ = T[1], b_ = T[3]; const bool g_ = a_ > b_; T[1] = g_ ? a_ : b_; T[3] = g_ ? b_ : a_; }
  { const float a_ = T[4], b_ = T[6]; const bool g_ = a_ > b_; T[4] = g_ ? a_ : b_; T[6] = g_ ? b_ : a_; }
  { const float a_ = T[5], b_ = T[7]; const bool g_ = a_ > b_; T[5] = g_ ? a_ : b_; T[7] = g_ ? b_ : a_; }
  { const float a_ = T[8], b_ = T[10]; const bool g_ = a_ > b_; T[8] = g_ ? a_ : b_; T[10] = g_ ? b_ : a_; }
  { const float a_ = T[9], b_ = T[11]; const bool g_ = a_ > b_; T[9] = g_ ? a_ : b_; T[11] = g_ ? b_ : a_; }
  { const float a_ = T[12], b_ = T[14]; const bool g_ = a_ > b_; T[12] = g_ ? a_ : b_; T[14] = g_ ? b_ : a_; }
  { const float a_ = T[13], b_ = T[15]; const bool g_ = a_ > b_; T[13] = g_ ? a_ : b_; T[15] = g_ ? b_ : a_; }
  { const float a_ = T[0], b_ = T[1]; const bool g_ = a_ > b_; T[0] = g_ ? a_ : b_; T[1] = g_ ? b_ : a_; }
  { const float a_ = T[2], b_ = T[3]; const bool g_ = a_ > b_; T[2] = g_ ? a_ : b_; T[3] = g_ ? b_ : a_; }
  { const float a_ = T[4], b_ = T[5]; const bool g_ = a_ > b_; T[4] = g_ ? a_ : b_; T[5] = g_ ? b_ : a_; }
  { const float a_ = T[6], b_ = T[7]; const bool g_ = a_ > b_; T[6] = g_ ? a_ : b_; T[7] = g_ ? b_ : a_; }
  { const float a_ = T[8], b_ = T[9]; const bool g_ = a_ > b_; T[8] = g_ ? a_ : b_; T[9] = g_ ? b_ : a_; }
  { const float a_ = T[10], b_ = T[11]; const bool g_ = a_ > b_; T[10] = g_ ? a_ : b_; T[11] = g_ ? b_ : a_; }
  { const float a_ = T[12], b_ = T[13]; const bool g_ = a_ > b_; T[12] = g_ ? a_ : b_; T[13] = g_ ? b_ : a_; }
  { const float a_ = T[14], b_ = T[15]; const bool g_ = a_ > b_; T[14] = g_ ? a_ : b_; T[15] = g_ ? b_ : a_; }
}

__device__ __forceinline__ void peer_topk(const int wave_s, const bf16* pq, const bf16* skb, int* ids, float* gates, LAS float* smem) {
  const int tid_ = opaque_tid(wave_s);
  const int lane = tid_ & 63, n = lane & 31, hh = lane >> 5, wave = tid_ >> 6;
  const int gw = blockIdx.x * NWAVES + wave;
  const int nw = gridDim.x * NWAVES;
  LAS float* lk = smem + wave * 2048;
  for (int it = gw; it < 512 * 8; it += nw) {
    const int h = it & 7, tok0 = (it >> 3) * 32;
#pragma unroll 1
    for (int half = 0; half < 2; half++) {
      bf16x8_t qf[8];
      {
        const bf16* qrow = pq + (size_t)(tok0 + n) * 2048 + h * 256 + half * 128 + 8 * hh;
#pragma unroll
        for (int ks = 0; ks < 8; ks++) qf[ks] = *(const bf16x8_t*)(qrow + 16 * ks);
      }
      float K[64];
#pragma unroll
      for (int kt = 0; kt < 4; kt++) {
        const bf16* krow = skb + ((size_t)((h * 2 + half) * 128 + kt * 32 + n)) * 128 + 8 * hh;
        f32x16_t acc;
#pragma unroll
        for (int r = 0; r < 16; r++) acc[r] = 0.f;
#pragma unroll
        for (int kq = 0; kq < 2; kq++) {
          bf16x8_t kf[4];
#pragma unroll
          for (int i = 0; i < 4; i++) kf[i] = *(const bf16x8_t*)(krow + 16 * (kq * 4 + i));
          MFMA_PAD();
#pragma unroll
          for (int i = 0; i < 4; i++) acc = __builtin_amdgcn_mfma_f32_32x32x16_bf16(kf[i], qf[kq * 4 + i], acc, 0, 0, 0);
          MFMA_PAD();
        }
#pragma unroll
        for (int i = 0; i < 16; i++) K[kt * 16 + i] = pack_key<0x7Fu>(acc[i], (unsigned)(kt * 32 + (i & 3) + 8 * (i >> 2) + 4 * hh));
      }
      __builtin_amdgcn_sched_barrier(0);
      top16_of_64(K);
      __builtin_amdgcn_sched_barrier(0);
      float T[16], P[16];
#pragma unroll
      for (int i = 0; i < 16; i++) { T[i] = K[i]; P[i] = __shfl_xor(K[i], 32, 64); }
      merge_top16(T, P);
#pragma unroll
      for (int i = 0; i < 16; i++) lk[(half * 16 + i) * 64 + lane] = T[i];
      __builtin_amdgcn_sched_barrier(0);
    }
    float f0[16], f1[16];
    int ti0[16], ti1[16];
#pragma unroll
    for (int i = 0; i < 16; i++) {
      const float k0 = lk[i * 64 + lane], k1 = lk[(16 + i) * 64 + lane];
      f0[i] = key_val<0x7Fu>(k0); ti0[i] = (int)key_idx<0x7Fu>(k0);
      f1[i] = key_val<0x7Fu>(k1); ti1[i] = (int)key_idx<0x7Fu>(k1);
    }
    float K[64];
    {
    K[0] = pack_key<0xFFu>(f0[0] + f1[0], 0u);
    K[1] = pack_key<0xFFu>(f0[0] + f1[1], 1u);
    K[2] = pack_key<0xFFu>(f0[0] + f1[2], 2u);
    K[3] = pack_key<0xFFu>(f0[0] + f1[3], 3u);
    K[4] = pack_key<0xFFu>(f0[0] + f1[4], 4u);
    K[5] = pack_key<0xFFu>(f0[0] + f1[5], 5u);
    K[6] = pack_key<0xFFu>(f0[0] + f1[6], 6u);
    K[7] = pack_key<0xFFu>(f0[0] + f1[7], 7u);
    K[8] = pack_key<0xFFu>(f0[0] + f1[8], 8u);
    K[9] = pack_key<0xFFu>(f0[0] + f1[9], 9u);
    K[10] = pack_key<0xFFu>(f0[0] + f1[10], 10u);
    K[11] = pack_key<0xFFu>(f0[0] + f1[11], 11u);
    K[12] = pack_key<0xFFu>(f0[0] + f1[12], 12u);
    K[13] = pack_key<0xFFu>(f0[0] + f1[13], 13u);
    K[14] = pack_key<0xFFu>(f0[0] + f1[14], 14u);
    K[15] = pack_key<0xFFu>(f0[0] + f1[15], 15u);
    K[16] = pack_key<0xFFu>(f0[1] + f1[0], 16u);
    K[17] = pack_key<0xFFu>(f0[1] + f1[1], 17u);
    K[18] = pack_key<0xFFu>(f0[1] + f1[2], 18u);
    K[19] = pack_key<0xFFu>(f0[1] + f1[3], 19u);
    K[20] = pack_key<0xFFu>(f0[1] + f1[4], 20u);
    K[21] = pack_key<0xFFu>(f0[1] + f1[5], 21u);
    K[22] = pack_key<0xFFu>(f0[1] + f1[6], 22u);
    K[23] = pack_key<0xFFu>(f0[1] + f1[7], 23u);
    K[24] = pack_key<0xFFu>(f0[2] + f1[0], 32u);
    K[25] = pack_key<0xFFu>(f0[2] + f1[1], 33u);
    K[26] = pack_key<0xFFu>(f0[2] + f1[2], 34u);
    K[27] = pack_key<0xFFu>(f0[2] + f1[3], 35u);
    K[28] = pack_key<0xFFu>(f0[2] + f1[4], 36u);
    K[29] = pack_key<0xFFu>(f0[3] + f1[0], 48u);
    K[30] = pack_key<0xFFu>(f0[3] + f1[1], 49u);
    K[31] = pack_key<0xFFu>(f0[3] + f1[2], 50u);
    K[32] = pack_key<0xFFu>(f0[3] + f1[3], 51u);
    K[33] = pack_key<0xFFu>(f0[4] + f1[0], 64u);
    K[34] = pack_key<0xFFu>(f0[4] + f1[1], 65u);
    K[35] = pack_key<0xFFu>(f0[4] + f1[2], 66u);
    K[36] = pack_key<0xFFu>(f0[5] + f1[0], 80u);
    K[37] = pack_key<0xFFu>(f0[5] + f1[1], 81u);
    K[38] = pack_key<0xFFu>(f0[6] + f1[0], 96u);
    K[39] = pack_key<0xFFu>(f0[6] + f1[1], 97u);
    K[40] = pack_key<0xFFu>(f0[7] + f1[0], 112u);
    K[41] = pack_key<0xFFu>(f0[7] + f1[1], 113u);
    K[42] = pack_key<0xFFu>(f0[8] + f1[0], 128u);
    K[43] = pack_key<0xFFu>(f0[9] + f1[0], 144u);
    K[44] = pack_key<0xFFu>(f0[10] + f1[0], 160u);
    K[45] = pack_key<0xFFu>(f0[11] + f1[0], 176u);
    K[46] = pack_key<0xFFu>(f0[12] + f1[0], 192u);
    K[47] = pack_key<0xFFu>(f0[13] + f1[0], 208u);
    K[48] = pack_key<0xFFu>(f0[14] + f1[0], 224u);
    K[49] = pack_key<0xFFu>(f0[15] + f1[0], 240u);
    K[50] = -3.0e38f;
    K[51] = -3.0e38f;
    K[52] = -3.0e38f;
    K[53] = -3.0e38f;
    K[54] = -3.0e38f;
    K[55] = -3.0e38f;
    K[56] = -3.0e38f;
    K[57] = -3.0e38f;
    K[58] = -3.0e38f;
    K[59] = -3.0e38f;
    K[60] = -3.0e38f;
    K[61] = -3.0e38f;
    K[62] = -3.0e38f;
    K[63] = -3.0e38f;
    }
    __builtin_amdgcn_sched_barrier(0);
    top16_of_64(K);
    __builtin_amdgcn_sched_barrier(0);
    float bv[16];
    int be[16];
#pragma unroll
    for (int r = 0; r < 16; r++) {
      const int flat = (int)key_idx<0xFFu>(K[r]);
      const int a = flat >> 4, b = flat & 15;
      int i0 = 0, i1 = 0;
#pragma unroll
      for (int i = 0; i < 16; i++) { i0 = (a == i) ? ti0[i] : i0; i1 = (b == i) ? ti1[i] : i1; }
      be[r] = i0 * 128 + i1;
      bv[r] = key_val<0xFFu>(K[r]);
    }
    const float b0 = bv[0];
    float ge[16];
    float gsum = 0.f;
#pragma unroll
    for (int r = 0; r < 16; r++) { ge[r] = __expf(bv[r] - b0); gsum += ge[r]; }
    const float ginv = 1.0f / gsum;
    if (hh == 0) {
      int* ip = ids + (size_t)(tok0 + n) * 128 + h * 16;
      float* gp = gates + (size_t)(tok0 + n) * 128 + h * 16;
#pragma unroll
      for (int r4 = 0; r4 < 4; r4++) {
        *(int4*)(ip + 4 * r4) = make_int4(be[4 * r4], be[4 * r4 + 1], be[4 * r4 + 2], be[4 * r4 + 3]);
        *(float4*)(gp + 4 * r4) = make_float4(ge[4 * r4] * ginv, ge[4 * r4 + 1] * ginv, ge[4 * r4 + 2] * ginv, ge[4 * r4 + 3] * ginv);
      }
    }
  }
}

typedef _Float16 f16x2_t __attribute__((ext_vector_type(2)));
__device__ __forceinline__ unsigned e4m3x2_to_f16x2(unsigned w, unsigned sel) {
  return __builtin_amdgcn_perm(w, w, sel);
}
__device__ __forceinline__ float dot2h(unsigned a, unsigned b, float c) {
  return __builtin_amdgcn_fdot2(__builtin_bit_cast(f16x2_t, a), __builtin_bit_cast(f16x2_t, b), c, false);
}
__device__ __forceinline__ unsigned pack_h2(float lo, float hi) {
  f16x2_t v; v.x = (_Float16)lo; v.y = (_Float16)hi;
  return __builtin_bit_cast(unsigned, v);
}
template <bool FINAL>
__device__ __forceinline__ void peer_gather(const int wave_s, bf16* xn, const float* rst, const unsigned char* ub, const unsigned char* vb, const float* vsc, const float* usc,
                                            const int* ids, const float* gates, float* xw, const float* gnext, float* outp) {
  const int tid_ = opaque_tid(wave_s);
  const int lane = tid_ & 63;
  const int gw = blockIdx.x * NWAVES + (tid_ >> 6);
  const int nw = gridDim.x * NWAVES;
  const int el = ((lane >> 5) & 1) * 8 + ((lane >> 4) & 1) * 4 + ((lane >> 3) & 1) * 2 + ((lane >> 2) & 1);
  int idv = 0;
  uint2 uu[16];
  uint2 vv[16];
  if (gw < NT) {
    idv = ids[(size_t)gw * 128 + (lane & 15)];
#pragma unroll
    for (int e = 0; e < 16; e++) {
      const int id = __builtin_amdgcn_readlane(idv, e);
      uu[e] = *(const uint2*)(ub + (size_t)id * 512 + lane * 8);
      vv[e] = *(const uint2*)(vb + (size_t)id * 512 + lane * 8);
    }
  }
  for (int tok = gw; tok < NT; tok += nw) {
    const int tokn = (tok + nw < NT) ? tok + nw : tok;
    int xqh[2] = {0, 0}, xql[2] = {0, 0};
    float xstep, qhalf;
    {
      const uint4 a = *(const uint4*)(xn + (size_t)tok * DM + lane * 16);
      const uint4 b = *(const uint4*)(xn + (size_t)tok * DM + lane * 16 + 8);
      const unsigned xw_[8] = {a.x, a.y, a.z, a.w, b.x, b.y, b.z, b.w};
      const float4* sp = (const float4*)(rst + (size_t)tok * 16);
      const float4 s0 = sp[0], s1 = sp[1], s2 = sp[2], s3 = sp[3];
      const float xs = rsqrtf((((s0.x + s0.y) + (s0.z + s0.w)) + ((s1.x + s1.y) + (s1.z + s1.w)) + ((s2.x + s2.y) + (s2.z + s2.w)) + ((s3.x + s3.y) + (s3.z + s3.w))) * (1.0f / 1024.f) + EPSF);
      float xf[16];
      float am = 0.f;
#pragma unroll
      for (int k = 0; k < 8; k++) { xf[2 * k] = bf_lo(xw_[k]) * xs; xf[2 * k + 1] = bf_hi(xw_[k]) * xs; am = fmaxf(am, fmaxf(fabsf(xf[2 * k]), fabsf(xf[2 * k + 1]))); }
#pragma unroll
      for (int o = 32; o >= 1; o >>= 1) am = fmaxf(am, __shfl_xor(am, o, 64));
      xstep = am * (1.0f / 119.f);
      const float inv = am > 0.f ? 119.f / am : 0.f;
      int qs = 0;
#pragma unroll
      for (int i = 0; i < 16; i++) {
        const int q = (int)rintf(xf[i] * inv);
        const int t = q + 8;
        xqh[i >> 3] |= ((t >> 4) & 15) << (4 * (i & 7));
        xql[i >> 3] |= (((t & 15) - 8) & 15) << (4 * (i & 7));
        qs += q;
      }
      qhalf = 0.5f * wsum((float)qs);
    }
    f16x2_t acc2[8];
#pragma unroll
    for (int i = 0; i < 8; i++) acc2[i] = (f16x2_t){(_Float16)0.f, (_Float16)0.f};
#pragma unroll 1
    for (int g = 0; g < 8; g++) {
      const int ide = __builtin_amdgcn_ds_bpermute(el << 2, idv);
      const float2 sc2 = ((const float2*)vsc)[ide];
      const float gv = gates[(size_t)tok * 128 + g * 16 + el] * sc2.x;
      const float us = sc2.y * xstep;
      const int idn = ids[(size_t)(g < 7 ? tok : tokn) * 128 + ((g + 1) & 7) * 16 + (lane & 15)];
      float d[16];
#pragma unroll
      for (int e = 0; e < 16; e++) {
        int sh = __builtin_amdgcn_sdot8((int)uu[e].x, xqh[0], 0, false);
        sh = __builtin_amdgcn_sdot8((int)uu[e].y, xqh[1], sh, false);
        int sl = __builtin_amdgcn_sdot8((int)uu[e].x, xql[0], 0, false);
        sl = __builtin_amdgcn_sdot8((int)uu[e].y, xql[1], sl, false);
        d[e] = (float)((sh << 4) + sl);
      }
#pragma unroll
      for (int e = 0; e < 16; e++) {
        const int id = __builtin_amdgcn_readlane(idn, e);
        uu[e] = *(const uint2*)(ub + (size_t)id * 512 + lane * 8);
      }
      float d8[8], d4[4], d2[2], d1;
      {
        const bool hi = (lane & 32) != 0;
#pragma unroll
        for (int i = 0; i < 8; i++) { const float send = hi ? d[i] : d[i + 8]; const float keep = hi ? d[i + 8] : d[i]; d8[i] = keep + __shfl_xor(send, 32, 64); }
      }
      {
        const bool hi = (lane & 16) != 0;
#pragma unroll
        for (int i = 0; i < 4; i++) { const float send = hi ? d8[i] : d8[i + 4]; const float keep = hi ? d8[i + 4] : d8[i]; d4[i] = keep + __shfl_xor(send, 16, 64); }
      }
      {
        const bool hi = (lane & 8) != 0;
#pragma unroll
        for (int i = 0; i < 2; i++) { const float send = hi ? d4[i] : d4[i + 2]; const float keep = hi ? d4[i + 2] : d4[i]; d2[i] = keep + __shfl_xor(send, 8, 64); }
      }
      {
        const bool hi = (lane & 4) != 0;
        const float send = hi ? d2[0] : d2[1];
        const float keep = hi ? d2[1] : d2[0];
        d1 = keep + __shfl_xor(send, 4, 64);
      }
      d1 += __shfl_xor(d1, 2, 64);
      d1 += __shfl_xor(d1, 1, 64);
      const float wl = gv * gelu_tanh((d1 + qhalf) * us);
#pragma unroll
      for (int e = 0; e < 16; e++) {
        const float w = __builtin_bit_cast(float, __builtin_amdgcn_readlane(__builtin_bit_cast(int, wl), ((e >> 3) & 1) * 32 + ((e >> 2) & 1) * 16 + ((e >> 1) & 1) * 8 + (e & 1) * 4));
        const f16x2_t w2 = __builtin_bit_cast(f16x2_t, pack_h2(w, w));
        const unsigned vw[2] = {vv[e].x, vv[e].y};
#pragma unroll
        for (int k = 0; k < 2; k++) {
          const unsigned w4 = vw[k];
          const unsigned le = __builtin_amdgcn_perm(V4_LUT_HI, V4_LUT_LO, w4 & 0x07070707u);
          const unsigned lo = __builtin_amdgcn_perm(V4_LUT_HI, V4_LUT_LO, (w4 >> 4) & 0x07070707u);
          const unsigned ee = ((w4 << 4) & 0x80808080u) | le;
          const unsigned eo = (w4 & 0x80808080u) | lo;
          const unsigned p01 = __builtin_amdgcn_perm(eo, ee, 0x040c000cu), p23 = __builtin_amdgcn_perm(eo, ee, 0x050c010cu);
          const unsigned p45 = __builtin_amdgcn_perm(eo, ee, 0x060c020cu), p67 = __builtin_amdgcn_perm(eo, ee, 0x070c030cu);
          acc2[4 * k + 0] = __builtin_elementwise_fma(__builtin_bit_cast(f16x2_t, p01), w2, acc2[4 * k + 0]);
          acc2[4 * k + 1] = __builtin_elementwise_fma(__builtin_bit_cast(f16x2_t, p23), w2, acc2[4 * k + 1]);
          acc2[4 * k + 2] = __builtin_elementwise_fma(__builtin_bit_cast(f16x2_t, p45), w2, acc2[4 * k + 2]);
          acc2[4 * k + 3] = __builtin_elementwise_fma(__builtin_bit_cast(f16x2_t, p67), w2, acc2[4 * k + 3]);
        }
      }
#pragma unroll
      for (int e = 0; e < 16; e++) {
        const int id = __builtin_amdgcn_readlane(idn, e);
        vv[e] = *(const uint2*)(vb + (size_t)id * 512 + lane * 8);
      }
      idv = idn;
    }
    float acc[16];
#pragma unroll
    for (int i = 0; i < 8; i++) { acc[2 * i] = (float)acc2[i].x; acc[2 * i + 1] = (float)acc2[i].y; }
    float* xr = xw + (size_t)tok * DM + lane * 16;
    float xv[16];
    float ssq = 0.f;
#pragma unroll
    for (int c = 0; c < 4; c++) {
      float4 a0 = *(float4*)(xr + c * 4);
      a0.x += acc[c * 4 + 0]; a0.y += acc[c * 4 + 1]; a0.z += acc[c * 4 + 2]; a0.w += acc[c * 4 + 3];
      if (!FINAL) *(float4*)(xr + c * 4) = a0;
      xv[c * 4 + 0] = a0.x; xv[c * 4 + 1] = a0.y; xv[c * 4 + 2] = a0.z; xv[c * 4 + 3] = a0.w;
      ssq += a0.x * a0.x + a0.y * a0.y + a0.z * a0.z + a0.w * a0.w;
    }
    ssq = wsum(ssq);
    const float rstd = rsqrtf(ssq * (1.0f / DM) + EPSF);
    const float4* g4 = (const float4*)(gnext + lane * 16);
    if (FINAL) {
      float* op = outp + (size_t)tok * DM + lane * 16;
#pragma unroll
      for (int c = 0; c < 4; c++) {
        const float4 gq = g4[c];
        *(float4*)(op + c * 4) = make_float4(xv[c * 4] * rstd * gq.x, xv[c * 4 + 1] * rstd * gq.y, xv[c * 4 + 2] * rstd * gq.z, xv[c * 4 + 3] * rstd * gq.w);
      }
    } else {
      uint4 o0, o1;
      { const float4 ga = g4[0], gb = g4[1];
        o0.x = pk2(xv[0] * rstd * ga.x, xv[1] * rstd * ga.y); o0.y = pk2(xv[2] * rstd * ga.z, xv[3] * rstd * ga.w);
        o0.z = pk2(xv[4] * rstd * gb.x, xv[5] * rstd * gb.y); o0.w = pk2(xv[6] * rstd * gb.z, xv[7] * rstd * gb.w); }
      { const float4 ga = g4[2], gb = g4[3];
        o1.x = pk2(xv[8] * rstd * ga.x, xv[9] * rstd * ga.y); o1.y = pk2(xv[10] * rstd * ga.z, xv[11] * rstd * ga.w);
        o1.z = pk2(xv[12] * rstd * gb.x, xv[13] * rstd * gb.y); o1.w = pk2(xv[14] * rstd * gb.z, xv[15] * rstd * gb.w); }
      *(uint4*)(xn + (size_t)tok * DM + lane * 16) = o0;
      *(uint4*)(xn + (size_t)tok * DM + lane * 16 + 8) = o1;
    }
  }
}

__device__ __forceinline__ void prologue_transposes(const int wave_s, const Params& p, unsigned char* ws, LAS unsigned char* lds) {
  const int tid_ = opaque_tid(wave_s);
  const int lane = tid_ & 63, wave = tid_ >> 6;
  LAS float* scr = (LAS float*)(lds + wave * 16384);
  const int gw = blockIdx.x * NWAVES + wave, NGW = gridDim.x * NWAVES;
  constexpr int I_IN = (DM / 64) * (DIN / 32), I_SQ = (DM / 64) * (DM / 32), I_2K = (DM / 64) * (2048 / 32);
  constexpr int I_GL = (256 / 64) * (256 / 32);
  constexpr int PER_LAYER = I_IN + 3 * I_SQ + 2 * I_2K + I_GL;
  const float* w3 = karg_in(3); const float* w19 = karg_in(19); const float* w22 = karg_in(22);
  const float* w23 = karg_in(23); const float* w24 = karg_in(24); const float* w26 = karg_in(26);
  const float* w16 = karg_in(16);
  for (int it = gw; it < 2 * PER_LAYER; it += NGW) {
    const int l = it / PER_LAYER;
    int r = it % PER_LAYER;
    unsigned char* wl = ws + WS_WT + (size_t)l * WT_LAYER;
    if (r < I_IN) { transpose_item(w3 + (size_t)l * DM * DIN, DM, DIN, (bf16*)(wl + WT_IN), scr, r, lane); continue; } r -= I_IN;
    if (r < I_SQ) { transpose_item(w19 + (size_t)l * DM * DM, DM, DM, (bf16*)(wl + WT_OUT), scr, r, lane); continue; } r -= I_SQ;
    if (r < I_SQ) { transpose_item(w22 + (size_t)l * DM * DM, DM, DM, (bf16*)(wl + WT_MQ), scr, r, lane); continue; } r -= I_SQ;
    if (r < I_2K) { transpose_item(w23 + (size_t)l * DM * 2048, DM, 2048, (bf16*)(wl + WT_MKV), scr, r, lane); continue; } r -= I_2K;
    if (r < I_SQ) { transpose_item(w24 + (size_t)l * DM * DM, DM, DM, (bf16*)(wl + WT_MO), scr, r, lane); continue; } r -= I_SQ;
    if (r < I_2K) { transpose_item(w26 + (size_t)l * DM * 2048, DM, 2048, (bf16*)(wl + WT_PQ), scr, r, lane); continue; } r -= I_2K;
    transpose_item(w16 + (size_t)l * 256 * 256, 256, 256, (bf16*)(wl + WT_GLU), scr, r, lane);
  }
}

template <class T> __device__ __forceinline__ T* opq(T* p) { asm volatile("" : "+s"(p)); return p; }
__device__ __forceinline__ void cvt_rows_bf16(const int wave_s, const float* src, bf16* dst, size_t n) {
  const int tid_ = opaque_tid(wave_s);
  const size_t gt = (size_t)blockIdx.x * (NWAVES * 64) + tid_;
  const size_t nth = (size_t)gridDim.x * NWAVES * 64;
  for (size_t i = gt; i < n / 8; i += nth) {
    const float4 a = ((const float4*)src)[2 * i], b = ((const float4*)src)[2 * i + 1];
    uint4 o; o.x = pk2(a.x, a.y); o.y = pk2(a.z, a.w); o.z = pk2(b.x, b.y); o.w = pk2(b.z, b.w);
    ((uint4*)dst)[i] = o;
  }
}

__device__ __forceinline__ unsigned enc_e4m3(float x) {
  const _Float16 hf = (_Float16)x;
  const unsigned h = (unsigned)__builtin_bit_cast(unsigned short, hf);
  return ((h + 0x7Fu + ((h >> 8) & 1u)) >> 8) & 0xFFu;
}
__device__ __forceinline__ void cvt_rows_e4m3(const int wave_s, const float* src, unsigned char* dst, size_t n, float sc) {
  const int tid_ = opaque_tid(wave_s);
  const size_t gt = (size_t)blockIdx.x * (NWAVES * 64) + tid_;
  const size_t nth = (size_t)gridDim.x * NWAVES * 64;
  for (size_t i = gt; i < n / 16; i += nth) {
    unsigned w[4];
#pragma unroll
    for (int k = 0; k < 4; k++) {
      const float4 a = ((const float4*)src)[4 * i + k];
      w[k] = enc_e4m3(a.x * sc) | (enc_e4m3(a.y * sc) << 8) | (enc_e4m3(a.z * sc) << 16) | (enc_e4m3(a.w * sc) << 24);
    }
    uint4 o; o.x = w[0]; o.y = w[1]; o.z = w[2]; o.w = w[3];
    ((uint4*)dst)[i] = o;
  }
}

__device__ __forceinline__ unsigned enc_v4(float z) {
  const float az = fabsf(z);
  unsigned c = 0;
  c += az > 0.25f; c += az > 0.5f; c += az > 0.75f; c += az > 1.0625f; c += az > 1.375f; c += az > 1.75f; c += az > 2.25f;
  return c | ((__builtin_bit_cast(unsigned, z) >> 28) & 8u);
}
__device__ __forceinline__ void cvt_rows_i4(const int wave_s, const float* src, unsigned char* dst, float* sc_out, int nrows) {
  const int tid_ = opaque_tid(wave_s);
  const int lane = tid_ & 63;
  const int gw = blockIdx.x * NWAVES + (tid_ >> 6);
  const int nw = gridDim.x * NWAVES;
  for (int r = gw; r < nrows; r += nw) {
    const float4* sp = (const float4*)(src + (size_t)r * 1024 + lane * 16);
    const float4 a0 = sp[0], a1 = sp[1], a2 = sp[2], a3 = sp[3];
    const float xv[16] = {a0.x, a0.y, a0.z, a0.w, a1.x, a1.y, a1.z, a1.w, a2.x, a2.y, a2.z, a2.w, a3.x, a3.y, a3.z, a3.w};
    float ss = 0.f;
#pragma unroll
    for (int i = 0; i < 16; i++) ss += xv[i] * xv[i];
    ss = wsum(ss);
    const float sc = sqrtf(ss * (1.0f / 1024.f)) * U4_STEP;
    const float inv = sc > 0.f ? 1.0f / sc : 0.f;
    unsigned w[2] = {0u, 0u};
#pragma unroll
    for (int i = 0; i < 16; i++) {
      const float f = fminf(fmaxf(floorf(xv[i] * inv), -8.f), 7.f);
      w[i >> 3] |= ((unsigned)(int)f & 15u) << (4 * (i & 7));
    }
    uint2 o; o.x = w[0]; o.y = w[1];
    *(uint2*)(dst + (size_t)r * 512 + lane * 8) = o;
    if (lane == 0) sc_out[2 * r] = sc;
  }
}
__device__ __forceinline__ void cvt_rows_v4(const int wave_s, const float* src, unsigned char* dst, float* sc_out, int nrows) {
  const int tid_ = opaque_tid(wave_s);
  const int lane = tid_ & 63;
  const int gw = blockIdx.x * NWAVES + (tid_ >> 6);
  const int nw = gridDim.x * NWAVES;
  for (int r = gw; r < nrows; r += nw) {
    const float4* sp = (const float4*)(src + (size_t)r * 1024 + lane * 16);
    const float4 a0 = sp[0], a1 = sp[1], a2 = sp[2], a3 = sp[3];
    const float xv[16] = {a0.x, a0.y, a0.z, a0.w, a1.x, a1.y, a1.z, a1.w, a2.x, a2.y, a2.z, a2.w, a3.x, a3.y, a3.z, a3.w};
    float ss = 0.f;
#pragma unroll
    for (int i = 0; i < 16; i++) ss += xv[i] * xv[i];
    ss = wsum(ss);
    const float sc = sqrtf(ss * (1.0f / 1024.f)) * V4_ROWSCALE;
    const float inv = sc > 0.f ? 1.0f / sc : 0.f;
    unsigned w[2] = {0u, 0u};
#pragma unroll
    for (int i = 0; i < 16; i++) w[i >> 3] |= enc_v4(xv[i] * inv) << (4 * (i & 7));
    uint2 o; o.x = w[0]; o.y = w[1];
    *(uint2*)(dst + (size_t)r * 512 + lane * 8) = o;
    if (lane == 0) sc_out[2 * r] = sc;
  }
}

#define GEMM_F32(Aptr, Wt, Cptr, Rptr, M_, N_) do { \
    pg8::Gemm g_{opq((const bf16*)(Aptr)), opq((const bf16*)(Wt)), (M_), (N_), DM}; pg8::StaticOrder S_; S_.init((M_), (N_), (int)gridDim.x, (int)blockIdx.x); \
    pg8::EpiF32R E_{opq((float*)(Cptr)), opq((const float*)(Rptr)), (N_)}; \
    pg8::gemm_phase<pg8::EpiF32R, pg8::StaticOrder, true, true>(wave_s, ldsl, g_, S_, E_); } while (0)
#define GEMM_BF16_C(Aptr, Wt, Optr, M_, N_, C_) do { \
    pg8::Gemm g_{opq((const bf16*)(Aptr)), opq((const bf16*)(Wt)), (M_), (N_), DM}; pg8::StaticOrder S_; S_.init((M_), (N_), (int)gridDim.x, (C_)); \
    pg8::EpiBf16 E_{opq((bf16*)(Optr)), (N_)}; \
    pg8::gemm_phase<pg8::EpiBf16, pg8::StaticOrder, true, true>(wave_s, ldsl, g_, S_, E_); } while (0)
#define GEMM_BF16(Aptr, Wt, Optr, M_, N_) GEMM_BF16_C(Aptr, Wt, Optr, M_, N_, (int)blockIdx.x)
#define GEMM_F32RN(Aptr, Wt, Cptr, Rptr, XGptr, Gptr, STptr) do { \
    pg8::Gemm g_{opq((const bf16*)(Aptr)), opq((const bf16*)(Wt)), NT, DM, DM}; pg8::StaticOrder S_; S_.init(NT, DM, (int)gridDim.x, (int)blockIdx.x); \
    pg8::EpiF32RN E_{opq((float*)(Cptr)), opq((const float*)(Rptr)), DM, opq((bf16*)(XGptr)), opq((const float*)(Gptr)), opq((float*)(STptr))}; \
    pg8::gemm_phase<pg8::EpiF32RN, pg8::StaticOrder, true, true>(wave_s, ldsl, g_, S_, E_); } while (0)
#define GEMM_BF16S(Aptr, Wt, Optr, N_, STptr) do { \
    pg8::Gemm g_{opq((const bf16*)(Aptr)), opq((const bf16*)(Wt)), NT, (N_), DM}; pg8::StaticOrder S_; S_.init(NT, (N_), (int)gridDim.x, (int)blockIdx.x); \
    pg8::EpiBf16S E_{opq((bf16*)(Optr)), (N_), opq((const float*)(STptr))}; \
    pg8::gemm_phase<pg8::EpiBf16S, pg8::StaticOrder, true, true>(wave_s, ldsl, g_, S_, E_); } while (0)

__global__ void __launch_bounds__(NWAVES * 64, 2) fwd_megakernel(Params p) {
  extern __shared__ __attribute__((aligned(16))) unsigned char lds[];
  LAS unsigned char* ldsl = (LAS unsigned char*)lds;
  LAS float* smem = (LAS float*)ldsl;
  const int wave_s = __builtin_amdgcn_readfirstlane((int)(threadIdx.x >> 6));
  unsigned char* ws = p.ws;
  volatile LAS unsigned* MISC = (volatile LAS unsigned*)(ldsl + (LDS_BYTES - 256));
  if (threadIdx.x < 64) MISC[threadIdx.x] = 0u;
  __syncthreads();
  const XcdBarrier bar = xcd_barrier_post((unsigned*)(ws + WS_CTL) + 4096, MISC + 8);
  float* xw = (float*)(ws + WS_XW);
  bf16* xn = (bf16*)(ws + WS_XN);
  bf16* big = (bf16*)(ws + WS_BIG);
  bf16* y = (bf16*)(ws + WS_Y);
  bf16* memh = (bf16*)(ws + WS_MEMH);
  bf16* kvb = (bf16*)(ws + WS_KVB);
  bf16* vT = (bf16*)(ws + WS_VT);
  float* ssmE = (float*)(ws + WS_SSME);
  float* ssmp = (float*)(ws + WS_SSMP);
  int* ids = (int*)(ws + WS_IDS);
  float* gates = (float*)(ws + WS_GATE);
  bf16* skb = (bf16*)(ws + WS_SKB);
  unsigned char* ub = ws + WS_UB;
  unsigned char* vb = ws + WS_VB;
  float* rst = (float*)(ws + WS_RST);
  float* vsc = (float*)(ws + WS_VSC);
  float* usc = (float*)(ws + WS_USC);

  prologue_transposes(wave_s, p, ws, ldsl);
  cvt_rows_bf16(wave_s, karg_in(27), skb, (size_t)2 * 8 * 2 * 128 * 128);
  cvt_rows_i4(wave_s, karg_in(28), ub, vsc + 1, 2 * 16384);
  cvt_rows_v4(wave_s, karg_in(29), vb, vsc, 2 * 16384);
  for (int l = 0; l < 2; l++)
    rms_rows<true>(wave_s, karg_in(1), karg_in(21) + l * DM, memh + (size_t)l * 1024 * 1024, 1024);
  ssm_params(wave_s, p, ssmp);
  rms_rows<true>(wave_s, karg_in(0), karg_in(2), xn, NT);
  xcd_barrier(bar);
  for (int l = 0; l < 2; l++)
    GEMM_BF16_C(memh + (size_t)l * 1024 * 1024, ws + WS_WT + (size_t)l * WT_LAYER + WT_MKV,
              kvb + (size_t)l * 1024 * 2048, 1024, 2048, (int)((blockIdx.x + gridDim.x - 64u - 32u * (unsigned)l) % gridDim.x));

#pragma nounroll
  for (int l = 0; l < 2; l++) {
    const float* xcur = (l == 0) ? karg_in(0) : xw;
    const float* sp = ssmp + (size_t)l * SSMP_PER_LAYER;
    const unsigned char* wl = ws + WS_WT + (size_t)l * WT_LAYER;
    GEMM_BF16(xn, wl + WT_IN, big, NT, DIN);
    xcd_barrier(bar);
    if (l == 0) vt_phase(wave_s, kvb, vT);
    ssm_chunk_end(wave_s, sp, big, ssmE, smem);
    flag_arrive((unsigned*)(ws + WS_CTL) + 8192 + 64 * l);
    attn_phase(wave_s, p, l, big, y, smem);
    conv_phase(wave_s, p, l, big, y, smem);
    flag_wait((unsigned*)(ws + WS_CTL) + 8192 + 64 * l, bar.bar);
    ssm_finish(wave_s, p, l, sp, big, ssmE, y, smem);
    xcd_barrier(bar);
    GEMM_F32RN(y, wl + WT_OUT, xw, xcur, xn, karg_in(20) + l * DM, rst);
    xcd_barrier(bar);
    GEMM_BF16S(xn, wl + WT_MQ, big, DM, rst);
    xcd_barrier(bar);
    memattn_phase(wave_s, big, kvb + (size_t)l * 1024 * 2048, vT + (size_t)l * 4 * 4 * 256 * 256, y, smem);
    xcd_barrier(bar);
    GEMM_F32RN(y, wl + WT_MO, xw, (const float*)xw, xn, karg_in(25) + l * DM, rst);
    xcd_barrier(bar);
    GEMM_BF16S(xn, wl + WT_PQ, big, 2048, rst);
    xcd_barrier(bar);
    peer_topk(wave_s, big, skb + (size_t)l * 8 * 2 * 128 * 128, ids, gates, smem);
    xcd_barrier(bar);
    if (l == 0) {
      peer_gather<false>(wave_s, xn, rst, ub + (size_t)l * 16384 * 512, vb + (size_t)l * 16384 * 512, vsc + (size_t)l * 2 * 16384, usc, ids, gates, xw, karg_in(2) + DM, (float*)nullptr);
      xcd_barrier(bar);
    } else {
      peer_gather<true>(wave_s, xn, rst, ub + (size_t)l * 16384 * 512, vb + (size_t)l * 16384 * 512, vsc + (size_t)l * 2 * 16384, usc, ids, gates, xw, karg_in(30), p.out);
    }
  }
}

extern "C" void kernel_launch(void* const* d_in, const int* in_sizes, int n_in,
                              void* d_out, int out_size, void* d_ws, size_t ws_size,
                              hipStream_t stream) {
  static int grid_blocks = 0;
  if (!grid_blocks) {
    int dev = 0, cus = 0, per_cu = 0;
    (void)hipGetDevice(&dev);
    (void)hipDeviceGetAttribute(&cus, hipDeviceAttributeMultiprocessorCount, dev);
    (void)hipFuncSetAttribute((const void*)fwd_megakernel, hipFuncAttributeMaxDynamicSharedMemorySize, LDS_BYTES);
    (void)hipOccupancyMaxActiveBlocksPerMultiprocessor(&per_cu, fwd_megakernel, NWAVES * 64, LDS_BYTES);
    if (per_cu < 1) fprintf(stderr, "occupancy query reports %d blocks/CU\n", per_cu);
    grid_blocks = cus;
  }
  (void)hipMemsetAsync((char*)d_ws + WS_CTL, 0, 65536, stream);
  Params p{};
  for (int i = 0; i < 31; i++) p.in[i] = (const float*)d_in[i];
  p.out = (float*)d_out;
  p.ws = (unsigned char*)d_ws;
  void* args[] = {&p};
  hipError_t e = hipLaunchCooperativeKernel((void*)fwd_megakernel, dim3(grid_blocks), dim3(NWAVES * 64),
                                            args, LDS_BYTES, stream);
  if (e != hipSuccess)
    fprintf(stderr, "cooperative launch failed: %s (grid %d)\n", hipGetErrorString(e), grid_blocks);
}
```

```cpp
#include <hip/hip_runtime.h>
#include <hip/hip_cooperative_groups.h>
#include <cstdio>
namespace cg = cooperative_groups;

#define NT 16384
#define SEQ 4096
#define DM 1024
#define DIN 2304
#define NMEM 256
#define EPSF 1e-6f
#define NWAVES 8
#define LDS_BYTES 147456

typedef unsigned short bf16;
#define LAS __attribute__((address_space(3)))

struct Params {
  const float* in[31];
  float* out;
  unsigned char* ws;
};
typedef __attribute__((address_space(4))) const unsigned char* kaptr_t;
__device__ __forceinline__ const float* karg_in(int i) {
  kaptr_t ka = (kaptr_t)__builtin_amdgcn_kernarg_segment_ptr();
  asm volatile("" : "+s"(ka));
  return *(const float* __attribute__((address_space(4))) const*)(ka + 8 * i);
}

constexpr size_t MiB = 1u << 20;
constexpr size_t WS_CTL  = 0;
constexpr size_t WS_WT   = 1 * MiB;
constexpr size_t WT_IN = 0, WT_OUT = WT_IN + (size_t)DIN * DM * 2, WT_MQ = WT_OUT + (size_t)DM * DM * 2,
                 WT_MKV = WT_MQ + (size_t)DM * DM * 2, WT_MO = WT_MKV + (size_t)2048 * DM * 2,
                 WT_PQ = WT_MO + (size_t)DM * DM * 2, WT_GLU = WT_PQ + (size_t)2048 * DM * 2, WT_LAYER = WT_GLU + (size_t)256 * 256 * 2;
constexpr size_t WS_XW   = WS_WT + 2 * WT_LAYER;
constexpr size_t WS_XN   = WS_XW + (size_t)NT * DM * 4;
constexpr size_t WS_BIG  = WS_XN + (size_t)NT * DM * 2;
constexpr size_t WS_Y    = WS_BIG + (size_t)NT * DIN * 2;
constexpr size_t WS_MEMH = WS_Y + (size_t)NT * DM * 2;
constexpr size_t WS_KVB  = WS_MEMH + (size_t)2 * 1024 * 1024 * 2;
constexpr size_t WS_VT   = WS_KVB + (size_t)2 * 1024 * 2048 * 2;
constexpr size_t WS_SSME = WS_VT + (size_t)2 * 4 * 4 * 256 * 256 * 2;
#define SSMP_PER_LAYER (2048 + 2048 + 32768)
constexpr size_t WS_SSMP = WS_SSME + (size_t)4 * 64 * 16 * 64 * 2 * 4;
constexpr size_t WS_IDS  = WS_SSMP + (size_t)2 * SSMP_PER_LAYER * 4;
constexpr size_t WS_GATE = WS_IDS + (size_t)NT * 128 * 4;
constexpr size_t WS_SKB  = WS_GATE + (size_t)NT * 128 * 4;
constexpr size_t WS_UB   = WS_SKB + (size_t)2 * 8 * 2 * 128 * 128 * 2;
constexpr size_t WS_VB   = WS_UB + (size_t)2 * 16384 * 512;
constexpr size_t WS_VSC  = WS_VB + (size_t)2 * 16384 * 512;
constexpr size_t WS_USC  = WS_VSC + (size_t)2 * 16384 * 4;
constexpr size_t WS_RST  = WS_USC + (size_t)2 * 16384 * 4;
constexpr size_t WS_END  = WS_RST + (size_t)NT * 16 * 4;
#define U_SCALE 64.0f
#define U4_STEP 0.3352f
#define V4_LUT_LO 0x3B393630u
#define V4_LUT_HI 0x41403E3Du
#define V4_ROWSCALE 1.075f
static_assert(WS_END <= 512 * MiB, "workspace");
static_assert(WT_LAYER % 256 == 0 && WS_SSMP % 16 == 0 && WS_IDS % 16 == 0 && WS_SKB % 256 == 0 && WS_VT % 256 == 0, "align");

__device__ __forceinline__ int opaque_tid(int wave_s) { int v = wave_s * 64 + (int)__builtin_amdgcn_mbcnt_hi(~0u, __builtin_amdgcn_mbcnt_lo(~0u, 0u)); asm volatile("" : "+v"(v)); return v; }
typedef __bf16 bf16n2_t __attribute__((ext_vector_type(2)));
typedef float f32n2_t __attribute__((ext_vector_type(2)));
__device__ __forceinline__ unsigned pk2(float lo, float hi) { f32n2_t v; v[0] = lo; v[1] = hi; return __builtin_bit_cast(unsigned, __builtin_convertvector(v, bf16n2_t)); }
__device__ __forceinline__ unsigned f2bf(float f) { return (unsigned)__builtin_bit_cast(unsigned short, (__bf16)f); }
__device__ __forceinline__ float bf_lo(unsigned u) { return __builtin_bit_cast(float, u << 16); }
__device__ __forceinline__ float bf_hi(unsigned u) { return __builtin_bit_cast(float, u & 0xffff0000u); }
__device__ __forceinline__ float bf2f(bf16 h) { return __builtin_bit_cast(float, (unsigned)h << 16); }


#define XB_TMO      128
#define XB_XCNT(j)  (256  + 64 * (j))
#define XB_XSUB(j)  (1280 + 64 * (j))
#define XB_XGEN(j)  (2304 + 64 * (j))
#define XB_TOP      3328
#define XB_TOPGEN   3392
#define XCD_BAR_WORDS 3456
#define XB_SPIN_CAP (1u << 22)
__device__ __forceinline__ unsigned xb_ld(unsigned* p)              { return __hip_atomic_load(p, __ATOMIC_RELAXED, __HIP_MEMORY_SCOPE_AGENT); }
__device__ __forceinline__ unsigned xb_add(unsigned* p, unsigned v) { return __hip_atomic_fetch_add(p, v, __ATOMIC_RELAXED, __HIP_MEMORY_SCOPE_AGENT); }
__device__ __forceinline__ unsigned xb_xcc_id() { return (unsigned)__builtin_amdgcn_s_getreg((3 << 11) | 20) & 0xFu; }
#define XB_SPIN(cond, bar) do { unsigned _sp = 0; while (cond) { __builtin_amdgcn_s_sleep(1); \
    if ((++_sp & 255u) == 0u) { if (xb_ld(&(bar)[XB_TMO])) break; if (_sp > XB_SPIN_CAP) { atomicAdd(&(bar)[XB_TMO], 1u); break; } } } } while (0)
struct XcdBarrier { unsigned* bar; unsigned x; volatile LAS unsigned* st; };
__device__ __forceinline__ XcdBarrier xcd_barrier_post(unsigned* bar, volatile LAS unsigned* st) {
    XcdBarrier b; b.bar = bar; b.x = xb_xcc_id(); b.st = st;
    if (threadIdx.x == 0) (void)xb_add(&bar[XB_XCNT(b.x)], 1u);
    return b;
}
__device__ __forceinline__ void xcd_barrier_complete(unsigned* bar, unsigned x, unsigned& nloc, unsigned& nx) {
    const unsigned G = gridDim.x * gridDim.y * gridDim.z;
    unsigned sum, cnt, mine, sp = 0u;
    for (;;) {
        sum = 0u; cnt = 0u; mine = 0u;
#pragma unroll
        for (unsigned j = 0; j < 16; ++j) { const unsigned c = xb_ld(&bar[XB_XCNT(j)]); sum += c; cnt += (c > 0u) ? 1u : 0u; mine = (j == x) ? c : mine; }
        if (sum == G) break;
        __builtin_amdgcn_s_sleep(1);
        if ((++sp & 255u) == 0u) { if (xb_ld(&bar[XB_TMO])) break; if (sp > XB_SPIN_CAP) { atomicAdd(&bar[XB_TMO], 1u); break; } }
    }
    nloc = mine > 0u ? mine : 1u; nx = cnt > 0u ? cnt : 1u;
}
__device__ __forceinline__ void flag_arrive(unsigned* cnt) {
    asm volatile("s_waitcnt vmcnt(0)" ::: "memory");
    __syncthreads();
    if (threadIdx.x == 0) { __builtin_amdgcn_fence(__ATOMIC_RELEASE, "agent"); asm volatile("s_waitcnt vmcnt(0)" ::: "memory"); (void)xb_add(cnt, 1u); }
}
__device__ __forceinline__ void flag_wait(unsigned* cnt, unsigned* bar) {
    asm volatile("s_waitcnt vmcnt(0)" ::: "memory");
    __syncthreads();
    if (threadIdx.x == 0) {
        const unsigned G = gridDim.x * gridDim.y * gridDim.z;
        XB_SPIN(xb_ld(cnt) < G, bar);
        __builtin_amdgcn_fence(__ATOMIC_ACQUIRE, "agent");
        asm volatile("s_waitcnt vmcnt(0)" ::: "memory");
    }
    __syncthreads();
}
__device__ __forceinline__ void xcd_barrier(const XcdBarrier& b) {
    asm volatile("s_waitcnt vmcnt(0)" ::: "memory");
    __syncthreads();
    if (threadIdx.x == 0) {
        unsigned* bar = b.bar;
        __builtin_amdgcn_s_waitcnt(0);
        unsigned nloc = b.st[0], nx = b.st[1];
        if (nloc == 0u) { xcd_barrier_complete(bar, b.x, nloc, nx); b.st[0] = nloc; b.st[1] = nx; }
        const unsigned old = xb_add(&bar[XB_XSUB(b.x)], 1u);
        const unsigned gen = old / nloc;
        if (old + 1u == (gen + 1u) * nloc) {
            __builtin_amdgcn_fence(__ATOMIC_RELEASE, "agent");
            asm volatile("s_waitcnt vmcnt(0)" ::: "memory");
            const unsigned og = xb_add(&bar[XB_TOP], 1u);
            const unsigned tg = og / nx;
            if (og + 1u == (tg + 1u) * nx) xb_add(&bar[XB_TOPGEN], 1u);
            else XB_SPIN(xb_ld(&bar[XB_TOPGEN]) == tg, bar);
            __builtin_amdgcn_fence(__ATOMIC_ACQUIRE, "agent");
            xb_add(&bar[XB_XGEN(b.x)], 1u);
            asm volatile("s_waitcnt vmcnt(0)" ::: "memory");
        } else {
            XB_SPIN(xb_ld(&bar[XB_XGEN(b.x)]) == gen, bar);
            __builtin_amdgcn_fence(__ATOMIC_ACQUIRE, "agent");
            asm volatile("s_waitcnt vmcnt(0)" ::: "memory");
        }
    }
    __syncthreads();
}

namespace pg8 {
#define PG8_LAS __attribute__((address_space(3)))
typedef unsigned short bf16_t;
typedef short bf16x8 __attribute__((ext_vector_type(8)));
typedef float f32x4 __attribute__((ext_vector_type(4)));
typedef unsigned u32x4 __attribute__((ext_vector_type(4)));
constexpr int BM = 256, BK = 64, HALF = 128, HTB = HALF * BK * 2, STAGE_BYTES = 8 * HTB, NXCD = 8, WGM = 8;
__host__ __device__ __forceinline__ int lds_byte(int r, int c) { const int st = (r >> 4) * 2 + (c >> 5), rr = r & 15, cc = c & 31, ob = rr * 64 + cc * 2; return st * 1024 + (ob ^ (((ob >> 9) & 1) << 5)); }
__host__ __device__ __forceinline__ void stage_rc(int b, int& R, int& C) { const int st = b / 1024, sb = b % 1024, swz = sb ^ (((sb >> 9) & 1) << 5); R = (st >> 1) * 16 + swz / 64; C = (st & 1) * 32 + (swz % 64) / 2; }
__host__ __device__ __forceinline__ int perm32(int rho) { const int n = rho >> 4, i = rho & 15; return 8 * (i >> 2) + 4 * n + (i & 3); }
struct Unit { int pm, pn; };
struct Gemm { const bf16_t* A; const bf16_t* Bt; int M, N, K; };
struct StaticOrder {
    int nM, nN, nwg, G, c;
    __host__ __device__ __forceinline__ void init(int M, int N, int G_, int c_) { nM = M / BM; nN = N / BM; nwg = nM * nN; G = G_; c = c_; }
    __host__ __device__ bool next(int i, Unit& u) const {
        const long L = (long)i * G + c; if (L >= nwg) return false;
        int wgid = (int)L; { const int q = nwg / NXCD, r = nwg % NXCD, xcd = wgid % NXCD, off = wgid / NXCD; wgid = (xcd < r ? xcd * (q + 1) : r * (q + 1) + (xcd - r) * q) + off; }
        const int nig = WGM * nN, gid = wgid / nig, fm = gid * WGM, gsz = (nM - fm) < WGM ? (nM - fm) : WGM;
        u.pm = fm + ((wgid % nig) % gsz); u.pn = (wgid % nig) / gsz; return true;
    }
    __device__ __forceinline__ void a_ready(const Unit&) const {}
    __device__ __forceinline__ void done(const Unit&) const {}
};
__device__ __forceinline__ unsigned cvt_pk_bf16(float lo, float hi) { unsigned r; asm volatile("v_cvt_pk_bf16_f32 %0, %1, %2" : "=v"(r) : "v"(lo), "v"(hi)); return r; }

struct EpiF32R {
    static constexpr bool PERM = false, AFTER_DRAIN = false;
    float* C; const float* R; int ldc;
    __device__ __forceinline__ void operator()(const f32x4 (&acc)[2][2][4][2], const Unit& u, int wr, int wc, int fr, int fq) const {
        const int row0 = u.pm * BM + wr * 64 + fr, col0 = u.pn * BM + wc * 32 + 4 * fq;
#pragma unroll
        for (int ai = 0; ai < 2; ++ai)
#pragma unroll
            for (int m = 0; m < 4; ++m) {
                const size_t ro = (size_t)(row0 + ai * HALF + m * 16) * ldc + col0;
                f32x4 rv[2][2];
#pragma unroll
                for (int bj = 0; bj < 2; ++bj)
#pragma unroll
                    for (int n = 0; n < 2; ++n) rv[bj][n] = R ? *(const f32x4*)(R + ro + bj * HALF + n * 16) : (f32x4){0.f, 0.f, 0.f, 0.f};
#pragma unroll
                for (int bj = 0; bj < 2; ++bj)
#pragma unroll
                    for (int n = 0; n < 2; ++n) *(f32x4*)(C + ro + bj * HALF + n * 16) = acc[ai][bj][m][n] + rv[bj][n];
                __builtin_amdgcn_sched_barrier(0);
            }
    }
};

struct EpiBf16 {
    static constexpr bool PERM = true, AFTER_DRAIN = false;
    bf16_t* O; int ldc;
    __device__ __forceinline__ void operator()(const f32x4 (&acc)[2][2][4][2], const Unit& u, int wr, int wc, int fr, int fq) const {
        const int row0 = u.pm * BM + wr * 64 + fr, col0 = u.pn * BM + wc * 32 + 8 * fq;
#pragma unroll
        for (int ai = 0; ai < 2; ++ai)
#pragma unroll
            for (int m = 0; m < 4; ++m) { bf16_t* rowp = O + (size_t)(row0 + ai * HALF + m * 16) * ldc + col0;
#pragma unroll
                for (int bj = 0; bj < 2; ++bj) { const f32x4 v0 = acc[ai][bj][m][0], v1 = acc[ai][bj][m][1];
                    u32x4 w; w.x = cvt_pk_bf16(v0[0], v0[1]); w.y = cvt_pk_bf16(v0[2], v0[3]); w.z = cvt_pk_bf16(v1[0], v1[1]); w.w = cvt_pk_bf16(v1[2], v1[3]);
                    *(u32x4*)(rowp + bj * HALF) = w; } }
    }
};

struct EpiF32RN {
    static constexpr bool PERM = false, AFTER_DRAIN = false;
    float* C; const float* R; int ldc; bf16_t* XG; const float* g; float* st;
    __device__ __forceinline__ void operator()(const f32x4 (&acc)[2][2][4][2], const Unit& u, int wr, int wc, int fr, int fq) const {
        const int row0 = u.pm * BM + wr * 64 + fr, col0 = u.pn * BM + wc * 32 + 4 * fq;
        f32x4 gv[2][2];
#pragma unroll
        for (int bj = 0; bj < 2; ++bj)
#pragma unroll
            for (int n = 0; n < 2; ++n) gv[bj][n] = *(const f32x4*)(g + col0 + bj * HALF + n * 16);
#pragma unroll
        for (int ai = 0; ai < 2; ++ai)
#pragma unroll
            for (int m = 0; m < 4; ++m) {
                const int row = row0 + ai * HALF + m * 16;
                const size_t ro = (size_t)row * ldc + col0;
                f32x4 rv[2][2];
#pragma unroll
                for (int bj = 0; bj < 2; ++bj)
#pragma unroll
                    for (int n = 0; n < 2; ++n) rv[bj][n] = *(const f32x4*)(R + ro + bj * HALF + n * 16);
                float ss = 0.f;
#pragma unroll
                for (int bj = 0; bj < 2; ++bj)
#pragma unroll
                    for (int n = 0; n < 2; ++n) {
                        const f32x4 v = acc[ai][bj][m][n] + rv[bj][n];
                        *(f32x4*)(C + ro + bj * HALF + n * 16) = v;
                        ss += (v[0] * v[0] + v[1] * v[1]) + (v[2] * v[2] + v[3] * v[3]);
                        const f32x4 w = v * gv[bj][n];
                        uint2 pk; pk.x = cvt_pk_bf16(w[0], w[1]); pk.y = cvt_pk_bf16(w[2], w[3]);
                        *(uint2*)(XG + ro + bj * HALF + n * 16) = pk;
                    }
                ss += __shfl_xor(ss, 16, 64); ss += __shfl_xor(ss, 32, 64);
                if (fq == 0) st[(size_t)row * 16 + u.pn * 4 + wc] = ss;
                __builtin_amdgcn_sched_barrier(0);
            }
    }
};
struct EpiBf16S {
    static constexpr bool PERM = true, AFTER_DRAIN = false;
    bf16_t* O; int ldc; const float* st;
    __device__ __forceinline__ void operator()(const f32x4 (&acc)[2][2][4][2], const Unit& u, int wr, int wc, int fr, int fq) const {
        const int row0 = u.pm * BM + wr * 64 + fr, col0 = u.pn * BM + wc * 32 + 8 * fq;
#pragma unroll
        for (int ai = 0; ai < 2; ++ai)
#pragma unroll
            for (int m = 0; m < 4; ++m) {
                const int row = row0 + ai * HALF + m * 16;
                const f32x4* sp = (const f32x4*)(st + (size_t)row * 16);
                const f32x4 s0 = sp[0], s1 = sp[1], s2 = sp[2], s3 = sp[3];
                const f32x4 sa = (s0 + s1) + (s2 + s3);
                const float rs = __builtin_amdgcn_rsqf(((sa[0] + sa[1]) + (sa[2] + sa[3])) * (1.0f / 1024.f) + 1e-6f);
                bf16_t* rowp = O + (size_t)row * ldc + col0;
#pragma unroll
                for (int bj = 0; bj < 2; ++bj) { const f32x4 v0 = acc[ai][bj][m][0] * rs, v1 = acc[ai][bj][m][1] * rs;
                    u32x4 w; w.x = cvt_pk_bf16(v0[0], v0[1]); w.y = cvt_pk_bf16(v0[2], v0[3]); w.z = cvt_pk_bf16(v1[0], v1[1]); w.w = cvt_pk_bf16(v1[2], v1[3]);
                    *(u32x4*)(rowp + bj * HALF) = w; }
                __builtin_amdgcn_sched_barrier(0);
            }
    }
};

template <class Epi, class Sched, bool ALIGN_EPI = false, bool SP2 = false>
__device__ __forceinline__ void gemm_phase(const int wave_s, PG8_LAS unsigned char* lds, const Gemm g, const Sched& S, const Epi& E) {
    const int tid = opaque_tid(wave_s), wid = __builtin_amdgcn_readfirstlane(tid >> 6), lane = tid & 63, wr = wid >> 2, wc = wid & 3, fr = lane & 15, fq = lane >> 4;
    const int K = g.K, nt = K / BK;
    unsigned voffA[2], voffB[2];
#pragma unroll
    for (int i = 0; i < 2; ++i) { int R, C; stage_rc(tid * 16 + i * 8192, R, C); const int Rb = Epi::PERM ? ((R & ~31) + perm32(R & 31)) : R;
        voffA[i] = (unsigned)(R * K + C) * 2u; voffB[i] = (unsigned)(Rb * K + C) * 2u; }
    const size_t kstep = (size_t)(BK * 2);
    const size_t hstep = (size_t)HALF * K * 2;
    const size_t tstep = 2 * hstep;
    const unsigned ldsw = (unsigned)wid * 1024u;
    const int aoff = lds_byte(wr * 64 + fr, fq * 8), boff = lds_byte(wc * 32 + fr, fq * 8);
#define PG8_SA(b, h) (((b) * 2 + (h)) * HTB)
#define PG8_SB(b, h) ((4 + (b) * 2 + (h)) * HTB)
#define PG8_STAGE(bufoff, gbase, voff) do { _Pragma("unroll") for (int _i = 0; _i < 2; ++_i) \
        __builtin_amdgcn_global_load_lds((const unsigned*)((const char*)(gbase) + (voff)[_i]), (PG8_LAS unsigned*)(lds + (bufoff) + ldsw + _i * 8192), 16, 0, 0); } while (0)
#define PG8_LDA(dst, b, h) do { _Pragma("unroll") for (int m = 0; m < 4; ++m) _Pragma("unroll") for (int k = 0; k < 2; ++k) dst[m][k] = *(const PG8_LAS bf16x8*)(lds + PG8_SA(b, h) + aoff + m * 2048 + k * 1024); } while (0)
#define PG8_LDB(dst, b, h) do { _Pragma("unroll") for (int n = 0; n < 2; ++n) _Pragma("unroll") for (int k = 0; k < 2; ++k) dst[n][k] = *(const PG8_LAS bf16x8*)(lds + PG8_SB(b, h) + boff + n * 2048 + k * 1024); } while (0)
#define PG8_MMA(ai, bj, At, Bt) do { __builtin_amdgcn_s_setprio(1); _Pragma("unroll") for (int m = 0; m < 4; ++m) _Pragma("unroll") for (int n = 0; n < 2; ++n) _Pragma("unroll") for (int k = 0; k < 2; ++k) \
        acc[ai][bj][m][n] = __builtin_amdgcn_mfma_f32_16x16x32_bf16(Bt[n][k], At[m][k], acc[ai][bj][m][n], 0, 0, 0); __builtin_amdgcn_s_setprio(0); } while (0)
#define PG8_WAIT_V(n) asm volatile("s_waitcnt vmcnt(" #n ")" ::: "memory")
#define PG8_WAIT_L(n) asm volatile("s_waitcnt lgkmcnt(" #n ")" ::: "memory")
#define PG8_BAR __builtin_amdgcn_s_barrier()
#define PG8_SCHED __builtin_amdgcn_sched_barrier(0)
    Unit cur, nxt; int ui = 0;
    if (!S.next(0, cur)) return;
    f32x4 acc[2][2][4][2];
#pragma unroll
    for (int a = 0; a < 2; ++a)
#pragma unroll
        for (int b = 0; b < 2; ++b)
#pragma unroll
            for (int m = 0; m < 4; ++m)
#pragma unroll
                for (int n = 0; n < 2; ++n) acc[a][b][m][n] = (f32x4){0.f, 0.f, 0.f, 0.f};
    bf16x8 At[4][2], B0[2][2], B1[2][2];
    const char* cA = (const char*)g.A + (size_t)cur.pm * tstep; const char* cB = (const char*)g.Bt + (size_t)cur.pn * tstep;
    S.a_ready(cur);
    if constexpr (SP2) {
        PG8_STAGE(PG8_SB(0, 0), cB, voffB); PG8_STAGE(PG8_SB(0, 1), cB + hstep, voffB); PG8_STAGE(PG8_SA(0, 0), cA, voffA); PG8_STAGE(PG8_SA(0, 1), cA + hstep, voffA);
        if (wr == 1) PG8_BAR;
        PG8_WAIT_V(2); PG8_BAR;
        PG8_STAGE(PG8_SB(1, 0), cB + kstep, voffB); PG8_STAGE(PG8_SA(1, 0), cA + kstep, voffA); PG8_STAGE(PG8_SB(1, 1), cB + hstep + kstep, voffB);
        PG8_WAIT_V(6); PG8_BAR;
    } else {
        PG8_STAGE(PG8_SB(0, 0), cB, voffB); PG8_STAGE(PG8_SA(0, 0), cA, voffA); PG8_STAGE(PG8_SB(0, 1), cB + hstep, voffB); PG8_STAGE(PG8_SA(0, 1), cA + hstep, voffA);
        if (wr == 1) PG8_BAR;
        PG8_WAIT_V(4); PG8_BAR;
        PG8_STAGE(PG8_SB(1, 0), cB + kstep, voffB); PG8_STAGE(PG8_SA(1, 0), cA + kstep, voffA); PG8_STAGE(PG8_SB(1, 1), cB + hstep + kstep, voffB);
        PG8_WAIT_V(6); PG8_BAR;
    }
    for (;;) {
        const bool has_next = S.next(ui + 1, nxt);
        const char* nA = has_next ? (const char*)g.A + (size_t)nxt.pm * tstep : cA; const char* nB = has_next ? (const char*)g.Bt + (size_t)nxt.pn * tstep : cB;
        for (int t = 0; t < nt; t += 2) {
            const bool last = (t == nt - 2);
            const char* a1 = cA + (size_t)(t + 1) * kstep;
            const char* a2 = last ? nA : cA + (size_t)(t + 2) * kstep; const char* b2 = last ? nB : cB + (size_t)(t + 2) * kstep;
            const char* a3 = a2 + kstep; const char* b3 = b2 + kstep;
            if (last && has_next) S.a_ready(nxt);
            if constexpr (SP2) {
            PG8_LDB(B0, 0, 0); PG8_LDB(B1, 0, 1); PG8_SCHED; PG8_LDA(At, 0, 0); PG8_STAGE(PG8_SA(1, 1), a1 + hstep, voffA);
            PG8_WAIT_V(8); PG8_WAIT_L(0); PG8_BAR; PG8_MMA(0, 0, At, B0); PG8_MMA(0, 1, At, B1); PG8_BAR; PG8_SCHED;
            PG8_LDA(At, 0, 1); PG8_STAGE(PG8_SB(0, 0), b2, voffB); PG8_STAGE(PG8_SB(0, 1), b2 + hstep, voffB); PG8_STAGE(PG8_SA(0, 0), a2, voffA);
            PG8_WAIT_V(8); PG8_WAIT_L(0); PG8_BAR; PG8_MMA(1, 0, At, B0); PG8_MMA(1, 1, At, B1); PG8_BAR; PG8_SCHED;
            PG8_LDB(B0, 1, 0); PG8_LDB(B1, 1, 1); PG8_SCHED; PG8_LDA(At, 1, 0); PG8_STAGE(PG8_SA(0, 1), a2 + hstep, voffA);
            PG8_WAIT_V(8); PG8_WAIT_L(0); PG8_BAR; PG8_MMA(0, 0, At, B0); PG8_MMA(0, 1, At, B1); PG8_BAR; PG8_SCHED;
            PG8_LDA(At, 1, 1); PG8_STAGE(PG8_SB(1, 0), b3, voffB); PG8_STAGE(PG8_SB(1, 1), b3 + hstep, voffB); PG8_STAGE(PG8_SA(1, 0), a3, voffA);
            PG8_WAIT_V(8); PG8_WAIT_L(0); PG8_BAR; PG8_MMA(1, 0, At, B0); PG8_MMA(1, 1, At, B1); PG8_BAR; PG8_SCHED;
            } else {
            PG8_LDB(B0, 0, 0); PG8_SCHED; PG8_LDA(At, 0, 0); PG8_STAGE(PG8_SA(1, 1), a1 + hstep, voffA);
            PG8_WAIT_L(8); PG8_BAR; PG8_WAIT_L(0); PG8_MMA(0, 0, At, B0); PG8_BAR; PG8_SCHED;
            PG8_LDB(B1, 0, 1); PG8_STAGE(PG8_SB(0, 0), b2, voffB);
            PG8_BAR; PG8_WAIT_L(0); PG8_MMA(0, 1, At, B1); PG8_BAR;
            PG8_LDA(At, 0, 1); PG8_STAGE(PG8_SA(0, 0), a2, voffA);
            PG8_BAR; PG8_WAIT_L(0); PG8_MMA(1, 0, At, B0); PG8_BAR; PG8_SCHED;
            PG8_STAGE(PG8_SB(0, 1), b2 + hstep, voffB);
            PG8_WAIT_V(6); PG8_BAR; PG8_MMA(1, 1, At, B1); PG8_BAR;
            PG8_LDB(B0, 1, 0); PG8_SCHED; PG8_LDA(At, 1, 0); PG8_STAGE(PG8_SA(0, 1), a2 + hstep, voffA);
            PG8_WAIT_L(8); PG8_BAR; PG8_WAIT_L(0); PG8_MMA(0, 0, At, B0); PG8_BAR; PG8_SCHED;
            PG8_LDB(B1, 1, 1); PG8_STAGE(PG8_SB(1, 0), b3, voffB);
            PG8_BAR; PG8_WAIT_L(0); PG8_MMA(0, 1, At, B1); PG8_BAR;
            PG8_LDA(At, 1, 1); PG8_STAGE(PG8_SA(1, 0), a3, voffA);
            PG8_BAR; PG8_WAIT_L(0); PG8_MMA(1, 0, At, B0); PG8_BAR; PG8_SCHED;
            PG8_STAGE(PG8_SB(1, 1), b3 + hstep, voffB);
            PG8_WAIT_V(6); PG8_BAR; PG8_MMA(1, 1, At, B1); PG8_BAR;
            }
        }
        if constexpr (ALIGN_EPI) { if (wr == 0) PG8_BAR; }
        if constexpr (!Epi::AFTER_DRAIN) { E(acc, cur, wr, wc, fr, fq); S.done(cur); }
        if (!has_next) break;
#pragma unroll
        for (int a = 0; a < 2; ++a)
#pragma unroll
            for (int b = 0; b < 2; ++b)
#pragma unroll
                for (int m = 0; m < 4; ++m)
#pragma unroll
                    for (int n = 0; n < 2; ++n) acc[a][b][m][n] = (f32x4){0.f, 0.f, 0.f, 0.f};
        cur = nxt; cA = nA; cB = nB; ++ui;
        if constexpr (ALIGN_EPI) { if (wr == 1) PG8_BAR; }
    }
    PG8_WAIT_V(0);
    if constexpr (!ALIGN_EPI) { if (wr == 0) PG8_BAR; }
    PG8_BAR;
#undef PG8_SA
#undef PG8_SB
#undef PG8_STAGE
#undef PG8_LDA
#undef PG8_LDB
#undef PG8_MMA
#undef PG8_WAIT_V
#undef PG8_WAIT_L
#undef PG8_BAR
#undef PG8_SCHED
}
}

__device__ __forceinline__ void transpose_item(const float* W, int K, int N, bf16* WT, LAS float* scr, int item, int lane) {
    const int nblk = N / 32, kb = item / nblk, nb = item % nblk, k0 = 64 * kb, n0 = 32 * nb;
#pragma unroll 8
    for (int i = 0; i < 32; ++i) { const int kk = 2 * i + (lane >> 5); scr[kk * 33 + (lane & 31)] = W[(size_t)(k0 + kk) * N + n0 + (lane & 31)]; }
    asm volatile("s_waitcnt lgkmcnt(0)" ::: "memory");
    const int c = lane & 7;
#pragma unroll
    for (int j = 0; j < 4; ++j) { const int n = (lane >> 3) + 8 * j; const LAS float* s = scr + (8 * c) * 33 + n;
        uint4 o; o.x = pk2(s[0 * 33], s[1 * 33]); o.y = pk2(s[2 * 33], s[3 * 33]); o.z = pk2(s[4 * 33], s[5 * 33]); o.w = pk2(s[6 * 33], s[7 * 33]);
        *(uint4*)(WT + (size_t)(n0 + n) * K + k0 + 8 * c) = o; }
    asm volatile("s_waitcnt lgkmcnt(0)" ::: "memory");
}

__device__ __forceinline__ float wsum(float v) {
#pragma unroll
  for (int o = 32; o > 0; o >>= 1) v += __shfl_xor(v, o, 64);
  return v;
}
__device__ __forceinline__ float wmaxf(float v) {
#pragma unroll
  for (int o = 32; o > 0; o >>= 1) v = fmaxf(v, __shfl_xor(v, o, 64));
  return v;
}
__device__ __forceinline__ float sigmoidf_(float x) { return __builtin_amdgcn_rcpf(1.0f + __expf(-x)); }
__device__ __forceinline__ float gelu_tanh(float x) {
  return x * sigmoidf_(1.5957691216057308f * (x + 0.044715f * x * x * x));
}

template <bool BF16OUT>
__device__ __forceinline__ void rms_rows(const int wave_s, const float* src, const float* g, void* dstv, int rows) {
  const int tid_ = opaque_tid(wave_s);
  const int lane = tid_ & 63;
  const int gw = blockIdx.x * NWAVES + (tid_ >> 6);
  const int nw = gridDim.x * NWAVES;
  for (int r = gw; r < rows; r += nw) {
    const float4* s4 = (const float4*)(src + (size_t)r * DM);
    float4 v[4];
    float ss = 0.f;
#pragma unroll
    for (int i = 0; i < 4; i++) {
      v[i] = s4[lane + i * 64];
      ss += v[i].x * v[i].x + v[i].y * v[i].y + v[i].z * v[i].z + v[i].w * v[i].w;
    }
    ss = wsum(ss);
    const float rstd = rsqrtf(ss * (1.0f / DM) + EPSF);
    const float4* g4 = (const float4*)g;
#pragma unroll
    for (int i = 0; i < 4; i++) {
      float4 gg = g4[lane + i * 64];
      float4 o;
      o.x = v[i].x * rstd * gg.x; o.y = v[i].y * rstd * gg.y;
      o.z = v[i].z * rstd * gg.z; o.w = v[i].w * rstd * gg.w;
      if (BF16OUT) {
        uint2 pk; pk.x = pk2(o.x, o.y); pk.y = pk2(o.z, o.w);
        ((uint2*)((bf16*)dstv + (size_t)r * DM))[lane + i * 64] = pk;
      } else {
        ((float4*)((float*)dstv + (size_t)r * DM))[lane + i * 64] = o;
      }
    }
  }
}

__device__ __forceinline__ void ssm_params(const int wave_s, const Params& p, float* ssmp_all) {
  const int tid_ = opaque_tid(wave_s);
  const float* in8 = karg_in(8); const float* in9 = karg_in(9); const float* in10 = karg_in(10);
  const float* in11 = karg_in(11); const float* in12 = karg_in(12);
  const int gt = blockIdx.x * blockDim.x + tid_;
  const int nth = gridDim.x * blockDim.x;
  for (int i = gt; i < 2 * 16 * 64; i += nth) {
    const int l = i / 1024, gp = i % 1024, g = gp / 64;
    float* sp = ssmp_all + (size_t)l * SSMP_PER_LAYER;
    const float lre = fminf(in8[l * 1024 + gp], -1e-4f);
    const float lim = in9[l * 1024 + gp];
    const float dt = expf(in10[l * 16 + g]);
    const float er = expf(lre * dt);
    float sn, cs;
    sincosf(lim * dt, &sn, &cs);
    const float br = er * cs, bi = er * sn;
    sp[gp * 2 + 0] = br;
    sp[gp * 2 + 1] = bi;
    float cr = br, ci = bi;
#pragma unroll
    for (int s = 0; s < 6; s++) {
      const float nr = cr * cr - ci * ci, ni = 2.f * cr * ci;
      cr = nr; ci = ni;
    }
    sp[2048 + gp * 2 + 0] = cr;
    sp[2048 + gp * 2 + 1] = ci;
    const float nr = br - 1.0f, ni = bi;
    const float den = lre * lre + lim * lim;
    const float fr = (nr * lre + ni * lim) / den;
    const float fi = (ni * lre - nr * lim) / den;
    for (int h = 0; h < 16; h++) {
      const float bre = in11[((size_t)l * 1024 + gp) * 16 + h];
      const float bim = in12[((size_t)l * 1024 + gp) * 16 + h];
      sp[4096 + ((g * 16 + h) * 64 + (gp & 63)) * 2 + 0] = fr * bre - fi * bim;
      sp[4096 + ((g * 16 + h) * 64 + (gp & 63)) * 2 + 1] = fr * bim + fi * bre;
    }
  }
}

__device__ __forceinline__ void conv_phase(const int wave_s, const Params& p, int l, const bf16* proj, bf16* y, LAS float* smem) {
  const int tid_ = opaque_tid(wave_s);
  const int lane = tid_ & 63;
  const int gw = blockIdx.x * NWAVES + (tid_ >> 6);
  const int nw = gridDim.x * NWAVES;
  const float* cw = karg_in(4) + (size_t)l * 31 * 256;
  const float4 cb = ((const float4*)(karg_in(5) + l * 256))[lane];
  const float4 lg = ((const float4*)(karg_in(6) + l * 256))[lane];
  const float4 lb = ((const float4*)(karg_in(7) + l * 256))[lane];
  const float4 gg = ((const float4*)(karg_in(18) + l * 1024))[lane];
  LAS float* cwl = smem + 1024;
  for (int i = tid_; i < 31 * 256 / 4; i += NWAVES * 64) *(LAS pg8::f32x4*)(cwl + 4 * i) = *(const pg8::f32x4*)(cw + 4 * i);
  __syncthreads();
  for (int it = gw; it < NT / 8; it += nw) {
    const int tok0 = it * 8;
    const int t0 = tok0 & (SEQ - 1);
    float4 acc[8];
#pragma unroll
    for (int o = 0; o < 8; o++) acc[o] = cb;
#pragma unroll
    for (int i = 0; i < 38; i++) {
      if (t0 - 30 + i >= 0) {
        const bf16* row = proj + (size_t)(tok0 - 30 + i) * DIN;
        const uint2 vp = ((const uint2*)row)[lane];
        const uint2 gp = ((const uint2*)(row + 256))[lane];
        float4 g4;
        g4.x = bf_lo(vp.x) * sigmoidf_(bf_lo(gp.x)); g4.y = bf_hi(vp.x) * sigmoidf_(bf_hi(gp.x));
        g4.z = bf_lo(vp.y) * sigmoidf_(bf_lo(gp.y)); g4.w = bf_hi(vp.y) * sigmoidf_(bf_hi(gp.y));
#pragma unroll
        for (int o = 0; o < 8; o++) {
          const int j = i - o;
          if (j >= 0 && j <= 30) {
            const pg8::f32x4 w4 = *(const LAS pg8::f32x4*)(cwl + j * 256 + lane * 4);
            acc[o].x += g4.x * w4[0]; acc[o].y += g4.y * w4[1];
            acc[o].z += g4.z * w4[2]; acc[o].w += g4.w * w4[3];
          }
        }
      }
    }
#pragma unroll
    for (int o = 0; o < 8; o++) {
      const float4 a = acc[o];
      const float mean = wsum(a.x + a.y + a.z + a.w) * (1.0f / 256.f);
      const float dx = a.x - mean, dy = a.y - mean, dz = a.z - mean, dw = a.w - mean;
      const float var = wsum(dx * dx + dy * dy + dz * dz + dw * dw) * (1.0f / 256.f);
      const float rs = rsqrtf(var + EPSF);
      float4 s;
      s.x = dx * rs * lg.x + lb.x; s.y = dy * rs * lg.y + lb.y;
      s.z = dz * rs * lg.z + lb.z; s.w = dw * rs * lg.w + lb.w;
      s.x = s.x * sigmoidf_(s.x); s.y = s.y * sigmoidf_(s.y);
      s.z = s.z * sigmoidf_(s.z); s.w = s.w * sigmoidf_(s.w);
      const float ss = wsum(s.x * s.x + s.y * s.y + s.z * s.z + s.w * s.w) * (1.0f / 256.f);
      const float r2 = rsqrtf(ss + EPSF);
      uint2 pk; pk.x = pk2(s.x * r2 * gg.x, s.y * r2 * gg.y); pk.y = pk2(s.z * r2 * gg.z, s.w * r2 * gg.w);
      ((uint2*)(y + (size_t)(tok0 + o) * DM))[lane] = pk;
    }
  }
}

typedef short bf16x8_t __attribute__((ext_vector_type(8)));
typedef float f32x16_t __attribute__((ext_vector_type(16)));
#define MFMA_PAD() do { __builtin_amdgcn_sched_barrier(0); asm volatile("s_nop 15\n\ts_nop 15" ::: "memory"); __builtin_amdgcn_sched_barrier(0); } while (0)

__device__ __forceinline__ void attn_phase(const int wave_s, const Params& p, int l, const bf16* proj, bf16* y, LAS float* smem) {
  const int tid = opaque_tid(wave_s), lane = tid & 63, wave = tid >> 6;
  const int n = lane & 31, hh = lane >> 5;
  const float* gg = karg_in(18) + l * 1024 + 256 + wave * 64;
  const float g0 = gg[n], g1 = gg[32 + n];
  LAS float* ssq = smem;
  LAS float* rstd = smem + 256;
  for (int item = blockIdx.x; item < 4 * 128; item += gridDim.x) {
    const int b = item >> 7, q0 = (item & 127) * 32;
    const size_t tokb = (size_t)b * SEQ;
    bf16x8_t qf[4];
    {
      const bf16* qrow = proj + (tokb + q0 + n) * DIN + 512 + wave * 64 + 8 * hh;
#pragma unroll
      for (int ks = 0; ks < 4; ks++) qf[ks] = *(const bf16x8_t*)(qrow + 16 * ks);
    }
    f32x16_t o0, o1;
#pragma unroll
    for (int r = 0; r < 16; r++) { o0[r] = 0.f; o1[r] = 0.f; }
    float R = 0.f;
    for (int kt = q0; kt >= 0; kt -= 32) {
      bf16x8_t kf[4];
      {
        const bf16* krow = proj + (tokb + kt + n) * DIN + 1024 + wave * 64 + 8 * hh;
#pragma unroll
        for (int ks = 0; ks < 4; ks++) kf[ks] = *(const bf16x8_t*)(krow + 16 * ks);
      }
      bf16x8_t vf0[2], vf1[2];
      {
        const bf16* vb = proj + (tokb + kt + 4 * hh) * DIN + 1536 + wave * 64 + n;
#pragma unroll
        for (int s = 0; s < 2; s++)
#pragma unroll
          for (int j = 0; j < 8; j++) {
            const int key = 16 * s + 8 * (j >> 2) + (j & 3);
            vf0[s][j] = (short)vb[(size_t)key * DIN];
            vf1[s][j] = (short)vb[(size_t)key * DIN + 32];
          }
      }
      f32x16_t sacc;
#pragma unroll
      for (int r = 0; r < 16; r++) sacc[r] = 0.f;
      __builtin_amdgcn_sched_barrier(0); asm volatile("s_nop 15\n\ts_nop 15" ::: "memory"); __builtin_amdgcn_sched_barrier(0);
#pragma unroll
      for (int ks = 0; ks < 4; ks++) sacc = __builtin_amdgcn_mfma_f32_32x32x16_bf16(kf[ks], qf[ks], sacc, 0, 0, 0);
      __builtin_amdgcn_sched_barrier(0); asm volatile("s_nop 15\n\ts_nop 15" ::: "memory"); __builtin_amdgcn_sched_barrier(0);
      float lst[16], lsz[16];
      const bool diag = (kt == q0);
#pragma unroll
      for (int r = 0; r < 16; r++) {
        const float z = sacc[r] * 0.125f;
        const float sp = __logf(1.0f + __expf(-fabsf(z)));
        float a = fminf(z, 0.f) - sp;
        float c = -(fmaxf(z, 0.f) + sp);
        if (diag) {
          const int key = (r & 3) + 8 * (r >> 2) + 4 * hh;
          if (key >= n) { a = -1.0e30f; c = 0.f; }
        }
        lsz[r] = a; lst[r] = c;
      }
      float Gs[4], Gp[4];
#pragma unroll
      for (int g = 0; g < 4; g++) {
        Gs[g] = (lst[4 * g] + lst[4 * g + 1]) + (lst[4 * g + 2] + lst[4 * g + 3]);
        Gp[g] = __shfl_xor(Gs[g], 32, 64);
      }
      float carry[4];
      {
        float after = R;
#pragma unroll
        for (int g = 3; g >= 0; g--) {
          carry[g] = after + (hh ? 0.f : Gp[g]);
          after += Gs[g] + Gp[g];
        }
        R = after;
      }
      bf16x8_t pf[2];
#pragma unroll
      for (int g = 0; g < 4; g++) {
        float run = carry[g];
        float a3 = __expf(lsz[4 * g + 3] + run); run += lst[4 * g + 3];
        float a2 = __expf(lsz[4 * g + 2] + run); run += lst[4 * g + 2];
        float a1 = __expf(lsz[4 * g + 1] + run); run += lst[4 * g + 1];
        float a0 = __expf(lsz[4 * g + 0] + run);
        const int s = g >> 1, jb = (g & 1) * 4;
        pf[s][jb + 0] = (short)f2bf(a0); pf[s][jb + 1] = (short)f2bf(a1);
        pf[s][jb + 2] = (short)f2bf(a2); pf[s][jb + 3] = (short)f2bf(a3);
      }
      __builtin_amdgcn_sched_barrier(0); asm volatile("s_nop 15\n\ts_nop 15" ::: "memory"); __builtin_amdgcn_sched_barrier(0);
#pragma unroll
      for (int s = 0; s < 2; s++) {
        o0 = __builtin_amdgcn_mfma_f32_32x32x16_bf16(pf[s], vf0[s], o0, 0, 0, 0);
        o1 = __builtin_amdgcn_mfma_f32_32x32x16_bf16(pf[s], vf1[s], o1, 0, 0, 0);
      }
      __builtin_amdgcn_sched_barrier(0); asm volatile("s_nop 15\n\ts_nop 15" ::: "memory"); __builtin_amdgcn_sched_barrier(0);
      if (__all(R < -110.f)) break;
    }
    float sq[16];
#pragma unroll
    for (int r = 0; r < 16; r++) {
      float v = o0[r] * o0[r] + o1[r] * o1[r];
#pragma unroll
      for (int o = 16; o > 0; o >>= 1) v += __shfl_xor(v, o, 64);
      sq[r] = v;
    }
    __syncthreads();
    if (n == 0) {
#pragma unroll
      for (int r = 0; r < 16; r++) ssq[wave * 32 + (r & 3) + 8 * (r >> 2) + 4 * hh] = sq[r];
    }
    __syncthreads();
    if (tid < 32) {
      float t = 0.f;
#pragma unroll
      for (int w = 0; w < 8; w++) t += ssq[w * 32 + tid];
      rstd[tid] = rsqrtf(t * (1.0f / 512.f) + EPSF);
    }
    __syncthreads();
#pragma unroll
    for (int r = 0; r < 16; r++) {
      const int qi = (r & 3) + 8 * (r >> 2) + 4 * hh;
      const float rs = rstd[qi];
      bf16* yr = y + (tokb + q0 + qi) * DM + 256 + wave * 64 + n;
      yr[0] = (bf16)f2bf(o0[r] * rs * g0);
      yr[32] = (bf16)f2bf(o1[r] * rs * g1);
    }
  }
}

#define SSM_BCAST_U(u, ua, ub, tt) do { \
    const unsigned w0 = (unsigned)__builtin_amdgcn_readlane((int)(ua).x, (tt)), w1 = (unsigned)__builtin_amdgcn_readlane((int)(ua).y, (tt)); \
    const unsigned w2 = (unsigned)__builtin_amdgcn_readlane((int)(ua).z, (tt)), w3 = (unsigned)__builtin_amdgcn_readlane((int)(ua).w, (tt)); \
    const unsigned w4 = (unsigned)__builtin_amdgcn_readlane((int)(ub).x, (tt)), w5 = (unsigned)__builtin_amdgcn_readlane((int)(ub).y, (tt)); \
    const unsigned w6 = (unsigned)__builtin_amdgcn_readlane((int)(ub).z, (tt)), w7 = (unsigned)__builtin_amdgcn_readlane((int)(ub).w, (tt)); \
    (u)[0] = bf_lo(w0); (u)[1] = bf_hi(w0); (u)[2] = bf_lo(w1); (u)[3] = bf_hi(w1); (u)[4] = bf_lo(w2); (u)[5] = bf_hi(w2); (u)[6] = bf_lo(w3); (u)[7] = bf_hi(w3); \
    (u)[8] = bf_lo(w4); (u)[9] = bf_hi(w4); (u)[10] = bf_lo(w5); (u)[11] = bf_hi(w5); (u)[12] = bf_lo(w6); (u)[13] = bf_hi(w6); (u)[14] = bf_lo(w7); (u)[15] = bf_hi(w7); } while (0)
#define SSM_RS 592
#define SSM_TILE_BASE 36864
#define SSM_TILE_BYTES (16 * SSM_RS)
typedef float f32x2_t __attribute__((ext_vector_type(2)));
__device__ __forceinline__ void ssm_load_bop(const float* ssmp, int g, int lane, bf16x8_t (&bop)[8]) {
  const int q = lane >> 4, n = lane & 15;
  float v[8][8];
#pragma unroll
  for (int j = 0; j < 8; j++) {
    const float4* rp = (const float4*)(ssmp + 4096 + (size_t)(g * 16 + ((8 * q + j) & 15)) * 128 + 8 * n);
    const float4 a = rp[0], b = rp[1];
    v[j][0] = a.x; v[j][1] = a.y; v[j][2] = a.z; v[j][3] = a.w; v[j][4] = b.x; v[j][5] = b.y; v[j][6] = b.z; v[j][7] = b.w;
  }
#pragma unroll
  for (int nt = 0; nt < 8; nt++) {
    pg8::u32x4 w;
    w.x = pk2(v[0][nt], v[1][nt]); w.y = pk2(v[2][nt], v[3][nt]); w.z = pk2(v[4][nt], v[5][nt]); w.w = pk2(v[6][nt], v[7][nt]);
    if (q >= 2) { w.x = 0u; w.y = 0u; w.z = 0u; w.w = 0u; }
    bop[nt] = __builtin_bit_cast(bf16x8_t, w);
  }
}
__device__ __forceinline__ void ssm_bu_block(LAS unsigned char* xt, int lane, int blk, const uint4& ua, const uint4& ub, const bf16x8_t (&bop)[8]) {
  const int q = lane >> 4, n = lane & 15;
  if (q == blk) {
    pg8::u32x4 w0, w1;
    w0.x = ua.x; w0.y = ua.y; w0.z = ua.z; w0.w = ua.w; w1.x = ub.x; w1.y = ub.y; w1.z = ub.z; w1.w = ub.w;
    LAS pg8::u32x4* ur = (LAS pg8::u32x4*)(xt + n * SSM_RS + 512);
    ur[0] = w0; ur[1] = w1;
  }
  __builtin_amdgcn_wave_barrier();
  const bf16x8_t uop = *(const LAS bf16x8_t*)(xt + n * SSM_RS + 512 + q * 16);
  pg8::f32x4 bacc[8];
#pragma unroll
  for (int nt = 0; nt < 8; nt++) {
    pg8::f32x4 z4; z4[0] = 0.f; z4[1] = 0.f; z4[2] = 0.f; z4[3] = 0.f;
    bacc[nt] = __builtin_amdgcn_mfma_f32_16x16x32_bf16(uop, bop[nt], z4, 0, 0, 0);
  }
#pragma unroll
  for (int j = 0; j < 4; j++) {
    pg8::f32x4 w0, w1;
    w0[0] = bacc[0][j]; w0[1] = bacc[1][j]; w0[2] = bacc[2][j]; w0[3] = bacc[3][j];
    w1[0] = bacc[4][j]; w1[1] = bacc[5][j]; w1[2] = bacc[6][j]; w1[3] = bacc[7][j];
    LAS pg8::f32x4* dr = (LAS pg8::f32x4*)(xt + (4 * q + j) * SSM_RS + 32 * n);
    dr[0] = w0; dr[1] = w1;
  }
  __builtin_amdgcn_wave_barrier();
}
__device__ __forceinline__ void ssm_zero_pad(LAS unsigned char* xt, int lane) {
  if (lane < 16) {
    pg8::u32x4 z4; z4.x = 0u; z4.y = 0u; z4.z = 0u; z4.w = 0u;
    LAS pg8::u32x4* zr = (LAS pg8::u32x4*)(xt + lane * SSM_RS + 544);
    zr[0] = z4; zr[1] = z4;
  }
}
__device__ __forceinline__ void ssm_chunk_end(const int wave_s, const float* ssmp, const bf16* proj, float* ssmE, LAS float* smem) {
  const int tid_ = opaque_tid(wave_s);
  const int lane = tid_ & 63;
  const int gw = blockIdx.x * NWAVES + (tid_ >> 6);
  const int nw = gridDim.x * NWAVES;
  for (int it = gw; it < 4 * 64 * 16; it += nw) {
    const int g = it & 15, c = (it >> 4) & 63, b = it >> 10;
    const int gp = g * 64 + lane;
    const uint4* up = (const uint4*)(proj + (size_t)(b * SEQ + c * 64 + lane) * DIN + 2048 + g * 16);
    const uint4 ua = up[0], ub = up[1];
    const float lbr = ssmp[gp * 2], lbi = ssmp[gp * 2 + 1];
    bf16x8_t bop[8];
    ssm_load_bop(ssmp, g, lane, bop);
    LAS unsigned char* xt = (LAS unsigned char*)smem + SSM_TILE_BASE + (tid_ >> 6) * SSM_TILE_BYTES;
    ssm_zero_pad(xt, lane);
    float xr = 0.f, xi = 0.f;
#pragma unroll 1
    for (int blk = 0; blk < 4; blk++) {
      ssm_bu_block(xt, lane, blk, ua, ub, bop);
#pragma unroll 4
      for (int tt = 0; tt < 16; tt++) {
        const f32x2_t bu = *(const LAS f32x2_t*)(xt + tt * SSM_RS + lane * 8);
        const float nr = lbr * xr - lbi * xi + bu[0];
        const float ni = lbr * xi + lbi * xr + bu[1];
        xr = nr; xi = ni;
      }
      __builtin_amdgcn_wave_barrier();
    }
    float* e = ssmE + ((size_t)((b * 64 + c) * 16 + g) * 64 + lane) * 2;
    e[0] = xr; e[1] = xi;
  }
}

__device__ __forceinline__ void ssm_finish(const int wave_s, const Params& p, int l, const float* ssmp, const bf16* proj,
                           const float* ssmE, bf16* y, LAS float* smem) {
  LAS bf16* Ytb = (LAS bf16*)smem;
  LAS float* ssq2 = smem + (64 * 264 * 2) / 4;
  LAS float* rstd2 = ssq2 + 512;
  const bf16* glT = (const bf16*)(p.ws + WS_WT + (size_t)l * WT_LAYER + WT_GLU);
  const int tid = opaque_tid(wave_s), lane = tid & 63, wave = tid >> 6;
  const float* cre = karg_in(13) + (size_t)l * 16 * 16 * 64;
  const float* cim = karg_in(14) + (size_t)l * 16 * 16 * 64;
  const float* dsk = karg_in(15) + l * 256;
  const float* glw = karg_in(16) + (size_t)l * 256 * 256;
  const float* glb = karg_in(17) + l * 256;
  const float* gg = karg_in(18) + l * 1024 + 768;
  for (int it = blockIdx.x; it < 256; it += gridDim.x) {
    const int b = it >> 6, c = it & 63;
    __syncthreads();
    for (int gi = 0; gi < 2; gi++) {
      const int g = wave + gi * 8;
      const int gp = g * 64 + lane;
      const float lbr = ssmp[gp * 2], lbi = ssmp[gp * 2 + 1];
      const float lcr = ssmp[2048 + gp * 2], lci = ssmp[2048 + gp * 2 + 1];
      bf16x8_t bop[8];
      ssm_load_bop(ssmp, g, lane, bop);
      bf16x8_t cop[5];
      {
        const int nn = lane & 15, q = lane >> 4;
#pragma unroll
        for (int ks = 0; ks < 4; ks++) {
          const float4 cr4 = *(const float4*)(cre + (g * 16 + nn) * 64 + 16 * ks + 4 * q);
          const float4 ci4 = *(const float4*)(cim + (g * 16 + nn) * 64 + 16 * ks + 4 * q);
          pg8::u32x4 w;
          w.x = pk2(cr4.x, -ci4.x); w.y = pk2(cr4.y, -ci4.y); w.z = pk2(cr4.z, -ci4.z); w.w = pk2(cr4.w, -ci4.w);
          cop[ks] = __builtin_bit_cast(bf16x8_t, w);
        }
        const float dn = dsk[g * 16 + nn];
        float dv[8];
#pragma unroll
        for (int j = 0; j < 8; j++) dv[j] = (8 * q + j == nn) ? dn : 0.f;
        pg8::u32x4 w;
        w.x = pk2(dv[0], dv[1]); w.y = pk2(dv[2], dv[3]); w.z = pk2(dv[4], dv[5]); w.w = pk2(dv[6], dv[7]);
        cop[4] = __builtin_bit_cast(bf16x8_t, w);
      }
      const uint4* up = (const uint4*)(proj + (size_t)(b * SEQ + c * 64 + lane) * DIN + 2048 + g * 16);
      const uint4 ua = up[0], ub = up[1];
      float xr = 0.f, xi = 0.f;
      {
        const float2* eb = (const float2*)ssmE + ((size_t)(b * 64) * 16 + g) * 64 + lane;
        for (int cc = 0; cc < c; cc += 16) {
          float2 ev[16];
#pragma unroll
          for (int k = 0; k < 16; k++) ev[k] = eb[(size_t)(cc + k < c ? cc + k : c - 1) * 16 * 64];
#pragma unroll
          for (int k = 0; k < 16; k++) {
            if (cc + k < c) {
              const float nr = lcr * xr - lci * xi + ev[k].x;
              const float ni = lcr * xi + lci * xr + ev[k].y;
              xr = nr; xi = ni;
            }
          }
        }
      }
      LAS unsigned char* xt = (LAS unsigned char*)smem + SSM_TILE_BASE + wave * SSM_TILE_BYTES;
      ssm_zero_pad(xt, lane);
#pragma unroll 1
      for (int blk = 0; blk < 4; blk++) {
        ssm_bu_block(xt, lane, blk, ua, ub, bop);
#pragma unroll 4
        for (int tt = 0; tt < 16; tt++) {
          const f32x2_t bu = *(const LAS f32x2_t*)(xt + tt * SSM_RS + lane * 8);
          const float nr = lbr * xr - lbi * xi + bu[0];
          const float ni = lbr * xi + lbi * xr + bu[1];
          xr = nr; xi = ni;
          *(LAS unsigned*)(xt + tt * SSM_RS + lane * 4) = pk2(xr, xi);
        }
        __builtin_amdgcn_wave_barrier();
        {
          pg8::f32x4 acc4;
          acc4[0] = 0.f; acc4[1] = 0.f; acc4[2] = 0.f; acc4[3] = 0.f;
          const LAS unsigned char* ar = xt + (lane & 15) * SSM_RS + (lane >> 4) * 16;
#pragma unroll
          for (int ks = 0; ks < 4; ks++)
            acc4 = __builtin_amdgcn_mfma_f32_16x16x32_bf16(*(const LAS bf16x8_t*)(ar + ks * 64), cop[ks], acc4, 0, 0, 0);
          acc4 = __builtin_amdgcn_mfma_f32_16x16x32_bf16(*(const LAS bf16x8_t*)(ar + 512), cop[4], acc4, 0, 0, 0);
#pragma unroll
          for (int j = 0; j < 4; j++)
            Ytb[(blk * 16 + 4 * (lane >> 4) + j) * 264 + g * 16 + (lane & 15)] = (bf16)f2bf(gelu_tanh(acc4[j]));
        }
        __builtin_amdgcn_wave_barrier();
      }
    }
    __syncthreads();
    {
      const int n = lane & 31, hh = lane >> 5;
      const int ch = wave * 32 + n;
      const float bj = glb[ch];
      const float gj = gg[ch];
      bf16x8_t gf[16];
      {
        const bf16* grow = glT + (size_t)ch * 256 + 8 * hh;
#pragma unroll
        for (int ks = 0; ks < 16; ks++) gf[ks] = *(const bf16x8_t*)(grow + 16 * ks);
      }
      float oo[2][16];
#pragma unroll
      for (int mt = 0; mt < 2; mt++) {
        f32x16_t z;
#pragma unroll
        for (int r = 0; r < 16; r++) z[r] = 0.f;
        const LAS bf16* yrow = Ytb + (mt * 32 + n) * 264 + 8 * hh;
#pragma unroll
        for (int kq = 0; kq < 4; kq++) {
          bf16x8_t yf[4];
#pragma unroll
          for (int i = 0; i < 4; i++) yf[i] = *(const LAS bf16x8_t*)(yrow + 16 * (kq * 4 + i));
          MFMA_PAD();
#pragma unroll
          for (int i = 0; i < 4; i++) z = __builtin_amdgcn_mfma_f32_32x32x16_bf16(yf[i], gf[kq * 4 + i], z, 0, 0, 0);
          MFMA_PAD();
        }
        float sq[16];
#pragma unroll
        for (int r = 0; r < 16; r++) {
          const int t = mt * 32 + (r & 3) + 8 * (r >> 2) + 4 * hh;
          const float yv = bf2f(Ytb[t * 264 + ch]);
          const float o = yv * sigmoidf_(z[r] + bj);
          oo[mt][r] = o;
          float v = o * o;
#pragma unroll
          for (int s = 16; s > 0; s >>= 1) v += __shfl_xor(v, s, 64);
          sq[r] = v;
        }
        if (n == 0) {
#pragma unroll
          for (int r = 0; r < 16; r++) ssq2[wave * 64 + mt * 32 + (r & 3) + 8 * (r >> 2) + 4 * hh] = sq[r];
        }
      }
      __syncthreads();
      if (tid < 64) {
        float t = 0.f;
#pragma unroll
        for (int w = 0; w < 8; w++) t += ssq2[w * 64 + tid];
        rstd2[tid] = rsqrtf(t * (1.0f / 256.f) + EPSF);
      }
      __syncthreads();
#pragma unroll
      for (int mt = 0; mt < 2; mt++)
#pragma unroll
        for (int r = 0; r < 16; r++) {
          const int t = mt * 32 + (r & 3) + 8 * (r >> 2) + 4 * hh;
          y[(size_t)(b * SEQ + c * 64 + t) * DM + 768 + ch] = (bf16)f2bf(oo[mt][r] * rstd2[t] * gj);
        }
    }
  }
}

__device__ __forceinline__ void memattn_phase(const int wave_s, const bf16* q, const bf16* kvb, const bf16* vT, bf16* o, LAS float* smem) {
  const int tid_ = opaque_tid(wave_s);
  const int lane = tid_ & 63, n = lane & 31, hh = lane >> 5, wave = tid_ >> 6;
  const int sig = (n & 0x13) | ((n & 4) << 1) | ((n & 8) >> 1);
  LAS bf16* Ls = (LAS bf16*)smem;
  pg8::StaticOrder S_; S_.init(NT, DM, (int)gridDim.x, (int)blockIdx.x);
  for (int it = 0; ; it++) {
    pg8::Unit u_;
    if (!S_.next(it, u_)) break;
    const int h = u_.pn, tg = u_.pm, b = tg >> 4;
    const int tok0 = (tg * 8 + wave) * 32;
    __syncthreads();
    {
      const int r = tid_ >> 1, hf = tid_ & 1;
      const pg8::u32x4* src4 = (const pg8::u32x4*)(kvb + (size_t)(b * NMEM + r) * 2048 + h * 256 + hf * 128);
      LAS pg8::u32x4* dst4 = (LAS pg8::u32x4*)(Ls + r * 264 + hf * 128);
#pragma unroll
      for (int k = 0; k < 16; k++) dst4[k] = src4[k];
    }
    f32x16_t st[8];
#pragma unroll
    for (int kt = 0; kt < 8; kt++)
#pragma unroll
      for (int r = 0; r < 16; r++) st[kt][r] = 0.f;
    const bf16* qrow = q + (size_t)(tok0 + n) * DM + h * 256 + 8 * hh;
    __syncthreads();
#pragma unroll
    for (int kq = 0; kq < 4; kq++) {
      bf16x8_t qf[4];
#pragma unroll
      for (int i = 0; i < 4; i++) qf[i] = *(const bf16x8_t*)(qrow + 16 * (kq * 4 + i));
#pragma unroll
      for (int kt = 0; kt < 8; kt++) {
        const LAS bf16* krow = Ls + (kt * 32 + sig) * 264 + 8 * hh;
        bf16x8_t kf[4];
#pragma unroll
        for (int i = 0; i < 4; i++) kf[i] = *(const LAS bf16x8_t*)(krow + 16 * (kq * 4 + i));
        MFMA_PAD();
#pragma unroll
        for (int i = 0; i < 4; i++) st[kt] = __builtin_amdgcn_mfma_f32_32x32x16_bf16(kf[i], qf[i], st[kt], 0, 0, 0);
        MFMA_PAD();
      }
    }
    float mx = st[0][0];
#pragma unroll
    for (int kt = 0; kt < 8; kt++)
#pragma unroll
      for (int r = 0; r < 16; r++) mx = fmaxf(mx, st[kt][r]);
    mx = fmaxf(mx, __shfl_xor(mx, 32, 64));
    float sum = 0.f;
#pragma unroll
    for (int kt = 0; kt < 8; kt++)
#pragma unroll
      for (int r = 0; r < 16; r++) { const float e = __expf((st[kt][r] - mx) * 0.0625f); st[kt][r] = e; sum += e; }
    sum += __shfl_xor(sum, 32, 64);
    const float inv = 1.0f / sum;
    bf16x8_t pf[8][2];
#pragma unroll
    for (int kt = 0; kt < 8; kt++)
#pragma unroll
      for (int s = 0; s < 2; s++)
#pragma unroll
        for (int j = 0; j < 8; j++) pf[kt][s][j] = (short)f2bf(st[kt][8 * s + j] * inv);
    __syncthreads();
    {
      const int r = tid_ >> 1, hf = tid_ & 1;
      const pg8::u32x4* src4 = (const pg8::u32x4*)(vT + ((size_t)(b * 4 + h) * 256 + r) * 256 + hf * 128);
      LAS pg8::u32x4* dst4 = (LAS pg8::u32x4*)(Ls + r * 264 + hf * 128);
#pragma unroll
      for (int k = 0; k < 16; k++) dst4[k] = src4[k];
    }
    __syncthreads();
#pragma unroll 1
    for (int dt = 0; dt < 8; dt++) {
      f32x16_t oacc;
#pragma unroll
      for (int r = 0; r < 16; r++) oacc[r] = 0.f;
      const LAS bf16* vrow = Ls + (dt * 32 + n) * 264 + 8 * hh;
#pragma unroll
      for (int kq = 0; kq < 4; kq++) {
        bf16x8_t vf[4];
#pragma unroll
        for (int i = 0; i < 4; i++) vf[i] = *(const LAS bf16x8_t*)(vrow + (kq * 2 + (i >> 1)) * 32 + 16 * (i & 1));
        MFMA_PAD();
#pragma unroll
        for (int i = 0; i < 4; i++) oacc = __builtin_amdgcn_mfma_f32_32x32x16_bf16(pf[kq * 2 + (i >> 1)][i & 1], vf[i], oacc, 0, 0, 0);
        MFMA_PAD();
      }
#pragma unroll
      for (int r = 0; r < 16; r++) {
        const int qi = (r & 3) + 8 * (r >> 2) + 4 * hh;
        o[(size_t)(tok0 + qi) * DM + h * 256 + dt * 32 + n] = (bf16)f2bf(oacc[r]);
      }
    }
  }
}

__device__ __forceinline__ void vt_phase(const int wave_s, const bf16* kvb, bf16* vT) {
  const int tid_ = opaque_tid(wave_s);
  const int gt = blockIdx.x * (NWAVES * 64) + tid_;
  const int nth = gridDim.x * NWAVES * 64;
  for (int i = gt; i < 2 * 4 * 4 * 256 * 256; i += nth) {
    const int m = i & 255, d = (i >> 8) & 255, h = (i >> 16) & 3, b = (i >> 18) & 3, l = i >> 20;
    vT[i] = kvb[((size_t)l * 1024 + b * 256 + m) * 2048 + 1024 + h * 256 + d];
  }
}

template <unsigned MASK>
__device__ __forceinline__ float pack_key(float s, unsigned idx) {
  const unsigned u = __builtin_bit_cast(unsigned, s);
  const unsigned tag = ((int)u < 0) ? idx : (MASK - idx);
  return __builtin_bit_cast(float, (u & ~MASK) + tag);
}
template <unsigned MASK>
__device__ __forceinline__ unsigned key_idx(float k) {
  const unsigned u = __builtin_bit_cast(unsigned, k);
  const unsigned tag = u & MASK;
  return ((int)u < 0) ? tag : (MASK - tag);
}
template <unsigned MASK>
__device__ __forceinline__ float key_val(float k) { return __builtin_bit_cast(float, __builtin_bit_cast(unsigned, k) & ~MASK); }
__device__ __forceinline__ void top16_of_64(float (&K)[64]) {
  { const float a_ = K[0], b_ = K[1]; const bool g_ = a_ > b_; K[0] = g_ ? a_ : b_; K[1] = g_ ? b_ : a_; }
  { const float a_ = K[2], b_ = K[3]; const bool g_ = a_ > b_; K[2] = g_ ? b_ : a_; K[3] = g_ ? a_ : b_; }
  { const float a_ = K[4], b_ = K[5]; const bool g_ = a_ > b_; K[4] = g_ ? a_ : b_; K[5] = g_ ? b_ : a_; }
  { const float a_ = K[6], b_ = K[7]; const bool g_ = a_ > b_; K[6] = g_ ? b_ : a_; K[7] = g_ ? a_ : b_; }
  { const float a_ = K[8], b_ = K[9]; const bool g_ = a_ > b_; K[8] = g_ ? a_ : b_; K[9] = g_ ? b_ : a_; }
  { const float a_ = K[10], b_ = K[11]; const bool g_ = a_ > b_; K[10] = g_ ? b_ : a_; K[11] = g_ ? a_ : b_; }
  { const float a_ = K[12], b_ = K[13]; const bool g_ = a_ > b_; K[12] = g_ ? a_ : b_; K[13] = g_ ? b_ : a_; }
  { const float a_ = K[14], b_ = K[15]; const bool g_ = a_ > b_; K[14] = g_ ? b_ : a_; K[15] = g_ ? a_ : b_; }
  { const float a_ = K[0], b_ = K[2]; const bool g_ = a_ > b_; K[0] = g_ ? a_ : b_; K[2] = g_ ? b_ : a_; }
  { const float a_ = K[1], b_ = K[3]; const bool g_ = a_ > b_; K[1] = g_ ? a_ : b_; K[3] = g_ ? b_ : a_; }
  { const float a_ = K[4], b_ = K[6]; const bool g_ = a_ > b_; K[4] = g_ ? b_ : a_; K[6] = g_ ? a_ : b_; }
  { const float a_ = K[5], b_ = K[7]; const bool g_ = a_ > b_; K[5] = g_ ? b_ : a_; K[7] = g_ ? a_ : b_; }
  { const float a_ = K[8], b_ = K[10]; const bool g_ = a_ > b_; K[8] = g_ ? a_ : b_; K[10] = g_ ? b_ : a_; }
  { const float a_ = K[9], b_ = K[11]; const bool g_ = a_ > b_; K[9] = g_ ? a_ : b_; K[11] = g_ ? b_ : a_; }
  { const float a_ = K[12], b_ = K[14]; const bool g_ = a_ > b_; K[12] = g_ ? b_ : a_; K[14] = g_ ? a_ : b_; }
  { const float a_ = K[13], b_ = K[15]; const bool g_ = a_ > b_; K[13] = g_ ? b_ : a_; K[15] = g_ ? a_ : b_; }
  { const float a_ = K[0], b_ = K[1]; const bool g_ = a_ > b_; K[0] = g_ ? a_ : b_; K[1] = g_ ? b_ : a_; }
  { const float a_ = K[2], b_ = K[3]; const bool g_ = a_ > b_; K[2] = g_ ? a_ : b_; K[3] = g_ ? b_ : a_; }
  { const float a_ = K[4], b_ = K[5]; const bool g_ = a_ > b_; K[4] = g_ ? b_ : a_; K[5] = g_ ? a_ : b_; }
  { const float a_ = K[6], b_ = K[7]; const bool g_ = a_ > b_; K[6] = g_ ? b_ : a_; K[7] = g_ ? a_ : b_; }
  { const float a_ = K[8], b_ = K[9]; const bool g_ = a_ > b_; K[8] = g_ ? a_ : b_; K[9] = g_ ? b_ : a_; }
  { const float a_ = K[10], b_ = K[11]; const bool g_ = a_ > b_; K[10] = g_ ? a_ : b_; K[11] = g_ ? b_ : a_; }
  { const float a_ = K[12], b_ = K[13]; const bool g_ = a_ > b_; K[12] = g_ ? b_ : a_; K[13] = g_ ? a_ : b_; }
  { const float a_ = K[14], b_ = K[15]; const bool g_ = a_ > b_; K[14] = g_ ? b_ : a_; K[15] = g_ ? a_ : b_; }
  { const float a_ = K[0], b_ = K[4]; const bool g_ = a_ > b_; K[0] = g_ ? a_ : b_; K[4] = g_ ? b_ : a_; }
  { const float a_ = K[1], b_ = K[5]; const bool g_ = a_ > b_; K[1] = g_ ? a_ : b_; K[5] = g_ ? b_ : a_; }
  { const float a_ = K[2], b_ = K[6]; const bool g_ = a_ > b_; K[2] = g_ ? a_ : b_; K[6] = g_ ? b_ : a_; }
  { const float a_ = K[3], b_ = K[7]; const bool g_ = a_ > b_; K[3] = g_ ? a_ : b_; K[7] = g_ ? b_ : a_; }
  { const float a_ = K[8], b_ = K[12]; const bool g_ = a_ > b_; K[8] = g_ ? b_ : a_; K[12] = g_ ? a_ : b_; }
  { const float a_ = K[9], b_ = K[13]; const bool g_ = a_ > b_; K[9] = g_ ? b_ : a_; K[13] = g_ ? a_ : b_; }
  { const float a_ = K[10], b_ = K[14]; const bool g_ = a_ > b_; K[10] = g_ ? b_ : a_; K[14] = g_ ? a_ : b_; }
  { const float a_ = K[11], b_ = K[15]; const bool g_ = a_ > b_; K[11] = g_ ? b_ : a_; K[15] = g_ ? a_ : b_; }
  { const float a_ = K[0], b_ = K[2]; const bool g_ = a_ > b_; K[0] = g_ ? a_ : b_; K[2] = g_ ? b_ : a_; }
  { const float a_ = K[1], b_ = K[3]; const bool g_ = a_ > b_; K[1] = g_ ? a_ : b_; K[3] = g_ ? b_ : a_; }
  { const float a_ = K[4], b_ = K[6]; const bool g_ = a_ > b_; K[4] = g_ ? a_ : b_; K[6] = g_ ? b_ : a_; }
  { const float a_ = K[5], b_ = K[7]; const bool g_ = a_ > b_; K[5] = g_ ? a_ : b_; K[7] = g_ ? b_ : a_; }
  { const float a_ = K[8], b_ = K[10]; const bool g_ = a_ > b_; K[8] = g_ ? b_ : a_; K[10] = g_ ? a_ : b_; }
  { const float a_ = K[9], b_ = K[11]; const bool g_ = a_ > b_; K[9] = g_ ? b_ : a_; K[11] = g_ ? a_ : b_; }
  { const float a_ = K[12], b_ = K[14]; const bool g_ = a_ > b_; K[12] = g_ ? b_ : a_; K[14] = g_ ? a_ : b_; }
  { const float a_ = K[13], b_ = K[15]; const bool g_ = a_ > b_; K[13] = g_ ? b_ : a_; K[15] = g_ ? a_ : b_; }
  { const float a_ = K[0], b_ = K[1]; const bool g_ = a_ > b_; K[0] = g_ ? a_ : b_; K[1] = g_ ? b_ : a_; }
  { const float a_ = K[2], b_ = K[3]; const bool g_ = a_ > b_; K[2] = g_ ? a_ : b_; K[3] = g_ ? b_ : a_; }
  { const float a_ = K[4], b_ = K[5]; const bool g_ = a_ > b_; K[4] = g_ ? a_ : b_; K[5] = g_ ? b_ : a_; }
  { const float a_ = K[6], b_ = K[7]; const bool g_ = a_ > b_; K[6] = g_ ? a_ : b_; K[7] = g_ ? b_ : a_; }
  { const float a_ = K[8], b_ = K[9]; const bool g_ = a_ > b_; K[8] = g_ ? b_ : a_; K[9] = g_ ? a_ : b_; }
  { const float a_ = K[10], b_ = K[11]; const bool g_ = a_ > b_; K[10] = g_ ? b_ : a_; K[11] = g_ ? a_ : b_; }
  { const float a_ = K[12], b_ = K[13]; const bool g_ = a_ > b_; K[12] = g_ ? b_ : a_; K[13] = g_ ? a_ : b_; }
  { const float a_ = K[14], b_ = K[15]; const bool g_ = a_ > b_; K[14] = g_ ? b_ : a_; K[15] = g_ ? a_ : b_; }
  { const float a_ = K[0], b_ = K[8]; const bool g_ = a_ > b_; K[0] = g_ ? a_ : b_; K[8] = g_ ? b_ : a_; }
  { const float a_ = K[1], b_ = K[9]; const bool g_ = a_ > b_; K[1] = g_ ? a_ : b_; K[9] = g_ ? b_ : a_; }
  { const float a_ = K[2], b_ = K[10]; const bool g_ = a_ > b_; K[2] = g_ ? a_ : b_; K[10] = g_ ? b_ : a_; }
  { const float a_ = K[3], b_ = K[11]; const bool g_ = a_ > b_; K[3] = g_ ? a_ : b_; K[11] = g_ ? b_ : a_; }
  { const float a_ = K[4], b_ = K[12]; const bool g_ = a_ > b_; K[4] = g_ ? a_ : b_; K[12] = g_ ? b_ : a_; }
  { const float a_ = K[5], b_ = K[13]; const bool g_ = a_ > b_; K[5] = g_ ? a_ : b_; K[13] = g_ ? b_ : a_; }
  { const float a_ = K[6], b_ = K[14]; const bool g_ = a_ > b_; K[6] = g_ ? a_ : b_; K[14] = g_ ? b_ : a_; }
  { const float a_ = K[7], b_ = K[15]; const bool g_ = a_ > b_; K[7] = g_ ? a_ : b_; K[15] = g_ ? b_ : a_; }
  { const float a_ = K[0], b_ = K[4]; const bool g_ = a_ > b_; K[0] = g_ ? a_ : b_; K[4] = g_ ? b_ : a_; }
  { const float a_ = K[1], b_ = K[5]; const bool g_ = a_ > b_; K[1] = g_ ? a_ : b_; K[5] = g_ ? b_ : a_; }
  { const float a_ = K[2], b_ = K[6]; const bool g_ = a_ > b_; K[2] = g_ ? a_ : b_; K[6] = g_ ? b_ : a_; }
  { const float a_ = K[3], b_ = K[7]; const bool g_ = a_ > b_; K[3] = g_ ? a_ : b_; K[7] = g_ ? b_ : a_; }
  { const float a_ = K[8], b_ = K[12]; const bool g_ = a_ > b_; K[8] = g_ ? a_ : b_; K[12] = g_ ? b_ : a_; }
  { const float a_ = K[9], b_ = K[13]; const bool g_ = a_ > b_; K[9] = g_ ? a_ : b_; K[13] = g_ ? b_ : a_; }
  { const float a_ = K[10], b_ = K[14]; const bool g_ = a_ > b_; K[10] = g_ ? a_ : b_; K[14] = g_ ? b_ : a_; }
  { const float a_ = K[11], b_ = K[15]; const bool g_ = a_ > b_; K[11] = g_ ? a_ : b_; K[15] = g_ ? b_ : a_; }
  { const float a_ = K[0], b_ = K[2]; const bool g_ = a_ > b_; K[0] = g_ ? a_ : b_; K[2] = g_ ? b_ : a_; }
  { const float a_ = K[1], b_ = K[3]; const bool g_ = a_ > b_; K[1] = g_ ? a_ : b_; K[3] = g_ ? b_ : a_; }
  { const float a_ = K[4], b_ = K[6]; const bool g_ = a_ > b_; K[4] = g_ ? a_ : b_; K[6] = g_ ? b_ : a_; }
  { const float a_ = K[5], b_ = K[7]; const bool g_ = a_ > b_; K[5] = g_ ? a_ : b_; K[7] = g_ ? b_ : a_; }
  { const float a_ = K[8], b_ = K[10]; const bool g_ = a_ > b_; K[8] = g_ ? a_ : b_; K[10] = g_ ? b_ : a_; }
  { const float a_ = K[9], b_ = K[11]; const bool g_ = a_ > b_; K[9] = g_ ? a_ : b_; K[11] = g_ ? b_ : a_; }
  { const float a_ = K[12], b_ = K[14]; const bool g_ = a_ > b_; K[12] = g_ ? a_ : b_; K[14] = g_ ? b_ : a_; }
  { const float a_ = K[13], b_ = K[15]; const bool g_ = a_ > b_; K[13] = g_ ? a_ : b_; K[15] = g_ ? b_ : a_; }
  { const float a_ = K[0], b_ = K[1]; const bool g_ = a_ > b_; K[0] = g_ ? a_ : b_; K[1] = g_ ? b_ : a_; }
  { const float a_ = K[2], b_ = K[3]; const bool g_ = a_ > b_; K[2] = g_ ? a_ : b_; K[3] = g_ ? b_ : a_; }
  { const float a_ = K[4], b_ = K[5]; const bool g_ = a_ > b_; K[4] = g_ ? a_ : b_; K[5] = g_ ? b_ : a_; }
  { const float a_ = K[6], b_ = K[7]; const bool g_ = a_ > b_; K[6] = g_ ? a_ : b_; K[7] = g_ ? b_ : a_; }
  { const float a_ = K[8], b_ = K[9]; const bool g_ = a_ > b_; K[8] = g_ ? a_ : b_; K[9] = g_ ? b_ : a_; }
  { const float a_ = K[10], b_ = K[11]; const bool g_ = a_ > b_; K[10] = g_ ? a_ : b_; K[11] = g_ ? b_ : a_; }
  { const float a_ = K[12], b_ = K[13]; const bool g_ = a_ > b_; K[12] = g_ ? a_ : b_; K[13] = g_ ? b_ : a_; }
  { const float a_ = K[14], b_ = K[15]; const bool g_ = a_ > b_; K[14] = g_ ? a_ : b_; K[15] = g_ ? b_ : a_; }
  { const float a_ = K[16], b_ = K[17]; const bool g_ = a_ > b_; K[16] = g_ ? a_ : b_; K[17] = g_ ? b_ : a_; }
  { const float a_ = K[18], b_ = K[19]; const bool g_ = a_ > b_; K[18] = g_ ? b_ : a_; K[19] = g_ ? a_ : b_; }
  { const float a_ = K[20], b_ = K[21]; const bool g_ = a_ > b_; K[20] = g_ ? a_ : b_; K[21] = g_ ? b_ : a_; }
  { const float a_ = K[22], b_ = K[23]; const bool g_ = a_ > b_; K[22] = g_ ? b_ : a_; K[23] = g_ ? a_ : b_; }
  { const float a_ = K[24], b_ = K[25]; const bool g_ = a_ > b_; K[24] = g_ ? a_ : b_; K[25] = g_ ? b_ : a_; }
  { const float a_ = K[26], b_ = K[27]; const bool g_ = a_ > b_; K[26] = g_ ? b_ : a_; K[27] = g_ ? a_ : b_; }
  { const float a_ = K[28], b_ = K[29]; const bool g_ = a_ > b_; K[28] = g_ ? a_ : b_; K[29] = g_ ? b_ : a_; }
  { const float a_ = K[30], b_ = K[31]; const bool g_ = a_ > b_; K[30] = g_ ? b_ : a_; K[31] = g_ ? a_ : b_; }
  { const float a_ = K[16], b_ = K[18]; const bool g_ = a_ > b_; K[16] = g_ ? a_ : b_; K[18] = g_ ? b_ : a_; }
  { const float a_ = K[17], b_ = K[19]; const bool g_ = a_ > b_; K[17] = g_ ? a_ : b_; K[19] = g_ ? b_ : a_; }
  { const float a_ = K[20], b_ = K[22]; const bool g_ = a_ > b_; K[20] = g_ ? b_ : a_; K[22] = g_ ? a_ : b_; }
  { const float a_ = K[21], b_ = K[23]; const bool g_ = a_ > b_; K[21] = g_ ? b_ : a_; K[23] = g_ ? a_ : b_; }
  { const float a_ = K[24], b_ = K[26]; const bool g_ = a_ > b_; K[24] = g_ ? a_ : b_; K[26] = g_ ? b_ : a_; }
  { const float a_ = K[25], b_ = K[27]; const bool g_ = a_ > b_; K[25] = g_ ? a_ : b_; K[27] = g_ ? b_ : a_; }
  { const float a_ = K[28], b_ = K[30]; const bool g_ = a_ > b_; K[28] = g_ ? b_ : a_; K[30] = g_ ? a_ : b_; }
  { const float a_ = K[29], b_ = K[31]; const bool g_ = a_ > b_; K[29] = g_ ? b_ : a_; K[31] = g_ ? a_ : b_; }
  { const float a_ = K[16], b_ = K[17]; const bool g_ = a_ > b_; K[16] = g_ ? a_ : b_; K[17] = g_ ? b_ : a_; }
  { const float a_ = K[18], b_ = K[19]; const bool g_ = a_ > b_; K[18] = g_ ? a_ : b_; K[19] = g_ ? b_ : a_; }
  { const float a_ = K[20], b_ = K[21]; const bool g_ = a_ > b_; K[20] = g_ ? b_ : a_; K[21] = g_ ? a_ : b_; }
  { const float a_ = K[22], b_ = K[23]; const bool g_ = a_ > b_; K[22] = g_ ? b_ : a_; K[23] = g_ ? a_ : b_; }
  { const float a_ = K[24], b_ = K[25]; const bool g_ = a_ > b_; K[24] = g_ ? a_ : b_; K[25] = g_ ? b_ : a_; }
  { const float a_ = K[26], b_ = K[27]; const bool g_ = a_ > b_; K[26] = g_ ? a_ : b_; K[27] = g_ ? b_ : a_; }
  { const float a_ = K[28], b_ = K[29]; const bool g_ = a_ > b_; K[28] = g_ ? b_ : a_; K[29] = g_ ? a_ : b_; }
  { const float a_ = K[30], b_ = K[31]; const bool g_ = a_ > b_; K[30] = g_ ? b_ : a_; K[31] = g_ ? a_ : b_; }
  { const float a_ = K[16], b_ = K[20]; const bool g_ = a_ > b_; K[16] = g_ ? a_ : b_; K[20] = g_ ? b_ : a_; }
  { const float a_ = K[17], b_ = K[21]; const bool g_ = a_ > b_; K[17] = g_ ? a_ : b_; K[21] = g_ ? b_ : a_; }
  { const float a_ = K[18], b_ = K[22]; const bool g_ = a_ > b_; K[18] = g_ ? a_ : b_; K[22] = g_ ? b_ : a_; }
  { const float a_ = K[19], b_ = K[23]; const bool g_ = a_ > b_; K[19] = g_ ? a_ : b_; K[23] = g_ ? b_ : a_; }
  { const float a_ = K[24], b_ = K[28]; const bool g_ = a_ > b_; K[24] = g_ ? b_ : a_; K[28] = g_ ? a_ : b_; }
  { const float a_ = K[25], b_ = K[29]; const bool g_ = a_ > b_; K[25] = g_ ? b_ : a_; K[29] = g_ ? a_ : b_; }
  { const float a_ = K[26], b_ = K[30]; const bool g_ = a_ > b_; K[26] = g_ ? b_ : a_; K[30] = g_ ? a_ : b_; }
  { const float a_ = K[27], b_ = K[31]; const bool g_ = a_ > b_; K[27] = g_ ? b_ : a_; K[31] = g_ ? a_ : b_; }
  { const float a_ = K[16], b_ = K[18]; const bool g_ = a_ > b_; K[16] = g_ ? a_ : b_; K[18] = g_ ? b_ : a_; }
  { const float a_ = K[17], b_ = K[19]; const bool g_ = a_ > b_; K[17] = g_ ? a_ : b_; K[19] = g_ ? b_ : a_; }
  { const float a_ = K[20], b_ = K[22]; const bool g_ = a_ > b_; K[20] = g_ ? a_ : b_; K[22] = g_ ? b_ : a_; }
  { const float a_ = K[21], b_ = K[23]; const bool g_ = a_ > b_; K[21] = g_ ? a_ : b_; K[23] = g_ ? b_ : a_; }
  { const float a_ = K[24], b_ = K[26]; const bool g_ = a_ > b_; K[24] = g_ ? b_ : a_; K[26] = g_ ? a_ : b_; }
  { const float a_ = K[25], b_ = K[27]; const bool g_ = a_ > b_; K[25] = g_ ? b_ : a_; K[27] = g_ ? a_ : b_; }
  { const float a_ = K[28], b_ = K[30]; const bool g_ = a_ > b_; K[28] = g_ ? b_ : a_; K[30] = g_ ? a_ : b_; }
  { const float a_ = K[29], b_ = K[31]; const bool g_ = a_ > b_; K[29] = g_ ? b_ : a_; K[31] = g_ ? a_ : b_; }
  { const float a_ = K[16], b_ = K[17]; const bool g_ = a_ > b_; K[16] = g_ ? a_ : b_; K[17] = g_ ? b_ : a_; }
  { const float a_ = K[18], b_ = K[19]; const bool g_ = a_ > b_; K[18] = g_ ? a_ : b_; K[19] = g_ ? b_ : a_; }
  { const float a_ = K[20], b_ = K[21]; const bool g_ = a_ > b_; K[20] = g_ ? a_ : b_; K[21] = g_ ? b_ : a_; }
  { const float a_ = K[22], b_ = K[23]; const bool g_ = a_ > b_; K[22] = g_ ? a_ : b_; K[23] = g_ ? b_ : a_; }
  { const float a_ = K[24], b_ = K[25]; const bool g_ = a_ > b_; K[24] = g_ ? b_ : a_; K[25] = g_ ? a_ : b_; }
  { const float a_ = K[26], b_ = K[27]; const bool g_ = a_ > b_; K[26] = g_ ? b_ : a_; K[27] = g_ ? a_ : b_; }
  { const float a_ = K[28], b_ = K[29]; const bool g_ = a_ > b_; K[28] = g_ ? b_ : a_; K[29] = g_ ? a_ : b_; }
  { const float a_ = K[30], b_ = K[31]; const bool g_ = a_ > b_; K[30] = g_ ? b_ : a_; K[31] = g_ ? a_ : b_; }
  { const float a_ = K[16], b_ = K[24]; const bool g_ = a_ > b_; K[16] = g_ ? a_ : b_; K[24] = g_ ? b_ : a_; }
  { const float a_ = K[17], b_ = K[25]; const bool g_ = a_ > b_; K[17] = g_ ? a_ : b_; K[25] = g_ ? b_ : a_; }
  { const float a_ = K[18], b_ = K[26]; const bool g_ = a_ > b_; K[18] = g_ ? a_ : b_; K[26] = g_ ? b_ : a_; }
  { const float a_ = K[19], b_ = K[27]; const bool g_ = a_ > b_; K[19] = g_ ? a_ : b_; K[27] = g_ ? b_ : a_; }
  { const float a_ = K[20], b_ = K[28]; const bool g_ = a_ > b_; K[20] = g_ ? a_ : b_; K[28] = g_ ? b_ : a_; }
  { const float a_ = K[21], b_ = K[29]; const bool g_ = a_ > b_; K[21] = g_ ? a_ : b_; K[29] = g_ ? b_ : a_; }
  { const float a_ = K[22], b_ = K[30]; const bool g_ = a_ > b_; K[22] = g_ ? a_ : b_; K[30] = g_ ? b_ : a_; }
  { const float a_ = K[23], b_ = K[31]; const bool g_ = a_ > b_; K[23] = g_ ? a_ : b_; K[31] = g_ ? b_ : a_; }
  { const float a_ = K[16], b_ = K[20]; const bool g_ = a_ > b_; K[16] = g_ ? a_ : b_; K[20] = g_ ? b_ : a_; }
  { const float a_ = K[17], b_ = K[21]; const bool g_ = a_ > b_; K[17] = g_ ? a_ : b_; K[21] = g_ ? b_ : a_; }
  { const float a_ = K[18], b_ = K[22]; const bool g_ = a_ > b_; K[18] = g_ ? a_ : b_; K[22] = g_ ? b_ : a_; }
  { const float a_ = K[19], b_ = K[23]; const bool g_ = a_ > b_; K[19] = g_ ? a_ : b_; K[23] = g_ ? b_ : a_; }
  { const float a_ = K[24], b_ = K[28]; const bool g_ = a_ > b_; K[24] = g_ ? a_ : b_; K[28] = g_ ? b_ : a_; }
  { const float a_ = K[25], b_ = K[29]; const bool g_ = a_ > b_; K[25] = g_ ? a_ : b_; K[29] = g_ ? b_ : a_; }
  { const float a_ = K[26], b_ = K[30]; const bool g_ = a_ > b_; K[26] = g_ ? a_ : b_; K[30] = g_ ? b_ : a_; }
  { const float a_ = K[27], b_ = K[31]; const bool g_ = a_ > b_; K[27] = g_ ? a_ : b_; K[31] = g_ ? b_ : a_; }
  { const float a_ = K[16], b_ = K[18]; const bool g_ = a_ > b_; K[16] = g_ ? a_ : b_; K[18] = g_ ? b_ : a_; }
  { const float a_ = K[17], b_ = K[19]; const bool g_ = a_ > b_; K[17] = g_ ? a_ : b_; K[19] = g_ ? b_ : a_; }
  { const float a_ = K[20], b_ = K[22]; const bool g_ = a_ > b_; K[20] = g_ ? a_ : b_; K[22] = g_ ? b_ : a_; }
  { const float a_ = K[21], b_ = K[23]; const bool g_ = a_ > b_; K[21] = g_ ? a_ : b_; K[23] = g_ ? b_ : a_; }
  { const float a_ = K[24], b_ = K[26]; const bool g_ = a_ > b_; K[24] = g_ ? a_ : b_; K[26] = g_ ? b_ : a_; }
  { const float a_ = K[25], b_ = K[27]; const bool g_ = a_ > b_; K[25] = g_ ? a_ : b_; K[27] = g_ ? b_ : a_; }
  { const float a_ = K[28], b_ = K[30]; const bool g_ = a_ > b_; K[28] = g_ ? a_ : b_; K[30] = g_ ? b_ : a_; }
  { const float a_ = K[29], b_ = K[31]; const bool g_ = a_ > b_; K[29] = g_ ? a_ : b_; K[31] = g_ ? b_ : a_; }
  { const float a_ = K[16], b_ = K[17]; const bool g_ = a_ > b_; K[16] = g_ ? a_ : b_; K[17] = g_ ? b_ : a_; }
  { const float a_ = K[18], b_ = K[19]; const bool g_ = a_ > b_; K[18] = g_ ? a_ : b_; K[19] = g_ ? b_ : a_; }
  { const float a_ = K[20], b_ = K[21]; const bool g_ = a_ > b_; K[20] = g_ ? a_ : b_; K[21] = g_ ? b_ : a_; }
  { const float a_ = K[22], b_ = K[23]; const bool g_ = a_ > b_; K[22] = g_ ? a_ : b_; K[23] = g_ ? b_ : a_; }
  { const float a_ = K[24], b_ = K[25]; const bool g_ = a_ > b_; K[24] = g_ ? a_ : b_; K[25] = g_ ? b_ : a_; }
  { const float a_ = K[26], b_ = K[27]; const bool g_ = a_ > b_; K[26] = g_ ? a_ : b_; K[27] = g_ ? b_ : a_; }
  { const float a_ = K[28], b_ = K[29]; const bool g_ = a_ > b_; K[28] = g_ ? a_ : b_; K[29] = g_ ? b_ : a_; }
  { const float a_ = K[30], b_ = K[31]; const bool g_ = a_ > b_; K[30] = g_ ? a_ : b_; K[31] = g_ ? b_ : a_; }
  { const float a_ = K[32], b_ = K[33]; const bool g_ = a_ > b_; K[32] = g_ ? a_ : b_; K[33] = g_ ? b_ : a_; }
  { const float a_ = K[34], b_ = K[35]; const bool g_ = a_ > b_; K[34] = g_ ? b_ : a_; K[35] = g_ ? a_ : b_; }
  { const float a_ = K[36], b_ = K[37]; const bool g_ = a_ > b_; K[36] = g_ ? a_ : b_; K[37] = g_ ? b_ : a_; }
  { const float a_ = K[38], b_ = K[39]; const bool g_ = a_ > b_; K[38] = g_ ? b_ : a_; K[39] = g_ ? a_ : b_; }
  { const float a_ = K[40], b_ = K[41]; const bool g_ = a_ > b_; K[40] = g_ ? a_ : b_; K[41] = g_ ? b_ : a_; }
  { const float a_ = K[42], b_ = K[43]; const bool g_ = a_ > b_; K[42] = g_ ? b_ : a_; K[43] = g_ ? a_ : b_; }
  { const float a_ = K[44], b_ = K[45]; const bool g_ = a_ > b_; K[44] = g_ ? a_ : b_; K[45] = g_ ? b_ : a_; }
  { const float a_ = K[46], b_ = K[47]; const bool g_ = a_ > b_; K[46] = g_ ? b_ : a_; K[47] = g_ ? a_ : b_; }
  { const float a_ = K[32], b_ = K[34]; const bool g_ = a_ > b_; K[32] = g_ ? a_ : b_; K[34] = g_ ? b_ : a_; }
  { const float a_ = K[33], b_ = K[35]; const bool g_ = a_ > b_; K[33] = g_ ? a_ : b_; K[35] = g_ ? b_ : a_; }
  { const float a_ = K[36], b_ = K[38]; const bool g_ = a_ > b_; K[36] = g_ ? b_ : a_; K[38] = g_ ? a_ : b_; }
  { const float a_ = K[37], b_ = K[39]; const bool g_ = a_ > b_; K[37] = g_ ? b_ : a_; K[39] = g_ ? a_ : b_; }
  { const float a_ = K[40], b_ = K[42]; const bool g_ = a_ > b_; K[40] = g_ ? a_ : b_; K[42] = g_ ? b_ : a_; }
  { const float a_ = K[41], b_ = K[43]; const bool g_ = a_ > b_; K[41] = g_ ? a_ : b_; K[43] = g_ ? b_ : a_; }
  { const float a_ = K[44], b_ = K[46]; const bool g_ = a_ > b_; K[44] = g_ ? b_ : a_; K[46] = g_ ? a_ : b_; }
  { const float a_ = K[45], b_ = K[47]; const bool g_ = a_ > b_; K[45] = g_ ? b_ : a_; K[47] = g_ ? a_ : b_; }
  { const float a_ = K[32], b_ = K[33]; const bool g_ = a_ > b_; K[32] = g_ ? a_ : b_; K[33] = g_ ? b_ : a_; }
  { const float a_ = K[34], b_ = K[35]; const bool g_ = a_ > b_; K[34] = g_ ? a_ : b_; K[35] = g_ ? b_ : a_; }
  { const float a_ = K[36], b_ = K[37]; const bool g_ = a_ > b_; K[36] = g_ ? b_ : a_; K[37] = g_ ? a_ : b_; }
  { const float a_ = K[38], b_ = K[39]; const bool g_ = a_ > b_; K[38] = g_ ? b_ : a_; K[39] = g_ ? a_ : b_; }
  { const float a_ = K[40], b_ = K[41]; const bool g_ = a_ > b_; K[40] = g_ ? a_ : b_; K[41] = g_ ? b_ : a_; }
  { const float a_ = K[42], b_ = K[43]; const bool g_ = a_ > b_; K[42] = g_ ? a_ : b_; K[43] = g_ ? b_ : a_; }
  { const float a_ = K[44], b_ = K[45]; const bool g_ = a_ > b_; K[44] = g_ ? b_ : a_; K[45] = g_ ? a_ : b_; }
  { const float a_ = K[46], b_ = K[47]; const bool g_ = a_ > b_; K[46] = g_ ? b_ : a_; K[47] = g_ ? a_ : b_; }
  { const float a_ = K[32], b_ = K[36]; const bool g_ = a_ > b_; K[32] = g_ ? a_ : b_; K[36] = g_ ? b_ : a_; }
  { const float a_ = K[33], b_ = K[37]; const bool g_ = a_ > b_; K[33] = g_ ? a_ : b_; K[37] = g_ ? b_ : a_; }
  { const float a_ = K[34], b_ = K[38]; const bool g_ = a_ > b_; K[34] = g_ ? a_ : b_; K[38] = g_ ? b_ : a_; }
  { const float a_ = K[35], b_ = K[39]; const bool g_ = a_ > b_; K[35] = g_ ? a_ : b_; K[39] = g_ ? b_ : a_; }
  { const float a_ = K[40], b_ = K[44]; const bool g_ = a_ > b_; K[40] = g_ ? b_ : a_; K[44] = g_ ? a_ : b_; }
  { const float a_ = K[41], b_ = K[45]; const bool g_ = a_ > b_; K[41] = g_ ? b_ : a_; K[45] = g_ ? a_ : b_; }
  { const float a_ = K[42], b_ = K[46]; const bool g_ = a_ > b_; K[42] = g_ ? b_ : a_; K[46] = g_ ? a_ : b_; }
  { const float a_ = K[43], b_ = K[47]; const bool g_ = a_ > b_; K[43] = g_ ? b_ : a_; K[47] = g_ ? a_ : b_; }
  { const float a_ = K[32], b_ = K[34]; const bool g_ = a_ > b_; K[32] = g_ ? a_ : b_; K[34] = g_ ? b_ : a_; }
  { const float a_ = K[33], b_ = K[35]; const bool g_ = a_ > b_; K[33] = g_ ? a_ : b_; K[35] = g_ ? b_ : a_; }
  { const float a_ = K[36], b_ = K[38]; const bool g_ = a_ > b_; K[36] = g_ ? a_ : b_; K[38] = g_ ? b_ : a_; }
  { const float a_ = K[37], b_ = K[39]; const bool g_ = a_ > b_; K[37] = g_ ? a_ : b_; K[39] = g_ ? b_ : a_; }
  { const float a_ = K[40], b_ = K[42]; const bool g_ = a_ > b_; K[40] = g_ ? b_ : a_; K[42] = g_ ? a_ : b_; }
  { const float a_ = K[41], b_ = K[43]; const bool g_ = a_ > b_; K[41] = g_ ? b_ : a_; K[43] = g_ ? a_ : b_; }
  { const float a_ = K[44], b_ = K[46]; const bool g_ = a_ > b_; K[44] = g_ ? b_ : a_; K[46] = g_ ? a_ : b_; }
  { const float a_ = K[45], b_ = K[47]; const bool g_ = a_ > b_; K[45] = g_ ? b_ : a_; K[47] = g_ ? a_ : b_; }
  { const float a_ = K[32], b_ = K[33]; const bool g_ = a_ > b_; K[32] = g_ ? a_ : b_; K[33] = g_ ? b_ : a_; }
  { const float a_ = K[34], b_ = K[35]; const bool g_ = a_ > b_; K[34] = g_ ? a_ : b_; K[35] = g_ ? b_ : a_; }
  { const float a_ = K[36], b_ = K[37]; const bool g_ = a_ > b_; K[36] = g_ ? a_ : b_; K[37] = g_ ? b_ : a_; }
  { const float a_ = K[38], b_ = K[39]; const bool g_ = a_ > b_; K[38] = g_ ? a_ : b_; K[39] = g_ ? b_ : a_; }
  { const float a_ = K[40], b_ = K[41]; const bool g_ = a_ > b_; K[40] = g_ ? b_ : a_; K[41] = g_ ? a_ : b_; }
  { const float a_ = K[42], b_ = K[43]; const bool g_ = a_ > b_; K[42] = g_ ? b_ : a_; K[43] = g_ ? a_ : b_; }
  { const float a_ = K[44], b_ = K[45]; const bool g_ = a_ > b_; K[44] = g_ ? b_ : a_; K[45] = g_ ? a_ : b_; }
  { const float a_ = K[46], b_ = K[47]; const bool g_ = a_ > b_; K[46] = g_ ? b_ : a_; K[47] = g_ ? a_ : b_; }
  { const float a_ = K[32], b_ = K[40]; const bool g_ = a_ > b_; K[32] = g_ ? a_ : b_; K[40] = g_ ? b_ : a_; }
  { const float a_ = K[33], b_ = K[41]; const bool g_ = a_ > b_; K[33] = g_ ? a_ : b_; K[41] = g_ ? b_ : a_; }
  { const float a_ = K[34], b_ = K[42]; const bool g_ = a_ > b_; K[34] = g_ ? a_ : b_; K[42] = g_ ? b_ : a_; }
  { const float a_ = K[35], b_ = K[43]; const bool g_ = a_ > b_; K[35] = g_ ? a_ : b_; K[43] = g_ ? b_ : a_; }
  { const float a_ = K[36], b_ = K[44]; const bool g_ = a_ > b_; K[36] = g_ ? a_ : b_; K[44] = g_ ? b_ : a_; }
  { const float a_ = K[37], b_ = K[45]; const bool g_ = a_ > b_; K[37] = g_ ? a_ : b_; K[45] = g_ ? b_ : a_; }
  { const float a_ = K[38], b_ = K[46]; const bool g_ = a_ > b_; K[38] = g_ ? a_ : b_; K[46] = g_ ? b_ : a_; }
  { const float a_ = K[39], b_ = K[47]; const bool g_ = a_ > b_; K[39] = g_ ? a_ : b_; K[47] = g_ ? b_ : a_; }
  { const float a_ = K[32], b_ = K[36]; const bool g_ = a_ > b_; K[32] = g_ ? a_ : b_; K[36] = g_ ? b_ : a_; }
  { const float a_ = K[33], b_ = K[37]; const bool g_ = a_ > b_; K[33] = g_ ? a_ : b_; K[37] = g_ ? b_ : a_; }
  { const float a_ = K[34], b_ = K[38]; const bool g_ = a_ > b_; K[34] = g_ ? a_ : b_; K[38] = g_ ? b_ : a_; }
  { const float a_ = K[35], b_ = K[39]; const bool g_ = a_ > b_; K[35] = g_ ? a_ : b_; K[39] = g_ ? b_ : a_; }
  { const float a_ = K[40], b_ = K[44]; const bool g_ = a_ > b_; K[40] = g_ ? a_ : b_; K[44] = g_ ? b_ : a_; }
  { const float a_ = K[41], b_ = K[45]; const bool g_ = a_ > b_; K[41] = g_ ? a_ : b_; K[45] = g_ ? b_ : a_; }
  { const float a_ = K[42], b_ = K[46]; const bool g_ = a_ > b_; K[42] = g_ ? a_ : b_; K[46] = g_ ? b_ : a_; }
  { const float a_ = K[43], b_ = K[47]; const bool g_ = a_ > b_; K[43] = g_ ? a_ : b_; K[47] = g_ ? b_ : a_; }
  { const float a_ = K[32], b_ = K[34]; const bool g_ = a_ > b_; K[32] = g_ ? a_ : b_; K[34] = g_ ? b_ : a_; }
  { const float a_ = K[33], b_ = K[35]; const bool g_ = a_ > b_; K[33] = g_ ? a_ : b_; K[35] = g_ ? b_ : a_; }
  { const float a_ = K[36], b_ = K[38]; const bool g_ = a_ > b_; K[36] = g_ ? a_ : b_; K[38] = g_ ? b_ : a_; }
  { const float a_ = K[37], b_ = K[39]; const bool g_ = a_ > b_; K[37] = g_ ? a_ : b_; K[39] = g_ ? b_ : a_; }
  { const float a_ = K[40], b_ = K[42]; const bool g_ = a_ > b_; K[40] = g_ ? a_ : b_; K[42] = g_ ? b_ : a_; }
  { const float a_ = K[41], b_ = K[43]; const bool g_ = a_ > b_; K[41] = g_ ? a_ : b_; K[43] = g_ ? b_ : a_; }
  { const float a_ = K[44], b_ = K[46]; const bool g_ = a_ > b_; K[44] = g_ ? a_ : b_; K[46] = g_ ? b_ : a_; }
  { const float a_ = K[45], b_ = K[47]; const bool g_ = a_ > b_; K[45] = g_ ? a_ : b_; K[47] = g_ ? b_ : a_; }
  { const float a_ = K[32], b_ = K[33]; const bool g_ = a_ > b_; K[32] = g_ ? a_ : b_; K[33] = g_ ? b_ : a_; }
  { const float a_ = K[34], b_ = K[35]; const bool g_ = a_ > b_; K[34] = g_ ? a_ : b_; K[35] = g_ ? b_ : a_; }
  { const float a_ = K[36], b_ = K[37]; const bool g_ = a_ > b_; K[36] = g_ ? a_ : b_; K[37] = g_ ? b_ : a_; }
  { const float a_ = K[38], b_ = K[39]; const bool g_ = a_ > b_; K[38] = g_ ? a_ : b_; K[39] = g_ ? b_ : a_; }
  { const float a_ = K[40], b_ = K[41]; const bool g_ = a_ > b_; K[40] = g_ ? a_ : b_; K[41] = g_ ? b_ : a_; }
  { const float a_ = K[42], b_ = K[43]; const bool g_ = a_ > b_; K[42] = g_ ? a_ : b_; K[43] = g_ ? b_ : a_; }
  { const float a_ = K[44], b_ = K[45]; const bool g_ = a_ > b_; K[44] = g_ ? a_ : b_; K[45] = g_ ? b_ : a_; }
  { const float a_ = K[46], b_ = K[47]; const bool g_ = a_ > b_; K[46] = g_ ? a_ : b_; K[47] = g_ ? b_ : a_; }
  { const float a_ = K[48], b_ = K[49]; const bool g_ = a_ > b_; K[48] = g_ ? a_ : b_; K[49] = g_ ? b_ : a_; }
  { const float a_ = K[50], b_ = K[51]; const bool g_ = a_ > b_; K[50] = g_ ? b_ : a_; K[51] = g_ ? a_ : b_; }
  { const float a_ = K[52], b_ = K[53]; const bool g_ = a_ > b_; K[52] = g_ ? a_ : b_; K[53] = g_ ? b_ : a_; }
  { const float a_ = K[54], b_ = K[55]; const bool g_ = a_ > b_; K[54] = g_ ? b_ : a_; K[55] = g_ ? a_ : b_; }
  { const float a_ = K[56], b_ = K[57]; const bool g_ = a_ > b_; K[56] = g_ ? a_ : b_; K[57] = g_ ? b_ : a_; }
  { const float a_ = K[58], b_ = K[59]; const bool g_ = a_ > b_; K[58] = g_ ? b_ : a_; K[59] = g_ ? a_ : b_; }
  { const float a_ = K[60], b_ = K[61]; const bool g_ = a_ > b_; K[60] = g_ ? a_ : b_; K[61] = g_ ? b_ : a_; }
  { const float a_ = K[62], b_ = K[63]; const bool g_ = a_ > b_; K[62] = g_ ? b_ : a_; K[63] = g_ ? a_ : b_; }
  { const float a_ = K[48], b_ = K[50]; const bool g_ = a_ > b_; K[48] = g_ ? a_ : b_; K[50] = g_ ? b_ : a_; }
  { const float a_ = K[49], b_ = K[51]; const bool g_ = a_ > b_; K[49] = g_ ? a_ : b_; K[51] = g_ ? b_ : a_; }
  { const float a_ = K[52], b_ = K[54]; const bool g_ = a_ > b_; K[52] = g_ ? b_ : a_; K[54] = g_ ? a_ : b_; }
  { const float a_ = K[53], b_ = K[55]; const bool g_ = a_ > b_; K[53] = g_ ? b_ : a_; K[55] = g_ ? a_ : b_; }
  { const float a_ = K[56], b_ = K[58]; const bool g_ = a_ > b_; K[56] = g_ ? a_ : b_; K[58] = g_ ? b_ : a_; }
  { const float a_ = K[57], b_ = K[59]; const bool g_ = a_ > b_; K[57] = g_ ? a_ : b_; K[59] = g_ ? b_ : a_; }
  { const float a_ = K[60], b_ = K[62]; const bool g_ = a_ > b_; K[60] = g_ ? b_ : a_; K[62] = g_ ? a_ : b_; }
  { const float a_ = K[61], b_ = K[63]; const bool g_ = a_ > b_; K[61] = g_ ? b_ : a_; K[63] = g_ ? a_ : b_; }
  { const float a_ = K[48], b_ = K[49]; const bool g_ = a_ > b_; K[48] = g_ ? a_ : b_; K[49] = g_ ? b_ : a_; }
  { const float a_ = K[50], b_ = K[51]; const bool g_ = a_ > b_; K[50] = g_ ? a_ : b_; K[51] = g_ ? b_ : a_; }
  { const float a_ = K[52], b_ = K[53]; const bool g_ = a_ > b_; K[52] = g_ ? b_ : a_; K[53] = g_ ? a_ : b_; }
  { const float a_ = K[54], b_ = K[55]; const bool g_ = a_ > b_; K[54] = g_ ? b_ : a_; K[55] = g_ ? a_ : b_; }
  { const float a_ = K[56], b_ = K[57]; const bool g_ = a_ > b_; K[56] = g_ ? a_ : b_; K[57] = g_ ? b_ : a_; }
  { const float a_ = K[58], b_ = K[59]; const bool g_ = a_ > b_; K[58] = g_ ? a_ : b_; K[59] = g_ ? b_ : a_; }
  { const float a_ = K[60], b_ = K[61]; const bool g_ = a_ > b_; K[60] = g_ ? b_ : a_; K[61] = g_ ? a_ : b_; }
  { const float a_ = K[62], b_ = K[63]; const bool g_ = a_ > b_; K[62] = g_ ? b_ : a_; K[63] = g_ ? a_ : b_; }
  { const float a_ = K[48], b_ = K[52]; const bool g_ = a_ > b_; K[48] = g_ ? a_ : b_; K[52] = g_ ? b_ : a_; }
  { const float a_ = K[49], b_ = K[53]; const bool g_ = a_ > b_; K[49] = g_ ? a_ : b_; K[53] = g_ ? b_ : a_; }
  { const float a_ = K[50], b_ = K[54]; const bool g_ = a_ > b_; K[50] = g_ ? a_ : b_; K[54] = g_ ? b_ : a_; }
  { const float a_ = K[51], b_ = K[55]; const bool g_ = a_ > b_; K[51] = g_ ? a_ : b_; K[55] = g_ ? b_ : a_; }
  { const float a_ = K[56], b_ = K[60]; const bool g_ = a_ > b_; K[56] = g_ ? b_ : a_; K[60] = g_ ? a_ : b_; }
  { const float a_ = K[57], b_ = K[61]; const bool g_ = a_ > b_; K[57] = g_ ? b_ : a_; K[61] = g_ ? a_ : b_; }
  { const float a_ = K[58], b_ = K[62]; const bool g_ = a_ > b_; K[58] = g_ ? b_ : a_; K[62] = g_ ? a_ : b_; }
  { const float a_ = K[59], b_ = K[63]; const bool g_ = a_ > b_; K[59] = g_ ? b_ : a_; K[63] = g_ ? a_ : b_; }
  { const float a_ = K[48], b_ = K[50]; const bool g_ = a_ > b_; K[48] = g_ ? a_ : b_; K[50] = g_ ? b_ : a_; }
  { const float a_ = K[49], b_ = K[51]; const bool g_ = a_ > b_; K[49] = g_ ? a_ : b_; K[51] = g_ ? b_ : a_; }
  { const float a_ = K[52], b_ = K[54]; const bool g_ = a_ > b_; K[52] = g_ ? a_ : b_; K[54] = g_ ? b_ : a_; }
  { const float a_ = K[53], b_ = K[55]; const bool g_ = a_ > b_; K[53] = g_ ? a_ : b_; K[55] = g_ ? b_ : a_; }
  { const float a_ = K[56], b_ = K[58]; const bool g_ = a_ > b_; K[56] = g_ ? b_ : a_; K[58] = g_ ? a_ : b_; }
  { const float a_ = K[57], b_ = K[59]; const bool g_ = a_ > b_; K[57] = g_ ? b_ : a_; K[59] = g_ ? a_ : b_; }
  { const float a_ = K[60], b_ = K[62]; const bool g_ = a_ > b_; K[60] = g_ ? b_ : a_; K[62] = g_ ? a_ : b_; }
  { const float a_ = K[61], b_ = K[63]; const bool g_ = a_ > b_; K[61] = g_ ? b_ : a_; K[63] = g_ ? a_ : b_; }
  { const float a_ = K[48], b_ = K[49]; const bool g_ = a_ > b_; K[48] = g_ ? a_ : b_; K[49] = g_ ? b_ : a_; }
  { const float a_ = K[50], b_ = K[51]; const bool g_ = a_ > b_; K[50] = g_ ? a_ : b_; K[51] = g_ ? b_ : a_; }
  { const float a_ = K[52], b_ = K[53]; const bool g_ = a_ > b_; K[52] = g_ ? a_ : b_; K[53] = g_ ? b_ : a_; }
  { const float a_ = K[54], b_ = K[55]; const bool g_ = a_ > b_; K[54] = g_ ? a_ : b_; K[55] = g_ ? b_ : a_; }
  { const float a_ = K[56], b_ = K[57]; const bool g_ = a_ > b_; K[56] = g_ ? b_ : a_; K[57] = g_ ? a_ : b_; }
  { const float a_ = K[58], b_ = K[59]; const bool g_ = a_ > b_; K[58] = g_ ? b_ : a_; K[59] = g_ ? a_ : b_; }
  { const float a_ = K[60], b_ = K[61]; const bool g_ = a_ > b_; K[60] = g_ ? b_ : a_; K[61] = g_ ? a_ : b_; }
  { const float a_ = K[62], b_ = K[63]; const bool g_ = a_ > b_; K[62] = g_ ? b_ : a_; K[63] = g_ ? a_ : b_; }
  { const float a_ = K[48], b_ = K[56]; const bool g_ = a_ > b_; K[48] = g_ ? a_ : b_; K[56] = g_ ? b_ : a_; }
  { const float a_ = K[49], b_ = K[57]; const bool g_ = a_ > b_; K[49] = g_ ? a_ : b_; K[57] = g_ ? b_ : a_; }
  { const float a_ = K[50], b_ = K[58]; const bool g_ = a_ > b_; K[50] = g_ ? a_ : b_; K[58] = g_ ? b_ : a_; }
  { const float a_ = K[51], b_ = K[59]; const bool g_ = a_ > b_; K[51] = g_ ? a_ : b_; K[59] = g_ ? b_ : a_; }
  { const float a_ = K[52], b_ = K[60]; const bool g_ = a_ > b_; K[52] = g_ ? a_ : b_; K[60] = g_ ? b_ : a_; }
  { const float a_ = K[53], b_ = K[61]; const bool g_ = a_ > b_; K[53] = g_ ? a_ : b_; K[61] = g_ ? b_ : a_; }
  { const float a_ = K[54], b_ = K[62]; const bool g_ = a_ > b_; K[54] = g_ ? a_ : b_; K[62] = g_ ? b_ : a_; }
  { const float a_ = K[55], b_ = K[63]; const bool g_ = a_ > b_; K[55] = g_ ? a_ : b_; K[63] = g_ ? b_ : a_; }
  { const float a_ = K[48], b_ = K[52]; const bool g_ = a_ > b_; K[48] = g_ ? a_ : b_; K[52] = g_ ? b_ : a_; }
  { const float a_ = K[49], b_ = K[53]; const bool g_ = a_ > b_; K[49] = g_ ? a_ : b_; K[53] = g_ ? b_ : a_; }
  { const float a_ = K[50], b_ = K[54]; const bool g_ = a_ > b_; K[50] = g_ ? a_ : b_; K[54] = g_ ? b_ : a_; }
  { const float a_ = K[51], b_ = K[55]; const bool g_ = a_ > b_; K[51] = g_ ? a_ : b_; K[55] = g_ ? b_ : a_; }
  { const float a_ = K[56], b_ = K[60]; const bool g_ = a_ > b_; K[56] = g_ ? a_ : b_; K[60] = g_ ? b_ : a_; }
  { const float a_ = K[57], b_ = K[61]; const bool g_ = a_ > b_; K[57] = g_ ? a_ : b_; K[61] = g_ ? b_ : a_; }
  { const float a_ = K[58], b_ = K[62]; const bool g_ = a_ > b_; K[58] = g_ ? a_ : b_; K[62] = g_ ? b_ : a_; }
  { const float a_ = K[59], b_ = K[63]; const bool g_ = a_ > b_; K[59] = g_ ? a_ : b_; K[63] = g_ ? b_ : a_; }
  { const float a_ = K[48], b_ = K[50]; const bool g_ = a_ > b_; K[48] = g_ ? a_ : b_; K[50] = g_ ? b_ : a_; }
  { const float a_ = K[49], b_ = K[51]; const bool g_ = a_ > b_; K[49] = g_ ? a_ : b_; K[51] = g_ ? b_ : a_; }
  { const float a_ = K[52], b_ = K[54]; const bool g_ = a_ > b_; K[52] = g_ ? a_ : b_; K[54] = g_ ? b_ : a_; }
  { const float a_ = K[53], b_ = K[55]; const bool g_ = a_ > b_; K[53] = g_ ? a_ : b_; K[55] = g_ ? b_ : a_; }
  { const float a_ = K[56], b_ = K[58]; const bool g_ = a_ > b_; K[56] = g_ ? a_ : b_; K[58] = g_ ? b_ : a_; }
  { const float a_ = K[57], b_ = K[59]; const bool g_ = a_ > b_; K[57] = g_ ? a_ : b_; K[59] = g_ ? b_ : a_; }
  { const float a_ = K[60], b_ = K[62]; const bool g_ = a_ > b_; K[60] = g_ ? a_ : b_; K[62] = g_ ? b_ : a_; }
  { const float a_ = K[61], b_ = K[63]; const bool g_ = a_ > b_; K[61] = g_ ? a_ : b_; K[63] = g_ ? b_ : a_; }
  { const float a_ = K[48], b_ = K[49]; const bool g_ = a_ > b_; K[48] = g_ ? a_ : b_; K[49] = g_ ? b_ : a_; }
  { const float a_ = K[50], b_ = K[51]; const bool g_ = a_ > b_; K[50] = g_ ? a_ : b_; K[51] = g_ ? b_ : a_; }
  { const float a_ = K[52], b_ = K[53]; const bool g_ = a_ > b_; K[52] = g_ ? a_ : b_; K[53] = g_ ? b_ : a_; }
  { const float a_ = K[54], b_ = K[55]; const bool g_ = a_ > b_; K[54] = g_ ? a_ : b_; K[55] = g_ ? b_ : a_; }
  { const float a_ = K[56], b_ = K[57]; const bool g_ = a_ > b_; K[56] = g_ ? a_ : b_; K[57] = g_ ? b_ : a_; }
  { const float a_ = K[58], b_ = K[59]; const bool g_ = a_ > b_; K[58] = g_ ? a_ : b_; K[59] = g_ ? b_ : a_; }
  { const float a_ = K[60], b_ = K[61]; const bool g_ = a_ > b_; K[60] = g_ ? a_ : b_; K[61] = g_ ? b_ : a_; }
  { const float a_ = K[62], b_ = K[63]; const bool g_ = a_ > b_; K[62] = g_ ? a_ : b_; K[63] = g_ ? b_ : a_; }
  { const float a_ = K[0], b_ = K[31]; K[0] = a_ > b_ ? a_ : b_; }
  { const float a_ = K[1], b_ = K[30]; K[1] = a_ > b_ ? a_ : b_; }
  { const float a_ = K[2], b_ = K[29]; K[2] = a_ > b_ ? a_ : b_; }
  { const float a_ = K[3], b_ = K[28]; K[3] = a_ > b_ ? a_ : b_; }
  { const float a_ = K[4], b_ = K[27]; K[4] = a_ > b_ ? a_ : b_; }
  { const float a_ = K[5], b_ = K[26]; K[5] = a_ > b_ ? a_ : b_; }
  { const float a_ = K[6], b_ = K[25]; K[6] = a_ > b_ ? a_ : b_; }
  { const float a_ = K[7], b_ = K[24]; K[7] = a_ > b_ ? a_ : b_; }
  { const float a_ = K[8], b_ = K[23]; K[8] = a_ > b_ ? a_ : b_; }
  { const float a_ = K[9], b_ = K[22]; K[9] = a_ > b_ ? a_ : b_; }
  { const float a_ = K[10], b_ = K[21]; K[10] = a_ > b_ ? a_ : b_; }
  { const float a_ = K[11], b_ = K[20]; K[11] = a_ > b_ ? a_ : b_; }
  { const float a_ = K[12], b_ = K[19]; K[12] = a_ > b_ ? a_ : b_; }
  { const float a_ = K[13], b_ = K[18]; K[13] = a_ > b_ ? a_ : b_; }
  { const float a_ = K[14], b_ = K[17]; K[14] = a_ > b_ ? a_ : b_; }
  { const float a_ = K[15], b_ = K[16]; K[15] = a_ > b_ ? a_ : b_; }
  { const float a_ = K[0], b_ = K[8]; const bool g_ = a_ > b_; K[0] = g_ ? a_ : b_; K[8] = g_ ? b_ : a_; }
  { const float a_ = K[1], b_ = K[9]; const bool g_ = a_ > b_; K[1] = g_ ? a_ : b_; K[9] = g_ ? b_ : a_; }
  { const float a_ = K[2], b_ = K[10]; const bool g_ = a_ > b_; K[2] = g_ ? a_ : b_; K[10] = g_ ? b_ : a_; }
  { const float a_ = K[3], b_ = K[11]; const bool g_ = a_ > b_; K[3] = g_ ? a_ : b_; K[11] = g_ ? b_ : a_; }
  { const float a_ = K[4], b_ = K[12]; const bool g_ = a_ > b_; K[4] = g_ ? a_ : b_; K[12] = g_ ? b_ : a_; }
  { const float a_ = K[5], b_ = K[13]; const bool g_ = a_ > b_; K[5] = g_ ? a_ : b_; K[13] = g_ ? b_ : a_; }
  { const float a_ = K[6], b_ = K[14]; const bool g_ = a_ > b_; K[6] = g_ ? a_ : b_; K[14] = g_ ? b_ : a_; }
  { const float a_ = K[7], b_ = K[15]; const bool g_ = a_ > b_; K[7] = g_ ? a_ : b_; K[15] = g_ ? b_ : a_; }
  { const float a_ = K[0], b_ = K[4]; const bool g_ = a_ > b_; K[0] = g_ ? a_ : b_; K[4] = g_ ? b_ : a_; }
  { const float a_ = K[1], b_ = K[5]; const bool g_ = a_ > b_; K[1] = g_ ? a_ : b_; K[5] = g_ ? b_ : a_; }
  { const float a_ = K[2], b_ = K[6]; const bool g_ = a_ > b_; K[2] = g_ ? a_ : b_; K[6] = g_ ? b_ : a_; }
  { const float a_ = K[3], b_ = K[7]; const bool g_ = a_ > b_; K[3] = g_ ? a_ : b_; K[7] = g_ ? b_ : a_; }
  { const float a_ = K[8], b_ = K[12]; const bool g_ = a_ > b_; K[8] = g_ ? a_ : b_; K[12] = g_ ? b_ : a_; }
  { const float a_ = K[9], b_ = K[13]; const bool g_ = a_ > b_; K[9] = g_ ? a_ : b_; K[13] = g_ ? b_ : a_; }
  { const float a_ = K[10], b_ = K[14]; const bool g_ = a_ > b_; K[10] = g_ ? a_ : b_; K[14] = g_ ? b_ : a_; }
  { const float a_ = K[11], b_ = K[15]; const bool g_ = a_ > b_; K[11] = g_ ? a_ : b_; K[15] = g_ ? b_ : a_; }
  { const float a_ = K[0], b_ = K[2]; const bool g_ = a_ > b_; K[0] = g_ ? a_ : b_; K[2] = g_ ? b_ : a_; }
  { const float a_ = K[1], b_ = K[3]; const bool g_ = a_ > b_; K[1] = g_ ? a_ : b_; K[3] = g_ ? b_ : a_; }
  { const float a_ = K[4], b_ = K[6]; const bool g_ = a_ > b_; K[4] = g_ ? a_ : b_; K[6] = g_ ? b_ : a_; }
  { const float a_ = K[5], b_ = K[7]; const bool g_ = a_ > b_; K[5] = g_ ? a_ : b_; K[7] = g_ ? b_ : a_; }
  { const float a_ = K[8], b_ = K[10]; const bool g_ = a_ > b_; K[8] = g_ ? a_ : b_; K[10] = g_ ? b_ : a_; }
  { const float a_ = K[9], b_ = K[11]; const bool g_ = a_ > b_; K[9] = g_ ? a_ : b_; K[11] = g_ ? b_ : a_; }
  { const float a_ = K[12], b_ = K[14]; const bool g_ = a_ > b_; K[12] = g_ ? a_ : b_; K[14] = g_ ? b_ : a_; }
  { const float a_ = K[13], b_ = K[15]; const bool g_ = a_ > b_; K[13] = g_ ? a_ : b_; K[15] = g_ ? b_ : a_; }
  { const float a_ = K[0], b_ = K[1]; const bool g_ = a_ > b_; K[0] = g_ ? a_ : b_; K[1] = g_ ? b_ : a_; }
  { const float a_ = K[2], b_ = K[3]; const bool g_ = a_ > b_; K[2] = g_ ? a_ : b_; K[3] = g_ ? b_ : a_; }
  { const float a_ = K[4], b_ = K[5]; const bool g_ = a_ > b_; K[4] = g_ ? a_ : b_; K[5] = g_ ? b_ : a_; }
  { const float a_ = K[6], b_ = K[7]; const bool g_ = a_ > b_; K[6] = g_ ? a_ : b_; K[7] = g_ ? b_ : a_; }
  { const float a_ = K[8], b_ = K[9]; const bool g_ = a_ > b_; K[8] = g_ ? a_ : b_; K[9] = g_ ? b_ : a_; }
  { const float a_ = K[10], b_ = K[11]; const bool g_ = a_ > b_; K[10] = g_ ? a_ : b_; K[11] = g_ ? b_ : a_; }
  { const float a_ = K[12], b_ = K[13]; const bool g_ = a_ > b_; K[12] = g_ ? a_ : b_; K[13] = g_ ? b_ : a_; }
  { const float a_ = K[14], b_ = K[15]; const bool g_ = a_ > b_; K[14] = g_ ? a_ : b_; K[15] = g_ ? b_ : a_; }
  { const float a_ = K[32], b_ = K[63]; K[32] = a_ > b_ ? a_ : b_; }
  { const float a_ = K[33], b_ = K[62]; K[33] = a_ > b_ ? a_ : b_; }
  { const float a_ = K[34], b_ = K[61]; K[34] = a_ > b_ ? a_ : b_; }
  { const float a_ = K[35], b_ = K[60]; K[35] = a_ > b_ ? a_ : b_; }
  { const float a_ = K[36], b_ = K[59]; K[36] = a_ > b_ ? a_ : b_; }
  { const float a_ = K[37], b_ = K[58]; K[37] = a_ > b_ ? a_ : b_; }
  { const float a_ = K[38], b_ = K[57]; K[38] = a_ > b_ ? a_ : b_; }
  { const float a_ = K[39], b_ = K[56]; K[39] = a_ > b_ ? a_ : b_; }
  { const float a_ = K[40], b_ = K[55]; K[40] = a_ > b_ ? a_ : b_; }
  { const float a_ = K[41], b_ = K[54]; K[41] = a_ > b_ ? a_ : b_; }
  { const float a_ = K[42], b_ = K[53]; K[42] = a_ > b_ ? a_ : b_; }
  { const float a_ = K[43], b_ = K[52]; K[43] = a_ > b_ ? a_ : b_; }
  { const float a_ = K[44], b_ = K[51]; K[44] = a_ > b_ ? a_ : b_; }
  { const float a_ = K[45], b_ = K[50]; K[45] = a_ > b_ ? a_ : b_; }
  { const float a_ = K[46], b_ = K[49]; K[46] = a_ > b_ ? a_ : b_; }
  { const float a_ = K[47], b_ = K[48]; K[47] = a_ > b_ ? a_ : b_; }
  { const float a_ = K[32], b_ = K[40]; const bool g_ = a_ > b_; K[32] = g_ ? a_ : b_; K[40] = g_ ? b_ : a_; }
  { const float a_ = K[33], b_ = K[41]; const bool g_ = a_ > b_; K[33] = g_ ? a_ : b_; K[41] = g_ ? b_ : a_; }
  { const float a_ = K[34], b_ = K[42]; const bool g_ = a_ > b_; K[34] = g_ ? a_ : b_; K[42] = g_ ? b_ : a_; }
  { const float a_ = K[35], b_ = K[43]; const bool g_ = a_ > b_; K[35] = g_ ? a_ : b_; K[43] = g_ ? b_ : a_; }
  { const float a_ = K[36], b_ = K[44]; const bool g_ = a_ > b_; K[36] = g_ ? a_ : b_; K[44] = g_ ? b_ : a_; }
  { const float a_ = K[37], b_ = K[45]; const bool g_ = a_ > b_; K[37] = g_ ? a_ : b_; K[45] = g_ ? b_ : a_; }
  { const float a_ = K[38], b_ = K[46]; const bool g_ = a_ > b_; K[38] = g_ ? a_ : b_; K[46] = g_ ? b_ : a_; }
  { const float a_ = K[39], b_ = K[47]; const bool g_ = a_ > b_; K[39] = g_ ? a_ : b_; K[47] = g_ ? b_ : a_; }
  { const float a_ = K[32], b_ = K[36]; const bool g_ = a_ > b_; K[32] = g_ ? a_ : b_; K[36] = g_ ? b_ : a_; }
  { const float a_ = K[33], b_ = K[37]; const bool g_ = a_ > b_; K[33] = g_ ? a_ : b_; K[37] = g_ ? b_ : a_; }
  { const float a_ = K[34], b_ = K[38]; const bool g_ = a_ > b_; K[34] = g_ ? a_ : b_; K[38] = g_ ? b_ : a_; }
  { const float a_ = K[35], b_ = K[39]; const bool g_ = a_ > b_; K[35] = g_ ? a_ : b_; K[39] = g_ ? b_ : a_; }
  { const float a_ = K[40], b_ = K[44]; const bool g_ = a_ > b_; K[40] = g_ ? a_ : b_; K[44] = g_ ? b_ : a_; }
  { const float a_ = K[41], b_ = K[45]; const bool g_ = a_ > b_; K[41] = g_ ? a_ : b_; K[45] = g_ ? b_ : a_; }
  { const float a_ = K[42], b_ = K[46]; const bool g_ = a_ > b_; K[42] = g_ ? a_ : b_; K[46] = g_ ? b_ : a_; }
  { const float a_ = K[43], b_ = K[47]; const bool g_ = a_ > b_; K[43] = g_ ? a_ : b_; K[47] = g_ ? b_ : a_; }
  { const float a_ = K[32], b_ = K[34]; const bool g_ = a_ > b_; K[32] = g_ ? a_ : b_; K[34] = g_ ? b_ : a_; }
  { const float a_ = K[33], b_ = K[35]; const bool g_ = a_ > b_; K[33] = g_ ? a_ : b_; K[35] = g_ ? b_ : a_; }
  { const float a_ = K[36], b_ = K[38]; const bool g_ = a_ > b_; K[36] = g_ ? a_ : b_; K[38] = g_ ? b_ : a_; }
  { const float a_ = K[37], b_ = K[39]; const bool g_ = a_ > b_; K[37] = g_ ? a_ : b_; K[39] = g_ ? b_ : a_; }
  { const float a_ = K[40], b_ = K[42]; const bool g_ = a_ > b_; K[40] = g_ ? a_ : b_; K[42] = g_ ? b_ : a_; }
  { const float a_ = K[41], b_ = K[43]; const bool g_ = a_ > b_; K[41] = g_ ? a_ : b_; K[43] = g_ ? b_ : a_; }
  { const float a_ = K[44], b_ = K[46]; const bool g_ = a_ > b_; K[44] = g_ ? a_ : b_; K[46] = g_ ? b_ : a_; }
  { const float a_ = K[45], b_ = K[47]; const bool g_ = a_ > b_; K[45] = g_ ? a_ : b_; K[47] = g_ ? b_ : a_; }
  { const float a_ = K[32], b_ = K[33]; const bool g_ = a_ > b_; K[32] = g_ ? a_ : b_; K[33] = g_ ? b_ : a_; }
  { const float a_ = K[34], b_ = K[35]; const bool g_ = a_ > b_; K[34] = g_ ? a_ : b_; K[35] = g_ ? b_ : a_; }
  { const float a_ = K[36], b_ = K[37]; const bool g_ = a_ > b_; K[36] = g_ ? a_ : b_; K[37] = g_ ? b_ : a_; }
  { const float a_ = K[38], b_ = K[39]; const bool g_ = a_ > b_; K[38] = g_ ? a_ : b_; K[39] = g_ ? b_ : a_; }
  { const float a_ = K[40], b_ = K[41]; const bool g_ = a_ > b_; K[40] = g_ ? a_ : b_; K[41] = g_ ? b_ : a_; }
  { const float a_ = K[42], b_ = K[43]; const bool g_ = a_ > b_; K[42] = g_ ? a_ : b_; K[43] = g_ ? b_ : a_; }
  { const float a_ = K[44], b_ = K[45]; const bool g_ = a_ > b_; K[44] = g_ ? a_ : b_; K[45] = g_ ? b_ : a_; }
  { const float a_ = K[46], b_ = K[47]; const bool g_ = a_ > b_; K[46] = g_ ? a_ : b_; K[47] = g_ ? b_ : a_; }
  { const float a_ = K[0], b_ = K[47]; K[0] = a_ > b_ ? a_ : b_; }
  { const float a_ = K[1], b_ = K[46]; K[1] = a_ > b_ ? a_ : b_; }
  { const float a_ = K[2], b_ = K[45]; K[2] = a_ > b_ ? a_ : b_; }
  { const float a_ = K[3], b_ = K[44]; K[3] = a_ > b_ ? a_ : b_; }
  { const float a_ = K[4], b_ = K[43]; K[4] = a_ > b_ ? a_ : b_; }
  { const float a_ = K[5], b_ = K[42]; K[5] = a_ > b_ ? a_ : b_; }
  { const float a_ = K[6], b_ = K[41]; K[6] = a_ > b_ ? a_ : b_; }
  { const float a_ = K[7], b_ = K[40]; K[7] = a_ > b_ ? a_ : b_; }
  { const float a_ = K[8], b_ = K[39]; K[8] = a_ > b_ ? a_ : b_; }
  { const float a_ = K[9], b_ = K[38]; K[9] = a_ > b_ ? a_ : b_; }
  { const float a_ = K[10], b_ = K[37]; K[10] = a_ > b_ ? a_ : b_; }
  { const float a_ = K[11], b_ = K[36]; K[11] = a_ > b_ ? a_ : b_; }
  { const float a_ = K[12], b_ = K[35]; K[12] = a_ > b_ ? a_ : b_; }
  { const float a_ = K[13], b_ = K[34]; K[13] = a_ > b_ ? a_ : b_; }
  { const float a_ = K[14], b_ = K[33]; K[14] = a_ > b_ ? a_ : b_; }
  { const float a_ = K[15], b_ = K[32]; K[15] = a_ > b_ ? a_ : b_; }
  { const float a_ = K[0], b_ = K[8]; const bool g_ = a_ > b_; K[0] = g_ ? a_ : b_; K[8] = g_ ? b_ : a_; }
  { const float a_ = K[1], b_ = K[9]; const bool g_ = a_ > b_; K[1] = g_ ? a_ : b_; K[9] = g_ ? b_ : a_; }
  { const float a_ = K[2], b_ = K[10]; const bool g_ = a_ > b_; K[2] = g_ ? a_ : b_; K[10] = g_ ? b_ : a_; }
  { const float a_ = K[3], b_ = K[11]; const bool g_ = a_ > b_; K[3] = g_ ? a_ : b_; K[11] = g_ ? b_ : a_; }
  { const float a_ = K[4], b_ = K[12]; const bool g_ = a_ > b_; K[4] = g_ ? a_ : b_; K[12] = g_ ? b_ : a_; }
  { const float a_ = K[5], b_ = K[13]; const bool g_ = a_ > b_; K[5] = g_ ? a_ : b_; K[13] = g_ ? b_ : a_; }
  { const float a_ = K[6], b_ = K[14]; const bool g_ = a_ > b_; K[6] = g_ ? a_ : b_; K[14] = g_ ? b_ : a_; }
  { const float a_ = K[7], b_ = K[15]; const bool g_ = a_ > b_; K[7] = g_ ? a_ : b_; K[15] = g_ ? b_ : a_; }
  { const float a_ = K[0], b_ = K[4]; const bool g_ = a_ > b_; K[0] = g_ ? a_ : b_; K[4] = g_ ? b_ : a_; }
  { const float a_ = K[1], b_ = K[5]; const bool g_ = a_ > b_; K[1] = g_ ? a_ : b_; K[5] = g_ ? b_ : a_; }
  { const float a_ = K[2], b_ = K[6]; const bool g_ = a_ > b_; K[2] = g_ ? a_ : b_; K[6] = g_ ? b_ : a_; }
  { const float a_ = K[3], b_ = K[7]; const bool g_ = a_ > b_; K[3] = g_ ? a_ : b_; K[7] = g_ ? b_ : a_; }
  { const float a_ = K[8], b_ = K[12]; const bool g_ = a_ > b_; K[8] = g_ ? a_ : b_; K[12] = g_ ? b_ : a_; }
  { const float a_ = K[9], b_ = K[13]; const bool g_ = a_ > b_; K[9] = g_ ? a_ : b_; K[13] = g_ ? b_ : a_; }
  { const float a_ = K[10], b_ = K[14]; const bool g_ = a_ > b_; K[10] = g_ ? a_ : b_; K[14] = g_ ? b_ : a_; }
  { const float a_ = K[11], b_ = K[15]; const bool g_ = a_ > b_; K[11] = g_ ? a_ : b_; K[15] = g_ ? b_ : a_; }
  { const float a_ = K[0], b_ = K[2]; const bool g_ = a_ > b_; K[0] = g_ ? a_ : b_; K[2] = g_ ? b_ : a_; }
  { const float a_ = K[1], b_ = K[3]; const bool g_ = a_ > b_; K[1] = g_ ? a_ : b_; K[3] = g_ ? b_ : a_; }
  { const float a_ = K[4], b_ = K[6]; const bool g_ = a_ > b_; K[4] = g_ ? a_ : b_; K[6] = g_ ? b_ : a_; }
  { const float a_ = K[5], b_ = K[7]; const bool g_ = a_ > b_; K[5] = g_ ? a_ : b_; K[7] = g_ ? b_ : a_; }
  { const float a_ = K[8], b_ = K[10]; const bool g_ = a_ > b_; K[8] = g_ ? a_ : b_; K[10] = g_ ? b_ : a_; }
  { const float a_ = K[9], b_ = K[11]; const bool g_ = a_ > b_; K[9] = g_ ? a_ : b_; K[11] = g_ ? b_ : a_; }
  { const float a_ = K[12], b_ = K[14]; const bool g_ = a_ > b_; K[12] = g_ ? a_ : b_; K[14] = g_ ? b_ : a_; }
  { const float a_ = K[13], b_ = K[15]; const bool g_ = a_ > b_; K[13] = g_ ? a_ : b_; K[15] = g_ ? b_ : a_; }
  { const float a_ = K[0], b_ = K[1]; const bool g_ = a_ > b_; K[0] = g_ ? a_ : b_; K[1] = g_ ? b_ : a_; }
  { const float a_ = K[2], b_ = K[3]; const bool g_ = a_ > b_; K[2] = g_ ? a_ : b_; K[3] = g_ ? b_ : a_; }
  { const float a_ = K[4], b_ = K[5]; const bool g_ = a_ > b_; K[4] = g_ ? a_ : b_; K[5] = g_ ? b_ : a_; }
  { const float a_ = K[6], b_ = K[7]; const bool g_ = a_ > b_; K[6] = g_ ? a_ : b_; K[7] = g_ ? b_ : a_; }
  { const float a_ = K[8], b_ = K[9]; const bool g_ = a_ > b_; K[8] = g_ ? a_ : b_; K[9] = g_ ? b_ : a_; }
  { const float a_ = K[10], b_ = K[11]; const bool g_ = a_ > b_; K[10] = g_ ? a_ : b_; K[11] = g_ ? b_ : a_; }
  { const float a_ = K[12], b_ = K[13]; const bool g_ = a_ > b_; K[12] = g_ ? a_ : b_; K[13] = g_ ? b_ : a_; }
  { const float a_ = K[14], b_ = K[15]; const bool g_ = a_ > b_; K[14] = g_ ? a_ : b_; K[15] = g_ ? b_ : a_; }
}
__device__ __forceinline__ void merge_top16(float (&T)[16], const float (&P)[16]) {
  { const float a_ = T[0], b_ = P[15]; T[0] = a_ > b_ ? a_ : b_; }
  { const float a_ = T[1], b_ = P[14]; T[1] = a_ > b_ ? a_ : b_; }
  { const float a_ = T[2], b_ = P[13]; T[2] = a_ > b_ ? a_ : b_; }
  { const float a_ = T[3], b_ = P[12]; T[3] = a_ > b_ ? a_ : b_; }
  { const float a_ = T[4], b_ = P[11]; T[4] = a_ > b_ ? a_ : b_; }
  { const float a_ = T[5], b_ = P[10]; T[5] = a_ > b_ ? a_ : b_; }
  { const float a_ = T[6], b_ = P[9]; T[6] = a_ > b_ ? a_ : b_; }
  { const float a_ = T[7], b_ = P[8]; T[7] = a_ > b_ ? a_ : b_; }
  { const float a_ = T[8], b_ = P[7]; T[8] = a_ > b_ ? a_ : b_; }
  { const float a_ = T[9], b_ = P[6]; T[9] = a_ > b_ ? a_ : b_; }
  { const float a_ = T[10], b_ = P[5]; T[10] = a_ > b_ ? a_ : b_; }
  { const float a_ = T[11], b_ = P[4]; T[11] = a_ > b_ ? a_ : b_; }
  { const float a_ = T[12], b_ = P[3]; T[12] = a_ > b_ ? a_ : b_; }
  { const float a_ = T[13], b_ = P[2]; T[13] = a_ > b_ ? a_ : b_; }
  { const float a_ = T[14], b_ = P[1]; T[14] = a_ > b_ ? a_ : b_; }
  { const float a_ = T[15], b_ = P[0]; T[15] = a_ > b_ ? a_ : b_; }
  { const float a_ = T[0], b_ = T[8]; const bool g_ = a_ > b_; T[0] = g_ ? a_ : b_; T[8] = g_ ? b_ : a_; }
  { const float a_ = T[1], b_ = T[9]; const bool g_ = a_ > b_; T[1] = g_ ? a_ : b_; T[9] = g_ ? b_ : a_; }
  { const float a_ = T[2], b_ = T[10]; const bool g_ = a_ > b_; T[2] = g_ ? a_ : b_; T[10] = g_ ? b_ : a_; }
  { const float a_ = T[3], b_ = T[11]; const bool g_ = a_ > b_; T[3] = g_ ? a_ : b_; T[11] = g_ ? b_ : a_; }
  { const float a_ = T[4], b_ = T[12]; const bool g_ = a_ > b_; T[4] = g_ ? a_ : b_; T[12] = g_ ? b_ : a_; }
  { const float a_ = T[5], b_ = T[13]; const bool g_ = a_ > b_; T[5] = g_ ? a_ : b_; T[13] = g_ ? b_ : a_; }
  { const float a_ = T[6], b_ = T[14]; const bool g_ = a_ > b_; T[6] = g_ ? a_ : b_; T[14] = g_ ? b_ : a_; }
  { const float a_ = T[7], b_ = T[15]; const bool g_ = a_ > b_; T[7] = g_ ? a_ : b_; T[15] = g_ ? b_ : a_; }
  { const float a_ = T[0], b_ = T[4]; const bool g_ = a_ > b_; T[0] = g_ ? a_ : b_; T[4] = g_ ? b_ : a_; }
  { const float a_ = T[1], b_ = T[5]; const bool g_ = a_ > b_; T[1] = g_ ? a_ : b_; T[5] = g_ ? b_ : a_; }
  { const float a_ = T[2], b_ = T[6]; const bool g_ = a_ > b_; T[2] = g_ ? a_ : b_; T[6] = g_ ? b_ : a_; }
  { const float a_ = T[3], b_ = T[7]; const bool g_ = a_ > b_; T[3] = g_ ? a_ : b_; T[7] = g_ ? b_ : a_; }
  { const float a_ = T[8], b_ = T[12]; const bool g_ = a_ > b_; T[8] = g_ ? a_ : b_; T[12] = g_ ? b_ : a_; }
  { const float a_ = T[9], b_ = T[13]; const bool g_ = a_ > b_; T[9] = g_ ? a_ : b_; T[13] = g_ ? b_ : a_; }
  { const float a_ = T[10], b_ = T[14]; const bool g_ = a_ > b_; T[10] = g_ ? a_ : b_; T[14] = g_ ? b_ : a_; }
  { const float a_ = T[11], b_ = T[15]; const bool g_ = a_ > b_; T[11] = g_ ? a_ : b_; T[15] = g_ ? b_ : a_; }
  { const float a_ = T[0], b_ = T[2]; const bool g_ = a_ > b_; T[0] = g_ ? a_ : b_; T[2] = g_ ? b_ : a_; }
  { const float a_ = T[1], b_ = T[3]; const bool g_ = a_ > b_; T[1] = g_ ? a_ : b_; T[3] = g_ ? b_ : a_; }
  { const float a_ = T[4], b_ = T[6]; const bool g_ = a_ > b_; T[4] = g_ ? a_ : b_; T[6] = g_ ? b_ : a_; }
  { const float a_ = T[5], b_ = T[7]; const bool g_ = a_ > b_; T[5] = g_ ? a_ : b_; T[7] = g_ ? b_ : a_; }
  { const float a_ = T[8], b_ = T[10]; const bool g_ = a_ > b_; T[8] = g_ ? a_ : b_; T[10] = g_ ? b_ : a_; }
  { const float a_ = T[9], b_ = T[11]; const bool g_ = a_ > b_; T[9] = g_ ? a_ : b_; T[11] = g_ ? b_ : a_; }
  { const float a_ = T[12], b_ = T[14]; const bool g_ = a_ > b_; T[12] = g_ ? a_ : b_; T[14] = g_ ? b_ : a_; }
  { const float a_ = T[13], b_ = T[15]; const bool g_ = a_ > b_; T[13] = g_ ? a_ : b_; T[15] = g_ ? b_ : a_; }
  { const float a_ = T[0], b_ = T[1]; const bool g_ = a_ > b_; T[0] = g_ ? a_ : b_; T[1] = g_ ? b_ : a_; }
  { const float a_ = T[2], b_ = T[3]; const bool g_ = a_ > b_; T[2] = g_ ? a_ : b_; T[3] = g_ ? b_ : a_; }
  { const float a_ = T[4], b_ = T[5]; const bool g_ = a_ > b_; T[4] = g_ ? a_ : b_; T[5] = g_ ? b_ : a_; }
  { const float a_ = T[6], b_ = T[7]; const bool g_ = a_ > b_; T[6] = g_ ? a_ : b_; T[7] = g_ ? b_ : a_; }
  { const float a_ = T[8], b_ = T[9]; const bool g_ = a_ > b_; T[8] = g_ ? a_ : b_; T[9] = g_ ? b_ : a_; }
  { const float a_ = T[10], b_ = T[11]; const bool g_ = a_ > b_; T[10] = g_ ? a_ : b_; T[11] = g_ ? b_ : a_; }
  { const float a_ = T[12], b_ = T[13]; const bool g_ = a_ > b_; T[12] = g_ ? a_ : b_; T[13] = g_ ? b_ : a_; }
  { const float a_ = T[14], b_ = T[15]; const bool g_ = a_ > b_; T[14] = g_ ? a_ : b_; T[15] = g_ ? b_ : a_; }
}

__device__ __forceinline__ void peer_topk(const int wave_s, const bf16* pq, const bf16* skb, int* ids, float* gates, LAS float* smem) {
  const int tid_ = opaque_tid(wave_s);
  const int lane = tid_ & 63, n = lane & 31, hh = lane >> 5, wave = tid_ >> 6;
  const int gw = blockIdx.x * NWAVES + wave;
  const int nw = gridDim.x * NWAVES;
  LAS float* lk = smem + wave * 2048;
  for (int it = gw; it < 512 * 8; it += nw) {
    const int h = it & 7, tok0 = (it >> 3) * 32;
#pragma unroll 1
    for (int half = 0; half < 2; half++) {
      bf16x8_t qf[8];
      {
        const bf16* qrow = pq + (size_t)(tok0 + n) * 2048 + h * 256 + half * 128 + 8 * hh;
#pragma unroll
        for (int ks = 0; ks < 8; ks++) qf[ks] = *(const bf16x8_t*)(qrow + 16 * ks);
      }
      float K[64];
#pragma unroll
      for (int kt = 0; kt < 4; kt++) {
        const bf16* krow = skb + ((size_t)((h * 2 + half) * 128 + kt * 32 + n)) * 128 + 8 * hh;
        f32x16_t acc;
#pragma unroll
        for (int r = 0; r < 16; r++) acc[r] = 0.f;
#pragma unroll
        for (int kq = 0; kq < 2; kq++) {
          bf16x8_t kf[4];
#pragma unroll
          for (int i = 0; i < 4; i++) kf[i] = *(const bf16x8_t*)(krow + 16 * (kq * 4 + i));
          MFMA_PAD();
#pragma unroll
          for (int i = 0; i < 4; i++) acc = __builtin_amdgcn_mfma_f32_32x32x16_bf16(kf[i], qf[kq * 4 + i], acc, 0, 0, 0);
          MFMA_PAD();
        }
#pragma unroll
        for (int i = 0; i < 16; i++) K[kt * 16 + i] = pack_key<0x7Fu>(acc[i], (unsigned)(kt * 32 + (i & 3) + 8 * (i >> 2) + 4 * hh));
      }
      __builtin_amdgcn_sched_barrier(0);
      top16_of_64(K);
      __builtin_amdgcn_sched_barrier(0);
      float T[16], P[16];
#pragma unroll
      for (int i = 0; i < 16; i++) { T[i] = K[i]; P[i] = __shfl_xor(K[i], 32, 64); }
      merge_top16(T, P);
#pragma unroll
      for (int i = 0; i < 16; i++) lk[(half * 16 + i) * 64 + lane] = T[i];
      __builtin_amdgcn_sched_barrier(0);
    }
    float f0[16], f1[16];
    int ti0[16], ti1[16];
#pragma unroll
    for (int i = 0; i < 16; i++) {
      const float k0 = lk[i * 64 + lane], k1 = lk[(16 + i) * 64 + lane];
      f0[i] = key_val<0x7Fu>(k0); ti0[i] = (int)key_idx<0x7Fu>(k0);
      f1[i] = key_val<0x7Fu>(k1); ti1[i] = (int)key_idx<0x7Fu>(k1);
    }
    float K[64];
    {
    K[0] = pack_key<0xFFu>(f0[0] + f1[0], 0u);
    K[1] = pack_key<0xFFu>(f0[0] + f1[1], 1u);
    K[2] = pack_key<0xFFu>(f0[0] + f1[2], 2u);
    K[3] = pack_key<0xFFu>(f0[0] + f1[3], 3u);
    K[4] = pack_key<0xFFu>(f0[0] + f1[4], 4u);
    K[5] = pack_key<0xFFu>(f0[0] + f1[5], 5u);
    K[6] = pack_key<0xFFu>(f0[0] + f1[6], 6u);
    K[7] = pack_key<0xFFu>(f0[0] + f1[7], 7u);
    K[8] = pack_key<0xFFu>(f0[0] + f1[8], 8u);
    K[9] = pack_key<0xFFu>(f0[0] + f1[9], 9u);
    K[10] = pack_key<0xFFu>(f0[0] + f1[10], 10u);
    K[11] = pack_key<0xFFu>(f0[0] + f1[11], 11u);
    K[12] = pack_key<0xFFu>(f0[0] + f1[12], 12u);
    K[13] = pack_key<0xFFu>(f0[0] + f1[13], 13u);
    K[14] = pack_key<0xFFu>(f0[0] + f1[14], 14u);
    K[15] = pack_key<0xFFu>(f0[0] + f1[15], 15u);
    K[16] = pack_key<0xFFu>(f0[1] + f1[0], 16u);
    K[17] = pack_key<0xFFu>(f0[1] + f1[1], 17u);
    K[18] = pack_key<0xFFu>(f0[1] + f1[2], 18u);
    K[19] = pack_key<0xFFu>(f0[1] + f1[3], 19u);
    K[20] = pack_key<0xFFu>(f0[1] + f1[4], 20u);
    K[21] = pack_key<0xFFu>(f0[1] + f1[5], 21u);
    K[22] = pack_key<0xFFu>(f0[1] + f1[6], 22u);
    K[23] = pack_key<0xFFu>(f0[1] + f1[7], 23u);
    K[24] = pack_key<0xFFu>(f0[2] + f1[0], 32u);
    K[25] = pack_key<0xFFu>(f0[2] + f1[1], 33u);
    K[26] = pack_key<0xFFu>(f0[2] + f1[2], 34u);
    K[27] = pack_key<0xFFu>(f0[2] + f1[3], 35u);
    K[28] = pack_key<0xFFu>(f0[2] + f1[4], 36u);
    K[29] = pack_key<0xFFu>(f0[3] + f1[0], 48u);
    K[30] = pack_key<0xFFu>(f0[3] + f1[1], 49u);
    K[31] = pack_key<0xFFu>(f0[3] + f1[2], 50u);
    K[32] = pack_key<0xFFu>(f0[3] + f1[3], 51u);
    K[33] = pack_key<0xFFu>(f0[4] + f1[0], 64u);
    K[34] = pack_key<0xFFu>(f0[4] + f1[1], 65u);
    K[35] = pack_key<0xFFu>(f0[4] + f1[2], 66u);
    K[36] = pack_key<0xFFu>(f0[5] + f1[0], 80u);
    K[37] = pack_key<0xFFu>(f0[5] + f1[1], 81u);
    K[38] = pack_key<0xFFu>(f0[6] + f1[0], 96u);
    K[39] = pack_key<0xFFu>(f0[6] + f1[1], 97u);
    K[40] = pack_key<0xFFu>(f0[7] + f1[0], 112u);
    K[41] = pack_key<0xFFu>(f0[7] + f1[1], 113u);
    K[42] = pack_key<0xFFu>(f0[8] + f1[0], 128u);
    K[43] = pack_key<0xFFu>(f0[9] + f1[0], 144u);
    K[44] = pack_key<0xFFu>(f0[10] + f1[0], 160u);
    K[45] = pack_key<0xFFu>(f0[11] + f1[0], 176u);
    K[46] = pack_key<0xFFu>(f0[12] + f1[0], 192u);
    K[47] = pack_key<0xFFu>(f0[13] + f1[0], 208u);
    K[48] = pack_key<0xFFu>(f0[14] + f1[0], 224u);
    K[49] = pack_key<0xFFu>(f0[15] + f1[0], 240u);
    K[50] = -3.0e38f;
    K[51] = -3.0e38f;
    K[52] = -3.0e38f;
    K[53] = -3.0e38f;
    K[54] = -3.0e38f;
    K[55] = -3.0e38f;
    K[56] = -3.0e38f;
    K[57] = -3.0e38f;
    K[58] = -3.0e38f;
    K[59] = -3.0e38f;
    K[60] = -3.0e38f;
    K[61] = -3.0e38f;
    K[62] = -3.0e38f;
    K[63] = -3.0e38f;
    }
    __builtin_amdgcn_sched_barrier(0);
    top16_of_64(K);
    __builtin_amdgcn_sched_barrier(0);
    float bv[16];
    int be[16];
#pragma unroll
    for (int r = 0; r < 16; r++) {
      const int flat = (int)key_idx<0xFFu>(K[r]);
      const int a = flat >> 4, b = flat & 15;
      int i0 = 0, i1 = 0;
#pragma unroll
      for (int i = 0; i < 16; i++) { i0 = (a == i) ? ti0[i] : i0; i1 = (b == i) ? ti1[i] : i1; }
      be[r] = i0 * 128 + i1;
      bv[r] = key_val<0xFFu>(K[r]);
    }
    const float b0 = bv[0];
    float ge[16];
    float gsum = 0.f;
#pragma unroll
    for (int r = 0; r < 16; r++) { ge[r] = __expf(bv[r] - b0); gsum += ge[r]; }
    const float ginv = 1.0f / gsum;
    if (hh == 0) {
      int* ip = ids + (size_t)(tok0 + n) * 128 + h * 16;
      float* gp = gates + (size_t)(tok0 + n) * 128 + h * 16;
#pragma unroll
      for (int r4 = 0; r4 < 4; r4++) {
        *(int4*)(ip + 4 * r4) = make_int4(be[4 * r4], be[4 * r4 + 1], be[4 * r4 + 2], be[4 * r4 + 3]);
        *(float4*)(gp + 4 * r4) = make_float4(ge[4 * r4] * ginv, ge[4 * r4 + 1] * ginv, ge[4 * r4 + 2] * ginv, ge[4 * r4 + 3] * ginv);
      }
    }
  }
}

typedef _Float16 f16x2_t __attribute__((ext_vector_type(2)));
__device__ __forceinline__ unsigned e4m3x2_to_f16x2(unsigned w, unsigned sel) {
  return __builtin_amdgcn_perm(w, w, sel);
}
__device__ __forceinline__ float dot2h(unsigned a, unsigned b, float c) {
  return __builtin_amdgcn_fdot2(__builtin_bit_cast(f16x2_t, a), __builtin_bit_cast(f16x2_t, b), c, false);
}
__device__ __forceinline__ unsigned pack_h2(float lo, float hi) {
  f16x2_t v; v.x = (_Float16)lo; v.y = (_Float16)hi;
  return __builtin_bit_cast(unsigned, v);
}
template <bool FINAL>
__device__ __forceinline__ void peer_gather(const int wave_s, bf16* xn, const float* rst, const unsigned char* ub, const unsigned char* vb, const float* vsc, const float* usc,
                                            const int* ids, const float* gates, float* xw, const float* gnext, float* outp) {
  const int tid_ = opaque_tid(wave_s);
  const int lane = tid_ & 63;
  const int gw = blockIdx.x * NWAVES + (tid_ >> 6);
  const int nw = gridDim.x * NWAVES;
  const int el = ((lane >> 5) & 1) * 8 + ((lane >> 4) & 1) * 4 + ((lane >> 3) & 1) * 2 + ((lane >> 2) & 1);
  int idv = 0;
  uint2 uu[16];
  uint2 vv[16];
  if (gw < NT) {
    idv = ids[(size_t)gw * 128 + (lane & 15)];
#pragma unroll
    for (int e = 0; e < 16; e++) {
      const int id = __builtin_amdgcn_readlane(idv, e);
      uu[e] = *(const uint2*)(ub + (size_t)id * 512 + lane * 8);
      vv[e] = *(const uint2*)(vb + (size_t)id * 512 + lane * 8);
    }
  }
  for (int tok = gw; tok < NT; tok += nw) {
    const int tokn = (tok + nw < NT) ? tok + nw : tok;
    int xqh[2] = {0, 0}, xql[2] = {0, 0};
    float xstep, qhalf;
    {
      const uint4 a = *(const uint4*)(xn + (size_t)tok * DM + lane * 16);
      const uint4 b = *(const uint4*)(xn + (size_t)tok * DM + lane * 16 + 8);
      const unsigned xw_[8] = {a.x, a.y, a.z, a.w, b.x, b.y, b.z, b.w};
      const float4* sp = (const float4*)(rst + (size_t)tok * 16);
      const float4 s0 = sp[0], s1 = sp[1], s2 = sp[2], s3 = sp[3];
      const float xs = rsqrtf((((s0.x + s0.y) + (s0.z + s0.w)) + ((s1.x + s1.y) + (s1.z + s1.w)) + ((s2.x + s2.y) + (s2.z + s2.w)) + ((s3.x + s3.y) + (s3.z + s3.w))) * (1.0f / 1024.f) + EPSF);
      float xf[16];
      float am = 0.f;
#pragma unroll
      for (int k = 0; k < 8; k++) { xf[2 * k] = bf_lo(xw_[k]) * xs; xf[2 * k + 1] = bf_hi(xw_[k]) * xs; am = fmaxf(am, fmaxf(fabsf(xf[2 * k]), fabsf(xf[2 * k + 1]))); }
#pragma unroll
      for (int o = 32; o >= 1; o >>= 1) am = fmaxf(am, __shfl_xor(am, o, 64));
      xstep = am * (1.0f / 119.f);
      const float inv = am > 0.f ? 119.f / am : 0.f;
      int qs = 0;
#pragma unroll
      for (int i = 0; i < 16; i++) {
        const int q = (int)rintf(xf[i] * inv);
        const int t = q + 8;
        xqh[i >> 3] |= ((t >> 4) & 15) << (4 * (i & 7));
        xql[i >> 3] |= (((t & 15) - 8) & 15) << (4 * (i & 7));
        qs += q;
      }
      qhalf = 0.5f * wsum((float)qs);
    }
    f16x2_t acc2[8];
#pragma unroll
    for (int i = 0; i < 8; i++) acc2[i] = (f16x2_t){(_Float16)0.f, (_Float16)0.f};
#pragma unroll 1
    for (int g = 0; g < 8; g++) {
      const int ide = __builtin_amdgcn_ds_bpermute(el << 2, idv);
      const float2 sc2 = ((const float2*)vsc)[ide];
      const float gv = gates[(size_t)tok * 128 + g * 16 + el] * sc2.x;
      const float us = sc2.y * xstep;
      const int idn = ids[(size_t)(g < 7 ? tok : tokn) * 128 + ((g + 1) & 7) * 16 + (lane & 15)];
      float d[16];
#pragma unroll
      for (int e = 0; e < 16; e++) {
        int sh = __builtin_amdgcn_sdot8((int)uu[e].x, xqh[0], 0, false);
        sh = __builtin_amdgcn_sdot8((int)uu[e].y, xqh[1], sh, false);
        int sl = __builtin_amdgcn_sdot8((int)uu[e].x, xql[0], 0, false);
        sl = __builtin_amdgcn_sdot8((int)uu[e].y, xql[1], sl, false);
        d[e] = (float)((sh << 4) + sl);
      }
#pragma unroll
      for (int e = 0; e < 16; e++) {
        const int id = __builtin_amdgcn_readlane(idn, e);
        uu[e] = *(const uint2*)(ub + (size_t)id * 512 + lane * 8);
      }
      float d8[8], d4[4], d2[2], d1;
      {
        const bool hi = (lane & 32) != 0;
#pragma unroll
        for (int i = 0; i < 8; i++) { const float send = hi ? d[i] : d[i + 8]; const float keep = hi ? d[i + 8] : d[i]; d8[i] = keep + __shfl_xor(send, 32, 64); }
      }
      {
        const bool hi = (lane & 16) != 0;
#pragma unroll
        for (int i = 0; i < 4; i++) { const float send = hi ? d8[i] : d8[i + 4]; const float keep = hi ? d8[i + 4] : d8[i]; d4[i] = keep + __shfl_xor(send, 16, 64); }
      }
      {
        const bool hi = (lane & 8) != 0;
#pragma unroll
        for (int i = 0; i < 2; i++) { const float send = hi ? d4[i] : d4[i + 2]; const float keep = hi ? d4[i + 2] : d4[i]; d2[i] = keep + __shfl_xor(send, 8, 64); }
      }
      {
        const bool hi = (lane & 4) != 0;
        const float send = hi ? d2[0] : d2[1];
        const float keep = hi ? d2[1] : d2[0];
        d1 = keep + __shfl_xor(send, 4, 64);
      }
      d1 += __shfl_xor(d1, 2, 64);
      d1 += __shfl_xor(d1, 1, 64);
      const float wl = gv * gelu_tanh((d1 + qhalf) * us);
#pragma unroll
      for (int e = 0; e < 16; e++) {
        const float w = __builtin_bit_cast(float, __builtin_amdgcn_readlane(__builtin_bit_cast(int, wl), ((e >> 3) & 1) * 32 + ((e >> 2) & 1) * 16 + ((e >> 1) & 1) * 8 + (e & 1) * 4));
        const f16x2_t w2 = __builtin_bit_cast(f16x2_t, pack_h2(w, w));
        const unsigned vw[2] = {vv[e].x, vv[e].y};
#pragma unroll
        for (int k = 0; k < 2; k++) {
          const unsigned w4 = vw[k];
          const unsigned le = __builtin_amdgcn_perm(V4_LUT_HI, V4_LUT_LO, w4 & 0x07070707u);
          const unsigned lo = __builtin_amdgcn_perm(V4_LUT_HI, V4_LUT_LO, (w4 >> 4) & 0x07070707u);
          const unsigned ee = ((w4 << 4) & 0x80808080u) | le;
          const unsigned eo = (w4 & 0x80808080u) | lo;
          const unsigned p01 = __builtin_amdgcn_perm(eo, ee, 0x040c000cu), p23 = __builtin_amdgcn_perm(eo, ee, 0x050c010cu);
          const unsigned p45 = __builtin_amdgcn_perm(eo, ee, 0x060c020cu), p67 = __builtin_amdgcn_perm(eo, ee, 0x070c030cu);
          acc2[4 * k + 0] = __builtin_elementwise_fma(__builtin_bit_cast(f16x2_t, p01), w2, acc2[4 * k + 0]);
          acc2[4 * k + 1] = __builtin_elementwise_fma(__builtin_bit_cast(f16x2_t, p23), w2, acc2[4 * k + 1]);
          acc2[4 * k + 2] = __builtin_elementwise_fma(__builtin_bit_cast(f16x2_t, p45), w2, acc2[4 * k + 2]);
          acc2[4 * k + 3] = __builtin_elementwise_fma(__builtin_bit_cast(f16x2_t, p67), w2, acc2[4 * k + 3]);
        }
      }
#pragma unroll
      for (int e = 0; e < 16; e++) {
        const int id = __builtin_amdgcn_readlane(idn, e);
        vv[e] = *(const uint2*)(vb + (size_t)id * 512 + lane * 8);
      }
      idv = idn;
    }
    float acc[16];
#pragma unroll
    for (int i = 0; i < 8; i++) { acc[2 * i] = (float)acc2[i].x; acc[2 * i + 1] = (float)acc2[i].y; }
    float* xr = xw + (size_t)tok * DM + lane * 16;
    float xv[16];
    float ssq = 0.f;
#pragma unroll
    for (int c = 0; c < 4; c++) {
      float4 a0 = *(float4*)(xr + c * 4);
      a0.x += acc[c * 4 + 0]; a0.y += acc[c * 4 + 1]; a0.z += acc[c * 4 + 2]; a0.w += acc[c * 4 + 3];
      if (!FINAL) *(float4*)(xr + c * 4) = a0;
      xv[c * 4 + 0] = a0.x; xv[c * 4 + 1] = a0.y; xv[c * 4 + 2] = a0.z; xv[c * 4 + 3] = a0.w;
      ssq += a0.x * a0.x + a0.y * a0.y + a0.z * a0.z + a0.w * a0.w;
    }
    ssq = wsum(ssq);
    const float rstd = rsqrtf(ssq * (1.0f / DM) + EPSF);
    const float4* g4 = (const float4*)(gnext + lane * 16);
    if (FINAL) {
      float* op = outp + (size_t)tok * DM + lane * 16;
#pragma unroll
      for (int c = 0; c < 4; c++) {
        const float4 gq = g4[c];
        *(float4*)(op + c * 4) = make_float4(xv[c * 4] * rstd * gq.x, xv[c * 4 + 1] * rstd * gq.y, xv[c * 4 + 2] * rstd * gq.z, xv[c * 4 + 3] * rstd * gq.w);
      }
    } else {
      uint4 o0, o1;
      { const float4 ga = g4[0], gb = g4[1];
        o0.x = pk2(xv[0] * rstd * ga.x, xv[1] * rstd * ga.y); o0.y = pk2(xv[2] * rstd * ga.z, xv[3] * rstd * ga.w);
        o0.z = pk2(xv[4] * rstd * gb.x, xv[5] * rstd * gb.y); o0.w = pk2(xv[6] * rstd * gb.z, xv[7] * rstd * gb.w); }
      { const float4 ga = g4[2], gb = g4[3];
        o1.x = pk2(xv[8] * rstd * ga.x, xv[9] * rstd * ga.y); o1.y = pk2(xv[10] * rstd * ga.z, xv[11] * rstd * ga.w);
        o1.z = pk2(xv[12] * rstd * gb.x, xv[13] * rstd * gb.y); o1.w = pk2(xv[14] * rstd * gb.z, xv[15] * rstd * gb.w); }
      *(uint4*)(xn + (size_t)tok * DM + lane * 16) = o0;
      *(uint4*)(xn + (size_t)tok * DM + lane * 16 + 8) = o1;
    }
  }
}

__device__ __forceinline__ void prologue_transposes(const int wave_s, const Params& p, unsigned char* ws, LAS unsigned char* lds) {
  const int tid_ = opaque_tid(wave_s);
  const int lane = tid_ & 63, wave = tid_ >> 6;
  LAS float* scr = (LAS float*)(lds + wave * 16384);
  const int gw = blockIdx.x * NWAVES + wave, NGW = gridDim.x * NWAVES;
  constexpr int I_IN = (DM / 64) * (DIN / 32), I_SQ = (DM / 64) * (DM / 32), I_2K = (DM / 64) * (2048 / 32);
  constexpr int I_GL = (256 / 64) * (256 / 32);
  constexpr int PER_LAYER = I_IN + 3 * I_SQ + 2 * I_2K + I_GL;
  const float* w3 = karg_in(3); const float* w19 = karg_in(19); const float* w22 = karg_in(22);
  const float* w23 = karg_in(23); const float* w24 = karg_in(24); const float* w26 = karg_in(26);
  const float* w16 = karg_in(16);
  for (int it = gw; it < 2 * PER_LAYER; it += NGW) {
    const int l = it / PER_LAYER;
    int r = it % PER_LAYER;
    unsigned char* wl = ws + WS_WT + (size_t)l * WT_LAYER;
    if (r < I_IN) { transpose_item(w3 + (size_t)l * DM * DIN, DM, DIN, (bf16*)(wl + WT_IN), scr, r, lane); continue; } r -= I_IN;
    if (r < I_SQ) { transpose_item(w19 + (size_t)l * DM * DM, DM, DM, (bf16*)(wl + WT_OUT), scr, r, lane); continue; } r -= I_SQ;
    if (r < I_SQ) { transpose_item(w22 + (size_t)l * DM * DM, DM, DM, (bf16*)(wl + WT_MQ), scr, r, lane); continue; } r -= I_SQ;
    if (r < I_2K) { transpose_item(w23 + (size_t)l * DM * 2048, DM, 2048, (bf16*)(wl + WT_MKV), scr, r, lane); continue; } r -= I_2K;
    if (r < I_SQ) { transpose_item(w24 + (size_t)l * DM * DM, DM, DM, (bf16*)(wl + WT_MO), scr, r, lane); continue; } r -= I_SQ;
    if (r < I_2K) { transpose_item(w26 + (size_t)l * DM * 2048, DM, 2048, (bf16*)(wl + WT_PQ), scr, r, lane); continue; } r -= I_2K;
    transpose_item(w16 + (size_t)l * 256 * 256, 256, 256, (bf16*)(wl + WT_GLU), scr, r, lane);
  }
}

template <class T> __device__ __forceinline__ T* opq(T* p) { asm volatile("" : "+s"(p)); return p; }
__device__ __forceinline__ void cvt_rows_bf16(const int wave_s, const float* src, bf16* dst, size_t n) {
  const int tid_ = opaque_tid(wave_s);
  const size_t gt = (size_t)blockIdx.x * (NWAVES * 64) + tid_;
  const size_t nth = (size_t)gridDim.x * NWAVES * 64;
  for (size_t i = gt; i < n / 8; i += nth) {
    const float4 a = ((const float4*)src)[2 * i], b = ((const float4*)src)[2 * i + 1];
    uint4 o; o.x = pk2(a.x, a.y); o.y = pk2(a.z, a.w); o.z = pk2(b.x, b.y); o.w = pk2(b.z, b.w);
    ((uint4*)dst)[i] = o;
  }
}

__device__ __forceinline__ unsigned enc_e4m3(float x) {
  const _Float16 hf = (_Float16)x;
  const unsigned h = (unsigned)__builtin_bit_cast(unsigned short, hf);
  return ((h + 0x7Fu + ((h >> 8) & 1u)) >> 8) & 0xFFu;
}
__device__ __forceinline__ void cvt_rows_e4m3(const int wave_s, const float* src, unsigned char* dst, size_t n, float sc) {
  const int tid_ = opaque_tid(wave_s);
  const size_t gt = (size_t)blockIdx.x * (NWAVES * 64) + tid_;
  const size_t nth = (size_t)gridDim.x * NWAVES * 64;
  for (size_t i = gt; i < n / 16; i += nth) {
    unsigned w[4];
#pragma unroll
    for (int k = 0; k < 4; k++) {
      const float4 a = ((const float4*)src)[4 * i + k];
      w[k] = enc_e4m3(a.x * sc) | (enc_e4m3(a.y * sc) << 8) | (enc_e4m3(a.z * sc) << 16) | (enc_e4m3(a.w * sc) << 24);
    }
    uint4 o; o.x = w[0]; o.y = w[1]; o.z = w[2]; o.w = w[3];
    ((uint4*)dst)[i] = o;
  }
}

__device__ __forceinline__ unsigned enc_v4(float z) {
  const float az = fabsf(z);
  unsigned c = 0;
  c += az > 0.25f; c += az > 0.5f; c += az > 0.75f; c += az > 1.0625f; c += az > 1.375f; c += az > 1.75f; c += az > 2.25f;
  return c | ((__builtin_bit_cast(unsigned, z) >> 28) & 8u);
}
__device__ __forceinline__ void cvt_rows_i4(const int wave_s, const float* src, unsigned char* dst, float* sc_out, int nrows) {
  const int tid_ = opaque_tid(wave_s);
  const int lane = tid_ & 63;
  const int gw = blockIdx.x * NWAVES + (tid_ >> 6);
  const int nw = gridDim.x * NWAVES;
  for (int r = gw; r < nrows; r += nw) {
    const float4* sp = (const float4*)(src + (size_t)r * 1024 + lane * 16);
    const float4 a0 = sp[0], a1 = sp[1], a2 = sp[2], a3 = sp[3];
    const float xv[16] = {a0.x, a0.y, a0.z, a0.w, a1.x, a1.y, a1.z, a1.w, a2.x, a2.y, a2.z, a2.w, a3.x, a3.y, a3.z, a3.w};
    float ss = 0.f;
#pragma unroll
    for (int i = 0; i < 16; i++) ss += xv[i] * xv[i];
    ss = wsum(ss);
    const float sc = sqrtf(ss * (1.0f / 1024.f)) * U4_STEP;
    const float inv = sc > 0.f ? 1.0f / sc : 0.f;
    unsigned w[2] = {0u, 0u};
#pragma unroll
    for (int i = 0; i < 16; i++) {
      const float f = fminf(fmaxf(floorf(xv[i] * inv), -8.f), 7.f);
      w[i >> 3] |= ((unsigned)(int)f & 15u) << (4 * (i & 7));
    }
    uint2 o; o.x = w[0]; o.y = w[1];
    *(uint2*)(dst + (size_t)r * 512 + lane * 8) = o;
    if (lane == 0) sc_out[2 * r] = sc;
  }
}
__device__ __forceinline__ void cvt_rows_v4(const int wave_s, const float* src, unsigned char* dst, float* sc_out, int nrows) {
  const int tid_ = opaque_tid(wave_s);
  const int lane = tid_ & 63;
  const int gw = blockIdx.x * NWAVES + (tid_ >> 6);
  const int nw = gridDim.x * NWAVES;
  for (int r = gw; r < nrows; r += nw) {
    const float4* sp = (const float4*)(src + (size_t)r * 1024 + lane * 16);
    const float4 a0 = sp[0], a1 = sp[1], a2 = sp[2], a3 = sp[3];
    const float xv[16] = {a0.x, a0.y, a0.z, a0.w, a1.x, a1.y, a1.z, a1.w, a2.x, a2.y, a2.z, a2.w, a3.x, a3.y, a3.z, a3.w};
    float ss = 0.f;
#pragma unroll
    for (int i = 0; i < 16; i++) ss += xv[i] * xv[i];
    ss = wsum(ss);
    const float sc = sqrtf(ss * (1.0f / 1024.f)) * V4_ROWSCALE;
    const float inv = sc > 0.f ? 1.0f / sc : 0.f;
    unsigned w[2] = {0u, 0u};
#pragma unroll
    for (int i = 0; i < 16; i++) w[i >> 3] |= enc_v4(xv[i] * inv) << (4 * (i & 7));
    uint2 o; o.x = w[0]; o.y = w[1];
    *(uint2*)(dst + (size_t)r * 512 + lane * 8) = o;
    if (lane == 0) sc_out[2 * r] = sc;
  }
}

#define GEMM_F32(Aptr, Wt, Cptr, Rptr, M_, N_) do { \
    pg8::Gemm g_{opq((const bf16*)(Aptr)), opq((const bf16*)(Wt)), (M_), (N_), DM}; pg8::StaticOrder S_; S_.init((M_), (N_), (int)gridDim.x, (int)blockIdx.x); \
    pg8::EpiF32R E_{opq((float*)(Cptr)), opq((const float*)(Rptr)), (N_)}; \
    pg8::gemm_phase<pg8::EpiF32R, pg8::StaticOrder, true, true>(wave_s, ldsl, g_, S_, E_); } while (0)
#define GEMM_BF16_C(Aptr, Wt, Optr, M_, N_, C_) do { \
    pg8::Gemm g_{opq((const bf16*)(Aptr)), opq((const bf16*)(Wt)), (M_), (N_), DM}; pg8::StaticOrder S_; S_.init((M_), (N_), (int)gridDim.x, (C_)); \
    pg8::EpiBf16 E_{opq((bf16*)(Optr)), (N_)}; \
    pg8::gemm_phase<pg8::EpiBf16, pg8::StaticOrder, true, true>(wave_s, ldsl, g_, S_, E_); } while (0)
#define GEMM_BF16(Aptr, Wt, Optr, M_, N_) GEMM_BF16_C(Aptr, Wt, Optr, M_, N_, (int)blockIdx.x)
#define GEMM_F32RN(Aptr, Wt, Cptr, Rptr, XGptr, Gptr, STptr) do { \
    pg8::Gemm g_{opq((const bf16*)(Aptr)), opq((const bf16*)(Wt)), NT, DM, DM}; pg8::StaticOrder S_; S_.init(NT, DM, (int)gridDim.x, (int)blockIdx.x); \
    pg8::EpiF32RN E_{opq((float*)(Cptr)), opq((const float*)(Rptr)), DM, opq((bf16*)(XGptr)), opq((const float*)(Gptr)), opq((float*)(STptr))}; \
    pg8::gemm_phase<pg8::EpiF32RN, pg8::StaticOrder, true, true>(wave_s, ldsl, g_, S_, E_); } while (0)
#define GEMM_BF16S(Aptr, Wt, Optr, N_, STptr) do { \
    pg8::Gemm g_{opq((const bf16*)(Aptr)), opq((const bf16*)(Wt)), NT, (N_), DM}; pg8::StaticOrder S_; S_.init(NT, (N_), (int)gridDim.x, (int)blockIdx.x); \
    pg8::EpiBf16S E_{opq((bf16*)(Optr)), (N_), opq((const float*)(STptr))}; \
    pg8::gemm_phase<pg8::EpiBf16S, pg8::StaticOrder, true, true>(wave_s, ldsl, g_, S_, E_); } while (0)

__global__ void __launch_bounds__(NWAVES * 64, 2) fwd_megakernel(Params p) {
  extern __shared__ __attribute__((aligned(16))) unsigned char lds[];
  LAS unsigned char* ldsl = (LAS unsigned char*)lds;
  LAS float* smem = (LAS float*)ldsl;
  const int wave_s = __builtin_amdgcn_readfirstlane((int)(threadIdx.x >> 6));
  unsigned char* ws = p.ws;
  volatile LAS unsigned* MISC = (volatile LAS unsigned*)(ldsl + (LDS_BYTES - 256));
  if (threadIdx.x < 64) MISC[threadIdx.x] = 0u;
  __syncthreads();
  const XcdBarrier bar = xcd_barrier_post((unsigned*)(ws + WS_CTL) + 4096, MISC + 8);
  float* xw = (float*)(ws + WS_XW);
  bf16* xn = (bf16*)(ws + WS_XN);
  bf16* big = (bf16*)(ws + WS_BIG);
  bf16* y = (bf16*)(ws + WS_Y);
  bf16* memh = (bf16*)(ws + WS_MEMH);
  bf16* kvb = (bf16*)(ws + WS_KVB);
  bf16* vT = (bf16*)(ws + WS_VT);
  float* ssmE = (float*)(ws + WS_SSME);
  float* ssmp = (float*)(ws + WS_SSMP);
  int* ids = (int*)(ws + WS_IDS);
  float* gates = (float*)(ws + WS_GATE);
  bf16* skb = (bf16*)(ws + WS_SKB);
  unsigned char* ub = ws + WS_UB;
  unsigned char* vb = ws + WS_VB;
  float* rst = (float*)(ws + WS_RST);
  float* vsc = (float*)(ws + WS_VSC);
  float* usc = (float*)(ws + WS_USC);

  prologue_transposes(wave_s, p, ws, ldsl);
  cvt_rows_bf16(wave_s, karg_in(27), skb, (size_t)2 * 8 * 2 * 128 * 128);
  cvt_rows_i4(wave_s, karg_in(28), ub, vsc + 1, 2 * 16384);
  cvt_rows_v4(wave_s, karg_in(29), vb, vsc, 2 * 16384);
  for (int l = 0; l < 2; l++)
    rms_rows<true>(wave_s, karg_in(1), karg_in(21) + l * DM, memh + (size_t)l * 1024 * 1024, 1024);
  ssm_params(wave_s, p, ssmp);
  rms_rows<true>(wave_s, karg_in(0), karg_in(2), xn, NT);
  xcd_barrier(bar);
  for (int l = 0; l < 2; l++)
    GEMM_BF16_C(memh + (size_t)l * 1024 * 1024, ws + WS_WT + (size_t)l * WT_LAYER + WT_MKV,
              kvb + (size_t)l * 1024 * 2048, 1024, 2048, (int)((blockIdx.x + gridDim.x - 64u - 32u * (unsigned)l) % gridDim.x));

#pragma nounroll
  for (int l = 0; l < 2; l++) {
    const float* xcur = (l == 0) ? karg_in(0) : xw;
    const float* sp = ssmp + (size_t)l * SSMP_PER_LAYER;
    const unsigned char* wl = ws + WS_WT + (size_t)l * WT_LAYER;
    GEMM_BF16(xn, wl + WT_IN, big, NT, DIN);
    xcd_barrier(bar);
    if (l == 0) vt_phase(wave_s, kvb, vT);
    ssm_chunk_end(wave_s, sp, big, ssmE, smem);
    flag_arrive((unsigned*)(ws + WS_CTL) + 8192 + 64 * l);
    attn_phase(wave_s, p, l, big, y, smem);
    conv_phase(wave_s, p, l, big, y, smem);
    flag_wait((unsigned*)(ws + WS_CTL) + 8192 + 64 * l, bar.bar);
    ssm_finish(wave_s, p, l, sp, big, ssmE, y, smem);
    xcd_barrier(bar);
    GEMM_F32RN(y, wl + WT_OUT, xw, xcur, xn, karg_in(20) + l * DM, rst);
    xcd_barrier(bar);
    GEMM_BF16S(xn, wl + WT_MQ, big, DM, rst);
    asm volatile("s_waitcnt vmcnt(0)" ::: "memory");
    __syncthreads();
    memattn_phase(wave_s, big, kvb + (size_t)l * 1024 * 2048, vT + (size_t)l * 4 * 4 * 256 * 256, y, smem);
    xcd_barrier(bar);
    GEMM_F32RN(y, wl + WT_MO, xw, (const float*)xw, xn, karg_in(25) + l * DM, rst);
    xcd_barrier(bar);
    GEMM_BF16S(xn, wl + WT_PQ, big, 2048, rst);
    xcd_barrier(bar);
    peer_topk(wave_s, big, skb + (size_t)l * 8 * 2 * 128 * 128, ids, gates, smem);
    xcd_barrier(bar);
    if (l == 0) {
      peer_gather<false>(wave_s, xn, rst, ub + (size_t)l * 16384 * 512, vb + (size_t)l * 16384 * 512, vsc + (size_t)l * 2 * 16384, usc, ids, gates, xw, karg_in(2) + DM, (float*)nullptr);
      xcd_barrier(bar);
    } else {
      peer_gather<true>(wave_s, xn, rst, ub + (size_t)l * 16384 * 512, vb + (size_t)l * 16384 * 512, vsc + (size_t)l * 2 * 16384, usc, ids, gates, xw, karg_in(30), p.out);
    }
  }
}

extern "C" void kernel_launch(void* const* d_in, const int* in_sizes, int n_in,
                              void* d_out, int out_size, void* d_ws, size_t ws_size,
                              hipStream_t stream) {
  static int grid_blocks = 0;
  if (!grid_blocks) {
    int dev = 0, cus = 0, per_cu = 0;
    (void)hipGetDevice(&dev);
    (void)hipDeviceGetAttribute(&cus, hipDeviceAttributeMultiprocessorCount, dev);
    (void)hipFuncSetAttribute((const void*)fwd_megakernel, hipFuncAttributeMaxDynamicSharedMemorySize, LDS_BYTES);
    (void)hipOccupancyMaxActiveBlocksPerMultiprocessor(&per_cu, fwd_megakernel, NWAVES * 64, LDS_BYTES);
    if (per_cu < 1) fprintf(stderr, "occupancy query reports %d blocks/CU\n", per_cu);
    grid_blocks = cus;
  }
  (void)hipMemsetAsync((char*)d_ws + WS_CTL, 0, 65536, stream);
  Params p{};
  for (int i = 0; i < 31; i++) p.in[i] = (const float*)d_in[i];
  p.out = (float*)d_out;
  p.ws = (unsigned char*)d_ws;
  void* args[] = {&p};
  hipError_t e = hipLaunchCooperativeKernel((void*)fwd_megakernel, dim3(grid_blocks), dim3(NWAVES * 64),
                                            args, LDS_BYTES, stream);
  if (e != hipSuccess)
    fprintf(stderr, "cooperative launch failed: %s (grid %d)\n", hipGetErrorString(e), grid_blocks);
}
```
